# Optimizing an MI355X kernel written in HIP

```python
import math
import jax, jax.numpy as jnp
from jax import lax
import numpy as np

D_MODEL = 2048
BATCH = 8
SEQ = 2048
DEPTH = 4

N_MIXERS = 3
N_POOL_LAYERS = (DEPTH + 2) // 3
N_DIL_LAYERS = (DEPTH + 1) // 3
N_CONV_LAYERS = DEPTH // 3

POOL_WINDOWS = (2, 4, 8, 16)
POOL_GROUPS = len(POOL_WINDOWS)
POOL_GROUP_DIM = D_MODEL // POOL_GROUPS

DIL_CONFIGS = ((128, 1), (512, 4), (2048, 16))
N_DIL_GROUPS = len(DIL_CONFIGS)
HEAD_DIM = 64
DIL_HEADS = 8
DIL_WIDTH = DIL_HEADS * HEAD_DIM
DIL_QKV_COLS = N_DIL_GROUPS * 3 * DIL_WIDTH
DIL_BLOCK = 128

N_BUCKETS = 32
MAX_DISTANCE = 2048
N_BIAS_HEADS = N_DIL_GROUPS * DIL_HEADS

CONV_WIDTH = 3

N_EXPERTS = 64
TOP_K = 8
N_EXPERT_GROUPS = 8
TOPK_GROUPS = 4
EXPERT_DIM = 128
SHARED_DIM = 256
ROUTED_SCALE = 2.5
ROW_BLOCK = 256

ALPHA = (2.0 * DEPTH) ** 0.25
BETA = (8.0 * DEPTH) ** -0.25
LN_EPS = 1e-5

kernel_name = "hybrid_pool_dilattn_shortconv_moe_deepnorm"


def layer_norm(x, g, b):
    xf = x.astype(jnp.float32)
    mu = jnp.mean(xf, axis=-1, keepdims=True)
    var = jnp.mean(jnp.square(xf - mu), axis=-1, keepdims=True)
    y = (xf - mu) * lax.rsqrt(var + LN_EPS)
    return (y * g.astype(jnp.float32) + b.astype(jnp.float32)).astype(x.dtype)


def trailing_mean_minus_self(u, w):
    s = u.shape[1]
    cs = jnp.cumsum(u, axis=1)
    prev = jnp.pad(cs, ((0, 0), (w, 0), (0, 0)))[:, :s]
    cnt = jnp.minimum(jnp.arange(1, s + 1), w).astype(jnp.float32)
    return (cs - prev) / cnt[None, :, None] - u


def pool_mixer(x, w_in, w_group, scale, w_out):
    bn, s, _ = x.shape
    u = (x @ w_in).astype(jnp.float32).reshape(bn, s, POOL_GROUPS, POOL_GROUP_DIM)
    pooled = jnp.stack([trailing_mean_minus_self(u[:, :, g], w)
                        for g, w in enumerate(POOL_WINDOWS)], axis=2)
    mixed = jnp.einsum('bsgc,gcd->bsgd', pooled.astype(x.dtype), w_group).reshape(bn, s, D_MODEL)
    return (mixed * scale) @ w_out


def t5_bucket(dist):
    max_exact = N_BUCKETS // 2
    is_small = dist < max_exact
    distf = jnp.maximum(dist, 1).astype(jnp.float32)
    large = max_exact + (jnp.log(distf / max_exact) / math.log(MAX_DISTANCE / max_exact)
                         * (N_BUCKETS - max_exact)).astype(jnp.int32)
    large = jnp.minimum(large, N_BUCKETS - 1)
    return jnp.where(is_small, dist, large)


def dilated_group(q, k, v, bias_tab, window, dil):
    bn, s, h, e = q.shape
    steps = window // dil
    span = DIL_BLOCK * dil
    s_pad = -(-s // span) * span
    nb = s_pad // span
    pad = ((0, 0), (0, s_pad - s), (0, 0), (0, 0))

    def blocks(t):
        return jnp.pad(t, pad).reshape(bn, nb, DIL_BLOCK, dil, h, e)

    def with_prev(t):
        prev = jnp.pad(t[:, :-1], ((0, 0), (1, 0), (0, 0), (0, 0), (0, 0), (0, 0)))
        return jnp.concatenate([prev, t], axis=2)

    qb = blocks(q)
    kk = with_prev(blocks(k))
    vv = with_prev(blocks(v))
    q_loc = jnp.arange(DIL_BLOCK)[:, None]
    k_loc = jnp.arange(2 * DIL_BLOCK)[None, :]
    rel = q_loc + DIL_BLOCK - k_loc
    band = (rel >= 0) & (rel <= steps)
    not_before_start = (jnp.arange(nb)[:, None, None] > 0) | (k_loc >= DIL_BLOCK)[None]
    mask = band[None] & not_before_start
    bias = bias_tab[t5_bucket(jnp.maximum(rel, 0) * dil)]
    bias = jnp.transpose(bias, (2, 0, 1)).astype(jnp.float32)
    logits = jnp.einsum('bnqrhe,bnkrhe->bnrhqk', qb, kk,
                        preferred_element_type=jnp.float32) * (e ** -0.5) + bias
    logits = jnp.where(mask[None, :, None, None], logits, -jnp.inf)
    lse = jax.nn.logsumexp(logits, axis=-1)
    p = jnp.exp(logits - lse[..., None])
    o = jnp.einsum('bnrhqk,bnkrhe->bnqrhe', p.astype(v.dtype), vv)
    o = o.reshape(bn, s_pad, h, e)[:, :s]
    lse = jnp.transpose(lse, (0, 1, 4, 2, 3)).reshape(bn, s_pad, h)[:, :s]
    return o, lse


def dilated_mixer(x, w_qkv, w_out, rel_bias):
    bn, s, _ = x.shape
    qkv = (x @ w_qkv).reshape(bn, s, N_DIL_GROUPS, 3, DIL_HEADS, HEAD_DIM)
    outs, lses = [], []
    for g, (win, dil) in enumerate(DIL_CONFIGS):
        o, l = dilated_group(qkv[:, :, g, 0], qkv[:, :, g, 1], qkv[:, :, g, 2],
                             rel_bias[:, g * DIL_HEADS:(g + 1) * DIL_HEADS], win, dil)
        outs.append(o)
        lses.append(l)
    wts = jax.nn.softmax(jnp.stack(lses, axis=0), axis=0)
    o = jnp.einsum('gbsh,gbshe->bshe', wts,
                   jnp.stack(outs, axis=0).astype(jnp.float32)).astype(x.dtype)
    return o.reshape(bn, s, DIL_WIDTH) @ w_out


def conv_mixer(x, w_in, conv_w, w_out):
    b_gate, c_gate, h = jnp.split(x @ w_in, 3, axis=-1)
    u = c_gate * h
    y = lax.conv_general_dilated(u, conv_w[:, None, :], window_strides=(1,),
                                 padding=[(CONV_WIDTH - 1, 0)],
                                 dimension_numbers=('NWC', 'WIO', 'NWC'),
                                 feature_group_count=u.shape[-1])
    return (b_gate * y) @ w_out


def moe(x2d, router_w, router_b, w_gu, w_down, sw_gu, sw_down):
    t = x2d.shape[0]
    scores = jax.nn.sigmoid(x2d.astype(jnp.float32) @ router_w.astype(jnp.float32))
    choice = scores + router_b.astype(jnp.float32)
    grouped = choice.reshape(t, N_EXPERT_GROUPS, N_EXPERTS // N_EXPERT_GROUPS)
    group_score = lax.top_k(grouped, 2)[0].sum(-1)
    _, gidx = lax.top_k(group_score, TOPK_GROUPS)
    gmask = jax.nn.one_hot(gidx, N_EXPERT_GROUPS, dtype=jnp.float32).sum(1) > 0
    emask = jnp.repeat(gmask, N_EXPERTS // N_EXPERT_GROUPS, axis=1)
    _, eidx = lax.top_k(jnp.where(emask, choice, -jnp.inf), TOP_K)
    gate = jnp.take_along_axis(scores, eidx, axis=1)
    gate = gate / jnp.sum(gate, axis=-1, keepdims=True) * ROUTED_SCALE

    tk = t * TOP_K
    flat_e = eidx.reshape(-1)
    order = jnp.argsort(flat_e)
    sorted_e = flat_e[order]
    sizes = jnp.bincount(flat_e, length=N_EXPERTS).astype(jnp.int32)
    start = jnp.cumsum(sizes) - sizes
    padded = (sizes + ROW_BLOCK - 1) // ROW_BLOCK * ROW_BLOCK
    pend = jnp.cumsum(padded)
    pstart = pend - padded
    dest = pstart[sorted_e] + (jnp.arange(tk, dtype=jnp.int32) - start[sorted_e])
    n_rows = -(-tk // ROW_BLOCK) * ROW_BLOCK + N_EXPERTS * ROW_BLOCK
    n_blk = n_rows // ROW_BLOCK
    row_tok = jnp.zeros((n_rows,), jnp.int32).at[dest].set((order // TOP_K).astype(jnp.int32))
    row_gate = jnp.zeros((n_rows,), jnp.float32).at[dest].set(gate.reshape(-1)[order])
    blk_e = jnp.minimum(jnp.searchsorted(pend, jnp.arange(n_blk, dtype=jnp.int32) * ROW_BLOCK,
                                         side='right'), N_EXPERTS - 1)
    xs = x2d[row_tok].reshape(n_blk, ROW_BLOCK, -1)
    hgu = jnp.einsum('nbd,ndf->nbf', xs, w_gu[blk_e])
    hg, hu = jnp.split(hgu, 2, axis=-1)
    y = jnp.einsum('nbf,nfd->nbd', jax.nn.silu(hg) * hu, w_down[blk_e]).reshape(n_rows, -1)
    y = y * row_gate[:, None].astype(y.dtype)
    routed = jax.ops.segment_sum(y, row_tok, num_segments=t)
    sg, su = jnp.split(x2d @ sw_gu, 2, axis=-1)
    shared = (jax.nn.silu(sg) * su) @ sw_down
    return routed + shared


def setup_inputs(seed: int = 0) -> dict:
    key = jax.random.key(seed)
    ks = jax.random.split(key, 21)

    def nrm(k, shape, scale):
        return jax.random.normal(k, shape, jnp.float32) * scale

    d = D_MODEL
    return {
        "x": nrm(ks[0], (BATCH, SEQ, d), 1.0),
        "rel_bias": nrm(ks[1], (N_BUCKETS, N_BIAS_HEADS), 0.5),
        "pool_w_in": nrm(ks[2], (N_POOL_LAYERS, d, d), d ** -0.5),
        "pool_w_group": nrm(ks[3], (N_POOL_LAYERS, POOL_GROUPS, POOL_GROUP_DIM, POOL_GROUP_DIM), POOL_GROUP_DIM ** -0.5),
        "pool_scale": 1.0 + nrm(ks[4], (N_POOL_LAYERS, d), 0.02),
        "pool_w_out": nrm(ks[5], (N_POOL_LAYERS, d, d), BETA * d ** -0.5),
        "dil_w_qkv": nrm(ks[6], (N_DIL_LAYERS, d, DIL_QKV_COLS), d ** -0.5),
        "dil_w_out": nrm(ks[7], (N_DIL_LAYERS, DIL_WIDTH, d), BETA * DIL_WIDTH ** -0.5),
        "conv_w_in": nrm(ks[8], (N_CONV_LAYERS, d, 3 * d), d ** -0.5),
        "conv_w": nrm(ks[9], (N_CONV_LAYERS, CONV_WIDTH, d), CONV_WIDTH ** -0.5),
        "conv_w_out": nrm(ks[10], (N_CONV_LAYERS, d, d), BETA * d ** -0.5),
        "ln_gain": 1.0 + nrm(ks[11], (DEPTH, 2, d), 0.02),
        "ln_bias": nrm(ks[12], (DEPTH, 2, d), 0.02),
        "router_w": nrm(ks[13], (DEPTH, d, N_EXPERTS), d ** -0.5),
        "router_bias": nrm(ks[14], (DEPTH, N_EXPERTS), 0.01),
        "expert_w_gu": nrm(ks[15], (DEPTH, N_EXPERTS, d, 2 * EXPERT_DIM), d ** -0.5),
        "expert_w_down": nrm(ks[16], (DEPTH, N_EXPERTS, EXPERT_DIM, d), BETA * EXPERT_DIM ** -0.5),
        "shared_w_gu": nrm(ks[17], (DEPTH, d, 2 * SHARED_DIM), d ** -0.5),
        "shared_w_down": nrm(ks[18], (DEPTH, SHARED_DIM, d), BETA * SHARED_DIM ** -0.5),
    }


def reference(x, rel_bias, pool_w_in, pool_w_group, pool_scale, pool_w_out,
              dil_w_qkv, dil_w_out, conv_w_in, conv_w, conv_w_out,
              ln_gain, ln_bias, router_w, router_bias, expert_w_gu, expert_w_down,
              shared_w_gu, shared_w_down):
    bn, s, d = x.shape
    ia = ib = ic = 0
    for i in range(DEPTH):
        kind = i % N_MIXERS
        if kind == 0:
            m = pool_mixer(x, pool_w_in[ia], pool_w_group[ia], pool_scale[ia], pool_w_out[ia])
            ia += 1
        elif kind == 1:
            m = dilated_mixer(x, dil_w_qkv[ib], dil_w_out[ib], rel_bias)
            ib += 1
        else:
            m = conv_mixer(x, conv_w_in[ic], conv_w[ic], conv_w_out[ic])
            ic += 1
        x = layer_norm(ALPHA * x + m, ln_gain[i, 0], ln_bias[i, 0])
        f = moe(x.reshape(bn * s, d), router_w[i], router_bias[i], expert_w_gu[i],
                expert_w_down[i], shared_w_gu[i], shared_w_down[i]).reshape(bn, s, d)
        x = layer_norm(ALPHA * x + f, ln_gain[i, 1], ln_bias[i, 1])
    return x
```

```cpp
#include <hip/hip_runtime.h>
#include <cstdio>
#include <cstdint>

#ifndef MK_ONE_LAUNCH
#define MK_ONE_LAUNCH 0
#endif

#define GAS __attribute__((address_space(1)))
#define LAS __attribute__((address_space(3)))
typedef unsigned short bf16;
typedef unsigned v4u __attribute__((ext_vector_type(4)));
typedef unsigned v2u __attribute__((ext_vector_type(2)));
typedef float f32x4 __attribute__((ext_vector_type(4)));
typedef float f32x2 __attribute__((ext_vector_type(2)));
typedef short bf16x8 __attribute__((ext_vector_type(8)));
typedef short s16x4 __attribute__((ext_vector_type(4)));

constexpr int NBATCH = 8, SEQ = 2048, D = 2048, T = NBATCH * SEQ, DEPTH = 4;
constexpr int NEXP = 64, TOPK = 8, EDIM = 128, SDIM = 256;
constexpr int QKVC = 4608, DILW = 512;
constexpr float ALPHA = 1.681792830507429f;
constexpr float LN_EPS = 1e-5f;
constexpr int CAP = 16384;
constexpr int HROWS = T * TOPK + NEXP * 256;

constexpr size_t MiB = 1u << 20;
constexpr size_t WS_CTL = 0, CTL_ZERO_BYTES = 1 * MiB;
constexpr size_t WS_W_POOL_IN = 1 * MiB;
constexpr size_t WS_W_POOL_G = WS_W_POOL_IN + 16 * MiB;
constexpr size_t WS_W_POOL_OUT = WS_W_POOL_G + 4 * MiB;
constexpr size_t WS_W_DIL_QKV = WS_W_POOL_OUT + 16 * MiB;
constexpr size_t WS_W_DIL_OUT = WS_W_DIL_QKV + 18 * MiB;
constexpr size_t WS_W_CONV_IN = WS_W_DIL_OUT + 2 * MiB;
constexpr size_t WS_W_CONV_OUT = WS_W_CONV_IN + 24 * MiB;
constexpr size_t WS_W_SH_GU = WS_W_CONV_OUT + 8 * MiB;
constexpr size_t WS_W_SH_D = WS_W_SH_GU + 8 * MiB;
constexpr size_t WS_W_EX_GU = WS_W_SH_D + 4 * MiB;
constexpr size_t WS_W_EX_D = WS_W_EX_GU + 256 * MiB;
constexpr size_t WS_XF = WS_W_EX_D + 256 * MiB;
constexpr size_t WS_YF = WS_XF + 128 * MiB;
constexpr size_t WS_X1F = WS_YF + 128 * MiB;
constexpr size_t WS_XB = WS_X1F + 128 * MiB;
constexpr size_t WS_X1B = WS_XB + 64 * MiB;
constexpr size_t WS_HB = WS_X1B + 64 * MiB;
constexpr size_t WS_HS = WS_HB + 72 * MiB;
constexpr size_t WS_LTOK = WS_HS + 8 * MiB;
constexpr size_t WS_LGATE = WS_LTOK + 4 * MiB;
constexpr size_t WS_EIDX = WS_LGATE + 4 * MiB;
constexpr size_t WS_INV = WS_EIDX + 1 * MiB;
constexpr size_t WS_BIG = WS_INV + 1 * MiB;
constexpr size_t WS_END = WS_BIG + 608 * MiB;
constexpr size_t BG_U = 0, BG_PL = 64 * MiB, BG_MX = 128 * MiB;
constexpr size_t BG_QKV = 0, BG_OG = 144 * MiB, BG_LSE = 192 * MiB, BG_O = 194 * MiB;
constexpr size_t BG_UC = 0, BG_BG = 64 * MiB, BG_Z = 128 * MiB;
constexpr int CW_BAR = 4096;
constexpr int CW_CNT = 16384;

constexpr int RING_BYTES = 131072;
constexpr int LDS_TAB = RING_BYTES;
constexpr int LDS_MISC = RING_BYTES + 8192;
constexpr int LDS_BYTES = 147456;

__device__ __forceinline__ unsigned cvt_pk_bf16(float lo, float hi) { unsigned r; asm volatile("v_cvt_pk_bf16_f32 %0, %1, %2" : "=v"(r) : "v"(lo), "v"(hi)); return r; }
__device__ __forceinline__ unsigned f2bf(float f) { unsigned u = __builtin_bit_cast(unsigned, f); return (u + 0x7fffu + ((u >> 16) & 1u)) >> 16; }
__device__ __forceinline__ unsigned pk2(float lo, float hi) { return f2bf(lo) | (f2bf(hi) << 16); }
__device__ __forceinline__ float bflo(unsigned w) { return __builtin_bit_cast(float, w << 16); }
__device__ __forceinline__ float bfhi(unsigned w) { return __builtin_bit_cast(float, w & 0xffff0000u); }
__device__ __forceinline__ float wave_sum(float v) {
#pragma unroll
    for (int o = 1; o < 64; o <<= 1) v += __shfl_xor(v, o);
    return v;
}
#define LDS_WAIT() asm volatile("s_waitcnt lgkmcnt(0)" ::: "memory")
#define VM_WAIT() asm volatile("s_waitcnt vmcnt(0)" ::: "memory")

#define XB_TMO      128
#define XB_XCNT(j)  (256  + 64 * (j))
#define XB_XSUB(j)  (1280 + 64 * (j))
#define XB_XGEN(j)  (2304 + 64 * (j))
#define XB_TOP      3328
#define XB_TOPGEN   3392
#define XCD_BAR_WORDS 3456
#define XB_SPIN_CAP (1u << 18)

__device__ __forceinline__ unsigned xb_ld(unsigned* p)              { return __hip_atomic_load(p, __ATOMIC_RELAXED, __HIP_MEMORY_SCOPE_AGENT); }
__device__ __forceinline__ unsigned xb_add(unsigned* p, unsigned v) { return __hip_atomic_fetch_add(p, v, __ATOMIC_RELAXED, __HIP_MEMORY_SCOPE_AGENT); }
__device__ __forceinline__ unsigned xb_xcc_id() { return (unsigned)__builtin_amdgcn_s_getreg((3 << 11) | 20) & 0xFu; }
#define XB_SPIN(cond, bar) do { unsigned _sp = 0; while (cond) { __builtin_amdgcn_s_sleep(1); \
    if ((++_sp & 255u) == 0u) { if (xb_ld(&(bar)[XB_TMO])) break; if (_sp > XB_SPIN_CAP) { atomicAdd(&(bar)[XB_TMO], 1u); break; } } } } while (0)

struct XcdBarrier {
    unsigned* bar; unsigned x;
    volatile LAS unsigned* st;
};

__device__ __forceinline__ XcdBarrier xcd_barrier_post(unsigned* bar, volatile LAS unsigned* st) {
    XcdBarrier b; b.bar = bar; b.x = xb_xcc_id(); b.st = st;
    if (threadIdx.x == 0) (void)xb_add(&bar[XB_XCNT(b.x)], 1u);
    return b;
}
__device__ __forceinline__ void xcd_barrier_complete(unsigned* bar, unsigned x, unsigned& nloc, unsigned& nx) {
    const unsigned G = gridDim.x * gridDim.y * gridDim.z;
    unsigned sum, cnt, mine, sp = 0u;
    for (;;) {
        sum = 0u; cnt = 0u; mine = 0u;
#pragma unroll
        for (unsigned j = 0; j < 16; ++j) { const unsigned c = xb_ld(&bar[XB_XCNT(j)]); sum += c; cnt += (c > 0u) ? 1u : 0u; mine = (j == x) ? c : mine; }
        if (sum == G) break;
        __builtin_amdgcn_s_sleep(1);
        if ((++sp & 255u) == 0u) { if (xb_ld(&bar[XB_TMO])) break; if (sp > XB_SPIN_CAP) { atomicAdd(&bar[XB_TMO], 1u); break; } }
    }
    nloc = mine > 0u ? mine : 1u; nx = cnt > 0u ? cnt : 1u;
}

__device__ __forceinline__ void xcd_barrier(const XcdBarrier& b) {
    asm volatile("s_waitcnt vmcnt(0)" ::: "memory");
    __syncthreads();
    if (threadIdx.x == 0) {
        unsigned* bar = b.bar;
        __builtin_amdgcn_s_waitcnt(0);
        unsigned nloc = b.st[0], nx = b.st[1];
        if (nloc == 0u) { xcd_barrier_complete(bar, b.x, nloc, nx); b.st[0] = nloc; b.st[1] = nx; }
        const unsigned old = xb_add(&bar[XB_XSUB(b.x)], 1u);
        const unsigned gen = old / nloc;
        if (old + 1u == (gen + 1u) * nloc) {
            __builtin_amdgcn_fence(__ATOMIC_RELEASE, "agent");
            asm volatile("s_waitcnt vmcnt(0)" ::: "memory");
            const unsigned og = xb_add(&bar[XB_TOP], 1u);
            const unsigned tg = og / nx;
            if (og + 1u == (tg + 1u) * nx) xb_add(&bar[XB_TOPGEN], 1u);
            else XB_SPIN(xb_ld(&bar[XB_TOPGEN]) == tg, bar);
            __builtin_amdgcn_fence(__ATOMIC_ACQUIRE, "agent");
            xb_add(&bar[XB_XGEN(b.x)], 1u);
            asm volatile("s_waitcnt vmcnt(0)" ::: "memory");
        } else {
            XB_SPIN(xb_ld(&bar[XB_XGEN(b.x)]) == gen, bar);
            __builtin_amdgcn_fence(__ATOMIC_ACQUIRE, "agent");
            asm volatile("s_waitcnt vmcnt(0)" ::: "memory");
        }
    }
    __syncthreads();
}

namespace g8 {
constexpr int BM = 256, BK = 64, HALF = 128, HTB = HALF * BK * 2, STAGE_BYTES = 8 * HTB, NXCD = 8, WGM = 8;
__host__ __device__ __forceinline__ int lds_byte(int r, int c) { const int st = (r >> 4) * 2 + (c >> 5), rr = r & 15, cc = c & 31, ob = rr * 64 + cc * 2; return st * 1024 + (ob ^ (((ob >> 9) & 1) << 5)); }
__host__ __device__ __forceinline__ void stage_rc(int b, int& R, int& C) { const int st = b / 1024, sb = b % 1024, swz = sb ^ (((sb >> 9) & 1) << 5); R = (st >> 1) * 16 + swz / 64; C = (st & 1) * 32 + (swz % 64) / 2; }
__host__ __device__ __forceinline__ int perm32(int rho) { const int n = rho >> 4, i = rho & 15; return 8 * (i >> 2) + 4 * n + (i & 3); }

struct Unit { const char* A; const char* B; const int* rows; int pm, pn, nvalid, aux; };

template <class Epi, class Sched, bool GATHER>
__device__ __forceinline__ void gemm_phase(LAS unsigned char* lds, const int K, const int lda, const int ldb, const Sched& S, const Epi& E) {
    const int tid = threadIdx.x, wid = __builtin_amdgcn_readfirstlane(tid >> 6), lane = tid & 63, wr = wid >> 2, wc = wid & 3, fr = lane & 15, fq = lane >> 4;
    const int nt = K / BK;
    int Rr[2], Cc[2]; unsigned voffB[2];
#pragma unroll
    for (int i = 0; i < 2; ++i) { stage_rc(tid * 16 + i * 8192, Rr[i], Cc[i]); const int Rb = Epi::PERM ? ((Rr[i] & ~31) + perm32(Rr[i] & 31)) : Rr[i]; voffB[i] = (unsigned)(Rb * ldb + Cc[i]) * 2u; }
    const size_t kstep = (size_t)(BK * 2);
    const size_t hstepB = (size_t)HALF * ldb * 2;
    const unsigned ldsw = (unsigned)wid * 1024u;
    const int aoff = lds_byte(wr * 64 + fr, fq * 8), boff = lds_byte(wc * 32 + fr, fq * 8);
#define G8_SA(b, h) (((b) * 2 + (h)) * HTB)
#define G8_SB(b, h) ((4 + (b) * 2 + (h)) * HTB)
#define G8_STAGE2(bufoff, gbase, v0, v1) do { \
        __builtin_amdgcn_global_load_lds((const unsigned*)((const char*)(gbase) + (v0)), (LAS unsigned*)(lds + (bufoff) + ldsw), 16, 0, 0); \
        __builtin_amdgcn_global_load_lds((const unsigned*)((const char*)(gbase) + (v1)), (LAS unsigned*)(lds + (bufoff) + ldsw + 8192), 16, 0, 0); } while (0)
#define G8_STAGEB(bufoff, gbase) G8_STAGE2(bufoff, gbase, voffB[0], voffB[1])
#define G8_LDA(dst, b, h) do { _Pragma("unroll") for (int m = 0; m < 4; ++m) _Pragma("unroll") for (int k = 0; k < 2; ++k) dst[m][k] = *(const LAS bf16x8*)(lds + G8_SA(b, h) + aoff + m * 2048 + k * 1024); } while (0)
#define G8_LDB(dst, b, h) do { _Pragma("unroll") for (int n = 0; n < 2; ++n) _Pragma("unroll") for (int k = 0; k < 2; ++k) dst[n][k] = *(const LAS bf16x8*)(lds + G8_SB(b, h) + boff + n * 2048 + k * 1024); } while (0)
#define G8_MMA(ai, bj, At, Bt) do { __builtin_amdgcn_s_setprio(1); _Pragma("unroll") for (int m = 0; m < 4; ++m) _Pragma("unroll") for (int n = 0; n < 2; ++n) _Pragma("unroll") for (int k = 0; k < 2; ++k) \
        acc[ai][bj][m][n] = __builtin_amdgcn_mfma_f32_16x16x32_bf16(Bt[n][k], At[m][k], acc[ai][bj][m][n], 0, 0, 0); __builtin_amdgcn_s_setprio(0); } while (0)
#define G8_WAIT_V(n) asm volatile("s_waitcnt vmcnt(" #n ")" ::: "memory")
#define G8_WAIT_L(n) asm volatile("s_waitcnt lgkmcnt(" #n ")" ::: "memory")
#define G8_BAR __builtin_amdgcn_s_barrier()
#define G8_SCHED __builtin_amdgcn_sched_barrier(0)
#define G8_SETVA(dst, u) do { _Pragma("unroll") for (int _h = 0; _h < 2; ++_h) _Pragma("unroll") for (int _i = 0; _i < 2; ++_i) { \
        const int _rl = _h * HALF + Rr[_i]; int _row = _rl; \
        if (GATHER) { _row = 0; if (_rl < (u).nvalid) _row = (u).rows[_rl]; } \
        dst[_h][_i] = (unsigned)(_row * lda + Cc[_i]) * 2u; } } while (0)
    Unit cur, nxt; int ui = 0;
    if (!S.next(0, cur)) return;
    f32x4 acc[2][2][4][2];
#pragma unroll
    for (int a = 0; a < 2; ++a)
#pragma unroll
        for (int b = 0; b < 2; ++b)
#pragma unroll
            for (int m = 0; m < 4; ++m)
#pragma unroll
                for (int n = 0; n < 2; ++n) acc[a][b][m][n] = (f32x4){0.f, 0.f, 0.f, 0.f};
    bf16x8 At[4][2], B0[2][2], B1[2][2];
    unsigned vAc[2][2], vAn[2][2];
    G8_SETVA(vAc, cur);
    const char* cA = cur.A; const char* cB = cur.B;
    G8_STAGEB(G8_SB(0, 0), cB); G8_STAGEB(G8_SB(0, 1), cB + hstepB); G8_STAGE2(G8_SA(0, 0), cA, vAc[0][0], vAc[0][1]); G8_STAGE2(G8_SA(0, 1), cA, vAc[1][0], vAc[1][1]);
    if (wr == 1) G8_BAR;
    G8_WAIT_V(2); G8_BAR;
    G8_STAGEB(G8_SB(1, 0), cB + kstep); G8_STAGE2(G8_SA(1, 0), cA + kstep, vAc[0][0], vAc[0][1]); G8_STAGEB(G8_SB(1, 1), cB + hstepB + kstep);
    G8_WAIT_V(6); G8_BAR;
    for (;;) {
        const bool has_next = S.next(ui + 1, nxt);
        const char* nA = has_next ? nxt.A : cA; const char* nB = has_next ? nxt.B : cB;
        if (GATHER) { if (has_next) { G8_SETVA(vAn, nxt); } else {
#pragma unroll
            for (int h = 0; h < 2; ++h)
#pragma unroll
                for (int i = 0; i < 2; ++i) vAn[h][i] = vAc[h][i]; } }
#pragma unroll 1
        for (int t = 0; t < nt; t += 2) {
            const bool last = (t == nt - 2);
            const char* a1 = cA + (size_t)(t + 1) * kstep;
            const char* a2 = last ? nA : cA + (size_t)(t + 2) * kstep; const char* b2 = last ? nB : cB + (size_t)(t + 2) * kstep;
            const char* a3 = a2 + kstep; const char* b3 = b2 + kstep;
            unsigned x00 = vAc[0][0], x01 = vAc[0][1], x10 = vAc[1][0], x11 = vAc[1][1];
            if (GATHER) { x00 = last ? vAn[0][0] : x00; x01 = last ? vAn[0][1] : x01; x10 = last ? vAn[1][0] : x10; x11 = last ? vAn[1][1] : x11; }
            G8_LDB(B0, 0, 0); G8_LDB(B1, 0, 1); G8_SCHED; G8_LDA(At, 0, 0); G8_STAGE2(G8_SA(1, 1), a1, vAc[1][0], vAc[1][1]);
            G8_WAIT_V(8); G8_WAIT_L(0); G8_BAR; G8_MMA(0, 0, At, B0); G8_MMA(0, 1, At, B1); G8_BAR; G8_SCHED;
            G8_LDA(At, 0, 1); G8_STAGEB(G8_SB(0, 0), b2); G8_STAGEB(G8_SB(0, 1), b2 + hstepB); G8_STAGE2(G8_SA(0, 0), a2, x00, x01);
            G8_WAIT_V(8); G8_WAIT_L(0); G8_BAR; G8_MMA(1, 0, At, B0); G8_MMA(1, 1, At, B1); G8_BAR; G8_SCHED;
            G8_LDB(B0, 1, 0); G8_LDB(B1, 1, 1); G8_SCHED; G8_LDA(At, 1, 0); G8_STAGE2(G8_SA(0, 1), a2, x10, x11);
            G8_WAIT_V(8); G8_WAIT_L(0); G8_BAR; G8_MMA(0, 0, At, B0); G8_MMA(0, 1, At, B1); G8_BAR; G8_SCHED;
            G8_LDA(At, 1, 1); G8_STAGEB(G8_SB(1, 0), b3); G8_STAGEB(G8_SB(1, 1), b3 + hstepB); G8_STAGE2(G8_SA(1, 0), a3, x00, x01);
            G8_WAIT_V(8); G8_WAIT_L(0); G8_BAR; G8_MMA(1, 0, At, B0); G8_MMA(1, 1, At, B1); G8_BAR; G8_SCHED;
        }
        if (wr == 0) G8_BAR;
        E(acc, cur, wr, wc, fr, fq);
        if (!has_next) break;
#pragma unroll
        for (int a = 0; a < 2; ++a)
#pragma unroll
            for (int b = 0; b < 2; ++b)
#pragma unroll
                for (int m = 0; m < 4; ++m)
#pragma unroll
                    for (int n = 0; n < 2; ++n) acc[a][b][m][n] = (f32x4){0.f, 0.f, 0.f, 0.f};
        cur = nxt; cA = nA; cB = nB; ++ui;
        if (GATHER) {
#pragma unroll
            for (int h = 0; h < 2; ++h)
#pragma unroll
                for (int i = 0; i < 2; ++i) vAc[h][i] = vAn[h][i]; }
        if (wr == 1) G8_BAR;
    }
    G8_WAIT_V(0);
    G8_BAR;
#undef G8_SA
#undef G8_SB
#undef G8_STAGE2
#undef G8_STAGEB
#undef G8_LDA
#undef G8_LDB
#undef G8_MMA
#undef G8_WAIT_V
#undef G8_WAIT_L
#undef G8_BAR
#undef G8_SCHED
#undef G8_SETVA
}

struct DenseSched {
    const char* A; const char* B; size_t a_tile, b_tile, agrp_stride; int agrp_shift, nM, nN, nwg, G, c;
    __device__ __forceinline__ void init(const void* A_, const void* B_, int M, int N, int lda, int ldb, int G_, int c_) {
        A = (const char*)A_; B = (const char*)B_; a_tile = (size_t)BM * lda * 2; b_tile = (size_t)BM * ldb * 2; agrp_stride = 0; agrp_shift = 0; nM = M / BM; nN = N / BM; nwg = nM * nN; G = G_; c = c_; }
    __device__ __forceinline__ bool next(int i, Unit& u) const {
        const long L = (long)i * G + c; if (L >= nwg) return false;
        int wgid = (int)L; { const int q = nwg / NXCD, r = nwg % NXCD, xcd = wgid % NXCD, off = wgid / NXCD; wgid = (xcd < r ? xcd * (q + 1) : r * (q + 1) + (xcd - r) * q) + off; }
        const int nig = WGM * nN, gid = wgid / nig, fm = gid * WGM, gsz = (nM - fm) < WGM ? (nM - fm) : WGM;
        u.pm = fm + ((wgid % nig) % gsz); u.pn = (wgid % nig) / gsz;
        u.A = A + (size_t)u.pm * a_tile + (size_t)(u.pn >> agrp_shift) * agrp_stride; u.B = B + (size_t)u.pn * b_tile; u.rows = nullptr; u.nvalid = BM; u.aux = 0; return true;
    }
};
template <int NPN, bool GATHERED>
struct ExpertSched {
    const LAS int* tpref; const LAS int* cnt; const char* A; const char* B; const int* tok; size_t b_exp, b_tile, a_tile; int NU, G, c;
    __device__ __forceinline__ bool next(int i, Unit& u) const {
        const int L = i * G + c; if (L >= NU) return false;
        const int tile = L / NPN, pn = L % NPN;
        int e = 0; while (__builtin_amdgcn_readfirstlane(tpref[e + 1]) <= tile) ++e;
        const int rb = tile - __builtin_amdgcn_readfirstlane(tpref[e]);
        u.pm = e; u.pn = pn; u.aux = tile * BM; u.nvalid = __builtin_amdgcn_readfirstlane(cnt[e]) - rb * BM; if (u.nvalid > BM) u.nvalid = BM;
        u.rows = tok + (size_t)e * CAP + rb * BM;
        u.A = GATHERED ? A : A + (size_t)tile * a_tile; u.B = B + (size_t)e * b_exp + (size_t)pn * b_tile; return true;
    }
};

struct EpiBf16 {
    static constexpr bool PERM = true;
    bf16* O; int ldc; int qscale;
    __device__ __forceinline__ void operator()(const f32x4 (&acc)[2][2][4][2], const Unit& u, int wr, int wc, int fr, int fq) const {
        const int row0 = u.pm * BM + wr * 64 + fr, col0 = u.pn * BM + wc * 32 + 8 * fq;
        const float sc = (qscale && (u.pn % 6) < 2) ? 0.125f : 1.0f;
#pragma unroll
        for (int ai = 0; ai < 2; ++ai)
#pragma unroll
            for (int m = 0; m < 4; ++m) { bf16* rowp = O + (size_t)(row0 + ai * HALF + m * 16) * ldc + col0;
#pragma unroll
                for (int bj = 0; bj < 2; ++bj) { const f32x4 v0 = acc[ai][bj][m][0] * sc, v1 = acc[ai][bj][m][1] * sc;
                    v4u w; w.x = cvt_pk_bf16(v0[0], v0[1]); w.y = cvt_pk_bf16(v0[2], v0[3]); w.z = cvt_pk_bf16(v1[0], v1[1]); w.w = cvt_pk_bf16(v1[2], v1[3]);
                    *(v4u*)(rowp + bj * HALF) = w; } }
    }
};
struct EpiScaleBf16 {
    static constexpr bool PERM = true;
    bf16* O; int ldc; const float* scale;
    __device__ __forceinline__ void operator()(const f32x4 (&acc)[2][2][4][2], const Unit& u, int wr, int wc, int fr, int fq) const {
        const int row0 = u.pm * BM + wr * 64 + fr, col0 = u.pn * BM + wc * 32 + 8 * fq;
        f32x4 sv[2][2];
#pragma unroll
        for (int bj = 0; bj < 2; ++bj)
#pragma unroll
            for (int n = 0; n < 2; ++n) sv[bj][n] = *(const f32x4*)(scale + col0 + bj * HALF + 4 * n);
#pragma unroll
        for (int ai = 0; ai < 2; ++ai)
#pragma unroll
            for (int m = 0; m < 4; ++m) { bf16* rowp = O + (size_t)(row0 + ai * HALF + m * 16) * ldc + col0;
#pragma unroll
                for (int bj = 0; bj < 2; ++bj) { const f32x4 v0 = acc[ai][bj][m][0] * sv[bj][0], v1 = acc[ai][bj][m][1] * sv[bj][1];
                    v4u w; w.x = cvt_pk_bf16(v0[0], v0[1]); w.y = cvt_pk_bf16(v0[2], v0[3]); w.z = cvt_pk_bf16(v1[0], v1[1]); w.w = cvt_pk_bf16(v1[2], v1[3]);
                    *(v4u*)(rowp + bj * HALF) = w; } }
    }
};
struct EpiResid {
    static constexpr bool PERM = false;
    const float* X; float* Y;
    __device__ __forceinline__ void operator()(const f32x4 (&acc)[2][2][4][2], const Unit& u, int wr, int wc, int fr, int fq) const {
        const int row0 = u.pm * BM + wr * 64 + fr, col0 = u.pn * BM + wc * 32 + 4 * fq;
#pragma unroll
        for (int ai = 0; ai < 2; ++ai)
#pragma unroll
            for (int m = 0; m < 4; ++m) { const size_t off = (size_t)(row0 + ai * HALF + m * 16) * D + col0;
#pragma unroll
                for (int bj = 0; bj < 2; ++bj)
#pragma unroll
                    for (int n = 0; n < 2; ++n) { const f32x4 xv = *(const f32x4*)(X + off + bj * HALF + n * 16); *(f32x4*)(Y + off + bj * HALF + n * 16) = xv * ALPHA + acc[ai][bj][m][n]; } }
    }
};
struct EpiConvIn {
    static constexpr bool PERM = true;
    bf16* UC; bf16* BGp;
    __device__ __forceinline__ void operator()(const f32x4 (&acc)[2][2][4][2], const Unit& u, int wr, int wc, int fr, int fq) const {
        const int row0 = u.pm * BM + wr * 64 + fr, cw = wc * 32 + 8 * fq;
        if (u.pn < 16) {
#pragma unroll
            for (int ai = 0; ai < 2; ++ai)
#pragma unroll
                for (int m = 0; m < 4; ++m) { bf16* rowp = UC + (size_t)(row0 + ai * HALF + m * 16) * D + u.pn * HALF + cw;
                    const f32x4 v0 = acc[ai][0][m][0] * acc[ai][1][m][0], v1 = acc[ai][0][m][1] * acc[ai][1][m][1];
                    v4u w; w.x = cvt_pk_bf16(v0[0], v0[1]); w.y = cvt_pk_bf16(v0[2], v0[3]); w.z = cvt_pk_bf16(v1[0], v1[1]); w.w = cvt_pk_bf16(v1[2], v1[3]);
                    *(v4u*)rowp = w; }
        } else {
#pragma unroll
            for (int ai = 0; ai < 2; ++ai)
#pragma unroll
                for (int m = 0; m < 4; ++m) { bf16* rowp = BGp + (size_t)(row0 + ai * HALF + m * 16) * D + (u.pn - 16) * BM + cw;
#pragma unroll
                    for (int bj = 0; bj < 2; ++bj) { const f32x4 v0 = acc[ai][bj][m][0], v1 = acc[ai][bj][m][1];
                        v4u w; w.x = cvt_pk_bf16(v0[0], v0[1]); w.y = cvt_pk_bf16(v0[2], v0[3]); w.z = cvt_pk_bf16(v1[0], v1[1]); w.w = cvt_pk_bf16(v1[2], v1[3]);
                        *(v4u*)(rowp + bj * HALF) = w; } }
        }
    }
};
__device__ __forceinline__ f32x4 silu_mul(f32x4 g, f32x4 uu) {
    f32x4 r;
#pragma unroll
    for (int j = 0; j < 4; ++j) r[j] = g[j] * __builtin_amdgcn_rcpf(1.0f + __expf(-g[j])) * uu[j];
    return r;
}
struct EpiExpertGU {
    static constexpr bool PERM = true;
    bf16* H;
    __device__ __forceinline__ void operator()(const f32x4 (&acc)[2][2][4][2], const Unit& u, int wr, int wc, int fr, int fq) const {
        const float* gates = (const float*)((const char*)u.rows + (WS_LGATE - WS_LTOK));
        const int cw = wc * 32 + 8 * fq;
#pragma unroll
        for (int ai = 0; ai < 2; ++ai)
#pragma unroll
            for (int m = 0; m < 4; ++m) { const int r = ai * HALF + wr * 64 + m * 16 + fr;
                if (r < u.nvalid) { const float gt = gates[r];
                    const f32x4 v0 = silu_mul(acc[ai][0][m][0], acc[ai][1][m][0]) * gt, v1 = silu_mul(acc[ai][0][m][1], acc[ai][1][m][1]) * gt;
                    v4u w; w.x = cvt_pk_bf16(v0[0], v0[1]); w.y = cvt_pk_bf16(v0[2], v0[3]); w.z = cvt_pk_bf16(v1[0], v1[1]); w.w = cvt_pk_bf16(v1[2], v1[3]);
                    bf16* rowp = H + (size_t)(u.aux + r) * 256 + cw;
                    *(v4u*)rowp = w; *(v4u*)(rowp + 128) = (v4u){0u, 0u, 0u, 0u}; } }
    }
};
struct EpiSharedGU {
    static constexpr bool PERM = true;
    bf16* HS;
    __device__ __forceinline__ void operator()(const f32x4 (&acc)[2][2][4][2], const Unit& u, int wr, int wc, int fr, int fq) const {
        const int row0 = u.pm * BM + wr * 64 + fr, cw = u.pn * HALF + wc * 32 + 8 * fq;
#pragma unroll
        for (int ai = 0; ai < 2; ++ai)
#pragma unroll
            for (int m = 0; m < 4; ++m) {
                const f32x4 v0 = silu_mul(acc[ai][0][m][0], acc[ai][1][m][0]), v1 = silu_mul(acc[ai][0][m][1], acc[ai][1][m][1]);
                v4u w; w.x = cvt_pk_bf16(v0[0], v0[1]); w.y = cvt_pk_bf16(v0[2], v0[3]); w.z = cvt_pk_bf16(v1[0], v1[1]); w.w = cvt_pk_bf16(v1[2], v1[3]);
                *(v4u*)(HS + (size_t)(row0 + ai * HALF + m * 16) * SDIM + cw) = w; }
    }
};
struct EpiDownY {
    static constexpr bool PERM = true;
    bf16* Y;
    __device__ __forceinline__ void operator()(const f32x4 (&acc)[2][2][4][2], const Unit& u, int wr, int wc, int fr, int fq) const {
        const int col0 = u.pn * BM + wc * 32 + 8 * fq;
#pragma unroll
        for (int ai = 0; ai < 2; ++ai)
#pragma unroll
            for (int m = 0; m < 4; ++m) { const int r = ai * HALF + wr * 64 + m * 16 + fr; bf16* rowp = Y + (size_t)(u.aux + r) * D + col0;
#pragma unroll
                for (int bj = 0; bj < 2; ++bj) { const f32x4 v0 = acc[ai][bj][m][0], v1 = acc[ai][bj][m][1];
                    v4u w; w.x = cvt_pk_bf16(v0[0], v0[1]); w.y = cvt_pk_bf16(v0[2], v0[3]); w.z = cvt_pk_bf16(v1[0], v1[1]); w.w = cvt_pk_bf16(v1[2], v1[3]);
                    *(v4u*)(rowp + bj * HALF) = w; } }
    }
};
}

struct Args { const float* in[19]; float* out; unsigned char* ws; int ph_lo, ph_hi; };
struct Frame {
    LAS unsigned char* lds; unsigned* ctl; unsigned char* ws;
    int tid, lane, wave, G;
};
enum { IN_X = 0, IN_RELB, IN_PWIN, IN_PWG, IN_PSC, IN_PWOUT, IN_DQKV, IN_DOUT, IN_CWIN, IN_CW, IN_CWOUT, IN_LNG, IN_LNB, IN_RW, IN_RB, IN_EGU, IN_ED, IN_SGU, IN_SD };

__device__ __forceinline__ void tr_item(const float* W, int K, int N, bf16* WT, int dstK, int mode, LAS float* scr, int item, int lane) {
    const int nblk = N / 32, kb = item / nblk, nb = item % nblk, k0 = 64 * kb, n0 = 32 * nb;
    int r0 = n0;
    if (mode == 1) { const int part = n0 / 2048, j = n0 % 2048; r0 = (part == 0) ? 4096 + j : 256 * (j / 128) + (part == 2 ? 128 : 0) + (j % 128); }
    if (mode == 2) { const int part = n0 / 256, j = n0 % 256; r0 = 256 * (j / 128) + 128 * part + (j % 128); }
#pragma unroll 8
    for (int i = 0; i < 32; ++i) { const int kk = 2 * i + (lane >> 5); scr[kk * 33 + (lane & 31)] = W[(size_t)(k0 + kk) * N + n0 + (lane & 31)]; }
    LDS_WAIT(); asm volatile("" ::: "memory");
    const int c = lane & 7;
#pragma unroll
    for (int j = 0; j < 4; ++j) { const int n = (lane >> 3) + 8 * j; const LAS float* s = scr + (8 * c) * 33 + n;
        v4u o; o.x = pk2(s[0 * 33], s[1 * 33]); o.y = pk2(s[2 * 33], s[3 * 33]); o.z = pk2(s[4 * 33], s[5 * 33]); o.w = pk2(s[6 * 33], s[7 * 33]);
        *(v4u*)(WT + (size_t)(r0 + n) * dstK + k0 + 8 * c) = o; }
    LDS_WAIT(); asm volatile("" ::: "memory");
}
__device__ __forceinline__ void phase_prologue(const Frame& F, const Args& a) {
    LAS float* scr = (LAS float*)(F.lds + F.wave * 16384);
    const int gw = blockIdx.x * 8 + F.wave, NGW = F.G * 8;
    constexpr int I0 = 2 * 2048, I1 = 8 * 128, I2 = 2 * 2048, I3 = 4608, I4 = 512, I5 = 6144, I6 = 2048, I7 = 4 * 512, I8 = 4 * 256, I9 = 256 * 256, I10 = 256 * 128;
    constexpr int NITEMS = I0 + I1 + I2 + I3 + I4 + I5 + I6 + I7 + I8 + I9 + I10;
    unsigned char* ws = F.ws;
    for (int it = gw; it < NITEMS; it += NGW) {
        int r = it;
        if (r < I0) { const int b = r / 2048; tr_item(a.in[IN_PWIN] + (size_t)b * D * D, D, D, (bf16*)(ws + WS_W_POOL_IN) + (size_t)b * D * D, D, 0, scr, r % 2048, F.lane); continue; } r -= I0;
        if (r < I1) { const int b = r / 128; tr_item(a.in[IN_PWG] + (size_t)b * 512 * 512, 512, 512, (bf16*)(ws + WS_W_POOL_G) + (size_t)b * 512 * 512, 512, 0, scr, r % 128, F.lane); continue; } r -= I1;
        if (r < I2) { const int b = r / 2048; tr_item(a.in[IN_PWOUT] + (size_t)b * D * D, D, D, (bf16*)(ws + WS_W_POOL_OUT) + (size_t)b * D * D, D, 0, scr, r % 2048, F.lane); continue; } r -= I2;
        if (r < I3) { tr_item(a.in[IN_DQKV], D, QKVC, (bf16*)(ws + WS_W_DIL_QKV), D, 0, scr, r, F.lane); continue; } r -= I3;
        if (r < I4) { tr_item(a.in[IN_DOUT], DILW, D, (bf16*)(ws + WS_W_DIL_OUT), DILW, 0, scr, r, F.lane); continue; } r -= I4;
        if (r < I5) { tr_item(a.in[IN_CWIN], D, 3 * D, (bf16*)(ws + WS_W_CONV_IN), D, 1, scr, r, F.lane); continue; } r -= I5;
        if (r < I6) { tr_item(a.in[IN_CWOUT], D, D, (bf16*)(ws + WS_W_CONV_OUT), D, 0, scr, r, F.lane); continue; } r -= I6;
        if (r < I7) { const int b = r / 512; tr_item(a.in[IN_SGU] + (size_t)b * D * 512, D, 512, (bf16*)(ws + WS_W_SH_GU) + (size_t)b * 512 * D, D, 2, scr, r % 512, F.lane); continue; } r -= I7;
        if (r < I8) { const int b = r / 256; tr_item(a.in[IN_SD] + (size_t)b * SDIM * D, SDIM, D, (bf16*)(ws + WS_W_SH_D) + (size_t)b * D * SDIM, SDIM, 0, scr, r % 256, F.lane); continue; } r -= I8;
        if (r < I9) { const int b = r / 256; tr_item(a.in[IN_EGU] + (size_t)b * D * 256, D, 256, (bf16*)(ws + WS_W_EX_GU) + (size_t)b * 256 * D, D, 0, scr, r % 256, F.lane); continue; } r -= I9;
        { const int b = r / 128; tr_item(a.in[IN_ED] + (size_t)b * EDIM * D, EDIM, D, (bf16*)(ws + WS_W_EX_D) + (size_t)b * D * 256, 256, 0, scr, r % 128, F.lane); }
    }
    const size_t gt = (size_t)blockIdx.x * 512 + F.tid, GT = (size_t)F.G * 512;
    for (size_t i = gt; i < (size_t)256 * 2048 * 16; i += GT) { const size_t row = i >> 4, ch = i & 15; *(v4u*)((bf16*)(ws + WS_W_EX_D) + row * 256 + 128 + ch * 8) = (v4u){0u, 0u, 0u, 0u}; }
    const float* x = a.in[IN_X]; bf16* xb = (bf16*)(ws + WS_XB);
    for (size_t i = gt; i < (size_t)T * D / 8; i += GT) { const f32x4 p = *(const f32x4*)(x + i * 8), q = *(const f32x4*)(x + i * 8 + 4);
        v4u w; w.x = pk2(p[0], p[1]); w.y = pk2(p[2], p[3]); w.z = pk2(q[0], q[1]); w.w = pk2(q[2], q[3]); *(v4u*)(xb + i * 8) = w; }
}

__device__ __forceinline__ void unpack8(const v4u w, float (&f)[8]) { f[0] = bflo(w.x); f[1] = bfhi(w.x); f[2] = bflo(w.y); f[3] = bfhi(w.y); f[4] = bflo(w.z); f[5] = bfhi(w.z); f[6] = bflo(w.w); f[7] = bfhi(w.w); }
__device__ __forceinline__ void phase_pool(const Frame& F, const bf16* U, bf16* PL) {
    for (int it = blockIdx.x * 512 + F.tid; it < (T / 32) * 256; it += F.G * 512) {
        const int cv = it & 255, ch = it >> 8, col = cv * 8, w = 2 << (col >> 9);
        const int row0 = ch * 32, pos0 = row0 & (SEQ - 1);
        float s[8], uu[8];
#pragma unroll
        for (int j = 0; j < 8; ++j) s[j] = 0.f;
        for (int j = 1; j < w; ++j) if (pos0 - j >= 0) { unpack8(*(const v4u*)(U + (size_t)(row0 - j) * D + col), uu);
#pragma unroll
            for (int q = 0; q < 8; ++q) s[q] += uu[q]; }
        for (int r = 0; r < 32; ++r) {
            const int t = row0 + r, pos = pos0 + r;
            unpack8(*(const v4u*)(U + (size_t)t * D + col), uu);
            const float inv = 1.0f / (float)((pos + 1) < w ? (pos + 1) : w);
            float o[8];
#pragma unroll
            for (int q = 0; q < 8; ++q) { s[q] += uu[q]; o[q] = s[q] * inv - uu[q]; }
            v4u ww; ww.x = pk2(o[0], o[1]); ww.y = pk2(o[2], o[3]); ww.z = pk2(o[4], o[5]); ww.w = pk2(o[6], o[7]);
            *(v4u*)(PL + (size_t)t * D + col) = ww;
            if (pos - w + 1 >= 0) { unpack8(*(const v4u*)(U + (size_t)(t - w + 1) * D + col), uu);
#pragma unroll
                for (int q = 0; q < 8; ++q) s[q] -= uu[q]; }
        }
    }
}

__device__ __forceinline__ void phase_conv(const Frame& F, const bf16* UC, const bf16* BGp, const float* cw, bf16* Z) {
    for (int it = blockIdx.x * 512 + F.tid; it < T * 256; it += F.G * 512) {
        const int cv = it & 255, t = it >> 8, col = cv * 8, pos = t & (SEQ - 1);
        float u0[8], u1[8], u2[8], bb[8], o[8];
        unpack8(*(const v4u*)(UC + (size_t)t * D + col), u2);
        if (pos >= 1) unpack8(*(const v4u*)(UC + (size_t)(t - 1) * D + col), u1); else {
#pragma unroll
            for (int q = 0; q < 8; ++q) u1[q] = 0.f; }
        if (pos >= 2) unpack8(*(const v4u*)(UC + (size_t)(t - 2) * D + col), u0); else {
#pragma unroll
            for (int q = 0; q < 8; ++q) u0[q] = 0.f; }
        unpack8(*(const v4u*)(BGp + (size_t)t * D + col), bb);
#pragma unroll
        for (int q = 0; q < 8; ++q) o[q] = bb[q] * (cw[col + q] * u0[q] + cw[D + col + q] * u1[q] + cw[2 * D + col + q] * u2[q]);
        v4u ww; ww.x = pk2(o[0], o[1]); ww.y = pk2(o[2], o[3]); ww.z = pk2(o[4], o[5]); ww.w = pk2(o[6], o[7]);
        *(v4u*)(Z + (size_t)t * D + col) = ww;
    }
}

__device__ __forceinline__ int t5_bucket(int dist) {
    if (dist < 16) return dist;
    int large = 16 + (int)(logf((float)dist / 16.0f) / logf(128.0f) * 16.0f);
    return large < 31 ? large : 31;
}
constexpr int AT_KS = 0, AT_KSTR = 144, AT_VT = 256 * 144, AT_VSTR = 520, AT_BIAS = AT_VT + 64 * 520;
__device__ __forceinline__ void phase_attn(const Frame& F, const bf16* QKV, const float* relb, bf16* OG, float* LSE) {
    LAS unsigned char* lds = F.lds;
    const int tid = F.tid, lane = F.lane, w = F.wave, fr = lane & 15, fq = lane >> 4;
    for (int unit = blockIdx.x; unit < NBATCH * 3 * 8 * 16; unit += F.G) {
        const int cmb = unit & 15, h = (unit >> 4) & 7, g = (unit >> 7) % 3, b = unit / 384;
        const int dsh = 2 * g, dil = 1 << dsh, r = cmb & (dil - 1), nb = cmb >> dsh;
        const bf16* base = QKV + (size_t)b * SEQ * QKVC + g * 1536 + h * 64;
        __syncthreads();
        {
            const int key = tid >> 1, half = tid & 1, jk = (nb - 1) * 128 + key;
            v4u kv[4], vv[4];
            if (jk >= 0) { const bf16* rp = base + (size_t)(jk * dil + r) * QKVC + half * 32;
#pragma unroll
                for (int i = 0; i < 4; ++i) { kv[i] = *(const v4u*)(rp + 512 + 8 * i); vv[i] = *(const v4u*)(rp + 1024 + 8 * i); } }
            else {
#pragma unroll
                for (int i = 0; i < 4; ++i) { kv[i] = (v4u){0u, 0u, 0u, 0u}; vv[i] = (v4u){0u, 0u, 0u, 0u}; } }
#pragma unroll
            for (int i = 0; i < 4; ++i) *(LAS v4u*)(lds + AT_KS + key * AT_KSTR + half * 64 + 16 * i) = kv[i];
#pragma unroll
            for (int i = 0; i < 4; ++i) {
                const unsigned ww[4] = {vv[i].x, vv[i].y, vv[i].z, vv[i].w};
#pragma unroll
                for (int q = 0; q < 4; ++q) { const int d = half * 32 + 8 * i + 2 * q;
                    *(LAS unsigned short*)(lds + AT_VT + d * AT_VSTR + key * 2) = (unsigned short)(ww[q] & 0xffffu);
                    *(LAS unsigned short*)(lds + AT_VT + (d + 1) * AT_VSTR + key * 2) = (unsigned short)(ww[q] >> 16); } }
            if (tid <= 128) ((LAS float*)(lds + AT_BIAS))[tid] = relb[t5_bucket(tid * dil) * 24 + g * 8 + h];
        }
        __syncthreads();
        const int qi = 16 * w + fr, jq = nb * 128 + qi, tq = jq * dil + r;
        const bf16* qp = base + (size_t)tq * QKVC + 8 * fq;
        const bf16x8 q0 = *(const bf16x8*)qp, q1 = *(const bf16x8*)(qp + 32);
        f32x4 s[9]; float mx = -INFINITY;
#pragma unroll
        for (int kt = 0; kt < 9; ++kt) {
            const int kb = 16 * (w + kt);
            const bf16x8 k0 = *(const LAS bf16x8*)(lds + AT_KS + (kb + fr) * AT_KSTR + fq * 16), k1 = *(const LAS bf16x8*)(lds + AT_KS + (kb + fr) * AT_KSTR + 64 + fq * 16);
            f32x4 a = (f32x4){0.f, 0.f, 0.f, 0.f};
            a = __builtin_amdgcn_mfma_f32_16x16x32_bf16(k0, q0, a, 0, 0, 0);
            a = __builtin_amdgcn_mfma_f32_16x16x32_bf16(k1, q1, a, 0, 0, 0);
#pragma unroll
            for (int i = 0; i < 4; ++i) { const int kl = kb + 4 * fq + i, rel = qi + 128 - kl;
                const bool ok = (rel >= 0) && (rel <= 128) && (nb > 0 || kl >= 128);
                const int rc = rel < 0 ? 0 : (rel > 128 ? 128 : rel);
                const float v = ok ? a[i] + ((LAS float*)(lds + AT_BIAS))[rc] : -INFINITY;
                a[i] = v; mx = fmaxf(mx, v); }
            s[kt] = a;
        }
        mx = fmaxf(mx, __shfl_xor(mx, 16)); mx = fmaxf(mx, __shfl_xor(mx, 32));
        float l = 0.f;
#pragma unroll
        for (int kt = 0; kt < 9; ++kt)
#pragma unroll
            for (int i = 0; i < 4; ++i) { const float p = __expf(s[kt][i] - mx); s[kt][i] = p; l += p; }
        l += __shfl_xor(l, 16); l += __shfl_xor(l, 32);
        f32x4 o[4];
#pragma unroll
        for (int nt = 0; nt < 4; ++nt) o[nt] = (f32x4){0.f, 0.f, 0.f, 0.f};
#pragma unroll
        for (int st = 0; st < 5; ++st) {
            const int kt0 = 2 * st, kt1 = 2 * st + 1;
            v4u pw; pw.x = pk2(s[kt0][0], s[kt0][1]); pw.y = pk2(s[kt0][2], s[kt0][3]);
            if (kt1 < 9) { pw.z = pk2(s[kt1 < 9 ? kt1 : 0][0], s[kt1 < 9 ? kt1 : 0][1]); pw.w = pk2(s[kt1 < 9 ? kt1 : 0][2], s[kt1 < 9 ? kt1 : 0][3]); } else { pw.z = 0u; pw.w = 0u; }
            const bf16x8 pf = __builtin_bit_cast(bf16x8, pw);
            const int kb0 = 16 * (w + kt0) + 4 * fq, kb1 = 16 * (w + kt1) + 4 * fq;
#pragma unroll
            for (int nt = 0; nt < 4; ++nt) { const int d = 16 * nt + fr;
                v2u va = *(const LAS v2u*)(lds + AT_VT + d * AT_VSTR + kb0 * 2), vb = (v2u){0u, 0u};
                if (kt1 < 9) vb = *(const LAS v2u*)(lds + AT_VT + d * AT_VSTR + kb1 * 2);
                v4u vw; vw.x = va.x; vw.y = va.y; vw.z = vb.x; vw.w = vb.y;
                o[nt] = __builtin_amdgcn_mfma_f32_16x16x32_bf16(__builtin_bit_cast(bf16x8, vw), pf, o[nt], 0, 0, 0); }
        }
        const float il = 1.0f / l;
        bf16* op = OG + ((size_t)g * T + (size_t)b * SEQ + tq) * DILW + h * 64 + 4 * fq;
#pragma unroll
        for (int nt = 0; nt < 4; ++nt) { v2u ww; ww.x = pk2(o[nt][0] * il, o[nt][1] * il); ww.y = pk2(o[nt][2] * il, o[nt][3] * il); *(v2u*)(op + 16 * nt) = ww; }
        if (fq == 0) LSE[((size_t)g * T + (size_t)b * SEQ + tq) * 8 + h] = mx + logf(l);
    }
}
__device__ __forceinline__ void phase_combine(const Frame& F, const bf16* OG, const float* LSE, bf16* O) {
    for (int it = blockIdx.x * 512 + F.tid; it < T * 64; it += F.G * 512) {
        const int c8 = it & 7, h = (it >> 3) & 7, t = it >> 6;
        const float l0 = LSE[((size_t)0 * T + t) * 8 + h], l1 = LSE[((size_t)1 * T + t) * 8 + h], l2 = LSE[((size_t)2 * T + t) * 8 + h];
        const float m = fmaxf(l0, fmaxf(l1, l2)); float w0 = __expf(l0 - m), w1 = __expf(l1 - m), w2 = __expf(l2 - m); const float inv = 1.0f / (w0 + w1 + w2); w0 *= inv; w1 *= inv; w2 *= inv;
        float a[8], bq[8], c[8], o[8]; const size_t off = (size_t)t * DILW + h * 64 + c8 * 8;
        unpack8(*(const v4u*)(OG + off), a); unpack8(*(const v4u*)(OG + (size_t)T * DILW + off), bq); unpack8(*(const v4u*)(OG + (size_t)2 * T * DILW + off), c);
#pragma unroll
        for (int q = 0; q < 8; ++q) o[q] = w0 * a[q] + w1 * bq[q] + w2 * c[q];
        v4u ww; ww.x = pk2(o[0], o[1]); ww.y = pk2(o[2], o[3]); ww.z = pk2(o[4], o[5]); ww.w = pk2(o[6], o[7]);
        *(v4u*)(O + off) = ww;
    }
}

constexpr int M1_LOG = 131072, M1_STAT = M1_LOG + 4096, M1_HIST = M1_STAT + 128, M1_BASE = M1_HIST + 256;
__device__ __forceinline__ void phase_moe1(const Frame& F, const float* Y, const float* gain, const float* bias, const float* RW, const float* RB,
                                           float* X1F, bf16* X1B, unsigned* cnt, int* ltok, float* lgate, int* eidx, int* inv) {
    LAS float* xs = (LAS float*)F.lds; LAS float* logit = (LAS float*)(F.lds + M1_LOG); LAS float* stat = (LAS float*)(F.lds + M1_STAT);
    LAS int* hist = (LAS int*)(F.lds + M1_HIST); LAS int* basep = (LAS int*)(F.lds + M1_BASE);
    const int tid = F.tid, lane = F.lane, w = F.wave;
    for (int rg = blockIdx.x; rg < T / 16; rg += F.G) {
        const int row0 = rg * 16;
        __syncthreads();
#pragma unroll
        for (int j = 0; j < 16; ++j) { const int idx = tid + 512 * j; *(LAS f32x4*)(xs + idx * 4) = *(const f32x4*)(Y + (size_t)row0 * D + (size_t)idx * 4); }
        if (tid < 64) hist[tid] = 0;
        __syncthreads();
#pragma unroll
        for (int rr = 0; rr < 2; ++rr) { const int r = 2 * w + rr; float sm = 0.f;
#pragma unroll
            for (int j = 0; j < 32; ++j) sm += xs[r * D + lane + 64 * j];
            const float mean = wave_sum(sm) * (1.0f / D); float sq = 0.f;
#pragma unroll
            for (int j = 0; j < 32; ++j) { const float d = xs[r * D + lane + 64 * j] - mean; sq += d * d; }
            const float rstd = 1.0f / sqrtf(wave_sum(sq) * (1.0f / D) + LN_EPS);
            if (lane == 0) { stat[2 * r] = mean; stat[2 * r + 1] = rstd; } }
        __syncthreads();
#pragma unroll
        for (int j = 0; j < 16; ++j) { const int idx = tid + 512 * j, r = idx >> 9, c4 = (idx & 511) * 4;
            const f32x4 v = *(LAS f32x4*)(xs + idx * 4), gv = *(const f32x4*)(gain + c4), bv = *(const f32x4*)(bias + c4);
            const float mean = stat[2 * r], rstd = stat[2 * r + 1];
            const f32x4 o = (v - mean) * rstd * gv + bv;
            *(LAS f32x4*)(xs + idx * 4) = o;
            *(f32x4*)(X1F + (size_t)(row0 + r) * D + c4) = o;
            v2u wb; wb.x = pk2(o[0], o[1]); wb.y = pk2(o[2], o[3]); *(v2u*)(X1B + (size_t)(row0 + r) * D + c4) = wb; }
        __syncthreads();
        { const int r = tid >> 5, ep = tid & 31; float a0 = 0.f, a1 = 0.f; const float* wp = RW + 2 * ep; const LAS float* xr = xs + r * D;
#pragma unroll 8
            for (int k = 0; k < D; ++k) { const f32x2 wv = *(const f32x2*)(wp + (size_t)k * NEXP); const float xv = xr[k]; a0 += xv * wv.x; a1 += xv * wv.y; }
            logit[r * NEXP + 2 * ep] = a0; logit[r * NEXP + 2 * ep + 1] = a1; }
        __syncthreads();
        int sel_pos[2]; float sel_gate[2]; int sel_rank[2]; bool sel_on[2];
#pragma unroll
        for (int rr = 0; rr < 2; ++rr) { const int r = 2 * w + rr;
            const float sc = 1.0f / (1.0f + __expf(-logit[r * NEXP + lane])); const float ch = sc + RB[lane];
            int rk = 0;
#pragma unroll
            for (int j = 0; j < 8; ++j) { const float cj = __shfl(ch, (lane & ~7) + j); rk += (cj > ch || (cj == ch && j < (lane & 7))) ? 1 : 0; }
            float gs = rk < 2 ? ch : 0.f; gs += __shfl_xor(gs, 1); gs += __shfl_xor(gs, 2); gs += __shfl_xor(gs, 4);
            int grk = 0; const int g = lane >> 3;
#pragma unroll
            for (int hh = 0; hh < 8; ++hh) { const float gh = __shfl(gs, 8 * hh); grk += (gh > gs || (gh == gs && hh < g)) ? 1 : 0; }
            const float msk = grk < 4 ? ch : -INFINITY;
            int erk = 0;
            for (int j = 0; j < 64; ++j) { const float mj = __shfl(msk, j); erk += (mj > msk || (mj == msk && j < lane)) ? 1 : 0; }
            const bool on = erk < 8;
            const float ssum = wave_sum(on ? sc : 0.f);
            sel_on[rr] = on; sel_rank[rr] = erk; sel_gate[rr] = sc / ssum * 2.5f; sel_pos[rr] = 0;
            if (on) sel_pos[rr] = __hip_atomic_fetch_add(&hist[lane], 1, __ATOMIC_RELAXED, __HIP_MEMORY_SCOPE_WORKGROUP); }
        __syncthreads();
        if (tid < 64) { const int hc = hist[tid]; int bs = 0; if (hc > 0) bs = (int)atomicAdd(&cnt[tid * 16], (unsigned)hc); basep[tid] = bs; }
        __syncthreads();
#pragma unroll
        for (int rr = 0; rr < 2; ++rr) if (sel_on[rr]) { const int t = row0 + 2 * w + rr, pos = basep[lane] + sel_pos[rr];
            ltok[(size_t)lane * CAP + pos] = t; lgate[(size_t)lane * CAP + pos] = sel_gate[rr];
            eidx[t * 8 + sel_rank[rr]] = lane; inv[t * 8 + sel_rank[rr]] = pos; }
    }
}
__device__ __forceinline__ int build_tiles(const Frame& F, const unsigned* cnt) {
    LAS int* tpref = (LAS int*)(F.lds + LDS_TAB); LAS int* cl = (LAS int*)(F.lds + LDS_TAB + 512);
    __syncthreads();
    if (F.tid < 64) cl[F.tid] = (int)__hip_atomic_load(&cnt[F.tid * 16], __ATOMIC_RELAXED, __HIP_MEMORY_SCOPE_AGENT);
    __syncthreads();
    if (F.tid == 0) { int acc = 0; for (int e = 0; e < 64; ++e) { tpref[e] = acc; acc += (cl[e] + 255) >> 8; } tpref[64] = acc; }
    __syncthreads();
    return __builtin_amdgcn_readfirstlane(tpref[64]);
}
__device__ __forceinline__ void phase_moe4(const Frame& F, const float* Y2, const bf16* Yr, const int* eidx, const int* inv, const float* gain, const float* bias, float* XO, bf16* XBo) {
    const LAS int* tpref = (const LAS int*)(F.lds + LDS_TAB);
    const int gw = blockIdx.x * 8 + F.wave, NGW = F.G * 8, lane = F.lane;
    for (int t = gw; t < T; t += NGW) {
        f32x4 v[8];
#pragma unroll
        for (int j = 0; j < 8; ++j) v[j] = *(const f32x4*)(Y2 + (size_t)t * D + 4 * lane + 256 * j);
        for (int k = 0; k < 8; ++k) { const int e = eidx[t * 8 + k], pos = inv[t * 8 + k]; const bf16* yr = Yr + (size_t)(tpref[e] * 256 + pos) * D + 4 * lane;
#pragma unroll
            for (int j = 0; j < 8; ++j) { const v2u w = *(const v2u*)(yr + 256 * j); v[j][0] += bflo(w.x); v[j][1] += bfhi(w.x); v[j][2] += bflo(w.y); v[j][3] += bfhi(w.y); } }
        float sm = 0.f;
#pragma unroll
        for (int j = 0; j < 8; ++j) sm += (v[j][0] + v[j][1]) + (v[j][2] + v[j][3]);
        const float mean = wave_sum(sm) * (1.0f / D); float sq = 0.f;
#pragma unroll
        for (int j = 0; j < 8; ++j) { v[j] = v[j] - mean; sq += (v[j][0] * v[j][0] + v[j][1] * v[j][1]) + (v[j][2] * v[j][2] + v[j][3] * v[j][3]); }
        const float rstd = 1.0f / sqrtf(wave_sum(sq) * (1.0f / D) + LN_EPS);
#pragma unroll
        for (int j = 0; j < 8; ++j) { const int c = 4 * lane + 256 * j; const f32x4 o = v[j] * rstd * *(const f32x4*)(gain + c) + *(const f32x4*)(bias + c);
            *(f32x4*)(XO + (size_t)t * D + c) = o;
            v2u wb; wb.x = pk2(o[0], o[1]); wb.y = pk2(o[2], o[3]); *(v2u*)(XBo + (size_t)t * D + c) = wb; }
    }
}

enum { PH_PRO = 0, PH_POOL_G1, PH_POOL_P, PH_POOL_G2, PH_POOL_G3, PH_DIL_G1, PH_DIL_ATT, PH_DIL_CMB, PH_DIL_G2, PH_CONV_G1, PH_CONV_E, PH_CONV_G2, PH_MOE1, PH_MOE2, PH_MOE3, PH_MOE4, PH_COUNT };

template <int PH>
__device__ __forceinline__ void run_phase(const Frame& F, const Args& args, const int L) {
    unsigned char* ws = F.ws; LAS unsigned char* ring = F.lds; const int c = (int)blockIdx.x;
    const float* xin = (L == 0) ? args.in[IN_X] : (const float*)(ws + WS_XF);
    const bf16* xb = (const bf16*)(ws + WS_XB);
    float* yf = (float*)(ws + WS_YF);
    unsigned char* big = ws + WS_BIG;
    const int ia = L / 3;
    if constexpr (PH == PH_PRO) { phase_prologue(F, args); }
    if constexpr (PH == PH_POOL_G1) { g8::DenseSched S; S.init(xb, (const bf16*)(ws + WS_W_POOL_IN) + (size_t)ia * D * D, T, D, D, D, F.G, c);
        g8::EpiBf16 E{(bf16*)(big + BG_U), D, 0}; g8::gemm_phase<g8::EpiBf16, g8::DenseSched, false>(ring, D, D, D, S, E); }
    if constexpr (PH == PH_POOL_P) { phase_pool(F, (const bf16*)(big + BG_U), (bf16*)(big + BG_PL)); }
    if constexpr (PH == PH_POOL_G2) { g8::DenseSched S; S.init((const bf16*)(big + BG_PL), (const bf16*)(ws + WS_W_POOL_G) + (size_t)ia * D * 512, T, D, D, 512, F.G, c); S.agrp_shift = 1; S.agrp_stride = 512 * 2;
        g8::EpiScaleBf16 E{(bf16*)(big + BG_MX), D, args.in[IN_PSC] + (size_t)ia * D}; g8::gemm_phase<g8::EpiScaleBf16, g8::DenseSched, false>(ring, 512, D, 512, S, E); }
    if constexpr (PH == PH_POOL_G3) { g8::DenseSched S; S.init((const bf16*)(big + BG_MX), (const bf16*)(ws + WS_W_POOL_OUT) + (size_t)ia * D * D, T, D, D, D, F.G, c);
        g8::EpiResid E{xin, yf}; g8::gemm_phase<g8::EpiResid, g8::DenseSched, false>(ring, D, D, D, S, E); }
    if constexpr (PH == PH_DIL_G1) { g8::DenseSched S; S.init(xb, (const bf16*)(ws + WS_W_DIL_QKV), T, QKVC, D, D, F.G, c);
        g8::EpiBf16 E{(bf16*)(big + BG_QKV), QKVC, 1}; g8::gemm_phase<g8::EpiBf16, g8::DenseSched, false>(ring, D, D, D, S, E); }
    if constexpr (PH == PH_DIL_ATT) { phase_attn(F, (const bf16*)(big + BG_QKV), args.in[IN_RELB], (bf16*)(big + BG_OG), (float*)(big + BG_LSE)); }
    if constexpr (PH == PH_DIL_CMB) { phase_combine(F, (const bf16*)(big + BG_OG), (const float*)(big + BG_LSE), (bf16*)(big + BG_O)); }
    if constexpr (PH == PH_DIL_G2) { g8::DenseSched S; S.init((const bf16*)(big + BG_O), (const bf16*)(ws + WS_W_DIL_OUT), T, D, DILW, DILW, F.G, c);
        g8::EpiResid E{xin, yf}; g8::gemm_phase<g8::EpiResid, g8::DenseSched, false>(ring, DILW, DILW, DILW, S, E); }
    if constexpr (PH == PH_CONV_G1) { g8::DenseSched S; S.init(xb, (const bf16*)(ws + WS_W_CONV_IN), T, 3 * D, D, D, F.G, c);
        g8::EpiConvIn E{(bf16*)(big + BG_UC), (bf16*)(big + BG_BG)}; g8::gemm_phase<g8::EpiConvIn, g8::DenseSched, false>(ring, D, D, D, S, E); }
    if constexpr (PH == PH_CONV_E) { phase_conv(F, (const bf16*)(big + BG_UC), (const bf16*)(big + BG_BG), args.in[IN_CW], (bf16*)(big + BG_Z)); }
    if constexpr (PH == PH_CONV_G2) { g8::DenseSched S; S.init((const bf16*)(big + BG_Z), (const bf16*)(ws + WS_W_CONV_OUT), T, D, D, D, F.G, c);
        g8::EpiResid E{xin, yf}; g8::gemm_phase<g8::EpiResid, g8::DenseSched, false>(ring, D, D, D, S, E); }
    unsigned* cnt = F.ctl + CW_CNT + L * 64 * 16;
    float* x1f = (float*)(ws + WS_X1F); bf16* x1b = (bf16*)(ws + WS_X1B);
    int* ltok = (int*)(ws + WS_LTOK); float* lgate = (float*)(ws + WS_LGATE); int* eidx = (int*)(ws + WS_EIDX); int* inv = (int*)(ws + WS_INV);
    bf16* HB = (bf16*)(ws + WS_HB); bf16* HS = (bf16*)(ws + WS_HS); bf16* Yr = (bf16*)(ws + WS_BIG);
    if constexpr (PH == PH_MOE1) {
        const float* g1 = args.in[IN_LNG] + (size_t)(L * 2 + 0) * D; const float* b1 = args.in[IN_LNB] + (size_t)(L * 2 + 0) * D;
        phase_moe1(F, yf, g1, b1, args.in[IN_RW] + (size_t)L * D * NEXP, args.in[IN_RB] + (size_t)L * NEXP, x1f, x1b, cnt, ltok, lgate, eidx, inv); }
    if constexpr (PH == PH_MOE2) {
        const int NT = build_tiles(F, cnt);
        { g8::ExpertSched<1, true> S; S.tpref = (const LAS int*)(F.lds + LDS_TAB); S.cnt = (const LAS int*)(F.lds + LDS_TAB + 512); S.A = (const char*)x1b; S.B = (const char*)((const bf16*)(ws + WS_W_EX_GU) + (size_t)L * 64 * 256 * D);
          S.tok = ltok; S.b_exp = (size_t)256 * D * 2; S.b_tile = 0; S.a_tile = 0; S.NU = NT; S.G = F.G; S.c = c;
          g8::EpiExpertGU E{HB}; g8::gemm_phase<g8::EpiExpertGU, g8::ExpertSched<1, true>, true>(ring, D, D, D, S, E); }
        { const int rot = (c - (NT % F.G) + F.G) % F.G;
          g8::DenseSched S; S.init(x1b, (const bf16*)(ws + WS_W_SH_GU) + (size_t)L * 512 * D, T, 512, D, D, F.G, rot);
          g8::EpiSharedGU E{HS}; g8::gemm_phase<g8::EpiSharedGU, g8::DenseSched, false>(ring, D, D, D, S, E); } }
    if constexpr (PH == PH_MOE3) {
        const int NT = build_tiles(F, cnt);
        { g8::ExpertSched<8, false> S; S.tpref = (const LAS int*)(F.lds + LDS_TAB); S.cnt = (const LAS int*)(F.lds + LDS_TAB + 512); S.A = (const char*)HB; S.B = (const char*)((const bf16*)(ws + WS_W_EX_D) + (size_t)L * 64 * D * 256);
          S.tok = ltok; S.b_exp = (size_t)D * 256 * 2; S.b_tile = (size_t)256 * 256 * 2; S.a_tile = (size_t)256 * 256 * 2; S.NU = NT * 8; S.G = F.G; S.c = c;
          g8::EpiDownY E{Yr}; g8::gemm_phase<g8::EpiDownY, g8::ExpertSched<8, false>, false>(ring, 256, 256, 256, S, E); }
        { const int rot = (c - ((NT * 8) % F.G) + F.G) % F.G;
          g8::DenseSched S; S.init(HS, (const bf16*)(ws + WS_W_SH_D) + (size_t)L * D * SDIM, T, D, SDIM, SDIM, F.G, rot);
          g8::EpiResid E{x1f, yf}; g8::gemm_phase<g8::EpiResid, g8::DenseSched, false>(ring, SDIM, SDIM, SDIM, S, E); } }
    if constexpr (PH == PH_MOE4) { (void)build_tiles(F, cnt);
        const float* g2 = args.in[IN_LNG] + (size_t)(L * 2 + 1) * D; const float* b2 = args.in[IN_LNB] + (size_t)(L * 2 + 1) * D;
        float* xo = (L == DEPTH - 1) ? args.out : (float*)(ws + WS_XF);
        phase_moe4(F, yf, Yr, eidx, inv, g2, b2, xo, (bf16*)(ws + WS_XB)); }
}
__device__ __forceinline__ void make_frame(Frame& F, const Args& args) {
    extern __shared__ __attribute__((aligned(16))) unsigned char lds_raw[];
    F.lds = (LAS unsigned char*)lds_raw; F.ws = args.ws; F.ctl = (unsigned*)(args.ws + WS_CTL);
    F.tid = threadIdx.x; F.lane = F.tid & 63; F.wave = __builtin_amdgcn_readfirstlane(F.tid >> 6); F.G = gridDim.x;
}
template <int PH> __global__ void __launch_bounds__(512, 2) k_phase(Args args, int L) {
    Frame F; make_frame(F, args);
    run_phase<PH>(F, args, L);
}

template <int PH> static void launch_phase(const Args& a, int L, int grid, hipStream_t stream) {
    static bool attr = false;
    if (!attr) { (void)hipFuncSetAttribute((const void*)k_phase<PH>, hipFuncAttributeMaxDynamicSharedMemorySize, LDS_BYTES); attr = true; }
    hipLaunchKernelGGL(k_phase<PH>, dim3(grid), dim3(512), LDS_BYTES, stream, a, L);
}
extern "C" void kernel_launch(void* const* d_in, const int* in_sizes, int n_in, void* d_out, int out_size, void* d_ws, size_t ws_size, hipStream_t stream) {
    static int grid = 0;
    if (grid == 0) {
        if (n_in != 19 || out_size != T * D || ws_size < WS_END) { fprintf(stderr, "kernel_launch: unexpected shapes (n_in %d out %d ws %zu need %zu)\n", n_in, out_size, ws_size, (size_t)WS_END); grid = -1; return; }
        int dev = 0, cus = 0;
        if (hipGetDevice(&dev) != hipSuccess || hipDeviceGetAttribute(&cus, hipDeviceAttributeMultiprocessorCount, dev) != hipSuccess) { grid = -1; return; }
        grid = cus;
    }
    if (grid < 0) return;
    (void)hipMemsetAsync((char*)d_ws + WS_CTL, 0, CTL_ZERO_BYTES, stream);
    Args a{};
    for (int i = 0; i < 19; ++i) a.in[i] = (const float*)d_in[i];
    a.out = (float*)d_out; a.ws = (unsigned char*)d_ws; a.ph_lo = 0; a.ph_hi = 0;
    launch_phase<PH_PRO>(a, 0, grid, stream);
    for (int L = 0; L < DEPTH; ++L) {
        const int kind = L % 3;
        if (kind == 0) { launch_phase<PH_POOL_G1>(a, L, grid, stream); launch_phase<PH_POOL_P>(a, L, grid, stream); launch_phase<PH_POOL_G2>(a, L, grid, stream); launch_phase<PH_POOL_G3>(a, L, grid, stream); }
        else if (kind == 1) { launch_phase<PH_DIL_G1>(a, L, grid, stream); launch_phase<PH_DIL_ATT>(a, L, grid, stream); launch_phase<PH_DIL_CMB>(a, L, grid, stream); launch_phase<PH_DIL_G2>(a, L, grid, stream); }
        else { launch_phase<PH_CONV_G1>(a, L, grid, stream); launch_phase<PH_CONV_E>(a, L, grid, stream); launch_phase<PH_CONV_G2>(a, L, grid, stream); }
        launch_phase<PH_MOE1>(a, L, grid, stream); launch_phase<PH_MOE2>(a, L, grid, stream); launch_phase<PH_MOE3>(a, L, grid, stream); launch_phase<PH_MOE4>(a, L, grid, stream);
    }
}
```

```cpp
#include <hip/hip_runtime.h>
#include <cstdio>
#include <cstdint>

#ifndef MK_ONE_LAUNCH
#define MK_ONE_LAUNCH 1
#endif

#define GAS __attribute__((address_space(1)))
#define LAS __attribute__((address_space(3)))
typedef unsigned short bf16;
typedef unsigned v4u __attribute__((ext_vector_type(4)));
typedef unsigned v2u __attribute__((ext_vector_type(2)));
typedef float f32x4 __attribute__((ext_vector_type(4)));
typedef float f32x2 __attribute__((ext_vector_type(2)));
typedef short bf16x8 __attribute__((ext_vector_type(8)));
typedef short s16x4 __attribute__((ext_vector_type(4)));

constexpr int NBATCH = 8, SEQ = 2048, D = 2048, T = NBATCH * SEQ, DEPTH = 4;
constexpr int NEXP = 64, TOPK = 8, EDIM = 128, SDIM = 256;
constexpr int QKVC = 4608, DILW = 512;
constexpr float ALPHA = 1.681792830507429f;
constexpr float LN_EPS = 1e-5f;
constexpr int CAP = 16384;
constexpr int HROWS = T * TOPK + NEXP * 256;

constexpr size_t MiB = 1u << 20;
constexpr size_t WS_CTL = 0, CTL_ZERO_BYTES = 1 * MiB;
constexpr size_t WS_W_POOL_IN = 1 * MiB;
constexpr size_t WS_W_POOL_G = WS_W_POOL_IN + 16 * MiB;
constexpr size_t WS_W_POOL_OUT = WS_W_POOL_G + 4 * MiB;
constexpr size_t WS_W_DIL_QKV = WS_W_POOL_OUT + 16 * MiB;
constexpr size_t WS_W_DIL_OUT = WS_W_DIL_QKV + 18 * MiB;
constexpr size_t WS_W_CONV_IN = WS_W_DIL_OUT + 2 * MiB;
constexpr size_t WS_W_CONV_OUT = WS_W_CONV_IN + 24 * MiB;
constexpr size_t WS_W_SH_GU = WS_W_CONV_OUT + 8 * MiB;
constexpr size_t WS_W_SH_D = WS_W_SH_GU + 8 * MiB;
constexpr size_t WS_W_EX_GU = WS_W_SH_D + 4 * MiB;
constexpr size_t WS_W_EX_D = WS_W_EX_GU + 256 * MiB;
constexpr size_t WS_XF = WS_W_EX_D + 256 * MiB;
constexpr size_t WS_YF = WS_XF + 128 * MiB;
constexpr size_t WS_X1F = WS_YF + 128 * MiB;
constexpr size_t WS_XB = WS_X1F + 128 * MiB;
constexpr size_t WS_X1B = WS_XB + 64 * MiB;
constexpr size_t WS_HB = WS_X1B + 64 * MiB;
constexpr size_t WS_HS = WS_HB + 72 * MiB;
constexpr size_t WS_LTOK = WS_HS + 8 * MiB;
constexpr size_t WS_LGATE = WS_LTOK + 4 * MiB;
constexpr size_t WS_EIDX = WS_LGATE + 4 * MiB;
constexpr size_t WS_INV = WS_EIDX + 1 * MiB;
constexpr size_t WS_BIG = WS_INV + 1 * MiB;
constexpr size_t WS_END = WS_BIG + 608 * MiB;
constexpr size_t BG_U = 0, BG_PL = 64 * MiB, BG_MX = 128 * MiB;
constexpr size_t BG_QKV = 0, BG_OG = 144 * MiB, BG_LSE = 192 * MiB, BG_O = 194 * MiB;
constexpr size_t BG_UC = 0, BG_BG = 64 * MiB, BG_Z = 128 * MiB;
constexpr int CW_BAR = 4096;
constexpr int CW_CNT = 16384;

constexpr int RING_BYTES = 131072;
constexpr int LDS_TAB = RING_BYTES;
constexpr int LDS_STASH = RING_BYTES + 1024;
constexpr int LDS_MISC = RING_BYTES + 1024 + 8192;
constexpr int LDS_BYTES = 147456;

__device__ __forceinline__ unsigned cvt_pk_bf16(float lo, float hi) { unsigned r; asm volatile("v_cvt_pk_bf16_f32 %0, %1, %2" : "=v"(r) : "v"(lo), "v"(hi)); return r; }
__device__ __forceinline__ unsigned f2bf(float f) { unsigned u = __builtin_bit_cast(unsigned, f); return (u + 0x7fffu + ((u >> 16) & 1u)) >> 16; }
__device__ __forceinline__ unsigned pk2(float lo, float hi) { return f2bf(lo) | (f2bf(hi) << 16); }
__device__ __forceinline__ float bflo(unsigned w) { return __builtin_bit_cast(float, w << 16); }
__device__ __forceinline__ float bfhi(unsigned w) { return __builtin_bit_cast(float, w & 0xffff0000u); }
__device__ __forceinline__ float shfl_from(float v, int src) { return __builtin_bit_cast(float, __builtin_amdgcn_ds_bpermute(src << 2, __builtin_bit_cast(int, v))); }
__device__ __forceinline__ float shfl_x(float v, int o, int lane) { return shfl_from(v, lane ^ o); }
__device__ __forceinline__ float wave_sum(float v, int lane) {
#pragma unroll
    for (int o = 1; o < 64; o <<= 1) v += shfl_x(v, o, lane);
    return v;
}
#define LDS_WAIT() asm volatile("s_waitcnt lgkmcnt(0)" ::: "memory")
#define VM_WAIT() asm volatile("s_waitcnt vmcnt(0)" ::: "memory")

#define XB_TMO      128
#define XB_XCNT(j)  (256  + 64 * (j))
#define XB_XSUB(j)  (1280 + 64 * (j))
#define XB_XGEN(j)  (2304 + 64 * (j))
#define XB_TOP      3328
#define XB_TOPGEN   3392
#define XCD_BAR_WORDS 3456
#define XB_SPIN_CAP (1u << 18)

__device__ __forceinline__ unsigned xb_ld(unsigned* p)              { return __hip_atomic_load(p, __ATOMIC_RELAXED, __HIP_MEMORY_SCOPE_AGENT); }
__device__ __forceinline__ unsigned xb_add(unsigned* p, unsigned v) { return __hip_atomic_fetch_add(p, v, __ATOMIC_RELAXED, __HIP_MEMORY_SCOPE_AGENT); }
__device__ __forceinline__ unsigned xb_xcc_id() { return (unsigned)__builtin_amdgcn_s_getreg((3 << 11) | 20) & 0xFu; }
#define XB_SPIN(cond, bar) do { unsigned _sp = 0; while (cond) { __builtin_amdgcn_s_sleep(1); \
    if ((++_sp & 255u) == 0u) { if (xb_ld(&(bar)[XB_TMO])) break; if (_sp > XB_SPIN_CAP) { atomicAdd(&(bar)[XB_TMO], 1u); break; } } } } while (0)

struct XcdBarrier {
    unsigned* bar; unsigned x;
    volatile LAS unsigned* st;
};

__device__ __forceinline__ XcdBarrier xcd_barrier_post(unsigned* bar, volatile LAS unsigned* st) {
    XcdBarrier b; b.bar = bar; b.x = xb_xcc_id(); b.st = st;
    if (threadIdx.x == 0) (void)xb_add(&bar[XB_XCNT(b.x)], 1u);
    return b;
}
__device__ __forceinline__ void xcd_barrier_complete(unsigned* bar, unsigned x, unsigned& nloc, unsigned& nx) {
    const unsigned G = gridDim.x * gridDim.y * gridDim.z;
    unsigned sum, cnt, mine, sp = 0u;
    for (;;) {
        sum = 0u; cnt = 0u; mine = 0u;
#pragma unroll
        for (unsigned j = 0; j < 16; ++j) { const unsigned c = xb_ld(&bar[XB_XCNT(j)]); sum += c; cnt += (c > 0u) ? 1u : 0u; mine = (j == x) ? c : mine; }
        if (sum == G) break;
        __builtin_amdgcn_s_sleep(1);
        if ((++sp & 255u) == 0u) { if (xb_ld(&bar[XB_TMO])) break; if (sp > XB_SPIN_CAP) { atomicAdd(&bar[XB_TMO], 1u); break; } }
    }
    nloc = mine > 0u ? mine : 1u; nx = cnt > 0u ? cnt : 1u;
}

__device__ __forceinline__ void xcd_barrier(const XcdBarrier& b) {
    asm volatile("s_waitcnt vmcnt(0)" ::: "memory");
    __syncthreads();
    if (threadIdx.x == 0) {
        unsigned* bar; unsigned bx = b.x; { GAS unsigned* bg = (GAS unsigned*)b.bar; asm volatile("" : "+s"(bg), "+s"(bx)); bar = (unsigned*)bg; }
        __builtin_amdgcn_s_waitcnt(0);
        unsigned nloc = b.st[0], nx = b.st[1];
        if (nloc == 0u) { xcd_barrier_complete(bar, bx, nloc, nx); b.st[0] = nloc; b.st[1] = nx; }
        const unsigned old = xb_add(&bar[XB_XSUB(bx)], 1u);
        const unsigned gen = old / nloc;
        if (old + 1u == (gen + 1u) * nloc) {
            __builtin_amdgcn_fence(__ATOMIC_RELEASE, "agent");
            asm volatile("s_waitcnt vmcnt(0)" ::: "memory");
            const unsigned og = xb_add(&bar[XB_TOP], 1u);
            const unsigned tg = og / nx;
            if (og + 1u == (tg + 1u) * nx) xb_add(&bar[XB_TOPGEN], 1u);
            else XB_SPIN(xb_ld(&bar[XB_TOPGEN]) == tg, bar);
            __builtin_amdgcn_fence(__ATOMIC_ACQUIRE, "agent");
            xb_add(&bar[XB_XGEN(bx)], 1u);
            asm volatile("s_waitcnt vmcnt(0)" ::: "memory");
        } else {
            XB_SPIN(xb_ld(&bar[XB_XGEN(bx)]) == gen, bar);
            __builtin_amdgcn_fence(__ATOMIC_ACQUIRE, "agent");
            asm volatile("s_waitcnt vmcnt(0)" ::: "memory");
        }
    }
    __syncthreads();
}

namespace g8 {
constexpr int BM = 256, BK = 64, HALF = 128, HTB = HALF * BK * 2, STAGE_BYTES = 8 * HTB, NXCD = 8, WGM = 8;
__host__ __device__ __forceinline__ int lds_byte(int r, int c) { const int st = (r >> 4) * 2 + (c >> 5), rr = r & 15, cc = c & 31, ob = rr * 64 + cc * 2; return st * 1024 + (ob ^ (((ob >> 9) & 1) << 5)); }
__host__ __device__ __forceinline__ void stage_rc(int b, int& R, int& C) { const int st = b / 1024, sb = b % 1024, swz = sb ^ (((sb >> 9) & 1) << 5); R = (st >> 1) * 16 + swz / 64; C = (st & 1) * 32 + (swz % 64) / 2; }
__host__ __device__ __forceinline__ int perm32(int rho) { const int n = rho >> 4, i = rho & 15; return 8 * (i >> 2) + 4 * n + (i & 3); }

struct Unit { const char* A; const char* B; const int* rows; int pm, pn, nvalid, aux; };

template <class Epi, class Sched, bool GATHER>
__device__ __forceinline__ void gemm_phase(LAS unsigned char* lds, const int tid_in, const int K, const int lda, const int ldb, const Sched& S, const Epi& E) {
    const int tid = tid_in, wid = __builtin_amdgcn_readfirstlane(tid >> 6), lane = tid & 63, wr = wid >> 2, wc = wid & 3, fr = lane & 15, fq = lane >> 4;
    const int nt = K / BK;
    unsigned voffB[2];
#pragma unroll
    for (int i = 0; i < 2; ++i) { int R_, C_; stage_rc(tid * 16 + i * 8192, R_, C_); const int Rb = Epi::PERM ? ((R_ & ~31) + perm32(R_ & 31)) : R_; voffB[i] = (unsigned)(Rb * ldb + C_) * 2u; }
    LAS v4u* stash = (LAS v4u*)(lds + (LDS_STASH - 0) + tid * 16);
    const size_t kstep = (size_t)(BK * 2);
    const size_t hstepB = (size_t)HALF * ldb * 2;
    const unsigned ldsw = (unsigned)wid * 1024u;
    const int aoff = lds_byte(wr * 64 + fr, fq * 8), boff = lds_byte(wc * 32 + fr, fq * 8);
#define G8_SA(b, h) (((b) * 2 + (h)) * HTB)
#define G8_SB(b, h) ((4 + (b) * 2 + (h)) * HTB)
#define G8_STAGE2(bufoff, gbase, v0, v1) do { \
        __builtin_amdgcn_global_load_lds((const unsigned*)((const char*)(gbase) + (v0)), (LAS unsigned*)(lds + (bufoff) + ldsw), 16, 0, 0); \
        __builtin_amdgcn_global_load_lds((const unsigned*)((const char*)(gbase) + (v1)), (LAS unsigned*)(lds + (bufoff) + ldsw + 8192), 16, 0, 0); } while (0)
#define G8_STAGEB(bufoff, gbase) G8_STAGE2(bufoff, gbase, voffB[0], voffB[1])
#define G8_LDA(dst, b, h) do { _Pragma("unroll") for (int m = 0; m < 4; ++m) _Pragma("unroll") for (int k = 0; k < 2; ++k) dst[m][k] = *(const LAS bf16x8*)(lds + G8_SA(b, h) + aoff + m * 2048 + k * 1024); } while (0)
#define G8_LDB(dst, b, h) do { _Pragma("unroll") for (int n = 0; n < 2; ++n) _Pragma("unroll") for (int k = 0; k < 2; ++k) dst[n][k] = *(const LAS bf16x8*)(lds + G8_SB(b, h) + boff + n * 2048 + k * 1024); } while (0)
#define G8_MMA(ai, bj, At, Bt) do { __builtin_amdgcn_s_setprio(1); _Pragma("unroll") for (int m = 0; m < 4; ++m) _Pragma("unroll") for (int n = 0; n < 2; ++n) _Pragma("unroll") for (int k = 0; k < 2; ++k) \
        acc[ai][bj][m][n] = __builtin_amdgcn_mfma_f32_16x16x32_bf16(Bt[n][k], At[m][k], acc[ai][bj][m][n], 0, 0, 0); __builtin_amdgcn_s_setprio(0); } while (0)
#define G8_WAIT_V(n) asm volatile("s_waitcnt vmcnt(" #n ")" ::: "memory")
#define G8_WAIT_L(n) asm volatile("s_waitcnt lgkmcnt(" #n ")" ::: "memory")
#define G8_BAR __builtin_amdgcn_s_barrier()
#define G8_SCHED __builtin_amdgcn_sched_barrier(0)
#define G8_SETVA(dst, u) do { int _t2 = tid; if (GATHER) asm volatile("" : "+v"(_t2)); _Pragma("unroll") for (int _h = 0; _h < 2; ++_h) _Pragma("unroll") for (int _i = 0; _i < 2; ++_i) { \
        int _R, _C; stage_rc(_t2 * 16 + _i * 8192, _R, _C); \
        const unsigned _rl = (unsigned)(_h * HALF + _R); unsigned _row = _rl; \
        if (GATHER) { _row = 0u; if (_rl < (unsigned)(u).nvalid) _row = (unsigned)(u).rows[_rl]; } \
        dst[_h][_i] = (_row * (unsigned)lda + (unsigned)_C) * 2u; } } while (0)
    Unit cur, nxt; int ui = 0;
    if (!S.next(0, cur)) return;
    f32x4 acc[2][2][4][2];
#pragma unroll
    for (int a = 0; a < 2; ++a)
#pragma unroll
        for (int b = 0; b < 2; ++b)
#pragma unroll
            for (int m = 0; m < 4; ++m)
#pragma unroll
                for (int n = 0; n < 2; ++n) acc[a][b][m][n] = (f32x4){0.f, 0.f, 0.f, 0.f};
    bf16x8 At[4][2], B0[2][2], B1[2][2];
    unsigned vAc[2][2]; unsigned xl00 = 0, xl01 = 0, xl10 = 0, xl11 = 0;
    G8_SETVA(vAc, cur);
    const char* cA = cur.A; const char* cB = cur.B;
    G8_STAGEB(G8_SB(0, 0), cB); G8_STAGEB(G8_SB(0, 1), cB + hstepB); G8_STAGE2(G8_SA(0, 0), cA, vAc[0][0], vAc[0][1]); G8_STAGE2(G8_SA(0, 1), cA, vAc[1][0], vAc[1][1]);
    if (wr == 1) G8_BAR;
    G8_WAIT_V(2); G8_BAR;
    G8_STAGEB(G8_SB(1, 0), cB + kstep); G8_STAGE2(G8_SA(1, 0), cA + kstep, vAc[0][0], vAc[0][1]); G8_STAGEB(G8_SB(1, 1), cB + hstepB + kstep);
    G8_WAIT_V(6); G8_BAR;
    for (;;) {
        const bool has_next = S.next(ui + 1, nxt);
        const char* nA = has_next ? nxt.A : cA; const char* nB = has_next ? nxt.B : cB;
        if (GATHER) { unsigned vAn[2][2]; if (has_next) { G8_SETVA(vAn, nxt); } else {
#pragma unroll
            for (int h = 0; h < 2; ++h)
#pragma unroll
                for (int i = 0; i < 2; ++i) vAn[h][i] = vAc[h][i]; }
            *stash = (v4u){vAn[0][0], vAn[0][1], vAn[1][0], vAn[1][1]}; }
#pragma unroll 1
        for (int t = 0; t < nt; t += 2) {
            const bool last = (t == nt - 2);
            const char* a1 = cA + (size_t)(t + 1) * kstep;
            const char* a2 = last ? nA : cA + (size_t)(t + 2) * kstep; const char* b2 = last ? nB : cB + (size_t)(t + 2) * kstep;
            const char* a3 = a2 + kstep; const char* b3 = b2 + kstep;
            unsigned x00 = vAc[0][0], x01 = vAc[0][1], x10 = vAc[1][0], x11 = vAc[1][1];
            if (GATHER) { if (last) { const v4u sv = *stash; x00 = sv.x; x01 = sv.y; x10 = sv.z; x11 = sv.w; } xl00 = x00; xl01 = x01; xl10 = x10; xl11 = x11; }
            G8_LDB(B0, 0, 0); G8_LDB(B1, 0, 1); G8_SCHED; G8_LDA(At, 0, 0); G8_STAGE2(G8_SA(1, 1), a1, vAc[1][0], vAc[1][1]);
            G8_WAIT_V(8); G8_WAIT_L(0); G8_BAR; G8_MMA(0, 0, At, B0); G8_MMA(0, 1, At, B1); G8_BAR; G8_SCHED;
            G8_LDA(At, 0, 1); G8_STAGEB(G8_SB(0, 0), b2); G8_STAGEB(G8_SB(0, 1), b2 + hstepB); G8_STAGE2(G8_SA(0, 0), a2, x00, x01);
            G8_WAIT_V(8); G8_WAIT_L(0); G8_BAR; G8_MMA(1, 0, At, B0); G8_MMA(1, 1, At, B1); G8_BAR; G8_SCHED;
            G8_LDB(B0, 1, 0); G8_LDB(B1, 1, 1); G8_SCHED; G8_LDA(At, 1, 0); G8_STAGE2(G8_SA(0, 1), a2, x10, x11);
            G8_WAIT_V(8); G8_WAIT_L(0); G8_BAR; G8_MMA(0, 0, At, B0); G8_MMA(0, 1, At, B1); G8_BAR; G8_SCHED;
            G8_LDA(At, 1, 1); G8_STAGEB(G8_SB(1, 0), b3); G8_STAGEB(G8_SB(1, 1), b3 + hstepB); G8_STAGE2(G8_SA(1, 0), a3, x00, x01);
            G8_WAIT_V(8); G8_WAIT_L(0); G8_BAR; G8_MMA(1, 0, At, B0); G8_MMA(1, 1, At, B1); G8_BAR; G8_SCHED;
        }
        if (wr == 0) G8_BAR;
        E(acc, cur, wr, wc, fr, fq);
        if (!has_next) break;
#pragma unroll
        for (int a = 0; a < 2; ++a)
#pragma unroll
            for (int b = 0; b < 2; ++b)
#pragma unroll
                for (int m = 0; m < 4; ++m)
#pragma unroll
                    for (int n = 0; n < 2; ++n) acc[a][b][m][n] = (f32x4){0.f, 0.f, 0.f, 0.f};
        cur = nxt; cA = nA; cB = nB; ++ui;
        if (GATHER) { vAc[0][0] = xl00; vAc[0][1] = xl01; vAc[1][0] = xl10; vAc[1][1] = xl11; }
        if (wr == 1) G8_BAR;
    }
    G8_WAIT_V(0);
    G8_BAR;
#undef G8_SA
#undef G8_SB
#undef G8_STAGE2
#undef G8_STAGEB
#undef G8_LDA
#undef G8_LDB
#undef G8_MMA
#undef G8_WAIT_V
#undef G8_WAIT_L
#undef G8_BAR
#undef G8_SCHED
#undef G8_SETVA
}

struct DenseSched {
    const char* A; const char* B; size_t a_tile, b_tile, agrp_stride; int agrp_shift, nM, nN, nwg, G, c;
    __device__ __forceinline__ void init(const void* A_, const void* B_, int M, int N, int lda, int ldb, int G_, int c_) {
        A = (const char*)A_; B = (const char*)B_; a_tile = (size_t)BM * lda * 2; b_tile = (size_t)BM * ldb * 2; agrp_stride = 0; agrp_shift = 0; nM = M / BM; nN = N / BM; nwg = nM * nN; G = G_; c = c_; }
    __device__ __forceinline__ bool next(int i, Unit& u) const {
        const long L = (long)i * G + c; if (L >= nwg) return false;
        int wgid = (int)L; { const int q = nwg / NXCD, r = nwg % NXCD, xcd = wgid % NXCD, off = wgid / NXCD; wgid = (xcd < r ? xcd * (q + 1) : r * (q + 1) + (xcd - r) * q) + off; }
        const int nig = WGM * nN, gid = wgid / nig, fm = gid * WGM, gsz = (nM - fm) < WGM ? (nM - fm) : WGM;
        u.pm = fm + ((wgid % nig) % gsz); u.pn = (wgid % nig) / gsz;
        u.A = A + (size_t)u.pm * a_tile + (size_t)(u.pn >> agrp_shift) * agrp_stride; u.B = B + (size_t)u.pn * b_tile; u.rows = nullptr; u.nvalid = BM; u.aux = 0; return true;
    }
};
template <int NPN, bool GATHERED>
struct ExpertSched {
    const LAS int* tpref; const LAS int* cnt; const char* A; const char* B; const int* tok; size_t b_exp, b_tile, a_tile; int NU, G, c;
    __device__ __forceinline__ bool next(int i, Unit& u) const {
        const int L = i * G + c; if (L >= NU) return false;
        const int tile = L / NPN, pn = L % NPN;
        int e = 0; while (__builtin_amdgcn_readfirstlane(tpref[e + 1]) <= tile) ++e;
        const int rb = tile - __builtin_amdgcn_readfirstlane(tpref[e]);
        u.pm = e; u.pn = pn; u.aux = tile * BM; u.nvalid = __builtin_amdgcn_readfirstlane(cnt[e]) - rb * BM; if (u.nvalid > BM) u.nvalid = BM;
        u.rows = tok + (size_t)e * CAP + rb * BM;
        u.A = GATHERED ? A : A + (size_t)tile * a_tile; u.B = B + (size_t)e * b_exp + (size_t)pn * b_tile; return true;
    }
};

struct EpiBf16 {
    static constexpr bool PERM = true;
    bf16* O; int ldc; int qscale;
    __device__ __forceinline__ void operator()(const f32x4 (&acc)[2][2][4][2], const Unit& u, int wr, int wc, int fr, int fq) const {
        asm volatile("" : "+v"(fr), "+v"(fq));
        const int row0 = u.pm * BM + wr * 64 + fr, col0 = u.pn * BM + wc * 32 + 8 * fq;
        const float sc = (qscale && (u.pn % 6) < 2) ? 0.125f : 1.0f;
#pragma unroll
        for (int ai = 0; ai < 2; ++ai)
#pragma unroll
            for (int m = 0; m < 4; ++m) { bf16* rowp = O + (size_t)(row0 + ai * HALF + m * 16) * ldc + col0;
#pragma unroll
                for (int bj = 0; bj < 2; ++bj) { const f32x4 v0 = acc[ai][bj][m][0] * sc, v1 = acc[ai][bj][m][1] * sc;
                    v4u w; w.x = cvt_pk_bf16(v0[0], v0[1]); w.y = cvt_pk_bf16(v0[2], v0[3]); w.z = cvt_pk_bf16(v1[0], v1[1]); w.w = cvt_pk_bf16(v1[2], v1[3]);
                    *(v4u*)(rowp + bj * HALF) = w; } }
    }
};
struct EpiScaleBf16 {
    static constexpr bool PERM = true;
    bf16* O; int ldc; const float* scale;
    __device__ __forceinline__ void operator()(const f32x4 (&acc)[2][2][4][2], const Unit& u, int wr, int wc, int fr, int fq) const {
        asm volatile("" : "+v"(fr), "+v"(fq));
        const int row0 = u.pm * BM + wr * 64 + fr, col0 = u.pn * BM + wc * 32 + 8 * fq;
        f32x4 sv[2][2];
#pragma unroll
        for (int bj = 0; bj < 2; ++bj)
#pragma unroll
            for (int n = 0; n < 2; ++n) sv[bj][n] = *(const f32x4*)(scale + col0 + bj * HALF + 4 * n);
#pragma unroll
        for (int ai = 0; ai < 2; ++ai)
#pragma unroll
            for (int m = 0; m < 4; ++m) { bf16* rowp = O + (size_t)(row0 + ai * HALF + m * 16) * ldc + col0;
#pragma unroll
                for (int bj = 0; bj < 2; ++bj) { const f32x4 v0 = acc[ai][bj][m][0] * sv[bj][0], v1 = acc[ai][bj][m][1] * sv[bj][1];
                    v4u w; w.x = cvt_pk_bf16(v0[0], v0[1]); w.y = cvt_pk_bf16(v0[2], v0[3]); w.z = cvt_pk_bf16(v1[0], v1[1]); w.w = cvt_pk_bf16(v1[2], v1[3]);
                    *(v4u*)(rowp + bj * HALF) = w; } }
    }
};
struct EpiResid {
    static constexpr bool PERM = false;
    const float* X; float* Y;
    __device__ __forceinline__ void operator()(const f32x4 (&acc)[2][2][4][2], const Unit& u, int wr, int wc, int fr, int fq) const {
        asm volatile("" : "+v"(fr), "+v"(fq));
        const int row0 = u.pm * BM + wr * 64 + fr, col0 = u.pn * BM + wc * 32 + 4 * fq;
#pragma unroll
        for (int ai = 0; ai < 2; ++ai)
#pragma unroll
            for (int m = 0; m < 4; ++m) { const size_t off = (size_t)(row0 + ai * HALF + m * 16) * D + col0;
#pragma unroll
                for (int bj = 0; bj < 2; ++bj)
#pragma unroll
                    for (int n = 0; n < 2; ++n) { const f32x4 xv = *(const f32x4*)(X + off + bj * HALF + n * 16); *(f32x4*)(Y + off + bj * HALF + n * 16) = xv * ALPHA + acc[ai][bj][m][n]; } }
    }
};
struct EpiConvIn {
    static constexpr bool PERM = true;
    bf16* UC; bf16* BGp;
    __device__ __forceinline__ void operator()(const f32x4 (&acc)[2][2][4][2], const Unit& u, int wr, int wc, int fr, int fq) const {
        asm volatile("" : "+v"(fr), "+v"(fq));
        const int row0 = u.pm * BM + wr * 64 + fr, cw = wc * 32 + 8 * fq;
        if (u.pn < 16) {
#pragma unroll
            for (int ai = 0; ai < 2; ++ai)
#pragma unroll
                for (int m = 0; m < 4; ++m) { bf16* rowp = UC + (size_t)(row0 + ai * HALF + m * 16) * D + u.pn * HALF + cw;
                    const f32x4 v0 = acc[ai][0][m][0] * acc[ai][1][m][0], v1 = acc[ai][0][m][1] * acc[ai][1][m][1];
                    v4u w; w.x = cvt_pk_bf16(v0[0], v0[1]); w.y = cvt_pk_bf16(v0[2], v0[3]); w.z = cvt_pk_bf16(v1[0], v1[1]); w.w = cvt_pk_bf16(v1[2], v1[3]);
                    *(v4u*)rowp = w; }
        } else {
#pragma unroll
            for (int ai = 0; ai < 2; ++ai)
#pragma unroll
                for (int m = 0; m < 4; ++m) { bf16* rowp = BGp + (size_t)(row0 + ai * HALF + m * 16) * D + (u.pn - 16) * BM + cw;
#pragma unroll
                    for (int bj = 0; bj < 2; ++bj) { const f32x4 v0 = acc[ai][bj][m][0], v1 = acc[ai][bj][m][1];
                        v4u w; w.x = cvt_pk_bf16(v0[0], v0[1]); w.y = cvt_pk_bf16(v0[2], v0[3]); w.z = cvt_pk_bf16(v1[0], v1[1]); w.w = cvt_pk_bf16(v1[2], v1[3]);
                        *(v4u*)(rowp + bj * HALF) = w; } }
        }
    }
};
__device__ __forceinline__ f32x4 silu_mul(f32x4 g, f32x4 uu) {
    f32x4 r;
#pragma unroll
    for (int j = 0; j < 4; ++j) r[j] = g[j] * __builtin_amdgcn_rcpf(1.0f + __expf(-g[j])) * uu[j];
    return r;
}
struct EpiExpertGU {
    static constexpr bool PERM = true;
    bf16* H;
    __device__ __forceinline__ void operator()(const f32x4 (&acc)[2][2][4][2], const Unit& u, int wr, int wc, int fr, int fq) const {
        asm volatile("" : "+v"(fr), "+v"(fq));
        const float* gates = (const float*)((const char*)u.rows + (WS_LGATE - WS_LTOK));
        const int cw = wc * 32 + 8 * fq;
#pragma unroll
        for (int ai = 0; ai < 2; ++ai)
#pragma unroll
            for (int m = 0; m < 4; ++m) { const int r = ai * HALF + wr * 64 + m * 16 + fr;
                if (r < u.nvalid) { const float gt = gates[r];
                    const f32x4 v0 = silu_mul(acc[ai][0][m][0], acc[ai][1][m][0]) * gt, v1 = silu_mul(acc[ai][0][m][1], acc[ai][1][m][1]) * gt;
                    v4u w; w.x = cvt_pk_bf16(v0[0], v0[1]); w.y = cvt_pk_bf16(v0[2], v0[3]); w.z = cvt_pk_bf16(v1[0], v1[1]); w.w = cvt_pk_bf16(v1[2], v1[3]);
                    bf16* rowp = H + (size_t)(u.aux + r) * 256 + cw;
                    *(v4u*)rowp = w; *(v4u*)(rowp + 128) = (v4u){0u, 0u, 0u, 0u}; } }
    }
};
struct EpiSharedGU {
    static constexpr bool PERM = true;
    bf16* HS;
    __device__ __forceinline__ void operator()(const f32x4 (&acc)[2][2][4][2], const Unit& u, int wr, int wc, int fr, int fq) const {
        asm volatile("" : "+v"(fr), "+v"(fq));
        const int row0 = u.pm * BM + wr * 64 + fr, cw = u.pn * HALF + wc * 32 + 8 * fq;
#pragma unroll
        for (int ai = 0; ai < 2; ++ai)
#pragma unroll
            for (int m = 0; m < 4; ++m) {
                const f32x4 v0 = silu_mul(acc[ai][0][m][0], acc[ai][1][m][0]), v1 = silu_mul(acc[ai][0][m][1], acc[ai][1][m][1]);
                v4u w; w.x = cvt_pk_bf16(v0[0], v0[1]); w.y = cvt_pk_bf16(v0[2], v0[3]); w.z = cvt_pk_bf16(v1[0], v1[1]); w.w = cvt_pk_bf16(v1[2], v1[3]);
                *(v4u*)(HS + (size_t)(row0 + ai * HALF + m * 16) * SDIM + cw) = w; }
    }
};
struct EpiDownY {
    static constexpr bool PERM = true;
    bf16* Y;
    __device__ __forceinline__ void operator()(const f32x4 (&acc)[2][2][4][2], const Unit& u, int wr, int wc, int fr, int fq) const {
        asm volatile("" : "+v"(fr), "+v"(fq));
        const int col0 = u.pn * BM + wc * 32 + 8 * fq;
#pragma unroll
        for (int ai = 0; ai < 2; ++ai)
#pragma unroll
            for (int m = 0; m < 4; ++m) { const int r = ai * HALF + wr * 64 + m * 16 + fr; bf16* rowp = Y + (size_t)(u.aux + r) * D + col0;
#pragma unroll
                for (int bj = 0; bj < 2; ++bj) { const f32x4 v0 = acc[ai][bj][m][0], v1 = acc[ai][bj][m][1];
                    v4u w; w.x = cvt_pk_bf16(v0[0], v0[1]); w.y = cvt_pk_bf16(v0[2], v0[3]); w.z = cvt_pk_bf16(v1[0], v1[1]); w.w = cvt_pk_bf16(v1[2], v1[3]);
                    *(v4u*)(rowp + bj * HALF) = w; } }
    }
};
}

struct Args { const float* in[19]; float* out; unsigned char* ws; int ph_lo, ph_hi; };
struct Frame {
    LAS unsigned char* lds; unsigned* ctl; unsigned char* ws;
    int tid, lane, wave, G, bid;
};
enum { IN_X = 0, IN_RELB, IN_PWIN, IN_PWG, IN_PSC, IN_PWOUT, IN_DQKV, IN_DOUT, IN_CWIN, IN_CW, IN_CWOUT, IN_LNG, IN_LNB, IN_RW, IN_RB, IN_EGU, IN_ED, IN_SGU, IN_SD };

#define CAS __attribute__((address_space(4)))
typedef const CAS unsigned char* KP;
__device__ __forceinline__ const float* ain(KP kp, int i) { return (const float*)((const GAS float* const CAS*)kp)[i]; }
__device__ __forceinline__ float* aout(KP kp) { return (float*)((GAS float* const CAS*)kp)[19]; }
__device__ __forceinline__ void tr_item(const float* W, int K, int N, bf16* WT, int dstK, int mode, LAS float* scr, int item, int lane) {
    const int nblk = N / 32, kb = item / nblk, nb = item % nblk, k0 = 64 * kb, n0 = 32 * nb;
    int r0 = n0;
    if (mode == 1) { const int part = n0 / 2048, j = n0 % 2048; r0 = (part == 0) ? 4096 + j : 256 * (j / 128) + (part == 2 ? 128 : 0) + (j % 128); }
    if (mode == 2) { const int part = n0 / 256, j = n0 % 256; r0 = 256 * (j / 128) + 128 * part + (j % 128); }
#pragma unroll 8
    for (int i = 0; i < 32; ++i) { const int kk = 2 * i + (lane >> 5); scr[kk * 33 + (lane & 31)] = W[(size_t)(k0 + kk) * N + n0 + (lane & 31)]; }
    LDS_WAIT(); asm volatile("" ::: "memory");
    const int c = lane & 7;
#pragma unroll
    for (int j = 0; j < 4; ++j) { const int n = (lane >> 3) + 8 * j; const LAS float* s = scr + (8 * c) * 33 + n;
        v4u o; o.x = pk2(s[0 * 33], s[1 * 33]); o.y = pk2(s[2 * 33], s[3 * 33]); o.z = pk2(s[4 * 33], s[5 * 33]); o.w = pk2(s[6 * 33], s[7 * 33]);
        *(v4u*)(WT + (size_t)(r0 + n) * dstK + k0 + 8 * c) = o; }
    LDS_WAIT(); asm volatile("" ::: "memory");
}
__device__ __forceinline__ void phase_prologue(const Frame& F, KP kp) {
    LAS float* scr = (LAS float*)(F.lds + F.wave * 16384);
    const int gw = F.bid * 8 + F.wave, NGW = F.G * 8;
    constexpr int I0 = 2 * 2048, I1 = 8 * 128, I2 = 2 * 2048, I3 = 4608, I4 = 512, I5 = 6144, I6 = 2048, I7 = 4 * 512, I8 = 4 * 256, I9 = 256 * 256, I10 = 256 * 128;
    constexpr int NITEMS = I0 + I1 + I2 + I3 + I4 + I5 + I6 + I7 + I8 + I9 + I10;
    unsigned char* ws = F.ws;
    for (int it = gw; it < NITEMS; it += NGW) {
        int r = it;
        if (r < I0) { const int b = r / 2048; tr_item(ain(kp, IN_PWIN) + (size_t)b * D * D, D, D, (bf16*)(ws + WS_W_POOL_IN) + (size_t)b * D * D, D, 0, scr, r % 2048, F.lane); continue; } r -= I0;
        if (r < I1) { const int b = r / 128; tr_item(ain(kp, IN_PWG) + (size_t)b * 512 * 512, 512, 512, (bf16*)(ws + WS_W_POOL_G) + (size_t)b * 512 * 512, 512, 0, scr, r % 128, F.lane); continue; } r -= I1;
        if (r < I2) { const int b = r / 2048; tr_item(ain(kp, IN_PWOUT) + (size_t)b * D * D, D, D, (bf16*)(ws + WS_W_POOL_OUT) + (size_t)b * D * D, D, 0, scr, r % 2048, F.lane); continue; } r -= I2;
        if (r < I3) { tr_item(ain(kp, IN_DQKV), D, QKVC, (bf16*)(ws + WS_W_DIL_QKV), D, 0, scr, r, F.lane); continue; } r -= I3;
        if (r < I4) { tr_item(ain(kp, IN_DOUT), DILW, D, (bf16*)(ws + WS_W_DIL_OUT), DILW, 0, scr, r, F.lane); continue; } r -= I4;
        if (r < I5) { tr_item(ain(kp, IN_CWIN), D, 3 * D, (bf16*)(ws + WS_W_CONV_IN), D, 1, scr, r, F.lane); continue; } r -= I5;
        if (r < I6) { tr_item(ain(kp, IN_CWOUT), D, D, (bf16*)(ws + WS_W_CONV_OUT), D, 0, scr, r, F.lane); continue; } r -= I6;
        if (r < I7) { const int b = r / 512; tr_item(ain(kp, IN_SGU) + (size_t)b * D * 512, D, 512, (bf16*)(ws + WS_W_SH_GU) + (size_t)b * 512 * D, D, 2, scr, r % 512, F.lane); continue; } r -= I7;
        if (r < I8) { const int b = r / 256; tr_item(ain(kp, IN_SD) + (size_t)b * SDIM * D, SDIM, D, (bf16*)(ws + WS_W_SH_D) + (size_t)b * D * SDIM, SDIM, 0, scr, r % 256, F.lane); continue; } r -= I8;
        if (r < I9) { const int b = r / 256; tr_item(ain(kp, IN_EGU) + (size_t)b * D * 256, D, 256, (bf16*)(ws + WS_W_EX_GU) + (size_t)b * 256 * D, D, 0, scr, r % 256, F.lane); continue; } r -= I9;
        { const int b = r / 128; tr_item(ain(kp, IN_ED) + (size_t)b * EDIM * D, EDIM, D, (bf16*)(ws + WS_W_EX_D) + (size_t)b * D * 256, 256, 0, scr, r % 128, F.lane); }
    }
    const size_t gt = (size_t)F.bid * 512 + F.tid, GT = (size_t)F.G * 512;
    for (size_t i = gt; i < (size_t)256 * 2048 * 16; i += GT) { const size_t row = i >> 4, ch = i & 15; *(v4u*)((bf16*)(ws + WS_W_EX_D) + row * 256 + 128 + ch * 8) = (v4u){0u, 0u, 0u, 0u}; }
    const float* x = ain(kp, IN_X); bf16* xb = (bf16*)(ws + WS_XB);
    for (size_t i = gt; i < (size_t)T * D / 8; i += GT) { const f32x4 p = *(const f32x4*)(x + i * 8), q = *(const f32x4*)(x + i * 8 + 4);
        v4u w; w.x = pk2(p[0], p[1]); w.y = pk2(p[2], p[3]); w.z = pk2(q[0], q[1]); w.w = pk2(q[2], q[3]); *(v4u*)(xb + i * 8) = w; }
}

__device__ __forceinline__ void unpack8(const v4u w, float (&f)[8]) { f[0] = bflo(w.x); f[1] = bfhi(w.x); f[2] = bflo(w.y); f[3] = bfhi(w.y); f[4] = bflo(w.z); f[5] = bfhi(w.z); f[6] = bflo(w.w); f[7] = bfhi(w.w); }
__device__ __forceinline__ void phase_pool(const Frame& F, const bf16* U, bf16* PL) {
    for (int it = F.bid * 512 + F.tid; it < (T / 32) * 256; it += F.G * 512) {
        const int cv = it & 255, ch = it >> 8, col = cv * 8, w = 2 << (col >> 9);
        const int row0 = ch * 32, pos0 = row0 & (SEQ - 1);
        float s[8], uu[8];
#pragma unroll
        for (int j = 0; j < 8; ++j) s[j] = 0.f;
        for (int j = 1; j < w; ++j) if (pos0 - j >= 0) { unpack8(*(const v4u*)(U + (size_t)(row0 - j) * D + col), uu);
#pragma unroll
            for (int q = 0; q < 8; ++q) s[q] += uu[q]; }
        for (int r = 0; r < 32; ++r) {
            const int t = row0 + r, pos = pos0 + r;
            unpack8(*(const v4u*)(U + (size_t)t * D + col), uu);
            const float inv = 1.0f / (float)((pos + 1) < w ? (pos + 1) : w);
            float o[8];
#pragma unroll
            for (int q = 0; q < 8; ++q) { s[q] += uu[q]; o[q] = s[q] * inv - uu[q]; }
            v4u ww; ww.x = pk2(o[0], o[1]); ww.y = pk2(o[2], o[3]); ww.z = pk2(o[4], o[5]); ww.w = pk2(o[6], o[7]);
            *(v4u*)(PL + (size_t)t * D + col) = ww;
            if (pos - w + 1 >= 0) { unpack8(*(const v4u*)(U + (size_t)(t - w + 1) * D + col), uu);
#pragma unroll
                for (int q = 0; q < 8; ++q) s[q] -= uu[q]; }
        }
    }
}

__device__ __forceinline__ void phase_conv(const Frame& F, const bf16* UC, const bf16* BGp, const float* cw, bf16* Z) {
    for (int it = F.bid * 512 + F.tid; it < T * 256; it += F.G * 512) {
        const int cv = it & 255, t = it >> 8, col = cv * 8, pos = t & (SEQ - 1);
        float u0[8], u1[8], u2[8], bb[8], o[8];
        unpack8(*(const v4u*)(UC + (size_t)t * D + col), u2);
        if (pos >= 1) unpack8(*(const v4u*)(UC + (size_t)(t - 1) * D + col), u1); else {
#pragma unroll
            for (int q = 0; q < 8; ++q) u1[q] = 0.f; }
        if (pos >= 2) unpack8(*(const v4u*)(UC + (size_t)(t - 2) * D + col), u0); else {
#pragma unroll
            for (int q = 0; q < 8; ++q) u0[q] = 0.f; }
        unpack8(*(const v4u*)(BGp + (size_t)t * D + col), bb);
#pragma unroll
        for (int q = 0; q < 8; ++q) o[q] = bb[q] * (cw[col + q] * u0[q] + cw[D + col + q] * u1[q] + cw[2 * D + col + q] * u2[q]);
        v4u ww; ww.x = pk2(o[0], o[1]); ww.y = pk2(o[2], o[3]); ww.z = pk2(o[4], o[5]); ww.w = pk2(o[6], o[7]);
        *(v4u*)(Z + (size_t)t * D + col) = ww;
    }
}

__device__ __forceinline__ int t5_bucket(int dist) {
    if (dist < 16) return dist;
    int large = 16 + (int)(logf((float)dist / 16.0f) / logf(128.0f) * 16.0f);
    return large < 31 ? large : 31;
}
constexpr int AT_KS = 0, AT_KSTR = 144, AT_VT = 256 * 144, AT_VSTR = 520, AT_BIAS = AT_VT + 64 * 520;
__device__ __forceinline__ void phase_attn(const Frame& F, const bf16* QKV, const float* relb, bf16* OG, float* LSE) {
    LAS unsigned char* lds = F.lds;
    const int tid = F.tid, lane = F.lane, w = tid >> 6, fr = lane & 15, fq = lane >> 4;
    for (int unit = F.bid; unit < NBATCH * 3 * 8 * 16; unit += F.G) {
        const int cmb = unit & 15, h = (unit >> 4) & 7, g = (unit >> 7) % 3, b = unit / 384;
        const int dsh = 2 * g, dil = 1 << dsh, r = cmb & (dil - 1), nb = cmb >> dsh;
        const bf16* base = QKV + (size_t)b * SEQ * QKVC + g * 1536 + h * 64;
        __syncthreads();
        {
            const int key = tid >> 1, half = tid & 1, jk = (nb - 1) * 128 + key;
            v4u kv[4], vv[4];
            if (jk >= 0) { const bf16* rp = base + (size_t)(jk * dil + r) * QKVC + half * 32;
#pragma unroll
                for (int i = 0; i < 4; ++i) { kv[i] = *(const v4u*)(rp + 512 + 8 * i); vv[i] = *(const v4u*)(rp + 1024 + 8 * i); } }
            else {
#pragma unroll
                for (int i = 0; i < 4; ++i) { kv[i] = (v4u){0u, 0u, 0u, 0u}; vv[i] = (v4u){0u, 0u, 0u, 0u}; } }
#pragma unroll
            for (int i = 0; i < 4; ++i) *(LAS v4u*)(lds + AT_KS + key * AT_KSTR + half * 64 + 16 * i) = kv[i];
#pragma unroll
            for (int i = 0; i < 4; ++i) {
                const unsigned ww[4] = {vv[i].x, vv[i].y, vv[i].z, vv[i].w};
#pragma unroll
                for (int q = 0; q < 4; ++q) { const int d = half * 32 + 8 * i + 2 * q;
                    *(LAS unsigned short*)(lds + AT_VT + d * AT_VSTR + key * 2) = (unsigned short)(ww[q] & 0xffffu);
                    *(LAS unsigned short*)(lds + AT_VT + (d + 1) * AT_VSTR + key * 2) = (unsigned short)(ww[q] >> 16); } }
            if (tid <= 128) ((LAS float*)(lds + AT_BIAS))[tid] = relb[t5_bucket(tid * dil) * 24 + g * 8 + h];
        }
        __syncthreads();
        int qi = 16 * w + fr; asm volatile("" : "+v"(qi));
        const int jq = nb * 128 + qi, tq = jq * dil + r;
        const bf16* qp = base + (size_t)tq * QKVC + 8 * fq;
        const bf16x8 q0 = *(const bf16x8*)qp, q1 = *(const bf16x8*)(qp + 32);
        f32x4 s[9]; float mx = -INFINITY;
#pragma unroll
        for (int kt = 0; kt < 9; ++kt) {
            const int kb = 16 * (w + kt);
            const bf16x8 k0 = *(const LAS bf16x8*)(lds + AT_KS + (kb + fr) * AT_KSTR + fq * 16), k1 = *(const LAS bf16x8*)(lds + AT_KS + (kb + fr) * AT_KSTR + 64 + fq * 16);
            f32x4 a = (f32x4){0.f, 0.f, 0.f, 0.f};
            a = __builtin_amdgcn_mfma_f32_16x16x32_bf16(k0, q0, a, 0, 0, 0);
            a = __builtin_amdgcn_mfma_f32_16x16x32_bf16(k1, q1, a, 0, 0, 0);
#pragma unroll
            for (int i = 0; i < 4; ++i) { const int kl = kb + 4 * fq + i, rel = qi + 128 - kl;
                const bool ok = (rel >= 0) && (rel <= 128) && (nb > 0 || kl >= 128);
                const int rc = rel < 0 ? 0 : (rel > 128 ? 128 : rel);
                const float v = ok ? a[i] + ((LAS float*)(lds + AT_BIAS))[rc] : -INFINITY;
                a[i] = v; mx = fmaxf(mx, v); }
            s[kt] = a;
        }
        mx = fmaxf(mx, shfl_x(mx, 16, lane)); mx = fmaxf(mx, shfl_x(mx, 32, lane));
        float l = 0.f;
#pragma unroll
        for (int kt = 0; kt < 9; ++kt)
#pragma unroll
            for (int i = 0; i < 4; ++i) { const float p = __expf(s[kt][i] - mx); s[kt][i] = p; l += p; }
        l += shfl_x(l, 16, lane); l += shfl_x(l, 32, lane);
        f32x4 o[4];
#pragma unroll
        for (int nt = 0; nt < 4; ++nt) o[nt] = (f32x4){0.f, 0.f, 0.f, 0.f};
#pragma unroll
        for (int st = 0; st < 5; ++st) {
            const int kt0 = 2 * st, kt1 = 2 * st + 1;
            v4u pw; pw.x = pk2(s[kt0][0], s[kt0][1]); pw.y = pk2(s[kt0][2], s[kt0][3]);
            if (kt1 < 9) { pw.z = pk2(s[kt1 < 9 ? kt1 : 0][0], s[kt1 < 9 ? kt1 : 0][1]); pw.w = pk2(s[kt1 < 9 ? kt1 : 0][2], s[kt1 < 9 ? kt1 : 0][3]); } else { pw.z = 0u; pw.w = 0u; }
            const bf16x8 pf = __builtin_bit_cast(bf16x8, pw);
            const int kb0 = 16 * (w + kt0) + 4 * fq, kb1 = 16 * (w + kt1) + 4 * fq;
#pragma unroll
            for (int nt = 0; nt < 4; ++nt) { const int d = 16 * nt + fr;
                v2u va = *(const LAS v2u*)(lds + AT_VT + d * AT_VSTR + kb0 * 2), vb = (v2u){0u, 0u};
                if (kt1 < 9) vb = *(const LAS v2u*)(lds + AT_VT + d * AT_VSTR + kb1 * 2);
                v4u vw; vw.x = va.x; vw.y = va.y; vw.z = vb.x; vw.w = vb.y;
                o[nt] = __builtin_amdgcn_mfma_f32_16x16x32_bf16(__builtin_bit_cast(bf16x8, vw), pf, o[nt], 0, 0, 0); }
        }
        const float il = 1.0f / l;
        bf16* op = OG + ((size_t)g * T + (size_t)b * SEQ + tq) * DILW + h * 64 + 4 * fq;
#pragma unroll
        for (int nt = 0; nt < 4; ++nt) { v2u ww; ww.x = pk2(o[nt][0] * il, o[nt][1] * il); ww.y = pk2(o[nt][2] * il, o[nt][3] * il); *(v2u*)(op + 16 * nt) = ww; }
        if (fq == 0) LSE[((size_t)g * T + (size_t)b * SEQ + tq) * 8 + h] = mx + logf(l);
    }
}
__device__ __forceinline__ void phase_combine(const Frame& F, const bf16* OG, const float* LSE, bf16* O) {
    for (int it = F.bid * 512 + F.tid; it < T * 64; it += F.G * 512) {
        const int c8 = it & 7, h = (it >> 3) & 7, t = it >> 6;
        const float l0 = LSE[((size_t)0 * T + t) * 8 + h], l1 = LSE[((size_t)1 * T + t) * 8 + h], l2 = LSE[((size_t)2 * T + t) * 8 + h];
        const float m = fmaxf(l0, fmaxf(l1, l2)); float w0 = __expf(l0 - m), w1 = __expf(l1 - m), w2 = __expf(l2 - m); const float inv = 1.0f / (w0 + w1 + w2); w0 *= inv; w1 *= inv; w2 *= inv;
        float a[8], bq[8], c[8], o[8]; const size_t off = (size_t)t * DILW + h * 64 + c8 * 8;
        unpack8(*(const v4u*)(OG + off), a); unpack8(*(const v4u*)(OG + (size_t)T * DILW + off), bq); unpack8(*(const v4u*)(OG + (size_t)2 * T * DILW + off), c);
#pragma unroll
        for (int q = 0; q < 8; ++q) o[q] = w0 * a[q] + w1 * bq[q] + w2 * c[q];
        v4u ww; ww.x = pk2(o[0], o[1]); ww.y = pk2(o[2], o[3]); ww.z = pk2(o[4], o[5]); ww.w = pk2(o[6], o[7]);
        *(v4u*)(O + off) = ww;
    }
}

constexpr int M1_LOG = 131072, M1_STAT = M1_LOG + 4096, M1_HIST = M1_STAT + 128, M1_BASE = M1_HIST + 256;
__device__ __forceinline__ void phase_moe1(const Frame& F, const float* Y, const float* gain, const float* bias, const float* RW, const float* RB,
                                           float* X1F, bf16* X1B, unsigned* cnt, int* ltok, float* lgate, int* eidx, int* inv) {
    LAS float* xs = (LAS float*)F.lds; LAS float* logit = (LAS float*)(F.lds + M1_LOG); LAS float* stat = (LAS float*)(F.lds + M1_STAT);
    LAS int* hist = (LAS int*)(F.lds + M1_HIST); LAS int* basep = (LAS int*)(F.lds + M1_BASE);
    const int tid = F.tid, lane = F.lane, w = F.wave;
    for (int rg = F.bid; rg < T / 16; rg += F.G) {
        const int row0 = rg * 16;
        __syncthreads();
#pragma unroll
        for (int j = 0; j < 16; ++j) { const int idx = tid + 512 * j; *(LAS f32x4*)(xs + idx * 4) = *(const f32x4*)(Y + (size_t)row0 * D + (size_t)idx * 4); }
        if (tid < 64) hist[tid] = 0;
        __syncthreads();
#pragma unroll
        for (int rr = 0; rr < 2; ++rr) { const int r = 2 * w + rr; float sm = 0.f;
#pragma unroll
            for (int j = 0; j < 32; ++j) sm += xs[r * D + lane + 64 * j];
            const float mean = wave_sum(sm, lane) * (1.0f / D); float sq = 0.f;
#pragma unroll
            for (int j = 0; j < 32; ++j) { const float d = xs[r * D + lane + 64 * j] - mean; sq += d * d; }
            const float rstd = 1.0f / sqrtf(wave_sum(sq, lane) * (1.0f / D) + LN_EPS);
            if (lane == 0) { stat[2 * r] = mean; stat[2 * r + 1] = rstd; } }
        __syncthreads();
#pragma unroll
        for (int j = 0; j < 16; ++j) { const int idx = tid + 512 * j, r = idx >> 9, c4 = (idx & 511) * 4;
            const f32x4 v = *(LAS f32x4*)(xs + idx * 4), gv = *(const f32x4*)(gain + c4), bv = *(const f32x4*)(bias + c4);
            const float mean = stat[2 * r], rstd = stat[2 * r + 1];
            const f32x4 o = (v - mean) * rstd * gv + bv;
            *(LAS f32x4*)(xs + idx * 4) = o;
            *(f32x4*)(X1F + (size_t)(row0 + r) * D + c4) = o;
            v2u wb; wb.x = pk2(o[0], o[1]); wb.y = pk2(o[2], o[3]); *(v2u*)(X1B + (size_t)(row0 + r) * D + c4) = wb; }
        __syncthreads();
        { const int r = tid >> 5, ep = tid & 31; float a0 = 0.f, a1 = 0.f; const float* wp = RW + 2 * ep; const LAS float* xr = xs + r * D;
            for (int k0 = 0; k0 < D; k0 += 16) {
                f32x2 wv[16];
#pragma unroll
                for (int j = 0; j < 16; ++j) wv[j] = *(const f32x2*)(wp + (size_t)(k0 + j) * NEXP);
                asm volatile("" : "+v"(wv[0]), "+v"(wv[1]), "+v"(wv[2]), "+v"(wv[3]), "+v"(wv[4]), "+v"(wv[5]), "+v"(wv[6]), "+v"(wv[7]));
                asm volatile("" : "+v"(wv[8]), "+v"(wv[9]), "+v"(wv[10]), "+v"(wv[11]), "+v"(wv[12]), "+v"(wv[13]), "+v"(wv[14]), "+v"(wv[15]));
#pragma unroll
                for (int j = 0; j < 16; ++j) { const float xv = xr[k0 + j]; a0 += xv * wv[j].x; a1 += xv * wv[j].y; } }
            logit[r * NEXP + 2 * ep] = a0; logit[r * NEXP + 2 * ep + 1] = a1; }
        __syncthreads();
        int sel_pos[2]; float sel_gate[2]; int sel_rank[2]; bool sel_on[2];
#pragma unroll
        for (int rr = 0; rr < 2; ++rr) { const int r = 2 * w + rr;
            const float sc = 1.0f / (1.0f + __expf(-logit[r * NEXP + lane])); const float ch = sc + RB[lane];
            int rk = 0;
#pragma unroll
            for (int j = 0; j < 8; ++j) { const float cj = shfl_from(ch, (lane & ~7) + j); rk += (cj > ch || (cj == ch && j < (lane & 7))) ? 1 : 0; }
            float gs = rk < 2 ? ch : 0.f; gs += shfl_x(gs, 1, lane); gs += shfl_x(gs, 2, lane); gs += shfl_x(gs, 4, lane);
            int grk = 0; const int g = lane >> 3;
#pragma unroll
            for (int hh = 0; hh < 8; ++hh) { const float gh = shfl_from(gs, 8 * hh); grk += (gh > gs || (gh == gs && hh < g)) ? 1 : 0; }
            const float msk = grk < 4 ? ch : -INFINITY;
            int erk = 0;
            for (int j = 0; j < 64; ++j) { const float mj = __builtin_bit_cast(float, __builtin_amdgcn_readlane(__builtin_bit_cast(int, msk), j)); erk += (mj > msk || (mj == msk && j < lane)) ? 1 : 0; }
            const bool on = erk < 8;
            const float ssum = wave_sum(on ? sc : 0.f, lane);
            sel_on[rr] = on; sel_rank[rr] = erk; sel_gate[rr] = sc / ssum * 2.5f; sel_pos[rr] = 0;
            if (on) sel_pos[rr] = __hip_atomic_fetch_add(&hist[lane], 1, __ATOMIC_RELAXED, __HIP_MEMORY_SCOPE_WORKGROUP); }
        __syncthreads();
        if (tid < 64) { const int hc = hist[tid]; int bs = 0; if (hc > 0) bs = (int)atomicAdd(&cnt[tid * 16], (unsigned)hc); basep[tid] = bs; }
        __syncthreads();
#pragma unroll
        for (int rr = 0; rr < 2; ++rr) if (sel_on[rr]) { const int t = row0 + 2 * w + rr, pos = basep[lane] + sel_pos[rr];
            ltok[(size_t)lane * CAP + pos] = t; lgate[(size_t)lane * CAP + pos] = sel_gate[rr];
            eidx[t * 8 + sel_rank[rr]] = lane; inv[t * 8 + sel_rank[rr]] = pos; }
    }
}
__device__ __forceinline__ int build_tiles(const Frame& F, const unsigned* cnt) {
    LAS int* tpref = (LAS int*)(F.lds + LDS_TAB); LAS int* cl = (LAS int*)(F.lds + LDS_TAB + 512);
    __syncthreads();
    if (F.tid < 64) cl[F.tid] = (int)__hip_atomic_load(&cnt[F.tid * 16], __ATOMIC_RELAXED, __HIP_MEMORY_SCOPE_AGENT);
    __syncthreads();
    if (F.tid == 0) { int acc = 0; for (int e = 0; e < 64; ++e) { tpref[e] = acc; acc += (cl[e] + 255) >> 8; } tpref[64] = acc; }
    __syncthreads();
    return __builtin_amdgcn_readfirstlane(tpref[64]);
}
__device__ __forceinline__ void phase_moe4(const Frame& F, const float* Y2, const bf16* Yr, const int* eidx, const int* inv, const float* gain, const float* bias, float* XO, bf16* XBo) {
    const LAS int* tpref = (const LAS int*)(F.lds + LDS_TAB);
    const int gw = F.bid * 8 + F.wave, NGW = F.G * 8, lane = F.lane;
    for (int t = gw; t < T; t += NGW) {
        f32x4 v[8];
#pragma unroll
        for (int j = 0; j < 8; ++j) v[j] = *(const f32x4*)(Y2 + (size_t)t * D + 4 * lane + 256 * j);
        for (int k = 0; k < 8; ++k) { const int e = eidx[t * 8 + k], pos = inv[t * 8 + k]; const bf16* yr = Yr + (size_t)(tpref[e] * 256 + pos) * D + 4 * lane;
#pragma unroll
            for (int j = 0; j < 8; ++j) { const v2u w = *(const v2u*)(yr + 256 * j); v[j][0] += bflo(w.x); v[j][1] += bfhi(w.x); v[j][2] += bflo(w.y); v[j][3] += bfhi(w.y); } }
        float sm = 0.f;
#pragma unroll
        for (int j = 0; j < 8; ++j) sm += (v[j][0] + v[j][1]) + (v[j][2] + v[j][3]);
        const float mean = wave_sum(sm, lane) * (1.0f / D); float sq = 0.f;
#pragma unroll
        for (int j = 0; j < 8; ++j) { v[j] = v[j] - mean; sq += (v[j][0] * v[j][0] + v[j][1] * v[j][1]) + (v[j][2] * v[j][2] + v[j][3] * v[j][3]); }
        const float rstd = 1.0f / sqrtf(wave_sum(sq, lane) * (1.0f / D) + LN_EPS);
#pragma unroll
        for (int j = 0; j < 8; ++j) { const int c = 4 * lane + 256 * j; const f32x4 o = v[j] * rstd * *(const f32x4*)(gain + c) + *(const f32x4*)(bias + c);
            *(f32x4*)(XO + (size_t)t * D + c) = o;
            v2u wb; wb.x = pk2(o[0], o[1]); wb.y = pk2(o[2], o[3]); *(v2u*)(XBo + (size_t)t * D + c) = wb; }
    }
}

enum { PH_PRO = 0, PH_POOL_G1, PH_POOL_P, PH_POOL_G2, PH_POOL_G3, PH_DIL_G1, PH_DIL_ATT, PH_DIL_CMB, PH_DIL_G2, PH_CONV_G1, PH_CONV_E, PH_CONV_G2, PH_MOE1, PH_MOE2, PH_MOE3, PH_MOE4, PH_COUNT };

template <int PH>
__device__ __forceinline__ void run_phase(const Frame& Fin, const Args& args_, const int L) {
    Frame F = Fin; { int w_ = Fin.wave, l_; asm volatile("" : "+s"(w_)); asm volatile("v_mbcnt_lo_u32_b32 %0, -1, 0\n\tv_mbcnt_hi_u32_b32 %0, -1, %0" : "=v"(l_)); F.wave = w_; F.lane = l_; F.tid = w_ * 64 + l_; }
    unsigned char* ws; { GAS unsigned char* wsg = (GAS unsigned char*)Fin.ws; asm volatile("" : "+s"(wsg)); ws = (unsigned char*)wsg; } F.ws = ws; F.ctl = (unsigned*)(ws + WS_CTL);
    KP kp = (KP)__builtin_amdgcn_kernarg_segment_ptr(); asm volatile("" : "+s"(kp)); (void)args_;
    { unsigned l_ = (unsigned)(size_t)Fin.lds; asm volatile("" : "+s"(l_)); F.lds = (LAS unsigned char*)(size_t)l_; }
    LAS unsigned char* ring = F.lds; int c = (int)blockIdx.x; { int g_ = Fin.G; asm volatile("" : "+s"(c), "+s"(g_)); F.G = g_; F.bid = c; }
    const float* xin = (L == 0) ? ain(kp, IN_X) : (const float*)(ws + WS_XF);
    const bf16* xb = (const bf16*)(ws + WS_XB);
    float* yf = (float*)(ws + WS_YF);
    unsigned char* big = ws + WS_BIG;
    const int ia = L / 3;
    if constexpr (PH == PH_PRO) { phase_prologue(F, kp); }
    if constexpr (PH == PH_POOL_G1) { g8::DenseSched S; S.init(xb, (const bf16*)(ws + WS_W_POOL_IN) + (size_t)ia * D * D, T, D, D, D, F.G, c);
        g8::EpiBf16 E{(bf16*)(big + BG_U), D, 0}; g8::gemm_phase<g8::EpiBf16, g8::DenseSched, false>(ring, F.tid, D, D, D, S, E); }
    if constexpr (PH == PH_POOL_P) { phase_pool(F, (const bf16*)(big + BG_U), (bf16*)(big + BG_PL)); }
    if constexpr (PH == PH_POOL_G2) { g8::DenseSched S; S.init((const bf16*)(big + BG_PL), (const bf16*)(ws + WS_W_POOL_G) + (size_t)ia * D * 512, T, D, D, 512, F.G, c); S.agrp_shift = 1; S.agrp_stride = 512 * 2;
        g8::EpiScaleBf16 E{(bf16*)(big + BG_MX), D, ain(kp, IN_PSC) + (size_t)ia * D}; g8::gemm_phase<g8::EpiScaleBf16, g8::DenseSched, false>(ring, F.tid, 512, D, 512, S, E); }
    if constexpr (PH == PH_POOL_G3) { g8::DenseSched S; S.init((const bf16*)(big + BG_MX), (const bf16*)(ws + WS_W_POOL_OUT) + (size_t)ia * D * D, T, D, D, D, F.G, c);
        g8::EpiResid E{xin, yf}; g8::gemm_phase<g8::EpiResid, g8::DenseSched, false>(ring, F.tid, D, D, D, S, E); }
    if constexpr (PH == PH_DIL_G1) { g8::DenseSched S; S.init(xb, (const bf16*)(ws + WS_W_DIL_QKV), T, QKVC, D, D, F.G, c);
        g8::EpiBf16 E{(bf16*)(big + BG_QKV), QKVC, 1}; g8::gemm_phase<g8::EpiBf16, g8::DenseSched, false>(ring, F.tid, D, D, D, S, E); }
    if constexpr (PH == PH_DIL_ATT) { phase_attn(F, (const bf16*)(big + BG_QKV), ain(kp, IN_RELB), (bf16*)(big + BG_OG), (float*)(big + BG_LSE)); }
    if constexpr (PH == PH_DIL_CMB) { phase_combine(F, (const bf16*)(big + BG_OG), (const float*)(big + BG_LSE), (bf16*)(big + BG_O)); }
    if constexpr (PH == PH_DIL_G2) { g8::DenseSched S; S.init((const bf16*)(big + BG_O), (const bf16*)(ws + WS_W_DIL_OUT), T, D, DILW, DILW, F.G, c);
        g8::EpiResid E{xin, yf}; g8::gemm_phase<g8::EpiResid, g8::DenseSched, false>(ring, F.tid, DILW, DILW, DILW, S, E); }
    if constexpr (PH == PH_CONV_G1) { g8::DenseSched S; S.init(xb, (const bf16*)(ws + WS_W_CONV_IN), T, 3 * D, D, D, F.G, c);
        g8::EpiConvIn E{(bf16*)(big + BG_UC), (bf16*)(big + BG_BG)}; g8::gemm_phase<g8::EpiConvIn, g8::DenseSched, false>(ring, F.tid, D, D, D, S, E); }
    if constexpr (PH == PH_CONV_E) { phase_conv(F, (const bf16*)(big + BG_UC), (const bf16*)(big + BG_BG), ain(kp, IN_CW), (bf16*)(big + BG_Z)); }
    if constexpr (PH == PH_CONV_G2) { g8::DenseSched S; S.init((const bf16*)(big + BG_Z), (const bf16*)(ws + WS_W_CONV_OUT), T, D, D, D, F.G, c);
        g8::EpiResid E{xin, yf}; g8::gemm_phase<g8::EpiResid, g8::DenseSched, false>(ring, F.tid, D, D, D, S, E); }
    unsigned* cnt = F.ctl + CW_CNT + L * 64 * 16;
    float* x1f = (float*)(ws + WS_X1F); bf16* x1b = (bf16*)(ws + WS_X1B);
    int* ltok = (int*)(ws + WS_LTOK); float* lgate = (float*)(ws + WS_LGATE); int* eidx = (int*)(ws + WS_EIDX); int* inv = (int*)(ws + WS_INV);
    bf16* HB = (bf16*)(ws + WS_HB); bf16* HS = (bf16*)(ws + WS_HS); bf16* Yr = (bf16*)(ws + WS_BIG);
    if constexpr (PH == PH_MOE1) {
        const float* g1 = ain(kp, IN_LNG) + (size_t)(L * 2 + 0) * D; const float* b1 = ain(kp, IN_LNB) + (size_t)(L * 2 + 0) * D;
        phase_moe1(F, yf, g1, b1, ain(kp, IN_RW) + (size_t)L * D * NEXP, ain(kp, IN_RB) + (size_t)L * NEXP, x1f, x1b, cnt, ltok, lgate, eidx, inv); }
    if constexpr (PH == PH_MOE2) {
        const int NT = build_tiles(F, cnt);
        { g8::ExpertSched<1, true> S; S.tpref = (const LAS int*)(F.lds + LDS_TAB); S.cnt = (const LAS int*)(F.lds + LDS_TAB + 512); S.A = (const char*)x1b; S.B = (const char*)((const bf16*)(ws + WS_W_EX_GU) + (size_t)L * 64 * 256 * D);
          S.tok = ltok; S.b_exp = (size_t)256 * D * 2; S.b_tile = 0; S.a_tile = 0; S.NU = NT; S.G = F.G; S.c = c;
          g8::EpiExpertGU E{HB}; g8::gemm_phase<g8::EpiExpertGU, g8::ExpertSched<1, true>, true>(ring, F.tid, D, D, D, S, E); }
        { const int rot = (c - (NT % F.G) + F.G) % F.G;
          g8::DenseSched S; S.init(x1b, (const bf16*)(ws + WS_W_SH_GU) + (size_t)L * 512 * D, T, 512, D, D, F.G, rot);
          int t2 = F.tid; asm volatile("" : "+v"(t2));
          g8::EpiSharedGU E{HS}; g8::gemm_phase<g8::EpiSharedGU, g8::DenseSched, false>(ring, t2, D, D, D, S, E); } }
    if constexpr (PH == PH_MOE3) {
        const int NT = build_tiles(F, cnt);
        { g8::ExpertSched<8, false> S; S.tpref = (const LAS int*)(F.lds + LDS_TAB); S.cnt = (const LAS int*)(F.lds + LDS_TAB + 512); S.A = (const char*)HB; S.B = (const char*)((const bf16*)(ws + WS_W_EX_D) + (size_t)L * 64 * D * 256);
          S.tok = ltok; S.b_exp = (size_t)D * 256 * 2; S.b_tile = (size_t)256 * 256 * 2; S.a_tile = (size_t)256 * 256 * 2; S.NU = NT * 8; S.G = F.G; S.c = c;
          g8::EpiDownY E{Yr}; g8::gemm_phase<g8::EpiDownY, g8::ExpertSched<8, false>, false>(ring, F.tid, 256, 256, 256, S, E); }
        { const int rot = (c - ((NT * 8) % F.G) + F.G) % F.G;
          g8::DenseSched S; S.init(HS, (const bf16*)(ws + WS_W_SH_D) + (size_t)L * D * SDIM, T, D, SDIM, SDIM, F.G, rot);
          int t2 = F.tid; asm volatile("" : "+v"(t2));
          g8::EpiResid E{x1f, yf}; g8::gemm_phase<g8::EpiResid, g8::DenseSched, false>(ring, t2, SDIM, SDIM, SDIM, S, E); } }
    if constexpr (PH == PH_MOE4) { (void)build_tiles(F, cnt);
        const float* g2 = ain(kp, IN_LNG) + (size_t)(L * 2 + 1) * D; const float* b2 = ain(kp, IN_LNB) + (size_t)(L * 2 + 1) * D;
        float* xo = (L == DEPTH - 1) ? aout(kp) : (float*)(ws + WS_XF);
        phase_moe4(F, yf, Yr, eidx, inv, g2, b2, xo, (bf16*)(ws + WS_XB)); }
}
__device__ __forceinline__ void make_frame(Frame& F, const Args& args) {
    extern __shared__ __attribute__((aligned(16))) unsigned char lds_raw[];
    F.lds = (LAS unsigned char*)lds_raw; F.ws = args.ws; F.ctl = (unsigned*)(args.ws + WS_CTL);
    F.tid = threadIdx.x; F.lane = F.tid & 63; F.wave = __builtin_amdgcn_readfirstlane(F.tid >> 6); F.G = gridDim.x; F.bid = blockIdx.x;
}
template <int PH> __global__ void __launch_bounds__(512, 2) k_phase(Args args, int L) {
    Frame F; make_frame(F, args);
    run_phase<PH>(F, args, L);
}

#ifndef MK_NOINLINE
#define MK_NOINLINE 0
#endif
#if MK_NOINLINE
template <int PH> __device__ __noinline__ void call_phase_ni(const int L) {
    Args dummy{}; Frame F;
    KP kp = (KP)__builtin_amdgcn_kernarg_segment_ptr();
    extern __shared__ __attribute__((aligned(16))) unsigned char lds_raw[];
    F.lds = (LAS unsigned char*)lds_raw; F.ws = (unsigned char*)((GAS unsigned char* const CAS*)kp)[20]; F.ctl = (unsigned*)(F.ws + WS_CTL);
    F.tid = threadIdx.x; F.lane = F.tid & 63; F.wave = __builtin_amdgcn_readfirstlane(F.tid >> 6); F.G = gridDim.x; F.bid = blockIdx.x;
    run_phase<PH>(F, dummy, L);
}
template <int PH> __device__ __forceinline__ void call_phase(const Frame& F, const Args& args, const int L) { call_phase_ni<PH>(L); }
#else
template <int PH> __device__ __forceinline__ void call_phase(const Frame& F, const Args& args, const int L) { asm volatile("; PHASE_BEGIN %0" :: "n"(PH)); run_phase<PH>(F, args, L); asm volatile("; PHASE_END %0" :: "n"(PH)); }
#endif
__global__ void __launch_bounds__(512, 2) fwd_all(Args args) {
    Frame F; make_frame(F, args);
    volatile LAS unsigned* misc = (volatile LAS unsigned*)(F.lds + LDS_MISC);
    if (F.tid < 4) misc[F.tid] = 0u;
    __syncthreads();
    const int lo = args.ph_lo, hi = args.ph_hi;
    XcdBarrier bar; bar.bar = F.ctl + CW_BAR; bar.x = 0; bar.st = misc;
    if (hi - lo > 1) bar = xcd_barrier_post(F.ctl + CW_BAR, misc);
    int pc = 0;
#define STEP(PH, Lx) do { if (pc >= lo && pc < hi) { call_phase<PH>(F, args, Lx); if (pc + 1 < hi) xcd_barrier(bar); } ++pc; } while (0)
    STEP(PH_PRO, 0);
#pragma unroll 1
    for (int L = 0; L < DEPTH; ++L) {
        const int kind = L % 3;
        if (kind == 0) { STEP(PH_POOL_G1, L); STEP(PH_POOL_P, L); STEP(PH_POOL_G2, L); STEP(PH_POOL_G3, L); }
        else if (kind == 1) { STEP(PH_DIL_G1, L); STEP(PH_DIL_ATT, L); STEP(PH_DIL_CMB, L); STEP(PH_DIL_G2, L); }
        else { STEP(PH_CONV_G1, L); STEP(PH_CONV_E, L); STEP(PH_CONV_G2, L); }
        STEP(PH_MOE1, L); STEP(PH_MOE2, L); STEP(PH_MOE3, L); STEP(PH_MOE4, L);
    }
#undef STEP
}
constexpr int N_STEPS = 1 + 2 * 8 + 8 + 7;

template <int PH> static void launch_phase(const Args& a, int L, int grid, hipStream_t stream) {
    static bool attr = false;
    if (!attr) { (void)hipFuncSetAttribute((const void*)k_phase<PH>, hipFuncAttributeMaxDynamicSharedMemorySize, LDS_BYTES); attr = true; }
    hipLaunchKernelGGL(k_phase<PH>, dim3(grid), dim3(512), LDS_BYTES, stream, a, L);
}
extern "C" void kernel_launch(void* const* d_in, const int* in_sizes, int n_in, void* d_out, int out_size, void* d_ws, size_t ws_size, hipStream_t stream) {
    static int grid = 0;
    if (grid == 0) {
        if (n_in != 19 || out_size != T * D || ws_size < WS_END) { fprintf(stderr, "kernel_launch: unexpected shapes (n_in %d out %d ws %zu need %zu)\n", n_in, out_size, ws_size, (size_t)WS_END); grid = -1; return; }
        int dev = 0, cus = 0;
        if (hipGetDevice(&dev) != hipSuccess || hipDeviceGetAttribute(&cus, hipDeviceAttributeMultiprocessorCount, dev) != hipSuccess) { grid = -1; return; }
#if MK_ONE_LAUNCH
        if (hipFuncSetAttribute((const void*)fwd_all, hipFuncAttributeMaxDynamicSharedMemorySize, LDS_BYTES) != hipSuccess) { fprintf(stderr, "kernel_launch: hipFuncSetAttribute failed\n"); grid = -1; return; }
        int per_cu = 0;
        if (hipOccupancyMaxActiveBlocksPerMultiprocessor(&per_cu, (const void*)fwd_all, 512, LDS_BYTES) != hipSuccess || per_cu < 1) { fprintf(stderr, "kernel_launch: occupancy query reports %d blocks per CU\n", per_cu); (void)hipGetLastError(); grid = -1; return; }
#endif
        grid = cus;
    }
    if (grid < 0) return;
    (void)hipMemsetAsync((char*)d_ws + WS_CTL, 0, CTL_ZERO_BYTES, stream);
    Args a{};
    for (int i = 0; i < 19; ++i) a.in[i] = (const float*)d_in[i];
    a.out = (float*)d_out; a.ws = (unsigned char*)d_ws; a.ph_lo = 0; a.ph_hi = 0;
#if MK_ONE_LAUNCH
#ifdef MK_SPLIT
    for (int p = 0; p < N_STEPS; ++p) { a.ph_lo = p; a.ph_hi = p + 1; hipLaunchKernelGGL(fwd_all, dim3(grid), dim3(512), LDS_BYTES, stream, a); }
#else
    a.ph_lo = 0; a.ph_hi = N_STEPS;
    hipLaunchKernelGGL(fwd_all, dim3(grid), dim3(512), LDS_BYTES, stream, a);
#endif
#elif defined(MK_HYBRID_MASK)
    {
        static bool attr2 = false; if (!attr2) { (void)hipFuncSetAttribute((const void*)fwd_all, hipFuncAttributeMaxDynamicSharedMemorySize, LDS_BYTES); attr2 = true; }
        int pc = 0;
#define HSTEP(PH, Lx) do { if ((MK_HYBRID_MASK >> (PH)) & 1) { a.ph_lo = pc; a.ph_hi = pc + 1; hipLaunchKernelGGL(fwd_all, dim3(grid), dim3(512), LDS_BYTES, stream, a); } else { a.ph_lo = 0; a.ph_hi = 0; launch_phase<PH>(a, Lx, grid, stream); } ++pc; } while (0)
        HSTEP(PH_PRO, 0);
        for (int L = 0; L < DEPTH; ++L) {
            const int kind = L % 3;
            if (kind == 0) { HSTEP(PH_POOL_G1, L); HSTEP(PH_POOL_P, L); HSTEP(PH_POOL_G2, L); HSTEP(PH_POOL_G3, L); }
            else if (kind == 1) { HSTEP(PH_DIL_G1, L); HSTEP(PH_DIL_ATT, L); HSTEP(PH_DIL_CMB, L); HSTEP(PH_DIL_G2, L); }
            else { HSTEP(PH_CONV_G1, L); HSTEP(PH_CONV_E, L); HSTEP(PH_CONV_G2, L); }
            HSTEP(PH_MOE1, L); HSTEP(PH_MOE2, L); HSTEP(PH_MOE3, L); HSTEP(PH_MOE4, L);
        }
#undef HSTEP
    }
#else
    launch_phase<PH_PRO>(a, 0, grid, stream);
    for (int L = 0; L < DEPTH; ++L) {
        const int kind = L % 3;
        if (kind == 0) { launch_phase<PH_POOL_G1>(a, L, grid, stream); launch_phase<PH_POOL_P>(a, L, grid, stream); launch_phase<PH_POOL_G2>(a, L, grid, stream); launch_phase<PH_POOL_G3>(a, L, grid, stream); }
        else if (kind == 1) { launch_phase<PH_DIL_G1>(a, L, grid, stream); launch_phase<PH_DIL_ATT>(a, L, grid, stream); launch_phase<PH_DIL_CMB>(a, L, grid, stream); launch_phase<PH_DIL_G2>(a, L, grid, stream); }
        else { launch_phase<PH_CONV_G1>(a, L, grid, stream); launch_phase<PH_CONV_E>(a, L, grid, stream); launch_phase<PH_CONV_G2>(a, L, grid, stream); }
        launch_phase<PH_MOE1>(a, L, grid, stream); launch_phase<PH_MOE2>(a, L, grid, stream); launch_phase<PH_MOE3>(a, L, grid, stream); launch_phase<PH_MOE4>(a, L, grid, stream);
    }
#endif
}
```

```cpp
#include <hip/hip_runtime.h>
#include <cstdio>
#include <cstdint>

#ifndef MK_ONE_LAUNCH
#define MK_ONE_LAUNCH 1
#endif

#define GAS __attribute__((address_space(1)))
#define LAS __attribute__((address_space(3)))
typedef unsigned short bf16;
typedef unsigned v4u __attribute__((ext_vector_type(4)));
typedef unsigned v2u __attribute__((ext_vector_type(2)));
typedef float f32x4 __attribute__((ext_vector_type(4)));
typedef float f32x2 __attribute__((ext_vector_type(2)));
typedef short bf16x8 __attribute__((ext_vector_type(8)));
typedef short s16x4 __attribute__((ext_vector_type(4)));

constexpr int NBATCH = 8, SEQ = 2048, D = 2048, T = NBATCH * SEQ, DEPTH = 4;
constexpr int NEXP = 64, TOPK = 8, EDIM = 128, SDIM = 256;
constexpr int QKVC = 4608, DILW = 512;
constexpr float ALPHA = 1.681792830507429f;
constexpr float LN_EPS = 1e-5f;
constexpr int CAP = 16384;
constexpr int HROWS = T * TOPK + NEXP * 256;

constexpr size_t MiB = 1u << 20;
constexpr size_t WS_CTL = 0, CTL_ZERO_BYTES = 1 * MiB;
constexpr size_t WS_W_POOL_IN = 1 * MiB;
constexpr size_t WS_W_POOL_G = WS_W_POOL_IN + 16 * MiB;
constexpr size_t WS_W_POOL_OUT = WS_W_POOL_G + 4 * MiB;
constexpr size_t WS_W_DIL_QKV = WS_W_POOL_OUT + 16 * MiB;
constexpr size_t WS_W_DIL_OUT = WS_W_DIL_QKV + 18 * MiB;
constexpr size_t WS_W_CONV_IN = WS_W_DIL_OUT + 2 * MiB;
constexpr size_t WS_W_CONV_OUT = WS_W_CONV_IN + 24 * MiB;
constexpr size_t WS_W_SH_GU = WS_W_CONV_OUT + 8 * MiB;
constexpr size_t WS_W_SH_D = WS_W_SH_GU + 8 * MiB;
constexpr size_t WS_W_EX_GU = WS_W_SH_D + 4 * MiB;
constexpr size_t WS_W_EX_D = WS_W_EX_GU + 256 * MiB;
constexpr size_t WS_XF = WS_W_EX_D + 256 * MiB;
constexpr size_t WS_YF = WS_XF + 128 * MiB;
constexpr size_t WS_X1F = WS_YF + 128 * MiB;
constexpr size_t WS_XB = WS_X1F + 128 * MiB;
constexpr size_t WS_X1B = WS_XB + 64 * MiB;
constexpr size_t WS_HB = WS_X1B + 64 * MiB;
constexpr size_t WS_HS = WS_HB + 72 * MiB;
constexpr size_t WS_LTOK = WS_HS + 8 * MiB;
constexpr size_t WS_LGATE = WS_LTOK + 4 * MiB;
constexpr size_t WS_EIDX = WS_LGATE + 4 * MiB;
constexpr size_t WS_INV = WS_EIDX + 1 * MiB;
constexpr size_t WS_BIG = WS_INV + 1 * MiB;
constexpr size_t WS_PST = WS_BIG + 608 * MiB;
constexpr size_t WS_ST1 = WS_PST + 4 * MiB;
constexpr size_t WS_ST2 = WS_ST1 + 1 * MiB;
constexpr size_t WS_RWH = WS_ST2 + 1 * MiB;
constexpr size_t WS_RWL = WS_RWH + 1 * MiB;
constexpr size_t WS_END = WS_RWL + 1 * MiB;
constexpr size_t WS_Y2F = WS_X1F;
constexpr size_t BG_U = 0, BG_PL = 64 * MiB, BG_MX = 128 * MiB;
constexpr size_t BG_QKV = 0, BG_OG = 144 * MiB, BG_LSE = 192 * MiB, BG_O = 194 * MiB;
constexpr size_t BG_UC = 0, BG_BG = 64 * MiB, BG_Z = 128 * MiB;
constexpr int CW_BAR = 4096;
constexpr int CW_CNT = 16384;

constexpr int RING_BYTES = 131072;
constexpr int LDS_TAB = RING_BYTES;
constexpr int LDS_STASH = RING_BYTES + 1024;
constexpr int LDS_MISC = RING_BYTES + 1024 + 8192;
constexpr int LDS_BYTES = 147456;

__device__ __forceinline__ unsigned cvt_pk_bf16(float lo, float hi) { unsigned r; asm volatile("v_cvt_pk_bf16_f32 %0, %1, %2" : "=v"(r) : "v"(lo), "v"(hi)); return r; }
__device__ __forceinline__ unsigned f2bf(float f) { unsigned u = __builtin_bit_cast(unsigned, f); return (u + 0x7fffu + ((u >> 16) & 1u)) >> 16; }
__device__ __forceinline__ unsigned pk2(float lo, float hi) { return f2bf(lo) | (f2bf(hi) << 16); }
__device__ __forceinline__ float bflo(unsigned w) { return __builtin_bit_cast(float, w << 16); }
__device__ __forceinline__ float bfhi(unsigned w) { return __builtin_bit_cast(float, w & 0xffff0000u); }
__device__ __forceinline__ float shfl_from(float v, int src) { return __builtin_bit_cast(float, __builtin_amdgcn_ds_bpermute(src << 2, __builtin_bit_cast(int, v))); }
__device__ __forceinline__ float shfl_x(float v, int o, int lane) { return shfl_from(v, lane ^ o); }
__device__ __forceinline__ float wave_sum(float v, int lane) {
#pragma unroll
    for (int o = 1; o < 64; o <<= 1) v += shfl_x(v, o, lane);
    return v;
}
#define LDS_WAIT() asm volatile("s_waitcnt lgkmcnt(0)" ::: "memory")
#define VM_WAIT() asm volatile("s_waitcnt vmcnt(0)" ::: "memory")

#define XB_TMO      128
#define XB_XCNT(j)  (256  + 64 * (j))
#define XB_XSUB(j)  (1280 + 64 * (j))
#define XB_XGEN(j)  (2304 + 64 * (j))
#define XB_TOP      3328
#define XB_TOPGEN   3392
#define XCD_BAR_WORDS 3456
#define XB_SPIN_CAP (1u << 18)

__device__ __forceinline__ unsigned xb_ld(unsigned* p)              { return __hip_atomic_load(p, __ATOMIC_RELAXED, __HIP_MEMORY_SCOPE_AGENT); }
__device__ __forceinline__ unsigned xb_add(unsigned* p, unsigned v) { return __hip_atomic_fetch_add(p, v, __ATOMIC_RELAXED, __HIP_MEMORY_SCOPE_AGENT); }
__device__ __forceinline__ unsigned xb_xcc_id() { return (unsigned)__builtin_amdgcn_s_getreg((3 << 11) | 20) & 0xFu; }
#define XB_SPIN(cond, bar) do { unsigned _sp = 0; while (cond) { __builtin_amdgcn_s_sleep(1); \
    if ((++_sp & 255u) == 0u) { if (xb_ld(&(bar)[XB_TMO])) break; if (_sp > XB_SPIN_CAP) { atomicAdd(&(bar)[XB_TMO], 1u); break; } } } } while (0)

struct XcdBarrier {
    unsigned* bar; unsigned x;
    volatile LAS unsigned* st;
};

__device__ __forceinline__ XcdBarrier xcd_barrier_post(unsigned* bar, volatile LAS unsigned* st) {
    XcdBarrier b; b.bar = bar; b.x = xb_xcc_id(); b.st = st;
    if (threadIdx.x == 0) (void)xb_add(&bar[XB_XCNT(b.x)], 1u);
    return b;
}
__device__ __forceinline__ void xcd_barrier_complete(unsigned* bar, unsigned x, unsigned& nloc, unsigned& nx) {
    const unsigned G = gridDim.x * gridDim.y * gridDim.z;
    unsigned sum, cnt, mine, sp = 0u;
    for (;;) {
        sum = 0u; cnt = 0u; mine = 0u;
#pragma unroll
        for (unsigned j = 0; j < 16; ++j) { const unsigned c = xb_ld(&bar[XB_XCNT(j)]); sum += c; cnt += (c > 0u) ? 1u : 0u; mine = (j == x) ? c : mine; }
        if (sum == G) break;
        __builtin_amdgcn_s_sleep(1);
        if ((++sp & 255u) == 0u) { if (xb_ld(&bar[XB_TMO])) break; if (sp > XB_SPIN_CAP) { atomicAdd(&bar[XB_TMO], 1u); break; } }
    }
    nloc = mine > 0u ? mine : 1u; nx = cnt > 0u ? cnt : 1u;
}

__device__ __forceinline__ void xcd_barrier(const XcdBarrier& b) {
    asm volatile("s_waitcnt vmcnt(0)" ::: "memory");
    __syncthreads();
    if (threadIdx.x == 0) {
        unsigned* bar; unsigned bx = b.x; { GAS unsigned* bg = (GAS unsigned*)b.bar; asm volatile("" : "+s"(bg), "+s"(bx)); bar = (unsigned*)bg; }
        __builtin_amdgcn_s_waitcnt(0);
        unsigned nloc = b.st[0], nx = b.st[1];
        if (nloc == 0u) { xcd_barrier_complete(bar, bx, nloc, nx); b.st[0] = nloc; b.st[1] = nx; }
        const unsigned old = xb_add(&bar[XB_XSUB(bx)], 1u);
        const unsigned gen = old / nloc;
        if (old + 1u == (gen + 1u) * nloc) {
            __builtin_amdgcn_fence(__ATOMIC_RELEASE, "agent");
            asm volatile("s_waitcnt vmcnt(0)" ::: "memory");
            const unsigned og = xb_add(&bar[XB_TOP], 1u);
            const unsigned tg = og / nx;
            if (og + 1u == (tg + 1u) * nx) xb_add(&bar[XB_TOPGEN], 1u);
            else XB_SPIN(xb_ld(&bar[XB_TOPGEN]) == tg, bar);
            __builtin_amdgcn_fence(__ATOMIC_ACQUIRE, "agent");
            xb_add(&bar[XB_XGEN(bx)], 1u);
            asm volatile("s_waitcnt vmcnt(0)" ::: "memory");
        } else {
            XB_SPIN(xb_ld(&bar[XB_XGEN(bx)]) == gen, bar);
            __builtin_amdgcn_fence(__ATOMIC_ACQUIRE, "agent");
            asm volatile("s_waitcnt vmcnt(0)" ::: "memory");
        }
    }
    __syncthreads();
}

namespace g8 {
constexpr int BM = 256, BK = 64, HALF = 128, HTB = HALF * BK * 2, STAGE_BYTES = 8 * HTB, NXCD = 8, WGM = 8;
__host__ __device__ __forceinline__ int lds_byte(int r, int c) { const int st = (r >> 4) * 2 + (c >> 5), rr = r & 15, cc = c & 31, ob = rr * 64 + cc * 2; return st * 1024 + (ob ^ (((ob >> 9) & 1) << 5)); }
__host__ __device__ __forceinline__ void stage_rc(int b, int& R, int& C) { const int st = b / 1024, sb = b % 1024, swz = sb ^ (((sb >> 9) & 1) << 5); R = (st >> 1) * 16 + swz / 64; C = (st & 1) * 32 + (swz % 64) / 2; }
__host__ __device__ __forceinline__ int perm32(int rho) { const int n = rho >> 4, i = rho & 15; return 8 * (i >> 2) + 4 * n + (i & 3); }

struct Unit { const char* A; const char* B; const int* rows; int pm, pn, nvalid, aux; };

template <class Epi, class Sched, bool GATHER>
__device__ __forceinline__ void gemm_phase(LAS unsigned char* lds, const int tid_in, const int K, const int lda, const int ldb, const Sched& S, const Epi& E) {
    const int tid = tid_in, wid = __builtin_amdgcn_readfirstlane(tid >> 6), lane = tid & 63, wr = wid >> 2, wc = wid & 3, fr = lane & 15, fq = lane >> 4;
    const int nt = K / BK;
    unsigned voffB[2];
#pragma unroll
    for (int i = 0; i < 2; ++i) { int R_, C_; stage_rc(tid * 16 + i * 8192, R_, C_); const int Rb = Epi::PERM ? ((R_ & ~31) + perm32(R_ & 31)) : R_; voffB[i] = (unsigned)(Rb * ldb + C_) * 2u; }
    LAS v4u* stash = (LAS v4u*)(lds + (LDS_STASH - 0) + tid * 16);
    const size_t kstep = (size_t)(BK * 2);
    const size_t hstepB = (size_t)HALF * ldb * 2;
    const unsigned ldsw = (unsigned)wid * 1024u;
    const int aoff = lds_byte(wr * 64 + fr, fq * 8), boff = lds_byte(wc * 32 + fr, fq * 8);
#define G8_SA(b, h) (((b) * 2 + (h)) * HTB)
#define G8_SB(b, h) ((4 + (b) * 2 + (h)) * HTB)
#define G8_STAGE2(bufoff, gbase, v0, v1) do { \
        __builtin_amdgcn_global_load_lds((const unsigned*)((const char*)(gbase) + (v0)), (LAS unsigned*)(lds + (bufoff) + ldsw), 16, 0, 0); \
        __builtin_amdgcn_global_load_lds((const unsigned*)((const char*)(gbase) + (v1)), (LAS unsigned*)(lds + (bufoff) + ldsw + 8192), 16, 0, 0); } while (0)
#define G8_STAGEB(bufoff, gbase) G8_STAGE2(bufoff, gbase, voffB[0], voffB[1])
#define G8_LDA(dst, b, h) do { _Pragma("unroll") for (int m = 0; m < 4; ++m) _Pragma("unroll") for (int k = 0; k < 2; ++k) dst[m][k] = *(const LAS bf16x8*)(lds + G8_SA(b, h) + aoff + m * 2048 + k * 1024); } while (0)
#define G8_LDB(dst, b, h) do { _Pragma("unroll") for (int n = 0; n < 2; ++n) _Pragma("unroll") for (int k = 0; k < 2; ++k) dst[n][k] = *(const LAS bf16x8*)(lds + G8_SB(b, h) + boff + n * 2048 + k * 1024); } while (0)
#define G8_MMA(ai, bj, At, Bt) do { __builtin_amdgcn_s_setprio(1); _Pragma("unroll") for (int m = 0; m < 4; ++m) _Pragma("unroll") for (int n = 0; n < 2; ++n) _Pragma("unroll") for (int k = 0; k < 2; ++k) \
        acc[ai][bj][m][n] = __builtin_amdgcn_mfma_f32_16x16x32_bf16(Bt[n][k], At[m][k], acc[ai][bj][m][n], 0, 0, 0); __builtin_amdgcn_s_setprio(0); } while (0)
#define G8_WAIT_V(n) asm volatile("s_waitcnt vmcnt(" #n ")" ::: "memory")
#define G8_WAIT_L(n) asm volatile("s_waitcnt lgkmcnt(" #n ")" ::: "memory")
#define G8_BAR __builtin_amdgcn_s_barrier()
#define G8_SCHED __builtin_amdgcn_sched_barrier(0)
#define G8_SETVA(dst, u) do { int _t2 = tid; if (GATHER) asm volatile("" : "+v"(_t2)); _Pragma("unroll") for (int _h = 0; _h < 2; ++_h) _Pragma("unroll") for (int _i = 0; _i < 2; ++_i) { \
        int _R, _C; stage_rc(_t2 * 16 + _i * 8192, _R, _C); \
        const unsigned _rl = (unsigned)(_h * HALF + _R); unsigned _row = _rl; \
        if (GATHER) { _row = 0u; if (_rl < (unsigned)(u).nvalid) _row = (unsigned)(u).rows[_rl] >> 3; } \
        dst[_h][_i] = (_row * (unsigned)lda + (unsigned)_C) * 2u; } } while (0)
    Unit cur, nxt; int ui = 0;
    if (!S.next(0, cur)) return;
    f32x4 acc[2][2][4][2];
#pragma unroll
    for (int a = 0; a < 2; ++a)
#pragma unroll
        for (int b = 0; b < 2; ++b)
#pragma unroll
            for (int m = 0; m < 4; ++m)
#pragma unroll
                for (int n = 0; n < 2; ++n) acc[a][b][m][n] = (f32x4){0.f, 0.f, 0.f, 0.f};
    bf16x8 At[4][2], B0[2][2], B1[2][2];
    unsigned vAc[2][2]; unsigned xl00 = 0, xl01 = 0, xl10 = 0, xl11 = 0;
    G8_SETVA(vAc, cur);
    const char* cA = cur.A; const char* cB = cur.B;
    G8_STAGEB(G8_SB(0, 0), cB); G8_STAGEB(G8_SB(0, 1), cB + hstepB); G8_STAGE2(G8_SA(0, 0), cA, vAc[0][0], vAc[0][1]); G8_STAGE2(G8_SA(0, 1), cA, vAc[1][0], vAc[1][1]);
    if (wr == 1) G8_BAR;
    G8_WAIT_V(2); G8_BAR;
    G8_STAGEB(G8_SB(1, 0), cB + kstep); G8_STAGE2(G8_SA(1, 0), cA + kstep, vAc[0][0], vAc[0][1]); G8_STAGEB(G8_SB(1, 1), cB + hstepB + kstep);
    G8_WAIT_V(6); G8_BAR;
    for (;;) {
        const bool has_next = S.next(ui + 1, nxt);
        const char* nA = has_next ? nxt.A : cA; const char* nB = has_next ? nxt.B : cB;
        if (GATHER) { unsigned vAn[2][2]; if (has_next) { G8_SETVA(vAn, nxt); } else {
#pragma unroll
            for (int h = 0; h < 2; ++h)
#pragma unroll
                for (int i = 0; i < 2; ++i) vAn[h][i] = vAc[h][i]; }
            *stash = (v4u){vAn[0][0], vAn[0][1], vAn[1][0], vAn[1][1]}; }
#pragma unroll 1
        for (int t = 0; t < nt; t += 2) {
            const bool last = (t == nt - 2);
            const char* a1 = cA + (size_t)(t + 1) * kstep;
            const char* a2 = last ? nA : cA + (size_t)(t + 2) * kstep; const char* b2 = last ? nB : cB + (size_t)(t + 2) * kstep;
            const char* a3 = a2 + kstep; const char* b3 = b2 + kstep;
            unsigned x00 = vAc[0][0], x01 = vAc[0][1], x10 = vAc[1][0], x11 = vAc[1][1];
            if (GATHER) { if (last) { const v4u sv = *stash; x00 = sv.x; x01 = sv.y; x10 = sv.z; x11 = sv.w; } xl00 = x00; xl01 = x01; xl10 = x10; xl11 = x11; }
            G8_LDB(B0, 0, 0); G8_LDB(B1, 0, 1); G8_SCHED; G8_LDA(At, 0, 0); G8_STAGE2(G8_SA(1, 1), a1, vAc[1][0], vAc[1][1]);
            G8_WAIT_V(8); G8_WAIT_L(0); G8_BAR; G8_MMA(0, 0, At, B0); G8_MMA(0, 1, At, B1); G8_BAR; G8_SCHED;
            G8_LDA(At, 0, 1); G8_STAGEB(G8_SB(0, 0), b2); G8_STAGEB(G8_SB(0, 1), b2 + hstepB); G8_STAGE2(G8_SA(0, 0), a2, x00, x01);
            G8_WAIT_V(8); G8_WAIT_L(0); G8_BAR; G8_MMA(1, 0, At, B0); G8_MMA(1, 1, At, B1); G8_BAR; G8_SCHED;
            G8_LDB(B0, 1, 0); G8_LDB(B1, 1, 1); G8_SCHED; G8_LDA(At, 1, 0); G8_STAGE2(G8_SA(0, 1), a2, x10, x11);
            G8_WAIT_V(8); G8_WAIT_L(0); G8_BAR; G8_MMA(0, 0, At, B0); G8_MMA(0, 1, At, B1); G8_BAR; G8_SCHED;
            G8_LDA(At, 1, 1); G8_STAGEB(G8_SB(1, 0), b3); G8_STAGEB(G8_SB(1, 1), b3 + hstepB); G8_STAGE2(G8_SA(1, 0), a3, x00, x01);
            G8_WAIT_V(8); G8_WAIT_L(0); G8_BAR; G8_MMA(1, 0, At, B0); G8_MMA(1, 1, At, B1); G8_BAR; G8_SCHED;
        }
        if (wr == 0) G8_BAR;
        E(acc, cur, wr, wc, fr, fq);
        if (!has_next) break;
#pragma unroll
        for (int a = 0; a < 2; ++a)
#pragma unroll
            for (int b = 0; b < 2; ++b)
#pragma unroll
                for (int m = 0; m < 4; ++m)
#pragma unroll
                    for (int n = 0; n < 2; ++n) acc[a][b][m][n] = (f32x4){0.f, 0.f, 0.f, 0.f};
        cur = nxt; cA = nA; cB = nB; ++ui;
        if (GATHER) { vAc[0][0] = xl00; vAc[0][1] = xl01; vAc[1][0] = xl10; vAc[1][1] = xl11; }
        if (wr == 1) G8_BAR;
    }
    G8_WAIT_V(0);
    G8_BAR;
#undef G8_SA
#undef G8_SB
#undef G8_STAGE2
#undef G8_STAGEB
#undef G8_LDA
#undef G8_LDB
#undef G8_MMA
#undef G8_WAIT_V
#undef G8_WAIT_L
#undef G8_BAR
#undef G8_SCHED
#undef G8_SETVA
}

struct DenseSched {
    const char* A; const char* B; size_t a_tile, b_tile, agrp_stride; int agrp_shift, nM, nN, nwg, G, c;
    __device__ __forceinline__ void init(const void* A_, const void* B_, int M, int N, int lda, int ldb, int G_, int c_) {
        A = (const char*)A_; B = (const char*)B_; a_tile = (size_t)BM * lda * 2; b_tile = (size_t)BM * ldb * 2; agrp_stride = 0; agrp_shift = 0; nM = M / BM; nN = N / BM; nwg = nM * nN; G = G_; c = c_; }
    __device__ __forceinline__ bool next(int i, Unit& u) const {
        const long L = (long)i * G + c; if (L >= nwg) return false;
        int wgid = (int)L; { const int q = nwg / NXCD, r = nwg % NXCD, xcd = wgid % NXCD, off = wgid / NXCD; wgid = (xcd < r ? xcd * (q + 1) : r * (q + 1) + (xcd - r) * q) + off; }
        const int nig = WGM * nN, gid = wgid / nig, fm = gid * WGM, gsz = (nM - fm) < WGM ? (nM - fm) : WGM;
        u.pm = fm + ((wgid % nig) % gsz); u.pn = (wgid % nig) / gsz;
        u.A = A + (size_t)u.pm * a_tile + (size_t)(u.pn >> agrp_shift) * agrp_stride; u.B = B + (size_t)u.pn * b_tile; u.rows = nullptr; u.nvalid = BM; u.aux = 0; return true;
    }
};
template <int NPN, bool GATHERED>
struct ExpertSched {
    const LAS int* tpref; const LAS int* cnt; const char* A; const char* B; const int* tok; size_t b_exp, b_tile, a_tile; int NU, G, c;
    __device__ __forceinline__ bool next(int i, Unit& u) const {
        const int L = i * G + c; if (L >= NU) return false;
        const int tile = L / NPN, pn = L % NPN;
        int e = 0; while (__builtin_amdgcn_readfirstlane(tpref[e + 1]) <= tile) ++e;
        const int rb = tile - __builtin_amdgcn_readfirstlane(tpref[e]);
        u.pm = e; u.pn = pn; u.aux = tile * BM; u.nvalid = __builtin_amdgcn_readfirstlane(cnt[e]) - rb * BM; if (u.nvalid > BM) u.nvalid = BM;
        u.rows = tok + (size_t)e * CAP + rb * BM;
        u.A = GATHERED ? A : A + (size_t)tile * a_tile; u.B = B + (size_t)e * b_exp + (size_t)pn * b_tile; return true;
    }
};

struct EpiBf16 {
    static constexpr bool PERM = true;
    bf16* O; int ldc; int qscale;
    __device__ __forceinline__ void operator()(const f32x4 (&acc)[2][2][4][2], const Unit& u, int wr, int wc, int fr, int fq) const {
        asm volatile("" : "+v"(fr), "+v"(fq));
        const int row0 = u.pm * BM + wr * 64 + fr, col0 = u.pn * BM + wc * 32 + 8 * fq;
        const float sc = (qscale && (u.pn % 6) < 2) ? 0.125f : 1.0f;
#pragma unroll
        for (int ai = 0; ai < 2; ++ai)
#pragma unroll
            for (int m = 0; m < 4; ++m) { bf16* rowp = O + (size_t)(row0 + ai * HALF + m * 16) * ldc + col0;
#pragma unroll
                for (int bj = 0; bj < 2; ++bj) { const f32x4 v0 = acc[ai][bj][m][0] * sc, v1 = acc[ai][bj][m][1] * sc;
                    v4u w; w.x = cvt_pk_bf16(v0[0], v0[1]); w.y = cvt_pk_bf16(v0[2], v0[3]); w.z = cvt_pk_bf16(v1[0], v1[1]); w.w = cvt_pk_bf16(v1[2], v1[3]);
                    *(v4u*)(rowp + bj * HALF) = w; } }
    }
};
struct EpiScaleBf16 {
    static constexpr bool PERM = true;
    bf16* O; int ldc; const float* scale;
    __device__ __forceinline__ void operator()(const f32x4 (&acc)[2][2][4][2], const Unit& u, int wr, int wc, int fr, int fq) const {
        asm volatile("" : "+v"(fr), "+v"(fq));
        const int row0 = u.pm * BM + wr * 64 + fr, col0 = u.pn * BM + wc * 32 + 8 * fq;
        f32x4 sv[2][2];
#pragma unroll
        for (int bj = 0; bj < 2; ++bj)
#pragma unroll
            for (int n = 0; n < 2; ++n) sv[bj][n] = *(const f32x4*)(scale + col0 + bj * HALF + 4 * n);
#pragma unroll
        for (int ai = 0; ai < 2; ++ai)
#pragma unroll
            for (int m = 0; m < 4; ++m) { bf16* rowp = O + (size_t)(row0 + ai * HALF + m * 16) * ldc + col0;
#pragma unroll
                for (int bj = 0; bj < 2; ++bj) { const f32x4 v0 = acc[ai][bj][m][0] * sv[bj][0], v1 = acc[ai][bj][m][1] * sv[bj][1];
                    v4u w; w.x = cvt_pk_bf16(v0[0], v0[1]); w.y = cvt_pk_bf16(v0[2], v0[3]); w.z = cvt_pk_bf16(v1[0], v1[1]); w.w = cvt_pk_bf16(v1[2], v1[3]);
                    *(v4u*)(rowp + bj * HALF) = w; } }
    }
};
struct EpiResid {
    static constexpr bool PERM = false;
    const float* X; float* Y;
    __device__ __forceinline__ void operator()(const f32x4 (&acc)[2][2][4][2], const Unit& u, int wr, int wc, int fr, int fq) const {
        asm volatile("" : "+v"(fr), "+v"(fq));
        const int row0 = u.pm * BM + wr * 64 + fr, col0 = u.pn * BM + wc * 32 + 4 * fq;
#pragma unroll
        for (int ai = 0; ai < 2; ++ai)
#pragma unroll
            for (int m = 0; m < 4; ++m) { const size_t off = (size_t)(row0 + ai * HALF + m * 16) * D + col0;
#pragma unroll
                for (int bj = 0; bj < 2; ++bj)
#pragma unroll
                    for (int n = 0; n < 2; ++n) { const f32x4 xv = *(const f32x4*)(X + off + bj * HALF + n * 16); *(f32x4*)(Y + off + bj * HALF + n * 16) = xv * ALPHA + acc[ai][bj][m][n]; } }
    }
};
struct EpiResidLN {
    static constexpr bool PERM = false;
    const float* X; const float* st; const float* g; const float* b; float* Y; float* pst; int mode;
    __device__ __forceinline__ void operator()(const f32x4 (&acc)[2][2][4][2], const Unit& u, int wr, int wc, int fr, int fq) const {
        asm volatile("" : "+v"(fr), "+v"(fq));
        const int row0 = u.pm * BM + wr * 64 + fr, col0 = u.pn * BM + wc * 32 + 4 * fq, lane = fq * 16 + fr;
        f32x4 gv[2][2], bv[2][2];
#pragma unroll
        for (int bj = 0; bj < 2; ++bj)
#pragma unroll
            for (int n = 0; n < 2; ++n) { gv[bj][n] = (f32x4){1.f, 1.f, 1.f, 1.f}; bv[bj][n] = (f32x4){0.f, 0.f, 0.f, 0.f};
                if (mode) { gv[bj][n] = *(const f32x4*)(g + col0 + bj * HALF + n * 16); bv[bj][n] = *(const f32x4*)(b + col0 + bj * HALF + n * 16); } }
#pragma unroll
        for (int ai = 0; ai < 2; ++ai)
#pragma unroll
            for (int m = 0; m < 4; ++m) { const int row = row0 + ai * HALF + m * 16; const size_t off = (size_t)row * D + col0;
                float mean = 0.f, rstd = 1.f; if (mode) { const f32x2 sv = *(const f32x2*)(st + 2 * row); mean = sv.x; rstd = sv.y; }
                float sm = 0.f, sq = 0.f;
#pragma unroll
                for (int bj = 0; bj < 2; ++bj)
#pragma unroll
                    for (int n = 0; n < 2; ++n) { f32x4 xv = *(const f32x4*)(X + off + bj * HALF + n * 16);
                        if (mode) xv = (xv - mean) * rstd * gv[bj][n] + bv[bj][n];
                        const f32x4 y = xv * ALPHA + acc[ai][bj][m][n]; *(f32x4*)(Y + off + bj * HALF + n * 16) = y;
                        sm += (y[0] + y[1]) + (y[2] + y[3]); sq += (y[0] * y[0] + y[1] * y[1]) + (y[2] * y[2] + y[3] * y[3]); }
                sm += shfl_x(sm, 16, lane); sm += shfl_x(sm, 32, lane); sq += shfl_x(sq, 16, lane); sq += shfl_x(sq, 32, lane);
                if (fq == 0) *(f32x2*)(pst + ((size_t)row * 32 + u.pn * 4 + wc) * 2) = (f32x2){sm, sq}; }
    }
};
struct EpiConvIn {
    static constexpr bool PERM = true;
    bf16* UC; bf16* BGp;
    __device__ __forceinline__ void operator()(const f32x4 (&acc)[2][2][4][2], const Unit& u, int wr, int wc, int fr, int fq) const {
        asm volatile("" : "+v"(fr), "+v"(fq));
        const int row0 = u.pm * BM + wr * 64 + fr, cw = wc * 32 + 8 * fq;
        if (u.pn < 16) {
#pragma unroll
            for (int ai = 0; ai < 2; ++ai)
#pragma unroll
                for (int m = 0; m < 4; ++m) { bf16* rowp = UC + (size_t)(row0 + ai * HALF + m * 16) * D + u.pn * HALF + cw;
                    const f32x4 v0 = acc[ai][0][m][0] * acc[ai][1][m][0], v1 = acc[ai][0][m][1] * acc[ai][1][m][1];
                    v4u w; w.x = cvt_pk_bf16(v0[0], v0[1]); w.y = cvt_pk_bf16(v0[2], v0[3]); w.z = cvt_pk_bf16(v1[0], v1[1]); w.w = cvt_pk_bf16(v1[2], v1[3]);
                    *(v4u*)rowp = w; }
        } else {
#pragma unroll
            for (int ai = 0; ai < 2; ++ai)
#pragma unroll
                for (int m = 0; m < 4; ++m) { bf16* rowp = BGp + (size_t)(row0 + ai * HALF + m * 16) * D + (u.pn - 16) * BM + cw;
#pragma unroll
                    for (int bj = 0; bj < 2; ++bj) { const f32x4 v0 = acc[ai][bj][m][0], v1 = acc[ai][bj][m][1];
                        v4u w; w.x = cvt_pk_bf16(v0[0], v0[1]); w.y = cvt_pk_bf16(v0[2], v0[3]); w.z = cvt_pk_bf16(v1[0], v1[1]); w.w = cvt_pk_bf16(v1[2], v1[3]);
                        *(v4u*)(rowp + bj * HALF) = w; } }
        }
    }
};
__device__ __forceinline__ f32x4 silu_mul(f32x4 g, f32x4 uu) {
    f32x4 r;
#pragma unroll
    for (int j = 0; j < 4; ++j) r[j] = g[j] * __builtin_amdgcn_rcpf(1.0f + __expf(-g[j])) * uu[j];
    return r;
}
struct EpiExpertGU {
    static constexpr bool PERM = true;
    bf16* H;
    __device__ __forceinline__ void operator()(const f32x4 (&acc)[2][2][4][2], const Unit& u, int wr, int wc, int fr, int fq) const {
        asm volatile("" : "+v"(fr), "+v"(fq));
        const float* gates = (const float*)((const char*)u.rows + (WS_LGATE - WS_LTOK));
        const int cw = wc * 32 + 8 * fq;
#pragma unroll
        for (int ai = 0; ai < 2; ++ai)
#pragma unroll
            for (int m = 0; m < 4; ++m) { const int r = ai * HALF + wr * 64 + m * 16 + fr;
                if (r < u.nvalid) { const float gt = gates[r]; const unsigned pid = (unsigned)u.rows[r];
                    const f32x4 v0 = silu_mul(acc[ai][0][m][0], acc[ai][1][m][0]) * gt, v1 = silu_mul(acc[ai][0][m][1], acc[ai][1][m][1]) * gt;
                    v4u w; w.x = cvt_pk_bf16(v0[0], v0[1]); w.y = cvt_pk_bf16(v0[2], v0[3]); w.z = cvt_pk_bf16(v1[0], v1[1]); w.w = cvt_pk_bf16(v1[2], v1[3]);
                    *(v4u*)(H + (size_t)pid * EDIM + cw) = w; } }
    }
};
struct EpiSharedGU {
    static constexpr bool PERM = true;
    bf16* HS;
    __device__ __forceinline__ void operator()(const f32x4 (&acc)[2][2][4][2], const Unit& u, int wr, int wc, int fr, int fq) const {
        asm volatile("" : "+v"(fr), "+v"(fq));
        const int row0 = u.pm * BM + wr * 64 + fr, cw = u.pn * HALF + wc * 32 + 8 * fq;
#pragma unroll
        for (int ai = 0; ai < 2; ++ai)
#pragma unroll
            for (int m = 0; m < 4; ++m) {
                const f32x4 v0 = silu_mul(acc[ai][0][m][0], acc[ai][1][m][0]), v1 = silu_mul(acc[ai][0][m][1], acc[ai][1][m][1]);
                v4u w; w.x = cvt_pk_bf16(v0[0], v0[1]); w.y = cvt_pk_bf16(v0[2], v0[3]); w.z = cvt_pk_bf16(v1[0], v1[1]); w.w = cvt_pk_bf16(v1[2], v1[3]);
                *(v4u*)(HS + (size_t)(row0 + ai * HALF + m * 16) * SDIM + cw) = w; }
    }
};
struct EpiDownY {
    static constexpr bool PERM = true;
    bf16* Y;
    __device__ __forceinline__ void operator()(const f32x4 (&acc)[2][2][4][2], const Unit& u, int wr, int wc, int fr, int fq) const {
        asm volatile("" : "+v"(fr), "+v"(fq));
        const int col0 = u.pn * BM + wc * 32 + 8 * fq;
#pragma unroll
        for (int ai = 0; ai < 2; ++ai)
#pragma unroll
            for (int m = 0; m < 4; ++m) { const int r = ai * HALF + wr * 64 + m * 16 + fr; bf16* rowp = Y + (size_t)(u.aux + r) * D + col0;
#pragma unroll
                for (int bj = 0; bj < 2; ++bj) { const f32x4 v0 = acc[ai][bj][m][0], v1 = acc[ai][bj][m][1];
                    v4u w; w.x = cvt_pk_bf16(v0[0], v0[1]); w.y = cvt_pk_bf16(v0[2], v0[3]); w.z = cvt_pk_bf16(v1[0], v1[1]); w.w = cvt_pk_bf16(v1[2], v1[3]);
                    *(v4u*)(rowp + bj * HALF) = w; } }
    }
};
}

struct Args { const float* in[19]; float* out; unsigned char* ws; int ph_lo, ph_hi; };
struct Frame {
    LAS unsigned char* lds; unsigned* ctl; unsigned char* ws;
    int tid, lane, wave, G, bid;
};
enum { IN_X = 0, IN_RELB, IN_PWIN, IN_PWG, IN_PSC, IN_PWOUT, IN_DQKV, IN_DOUT, IN_CWIN, IN_CW, IN_CWOUT, IN_LNG, IN_LNB, IN_RW, IN_RB, IN_EGU, IN_ED, IN_SGU, IN_SD };

#define CAS __attribute__((address_space(4)))
typedef const CAS unsigned char* KP;
__device__ __forceinline__ const float* ain(KP kp, int i) { return (const float*)((const GAS float* const CAS*)kp)[i]; }
__device__ __forceinline__ float* aout(KP kp) { return (float*)((GAS float* const CAS*)kp)[19]; }
__device__ __forceinline__ void tr_item(const float* W, int K, int N, bf16* WT, int dstK, int mode, LAS float* scr, int item, int lane) {
    const int nblk = N / 32, kb = item / nblk, nb = item % nblk, k0 = 64 * kb, n0 = 32 * nb;
    int r0 = n0;
    if (mode == 1) { const int part = n0 / 2048, j = n0 % 2048; r0 = (part == 0) ? 4096 + j : 256 * (j / 128) + (part == 2 ? 128 : 0) + (j % 128); }
    if (mode == 2) { const int part = n0 / 256, j = n0 % 256; r0 = 256 * (j / 128) + 128 * part + (j % 128); }
#pragma unroll 8
    for (int i = 0; i < 32; ++i) { const int kk = 2 * i + (lane >> 5); scr[kk * 33 + (lane & 31)] = W[(size_t)(k0 + kk) * N + n0 + (lane & 31)]; }
    LDS_WAIT(); asm volatile("" ::: "memory");
    const int c = lane & 7;
#pragma unroll
    for (int j = 0; j < 4; ++j) { const int n = (lane >> 3) + 8 * j; const LAS float* s = scr + (8 * c) * 33 + n;
        v4u o; o.x = pk2(s[0 * 33], s[1 * 33]); o.y = pk2(s[2 * 33], s[3 * 33]); o.z = pk2(s[4 * 33], s[5 * 33]); o.w = pk2(s[6 * 33], s[7 * 33]);
        *(v4u*)(WT + (size_t)(r0 + n) * dstK + k0 + 8 * c) = o; }
    LDS_WAIT(); asm volatile("" ::: "memory");
}
__device__ __forceinline__ void phase_prologue(const Frame& F, KP kp) {
    LAS float* scr = (LAS float*)(F.lds + F.wave * 16384);
    const int gw = F.bid * 8 + F.wave, NGW = F.G * 8;
    constexpr int I0 = 2 * 2048, I1 = 8 * 128, I2 = 2 * 2048, I3 = 4608, I4 = 512, I5 = 6144, I6 = 2048, I7 = 4 * 512, I8 = 4 * 256, I9 = 256 * 256, I10 = 256 * 128;
    constexpr int NITEMS = I0 + I1 + I2 + I3 + I4 + I5 + I6 + I7 + I8 + I9 + I10;
    unsigned char* ws = F.ws;
    for (int it = gw; it < NITEMS; it += NGW) {
        int r = it;
        if (r < I0) { const int b = r / 2048; tr_item(ain(kp, IN_PWIN) + (size_t)b * D * D, D, D, (bf16*)(ws + WS_W_POOL_IN) + (size_t)b * D * D, D, 0, scr, r % 2048, F.lane); continue; } r -= I0;
        if (r < I1) { const int b = r / 128; tr_item(ain(kp, IN_PWG) + (size_t)b * 512 * 512, 512, 512, (bf16*)(ws + WS_W_POOL_G) + (size_t)b * 512 * 512, 512, 0, scr, r % 128, F.lane); continue; } r -= I1;
        if (r < I2) { const int b = r / 2048; tr_item(ain(kp, IN_PWOUT) + (size_t)b * D * D, D, D, (bf16*)(ws + WS_W_POOL_OUT) + (size_t)b * D * D, D, 0, scr, r % 2048, F.lane); continue; } r -= I2;
        if (r < I3) { tr_item(ain(kp, IN_DQKV), D, QKVC, (bf16*)(ws + WS_W_DIL_QKV), D, 0, scr, r, F.lane); continue; } r -= I3;
        if (r < I4) { tr_item(ain(kp, IN_DOUT), DILW, D, (bf16*)(ws + WS_W_DIL_OUT), DILW, 0, scr, r, F.lane); continue; } r -= I4;
        if (r < I5) { tr_item(ain(kp, IN_CWIN), D, 3 * D, (bf16*)(ws + WS_W_CONV_IN), D, 1, scr, r, F.lane); continue; } r -= I5;
        if (r < I6) { tr_item(ain(kp, IN_CWOUT), D, D, (bf16*)(ws + WS_W_CONV_OUT), D, 0, scr, r, F.lane); continue; } r -= I6;
        if (r < I7) { const int b = r / 512; tr_item(ain(kp, IN_SGU) + (size_t)b * D * 512, D, 512, (bf16*)(ws + WS_W_SH_GU) + (size_t)b * 512 * D, D, 2, scr, r % 512, F.lane); continue; } r -= I7;
        if (r < I8) { const int b = r / 256; tr_item(ain(kp, IN_SD) + (size_t)b * SDIM * D, SDIM, D, (bf16*)(ws + WS_W_SH_D) + (size_t)b * D * SDIM, SDIM, 0, scr, r % 256, F.lane); continue; } r -= I8;
        if (r < I9) { const int b = r / 256; tr_item(ain(kp, IN_EGU) + (size_t)b * D * 256, D, 256, (bf16*)(ws + WS_W_EX_GU) + (size_t)b * 256 * D, D, 0, scr, r % 256, F.lane); continue; } r -= I9;
        { const int b = r / 128; tr_item(ain(kp, IN_ED) + (size_t)b * EDIM * D, EDIM, D, (bf16*)(ws + WS_W_EX_D) + (size_t)b * D * EDIM, EDIM, 0, scr, r % 128, F.lane); }
    }
    const size_t gt = (size_t)F.bid * 512 + F.tid, GT = (size_t)F.G * 512;
    { const float* rw = ain(kp, IN_RW); bf16* wh = (bf16*)(ws + WS_RWH); bf16* wl = (bf16*)(ws + WS_RWL);
      for (size_t i = gt; i < (size_t)DEPTH * NEXP * D / 8; i += GT) { const size_t k8 = i % (D / 8), e = (i / (D / 8)) % NEXP, l = i / ((size_t)NEXP * D / 8);
          float v[8]; unsigned hi[8], lo[8];
#pragma unroll
          for (int j = 0; j < 8; ++j) { v[j] = rw[(l * D + k8 * 8 + j) * NEXP + e]; hi[j] = f2bf(v[j]); lo[j] = f2bf(v[j] - __builtin_bit_cast(float, hi[j] << 16)); }
          v4u a, b2; a.x = hi[0] | (hi[1] << 16); a.y = hi[2] | (hi[3] << 16); a.z = hi[4] | (hi[5] << 16); a.w = hi[6] | (hi[7] << 16);
          b2.x = lo[0] | (lo[1] << 16); b2.y = lo[2] | (lo[3] << 16); b2.z = lo[4] | (lo[5] << 16); b2.w = lo[6] | (lo[7] << 16);
          *(v4u*)(wh + (l * NEXP + e) * D + k8 * 8) = a; *(v4u*)(wl + (l * NEXP + e) * D + k8 * 8) = b2; } }
    const float* x = ain(kp, IN_X); bf16* xb = (bf16*)(ws + WS_XB);
    for (size_t i = gt; i < (size_t)T * D / 8; i += GT) { const f32x4 p = *(const f32x4*)(x + i * 8), q = *(const f32x4*)(x + i * 8 + 4);
        v4u w; w.x = pk2(p[0], p[1]); w.y = pk2(p[2], p[3]); w.z = pk2(q[0], q[1]); w.w = pk2(q[2], q[3]); *(v4u*)(xb + i * 8) = w; }
}

__device__ __forceinline__ void unpack8(const v4u w, float (&f)[8]) { f[0] = bflo(w.x); f[1] = bfhi(w.x); f[2] = bflo(w.y); f[3] = bfhi(w.y); f[4] = bflo(w.z); f[5] = bfhi(w.z); f[6] = bflo(w.w); f[7] = bfhi(w.w); }
__device__ __forceinline__ void phase_pool(const Frame& F, const bf16* U, bf16* PL) {
    for (int it = F.bid * 512 + F.tid; it < (T / 32) * 256; it += F.G * 512) {
        const int cv = it & 255, ch = it >> 8, col = cv * 8, w = 2 << (col >> 9);
        const int row0 = ch * 32, pos0 = row0 & (SEQ - 1);
        float s[8], uu[8];
#pragma unroll
        for (int j = 0; j < 8; ++j) s[j] = 0.f;
        for (int j = 1; j < w; ++j) if (pos0 - j >= 0) { unpack8(*(const v4u*)(U + (size_t)(row0 - j) * D + col), uu);
#pragma unroll
            for (int q = 0; q < 8; ++q) s[q] += uu[q]; }
        for (int r = 0; r < 32; ++r) {
            const int t = row0 + r, pos = pos0 + r;
            unpack8(*(const v4u*)(U + (size_t)t * D + col), uu);
            const float inv = 1.0f / (float)((pos + 1) < w ? (pos + 1) : w);
            float o[8];
#pragma unroll
            for (int q = 0; q < 8; ++q) { s[q] += uu[q]; o[q] = s[q] * inv - uu[q]; }
            v4u ww; ww.x = pk2(o[0], o[1]); ww.y = pk2(o[2], o[3]); ww.z = pk2(o[4], o[5]); ww.w = pk2(o[6], o[7]);
            *(v4u*)(PL + (size_t)t * D + col) = ww;
            if (pos - w + 1 >= 0) { unpack8(*(const v4u*)(U + (size_t)(t - w + 1) * D + col), uu);
#pragma unroll
                for (int q = 0; q < 8; ++q) s[q] -= uu[q]; }
        }
    }
}

__device__ __forceinline__ void phase_conv(const Frame& F, const bf16* UC, const bf16* BGp, const float* cw, bf16* Z) {
    for (int it = F.bid * 512 + F.tid; it < T * 256; it += F.G * 512) {
        const int cv = it & 255, t = it >> 8, col = cv * 8, pos = t & (SEQ - 1);
        float u0[8], u1[8], u2[8], bb[8], o[8];
        unpack8(*(const v4u*)(UC + (size_t)t * D + col), u2);
        if (pos >= 1) unpack8(*(const v4u*)(UC + (size_t)(t - 1) * D + col), u1); else {
#pragma unroll
            for (int q = 0; q < 8; ++q) u1[q] = 0.f; }
        if (pos >= 2) unpack8(*(const v4u*)(UC + (size_t)(t - 2) * D + col), u0); else {
#pragma unroll
            for (int q = 0; q < 8; ++q) u0[q] = 0.f; }
        unpack8(*(const v4u*)(BGp + (size_t)t * D + col), bb);
#pragma unroll
        for (int q = 0; q < 8; ++q) o[q] = bb[q] * (cw[col + q] * u0[q] + cw[D + col + q] * u1[q] + cw[2 * D + col + q] * u2[q]);
        v4u ww; ww.x = pk2(o[0], o[1]); ww.y = pk2(o[2], o[3]); ww.z = pk2(o[4], o[5]); ww.w = pk2(o[6], o[7]);
        *(v4u*)(Z + (size_t)t * D + col) = ww;
    }
}

__device__ __forceinline__ int t5_bucket(int dist) {
    if (dist < 16) return dist;
    int large = 16 + (int)(logf((float)dist / 16.0f) / logf(128.0f) * 16.0f);
    return large < 31 ? large : 31;
}
constexpr int AT_KS = 0, AT_KSTR = 144, AT_VT = 256 * 144, AT_VSTR = 520, AT_BIAS = AT_VT + 64 * 520;
__device__ __forceinline__ void phase_attn(const Frame& F, const bf16* QKV, const float* relb, bf16* OG, float* LSE) {
    LAS unsigned char* lds = F.lds;
    const int tid = F.tid, lane = F.lane, w = tid >> 6, fr = lane & 15, fq = lane >> 4;
    for (int unit = F.bid; unit < NBATCH * 3 * 8 * 16; unit += F.G) {
        const int cmb = unit & 15, h = (unit >> 4) & 7, g = (unit >> 7) % 3, b = unit / 384;
        const int dsh = 2 * g, dil = 1 << dsh, r = cmb & (dil - 1), nb = cmb >> dsh;
        const bf16* base = QKV + (size_t)b * SEQ * QKVC + g * 1536 + h * 64;
        __syncthreads();
        {
            const int key = tid >> 1, half = tid & 1, jk = (nb - 1) * 128 + key;
            v4u kv[4], vv[4];
            if (jk >= 0) { const bf16* rp = base + (size_t)(jk * dil + r) * QKVC + half * 32;
#pragma unroll
                for (int i = 0; i < 4; ++i) { kv[i] = *(const v4u*)(rp + 512 + 8 * i); vv[i] = *(const v4u*)(rp + 1024 + 8 * i); } }
            else {
#pragma unroll
                for (int i = 0; i < 4; ++i) { kv[i] = (v4u){0u, 0u, 0u, 0u}; vv[i] = (v4u){0u, 0u, 0u, 0u}; } }
#pragma unroll
            for (int i = 0; i < 4; ++i) *(LAS v4u*)(lds + AT_KS + key * AT_KSTR + half * 64 + 16 * i) = kv[i];
#pragma unroll
            for (int i = 0; i < 4; ++i) {
                const unsigned ww[4] = {vv[i].x, vv[i].y, vv[i].z, vv[i].w};
#pragma unroll
                for (int q = 0; q < 4; ++q) { const int d = half * 32 + 8 * i + 2 * q;
                    *(LAS unsigned short*)(lds + AT_VT + d * AT_VSTR + key * 2) = (unsigned short)(ww[q] & 0xffffu);
                    *(LAS unsigned short*)(lds + AT_VT + (d + 1) * AT_VSTR + key * 2) = (unsigned short)(ww[q] >> 16); } }
            if (tid <= 128) ((LAS float*)(lds + AT_BIAS))[tid] = relb[t5_bucket(tid * dil) * 24 + g * 8 + h];
        }
        __syncthreads();
        int qi = 16 * w + fr; asm volatile("" : "+v"(qi));
        const int jq = nb * 128 + qi, tq = jq * dil + r;
        const bf16* qp = base + (size_t)tq * QKVC + 8 * fq;
        const bf16x8 q0 = *(const bf16x8*)qp, q1 = *(const bf16x8*)(qp + 32);
        f32x4 s[9]; float mx = -INFINITY;
#pragma unroll
        for (int kt = 0; kt < 9; ++kt) {
            const int kb = 16 * (w + kt);
            const bf16x8 k0 = *(const LAS bf16x8*)(lds + AT_KS + (kb + fr) * AT_KSTR + fq * 16), k1 = *(const LAS bf16x8*)(lds + AT_KS + (kb + fr) * AT_KSTR + 64 + fq * 16);
            f32x4 a = (f32x4){0.f, 0.f, 0.f, 0.f};
            a = __builtin_amdgcn_mfma_f32_16x16x32_bf16(k0, q0, a, 0, 0, 0);
            a = __builtin_amdgcn_mfma_f32_16x16x32_bf16(k1, q1, a, 0, 0, 0);
#pragma unroll
            for (int i = 0; i < 4; ++i) { const int kl = kb + 4 * fq + i, rel = qi + 128 - kl;
                const bool ok = (rel >= 0) && (rel <= 128) && (nb > 0 || kl >= 128);
                const int rc = rel < 0 ? 0 : (rel > 128 ? 128 : rel);
                const float v = ok ? a[i] + ((LAS float*)(lds + AT_BIAS))[rc] : -INFINITY;
                a[i] = v; mx = fmaxf(mx, v); }
            s[kt] = a;
        }
        mx = fmaxf(mx, shfl_x(mx, 16, lane)); mx = fmaxf(mx, shfl_x(mx, 32, lane));
        float l = 0.f;
#pragma unroll
        for (int kt = 0; kt < 9; ++kt)
#pragma unroll
            for (int i = 0; i < 4; ++i) { const float p = __expf(s[kt][i] - mx); s[kt][i] = p; l += p; }
        l += shfl_x(l, 16, lane); l += shfl_x(l, 32, lane);
        f32x4 o[4];
#pragma unroll
        for (int nt = 0; nt < 4; ++nt) o[nt] = (f32x4){0.f, 0.f, 0.f, 0.f};
#pragma unroll
        for (int st = 0; st < 5; ++st) {
            const int kt0 = 2 * st, kt1 = 2 * st + 1;
            v4u pw; pw.x = pk2(s[kt0][0], s[kt0][1]); pw.y = pk2(s[kt0][2], s[kt0][3]);
            if (kt1 < 9) { pw.z = pk2(s[kt1 < 9 ? kt1 : 0][0], s[kt1 < 9 ? kt1 : 0][1]); pw.w = pk2(s[kt1 < 9 ? kt1 : 0][2], s[kt1 < 9 ? kt1 : 0][3]); } else { pw.z = 0u; pw.w = 0u; }
            const bf16x8 pf = __builtin_bit_cast(bf16x8, pw);
            const int kb0 = 16 * (w + kt0) + 4 * fq, kb1 = 16 * (w + kt1) + 4 * fq;
#pragma unroll
            for (int nt = 0; nt < 4; ++nt) { const int d = 16 * nt + fr;
                v2u va = *(const LAS v2u*)(lds + AT_VT + d * AT_VSTR + kb0 * 2), vb = (v2u){0u, 0u};
                if (kt1 < 9) vb = *(const LAS v2u*)(lds + AT_VT + d * AT_VSTR + kb1 * 2);
                v4u vw; vw.x = va.x; vw.y = va.y; vw.z = vb.x; vw.w = vb.y;
                o[nt] = __builtin_amdgcn_mfma_f32_16x16x32_bf16(__builtin_bit_cast(bf16x8, vw), pf, o[nt], 0, 0, 0); }
        }
        const float il = 1.0f / l;
        bf16* op = OG + ((size_t)g * T + (size_t)b * SEQ + tq) * DILW + h * 64 + 4 * fq;
#pragma unroll
        for (int nt = 0; nt < 4; ++nt) { v2u ww; ww.x = pk2(o[nt][0] * il, o[nt][1] * il); ww.y = pk2(o[nt][2] * il, o[nt][3] * il); *(v2u*)(op + 16 * nt) = ww; }
        if (fq == 0) LSE[((size_t)g * T + (size_t)b * SEQ + tq) * 8 + h] = mx + logf(l);
    }
}
__device__ __forceinline__ void phase_combine(const Frame& F, const bf16* OG, const float* LSE, bf16* O) {
    for (int it = F.bid * 512 + F.tid; it < T * 64; it += F.G * 512) {
        const int c8 = it & 7, h = (it >> 3) & 7, t = it >> 6;
        const float l0 = LSE[((size_t)0 * T + t) * 8 + h], l1 = LSE[((size_t)1 * T + t) * 8 + h], l2 = LSE[((size_t)2 * T + t) * 8 + h];
        const float m = fmaxf(l0, fmaxf(l1, l2)); float w0 = __expf(l0 - m), w1 = __expf(l1 - m), w2 = __expf(l2 - m); const float inv = 1.0f / (w0 + w1 + w2); w0 *= inv; w1 *= inv; w2 *= inv;
        float a[8], bq[8], c[8], o[8]; const size_t off = (size_t)t * DILW + h * 64 + c8 * 8;
        unpack8(*(const v4u*)(OG + off), a); unpack8(*(const v4u*)(OG + (size_t)T * DILW + off), bq); unpack8(*(const v4u*)(OG + (size_t)2 * T * DILW + off), c);
#pragma unroll
        for (int q = 0; q < 8; ++q) o[q] = w0 * a[q] + w1 * bq[q] + w2 * c[q];
        v4u ww; ww.x = pk2(o[0], o[1]); ww.y = pk2(o[2], o[3]); ww.z = pk2(o[4], o[5]); ww.w = pk2(o[6], o[7]);
        *(v4u*)(O + off) = ww;
    }
}

constexpr int M1_LOG = 131072, M1_STAT = M1_LOG + 4096, M1_HIST = M1_STAT + 128, M1_BASE = M1_HIST + 256;
__device__ __forceinline__ void phase_moe1(const Frame& F, const float* Y, const float* gain, const float* bias, const float* RW, const float* RB,
                                           float* X1F, bf16* X1B, unsigned* cnt, int* ltok, float* lgate, int* eidx, int* inv) {
    LAS float* xs = (LAS float*)F.lds; LAS float* logit = (LAS float*)(F.lds + M1_LOG); LAS float* stat = (LAS float*)(F.lds + M1_STAT);
    LAS int* hist = (LAS int*)(F.lds + M1_HIST); LAS int* basep = (LAS int*)(F.lds + M1_BASE);
    const int tid = F.tid, lane = F.lane, w = F.wave;
    for (int rg = F.bid; rg < T / 16; rg += F.G) {
        const int row0 = rg * 16;
        __syncthreads();
#pragma unroll
        for (int j = 0; j < 16; ++j) { const int idx = tid + 512 * j; *(LAS f32x4*)(xs + idx * 4) = *(const f32x4*)(Y + (size_t)row0 * D + (size_t)idx * 4); }
        if (tid < 64) hist[tid] = 0;
        __syncthreads();
#pragma unroll
        for (int rr = 0; rr < 2; ++rr) { const int r = 2 * w + rr; float sm = 0.f;
#pragma unroll
            for (int j = 0; j < 32; ++j) sm += xs[r * D + lane + 64 * j];
            const float mean = wave_sum(sm, lane) * (1.0f / D); float sq = 0.f;
#pragma unroll
            for (int j = 0; j < 32; ++j) { const float d = xs[r * D + lane + 64 * j] - mean; sq += d * d; }
            const float rstd = 1.0f / sqrtf(wave_sum(sq, lane) * (1.0f / D) + LN_EPS);
            if (lane == 0) { stat[2 * r] = mean; stat[2 * r + 1] = rstd; } }
        __syncthreads();
#pragma unroll
        for (int j = 0; j < 16; ++j) { const int idx = tid + 512 * j, r = idx >> 9, c4 = (idx & 511) * 4;
            const f32x4 v = *(LAS f32x4*)(xs + idx * 4), gv = *(const f32x4*)(gain + c4), bv = *(const f32x4*)(bias + c4);
            const float mean = stat[2 * r], rstd = stat[2 * r + 1];
            const f32x4 o = (v - mean) * rstd * gv + bv;
            *(LAS f32x4*)(xs + idx * 4) = o;
            *(f32x4*)(X1F + (size_t)(row0 + r) * D + c4) = o;
            v2u wb; wb.x = pk2(o[0], o[1]); wb.y = pk2(o[2], o[3]); *(v2u*)(X1B + (size_t)(row0 + r) * D + c4) = wb; }
        __syncthreads();
        { const int r = tid >> 5, ep = tid & 31; float a0 = 0.f, a1 = 0.f; const float* wp = RW + 2 * ep; const LAS float* xr = xs + r * D;
            for (int k0 = 0; k0 < D; k0 += 16) {
                f32x2 wv[16];
#pragma unroll
                for (int j = 0; j < 16; ++j) wv[j] = *(const f32x2*)(wp + (size_t)(k0 + j) * NEXP);
                asm volatile("" : "+v"(wv[0]), "+v"(wv[1]), "+v"(wv[2]), "+v"(wv[3]), "+v"(wv[4]), "+v"(wv[5]), "+v"(wv[6]), "+v"(wv[7]));
                asm volatile("" : "+v"(wv[8]), "+v"(wv[9]), "+v"(wv[10]), "+v"(wv[11]), "+v"(wv[12]), "+v"(wv[13]), "+v"(wv[14]), "+v"(wv[15]));
#pragma unroll
                for (int j = 0; j < 16; ++j) { const float xv = xr[k0 + j]; a0 += xv * wv[j].x; a1 += xv * wv[j].y; } }
            logit[r * NEXP + 2 * ep] = a0; logit[r * NEXP + 2 * ep + 1] = a1; }
        __syncthreads();
        int sel_pos[2]; float sel_gate[2]; int sel_rank[2]; bool sel_on[2];
#pragma unroll
        for (int rr = 0; rr < 2; ++rr) { const int r = 2 * w + rr;
            const float sc = 1.0f / (1.0f + __expf(-logit[r * NEXP + lane])); const float ch = sc + RB[lane];
            int rk = 0;
#pragma unroll
            for (int j = 0; j < 8; ++j) { const float cj = shfl_from(ch, (lane & ~7) + j); rk += (cj > ch || (cj == ch && j < (lane & 7))) ? 1 : 0; }
            float gs = rk < 2 ? ch : 0.f; gs += shfl_x(gs, 1, lane); gs += shfl_x(gs, 2, lane); gs += shfl_x(gs, 4, lane);
            int grk = 0; const int g = lane >> 3;
#pragma unroll
            for (int hh = 0; hh < 8; ++hh) { const float gh = shfl_from(gs, 8 * hh); grk += (gh > gs || (gh == gs && hh < g)) ? 1 : 0; }
            const float msk = grk < 4 ? ch : -INFINITY;
            int erk = 0;
            for (int j = 0; j < 64; ++j) { const float mj = __builtin_bit_cast(float, __builtin_amdgcn_readlane(__builtin_bit_cast(int, msk), j)); erk += (mj > msk || (mj == msk && j < lane)) ? 1 : 0; }
            const bool on = erk < 8;
            const float ssum = wave_sum(on ? sc : 0.f, lane);
            sel_on[rr] = on; sel_rank[rr] = erk; sel_gate[rr] = sc / ssum * 2.5f; sel_pos[rr] = 0;
            if (on) sel_pos[rr] = __hip_atomic_fetch_add(&hist[lane], 1, __ATOMIC_RELAXED, __HIP_MEMORY_SCOPE_WORKGROUP); }
        __syncthreads();
        if (tid < 64) { const int hc = hist[tid]; int bs = 0; if (hc > 0) bs = (int)atomicAdd(&cnt[tid * 16], (unsigned)hc); basep[tid] = bs; }
        __syncthreads();
#pragma unroll
        for (int rr = 0; rr < 2; ++rr) if (sel_on[rr]) { const int t = row0 + 2 * w + rr, pos = basep[lane] + sel_pos[rr];
            ltok[(size_t)lane * CAP + pos] = t; lgate[(size_t)lane * CAP + pos] = sel_gate[rr];
            eidx[t * 8 + sel_rank[rr]] = lane; inv[t * 8 + sel_rank[rr]] = pos; }
    }
}
__device__ __forceinline__ int build_tiles(const Frame& F, const unsigned* cnt) {
    LAS int* tpref = (LAS int*)(F.lds + LDS_TAB); LAS int* cl = (LAS int*)(F.lds + LDS_TAB + 512);
    __syncthreads();
    if (F.tid < 64) cl[F.tid] = (int)__hip_atomic_load(&cnt[F.tid * 16], __ATOMIC_RELAXED, __HIP_MEMORY_SCOPE_AGENT);
    __syncthreads();
    if (F.tid == 0) { int acc = 0; for (int e = 0; e < 64; ++e) { tpref[e] = acc; acc += (cl[e] + 255) >> 8; } tpref[64] = acc; }
    __syncthreads();
    return __builtin_amdgcn_readfirstlane(tpref[64]);
}
__device__ __forceinline__ void phase_moe4(const Frame& F, const float* Y2, const bf16* Yr, const int* eidx, const int* inv, const float* gain, const float* bias, float* XO, bf16* XBo) {
    const LAS int* tpref = (const LAS int*)(F.lds + LDS_TAB);
    const int gw = F.bid * 8 + F.wave, NGW = F.G * 8, lane = F.lane;
    for (int t = gw; t < T; t += NGW) {
        f32x4 v[8];
#pragma unroll
        for (int j = 0; j < 8; ++j) v[j] = *(const f32x4*)(Y2 + (size_t)t * D + 4 * lane + 256 * j);
        for (int k = 0; k < 8; ++k) { const int e = eidx[t * 8 + k], pos = inv[t * 8 + k]; const bf16* yr = Yr + (size_t)(tpref[e] * 256 + pos) * D + 4 * lane;
#pragma unroll
            for (int j = 0; j < 8; ++j) { const v2u w = *(const v2u*)(yr + 256 * j); v[j][0] += bflo(w.x); v[j][1] += bfhi(w.x); v[j][2] += bflo(w.y); v[j][3] += bfhi(w.y); } }
        float sm = 0.f;
#pragma unroll
        for (int j = 0; j < 8; ++j) sm += (v[j][0] + v[j][1]) + (v[j][2] + v[j][3]);
        const float mean = wave_sum(sm, lane) * (1.0f / D); float sq = 0.f;
#pragma unroll
        for (int j = 0; j < 8; ++j) { v[j] = v[j] - mean; sq += (v[j][0] * v[j][0] + v[j][1] * v[j][1]) + (v[j][2] * v[j][2] + v[j][3] * v[j][3]); }
        const float rstd = 1.0f / sqrtf(wave_sum(sq, lane) * (1.0f / D) + LN_EPS);
#pragma unroll
        for (int j = 0; j < 8; ++j) { const int c = 4 * lane + 256 * j; const f32x4 o = v[j] * rstd * *(const f32x4*)(gain + c) + *(const f32x4*)(bias + c);
            *(f32x4*)(XO + (size_t)t * D + c) = o;
            v2u wb; wb.x = pk2(o[0], o[1]); wb.y = pk2(o[2], o[3]); *(v2u*)(XBo + (size_t)t * D + c) = wb; }
    }
}


constexpr int M1_P = 0, M1N_HIST = 32768, M1N_BASE = 32768 + 256;
__device__ __forceinline__ void phase_moe1n(const Frame& F, const float* Y, const float* pst, const float* gain, const float* bias, const bf16* WH, const bf16* WL, const float* RB,
                                            bf16* X1B, float* ST1, unsigned* cnt, int* ltok, float* lgate, int* eidx) {
    LAS float* P = (LAS float*)(F.lds + M1_P); LAS int* hist = (LAS int*)(F.lds + M1N_HIST); LAS int* basep = (LAS int*)(F.lds + M1N_BASE);
    const int tid = F.tid, lane = F.lane, w = F.wave, r = lane & 15, q = lane >> 4, pr = w >> 1, kh = w & 1;
    for (int item = F.bid; item < T / 64; item += F.G) {
        const int row0 = item * 64, row = row0 + 16 * pr + r;
        __syncthreads();
        if (tid < 64) hist[tid] = 0;
        float mean, rstd;
        { const f32x4* pp = (const f32x4*)(pst + ((size_t)row * 32 + q * 8) * 2); const f32x4 a = pp[0], b = pp[1], c = pp[2], d = pp[3];
          float sm = (a[0] + a[2]) + (b[0] + b[2]) + (c[0] + c[2]) + (d[0] + d[2]), sq = (a[1] + a[3]) + (b[1] + b[3]) + (c[1] + c[3]) + (d[1] + d[3]);
          sm += shfl_x(sm, 16, lane); sm += shfl_x(sm, 32, lane); sq += shfl_x(sq, 16, lane); sq += shfl_x(sq, 32, lane);
          mean = sm * (1.0f / D); const float var = fmaxf(sq * (1.0f / D) - mean * mean, 0.f); rstd = 1.0f / sqrtf(var + LN_EPS);
          if (kh == 0 && q == 0) *(f32x2*)(ST1 + 2 * row) = (f32x2){mean, rstd}; }
        const float* yp = Y + (size_t)row * D + kh * 1024 + 8 * q; const float* gp = gain + kh * 1024 + 8 * q; const float* bp = bias + kh * 1024 + 8 * q;
        const bf16* whp = WH + (size_t)r * D + kh * 1024 + 8 * q; const bf16* wlp = WL + (size_t)r * D + kh * 1024 + 8 * q;
        bf16* xo = X1B + (size_t)row * D + kh * 1024 + 8 * q;
        f32x4 acc[4];
#pragma unroll
        for (int nt = 0; nt < 4; ++nt) acc[nt] = (f32x4){0.f, 0.f, 0.f, 0.f};
#define M1_LOAD(S, st) do { const int _k = 32 * (st); S##y0 = *(const f32x4*)(yp + _k); S##y1 = *(const f32x4*)(yp + _k + 4); S##g0 = *(const f32x4*)(gp + _k); S##g1 = *(const f32x4*)(gp + _k + 4); \
            S##b0 = *(const f32x4*)(bp + _k); S##b1 = *(const f32x4*)(bp + _k + 4); \
            _Pragma("unroll") for (int nt = 0; nt < 4; ++nt) { S##wh[nt] = *(const bf16x8*)(whp + (size_t)nt * 16 * D + _k); S##wl[nt] = *(const bf16x8*)(wlp + (size_t)nt * 16 * D + _k); } } while (0)
#define M1_COMP(S, st) do { const f32x4 x0 = (S##y0 - mean) * rstd * S##g0 + S##b0, x1 = (S##y1 - mean) * rstd * S##g1 + S##b1; \
            v4u h; h.x = cvt_pk_bf16(x0[0], x0[1]); h.y = cvt_pk_bf16(x0[2], x0[3]); h.z = cvt_pk_bf16(x1[0], x1[1]); h.w = cvt_pk_bf16(x1[2], x1[3]); \
            *(v4u*)(xo + 32 * (st)) = h; \
            v4u l; l.x = cvt_pk_bf16(x0[0] - bflo(h.x), x0[1] - bfhi(h.x)); l.y = cvt_pk_bf16(x0[2] - bflo(h.y), x0[3] - bfhi(h.y)); \
            l.z = cvt_pk_bf16(x1[0] - bflo(h.z), x1[1] - bfhi(h.z)); l.w = cvt_pk_bf16(x1[2] - bflo(h.w), x1[3] - bfhi(h.w)); \
            const bf16x8 xh = __builtin_bit_cast(bf16x8, h), xl = __builtin_bit_cast(bf16x8, l); \
            _Pragma("unroll") for (int nt = 0; nt < 4; ++nt) { acc[nt] = __builtin_amdgcn_mfma_f32_16x16x32_bf16(xh, S##wh[nt], acc[nt], 0, 0, 0); \
                acc[nt] = __builtin_amdgcn_mfma_f32_16x16x32_bf16(xl, S##wh[nt], acc[nt], 0, 0, 0); acc[nt] = __builtin_amdgcn_mfma_f32_16x16x32_bf16(xh, S##wl[nt], acc[nt], 0, 0, 0); } } while (0)
        f32x4 Ay0, Ay1, Ag0, Ag1, Ab0, Ab1, By0, By1, Bg0, Bg1, Bb0, Bb1; bf16x8 Awh[4], Awl[4], Bwh[4], Bwl[4];
        M1_LOAD(A, 0);
        __builtin_amdgcn_sched_barrier(0);
#pragma unroll 1
        for (int st = 0; st < 32; st += 2) {
            M1_LOAD(B, st + 1);
            __builtin_amdgcn_sched_barrier(0);
            M1_COMP(A, st);
            __builtin_amdgcn_sched_barrier(0);
            if (st + 2 < 32) M1_LOAD(A, st + 2);
            __builtin_amdgcn_sched_barrier(0);
            M1_COMP(B, st + 1);
            __builtin_amdgcn_sched_barrier(0);
        }
#undef M1_LOAD
#undef M1_COMP
#pragma unroll
        for (int nt = 0; nt < 4; ++nt)
#pragma unroll
            for (int i = 0; i < 4; ++i) P[(kh * 64 + 16 * pr + 4 * q + i) * 64 + 16 * nt + r] = acc[nt][i];
        __syncthreads();
        int sel_pos[8]; float sel_gate[8]; int sel_rank[8]; bool sel_on[8];
        const float rb = RB[lane];
#pragma unroll
        for (int rr = 0; rr < 8; ++rr) { const int rl = 8 * w + rr;
            const float lg = P[rl * 64 + lane] + P[(64 + rl) * 64 + lane];
            const float sc = 1.0f / (1.0f + __expf(-lg)); const float ch = sc + rb;
            int rk = 0;
#pragma unroll
            for (int j = 0; j < 8; ++j) { const float cj = shfl_from(ch, (lane & ~7) + j); rk += (cj > ch || (cj == ch && j < (lane & 7))) ? 1 : 0; }
            float gs = rk < 2 ? ch : 0.f; gs += shfl_x(gs, 1, lane); gs += shfl_x(gs, 2, lane); gs += shfl_x(gs, 4, lane);
            int grk = 0; const int g = lane >> 3;
#pragma unroll
            for (int hh = 0; hh < 8; ++hh) { const float gh = shfl_from(gs, 8 * hh); grk += (gh > gs || (gh == gs && hh < g)) ? 1 : 0; }
            const float msk = grk < 4 ? ch : -INFINITY;
            int erk = 0;
            for (int j = 0; j < 64; ++j) { const float mj = __builtin_bit_cast(float, __builtin_amdgcn_readlane(__builtin_bit_cast(int, msk), j)); erk += (mj > msk || (mj == msk && j < lane)) ? 1 : 0; }
            const bool on = erk < 8;
            const float ssum = wave_sum(on ? sc : 0.f, lane);
            sel_on[rr] = on; sel_rank[rr] = erk; sel_gate[rr] = sc / ssum * 2.5f; sel_pos[rr] = 0;
            if (on) sel_pos[rr] = __hip_atomic_fetch_add(&hist[lane], 1, __ATOMIC_RELAXED, __HIP_MEMORY_SCOPE_WORKGROUP); }
        __syncthreads();
        if (tid < 64) { const int hc = hist[tid]; int bs = 0; if (hc > 0) bs = (int)atomicAdd(&cnt[tid * 16], (unsigned)hc); basep[tid] = bs; }
        __syncthreads();
#pragma unroll
        for (int rr = 0; rr < 8; ++rr) if (sel_on[rr]) { const int t = row0 + 8 * w + rr, pos = basep[lane] + sel_pos[rr];
            ltok[(size_t)lane * CAP + pos] = t * 8 + sel_rank[rr]; lgate[(size_t)lane * CAP + pos] = sel_gate[rr];
            eidx[t * 8 + sel_rank[rr]] = lane; }
    }
}

constexpr int M3_PL = 131072, M3_CNT = 139264, M3_OFF = 139264 + 272;
__device__ __forceinline__ void phase_moe3n(const Frame& F, const bf16* H, const bf16* HSp, const int* eidx, const bf16* WD, const bf16* WSD,
                                            const float* Y1, const float* ST1, const float* g1, const float* b1, float* Y2, float* PST2) {
    LAS float* out = (LAS float*)F.lds; LAS unsigned short* plist = (LAS unsigned short*)(F.lds + M3_PL); LAS int* cnt = (LAS int*)(F.lds + M3_CNT); LAS int* off = (LAS int*)(F.lds + M3_OFF);
    const int tid = F.tid, lane = F.lane, w = F.wave, r = lane & 15, q = lane >> 4;
    for (int u = F.bid; u < 1024; u += F.G) {
        const int nc = (u & 7) | ((u >> 8) << 3), tb = (u >> 3) & 31;
        __syncthreads();
#pragma unroll
        for (int j = 0; j < 16; ++j) ((LAS v4u*)out)[tid + 512 * j] = (v4u){0u, 0u, 0u, 0u};
        if (tid < 66) cnt[tid] = 0;
        __syncthreads();
        int ee[8], pp[8];
        { const v4u e0 = *(const v4u*)(eidx + ((size_t)tb * 512 + tid) * 8), e1 = *(const v4u*)(eidx + ((size_t)tb * 512 + tid) * 8 + 4);
          ee[0] = e0.x; ee[1] = e0.y; ee[2] = e0.z; ee[3] = e0.w; ee[4] = e1.x; ee[5] = e1.y; ee[6] = e1.z; ee[7] = e1.w; }
#pragma unroll
        for (int j = 0; j < 8; ++j) pp[j] = __hip_atomic_fetch_add(&cnt[ee[j]], 1, __ATOMIC_RELAXED, __HIP_MEMORY_SCOPE_WORKGROUP);
        __syncthreads();
        if (w == 0) { int c = cnt[lane], x = c;
#pragma unroll
            for (int o = 1; o < 64; o <<= 1) { const int y = __builtin_amdgcn_ds_bpermute(((lane - o) & 63) << 2, x); if (lane >= o) x += y; }
            off[lane] = x - c; if (lane == 63) off[64] = x; }
        __syncthreads();
#pragma unroll
        for (int j = 0; j < 8; ++j) plist[off[ee[j]] + pp[j]] = (unsigned short)(tid * 8 + j);
        __syncthreads();
        const char* Hb = (const char*)H + (size_t)tb * 4096 * 256 + q * 16;
        const char* HSb = (const char*)HSp + (size_t)tb * 512 * 512 + q * 16;
        const char* Bb = (const char*)WD + ((size_t)nc * 64 + r) * 256 + q * 16;
        const char* BSb = (const char*)WSD + ((size_t)nc * 64 + r) * 512 + q * 16;
#define M3_NROWS(sg) ((sg) < 8 ? __builtin_amdgcn_readfirstlane(cnt[w + 8 * (sg)]) : 64)
#define M3_RBASE(sg) ((sg) < 8 ? __builtin_amdgcn_readfirstlane(off[w + 8 * (sg)]) : 0)
#define M3_LOADB(dst, sg) do { const char* _b = (sg) < 8 ? Bb + (size_t)(w + 8 * (sg)) * 524288 : BSb + ((sg) - 8) * 256; const int _ns = (sg) < 8 ? 4096 : 8192; \
            _Pragma("unroll") for (int nt = 0; nt < 4; ++nt) _Pragma("unroll") for (int kk = 0; kk < 4; ++kk) dst[nt][kk] = *(const bf16x8*)(_b + nt * _ns + kk * 64); } while (0)
#define M3_LOADA(dst, sg, bb, nr, rbs) do { int _i = 16 * (bb) + r; const char* _a; \
            if ((sg) < 8) { _i = _i < (nr) ? _i : (nr) - 1; const unsigned _rid = plist[(rbs) + _i]; _a = Hb + (size_t)_rid * 256; } \
            else { _a = HSb + (size_t)(64 * w + _i) * 512 + ((sg) - 8) * 256; } \
            _Pragma("unroll") for (int kk = 0; kk < 4; ++kk) dst[kk] = *(const bf16x8*)(_a + kk * 64); } while (0)
        int seg = 0; while (seg < 8 && M3_NROWS(seg) == 0) ++seg;
        int bt = 0, nr = M3_NROWS(seg), rbs = M3_RBASE(seg);
        bf16x8 Bc[4][4], Bn[4][4], Ac[4], An[4];
        M3_LOADB(Bc, seg); M3_LOADA(Ac, seg, bt, nr, rbs);
        int nsg = seg + 1; while (nsg < 8 && M3_NROWS(nsg) == 0) ++nsg;
        if (nsg < 10) M3_LOADB(Bn, nsg);
        __builtin_amdgcn_sched_barrier(0);
#pragma unroll 1
        while (seg < 10) {
            int nb = bt + 1, ns2 = seg, nnr = nr, nrbs = rbs;
            if (nb * 16 >= nr) { nb = 0; ns2 = nsg; if (ns2 < 10) { nnr = M3_NROWS(ns2); nrbs = M3_RBASE(ns2); } }
            if (ns2 < 10) M3_LOADA(An, ns2, nb, nnr, nrbs);
            int tk[4]; bool ok[4];
#pragma unroll
            for (int i = 0; i < 4; ++i) { const int idx = 16 * bt + 4 * q + i; ok[i] = idx < nr;
                if (seg < 8) { const int ic = ok[i] ? idx : nr - 1; tk[i] = (int)plist[rbs + ic] >> 3; } else tk[i] = 64 * w + idx; }
            __builtin_amdgcn_sched_barrier(0);
            f32x4 acc[4];
#pragma unroll
            for (int nt = 0; nt < 4; ++nt) { acc[nt] = (f32x4){0.f, 0.f, 0.f, 0.f};
#pragma unroll
                for (int kk = 0; kk < 4; ++kk) acc[nt] = __builtin_amdgcn_mfma_f32_16x16x32_bf16(Ac[kk], Bc[nt][kk], acc[nt], 0, 0, 0); }
#pragma unroll
            for (int i = 0; i < 4; ++i) if (ok[i]) { LAS float* op = out + tk[i] * 64 + r; const int par = tk[i] & 1;
#pragma unroll
                for (int nt = 0; nt < 4; ++nt) (void)__hip_atomic_fetch_add((LAS int*)(op + 16 * (nt ^ par)), __float2int_rn(acc[nt][i] * 4194304.0f), __ATOMIC_RELAXED, __HIP_MEMORY_SCOPE_WORKGROUP); }
            __builtin_amdgcn_sched_barrier(0);
#pragma unroll
            for (int kk = 0; kk < 4; ++kk) Ac[kk] = An[kk];
            if (ns2 != seg) {
#pragma unroll
                for (int nt = 0; nt < 4; ++nt)
#pragma unroll
                    for (int kk = 0; kk < 4; ++kk) Bc[nt][kk] = Bn[nt][kk];
                seg = ns2; nr = nnr; rbs = nrbs;
                nsg = seg + 1; while (nsg < 8 && M3_NROWS(nsg) == 0) ++nsg;
                if (seg < 10 && nsg < 10) M3_LOADB(Bn, nsg);
            }
            bt = nb;
            __builtin_amdgcn_sched_barrier(0);
        }
#undef M3_NROWS
#undef M3_RBASE
#undef M3_LOADB
#undef M3_LOADA
        __syncthreads();
        { const int c4 = lane & 15, rs = lane >> 4, col = nc * 64 + 4 * c4;
          const f32x4 gv = *(const f32x4*)(g1 + col), bv = *(const f32x4*)(b1 + col);
#pragma unroll 4
          for (int it = 0; it < 16; ++it) { const int rl = 64 * w + 4 * it + rs; const size_t row = (size_t)tb * 512 + rl;
              const f32x4 yv = *(const f32x4*)(Y1 + row * D + col); const f32x2 sv = *(const f32x2*)(ST1 + 2 * row);
              const v4u ti = *(const LAS v4u*)(out + rl * 64 + ((4 * c4) ^ ((rl & 1) << 4)));
              const f32x4 tv = (f32x4){(float)(int)ti.x, (float)(int)ti.y, (float)(int)ti.z, (float)(int)ti.w} * (1.0f / 4194304.0f);
              const f32x4 y = ((yv - sv.x) * sv.y * gv + bv) * ALPHA + tv;
              *(f32x4*)(Y2 + row * D + col) = y;
              float sm = (y[0] + y[1]) + (y[2] + y[3]), sq = (y[0] * y[0] + y[1] * y[1]) + (y[2] * y[2] + y[3] * y[3]);
#pragma unroll
              for (int o = 1; o < 16; o <<= 1) { sm += shfl_x(sm, o, lane); sq += shfl_x(sq, o, lane); }
              if (c4 == 0) *(f32x2*)(PST2 + (row * 32 + nc) * 2) = (f32x2){sm, sq}; } }
    }
}

__device__ __forceinline__ void phase_moe4n(const Frame& F, const float* Y2, const float* pst, const float* gain, const float* bias, float* ST2, bf16* XBo, float* OUT, int last) {
    const int gw = F.bid * 8 + F.wave, NGW = F.G * 8, lane = F.lane;
    for (int t = gw; t < T; t += NGW) {
        f32x4 v[8];
#pragma unroll
        for (int j = 0; j < 8; ++j) v[j] = *(const f32x4*)(Y2 + (size_t)t * D + 4 * lane + 256 * j);
        f32x2 pv = (f32x2){0.f, 0.f}; if (lane < 32) pv = *(const f32x2*)(pst + ((size_t)t * 32 + lane) * 2);
        const float mean = wave_sum(pv.x, lane) * (1.0f / D); const float var = fmaxf(wave_sum(pv.y, lane) * (1.0f / D) - mean * mean, 0.f); const float rstd = 1.0f / sqrtf(var + LN_EPS);
        if (lane == 0) *(f32x2*)(ST2 + 2 * (size_t)t) = (f32x2){mean, rstd};
#pragma unroll
        for (int j = 0; j < 8; ++j) { const int c = 4 * lane + 256 * j; const f32x4 o = (v[j] - mean) * rstd * *(const f32x4*)(gain + c) + *(const f32x4*)(bias + c);
            if (last) *(f32x4*)(OUT + (size_t)t * D + c) = o;
            else { v2u wb; wb.x = pk2(o[0], o[1]); wb.y = pk2(o[2], o[3]); *(v2u*)(XBo + (size_t)t * D + c) = wb; } }
    }
}
enum { PH_PRO = 0, PH_POOL_G1, PH_POOL_P, PH_POOL_G2, PH_POOL_G3, PH_DIL_G1, PH_DIL_ATT, PH_DIL_CMB, PH_DIL_G2, PH_CONV_G1, PH_CONV_E, PH_CONV_G2, PH_MOE1, PH_MOE2, PH_MOE3, PH_MOE4, PH_COUNT };

template <int PH>
__device__ __forceinline__ void run_phase(const Frame& Fin, const Args& args_, const int L) {
    Frame F = Fin; { int w_ = Fin.wave, l_; asm volatile("" : "+s"(w_)); asm volatile("v_mbcnt_lo_u32_b32 %0, -1, 0\n\tv_mbcnt_hi_u32_b32 %0, -1, %0" : "=v"(l_)); F.wave = w_; F.lane = l_; F.tid = w_ * 64 + l_; }
    unsigned char* ws; { GAS unsigned char* wsg = (GAS unsigned char*)Fin.ws; asm volatile("" : "+s"(wsg)); ws = (unsigned char*)wsg; } F.ws = ws; F.ctl = (unsigned*)(ws + WS_CTL);
    KP kp = (KP)__builtin_amdgcn_kernarg_segment_ptr(); asm volatile("" : "+s"(kp)); (void)args_;
    { unsigned l_ = (unsigned)(size_t)Fin.lds; asm volatile("" : "+s"(l_)); F.lds = (LAS unsigned char*)(size_t)l_; }
    LAS unsigned char* ring = F.lds; int c = (int)blockIdx.x; { int g_ = Fin.G; asm volatile("" : "+s"(c), "+s"(g_)); F.G = g_; F.bid = c; }
    const float* xres = (L == 0) ? ain(kp, IN_X) : (const float*)(ws + WS_Y2F);
    const float* st2 = (const float*)(ws + WS_ST2); float* pstp = (float*)(ws + WS_PST);
    const float* g2p = ain(kp, IN_LNG) + (size_t)((L > 0 ? L - 1 : 0) * 2 + 1) * D; const float* b2p = ain(kp, IN_LNB) + (size_t)((L > 0 ? L - 1 : 0) * 2 + 1) * D;
    const bf16* xb = (const bf16*)(ws + WS_XB);
    float* yf = (float*)(ws + WS_YF);
    unsigned char* big = ws + WS_BIG;
    const int ia = L / 3;
    if constexpr (PH == PH_PRO) { phase_prologue(F, kp); }
    if constexpr (PH == PH_POOL_G1) { g8::DenseSched S; S.init(xb, (const bf16*)(ws + WS_W_POOL_IN) + (size_t)ia * D * D, T, D, D, D, F.G, c);
        g8::EpiBf16 E{(bf16*)(big + BG_U), D, 0}; g8::gemm_phase<g8::EpiBf16, g8::DenseSched, false>(ring, F.tid, D, D, D, S, E); }
    if constexpr (PH == PH_POOL_P) { phase_pool(F, (const bf16*)(big + BG_U), (bf16*)(big + BG_PL)); }
    if constexpr (PH == PH_POOL_G2) { g8::DenseSched S; S.init((const bf16*)(big + BG_PL), (const bf16*)(ws + WS_W_POOL_G) + (size_t)ia * D * 512, T, D, D, 512, F.G, c); S.agrp_shift = 1; S.agrp_stride = 512 * 2;
        g8::EpiScaleBf16 E{(bf16*)(big + BG_MX), D, ain(kp, IN_PSC) + (size_t)ia * D}; g8::gemm_phase<g8::EpiScaleBf16, g8::DenseSched, false>(ring, F.tid, 512, D, 512, S, E); }
    if constexpr (PH == PH_POOL_G3) { g8::DenseSched S; S.init((const bf16*)(big + BG_MX), (const bf16*)(ws + WS_W_POOL_OUT) + (size_t)ia * D * D, T, D, D, D, F.G, c);
        g8::EpiResidLN E{xres, st2, g2p, b2p, yf, pstp, L > 0}; g8::gemm_phase<g8::EpiResidLN, g8::DenseSched, false>(ring, F.tid, D, D, D, S, E); }
    if constexpr (PH == PH_DIL_G1) { g8::DenseSched S; S.init(xb, (const bf16*)(ws + WS_W_DIL_QKV), T, QKVC, D, D, F.G, c);
        g8::EpiBf16 E{(bf16*)(big + BG_QKV), QKVC, 1}; g8::gemm_phase<g8::EpiBf16, g8::DenseSched, false>(ring, F.tid, D, D, D, S, E); }
    if constexpr (PH == PH_DIL_ATT) { phase_attn(F, (const bf16*)(big + BG_QKV), ain(kp, IN_RELB), (bf16*)(big + BG_OG), (float*)(big + BG_LSE)); }
    if constexpr (PH == PH_DIL_CMB) { phase_combine(F, (const bf16*)(big + BG_OG), (const float*)(big + BG_LSE), (bf16*)(big + BG_O)); }
    if constexpr (PH == PH_DIL_G2) { g8::DenseSched S; S.init((const bf16*)(big + BG_O), (const bf16*)(ws + WS_W_DIL_OUT), T, D, DILW, DILW, F.G, c);
        g8::EpiResidLN E{xres, st2, g2p, b2p, yf, pstp, L > 0}; g8::gemm_phase<g8::EpiResidLN, g8::DenseSched, false>(ring, F.tid, DILW, DILW, DILW, S, E); }
    if constexpr (PH == PH_CONV_G1) { g8::DenseSched S; S.init(xb, (const bf16*)(ws + WS_W_CONV_IN), T, 3 * D, D, D, F.G, c);
        g8::EpiConvIn E{(bf16*)(big + BG_UC), (bf16*)(big + BG_BG)}; g8::gemm_phase<g8::EpiConvIn, g8::DenseSched, false>(ring, F.tid, D, D, D, S, E); }
    if constexpr (PH == PH_CONV_E) { phase_conv(F, (const bf16*)(big + BG_UC), (const bf16*)(big + BG_BG), ain(kp, IN_CW), (bf16*)(big + BG_Z)); }
    if constexpr (PH == PH_CONV_G2) { g8::DenseSched S; S.init((const bf16*)(big + BG_Z), (const bf16*)(ws + WS_W_CONV_OUT), T, D, D, D, F.G, c);
        g8::EpiResidLN E{xres, st2, g2p, b2p, yf, pstp, L > 0}; g8::gemm_phase<g8::EpiResidLN, g8::DenseSched, false>(ring, F.tid, D, D, D, S, E); }
    unsigned* cnt = F.ctl + CW_CNT + L * 64 * 16;
    float* x1f = (float*)(ws + WS_X1F); bf16* x1b = (bf16*)(ws + WS_X1B);
    int* ltok = (int*)(ws + WS_LTOK); float* lgate = (float*)(ws + WS_LGATE); int* eidx = (int*)(ws + WS_EIDX); int* inv = (int*)(ws + WS_INV);
    bf16* HB = (bf16*)(ws + WS_HB); bf16* HS = (bf16*)(ws + WS_HS); bf16* Yr = (bf16*)(ws + WS_BIG);
    if constexpr (PH == PH_MOE1) {
        const float* g1 = ain(kp, IN_LNG) + (size_t)(L * 2 + 0) * D; const float* b1 = ain(kp, IN_LNB) + (size_t)(L * 2 + 0) * D;
        phase_moe1n(F, yf, pstp, g1, b1, (const bf16*)(ws + WS_RWH) + (size_t)L * NEXP * D, (const bf16*)(ws + WS_RWL) + (size_t)L * NEXP * D, ain(kp, IN_RB) + (size_t)L * NEXP,
                    x1b, (float*)(ws + WS_ST1), cnt, ltok, lgate, eidx); }
    if constexpr (PH == PH_MOE2) {
        const int NT = build_tiles(F, cnt);
        { g8::ExpertSched<1, true> S; S.tpref = (const LAS int*)(F.lds + LDS_TAB); S.cnt = (const LAS int*)(F.lds + LDS_TAB + 512); S.A = (const char*)x1b; S.B = (const char*)((const bf16*)(ws + WS_W_EX_GU) + (size_t)L * 64 * 256 * D);
          S.tok = ltok; S.b_exp = (size_t)256 * D * 2; S.b_tile = 0; S.a_tile = 0; S.NU = NT; S.G = F.G; S.c = c;
          g8::EpiExpertGU E{HB}; g8::gemm_phase<g8::EpiExpertGU, g8::ExpertSched<1, true>, true>(ring, F.tid, D, D, D, S, E); }
        { const int rot = (c - (NT % F.G) + F.G) % F.G;
          g8::DenseSched S; S.init(x1b, (const bf16*)(ws + WS_W_SH_GU) + (size_t)L * 512 * D, T, 512, D, D, F.G, rot);
          int t2 = F.tid; asm volatile("" : "+v"(t2));
          g8::EpiSharedGU E{HS}; g8::gemm_phase<g8::EpiSharedGU, g8::DenseSched, false>(ring, t2, D, D, D, S, E); } }
    if constexpr (PH == PH_MOE3) {
        const float* g1 = ain(kp, IN_LNG) + (size_t)(L * 2 + 0) * D; const float* b1 = ain(kp, IN_LNB) + (size_t)(L * 2 + 0) * D;
        phase_moe3n(F, HB, HS, eidx, (const bf16*)(ws + WS_W_EX_D) + (size_t)L * 64 * D * EDIM, (const bf16*)(ws + WS_W_SH_D) + (size_t)L * D * SDIM,
                    yf, (const float*)(ws + WS_ST1), g1, b1, (float*)(ws + WS_Y2F), pstp); }
    if constexpr (PH == PH_MOE4) {
        const float* g2 = ain(kp, IN_LNG) + (size_t)(L * 2 + 1) * D; const float* b2 = ain(kp, IN_LNB) + (size_t)(L * 2 + 1) * D;
        phase_moe4n(F, (const float*)(ws + WS_Y2F), pstp, g2, b2, (float*)(ws + WS_ST2), (bf16*)(ws + WS_XB), aout(kp), L == DEPTH - 1); }
}
__device__ __forceinline__ void make_frame(Frame& F, const Args& args) {
    extern __shared__ __attribute__((aligned(16))) unsigned char lds_raw[];
    F.lds = (LAS unsigned char*)lds_raw; F.ws = args.ws; F.ctl = (unsigned*)(args.ws + WS_CTL);
    F.tid = threadIdx.x; F.lane = F.tid & 63; F.wave = __builtin_amdgcn_readfirstlane(F.tid >> 6); F.G = gridDim.x; F.bid = blockIdx.x;
}
template <int PH> __global__ void __launch_bounds__(512, 2) k_phase(Args args, int L) {
    Frame F; make_frame(F, args);
    run_phase<PH>(F, args, L);
}

#ifndef MK_NOINLINE
#define MK_NOINLINE 0
#endif
#if MK_NOINLINE
template <int PH> __device__ __noinline__ void call_phase_ni(const int L) {
    Args dummy{}; Frame F;
    KP kp = (KP)__builtin_amdgcn_kernarg_segment_ptr();
    extern __shared__ __attribute__((aligned(16))) unsigned char lds_raw[];
    F.lds = (LAS unsigned char*)lds_raw; F.ws = (unsigned char*)((GAS unsigned char* const CAS*)kp)[20]; F.ctl = (unsigned*)(F.ws + WS_CTL);
    F.tid = threadIdx.x; F.lane = F.tid & 63; F.wave = __builtin_amdgcn_readfirstlane(F.tid >> 6); F.G = gridDim.x; F.bid = blockIdx.x;
    run_phase<PH>(F, dummy, L);
}
template <int PH> __device__ __forceinline__ void call_phase(const Frame& F, const Args& args, const int L) { call_phase_ni<PH>(L); }
#else
template <int PH> __device__ __forceinline__ void call_phase(const Frame& F, const Args& args, const int L) { asm volatile("; PHASE_BEGIN %0" :: "n"(PH)); run_phase<PH>(F, args, L); asm volatile("; PHASE_END %0" :: "n"(PH)); }
#endif
__global__ void __launch_bounds__(512, 2) fwd_all(Args args) {
    Frame F; make_frame(F, args);
    volatile LAS unsigned* misc = (volatile LAS unsigned*)(F.lds + LDS_MISC);
    if (F.tid < 4) misc[F.tid] = 0u;
    __syncthreads();
    const int lo = args.ph_lo, hi = args.ph_hi;
    XcdBarrier bar; bar.bar = F.ctl + CW_BAR; bar.x = 0; bar.st = misc;
    if (hi - lo > 1) bar = xcd_barrier_post(F.ctl + CW_BAR, misc);
    int pc = 0;
#define STEP(PH, Lx) do { if (pc >= lo && pc < hi) { call_phase<PH>(F, args, Lx); if (pc + 1 < hi) xcd_barrier(bar); } ++pc; } while (0)
    STEP(PH_PRO, 0);
#pragma unroll 1
    for (int L = 0; L < DEPTH; ++L) {
        const int kind = L % 3;
        if (kind == 0) { STEP(PH_POOL_G1, L); STEP(PH_POOL_P, L); STEP(PH_POOL_G2, L); STEP(PH_POOL_G3, L); }
        else if (kind == 1) { STEP(PH_DIL_G1, L); STEP(PH_DIL_ATT, L); STEP(PH_DIL_CMB, L); STEP(PH_DIL_G2, L); }
        else { STEP(PH_CONV_G1, L); STEP(PH_CONV_E, L); STEP(PH_CONV_G2, L); }
        STEP(PH_MOE1, L); STEP(PH_MOE2, L); STEP(PH_MOE3, L); STEP(PH_MOE4, L);
    }
#undef STEP
}
constexpr int N_STEPS = 1 + 2 * 8 + 8 + 7;

template <int PH> static void launch_phase(const Args& a, int L, int grid, hipStream_t stream) {
    static bool attr = false;
    if (!attr) { (void)hipFuncSetAttribute((const void*)k_phase<PH>, hipFuncAttributeMaxDynamicSharedMemorySize, LDS_BYTES); attr = true; }
    hipLaunchKernelGGL(k_phase<PH>, dim3(grid), dim3(512), LDS_BYTES, stream, a, L);
}
extern "C" void kernel_launch(void* const* d_in, const int* in_sizes, int n_in, void* d_out, int out_size, void* d_ws, size_t ws_size, hipStream_t stream) {
    static int grid = 0;
    if (grid == 0) {
        if (n_in != 19 || out_size != T * D || ws_size < WS_END) { fprintf(stderr, "kernel_launch: unexpected shapes (n_in %d out %d ws %zu need %zu)\n", n_in, out_size, ws_size, (size_t)WS_END); grid = -1; return; }
        int dev = 0, cus = 0;
        if (hipGetDevice(&dev) != hipSuccess || hipDeviceGetAttribute(&cus, hipDeviceAttributeMultiprocessorCount, dev) != hipSuccess) { grid = -1; return; }
#if MK_ONE_LAUNCH
        if (hipFuncSetAttribute((const void*)fwd_all, hipFuncAttributeMaxDynamicSharedMemorySize, LDS_BYTES) != hipSuccess) { fprintf(stderr, "kernel_launch: hipFuncSetAttribute failed\n"); grid = -1; return; }
        int per_cu = 0;
        if (hipOccupancyMaxActiveBlocksPerMultiprocessor(&per_cu, (const void*)fwd_all, 512, LDS_BYTES) != hipSuccess || per_cu < 1) { fprintf(stderr, "kernel_launch: occupancy query reports %d blocks per CU\n", per_cu); (void)hipGetLastError(); grid = -1; return; }
#endif
        grid = cus;
    }
    if (grid < 0) return;
    (void)hipMemsetAsync((char*)d_ws + WS_CTL, 0, CTL_ZERO_BYTES, stream);
    Args a{};
    for (int i = 0; i < 19; ++i) a.in[i] = (const float*)d_in[i];
    a.out = (float*)d_out; a.ws = (unsigned char*)d_ws; a.ph_lo = 0; a.ph_hi = 0;
#if MK_ONE_LAUNCH
#ifdef MK_SPLIT
    for (int p = 0; p < N_STEPS; ++p) { a.ph_lo = p; a.ph_hi = p + 1; hipLaunchKernelGGL(fwd_all, dim3(grid), dim3(512), LDS_BYTES, stream, a); }
#else
    a.ph_lo = 0; a.ph_hi = N_STEPS;
    hipLaunchKernelGGL(fwd_all, dim3(grid), dim3(512), LDS_BYTES, stream, a);
#endif
#elif defined(MK_HYBRID_MASK)
    {
        static bool attr2 = false; if (!attr2) { (void)hipFuncSetAttribute((const void*)fwd_all, hipFuncAttributeMaxDynamicSharedMemorySize, LDS_BYTES); attr2 = true; }
        int pc = 0;
#define HSTEP(PH, Lx) do { if ((MK_HYBRID_MASK >> (PH)) & 1) { a.ph_lo = pc; a.ph_hi = pc + 1; hipLaunchKernelGGL(fwd_all, dim3(grid), dim3(512), LDS_BYTES, stream, a); } else { a.ph_lo = 0; a.ph_hi = 0; launch_phase<PH>(a, Lx, grid, stream); } ++pc; } while (0)
        HSTEP(PH_PRO, 0);
        for (int L = 0; L < DEPTH; ++L) {
            const int kind = L % 3;
            if (kind == 0) { HSTEP(PH_POOL_G1, L); HSTEP(PH_POOL_P, L); HSTEP(PH_POOL_G2, L); HSTEP(PH_POOL_G3, L); }
            else if (kind == 1) { HSTEP(PH_DIL_G1, L); HSTEP(PH_DIL_ATT, L); HSTEP(PH_DIL_CMB, L); HSTEP(PH_DIL_G2, L); }
            else { HSTEP(PH_CONV_G1, L); HSTEP(PH_CONV_E, L); HSTEP(PH_CONV_G2, L); }
            HSTEP(PH_MOE1, L); HSTEP(PH_MOE2, L); HSTEP(PH_MOE3, L); HSTEP(PH_MOE4, L);
        }
#undef HSTEP
    }
#else
    launch_phase<PH_PRO>(a, 0, grid, stream);
    for (int L = 0; L < DEPTH; ++L) {
        const int kind = L % 3;
        if (kind == 0) { launch_phase<PH_POOL_G1>(a, L, grid, stream); launch_phase<PH_POOL_P>(a, L, grid, stream); launch_phase<PH_POOL_G2>(a, L, grid, stream); launch_phase<PH_POOL_G3>(a, L, grid, stream); }
        else if (kind == 1) { launch_phase<PH_DIL_G1>(a, L, grid, stream); launch_phase<PH_DIL_ATT>(a, L, grid, stream); launch_phase<PH_DIL_CMB>(a, L, grid, stream); launch_phase<PH_DIL_G2>(a, L, grid, stream); }
        else { launch_phase<PH_CONV_G1>(a, L, grid, stream); launch_phase<PH_CONV_E>(a, L, grid, stream); launch_phase<PH_CONV_G2>(a, L, grid, stream); }
        launch_phase<PH_MOE1>(a, L, grid, stream); launch_phase<PH_MOE2>(a, L, grid, stream); launch_phase<PH_MOE3>(a, L, grid, stream); launch_phase<PH_MOE4>(a, L, grid, stream);
    }
#endif
}
```

```cpp
#include <hip/hip_runtime.h>
#include <cstdio>
#include <cstdint>

#ifndef MK_ONE_LAUNCH
#define MK_ONE_LAUNCH 1
#endif

#define GAS __attribute__((address_space(1)))
#define LAS __attribute__((address_space(3)))
typedef unsigned short bf16;
typedef unsigned v4u __attribute__((ext_vector_type(4)));
typedef unsigned v2u __attribute__((ext_vector_type(2)));
typedef float f32x4 __attribute__((ext_vector_type(4)));
typedef float f32x2 __attribute__((ext_vector_type(2)));
typedef short bf16x8 __attribute__((ext_vector_type(8)));
typedef short s16x4 __attribute__((ext_vector_type(4)));

constexpr int NBATCH = 8, SEQ = 2048, D = 2048, T = NBATCH * SEQ, DEPTH = 4;
constexpr int NEXP = 64, TOPK = 8, EDIM = 128, SDIM = 256;
constexpr int QKVC = 4608, DILW = 512;
constexpr float ALPHA = 1.681792830507429f;
constexpr float LN_EPS = 1e-5f;
constexpr int CAP = 16384;
constexpr int HROWS = T * TOPK + NEXP * 256;

constexpr size_t MiB = 1u << 20;
constexpr size_t WS_CTL = 0, CTL_ZERO_BYTES = 1 * MiB;
constexpr size_t WS_W_POOL_IN = 1 * MiB;
constexpr size_t WS_W_POOL_G = WS_W_POOL_IN + 16 * MiB;
constexpr size_t WS_W_POOL_OUT = WS_W_POOL_G + 4 * MiB;
constexpr size_t WS_W_DIL_QKV = WS_W_POOL_OUT + 16 * MiB;
constexpr size_t WS_W_DIL_OUT = WS_W_DIL_QKV + 18 * MiB;
constexpr size_t WS_W_CONV_IN = WS_W_DIL_OUT + 2 * MiB;
constexpr size_t WS_W_CONV_OUT = WS_W_CONV_IN + 24 * MiB;
constexpr size_t WS_W_SH_GU = WS_W_CONV_OUT + 8 * MiB;
constexpr size_t WS_W_SH_D = WS_W_SH_GU + 8 * MiB;
constexpr size_t WS_W_EX_GU = WS_W_SH_D + 4 * MiB;
constexpr size_t WS_W_EX_D = WS_W_EX_GU + 256 * MiB;
constexpr size_t WS_XF = WS_W_EX_D + 256 * MiB;
constexpr size_t WS_YF = WS_XF + 128 * MiB;
constexpr size_t WS_X1F = WS_YF + 128 * MiB;
constexpr size_t WS_XB = WS_X1F + 128 * MiB;
constexpr size_t WS_X1B = WS_XB + 64 * MiB;
constexpr size_t WS_HB = WS_X1B + 64 * MiB;
constexpr size_t WS_HS = WS_HB + 72 * MiB;
constexpr size_t WS_LTOK = WS_HS + 8 * MiB;
constexpr size_t WS_LGATE = WS_LTOK + 4 * MiB;
constexpr size_t WS_EIDX = WS_LGATE + 4 * MiB;
constexpr size_t WS_INV = WS_EIDX + 1 * MiB;
constexpr size_t WS_BIG = WS_INV + 1 * MiB;
constexpr size_t WS_PST = WS_BIG + 608 * MiB;
constexpr size_t WS_ST1 = WS_PST + 4 * MiB;
constexpr size_t WS_ST2 = WS_ST1 + 1 * MiB;
constexpr size_t WS_RWH = WS_ST2 + 1 * MiB;
constexpr size_t WS_RWL = WS_RWH + 1 * MiB;
constexpr size_t WS_PST2 = WS_RWL + 1 * MiB;
constexpr size_t WS_END = WS_PST2 + 8 * MiB;
constexpr size_t WS_Y2F = WS_X1F;
constexpr size_t BG_U = 0, BG_PL = 64 * MiB, BG_MX = 128 * MiB;
constexpr size_t BG_QKV = 0, BG_OG = 144 * MiB, BG_LSE = 192 * MiB, BG_O = 194 * MiB;
constexpr size_t BG_UC = 0, BG_BG = 64 * MiB, BG_Z = 128 * MiB;
constexpr int CW_BAR = 4096;
constexpr int CW_CNT = 16384;

constexpr int RING_BYTES = 131072;
constexpr int LDS_TAB = RING_BYTES;
constexpr int LDS_STASH = RING_BYTES + 1024;
constexpr int LDS_BYTES = 163840;
constexpr int LDS_MISC = LDS_BYTES - 1024;

__device__ __forceinline__ unsigned cvt_pk_bf16(float lo, float hi) { unsigned r; asm volatile("v_cvt_pk_bf16_f32 %0, %1, %2" : "=v"(r) : "v"(lo), "v"(hi)); return r; }
__device__ __forceinline__ unsigned f2bf(float f) { unsigned u = __builtin_bit_cast(unsigned, f); return (u + 0x7fffu + ((u >> 16) & 1u)) >> 16; }
__device__ __forceinline__ unsigned pk2(float lo, float hi) { return f2bf(lo) | (f2bf(hi) << 16); }
__device__ __forceinline__ float bflo(unsigned w) { return __builtin_bit_cast(float, w << 16); }
__device__ __forceinline__ float bfhi(unsigned w) { return __builtin_bit_cast(float, w & 0xffff0000u); }
__device__ __forceinline__ float shfl_from(float v, int src) { return __builtin_bit_cast(float, __builtin_amdgcn_ds_bpermute(src << 2, __builtin_bit_cast(int, v))); }
__device__ __forceinline__ float shfl_x(float v, int o, int lane) { return shfl_from(v, lane ^ o); }
__device__ __forceinline__ float wave_sum(float v, int lane) {
#pragma unroll
    for (int o = 1; o < 64; o <<= 1) v += shfl_x(v, o, lane);
    return v;
}
#define LDS_WAIT() asm volatile("s_waitcnt lgkmcnt(0)" ::: "memory")
#define VM_WAIT() asm volatile("s_waitcnt vmcnt(0)" ::: "memory")

#define XB_TMO      128
#define XB_XCNT(j)  (256  + 64 * (j))
#define XB_XSUB(j)  (1280 + 64 * (j))
#define XB_XGEN(j)  (2304 + 64 * (j))
#define XB_TOP      3328
#define XB_TOPGEN   3392
#define XCD_BAR_WORDS 3456
#define XB_SPIN_CAP (1u << 18)

__device__ __forceinline__ unsigned xb_ld(unsigned* p)              { return __hip_atomic_load(p, __ATOMIC_RELAXED, __HIP_MEMORY_SCOPE_AGENT); }
__device__ __forceinline__ unsigned xb_add(unsigned* p, unsigned v) { return __hip_atomic_fetch_add(p, v, __ATOMIC_RELAXED, __HIP_MEMORY_SCOPE_AGENT); }
__device__ __forceinline__ unsigned xb_xcc_id() { return (unsigned)__builtin_amdgcn_s_getreg((3 << 11) | 20) & 0xFu; }
#define XB_SPIN(cond, bar) do { unsigned _sp = 0; while (cond) { __builtin_amdgcn_s_sleep(1); \
    if ((++_sp & 255u) == 0u) { if (xb_ld(&(bar)[XB_TMO])) break; if (_sp > XB_SPIN_CAP) { atomicAdd(&(bar)[XB_TMO], 1u); break; } } } } while (0)

struct XcdBarrier {
    unsigned* bar; unsigned x;
    volatile LAS unsigned* st;
};

__device__ __forceinline__ XcdBarrier xcd_barrier_post(unsigned* bar, volatile LAS unsigned* st) {
    XcdBarrier b; b.bar = bar; b.x = xb_xcc_id(); b.st = st;
    if (threadIdx.x == 0) (void)xb_add(&bar[XB_XCNT(b.x)], 1u);
    return b;
}
__device__ __forceinline__ void xcd_barrier_complete(unsigned* bar, unsigned x, unsigned& nloc, unsigned& nx) {
    const unsigned G = gridDim.x * gridDim.y * gridDim.z;
    unsigned sum, cnt, mine, sp = 0u;
    for (;;) {
        sum = 0u; cnt = 0u; mine = 0u;
#pragma unroll
        for (unsigned j = 0; j < 16; ++j) { const unsigned c = xb_ld(&bar[XB_XCNT(j)]); sum += c; cnt += (c > 0u) ? 1u : 0u; mine = (j == x) ? c : mine; }
        if (sum == G) break;
        __builtin_amdgcn_s_sleep(1);
        if ((++sp & 255u) == 0u) { if (xb_ld(&bar[XB_TMO])) break; if (sp > XB_SPIN_CAP) { atomicAdd(&bar[XB_TMO], 1u); break; } }
    }
    nloc = mine > 0u ? mine : 1u; nx = cnt > 0u ? cnt : 1u;
}

__device__ __forceinline__ void xcd_barrier(const XcdBarrier& b) {
    asm volatile("s_waitcnt vmcnt(0)" ::: "memory");
    __syncthreads();
    if (threadIdx.x == 0) {
        unsigned* bar; unsigned bx = b.x; { GAS unsigned* bg = (GAS unsigned*)b.bar; asm volatile("" : "+s"(bg), "+s"(bx)); bar = (unsigned*)bg; }
        __builtin_amdgcn_s_waitcnt(0);
        unsigned nloc = b.st[0], nx = b.st[1];
        if (nloc == 0u) { xcd_barrier_complete(bar, bx, nloc, nx); b.st[0] = nloc; b.st[1] = nx; }
        const unsigned old = xb_add(&bar[XB_XSUB(bx)], 1u);
        const unsigned gen = old / nloc;
        if (old + 1u == (gen + 1u) * nloc) {
            __builtin_amdgcn_fence(__ATOMIC_RELEASE, "agent");
            asm volatile("s_waitcnt vmcnt(0)" ::: "memory");
            const unsigned og = xb_add(&bar[XB_TOP], 1u);
            const unsigned tg = og / nx;
            if (og + 1u == (tg + 1u) * nx) xb_add(&bar[XB_TOPGEN], 1u);
            else XB_SPIN(xb_ld(&bar[XB_TOPGEN]) == tg, bar);
            __builtin_amdgcn_fence(__ATOMIC_ACQUIRE, "agent");
            xb_add(&bar[XB_XGEN(bx)], 1u);
            asm volatile("s_waitcnt vmcnt(0)" ::: "memory");
        } else {
            XB_SPIN(xb_ld(&bar[XB_XGEN(bx)]) == gen, bar);
            __builtin_amdgcn_fence(__ATOMIC_ACQUIRE, "agent");
            asm volatile("s_waitcnt vmcnt(0)" ::: "memory");
        }
    }
    __syncthreads();
}

namespace g8 {
constexpr int BM = 256, BK = 64, HALF = 128, HTB = HALF * BK * 2, STAGE_BYTES = 8 * HTB, NXCD = 8, WGM = 8;
__host__ __device__ __forceinline__ int lds_byte(int r, int c) { const int st = (r >> 4) * 2 + (c >> 5), rr = r & 15, cc = c & 31, ob = rr * 64 + cc * 2; return st * 1024 + (ob ^ (((ob >> 9) & 1) << 5)); }
__host__ __device__ __forceinline__ void stage_rc(int b, int& R, int& C) { const int st = b / 1024, sb = b % 1024, swz = sb ^ (((sb >> 9) & 1) << 5); R = (st >> 1) * 16 + swz / 64; C = (st & 1) * 32 + (swz % 64) / 2; }
__host__ __device__ __forceinline__ int perm32(int rho) { const int n = rho >> 4, i = rho & 15; return 8 * (i >> 2) + 4 * n + (i & 3); }

struct Unit { const char* A; const char* B; const int* rows; int pm, pn, nvalid, aux; };

template <class Epi, class Sched, bool GATHER>
__device__ __forceinline__ void gemm_phase(LAS unsigned char* lds, const int tid_in, const int K, const int lda, const int ldb, const Sched& S, const Epi& E) {
    const int tid = tid_in, wid = __builtin_amdgcn_readfirstlane(tid >> 6), lane = tid & 63, wr = wid >> 2, wc = wid & 3, fr = lane & 15, fq = lane >> 4;
    const int nt = K / BK;
    unsigned voffB[2];
#pragma unroll
    for (int i = 0; i < 2; ++i) { int R_, C_; stage_rc(tid * 16 + i * 8192, R_, C_); const int Rb = Epi::PERM ? ((R_ & ~31) + perm32(R_ & 31)) : R_; voffB[i] = (unsigned)(Rb * ldb + C_) * 2u; }
    LAS v4u* stash = (LAS v4u*)(lds + (LDS_STASH - 0) + tid * 16);
    const size_t kstep = (size_t)(BK * 2);
    const size_t hstepB = (size_t)HALF * ldb * 2;
    const unsigned ldsw = (unsigned)wid * 1024u;
    const int aoff = lds_byte(wr * 64 + fr, fq * 8), boff = lds_byte(wc * 32 + fr, fq * 8);
#define G8_SA(b, h) (((b) * 2 + (h)) * HTB)
#define G8_SB(b, h) ((4 + (b) * 2 + (h)) * HTB)
#define G8_STAGE2(bufoff, gbase, v0, v1) do { \
        __builtin_amdgcn_global_load_lds((const unsigned*)((const char*)(gbase) + (v0)), (LAS unsigned*)(lds + (bufoff) + ldsw), 16, 0, 0); \
        __builtin_amdgcn_global_load_lds((const unsigned*)((const char*)(gbase) + (v1)), (LAS unsigned*)(lds + (bufoff) + ldsw + 8192), 16, 0, 0); } while (0)
#define G8_STAGEB(bufoff, gbase) G8_STAGE2(bufoff, gbase, voffB[0], voffB[1])
#define G8_LDA(dst, b, h) do { _Pragma("unroll") for (int m = 0; m < 4; ++m) _Pragma("unroll") for (int k = 0; k < 2; ++k) dst[m][k] = *(const LAS bf16x8*)(lds + G8_SA(b, h) + aoff + m * 2048 + k * 1024); } while (0)
#define G8_LDB(dst, b, h) do { _Pragma("unroll") for (int n = 0; n < 2; ++n) _Pragma("unroll") for (int k = 0; k < 2; ++k) dst[n][k] = *(const LAS bf16x8*)(lds + G8_SB(b, h) + boff + n * 2048 + k * 1024); } while (0)
#define G8_MMA(ai, bj, At, Bt) do { __builtin_amdgcn_s_setprio(1); _Pragma("unroll") for (int m = 0; m < 4; ++m) _Pragma("unroll") for (int n = 0; n < 2; ++n) _Pragma("unroll") for (int k = 0; k < 2; ++k) \
        acc[ai][bj][m][n] = __builtin_amdgcn_mfma_f32_16x16x32_bf16(Bt[n][k], At[m][k], acc[ai][bj][m][n], 0, 0, 0); __builtin_amdgcn_s_setprio(0); } while (0)
#define G8_WAIT_V(n) asm volatile("s_waitcnt vmcnt(" #n ")" ::: "memory")
#define G8_WAIT_L(n) asm volatile("s_waitcnt lgkmcnt(" #n ")" ::: "memory")
#define G8_BAR __builtin_amdgcn_s_barrier()
#define G8_SCHED __builtin_amdgcn_sched_barrier(0)
#define G8_SETVA(dst, u) do { int _t2 = tid; if (GATHER) asm volatile("" : "+v"(_t2)); _Pragma("unroll") for (int _h = 0; _h < 2; ++_h) _Pragma("unroll") for (int _i = 0; _i < 2; ++_i) { \
        int _R, _C; stage_rc(_t2 * 16 + _i * 8192, _R, _C); \
        const unsigned _rl = (unsigned)(_h * HALF + _R); unsigned _row = _rl; \
        if (GATHER) { _row = 0u; if (_rl < (unsigned)(u).nvalid) _row = (unsigned)(u).rows[_rl] >> 3; } \
        dst[_h][_i] = (_row * (unsigned)lda + (unsigned)_C) * 2u; } } while (0)
    Unit cur, nxt; int ui = 0;
    if (!S.next(0, cur)) return;
    f32x4 acc[2][2][4][2];
#pragma unroll
    for (int a = 0; a < 2; ++a)
#pragma unroll
        for (int b = 0; b < 2; ++b)
#pragma unroll
            for (int m = 0; m < 4; ++m)
#pragma unroll
                for (int n = 0; n < 2; ++n) acc[a][b][m][n] = (f32x4){0.f, 0.f, 0.f, 0.f};
    bf16x8 At[4][2], B0[2][2], B1[2][2];
    unsigned vAc[2][2]; unsigned xl00 = 0, xl01 = 0, xl10 = 0, xl11 = 0;
    G8_SETVA(vAc, cur);
    const char* cA = cur.A; const char* cB = cur.B;
    G8_STAGEB(G8_SB(0, 0), cB); G8_STAGEB(G8_SB(0, 1), cB + hstepB); G8_STAGE2(G8_SA(0, 0), cA, vAc[0][0], vAc[0][1]); G8_STAGE2(G8_SA(0, 1), cA, vAc[1][0], vAc[1][1]);
    if (wr == 1) G8_BAR;
    G8_WAIT_V(2); G8_BAR;
    G8_STAGEB(G8_SB(1, 0), cB + kstep); G8_STAGE2(G8_SA(1, 0), cA + kstep, vAc[0][0], vAc[0][1]); G8_STAGEB(G8_SB(1, 1), cB + hstepB + kstep);
    G8_WAIT_V(6); G8_BAR;
    for (;;) {
        const bool has_next = S.next(ui + 1, nxt);
        const char* nA = has_next ? nxt.A : cA; const char* nB = has_next ? nxt.B : cB;
        if (GATHER) { unsigned vAn[2][2]; if (has_next) { G8_SETVA(vAn, nxt); } else {
#pragma unroll
            for (int h = 0; h < 2; ++h)
#pragma unroll
                for (int i = 0; i < 2; ++i) vAn[h][i] = vAc[h][i]; }
            *stash = (v4u){vAn[0][0], vAn[0][1], vAn[1][0], vAn[1][1]}; }
#pragma unroll 1
        for (int t = 0; t < nt; t += 2) {
            const bool last = (t == nt - 2);
            const char* a1 = cA + (size_t)(t + 1) * kstep;
            const char* a2 = last ? nA : cA + (size_t)(t + 2) * kstep; const char* b2 = last ? nB : cB + (size_t)(t + 2) * kstep;
            const char* a3 = a2 + kstep; const char* b3 = b2 + kstep;
            unsigned x00 = vAc[0][0], x01 = vAc[0][1], x10 = vAc[1][0], x11 = vAc[1][1];
            if (GATHER) { if (last) { const v4u sv = *stash; x00 = sv.x; x01 = sv.y; x10 = sv.z; x11 = sv.w; } xl00 = x00; xl01 = x01; xl10 = x10; xl11 = x11; }
            G8_LDB(B0, 0, 0); G8_LDB(B1, 0, 1); G8_SCHED; G8_LDA(At, 0, 0); G8_STAGE2(G8_SA(1, 1), a1, vAc[1][0], vAc[1][1]);
            G8_WAIT_V(8); G8_WAIT_L(0); G8_BAR; G8_MMA(0, 0, At, B0); G8_MMA(0, 1, At, B1); G8_BAR; G8_SCHED;
            G8_LDA(At, 0, 1); G8_STAGEB(G8_SB(0, 0), b2); G8_STAGEB(G8_SB(0, 1), b2 + hstepB); G8_STAGE2(G8_SA(0, 0), a2, x00, x01);
            G8_WAIT_V(8); G8_WAIT_L(0); G8_BAR; G8_MMA(1, 0, At, B0); G8_MMA(1, 1, At, B1); G8_BAR; G8_SCHED;
            G8_LDB(B0, 1, 0); G8_LDB(B1, 1, 1); G8_SCHED; G8_LDA(At, 1, 0); G8_STAGE2(G8_SA(0, 1), a2, x10, x11);
            G8_WAIT_V(8); G8_WAIT_L(0); G8_BAR; G8_MMA(0, 0, At, B0); G8_MMA(0, 1, At, B1); G8_BAR; G8_SCHED;
            G8_LDA(At, 1, 1); G8_STAGEB(G8_SB(1, 0), b3); G8_STAGEB(G8_SB(1, 1), b3 + hstepB); G8_STAGE2(G8_SA(1, 0), a3, x00, x01);
            G8_WAIT_V(8); G8_WAIT_L(0); G8_BAR; G8_MMA(1, 0, At, B0); G8_MMA(1, 1, At, B1); G8_BAR; G8_SCHED;
        }
        if (wr == 0) G8_BAR;
        E(acc, cur, wr, wc, fr, fq);
        if (!has_next) break;
#pragma unroll
        for (int a = 0; a < 2; ++a)
#pragma unroll
            for (int b = 0; b < 2; ++b)
#pragma unroll
                for (int m = 0; m < 4; ++m)
#pragma unroll
                    for (int n = 0; n < 2; ++n) acc[a][b][m][n] = (f32x4){0.f, 0.f, 0.f, 0.f};
        cur = nxt; cA = nA; cB = nB; ++ui;
        if (GATHER) { vAc[0][0] = xl00; vAc[0][1] = xl01; vAc[1][0] = xl10; vAc[1][1] = xl11; }
        if (wr == 1) G8_BAR;
    }
    G8_WAIT_V(0);
    G8_BAR;
#undef G8_SA
#undef G8_SB
#undef G8_STAGE2
#undef G8_STAGEB
#undef G8_LDA
#undef G8_LDB
#undef G8_MMA
#undef G8_WAIT_V
#undef G8_WAIT_L
#undef G8_BAR
#undef G8_SCHED
#undef G8_SETVA
}

struct DenseSched {
    const char* A; const char* B; size_t a_tile, b_tile, agrp_stride; int agrp_shift, nM, nN, nwg, G, c;
    __device__ __forceinline__ void init(const void* A_, const void* B_, int M, int N, int lda, int ldb, int G_, int c_) {
        A = (const char*)A_; B = (const char*)B_; a_tile = (size_t)BM * lda * 2; b_tile = (size_t)BM * ldb * 2; agrp_stride = 0; agrp_shift = 0; nM = M / BM; nN = N / BM; nwg = nM * nN; G = G_; c = c_; }
    __device__ __forceinline__ bool next(int i, Unit& u) const {
        const long L = (long)i * G + c; if (L >= nwg) return false;
        int wgid = (int)L; { const int q = nwg / NXCD, r = nwg % NXCD, xcd = wgid % NXCD, off = wgid / NXCD; wgid = (xcd < r ? xcd * (q + 1) : r * (q + 1) + (xcd - r) * q) + off; }
        const int nig = WGM * nN, gid = wgid / nig, fm = gid * WGM, gsz = (nM - fm) < WGM ? (nM - fm) : WGM;
        u.pm = fm + ((wgid % nig) % gsz); u.pn = (wgid % nig) / gsz;
        u.A = A + (size_t)u.pm * a_tile + (size_t)(u.pn >> agrp_shift) * agrp_stride; u.B = B + (size_t)u.pn * b_tile; u.rows = nullptr; u.nvalid = BM; u.aux = 0; return true;
    }
};
template <int NPN, bool GATHERED>
struct ExpertSched {
    const LAS int* tpref; const LAS int* cnt; const char* A; const char* B; const int* tok; size_t b_exp, b_tile, a_tile; int NU, G, c;
    __device__ __forceinline__ bool next(int i, Unit& u) const {
        const int L = i * G + c; if (L >= NU) return false;
        const int tile = L / NPN, pn = L % NPN;
        int e = 0; while (__builtin_amdgcn_readfirstlane(tpref[e + 1]) <= tile) ++e;
        const int rb = tile - __builtin_amdgcn_readfirstlane(tpref[e]);
        u.pm = e; u.pn = pn; u.aux = tile * BM; u.nvalid = __builtin_amdgcn_readfirstlane(cnt[e]) - rb * BM; if (u.nvalid > BM) u.nvalid = BM;
        u.rows = tok + (size_t)e * CAP + rb * BM;
        u.A = GATHERED ? A : A + (size_t)tile * a_tile; u.B = B + (size_t)e * b_exp + (size_t)pn * b_tile; return true;
    }
};

struct EpiBf16 {
    static constexpr bool PERM = true;
    bf16* O; int ldc; int qscale;
    __device__ __forceinline__ void operator()(const f32x4 (&acc)[2][2][4][2], const Unit& u, int wr, int wc, int fr, int fq) const {
        asm volatile("" : "+v"(fr), "+v"(fq));
        const int row0 = u.pm * BM + wr * 64 + fr, col0 = u.pn * BM + wc * 32 + 8 * fq;
        const float sc = (qscale && (u.pn % 6) < 2) ? 0.125f : 1.0f;
#pragma unroll
        for (int ai = 0; ai < 2; ++ai)
#pragma unroll
            for (int m = 0; m < 4; ++m) { bf16* rowp = O + (size_t)(row0 + ai * HALF + m * 16) * ldc + col0;
#pragma unroll
                for (int bj = 0; bj < 2; ++bj) { const f32x4 v0 = acc[ai][bj][m][0] * sc, v1 = acc[ai][bj][m][1] * sc;
                    v4u w; w.x = cvt_pk_bf16(v0[0], v0[1]); w.y = cvt_pk_bf16(v0[2], v0[3]); w.z = cvt_pk_bf16(v1[0], v1[1]); w.w = cvt_pk_bf16(v1[2], v1[3]);
                    *(v4u*)(rowp + bj * HALF) = w; } }
    }
};
struct EpiScaleBf16 {
    static constexpr bool PERM = true;
    bf16* O; int ldc; const float* scale;
    __device__ __forceinline__ void operator()(const f32x4 (&acc)[2][2][4][2], const Unit& u, int wr, int wc, int fr, int fq) const {
        asm volatile("" : "+v"(fr), "+v"(fq));
        const int row0 = u.pm * BM + wr * 64 + fr, col0 = u.pn * BM + wc * 32 + 8 * fq;
        f32x4 sv[2][2];
#pragma unroll
        for (int bj = 0; bj < 2; ++bj)
#pragma unroll
            for (int n = 0; n < 2; ++n) sv[bj][n] = *(const f32x4*)(scale + col0 + bj * HALF + 4 * n);
#pragma unroll
        for (int ai = 0; ai < 2; ++ai)
#pragma unroll
            for (int m = 0; m < 4; ++m) { bf16* rowp = O + (size_t)(row0 + ai * HALF + m * 16) * ldc + col0;
#pragma unroll
                for (int bj = 0; bj < 2; ++bj) { const f32x4 v0 = acc[ai][bj][m][0] * sv[bj][0], v1 = acc[ai][bj][m][1] * sv[bj][1];
                    v4u w; w.x = cvt_pk_bf16(v0[0], v0[1]); w.y = cvt_pk_bf16(v0[2], v0[3]); w.z = cvt_pk_bf16(v1[0], v1[1]); w.w = cvt_pk_bf16(v1[2], v1[3]);
                    *(v4u*)(rowp + bj * HALF) = w; } }
    }
};
struct EpiResid {
    static constexpr bool PERM = false;
    const float* X; float* Y;
    __device__ __forceinline__ void operator()(const f32x4 (&acc)[2][2][4][2], const Unit& u, int wr, int wc, int fr, int fq) const {
        asm volatile("" : "+v"(fr), "+v"(fq));
        const int row0 = u.pm * BM + wr * 64 + fr, col0 = u.pn * BM + wc * 32 + 4 * fq;
#pragma unroll
        for (int ai = 0; ai < 2; ++ai)
#pragma unroll
            for (int m = 0; m < 4; ++m) { const size_t off = (size_t)(row0 + ai * HALF + m * 16) * D + col0;
#pragma unroll
                for (int bj = 0; bj < 2; ++bj)
#pragma unroll
                    for (int n = 0; n < 2; ++n) { const f32x4 xv = *(const f32x4*)(X + off + bj * HALF + n * 16); *(f32x4*)(Y + off + bj * HALF + n * 16) = xv * ALPHA + acc[ai][bj][m][n]; } }
    }
};
struct EpiResidLN {
    static constexpr bool PERM = false;
    const float* X; const float* st; const float* g; const float* b; float* Y; float* pst; int mode;
    __device__ __forceinline__ void operator()(const f32x4 (&acc)[2][2][4][2], const Unit& u, int wr, int wc, int fr, int fq) const {
        asm volatile("" : "+v"(fr), "+v"(fq));
        const int row0 = u.pm * BM + wr * 64 + fr, col0 = u.pn * BM + wc * 32 + 4 * fq, lane = fq * 16 + fr;
        f32x4 gv[2][2], bv[2][2];
#pragma unroll
        for (int bj = 0; bj < 2; ++bj)
#pragma unroll
            for (int n = 0; n < 2; ++n) { gv[bj][n] = (f32x4){1.f, 1.f, 1.f, 1.f}; bv[bj][n] = (f32x4){0.f, 0.f, 0.f, 0.f};
                if (mode) { gv[bj][n] = *(const f32x4*)(g + col0 + bj * HALF + n * 16); bv[bj][n] = *(const f32x4*)(b + col0 + bj * HALF + n * 16); } }
#pragma unroll
        for (int ai = 0; ai < 2; ++ai)
#pragma unroll
            for (int m = 0; m < 4; ++m) { const int row = row0 + ai * HALF + m * 16; const size_t off = (size_t)row * D + col0;
                float mean = 0.f, rstd = 1.f; if (mode) { const f32x2 sv = *(const f32x2*)(st + 2 * row); mean = sv.x; rstd = sv.y; }
                float sm = 0.f, sq = 0.f;
#pragma unroll
                for (int bj = 0; bj < 2; ++bj)
#pragma unroll
                    for (int n = 0; n < 2; ++n) { f32x4 xv = *(const f32x4*)(X + off + bj * HALF + n * 16);
                        if (mode) xv = (xv - mean) * rstd * gv[bj][n] + bv[bj][n];
                        const f32x4 y = xv * ALPHA + acc[ai][bj][m][n]; *(f32x4*)(Y + off + bj * HALF + n * 16) = y;
                        sm += (y[0] + y[1]) + (y[2] + y[3]); sq += (y[0] * y[0] + y[1] * y[1]) + (y[2] * y[2] + y[3] * y[3]); }
                sm += shfl_x(sm, 16, lane); sm += shfl_x(sm, 32, lane); sq += shfl_x(sq, 16, lane); sq += shfl_x(sq, 32, lane);
                if (fq == 0) *(f32x2*)(pst + ((size_t)row * 32 + u.pn * 4 + wc) * 2) = (f32x2){sm, sq}; }
    }
};
struct EpiConvIn {
    static constexpr bool PERM = true;
    bf16* UC; bf16* BGp;
    __device__ __forceinline__ void operator()(const f32x4 (&acc)[2][2][4][2], const Unit& u, int wr, int wc, int fr, int fq) const {
        asm volatile("" : "+v"(fr), "+v"(fq));
        const int row0 = u.pm * BM + wr * 64 + fr, cw = wc * 32 + 8 * fq;
        if (u.pn < 16) {
#pragma unroll
            for (int ai = 0; ai < 2; ++ai)
#pragma unroll
                for (int m = 0; m < 4; ++m) { bf16* rowp = UC + (size_t)(row0 + ai * HALF + m * 16) * D + u.pn * HALF + cw;
                    const f32x4 v0 = acc[ai][0][m][0] * acc[ai][1][m][0], v1 = acc[ai][0][m][1] * acc[ai][1][m][1];
                    v4u w; w.x = cvt_pk_bf16(v0[0], v0[1]); w.y = cvt_pk_bf16(v0[2], v0[3]); w.z = cvt_pk_bf16(v1[0], v1[1]); w.w = cvt_pk_bf16(v1[2], v1[3]);
                    *(v4u*)rowp = w; }
        } else {
#pragma unroll
            for (int ai = 0; ai < 2; ++ai)
#pragma unroll
                for (int m = 0; m < 4; ++m) { bf16* rowp = BGp + (size_t)(row0 + ai * HALF + m * 16) * D + (u.pn - 16) * BM + cw;
#pragma unroll
                    for (int bj = 0; bj < 2; ++bj) { const f32x4 v0 = acc[ai][bj][m][0], v1 = acc[ai][bj][m][1];
                        v4u w; w.x = cvt_pk_bf16(v0[0], v0[1]); w.y = cvt_pk_bf16(v0[2], v0[3]); w.z = cvt_pk_bf16(v1[0], v1[1]); w.w = cvt_pk_bf16(v1[2], v1[3]);
                        *(v4u*)(rowp + bj * HALF) = w; } }
        }
    }
};
__device__ __forceinline__ f32x4 silu_mul(f32x4 g, f32x4 uu) {
    f32x4 r;
#pragma unroll
    for (int j = 0; j < 4; ++j) r[j] = g[j] * __builtin_amdgcn_rcpf(1.0f + __expf(-g[j])) * uu[j];
    return r;
}
struct EpiExpertGU {
    static constexpr bool PERM = true;
    bf16* H;
    __device__ __forceinline__ void operator()(const f32x4 (&acc)[2][2][4][2], const Unit& u, int wr, int wc, int fr, int fq) const {
        asm volatile("" : "+v"(fr), "+v"(fq));
        const float* gates = (const float*)((const char*)u.rows + (WS_LGATE - WS_LTOK));
        const int cw = wc * 32 + 8 * fq;
#pragma unroll
        for (int ai = 0; ai < 2; ++ai)
#pragma unroll
            for (int m = 0; m < 4; ++m) { const int r = ai * HALF + wr * 64 + m * 16 + fr;
                if (r < u.nvalid) { const float gt = gates[r]; const unsigned pid = (unsigned)u.rows[r];
                    const f32x4 v0 = silu_mul(acc[ai][0][m][0], acc[ai][1][m][0]) * gt, v1 = silu_mul(acc[ai][0][m][1], acc[ai][1][m][1]) * gt;
                    v4u w; w.x = cvt_pk_bf16(v0[0], v0[1]); w.y = cvt_pk_bf16(v0[2], v0[3]); w.z = cvt_pk_bf16(v1[0], v1[1]); w.w = cvt_pk_bf16(v1[2], v1[3]);
                    (void)pid; *(v4u*)(H + (size_t)(u.aux + r) * EDIM + cw) = w; } }
    }
};
struct EpiSharedGU {
    static constexpr bool PERM = true;
    bf16* HS;
    __device__ __forceinline__ void operator()(const f32x4 (&acc)[2][2][4][2], const Unit& u, int wr, int wc, int fr, int fq) const {
        asm volatile("" : "+v"(fr), "+v"(fq));
        const int row0 = u.pm * BM + wr * 64 + fr, cw = u.pn * HALF + wc * 32 + 8 * fq;
#pragma unroll
        for (int ai = 0; ai < 2; ++ai)
#pragma unroll
            for (int m = 0; m < 4; ++m) {
                const f32x4 v0 = silu_mul(acc[ai][0][m][0], acc[ai][1][m][0]), v1 = silu_mul(acc[ai][0][m][1], acc[ai][1][m][1]);
                v4u w; w.x = cvt_pk_bf16(v0[0], v0[1]); w.y = cvt_pk_bf16(v0[2], v0[3]); w.z = cvt_pk_bf16(v1[0], v1[1]); w.w = cvt_pk_bf16(v1[2], v1[3]);
                *(v4u*)(HS + (size_t)(row0 + ai * HALF + m * 16) * SDIM + cw) = w; }
    }
};
struct EpiDownY {
    static constexpr bool PERM = true;
    bf16* Y;
    __device__ __forceinline__ void operator()(const f32x4 (&acc)[2][2][4][2], const Unit& u, int wr, int wc, int fr, int fq) const {
        asm volatile("" : "+v"(fr), "+v"(fq));
        const int col0 = u.pn * BM + wc * 32 + 8 * fq;
#pragma unroll
        for (int ai = 0; ai < 2; ++ai)
#pragma unroll
            for (int m = 0; m < 4; ++m) { const int r = ai * HALF + wr * 64 + m * 16 + fr; bf16* rowp = Y + (size_t)(u.aux + r) * D + col0;
#pragma unroll
                for (int bj = 0; bj < 2; ++bj) { const f32x4 v0 = acc[ai][bj][m][0], v1 = acc[ai][bj][m][1];
                    v4u w; w.x = cvt_pk_bf16(v0[0], v0[1]); w.y = cvt_pk_bf16(v0[2], v0[3]); w.z = cvt_pk_bf16(v1[0], v1[1]); w.w = cvt_pk_bf16(v1[2], v1[3]);
                    *(v4u*)(rowp + bj * HALF) = w; } }
    }
};
}

struct Args { const float* in[19]; float* out; unsigned char* ws; int ph_lo, ph_hi; };
struct Frame {
    LAS unsigned char* lds; unsigned* ctl; unsigned char* ws;
    int tid, lane, wave, G, bid;
};
enum { IN_X = 0, IN_RELB, IN_PWIN, IN_PWG, IN_PSC, IN_PWOUT, IN_DQKV, IN_DOUT, IN_CWIN, IN_CW, IN_CWOUT, IN_LNG, IN_LNB, IN_RW, IN_RB, IN_EGU, IN_ED, IN_SGU, IN_SD };

#define CAS __attribute__((address_space(4)))
typedef const CAS unsigned char* KP;
__device__ __forceinline__ const float* ain(KP kp, int i) { return (const float*)((const GAS float* const CAS*)kp)[i]; }
__device__ __forceinline__ float* aout(KP kp) { return (float*)((GAS float* const CAS*)kp)[19]; }
__device__ __forceinline__ void tr_item(const float* W, int K, int N, bf16* WT, int dstK, int mode, LAS float* scr, int item, int lane) {
    const int nblk = N / 32, kb = item / nblk, nb = item % nblk, k0 = 64 * kb, n0 = 32 * nb;
    int r0 = n0;
    if (mode == 1) { const int part = n0 / 2048, j = n0 % 2048; r0 = (part == 0) ? 4096 + j : 256 * (j / 128) + (part == 2 ? 128 : 0) + (j % 128); }
    if (mode == 2) { const int part = n0 / 256, j = n0 % 256; r0 = 256 * (j / 128) + 128 * part + (j % 128); }
#pragma unroll 8
    for (int i = 0; i < 32; ++i) { const int kk = 2 * i + (lane >> 5); scr[kk * 33 + (lane & 31)] = W[(size_t)(k0 + kk) * N + n0 + (lane & 31)]; }
    LDS_WAIT(); asm volatile("" ::: "memory");
    const int c = lane & 7;
#pragma unroll
    for (int j = 0; j < 4; ++j) { const int n = (lane >> 3) + 8 * j; const LAS float* s = scr + (8 * c) * 33 + n;
        v4u o; o.x = pk2(s[0 * 33], s[1 * 33]); o.y = pk2(s[2 * 33], s[3 * 33]); o.z = pk2(s[4 * 33], s[5 * 33]); o.w = pk2(s[6 * 33], s[7 * 33]);
        *(v4u*)(WT + (size_t)(r0 + n) * dstK + k0 + 8 * c) = o; }
    LDS_WAIT(); asm volatile("" ::: "memory");
}
__device__ __forceinline__ void phase_prologue(const Frame& F, KP kp) {
    LAS float* scr = (LAS float*)(F.lds + F.wave * 16384);
    const int gw = F.bid * 8 + F.wave, NGW = F.G * 8;
    constexpr int I0 = 2 * 2048, I1 = 8 * 128, I2 = 2 * 2048, I3 = 4608, I4 = 512, I5 = 6144, I6 = 2048, I7 = 4 * 512, I8 = 4 * 256, I9 = 256 * 256, I10 = 256 * 128;
    constexpr int NITEMS = I0 + I1 + I2 + I3 + I4 + I5 + I6 + I7 + I8 + I9 + I10;
    unsigned char* ws = F.ws;
    for (int it = gw; it < NITEMS; it += NGW) {
        int r = it;
        if (r < I0) { const int b = r / 2048; tr_item(ain(kp, IN_PWIN) + (size_t)b * D * D, D, D, (bf16*)(ws + WS_W_POOL_IN) + (size_t)b * D * D, D, 0, scr, r % 2048, F.lane); continue; } r -= I0;
        if (r < I1) { const int b = r / 128; tr_item(ain(kp, IN_PWG) + (size_t)b * 512 * 512, 512, 512, (bf16*)(ws + WS_W_POOL_G) + (size_t)b * 512 * 512, 512, 0, scr, r % 128, F.lane); continue; } r -= I1;
        if (r < I2) { const int b = r / 2048; tr_item(ain(kp, IN_PWOUT) + (size_t)b * D * D, D, D, (bf16*)(ws + WS_W_POOL_OUT) + (size_t)b * D * D, D, 0, scr, r % 2048, F.lane); continue; } r -= I2;
        if (r < I3) { tr_item(ain(kp, IN_DQKV), D, QKVC, (bf16*)(ws + WS_W_DIL_QKV), D, 0, scr, r, F.lane); continue; } r -= I3;
        if (r < I4) { tr_item(ain(kp, IN_DOUT), DILW, D, (bf16*)(ws + WS_W_DIL_OUT), DILW, 0, scr, r, F.lane); continue; } r -= I4;
        if (r < I5) { tr_item(ain(kp, IN_CWIN), D, 3 * D, (bf16*)(ws + WS_W_CONV_IN), D, 1, scr, r, F.lane); continue; } r -= I5;
        if (r < I6) { tr_item(ain(kp, IN_CWOUT), D, D, (bf16*)(ws + WS_W_CONV_OUT), D, 0, scr, r, F.lane); continue; } r -= I6;
        if (r < I7) { const int b = r / 512; tr_item(ain(kp, IN_SGU) + (size_t)b * D * 512, D, 512, (bf16*)(ws + WS_W_SH_GU) + (size_t)b * 512 * D, D, 2, scr, r % 512, F.lane); continue; } r -= I7;
        if (r < I8) { const int b = r / 256; tr_item(ain(kp, IN_SD) + (size_t)b * SDIM * D, SDIM, D, (bf16*)(ws + WS_W_SH_D) + (size_t)b * D * SDIM, SDIM, 0, scr, r % 256, F.lane); continue; } r -= I8;
        if (r < I9) { const int b = r / 256; tr_item(ain(kp, IN_EGU) + (size_t)b * D * 256, D, 256, (bf16*)(ws + WS_W_EX_GU) + (size_t)b * 256 * D, D, 0, scr, r % 256, F.lane); continue; } r -= I9;
        { const int b = r / 128; tr_item(ain(kp, IN_ED) + (size_t)b * EDIM * D, EDIM, D, (bf16*)(ws + WS_W_EX_D) + (size_t)b * D * EDIM, EDIM, 0, scr, r % 128, F.lane); }
    }
    const size_t gt = (size_t)F.bid * 512 + F.tid, GT = (size_t)F.G * 512;
    { const float* rw = ain(kp, IN_RW); bf16* wh = (bf16*)(ws + WS_RWH); bf16* wl = (bf16*)(ws + WS_RWL);
      for (size_t i = gt; i < (size_t)DEPTH * NEXP * D / 8; i += GT) { const size_t k8 = i % (D / 8), e = (i / (D / 8)) % NEXP, l = i / ((size_t)NEXP * D / 8);
          float v[8]; unsigned hi[8], lo[8];
#pragma unroll
          for (int j = 0; j < 8; ++j) { v[j] = rw[(l * D + k8 * 8 + j) * NEXP + e]; hi[j] = f2bf(v[j]); lo[j] = f2bf(v[j] - __builtin_bit_cast(float, hi[j] << 16)); }
          v4u a, b2; a.x = hi[0] | (hi[1] << 16); a.y = hi[2] | (hi[3] << 16); a.z = hi[4] | (hi[5] << 16); a.w = hi[6] | (hi[7] << 16);
          b2.x = lo[0] | (lo[1] << 16); b2.y = lo[2] | (lo[3] << 16); b2.z = lo[4] | (lo[5] << 16); b2.w = lo[6] | (lo[7] << 16);
          *(v4u*)(wh + (l * NEXP + e) * D + k8 * 8) = a; *(v4u*)(wl + (l * NEXP + e) * D + k8 * 8) = b2; } }
    const float* x = ain(kp, IN_X); bf16* xb = (bf16*)(ws + WS_XB);
    for (size_t i = gt; i < (size_t)T * D / 8; i += GT) { const f32x4 p = *(const f32x4*)(x + i * 8), q = *(const f32x4*)(x + i * 8 + 4);
        v4u w; w.x = pk2(p[0], p[1]); w.y = pk2(p[2], p[3]); w.z = pk2(q[0], q[1]); w.w = pk2(q[2], q[3]); *(v4u*)(xb + i * 8) = w; }
}

__device__ __forceinline__ void unpack8(const v4u w, float (&f)[8]) { f[0] = bflo(w.x); f[1] = bfhi(w.x); f[2] = bflo(w.y); f[3] = bfhi(w.y); f[4] = bflo(w.z); f[5] = bfhi(w.z); f[6] = bflo(w.w); f[7] = bfhi(w.w); }
__device__ __forceinline__ void phase_pool(const Frame& F, const bf16* U, bf16* PL) {
    for (int it = F.bid * 512 + F.tid; it < (T / 32) * 256; it += F.G * 512) {
        const int cv = it & 255, ch = it >> 8, col = cv * 8, w = 2 << (col >> 9);
        const int row0 = ch * 32, pos0 = row0 & (SEQ - 1);
        float s[8], uu[8];
#pragma unroll
        for (int j = 0; j < 8; ++j) s[j] = 0.f;
        for (int j = 1; j < w; ++j) if (pos0 - j >= 0) { unpack8(*(const v4u*)(U + (size_t)(row0 - j) * D + col), uu);
#pragma unroll
            for (int q = 0; q < 8; ++q) s[q] += uu[q]; }
        for (int r = 0; r < 32; ++r) {
            const int t = row0 + r, pos = pos0 + r;
            unpack8(*(const v4u*)(U + (size_t)t * D + col), uu);
            const float inv = 1.0f / (float)((pos + 1) < w ? (pos + 1) : w);
            float o[8];
#pragma unroll
            for (int q = 0; q < 8; ++q) { s[q] += uu[q]; o[q] = s[q] * inv - uu[q]; }
            v4u ww; ww.x = pk2(o[0], o[1]); ww.y = pk2(o[2], o[3]); ww.z = pk2(o[4], o[5]); ww.w = pk2(o[6], o[7]);
            *(v4u*)(PL + (size_t)t * D + col) = ww;
            if (pos - w + 1 >= 0) { unpack8(*(const v4u*)(U + (size_t)(t - w + 1) * D + col), uu);
#pragma unroll
                for (int q = 0; q < 8; ++q) s[q] -= uu[q]; }
        }
    }
}

__device__ __forceinline__ void phase_conv(const Frame& F, const bf16* UC, const bf16* BGp, const float* cw, bf16* Z) {
    for (int it = F.bid * 512 + F.tid; it < T * 256; it += F.G * 512) {
        const int cv = it & 255, t = it >> 8, col = cv * 8, pos = t & (SEQ - 1);
        float u0[8], u1[8], u2[8], bb[8], o[8];
        unpack8(*(const v4u*)(UC + (size_t)t * D + col), u2);
        if (pos >= 1) unpack8(*(const v4u*)(UC + (size_t)(t - 1) * D + col), u1); else {
#pragma unroll
            for (int q = 0; q < 8; ++q) u1[q] = 0.f; }
        if (pos >= 2) unpack8(*(const v4u*)(UC + (size_t)(t - 2) * D + col), u0); else {
#pragma unroll
            for (int q = 0; q < 8; ++q) u0[q] = 0.f; }
        unpack8(*(const v4u*)(BGp + (size_t)t * D + col), bb);
#pragma unroll
        for (int q = 0; q < 8; ++q) o[q] = bb[q] * (cw[col + q] * u0[q] + cw[D + col + q] * u1[q] + cw[2 * D + col + q] * u2[q]);
        v4u ww; ww.x = pk2(o[0], o[1]); ww.y = pk2(o[2], o[3]); ww.z = pk2(o[4], o[5]); ww.w = pk2(o[6], o[7]);
        *(v4u*)(Z + (size_t)t * D + col) = ww;
    }
}

__device__ __forceinline__ int t5_bucket(int dist) {
    if (dist < 16) return dist;
    int large = 16 + (int)(logf((float)dist / 16.0f) / logf(128.0f) * 16.0f);
    return large < 31 ? large : 31;
}
constexpr int AT_KS = 0, AT_KSTR = 144, AT_VT = 256 * 144, AT_VSTR = 520, AT_BIAS = AT_VT + 64 * 520;
__device__ __forceinline__ void phase_attn(const Frame& F, const bf16* QKV, const float* relb, bf16* OG, float* LSE) {
    LAS unsigned char* lds = F.lds;
    const int tid = F.tid, lane = F.lane, w = tid >> 6, fr = lane & 15, fq = lane >> 4;
    for (int unit = F.bid; unit < NBATCH * 3 * 8 * 16; unit += F.G) {
        const int cmb = unit & 15, h = (unit >> 4) & 7, g = (unit >> 7) % 3, b = unit / 384;
        const int dsh = 2 * g, dil = 1 << dsh, r = cmb & (dil - 1), nb = cmb >> dsh;
        const bf16* base = QKV + (size_t)b * SEQ * QKVC + g * 1536 + h * 64;
        __syncthreads();
        {
            const int key = tid >> 1, half = tid & 1, jk = (nb - 1) * 128 + key;
            v4u kv[4], vv[4];
            if (jk >= 0) { const bf16* rp = base + (size_t)(jk * dil + r) * QKVC + half * 32;
#pragma unroll
                for (int i = 0; i < 4; ++i) { kv[i] = *(const v4u*)(rp + 512 + 8 * i); vv[i] = *(const v4u*)(rp + 1024 + 8 * i); } }
            else {
#pragma unroll
                for (int i = 0; i < 4; ++i) { kv[i] = (v4u){0u, 0u, 0u, 0u}; vv[i] = (v4u){0u, 0u, 0u, 0u}; } }
#pragma unroll
            for (int i = 0; i < 4; ++i) *(LAS v4u*)(lds + AT_KS + key * AT_KSTR + half * 64 + 16 * i) = kv[i];
#pragma unroll
            for (int i = 0; i < 4; ++i) {
                const unsigned ww[4] = {vv[i].x, vv[i].y, vv[i].z, vv[i].w};
#pragma unroll
                for (int q = 0; q < 4; ++q) { const int d = half * 32 + 8 * i + 2 * q;
                    *(LAS unsigned short*)(lds + AT_VT + d * AT_VSTR + key * 2) = (unsigned short)(ww[q] & 0xffffu);
                    *(LAS unsigned short*)(lds + AT_VT + (d + 1) * AT_VSTR + key * 2) = (unsigned short)(ww[q] >> 16); } }
            if (tid <= 128) ((LAS float*)(lds + AT_BIAS))[tid] = relb[t5_bucket(tid * dil) * 24 + g * 8 + h];
        }
        __syncthreads();
        int qi = 16 * w + fr; asm volatile("" : "+v"(qi));
        const int jq = nb * 128 + qi, tq = jq * dil + r;
        const bf16* qp = base + (size_t)tq * QKVC + 8 * fq;
        const bf16x8 q0 = *(const bf16x8*)qp, q1 = *(const bf16x8*)(qp + 32);
        f32x4 s[9]; float mx = -INFINITY;
#pragma unroll
        for (int kt = 0; kt < 9; ++kt) {
            const int kb = 16 * (w + kt);
            const bf16x8 k0 = *(const LAS bf16x8*)(lds + AT_KS + (kb + fr) * AT_KSTR + fq * 16), k1 = *(const LAS bf16x8*)(lds + AT_KS + (kb + fr) * AT_KSTR + 64 + fq * 16);
            f32x4 a = (f32x4){0.f, 0.f, 0.f, 0.f};
            a = __builtin_amdgcn_mfma_f32_16x16x32_bf16(k0, q0, a, 0, 0, 0);
            a = __builtin_amdgcn_mfma_f32_16x16x32_bf16(k1, q1, a, 0, 0, 0);
#pragma unroll
            for (int i = 0; i < 4; ++i) { const int kl = kb + 4 * fq + i, rel = qi + 128 - kl;
                const bool ok = (rel >= 0) && (rel <= 128) && (nb > 0 || kl >= 128);
                const int rc = rel < 0 ? 0 : (rel > 128 ? 128 : rel);
                const float v = ok ? a[i] + ((LAS float*)(lds + AT_BIAS))[rc] : -INFINITY;
                a[i] = v; mx = fmaxf(mx, v); }
            s[kt] = a;
        }
        mx = fmaxf(mx, shfl_x(mx, 16, lane)); mx = fmaxf(mx, shfl_x(mx, 32, lane));
        float l = 0.f;
#pragma unroll
        for (int kt = 0; kt < 9; ++kt)
#pragma unroll
            for (int i = 0; i < 4; ++i) { const float p = __expf(s[kt][i] - mx); s[kt][i] = p; l += p; }
        l += shfl_x(l, 16, lane); l += shfl_x(l, 32, lane);
        f32x4 o[4];
#pragma unroll
        for (int nt = 0; nt < 4; ++nt) o[nt] = (f32x4){0.f, 0.f, 0.f, 0.f};
#pragma unroll
        for (int st = 0; st < 5; ++st) {
            const int kt0 = 2 * st, kt1 = 2 * st + 1;
            v4u pw; pw.x = pk2(s[kt0][0], s[kt0][1]); pw.y = pk2(s[kt0][2], s[kt0][3]);
            if (kt1 < 9) { pw.z = pk2(s[kt1 < 9 ? kt1 : 0][0], s[kt1 < 9 ? kt1 : 0][1]); pw.w = pk2(s[kt1 < 9 ? kt1 : 0][2], s[kt1 < 9 ? kt1 : 0][3]); } else { pw.z = 0u; pw.w = 0u; }
            const bf16x8 pf = __builtin_bit_cast(bf16x8, pw);
            const int kb0 = 16 * (w + kt0) + 4 * fq, kb1 = 16 * (w + kt1) + 4 * fq;
#pragma unroll
            for (int nt = 0; nt < 4; ++nt) { const int d = 16 * nt + fr;
                v2u va = *(const LAS v2u*)(lds + AT_VT + d * AT_VSTR + kb0 * 2), vb = (v2u){0u, 0u};
                if (kt1 < 9) vb = *(const LAS v2u*)(lds + AT_VT + d * AT_VSTR + kb1 * 2);
                v4u vw; vw.x = va.x; vw.y = va.y; vw.z = vb.x; vw.w = vb.y;
                o[nt] = __builtin_amdgcn_mfma_f32_16x16x32_bf16(__builtin_bit_cast(bf16x8, vw), pf, o[nt], 0, 0, 0); }
        }
        const float il = 1.0f / l;
        bf16* op = OG + ((size_t)g * T + (size_t)b * SEQ + tq) * DILW + h * 64 + 4 * fq;
#pragma unroll
        for (int nt = 0; nt < 4; ++nt) { v2u ww; ww.x = pk2(o[nt][0] * il, o[nt][1] * il); ww.y = pk2(o[nt][2] * il, o[nt][3] * il); *(v2u*)(op + 16 * nt) = ww; }
        if (fq == 0) LSE[((size_t)g * T + (size_t)b * SEQ + tq) * 8 + h] = mx + logf(l);
    }
}
__device__ __forceinline__ void phase_combine(const Frame& F, const bf16* OG, const float* LSE, bf16* O) {
    for (int it = F.bid * 512 + F.tid; it < T * 64; it += F.G * 512) {
        const int c8 = it & 7, h = (it >> 3) & 7, t = it >> 6;
        const float l0 = LSE[((size_t)0 * T + t) * 8 + h], l1 = LSE[((size_t)1 * T + t) * 8 + h], l2 = LSE[((size_t)2 * T + t) * 8 + h];
        const float m = fmaxf(l0, fmaxf(l1, l2)); float w0 = __expf(l0 - m), w1 = __expf(l1 - m), w2 = __expf(l2 - m); const float inv = 1.0f / (w0 + w1 + w2); w0 *= inv; w1 *= inv; w2 *= inv;
        float a[8], bq[8], c[8], o[8]; const size_t off = (size_t)t * DILW + h * 64 + c8 * 8;
        unpack8(*(const v4u*)(OG + off), a); unpack8(*(const v4u*)(OG + (size_t)T * DILW + off), bq); unpack8(*(const v4u*)(OG + (size_t)2 * T * DILW + off), c);
#pragma unroll
        for (int q = 0; q < 8; ++q) o[q] = w0 * a[q] + w1 * bq[q] + w2 * c[q];
        v4u ww; ww.x = pk2(o[0], o[1]); ww.y = pk2(o[2], o[3]); ww.z = pk2(o[4], o[5]); ww.w = pk2(o[6], o[7]);
        *(v4u*)(O + off) = ww;
    }
}

constexpr int M1_LOG = 131072, M1_STAT = M1_LOG + 4096, M1_HIST = M1_STAT + 128, M1_BASE = M1_HIST + 256;
__device__ __forceinline__ void phase_moe1(const Frame& F, const float* Y, const float* gain, const float* bias, const float* RW, const float* RB,
                                           float* X1F, bf16* X1B, unsigned* cnt, int* ltok, float* lgate, int* eidx, int* inv) {
    LAS float* xs = (LAS float*)F.lds; LAS float* logit = (LAS float*)(F.lds + M1_LOG); LAS float* stat = (LAS float*)(F.lds + M1_STAT);
    LAS int* hist = (LAS int*)(F.lds + M1_HIST); LAS int* basep = (LAS int*)(F.lds + M1_BASE);
    const int tid = F.tid, lane = F.lane, w = F.wave;
    for (int rg = F.bid; rg < T / 16; rg += F.G) {
        const int row0 = rg * 16;
        __syncthreads();
#pragma unroll
        for (int j = 0; j < 16; ++j) { const int idx = tid + 512 * j; *(LAS f32x4*)(xs + idx * 4) = *(const f32x4*)(Y + (size_t)row0 * D + (size_t)idx * 4); }
        if (tid < 64) hist[tid] = 0;
        __syncthreads();
#pragma unroll
        for (int rr = 0; rr < 2; ++rr) { const int r = 2 * w + rr; float sm = 0.f;
#pragma unroll
            for (int j = 0; j < 32; ++j) sm += xs[r * D + lane + 64 * j];
            const float mean = wave_sum(sm, lane) * (1.0f / D); float sq = 0.f;
#pragma unroll
            for (int j = 0; j < 32; ++j) { const float d = xs[r * D + lane + 64 * j] - mean; sq += d * d; }
            const float rstd = 1.0f / sqrtf(wave_sum(sq, lane) * (1.0f / D) + LN_EPS);
            if (lane == 0) { stat[2 * r] = mean; stat[2 * r + 1] = rstd; } }
        __syncthreads();
#pragma unroll
        for (int j = 0; j < 16; ++j) { const int idx = tid + 512 * j, r = idx >> 9, c4 = (idx & 511) * 4;
            const f32x4 v = *(LAS f32x4*)(xs + idx * 4), gv = *(const f32x4*)(gain + c4), bv = *(const f32x4*)(bias + c4);
            const float mean = stat[2 * r], rstd = stat[2 * r + 1];
            const f32x4 o = (v - mean) * rstd * gv + bv;
            *(LAS f32x4*)(xs + idx * 4) = o;
            *(f32x4*)(X1F + (size_t)(row0 + r) * D + c4) = o;
            v2u wb; wb.x = pk2(o[0], o[1]); wb.y = pk2(o[2], o[3]); *(v2u*)(X1B + (size_t)(row0 + r) * D + c4) = wb; }
        __syncthreads();
        { const int r = tid >> 5, ep = tid & 31; float a0 = 0.f, a1 = 0.f; const float* wp = RW + 2 * ep; const LAS float* xr = xs + r * D;
            for (int k0 = 0; k0 < D; k0 += 16) {
                f32x2 wv[16];
#pragma unroll
                for (int j = 0; j < 16; ++j) wv[j] = *(const f32x2*)(wp + (size_t)(k0 + j) * NEXP);
                asm volatile("" : "+v"(wv[0]), "+v"(wv[1]), "+v"(wv[2]), "+v"(wv[3]), "+v"(wv[4]), "+v"(wv[5]), "+v"(wv[6]), "+v"(wv[7]));
                asm volatile("" : "+v"(wv[8]), "+v"(wv[9]), "+v"(wv[10]), "+v"(wv[11]), "+v"(wv[12]), "+v"(wv[13]), "+v"(wv[14]), "+v"(wv[15]));
#pragma unroll
                for (int j = 0; j < 16; ++j) { const float xv = xr[k0 + j]; a0 += xv * wv[j].x; a1 += xv * wv[j].y; } }
            logit[r * NEXP + 2 * ep] = a0; logit[r * NEXP + 2 * ep + 1] = a1; }
        __syncthreads();
        int sel_pos[2]; float sel_gate[2]; int sel_rank[2]; bool sel_on[2];
#pragma unroll
        for (int rr = 0; rr < 2; ++rr) { const int r = 2 * w + rr;
            const float sc = 1.0f / (1.0f + __expf(-logit[r * NEXP + lane])); const float ch = sc + RB[lane];
            int rk = 0;
#pragma unroll
            for (int j = 0; j < 8; ++j) { const float cj = shfl_from(ch, (lane & ~7) + j); rk += (cj > ch || (cj == ch && j < (lane & 7))) ? 1 : 0; }
            float gs = rk < 2 ? ch : 0.f; gs += shfl_x(gs, 1, lane); gs += shfl_x(gs, 2, lane); gs += shfl_x(gs, 4, lane);
            int grk = 0; const int g = lane >> 3;
#pragma unroll
            for (int hh = 0; hh < 8; ++hh) { const float gh = shfl_from(gs, 8 * hh); grk += (gh > gs || (gh == gs && hh < g)) ? 1 : 0; }
            const float msk = grk < 4 ? ch : -INFINITY;
            int erk = 0;
            for (int j = 0; j < 64; ++j) { const float mj = __builtin_bit_cast(float, __builtin_amdgcn_readlane(__builtin_bit_cast(int, msk), j)); erk += (mj > msk || (mj == msk && j < lane)) ? 1 : 0; }
            const bool on = erk < 8;
            const float ssum = wave_sum(on ? sc : 0.f, lane);
            sel_on[rr] = on; sel_rank[rr] = erk; sel_gate[rr] = sc / ssum * 2.5f; sel_pos[rr] = 0;
            if (on) sel_pos[rr] = __hip_atomic_fetch_add(&hist[lane], 1, __ATOMIC_RELAXED, __HIP_MEMORY_SCOPE_WORKGROUP); }
        __syncthreads();
        if (tid < 64) { const int hc = hist[tid]; int bs = 0; if (hc > 0) bs = (int)atomicAdd(&cnt[tid * 16], (unsigned)hc); basep[tid] = bs; }
        __syncthreads();
#pragma unroll
        for (int rr = 0; rr < 2; ++rr) if (sel_on[rr]) { const int t = row0 + 2 * w + rr, pos = basep[lane] + sel_pos[rr];
            ltok[(size_t)lane * CAP + pos] = t; lgate[(size_t)lane * CAP + pos] = sel_gate[rr];
            eidx[t * 8 + sel_rank[rr]] = lane; inv[t * 8 + sel_rank[rr]] = pos; }
    }
}
__device__ __forceinline__ int build_tiles(const Frame& F, const unsigned* cnt) {
    LAS int* tpref = (LAS int*)(F.lds + LDS_TAB); LAS int* cl = (LAS int*)(F.lds + LDS_TAB + 512);
    __syncthreads();
    if (F.tid < 64) cl[F.tid] = (int)__hip_atomic_load(&cnt[F.tid * 16], __ATOMIC_RELAXED, __HIP_MEMORY_SCOPE_AGENT);
    __syncthreads();
    if (F.tid == 0) { int acc = 0; for (int e = 0; e < 64; ++e) { tpref[e] = acc; acc += (cl[e] + 255) >> 8; } tpref[64] = acc; }
    __syncthreads();
    return __builtin_amdgcn_readfirstlane(tpref[64]);
}
__device__ __forceinline__ void phase_moe4(const Frame& F, const float* Y2, const bf16* Yr, const int* eidx, const int* inv, const float* gain, const float* bias, float* XO, bf16* XBo) {
    const LAS int* tpref = (const LAS int*)(F.lds + LDS_TAB);
    const int gw = F.bid * 8 + F.wave, NGW = F.G * 8, lane = F.lane;
    for (int t = gw; t < T; t += NGW) {
        f32x4 v[8];
#pragma unroll
        for (int j = 0; j < 8; ++j) v[j] = *(const f32x4*)(Y2 + (size_t)t * D + 4 * lane + 256 * j);
        for (int k = 0; k < 8; ++k) { const int e = eidx[t * 8 + k], pos = inv[t * 8 + k]; const bf16* yr = Yr + (size_t)(tpref[e] * 256 + pos) * D + 4 * lane;
#pragma unroll
            for (int j = 0; j < 8; ++j) { const v2u w = *(const v2u*)(yr + 256 * j); v[j][0] += bflo(w.x); v[j][1] += bfhi(w.x); v[j][2] += bflo(w.y); v[j][3] += bfhi(w.y); } }
        float sm = 0.f;
#pragma unroll
        for (int j = 0; j < 8; ++j) sm += (v[j][0] + v[j][1]) + (v[j][2] + v[j][3]);
        const float mean = wave_sum(sm, lane) * (1.0f / D); float sq = 0.f;
#pragma unroll
        for (int j = 0; j < 8; ++j) { v[j] = v[j] - mean; sq += (v[j][0] * v[j][0] + v[j][1] * v[j][1]) + (v[j][2] * v[j][2] + v[j][3] * v[j][3]); }
        const float rstd = 1.0f / sqrtf(wave_sum(sq, lane) * (1.0f / D) + LN_EPS);
#pragma unroll
        for (int j = 0; j < 8; ++j) { const int c = 4 * lane + 256 * j; const f32x4 o = v[j] * rstd * *(const f32x4*)(gain + c) + *(const f32x4*)(bias + c);
            *(f32x4*)(XO + (size_t)t * D + c) = o;
            v2u wb; wb.x = pk2(o[0], o[1]); wb.y = pk2(o[2], o[3]); *(v2u*)(XBo + (size_t)t * D + c) = wb; }
    }
}


constexpr int M1_P = 0, M1N_HIST = 32768, M1N_BASE = 32768 + 256;
__device__ __forceinline__ void phase_moe1n(const Frame& F, const float* Y, const float* pst, const float* gain, const float* bias, const bf16* WH, const bf16* WL, const float* RB,
                                            bf16* X1B, float* ST1, unsigned* cnt, int* ltok, float* lgate, int* eidx, int* inv) {
    LAS float* P = (LAS float*)(F.lds + M1_P); LAS int* hist = (LAS int*)(F.lds + M1N_HIST); LAS int* basep = (LAS int*)(F.lds + M1N_BASE);
    const int tid = F.tid, lane = F.lane, w = F.wave, r = lane & 15, q = lane >> 4, pr = w >> 1, kh = w & 1;
    for (int item = F.bid; item < T / 64; item += F.G) {
        const int row0 = item * 64, row = row0 + 16 * pr + r;
        __syncthreads();
        if (tid < 64) hist[tid] = 0;
        float mean, rstd;
        { const f32x4* pp = (const f32x4*)(pst + ((size_t)row * 32 + q * 8) * 2); const f32x4 a = pp[0], b = pp[1], c = pp[2], d = pp[3];
          float sm = (a[0] + a[2]) + (b[0] + b[2]) + (c[0] + c[2]) + (d[0] + d[2]), sq = (a[1] + a[3]) + (b[1] + b[3]) + (c[1] + c[3]) + (d[1] + d[3]);
          sm += shfl_x(sm, 16, lane); sm += shfl_x(sm, 32, lane); sq += shfl_x(sq, 16, lane); sq += shfl_x(sq, 32, lane);
          mean = sm * (1.0f / D); const float var = fmaxf(sq * (1.0f / D) - mean * mean, 0.f); rstd = 1.0f / sqrtf(var + LN_EPS);
          if (kh == 0 && q == 0) *(f32x2*)(ST1 + 2 * row) = (f32x2){mean, rstd}; }
        const float* yp = Y + (size_t)row * D + kh * 1024 + 8 * q; const float* gp = gain + kh * 1024 + 8 * q; const float* bp = bias + kh * 1024 + 8 * q;
        const bf16* whp = WH + (size_t)r * D + kh * 1024 + 8 * q; const bf16* wlp = WL + (size_t)r * D + kh * 1024 + 8 * q;
        bf16* xo = X1B + (size_t)row * D + kh * 1024 + 8 * q;
        f32x4 acc[4];
#pragma unroll
        for (int nt = 0; nt < 4; ++nt) acc[nt] = (f32x4){0.f, 0.f, 0.f, 0.f};
#define M1_LOAD(S, st) do { const int _k = 32 * (st); S##y0 = *(const f32x4*)(yp + _k); S##y1 = *(const f32x4*)(yp + _k + 4); S##g0 = *(const f32x4*)(gp + _k); S##g1 = *(const f32x4*)(gp + _k + 4); \
            S##b0 = *(const f32x4*)(bp + _k); S##b1 = *(const f32x4*)(bp + _k + 4); \
            _Pragma("unroll") for (int nt = 0; nt < 4; ++nt) { S##wh[nt] = *(const bf16x8*)(whp + (size_t)nt * 16 * D + _k); S##wl[nt] = *(const bf16x8*)(wlp + (size_t)nt * 16 * D + _k); } } while (0)
#define M1_COMP(S, st) do { const f32x4 x0 = (S##y0 - mean) * rstd * S##g0 + S##b0, x1 = (S##y1 - mean) * rstd * S##g1 + S##b1; \
            v4u h; h.x = cvt_pk_bf16(x0[0], x0[1]); h.y = cvt_pk_bf16(x0[2], x0[3]); h.z = cvt_pk_bf16(x1[0], x1[1]); h.w = cvt_pk_bf16(x1[2], x1[3]); \
            *(v4u*)(xo + 32 * (st)) = h; \
            v4u l; l.x = cvt_pk_bf16(x0[0] - bflo(h.x), x0[1] - bfhi(h.x)); l.y = cvt_pk_bf16(x0[2] - bflo(h.y), x0[3] - bfhi(h.y)); \
            l.z = cvt_pk_bf16(x1[0] - bflo(h.z), x1[1] - bfhi(h.z)); l.w = cvt_pk_bf16(x1[2] - bflo(h.w), x1[3] - bfhi(h.w)); \
            const bf16x8 xh = __builtin_bit_cast(bf16x8, h), xl = __builtin_bit_cast(bf16x8, l); \
            _Pragma("unroll") for (int nt = 0; nt < 4; ++nt) { acc[nt] = __builtin_amdgcn_mfma_f32_16x16x32_bf16(xh, S##wh[nt], acc[nt], 0, 0, 0); \
                acc[nt] = __builtin_amdgcn_mfma_f32_16x16x32_bf16(xl, S##wh[nt], acc[nt], 0, 0, 0); acc[nt] = __builtin_amdgcn_mfma_f32_16x16x32_bf16(xh, S##wl[nt], acc[nt], 0, 0, 0); } } while (0)
        f32x4 Ay0, Ay1, Ag0, Ag1, Ab0, Ab1, By0, By1, Bg0, Bg1, Bb0, Bb1; bf16x8 Awh[4], Awl[4], Bwh[4], Bwl[4];
        M1_LOAD(A, 0);
        __builtin_amdgcn_sched_barrier(0);
#pragma unroll 1
        for (int st = 0; st < 32; st += 2) {
            M1_LOAD(B, st + 1);
            __builtin_amdgcn_sched_barrier(0);
            M1_COMP(A, st);
            __builtin_amdgcn_sched_barrier(0);
            if (st + 2 < 32) M1_LOAD(A, st + 2);
            __builtin_amdgcn_sched_barrier(0);
            M1_COMP(B, st + 1);
            __builtin_amdgcn_sched_barrier(0);
        }
#undef M1_LOAD
#undef M1_COMP
#pragma unroll
        for (int nt = 0; nt < 4; ++nt)
#pragma unroll
            for (int i = 0; i < 4; ++i) P[(kh * 64 + 16 * pr + 4 * q + i) * 64 + 16 * nt + r] = acc[nt][i];
        __syncthreads();
        int sel_pos[8]; float sel_gate[8]; int sel_rank[8]; bool sel_on[8];
        const float rb = RB[lane];
#pragma unroll
        for (int rr = 0; rr < 8; ++rr) { const int rl = 8 * w + rr;
            const float lg = P[rl * 64 + lane] + P[(64 + rl) * 64 + lane];
            const float sc = 1.0f / (1.0f + __expf(-lg)); const float ch = sc + rb;
            int rk = 0;
#pragma unroll
            for (int j = 0; j < 8; ++j) { const float cj = shfl_from(ch, (lane & ~7) + j); rk += (cj > ch || (cj == ch && j < (lane & 7))) ? 1 : 0; }
            float gs = rk < 2 ? ch : 0.f; gs += shfl_x(gs, 1, lane); gs += shfl_x(gs, 2, lane); gs += shfl_x(gs, 4, lane);
            int grk = 0; const int g = lane >> 3;
#pragma unroll
            for (int hh = 0; hh < 8; ++hh) { const float gh = shfl_from(gs, 8 * hh); grk += (gh > gs || (gh == gs && hh < g)) ? 1 : 0; }
            const float msk = grk < 4 ? ch : -INFINITY;
            int erk = 0;
            for (int j = 0; j < 64; ++j) { const float mj = __builtin_bit_cast(float, __builtin_amdgcn_readlane(__builtin_bit_cast(int, msk), j)); erk += (mj > msk || (mj == msk && j < lane)) ? 1 : 0; }
            const bool on = erk < 8;
            const float ssum = wave_sum(on ? sc : 0.f, lane);
            sel_on[rr] = on; sel_rank[rr] = erk; sel_gate[rr] = sc / ssum * 2.5f; sel_pos[rr] = 0;
            if (on) sel_pos[rr] = __hip_atomic_fetch_add(&hist[lane], 1, __ATOMIC_RELAXED, __HIP_MEMORY_SCOPE_WORKGROUP); }
        __syncthreads();
        if (tid < 64) { const int hc = hist[tid]; int bs = 0; if (hc > 0) bs = (int)atomicAdd(&cnt[tid * 16], (unsigned)hc); basep[tid] = bs; }
        __syncthreads();
#pragma unroll
        for (int rr = 0; rr < 8; ++rr) if (sel_on[rr]) { const int t = row0 + 8 * w + rr, pos = basep[lane] + sel_pos[rr];
            ltok[(size_t)lane * CAP + pos] = t * 8 + sel_rank[rr]; lgate[(size_t)lane * CAP + pos] = sel_gate[rr];
            eidx[t * 8 + sel_rank[rr]] = lane; inv[t * 8 + sel_rank[rr]] = pos; }
    }
}

constexpr int M3_PL = 131072, M3_CNT = 147456, M3_OFF = 147456 + 272;
__device__ __forceinline__ void phase_moe3n(const Frame& F, const bf16* H, const bf16* HSp, const int* eidx, const bf16* WD, const bf16* WSD,
                                            const float* Y1, const float* ST1, const float* g1, const float* b1, float* Y2, float* PST2) {
    LAS int* out = (LAS int*)F.lds; LAS unsigned short* plist = (LAS unsigned short*)(F.lds + M3_PL); LAS int* cnt = (LAS int*)(F.lds + M3_CNT); LAS int* off = (LAS int*)(F.lds + M3_OFF);
    const int tid = F.tid, lane = F.lane, w = F.wave, r = lane & 15, q = lane >> 4;
    for (int u = F.bid; u < 1024; u += F.G) {
        int nc = (u & 7) | ((u >> 7) << 3), tb = (u >> 3) & 15;
        if (F.G == 256) { const int i = u >> 8, x = u & 7, j = (u >> 3) & 31; tb = 2 * x + (i >> 1); nc = 32 * (i & 1) + j; }
        __syncthreads();
#pragma unroll
        for (int j = 0; j < 16; ++j) ((LAS v4u*)out)[tid + 512 * j] = (v4u){0u, 0u, 0u, 0u};
        if (tid < 66) cnt[tid] = 0;
        __syncthreads();
        int ee[16], pp[16];
        { const v4u* ep = (const v4u*)(eidx + ((size_t)tb * 1024 + 2 * tid) * 8); const v4u e0 = ep[0], e1 = ep[1], e2 = ep[2], e3 = ep[3];
          ee[0] = e0.x; ee[1] = e0.y; ee[2] = e0.z; ee[3] = e0.w; ee[4] = e1.x; ee[5] = e1.y; ee[6] = e1.z; ee[7] = e1.w;
          ee[8] = e2.x; ee[9] = e2.y; ee[10] = e2.z; ee[11] = e2.w; ee[12] = e3.x; ee[13] = e3.y; ee[14] = e3.z; ee[15] = e3.w; }
#pragma unroll
        for (int j = 0; j < 16; ++j) pp[j] = __hip_atomic_fetch_add(&cnt[ee[j]], 1, __ATOMIC_RELAXED, __HIP_MEMORY_SCOPE_WORKGROUP);
        __syncthreads();
        if (w == 0) { int c = cnt[lane], x = c;
#pragma unroll
            for (int o = 1; o < 64; o <<= 1) { const int y = __builtin_amdgcn_ds_bpermute(((lane - o) & 63) << 2, x); if (lane >= o) x += y; }
            off[lane] = x - c; if (lane == 63) off[64] = x; }
        __syncthreads();
#pragma unroll
        for (int j = 0; j < 16; ++j) plist[off[ee[j]] + pp[j]] = (unsigned short)(tid * 16 + j);
        __syncthreads();
        const char* Hb = (const char*)H + (size_t)tb * 8192 * 256 + q * 16;
        const char* HSb = (const char*)HSp + (size_t)tb * 1024 * 512 + q * 16;
        const char* Bb = (const char*)WD + ((size_t)nc * 32 + r) * 256 + q * 16;
        const char* BSb = (const char*)WSD + ((size_t)nc * 32 + r) * 512 + q * 16;
#define M3_NR(sg) ((sg) < 8 ? __builtin_amdgcn_readfirstlane(cnt[w + 8 * (sg)]) : 128)
#define M3_RB(sg) ((sg) < 8 ? __builtin_amdgcn_readfirstlane(off[w + 8 * (sg)]) : 0)
#define M3_GLD(dst, ptr, OFF) asm volatile("global_load_dwordx4 %0, %1, off offset:" #OFF : "=&v"(dst) : "v"(ptr) : "memory")
#define M3_LOADB(dst, sg) do { const char* _b0 = (sg) < 8 ? Bb + (size_t)(w + 8 * (sg)) * 524288 : BSb + ((sg) - 8) * 256; const char* _b1 = _b0 + ((sg) < 8 ? 4096 : 8192); \
            M3_GLD(dst[0][0], _b0, 0); M3_GLD(dst[0][1], _b0, 64); M3_GLD(dst[0][2], _b0, 128); M3_GLD(dst[0][3], _b0, 192); \
            M3_GLD(dst[1][0], _b1, 0); M3_GLD(dst[1][1], _b1, 64); M3_GLD(dst[1][2], _b1, 128); M3_GLD(dst[1][3], _b1, 192); } while (0)
#define M3_LOADA(dst, sg, bb, nr, rbs) do { int _i = 16 * (bb) + r; _i = _i < (nr) ? _i : (nr) - 1; const unsigned _rid = plist[(rbs) + _i]; \
            const char* _a = (sg) < 8 ? Hb + (size_t)_rid * 256 : ((sg) < 10 ? HSb + (size_t)(128 * w + _i) * 512 + ((sg) - 8) * 256 : Hb); \
            M3_GLD(dst[0], _a, 0); M3_GLD(dst[1], _a, 64); M3_GLD(dst[2], _a, 128); M3_GLD(dst[3], _a, 192); } while (0)
#define M3_ADV(sg, bb, nr, rbs) do { if ((sg) < 10) { ++(bb); if ((bb) * 16 >= (nr)) { (bb) = 0; do { ++(sg); } while ((sg) < 8 && M3_NR(sg) == 0); if ((sg) < 10) { (nr) = M3_NR(sg); (rbs) = M3_RB(sg); } } } } while (0)
#define M3_WAITA(AS) asm volatile("s_waitcnt vmcnt(12)" : "+v"(AS[0]), "+v"(AS[1]), "+v"(AS[2]), "+v"(AS[3]) :: "memory")
#define M3_WAITB(N) asm volatile("s_waitcnt vmcnt(" #N ")" : "+v"(Bn[0][0]), "+v"(Bn[0][1]), "+v"(Bn[0][2]), "+v"(Bn[0][3]), "+v"(Bn[1][0]), "+v"(Bn[1][1]), "+v"(Bn[1][2]), "+v"(Bn[1][3]) :: "memory")
#define M3_STEP(AS) if (cseg < 10) { \
              \
            int tk[4]; bool ok[4]; unsigned pl[4]; const int rt_ = cseg < 8; \
            _Pragma("unroll") for (int i = 0; i < 4; ++i) { const int idx = 16 * cbt + 4 * q + i; ok[i] = idx < cnr; const int ic = ok[i] ? idx : cnr - 1; pl[i] = plist[crbs + ic]; tk[i] = 128 * w + ic; } \
            _Pragma("unroll") for (int i = 0; i < 4; ++i) tk[i] = rt_ ? (int)(pl[i] >> 3) : tk[i]; \
            M3_WAITA(AS); \
            f32x4 acc[2]; \
            _Pragma("unroll") for (int nt = 0; nt < 2; ++nt) { acc[nt] = (f32x4){0.f, 0.f, 0.f, 0.f}; \
                _Pragma("unroll") for (int kk = 0; kk < 4; ++kk) acc[nt] = __builtin_amdgcn_mfma_f32_16x16x32_bf16(__builtin_bit_cast(bf16x8, AS[kk]), __builtin_bit_cast(bf16x8, Bc[nt][kk]), acc[nt], 0, 0, 0); } \
              \
            _Pragma("unroll") for (int i = 0; i < 4; ++i) { const long long lo_ = ok[i] ? (long long)__float2int_rn(acc[0][i] * 4194304.0f) : 0ll, hi_ = ok[i] ? (long long)__float2int_rn(acc[1][i] * 4194304.0f) : 0ll; \
                (void)__hip_atomic_fetch_add((LAS unsigned long long*)out + tk[i] * 16 + r, (unsigned long long)((hi_ << 32) + lo_), __ATOMIC_RELAXED, __HIP_MEMORY_SCOPE_WORKGROUP); } \
            M3_LOADA(AS, pseg, pbt, pnr, prbs); M3_ADV(pseg, pbt, pnr, prbs); \
            { const int old_ = cseg, nbat_ = (cnr + 15) >> 4; M3_ADV(cseg, cbt, cnr, crbs); \
              if (cseg != old_ && cseg < 10) { \
                  if (nbat_ == 1) M3_WAITB(4); else if (nbat_ == 2) M3_WAITB(8); else if (nbat_ == 3) M3_WAITB(12); else M3_WAITB(16); \
                  _Pragma("unroll") for (int nt = 0; nt < 2; ++nt) _Pragma("unroll") for (int kk = 0; kk < 4; ++kk) Bc[nt][kk] = Bn[nt][kk]; \
                  int nb_ = cseg; do { ++nb_; } while (nb_ < 8 && M3_NR(nb_) == 0); if (nb_ >= 10) nb_ = 9; M3_LOADB(Bn, nb_); } } }
        int cseg = -1, cbt = 0, cnr = 0, crbs = 0;
        do { ++cseg; } while (cseg < 8 && M3_NR(cseg) == 0);
        cnr = M3_NR(cseg); crbs = M3_RB(cseg);
        int pseg = cseg, pbt = 0, pnr = cnr, prbs = crbs;
        v4u Bc[2][4], Bn[2][4], A0[4], A1[4], A2[4], A3[4];
        M3_LOADB(Bc, cseg);
        M3_LOADA(A0, pseg, pbt, pnr, prbs); M3_ADV(pseg, pbt, pnr, prbs);
        M3_LOADA(A1, pseg, pbt, pnr, prbs); M3_ADV(pseg, pbt, pnr, prbs);
        M3_LOADA(A2, pseg, pbt, pnr, prbs); M3_ADV(pseg, pbt, pnr, prbs);
        M3_LOADA(A3, pseg, pbt, pnr, prbs); M3_ADV(pseg, pbt, pnr, prbs);
        { int nb_ = cseg; do { ++nb_; } while (nb_ < 8 && M3_NR(nb_) == 0); if (nb_ >= 10) nb_ = 9; M3_LOADB(Bn, nb_); }
        asm volatile("s_waitcnt vmcnt(0)" : "+v"(Bc[0][0]), "+v"(Bc[0][1]), "+v"(Bc[0][2]), "+v"(Bc[0][3]), "+v"(Bc[1][0]), "+v"(Bc[1][1]), "+v"(Bc[1][2]), "+v"(Bc[1][3]) :: "memory");
#pragma unroll 1
        while (cseg < 10) { M3_STEP(A0) M3_STEP(A1) M3_STEP(A2) M3_STEP(A3) }
        asm volatile("s_waitcnt vmcnt(0)" : "+v"(A0[0]), "+v"(A0[1]), "+v"(A0[2]), "+v"(A0[3]), "+v"(A1[0]), "+v"(A1[1]), "+v"(A1[2]), "+v"(A1[3]), "+v"(A2[0]), "+v"(A2[1]), "+v"(A2[2]), "+v"(A2[3]),
                     "+v"(A3[0]), "+v"(A3[1]), "+v"(A3[2]), "+v"(A3[3]), "+v"(Bn[0][0]), "+v"(Bn[0][1]), "+v"(Bn[0][2]), "+v"(Bn[0][3]), "+v"(Bn[1][0]), "+v"(Bn[1][1]), "+v"(Bn[1][2]), "+v"(Bn[1][3]) :: "memory");
#undef M3_NR
#undef M3_RB
#undef M3_GLD
#undef M3_LOADB
#undef M3_LOADA
#undef M3_ADV
#undef M3_WAITA
#undef M3_WAITB
#undef M3_STEP
        __syncthreads();
        { const int c4 = lane & 7, rs = lane >> 3, col = nc * 32 + 4 * c4;
          const f32x4 gv = *(const f32x4*)(g1 + col), bv = *(const f32x4*)(b1 + col);
#pragma unroll 4
          for (int it = 0; it < 16; ++it) { const int rl = 128 * w + 8 * it + rs; const size_t row = (size_t)tb * 1024 + rl;
              const f32x4 yv = *(const f32x4*)(Y1 + row * D + col); const f32x2 sv = *(const f32x2*)(ST1 + 2 * row);
              f32x4 tv; { const int nt = c4 >> 2, r0 = (4 * c4) & 15;
#pragma unroll
                  for (int j = 0; j < 4; ++j) { const v2u cell = *(const LAS v2u*)(out + rl * 32 + 2 * (r0 + j)); const int lo = (int)cell.x, hi = (int)cell.y + (lo < 0 ? 1 : 0); tv[j] = (float)(nt ? hi : lo) * (1.0f / 4194304.0f); } }
              const f32x4 y = ((yv - sv.x) * sv.y * gv + bv) * ALPHA + tv;
              *(f32x4*)(Y2 + row * D + col) = y;
              float sm = (y[0] + y[1]) + (y[2] + y[3]), sq = (y[0] * y[0] + y[1] * y[1]) + (y[2] * y[2] + y[3] * y[3]);
#pragma unroll
              for (int o = 1; o < 8; o <<= 1) { sm += shfl_x(sm, o, lane); sq += shfl_x(sq, o, lane); }
              if (c4 == 0) *(f32x2*)(PST2 + (row * 64 + nc) * 2) = (f32x2){sm, sq}; } }
    }
}

__device__ __forceinline__ void phase_moe4n(const Frame& F, const float* Y2, const float* pst, const float* gain, const float* bias, float* ST2, bf16* XBo, float* OUT, int last) {
    const int gw = F.bid * 8 + F.wave, NGW = F.G * 8, lane = F.lane;
    for (int t = gw; t < T; t += NGW) {
        f32x4 v[8];
#pragma unroll
        for (int j = 0; j < 8; ++j) v[j] = *(const f32x4*)(Y2 + (size_t)t * D + 4 * lane + 256 * j);
        const f32x2 pv = *(const f32x2*)(pst + ((size_t)t * 64 + lane) * 2);
        const float mean = wave_sum(pv.x, lane) * (1.0f / D); const float var = fmaxf(wave_sum(pv.y, lane) * (1.0f / D) - mean * mean, 0.f); const float rstd = 1.0f / sqrtf(var + LN_EPS);
        if (lane == 0) *(f32x2*)(ST2 + 2 * (size_t)t) = (f32x2){mean, rstd};
#pragma unroll
        for (int j = 0; j < 8; ++j) { const int c = 4 * lane + 256 * j; const f32x4 o = (v[j] - mean) * rstd * *(const f32x4*)(gain + c) + *(const f32x4*)(bias + c);
            if (last) *(f32x4*)(OUT + (size_t)t * D + c) = o;
            else { v2u wb; wb.x = pk2(o[0], o[1]); wb.y = pk2(o[2], o[3]); *(v2u*)(XBo + (size_t)t * D + c) = wb; } }
    }
}


__device__ __forceinline__ void phase_moe4g(const Frame& F, float* Y2, const bf16* Yr, const int* eidx, const int* inv, const float* gain, const float* bias, float* ST2, bf16* XBo, float* OUT, int last) {
    const LAS int* tpref = (const LAS int*)(F.lds + LDS_TAB);
    const int gw = F.bid * 8 + F.wave, NGW = F.G * 8, lane = F.lane;
    for (int t = gw; t < T; t += NGW) {
        int rowi = 0; if (lane < 8) { const int e = eidx[t * 8 + lane], ps = inv[t * 8 + lane]; rowi = tpref[e] * 256 + ps; }
        const bf16* rp[8];
#pragma unroll
        for (int k = 0; k < 8; ++k) rp[k] = Yr + (size_t)__builtin_amdgcn_readlane(rowi, k) * D + 4 * lane;
        f32x4 v[8]; v2u yv[8][8];
#pragma unroll
        for (int j = 0; j < 8; ++j) v[j] = *(const f32x4*)(Y2 + (size_t)t * D + 4 * lane + 256 * j);
#pragma unroll
        for (int k = 0; k < 8; ++k)
#pragma unroll
            for (int j = 0; j < 8; ++j) yv[k][j] = *(const v2u*)(rp[k] + 256 * j);
#pragma unroll
        for (int k = 0; k < 8; ++k) asm volatile("" : "+v"(yv[k][0]), "+v"(yv[k][1]), "+v"(yv[k][2]), "+v"(yv[k][3]), "+v"(yv[k][4]), "+v"(yv[k][5]), "+v"(yv[k][6]), "+v"(yv[k][7]));
#pragma unroll
        for (int k = 0; k < 8; ++k)
#pragma unroll
            for (int j = 0; j < 8; ++j) { v[j][0] += bflo(yv[k][j].x); v[j][1] += bfhi(yv[k][j].x); v[j][2] += bflo(yv[k][j].y); v[j][3] += bfhi(yv[k][j].y); }
        float sm = 0.f;
#pragma unroll
        for (int j = 0; j < 8; ++j) sm += (v[j][0] + v[j][1]) + (v[j][2] + v[j][3]);
        const float mean = wave_sum(sm, lane) * (1.0f / D); float sq = 0.f;
#pragma unroll
        for (int j = 0; j < 8; ++j) { const f32x4 d = v[j] - mean; sq += (d[0] * d[0] + d[1] * d[1]) + (d[2] * d[2] + d[3] * d[3]); }
        const float rstd = 1.0f / sqrtf(wave_sum(sq, lane) * (1.0f / D) + LN_EPS);
        if (lane == 0) *(f32x2*)(ST2 + 2 * (size_t)t) = (f32x2){mean, rstd};
#pragma unroll
        for (int j = 0; j < 8; ++j) { const int c = 4 * lane + 256 * j;
            if (!last) *(f32x4*)(Y2 + (size_t)t * D + c) = v[j];
            const f32x4 o = (v[j] - mean) * rstd * *(const f32x4*)(gain + c) + *(const f32x4*)(bias + c);
            if (last) *(f32x4*)(OUT + (size_t)t * D + c) = o;
            else { v2u wb; wb.x = pk2(o[0], o[1]); wb.y = pk2(o[2], o[3]); *(v2u*)(XBo + (size_t)t * D + c) = wb; } }
    }
}

enum { PH_PRO = 0, PH_POOL_G1, PH_POOL_P, PH_POOL_G2, PH_POOL_G3, PH_DIL_G1, PH_DIL_ATT, PH_DIL_CMB, PH_DIL_G2, PH_CONV_G1, PH_CONV_E, PH_CONV_G2, PH_MOE1, PH_MOE2, PH_MOE3, PH_MOE4, PH_COUNT };

template <int PH>
__device__ __forceinline__ void run_phase(const Frame& Fin, const Args& args_, const int L) {
    Frame F = Fin; { int w_ = Fin.wave, l_; asm volatile("" : "+s"(w_)); asm volatile("v_mbcnt_lo_u32_b32 %0, -1, 0\n\tv_mbcnt_hi_u32_b32 %0, -1, %0" : "=v"(l_)); F.wave = w_; F.lane = l_; F.tid = w_ * 64 + l_; }
    unsigned char* ws; { GAS unsigned char* wsg = (GAS unsigned char*)Fin.ws; asm volatile("" : "+s"(wsg)); ws = (unsigned char*)wsg; } F.ws = ws; F.ctl = (unsigned*)(ws + WS_CTL);
    KP kp = (KP)__builtin_amdgcn_kernarg_segment_ptr(); asm volatile("" : "+s"(kp)); (void)args_;
    { unsigned l_ = (unsigned)(size_t)Fin.lds; asm volatile("" : "+s"(l_)); F.lds = (LAS unsigned char*)(size_t)l_; }
    LAS unsigned char* ring = F.lds; int c = (int)blockIdx.x; { int g_ = Fin.G; asm volatile("" : "+s"(c), "+s"(g_)); F.G = g_; F.bid = c; }
    const float* xres = (L == 0) ? ain(kp, IN_X) : (const float*)(ws + WS_Y2F);
    const float* st2 = (const float*)(ws + WS_ST2); float* pstp = (float*)(ws + WS_PST);
    const float* g2p = ain(kp, IN_LNG) + (size_t)((L > 0 ? L - 1 : 0) * 2 + 1) * D; const float* b2p = ain(kp, IN_LNB) + (size_t)((L > 0 ? L - 1 : 0) * 2 + 1) * D;
    const bf16* xb = (const bf16*)(ws + WS_XB);
    float* yf = (float*)(ws + WS_YF);
    unsigned char* big = ws + WS_BIG;
    const int ia = L / 3;
    if constexpr (PH == PH_PRO) { phase_prologue(F, kp); }
    if constexpr (PH == PH_POOL_G1) { g8::DenseSched S; S.init(xb, (const bf16*)(ws + WS_W_POOL_IN) + (size_t)ia * D * D, T, D, D, D, F.G, c);
        g8::EpiBf16 E{(bf16*)(big + BG_U), D, 0}; g8::gemm_phase<g8::EpiBf16, g8::DenseSched, false>(ring, F.tid, D, D, D, S, E); }
    if constexpr (PH == PH_POOL_P) { phase_pool(F, (const bf16*)(big + BG_U), (bf16*)(big + BG_PL)); }
    if constexpr (PH == PH_POOL_G2) { g8::DenseSched S; S.init((const bf16*)(big + BG_PL), (const bf16*)(ws + WS_W_POOL_G) + (size_t)ia * D * 512, T, D, D, 512, F.G, c); S.agrp_shift = 1; S.agrp_stride = 512 * 2;
        g8::EpiScaleBf16 E{(bf16*)(big + BG_MX), D, ain(kp, IN_PSC) + (size_t)ia * D}; g8::gemm_phase<g8::EpiScaleBf16, g8::DenseSched, false>(ring, F.tid, 512, D, 512, S, E); }
    if constexpr (PH == PH_POOL_G3) { g8::DenseSched S; S.init((const bf16*)(big + BG_MX), (const bf16*)(ws + WS_W_POOL_OUT) + (size_t)ia * D * D, T, D, D, D, F.G, c);
        g8::EpiResidLN E{xres, st2, g2p, b2p, yf, pstp, L > 0}; g8::gemm_phase<g8::EpiResidLN, g8::DenseSched, false>(ring, F.tid, D, D, D, S, E); }
    if constexpr (PH == PH_DIL_G1) { g8::DenseSched S; S.init(xb, (const bf16*)(ws + WS_W_DIL_QKV), T, QKVC, D, D, F.G, c);
        g8::EpiBf16 E{(bf16*)(big + BG_QKV), QKVC, 1}; g8::gemm_phase<g8::EpiBf16, g8::DenseSched, false>(ring, F.tid, D, D, D, S, E); }
    if constexpr (PH == PH_DIL_ATT) { phase_attn(F, (const bf16*)(big + BG_QKV), ain(kp, IN_RELB), (bf16*)(big + BG_OG), (float*)(big + BG_LSE)); }
    if constexpr (PH == PH_DIL_CMB) { phase_combine(F, (const bf16*)(big + BG_OG), (const float*)(big + BG_LSE), (bf16*)(big + BG_O)); }
    if constexpr (PH == PH_DIL_G2) { g8::DenseSched S; S.init((const bf16*)(big + BG_O), (const bf16*)(ws + WS_W_DIL_OUT), T, D, DILW, DILW, F.G, c);
        g8::EpiResidLN E{xres, st2, g2p, b2p, yf, pstp, L > 0}; g8::gemm_phase<g8::EpiResidLN, g8::DenseSched, false>(ring, F.tid, DILW, DILW, DILW, S, E); }
    if constexpr (PH == PH_CONV_G1) { g8::DenseSched S; S.init(xb, (const bf16*)(ws + WS_W_CONV_IN), T, 3 * D, D, D, F.G, c);
        g8::EpiConvIn E{(bf16*)(big + BG_UC), (bf16*)(big + BG_BG)}; g8::gemm_phase<g8::EpiConvIn, g8::DenseSched, false>(ring, F.tid, D, D, D, S, E); }
    if constexpr (PH == PH_CONV_E) { phase_conv(F, (const bf16*)(big + BG_UC), (const bf16*)(big + BG_BG), ain(kp, IN_CW), (bf16*)(big + BG_Z)); }
    if constexpr (PH == PH_CONV_G2) { g8::DenseSched S; S.init((const bf16*)(big + BG_Z), (const bf16*)(ws + WS_W_CONV_OUT), T, D, D, D, F.G, c);
        g8::EpiResidLN E{xres, st2, g2p, b2p, yf, pstp, L > 0}; g8::gemm_phase<g8::EpiResidLN, g8::DenseSched, false>(ring, F.tid, D, D, D, S, E); }
    unsigned* cnt = F.ctl + CW_CNT + L * 64 * 16;
    float* x1f = (float*)(ws + WS_X1F); bf16* x1b = (bf16*)(ws + WS_X1B);
    int* ltok = (int*)(ws + WS_LTOK); float* lgate = (float*)(ws + WS_LGATE); int* eidx = (int*)(ws + WS_EIDX); int* inv = (int*)(ws + WS_INV);
    bf16* HB = (bf16*)(ws + WS_HB); bf16* HS = (bf16*)(ws + WS_HS); bf16* Yr = (bf16*)(ws + WS_BIG);
    if constexpr (PH == PH_MOE1) {
        const float* g1 = ain(kp, IN_LNG) + (size_t)(L * 2 + 0) * D; const float* b1 = ain(kp, IN_LNB) + (size_t)(L * 2 + 0) * D;
        phase_moe1n(F, yf, pstp, g1, b1, (const bf16*)(ws + WS_RWH) + (size_t)L * NEXP * D, (const bf16*)(ws + WS_RWL) + (size_t)L * NEXP * D, ain(kp, IN_RB) + (size_t)L * NEXP,
                    x1b, (float*)(ws + WS_ST1), cnt, ltok, lgate, eidx, inv); }
    if constexpr (PH == PH_MOE2) {
        const int NT = build_tiles(F, cnt);
        { g8::ExpertSched<1, true> S; S.tpref = (const LAS int*)(F.lds + LDS_TAB); S.cnt = (const LAS int*)(F.lds + LDS_TAB + 512); S.A = (const char*)x1b; S.B = (const char*)((const bf16*)(ws + WS_W_EX_GU) + (size_t)L * 64 * 256 * D);
          S.tok = ltok; S.b_exp = (size_t)256 * D * 2; S.b_tile = 0; S.a_tile = 0; S.NU = NT; S.G = F.G; S.c = c;
          g8::EpiExpertGU E{HB}; g8::gemm_phase<g8::EpiExpertGU, g8::ExpertSched<1, true>, true>(ring, F.tid, D, D, D, S, E); }
        { const int rot = (c - (NT % F.G) + F.G) % F.G;
          g8::DenseSched S; S.init(x1b, (const bf16*)(ws + WS_W_SH_GU) + (size_t)L * 512 * D, T, 512, D, D, F.G, rot);
          int t2 = F.tid; asm volatile("" : "+v"(t2));
          g8::EpiSharedGU E{HS}; g8::gemm_phase<g8::EpiSharedGU, g8::DenseSched, false>(ring, t2, D, D, D, S, E); } }
    if constexpr (PH == PH_MOE3) {
        const float* g1 = ain(kp, IN_LNG) + (size_t)(L * 2 + 0) * D; const float* b1 = ain(kp, IN_LNB) + (size_t)(L * 2 + 0) * D;
        const int NT = build_tiles(F, cnt);
        { g8::ExpertSched<8, false> S; S.tpref = (const LAS int*)(F.lds + LDS_TAB); S.cnt = (const LAS int*)(F.lds + LDS_TAB + 512); S.A = (const char*)HB; S.B = (const char*)((const bf16*)(ws + WS_W_EX_D) + (size_t)L * 64 * D * EDIM);
          S.tok = ltok; S.b_exp = (size_t)D * EDIM * 2; S.b_tile = (size_t)256 * EDIM * 2; S.a_tile = (size_t)256 * EDIM * 2; S.NU = NT * 8; S.G = F.G; S.c = c;
          int kd = EDIM; asm volatile("" : "+s"(kd));
          g8::EpiDownY E{Yr}; g8::gemm_phase<g8::EpiDownY, g8::ExpertSched<8, false>, false>(ring, F.tid, kd, kd, kd, S, E); }
        { const int rot = (c - ((NT * 8) % F.G) + F.G) % F.G;
          g8::DenseSched S; S.init(HS, (const bf16*)(ws + WS_W_SH_D) + (size_t)L * D * SDIM, T, D, SDIM, SDIM, F.G, rot);
          int t2 = F.tid; asm volatile("" : "+v"(t2));
          int ks = SDIM; asm volatile("" : "+s"(ks));
          g8::EpiResidLN E{yf, (const float*)(ws + WS_ST1), g1, b1, (float*)(ws + WS_Y2F), pstp, 1}; g8::gemm_phase<g8::EpiResidLN, g8::DenseSched, false>(ring, t2, ks, ks, ks, S, E); } }
    if constexpr (PH == PH_MOE4) { (void)build_tiles(F, cnt);
        const float* g2 = ain(kp, IN_LNG) + (size_t)(L * 2 + 1) * D; const float* b2 = ain(kp, IN_LNB) + (size_t)(L * 2 + 1) * D;
        phase_moe4g(F, (float*)(ws + WS_Y2F), Yr, eidx, inv, g2, b2, (float*)(ws + WS_ST2), (bf16*)(ws + WS_XB), aout(kp), L == DEPTH - 1); }
}
__device__ __forceinline__ void make_frame(Frame& F, const Args& args) {
    extern __shared__ __attribute__((aligned(16))) unsigned char lds_raw[];
    F.lds = (LAS unsigned char*)lds_raw; F.ws = args.ws; F.ctl = (unsigned*)(args.ws + WS_CTL);
    F.tid = threadIdx.x; F.lane = F.tid & 63; F.wave = __builtin_amdgcn_readfirstlane(F.tid >> 6); F.G = gridDim.x; F.bid = blockIdx.x;
}
template <int PH> __global__ void __launch_bounds__(512, 2) k_phase(Args args, int L) {
    Frame F; make_frame(F, args);
    run_phase<PH>(F, args, L);
}

#ifndef MK_NOINLINE
#define MK_NOINLINE 0
#endif
#if MK_NOINLINE
template <int PH> __device__ __noinline__ void call_phase_ni(const int L) {
    Args dummy{}; Frame F;
    KP kp = (KP)__builtin_amdgcn_kernarg_segment_ptr();
    extern __shared__ __attribute__((aligned(16))) unsigned char lds_raw[];
    F.lds = (LAS unsigned char*)lds_raw; F.ws = (unsigned char*)((GAS unsigned char* const CAS*)kp)[20]; F.ctl = (unsigned*)(F.ws + WS_CTL);
    F.tid = threadIdx.x; F.lane = F.tid & 63; F.wave = __builtin_amdgcn_readfirstlane(F.tid >> 6); F.G = gridDim.x; F.bid = blockIdx.x;
    run_phase<PH>(F, dummy, L);
}
template <int PH> __device__ __forceinline__ void call_phase(const Frame& F, const Args& args, const int L) { call_phase_ni<PH>(L); }
#else
template <int PH> __device__ __forceinline__ void call_phase(const Frame& F, const Args& args, const int L) { asm volatile("; PHASE_BEGIN %0" :: "n"(PH)); run_phase<PH>(F, args, L); asm volatile("; PHASE_END %0" :: "n"(PH)); }
#endif
__global__ void __launch_bounds__(512, 2) fwd_all(Args args) {
    Frame F; make_frame(F, args);
    volatile LAS unsigned* misc = (volatile LAS unsigned*)(F.lds + LDS_MISC);
    if (F.tid < 4) misc[F.tid] = 0u;
    __syncthreads();
    const int lo = args.ph_lo, hi = args.ph_hi;
    XcdBarrier bar; bar.bar = F.ctl + CW_BAR; bar.x = 0; bar.st = misc;
    if (hi - lo > 1) bar = xcd_barrier_post(F.ctl + CW_BAR, misc);
    int pc = 0;
#ifndef MK_DUP_MASK
#define MK_DUP_MASK 0
#endif
#define STEP(PH, Lx) do { if (pc >= lo && pc < hi) { if ((MK_DUP_MASK >> (PH)) & 1) { call_phase<PH>(F, args, Lx); xcd_barrier(bar); } call_phase<PH>(F, args, Lx); if (pc + 1 < hi) xcd_barrier(bar); } ++pc; } while (0)
    STEP(PH_PRO, 0);
#pragma unroll 1
    for (int L = 0; L < DEPTH; ++L) {
        const int kind = L % 3;
        if (kind == 0) { STEP(PH_POOL_G1, L); STEP(PH_POOL_P, L); STEP(PH_POOL_G2, L); STEP(PH_POOL_G3, L); }
        else if (kind == 1) { STEP(PH_DIL_G1, L); STEP(PH_DIL_ATT, L); STEP(PH_DIL_CMB, L); STEP(PH_DIL_G2, L); }
        else { STEP(PH_CONV_G1, L); STEP(PH_CONV_E, L); STEP(PH_CONV_G2, L); }
        STEP(PH_MOE1, L); STEP(PH_MOE2, L); STEP(PH_MOE3, L); STEP(PH_MOE4, L);
    }
#undef STEP
}
constexpr int N_STEPS = 1 + 2 * 8 + 8 + 7;

template <int PH> static void launch_phase(const Args& a, int L, int grid, hipStream_t stream) {
    static bool attr = false;
    if (!attr) { (void)hipFuncSetAttribute((const void*)k_phase<PH>, hipFuncAttributeMaxDynamicSharedMemorySize, LDS_BYTES); attr = true; }
    hipLaunchKernelGGL(k_phase<PH>, dim3(grid), dim3(512), LDS_BYTES, stream, a, L);
}
extern "C" void kernel_launch(void* const* d_in, const int* in_sizes, int n_in, void* d_out, int out_size, void* d_ws, size_t ws_size, hipStream_t stream) {
    static int grid = 0;
    if (grid == 0) {
        if (n_in != 19 || out_size != T * D || ws_size < WS_END) { fprintf(stderr, "kernel_launch: unexpected shapes (n_in %d out %d ws %zu need %zu)\n", n_in, out_size, ws_size, (size_t)WS_END); grid = -1; return; }
        int dev = 0, cus = 0;
        if (hipGetDevice(&dev) != hipSuccess || hipDeviceGetAttribute(&cus, hipDeviceAttributeMultiprocessorCount, dev) != hipSuccess) { grid = -1; return; }
#if MK_ONE_LAUNCH
        if (hipFuncSetAttribute((const void*)fwd_all, hipFuncAttributeMaxDynamicSharedMemorySize, LDS_BYTES) != hipSuccess) { fprintf(stderr, "kernel_launch: hipFuncSetAttribute failed\n"); grid = -1; return; }
        int per_cu = 0;
        if (hipOccupancyMaxActiveBlocksPerMultiprocessor(&per_cu, (const void*)fwd_all, 512, LDS_BYTES) != hipSuccess || per_cu < 1) { fprintf(stderr, "kernel_launch: note: occupancy query reports %d blocks per CU\n", per_cu); (void)hipGetLastError(); }
#endif
        grid = cus;
    }
    if (grid < 0) return;
    (void)hipMemsetAsync((char*)d_ws + WS_CTL, 0, CTL_ZERO_BYTES, stream);
    Args a{};
    for (int i = 0; i < 19; ++i) a.in[i] = (const float*)d_in[i];
    a.out = (float*)d_out; a.ws = (unsigned char*)d_ws; a.ph_lo = 0; a.ph_hi = 0;
#if MK_ONE_LAUNCH
#ifdef MK_SPLIT
    for (int p = 0; p < N_STEPS; ++p) { a.ph_lo = p; a.ph_hi = p + 1; hipLaunchKernelGGL(fwd_all, dim3(grid), dim3(512), LDS_BYTES, stream, a); }
#else
    a.ph_lo = 0; a.ph_hi = N_STEPS;
    hipLaunchKernelGGL(fwd_all, dim3(grid), dim3(512), LDS_BYTES, stream, a);
#endif
#elif defined(MK_HYBRID_MASK)
    {
        static bool attr2 = false; if (!attr2) { (void)hipFuncSetAttribute((const void*)fwd_all, hipFuncAttributeMaxDynamicSharedMemorySize, LDS_BYTES); attr2 = true; }
        int pc = 0;
#define HSTEP(PH, Lx) do { if ((MK_HYBRID_MASK >> (PH)) & 1) { a.ph_lo = pc; a.ph_hi = pc + 1; hipLaunchKernelGGL(fwd_all, dim3(grid), dim3(512), LDS_BYTES, stream, a); } else { a.ph_lo = 0; a.ph_hi = 0; launch_phase<PH>(a, Lx, grid, stream); } ++pc; } while (0)
        HSTEP(PH_PRO, 0);
        for (int L = 0; L < DEPTH; ++L) {
            const int kind = L % 3;
            if (kind == 0) { HSTEP(PH_POOL_G1, L); HSTEP(PH_POOL_P, L); HSTEP(PH_POOL_G2, L); HSTEP(PH_POOL_G3, L); }
            else if (kind == 1) { HSTEP(PH_DIL_G1, L); HSTEP(PH_DIL_ATT, L); HSTEP(PH_DIL_CMB, L); HSTEP(PH_DIL_G2, L); }
            else { HSTEP(PH_CONV_G1, L); HSTEP(PH_CONV_E, L); HSTEP(PH_CONV_G2, L); }
            HSTEP(PH_MOE1, L); HSTEP(PH_MOE2, L); HSTEP(PH_MOE3, L); HSTEP(PH_MOE4, L);
        }
#undef HSTEP
    }
#else
    launch_phase<PH_PRO>(a, 0, grid, stream);
    for (int L = 0; L < DEPTH; ++L) {
        const int kind = L % 3;
        if (kind == 0) { launch_phase<PH_POOL_G1>(a, L, grid, stream); launch_phase<PH_POOL_P>(a, L, grid, stream); launch_phase<PH_POOL_G2>(a, L, grid, stream); launch_phase<PH_POOL_G3>(a, L, grid, stream); }
        else if (kind == 1) { launch_phase<PH_DIL_G1>(a, L, grid, stream); launch_phase<PH_DIL_ATT>(a, L, grid, stream); launch_phase<PH_DIL_CMB>(a, L, grid, stream); launch_phase<PH_DIL_G2>(a, L, grid, stream); }
        else { launch_phase<PH_CONV_G1>(a, L, grid, stream); launch_phase<PH_CONV_E>(a, L, grid, stream); launch_phase<PH_CONV_G2>(a, L, grid, stream); }
        launch_phase<PH_MOE1>(a, L, grid, stream); launch_phase<PH_MOE2>(a, L, grid, stream); launch_phase<PH_MOE3>(a, L, grid, stream); launch_phase<PH_MOE4>(a, L, grid, stream);
    }
#endif
}
```

```cpp
#include <hip/hip_runtime.h>
#include <cstdio>
#include <cstdint>

#ifndef MK_ONE_LAUNCH
#define MK_ONE_LAUNCH 1
#endif

#define GAS __attribute__((address_space(1)))
#define LAS __attribute__((address_space(3)))
typedef unsigned short bf16;
typedef unsigned v4u __attribute__((ext_vector_type(4)));
typedef unsigned v2u __attribute__((ext_vector_type(2)));
typedef float f32x4 __attribute__((ext_vector_type(4)));
typedef float f32x2 __attribute__((ext_vector_type(2)));
typedef short bf16x8 __attribute__((ext_vector_type(8)));
typedef short s16x4 __attribute__((ext_vector_type(4)));

constexpr int NBATCH = 8, SEQ = 2048, D = 2048, T = NBATCH * SEQ, DEPTH = 4;
constexpr int NEXP = 64, TOPK = 8, EDIM = 128, SDIM = 256;
constexpr int QKVC = 4608, DILW = 512;
constexpr float ALPHA = 1.681792830507429f;
constexpr float LN_EPS = 1e-5f;
constexpr int CAP = 16384;
constexpr int HROWS = T * TOPK + NEXP * 256;

constexpr size_t MiB = 1u << 20;
constexpr size_t WS_CTL = 0, CTL_ZERO_BYTES = 1 * MiB;
constexpr size_t WS_W_POOL_IN = 1 * MiB;
constexpr size_t WS_W_POOL_G = WS_W_POOL_IN + 16 * MiB;
constexpr size_t WS_W_POOL_OUT = WS_W_POOL_G + 4 * MiB;
constexpr size_t WS_W_DIL_QKV = WS_W_POOL_OUT + 16 * MiB;
constexpr size_t WS_W_DIL_OUT = WS_W_DIL_QKV + 18 * MiB;
constexpr size_t WS_W_CONV_IN = WS_W_DIL_OUT + 2 * MiB;
constexpr size_t WS_W_CONV_OUT = WS_W_CONV_IN + 24 * MiB;
constexpr size_t WS_W_SH_GU = WS_W_CONV_OUT + 8 * MiB;
constexpr size_t WS_W_SH_D = WS_W_SH_GU + 8 * MiB;
constexpr size_t WS_W_EX_GU = WS_W_SH_D + 4 * MiB;
constexpr size_t WS_W_EX_D = WS_W_EX_GU + 256 * MiB;
constexpr size_t WS_XF = WS_W_EX_D + 256 * MiB;
constexpr size_t WS_YF = WS_XF + 128 * MiB;
constexpr size_t WS_X1F = WS_YF + 128 * MiB;
constexpr size_t WS_XB = WS_X1F + 128 * MiB;
constexpr size_t WS_X1B = WS_XB + 64 * MiB;
constexpr size_t WS_HB = WS_X1B + 64 * MiB;
constexpr size_t WS_HS = WS_HB + 72 * MiB;
constexpr size_t WS_LTOK = WS_HS + 8 * MiB;
constexpr size_t WS_LGATE = WS_LTOK + 4 * MiB;
constexpr size_t WS_EIDX = WS_LGATE + 4 * MiB;
constexpr size_t WS_INV = WS_EIDX + 1 * MiB;
constexpr size_t WS_BIG = WS_INV + 1 * MiB;
constexpr size_t WS_PST = WS_BIG + 608 * MiB;
constexpr size_t WS_ST1 = WS_PST + 4 * MiB;
constexpr size_t WS_ST2 = WS_ST1 + 1 * MiB;
constexpr size_t WS_RWH = WS_ST2 + 1 * MiB;
constexpr size_t WS_RWL = WS_RWH + 1 * MiB;
constexpr size_t WS_PST2 = WS_RWL + 1 * MiB;
constexpr size_t WS_END = WS_PST2 + 8 * MiB;
constexpr size_t WS_Y2F = WS_X1F;
constexpr size_t BG_U = 0, BG_PL = 64 * MiB, BG_MX = 128 * MiB;
constexpr size_t BG_QKV = 0, BG_OG = 144 * MiB, BG_LSE = 192 * MiB, BG_O = 194 * MiB;
constexpr size_t BG_UC = 0, BG_BG = 64 * MiB, BG_Z = 128 * MiB;
constexpr int CW_BAR = 4096;
constexpr int CW_CNT = 16384;

constexpr int RING_BYTES = 131072;
constexpr int LDS_TAB = RING_BYTES;
constexpr int LDS_STASH = RING_BYTES + 1024;
constexpr int LDS_BYTES = 163840;
constexpr int LDS_MISC = LDS_BYTES - 1024;

__device__ __forceinline__ unsigned cvt_pk_bf16(float lo, float hi) { unsigned r; asm volatile("v_cvt_pk_bf16_f32 %0, %1, %2" : "=v"(r) : "v"(lo), "v"(hi)); return r; }
__device__ __forceinline__ unsigned f2bf(float f) { unsigned u = __builtin_bit_cast(unsigned, f); return (u + 0x7fffu + ((u >> 16) & 1u)) >> 16; }
__device__ __forceinline__ unsigned pk2(float lo, float hi) { return f2bf(lo) | (f2bf(hi) << 16); }
__device__ __forceinline__ float bflo(unsigned w) { return __builtin_bit_cast(float, w << 16); }
__device__ __forceinline__ float bfhi(unsigned w) { return __builtin_bit_cast(float, w & 0xffff0000u); }
__device__ __forceinline__ float shfl_from(float v, int src) { return __builtin_bit_cast(float, __builtin_amdgcn_ds_bpermute(src << 2, __builtin_bit_cast(int, v))); }
__device__ __forceinline__ float shfl_x(float v, int o, int lane) { return shfl_from(v, lane ^ o); }
__device__ __forceinline__ float wave_sum(float v, int lane) {
#pragma unroll
    for (int o = 1; o < 64; o <<= 1) v += shfl_x(v, o, lane);
    return v;
}
#define LDS_WAIT() asm volatile("s_waitcnt lgkmcnt(0)" ::: "memory")
#define VM_WAIT() asm volatile("s_waitcnt vmcnt(0)" ::: "memory")

#define XB_TMO      128
#define XB_XCNT(j)  (256  + 64 * (j))
#define XB_XSUB(j)  (1280 + 64 * (j))
#define XB_XGEN(j)  (2304 + 64 * (j))
#define XB_TOP      3328
#define XB_TOPGEN   3392
#define XCD_BAR_WORDS 3456
#define XB_SPIN_CAP (1u << 18)

__device__ __forceinline__ unsigned xb_ld(unsigned* p)              { return __hip_atomic_load(p, __ATOMIC_RELAXED, __HIP_MEMORY_SCOPE_AGENT); }
__device__ __forceinline__ unsigned xb_add(unsigned* p, unsigned v) { return __hip_atomic_fetch_add(p, v, __ATOMIC_RELAXED, __HIP_MEMORY_SCOPE_AGENT); }
__device__ __forceinline__ unsigned xb_xcc_id() { return (unsigned)__builtin_amdgcn_s_getreg((3 << 11) | 20) & 0xFu; }
#define XB_SPIN(cond, bar) do { unsigned _sp = 0; while (cond) { __builtin_amdgcn_s_sleep(1); \
    if ((++_sp & 255u) == 0u) { if (xb_ld(&(bar)[XB_TMO])) break; if (_sp > XB_SPIN_CAP) { atomicAdd(&(bar)[XB_TMO], 1u); break; } } } } while (0)

struct XcdBarrier {
    unsigned* bar; unsigned x;
    volatile LAS unsigned* st;
};

__device__ __forceinline__ XcdBarrier xcd_barrier_post(unsigned* bar, volatile LAS unsigned* st) {
    XcdBarrier b; b.bar = bar; b.x = xb_xcc_id(); b.st = st;
    if (threadIdx.x == 0) (void)xb_add(&bar[XB_XCNT(b.x)], 1u);
    return b;
}
__device__ __forceinline__ void xcd_barrier_complete(unsigned* bar, unsigned x, unsigned& nloc, unsigned& nx) {
    const unsigned G = gridDim.x * gridDim.y * gridDim.z;
    unsigned sum, cnt, mine, sp = 0u;
    for (;;) {
        sum = 0u; cnt = 0u; mine = 0u;
#pragma unroll
        for (unsigned j = 0; j < 16; ++j) { const unsigned c = xb_ld(&bar[XB_XCNT(j)]); sum += c; cnt += (c > 0u) ? 1u : 0u; mine = (j == x) ? c : mine; }
        if (sum == G) break;
        __builtin_amdgcn_s_sleep(1);
        if ((++sp & 255u) == 0u) { if (xb_ld(&bar[XB_TMO])) break; if (sp > XB_SPIN_CAP) { atomicAdd(&bar[XB_TMO], 1u); break; } }
    }
    nloc = mine > 0u ? mine : 1u; nx = cnt > 0u ? cnt : 1u;
}

__device__ __forceinline__ void xcd_barrier(const XcdBarrier& b) {
    asm volatile("s_waitcnt vmcnt(0)" ::: "memory");
    __syncthreads();
    if (threadIdx.x == 0) {
        unsigned* bar; unsigned bx = b.x; { GAS unsigned* bg = (GAS unsigned*)b.bar; asm volatile("" : "+s"(bg), "+s"(bx)); bar = (unsigned*)bg; }
        __builtin_amdgcn_s_waitcnt(0);
        unsigned nloc = b.st[0], nx = b.st[1];
        if (nloc == 0u) { xcd_barrier_complete(bar, bx, nloc, nx); b.st[0] = nloc; b.st[1] = nx; }
        const unsigned old = xb_add(&bar[XB_XSUB(bx)], 1u);
        const unsigned gen = old / nloc;
        if (old + 1u == (gen + 1u) * nloc) {
            __builtin_amdgcn_fence(__ATOMIC_RELEASE, "agent");
            asm volatile("s_waitcnt vmcnt(0)" ::: "memory");
            const unsigned og = xb_add(&bar[XB_TOP], 1u);
            const unsigned tg = og / nx;
            if (og + 1u == (tg + 1u) * nx) xb_add(&bar[XB_TOPGEN], 1u);
            else XB_SPIN(xb_ld(&bar[XB_TOPGEN]) == tg, bar);
            __builtin_amdgcn_fence(__ATOMIC_ACQUIRE, "agent");
            xb_add(&bar[XB_XGEN(bx)], 1u);
            asm volatile("s_waitcnt vmcnt(0)" ::: "memory");
        } else {
            XB_SPIN(xb_ld(&bar[XB_XGEN(bx)]) == gen, bar);
            __builtin_amdgcn_fence(__ATOMIC_ACQUIRE, "agent");
            asm volatile("s_waitcnt vmcnt(0)" ::: "memory");
        }
    }
    __syncthreads();
}

namespace g8 {
constexpr int BM = 256, BK = 64, HALF = 128, HTB = HALF * BK * 2, STAGE_BYTES = 8 * HTB, NXCD = 8, WGM = 8;
__host__ __device__ __forceinline__ int lds_byte(int r, int c) { const int st = (r >> 4) * 2 + (c >> 5), rr = r & 15, cc = c & 31, ob = rr * 64 + cc * 2; return st * 1024 + (ob ^ (((ob >> 9) & 1) << 5)); }
__host__ __device__ __forceinline__ void stage_rc(int b, int& R, int& C) { const int st = b / 1024, sb = b % 1024, swz = sb ^ (((sb >> 9) & 1) << 5); R = (st >> 1) * 16 + swz / 64; C = (st & 1) * 32 + (swz % 64) / 2; }
__host__ __device__ __forceinline__ int perm32(int rho) { const int n = rho >> 4, i = rho & 15; return 8 * (i >> 2) + 4 * n + (i & 3); }

struct Unit { const char* A; const char* B; const int* rows; int pm, pn, nvalid, aux; };

template <class Epi, class Sched, bool GATHER>
__device__ __forceinline__ void gemm_phase(LAS unsigned char* lds, const int tid_in, const int K, const int lda, const int ldb, const Sched& S, const Epi& E) {
    const int tid = tid_in, wid = __builtin_amdgcn_readfirstlane(tid >> 6), lane = tid & 63, wr = wid >> 2, wc = wid & 3, fr = lane & 15, fq = lane >> 4;
    const int nt = K / BK;
    unsigned voffB[2];
#pragma unroll
    for (int i = 0; i < 2; ++i) { int R_, C_; stage_rc(tid * 16 + i * 8192, R_, C_); const int Rb = Epi::PERM ? ((R_ & ~31) + perm32(R_ & 31)) : R_; voffB[i] = (unsigned)(Rb * ldb + C_) * 2u; }
    LAS v4u* stash = (LAS v4u*)(lds + (LDS_STASH - 0) + tid * 16);
    const size_t kstep = (size_t)(BK * 2);
    const size_t hstepB = (size_t)HALF * ldb * 2;
    const unsigned ldsw = (unsigned)wid * 1024u;
    const int aoff = lds_byte(wr * 64 + fr, fq * 8), boff = lds_byte(wc * 32 + fr, fq * 8);
#define G8_SA(b, h) (((b) * 2 + (h)) * HTB)
#define G8_SB(b, h) ((4 + (b) * 2 + (h)) * HTB)
#define G8_STAGE2(bufoff, gbase, v0, v1) do { \
        __builtin_amdgcn_global_load_lds((const unsigned*)((const char*)(gbase) + (v0)), (LAS unsigned*)(lds + (bufoff) + ldsw), 16, 0, 0); \
        __builtin_amdgcn_global_load_lds((const unsigned*)((const char*)(gbase) + (v1)), (LAS unsigned*)(lds + (bufoff) + ldsw + 8192), 16, 0, 0); } while (0)
#define G8_STAGEB(bufoff, gbase) G8_STAGE2(bufoff, gbase, voffB[0], voffB[1])
#define G8_LDA(dst, b, h) do { _Pragma("unroll") for (int m = 0; m < 4; ++m) _Pragma("unroll") for (int k = 0; k < 2; ++k) dst[m][k] = *(const LAS bf16x8*)(lds + G8_SA(b, h) + aoff + m * 2048 + k * 1024); } while (0)
#define G8_LDB(dst, b, h) do { _Pragma("unroll") for (int n = 0; n < 2; ++n) _Pragma("unroll") for (int k = 0; k < 2; ++k) dst[n][k] = *(const LAS bf16x8*)(lds + G8_SB(b, h) + boff + n * 2048 + k * 1024); } while (0)
#define G8_MMA(ai, bj, At, Bt) do { __builtin_amdgcn_s_setprio(1); _Pragma("unroll") for (int m = 0; m < 4; ++m) _Pragma("unroll") for (int n = 0; n < 2; ++n) _Pragma("unroll") for (int k = 0; k < 2; ++k) \
        acc[ai][bj][m][n] = __builtin_amdgcn_mfma_f32_16x16x32_bf16(Bt[n][k], At[m][k], acc[ai][bj][m][n], 0, 0, 0); __builtin_amdgcn_s_setprio(0); } while (0)
#define G8_WAIT_V(n) asm volatile("s_waitcnt vmcnt(" #n ")" ::: "memory")
#define G8_WAIT_L(n) asm volatile("s_waitcnt lgkmcnt(" #n ")" ::: "memory")
#define G8_BAR __builtin_amdgcn_s_barrier()
#define G8_SCHED __builtin_amdgcn_sched_barrier(0)
#define G8_SETVA(dst, u) do { int _t2 = tid; if (GATHER) asm volatile("" : "+v"(_t2)); _Pragma("unroll") for (int _h = 0; _h < 2; ++_h) _Pragma("unroll") for (int _i = 0; _i < 2; ++_i) { \
        int _R, _C; stage_rc(_t2 * 16 + _i * 8192, _R, _C); \
        const unsigned _rl = (unsigned)(_h * HALF + _R); unsigned _row = _rl; \
        if (GATHER) { _row = 0u; if (_rl < (unsigned)(u).nvalid) _row = (unsigned)(u).rows[_rl] >> 3; } \
        dst[_h][_i] = (_row * (unsigned)lda + (unsigned)_C) * 2u; } } while (0)
    Unit cur, nxt; int ui = 0;
    if (!S.next(0, cur)) return;
    f32x4 acc[2][2][4][2];
#pragma unroll
    for (int a = 0; a < 2; ++a)
#pragma unroll
        for (int b = 0; b < 2; ++b)
#pragma unroll
            for (int m = 0; m < 4; ++m)
#pragma unroll
                for (int n = 0; n < 2; ++n) acc[a][b][m][n] = (f32x4){0.f, 0.f, 0.f, 0.f};
    bf16x8 At[4][2], B0[2][2], B1[2][2];
    unsigned vAc[2][2]; unsigned xl00 = 0, xl01 = 0, xl10 = 0, xl11 = 0;
    G8_SETVA(vAc, cur);
    const char* cA = cur.A; const char* cB = cur.B;
    G8_STAGEB(G8_SB(0, 0), cB); G8_STAGEB(G8_SB(0, 1), cB + hstepB); G8_STAGE2(G8_SA(0, 0), cA, vAc[0][0], vAc[0][1]); G8_STAGE2(G8_SA(0, 1), cA, vAc[1][0], vAc[1][1]);
    if (wr == 1) G8_BAR;
    G8_WAIT_V(2); G8_BAR;
    G8_STAGEB(G8_SB(1, 0), cB + kstep); G8_STAGE2(G8_SA(1, 0), cA + kstep, vAc[0][0], vAc[0][1]); G8_STAGEB(G8_SB(1, 1), cB + hstepB + kstep);
    G8_WAIT_V(6); G8_BAR;
    for (;;) {
        const bool has_next = S.next(ui + 1, nxt);
        const char* nA = has_next ? nxt.A : cA; const char* nB = has_next ? nxt.B : cB;
        if (GATHER) { unsigned vAn[2][2]; if (has_next) { G8_SETVA(vAn, nxt); } else {
#pragma unroll
            for (int h = 0; h < 2; ++h)
#pragma unroll
                for (int i = 0; i < 2; ++i) vAn[h][i] = vAc[h][i]; }
            *stash = (v4u){vAn[0][0], vAn[0][1], vAn[1][0], vAn[1][1]}; }
#pragma unroll 1
        for (int t = 0; t < nt; t += 2) {
            const bool last = (t == nt - 2);
            const char* a1 = cA + (size_t)(t + 1) * kstep;
            const char* a2 = last ? nA : cA + (size_t)(t + 2) * kstep; const char* b2 = last ? nB : cB + (size_t)(t + 2) * kstep;
            const char* a3 = a2 + kstep; const char* b3 = b2 + kstep;
            unsigned x00 = vAc[0][0], x01 = vAc[0][1], x10 = vAc[1][0], x11 = vAc[1][1];
            if (GATHER) { if (last) { const v4u sv = *stash; x00 = sv.x; x01 = sv.y; x10 = sv.z; x11 = sv.w; } xl00 = x00; xl01 = x01; xl10 = x10; xl11 = x11; }
            G8_LDB(B0, 0, 0); G8_LDB(B1, 0, 1); G8_SCHED; G8_LDA(At, 0, 0); G8_STAGE2(G8_SA(1, 1), a1, vAc[1][0], vAc[1][1]);
            G8_WAIT_V(8); G8_WAIT_L(0); G8_BAR; G8_MMA(0, 0, At, B0); G8_MMA(0, 1, At, B1); G8_BAR; G8_SCHED;
            G8_LDA(At, 0, 1); G8_STAGEB(G8_SB(0, 0), b2); G8_STAGEB(G8_SB(0, 1), b2 + hstepB); G8_STAGE2(G8_SA(0, 0), a2, x00, x01);
            G8_WAIT_V(8); G8_WAIT_L(0); G8_BAR; G8_MMA(1, 0, At, B0); G8_MMA(1, 1, At, B1); G8_BAR; G8_SCHED;
            G8_LDB(B0, 1, 0); G8_LDB(B1, 1, 1); G8_SCHED; G8_LDA(At, 1, 0); G8_STAGE2(G8_SA(0, 1), a2, x10, x11);
            G8_WAIT_V(8); G8_WAIT_L(0); G8_BAR; G8_MMA(0, 0, At, B0); G8_MMA(0, 1, At, B1); G8_BAR; G8_SCHED;
            G8_LDA(At, 1, 1); G8_STAGEB(G8_SB(1, 0), b3); G8_STAGEB(G8_SB(1, 1), b3 + hstepB); G8_STAGE2(G8_SA(1, 0), a3, x00, x01);
            G8_WAIT_V(8); G8_WAIT_L(0); G8_BAR; G8_MMA(1, 0, At, B0); G8_MMA(1, 1, At, B1); G8_BAR; G8_SCHED;
        }
        if (wr == 0) G8_BAR;
        E(acc, cur, wr, wc, fr, fq);
        if (!has_next) break;
#pragma unroll
        for (int a = 0; a < 2; ++a)
#pragma unroll
            for (int b = 0; b < 2; ++b)
#pragma unroll
                for (int m = 0; m < 4; ++m)
#pragma unroll
                    for (int n = 0; n < 2; ++n) acc[a][b][m][n] = (f32x4){0.f, 0.f, 0.f, 0.f};
        cur = nxt; cA = nA; cB = nB; ++ui;
        if (GATHER) { vAc[0][0] = xl00; vAc[0][1] = xl01; vAc[1][0] = xl10; vAc[1][1] = xl11; }
        if (wr == 1) G8_BAR;
    }
    G8_WAIT_V(0);
    G8_BAR;
#undef G8_SA
#undef G8_SB
#undef G8_STAGE2
#undef G8_STAGEB
#undef G8_LDA
#undef G8_LDB
#undef G8_MMA
#undef G8_WAIT_V
#undef G8_WAIT_L
#undef G8_BAR
#undef G8_SCHED
#undef G8_SETVA
}

struct DenseSched {
    const char* A; const char* B; size_t a_tile, b_tile, agrp_stride; int agrp_shift, nM, nN, nwg, G, c;
    __device__ __forceinline__ void init(const void* A_, const void* B_, int M, int N, int lda, int ldb, int G_, int c_) {
        A = (const char*)A_; B = (const char*)B_; a_tile = (size_t)BM * lda * 2; b_tile = (size_t)BM * ldb * 2; agrp_stride = 0; agrp_shift = 0; nM = M / BM; nN = N / BM; nwg = nM * nN; G = G_; c = c_; }
    __device__ __forceinline__ bool next(int i, Unit& u) const {
        const long L = (long)i * G + c; if (L >= nwg) return false;
        int wgid = (int)L; { const int q = nwg / NXCD, r = nwg % NXCD, xcd = wgid % NXCD, off = wgid / NXCD; wgid = (xcd < r ? xcd * (q + 1) : r * (q + 1) + (xcd - r) * q) + off; }
        const int nig = WGM * nN, gid = wgid / nig, fm = gid * WGM, gsz = (nM - fm) < WGM ? (nM - fm) : WGM;
        u.pm = fm + ((wgid % nig) % gsz); u.pn = (wgid % nig) / gsz;
        u.A = A + (size_t)u.pm * a_tile + (size_t)(u.pn >> agrp_shift) * agrp_stride; u.B = B + (size_t)u.pn * b_tile; u.rows = nullptr; u.nvalid = BM; u.aux = 0; return true;
    }
};
template <int NPN, bool GATHERED>
struct ExpertSched {
    const LAS int* tpref; const LAS int* cnt; const char* A; const char* B; const int* tok; size_t b_exp, b_tile, a_tile; int NU, G, c;
    __device__ __forceinline__ bool next(int i, Unit& u) const {
        const int L = i * G + c; if (L >= NU) return false;
        const int tile = L / NPN, pn = L % NPN;
        int e = 0; while (__builtin_amdgcn_readfirstlane(tpref[e + 1]) <= tile) ++e;
        const int rb = tile - __builtin_amdgcn_readfirstlane(tpref[e]);
        u.pm = e; u.pn = pn; u.aux = tile * BM; u.nvalid = __builtin_amdgcn_readfirstlane(cnt[e]) - rb * BM; if (u.nvalid > BM) u.nvalid = BM;
        u.rows = tok + (size_t)e * CAP + rb * BM;
        u.A = GATHERED ? A : A + (size_t)tile * a_tile; u.B = B + (size_t)e * b_exp + (size_t)pn * b_tile; return true;
    }
};

struct EpiBf16 {
    static constexpr bool PERM = true;
    bf16* O; int ldc; int qscale;
    __device__ __forceinline__ void operator()(const f32x4 (&acc)[2][2][4][2], const Unit& u, int wr, int wc, int fr, int fq) const {
        asm volatile("" : "+v"(fr), "+v"(fq));
        const int row0 = u.pm * BM + wr * 64 + fr, col0 = u.pn * BM + wc * 32 + 8 * fq;
        const float sc = (qscale && (u.pn % 6) < 2) ? 0.125f : 1.0f;
#pragma unroll
        for (int ai = 0; ai < 2; ++ai)
#pragma unroll
            for (int m = 0; m < 4; ++m) { bf16* rowp = O + (size_t)(row0 + ai * HALF + m * 16) * ldc + col0;
#pragma unroll
                for (int bj = 0; bj < 2; ++bj) { const f32x4 v0 = acc[ai][bj][m][0] * sc, v1 = acc[ai][bj][m][1] * sc;
                    v4u w; w.x = cvt_pk_bf16(v0[0], v0[1]); w.y = cvt_pk_bf16(v0[2], v0[3]); w.z = cvt_pk_bf16(v1[0], v1[1]); w.w = cvt_pk_bf16(v1[2], v1[3]);
                    *(v4u*)(rowp + bj * HALF) = w; } }
    }
};
struct EpiScaleBf16 {
    static constexpr bool PERM = true;
    bf16* O; int ldc; const float* scale;
    __device__ __forceinline__ void operator()(const f32x4 (&acc)[2][2][4][2], const Unit& u, int wr, int wc, int fr, int fq) const {
        asm volatile("" : "+v"(fr), "+v"(fq));
        const int row0 = u.pm * BM + wr * 64 + fr, col0 = u.pn * BM + wc * 32 + 8 * fq;
        f32x4 sv[2][2];
#pragma unroll
        for (int bj = 0; bj < 2; ++bj)
#pragma unroll
            for (int n = 0; n < 2; ++n) sv[bj][n] = *(const f32x4*)(scale + col0 + bj * HALF + 4 * n);
#pragma unroll
        for (int ai = 0; ai < 2; ++ai)
#pragma unroll
            for (int m = 0; m < 4; ++m) { bf16* rowp = O + (size_t)(row0 + ai * HALF + m * 16) * ldc + col0;
#pragma unroll
                for (int bj = 0; bj < 2; ++bj) { const f32x4 v0 = acc[ai][bj][m][0] * sv[bj][0], v1 = acc[ai][bj][m][1] * sv[bj][1];
                    v4u w; w.x = cvt_pk_bf16(v0[0], v0[1]); w.y = cvt_pk_bf16(v0[2], v0[3]); w.z = cvt_pk_bf16(v1[0], v1[1]); w.w = cvt_pk_bf16(v1[2], v1[3]);
                    *(v4u*)(rowp + bj * HALF) = w; } }
    }
};
struct EpiResid {
    static constexpr bool PERM = false;
    const float* X; float* Y;
    __device__ __forceinline__ void operator()(const f32x4 (&acc)[2][2][4][2], const Unit& u, int wr, int wc, int fr, int fq) const {
        asm volatile("" : "+v"(fr), "+v"(fq));
        const int row0 = u.pm * BM + wr * 64 + fr, col0 = u.pn * BM + wc * 32 + 4 * fq;
#pragma unroll
        for (int ai = 0; ai < 2; ++ai)
#pragma unroll
            for (int m = 0; m < 4; ++m) { const size_t off = (size_t)(row0 + ai * HALF + m * 16) * D + col0;
#pragma unroll
                for (int bj = 0; bj < 2; ++bj)
#pragma unroll
                    for (int n = 0; n < 2; ++n) { const f32x4 xv = *(const f32x4*)(X + off + bj * HALF + n * 16); *(f32x4*)(Y + off + bj * HALF + n * 16) = xv * ALPHA + acc[ai][bj][m][n]; } }
    }
};
struct EpiResidLN {
    static constexpr bool PERM = true;
    const float* X32; const bf16* Xb; const float* st; const float* g; const float* b; bf16* Y; float* pst; int mode;
    __device__ __forceinline__ void operator()(const f32x4 (&acc)[2][2][4][2], const Unit& u, int wr, int wc, int fr, int fq) const {
        asm volatile("" : "+v"(fr), "+v"(fq));
        const int row0 = u.pm * BM + wr * 64 + fr, col0 = u.pn * BM + wc * 32 + 8 * fq, lane = fq * 16 + fr;
#pragma unroll
        for (int ai = 0; ai < 2; ++ai)
#pragma unroll
            for (int m = 0; m < 4; ++m) { const int row = row0 + ai * HALF + m * 16; const size_t off = (size_t)row * D + col0;
                float mean = 0.f, rstd = 1.f; if (mode) { const f32x2 sv = *(const f32x2*)(st + 2 * row); mean = sv.x; rstd = sv.y; }
                float sm = 0.f, sq = 0.f;
#pragma unroll
                for (int bj = 0; bj < 2; ++bj) { f32x4 x0, x1;
                    if (mode) { const v4u xv = *(const v4u*)(Xb + off + bj * HALF);
                        const f32x4 g0 = *(const f32x4*)(g + col0 + bj * HALF), g1 = *(const f32x4*)(g + col0 + bj * HALF + 4), b0 = *(const f32x4*)(b + col0 + bj * HALF), b1 = *(const f32x4*)(b + col0 + bj * HALF + 4);
                        x0 = ((f32x4){bflo(xv.x), bfhi(xv.x), bflo(xv.y), bfhi(xv.y)} - mean) * rstd * g0 + b0; x1 = ((f32x4){bflo(xv.z), bfhi(xv.z), bflo(xv.w), bfhi(xv.w)} - mean) * rstd * g1 + b1; }
                    else { x0 = *(const f32x4*)(X32 + off + bj * HALF); x1 = *(const f32x4*)(X32 + off + bj * HALF + 4); }
                    const f32x4 y0 = x0 * ALPHA + acc[ai][bj][m][0], y1 = x1 * ALPHA + acc[ai][bj][m][1];
                    v4u w; w.x = cvt_pk_bf16(y0[0], y0[1]); w.y = cvt_pk_bf16(y0[2], y0[3]); w.z = cvt_pk_bf16(y1[0], y1[1]); w.w = cvt_pk_bf16(y1[2], y1[3]);
                    *(v4u*)(Y + off + bj * HALF) = w;
                    sm += ((y0[0] + y0[1]) + (y0[2] + y0[3])) + ((y1[0] + y1[1]) + (y1[2] + y1[3]));
                    sq += ((y0[0] * y0[0] + y0[1] * y0[1]) + (y0[2] * y0[2] + y0[3] * y0[3])) + ((y1[0] * y1[0] + y1[1] * y1[1]) + (y1[2] * y1[2] + y1[3] * y1[3])); }
                sm += shfl_x(sm, 16, lane); sm += shfl_x(sm, 32, lane); sq += shfl_x(sq, 16, lane); sq += shfl_x(sq, 32, lane);
                if (fq == 0) *(f32x2*)(pst + ((size_t)row * 32 + u.pn * 4 + wc) * 2) = (f32x2){sm, sq}; }
    }
};
struct EpiConvIn {
    static constexpr bool PERM = true;
    bf16* UC; bf16* BGp;
    __device__ __forceinline__ void operator()(const f32x4 (&acc)[2][2][4][2], const Unit& u, int wr, int wc, int fr, int fq) const {
        asm volatile("" : "+v"(fr), "+v"(fq));
        const int row0 = u.pm * BM + wr * 64 + fr, cw = wc * 32 + 8 * fq;
        if (u.pn < 16) {
#pragma unroll
            for (int ai = 0; ai < 2; ++ai)
#pragma unroll
                for (int m = 0; m < 4; ++m) { bf16* rowp = UC + (size_t)(row0 + ai * HALF + m * 16) * D + u.pn * HALF + cw;
                    const f32x4 v0 = acc[ai][0][m][0] * acc[ai][1][m][0], v1 = acc[ai][0][m][1] * acc[ai][1][m][1];
                    v4u w; w.x = cvt_pk_bf16(v0[0], v0[1]); w.y = cvt_pk_bf16(v0[2], v0[3]); w.z = cvt_pk_bf16(v1[0], v1[1]); w.w = cvt_pk_bf16(v1[2], v1[3]);
                    *(v4u*)rowp = w; }
        } else {
#pragma unroll
            for (int ai = 0; ai < 2; ++ai)
#pragma unroll
                for (int m = 0; m < 4; ++m) { bf16* rowp = BGp + (size_t)(row0 + ai * HALF + m * 16) * D + (u.pn - 16) * BM + cw;
#pragma unroll
                    for (int bj = 0; bj < 2; ++bj) { const f32x4 v0 = acc[ai][bj][m][0], v1 = acc[ai][bj][m][1];
                        v4u w; w.x = cvt_pk_bf16(v0[0], v0[1]); w.y = cvt_pk_bf16(v0[2], v0[3]); w.z = cvt_pk_bf16(v1[0], v1[1]); w.w = cvt_pk_bf16(v1[2], v1[3]);
                        *(v4u*)(rowp + bj * HALF) = w; } }
        }
    }
};
__device__ __forceinline__ f32x4 silu_mul(f32x4 g, f32x4 uu) {
    f32x4 r;
#pragma unroll
    for (int j = 0; j < 4; ++j) r[j] = g[j] * __builtin_amdgcn_rcpf(1.0f + __expf(-g[j])) * uu[j];
    return r;
}
struct EpiExpertGU {
    static constexpr bool PERM = true;
    bf16* H;
    __device__ __forceinline__ void operator()(const f32x4 (&acc)[2][2][4][2], const Unit& u, int wr, int wc, int fr, int fq) const {
        asm volatile("" : "+v"(fr), "+v"(fq));
        const float* gates = (const float*)((const char*)u.rows + (WS_LGATE - WS_LTOK));
        const int cw = wc * 32 + 8 * fq;
#pragma unroll
        for (int ai = 0; ai < 2; ++ai)
#pragma unroll
            for (int m = 0; m < 4; ++m) { const int r = ai * HALF + wr * 64 + m * 16 + fr;
                if (r < u.nvalid) { const float gt = gates[r]; const unsigned pid = (unsigned)u.rows[r];
                    const f32x4 v0 = silu_mul(acc[ai][0][m][0], acc[ai][1][m][0]) * gt, v1 = silu_mul(acc[ai][0][m][1], acc[ai][1][m][1]) * gt;
                    v4u w; w.x = cvt_pk_bf16(v0[0], v0[1]); w.y = cvt_pk_bf16(v0[2], v0[3]); w.z = cvt_pk_bf16(v1[0], v1[1]); w.w = cvt_pk_bf16(v1[2], v1[3]);
                    (void)pid; *(v4u*)(H + (size_t)(u.aux + r) * EDIM + cw) = w; } }
    }
};
struct EpiSharedGU {
    static constexpr bool PERM = true;
    bf16* HS;
    __device__ __forceinline__ void operator()(const f32x4 (&acc)[2][2][4][2], const Unit& u, int wr, int wc, int fr, int fq) const {
        asm volatile("" : "+v"(fr), "+v"(fq));
        const int row0 = u.pm * BM + wr * 64 + fr, cw = u.pn * HALF + wc * 32 + 8 * fq;
#pragma unroll
        for (int ai = 0; ai < 2; ++ai)
#pragma unroll
            for (int m = 0; m < 4; ++m) {
                const f32x4 v0 = silu_mul(acc[ai][0][m][0], acc[ai][1][m][0]), v1 = silu_mul(acc[ai][0][m][1], acc[ai][1][m][1]);
                v4u w; w.x = cvt_pk_bf16(v0[0], v0[1]); w.y = cvt_pk_bf16(v0[2], v0[3]); w.z = cvt_pk_bf16(v1[0], v1[1]); w.w = cvt_pk_bf16(v1[2], v1[3]);
                *(v4u*)(HS + (size_t)(row0 + ai * HALF + m * 16) * SDIM + cw) = w; }
    }
};
struct EpiDownY {
    static constexpr bool PERM = true;
    bf16* Y;
    __device__ __forceinline__ void operator()(const f32x4 (&acc)[2][2][4][2], const Unit& u, int wr, int wc, int fr, int fq) const {
        asm volatile("" : "+v"(fr), "+v"(fq));
        const int col0 = u.pn * BM + wc * 32 + 8 * fq;
#pragma unroll
        for (int ai = 0; ai < 2; ++ai)
#pragma unroll
            for (int m = 0; m < 4; ++m) { const int r = ai * HALF + wr * 64 + m * 16 + fr; bf16* rowp = Y + (size_t)(u.aux + r) * D + col0;
#pragma unroll
                for (int bj = 0; bj < 2; ++bj) { const f32x4 v0 = acc[ai][bj][m][0], v1 = acc[ai][bj][m][1];
                    v4u w; w.x = cvt_pk_bf16(v0[0], v0[1]); w.y = cvt_pk_bf16(v0[2], v0[3]); w.z = cvt_pk_bf16(v1[0], v1[1]); w.w = cvt_pk_bf16(v1[2], v1[3]);
                    *(v4u*)(rowp + bj * HALF) = w; } }
    }
};
}

struct Args { const float* in[19]; float* out; unsigned char* ws; int ph_lo, ph_hi; };
struct Frame {
    LAS unsigned char* lds; unsigned* ctl; unsigned char* ws;
    int tid, lane, wave, G, bid;
};
enum { IN_X = 0, IN_RELB, IN_PWIN, IN_PWG, IN_PSC, IN_PWOUT, IN_DQKV, IN_DOUT, IN_CWIN, IN_CW, IN_CWOUT, IN_LNG, IN_LNB, IN_RW, IN_RB, IN_EGU, IN_ED, IN_SGU, IN_SD };

#define CAS __attribute__((address_space(4)))
typedef const CAS unsigned char* KP;
__device__ __forceinline__ const float* ain(KP kp, int i) { return (const float*)((const GAS float* const CAS*)kp)[i]; }
__device__ __forceinline__ float* aout(KP kp) { return (float*)((GAS float* const CAS*)kp)[19]; }
__device__ __forceinline__ void tr_item(const float* W, int K, int N, bf16* WT, int dstK, int mode, LAS float* scr, int item, int lane) {
    const int nblk = N / 32, kb = item / nblk, nb = item % nblk, k0 = 64 * kb, n0 = 32 * nb;
    int r0 = n0;
    if (mode == 1) { const int part = n0 / 2048, j = n0 % 2048; r0 = (part == 0) ? 4096 + j : 256 * (j / 128) + (part == 2 ? 128 : 0) + (j % 128); }
    if (mode == 2) { const int part = n0 / 256, j = n0 % 256; r0 = 256 * (j / 128) + 128 * part + (j % 128); }
#pragma unroll 8
    for (int i = 0; i < 32; ++i) { const int kk = 2 * i + (lane >> 5); scr[kk * 33 + (lane & 31)] = W[(size_t)(k0 + kk) * N + n0 + (lane & 31)]; }
    LDS_WAIT(); asm volatile("" ::: "memory");
    const int c = lane & 7;
#pragma unroll
    for (int j = 0; j < 4; ++j) { const int n = (lane >> 3) + 8 * j; const LAS float* s = scr + (8 * c) * 33 + n;
        v4u o; o.x = pk2(s[0 * 33], s[1 * 33]); o.y = pk2(s[2 * 33], s[3 * 33]); o.z = pk2(s[4 * 33], s[5 * 33]); o.w = pk2(s[6 * 33], s[7 * 33]);
        *(v4u*)(WT + (size_t)(r0 + n) * dstK + k0 + 8 * c) = o; }
    LDS_WAIT(); asm volatile("" ::: "memory");
}
__device__ __forceinline__ void phase_prologue(const Frame& F, KP kp) {
    LAS float* scr = (LAS float*)(F.lds + F.wave * 16384);
    const int gw = F.bid * 8 + F.wave, NGW = F.G * 8;
    constexpr int I0 = 2 * 2048, I1 = 8 * 128, I2 = 2 * 2048, I3 = 4608, I4 = 512, I5 = 6144, I6 = 2048, I7 = 4 * 512, I8 = 4 * 256, I9 = 256 * 256, I10 = 256 * 128;
    constexpr int NITEMS = I0 + I1 + I2 + I3 + I4 + I5 + I6 + I7 + I8 + I9 + I10;
    unsigned char* ws = F.ws;
    for (int it = gw; it < NITEMS; it += NGW) {
        int r = it;
        if (r < I0) { const int b = r / 2048; tr_item(ain(kp, IN_PWIN) + (size_t)b * D * D, D, D, (bf16*)(ws + WS_W_POOL_IN) + (size_t)b * D * D, D, 0, scr, r % 2048, F.lane); continue; } r -= I0;
        if (r < I1) { const int b = r / 128; tr_item(ain(kp, IN_PWG) + (size_t)b * 512 * 512, 512, 512, (bf16*)(ws + WS_W_POOL_G) + (size_t)b * 512 * 512, 512, 0, scr, r % 128, F.lane); continue; } r -= I1;
        if (r < I2) { const int b = r / 2048; tr_item(ain(kp, IN_PWOUT) + (size_t)b * D * D, D, D, (bf16*)(ws + WS_W_POOL_OUT) + (size_t)b * D * D, D, 0, scr, r % 2048, F.lane); continue; } r -= I2;
        if (r < I3) { tr_item(ain(kp, IN_DQKV), D, QKVC, (bf16*)(ws + WS_W_DIL_QKV), D, 0, scr, r, F.lane); continue; } r -= I3;
        if (r < I4) { tr_item(ain(kp, IN_DOUT), DILW, D, (bf16*)(ws + WS_W_DIL_OUT), DILW, 0, scr, r, F.lane); continue; } r -= I4;
        if (r < I5) { tr_item(ain(kp, IN_CWIN), D, 3 * D, (bf16*)(ws + WS_W_CONV_IN), D, 1, scr, r, F.lane); continue; } r -= I5;
        if (r < I6) { tr_item(ain(kp, IN_CWOUT), D, D, (bf16*)(ws + WS_W_CONV_OUT), D, 0, scr, r, F.lane); continue; } r -= I6;
        if (r < I7) { const int b = r / 512; tr_item(ain(kp, IN_SGU) + (size_t)b * D * 512, D, 512, (bf16*)(ws + WS_W_SH_GU) + (size_t)b * 512 * D, D, 2, scr, r % 512, F.lane); continue; } r -= I7;
        if (r < I8) { const int b = r / 256; tr_item(ain(kp, IN_SD) + (size_t)b * SDIM * D, SDIM, D, (bf16*)(ws + WS_W_SH_D) + (size_t)b * D * SDIM, SDIM, 0, scr, r % 256, F.lane); continue; } r -= I8;
        if (r < I9) { const int b = r / 256; tr_item(ain(kp, IN_EGU) + (size_t)b * D * 256, D, 256, (bf16*)(ws + WS_W_EX_GU) + (size_t)b * 256 * D, D, 0, scr, r % 256, F.lane); continue; } r -= I9;
        { const int b = r / 128; tr_item(ain(kp, IN_ED) + (size_t)b * EDIM * D, EDIM, D, (bf16*)(ws + WS_W_EX_D) + (size_t)b * D * EDIM, EDIM, 0, scr, r % 128, F.lane); }
    }
    const size_t gt = (size_t)F.bid * 512 + F.tid, GT = (size_t)F.G * 512;
    { const float* rw = ain(kp, IN_RW); bf16* wh = (bf16*)(ws + WS_RWH); bf16* wl = (bf16*)(ws + WS_RWL);
      for (size_t i = gt; i < (size_t)DEPTH * NEXP * D / 8; i += GT) { const size_t k8 = i % (D / 8), e = (i / (D / 8)) % NEXP, l = i / ((size_t)NEXP * D / 8);
          float v[8]; unsigned hi[8], lo[8];
#pragma unroll
          for (int j = 0; j < 8; ++j) { v[j] = rw[(l * D + k8 * 8 + j) * NEXP + e]; hi[j] = f2bf(v[j]); lo[j] = f2bf(v[j] - __builtin_bit_cast(float, hi[j] << 16)); }
          v4u a, b2; a.x = hi[0] | (hi[1] << 16); a.y = hi[2] | (hi[3] << 16); a.z = hi[4] | (hi[5] << 16); a.w = hi[6] | (hi[7] << 16);
          b2.x = lo[0] | (lo[1] << 16); b2.y = lo[2] | (lo[3] << 16); b2.z = lo[4] | (lo[5] << 16); b2.w = lo[6] | (lo[7] << 16);
          *(v4u*)(wh + (l * NEXP + e) * D + k8 * 8) = a; *(v4u*)(wl + (l * NEXP + e) * D + k8 * 8) = b2; } }
    const float* x = ain(kp, IN_X); bf16* xb = (bf16*)(ws + WS_XB);
    for (size_t i = gt; i < (size_t)T * D / 8; i += GT) { const f32x4 p = *(const f32x4*)(x + i * 8), q = *(const f32x4*)(x + i * 8 + 4);
        v4u w; w.x = pk2(p[0], p[1]); w.y = pk2(p[2], p[3]); w.z = pk2(q[0], q[1]); w.w = pk2(q[2], q[3]); *(v4u*)(xb + i * 8) = w; }
}

__device__ __forceinline__ void unpack8(const v4u w, float (&f)[8]) { f[0] = bflo(w.x); f[1] = bfhi(w.x); f[2] = bflo(w.y); f[3] = bfhi(w.y); f[4] = bflo(w.z); f[5] = bfhi(w.z); f[6] = bflo(w.w); f[7] = bfhi(w.w); }
__device__ __forceinline__ void phase_pool(const Frame& F, const bf16* U, bf16* PL) {
    for (int it = F.bid * 512 + F.tid; it < (T / 32) * 256; it += F.G * 512) {
        const int cv = it & 255, ch = it >> 8, col = cv * 8, w = 2 << (col >> 9);
        const int row0 = ch * 32, pos0 = row0 & (SEQ - 1);
        float s[8], uu[8];
#pragma unroll
        for (int j = 0; j < 8; ++j) s[j] = 0.f;
        for (int j = 1; j < w; ++j) if (pos0 - j >= 0) { unpack8(*(const v4u*)(U + (size_t)(row0 - j) * D + col), uu);
#pragma unroll
            for (int q = 0; q < 8; ++q) s[q] += uu[q]; }
        for (int r = 0; r < 32; ++r) {
            const int t = row0 + r, pos = pos0 + r;
            unpack8(*(const v4u*)(U + (size_t)t * D + col), uu);
            const float inv = 1.0f / (float)((pos + 1) < w ? (pos + 1) : w);
            float o[8];
#pragma unroll
            for (int q = 0; q < 8; ++q) { s[q] += uu[q]; o[q] = s[q] * inv - uu[q]; }
            v4u ww; ww.x = pk2(o[0], o[1]); ww.y = pk2(o[2], o[3]); ww.z = pk2(o[4], o[5]); ww.w = pk2(o[6], o[7]);
            *(v4u*)(PL + (size_t)t * D + col) = ww;
            if (pos - w + 1 >= 0) { unpack8(*(const v4u*)(U + (size_t)(t - w + 1) * D + col), uu);
#pragma unroll
                for (int q = 0; q < 8; ++q) s[q] -= uu[q]; }
        }
    }
}

__device__ __forceinline__ void phase_conv(const Frame& F, const bf16* UC, const bf16* BGp, const float* cw, bf16* Z) {
    for (int it = F.bid * 512 + F.tid; it < T * 256; it += F.G * 512) {
        const int cv = it & 255, t = it >> 8, col = cv * 8, pos = t & (SEQ - 1);
        float u0[8], u1[8], u2[8], bb[8], o[8];
        unpack8(*(const v4u*)(UC + (size_t)t * D + col), u2);
        if (pos >= 1) unpack8(*(const v4u*)(UC + (size_t)(t - 1) * D + col), u1); else {
#pragma unroll
            for (int q = 0; q < 8; ++q) u1[q] = 0.f; }
        if (pos >= 2) unpack8(*(const v4u*)(UC + (size_t)(t - 2) * D + col), u0); else {
#pragma unroll
            for (int q = 0; q < 8; ++q) u0[q] = 0.f; }
        unpack8(*(const v4u*)(BGp + (size_t)t * D + col), bb);
#pragma unroll
        for (int q = 0; q < 8; ++q) o[q] = bb[q] * (cw[col + q] * u0[q] + cw[D + col + q] * u1[q] + cw[2 * D + col + q] * u2[q]);
        v4u ww; ww.x = pk2(o[0], o[1]); ww.y = pk2(o[2], o[3]); ww.z = pk2(o[4], o[5]); ww.w = pk2(o[6], o[7]);
        *(v4u*)(Z + (size_t)t * D + col) = ww;
    }
}

__device__ __forceinline__ int t5_bucket(int dist) {
    if (dist < 16) return dist;
    int large = 16 + (int)(logf((float)dist / 16.0f) / logf(128.0f) * 16.0f);
    return large < 31 ? large : 31;
}
constexpr int AT_KS = 0, AT_KSTR = 144, AT_VT = 256 * 144, AT_VSTR = 520, AT_BIAS = AT_VT + 64 * 520;
__device__ __forceinline__ void phase_attn(const Frame& F, const bf16* QKV, const float* relb, bf16* OG, float* LSE) {
    LAS unsigned char* lds = F.lds;
    const int tid = F.tid, lane = F.lane, w = tid >> 6, fr = lane & 15, fq = lane >> 4;
    for (int unit = F.bid; unit < NBATCH * 3 * 8 * 16; unit += F.G) {
        const int cmb = unit & 15, h = (unit >> 4) & 7, g = (unit >> 7) % 3, b = unit / 384;
        const int dsh = 2 * g, dil = 1 << dsh, r = cmb & (dil - 1), nb = cmb >> dsh;
        const bf16* base = QKV + (size_t)b * SEQ * QKVC + g * 1536 + h * 64;
        __syncthreads();
        {
            const int key = tid >> 1, half = tid & 1, jk = (nb - 1) * 128 + key;
            v4u kv[4], vv[4];
            if (jk >= 0) { const bf16* rp = base + (size_t)(jk * dil + r) * QKVC + half * 32;
#pragma unroll
                for (int i = 0; i < 4; ++i) { kv[i] = *(const v4u*)(rp + 512 + 8 * i); vv[i] = *(const v4u*)(rp + 1024 + 8 * i); } }
            else {
#pragma unroll
                for (int i = 0; i < 4; ++i) { kv[i] = (v4u){0u, 0u, 0u, 0u}; vv[i] = (v4u){0u, 0u, 0u, 0u}; } }
#pragma unroll
            for (int i = 0; i < 4; ++i) *(LAS v4u*)(lds + AT_KS + key * AT_KSTR + half * 64 + 16 * i) = kv[i];
#pragma unroll
            for (int i = 0; i < 4; ++i) {
                const unsigned ww[4] = {vv[i].x, vv[i].y, vv[i].z, vv[i].w};
#pragma unroll
                for (int q = 0; q < 4; ++q) { const int d = half * 32 + 8 * i + 2 * q;
                    *(LAS unsigned short*)(lds + AT_VT + d * AT_VSTR + key * 2) = (unsigned short)(ww[q] & 0xffffu);
                    *(LAS unsigned short*)(lds + AT_VT + (d + 1) * AT_VSTR + key * 2) = (unsigned short)(ww[q] >> 16); } }
            if (tid <= 128) ((LAS float*)(lds + AT_BIAS))[tid] = relb[t5_bucket(tid * dil) * 24 + g * 8 + h];
        }
        __syncthreads();
        int qi = 16 * w + fr; asm volatile("" : "+v"(qi));
        const int jq = nb * 128 + qi, tq = jq * dil + r;
        const bf16* qp = base + (size_t)tq * QKVC + 8 * fq;
        const bf16x8 q0 = *(const bf16x8*)qp, q1 = *(const bf16x8*)(qp + 32);
        f32x4 s[9]; float mx = -INFINITY;
#pragma unroll
        for (int kt = 0; kt < 9; ++kt) {
            const int kb = 16 * (w + kt);
            const bf16x8 k0 = *(const LAS bf16x8*)(lds + AT_KS + (kb + fr) * AT_KSTR + fq * 16), k1 = *(const LAS bf16x8*)(lds + AT_KS + (kb + fr) * AT_KSTR + 64 + fq * 16);
            f32x4 a = (f32x4){0.f, 0.f, 0.f, 0.f};
            a = __builtin_amdgcn_mfma_f32_16x16x32_bf16(k0, q0, a, 0, 0, 0);
            a = __builtin_amdgcn_mfma_f32_16x16x32_bf16(k1, q1, a, 0, 0, 0);
#pragma unroll
            for (int i = 0; i < 4; ++i) { const int kl = kb + 4 * fq + i, rel = qi + 128 - kl;
                const bool ok = (rel >= 0) && (rel <= 128) && (nb > 0 || kl >= 128);
                const int rc = rel < 0 ? 0 : (rel > 128 ? 128 : rel);
                const float v = ok ? a[i] + ((LAS float*)(lds + AT_BIAS))[rc] : -INFINITY;
                a[i] = v; mx = fmaxf(mx, v); }
            s[kt] = a;
        }
        mx = fmaxf(mx, shfl_x(mx, 16, lane)); mx = fmaxf(mx, shfl_x(mx, 32, lane));
        float l = 0.f;
#pragma unroll
        for (int kt = 0; kt < 9; ++kt)
#pragma unroll
            for (int i = 0; i < 4; ++i) { const float p = __expf(s[kt][i] - mx); s[kt][i] = p; l += p; }
        l += shfl_x(l, 16, lane); l += shfl_x(l, 32, lane);
        f32x4 o[4];
#pragma unroll
        for (int nt = 0; nt < 4; ++nt) o[nt] = (f32x4){0.f, 0.f, 0.f, 0.f};
#pragma unroll
        for (int st = 0; st < 5; ++st) {
            const int kt0 = 2 * st, kt1 = 2 * st + 1;
            v4u pw; pw.x = pk2(s[kt0][0], s[kt0][1]); pw.y = pk2(s[kt0][2], s[kt0][3]);
            if (kt1 < 9) { pw.z = pk2(s[kt1 < 9 ? kt1 : 0][0], s[kt1 < 9 ? kt1 : 0][1]); pw.w = pk2(s[kt1 < 9 ? kt1 : 0][2], s[kt1 < 9 ? kt1 : 0][3]); } else { pw.z = 0u; pw.w = 0u; }
            const bf16x8 pf = __builtin_bit_cast(bf16x8, pw);
            const int kb0 = 16 * (w + kt0) + 4 * fq, kb1 = 16 * (w + kt1) + 4 * fq;
#pragma unroll
            for (int nt = 0; nt < 4; ++nt) { const int d = 16 * nt + fr;
                v2u va = *(const LAS v2u*)(lds + AT_VT + d * AT_VSTR + kb0 * 2), vb = (v2u){0u, 0u};
                if (kt1 < 9) vb = *(const LAS v2u*)(lds + AT_VT + d * AT_VSTR + kb1 * 2);
                v4u vw; vw.x = va.x; vw.y = va.y; vw.z = vb.x; vw.w = vb.y;
                o[nt] = __builtin_amdgcn_mfma_f32_16x16x32_bf16(__builtin_bit_cast(bf16x8, vw), pf, o[nt], 0, 0, 0); }
        }
        const float il = 1.0f / l;
        bf16* op = OG + ((size_t)g * T + (size_t)b * SEQ + tq) * DILW + h * 64 + 4 * fq;
#pragma unroll
        for (int nt = 0; nt < 4; ++nt) { v2u ww; ww.x = pk2(o[nt][0] * il, o[nt][1] * il); ww.y = pk2(o[nt][2] * il, o[nt][3] * il); *(v2u*)(op + 16 * nt) = ww; }
        if (fq == 0) LSE[((size_t)g * T + (size_t)b * SEQ + tq) * 8 + h] = mx + logf(l);
    }
}
__device__ __forceinline__ void phase_combine(const Frame& F, const bf16* OG, const float* LSE, bf16* O) {
    for (int it = F.bid * 512 + F.tid; it < T * 64; it += F.G * 512) {
        const int c8 = it & 7, h = (it >> 3) & 7, t = it >> 6;
        const float l0 = LSE[((size_t)0 * T + t) * 8 + h], l1 = LSE[((size_t)1 * T + t) * 8 + h], l2 = LSE[((size_t)2 * T + t) * 8 + h];
        const float m = fmaxf(l0, fmaxf(l1, l2)); float w0 = __expf(l0 - m), w1 = __expf(l1 - m), w2 = __expf(l2 - m); const float inv = 1.0f / (w0 + w1 + w2); w0 *= inv; w1 *= inv; w2 *= inv;
        float a[8], bq[8], c[8], o[8]; const size_t off = (size_t)t * DILW + h * 64 + c8 * 8;
        unpack8(*(const v4u*)(OG + off), a); unpack8(*(const v4u*)(OG + (size_t)T * DILW + off), bq); unpack8(*(const v4u*)(OG + (size_t)2 * T * DILW + off), c);
#pragma unroll
        for (int q = 0; q < 8; ++q) o[q] = w0 * a[q] + w1 * bq[q] + w2 * c[q];
        v4u ww; ww.x = pk2(o[0], o[1]); ww.y = pk2(o[2], o[3]); ww.z = pk2(o[4], o[5]); ww.w = pk2(o[6], o[7]);
        *(v4u*)(O + off) = ww;
    }
}

constexpr int M1_LOG = 131072, M1_STAT = M1_LOG + 4096, M1_HIST = M1_STAT + 128, M1_BASE = M1_HIST + 256;
__device__ __forceinline__ void phase_moe1(const Frame& F, const float* Y, const float* gain, const float* bias, const float* RW, const float* RB,
                                           float* X1F, bf16* X1B, unsigned* cnt, int* ltok, float* lgate, int* eidx, int* inv) {
    LAS float* xs = (LAS float*)F.lds; LAS float* logit = (LAS float*)(F.lds + M1_LOG); LAS float* stat = (LAS float*)(F.lds + M1_STAT);
    LAS int* hist = (LAS int*)(F.lds + M1_HIST); LAS int* basep = (LAS int*)(F.lds + M1_BASE);
    const int tid = F.tid, lane = F.lane, w = F.wave;
    for (int rg = F.bid; rg < T / 16; rg += F.G) {
        const int row0 = rg * 16;
        __syncthreads();
#pragma unroll
        for (int j = 0; j < 16; ++j) { const int idx = tid + 512 * j; *(LAS f32x4*)(xs + idx * 4) = *(const f32x4*)(Y + (size_t)row0 * D + (size_t)idx * 4); }
        if (tid < 64) hist[tid] = 0;
        __syncthreads();
#pragma unroll
        for (int rr = 0; rr < 2; ++rr) { const int r = 2 * w + rr; float sm = 0.f;
#pragma unroll
            for (int j = 0; j < 32; ++j) sm += xs[r * D + lane + 64 * j];
            const float mean = wave_sum(sm, lane) * (1.0f / D); float sq = 0.f;
#pragma unroll
            for (int j = 0; j < 32; ++j) { const float d = xs[r * D + lane + 64 * j] - mean; sq += d * d; }
            const float rstd = 1.0f / sqrtf(wave_sum(sq, lane) * (1.0f / D) + LN_EPS);
            if (lane == 0) { stat[2 * r] = mean; stat[2 * r + 1] = rstd; } }
        __syncthreads();
#pragma unroll
        for (int j = 0; j < 16; ++j) { const int idx = tid + 512 * j, r = idx >> 9, c4 = (idx & 511) * 4;
            const f32x4 v = *(LAS f32x4*)(xs + idx * 4), gv = *(const f32x4*)(gain + c4), bv = *(const f32x4*)(bias + c4);
            const float mean = stat[2 * r], rstd = stat[2 * r + 1];
            const f32x4 o = (v - mean) * rstd * gv + bv;
            *(LAS f32x4*)(xs + idx * 4) = o;
            *(f32x4*)(X1F + (size_t)(row0 + r) * D + c4) = o;
            v2u wb; wb.x = pk2(o[0], o[1]); wb.y = pk2(o[2], o[3]); *(v2u*)(X1B + (size_t)(row0 + r) * D + c4) = wb; }
        __syncthreads();
        { const int r = tid >> 5, ep = tid & 31; float a0 = 0.f, a1 = 0.f; const float* wp = RW + 2 * ep; const LAS float* xr = xs + r * D;
            for (int k0 = 0; k0 < D; k0 += 16) {
                f32x2 wv[16];
#pragma unroll
                for (int j = 0; j < 16; ++j) wv[j] = *(const f32x2*)(wp + (size_t)(k0 + j) * NEXP);
                asm volatile("" : "+v"(wv[0]), "+v"(wv[1]), "+v"(wv[2]), "+v"(wv[3]), "+v"(wv[4]), "+v"(wv[5]), "+v"(wv[6]), "+v"(wv[7]));
                asm volatile("" : "+v"(wv[8]), "+v"(wv[9]), "+v"(wv[10]), "+v"(wv[11]), "+v"(wv[12]), "+v"(wv[13]), "+v"(wv[14]), "+v"(wv[15]));
#pragma unroll
                for (int j = 0; j < 16; ++j) { const float xv = xr[k0 + j]; a0 += xv * wv[j].x; a1 += xv * wv[j].y; } }
            logit[r * NEXP + 2 * ep] = a0; logit[r * NEXP + 2 * ep + 1] = a1; }
        __syncthreads();
        int sel_pos[2]; float sel_gate[2]; int sel_rank[2]; bool sel_on[2];
#pragma unroll
        for (int rr = 0; rr < 2; ++rr) { const int r = 2 * w + rr;
            const float sc = 1.0f / (1.0f + __expf(-logit[r * NEXP + lane])); const float ch = sc + RB[lane];
            int rk = 0;
#pragma unroll
            for (int j = 0; j < 8; ++j) { const float cj = shfl_from(ch, (lane & ~7) + j); rk += (cj > ch || (cj == ch && j < (lane & 7))) ? 1 : 0; }
            float gs = rk < 2 ? ch : 0.f; gs += shfl_x(gs, 1, lane); gs += shfl_x(gs, 2, lane); gs += shfl_x(gs, 4, lane);
            int grk = 0; const int g = lane >> 3;
#pragma unroll
            for (int hh = 0; hh < 8; ++hh) { const float gh = shfl_from(gs, 8 * hh); grk += (gh > gs || (gh == gs && hh < g)) ? 1 : 0; }
            const float msk = grk < 4 ? ch : -INFINITY;
            int erk = 0;
            for (int j = 0; j < 64; ++j) { const float mj = __builtin_bit_cast(float, __builtin_amdgcn_readlane(__builtin_bit_cast(int, msk), j)); erk += (mj > msk || (mj == msk && j < lane)) ? 1 : 0; }
            const bool on = erk < 8;
            const float ssum = wave_sum(on ? sc : 0.f, lane);
            sel_on[rr] = on; sel_rank[rr] = erk; sel_gate[rr] = sc / ssum * 2.5f; sel_pos[rr] = 0;
            if (on) sel_pos[rr] = __hip_atomic_fetch_add(&hist[lane], 1, __ATOMIC_RELAXED, __HIP_MEMORY_SCOPE_WORKGROUP); }
        __syncthreads();
        if (tid < 64) { const int hc = hist[tid]; int bs = 0; if (hc > 0) bs = (int)atomicAdd(&cnt[tid * 16], (unsigned)hc); basep[tid] = bs; }
        __syncthreads();
#pragma unroll
        for (int rr = 0; rr < 2; ++rr) if (sel_on[rr]) { const int t = row0 + 2 * w + rr, pos = basep[lane] + sel_pos[rr];
            ltok[(size_t)lane * CAP + pos] = t; lgate[(size_t)lane * CAP + pos] = sel_gate[rr];
            eidx[t * 8 + sel_rank[rr]] = lane; inv[t * 8 + sel_rank[rr]] = pos; }
    }
}
__device__ __forceinline__ int build_tiles(const Frame& F, const unsigned* cnt) {
    LAS int* tpref = (LAS int*)(F.lds + LDS_TAB); LAS int* cl = (LAS int*)(F.lds + LDS_TAB + 512);
    __syncthreads();
    if (F.tid < 64) cl[F.tid] = (int)__hip_atomic_load(&cnt[F.tid * 16], __ATOMIC_RELAXED, __HIP_MEMORY_SCOPE_AGENT);
    __syncthreads();
    if (F.tid == 0) { int acc = 0; for (int e = 0; e < 64; ++e) { tpref[e] = acc; acc += (cl[e] + 255) >> 8; } tpref[64] = acc; }
    __syncthreads();
    return __builtin_amdgcn_readfirstlane(tpref[64]);
}
__device__ __forceinline__ void phase_moe4(const Frame& F, const float* Y2, const bf16* Yr, const int* eidx, const int* inv, const float* gain, const float* bias, float* XO, bf16* XBo) {
    const LAS int* tpref = (const LAS int*)(F.lds + LDS_TAB);
    const int gw = F.bid * 8 + F.wave, NGW = F.G * 8, lane = F.lane;
    for (int t = gw; t < T; t += NGW) {
        f32x4 v[8];
#pragma unroll
        for (int j = 0; j < 8; ++j) v[j] = *(const f32x4*)(Y2 + (size_t)t * D + 4 * lane + 256 * j);
        for (int k = 0; k < 8; ++k) { const int e = eidx[t * 8 + k], pos = inv[t * 8 + k]; const bf16* yr = Yr + (size_t)(tpref[e] * 256 + pos) * D + 4 * lane;
#pragma unroll
            for (int j = 0; j < 8; ++j) { const v2u w = *(const v2u*)(yr + 256 * j); v[j][0] += bflo(w.x); v[j][1] += bfhi(w.x); v[j][2] += bflo(w.y); v[j][3] += bfhi(w.y); } }
        float sm = 0.f;
#pragma unroll
        for (int j = 0; j < 8; ++j) sm += (v[j][0] + v[j][1]) + (v[j][2] + v[j][3]);
        const float mean = wave_sum(sm, lane) * (1.0f / D); float sq = 0.f;
#pragma unroll
        for (int j = 0; j < 8; ++j) { v[j] = v[j] - mean; sq += (v[j][0] * v[j][0] + v[j][1] * v[j][1]) + (v[j][2] * v[j][2] + v[j][3] * v[j][3]); }
        const float rstd = 1.0f / sqrtf(wave_sum(sq, lane) * (1.0f / D) + LN_EPS);
#pragma unroll
        for (int j = 0; j < 8; ++j) { const int c = 4 * lane + 256 * j; const f32x4 o = v[j] * rstd * *(const f32x4*)(gain + c) + *(const f32x4*)(bias + c);
            *(f32x4*)(XO + (size_t)t * D + c) = o;
            v2u wb; wb.x = pk2(o[0], o[1]); wb.y = pk2(o[2], o[3]); *(v2u*)(XBo + (size_t)t * D + c) = wb; }
    }
}


constexpr int M1_P = 0, M1N_HIST = 32768, M1N_BASE = 32768 + 256;
__device__ __forceinline__ void phase_moe1n(const Frame& F, const bf16* Y, const float* pst, const float* gain, const float* bias, const bf16* WH, const bf16* WL, const float* RB,
                                            bf16* X1B, float* ST1, unsigned* cnt, int* ltok, float* lgate, int* eidx, int* inv) {
    LAS float* P = (LAS float*)(F.lds + M1_P); LAS int* hist = (LAS int*)(F.lds + M1N_HIST); LAS int* basep = (LAS int*)(F.lds + M1N_BASE);
    const int tid = F.tid, lane = F.lane, w = F.wave, r = lane & 15, q = lane >> 4, pr = w >> 1, kh = w & 1;
    for (int item = F.bid; item < T / 64; item += F.G) {
        const int row0 = item * 64, row = row0 + 16 * pr + r;
        __syncthreads();
        if (tid < 64) hist[tid] = 0;
        float mean, rstd;
        { const f32x4* pp = (const f32x4*)(pst + ((size_t)row * 32 + q * 8) * 2); const f32x4 a = pp[0], b = pp[1], c = pp[2], d = pp[3];
          float sm = (a[0] + a[2]) + (b[0] + b[2]) + (c[0] + c[2]) + (d[0] + d[2]), sq = (a[1] + a[3]) + (b[1] + b[3]) + (c[1] + c[3]) + (d[1] + d[3]);
          sm += shfl_x(sm, 16, lane); sm += shfl_x(sm, 32, lane); sq += shfl_x(sq, 16, lane); sq += shfl_x(sq, 32, lane);
          mean = sm * (1.0f / D); const float var = fmaxf(sq * (1.0f / D) - mean * mean, 0.f); rstd = 1.0f / sqrtf(var + LN_EPS);
          if (kh == 0 && q == 0) *(f32x2*)(ST1 + 2 * row) = (f32x2){mean, rstd}; }
        const bf16* yp = Y + (size_t)row * D + kh * 1024 + 8 * q; const float* gp = gain + kh * 1024 + 8 * q; const float* bp = bias + kh * 1024 + 8 * q;
        const bf16* whp = WH + (size_t)r * D + kh * 1024 + 8 * q; const bf16* wlp = WL + (size_t)r * D + kh * 1024 + 8 * q;
        bf16* xo = X1B + (size_t)row * D + kh * 1024 + 8 * q;
        f32x4 acc[4];
#pragma unroll
        for (int nt = 0; nt < 4; ++nt) acc[nt] = (f32x4){0.f, 0.f, 0.f, 0.f};
#define M1_LOAD(S, st) do { const int _k = 32 * (st); S##yb = *(const v4u*)(yp + _k); S##g0 = *(const f32x4*)(gp + _k); S##g1 = *(const f32x4*)(gp + _k + 4); \
            S##b0 = *(const f32x4*)(bp + _k); S##b1 = *(const f32x4*)(bp + _k + 4); \
            _Pragma("unroll") for (int nt = 0; nt < 4; ++nt) { S##wh[nt] = *(const bf16x8*)(whp + (size_t)nt * 16 * D + _k); S##wl[nt] = *(const bf16x8*)(wlp + (size_t)nt * 16 * D + _k); } } while (0)
#define M1_COMP(S, st) do { const f32x4 S##y0 = (f32x4){bflo(S##yb.x), bfhi(S##yb.x), bflo(S##yb.y), bfhi(S##yb.y)}, S##y1 = (f32x4){bflo(S##yb.z), bfhi(S##yb.z), bflo(S##yb.w), bfhi(S##yb.w)}; \
            const f32x4 x0 = (S##y0 - mean) * rstd * S##g0 + S##b0, x1 = (S##y1 - mean) * rstd * S##g1 + S##b1; \
            v4u h; h.x = cvt_pk_bf16(x0[0], x0[1]); h.y = cvt_pk_bf16(x0[2], x0[3]); h.z = cvt_pk_bf16(x1[0], x1[1]); h.w = cvt_pk_bf16(x1[2], x1[3]); \
            *(v4u*)(xo + 32 * (st)) = h; \
            v4u l; l.x = cvt_pk_bf16(x0[0] - bflo(h.x), x0[1] - bfhi(h.x)); l.y = cvt_pk_bf16(x0[2] - bflo(h.y), x0[3] - bfhi(h.y)); \
            l.z = cvt_pk_bf16(x1[0] - bflo(h.z), x1[1] - bfhi(h.z)); l.w = cvt_pk_bf16(x1[2] - bflo(h.w), x1[3] - bfhi(h.w)); \
            const bf16x8 xh = __builtin_bit_cast(bf16x8, h), xl = __builtin_bit_cast(bf16x8, l); \
            _Pragma("unroll") for (int nt = 0; nt < 4; ++nt) { acc[nt] = __builtin_amdgcn_mfma_f32_16x16x32_bf16(xh, S##wh[nt], acc[nt], 0, 0, 0); \
                acc[nt] = __builtin_amdgcn_mfma_f32_16x16x32_bf16(xl, S##wh[nt], acc[nt], 0, 0, 0); acc[nt] = __builtin_amdgcn_mfma_f32_16x16x32_bf16(xh, S##wl[nt], acc[nt], 0, 0, 0); } } while (0)
        v4u Ayb, Byb; f32x4 Ag0, Ag1, Ab0, Ab1, Bg0, Bg1, Bb0, Bb1; bf16x8 Awh[4], Awl[4], Bwh[4], Bwl[4];
        M1_LOAD(A, 0);
        __builtin_amdgcn_sched_barrier(0);
#pragma unroll 1
        for (int st = 0; st < 32; st += 2) {
            M1_LOAD(B, st + 1);
            __builtin_amdgcn_sched_barrier(0);
            M1_COMP(A, st);
            __builtin_amdgcn_sched_barrier(0);
            if (st + 2 < 32) M1_LOAD(A, st + 2);
            __builtin_amdgcn_sched_barrier(0);
            M1_COMP(B, st + 1);
            __builtin_amdgcn_sched_barrier(0);
        }
#undef M1_LOAD
#undef M1_COMP
#pragma unroll
        for (int nt = 0; nt < 4; ++nt)
#pragma unroll
            for (int i = 0; i < 4; ++i) P[(kh * 64 + 16 * pr + 4 * q + i) * 64 + 16 * nt + r] = acc[nt][i];
        __syncthreads();
        int sel_pos[8]; float sel_gate[8]; int sel_rank[8]; bool sel_on[8];
        const float rb = RB[lane];
#pragma unroll
        for (int rr = 0; rr < 8; ++rr) { const int rl = 8 * w + rr;
            const float lg = P[rl * 64 + lane] + P[(64 + rl) * 64 + lane];
            const float sc = 1.0f / (1.0f + __expf(-lg)); const float ch = sc + rb;
            int rk = 0;
#pragma unroll
            for (int j = 0; j < 8; ++j) { const float cj = shfl_from(ch, (lane & ~7) + j); rk += (cj > ch || (cj == ch && j < (lane & 7))) ? 1 : 0; }
            float gs = rk < 2 ? ch : 0.f; gs += shfl_x(gs, 1, lane); gs += shfl_x(gs, 2, lane); gs += shfl_x(gs, 4, lane);
            int grk = 0; const int g = lane >> 3;
#pragma unroll
            for (int hh = 0; hh < 8; ++hh) { const float gh = shfl_from(gs, 8 * hh); grk += (gh > gs || (gh == gs && hh < g)) ? 1 : 0; }
            const float msk = grk < 4 ? ch : -INFINITY;
            int erk = 0;
            for (int j = 0; j < 64; ++j) { const float mj = __builtin_bit_cast(float, __builtin_amdgcn_readlane(__builtin_bit_cast(int, msk), j)); erk += (mj > msk || (mj == msk && j < lane)) ? 1 : 0; }
            const bool on = erk < 8;
            const float ssum = wave_sum(on ? sc : 0.f, lane);
            sel_on[rr] = on; sel_rank[rr] = erk; sel_gate[rr] = sc / ssum * 2.5f; sel_pos[rr] = 0;
            if (on) sel_pos[rr] = __hip_atomic_fetch_add(&hist[lane], 1, __ATOMIC_RELAXED, __HIP_MEMORY_SCOPE_WORKGROUP); }
        __syncthreads();
        if (tid < 64) { const int hc = hist[tid]; int bs = 0; if (hc > 0) bs = (int)atomicAdd(&cnt[tid * 16], (unsigned)hc); basep[tid] = bs; }
        __syncthreads();
#pragma unroll
        for (int rr = 0; rr < 8; ++rr) if (sel_on[rr]) { const int t = row0 + 8 * w + rr, pos = basep[lane] + sel_pos[rr];
            ltok[(size_t)lane * CAP + pos] = t * 8 + sel_rank[rr]; lgate[(size_t)lane * CAP + pos] = sel_gate[rr];
            eidx[t * 8 + sel_rank[rr]] = lane; inv[t * 8 + sel_rank[rr]] = pos; }
    }
}

constexpr int M3_PL = 131072, M3_CNT = 147456, M3_OFF = 147456 + 272;
__device__ __forceinline__ void phase_moe3n(const Frame& F, const bf16* H, const bf16* HSp, const int* eidx, const bf16* WD, const bf16* WSD,
                                            const float* Y1, const float* ST1, const float* g1, const float* b1, float* Y2, float* PST2) {
    LAS int* out = (LAS int*)F.lds; LAS unsigned short* plist = (LAS unsigned short*)(F.lds + M3_PL); LAS int* cnt = (LAS int*)(F.lds + M3_CNT); LAS int* off = (LAS int*)(F.lds + M3_OFF);
    const int tid = F.tid, lane = F.lane, w = F.wave, r = lane & 15, q = lane >> 4;
    for (int u = F.bid; u < 1024; u += F.G) {
        int nc = (u & 7) | ((u >> 7) << 3), tb = (u >> 3) & 15;
        if (F.G == 256) { const int i = u >> 8, x = u & 7, j = (u >> 3) & 31; tb = 2 * x + (i >> 1); nc = 32 * (i & 1) + j; }
        __syncthreads();
#pragma unroll
        for (int j = 0; j < 16; ++j) ((LAS v4u*)out)[tid + 512 * j] = (v4u){0u, 0u, 0u, 0u};
        if (tid < 66) cnt[tid] = 0;
        __syncthreads();
        int ee[16], pp[16];
        { const v4u* ep = (const v4u*)(eidx + ((size_t)tb * 1024 + 2 * tid) * 8); const v4u e0 = ep[0], e1 = ep[1], e2 = ep[2], e3 = ep[3];
          ee[0] = e0.x; ee[1] = e0.y; ee[2] = e0.z; ee[3] = e0.w; ee[4] = e1.x; ee[5] = e1.y; ee[6] = e1.z; ee[7] = e1.w;
          ee[8] = e2.x; ee[9] = e2.y; ee[10] = e2.z; ee[11] = e2.w; ee[12] = e3.x; ee[13] = e3.y; ee[14] = e3.z; ee[15] = e3.w; }
#pragma unroll
        for (int j = 0; j < 16; ++j) pp[j] = __hip_atomic_fetch_add(&cnt[ee[j]], 1, __ATOMIC_RELAXED, __HIP_MEMORY_SCOPE_WORKGROUP);
        __syncthreads();
        if (w == 0) { int c = cnt[lane], x = c;
#pragma unroll
            for (int o = 1; o < 64; o <<= 1) { const int y = __builtin_amdgcn_ds_bpermute(((lane - o) & 63) << 2, x); if (lane >= o) x += y; }
            off[lane] = x - c; if (lane == 63) off[64] = x; }
        __syncthreads();
#pragma unroll
        for (int j = 0; j < 16; ++j) plist[off[ee[j]] + pp[j]] = (unsigned short)(tid * 16 + j);
        __syncthreads();
        const char* Hb = (const char*)H + (size_t)tb * 8192 * 256 + q * 16;
        const char* HSb = (const char*)HSp + (size_t)tb * 1024 * 512 + q * 16;
        const char* Bb = (const char*)WD + ((size_t)nc * 32 + r) * 256 + q * 16;
        const char* BSb = (const char*)WSD + ((size_t)nc * 32 + r) * 512 + q * 16;
#define M3_NR(sg) ((sg) < 8 ? __builtin_amdgcn_readfirstlane(cnt[w + 8 * (sg)]) : 128)
#define M3_RB(sg) ((sg) < 8 ? __builtin_amdgcn_readfirstlane(off[w + 8 * (sg)]) : 0)
#define M3_GLD(dst, ptr, OFF) asm volatile("global_load_dwordx4 %0, %1, off offset:" #OFF : "=&v"(dst) : "v"(ptr) : "memory")
#define M3_LOADB(dst, sg) do { const char* _b0 = (sg) < 8 ? Bb + (size_t)(w + 8 * (sg)) * 524288 : BSb + ((sg) - 8) * 256; const char* _b1 = _b0 + ((sg) < 8 ? 4096 : 8192); \
            M3_GLD(dst[0][0], _b0, 0); M3_GLD(dst[0][1], _b0, 64); M3_GLD(dst[0][2], _b0, 128); M3_GLD(dst[0][3], _b0, 192); \
            M3_GLD(dst[1][0], _b1, 0); M3_GLD(dst[1][1], _b1, 64); M3_GLD(dst[1][2], _b1, 128); M3_GLD(dst[1][3], _b1, 192); } while (0)
#define M3_LOADA(dst, sg, bb, nr, rbs) do { int _i = 16 * (bb) + r; _i = _i < (nr) ? _i : (nr) - 1; const unsigned _rid = plist[(rbs) + _i]; \
            const char* _a = (sg) < 8 ? Hb + (size_t)_rid * 256 : ((sg) < 10 ? HSb + (size_t)(128 * w + _i) * 512 + ((sg) - 8) * 256 : Hb); \
            M3_GLD(dst[0], _a, 0); M3_GLD(dst[1], _a, 64); M3_GLD(dst[2], _a, 128); M3_GLD(dst[3], _a, 192); } while (0)
#define M3_ADV(sg, bb, nr, rbs) do { if ((sg) < 10) { ++(bb); if ((bb) * 16 >= (nr)) { (bb) = 0; do { ++(sg); } while ((sg) < 8 && M3_NR(sg) == 0); if ((sg) < 10) { (nr) = M3_NR(sg); (rbs) = M3_RB(sg); } } } } while (0)
#define M3_WAITA(AS) asm volatile("s_waitcnt vmcnt(12)" : "+v"(AS[0]), "+v"(AS[1]), "+v"(AS[2]), "+v"(AS[3]) :: "memory")
#define M3_WAITB(N) asm volatile("s_waitcnt vmcnt(" #N ")" : "+v"(Bn[0][0]), "+v"(Bn[0][1]), "+v"(Bn[0][2]), "+v"(Bn[0][3]), "+v"(Bn[1][0]), "+v"(Bn[1][1]), "+v"(Bn[1][2]), "+v"(Bn[1][3]) :: "memory")
#define M3_STEP(AS) if (cseg < 10) { \
              \
            int tk[4]; bool ok[4]; unsigned pl[4]; const int rt_ = cseg < 8; \
            _Pragma("unroll") for (int i = 0; i < 4; ++i) { const int idx = 16 * cbt + 4 * q + i; ok[i] = idx < cnr; const int ic = ok[i] ? idx : cnr - 1; pl[i] = plist[crbs + ic]; tk[i] = 128 * w + ic; } \
            _Pragma("unroll") for (int i = 0; i < 4; ++i) tk[i] = rt_ ? (int)(pl[i] >> 3) : tk[i]; \
            M3_WAITA(AS); \
            f32x4 acc[2]; \
            _Pragma("unroll") for (int nt = 0; nt < 2; ++nt) { acc[nt] = (f32x4){0.f, 0.f, 0.f, 0.f}; \
                _Pragma("unroll") for (int kk = 0; kk < 4; ++kk) acc[nt] = __builtin_amdgcn_mfma_f32_16x16x32_bf16(__builtin_bit_cast(bf16x8, AS[kk]), __builtin_bit_cast(bf16x8, Bc[nt][kk]), acc[nt], 0, 0, 0); } \
              \
            _Pragma("unroll") for (int i = 0; i < 4; ++i) { const long long lo_ = ok[i] ? (long long)__float2int_rn(acc[0][i] * 4194304.0f) : 0ll, hi_ = ok[i] ? (long long)__float2int_rn(acc[1][i] * 4194304.0f) : 0ll; \
                (void)__hip_atomic_fetch_add((LAS unsigned long long*)out + tk[i] * 16 + r, (unsigned long long)((hi_ << 32) + lo_), __ATOMIC_RELAXED, __HIP_MEMORY_SCOPE_WORKGROUP); } \
            M3_LOADA(AS, pseg, pbt, pnr, prbs); M3_ADV(pseg, pbt, pnr, prbs); \
            { const int old_ = cseg, nbat_ = (cnr + 15) >> 4; M3_ADV(cseg, cbt, cnr, crbs); \
              if (cseg != old_ && cseg < 10) { \
                  if (nbat_ == 1) M3_WAITB(4); else if (nbat_ == 2) M3_WAITB(8); else if (nbat_ == 3) M3_WAITB(12); else M3_WAITB(16); \
                  _Pragma("unroll") for (int nt = 0; nt < 2; ++nt) _Pragma("unroll") for (int kk = 0; kk < 4; ++kk) Bc[nt][kk] = Bn[nt][kk]; \
                  int nb_ = cseg; do { ++nb_; } while (nb_ < 8 && M3_NR(nb_) == 0); if (nb_ >= 10) nb_ = 9; M3_LOADB(Bn, nb_); } } }
        int cseg = -1, cbt = 0, cnr = 0, crbs = 0;
        do { ++cseg; } while (cseg < 8 && M3_NR(cseg) == 0);
        cnr = M3_NR(cseg); crbs = M3_RB(cseg);
        int pseg = cseg, pbt = 0, pnr = cnr, prbs = crbs;
        v4u Bc[2][4], Bn[2][4], A0[4], A1[4], A2[4], A3[4];
        M3_LOADB(Bc, cseg);
        M3_LOADA(A0, pseg, pbt, pnr, prbs); M3_ADV(pseg, pbt, pnr, prbs);
        M3_LOADA(A1, pseg, pbt, pnr, prbs); M3_ADV(pseg, pbt, pnr, prbs);
        M3_LOADA(A2, pseg, pbt, pnr, prbs); M3_ADV(pseg, pbt, pnr, prbs);
        M3_LOADA(A3, pseg, pbt, pnr, prbs); M3_ADV(pseg, pbt, pnr, prbs);
        { int nb_ = cseg; do { ++nb_; } while (nb_ < 8 && M3_NR(nb_) == 0); if (nb_ >= 10) nb_ = 9; M3_LOADB(Bn, nb_); }
        asm volatile("s_waitcnt vmcnt(0)" : "+v"(Bc[0][0]), "+v"(Bc[0][1]), "+v"(Bc[0][2]), "+v"(Bc[0][3]), "+v"(Bc[1][0]), "+v"(Bc[1][1]), "+v"(Bc[1][2]), "+v"(Bc[1][3]) :: "memory");
#pragma unroll 1
        while (cseg < 10) { M3_STEP(A0) M3_STEP(A1) M3_STEP(A2) M3_STEP(A3) }
        asm volatile("s_waitcnt vmcnt(0)" : "+v"(A0[0]), "+v"(A0[1]), "+v"(A0[2]), "+v"(A0[3]), "+v"(A1[0]), "+v"(A1[1]), "+v"(A1[2]), "+v"(A1[3]), "+v"(A2[0]), "+v"(A2[1]), "+v"(A2[2]), "+v"(A2[3]),
                     "+v"(A3[0]), "+v"(A3[1]), "+v"(A3[2]), "+v"(A3[3]), "+v"(Bn[0][0]), "+v"(Bn[0][1]), "+v"(Bn[0][2]), "+v"(Bn[0][3]), "+v"(Bn[1][0]), "+v"(Bn[1][1]), "+v"(Bn[1][2]), "+v"(Bn[1][3]) :: "memory");
#undef M3_NR
#undef M3_RB
#undef M3_GLD
#undef M3_LOADB
#undef M3_LOADA
#undef M3_ADV
#undef M3_WAITA
#undef M3_WAITB
#undef M3_STEP
        __syncthreads();
        { const int c4 = lane & 7, rs = lane >> 3, col = nc * 32 + 4 * c4;
          const f32x4 gv = *(const f32x4*)(g1 + col), bv = *(const f32x4*)(b1 + col);
#pragma unroll 4
          for (int it = 0; it < 16; ++it) { const int rl = 128 * w + 8 * it + rs; const size_t row = (size_t)tb * 1024 + rl;
              const f32x4 yv = *(const f32x4*)(Y1 + row * D + col); const f32x2 sv = *(const f32x2*)(ST1 + 2 * row);
              f32x4 tv; { const int nt = c4 >> 2, r0 = (4 * c4) & 15;
#pragma unroll
                  for (int j = 0; j < 4; ++j) { const v2u cell = *(const LAS v2u*)(out + rl * 32 + 2 * (r0 + j)); const int lo = (int)cell.x, hi = (int)cell.y + (lo < 0 ? 1 : 0); tv[j] = (float)(nt ? hi : lo) * (1.0f / 4194304.0f); } }
              const f32x4 y = ((yv - sv.x) * sv.y * gv + bv) * ALPHA + tv;
              *(f32x4*)(Y2 + row * D + col) = y;
              float sm = (y[0] + y[1]) + (y[2] + y[3]), sq = (y[0] * y[0] + y[1] * y[1]) + (y[2] * y[2] + y[3] * y[3]);
#pragma unroll
              for (int o = 1; o < 8; o <<= 1) { sm += shfl_x(sm, o, lane); sq += shfl_x(sq, o, lane); }
              if (c4 == 0) *(f32x2*)(PST2 + (row * 64 + nc) * 2) = (f32x2){sm, sq}; } }
    }
}

__device__ __forceinline__ void phase_moe4n(const Frame& F, const float* Y2, const float* pst, const float* gain, const float* bias, float* ST2, bf16* XBo, float* OUT, int last) {
    const int gw = F.bid * 8 + F.wave, NGW = F.G * 8, lane = F.lane;
    for (int t = gw; t < T; t += NGW) {
        f32x4 v[8];
#pragma unroll
        for (int j = 0; j < 8; ++j) v[j] = *(const f32x4*)(Y2 + (size_t)t * D + 4 * lane + 256 * j);
        const f32x2 pv = *(const f32x2*)(pst + ((size_t)t * 64 + lane) * 2);
        const float mean = wave_sum(pv.x, lane) * (1.0f / D); const float var = fmaxf(wave_sum(pv.y, lane) * (1.0f / D) - mean * mean, 0.f); const float rstd = 1.0f / sqrtf(var + LN_EPS);
        if (lane == 0) *(f32x2*)(ST2 + 2 * (size_t)t) = (f32x2){mean, rstd};
#pragma unroll
        for (int j = 0; j < 8; ++j) { const int c = 4 * lane + 256 * j; const f32x4 o = (v[j] - mean) * rstd * *(const f32x4*)(gain + c) + *(const f32x4*)(bias + c);
            if (last) *(f32x4*)(OUT + (size_t)t * D + c) = o;
            else { v2u wb; wb.x = pk2(o[0], o[1]); wb.y = pk2(o[2], o[3]); *(v2u*)(XBo + (size_t)t * D + c) = wb; } }
    }
}


__device__ __forceinline__ void phase_moe4g(const Frame& F, bf16* Y2, const bf16* Yr, const int* eidx, const int* inv, const float* gain, const float* bias, float* ST2, bf16* XBo, float* OUT, int last) {
    const LAS int* tpref = (const LAS int*)(F.lds + LDS_TAB);
    const int gw = F.bid * 8 + F.wave, NGW = F.G * 8, lane = F.lane;
    for (int t = gw; t < T; t += NGW) {
        int rowi = 0; if (lane < 8) { const int e = eidx[t * 8 + lane], ps = inv[t * 8 + lane]; rowi = tpref[e] * 256 + ps; }
        const bf16* rp[8];
#pragma unroll
        for (int k = 0; k < 8; ++k) rp[k] = Yr + (size_t)__builtin_amdgcn_readlane(rowi, k) * D + 4 * lane;
        f32x4 v[8]; v2u yv[8][8];
#pragma unroll
        for (int j = 0; j < 8; ++j) { const v2u pv = *(const v2u*)(Y2 + (size_t)t * D + 4 * lane + 256 * j); v[j] = (f32x4){bflo(pv.x), bfhi(pv.x), bflo(pv.y), bfhi(pv.y)}; }
#pragma unroll
        for (int k = 0; k < 8; ++k)
#pragma unroll
            for (int j = 0; j < 8; ++j) yv[k][j] = *(const v2u*)(rp[k] + 256 * j);
#pragma unroll
        for (int k = 0; k < 8; ++k) asm volatile("" : "+v"(yv[k][0]), "+v"(yv[k][1]), "+v"(yv[k][2]), "+v"(yv[k][3]), "+v"(yv[k][4]), "+v"(yv[k][5]), "+v"(yv[k][6]), "+v"(yv[k][7]));
#pragma unroll
        for (int k = 0; k < 8; ++k)
#pragma unroll
            for (int j = 0; j < 8; ++j) { v[j][0] += bflo(yv[k][j].x); v[j][1] += bfhi(yv[k][j].x); v[j][2] += bflo(yv[k][j].y); v[j][3] += bfhi(yv[k][j].y); }
        float sm = 0.f;
#pragma unroll
        for (int j = 0; j < 8; ++j) sm += (v[j][0] + v[j][1]) + (v[j][2] + v[j][3]);
        const float mean = wave_sum(sm, lane) * (1.0f / D); float sq = 0.f;
#pragma unroll
        for (int j = 0; j < 8; ++j) { const f32x4 d = v[j] - mean; sq += (d[0] * d[0] + d[1] * d[1]) + (d[2] * d[2] + d[3] * d[3]); }
        const float rstd = 1.0f / sqrtf(wave_sum(sq, lane) * (1.0f / D) + LN_EPS);
        if (lane == 0) *(f32x2*)(ST2 + 2 * (size_t)t) = (f32x2){mean, rstd};
#pragma unroll
        for (int j = 0; j < 8; ++j) { const int c = 4 * lane + 256 * j;
            if (!last) { v2u yw; yw.x = pk2(v[j][0], v[j][1]); yw.y = pk2(v[j][2], v[j][3]); *(v2u*)(Y2 + (size_t)t * D + c) = yw; }
            const f32x4 o = (v[j] - mean) * rstd * *(const f32x4*)(gain + c) + *(const f32x4*)(bias + c);
            if (last) *(f32x4*)(OUT + (size_t)t * D + c) = o;
            else { v2u wb; wb.x = pk2(o[0], o[1]); wb.y = pk2(o[2], o[3]); *(v2u*)(XBo + (size_t)t * D + c) = wb; } }
    }
}

enum { PH_PRO = 0, PH_POOL_G1, PH_POOL_P, PH_POOL_G2, PH_POOL_G3, PH_DIL_G1, PH_DIL_ATT, PH_DIL_CMB, PH_DIL_G2, PH_CONV_G1, PH_CONV_E, PH_CONV_G2, PH_MOE1, PH_MOE2, PH_MOE3, PH_MOE4, PH_COUNT };

template <int PH>
__device__ __forceinline__ void run_phase(const Frame& Fin, const Args& args_, const int L) {
    Frame F = Fin; { int w_ = Fin.wave, l_; asm volatile("" : "+s"(w_)); asm volatile("v_mbcnt_lo_u32_b32 %0, -1, 0\n\tv_mbcnt_hi_u32_b32 %0, -1, %0" : "=v"(l_)); F.wave = w_; F.lane = l_; F.tid = w_ * 64 + l_; }
    unsigned char* ws; { GAS unsigned char* wsg = (GAS unsigned char*)Fin.ws; asm volatile("" : "+s"(wsg)); ws = (unsigned char*)wsg; } F.ws = ws; F.ctl = (unsigned*)(ws + WS_CTL);
    KP kp = (KP)__builtin_amdgcn_kernarg_segment_ptr(); asm volatile("" : "+s"(kp)); (void)args_;
    { unsigned l_ = (unsigned)(size_t)Fin.lds; asm volatile("" : "+s"(l_)); F.lds = (LAS unsigned char*)(size_t)l_; }
    LAS unsigned char* ring = F.lds; int c = (int)blockIdx.x; { int g_ = Fin.G; asm volatile("" : "+s"(c), "+s"(g_)); F.G = g_; F.bid = c; }
    const float* xres = ain(kp, IN_X); const bf16* xresb = (const bf16*)(ws + WS_Y2F);
    const float* st2 = (const float*)(ws + WS_ST2); float* pstp = (float*)(ws + WS_PST);
    const float* g2p = ain(kp, IN_LNG) + (size_t)((L > 0 ? L - 1 : 0) * 2 + 1) * D; const float* b2p = ain(kp, IN_LNB) + (size_t)((L > 0 ? L - 1 : 0) * 2 + 1) * D;
    const bf16* xb = (const bf16*)(ws + WS_XB);
    bf16* yf = (bf16*)(ws + WS_YF);
    unsigned char* big = ws + WS_BIG;
    const int ia = L / 3;
    if constexpr (PH == PH_PRO) { phase_prologue(F, kp); }
    if constexpr (PH == PH_POOL_G1) { g8::DenseSched S; S.init(xb, (const bf16*)(ws + WS_W_POOL_IN) + (size_t)ia * D * D, T, D, D, D, F.G, c);
        g8::EpiBf16 E{(bf16*)(big + BG_U), D, 0}; g8::gemm_phase<g8::EpiBf16, g8::DenseSched, false>(ring, F.tid, D, D, D, S, E); }
    if constexpr (PH == PH_POOL_P) { phase_pool(F, (const bf16*)(big + BG_U), (bf16*)(big + BG_PL)); }
    if constexpr (PH == PH_POOL_G2) { g8::DenseSched S; S.init((const bf16*)(big + BG_PL), (const bf16*)(ws + WS_W_POOL_G) + (size_t)ia * D * 512, T, D, D, 512, F.G, c); S.agrp_shift = 1; S.agrp_stride = 512 * 2;
        g8::EpiScaleBf16 E{(bf16*)(big + BG_MX), D, ain(kp, IN_PSC) + (size_t)ia * D}; g8::gemm_phase<g8::EpiScaleBf16, g8::DenseSched, false>(ring, F.tid, 512, D, 512, S, E); }
    if constexpr (PH == PH_POOL_G3) { g8::DenseSched S; S.init((const bf16*)(big + BG_MX), (const bf16*)(ws + WS_W_POOL_OUT) + (size_t)ia * D * D, T, D, D, D, F.G, c);
        g8::EpiResidLN E{xres, xresb, st2, g2p, b2p, yf, pstp, L > 0}; g8::gemm_phase<g8::EpiResidLN, g8::DenseSched, false>(ring, F.tid, D, D, D, S, E); }
    if constexpr (PH == PH_DIL_G1) { g8::DenseSched S; S.init(xb, (const bf16*)(ws + WS_W_DIL_QKV), T, QKVC, D, D, F.G, c);
        g8::EpiBf16 E{(bf16*)(big + BG_QKV), QKVC, 1}; g8::gemm_phase<g8::EpiBf16, g8::DenseSched, false>(ring, F.tid, D, D, D, S, E); }
    if constexpr (PH == PH_DIL_ATT) { phase_attn(F, (const bf16*)(big + BG_QKV), ain(kp, IN_RELB), (bf16*)(big + BG_OG), (float*)(big + BG_LSE)); }
    if constexpr (PH == PH_DIL_CMB) { phase_combine(F, (const bf16*)(big + BG_OG), (const float*)(big + BG_LSE), (bf16*)(big + BG_O)); }
    if constexpr (PH == PH_DIL_G2) { g8::DenseSched S; S.init((const bf16*)(big + BG_O), (const bf16*)(ws + WS_W_DIL_OUT), T, D, DILW, DILW, F.G, c);
        g8::EpiResidLN E{xres, xresb, st2, g2p, b2p, yf, pstp, L > 0}; g8::gemm_phase<g8::EpiResidLN, g8::DenseSched, false>(ring, F.tid, DILW, DILW, DILW, S, E); }
    if constexpr (PH == PH_CONV_G1) { g8::DenseSched S; S.init(xb, (const bf16*)(ws + WS_W_CONV_IN), T, 3 * D, D, D, F.G, c);
        g8::EpiConvIn E{(bf16*)(big + BG_UC), (bf16*)(big + BG_BG)}; g8::gemm_phase<g8::EpiConvIn, g8::DenseSched, false>(ring, F.tid, D, D, D, S, E); }
    if constexpr (PH == PH_CONV_E) { phase_conv(F, (const bf16*)(big + BG_UC), (const bf16*)(big + BG_BG), ain(kp, IN_CW), (bf16*)(big + BG_Z)); }
    if constexpr (PH == PH_CONV_G2) { g8::DenseSched S; S.init((const bf16*)(big + BG_Z), (const bf16*)(ws + WS_W_CONV_OUT), T, D, D, D, F.G, c);
        g8::EpiResidLN E{xres, xresb, st2, g2p, b2p, yf, pstp, L > 0}; g8::gemm_phase<g8::EpiResidLN, g8::DenseSched, false>(ring, F.tid, D, D, D, S, E); }
    unsigned* cnt = F.ctl + CW_CNT + L * 64 * 16;
    float* x1f = (float*)(ws + WS_X1F); bf16* x1b = (bf16*)(ws + WS_X1B);
    int* ltok = (int*)(ws + WS_LTOK); float* lgate = (float*)(ws + WS_LGATE); int* eidx = (int*)(ws + WS_EIDX); int* inv = (int*)(ws + WS_INV);
    bf16* HB = (bf16*)(ws + WS_HB); bf16* HS = (bf16*)(ws + WS_HS); bf16* Yr = (bf16*)(ws + WS_BIG);
    if constexpr (PH == PH_MOE1) {
        const float* g1 = ain(kp, IN_LNG) + (size_t)(L * 2 + 0) * D; const float* b1 = ain(kp, IN_LNB) + (size_t)(L * 2 + 0) * D;
        phase_moe1n(F, yf, pstp, g1, b1, (const bf16*)(ws + WS_RWH) + (size_t)L * NEXP * D, (const bf16*)(ws + WS_RWL) + (size_t)L * NEXP * D, ain(kp, IN_RB) + (size_t)L * NEXP,
                    x1b, (float*)(ws + WS_ST1), cnt, ltok, lgate, eidx, inv); }
    if constexpr (PH == PH_MOE2) {
        const int NT = build_tiles(F, cnt);
        { g8::ExpertSched<1, true> S; S.tpref = (const LAS int*)(F.lds + LDS_TAB); S.cnt = (const LAS int*)(F.lds + LDS_TAB + 512); S.A = (const char*)x1b; S.B = (const char*)((const bf16*)(ws + WS_W_EX_GU) + (size_t)L * 64 * 256 * D);
          S.tok = ltok; S.b_exp = (size_t)256 * D * 2; S.b_tile = 0; S.a_tile = 0; S.NU = NT; S.G = F.G; S.c = c;
          g8::EpiExpertGU E{HB}; g8::gemm_phase<g8::EpiExpertGU, g8::ExpertSched<1, true>, true>(ring, F.tid, D, D, D, S, E); }
        { const int rot = (c - (NT % F.G) + F.G) % F.G;
          g8::DenseSched S; S.init(x1b, (const bf16*)(ws + WS_W_SH_GU) + (size_t)L * 512 * D, T, 512, D, D, F.G, rot);
          int t2 = F.tid; asm volatile("" : "+v"(t2));
          g8::EpiSharedGU E{HS}; g8::gemm_phase<g8::EpiSharedGU, g8::DenseSched, false>(ring, t2, D, D, D, S, E); } }
    if constexpr (PH == PH_MOE3) {
        const float* g1 = ain(kp, IN_LNG) + (size_t)(L * 2 + 0) * D; const float* b1 = ain(kp, IN_LNB) + (size_t)(L * 2 + 0) * D;
        const int NT = build_tiles(F, cnt);
        { g8::ExpertSched<8, false> S; S.tpref = (const LAS int*)(F.lds + LDS_TAB); S.cnt = (const LAS int*)(F.lds + LDS_TAB + 512); S.A = (const char*)HB; S.B = (const char*)((const bf16*)(ws + WS_W_EX_D) + (size_t)L * 64 * D * EDIM);
          S.tok = ltok; S.b_exp = (size_t)D * EDIM * 2; S.b_tile = (size_t)256 * EDIM * 2; S.a_tile = (size_t)256 * EDIM * 2; S.NU = NT * 8; S.G = F.G; S.c = c;
          int kd = EDIM; asm volatile("" : "+s"(kd));
          g8::EpiDownY E{Yr}; g8::gemm_phase<g8::EpiDownY, g8::ExpertSched<8, false>, false>(ring, F.tid, kd, kd, kd, S, E); }
        { const int rot = (c - ((NT * 8) % F.G) + F.G) % F.G;
          g8::DenseSched S; S.init(HS, (const bf16*)(ws + WS_W_SH_D) + (size_t)L * D * SDIM, T, D, SDIM, SDIM, F.G, rot);
          int t2 = F.tid; asm volatile("" : "+v"(t2));
          int ks = SDIM; asm volatile("" : "+s"(ks));
          g8::EpiResidLN E{nullptr, yf, (const float*)(ws + WS_ST1), g1, b1, (bf16*)(ws + WS_Y2F), pstp, 1}; g8::gemm_phase<g8::EpiResidLN, g8::DenseSched, false>(ring, t2, ks, ks, ks, S, E); } }
    if constexpr (PH == PH_MOE4) { (void)build_tiles(F, cnt);
        const float* g2 = ain(kp, IN_LNG) + (size_t)(L * 2 + 1) * D; const float* b2 = ain(kp, IN_LNB) + (size_t)(L * 2 + 1) * D;
        phase_moe4g(F, (bf16*)(ws + WS_Y2F), Yr, eidx, inv, g2, b2, (float*)(ws + WS_ST2), (bf16*)(ws + WS_XB), aout(kp), L == DEPTH - 1); }
}
__device__ __forceinline__ void make_frame(Frame& F, const Args& args) {
    extern __shared__ __attribute__((aligned(16))) unsigned char lds_raw[];
    F.lds = (LAS unsigned char*)lds_raw; F.ws = args.ws; F.ctl = (unsigned*)(args.ws + WS_CTL);
    F.tid = threadIdx.x; F.lane = F.tid & 63; F.wave = __builtin_amdgcn_readfirstlane(F.tid >> 6); F.G = gridDim.x; F.bid = blockIdx.x;
}
template <int PH> __global__ void __launch_bounds__(512, 2) k_phase(Args args, int L) {
    Frame F; make_frame(F, args);
    run_phase<PH>(F, args, L);
}

#ifndef MK_NOINLINE
#define MK_NOINLINE 0
#endif
#if MK_NOINLINE
template <int PH> __device__ __noinline__ void call_phase_ni(const int L) {
    Args dummy{}; Frame F;
    KP kp = (KP)__builtin_amdgcn_kernarg_segment_ptr();
    extern __shared__ __attribute__((aligned(16))) unsigned char lds_raw[];
    F.lds = (LAS unsigned char*)lds_raw; F.ws = (unsigned char*)((GAS unsigned char* const CAS*)kp)[20]; F.ctl = (unsigned*)(F.ws + WS_CTL);
    F.tid = threadIdx.x; F.lane = F.tid & 63; F.wave = __builtin_amdgcn_readfirstlane(F.tid >> 6); F.G = gridDim.x; F.bid = blockIdx.x;
    run_phase<PH>(F, dummy, L);
}
template <int PH> __device__ __forceinline__ void call_phase(const Frame& F, const Args& args, const int L) { call_phase_ni<PH>(L); }
#else
template <int PH> __device__ __forceinline__ void call_phase(const Frame& F, const Args& args, const int L) { asm volatile("; PHASE_BEGIN %0" :: "n"(PH)); run_phase<PH>(F, args, L); asm volatile("; PHASE_END %0" :: "n"(PH)); }
#endif
__global__ void __launch_bounds__(512, 2) fwd_all(Args args) {
    Frame F; make_frame(F, args);
    volatile LAS unsigned* misc = (volatile LAS unsigned*)(F.lds + LDS_MISC);
    if (F.tid < 4) misc[F.tid] = 0u;
    __syncthreads();
    const int lo = args.ph_lo, hi = args.ph_hi;
    XcdBarrier bar; bar.bar = F.ctl + CW_BAR; bar.x = 0; bar.st = misc;
    if (hi - lo > 1) bar = xcd_barrier_post(F.ctl + CW_BAR, misc);
    int pc = 0;
#ifndef MK_DUP_MASK
#define MK_DUP_MASK 0
#endif
#define STEP(PH, Lx) do { if (pc >= lo && pc < hi) { if ((MK_DUP_MASK >> (PH)) & 1) { call_phase<PH>(F, args, Lx); xcd_barrier(bar); } call_phase<PH>(F, args, Lx); if (pc + 1 < hi) xcd_barrier(bar); } ++pc; } while (0)
    STEP(PH_PRO, 0);
#pragma unroll 1
    for (int L = 0; L < DEPTH; ++L) {
        const int kind = L % 3;
        if (kind == 0) { STEP(PH_POOL_G1, L); STEP(PH_POOL_P, L); STEP(PH_POOL_G2, L); STEP(PH_POOL_G3, L); }
        else if (kind == 1) { STEP(PH_DIL_G1, L); STEP(PH_DIL_ATT, L); STEP(PH_DIL_CMB, L); STEP(PH_DIL_G2, L); }
        else { STEP(PH_CONV_G1, L); STEP(PH_CONV_E, L); STEP(PH_CONV_G2, L); }
        STEP(PH_MOE1, L); STEP(PH_MOE2, L); STEP(PH_MOE3, L); STEP(PH_MOE4, L);
    }
#undef STEP
}
constexpr int N_STEPS = 1 + 2 * 8 + 8 + 7;

template <int PH> static void launch_phase(const Args& a, int L, int grid, hipStream_t stream) {
    static bool attr = false;
    if (!attr) { (void)hipFuncSetAttribute((const void*)k_phase<PH>, hipFuncAttributeMaxDynamicSharedMemorySize, LDS_BYTES); attr = true; }
    hipLaunchKernelGGL(k_phase<PH>, dim3(grid), dim3(512), LDS_BYTES, stream, a, L);
}
extern "C" void kernel_launch(void* const* d_in, const int* in_sizes, int n_in, void* d_out, int out_size, void* d_ws, size_t ws_size, hipStream_t stream) {
    static int grid = 0;
    if (grid == 0) {
        if (n_in != 19 || out_size != T * D || ws_size < WS_END) { fprintf(stderr, "kernel_launch: unexpected shapes (n_in %d out %d ws %zu need %zu)\n", n_in, out_size, ws_size, (size_t)WS_END); grid = -1; return; }
        int dev = 0, cus = 0;
        if (hipGetDevice(&dev) != hipSuccess || hipDeviceGetAttribute(&cus, hipDeviceAttributeMultiprocessorCount, dev) != hipSuccess) { grid = -1; return; }
#if MK_ONE_LAUNCH
        if (hipFuncSetAttribute((const void*)fwd_all, hipFuncAttributeMaxDynamicSharedMemorySize, LDS_BYTES) != hipSuccess) { fprintf(stderr, "kernel_launch: hipFuncSetAttribute failed\n"); grid = -1; return; }
        int per_cu = 0;
        if (hipOccupancyMaxActiveBlocksPerMultiprocessor(&per_cu, (const void*)fwd_all, 512, LDS_BYTES) != hipSuccess || per_cu < 1) { fprintf(stderr, "kernel_launch: note: occupancy query reports %d blocks per CU\n", per_cu); (void)hipGetLastError(); }
#endif
        grid = cus;
    }
    if (grid < 0) return;
    (void)hipMemsetAsync((char*)d_ws + WS_CTL, 0, CTL_ZERO_BYTES, stream);
    Args a{};
    for (int i = 0; i < 19; ++i) a.in[i] = (const float*)d_in[i];
    a.out = (float*)d_out; a.ws = (unsigned char*)d_ws; a.ph_lo = 0; a.ph_hi = 0;
#if MK_ONE_LAUNCH
#ifdef MK_SPLIT
    for (int p = 0; p < N_STEPS; ++p) { a.ph_lo = p; a.ph_hi = p + 1; hipLaunchKernelGGL(fwd_all, dim3(grid), dim3(512), LDS_BYTES, stream, a); }
#else
    a.ph_lo = 0; a.ph_hi = N_STEPS;
    hipLaunchKernelGGL(fwd_all, dim3(grid), dim3(512), LDS_BYTES, stream, a);
#endif
#elif defined(MK_HYBRID_MASK)
    {
        static bool attr2 = false; if (!attr2) { (void)hipFuncSetAttribute((const void*)fwd_all, hipFuncAttributeMaxDynamicSharedMemorySize, LDS_BYTES); attr2 = true; }
        int pc = 0;
#define HSTEP(PH, Lx) do { if ((MK_HYBRID_MASK >> (PH)) & 1) { a.ph_lo = pc; a.ph_hi = pc + 1; hipLaunchKernelGGL(fwd_all, dim3(grid), dim3(512), LDS_BYTES, stream, a); } else { a.ph_lo = 0; a.ph_hi = 0; launch_phase<PH>(a, Lx, grid, stream); } ++pc; } while (0)
        HSTEP(PH_PRO, 0);
        for (int L = 0; L < DEPTH; ++L) {
            const int kind = L % 3;
            if (kind == 0) { HSTEP(PH_POOL_G1, L); HSTEP(PH_POOL_P, L); HSTEP(PH_POOL_G2, L); HSTEP(PH_POOL_G3, L); }
            else if (kind == 1) { HSTEP(PH_DIL_G1, L); HSTEP(PH_DIL_ATT, L); HSTEP(PH_DIL_CMB, L); HSTEP(PH_DIL_G2, L); }
            else { HSTEP(PH_CONV_G1, L); HSTEP(PH_CONV_E, L); HSTEP(PH_CONV_G2, L); }
            HSTEP(PH_MOE1, L); HSTEP(PH_MOE2, L); HSTEP(PH_MOE3, L); HSTEP(PH_MOE4, L);
        }
#undef HSTEP
    }
#else
    launch_phase<PH_PRO>(a, 0, grid, stream);
    for (int L = 0; L < DEPTH; ++L) {
        const int kind = L % 3;
        if (kind == 0) { launch_phase<PH_POOL_G1>(a, L, grid, stream); launch_phase<PH_POOL_P>(a, L, grid, stream); launch_phase<PH_POOL_G2>(a, L, grid, stream); launch_phase<PH_POOL_G3>(a, L, grid, stream); }
        else if (kind == 1) { launch_phase<PH_DIL_G1>(a, L, grid, stream); launch_phase<PH_DIL_ATT>(a, L, grid, stream); launch_phase<PH_DIL_CMB>(a, L, grid, stream); launch_phase<PH_DIL_G2>(a, L, grid, stream); }
        else { launch_phase<PH_CONV_G1>(a, L, grid, stream); launch_phase<PH_CONV_E>(a, L, grid, stream); launch_phase<PH_CONV_G2>(a, L, grid, stream); }
        launch_phase<PH_MOE1>(a, L, grid, stream); launch_phase<PH_MOE2>(a, L, grid, stream); launch_phase<PH_MOE3>(a, L, grid, stream); launch_phase<PH_MOE4>(a, L, grid, stream);
    }
#endif
}
```

```cpp
#include <hip/hip_runtime.h>
#include <cstdio>
#include <cstdint>

#ifndef MK_ONE_LAUNCH
#define MK_ONE_LAUNCH 1
#endif

#define GAS __attribute__((address_space(1)))
#define LAS __attribute__((address_space(3)))
typedef unsigned short bf16;
typedef unsigned v4u __attribute__((ext_vector_type(4)));
typedef unsigned v2u __attribute__((ext_vector_type(2)));
typedef float f32x4 __attribute__((ext_vector_type(4)));
typedef float f32x2 __attribute__((ext_vector_type(2)));
typedef short bf16x8 __attribute__((ext_vector_type(8)));
typedef short s16x4 __attribute__((ext_vector_type(4)));

constexpr int NBATCH = 8, SEQ = 2048, D = 2048, T = NBATCH * SEQ, DEPTH = 4;
constexpr int NEXP = 64, TOPK = 8, EDIM = 128, SDIM = 256;
constexpr int QKVC = 4608, DILW = 512;
constexpr float ALPHA = 1.681792830507429f;
constexpr float LN_EPS = 1e-5f;
constexpr int CAP = 16384;
constexpr int HROWS = T * TOPK + NEXP * 256;

constexpr size_t MiB = 1u << 20;
constexpr size_t WS_CTL = 0, CTL_ZERO_BYTES = 1 * MiB;
constexpr size_t WS_W_POOL_IN = 1 * MiB;
constexpr size_t WS_W_POOL_G = WS_W_POOL_IN + 16 * MiB;
constexpr size_t WS_W_POOL_OUT = WS_W_POOL_G + 4 * MiB;
constexpr size_t WS_W_DIL_QKV = WS_W_POOL_OUT + 16 * MiB;
constexpr size_t WS_W_DIL_OUT = WS_W_DIL_QKV + 18 * MiB;
constexpr size_t WS_W_CONV_IN = WS_W_DIL_OUT + 2 * MiB;
constexpr size_t WS_W_CONV_OUT = WS_W_CONV_IN + 24 * MiB;
constexpr size_t WS_W_SH_GU = WS_W_CONV_OUT + 8 * MiB;
constexpr size_t WS_W_SH_D = WS_W_SH_GU + 8 * MiB;
constexpr size_t WS_W_EX_GU = WS_W_SH_D + 4 * MiB;
constexpr size_t WS_W_EX_D = WS_W_EX_GU + 256 * MiB;
constexpr size_t WS_XF = WS_W_EX_D + 256 * MiB;
constexpr size_t WS_YF = WS_XF + 128 * MiB;
constexpr size_t WS_X1F = WS_YF + 128 * MiB;
constexpr size_t WS_XB = WS_X1F + 128 * MiB;
constexpr size_t WS_X1B = WS_XB + 64 * MiB;
constexpr size_t WS_HB = WS_X1B + 64 * MiB;
constexpr size_t WS_HS = WS_HB + 72 * MiB;
constexpr size_t WS_LTOK = WS_HS + 8 * MiB;
constexpr size_t WS_LGATE = WS_LTOK + 4 * MiB;
constexpr size_t WS_EIDX = WS_LGATE + 4 * MiB;
constexpr size_t WS_INV = WS_EIDX + 1 * MiB;
constexpr size_t WS_BIG = WS_INV + 1 * MiB;
constexpr size_t WS_PST = WS_BIG + 608 * MiB;
constexpr size_t WS_ST1 = WS_PST + 4 * MiB;
constexpr size_t WS_ST2 = WS_ST1 + 1 * MiB;
constexpr size_t WS_RWH = WS_ST2 + 1 * MiB;
constexpr size_t WS_RWL = WS_RWH + 1 * MiB;
constexpr size_t WS_PST2 = WS_RWL + 1 * MiB;
constexpr size_t WS_END = WS_PST2 + 8 * MiB;
constexpr size_t WS_Y2F = WS_X1F;
constexpr size_t BG_U = 0, BG_PL = 64 * MiB, BG_MX = 128 * MiB;
constexpr size_t BG_QKV = 0, BG_OG = 144 * MiB, BG_LSE = 192 * MiB, BG_O = 194 * MiB;
constexpr size_t BG_UC = 0, BG_BG = 64 * MiB, BG_Z = 128 * MiB;
constexpr int CW_BAR = 4096;
constexpr int CW_CNT = 16384;

constexpr int RING_BYTES = 131072;
constexpr int LDS_TAB = RING_BYTES;
constexpr int LDS_STASH = RING_BYTES + 1024;
constexpr int LDS_BYTES = 163840;
constexpr int LDS_MISC = LDS_BYTES - 1024;

typedef __bf16 bf16x2_t __attribute__((ext_vector_type(2)));
typedef float f32x2_t __attribute__((ext_vector_type(2)));
__device__ __forceinline__ unsigned cvt_pk_bf16(float lo, float hi) { const bf16x2_t r = __builtin_convertvector((f32x2_t){lo, hi}, bf16x2_t); return __builtin_bit_cast(unsigned, r); }
__device__ __forceinline__ unsigned f2bf(float f) { unsigned u = __builtin_bit_cast(unsigned, f); return (u + 0x7fffu + ((u >> 16) & 1u)) >> 16; }
__device__ __forceinline__ unsigned pk2(float lo, float hi) { return f2bf(lo) | (f2bf(hi) << 16); }
__device__ __forceinline__ float bflo(unsigned w) { return __builtin_bit_cast(float, w << 16); }
__device__ __forceinline__ float bfhi(unsigned w) { return __builtin_bit_cast(float, w & 0xffff0000u); }
__device__ __forceinline__ float shfl_from(float v, int src) { return __builtin_bit_cast(float, __builtin_amdgcn_ds_bpermute(src << 2, __builtin_bit_cast(int, v))); }
__device__ __forceinline__ float shfl_x(float v, int o, int lane) { return shfl_from(v, lane ^ o); }
__device__ __forceinline__ float wave_sum(float v, int lane) {
#pragma unroll
    for (int o = 1; o < 64; o <<= 1) v += shfl_x(v, o, lane);
    return v;
}
#define LDS_WAIT() asm volatile("s_waitcnt lgkmcnt(0)" ::: "memory")
#define VM_WAIT() asm volatile("s_waitcnt vmcnt(0)" ::: "memory")

#define XB_TMO      128
#define XB_XCNT(j)  (256  + 64 * (j))
#define XB_XSUB(j)  (1280 + 64 * (j))
#define XB_XGEN(j)  (2304 + 64 * (j))
#define XB_TOP      3328
#define XB_TOPGEN   3392
#define XCD_BAR_WORDS 3456
#define XB_SPIN_CAP (1u << 18)

__device__ __forceinline__ unsigned xb_ld(unsigned* p)              { return __hip_atomic_load(p, __ATOMIC_RELAXED, __HIP_MEMORY_SCOPE_AGENT); }
__device__ __forceinline__ unsigned xb_add(unsigned* p, unsigned v) { return __hip_atomic_fetch_add(p, v, __ATOMIC_RELAXED, __HIP_MEMORY_SCOPE_AGENT); }
__device__ __forceinline__ unsigned xb_xcc_id() { return (unsigned)__builtin_amdgcn_s_getreg((3 << 11) | 20) & 0xFu; }
#define XB_SPIN(cond, bar) do { unsigned _sp = 0; while (cond) { __builtin_amdgcn_s_sleep(1); \
    if ((++_sp & 255u) == 0u) { if (xb_ld(&(bar)[XB_TMO])) break; if (_sp > XB_SPIN_CAP) { atomicAdd(&(bar)[XB_TMO], 1u); break; } } } } while (0)

struct XcdBarrier {
    unsigned* bar; unsigned x;
    volatile LAS unsigned* st;
};

__device__ __forceinline__ XcdBarrier xcd_barrier_post(unsigned* bar, volatile LAS unsigned* st) {
    XcdBarrier b; b.bar = bar; b.x = xb_xcc_id(); b.st = st;
    if (threadIdx.x == 0) (void)xb_add(&bar[XB_XCNT(b.x)], 1u);
    return b;
}
__device__ __forceinline__ void xcd_barrier_complete(unsigned* bar, unsigned x, unsigned& nloc, unsigned& nx) {
    const unsigned G = gridDim.x * gridDim.y * gridDim.z;
    unsigned sum, cnt, mine, sp = 0u;
    for (;;) {
        sum = 0u; cnt = 0u; mine = 0u;
#pragma unroll
        for (unsigned j = 0; j < 16; ++j) { const unsigned c = xb_ld(&bar[XB_XCNT(j)]); sum += c; cnt += (c > 0u) ? 1u : 0u; mine = (j == x) ? c : mine; }
        if (sum == G) break;
        __builtin_amdgcn_s_sleep(1);
        if ((++sp & 255u) == 0u) { if (xb_ld(&bar[XB_TMO])) break; if (sp > XB_SPIN_CAP) { atomicAdd(&bar[XB_TMO], 1u); break; } }
    }
    nloc = mine > 0u ? mine : 1u; nx = cnt > 0u ? cnt : 1u;
}

__device__ __forceinline__ void xcd_barrier(const XcdBarrier& b) {
    asm volatile("s_waitcnt vmcnt(0)" ::: "memory");
    __syncthreads();
    if (threadIdx.x == 0) {
        unsigned* bar; unsigned bx = b.x; { GAS unsigned* bg = (GAS unsigned*)b.bar; asm volatile("" : "+s"(bg), "+s"(bx)); bar = (unsigned*)bg; }
        __builtin_amdgcn_s_waitcnt(0);
        unsigned nloc = b.st[0], nx = b.st[1];
        if (nloc == 0u) { xcd_barrier_complete(bar, bx, nloc, nx); b.st[0] = nloc; b.st[1] = nx; }
        const unsigned old = xb_add(&bar[XB_XSUB(bx)], 1u);
        const unsigned gen = old / nloc;
        if (old + 1u == (gen + 1u) * nloc) {
            __builtin_amdgcn_fence(__ATOMIC_RELEASE, "agent");
            asm volatile("s_waitcnt vmcnt(0)" ::: "memory");
            const unsigned og = xb_add(&bar[XB_TOP], 1u);
            const unsigned tg = og / nx;
            if (og + 1u == (tg + 1u) * nx) xb_add(&bar[XB_TOPGEN], 1u);
            else XB_SPIN(xb_ld(&bar[XB_TOPGEN]) == tg, bar);
            __builtin_amdgcn_fence(__ATOMIC_ACQUIRE, "agent");
            xb_add(&bar[XB_XGEN(bx)], 1u);
            asm volatile("s_waitcnt vmcnt(0)" ::: "memory");
        } else {
            XB_SPIN(xb_ld(&bar[XB_XGEN(bx)]) == gen, bar);
            __builtin_amdgcn_fence(__ATOMIC_ACQUIRE, "agent");
            asm volatile("s_waitcnt vmcnt(0)" ::: "memory");
        }
    }
    __syncthreads();
}

namespace g8 {
constexpr int BM = 256, BK = 64, HALF = 128, HTB = HALF * BK * 2, STAGE_BYTES = 8 * HTB, NXCD = 8, WGM = 8;
__host__ __device__ __forceinline__ int lds_byte(int r, int c) { const int st = (r >> 4) * 2 + (c >> 5), rr = r & 15, cc = c & 31, ob = rr * 64 + cc * 2; return st * 1024 + (ob ^ (((ob >> 9) & 1) << 5)); }
__host__ __device__ __forceinline__ void stage_rc(int b, int& R, int& C) { const int st = b / 1024, sb = b % 1024, swz = sb ^ (((sb >> 9) & 1) << 5); R = (st >> 1) * 16 + swz / 64; C = (st & 1) * 32 + (swz % 64) / 2; }
__host__ __device__ __forceinline__ int perm32(int rho) { const int n = rho >> 4, i = rho & 15; return 8 * (i >> 2) + 4 * n + (i & 3); }

struct Unit { const char* A; const char* B; const int* rows; int pm, pn, nvalid, aux; };

template <class Epi, class Sched, bool GATHER>
__device__ __forceinline__ void gemm_phase(LAS unsigned char* lds, const int tid_in, const int K, const int lda, const int ldb, const Sched& S, const Epi& E) {
    const int tid = tid_in, wid = __builtin_amdgcn_readfirstlane(tid >> 6), lane = tid & 63, wr = wid >> 2, wc = wid & 3, fr = lane & 15, fq = lane >> 4;
    const int nt = K / BK;
    unsigned voffB[2];
#pragma unroll
    for (int i = 0; i < 2; ++i) { int R_, C_; stage_rc(tid * 16 + i * 8192, R_, C_); const int Rb = Epi::PERM ? ((R_ & ~31) + perm32(R_ & 31)) : R_; voffB[i] = (unsigned)(Rb * ldb + C_) * 2u; }
    LAS v4u* stash = (LAS v4u*)(lds + (LDS_STASH - 0) + tid * 16);
    const size_t kstep = (size_t)(BK * 2);
    const size_t hstepB = (size_t)HALF * ldb * 2;
    const unsigned ldsw = (unsigned)wid * 1024u;
    const int aoff = lds_byte(wr * 64 + fr, fq * 8), boff = lds_byte(wc * 32 + fr, fq * 8);
#define G8_SA(b, h) (((b) * 2 + (h)) * HTB)
#define G8_SB(b, h) ((4 + (b) * 2 + (h)) * HTB)
#define G8_STAGE2(bufoff, gbase, v0, v1) do { \
        __builtin_amdgcn_global_load_lds((const unsigned*)((const char*)(gbase) + (v0)), (LAS unsigned*)(lds + (bufoff) + ldsw), 16, 0, 0); \
        __builtin_amdgcn_global_load_lds((const unsigned*)((const char*)(gbase) + (v1)), (LAS unsigned*)(lds + (bufoff) + ldsw + 8192), 16, 0, 0); } while (0)
#define G8_STAGEB(bufoff, gbase) G8_STAGE2(bufoff, gbase, voffB[0], voffB[1])
#define G8_LDA(dst, b, h) do { _Pragma("unroll") for (int m = 0; m < 4; ++m) _Pragma("unroll") for (int k = 0; k < 2; ++k) dst[m][k] = *(const LAS bf16x8*)(lds + G8_SA(b, h) + aoff + m * 2048 + k * 1024); } while (0)
#define G8_LDB(dst, b, h) do { _Pragma("unroll") for (int n = 0; n < 2; ++n) _Pragma("unroll") for (int k = 0; k < 2; ++k) dst[n][k] = *(const LAS bf16x8*)(lds + G8_SB(b, h) + boff + n * 2048 + k * 1024); } while (0)
#define G8_MMA(ai, bj, At, Bt) do { __builtin_amdgcn_s_setprio(1); _Pragma("unroll") for (int m = 0; m < 4; ++m) _Pragma("unroll") for (int n = 0; n < 2; ++n) _Pragma("unroll") for (int k = 0; k < 2; ++k) \
        acc[ai][bj][m][n] = __builtin_amdgcn_mfma_f32_16x16x32_bf16(Bt[n][k], At[m][k], acc[ai][bj][m][n], 0, 0, 0); __builtin_amdgcn_s_setprio(0); } while (0)
#define G8_WAIT_V(n) asm volatile("s_waitcnt vmcnt(" #n ")" ::: "memory")
#define G8_WAIT_L(n) asm volatile("s_waitcnt lgkmcnt(" #n ")" ::: "memory")
#define G8_BAR __builtin_amdgcn_s_barrier()
#define G8_SCHED __builtin_amdgcn_sched_barrier(0)
#define G8_SETVA(dst, u) do { int _t2 = tid; if (GATHER) asm volatile("" : "+v"(_t2)); _Pragma("unroll") for (int _h = 0; _h < 2; ++_h) _Pragma("unroll") for (int _i = 0; _i < 2; ++_i) { \
        int _R, _C; stage_rc(_t2 * 16 + _i * 8192, _R, _C); \
        const unsigned _rl = (unsigned)(_h * HALF + _R); unsigned _row = _rl; \
        if (GATHER) { _row = 0u; if (_rl < (unsigned)(u).nvalid) _row = (unsigned)(u).rows[_rl] >> 3; } \
        dst[_h][_i] = (_row * (unsigned)lda + (unsigned)_C) * 2u; } } while (0)
    Unit cur, nxt; int ui = 0;
    if (!S.next(0, cur)) return;
    f32x4 acc[2][2][4][2];
#pragma unroll
    for (int a = 0; a < 2; ++a)
#pragma unroll
        for (int b = 0; b < 2; ++b)
#pragma unroll
            for (int m = 0; m < 4; ++m)
#pragma unroll
                for (int n = 0; n < 2; ++n) acc[a][b][m][n] = (f32x4){0.f, 0.f, 0.f, 0.f};
    bf16x8 At[4][2], B0[2][2], B1[2][2];
    unsigned vAc[2][2]; unsigned xl00 = 0, xl01 = 0, xl10 = 0, xl11 = 0;
    G8_SETVA(vAc, cur);
    const char* cA = cur.A; const char* cB = cur.B;
    G8_STAGEB(G8_SB(0, 0), cB); G8_STAGEB(G8_SB(0, 1), cB + hstepB); G8_STAGE2(G8_SA(0, 0), cA, vAc[0][0], vAc[0][1]); G8_STAGE2(G8_SA(0, 1), cA, vAc[1][0], vAc[1][1]);
    if (wr == 1) G8_BAR;
    G8_WAIT_V(2); G8_BAR;
    G8_STAGEB(G8_SB(1, 0), cB + kstep); G8_STAGE2(G8_SA(1, 0), cA + kstep, vAc[0][0], vAc[0][1]); G8_STAGEB(G8_SB(1, 1), cB + hstepB + kstep);
    G8_WAIT_V(6); G8_BAR;
    for (;;) {
        const bool has_next = S.next(ui + 1, nxt);
        const char* nA = has_next ? nxt.A : cA; const char* nB = has_next ? nxt.B : cB;
        if (GATHER) { unsigned vAn[2][2]; if (has_next) { G8_SETVA(vAn, nxt); } else {
#pragma unroll
            for (int h = 0; h < 2; ++h)
#pragma unroll
                for (int i = 0; i < 2; ++i) vAn[h][i] = vAc[h][i]; }
            *stash = (v4u){vAn[0][0], vAn[0][1], vAn[1][0], vAn[1][1]}; }
#pragma unroll 1
        for (int t = 0; t < nt; t += 2) {
            const bool last = (t == nt - 2);
            const char* a1 = cA + (size_t)(t + 1) * kstep;
            const char* a2 = last ? nA : cA + (size_t)(t + 2) * kstep; const char* b2 = last ? nB : cB + (size_t)(t + 2) * kstep;
            const char* a3 = a2 + kstep; const char* b3 = b2 + kstep;
            unsigned x00 = vAc[0][0], x01 = vAc[0][1], x10 = vAc[1][0], x11 = vAc[1][1];
            if (GATHER) { if (last) { const v4u sv = *stash; x00 = sv.x; x01 = sv.y; x10 = sv.z; x11 = sv.w; } xl00 = x00; xl01 = x01; xl10 = x10; xl11 = x11; }
            G8_LDB(B0, 0, 0); G8_LDB(B1, 0, 1); G8_SCHED; G8_LDA(At, 0, 0); G8_STAGE2(G8_SA(1, 1), a1, vAc[1][0], vAc[1][1]);
            G8_WAIT_V(8); G8_WAIT_L(0); G8_BAR; G8_MMA(0, 0, At, B0); G8_MMA(0, 1, At, B1); G8_BAR; G8_SCHED;
            G8_LDA(At, 0, 1); G8_STAGEB(G8_SB(0, 0), b2); G8_STAGEB(G8_SB(0, 1), b2 + hstepB); G8_STAGE2(G8_SA(0, 0), a2, x00, x01);
            G8_WAIT_V(8); G8_WAIT_L(0); G8_BAR; G8_MMA(1, 0, At, B0); G8_MMA(1, 1, At, B1); G8_BAR; G8_SCHED;
            G8_LDB(B0, 1, 0); G8_LDB(B1, 1, 1); G8_SCHED; G8_LDA(At, 1, 0); G8_STAGE2(G8_SA(0, 1), a2, x10, x11);
            G8_WAIT_V(8); G8_WAIT_L(0); G8_BAR; G8_MMA(0, 0, At, B0); G8_MMA(0, 1, At, B1); G8_BAR; G8_SCHED;
            G8_LDA(At, 1, 1); G8_STAGEB(G8_SB(1, 0), b3); G8_STAGEB(G8_SB(1, 1), b3 + hstepB); G8_STAGE2(G8_SA(1, 0), a3, x00, x01);
            G8_WAIT_V(8); G8_WAIT_L(0); G8_BAR; G8_MMA(1, 0, At, B0); G8_MMA(1, 1, At, B1); G8_BAR; G8_SCHED;
        }
        if (wr == 0) G8_BAR;
        E(acc, cur, wr, wc, fr, fq);
        if (!has_next) break;
#pragma unroll
        for (int a = 0; a < 2; ++a)
#pragma unroll
            for (int b = 0; b < 2; ++b)
#pragma unroll
                for (int m = 0; m < 4; ++m)
#pragma unroll
                    for (int n = 0; n < 2; ++n) acc[a][b][m][n] = (f32x4){0.f, 0.f, 0.f, 0.f};
        cur = nxt; cA = nA; cB = nB; ++ui;
        if (GATHER) { vAc[0][0] = xl00; vAc[0][1] = xl01; vAc[1][0] = xl10; vAc[1][1] = xl11; }
        if (wr == 1) G8_BAR;
    }
    G8_WAIT_V(0);
    G8_BAR;
#undef G8_SA
#undef G8_SB
#undef G8_STAGE2
#undef G8_STAGEB
#undef G8_LDA
#undef G8_LDB
#undef G8_MMA
#undef G8_WAIT_V
#undef G8_WAIT_L
#undef G8_BAR
#undef G8_SCHED
#undef G8_SETVA
}

struct DenseSched {
    const char* A; const char* B; size_t a_tile, b_tile, agrp_stride; int agrp_shift, nM, nN, nwg, G, c;
    __device__ __forceinline__ void init(const void* A_, const void* B_, int M, int N, int lda, int ldb, int G_, int c_) {
        A = (const char*)A_; B = (const char*)B_; a_tile = (size_t)BM * lda * 2; b_tile = (size_t)BM * ldb * 2; agrp_stride = 0; agrp_shift = 0; nM = M / BM; nN = N / BM; nwg = nM * nN; G = G_; c = c_; }
    __device__ __forceinline__ bool next(int i, Unit& u) const {
        const long L = (long)i * G + c; if (L >= nwg) return false;
        int wgid = (int)L; { const int q = nwg / NXCD, r = nwg % NXCD, xcd = wgid % NXCD, off = wgid / NXCD; wgid = (xcd < r ? xcd * (q + 1) : r * (q + 1) + (xcd - r) * q) + off; }
        const int nig = WGM * nN, gid = wgid / nig, fm = gid * WGM, gsz = (nM - fm) < WGM ? (nM - fm) : WGM;
        u.pm = fm + ((wgid % nig) % gsz); u.pn = (wgid % nig) / gsz;
        u.A = A + (size_t)u.pm * a_tile + (size_t)(u.pn >> agrp_shift) * agrp_stride; u.B = B + (size_t)u.pn * b_tile; u.rows = nullptr; u.nvalid = BM; u.aux = 0; return true;
    }
};
template <int NPN, bool GATHERED>
struct ExpertSched {
    const LAS int* tpref; const LAS int* cnt; const char* A; const char* B; const int* tok; size_t b_exp, b_tile, a_tile; int NU, G, c;
    __device__ __forceinline__ bool next(int i, Unit& u) const {
        const int L = i * G + c; if (L >= NU) return false;
        const int tile = L / NPN, pn = L % NPN;
        int e = 0; while (__builtin_amdgcn_readfirstlane(tpref[e + 1]) <= tile) ++e;
        const int rb = tile - __builtin_amdgcn_readfirstlane(tpref[e]);
        u.pm = e; u.pn = pn; u.aux = tile * BM; u.nvalid = __builtin_amdgcn_readfirstlane(cnt[e]) - rb * BM; if (u.nvalid > BM) u.nvalid = BM;
        u.rows = tok + (size_t)e * CAP + rb * BM;
        u.A = GATHERED ? A : A + (size_t)tile * a_tile; u.B = B + (size_t)e * b_exp + (size_t)pn * b_tile; return true;
    }
};

struct EpiBf16 {
    static constexpr bool PERM = true;
    bf16* O; int ldc; int qscale;
    __device__ __forceinline__ void operator()(const f32x4 (&acc)[2][2][4][2], const Unit& u, int wr, int wc, int fr, int fq) const {
        asm volatile("" : "+v"(fr), "+v"(fq));
        const int row0 = u.pm * BM + wr * 64 + fr, col0 = u.pn * BM + wc * 32 + 8 * fq;
        const float sc = (qscale && (u.pn % 6) < 2) ? 0.125f : 1.0f;
#pragma unroll
        for (int ai = 0; ai < 2; ++ai)
#pragma unroll
            for (int m = 0; m < 4; ++m) { bf16* rowp = O + (size_t)(row0 + ai * HALF + m * 16) * ldc + col0;
#pragma unroll
                for (int bj = 0; bj < 2; ++bj) { const f32x4 v0 = acc[ai][bj][m][0] * sc, v1 = acc[ai][bj][m][1] * sc;
                    v4u w; w.x = cvt_pk_bf16(v0[0], v0[1]); w.y = cvt_pk_bf16(v0[2], v0[3]); w.z = cvt_pk_bf16(v1[0], v1[1]); w.w = cvt_pk_bf16(v1[2], v1[3]);
                    *(v4u*)(rowp + bj * HALF) = w; } }
    }
};
struct EpiScaleBf16 {
    static constexpr bool PERM = true;
    bf16* O; int ldc; const float* scale;
    __device__ __forceinline__ void operator()(const f32x4 (&acc)[2][2][4][2], const Unit& u, int wr, int wc, int fr, int fq) const {
        asm volatile("" : "+v"(fr), "+v"(fq));
        const int row0 = u.pm * BM + wr * 64 + fr, col0 = u.pn * BM + wc * 32 + 8 * fq;
        f32x4 sv[2][2];
#pragma unroll
        for (int bj = 0; bj < 2; ++bj)
#pragma unroll
            for (int n = 0; n < 2; ++n) sv[bj][n] = *(const f32x4*)(scale + col0 + bj * HALF + 4 * n);
#pragma unroll
        for (int ai = 0; ai < 2; ++ai)
#pragma unroll
            for (int m = 0; m < 4; ++m) { bf16* rowp = O + (size_t)(row0 + ai * HALF + m * 16) * ldc + col0;
#pragma unroll
                for (int bj = 0; bj < 2; ++bj) { const f32x4 v0 = acc[ai][bj][m][0] * sv[bj][0], v1 = acc[ai][bj][m][1] * sv[bj][1];
                    v4u w; w.x = cvt_pk_bf16(v0[0], v0[1]); w.y = cvt_pk_bf16(v0[2], v0[3]); w.z = cvt_pk_bf16(v1[0], v1[1]); w.w = cvt_pk_bf16(v1[2], v1[3]);
                    *(v4u*)(rowp + bj * HALF) = w; } }
    }
};
struct EpiResid {
    static constexpr bool PERM = false;
    const float* X; float* Y;
    __device__ __forceinline__ void operator()(const f32x4 (&acc)[2][2][4][2], const Unit& u, int wr, int wc, int fr, int fq) const {
        asm volatile("" : "+v"(fr), "+v"(fq));
        const int row0 = u.pm * BM + wr * 64 + fr, col0 = u.pn * BM + wc * 32 + 4 * fq;
#pragma unroll
        for (int ai = 0; ai < 2; ++ai)
#pragma unroll
            for (int m = 0; m < 4; ++m) { const size_t off = (size_t)(row0 + ai * HALF + m * 16) * D + col0;
#pragma unroll
                for (int bj = 0; bj < 2; ++bj)
#pragma unroll
                    for (int n = 0; n < 2; ++n) { const f32x4 xv = *(const f32x4*)(X + off + bj * HALF + n * 16); *(f32x4*)(Y + off + bj * HALF + n * 16) = xv * ALPHA + acc[ai][bj][m][n]; } }
    }
};
struct EpiResidLN {
    static constexpr bool PERM = true;
    const float* X32; const bf16* Xb; const float* st; const float* g; const float* b; bf16* Y; float* pst; int mode;
    __device__ __forceinline__ void operator()(const f32x4 (&acc)[2][2][4][2], const Unit& u, int wr, int wc, int fr, int fq) const {
        asm volatile("" : "+v"(fr), "+v"(fq));
        const int row0 = u.pm * BM + wr * 64 + fr, col0 = u.pn * BM + wc * 32 + 8 * fq, lane = fq * 16 + fr;
#pragma unroll
        for (int ai = 0; ai < 2; ++ai)
#pragma unroll
            for (int m = 0; m < 4; ++m) { const int row = row0 + ai * HALF + m * 16; const size_t off = (size_t)row * D + col0;
                float mean = 0.f, rstd = 1.f; if (mode) { const f32x2 sv = *(const f32x2*)(st + 2 * row); mean = sv.x; rstd = sv.y; }
                float sm = 0.f, sq = 0.f;
#pragma unroll
                for (int bj = 0; bj < 2; ++bj) { f32x4 x0, x1;
                    if (mode) { const v4u xv = *(const v4u*)(Xb + off + bj * HALF);
                        const f32x4 g0 = *(const f32x4*)(g + col0 + bj * HALF), g1 = *(const f32x4*)(g + col0 + bj * HALF + 4), b0 = *(const f32x4*)(b + col0 + bj * HALF), b1 = *(const f32x4*)(b + col0 + bj * HALF + 4);
                        x0 = ((f32x4){bflo(xv.x), bfhi(xv.x), bflo(xv.y), bfhi(xv.y)} - mean) * rstd * g0 + b0; x1 = ((f32x4){bflo(xv.z), bfhi(xv.z), bflo(xv.w), bfhi(xv.w)} - mean) * rstd * g1 + b1; }
                    else { x0 = *(const f32x4*)(X32 + off + bj * HALF); x1 = *(const f32x4*)(X32 + off + bj * HALF + 4); }
                    const f32x4 y0 = x0 * ALPHA + acc[ai][bj][m][0], y1 = x1 * ALPHA + acc[ai][bj][m][1];
                    v4u w; w.x = cvt_pk_bf16(y0[0], y0[1]); w.y = cvt_pk_bf16(y0[2], y0[3]); w.z = cvt_pk_bf16(y1[0], y1[1]); w.w = cvt_pk_bf16(y1[2], y1[3]);
                    *(v4u*)(Y + off + bj * HALF) = w;
                    sm += ((y0[0] + y0[1]) + (y0[2] + y0[3])) + ((y1[0] + y1[1]) + (y1[2] + y1[3]));
                    sq += ((y0[0] * y0[0] + y0[1] * y0[1]) + (y0[2] * y0[2] + y0[3] * y0[3])) + ((y1[0] * y1[0] + y1[1] * y1[1]) + (y1[2] * y1[2] + y1[3] * y1[3])); }
                sm += shfl_x(sm, 16, lane); sm += shfl_x(sm, 32, lane); sq += shfl_x(sq, 16, lane); sq += shfl_x(sq, 32, lane);
                if (fq == 0) *(f32x2*)(pst + ((size_t)row * 32 + u.pn * 4 + wc) * 2) = (f32x2){sm, sq}; }
    }
};
struct EpiConvIn {
    static constexpr bool PERM = true;
    bf16* UC; bf16* BGp;
    __device__ __forceinline__ void operator()(const f32x4 (&acc)[2][2][4][2], const Unit& u, int wr, int wc, int fr, int fq) const {
        asm volatile("" : "+v"(fr), "+v"(fq));
        const int row0 = u.pm * BM + wr * 64 + fr, cw = wc * 32 + 8 * fq;
        if (u.pn < 16) {
#pragma unroll
            for (int ai = 0; ai < 2; ++ai)
#pragma unroll
                for (int m = 0; m < 4; ++m) { bf16* rowp = UC + (size_t)(row0 + ai * HALF + m * 16) * D + u.pn * HALF + cw;
                    const f32x4 v0 = acc[ai][0][m][0] * acc[ai][1][m][0], v1 = acc[ai][0][m][1] * acc[ai][1][m][1];
                    v4u w; w.x = cvt_pk_bf16(v0[0], v0[1]); w.y = cvt_pk_bf16(v0[2], v0[3]); w.z = cvt_pk_bf16(v1[0], v1[1]); w.w = cvt_pk_bf16(v1[2], v1[3]);
                    *(v4u*)rowp = w; }
        } else {
#pragma unroll
            for (int ai = 0; ai < 2; ++ai)
#pragma unroll
                for (int m = 0; m < 4; ++m) { bf16* rowp = BGp + (size_t)(row0 + ai * HALF + m * 16) * D + (u.pn - 16) * BM + cw;
#pragma unroll
                    for (int bj = 0; bj < 2; ++bj) { const f32x4 v0 = acc[ai][bj][m][0], v1 = acc[ai][bj][m][1];
                        v4u w; w.x = cvt_pk_bf16(v0[0], v0[1]); w.y = cvt_pk_bf16(v0[2], v0[3]); w.z = cvt_pk_bf16(v1[0], v1[1]); w.w = cvt_pk_bf16(v1[2], v1[3]);
                        *(v4u*)(rowp + bj * HALF) = w; } }
        }
    }
};
__device__ __forceinline__ f32x4 silu_mul(f32x4 g, f32x4 uu) {
    f32x4 r;
#pragma unroll
    for (int j = 0; j < 4; ++j) r[j] = g[j] * __builtin_amdgcn_rcpf(1.0f + __expf(-g[j])) * uu[j];
    return r;
}
struct EpiExpertGU {
    static constexpr bool PERM = true;
    bf16* H;
    __device__ __forceinline__ void operator()(const f32x4 (&acc)[2][2][4][2], const Unit& u, int wr, int wc, int fr, int fq) const {
        asm volatile("" : "+v"(fr), "+v"(fq));
        const float* gates = (const float*)((const char*)u.rows + (WS_LGATE - WS_LTOK));
        const int cw = wc * 32 + 8 * fq;
#pragma unroll
        for (int ai = 0; ai < 2; ++ai)
#pragma unroll
            for (int m = 0; m < 4; ++m) { const int r = ai * HALF + wr * 64 + m * 16 + fr;
                if (r < u.nvalid) { const float gt = gates[r]; const unsigned pid = (unsigned)u.rows[r];
                    const f32x4 v0 = silu_mul(acc[ai][0][m][0], acc[ai][1][m][0]) * gt, v1 = silu_mul(acc[ai][0][m][1], acc[ai][1][m][1]) * gt;
                    v4u w; w.x = cvt_pk_bf16(v0[0], v0[1]); w.y = cvt_pk_bf16(v0[2], v0[3]); w.z = cvt_pk_bf16(v1[0], v1[1]); w.w = cvt_pk_bf16(v1[2], v1[3]);
                    (void)pid; *(v4u*)(H + (size_t)(u.aux + r) * EDIM + cw) = w; } }
    }
};
struct EpiSharedGU {
    static constexpr bool PERM = true;
    bf16* HS;
    __device__ __forceinline__ void operator()(const f32x4 (&acc)[2][2][4][2], const Unit& u, int wr, int wc, int fr, int fq) const {
        asm volatile("" : "+v"(fr), "+v"(fq));
        const int row0 = u.pm * BM + wr * 64 + fr, cw = u.pn * HALF + wc * 32 + 8 * fq;
#pragma unroll
        for (int ai = 0; ai < 2; ++ai)
#pragma unroll
            for (int m = 0; m < 4; ++m) {
                const f32x4 v0 = silu_mul(acc[ai][0][m][0], acc[ai][1][m][0]), v1 = silu_mul(acc[ai][0][m][1], acc[ai][1][m][1]);
                v4u w; w.x = cvt_pk_bf16(v0[0], v0[1]); w.y = cvt_pk_bf16(v0[2], v0[3]); w.z = cvt_pk_bf16(v1[0], v1[1]); w.w = cvt_pk_bf16(v1[2], v1[3]);
                *(v4u*)(HS + (size_t)(row0 + ai * HALF + m * 16) * SDIM + cw) = w; }
    }
};
struct EpiDownY {
    static constexpr bool PERM = true;
    bf16* Y;
    __device__ __forceinline__ void operator()(const f32x4 (&acc)[2][2][4][2], const Unit& u, int wr, int wc, int fr, int fq) const {
        asm volatile("" : "+v"(fr), "+v"(fq));
        const int col0 = u.pn * BM + wc * 32 + 8 * fq;
#pragma unroll
        for (int ai = 0; ai < 2; ++ai)
#pragma unroll
            for (int m = 0; m < 4; ++m) { const int r = ai * HALF + wr * 64 + m * 16 + fr; bf16* rowp = Y + (size_t)(u.aux + r) * D + col0;
#pragma unroll
                for (int bj = 0; bj < 2; ++bj) { const f32x4 v0 = acc[ai][bj][m][0], v1 = acc[ai][bj][m][1];
                    v4u w; w.x = cvt_pk_bf16(v0[0], v0[1]); w.y = cvt_pk_bf16(v0[2], v0[3]); w.z = cvt_pk_bf16(v1[0], v1[1]); w.w = cvt_pk_bf16(v1[2], v1[3]);
                    *(v4u*)(rowp + bj * HALF) = w; } }
    }
};
}

struct Args { const float* in[19]; float* out; unsigned char* ws; int ph_lo, ph_hi; };
struct Frame {
    LAS unsigned char* lds; unsigned* ctl; unsigned char* ws;
    int tid, lane, wave, G, bid;
};
enum { IN_X = 0, IN_RELB, IN_PWIN, IN_PWG, IN_PSC, IN_PWOUT, IN_DQKV, IN_DOUT, IN_CWIN, IN_CW, IN_CWOUT, IN_LNG, IN_LNB, IN_RW, IN_RB, IN_EGU, IN_ED, IN_SGU, IN_SD };

#define CAS __attribute__((address_space(4)))
typedef const CAS unsigned char* KP;
__device__ __forceinline__ const float* ain(KP kp, int i) { return (const float*)((const GAS float* const CAS*)kp)[i]; }
__device__ __forceinline__ float* aout(KP kp) { return (float*)((GAS float* const CAS*)kp)[19]; }
__device__ __forceinline__ void tr_item(const float* W, int K, int N, bf16* WT, int dstK, int mode, LAS float* scr, int item, int lane) {
    const int nblk = N / 32, kb = item / nblk, nb = item % nblk, k0 = 64 * kb, n0 = 32 * nb;
    int r0 = n0;
    if (mode == 1) { const int part = n0 / 2048, j = n0 % 2048; r0 = (part == 0) ? 4096 + j : 256 * (j / 128) + (part == 2 ? 128 : 0) + (j % 128); }
    if (mode == 2) { const int part = n0 / 256, j = n0 % 256; r0 = 256 * (j / 128) + 128 * part + (j % 128); }
#pragma unroll 8
    for (int i = 0; i < 32; ++i) { const int kk = 2 * i + (lane >> 5); scr[kk * 33 + (lane & 31)] = W[(size_t)(k0 + kk) * N + n0 + (lane & 31)]; }
    LDS_WAIT(); asm volatile("" ::: "memory");
    const int c = lane & 7;
#pragma unroll
    for (int j = 0; j < 4; ++j) { const int n = (lane >> 3) + 8 * j; const LAS float* s = scr + (8 * c) * 33 + n;
        v4u o; o.x = pk2(s[0 * 33], s[1 * 33]); o.y = pk2(s[2 * 33], s[3 * 33]); o.z = pk2(s[4 * 33], s[5 * 33]); o.w = pk2(s[6 * 33], s[7 * 33]);
        *(v4u*)(WT + (size_t)(r0 + n) * dstK + k0 + 8 * c) = o; }
    LDS_WAIT(); asm volatile("" ::: "memory");
}
__device__ __forceinline__ void phase_prologue(const Frame& F, KP kp) {
    LAS float* scr = (LAS float*)(F.lds + F.wave * 16384);
    const int gw = F.bid * 8 + F.wave, NGW = F.G * 8;
    constexpr int I0 = 2 * 2048, I1 = 8 * 128, I2 = 2 * 2048, I3 = 4608, I4 = 512, I5 = 6144, I6 = 2048, I7 = 4 * 512, I8 = 4 * 256, I9 = 256 * 256, I10 = 256 * 128;
    constexpr int NITEMS = I0 + I1 + I2 + I3 + I4 + I5 + I6 + I7 + I8 + I9 + I10;
    unsigned char* ws = F.ws;
    for (int it = gw; it < NITEMS; it += NGW) {
        int r = it;
        if (r < I0) { const int b = r / 2048; tr_item(ain(kp, IN_PWIN) + (size_t)b * D * D, D, D, (bf16*)(ws + WS_W_POOL_IN) + (size_t)b * D * D, D, 0, scr, r % 2048, F.lane); continue; } r -= I0;
        if (r < I1) { const int b = r / 128; tr_item(ain(kp, IN_PWG) + (size_t)b * 512 * 512, 512, 512, (bf16*)(ws + WS_W_POOL_G) + (size_t)b * 512 * 512, 512, 0, scr, r % 128, F.lane); continue; } r -= I1;
        if (r < I2) { const int b = r / 2048; tr_item(ain(kp, IN_PWOUT) + (size_t)b * D * D, D, D, (bf16*)(ws + WS_W_POOL_OUT) + (size_t)b * D * D, D, 0, scr, r % 2048, F.lane); continue; } r -= I2;
        if (r < I3) { tr_item(ain(kp, IN_DQKV), D, QKVC, (bf16*)(ws + WS_W_DIL_QKV), D, 0, scr, r, F.lane); continue; } r -= I3;
        if (r < I4) { tr_item(ain(kp, IN_DOUT), DILW, D, (bf16*)(ws + WS_W_DIL_OUT), DILW, 0, scr, r, F.lane); continue; } r -= I4;
        if (r < I5) { tr_item(ain(kp, IN_CWIN), D, 3 * D, (bf16*)(ws + WS_W_CONV_IN), D, 1, scr, r, F.lane); continue; } r -= I5;
        if (r < I6) { tr_item(ain(kp, IN_CWOUT), D, D, (bf16*)(ws + WS_W_CONV_OUT), D, 0, scr, r, F.lane); continue; } r -= I6;
        if (r < I7) { const int b = r / 512; tr_item(ain(kp, IN_SGU) + (size_t)b * D * 512, D, 512, (bf16*)(ws + WS_W_SH_GU) + (size_t)b * 512 * D, D, 2, scr, r % 512, F.lane); continue; } r -= I7;
        if (r < I8) { const int b = r / 256; tr_item(ain(kp, IN_SD) + (size_t)b * SDIM * D, SDIM, D, (bf16*)(ws + WS_W_SH_D) + (size_t)b * D * SDIM, SDIM, 0, scr, r % 256, F.lane); continue; } r -= I8;
        if (r < I9) { const int b = r / 256; tr_item(ain(kp, IN_EGU) + (size_t)b * D * 256, D, 256, (bf16*)(ws + WS_W_EX_GU) + (size_t)b * 256 * D, D, 0, scr, r % 256, F.lane); continue; } r -= I9;
        { const int b = r / 128; tr_item(ain(kp, IN_ED) + (size_t)b * EDIM * D, EDIM, D, (bf16*)(ws + WS_W_EX_D) + (size_t)b * D * EDIM, EDIM, 0, scr, r % 128, F.lane); }
    }
    const size_t gt = (size_t)F.bid * 512 + F.tid, GT = (size_t)F.G * 512;
    { const float* rw = ain(kp, IN_RW); bf16* wh = (bf16*)(ws + WS_RWH); bf16* wl = (bf16*)(ws + WS_RWL);
      for (size_t i = gt; i < (size_t)DEPTH * NEXP * D / 8; i += GT) { const size_t k8 = i % (D / 8), e = (i / (D / 8)) % NEXP, l = i / ((size_t)NEXP * D / 8);
          float v[8]; unsigned hi[8], lo[8];
#pragma unroll
          for (int j = 0; j < 8; ++j) { v[j] = rw[(l * D + k8 * 8 + j) * NEXP + e]; hi[j] = f2bf(v[j]); lo[j] = f2bf(v[j] - __builtin_bit_cast(float, hi[j] << 16)); }
          v4u a, b2; a.x = hi[0] | (hi[1] << 16); a.y = hi[2] | (hi[3] << 16); a.z = hi[4] | (hi[5] << 16); a.w = hi[6] | (hi[7] << 16);
          b2.x = lo[0] | (lo[1] << 16); b2.y = lo[2] | (lo[3] << 16); b2.z = lo[4] | (lo[5] << 16); b2.w = lo[6] | (lo[7] << 16);
          *(v4u*)(wh + (l * NEXP + e) * D + k8 * 8) = a; *(v4u*)(wl + (l * NEXP + e) * D + k8 * 8) = b2; } }
    const float* x = ain(kp, IN_X); bf16* xb = (bf16*)(ws + WS_XB);
    for (size_t i = gt; i < (size_t)T * D / 8; i += GT) { const f32x4 p = *(const f32x4*)(x + i * 8), q = *(const f32x4*)(x + i * 8 + 4);
        v4u w; w.x = pk2(p[0], p[1]); w.y = pk2(p[2], p[3]); w.z = pk2(q[0], q[1]); w.w = pk2(q[2], q[3]); *(v4u*)(xb + i * 8) = w; }
}

__device__ __forceinline__ void unpack8(const v4u w, float (&f)[8]) { f[0] = bflo(w.x); f[1] = bfhi(w.x); f[2] = bflo(w.y); f[3] = bfhi(w.y); f[4] = bflo(w.z); f[5] = bfhi(w.z); f[6] = bflo(w.w); f[7] = bfhi(w.w); }
__device__ __forceinline__ void phase_pool(const Frame& F, const bf16* U, bf16* PL) {
    for (int it = F.bid * 512 + F.tid; it < (T / 32) * 256; it += F.G * 512) {
        const int cv = it & 255, ch = it >> 8, col = cv * 8, w = 2 << (col >> 9);
        const int row0 = ch * 32, pos0 = row0 & (SEQ - 1);
        float s[8], uu[8];
#pragma unroll
        for (int j = 0; j < 8; ++j) s[j] = 0.f;
        for (int j = 1; j < w; ++j) if (pos0 - j >= 0) { unpack8(*(const v4u*)(U + (size_t)(row0 - j) * D + col), uu);
#pragma unroll
            for (int q = 0; q < 8; ++q) s[q] += uu[q]; }
        for (int r = 0; r < 32; ++r) {
            const int t = row0 + r, pos = pos0 + r;
            unpack8(*(const v4u*)(U + (size_t)t * D + col), uu);
            const float inv = 1.0f / (float)((pos + 1) < w ? (pos + 1) : w);
            float o[8];
#pragma unroll
            for (int q = 0; q < 8; ++q) { s[q] += uu[q]; o[q] = s[q] * inv - uu[q]; }
            v4u ww; ww.x = pk2(o[0], o[1]); ww.y = pk2(o[2], o[3]); ww.z = pk2(o[4], o[5]); ww.w = pk2(o[6], o[7]);
            *(v4u*)(PL + (size_t)t * D + col) = ww;
            if (pos - w + 1 >= 0) { unpack8(*(const v4u*)(U + (size_t)(t - w + 1) * D + col), uu);
#pragma unroll
                for (int q = 0; q < 8; ++q) s[q] -= uu[q]; }
        }
    }
}

__device__ __forceinline__ void phase_conv(const Frame& F, const bf16* UC, const bf16* BGp, const float* cw, bf16* Z) {
    for (int it = F.bid * 512 + F.tid; it < T * 256; it += F.G * 512) {
        const int cv = it & 255, t = it >> 8, col = cv * 8, pos = t & (SEQ - 1);
        float u0[8], u1[8], u2[8], bb[8], o[8];
        unpack8(*(const v4u*)(UC + (size_t)t * D + col), u2);
        if (pos >= 1) unpack8(*(const v4u*)(UC + (size_t)(t - 1) * D + col), u1); else {
#pragma unroll
            for (int q = 0; q < 8; ++q) u1[q] = 0.f; }
        if (pos >= 2) unpack8(*(const v4u*)(UC + (size_t)(t - 2) * D + col), u0); else {
#pragma unroll
            for (int q = 0; q < 8; ++q) u0[q] = 0.f; }
        unpack8(*(const v4u*)(BGp + (size_t)t * D + col), bb);
#pragma unroll
        for (int q = 0; q < 8; ++q) o[q] = bb[q] * (cw[col + q] * u0[q] + cw[D + col + q] * u1[q] + cw[2 * D + col + q] * u2[q]);
        v4u ww; ww.x = pk2(o[0], o[1]); ww.y = pk2(o[2], o[3]); ww.z = pk2(o[4], o[5]); ww.w = pk2(o[6], o[7]);
        *(v4u*)(Z + (size_t)t * D + col) = ww;
    }
}

__device__ __forceinline__ int t5_bucket(int dist) {
    if (dist < 16) return dist;
    int large = 16 + (int)(logf((float)dist / 16.0f) / logf(128.0f) * 16.0f);
    return large < 31 ? large : 31;
}
constexpr int AT_KS = 0, AT_KSTR = 144, AT_VT = 256 * 144, AT_VSTR = 520, AT_BIAS = AT_VT + 64 * 520;
__device__ __forceinline__ void phase_attn(const Frame& F, const bf16* QKV, const float* relb, bf16* OG, float* LSE) {
    LAS unsigned char* lds = F.lds;
    const int tid = F.tid, lane = F.lane, w = tid >> 6, fr = lane & 15, fq = lane >> 4;
    for (int unit = F.bid; unit < NBATCH * 3 * 8 * 16; unit += F.G) {
        const int cmb = unit & 15, h = (unit >> 4) & 7, g = (unit >> 7) % 3, b = unit / 384;
        const int dsh = 2 * g, dil = 1 << dsh, r = cmb & (dil - 1), nb = cmb >> dsh;
        const bf16* base = QKV + (size_t)b * SEQ * QKVC + g * 1536 + h * 64;
        __syncthreads();
        {
            const int key = tid >> 1, half = tid & 1, jk = (nb - 1) * 128 + key;
            v4u kv[4], vv[4];
            if (jk >= 0) { const bf16* rp = base + (size_t)(jk * dil + r) * QKVC + half * 32;
#pragma unroll
                for (int i = 0; i < 4; ++i) { kv[i] = *(const v4u*)(rp + 512 + 8 * i); vv[i] = *(const v4u*)(rp + 1024 + 8 * i); } }
            else {
#pragma unroll
                for (int i = 0; i < 4; ++i) { kv[i] = (v4u){0u, 0u, 0u, 0u}; vv[i] = (v4u){0u, 0u, 0u, 0u}; } }
#pragma unroll
            for (int i = 0; i < 4; ++i) *(LAS v4u*)(lds + AT_KS + key * AT_KSTR + half * 64 + 16 * i) = kv[i];
#pragma unroll
            for (int i = 0; i < 4; ++i) {
                const unsigned ww[4] = {vv[i].x, vv[i].y, vv[i].z, vv[i].w};
#pragma unroll
                for (int q = 0; q < 4; ++q) { const int d = half * 32 + 8 * i + 2 * q;
                    *(LAS unsigned short*)(lds + AT_VT + d * AT_VSTR + key * 2) = (unsigned short)(ww[q] & 0xffffu);
                    *(LAS unsigned short*)(lds + AT_VT + (d + 1) * AT_VSTR + key * 2) = (unsigned short)(ww[q] >> 16); } }
            if (tid <= 128) ((LAS float*)(lds + AT_BIAS))[tid] = relb[t5_bucket(tid * dil) * 24 + g * 8 + h];
        }
        __syncthreads();
        int qi = 16 * w + fr; asm volatile("" : "+v"(qi));
        const int jq = nb * 128 + qi, tq = jq * dil + r;
        const bf16* qp = base + (size_t)tq * QKVC + 8 * fq;
        const bf16x8 q0 = *(const bf16x8*)qp, q1 = *(const bf16x8*)(qp + 32);
        f32x4 s[9]; float mx = -INFINITY;
#pragma unroll
        for (int kt = 0; kt < 9; ++kt) {
            const int kb = 16 * (w + kt);
            const bf16x8 k0 = *(const LAS bf16x8*)(lds + AT_KS + (kb + fr) * AT_KSTR + fq * 16), k1 = *(const LAS bf16x8*)(lds + AT_KS + (kb + fr) * AT_KSTR + 64 + fq * 16);
            f32x4 a = (f32x4){0.f, 0.f, 0.f, 0.f};
            a = __builtin_amdgcn_mfma_f32_16x16x32_bf16(k0, q0, a, 0, 0, 0);
            a = __builtin_amdgcn_mfma_f32_16x16x32_bf16(k1, q1, a, 0, 0, 0);
#pragma unroll
            for (int i = 0; i < 4; ++i) { const int kl = kb + 4 * fq + i, rel = qi + 128 - kl;
                const bool ok = (rel >= 0) && (rel <= 128) && (nb > 0 || kl >= 128);
                const int rc = rel < 0 ? 0 : (rel > 128 ? 128 : rel);
                const float v = ok ? a[i] + ((LAS float*)(lds + AT_BIAS))[rc] : -INFINITY;
                a[i] = v; mx = fmaxf(mx, v); }
            s[kt] = a;
        }
        mx = fmaxf(mx, shfl_x(mx, 16, lane)); mx = fmaxf(mx, shfl_x(mx, 32, lane));
        float l = 0.f;
#pragma unroll
        for (int kt = 0; kt < 9; ++kt)
#pragma unroll
            for (int i = 0; i < 4; ++i) { const float p = __expf(s[kt][i] - mx); s[kt][i] = p; l += p; }
        l += shfl_x(l, 16, lane); l += shfl_x(l, 32, lane);
        f32x4 o[4];
#pragma unroll
        for (int nt = 0; nt < 4; ++nt) o[nt] = (f32x4){0.f, 0.f, 0.f, 0.f};
#pragma unroll
        for (int st = 0; st < 5; ++st) {
            const int kt0 = 2 * st, kt1 = 2 * st + 1;
            v4u pw; pw.x = pk2(s[kt0][0], s[kt0][1]); pw.y = pk2(s[kt0][2], s[kt0][3]);
            if (kt1 < 9) { pw.z = pk2(s[kt1 < 9 ? kt1 : 0][0], s[kt1 < 9 ? kt1 : 0][1]); pw.w = pk2(s[kt1 < 9 ? kt1 : 0][2], s[kt1 < 9 ? kt1 : 0][3]); } else { pw.z = 0u; pw.w = 0u; }
            const bf16x8 pf = __builtin_bit_cast(bf16x8, pw);
            const int kb0 = 16 * (w + kt0) + 4 * fq, kb1 = 16 * (w + kt1) + 4 * fq;
#pragma unroll
            for (int nt = 0; nt < 4; ++nt) { const int d = 16 * nt + fr;
                v2u va = *(const LAS v2u*)(lds + AT_VT + d * AT_VSTR + kb0 * 2), vb = (v2u){0u, 0u};
                if (kt1 < 9) vb = *(const LAS v2u*)(lds + AT_VT + d * AT_VSTR + kb1 * 2);
                v4u vw; vw.x = va.x; vw.y = va.y; vw.z = vb.x; vw.w = vb.y;
                o[nt] = __builtin_amdgcn_mfma_f32_16x16x32_bf16(__builtin_bit_cast(bf16x8, vw), pf, o[nt], 0, 0, 0); }
        }
        const float il = 1.0f / l;
        bf16* op = OG + ((size_t)g * T + (size_t)b * SEQ + tq) * DILW + h * 64 + 4 * fq;
#pragma unroll
        for (int nt = 0; nt < 4; ++nt) { v2u ww; ww.x = pk2(o[nt][0] * il, o[nt][1] * il); ww.y = pk2(o[nt][2] * il, o[nt][3] * il); *(v2u*)(op + 16 * nt) = ww; }
        if (fq == 0) LSE[((size_t)g * T + (size_t)b * SEQ + tq) * 8 + h] = mx + logf(l);
    }
}
__device__ __forceinline__ void phase_combine(const Frame& F, const bf16* OG, const float* LSE, bf16* O) {
    for (int it = F.bid * 512 + F.tid; it < T * 64; it += F.G * 512) {
        const int c8 = it & 7, h = (it >> 3) & 7, t = it >> 6;
        const float l0 = LSE[((size_t)0 * T + t) * 8 + h], l1 = LSE[((size_t)1 * T + t) * 8 + h], l2 = LSE[((size_t)2 * T + t) * 8 + h];
        const float m = fmaxf(l0, fmaxf(l1, l2)); float w0 = __expf(l0 - m), w1 = __expf(l1 - m), w2 = __expf(l2 - m); const float inv = 1.0f / (w0 + w1 + w2); w0 *= inv; w1 *= inv; w2 *= inv;
        float a[8], bq[8], c[8], o[8]; const size_t off = (size_t)t * DILW + h * 64 + c8 * 8;
        unpack8(*(const v4u*)(OG + off), a); unpack8(*(const v4u*)(OG + (size_t)T * DILW + off), bq); unpack8(*(const v4u*)(OG + (size_t)2 * T * DILW + off), c);
#pragma unroll
        for (int q = 0; q < 8; ++q) o[q] = w0 * a[q] + w1 * bq[q] + w2 * c[q];
        v4u ww; ww.x = pk2(o[0], o[1]); ww.y = pk2(o[2], o[3]); ww.z = pk2(o[4], o[5]); ww.w = pk2(o[6], o[7]);
        *(v4u*)(O + off) = ww;
    }
}

constexpr int M1_LOG = 131072, M1_STAT = M1_LOG + 4096, M1_HIST = M1_STAT + 128, M1_BASE = M1_HIST + 256;
__device__ __forceinline__ void phase_moe1(const Frame& F, const float* Y, const float* gain, const float* bias, const float* RW, const float* RB,
                                           float* X1F, bf16* X1B, unsigned* cnt, int* ltok, float* lgate, int* eidx, int* inv) {
    LAS float* xs = (LAS float*)F.lds; LAS float* logit = (LAS float*)(F.lds + M1_LOG); LAS float* stat = (LAS float*)(F.lds + M1_STAT);
    LAS int* hist = (LAS int*)(F.lds + M1_HIST); LAS int* basep = (LAS int*)(F.lds + M1_BASE);
    const int tid = F.tid, lane = F.lane, w = F.wave;
    for (int rg = F.bid; rg < T / 16; rg += F.G) {
        const int row0 = rg * 16;
        __syncthreads();
#pragma unroll
        for (int j = 0; j < 16; ++j) { const int idx = tid + 512 * j; *(LAS f32x4*)(xs + idx * 4) = *(const f32x4*)(Y + (size_t)row0 * D + (size_t)idx * 4); }
        if (tid < 64) hist[tid] = 0;
        __syncthreads();
#pragma unroll
        for (int rr = 0; rr < 2; ++rr) { const int r = 2 * w + rr; float sm = 0.f;
#pragma unroll
            for (int j = 0; j < 32; ++j) sm += xs[r * D + lane + 64 * j];
            const float mean = wave_sum(sm, lane) * (1.0f / D); float sq = 0.f;
#pragma unroll
            for (int j = 0; j < 32; ++j) { const float d = xs[r * D + lane + 64 * j] - mean; sq += d * d; }
            const float rstd = 1.0f / sqrtf(wave_sum(sq, lane) * (1.0f / D) + LN_EPS);
            if (lane == 0) { stat[2 * r] = mean; stat[2 * r + 1] = rstd; } }
        __syncthreads();
#pragma unroll
        for (int j = 0; j < 16; ++j) { const int idx = tid + 512 * j, r = idx >> 9, c4 = (idx & 511) * 4;
            const f32x4 v = *(LAS f32x4*)(xs + idx * 4), gv = *(const f32x4*)(gain + c4), bv = *(const f32x4*)(bias + c4);
            const float mean = stat[2 * r], rstd = stat[2 * r + 1];
            const f32x4 o = (v - mean) * rstd * gv + bv;
            *(LAS f32x4*)(xs + idx * 4) = o;
            *(f32x4*)(X1F + (size_t)(row0 + r) * D + c4) = o;
            v2u wb; wb.x = pk2(o[0], o[1]); wb.y = pk2(o[2], o[3]); *(v2u*)(X1B + (size_t)(row0 + r) * D + c4) = wb; }
        __syncthreads();
        { const int r = tid >> 5, ep = tid & 31; float a0 = 0.f, a1 = 0.f; const float* wp = RW + 2 * ep; const LAS float* xr = xs + r * D;
            for (int k0 = 0; k0 < D; k0 += 16) {
                f32x2 wv[16];
#pragma unroll
                for (int j = 0; j < 16; ++j) wv[j] = *(const f32x2*)(wp + (size_t)(k0 + j) * NEXP);
                asm volatile("" : "+v"(wv[0]), "+v"(wv[1]), "+v"(wv[2]), "+v"(wv[3]), "+v"(wv[4]), "+v"(wv[5]), "+v"(wv[6]), "+v"(wv[7]));
                asm volatile("" : "+v"(wv[8]), "+v"(wv[9]), "+v"(wv[10]), "+v"(wv[11]), "+v"(wv[12]), "+v"(wv[13]), "+v"(wv[14]), "+v"(wv[15]));
#pragma unroll
                for (int j = 0; j < 16; ++j) { const float xv = xr[k0 + j]; a0 += xv * wv[j].x; a1 += xv * wv[j].y; } }
            logit[r * NEXP + 2 * ep] = a0; logit[r * NEXP + 2 * ep + 1] = a1; }
        __syncthreads();
        int sel_pos[2]; float sel_gate[2]; int sel_rank[2]; bool sel_on[2];
#pragma unroll
        for (int rr = 0; rr < 2; ++rr) { const int r = 2 * w + rr;
            const float sc = 1.0f / (1.0f + __expf(-logit[r * NEXP + lane])); const float ch = sc + RB[lane];
            int rk = 0;
#pragma unroll
            for (int j = 0; j < 8; ++j) { const float cj = shfl_from(ch, (lane & ~7) + j); rk += (cj > ch || (cj == ch && j < (lane & 7))) ? 1 : 0; }
            float gs = rk < 2 ? ch : 0.f; gs += shfl_x(gs, 1, lane); gs += shfl_x(gs, 2, lane); gs += shfl_x(gs, 4, lane);
            int grk = 0; const int g = lane >> 3;
#pragma unroll
            for (int hh = 0; hh < 8; ++hh) { const float gh = shfl_from(gs, 8 * hh); grk += (gh > gs || (gh == gs && hh < g)) ? 1 : 0; }
            const float msk = grk < 4 ? ch : -INFINITY;
            int erk = 0;
            for (int j = 0; j < 64; ++j) { const float mj = __builtin_bit_cast(float, __builtin_amdgcn_readlane(__builtin_bit_cast(int, msk), j)); erk += (mj > msk || (mj == msk && j < lane)) ? 1 : 0; }
            const bool on = erk < 8;
            const float ssum = wave_sum(on ? sc : 0.f, lane);
            sel_on[rr] = on; sel_rank[rr] = erk; sel_gate[rr] = sc / ssum * 2.5f; sel_pos[rr] = 0;
            if (on) sel_pos[rr] = __hip_atomic_fetch_add(&hist[lane], 1, __ATOMIC_RELAXED, __HIP_MEMORY_SCOPE_WORKGROUP); }
        __syncthreads();
        if (tid < 64) { const int hc = hist[tid]; int bs = 0; if (hc > 0) bs = (int)atomicAdd(&cnt[tid * 16], (unsigned)hc); basep[tid] = bs; }
        __syncthreads();
#pragma unroll
        for (int rr = 0; rr < 2; ++rr) if (sel_on[rr]) { const int t = row0 + 2 * w + rr, pos = basep[lane] + sel_pos[rr];
            ltok[(size_t)lane * CAP + pos] = t; lgate[(size_t)lane * CAP + pos] = sel_gate[rr];
            eidx[t * 8 + sel_rank[rr]] = lane; inv[t * 8 + sel_rank[rr]] = pos; }
    }
}
__device__ __forceinline__ int build_tiles(const Frame& F, const unsigned* cnt) {
    LAS int* tpref = (LAS int*)(F.lds + LDS_TAB); LAS int* cl = (LAS int*)(F.lds + LDS_TAB + 512);
    __syncthreads();
    if (F.tid < 64) cl[F.tid] = (int)__hip_atomic_load(&cnt[F.tid * 16], __ATOMIC_RELAXED, __HIP_MEMORY_SCOPE_AGENT);
    __syncthreads();
    if (F.tid == 0) { int acc = 0; for (int e = 0; e < 64; ++e) { tpref[e] = acc; acc += (cl[e] + 255) >> 8; } tpref[64] = acc; }
    __syncthreads();
    return __builtin_amdgcn_readfirstlane(tpref[64]);
}
__device__ __forceinline__ void phase_moe4(const Frame& F, const float* Y2, const bf16* Yr, const int* eidx, const int* inv, const float* gain, const float* bias, float* XO, bf16* XBo) {
    const LAS int* tpref = (const LAS int*)(F.lds + LDS_TAB);
    const int gw = F.bid * 8 + F.wave, NGW = F.G * 8, lane = F.lane;
    for (int t = gw; t < T; t += NGW) {
        f32x4 v[8];
#pragma unroll
        for (int j = 0; j < 8; ++j) v[j] = *(const f32x4*)(Y2 + (size_t)t * D + 4 * lane + 256 * j);
        for (int k = 0; k < 8; ++k) { const int e = eidx[t * 8 + k], pos = inv[t * 8 + k]; const bf16* yr = Yr + (size_t)(tpref[e] * 256 + pos) * D + 4 * lane;
#pragma unroll
            for (int j = 0; j < 8; ++j) { const v2u w = *(const v2u*)(yr + 256 * j); v[j][0] += bflo(w.x); v[j][1] += bfhi(w.x); v[j][2] += bflo(w.y); v[j][3] += bfhi(w.y); } }
        float sm = 0.f;
#pragma unroll
        for (int j = 0; j < 8; ++j) sm += (v[j][0] + v[j][1]) + (v[j][2] + v[j][3]);
        const float mean = wave_sum(sm, lane) * (1.0f / D); float sq = 0.f;
#pragma unroll
        for (int j = 0; j < 8; ++j) { v[j] = v[j] - mean; sq += (v[j][0] * v[j][0] + v[j][1] * v[j][1]) + (v[j][2] * v[j][2] + v[j][3] * v[j][3]); }
        const float rstd = 1.0f / sqrtf(wave_sum(sq, lane) * (1.0f / D) + LN_EPS);
#pragma unroll
        for (int j = 0; j < 8; ++j) { const int c = 4 * lane + 256 * j; const f32x4 o = v[j] * rstd * *(const f32x4*)(gain + c) + *(const f32x4*)(bias + c);
            *(f32x4*)(XO + (size_t)t * D + c) = o;
            v2u wb; wb.x = pk2(o[0], o[1]); wb.y = pk2(o[2], o[3]); *(v2u*)(XBo + (size_t)t * D + c) = wb; }
    }
}


constexpr int M1_P = 0, M1N_HIST = 32768, M1N_BASE = 32768 + 256;
__device__ __forceinline__ void phase_moe1n(const Frame& F, const bf16* Y, const float* pst, const float* gain, const float* bias, const bf16* WH, const bf16* WL, const float* RB,
                                            bf16* X1B, float* ST1, unsigned* cnt, int* ltok, float* lgate, int* eidx, int* inv) {
    LAS float* P = (LAS float*)(F.lds + M1_P); LAS int* hist = (LAS int*)(F.lds + M1N_HIST); LAS int* basep = (LAS int*)(F.lds + M1N_BASE);
    const int tid = F.tid, lane = F.lane, w = F.wave, r = lane & 15, q = lane >> 4, pr = w >> 1, kh = w & 1;
    for (int item = F.bid; item < T / 64; item += F.G) {
        const int row0 = item * 64, row = row0 + 16 * pr + r;
        __syncthreads();
        if (tid < 64) hist[tid] = 0;
        float mean, rstd;
        { const f32x4* pp = (const f32x4*)(pst + ((size_t)row * 32 + q * 8) * 2); const f32x4 a = pp[0], b = pp[1], c = pp[2], d = pp[3];
          float sm = (a[0] + a[2]) + (b[0] + b[2]) + (c[0] + c[2]) + (d[0] + d[2]), sq = (a[1] + a[3]) + (b[1] + b[3]) + (c[1] + c[3]) + (d[1] + d[3]);
          sm += shfl_x(sm, 16, lane); sm += shfl_x(sm, 32, lane); sq += shfl_x(sq, 16, lane); sq += shfl_x(sq, 32, lane);
          mean = sm * (1.0f / D); const float var = fmaxf(sq * (1.0f / D) - mean * mean, 0.f); rstd = 1.0f / sqrtf(var + LN_EPS);
          if (kh == 0 && q == 0) *(f32x2*)(ST1 + 2 * row) = (f32x2){mean, rstd}; }
        const bf16* yp = Y + (size_t)row * D + kh * 1024 + 8 * q; const float* gp = gain + kh * 1024 + 8 * q; const float* bp = bias + kh * 1024 + 8 * q;
        const bf16* whp = WH + (size_t)r * D + kh * 1024 + 8 * q; const bf16* wlp = WL + (size_t)r * D + kh * 1024 + 8 * q;
        bf16* xo = X1B + (size_t)row * D + kh * 1024 + 8 * q;
        f32x4 acc[4];
#pragma unroll
        for (int nt = 0; nt < 4; ++nt) acc[nt] = (f32x4){0.f, 0.f, 0.f, 0.f};
#define M1_LOAD(S, st) do { const int _k = 32 * (st); S##yb = *(const v4u*)(yp + _k); S##g0 = *(const f32x4*)(gp + _k); S##g1 = *(const f32x4*)(gp + _k + 4); \
            S##b0 = *(const f32x4*)(bp + _k); S##b1 = *(const f32x4*)(bp + _k + 4); \
            _Pragma("unroll") for (int nt = 0; nt < 4; ++nt) { S##wh[nt] = *(const bf16x8*)(whp + (size_t)nt * 16 * D + _k); S##wl[nt] = *(const bf16x8*)(wlp + (size_t)nt * 16 * D + _k); } } while (0)
#define M1_COMP(S, st) do { const f32x4 S##y0 = (f32x4){bflo(S##yb.x), bfhi(S##yb.x), bflo(S##yb.y), bfhi(S##yb.y)}, S##y1 = (f32x4){bflo(S##yb.z), bfhi(S##yb.z), bflo(S##yb.w), bfhi(S##yb.w)}; \
            const f32x4 x0 = (S##y0 - mean) * rstd * S##g0 + S##b0, x1 = (S##y1 - mean) * rstd * S##g1 + S##b1; \
            v4u h; h.x = cvt_pk_bf16(x0[0], x0[1]); h.y = cvt_pk_bf16(x0[2], x0[3]); h.z = cvt_pk_bf16(x1[0], x1[1]); h.w = cvt_pk_bf16(x1[2], x1[3]); \
            *(v4u*)(xo + 32 * (st)) = h; \
            v4u l; l.x = cvt_pk_bf16(x0[0] - bflo(h.x), x0[1] - bfhi(h.x)); l.y = cvt_pk_bf16(x0[2] - bflo(h.y), x0[3] - bfhi(h.y)); \
            l.z = cvt_pk_bf16(x1[0] - bflo(h.z), x1[1] - bfhi(h.z)); l.w = cvt_pk_bf16(x1[2] - bflo(h.w), x1[3] - bfhi(h.w)); \
            const bf16x8 xh = __builtin_bit_cast(bf16x8, h), xl = __builtin_bit_cast(bf16x8, l); \
            _Pragma("unroll") for (int nt = 0; nt < 4; ++nt) { acc[nt] = __builtin_amdgcn_mfma_f32_16x16x32_bf16(xh, S##wh[nt], acc[nt], 0, 0, 0); \
                acc[nt] = __builtin_amdgcn_mfma_f32_16x16x32_bf16(xl, S##wh[nt], acc[nt], 0, 0, 0); acc[nt] = __builtin_amdgcn_mfma_f32_16x16x32_bf16(xh, S##wl[nt], acc[nt], 0, 0, 0); } } while (0)
        v4u Ayb, Byb; f32x4 Ag0, Ag1, Ab0, Ab1, Bg0, Bg1, Bb0, Bb1; bf16x8 Awh[4], Awl[4], Bwh[4], Bwl[4];
        M1_LOAD(A, 0);
        __builtin_amdgcn_sched_barrier(0);
#pragma unroll 1
        for (int st = 0; st < 32; st += 2) {
            M1_LOAD(B, st + 1);
            __builtin_amdgcn_sched_barrier(0);
            M1_COMP(A, st);
            __builtin_amdgcn_sched_barrier(0);
            if (st + 2 < 32) M1_LOAD(A, st + 2);
            __builtin_amdgcn_sched_barrier(0);
            M1_COMP(B, st + 1);
            __builtin_amdgcn_sched_barrier(0);
        }
#undef M1_LOAD
#undef M1_COMP
#pragma unroll
        for (int nt = 0; nt < 4; ++nt)
#pragma unroll
            for (int i = 0; i < 4; ++i) P[(kh * 64 + 16 * pr + 4 * q + i) * 64 + 16 * nt + r] = acc[nt][i];
        __syncthreads();
        int sel_pos[8]; float sel_gate[8]; int sel_rank[8]; bool sel_on[8];
        const float rb = RB[lane];
#pragma unroll
        for (int rr = 0; rr < 8; ++rr) { const int rl = 8 * w + rr;
            float lg = P[rl * 64 + lane] + P[(64 + rl) * 64 + lane]; lg = (lg == lg) ? lg : -1.0e30f;
            const float sc = 1.0f / (1.0f + __expf(-lg)); const float ch = sc + rb;
            int rk = 0;
#pragma unroll
            for (int j = 0; j < 8; ++j) { const float cj = shfl_from(ch, (lane & ~7) + j); rk += (cj > ch || (cj == ch && j < (lane & 7))) ? 1 : 0; }
            float gs = rk < 2 ? ch : 0.f; gs += shfl_x(gs, 1, lane); gs += shfl_x(gs, 2, lane); gs += shfl_x(gs, 4, lane);
            int grk = 0; const int g = lane >> 3;
#pragma unroll
            for (int hh = 0; hh < 8; ++hh) { const float gh = shfl_from(gs, 8 * hh); grk += (gh > gs || (gh == gs && hh < g)) ? 1 : 0; }
            const float msk = grk < 4 ? ch : -INFINITY;
            int erk = 0;
            for (int j = 0; j < 64; ++j) { const float mj = __builtin_bit_cast(float, __builtin_amdgcn_readlane(__builtin_bit_cast(int, msk), j)); erk += (mj > msk || (mj == msk && j < lane)) ? 1 : 0; }
            const bool on = erk < 8;
            const float ssum = wave_sum(on ? sc : 0.f, lane);
            sel_on[rr] = on; sel_rank[rr] = erk; sel_gate[rr] = sc / ssum * 2.5f; sel_pos[rr] = 0;
            if (on) sel_pos[rr] = __hip_atomic_fetch_add(&hist[lane], 1, __ATOMIC_RELAXED, __HIP_MEMORY_SCOPE_WORKGROUP); }
        __syncthreads();
        if (tid < 64) { const int hc = hist[tid]; int bs = 0; if (hc > 0) bs = (int)atomicAdd(&cnt[tid * 16], (unsigned)hc); basep[tid] = bs; }
        __syncthreads();
#pragma unroll
        for (int rr = 0; rr < 8; ++rr) if (sel_on[rr]) { const int t = row0 + 8 * w + rr, pos = basep[lane] + sel_pos[rr];
            ltok[(size_t)lane * CAP + pos] = t * 8 + sel_rank[rr]; lgate[(size_t)lane * CAP + pos] = sel_gate[rr];
            eidx[t * 8 + sel_rank[rr]] = lane; inv[t * 8 + sel_rank[rr]] = pos; }
    }
}

constexpr int M3_PL = 131072, M3_CNT = 147456, M3_OFF = 147456 + 272;
__device__ __forceinline__ void phase_moe3n(const Frame& F, const bf16* H, const bf16* HSp, const int* eidx, const bf16* WD, const bf16* WSD,
                                            const float* Y1, const float* ST1, const float* g1, const float* b1, float* Y2, float* PST2) {
    LAS int* out = (LAS int*)F.lds; LAS unsigned short* plist = (LAS unsigned short*)(F.lds + M3_PL); LAS int* cnt = (LAS int*)(F.lds + M3_CNT); LAS int* off = (LAS int*)(F.lds + M3_OFF);
    const int tid = F.tid, lane = F.lane, w = F.wave, r = lane & 15, q = lane >> 4;
    for (int u = F.bid; u < 1024; u += F.G) {
        int nc = (u & 7) | ((u >> 7) << 3), tb = (u >> 3) & 15;
        if (F.G == 256) { const int i = u >> 8, x = u & 7, j = (u >> 3) & 31; tb = 2 * x + (i >> 1); nc = 32 * (i & 1) + j; }
        __syncthreads();
#pragma unroll
        for (int j = 0; j < 16; ++j) ((LAS v4u*)out)[tid + 512 * j] = (v4u){0u, 0u, 0u, 0u};
        if (tid < 66) cnt[tid] = 0;
        __syncthreads();
        int ee[16], pp[16];
        { const v4u* ep = (const v4u*)(eidx + ((size_t)tb * 1024 + 2 * tid) * 8); const v4u e0 = ep[0], e1 = ep[1], e2 = ep[2], e3 = ep[3];
          ee[0] = e0.x; ee[1] = e0.y; ee[2] = e0.z; ee[3] = e0.w; ee[4] = e1.x; ee[5] = e1.y; ee[6] = e1.z; ee[7] = e1.w;
          ee[8] = e2.x; ee[9] = e2.y; ee[10] = e2.z; ee[11] = e2.w; ee[12] = e3.x; ee[13] = e3.y; ee[14] = e3.z; ee[15] = e3.w; }
#pragma unroll
        for (int j = 0; j < 16; ++j) pp[j] = __hip_atomic_fetch_add(&cnt[ee[j]], 1, __ATOMIC_RELAXED, __HIP_MEMORY_SCOPE_WORKGROUP);
        __syncthreads();
        if (w == 0) { int c = cnt[lane], x = c;
#pragma unroll
            for (int o = 1; o < 64; o <<= 1) { const int y = __builtin_amdgcn_ds_bpermute(((lane - o) & 63) << 2, x); if (lane >= o) x += y; }
            off[lane] = x - c; if (lane == 63) off[64] = x; }
        __syncthreads();
#pragma unroll
        for (int j = 0; j < 16; ++j) plist[off[ee[j]] + pp[j]] = (unsigned short)(tid * 16 + j);
        __syncthreads();
        const char* Hb = (const char*)H + (size_t)tb * 8192 * 256 + q * 16;
        const char* HSb = (const char*)HSp + (size_t)tb * 1024 * 512 + q * 16;
        const char* Bb = (const char*)WD + ((size_t)nc * 32 + r) * 256 + q * 16;
        const char* BSb = (const char*)WSD + ((size_t)nc * 32 + r) * 512 + q * 16;
#define M3_NR(sg) ((sg) < 8 ? __builtin_amdgcn_readfirstlane(cnt[w + 8 * (sg)]) : 128)
#define M3_RB(sg) ((sg) < 8 ? __builtin_amdgcn_readfirstlane(off[w + 8 * (sg)]) : 0)
#define M3_GLD(dst, ptr, OFF) asm volatile("global_load_dwordx4 %0, %1, off offset:" #OFF : "=&v"(dst) : "v"(ptr) : "memory")
#define M3_LOADB(dst, sg) do { const char* _b0 = (sg) < 8 ? Bb + (size_t)(w + 8 * (sg)) * 524288 : BSb + ((sg) - 8) * 256; const char* _b1 = _b0 + ((sg) < 8 ? 4096 : 8192); \
            M3_GLD(dst[0][0], _b0, 0); M3_GLD(dst[0][1], _b0, 64); M3_GLD(dst[0][2], _b0, 128); M3_GLD(dst[0][3], _b0, 192); \
            M3_GLD(dst[1][0], _b1, 0); M3_GLD(dst[1][1], _b1, 64); M3_GLD(dst[1][2], _b1, 128); M3_GLD(dst[1][3], _b1, 192); } while (0)
#define M3_LOADA(dst, sg, bb, nr, rbs) do { int _i = 16 * (bb) + r; _i = _i < (nr) ? _i : (nr) - 1; const unsigned _rid = plist[(rbs) + _i]; \
            const char* _a = (sg) < 8 ? Hb + (size_t)_rid * 256 : ((sg) < 10 ? HSb + (size_t)(128 * w + _i) * 512 + ((sg) - 8) * 256 : Hb); \
            M3_GLD(dst[0], _a, 0); M3_GLD(dst[1], _a, 64); M3_GLD(dst[2], _a, 128); M3_GLD(dst[3], _a, 192); } while (0)
#define M3_ADV(sg, bb, nr, rbs) do { if ((sg) < 10) { ++(bb); if ((bb) * 16 >= (nr)) { (bb) = 0; do { ++(sg); } while ((sg) < 8 && M3_NR(sg) == 0); if ((sg) < 10) { (nr) = M3_NR(sg); (rbs) = M3_RB(sg); } } } } while (0)
#define M3_WAITA(AS) asm volatile("s_waitcnt vmcnt(12)" : "+v"(AS[0]), "+v"(AS[1]), "+v"(AS[2]), "+v"(AS[3]) :: "memory")
#define M3_WAITB(N) asm volatile("s_waitcnt vmcnt(" #N ")" : "+v"(Bn[0][0]), "+v"(Bn[0][1]), "+v"(Bn[0][2]), "+v"(Bn[0][3]), "+v"(Bn[1][0]), "+v"(Bn[1][1]), "+v"(Bn[1][2]), "+v"(Bn[1][3]) :: "memory")
#define M3_STEP(AS) if (cseg < 10) { \
              \
            int tk[4]; bool ok[4]; unsigned pl[4]; const int rt_ = cseg < 8; \
            _Pragma("unroll") for (int i = 0; i < 4; ++i) { const int idx = 16 * cbt + 4 * q + i; ok[i] = idx < cnr; const int ic = ok[i] ? idx : cnr - 1; pl[i] = plist[crbs + ic]; tk[i] = 128 * w + ic; } \
            _Pragma("unroll") for (int i = 0; i < 4; ++i) tk[i] = rt_ ? (int)(pl[i] >> 3) : tk[i]; \
            M3_WAITA(AS); \
            f32x4 acc[2]; \
            _Pragma("unroll") for (int nt = 0; nt < 2; ++nt) { acc[nt] = (f32x4){0.f, 0.f, 0.f, 0.f}; \
                _Pragma("unroll") for (int kk = 0; kk < 4; ++kk) acc[nt] = __builtin_amdgcn_mfma_f32_16x16x32_bf16(__builtin_bit_cast(bf16x8, AS[kk]), __builtin_bit_cast(bf16x8, Bc[nt][kk]), acc[nt], 0, 0, 0); } \
              \
            _Pragma("unroll") for (int i = 0; i < 4; ++i) { const long long lo_ = ok[i] ? (long long)__float2int_rn(acc[0][i] * 4194304.0f) : 0ll, hi_ = ok[i] ? (long long)__float2int_rn(acc[1][i] * 4194304.0f) : 0ll; \
                (void)__hip_atomic_fetch_add((LAS unsigned long long*)out + tk[i] * 16 + r, (unsigned long long)((hi_ << 32) + lo_), __ATOMIC_RELAXED, __HIP_MEMORY_SCOPE_WORKGROUP); } \
            M3_LOADA(AS, pseg, pbt, pnr, prbs); M3_ADV(pseg, pbt, pnr, prbs); \
            { const int old_ = cseg, nbat_ = (cnr + 15) >> 4; M3_ADV(cseg, cbt, cnr, crbs); \
              if (cseg != old_ && cseg < 10) { \
                  if (nbat_ == 1) M3_WAITB(4); else if (nbat_ == 2) M3_WAITB(8); else if (nbat_ == 3) M3_WAITB(12); else M3_WAITB(16); \
                  _Pragma("unroll") for (int nt = 0; nt < 2; ++nt) _Pragma("unroll") for (int kk = 0; kk < 4; ++kk) Bc[nt][kk] = Bn[nt][kk]; \
                  int nb_ = cseg; do { ++nb_; } while (nb_ < 8 && M3_NR(nb_) == 0); if (nb_ >= 10) nb_ = 9; M3_LOADB(Bn, nb_); } } }
        int cseg = -1, cbt = 0, cnr = 0, crbs = 0;
        do { ++cseg; } while (cseg < 8 && M3_NR(cseg) == 0);
        cnr = M3_NR(cseg); crbs = M3_RB(cseg);
        int pseg = cseg, pbt = 0, pnr = cnr, prbs = crbs;
        v4u Bc[2][4], Bn[2][4], A0[4], A1[4], A2[4], A3[4];
        M3_LOADB(Bc, cseg);
        M3_LOADA(A0, pseg, pbt, pnr, prbs); M3_ADV(pseg, pbt, pnr, prbs);
        M3_LOADA(A1, pseg, pbt, pnr, prbs); M3_ADV(pseg, pbt, pnr, prbs);
        M3_LOADA(A2, pseg, pbt, pnr, prbs); M3_ADV(pseg, pbt, pnr, prbs);
        M3_LOADA(A3, pseg, pbt, pnr, prbs); M3_ADV(pseg, pbt, pnr, prbs);
        { int nb_ = cseg; do { ++nb_; } while (nb_ < 8 && M3_NR(nb_) == 0); if (nb_ >= 10) nb_ = 9; M3_LOADB(Bn, nb_); }
        asm volatile("s_waitcnt vmcnt(0)" : "+v"(Bc[0][0]), "+v"(Bc[0][1]), "+v"(Bc[0][2]), "+v"(Bc[0][3]), "+v"(Bc[1][0]), "+v"(Bc[1][1]), "+v"(Bc[1][2]), "+v"(Bc[1][3]) :: "memory");
#pragma unroll 1
        while (cseg < 10) { M3_STEP(A0) M3_STEP(A1) M3_STEP(A2) M3_STEP(A3) }
        asm volatile("s_waitcnt vmcnt(0)" : "+v"(A0[0]), "+v"(A0[1]), "+v"(A0[2]), "+v"(A0[3]), "+v"(A1[0]), "+v"(A1[1]), "+v"(A1[2]), "+v"(A1[3]), "+v"(A2[0]), "+v"(A2[1]), "+v"(A2[2]), "+v"(A2[3]),
                     "+v"(A3[0]), "+v"(A3[1]), "+v"(A3[2]), "+v"(A3[3]), "+v"(Bn[0][0]), "+v"(Bn[0][1]), "+v"(Bn[0][2]), "+v"(Bn[0][3]), "+v"(Bn[1][0]), "+v"(Bn[1][1]), "+v"(Bn[1][2]), "+v"(Bn[1][3]) :: "memory");
#undef M3_NR
#undef M3_RB
#undef M3_GLD
#undef M3_LOADB
#undef M3_LOADA
#undef M3_ADV
#undef M3_WAITA
#undef M3_WAITB
#undef M3_STEP
        __syncthreads();
        { const int c4 = lane & 7, rs = lane >> 3, col = nc * 32 + 4 * c4;
          const f32x4 gv = *(const f32x4*)(g1 + col), bv = *(const f32x4*)(b1 + col);
#pragma unroll 4
          for (int it = 0; it < 16; ++it) { const int rl = 128 * w + 8 * it + rs; const size_t row = (size_t)tb * 1024 + rl;
              const f32x4 yv = *(const f32x4*)(Y1 + row * D + col); const f32x2 sv = *(const f32x2*)(ST1 + 2 * row);
              f32x4 tv; { const int nt = c4 >> 2, r0 = (4 * c4) & 15;
#pragma unroll
                  for (int j = 0; j < 4; ++j) { const v2u cell = *(const LAS v2u*)(out + rl * 32 + 2 * (r0 + j)); const int lo = (int)cell.x, hi = (int)cell.y + (lo < 0 ? 1 : 0); tv[j] = (float)(nt ? hi : lo) * (1.0f / 4194304.0f); } }
              const f32x4 y = ((yv - sv.x) * sv.y * gv + bv) * ALPHA + tv;
              *(f32x4*)(Y2 + row * D + col) = y;
              float sm = (y[0] + y[1]) + (y[2] + y[3]), sq = (y[0] * y[0] + y[1] * y[1]) + (y[2] * y[2] + y[3] * y[3]);
#pragma unroll
              for (int o = 1; o < 8; o <<= 1) { sm += shfl_x(sm, o, lane); sq += shfl_x(sq, o, lane); }
              if (c4 == 0) *(f32x2*)(PST2 + (row * 64 + nc) * 2) = (f32x2){sm, sq}; } }
    }
}

__device__ __forceinline__ void phase_moe4n(const Frame& F, const float* Y2, const float* pst, const float* gain, const float* bias, float* ST2, bf16* XBo, float* OUT, int last) {
    const int gw = F.bid * 8 + F.wave, NGW = F.G * 8, lane = F.lane;
    for (int t = gw; t < T; t += NGW) {
        f32x4 v[8];
#pragma unroll
        for (int j = 0; j < 8; ++j) v[j] = *(const f32x4*)(Y2 + (size_t)t * D + 4 * lane + 256 * j);
        const f32x2 pv = *(const f32x2*)(pst + ((size_t)t * 64 + lane) * 2);
        const float mean = wave_sum(pv.x, lane) * (1.0f / D); const float var = fmaxf(wave_sum(pv.y, lane) * (1.0f / D) - mean * mean, 0.f); const float rstd = 1.0f / sqrtf(var + LN_EPS);
        if (lane == 0) *(f32x2*)(ST2 + 2 * (size_t)t) = (f32x2){mean, rstd};
#pragma unroll
        for (int j = 0; j < 8; ++j) { const int c = 4 * lane + 256 * j; const f32x4 o = (v[j] - mean) * rstd * *(const f32x4*)(gain + c) + *(const f32x4*)(bias + c);
            if (last) *(f32x4*)(OUT + (size_t)t * D + c) = o;
            else { v2u wb; wb.x = pk2(o[0], o[1]); wb.y = pk2(o[2], o[3]); *(v2u*)(XBo + (size_t)t * D + c) = wb; } }
    }
}


__device__ __forceinline__ void phase_moe4g(const Frame& F, bf16* Y2, const bf16* Yr, const int* eidx, const int* inv, const float* gain, const float* bias, float* ST2, bf16* XBo, float* OUT, int last) {
    const LAS int* tpref = (const LAS int*)(F.lds + LDS_TAB);
    const int gw = F.bid * 8 + F.wave, NGW = F.G * 8, lane = F.lane;
    for (int t = gw; t < T; t += NGW) {
        int rowi = 0; if (lane < 8) { const int e = eidx[t * 8 + lane], ps = inv[t * 8 + lane]; rowi = tpref[e] * 256 + ps; }
        const bf16* rp[8];
#pragma unroll
        for (int k = 0; k < 8; ++k) rp[k] = Yr + (size_t)__builtin_amdgcn_readlane(rowi, k) * D + 4 * lane;
        f32x4 v[8]; v2u yv[8][8];
#pragma unroll
        for (int j = 0; j < 8; ++j) { const v2u pv = *(const v2u*)(Y2 + (size_t)t * D + 4 * lane + 256 * j); v[j] = (f32x4){bflo(pv.x), bfhi(pv.x), bflo(pv.y), bfhi(pv.y)}; }
#pragma unroll
        for (int k = 0; k < 8; ++k)
#pragma unroll
            for (int j = 0; j < 8; ++j) yv[k][j] = *(const v2u*)(rp[k] + 256 * j);
#pragma unroll
        for (int k = 0; k < 8; ++k) asm volatile("" : "+v"(yv[k][0]), "+v"(yv[k][1]), "+v"(yv[k][2]), "+v"(yv[k][3]), "+v"(yv[k][4]), "+v"(yv[k][5]), "+v"(yv[k][6]), "+v"(yv[k][7]));
#pragma unroll
        for (int k = 0; k < 8; ++k)
#pragma unroll
            for (int j = 0; j < 8; ++j) { v[j][0] += bflo(yv[k][j].x); v[j][1] += bfhi(yv[k][j].x); v[j][2] += bflo(yv[k][j].y); v[j][3] += bfhi(yv[k][j].y); }
        float sm = 0.f;
#pragma unroll
        for (int j = 0; j < 8; ++j) sm += (v[j][0] + v[j][1]) + (v[j][2] + v[j][3]);
        const float mean = wave_sum(sm, lane) * (1.0f / D); float sq = 0.f;
#pragma unroll
        for (int j = 0; j < 8; ++j) { const f32x4 d = v[j] - mean; sq += (d[0] * d[0] + d[1] * d[1]) + (d[2] * d[2] + d[3] * d[3]); }
        const float rstd = 1.0f / sqrtf(wave_sum(sq, lane) * (1.0f / D) + LN_EPS);
        if (lane == 0) *(f32x2*)(ST2 + 2 * (size_t)t) = (f32x2){mean, rstd};
#pragma unroll
        for (int j = 0; j < 8; ++j) { const int c = 4 * lane + 256 * j;
            if (!last) { v2u yw; yw.x = pk2(v[j][0], v[j][1]); yw.y = pk2(v[j][2], v[j][3]); *(v2u*)(Y2 + (size_t)t * D + c) = yw; }
            const f32x4 o = (v[j] - mean) * rstd * *(const f32x4*)(gain + c) + *(const f32x4*)(bias + c);
            if (last) *(f32x4*)(OUT + (size_t)t * D + c) = o;
            else { v2u wb; wb.x = pk2(o[0], o[1]); wb.y = pk2(o[2], o[3]); *(v2u*)(XBo + (size_t)t * D + c) = wb; } }
    }
}


__device__ __forceinline__ void phase_downproj3(const Frame& F, const bf16* H, const bf16* WD, bf16* Y, int NT) {
    const LAS int* tpref = (const LAS int*)(F.lds + LDS_TAB); const LAS int* cl = (const LAS int*)(F.lds + LDS_TAB + 512);
    LAS unsigned char* lds = F.lds;
    const int tid = F.tid, lane = F.lane, w = F.wave, fr = lane & 15, fq = lane >> 4;
    unsigned voffB[2];
#pragma unroll
    for (int i = 0; i < 2; ++i) { int R_, C_; g8::stage_rc(tid * 16 + i * 8192, R_, C_); const int Rb = (R_ & ~31) + g8::perm32(R_ & 31); voffB[i] = (unsigned)(Rb * EDIM + C_) * 2u; }
    const unsigned ldsw = (unsigned)w * 1024u, lbase = (unsigned)(size_t)lds;
    int boffg[4];
#pragma unroll
    for (int g = 0; g < 4; ++g) boffg[g] = g8::lds_byte(32 * g + fr, fq * 8);
    LAS unsigned char* stg = lds + (w < 7 ? 65536 + w * (32 * 272) : 140288);
    const int NU = NT * 4;
    int u = F.bid; if (u >= NU) return;
#define DP3_UNITINFO(uu, EXP, NV) do { const int tl_ = (uu) >> 2; int e_ = 0; while (__builtin_amdgcn_readfirstlane(tpref[e_ + 1]) <= tl_) ++e_; EXP = e_; \
        NV = __builtin_amdgcn_readfirstlane(cl[e_]) - (tl_ - __builtin_amdgcn_readfirstlane(tpref[e_])) * 256; } while (0)
#define DP3_GLDS(gsrc, ldsdst) do { unsigned keep_; asm volatile("s_mov_b32 %0, m0\n\ts_mov_b32 m0, %2\n\ts_nop 0\n\tglobal_load_lds_dwordx4 %1, off\n\ts_mov_b32 m0, %0" : "=&s"(keep_) : "v"(gsrc), "s"(ldsdst) : "memory"); } while (0)
#define DP3_STAGE(slot, gb) do { _Pragma("unroll") for (int kt = 0; kt < 2; ++kt) { \
        DP3_GLDS((const void*)((gb) + kt * 128 + voffB[0]), lbase + (unsigned)((slot) * 32768 + kt * 16384) + ldsw); \
        DP3_GLDS((const void*)((gb) + kt * 128 + voffB[1]), lbase + (unsigned)((slot) * 32768 + kt * 16384) + ldsw + 8192u); } } while (0)
#define DP3_LOADA(dst, uu) do { const bf16* ap_ = H + (size_t)(((uu) >> 2) * 256 + 32 * w + fr) * EDIM + 8 * fq; \
        _Pragma("unroll") for (int m = 0; m < 2; ++m) _Pragma("unroll") for (int kk = 0; kk < 4; ++kk) dst[m][kk] = *(const bf16x8*)(ap_ + (size_t)m * 16 * EDIM + 32 * kk); } while (0)
    int ecur, nvcur; DP3_UNITINFO(u, ecur, nvcur);
    bf16x8 A[2][4], An[2][4];
    DP3_LOADA(A, u);
    { const char* gb = (const char*)(WD + (size_t)ecur * D * EDIM + (size_t)((u & 3) * 512) * EDIM); DP3_STAGE(0, gb); }
    asm volatile("s_waitcnt vmcnt(0)" ::: "memory");
#pragma unroll 1
    for (;;) {
        const int un = (u + F.G < NU) ? u + F.G : u; int enx, nvnx; DP3_UNITINFO(un, enx, nvnx);
        const char* gbc = (const char*)(WD + (size_t)ecur * D * EDIM + (size_t)((u & 3) * 512) * EDIM);
        const char* gbn = (const char*)(WD + (size_t)enx * D * EDIM + (size_t)((un & 3) * 512) * EDIM);
        const int tile = u >> 2, colu = (u & 3) * 512;
#pragma unroll
        for (int c = 0; c < 4; ++c) {
            asm volatile("s_waitcnt vmcnt(8)" ::: "memory");
            __builtin_amdgcn_s_barrier();
            if (c == 3) { const bf16* ap_ = H + (size_t)((un >> 2) * 256 + 32 * w + fr) * EDIM + 8 * fq;
#pragma unroll
                for (int m = 0; m < 2; ++m) { const bf16* am_ = ap_ + (size_t)m * 16 * EDIM;
                    asm volatile("global_load_dwordx4 %0, %1, off" : "=&v"(An[m][0]) : "v"(am_) : "memory"); asm volatile("global_load_dwordx4 %0, %1, off offset:64" : "=&v"(An[m][1]) : "v"(am_) : "memory");
                    asm volatile("global_load_dwordx4 %0, %1, off offset:128" : "=&v"(An[m][2]) : "v"(am_) : "memory"); asm volatile("global_load_dwordx4 %0, %1, off offset:192" : "=&v"(An[m][3]) : "v"(am_) : "memory"); } }
            { const char* gnext = (c < 3) ? gbc + (size_t)(c + 1) * 128 * EDIM * 2 : gbn; DP3_STAGE((c + 1) & 1, gnext); }
            __builtin_amdgcn_sched_barrier(0);
            f32x4 acc[2][4][2];
#pragma unroll
            for (int g = 0; g < 4; ++g) { bf16x8 Bf[2][4];
#pragma unroll
                for (int n = 0; n < 2; ++n)
#pragma unroll
                    for (int kk = 0; kk < 4; ++kk) Bf[n][kk] = *(const LAS bf16x8*)(lds + (c & 1) * 32768 + (kk >> 1) * 16384 + boffg[g] + n * 2048 + (kk & 1) * 1024);
#pragma unroll
                for (int m = 0; m < 2; ++m)
#pragma unroll
                    for (int n = 0; n < 2; ++n) { acc[m][g][n] = (f32x4){0.f, 0.f, 0.f, 0.f};
#pragma unroll
                        for (int kk = 0; kk < 4; ++kk) acc[m][g][n] = __builtin_amdgcn_mfma_f32_16x16x32_bf16(Bf[n][kk], A[m][kk], acc[m][g][n], 0, 0, 0); } }
#pragma unroll
            for (int m = 0; m < 2; ++m)
#pragma unroll
                for (int g = 0; g < 4; ++g) { v4u o; o.x = cvt_pk_bf16(acc[m][g][0][0], acc[m][g][0][1]); o.y = cvt_pk_bf16(acc[m][g][0][2], acc[m][g][0][3]); o.z = cvt_pk_bf16(acc[m][g][1][0], acc[m][g][1][1]); o.w = cvt_pk_bf16(acc[m][g][1][2], acc[m][g][1][3]);
                    *(LAS v4u*)(stg + (16 * m + fr) * 272 + (4 * g + fq) * 16) = o; }
#pragma unroll
            for (int it = 0; it < 8; ++it) { const int rr = 4 * it + (lane >> 4), rl = 32 * w + rr;
                const v4u o = *(const LAS v4u*)(stg + rr * 272 + (lane & 15) * 16);
                v4u* dst = (v4u*)(Y + (size_t)(tile * 256 + rl) * D + colu + 128 * c + 8 * (lane & 15));
                if (rl < nvcur) *dst = o; else *dst = o; }
            __builtin_amdgcn_sched_barrier(0);
        }
        asm volatile("s_waitcnt vmcnt(12)" : "+v"(An[0][0]), "+v"(An[0][1]), "+v"(An[0][2]), "+v"(An[0][3]), "+v"(An[1][0]), "+v"(An[1][1]), "+v"(An[1][2]), "+v"(An[1][3]) :: "memory");
        if (un == u) break;
#pragma unroll
        for (int m = 0; m < 2; ++m)
#pragma unroll
            for (int kk = 0; kk < 4; ++kk) A[m][kk] = An[m][kk];
        u = un; ecur = enx; nvcur = nvnx;
    }
    asm volatile("s_waitcnt vmcnt(0)" ::: "memory");
#undef DP3_UNITINFO
#undef DP3_STAGE
#undef DP3_GLDS
#undef DP3_LOADA
}

enum { PH_PRO = 0, PH_POOL_G1, PH_POOL_P, PH_POOL_G2, PH_POOL_G3, PH_DIL_G1, PH_DIL_ATT, PH_DIL_CMB, PH_DIL_G2, PH_CONV_G1, PH_CONV_E, PH_CONV_G2, PH_MOE1, PH_MOE2, PH_MOE3, PH_MOE4, PH_COUNT };

template <int PH>
__device__ __forceinline__ void run_phase(const Frame& Fin, const Args& args_, const int L) {
    Frame F = Fin; { int w_ = Fin.wave, l_; asm volatile("" : "+s"(w_)); asm volatile("v_mbcnt_lo_u32_b32 %0, -1, 0\n\tv_mbcnt_hi_u32_b32 %0, -1, %0" : "=v"(l_)); F.wave = w_; F.lane = l_; F.tid = w_ * 64 + l_; }
    unsigned char* ws; { GAS unsigned char* wsg = (GAS unsigned char*)Fin.ws; asm volatile("" : "+s"(wsg)); ws = (unsigned char*)wsg; } F.ws = ws; F.ctl = (unsigned*)(ws + WS_CTL);
    KP kp = (KP)__builtin_amdgcn_kernarg_segment_ptr(); asm volatile("" : "+s"(kp)); (void)args_;
    { unsigned l_ = (unsigned)(size_t)Fin.lds; asm volatile("" : "+s"(l_)); F.lds = (LAS unsigned char*)(size_t)l_; }
    LAS unsigned char* ring = F.lds; int c = (int)blockIdx.x; { int g_ = Fin.G; asm volatile("" : "+s"(c), "+s"(g_)); F.G = g_; F.bid = c; }
    const float* xres = ain(kp, IN_X); const bf16* xresb = (const bf16*)(ws + WS_Y2F);
    const float* st2 = (const float*)(ws + WS_ST2); float* pstp = (float*)(ws + WS_PST);
    const float* g2p = ain(kp, IN_LNG) + (size_t)((L > 0 ? L - 1 : 0) * 2 + 1) * D; const float* b2p = ain(kp, IN_LNB) + (size_t)((L > 0 ? L - 1 : 0) * 2 + 1) * D;
    const bf16* xb = (const bf16*)(ws + WS_XB);
    bf16* yf = (bf16*)(ws + WS_YF);
    unsigned char* big = ws + WS_BIG;
    const int ia = L / 3;
    if constexpr (PH == PH_PRO) { phase_prologue(F, kp); }
    if constexpr (PH == PH_POOL_G1) { g8::DenseSched S; S.init(xb, (const bf16*)(ws + WS_W_POOL_IN) + (size_t)ia * D * D, T, D, D, D, F.G, c);
        g8::EpiBf16 E{(bf16*)(big + BG_U), D, 0}; g8::gemm_phase<g8::EpiBf16, g8::DenseSched, false>(ring, F.tid, D, D, D, S, E); }
    if constexpr (PH == PH_POOL_P) { phase_pool(F, (const bf16*)(big + BG_U), (bf16*)(big + BG_PL)); }
    if constexpr (PH == PH_POOL_G2) { g8::DenseSched S; S.init((const bf16*)(big + BG_PL), (const bf16*)(ws + WS_W_POOL_G) + (size_t)ia * D * 512, T, D, D, 512, F.G, c); S.agrp_shift = 1; S.agrp_stride = 512 * 2;
        g8::EpiScaleBf16 E{(bf16*)(big + BG_MX), D, ain(kp, IN_PSC) + (size_t)ia * D}; g8::gemm_phase<g8::EpiScaleBf16, g8::DenseSched, false>(ring, F.tid, 512, D, 512, S, E); }
    if constexpr (PH == PH_POOL_G3) { g8::DenseSched S; S.init((const bf16*)(big + BG_MX), (const bf16*)(ws + WS_W_POOL_OUT) + (size_t)ia * D * D, T, D, D, D, F.G, c);
        g8::EpiResidLN E{xres, xresb, st2, g2p, b2p, yf, pstp, L > 0}; g8::gemm_phase<g8::EpiResidLN, g8::DenseSched, false>(ring, F.tid, D, D, D, S, E); }
    if constexpr (PH == PH_DIL_G1) { g8::DenseSched S; S.init(xb, (const bf16*)(ws + WS_W_DIL_QKV), T, QKVC, D, D, F.G, c);
        g8::EpiBf16 E{(bf16*)(big + BG_QKV), QKVC, 1}; g8::gemm_phase<g8::EpiBf16, g8::DenseSched, false>(ring, F.tid, D, D, D, S, E); }
    if constexpr (PH == PH_DIL_ATT) { phase_attn(F, (const bf16*)(big + BG_QKV), ain(kp, IN_RELB), (bf16*)(big + BG_OG), (float*)(big + BG_LSE)); }
    if constexpr (PH == PH_DIL_CMB) { phase_combine(F, (const bf16*)(big + BG_OG), (const float*)(big + BG_LSE), (bf16*)(big + BG_O)); }
    if constexpr (PH == PH_DIL_G2) { g8::DenseSched S; S.init((const bf16*)(big + BG_O), (const bf16*)(ws + WS_W_DIL_OUT), T, D, DILW, DILW, F.G, c);
        g8::EpiResidLN E{xres, xresb, st2, g2p, b2p, yf, pstp, L > 0}; g8::gemm_phase<g8::EpiResidLN, g8::DenseSched, false>(ring, F.tid, DILW, DILW, DILW, S, E); }
    if constexpr (PH == PH_CONV_G1) { g8::DenseSched S; S.init(xb, (const bf16*)(ws + WS_W_CONV_IN), T, 3 * D, D, D, F.G, c);
        g8::EpiConvIn E{(bf16*)(big + BG_UC), (bf16*)(big + BG_BG)}; g8::gemm_phase<g8::EpiConvIn, g8::DenseSched, false>(ring, F.tid, D, D, D, S, E); }
    if constexpr (PH == PH_CONV_E) { phase_conv(F, (const bf16*)(big + BG_UC), (const bf16*)(big + BG_BG), ain(kp, IN_CW), (bf16*)(big + BG_Z)); }
    if constexpr (PH == PH_CONV_G2) { g8::DenseSched S; S.init((const bf16*)(big + BG_Z), (const bf16*)(ws + WS_W_CONV_OUT), T, D, D, D, F.G, c);
        g8::EpiResidLN E{xres, xresb, st2, g2p, b2p, yf, pstp, L > 0}; g8::gemm_phase<g8::EpiResidLN, g8::DenseSched, false>(ring, F.tid, D, D, D, S, E); }
    unsigned* cnt = F.ctl + CW_CNT + L * 64 * 16;
    float* x1f = (float*)(ws + WS_X1F); bf16* x1b = (bf16*)(ws + WS_X1B);
    int* ltok = (int*)(ws + WS_LTOK); float* lgate = (float*)(ws + WS_LGATE); int* eidx = (int*)(ws + WS_EIDX); int* inv = (int*)(ws + WS_INV);
    bf16* HB = (bf16*)(ws + WS_HB); bf16* HS = (bf16*)(ws + WS_HS); bf16* Yr = (bf16*)(ws + WS_BIG);
    if constexpr (PH == PH_MOE1) {
        const float* g1 = ain(kp, IN_LNG) + (size_t)(L * 2 + 0) * D; const float* b1 = ain(kp, IN_LNB) + (size_t)(L * 2 + 0) * D;
        phase_moe1n(F, yf, pstp, g1, b1, (const bf16*)(ws + WS_RWH) + (size_t)L * NEXP * D, (const bf16*)(ws + WS_RWL) + (size_t)L * NEXP * D, ain(kp, IN_RB) + (size_t)L * NEXP,
                    x1b, (float*)(ws + WS_ST1), cnt, ltok, lgate, eidx, inv); }
    if constexpr (PH == PH_MOE2) {
        const int NT = build_tiles(F, cnt);
        { g8::ExpertSched<1, true> S; S.tpref = (const LAS int*)(F.lds + LDS_TAB); S.cnt = (const LAS int*)(F.lds + LDS_TAB + 512); S.A = (const char*)x1b; S.B = (const char*)((const bf16*)(ws + WS_W_EX_GU) + (size_t)L * 64 * 256 * D);
          S.tok = ltok; S.b_exp = (size_t)256 * D * 2; S.b_tile = 0; S.a_tile = 0; S.NU = NT; S.G = F.G; S.c = c;
          g8::EpiExpertGU E{HB}; g8::gemm_phase<g8::EpiExpertGU, g8::ExpertSched<1, true>, true>(ring, F.tid, D, D, D, S, E); }
        { const int rot = (c - (NT % F.G) + F.G) % F.G;
          g8::DenseSched S; S.init(x1b, (const bf16*)(ws + WS_W_SH_GU) + (size_t)L * 512 * D, T, 512, D, D, F.G, rot);
          int t2 = F.tid; asm volatile("" : "+v"(t2));
          g8::EpiSharedGU E{HS}; g8::gemm_phase<g8::EpiSharedGU, g8::DenseSched, false>(ring, t2, D, D, D, S, E); } }
    if constexpr (PH == PH_MOE3) {
        const float* g1 = ain(kp, IN_LNG) + (size_t)(L * 2 + 0) * D; const float* b1 = ain(kp, IN_LNB) + (size_t)(L * 2 + 0) * D;
        const int NT = build_tiles(F, cnt);
        __syncthreads();
        phase_downproj3(F, HB, (const bf16*)(ws + WS_W_EX_D) + (size_t)L * 64 * D * EDIM, Yr, NT);
        __syncthreads();
        { const int rot = (c - ((NT * 4) % F.G) + F.G) % F.G;
          g8::DenseSched S; S.init(HS, (const bf16*)(ws + WS_W_SH_D) + (size_t)L * D * SDIM, T, D, SDIM, SDIM, F.G, rot);
          int t2 = F.tid; asm volatile("" : "+v"(t2));
          int ks = SDIM; asm volatile("" : "+s"(ks));
          g8::EpiResidLN E{nullptr, yf, (const float*)(ws + WS_ST1), g1, b1, (bf16*)(ws + WS_Y2F), pstp, 1}; g8::gemm_phase<g8::EpiResidLN, g8::DenseSched, false>(ring, t2, ks, ks, ks, S, E); } }
    if constexpr (PH == PH_MOE4) { (void)build_tiles(F, cnt);
        const float* g2 = ain(kp, IN_LNG) + (size_t)(L * 2 + 1) * D; const float* b2 = ain(kp, IN_LNB) + (size_t)(L * 2 + 1) * D;
        phase_moe4g(F, (bf16*)(ws + WS_Y2F), Yr, eidx, inv, g2, b2, (float*)(ws + WS_ST2), (bf16*)(ws + WS_XB), aout(kp), L == DEPTH - 1); }
}
__device__ __forceinline__ void make_frame(Frame& F, const Args& args) {
    extern __shared__ __attribute__((aligned(16))) unsigned char lds_raw[];
    F.lds = (LAS unsigned char*)lds_raw; F.ws = args.ws; F.ctl = (unsigned*)(args.ws + WS_CTL);
    F.tid = threadIdx.x; F.lane = F.tid & 63; F.wave = __builtin_amdgcn_readfirstlane(F.tid >> 6); F.G = gridDim.x; F.bid = blockIdx.x;
}
template <int PH> __global__ void __launch_bounds__(512, 2) k_phase(Args args, int L) {
    Frame F; make_frame(F, args);
    run_phase<PH>(F, args, L);
}

#ifndef MK_NOINLINE
#define MK_NOINLINE 0
#endif
#if MK_NOINLINE
template <int PH> __device__ __noinline__ void call_phase_ni(const int L) {
    Args dummy{}; Frame F;
    KP kp = (KP)__builtin_amdgcn_kernarg_segment_ptr();
    extern __shared__ __attribute__((aligned(16))) unsigned char lds_raw[];
    F.lds = (LAS unsigned char*)lds_raw; F.ws = (unsigned char*)((GAS unsigned char* const CAS*)kp)[20]; F.ctl = (unsigned*)(F.ws + WS_CTL);
    F.tid = threadIdx.x; F.lane = F.tid & 63; F.wave = __builtin_amdgcn_readfirstlane(F.tid >> 6); F.G = gridDim.x; F.bid = blockIdx.x;
    run_phase<PH>(F, dummy, L);
}
template <int PH> __device__ __forceinline__ void call_phase(const Frame& F, const Args& args, const int L) { call_phase_ni<PH>(L); }
#else
template <int PH> __device__ __forceinline__ void call_phase(const Frame& F, const Args& args, const int L) { asm volatile("; PHASE_BEGIN %0" :: "n"(PH)); run_phase<PH>(F, args, L); asm volatile("; PHASE_END %0" :: "n"(PH)); }
#endif
__global__ void __launch_bounds__(512, 2) fwd_all(Args args) {
    Frame F; make_frame(F, args);
    volatile LAS unsigned* misc = (volatile LAS unsigned*)(F.lds + LDS_MISC);
    if (F.tid < 4) misc[F.tid] = 0u;
    __syncthreads();
    const int lo = args.ph_lo, hi = args.ph_hi;
    XcdBarrier bar; bar.bar = F.ctl + CW_BAR; bar.x = 0; bar.st = misc;
    if (hi - lo > 1) bar = xcd_barrier_post(F.ctl + CW_BAR, misc);
    int pc = 0;
#ifndef MK_DUP_MASK
#define MK_DUP_MASK 0
#endif
#define STEP(PH, Lx) do { if (pc >= lo && pc < hi) { if ((MK_DUP_MASK >> (PH)) & 1) { call_phase<PH>(F, args, Lx); xcd_barrier(bar); } call_phase<PH>(F, args, Lx); if (pc + 1 < hi) xcd_barrier(bar); } ++pc; } while (0)
    STEP(PH_PRO, 0);
#pragma unroll 1
    for (int L = 0; L < DEPTH; ++L) {
        const int kind = L % 3;
        if (kind == 0) { STEP(PH_POOL_G1, L); STEP(PH_POOL_P, L); STEP(PH_POOL_G2, L); STEP(PH_POOL_G3, L); }
        else if (kind == 1) { STEP(PH_DIL_G1, L); STEP(PH_DIL_ATT, L); STEP(PH_DIL_CMB, L); STEP(PH_DIL_G2, L); }
        else { STEP(PH_CONV_G1, L); STEP(PH_CONV_E, L); STEP(PH_CONV_G2, L); }
        STEP(PH_MOE1, L); STEP(PH_MOE2, L); STEP(PH_MOE3, L); STEP(PH_MOE4, L);
    }
#undef STEP
}
constexpr int N_STEPS = 1 + 2 * 8 + 8 + 7;

template <int PH> static void launch_phase(const Args& a, int L, int grid, hipStream_t stream) {
    static bool attr = false;
    if (!attr) { (void)hipFuncSetAttribute((const void*)k_phase<PH>, hipFuncAttributeMaxDynamicSharedMemorySize, LDS_BYTES); attr = true; }
    hipLaunchKernelGGL(k_phase<PH>, dim3(grid), dim3(512), LDS_BYTES, stream, a, L);
}
extern "C" void kernel_launch(void* const* d_in, const int* in_sizes, int n_in, void* d_out, int out_size, void* d_ws, size_t ws_size, hipStream_t stream) {
    static int grid = 0;
    if (grid == 0) {
        if (n_in != 19 || out_size != T * D || ws_size < WS_END) { fprintf(stderr, "kernel_launch: unexpected shapes (n_in %d out %d ws %zu need %zu)\n", n_in, out_size, ws_size, (size_t)WS_END); grid = -1; return; }
        int dev = 0, cus = 0;
        if (hipGetDevice(&dev) != hipSuccess || hipDeviceGetAttribute(&cus, hipDeviceAttributeMultiprocessorCount, dev) != hipSuccess) { grid = -1; return; }
#if MK_ONE_LAUNCH
        if (hipFuncSetAttribute((const void*)fwd_all, hipFuncAttributeMaxDynamicSharedMemorySize, LDS_BYTES) != hipSuccess) { fprintf(stderr, "kernel_launch: hipFuncSetAttribute failed\n"); grid = -1; return; }
        int per_cu = 0;
        if (hipOccupancyMaxActiveBlocksPerMultiprocessor(&per_cu, (const void*)fwd_all, 512, LDS_BYTES) != hipSuccess || per_cu < 1) { fprintf(stderr, "kernel_launch: note: occupancy query reports %d blocks per CU\n", per_cu); (void)hipGetLastError(); }
#endif
        grid = cus;
    }
    if (grid < 0) return;
    (void)hipMemsetAsync((char*)d_ws + WS_CTL, 0, CTL_ZERO_BYTES, stream);
    Args a{};
    for (int i = 0; i < 19; ++i) a.in[i] = (const float*)d_in[i];
    a.out = (float*)d_out; a.ws = (unsigned char*)d_ws; a.ph_lo = 0; a.ph_hi = 0;
#if MK_ONE_LAUNCH
#ifdef MK_SPLIT
    for (int p = 0; p < N_STEPS; ++p) { a.ph_lo = p; a.ph_hi = p + 1; hipLaunchKernelGGL(fwd_all, dim3(grid), dim3(512), LDS_BYTES, stream, a); }
#else
    a.ph_lo = 0; a.ph_hi = N_STEPS;
    hipLaunchKernelGGL(fwd_all, dim3(grid), dim3(512), LDS_BYTES, stream, a);
#endif
#elif defined(MK_HYBRID_MASK)
    {
        static bool attr2 = false; if (!attr2) { (void)hipFuncSetAttribute((const void*)fwd_all, hipFuncAttributeMaxDynamicSharedMemorySize, LDS_BYTES); attr2 = true; }
        int pc = 0;
#define HSTEP(PH, Lx) do { if ((MK_HYBRID_MASK >> (PH)) & 1) { a.ph_lo = pc; a.ph_hi = pc + 1; hipLaunchKernelGGL(fwd_all, dim3(grid), dim3(512), LDS_BYTES, stream, a); } else { a.ph_lo = 0; a.ph_hi = 0; launch_phase<PH>(a, Lx, grid, stream); } ++pc; } while (0)
        HSTEP(PH_PRO, 0);
        for (int L = 0; L < DEPTH; ++L) {
            const int kind = L % 3;
            if (kind == 0) { HSTEP(PH_POOL_G1, L); HSTEP(PH_POOL_P, L); HSTEP(PH_POOL_G2, L); HSTEP(PH_POOL_G3, L); }
            else if (kind == 1) { HSTEP(PH_DIL_G1, L); HSTEP(PH_DIL_ATT, L); HSTEP(PH_DIL_CMB, L); HSTEP(PH_DIL_G2, L); }
            else { HSTEP(PH_CONV_G1, L); HSTEP(PH_CONV_E, L); HSTEP(PH_CONV_G2, L); }
            HSTEP(PH_MOE1, L); HSTEP(PH_MOE2, L); HSTEP(PH_MOE3, L); HSTEP(PH_MOE4, L);
        }
#undef HSTEP
    }
#else
    launch_phase<PH_PRO>(a, 0, grid, stream);
    for (int L = 0; L < DEPTH; ++L) {
        const int kind = L % 3;
        if (kind == 0) { launch_phase<PH_POOL_G1>(a, L, grid, stream); launch_phase<PH_POOL_P>(a, L, grid, stream); launch_phase<PH_POOL_G2>(a, L, grid, stream); launch_phase<PH_POOL_G3>(a, L, grid, stream); }
        else if (kind == 1) { launch_phase<PH_DIL_G1>(a, L, grid, stream); launch_phase<PH_DIL_ATT>(a, L, grid, stream); launch_phase<PH_DIL_CMB>(a, L, grid, stream); launch_phase<PH_DIL_G2>(a, L, grid, stream); }
        else { launch_phase<PH_CONV_G1>(a, L, grid, stream); launch_phase<PH_CONV_E>(a, L, grid, stream); launch_phase<PH_CONV_G2>(a, L, grid, stream); }
        launch_phase<PH_MOE1>(a, L, grid, stream); launch_phase<PH_MOE2>(a, L, grid, stream); launch_phase<PH_MOE3>(a, L, grid, stream); launch_phase<PH_MOE4>(a, L, grid, stream);
    }
#endif
}
```

```cpp
#include <hip/hip_runtime.h>
#include <cstdio>
#include <cstdint>

#ifndef MK_ONE_LAUNCH
#define MK_ONE_LAUNCH 1
#endif

#define GAS __attribute__((address_space(1)))
#define LAS __attribute__((address_space(3)))
typedef unsigned short bf16;
typedef unsigned v4u __attribute__((ext_vector_type(4)));
typedef unsigned v2u __attribute__((ext_vector_type(2)));
typedef float f32x4 __attribute__((ext_vector_type(4)));
typedef float f32x2 __attribute__((ext_vector_type(2)));
typedef short bf16x8 __attribute__((ext_vector_type(8)));
typedef short s16x4 __attribute__((ext_vector_type(4)));

constexpr int NBATCH = 8, SEQ = 2048, D = 2048, T = NBATCH * SEQ, DEPTH = 4;
constexpr int NEXP = 64, TOPK = 8, EDIM = 128, SDIM = 256;
constexpr int QKVC = 4608, DILW = 512;
constexpr float ALPHA = 1.681792830507429f;
constexpr float LN_EPS = 1e-5f;
constexpr int CAP = 16384;
constexpr int HROWS = T * TOPK + NEXP * 256;

constexpr size_t MiB = 1u << 20;
constexpr size_t WS_CTL = 0, CTL_ZERO_BYTES = 1 * MiB;
constexpr size_t WS_W_POOL_IN = 1 * MiB;
constexpr size_t WS_W_POOL_G = WS_W_POOL_IN + 16 * MiB;
constexpr size_t WS_W_POOL_OUT = WS_W_POOL_G + 4 * MiB;
constexpr size_t WS_W_DIL_QKV = WS_W_POOL_OUT + 16 * MiB;
constexpr size_t WS_W_DIL_OUT = WS_W_DIL_QKV + 18 * MiB;
constexpr size_t WS_W_CONV_IN = WS_W_DIL_OUT + 2 * MiB;
constexpr size_t WS_W_CONV_OUT = WS_W_CONV_IN + 24 * MiB;
constexpr size_t WS_W_SH_GU = WS_W_CONV_OUT + 8 * MiB;
constexpr size_t WS_W_SH_D = WS_W_SH_GU + 8 * MiB;
constexpr size_t WS_W_EX_GU = WS_W_SH_D + 4 * MiB;
constexpr size_t WS_W_EX_D = WS_W_EX_GU + 256 * MiB;
constexpr size_t WS_XF = WS_W_EX_D + 256 * MiB;
constexpr size_t WS_YF = WS_XF + 128 * MiB;
constexpr size_t WS_X1F = WS_YF + 128 * MiB;
constexpr size_t WS_XB = WS_X1F + 128 * MiB;
constexpr size_t WS_X1B = WS_XB + 64 * MiB;
constexpr size_t WS_HB = WS_X1B + 64 * MiB;
constexpr size_t WS_HS = WS_HB + 72 * MiB;
constexpr size_t WS_LTOK = WS_HS + 8 * MiB;
constexpr size_t WS_LGATE = WS_LTOK + 4 * MiB;
constexpr size_t WS_EIDX = WS_LGATE + 4 * MiB;
constexpr size_t WS_INV = WS_EIDX + 1 * MiB;
constexpr size_t WS_BIG = WS_INV + 1 * MiB;
constexpr size_t WS_PST = WS_BIG + 608 * MiB;
constexpr size_t WS_ST1 = WS_PST + 4 * MiB;
constexpr size_t WS_ST2 = WS_ST1 + 1 * MiB;
constexpr size_t WS_RWH = WS_ST2 + 1 * MiB;
constexpr size_t WS_RWL = WS_RWH + 1 * MiB;
constexpr size_t WS_PST2 = WS_RWL + 1 * MiB;
constexpr size_t WS_END = WS_PST2 + 8 * MiB;
constexpr size_t WS_Y2F = WS_X1F;
constexpr size_t BG_U = 0, BG_PL = 64 * MiB, BG_MX = 128 * MiB;
constexpr size_t BG_QKV = 0, BG_OG = 144 * MiB, BG_LSE = 192 * MiB, BG_O = 194 * MiB;
constexpr size_t BG_UC = 0, BG_BG = 64 * MiB, BG_Z = 128 * MiB;
constexpr size_t BG_YSC = 320 * MiB;
constexpr int CW_BAR = 4096;
constexpr int CW_CNT = 16384;

constexpr int RING_BYTES = 131072;
constexpr int LDS_TAB = RING_BYTES;
constexpr int LDS_STASH = RING_BYTES + 1024;
constexpr int LDS_BYTES = 163840;
constexpr int LDS_MISC = LDS_BYTES - 1024;

typedef __bf16 bf16x2_t __attribute__((ext_vector_type(2)));
typedef float f32x2_t __attribute__((ext_vector_type(2)));
__device__ __forceinline__ unsigned cvt_pk_bf16(float lo, float hi) { const bf16x2_t r = __builtin_convertvector((f32x2_t){lo, hi}, bf16x2_t); return __builtin_bit_cast(unsigned, r); }
__device__ __forceinline__ unsigned f2bf(float f) { unsigned u = __builtin_bit_cast(unsigned, f); return (u + 0x7fffu + ((u >> 16) & 1u)) >> 16; }
__device__ __forceinline__ unsigned pk2(float lo, float hi) { return f2bf(lo) | (f2bf(hi) << 16); }
__device__ __forceinline__ float bflo(unsigned w) { return __builtin_bit_cast(float, w << 16); }
__device__ __forceinline__ float bfhi(unsigned w) { return __builtin_bit_cast(float, w & 0xffff0000u); }
__device__ __forceinline__ float shfl_from(float v, int src) { return __builtin_bit_cast(float, __builtin_amdgcn_ds_bpermute(src << 2, __builtin_bit_cast(int, v))); }
__device__ __forceinline__ float shfl_x(float v, int o, int lane) { return shfl_from(v, lane ^ o); }
__device__ __forceinline__ float wave_sum(float v, int lane) {
#pragma unroll
    for (int o = 1; o < 64; o <<= 1) v += shfl_x(v, o, lane);
    return v;
}
#define LDS_WAIT() asm volatile("s_waitcnt lgkmcnt(0)" ::: "memory")
#define VM_WAIT() asm volatile("s_waitcnt vmcnt(0)" ::: "memory")

#define XB_TMO      128
#define XB_XCNT(j)  (256  + 64 * (j))
#define XB_XSUB(j)  (1280 + 64 * (j))
#define XB_XGEN(j)  (2304 + 64 * (j))
#define XB_TOP      3328
#define XB_TOPGEN   3392
#define XCD_BAR_WORDS 3456
#define XB_SPIN_CAP (1u << 18)

__device__ __forceinline__ unsigned xb_ld(unsigned* p)              { return __hip_atomic_load(p, __ATOMIC_RELAXED, __HIP_MEMORY_SCOPE_AGENT); }
__device__ __forceinline__ unsigned xb_add(unsigned* p, unsigned v) { return __hip_atomic_fetch_add(p, v, __ATOMIC_RELAXED, __HIP_MEMORY_SCOPE_AGENT); }
__device__ __forceinline__ unsigned xb_xcc_id() { return (unsigned)__builtin_amdgcn_s_getreg((3 << 11) | 20) & 0xFu; }
#define XB_SPIN(cond, bar) do { unsigned _sp = 0; while (cond) { __builtin_amdgcn_s_sleep(1); \
    if ((++_sp & 255u) == 0u) { if (xb_ld(&(bar)[XB_TMO])) break; if (_sp > XB_SPIN_CAP) { atomicAdd(&(bar)[XB_TMO], 1u); break; } } } } while (0)

struct XcdBarrier {
    unsigned* bar; unsigned x;
    volatile LAS unsigned* st;
};

__device__ __forceinline__ XcdBarrier xcd_barrier_post(unsigned* bar, volatile LAS unsigned* st) {
    XcdBarrier b; b.bar = bar; b.x = xb_xcc_id(); b.st = st;
    if (threadIdx.x == 0) (void)xb_add(&bar[XB_XCNT(b.x)], 1u);
    return b;
}
__device__ __forceinline__ void xcd_barrier_complete(unsigned* bar, unsigned x, unsigned& nloc, unsigned& nx) {
    const unsigned G = gridDim.x * gridDim.y * gridDim.z;
    unsigned sum, cnt, mine, sp = 0u;
    for (;;) {
        sum = 0u; cnt = 0u; mine = 0u;
#pragma unroll
        for (unsigned j = 0; j < 16; ++j) { const unsigned c = xb_ld(&bar[XB_XCNT(j)]); sum += c; cnt += (c > 0u) ? 1u : 0u; mine = (j == x) ? c : mine; }
        if (sum == G) break;
        __builtin_amdgcn_s_sleep(1);
        if ((++sp & 255u) == 0u) { if (xb_ld(&bar[XB_TMO])) break; if (sp > XB_SPIN_CAP) { atomicAdd(&bar[XB_TMO], 1u); break; } }
    }
    nloc = mine > 0u ? mine : 1u; nx = cnt > 0u ? cnt : 1u;
}

__device__ __forceinline__ void xcd_barrier(const XcdBarrier& b) {
    asm volatile("s_waitcnt vmcnt(0)" ::: "memory");
    __syncthreads();
    if (threadIdx.x == 0) {
        unsigned* bar; unsigned bx = b.x; { GAS unsigned* bg = (GAS unsigned*)b.bar; asm volatile("" : "+s"(bg), "+s"(bx)); bar = (unsigned*)bg; }
        __builtin_amdgcn_s_waitcnt(0);
        unsigned nloc = b.st[0], nx = b.st[1];
        if (nloc == 0u) { xcd_barrier_complete(bar, bx, nloc, nx); b.st[0] = nloc; b.st[1] = nx; }
        const unsigned old = xb_add(&bar[XB_XSUB(bx)], 1u);
        const unsigned gen = old / nloc;
        if (old + 1u == (gen + 1u) * nloc) {
            __builtin_amdgcn_fence(__ATOMIC_RELEASE, "agent");
            asm volatile("s_waitcnt vmcnt(0)" ::: "memory");
            const unsigned og = xb_add(&bar[XB_TOP], 1u);
            const unsigned tg = og / nx;
            if (og + 1u == (tg + 1u) * nx) xb_add(&bar[XB_TOPGEN], 1u);
            else XB_SPIN(xb_ld(&bar[XB_TOPGEN]) == tg, bar);
            __builtin_amdgcn_fence(__ATOMIC_ACQUIRE, "agent");
            xb_add(&bar[XB_XGEN(bx)], 1u);
            asm volatile("s_waitcnt vmcnt(0)" ::: "memory");
        } else {
            XB_SPIN(xb_ld(&bar[XB_XGEN(bx)]) == gen, bar);
            __builtin_amdgcn_fence(__ATOMIC_ACQUIRE, "agent");
            asm volatile("s_waitcnt vmcnt(0)" ::: "memory");
        }
    }
    __syncthreads();
}

namespace g8 {
constexpr int BM = 256, BK = 64, HALF = 128, HTB = HALF * BK * 2, STAGE_BYTES = 8 * HTB, NXCD = 8, WGM = 8;
__host__ __device__ __forceinline__ int lds_byte(int r, int c) { const int st = (r >> 4) * 2 + (c >> 5), rr = r & 15, cc = c & 31, ob = rr * 64 + cc * 2; return st * 1024 + (ob ^ (((ob >> 9) & 1) << 5)); }
__host__ __device__ __forceinline__ void stage_rc(int b, int& R, int& C) { const int st = b / 1024, sb = b % 1024, swz = sb ^ (((sb >> 9) & 1) << 5); R = (st >> 1) * 16 + swz / 64; C = (st & 1) * 32 + (swz % 64) / 2; }
__host__ __device__ __forceinline__ int perm32(int rho) { const int n = rho >> 4, i = rho & 15; return 8 * (i >> 2) + 4 * n + (i & 3); }

struct Unit { const char* A; const char* B; const int* rows; int pm, pn, nvalid, aux; };

template <class Epi, class Sched, bool GATHER>
__device__ __forceinline__ void gemm_phase(LAS unsigned char* lds, const int tid_in, const int K, const int lda, const int ldb, const Sched& S, const Epi& E) {
    const int tid = tid_in, wid = __builtin_amdgcn_readfirstlane(tid >> 6), lane = tid & 63, wr = wid >> 2, wc = wid & 3, fr = lane & 15, fq = lane >> 4;
    const int nt = K / BK;
    unsigned voffB[2];
#pragma unroll
    for (int i = 0; i < 2; ++i) { int R_, C_; stage_rc(tid * 16 + i * 8192, R_, C_); const int Rb = Epi::PERM ? ((R_ & ~31) + perm32(R_ & 31)) : R_; voffB[i] = (unsigned)(Rb * ldb + C_) * 2u; }
    LAS v4u* stash = (LAS v4u*)(lds + (LDS_STASH - 0) + tid * 16);
    const size_t kstep = (size_t)(BK * 2);
    const size_t hstepB = (size_t)HALF * ldb * 2;
    const unsigned ldsw = (unsigned)wid * 1024u;
    const int aoff = lds_byte(wr * 64 + fr, fq * 8), boff = lds_byte(wc * 32 + fr, fq * 8);
#define G8_SA(b, h) (((b) * 2 + (h)) * HTB)
#define G8_SB(b, h) ((4 + (b) * 2 + (h)) * HTB)
#define G8_STAGE2(bufoff, gbase, v0, v1) do { \
        __builtin_amdgcn_global_load_lds((const unsigned*)((const char*)(gbase) + (v0)), (LAS unsigned*)(lds + (bufoff) + ldsw), 16, 0, 0); \
        __builtin_amdgcn_global_load_lds((const unsigned*)((const char*)(gbase) + (v1)), (LAS unsigned*)(lds + (bufoff) + ldsw + 8192), 16, 0, 0); } while (0)
#define G8_STAGEB(bufoff, gbase) G8_STAGE2(bufoff, gbase, voffB[0], voffB[1])
#define G8_LDA(dst, b, h) do { _Pragma("unroll") for (int m = 0; m < 4; ++m) _Pragma("unroll") for (int k = 0; k < 2; ++k) dst[m][k] = *(const LAS bf16x8*)(lds + G8_SA(b, h) + aoff + m * 2048 + k * 1024); } while (0)
#define G8_LDB(dst, b, h) do { _Pragma("unroll") for (int n = 0; n < 2; ++n) _Pragma("unroll") for (int k = 0; k < 2; ++k) dst[n][k] = *(const LAS bf16x8*)(lds + G8_SB(b, h) + boff + n * 2048 + k * 1024); } while (0)
#define G8_MMA(ai, bj, At, Bt) do { __builtin_amdgcn_s_setprio(1); _Pragma("unroll") for (int m = 0; m < 4; ++m) _Pragma("unroll") for (int n = 0; n < 2; ++n) _Pragma("unroll") for (int k = 0; k < 2; ++k) \
        acc[ai][bj][m][n] = __builtin_amdgcn_mfma_f32_16x16x32_bf16(Bt[n][k], At[m][k], acc[ai][bj][m][n], 0, 0, 0); __builtin_amdgcn_s_setprio(0); } while (0)
#define G8_WAIT_V(n) asm volatile("s_waitcnt vmcnt(" #n ")" ::: "memory")
#define G8_WAIT_L(n) asm volatile("s_waitcnt lgkmcnt(" #n ")" ::: "memory")
#define G8_BAR __builtin_amdgcn_s_barrier()
#define G8_SCHED __builtin_amdgcn_sched_barrier(0)
#define G8_SETVA(dst, u) do { int _t2 = tid; if (GATHER) asm volatile("" : "+v"(_t2)); _Pragma("unroll") for (int _h = 0; _h < 2; ++_h) _Pragma("unroll") for (int _i = 0; _i < 2; ++_i) { \
        int _R, _C; stage_rc(_t2 * 16 + _i * 8192, _R, _C); \
        const unsigned _rl = (unsigned)(_h * HALF + _R); unsigned _row = _rl; \
        if (GATHER) { _row = 0u; if (_rl < (unsigned)(u).nvalid) _row = (unsigned)(u).rows[_rl] >> 3; } \
        dst[_h][_i] = (_row * (unsigned)lda + (unsigned)_C) * 2u; } } while (0)
    Unit cur, nxt; int ui = 0;
    if (!S.next(0, cur)) return;
    f32x4 acc[2][2][4][2];
#pragma unroll
    for (int a = 0; a < 2; ++a)
#pragma unroll
        for (int b = 0; b < 2; ++b)
#pragma unroll
            for (int m = 0; m < 4; ++m)
#pragma unroll
                for (int n = 0; n < 2; ++n) acc[a][b][m][n] = (f32x4){0.f, 0.f, 0.f, 0.f};
    bf16x8 At[4][2], B0[2][2], B1[2][2];
    unsigned vAc[2][2]; unsigned xl00 = 0, xl01 = 0, xl10 = 0, xl11 = 0;
    G8_SETVA(vAc, cur);
    const char* cA = cur.A; const char* cB = cur.B;
    G8_STAGEB(G8_SB(0, 0), cB); G8_STAGEB(G8_SB(0, 1), cB + hstepB); G8_STAGE2(G8_SA(0, 0), cA, vAc[0][0], vAc[0][1]); G8_STAGE2(G8_SA(0, 1), cA, vAc[1][0], vAc[1][1]);
    if (wr == 1) G8_BAR;
    G8_WAIT_V(2); G8_BAR;
    G8_STAGEB(G8_SB(1, 0), cB + kstep); G8_STAGE2(G8_SA(1, 0), cA + kstep, vAc[0][0], vAc[0][1]); G8_STAGEB(G8_SB(1, 1), cB + hstepB + kstep);
    G8_WAIT_V(6); G8_BAR;
    for (;;) {
        const bool has_next = S.next(ui + 1, nxt);
        const char* nA = has_next ? nxt.A : cA; const char* nB = has_next ? nxt.B : cB;
        if (GATHER) { unsigned vAn[2][2]; if (has_next) { G8_SETVA(vAn, nxt); } else {
#pragma unroll
            for (int h = 0; h < 2; ++h)
#pragma unroll
                for (int i = 0; i < 2; ++i) vAn[h][i] = vAc[h][i]; }
            *stash = (v4u){vAn[0][0], vAn[0][1], vAn[1][0], vAn[1][1]}; }
#pragma unroll 1
        for (int t = 0; t < nt; t += 2) {
            const bool last = (t == nt - 2);
            const char* a1 = cA + (size_t)(t + 1) * kstep;
            const char* a2 = last ? nA : cA + (size_t)(t + 2) * kstep; const char* b2 = last ? nB : cB + (size_t)(t + 2) * kstep;
            const char* a3 = a2 + kstep; const char* b3 = b2 + kstep;
            unsigned x00 = vAc[0][0], x01 = vAc[0][1], x10 = vAc[1][0], x11 = vAc[1][1];
            if (GATHER) { if (last) { const v4u sv = *stash; x00 = sv.x; x01 = sv.y; x10 = sv.z; x11 = sv.w; } xl00 = x00; xl01 = x01; xl10 = x10; xl11 = x11; }
            G8_LDB(B0, 0, 0); G8_LDB(B1, 0, 1); G8_SCHED; G8_LDA(At, 0, 0); G8_STAGE2(G8_SA(1, 1), a1, vAc[1][0], vAc[1][1]);
            G8_WAIT_V(8); G8_WAIT_L(0); G8_BAR; G8_MMA(0, 0, At, B0); G8_MMA(0, 1, At, B1); G8_BAR; G8_SCHED;
            G8_LDA(At, 0, 1); G8_STAGEB(G8_SB(0, 0), b2); G8_STAGEB(G8_SB(0, 1), b2 + hstepB); G8_STAGE2(G8_SA(0, 0), a2, x00, x01);
            G8_WAIT_V(8); G8_WAIT_L(0); G8_BAR; G8_MMA(1, 0, At, B0); G8_MMA(1, 1, At, B1); G8_BAR; G8_SCHED;
            G8_LDB(B0, 1, 0); G8_LDB(B1, 1, 1); G8_SCHED; G8_LDA(At, 1, 0); G8_STAGE2(G8_SA(0, 1), a2, x10, x11);
            G8_WAIT_V(8); G8_WAIT_L(0); G8_BAR; G8_MMA(0, 0, At, B0); G8_MMA(0, 1, At, B1); G8_BAR; G8_SCHED;
            G8_LDA(At, 1, 1); G8_STAGEB(G8_SB(1, 0), b3); G8_STAGEB(G8_SB(1, 1), b3 + hstepB); G8_STAGE2(G8_SA(1, 0), a3, x00, x01);
            G8_WAIT_V(8); G8_WAIT_L(0); G8_BAR; G8_MMA(1, 0, At, B0); G8_MMA(1, 1, At, B1); G8_BAR; G8_SCHED;
        }
        if (wr == 0) G8_BAR;
        E(acc, cur, wr, wc, fr, fq);
        if (!has_next) break;
#pragma unroll
        for (int a = 0; a < 2; ++a)
#pragma unroll
            for (int b = 0; b < 2; ++b)
#pragma unroll
                for (int m = 0; m < 4; ++m)
#pragma unroll
                    for (int n = 0; n < 2; ++n) acc[a][b][m][n] = (f32x4){0.f, 0.f, 0.f, 0.f};
        cur = nxt; cA = nA; cB = nB; ++ui;
        if (GATHER) { vAc[0][0] = xl00; vAc[0][1] = xl01; vAc[1][0] = xl10; vAc[1][1] = xl11; }
        if (wr == 1) G8_BAR;
    }
    G8_WAIT_V(0);
    G8_BAR;
#undef G8_SA
#undef G8_SB
#undef G8_STAGE2
#undef G8_STAGEB
#undef G8_LDA
#undef G8_LDB
#undef G8_MMA
#undef G8_WAIT_V
#undef G8_WAIT_L
#undef G8_BAR
#undef G8_SCHED
#undef G8_SETVA
}

struct DenseSched {
    const char* A; const char* B; size_t a_tile, b_tile, agrp_stride; int agrp_shift, nM, nN, nwg, G, c;
    __device__ __forceinline__ void init(const void* A_, const void* B_, int M, int N, int lda, int ldb, int G_, int c_) {
        A = (const char*)A_; B = (const char*)B_; a_tile = (size_t)BM * lda * 2; b_tile = (size_t)BM * ldb * 2; agrp_stride = 0; agrp_shift = 0; nM = M / BM; nN = N / BM; nwg = nM * nN; G = G_; c = c_; }
    __device__ __forceinline__ bool next(int i, Unit& u) const {
        const long L = (long)i * G + c; if (L >= nwg) return false;
        int wgid = (int)L; { const int q = nwg / NXCD, r = nwg % NXCD, xcd = wgid % NXCD, off = wgid / NXCD; wgid = (xcd < r ? xcd * (q + 1) : r * (q + 1) + (xcd - r) * q) + off; }
        const int nig = WGM * nN, gid = wgid / nig, fm = gid * WGM, gsz = (nM - fm) < WGM ? (nM - fm) : WGM;
        u.pm = fm + ((wgid % nig) % gsz); u.pn = (wgid % nig) / gsz;
        u.A = A + (size_t)u.pm * a_tile + (size_t)(u.pn >> agrp_shift) * agrp_stride; u.B = B + (size_t)u.pn * b_tile; u.rows = nullptr; u.nvalid = BM; u.aux = 0; return true;
    }
};
template <int NPN, bool GATHERED>
struct ExpertSched {
    const LAS int* tpref; const LAS int* cnt; const char* A; const char* B; const int* tok; size_t b_exp, b_tile, a_tile; int NU, G, c;
    __device__ __forceinline__ bool next(int i, Unit& u) const {
        const int L = i * G + c; if (L >= NU) return false;
        const int tile = L / NPN, pn = L % NPN;
        int e = 0; while (__builtin_amdgcn_readfirstlane(tpref[e + 1]) <= tile) ++e;
        const int rb = tile - __builtin_amdgcn_readfirstlane(tpref[e]);
        u.pm = e; u.pn = pn; u.aux = tile * BM; u.nvalid = __builtin_amdgcn_readfirstlane(cnt[e]) - rb * BM; if (u.nvalid > BM) u.nvalid = BM;
        u.rows = tok + (size_t)e * CAP + rb * BM;
        u.A = GATHERED ? A : A + (size_t)tile * a_tile; u.B = B + (size_t)e * b_exp + (size_t)pn * b_tile; return true;
    }
};

struct EpiBf16 {
    static constexpr bool PERM = true;
    bf16* O; int ldc; int qscale;
    __device__ __forceinline__ void operator()(const f32x4 (&acc)[2][2][4][2], const Unit& u, int wr, int wc, int fr, int fq) const {
        asm volatile("" : "+v"(fr), "+v"(fq));
        const int row0 = u.pm * BM + wr * 64 + fr, col0 = u.pn * BM + wc * 32 + 8 * fq;
        const float sc = (qscale && (u.pn % 6) < 2) ? 0.125f : 1.0f;
#pragma unroll
        for (int ai = 0; ai < 2; ++ai)
#pragma unroll
            for (int m = 0; m < 4; ++m) { bf16* rowp = O + (size_t)(row0 + ai * HALF + m * 16) * ldc + col0;
#pragma unroll
                for (int bj = 0; bj < 2; ++bj) { const f32x4 v0 = acc[ai][bj][m][0] * sc, v1 = acc[ai][bj][m][1] * sc;
                    v4u w; w.x = cvt_pk_bf16(v0[0], v0[1]); w.y = cvt_pk_bf16(v0[2], v0[3]); w.z = cvt_pk_bf16(v1[0], v1[1]); w.w = cvt_pk_bf16(v1[2], v1[3]);
                    *(v4u*)(rowp + bj * HALF) = w; } }
    }
};
struct EpiScaleBf16 {
    static constexpr bool PERM = true;
    bf16* O; int ldc; const float* scale;
    __device__ __forceinline__ void operator()(const f32x4 (&acc)[2][2][4][2], const Unit& u, int wr, int wc, int fr, int fq) const {
        asm volatile("" : "+v"(fr), "+v"(fq));
        const int row0 = u.pm * BM + wr * 64 + fr, col0 = u.pn * BM + wc * 32 + 8 * fq;
        f32x4 sv[2][2];
#pragma unroll
        for (int bj = 0; bj < 2; ++bj)
#pragma unroll
            for (int n = 0; n < 2; ++n) sv[bj][n] = *(const f32x4*)(scale + col0 + bj * HALF + 4 * n);
#pragma unroll
        for (int ai = 0; ai < 2; ++ai)
#pragma unroll
            for (int m = 0; m < 4; ++m) { bf16* rowp = O + (size_t)(row0 + ai * HALF + m * 16) * ldc + col0;
#pragma unroll
                for (int bj = 0; bj < 2; ++bj) { const f32x4 v0 = acc[ai][bj][m][0] * sv[bj][0], v1 = acc[ai][bj][m][1] * sv[bj][1];
                    v4u w; w.x = cvt_pk_bf16(v0[0], v0[1]); w.y = cvt_pk_bf16(v0[2], v0[3]); w.z = cvt_pk_bf16(v1[0], v1[1]); w.w = cvt_pk_bf16(v1[2], v1[3]);
                    *(v4u*)(rowp + bj * HALF) = w; } }
    }
};
struct EpiResid {
    static constexpr bool PERM = false;
    const float* X; float* Y;
    __device__ __forceinline__ void operator()(const f32x4 (&acc)[2][2][4][2], const Unit& u, int wr, int wc, int fr, int fq) const {
        asm volatile("" : "+v"(fr), "+v"(fq));
        const int row0 = u.pm * BM + wr * 64 + fr, col0 = u.pn * BM + wc * 32 + 4 * fq;
#pragma unroll
        for (int ai = 0; ai < 2; ++ai)
#pragma unroll
            for (int m = 0; m < 4; ++m) { const size_t off = (size_t)(row0 + ai * HALF + m * 16) * D + col0;
#pragma unroll
                for (int bj = 0; bj < 2; ++bj)
#pragma unroll
                    for (int n = 0; n < 2; ++n) { const f32x4 xv = *(const f32x4*)(X + off + bj * HALF + n * 16); *(f32x4*)(Y + off + bj * HALF + n * 16) = xv * ALPHA + acc[ai][bj][m][n]; } }
    }
};
struct EpiResidLN {
    static constexpr bool PERM = true;
    const float* X32; const bf16* Xb; const float* st; const float* g; const float* b; bf16* Y; float* pst; int mode;
    __device__ __forceinline__ void operator()(const f32x4 (&acc)[2][2][4][2], const Unit& u, int wr, int wc, int fr, int fq) const {
        asm volatile("" : "+v"(fr), "+v"(fq));
        const int row0 = u.pm * BM + wr * 64 + fr, col0 = u.pn * BM + wc * 32 + 8 * fq, lane = fq * 16 + fr;
#pragma unroll
        for (int ai = 0; ai < 2; ++ai)
#pragma unroll
            for (int m = 0; m < 4; ++m) { const int row = row0 + ai * HALF + m * 16; const size_t off = (size_t)row * D + col0;
                float mean = 0.f, rstd = 1.f; if (mode) { const f32x2 sv = *(const f32x2*)(st + 2 * row); mean = sv.x; rstd = sv.y; }
                float sm = 0.f, sq = 0.f;
#pragma unroll
                for (int bj = 0; bj < 2; ++bj) { f32x4 x0, x1;
                    if (mode) { const v4u xv = *(const v4u*)(Xb + off + bj * HALF);
                        const f32x4 g0 = *(const f32x4*)(g + col0 + bj * HALF), g1 = *(const f32x4*)(g + col0 + bj * HALF + 4), b0 = *(const f32x4*)(b + col0 + bj * HALF), b1 = *(const f32x4*)(b + col0 + bj * HALF + 4);
                        x0 = ((f32x4){bflo(xv.x), bfhi(xv.x), bflo(xv.y), bfhi(xv.y)} - mean) * rstd * g0 + b0; x1 = ((f32x4){bflo(xv.z), bfhi(xv.z), bflo(xv.w), bfhi(xv.w)} - mean) * rstd * g1 + b1; }
                    else { x0 = *(const f32x4*)(X32 + off + bj * HALF); x1 = *(const f32x4*)(X32 + off + bj * HALF + 4); }
                    const f32x4 y0 = x0 * ALPHA + acc[ai][bj][m][0], y1 = x1 * ALPHA + acc[ai][bj][m][1];
                    v4u w; w.x = cvt_pk_bf16(y0[0], y0[1]); w.y = cvt_pk_bf16(y0[2], y0[3]); w.z = cvt_pk_bf16(y1[0], y1[1]); w.w = cvt_pk_bf16(y1[2], y1[3]);
                    *(v4u*)(Y + off + bj * HALF) = w;
                    sm += ((y0[0] + y0[1]) + (y0[2] + y0[3])) + ((y1[0] + y1[1]) + (y1[2] + y1[3]));
                    sq += ((y0[0] * y0[0] + y0[1] * y0[1]) + (y0[2] * y0[2] + y0[3] * y0[3])) + ((y1[0] * y1[0] + y1[1] * y1[1]) + (y1[2] * y1[2] + y1[3] * y1[3])); }
                sm += shfl_x(sm, 16, lane); sm += shfl_x(sm, 32, lane); sq += shfl_x(sq, 16, lane); sq += shfl_x(sq, 32, lane);
                if (fq == 0) *(f32x2*)(pst + ((size_t)row * 32 + u.pn * 4 + wc) * 2) = (f32x2){sm, sq}; }
    }
};
struct EpiConvIn {
    static constexpr bool PERM = true;
    bf16* UC; bf16* BGp;
    __device__ __forceinline__ void operator()(const f32x4 (&acc)[2][2][4][2], const Unit& u, int wr, int wc, int fr, int fq) const {
        asm volatile("" : "+v"(fr), "+v"(fq));
        const int row0 = u.pm * BM + wr * 64 + fr, cw = wc * 32 + 8 * fq;
        if (u.pn < 16) {
#pragma unroll
            for (int ai = 0; ai < 2; ++ai)
#pragma unroll
                for (int m = 0; m < 4; ++m) { bf16* rowp = UC + (size_t)(row0 + ai * HALF + m * 16) * D + u.pn * HALF + cw;
                    const f32x4 v0 = acc[ai][0][m][0] * acc[ai][1][m][0], v1 = acc[ai][0][m][1] * acc[ai][1][m][1];
                    v4u w; w.x = cvt_pk_bf16(v0[0], v0[1]); w.y = cvt_pk_bf16(v0[2], v0[3]); w.z = cvt_pk_bf16(v1[0], v1[1]); w.w = cvt_pk_bf16(v1[2], v1[3]);
                    *(v4u*)rowp = w; }
        } else {
#pragma unroll
            for (int ai = 0; ai < 2; ++ai)
#pragma unroll
                for (int m = 0; m < 4; ++m) { bf16* rowp = BGp + (size_t)(row0 + ai * HALF + m * 16) * D + (u.pn - 16) * BM + cw;
#pragma unroll
                    for (int bj = 0; bj < 2; ++bj) { const f32x4 v0 = acc[ai][bj][m][0], v1 = acc[ai][bj][m][1];
                        v4u w; w.x = cvt_pk_bf16(v0[0], v0[1]); w.y = cvt_pk_bf16(v0[2], v0[3]); w.z = cvt_pk_bf16(v1[0], v1[1]); w.w = cvt_pk_bf16(v1[2], v1[3]);
                        *(v4u*)(rowp + bj * HALF) = w; } }
        }
    }
};
__device__ __forceinline__ f32x4 silu_mul(f32x4 g, f32x4 uu) {
    f32x4 r;
#pragma unroll
    for (int j = 0; j < 4; ++j) r[j] = g[j] * __builtin_amdgcn_rcpf(1.0f + __expf(-g[j])) * uu[j];
    return r;
}
struct EpiExpertGU {
    static constexpr bool PERM = true;
    bf16* H;
    __device__ __forceinline__ void operator()(const f32x4 (&acc)[2][2][4][2], const Unit& u, int wr, int wc, int fr, int fq) const {
        asm volatile("" : "+v"(fr), "+v"(fq));
        const float* gates = (const float*)((const char*)u.rows + (WS_LGATE - WS_LTOK));
        const int cw = wc * 32 + 8 * fq;
#pragma unroll
        for (int ai = 0; ai < 2; ++ai)
#pragma unroll
            for (int m = 0; m < 4; ++m) { const int r = ai * HALF + wr * 64 + m * 16 + fr;
                if (r < u.nvalid) { const float gt = gates[r]; const unsigned pid = (unsigned)u.rows[r];
                    const f32x4 v0 = silu_mul(acc[ai][0][m][0], acc[ai][1][m][0]) * gt, v1 = silu_mul(acc[ai][0][m][1], acc[ai][1][m][1]) * gt;
                    v4u w; w.x = cvt_pk_bf16(v0[0], v0[1]); w.y = cvt_pk_bf16(v0[2], v0[3]); w.z = cvt_pk_bf16(v1[0], v1[1]); w.w = cvt_pk_bf16(v1[2], v1[3]);
                    (void)pid; *(v4u*)(H + (size_t)(u.aux + r) * EDIM + cw) = w; } }
    }
};
struct EpiSharedGU {
    static constexpr bool PERM = true;
    bf16* HS;
    __device__ __forceinline__ void operator()(const f32x4 (&acc)[2][2][4][2], const Unit& u, int wr, int wc, int fr, int fq) const {
        asm volatile("" : "+v"(fr), "+v"(fq));
        const int row0 = u.pm * BM + wr * 64 + fr, cw = u.pn * HALF + wc * 32 + 8 * fq;
#pragma unroll
        for (int ai = 0; ai < 2; ++ai)
#pragma unroll
            for (int m = 0; m < 4; ++m) {
                const f32x4 v0 = silu_mul(acc[ai][0][m][0], acc[ai][1][m][0]), v1 = silu_mul(acc[ai][0][m][1], acc[ai][1][m][1]);
                v4u w; w.x = cvt_pk_bf16(v0[0], v0[1]); w.y = cvt_pk_bf16(v0[2], v0[3]); w.z = cvt_pk_bf16(v1[0], v1[1]); w.w = cvt_pk_bf16(v1[2], v1[3]);
                *(v4u*)(HS + (size_t)(row0 + ai * HALF + m * 16) * SDIM + cw) = w; }
    }
};
struct EpiDownY {
    static constexpr bool PERM = true;
    bf16* Y;
    __device__ __forceinline__ void operator()(const f32x4 (&acc)[2][2][4][2], const Unit& u, int wr, int wc, int fr, int fq) const {
        asm volatile("" : "+v"(fr), "+v"(fq));
        const int col0 = u.pn * BM + wc * 32 + 8 * fq;
#pragma unroll
        for (int ai = 0; ai < 2; ++ai)
#pragma unroll
            for (int m = 0; m < 4; ++m) { const int r = ai * HALF + wr * 64 + m * 16 + fr; bf16* rowp = Y + (size_t)(u.aux + r) * D + col0;
#pragma unroll
                for (int bj = 0; bj < 2; ++bj) { const f32x4 v0 = acc[ai][bj][m][0], v1 = acc[ai][bj][m][1];
                    v4u w; w.x = cvt_pk_bf16(v0[0], v0[1]); w.y = cvt_pk_bf16(v0[2], v0[3]); w.z = cvt_pk_bf16(v1[0], v1[1]); w.w = cvt_pk_bf16(v1[2], v1[3]);
                    *(v4u*)(rowp + bj * HALF) = w; } }
    }
};
}

struct Args { const float* in[19]; float* out; unsigned char* ws; int ph_lo, ph_hi; };
struct Frame {
    LAS unsigned char* lds; unsigned* ctl; unsigned char* ws;
    int tid, lane, wave, G, bid;
};
enum { IN_X = 0, IN_RELB, IN_PWIN, IN_PWG, IN_PSC, IN_PWOUT, IN_DQKV, IN_DOUT, IN_CWIN, IN_CW, IN_CWOUT, IN_LNG, IN_LNB, IN_RW, IN_RB, IN_EGU, IN_ED, IN_SGU, IN_SD };

#define CAS __attribute__((address_space(4)))
typedef const CAS unsigned char* KP;
__device__ __forceinline__ const float* ain(KP kp, int i) { return (const float*)((const GAS float* const CAS*)kp)[i]; }
__device__ __forceinline__ float* aout(KP kp) { return (float*)((GAS float* const CAS*)kp)[19]; }
__device__ __forceinline__ void tr_item(const float* W, int K, int N, bf16* WT, int dstK, int mode, LAS float* scr, int item, int lane) {
    const int nblk = N / 32, kb = item / nblk, nb = item % nblk, k0 = 64 * kb, n0 = 32 * nb;
    int r0 = n0;
    if (mode == 1) { const int part = n0 / 2048, j = n0 % 2048; r0 = (part == 0) ? 4096 + j : 256 * (j / 128) + (part == 2 ? 128 : 0) + (j % 128); }
    if (mode == 2) { const int part = n0 / 256, j = n0 % 256; r0 = 256 * (j / 128) + 128 * part + (j % 128); }
#pragma unroll 8
    for (int i = 0; i < 32; ++i) { const int kk = 2 * i + (lane >> 5); scr[kk * 33 + (lane & 31)] = W[(size_t)(k0 + kk) * N + n0 + (lane & 31)]; }
    LDS_WAIT(); asm volatile("" ::: "memory");
    const int c = lane & 7;
#pragma unroll
    for (int j = 0; j < 4; ++j) { const int n = (lane >> 3) + 8 * j; const LAS float* s = scr + (8 * c) * 33 + n;
        v4u o; o.x = pk2(s[0 * 33], s[1 * 33]); o.y = pk2(s[2 * 33], s[3 * 33]); o.z = pk2(s[4 * 33], s[5 * 33]); o.w = pk2(s[6 * 33], s[7 * 33]);
        *(v4u*)(WT + (size_t)(r0 + n) * dstK + k0 + 8 * c) = o; }
    LDS_WAIT(); asm volatile("" ::: "memory");
}
__device__ __forceinline__ void phase_prologue(const Frame& F, KP kp) {
    LAS float* scr = (LAS float*)(F.lds + F.wave * 16384);
    const int gw = F.bid * 8 + F.wave, NGW = F.G * 8;
    constexpr int I0 = 2 * 2048, I1 = 8 * 128, I2 = 2 * 2048, I3 = 4608, I4 = 512, I5 = 6144, I6 = 2048, I7 = 4 * 512, I8 = 4 * 256, I9 = 256 * 256, I10 = 256 * 128;
    constexpr int NITEMS = I0 + I1 + I2 + I3 + I4 + I5 + I6 + I7 + I8 + I9 + I10;
    unsigned char* ws = F.ws;
    for (int it = gw; it < NITEMS; it += NGW) {
        int r = it;
        if (r < I0) { const int b = r / 2048; tr_item(ain(kp, IN_PWIN) + (size_t)b * D * D, D, D, (bf16*)(ws + WS_W_POOL_IN) + (size_t)b * D * D, D, 0, scr, r % 2048, F.lane); continue; } r -= I0;
        if (r < I1) { const int b = r / 128; tr_item(ain(kp, IN_PWG) + (size_t)b * 512 * 512, 512, 512, (bf16*)(ws + WS_W_POOL_G) + (size_t)b * 512 * 512, 512, 0, scr, r % 128, F.lane); continue; } r -= I1;
        if (r < I2) { const int b = r / 2048; tr_item(ain(kp, IN_PWOUT) + (size_t)b * D * D, D, D, (bf16*)(ws + WS_W_POOL_OUT) + (size_t)b * D * D, D, 0, scr, r % 2048, F.lane); continue; } r -= I2;
        if (r < I3) { tr_item(ain(kp, IN_DQKV), D, QKVC, (bf16*)(ws + WS_W_DIL_QKV), D, 0, scr, r, F.lane); continue; } r -= I3;
        if (r < I4) { tr_item(ain(kp, IN_DOUT), DILW, D, (bf16*)(ws + WS_W_DIL_OUT), DILW, 0, scr, r, F.lane); continue; } r -= I4;
        if (r < I5) { tr_item(ain(kp, IN_CWIN), D, 3 * D, (bf16*)(ws + WS_W_CONV_IN), D, 1, scr, r, F.lane); continue; } r -= I5;
        if (r < I6) { tr_item(ain(kp, IN_CWOUT), D, D, (bf16*)(ws + WS_W_CONV_OUT), D, 0, scr, r, F.lane); continue; } r -= I6;
        if (r < I7) { const int b = r / 512; tr_item(ain(kp, IN_SGU) + (size_t)b * D * 512, D, 512, (bf16*)(ws + WS_W_SH_GU) + (size_t)b * 512 * D, D, 2, scr, r % 512, F.lane); continue; } r -= I7;
        if (r < I8) { const int b = r / 256; tr_item(ain(kp, IN_SD) + (size_t)b * SDIM * D, SDIM, D, (bf16*)(ws + WS_W_SH_D) + (size_t)b * D * SDIM, SDIM, 0, scr, r % 256, F.lane); continue; } r -= I8;
        if (r < I9) { const int b = r / 256; tr_item(ain(kp, IN_EGU) + (size_t)b * D * 256, D, 256, (bf16*)(ws + WS_W_EX_GU) + (size_t)b * 256 * D, D, 0, scr, r % 256, F.lane); continue; } r -= I9;
        { const int b = r / 128; tr_item(ain(kp, IN_ED) + (size_t)b * EDIM * D, EDIM, D, (bf16*)(ws + WS_W_EX_D) + (size_t)b * D * EDIM, EDIM, 0, scr, r % 128, F.lane); }
    }
    const size_t gt = (size_t)F.bid * 512 + F.tid, GT = (size_t)F.G * 512;
    { const float* rw = ain(kp, IN_RW); bf16* wh = (bf16*)(ws + WS_RWH); bf16* wl = (bf16*)(ws + WS_RWL);
      for (size_t i = gt; i < (size_t)DEPTH * NEXP * D / 8; i += GT) { const size_t k8 = i % (D / 8), e = (i / (D / 8)) % NEXP, l = i / ((size_t)NEXP * D / 8);
          float v[8]; unsigned hi[8], lo[8];
#pragma unroll
          for (int j = 0; j < 8; ++j) { v[j] = rw[(l * D + k8 * 8 + j) * NEXP + e]; hi[j] = f2bf(v[j]); lo[j] = f2bf(v[j] - __builtin_bit_cast(float, hi[j] << 16)); }
          v4u a, b2; a.x = hi[0] | (hi[1] << 16); a.y = hi[2] | (hi[3] << 16); a.z = hi[4] | (hi[5] << 16); a.w = hi[6] | (hi[7] << 16);
          b2.x = lo[0] | (lo[1] << 16); b2.y = lo[2] | (lo[3] << 16); b2.z = lo[4] | (lo[5] << 16); b2.w = lo[6] | (lo[7] << 16);
          *(v4u*)(wh + (l * NEXP + e) * D + k8 * 8) = a; *(v4u*)(wl + (l * NEXP + e) * D + k8 * 8) = b2; } }
    const float* x = ain(kp, IN_X); bf16* xb = (bf16*)(ws + WS_XB);
    for (size_t i = gt; i < (size_t)T * D / 8; i += GT) { const f32x4 p = *(const f32x4*)(x + i * 8), q = *(const f32x4*)(x + i * 8 + 4);
        v4u w; w.x = pk2(p[0], p[1]); w.y = pk2(p[2], p[3]); w.z = pk2(q[0], q[1]); w.w = pk2(q[2], q[3]); *(v4u*)(xb + i * 8) = w; }
}

__device__ __forceinline__ void unpack8(const v4u w, float (&f)[8]) { f[0] = bflo(w.x); f[1] = bfhi(w.x); f[2] = bflo(w.y); f[3] = bfhi(w.y); f[4] = bflo(w.z); f[5] = bfhi(w.z); f[6] = bflo(w.w); f[7] = bfhi(w.w); }
__device__ __forceinline__ void phase_pool(const Frame& F, const bf16* U, bf16* PL) {
    for (int it = F.bid * 512 + F.tid; it < (T / 32) * 256; it += F.G * 512) {
        const int cv = it & 255, ch = it >> 8, col = cv * 8, w = 2 << (col >> 9);
        const int row0 = ch * 32, pos0 = row0 & (SEQ - 1);
        float s[8], uu[8];
#pragma unroll
        for (int j = 0; j < 8; ++j) s[j] = 0.f;
        for (int j = 1; j < w; ++j) if (pos0 - j >= 0) { unpack8(*(const v4u*)(U + (size_t)(row0 - j) * D + col), uu);
#pragma unroll
            for (int q = 0; q < 8; ++q) s[q] += uu[q]; }
        for (int r = 0; r < 32; ++r) {
            const int t = row0 + r, pos = pos0 + r;
            unpack8(*(const v4u*)(U + (size_t)t * D + col), uu);
            const float inv = 1.0f / (float)((pos + 1) < w ? (pos + 1) : w);
            float o[8];
#pragma unroll
            for (int q = 0; q < 8; ++q) { s[q] += uu[q]; o[q] = s[q] * inv - uu[q]; }
            v4u ww; ww.x = pk2(o[0], o[1]); ww.y = pk2(o[2], o[3]); ww.z = pk2(o[4], o[5]); ww.w = pk2(o[6], o[7]);
            *(v4u*)(PL + (size_t)t * D + col) = ww;
            if (pos - w + 1 >= 0) { unpack8(*(const v4u*)(U + (size_t)(t - w + 1) * D + col), uu);
#pragma unroll
                for (int q = 0; q < 8; ++q) s[q] -= uu[q]; }
        }
    }
}

__device__ __forceinline__ void phase_conv(const Frame& F, const bf16* UC, const bf16* BGp, const float* cw, bf16* Z) {
    for (int it = F.bid * 512 + F.tid; it < T * 256; it += F.G * 512) {
        const int cv = it & 255, t = it >> 8, col = cv * 8, pos = t & (SEQ - 1);
        float u0[8], u1[8], u2[8], bb[8], o[8];
        unpack8(*(const v4u*)(UC + (size_t)t * D + col), u2);
        if (pos >= 1) unpack8(*(const v4u*)(UC + (size_t)(t - 1) * D + col), u1); else {
#pragma unroll
            for (int q = 0; q < 8; ++q) u1[q] = 0.f; }
        if (pos >= 2) unpack8(*(const v4u*)(UC + (size_t)(t - 2) * D + col), u0); else {
#pragma unroll
            for (int q = 0; q < 8; ++q) u0[q] = 0.f; }
        unpack8(*(const v4u*)(BGp + (size_t)t * D + col), bb);
#pragma unroll
        for (int q = 0; q < 8; ++q) o[q] = bb[q] * (cw[col + q] * u0[q] + cw[D + col + q] * u1[q] + cw[2 * D + col + q] * u2[q]);
        v4u ww; ww.x = pk2(o[0], o[1]); ww.y = pk2(o[2], o[3]); ww.z = pk2(o[4], o[5]); ww.w = pk2(o[6], o[7]);
        *(v4u*)(Z + (size_t)t * D + col) = ww;
    }
}

__device__ __forceinline__ int t5_bucket(int dist) {
    if (dist < 16) return dist;
    int large = 16 + (int)(logf((float)dist / 16.0f) / logf(128.0f) * 16.0f);
    return large < 31 ? large : 31;
}
constexpr int AT_KS = 0, AT_KSTR = 144, AT_VT = 256 * 144, AT_VSTR = 520, AT_BIAS = AT_VT + 64 * 520;
__device__ __forceinline__ void phase_attn(const Frame& F, const bf16* QKV, const float* relb, bf16* OG, float* LSE) {
    LAS unsigned char* lds = F.lds;
    const int tid = F.tid, lane = F.lane, w = tid >> 6, fr = lane & 15, fq = lane >> 4;
    for (int unit = F.bid; unit < NBATCH * 3 * 8 * 16; unit += F.G) {
        const int cmb = unit & 15, h = (unit >> 4) & 7, g = (unit >> 7) % 3, b = unit / 384;
        const int dsh = 2 * g, dil = 1 << dsh, r = cmb & (dil - 1), nb = cmb >> dsh;
        const bf16* base = QKV + (size_t)b * SEQ * QKVC + g * 1536 + h * 64;
        __syncthreads();
        {
            const int key = tid >> 1, half = tid & 1, jk = (nb - 1) * 128 + key;
            v4u kv[4], vv[4];
            if (jk >= 0) { const bf16* rp = base + (size_t)(jk * dil + r) * QKVC + half * 32;
#pragma unroll
                for (int i = 0; i < 4; ++i) { kv[i] = *(const v4u*)(rp + 512 + 8 * i); vv[i] = *(const v4u*)(rp + 1024 + 8 * i); } }
            else {
#pragma unroll
                for (int i = 0; i < 4; ++i) { kv[i] = (v4u){0u, 0u, 0u, 0u}; vv[i] = (v4u){0u, 0u, 0u, 0u}; } }
#pragma unroll
            for (int i = 0; i < 4; ++i) *(LAS v4u*)(lds + AT_KS + key * AT_KSTR + half * 64 + 16 * i) = kv[i];
#pragma unroll
            for (int i = 0; i < 4; ++i) {
                const unsigned ww[4] = {vv[i].x, vv[i].y, vv[i].z, vv[i].w};
#pragma unroll
                for (int q = 0; q < 4; ++q) { const int d = half * 32 + 8 * i + 2 * q;
                    *(LAS unsigned short*)(lds + AT_VT + d * AT_VSTR + key * 2) = (unsigned short)(ww[q] & 0xffffu);
                    *(LAS unsigned short*)(lds + AT_VT + (d + 1) * AT_VSTR + key * 2) = (unsigned short)(ww[q] >> 16); } }
            if (tid <= 128) ((LAS float*)(lds + AT_BIAS))[tid] = relb[t5_bucket(tid * dil) * 24 + g * 8 + h];
        }
        __syncthreads();
        int qi = 16 * w + fr; asm volatile("" : "+v"(qi));
        const int jq = nb * 128 + qi, tq = jq * dil + r;
        const bf16* qp = base + (size_t)tq * QKVC + 8 * fq;
        const bf16x8 q0 = *(const bf16x8*)qp, q1 = *(const bf16x8*)(qp + 32);
        f32x4 s[9]; float mx = -INFINITY;
#pragma unroll
        for (int kt = 0; kt < 9; ++kt) {
            const int kb = 16 * (w + kt);
            const bf16x8 k0 = *(const LAS bf16x8*)(lds + AT_KS + (kb + fr) * AT_KSTR + fq * 16), k1 = *(const LAS bf16x8*)(lds + AT_KS + (kb + fr) * AT_KSTR + 64 + fq * 16);
            f32x4 a = (f32x4){0.f, 0.f, 0.f, 0.f};
            a = __builtin_amdgcn_mfma_f32_16x16x32_bf16(k0, q0, a, 0, 0, 0);
            a = __builtin_amdgcn_mfma_f32_16x16x32_bf16(k1, q1, a, 0, 0, 0);
#pragma unroll
            for (int i = 0; i < 4; ++i) { const int kl = kb + 4 * fq + i, rel = qi + 128 - kl;
                const bool ok = (rel >= 0) && (rel <= 128) && (nb > 0 || kl >= 128);
                const int rc = rel < 0 ? 0 : (rel > 128 ? 128 : rel);
                const float v = ok ? a[i] + ((LAS float*)(lds + AT_BIAS))[rc] : -INFINITY;
                a[i] = v; mx = fmaxf(mx, v); }
            s[kt] = a;
        }
        mx = fmaxf(mx, shfl_x(mx, 16, lane)); mx = fmaxf(mx, shfl_x(mx, 32, lane));
        float l = 0.f;
#pragma unroll
        for (int kt = 0; kt < 9; ++kt)
#pragma unroll
            for (int i = 0; i < 4; ++i) { const float p = __expf(s[kt][i] - mx); s[kt][i] = p; l += p; }
        l += shfl_x(l, 16, lane); l += shfl_x(l, 32, lane);
        f32x4 o[4];
#pragma unroll
        for (int nt = 0; nt < 4; ++nt) o[nt] = (f32x4){0.f, 0.f, 0.f, 0.f};
#pragma unroll
        for (int st = 0; st < 5; ++st) {
            const int kt0 = 2 * st, kt1 = 2 * st + 1;
            v4u pw; pw.x = pk2(s[kt0][0], s[kt0][1]); pw.y = pk2(s[kt0][2], s[kt0][3]);
            if (kt1 < 9) { pw.z = pk2(s[kt1 < 9 ? kt1 : 0][0], s[kt1 < 9 ? kt1 : 0][1]); pw.w = pk2(s[kt1 < 9 ? kt1 : 0][2], s[kt1 < 9 ? kt1 : 0][3]); } else { pw.z = 0u; pw.w = 0u; }
            const bf16x8 pf = __builtin_bit_cast(bf16x8, pw);
            const int kb0 = 16 * (w + kt0) + 4 * fq, kb1 = 16 * (w + kt1) + 4 * fq;
#pragma unroll
            for (int nt = 0; nt < 4; ++nt) { const int d = 16 * nt + fr;
                v2u va = *(const LAS v2u*)(lds + AT_VT + d * AT_VSTR + kb0 * 2), vb = (v2u){0u, 0u};
                if (kt1 < 9) vb = *(const LAS v2u*)(lds + AT_VT + d * AT_VSTR + kb1 * 2);
                v4u vw; vw.x = va.x; vw.y = va.y; vw.z = vb.x; vw.w = vb.y;
                o[nt] = __builtin_amdgcn_mfma_f32_16x16x32_bf16(__builtin_bit_cast(bf16x8, vw), pf, o[nt], 0, 0, 0); }
        }
        const float il = 1.0f / l;
        bf16* op = OG + ((size_t)g * T + (size_t)b * SEQ + tq) * DILW + h * 64 + 4 * fq;
#pragma unroll
        for (int nt = 0; nt < 4; ++nt) { v2u ww; ww.x = pk2(o[nt][0] * il, o[nt][1] * il); ww.y = pk2(o[nt][2] * il, o[nt][3] * il); *(v2u*)(op + 16 * nt) = ww; }
        if (fq == 0) LSE[((size_t)g * T + (size_t)b * SEQ + tq) * 8 + h] = mx + logf(l);
    }
}
__device__ __forceinline__ void phase_combine(const Frame& F, const bf16* OG, const float* LSE, bf16* O) {
    for (int it = F.bid * 512 + F.tid; it < T * 64; it += F.G * 512) {
        const int c8 = it & 7, h = (it >> 3) & 7, t = it >> 6;
        const float l0 = LSE[((size_t)0 * T + t) * 8 + h], l1 = LSE[((size_t)1 * T + t) * 8 + h], l2 = LSE[((size_t)2 * T + t) * 8 + h];
        const float m = fmaxf(l0, fmaxf(l1, l2)); float w0 = __expf(l0 - m), w1 = __expf(l1 - m), w2 = __expf(l2 - m); const float inv = 1.0f / (w0 + w1 + w2); w0 *= inv; w1 *= inv; w2 *= inv;
        float a[8], bq[8], c[8], o[8]; const size_t off = (size_t)t * DILW + h * 64 + c8 * 8;
        unpack8(*(const v4u*)(OG + off), a); unpack8(*(const v4u*)(OG + (size_t)T * DILW + off), bq); unpack8(*(const v4u*)(OG + (size_t)2 * T * DILW + off), c);
#pragma unroll
        for (int q = 0; q < 8; ++q) o[q] = w0 * a[q] + w1 * bq[q] + w2 * c[q];
        v4u ww; ww.x = pk2(o[0], o[1]); ww.y = pk2(o[2], o[3]); ww.z = pk2(o[4], o[5]); ww.w = pk2(o[6], o[7]);
        *(v4u*)(O + off) = ww;
    }
}

constexpr int M1_LOG = 131072, M1_STAT = M1_LOG + 4096, M1_HIST = M1_STAT + 128, M1_BASE = M1_HIST + 256;
__device__ __forceinline__ void phase_moe1(const Frame& F, const float* Y, const float* gain, const float* bias, const float* RW, const float* RB,
                                           float* X1F, bf16* X1B, unsigned* cnt, int* ltok, float* lgate, int* eidx, int* inv) {
    LAS float* xs = (LAS float*)F.lds; LAS float* logit = (LAS float*)(F.lds + M1_LOG); LAS float* stat = (LAS float*)(F.lds + M1_STAT);
    LAS int* hist = (LAS int*)(F.lds + M1_HIST); LAS int* basep = (LAS int*)(F.lds + M1_BASE);
    const int tid = F.tid, lane = F.lane, w = F.wave;
    for (int rg = F.bid; rg < T / 16; rg += F.G) {
        const int row0 = rg * 16;
        __syncthreads();
#pragma unroll
        for (int j = 0; j < 16; ++j) { const int idx = tid + 512 * j; *(LAS f32x4*)(xs + idx * 4) = *(const f32x4*)(Y + (size_t)row0 * D + (size_t)idx * 4); }
        if (tid < 64) hist[tid] = 0;
        __syncthreads();
#pragma unroll
        for (int rr = 0; rr < 2; ++rr) { const int r = 2 * w + rr; float sm = 0.f;
#pragma unroll
            for (int j = 0; j < 32; ++j) sm += xs[r * D + lane + 64 * j];
            const float mean = wave_sum(sm, lane) * (1.0f / D); float sq = 0.f;
#pragma unroll
            for (int j = 0; j < 32; ++j) { const float d = xs[r * D + lane + 64 * j] - mean; sq += d * d; }
            const float rstd = 1.0f / sqrtf(wave_sum(sq, lane) * (1.0f / D) + LN_EPS);
            if (lane == 0) { stat[2 * r] = mean; stat[2 * r + 1] = rstd; } }
        __syncthreads();
#pragma unroll
        for (int j = 0; j < 16; ++j) { const int idx = tid + 512 * j, r = idx >> 9, c4 = (idx & 511) * 4;
            const f32x4 v = *(LAS f32x4*)(xs + idx * 4), gv = *(const f32x4*)(gain + c4), bv = *(const f32x4*)(bias + c4);
            const float mean = stat[2 * r], rstd = stat[2 * r + 1];
            const f32x4 o = (v - mean) * rstd * gv + bv;
            *(LAS f32x4*)(xs + idx * 4) = o;
            *(f32x4*)(X1F + (size_t)(row0 + r) * D + c4) = o;
            v2u wb; wb.x = pk2(o[0], o[1]); wb.y = pk2(o[2], o[3]); *(v2u*)(X1B + (size_t)(row0 + r) * D + c4) = wb; }
        __syncthreads();
        { const int r = tid >> 5, ep = tid & 31; float a0 = 0.f, a1 = 0.f; const float* wp = RW + 2 * ep; const LAS float* xr = xs + r * D;
            for (int k0 = 0; k0 < D; k0 += 16) {
                f32x2 wv[16];
#pragma unroll
                for (int j = 0; j < 16; ++j) wv[j] = *(const f32x2*)(wp + (size_t)(k0 + j) * NEXP);
                asm volatile("" : "+v"(wv[0]), "+v"(wv[1]), "+v"(wv[2]), "+v"(wv[3]), "+v"(wv[4]), "+v"(wv[5]), "+v"(wv[6]), "+v"(wv[7]));
                asm volatile("" : "+v"(wv[8]), "+v"(wv[9]), "+v"(wv[10]), "+v"(wv[11]), "+v"(wv[12]), "+v"(wv[13]), "+v"(wv[14]), "+v"(wv[15]));
#pragma unroll
                for (int j = 0; j < 16; ++j) { const float xv = xr[k0 + j]; a0 += xv * wv[j].x; a1 += xv * wv[j].y; } }
            logit[r * NEXP + 2 * ep] = a0; logit[r * NEXP + 2 * ep + 1] = a1; }
        __syncthreads();
        int sel_pos[2]; float sel_gate[2]; int sel_rank[2]; bool sel_on[2];
#pragma unroll
        for (int rr = 0; rr < 2; ++rr) { const int r = 2 * w + rr;
            const float sc = 1.0f / (1.0f + __expf(-logit[r * NEXP + lane])); const float ch = sc + RB[lane];
            int rk = 0;
#pragma unroll
            for (int j = 0; j < 8; ++j) { const float cj = shfl_from(ch, (lane & ~7) + j); rk += (cj > ch || (cj == ch && j < (lane & 7))) ? 1 : 0; }
            float gs = rk < 2 ? ch : 0.f; gs += shfl_x(gs, 1, lane); gs += shfl_x(gs, 2, lane); gs += shfl_x(gs, 4, lane);
            int grk = 0; const int g = lane >> 3;
#pragma unroll
            for (int hh = 0; hh < 8; ++hh) { const float gh = shfl_from(gs, 8 * hh); grk += (gh > gs || (gh == gs && hh < g)) ? 1 : 0; }
            const float msk = grk < 4 ? ch : -INFINITY;
            int erk = 0;
            for (int j = 0; j < 64; ++j) { const float mj = __builtin_bit_cast(float, __builtin_amdgcn_readlane(__builtin_bit_cast(int, msk), j)); erk += (mj > msk || (mj == msk && j < lane)) ? 1 : 0; }
            const bool on = erk < 8;
            const float ssum = wave_sum(on ? sc : 0.f, lane);
            sel_on[rr] = on; sel_rank[rr] = erk; sel_gate[rr] = sc / ssum * 2.5f; sel_pos[rr] = 0;
            if (on) sel_pos[rr] = __hip_atomic_fetch_add(&hist[lane], 1, __ATOMIC_RELAXED, __HIP_MEMORY_SCOPE_WORKGROUP); }
        __syncthreads();
        if (tid < 64) { const int hc = hist[tid]; int bs = 0; if (hc > 0) bs = (int)atomicAdd(&cnt[tid * 16], (unsigned)hc); basep[tid] = bs; }
        __syncthreads();
#pragma unroll
        for (int rr = 0; rr < 2; ++rr) if (sel_on[rr]) { const int t = row0 + 2 * w + rr, pos = basep[lane] + sel_pos[rr];
            ltok[(size_t)lane * CAP + pos] = t; lgate[(size_t)lane * CAP + pos] = sel_gate[rr];
            eidx[t * 8 + sel_rank[rr]] = lane; inv[t * 8 + sel_rank[rr]] = pos; }
    }
}
__device__ __forceinline__ int build_tiles(const Frame& F, const unsigned* cnt) {
    LAS int* tpref = (LAS int*)(F.lds + LDS_TAB); LAS int* cl = (LAS int*)(F.lds + LDS_TAB + 512);
    __syncthreads();
    if (F.tid < 64) cl[F.tid] = (int)__hip_atomic_load(&cnt[F.tid * 16], __ATOMIC_RELAXED, __HIP_MEMORY_SCOPE_AGENT);
    __syncthreads();
    if (F.tid == 0) { int acc = 0; for (int e = 0; e < 64; ++e) { tpref[e] = acc; acc += (cl[e] + 255) >> 8; } tpref[64] = acc; }
    __syncthreads();
    return __builtin_amdgcn_readfirstlane(tpref[64]);
}
__device__ __forceinline__ void phase_moe4(const Frame& F, const float* Y2, const bf16* Yr, const int* eidx, const int* inv, const float* gain, const float* bias, float* XO, bf16* XBo) {
    const LAS int* tpref = (const LAS int*)(F.lds + LDS_TAB);
    const int gw = F.bid * 8 + F.wave, NGW = F.G * 8, lane = F.lane;
    for (int t = gw; t < T; t += NGW) {
        f32x4 v[8];
#pragma unroll
        for (int j = 0; j < 8; ++j) v[j] = *(const f32x4*)(Y2 + (size_t)t * D + 4 * lane + 256 * j);
        for (int k = 0; k < 8; ++k) { const int e = eidx[t * 8 + k], pos = inv[t * 8 + k]; const bf16* yr = Yr + (size_t)(tpref[e] * 256 + pos) * D + 4 * lane;
#pragma unroll
            for (int j = 0; j < 8; ++j) { const v2u w = *(const v2u*)(yr + 256 * j); v[j][0] += bflo(w.x); v[j][1] += bfhi(w.x); v[j][2] += bflo(w.y); v[j][3] += bfhi(w.y); } }
        float sm = 0.f;
#pragma unroll
        for (int j = 0; j < 8; ++j) sm += (v[j][0] + v[j][1]) + (v[j][2] + v[j][3]);
        const float mean = wave_sum(sm, lane) * (1.0f / D); float sq = 0.f;
#pragma unroll
        for (int j = 0; j < 8; ++j) { v[j] = v[j] - mean; sq += (v[j][0] * v[j][0] + v[j][1] * v[j][1]) + (v[j][2] * v[j][2] + v[j][3] * v[j][3]); }
        const float rstd = 1.0f / sqrtf(wave_sum(sq, lane) * (1.0f / D) + LN_EPS);
#pragma unroll
        for (int j = 0; j < 8; ++j) { const int c = 4 * lane + 256 * j; const f32x4 o = v[j] * rstd * *(const f32x4*)(gain + c) + *(const f32x4*)(bias + c);
            *(f32x4*)(XO + (size_t)t * D + c) = o;
            v2u wb; wb.x = pk2(o[0], o[1]); wb.y = pk2(o[2], o[3]); *(v2u*)(XBo + (size_t)t * D + c) = wb; }
    }
}


constexpr int M1_P = 0, M1N_HIST = 32768, M1N_BASE = 32768 + 256;
__device__ __forceinline__ void phase_moe1n(const Frame& F, const bf16* Y, const float* pst, const float* gain, const float* bias, const bf16* WH, const bf16* WL, const float* RB,
                                            bf16* X1B, float* ST1, unsigned* cnt, int* ltok, float* lgate, int* eidx, int* inv) {
    LAS float* P = (LAS float*)(F.lds + M1_P); LAS int* hist = (LAS int*)(F.lds + M1N_HIST); LAS int* basep = (LAS int*)(F.lds + M1N_BASE);
    const int tid = F.tid, lane = F.lane, w = F.wave, r = lane & 15, q = lane >> 4, pr = w >> 1, kh = w & 1;
    for (int item = F.bid; item < T / 64; item += F.G) {
        const int row0 = item * 64, row = row0 + 16 * pr + r;
        __syncthreads();
        if (tid < 64) hist[tid] = 0;
        float mean, rstd;
        { const f32x4* pp = (const f32x4*)(pst + ((size_t)row * 32 + q * 8) * 2); const f32x4 a = pp[0], b = pp[1], c = pp[2], d = pp[3];
          float sm = (a[0] + a[2]) + (b[0] + b[2]) + (c[0] + c[2]) + (d[0] + d[2]), sq = (a[1] + a[3]) + (b[1] + b[3]) + (c[1] + c[3]) + (d[1] + d[3]);
          sm += shfl_x(sm, 16, lane); sm += shfl_x(sm, 32, lane); sq += shfl_x(sq, 16, lane); sq += shfl_x(sq, 32, lane);
          mean = sm * (1.0f / D); const float var = fmaxf(sq * (1.0f / D) - mean * mean, 0.f); rstd = 1.0f / sqrtf(var + LN_EPS);
          if (kh == 0 && q == 0) *(f32x2*)(ST1 + 2 * row) = (f32x2){mean, rstd}; }
        const bf16* yp = Y + (size_t)row * D + kh * 1024 + 8 * q; const float* gp = gain + kh * 1024 + 8 * q; const float* bp = bias + kh * 1024 + 8 * q;
        const bf16* whp = WH + (size_t)r * D + kh * 1024 + 8 * q; const bf16* wlp = WL + (size_t)r * D + kh * 1024 + 8 * q;
        bf16* xo = X1B + (size_t)row * D + kh * 1024 + 8 * q;
        f32x4 acc[4];
#pragma unroll
        for (int nt = 0; nt < 4; ++nt) acc[nt] = (f32x4){0.f, 0.f, 0.f, 0.f};
#define M1_LOAD(S, st) do { const int _k = 32 * (st); S##yb = *(const v4u*)(yp + _k); S##g0 = *(const f32x4*)(gp + _k); S##g1 = *(const f32x4*)(gp + _k + 4); \
            S##b0 = *(const f32x4*)(bp + _k); S##b1 = *(const f32x4*)(bp + _k + 4); \
            _Pragma("unroll") for (int nt = 0; nt < 4; ++nt) { S##wh[nt] = *(const bf16x8*)(whp + (size_t)nt * 16 * D + _k); S##wl[nt] = *(const bf16x8*)(wlp + (size_t)nt * 16 * D + _k); } } while (0)
#define M1_COMP(S, st) do { const f32x4 S##y0 = (f32x4){bflo(S##yb.x), bfhi(S##yb.x), bflo(S##yb.y), bfhi(S##yb.y)}, S##y1 = (f32x4){bflo(S##yb.z), bfhi(S##yb.z), bflo(S##yb.w), bfhi(S##yb.w)}; \
            const f32x4 x0 = (S##y0 - mean) * rstd * S##g0 + S##b0, x1 = (S##y1 - mean) * rstd * S##g1 + S##b1; \
            v4u h; h.x = cvt_pk_bf16(x0[0], x0[1]); h.y = cvt_pk_bf16(x0[2], x0[3]); h.z = cvt_pk_bf16(x1[0], x1[1]); h.w = cvt_pk_bf16(x1[2], x1[3]); \
            *(v4u*)(xo + 32 * (st)) = h; \
            v4u l; l.x = cvt_pk_bf16(x0[0] - bflo(h.x), x0[1] - bfhi(h.x)); l.y = cvt_pk_bf16(x0[2] - bflo(h.y), x0[3] - bfhi(h.y)); \
            l.z = cvt_pk_bf16(x1[0] - bflo(h.z), x1[1] - bfhi(h.z)); l.w = cvt_pk_bf16(x1[2] - bflo(h.w), x1[3] - bfhi(h.w)); \
            const bf16x8 xh = __builtin_bit_cast(bf16x8, h), xl = __builtin_bit_cast(bf16x8, l); \
            _Pragma("unroll") for (int nt = 0; nt < 4; ++nt) { acc[nt] = __builtin_amdgcn_mfma_f32_16x16x32_bf16(xh, S##wh[nt], acc[nt], 0, 0, 0); \
                acc[nt] = __builtin_amdgcn_mfma_f32_16x16x32_bf16(xl, S##wh[nt], acc[nt], 0, 0, 0); acc[nt] = __builtin_amdgcn_mfma_f32_16x16x32_bf16(xh, S##wl[nt], acc[nt], 0, 0, 0); } } while (0)
        v4u Ayb, Byb; f32x4 Ag0, Ag1, Ab0, Ab1, Bg0, Bg1, Bb0, Bb1; bf16x8 Awh[4], Awl[4], Bwh[4], Bwl[4];
        M1_LOAD(A, 0);
        __builtin_amdgcn_sched_barrier(0);
#pragma unroll 1
        for (int st = 0; st < 32; st += 2) {
            M1_LOAD(B, st + 1);
            __builtin_amdgcn_sched_barrier(0);
            M1_COMP(A, st);
            __builtin_amdgcn_sched_barrier(0);
            if (st + 2 < 32) M1_LOAD(A, st + 2);
            __builtin_amdgcn_sched_barrier(0);
            M1_COMP(B, st + 1);
            __builtin_amdgcn_sched_barrier(0);
        }
#undef M1_LOAD
#undef M1_COMP
#pragma unroll
        for (int nt = 0; nt < 4; ++nt)
#pragma unroll
            for (int i = 0; i < 4; ++i) P[(kh * 64 + 16 * pr + 4 * q + i) * 64 + 16 * nt + r] = acc[nt][i];
        __syncthreads();
        int sel_pos[8]; float sel_gate[8]; int sel_rank[8]; bool sel_on[8];
        const float rb = RB[lane];
#pragma unroll
        for (int rr = 0; rr < 8; ++rr) { const int rl = 8 * w + rr;
            float lg = P[rl * 64 + lane] + P[(64 + rl) * 64 + lane]; lg = (lg == lg) ? lg : -1.0e30f;
            const float sc = 1.0f / (1.0f + __expf(-lg)); const float ch = sc + rb;
            int rk = 0;
#pragma unroll
            for (int j = 0; j < 8; ++j) { const float cj = shfl_from(ch, (lane & ~7) + j); rk += (cj > ch || (cj == ch && j < (lane & 7))) ? 1 : 0; }
            float gs = rk < 2 ? ch : 0.f; gs += shfl_x(gs, 1, lane); gs += shfl_x(gs, 2, lane); gs += shfl_x(gs, 4, lane);
            int grk = 0; const int g = lane >> 3;
#pragma unroll
            for (int hh = 0; hh < 8; ++hh) { const float gh = shfl_from(gs, 8 * hh); grk += (gh > gs || (gh == gs && hh < g)) ? 1 : 0; }
            const float msk = grk < 4 ? ch : -INFINITY;
            int erk = 0;
            for (int j = 0; j < 64; ++j) { const float mj = __builtin_bit_cast(float, __builtin_amdgcn_readlane(__builtin_bit_cast(int, msk), j)); erk += (mj > msk || (mj == msk && j < lane)) ? 1 : 0; }
            const bool on = erk < 8;
            const float ssum = wave_sum(on ? sc : 0.f, lane);
            sel_on[rr] = on; sel_rank[rr] = erk; sel_gate[rr] = sc / ssum * 2.5f; sel_pos[rr] = 0;
            if (on) sel_pos[rr] = __hip_atomic_fetch_add(&hist[lane], 1, __ATOMIC_RELAXED, __HIP_MEMORY_SCOPE_WORKGROUP); }
        __syncthreads();
        if (tid < 64) { const int hc = hist[tid]; int bs = 0; if (hc > 0) bs = (int)atomicAdd(&cnt[tid * 16], (unsigned)hc); basep[tid] = bs; }
        __syncthreads();
#pragma unroll
        for (int rr = 0; rr < 8; ++rr) if (sel_on[rr]) { const int t = row0 + 8 * w + rr, pos = basep[lane] + sel_pos[rr];
            ltok[(size_t)lane * CAP + pos] = t * 8 + sel_rank[rr]; lgate[(size_t)lane * CAP + pos] = sel_gate[rr];
            eidx[t * 8 + sel_rank[rr]] = lane; inv[t * 8 + sel_rank[rr]] = pos; }
    }
}

constexpr int M3_PL = 131072, M3_CNT = 147456, M3_OFF = 147456 + 272;
__device__ __forceinline__ void phase_moe3n(const Frame& F, const bf16* H, const bf16* HSp, const int* eidx, const bf16* WD, const bf16* WSD,
                                            const float* Y1, const float* ST1, const float* g1, const float* b1, float* Y2, float* PST2) {
    LAS int* out = (LAS int*)F.lds; LAS unsigned short* plist = (LAS unsigned short*)(F.lds + M3_PL); LAS int* cnt = (LAS int*)(F.lds + M3_CNT); LAS int* off = (LAS int*)(F.lds + M3_OFF);
    const int tid = F.tid, lane = F.lane, w = F.wave, r = lane & 15, q = lane >> 4;
    for (int u = F.bid; u < 1024; u += F.G) {
        int nc = (u & 7) | ((u >> 7) << 3), tb = (u >> 3) & 15;
        if (F.G == 256) { const int i = u >> 8, x = u & 7, j = (u >> 3) & 31; tb = 2 * x + (i >> 1); nc = 32 * (i & 1) + j; }
        __syncthreads();
#pragma unroll
        for (int j = 0; j < 16; ++j) ((LAS v4u*)out)[tid + 512 * j] = (v4u){0u, 0u, 0u, 0u};
        if (tid < 66) cnt[tid] = 0;
        __syncthreads();
        int ee[16], pp[16];
        { const v4u* ep = (const v4u*)(eidx + ((size_t)tb * 1024 + 2 * tid) * 8); const v4u e0 = ep[0], e1 = ep[1], e2 = ep[2], e3 = ep[3];
          ee[0] = e0.x; ee[1] = e0.y; ee[2] = e0.z; ee[3] = e0.w; ee[4] = e1.x; ee[5] = e1.y; ee[6] = e1.z; ee[7] = e1.w;
          ee[8] = e2.x; ee[9] = e2.y; ee[10] = e2.z; ee[11] = e2.w; ee[12] = e3.x; ee[13] = e3.y; ee[14] = e3.z; ee[15] = e3.w; }
#pragma unroll
        for (int j = 0; j < 16; ++j) pp[j] = __hip_atomic_fetch_add(&cnt[ee[j]], 1, __ATOMIC_RELAXED, __HIP_MEMORY_SCOPE_WORKGROUP);
        __syncthreads();
        if (w == 0) { int c = cnt[lane], x = c;
#pragma unroll
            for (int o = 1; o < 64; o <<= 1) { const int y = __builtin_amdgcn_ds_bpermute(((lane - o) & 63) << 2, x); if (lane >= o) x += y; }
            off[lane] = x - c; if (lane == 63) off[64] = x; }
        __syncthreads();
#pragma unroll
        for (int j = 0; j < 16; ++j) plist[off[ee[j]] + pp[j]] = (unsigned short)(tid * 16 + j);
        __syncthreads();
        const char* Hb = (const char*)H + (size_t)tb * 8192 * 256 + q * 16;
        const char* HSb = (const char*)HSp + (size_t)tb * 1024 * 512 + q * 16;
        const char* Bb = (const char*)WD + ((size_t)nc * 32 + r) * 256 + q * 16;
        const char* BSb = (const char*)WSD + ((size_t)nc * 32 + r) * 512 + q * 16;
#define M3_NR(sg) ((sg) < 8 ? __builtin_amdgcn_readfirstlane(cnt[w + 8 * (sg)]) : 128)
#define M3_RB(sg) ((sg) < 8 ? __builtin_amdgcn_readfirstlane(off[w + 8 * (sg)]) : 0)
#define M3_GLD(dst, ptr, OFF) asm volatile("global_load_dwordx4 %0, %1, off offset:" #OFF : "=&v"(dst) : "v"(ptr) : "memory")
#define M3_LOADB(dst, sg) do { const char* _b0 = (sg) < 8 ? Bb + (size_t)(w + 8 * (sg)) * 524288 : BSb + ((sg) - 8) * 256; const char* _b1 = _b0 + ((sg) < 8 ? 4096 : 8192); \
            M3_GLD(dst[0][0], _b0, 0); M3_GLD(dst[0][1], _b0, 64); M3_GLD(dst[0][2], _b0, 128); M3_GLD(dst[0][3], _b0, 192); \
            M3_GLD(dst[1][0], _b1, 0); M3_GLD(dst[1][1], _b1, 64); M3_GLD(dst[1][2], _b1, 128); M3_GLD(dst[1][3], _b1, 192); } while (0)
#define M3_LOADA(dst, sg, bb, nr, rbs) do { int _i = 16 * (bb) + r; _i = _i < (nr) ? _i : (nr) - 1; const unsigned _rid = plist[(rbs) + _i]; \
            const char* _a = (sg) < 8 ? Hb + (size_t)_rid * 256 : ((sg) < 10 ? HSb + (size_t)(128 * w + _i) * 512 + ((sg) - 8) * 256 : Hb); \
            M3_GLD(dst[0], _a, 0); M3_GLD(dst[1], _a, 64); M3_GLD(dst[2], _a, 128); M3_GLD(dst[3], _a, 192); } while (0)
#define M3_ADV(sg, bb, nr, rbs) do { if ((sg) < 10) { ++(bb); if ((bb) * 16 >= (nr)) { (bb) = 0; do { ++(sg); } while ((sg) < 8 && M3_NR(sg) == 0); if ((sg) < 10) { (nr) = M3_NR(sg); (rbs) = M3_RB(sg); } } } } while (0)
#define M3_WAITA(AS) asm volatile("s_waitcnt vmcnt(12)" : "+v"(AS[0]), "+v"(AS[1]), "+v"(AS[2]), "+v"(AS[3]) :: "memory")
#define M3_WAITB(N) asm volatile("s_waitcnt vmcnt(" #N ")" : "+v"(Bn[0][0]), "+v"(Bn[0][1]), "+v"(Bn[0][2]), "+v"(Bn[0][3]), "+v"(Bn[1][0]), "+v"(Bn[1][1]), "+v"(Bn[1][2]), "+v"(Bn[1][3]) :: "memory")
#define M3_STEP(AS) if (cseg < 10) { \
              \
            int tk[4]; bool ok[4]; unsigned pl[4]; const int rt_ = cseg < 8; \
            _Pragma("unroll") for (int i = 0; i < 4; ++i) { const int idx = 16 * cbt + 4 * q + i; ok[i] = idx < cnr; const int ic = ok[i] ? idx : cnr - 1; pl[i] = plist[crbs + ic]; tk[i] = 128 * w + ic; } \
            _Pragma("unroll") for (int i = 0; i < 4; ++i) tk[i] = rt_ ? (int)(pl[i] >> 3) : tk[i]; \
            M3_WAITA(AS); \
            f32x4 acc[2]; \
            _Pragma("unroll") for (int nt = 0; nt < 2; ++nt) { acc[nt] = (f32x4){0.f, 0.f, 0.f, 0.f}; \
                _Pragma("unroll") for (int kk = 0; kk < 4; ++kk) acc[nt] = __builtin_amdgcn_mfma_f32_16x16x32_bf16(__builtin_bit_cast(bf16x8, AS[kk]), __builtin_bit_cast(bf16x8, Bc[nt][kk]), acc[nt], 0, 0, 0); } \
              \
            _Pragma("unroll") for (int i = 0; i < 4; ++i) { const long long lo_ = ok[i] ? (long long)__float2int_rn(acc[0][i] * 4194304.0f) : 0ll, hi_ = ok[i] ? (long long)__float2int_rn(acc[1][i] * 4194304.0f) : 0ll; \
                (void)__hip_atomic_fetch_add((LAS unsigned long long*)out + tk[i] * 16 + r, (unsigned long long)((hi_ << 32) + lo_), __ATOMIC_RELAXED, __HIP_MEMORY_SCOPE_WORKGROUP); } \
            M3_LOADA(AS, pseg, pbt, pnr, prbs); M3_ADV(pseg, pbt, pnr, prbs); \
            { const int old_ = cseg, nbat_ = (cnr + 15) >> 4; M3_ADV(cseg, cbt, cnr, crbs); \
              if (cseg != old_ && cseg < 10) { \
                  if (nbat_ == 1) M3_WAITB(4); else if (nbat_ == 2) M3_WAITB(8); else if (nbat_ == 3) M3_WAITB(12); else M3_WAITB(16); \
                  _Pragma("unroll") for (int nt = 0; nt < 2; ++nt) _Pragma("unroll") for (int kk = 0; kk < 4; ++kk) Bc[nt][kk] = Bn[nt][kk]; \
                  int nb_ = cseg; do { ++nb_; } while (nb_ < 8 && M3_NR(nb_) == 0); if (nb_ >= 10) nb_ = 9; M3_LOADB(Bn, nb_); } } }
        int cseg = -1, cbt = 0, cnr = 0, crbs = 0;
        do { ++cseg; } while (cseg < 8 && M3_NR(cseg) == 0);
        cnr = M3_NR(cseg); crbs = M3_RB(cseg);
        int pseg = cseg, pbt = 0, pnr = cnr, prbs = crbs;
        v4u Bc[2][4], Bn[2][4], A0[4], A1[4], A2[4], A3[4];
        M3_LOADB(Bc, cseg);
        M3_LOADA(A0, pseg, pbt, pnr, prbs); M3_ADV(pseg, pbt, pnr, prbs);
        M3_LOADA(A1, pseg, pbt, pnr, prbs); M3_ADV(pseg, pbt, pnr, prbs);
        M3_LOADA(A2, pseg, pbt, pnr, prbs); M3_ADV(pseg, pbt, pnr, prbs);
        M3_LOADA(A3, pseg, pbt, pnr, prbs); M3_ADV(pseg, pbt, pnr, prbs);
        { int nb_ = cseg; do { ++nb_; } while (nb_ < 8 && M3_NR(nb_) == 0); if (nb_ >= 10) nb_ = 9; M3_LOADB(Bn, nb_); }
        asm volatile("s_waitcnt vmcnt(0)" : "+v"(Bc[0][0]), "+v"(Bc[0][1]), "+v"(Bc[0][2]), "+v"(Bc[0][3]), "+v"(Bc[1][0]), "+v"(Bc[1][1]), "+v"(Bc[1][2]), "+v"(Bc[1][3]) :: "memory");
#pragma unroll 1
        while (cseg < 10) { M3_STEP(A0) M3_STEP(A1) M3_STEP(A2) M3_STEP(A3) }
        asm volatile("s_waitcnt vmcnt(0)" : "+v"(A0[0]), "+v"(A0[1]), "+v"(A0[2]), "+v"(A0[3]), "+v"(A1[0]), "+v"(A1[1]), "+v"(A1[2]), "+v"(A1[3]), "+v"(A2[0]), "+v"(A2[1]), "+v"(A2[2]), "+v"(A2[3]),
                     "+v"(A3[0]), "+v"(A3[1]), "+v"(A3[2]), "+v"(A3[3]), "+v"(Bn[0][0]), "+v"(Bn[0][1]), "+v"(Bn[0][2]), "+v"(Bn[0][3]), "+v"(Bn[1][0]), "+v"(Bn[1][1]), "+v"(Bn[1][2]), "+v"(Bn[1][3]) :: "memory");
#undef M3_NR
#undef M3_RB
#undef M3_GLD
#undef M3_LOADB
#undef M3_LOADA
#undef M3_ADV
#undef M3_WAITA
#undef M3_WAITB
#undef M3_STEP
        __syncthreads();
        { const int c4 = lane & 7, rs = lane >> 3, col = nc * 32 + 4 * c4;
          const f32x4 gv = *(const f32x4*)(g1 + col), bv = *(const f32x4*)(b1 + col);
#pragma unroll 4
          for (int it = 0; it < 16; ++it) { const int rl = 128 * w + 8 * it + rs; const size_t row = (size_t)tb * 1024 + rl;
              const f32x4 yv = *(const f32x4*)(Y1 + row * D + col); const f32x2 sv = *(const f32x2*)(ST1 + 2 * row);
              f32x4 tv; { const int nt = c4 >> 2, r0 = (4 * c4) & 15;
#pragma unroll
                  for (int j = 0; j < 4; ++j) { const v2u cell = *(const LAS v2u*)(out + rl * 32 + 2 * (r0 + j)); const int lo = (int)cell.x, hi = (int)cell.y + (lo < 0 ? 1 : 0); tv[j] = (float)(nt ? hi : lo) * (1.0f / 4194304.0f); } }
              const f32x4 y = ((yv - sv.x) * sv.y * gv + bv) * ALPHA + tv;
              *(f32x4*)(Y2 + row * D + col) = y;
              float sm = (y[0] + y[1]) + (y[2] + y[3]), sq = (y[0] * y[0] + y[1] * y[1]) + (y[2] * y[2] + y[3] * y[3]);
#pragma unroll
              for (int o = 1; o < 8; o <<= 1) { sm += shfl_x(sm, o, lane); sq += shfl_x(sq, o, lane); }
              if (c4 == 0) *(f32x2*)(PST2 + (row * 64 + nc) * 2) = (f32x2){sm, sq}; } }
    }
}

__device__ __forceinline__ void phase_moe4n(const Frame& F, const float* Y2, const float* pst, const float* gain, const float* bias, float* ST2, bf16* XBo, float* OUT, int last) {
    const int gw = F.bid * 8 + F.wave, NGW = F.G * 8, lane = F.lane;
    for (int t = gw; t < T; t += NGW) {
        f32x4 v[8];
#pragma unroll
        for (int j = 0; j < 8; ++j) v[j] = *(const f32x4*)(Y2 + (size_t)t * D + 4 * lane + 256 * j);
        const f32x2 pv = *(const f32x2*)(pst + ((size_t)t * 64 + lane) * 2);
        const float mean = wave_sum(pv.x, lane) * (1.0f / D); const float var = fmaxf(wave_sum(pv.y, lane) * (1.0f / D) - mean * mean, 0.f); const float rstd = 1.0f / sqrtf(var + LN_EPS);
        if (lane == 0) *(f32x2*)(ST2 + 2 * (size_t)t) = (f32x2){mean, rstd};
#pragma unroll
        for (int j = 0; j < 8; ++j) { const int c = 4 * lane + 256 * j; const f32x4 o = (v[j] - mean) * rstd * *(const f32x4*)(gain + c) + *(const f32x4*)(bias + c);
            if (last) *(f32x4*)(OUT + (size_t)t * D + c) = o;
            else { v2u wb; wb.x = pk2(o[0], o[1]); wb.y = pk2(o[2], o[3]); *(v2u*)(XBo + (size_t)t * D + c) = wb; } }
    }
}


__device__ __forceinline__ void phase_moe4q(const Frame& F, bf16* Y2, const unsigned char* Yq, const float* Ysc, const int* eidx, const int* inv, const float* gain, const float* bias, float* ST2, bf16* XBo, float* OUT, int last) {
    const LAS int* tpref = (const LAS int*)(F.lds + LDS_TAB);
    const int gw = F.bid * 8 + F.wave, NGW = F.G * 8, lane = F.lane;
    for (int t = gw; t < T; t += NGW) {
        int rowi = 0; if (lane < 8) { const int e = eidx[t * 8 + lane], ps = inv[t * 8 + lane]; rowi = tpref[e] * 256 + ps; }
        v4u pv[2][2], yv[8][2]; float sc[8][2];
#pragma unroll
        for (int j = 0; j < 2; ++j) { pv[j][0] = *(const v4u*)(Y2 + (size_t)t * D + 16 * lane + 1024 * j); pv[j][1] = *(const v4u*)(Y2 + (size_t)t * D + 16 * lane + 1024 * j + 8); }
#pragma unroll
        for (int k = 0; k < 8; ++k) { const size_t row = (size_t)__builtin_amdgcn_readlane(rowi, k);
#pragma unroll
            for (int j = 0; j < 2; ++j) { yv[k][j] = *(const v4u*)(Yq + row * D + 16 * lane + 1024 * j); sc[k][j] = Ysc[row * 16 + 8 * j + (lane >> 3)]; } }
#pragma unroll
        for (int k = 0; k < 8; ++k) asm volatile("" : "+v"(yv[k][0]), "+v"(yv[k][1]), "+v"(sc[k][0]), "+v"(sc[k][1]));
        float v[2][16];
#pragma unroll
        for (int j = 0; j < 2; ++j) { float f0[8], f1[8]; unpack8(pv[j][0], f0); unpack8(pv[j][1], f1);
            const float ss = ((sc[0][j] + sc[1][j]) + (sc[2][j] + sc[3][j])) + ((sc[4][j] + sc[5][j]) + (sc[6][j] + sc[7][j]));
#pragma unroll
            for (int i = 0; i < 8; ++i) { v[j][i] = f0[i] - 128.f * ss; v[j][8 + i] = f1[i] - 128.f * ss; } }
#pragma unroll
        for (int k = 0; k < 8; ++k)
#pragma unroll
            for (int j = 0; j < 2; ++j) { const float s_ = sc[k][j]; const unsigned q[4] = {yv[k][j].x, yv[k][j].y, yv[k][j].z, yv[k][j].w};
#pragma unroll
                for (int d = 0; d < 4; ++d) { v[j][4 * d + 0] += s_ * (float)(q[d] & 0xffu); v[j][4 * d + 1] += s_ * (float)((q[d] >> 8) & 0xffu); v[j][4 * d + 2] += s_ * (float)((q[d] >> 16) & 0xffu); v[j][4 * d + 3] += s_ * (float)(q[d] >> 24); } }
        float sm = 0.f;
#pragma unroll
        for (int j = 0; j < 2; ++j)
#pragma unroll
            for (int i = 0; i < 16; i += 4) sm += (v[j][i] + v[j][i + 1]) + (v[j][i + 2] + v[j][i + 3]);
        const float mean = wave_sum(sm, lane) * (1.0f / D); float sq = 0.f;
#pragma unroll
        for (int j = 0; j < 2; ++j)
#pragma unroll
            for (int i = 0; i < 16; ++i) { const float d = v[j][i] - mean; sq += d * d; }
        const float rstd = 1.0f / sqrtf(wave_sum(sq, lane) * (1.0f / D) + LN_EPS);
        if (lane == 0) *(f32x2*)(ST2 + 2 * (size_t)t) = (f32x2){mean, rstd};
#pragma unroll
        for (int j = 0; j < 2; ++j)
#pragma unroll
            for (int h = 0; h < 2; ++h) { const int c = 16 * lane + 1024 * j + 8 * h; const float* vv = &v[j][8 * h];
                if (!last) { v4u yw; yw.x = pk2(vv[0], vv[1]); yw.y = pk2(vv[2], vv[3]); yw.z = pk2(vv[4], vv[5]); yw.w = pk2(vv[6], vv[7]); *(v4u*)(Y2 + (size_t)t * D + c) = yw; }
                const f32x4 g0 = *(const f32x4*)(gain + c), g1 = *(const f32x4*)(gain + c + 4), b0 = *(const f32x4*)(bias + c), b1 = *(const f32x4*)(bias + c + 4);
                const f32x4 o0 = ((f32x4){vv[0], vv[1], vv[2], vv[3]} - mean) * rstd * g0 + b0, o1 = ((f32x4){vv[4], vv[5], vv[6], vv[7]} - mean) * rstd * g1 + b1;
                if (last) { *(f32x4*)(OUT + (size_t)t * D + c) = o0; *(f32x4*)(OUT + (size_t)t * D + c + 4) = o1; }
                else { v4u wb; wb.x = pk2(o0[0], o0[1]); wb.y = pk2(o0[2], o0[3]); wb.z = pk2(o1[0], o1[1]); wb.w = pk2(o1[2], o1[3]); *(v4u*)(XBo + (size_t)t * D + c) = wb; } }
    }
}

__device__ __forceinline__ void phase_downproj3(const Frame& F, const bf16* H, const bf16* WD, unsigned char* Yq, float* Ysc, int NT) {
    const LAS int* tpref = (const LAS int*)(F.lds + LDS_TAB); const LAS int* cl = (const LAS int*)(F.lds + LDS_TAB + 512);
    LAS unsigned char* lds = F.lds;
    const int tid = F.tid, lane = F.lane, w = F.wave, fr = lane & 15, fq = lane >> 4;
    unsigned voffB[2];
#pragma unroll
    for (int i = 0; i < 2; ++i) { int R_, C_; g8::stage_rc(tid * 16 + i * 8192, R_, C_); const int Rb = (R_ & ~31) + g8::perm32(R_ & 31); voffB[i] = (unsigned)(Rb * EDIM + C_) * 2u; }
    const unsigned ldsw = (unsigned)w * 1024u, lbase = (unsigned)(size_t)lds;
    int boffg[4];
#pragma unroll
    for (int g = 0; g < 4; ++g) boffg[g] = g8::lds_byte(32 * g + fr, fq * 8);
    LAS unsigned char* stg = lds + 65536 + w * (32 * 144);
    const int NU = NT * 4;
    int u = F.bid; if (u >= NU) return;
#define DP3_UNITINFO(uu, EXP, NV) do { const int tl_ = (uu) >> 2; int e_ = 0; while (__builtin_amdgcn_readfirstlane(tpref[e_ + 1]) <= tl_) ++e_; EXP = e_; \
        NV = __builtin_amdgcn_readfirstlane(cl[e_]) - (tl_ - __builtin_amdgcn_readfirstlane(tpref[e_])) * 256; } while (0)
#define DP3_GLDS(gsrc, ldsdst) do { unsigned keep_; asm volatile("s_mov_b32 %0, m0\n\ts_mov_b32 m0, %2\n\ts_nop 0\n\tglobal_load_lds_dwordx4 %1, off\n\ts_mov_b32 m0, %0" : "=&s"(keep_) : "v"(gsrc), "s"(ldsdst) : "memory"); } while (0)
#define DP3_STAGE(slot, gb) do { _Pragma("unroll") for (int kt = 0; kt < 2; ++kt) { \
        DP3_GLDS((const void*)((gb) + kt * 128 + voffB[0]), lbase + (unsigned)((slot) * 32768 + kt * 16384) + ldsw); \
        DP3_GLDS((const void*)((gb) + kt * 128 + voffB[1]), lbase + (unsigned)((slot) * 32768 + kt * 16384) + ldsw + 8192u); } } while (0)
#define DP3_LOADA(dst, uu) do { const bf16* ap_ = H + (size_t)(((uu) >> 2) * 256 + 32 * w + fr) * EDIM + 8 * fq; \
        _Pragma("unroll") for (int m = 0; m < 2; ++m) _Pragma("unroll") for (int kk = 0; kk < 4; ++kk) dst[m][kk] = *(const bf16x8*)(ap_ + (size_t)m * 16 * EDIM + 32 * kk); } while (0)
    int ecur, nvcur; DP3_UNITINFO(u, ecur, nvcur);
    bf16x8 A[2][4], An[2][4];
    DP3_LOADA(A, u);
    { const char* gb = (const char*)(WD + (size_t)ecur * D * EDIM + (size_t)((u & 3) * 512) * EDIM); DP3_STAGE(0, gb); }
    asm volatile("s_waitcnt vmcnt(0)" ::: "memory");
#pragma unroll 1
    for (;;) {
        const int un = (u + F.G < NU) ? u + F.G : u; int enx, nvnx; DP3_UNITINFO(un, enx, nvnx);
        const char* gbc = (const char*)(WD + (size_t)ecur * D * EDIM + (size_t)((u & 3) * 512) * EDIM);
        const char* gbn = (const char*)(WD + (size_t)enx * D * EDIM + (size_t)((un & 3) * 512) * EDIM);
        const int tile = u >> 2, colu = (u & 3) * 512;
        float scq[2][4];
#pragma unroll
        for (int c = 0; c < 4; ++c) {
            if (c == 0) asm volatile("s_waitcnt vmcnt(5)" ::: "memory"); else asm volatile("s_waitcnt vmcnt(4)" ::: "memory");
            __builtin_amdgcn_s_barrier();
            if (c == 3) { const bf16* ap_ = H + (size_t)((un >> 2) * 256 + 32 * w + fr) * EDIM + 8 * fq;
#pragma unroll
                for (int m = 0; m < 2; ++m) { const bf16* am_ = ap_ + (size_t)m * 16 * EDIM;
                    asm volatile("global_load_dwordx4 %0, %1, off" : "=&v"(An[m][0]) : "v"(am_) : "memory"); asm volatile("global_load_dwordx4 %0, %1, off offset:64" : "=&v"(An[m][1]) : "v"(am_) : "memory");
                    asm volatile("global_load_dwordx4 %0, %1, off offset:128" : "=&v"(An[m][2]) : "v"(am_) : "memory"); asm volatile("global_load_dwordx4 %0, %1, off offset:192" : "=&v"(An[m][3]) : "v"(am_) : "memory"); } }
            { const char* gnext = (c < 3) ? gbc + (size_t)(c + 1) * 128 * EDIM * 2 : gbn; DP3_STAGE((c + 1) & 1, gnext); }
            __builtin_amdgcn_sched_barrier(0);
            f32x4 acc[2][4][2];
#pragma unroll
            for (int g = 0; g < 4; ++g) { bf16x8 Bf[2][4];
#pragma unroll
                for (int n = 0; n < 2; ++n)
#pragma unroll
                    for (int kk = 0; kk < 4; ++kk) Bf[n][kk] = *(const LAS bf16x8*)(lds + (c & 1) * 32768 + (kk >> 1) * 16384 + boffg[g] + n * 2048 + (kk & 1) * 1024);
#pragma unroll
                for (int m = 0; m < 2; ++m)
#pragma unroll
                    for (int n = 0; n < 2; ++n) { acc[m][g][n] = (f32x4){0.f, 0.f, 0.f, 0.f};
#pragma unroll
                        for (int kk = 0; kk < 4; ++kk) acc[m][g][n] = __builtin_amdgcn_mfma_f32_16x16x32_bf16(Bf[n][kk], A[m][kk], acc[m][g][n], 0, 0, 0); } }
#pragma unroll
            for (int m = 0; m < 2; ++m) {
                float am = 0.f;
#pragma unroll
                for (int g = 0; g < 4; ++g)
#pragma unroll
                    for (int n = 0; n < 2; ++n) am = fmaxf(am, fmaxf(fmaxf(fabsf(acc[m][g][n][0]), fabsf(acc[m][g][n][1])), fmaxf(fabsf(acc[m][g][n][2]), fabsf(acc[m][g][n][3]))));
                am = fmaxf(am, shfl_x(am, 16, lane)); am = fmaxf(am, shfl_x(am, 32, lane));
                am = fminf(am, 3.0e38f);
                const float isc = am > 0.f ? 127.0f * __builtin_amdgcn_rcpf(am) : 0.f;
                scq[m][c] = am * (1.0f / 127.0f);
#pragma unroll
                for (int g = 0; g < 4; ++g) { unsigned qd[2];
#pragma unroll
                    for (int n = 0; n < 2; ++n) {
                        const unsigned t0 = __builtin_bit_cast(unsigned, __builtin_fmaf(acc[m][g][n][0], isc, 8388736.0f)), t1 = __builtin_bit_cast(unsigned, __builtin_fmaf(acc[m][g][n][1], isc, 8388736.0f));
                        const unsigned t2 = __builtin_bit_cast(unsigned, __builtin_fmaf(acc[m][g][n][2], isc, 8388736.0f)), t3 = __builtin_bit_cast(unsigned, __builtin_fmaf(acc[m][g][n][3], isc, 8388736.0f));
                        qd[n] = (t0 & 0xffu) | ((t1 & 0xffu) << 8) | ((t2 & 0xffu) << 16) | (t3 << 24); }
                    *(LAS v2u*)(stg + (16 * m + fr) * 144 + 32 * g + 8 * fq) = (v2u){qd[0], qd[1]}; } }
#pragma unroll
            for (int it = 0; it < 4; ++it) { const int rr = 8 * it + (lane >> 3);
                const v4u o = *(const LAS v4u*)(stg + rr * 144 + (lane & 7) * 16);
                *(v4u*)(Yq + (size_t)(tile * 256 + 32 * w + rr) * D + colu + 128 * c + 16 * (lane & 7)) = o; }
            if (c == 3) { const f32x4 so = fq == 0 ? (f32x4){scq[0][0], scq[0][1], scq[0][2], scq[0][3]} : (f32x4){scq[1][0], scq[1][1], scq[1][2], scq[1][3]};
                if (fq < 2) *(f32x4*)(Ysc + (size_t)(tile * 256 + 32 * w + 16 * fq + fr) * 16 + (colu >> 7)) = so; }
            __builtin_amdgcn_sched_barrier(0);
        }
        asm volatile("s_waitcnt vmcnt(9)" : "+v"(An[0][0]), "+v"(An[0][1]), "+v"(An[0][2]), "+v"(An[0][3]), "+v"(An[1][0]), "+v"(An[1][1]), "+v"(An[1][2]), "+v"(An[1][3]) :: "memory");
        if (un == u) break;
#pragma unroll
        for (int m = 0; m < 2; ++m)
#pragma unroll
            for (int kk = 0; kk < 4; ++kk) A[m][kk] = An[m][kk];
        u = un; ecur = enx; nvcur = nvnx;
    }
    asm volatile("s_waitcnt vmcnt(0)" ::: "memory");
#undef DP3_UNITINFO
#undef DP3_STAGE
#undef DP3_GLDS
#undef DP3_LOADA
}

enum { PH_PRO = 0, PH_POOL_G1, PH_POOL_P, PH_POOL_G2, PH_POOL_G3, PH_DIL_G1, PH_DIL_ATT, PH_DIL_CMB, PH_DIL_G2, PH_CONV_G1, PH_CONV_E, PH_CONV_G2, PH_MOE1, PH_MOE2, PH_MOE3, PH_MOE4, PH_COUNT };

template <int PH>
__device__ __forceinline__ void run_phase(const Frame& Fin, const Args& args_, const int L) {
    Frame F = Fin; { int w_ = Fin.wave, l_; asm volatile("" : "+s"(w_)); asm volatile("v_mbcnt_lo_u32_b32 %0, -1, 0\n\tv_mbcnt_hi_u32_b32 %0, -1, %0" : "=v"(l_)); F.wave = w_; F.lane = l_; F.tid = w_ * 64 + l_; }
    unsigned char* ws; { GAS unsigned char* wsg = (GAS unsigned char*)Fin.ws; asm volatile("" : "+s"(wsg)); ws = (unsigned char*)wsg; } F.ws = ws; F.ctl = (unsigned*)(ws + WS_CTL);
    KP kp = (KP)__builtin_amdgcn_kernarg_segment_ptr(); asm volatile("" : "+s"(kp)); (void)args_;
    { unsigned l_ = (unsigned)(size_t)Fin.lds; asm volatile("" : "+s"(l_)); F.lds = (LAS unsigned char*)(size_t)l_; }
    LAS unsigned char* ring = F.lds; int c = (int)blockIdx.x; { int g_ = Fin.G; asm volatile("" : "+s"(c), "+s"(g_)); F.G = g_; F.bid = c; }
    const float* xres = ain(kp, IN_X); const bf16* xresb = (const bf16*)(ws + WS_Y2F);
    const float* st2 = (const float*)(ws + WS_ST2); float* pstp = (float*)(ws + WS_PST);
    const float* g2p = ain(kp, IN_LNG) + (size_t)((L > 0 ? L - 1 : 0) * 2 + 1) * D; const float* b2p = ain(kp, IN_LNB) + (size_t)((L > 0 ? L - 1 : 0) * 2 + 1) * D;
    const bf16* xb = (const bf16*)(ws + WS_XB);
    bf16* yf = (bf16*)(ws + WS_YF);
    unsigned char* big = ws + WS_BIG;
    const int ia = L / 3;
    if constexpr (PH == PH_PRO) { phase_prologue(F, kp); }
    if constexpr (PH == PH_POOL_G1) { g8::DenseSched S; S.init(xb, (const bf16*)(ws + WS_W_POOL_IN) + (size_t)ia * D * D, T, D, D, D, F.G, c);
        g8::EpiBf16 E{(bf16*)(big + BG_U), D, 0}; g8::gemm_phase<g8::EpiBf16, g8::DenseSched, false>(ring, F.tid, D, D, D, S, E); }
    if constexpr (PH == PH_POOL_P) { phase_pool(F, (const bf16*)(big + BG_U), (bf16*)(big + BG_PL)); }
    if constexpr (PH == PH_POOL_G2) { g8::DenseSched S; S.init((const bf16*)(big + BG_PL), (const bf16*)(ws + WS_W_POOL_G) + (size_t)ia * D * 512, T, D, D, 512, F.G, c); S.agrp_shift = 1; S.agrp_stride = 512 * 2;
        g8::EpiScaleBf16 E{(bf16*)(big + BG_MX), D, ain(kp, IN_PSC) + (size_t)ia * D}; g8::gemm_phase<g8::EpiScaleBf16, g8::DenseSched, false>(ring, F.tid, 512, D, 512, S, E); }
    if constexpr (PH == PH_POOL_G3) { g8::DenseSched S; S.init((const bf16*)(big + BG_MX), (const bf16*)(ws + WS_W_POOL_OUT) + (size_t)ia * D * D, T, D, D, D, F.G, c);
        g8::EpiResidLN E{xres, xresb, st2, g2p, b2p, yf, pstp, L > 0}; g8::gemm_phase<g8::EpiResidLN, g8::DenseSched, false>(ring, F.tid, D, D, D, S, E); }
    if constexpr (PH == PH_DIL_G1) { g8::DenseSched S; S.init(xb, (const bf16*)(ws + WS_W_DIL_QKV), T, QKVC, D, D, F.G, c);
        g8::EpiBf16 E{(bf16*)(big + BG_QKV), QKVC, 1}; g8::gemm_phase<g8::EpiBf16, g8::DenseSched, false>(ring, F.tid, D, D, D, S, E); }
    if constexpr (PH == PH_DIL_ATT) { phase_attn(F, (const bf16*)(big + BG_QKV), ain(kp, IN_RELB), (bf16*)(big + BG_OG), (float*)(big + BG_LSE)); }
    if constexpr (PH == PH_DIL_CMB) { phase_combine(F, (const bf16*)(big + BG_OG), (const float*)(big + BG_LSE), (bf16*)(big + BG_O)); }
    if constexpr (PH == PH_DIL_G2) { g8::DenseSched S; S.init((const bf16*)(big + BG_O), (const bf16*)(ws + WS_W_DIL_OUT), T, D, DILW, DILW, F.G, c);
        g8::EpiResidLN E{xres, xresb, st2, g2p, b2p, yf, pstp, L > 0}; g8::gemm_phase<g8::EpiResidLN, g8::DenseSched, false>(ring, F.tid, DILW, DILW, DILW, S, E); }
    if constexpr (PH == PH_CONV_G1) { g8::DenseSched S; S.init(xb, (const bf16*)(ws + WS_W_CONV_IN), T, 3 * D, D, D, F.G, c);
        g8::EpiConvIn E{(bf16*)(big + BG_UC), (bf16*)(big + BG_BG)}; g8::gemm_phase<g8::EpiConvIn, g8::DenseSched, false>(ring, F.tid, D, D, D, S, E); }
    if constexpr (PH == PH_CONV_E) { phase_conv(F, (const bf16*)(big + BG_UC), (const bf16*)(big + BG_BG), ain(kp, IN_CW), (bf16*)(big + BG_Z)); }
    if constexpr (PH == PH_CONV_G2) { g8::DenseSched S; S.init((const bf16*)(big + BG_Z), (const bf16*)(ws + WS_W_CONV_OUT), T, D, D, D, F.G, c);
        g8::EpiResidLN E{xres, xresb, st2, g2p, b2p, yf, pstp, L > 0}; g8::gemm_phase<g8::EpiResidLN, g8::DenseSched, false>(ring, F.tid, D, D, D, S, E); }
    unsigned* cnt = F.ctl + CW_CNT + L * 64 * 16;
    float* x1f = (float*)(ws + WS_X1F); bf16* x1b = (bf16*)(ws + WS_X1B);
    int* ltok = (int*)(ws + WS_LTOK); float* lgate = (float*)(ws + WS_LGATE); int* eidx = (int*)(ws + WS_EIDX); int* inv = (int*)(ws + WS_INV);
    bf16* HB = (bf16*)(ws + WS_HB); bf16* HS = (bf16*)(ws + WS_HS); bf16* Yr = (bf16*)(ws + WS_BIG);
    if constexpr (PH == PH_MOE1) {
        const float* g1 = ain(kp, IN_LNG) + (size_t)(L * 2 + 0) * D; const float* b1 = ain(kp, IN_LNB) + (size_t)(L * 2 + 0) * D;
        phase_moe1n(F, yf, pstp, g1, b1, (const bf16*)(ws + WS_RWH) + (size_t)L * NEXP * D, (const bf16*)(ws + WS_RWL) + (size_t)L * NEXP * D, ain(kp, IN_RB) + (size_t)L * NEXP,
                    x1b, (float*)(ws + WS_ST1), cnt, ltok, lgate, eidx, inv); }
    if constexpr (PH == PH_MOE2) {
        const int NT = build_tiles(F, cnt);
        { g8::ExpertSched<1, true> S; S.tpref = (const LAS int*)(F.lds + LDS_TAB); S.cnt = (const LAS int*)(F.lds + LDS_TAB + 512); S.A = (const char*)x1b; S.B = (const char*)((const bf16*)(ws + WS_W_EX_GU) + (size_t)L * 64 * 256 * D);
          S.tok = ltok; S.b_exp = (size_t)256 * D * 2; S.b_tile = 0; S.a_tile = 0; S.NU = NT; S.G = F.G; S.c = c;
          g8::EpiExpertGU E{HB}; g8::gemm_phase<g8::EpiExpertGU, g8::ExpertSched<1, true>, true>(ring, F.tid, D, D, D, S, E); }
        { const int rot = (c - (NT % F.G) + F.G) % F.G;
          g8::DenseSched S; S.init(x1b, (const bf16*)(ws + WS_W_SH_GU) + (size_t)L * 512 * D, T, 512, D, D, F.G, rot);
          int t2 = F.tid; asm volatile("" : "+v"(t2));
          g8::EpiSharedGU E{HS}; g8::gemm_phase<g8::EpiSharedGU, g8::DenseSched, false>(ring, t2, D, D, D, S, E); } }
    if constexpr (PH == PH_MOE3) {
        const float* g1 = ain(kp, IN_LNG) + (size_t)(L * 2 + 0) * D; const float* b1 = ain(kp, IN_LNB) + (size_t)(L * 2 + 0) * D;
        const int NT = build_tiles(F, cnt);
        __syncthreads();
        phase_downproj3(F, HB, (const bf16*)(ws + WS_W_EX_D) + (size_t)L * 64 * D * EDIM, (unsigned char*)Yr, (float*)(ws + WS_BIG + BG_YSC), NT);
        __syncthreads();
        { const int rot = (c - ((NT * 4) % F.G) + F.G) % F.G;
          g8::DenseSched S; S.init(HS, (const bf16*)(ws + WS_W_SH_D) + (size_t)L * D * SDIM, T, D, SDIM, SDIM, F.G, rot);
          int t2 = F.tid; asm volatile("" : "+v"(t2));
          int ks = SDIM; asm volatile("" : "+s"(ks));
          g8::EpiResidLN E{nullptr, yf, (const float*)(ws + WS_ST1), g1, b1, (bf16*)(ws + WS_Y2F), pstp, 1}; g8::gemm_phase<g8::EpiResidLN, g8::DenseSched, false>(ring, t2, ks, ks, ks, S, E); } }
    if constexpr (PH == PH_MOE4) { (void)build_tiles(F, cnt);
        const float* g2 = ain(kp, IN_LNG) + (size_t)(L * 2 + 1) * D; const float* b2 = ain(kp, IN_LNB) + (size_t)(L * 2 + 1) * D;
        phase_moe4q(F, (bf16*)(ws + WS_Y2F), (const unsigned char*)Yr, (const float*)(ws + WS_BIG + BG_YSC), eidx, inv, g2, b2, (float*)(ws + WS_ST2), (bf16*)(ws + WS_XB), aout(kp), L == DEPTH - 1); }
}
__device__ __forceinline__ void make_frame(Frame& F, const Args& args) {
    extern __shared__ __attribute__((aligned(16))) unsigned char lds_raw[];
    F.lds = (LAS unsigned char*)lds_raw; F.ws = args.ws; F.ctl = (unsigned*)(args.ws + WS_CTL);
    F.tid = threadIdx.x; F.lane = F.tid & 63; F.wave = __builtin_amdgcn_readfirstlane(F.tid >> 6); F.G = gridDim.x; F.bid = blockIdx.x;
}
template <int PH> __global__ void __launch_bounds__(512, 2) k_phase(Args args, int L) {
    Frame F; make_frame(F, args);
    run_phase<PH>(F, args, L);
}

#ifndef MK_NOINLINE
#define MK_NOINLINE 0
#endif
#if MK_NOINLINE
template <int PH> __device__ __noinline__ void call_phase_ni(const int L) {
    Args dummy{}; Frame F;
    KP kp = (KP)__builtin_amdgcn_kernarg_segment_ptr();
    extern __shared__ __attribute__((aligned(16))) unsigned char lds_raw[];
    F.lds = (LAS unsigned char*)lds_raw; F.ws = (unsigned char*)((GAS unsigned char* const CAS*)kp)[20]; F.ctl = (unsigned*)(F.ws + WS_CTL);
    F.tid = threadIdx.x; F.lane = F.tid & 63; F.wave = __builtin_amdgcn_readfirstlane(F.tid >> 6); F.G = gridDim.x; F.bid = blockIdx.x;
    run_phase<PH>(F, dummy, L);
}
template <int PH> __device__ __forceinline__ void call_phase(const Frame& F, const Args& args, const int L) { call_phase_ni<PH>(L); }
#else
template <int PH> __device__ __forceinline__ void call_phase(const Frame& F, const Args& args, const int L) { asm volatile("; PHASE_BEGIN %0" :: "n"(PH)); run_phase<PH>(F, args, L); asm volatile("; PHASE_END %0" :: "n"(PH)); }
#endif
__global__ void __launch_bounds__(512, 2) fwd_all(Args args) {
    Frame F; make_frame(F, args);
    volatile LAS unsigned* misc = (volatile LAS unsigned*)(F.lds + LDS_MISC);
    if (F.tid < 4) misc[F.tid] = 0u;
    __syncthreads();
    const int lo = args.ph_lo, hi = args.ph_hi;
    XcdBarrier bar; bar.bar = F.ctl + CW_BAR; bar.x = 0; bar.st = misc;
    if (hi - lo > 1) bar = xcd_barrier_post(F.ctl + CW_BAR, misc);
    int pc = 0;
#ifndef MK_DUP_MASK
#define MK_DUP_MASK 0
#endif
#define STEP(PH, Lx) do { if (pc >= lo && pc < hi) { if ((MK_DUP_MASK >> (PH)) & 1) { call_phase<PH>(F, args, Lx); xcd_barrier(bar); } call_phase<PH>(F, args, Lx); if (pc + 1 < hi) xcd_barrier(bar); } ++pc; } while (0)
    STEP(PH_PRO, 0);
#pragma unroll 1
    for (int L = 0; L < DEPTH; ++L) {
        const int kind = L % 3;
        if (kind == 0) { STEP(PH_POOL_G1, L); STEP(PH_POOL_P, L); STEP(PH_POOL_G2, L); STEP(PH_POOL_G3, L); }
        else if (kind == 1) { STEP(PH_DIL_G1, L); STEP(PH_DIL_ATT, L); STEP(PH_DIL_CMB, L); STEP(PH_DIL_G2, L); }
        else { STEP(PH_CONV_G1, L); STEP(PH_CONV_E, L); STEP(PH_CONV_G2, L); }
        STEP(PH_MOE1, L); STEP(PH_MOE2, L); STEP(PH_MOE3, L); STEP(PH_MOE4, L);
    }
#undef STEP
}
constexpr int N_STEPS = 1 + 2 * 8 + 8 + 7;

template <int PH> static void launch_phase(const Args& a, int L, int grid, hipStream_t stream) {
    static bool attr = false;
    if (!attr) { (void)hipFuncSetAttribute((const void*)k_phase<PH>, hipFuncAttributeMaxDynamicSharedMemorySize, LDS_BYTES); attr = true; }
    hipLaunchKernelGGL(k_phase<PH>, dim3(grid), dim3(512), LDS_BYTES, stream, a, L);
}
extern "C" void kernel_launch(void* const* d_in, const int* in_sizes, int n_in, void* d_out, int out_size, void* d_ws, size_t ws_size, hipStream_t stream) {
    static int grid = 0;
    if (grid == 0) {
        if (n_in != 19 || out_size != T * D || ws_size < WS_END) { fprintf(stderr, "kernel_launch: unexpected shapes (n_in %d out %d ws %zu need %zu)\n", n_in, out_size, ws_size, (size_t)WS_END); grid = -1; return; }
        int dev = 0, cus = 0;
        if (hipGetDevice(&dev) != hipSuccess || hipDeviceGetAttribute(&cus, hipDeviceAttributeMultiprocessorCount, dev) != hipSuccess) { grid = -1; return; }
#if MK_ONE_LAUNCH
        if (hipFuncSetAttribute((const void*)fwd_all, hipFuncAttributeMaxDynamicSharedMemorySize, LDS_BYTES) != hipSuccess) { fprintf(stderr, "kernel_launch: hipFuncSetAttribute failed\n"); grid = -1; return; }
        int per_cu = 0;
        if (hipOccupancyMaxActiveBlocksPerMultiprocessor(&per_cu, (const void*)fwd_all, 512, LDS_BYTES) != hipSuccess || per_cu < 1) { fprintf(stderr, "kernel_launch: note: occupancy query reports %d blocks per CU\n", per_cu); (void)hipGetLastError(); }
#endif
        grid = cus;
    }
    if (grid < 0) return;
    (void)hipMemsetAsync((char*)d_ws + WS_CTL, 0, CTL_ZERO_BYTES, stream);
    Args a{};
    for (int i = 0; i < 19; ++i) a.in[i] = (const float*)d_in[i];
    a.out = (float*)d_out; a.ws = (unsigned char*)d_ws; a.ph_lo = 0; a.ph_hi = 0;
#if MK_ONE_LAUNCH
#ifdef MK_SPLIT
    for (int p = 0; p < N_STEPS; ++p) { a.ph_lo = p; a.ph_hi = p + 1; hipLaunchKernelGGL(fwd_all, dim3(grid), dim3(512), LDS_BYTES, stream, a); }
#else
    a.ph_lo = 0; a.ph_hi = N_STEPS;
    hipLaunchKernelGGL(fwd_all, dim3(grid), dim3(512), LDS_BYTES, stream, a);
#endif
#elif defined(MK_HYBRID_MASK)
    {
        static bool attr2 = false; if (!attr2) { (void)hipFuncSetAttribute((const void*)fwd_all, hipFuncAttributeMaxDynamicSharedMemorySize, LDS_BYTES); attr2 = true; }
        int pc = 0;
#define HSTEP(PH, Lx) do { if ((MK_HYBRID_MASK >> (PH)) & 1) { a.ph_lo = pc; a.ph_hi = pc + 1; hipLaunchKernelGGL(fwd_all, dim3(grid), dim3(512), LDS_BYTES, stream, a); } else { a.ph_lo = 0; a.ph_hi = 0; launch_phase<PH>(a, Lx, grid, stream); } ++pc; } while (0)
        HSTEP(PH_PRO, 0);
        for (int L = 0; L < DEPTH; ++L) {
            const int kind = L % 3;
            if (kind == 0) { HSTEP(PH_POOL_G1, L); HSTEP(PH_POOL_P, L); HSTEP(PH_POOL_G2, L); HSTEP(PH_POOL_G3, L); }
            else if (kind == 1) { HSTEP(PH_DIL_G1, L); HSTEP(PH_DIL_ATT, L); HSTEP(PH_DIL_CMB, L); HSTEP(PH_DIL_G2, L); }
            else { HSTEP(PH_CONV_G1, L); HSTEP(PH_CONV_E, L); HSTEP(PH_CONV_G2, L); }
            HSTEP(PH_MOE1, L); HSTEP(PH_MOE2, L); HSTEP(PH_MOE3, L); HSTEP(PH_MOE4, L);
        }
#undef HSTEP
    }
#else
    launch_phase<PH_PRO>(a, 0, grid, stream);
    for (int L = 0; L < DEPTH; ++L) {
        const int kind = L % 3;
        if (kind == 0) { launch_phase<PH_POOL_G1>(a, L, grid, stream); launch_phase<PH_POOL_P>(a, L, grid, stream); launch_phase<PH_POOL_G2>(a, L, grid, stream); launch_phase<PH_POOL_G3>(a, L, grid, stream); }
        else if (kind == 1) { launch_phase<PH_DIL_G1>(a, L, grid, stream); launch_phase<PH_DIL_ATT>(a, L, grid, stream); launch_phase<PH_DIL_CMB>(a, L, grid, stream); launch_phase<PH_DIL_G2>(a, L, grid, stream); }
        else { launch_phase<PH_CONV_G1>(a, L, grid, stream); launch_phase<PH_CONV_E>(a, L, grid, stream); launch_phase<PH_CONV_G2>(a, L, grid, stream); }
        launch_phase<PH_MOE1>(a, L, grid, stream); launch_phase<PH_MOE2>(a, L, grid, stream); launch_phase<PH_MOE3>(a, L, grid, stream); launch_phase<PH_MOE4>(a, L, grid, stream);
    }
#endif
}
```

```cpp
#include <hip/hip_runtime.h>
#include <cstdio>
#include <cstdint>

#ifndef MK_ONE_LAUNCH
#define MK_ONE_LAUNCH 1
#endif

#define GAS __attribute__((address_space(1)))
#define LAS __attribute__((address_space(3)))
typedef unsigned short bf16;
typedef unsigned v4u __attribute__((ext_vector_type(4)));
typedef unsigned v2u __attribute__((ext_vector_type(2)));
typedef float f32x4 __attribute__((ext_vector_type(4)));
typedef float f32x2 __attribute__((ext_vector_type(2)));
typedef short bf16x8 __attribute__((ext_vector_type(8)));
typedef short s16x4 __attribute__((ext_vector_type(4)));

constexpr int NBATCH = 8, SEQ = 2048, D = 2048, T = NBATCH * SEQ, DEPTH = 4;
constexpr int NEXP = 64, TOPK = 8, EDIM = 128, SDIM = 256;
constexpr int QKVC = 4608, DILW = 512;
constexpr float ALPHA = 1.681792830507429f;
constexpr float LN_EPS = 1e-5f;
constexpr int CAP = 16384;
constexpr int HROWS = T * TOPK + NEXP * 256;

constexpr size_t MiB = 1u << 20;
constexpr size_t WS_CTL = 0, CTL_ZERO_BYTES = 1 * MiB;
constexpr size_t WS_W_POOL_IN = 1 * MiB;
constexpr size_t WS_W_POOL_G = WS_W_POOL_IN + 16 * MiB;
constexpr size_t WS_W_POOL_OUT = WS_W_POOL_G + 4 * MiB;
constexpr size_t WS_W_DIL_QKV = WS_W_POOL_OUT + 16 * MiB;
constexpr size_t WS_W_DIL_OUT = WS_W_DIL_QKV + 18 * MiB;
constexpr size_t WS_W_CONV_IN = WS_W_DIL_OUT + 2 * MiB;
constexpr size_t WS_W_CONV_OUT = WS_W_CONV_IN + 24 * MiB;
constexpr size_t WS_W_SH_GU = WS_W_CONV_OUT + 8 * MiB;
constexpr size_t WS_W_SH_D = WS_W_SH_GU + 8 * MiB;
constexpr size_t WS_W_EX_GU = WS_W_SH_D + 4 * MiB;
constexpr size_t WS_W_EX_D = WS_W_EX_GU + 256 * MiB;
constexpr size_t WS_XF = WS_W_EX_D + 256 * MiB;
constexpr size_t WS_YF = WS_XF + 128 * MiB;
constexpr size_t WS_X1F = WS_YF + 128 * MiB;
constexpr size_t WS_XB = WS_X1F + 128 * MiB;
constexpr size_t WS_X1B = WS_XB + 64 * MiB;
constexpr size_t WS_HB = WS_X1B + 64 * MiB;
constexpr size_t WS_HS = WS_HB + 72 * MiB;
constexpr size_t WS_LTOK = WS_HS + 8 * MiB;
constexpr size_t WS_LGATE = WS_LTOK + 4 * MiB;
constexpr size_t WS_EIDX = WS_LGATE + 4 * MiB;
constexpr size_t WS_INV = WS_EIDX + 1 * MiB;
constexpr size_t WS_BIG = WS_INV + 1 * MiB;
constexpr size_t WS_PST = WS_BIG + 608 * MiB;
constexpr size_t WS_ST1 = WS_PST + 4 * MiB;
constexpr size_t WS_ST2 = WS_ST1 + 1 * MiB;
constexpr size_t WS_RWH = WS_ST2 + 1 * MiB;
constexpr size_t WS_RWL = WS_RWH + 1 * MiB;
constexpr size_t WS_PST2 = WS_RWL + 1 * MiB;
constexpr size_t WS_END = WS_PST2 + 8 * MiB;
constexpr size_t WS_Y2F = WS_X1F;
constexpr size_t BG_U = 0, BG_PL = 64 * MiB, BG_MX = 128 * MiB;
constexpr size_t BG_QKV = 0, BG_OG = 144 * MiB, BG_LSE = 192 * MiB, BG_O = 194 * MiB;
constexpr size_t BG_UC = 0, BG_BG = 64 * MiB, BG_Z = 128 * MiB;
constexpr size_t BG_YSC = 320 * MiB;
constexpr int CW_BAR = 4096;
constexpr int CW_CNT = 16384;

constexpr int RING_BYTES = 131072;
constexpr int LDS_TAB = RING_BYTES;
constexpr int LDS_STASH = RING_BYTES + 1024;
constexpr int LDS_BYTES = 163840;
constexpr int LDS_MISC = LDS_BYTES - 1024;

typedef __bf16 bf16x2_t __attribute__((ext_vector_type(2)));
typedef float f32x2_t __attribute__((ext_vector_type(2)));
__device__ __forceinline__ unsigned cvt_pk_bf16(float lo, float hi) { const bf16x2_t r = __builtin_convertvector((f32x2_t){lo, hi}, bf16x2_t); return __builtin_bit_cast(unsigned, r); }
__device__ __forceinline__ unsigned f2bf(float f) { unsigned u = __builtin_bit_cast(unsigned, f); return (u + 0x7fffu + ((u >> 16) & 1u)) >> 16; }
__device__ __forceinline__ unsigned pk2(float lo, float hi) { return f2bf(lo) | (f2bf(hi) << 16); }
__device__ __forceinline__ float bflo(unsigned w) { return __builtin_bit_cast(float, w << 16); }
__device__ __forceinline__ float bfhi(unsigned w) { return __builtin_bit_cast(float, w & 0xffff0000u); }
__device__ __forceinline__ float shfl_from(float v, int src) { return __builtin_bit_cast(float, __builtin_amdgcn_ds_bpermute(src << 2, __builtin_bit_cast(int, v))); }
__device__ __forceinline__ float shfl_x(float v, int o, int lane) { return shfl_from(v, lane ^ o); }
__device__ __forceinline__ float wave_sum(float v, int lane) {
#pragma unroll
    for (int o = 1; o < 64; o <<= 1) v += shfl_x(v, o, lane);
    return v;
}
#define LDS_WAIT() asm volatile("s_waitcnt lgkmcnt(0)" ::: "memory")
#define VM_WAIT() asm volatile("s_waitcnt vmcnt(0)" ::: "memory")

#define XB_TMO      128
#define XB_XCNT(j)  (256  + 64 * (j))
#define XB_XSUB(j)  (1280 + 64 * (j))
#define XB_XGEN(j)  (2304 + 64 * (j))
#define XB_TOP      3328
#define XB_TOPGEN   3392
#define XCD_BAR_WORDS 3456
#define XB_SPIN_CAP (1u << 18)

__device__ __forceinline__ unsigned xb_ld(unsigned* p)              { return __hip_atomic_load(p, __ATOMIC_RELAXED, __HIP_MEMORY_SCOPE_AGENT); }
__device__ __forceinline__ unsigned xb_add(unsigned* p, unsigned v) { return __hip_atomic_fetch_add(p, v, __ATOMIC_RELAXED, __HIP_MEMORY_SCOPE_AGENT); }
__device__ __forceinline__ unsigned xb_xcc_id() { return (unsigned)__builtin_amdgcn_s_getreg((3 << 11) | 20) & 0xFu; }
#define XB_SPIN(cond, bar) do { unsigned _sp = 0; while (cond) { __builtin_amdgcn_s_sleep(1); \
    if ((++_sp & 255u) == 0u) { if (xb_ld(&(bar)[XB_TMO])) break; if (_sp > XB_SPIN_CAP) { atomicAdd(&(bar)[XB_TMO], 1u); break; } } } } while (0)

struct XcdBarrier {
    unsigned* bar; unsigned x;
    volatile LAS unsigned* st;
};

__device__ __forceinline__ XcdBarrier xcd_barrier_post(unsigned* bar, volatile LAS unsigned* st) {
    XcdBarrier b; b.bar = bar; b.x = xb_xcc_id(); b.st = st;
    if (threadIdx.x == 0) (void)xb_add(&bar[XB_XCNT(b.x)], 1u);
    return b;
}
__device__ __forceinline__ void xcd_barrier_complete(unsigned* bar, unsigned x, unsigned& nloc, unsigned& nx) {
    const unsigned G = gridDim.x * gridDim.y * gridDim.z;
    unsigned sum, cnt, mine, sp = 0u;
    for (;;) {
        sum = 0u; cnt = 0u; mine = 0u;
#pragma unroll
        for (unsigned j = 0; j < 16; ++j) { const unsigned c = xb_ld(&bar[XB_XCNT(j)]); sum += c; cnt += (c > 0u) ? 1u : 0u; mine = (j == x) ? c : mine; }
        if (sum == G) break;
        __builtin_amdgcn_s_sleep(1);
        if ((++sp & 255u) == 0u) { if (xb_ld(&bar[XB_TMO])) break; if (sp > XB_SPIN_CAP) { atomicAdd(&bar[XB_TMO], 1u); break; } }
    }
    nloc = mine > 0u ? mine : 1u; nx = cnt > 0u ? cnt : 1u;
}

__device__ __forceinline__ void xcd_barrier(const XcdBarrier& b) {
    asm volatile("s_waitcnt vmcnt(0)" ::: "memory");
    __syncthreads();
    if (threadIdx.x == 0) {
        unsigned* bar; unsigned bx = b.x; { GAS unsigned* bg = (GAS unsigned*)b.bar; asm volatile("" : "+s"(bg), "+s"(bx)); bar = (unsigned*)bg; }
        __builtin_amdgcn_s_waitcnt(0);
        unsigned nloc = b.st[0], nx = b.st[1];
        if (nloc == 0u) { xcd_barrier_complete(bar, bx, nloc, nx); b.st[0] = nloc; b.st[1] = nx; }
        const unsigned old = xb_add(&bar[XB_XSUB(bx)], 1u);
        const unsigned gen = old / nloc;
        if (old + 1u == (gen + 1u) * nloc) {
            __builtin_amdgcn_fence(__ATOMIC_RELEASE, "agent");
            asm volatile("s_waitcnt vmcnt(0)" ::: "memory");
            const unsigned og = xb_add(&bar[XB_TOP], 1u);
            const unsigned tg = og / nx;
            if (og + 1u == (tg + 1u) * nx) xb_add(&bar[XB_TOPGEN], 1u);
            else XB_SPIN(xb_ld(&bar[XB_TOPGEN]) == tg, bar);
            __builtin_amdgcn_fence(__ATOMIC_ACQUIRE, "agent");
            xb_add(&bar[XB_XGEN(bx)], 1u);
            asm volatile("s_waitcnt vmcnt(0)" ::: "memory");
        } else {
            XB_SPIN(xb_ld(&bar[XB_XGEN(bx)]) == gen, bar);
            __builtin_amdgcn_fence(__ATOMIC_ACQUIRE, "agent");
            asm volatile("s_waitcnt vmcnt(0)" ::: "memory");
        }
    }
    __syncthreads();
}

namespace g8 {
constexpr int BM = 256, BK = 64, HALF = 128, HTB = HALF * BK * 2, STAGE_BYTES = 8 * HTB, NXCD = 8, WGM = 8;
__host__ __device__ __forceinline__ int lds_byte(int r, int c) { const int st = (r >> 4) * 2 + (c >> 5), rr = r & 15, cc = c & 31, ob = rr * 64 + cc * 2; return st * 1024 + (ob ^ (((ob >> 9) & 1) << 5)); }
__host__ __device__ __forceinline__ void stage_rc(int b, int& R, int& C) { const int st = b / 1024, sb = b % 1024, swz = sb ^ (((sb >> 9) & 1) << 5); R = (st >> 1) * 16 + swz / 64; C = (st & 1) * 32 + (swz % 64) / 2; }
__host__ __device__ __forceinline__ int perm32(int rho) { const int n = rho >> 4, i = rho & 15; return 8 * (i >> 2) + 4 * n + (i & 3); }

struct Unit { const char* A; const char* B; const int* rows; int pm, pn, nvalid, aux; };

template <class Epi, class Sched, bool GATHER>
__device__ __forceinline__ void gemm_phase(LAS unsigned char* lds, const int tid_in, const int K, const int lda, const int ldb, const Sched& S, const Epi& E) {
    const int tid = tid_in, wid = __builtin_amdgcn_readfirstlane(tid >> 6), lane = tid & 63, wr = wid >> 2, wc = wid & 3, fr = lane & 15, fq = lane >> 4;
    const int nt = K / BK;
    unsigned voffB[2];
#pragma unroll
    for (int i = 0; i < 2; ++i) { int R_, C_; stage_rc(tid * 16 + i * 8192, R_, C_); const int Rb = Epi::PERM ? ((R_ & ~31) + perm32(R_ & 31)) : R_; voffB[i] = (unsigned)(Rb * ldb + C_) * 2u; }
    LAS v4u* stash = (LAS v4u*)(lds + (LDS_STASH - 0) + tid * 16);
    const size_t kstep = (size_t)(BK * 2);
    const size_t hstepB = (size_t)HALF * ldb * 2;
    const unsigned ldsw = (unsigned)wid * 1024u;
    const int aoff = lds_byte(wr * 64 + fr, fq * 8), boff = lds_byte(wc * 32 + fr, fq * 8);
#define G8_SA(b, h) (((b) * 2 + (h)) * HTB)
#define G8_SB(b, h) ((4 + (b) * 2 + (h)) * HTB)
#define G8_STAGE2(bufoff, gbase, v0, v1) do { \
        __builtin_amdgcn_global_load_lds((const unsigned*)((const char*)(gbase) + (v0)), (LAS unsigned*)(lds + (bufoff) + ldsw), 16, 0, 0); \
        __builtin_amdgcn_global_load_lds((const unsigned*)((const char*)(gbase) + (v1)), (LAS unsigned*)(lds + (bufoff) + ldsw + 8192), 16, 0, 0); } while (0)
#define G8_STAGEB(bufoff, gbase) G8_STAGE2(bufoff, gbase, voffB[0], voffB[1])
#define G8_LDA(dst, b, h) do { _Pragma("unroll") for (int m = 0; m < 4; ++m) _Pragma("unroll") for (int k = 0; k < 2; ++k) dst[m][k] = *(const LAS bf16x8*)(lds + G8_SA(b, h) + aoff + m * 2048 + k * 1024); } while (0)
#define G8_LDB(dst, b, h) do { _Pragma("unroll") for (int n = 0; n < 2; ++n) _Pragma("unroll") for (int k = 0; k < 2; ++k) dst[n][k] = *(const LAS bf16x8*)(lds + G8_SB(b, h) + boff + n * 2048 + k * 1024); } while (0)
#define G8_MMA(ai, bj, At, Bt) do { __builtin_amdgcn_s_setprio(1); _Pragma("unroll") for (int m = 0; m < 4; ++m) _Pragma("unroll") for (int n = 0; n < 2; ++n) _Pragma("unroll") for (int k = 0; k < 2; ++k) \
        acc[ai][bj][m][n] = __builtin_amdgcn_mfma_f32_16x16x32_bf16(Bt[n][k], At[m][k], acc[ai][bj][m][n], 0, 0, 0); __builtin_amdgcn_s_setprio(0); } while (0)
#define G8_WAIT_V(n) asm volatile("s_waitcnt vmcnt(" #n ")" ::: "memory")
#define G8_WAIT_L(n) asm volatile("s_waitcnt lgkmcnt(" #n ")" ::: "memory")
#define G8_BAR __builtin_amdgcn_s_barrier()
#define G8_SCHED __builtin_amdgcn_sched_barrier(0)
#define G8_SETVA(dst, u) do { int _t2 = tid; if (GATHER) asm volatile("" : "+v"(_t2)); _Pragma("unroll") for (int _h = 0; _h < 2; ++_h) _Pragma("unroll") for (int _i = 0; _i < 2; ++_i) { \
        int _R, _C; stage_rc(_t2 * 16 + _i * 8192, _R, _C); \
        const unsigned _rl = (unsigned)(_h * HALF + _R); unsigned _row = _rl; \
        if (GATHER) { _row = 0u; if (_rl < (unsigned)(u).nvalid) _row = (unsigned)(u).rows[_rl] >> 3; } \
        dst[_h][_i] = (_row * (unsigned)lda + (unsigned)_C) * 2u; } } while (0)
    Unit cur, nxt; int ui = 0;
    if (!S.next(0, cur)) return;
    f32x4 acc[2][2][4][2];
#pragma unroll
    for (int a = 0; a < 2; ++a)
#pragma unroll
        for (int b = 0; b < 2; ++b)
#pragma unroll
            for (int m = 0; m < 4; ++m)
#pragma unroll
                for (int n = 0; n < 2; ++n) acc[a][b][m][n] = (f32x4){0.f, 0.f, 0.f, 0.f};
    bf16x8 At[4][2], B0[2][2], B1[2][2];
    unsigned vAc[2][2]; unsigned xl00 = 0, xl01 = 0, xl10 = 0, xl11 = 0;
    G8_SETVA(vAc, cur);
    const char* cA = cur.A; const char* cB = cur.B;
    G8_STAGEB(G8_SB(0, 0), cB); G8_STAGEB(G8_SB(0, 1), cB + hstepB); G8_STAGE2(G8_SA(0, 0), cA, vAc[0][0], vAc[0][1]); G8_STAGE2(G8_SA(0, 1), cA, vAc[1][0], vAc[1][1]);
    if (wr == 1) G8_BAR;
    G8_WAIT_V(2); G8_BAR;
    G8_STAGEB(G8_SB(1, 0), cB + kstep); G8_STAGE2(G8_SA(1, 0), cA + kstep, vAc[0][0], vAc[0][1]); G8_STAGEB(G8_SB(1, 1), cB + hstepB + kstep);
    G8_WAIT_V(6); G8_BAR;
    for (;;) {
        const bool has_next = S.next(ui + 1, nxt);
        const char* nA = has_next ? nxt.A : cA; const char* nB = has_next ? nxt.B : cB;
        if (GATHER) { unsigned vAn[2][2]; if (has_next) { G8_SETVA(vAn, nxt); } else {
#pragma unroll
            for (int h = 0; h < 2; ++h)
#pragma unroll
                for (int i = 0; i < 2; ++i) vAn[h][i] = vAc[h][i]; }
            *stash = (v4u){vAn[0][0], vAn[0][1], vAn[1][0], vAn[1][1]}; }
#pragma unroll 1
        for (int t = 0; t < nt; t += 2) {
            const bool last = (t == nt - 2);
            const char* a1 = cA + (size_t)(t + 1) * kstep;
            const char* a2 = last ? nA : cA + (size_t)(t + 2) * kstep; const char* b2 = last ? nB : cB + (size_t)(t + 2) * kstep;
            const char* a3 = a2 + kstep; const char* b3 = b2 + kstep;
            unsigned x00 = vAc[0][0], x01 = vAc[0][1], x10 = vAc[1][0], x11 = vAc[1][1];
            if (GATHER) { if (last) { const v4u sv = *stash; x00 = sv.x; x01 = sv.y; x10 = sv.z; x11 = sv.w; } xl00 = x00; xl01 = x01; xl10 = x10; xl11 = x11; }
            G8_LDB(B0, 0, 0); G8_LDB(B1, 0, 1); G8_SCHED; G8_LDA(At, 0, 0); G8_STAGE2(G8_SA(1, 1), a1, vAc[1][0], vAc[1][1]);
            G8_WAIT_V(8); G8_WAIT_L(0); G8_BAR; G8_MMA(0, 0, At, B0); G8_MMA(0, 1, At, B1); G8_BAR; G8_SCHED;
            G8_LDA(At, 0, 1); G8_STAGEB(G8_SB(0, 0), b2); G8_STAGEB(G8_SB(0, 1), b2 + hstepB); G8_STAGE2(G8_SA(0, 0), a2, x00, x01);
            G8_WAIT_V(8); G8_WAIT_L(0); G8_BAR; G8_MMA(1, 0, At, B0); G8_MMA(1, 1, At, B1); G8_BAR; G8_SCHED;
            G8_LDB(B0, 1, 0); G8_LDB(B1, 1, 1); G8_SCHED; G8_LDA(At, 1, 0); G8_STAGE2(G8_SA(0, 1), a2, x10, x11);
            G8_WAIT_V(8); G8_WAIT_L(0); G8_BAR; G8_MMA(0, 0, At, B0); G8_MMA(0, 1, At, B1); G8_BAR; G8_SCHED;
            G8_LDA(At, 1, 1); G8_STAGEB(G8_SB(1, 0), b3); G8_STAGEB(G8_SB(1, 1), b3 + hstepB); G8_STAGE2(G8_SA(1, 0), a3, x00, x01);
            G8_WAIT_V(8); G8_WAIT_L(0); G8_BAR; G8_MMA(1, 0, At, B0); G8_MMA(1, 1, At, B1); G8_BAR; G8_SCHED;
        }
        if (wr == 0) G8_BAR;
        E(acc, cur, wr, wc, fr, fq);
        if (!has_next) break;
#pragma unroll
        for (int a = 0; a < 2; ++a)
#pragma unroll
            for (int b = 0; b < 2; ++b)
#pragma unroll
                for (int m = 0; m < 4; ++m)
#pragma unroll
                    for (int n = 0; n < 2; ++n) acc[a][b][m][n] = (f32x4){0.f, 0.f, 0.f, 0.f};
        cur = nxt; cA = nA; cB = nB; ++ui;
        if (GATHER) { vAc[0][0] = xl00; vAc[0][1] = xl01; vAc[1][0] = xl10; vAc[1][1] = xl11; }
        if (wr == 1) G8_BAR;
    }
    G8_WAIT_V(0);
    G8_BAR;
#undef G8_SA
#undef G8_SB
#undef G8_STAGE2
#undef G8_STAGEB
#undef G8_LDA
#undef G8_LDB
#undef G8_MMA
#undef G8_WAIT_V
#undef G8_WAIT_L
#undef G8_BAR
#undef G8_SCHED
#undef G8_SETVA
}

struct DenseSched {
    const char* A; const char* B; size_t a_tile, b_tile, agrp_stride; int agrp_shift, nM, nN, nwg, G, c;
    __device__ __forceinline__ void init(const void* A_, const void* B_, int M, int N, int lda, int ldb, int G_, int c_) {
        A = (const char*)A_; B = (const char*)B_; a_tile = (size_t)BM * lda * 2; b_tile = (size_t)BM * ldb * 2; agrp_stride = 0; agrp_shift = 0; nM = M / BM; nN = N / BM; nwg = nM * nN; G = G_; c = c_; }
    __device__ __forceinline__ bool next(int i, Unit& u) const {
        const long L = (long)i * G + c; if (L >= nwg) return false;
        int wgid = (int)L; { const int q = nwg / NXCD, r = nwg % NXCD, xcd = wgid % NXCD, off = wgid / NXCD; wgid = (xcd < r ? xcd * (q + 1) : r * (q + 1) + (xcd - r) * q) + off; }
        const int nig = WGM * nN, gid = wgid / nig, fm = gid * WGM, gsz = (nM - fm) < WGM ? (nM - fm) : WGM;
        u.pm = fm + ((wgid % nig) % gsz); u.pn = (wgid % nig) / gsz;
        u.A = A + (size_t)u.pm * a_tile + (size_t)(u.pn >> agrp_shift) * agrp_stride; u.B = B + (size_t)u.pn * b_tile; u.rows = nullptr; u.nvalid = BM; u.aux = 0; return true;
    }
};
template <int NPN, bool GATHERED>
struct ExpertSched {
    const LAS int* tpref; const LAS int* cnt; const char* A; const char* B; const int* tok; size_t b_exp, b_tile, a_tile; int NU, G, c;
    __device__ __forceinline__ bool next(int i, Unit& u) const {
        const int L = i * G + c; if (L >= NU) return false;
        const int tile = L / NPN, pn = L % NPN;
        int e = 0; while (__builtin_amdgcn_readfirstlane(tpref[e + 1]) <= tile) ++e;
        const int rb = tile - __builtin_amdgcn_readfirstlane(tpref[e]);
        u.pm = e; u.pn = pn; u.aux = tile * BM; u.nvalid = __builtin_amdgcn_readfirstlane(cnt[e]) - rb * BM; if (u.nvalid > BM) u.nvalid = BM;
        u.rows = tok + (size_t)e * CAP + rb * BM;
        u.A = GATHERED ? A : A + (size_t)tile * a_tile; u.B = B + (size_t)e * b_exp + (size_t)pn * b_tile; return true;
    }
};

struct EpiBf16 {
    static constexpr bool PERM = true;
    bf16* O; int ldc; int qscale;
    __device__ __forceinline__ void operator()(const f32x4 (&acc)[2][2][4][2], const Unit& u, int wr, int wc, int fr, int fq) const {
        asm volatile("" : "+v"(fr), "+v"(fq));
        const int row0 = u.pm * BM + wr * 64 + fr, col0 = u.pn * BM + wc * 32 + 8 * fq;
        const float sc = (qscale && (u.pn % 6) < 2) ? 0.125f : 1.0f;
#pragma unroll
        for (int ai = 0; ai < 2; ++ai)
#pragma unroll
            for (int m = 0; m < 4; ++m) { bf16* rowp = O + (size_t)(row0 + ai * HALF + m * 16) * ldc + col0;
#pragma unroll
                for (int bj = 0; bj < 2; ++bj) { const f32x4 v0 = acc[ai][bj][m][0] * sc, v1 = acc[ai][bj][m][1] * sc;
                    v4u w; w.x = cvt_pk_bf16(v0[0], v0[1]); w.y = cvt_pk_bf16(v0[2], v0[3]); w.z = cvt_pk_bf16(v1[0], v1[1]); w.w = cvt_pk_bf16(v1[2], v1[3]);
                    *(v4u*)(rowp + bj * HALF) = w; } }
    }
};
struct EpiScaleBf16 {
    static constexpr bool PERM = true;
    bf16* O; int ldc; const float* scale;
    __device__ __forceinline__ void operator()(const f32x4 (&acc)[2][2][4][2], const Unit& u, int wr, int wc, int fr, int fq) const {
        asm volatile("" : "+v"(fr), "+v"(fq));
        const int row0 = u.pm * BM + wr * 64 + fr, col0 = u.pn * BM + wc * 32 + 8 * fq;
        f32x4 sv[2][2];
#pragma unroll
        for (int bj = 0; bj < 2; ++bj)
#pragma unroll
            for (int n = 0; n < 2; ++n) sv[bj][n] = *(const f32x4*)(scale + col0 + bj * HALF + 4 * n);
#pragma unroll
        for (int ai = 0; ai < 2; ++ai)
#pragma unroll
            for (int m = 0; m < 4; ++m) { bf16* rowp = O + (size_t)(row0 + ai * HALF + m * 16) * ldc + col0;
#pragma unroll
                for (int bj = 0; bj < 2; ++bj) { const f32x4 v0 = acc[ai][bj][m][0] * sv[bj][0], v1 = acc[ai][bj][m][1] * sv[bj][1];
                    v4u w; w.x = cvt_pk_bf16(v0[0], v0[1]); w.y = cvt_pk_bf16(v0[2], v0[3]); w.z = cvt_pk_bf16(v1[0], v1[1]); w.w = cvt_pk_bf16(v1[2], v1[3]);
                    *(v4u*)(rowp + bj * HALF) = w; } }
    }
};
struct EpiResid {
    static constexpr bool PERM = false;
    const float* X; float* Y;
    __device__ __forceinline__ void operator()(const f32x4 (&acc)[2][2][4][2], const Unit& u, int wr, int wc, int fr, int fq) const {
        asm volatile("" : "+v"(fr), "+v"(fq));
        const int row0 = u.pm * BM + wr * 64 + fr, col0 = u.pn * BM + wc * 32 + 4 * fq;
#pragma unroll
        for (int ai = 0; ai < 2; ++ai)
#pragma unroll
            for (int m = 0; m < 4; ++m) { const size_t off = (size_t)(row0 + ai * HALF + m * 16) * D + col0;
#pragma unroll
                for (int bj = 0; bj < 2; ++bj)
#pragma unroll
                    for (int n = 0; n < 2; ++n) { const f32x4 xv = *(const f32x4*)(X + off + bj * HALF + n * 16); *(f32x4*)(Y + off + bj * HALF + n * 16) = xv * ALPHA + acc[ai][bj][m][n]; } }
    }
};
struct EpiResidLN {
    static constexpr bool PERM = true;
    const float* X32; const bf16* Xb; const float* st; const float* g; const float* b; bf16* Y; float* pst; int mode;
    __device__ __forceinline__ void operator()(const f32x4 (&acc)[2][2][4][2], const Unit& u, int wr, int wc, int fr, int fq) const {
        asm volatile("" : "+v"(fr), "+v"(fq));
        const int row0 = u.pm * BM + wr * 64 + fr, col0 = u.pn * BM + wc * 32 + 8 * fq, lane = fq * 16 + fr;
#pragma unroll
        for (int ai = 0; ai < 2; ++ai)
#pragma unroll
            for (int m = 0; m < 4; ++m) { const int row = row0 + ai * HALF + m * 16; const size_t off = (size_t)row * D + col0;
                float mean = 0.f, rstd = 1.f; if (mode) { const f32x2 sv = *(const f32x2*)(st + 2 * row); mean = sv.x; rstd = sv.y; }
                float sm = 0.f, sq = 0.f;
#pragma unroll
                for (int bj = 0; bj < 2; ++bj) { f32x4 x0, x1;
                    if (mode) { const v4u xv = *(const v4u*)(Xb + off + bj * HALF);
                        const f32x4 g0 = *(const f32x4*)(g + col0 + bj * HALF), g1 = *(const f32x4*)(g + col0 + bj * HALF + 4), b0 = *(const f32x4*)(b + col0 + bj * HALF), b1 = *(const f32x4*)(b + col0 + bj * HALF + 4);
                        x0 = ((f32x4){bflo(xv.x), bfhi(xv.x), bflo(xv.y), bfhi(xv.y)} - mean) * rstd * g0 + b0; x1 = ((f32x4){bflo(xv.z), bfhi(xv.z), bflo(xv.w), bfhi(xv.w)} - mean) * rstd * g1 + b1; }
                    else { x0 = *(const f32x4*)(X32 + off + bj * HALF); x1 = *(const f32x4*)(X32 + off + bj * HALF + 4); }
                    const f32x4 y0 = x0 * ALPHA + acc[ai][bj][m][0], y1 = x1 * ALPHA + acc[ai][bj][m][1];
                    v4u w; w.x = cvt_pk_bf16(y0[0], y0[1]); w.y = cvt_pk_bf16(y0[2], y0[3]); w.z = cvt_pk_bf16(y1[0], y1[1]); w.w = cvt_pk_bf16(y1[2], y1[3]);
                    *(v4u*)(Y + off + bj * HALF) = w;
                    sm += ((y0[0] + y0[1]) + (y0[2] + y0[3])) + ((y1[0] + y1[1]) + (y1[2] + y1[3]));
                    sq += ((y0[0] * y0[0] + y0[1] * y0[1]) + (y0[2] * y0[2] + y0[3] * y0[3])) + ((y1[0] * y1[0] + y1[1] * y1[1]) + (y1[2] * y1[2] + y1[3] * y1[3])); }
                sm += shfl_x(sm, 16, lane); sm += shfl_x(sm, 32, lane); sq += shfl_x(sq, 16, lane); sq += shfl_x(sq, 32, lane);
                if (fq == 0) *(f32x2*)(pst + ((size_t)row * 32 + u.pn * 4 + wc) * 2) = (f32x2){sm, sq}; }
    }
};
struct EpiConvIn {
    static constexpr bool PERM = true;
    bf16* UC; bf16* BGp;
    __device__ __forceinline__ void operator()(const f32x4 (&acc)[2][2][4][2], const Unit& u, int wr, int wc, int fr, int fq) const {
        asm volatile("" : "+v"(fr), "+v"(fq));
        const int row0 = u.pm * BM + wr * 64 + fr, cw = wc * 32 + 8 * fq;
        if (u.pn < 16) {
#pragma unroll
            for (int ai = 0; ai < 2; ++ai)
#pragma unroll
                for (int m = 0; m < 4; ++m) { bf16* rowp = UC + (size_t)(row0 + ai * HALF + m * 16) * D + u.pn * HALF + cw;
                    const f32x4 v0 = acc[ai][0][m][0] * acc[ai][1][m][0], v1 = acc[ai][0][m][1] * acc[ai][1][m][1];
                    v4u w; w.x = cvt_pk_bf16(v0[0], v0[1]); w.y = cvt_pk_bf16(v0[2], v0[3]); w.z = cvt_pk_bf16(v1[0], v1[1]); w.w = cvt_pk_bf16(v1[2], v1[3]);
                    *(v4u*)rowp = w; }
        } else {
#pragma unroll
            for (int ai = 0; ai < 2; ++ai)
#pragma unroll
                for (int m = 0; m < 4; ++m) { bf16* rowp = BGp + (size_t)(row0 + ai * HALF + m * 16) * D + (u.pn - 16) * BM + cw;
#pragma unroll
                    for (int bj = 0; bj < 2; ++bj) { const f32x4 v0 = acc[ai][bj][m][0], v1 = acc[ai][bj][m][1];
                        v4u w; w.x = cvt_pk_bf16(v0[0], v0[1]); w.y = cvt_pk_bf16(v0[2], v0[3]); w.z = cvt_pk_bf16(v1[0], v1[1]); w.w = cvt_pk_bf16(v1[2], v1[3]);
                        *(v4u*)(rowp + bj * HALF) = w; } }
        }
    }
};
__device__ __forceinline__ f32x4 silu_mul(f32x4 g, f32x4 uu) {
    f32x4 r;
#pragma unroll
    for (int j = 0; j < 4; ++j) r[j] = g[j] * __builtin_amdgcn_rcpf(1.0f + __expf(-g[j])) * uu[j];
    return r;
}
struct EpiExpertGU {
    static constexpr bool PERM = true;
    bf16* H;
    __device__ __forceinline__ void operator()(const f32x4 (&acc)[2][2][4][2], const Unit& u, int wr, int wc, int fr, int fq) const {
        asm volatile("" : "+v"(fr), "+v"(fq));
        const float* gates = (const float*)((const char*)u.rows + (WS_LGATE - WS_LTOK));
        const int cw = wc * 32 + 8 * fq;
#pragma unroll
        for (int ai = 0; ai < 2; ++ai)
#pragma unroll
            for (int m = 0; m < 4; ++m) { const int r = ai * HALF + wr * 64 + m * 16 + fr;
                if (r < u.nvalid) { const float gt = gates[r]; const unsigned pid = (unsigned)u.rows[r];
                    const f32x4 v0 = silu_mul(acc[ai][0][m][0], acc[ai][1][m][0]) * gt, v1 = silu_mul(acc[ai][0][m][1], acc[ai][1][m][1]) * gt;
                    v4u w; w.x = cvt_pk_bf16(v0[0], v0[1]); w.y = cvt_pk_bf16(v0[2], v0[3]); w.z = cvt_pk_bf16(v1[0], v1[1]); w.w = cvt_pk_bf16(v1[2], v1[3]);
                    (void)pid; *(v4u*)(H + (size_t)(u.aux + r) * EDIM + cw) = w; } }
    }
};
struct EpiSharedGU {
    static constexpr bool PERM = true;
    bf16* HS;
    __device__ __forceinline__ void operator()(const f32x4 (&acc)[2][2][4][2], const Unit& u, int wr, int wc, int fr, int fq) const {
        asm volatile("" : "+v"(fr), "+v"(fq));
        const int row0 = u.pm * BM + wr * 64 + fr, cw = u.pn * HALF + wc * 32 + 8 * fq;
#pragma unroll
        for (int ai = 0; ai < 2; ++ai)
#pragma unroll
            for (int m = 0; m < 4; ++m) {
                const f32x4 v0 = silu_mul(acc[ai][0][m][0], acc[ai][1][m][0]), v1 = silu_mul(acc[ai][0][m][1], acc[ai][1][m][1]);
                v4u w; w.x = cvt_pk_bf16(v0[0], v0[1]); w.y = cvt_pk_bf16(v0[2], v0[3]); w.z = cvt_pk_bf16(v1[0], v1[1]); w.w = cvt_pk_bf16(v1[2], v1[3]);
                *(v4u*)(HS + (size_t)(row0 + ai * HALF + m * 16) * SDIM + cw) = w; }
    }
};
struct EpiDownY {
    static constexpr bool PERM = true;
    bf16* Y;
    __device__ __forceinline__ void operator()(const f32x4 (&acc)[2][2][4][2], const Unit& u, int wr, int wc, int fr, int fq) const {
        asm volatile("" : "+v"(fr), "+v"(fq));
        const int col0 = u.pn * BM + wc * 32 + 8 * fq;
#pragma unroll
        for (int ai = 0; ai < 2; ++ai)
#pragma unroll
            for (int m = 0; m < 4; ++m) { const int r = ai * HALF + wr * 64 + m * 16 + fr; bf16* rowp = Y + (size_t)(u.aux + r) * D + col0;
#pragma unroll
                for (int bj = 0; bj < 2; ++bj) { const f32x4 v0 = acc[ai][bj][m][0], v1 = acc[ai][bj][m][1];
                    v4u w; w.x = cvt_pk_bf16(v0[0], v0[1]); w.y = cvt_pk_bf16(v0[2], v0[3]); w.z = cvt_pk_bf16(v1[0], v1[1]); w.w = cvt_pk_bf16(v1[2], v1[3]);
                    *(v4u*)(rowp + bj * HALF) = w; } }
    }
};
}

struct Args { const float* in[19]; float* out; unsigned char* ws; int ph_lo, ph_hi; };
struct Frame {
    LAS unsigned char* lds; unsigned* ctl; unsigned char* ws;
    int tid, lane, wave, G, bid;
};
enum { IN_X = 0, IN_RELB, IN_PWIN, IN_PWG, IN_PSC, IN_PWOUT, IN_DQKV, IN_DOUT, IN_CWIN, IN_CW, IN_CWOUT, IN_LNG, IN_LNB, IN_RW, IN_RB, IN_EGU, IN_ED, IN_SGU, IN_SD };

#define CAS __attribute__((address_space(4)))
typedef const CAS unsigned char* KP;
__device__ __forceinline__ const float* ain(KP kp, int i) { return (const float*)((const GAS float* const CAS*)kp)[i]; }
__device__ __forceinline__ float* aout(KP kp) { return (float*)((GAS float* const CAS*)kp)[19]; }
__device__ __forceinline__ void tr_item(const float* W, int K, int N, bf16* WT, int dstK, int mode, LAS float* scr, int item, int lane) {
    const int nblk = N / 32, kb = item / nblk, nb = item % nblk, k0 = 64 * kb, n0 = 32 * nb;
    int r0 = n0;
    if (mode == 1) { const int part = n0 / 2048, j = n0 % 2048; r0 = (part == 0) ? 4096 + j : 256 * (j / 128) + (part == 2 ? 128 : 0) + (j % 128); }
    if (mode == 2) { const int part = n0 / 256, j = n0 % 256; r0 = 256 * (j / 128) + 128 * part + (j % 128); }
#pragma unroll 8
    for (int i = 0; i < 32; ++i) { const int kk = 2 * i + (lane >> 5); scr[kk * 33 + (lane & 31)] = W[(size_t)(k0 + kk) * N + n0 + (lane & 31)]; }
    LDS_WAIT(); asm volatile("" ::: "memory");
    const int c = lane & 7;
#pragma unroll
    for (int j = 0; j < 4; ++j) { const int n = (lane >> 3) + 8 * j; const LAS float* s = scr + (8 * c) * 33 + n;
        v4u o; o.x = pk2(s[0 * 33], s[1 * 33]); o.y = pk2(s[2 * 33], s[3 * 33]); o.z = pk2(s[4 * 33], s[5 * 33]); o.w = pk2(s[6 * 33], s[7 * 33]);
        *(v4u*)(WT + (size_t)(r0 + n) * dstK + k0 + 8 * c) = o; }
    LDS_WAIT(); asm volatile("" ::: "memory");
}
__device__ __forceinline__ void phase_prologue(const Frame& F, KP kp) {
    LAS float* scr = (LAS float*)(F.lds + F.wave * 16384);
    const int gw = F.bid * 8 + F.wave, NGW = F.G * 8;
    constexpr int I0 = 2 * 2048, I1 = 8 * 128, I2 = 2 * 2048, I3 = 4608, I4 = 512, I5 = 6144, I6 = 2048, I7 = 4 * 512, I8 = 4 * 256, I9 = 256 * 256, I10 = 256 * 128;
    constexpr int NITEMS = I0 + I1 + I2 + I3 + I4 + I5 + I6 + I7 + I8 + I9 + I10;
    unsigned char* ws = F.ws;
    for (int it = gw; it < NITEMS; it += NGW) {
        int r = it;
        if (r < I0) { const int b = r / 2048; tr_item(ain(kp, IN_PWIN) + (size_t)b * D * D, D, D, (bf16*)(ws + WS_W_POOL_IN) + (size_t)b * D * D, D, 0, scr, r % 2048, F.lane); continue; } r -= I0;
        if (r < I1) { const int b = r / 128; tr_item(ain(kp, IN_PWG) + (size_t)b * 512 * 512, 512, 512, (bf16*)(ws + WS_W_POOL_G) + (size_t)b * 512 * 512, 512, 0, scr, r % 128, F.lane); continue; } r -= I1;
        if (r < I2) { const int b = r / 2048; tr_item(ain(kp, IN_PWOUT) + (size_t)b * D * D, D, D, (bf16*)(ws + WS_W_POOL_OUT) + (size_t)b * D * D, D, 0, scr, r % 2048, F.lane); continue; } r -= I2;
        if (r < I3) { tr_item(ain(kp, IN_DQKV), D, QKVC, (bf16*)(ws + WS_W_DIL_QKV), D, 0, scr, r, F.lane); continue; } r -= I3;
        if (r < I4) { tr_item(ain(kp, IN_DOUT), DILW, D, (bf16*)(ws + WS_W_DIL_OUT), DILW, 0, scr, r, F.lane); continue; } r -= I4;
        if (r < I5) { tr_item(ain(kp, IN_CWIN), D, 3 * D, (bf16*)(ws + WS_W_CONV_IN), D, 1, scr, r, F.lane); continue; } r -= I5;
        if (r < I6) { tr_item(ain(kp, IN_CWOUT), D, D, (bf16*)(ws + WS_W_CONV_OUT), D, 0, scr, r, F.lane); continue; } r -= I6;
        if (r < I7) { const int b = r / 512; tr_item(ain(kp, IN_SGU) + (size_t)b * D * 512, D, 512, (bf16*)(ws + WS_W_SH_GU) + (size_t)b * 512 * D, D, 2, scr, r % 512, F.lane); continue; } r -= I7;
        if (r < I8) { const int b = r / 256; tr_item(ain(kp, IN_SD) + (size_t)b * SDIM * D, SDIM, D, (bf16*)(ws + WS_W_SH_D) + (size_t)b * D * SDIM, SDIM, 0, scr, r % 256, F.lane); continue; } r -= I8;
        if (r < I9) { const int b = r / 256; tr_item(ain(kp, IN_EGU) + (size_t)b * D * 256, D, 256, (bf16*)(ws + WS_W_EX_GU) + (size_t)b * 256 * D, D, 0, scr, r % 256, F.lane); continue; } r -= I9;
        { const int b = r / 128; tr_item(ain(kp, IN_ED) + (size_t)b * EDIM * D, EDIM, D, (bf16*)(ws + WS_W_EX_D) + (size_t)b * D * EDIM, EDIM, 0, scr, r % 128, F.lane); }
    }
    const size_t gt = (size_t)F.bid * 512 + F.tid, GT = (size_t)F.G * 512;
    { const float* rw = ain(kp, IN_RW); bf16* wh = (bf16*)(ws + WS_RWH); bf16* wl = (bf16*)(ws + WS_RWL);
      for (size_t i = gt; i < (size_t)DEPTH * NEXP * D / 8; i += GT) { const size_t k8 = i % (D / 8), e = (i / (D / 8)) % NEXP, l = i / ((size_t)NEXP * D / 8);
          float v[8]; unsigned hi[8], lo[8];
#pragma unroll
          for (int j = 0; j < 8; ++j) { v[j] = rw[(l * D + k8 * 8 + j) * NEXP + e]; hi[j] = f2bf(v[j]); lo[j] = f2bf(v[j] - __builtin_bit_cast(float, hi[j] << 16)); }
          v4u a, b2; a.x = hi[0] | (hi[1] << 16); a.y = hi[2] | (hi[3] << 16); a.z = hi[4] | (hi[5] << 16); a.w = hi[6] | (hi[7] << 16);
          b2.x = lo[0] | (lo[1] << 16); b2.y = lo[2] | (lo[3] << 16); b2.z = lo[4] | (lo[5] << 16); b2.w = lo[6] | (lo[7] << 16);
          *(v4u*)(wh + (l * NEXP + e) * D + k8 * 8) = a; *(v4u*)(wl + (l * NEXP + e) * D + k8 * 8) = b2; } }
    const float* x = ain(kp, IN_X); bf16* xb = (bf16*)(ws + WS_XB);
    for (size_t i = gt; i < (size_t)T * D / 8; i += GT) { const f32x4 p = *(const f32x4*)(x + i * 8), q = *(const f32x4*)(x + i * 8 + 4);
        v4u w; w.x = pk2(p[0], p[1]); w.y = pk2(p[2], p[3]); w.z = pk2(q[0], q[1]); w.w = pk2(q[2], q[3]); *(v4u*)(xb + i * 8) = w; }
}

__device__ __forceinline__ void unpack8(const v4u w, float (&f)[8]) { f[0] = bflo(w.x); f[1] = bfhi(w.x); f[2] = bflo(w.y); f[3] = bfhi(w.y); f[4] = bflo(w.z); f[5] = bfhi(w.z); f[6] = bflo(w.w); f[7] = bfhi(w.w); }
__device__ __forceinline__ void phase_pool(const Frame& F, const bf16* U, bf16* PL) {
    for (int it = F.bid * 512 + F.tid; it < (T / 32) * 256; it += F.G * 512) {
        const int cv = it & 255, ch = it >> 8, col = cv * 8, w = 2 << (col >> 9);
        const int row0 = ch * 32, pos0 = row0 & (SEQ - 1);
        float s[8], uu[8];
#pragma unroll
        for (int j = 0; j < 8; ++j) s[j] = 0.f;
        for (int j = 1; j < w; ++j) if (pos0 - j >= 0) { unpack8(*(const v4u*)(U + (size_t)(row0 - j) * D + col), uu);
#pragma unroll
            for (int q = 0; q < 8; ++q) s[q] += uu[q]; }
        for (int r = 0; r < 32; ++r) {
            const int t = row0 + r, pos = pos0 + r;
            unpack8(*(const v4u*)(U + (size_t)t * D + col), uu);
            const float inv = 1.0f / (float)((pos + 1) < w ? (pos + 1) : w);
            float o[8];
#pragma unroll
            for (int q = 0; q < 8; ++q) { s[q] += uu[q]; o[q] = s[q] * inv - uu[q]; }
            v4u ww; ww.x = pk2(o[0], o[1]); ww.y = pk2(o[2], o[3]); ww.z = pk2(o[4], o[5]); ww.w = pk2(o[6], o[7]);
            *(v4u*)(PL + (size_t)t * D + col) = ww;
            if (pos - w + 1 >= 0) { unpack8(*(const v4u*)(U + (size_t)(t - w + 1) * D + col), uu);
#pragma unroll
                for (int q = 0; q < 8; ++q) s[q] -= uu[q]; }
        }
    }
}

__device__ __forceinline__ void phase_conv(const Frame& F, const bf16* UC, const bf16* BGp, const float* cw, bf16* Z) {
    for (int it = F.bid * 512 + F.tid; it < T * 256; it += F.G * 512) {
        const int cv = it & 255, t = it >> 8, col = cv * 8, pos = t & (SEQ - 1);
        float u0[8], u1[8], u2[8], bb[8], o[8];
        unpack8(*(const v4u*)(UC + (size_t)t * D + col), u2);
        if (pos >= 1) unpack8(*(const v4u*)(UC + (size_t)(t - 1) * D + col), u1); else {
#pragma unroll
            for (int q = 0; q < 8; ++q) u1[q] = 0.f; }
        if (pos >= 2) unpack8(*(const v4u*)(UC + (size_t)(t - 2) * D + col), u0); else {
#pragma unroll
            for (int q = 0; q < 8; ++q) u0[q] = 0.f; }
        unpack8(*(const v4u*)(BGp + (size_t)t * D + col), bb);
#pragma unroll
        for (int q = 0; q < 8; ++q) o[q] = bb[q] * (cw[col + q] * u0[q] + cw[D + col + q] * u1[q] + cw[2 * D + col + q] * u2[q]);
        v4u ww; ww.x = pk2(o[0], o[1]); ww.y = pk2(o[2], o[3]); ww.z = pk2(o[4], o[5]); ww.w = pk2(o[6], o[7]);
        *(v4u*)(Z + (size_t)t * D + col) = ww;
    }
}

__device__ __forceinline__ int t5_bucket(int dist) {
    if (dist < 16) return dist;
    int large = 16 + (int)(logf((float)dist / 16.0f) / logf(128.0f) * 16.0f);
    return large < 31 ? large : 31;
}
constexpr int AT_KS = 0, AT_KSTR = 144, AT_VT = 256 * 144, AT_VSTR = 520, AT_BIAS = AT_VT + 64 * 520;
__device__ __forceinline__ void phase_attn(const Frame& F, const bf16* QKV, const float* relb, bf16* OG, float* LSE) {
    LAS unsigned char* lds = F.lds;
    const int tid = F.tid, lane = F.lane, w = tid >> 6, fr = lane & 15, fq = lane >> 4;
    for (int unit = F.bid; unit < NBATCH * 3 * 8 * 16; unit += F.G) {
        const int cmb = unit & 15, h = (unit >> 4) & 7, g = (unit >> 7) % 3, b = unit / 384;
        const int dsh = 2 * g, dil = 1 << dsh, r = cmb & (dil - 1), nb = cmb >> dsh;
        const bf16* base = QKV + (size_t)b * SEQ * QKVC + g * 1536 + h * 64;
        __syncthreads();
        {
            const int key = tid >> 1, half = tid & 1, jk = (nb - 1) * 128 + key;
            v4u kv[4], vv[4];
            if (jk >= 0) { const bf16* rp = base + (size_t)(jk * dil + r) * QKVC + half * 32;
#pragma unroll
                for (int i = 0; i < 4; ++i) { kv[i] = *(const v4u*)(rp + 512 + 8 * i); vv[i] = *(const v4u*)(rp + 1024 + 8 * i); } }
            else {
#pragma unroll
                for (int i = 0; i < 4; ++i) { kv[i] = (v4u){0u, 0u, 0u, 0u}; vv[i] = (v4u){0u, 0u, 0u, 0u}; } }
#pragma unroll
            for (int i = 0; i < 4; ++i) *(LAS v4u*)(lds + AT_KS + key * AT_KSTR + half * 64 + 16 * i) = kv[i];
#pragma unroll
            for (int i = 0; i < 4; ++i) {
                const unsigned ww[4] = {vv[i].x, vv[i].y, vv[i].z, vv[i].w};
#pragma unroll
                for (int q = 0; q < 4; ++q) { const int d = half * 32 + 8 * i + 2 * q;
                    *(LAS unsigned short*)(lds + AT_VT + d * AT_VSTR + key * 2) = (unsigned short)(ww[q] & 0xffffu);
                    *(LAS unsigned short*)(lds + AT_VT + (d + 1) * AT_VSTR + key * 2) = (unsigned short)(ww[q] >> 16); } }
            if (tid <= 128) ((LAS float*)(lds + AT_BIAS))[tid] = relb[t5_bucket(tid * dil) * 24 + g * 8 + h];
        }
        __syncthreads();
        int qi = 16 * w + fr; asm volatile("" : "+v"(qi));
        const int jq = nb * 128 + qi, tq = jq * dil + r;
        const bf16* qp = base + (size_t)tq * QKVC + 8 * fq;
        const bf16x8 q0 = *(const bf16x8*)qp, q1 = *(const bf16x8*)(qp + 32);
        f32x4 s[9]; float mx = -INFINITY;
#pragma unroll
        for (int kt = 0; kt < 9; ++kt) {
            const int kb = 16 * (w + kt);
            const bf16x8 k0 = *(const LAS bf16x8*)(lds + AT_KS + (kb + fr) * AT_KSTR + fq * 16), k1 = *(const LAS bf16x8*)(lds + AT_KS + (kb + fr) * AT_KSTR + 64 + fq * 16);
            f32x4 a = (f32x4){0.f, 0.f, 0.f, 0.f};
            a = __builtin_amdgcn_mfma_f32_16x16x32_bf16(k0, q0, a, 0, 0, 0);
            a = __builtin_amdgcn_mfma_f32_16x16x32_bf16(k1, q1, a, 0, 0, 0);
#pragma unroll
            for (int i = 0; i < 4; ++i) { const int kl = kb + 4 * fq + i, rel = qi + 128 - kl;
                const bool ok = (rel >= 0) && (rel <= 128) && (nb > 0 || kl >= 128);
                const int rc = rel < 0 ? 0 : (rel > 128 ? 128 : rel);
                const float v = ok ? a[i] + ((LAS float*)(lds + AT_BIAS))[rc] : -INFINITY;
                a[i] = v; mx = fmaxf(mx, v); }
            s[kt] = a;
        }
        mx = fmaxf(mx, shfl_x(mx, 16, lane)); mx = fmaxf(mx, shfl_x(mx, 32, lane));
        float l = 0.f;
#pragma unroll
        for (int kt = 0; kt < 9; ++kt)
#pragma unroll
            for (int i = 0; i < 4; ++i) { const float p = __expf(s[kt][i] - mx); s[kt][i] = p; l += p; }
        l += shfl_x(l, 16, lane); l += shfl_x(l, 32, lane);
        f32x4 o[4];
#pragma unroll
        for (int nt = 0; nt < 4; ++nt) o[nt] = (f32x4){0.f, 0.f, 0.f, 0.f};
#pragma unroll
        for (int st = 0; st < 5; ++st) {
            const int kt0 = 2 * st, kt1 = 2 * st + 1;
            v4u pw; pw.x = pk2(s[kt0][0], s[kt0][1]); pw.y = pk2(s[kt0][2], s[kt0][3]);
            if (kt1 < 9) { pw.z = pk2(s[kt1 < 9 ? kt1 : 0][0], s[kt1 < 9 ? kt1 : 0][1]); pw.w = pk2(s[kt1 < 9 ? kt1 : 0][2], s[kt1 < 9 ? kt1 : 0][3]); } else { pw.z = 0u; pw.w = 0u; }
            const bf16x8 pf = __builtin_bit_cast(bf16x8, pw);
            const int kb0 = 16 * (w + kt0) + 4 * fq, kb1 = 16 * (w + kt1) + 4 * fq;
#pragma unroll
            for (int nt = 0; nt < 4; ++nt) { const int d = 16 * nt + fr;
                v2u va = *(const LAS v2u*)(lds + AT_VT + d * AT_VSTR + kb0 * 2), vb = (v2u){0u, 0u};
                if (kt1 < 9) vb = *(const LAS v2u*)(lds + AT_VT + d * AT_VSTR + kb1 * 2);
                v4u vw; vw.x = va.x; vw.y = va.y; vw.z = vb.x; vw.w = vb.y;
                o[nt] = __builtin_amdgcn_mfma_f32_16x16x32_bf16(__builtin_bit_cast(bf16x8, vw), pf, o[nt], 0, 0, 0); }
        }
        const float il = 1.0f / l;
        bf16* op = OG + ((size_t)g * T + (size_t)b * SEQ + tq) * DILW + h * 64 + 4 * fq;
#pragma unroll
        for (int nt = 0; nt < 4; ++nt) { v2u ww; ww.x = pk2(o[nt][0] * il, o[nt][1] * il); ww.y = pk2(o[nt][2] * il, o[nt][3] * il); *(v2u*)(op + 16 * nt) = ww; }
        if (fq == 0) LSE[((size_t)g * T + (size_t)b * SEQ + tq) * 8 + h] = mx + logf(l);
    }
}
__device__ __forceinline__ void phase_combine(const Frame& F, const bf16* OG, const float* LSE, bf16* O) {
    for (int it = F.bid * 512 + F.tid; it < T * 64; it += F.G * 512) {
        const int c8 = it & 7, h = (it >> 3) & 7, t = it >> 6;
        const float l0 = LSE[((size_t)0 * T + t) * 8 + h], l1 = LSE[((size_t)1 * T + t) * 8 + h], l2 = LSE[((size_t)2 * T + t) * 8 + h];
        const float m = fmaxf(l0, fmaxf(l1, l2)); float w0 = __expf(l0 - m), w1 = __expf(l1 - m), w2 = __expf(l2 - m); const float inv = 1.0f / (w0 + w1 + w2); w0 *= inv; w1 *= inv; w2 *= inv;
        float a[8], bq[8], c[8], o[8]; const size_t off = (size_t)t * DILW + h * 64 + c8 * 8;
        unpack8(*(const v4u*)(OG + off), a); unpack8(*(const v4u*)(OG + (size_t)T * DILW + off), bq); unpack8(*(const v4u*)(OG + (size_t)2 * T * DILW + off), c);
#pragma unroll
        for (int q = 0; q < 8; ++q) o[q] = w0 * a[q] + w1 * bq[q] + w2 * c[q];
        v4u ww; ww.x = pk2(o[0], o[1]); ww.y = pk2(o[2], o[3]); ww.z = pk2(o[4], o[5]); ww.w = pk2(o[6], o[7]);
        *(v4u*)(O + off) = ww;
    }
}

constexpr int M1_LOG = 131072, M1_STAT = M1_LOG + 4096, M1_HIST = M1_STAT + 128, M1_BASE = M1_HIST + 256;
__device__ __forceinline__ void phase_moe1(const Frame& F, const float* Y, const float* gain, const float* bias, const float* RW, const float* RB,
                                           float* X1F, bf16* X1B, unsigned* cnt, int* ltok, float* lgate, int* eidx, int* inv) {
    LAS float* xs = (LAS float*)F.lds; LAS float* logit = (LAS float*)(F.lds + M1_LOG); LAS float* stat = (LAS float*)(F.lds + M1_STAT);
    LAS int* hist = (LAS int*)(F.lds + M1_HIST); LAS int* basep = (LAS int*)(F.lds + M1_BASE);
    const int tid = F.tid, lane = F.lane, w = F.wave;
    for (int rg = F.bid; rg < T / 16; rg += F.G) {
        const int row0 = rg * 16;
        __syncthreads();
#pragma unroll
        for (int j = 0; j < 16; ++j) { const int idx = tid + 512 * j; *(LAS f32x4*)(xs + idx * 4) = *(const f32x4*)(Y + (size_t)row0 * D + (size_t)idx * 4); }
        if (tid < 64) hist[tid] = 0;
        __syncthreads();
#pragma unroll
        for (int rr = 0; rr < 2; ++rr) { const int r = 2 * w + rr; float sm = 0.f;
#pragma unroll
            for (int j = 0; j < 32; ++j) sm += xs[r * D + lane + 64 * j];
            const float mean = wave_sum(sm, lane) * (1.0f / D); float sq = 0.f;
#pragma unroll
            for (int j = 0; j < 32; ++j) { const float d = xs[r * D + lane + 64 * j] - mean; sq += d * d; }
            const float rstd = 1.0f / sqrtf(wave_sum(sq, lane) * (1.0f / D) + LN_EPS);
            if (lane == 0) { stat[2 * r] = mean; stat[2 * r + 1] = rstd; } }
        __syncthreads();
#pragma unroll
        for (int j = 0; j < 16; ++j) { const int idx = tid + 512 * j, r = idx >> 9, c4 = (idx & 511) * 4;
            const f32x4 v = *(LAS f32x4*)(xs + idx * 4), gv = *(const f32x4*)(gain + c4), bv = *(const f32x4*)(bias + c4);
            const float mean = stat[2 * r], rstd = stat[2 * r + 1];
            const f32x4 o = (v - mean) * rstd * gv + bv;
            *(LAS f32x4*)(xs + idx * 4) = o;
            *(f32x4*)(X1F + (size_t)(row0 + r) * D + c4) = o;
            v2u wb; wb.x = pk2(o[0], o[1]); wb.y = pk2(o[2], o[3]); *(v2u*)(X1B + (size_t)(row0 + r) * D + c4) = wb; }
        __syncthreads();
        { const int r = tid >> 5, ep = tid & 31; float a0 = 0.f, a1 = 0.f; const float* wp = RW + 2 * ep; const LAS float* xr = xs + r * D;
            for (int k0 = 0; k0 < D; k0 += 16) {
                f32x2 wv[16];
#pragma unroll
                for (int j = 0; j < 16; ++j) wv[j] = *(const f32x2*)(wp + (size_t)(k0 + j) * NEXP);
                asm volatile("" : "+v"(wv[0]), "+v"(wv[1]), "+v"(wv[2]), "+v"(wv[3]), "+v"(wv[4]), "+v"(wv[5]), "+v"(wv[6]), "+v"(wv[7]));
                asm volatile("" : "+v"(wv[8]), "+v"(wv[9]), "+v"(wv[10]), "+v"(wv[11]), "+v"(wv[12]), "+v"(wv[13]), "+v"(wv[14]), "+v"(wv[15]));
#pragma unroll
                for (int j = 0; j < 16; ++j) { const float xv = xr[k0 + j]; a0 += xv * wv[j].x; a1 += xv * wv[j].y; } }
            logit[r * NEXP + 2 * ep] = a0; logit[r * NEXP + 2 * ep + 1] = a1; }
        __syncthreads();
        int sel_pos[2]; float sel_gate[2]; int sel_rank[2]; bool sel_on[2];
#pragma unroll
        for (int rr = 0; rr < 2; ++rr) { const int r = 2 * w + rr;
            const float sc = 1.0f / (1.0f + __expf(-logit[r * NEXP + lane])); const float ch = sc + RB[lane];
            int rk = 0;
#pragma unroll
            for (int j = 0; j < 8; ++j) { const float cj = shfl_from(ch, (lane & ~7) + j); rk += (cj > ch || (cj == ch && j < (lane & 7))) ? 1 : 0; }
            float gs = rk < 2 ? ch : 0.f; gs += shfl_x(gs, 1, lane); gs += shfl_x(gs, 2, lane); gs += shfl_x(gs, 4, lane);
            int grk = 0; const int g = lane >> 3;
#pragma unroll
            for (int hh = 0; hh < 8; ++hh) { const float gh = shfl_from(gs, 8 * hh); grk += (gh > gs || (gh == gs && hh < g)) ? 1 : 0; }
            const float msk = grk < 4 ? ch : -INFINITY;
            int erk = 0;
            for (int j = 0; j < 64; ++j) { const float mj = __builtin_bit_cast(float, __builtin_amdgcn_readlane(__builtin_bit_cast(int, msk), j)); erk += (mj > msk || (mj == msk && j < lane)) ? 1 : 0; }
            const bool on = erk < 8;
            const float ssum = wave_sum(on ? sc : 0.f, lane);
            sel_on[rr] = on; sel_rank[rr] = erk; sel_gate[rr] = sc / ssum * 2.5f; sel_pos[rr] = 0;
            if (on) sel_pos[rr] = __hip_atomic_fetch_add(&hist[lane], 1, __ATOMIC_RELAXED, __HIP_MEMORY_SCOPE_WORKGROUP); }
        __syncthreads();
        if (tid < 64) { const int hc = hist[tid]; int bs = 0; if (hc > 0) bs = (int)atomicAdd(&cnt[tid * 16], (unsigned)hc); basep[tid] = bs; }
        __syncthreads();
#pragma unroll
        for (int rr = 0; rr < 2; ++rr) if (sel_on[rr]) { const int t = row0 + 2 * w + rr, pos = basep[lane] + sel_pos[rr];
            ltok[(size_t)lane * CAP + pos] = t; lgate[(size_t)lane * CAP + pos] = sel_gate[rr];
            eidx[t * 8 + sel_rank[rr]] = lane; inv[t * 8 + sel_rank[rr]] = pos; }
    }
}
__device__ __forceinline__ int build_tiles(const Frame& F, const unsigned* cnt) {
    LAS int* tpref = (LAS int*)(F.lds + LDS_TAB); LAS int* cl = (LAS int*)(F.lds + LDS_TAB + 512);
    __syncthreads();
    if (F.tid < 64) cl[F.tid] = (int)__hip_atomic_load(&cnt[F.tid * 16], __ATOMIC_RELAXED, __HIP_MEMORY_SCOPE_AGENT);
    __syncthreads();
    if (F.tid == 0) { int acc = 0; for (int e = 0; e < 64; ++e) { tpref[e] = acc; acc += (cl[e] + 255) >> 8; } tpref[64] = acc; }
    __syncthreads();
    return __builtin_amdgcn_readfirstlane(tpref[64]);
}
__device__ __forceinline__ void phase_moe4(const Frame& F, const float* Y2, const bf16* Yr, const int* eidx, const int* inv, const float* gain, const float* bias, float* XO, bf16* XBo) {
    const LAS int* tpref = (const LAS int*)(F.lds + LDS_TAB);
    const int gw = F.bid * 8 + F.wave, NGW = F.G * 8, lane = F.lane;
    for (int t = gw; t < T; t += NGW) {
        f32x4 v[8];
#pragma unroll
        for (int j = 0; j < 8; ++j) v[j] = *(const f32x4*)(Y2 + (size_t)t * D + 4 * lane + 256 * j);
        for (int k = 0; k < 8; ++k) { const int e = eidx[t * 8 + k], pos = inv[t * 8 + k]; const bf16* yr = Yr + (size_t)(tpref[e] * 256 + pos) * D + 4 * lane;
#pragma unroll
            for (int j = 0; j < 8; ++j) { const v2u w = *(const v2u*)(yr + 256 * j); v[j][0] += bflo(w.x); v[j][1] += bfhi(w.x); v[j][2] += bflo(w.y); v[j][3] += bfhi(w.y); } }
        float sm = 0.f;
#pragma unroll
        for (int j = 0; j < 8; ++j) sm += (v[j][0] + v[j][1]) + (v[j][2] + v[j][3]);
        const float mean = wave_sum(sm, lane) * (1.0f / D); float sq = 0.f;
#pragma unroll
        for (int j = 0; j < 8; ++j) { v[j] = v[j] - mean; sq += (v[j][0] * v[j][0] + v[j][1] * v[j][1]) + (v[j][2] * v[j][2] + v[j][3] * v[j][3]); }
        const float rstd = 1.0f / sqrtf(wave_sum(sq, lane) * (1.0f / D) + LN_EPS);
#pragma unroll
        for (int j = 0; j < 8; ++j) { const int c = 4 * lane + 256 * j; const f32x4 o = v[j] * rstd * *(const f32x4*)(gain + c) + *(const f32x4*)(bias + c);
            *(f32x4*)(XO + (size_t)t * D + c) = o;
            v2u wb; wb.x = pk2(o[0], o[1]); wb.y = pk2(o[2], o[3]); *(v2u*)(XBo + (size_t)t * D + c) = wb; }
    }
}


constexpr int M1_P = 0, M1N_HIST = 131072, M1N_BASE = 131072 + 256, M1N_GB = 131072 + 1024;
__device__ __forceinline__ void phase_moe1n(const Frame& F, const bf16* Y, const float* pst, const float* gain, const float* bias, const bf16* WH, const bf16* WL, const float* RB,
                                            bf16* X1B, float* ST1, unsigned* cnt, int* ltok, float* lgate, int* eidx, int* inv) {
    LAS float* P = (LAS float*)(F.lds + M1_P); LAS int* hist = (LAS int*)(F.lds + M1N_HIST); LAS int* basep = (LAS int*)(F.lds + M1N_BASE);
    const int tid = F.tid, lane = F.lane, w = F.wave, r = lane & 15, q = lane >> 4;
    for (int item = F.bid; item < T / 64; item += F.G) {
        const int row0 = item * 64;
        __syncthreads();
        if (tid < 64) hist[tid] = 0;
        { LAS f32x4* gb = (LAS f32x4*)(F.lds + M1N_GB); gb[tid] = *(const f32x4*)(gain + 4 * tid); gb[512 + tid] = *(const f32x4*)(bias + 4 * tid); }
        __syncthreads();
        float mean[4], rstd[4];
#pragma unroll
        for (int rt = 0; rt < 4; ++rt) { const int row = row0 + 16 * rt + r;
          const f32x4* pp = (const f32x4*)(pst + ((size_t)row * 32 + q * 8) * 2); const f32x4 a = pp[0], b = pp[1], c = pp[2], d = pp[3];
          float sm = (a[0] + a[2]) + (b[0] + b[2]) + (c[0] + c[2]) + (d[0] + d[2]), sq = (a[1] + a[3]) + (b[1] + b[3]) + (c[1] + c[3]) + (d[1] + d[3]);
          sm += shfl_x(sm, 16, lane); sm += shfl_x(sm, 32, lane); sq += shfl_x(sq, 16, lane); sq += shfl_x(sq, 32, lane);
          mean[rt] = sm * (1.0f / D); const float var = fmaxf(sq * (1.0f / D) - mean[rt] * mean[rt], 0.f); rstd[rt] = 1.0f / sqrtf(var + LN_EPS);
          if (w == 0 && q == 0) *(f32x2*)(ST1 + 2 * row) = (f32x2){mean[rt], rstd[rt]}; }
        const int kb = 256 * w + 8 * q;
        const LAS float* gl = (const LAS float*)(F.lds + M1N_GB) + kb;
        f32x4 acc[4][4];
#pragma unroll
        for (int rt = 0; rt < 4; ++rt)
#pragma unroll
            for (int nt = 0; nt < 4; ++nt) acc[rt][nt] = (f32x4){0.f, 0.f, 0.f, 0.f};
        v4u yb[3][4]; bf16x8 wh[4], wl[4];
        unsigned vo[4];
#pragma unroll
        for (int i = 0; i < 4; ++i) { vo[i] = (unsigned)(r * D + kb) * 2u + (unsigned)i * (16u * D * 2u); asm volatile("" : "+v"(vo[i])); }
        const char* ybase = (const char*)(Y + (size_t)row0 * D); char* xbase = (char*)(X1B + (size_t)row0 * D);
#define M1_LOADY(st) do { _Pragma("unroll") for (int rt = 0; rt < 4; ++rt) yb[(st) % 3][rt] = *(const v4u*)(ybase + vo[rt] + 64 * (st)); } while (0)
#define M1_LOADW(st) do { _Pragma("unroll") for (int nt = 0; nt < 4; ++nt) { wh[nt] = *(const bf16x8*)((const char*)WH + vo[nt] + 64 * (st)); wl[nt] = *(const bf16x8*)((const char*)WL + vo[nt] + 64 * (st)); } } while (0)
        M1_LOADY(0); M1_LOADW(0); M1_LOADY(1);
        __builtin_amdgcn_sched_barrier(0);
#pragma unroll
        for (int st = 0; st < 8; ++st) {
            const f32x4 g0 = *(const LAS f32x4*)(gl + 32 * st), g1 = *(const LAS f32x4*)(gl + 32 * st + 4), b0 = *(const LAS f32x4*)(gl + 2048 + 32 * st), b1 = *(const LAS f32x4*)(gl + 2048 + 32 * st + 4);
#pragma unroll
            for (int rt = 0; rt < 4; ++rt) { const v4u yv = yb[st % 3][rt];
                const f32x4 y0_ = (f32x4){bflo(yv.x), bfhi(yv.x), bflo(yv.y), bfhi(yv.y)}, y1_ = (f32x4){bflo(yv.z), bfhi(yv.z), bflo(yv.w), bfhi(yv.w)};
                const f32x4 x0 = (y0_ - mean[rt]) * rstd[rt] * g0 + b0, x1 = (y1_ - mean[rt]) * rstd[rt] * g1 + b1;
                v4u h; h.x = cvt_pk_bf16(x0[0], x0[1]); h.y = cvt_pk_bf16(x0[2], x0[3]); h.z = cvt_pk_bf16(x1[0], x1[1]); h.w = cvt_pk_bf16(x1[2], x1[3]);
                *(v4u*)(xbase + vo[rt] + 64 * st) = h;
                v4u l; l.x = cvt_pk_bf16(x0[0] - bflo(h.x), x0[1] - bfhi(h.x)); l.y = cvt_pk_bf16(x0[2] - bflo(h.y), x0[3] - bfhi(h.y));
                l.z = cvt_pk_bf16(x1[0] - bflo(h.z), x1[1] - bfhi(h.z)); l.w = cvt_pk_bf16(x1[2] - bflo(h.w), x1[3] - bfhi(h.w));
                const bf16x8 xh = __builtin_bit_cast(bf16x8, h), xl = __builtin_bit_cast(bf16x8, l);
#pragma unroll
                for (int nt = 0; nt < 4; ++nt) { acc[rt][nt] = __builtin_amdgcn_mfma_f32_16x16x32_bf16(xh, wh[nt], acc[rt][nt], 0, 0, 0);
                    acc[rt][nt] = __builtin_amdgcn_mfma_f32_16x16x32_bf16(xl, wh[nt], acc[rt][nt], 0, 0, 0); acc[rt][nt] = __builtin_amdgcn_mfma_f32_16x16x32_bf16(xh, wl[nt], acc[rt][nt], 0, 0, 0); } }
            __builtin_amdgcn_sched_barrier(0);
            if (st + 1 < 8) M1_LOADW(st + 1);
            if (st + 2 < 8) M1_LOADY(st + 2);
            __builtin_amdgcn_sched_barrier(0);
        }
#undef M1_LOADY
#undef M1_LOADW
#pragma unroll
        for (int rt = 0; rt < 4; ++rt)
#pragma unroll
            for (int nt = 0; nt < 4; ++nt)
#pragma unroll
                for (int i = 0; i < 4; ++i) P[(w * 64 + 16 * rt + 4 * q + i) * 64 + 16 * nt + r] = acc[rt][nt][i];
        __syncthreads();
        int sel_pos[8]; float sel_gate[8]; int sel_rank[8]; bool sel_on[8];
        const float rb = RB[lane];
#pragma unroll
        for (int rr = 0; rr < 8; ++rr) { const int rl = 8 * w + rr;
            float lg = ((P[rl * 64 + lane] + P[(64 + rl) * 64 + lane]) + (P[(128 + rl) * 64 + lane] + P[(192 + rl) * 64 + lane])) + ((P[(256 + rl) * 64 + lane] + P[(320 + rl) * 64 + lane]) + (P[(384 + rl) * 64 + lane] + P[(448 + rl) * 64 + lane]));
            lg = (lg == lg) ? lg : -1.0e30f;
            const float sc = 1.0f / (1.0f + __expf(-lg)); const float ch = sc + rb;
            int rk = 0;
#pragma unroll
            for (int j = 0; j < 8; ++j) { const float cj = shfl_from(ch, (lane & ~7) + j); rk += (cj > ch || (cj == ch && j < (lane & 7))) ? 1 : 0; }
            float gs = rk < 2 ? ch : 0.f; gs += shfl_x(gs, 1, lane); gs += shfl_x(gs, 2, lane); gs += shfl_x(gs, 4, lane);
            int grk = 0; const int g = lane >> 3;
#pragma unroll
            for (int hh = 0; hh < 8; ++hh) { const float gh = shfl_from(gs, 8 * hh); grk += (gh > gs || (gh == gs && hh < g)) ? 1 : 0; }
            const float msk = grk < 4 ? ch : -INFINITY;
            int erk = 0;
            for (int j = 0; j < 64; ++j) { const float mj = __builtin_bit_cast(float, __builtin_amdgcn_readlane(__builtin_bit_cast(int, msk), j)); erk += (mj > msk || (mj == msk && j < lane)) ? 1 : 0; }
            const bool on = erk < 8;
            const float ssum = wave_sum(on ? sc : 0.f, lane);
            sel_on[rr] = on; sel_rank[rr] = erk; sel_gate[rr] = sc / ssum * 2.5f; sel_pos[rr] = 0;
            if (on) sel_pos[rr] = __hip_atomic_fetch_add(&hist[lane], 1, __ATOMIC_RELAXED, __HIP_MEMORY_SCOPE_WORKGROUP); }
        __syncthreads();
        if (tid < 64) { int tt = tid; asm volatile("" : "+v"(tt));
            const int hc = hist[tt]; int bs = 0; if (hc > 0) bs = (int)atomicAdd(&cnt[tt * 16], (unsigned)hc); basep[tt] = bs; }
        __syncthreads();
#pragma unroll
        for (int rr = 0; rr < 8; ++rr) if (sel_on[rr]) { const int t = row0 + 8 * w + rr, pos = basep[lane] + sel_pos[rr];
            ltok[(size_t)lane * CAP + pos] = t * 8 + sel_rank[rr]; lgate[(size_t)lane * CAP + pos] = sel_gate[rr];
            eidx[t * 8 + sel_rank[rr]] = lane; inv[t * 8 + sel_rank[rr]] = pos; }
    }
}

constexpr int M3_PL = 131072, M3_CNT = 147456, M3_OFF = 147456 + 272;
__device__ __forceinline__ void phase_moe3n(const Frame& F, const bf16* H, const bf16* HSp, const int* eidx, const bf16* WD, const bf16* WSD,
                                            const float* Y1, const float* ST1, const float* g1, const float* b1, float* Y2, float* PST2) {
    LAS int* out = (LAS int*)F.lds; LAS unsigned short* plist = (LAS unsigned short*)(F.lds + M3_PL); LAS int* cnt = (LAS int*)(F.lds + M3_CNT); LAS int* off = (LAS int*)(F.lds + M3_OFF);
    const int tid = F.tid, lane = F.lane, w = F.wave, r = lane & 15, q = lane >> 4;
    for (int u = F.bid; u < 1024; u += F.G) {
        int nc = (u & 7) | ((u >> 7) << 3), tb = (u >> 3) & 15;
        if (F.G == 256) { const int i = u >> 8, x = u & 7, j = (u >> 3) & 31; tb = 2 * x + (i >> 1); nc = 32 * (i & 1) + j; }
        __syncthreads();
#pragma unroll
        for (int j = 0; j < 16; ++j) ((LAS v4u*)out)[tid + 512 * j] = (v4u){0u, 0u, 0u, 0u};
        if (tid < 66) cnt[tid] = 0;
        __syncthreads();
        int ee[16], pp[16];
        { const v4u* ep = (const v4u*)(eidx + ((size_t)tb * 1024 + 2 * tid) * 8); const v4u e0 = ep[0], e1 = ep[1], e2 = ep[2], e3 = ep[3];
          ee[0] = e0.x; ee[1] = e0.y; ee[2] = e0.z; ee[3] = e0.w; ee[4] = e1.x; ee[5] = e1.y; ee[6] = e1.z; ee[7] = e1.w;
          ee[8] = e2.x; ee[9] = e2.y; ee[10] = e2.z; ee[11] = e2.w; ee[12] = e3.x; ee[13] = e3.y; ee[14] = e3.z; ee[15] = e3.w; }
#pragma unroll
        for (int j = 0; j < 16; ++j) pp[j] = __hip_atomic_fetch_add(&cnt[ee[j]], 1, __ATOMIC_RELAXED, __HIP_MEMORY_SCOPE_WORKGROUP);
        __syncthreads();
        if (w == 0) { int c = cnt[lane], x = c;
#pragma unroll
            for (int o = 1; o < 64; o <<= 1) { const int y = __builtin_amdgcn_ds_bpermute(((lane - o) & 63) << 2, x); if (lane >= o) x += y; }
            off[lane] = x - c; if (lane == 63) off[64] = x; }
        __syncthreads();
#pragma unroll
        for (int j = 0; j < 16; ++j) plist[off[ee[j]] + pp[j]] = (unsigned short)(tid * 16 + j);
        __syncthreads();
        const char* Hb = (const char*)H + (size_t)tb * 8192 * 256 + q * 16;
        const char* HSb = (const char*)HSp + (size_t)tb * 1024 * 512 + q * 16;
        const char* Bb = (const char*)WD + ((size_t)nc * 32 + r) * 256 + q * 16;
        const char* BSb = (const char*)WSD + ((size_t)nc * 32 + r) * 512 + q * 16;
#define M3_NR(sg) ((sg) < 8 ? __builtin_amdgcn_readfirstlane(cnt[w + 8 * (sg)]) : 128)
#define M3_RB(sg) ((sg) < 8 ? __builtin_amdgcn_readfirstlane(off[w + 8 * (sg)]) : 0)
#define M3_GLD(dst, ptr, OFF) asm volatile("global_load_dwordx4 %0, %1, off offset:" #OFF : "=&v"(dst) : "v"(ptr) : "memory")
#define M3_LOADB(dst, sg) do { const char* _b0 = (sg) < 8 ? Bb + (size_t)(w + 8 * (sg)) * 524288 : BSb + ((sg) - 8) * 256; const char* _b1 = _b0 + ((sg) < 8 ? 4096 : 8192); \
            M3_GLD(dst[0][0], _b0, 0); M3_GLD(dst[0][1], _b0, 64); M3_GLD(dst[0][2], _b0, 128); M3_GLD(dst[0][3], _b0, 192); \
            M3_GLD(dst[1][0], _b1, 0); M3_GLD(dst[1][1], _b1, 64); M3_GLD(dst[1][2], _b1, 128); M3_GLD(dst[1][3], _b1, 192); } while (0)
#define M3_LOADA(dst, sg, bb, nr, rbs) do { int _i = 16 * (bb) + r; _i = _i < (nr) ? _i : (nr) - 1; const unsigned _rid = plist[(rbs) + _i]; \
            const char* _a = (sg) < 8 ? Hb + (size_t)_rid * 256 : ((sg) < 10 ? HSb + (size_t)(128 * w + _i) * 512 + ((sg) - 8) * 256 : Hb); \
            M3_GLD(dst[0], _a, 0); M3_GLD(dst[1], _a, 64); M3_GLD(dst[2], _a, 128); M3_GLD(dst[3], _a, 192); } while (0)
#define M3_ADV(sg, bb, nr, rbs) do { if ((sg) < 10) { ++(bb); if ((bb) * 16 >= (nr)) { (bb) = 0; do { ++(sg); } while ((sg) < 8 && M3_NR(sg) == 0); if ((sg) < 10) { (nr) = M3_NR(sg); (rbs) = M3_RB(sg); } } } } while (0)
#define M3_WAITA(AS) asm volatile("s_waitcnt vmcnt(12)" : "+v"(AS[0]), "+v"(AS[1]), "+v"(AS[2]), "+v"(AS[3]) :: "memory")
#define M3_WAITB(N) asm volatile("s_waitcnt vmcnt(" #N ")" : "+v"(Bn[0][0]), "+v"(Bn[0][1]), "+v"(Bn[0][2]), "+v"(Bn[0][3]), "+v"(Bn[1][0]), "+v"(Bn[1][1]), "+v"(Bn[1][2]), "+v"(Bn[1][3]) :: "memory")
#define M3_STEP(AS) if (cseg < 10) { \
              \
            int tk[4]; bool ok[4]; unsigned pl[4]; const int rt_ = cseg < 8; \
            _Pragma("unroll") for (int i = 0; i < 4; ++i) { const int idx = 16 * cbt + 4 * q + i; ok[i] = idx < cnr; const int ic = ok[i] ? idx : cnr - 1; pl[i] = plist[crbs + ic]; tk[i] = 128 * w + ic; } \
            _Pragma("unroll") for (int i = 0; i < 4; ++i) tk[i] = rt_ ? (int)(pl[i] >> 3) : tk[i]; \
            M3_WAITA(AS); \
            f32x4 acc[2]; \
            _Pragma("unroll") for (int nt = 0; nt < 2; ++nt) { acc[nt] = (f32x4){0.f, 0.f, 0.f, 0.f}; \
                _Pragma("unroll") for (int kk = 0; kk < 4; ++kk) acc[nt] = __builtin_amdgcn_mfma_f32_16x16x32_bf16(__builtin_bit_cast(bf16x8, AS[kk]), __builtin_bit_cast(bf16x8, Bc[nt][kk]), acc[nt], 0, 0, 0); } \
              \
            _Pragma("unroll") for (int i = 0; i < 4; ++i) { const long long lo_ = ok[i] ? (long long)__float2int_rn(acc[0][i] * 4194304.0f) : 0ll, hi_ = ok[i] ? (long long)__float2int_rn(acc[1][i] * 4194304.0f) : 0ll; \
                (void)__hip_atomic_fetch_add((LAS unsigned long long*)out + tk[i] * 16 + r, (unsigned long long)((hi_ << 32) + lo_), __ATOMIC_RELAXED, __HIP_MEMORY_SCOPE_WORKGROUP); } \
            M3_LOADA(AS, pseg, pbt, pnr, prbs); M3_ADV(pseg, pbt, pnr, prbs); \
            { const int old_ = cseg, nbat_ = (cnr + 15) >> 4; M3_ADV(cseg, cbt, cnr, crbs); \
              if (cseg != old_ && cseg < 10) { \
                  if (nbat_ == 1) M3_WAITB(4); else if (nbat_ == 2) M3_WAITB(8); else if (nbat_ == 3) M3_WAITB(12); else M3_WAITB(16); \
                  _Pragma("unroll") for (int nt = 0; nt < 2; ++nt) _Pragma("unroll") for (int kk = 0; kk < 4; ++kk) Bc[nt][kk] = Bn[nt][kk]; \
                  int nb_ = cseg; do { ++nb_; } while (nb_ < 8 && M3_NR(nb_) == 0); if (nb_ >= 10) nb_ = 9; M3_LOADB(Bn, nb_); } } }
        int cseg = -1, cbt = 0, cnr = 0, crbs = 0;
        do { ++cseg; } while (cseg < 8 && M3_NR(cseg) == 0);
        cnr = M3_NR(cseg); crbs = M3_RB(cseg);
        int pseg = cseg, pbt = 0, pnr = cnr, prbs = crbs;
        v4u Bc[2][4], Bn[2][4], A0[4], A1[4], A2[4], A3[4];
        M3_LOADB(Bc, cseg);
        M3_LOADA(A0, pseg, pbt, pnr, prbs); M3_ADV(pseg, pbt, pnr, prbs);
        M3_LOADA(A1, pseg, pbt, pnr, prbs); M3_ADV(pseg, pbt, pnr, prbs);
        M3_LOADA(A2, pseg, pbt, pnr, prbs); M3_ADV(pseg, pbt, pnr, prbs);
        M3_LOADA(A3, pseg, pbt, pnr, prbs); M3_ADV(pseg, pbt, pnr, prbs);
        { int nb_ = cseg; do { ++nb_; } while (nb_ < 8 && M3_NR(nb_) == 0); if (nb_ >= 10) nb_ = 9; M3_LOADB(Bn, nb_); }
        asm volatile("s_waitcnt vmcnt(0)" : "+v"(Bc[0][0]), "+v"(Bc[0][1]), "+v"(Bc[0][2]), "+v"(Bc[0][3]), "+v"(Bc[1][0]), "+v"(Bc[1][1]), "+v"(Bc[1][2]), "+v"(Bc[1][3]) :: "memory");
#pragma unroll 1
        while (cseg < 10) { M3_STEP(A0) M3_STEP(A1) M3_STEP(A2) M3_STEP(A3) }
        asm volatile("s_waitcnt vmcnt(0)" : "+v"(A0[0]), "+v"(A0[1]), "+v"(A0[2]), "+v"(A0[3]), "+v"(A1[0]), "+v"(A1[1]), "+v"(A1[2]), "+v"(A1[3]), "+v"(A2[0]), "+v"(A2[1]), "+v"(A2[2]), "+v"(A2[3]),
                     "+v"(A3[0]), "+v"(A3[1]), "+v"(A3[2]), "+v"(A3[3]), "+v"(Bn[0][0]), "+v"(Bn[0][1]), "+v"(Bn[0][2]), "+v"(Bn[0][3]), "+v"(Bn[1][0]), "+v"(Bn[1][1]), "+v"(Bn[1][2]), "+v"(Bn[1][3]) :: "memory");
#undef M3_NR
#undef M3_RB
#undef M3_GLD
#undef M3_LOADB
#undef M3_LOADA
#undef M3_ADV
#undef M3_WAITA
#undef M3_WAITB
#undef M3_STEP
        __syncthreads();
        { const int c4 = lane & 7, rs = lane >> 3, col = nc * 32 + 4 * c4;
          const f32x4 gv = *(const f32x4*)(g1 + col), bv = *(const f32x4*)(b1 + col);
#pragma unroll 4
          for (int it = 0; it < 16; ++it) { const int rl = 128 * w + 8 * it + rs; const size_t row = (size_t)tb * 1024 + rl;
              const f32x4 yv = *(const f32x4*)(Y1 + row * D + col); const f32x2 sv = *(const f32x2*)(ST1 + 2 * row);
              f32x4 tv; { const int nt = c4 >> 2, r0 = (4 * c4) & 15;
#pragma unroll
                  for (int j = 0; j < 4; ++j) { const v2u cell = *(const LAS v2u*)(out + rl * 32 + 2 * (r0 + j)); const int lo = (int)cell.x, hi = (int)cell.y + (lo < 0 ? 1 : 0); tv[j] = (float)(nt ? hi : lo) * (1.0f / 4194304.0f); } }
              const f32x4 y = ((yv - sv.x) * sv.y * gv + bv) * ALPHA + tv;
              *(f32x4*)(Y2 + row * D + col) = y;
              float sm = (y[0] + y[1]) + (y[2] + y[3]), sq = (y[0] * y[0] + y[1] * y[1]) + (y[2] * y[2] + y[3] * y[3]);
#pragma unroll
              for (int o = 1; o < 8; o <<= 1) { sm += shfl_x(sm, o, lane); sq += shfl_x(sq, o, lane); }
              if (c4 == 0) *(f32x2*)(PST2 + (row * 64 + nc) * 2) = (f32x2){sm, sq}; } }
    }
}

__device__ __forceinline__ void phase_moe4n(const Frame& F, const float* Y2, const float* pst, const float* gain, const float* bias, float* ST2, bf16* XBo, float* OUT, int last) {
    const int gw = F.bid * 8 + F.wave, NGW = F.G * 8, lane = F.lane;
    for (int t = gw; t < T; t += NGW) {
        f32x4 v[8];
#pragma unroll
        for (int j = 0; j < 8; ++j) v[j] = *(const f32x4*)(Y2 + (size_t)t * D + 4 * lane + 256 * j);
        const f32x2 pv = *(const f32x2*)(pst + ((size_t)t * 64 + lane) * 2);
        const float mean = wave_sum(pv.x, lane) * (1.0f / D); const float var = fmaxf(wave_sum(pv.y, lane) * (1.0f / D) - mean * mean, 0.f); const float rstd = 1.0f / sqrtf(var + LN_EPS);
        if (lane == 0) *(f32x2*)(ST2 + 2 * (size_t)t) = (f32x2){mean, rstd};
#pragma unroll
        for (int j = 0; j < 8; ++j) { const int c = 4 * lane + 256 * j; const f32x4 o = (v[j] - mean) * rstd * *(const f32x4*)(gain + c) + *(const f32x4*)(bias + c);
            if (last) *(f32x4*)(OUT + (size_t)t * D + c) = o;
            else { v2u wb; wb.x = pk2(o[0], o[1]); wb.y = pk2(o[2], o[3]); *(v2u*)(XBo + (size_t)t * D + c) = wb; } }
    }
}


__device__ __forceinline__ void phase_moe4q(const Frame& F, bf16* Y2, const unsigned char* Yq, const float* Ysc, const int* eidx, const int* inv, const float* gain, const float* bias, float* ST2, bf16* XBo, float* OUT, int last) {
    const LAS int* tpref = (const LAS int*)(F.lds + LDS_TAB);
    const int gw = F.bid * 8 + F.wave, NGW = F.G * 8, lane = F.lane;
    for (int t = gw; t < T; t += NGW) {
        int rowi = 0; if (lane < 8) { const int e = eidx[t * 8 + lane], ps = inv[t * 8 + lane]; rowi = tpref[e] * 256 + ps; }
        v4u pv[2][2], yv[8][2]; float sc[8][2];
#pragma unroll
        for (int j = 0; j < 2; ++j) { pv[j][0] = *(const v4u*)(Y2 + (size_t)t * D + 16 * lane + 1024 * j); pv[j][1] = *(const v4u*)(Y2 + (size_t)t * D + 16 * lane + 1024 * j + 8); }
#pragma unroll
        for (int k = 0; k < 8; ++k) { const size_t row = (size_t)__builtin_amdgcn_readlane(rowi, k);
#pragma unroll
            for (int j = 0; j < 2; ++j) { yv[k][j] = *(const v4u*)(Yq + row * D + 16 * lane + 1024 * j); sc[k][j] = Ysc[row * 16 + 8 * j + (lane >> 3)]; } }
#pragma unroll
        for (int k = 0; k < 8; ++k) asm volatile("" : "+v"(yv[k][0]), "+v"(yv[k][1]), "+v"(sc[k][0]), "+v"(sc[k][1]));
        float v[2][16];
#pragma unroll
        for (int j = 0; j < 2; ++j) { float f0[8], f1[8]; unpack8(pv[j][0], f0); unpack8(pv[j][1], f1);
            const float ss = ((sc[0][j] + sc[1][j]) + (sc[2][j] + sc[3][j])) + ((sc[4][j] + sc[5][j]) + (sc[6][j] + sc[7][j]));
#pragma unroll
            for (int i = 0; i < 8; ++i) { v[j][i] = f0[i] - 128.f * ss; v[j][8 + i] = f1[i] - 128.f * ss; } }
#pragma unroll
        for (int k = 0; k < 8; ++k)
#pragma unroll
            for (int j = 0; j < 2; ++j) { const float s_ = sc[k][j]; const unsigned q[4] = {yv[k][j].x, yv[k][j].y, yv[k][j].z, yv[k][j].w};
#pragma unroll
                for (int d = 0; d < 4; ++d) { v[j][4 * d + 0] += s_ * (float)(q[d] & 0xffu); v[j][4 * d + 1] += s_ * (float)((q[d] >> 8) & 0xffu); v[j][4 * d + 2] += s_ * (float)((q[d] >> 16) & 0xffu); v[j][4 * d + 3] += s_ * (float)(q[d] >> 24); } }
        float sm = 0.f;
#pragma unroll
        for (int j = 0; j < 2; ++j)
#pragma unroll
            for (int i = 0; i < 16; i += 4) sm += (v[j][i] + v[j][i + 1]) + (v[j][i + 2] + v[j][i + 3]);
        const float mean = wave_sum(sm, lane) * (1.0f / D); float sq = 0.f;
#pragma unroll
        for (int j = 0; j < 2; ++j)
#pragma unroll
            for (int i = 0; i < 16; ++i) { const float d = v[j][i] - mean; sq += d * d; }
        const float rstd = 1.0f / sqrtf(wave_sum(sq, lane) * (1.0f / D) + LN_EPS);
        if (lane == 0) *(f32x2*)(ST2 + 2 * (size_t)t) = (f32x2){mean, rstd};
#pragma unroll
        for (int j = 0; j < 2; ++j)
#pragma unroll
            for (int h = 0; h < 2; ++h) { const int c = 16 * lane + 1024 * j + 8 * h; const float* vv = &v[j][8 * h];
                if (!last) { v4u yw; yw.x = pk2(vv[0], vv[1]); yw.y = pk2(vv[2], vv[3]); yw.z = pk2(vv[4], vv[5]); yw.w = pk2(vv[6], vv[7]); *(v4u*)(Y2 + (size_t)t * D + c) = yw; }
                const f32x4 g0 = *(const f32x4*)(gain + c), g1 = *(const f32x4*)(gain + c + 4), b0 = *(const f32x4*)(bias + c), b1 = *(const f32x4*)(bias + c + 4);
                const f32x4 o0 = ((f32x4){vv[0], vv[1], vv[2], vv[3]} - mean) * rstd * g0 + b0, o1 = ((f32x4){vv[4], vv[5], vv[6], vv[7]} - mean) * rstd * g1 + b1;
                if (last) { *(f32x4*)(OUT + (size_t)t * D + c) = o0; *(f32x4*)(OUT + (size_t)t * D + c + 4) = o1; }
                else { v4u wb; wb.x = pk2(o0[0], o0[1]); wb.y = pk2(o0[2], o0[3]); wb.z = pk2(o1[0], o1[1]); wb.w = pk2(o1[2], o1[3]); *(v4u*)(XBo + (size_t)t * D + c) = wb; } }
    }
}

__device__ __forceinline__ void phase_downproj3(const Frame& F, const bf16* H, const bf16* WD, unsigned char* Yq, float* Ysc, int NT) {
    const LAS int* tpref = (const LAS int*)(F.lds + LDS_TAB); const LAS int* cl = (const LAS int*)(F.lds + LDS_TAB + 512);
    LAS unsigned char* lds = F.lds;
    const int tid = F.tid, lane = F.lane, w = F.wave, fr = lane & 15, fq = lane >> 4;
    unsigned voffB[2];
#pragma unroll
    for (int i = 0; i < 2; ++i) { int R_, C_; g8::stage_rc(tid * 16 + i * 8192, R_, C_); const int Rb = (R_ & ~31) + g8::perm32(R_ & 31); voffB[i] = (unsigned)(Rb * EDIM + C_) * 2u; }
    const unsigned ldsw = (unsigned)w * 1024u, lbase = (unsigned)(size_t)lds;
    int boffg[4];
#pragma unroll
    for (int g = 0; g < 4; ++g) boffg[g] = g8::lds_byte(32 * g + fr, fq * 8);
    LAS unsigned char* stg = lds + 65536 + w * (32 * 144);
    const int NU = NT * 4;
    int u = F.bid; if (u >= NU) return;
#define DP3_UNITINFO(uu, EXP, NV) do { const int tl_ = (uu) >> 2; int e_ = 0; while (__builtin_amdgcn_readfirstlane(tpref[e_ + 1]) <= tl_) ++e_; EXP = e_; \
        NV = __builtin_amdgcn_readfirstlane(cl[e_]) - (tl_ - __builtin_amdgcn_readfirstlane(tpref[e_])) * 256; } while (0)
#define DP3_GLDS(gsrc, ldsdst) do { unsigned keep_; asm volatile("s_mov_b32 %0, m0\n\ts_mov_b32 m0, %2\n\ts_nop 0\n\tglobal_load_lds_dwordx4 %1, off\n\ts_mov_b32 m0, %0" : "=&s"(keep_) : "v"(gsrc), "s"(ldsdst) : "memory"); } while (0)
#define DP3_STAGE(slot, gb) do { _Pragma("unroll") for (int kt = 0; kt < 2; ++kt) { \
        DP3_GLDS((const void*)((gb) + kt * 128 + voffB[0]), lbase + (unsigned)((slot) * 32768 + kt * 16384) + ldsw); \
        DP3_GLDS((const void*)((gb) + kt * 128 + voffB[1]), lbase + (unsigned)((slot) * 32768 + kt * 16384) + ldsw + 8192u); } } while (0)
#define DP3_LOADA(dst, uu) do { const bf16* ap_ = H + (size_t)(((uu) >> 2) * 256 + 32 * w + fr) * EDIM + 8 * fq; \
        _Pragma("unroll") for (int m = 0; m < 2; ++m) _Pragma("unroll") for (int kk = 0; kk < 4; ++kk) dst[m][kk] = *(const bf16x8*)(ap_ + (size_t)m * 16 * EDIM + 32 * kk); } while (0)
    int ecur, nvcur; DP3_UNITINFO(u, ecur, nvcur);
    bf16x8 A[2][4], An[2][4];
    DP3_LOADA(A, u);
    { const char* gb = (const char*)(WD + (size_t)ecur * D * EDIM + (size_t)((u & 3) * 512) * EDIM); DP3_STAGE(0, gb); }
    asm volatile("s_waitcnt vmcnt(0)" ::: "memory");
#pragma unroll 1
    for (;;) {
        const int un = (u + F.G < NU) ? u + F.G : u; int enx, nvnx; DP3_UNITINFO(un, enx, nvnx);
        const char* gbc = (const char*)(WD + (size_t)ecur * D * EDIM + (size_t)((u & 3) * 512) * EDIM);
        const char* gbn = (const char*)(WD + (size_t)enx * D * EDIM + (size_t)((un & 3) * 512) * EDIM);
        const int tile = u >> 2, colu = (u & 3) * 512;
        float scq[2][4];
#pragma unroll
        for (int c = 0; c < 4; ++c) {
            if (c == 0) asm volatile("s_waitcnt vmcnt(5)" ::: "memory"); else asm volatile("s_waitcnt vmcnt(4)" ::: "memory");
            __builtin_amdgcn_s_barrier();
            if (c == 3) { const bf16* ap_ = H + (size_t)((un >> 2) * 256 + 32 * w + fr) * EDIM + 8 * fq;
#pragma unroll
                for (int m = 0; m < 2; ++m) { const bf16* am_ = ap_ + (size_t)m * 16 * EDIM;
                    asm volatile("global_load_dwordx4 %0, %1, off" : "=&v"(An[m][0]) : "v"(am_) : "memory"); asm volatile("global_load_dwordx4 %0, %1, off offset:64" : "=&v"(An[m][1]) : "v"(am_) : "memory");
                    asm volatile("global_load_dwordx4 %0, %1, off offset:128" : "=&v"(An[m][2]) : "v"(am_) : "memory"); asm volatile("global_load_dwordx4 %0, %1, off offset:192" : "=&v"(An[m][3]) : "v"(am_) : "memory"); } }
            { const char* gnext = (c < 3) ? gbc + (size_t)(c + 1) * 128 * EDIM * 2 : gbn; DP3_STAGE((c + 1) & 1, gnext); }
            __builtin_amdgcn_sched_barrier(0);
            f32x4 acc[2][4][2];
#pragma unroll
            for (int g = 0; g < 4; ++g) { bf16x8 Bf[2][4];
#pragma unroll
                for (int n = 0; n < 2; ++n)
#pragma unroll
                    for (int kk = 0; kk < 4; ++kk) Bf[n][kk] = *(const LAS bf16x8*)(lds + (c & 1) * 32768 + (kk >> 1) * 16384 + boffg[g] + n * 2048 + (kk & 1) * 1024);
#pragma unroll
                for (int m = 0; m < 2; ++m)
#pragma unroll
                    for (int n = 0; n < 2; ++n) { acc[m][g][n] = (f32x4){0.f, 0.f, 0.f, 0.f};
#pragma unroll
                        for (int kk = 0; kk < 4; ++kk) acc[m][g][n] = __builtin_amdgcn_mfma_f32_16x16x32_bf16(Bf[n][kk], A[m][kk], acc[m][g][n], 0, 0, 0); } }
#pragma unroll
            for (int m = 0; m < 2; ++m) {
                float am = 0.f;
#pragma unroll
                for (int g = 0; g < 4; ++g)
#pragma unroll
                    for (int n = 0; n < 2; ++n) am = fmaxf(am, fmaxf(fmaxf(fabsf(acc[m][g][n][0]), fabsf(acc[m][g][n][1])), fmaxf(fabsf(acc[m][g][n][2]), fabsf(acc[m][g][n][3]))));
                am = fmaxf(am, shfl_x(am, 16, lane)); am = fmaxf(am, shfl_x(am, 32, lane));
                am = fminf(am, 3.0e38f);
                const float isc = am > 0.f ? 127.0f * __builtin_amdgcn_rcpf(am) : 0.f;
                scq[m][c] = am * (1.0f / 127.0f);
#pragma unroll
                for (int g = 0; g < 4; ++g) { unsigned qd[2];
#pragma unroll
                    for (int n = 0; n < 2; ++n) {
                        const unsigned t0 = __builtin_bit_cast(unsigned, __builtin_fmaf(acc[m][g][n][0], isc, 8388736.0f)), t1 = __builtin_bit_cast(unsigned, __builtin_fmaf(acc[m][g][n][1], isc, 8388736.0f));
                        const unsigned t2 = __builtin_bit_cast(unsigned, __builtin_fmaf(acc[m][g][n][2], isc, 8388736.0f)), t3 = __builtin_bit_cast(unsigned, __builtin_fmaf(acc[m][g][n][3], isc, 8388736.0f));
                        qd[n] = (t0 & 0xffu) | ((t1 & 0xffu) << 8) | ((t2 & 0xffu) << 16) | (t3 << 24); }
                    *(LAS v2u*)(stg + (16 * m + fr) * 144 + 32 * g + 8 * fq) = (v2u){qd[0], qd[1]}; } }
#pragma unroll
            for (int it = 0; it < 4; ++it) { const int rr = 8 * it + (lane >> 3);
                const v4u o = *(const LAS v4u*)(stg + rr * 144 + (lane & 7) * 16);
                *(v4u*)(Yq + (size_t)(tile * 256 + 32 * w + rr) * D + colu + 128 * c + 16 * (lane & 7)) = o; }
            if (c == 3) { const f32x4 so = fq == 0 ? (f32x4){scq[0][0], scq[0][1], scq[0][2], scq[0][3]} : (f32x4){scq[1][0], scq[1][1], scq[1][2], scq[1][3]};
                if (fq < 2) *(f32x4*)(Ysc + (size_t)(tile * 256 + 32 * w + 16 * fq + fr) * 16 + (colu >> 7)) = so; }
            __builtin_amdgcn_sched_barrier(0);
        }
        asm volatile("s_waitcnt vmcnt(9)" : "+v"(An[0][0]), "+v"(An[0][1]), "+v"(An[0][2]), "+v"(An[0][3]), "+v"(An[1][0]), "+v"(An[1][1]), "+v"(An[1][2]), "+v"(An[1][3]) :: "memory");
        if (un == u) break;
#pragma unroll
        for (int m = 0; m < 2; ++m)
#pragma unroll
            for (int kk = 0; kk < 4; ++kk) A[m][kk] = An[m][kk];
        u = un; ecur = enx; nvcur = nvnx;
    }
    asm volatile("s_waitcnt vmcnt(0)" ::: "memory");
#undef DP3_UNITINFO
#undef DP3_STAGE
#undef DP3_GLDS
#undef DP3_LOADA
}

enum { PH_PRO = 0, PH_POOL_G1, PH_POOL_P, PH_POOL_G2, PH_POOL_G3, PH_DIL_G1, PH_DIL_ATT, PH_DIL_CMB, PH_DIL_G2, PH_CONV_G1, PH_CONV_E, PH_CONV_G2, PH_MOE1, PH_MOE2, PH_MOE3, PH_MOE4, PH_COUNT };

template <int PH>
__device__ __forceinline__ void run_phase(const Frame& Fin, const Args& args_, const int L) {
    Frame F = Fin; { int w_ = Fin.wave, l_; asm volatile("" : "+s"(w_)); asm volatile("v_mbcnt_lo_u32_b32 %0, -1, 0\n\tv_mbcnt_hi_u32_b32 %0, -1, %0" : "=v"(l_)); F.wave = w_; F.lane = l_; F.tid = w_ * 64 + l_; }
    unsigned char* ws; { GAS unsigned char* wsg = (GAS unsigned char*)Fin.ws; asm volatile("" : "+s"(wsg)); ws = (unsigned char*)wsg; } F.ws = ws; F.ctl = (unsigned*)(ws + WS_CTL);
    KP kp = (KP)__builtin_amdgcn_kernarg_segment_ptr(); asm volatile("" : "+s"(kp)); (void)args_;
    { unsigned l_ = (unsigned)(size_t)Fin.lds; asm volatile("" : "+s"(l_)); F.lds = (LAS unsigned char*)(size_t)l_; }
    LAS unsigned char* ring = F.lds; int c = (int)blockIdx.x; { int g_ = Fin.G; asm volatile("" : "+s"(c), "+s"(g_)); F.G = g_; F.bid = c; }
    const float* xres = ain(kp, IN_X); const bf16* xresb = (const bf16*)(ws + WS_Y2F);
    const float* st2 = (const float*)(ws + WS_ST2); float* pstp = (float*)(ws + WS_PST);
    const float* g2p = ain(kp, IN_LNG) + (size_t)((L > 0 ? L - 1 : 0) * 2 + 1) * D; const float* b2p = ain(kp, IN_LNB) + (size_t)((L > 0 ? L - 1 : 0) * 2 + 1) * D;
    const bf16* xb = (const bf16*)(ws + WS_XB);
    bf16* yf = (bf16*)(ws + WS_YF);
    unsigned char* big = ws + WS_BIG;
    const int ia = L / 3;
    if constexpr (PH == PH_PRO) { phase_prologue(F, kp); }
    if constexpr (PH == PH_POOL_G1) { g8::DenseSched S; S.init(xb, (const bf16*)(ws + WS_W_POOL_IN) + (size_t)ia * D * D, T, D, D, D, F.G, c);
        g8::EpiBf16 E{(bf16*)(big + BG_U), D, 0}; g8::gemm_phase<g8::EpiBf16, g8::DenseSched, false>(ring, F.tid, D, D, D, S, E); }
    if constexpr (PH == PH_POOL_P) { phase_pool(F, (const bf16*)(big + BG_U), (bf16*)(big + BG_PL)); }
    if constexpr (PH == PH_POOL_G2) { g8::DenseSched S; S.init((const bf16*)(big + BG_PL), (const bf16*)(ws + WS_W_POOL_G) + (size_t)ia * D * 512, T, D, D, 512, F.G, c); S.agrp_shift = 1; S.agrp_stride = 512 * 2;
        g8::EpiScaleBf16 E{(bf16*)(big + BG_MX), D, ain(kp, IN_PSC) + (size_t)ia * D}; g8::gemm_phase<g8::EpiScaleBf16, g8::DenseSched, false>(ring, F.tid, 512, D, 512, S, E); }
    if constexpr (PH == PH_POOL_G3) { g8::DenseSched S; S.init((const bf16*)(big + BG_MX), (const bf16*)(ws + WS_W_POOL_OUT) + (size_t)ia * D * D, T, D, D, D, F.G, c);
        g8::EpiResidLN E{xres, xresb, st2, g2p, b2p, yf, pstp, L > 0}; g8::gemm_phase<g8::EpiResidLN, g8::DenseSched, false>(ring, F.tid, D, D, D, S, E); }
    if constexpr (PH == PH_DIL_G1) { g8::DenseSched S; S.init(xb, (const bf16*)(ws + WS_W_DIL_QKV), T, QKVC, D, D, F.G, c);
        g8::EpiBf16 E{(bf16*)(big + BG_QKV), QKVC, 1}; g8::gemm_phase<g8::EpiBf16, g8::DenseSched, false>(ring, F.tid, D, D, D, S, E); }
    if constexpr (PH == PH_DIL_ATT) { phase_attn(F, (const bf16*)(big + BG_QKV), ain(kp, IN_RELB), (bf16*)(big + BG_OG), (float*)(big + BG_LSE)); }
    if constexpr (PH == PH_DIL_CMB) { phase_combine(F, (const bf16*)(big + BG_OG), (const float*)(big + BG_LSE), (bf16*)(big + BG_O)); }
    if constexpr (PH == PH_DIL_G2) { g8::DenseSched S; S.init((const bf16*)(big + BG_O), (const bf16*)(ws + WS_W_DIL_OUT), T, D, DILW, DILW, F.G, c);
        g8::EpiResidLN E{xres, xresb, st2, g2p, b2p, yf, pstp, L > 0}; g8::gemm_phase<g8::EpiResidLN, g8::DenseSched, false>(ring, F.tid, DILW, DILW, DILW, S, E); }
    if constexpr (PH == PH_CONV_G1) { g8::DenseSched S; S.init(xb, (const bf16*)(ws + WS_W_CONV_IN), T, 3 * D, D, D, F.G, c);
        g8::EpiConvIn E{(bf16*)(big + BG_UC), (bf16*)(big + BG_BG)}; g8::gemm_phase<g8::EpiConvIn, g8::DenseSched, false>(ring, F.tid, D, D, D, S, E); }
    if constexpr (PH == PH_CONV_E) { phase_conv(F, (const bf16*)(big + BG_UC), (const bf16*)(big + BG_BG), ain(kp, IN_CW), (bf16*)(big + BG_Z)); }
    if constexpr (PH == PH_CONV_G2) { g8::DenseSched S; S.init((const bf16*)(big + BG_Z), (const bf16*)(ws + WS_W_CONV_OUT), T, D, D, D, F.G, c);
        g8::EpiResidLN E{xres, xresb, st2, g2p, b2p, yf, pstp, L > 0}; g8::gemm_phase<g8::EpiResidLN, g8::DenseSched, false>(ring, F.tid, D, D, D, S, E); }
    unsigned* cnt = F.ctl + CW_CNT + L * 64 * 16;
    float* x1f = (float*)(ws + WS_X1F); bf16* x1b = (bf16*)(ws + WS_X1B);
    int* ltok = (int*)(ws + WS_LTOK); float* lgate = (float*)(ws + WS_LGATE); int* eidx = (int*)(ws + WS_EIDX); int* inv = (int*)(ws + WS_INV);
    bf16* HB = (bf16*)(ws + WS_HB); bf16* HS = (bf16*)(ws + WS_HS); bf16* Yr = (bf16*)(ws + WS_BIG);
    if constexpr (PH == PH_MOE1) {
        const float* g1 = ain(kp, IN_LNG) + (size_t)(L * 2 + 0) * D; const float* b1 = ain(kp, IN_LNB) + (size_t)(L * 2 + 0) * D;
        phase_moe1n(F, yf, pstp, g1, b1, (const bf16*)(ws + WS_RWH) + (size_t)L * NEXP * D, (const bf16*)(ws + WS_RWL) + (size_t)L * NEXP * D, ain(kp, IN_RB) + (size_t)L * NEXP,
                    x1b, (float*)(ws + WS_ST1), cnt, ltok, lgate, eidx, inv); }
    if constexpr (PH == PH_MOE2) {
        const int NT = build_tiles(F, cnt);
        { g8::ExpertSched<1, true> S; S.tpref = (const LAS int*)(F.lds + LDS_TAB); S.cnt = (const LAS int*)(F.lds + LDS_TAB + 512); S.A = (const char*)x1b; S.B = (const char*)((const bf16*)(ws + WS_W_EX_GU) + (size_t)L * 64 * 256 * D);
          S.tok = ltok; S.b_exp = (size_t)256 * D * 2; S.b_tile = 0; S.a_tile = 0; S.NU = NT; S.G = F.G; S.c = c;
          g8::EpiExpertGU E{HB}; g8::gemm_phase<g8::EpiExpertGU, g8::ExpertSched<1, true>, true>(ring, F.tid, D, D, D, S, E); }
        { const int rot = (c - (NT % F.G) + F.G) % F.G;
          g8::DenseSched S; S.init(x1b, (const bf16*)(ws + WS_W_SH_GU) + (size_t)L * 512 * D, T, 512, D, D, F.G, rot);
          int t2 = F.tid; asm volatile("" : "+v"(t2));
          g8::EpiSharedGU E{HS}; g8::gemm_phase<g8::EpiSharedGU, g8::DenseSched, false>(ring, t2, D, D, D, S, E); } }
    if constexpr (PH == PH_MOE3) {
        const float* g1 = ain(kp, IN_LNG) + (size_t)(L * 2 + 0) * D; const float* b1 = ain(kp, IN_LNB) + (size_t)(L * 2 + 0) * D;
        const int NT = build_tiles(F, cnt);
        __syncthreads();
        phase_downproj3(F, HB, (const bf16*)(ws + WS_W_EX_D) + (size_t)L * 64 * D * EDIM, (unsigned char*)Yr, (float*)(ws + WS_BIG + BG_YSC), NT);
        __syncthreads();
        { const int rot = (c - ((NT * 4) % F.G) + F.G) % F.G;
          g8::DenseSched S; S.init(HS, (const bf16*)(ws + WS_W_SH_D) + (size_t)L * D * SDIM, T, D, SDIM, SDIM, F.G, rot);
          int t2 = F.tid; asm volatile("" : "+v"(t2));
          int ks = SDIM; asm volatile("" : "+s"(ks));
          g8::EpiResidLN E{nullptr, yf, (const float*)(ws + WS_ST1), g1, b1, (bf16*)(ws + WS_Y2F), pstp, 1}; g8::gemm_phase<g8::EpiResidLN, g8::DenseSched, false>(ring, t2, ks, ks, ks, S, E); } }
    if constexpr (PH == PH_MOE4) { (void)build_tiles(F, cnt);
        const float* g2 = ain(kp, IN_LNG) + (size_t)(L * 2 + 1) * D; const float* b2 = ain(kp, IN_LNB) + (size_t)(L * 2 + 1) * D;
        phase_moe4q(F, (bf16*)(ws + WS_Y2F), (const unsigned char*)Yr, (const float*)(ws + WS_BIG + BG_YSC), eidx, inv, g2, b2, (float*)(ws + WS_ST2), (bf16*)(ws + WS_XB), aout(kp), L == DEPTH - 1); }
}
__device__ __forceinline__ void make_frame(Frame& F, const Args& args) {
    extern __shared__ __attribute__((aligned(16))) unsigned char lds_raw[];
    F.lds = (LAS unsigned char*)lds_raw; F.ws = args.ws; F.ctl = (unsigned*)(args.ws + WS_CTL);
    F.tid = threadIdx.x; F.lane = F.tid & 63; F.wave = __builtin_amdgcn_readfirstlane(F.tid >> 6); F.G = gridDim.x; F.bid = blockIdx.x;
}
template <int PH> __global__ void __launch_bounds__(512, 2) k_phase(Args args, int L) {
    Frame F; make_frame(F, args);
    run_phase<PH>(F, args, L);
}

#ifndef MK_NOINLINE
#define MK_NOINLINE 0
#endif
#if MK_NOINLINE
template <int PH> __device__ __noinline__ void call_phase_ni(const int L) {
    Args dummy{}; Frame F;
    KP kp = (KP)__builtin_amdgcn_kernarg_segment_ptr();
    extern __shared__ __attribute__((aligned(16))) unsigned char lds_raw[];
    F.lds = (LAS unsigned char*)lds_raw; F.ws = (unsigned char*)((GAS unsigned char* const CAS*)kp)[20]; F.ctl = (unsigned*)(F.ws + WS_CTL);
    F.tid = threadIdx.x; F.lane = F.tid & 63; F.wave = __builtin_amdgcn_readfirstlane(F.tid >> 6); F.G = gridDim.x; F.bid = blockIdx.x;
    run_phase<PH>(F, dummy, L);
}
template <int PH> __device__ __forceinline__ void call_phase(const Frame& F, const Args& args, const int L) { call_phase_ni<PH>(L); }
#else
template <int PH> __device__ __forceinline__ void call_phase(const Frame& F, const Args& args, const int L) { asm volatile("; PHASE_BEGIN %0" :: "n"(PH)); run_phase<PH>(F, args, L); asm volatile("; PHASE_END %0" :: "n"(PH)); }
#endif
__global__ void __launch_bounds__(512, 2) fwd_all(Args args) {
    Frame F; make_frame(F, args);
    volatile LAS unsigned* misc = (volatile LAS unsigned*)(F.lds + LDS_MISC);
    if (F.tid < 4) misc[F.tid] = 0u;
    __syncthreads();
    const int lo = args.ph_lo, hi = args.ph_hi;
    XcdBarrier bar; bar.bar = F.ctl + CW_BAR; bar.x = 0; bar.st = misc;
    if (hi - lo > 1) bar = xcd_barrier_post(F.ctl + CW_BAR, misc);
    int pc = 0;
#ifndef MK_DUP_MASK
#define MK_DUP_MASK 0
#endif
#define STEP(PH, Lx) do { if (pc >= lo && pc < hi) { if ((MK_DUP_MASK >> (PH)) & 1) { call_phase<PH>(F, args, Lx); xcd_barrier(bar); } call_phase<PH>(F, args, Lx); if (pc + 1 < hi) xcd_barrier(bar); } ++pc; } while (0)
    STEP(PH_PRO, 0);
#pragma unroll 1
    for (int L = 0; L < DEPTH; ++L) {
        const int kind = L % 3;
        if (kind == 0) { STEP(PH_POOL_G1, L); STEP(PH_POOL_P, L); STEP(PH_POOL_G2, L); STEP(PH_POOL_G3, L); }
        else if (kind == 1) { STEP(PH_DIL_G1, L); STEP(PH_DIL_ATT, L); STEP(PH_DIL_CMB, L); STEP(PH_DIL_G2, L); }
        else { STEP(PH_CONV_G1, L); STEP(PH_CONV_E, L); STEP(PH_CONV_G2, L); }
        STEP(PH_MOE1, L); STEP(PH_MOE2, L); STEP(PH_MOE3, L); STEP(PH_MOE4, L);
    }
#undef STEP
}
constexpr int N_STEPS = 1 + 2 * 8 + 8 + 7;

template <int PH> static void launch_phase(const Args& a, int L, int grid, hipStream_t stream) {
    static bool attr = false;
    if (!attr) { (void)hipFuncSetAttribute((const void*)k_phase<PH>, hipFuncAttributeMaxDynamicSharedMemorySize, LDS_BYTES); attr = true; }
    hipLaunchKernelGGL(k_phase<PH>, dim3(grid), dim3(512), LDS_BYTES, stream, a, L);
}
extern "C" void kernel_launch(void* const* d_in, const int* in_sizes, int n_in, void* d_out, int out_size, void* d_ws, size_t ws_size, hipStream_t stream) {
    static int grid = 0;
    if (grid == 0) {
        if (n_in != 19 || out_size != T * D || ws_size < WS_END) { fprintf(stderr, "kernel_launch: unexpected shapes (n_in %d out %d ws %zu need %zu)\n", n_in, out_size, ws_size, (size_t)WS_END); grid = -1; return; }
        int dev = 0, cus = 0;
        if (hipGetDevice(&dev) != hipSuccess || hipDeviceGetAttribute(&cus, hipDeviceAttributeMultiprocessorCount, dev) != hipSuccess) { grid = -1; return; }
#if MK_ONE_LAUNCH
        if (hipFuncSetAttribute((const void*)fwd_all, hipFuncAttributeMaxDynamicSharedMemorySize, LDS_BYTES) != hipSuccess) { fprintf(stderr, "kernel_launch: hipFuncSetAttribute failed\n"); grid = -1; return; }
        int per_cu = 0;
        if (hipOccupancyMaxActiveBlocksPerMultiprocessor(&per_cu, (const void*)fwd_all, 512, LDS_BYTES) != hipSuccess || per_cu < 1) { fprintf(stderr, "kernel_launch: note: occupancy query reports %d blocks per CU\n", per_cu); (void)hipGetLastError(); }
#endif
        grid = cus;
    }
    if (grid < 0) return;
    (void)hipMemsetAsync((char*)d_ws + WS_CTL, 0, CTL_ZERO_BYTES, stream);
    Args a{};
    for (int i = 0; i < 19; ++i) a.in[i] = (const float*)d_in[i];
    a.out = (float*)d_out; a.ws = (unsigned char*)d_ws; a.ph_lo = 0; a.ph_hi = 0;
#if MK_ONE_LAUNCH
#ifdef MK_SPLIT
    for (int p = 0; p < N_STEPS; ++p) { a.ph_lo = p; a.ph_hi = p + 1; hipLaunchKernelGGL(fwd_all, dim3(grid), dim3(512), LDS_BYTES, stream, a); }
#else
    a.ph_lo = 0; a.ph_hi = N_STEPS;
    hipLaunchKernelGGL(fwd_all, dim3(grid), dim3(512), LDS_BYTES, stream, a);
#endif
#elif defined(MK_HYBRID_MASK)
    {
        static bool attr2 = false; if (!attr2) { (void)hipFuncSetAttribute((const void*)fwd_all, hipFuncAttributeMaxDynamicSharedMemorySize, LDS_BYTES); attr2 = true; }
        int pc = 0;
#define HSTEP(PH, Lx) do { if ((MK_HYBRID_MASK >> (PH)) & 1) { a.ph_lo = pc; a.ph_hi = pc + 1; hipLaunchKernelGGL(fwd_all, dim3(grid), dim3(512), LDS_BYTES, stream, a); } else { a.ph_lo = 0; a.ph_hi = 0; launch_phase<PH>(a, Lx, grid, stream); } ++pc; } while (0)
        HSTEP(PH_PRO, 0);
        for (int L = 0; L < DEPTH; ++L) {
            const int kind = L % 3;
            if (kind == 0) { HSTEP(PH_POOL_G1, L); HSTEP(PH_POOL_P, L); HSTEP(PH_POOL_G2, L); HSTEP(PH_POOL_G3, L); }
            else if (kind == 1) { HSTEP(PH_DIL_G1, L); HSTEP(PH_DIL_ATT, L); HSTEP(PH_DIL_CMB, L); HSTEP(PH_DIL_G2, L); }
            else { HSTEP(PH_CONV_G1, L); HSTEP(PH_CONV_E, L); HSTEP(PH_CONV_G2, L); }
            HSTEP(PH_MOE1, L); HSTEP(PH_MOE2, L); HSTEP(PH_MOE3, L); HSTEP(PH_MOE4, L);
        }
#undef HSTEP
    }
#else
    launch_phase<PH_PRO>(a, 0, grid, stream);
    for (int L = 0; L < DEPTH; ++L) {
        const int kind = L % 3;
        if (kind == 0) { launch_phase<PH_POOL_G1>(a, L, grid, stream); launch_phase<PH_POOL_P>(a, L, grid, stream); launch_phase<PH_POOL_G2>(a, L, grid, stream); launch_phase<PH_POOL_G3>(a, L, grid, stream); }
        else if (kind == 1) { launch_phase<PH_DIL_G1>(a, L, grid, stream); launch_phase<PH_DIL_ATT>(a, L, grid, stream); launch_phase<PH_DIL_CMB>(a, L, grid, stream); launch_phase<PH_DIL_G2>(a, L, grid, stream); }
        else { launch_phase<PH_CONV_G1>(a, L, grid, stream); launch_phase<PH_CONV_E>(a, L, grid, stream); launch_phase<PH_CONV_G2>(a, L, grid, stream); }
        launch_phase<PH_MOE1>(a, L, grid, stream); launch_phase<PH_MOE2>(a, L, grid, stream); launch_phase<PH_MOE3>(a, L, grid, stream); launch_phase<PH_MOE4>(a, L, grid, stream);
    }
#endif
}
```

```cpp
#include <hip/hip_runtime.h>
#include <cstdio>
#include <cstdint>

#ifndef MK_ONE_LAUNCH
#define MK_ONE_LAUNCH 1
#endif

#define GAS __attribute__((address_space(1)))
#define LAS __attribute__((address_space(3)))
typedef unsigned short bf16;
typedef unsigned v4u __attribute__((ext_vector_type(4)));
typedef unsigned v2u __attribute__((ext_vector_type(2)));
typedef float f32x4 __attribute__((ext_vector_type(4)));
typedef float f32x2 __attribute__((ext_vector_type(2)));
typedef short bf16x8 __attribute__((ext_vector_type(8)));
typedef short s16x4 __attribute__((ext_vector_type(4)));

constexpr int NBATCH = 8, SEQ = 2048, D = 2048, T = NBATCH * SEQ, DEPTH = 4;
constexpr int NEXP = 64, TOPK = 8, EDIM = 128, SDIM = 256;
constexpr int QKVC = 4608, DILW = 512;
constexpr float ALPHA = 1.681792830507429f;
constexpr float LN_EPS = 1e-5f;
constexpr int CAP = 16384;
constexpr int HROWS = T * TOPK + NEXP * 256;

constexpr size_t MiB = 1u << 20;
constexpr size_t WS_CTL = 0, CTL_ZERO_BYTES = 1 * MiB;
constexpr size_t WS_W_POOL_IN = 1 * MiB;
constexpr size_t WS_W_POOL_G = WS_W_POOL_IN + 16 * MiB;
constexpr size_t WS_W_POOL_OUT = WS_W_POOL_G + 4 * MiB;
constexpr size_t WS_W_DIL_QKV = WS_W_POOL_OUT + 16 * MiB;
constexpr size_t WS_W_DIL_OUT = WS_W_DIL_QKV + 18 * MiB;
constexpr size_t WS_W_CONV_IN = WS_W_DIL_OUT + 2 * MiB;
constexpr size_t WS_W_CONV_OUT = WS_W_CONV_IN + 24 * MiB;
constexpr size_t WS_W_SH_GU = WS_W_CONV_OUT + 8 * MiB;
constexpr size_t WS_W_SH_D = WS_W_SH_GU + 8 * MiB;
constexpr size_t WS_W_EX_GU = WS_W_SH_D + 4 * MiB;
constexpr size_t WS_W_EX_D = WS_W_EX_GU + 256 * MiB;
constexpr size_t WS_XF = WS_W_EX_D + 256 * MiB;
constexpr size_t WS_YF = WS_XF + 128 * MiB;
constexpr size_t WS_X1F = WS_YF + 128 * MiB;
constexpr size_t WS_XB = WS_X1F + 128 * MiB;
constexpr size_t WS_X1B = WS_XB + 64 * MiB;
constexpr size_t WS_HB = WS_X1B + 64 * MiB;
constexpr size_t WS_HS = WS_HB + 72 * MiB;
constexpr size_t WS_LTOK = WS_HS + 8 * MiB;
constexpr size_t WS_LGATE = WS_LTOK + 4 * MiB;
constexpr size_t WS_EIDX = WS_LGATE + 4 * MiB;
constexpr size_t WS_INV = WS_EIDX + 1 * MiB;
constexpr size_t WS_BIG = WS_INV + 1 * MiB;
constexpr size_t WS_PST = WS_BIG + 608 * MiB;
constexpr size_t WS_ST1 = WS_PST + 4 * MiB;
constexpr size_t WS_ST2 = WS_ST1 + 1 * MiB;
constexpr size_t WS_RWH = WS_ST2 + 1 * MiB;
constexpr size_t WS_RWL = WS_RWH + 1 * MiB;
constexpr size_t WS_PST2 = WS_RWL + 1 * MiB;
constexpr size_t WS_END = WS_PST2 + 8 * MiB;
constexpr size_t WS_Y2F = WS_X1F;
constexpr size_t BG_U = 0, BG_PL = 64 * MiB, BG_MX = 128 * MiB;
constexpr size_t BG_QKV = 0, BG_OG = 144 * MiB, BG_LSE = 192 * MiB, BG_O = 194 * MiB;
constexpr size_t BG_UC = 0, BG_BG = 64 * MiB, BG_Z = 128 * MiB;
constexpr size_t BG_YSC = 400 * MiB;
constexpr int CW_BAR = 4096;
constexpr int CW_CNT = 16384;

constexpr int RING_BYTES = 131072;
constexpr int LDS_TAB = RING_BYTES;
constexpr int LDS_STASH = RING_BYTES + 1024;
constexpr int LDS_BYTES = 163840;
constexpr int LDS_MISC = LDS_BYTES - 1024;

typedef __bf16 bf16x2_t __attribute__((ext_vector_type(2)));
typedef float f32x2_t __attribute__((ext_vector_type(2)));
__device__ __forceinline__ unsigned cvt_pk_bf16(float lo, float hi) { const bf16x2_t r = __builtin_convertvector((f32x2_t){lo, hi}, bf16x2_t); return __builtin_bit_cast(unsigned, r); }
__device__ __forceinline__ unsigned f2bf(float f) { unsigned u = __builtin_bit_cast(unsigned, f); return (u + 0x7fffu + ((u >> 16) & 1u)) >> 16; }
__device__ __forceinline__ unsigned pk2(float lo, float hi) { return f2bf(lo) | (f2bf(hi) << 16); }
__device__ __forceinline__ float bflo(unsigned w) { return __builtin_bit_cast(float, w << 16); }
__device__ __forceinline__ float bfhi(unsigned w) { return __builtin_bit_cast(float, w & 0xffff0000u); }
__device__ __forceinline__ float shfl_from(float v, int src) { return __builtin_bit_cast(float, __builtin_amdgcn_ds_bpermute(src << 2, __builtin_bit_cast(int, v))); }
__device__ __forceinline__ float shfl_x(float v, int o, int lane) { return shfl_from(v, lane ^ o); }
__device__ __forceinline__ float wave_sum(float v, int lane) {
#pragma unroll
    for (int o = 1; o < 64; o <<= 1) v += shfl_x(v, o, lane);
    return v;
}
#define LDS_WAIT() asm volatile("s_waitcnt lgkmcnt(0)" ::: "memory")
#define VM_WAIT() asm volatile("s_waitcnt vmcnt(0)" ::: "memory")

#define XB_TMO      128
#define XB_XCNT(j)  (256  + 64 * (j))
#define XB_XSUB(j)  (1280 + 64 * (j))
#define XB_XGEN(j)  (2304 + 64 * (j))
#define XB_TOP      3328
#define XB_TOPGEN   3392
#define XCD_BAR_WORDS 3456
#define XB_SPIN_CAP (1u << 18)

__device__ __forceinline__ unsigned xb_ld(unsigned* p)              { return __hip_atomic_load(p, __ATOMIC_RELAXED, __HIP_MEMORY_SCOPE_AGENT); }
__device__ __forceinline__ unsigned xb_add(unsigned* p, unsigned v) { return __hip_atomic_fetch_add(p, v, __ATOMIC_RELAXED, __HIP_MEMORY_SCOPE_AGENT); }
__device__ __forceinline__ unsigned xb_xcc_id() { return (unsigned)__builtin_amdgcn_s_getreg((3 << 11) | 20) & 0xFu; }
#define XB_SPIN(cond, bar) do { unsigned _sp = 0; while (cond) { __builtin_amdgcn_s_sleep(1); \
    if ((++_sp & 255u) == 0u) { if (xb_ld(&(bar)[XB_TMO])) break; if (_sp > XB_SPIN_CAP) { atomicAdd(&(bar)[XB_TMO], 1u); break; } } } } while (0)

struct XcdBarrier {
    unsigned* bar; unsigned x;
    volatile LAS unsigned* st;
};

__device__ __forceinline__ XcdBarrier xcd_barrier_post(unsigned* bar, volatile LAS unsigned* st) {
    XcdBarrier b; b.bar = bar; b.x = xb_xcc_id(); b.st = st;
    if (threadIdx.x == 0) (void)xb_add(&bar[XB_XCNT(b.x)], 1u);
    return b;
}
__device__ __forceinline__ void xcd_barrier_complete(unsigned* bar, unsigned x, unsigned& nloc, unsigned& nx) {
    const unsigned G = gridDim.x * gridDim.y * gridDim.z;
    unsigned sum, cnt, mine, sp = 0u;
    for (;;) {
        sum = 0u; cnt = 0u; mine = 0u;
#pragma unroll
        for (unsigned j = 0; j < 16; ++j) { const unsigned c = xb_ld(&bar[XB_XCNT(j)]); sum += c; cnt += (c > 0u) ? 1u : 0u; mine = (j == x) ? c : mine; }
        if (sum == G) break;
        __builtin_amdgcn_s_sleep(1);
        if ((++sp & 255u) == 0u) { if (xb_ld(&bar[XB_TMO])) break; if (sp > XB_SPIN_CAP) { atomicAdd(&bar[XB_TMO], 1u); break; } }
    }
    nloc = mine > 0u ? mine : 1u; nx = cnt > 0u ? cnt : 1u;
}

__device__ __forceinline__ void xcd_barrier(const XcdBarrier& b) {
    asm volatile("s_waitcnt vmcnt(0)" ::: "memory");
    __syncthreads();
    if (threadIdx.x == 0) {
        unsigned* bar; unsigned bx = b.x; { GAS unsigned* bg = (GAS unsigned*)b.bar; asm volatile("" : "+s"(bg), "+s"(bx)); bar = (unsigned*)bg; }
        __builtin_amdgcn_s_waitcnt(0);
        unsigned nloc = b.st[0], nx = b.st[1];
        if (nloc == 0u) { xcd_barrier_complete(bar, bx, nloc, nx); b.st[0] = nloc; b.st[1] = nx; }
        const unsigned old = xb_add(&bar[XB_XSUB(bx)], 1u);
        const unsigned gen = old / nloc;
        if (old + 1u == (gen + 1u) * nloc) {
            __builtin_amdgcn_fence(__ATOMIC_RELEASE, "agent");
            asm volatile("s_waitcnt vmcnt(0)" ::: "memory");
            const unsigned og = xb_add(&bar[XB_TOP], 1u);
            const unsigned tg = og / nx;
            if (og + 1u == (tg + 1u) * nx) xb_add(&bar[XB_TOPGEN], 1u);
            else XB_SPIN(xb_ld(&bar[XB_TOPGEN]) == tg, bar);
            __builtin_amdgcn_fence(__ATOMIC_ACQUIRE, "agent");
            xb_add(&bar[XB_XGEN(bx)], 1u);
            asm volatile("s_waitcnt vmcnt(0)" ::: "memory");
        } else {
            XB_SPIN(xb_ld(&bar[XB_XGEN(bx)]) == gen, bar);
            __builtin_amdgcn_fence(__ATOMIC_ACQUIRE, "agent");
            asm volatile("s_waitcnt vmcnt(0)" ::: "memory");
        }
    }
    __syncthreads();
}

namespace g8 {
constexpr int BM = 256, BK = 64, HALF = 128, HTB = HALF * BK * 2, STAGE_BYTES = 8 * HTB, NXCD = 8, WGM = 8;
__host__ __device__ __forceinline__ int lds_byte(int r, int c) { const int st = (r >> 4) * 2 + (c >> 5), rr = r & 15, cc = c & 31, ob = rr * 64 + cc * 2; return st * 1024 + (ob ^ (((ob >> 9) & 1) << 5)); }
__host__ __device__ __forceinline__ void stage_rc(int b, int& R, int& C) { const int st = b / 1024, sb = b % 1024, swz = sb ^ (((sb >> 9) & 1) << 5); R = (st >> 1) * 16 + swz / 64; C = (st & 1) * 32 + (swz % 64) / 2; }
__host__ __device__ __forceinline__ int perm32(int rho) { const int n = rho >> 4, i = rho & 15; return 8 * (i >> 2) + 4 * n + (i & 3); }

struct Unit { const char* A; const char* B; const int* rows; int pm, pn, nvalid, aux; };

template <class Epi, class Sched, bool GATHER>
__device__ __forceinline__ void gemm_phase(LAS unsigned char* lds, const int tid_in, const int K, const int lda, const int ldb, const Sched& S, const Epi& E) {
    const int tid = tid_in, wid = __builtin_amdgcn_readfirstlane(tid >> 6), lane = tid & 63, wr = wid >> 2, wc = wid & 3, fr = lane & 15, fq = lane >> 4;
    const int nt = K / BK;
    unsigned voffB[2];
#pragma unroll
    for (int i = 0; i < 2; ++i) { int R_, C_; stage_rc(tid * 16 + i * 8192, R_, C_); const int Rb = Epi::PERM ? ((R_ & ~31) + perm32(R_ & 31)) : R_; voffB[i] = (unsigned)(Rb * ldb + C_) * 2u; }
    LAS v4u* stash = (LAS v4u*)(lds + (LDS_STASH - 0) + tid * 16);
    const size_t kstep = (size_t)(BK * 2);
    const size_t hstepB = (size_t)HALF * ldb * 2;
    const unsigned ldsw = (unsigned)wid * 1024u;
    const int aoff = lds_byte(wr * 64 + fr, fq * 8), boff = lds_byte(wc * 32 + fr, fq * 8);
#define G8_SA(b, h) (((b) * 2 + (h)) * HTB)
#define G8_SB(b, h) ((4 + (b) * 2 + (h)) * HTB)
#define G8_STAGE2(bufoff, gbase, v0, v1) do { \
        __builtin_amdgcn_global_load_lds((const unsigned*)((const char*)(gbase) + (v0)), (LAS unsigned*)(lds + (bufoff) + ldsw), 16, 0, 0); \
        __builtin_amdgcn_global_load_lds((const unsigned*)((const char*)(gbase) + (v1)), (LAS unsigned*)(lds + (bufoff) + ldsw + 8192), 16, 0, 0); } while (0)
#define G8_STAGEB(bufoff, gbase) G8_STAGE2(bufoff, gbase, voffB[0], voffB[1])
#define G8_LDA(dst, b, h) do { _Pragma("unroll") for (int m = 0; m < 4; ++m) _Pragma("unroll") for (int k = 0; k < 2; ++k) dst[m][k] = *(const LAS bf16x8*)(lds + G8_SA(b, h) + aoff + m * 2048 + k * 1024); } while (0)
#define G8_LDB(dst, b, h) do { _Pragma("unroll") for (int n = 0; n < 2; ++n) _Pragma("unroll") for (int k = 0; k < 2; ++k) dst[n][k] = *(const LAS bf16x8*)(lds + G8_SB(b, h) + boff + n * 2048 + k * 1024); } while (0)
#define G8_MMA(ai, bj, At, Bt) do { __builtin_amdgcn_s_setprio(1); _Pragma("unroll") for (int m = 0; m < 4; ++m) _Pragma("unroll") for (int n = 0; n < 2; ++n) _Pragma("unroll") for (int k = 0; k < 2; ++k) \
        acc[ai][bj][m][n] = __builtin_amdgcn_mfma_f32_16x16x32_bf16(Bt[n][k], At[m][k], acc[ai][bj][m][n], 0, 0, 0); __builtin_amdgcn_s_setprio(0); } while (0)
#define G8_WAIT_V(n) asm volatile("s_waitcnt vmcnt(" #n ")" ::: "memory")
#define G8_WAIT_L(n) asm volatile("s_waitcnt lgkmcnt(" #n ")" ::: "memory")
#define G8_BAR __builtin_amdgcn_s_barrier()
#define G8_SCHED __builtin_amdgcn_sched_barrier(0)
#define G8_SETVA(dst, u) do { int _t2 = tid; if (GATHER) asm volatile("" : "+v"(_t2)); _Pragma("unroll") for (int _h = 0; _h < 2; ++_h) _Pragma("unroll") for (int _i = 0; _i < 2; ++_i) { \
        int _R, _C; stage_rc(_t2 * 16 + _i * 8192, _R, _C); \
        const unsigned _rl = (unsigned)(_h * HALF + _R); unsigned _row = _rl; \
        if (GATHER) { _row = 0u; if (_rl < (unsigned)(u).nvalid) _row = (unsigned)(u).rows[_rl] >> 3; } \
        dst[_h][_i] = (_row * (unsigned)lda + (unsigned)_C) * 2u; } } while (0)
    Unit cur, nxt; int ui = 0;
    if (!S.next(0, cur)) return;
    f32x4 acc[2][2][4][2];
#pragma unroll
    for (int a = 0; a < 2; ++a)
#pragma unroll
        for (int b = 0; b < 2; ++b)
#pragma unroll
            for (int m = 0; m < 4; ++m)
#pragma unroll
                for (int n = 0; n < 2; ++n) acc[a][b][m][n] = (f32x4){0.f, 0.f, 0.f, 0.f};
    bf16x8 At[4][2], B0[2][2], B1[2][2];
    unsigned vAc[2][2]; unsigned xl00 = 0, xl01 = 0, xl10 = 0, xl11 = 0;
    G8_SETVA(vAc, cur);
    const char* cA = cur.A; const char* cB = cur.B;
    G8_STAGEB(G8_SB(0, 0), cB); G8_STAGEB(G8_SB(0, 1), cB + hstepB); G8_STAGE2(G8_SA(0, 0), cA, vAc[0][0], vAc[0][1]); G8_STAGE2(G8_SA(0, 1), cA, vAc[1][0], vAc[1][1]);
    if (wr == 1) G8_BAR;
    G8_WAIT_V(2); G8_BAR;
    G8_STAGEB(G8_SB(1, 0), cB + kstep); G8_STAGE2(G8_SA(1, 0), cA + kstep, vAc[0][0], vAc[0][1]); G8_STAGEB(G8_SB(1, 1), cB + hstepB + kstep);
    G8_WAIT_V(6); G8_BAR;
    for (;;) {
        const bool has_next = S.next(ui + 1, nxt);
        const char* nA = has_next ? nxt.A : cA; const char* nB = has_next ? nxt.B : cB;
        if (GATHER) { unsigned vAn[2][2]; if (has_next) { G8_SETVA(vAn, nxt); } else {
#pragma unroll
            for (int h = 0; h < 2; ++h)
#pragma unroll
                for (int i = 0; i < 2; ++i) vAn[h][i] = vAc[h][i]; }
            *stash = (v4u){vAn[0][0], vAn[0][1], vAn[1][0], vAn[1][1]}; }
#pragma unroll 1
        for (int t = 0; t < nt; t += 2) {
            const bool last = (t == nt - 2);
            const char* a1 = cA + (size_t)(t + 1) * kstep;
            const char* a2 = last ? nA : cA + (size_t)(t + 2) * kstep; const char* b2 = last ? nB : cB + (size_t)(t + 2) * kstep;
            const char* a3 = a2 + kstep; const char* b3 = b2 + kstep;
            unsigned x00 = vAc[0][0], x01 = vAc[0][1], x10 = vAc[1][0], x11 = vAc[1][1];
            if (GATHER) { if (last) { const v4u sv = *stash; x00 = sv.x; x01 = sv.y; x10 = sv.z; x11 = sv.w; } xl00 = x00; xl01 = x01; xl10 = x10; xl11 = x11; }
            G8_LDB(B0, 0, 0); G8_LDB(B1, 0, 1); G8_SCHED; G8_LDA(At, 0, 0); G8_STAGE2(G8_SA(1, 1), a1, vAc[1][0], vAc[1][1]);
            G8_WAIT_V(8); G8_WAIT_L(0); G8_BAR; G8_MMA(0, 0, At, B0); G8_MMA(0, 1, At, B1); G8_BAR; G8_SCHED;
            G8_LDA(At, 0, 1); G8_STAGEB(G8_SB(0, 0), b2); G8_STAGEB(G8_SB(0, 1), b2 + hstepB); G8_STAGE2(G8_SA(0, 0), a2, x00, x01);
            G8_WAIT_V(8); G8_WAIT_L(0); G8_BAR; G8_MMA(1, 0, At, B0); G8_MMA(1, 1, At, B1); G8_BAR; G8_SCHED;
            G8_LDB(B0, 1, 0); G8_LDB(B1, 1, 1); G8_SCHED; G8_LDA(At, 1, 0); G8_STAGE2(G8_SA(0, 1), a2, x10, x11);
            G8_WAIT_V(8); G8_WAIT_L(0); G8_BAR; G8_MMA(0, 0, At, B0); G8_MMA(0, 1, At, B1); G8_BAR; G8_SCHED;
            G8_LDA(At, 1, 1); G8_STAGEB(G8_SB(1, 0), b3); G8_STAGEB(G8_SB(1, 1), b3 + hstepB); G8_STAGE2(G8_SA(1, 0), a3, x00, x01);
            G8_WAIT_V(8); G8_WAIT_L(0); G8_BAR; G8_MMA(1, 0, At, B0); G8_MMA(1, 1, At, B1); G8_BAR; G8_SCHED;
        }
        if (wr == 0) G8_BAR;
        E(acc, cur, wr, wc, fr, fq);
        if (!has_next) break;
#pragma unroll
        for (int a = 0; a < 2; ++a)
#pragma unroll
            for (int b = 0; b < 2; ++b)
#pragma unroll
                for (int m = 0; m < 4; ++m)
#pragma unroll
                    for (int n = 0; n < 2; ++n) acc[a][b][m][n] = (f32x4){0.f, 0.f, 0.f, 0.f};
        cur = nxt; cA = nA; cB = nB; ++ui;
        if (GATHER) { vAc[0][0] = xl00; vAc[0][1] = xl01; vAc[1][0] = xl10; vAc[1][1] = xl11; }
        if (wr == 1) G8_BAR;
    }
    G8_WAIT_V(0);
    G8_BAR;
#undef G8_SA
#undef G8_SB
#undef G8_STAGE2
#undef G8_STAGEB
#undef G8_LDA
#undef G8_LDB
#undef G8_MMA
#undef G8_WAIT_V
#undef G8_WAIT_L
#undef G8_BAR
#undef G8_SCHED
#undef G8_SETVA
}

struct DenseSched {
    const char* A; const char* B; size_t a_tile, b_tile, agrp_stride; int agrp_shift, nM, nN, nwg, G, c;
    __device__ __forceinline__ void init(const void* A_, const void* B_, int M, int N, int lda, int ldb, int G_, int c_) {
        A = (const char*)A_; B = (const char*)B_; a_tile = (size_t)BM * lda * 2; b_tile = (size_t)BM * ldb * 2; agrp_stride = 0; agrp_shift = 0; nM = M / BM; nN = N / BM; nwg = nM * nN; G = G_; c = c_; }
    __device__ __forceinline__ bool next(int i, Unit& u) const {
        const long L = (long)i * G + c; if (L >= nwg) return false;
        int wgid = (int)L; { const int q = nwg / NXCD, r = nwg % NXCD, xcd = wgid % NXCD, off = wgid / NXCD; wgid = (xcd < r ? xcd * (q + 1) : r * (q + 1) + (xcd - r) * q) + off; }
        const int nig = WGM * nN, gid = wgid / nig, fm = gid * WGM, gsz = (nM - fm) < WGM ? (nM - fm) : WGM;
        u.pm = fm + ((wgid % nig) % gsz); u.pn = (wgid % nig) / gsz;
        u.A = A + (size_t)u.pm * a_tile + (size_t)(u.pn >> agrp_shift) * agrp_stride; u.B = B + (size_t)u.pn * b_tile; u.rows = nullptr; u.nvalid = BM; u.aux = 0; return true;
    }
};
template <int NPN, bool GATHERED>
struct ExpertSched {
    const LAS int* tpref; const LAS int* cnt; const char* A; const char* B; const int* tok; size_t b_exp, b_tile, a_tile; int NU, G, c;
    __device__ __forceinline__ bool next(int i, Unit& u) const {
        const int L = i * G + c; if (L >= NU) return false;
        const int tile = L / NPN, pn = L % NPN;
        int e = 0; while (__builtin_amdgcn_readfirstlane(tpref[e + 1]) <= tile) ++e;
        const int rb = tile - __builtin_amdgcn_readfirstlane(tpref[e]);
        u.pm = e; u.pn = pn; u.aux = tile * BM; u.nvalid = __builtin_amdgcn_readfirstlane(cnt[e]) - rb * BM; if (u.nvalid > BM) u.nvalid = BM;
        u.rows = tok + (size_t)e * CAP + rb * BM;
        u.A = GATHERED ? A : A + (size_t)tile * a_tile; u.B = B + (size_t)e * b_exp + (size_t)pn * b_tile; return true;
    }
};

struct EpiBf16 {
    static constexpr bool PERM = true;
    bf16* O; int ldc; int qscale;
    __device__ __forceinline__ void operator()(const f32x4 (&acc)[2][2][4][2], const Unit& u, int wr, int wc, int fr, int fq) const {
        asm volatile("" : "+v"(fr), "+v"(fq));
        const int row0 = u.pm * BM + wr * 64 + fr, col0 = u.pn * BM + wc * 32 + 8 * fq;
        const float sc = (qscale && (u.pn % 6) < 2) ? 0.125f : 1.0f;
#pragma unroll
        for (int ai = 0; ai < 2; ++ai)
#pragma unroll
            for (int m = 0; m < 4; ++m) { bf16* rowp = O + (size_t)(row0 + ai * HALF + m * 16) * ldc + col0;
#pragma unroll
                for (int bj = 0; bj < 2; ++bj) { const f32x4 v0 = acc[ai][bj][m][0] * sc, v1 = acc[ai][bj][m][1] * sc;
                    v4u w; w.x = cvt_pk_bf16(v0[0], v0[1]); w.y = cvt_pk_bf16(v0[2], v0[3]); w.z = cvt_pk_bf16(v1[0], v1[1]); w.w = cvt_pk_bf16(v1[2], v1[3]);
                    *(v4u*)(rowp + bj * HALF) = w; } }
    }
};
struct EpiScaleBf16 {
    static constexpr bool PERM = true;
    bf16* O; int ldc; const float* scale;
    __device__ __forceinline__ void operator()(const f32x4 (&acc)[2][2][4][2], const Unit& u, int wr, int wc, int fr, int fq) const {
        asm volatile("" : "+v"(fr), "+v"(fq));
        const int row0 = u.pm * BM + wr * 64 + fr, col0 = u.pn * BM + wc * 32 + 8 * fq;
        f32x4 sv[2][2];
#pragma unroll
        for (int bj = 0; bj < 2; ++bj)
#pragma unroll
            for (int n = 0; n < 2; ++n) sv[bj][n] = *(const f32x4*)(scale + col0 + bj * HALF + 4 * n);
#pragma unroll
        for (int ai = 0; ai < 2; ++ai)
#pragma unroll
            for (int m = 0; m < 4; ++m) { bf16* rowp = O + (size_t)(row0 + ai * HALF + m * 16) * ldc + col0;
#pragma unroll
                for (int bj = 0; bj < 2; ++bj) { const f32x4 v0 = acc[ai][bj][m][0] * sv[bj][0], v1 = acc[ai][bj][m][1] * sv[bj][1];
                    v4u w; w.x = cvt_pk_bf16(v0[0], v0[1]); w.y = cvt_pk_bf16(v0[2], v0[3]); w.z = cvt_pk_bf16(v1[0], v1[1]); w.w = cvt_pk_bf16(v1[2], v1[3]);
                    *(v4u*)(rowp + bj * HALF) = w; } }
    }
};
struct EpiResid {
    static constexpr bool PERM = false;
    const float* X; float* Y;
    __device__ __forceinline__ void operator()(const f32x4 (&acc)[2][2][4][2], const Unit& u, int wr, int wc, int fr, int fq) const {
        asm volatile("" : "+v"(fr), "+v"(fq));
        const int row0 = u.pm * BM + wr * 64 + fr, col0 = u.pn * BM + wc * 32 + 4 * fq;
#pragma unroll
        for (int ai = 0; ai < 2; ++ai)
#pragma unroll
            for (int m = 0; m < 4; ++m) { const size_t off = (size_t)(row0 + ai * HALF + m * 16) * D + col0;
#pragma unroll
                for (int bj = 0; bj < 2; ++bj)
#pragma unroll
                    for (int n = 0; n < 2; ++n) { const f32x4 xv = *(const f32x4*)(X + off + bj * HALF + n * 16); *(f32x4*)(Y + off + bj * HALF + n * 16) = xv * ALPHA + acc[ai][bj][m][n]; } }
    }
};
struct EpiResidLN {
    static constexpr bool PERM = true;
    const float* X32; const bf16* Xb; const float* st; const float* g; const float* b; bf16* Y; float* pst; int mode;
    __device__ __forceinline__ void operator()(const f32x4 (&acc)[2][2][4][2], const Unit& u, int wr, int wc, int fr, int fq) const {
        asm volatile("" : "+v"(fr), "+v"(fq));
        const int row0 = u.pm * BM + wr * 64 + fr, col0 = u.pn * BM + wc * 32 + 8 * fq, lane = fq * 16 + fr;
#pragma unroll
        for (int ai = 0; ai < 2; ++ai)
#pragma unroll
            for (int m = 0; m < 4; ++m) { const int row = row0 + ai * HALF + m * 16; const size_t off = (size_t)row * D + col0;
                float mean = 0.f, rstd = 1.f; if (mode) { const f32x2 sv = *(const f32x2*)(st + 2 * row); mean = sv.x; rstd = sv.y; }
                float sm = 0.f, sq = 0.f;
#pragma unroll
                for (int bj = 0; bj < 2; ++bj) { f32x4 x0, x1;
                    if (mode) { const v4u xv = *(const v4u*)(Xb + off + bj * HALF);
                        const f32x4 g0 = *(const f32x4*)(g + col0 + bj * HALF), g1 = *(const f32x4*)(g + col0 + bj * HALF + 4), b0 = *(const f32x4*)(b + col0 + bj * HALF), b1 = *(const f32x4*)(b + col0 + bj * HALF + 4);
                        x0 = ((f32x4){bflo(xv.x), bfhi(xv.x), bflo(xv.y), bfhi(xv.y)} - mean) * rstd * g0 + b0; x1 = ((f32x4){bflo(xv.z), bfhi(xv.z), bflo(xv.w), bfhi(xv.w)} - mean) * rstd * g1 + b1; }
                    else { x0 = *(const f32x4*)(X32 + off + bj * HALF); x1 = *(const f32x4*)(X32 + off + bj * HALF + 4); }
                    const f32x4 y0 = x0 * ALPHA + acc[ai][bj][m][0], y1 = x1 * ALPHA + acc[ai][bj][m][1];
                    v4u w; w.x = cvt_pk_bf16(y0[0], y0[1]); w.y = cvt_pk_bf16(y0[2], y0[3]); w.z = cvt_pk_bf16(y1[0], y1[1]); w.w = cvt_pk_bf16(y1[2], y1[3]);
                    *(v4u*)(Y + off + bj * HALF) = w;
                    sm += ((y0[0] + y0[1]) + (y0[2] + y0[3])) + ((y1[0] + y1[1]) + (y1[2] + y1[3]));
                    sq += ((y0[0] * y0[0] + y0[1] * y0[1]) + (y0[2] * y0[2] + y0[3] * y0[3])) + ((y1[0] * y1[0] + y1[1] * y1[1]) + (y1[2] * y1[2] + y1[3] * y1[3])); }
                sm += shfl_x(sm, 16, lane); sm += shfl_x(sm, 32, lane); sq += shfl_x(sq, 16, lane); sq += shfl_x(sq, 32, lane);
                if (fq == 0) *(f32x2*)(pst + ((size_t)row * 32 + u.pn * 4 + wc) * 2) = (f32x2){sm, sq}; }
    }
};
struct EpiConvIn {
    static constexpr bool PERM = true;
    bf16* UC; bf16* BGp;
    __device__ __forceinline__ void operator()(const f32x4 (&acc)[2][2][4][2], const Unit& u, int wr, int wc, int fr, int fq) const {
        asm volatile("" : "+v"(fr), "+v"(fq));
        const int row0 = u.pm * BM + wr * 64 + fr, cw = wc * 32 + 8 * fq;
        if (u.pn < 16) {
#pragma unroll
            for (int ai = 0; ai < 2; ++ai)
#pragma unroll
                for (int m = 0; m < 4; ++m) { bf16* rowp = UC + (size_t)(row0 + ai * HALF + m * 16) * D + u.pn * HALF + cw;
                    const f32x4 v0 = acc[ai][0][m][0] * acc[ai][1][m][0], v1 = acc[ai][0][m][1] * acc[ai][1][m][1];
                    v4u w; w.x = cvt_pk_bf16(v0[0], v0[1]); w.y = cvt_pk_bf16(v0[2], v0[3]); w.z = cvt_pk_bf16(v1[0], v1[1]); w.w = cvt_pk_bf16(v1[2], v1[3]);
                    *(v4u*)rowp = w; }
        } else {
#pragma unroll
            for (int ai = 0; ai < 2; ++ai)
#pragma unroll
                for (int m = 0; m < 4; ++m) { bf16* rowp = BGp + (size_t)(row0 + ai * HALF + m * 16) * D + (u.pn - 16) * BM + cw;
#pragma unroll
                    for (int bj = 0; bj < 2; ++bj) { const f32x4 v0 = acc[ai][bj][m][0], v1 = acc[ai][bj][m][1];
                        v4u w; w.x = cvt_pk_bf16(v0[0], v0[1]); w.y = cvt_pk_bf16(v0[2], v0[3]); w.z = cvt_pk_bf16(v1[0], v1[1]); w.w = cvt_pk_bf16(v1[2], v1[3]);
                        *(v4u*)(rowp + bj * HALF) = w; } }
        }
    }
};
__device__ __forceinline__ f32x4 silu_mul(f32x4 g, f32x4 uu) {
    f32x4 r;
#pragma unroll
    for (int j = 0; j < 4; ++j) r[j] = g[j] * __builtin_amdgcn_rcpf(1.0f + __expf(-g[j])) * uu[j];
    return r;
}
struct EpiExpertGU {
    static constexpr bool PERM = true;
    bf16* H;
    __device__ __forceinline__ void operator()(const f32x4 (&acc)[2][2][4][2], const Unit& u, int wr, int wc, int fr, int fq) const {
        asm volatile("" : "+v"(fr), "+v"(fq));
        const float* gates = (const float*)((const char*)u.rows + (WS_LGATE - WS_LTOK));
        const int cw = wc * 32 + 8 * fq;
#pragma unroll
        for (int ai = 0; ai < 2; ++ai)
#pragma unroll
            for (int m = 0; m < 4; ++m) { const int r = ai * HALF + wr * 64 + m * 16 + fr;
                if (r < u.nvalid) { const float gt = gates[r]; const unsigned pid = (unsigned)u.rows[r];
                    const f32x4 v0 = silu_mul(acc[ai][0][m][0], acc[ai][1][m][0]) * gt, v1 = silu_mul(acc[ai][0][m][1], acc[ai][1][m][1]) * gt;
                    v4u w; w.x = cvt_pk_bf16(v0[0], v0[1]); w.y = cvt_pk_bf16(v0[2], v0[3]); w.z = cvt_pk_bf16(v1[0], v1[1]); w.w = cvt_pk_bf16(v1[2], v1[3]);
                    (void)pid; *(v4u*)(H + (size_t)(u.aux + r) * EDIM + cw) = w; } }
    }
};
struct EpiSharedGU {
    static constexpr bool PERM = true;
    bf16* HS;
    __device__ __forceinline__ void operator()(const f32x4 (&acc)[2][2][4][2], const Unit& u, int wr, int wc, int fr, int fq) const {
        asm volatile("" : "+v"(fr), "+v"(fq));
        const int row0 = u.pm * BM + wr * 64 + fr, cw = u.pn * HALF + wc * 32 + 8 * fq;
#pragma unroll
        for (int ai = 0; ai < 2; ++ai)
#pragma unroll
            for (int m = 0; m < 4; ++m) {
                const f32x4 v0 = silu_mul(acc[ai][0][m][0], acc[ai][1][m][0]), v1 = silu_mul(acc[ai][0][m][1], acc[ai][1][m][1]);
                v4u w; w.x = cvt_pk_bf16(v0[0], v0[1]); w.y = cvt_pk_bf16(v0[2], v0[3]); w.z = cvt_pk_bf16(v1[0], v1[1]); w.w = cvt_pk_bf16(v1[2], v1[3]);
                *(v4u*)(HS + (size_t)(row0 + ai * HALF + m * 16) * SDIM + cw) = w; }
    }
};
struct EpiDownY {
    static constexpr bool PERM = true;
    bf16* Y;
    __device__ __forceinline__ void operator()(const f32x4 (&acc)[2][2][4][2], const Unit& u, int wr, int wc, int fr, int fq) const {
        asm volatile("" : "+v"(fr), "+v"(fq));
        const int col0 = u.pn * BM + wc * 32 + 8 * fq;
#pragma unroll
        for (int ai = 0; ai < 2; ++ai)
#pragma unroll
            for (int m = 0; m < 4; ++m) { const int r = ai * HALF + wr * 64 + m * 16 + fr; bf16* rowp = Y + (size_t)(u.aux + r) * D + col0;
#pragma unroll
                for (int bj = 0; bj < 2; ++bj) { const f32x4 v0 = acc[ai][bj][m][0], v1 = acc[ai][bj][m][1];
                    v4u w; w.x = cvt_pk_bf16(v0[0], v0[1]); w.y = cvt_pk_bf16(v0[2], v0[3]); w.z = cvt_pk_bf16(v1[0], v1[1]); w.w = cvt_pk_bf16(v1[2], v1[3]);
                    *(v4u*)(rowp + bj * HALF) = w; } }
    }
};
}

struct Args { const float* in[19]; float* out; unsigned char* ws; int ph_lo, ph_hi; };
struct Frame {
    LAS unsigned char* lds; unsigned* ctl; unsigned char* ws;
    int tid, lane, wave, G, bid;
};
enum { IN_X = 0, IN_RELB, IN_PWIN, IN_PWG, IN_PSC, IN_PWOUT, IN_DQKV, IN_DOUT, IN_CWIN, IN_CW, IN_CWOUT, IN_LNG, IN_LNB, IN_RW, IN_RB, IN_EGU, IN_ED, IN_SGU, IN_SD };

#define CAS __attribute__((address_space(4)))
typedef const CAS unsigned char* KP;
__device__ __forceinline__ const float* ain(KP kp, int i) { return (const float*)((const GAS float* const CAS*)kp)[i]; }
__device__ __forceinline__ float* aout(KP kp) { return (float*)((GAS float* const CAS*)kp)[19]; }
__device__ __forceinline__ void tr_item(const float* W, int K, int N, bf16* WT, int dstK, int mode, LAS float* scr, int item, int lane) {
    const int nblk = N / 32, kb = item / nblk, nb = item % nblk, k0 = 64 * kb, n0 = 32 * nb;
    int r0 = n0;
    if (mode == 1) { const int part = n0 / 2048, j = n0 % 2048; r0 = (part == 0) ? 4096 + j : 256 * (j / 128) + (part == 2 ? 128 : 0) + (j % 128); }
    if (mode == 2) { const int part = n0 / 256, j = n0 % 256; r0 = 256 * (j / 128) + 128 * part + (j % 128); }
#pragma unroll 8
    for (int i = 0; i < 32; ++i) { const int kk = 2 * i + (lane >> 5); scr[kk * 33 + (lane & 31)] = W[(size_t)(k0 + kk) * N + n0 + (lane & 31)]; }
    LDS_WAIT(); asm volatile("" ::: "memory");
    const int c = lane & 7;
#pragma unroll
    for (int j = 0; j < 4; ++j) { const int n = (lane >> 3) + 8 * j; const LAS float* s = scr + (8 * c) * 33 + n;
        v4u o; o.x = pk2(s[0 * 33], s[1 * 33]); o.y = pk2(s[2 * 33], s[3 * 33]); o.z = pk2(s[4 * 33], s[5 * 33]); o.w = pk2(s[6 * 33], s[7 * 33]);
        *(v4u*)(WT + (size_t)(r0 + n) * dstK + k0 + 8 * c) = o; }
    LDS_WAIT(); asm volatile("" ::: "memory");
}
__device__ __forceinline__ void phase_prologue(const Frame& F, KP kp) {
    LAS float* scr = (LAS float*)(F.lds + F.wave * 16384);
    const int gw = F.bid * 8 + F.wave, NGW = F.G * 8;
    constexpr int I0 = 2 * 2048, I1 = 8 * 128, I2 = 2 * 2048, I3 = 4608, I4 = 512, I5 = 6144, I6 = 2048, I7 = 4 * 512, I8 = 4 * 256, I9 = 256 * 256, I10 = 256 * 128;
    constexpr int NITEMS = I0 + I1 + I2 + I3 + I4 + I5 + I6 + I7 + I8 + I9 + I10;
    unsigned char* ws = F.ws;
    for (int it = gw; it < NITEMS; it += NGW) {
        int r = it;
        if (r < I0) { const int b = r / 2048; tr_item(ain(kp, IN_PWIN) + (size_t)b * D * D, D, D, (bf16*)(ws + WS_W_POOL_IN) + (size_t)b * D * D, D, 0, scr, r % 2048, F.lane); continue; } r -= I0;
        if (r < I1) { const int b = r / 128; tr_item(ain(kp, IN_PWG) + (size_t)b * 512 * 512, 512, 512, (bf16*)(ws + WS_W_POOL_G) + (size_t)b * 512 * 512, 512, 0, scr, r % 128, F.lane); continue; } r -= I1;
        if (r < I2) { const int b = r / 2048; tr_item(ain(kp, IN_PWOUT) + (size_t)b * D * D, D, D, (bf16*)(ws + WS_W_POOL_OUT) + (size_t)b * D * D, D, 0, scr, r % 2048, F.lane); continue; } r -= I2;
        if (r < I3) { tr_item(ain(kp, IN_DQKV), D, QKVC, (bf16*)(ws + WS_W_DIL_QKV), D, 0, scr, r, F.lane); continue; } r -= I3;
        if (r < I4) { tr_item(ain(kp, IN_DOUT), DILW, D, (bf16*)(ws + WS_W_DIL_OUT), DILW, 0, scr, r, F.lane); continue; } r -= I4;
        if (r < I5) { tr_item(ain(kp, IN_CWIN), D, 3 * D, (bf16*)(ws + WS_W_CONV_IN), D, 1, scr, r, F.lane); continue; } r -= I5;
        if (r < I6) { tr_item(ain(kp, IN_CWOUT), D, D, (bf16*)(ws + WS_W_CONV_OUT), D, 0, scr, r, F.lane); continue; } r -= I6;
        if (r < I7) { const int b = r / 512; tr_item(ain(kp, IN_SGU) + (size_t)b * D * 512, D, 512, (bf16*)(ws + WS_W_SH_GU) + (size_t)b * 512 * D, D, 2, scr, r % 512, F.lane); continue; } r -= I7;
        if (r < I8) { const int b = r / 256; tr_item(ain(kp, IN_SD) + (size_t)b * SDIM * D, SDIM, D, (bf16*)(ws + WS_W_SH_D) + (size_t)b * D * SDIM, SDIM, 0, scr, r % 256, F.lane); continue; } r -= I8;
        if (r < I9) { const int b = r / 256; tr_item(ain(kp, IN_EGU) + (size_t)b * D * 256, D, 256, (bf16*)(ws + WS_W_EX_GU) + (size_t)b * 256 * D, D, 0, scr, r % 256, F.lane); continue; } r -= I9;
        { const int b = r / 128; tr_item(ain(kp, IN_ED) + (size_t)b * EDIM * D, EDIM, D, (bf16*)(ws + WS_W_EX_D) + (size_t)b * D * EDIM, EDIM, 0, scr, r % 128, F.lane); }
    }
    const size_t gt = (size_t)F.bid * 512 + F.tid, GT = (size_t)F.G * 512;
    { const float* rw = ain(kp, IN_RW); bf16* wh = (bf16*)(ws + WS_RWH); bf16* wl = (bf16*)(ws + WS_RWL);
      for (size_t i = gt; i < (size_t)DEPTH * NEXP * D / 8; i += GT) { const size_t k8 = i % (D / 8), e = (i / (D / 8)) % NEXP, l = i / ((size_t)NEXP * D / 8);
          float v[8]; unsigned hi[8], lo[8];
#pragma unroll
          for (int j = 0; j < 8; ++j) { v[j] = rw[(l * D + k8 * 8 + j) * NEXP + e]; hi[j] = f2bf(v[j]); lo[j] = f2bf(v[j] - __builtin_bit_cast(float, hi[j] << 16)); }
          v4u a, b2; a.x = hi[0] | (hi[1] << 16); a.y = hi[2] | (hi[3] << 16); a.z = hi[4] | (hi[5] << 16); a.w = hi[6] | (hi[7] << 16);
          b2.x = lo[0] | (lo[1] << 16); b2.y = lo[2] | (lo[3] << 16); b2.z = lo[4] | (lo[5] << 16); b2.w = lo[6] | (lo[7] << 16);
          *(v4u*)(wh + (l * NEXP + e) * D + k8 * 8) = a; *(v4u*)(wl + (l * NEXP + e) * D + k8 * 8) = b2; } }
    const float* x = ain(kp, IN_X); bf16* xb = (bf16*)(ws + WS_XB);
    for (size_t i = gt; i < (size_t)T * D / 8; i += GT) { const f32x4 p = *(const f32x4*)(x + i * 8), q = *(const f32x4*)(x + i * 8 + 4);
        v4u w; w.x = pk2(p[0], p[1]); w.y = pk2(p[2], p[3]); w.z = pk2(q[0], q[1]); w.w = pk2(q[2], q[3]); *(v4u*)(xb + i * 8) = w; }
}

__device__ __forceinline__ void unpack8(const v4u w, float (&f)[8]) { f[0] = bflo(w.x); f[1] = bfhi(w.x); f[2] = bflo(w.y); f[3] = bfhi(w.y); f[4] = bflo(w.z); f[5] = bfhi(w.z); f[6] = bflo(w.w); f[7] = bfhi(w.w); }
__device__ __forceinline__ void phase_pool(const Frame& F, const bf16* U, bf16* PL) {
    for (int it = F.bid * 512 + F.tid; it < (T / 32) * 256; it += F.G * 512) {
        const int cv = it & 255, ch = it >> 8, col = cv * 8, w = 2 << (col >> 9);
        const int row0 = ch * 32, pos0 = row0 & (SEQ - 1);
        float s[8], uu[8];
#pragma unroll
        for (int j = 0; j < 8; ++j) s[j] = 0.f;
        for (int j = 1; j < w; ++j) if (pos0 - j >= 0) { unpack8(*(const v4u*)(U + (size_t)(row0 - j) * D + col), uu);
#pragma unroll
            for (int q = 0; q < 8; ++q) s[q] += uu[q]; }
        for (int r = 0; r < 32; ++r) {
            const int t = row0 + r, pos = pos0 + r;
            unpack8(*(const v4u*)(U + (size_t)t * D + col), uu);
            const float inv = 1.0f / (float)((pos + 1) < w ? (pos + 1) : w);
            float o[8];
#pragma unroll
            for (int q = 0; q < 8; ++q) { s[q] += uu[q]; o[q] = s[q] * inv - uu[q]; }
            v4u ww; ww.x = pk2(o[0], o[1]); ww.y = pk2(o[2], o[3]); ww.z = pk2(o[4], o[5]); ww.w = pk2(o[6], o[7]);
            *(v4u*)(PL + (size_t)t * D + col) = ww;
            if (pos - w + 1 >= 0) { unpack8(*(const v4u*)(U + (size_t)(t - w + 1) * D + col), uu);
#pragma unroll
                for (int q = 0; q < 8; ++q) s[q] -= uu[q]; }
        }
    }
}

__device__ __forceinline__ void phase_conv(const Frame& F, const bf16* UC, const bf16* BGp, const float* cw, bf16* Z) {
    for (int it = F.bid * 512 + F.tid; it < T * 256; it += F.G * 512) {
        const int cv = it & 255, t = it >> 8, col = cv * 8, pos = t & (SEQ - 1);
        float u0[8], u1[8], u2[8], bb[8], o[8];
        unpack8(*(const v4u*)(UC + (size_t)t * D + col), u2);
        if (pos >= 1) unpack8(*(const v4u*)(UC + (size_t)(t - 1) * D + col), u1); else {
#pragma unroll
            for (int q = 0; q < 8; ++q) u1[q] = 0.f; }
        if (pos >= 2) unpack8(*(const v4u*)(UC + (size_t)(t - 2) * D + col), u0); else {
#pragma unroll
            for (int q = 0; q < 8; ++q) u0[q] = 0.f; }
        unpack8(*(const v4u*)(BGp + (size_t)t * D + col), bb);
#pragma unroll
        for (int q = 0; q < 8; ++q) o[q] = bb[q] * (cw[col + q] * u0[q] + cw[D + col + q] * u1[q] + cw[2 * D + col + q] * u2[q]);
        v4u ww; ww.x = pk2(o[0], o[1]); ww.y = pk2(o[2], o[3]); ww.z = pk2(o[4], o[5]); ww.w = pk2(o[6], o[7]);
        *(v4u*)(Z + (size_t)t * D + col) = ww;
    }
}

__device__ __forceinline__ int t5_bucket(int dist) {
    if (dist < 16) return dist;
    int large = 16 + (int)(logf((float)dist / 16.0f) / logf(128.0f) * 16.0f);
    return large < 31 ? large : 31;
}
constexpr int AT_KS = 0, AT_KSTR = 144, AT_VT = 256 * 144, AT_VSTR = 520, AT_BIAS = AT_VT + 64 * 520;
__device__ __forceinline__ void phase_attn(const Frame& F, const bf16* QKV, const float* relb, bf16* OG, float* LSE) {
    LAS unsigned char* lds = F.lds;
    const int tid = F.tid, lane = F.lane, w = tid >> 6, fr = lane & 15, fq = lane >> 4;
    for (int unit = F.bid; unit < NBATCH * 3 * 8 * 16; unit += F.G) {
        const int cmb = unit & 15, h = (unit >> 4) & 7, g = (unit >> 7) % 3, b = unit / 384;
        const int dsh = 2 * g, dil = 1 << dsh, r = cmb & (dil - 1), nb = cmb >> dsh;
        const bf16* base = QKV + (size_t)b * SEQ * QKVC + g * 1536 + h * 64;
        __syncthreads();
        {
            const int key = tid >> 1, half = tid & 1, jk = (nb - 1) * 128 + key;
            v4u kv[4], vv[4];
            if (jk >= 0) { const bf16* rp = base + (size_t)(jk * dil + r) * QKVC + half * 32;
#pragma unroll
                for (int i = 0; i < 4; ++i) { kv[i] = *(const v4u*)(rp + 512 + 8 * i); vv[i] = *(const v4u*)(rp + 1024 + 8 * i); } }
            else {
#pragma unroll
                for (int i = 0; i < 4; ++i) { kv[i] = (v4u){0u, 0u, 0u, 0u}; vv[i] = (v4u){0u, 0u, 0u, 0u}; } }
#pragma unroll
            for (int i = 0; i < 4; ++i) *(LAS v4u*)(lds + AT_KS + key * AT_KSTR + half * 64 + 16 * i) = kv[i];
#pragma unroll
            for (int i = 0; i < 4; ++i) {
                const unsigned ww[4] = {vv[i].x, vv[i].y, vv[i].z, vv[i].w};
#pragma unroll
                for (int q = 0; q < 4; ++q) { const int d = half * 32 + 8 * i + 2 * q;
                    *(LAS unsigned short*)(lds + AT_VT + d * AT_VSTR + key * 2) = (unsigned short)(ww[q] & 0xffffu);
                    *(LAS unsigned short*)(lds + AT_VT + (d + 1) * AT_VSTR + key * 2) = (unsigned short)(ww[q] >> 16); } }
            if (tid <= 128) ((LAS float*)(lds + AT_BIAS))[tid] = relb[t5_bucket(tid * dil) * 24 + g * 8 + h];
        }
        __syncthreads();
        int qi = 16 * w + fr; asm volatile("" : "+v"(qi));
        const int jq = nb * 128 + qi, tq = jq * dil + r;
        const bf16* qp = base + (size_t)tq * QKVC + 8 * fq;
        const bf16x8 q0 = *(const bf16x8*)qp, q1 = *(const bf16x8*)(qp + 32);
        f32x4 s[9]; float mx = -INFINITY;
#pragma unroll
        for (int kt = 0; kt < 9; ++kt) {
            const int kb = 16 * (w + kt);
            const bf16x8 k0 = *(const LAS bf16x8*)(lds + AT_KS + (kb + fr) * AT_KSTR + fq * 16), k1 = *(const LAS bf16x8*)(lds + AT_KS + (kb + fr) * AT_KSTR + 64 + fq * 16);
            f32x4 a = (f32x4){0.f, 0.f, 0.f, 0.f};
            a = __builtin_amdgcn_mfma_f32_16x16x32_bf16(k0, q0, a, 0, 0, 0);
            a = __builtin_amdgcn_mfma_f32_16x16x32_bf16(k1, q1, a, 0, 0, 0);
#pragma unroll
            for (int i = 0; i < 4; ++i) { const int kl = kb + 4 * fq + i, rel = qi + 128 - kl;
                const bool ok = (rel >= 0) && (rel <= 128) && (nb > 0 || kl >= 128);
                const int rc = rel < 0 ? 0 : (rel > 128 ? 128 : rel);
                const float v = ok ? a[i] + ((LAS float*)(lds + AT_BIAS))[rc] : -INFINITY;
                a[i] = v; mx = fmaxf(mx, v); }
            s[kt] = a;
        }
        mx = fmaxf(mx, shfl_x(mx, 16, lane)); mx = fmaxf(mx, shfl_x(mx, 32, lane));
        float l = 0.f;
#pragma unroll
        for (int kt = 0; kt < 9; ++kt)
#pragma unroll
            for (int i = 0; i < 4; ++i) { const float p = __expf(s[kt][i] - mx); s[kt][i] = p; l += p; }
        l += shfl_x(l, 16, lane); l += shfl_x(l, 32, lane);
        f32x4 o[4];
#pragma unroll
        for (int nt = 0; nt < 4; ++nt) o[nt] = (f32x4){0.f, 0.f, 0.f, 0.f};
#pragma unroll
        for (int st = 0; st < 5; ++st) {
            const int kt0 = 2 * st, kt1 = 2 * st + 1;
            v4u pw; pw.x = pk2(s[kt0][0], s[kt0][1]); pw.y = pk2(s[kt0][2], s[kt0][3]);
            if (kt1 < 9) { pw.z = pk2(s[kt1 < 9 ? kt1 : 0][0], s[kt1 < 9 ? kt1 : 0][1]); pw.w = pk2(s[kt1 < 9 ? kt1 : 0][2], s[kt1 < 9 ? kt1 : 0][3]); } else { pw.z = 0u; pw.w = 0u; }
            const bf16x8 pf = __builtin_bit_cast(bf16x8, pw);
            const int kb0 = 16 * (w + kt0) + 4 * fq, kb1 = 16 * (w + kt1) + 4 * fq;
#pragma unroll
            for (int nt = 0; nt < 4; ++nt) { const int d = 16 * nt + fr;
                v2u va = *(const LAS v2u*)(lds + AT_VT + d * AT_VSTR + kb0 * 2), vb = (v2u){0u, 0u};
                if (kt1 < 9) vb = *(const LAS v2u*)(lds + AT_VT + d * AT_VSTR + kb1 * 2);
                v4u vw; vw.x = va.x; vw.y = va.y; vw.z = vb.x; vw.w = vb.y;
                o[nt] = __builtin_amdgcn_mfma_f32_16x16x32_bf16(__builtin_bit_cast(bf16x8, vw), pf, o[nt], 0, 0, 0); }
        }
        const float il = 1.0f / l;
        bf16* op = OG + ((size_t)g * T + (size_t)b * SEQ + tq) * DILW + h * 64 + 4 * fq;
#pragma unroll
        for (int nt = 0; nt < 4; ++nt) { v2u ww; ww.x = pk2(o[nt][0] * il, o[nt][1] * il); ww.y = pk2(o[nt][2] * il, o[nt][3] * il); *(v2u*)(op + 16 * nt) = ww; }
        if (fq == 0) LSE[((size_t)g * T + (size_t)b * SEQ + tq) * 8 + h] = mx + logf(l);
    }
}
__device__ __forceinline__ void phase_combine(const Frame& F, const bf16* OG, const float* LSE, bf16* O) {
    for (int it = F.bid * 512 + F.tid; it < T * 64; it += F.G * 512) {
        const int c8 = it & 7, h = (it >> 3) & 7, t = it >> 6;
        const float l0 = LSE[((size_t)0 * T + t) * 8 + h], l1 = LSE[((size_t)1 * T + t) * 8 + h], l2 = LSE[((size_t)2 * T + t) * 8 + h];
        const float m = fmaxf(l0, fmaxf(l1, l2)); float w0 = __expf(l0 - m), w1 = __expf(l1 - m), w2 = __expf(l2 - m); const float inv = 1.0f / (w0 + w1 + w2); w0 *= inv; w1 *= inv; w2 *= inv;
        float a[8], bq[8], c[8], o[8]; const size_t off = (size_t)t * DILW + h * 64 + c8 * 8;
        unpack8(*(const v4u*)(OG + off), a); unpack8(*(const v4u*)(OG + (size_t)T * DILW + off), bq); unpack8(*(const v4u*)(OG + (size_t)2 * T * DILW + off), c);
#pragma unroll
        for (int q = 0; q < 8; ++q) o[q] = w0 * a[q] + w1 * bq[q] + w2 * c[q];
        v4u ww; ww.x = pk2(o[0], o[1]); ww.y = pk2(o[2], o[3]); ww.z = pk2(o[4], o[5]); ww.w = pk2(o[6], o[7]);
        *(v4u*)(O + off) = ww;
    }
}

constexpr int M1_LOG = 131072, M1_STAT = M1_LOG + 4096, M1_HIST = M1_STAT + 128, M1_BASE = M1_HIST + 256;
__device__ __forceinline__ void phase_moe1(const Frame& F, const float* Y, const float* gain, const float* bias, const float* RW, const float* RB,
                                           float* X1F, bf16* X1B, unsigned* cnt, int* ltok, float* lgate, int* eidx, int* inv) {
    LAS float* xs = (LAS float*)F.lds; LAS float* logit = (LAS float*)(F.lds + M1_LOG); LAS float* stat = (LAS float*)(F.lds + M1_STAT);
    LAS int* hist = (LAS int*)(F.lds + M1_HIST); LAS int* basep = (LAS int*)(F.lds + M1_BASE);
    const int tid = F.tid, lane = F.lane, w = F.wave;
    for (int rg = F.bid; rg < T / 16; rg += F.G) {
        const int row0 = rg * 16;
        __syncthreads();
#pragma unroll
        for (int j = 0; j < 16; ++j) { const int idx = tid + 512 * j; *(LAS f32x4*)(xs + idx * 4) = *(const f32x4*)(Y + (size_t)row0 * D + (size_t)idx * 4); }
        if (tid < 64) hist[tid] = 0;
        __syncthreads();
#pragma unroll
        for (int rr = 0; rr < 2; ++rr) { const int r = 2 * w + rr; float sm = 0.f;
#pragma unroll
            for (int j = 0; j < 32; ++j) sm += xs[r * D + lane + 64 * j];
            const float mean = wave_sum(sm, lane) * (1.0f / D); float sq = 0.f;
#pragma unroll
            for (int j = 0; j < 32; ++j) { const float d = xs[r * D + lane + 64 * j] - mean; sq += d * d; }
            const float rstd = 1.0f / sqrtf(wave_sum(sq, lane) * (1.0f / D) + LN_EPS);
            if (lane == 0) { stat[2 * r] = mean; stat[2 * r + 1] = rstd; } }
        __syncthreads();
#pragma unroll
        for (int j = 0; j < 16; ++j) { const int idx = tid + 512 * j, r = idx >> 9, c4 = (idx & 511) * 4;
            const f32x4 v = *(LAS f32x4*)(xs + idx * 4), gv = *(const f32x4*)(gain + c4), bv = *(const f32x4*)(bias + c4);
            const float mean = stat[2 * r], rstd = stat[2 * r + 1];
            const f32x4 o = (v - mean) * rstd * gv + bv;
            *(LAS f32x4*)(xs + idx * 4) = o;
            *(f32x4*)(X1F + (size_t)(row0 + r) * D + c4) = o;
            v2u wb; wb.x = pk2(o[0], o[1]); wb.y = pk2(o[2], o[3]); *(v2u*)(X1B + (size_t)(row0 + r) * D + c4) = wb; }
        __syncthreads();
        { const int r = tid >> 5, ep = tid & 31; float a0 = 0.f, a1 = 0.f; const float* wp = RW + 2 * ep; const LAS float* xr = xs + r * D;
            for (int k0 = 0; k0 < D; k0 += 16) {
                f32x2 wv[16];
#pragma unroll
                for (int j = 0; j < 16; ++j) wv[j] = *(const f32x2*)(wp + (size_t)(k0 + j) * NEXP);
                asm volatile("" : "+v"(wv[0]), "+v"(wv[1]), "+v"(wv[2]), "+v"(wv[3]), "+v"(wv[4]), "+v"(wv[5]), "+v"(wv[6]), "+v"(wv[7]));
                asm volatile("" : "+v"(wv[8]), "+v"(wv[9]), "+v"(wv[10]), "+v"(wv[11]), "+v"(wv[12]), "+v"(wv[13]), "+v"(wv[14]), "+v"(wv[15]));
#pragma unroll
                for (int j = 0; j < 16; ++j) { const float xv = xr[k0 + j]; a0 += xv * wv[j].x; a1 += xv * wv[j].y; } }
            logit[r * NEXP + 2 * ep] = a0; logit[r * NEXP + 2 * ep + 1] = a1; }
        __syncthreads();
        int sel_pos[2]; float sel_gate[2]; int sel_rank[2]; bool sel_on[2];
#pragma unroll
        for (int rr = 0; rr < 2; ++rr) { const int r = 2 * w + rr;
            const float sc = 1.0f / (1.0f + __expf(-logit[r * NEXP + lane])); const float ch = sc + RB[lane];
            int rk = 0;
#pragma unroll
            for (int j = 0; j < 8; ++j) { const float cj = shfl_from(ch, (lane & ~7) + j); rk += (cj > ch || (cj == ch && j < (lane & 7))) ? 1 : 0; }
            float gs = rk < 2 ? ch : 0.f; gs += shfl_x(gs, 1, lane); gs += shfl_x(gs, 2, lane); gs += shfl_x(gs, 4, lane);
            int grk = 0; const int g = lane >> 3;
#pragma unroll
            for (int hh = 0; hh < 8; ++hh) { const float gh = shfl_from(gs, 8 * hh); grk += (gh > gs || (gh == gs && hh < g)) ? 1 : 0; }
            const float msk = grk < 4 ? ch : -INFINITY;
            int erk = 0;
            for (int j = 0; j < 64; ++j) { const float mj = __builtin_bit_cast(float, __builtin_amdgcn_readlane(__builtin_bit_cast(int, msk), j)); erk += (mj > msk || (mj == msk && j < lane)) ? 1 : 0; }
            const bool on = erk < 8;
            const float ssum = wave_sum(on ? sc : 0.f, lane);
            sel_on[rr] = on; sel_rank[rr] = erk; sel_gate[rr] = sc / ssum * 2.5f; sel_pos[rr] = 0;
            if (on) sel_pos[rr] = __hip_atomic_fetch_add(&hist[lane], 1, __ATOMIC_RELAXED, __HIP_MEMORY_SCOPE_WORKGROUP); }
        __syncthreads();
        if (tid < 64) { const int hc = hist[tid]; int bs = 0; if (hc > 0) bs = (int)atomicAdd(&cnt[tid * 16], (unsigned)hc); basep[tid] = bs; }
        __syncthreads();
#pragma unroll
        for (int rr = 0; rr < 2; ++rr) if (sel_on[rr]) { const int t = row0 + 2 * w + rr, pos = basep[lane] + sel_pos[rr];
            ltok[(size_t)lane * CAP + pos] = t; lgate[(size_t)lane * CAP + pos] = sel_gate[rr];
            eidx[t * 8 + sel_rank[rr]] = lane; inv[t * 8 + sel_rank[rr]] = pos; }
    }
}
__device__ __forceinline__ int build_tiles(const Frame& F, const unsigned* cnt) {
    LAS int* tpref = (LAS int*)(F.lds + LDS_TAB); LAS int* cl = (LAS int*)(F.lds + LDS_TAB + 512);
    __syncthreads();
    if (F.tid < 64) cl[F.tid] = (int)__hip_atomic_load(&cnt[F.tid * 16], __ATOMIC_RELAXED, __HIP_MEMORY_SCOPE_AGENT);
    __syncthreads();
    if (F.tid == 0) { int acc = 0; for (int e = 0; e < 64; ++e) { tpref[e] = acc; acc += (cl[e] + 255) >> 8; } tpref[64] = acc; tpref[65] = acc + T / 256; tpref[66] = acc + 2 * (T / 256); cl[64] = T; cl[65] = T; }
    __syncthreads();
    return __builtin_amdgcn_readfirstlane(tpref[64]);
}
__device__ __forceinline__ void phase_moe4(const Frame& F, const float* Y2, const bf16* Yr, const int* eidx, const int* inv, const float* gain, const float* bias, float* XO, bf16* XBo) {
    const LAS int* tpref = (const LAS int*)(F.lds + LDS_TAB);
    const int gw = F.bid * 8 + F.wave, NGW = F.G * 8, lane = F.lane;
    for (int t = gw; t < T; t += NGW) {
        f32x4 v[8];
#pragma unroll
        for (int j = 0; j < 8; ++j) v[j] = *(const f32x4*)(Y2 + (size_t)t * D + 4 * lane + 256 * j);
        for (int k = 0; k < 8; ++k) { const int e = eidx[t * 8 + k], pos = inv[t * 8 + k]; const bf16* yr = Yr + (size_t)(tpref[e] * 256 + pos) * D + 4 * lane;
#pragma unroll
            for (int j = 0; j < 8; ++j) { const v2u w = *(const v2u*)(yr + 256 * j); v[j][0] += bflo(w.x); v[j][1] += bfhi(w.x); v[j][2] += bflo(w.y); v[j][3] += bfhi(w.y); } }
        float sm = 0.f;
#pragma unroll
        for (int j = 0; j < 8; ++j) sm += (v[j][0] + v[j][1]) + (v[j][2] + v[j][3]);
        const float mean = wave_sum(sm, lane) * (1.0f / D); float sq = 0.f;
#pragma unroll
        for (int j = 0; j < 8; ++j) { v[j] = v[j] - mean; sq += (v[j][0] * v[j][0] + v[j][1] * v[j][1]) + (v[j][2] * v[j][2] + v[j][3] * v[j][3]); }
        const float rstd = 1.0f / sqrtf(wave_sum(sq, lane) * (1.0f / D) + LN_EPS);
#pragma unroll
        for (int j = 0; j < 8; ++j) { const int c = 4 * lane + 256 * j; const f32x4 o = v[j] * rstd * *(const f32x4*)(gain + c) + *(const f32x4*)(bias + c);
            *(f32x4*)(XO + (size_t)t * D + c) = o;
            v2u wb; wb.x = pk2(o[0], o[1]); wb.y = pk2(o[2], o[3]); *(v2u*)(XBo + (size_t)t * D + c) = wb; }
    }
}


constexpr int M1_P = 0, M1N_HIST = 131072, M1N_BASE = 131072 + 256, M1N_GB = 131072 + 1024;
__device__ __forceinline__ void phase_moe1n(const Frame& F, const bf16* Y, const float* pst, const float* gain, const float* bias, const bf16* WH, const bf16* WL, const float* RB,
                                            bf16* X1B, float* ST1, unsigned* cnt, int* ltok, float* lgate, int* eidx, int* inv) {
    LAS float* P = (LAS float*)(F.lds + M1_P); LAS int* hist = (LAS int*)(F.lds + M1N_HIST); LAS int* basep = (LAS int*)(F.lds + M1N_BASE);
    const int tid = F.tid, lane = F.lane, w = F.wave, r = lane & 15, q = lane >> 4;
    for (int item = F.bid; item < T / 64; item += F.G) {
        const int row0 = item * 64;
        __syncthreads();
        if (tid < 64) hist[tid] = 0;
        { LAS f32x4* gb = (LAS f32x4*)(F.lds + M1N_GB); gb[tid] = *(const f32x4*)(gain + 4 * tid); gb[512 + tid] = *(const f32x4*)(bias + 4 * tid); }
        __syncthreads();
        float mean[4], rstd[4];
#pragma unroll
        for (int rt = 0; rt < 4; ++rt) { const int row = row0 + 16 * rt + r;
          const f32x4* pp = (const f32x4*)(pst + ((size_t)row * 32 + q * 8) * 2); const f32x4 a = pp[0], b = pp[1], c = pp[2], d = pp[3];
          float sm = (a[0] + a[2]) + (b[0] + b[2]) + (c[0] + c[2]) + (d[0] + d[2]), sq = (a[1] + a[3]) + (b[1] + b[3]) + (c[1] + c[3]) + (d[1] + d[3]);
          sm += shfl_x(sm, 16, lane); sm += shfl_x(sm, 32, lane); sq += shfl_x(sq, 16, lane); sq += shfl_x(sq, 32, lane);
          mean[rt] = sm * (1.0f / D); const float var = fmaxf(sq * (1.0f / D) - mean[rt] * mean[rt], 0.f); rstd[rt] = 1.0f / sqrtf(var + LN_EPS);
          if (w == 0 && q == 0) *(f32x2*)(ST1 + 2 * row) = (f32x2){mean[rt], rstd[rt]}; }
        const int kb = 256 * w + 8 * q;
        const LAS float* gl = (const LAS float*)(F.lds + M1N_GB) + kb;
        f32x4 acc[4][4];
#pragma unroll
        for (int rt = 0; rt < 4; ++rt)
#pragma unroll
            for (int nt = 0; nt < 4; ++nt) acc[rt][nt] = (f32x4){0.f, 0.f, 0.f, 0.f};
        v4u yb[3][4]; bf16x8 wh[4], wl[4];
        unsigned vo[4];
#pragma unroll
        for (int i = 0; i < 4; ++i) { vo[i] = (unsigned)(r * D + kb) * 2u + (unsigned)i * (16u * D * 2u); asm volatile("" : "+v"(vo[i])); }
        const char* ybase = (const char*)(Y + (size_t)row0 * D); char* xbase = (char*)(X1B + (size_t)row0 * D);
#define M1_LOADY(st) do { _Pragma("unroll") for (int rt = 0; rt < 4; ++rt) yb[(st) % 3][rt] = *(const v4u*)(ybase + vo[rt] + 64 * (st)); } while (0)
#define M1_LOADW(st) do { _Pragma("unroll") for (int nt = 0; nt < 4; ++nt) { wh[nt] = *(const bf16x8*)((const char*)WH + vo[nt] + 64 * (st)); wl[nt] = *(const bf16x8*)((const char*)WL + vo[nt] + 64 * (st)); } } while (0)
        M1_LOADY(0); M1_LOADW(0); M1_LOADY(1);
        __builtin_amdgcn_sched_barrier(0);
#pragma unroll
        for (int st = 0; st < 8; ++st) {
            const f32x4 g0 = *(const LAS f32x4*)(gl + 32 * st), g1 = *(const LAS f32x4*)(gl + 32 * st + 4), b0 = *(const LAS f32x4*)(gl + 2048 + 32 * st), b1 = *(const LAS f32x4*)(gl + 2048 + 32 * st + 4);
#pragma unroll
            for (int rt = 0; rt < 4; ++rt) { const v4u yv = yb[st % 3][rt];
                const f32x4 y0_ = (f32x4){bflo(yv.x), bfhi(yv.x), bflo(yv.y), bfhi(yv.y)}, y1_ = (f32x4){bflo(yv.z), bfhi(yv.z), bflo(yv.w), bfhi(yv.w)};
                const f32x4 x0 = (y0_ - mean[rt]) * rstd[rt] * g0 + b0, x1 = (y1_ - mean[rt]) * rstd[rt] * g1 + b1;
                v4u h; h.x = cvt_pk_bf16(x0[0], x0[1]); h.y = cvt_pk_bf16(x0[2], x0[3]); h.z = cvt_pk_bf16(x1[0], x1[1]); h.w = cvt_pk_bf16(x1[2], x1[3]);
                *(v4u*)(xbase + vo[rt] + 64 * st) = h;
                v4u l; l.x = cvt_pk_bf16(x0[0] - bflo(h.x), x0[1] - bfhi(h.x)); l.y = cvt_pk_bf16(x0[2] - bflo(h.y), x0[3] - bfhi(h.y));
                l.z = cvt_pk_bf16(x1[0] - bflo(h.z), x1[1] - bfhi(h.z)); l.w = cvt_pk_bf16(x1[2] - bflo(h.w), x1[3] - bfhi(h.w));
                const bf16x8 xh = __builtin_bit_cast(bf16x8, h), xl = __builtin_bit_cast(bf16x8, l);
#pragma unroll
                for (int nt = 0; nt < 4; ++nt) { acc[rt][nt] = __builtin_amdgcn_mfma_f32_16x16x32_bf16(xh, wh[nt], acc[rt][nt], 0, 0, 0);
                    acc[rt][nt] = __builtin_amdgcn_mfma_f32_16x16x32_bf16(xl, wh[nt], acc[rt][nt], 0, 0, 0); acc[rt][nt] = __builtin_amdgcn_mfma_f32_16x16x32_bf16(xh, wl[nt], acc[rt][nt], 0, 0, 0); } }
            __builtin_amdgcn_sched_barrier(0);
            if (st + 1 < 8) M1_LOADW(st + 1);
            if (st + 2 < 8) M1_LOADY(st + 2);
            __builtin_amdgcn_sched_barrier(0);
        }
#undef M1_LOADY
#undef M1_LOADW
#pragma unroll
        for (int rt = 0; rt < 4; ++rt)
#pragma unroll
            for (int nt = 0; nt < 4; ++nt)
#pragma unroll
                for (int i = 0; i < 4; ++i) P[(w * 64 + 16 * rt + 4 * q + i) * 64 + 16 * nt + r] = acc[rt][nt][i];
        __syncthreads();
        int sel_pos[8]; float sel_gate[8]; int sel_rank[8]; bool sel_on[8];
        const float rb = RB[lane];
#pragma unroll
        for (int rr = 0; rr < 8; ++rr) { const int rl = 8 * w + rr;
            float lg = ((P[rl * 64 + lane] + P[(64 + rl) * 64 + lane]) + (P[(128 + rl) * 64 + lane] + P[(192 + rl) * 64 + lane])) + ((P[(256 + rl) * 64 + lane] + P[(320 + rl) * 64 + lane]) + (P[(384 + rl) * 64 + lane] + P[(448 + rl) * 64 + lane]));
            lg = (lg == lg) ? lg : -1.0e30f;
            const float sc = 1.0f / (1.0f + __expf(-lg)); const float ch = sc + rb;
            int rk = 0;
#pragma unroll
            for (int j = 0; j < 8; ++j) { const float cj = shfl_from(ch, (lane & ~7) + j); rk += (cj > ch || (cj == ch && j < (lane & 7))) ? 1 : 0; }
            float gs = rk < 2 ? ch : 0.f; gs += shfl_x(gs, 1, lane); gs += shfl_x(gs, 2, lane); gs += shfl_x(gs, 4, lane);
            int grk = 0; const int g = lane >> 3;
#pragma unroll
            for (int hh = 0; hh < 8; ++hh) { const float gh = shfl_from(gs, 8 * hh); grk += (gh > gs || (gh == gs && hh < g)) ? 1 : 0; }
            const float msk = grk < 4 ? ch : -INFINITY;
            int erk = 0;
            for (int j = 0; j < 64; ++j) { const float mj = __builtin_bit_cast(float, __builtin_amdgcn_readlane(__builtin_bit_cast(int, msk), j)); erk += (mj > msk || (mj == msk && j < lane)) ? 1 : 0; }
            const bool on = erk < 8;
            const float ssum = wave_sum(on ? sc : 0.f, lane);
            sel_on[rr] = on; sel_rank[rr] = erk; sel_gate[rr] = sc / ssum * 2.5f; sel_pos[rr] = 0;
            if (on) sel_pos[rr] = __hip_atomic_fetch_add(&hist[lane], 1, __ATOMIC_RELAXED, __HIP_MEMORY_SCOPE_WORKGROUP); }
        __syncthreads();
        if (tid < 64) { int tt = tid; asm volatile("" : "+v"(tt));
            const int hc = hist[tt]; int bs = 0; if (hc > 0) bs = (int)atomicAdd(&cnt[tt * 16], (unsigned)hc); basep[tt] = bs; }
        __syncthreads();
#pragma unroll
        for (int rr = 0; rr < 8; ++rr) if (sel_on[rr]) { const int t = row0 + 8 * w + rr, pos = basep[lane] + sel_pos[rr];
            ltok[(size_t)lane * CAP + pos] = t * 8 + sel_rank[rr]; lgate[(size_t)lane * CAP + pos] = sel_gate[rr];
            eidx[t * 8 + sel_rank[rr]] = lane; inv[t * 8 + sel_rank[rr]] = pos; }
    }
}

constexpr int M3_PL = 131072, M3_CNT = 147456, M3_OFF = 147456 + 272;
__device__ __forceinline__ void phase_moe3n(const Frame& F, const bf16* H, const bf16* HSp, const int* eidx, const bf16* WD, const bf16* WSD,
                                            const float* Y1, const float* ST1, const float* g1, const float* b1, float* Y2, float* PST2) {
    LAS int* out = (LAS int*)F.lds; LAS unsigned short* plist = (LAS unsigned short*)(F.lds + M3_PL); LAS int* cnt = (LAS int*)(F.lds + M3_CNT); LAS int* off = (LAS int*)(F.lds + M3_OFF);
    const int tid = F.tid, lane = F.lane, w = F.wave, r = lane & 15, q = lane >> 4;
    for (int u = F.bid; u < 1024; u += F.G) {
        int nc = (u & 7) | ((u >> 7) << 3), tb = (u >> 3) & 15;
        if (F.G == 256) { const int i = u >> 8, x = u & 7, j = (u >> 3) & 31; tb = 2 * x + (i >> 1); nc = 32 * (i & 1) + j; }
        __syncthreads();
#pragma unroll
        for (int j = 0; j < 16; ++j) ((LAS v4u*)out)[tid + 512 * j] = (v4u){0u, 0u, 0u, 0u};
        if (tid < 66) cnt[tid] = 0;
        __syncthreads();
        int ee[16], pp[16];
        { const v4u* ep = (const v4u*)(eidx + ((size_t)tb * 1024 + 2 * tid) * 8); const v4u e0 = ep[0], e1 = ep[1], e2 = ep[2], e3 = ep[3];
          ee[0] = e0.x; ee[1] = e0.y; ee[2] = e0.z; ee[3] = e0.w; ee[4] = e1.x; ee[5] = e1.y; ee[6] = e1.z; ee[7] = e1.w;
          ee[8] = e2.x; ee[9] = e2.y; ee[10] = e2.z; ee[11] = e2.w; ee[12] = e3.x; ee[13] = e3.y; ee[14] = e3.z; ee[15] = e3.w; }
#pragma unroll
        for (int j = 0; j < 16; ++j) pp[j] = __hip_atomic_fetch_add(&cnt[ee[j]], 1, __ATOMIC_RELAXED, __HIP_MEMORY_SCOPE_WORKGROUP);
        __syncthreads();
        if (w == 0) { int c = cnt[lane], x = c;
#pragma unroll
            for (int o = 1; o < 64; o <<= 1) { const int y = __builtin_amdgcn_ds_bpermute(((lane - o) & 63) << 2, x); if (lane >= o) x += y; }
            off[lane] = x - c; if (lane == 63) off[64] = x; }
        __syncthreads();
#pragma unroll
        for (int j = 0; j < 16; ++j) plist[off[ee[j]] + pp[j]] = (unsigned short)(tid * 16 + j);
        __syncthreads();
        const char* Hb = (const char*)H + (size_t)tb * 8192 * 256 + q * 16;
        const char* HSb = (const char*)HSp + (size_t)tb * 1024 * 512 + q * 16;
        const char* Bb = (const char*)WD + ((size_t)nc * 32 + r) * 256 + q * 16;
        const char* BSb = (const char*)WSD + ((size_t)nc * 32 + r) * 512 + q * 16;
#define M3_NR(sg) ((sg) < 8 ? __builtin_amdgcn_readfirstlane(cnt[w + 8 * (sg)]) : 128)
#define M3_RB(sg) ((sg) < 8 ? __builtin_amdgcn_readfirstlane(off[w + 8 * (sg)]) : 0)
#define M3_GLD(dst, ptr, OFF) asm volatile("global_load_dwordx4 %0, %1, off offset:" #OFF : "=&v"(dst) : "v"(ptr) : "memory")
#define M3_LOADB(dst, sg) do { const char* _b0 = (sg) < 8 ? Bb + (size_t)(w + 8 * (sg)) * 524288 : BSb + ((sg) - 8) * 256; const char* _b1 = _b0 + ((sg) < 8 ? 4096 : 8192); \
            M3_GLD(dst[0][0], _b0, 0); M3_GLD(dst[0][1], _b0, 64); M3_GLD(dst[0][2], _b0, 128); M3_GLD(dst[0][3], _b0, 192); \
            M3_GLD(dst[1][0], _b1, 0); M3_GLD(dst[1][1], _b1, 64); M3_GLD(dst[1][2], _b1, 128); M3_GLD(dst[1][3], _b1, 192); } while (0)
#define M3_LOADA(dst, sg, bb, nr, rbs) do { int _i = 16 * (bb) + r; _i = _i < (nr) ? _i : (nr) - 1; const unsigned _rid = plist[(rbs) + _i]; \
            const char* _a = (sg) < 8 ? Hb + (size_t)_rid * 256 : ((sg) < 10 ? HSb + (size_t)(128 * w + _i) * 512 + ((sg) - 8) * 256 : Hb); \
            M3_GLD(dst[0], _a, 0); M3_GLD(dst[1], _a, 64); M3_GLD(dst[2], _a, 128); M3_GLD(dst[3], _a, 192); } while (0)
#define M3_ADV(sg, bb, nr, rbs) do { if ((sg) < 10) { ++(bb); if ((bb) * 16 >= (nr)) { (bb) = 0; do { ++(sg); } while ((sg) < 8 && M3_NR(sg) == 0); if ((sg) < 10) { (nr) = M3_NR(sg); (rbs) = M3_RB(sg); } } } } while (0)
#define M3_WAITA(AS) asm volatile("s_waitcnt vmcnt(12)" : "+v"(AS[0]), "+v"(AS[1]), "+v"(AS[2]), "+v"(AS[3]) :: "memory")
#define M3_WAITB(N) asm volatile("s_waitcnt vmcnt(" #N ")" : "+v"(Bn[0][0]), "+v"(Bn[0][1]), "+v"(Bn[0][2]), "+v"(Bn[0][3]), "+v"(Bn[1][0]), "+v"(Bn[1][1]), "+v"(Bn[1][2]), "+v"(Bn[1][3]) :: "memory")
#define M3_STEP(AS) if (cseg < 10) { \
              \
            int tk[4]; bool ok[4]; unsigned pl[4]; const int rt_ = cseg < 8; \
            _Pragma("unroll") for (int i = 0; i < 4; ++i) { const int idx = 16 * cbt + 4 * q + i; ok[i] = idx < cnr; const int ic = ok[i] ? idx : cnr - 1; pl[i] = plist[crbs + ic]; tk[i] = 128 * w + ic; } \
            _Pragma("unroll") for (int i = 0; i < 4; ++i) tk[i] = rt_ ? (int)(pl[i] >> 3) : tk[i]; \
            M3_WAITA(AS); \
            f32x4 acc[2]; \
            _Pragma("unroll") for (int nt = 0; nt < 2; ++nt) { acc[nt] = (f32x4){0.f, 0.f, 0.f, 0.f}; \
                _Pragma("unroll") for (int kk = 0; kk < 4; ++kk) acc[nt] = __builtin_amdgcn_mfma_f32_16x16x32_bf16(__builtin_bit_cast(bf16x8, AS[kk]), __builtin_bit_cast(bf16x8, Bc[nt][kk]), acc[nt], 0, 0, 0); } \
              \
            _Pragma("unroll") for (int i = 0; i < 4; ++i) { const long long lo_ = ok[i] ? (long long)__float2int_rn(acc[0][i] * 4194304.0f) : 0ll, hi_ = ok[i] ? (long long)__float2int_rn(acc[1][i] * 4194304.0f) : 0ll; \
                (void)__hip_atomic_fetch_add((LAS unsigned long long*)out + tk[i] * 16 + r, (unsigned long long)((hi_ << 32) + lo_), __ATOMIC_RELAXED, __HIP_MEMORY_SCOPE_WORKGROUP); } \
            M3_LOADA(AS, pseg, pbt, pnr, prbs); M3_ADV(pseg, pbt, pnr, prbs); \
            { const int old_ = cseg, nbat_ = (cnr + 15) >> 4; M3_ADV(cseg, cbt, cnr, crbs); \
              if (cseg != old_ && cseg < 10) { \
                  if (nbat_ == 1) M3_WAITB(4); else if (nbat_ == 2) M3_WAITB(8); else if (nbat_ == 3) M3_WAITB(12); else M3_WAITB(16); \
                  _Pragma("unroll") for (int nt = 0; nt < 2; ++nt) _Pragma("unroll") for (int kk = 0; kk < 4; ++kk) Bc[nt][kk] = Bn[nt][kk]; \
                  int nb_ = cseg; do { ++nb_; } while (nb_ < 8 && M3_NR(nb_) == 0); if (nb_ >= 10) nb_ = 9; M3_LOADB(Bn, nb_); } } }
        int cseg = -1, cbt = 0, cnr = 0, crbs = 0;
        do { ++cseg; } while (cseg < 8 && M3_NR(cseg) == 0);
        cnr = M3_NR(cseg); crbs = M3_RB(cseg);
        int pseg = cseg, pbt = 0, pnr = cnr, prbs = crbs;
        v4u Bc[2][4], Bn[2][4], A0[4], A1[4], A2[4], A3[4];
        M3_LOADB(Bc, cseg);
        M3_LOADA(A0, pseg, pbt, pnr, prbs); M3_ADV(pseg, pbt, pnr, prbs);
        M3_LOADA(A1, pseg, pbt, pnr, prbs); M3_ADV(pseg, pbt, pnr, prbs);
        M3_LOADA(A2, pseg, pbt, pnr, prbs); M3_ADV(pseg, pbt, pnr, prbs);
        M3_LOADA(A3, pseg, pbt, pnr, prbs); M3_ADV(pseg, pbt, pnr, prbs);
        { int nb_ = cseg; do { ++nb_; } while (nb_ < 8 && M3_NR(nb_) == 0); if (nb_ >= 10) nb_ = 9; M3_LOADB(Bn, nb_); }
        asm volatile("s_waitcnt vmcnt(0)" : "+v"(Bc[0][0]), "+v"(Bc[0][1]), "+v"(Bc[0][2]), "+v"(Bc[0][3]), "+v"(Bc[1][0]), "+v"(Bc[1][1]), "+v"(Bc[1][2]), "+v"(Bc[1][3]) :: "memory");
#pragma unroll 1
        while (cseg < 10) { M3_STEP(A0) M3_STEP(A1) M3_STEP(A2) M3_STEP(A3) }
        asm volatile("s_waitcnt vmcnt(0)" : "+v"(A0[0]), "+v"(A0[1]), "+v"(A0[2]), "+v"(A0[3]), "+v"(A1[0]), "+v"(A1[1]), "+v"(A1[2]), "+v"(A1[3]), "+v"(A2[0]), "+v"(A2[1]), "+v"(A2[2]), "+v"(A2[3]),
                     "+v"(A3[0]), "+v"(A3[1]), "+v"(A3[2]), "+v"(A3[3]), "+v"(Bn[0][0]), "+v"(Bn[0][1]), "+v"(Bn[0][2]), "+v"(Bn[0][3]), "+v"(Bn[1][0]), "+v"(Bn[1][1]), "+v"(Bn[1][2]), "+v"(Bn[1][3]) :: "memory");
#undef M3_NR
#undef M3_RB
#undef M3_GLD
#undef M3_LOADB
#undef M3_LOADA
#undef M3_ADV
#undef M3_WAITA
#undef M3_WAITB
#undef M3_STEP
        __syncthreads();
        { const int c4 = lane & 7, rs = lane >> 3, col = nc * 32 + 4 * c4;
          const f32x4 gv = *(const f32x4*)(g1 + col), bv = *(const f32x4*)(b1 + col);
#pragma unroll 4
          for (int it = 0; it < 16; ++it) { const int rl = 128 * w + 8 * it + rs; const size_t row = (size_t)tb * 1024 + rl;
              const f32x4 yv = *(const f32x4*)(Y1 + row * D + col); const f32x2 sv = *(const f32x2*)(ST1 + 2 * row);
              f32x4 tv; { const int nt = c4 >> 2, r0 = (4 * c4) & 15;
#pragma unroll
                  for (int j = 0; j < 4; ++j) { const v2u cell = *(const LAS v2u*)(out + rl * 32 + 2 * (r0 + j)); const int lo = (int)cell.x, hi = (int)cell.y + (lo < 0 ? 1 : 0); tv[j] = (float)(nt ? hi : lo) * (1.0f / 4194304.0f); } }
              const f32x4 y = ((yv - sv.x) * sv.y * gv + bv) * ALPHA + tv;
              *(f32x4*)(Y2 + row * D + col) = y;
              float sm = (y[0] + y[1]) + (y[2] + y[3]), sq = (y[0] * y[0] + y[1] * y[1]) + (y[2] * y[2] + y[3] * y[3]);
#pragma unroll
              for (int o = 1; o < 8; o <<= 1) { sm += shfl_x(sm, o, lane); sq += shfl_x(sq, o, lane); }
              if (c4 == 0) *(f32x2*)(PST2 + (row * 64 + nc) * 2) = (f32x2){sm, sq}; } }
    }
}

__device__ __forceinline__ void phase_moe4n(const Frame& F, const float* Y2, const float* pst, const float* gain, const float* bias, float* ST2, bf16* XBo, float* OUT, int last) {
    const int gw = F.bid * 8 + F.wave, NGW = F.G * 8, lane = F.lane;
    for (int t = gw; t < T; t += NGW) {
        f32x4 v[8];
#pragma unroll
        for (int j = 0; j < 8; ++j) v[j] = *(const f32x4*)(Y2 + (size_t)t * D + 4 * lane + 256 * j);
        const f32x2 pv = *(const f32x2*)(pst + ((size_t)t * 64 + lane) * 2);
        const float mean = wave_sum(pv.x, lane) * (1.0f / D); const float var = fmaxf(wave_sum(pv.y, lane) * (1.0f / D) - mean * mean, 0.f); const float rstd = 1.0f / sqrtf(var + LN_EPS);
        if (lane == 0) *(f32x2*)(ST2 + 2 * (size_t)t) = (f32x2){mean, rstd};
#pragma unroll
        for (int j = 0; j < 8; ++j) { const int c = 4 * lane + 256 * j; const f32x4 o = (v[j] - mean) * rstd * *(const f32x4*)(gain + c) + *(const f32x4*)(bias + c);
            if (last) *(f32x4*)(OUT + (size_t)t * D + c) = o;
            else { v2u wb; wb.x = pk2(o[0], o[1]); wb.y = pk2(o[2], o[3]); *(v2u*)(XBo + (size_t)t * D + c) = wb; } }
    }
}


__device__ __forceinline__ void phase_moe4q(const Frame& F, const bf16* X1, bf16* Y2, const unsigned char* Yq, const float* Ysc, const int* eidx, const int* inv, const float* gain, const float* bias, float* ST2, bf16* XBo, float* OUT, int last) {
    const LAS int* tpref = (const LAS int*)(F.lds + LDS_TAB);
    const int gw = F.bid * 8 + F.wave, NGW = F.G * 8, lane = F.lane;
    for (int t = gw; t < T; t += NGW) {
        int rowi = 0; if (lane < 8) { const int e = eidx[t * 8 + lane], ps = inv[t * 8 + lane]; rowi = tpref[e] * 256 + ps; } else if (lane < 10) rowi = tpref[56 + lane] * 256 + t;
        v4u pv[2][2], yv[10][2]; float sc[10][2];
#pragma unroll
        for (int j = 0; j < 2; ++j) { pv[j][0] = *(const v4u*)(X1 + (size_t)t * D + 16 * lane + 1024 * j); pv[j][1] = *(const v4u*)(X1 + (size_t)t * D + 16 * lane + 1024 * j + 8); }
#pragma unroll
        for (int k = 0; k < 10; ++k) { const size_t row = (size_t)__builtin_amdgcn_readlane(rowi, k);
#pragma unroll
            for (int j = 0; j < 2; ++j) { yv[k][j] = *(const v4u*)(Yq + row * D + 16 * lane + 1024 * j); sc[k][j] = Ysc[row * 16 + 8 * j + (lane >> 3)]; } }
#pragma unroll
        for (int k = 0; k < 10; ++k) asm volatile("" : "+v"(yv[k][0]), "+v"(yv[k][1]), "+v"(sc[k][0]), "+v"(sc[k][1]));
        float v[2][16];
#pragma unroll
        for (int j = 0; j < 2; ++j) { float f0[8], f1[8]; unpack8(pv[j][0], f0); unpack8(pv[j][1], f1);
            const float ss = (((sc[0][j] + sc[1][j]) + (sc[2][j] + sc[3][j])) + ((sc[4][j] + sc[5][j]) + (sc[6][j] + sc[7][j]))) + (sc[8][j] + sc[9][j]);
#pragma unroll
            for (int i = 0; i < 8; ++i) { v[j][i] = ALPHA * f0[i] - 128.f * ss; v[j][8 + i] = ALPHA * f1[i] - 128.f * ss; } }
#pragma unroll
        for (int k = 0; k < 10; ++k)
#pragma unroll
            for (int j = 0; j < 2; ++j) { const float s_ = sc[k][j]; const unsigned q[4] = {yv[k][j].x, yv[k][j].y, yv[k][j].z, yv[k][j].w};
#pragma unroll
                for (int d = 0; d < 4; ++d) { v[j][4 * d + 0] += s_ * (float)(q[d] & 0xffu); v[j][4 * d + 1] += s_ * (float)((q[d] >> 8) & 0xffu); v[j][4 * d + 2] += s_ * (float)((q[d] >> 16) & 0xffu); v[j][4 * d + 3] += s_ * (float)(q[d] >> 24); } }
        float sm = 0.f;
#pragma unroll
        for (int j = 0; j < 2; ++j)
#pragma unroll
            for (int i = 0; i < 16; i += 4) sm += (v[j][i] + v[j][i + 1]) + (v[j][i + 2] + v[j][i + 3]);
        const float mean = wave_sum(sm, lane) * (1.0f / D); float sq = 0.f;
#pragma unroll
        for (int j = 0; j < 2; ++j)
#pragma unroll
            for (int i = 0; i < 16; ++i) { const float d = v[j][i] - mean; sq += d * d; }
        const float rstd = 1.0f / sqrtf(wave_sum(sq, lane) * (1.0f / D) + LN_EPS);
        if (lane == 0) *(f32x2*)(ST2 + 2 * (size_t)t) = (f32x2){mean, rstd};
#pragma unroll
        for (int j = 0; j < 2; ++j)
#pragma unroll
            for (int h = 0; h < 2; ++h) { const int c = 16 * lane + 1024 * j + 8 * h; const float* vv = &v[j][8 * h];
                if (!last) { v4u yw; yw.x = pk2(vv[0], vv[1]); yw.y = pk2(vv[2], vv[3]); yw.z = pk2(vv[4], vv[5]); yw.w = pk2(vv[6], vv[7]); *(v4u*)(Y2 + (size_t)t * D + c) = yw; }
                const f32x4 g0 = *(const f32x4*)(gain + c), g1 = *(const f32x4*)(gain + c + 4), b0 = *(const f32x4*)(bias + c), b1 = *(const f32x4*)(bias + c + 4);
                const f32x4 o0 = ((f32x4){vv[0], vv[1], vv[2], vv[3]} - mean) * rstd * g0 + b0, o1 = ((f32x4){vv[4], vv[5], vv[6], vv[7]} - mean) * rstd * g1 + b1;
                if (last) { *(f32x4*)(OUT + (size_t)t * D + c) = o0; *(f32x4*)(OUT + (size_t)t * D + c + 4) = o1; }
                else { v4u wb; wb.x = pk2(o0[0], o0[1]); wb.y = pk2(o0[2], o0[3]); wb.z = pk2(o1[0], o1[1]); wb.w = pk2(o1[2], o1[3]); *(v4u*)(XBo + (size_t)t * D + c) = wb; } }
    }
}

__device__ __forceinline__ void phase_downproj3(const Frame& F, const bf16* H, const bf16* WD, const bf16* HSp, const bf16* WSD, unsigned char* Yq, float* Ysc, int NT) {
    const LAS int* tpref = (const LAS int*)(F.lds + LDS_TAB); const LAS int* cl = (const LAS int*)(F.lds + LDS_TAB + 512);
    LAS unsigned char* lds = F.lds;
    const int tid = F.tid, lane = F.lane, w = F.wave, fr = lane & 15, fq = lane >> 4;
    unsigned rbB[2], cbB[2];
#pragma unroll
    for (int i = 0; i < 2; ++i) { int R_, C_; g8::stage_rc(tid * 16 + i * 8192, R_, C_); rbB[i] = (unsigned)((R_ & ~31) + g8::perm32(R_ & 31)); cbB[i] = (unsigned)C_ * 2u; }
    const unsigned ldsw = (unsigned)w * 1024u, lbase = (unsigned)(size_t)lds;
    int boffg[4];
#pragma unroll
    for (int g = 0; g < 4; ++g) boffg[g] = g8::lds_byte(32 * g + fr, fq * 8);
    LAS unsigned char* stg = lds + 65536 + w * (32 * 144);
    const int NU = NT * 4;
    int u = F.bid; if (u >= NU) return;
#define DP3_UNITINFO(uu, EXP, NV) do { const int tl_ = (uu) >> 2; int e_ = 0; while (__builtin_amdgcn_readfirstlane(tpref[e_ + 1]) <= tl_) ++e_; EXP = e_; \
        NV = __builtin_amdgcn_readfirstlane(cl[e_]) - (tl_ - __builtin_amdgcn_readfirstlane(tpref[e_])) * 256; } while (0)
#define DP3_GLDS(gsrc, ldsdst) do { unsigned keep_; asm volatile("s_mov_b32 %0, m0\n\ts_mov_b32 m0, %2\n\ts_nop 0\n\tglobal_load_lds_dwordx4 %1, off\n\ts_mov_b32 m0, %0" : "=&s"(keep_) : "v"(gsrc), "s"(ldsdst) : "memory"); } while (0)
#define DP3_STAGE(slot, gb, bs) do { const unsigned v0_ = rbB[0] * (unsigned)(bs) + cbB[0], v1_ = rbB[1] * (unsigned)(bs) + cbB[1]; _Pragma("unroll") for (int kt = 0; kt < 2; ++kt) { \
        DP3_GLDS((const void*)((gb) + kt * 128 + v0_), lbase + (unsigned)((slot) * 32768 + kt * 16384) + ldsw); \
        DP3_GLDS((const void*)((gb) + kt * 128 + v1_), lbase + (unsigned)((slot) * 32768 + kt * 16384) + ldsw + 8192u); } } while (0)
#define DP3_SRC(uu, ee, AB, AS, BB, BS) do { const int tl_ = (uu) >> 2, cu_ = ((uu) & 3) * 512; \
        if ((ee) < 64) { AB = (const char*)(H + (size_t)tl_ * 256 * EDIM); AS = EDIM * 2; BB = (const char*)(WD + (size_t)(ee) * D * EDIM + (size_t)cu_ * EDIM); BS = EDIM * 2; } \
        else { const int t0_ = (tl_ - __builtin_amdgcn_readfirstlane(tpref[ee])) * 256; AB = (const char*)(HSp + (size_t)t0_ * SDIM + ((ee) - 64) * EDIM); AS = SDIM * 2; \
               BB = (const char*)(WSD + (size_t)cu_ * SDIM + ((ee) - 64) * EDIM); BS = SDIM * 2; } } while (0)
    int ecur, nvcur; DP3_UNITINFO(u, ecur, nvcur);
    const char* abc; const char* gbc; int asc, bsc; DP3_SRC(u, ecur, abc, asc, gbc, bsc);
    bf16x8 A[2][4], An[2][4];
    { const char* ap_ = abc + (size_t)(32 * w + fr) * asc + 16 * fq;
#pragma unroll
      for (int m = 0; m < 2; ++m)
#pragma unroll
          for (int kk = 0; kk < 4; ++kk) A[m][kk] = *(const bf16x8*)(ap_ + (size_t)m * 16 * asc + 64 * kk); }
    DP3_STAGE(0, gbc, bsc);
    asm volatile("s_waitcnt vmcnt(0)" ::: "memory");
#pragma unroll 1
    for (;;) {
        const int un = (u + F.G < NU) ? u + F.G : u; int enx, nvnx; DP3_UNITINFO(un, enx, nvnx);
        const char* abn; const char* gbn; int asn, bsn; DP3_SRC(un, enx, abn, asn, gbn, bsn);
        const int tile = u >> 2, colu = (u & 3) * 512;
        float scq[2][4];
#pragma unroll
        for (int c = 0; c < 4; ++c) {
            if (c == 0) asm volatile("s_waitcnt vmcnt(5)" ::: "memory"); else asm volatile("s_waitcnt vmcnt(4)" ::: "memory");
            __builtin_amdgcn_s_barrier();
            if (c == 3) { const char* ap_ = abn + (size_t)(32 * w + fr) * asn + 16 * fq;
#pragma unroll
                for (int m = 0; m < 2; ++m) { const char* am_ = ap_ + (size_t)m * 16 * asn;
                    asm volatile("global_load_dwordx4 %0, %1, off" : "=&v"(An[m][0]) : "v"(am_) : "memory"); asm volatile("global_load_dwordx4 %0, %1, off offset:64" : "=&v"(An[m][1]) : "v"(am_) : "memory");
                    asm volatile("global_load_dwordx4 %0, %1, off offset:128" : "=&v"(An[m][2]) : "v"(am_) : "memory"); asm volatile("global_load_dwordx4 %0, %1, off offset:192" : "=&v"(An[m][3]) : "v"(am_) : "memory"); } }
            { const char* gnext = (c < 3) ? gbc + (size_t)(c + 1) * 128 * bsc : gbn; const int bnext = (c < 3) ? bsc : bsn; DP3_STAGE((c + 1) & 1, gnext, bnext); }
            __builtin_amdgcn_sched_barrier(0);
            f32x4 acc[2][4][2];
#pragma unroll
            for (int g = 0; g < 4; ++g) { bf16x8 Bf[2][4];
#pragma unroll
                for (int n = 0; n < 2; ++n)
#pragma unroll
                    for (int kk = 0; kk < 4; ++kk) Bf[n][kk] = *(const LAS bf16x8*)(lds + (c & 1) * 32768 + (kk >> 1) * 16384 + boffg[g] + n * 2048 + (kk & 1) * 1024);
#pragma unroll
                for (int m = 0; m < 2; ++m)
#pragma unroll
                    for (int n = 0; n < 2; ++n) { acc[m][g][n] = (f32x4){0.f, 0.f, 0.f, 0.f};
#pragma unroll
                        for (int kk = 0; kk < 4; ++kk) acc[m][g][n] = __builtin_amdgcn_mfma_f32_16x16x32_bf16(Bf[n][kk], A[m][kk], acc[m][g][n], 0, 0, 0); } }
#pragma unroll
            for (int m = 0; m < 2; ++m) {
                float am = 0.f;
#pragma unroll
                for (int g = 0; g < 4; ++g)
#pragma unroll
                    for (int n = 0; n < 2; ++n) am = fmaxf(am, fmaxf(fmaxf(fabsf(acc[m][g][n][0]), fabsf(acc[m][g][n][1])), fmaxf(fabsf(acc[m][g][n][2]), fabsf(acc[m][g][n][3]))));
                am = fmaxf(am, shfl_x(am, 16, lane)); am = fmaxf(am, shfl_x(am, 32, lane));
                am = fminf(am, 3.0e38f);
                const float isc = am > 0.f ? 127.0f * __builtin_amdgcn_rcpf(am) : 0.f;
                scq[m][c] = am * (1.0f / 127.0f);
#pragma unroll
                for (int g = 0; g < 4; ++g) { unsigned qd[2];
#pragma unroll
                    for (int n = 0; n < 2; ++n) {
                        const unsigned t0 = __builtin_bit_cast(unsigned, __builtin_fmaf(acc[m][g][n][0], isc, 8388736.0f)), t1 = __builtin_bit_cast(unsigned, __builtin_fmaf(acc[m][g][n][1], isc, 8388736.0f));
                        const unsigned t2 = __builtin_bit_cast(unsigned, __builtin_fmaf(acc[m][g][n][2], isc, 8388736.0f)), t3 = __builtin_bit_cast(unsigned, __builtin_fmaf(acc[m][g][n][3], isc, 8388736.0f));
                        qd[n] = (t0 & 0xffu) | ((t1 & 0xffu) << 8) | ((t2 & 0xffu) << 16) | (t3 << 24); }
                    *(LAS v2u*)(stg + (16 * m + fr) * 144 + 32 * g + 8 * fq) = (v2u){qd[0], qd[1]}; } }
#pragma unroll
            for (int it = 0; it < 4; ++it) { const int rr = 8 * it + (lane >> 3);
                const v4u o = *(const LAS v4u*)(stg + rr * 144 + (lane & 7) * 16);
                *(v4u*)(Yq + (size_t)(tile * 256 + 32 * w + rr) * D + colu + 128 * c + 16 * (lane & 7)) = o; }
            if (c == 3) { const f32x4 so = fq == 0 ? (f32x4){scq[0][0], scq[0][1], scq[0][2], scq[0][3]} : (f32x4){scq[1][0], scq[1][1], scq[1][2], scq[1][3]};
                if (fq < 2) *(f32x4*)(Ysc + (size_t)(tile * 256 + 32 * w + 16 * fq + fr) * 16 + (colu >> 7)) = so; }
            __builtin_amdgcn_sched_barrier(0);
        }
        asm volatile("s_waitcnt vmcnt(9)" : "+v"(An[0][0]), "+v"(An[0][1]), "+v"(An[0][2]), "+v"(An[0][3]), "+v"(An[1][0]), "+v"(An[1][1]), "+v"(An[1][2]), "+v"(An[1][3]) :: "memory");
        if (un == u) break;
#pragma unroll
        for (int m = 0; m < 2; ++m)
#pragma unroll
            for (int kk = 0; kk < 4; ++kk) A[m][kk] = An[m][kk];
        u = un; ecur = enx; nvcur = nvnx; abc = abn; asc = asn; gbc = gbn; bsc = bsn;
    }
    asm volatile("s_waitcnt vmcnt(0)" ::: "memory");
#undef DP3_UNITINFO
#undef DP3_STAGE
#undef DP3_GLDS
#undef DP3_SRC
}

enum { PH_PRO = 0, PH_POOL_G1, PH_POOL_P, PH_POOL_G2, PH_POOL_G3, PH_DIL_G1, PH_DIL_ATT, PH_DIL_CMB, PH_DIL_G2, PH_CONV_G1, PH_CONV_E, PH_CONV_G2, PH_MOE1, PH_MOE2, PH_MOE3, PH_MOE4, PH_COUNT };

template <int PH>
__device__ __forceinline__ void run_phase(const Frame& Fin, const Args& args_, const int L) {
    Frame F = Fin; { int w_ = Fin.wave, l_; asm volatile("" : "+s"(w_)); asm volatile("v_mbcnt_lo_u32_b32 %0, -1, 0\n\tv_mbcnt_hi_u32_b32 %0, -1, %0" : "=v"(l_)); F.wave = w_; F.lane = l_; F.tid = w_ * 64 + l_; }
    unsigned char* ws; { GAS unsigned char* wsg = (GAS unsigned char*)Fin.ws; asm volatile("" : "+s"(wsg)); ws = (unsigned char*)wsg; } F.ws = ws; F.ctl = (unsigned*)(ws + WS_CTL);
    KP kp = (KP)__builtin_amdgcn_kernarg_segment_ptr(); asm volatile("" : "+s"(kp)); (void)args_;
    { unsigned l_ = (unsigned)(size_t)Fin.lds; asm volatile("" : "+s"(l_)); F.lds = (LAS unsigned char*)(size_t)l_; }
    LAS unsigned char* ring = F.lds; int c = (int)blockIdx.x; { int g_ = Fin.G; asm volatile("" : "+s"(c), "+s"(g_)); F.G = g_; F.bid = c; }
    const float* xres = ain(kp, IN_X); const bf16* xresb = (const bf16*)(ws + WS_Y2F);
    const float* st2 = (const float*)(ws + WS_ST2); float* pstp = (float*)(ws + WS_PST);
    const float* g2p = ain(kp, IN_LNG) + (size_t)((L > 0 ? L - 1 : 0) * 2 + 1) * D; const float* b2p = ain(kp, IN_LNB) + (size_t)((L > 0 ? L - 1 : 0) * 2 + 1) * D;
    const bf16* xb = (const bf16*)(ws + WS_XB);
    bf16* yf = (bf16*)(ws + WS_YF);
    unsigned char* big = ws + WS_BIG;
    const int ia = L / 3;
    if constexpr (PH == PH_PRO) { phase_prologue(F, kp); }
    if constexpr (PH == PH_POOL_G1) { g8::DenseSched S; S.init(xb, (const bf16*)(ws + WS_W_POOL_IN) + (size_t)ia * D * D, T, D, D, D, F.G, c);
        g8::EpiBf16 E{(bf16*)(big + BG_U), D, 0}; g8::gemm_phase<g8::EpiBf16, g8::DenseSched, false>(ring, F.tid, D, D, D, S, E); }
    if constexpr (PH == PH_POOL_P) { phase_pool(F, (const bf16*)(big + BG_U), (bf16*)(big + BG_PL)); }
    if constexpr (PH == PH_POOL_G2) { g8::DenseSched S; S.init((const bf16*)(big + BG_PL), (const bf16*)(ws + WS_W_POOL_G) + (size_t)ia * D * 512, T, D, D, 512, F.G, c); S.agrp_shift = 1; S.agrp_stride = 512 * 2;
        g8::EpiScaleBf16 E{(bf16*)(big + BG_MX), D, ain(kp, IN_PSC) + (size_t)ia * D}; g8::gemm_phase<g8::EpiScaleBf16, g8::DenseSched, false>(ring, F.tid, 512, D, 512, S, E); }
    if constexpr (PH == PH_POOL_G3) { g8::DenseSched S; S.init((const bf16*)(big + BG_MX), (const bf16*)(ws + WS_W_POOL_OUT) + (size_t)ia * D * D, T, D, D, D, F.G, c);
        g8::EpiResidLN E{xres, xresb, st2, g2p, b2p, yf, pstp, L > 0}; g8::gemm_phase<g8::EpiResidLN, g8::DenseSched, false>(ring, F.tid, D, D, D, S, E); }
    if constexpr (PH == PH_DIL_G1) { g8::DenseSched S; S.init(xb, (const bf16*)(ws + WS_W_DIL_QKV), T, QKVC, D, D, F.G, c);
        g8::EpiBf16 E{(bf16*)(big + BG_QKV), QKVC, 1}; g8::gemm_phase<g8::EpiBf16, g8::DenseSched, false>(ring, F.tid, D, D, D, S, E); }
    if constexpr (PH == PH_DIL_ATT) { phase_attn(F, (const bf16*)(big + BG_QKV), ain(kp, IN_RELB), (bf16*)(big + BG_OG), (float*)(big + BG_LSE)); }
    if constexpr (PH == PH_DIL_CMB) { phase_combine(F, (const bf16*)(big + BG_OG), (const float*)(big + BG_LSE), (bf16*)(big + BG_O)); }
    if constexpr (PH == PH_DIL_G2) { g8::DenseSched S; S.init((const bf16*)(big + BG_O), (const bf16*)(ws + WS_W_DIL_OUT), T, D, DILW, DILW, F.G, c);
        g8::EpiResidLN E{xres, xresb, st2, g2p, b2p, yf, pstp, L > 0}; g8::gemm_phase<g8::EpiResidLN, g8::DenseSched, false>(ring, F.tid, DILW, DILW, DILW, S, E); }
    if constexpr (PH == PH_CONV_G1) { g8::DenseSched S; S.init(xb, (const bf16*)(ws + WS_W_CONV_IN), T, 3 * D, D, D, F.G, c);
        g8::EpiConvIn E{(bf16*)(big + BG_UC), (bf16*)(big + BG_BG)}; g8::gemm_phase<g8::EpiConvIn, g8::DenseSched, false>(ring, F.tid, D, D, D, S, E); }
    if constexpr (PH == PH_CONV_E) { phase_conv(F, (const bf16*)(big + BG_UC), (const bf16*)(big + BG_BG), ain(kp, IN_CW), (bf16*)(big + BG_Z)); }
    if constexpr (PH == PH_CONV_G2) { g8::DenseSched S; S.init((const bf16*)(big + BG_Z), (const bf16*)(ws + WS_W_CONV_OUT), T, D, D, D, F.G, c);
        g8::EpiResidLN E{xres, xresb, st2, g2p, b2p, yf, pstp, L > 0}; g8::gemm_phase<g8::EpiResidLN, g8::DenseSched, false>(ring, F.tid, D, D, D, S, E); }
    unsigned* cnt = F.ctl + CW_CNT + L * 64 * 16;
    float* x1f = (float*)(ws + WS_X1F); bf16* x1b = (bf16*)(ws + WS_X1B);
    int* ltok = (int*)(ws + WS_LTOK); float* lgate = (float*)(ws + WS_LGATE); int* eidx = (int*)(ws + WS_EIDX); int* inv = (int*)(ws + WS_INV);
    bf16* HB = (bf16*)(ws + WS_HB); bf16* HS = (bf16*)(ws + WS_HS); bf16* Yr = (bf16*)(ws + WS_BIG);
    if constexpr (PH == PH_MOE1) {
        const float* g1 = ain(kp, IN_LNG) + (size_t)(L * 2 + 0) * D; const float* b1 = ain(kp, IN_LNB) + (size_t)(L * 2 + 0) * D;
        phase_moe1n(F, yf, pstp, g1, b1, (const bf16*)(ws + WS_RWH) + (size_t)L * NEXP * D, (const bf16*)(ws + WS_RWL) + (size_t)L * NEXP * D, ain(kp, IN_RB) + (size_t)L * NEXP,
                    x1b, (float*)(ws + WS_ST1), cnt, ltok, lgate, eidx, inv); }
    if constexpr (PH == PH_MOE2) {
        const int NT = build_tiles(F, cnt);
        { g8::ExpertSched<1, true> S; S.tpref = (const LAS int*)(F.lds + LDS_TAB); S.cnt = (const LAS int*)(F.lds + LDS_TAB + 512); S.A = (const char*)x1b; S.B = (const char*)((const bf16*)(ws + WS_W_EX_GU) + (size_t)L * 64 * 256 * D);
          S.tok = ltok; S.b_exp = (size_t)256 * D * 2; S.b_tile = 0; S.a_tile = 0; S.NU = NT; S.G = F.G; S.c = c;
          g8::EpiExpertGU E{HB}; g8::gemm_phase<g8::EpiExpertGU, g8::ExpertSched<1, true>, true>(ring, F.tid, D, D, D, S, E); }
        { const int rot = (c - (NT % F.G) + F.G) % F.G;
          g8::DenseSched S; S.init(x1b, (const bf16*)(ws + WS_W_SH_GU) + (size_t)L * 512 * D, T, 512, D, D, F.G, rot);
          int t2 = F.tid; asm volatile("" : "+v"(t2));
          g8::EpiSharedGU E{HS}; g8::gemm_phase<g8::EpiSharedGU, g8::DenseSched, false>(ring, t2, D, D, D, S, E); } }
    if constexpr (PH == PH_MOE3) {
        const float* g1 = ain(kp, IN_LNG) + (size_t)(L * 2 + 0) * D; const float* b1 = ain(kp, IN_LNB) + (size_t)(L * 2 + 0) * D;
        const int NT = build_tiles(F, cnt);
        __syncthreads();
        phase_downproj3(F, HB, (const bf16*)(ws + WS_W_EX_D) + (size_t)L * 64 * D * EDIM, HS, (const bf16*)(ws + WS_W_SH_D) + (size_t)L * D * SDIM, (unsigned char*)Yr, (float*)(ws + WS_BIG + BG_YSC), NT + 2 * (T / 256));
        (void)g1; (void)b1; }
    if constexpr (PH == PH_MOE4) { (void)build_tiles(F, cnt);
        const float* g2 = ain(kp, IN_LNG) + (size_t)(L * 2 + 1) * D; const float* b2 = ain(kp, IN_LNB) + (size_t)(L * 2 + 1) * D;
        phase_moe4q(F, x1b, (bf16*)(ws + WS_Y2F), (const unsigned char*)Yr, (const float*)(ws + WS_BIG + BG_YSC), eidx, inv, g2, b2, (float*)(ws + WS_ST2), (bf16*)(ws + WS_XB), aout(kp), L == DEPTH - 1); }
}
__device__ __forceinline__ void make_frame(Frame& F, const Args& args) {
    extern __shared__ __attribute__((aligned(16))) unsigned char lds_raw[];
    F.lds = (LAS unsigned char*)lds_raw; F.ws = args.ws; F.ctl = (unsigned*)(args.ws + WS_CTL);
    F.tid = threadIdx.x; F.lane = F.tid & 63; F.wave = __builtin_amdgcn_readfirstlane(F.tid >> 6); F.G = gridDim.x; F.bid = blockIdx.x;
}
template <int PH> __global__ void __launch_bounds__(512, 2) k_phase(Args args, int L) {
    Frame F; make_frame(F, args);
    run_phase<PH>(F, args, L);
}

#ifndef MK_NOINLINE
#define MK_NOINLINE 0
#endif
#if MK_NOINLINE
template <int PH> __device__ __noinline__ void call_phase_ni(const int L) {
    Args dummy{}; Frame F;
    KP kp = (KP)__builtin_amdgcn_kernarg_segment_ptr();
    extern __shared__ __attribute__((aligned(16))) unsigned char lds_raw[];
    F.lds = (LAS unsigned char*)lds_raw; F.ws = (unsigned char*)((GAS unsigned char* const CAS*)kp)[20]; F.ctl = (unsigned*)(F.ws + WS_CTL);
    F.tid = threadIdx.x; F.lane = F.tid & 63; F.wave = __builtin_amdgcn_readfirstlane(F.tid >> 6); F.G = gridDim.x; F.bid = blockIdx.x;
    run_phase<PH>(F, dummy, L);
}
template <int PH> __device__ __forceinline__ void call_phase(const Frame& F, const Args& args, const int L) { call_phase_ni<PH>(L); }
#else
template <int PH> __device__ __forceinline__ void call_phase(const Frame& F, const Args& args, const int L) { asm volatile("; PHASE_BEGIN %0" :: "n"(PH)); run_phase<PH>(F, args, L); asm volatile("; PHASE_END %0" :: "n"(PH)); }
#endif
__global__ void __launch_bounds__(512, 2) fwd_all(Args args) {
    Frame F; make_frame(F, args);
    volatile LAS unsigned* misc = (volatile LAS unsigned*)(F.lds + LDS_MISC);
    if (F.tid < 4) misc[F.tid] = 0u;
    __syncthreads();
    const int lo = args.ph_lo, hi = args.ph_hi;
    XcdBarrier bar; bar.bar = F.ctl + CW_BAR; bar.x = 0; bar.st = misc;
    if (hi - lo > 1) bar = xcd_barrier_post(F.ctl + CW_BAR, misc);
    int pc = 0;
#ifndef MK_DUP_MASK
#define MK_DUP_MASK 0
#endif
#define STEP(PH, Lx) do { if (pc >= lo && pc < hi) { if ((MK_DUP_MASK >> (PH)) & 1) { call_phase<PH>(F, args, Lx); xcd_barrier(bar); } call_phase<PH>(F, args, Lx); if (pc + 1 < hi) xcd_barrier(bar); } ++pc; } while (0)
    STEP(PH_PRO, 0);
#pragma unroll 1
    for (int L = 0; L < DEPTH; ++L) {
        const int kind = L % 3;
        if (kind == 0) { STEP(PH_POOL_G1, L); STEP(PH_POOL_P, L); STEP(PH_POOL_G2, L); STEP(PH_POOL_G3, L); }
        else if (kind == 1) { STEP(PH_DIL_G1, L); STEP(PH_DIL_ATT, L); STEP(PH_DIL_CMB, L); STEP(PH_DIL_G2, L); }
        else { STEP(PH_CONV_G1, L); STEP(PH_CONV_E, L); STEP(PH_CONV_G2, L); }
        STEP(PH_MOE1, L); STEP(PH_MOE2, L); STEP(PH_MOE3, L); STEP(PH_MOE4, L);
    }
#undef STEP
}
constexpr int N_STEPS = 1 + 2 * 8 + 8 + 7;

template <int PH> static void launch_phase(const Args& a, int L, int grid, hipStream_t stream) {
    static bool attr = false;
    if (!attr) { (void)hipFuncSetAttribute((const void*)k_phase<PH>, hipFuncAttributeMaxDynamicSharedMemorySize, LDS_BYTES); attr = true; }
    hipLaunchKernelGGL(k_phase<PH>, dim3(grid), dim3(512), LDS_BYTES, stream, a, L);
}
extern "C" void kernel_launch(void* const* d_in, const int* in_sizes, int n_in, void* d_out, int out_size, void* d_ws, size_t ws_size, hipStream_t stream) {
    static int grid = 0;
    if (grid == 0) {
        if (n_in != 19 || out_size != T * D || ws_size < WS_END) { fprintf(stderr, "kernel_launch: unexpected shapes (n_in %d out %d ws %zu need %zu)\n", n_in, out_size, ws_size, (size_t)WS_END); grid = -1; return; }
        int dev = 0, cus = 0;
        if (hipGetDevice(&dev) != hipSuccess || hipDeviceGetAttribute(&cus, hipDeviceAttributeMultiprocessorCount, dev) != hipSuccess) { grid = -1; return; }
#if MK_ONE_LAUNCH
        if (hipFuncSetAttribute((const void*)fwd_all, hipFuncAttributeMaxDynamicSharedMemorySize, LDS_BYTES) != hipSuccess) { fprintf(stderr, "kernel_launch: hipFuncSetAttribute failed\n"); grid = -1; return; }
        int per_cu = 0;
        if (hipOccupancyMaxActiveBlocksPerMultiprocessor(&per_cu, (const void*)fwd_all, 512, LDS_BYTES) != hipSuccess || per_cu < 1) { fprintf(stderr, "kernel_launch: note: occupancy query reports %d blocks per CU\n", per_cu); (void)hipGetLastError(); }
#endif
        grid = cus;
    }
    if (grid < 0) return;
    (void)hipMemsetAsync((char*)d_ws + WS_CTL, 0, CTL_ZERO_BYTES, stream);
    Args a{};
    for (int i = 0; i < 19; ++i) a.in[i] = (const float*)d_in[i];
    a.out = (float*)d_out; a.ws = (unsigned char*)d_ws; a.ph_lo = 0; a.ph_hi = 0;
#if MK_ONE_LAUNCH
#ifdef MK_SPLIT
    for (int p = 0; p < N_STEPS; ++p) { a.ph_lo = p; a.ph_hi = p + 1; hipLaunchKernelGGL(fwd_all, dim3(grid), dim3(512), LDS_BYTES, stream, a); }
#else
    a.ph_lo = 0; a.ph_hi = N_STEPS;
    hipLaunchKernelGGL(fwd_all, dim3(grid), dim3(512), LDS_BYTES, stream, a);
#endif
#elif defined(MK_HYBRID_MASK)
    {
        static bool attr2 = false; if (!attr2) { (void)hipFuncSetAttribute((const void*)fwd_all, hipFuncAttributeMaxDynamicSharedMemorySize, LDS_BYTES); attr2 = true; }
        int pc = 0;
#define HSTEP(PH, Lx) do { if ((MK_HYBRID_MASK >> (PH)) & 1) { a.ph_lo = pc; a.ph_hi = pc + 1; hipLaunchKernelGGL(fwd_all, dim3(grid), dim3(512), LDS_BYTES, stream, a); } else { a.ph_lo = 0; a.ph_hi = 0; launch_phase<PH>(a, Lx, grid, stream); } ++pc; } while (0)
        HSTEP(PH_PRO, 0);
        for (int L = 0; L < DEPTH; ++L) {
            const int kind = L % 3;
            if (kind == 0) { HSTEP(PH_POOL_G1, L); HSTEP(PH_POOL_P, L); HSTEP(PH_POOL_G2, L); HSTEP(PH_POOL_G3, L); }
            else if (kind == 1) { HSTEP(PH_DIL_G1, L); HSTEP(PH_DIL_ATT, L); HSTEP(PH_DIL_CMB, L); HSTEP(PH_DIL_G2, L); }
            else { HSTEP(PH_CONV_G1, L); HSTEP(PH_CONV_E, L); HSTEP(PH_CONV_G2, L); }
            HSTEP(PH_MOE1, L); HSTEP(PH_MOE2, L); HSTEP(PH_MOE3, L); HSTEP(PH_MOE4, L);
        }
#undef HSTEP
    }
#else
    launch_phase<PH_PRO>(a, 0, grid, stream);
    for (int L = 0; L < DEPTH; ++L) {
        const int kind = L % 3;
        if (kind == 0) { launch_phase<PH_POOL_G1>(a, L, grid, stream); launch_phase<PH_POOL_P>(a, L, grid, stream); launch_phase<PH_POOL_G2>(a, L, grid, stream); launch_phase<PH_POOL_G3>(a, L, grid, stream); }
        else if (kind == 1) { launch_phase<PH_DIL_G1>(a, L, grid, stream); launch_phase<PH_DIL_ATT>(a, L, grid, stream); launch_phase<PH_DIL_CMB>(a, L, grid, stream); launch_phase<PH_DIL_G2>(a, L, grid, stream); }
        else { launch_phase<PH_CONV_G1>(a, L, grid, stream); launch_phase<PH_CONV_E>(a, L, grid, stream); launch_phase<PH_CONV_G2>(a, L, grid, stream); }
        launch_phase<PH_MOE1>(a, L, grid, stream); launch_phase<PH_MOE2>(a, L, grid, stream); launch_phase<PH_MOE3>(a, L, grid, stream); launch_phase<PH_MOE4>(a, L, grid, stream);
    }
#endif
}
```

```cpp
#include <hip/hip_runtime.h>
#include <cstdio>
#include <cstdint>

#ifndef MK_ONE_LAUNCH
#define MK_ONE_LAUNCH 1
#endif

#define GAS __attribute__((address_space(1)))
#define LAS __attribute__((address_space(3)))
typedef unsigned short bf16;
typedef unsigned v4u __attribute__((ext_vector_type(4)));
typedef unsigned v2u __attribute__((ext_vector_type(2)));
typedef float f32x4 __attribute__((ext_vector_type(4)));
typedef float f32x2 __attribute__((ext_vector_type(2)));
typedef short bf16x8 __attribute__((ext_vector_type(8)));
typedef short s16x4 __attribute__((ext_vector_type(4)));

constexpr int NBATCH = 8, SEQ = 2048, D = 2048, T = NBATCH * SEQ, DEPTH = 4;
constexpr int NEXP = 64, TOPK = 8, EDIM = 128, SDIM = 256;
constexpr int QKVC = 4608, DILW = 512;
constexpr float ALPHA = 1.681792830507429f;
constexpr float LN_EPS = 1e-5f;
constexpr int CAP = 16384;
constexpr int HROWS = T * TOPK + NEXP * 256;

constexpr size_t MiB = 1u << 20;
constexpr size_t WS_CTL = 0, CTL_ZERO_BYTES = 1 * MiB;
constexpr size_t WS_W_POOL_IN = 1 * MiB;
constexpr size_t WS_W_POOL_G = WS_W_POOL_IN + 16 * MiB;
constexpr size_t WS_W_POOL_OUT = WS_W_POOL_G + 4 * MiB;
constexpr size_t WS_W_DIL_QKV = WS_W_POOL_OUT + 16 * MiB;
constexpr size_t WS_W_DIL_OUT = WS_W_DIL_QKV + 18 * MiB;
constexpr size_t WS_W_CONV_IN = WS_W_DIL_OUT + 2 * MiB;
constexpr size_t WS_W_CONV_OUT = WS_W_CONV_IN + 24 * MiB;
constexpr size_t WS_W_SH_GU = WS_W_CONV_OUT + 8 * MiB;
constexpr size_t WS_W_SH_D = WS_W_SH_GU + 8 * MiB;
constexpr size_t WS_W_EX_GU = WS_W_SH_D + 4 * MiB;
constexpr size_t WS_W_EX_D = WS_W_EX_GU + 256 * MiB;
constexpr size_t WS_XF = WS_W_EX_D + 256 * MiB;
constexpr size_t WS_YF = WS_XF + 128 * MiB;
constexpr size_t WS_X1F = WS_YF + 128 * MiB;
constexpr size_t WS_XB = WS_X1F + 128 * MiB;
constexpr size_t WS_X1B = WS_XB + 64 * MiB;
constexpr size_t WS_HB = WS_X1B + 64 * MiB;
constexpr size_t WS_HS = WS_HB + 72 * MiB;
constexpr size_t WS_LTOK = WS_HS + 8 * MiB;
constexpr size_t WS_LGATE = WS_LTOK + 4 * MiB;
constexpr size_t WS_EIDX = WS_LGATE + 4 * MiB;
constexpr size_t WS_INV = WS_EIDX + 1 * MiB;
constexpr size_t WS_BIG = WS_INV + 1 * MiB;
constexpr size_t WS_PST = WS_BIG + 608 * MiB;
constexpr size_t WS_ST1 = WS_PST + 4 * MiB;
constexpr size_t WS_ST2 = WS_ST1 + 1 * MiB;
constexpr size_t WS_RWH = WS_ST2 + 1 * MiB;
constexpr size_t WS_RWL = WS_RWH + 1 * MiB;
constexpr size_t WS_PST2 = WS_RWL + 1 * MiB;
constexpr size_t WS_END = WS_PST2 + 8 * MiB;
constexpr size_t WS_Y2F = WS_X1F;
constexpr size_t BG_U = 0, BG_PL = 64 * MiB, BG_MX = 128 * MiB;
constexpr size_t BG_QKV = 0, BG_OG = 144 * MiB, BG_LSE = 192 * MiB, BG_O = 194 * MiB;
constexpr size_t BG_UC = 0, BG_BG = 64 * MiB, BG_Z = 128 * MiB;
constexpr size_t BG_YSC = 400 * MiB;
constexpr int CW_BAR = 4096;
constexpr int CW_CNT = 16384;

constexpr int RING_BYTES = 131072;
constexpr int LDS_TAB = RING_BYTES;
constexpr int LDS_STASH = RING_BYTES + 1024;
constexpr int LDS_BYTES = 163840;
constexpr int LDS_MISC = LDS_BYTES - 1024;

typedef __bf16 bf16x2_t __attribute__((ext_vector_type(2)));
typedef float f32x2_t __attribute__((ext_vector_type(2)));
__device__ __forceinline__ unsigned cvt_pk_bf16(float lo, float hi) { const bf16x2_t r = __builtin_convertvector((f32x2_t){lo, hi}, bf16x2_t); return __builtin_bit_cast(unsigned, r); }
__device__ __forceinline__ unsigned f2bf(float f) { unsigned u = __builtin_bit_cast(unsigned, f); return (u + 0x7fffu + ((u >> 16) & 1u)) >> 16; }
__device__ __forceinline__ unsigned pk2(float lo, float hi) { return f2bf(lo) | (f2bf(hi) << 16); }
__device__ __forceinline__ float bflo(unsigned w) { return __builtin_bit_cast(float, w << 16); }
__device__ __forceinline__ float bfhi(unsigned w) { return __builtin_bit_cast(float, w & 0xffff0000u); }
__device__ __forceinline__ float shfl_from(float v, int src) { return __builtin_bit_cast(float, __builtin_amdgcn_ds_bpermute(src << 2, __builtin_bit_cast(int, v))); }
__device__ __forceinline__ float shfl_x(float v, int o, int lane) { return shfl_from(v, lane ^ o); }
__device__ __forceinline__ float wave_sum(float v, int lane) {
#pragma unroll
    for (int o = 1; o < 64; o <<= 1) v += shfl_x(v, o, lane);
    return v;
}
#define LDS_WAIT() asm volatile("s_waitcnt lgkmcnt(0)" ::: "memory")
#define VM_WAIT() asm volatile("s_waitcnt vmcnt(0)" ::: "memory")

#define XB_TMO      128
#define XB_XCNT(j)  (256  + 64 * (j))
#define XB_XSUB(j)  (1280 + 64 * (j))
#define XB_XGEN(j)  (2304 + 64 * (j))
#define XB_TOP      3328
#define XB_TOPGEN   3392
#define XCD_BAR_WORDS 3456
#define XB_SPIN_CAP (1u << 18)

__device__ __forceinline__ unsigned xb_ld(unsigned* p)              { return __hip_atomic_load(p, __ATOMIC_RELAXED, __HIP_MEMORY_SCOPE_AGENT); }
__device__ __forceinline__ unsigned xb_add(unsigned* p, unsigned v) { return __hip_atomic_fetch_add(p, v, __ATOMIC_RELAXED, __HIP_MEMORY_SCOPE_AGENT); }
__device__ __forceinline__ unsigned xb_xcc_id() { return (unsigned)__builtin_amdgcn_s_getreg((3 << 11) | 20) & 0xFu; }
#define XB_SPIN(cond, bar) do { unsigned _sp = 0; while (cond) { __builtin_amdgcn_s_sleep(1); \
    if ((++_sp & 255u) == 0u) { if (xb_ld(&(bar)[XB_TMO])) break; if (_sp > XB_SPIN_CAP) { atomicAdd(&(bar)[XB_TMO], 1u); break; } } } } while (0)

struct XcdBarrier {
    unsigned* bar; unsigned x;
    volatile LAS unsigned* st;
};

__device__ __forceinline__ XcdBarrier xcd_barrier_post(unsigned* bar, volatile LAS unsigned* st) {
    XcdBarrier b; b.bar = bar; b.x = xb_xcc_id(); b.st = st;
    if (threadIdx.x == 0) (void)xb_add(&bar[XB_XCNT(b.x)], 1u);
    return b;
}
__device__ __forceinline__ void xcd_barrier_complete(unsigned* bar, unsigned x, unsigned& nloc, unsigned& nx) {
    const unsigned G = gridDim.x * gridDim.y * gridDim.z;
    unsigned sum, cnt, mine, sp = 0u;
    for (;;) {
        sum = 0u; cnt = 0u; mine = 0u;
#pragma unroll
        for (unsigned j = 0; j < 16; ++j) { const unsigned c = xb_ld(&bar[XB_XCNT(j)]); sum += c; cnt += (c > 0u) ? 1u : 0u; mine = (j == x) ? c : mine; }
        if (sum == G) break;
        __builtin_amdgcn_s_sleep(1);
        if ((++sp & 255u) == 0u) { if (xb_ld(&bar[XB_TMO])) break; if (sp > XB_SPIN_CAP) { atomicAdd(&bar[XB_TMO], 1u); break; } }
    }
    nloc = mine > 0u ? mine : 1u; nx = cnt > 0u ? cnt : 1u;
}

__device__ __forceinline__ void xcd_barrier(const XcdBarrier& b) {
    asm volatile("s_waitcnt vmcnt(0)" ::: "memory");
    __syncthreads();
    if (threadIdx.x == 0) {
        unsigned* bar; unsigned bx = b.x; { GAS unsigned* bg = (GAS unsigned*)b.bar; asm volatile("" : "+s"(bg), "+s"(bx)); bar = (unsigned*)bg; }
        __builtin_amdgcn_s_waitcnt(0);
        unsigned nloc = b.st[0], nx = b.st[1];
        if (nloc == 0u) { xcd_barrier_complete(bar, bx, nloc, nx); b.st[0] = nloc; b.st[1] = nx; }
        const unsigned old = xb_add(&bar[XB_XSUB(bx)], 1u);
        const unsigned gen = old / nloc;
        if (old + 1u == (gen + 1u) * nloc) {
            __builtin_amdgcn_fence(__ATOMIC_RELEASE, "agent");
            asm volatile("s_waitcnt vmcnt(0)" ::: "memory");
            const unsigned og = xb_add(&bar[XB_TOP], 1u);
            const unsigned tg = og / nx;
            if (og + 1u == (tg + 1u) * nx) xb_add(&bar[XB_TOPGEN], 1u);
            else XB_SPIN(xb_ld(&bar[XB_TOPGEN]) == tg, bar);
            __builtin_amdgcn_fence(__ATOMIC_ACQUIRE, "agent");
            xb_add(&bar[XB_XGEN(bx)], 1u);
            asm volatile("s_waitcnt vmcnt(0)" ::: "memory");
        } else {
            XB_SPIN(xb_ld(&bar[XB_XGEN(bx)]) == gen, bar);
            __builtin_amdgcn_fence(__ATOMIC_ACQUIRE, "agent");
            asm volatile("s_waitcnt vmcnt(0)" ::: "memory");
        }
    }
    __syncthreads();
}

namespace g8 {
constexpr int BM = 256, BK = 64, HALF = 128, HTB = HALF * BK * 2, STAGE_BYTES = 8 * HTB, NXCD = 8, WGM = 8;
__host__ __device__ __forceinline__ int lds_byte(int r, int c) { const int st = (r >> 4) * 2 + (c >> 5), rr = r & 15, cc = c & 31, ob = rr * 64 + cc * 2; return st * 1024 + (ob ^ (((ob >> 9) & 1) << 5)); }
__host__ __device__ __forceinline__ void stage_rc(int b, int& R, int& C) { const int st = b / 1024, sb = b % 1024, swz = sb ^ (((sb >> 9) & 1) << 5); R = (st >> 1) * 16 + swz / 64; C = (st & 1) * 32 + (swz % 64) / 2; }
__host__ __device__ __forceinline__ int perm32(int rho) { const int n = rho >> 4, i = rho & 15; return 8 * (i >> 2) + 4 * n + (i & 3); }

struct Unit { const char* A; const char* B; const int* rows; int pm, pn, nvalid, aux; };

template <class Epi, class Sched, bool GATHER>
__device__ __forceinline__ void gemm_phase(LAS unsigned char* lds, const int tid_in, const int K, const int lda, const int ldb, const Sched& S, const Epi& E) {
    const int tid = tid_in, wid = __builtin_amdgcn_readfirstlane(tid >> 6), lane = tid & 63, wr = wid >> 2, wc = wid & 3, fr = lane & 15, fq = lane >> 4;
    const int nt = K / BK;
    unsigned voffB[2];
#pragma unroll
    for (int i = 0; i < 2; ++i) { int R_, C_; stage_rc(tid * 16 + i * 8192, R_, C_); const int Rb = Epi::PERM ? ((R_ & ~31) + perm32(R_ & 31)) : R_; voffB[i] = (unsigned)(Rb * ldb + C_) * 2u; }
    LAS v4u* stash = (LAS v4u*)(lds + (LDS_STASH - 0) + tid * 16);
    const size_t kstep = (size_t)(BK * 2);
    const size_t hstepB = (size_t)HALF * ldb * 2;
    const unsigned ldsw = (unsigned)wid * 1024u;
    const int aoff = lds_byte(wr * 64 + fr, fq * 8), boff = lds_byte(wc * 32 + fr, fq * 8);
#define G8_SA(b, h) (((b) * 2 + (h)) * HTB)
#define G8_SB(b, h) ((4 + (b) * 2 + (h)) * HTB)
#define G8_STAGE2(bufoff, gbase, v0, v1) do { \
        __builtin_amdgcn_global_load_lds((const unsigned*)((const char*)(gbase) + (v0)), (LAS unsigned*)(lds + (bufoff) + ldsw), 16, 0, 0); \
        __builtin_amdgcn_global_load_lds((const unsigned*)((const char*)(gbase) + (v1)), (LAS unsigned*)(lds + (bufoff) + ldsw + 8192), 16, 0, 0); } while (0)
#define G8_STAGEB(bufoff, gbase) G8_STAGE2(bufoff, gbase, voffB[0], voffB[1])
#define G8_LDA(dst, b, h) do { _Pragma("unroll") for (int m = 0; m < 4; ++m) _Pragma("unroll") for (int k = 0; k < 2; ++k) dst[m][k] = *(const LAS bf16x8*)(lds + G8_SA(b, h) + aoff + m * 2048 + k * 1024); } while (0)
#define G8_LDB(dst, b, h) do { _Pragma("unroll") for (int n = 0; n < 2; ++n) _Pragma("unroll") for (int k = 0; k < 2; ++k) dst[n][k] = *(const LAS bf16x8*)(lds + G8_SB(b, h) + boff + n * 2048 + k * 1024); } while (0)
#define G8_MMA(ai, bj, At, Bt) do { __builtin_amdgcn_s_setprio(1); _Pragma("unroll") for (int m = 0; m < 4; ++m) _Pragma("unroll") for (int n = 0; n < 2; ++n) _Pragma("unroll") for (int k = 0; k < 2; ++k) \
        acc[ai][bj][m][n] = __builtin_amdgcn_mfma_f32_16x16x32_bf16(Bt[n][k], At[m][k], acc[ai][bj][m][n], 0, 0, 0); __builtin_amdgcn_s_setprio(0); } while (0)
#define G8_WAIT_V(n) asm volatile("s_waitcnt vmcnt(" #n ")" ::: "memory")
#define G8_WAIT_L(n) asm volatile("s_waitcnt lgkmcnt(" #n ")" ::: "memory")
#define G8_BAR __builtin_amdgcn_s_barrier()
#define G8_SCHED __builtin_amdgcn_sched_barrier(0)
#define G8_SETVA(dst, u) do { int _t2 = tid; if (GATHER) asm volatile("" : "+v"(_t2)); _Pragma("unroll") for (int _h = 0; _h < 2; ++_h) _Pragma("unroll") for (int _i = 0; _i < 2; ++_i) { \
        int _R, _C; stage_rc(_t2 * 16 + _i * 8192, _R, _C); \
        const unsigned _rl = (unsigned)(_h * HALF + _R); unsigned _row = _rl; \
        if (GATHER) { _row = 0u; if (_rl < (unsigned)(u).nvalid) _row = (unsigned)(u).rows[_rl] >> 3; } \
        dst[_h][_i] = (_row * (unsigned)lda + (unsigned)_C) * 2u; } } while (0)
    Unit cur, nxt; int ui = 0;
    if (!S.next(0, cur)) return;
    f32x4 acc[2][2][4][2];
#pragma unroll
    for (int a = 0; a < 2; ++a)
#pragma unroll
        for (int b = 0; b < 2; ++b)
#pragma unroll
            for (int m = 0; m < 4; ++m)
#pragma unroll
                for (int n = 0; n < 2; ++n) acc[a][b][m][n] = (f32x4){0.f, 0.f, 0.f, 0.f};
    bf16x8 At[4][2], B0[2][2], B1[2][2];
    unsigned vAc[2][2]; unsigned xl00 = 0, xl01 = 0, xl10 = 0, xl11 = 0;
    G8_SETVA(vAc, cur);
    const char* cA = cur.A; const char* cB = cur.B;
    G8_STAGEB(G8_SB(0, 0), cB); G8_STAGEB(G8_SB(0, 1), cB + hstepB); G8_STAGE2(G8_SA(0, 0), cA, vAc[0][0], vAc[0][1]); G8_STAGE2(G8_SA(0, 1), cA, vAc[1][0], vAc[1][1]);
    if (wr == 1) G8_BAR;
    G8_WAIT_V(2); G8_BAR;
    G8_STAGEB(G8_SB(1, 0), cB + kstep); G8_STAGE2(G8_SA(1, 0), cA + kstep, vAc[0][0], vAc[0][1]); G8_STAGEB(G8_SB(1, 1), cB + hstepB + kstep);
    G8_WAIT_V(6); G8_BAR;
    for (;;) {
        const bool has_next = S.next(ui + 1, nxt);
        const char* nA = has_next ? nxt.A : cA; const char* nB = has_next ? nxt.B : cB;
        if (GATHER) { unsigned vAn[2][2]; if (has_next) { G8_SETVA(vAn, nxt); } else {
#pragma unroll
            for (int h = 0; h < 2; ++h)
#pragma unroll
                for (int i = 0; i < 2; ++i) vAn[h][i] = vAc[h][i]; }
            *stash = (v4u){vAn[0][0], vAn[0][1], vAn[1][0], vAn[1][1]}; }
#pragma unroll 1
        for (int t = 0; t < nt; t += 2) {
            const bool last = (t == nt - 2);
            const char* a1 = cA + (size_t)(t + 1) * kstep;
            const char* a2 = last ? nA : cA + (size_t)(t + 2) * kstep; const char* b2 = last ? nB : cB + (size_t)(t + 2) * kstep;
            const char* a3 = a2 + kstep; const char* b3 = b2 + kstep;
            unsigned x00 = vAc[0][0], x01 = vAc[0][1], x10 = vAc[1][0], x11 = vAc[1][1];
            if (GATHER) { if (last) { const v4u sv = *stash; x00 = sv.x; x01 = sv.y; x10 = sv.z; x11 = sv.w; } xl00 = x00; xl01 = x01; xl10 = x10; xl11 = x11; }
            G8_LDB(B0, 0, 0); G8_LDB(B1, 0, 1); G8_SCHED; G8_LDA(At, 0, 0); G8_STAGE2(G8_SA(1, 1), a1, vAc[1][0], vAc[1][1]);
            G8_WAIT_V(8); G8_WAIT_L(0); G8_BAR; G8_MMA(0, 0, At, B0); G8_MMA(0, 1, At, B1); G8_BAR; G8_SCHED;
            G8_LDA(At, 0, 1); G8_STAGEB(G8_SB(0, 0), b2); G8_STAGEB(G8_SB(0, 1), b2 + hstepB); G8_STAGE2(G8_SA(0, 0), a2, x00, x01);
            G8_WAIT_V(8); G8_WAIT_L(0); G8_BAR; G8_MMA(1, 0, At, B0); G8_MMA(1, 1, At, B1); G8_BAR; G8_SCHED;
            G8_LDB(B0, 1, 0); G8_LDB(B1, 1, 1); G8_SCHED; G8_LDA(At, 1, 0); G8_STAGE2(G8_SA(0, 1), a2, x10, x11);
            G8_WAIT_V(8); G8_WAIT_L(0); G8_BAR; G8_MMA(0, 0, At, B0); G8_MMA(0, 1, At, B1); G8_BAR; G8_SCHED;
            G8_LDA(At, 1, 1); G8_STAGEB(G8_SB(1, 0), b3); G8_STAGEB(G8_SB(1, 1), b3 + hstepB); G8_STAGE2(G8_SA(1, 0), a3, x00, x01);
            G8_WAIT_V(8); G8_WAIT_L(0); G8_BAR; G8_MMA(1, 0, At, B0); G8_MMA(1, 1, At, B1); G8_BAR; G8_SCHED;
        }
        if (wr == 0) G8_BAR;
        E(acc, cur, wr, wc, fr, fq);
        if (!has_next) break;
#pragma unroll
        for (int a = 0; a < 2; ++a)
#pragma unroll
            for (int b = 0; b < 2; ++b)
#pragma unroll
                for (int m = 0; m < 4; ++m)
#pragma unroll
                    for (int n = 0; n < 2; ++n) acc[a][b][m][n] = (f32x4){0.f, 0.f, 0.f, 0.f};
        cur = nxt; cA = nA; cB = nB; ++ui;
        if (GATHER) { vAc[0][0] = xl00; vAc[0][1] = xl01; vAc[1][0] = xl10; vAc[1][1] = xl11; }
        if (wr == 1) G8_BAR;
    }
    G8_WAIT_V(0);
    G8_BAR;
#undef G8_SA
#undef G8_SB
#undef G8_STAGE2
#undef G8_STAGEB
#undef G8_LDA
#undef G8_LDB
#undef G8_MMA
#undef G8_WAIT_V
#undef G8_WAIT_L
#undef G8_BAR
#undef G8_SCHED
#undef G8_SETVA
}

struct DenseSched {
    const char* A; const char* B; size_t a_tile, b_tile, agrp_stride; int agrp_shift, nM, nN, nwg, G, c;
    __device__ __forceinline__ void init(const void* A_, const void* B_, int M, int N, int lda, int ldb, int G_, int c_) {
        A = (const char*)A_; B = (const char*)B_; a_tile = (size_t)BM * lda * 2; b_tile = (size_t)BM * ldb * 2; agrp_stride = 0; agrp_shift = 0; nM = M / BM; nN = N / BM; nwg = nM * nN; G = G_; c = c_; }
    __device__ __forceinline__ bool next(int i, Unit& u) const {
        const long L = (long)i * G + c; if (L >= nwg) return false;
        int wgid = (int)L; { const int q = nwg / NXCD, r = nwg % NXCD, xcd = wgid % NXCD, off = wgid / NXCD; wgid = (xcd < r ? xcd * (q + 1) : r * (q + 1) + (xcd - r) * q) + off; }
        const int nig = WGM * nN, gid = wgid / nig, fm = gid * WGM, gsz = (nM - fm) < WGM ? (nM - fm) : WGM;
        u.pm = fm + ((wgid % nig) % gsz); u.pn = (wgid % nig) / gsz;
        u.A = A + (size_t)u.pm * a_tile + (size_t)(u.pn >> agrp_shift) * agrp_stride; u.B = B + (size_t)u.pn * b_tile; u.rows = nullptr; u.nvalid = BM; u.aux = 0; return true;
    }
};
template <int NPN, bool GATHERED>
struct ExpertSched {
    const LAS int* tpref; const LAS int* cnt; const char* A; const char* B; const int* tok; size_t b_exp, b_tile, a_tile; int NU, G, c;
    __device__ __forceinline__ bool next(int i, Unit& u) const {
        const int L = i * G + c; if (L >= NU) return false;
        const int tile = L / NPN, pn = L % NPN;
        int e = 0; while (__builtin_amdgcn_readfirstlane(tpref[e + 1]) <= tile) ++e;
        const int rb = tile - __builtin_amdgcn_readfirstlane(tpref[e]);
        u.pm = e; u.pn = pn; u.aux = tile * BM; u.nvalid = __builtin_amdgcn_readfirstlane(cnt[e]) - rb * BM; if (u.nvalid > BM) u.nvalid = BM;
        u.rows = tok + (size_t)e * CAP + rb * BM;
        u.A = GATHERED ? A : A + (size_t)tile * a_tile; u.B = B + (size_t)e * b_exp + (size_t)pn * b_tile; return true;
    }
};

struct EpiBf16 {
    static constexpr bool PERM = true;
    bf16* O; int ldc; int qscale;
    __device__ __forceinline__ void operator()(const f32x4 (&acc)[2][2][4][2], const Unit& u, int wr, int wc, int fr, int fq) const {
        asm volatile("" : "+v"(fr), "+v"(fq));
        const int row0 = u.pm * BM + wr * 64 + fr, col0 = u.pn * BM + wc * 32 + 8 * fq;
        const float sc = (qscale && (u.pn % 6) < 2) ? 0.125f : 1.0f;
#pragma unroll
        for (int ai = 0; ai < 2; ++ai)
#pragma unroll
            for (int m = 0; m < 4; ++m) { bf16* rowp = O + (size_t)(row0 + ai * HALF + m * 16) * ldc + col0;
#pragma unroll
                for (int bj = 0; bj < 2; ++bj) { const f32x4 v0 = acc[ai][bj][m][0] * sc, v1 = acc[ai][bj][m][1] * sc;
                    v4u w; w.x = cvt_pk_bf16(v0[0], v0[1]); w.y = cvt_pk_bf16(v0[2], v0[3]); w.z = cvt_pk_bf16(v1[0], v1[1]); w.w = cvt_pk_bf16(v1[2], v1[3]);
                    *(v4u*)(rowp + bj * HALF) = w; } }
    }
};
struct EpiScaleBf16 {
    static constexpr bool PERM = true;
    bf16* O; int ldc; const float* scale;
    __device__ __forceinline__ void operator()(const f32x4 (&acc)[2][2][4][2], const Unit& u, int wr, int wc, int fr, int fq) const {
        asm volatile("" : "+v"(fr), "+v"(fq));
        const int row0 = u.pm * BM + wr * 64 + fr, col0 = u.pn * BM + wc * 32 + 8 * fq;
        f32x4 sv[2][2];
#pragma unroll
        for (int bj = 0; bj < 2; ++bj)
#pragma unroll
            for (int n = 0; n < 2; ++n) sv[bj][n] = *(const f32x4*)(scale + col0 + bj * HALF + 4 * n);
#pragma unroll
        for (int ai = 0; ai < 2; ++ai)
#pragma unroll
            for (int m = 0; m < 4; ++m) { bf16* rowp = O + (size_t)(row0 + ai * HALF + m * 16) * ldc + col0;
#pragma unroll
                for (int bj = 0; bj < 2; ++bj) { const f32x4 v0 = acc[ai][bj][m][0] * sv[bj][0], v1 = acc[ai][bj][m][1] * sv[bj][1];
                    v4u w; w.x = cvt_pk_bf16(v0[0], v0[1]); w.y = cvt_pk_bf16(v0[2], v0[3]); w.z = cvt_pk_bf16(v1[0], v1[1]); w.w = cvt_pk_bf16(v1[2], v1[3]);
                    *(v4u*)(rowp + bj * HALF) = w; } }
    }
};
struct EpiResid {
    static constexpr bool PERM = false;
    const float* X; float* Y;
    __device__ __forceinline__ void operator()(const f32x4 (&acc)[2][2][4][2], const Unit& u, int wr, int wc, int fr, int fq) const {
        asm volatile("" : "+v"(fr), "+v"(fq));
        const int row0 = u.pm * BM + wr * 64 + fr, col0 = u.pn * BM + wc * 32 + 4 * fq;
#pragma unroll
        for (int ai = 0; ai < 2; ++ai)
#pragma unroll
            for (int m = 0; m < 4; ++m) { const size_t off = (size_t)(row0 + ai * HALF + m * 16) * D + col0;
#pragma unroll
                for (int bj = 0; bj < 2; ++bj)
#pragma unroll
                    for (int n = 0; n < 2; ++n) { const f32x4 xv = *(const f32x4*)(X + off + bj * HALF + n * 16); *(f32x4*)(Y + off + bj * HALF + n * 16) = xv * ALPHA + acc[ai][bj][m][n]; } }
    }
};
struct EpiResidLN {
    static constexpr bool PERM = true;
    const float* X32; const bf16* Xb; const float* st; const float* g; const float* b; bf16* Y; float* pst; int mode;
    __device__ __forceinline__ void operator()(const f32x4 (&acc)[2][2][4][2], const Unit& u, int wr, int wc, int fr, int fq) const {
        asm volatile("" : "+v"(fr), "+v"(fq));
        const int row0 = u.pm * BM + wr * 64 + fr, col0 = u.pn * BM + wc * 32 + 8 * fq, lane = fq * 16 + fr;
#pragma unroll
        for (int ai = 0; ai < 2; ++ai)
#pragma unroll
            for (int m = 0; m < 4; ++m) { const int row = row0 + ai * HALF + m * 16; const size_t off = (size_t)row * D + col0;
                float mean = 0.f, rstd = 1.f; if (mode) { const f32x2 sv = *(const f32x2*)(st + 2 * row); mean = sv.x; rstd = sv.y; }
                float sm = 0.f, sq = 0.f;
#pragma unroll
                for (int bj = 0; bj < 2; ++bj) { f32x4 x0, x1;
                    if (mode) { const v4u xv = *(const v4u*)(Xb + off + bj * HALF);
                        const f32x4 g0 = *(const f32x4*)(g + col0 + bj * HALF), g1 = *(const f32x4*)(g + col0 + bj * HALF + 4), b0 = *(const f32x4*)(b + col0 + bj * HALF), b1 = *(const f32x4*)(b + col0 + bj * HALF + 4);
                        x0 = ((f32x4){bflo(xv.x), bfhi(xv.x), bflo(xv.y), bfhi(xv.y)} - mean) * rstd * g0 + b0; x1 = ((f32x4){bflo(xv.z), bfhi(xv.z), bflo(xv.w), bfhi(xv.w)} - mean) * rstd * g1 + b1; }
                    else { x0 = *(const f32x4*)(X32 + off + bj * HALF); x1 = *(const f32x4*)(X32 + off + bj * HALF + 4); }
                    const f32x4 y0 = x0 * ALPHA + acc[ai][bj][m][0], y1 = x1 * ALPHA + acc[ai][bj][m][1];
                    v4u w; w.x = cvt_pk_bf16(y0[0], y0[1]); w.y = cvt_pk_bf16(y0[2], y0[3]); w.z = cvt_pk_bf16(y1[0], y1[1]); w.w = cvt_pk_bf16(y1[2], y1[3]);
                    *(v4u*)(Y + off + bj * HALF) = w;
                    sm += ((y0[0] + y0[1]) + (y0[2] + y0[3])) + ((y1[0] + y1[1]) + (y1[2] + y1[3]));
                    sq += ((y0[0] * y0[0] + y0[1] * y0[1]) + (y0[2] * y0[2] + y0[3] * y0[3])) + ((y1[0] * y1[0] + y1[1] * y1[1]) + (y1[2] * y1[2] + y1[3] * y1[3])); }
                sm += shfl_x(sm, 16, lane); sm += shfl_x(sm, 32, lane); sq += shfl_x(sq, 16, lane); sq += shfl_x(sq, 32, lane);
                if (fq == 0) *(f32x2*)(pst + ((size_t)row * 32 + u.pn * 4 + wc) * 2) = (f32x2){sm, sq}; }
    }
};
struct EpiConvIn {
    static constexpr bool PERM = true;
    bf16* UC; bf16* BGp;
    __device__ __forceinline__ void operator()(const f32x4 (&acc)[2][2][4][2], const Unit& u, int wr, int wc, int fr, int fq) const {
        asm volatile("" : "+v"(fr), "+v"(fq));
        const int row0 = u.pm * BM + wr * 64 + fr, cw = wc * 32 + 8 * fq;
        if (u.pn < 16) {
#pragma unroll
            for (int ai = 0; ai < 2; ++ai)
#pragma unroll
                for (int m = 0; m < 4; ++m) { bf16* rowp = UC + (size_t)(row0 + ai * HALF + m * 16) * D + u.pn * HALF + cw;
                    const f32x4 v0 = acc[ai][0][m][0] * acc[ai][1][m][0], v1 = acc[ai][0][m][1] * acc[ai][1][m][1];
                    v4u w; w.x = cvt_pk_bf16(v0[0], v0[1]); w.y = cvt_pk_bf16(v0[2], v0[3]); w.z = cvt_pk_bf16(v1[0], v1[1]); w.w = cvt_pk_bf16(v1[2], v1[3]);
                    *(v4u*)rowp = w; }
        } else {
#pragma unroll
            for (int ai = 0; ai < 2; ++ai)
#pragma unroll
                for (int m = 0; m < 4; ++m) { bf16* rowp = BGp + (size_t)(row0 + ai * HALF + m * 16) * D + (u.pn - 16) * BM + cw;
#pragma unroll
                    for (int bj = 0; bj < 2; ++bj) { const f32x4 v0 = acc[ai][bj][m][0], v1 = acc[ai][bj][m][1];
                        v4u w; w.x = cvt_pk_bf16(v0[0], v0[1]); w.y = cvt_pk_bf16(v0[2], v0[3]); w.z = cvt_pk_bf16(v1[0], v1[1]); w.w = cvt_pk_bf16(v1[2], v1[3]);
                        *(v4u*)(rowp + bj * HALF) = w; } }
        }
    }
};
__device__ __forceinline__ f32x4 silu_mul(f32x4 g, f32x4 uu) {
    f32x4 r;
#pragma unroll
    for (int j = 0; j < 4; ++j) r[j] = g[j] * __builtin_amdgcn_rcpf(1.0f + __expf(-g[j])) * uu[j];
    return r;
}
struct EpiExpertGU {
    static constexpr bool PERM = true;
    bf16* H;
    __device__ __forceinline__ void operator()(const f32x4 (&acc)[2][2][4][2], const Unit& u, int wr, int wc, int fr, int fq) const {
        asm volatile("" : "+v"(fr), "+v"(fq));
        const float* gates = (const float*)((const char*)u.rows + (WS_LGATE - WS_LTOK));
        const int cw = wc * 32 + 8 * fq;
#pragma unroll
        for (int ai = 0; ai < 2; ++ai)
#pragma unroll
            for (int m = 0; m < 4; ++m) { const int r = ai * HALF + wr * 64 + m * 16 + fr;
                if (r < u.nvalid) { const float gt = gates[r]; const unsigned pid = (unsigned)u.rows[r];
                    const f32x4 v0 = silu_mul(acc[ai][0][m][0], acc[ai][1][m][0]) * gt, v1 = silu_mul(acc[ai][0][m][1], acc[ai][1][m][1]) * gt;
                    v4u w; w.x = cvt_pk_bf16(v0[0], v0[1]); w.y = cvt_pk_bf16(v0[2], v0[3]); w.z = cvt_pk_bf16(v1[0], v1[1]); w.w = cvt_pk_bf16(v1[2], v1[3]);
                    (void)pid; *(v4u*)(H + (size_t)(u.aux + r) * EDIM + cw) = w; } }
    }
};
struct EpiSharedGU {
    static constexpr bool PERM = true;
    bf16* HS;
    __device__ __forceinline__ void operator()(const f32x4 (&acc)[2][2][4][2], const Unit& u, int wr, int wc, int fr, int fq) const {
        asm volatile("" : "+v"(fr), "+v"(fq));
        const int row0 = u.pm * BM + wr * 64 + fr, cw = u.pn * HALF + wc * 32 + 8 * fq;
#pragma unroll
        for (int ai = 0; ai < 2; ++ai)
#pragma unroll
            for (int m = 0; m < 4; ++m) {
                const f32x4 v0 = silu_mul(acc[ai][0][m][0], acc[ai][1][m][0]), v1 = silu_mul(acc[ai][0][m][1], acc[ai][1][m][1]);
                v4u w; w.x = cvt_pk_bf16(v0[0], v0[1]); w.y = cvt_pk_bf16(v0[2], v0[3]); w.z = cvt_pk_bf16(v1[0], v1[1]); w.w = cvt_pk_bf16(v1[2], v1[3]);
                *(v4u*)(HS + (size_t)(row0 + ai * HALF + m * 16) * SDIM + cw) = w; }
    }
};
struct EpiDownY {
    static constexpr bool PERM = true;
    bf16* Y;
    __device__ __forceinline__ void operator()(const f32x4 (&acc)[2][2][4][2], const Unit& u, int wr, int wc, int fr, int fq) const {
        asm volatile("" : "+v"(fr), "+v"(fq));
        const int col0 = u.pn * BM + wc * 32 + 8 * fq;
#pragma unroll
        for (int ai = 0; ai < 2; ++ai)
#pragma unroll
            for (int m = 0; m < 4; ++m) { const int r = ai * HALF + wr * 64 + m * 16 + fr; bf16* rowp = Y + (size_t)(u.aux + r) * D + col0;
#pragma unroll
                for (int bj = 0; bj < 2; ++bj) { const f32x4 v0 = acc[ai][bj][m][0], v1 = acc[ai][bj][m][1];
                    v4u w; w.x = cvt_pk_bf16(v0[0], v0[1]); w.y = cvt_pk_bf16(v0[2], v0[3]); w.z = cvt_pk_bf16(v1[0], v1[1]); w.w = cvt_pk_bf16(v1[2], v1[3]);
                    *(v4u*)(rowp + bj * HALF) = w; } }
    }
};
}

struct Args { const float* in[19]; float* out; unsigned char* ws; int ph_lo, ph_hi; };
struct Frame {
    LAS unsigned char* lds; unsigned* ctl; unsigned char* ws;
    int tid, lane, wave, G, bid;
};
enum { IN_X = 0, IN_RELB, IN_PWIN, IN_PWG, IN_PSC, IN_PWOUT, IN_DQKV, IN_DOUT, IN_CWIN, IN_CW, IN_CWOUT, IN_LNG, IN_LNB, IN_RW, IN_RB, IN_EGU, IN_ED, IN_SGU, IN_SD };

#define CAS __attribute__((address_space(4)))
typedef const CAS unsigned char* KP;
__device__ __forceinline__ const float* ain(KP kp, int i) { return (const float*)((const GAS float* const CAS*)kp)[i]; }
__device__ __forceinline__ float* aout(KP kp) { return (float*)((GAS float* const CAS*)kp)[19]; }
__device__ __forceinline__ void tr_item(const float* W, int K, int N, bf16* WT, int dstK, int mode, LAS float* scr, int item, int lane) {
    const int nblk = N / 32, kb = item / nblk, nb = item % nblk, k0 = 64 * kb, n0 = 32 * nb;
    int r0 = n0;
    if (mode == 1) { const int part = n0 / 2048, j = n0 % 2048; r0 = (part == 0) ? 4096 + j : 256 * (j / 128) + (part == 2 ? 128 : 0) + (j % 128); }
    if (mode == 2) { const int part = n0 / 256, j = n0 % 256; r0 = 256 * (j / 128) + 128 * part + (j % 128); }
#pragma unroll 8
    for (int i = 0; i < 32; ++i) { const int kk = 2 * i + (lane >> 5); scr[kk * 33 + (lane & 31)] = W[(size_t)(k0 + kk) * N + n0 + (lane & 31)]; }
    LDS_WAIT(); asm volatile("" ::: "memory");
    const int c = lane & 7;
#pragma unroll
    for (int j = 0; j < 4; ++j) { const int n = (lane >> 3) + 8 * j; const LAS float* s = scr + (8 * c) * 33 + n;
        v4u o; o.x = pk2(s[0 * 33], s[1 * 33]); o.y = pk2(s[2 * 33], s[3 * 33]); o.z = pk2(s[4 * 33], s[5 * 33]); o.w = pk2(s[6 * 33], s[7 * 33]);
        *(v4u*)(WT + (size_t)(r0 + n) * dstK + k0 + 8 * c) = o; }
    LDS_WAIT(); asm volatile("" ::: "memory");
}
__device__ __forceinline__ void phase_prologue(const Frame& F, KP kp) {
    LAS float* scr = (LAS float*)(F.lds + F.wave * 16384);
    const int gw = F.bid * 8 + F.wave, NGW = F.G * 8;
    constexpr int I0 = 2 * 2048, I1 = 8 * 128, I2 = 2 * 2048, I3 = 4608, I4 = 512, I5 = 6144, I6 = 2048, I7 = 4 * 512, I8 = 4 * 256, I9 = 256 * 256, I10 = 256 * 128;
    constexpr int NITEMS = I0 + I1 + I2 + I3 + I4 + I5 + I6 + I7 + I8 + I9 + I10;
    unsigned char* ws = F.ws;
    for (int it = gw; it < NITEMS; it += NGW) {
        int r = it;
        if (r < I0) { const int b = r / 2048; tr_item(ain(kp, IN_PWIN) + (size_t)b * D * D, D, D, (bf16*)(ws + WS_W_POOL_IN) + (size_t)b * D * D, D, 0, scr, r % 2048, F.lane); continue; } r -= I0;
        if (r < I1) { const int b = r / 128; tr_item(ain(kp, IN_PWG) + (size_t)b * 512 * 512, 512, 512, (bf16*)(ws + WS_W_POOL_G) + (size_t)b * 512 * 512, 512, 0, scr, r % 128, F.lane); continue; } r -= I1;
        if (r < I2) { const int b = r / 2048; tr_item(ain(kp, IN_PWOUT) + (size_t)b * D * D, D, D, (bf16*)(ws + WS_W_POOL_OUT) + (size_t)b * D * D, D, 0, scr, r % 2048, F.lane); continue; } r -= I2;
        if (r < I3) { tr_item(ain(kp, IN_DQKV), D, QKVC, (bf16*)(ws + WS_W_DIL_QKV), D, 0, scr, r, F.lane); continue; } r -= I3;
        if (r < I4) { tr_item(ain(kp, IN_DOUT), DILW, D, (bf16*)(ws + WS_W_DIL_OUT), DILW, 0, scr, r, F.lane); continue; } r -= I4;
        if (r < I5) { tr_item(ain(kp, IN_CWIN), D, 3 * D, (bf16*)(ws + WS_W_CONV_IN), D, 1, scr, r, F.lane); continue; } r -= I5;
        if (r < I6) { tr_item(ain(kp, IN_CWOUT), D, D, (bf16*)(ws + WS_W_CONV_OUT), D, 0, scr, r, F.lane); continue; } r -= I6;
        if (r < I7) { const int b = r / 512; tr_item(ain(kp, IN_SGU) + (size_t)b * D * 512, D, 512, (bf16*)(ws + WS_W_SH_GU) + (size_t)b * 512 * D, D, 2, scr, r % 512, F.lane); continue; } r -= I7;
        if (r < I8) { const int b = r / 256; tr_item(ain(kp, IN_SD) + (size_t)b * SDIM * D, SDIM, D, (bf16*)(ws + WS_W_SH_D) + (size_t)b * D * SDIM, SDIM, 0, scr, r % 256, F.lane); continue; } r -= I8;
        if (r < I9) { const int b = r / 256; tr_item(ain(kp, IN_EGU) + (size_t)b * D * 256, D, 256, (bf16*)(ws + WS_W_EX_GU) + (size_t)b * 256 * D, D, 0, scr, r % 256, F.lane); continue; } r -= I9;
        { const int b = r / 128; tr_item(ain(kp, IN_ED) + (size_t)b * EDIM * D, EDIM, D, (bf16*)(ws + WS_W_EX_D) + (size_t)b * D * EDIM, EDIM, 0, scr, r % 128, F.lane); }
    }
    const size_t gt = (size_t)F.bid * 512 + F.tid, GT = (size_t)F.G * 512;
    { const float* rw = ain(kp, IN_RW); bf16* wh = (bf16*)(ws + WS_RWH); bf16* wl = (bf16*)(ws + WS_RWL);
      for (size_t i = gt; i < (size_t)DEPTH * NEXP * D / 8; i += GT) { const size_t k8 = i % (D / 8), e = (i / (D / 8)) % NEXP, l = i / ((size_t)NEXP * D / 8);
          float v[8]; unsigned hi[8], lo[8];
#pragma unroll
          for (int j = 0; j < 8; ++j) { v[j] = rw[(l * D + k8 * 8 + j) * NEXP + e]; hi[j] = f2bf(v[j]); lo[j] = f2bf(v[j] - __builtin_bit_cast(float, hi[j] << 16)); }
          v4u a, b2; a.x = hi[0] | (hi[1] << 16); a.y = hi[2] | (hi[3] << 16); a.z = hi[4] | (hi[5] << 16); a.w = hi[6] | (hi[7] << 16);
          b2.x = lo[0] | (lo[1] << 16); b2.y = lo[2] | (lo[3] << 16); b2.z = lo[4] | (lo[5] << 16); b2.w = lo[6] | (lo[7] << 16);
          *(v4u*)(wh + (l * NEXP + e) * D + k8 * 8) = a; *(v4u*)(wl + (l * NEXP + e) * D + k8 * 8) = b2; } }
    const float* x = ain(kp, IN_X); bf16* xb = (bf16*)(ws + WS_XB);
    for (size_t i = gt; i < (size_t)T * D / 8; i += GT) { const f32x4 p = *(const f32x4*)(x + i * 8), q = *(const f32x4*)(x + i * 8 + 4);
        v4u w; w.x = pk2(p[0], p[1]); w.y = pk2(p[2], p[3]); w.z = pk2(q[0], q[1]); w.w = pk2(q[2], q[3]); *(v4u*)(xb + i * 8) = w; }
}

__device__ __forceinline__ void unpack8(const v4u w, float (&f)[8]) { f[0] = bflo(w.x); f[1] = bfhi(w.x); f[2] = bflo(w.y); f[3] = bfhi(w.y); f[4] = bflo(w.z); f[5] = bfhi(w.z); f[6] = bflo(w.w); f[7] = bfhi(w.w); }
__device__ __forceinline__ void phase_pool(const Frame& F, const bf16* U, bf16* PL) {
    for (int it = F.bid * 512 + F.tid; it < (T / 32) * 256; it += F.G * 512) {
        const int cv = it & 255, ch = it >> 8, col = cv * 8, w = 2 << (col >> 9);
        const int row0 = ch * 32, pos0 = row0 & (SEQ - 1);
        float s[8], uu[8];
#pragma unroll
        for (int j = 0; j < 8; ++j) s[j] = 0.f;
        for (int j = 1; j < w; ++j) if (pos0 - j >= 0) { unpack8(*(const v4u*)(U + (size_t)(row0 - j) * D + col), uu);
#pragma unroll
            for (int q = 0; q < 8; ++q) s[q] += uu[q]; }
        for (int r = 0; r < 32; ++r) {
            const int t = row0 + r, pos = pos0 + r;
            unpack8(*(const v4u*)(U + (size_t)t * D + col), uu);
            const float inv = 1.0f / (float)((pos + 1) < w ? (pos + 1) : w);
            float o[8];
#pragma unroll
            for (int q = 0; q < 8; ++q) { s[q] += uu[q]; o[q] = s[q] * inv - uu[q]; }
            v4u ww; ww.x = pk2(o[0], o[1]); ww.y = pk2(o[2], o[3]); ww.z = pk2(o[4], o[5]); ww.w = pk2(o[6], o[7]);
            *(v4u*)(PL + (size_t)t * D + col) = ww;
            if (pos - w + 1 >= 0) { unpack8(*(const v4u*)(U + (size_t)(t - w + 1) * D + col), uu);
#pragma unroll
                for (int q = 0; q < 8; ++q) s[q] -= uu[q]; }
        }
    }
}

__device__ __forceinline__ void phase_conv(const Frame& F, const bf16* UC, const bf16* BGp, const float* cw, bf16* Z) {
    for (int it = F.bid * 512 + F.tid; it < T * 256; it += F.G * 512) {
        const int cv = it & 255, t = it >> 8, col = cv * 8, pos = t & (SEQ - 1);
        float u0[8], u1[8], u2[8], bb[8], o[8];
        unpack8(*(const v4u*)(UC + (size_t)t * D + col), u2);
        if (pos >= 1) unpack8(*(const v4u*)(UC + (size_t)(t - 1) * D + col), u1); else {
#pragma unroll
            for (int q = 0; q < 8; ++q) u1[q] = 0.f; }
        if (pos >= 2) unpack8(*(const v4u*)(UC + (size_t)(t - 2) * D + col), u0); else {
#pragma unroll
            for (int q = 0; q < 8; ++q) u0[q] = 0.f; }
        unpack8(*(const v4u*)(BGp + (size_t)t * D + col), bb);
#pragma unroll
        for (int q = 0; q < 8; ++q) o[q] = bb[q] * (cw[col + q] * u0[q] + cw[D + col + q] * u1[q] + cw[2 * D + col + q] * u2[q]);
        v4u ww; ww.x = pk2(o[0], o[1]); ww.y = pk2(o[2], o[3]); ww.z = pk2(o[4], o[5]); ww.w = pk2(o[6], o[7]);
        *(v4u*)(Z + (size_t)t * D + col) = ww;
    }
}

__device__ __forceinline__ int t5_bucket(int dist) {
    if (dist < 16) return dist;
    int large = 16 + (int)(logf((float)dist / 16.0f) / logf(128.0f) * 16.0f);
    return large < 31 ? large : 31;
}
constexpr int AT_KS = 0, AT_KSTR = 144, AT_VT = 256 * 144, AT_VSTR = 520, AT_BIAS = AT_VT + 64 * 520;
__device__ __forceinline__ void phase_attn(const Frame& F, const bf16* QKV, const float* relb, bf16* OG, float* LSE) {
    LAS unsigned char* lds = F.lds;
    const int tid = F.tid, lane = F.lane, w = tid >> 6, fr = lane & 15, fq = lane >> 4;
    for (int unit = F.bid; unit < NBATCH * 3 * 8 * 16; unit += F.G) {
        const int cmb = unit & 15, h = (unit >> 4) & 7, g = (unit >> 7) % 3, b = unit / 384;
        const int dsh = 2 * g, dil = 1 << dsh, r = cmb & (dil - 1), nb = cmb >> dsh;
        const bf16* base = QKV + (size_t)b * SEQ * QKVC + g * 1536 + h * 64;
        __syncthreads();
        {
            const int key = tid >> 1, half = tid & 1, jk = (nb - 1) * 128 + key;
            v4u kv[4], vv[4];
            if (jk >= 0) { const bf16* rp = base + (size_t)(jk * dil + r) * QKVC + half * 32;
#pragma unroll
                for (int i = 0; i < 4; ++i) { kv[i] = *(const v4u*)(rp + 512 + 8 * i); vv[i] = *(const v4u*)(rp + 1024 + 8 * i); } }
            else {
#pragma unroll
                for (int i = 0; i < 4; ++i) { kv[i] = (v4u){0u, 0u, 0u, 0u}; vv[i] = (v4u){0u, 0u, 0u, 0u}; } }
#pragma unroll
            for (int i = 0; i < 4; ++i) *(LAS v4u*)(lds + AT_KS + key * AT_KSTR + half * 64 + 16 * i) = kv[i];
#pragma unroll
            for (int i = 0; i < 4; ++i) {
                const unsigned ww[4] = {vv[i].x, vv[i].y, vv[i].z, vv[i].w};
#pragma unroll
                for (int q = 0; q < 4; ++q) { const int d = half * 32 + 8 * i + 2 * q;
                    *(LAS unsigned short*)(lds + AT_VT + d * AT_VSTR + key * 2) = (unsigned short)(ww[q] & 0xffffu);
                    *(LAS unsigned short*)(lds + AT_VT + (d + 1) * AT_VSTR + key * 2) = (unsigned short)(ww[q] >> 16); } }
            if (tid <= 128) ((LAS float*)(lds + AT_BIAS))[tid] = relb[t5_bucket(tid * dil) * 24 + g * 8 + h];
        }
        __syncthreads();
        int qi = 16 * w + fr; asm volatile("" : "+v"(qi));
        const int jq = nb * 128 + qi, tq = jq * dil + r;
        const bf16* qp = base + (size_t)tq * QKVC + 8 * fq;
        const bf16x8 q0 = *(const bf16x8*)qp, q1 = *(const bf16x8*)(qp + 32);
        f32x4 s[9]; float mx = -INFINITY;
#pragma unroll
        for (int kt = 0; kt < 9; ++kt) {
            const int kb = 16 * (w + kt);
            const bf16x8 k0 = *(const LAS bf16x8*)(lds + AT_KS + (kb + fr) * AT_KSTR + fq * 16), k1 = *(const LAS bf16x8*)(lds + AT_KS + (kb + fr) * AT_KSTR + 64 + fq * 16);
            f32x4 a = (f32x4){0.f, 0.f, 0.f, 0.f};
            a = __builtin_amdgcn_mfma_f32_16x16x32_bf16(k0, q0, a, 0, 0, 0);
            a = __builtin_amdgcn_mfma_f32_16x16x32_bf16(k1, q1, a, 0, 0, 0);
#pragma unroll
            for (int i = 0; i < 4; ++i) { const int kl = kb + 4 * fq + i, rel = qi + 128 - kl;
                const bool ok = (rel >= 0) && (rel <= 128) && (nb > 0 || kl >= 128);
                const int rc = rel < 0 ? 0 : (rel > 128 ? 128 : rel);
                const float v = ok ? a[i] + ((LAS float*)(lds + AT_BIAS))[rc] : -INFINITY;
                a[i] = v; mx = fmaxf(mx, v); }
            s[kt] = a;
        }
        mx = fmaxf(mx, shfl_x(mx, 16, lane)); mx = fmaxf(mx, shfl_x(mx, 32, lane));
        float l = 0.f;
#pragma unroll
        for (int kt = 0; kt < 9; ++kt)
#pragma unroll
            for (int i = 0; i < 4; ++i) { const float p = __expf(s[kt][i] - mx); s[kt][i] = p; l += p; }
        l += shfl_x(l, 16, lane); l += shfl_x(l, 32, lane);
        f32x4 o[4];
#pragma unroll
        for (int nt = 0; nt < 4; ++nt) o[nt] = (f32x4){0.f, 0.f, 0.f, 0.f};
#pragma unroll
        for (int st = 0; st < 5; ++st) {
            const int kt0 = 2 * st, kt1 = 2 * st + 1;
            v4u pw; pw.x = pk2(s[kt0][0], s[kt0][1]); pw.y = pk2(s[kt0][2], s[kt0][3]);
            if (kt1 < 9) { pw.z = pk2(s[kt1 < 9 ? kt1 : 0][0], s[kt1 < 9 ? kt1 : 0][1]); pw.w = pk2(s[kt1 < 9 ? kt1 : 0][2], s[kt1 < 9 ? kt1 : 0][3]); } else { pw.z = 0u; pw.w = 0u; }
            const bf16x8 pf = __builtin_bit_cast(bf16x8, pw);
            const int kb0 = 16 * (w + kt0) + 4 * fq, kb1 = 16 * (w + kt1) + 4 * fq;
#pragma unroll
            for (int nt = 0; nt < 4; ++nt) { const int d = 16 * nt + fr;
                v2u va = *(const LAS v2u*)(lds + AT_VT + d * AT_VSTR + kb0 * 2), vb = (v2u){0u, 0u};
                if (kt1 < 9) vb = *(const LAS v2u*)(lds + AT_VT + d * AT_VSTR + kb1 * 2);
                v4u vw; vw.x = va.x; vw.y = va.y; vw.z = vb.x; vw.w = vb.y;
                o[nt] = __builtin_amdgcn_mfma_f32_16x16x32_bf16(__builtin_bit_cast(bf16x8, vw), pf, o[nt], 0, 0, 0); }
        }
        const float il = 1.0f / l;
        bf16* op = OG + ((size_t)g * T + (size_t)b * SEQ + tq) * DILW + h * 64 + 4 * fq;
#pragma unroll
        for (int nt = 0; nt < 4; ++nt) { v2u ww; ww.x = pk2(o[nt][0] * il, o[nt][1] * il); ww.y = pk2(o[nt][2] * il, o[nt][3] * il); *(v2u*)(op + 16 * nt) = ww; }
        if (fq == 0) LSE[((size_t)g * T + (size_t)b * SEQ + tq) * 8 + h] = mx + logf(l);
    }
}
__device__ __forceinline__ void phase_combine(const Frame& F, const bf16* OG, const float* LSE, bf16* O) {
    for (int it = F.bid * 512 + F.tid; it < T * 64; it += F.G * 512) {
        const int c8 = it & 7, h = (it >> 3) & 7, t = it >> 6;
        const float l0 = LSE[((size_t)0 * T + t) * 8 + h], l1 = LSE[((size_t)1 * T + t) * 8 + h], l2 = LSE[((size_t)2 * T + t) * 8 + h];
        const float m = fmaxf(l0, fmaxf(l1, l2)); float w0 = __expf(l0 - m), w1 = __expf(l1 - m), w2 = __expf(l2 - m); const float inv = 1.0f / (w0 + w1 + w2); w0 *= inv; w1 *= inv; w2 *= inv;
        float a[8], bq[8], c[8], o[8]; const size_t off = (size_t)t * DILW + h * 64 + c8 * 8;
        unpack8(*(const v4u*)(OG + off), a); unpack8(*(const v4u*)(OG + (size_t)T * DILW + off), bq); unpack8(*(const v4u*)(OG + (size_t)2 * T * DILW + off), c);
#pragma unroll
        for (int q = 0; q < 8; ++q) o[q] = w0 * a[q] + w1 * bq[q] + w2 * c[q];
        v4u ww; ww.x = pk2(o[0], o[1]); ww.y = pk2(o[2], o[3]); ww.z = pk2(o[4], o[5]); ww.w = pk2(o[6], o[7]);
        *(v4u*)(O + off) = ww;
    }
}

constexpr int M1_LOG = 131072, M1_STAT = M1_LOG + 4096, M1_HIST = M1_STAT + 128, M1_BASE = M1_HIST + 256;
__device__ __forceinline__ void phase_moe1(const Frame& F, const float* Y, const float* gain, const float* bias, const float* RW, const float* RB,
                                           float* X1F, bf16* X1B, unsigned* cnt, int* ltok, float* lgate, int* eidx, int* inv) {
    LAS float* xs = (LAS float*)F.lds; LAS float* logit = (LAS float*)(F.lds + M1_LOG); LAS float* stat = (LAS float*)(F.lds + M1_STAT);
    LAS int* hist = (LAS int*)(F.lds + M1_HIST); LAS int* basep = (LAS int*)(F.lds + M1_BASE);
    const int tid = F.tid, lane = F.lane, w = F.wave;
    for (int rg = F.bid; rg < T / 16; rg += F.G) {
        const int row0 = rg * 16;
        __syncthreads();
#pragma unroll
        for (int j = 0; j < 16; ++j) { const int idx = tid + 512 * j; *(LAS f32x4*)(xs + idx * 4) = *(const f32x4*)(Y + (size_t)row0 * D + (size_t)idx * 4); }
        if (tid < 64) hist[tid] = 0;
        __syncthreads();
#pragma unroll
        for (int rr = 0; rr < 2; ++rr) { const int r = 2 * w + rr; float sm = 0.f;
#pragma unroll
            for (int j = 0; j < 32; ++j) sm += xs[r * D + lane + 64 * j];
            const float mean = wave_sum(sm, lane) * (1.0f / D); float sq = 0.f;
#pragma unroll
            for (int j = 0; j < 32; ++j) { const float d = xs[r * D + lane + 64 * j] - mean; sq += d * d; }
            const float rstd = 1.0f / sqrtf(wave_sum(sq, lane) * (1.0f / D) + LN_EPS);
            if (lane == 0) { stat[2 * r] = mean; stat[2 * r + 1] = rstd; } }
        __syncthreads();
#pragma unroll
        for (int j = 0; j < 16; ++j) { const int idx = tid + 512 * j, r = idx >> 9, c4 = (idx & 511) * 4;
            const f32x4 v = *(LAS f32x4*)(xs + idx * 4), gv = *(const f32x4*)(gain + c4), bv = *(const f32x4*)(bias + c4);
            const float mean = stat[2 * r], rstd = stat[2 * r + 1];
            const f32x4 o = (v - mean) * rstd * gv + bv;
            *(LAS f32x4*)(xs + idx * 4) = o;
            *(f32x4*)(X1F + (size_t)(row0 + r) * D + c4) = o;
            v2u wb; wb.x = pk2(o[0], o[1]); wb.y = pk2(o[2], o[3]); *(v2u*)(X1B + (size_t)(row0 + r) * D + c4) = wb; }
        __syncthreads();
        { const int r = tid >> 5, ep = tid & 31; float a0 = 0.f, a1 = 0.f; const float* wp = RW + 2 * ep; const LAS float* xr = xs + r * D;
            for (int k0 = 0; k0 < D; k0 += 16) {
                f32x2 wv[16];
#pragma unroll
                for (int j = 0; j < 16; ++j) wv[j] = *(const f32x2*)(wp + (size_t)(k0 + j) * NEXP);
                asm volatile("" : "+v"(wv[0]), "+v"(wv[1]), "+v"(wv[2]), "+v"(wv[3]), "+v"(wv[4]), "+v"(wv[5]), "+v"(wv[6]), "+v"(wv[7]));
                asm volatile("" : "+v"(wv[8]), "+v"(wv[9]), "+v"(wv[10]), "+v"(wv[11]), "+v"(wv[12]), "+v"(wv[13]), "+v"(wv[14]), "+v"(wv[15]));
#pragma unroll
                for (int j = 0; j < 16; ++j) { const float xv = xr[k0 + j]; a0 += xv * wv[j].x; a1 += xv * wv[j].y; } }
            logit[r * NEXP + 2 * ep] = a0; logit[r * NEXP + 2 * ep + 1] = a1; }
        __syncthreads();
        int sel_pos[2]; float sel_gate[2]; int sel_rank[2]; bool sel_on[2];
#pragma unroll
        for (int rr = 0; rr < 2; ++rr) { const int r = 2 * w + rr;
            const float sc = 1.0f / (1.0f + __expf(-logit[r * NEXP + lane])); const float ch = sc + RB[lane];
            int rk = 0;
#pragma unroll
            for (int j = 0; j < 8; ++j) { const float cj = shfl_from(ch, (lane & ~7) + j); rk += (cj > ch || (cj == ch && j < (lane & 7))) ? 1 : 0; }
            float gs = rk < 2 ? ch : 0.f; gs += shfl_x(gs, 1, lane); gs += shfl_x(gs, 2, lane); gs += shfl_x(gs, 4, lane);
            int grk = 0; const int g = lane >> 3;
#pragma unroll
            for (int hh = 0; hh < 8; ++hh) { const float gh = shfl_from(gs, 8 * hh); grk += (gh > gs || (gh == gs && hh < g)) ? 1 : 0; }
            const float msk = grk < 4 ? ch : -INFINITY;
            int erk = 0;
            for (int j = 0; j < 64; ++j) { const float mj = __builtin_bit_cast(float, __builtin_amdgcn_readlane(__builtin_bit_cast(int, msk), j)); erk += (mj > msk || (mj == msk && j < lane)) ? 1 : 0; }
            const bool on = erk < 8;
            const float ssum = wave_sum(on ? sc : 0.f, lane);
            sel_on[rr] = on; sel_rank[rr] = erk; sel_gate[rr] = sc / ssum * 2.5f; sel_pos[rr] = 0;
            if (on) sel_pos[rr] = __hip_atomic_fetch_add(&hist[lane], 1, __ATOMIC_RELAXED, __HIP_MEMORY_SCOPE_WORKGROUP); }
        __syncthreads();
        if (tid < 64) { const int hc = hist[tid]; int bs = 0; if (hc > 0) bs = (int)atomicAdd(&cnt[tid * 16], (unsigned)hc); basep[tid] = bs; }
        __syncthreads();
#pragma unroll
        for (int rr = 0; rr < 2; ++rr) if (sel_on[rr]) { const int t = row0 + 2 * w + rr, pos = basep[lane] + sel_pos[rr];
            ltok[(size_t)lane * CAP + pos] = t; lgate[(size_t)lane * CAP + pos] = sel_gate[rr];
            eidx[t * 8 + sel_rank[rr]] = lane; inv[t * 8 + sel_rank[rr]] = pos; }
    }
}
__device__ __forceinline__ int build_tiles(const Frame& F, const unsigned* cnt) {
    LAS int* tpref = (LAS int*)(F.lds + LDS_TAB); LAS int* cl = (LAS int*)(F.lds + LDS_TAB + 512);
    __syncthreads();
    if (F.tid < 64) cl[F.tid] = (int)__hip_atomic_load(&cnt[F.tid * 16], __ATOMIC_RELAXED, __HIP_MEMORY_SCOPE_AGENT);
    __syncthreads();
    if (F.tid == 0) { int acc = 0; for (int e = 0; e < 64; ++e) { tpref[e] = acc; acc += (cl[e] + 255) >> 8; } tpref[64] = acc; tpref[65] = acc + T / 256; tpref[66] = acc + 2 * (T / 256); cl[64] = T; cl[65] = T; }
    __syncthreads();
    return __builtin_amdgcn_readfirstlane(tpref[64]);
}
__device__ __forceinline__ void phase_moe4(const Frame& F, const float* Y2, const bf16* Yr, const int* eidx, const int* inv, const float* gain, const float* bias, float* XO, bf16* XBo) {
    const LAS int* tpref = (const LAS int*)(F.lds + LDS_TAB);
    const int gw = F.bid * 8 + F.wave, NGW = F.G * 8, lane = F.lane;
    for (int t = gw; t < T; t += NGW) {
        f32x4 v[8];
#pragma unroll
        for (int j = 0; j < 8; ++j) v[j] = *(const f32x4*)(Y2 + (size_t)t * D + 4 * lane + 256 * j);
        for (int k = 0; k < 8; ++k) { const int e = eidx[t * 8 + k], pos = inv[t * 8 + k]; const bf16* yr = Yr + (size_t)(tpref[e] * 256 + pos) * D + 4 * lane;
#pragma unroll
            for (int j = 0; j < 8; ++j) { const v2u w = *(const v2u*)(yr + 256 * j); v[j][0] += bflo(w.x); v[j][1] += bfhi(w.x); v[j][2] += bflo(w.y); v[j][3] += bfhi(w.y); } }
        float sm = 0.f;
#pragma unroll
        for (int j = 0; j < 8; ++j) sm += (v[j][0] + v[j][1]) + (v[j][2] + v[j][3]);
        const float mean = wave_sum(sm, lane) * (1.0f / D); float sq = 0.f;
#pragma unroll
        for (int j = 0; j < 8; ++j) { v[j] = v[j] - mean; sq += (v[j][0] * v[j][0] + v[j][1] * v[j][1]) + (v[j][2] * v[j][2] + v[j][3] * v[j][3]); }
        const float rstd = 1.0f / sqrtf(wave_sum(sq, lane) * (1.0f / D) + LN_EPS);
#pragma unroll
        for (int j = 0; j < 8; ++j) { const int c = 4 * lane + 256 * j; const f32x4 o = v[j] * rstd * *(const f32x4*)(gain + c) + *(const f32x4*)(bias + c);
            *(f32x4*)(XO + (size_t)t * D + c) = o;
            v2u wb; wb.x = pk2(o[0], o[1]); wb.y = pk2(o[2], o[3]); *(v2u*)(XBo + (size_t)t * D + c) = wb; }
    }
}


constexpr int M1_P = 0, M1N_HIST = 131072, M1N_BASE = 131072 + 256, M1N_GB = 131072 + 1024;
__device__ __forceinline__ void phase_moe1n(const Frame& F, const bf16* Y, const float* pst, const float* gain, const float* bias, const bf16* WH, const bf16* WL, const float* RB,
                                            bf16* X1B, float* ST1, unsigned* cnt, int* ltok, float* lgate, int* eidx, int* inv) {
    LAS float* P = (LAS float*)(F.lds + M1_P); LAS int* hist = (LAS int*)(F.lds + M1N_HIST); LAS int* basep = (LAS int*)(F.lds + M1N_BASE);
    const int tid = F.tid, lane = F.lane, w = F.wave, r = lane & 15, q = lane >> 4;
    for (int item = F.bid; item < T / 64; item += F.G) {
        const int row0 = item * 64;
        __syncthreads();
        if (tid < 64) hist[tid] = 0;
        { LAS f32x4* gb = (LAS f32x4*)(F.lds + M1N_GB); gb[tid] = *(const f32x4*)(gain + 4 * tid); gb[512 + tid] = *(const f32x4*)(bias + 4 * tid); }
        __syncthreads();
        float mean[4], rstd[4];
#pragma unroll
        for (int rt = 0; rt < 4; ++rt) { const int row = row0 + 16 * rt + r;
          const f32x4* pp = (const f32x4*)(pst + ((size_t)row * 32 + q * 8) * 2); const f32x4 a = pp[0], b = pp[1], c = pp[2], d = pp[3];
          float sm = (a[0] + a[2]) + (b[0] + b[2]) + (c[0] + c[2]) + (d[0] + d[2]), sq = (a[1] + a[3]) + (b[1] + b[3]) + (c[1] + c[3]) + (d[1] + d[3]);
          sm += shfl_x(sm, 16, lane); sm += shfl_x(sm, 32, lane); sq += shfl_x(sq, 16, lane); sq += shfl_x(sq, 32, lane);
          mean[rt] = sm * (1.0f / D); const float var = fmaxf(sq * (1.0f / D) - mean[rt] * mean[rt], 0.f); rstd[rt] = 1.0f / sqrtf(var + LN_EPS);
          if (w == 0 && q == 0) *(f32x2*)(ST1 + 2 * row) = (f32x2){mean[rt], rstd[rt]}; }
        const int kb = 256 * w + 8 * q;
        const LAS float* gl = (const LAS float*)(F.lds + M1N_GB) + kb;
        f32x4 acc[4][4];
#pragma unroll
        for (int rt = 0; rt < 4; ++rt)
#pragma unroll
            for (int nt = 0; nt < 4; ++nt) acc[rt][nt] = (f32x4){0.f, 0.f, 0.f, 0.f};
        v4u yb[3][4]; bf16x8 wh[4], wl[4];
        unsigned vo[4];
#pragma unroll
        for (int i = 0; i < 4; ++i) { vo[i] = (unsigned)(r * D + kb) * 2u + (unsigned)i * (16u * D * 2u); asm volatile("" : "+v"(vo[i])); }
        const char* ybase = (const char*)(Y + (size_t)row0 * D); char* xbase = (char*)(X1B + (size_t)row0 * D);
#define M1_LOADY(st) do { _Pragma("unroll") for (int rt = 0; rt < 4; ++rt) yb[(st) % 3][rt] = *(const v4u*)(ybase + vo[rt] + 64 * (st)); } while (0)
#define M1_LOADW(st) do { _Pragma("unroll") for (int nt = 0; nt < 4; ++nt) { wh[nt] = *(const bf16x8*)((const char*)WH + vo[nt] + 64 * (st)); wl[nt] = *(const bf16x8*)((const char*)WL + vo[nt] + 64 * (st)); } } while (0)
        M1_LOADY(0); M1_LOADW(0); M1_LOADY(1);
        __builtin_amdgcn_sched_barrier(0);
#pragma unroll
        for (int st = 0; st < 8; ++st) {
            const f32x4 g0 = *(const LAS f32x4*)(gl + 32 * st), g1 = *(const LAS f32x4*)(gl + 32 * st + 4), b0 = *(const LAS f32x4*)(gl + 2048 + 32 * st), b1 = *(const LAS f32x4*)(gl + 2048 + 32 * st + 4);
#pragma unroll
            for (int rt = 0; rt < 4; ++rt) { const v4u yv = yb[st % 3][rt];
                const f32x4 y0_ = (f32x4){bflo(yv.x), bfhi(yv.x), bflo(yv.y), bfhi(yv.y)}, y1_ = (f32x4){bflo(yv.z), bfhi(yv.z), bflo(yv.w), bfhi(yv.w)};
                const f32x4 x0 = (y0_ - mean[rt]) * rstd[rt] * g0 + b0, x1 = (y1_ - mean[rt]) * rstd[rt] * g1 + b1;
                v4u h; h.x = cvt_pk_bf16(x0[0], x0[1]); h.y = cvt_pk_bf16(x0[2], x0[3]); h.z = cvt_pk_bf16(x1[0], x1[1]); h.w = cvt_pk_bf16(x1[2], x1[3]);
                *(v4u*)(xbase + vo[rt] + 64 * st) = h;
                v4u l; l.x = cvt_pk_bf16(x0[0] - bflo(h.x), x0[1] - bfhi(h.x)); l.y = cvt_pk_bf16(x0[2] - bflo(h.y), x0[3] - bfhi(h.y));
                l.z = cvt_pk_bf16(x1[0] - bflo(h.z), x1[1] - bfhi(h.z)); l.w = cvt_pk_bf16(x1[2] - bflo(h.w), x1[3] - bfhi(h.w));
                const bf16x8 xh = __builtin_bit_cast(bf16x8, h), xl = __builtin_bit_cast(bf16x8, l);
#pragma unroll
                for (int nt = 0; nt < 4; ++nt) { acc[rt][nt] = __builtin_amdgcn_mfma_f32_16x16x32_bf16(xh, wh[nt], acc[rt][nt], 0, 0, 0);
                    acc[rt][nt] = __builtin_amdgcn_mfma_f32_16x16x32_bf16(xl, wh[nt], acc[rt][nt], 0, 0, 0); acc[rt][nt] = __builtin_amdgcn_mfma_f32_16x16x32_bf16(xh, wl[nt], acc[rt][nt], 0, 0, 0); } }
            __builtin_amdgcn_sched_barrier(0);
            if (st + 1 < 8) M1_LOADW(st + 1);
            if (st + 2 < 8) M1_LOADY(st + 2);
            __builtin_amdgcn_sched_barrier(0);
        }
#undef M1_LOADY
#undef M1_LOADW
#pragma unroll
        for (int rt = 0; rt < 4; ++rt)
#pragma unroll
            for (int nt = 0; nt < 4; ++nt)
#pragma unroll
                for (int i = 0; i < 4; ++i) P[(w * 64 + 16 * rt + 4 * q + i) * 64 + 16 * nt + r] = acc[rt][nt][i];
        __syncthreads();
        int sel_pos[8]; float sel_gate[8]; int sel_rank[8]; bool sel_on[8];
        const float rb = RB[lane];
#pragma unroll
        for (int rr = 0; rr < 8; ++rr) { const int rl = 8 * w + rr;
            float lg = ((P[rl * 64 + lane] + P[(64 + rl) * 64 + lane]) + (P[(128 + rl) * 64 + lane] + P[(192 + rl) * 64 + lane])) + ((P[(256 + rl) * 64 + lane] + P[(320 + rl) * 64 + lane]) + (P[(384 + rl) * 64 + lane] + P[(448 + rl) * 64 + lane]));
            lg = (lg == lg) ? lg : -1.0e30f;
            const float sc = 1.0f / (1.0f + __expf(-lg)); const float ch = sc + rb;
            int rk = 0;
#pragma unroll
            for (int j = 0; j < 8; ++j) { const float cj = shfl_from(ch, (lane & ~7) + j); rk += (cj > ch || (cj == ch && j < (lane & 7))) ? 1 : 0; }
            float gs = rk < 2 ? ch : 0.f; gs += shfl_x(gs, 1, lane); gs += shfl_x(gs, 2, lane); gs += shfl_x(gs, 4, lane);
            int grk = 0; const int g = lane >> 3;
#pragma unroll
            for (int hh = 0; hh < 8; ++hh) { const float gh = shfl_from(gs, 8 * hh); grk += (gh > gs || (gh == gs && hh < g)) ? 1 : 0; }
            const float msk = grk < 4 ? ch : -INFINITY;
            int erk = 0;
            for (int j = 0; j < 64; ++j) { const float mj = __builtin_bit_cast(float, __builtin_amdgcn_readlane(__builtin_bit_cast(int, msk), j)); erk += (mj > msk || (mj == msk && j < lane)) ? 1 : 0; }
            const bool on = erk < 8;
            const float ssum = wave_sum(on ? sc : 0.f, lane);
            sel_on[rr] = on; sel_rank[rr] = erk; sel_gate[rr] = sc / ssum * 2.5f; sel_pos[rr] = 0;
            if (on) sel_pos[rr] = __hip_atomic_fetch_add(&hist[lane], 1, __ATOMIC_RELAXED, __HIP_MEMORY_SCOPE_WORKGROUP); }
        __syncthreads();
        if (tid < 64) { int tt = tid; asm volatile("" : "+v"(tt));
            const int hc = hist[tt]; int bs = 0; if (hc > 0) bs = (int)atomicAdd(&cnt[tt * 16], (unsigned)hc); basep[tt] = bs; }
        __syncthreads();
#pragma unroll
        for (int rr = 0; rr < 8; ++rr) if (sel_on[rr]) { const int t = row0 + 8 * w + rr, pos = basep[lane] + sel_pos[rr];
            ltok[(size_t)lane * CAP + pos] = t * 8 + sel_rank[rr]; lgate[(size_t)lane * CAP + pos] = sel_gate[rr];
            eidx[t * 8 + sel_rank[rr]] = lane; inv[t * 8 + sel_rank[rr]] = pos; }
    }
}

constexpr int M3_PL = 131072, M3_CNT = 147456, M3_OFF = 147456 + 272;
__device__ __forceinline__ void phase_moe3n(const Frame& F, const bf16* H, const bf16* HSp, const int* eidx, const bf16* WD, const bf16* WSD,
                                            const float* Y1, const float* ST1, const float* g1, const float* b1, float* Y2, float* PST2) {
    LAS int* out = (LAS int*)F.lds; LAS unsigned short* plist = (LAS unsigned short*)(F.lds + M3_PL); LAS int* cnt = (LAS int*)(F.lds + M3_CNT); LAS int* off = (LAS int*)(F.lds + M3_OFF);
    const int tid = F.tid, lane = F.lane, w = F.wave, r = lane & 15, q = lane >> 4;
    for (int u = F.bid; u < 1024; u += F.G) {
        int nc = (u & 7) | ((u >> 7) << 3), tb = (u >> 3) & 15;
        if (F.G == 256) { const int i = u >> 8, x = u & 7, j = (u >> 3) & 31; tb = 2 * x + (i >> 1); nc = 32 * (i & 1) + j; }
        __syncthreads();
#pragma unroll
        for (int j = 0; j < 16; ++j) ((LAS v4u*)out)[tid + 512 * j] = (v4u){0u, 0u, 0u, 0u};
        if (tid < 66) cnt[tid] = 0;
        __syncthreads();
        int ee[16], pp[16];
        { const v4u* ep = (const v4u*)(eidx + ((size_t)tb * 1024 + 2 * tid) * 8); const v4u e0 = ep[0], e1 = ep[1], e2 = ep[2], e3 = ep[3];
          ee[0] = e0.x; ee[1] = e0.y; ee[2] = e0.z; ee[3] = e0.w; ee[4] = e1.x; ee[5] = e1.y; ee[6] = e1.z; ee[7] = e1.w;
          ee[8] = e2.x; ee[9] = e2.y; ee[10] = e2.z; ee[11] = e2.w; ee[12] = e3.x; ee[13] = e3.y; ee[14] = e3.z; ee[15] = e3.w; }
#pragma unroll
        for (int j = 0; j < 16; ++j) pp[j] = __hip_atomic_fetch_add(&cnt[ee[j]], 1, __ATOMIC_RELAXED, __HIP_MEMORY_SCOPE_WORKGROUP);
        __syncthreads();
        if (w == 0) { int c = cnt[lane], x = c;
#pragma unroll
            for (int o = 1; o < 64; o <<= 1) { const int y = __builtin_amdgcn_ds_bpermute(((lane - o) & 63) << 2, x); if (lane >= o) x += y; }
            off[lane] = x - c; if (lane == 63) off[64] = x; }
        __syncthreads();
#pragma unroll
        for (int j = 0; j < 16; ++j) plist[off[ee[j]] + pp[j]] = (unsigned short)(tid * 16 + j);
        __syncthreads();
        const char* Hb = (const char*)H + (size_t)tb * 8192 * 256 + q * 16;
        const char* HSb = (const char*)HSp + (size_t)tb * 1024 * 512 + q * 16;
        const char* Bb = (const char*)WD + ((size_t)nc * 32 + r) * 256 + q * 16;
        const char* BSb = (const char*)WSD + ((size_t)nc * 32 + r) * 512 + q * 16;
#define M3_NR(sg) ((sg) < 8 ? __builtin_amdgcn_readfirstlane(cnt[w + 8 * (sg)]) : 128)
#define M3_RB(sg) ((sg) < 8 ? __builtin_amdgcn_readfirstlane(off[w + 8 * (sg)]) : 0)
#define M3_GLD(dst, ptr, OFF) asm volatile("global_load_dwordx4 %0, %1, off offset:" #OFF : "=&v"(dst) : "v"(ptr) : "memory")
#define M3_LOADB(dst, sg) do { const char* _b0 = (sg) < 8 ? Bb + (size_t)(w + 8 * (sg)) * 524288 : BSb + ((sg) - 8) * 256; const char* _b1 = _b0 + ((sg) < 8 ? 4096 : 8192); \
            M3_GLD(dst[0][0], _b0, 0); M3_GLD(dst[0][1], _b0, 64); M3_GLD(dst[0][2], _b0, 128); M3_GLD(dst[0][3], _b0, 192); \
            M3_GLD(dst[1][0], _b1, 0); M3_GLD(dst[1][1], _b1, 64); M3_GLD(dst[1][2], _b1, 128); M3_GLD(dst[1][3], _b1, 192); } while (0)
#define M3_LOADA(dst, sg, bb, nr, rbs) do { int _i = 16 * (bb) + r; _i = _i < (nr) ? _i : (nr) - 1; const unsigned _rid = plist[(rbs) + _i]; \
            const char* _a = (sg) < 8 ? Hb + (size_t)_rid * 256 : ((sg) < 10 ? HSb + (size_t)(128 * w + _i) * 512 + ((sg) - 8) * 256 : Hb); \
            M3_GLD(dst[0], _a, 0); M3_GLD(dst[1], _a, 64); M3_GLD(dst[2], _a, 128); M3_GLD(dst[3], _a, 192); } while (0)
#define M3_ADV(sg, bb, nr, rbs) do { if ((sg) < 10) { ++(bb); if ((bb) * 16 >= (nr)) { (bb) = 0; do { ++(sg); } while ((sg) < 8 && M3_NR(sg) == 0); if ((sg) < 10) { (nr) = M3_NR(sg); (rbs) = M3_RB(sg); } } } } while (0)
#define M3_WAITA(AS) asm volatile("s_waitcnt vmcnt(12)" : "+v"(AS[0]), "+v"(AS[1]), "+v"(AS[2]), "+v"(AS[3]) :: "memory")
#define M3_WAITB(N) asm volatile("s_waitcnt vmcnt(" #N ")" : "+v"(Bn[0][0]), "+v"(Bn[0][1]), "+v"(Bn[0][2]), "+v"(Bn[0][3]), "+v"(Bn[1][0]), "+v"(Bn[1][1]), "+v"(Bn[1][2]), "+v"(Bn[1][3]) :: "memory")
#define M3_STEP(AS) if (cseg < 10) { \
              \
            int tk[4]; bool ok[4]; unsigned pl[4]; const int rt_ = cseg < 8; \
            _Pragma("unroll") for (int i = 0; i < 4; ++i) { const int idx = 16 * cbt + 4 * q + i; ok[i] = idx < cnr; const int ic = ok[i] ? idx : cnr - 1; pl[i] = plist[crbs + ic]; tk[i] = 128 * w + ic; } \
            _Pragma("unroll") for (int i = 0; i < 4; ++i) tk[i] = rt_ ? (int)(pl[i] >> 3) : tk[i]; \
            M3_WAITA(AS); \
            f32x4 acc[2]; \
            _Pragma("unroll") for (int nt = 0; nt < 2; ++nt) { acc[nt] = (f32x4){0.f, 0.f, 0.f, 0.f}; \
                _Pragma("unroll") for (int kk = 0; kk < 4; ++kk) acc[nt] = __builtin_amdgcn_mfma_f32_16x16x32_bf16(__builtin_bit_cast(bf16x8, AS[kk]), __builtin_bit_cast(bf16x8, Bc[nt][kk]), acc[nt], 0, 0, 0); } \
              \
            _Pragma("unroll") for (int i = 0; i < 4; ++i) { const long long lo_ = ok[i] ? (long long)__float2int_rn(acc[0][i] * 4194304.0f) : 0ll, hi_ = ok[i] ? (long long)__float2int_rn(acc[1][i] * 4194304.0f) : 0ll; \
                (void)__hip_atomic_fetch_add((LAS unsigned long long*)out + tk[i] * 16 + r, (unsigned long long)((hi_ << 32) + lo_), __ATOMIC_RELAXED, __HIP_MEMORY_SCOPE_WORKGROUP); } \
            M3_LOADA(AS, pseg, pbt, pnr, prbs); M3_ADV(pseg, pbt, pnr, prbs); \
            { const int old_ = cseg, nbat_ = (cnr + 15) >> 4; M3_ADV(cseg, cbt, cnr, crbs); \
              if (cseg != old_ && cseg < 10) { \
                  if (nbat_ == 1) M3_WAITB(4); else if (nbat_ == 2) M3_WAITB(8); else if (nbat_ == 3) M3_WAITB(12); else M3_WAITB(16); \
                  _Pragma("unroll") for (int nt = 0; nt < 2; ++nt) _Pragma("unroll") for (int kk = 0; kk < 4; ++kk) Bc[nt][kk] = Bn[nt][kk]; \
                  int nb_ = cseg; do { ++nb_; } while (nb_ < 8 && M3_NR(nb_) == 0); if (nb_ >= 10) nb_ = 9; M3_LOADB(Bn, nb_); } } }
        int cseg = -1, cbt = 0, cnr = 0, crbs = 0;
        do { ++cseg; } while (cseg < 8 && M3_NR(cseg) == 0);
        cnr = M3_NR(cseg); crbs = M3_RB(cseg);
        int pseg = cseg, pbt = 0, pnr = cnr, prbs = crbs;
        v4u Bc[2][4], Bn[2][4], A0[4], A1[4], A2[4], A3[4];
        M3_LOADB(Bc, cseg);
        M3_LOADA(A0, pseg, pbt, pnr, prbs); M3_ADV(pseg, pbt, pnr, prbs);
        M3_LOADA(A1, pseg, pbt, pnr, prbs); M3_ADV(pseg, pbt, pnr, prbs);
        M3_LOADA(A2, pseg, pbt, pnr, prbs); M3_ADV(pseg, pbt, pnr, prbs);
        M3_LOADA(A3, pseg, pbt, pnr, prbs); M3_ADV(pseg, pbt, pnr, prbs);
        { int nb_ = cseg; do { ++nb_; } while (nb_ < 8 && M3_NR(nb_) == 0); if (nb_ >= 10) nb_ = 9; M3_LOADB(Bn, nb_); }
        asm volatile("s_waitcnt vmcnt(0)" : "+v"(Bc[0][0]), "+v"(Bc[0][1]), "+v"(Bc[0][2]), "+v"(Bc[0][3]), "+v"(Bc[1][0]), "+v"(Bc[1][1]), "+v"(Bc[1][2]), "+v"(Bc[1][3]) :: "memory");
#pragma unroll 1
        while (cseg < 10) { M3_STEP(A0) M3_STEP(A1) M3_STEP(A2) M3_STEP(A3) }
        asm volatile("s_waitcnt vmcnt(0)" : "+v"(A0[0]), "+v"(A0[1]), "+v"(A0[2]), "+v"(A0[3]), "+v"(A1[0]), "+v"(A1[1]), "+v"(A1[2]), "+v"(A1[3]), "+v"(A2[0]), "+v"(A2[1]), "+v"(A2[2]), "+v"(A2[3]),
                     "+v"(A3[0]), "+v"(A3[1]), "+v"(A3[2]), "+v"(A3[3]), "+v"(Bn[0][0]), "+v"(Bn[0][1]), "+v"(Bn[0][2]), "+v"(Bn[0][3]), "+v"(Bn[1][0]), "+v"(Bn[1][1]), "+v"(Bn[1][2]), "+v"(Bn[1][3]) :: "memory");
#undef M3_NR
#undef M3_RB
#undef M3_GLD
#undef M3_LOADB
#undef M3_LOADA
#undef M3_ADV
#undef M3_WAITA
#undef M3_WAITB
#undef M3_STEP
        __syncthreads();
        { const int c4 = lane & 7, rs = lane >> 3, col = nc * 32 + 4 * c4;
          const f32x4 gv = *(const f32x4*)(g1 + col), bv = *(const f32x4*)(b1 + col);
#pragma unroll 4
          for (int it = 0; it < 16; ++it) { const int rl = 128 * w + 8 * it + rs; const size_t row = (size_t)tb * 1024 + rl;
              const f32x4 yv = *(const f32x4*)(Y1 + row * D + col); const f32x2 sv = *(const f32x2*)(ST1 + 2 * row);
              f32x4 tv; { const int nt = c4 >> 2, r0 = (4 * c4) & 15;
#pragma unroll
                  for (int j = 0; j < 4; ++j) { const v2u cell = *(const LAS v2u*)(out + rl * 32 + 2 * (r0 + j)); const int lo = (int)cell.x, hi = (int)cell.y + (lo < 0 ? 1 : 0); tv[j] = (float)(nt ? hi : lo) * (1.0f / 4194304.0f); } }
              const f32x4 y = ((yv - sv.x) * sv.y * gv + bv) * ALPHA + tv;
              *(f32x4*)(Y2 + row * D + col) = y;
              float sm = (y[0] + y[1]) + (y[2] + y[3]), sq = (y[0] * y[0] + y[1] * y[1]) + (y[2] * y[2] + y[3] * y[3]);
#pragma unroll
              for (int o = 1; o < 8; o <<= 1) { sm += shfl_x(sm, o, lane); sq += shfl_x(sq, o, lane); }
              if (c4 == 0) *(f32x2*)(PST2 + (row * 64 + nc) * 2) = (f32x2){sm, sq}; } }
    }
}

__device__ __forceinline__ void phase_moe4n(const Frame& F, const float* Y2, const float* pst, const float* gain, const float* bias, float* ST2, bf16* XBo, float* OUT, int last) {
    const int gw = F.bid * 8 + F.wave, NGW = F.G * 8, lane = F.lane;
    for (int t = gw; t < T; t += NGW) {
        f32x4 v[8];
#pragma unroll
        for (int j = 0; j < 8; ++j) v[j] = *(const f32x4*)(Y2 + (size_t)t * D + 4 * lane + 256 * j);
        const f32x2 pv = *(const f32x2*)(pst + ((size_t)t * 64 + lane) * 2);
        const float mean = wave_sum(pv.x, lane) * (1.0f / D); const float var = fmaxf(wave_sum(pv.y, lane) * (1.0f / D) - mean * mean, 0.f); const float rstd = 1.0f / sqrtf(var + LN_EPS);
        if (lane == 0) *(f32x2*)(ST2 + 2 * (size_t)t) = (f32x2){mean, rstd};
#pragma unroll
        for (int j = 0; j < 8; ++j) { const int c = 4 * lane + 256 * j; const f32x4 o = (v[j] - mean) * rstd * *(const f32x4*)(gain + c) + *(const f32x4*)(bias + c);
            if (last) *(f32x4*)(OUT + (size_t)t * D + c) = o;
            else { v2u wb; wb.x = pk2(o[0], o[1]); wb.y = pk2(o[2], o[3]); *(v2u*)(XBo + (size_t)t * D + c) = wb; } }
    }
}


__device__ __forceinline__ void phase_moe4q(const Frame& F, const bf16* X1, bf16* Y2, const unsigned char* Yq, const float* Ysc, const int* eidx, const int* inv, const float* gain, const float* bias, float* ST2, bf16* XBo, float* OUT, int last) {
    const LAS int* tpref = (const LAS int*)(F.lds + LDS_TAB);
    const int gw = F.bid * 8 + F.wave, NGW = F.G * 8, lane = F.lane;
    for (int t = gw; t < T; t += NGW) {
        int rowi = 0; if (lane < 8) { const int e = eidx[t * 8 + lane], ps = inv[t * 8 + lane]; rowi = tpref[e] * 256 + ps; } else if (lane < 10) rowi = tpref[56 + lane] * 256 + t;
        v4u pv[2][2], yv[10][2]; float sc[10][2];
#pragma unroll
        for (int j = 0; j < 2; ++j) { pv[j][0] = *(const v4u*)(X1 + (size_t)t * D + 16 * lane + 1024 * j); pv[j][1] = *(const v4u*)(X1 + (size_t)t * D + 16 * lane + 1024 * j + 8); }
#pragma unroll
        for (int k = 0; k < 10; ++k) { const size_t row = (size_t)__builtin_amdgcn_readlane(rowi, k);
#pragma unroll
            for (int j = 0; j < 2; ++j) { yv[k][j] = *(const v4u*)(Yq + row * D + 16 * lane + 1024 * j); sc[k][j] = Ysc[row * 16 + 8 * j + (lane >> 3)]; } }
#pragma unroll
        for (int k = 0; k < 10; ++k) asm volatile("" : "+v"(yv[k][0]), "+v"(yv[k][1]), "+v"(sc[k][0]), "+v"(sc[k][1]));
        float v[2][16];
#pragma unroll
        for (int j = 0; j < 2; ++j) { float f0[8], f1[8]; unpack8(pv[j][0], f0); unpack8(pv[j][1], f1);
            const float ss = (((sc[0][j] + sc[1][j]) + (sc[2][j] + sc[3][j])) + ((sc[4][j] + sc[5][j]) + (sc[6][j] + sc[7][j]))) + (sc[8][j] + sc[9][j]);
#pragma unroll
            for (int i = 0; i < 8; ++i) { v[j][i] = ALPHA * f0[i] - 128.f * ss; v[j][8 + i] = ALPHA * f1[i] - 128.f * ss; } }
#pragma unroll
        for (int k = 0; k < 10; ++k)
#pragma unroll
            for (int j = 0; j < 2; ++j) { const float s_ = sc[k][j]; const unsigned q[4] = {yv[k][j].x, yv[k][j].y, yv[k][j].z, yv[k][j].w};
#pragma unroll
                for (int d = 0; d < 4; ++d) { v[j][4 * d + 0] += s_ * (float)(q[d] & 0xffu); v[j][4 * d + 1] += s_ * (float)((q[d] >> 8) & 0xffu); v[j][4 * d + 2] += s_ * (float)((q[d] >> 16) & 0xffu); v[j][4 * d + 3] += s_ * (float)(q[d] >> 24); } }
        float sm = 0.f;
#pragma unroll
        for (int j = 0; j < 2; ++j)
#pragma unroll
            for (int i = 0; i < 16; i += 4) sm += (v[j][i] + v[j][i + 1]) + (v[j][i + 2] + v[j][i + 3]);
        const float mean = wave_sum(sm, lane) * (1.0f / D); float sq = 0.f;
#pragma unroll
        for (int j = 0; j < 2; ++j)
#pragma unroll
            for (int i = 0; i < 16; ++i) { const float d = v[j][i] - mean; sq += d * d; }
        const float rstd = 1.0f / sqrtf(wave_sum(sq, lane) * (1.0f / D) + LN_EPS);
        if (lane == 0) *(f32x2*)(ST2 + 2 * (size_t)t) = (f32x2){mean, rstd};
#pragma unroll
        for (int j = 0; j < 2; ++j)
#pragma unroll
            for (int h = 0; h < 2; ++h) { const int c = 16 * lane + 1024 * j + 8 * h; const float* vv = &v[j][8 * h];
                if (!last) { v4u yw; yw.x = pk2(vv[0], vv[1]); yw.y = pk2(vv[2], vv[3]); yw.z = pk2(vv[4], vv[5]); yw.w = pk2(vv[6], vv[7]); *(v4u*)(Y2 + (size_t)t * D + c) = yw; }
                const f32x4 g0 = *(const f32x4*)(gain + c), g1 = *(const f32x4*)(gain + c + 4), b0 = *(const f32x4*)(bias + c), b1 = *(const f32x4*)(bias + c + 4);
                const f32x4 o0 = ((f32x4){vv[0], vv[1], vv[2], vv[3]} - mean) * rstd * g0 + b0, o1 = ((f32x4){vv[4], vv[5], vv[6], vv[7]} - mean) * rstd * g1 + b1;
                if (last) { *(f32x4*)(OUT + (size_t)t * D + c) = o0; *(f32x4*)(OUT + (size_t)t * D + c + 4) = o1; }
                else { v4u wb; wb.x = pk2(o0[0], o0[1]); wb.y = pk2(o0[2], o0[3]); wb.z = pk2(o1[0], o1[1]); wb.w = pk2(o1[2], o1[3]); *(v4u*)(XBo + (size_t)t * D + c) = wb; } }
    }
}

__device__ __forceinline__ void phase_downproj3(const Frame& F, const bf16* H, const bf16* WD, const bf16* HSp, const bf16* WSD, unsigned char* Yq, float* Ysc, int NT) {
    const LAS int* tpref = (const LAS int*)(F.lds + LDS_TAB); const LAS int* cl = (const LAS int*)(F.lds + LDS_TAB + 512);
    LAS unsigned char* lds = F.lds;
    const int tid = F.tid, lane = F.lane, w = F.wave, fr = lane & 15, fq = lane >> 4;
    unsigned rbB[2], cbB[2];
#pragma unroll
    for (int i = 0; i < 2; ++i) { int R_, C_; g8::stage_rc(tid * 16 + i * 8192, R_, C_); rbB[i] = (unsigned)((R_ & ~31) + g8::perm32(R_ & 31)); cbB[i] = (unsigned)C_ * 2u; }
    const unsigned ldsw = (unsigned)w * 1024u, lbase = (unsigned)(size_t)lds;
    int boffg[4];
#pragma unroll
    for (int g = 0; g < 4; ++g) boffg[g] = g8::lds_byte(32 * g + fr, fq * 8);
    LAS unsigned char* stg = lds + 65536 + w * (32 * 144);
    const int NU = NT * 4;
    int u = F.bid; if (u >= NU) return;
#define DP3_UNITINFO(uu, E0, EXP, NV) do { const int tl_ = (uu) >> 2; int e_ = (E0); while (__builtin_amdgcn_readfirstlane(tpref[e_ + 1]) <= tl_) ++e_; EXP = e_; \
        NV = __builtin_amdgcn_readfirstlane(cl[e_]) - (tl_ - __builtin_amdgcn_readfirstlane(tpref[e_])) * 256; } while (0)
#define DP3_GLDS(gsrc, ldsdst) do { unsigned keep_; asm volatile("s_mov_b32 %0, m0\n\ts_mov_b32 m0, %2\n\ts_nop 0\n\tglobal_load_lds_dwordx4 %1, off\n\ts_mov_b32 m0, %0" : "=&s"(keep_) : "v"(gsrc), "s"(ldsdst) : "memory"); } while (0)
#define DP3_STAGE(slot, gb, bs) do { const unsigned v0_ = rbB[0] * (unsigned)(bs) + cbB[0], v1_ = rbB[1] * (unsigned)(bs) + cbB[1]; _Pragma("unroll") for (int kt = 0; kt < 2; ++kt) { \
        DP3_GLDS((const void*)((gb) + kt * 128 + v0_), lbase + (unsigned)((slot) * 32768 + kt * 16384) + ldsw); \
        DP3_GLDS((const void*)((gb) + kt * 128 + v1_), lbase + (unsigned)((slot) * 32768 + kt * 16384) + ldsw + 8192u); } } while (0)
#define DP3_SRC(uu, ee, AB, AS, BB, BS) do { const int tl_ = (uu) >> 2, cu_ = ((uu) & 3) * 512; \
        if ((ee) < 64) { AB = (const char*)(H + (size_t)tl_ * 256 * EDIM); AS = EDIM * 2; BB = (const char*)(WD + (size_t)(ee) * D * EDIM + (size_t)cu_ * EDIM); BS = EDIM * 2; } \
        else { const int t0_ = (tl_ - __builtin_amdgcn_readfirstlane(tpref[ee])) * 256; AB = (const char*)(HSp + (size_t)t0_ * SDIM + ((ee) - 64) * EDIM); AS = SDIM * 2; \
               BB = (const char*)(WSD + (size_t)cu_ * SDIM + ((ee) - 64) * EDIM); BS = SDIM * 2; } } while (0)
    int ecur, nvcur; DP3_UNITINFO(u, 0, ecur, nvcur);
    const char* abc; const char* gbc; int asc, bsc; DP3_SRC(u, ecur, abc, asc, gbc, bsc);
    bf16x8 A[2][4], An[2][4];
    { const char* ap_ = abc + (size_t)(32 * w + fr) * asc + 16 * fq;
#pragma unroll
      for (int m = 0; m < 2; ++m)
#pragma unroll
          for (int kk = 0; kk < 4; ++kk) A[m][kk] = *(const bf16x8*)(ap_ + (size_t)m * 16 * asc + 64 * kk); }
    DP3_STAGE(0, gbc, bsc);
    asm volatile("s_waitcnt vmcnt(0)" ::: "memory");
#pragma unroll 1
    for (;;) {
        const int un = (u + F.G < NU) ? u + F.G : u; int enx, nvnx; DP3_UNITINFO(un, ecur, enx, nvnx);
        const char* abn; const char* gbn; int asn, bsn; DP3_SRC(un, enx, abn, asn, gbn, bsn);
        const int tile = u >> 2, colu = (u & 3) * 512;
        float scq[2][4];
#pragma unroll
        for (int c = 0; c < 4; ++c) {
            if (c == 0) asm volatile("s_waitcnt vmcnt(5)" ::: "memory"); else asm volatile("s_waitcnt vmcnt(4)" ::: "memory");
            __builtin_amdgcn_s_barrier();
            if (c == 3) { const char* ap_ = abn + (size_t)(32 * w + fr) * asn + 16 * fq;
#pragma unroll
                for (int m = 0; m < 2; ++m) { const char* am_ = ap_ + (size_t)m * 16 * asn;
                    asm volatile("global_load_dwordx4 %0, %1, off" : "=&v"(An[m][0]) : "v"(am_) : "memory"); asm volatile("global_load_dwordx4 %0, %1, off offset:64" : "=&v"(An[m][1]) : "v"(am_) : "memory");
                    asm volatile("global_load_dwordx4 %0, %1, off offset:128" : "=&v"(An[m][2]) : "v"(am_) : "memory"); asm volatile("global_load_dwordx4 %0, %1, off offset:192" : "=&v"(An[m][3]) : "v"(am_) : "memory"); } }
            { const char* gnext = (c < 3) ? gbc + (size_t)(c + 1) * 128 * bsc : gbn; const int bnext = (c < 3) ? bsc : bsn; DP3_STAGE((c + 1) & 1, gnext, bnext); }
            __builtin_amdgcn_sched_barrier(0);
            f32x4 acc[2][4][2];
#pragma unroll
            for (int g = 0; g < 4; ++g) { bf16x8 Bf[2][4];
#pragma unroll
                for (int n = 0; n < 2; ++n)
#pragma unroll
                    for (int kk = 0; kk < 4; ++kk) Bf[n][kk] = *(const LAS bf16x8*)(lds + (c & 1) * 32768 + (kk >> 1) * 16384 + boffg[g] + n * 2048 + (kk & 1) * 1024);
#pragma unroll
                for (int m = 0; m < 2; ++m)
#pragma unroll
                    for (int n = 0; n < 2; ++n) { acc[m][g][n] = (f32x4){0.f, 0.f, 0.f, 0.f};
#pragma unroll
                        for (int kk = 0; kk < 4; ++kk) acc[m][g][n] = __builtin_amdgcn_mfma_f32_16x16x32_bf16(Bf[n][kk], A[m][kk], acc[m][g][n], 0, 0, 0); } }
#pragma unroll
            for (int m = 0; m < 2; ++m) {
                float am0 = 0.f, am1 = 0.f;
#pragma unroll
                for (int g = 0; g < 4; ++g)
#pragma unroll
                    for (int n = 0; n < 2; ++n) { am0 = fmaxf(fmaxf(am0, fabsf(acc[m][g][n][0])), fabsf(acc[m][g][n][1])); am1 = fmaxf(fmaxf(am1, fabsf(acc[m][g][n][2])), fabsf(acc[m][g][n][3])); }
                float am = fmaxf(am0, am1);
                am = fmaxf(am, shfl_x(am, 16, lane)); am = fmaxf(am, shfl_x(am, 32, lane));
                am = fminf(am, 3.0e38f);
                const float isc = am > 0.f ? 127.0f * __builtin_amdgcn_rcpf(am) : 0.f;
                scq[m][c] = am * (1.0f / 127.0f);
                const f32x2_t isc2 = (f32x2_t){isc, isc}, mg2 = (f32x2_t){8388736.0f, 8388736.0f};
#pragma unroll
                for (int g = 0; g < 4; ++g) { unsigned qd[2];
#pragma unroll
                    for (int n = 0; n < 2; ++n) {
                        const f32x2_t tl = __builtin_elementwise_fma((f32x2_t){acc[m][g][n][0], acc[m][g][n][1]}, isc2, mg2), th = __builtin_elementwise_fma((f32x2_t){acc[m][g][n][2], acc[m][g][n][3]}, isc2, mg2);
                        const float f0_ = tl.x, f1_ = tl.y, f2_ = th.x, f3_ = th.y;
                        qd[n] = __builtin_amdgcn_perm(__builtin_bit_cast(unsigned, f1_), __builtin_bit_cast(unsigned, f0_), 0x0c0c0400u) | __builtin_amdgcn_perm(__builtin_bit_cast(unsigned, f3_), __builtin_bit_cast(unsigned, f2_), 0x04000c0cu); }
                    *(LAS v2u*)(stg + (16 * m + fr) * 144 + 32 * g + 8 * fq) = (v2u){qd[0], qd[1]}; } }
#pragma unroll
            for (int it = 0; it < 4; ++it) { const int rr = 8 * it + (lane >> 3);
                const v4u o = *(const LAS v4u*)(stg + rr * 144 + (lane & 7) * 16);
                *(v4u*)(Yq + (size_t)(tile * 256 + 32 * w + rr) * D + colu + 128 * c + 16 * (lane & 7)) = o; }
            if (c == 3) { const f32x4 so = fq == 0 ? (f32x4){scq[0][0], scq[0][1], scq[0][2], scq[0][3]} : (f32x4){scq[1][0], scq[1][1], scq[1][2], scq[1][3]};
                if (fq < 2) *(f32x4*)(Ysc + (size_t)(tile * 256 + 32 * w + 16 * fq + fr) * 16 + (colu >> 7)) = so; }
            __builtin_amdgcn_sched_barrier(0);
        }
        asm volatile("s_waitcnt vmcnt(9)" : "+v"(An[0][0]), "+v"(An[0][1]), "+v"(An[0][2]), "+v"(An[0][3]), "+v"(An[1][0]), "+v"(An[1][1]), "+v"(An[1][2]), "+v"(An[1][3]) :: "memory");
        if (un == u) break;
#pragma unroll
        for (int m = 0; m < 2; ++m)
#pragma unroll
            for (int kk = 0; kk < 4; ++kk) A[m][kk] = An[m][kk];
        u = un; ecur = enx; nvcur = nvnx; abc = abn; asc = asn; gbc = gbn; bsc = bsn;
    }
    asm volatile("s_waitcnt vmcnt(0)" ::: "memory");
#undef DP3_UNITINFO
#undef DP3_STAGE
#undef DP3_GLDS
#undef DP3_SRC
}

enum { PH_PRO = 0, PH_POOL_G1, PH_POOL_P, PH_POOL_G2, PH_POOL_G3, PH_DIL_G1, PH_DIL_ATT, PH_DIL_CMB, PH_DIL_G2, PH_CONV_G1, PH_CONV_E, PH_CONV_G2, PH_MOE1, PH_MOE2, PH_MOE3, PH_MOE4, PH_COUNT };

template <int PH>
__device__ __forceinline__ void run_phase(const Frame& Fin, const Args& args_, const int L) {
    Frame F = Fin; { int w_ = Fin.wave, l_; asm volatile("" : "+s"(w_)); asm volatile("v_mbcnt_lo_u32_b32 %0, -1, 0\n\tv_mbcnt_hi_u32_b32 %0, -1, %0" : "=v"(l_)); F.wave = w_; F.lane = l_; F.tid = w_ * 64 + l_; }
    unsigned char* ws; { GAS unsigned char* wsg = (GAS unsigned char*)Fin.ws; asm volatile("" : "+s"(wsg)); ws = (unsigned char*)wsg; } F.ws = ws; F.ctl = (unsigned*)(ws + WS_CTL);
    KP kp = (KP)__builtin_amdgcn_kernarg_segment_ptr(); asm volatile("" : "+s"(kp)); (void)args_;
    { unsigned l_ = (unsigned)(size_t)Fin.lds; asm volatile("" : "+s"(l_)); F.lds = (LAS unsigned char*)(size_t)l_; }
    LAS unsigned char* ring = F.lds; int c = (int)blockIdx.x; { int g_ = Fin.G; asm volatile("" : "+s"(c), "+s"(g_)); F.G = g_; F.bid = c; }
    const float* xres = ain(kp, IN_X); const bf16* xresb = (const bf16*)(ws + WS_Y2F);
    const float* st2 = (const float*)(ws + WS_ST2); float* pstp = (float*)(ws + WS_PST);
    const float* g2p = ain(kp, IN_LNG) + (size_t)((L > 0 ? L - 1 : 0) * 2 + 1) * D; const float* b2p = ain(kp, IN_LNB) + (size_t)((L > 0 ? L - 1 : 0) * 2 + 1) * D;
    const bf16* xb = (const bf16*)(ws + WS_XB);
    bf16* yf = (bf16*)(ws + WS_YF);
    unsigned char* big = ws + WS_BIG;
    const int ia = L / 3;
    if constexpr (PH == PH_PRO) { phase_prologue(F, kp); }
    if constexpr (PH == PH_POOL_G1) { g8::DenseSched S; S.init(xb, (const bf16*)(ws + WS_W_POOL_IN) + (size_t)ia * D * D, T, D, D, D, F.G, c);
        g8::EpiBf16 E{(bf16*)(big + BG_U), D, 0}; g8::gemm_phase<g8::EpiBf16, g8::DenseSched, false>(ring, F.tid, D, D, D, S, E); }
    if constexpr (PH == PH_POOL_P) { phase_pool(F, (const bf16*)(big + BG_U), (bf16*)(big + BG_PL)); }
    if constexpr (PH == PH_POOL_G2) { g8::DenseSched S; S.init((const bf16*)(big + BG_PL), (const bf16*)(ws + WS_W_POOL_G) + (size_t)ia * D * 512, T, D, D, 512, F.G, c); S.agrp_shift = 1; S.agrp_stride = 512 * 2;
        g8::EpiScaleBf16 E{(bf16*)(big + BG_MX), D, ain(kp, IN_PSC) + (size_t)ia * D}; g8::gemm_phase<g8::EpiScaleBf16, g8::DenseSched, false>(ring, F.tid, 512, D, 512, S, E); }
    if constexpr (PH == PH_POOL_G3) { g8::DenseSched S; S.init((const bf16*)(big + BG_MX), (const bf16*)(ws + WS_W_POOL_OUT) + (size_t)ia * D * D, T, D, D, D, F.G, c);
        g8::EpiResidLN E{xres, xresb, st2, g2p, b2p, yf, pstp, L > 0}; g8::gemm_phase<g8::EpiResidLN, g8::DenseSched, false>(ring, F.tid, D, D, D, S, E); }
    if constexpr (PH == PH_DIL_G1) { g8::DenseSched S; S.init(xb, (const bf16*)(ws + WS_W_DIL_QKV), T, QKVC, D, D, F.G, c);
        g8::EpiBf16 E{(bf16*)(big + BG_QKV), QKVC, 1}; g8::gemm_phase<g8::EpiBf16, g8::DenseSched, false>(ring, F.tid, D, D, D, S, E); }
    if constexpr (PH == PH_DIL_ATT) { phase_attn(F, (const bf16*)(big + BG_QKV), ain(kp, IN_RELB), (bf16*)(big + BG_OG), (float*)(big + BG_LSE)); }
    if constexpr (PH == PH_DIL_CMB) { phase_combine(F, (const bf16*)(big + BG_OG), (const float*)(big + BG_LSE), (bf16*)(big + BG_O)); }
    if constexpr (PH == PH_DIL_G2) { g8::DenseSched S; S.init((const bf16*)(big + BG_O), (const bf16*)(ws + WS_W_DIL_OUT), T, D, DILW, DILW, F.G, c);
        g8::EpiResidLN E{xres, xresb, st2, g2p, b2p, yf, pstp, L > 0}; g8::gemm_phase<g8::EpiResidLN, g8::DenseSched, false>(ring, F.tid, DILW, DILW, DILW, S, E); }
    if constexpr (PH == PH_CONV_G1) { g8::DenseSched S; S.init(xb, (const bf16*)(ws + WS_W_CONV_IN), T, 3 * D, D, D, F.G, c);
        g8::EpiConvIn E{(bf16*)(big + BG_UC), (bf16*)(big + BG_BG)}; g8::gemm_phase<g8::EpiConvIn, g8::DenseSched, false>(ring, F.tid, D, D, D, S, E); }
    if constexpr (PH == PH_CONV_E) { phase_conv(F, (const bf16*)(big + BG_UC), (const bf16*)(big + BG_BG), ain(kp, IN_CW), (bf16*)(big + BG_Z)); }
    if constexpr (PH == PH_CONV_G2) { g8::DenseSched S; S.init((const bf16*)(big + BG_Z), (const bf16*)(ws + WS_W_CONV_OUT), T, D, D, D, F.G, c);
        g8::EpiResidLN E{xres, xresb, st2, g2p, b2p, yf, pstp, L > 0}; g8::gemm_phase<g8::EpiResidLN, g8::DenseSched, false>(ring, F.tid, D, D, D, S, E); }
    unsigned* cnt = F.ctl + CW_CNT + L * 64 * 16;
    float* x1f = (float*)(ws + WS_X1F); bf16* x1b = (bf16*)(ws + WS_X1B);
    int* ltok = (int*)(ws + WS_LTOK); float* lgate = (float*)(ws + WS_LGATE); int* eidx = (int*)(ws + WS_EIDX); int* inv = (int*)(ws + WS_INV);
    bf16* HB = (bf16*)(ws + WS_HB); bf16* HS = (bf16*)(ws + WS_HS); bf16* Yr = (bf16*)(ws + WS_BIG);
    if constexpr (PH == PH_MOE1) {
        const float* g1 = ain(kp, IN_LNG) + (size_t)(L * 2 + 0) * D; const float* b1 = ain(kp, IN_LNB) + (size_t)(L * 2 + 0) * D;
        phase_moe1n(F, yf, pstp, g1, b1, (const bf16*)(ws + WS_RWH) + (size_t)L * NEXP * D, (const bf16*)(ws + WS_RWL) + (size_t)L * NEXP * D, ain(kp, IN_RB) + (size_t)L * NEXP,
                    x1b, (float*)(ws + WS_ST1), cnt, ltok, lgate, eidx, inv); }
    if constexpr (PH == PH_MOE2) {
        const int NT = build_tiles(F, cnt);
        { g8::ExpertSched<1, true> S; S.tpref = (const LAS int*)(F.lds + LDS_TAB); S.cnt = (const LAS int*)(F.lds + LDS_TAB + 512); S.A = (const char*)x1b; S.B = (const char*)((const bf16*)(ws + WS_W_EX_GU) + (size_t)L * 64 * 256 * D);
          S.tok = ltok; S.b_exp = (size_t)256 * D * 2; S.b_tile = 0; S.a_tile = 0; S.NU = NT; S.G = F.G; S.c = c;
          g8::EpiExpertGU E{HB}; g8::gemm_phase<g8::EpiExpertGU, g8::ExpertSched<1, true>, true>(ring, F.tid, D, D, D, S, E); }
        { const int rot = (c - (NT % F.G) + F.G) % F.G;
          g8::DenseSched S; S.init(x1b, (const bf16*)(ws + WS_W_SH_GU) + (size_t)L * 512 * D, T, 512, D, D, F.G, rot);
          int t2 = F.tid; asm volatile("" : "+v"(t2));
          g8::EpiSharedGU E{HS}; g8::gemm_phase<g8::EpiSharedGU, g8::DenseSched, false>(ring, t2, D, D, D, S, E); } }
    if constexpr (PH == PH_MOE3) {
        const float* g1 = ain(kp, IN_LNG) + (size_t)(L * 2 + 0) * D; const float* b1 = ain(kp, IN_LNB) + (size_t)(L * 2 + 0) * D;
        const int NT = build_tiles(F, cnt);
        __syncthreads();
        phase_downproj3(F, HB, (const bf16*)(ws + WS_W_EX_D) + (size_t)L * 64 * D * EDIM, HS, (const bf16*)(ws + WS_W_SH_D) + (size_t)L * D * SDIM, (unsigned char*)Yr, (float*)(ws + WS_BIG + BG_YSC), NT + 2 * (T / 256));
        (void)g1; (void)b1; }
    if constexpr (PH == PH_MOE4) { (void)build_tiles(F, cnt);
        const float* g2 = ain(kp, IN_LNG) + (size_t)(L * 2 + 1) * D; const float* b2 = ain(kp, IN_LNB) + (size_t)(L * 2 + 1) * D;
        phase_moe4q(F, x1b, (bf16*)(ws + WS_Y2F), (const unsigned char*)Yr, (const float*)(ws + WS_BIG + BG_YSC), eidx, inv, g2, b2, (float*)(ws + WS_ST2), (bf16*)(ws + WS_XB), aout(kp), L == DEPTH - 1); }
}
__device__ __forceinline__ void make_frame(Frame& F, const Args& args) {
    extern __shared__ __attribute__((aligned(16))) unsigned char lds_raw[];
    F.lds = (LAS unsigned char*)lds_raw; F.ws = args.ws; F.ctl = (unsigned*)(args.ws + WS_CTL);
    F.tid = threadIdx.x; F.lane = F.tid & 63; F.wave = __builtin_amdgcn_readfirstlane(F.tid >> 6); F.G = gridDim.x; F.bid = blockIdx.x;
}
template <int PH> __global__ void __launch_bounds__(512, 2) k_phase(Args args, int L) {
    Frame F; make_frame(F, args);
    run_phase<PH>(F, args, L);
}

#ifndef MK_NOINLINE
#define MK_NOINLINE 0
#endif
#if MK_NOINLINE
template <int PH> __device__ __noinline__ void call_phase_ni(const int L) {
    Args dummy{}; Frame F;
    KP kp = (KP)__builtin_amdgcn_kernarg_segment_ptr();
    extern __shared__ __attribute__((aligned(16))) unsigned char lds_raw[];
    F.lds = (LAS unsigned char*)lds_raw; F.ws = (unsigned char*)((GAS unsigned char* const CAS*)kp)[20]; F.ctl = (unsigned*)(F.ws + WS_CTL);
    F.tid = threadIdx.x; F.lane = F.tid & 63; F.wave = __builtin_amdgcn_readfirstlane(F.tid >> 6); F.G = gridDim.x; F.bid = blockIdx.x;
    run_phase<PH>(F, dummy, L);
}
template <int PH> __device__ __forceinline__ void call_phase(const Frame& F, const Args& args, const int L) { call_phase_ni<PH>(L); }
#else
template <int PH> __device__ __forceinline__ void call_phase(const Frame& F, const Args& args, const int L) { asm volatile("; PHASE_BEGIN %0" :: "n"(PH)); run_phase<PH>(F, args, L); asm volatile("; PHASE_END %0" :: "n"(PH)); }
#endif
__global__ void __launch_bounds__(512, 2) fwd_all(Args args) {
    Frame F; make_frame(F, args);
    volatile LAS unsigned* misc = (volatile LAS unsigned*)(F.lds + LDS_MISC);
    if (F.tid < 4) misc[F.tid] = 0u;
    __syncthreads();
    const int lo = args.ph_lo, hi = args.ph_hi;
    XcdBarrier bar; bar.bar = F.ctl + CW_BAR; bar.x = 0; bar.st = misc;
    if (hi - lo > 1) bar = xcd_barrier_post(F.ctl + CW_BAR, misc);
    int pc = 0;
#ifndef MK_DUP_MASK
#define MK_DUP_MASK 0
#endif
#if MK_DUP_MASK
#define STEP(PH, Lx) do { if (pc >= lo && pc < hi) { int nrep_ = ((MK_DUP_MASK >> (PH)) & 1) ? 2 : 1; asm volatile("" : "+s"(nrep_)); _Pragma("unroll 1") for (int r_ = 0; r_ < nrep_; ++r_) { call_phase<PH>(F, args, Lx); if (r_ + 1 < nrep_ || pc + 1 < hi) xcd_barrier(bar); } } ++pc; } while (0)
#else
#define STEP(PH, Lx) do { if (pc >= lo && pc < hi) { call_phase<PH>(F, args, Lx); if (pc + 1 < hi) xcd_barrier(bar); } ++pc; } while (0)
#endif
    STEP(PH_PRO, 0);
#pragma unroll 1
    for (int L = 0; L < DEPTH; ++L) {
        const int kind = L % 3;
        if (kind == 0) { STEP(PH_POOL_G1, L); STEP(PH_POOL_P, L); STEP(PH_POOL_G2, L); STEP(PH_POOL_G3, L); }
        else if (kind == 1) { STEP(PH_DIL_G1, L); STEP(PH_DIL_ATT, L); STEP(PH_DIL_CMB, L); STEP(PH_DIL_G2, L); }
        else { STEP(PH_CONV_G1, L); STEP(PH_CONV_E, L); STEP(PH_CONV_G2, L); }
        STEP(PH_MOE1, L); STEP(PH_MOE2, L); STEP(PH_MOE3, L); STEP(PH_MOE4, L);
    }
#undef STEP
}
constexpr int N_STEPS = 1 + 2 * 8 + 8 + 7;

template <int PH> static void launch_phase(const Args& a, int L, int grid, hipStream_t stream) {
    static bool attr = false;
    if (!attr) { (void)hipFuncSetAttribute((const void*)k_phase<PH>, hipFuncAttributeMaxDynamicSharedMemorySize, LDS_BYTES); attr = true; }
    hipLaunchKernelGGL(k_phase<PH>, dim3(grid), dim3(512), LDS_BYTES, stream, a, L);
}
extern "C" void kernel_launch(void* const* d_in, const int* in_sizes, int n_in, void* d_out, int out_size, void* d_ws, size_t ws_size, hipStream_t stream) {
    static int grid = 0;
    if (grid == 0) {
        if (n_in != 19 || out_size != T * D || ws_size < WS_END) { fprintf(stderr, "kernel_launch: unexpected shapes (n_in %d out %d ws %zu need %zu)\n", n_in, out_size, ws_size, (size_t)WS_END); grid = -1; return; }
        int dev = 0, cus = 0;
        if (hipGetDevice(&dev) != hipSuccess || hipDeviceGetAttribute(&cus, hipDeviceAttributeMultiprocessorCount, dev) != hipSuccess) { grid = -1; return; }
#if MK_ONE_LAUNCH
        if (hipFuncSetAttribute((const void*)fwd_all, hipFuncAttributeMaxDynamicSharedMemorySize, LDS_BYTES) != hipSuccess) { fprintf(stderr, "kernel_launch: hipFuncSetAttribute failed\n"); grid = -1; return; }
        int per_cu = 0;
        if (hipOccupancyMaxActiveBlocksPerMultiprocessor(&per_cu, (const void*)fwd_all, 512, LDS_BYTES) != hipSuccess || per_cu < 1) { fprintf(stderr, "kernel_launch: note: occupancy query reports %d blocks per CU\n", per_cu); (void)hipGetLastError(); }
#endif
        grid = cus;
    }
    if (grid < 0) return;
    (void)hipMemsetAsync((char*)d_ws + WS_CTL, 0, CTL_ZERO_BYTES, stream);
    Args a{};
    for (int i = 0; i < 19; ++i) a.in[i] = (const float*)d_in[i];
    a.out = (float*)d_out; a.ws = (unsigned char*)d_ws; a.ph_lo = 0; a.ph_hi = 0;
#if MK_ONE_LAUNCH
#ifdef MK_SPLIT
    for (int p = 0; p < N_STEPS; ++p) { a.ph_lo = p; a.ph_hi = p + 1; hipLaunchKernelGGL(fwd_all, dim3(grid), dim3(512), LDS_BYTES, stream, a); }
#else
    a.ph_lo = 0; a.ph_hi = N_STEPS;
    hipLaunchKernelGGL(fwd_all, dim3(grid), dim3(512), LDS_BYTES, stream, a);
#endif
#elif defined(MK_HYBRID_MASK)
    {
        static bool attr2 = false; if (!attr2) { (void)hipFuncSetAttribute((const void*)fwd_all, hipFuncAttributeMaxDynamicSharedMemorySize, LDS_BYTES); attr2 = true; }
        int pc = 0;
#define HSTEP(PH, Lx) do { if ((MK_HYBRID_MASK >> (PH)) & 1) { a.ph_lo = pc; a.ph_hi = pc + 1; hipLaunchKernelGGL(fwd_all, dim3(grid), dim3(512), LDS_BYTES, stream, a); } else { a.ph_lo = 0; a.ph_hi = 0; launch_phase<PH>(a, Lx, grid, stream); } ++pc; } while (0)
        HSTEP(PH_PRO, 0);
        for (int L = 0; L < DEPTH; ++L) {
            const int kind = L % 3;
            if (kind == 0) { HSTEP(PH_POOL_G1, L); HSTEP(PH_POOL_P, L); HSTEP(PH_POOL_G2, L); HSTEP(PH_POOL_G3, L); }
            else if (kind == 1) { HSTEP(PH_DIL_G1, L); HSTEP(PH_DIL_ATT, L); HSTEP(PH_DIL_CMB, L); HSTEP(PH_DIL_G2, L); }
            else { HSTEP(PH_CONV_G1, L); HSTEP(PH_CONV_E, L); HSTEP(PH_CONV_G2, L); }
            HSTEP(PH_MOE1, L); HSTEP(PH_MOE2, L); HSTEP(PH_MOE3, L); HSTEP(PH_MOE4, L);
        }
#undef HSTEP
    }
#else
    launch_phase<PH_PRO>(a, 0, grid, stream);
    for (int L = 0; L < DEPTH; ++L) {
        const int kind = L % 3;
        if (kind == 0) { launch_phase<PH_POOL_G1>(a, L, grid, stream); launch_phase<PH_POOL_P>(a, L, grid, stream); launch_phase<PH_POOL_G2>(a, L, grid, stream); launch_phase<PH_POOL_G3>(a, L, grid, stream); }
        else if (kind == 1) { launch_phase<PH_DIL_G1>(a, L, grid, stream); launch_phase<PH_DIL_ATT>(a, L, grid, stream); launch_phase<PH_DIL_CMB>(a, L, grid, stream); launch_phase<PH_DIL_G2>(a, L, grid, stream); }
        else { launch_phase<PH_CONV_G1>(a, L, grid, stream); launch_phase<PH_CONV_E>(a, L, grid, stream); launch_phase<PH_CONV_G2>(a, L, grid, stream); }
        launch_phase<PH_MOE1>(a, L, grid, stream); launch_phase<PH_MOE2>(a, L, grid, stream); launch_phase<PH_MOE3>(a, L, grid, stream); launch_phase<PH_MOE4>(a, L, grid, stream);
    }
#endif
}
```

```cpp
#include <hip/hip_runtime.h>
#include <cstdio>
#include <cstdint>

#ifndef MK_ONE_LAUNCH
#define MK_ONE_LAUNCH 1
#endif

#define GAS __attribute__((address_space(1)))
#define LAS __attribute__((address_space(3)))
typedef unsigned short bf16;
typedef unsigned v4u __attribute__((ext_vector_type(4)));
typedef unsigned v2u __attribute__((ext_vector_type(2)));
typedef float f32x4 __attribute__((ext_vector_type(4)));
typedef float f32x2 __attribute__((ext_vector_type(2)));
typedef short bf16x8 __attribute__((ext_vector_type(8)));
typedef short s16x4 __attribute__((ext_vector_type(4)));

constexpr int NBATCH = 8, SEQ = 2048, D = 2048, T = NBATCH * SEQ, DEPTH = 4;
constexpr int NEXP = 64, TOPK = 8, EDIM = 128, SDIM = 256;
constexpr int QKVC = 4608, DILW = 512;
constexpr float ALPHA = 1.681792830507429f;
constexpr float LN_EPS = 1e-5f;
constexpr int CAP = 16384;
constexpr int HROWS = T * TOPK + NEXP * 256;

constexpr size_t MiB = 1u << 20;
constexpr size_t WS_CTL = 0, CTL_ZERO_BYTES = 1 * MiB;
constexpr size_t WS_W_POOL_IN = 1 * MiB;
constexpr size_t WS_W_POOL_G = WS_W_POOL_IN + 16 * MiB;
constexpr size_t WS_W_POOL_OUT = WS_W_POOL_G + 4 * MiB;
constexpr size_t WS_W_DIL_QKV = WS_W_POOL_OUT + 16 * MiB;
constexpr size_t WS_W_DIL_OUT = WS_W_DIL_QKV + 18 * MiB;
constexpr size_t WS_W_CONV_IN = WS_W_DIL_OUT + 2 * MiB;
constexpr size_t WS_W_CONV_OUT = WS_W_CONV_IN + 24 * MiB;
constexpr size_t WS_W_SH_GU = WS_W_CONV_OUT + 8 * MiB;
constexpr size_t WS_W_SH_D = WS_W_SH_GU + 8 * MiB;
constexpr size_t WS_W_EX_GU = WS_W_SH_D + 4 * MiB;
constexpr size_t WS_W_EX_D = WS_W_EX_GU + 256 * MiB;
constexpr size_t WS_XF = WS_W_EX_D + 256 * MiB;
constexpr size_t WS_YF = WS_XF + 128 * MiB;
constexpr size_t WS_X1F = WS_YF + 128 * MiB;
constexpr size_t WS_XB = WS_X1F + 128 * MiB;
constexpr size_t WS_X1B = WS_XB + 64 * MiB;
constexpr size_t WS_HB = WS_X1B + 64 * MiB;
constexpr size_t WS_HS = WS_HB + 72 * MiB;
constexpr size_t WS_LTOK = WS_HS + 8 * MiB;
constexpr size_t WS_LGATE = WS_LTOK + 4 * MiB;
constexpr size_t WS_EIDX = WS_LGATE + 4 * MiB;
constexpr size_t WS_INV = WS_EIDX + 1 * MiB;
constexpr size_t WS_BIG = WS_INV + 1 * MiB;
constexpr size_t WS_PST = WS_BIG + 608 * MiB;
constexpr size_t WS_ST1 = WS_PST + 4 * MiB;
constexpr size_t WS_ST2 = WS_ST1 + 1 * MiB;
constexpr size_t WS_RWH = WS_ST2 + 1 * MiB;
constexpr size_t WS_RWL = WS_RWH + 1 * MiB;
constexpr size_t WS_PST2 = WS_RWL + 1 * MiB;
constexpr size_t WS_END = WS_PST2 + 8 * MiB;
constexpr size_t WS_Y2F = WS_X1F;
constexpr size_t BG_U = 0, BG_PL = 64 * MiB, BG_MX = 128 * MiB;
constexpr size_t BG_QKV = 0, BG_OG = 144 * MiB, BG_LSE = 192 * MiB, BG_O = 194 * MiB;
constexpr size_t BG_UC = 0, BG_BG = 64 * MiB, BG_Z = 128 * MiB;
constexpr size_t BG_YSC = 400 * MiB;
constexpr int CW_BAR = 4096;
constexpr int CW_CNT = 16384;

constexpr int RING_BYTES = 131072;
constexpr int LDS_TAB = RING_BYTES;
constexpr int LDS_STASH = RING_BYTES + 1024;
constexpr int LDS_BYTES = 163840;
constexpr int LDS_MISC = LDS_BYTES - 1024;

typedef __bf16 bf16x2_t __attribute__((ext_vector_type(2)));
typedef float f32x2_t __attribute__((ext_vector_type(2)));
__device__ __forceinline__ unsigned cvt_pk_bf16(float lo, float hi) { const bf16x2_t r = __builtin_convertvector((f32x2_t){lo, hi}, bf16x2_t); return __builtin_bit_cast(unsigned, r); }
__device__ __forceinline__ unsigned f2bf(float f) { unsigned u = __builtin_bit_cast(unsigned, f); return (u + 0x7fffu + ((u >> 16) & 1u)) >> 16; }
__device__ __forceinline__ unsigned pk2(float lo, float hi) { return f2bf(lo) | (f2bf(hi) << 16); }
__device__ __forceinline__ float bflo(unsigned w) { return __builtin_bit_cast(float, w << 16); }
__device__ __forceinline__ float bfhi(unsigned w) { return __builtin_bit_cast(float, w & 0xffff0000u); }
__device__ __forceinline__ float shfl_from(float v, int src) { return __builtin_bit_cast(float, __builtin_amdgcn_ds_bpermute(src << 2, __builtin_bit_cast(int, v))); }
__device__ __forceinline__ float shfl_x(float v, int o, int lane) { return shfl_from(v, lane ^ o); }
__device__ __forceinline__ float wave_sum(float v, int lane) {
#pragma unroll
    for (int o = 1; o < 64; o <<= 1) v += shfl_x(v, o, lane);
    return v;
}
#define LDS_WAIT() asm volatile("s_waitcnt lgkmcnt(0)" ::: "memory")
#define VM_WAIT() asm volatile("s_waitcnt vmcnt(0)" ::: "memory")

#define XB_TMO      128
#define XB_XCNT(j)  (256  + 64 * (j))
#define XB_XSUB(j)  (1280 + 64 * (j))
#define XB_XGEN(j)  (2304 + 64 * (j))
#define XB_TOP      3328
#define XB_TOPGEN   3392
#define XCD_BAR_WORDS 3456
#define XB_SPIN_CAP (1u << 18)

__device__ __forceinline__ unsigned xb_ld(unsigned* p)              { return __hip_atomic_load(p, __ATOMIC_RELAXED, __HIP_MEMORY_SCOPE_AGENT); }
__device__ __forceinline__ unsigned xb_add(unsigned* p, unsigned v) { return __hip_atomic_fetch_add(p, v, __ATOMIC_RELAXED, __HIP_MEMORY_SCOPE_AGENT); }
__device__ __forceinline__ unsigned xb_xcc_id() { return (unsigned)__builtin_amdgcn_s_getreg((3 << 11) | 20) & 0xFu; }
#define XB_SPIN(cond, bar) do { unsigned _sp = 0; while (cond) { __builtin_amdgcn_s_sleep(1); \
    if ((++_sp & 255u) == 0u) { if (xb_ld(&(bar)[XB_TMO])) break; if (_sp > XB_SPIN_CAP) { atomicAdd(&(bar)[XB_TMO], 1u); break; } } } } while (0)

struct XcdBarrier {
    unsigned* bar; unsigned x;
    volatile LAS unsigned* st;
};

__device__ __forceinline__ XcdBarrier xcd_barrier_post(unsigned* bar, volatile LAS unsigned* st) {
    XcdBarrier b; b.bar = bar; b.x = xb_xcc_id(); b.st = st;
    if (threadIdx.x == 0) (void)xb_add(&bar[XB_XCNT(b.x)], 1u);
    return b;
}
__device__ __forceinline__ void xcd_barrier_complete(unsigned* bar, unsigned x, unsigned& nloc, unsigned& nx) {
    const unsigned G = gridDim.x * gridDim.y * gridDim.z;
    unsigned sum, cnt, mine, sp = 0u;
    for (;;) {
        sum = 0u; cnt = 0u; mine = 0u;
#pragma unroll
        for (unsigned j = 0; j < 16; ++j) { const unsigned c = xb_ld(&bar[XB_XCNT(j)]); sum += c; cnt += (c > 0u) ? 1u : 0u; mine = (j == x) ? c : mine; }
        if (sum == G) break;
        __builtin_amdgcn_s_sleep(1);
        if ((++sp & 255u) == 0u) { if (xb_ld(&bar[XB_TMO])) break; if (sp > XB_SPIN_CAP) { atomicAdd(&bar[XB_TMO], 1u); break; } }
    }
    nloc = mine > 0u ? mine : 1u; nx = cnt > 0u ? cnt : 1u;
}

__device__ __forceinline__ void xcd_barrier(const XcdBarrier& b) {
    asm volatile("s_waitcnt vmcnt(0)" ::: "memory");
    __syncthreads();
    if (threadIdx.x == 0) {
        unsigned* bar; unsigned bx = b.x; { GAS unsigned* bg = (GAS unsigned*)b.bar; asm volatile("" : "+s"(bg), "+s"(bx)); bar = (unsigned*)bg; }
        __builtin_amdgcn_s_waitcnt(0);
        unsigned nloc = b.st[0], nx = b.st[1];
        if (nloc == 0u) { xcd_barrier_complete(bar, bx, nloc, nx); b.st[0] = nloc; b.st[1] = nx; }
        const unsigned old = xb_add(&bar[XB_XSUB(bx)], 1u);
        const unsigned gen = old / nloc;
        if (old + 1u == (gen + 1u) * nloc) {
            __builtin_amdgcn_fence(__ATOMIC_RELEASE, "agent");
            asm volatile("s_waitcnt vmcnt(0)" ::: "memory");
            const unsigned og = xb_add(&bar[XB_TOP], 1u);
            const unsigned tg = og / nx;
            if (og + 1u == (tg + 1u) * nx) xb_add(&bar[XB_TOPGEN], 1u);
            else XB_SPIN(xb_ld(&bar[XB_TOPGEN]) == tg, bar);
            __builtin_amdgcn_fence(__ATOMIC_ACQUIRE, "agent");
            xb_add(&bar[XB_XGEN(bx)], 1u);
            asm volatile("s_waitcnt vmcnt(0)" ::: "memory");
        } else {
            XB_SPIN(xb_ld(&bar[XB_XGEN(bx)]) == gen, bar);
            __builtin_amdgcn_fence(__ATOMIC_ACQUIRE, "agent");
            asm volatile("s_waitcnt vmcnt(0)" ::: "memory");
        }
    }
    __syncthreads();
}

namespace g8 {
constexpr int BM = 256, BK = 64, HALF = 128, HTB = HALF * BK * 2, STAGE_BYTES = 8 * HTB, NXCD = 8, WGM = 8;
__host__ __device__ __forceinline__ int lds_byte(int r, int c) { const int st = (r >> 4) * 2 + (c >> 5), rr = r & 15, cc = c & 31, ob = rr * 64 + cc * 2; return st * 1024 + (ob ^ (((ob >> 9) & 1) << 5)); }
__host__ __device__ __forceinline__ void stage_rc(int b, int& R, int& C) { const int st = b / 1024, sb = b % 1024, swz = sb ^ (((sb >> 9) & 1) << 5); R = (st >> 1) * 16 + swz / 64; C = (st & 1) * 32 + (swz % 64) / 2; }
__host__ __device__ __forceinline__ int perm32(int rho) { const int n = rho >> 4, i = rho & 15; return 8 * (i >> 2) + 4 * n + (i & 3); }

struct Unit { const char* A; const char* B; const int* rows; int pm, pn, nvalid, aux; };

template <class Epi, class Sched, bool GATHER>
__device__ __forceinline__ void gemm_phase(LAS unsigned char* lds, const int tid_in, const int K, const int lda, const int ldb, const Sched& S, const Epi& E) {
    const int tid = tid_in, wid = __builtin_amdgcn_readfirstlane(tid >> 6), lane = tid & 63, wr = wid >> 2, wc = wid & 3, fr = lane & 15, fq = lane >> 4;
    const int nt = K / BK;
    unsigned voffB[2];
#pragma unroll
    for (int i = 0; i < 2; ++i) { int R_, C_; stage_rc(tid * 16 + i * 8192, R_, C_); const int Rb = Epi::PERM ? ((R_ & ~31) + perm32(R_ & 31)) : R_; voffB[i] = (unsigned)(Rb * ldb + C_) * 2u; }
    LAS v4u* stash = (LAS v4u*)(lds + (LDS_STASH - 0) + tid * 16);
    const size_t kstep = (size_t)(BK * 2);
    const size_t hstepB = (size_t)HALF * ldb * 2;
    const unsigned ldsw = (unsigned)wid * 1024u;
    const int aoff = lds_byte(wr * 64 + fr, fq * 8), boff = lds_byte(wc * 32 + fr, fq * 8);
#define G8_SA(b, h) (((b) * 2 + (h)) * HTB)
#define G8_SB(b, h) ((4 + (b) * 2 + (h)) * HTB)
#define G8_STAGE2(bufoff, gbase, v0, v1) do { \
        __builtin_amdgcn_global_load_lds((const unsigned*)((const char*)(gbase) + (v0)), (LAS unsigned*)(lds + (bufoff) + ldsw), 16, 0, 0); \
        __builtin_amdgcn_global_load_lds((const unsigned*)((const char*)(gbase) + (v1)), (LAS unsigned*)(lds + (bufoff) + ldsw + 8192), 16, 0, 0); } while (0)
#define G8_STAGEB(bufoff, gbase) G8_STAGE2(bufoff, gbase, voffB[0], voffB[1])
#define G8_LDA(dst, b, h) do { _Pragma("unroll") for (int m = 0; m < 4; ++m) _Pragma("unroll") for (int k = 0; k < 2; ++k) dst[m][k] = *(const LAS bf16x8*)(lds + G8_SA(b, h) + aoff + m * 2048 + k * 1024); } while (0)
#define G8_LDB(dst, b, h) do { _Pragma("unroll") for (int n = 0; n < 2; ++n) _Pragma("unroll") for (int k = 0; k < 2; ++k) dst[n][k] = *(const LAS bf16x8*)(lds + G8_SB(b, h) + boff + n * 2048 + k * 1024); } while (0)
#define G8_MMA(ai, bj, At, Bt) do { __builtin_amdgcn_s_setprio(1); _Pragma("unroll") for (int m = 0; m < 4; ++m) _Pragma("unroll") for (int n = 0; n < 2; ++n) _Pragma("unroll") for (int k = 0; k < 2; ++k) \
        acc[ai][bj][m][n] = __builtin_amdgcn_mfma_f32_16x16x32_bf16(Bt[n][k], At[m][k], acc[ai][bj][m][n], 0, 0, 0); __builtin_amdgcn_s_setprio(0); } while (0)
#define G8_WAIT_V(n) asm volatile("s_waitcnt vmcnt(" #n ")" ::: "memory")
#define G8_WAIT_L(n) asm volatile("s_waitcnt lgkmcnt(" #n ")" ::: "memory")
#define G8_BAR __builtin_amdgcn_s_barrier()
#define G8_SCHED __builtin_amdgcn_sched_barrier(0)
#define G8_SETVA(dst, u) do { int _t2 = tid; if (GATHER) asm volatile("" : "+v"(_t2)); _Pragma("unroll") for (int _h = 0; _h < 2; ++_h) _Pragma("unroll") for (int _i = 0; _i < 2; ++_i) { \
        int _R, _C; stage_rc(_t2 * 16 + _i * 8192, _R, _C); \
        const unsigned _rl = (unsigned)(_h * HALF + _R); unsigned _row = _rl; \
        if (GATHER) { _row = 0u; if (_rl < (unsigned)(u).nvalid) _row = (unsigned)(u).rows[_rl] >> 3; } \
        dst[_h][_i] = (_row * (unsigned)lda + (unsigned)_C) * 2u; } } while (0)
    Unit cur, nxt; int ui = 0;
    if (!S.next(0, cur)) return;
    f32x4 acc[2][2][4][2];
#pragma unroll
    for (int a = 0; a < 2; ++a)
#pragma unroll
        for (int b = 0; b < 2; ++b)
#pragma unroll
            for (int m = 0; m < 4; ++m)
#pragma unroll
                for (int n = 0; n < 2; ++n) acc[a][b][m][n] = (f32x4){0.f, 0.f, 0.f, 0.f};
    bf16x8 At[4][2], B0[2][2], B1[2][2];
    unsigned vAc[2][2]; unsigned xl00 = 0, xl01 = 0, xl10 = 0, xl11 = 0;
    G8_SETVA(vAc, cur);
    const char* cA = cur.A; const char* cB = cur.B;
    G8_STAGEB(G8_SB(0, 0), cB); G8_STAGEB(G8_SB(0, 1), cB + hstepB); G8_STAGE2(G8_SA(0, 0), cA, vAc[0][0], vAc[0][1]); G8_STAGE2(G8_SA(0, 1), cA, vAc[1][0], vAc[1][1]);
    if (wr == 1) G8_BAR;
    G8_WAIT_V(2); G8_BAR;
    G8_STAGEB(G8_SB(1, 0), cB + kstep); G8_STAGE2(G8_SA(1, 0), cA + kstep, vAc[0][0], vAc[0][1]); G8_STAGEB(G8_SB(1, 1), cB + hstepB + kstep);
    G8_WAIT_V(6); G8_BAR;
    for (;;) {
        const bool has_next = S.next(ui + 1, nxt);
        const char* nA = has_next ? nxt.A : cA; const char* nB = has_next ? nxt.B : cB;
        if (GATHER) { unsigned vAn[2][2]; if (has_next) { G8_SETVA(vAn, nxt); } else {
#pragma unroll
            for (int h = 0; h < 2; ++h)
#pragma unroll
                for (int i = 0; i < 2; ++i) vAn[h][i] = vAc[h][i]; }
            *stash = (v4u){vAn[0][0], vAn[0][1], vAn[1][0], vAn[1][1]}; }
#pragma unroll 1
        for (int t = 0; t < nt; t += 2) {
            const bool last = (t == nt - 2);
            const char* a1 = cA + (size_t)(t + 1) * kstep;
            const char* a2 = last ? nA : cA + (size_t)(t + 2) * kstep; const char* b2 = last ? nB : cB + (size_t)(t + 2) * kstep;
            const char* a3 = a2 + kstep; const char* b3 = b2 + kstep;
            unsigned x00 = vAc[0][0], x01 = vAc[0][1], x10 = vAc[1][0], x11 = vAc[1][1];
            if (GATHER) { if (last) { const v4u sv = *stash; x00 = sv.x; x01 = sv.y; x10 = sv.z; x11 = sv.w; } xl00 = x00; xl01 = x01; xl10 = x10; xl11 = x11; }
            G8_LDB(B0, 0, 0); G8_LDB(B1, 0, 1); G8_SCHED; G8_LDA(At, 0, 0); G8_STAGE2(G8_SA(1, 1), a1, vAc[1][0], vAc[1][1]);
            G8_WAIT_V(8); G8_WAIT_L(0); G8_BAR; G8_MMA(0, 0, At, B0); G8_MMA(0, 1, At, B1); G8_BAR; G8_SCHED;
            G8_LDA(At, 0, 1); G8_STAGEB(G8_SB(0, 0), b2); G8_STAGEB(G8_SB(0, 1), b2 + hstepB); G8_STAGE2(G8_SA(0, 0), a2, x00, x01);
            G8_WAIT_V(8); G8_WAIT_L(0); G8_BAR; G8_MMA(1, 0, At, B0); G8_MMA(1, 1, At, B1); G8_BAR; G8_SCHED;
            G8_LDB(B0, 1, 0); G8_LDB(B1, 1, 1); G8_SCHED; G8_LDA(At, 1, 0); G8_STAGE2(G8_SA(0, 1), a2, x10, x11);
            G8_WAIT_V(8); G8_WAIT_L(0); G8_BAR; G8_MMA(0, 0, At, B0); G8_MMA(0, 1, At, B1); G8_BAR; G8_SCHED;
            G8_LDA(At, 1, 1); G8_STAGEB(G8_SB(1, 0), b3); G8_STAGEB(G8_SB(1, 1), b3 + hstepB); G8_STAGE2(G8_SA(1, 0), a3, x00, x01);
            G8_WAIT_V(8); G8_WAIT_L(0); G8_BAR; G8_MMA(1, 0, At, B0); G8_MMA(1, 1, At, B1); G8_BAR; G8_SCHED;
        }
        if (wr == 0) G8_BAR;
        E(acc, cur, wr, wc, fr, fq);
        if (!has_next) break;
#pragma unroll
        for (int a = 0; a < 2; ++a)
#pragma unroll
            for (int b = 0; b < 2; ++b)
#pragma unroll
                for (int m = 0; m < 4; ++m)
#pragma unroll
                    for (int n = 0; n < 2; ++n) acc[a][b][m][n] = (f32x4){0.f, 0.f, 0.f, 0.f};
        cur = nxt; cA = nA; cB = nB; ++ui;
        if (GATHER) { vAc[0][0] = xl00; vAc[0][1] = xl01; vAc[1][0] = xl10; vAc[1][1] = xl11; }
        if (wr == 1) G8_BAR;
    }
    G8_WAIT_V(0);
    G8_BAR;
#undef G8_SA
#undef G8_SB
#undef G8_STAGE2
#undef G8_STAGEB
#undef G8_LDA
#undef G8_LDB
#undef G8_MMA
#undef G8_WAIT_V
#undef G8_WAIT_L
#undef G8_BAR
#undef G8_SCHED
#undef G8_SETVA
}

struct DenseSched {
    const char* A; const char* B; size_t a_tile, b_tile, agrp_stride; int agrp_shift, nM, nN, nwg, G, c;
    __device__ __forceinline__ void init(const void* A_, const void* B_, int M, int N, int lda, int ldb, int G_, int c_) {
        A = (const char*)A_; B = (const char*)B_; a_tile = (size_t)BM * lda * 2; b_tile = (size_t)BM * ldb * 2; agrp_stride = 0; agrp_shift = 0; nM = M / BM; nN = N / BM; nwg = nM * nN; G = G_; c = c_; }
    __device__ __forceinline__ bool next(int i, Unit& u) const {
        const long L = (long)i * G + c; if (L >= nwg) return false;
        int wgid = (int)L; { const int q = nwg / NXCD, r = nwg % NXCD, xcd = wgid % NXCD, off = wgid / NXCD; wgid = (xcd < r ? xcd * (q + 1) : r * (q + 1) + (xcd - r) * q) + off; }
        const int nig = WGM * nN, gid = wgid / nig, fm = gid * WGM, gsz = (nM - fm) < WGM ? (nM - fm) : WGM;
        u.pm = fm + ((wgid % nig) % gsz); u.pn = (wgid % nig) / gsz;
        u.A = A + (size_t)u.pm * a_tile + (size_t)(u.pn >> agrp_shift) * agrp_stride; u.B = B + (size_t)u.pn * b_tile; u.rows = nullptr; u.nvalid = BM; u.aux = 0; return true;
    }
};
template <int NPN, bool GATHERED>
struct ExpertSched {
    const LAS int* tpref; const LAS int* cnt; const char* A; const char* B; const int* tok; size_t b_exp, b_tile, a_tile; int NU, G, c;
    __device__ __forceinline__ bool next(int i, Unit& u) const {
        int L = i * G + c; if (L >= NU) return false;
        if ((i + 1) * G <= NU && (G % NXCD) == 0) L = i * G + (c % NXCD) * (G / NXCD) + c / NXCD;
        const int tile = L / NPN, pn = L % NPN;
        int e = 0; while (__builtin_amdgcn_readfirstlane(tpref[e + 1]) <= tile) ++e;
        const int rb = tile - __builtin_amdgcn_readfirstlane(tpref[e]);
        u.pm = e; u.pn = pn; u.aux = tile * BM; u.nvalid = __builtin_amdgcn_readfirstlane(cnt[e]) - rb * BM; if (u.nvalid > BM) u.nvalid = BM;
        u.rows = tok + (size_t)e * CAP + rb * BM;
        u.A = GATHERED ? A : A + (size_t)tile * a_tile; u.B = B + (size_t)e * b_exp + (size_t)pn * b_tile; return true;
    }
};

struct EpiBf16 {
    static constexpr bool PERM = true;
    bf16* O; int ldc; int qscale;
    __device__ __forceinline__ void operator()(const f32x4 (&acc)[2][2][4][2], const Unit& u, int wr, int wc, int fr, int fq) const {
        asm volatile("" : "+v"(fr), "+v"(fq));
        const int row0 = u.pm * BM + wr * 64 + fr, col0 = u.pn * BM + wc * 32 + 8 * fq;
        const float sc = (qscale && (u.pn % 6) < 2) ? 0.125f : 1.0f;
#pragma unroll
        for (int ai = 0; ai < 2; ++ai)
#pragma unroll
            for (int m = 0; m < 4; ++m) { bf16* rowp = O + (size_t)(row0 + ai * HALF + m * 16) * ldc + col0;
#pragma unroll
                for (int bj = 0; bj < 2; ++bj) { const f32x4 v0 = acc[ai][bj][m][0] * sc, v1 = acc[ai][bj][m][1] * sc;
                    v4u w; w.x = cvt_pk_bf16(v0[0], v0[1]); w.y = cvt_pk_bf16(v0[2], v0[3]); w.z = cvt_pk_bf16(v1[0], v1[1]); w.w = cvt_pk_bf16(v1[2], v1[3]);
                    *(v4u*)(rowp + bj * HALF) = w; } }
    }
};
struct EpiScaleBf16 {
    static constexpr bool PERM = true;
    bf16* O; int ldc; const float* scale;
    __device__ __forceinline__ void operator()(const f32x4 (&acc)[2][2][4][2], const Unit& u, int wr, int wc, int fr, int fq) const {
        asm volatile("" : "+v"(fr), "+v"(fq));
        const int row0 = u.pm * BM + wr * 64 + fr, col0 = u.pn * BM + wc * 32 + 8 * fq;
        f32x4 sv[2][2];
#pragma unroll
        for (int bj = 0; bj < 2; ++bj)
#pragma unroll
            for (int n = 0; n < 2; ++n) sv[bj][n] = *(const f32x4*)(scale + col0 + bj * HALF + 4 * n);
#pragma unroll
        for (int ai = 0; ai < 2; ++ai)
#pragma unroll
            for (int m = 0; m < 4; ++m) { bf16* rowp = O + (size_t)(row0 + ai * HALF + m * 16) * ldc + col0;
#pragma unroll
                for (int bj = 0; bj < 2; ++bj) { const f32x4 v0 = acc[ai][bj][m][0] * sv[bj][0], v1 = acc[ai][bj][m][1] * sv[bj][1];
                    v4u w; w.x = cvt_pk_bf16(v0[0], v0[1]); w.y = cvt_pk_bf16(v0[2], v0[3]); w.z = cvt_pk_bf16(v1[0], v1[1]); w.w = cvt_pk_bf16(v1[2], v1[3]);
                    *(v4u*)(rowp + bj * HALF) = w; } }
    }
};
struct EpiResid {
    static constexpr bool PERM = false;
    const float* X; float* Y;
    __device__ __forceinline__ void operator()(const f32x4 (&acc)[2][2][4][2], const Unit& u, int wr, int wc, int fr, int fq) const {
        asm volatile("" : "+v"(fr), "+v"(fq));
        const int row0 = u.pm * BM + wr * 64 + fr, col0 = u.pn * BM + wc * 32 + 4 * fq;
#pragma unroll
        for (int ai = 0; ai < 2; ++ai)
#pragma unroll
            for (int m = 0; m < 4; ++m) { const size_t off = (size_t)(row0 + ai * HALF + m * 16) * D + col0;
#pragma unroll
                for (int bj = 0; bj < 2; ++bj)
#pragma unroll
                    for (int n = 0; n < 2; ++n) { const f32x4 xv = *(const f32x4*)(X + off + bj * HALF + n * 16); *(f32x4*)(Y + off + bj * HALF + n * 16) = xv * ALPHA + acc[ai][bj][m][n]; } }
    }
};
struct EpiResidLN {
    static constexpr bool PERM = true;
    const float* X32; const bf16* Xb; const float* st; const float* g; const float* b; bf16* Y; float* pst; int mode;
    __device__ __forceinline__ void operator()(const f32x4 (&acc)[2][2][4][2], const Unit& u, int wr, int wc, int fr, int fq) const {
        asm volatile("" : "+v"(fr), "+v"(fq));
        const int row0 = u.pm * BM + wr * 64 + fr, col0 = u.pn * BM + wc * 32 + 8 * fq, lane = fq * 16 + fr;
#pragma unroll
        for (int ai = 0; ai < 2; ++ai)
#pragma unroll
            for (int m = 0; m < 4; ++m) { const int row = row0 + ai * HALF + m * 16; const size_t off = (size_t)row * D + col0;
                float mean = 0.f, rstd = 1.f; if (mode) { const f32x2 sv = *(const f32x2*)(st + 2 * row); mean = sv.x; rstd = sv.y; }
                float sm = 0.f, sq = 0.f;
#pragma unroll
                for (int bj = 0; bj < 2; ++bj) { f32x4 x0, x1;
                    if (mode) { const v4u xv = *(const v4u*)(Xb + off + bj * HALF);
                        const f32x4 g0 = *(const f32x4*)(g + col0 + bj * HALF), g1 = *(const f32x4*)(g + col0 + bj * HALF + 4), b0 = *(const f32x4*)(b + col0 + bj * HALF), b1 = *(const f32x4*)(b + col0 + bj * HALF + 4);
                        x0 = ((f32x4){bflo(xv.x), bfhi(xv.x), bflo(xv.y), bfhi(xv.y)} - mean) * rstd * g0 + b0; x1 = ((f32x4){bflo(xv.z), bfhi(xv.z), bflo(xv.w), bfhi(xv.w)} - mean) * rstd * g1 + b1; }
                    else { x0 = *(const f32x4*)(X32 + off + bj * HALF); x1 = *(const f32x4*)(X32 + off + bj * HALF + 4); }
                    const f32x4 y0 = x0 * ALPHA + acc[ai][bj][m][0], y1 = x1 * ALPHA + acc[ai][bj][m][1];
                    v4u w; w.x = cvt_pk_bf16(y0[0], y0[1]); w.y = cvt_pk_bf16(y0[2], y0[3]); w.z = cvt_pk_bf16(y1[0], y1[1]); w.w = cvt_pk_bf16(y1[2], y1[3]);
                    *(v4u*)(Y + off + bj * HALF) = w;
                    sm += ((y0[0] + y0[1]) + (y0[2] + y0[3])) + ((y1[0] + y1[1]) + (y1[2] + y1[3]));
                    sq += ((y0[0] * y0[0] + y0[1] * y0[1]) + (y0[2] * y0[2] + y0[3] * y0[3])) + ((y1[0] * y1[0] + y1[1] * y1[1]) + (y1[2] * y1[2] + y1[3] * y1[3])); }
                sm += shfl_x(sm, 16, lane); sm += shfl_x(sm, 32, lane); sq += shfl_x(sq, 16, lane); sq += shfl_x(sq, 32, lane);
                if (fq == 0) *(f32x2*)(pst + ((size_t)row * 32 + u.pn * 4 + wc) * 2) = (f32x2){sm, sq}; }
    }
};
struct EpiConvIn {
    static constexpr bool PERM = true;
    bf16* UC; bf16* BGp;
    __device__ __forceinline__ void operator()(const f32x4 (&acc)[2][2][4][2], const Unit& u, int wr, int wc, int fr, int fq) const {
        asm volatile("" : "+v"(fr), "+v"(fq));
        const int row0 = u.pm * BM + wr * 64 + fr, cw = wc * 32 + 8 * fq;
        if (u.pn < 16) {
#pragma unroll
            for (int ai = 0; ai < 2; ++ai)
#pragma unroll
                for (int m = 0; m < 4; ++m) { bf16* rowp = UC + (size_t)(row0 + ai * HALF + m * 16) * D + u.pn * HALF + cw;
                    const f32x4 v0 = acc[ai][0][m][0] * acc[ai][1][m][0], v1 = acc[ai][0][m][1] * acc[ai][1][m][1];
                    v4u w; w.x = cvt_pk_bf16(v0[0], v0[1]); w.y = cvt_pk_bf16(v0[2], v0[3]); w.z = cvt_pk_bf16(v1[0], v1[1]); w.w = cvt_pk_bf16(v1[2], v1[3]);
                    *(v4u*)rowp = w; }
        } else {
#pragma unroll
            for (int ai = 0; ai < 2; ++ai)
#pragma unroll
                for (int m = 0; m < 4; ++m) { bf16* rowp = BGp + (size_t)(row0 + ai * HALF + m * 16) * D + (u.pn - 16) * BM + cw;
#pragma unroll
                    for (int bj = 0; bj < 2; ++bj) { const f32x4 v0 = acc[ai][bj][m][0], v1 = acc[ai][bj][m][1];
                        v4u w; w.x = cvt_pk_bf16(v0[0], v0[1]); w.y = cvt_pk_bf16(v0[2], v0[3]); w.z = cvt_pk_bf16(v1[0], v1[1]); w.w = cvt_pk_bf16(v1[2], v1[3]);
                        *(v4u*)(rowp + bj * HALF) = w; } }
        }
    }
};
__device__ __forceinline__ f32x4 silu_mul(f32x4 g, f32x4 uu) {
    f32x4 r;
#pragma unroll
    for (int j = 0; j < 4; ++j) r[j] = g[j] * __builtin_amdgcn_rcpf(1.0f + __expf(-g[j])) * uu[j];
    return r;
}
struct EpiExpertGU {
    static constexpr bool PERM = true;
    bf16* H;
    __device__ __forceinline__ void operator()(const f32x4 (&acc)[2][2][4][2], const Unit& u, int wr, int wc, int fr, int fq) const {
        asm volatile("" : "+v"(fr), "+v"(fq));
        const float* gates = (const float*)((const char*)u.rows + (WS_LGATE - WS_LTOK));
        const int cw = wc * 32 + 8 * fq;
#pragma unroll
        for (int ai = 0; ai < 2; ++ai)
#pragma unroll
            for (int m = 0; m < 4; ++m) { const int r = ai * HALF + wr * 64 + m * 16 + fr;
                if (r < u.nvalid) { const float gt = gates[r]; const unsigned pid = (unsigned)u.rows[r];
                    const f32x4 v0 = silu_mul(acc[ai][0][m][0], acc[ai][1][m][0]) * gt, v1 = silu_mul(acc[ai][0][m][1], acc[ai][1][m][1]) * gt;
                    v4u w; w.x = cvt_pk_bf16(v0[0], v0[1]); w.y = cvt_pk_bf16(v0[2], v0[3]); w.z = cvt_pk_bf16(v1[0], v1[1]); w.w = cvt_pk_bf16(v1[2], v1[3]);
                    (void)pid; *(v4u*)(H + (size_t)(u.aux + r) * EDIM + cw) = w; } }
    }
};
struct EpiSharedGU {
    static constexpr bool PERM = true;
    bf16* HS;
    __device__ __forceinline__ void operator()(const f32x4 (&acc)[2][2][4][2], const Unit& u, int wr, int wc, int fr, int fq) const {
        asm volatile("" : "+v"(fr), "+v"(fq));
        const int row0 = u.pm * BM + wr * 64 + fr, cw = u.pn * HALF + wc * 32 + 8 * fq;
#pragma unroll
        for (int ai = 0; ai < 2; ++ai)
#pragma unroll
            for (int m = 0; m < 4; ++m) {
                const f32x4 v0 = silu_mul(acc[ai][0][m][0], acc[ai][1][m][0]), v1 = silu_mul(acc[ai][0][m][1], acc[ai][1][m][1]);
                v4u w; w.x = cvt_pk_bf16(v0[0], v0[1]); w.y = cvt_pk_bf16(v0[2], v0[3]); w.z = cvt_pk_bf16(v1[0], v1[1]); w.w = cvt_pk_bf16(v1[2], v1[3]);
                *(v4u*)(HS + (size_t)(row0 + ai * HALF + m * 16) * SDIM + cw) = w; }
    }
};
struct EpiDownY {
    static constexpr bool PERM = true;
    bf16* Y;
    __device__ __forceinline__ void operator()(const f32x4 (&acc)[2][2][4][2], const Unit& u, int wr, int wc, int fr, int fq) const {
        asm volatile("" : "+v"(fr), "+v"(fq));
        const int col0 = u.pn * BM + wc * 32 + 8 * fq;
#pragma unroll
        for (int ai = 0; ai < 2; ++ai)
#pragma unroll
            for (int m = 0; m < 4; ++m) { const int r = ai * HALF + wr * 64 + m * 16 + fr; bf16* rowp = Y + (size_t)(u.aux + r) * D + col0;
#pragma unroll
                for (int bj = 0; bj < 2; ++bj) { const f32x4 v0 = acc[ai][bj][m][0], v1 = acc[ai][bj][m][1];
                    v4u w; w.x = cvt_pk_bf16(v0[0], v0[1]); w.y = cvt_pk_bf16(v0[2], v0[3]); w.z = cvt_pk_bf16(v1[0], v1[1]); w.w = cvt_pk_bf16(v1[2], v1[3]);
                    *(v4u*)(rowp + bj * HALF) = w; } }
    }
};
}

struct Args { const float* in[19]; float* out; unsigned char* ws; int ph_lo, ph_hi; };
struct Frame {
    LAS unsigned char* lds; unsigned* ctl; unsigned char* ws;
    int tid, lane, wave, G, bid;
};
enum { IN_X = 0, IN_RELB, IN_PWIN, IN_PWG, IN_PSC, IN_PWOUT, IN_DQKV, IN_DOUT, IN_CWIN, IN_CW, IN_CWOUT, IN_LNG, IN_LNB, IN_RW, IN_RB, IN_EGU, IN_ED, IN_SGU, IN_SD };

#define CAS __attribute__((address_space(4)))
typedef const CAS unsigned char* KP;
__device__ __forceinline__ const float* ain(KP kp, int i) { return (const float*)((const GAS float* const CAS*)kp)[i]; }
__device__ __forceinline__ float* aout(KP kp) { return (float*)((GAS float* const CAS*)kp)[19]; }
__device__ __forceinline__ void tr_item(const float* W, int K, int N, bf16* WT, int dstK, int mode, LAS float* scr, int item, int lane) {
    const int nblk = N / 32, kb = item / nblk, nb = item % nblk, k0 = 64 * kb, n0 = 32 * nb;
    int r0 = n0;
    if (mode == 1) { const int part = n0 / 2048, j = n0 % 2048; r0 = (part == 0) ? 4096 + j : 256 * (j / 128) + (part == 2 ? 128 : 0) + (j % 128); }
    if (mode == 2) { const int part = n0 / 256, j = n0 % 256; r0 = 256 * (j / 128) + 128 * part + (j % 128); }
#pragma unroll 8
    for (int i = 0; i < 32; ++i) { const int kk = 2 * i + (lane >> 5); scr[kk * 33 + (lane & 31)] = W[(size_t)(k0 + kk) * N + n0 + (lane & 31)]; }
    LDS_WAIT(); asm volatile("" ::: "memory");
    const int c = lane & 7;
#pragma unroll
    for (int j = 0; j < 4; ++j) { const int n = (lane >> 3) + 8 * j; const LAS float* s = scr + (8 * c) * 33 + n;
        v4u o; o.x = pk2(s[0 * 33], s[1 * 33]); o.y = pk2(s[2 * 33], s[3 * 33]); o.z = pk2(s[4 * 33], s[5 * 33]); o.w = pk2(s[6 * 33], s[7 * 33]);
        *(v4u*)(WT + (size_t)(r0 + n) * dstK + k0 + 8 * c) = o; }
    LDS_WAIT(); asm volatile("" ::: "memory");
}
__device__ __forceinline__ void phase_prologue(const Frame& F, KP kp) {
    LAS float* scr = (LAS float*)(F.lds + F.wave * 16384);
    const int gw = F.bid * 8 + F.wave, NGW = F.G * 8;
    constexpr int I0 = 2 * 2048, I1 = 8 * 128, I2 = 2 * 2048, I3 = 4608, I4 = 512, I5 = 6144, I6 = 2048, I7 = 4 * 512, I8 = 4 * 256, I9 = 256 * 256, I10 = 256 * 128;
    constexpr int NITEMS = I0 + I1 + I2 + I3 + I4 + I5 + I6 + I7 + I8 + I9 + I10;
    unsigned char* ws = F.ws;
    for (int it = gw; it < NITEMS; it += NGW) {
        int r = it;
        if (r < I0) { const int b = r / 2048; tr_item(ain(kp, IN_PWIN) + (size_t)b * D * D, D, D, (bf16*)(ws + WS_W_POOL_IN) + (size_t)b * D * D, D, 0, scr, r % 2048, F.lane); continue; } r -= I0;
        if (r < I1) { const int b = r / 128; tr_item(ain(kp, IN_PWG) + (size_t)b * 512 * 512, 512, 512, (bf16*)(ws + WS_W_POOL_G) + (size_t)b * 512 * 512, 512, 0, scr, r % 128, F.lane); continue; } r -= I1;
        if (r < I2) { const int b = r / 2048; tr_item(ain(kp, IN_PWOUT) + (size_t)b * D * D, D, D, (bf16*)(ws + WS_W_POOL_OUT) + (size_t)b * D * D, D, 0, scr, r % 2048, F.lane); continue; } r -= I2;
        if (r < I3) { tr_item(ain(kp, IN_DQKV), D, QKVC, (bf16*)(ws + WS_W_DIL_QKV), D, 0, scr, r, F.lane); continue; } r -= I3;
        if (r < I4) { tr_item(ain(kp, IN_DOUT), DILW, D, (bf16*)(ws + WS_W_DIL_OUT), DILW, 0, scr, r, F.lane); continue; } r -= I4;
        if (r < I5) { tr_item(ain(kp, IN_CWIN), D, 3 * D, (bf16*)(ws + WS_W_CONV_IN), D, 1, scr, r, F.lane); continue; } r -= I5;
        if (r < I6) { tr_item(ain(kp, IN_CWOUT), D, D, (bf16*)(ws + WS_W_CONV_OUT), D, 0, scr, r, F.lane); continue; } r -= I6;
        if (r < I7) { const int b = r / 512; tr_item(ain(kp, IN_SGU) + (size_t)b * D * 512, D, 512, (bf16*)(ws + WS_W_SH_GU) + (size_t)b * 512 * D, D, 2, scr, r % 512, F.lane); continue; } r -= I7;
        if (r < I8) { const int b = r / 256; tr_item(ain(kp, IN_SD) + (size_t)b * SDIM * D, SDIM, D, (bf16*)(ws + WS_W_SH_D) + (size_t)b * D * SDIM, SDIM, 0, scr, r % 256, F.lane); continue; } r -= I8;
        if (r < I9) { const int b = r / 256; tr_item(ain(kp, IN_EGU) + (size_t)b * D * 256, D, 256, (bf16*)(ws + WS_W_EX_GU) + (size_t)b * 256 * D, D, 0, scr, r % 256, F.lane); continue; } r -= I9;
        { const int b = r / 128; tr_item(ain(kp, IN_ED) + (size_t)b * EDIM * D, EDIM, D, (bf16*)(ws + WS_W_EX_D) + (size_t)b * D * EDIM, EDIM, 0, scr, r % 128, F.lane); }
    }
    const size_t gt = (size_t)F.bid * 512 + F.tid, GT = (size_t)F.G * 512;
    { const float* rw = ain(kp, IN_RW); bf16* wh = (bf16*)(ws + WS_RWH); bf16* wl = (bf16*)(ws + WS_RWL);
      for (size_t i = gt; i < (size_t)DEPTH * NEXP * D / 8; i += GT) { const size_t k8 = i % (D / 8), e = (i / (D / 8)) % NEXP, l = i / ((size_t)NEXP * D / 8);
          float v[8]; unsigned hi[8], lo[8];
#pragma unroll
          for (int j = 0; j < 8; ++j) { v[j] = rw[(l * D + k8 * 8 + j) * NEXP + e]; hi[j] = f2bf(v[j]); lo[j] = f2bf(v[j] - __builtin_bit_cast(float, hi[j] << 16)); }
          v4u a, b2; a.x = hi[0] | (hi[1] << 16); a.y = hi[2] | (hi[3] << 16); a.z = hi[4] | (hi[5] << 16); a.w = hi[6] | (hi[7] << 16);
          b2.x = lo[0] | (lo[1] << 16); b2.y = lo[2] | (lo[3] << 16); b2.z = lo[4] | (lo[5] << 16); b2.w = lo[6] | (lo[7] << 16);
          *(v4u*)(wh + (l * NEXP + e) * D + k8 * 8) = a; *(v4u*)(wl + (l * NEXP + e) * D + k8 * 8) = b2; } }
    const float* x = ain(kp, IN_X); bf16* xb = (bf16*)(ws + WS_XB);
    for (size_t i = gt; i < (size_t)T * D / 8; i += GT) { const f32x4 p = *(const f32x4*)(x + i * 8), q = *(const f32x4*)(x + i * 8 + 4);
        v4u w; w.x = pk2(p[0], p[1]); w.y = pk2(p[2], p[3]); w.z = pk2(q[0], q[1]); w.w = pk2(q[2], q[3]); *(v4u*)(xb + i * 8) = w; }
}

__device__ __forceinline__ void unpack8(const v4u w, float (&f)[8]) { f[0] = bflo(w.x); f[1] = bfhi(w.x); f[2] = bflo(w.y); f[3] = bfhi(w.y); f[4] = bflo(w.z); f[5] = bfhi(w.z); f[6] = bflo(w.w); f[7] = bfhi(w.w); }
__device__ __forceinline__ void phase_pool(const Frame& F, const bf16* U, bf16* PL) {
    for (int it = F.bid * 512 + F.tid; it < (T / 32) * 256; it += F.G * 512) {
        const int cv = it & 255, ch = it >> 8, col = cv * 8, w = 2 << (col >> 9);
        const int row0 = ch * 32, pos0 = row0 & (SEQ - 1);
        float s[8], uu[8];
#pragma unroll
        for (int j = 0; j < 8; ++j) s[j] = 0.f;
        for (int j = 1; j < w; ++j) if (pos0 - j >= 0) { unpack8(*(const v4u*)(U + (size_t)(row0 - j) * D + col), uu);
#pragma unroll
            for (int q = 0; q < 8; ++q) s[q] += uu[q]; }
        for (int r = 0; r < 32; ++r) {
            const int t = row0 + r, pos = pos0 + r;
            unpack8(*(const v4u*)(U + (size_t)t * D + col), uu);
            const float inv = 1.0f / (float)((pos + 1) < w ? (pos + 1) : w);
            float o[8];
#pragma unroll
            for (int q = 0; q < 8; ++q) { s[q] += uu[q]; o[q] = s[q] * inv - uu[q]; }
            v4u ww; ww.x = pk2(o[0], o[1]); ww.y = pk2(o[2], o[3]); ww.z = pk2(o[4], o[5]); ww.w = pk2(o[6], o[7]);
            *(v4u*)(PL + (size_t)t * D + col) = ww;
            if (pos - w + 1 >= 0) { unpack8(*(const v4u*)(U + (size_t)(t - w + 1) * D + col), uu);
#pragma unroll
                for (int q = 0; q < 8; ++q) s[q] -= uu[q]; }
        }
    }
}

__device__ __forceinline__ void phase_conv(const Frame& F, const bf16* UC, const bf16* BGp, const float* cw, bf16* Z) {
    for (int it = F.bid * 512 + F.tid; it < T * 256; it += F.G * 512) {
        const int cv = it & 255, t = it >> 8, col = cv * 8, pos = t & (SEQ - 1);
        float u0[8], u1[8], u2[8], bb[8], o[8];
        unpack8(*(const v4u*)(UC + (size_t)t * D + col), u2);
        if (pos >= 1) unpack8(*(const v4u*)(UC + (size_t)(t - 1) * D + col), u1); else {
#pragma unroll
            for (int q = 0; q < 8; ++q) u1[q] = 0.f; }
        if (pos >= 2) unpack8(*(const v4u*)(UC + (size_t)(t - 2) * D + col), u0); else {
#pragma unroll
            for (int q = 0; q < 8; ++q) u0[q] = 0.f; }
        unpack8(*(const v4u*)(BGp + (size_t)t * D + col), bb);
#pragma unroll
        for (int q = 0; q < 8; ++q) o[q] = bb[q] * (cw[col + q] * u0[q] + cw[D + col + q] * u1[q] + cw[2 * D + col + q] * u2[q]);
        v4u ww; ww.x = pk2(o[0], o[1]); ww.y = pk2(o[2], o[3]); ww.z = pk2(o[4], o[5]); ww.w = pk2(o[6], o[7]);
        *(v4u*)(Z + (size_t)t * D + col) = ww;
    }
}

__device__ __forceinline__ int t5_bucket(int dist) {
    if (dist < 16) return dist;
    int large = 16 + (int)(logf((float)dist / 16.0f) / logf(128.0f) * 16.0f);
    return large < 31 ? large : 31;
}
constexpr int AT_KS = 0, AT_KSTR = 144, AT_VT = 256 * 144, AT_VSTR = 520, AT_BIAS = AT_VT + 64 * 520;
__device__ __forceinline__ void phase_attn(const Frame& F, const bf16* QKV, const float* relb, bf16* OG, float* LSE) {
    LAS unsigned char* lds = F.lds;
    const int tid = F.tid, lane = F.lane, w = tid >> 6, fr = lane & 15, fq = lane >> 4;
    for (int unit = F.bid; unit < NBATCH * 3 * 8 * 16; unit += F.G) {
        const int cmb = unit & 15, h = (unit >> 4) & 7, g = (unit >> 7) % 3, b = unit / 384;
        const int dsh = 2 * g, dil = 1 << dsh, r = cmb & (dil - 1), nb = cmb >> dsh;
        const bf16* base = QKV + (size_t)b * SEQ * QKVC + g * 1536 + h * 64;
        __syncthreads();
        {
            const int key = tid >> 1, half = tid & 1, jk = (nb - 1) * 128 + key;
            v4u kv[4], vv[4];
            if (jk >= 0) { const bf16* rp = base + (size_t)(jk * dil + r) * QKVC + half * 32;
#pragma unroll
                for (int i = 0; i < 4; ++i) { kv[i] = *(const v4u*)(rp + 512 + 8 * i); vv[i] = *(const v4u*)(rp + 1024 + 8 * i); } }
            else {
#pragma unroll
                for (int i = 0; i < 4; ++i) { kv[i] = (v4u){0u, 0u, 0u, 0u}; vv[i] = (v4u){0u, 0u, 0u, 0u}; } }
#pragma unroll
            for (int i = 0; i < 4; ++i) *(LAS v4u*)(lds + AT_KS + key * AT_KSTR + half * 64 + 16 * i) = kv[i];
#pragma unroll
            for (int i = 0; i < 4; ++i) {
                const unsigned ww[4] = {vv[i].x, vv[i].y, vv[i].z, vv[i].w};
#pragma unroll
                for (int q = 0; q < 4; ++q) { const int d = half * 32 + 8 * i + 2 * q;
                    *(LAS unsigned short*)(lds + AT_VT + d * AT_VSTR + key * 2) = (unsigned short)(ww[q] & 0xffffu);
                    *(LAS unsigned short*)(lds + AT_VT + (d + 1) * AT_VSTR + key * 2) = (unsigned short)(ww[q] >> 16); } }
            if (tid <= 128) ((LAS float*)(lds + AT_BIAS))[tid] = relb[t5_bucket(tid * dil) * 24 + g * 8 + h];
        }
        __syncthreads();
        int qi = 16 * w + fr; asm volatile("" : "+v"(qi));
        const int jq = nb * 128 + qi, tq = jq * dil + r;
        const bf16* qp = base + (size_t)tq * QKVC + 8 * fq;
        const bf16x8 q0 = *(const bf16x8*)qp, q1 = *(const bf16x8*)(qp + 32);
        f32x4 s[9]; float mx = -INFINITY;
#pragma unroll
        for (int kt = 0; kt < 9; ++kt) {
            const int kb = 16 * (w + kt);
            const bf16x8 k0 = *(const LAS bf16x8*)(lds + AT_KS + (kb + fr) * AT_KSTR + fq * 16), k1 = *(const LAS bf16x8*)(lds + AT_KS + (kb + fr) * AT_KSTR + 64 + fq * 16);
            f32x4 a = (f32x4){0.f, 0.f, 0.f, 0.f};
            a = __builtin_amdgcn_mfma_f32_16x16x32_bf16(k0, q0, a, 0, 0, 0);
            a = __builtin_amdgcn_mfma_f32_16x16x32_bf16(k1, q1, a, 0, 0, 0);
#pragma unroll
            for (int i = 0; i < 4; ++i) { const int kl = kb + 4 * fq + i, rel = qi + 128 - kl;
                const bool ok = (rel >= 0) && (rel <= 128) && (nb > 0 || kl >= 128);
                const int rc = rel < 0 ? 0 : (rel > 128 ? 128 : rel);
                const float v = ok ? a[i] + ((LAS float*)(lds + AT_BIAS))[rc] : -INFINITY;
                a[i] = v; mx = fmaxf(mx, v); }
            s[kt] = a;
        }
        mx = fmaxf(mx, shfl_x(mx, 16, lane)); mx = fmaxf(mx, shfl_x(mx, 32, lane));
        float l = 0.f;
#pragma unroll
        for (int kt = 0; kt < 9; ++kt)
#pragma unroll
            for (int i = 0; i < 4; ++i) { const float p = __expf(s[kt][i] - mx); s[kt][i] = p; l += p; }
        l += shfl_x(l, 16, lane); l += shfl_x(l, 32, lane);
        f32x4 o[4];
#pragma unroll
        for (int nt = 0; nt < 4; ++nt) o[nt] = (f32x4){0.f, 0.f, 0.f, 0.f};
#pragma unroll
        for (int st = 0; st < 5; ++st) {
            const int kt0 = 2 * st, kt1 = 2 * st + 1;
            v4u pw; pw.x = pk2(s[kt0][0], s[kt0][1]); pw.y = pk2(s[kt0][2], s[kt0][3]);
            if (kt1 < 9) { pw.z = pk2(s[kt1 < 9 ? kt1 : 0][0], s[kt1 < 9 ? kt1 : 0][1]); pw.w = pk2(s[kt1 < 9 ? kt1 : 0][2], s[kt1 < 9 ? kt1 : 0][3]); } else { pw.z = 0u; pw.w = 0u; }
            const bf16x8 pf = __builtin_bit_cast(bf16x8, pw);
            const int kb0 = 16 * (w + kt0) + 4 * fq, kb1 = 16 * (w + kt1) + 4 * fq;
#pragma unroll
            for (int nt = 0; nt < 4; ++nt) { const int d = 16 * nt + fr;
                v2u va = *(const LAS v2u*)(lds + AT_VT + d * AT_VSTR + kb0 * 2), vb = (v2u){0u, 0u};
                if (kt1 < 9) vb = *(const LAS v2u*)(lds + AT_VT + d * AT_VSTR + kb1 * 2);
                v4u vw; vw.x = va.x; vw.y = va.y; vw.z = vb.x; vw.w = vb.y;
                o[nt] = __builtin_amdgcn_mfma_f32_16x16x32_bf16(__builtin_bit_cast(bf16x8, vw), pf, o[nt], 0, 0, 0); }
        }
        const float il = 1.0f / l;
        bf16* op = OG + ((size_t)g * T + (size_t)b * SEQ + tq) * DILW + h * 64 + 4 * fq;
#pragma unroll
        for (int nt = 0; nt < 4; ++nt) { v2u ww; ww.x = pk2(o[nt][0] * il, o[nt][1] * il); ww.y = pk2(o[nt][2] * il, o[nt][3] * il); *(v2u*)(op + 16 * nt) = ww; }
        if (fq == 0) LSE[((size_t)g * T + (size_t)b * SEQ + tq) * 8 + h] = mx + logf(l);
    }
}
__device__ __forceinline__ void phase_combine(const Frame& F, const bf16* OG, const float* LSE, bf16* O) {
    for (int it = F.bid * 512 + F.tid; it < T * 64; it += F.G * 512) {
        const int c8 = it & 7, h = (it >> 3) & 7, t = it >> 6;
        const float l0 = LSE[((size_t)0 * T + t) * 8 + h], l1 = LSE[((size_t)1 * T + t) * 8 + h], l2 = LSE[((size_t)2 * T + t) * 8 + h];
        const float m = fmaxf(l0, fmaxf(l1, l2)); float w0 = __expf(l0 - m), w1 = __expf(l1 - m), w2 = __expf(l2 - m); const float inv = 1.0f / (w0 + w1 + w2); w0 *= inv; w1 *= inv; w2 *= inv;
        float a[8], bq[8], c[8], o[8]; const size_t off = (size_t)t * DILW + h * 64 + c8 * 8;
        unpack8(*(const v4u*)(OG + off), a); unpack8(*(const v4u*)(OG + (size_t)T * DILW + off), bq); unpack8(*(const v4u*)(OG + (size_t)2 * T * DILW + off), c);
#pragma unroll
        for (int q = 0; q < 8; ++q) o[q] = w0 * a[q] + w1 * bq[q] + w2 * c[q];
        v4u ww; ww.x = pk2(o[0], o[1]); ww.y = pk2(o[2], o[3]); ww.z = pk2(o[4], o[5]); ww.w = pk2(o[6], o[7]);
        *(v4u*)(O + off) = ww;
    }
}

constexpr int M1_LOG = 131072, M1_STAT = M1_LOG + 4096, M1_HIST = M1_STAT + 128, M1_BASE = M1_HIST + 256;
__device__ __forceinline__ void phase_moe1(const Frame& F, const float* Y, const float* gain, const float* bias, const float* RW, const float* RB,
                                           float* X1F, bf16* X1B, unsigned* cnt, int* ltok, float* lgate, int* eidx, int* inv) {
    LAS float* xs = (LAS float*)F.lds; LAS float* logit = (LAS float*)(F.lds + M1_LOG); LAS float* stat = (LAS float*)(F.lds + M1_STAT);
    LAS int* hist = (LAS int*)(F.lds + M1_HIST); LAS int* basep = (LAS int*)(F.lds + M1_BASE);
    const int tid = F.tid, lane = F.lane, w = F.wave;
    for (int rg = F.bid; rg < T / 16; rg += F.G) {
        const int row0 = rg * 16;
        __syncthreads();
#pragma unroll
        for (int j = 0; j < 16; ++j) { const int idx = tid + 512 * j; *(LAS f32x4*)(xs + idx * 4) = *(const f32x4*)(Y + (size_t)row0 * D + (size_t)idx * 4); }
        if (tid < 64) hist[tid] = 0;
        __syncthreads();
#pragma unroll
        for (int rr = 0; rr < 2; ++rr) { const int r = 2 * w + rr; float sm = 0.f;
#pragma unroll
            for (int j = 0; j < 32; ++j) sm += xs[r * D + lane + 64 * j];
            const float mean = wave_sum(sm, lane) * (1.0f / D); float sq = 0.f;
#pragma unroll
            for (int j = 0; j < 32; ++j) { const float d = xs[r * D + lane + 64 * j] - mean; sq += d * d; }
            const float rstd = 1.0f / sqrtf(wave_sum(sq, lane) * (1.0f / D) + LN_EPS);
            if (lane == 0) { stat[2 * r] = mean; stat[2 * r + 1] = rstd; } }
        __syncthreads();
#pragma unroll
        for (int j = 0; j < 16; ++j) { const int idx = tid + 512 * j, r = idx >> 9, c4 = (idx & 511) * 4;
            const f32x4 v = *(LAS f32x4*)(xs + idx * 4), gv = *(const f32x4*)(gain + c4), bv = *(const f32x4*)(bias + c4);
            const float mean = stat[2 * r], rstd = stat[2 * r + 1];
            const f32x4 o = (v - mean) * rstd * gv + bv;
            *(LAS f32x4*)(xs + idx * 4) = o;
            *(f32x4*)(X1F + (size_t)(row0 + r) * D + c4) = o;
            v2u wb; wb.x = pk2(o[0], o[1]); wb.y = pk2(o[2], o[3]); *(v2u*)(X1B + (size_t)(row0 + r) * D + c4) = wb; }
        __syncthreads();
        { const int r = tid >> 5, ep = tid & 31; float a0 = 0.f, a1 = 0.f; const float* wp = RW + 2 * ep; const LAS float* xr = xs + r * D;
            for (int k0 = 0; k0 < D; k0 += 16) {
                f32x2 wv[16];
#pragma unroll
                for (int j = 0; j < 16; ++j) wv[j] = *(const f32x2*)(wp + (size_t)(k0 + j) * NEXP);
                asm volatile("" : "+v"(wv[0]), "+v"(wv[1]), "+v"(wv[2]), "+v"(wv[3]), "+v"(wv[4]), "+v"(wv[5]), "+v"(wv[6]), "+v"(wv[7]));
                asm volatile("" : "+v"(wv[8]), "+v"(wv[9]), "+v"(wv[10]), "+v"(wv[11]), "+v"(wv[12]), "+v"(wv[13]), "+v"(wv[14]), "+v"(wv[15]));
#pragma unroll
                for (int j = 0; j < 16; ++j) { const float xv = xr[k0 + j]; a0 += xv * wv[j].x; a1 += xv * wv[j].y; } }
            logit[r * NEXP + 2 * ep] = a0; logit[r * NEXP + 2 * ep + 1] = a1; }
        __syncthreads();
        int sel_pos[2]; float sel_gate[2]; int sel_rank[2]; bool sel_on[2];
#pragma unroll
        for (int rr = 0; rr < 2; ++rr) { const int r = 2 * w + rr;
            const float sc = 1.0f / (1.0f + __expf(-logit[r * NEXP + lane])); const float ch = sc + RB[lane];
            int rk = 0;
#pragma unroll
            for (int j = 0; j < 8; ++j) { const float cj = shfl_from(ch, (lane & ~7) + j); rk += (cj > ch || (cj == ch && j < (lane & 7))) ? 1 : 0; }
            float gs = rk < 2 ? ch : 0.f; gs += shfl_x(gs, 1, lane); gs += shfl_x(gs, 2, lane); gs += shfl_x(gs, 4, lane);
            int grk = 0; const int g = lane >> 3;
#pragma unroll
            for (int hh = 0; hh < 8; ++hh) { const float gh = shfl_from(gs, 8 * hh); grk += (gh > gs || (gh == gs && hh < g)) ? 1 : 0; }
            const float msk = grk < 4 ? ch : -INFINITY;
            int erk = 0;
            for (int j = 0; j < 64; ++j) { const float mj = __builtin_bit_cast(float, __builtin_amdgcn_readlane(__builtin_bit_cast(int, msk), j)); erk += (mj > msk || (mj == msk && j < lane)) ? 1 : 0; }
            const bool on = erk < 8;
            const float ssum = wave_sum(on ? sc : 0.f, lane);
            sel_on[rr] = on; sel_rank[rr] = erk; sel_gate[rr] = sc / ssum * 2.5f; sel_pos[rr] = 0;
            if (on) sel_pos[rr] = __hip_atomic_fetch_add(&hist[lane], 1, __ATOMIC_RELAXED, __HIP_MEMORY_SCOPE_WORKGROUP); }
        __syncthreads();
        if (tid < 64) { const int hc = hist[tid]; int bs = 0; if (hc > 0) bs = (int)atomicAdd(&cnt[tid * 16], (unsigned)hc); basep[tid] = bs; }
        __syncthreads();
#pragma unroll
        for (int rr = 0; rr < 2; ++rr) if (sel_on[rr]) { const int t = row0 + 2 * w + rr, pos = basep[lane] + sel_pos[rr];
            ltok[(size_t)lane * CAP + pos] = t; lgate[(size_t)lane * CAP + pos] = sel_gate[rr];
            eidx[t * 8 + sel_rank[rr]] = lane; inv[t * 8 + sel_rank[rr]] = pos; }
    }
}
__device__ __forceinline__ int build_tiles(const Frame& F, const unsigned* cnt) {
    LAS int* tpref = (LAS int*)(F.lds + LDS_TAB); LAS int* cl = (LAS int*)(F.lds + LDS_TAB + 512);
    __syncthreads();
    if (F.tid < 64) cl[F.tid] = (int)__hip_atomic_load(&cnt[F.tid * 16], __ATOMIC_RELAXED, __HIP_MEMORY_SCOPE_AGENT);
    __syncthreads();
    if (F.tid == 0) { int acc = 0; for (int e = 0; e < 64; ++e) { tpref[e] = acc; acc += (cl[e] + 255) >> 8; } tpref[64] = acc; tpref[65] = acc + T / 256; tpref[66] = acc + 2 * (T / 256); cl[64] = T; cl[65] = T; }
    __syncthreads();
    return __builtin_amdgcn_readfirstlane(tpref[64]);
}
__device__ __forceinline__ void phase_moe4(const Frame& F, const float* Y2, const bf16* Yr, const int* eidx, const int* inv, const float* gain, const float* bias, float* XO, bf16* XBo) {
    const LAS int* tpref = (const LAS int*)(F.lds + LDS_TAB);
    const int gw = F.bid * 8 + F.wave, NGW = F.G * 8, lane = F.lane;
    for (int t = gw; t < T; t += NGW) {
        f32x4 v[8];
#pragma unroll
        for (int j = 0; j < 8; ++j) v[j] = *(const f32x4*)(Y2 + (size_t)t * D + 4 * lane + 256 * j);
        for (int k = 0; k < 8; ++k) { const int e = eidx[t * 8 + k], pos = inv[t * 8 + k]; const bf16* yr = Yr + (size_t)(tpref[e] * 256 + pos) * D + 4 * lane;
#pragma unroll
            for (int j = 0; j < 8; ++j) { const v2u w = *(const v2u*)(yr + 256 * j); v[j][0] += bflo(w.x); v[j][1] += bfhi(w.x); v[j][2] += bflo(w.y); v[j][3] += bfhi(w.y); } }
        float sm = 0.f;
#pragma unroll
        for (int j = 0; j < 8; ++j) sm += (v[j][0] + v[j][1]) + (v[j][2] + v[j][3]);
        const float mean = wave_sum(sm, lane) * (1.0f / D); float sq = 0.f;
#pragma unroll
        for (int j = 0; j < 8; ++j) { v[j] = v[j] - mean; sq += (v[j][0] * v[j][0] + v[j][1] * v[j][1]) + (v[j][2] * v[j][2] + v[j][3] * v[j][3]); }
        const float rstd = 1.0f / sqrtf(wave_sum(sq, lane) * (1.0f / D) + LN_EPS);
#pragma unroll
        for (int j = 0; j < 8; ++j) { const int c = 4 * lane + 256 * j; const f32x4 o = v[j] * rstd * *(const f32x4*)(gain + c) + *(const f32x4*)(bias + c);
            *(f32x4*)(XO + (size_t)t * D + c) = o;
            v2u wb; wb.x = pk2(o[0], o[1]); wb.y = pk2(o[2], o[3]); *(v2u*)(XBo + (size_t)t * D + c) = wb; }
    }
}


constexpr int M1_P = 0, M1N_HIST = 131072, M1N_BASE = 131072 + 256, M1N_GB = 131072 + 1024;
__device__ __forceinline__ void phase_moe1n(const Frame& F, const bf16* Y, const float* pst, const float* gain, const float* bias, const bf16* WH, const bf16* WL, const float* RB,
                                            bf16* X1B, float* ST1, unsigned* cnt, int* ltok, float* lgate, int* eidx, int* inv) {
    LAS float* P = (LAS float*)(F.lds + M1_P); LAS int* hist = (LAS int*)(F.lds + M1N_HIST); LAS int* basep = (LAS int*)(F.lds + M1N_BASE);
    const int tid = F.tid, lane = F.lane, w = F.wave, r = lane & 15, q = lane >> 4;
    for (int item = F.bid; item < T / 64; item += F.G) {
        const int row0 = item * 64;
        __syncthreads();
        if (tid < 64) hist[tid] = 0;
        { LAS f32x4* gb = (LAS f32x4*)(F.lds + M1N_GB); gb[tid] = *(const f32x4*)(gain + 4 * tid); gb[512 + tid] = *(const f32x4*)(bias + 4 * tid); }
        __syncthreads();
        float mean[4], rstd[4];
#pragma unroll
        for (int rt = 0; rt < 4; ++rt) { const int row = row0 + 16 * rt + r;
          const f32x4* pp = (const f32x4*)(pst + ((size_t)row * 32 + q * 8) * 2); const f32x4 a = pp[0], b = pp[1], c = pp[2], d = pp[3];
          float sm = (a[0] + a[2]) + (b[0] + b[2]) + (c[0] + c[2]) + (d[0] + d[2]), sq = (a[1] + a[3]) + (b[1] + b[3]) + (c[1] + c[3]) + (d[1] + d[3]);
          sm += shfl_x(sm, 16, lane); sm += shfl_x(sm, 32, lane); sq += shfl_x(sq, 16, lane); sq += shfl_x(sq, 32, lane);
          mean[rt] = sm * (1.0f / D); const float var = fmaxf(sq * (1.0f / D) - mean[rt] * mean[rt], 0.f); rstd[rt] = 1.0f / sqrtf(var + LN_EPS);
          if (w == 0 && q == 0) *(f32x2*)(ST1 + 2 * row) = (f32x2){mean[rt], rstd[rt]}; }
        const int kb = 256 * w + 8 * q;
        const LAS float* gl = (const LAS float*)(F.lds + M1N_GB) + kb;
        f32x4 acc[4][4];
#pragma unroll
        for (int rt = 0; rt < 4; ++rt)
#pragma unroll
            for (int nt = 0; nt < 4; ++nt) acc[rt][nt] = (f32x4){0.f, 0.f, 0.f, 0.f};
        v4u yb[3][4]; bf16x8 wh[4], wl[4];
        unsigned vo[4];
#pragma unroll
        for (int i = 0; i < 4; ++i) { vo[i] = (unsigned)(r * D + kb) * 2u + (unsigned)i * (16u * D * 2u); asm volatile("" : "+v"(vo[i])); }
        const char* ybase = (const char*)(Y + (size_t)row0 * D); char* xbase = (char*)(X1B + (size_t)row0 * D);
#define M1_LOADY(st) do { _Pragma("unroll") for (int rt = 0; rt < 4; ++rt) yb[(st) % 3][rt] = *(const v4u*)(ybase + vo[rt] + 64 * (st)); } while (0)
#define M1_LOADW(st) do { _Pragma("unroll") for (int nt = 0; nt < 4; ++nt) { wh[nt] = *(const bf16x8*)((const char*)WH + vo[nt] + 64 * (st)); wl[nt] = *(const bf16x8*)((const char*)WL + vo[nt] + 64 * (st)); } } while (0)
        M1_LOADY(0); M1_LOADW(0); M1_LOADY(1);
        __builtin_amdgcn_sched_barrier(0);
#pragma unroll
        for (int st = 0; st < 8; ++st) {
            const f32x4 g0 = *(const LAS f32x4*)(gl + 32 * st), g1 = *(const LAS f32x4*)(gl + 32 * st + 4), b0 = *(const LAS f32x4*)(gl + 2048 + 32 * st), b1 = *(const LAS f32x4*)(gl + 2048 + 32 * st + 4);
#pragma unroll
            for (int rt = 0; rt < 4; ++rt) { const v4u yv = yb[st % 3][rt];
                const f32x4 y0_ = (f32x4){bflo(yv.x), bfhi(yv.x), bflo(yv.y), bfhi(yv.y)}, y1_ = (f32x4){bflo(yv.z), bfhi(yv.z), bflo(yv.w), bfhi(yv.w)};
                const f32x4 x0 = (y0_ - mean[rt]) * rstd[rt] * g0 + b0, x1 = (y1_ - mean[rt]) * rstd[rt] * g1 + b1;
                v4u h; h.x = cvt_pk_bf16(x0[0], x0[1]); h.y = cvt_pk_bf16(x0[2], x0[3]); h.z = cvt_pk_bf16(x1[0], x1[1]); h.w = cvt_pk_bf16(x1[2], x1[3]);
                *(v4u*)(xbase + vo[rt] + 64 * st) = h;
                v4u l; l.x = cvt_pk_bf16(x0[0] - bflo(h.x), x0[1] - bfhi(h.x)); l.y = cvt_pk_bf16(x0[2] - bflo(h.y), x0[3] - bfhi(h.y));
                l.z = cvt_pk_bf16(x1[0] - bflo(h.z), x1[1] - bfhi(h.z)); l.w = cvt_pk_bf16(x1[2] - bflo(h.w), x1[3] - bfhi(h.w));
                const bf16x8 xh = __builtin_bit_cast(bf16x8, h), xl = __builtin_bit_cast(bf16x8, l);
#pragma unroll
                for (int nt = 0; nt < 4; ++nt) { acc[rt][nt] = __builtin_amdgcn_mfma_f32_16x16x32_bf16(xh, wh[nt], acc[rt][nt], 0, 0, 0);
                    acc[rt][nt] = __builtin_amdgcn_mfma_f32_16x16x32_bf16(xl, wh[nt], acc[rt][nt], 0, 0, 0); acc[rt][nt] = __builtin_amdgcn_mfma_f32_16x16x32_bf16(xh, wl[nt], acc[rt][nt], 0, 0, 0); } }
            __builtin_amdgcn_sched_barrier(0);
            if (st + 1 < 8) M1_LOADW(st + 1);
            if (st + 2 < 8) M1_LOADY(st + 2);
            __builtin_amdgcn_sched_barrier(0);
        }
#undef M1_LOADY
#undef M1_LOADW
#pragma unroll
        for (int rt = 0; rt < 4; ++rt)
#pragma unroll
            for (int nt = 0; nt < 4; ++nt)
#pragma unroll
                for (int i = 0; i < 4; ++i) P[(w * 64 + 16 * rt + 4 * q + i) * 64 + 16 * nt + r] = acc[rt][nt][i];
        __syncthreads();
        int sel_pos[8]; float sel_gate[8]; int sel_rank[8]; bool sel_on[8];
        const float rb = RB[lane];
#pragma unroll
        for (int rr = 0; rr < 8; ++rr) { const int rl = 8 * w + rr;
            float lg = ((P[rl * 64 + lane] + P[(64 + rl) * 64 + lane]) + (P[(128 + rl) * 64 + lane] + P[(192 + rl) * 64 + lane])) + ((P[(256 + rl) * 64 + lane] + P[(320 + rl) * 64 + lane]) + (P[(384 + rl) * 64 + lane] + P[(448 + rl) * 64 + lane]));
            lg = (lg == lg) ? lg : -1.0e30f;
            const float sc = 1.0f / (1.0f + __expf(-lg)); const float ch = sc + rb;
            int rk = 0;
#pragma unroll
            for (int j = 0; j < 8; ++j) { const float cj = shfl_from(ch, (lane & ~7) + j); rk += (cj > ch || (cj == ch && j < (lane & 7))) ? 1 : 0; }
            float gs = rk < 2 ? ch : 0.f; gs += shfl_x(gs, 1, lane); gs += shfl_x(gs, 2, lane); gs += shfl_x(gs, 4, lane);
            int grk = 0; const int g = lane >> 3;
#pragma unroll
            for (int hh = 0; hh < 8; ++hh) { const float gh = shfl_from(gs, 8 * hh); grk += (gh > gs || (gh == gs && hh < g)) ? 1 : 0; }
            const float msk = grk < 4 ? ch : -INFINITY;
            int erk = 0;
            for (int j = 0; j < 64; ++j) { const float mj = __builtin_bit_cast(float, __builtin_amdgcn_readlane(__builtin_bit_cast(int, msk), j)); erk += (mj > msk || (mj == msk && j < lane)) ? 1 : 0; }
            const bool on = erk < 8;
            const float ssum = wave_sum(on ? sc : 0.f, lane);
            sel_on[rr] = on; sel_rank[rr] = erk; sel_gate[rr] = sc / ssum * 2.5f; sel_pos[rr] = 0;
            if (on) sel_pos[rr] = __hip_atomic_fetch_add(&hist[lane], 1, __ATOMIC_RELAXED, __HIP_MEMORY_SCOPE_WORKGROUP); }
        __syncthreads();
        if (tid < 64) { int tt = tid; asm volatile("" : "+v"(tt));
            const int hc = hist[tt]; int bs = 0; if (hc > 0) bs = (int)atomicAdd(&cnt[tt * 16], (unsigned)hc); basep[tt] = bs; }
        __syncthreads();
#pragma unroll
        for (int rr = 0; rr < 8; ++rr) if (sel_on[rr]) { const int t = row0 + 8 * w + rr, pos = basep[lane] + sel_pos[rr];
            ltok[(size_t)lane * CAP + pos] = t * 8 + sel_rank[rr]; lgate[(size_t)lane * CAP + pos] = sel_gate[rr];
            eidx[t * 8 + sel_rank[rr]] = lane; inv[t * 8 + sel_rank[rr]] = pos; }
    }
}

constexpr int M3_PL = 131072, M3_CNT = 147456, M3_OFF = 147456 + 272;
__device__ __forceinline__ void phase_moe3n(const Frame& F, const bf16* H, const bf16* HSp, const int* eidx, const bf16* WD, const bf16* WSD,
                                            const float* Y1, const float* ST1, const float* g1, const float* b1, float* Y2, float* PST2) {
    LAS int* out = (LAS int*)F.lds; LAS unsigned short* plist = (LAS unsigned short*)(F.lds + M3_PL); LAS int* cnt = (LAS int*)(F.lds + M3_CNT); LAS int* off = (LAS int*)(F.lds + M3_OFF);
    const int tid = F.tid, lane = F.lane, w = F.wave, r = lane & 15, q = lane >> 4;
    for (int u = F.bid; u < 1024; u += F.G) {
        int nc = (u & 7) | ((u >> 7) << 3), tb = (u >> 3) & 15;
        if (F.G == 256) { const int i = u >> 8, x = u & 7, j = (u >> 3) & 31; tb = 2 * x + (i >> 1); nc = 32 * (i & 1) + j; }
        __syncthreads();
#pragma unroll
        for (int j = 0; j < 16; ++j) ((LAS v4u*)out)[tid + 512 * j] = (v4u){0u, 0u, 0u, 0u};
        if (tid < 66) cnt[tid] = 0;
        __syncthreads();
        int ee[16], pp[16];
        { const v4u* ep = (const v4u*)(eidx + ((size_t)tb * 1024 + 2 * tid) * 8); const v4u e0 = ep[0], e1 = ep[1], e2 = ep[2], e3 = ep[3];
          ee[0] = e0.x; ee[1] = e0.y; ee[2] = e0.z; ee[3] = e0.w; ee[4] = e1.x; ee[5] = e1.y; ee[6] = e1.z; ee[7] = e1.w;
          ee[8] = e2.x; ee[9] = e2.y; ee[10] = e2.z; ee[11] = e2.w; ee[12] = e3.x; ee[13] = e3.y; ee[14] = e3.z; ee[15] = e3.w; }
#pragma unroll
        for (int j = 0; j < 16; ++j) pp[j] = __hip_atomic_fetch_add(&cnt[ee[j]], 1, __ATOMIC_RELAXED, __HIP_MEMORY_SCOPE_WORKGROUP);
        __syncthreads();
        if (w == 0) { int c = cnt[lane], x = c;
#pragma unroll
            for (int o = 1; o < 64; o <<= 1) { const int y = __builtin_amdgcn_ds_bpermute(((lane - o) & 63) << 2, x); if (lane >= o) x += y; }
            off[lane] = x - c; if (lane == 63) off[64] = x; }
        __syncthreads();
#pragma unroll
        for (int j = 0; j < 16; ++j) plist[off[ee[j]] + pp[j]] = (unsigned short)(tid * 16 + j);
        __syncthreads();
        const char* Hb = (const char*)H + (size_t)tb * 8192 * 256 + q * 16;
        const char* HSb = (const char*)HSp + (size_t)tb * 1024 * 512 + q * 16;
        const char* Bb = (const char*)WD + ((size_t)nc * 32 + r) * 256 + q * 16;
        const char* BSb = (const char*)WSD + ((size_t)nc * 32 + r) * 512 + q * 16;
#define M3_NR(sg) ((sg) < 8 ? __builtin_amdgcn_readfirstlane(cnt[w + 8 * (sg)]) : 128)
#define M3_RB(sg) ((sg) < 8 ? __builtin_amdgcn_readfirstlane(off[w + 8 * (sg)]) : 0)
#define M3_GLD(dst, ptr, OFF) asm volatile("global_load_dwordx4 %0, %1, off offset:" #OFF : "=&v"(dst) : "v"(ptr) : "memory")
#define M3_LOADB(dst, sg) do { const char* _b0 = (sg) < 8 ? Bb + (size_t)(w + 8 * (sg)) * 524288 : BSb + ((sg) - 8) * 256; const char* _b1 = _b0 + ((sg) < 8 ? 4096 : 8192); \
            M3_GLD(dst[0][0], _b0, 0); M3_GLD(dst[0][1], _b0, 64); M3_GLD(dst[0][2], _b0, 128); M3_GLD(dst[0][3], _b0, 192); \
            M3_GLD(dst[1][0], _b1, 0); M3_GLD(dst[1][1], _b1, 64); M3_GLD(dst[1][2], _b1, 128); M3_GLD(dst[1][3], _b1, 192); } while (0)
#define M3_LOADA(dst, sg, bb, nr, rbs) do { int _i = 16 * (bb) + r; _i = _i < (nr) ? _i : (nr) - 1; const unsigned _rid = plist[(rbs) + _i]; \
            const char* _a = (sg) < 8 ? Hb + (size_t)_rid * 256 : ((sg) < 10 ? HSb + (size_t)(128 * w + _i) * 512 + ((sg) - 8) * 256 : Hb); \
            M3_GLD(dst[0], _a, 0); M3_GLD(dst[1], _a, 64); M3_GLD(dst[2], _a, 128); M3_GLD(dst[3], _a, 192); } while (0)
#define M3_ADV(sg, bb, nr, rbs) do { if ((sg) < 10) { ++(bb); if ((bb) * 16 >= (nr)) { (bb) = 0; do { ++(sg); } while ((sg) < 8 && M3_NR(sg) == 0); if ((sg) < 10) { (nr) = M3_NR(sg); (rbs) = M3_RB(sg); } } } } while (0)
#define M3_WAITA(AS) asm volatile("s_waitcnt vmcnt(12)" : "+v"(AS[0]), "+v"(AS[1]), "+v"(AS[2]), "+v"(AS[3]) :: "memory")
#define M3_WAITB(N) asm volatile("s_waitcnt vmcnt(" #N ")" : "+v"(Bn[0][0]), "+v"(Bn[0][1]), "+v"(Bn[0][2]), "+v"(Bn[0][3]), "+v"(Bn[1][0]), "+v"(Bn[1][1]), "+v"(Bn[1][2]), "+v"(Bn[1][3]) :: "memory")
#define M3_STEP(AS) if (cseg < 10) { \
              \
            int tk[4]; bool ok[4]; unsigned pl[4]; const int rt_ = cseg < 8; \
            _Pragma("unroll") for (int i = 0; i < 4; ++i) { const int idx = 16 * cbt + 4 * q + i; ok[i] = idx < cnr; const int ic = ok[i] ? idx : cnr - 1; pl[i] = plist[crbs + ic]; tk[i] = 128 * w + ic; } \
            _Pragma("unroll") for (int i = 0; i < 4; ++i) tk[i] = rt_ ? (int)(pl[i] >> 3) : tk[i]; \
            M3_WAITA(AS); \
            f32x4 acc[2]; \
            _Pragma("unroll") for (int nt = 0; nt < 2; ++nt) { acc[nt] = (f32x4){0.f, 0.f, 0.f, 0.f}; \
                _Pragma("unroll") for (int kk = 0; kk < 4; ++kk) acc[nt] = __builtin_amdgcn_mfma_f32_16x16x32_bf16(__builtin_bit_cast(bf16x8, AS[kk]), __builtin_bit_cast(bf16x8, Bc[nt][kk]), acc[nt], 0, 0, 0); } \
              \
            _Pragma("unroll") for (int i = 0; i < 4; ++i) { const long long lo_ = ok[i] ? (long long)__float2int_rn(acc[0][i] * 4194304.0f) : 0ll, hi_ = ok[i] ? (long long)__float2int_rn(acc[1][i] * 4194304.0f) : 0ll; \
                (void)__hip_atomic_fetch_add((LAS unsigned long long*)out + tk[i] * 16 + r, (unsigned long long)((hi_ << 32) + lo_), __ATOMIC_RELAXED, __HIP_MEMORY_SCOPE_WORKGROUP); } \
            M3_LOADA(AS, pseg, pbt, pnr, prbs); M3_ADV(pseg, pbt, pnr, prbs); \
            { const int old_ = cseg, nbat_ = (cnr + 15) >> 4; M3_ADV(cseg, cbt, cnr, crbs); \
              if (cseg != old_ && cseg < 10) { \
                  if (nbat_ == 1) M3_WAITB(4); else if (nbat_ == 2) M3_WAITB(8); else if (nbat_ == 3) M3_WAITB(12); else M3_WAITB(16); \
                  _Pragma("unroll") for (int nt = 0; nt < 2; ++nt) _Pragma("unroll") for (int kk = 0; kk < 4; ++kk) Bc[nt][kk] = Bn[nt][kk]; \
                  int nb_ = cseg; do { ++nb_; } while (nb_ < 8 && M3_NR(nb_) == 0); if (nb_ >= 10) nb_ = 9; M3_LOADB(Bn, nb_); } } }
        int cseg = -1, cbt = 0, cnr = 0, crbs = 0;
        do { ++cseg; } while (cseg < 8 && M3_NR(cseg) == 0);
        cnr = M3_NR(cseg); crbs = M3_RB(cseg);
        int pseg = cseg, pbt = 0, pnr = cnr, prbs = crbs;
        v4u Bc[2][4], Bn[2][4], A0[4], A1[4], A2[4], A3[4];
        M3_LOADB(Bc, cseg);
        M3_LOADA(A0, pseg, pbt, pnr, prbs); M3_ADV(pseg, pbt, pnr, prbs);
        M3_LOADA(A1, pseg, pbt, pnr, prbs); M3_ADV(pseg, pbt, pnr, prbs);
        M3_LOADA(A2, pseg, pbt, pnr, prbs); M3_ADV(pseg, pbt, pnr, prbs);
        M3_LOADA(A3, pseg, pbt, pnr, prbs); M3_ADV(pseg, pbt, pnr, prbs);
        { int nb_ = cseg; do { ++nb_; } while (nb_ < 8 && M3_NR(nb_) == 0); if (nb_ >= 10) nb_ = 9; M3_LOADB(Bn, nb_); }
        asm volatile("s_waitcnt vmcnt(0)" : "+v"(Bc[0][0]), "+v"(Bc[0][1]), "+v"(Bc[0][2]), "+v"(Bc[0][3]), "+v"(Bc[1][0]), "+v"(Bc[1][1]), "+v"(Bc[1][2]), "+v"(Bc[1][3]) :: "memory");
#pragma unroll 1
        while (cseg < 10) { M3_STEP(A0) M3_STEP(A1) M3_STEP(A2) M3_STEP(A3) }
        asm volatile("s_waitcnt vmcnt(0)" : "+v"(A0[0]), "+v"(A0[1]), "+v"(A0[2]), "+v"(A0[3]), "+v"(A1[0]), "+v"(A1[1]), "+v"(A1[2]), "+v"(A1[3]), "+v"(A2[0]), "+v"(A2[1]), "+v"(A2[2]), "+v"(A2[3]),
                     "+v"(A3[0]), "+v"(A3[1]), "+v"(A3[2]), "+v"(A3[3]), "+v"(Bn[0][0]), "+v"(Bn[0][1]), "+v"(Bn[0][2]), "+v"(Bn[0][3]), "+v"(Bn[1][0]), "+v"(Bn[1][1]), "+v"(Bn[1][2]), "+v"(Bn[1][3]) :: "memory");
#undef M3_NR
#undef M3_RB
#undef M3_GLD
#undef M3_LOADB
#undef M3_LOADA
#undef M3_ADV
#undef M3_WAITA
#undef M3_WAITB
#undef M3_STEP
        __syncthreads();
        { const int c4 = lane & 7, rs = lane >> 3, col = nc * 32 + 4 * c4;
          const f32x4 gv = *(const f32x4*)(g1 + col), bv = *(const f32x4*)(b1 + col);
#pragma unroll 4
          for (int it = 0; it < 16; ++it) { const int rl = 128 * w + 8 * it + rs; const size_t row = (size_t)tb * 1024 + rl;
              const f32x4 yv = *(const f32x4*)(Y1 + row * D + col); const f32x2 sv = *(const f32x2*)(ST1 + 2 * row);
              f32x4 tv; { const int nt = c4 >> 2, r0 = (4 * c4) & 15;
#pragma unroll
                  for (int j = 0; j < 4; ++j) { const v2u cell = *(const LAS v2u*)(out + rl * 32 + 2 * (r0 + j)); const int lo = (int)cell.x, hi = (int)cell.y + (lo < 0 ? 1 : 0); tv[j] = (float)(nt ? hi : lo) * (1.0f / 4194304.0f); } }
              const f32x4 y = ((yv - sv.x) * sv.y * gv + bv) * ALPHA + tv;
              *(f32x4*)(Y2 + row * D + col) = y;
              float sm = (y[0] + y[1]) + (y[2] + y[3]), sq = (y[0] * y[0] + y[1] * y[1]) + (y[2] * y[2] + y[3] * y[3]);
#pragma unroll
              for (int o = 1; o < 8; o <<= 1) { sm += shfl_x(sm, o, lane); sq += shfl_x(sq, o, lane); }
              if (c4 == 0) *(f32x2*)(PST2 + (row * 64 + nc) * 2) = (f32x2){sm, sq}; } }
    }
}

__device__ __forceinline__ void phase_moe4n(const Frame& F, const float* Y2, const float* pst, const float* gain, const float* bias, float* ST2, bf16* XBo, float* OUT, int last) {
    const int gw = F.bid * 8 + F.wave, NGW = F.G * 8, lane = F.lane;
    for (int t = gw; t < T; t += NGW) {
        f32x4 v[8];
#pragma unroll
        for (int j = 0; j < 8; ++j) v[j] = *(const f32x4*)(Y2 + (size_t)t * D + 4 * lane + 256 * j);
        const f32x2 pv = *(const f32x2*)(pst + ((size_t)t * 64 + lane) * 2);
        const float mean = wave_sum(pv.x, lane) * (1.0f / D); const float var = fmaxf(wave_sum(pv.y, lane) * (1.0f / D) - mean * mean, 0.f); const float rstd = 1.0f / sqrtf(var + LN_EPS);
        if (lane == 0) *(f32x2*)(ST2 + 2 * (size_t)t) = (f32x2){mean, rstd};
#pragma unroll
        for (int j = 0; j < 8; ++j) { const int c = 4 * lane + 256 * j; const f32x4 o = (v[j] - mean) * rstd * *(const f32x4*)(gain + c) + *(const f32x4*)(bias + c);
            if (last) *(f32x4*)(OUT + (size_t)t * D + c) = o;
            else { v2u wb; wb.x = pk2(o[0], o[1]); wb.y = pk2(o[2], o[3]); *(v2u*)(XBo + (size_t)t * D + c) = wb; } }
    }
}


__device__ __forceinline__ void phase_moe4q(const Frame& F, const bf16* X1, bf16* Y2, const unsigned char* Yq, const float* Ysc, const int* eidx, const int* inv, const float* gain, const float* bias, float* ST2, bf16* XBo, float* OUT, int last) {
    const LAS int* tpref = (const LAS int*)(F.lds + LDS_TAB);
    const int gw = F.bid * 8 + F.wave, NGW = F.G * 8, lane = F.lane;
    for (int t = gw; t < T; t += NGW) {
        int rowi = 0; if (lane < 8) { const int e = eidx[t * 8 + lane], ps = inv[t * 8 + lane]; rowi = tpref[e] * 256 + ps; } else if (lane < 10) rowi = tpref[56 + lane] * 256 + t;
        v4u pv[2][2], yv[10][2]; float sc[10][2];
#pragma unroll
        for (int j = 0; j < 2; ++j) { pv[j][0] = *(const v4u*)(X1 + (size_t)t * D + 16 * lane + 1024 * j); pv[j][1] = *(const v4u*)(X1 + (size_t)t * D + 16 * lane + 1024 * j + 8); }
#pragma unroll
        for (int k = 0; k < 10; ++k) { const size_t row = (size_t)__builtin_amdgcn_readlane(rowi, k);
#pragma unroll
            for (int j = 0; j < 2; ++j) { yv[k][j] = *(const v4u*)(Yq + row * D + 16 * lane + 1024 * j); sc[k][j] = Ysc[row * 16 + 8 * j + (lane >> 3)]; } }
#pragma unroll
        for (int k = 0; k < 10; ++k) asm volatile("" : "+v"(yv[k][0]), "+v"(yv[k][1]), "+v"(sc[k][0]), "+v"(sc[k][1]));
        float v[2][16];
#pragma unroll
        for (int j = 0; j < 2; ++j) { float f0[8], f1[8]; unpack8(pv[j][0], f0); unpack8(pv[j][1], f1);
            const float ss = (((sc[0][j] + sc[1][j]) + (sc[2][j] + sc[3][j])) + ((sc[4][j] + sc[5][j]) + (sc[6][j] + sc[7][j]))) + (sc[8][j] + sc[9][j]);
#pragma unroll
            for (int i = 0; i < 8; ++i) { v[j][i] = ALPHA * f0[i] - 128.f * ss; v[j][8 + i] = ALPHA * f1[i] - 128.f * ss; } }
#pragma unroll
        for (int k = 0; k < 10; ++k)
#pragma unroll
            for (int j = 0; j < 2; ++j) { const float s_ = sc[k][j]; const unsigned q[4] = {yv[k][j].x, yv[k][j].y, yv[k][j].z, yv[k][j].w};
#pragma unroll
                for (int d = 0; d < 4; ++d) { v[j][4 * d + 0] += s_ * (float)(q[d] & 0xffu); v[j][4 * d + 1] += s_ * (float)((q[d] >> 8) & 0xffu); v[j][4 * d + 2] += s_ * (float)((q[d] >> 16) & 0xffu); v[j][4 * d + 3] += s_ * (float)(q[d] >> 24); } }
        float sm = 0.f;
#pragma unroll
        for (int j = 0; j < 2; ++j)
#pragma unroll
            for (int i = 0; i < 16; i += 4) sm += (v[j][i] + v[j][i + 1]) + (v[j][i + 2] + v[j][i + 3]);
        const float mean = wave_sum(sm, lane) * (1.0f / D); float sq = 0.f;
#pragma unroll
        for (int j = 0; j < 2; ++j)
#pragma unroll
            for (int i = 0; i < 16; ++i) { const float d = v[j][i] - mean; sq += d * d; }
        const float rstd = 1.0f / sqrtf(wave_sum(sq, lane) * (1.0f / D) + LN_EPS);
        if (lane == 0) *(f32x2*)(ST2 + 2 * (size_t)t) = (f32x2){mean, rstd};
#pragma unroll
        for (int j = 0; j < 2; ++j)
#pragma unroll
            for (int h = 0; h < 2; ++h) { const int c = 16 * lane + 1024 * j + 8 * h; const float* vv = &v[j][8 * h];
                if (!last) { v4u yw; yw.x = pk2(vv[0], vv[1]); yw.y = pk2(vv[2], vv[3]); yw.z = pk2(vv[4], vv[5]); yw.w = pk2(vv[6], vv[7]); *(v4u*)(Y2 + (size_t)t * D + c) = yw; }
                const f32x4 g0 = *(const f32x4*)(gain + c), g1 = *(const f32x4*)(gain + c + 4), b0 = *(const f32x4*)(bias + c), b1 = *(const f32x4*)(bias + c + 4);
                const f32x4 o0 = ((f32x4){vv[0], vv[1], vv[2], vv[3]} - mean) * rstd * g0 + b0, o1 = ((f32x4){vv[4], vv[5], vv[6], vv[7]} - mean) * rstd * g1 + b1;
                if (last) { *(f32x4*)(OUT + (size_t)t * D + c) = o0; *(f32x4*)(OUT + (size_t)t * D + c + 4) = o1; }
                else { v4u wb; wb.x = pk2(o0[0], o0[1]); wb.y = pk2(o0[2], o0[3]); wb.z = pk2(o1[0], o1[1]); wb.w = pk2(o1[2], o1[3]); *(v4u*)(XBo + (size_t)t * D + c) = wb; } }
    }
}

__device__ __forceinline__ void phase_downproj3(const Frame& F, const bf16* H, const bf16* WD, const bf16* HSp, const bf16* WSD, unsigned char* Yq, float* Ysc, int NT) {
    const LAS int* tpref = (const LAS int*)(F.lds + LDS_TAB); const LAS int* cl = (const LAS int*)(F.lds + LDS_TAB + 512);
    LAS unsigned char* lds = F.lds;
    const int tid = F.tid, lane = F.lane, w = F.wave, fr = lane & 15, fq = lane >> 4;
    unsigned rbB[2], cbB[2];
#pragma unroll
    for (int i = 0; i < 2; ++i) { int R_, C_; g8::stage_rc(tid * 16 + i * 8192, R_, C_); rbB[i] = (unsigned)((R_ & ~31) + g8::perm32(R_ & 31)); cbB[i] = (unsigned)C_ * 2u; }
    const unsigned ldsw = (unsigned)w * 1024u, lbase = (unsigned)(size_t)lds;
    int boffg[4];
#pragma unroll
    for (int g = 0; g < 4; ++g) boffg[g] = g8::lds_byte(32 * g + fr, fq * 8);
    LAS unsigned char* stg = lds + 65536 + w * (32 * 144);
    const int NU = NT * 4;
    const int upos = (F.G % 8) == 0 ? (F.bid & 7) * (F.G >> 3) + (F.bid >> 3) : F.bid;
    int ub = 0;
    int u = (F.G <= NU) ? upos : F.bid; if (u >= NU) return;
#define DP3_UNITINFO(uu, E0, EXP, NV) do { const int tl_ = (uu) >> 2; int e_ = (E0); while (__builtin_amdgcn_readfirstlane(tpref[e_ + 1]) <= tl_) ++e_; EXP = e_; \
        NV = __builtin_amdgcn_readfirstlane(cl[e_]) - (tl_ - __builtin_amdgcn_readfirstlane(tpref[e_])) * 256; } while (0)
#define DP3_GLDS(gsrc, ldsdst) do { unsigned keep_; asm volatile("s_mov_b32 %0, m0\n\ts_mov_b32 m0, %2\n\ts_nop 0\n\tglobal_load_lds_dwordx4 %1, off\n\ts_mov_b32 m0, %0" : "=&s"(keep_) : "v"(gsrc), "s"(ldsdst) : "memory"); } while (0)
#define DP3_STAGE(slot, gb, bs) do { const unsigned v0_ = rbB[0] * (unsigned)(bs) + cbB[0], v1_ = rbB[1] * (unsigned)(bs) + cbB[1]; _Pragma("unroll") for (int kt = 0; kt < 2; ++kt) { \
        DP3_GLDS((const void*)((gb) + kt * 128 + v0_), lbase + (unsigned)((slot) * 32768 + kt * 16384) + ldsw); \
        DP3_GLDS((const void*)((gb) + kt * 128 + v1_), lbase + (unsigned)((slot) * 32768 + kt * 16384) + ldsw + 8192u); } } while (0)
#define DP3_SRC(uu, ee, AB, AS, BB, BS) do { const int tl_ = (uu) >> 2, cu_ = ((uu) & 3) * 512; \
        if ((ee) < 64) { AB = (const char*)(H + (size_t)tl_ * 256 * EDIM); AS = EDIM * 2; BB = (const char*)(WD + (size_t)(ee) * D * EDIM + (size_t)cu_ * EDIM); BS = EDIM * 2; } \
        else { const int t0_ = (tl_ - __builtin_amdgcn_readfirstlane(tpref[ee])) * 256; AB = (const char*)(HSp + (size_t)t0_ * SDIM + ((ee) - 64) * EDIM); AS = SDIM * 2; \
               BB = (const char*)(WSD + (size_t)cu_ * SDIM + ((ee) - 64) * EDIM); BS = SDIM * 2; } } while (0)
    int ecur, nvcur; DP3_UNITINFO(u, 0, ecur, nvcur);
    const char* abc; const char* gbc; int asc, bsc; DP3_SRC(u, ecur, abc, asc, gbc, bsc);
    bf16x8 A[2][4], An[2][4];
    { const char* ap_ = abc + (size_t)(32 * w + fr) * asc + 16 * fq;
#pragma unroll
      for (int m = 0; m < 2; ++m)
#pragma unroll
          for (int kk = 0; kk < 4; ++kk) A[m][kk] = *(const bf16x8*)(ap_ + (size_t)m * 16 * asc + 64 * kk); }
    DP3_STAGE(0, gbc, bsc);
    asm volatile("s_waitcnt vmcnt(0)" ::: "memory");
#pragma unroll 1
    for (;;) {
        int un = u; { const int nb = ub + F.G; if (nb + F.G <= NU) un = nb + upos; else if (nb + F.bid < NU) un = nb + F.bid; if (un != u) ub = nb; }
        int enx, nvnx; DP3_UNITINFO(un, (un > u ? ecur : 0), enx, nvnx);
        const char* abn; const char* gbn; int asn, bsn; DP3_SRC(un, enx, abn, asn, gbn, bsn);
        const int tile = u >> 2, colu = (u & 3) * 512;
        float scq[2][4];
#pragma unroll
        for (int c = 0; c < 4; ++c) {
            if (c == 0) asm volatile("s_waitcnt vmcnt(5)" ::: "memory"); else asm volatile("s_waitcnt vmcnt(4)" ::: "memory");
            __builtin_amdgcn_s_barrier();
            if (c == 3) { const char* ap_ = abn + (size_t)(32 * w + fr) * asn + 16 * fq;
#pragma unroll
                for (int m = 0; m < 2; ++m) { const char* am_ = ap_ + (size_t)m * 16 * asn;
                    asm volatile("global_load_dwordx4 %0, %1, off" : "=&v"(An[m][0]) : "v"(am_) : "memory"); asm volatile("global_load_dwordx4 %0, %1, off offset:64" : "=&v"(An[m][1]) : "v"(am_) : "memory");
                    asm volatile("global_load_dwordx4 %0, %1, off offset:128" : "=&v"(An[m][2]) : "v"(am_) : "memory"); asm volatile("global_load_dwordx4 %0, %1, off offset:192" : "=&v"(An[m][3]) : "v"(am_) : "memory"); } }
            { const char* gnext = (c < 3) ? gbc + (size_t)(c + 1) * 128 * bsc : gbn; const int bnext = (c < 3) ? bsc : bsn; DP3_STAGE((c + 1) & 1, gnext, bnext); }
            __builtin_amdgcn_sched_barrier(0);
            f32x4 acc[2][4][2];
#pragma unroll
            for (int g = 0; g < 4; ++g) { bf16x8 Bf[2][4];
#pragma unroll
                for (int n = 0; n < 2; ++n)
#pragma unroll
                    for (int kk = 0; kk < 4; ++kk) Bf[n][kk] = *(const LAS bf16x8*)(lds + (c & 1) * 32768 + (kk >> 1) * 16384 + boffg[g] + n * 2048 + (kk & 1) * 1024);
#pragma unroll
                for (int m = 0; m < 2; ++m)
#pragma unroll
                    for (int n = 0; n < 2; ++n) { acc[m][g][n] = (f32x4){0.f, 0.f, 0.f, 0.f};
#pragma unroll
                        for (int kk = 0; kk < 4; ++kk) acc[m][g][n] = __builtin_amdgcn_mfma_f32_16x16x32_bf16(Bf[n][kk], A[m][kk], acc[m][g][n], 0, 0, 0); } }
#pragma unroll
            for (int m = 0; m < 2; ++m) {
                float am0 = 0.f, am1 = 0.f;
#pragma unroll
                for (int g = 0; g < 4; ++g)
#pragma unroll
                    for (int n = 0; n < 2; ++n) { am0 = fmaxf(fmaxf(am0, fabsf(acc[m][g][n][0])), fabsf(acc[m][g][n][1])); am1 = fmaxf(fmaxf(am1, fabsf(acc[m][g][n][2])), fabsf(acc[m][g][n][3])); }
                float am = fmaxf(am0, am1);
                am = fmaxf(am, shfl_x(am, 16, lane)); am = fmaxf(am, shfl_x(am, 32, lane));
                am = fminf(am, 3.0e38f);
                const float isc = am > 0.f ? 127.0f * __builtin_amdgcn_rcpf(am) : 0.f;
                scq[m][c] = am * (1.0f / 127.0f);
                const f32x2_t isc2 = (f32x2_t){isc, isc}, mg2 = (f32x2_t){8388736.0f, 8388736.0f};
#pragma unroll
                for (int g = 0; g < 4; ++g) { unsigned qd[2];
#pragma unroll
                    for (int n = 0; n < 2; ++n) {
                        const f32x2_t tl = __builtin_elementwise_fma((f32x2_t){acc[m][g][n][0], acc[m][g][n][1]}, isc2, mg2), th = __builtin_elementwise_fma((f32x2_t){acc[m][g][n][2], acc[m][g][n][3]}, isc2, mg2);
                        const float f0_ = tl.x, f1_ = tl.y, f2_ = th.x, f3_ = th.y;
                        qd[n] = __builtin_amdgcn_perm(__builtin_bit_cast(unsigned, f1_), __builtin_bit_cast(unsigned, f0_), 0x0c0c0400u) | __builtin_amdgcn_perm(__builtin_bit_cast(unsigned, f3_), __builtin_bit_cast(unsigned, f2_), 0x04000c0cu); }
                    *(LAS v2u*)(stg + (16 * m + fr) * 144 + 32 * g + 8 * fq) = (v2u){qd[0], qd[1]}; } }
#pragma unroll
            for (int it = 0; it < 4; ++it) { const int rr = 8 * it + (lane >> 3);
                const v4u o = *(const LAS v4u*)(stg + rr * 144 + (lane & 7) * 16);
                *(v4u*)(Yq + (size_t)(tile * 256 + 32 * w + rr) * D + colu + 128 * c + 16 * (lane & 7)) = o; }
            if (c == 3) { const f32x4 so = fq == 0 ? (f32x4){scq[0][0], scq[0][1], scq[0][2], scq[0][3]} : (f32x4){scq[1][0], scq[1][1], scq[1][2], scq[1][3]};
                if (fq < 2) *(f32x4*)(Ysc + (size_t)(tile * 256 + 32 * w + 16 * fq + fr) * 16 + (colu >> 7)) = so; }
            __builtin_amdgcn_sched_barrier(0);
        }
        asm volatile("s_waitcnt vmcnt(9)" : "+v"(An[0][0]), "+v"(An[0][1]), "+v"(An[0][2]), "+v"(An[0][3]), "+v"(An[1][0]), "+v"(An[1][1]), "+v"(An[1][2]), "+v"(An[1][3]) :: "memory");
        if (un == u) break;
#pragma unroll
        for (int m = 0; m < 2; ++m)
#pragma unroll
            for (int kk = 0; kk < 4; ++kk) A[m][kk] = An[m][kk];
        u = un; ecur = enx; nvcur = nvnx; abc = abn; asc = asn; gbc = gbn; bsc = bsn;
    }
    asm volatile("s_waitcnt vmcnt(0)" ::: "memory");
#undef DP3_UNITINFO
#undef DP3_STAGE
#undef DP3_GLDS
#undef DP3_SRC
}

enum { PH_PRO = 0, PH_POOL_G1, PH_POOL_P, PH_POOL_G2, PH_POOL_G3, PH_DIL_G1, PH_DIL_ATT, PH_DIL_CMB, PH_DIL_G2, PH_CONV_G1, PH_CONV_E, PH_CONV_G2, PH_MOE1, PH_MOE2, PH_MOE3, PH_MOE4, PH_COUNT };

template <int PH>
__device__ __forceinline__ void run_phase(const Frame& Fin, const Args& args_, const int L) {
    Frame F = Fin; { int w_ = Fin.wave, l_; asm volatile("" : "+s"(w_)); asm volatile("v_mbcnt_lo_u32_b32 %0, -1, 0\n\tv_mbcnt_hi_u32_b32 %0, -1, %0" : "=v"(l_)); F.wave = w_; F.lane = l_; F.tid = w_ * 64 + l_; }
    unsigned char* ws; { GAS unsigned char* wsg = (GAS unsigned char*)Fin.ws; asm volatile("" : "+s"(wsg)); ws = (unsigned char*)wsg; } F.ws = ws; F.ctl = (unsigned*)(ws + WS_CTL);
    KP kp = (KP)__builtin_amdgcn_kernarg_segment_ptr(); asm volatile("" : "+s"(kp)); (void)args_;
    { unsigned l_ = (unsigned)(size_t)Fin.lds; asm volatile("" : "+s"(l_)); F.lds = (LAS unsigned char*)(size_t)l_; }
    LAS unsigned char* ring = F.lds; int c = (int)blockIdx.x; { int g_ = Fin.G; asm volatile("" : "+s"(c), "+s"(g_)); F.G = g_; F.bid = c; }
    const float* xres = ain(kp, IN_X); const bf16* xresb = (const bf16*)(ws + WS_Y2F);
    const float* st2 = (const float*)(ws + WS_ST2); float* pstp = (float*)(ws + WS_PST);
    const float* g2p = ain(kp, IN_LNG) + (size_t)((L > 0 ? L - 1 : 0) * 2 + 1) * D; const float* b2p = ain(kp, IN_LNB) + (size_t)((L > 0 ? L - 1 : 0) * 2 + 1) * D;
    const bf16* xb = (const bf16*)(ws + WS_XB);
    bf16* yf = (bf16*)(ws + WS_YF);
    unsigned char* big = ws + WS_BIG;
    const int ia = L / 3;
    if constexpr (PH == PH_PRO) { phase_prologue(F, kp); }
    if constexpr (PH == PH_POOL_G1) { g8::DenseSched S; S.init(xb, (const bf16*)(ws + WS_W_POOL_IN) + (size_t)ia * D * D, T, D, D, D, F.G, c);
        g8::EpiBf16 E{(bf16*)(big + BG_U), D, 0}; g8::gemm_phase<g8::EpiBf16, g8::DenseSched, false>(ring, F.tid, D, D, D, S, E); }
    if constexpr (PH == PH_POOL_P) { phase_pool(F, (const bf16*)(big + BG_U), (bf16*)(big + BG_PL)); }
    if constexpr (PH == PH_POOL_G2) { g8::DenseSched S; S.init((const bf16*)(big + BG_PL), (const bf16*)(ws + WS_W_POOL_G) + (size_t)ia * D * 512, T, D, D, 512, F.G, c); S.agrp_shift = 1; S.agrp_stride = 512 * 2;
        g8::EpiScaleBf16 E{(bf16*)(big + BG_MX), D, ain(kp, IN_PSC) + (size_t)ia * D}; g8::gemm_phase<g8::EpiScaleBf16, g8::DenseSched, false>(ring, F.tid, 512, D, 512, S, E); }
    if constexpr (PH == PH_POOL_G3) { g8::DenseSched S; S.init((const bf16*)(big + BG_MX), (const bf16*)(ws + WS_W_POOL_OUT) + (size_t)ia * D * D, T, D, D, D, F.G, c);
        g8::EpiResidLN E{xres, xresb, st2, g2p, b2p, yf, pstp, L > 0}; g8::gemm_phase<g8::EpiResidLN, g8::DenseSched, false>(ring, F.tid, D, D, D, S, E); }
    if constexpr (PH == PH_DIL_G1) { g8::DenseSched S; S.init(xb, (const bf16*)(ws + WS_W_DIL_QKV), T, QKVC, D, D, F.G, c);
        g8::EpiBf16 E{(bf16*)(big + BG_QKV), QKVC, 1}; g8::gemm_phase<g8::EpiBf16, g8::DenseSched, false>(ring, F.tid, D, D, D, S, E); }
    if constexpr (PH == PH_DIL_ATT) { phase_attn(F, (const bf16*)(big + BG_QKV), ain(kp, IN_RELB), (bf16*)(big + BG_OG), (float*)(big + BG_LSE)); }
    if constexpr (PH == PH_DIL_CMB) { phase_combine(F, (const bf16*)(big + BG_OG), (const float*)(big + BG_LSE), (bf16*)(big + BG_O)); }
    if constexpr (PH == PH_DIL_G2) { g8::DenseSched S; S.init((const bf16*)(big + BG_O), (const bf16*)(ws + WS_W_DIL_OUT), T, D, DILW, DILW, F.G, c);
        g8::EpiResidLN E{xres, xresb, st2, g2p, b2p, yf, pstp, L > 0}; g8::gemm_phase<g8::EpiResidLN, g8::DenseSched, false>(ring, F.tid, DILW, DILW, DILW, S, E); }
    if constexpr (PH == PH_CONV_G1) { g8::DenseSched S; S.init(xb, (const bf16*)(ws + WS_W_CONV_IN), T, 3 * D, D, D, F.G, c);
        g8::EpiConvIn E{(bf16*)(big + BG_UC), (bf16*)(big + BG_BG)}; g8::gemm_phase<g8::EpiConvIn, g8::DenseSched, false>(ring, F.tid, D, D, D, S, E); }
    if constexpr (PH == PH_CONV_E) { phase_conv(F, (const bf16*)(big + BG_UC), (const bf16*)(big + BG_BG), ain(kp, IN_CW), (bf16*)(big + BG_Z)); }
    if constexpr (PH == PH_CONV_G2) { g8::DenseSched S; S.init((const bf16*)(big + BG_Z), (const bf16*)(ws + WS_W_CONV_OUT), T, D, D, D, F.G, c);
        g8::EpiResidLN E{xres, xresb, st2, g2p, b2p, yf, pstp, L > 0}; g8::gemm_phase<g8::EpiResidLN, g8::DenseSched, false>(ring, F.tid, D, D, D, S, E); }
    unsigned* cnt = F.ctl + CW_CNT + L * 64 * 16;
    float* x1f = (float*)(ws + WS_X1F); bf16* x1b = (bf16*)(ws + WS_X1B);
    int* ltok = (int*)(ws + WS_LTOK); float* lgate = (float*)(ws + WS_LGATE); int* eidx = (int*)(ws + WS_EIDX); int* inv = (int*)(ws + WS_INV);
    bf16* HB = (bf16*)(ws + WS_HB); bf16* HS = (bf16*)(ws + WS_HS); bf16* Yr = (bf16*)(ws + WS_BIG);
    if constexpr (PH == PH_MOE1) {
        const float* g1 = ain(kp, IN_LNG) + (size_t)(L * 2 + 0) * D; const float* b1 = ain(kp, IN_LNB) + (size_t)(L * 2 + 0) * D;
        phase_moe1n(F, yf, pstp, g1, b1, (const bf16*)(ws + WS_RWH) + (size_t)L * NEXP * D, (const bf16*)(ws + WS_RWL) + (size_t)L * NEXP * D, ain(kp, IN_RB) + (size_t)L * NEXP,
                    x1b, (float*)(ws + WS_ST1), cnt, ltok, lgate, eidx, inv); }
    if constexpr (PH == PH_MOE2) {
        const int NT = build_tiles(F, cnt);
        { g8::ExpertSched<1, true> S; S.tpref = (const LAS int*)(F.lds + LDS_TAB); S.cnt = (const LAS int*)(F.lds + LDS_TAB + 512); S.A = (const char*)x1b; S.B = (const char*)((const bf16*)(ws + WS_W_EX_GU) + (size_t)L * 64 * 256 * D);
          S.tok = ltok; S.b_exp = (size_t)256 * D * 2; S.b_tile = 0; S.a_tile = 0; S.NU = NT; S.G = F.G; S.c = c;
          g8::EpiExpertGU E{HB}; g8::gemm_phase<g8::EpiExpertGU, g8::ExpertSched<1, true>, true>(ring, F.tid, D, D, D, S, E); }
        { const int rot = (c - (NT % F.G) + F.G) % F.G;
          g8::DenseSched S; S.init(x1b, (const bf16*)(ws + WS_W_SH_GU) + (size_t)L * 512 * D, T, 512, D, D, F.G, rot);
          int t2 = F.tid; asm volatile("" : "+v"(t2));
          g8::EpiSharedGU E{HS}; g8::gemm_phase<g8::EpiSharedGU, g8::DenseSched, false>(ring, t2, D, D, D, S, E); } }
    if constexpr (PH == PH_MOE3) {
        const float* g1 = ain(kp, IN_LNG) + (size_t)(L * 2 + 0) * D; const float* b1 = ain(kp, IN_LNB) + (size_t)(L * 2 + 0) * D;
        const int NT = build_tiles(F, cnt);
        __syncthreads();
        phase_downproj3(F, HB, (const bf16*)(ws + WS_W_EX_D) + (size_t)L * 64 * D * EDIM, HS, (const bf16*)(ws + WS_W_SH_D) + (size_t)L * D * SDIM, (unsigned char*)Yr, (float*)(ws + WS_BIG + BG_YSC), NT + 2 * (T / 256));
        (void)g1; (void)b1; }
    if constexpr (PH == PH_MOE4) { (void)build_tiles(F, cnt);
        const float* g2 = ain(kp, IN_LNG) + (size_t)(L * 2 + 1) * D; const float* b2 = ain(kp, IN_LNB) + (size_t)(L * 2 + 1) * D;
        phase_moe4q(F, x1b, (bf16*)(ws + WS_Y2F), (const unsigned char*)Yr, (const float*)(ws + WS_BIG + BG_YSC), eidx, inv, g2, b2, (float*)(ws + WS_ST2), (bf16*)(ws + WS_XB), aout(kp), L == DEPTH - 1); }
}
__device__ __forceinline__ void make_frame(Frame& F, const Args& args) {
    extern __shared__ __attribute__((aligned(16))) unsigned char lds_raw[];
    F.lds = (LAS unsigned char*)lds_raw; F.ws = args.ws; F.ctl = (unsigned*)(args.ws + WS_CTL);
    F.tid = threadIdx.x; F.lane = F.tid & 63; F.wave = __builtin_amdgcn_readfirstlane(F.tid >> 6); F.G = gridDim.x; F.bid = blockIdx.x;
}
template <int PH> __global__ void __launch_bounds__(512, 2) k_phase(Args args, int L) {
    Frame F; make_frame(F, args);
    run_phase<PH>(F, args, L);
}

#ifndef MK_NOINLINE
#define MK_NOINLINE 0
#endif
#if MK_NOINLINE
template <int PH> __device__ __noinline__ void call_phase_ni(const int L) {
    Args dummy{}; Frame F;
    KP kp = (KP)__builtin_amdgcn_kernarg_segment_ptr();
    extern __shared__ __attribute__((aligned(16))) unsigned char lds_raw[];
    F.lds = (LAS unsigned char*)lds_raw; F.ws = (unsigned char*)((GAS unsigned char* const CAS*)kp)[20]; F.ctl = (unsigned*)(F.ws + WS_CTL);
    F.tid = threadIdx.x; F.lane = F.tid & 63; F.wave = __builtin_amdgcn_readfirstlane(F.tid >> 6); F.G = gridDim.x; F.bid = blockIdx.x;
    run_phase<PH>(F, dummy, L);
}
template <int PH> __device__ __forceinline__ void call_phase(const Frame& F, const Args& args, const int L) { call_phase_ni<PH>(L); }
#else
template <int PH> __device__ __forceinline__ void call_phase(const Frame& F, const Args& args, const int L) { asm volatile("; PHASE_BEGIN %0" :: "n"(PH)); run_phase<PH>(F, args, L); asm volatile("; PHASE_END %0" :: "n"(PH)); }
#endif
__global__ void __launch_bounds__(512, 2) fwd_all(Args args) {
    Frame F; make_frame(F, args);
    volatile LAS unsigned* misc = (volatile LAS unsigned*)(F.lds + LDS_MISC);
    if (F.tid < 4) misc[F.tid] = 0u;
    __syncthreads();
    const int lo = args.ph_lo, hi = args.ph_hi;
    XcdBarrier bar; bar.bar = F.ctl + CW_BAR; bar.x = 0; bar.st = misc;
    if (hi - lo > 1) bar = xcd_barrier_post(F.ctl + CW_BAR, misc);
    int pc = 0;
#ifndef MK_DUP_MASK
#define MK_DUP_MASK 0
#endif
#if MK_DUP_MASK
#define STEP(PH, Lx) do { if (pc >= lo && pc < hi) { int nrep_ = ((MK_DUP_MASK >> (PH)) & 1) ? 2 : 1; asm volatile("" : "+s"(nrep_)); _Pragma("unroll 1") for (int r_ = 0; r_ < nrep_; ++r_) { call_phase<PH>(F, args, Lx); if (r_ + 1 < nrep_ || pc + 1 < hi) xcd_barrier(bar); } } ++pc; } while (0)
#else
#define STEP(PH, Lx) do { if (pc >= lo && pc < hi) { call_phase<PH>(F, args, Lx); if (pc + 1 < hi) xcd_barrier(bar); } ++pc; } while (0)
#endif
    STEP(PH_PRO, 0);
#pragma unroll 1
    for (int L = 0; L < DEPTH; ++L) {
        const int kind = L % 3;
        if (kind == 0) { STEP(PH_POOL_G1, L); STEP(PH_POOL_P, L); STEP(PH_POOL_G2, L); STEP(PH_POOL_G3, L); }
        else if (kind == 1) { STEP(PH_DIL_G1, L); STEP(PH_DIL_ATT, L); STEP(PH_DIL_CMB, L); STEP(PH_DIL_G2, L); }
        else { STEP(PH_CONV_G1, L); STEP(PH_CONV_E, L); STEP(PH_CONV_G2, L); }
        STEP(PH_MOE1, L); STEP(PH_MOE2, L); STEP(PH_MOE3, L); STEP(PH_MOE4, L);
    }
#undef STEP
}
constexpr int N_STEPS = 1 + 2 * 8 + 8 + 7;

template <int PH> static void launch_phase(const Args& a, int L, int grid, hipStream_t stream) {
    static bool attr = false;
    if (!attr) { (void)hipFuncSetAttribute((const void*)k_phase<PH>, hipFuncAttributeMaxDynamicSharedMemorySize, LDS_BYTES); attr = true; }
    hipLaunchKernelGGL(k_phase<PH>, dim3(grid), dim3(512), LDS_BYTES, stream, a, L);
}
extern "C" void kernel_launch(void* const* d_in, const int* in_sizes, int n_in, void* d_out, int out_size, void* d_ws, size_t ws_size, hipStream_t stream) {
    static int grid = 0;
    if (grid == 0) {
        if (n_in != 19 || out_size != T * D || ws_size < WS_END) { fprintf(stderr, "kernel_launch: unexpected shapes (n_in %d out %d ws %zu need %zu)\n", n_in, out_size, ws_size, (size_t)WS_END); grid = -1; return; }
        int dev = 0, cus = 0;
        if (hipGetDevice(&dev) != hipSuccess || hipDeviceGetAttribute(&cus, hipDeviceAttributeMultiprocessorCount, dev) != hipSuccess) { grid = -1; return; }
#if MK_ONE_LAUNCH
        if (hipFuncSetAttribute((const void*)fwd_all, hipFuncAttributeMaxDynamicSharedMemorySize, LDS_BYTES) != hipSuccess) { fprintf(stderr, "kernel_launch: hipFuncSetAttribute failed\n"); grid = -1; return; }
        int per_cu = 0;
        if (hipOccupancyMaxActiveBlocksPerMultiprocessor(&per_cu, (const void*)fwd_all, 512, LDS_BYTES) != hipSuccess || per_cu < 1) { fprintf(stderr, "kernel_launch: note: occupancy query reports %d blocks per CU\n", per_cu); (void)hipGetLastError(); }
#endif
        grid = cus;
    }
    if (grid < 0) return;
    (void)hipMemsetAsync((char*)d_ws + WS_CTL, 0, CTL_ZERO_BYTES, stream);
    Args a{};
    for (int i = 0; i < 19; ++i) a.in[i] = (const float*)d_in[i];
    a.out = (float*)d_out; a.ws = (unsigned char*)d_ws; a.ph_lo = 0; a.ph_hi = 0;
#if MK_ONE_LAUNCH
#ifdef MK_SPLIT
    for (int p = 0; p < N_STEPS; ++p) { a.ph_lo = p; a.ph_hi = p + 1; hipLaunchKernelGGL(fwd_all, dim3(grid), dim3(512), LDS_BYTES, stream, a); }
#else
    a.ph_lo = 0; a.ph_hi = N_STEPS;
    hipLaunchKernelGGL(fwd_all, dim3(grid), dim3(512), LDS_BYTES, stream, a);
#endif
#elif defined(MK_HYBRID_MASK)
    {
        static bool attr2 = false; if (!attr2) { (void)hipFuncSetAttribute((const void*)fwd_all, hipFuncAttributeMaxDynamicSharedMemorySize, LDS_BYTES); attr2 = true; }
        int pc = 0;
#define HSTEP(PH, Lx) do { if ((MK_HYBRID_MASK >> (PH)) & 1) { a.ph_lo = pc; a.ph_hi = pc + 1; hipLaunchKernelGGL(fwd_all, dim3(grid), dim3(512), LDS_BYTES, stream, a); } else { a.ph_lo = 0; a.ph_hi = 0; launch_phase<PH>(a, Lx, grid, stream); } ++pc; } while (0)
        HSTEP(PH_PRO, 0);
        for (int L = 0; L < DEPTH; ++L) {
            const int kind = L % 3;
            if (kind == 0) { HSTEP(PH_POOL_G1, L); HSTEP(PH_POOL_P, L); HSTEP(PH_POOL_G2, L); HSTEP(PH_POOL_G3, L); }
            else if (kind == 1) { HSTEP(PH_DIL_G1, L); HSTEP(PH_DIL_ATT, L); HSTEP(PH_DIL_CMB, L); HSTEP(PH_DIL_G2, L); }
            else { HSTEP(PH_CONV_G1, L); HSTEP(PH_CONV_E, L); HSTEP(PH_CONV_G2, L); }
            HSTEP(PH_MOE1, L); HSTEP(PH_MOE2, L); HSTEP(PH_MOE3, L); HSTEP(PH_MOE4, L);
        }
#undef HSTEP
    }
#else
    launch_phase<PH_PRO>(a, 0, grid, stream);
    for (int L = 0; L < DEPTH; ++L) {
        const int kind = L % 3;
        if (kind == 0) { launch_phase<PH_POOL_G1>(a, L, grid, stream); launch_phase<PH_POOL_P>(a, L, grid, stream); launch_phase<PH_POOL_G2>(a, L, grid, stream); launch_phase<PH_POOL_G3>(a, L, grid, stream); }
        else if (kind == 1) { launch_phase<PH_DIL_G1>(a, L, grid, stream); launch_phase<PH_DIL_ATT>(a, L, grid, stream); launch_phase<PH_DIL_CMB>(a, L, grid, stream); launch_phase<PH_DIL_G2>(a, L, grid, stream); }
        else { launch_phase<PH_CONV_G1>(a, L, grid, stream); launch_phase<PH_CONV_E>(a, L, grid, stream); launch_phase<PH_CONV_G2>(a, L, grid, stream); }
        launch_phase<PH_MOE1>(a, L, grid, stream); launch_phase<PH_MOE2>(a, L, grid, stream); launch_phase<PH_MOE3>(a, L, grid, stream); launch_phase<PH_MOE4>(a, L, grid, stream);
    }
#endif
}
```

```cpp
#include <hip/hip_runtime.h>
#include <cstdio>
#include <cstdint>

#ifndef MK_ONE_LAUNCH
#define MK_ONE_LAUNCH 1
#endif

#define GAS __attribute__((address_space(1)))
#define LAS __attribute__((address_space(3)))
typedef unsigned short bf16;
typedef unsigned v4u __attribute__((ext_vector_type(4)));
typedef unsigned v2u __attribute__((ext_vector_type(2)));
typedef float f32x4 __attribute__((ext_vector_type(4)));
typedef float f32x2 __attribute__((ext_vector_type(2)));
typedef short bf16x8 __attribute__((ext_vector_type(8)));
typedef short s16x4 __attribute__((ext_vector_type(4)));

constexpr int NBATCH = 8, SEQ = 2048, D = 2048, T = NBATCH * SEQ, DEPTH = 4;
constexpr int NEXP = 64, TOPK = 8, EDIM = 128, SDIM = 256;
constexpr int QKVC = 4608, DILW = 512;
constexpr float ALPHA = 1.681792830507429f;
constexpr float LN_EPS = 1e-5f;
constexpr int CAP = 16384;
constexpr int HROWS = T * TOPK + NEXP * 256;

constexpr size_t MiB = 1u << 20;
constexpr size_t WS_CTL = 0, CTL_ZERO_BYTES = 1 * MiB;
constexpr size_t WS_W_POOL_IN = 1 * MiB;
constexpr size_t WS_W_POOL_G = WS_W_POOL_IN + 16 * MiB;
constexpr size_t WS_W_POOL_OUT = WS_W_POOL_G + 4 * MiB;
constexpr size_t WS_W_DIL_QKV = WS_W_POOL_OUT + 16 * MiB;
constexpr size_t WS_W_DIL_OUT = WS_W_DIL_QKV + 18 * MiB;
constexpr size_t WS_W_CONV_IN = WS_W_DIL_OUT + 2 * MiB;
constexpr size_t WS_W_CONV_OUT = WS_W_CONV_IN + 24 * MiB;
constexpr size_t WS_W_SH_GU = WS_W_CONV_OUT + 8 * MiB;
constexpr size_t WS_W_SH_D = WS_W_SH_GU + 8 * MiB;
constexpr size_t WS_W_EX_GU = WS_W_SH_D + 4 * MiB;
constexpr size_t WS_W_EX_D = WS_W_EX_GU + 256 * MiB;
constexpr size_t WS_XF = WS_W_EX_D + 256 * MiB;
constexpr size_t WS_YF = WS_XF + 128 * MiB;
constexpr size_t WS_X1F = WS_YF + 128 * MiB;
constexpr size_t WS_XB = WS_X1F + 128 * MiB;
constexpr size_t WS_X1B = WS_XB + 64 * MiB;
constexpr size_t WS_HB = WS_X1B + 64 * MiB;
constexpr size_t WS_HS = WS_HB + 72 * MiB;
constexpr size_t WS_LTOK = WS_HS + 8 * MiB;
constexpr size_t WS_LGATE = WS_LTOK + 4 * MiB;
constexpr size_t WS_EIDX = WS_LGATE + 4 * MiB;
constexpr size_t WS_INV = WS_EIDX + 1 * MiB;
constexpr size_t WS_BIG = WS_INV + 1 * MiB;
constexpr size_t WS_PST = WS_BIG + 608 * MiB;
constexpr size_t WS_ST1 = WS_PST + 4 * MiB;
constexpr size_t WS_ST2 = WS_ST1 + 1 * MiB;
constexpr size_t WS_RWH = WS_ST2 + 1 * MiB;
constexpr size_t WS_RWL = WS_RWH + 1 * MiB;
constexpr size_t WS_PST2 = WS_RWL + 1 * MiB;
constexpr size_t WS_END = WS_PST2 + 8 * MiB;
constexpr size_t WS_Y2F = WS_X1F;
constexpr size_t BG_U = 0, BG_PL = 64 * MiB, BG_MX = 128 * MiB;
constexpr size_t BG_QKV = 0, BG_OG = 144 * MiB, BG_LSE = 192 * MiB, BG_O = 194 * MiB;
constexpr size_t BG_UC = 0, BG_BG = 64 * MiB, BG_Z = 128 * MiB;
constexpr size_t BG_YSC = 400 * MiB;
constexpr int CW_BAR = 4096;
constexpr int CW_CNT = 16384;

constexpr int RING_BYTES = 131072;
constexpr int LDS_TAB = RING_BYTES;
constexpr int LDS_STASH = RING_BYTES + 1024;
constexpr int LDS_BYTES = 163840;
constexpr int LDS_MISC = LDS_BYTES - 1024;

typedef __bf16 bf16x2_t __attribute__((ext_vector_type(2)));
typedef float f32x2_t __attribute__((ext_vector_type(2)));
__device__ __forceinline__ unsigned cvt_pk_bf16(float lo, float hi) { const bf16x2_t r = __builtin_convertvector((f32x2_t){lo, hi}, bf16x2_t); return __builtin_bit_cast(unsigned, r); }
__device__ __forceinline__ unsigned f2bf(float f) { unsigned u = __builtin_bit_cast(unsigned, f); return (u + 0x7fffu + ((u >> 16) & 1u)) >> 16; }
__device__ __forceinline__ unsigned pk2(float lo, float hi) { return f2bf(lo) | (f2bf(hi) << 16); }
__device__ __forceinline__ float bflo(unsigned w) { return __builtin_bit_cast(float, w << 16); }
__device__ __forceinline__ float bfhi(unsigned w) { return __builtin_bit_cast(float, w & 0xffff0000u); }
__device__ __forceinline__ float shfl_from(float v, int src) { return __builtin_bit_cast(float, __builtin_amdgcn_ds_bpermute(src << 2, __builtin_bit_cast(int, v))); }
__device__ __forceinline__ float shfl_x(float v, int o, int lane) { return shfl_from(v, lane ^ o); }
__device__ __forceinline__ float wave_sum(float v, int lane) {
#pragma unroll
    for (int o = 1; o < 64; o <<= 1) v += shfl_x(v, o, lane);
    return v;
}
#define LDS_WAIT() asm volatile("s_waitcnt lgkmcnt(0)" ::: "memory")
#define VM_WAIT() asm volatile("s_waitcnt vmcnt(0)" ::: "memory")

#define XB_TMO      128
#define XB_XCNT(j)  (256  + 64 * (j))
#define XB_XSUB(j)  (1280 + 64 * (j))
#define XB_XGEN(j)  (2304 + 64 * (j))
#define XB_TOP      3328
#define XB_TOPGEN   3392
#define XCD_BAR_WORDS 3456
#define XB_SPIN_CAP (1u << 18)

__device__ __forceinline__ unsigned xb_ld(unsigned* p)              { return __hip_atomic_load(p, __ATOMIC_RELAXED, __HIP_MEMORY_SCOPE_AGENT); }
__device__ __forceinline__ unsigned xb_add(unsigned* p, unsigned v) { return __hip_atomic_fetch_add(p, v, __ATOMIC_RELAXED, __HIP_MEMORY_SCOPE_AGENT); }
__device__ __forceinline__ unsigned xb_xcc_id() { return (unsigned)__builtin_amdgcn_s_getreg((3 << 11) | 20) & 0xFu; }
#define XB_SPIN(cond, bar) do { unsigned _sp = 0; while (cond) { __builtin_amdgcn_s_sleep(1); \
    if ((++_sp & 255u) == 0u) { if (xb_ld(&(bar)[XB_TMO])) break; if (_sp > XB_SPIN_CAP) { atomicAdd(&(bar)[XB_TMO], 1u); break; } } } } while (0)

struct XcdBarrier {
    unsigned* bar; unsigned x;
    volatile LAS unsigned* st;
};

__device__ __forceinline__ XcdBarrier xcd_barrier_post(unsigned* bar, volatile LAS unsigned* st) {
    XcdBarrier b; b.bar = bar; b.x = xb_xcc_id(); b.st = st;
    if (threadIdx.x == 0) (void)xb_add(&bar[XB_XCNT(b.x)], 1u);
    return b;
}
__device__ __forceinline__ void xcd_barrier_complete(unsigned* bar, unsigned x, unsigned& nloc, unsigned& nx) {
    const unsigned G = gridDim.x * gridDim.y * gridDim.z;
    unsigned sum, cnt, mine, sp = 0u;
    for (;;) {
        sum = 0u; cnt = 0u; mine = 0u;
#pragma unroll
        for (unsigned j = 0; j < 16; ++j) { const unsigned c = xb_ld(&bar[XB_XCNT(j)]); sum += c; cnt += (c > 0u) ? 1u : 0u; mine = (j == x) ? c : mine; }
        if (sum == G) break;
        __builtin_amdgcn_s_sleep(1);
        if ((++sp & 255u) == 0u) { if (xb_ld(&bar[XB_TMO])) break; if (sp > XB_SPIN_CAP) { atomicAdd(&bar[XB_TMO], 1u); break; } }
    }
    nloc = mine > 0u ? mine : 1u; nx = cnt > 0u ? cnt : 1u;
}

__device__ __forceinline__ void xcd_barrier(const XcdBarrier& b) {
    asm volatile("s_waitcnt vmcnt(0)" ::: "memory");
    __syncthreads();
    if (threadIdx.x == 0) {
        unsigned* bar; unsigned bx = b.x; { GAS unsigned* bg = (GAS unsigned*)b.bar; asm volatile("" : "+s"(bg), "+s"(bx)); bar = (unsigned*)bg; }
        __builtin_amdgcn_s_waitcnt(0);
        unsigned nloc = b.st[0], nx = b.st[1];
        if (nloc == 0u) { xcd_barrier_complete(bar, bx, nloc, nx); b.st[0] = nloc; b.st[1] = nx; }
        const unsigned old = xb_add(&bar[XB_XSUB(bx)], 1u);
        const unsigned gen = old / nloc;
        if (old + 1u == (gen + 1u) * nloc) {
            __builtin_amdgcn_fence(__ATOMIC_RELEASE, "agent");
            asm volatile("s_waitcnt vmcnt(0)" ::: "memory");
            const unsigned og = xb_add(&bar[XB_TOP], 1u);
            const unsigned tg = og / nx;
            if (og + 1u == (tg + 1u) * nx) xb_add(&bar[XB_TOPGEN], 1u);
            else XB_SPIN(xb_ld(&bar[XB_TOPGEN]) == tg, bar);
            __builtin_amdgcn_fence(__ATOMIC_ACQUIRE, "agent");
            xb_add(&bar[XB_XGEN(bx)], 1u);
            asm volatile("s_waitcnt vmcnt(0)" ::: "memory");
        } else {
            XB_SPIN(xb_ld(&bar[XB_XGEN(bx)]) == gen, bar);
            __builtin_amdgcn_fence(__ATOMIC_ACQUIRE, "agent");
            asm volatile("s_waitcnt vmcnt(0)" ::: "memory");
        }
    }
    __syncthreads();
}

namespace g8 {
constexpr int BM = 256, BK = 64, HALF = 128, HTB = HALF * BK * 2, STAGE_BYTES = 8 * HTB, NXCD = 8, WGM = 8;
__host__ __device__ __forceinline__ int lds_byte(int r, int c) { const int st = (r >> 4) * 2 + (c >> 5), rr = r & 15, cc = c & 31, ob = rr * 64 + cc * 2; return st * 1024 + (ob ^ (((ob >> 9) & 1) << 5)); }
__host__ __device__ __forceinline__ void stage_rc(int b, int& R, int& C) { const int st = b / 1024, sb = b % 1024, swz = sb ^ (((sb >> 9) & 1) << 5); R = (st >> 1) * 16 + swz / 64; C = (st & 1) * 32 + (swz % 64) / 2; }
__host__ __device__ __forceinline__ int perm32(int rho) { const int n = rho >> 4, i = rho & 15; return 8 * (i >> 2) + 4 * n + (i & 3); }

struct Unit { const char* A; const char* B; const int* rows; int pm, pn, nvalid, aux; };

template <class Epi, class Sched, bool GATHER>
__device__ __forceinline__ void gemm_phase(LAS unsigned char* lds, const int tid_in, const int K, const int lda, const int ldb, const Sched& S, const Epi& E) {
    const int tid = tid_in, wid = __builtin_amdgcn_readfirstlane(tid >> 6), lane = tid & 63, wr = wid >> 2, wc = wid & 3, fr = lane & 15, fq = lane >> 4;
    const int nt = K / BK;
    unsigned voffB[2];
#pragma unroll
    for (int i = 0; i < 2; ++i) { int R_, C_; stage_rc(tid * 16 + i * 8192, R_, C_); const int Rb = Epi::PERM ? ((R_ & ~31) + perm32(R_ & 31)) : R_; voffB[i] = (unsigned)(Rb * ldb + C_) * 2u; }
    LAS v4u* stash = (LAS v4u*)(lds + (LDS_STASH - 0) + tid * 16);
    const size_t kstep = (size_t)(BK * 2);
    const size_t hstepB = (size_t)HALF * ldb * 2;
    const unsigned ldsw = (unsigned)wid * 1024u;
    const int aoff = lds_byte(wr * 64 + fr, fq * 8), boff = lds_byte(wc * 32 + fr, fq * 8);
#define G8_SA(b, h) (((b) * 2 + (h)) * HTB)
#define G8_SB(b, h) ((4 + (b) * 2 + (h)) * HTB)
#define G8_STAGE2(bufoff, gbase, v0, v1) do { \
        __builtin_amdgcn_global_load_lds((const unsigned*)((const char*)(gbase) + (v0)), (LAS unsigned*)(lds + (bufoff) + ldsw), 16, 0, 0); \
        __builtin_amdgcn_global_load_lds((const unsigned*)((const char*)(gbase) + (v1)), (LAS unsigned*)(lds + (bufoff) + ldsw + 8192), 16, 0, 0); } while (0)
#define G8_STAGEB(bufoff, gbase) G8_STAGE2(bufoff, gbase, voffB[0], voffB[1])
#define G8_LDA(dst, b, h) do { _Pragma("unroll") for (int m = 0; m < 4; ++m) _Pragma("unroll") for (int k = 0; k < 2; ++k) dst[m][k] = *(const LAS bf16x8*)(lds + G8_SA(b, h) + aoff + m * 2048 + k * 1024); } while (0)
#define G8_LDB(dst, b, h) do { _Pragma("unroll") for (int n = 0; n < 2; ++n) _Pragma("unroll") for (int k = 0; k < 2; ++k) dst[n][k] = *(const LAS bf16x8*)(lds + G8_SB(b, h) + boff + n * 2048 + k * 1024); } while (0)
#define G8_MMA(ai, bj, At, Bt) do { __builtin_amdgcn_s_setprio(1); _Pragma("unroll") for (int m = 0; m < 4; ++m) _Pragma("unroll") for (int n = 0; n < 2; ++n) _Pragma("unroll") for (int k = 0; k < 2; ++k) \
        acc[ai][bj][m][n] = __builtin_amdgcn_mfma_f32_16x16x32_bf16(Bt[n][k], At[m][k], acc[ai][bj][m][n], 0, 0, 0); __builtin_amdgcn_s_setprio(0); } while (0)
#define G8_WAIT_V(n) asm volatile("s_waitcnt vmcnt(" #n ")" ::: "memory")
#define G8_WAIT_L(n) asm volatile("s_waitcnt lgkmcnt(" #n ")" ::: "memory")
#define G8_BAR __builtin_amdgcn_s_barrier()
#define G8_SCHED __builtin_amdgcn_sched_barrier(0)
#define G8_SETVA(dst, u) do { int _t2 = tid; if (GATHER) asm volatile("" : "+v"(_t2)); _Pragma("unroll") for (int _h = 0; _h < 2; ++_h) _Pragma("unroll") for (int _i = 0; _i < 2; ++_i) { \
        int _R, _C; stage_rc(_t2 * 16 + _i * 8192, _R, _C); \
        const unsigned _rl = (unsigned)(_h * HALF + _R); unsigned _row = _rl; \
        if (GATHER) { _row = 0u; if (_rl < (unsigned)(u).nvalid) _row = (unsigned)(u).rows[_rl] >> 3; } \
        dst[_h][_i] = (_row * (unsigned)lda + (unsigned)_C) * 2u; } } while (0)
    Unit cur, nxt; int ui = 0;
    if (!S.next(0, cur)) return;
    f32x4 acc[2][2][4][2];
#pragma unroll
    for (int a = 0; a < 2; ++a)
#pragma unroll
        for (int b = 0; b < 2; ++b)
#pragma unroll
            for (int m = 0; m < 4; ++m)
#pragma unroll
                for (int n = 0; n < 2; ++n) acc[a][b][m][n] = (f32x4){0.f, 0.f, 0.f, 0.f};
    bf16x8 At[4][2], B0[2][2], B1[2][2];
    unsigned vAc[2][2]; unsigned xl00 = 0, xl01 = 0, xl10 = 0, xl11 = 0;
    G8_SETVA(vAc, cur);
    const char* cA = cur.A; const char* cB = cur.B;
    G8_STAGEB(G8_SB(0, 0), cB); G8_STAGEB(G8_SB(0, 1), cB + hstepB); G8_STAGE2(G8_SA(0, 0), cA, vAc[0][0], vAc[0][1]); G8_STAGE2(G8_SA(0, 1), cA, vAc[1][0], vAc[1][1]);
    if (wr == 1) G8_BAR;
    G8_WAIT_V(2); G8_BAR;
    G8_STAGEB(G8_SB(1, 0), cB + kstep); G8_STAGE2(G8_SA(1, 0), cA + kstep, vAc[0][0], vAc[0][1]); G8_STAGEB(G8_SB(1, 1), cB + hstepB + kstep);
    G8_WAIT_V(6); G8_BAR;
    for (;;) {
        const bool has_next = S.next(ui + 1, nxt);
        const char* nA = has_next ? nxt.A : cA; const char* nB = has_next ? nxt.B : cB;
        if (GATHER) { unsigned vAn[2][2]; if (has_next) { G8_SETVA(vAn, nxt); } else {
#pragma unroll
            for (int h = 0; h < 2; ++h)
#pragma unroll
                for (int i = 0; i < 2; ++i) vAn[h][i] = vAc[h][i]; }
            *stash = (v4u){vAn[0][0], vAn[0][1], vAn[1][0], vAn[1][1]}; }
#pragma unroll 1
        for (int t = 0; t < nt; t += 2) {
            const bool last = (t == nt - 2);
            const char* a1 = cA + (size_t)(t + 1) * kstep;
            const char* a2 = last ? nA : cA + (size_t)(t + 2) * kstep; const char* b2 = last ? nB : cB + (size_t)(t + 2) * kstep;
            const char* a3 = a2 + kstep; const char* b3 = b2 + kstep;
            unsigned x00 = vAc[0][0], x01 = vAc[0][1], x10 = vAc[1][0], x11 = vAc[1][1];
            if (GATHER) { if (last) { const v4u sv = *stash; x00 = sv.x; x01 = sv.y; x10 = sv.z; x11 = sv.w; } xl00 = x00; xl01 = x01; xl10 = x10; xl11 = x11; }
            G8_LDB(B0, 0, 0); G8_LDB(B1, 0, 1); G8_SCHED; G8_LDA(At, 0, 0); G8_STAGE2(G8_SA(1, 1), a1, vAc[1][0], vAc[1][1]);
            G8_WAIT_V(8); G8_WAIT_L(0); G8_BAR; G8_MMA(0, 0, At, B0); G8_MMA(0, 1, At, B1); G8_BAR; G8_SCHED;
            G8_LDA(At, 0, 1); G8_STAGEB(G8_SB(0, 0), b2); G8_STAGEB(G8_SB(0, 1), b2 + hstepB); G8_STAGE2(G8_SA(0, 0), a2, x00, x01);
            G8_WAIT_V(8); G8_WAIT_L(0); G8_BAR; G8_MMA(1, 0, At, B0); G8_MMA(1, 1, At, B1); G8_BAR; G8_SCHED;
            G8_LDB(B0, 1, 0); G8_LDB(B1, 1, 1); G8_SCHED; G8_LDA(At, 1, 0); G8_STAGE2(G8_SA(0, 1), a2, x10, x11);
            G8_WAIT_V(8); G8_WAIT_L(0); G8_BAR; G8_MMA(0, 0, At, B0); G8_MMA(0, 1, At, B1); G8_BAR; G8_SCHED;
            G8_LDA(At, 1, 1); G8_STAGEB(G8_SB(1, 0), b3); G8_STAGEB(G8_SB(1, 1), b3 + hstepB); G8_STAGE2(G8_SA(1, 0), a3, x00, x01);
            G8_WAIT_V(8); G8_WAIT_L(0); G8_BAR; G8_MMA(1, 0, At, B0); G8_MMA(1, 1, At, B1); G8_BAR; G8_SCHED;
        }
        if (wr == 0) G8_BAR;
        E(acc, cur, wr, wc, fr, fq);
        if (!has_next) break;
#pragma unroll
        for (int a = 0; a < 2; ++a)
#pragma unroll
            for (int b = 0; b < 2; ++b)
#pragma unroll
                for (int m = 0; m < 4; ++m)
#pragma unroll
                    for (int n = 0; n < 2; ++n) acc[a][b][m][n] = (f32x4){0.f, 0.f, 0.f, 0.f};
        cur = nxt; cA = nA; cB = nB; ++ui;
        if (GATHER) { vAc[0][0] = xl00; vAc[0][1] = xl01; vAc[1][0] = xl10; vAc[1][1] = xl11; }
        if (wr == 1) G8_BAR;
    }
    G8_WAIT_V(0);
    G8_BAR;
#undef G8_SA
#undef G8_SB
#undef G8_STAGE2
#undef G8_STAGEB
#undef G8_LDA
#undef G8_LDB
#undef G8_MMA
#undef G8_WAIT_V
#undef G8_WAIT_L
#undef G8_BAR
#undef G8_SCHED
#undef G8_SETVA
}

struct DenseSched {
    const char* A; const char* B; size_t a_tile, b_tile, agrp_stride; int agrp_shift, nM, nN, nwg, G, c;
    __device__ __forceinline__ void init(const void* A_, const void* B_, int M, int N, int lda, int ldb, int G_, int c_) {
        A = (const char*)A_; B = (const char*)B_; a_tile = (size_t)BM * lda * 2; b_tile = (size_t)BM * ldb * 2; agrp_stride = 0; agrp_shift = 0; nM = M / BM; nN = N / BM; nwg = nM * nN; G = G_; c = c_; }
    __device__ __forceinline__ bool next(int i, Unit& u) const {
        const long L = (long)i * G + c; if (L >= nwg) return false;
        int wgid = (int)L; { const int q = nwg / NXCD, r = nwg % NXCD, xcd = wgid % NXCD, off = wgid / NXCD; wgid = (xcd < r ? xcd * (q + 1) : r * (q + 1) + (xcd - r) * q) + off; }
        const int nig = WGM * nN, gid = wgid / nig, fm = gid * WGM, gsz = (nM - fm) < WGM ? (nM - fm) : WGM;
        u.pm = fm + ((wgid % nig) % gsz); u.pn = (wgid % nig) / gsz;
        u.A = A + (size_t)u.pm * a_tile + (size_t)(u.pn >> agrp_shift) * agrp_stride; u.B = B + (size_t)u.pn * b_tile; u.rows = nullptr; u.nvalid = BM; u.aux = 0; return true;
    }
};
template <int NPN, bool GATHERED>
struct ExpertSched {
    const LAS int* tpref; const LAS int* cnt; const char* A; const char* B; const int* tok; size_t b_exp, b_tile, a_tile; int NU, G, c;
    __device__ __forceinline__ bool next(int i, Unit& u) const {
        int L = i * G + c; if (L >= NU) return false;
        if ((i + 1) * G <= NU && (G % NXCD) == 0) L = i * G + (c % NXCD) * (G / NXCD) + c / NXCD;
        const int tile = L / NPN, pn = L % NPN;
        int e = 0; while (__builtin_amdgcn_readfirstlane(tpref[e + 1]) <= tile) ++e;
        const int rb = tile - __builtin_amdgcn_readfirstlane(tpref[e]);
        u.pm = e; u.pn = pn; u.aux = tile * BM; u.nvalid = __builtin_amdgcn_readfirstlane(cnt[e]) - rb * BM; if (u.nvalid > BM) u.nvalid = BM;
        u.rows = tok + (size_t)e * CAP + rb * BM;
        u.A = GATHERED ? A : A + (size_t)tile * a_tile; u.B = B + (size_t)e * b_exp + (size_t)pn * b_tile; return true;
    }
};

struct EpiBf16 {
    static constexpr bool PERM = true;
    bf16* O; int ldc; int qscale;
    __device__ __forceinline__ void operator()(const f32x4 (&acc)[2][2][4][2], const Unit& u, int wr, int wc, int fr, int fq) const {
        asm volatile("" : "+v"(fr), "+v"(fq));
        const int row0 = u.pm * BM + wr * 64 + fr, col0 = u.pn * BM + wc * 32 + 8 * fq;
        const float sc = (qscale && (u.pn % 6) < 2) ? 0.125f : 1.0f;
#pragma unroll
        for (int ai = 0; ai < 2; ++ai)
#pragma unroll
            for (int m = 0; m < 4; ++m) { bf16* rowp = O + (size_t)(row0 + ai * HALF + m * 16) * ldc + col0;
#pragma unroll
                for (int bj = 0; bj < 2; ++bj) { const f32x4 v0 = acc[ai][bj][m][0] * sc, v1 = acc[ai][bj][m][1] * sc;
                    v4u w; w.x = cvt_pk_bf16(v0[0], v0[1]); w.y = cvt_pk_bf16(v0[2], v0[3]); w.z = cvt_pk_bf16(v1[0], v1[1]); w.w = cvt_pk_bf16(v1[2], v1[3]);
                    *(v4u*)(rowp + bj * HALF) = w; } }
    }
};
struct EpiScaleBf16 {
    static constexpr bool PERM = true;
    bf16* O; int ldc; const float* scale;
    __device__ __forceinline__ void operator()(const f32x4 (&acc)[2][2][4][2], const Unit& u, int wr, int wc, int fr, int fq) const {
        asm volatile("" : "+v"(fr), "+v"(fq));
        const int row0 = u.pm * BM + wr * 64 + fr, col0 = u.pn * BM + wc * 32 + 8 * fq;
        f32x4 sv[2][2];
#pragma unroll
        for (int bj = 0; bj < 2; ++bj)
#pragma unroll
            for (int n = 0; n < 2; ++n) sv[bj][n] = *(const f32x4*)(scale + col0 + bj * HALF + 4 * n);
#pragma unroll
        for (int ai = 0; ai < 2; ++ai)
#pragma unroll
            for (int m = 0; m < 4; ++m) { bf16* rowp = O + (size_t)(row0 + ai * HALF + m * 16) * ldc + col0;
#pragma unroll
                for (int bj = 0; bj < 2; ++bj) { const f32x4 v0 = acc[ai][bj][m][0] * sv[bj][0], v1 = acc[ai][bj][m][1] * sv[bj][1];
                    v4u w; w.x = cvt_pk_bf16(v0[0], v0[1]); w.y = cvt_pk_bf16(v0[2], v0[3]); w.z = cvt_pk_bf16(v1[0], v1[1]); w.w = cvt_pk_bf16(v1[2], v1[3]);
                    *(v4u*)(rowp + bj * HALF) = w; } }
    }
};
struct EpiResid {
    static constexpr bool PERM = false;
    const float* X; float* Y;
    __device__ __forceinline__ void operator()(const f32x4 (&acc)[2][2][4][2], const Unit& u, int wr, int wc, int fr, int fq) const {
        asm volatile("" : "+v"(fr), "+v"(fq));
        const int row0 = u.pm * BM + wr * 64 + fr, col0 = u.pn * BM + wc * 32 + 4 * fq;
#pragma unroll
        for (int ai = 0; ai < 2; ++ai)
#pragma unroll
            for (int m = 0; m < 4; ++m) { const size_t off = (size_t)(row0 + ai * HALF + m * 16) * D + col0;
#pragma unroll
                for (int bj = 0; bj < 2; ++bj)
#pragma unroll
                    for (int n = 0; n < 2; ++n) { const f32x4 xv = *(const f32x4*)(X + off + bj * HALF + n * 16); *(f32x4*)(Y + off + bj * HALF + n * 16) = xv * ALPHA + acc[ai][bj][m][n]; } }
    }
};
struct EpiResidLN {
    static constexpr bool PERM = true;
    const float* X32; const bf16* Xb; const float* st; const float* g; const float* b; bf16* Y; float* pst; int mode;
    __device__ __forceinline__ void operator()(const f32x4 (&acc)[2][2][4][2], const Unit& u, int wr, int wc, int fr, int fq) const {
        asm volatile("" : "+v"(fr), "+v"(fq));
        const int row0 = u.pm * BM + wr * 64 + fr, col0 = u.pn * BM + wc * 32 + 8 * fq, lane = fq * 16 + fr;
#pragma unroll
        for (int ai = 0; ai < 2; ++ai)
#pragma unroll
            for (int m = 0; m < 4; ++m) { const int row = row0 + ai * HALF + m * 16; const size_t off = (size_t)row * D + col0;
                float mean = 0.f, rstd = 1.f; if (mode == 1) { const f32x2 sv = *(const f32x2*)(st + 2 * row); mean = sv.x; rstd = sv.y; }
                float sm = 0.f, sq = 0.f;
#pragma unroll
                for (int bj = 0; bj < 2; ++bj) { f32x4 x0, x1;
                    if (mode == 2) { const v4u xv = *(const v4u*)(Xb + off + bj * HALF); x0 = (f32x4){bflo(xv.x), bfhi(xv.x), bflo(xv.y), bfhi(xv.y)}; x1 = (f32x4){bflo(xv.z), bfhi(xv.z), bflo(xv.w), bfhi(xv.w)}; }
                    else if (mode) { const v4u xv = *(const v4u*)(Xb + off + bj * HALF);
                        const f32x4 g0 = *(const f32x4*)(g + col0 + bj * HALF), g1 = *(const f32x4*)(g + col0 + bj * HALF + 4), b0 = *(const f32x4*)(b + col0 + bj * HALF), b1 = *(const f32x4*)(b + col0 + bj * HALF + 4);
                        x0 = ((f32x4){bflo(xv.x), bfhi(xv.x), bflo(xv.y), bfhi(xv.y)} - mean) * rstd * g0 + b0; x1 = ((f32x4){bflo(xv.z), bfhi(xv.z), bflo(xv.w), bfhi(xv.w)} - mean) * rstd * g1 + b1; }
                    else { x0 = *(const f32x4*)(X32 + off + bj * HALF); x1 = *(const f32x4*)(X32 + off + bj * HALF + 4); }
                    const f32x4 y0 = x0 * ALPHA + acc[ai][bj][m][0], y1 = x1 * ALPHA + acc[ai][bj][m][1];
                    v4u w; w.x = cvt_pk_bf16(y0[0], y0[1]); w.y = cvt_pk_bf16(y0[2], y0[3]); w.z = cvt_pk_bf16(y1[0], y1[1]); w.w = cvt_pk_bf16(y1[2], y1[3]);
                    *(v4u*)(Y + off + bj * HALF) = w;
                    sm += ((y0[0] + y0[1]) + (y0[2] + y0[3])) + ((y1[0] + y1[1]) + (y1[2] + y1[3]));
                    sq += ((y0[0] * y0[0] + y0[1] * y0[1]) + (y0[2] * y0[2] + y0[3] * y0[3])) + ((y1[0] * y1[0] + y1[1] * y1[1]) + (y1[2] * y1[2] + y1[3] * y1[3])); }
                sm += shfl_x(sm, 16, lane); sm += shfl_x(sm, 32, lane); sq += shfl_x(sq, 16, lane); sq += shfl_x(sq, 32, lane);
                if (fq == 0) *(f32x2*)(pst + ((size_t)row * 32 + u.pn * 4 + wc) * 2) = (f32x2){sm, sq}; }
    }
};
struct EpiConvIn {
    static constexpr bool PERM = true;
    bf16* UC; bf16* BGp;
    __device__ __forceinline__ void operator()(const f32x4 (&acc)[2][2][4][2], const Unit& u, int wr, int wc, int fr, int fq) const {
        asm volatile("" : "+v"(fr), "+v"(fq));
        const int row0 = u.pm * BM + wr * 64 + fr, cw = wc * 32 + 8 * fq;
        if (u.pn < 16) {
#pragma unroll
            for (int ai = 0; ai < 2; ++ai)
#pragma unroll
                for (int m = 0; m < 4; ++m) { bf16* rowp = UC + (size_t)(row0 + ai * HALF + m * 16) * D + u.pn * HALF + cw;
                    const f32x4 v0 = acc[ai][0][m][0] * acc[ai][1][m][0], v1 = acc[ai][0][m][1] * acc[ai][1][m][1];
                    v4u w; w.x = cvt_pk_bf16(v0[0], v0[1]); w.y = cvt_pk_bf16(v0[2], v0[3]); w.z = cvt_pk_bf16(v1[0], v1[1]); w.w = cvt_pk_bf16(v1[2], v1[3]);
                    *(v4u*)rowp = w; }
        } else {
#pragma unroll
            for (int ai = 0; ai < 2; ++ai)
#pragma unroll
                for (int m = 0; m < 4; ++m) { bf16* rowp = BGp + (size_t)(row0 + ai * HALF + m * 16) * D + (u.pn - 16) * BM + cw;
#pragma unroll
                    for (int bj = 0; bj < 2; ++bj) { const f32x4 v0 = acc[ai][bj][m][0], v1 = acc[ai][bj][m][1];
                        v4u w; w.x = cvt_pk_bf16(v0[0], v0[1]); w.y = cvt_pk_bf16(v0[2], v0[3]); w.z = cvt_pk_bf16(v1[0], v1[1]); w.w = cvt_pk_bf16(v1[2], v1[3]);
                        *(v4u*)(rowp + bj * HALF) = w; } }
        }
    }
};
__device__ __forceinline__ f32x4 silu_mul(f32x4 g, f32x4 uu) {
    f32x4 r;
#pragma unroll
    for (int j = 0; j < 4; ++j) r[j] = g[j] * __builtin_amdgcn_rcpf(1.0f + __expf(-g[j])) * uu[j];
    return r;
}
struct EpiExpertGU {
    static constexpr bool PERM = true;
    bf16* H;
    __device__ __forceinline__ void operator()(const f32x4 (&acc)[2][2][4][2], const Unit& u, int wr, int wc, int fr, int fq) const {
        asm volatile("" : "+v"(fr), "+v"(fq));
        const float* gates = (const float*)((const char*)u.rows + (WS_LGATE - WS_LTOK));
        const int cw = wc * 32 + 8 * fq;
#pragma unroll
        for (int ai = 0; ai < 2; ++ai)
#pragma unroll
            for (int m = 0; m < 4; ++m) { const int r = ai * HALF + wr * 64 + m * 16 + fr;
                if (r < u.nvalid) { const float gt = gates[r]; const unsigned pid = (unsigned)u.rows[r];
                    const f32x4 v0 = silu_mul(acc[ai][0][m][0], acc[ai][1][m][0]) * gt, v1 = silu_mul(acc[ai][0][m][1], acc[ai][1][m][1]) * gt;
                    v4u w; w.x = cvt_pk_bf16(v0[0], v0[1]); w.y = cvt_pk_bf16(v0[2], v0[3]); w.z = cvt_pk_bf16(v1[0], v1[1]); w.w = cvt_pk_bf16(v1[2], v1[3]);
                    (void)pid; *(v4u*)(H + (size_t)(u.aux + r) * EDIM + cw) = w; } }
    }
};
struct EpiSharedGU {
    static constexpr bool PERM = true;
    bf16* HS;
    __device__ __forceinline__ void operator()(const f32x4 (&acc)[2][2][4][2], const Unit& u, int wr, int wc, int fr, int fq) const {
        asm volatile("" : "+v"(fr), "+v"(fq));
        const int row0 = u.pm * BM + wr * 64 + fr, cw = u.pn * HALF + wc * 32 + 8 * fq;
#pragma unroll
        for (int ai = 0; ai < 2; ++ai)
#pragma unroll
            for (int m = 0; m < 4; ++m) {
                const f32x4 v0 = silu_mul(acc[ai][0][m][0], acc[ai][1][m][0]), v1 = silu_mul(acc[ai][0][m][1], acc[ai][1][m][1]);
                v4u w; w.x = cvt_pk_bf16(v0[0], v0[1]); w.y = cvt_pk_bf16(v0[2], v0[3]); w.z = cvt_pk_bf16(v1[0], v1[1]); w.w = cvt_pk_bf16(v1[2], v1[3]);
                *(v4u*)(HS + (size_t)(row0 + ai * HALF + m * 16) * SDIM + cw) = w; }
    }
};
struct EpiDownY {
    static constexpr bool PERM = true;
    bf16* Y;
    __device__ __forceinline__ void operator()(const f32x4 (&acc)[2][2][4][2], const Unit& u, int wr, int wc, int fr, int fq) const {
        asm volatile("" : "+v"(fr), "+v"(fq));
        const int col0 = u.pn * BM + wc * 32 + 8 * fq;
#pragma unroll
        for (int ai = 0; ai < 2; ++ai)
#pragma unroll
            for (int m = 0; m < 4; ++m) { const int r = ai * HALF + wr * 64 + m * 16 + fr; bf16* rowp = Y + (size_t)(u.aux + r) * D + col0;
#pragma unroll
                for (int bj = 0; bj < 2; ++bj) { const f32x4 v0 = acc[ai][bj][m][0], v1 = acc[ai][bj][m][1];
                    v4u w; w.x = cvt_pk_bf16(v0[0], v0[1]); w.y = cvt_pk_bf16(v0[2], v0[3]); w.z = cvt_pk_bf16(v1[0], v1[1]); w.w = cvt_pk_bf16(v1[2], v1[3]);
                    *(v4u*)(rowp + bj * HALF) = w; } }
    }
};
}

struct Args { const float* in[19]; float* out; unsigned char* ws; int ph_lo, ph_hi; };
struct Frame {
    LAS unsigned char* lds; unsigned* ctl; unsigned char* ws;
    int tid, lane, wave, G, bid;
};
enum { IN_X = 0, IN_RELB, IN_PWIN, IN_PWG, IN_PSC, IN_PWOUT, IN_DQKV, IN_DOUT, IN_CWIN, IN_CW, IN_CWOUT, IN_LNG, IN_LNB, IN_RW, IN_RB, IN_EGU, IN_ED, IN_SGU, IN_SD };

#define CAS __attribute__((address_space(4)))
typedef const CAS unsigned char* KP;
__device__ __forceinline__ const float* ain(KP kp, int i) { return (const float*)((const GAS float* const CAS*)kp)[i]; }
__device__ __forceinline__ float* aout(KP kp) { return (float*)((GAS float* const CAS*)kp)[19]; }
__device__ __forceinline__ void tr_item(const float* W, int K, int N, bf16* WT, int dstK, int mode, LAS float* scr, int item, int lane) {
    const int nblk = N / 32, kb = item / nblk, nb = item % nblk, k0 = 64 * kb, n0 = 32 * nb;
    int r0 = n0;
    if (mode == 1) { const int part = n0 / 2048, j = n0 % 2048; r0 = (part == 0) ? 4096 + j : 256 * (j / 128) + (part == 2 ? 128 : 0) + (j % 128); }
    if (mode == 2) { const int part = n0 / 256, j = n0 % 256; r0 = 256 * (j / 128) + 128 * part + (j % 128); }
#pragma unroll 8
    for (int i = 0; i < 32; ++i) { const int kk = 2 * i + (lane >> 5); scr[kk * 33 + (lane & 31)] = W[(size_t)(k0 + kk) * N + n0 + (lane & 31)]; }
    LDS_WAIT(); asm volatile("" ::: "memory");
    const int c = lane & 7;
#pragma unroll
    for (int j = 0; j < 4; ++j) { const int n = (lane >> 3) + 8 * j; const LAS float* s = scr + (8 * c) * 33 + n;
        v4u o; o.x = pk2(s[0 * 33], s[1 * 33]); o.y = pk2(s[2 * 33], s[3 * 33]); o.z = pk2(s[4 * 33], s[5 * 33]); o.w = pk2(s[6 * 33], s[7 * 33]);
        *(v4u*)(WT + (size_t)(r0 + n) * dstK + k0 + 8 * c) = o; }
    LDS_WAIT(); asm volatile("" ::: "memory");
}
__device__ __forceinline__ void phase_prologue(const Frame& F, KP kp) {
    LAS float* scr = (LAS float*)(F.lds + F.wave * 16384);
    const int gw = F.bid * 8 + F.wave, NGW = F.G * 8;
    constexpr int I0 = 2 * 2048, I1 = 8 * 128, I2 = 2 * 2048, I3 = 4608, I4 = 512, I5 = 6144, I6 = 2048, I7 = 4 * 512, I8 = 4 * 256, I9 = 256 * 256, I10 = 256 * 128;
    constexpr int NITEMS = I0 + I1 + I2 + I3 + I4 + I5 + I6 + I7 + I8 + I9 + I10;
    unsigned char* ws = F.ws;
    for (int it = gw; it < NITEMS; it += NGW) {
        int r = it;
        if (r < I0) { const int b = r / 2048; tr_item(ain(kp, IN_PWIN) + (size_t)b * D * D, D, D, (bf16*)(ws + WS_W_POOL_IN) + (size_t)b * D * D, D, 0, scr, r % 2048, F.lane); continue; } r -= I0;
        if (r < I1) { const int b = r / 128; tr_item(ain(kp, IN_PWG) + (size_t)b * 512 * 512, 512, 512, (bf16*)(ws + WS_W_POOL_G) + (size_t)b * 512 * 512, 512, 0, scr, r % 128, F.lane); continue; } r -= I1;
        if (r < I2) { const int b = r / 2048; tr_item(ain(kp, IN_PWOUT) + (size_t)b * D * D, D, D, (bf16*)(ws + WS_W_POOL_OUT) + (size_t)b * D * D, D, 0, scr, r % 2048, F.lane); continue; } r -= I2;
        if (r < I3) { tr_item(ain(kp, IN_DQKV), D, QKVC, (bf16*)(ws + WS_W_DIL_QKV), D, 0, scr, r, F.lane); continue; } r -= I3;
        if (r < I4) { tr_item(ain(kp, IN_DOUT), DILW, D, (bf16*)(ws + WS_W_DIL_OUT), DILW, 0, scr, r, F.lane); continue; } r -= I4;
        if (r < I5) { tr_item(ain(kp, IN_CWIN), D, 3 * D, (bf16*)(ws + WS_W_CONV_IN), D, 1, scr, r, F.lane); continue; } r -= I5;
        if (r < I6) { tr_item(ain(kp, IN_CWOUT), D, D, (bf16*)(ws + WS_W_CONV_OUT), D, 0, scr, r, F.lane); continue; } r -= I6;
        if (r < I7) { const int b = r / 512; tr_item(ain(kp, IN_SGU) + (size_t)b * D * 512, D, 512, (bf16*)(ws + WS_W_SH_GU) + (size_t)b * 512 * D, D, 2, scr, r % 512, F.lane); continue; } r -= I7;
        if (r < I8) { const int b = r / 256; tr_item(ain(kp, IN_SD) + (size_t)b * SDIM * D, SDIM, D, (bf16*)(ws + WS_W_SH_D) + (size_t)b * D * SDIM, SDIM, 0, scr, r % 256, F.lane); continue; } r -= I8;
        if (r < I9) { const int b = r / 256; tr_item(ain(kp, IN_EGU) + (size_t)b * D * 256, D, 256, (bf16*)(ws + WS_W_EX_GU) + (size_t)b * 256 * D, D, 0, scr, r % 256, F.lane); continue; } r -= I9;
        { const int b = r / 128; tr_item(ain(kp, IN_ED) + (size_t)b * EDIM * D, EDIM, D, (bf16*)(ws + WS_W_EX_D) + (size_t)b * D * EDIM, EDIM, 0, scr, r % 128, F.lane); }
    }
    const size_t gt = (size_t)F.bid * 512 + F.tid, GT = (size_t)F.G * 512;
    { const float* rw = ain(kp, IN_RW); bf16* wh = (bf16*)(ws + WS_RWH); bf16* wl = (bf16*)(ws + WS_RWL);
      for (size_t i = gt; i < (size_t)DEPTH * NEXP * D / 8; i += GT) { const size_t k8 = i % (D / 8), e = (i / (D / 8)) % NEXP, l = i / ((size_t)NEXP * D / 8);
          float v[8]; unsigned hi[8], lo[8];
#pragma unroll
          for (int j = 0; j < 8; ++j) { v[j] = rw[(l * D + k8 * 8 + j) * NEXP + e]; hi[j] = f2bf(v[j]); lo[j] = f2bf(v[j] - __builtin_bit_cast(float, hi[j] << 16)); }
          v4u a, b2; a.x = hi[0] | (hi[1] << 16); a.y = hi[2] | (hi[3] << 16); a.z = hi[4] | (hi[5] << 16); a.w = hi[6] | (hi[7] << 16);
          b2.x = lo[0] | (lo[1] << 16); b2.y = lo[2] | (lo[3] << 16); b2.z = lo[4] | (lo[5] << 16); b2.w = lo[6] | (lo[7] << 16);
          *(v4u*)(wh + (l * NEXP + e) * D + k8 * 8) = a; *(v4u*)(wl + (l * NEXP + e) * D + k8 * 8) = b2; } }
    const float* x = ain(kp, IN_X); bf16* xb = (bf16*)(ws + WS_XB);
    for (size_t i = gt; i < (size_t)T * D / 8; i += GT) { const f32x4 p = *(const f32x4*)(x + i * 8), q = *(const f32x4*)(x + i * 8 + 4);
        v4u w; w.x = pk2(p[0], p[1]); w.y = pk2(p[2], p[3]); w.z = pk2(q[0], q[1]); w.w = pk2(q[2], q[3]); *(v4u*)(xb + i * 8) = w; }
}

__device__ __forceinline__ void unpack8(const v4u w, float (&f)[8]) { f[0] = bflo(w.x); f[1] = bfhi(w.x); f[2] = bflo(w.y); f[3] = bfhi(w.y); f[4] = bflo(w.z); f[5] = bfhi(w.z); f[6] = bflo(w.w); f[7] = bfhi(w.w); }
__device__ __forceinline__ void phase_pool(const Frame& F, const bf16* U, bf16* PL) {
    for (int it = F.bid * 512 + F.tid; it < (T / 32) * 256; it += F.G * 512) {
        const int cv = it & 255, ch = it >> 8, col = cv * 8, w = 2 << (col >> 9);
        const int row0 = ch * 32, pos0 = row0 & (SEQ - 1);
        float s[8], uu[8];
#pragma unroll
        for (int j = 0; j < 8; ++j) s[j] = 0.f;
        for (int j = 1; j < w; ++j) if (pos0 - j >= 0) { unpack8(*(const v4u*)(U + (size_t)(row0 - j) * D + col), uu);
#pragma unroll
            for (int q = 0; q < 8; ++q) s[q] += uu[q]; }
        for (int r = 0; r < 32; ++r) {
            const int t = row0 + r, pos = pos0 + r;
            unpack8(*(const v4u*)(U + (size_t)t * D + col), uu);
            const float inv = 1.0f / (float)((pos + 1) < w ? (pos + 1) : w);
            float o[8];
#pragma unroll
            for (int q = 0; q < 8; ++q) { s[q] += uu[q]; o[q] = s[q] * inv - uu[q]; }
            v4u ww; ww.x = pk2(o[0], o[1]); ww.y = pk2(o[2], o[3]); ww.z = pk2(o[4], o[5]); ww.w = pk2(o[6], o[7]);
            *(v4u*)(PL + (size_t)t * D + col) = ww;
            if (pos - w + 1 >= 0) { unpack8(*(const v4u*)(U + (size_t)(t - w + 1) * D + col), uu);
#pragma unroll
                for (int q = 0; q < 8; ++q) s[q] -= uu[q]; }
        }
    }
}

__device__ __forceinline__ void phase_conv(const Frame& F, const bf16* UC, const bf16* BGp, const float* cw, bf16* Z) {
    for (int it = F.bid * 512 + F.tid; it < T * 256; it += F.G * 512) {
        const int cv = it & 255, t = it >> 8, col = cv * 8, pos = t & (SEQ - 1);
        float u0[8], u1[8], u2[8], bb[8], o[8];
        unpack8(*(const v4u*)(UC + (size_t)t * D + col), u2);
        if (pos >= 1) unpack8(*(const v4u*)(UC + (size_t)(t - 1) * D + col), u1); else {
#pragma unroll
            for (int q = 0; q < 8; ++q) u1[q] = 0.f; }
        if (pos >= 2) unpack8(*(const v4u*)(UC + (size_t)(t - 2) * D + col), u0); else {
#pragma unroll
            for (int q = 0; q < 8; ++q) u0[q] = 0.f; }
        unpack8(*(const v4u*)(BGp + (size_t)t * D + col), bb);
#pragma unroll
        for (int q = 0; q < 8; ++q) o[q] = bb[q] * (cw[col + q] * u0[q] + cw[D + col + q] * u1[q] + cw[2 * D + col + q] * u2[q]);
        v4u ww; ww.x = pk2(o[0], o[1]); ww.y = pk2(o[2], o[3]); ww.z = pk2(o[4], o[5]); ww.w = pk2(o[6], o[7]);
        *(v4u*)(Z + (size_t)t * D + col) = ww;
    }
}

__device__ __forceinline__ int t5_bucket(int dist) {
    if (dist < 16) return dist;
    int large = 16 + (int)(logf((float)dist / 16.0f) / logf(128.0f) * 16.0f);
    return large < 31 ? large : 31;
}
constexpr int AT_KS = 0, AT_KSTR = 144, AT_VT = 256 * 144, AT_VSTR = 520, AT_BIAS = AT_VT + 64 * 520;
__device__ __forceinline__ void phase_attn(const Frame& F, const bf16* QKV, const float* relb, bf16* OG, float* LSE) {
    LAS unsigned char* lds = F.lds;
    const int tid = F.tid, lane = F.lane, w = tid >> 6, fr = lane & 15, fq = lane >> 4;
    for (int unit = F.bid; unit < NBATCH * 3 * 8 * 16; unit += F.G) {
        const int cmb = unit & 15, h = (unit >> 4) & 7, g = (unit >> 7) % 3, b = unit / 384;
        const int dsh = 2 * g, dil = 1 << dsh, r = cmb & (dil - 1), nb = cmb >> dsh;
        const bf16* base = QKV + (size_t)b * SEQ * QKVC + g * 1536 + h * 64;
        __syncthreads();
        {
            const int key = tid >> 1, half = tid & 1, jk = (nb - 1) * 128 + key;
            v4u kv[4], vv[4];
            if (jk >= 0) { const bf16* rp = base + (size_t)(jk * dil + r) * QKVC + half * 32;
#pragma unroll
                for (int i = 0; i < 4; ++i) { kv[i] = *(const v4u*)(rp + 512 + 8 * i); vv[i] = *(const v4u*)(rp + 1024 + 8 * i); } }
            else {
#pragma unroll
                for (int i = 0; i < 4; ++i) { kv[i] = (v4u){0u, 0u, 0u, 0u}; vv[i] = (v4u){0u, 0u, 0u, 0u}; } }
#pragma unroll
            for (int i = 0; i < 4; ++i) *(LAS v4u*)(lds + AT_KS + key * AT_KSTR + half * 64 + 16 * i) = kv[i];
#pragma unroll
            for (int i = 0; i < 4; ++i) {
                const unsigned ww[4] = {vv[i].x, vv[i].y, vv[i].z, vv[i].w};
#pragma unroll
                for (int q = 0; q < 4; ++q) { const int d = half * 32 + 8 * i + 2 * q;
                    *(LAS unsigned short*)(lds + AT_VT + d * AT_VSTR + key * 2) = (unsigned short)(ww[q] & 0xffffu);
                    *(LAS unsigned short*)(lds + AT_VT + (d + 1) * AT_VSTR + key * 2) = (unsigned short)(ww[q] >> 16); } }
            if (tid <= 128) ((LAS float*)(lds + AT_BIAS))[tid] = relb[t5_bucket(tid * dil) * 24 + g * 8 + h];
        }
        __syncthreads();
        int qi = 16 * w + fr; asm volatile("" : "+v"(qi));
        const int jq = nb * 128 + qi, tq = jq * dil + r;
        const bf16* qp = base + (size_t)tq * QKVC + 8 * fq;
        const bf16x8 q0 = *(const bf16x8*)qp, q1 = *(const bf16x8*)(qp + 32);
        f32x4 s[9]; float mx = -INFINITY;
#pragma unroll
        for (int kt = 0; kt < 9; ++kt) {
            const int kb = 16 * (w + kt);
            const bf16x8 k0 = *(const LAS bf16x8*)(lds + AT_KS + (kb + fr) * AT_KSTR + fq * 16), k1 = *(const LAS bf16x8*)(lds + AT_KS + (kb + fr) * AT_KSTR + 64 + fq * 16);
            f32x4 a = (f32x4){0.f, 0.f, 0.f, 0.f};
            a = __builtin_amdgcn_mfma_f32_16x16x32_bf16(k0, q0, a, 0, 0, 0);
            a = __builtin_amdgcn_mfma_f32_16x16x32_bf16(k1, q1, a, 0, 0, 0);
#pragma unroll
            for (int i = 0; i < 4; ++i) { const int kl = kb + 4 * fq + i, rel = qi + 128 - kl;
                const bool ok = (rel >= 0) && (rel <= 128) && (nb > 0 || kl >= 128);
                const int rc = rel < 0 ? 0 : (rel > 128 ? 128 : rel);
                const float v = ok ? a[i] + ((LAS float*)(lds + AT_BIAS))[rc] : -INFINITY;
                a[i] = v; mx = fmaxf(mx, v); }
            s[kt] = a;
        }
        mx = fmaxf(mx, shfl_x(mx, 16, lane)); mx = fmaxf(mx, shfl_x(mx, 32, lane));
        float l = 0.f;
#pragma unroll
        for (int kt = 0; kt < 9; ++kt)
#pragma unroll
            for (int i = 0; i < 4; ++i) { const float p = __expf(s[kt][i] - mx); s[kt][i] = p; l += p; }
        l += shfl_x(l, 16, lane); l += shfl_x(l, 32, lane);
        f32x4 o[4];
#pragma unroll
        for (int nt = 0; nt < 4; ++nt) o[nt] = (f32x4){0.f, 0.f, 0.f, 0.f};
#pragma unroll
        for (int st = 0; st < 5; ++st) {
            const int kt0 = 2 * st, kt1 = 2 * st + 1;
            v4u pw; pw.x = pk2(s[kt0][0], s[kt0][1]); pw.y = pk2(s[kt0][2], s[kt0][3]);
            if (kt1 < 9) { pw.z = pk2(s[kt1 < 9 ? kt1 : 0][0], s[kt1 < 9 ? kt1 : 0][1]); pw.w = pk2(s[kt1 < 9 ? kt1 : 0][2], s[kt1 < 9 ? kt1 : 0][3]); } else { pw.z = 0u; pw.w = 0u; }
            const bf16x8 pf = __builtin_bit_cast(bf16x8, pw);
            const int kb0 = 16 * (w + kt0) + 4 * fq, kb1 = 16 * (w + kt1) + 4 * fq;
#pragma unroll
            for (int nt = 0; nt < 4; ++nt) { const int d = 16 * nt + fr;
                v2u va = *(const LAS v2u*)(lds + AT_VT + d * AT_VSTR + kb0 * 2), vb = (v2u){0u, 0u};
                if (kt1 < 9) vb = *(const LAS v2u*)(lds + AT_VT + d * AT_VSTR + kb1 * 2);
                v4u vw; vw.x = va.x; vw.y = va.y; vw.z = vb.x; vw.w = vb.y;
                o[nt] = __builtin_amdgcn_mfma_f32_16x16x32_bf16(__builtin_bit_cast(bf16x8, vw), pf, o[nt], 0, 0, 0); }
        }
        const float il = 1.0f / l;
        bf16* op = OG + ((size_t)g * T + (size_t)b * SEQ + tq) * DILW + h * 64 + 4 * fq;
#pragma unroll
        for (int nt = 0; nt < 4; ++nt) { v2u ww; ww.x = pk2(o[nt][0] * il, o[nt][1] * il); ww.y = pk2(o[nt][2] * il, o[nt][3] * il); *(v2u*)(op + 16 * nt) = ww; }
        if (fq == 0) LSE[((size_t)g * T + (size_t)b * SEQ + tq) * 8 + h] = mx + logf(l);
    }
}
__device__ __forceinline__ void phase_combine(const Frame& F, const bf16* OG, const float* LSE, bf16* O) {
    for (int it = F.bid * 512 + F.tid; it < T * 64; it += F.G * 512) {
        const int c8 = it & 7, h = (it >> 3) & 7, t = it >> 6;
        const float l0 = LSE[((size_t)0 * T + t) * 8 + h], l1 = LSE[((size_t)1 * T + t) * 8 + h], l2 = LSE[((size_t)2 * T + t) * 8 + h];
        const float m = fmaxf(l0, fmaxf(l1, l2)); float w0 = __expf(l0 - m), w1 = __expf(l1 - m), w2 = __expf(l2 - m); const float inv = 1.0f / (w0 + w1 + w2); w0 *= inv; w1 *= inv; w2 *= inv;
        float a[8], bq[8], c[8], o[8]; const size_t off = (size_t)t * DILW + h * 64 + c8 * 8;
        unpack8(*(const v4u*)(OG + off), a); unpack8(*(const v4u*)(OG + (size_t)T * DILW + off), bq); unpack8(*(const v4u*)(OG + (size_t)2 * T * DILW + off), c);
#pragma unroll
        for (int q = 0; q < 8; ++q) o[q] = w0 * a[q] + w1 * bq[q] + w2 * c[q];
        v4u ww; ww.x = pk2(o[0], o[1]); ww.y = pk2(o[2], o[3]); ww.z = pk2(o[4], o[5]); ww.w = pk2(o[6], o[7]);
        *(v4u*)(O + off) = ww;
    }
}

constexpr int M1_LOG = 131072, M1_STAT = M1_LOG + 4096, M1_HIST = M1_STAT + 128, M1_BASE = M1_HIST + 256;
__device__ __forceinline__ void phase_moe1(const Frame& F, const float* Y, const float* gain, const float* bias, const float* RW, const float* RB,
                                           float* X1F, bf16* X1B, unsigned* cnt, int* ltok, float* lgate, int* eidx, int* inv) {
    LAS float* xs = (LAS float*)F.lds; LAS float* logit = (LAS float*)(F.lds + M1_LOG); LAS float* stat = (LAS float*)(F.lds + M1_STAT);
    LAS int* hist = (LAS int*)(F.lds + M1_HIST); LAS int* basep = (LAS int*)(F.lds + M1_BASE);
    const int tid = F.tid, lane = F.lane, w = F.wave;
    for (int rg = F.bid; rg < T / 16; rg += F.G) {
        const int row0 = rg * 16;
        __syncthreads();
#pragma unroll
        for (int j = 0; j < 16; ++j) { const int idx = tid + 512 * j; *(LAS f32x4*)(xs + idx * 4) = *(const f32x4*)(Y + (size_t)row0 * D + (size_t)idx * 4); }
        if (tid < 64) hist[tid] = 0;
        __syncthreads();
#pragma unroll
        for (int rr = 0; rr < 2; ++rr) { const int r = 2 * w + rr; float sm = 0.f;
#pragma unroll
            for (int j = 0; j < 32; ++j) sm += xs[r * D + lane + 64 * j];
            const float mean = wave_sum(sm, lane) * (1.0f / D); float sq = 0.f;
#pragma unroll
            for (int j = 0; j < 32; ++j) { const float d = xs[r * D + lane + 64 * j] - mean; sq += d * d; }
            const float rstd = 1.0f / sqrtf(wave_sum(sq, lane) * (1.0f / D) + LN_EPS);
            if (lane == 0) { stat[2 * r] = mean; stat[2 * r + 1] = rstd; } }
        __syncthreads();
#pragma unroll
        for (int j = 0; j < 16; ++j) { const int idx = tid + 512 * j, r = idx >> 9, c4 = (idx & 511) * 4;
            const f32x4 v = *(LAS f32x4*)(xs + idx * 4), gv = *(const f32x4*)(gain + c4), bv = *(const f32x4*)(bias + c4);
            const float mean = stat[2 * r], rstd = stat[2 * r + 1];
            const f32x4 o = (v - mean) * rstd * gv + bv;
            *(LAS f32x4*)(xs + idx * 4) = o;
            *(f32x4*)(X1F + (size_t)(row0 + r) * D + c4) = o;
            v2u wb; wb.x = pk2(o[0], o[1]); wb.y = pk2(o[2], o[3]); *(v2u*)(X1B + (size_t)(row0 + r) * D + c4) = wb; }
        __syncthreads();
        { const int r = tid >> 5, ep = tid & 31; float a0 = 0.f, a1 = 0.f; const float* wp = RW + 2 * ep; const LAS float* xr = xs + r * D;
            for (int k0 = 0; k0 < D; k0 += 16) {
                f32x2 wv[16];
#pragma unroll
                for (int j = 0; j < 16; ++j) wv[j] = *(const f32x2*)(wp + (size_t)(k0 + j) * NEXP);
                asm volatile("" : "+v"(wv[0]), "+v"(wv[1]), "+v"(wv[2]), "+v"(wv[3]), "+v"(wv[4]), "+v"(wv[5]), "+v"(wv[6]), "+v"(wv[7]));
                asm volatile("" : "+v"(wv[8]), "+v"(wv[9]), "+v"(wv[10]), "+v"(wv[11]), "+v"(wv[12]), "+v"(wv[13]), "+v"(wv[14]), "+v"(wv[15]));
#pragma unroll
                for (int j = 0; j < 16; ++j) { const float xv = xr[k0 + j]; a0 += xv * wv[j].x; a1 += xv * wv[j].y; } }
            logit[r * NEXP + 2 * ep] = a0; logit[r * NEXP + 2 * ep + 1] = a1; }
        __syncthreads();
        int sel_pos[2]; float sel_gate[2]; int sel_rank[2]; bool sel_on[2];
#pragma unroll
        for (int rr = 0; rr < 2; ++rr) { const int r = 2 * w + rr;
            const float sc = 1.0f / (1.0f + __expf(-logit[r * NEXP + lane])); const float ch = sc + RB[lane];
            int rk = 0;
#pragma unroll
            for (int j = 0; j < 8; ++j) { const float cj = shfl_from(ch, (lane & ~7) + j); rk += (cj > ch || (cj == ch && j < (lane & 7))) ? 1 : 0; }
            float gs = rk < 2 ? ch : 0.f; gs += shfl_x(gs, 1, lane); gs += shfl_x(gs, 2, lane); gs += shfl_x(gs, 4, lane);
            int grk = 0; const int g = lane >> 3;
#pragma unroll
            for (int hh = 0; hh < 8; ++hh) { const float gh = shfl_from(gs, 8 * hh); grk += (gh > gs || (gh == gs && hh < g)) ? 1 : 0; }
            const float msk = grk < 4 ? ch : -INFINITY;
            int erk = 0;
            for (int j = 0; j < 64; ++j) { const float mj = __builtin_bit_cast(float, __builtin_amdgcn_readlane(__builtin_bit_cast(int, msk), j)); erk += (mj > msk || (mj == msk && j < lane)) ? 1 : 0; }
            const bool on = erk < 8;
            const float ssum = wave_sum(on ? sc : 0.f, lane);
            sel_on[rr] = on; sel_rank[rr] = erk; sel_gate[rr] = sc / ssum * 2.5f; sel_pos[rr] = 0;
            if (on) sel_pos[rr] = __hip_atomic_fetch_add(&hist[lane], 1, __ATOMIC_RELAXED, __HIP_MEMORY_SCOPE_WORKGROUP); }
        __syncthreads();
        if (tid < 64) { const int hc = hist[tid]; int bs = 0; if (hc > 0) bs = (int)atomicAdd(&cnt[tid * 16], (unsigned)hc); basep[tid] = bs; }
        __syncthreads();
#pragma unroll
        for (int rr = 0; rr < 2; ++rr) if (sel_on[rr]) { const int t = row0 + 2 * w + rr, pos = basep[lane] + sel_pos[rr];
            ltok[(size_t)lane * CAP + pos] = t; lgate[(size_t)lane * CAP + pos] = sel_gate[rr];
            eidx[t * 8 + sel_rank[rr]] = lane; inv[t * 8 + sel_rank[rr]] = pos; }
    }
}
__device__ __forceinline__ int build_tiles(const Frame& F, const unsigned* cnt) {
    LAS int* tpref = (LAS int*)(F.lds + LDS_TAB); LAS int* cl = (LAS int*)(F.lds + LDS_TAB + 512);
    __syncthreads();
    if (F.tid < 64) cl[F.tid] = (int)__hip_atomic_load(&cnt[F.tid * 16], __ATOMIC_RELAXED, __HIP_MEMORY_SCOPE_AGENT);
    __syncthreads();
    if (F.tid == 0) { int acc = 0; for (int e = 0; e < 64; ++e) { tpref[e] = acc; acc += (cl[e] + 255) >> 8; } tpref[64] = acc; tpref[65] = acc + T / 256; tpref[66] = acc + 2 * (T / 256); cl[64] = T; cl[65] = T; }
    __syncthreads();
    return __builtin_amdgcn_readfirstlane(tpref[64]);
}
__device__ __forceinline__ void phase_moe4(const Frame& F, const float* Y2, const bf16* Yr, const int* eidx, const int* inv, const float* gain, const float* bias, float* XO, bf16* XBo) {
    const LAS int* tpref = (const LAS int*)(F.lds + LDS_TAB);
    const int gw = F.bid * 8 + F.wave, NGW = F.G * 8, lane = F.lane;
    for (int t = gw; t < T; t += NGW) {
        f32x4 v[8];
#pragma unroll
        for (int j = 0; j < 8; ++j) v[j] = *(const f32x4*)(Y2 + (size_t)t * D + 4 * lane + 256 * j);
        for (int k = 0; k < 8; ++k) { const int e = eidx[t * 8 + k], pos = inv[t * 8 + k]; const bf16* yr = Yr + (size_t)(tpref[e] * 256 + pos) * D + 4 * lane;
#pragma unroll
            for (int j = 0; j < 8; ++j) { const v2u w = *(const v2u*)(yr + 256 * j); v[j][0] += bflo(w.x); v[j][1] += bfhi(w.x); v[j][2] += bflo(w.y); v[j][3] += bfhi(w.y); } }
        float sm = 0.f;
#pragma unroll
        for (int j = 0; j < 8; ++j) sm += (v[j][0] + v[j][1]) + (v[j][2] + v[j][3]);
        const float mean = wave_sum(sm, lane) * (1.0f / D); float sq = 0.f;
#pragma unroll
        for (int j = 0; j < 8; ++j) { v[j] = v[j] - mean; sq += (v[j][0] * v[j][0] + v[j][1] * v[j][1]) + (v[j][2] * v[j][2] + v[j][3] * v[j][3]); }
        const float rstd = 1.0f / sqrtf(wave_sum(sq, lane) * (1.0f / D) + LN_EPS);
#pragma unroll
        for (int j = 0; j < 8; ++j) { const int c = 4 * lane + 256 * j; const f32x4 o = v[j] * rstd * *(const f32x4*)(gain + c) + *(const f32x4*)(bias + c);
            *(f32x4*)(XO + (size_t)t * D + c) = o;
            v2u wb; wb.x = pk2(o[0], o[1]); wb.y = pk2(o[2], o[3]); *(v2u*)(XBo + (size_t)t * D + c) = wb; }
    }
}


constexpr int M1_P = 0, M1N_HIST = 131072, M1N_BASE = 131072 + 256, M1N_GB = 131072 + 1024;
__device__ __forceinline__ void phase_moe1n(const Frame& F, const bf16* Y, const float* pst, const float* gain, const float* bias, const bf16* WH, const bf16* WL, const float* RB,
                                            bf16* X1B, float* ST1, unsigned* cnt, int* ltok, float* lgate, int* eidx, int* inv) {
    LAS float* P = (LAS float*)(F.lds + M1_P); LAS int* hist = (LAS int*)(F.lds + M1N_HIST); LAS int* basep = (LAS int*)(F.lds + M1N_BASE);
    const int tid = F.tid, lane = F.lane, w = F.wave, r = lane & 15, q = lane >> 4;
    for (int item = F.bid; item < T / 64; item += F.G) {
        const int row0 = item * 64;
        __syncthreads();
        if (tid < 64) hist[tid] = 0;
        { LAS f32x4* gb = (LAS f32x4*)(F.lds + M1N_GB); gb[tid] = *(const f32x4*)(gain + 4 * tid); gb[512 + tid] = *(const f32x4*)(bias + 4 * tid); }
        __syncthreads();
        float mean[4], rstd[4];
#pragma unroll
        for (int rt = 0; rt < 4; ++rt) { const int row = row0 + 16 * rt + r;
          const f32x4* pp = (const f32x4*)(pst + ((size_t)row * 32 + q * 8) * 2); const f32x4 a = pp[0], b = pp[1], c = pp[2], d = pp[3];
          float sm = (a[0] + a[2]) + (b[0] + b[2]) + (c[0] + c[2]) + (d[0] + d[2]), sq = (a[1] + a[3]) + (b[1] + b[3]) + (c[1] + c[3]) + (d[1] + d[3]);
          sm += shfl_x(sm, 16, lane); sm += shfl_x(sm, 32, lane); sq += shfl_x(sq, 16, lane); sq += shfl_x(sq, 32, lane);
          mean[rt] = sm * (1.0f / D); const float var = fmaxf(sq * (1.0f / D) - mean[rt] * mean[rt], 0.f); rstd[rt] = 1.0f / sqrtf(var + LN_EPS);
          if (w == 0 && q == 0) *(f32x2*)(ST1 + 2 * row) = (f32x2){mean[rt], rstd[rt]}; }
        const int kb = 256 * w + 8 * q;
        const LAS float* gl = (const LAS float*)(F.lds + M1N_GB) + kb;
        f32x4 acc[4][4];
#pragma unroll
        for (int rt = 0; rt < 4; ++rt)
#pragma unroll
            for (int nt = 0; nt < 4; ++nt) acc[rt][nt] = (f32x4){0.f, 0.f, 0.f, 0.f};
        v4u yb[3][4]; bf16x8 wh[4], wl[4];
        unsigned vo[4];
#pragma unroll
        for (int i = 0; i < 4; ++i) { vo[i] = (unsigned)(r * D + kb) * 2u + (unsigned)i * (16u * D * 2u); asm volatile("" : "+v"(vo[i])); }
        const char* ybase = (const char*)(Y + (size_t)row0 * D); char* xbase = (char*)(X1B + (size_t)row0 * D);
#define M1_LOADY(st) do { _Pragma("unroll") for (int rt = 0; rt < 4; ++rt) yb[(st) % 3][rt] = *(const v4u*)(ybase + vo[rt] + 64 * (st)); } while (0)
#define M1_LOADW(st) do { _Pragma("unroll") for (int nt = 0; nt < 4; ++nt) { wh[nt] = *(const bf16x8*)((const char*)WH + vo[nt] + 64 * (st)); wl[nt] = *(const bf16x8*)((const char*)WL + vo[nt] + 64 * (st)); } } while (0)
        M1_LOADY(0); M1_LOADW(0); M1_LOADY(1);
        __builtin_amdgcn_sched_barrier(0);
#pragma unroll
        for (int st = 0; st < 8; ++st) {
            const f32x4 g0 = *(const LAS f32x4*)(gl + 32 * st), g1 = *(const LAS f32x4*)(gl + 32 * st + 4), b0 = *(const LAS f32x4*)(gl + 2048 + 32 * st), b1 = *(const LAS f32x4*)(gl + 2048 + 32 * st + 4);
#pragma unroll
            for (int rt = 0; rt < 4; ++rt) { const v4u yv = yb[st % 3][rt];
                const f32x4 y0_ = (f32x4){bflo(yv.x), bfhi(yv.x), bflo(yv.y), bfhi(yv.y)}, y1_ = (f32x4){bflo(yv.z), bfhi(yv.z), bflo(yv.w), bfhi(yv.w)};
                const f32x4 x0 = (y0_ - mean[rt]) * rstd[rt] * g0 + b0, x1 = (y1_ - mean[rt]) * rstd[rt] * g1 + b1;
                v4u h; h.x = cvt_pk_bf16(x0[0], x0[1]); h.y = cvt_pk_bf16(x0[2], x0[3]); h.z = cvt_pk_bf16(x1[0], x1[1]); h.w = cvt_pk_bf16(x1[2], x1[3]);
                *(v4u*)(xbase + vo[rt] + 64 * st) = h;
                v4u l; l.x = cvt_pk_bf16(x0[0] - bflo(h.x), x0[1] - bfhi(h.x)); l.y = cvt_pk_bf16(x0[2] - bflo(h.y), x0[3] - bfhi(h.y));
                l.z = cvt_pk_bf16(x1[0] - bflo(h.z), x1[1] - bfhi(h.z)); l.w = cvt_pk_bf16(x1[2] - bflo(h.w), x1[3] - bfhi(h.w));
                const bf16x8 xh = __builtin_bit_cast(bf16x8, h), xl = __builtin_bit_cast(bf16x8, l);
#pragma unroll
                for (int nt = 0; nt < 4; ++nt) { acc[rt][nt] = __builtin_amdgcn_mfma_f32_16x16x32_bf16(xh, wh[nt], acc[rt][nt], 0, 0, 0);
                    acc[rt][nt] = __builtin_amdgcn_mfma_f32_16x16x32_bf16(xl, wh[nt], acc[rt][nt], 0, 0, 0); acc[rt][nt] = __builtin_amdgcn_mfma_f32_16x16x32_bf16(xh, wl[nt], acc[rt][nt], 0, 0, 0); } }
            __builtin_amdgcn_sched_barrier(0);
            if (st + 1 < 8) M1_LOADW(st + 1);
            if (st + 2 < 8) M1_LOADY(st + 2);
            __builtin_amdgcn_sched_barrier(0);
        }
#undef M1_LOADY
#undef M1_LOADW
#pragma unroll
        for (int rt = 0; rt < 4; ++rt)
#pragma unroll
            for (int nt = 0; nt < 4; ++nt)
#pragma unroll
                for (int i = 0; i < 4; ++i) P[(w * 64 + 16 * rt + 4 * q + i) * 64 + 16 * nt + r] = acc[rt][nt][i];
        __syncthreads();
        int sel_pos[8]; float sel_gate[8]; int sel_rank[8]; bool sel_on[8];
        const float rb = RB[lane];
#pragma unroll
        for (int rr = 0; rr < 8; ++rr) { const int rl = 8 * w + rr;
            float lg = ((P[rl * 64 + lane] + P[(64 + rl) * 64 + lane]) + (P[(128 + rl) * 64 + lane] + P[(192 + rl) * 64 + lane])) + ((P[(256 + rl) * 64 + lane] + P[(320 + rl) * 64 + lane]) + (P[(384 + rl) * 64 + lane] + P[(448 + rl) * 64 + lane]));
            lg = (lg == lg) ? lg : -1.0e30f;
            const float sc = 1.0f / (1.0f + __expf(-lg)); const float ch = sc + rb;
            int rk = 0;
#pragma unroll
            for (int j = 0; j < 8; ++j) { const float cj = shfl_from(ch, (lane & ~7) + j); rk += (cj > ch || (cj == ch && j < (lane & 7))) ? 1 : 0; }
            float gs = rk < 2 ? ch : 0.f; gs += shfl_x(gs, 1, lane); gs += shfl_x(gs, 2, lane); gs += shfl_x(gs, 4, lane);
            int grk = 0; const int g = lane >> 3;
#pragma unroll
            for (int hh = 0; hh < 8; ++hh) { const float gh = shfl_from(gs, 8 * hh); grk += (gh > gs || (gh == gs && hh < g)) ? 1 : 0; }
            const float msk = grk < 4 ? ch : -INFINITY;
            int erk = 0;
            for (int j = 0; j < 64; ++j) { const float mj = __builtin_bit_cast(float, __builtin_amdgcn_readlane(__builtin_bit_cast(int, msk), j)); erk += (mj > msk || (mj == msk && j < lane)) ? 1 : 0; }
            const bool on = erk < 8;
            const float ssum = wave_sum(on ? sc : 0.f, lane);
            sel_on[rr] = on; sel_rank[rr] = erk; sel_gate[rr] = sc / ssum * 2.5f; sel_pos[rr] = 0;
            if (on) sel_pos[rr] = __hip_atomic_fetch_add(&hist[lane], 1, __ATOMIC_RELAXED, __HIP_MEMORY_SCOPE_WORKGROUP); }
        __syncthreads();
        if (tid < 64) { int tt = tid; asm volatile("" : "+v"(tt));
            const int hc = hist[tt]; int bs = 0; if (hc > 0) bs = (int)atomicAdd(&cnt[tt * 16], (unsigned)hc); basep[tt] = bs; }
        __syncthreads();
#pragma unroll
        for (int rr = 0; rr < 8; ++rr) if (sel_on[rr]) { const int t = row0 + 8 * w + rr, pos = basep[lane] + sel_pos[rr];
            ltok[(size_t)lane * CAP + pos] = t * 8 + sel_rank[rr]; lgate[(size_t)lane * CAP + pos] = sel_gate[rr];
            eidx[t * 8 + sel_rank[rr]] = lane; inv[t * 8 + sel_rank[rr]] = pos; }
    }
}

constexpr int M3_PL = 131072, M3_CNT = 147456, M3_OFF = 147456 + 272;
__device__ __forceinline__ void phase_moe3n(const Frame& F, const bf16* H, const bf16* HSp, const int* eidx, const bf16* WD, const bf16* WSD,
                                            const float* Y1, const float* ST1, const float* g1, const float* b1, float* Y2, float* PST2) {
    LAS int* out = (LAS int*)F.lds; LAS unsigned short* plist = (LAS unsigned short*)(F.lds + M3_PL); LAS int* cnt = (LAS int*)(F.lds + M3_CNT); LAS int* off = (LAS int*)(F.lds + M3_OFF);
    const int tid = F.tid, lane = F.lane, w = F.wave, r = lane & 15, q = lane >> 4;
    for (int u = F.bid; u < 1024; u += F.G) {
        int nc = (u & 7) | ((u >> 7) << 3), tb = (u >> 3) & 15;
        if (F.G == 256) { const int i = u >> 8, x = u & 7, j = (u >> 3) & 31; tb = 2 * x + (i >> 1); nc = 32 * (i & 1) + j; }
        __syncthreads();
#pragma unroll
        for (int j = 0; j < 16; ++j) ((LAS v4u*)out)[tid + 512 * j] = (v4u){0u, 0u, 0u, 0u};
        if (tid < 66) cnt[tid] = 0;
        __syncthreads();
        int ee[16], pp[16];
        { const v4u* ep = (const v4u*)(eidx + ((size_t)tb * 1024 + 2 * tid) * 8); const v4u e0 = ep[0], e1 = ep[1], e2 = ep[2], e3 = ep[3];
          ee[0] = e0.x; ee[1] = e0.y; ee[2] = e0.z; ee[3] = e0.w; ee[4] = e1.x; ee[5] = e1.y; ee[6] = e1.z; ee[7] = e1.w;
          ee[8] = e2.x; ee[9] = e2.y; ee[10] = e2.z; ee[11] = e2.w; ee[12] = e3.x; ee[13] = e3.y; ee[14] = e3.z; ee[15] = e3.w; }
#pragma unroll
        for (int j = 0; j < 16; ++j) pp[j] = __hip_atomic_fetch_add(&cnt[ee[j]], 1, __ATOMIC_RELAXED, __HIP_MEMORY_SCOPE_WORKGROUP);
        __syncthreads();
        if (w == 0) { int c = cnt[lane], x = c;
#pragma unroll
            for (int o = 1; o < 64; o <<= 1) { const int y = __builtin_amdgcn_ds_bpermute(((lane - o) & 63) << 2, x); if (lane >= o) x += y; }
            off[lane] = x - c; if (lane == 63) off[64] = x; }
        __syncthreads();
#pragma unroll
        for (int j = 0; j < 16; ++j) plist[off[ee[j]] + pp[j]] = (unsigned short)(tid * 16 + j);
        __syncthreads();
        const char* Hb = (const char*)H + (size_t)tb * 8192 * 256 + q * 16;
        const char* HSb = (const char*)HSp + (size_t)tb * 1024 * 512 + q * 16;
        const char* Bb = (const char*)WD + ((size_t)nc * 32 + r) * 256 + q * 16;
        const char* BSb = (const char*)WSD + ((size_t)nc * 32 + r) * 512 + q * 16;
#define M3_NR(sg) ((sg) < 8 ? __builtin_amdgcn_readfirstlane(cnt[w + 8 * (sg)]) : 128)
#define M3_RB(sg) ((sg) < 8 ? __builtin_amdgcn_readfirstlane(off[w + 8 * (sg)]) : 0)
#define M3_GLD(dst, ptr, OFF) asm volatile("global_load_dwordx4 %0, %1, off offset:" #OFF : "=&v"(dst) : "v"(ptr) : "memory")
#define M3_LOADB(dst, sg) do { const char* _b0 = (sg) < 8 ? Bb + (size_t)(w + 8 * (sg)) * 524288 : BSb + ((sg) - 8) * 256; const char* _b1 = _b0 + ((sg) < 8 ? 4096 : 8192); \
            M3_GLD(dst[0][0], _b0, 0); M3_GLD(dst[0][1], _b0, 64); M3_GLD(dst[0][2], _b0, 128); M3_GLD(dst[0][3], _b0, 192); \
            M3_GLD(dst[1][0], _b1, 0); M3_GLD(dst[1][1], _b1, 64); M3_GLD(dst[1][2], _b1, 128); M3_GLD(dst[1][3], _b1, 192); } while (0)
#define M3_LOADA(dst, sg, bb, nr, rbs) do { int _i = 16 * (bb) + r; _i = _i < (nr) ? _i : (nr) - 1; const unsigned _rid = plist[(rbs) + _i]; \
            const char* _a = (sg) < 8 ? Hb + (size_t)_rid * 256 : ((sg) < 10 ? HSb + (size_t)(128 * w + _i) * 512 + ((sg) - 8) * 256 : Hb); \
            M3_GLD(dst[0], _a, 0); M3_GLD(dst[1], _a, 64); M3_GLD(dst[2], _a, 128); M3_GLD(dst[3], _a, 192); } while (0)
#define M3_ADV(sg, bb, nr, rbs) do { if ((sg) < 10) { ++(bb); if ((bb) * 16 >= (nr)) { (bb) = 0; do { ++(sg); } while ((sg) < 8 && M3_NR(sg) == 0); if ((sg) < 10) { (nr) = M3_NR(sg); (rbs) = M3_RB(sg); } } } } while (0)
#define M3_WAITA(AS) asm volatile("s_waitcnt vmcnt(12)" : "+v"(AS[0]), "+v"(AS[1]), "+v"(AS[2]), "+v"(AS[3]) :: "memory")
#define M3_WAITB(N) asm volatile("s_waitcnt vmcnt(" #N ")" : "+v"(Bn[0][0]), "+v"(Bn[0][1]), "+v"(Bn[0][2]), "+v"(Bn[0][3]), "+v"(Bn[1][0]), "+v"(Bn[1][1]), "+v"(Bn[1][2]), "+v"(Bn[1][3]) :: "memory")
#define M3_STEP(AS) if (cseg < 10) { \
              \
            int tk[4]; bool ok[4]; unsigned pl[4]; const int rt_ = cseg < 8; \
            _Pragma("unroll") for (int i = 0; i < 4; ++i) { const int idx = 16 * cbt + 4 * q + i; ok[i] = idx < cnr; const int ic = ok[i] ? idx : cnr - 1; pl[i] = plist[crbs + ic]; tk[i] = 128 * w + ic; } \
            _Pragma("unroll") for (int i = 0; i < 4; ++i) tk[i] = rt_ ? (int)(pl[i] >> 3) : tk[i]; \
            M3_WAITA(AS); \
            f32x4 acc[2]; \
            _Pragma("unroll") for (int nt = 0; nt < 2; ++nt) { acc[nt] = (f32x4){0.f, 0.f, 0.f, 0.f}; \
                _Pragma("unroll") for (int kk = 0; kk < 4; ++kk) acc[nt] = __builtin_amdgcn_mfma_f32_16x16x32_bf16(__builtin_bit_cast(bf16x8, AS[kk]), __builtin_bit_cast(bf16x8, Bc[nt][kk]), acc[nt], 0, 0, 0); } \
              \
            _Pragma("unroll") for (int i = 0; i < 4; ++i) { const long long lo_ = ok[i] ? (long long)__float2int_rn(acc[0][i] * 4194304.0f) : 0ll, hi_ = ok[i] ? (long long)__float2int_rn(acc[1][i] * 4194304.0f) : 0ll; \
                (void)__hip_atomic_fetch_add((LAS unsigned long long*)out + tk[i] * 16 + r, (unsigned long long)((hi_ << 32) + lo_), __ATOMIC_RELAXED, __HIP_MEMORY_SCOPE_WORKGROUP); } \
            M3_LOADA(AS, pseg, pbt, pnr, prbs); M3_ADV(pseg, pbt, pnr, prbs); \
            { const int old_ = cseg, nbat_ = (cnr + 15) >> 4; M3_ADV(cseg, cbt, cnr, crbs); \
              if (cseg != old_ && cseg < 10) { \
                  if (nbat_ == 1) M3_WAITB(4); else if (nbat_ == 2) M3_WAITB(8); else if (nbat_ == 3) M3_WAITB(12); else M3_WAITB(16); \
                  _Pragma("unroll") for (int nt = 0; nt < 2; ++nt) _Pragma("unroll") for (int kk = 0; kk < 4; ++kk) Bc[nt][kk] = Bn[nt][kk]; \
                  int nb_ = cseg; do { ++nb_; } while (nb_ < 8 && M3_NR(nb_) == 0); if (nb_ >= 10) nb_ = 9; M3_LOADB(Bn, nb_); } } }
        int cseg = -1, cbt = 0, cnr = 0, crbs = 0;
        do { ++cseg; } while (cseg < 8 && M3_NR(cseg) == 0);
        cnr = M3_NR(cseg); crbs = M3_RB(cseg);
        int pseg = cseg, pbt = 0, pnr = cnr, prbs = crbs;
        v4u Bc[2][4], Bn[2][4], A0[4], A1[4], A2[4], A3[4];
        M3_LOADB(Bc, cseg);
        M3_LOADA(A0, pseg, pbt, pnr, prbs); M3_ADV(pseg, pbt, pnr, prbs);
        M3_LOADA(A1, pseg, pbt, pnr, prbs); M3_ADV(pseg, pbt, pnr, prbs);
        M3_LOADA(A2, pseg, pbt, pnr, prbs); M3_ADV(pseg, pbt, pnr, prbs);
        M3_LOADA(A3, pseg, pbt, pnr, prbs); M3_ADV(pseg, pbt, pnr, prbs);
        { int nb_ = cseg; do { ++nb_; } while (nb_ < 8 && M3_NR(nb_) == 0); if (nb_ >= 10) nb_ = 9; M3_LOADB(Bn, nb_); }
        asm volatile("s_waitcnt vmcnt(0)" : "+v"(Bc[0][0]), "+v"(Bc[0][1]), "+v"(Bc[0][2]), "+v"(Bc[0][3]), "+v"(Bc[1][0]), "+v"(Bc[1][1]), "+v"(Bc[1][2]), "+v"(Bc[1][3]) :: "memory");
#pragma unroll 1
        while (cseg < 10) { M3_STEP(A0) M3_STEP(A1) M3_STEP(A2) M3_STEP(A3) }
        asm volatile("s_waitcnt vmcnt(0)" : "+v"(A0[0]), "+v"(A0[1]), "+v"(A0[2]), "+v"(A0[3]), "+v"(A1[0]), "+v"(A1[1]), "+v"(A1[2]), "+v"(A1[3]), "+v"(A2[0]), "+v"(A2[1]), "+v"(A2[2]), "+v"(A2[3]),
                     "+v"(A3[0]), "+v"(A3[1]), "+v"(A3[2]), "+v"(A3[3]), "+v"(Bn[0][0]), "+v"(Bn[0][1]), "+v"(Bn[0][2]), "+v"(Bn[0][3]), "+v"(Bn[1][0]), "+v"(Bn[1][1]), "+v"(Bn[1][2]), "+v"(Bn[1][3]) :: "memory");
#undef M3_NR
#undef M3_RB
#undef M3_GLD
#undef M3_LOADB
#undef M3_LOADA
#undef M3_ADV
#undef M3_WAITA
#undef M3_WAITB
#undef M3_STEP
        __syncthreads();
        { const int c4 = lane & 7, rs = lane >> 3, col = nc * 32 + 4 * c4;
          const f32x4 gv = *(const f32x4*)(g1 + col), bv = *(const f32x4*)(b1 + col);
#pragma unroll 4
          for (int it = 0; it < 16; ++it) { const int rl = 128 * w + 8 * it + rs; const size_t row = (size_t)tb * 1024 + rl;
              const f32x4 yv = *(const f32x4*)(Y1 + row * D + col); const f32x2 sv = *(const f32x2*)(ST1 + 2 * row);
              f32x4 tv; { const int nt = c4 >> 2, r0 = (4 * c4) & 15;
#pragma unroll
                  for (int j = 0; j < 4; ++j) { const v2u cell = *(const LAS v2u*)(out + rl * 32 + 2 * (r0 + j)); const int lo = (int)cell.x, hi = (int)cell.y + (lo < 0 ? 1 : 0); tv[j] = (float)(nt ? hi : lo) * (1.0f / 4194304.0f); } }
              const f32x4 y = ((yv - sv.x) * sv.y * gv + bv) * ALPHA + tv;
              *(f32x4*)(Y2 + row * D + col) = y;
              float sm = (y[0] + y[1]) + (y[2] + y[3]), sq = (y[0] * y[0] + y[1] * y[1]) + (y[2] * y[2] + y[3] * y[3]);
#pragma unroll
              for (int o = 1; o < 8; o <<= 1) { sm += shfl_x(sm, o, lane); sq += shfl_x(sq, o, lane); }
              if (c4 == 0) *(f32x2*)(PST2 + (row * 64 + nc) * 2) = (f32x2){sm, sq}; } }
    }
}

__device__ __forceinline__ void phase_moe4n(const Frame& F, const float* Y2, const float* pst, const float* gain, const float* bias, float* ST2, bf16* XBo, float* OUT, int last) {
    const int gw = F.bid * 8 + F.wave, NGW = F.G * 8, lane = F.lane;
    for (int t = gw; t < T; t += NGW) {
        f32x4 v[8];
#pragma unroll
        for (int j = 0; j < 8; ++j) v[j] = *(const f32x4*)(Y2 + (size_t)t * D + 4 * lane + 256 * j);
        const f32x2 pv = *(const f32x2*)(pst + ((size_t)t * 64 + lane) * 2);
        const float mean = wave_sum(pv.x, lane) * (1.0f / D); const float var = fmaxf(wave_sum(pv.y, lane) * (1.0f / D) - mean * mean, 0.f); const float rstd = 1.0f / sqrtf(var + LN_EPS);
        if (lane == 0) *(f32x2*)(ST2 + 2 * (size_t)t) = (f32x2){mean, rstd};
#pragma unroll
        for (int j = 0; j < 8; ++j) { const int c = 4 * lane + 256 * j; const f32x4 o = (v[j] - mean) * rstd * *(const f32x4*)(gain + c) + *(const f32x4*)(bias + c);
            if (last) *(f32x4*)(OUT + (size_t)t * D + c) = o;
            else { v2u wb; wb.x = pk2(o[0], o[1]); wb.y = pk2(o[2], o[3]); *(v2u*)(XBo + (size_t)t * D + c) = wb; } }
    }
}


__device__ __forceinline__ void phase_moe4q(const Frame& F, const bf16* X1, bf16* Y2, const unsigned char* Yq, const float* Ysc, const int* eidx, const int* inv, const float* gain, const float* bias, float* ST2, bf16* XBo, float* OUT, int last) {
    const LAS int* tpref = (const LAS int*)(F.lds + LDS_TAB);
    const int gw = F.bid * 8 + F.wave, NGW = F.G * 8, lane = F.lane;
    for (int t = gw; t < T; t += NGW) {
        int rowi = 0; if (lane < 8) { const int e = eidx[t * 8 + lane], ps = inv[t * 8 + lane]; rowi = tpref[e] * 256 + ps; } else if (lane < 10) rowi = tpref[56 + lane] * 256 + t;
        v4u pv[2][2], yv[10][2]; float sc[10][2];
#pragma unroll
        for (int j = 0; j < 2; ++j) { pv[j][0] = *(const v4u*)(X1 + (size_t)t * D + 16 * lane + 1024 * j); pv[j][1] = *(const v4u*)(X1 + (size_t)t * D + 16 * lane + 1024 * j + 8); }
#pragma unroll
        for (int k = 0; k < 10; ++k) { const size_t row = (size_t)__builtin_amdgcn_readlane(rowi, k);
#pragma unroll
            for (int j = 0; j < 2; ++j) { yv[k][j] = *(const v4u*)(Yq + row * D + 16 * lane + 1024 * j); sc[k][j] = Ysc[row * 16 + 8 * j + (lane >> 3)]; } }
#pragma unroll
        for (int k = 0; k < 10; ++k) asm volatile("" : "+v"(yv[k][0]), "+v"(yv[k][1]), "+v"(sc[k][0]), "+v"(sc[k][1]));
        float v[2][16];
#pragma unroll
        for (int j = 0; j < 2; ++j) { float f0[8], f1[8]; unpack8(pv[j][0], f0); unpack8(pv[j][1], f1);
            const float ss = (((sc[0][j] + sc[1][j]) + (sc[2][j] + sc[3][j])) + ((sc[4][j] + sc[5][j]) + (sc[6][j] + sc[7][j]))) + (sc[8][j] + sc[9][j]);
#pragma unroll
            for (int i = 0; i < 8; ++i) { v[j][i] = ALPHA * f0[i] - 128.f * ss; v[j][8 + i] = ALPHA * f1[i] - 128.f * ss; } }
#pragma unroll
        for (int k = 0; k < 10; ++k)
#pragma unroll
            for (int j = 0; j < 2; ++j) { const float s_ = sc[k][j]; const unsigned q[4] = {yv[k][j].x, yv[k][j].y, yv[k][j].z, yv[k][j].w};
#pragma unroll
                for (int d = 0; d < 4; ++d) { v[j][4 * d + 0] += s_ * (float)(q[d] & 0xffu); v[j][4 * d + 1] += s_ * (float)((q[d] >> 8) & 0xffu); v[j][4 * d + 2] += s_ * (float)((q[d] >> 16) & 0xffu); v[j][4 * d + 3] += s_ * (float)(q[d] >> 24); } }
        float sm = 0.f;
#pragma unroll
        for (int j = 0; j < 2; ++j)
#pragma unroll
            for (int i = 0; i < 16; i += 4) sm += (v[j][i] + v[j][i + 1]) + (v[j][i + 2] + v[j][i + 3]);
        const float mean = wave_sum(sm, lane) * (1.0f / D); float sq = 0.f;
#pragma unroll
        for (int j = 0; j < 2; ++j)
#pragma unroll
            for (int i = 0; i < 16; ++i) { const float d = v[j][i] - mean; sq += d * d; }
        const float rstd = 1.0f / sqrtf(wave_sum(sq, lane) * (1.0f / D) + LN_EPS);
        (void)ST2; (void)Y2;
#pragma unroll
        for (int j = 0; j < 2; ++j)
#pragma unroll
            for (int h = 0; h < 2; ++h) { const int c = 16 * lane + 1024 * j + 8 * h; const float* vv = &v[j][8 * h];
                const f32x4 g0 = *(const f32x4*)(gain + c), g1 = *(const f32x4*)(gain + c + 4), b0 = *(const f32x4*)(bias + c), b1 = *(const f32x4*)(bias + c + 4);
                const f32x4 o0 = ((f32x4){vv[0], vv[1], vv[2], vv[3]} - mean) * rstd * g0 + b0, o1 = ((f32x4){vv[4], vv[5], vv[6], vv[7]} - mean) * rstd * g1 + b1;
                if (last) { *(f32x4*)(OUT + (size_t)t * D + c) = o0; *(f32x4*)(OUT + (size_t)t * D + c + 4) = o1; }
                else { v4u wb; wb.x = pk2(o0[0], o0[1]); wb.y = pk2(o0[2], o0[3]); wb.z = pk2(o1[0], o1[1]); wb.w = pk2(o1[2], o1[3]); *(v4u*)(XBo + (size_t)t * D + c) = wb; } }
    }
}

__device__ __forceinline__ void phase_downproj3(const Frame& F, const bf16* H, const bf16* WD, const bf16* HSp, const bf16* WSD, unsigned char* Yq, float* Ysc, int NT) {
    const LAS int* tpref = (const LAS int*)(F.lds + LDS_TAB); const LAS int* cl = (const LAS int*)(F.lds + LDS_TAB + 512);
    LAS unsigned char* lds = F.lds;
    const int tid = F.tid, lane = F.lane, w = F.wave, fr = lane & 15, fq = lane >> 4;
    unsigned rbB[2], cbB[2];
#pragma unroll
    for (int i = 0; i < 2; ++i) { int R_, C_; g8::stage_rc(tid * 16 + i * 8192, R_, C_); rbB[i] = (unsigned)((R_ & ~31) + g8::perm32(R_ & 31)); cbB[i] = (unsigned)C_ * 2u; }
    const unsigned ldsw = (unsigned)w * 1024u, lbase = (unsigned)(size_t)lds;
    int boffg[4];
#pragma unroll
    for (int g = 0; g < 4; ++g) boffg[g] = g8::lds_byte(32 * g + fr, fq * 8);
    LAS unsigned char* stg = lds + 65536 + w * (32 * 144);
    const int NU = NT * 4;
    const int upos = (F.G % 8) == 0 ? (F.bid & 7) * (F.G >> 3) + (F.bid >> 3) : F.bid;
    int ub = 0;
    int u = (F.G <= NU) ? upos : F.bid; if (u >= NU) return;
#define DP3_UNITINFO(uu, E0, EXP, NV) do { const int tl_ = (uu) >> 2; int e_ = (E0); while (__builtin_amdgcn_readfirstlane(tpref[e_ + 1]) <= tl_) ++e_; EXP = e_; \
        NV = __builtin_amdgcn_readfirstlane(cl[e_]) - (tl_ - __builtin_amdgcn_readfirstlane(tpref[e_])) * 256; } while (0)
#define DP3_GLDS(gsrc, ldsdst) do { unsigned keep_; asm volatile("s_mov_b32 %0, m0\n\ts_mov_b32 m0, %2\n\ts_nop 0\n\tglobal_load_lds_dwordx4 %1, off\n\ts_mov_b32 m0, %0" : "=&s"(keep_) : "v"(gsrc), "s"(ldsdst) : "memory"); } while (0)
#define DP3_STAGE(slot, gb, bs) do { const unsigned v0_ = rbB[0] * (unsigned)(bs) + cbB[0], v1_ = rbB[1] * (unsigned)(bs) + cbB[1]; _Pragma("unroll") for (int kt = 0; kt < 2; ++kt) { \
        DP3_GLDS((const void*)((gb) + kt * 128 + v0_), lbase + (unsigned)((slot) * 32768 + kt * 16384) + ldsw); \
        DP3_GLDS((const void*)((gb) + kt * 128 + v1_), lbase + (unsigned)((slot) * 32768 + kt * 16384) + ldsw + 8192u); } } while (0)
#define DP3_SRC(uu, ee, AB, AS, BB, BS) do { const int tl_ = (uu) >> 2, cu_ = ((uu) & 3) * 512; \
        if ((ee) < 64) { AB = (const char*)(H + (size_t)tl_ * 256 * EDIM); AS = EDIM * 2; BB = (const char*)(WD + (size_t)(ee) * D * EDIM + (size_t)cu_ * EDIM); BS = EDIM * 2; } \
        else { const int t0_ = (tl_ - __builtin_amdgcn_readfirstlane(tpref[ee])) * 256; AB = (const char*)(HSp + (size_t)t0_ * SDIM + ((ee) - 64) * EDIM); AS = SDIM * 2; \
               BB = (const char*)(WSD + (size_t)cu_ * SDIM + ((ee) - 64) * EDIM); BS = SDIM * 2; } } while (0)
    int ecur, nvcur; DP3_UNITINFO(u, 0, ecur, nvcur);
    const char* abc; const char* gbc; int asc, bsc; DP3_SRC(u, ecur, abc, asc, gbc, bsc);
    bf16x8 A[2][4], An[2][4];
    { const char* ap_ = abc + (size_t)(32 * w + fr) * asc + 16 * fq;
#pragma unroll
      for (int m = 0; m < 2; ++m)
#pragma unroll
          for (int kk = 0; kk < 4; ++kk) A[m][kk] = *(const bf16x8*)(ap_ + (size_t)m * 16 * asc + 64 * kk); }
    DP3_STAGE(0, gbc, bsc);
    asm volatile("s_waitcnt vmcnt(0)" ::: "memory");
#pragma unroll 1
    for (;;) {
        int un = u; { const int nb = ub + F.G; if (nb + F.G <= NU) un = nb + upos; else if (nb + F.bid < NU) un = nb + F.bid; if (un != u) ub = nb; }
        int enx, nvnx; DP3_UNITINFO(un, (un > u ? ecur : 0), enx, nvnx);
        const char* abn; const char* gbn; int asn, bsn; DP3_SRC(un, enx, abn, asn, gbn, bsn);
        const int tile = u >> 2, colu = (u & 3) * 512;
        float scq[2][4];
#pragma unroll
        for (int c = 0; c < 4; ++c) {
            if (c == 0) asm volatile("s_waitcnt vmcnt(5)" ::: "memory"); else asm volatile("s_waitcnt vmcnt(4)" ::: "memory");
            __builtin_amdgcn_s_barrier();
            if (c == 3) { const char* ap_ = abn + (size_t)(32 * w + fr) * asn + 16 * fq;
#pragma unroll
                for (int m = 0; m < 2; ++m) { const char* am_ = ap_ + (size_t)m * 16 * asn;
                    asm volatile("global_load_dwordx4 %0, %1, off" : "=&v"(An[m][0]) : "v"(am_) : "memory"); asm volatile("global_load_dwordx4 %0, %1, off offset:64" : "=&v"(An[m][1]) : "v"(am_) : "memory");
                    asm volatile("global_load_dwordx4 %0, %1, off offset:128" : "=&v"(An[m][2]) : "v"(am_) : "memory"); asm volatile("global_load_dwordx4 %0, %1, off offset:192" : "=&v"(An[m][3]) : "v"(am_) : "memory"); } }
            { const char* gnext = (c < 3) ? gbc + (size_t)(c + 1) * 128 * bsc : gbn; const int bnext = (c < 3) ? bsc : bsn; DP3_STAGE((c + 1) & 1, gnext, bnext); }
            __builtin_amdgcn_sched_barrier(0);
            f32x4 acc[2][4][2];
#pragma unroll
            for (int g = 0; g < 4; ++g) { bf16x8 Bf[2][4];
#pragma unroll
                for (int n = 0; n < 2; ++n)
#pragma unroll
                    for (int kk = 0; kk < 4; ++kk) Bf[n][kk] = *(const LAS bf16x8*)(lds + (c & 1) * 32768 + (kk >> 1) * 16384 + boffg[g] + n * 2048 + (kk & 1) * 1024);
#pragma unroll
                for (int m = 0; m < 2; ++m)
#pragma unroll
                    for (int n = 0; n < 2; ++n) { acc[m][g][n] = (f32x4){0.f, 0.f, 0.f, 0.f};
#pragma unroll
                        for (int kk = 0; kk < 4; ++kk) acc[m][g][n] = __builtin_amdgcn_mfma_f32_16x16x32_bf16(Bf[n][kk], A[m][kk], acc[m][g][n], 0, 0, 0); } }
#pragma unroll
            for (int m = 0; m < 2; ++m) {
                float am0 = 0.f, am1 = 0.f;
#pragma unroll
                for (int g = 0; g < 4; ++g)
#pragma unroll
                    for (int n = 0; n < 2; ++n) { am0 = fmaxf(fmaxf(am0, fabsf(acc[m][g][n][0])), fabsf(acc[m][g][n][1])); am1 = fmaxf(fmaxf(am1, fabsf(acc[m][g][n][2])), fabsf(acc[m][g][n][3])); }
                float am = fmaxf(am0, am1);
                am = fmaxf(am, shfl_x(am, 16, lane)); am = fmaxf(am, shfl_x(am, 32, lane));
                am = fminf(am, 3.0e38f);
                const float isc = am > 0.f ? 127.0f * __builtin_amdgcn_rcpf(am) : 0.f;
                scq[m][c] = am * (1.0f / 127.0f);
                const f32x2_t isc2 = (f32x2_t){isc, isc}, mg2 = (f32x2_t){8388736.0f, 8388736.0f};
#pragma unroll
                for (int g = 0; g < 4; ++g) { unsigned qd[2];
#pragma unroll
                    for (int n = 0; n < 2; ++n) {
                        const f32x2_t tl = __builtin_elementwise_fma((f32x2_t){acc[m][g][n][0], acc[m][g][n][1]}, isc2, mg2), th = __builtin_elementwise_fma((f32x2_t){acc[m][g][n][2], acc[m][g][n][3]}, isc2, mg2);
                        const float f0_ = tl.x, f1_ = tl.y, f2_ = th.x, f3_ = th.y;
                        qd[n] = __builtin_amdgcn_perm(__builtin_bit_cast(unsigned, f1_), __builtin_bit_cast(unsigned, f0_), 0x0c0c0400u) | __builtin_amdgcn_perm(__builtin_bit_cast(unsigned, f3_), __builtin_bit_cast(unsigned, f2_), 0x04000c0cu); }
                    *(LAS v2u*)(stg + (16 * m + fr) * 144 + 32 * g + 8 * fq) = (v2u){qd[0], qd[1]}; } }
#pragma unroll
            for (int it = 0; it < 4; ++it) { const int rr = 8 * it + (lane >> 3);
                const v4u o = *(const LAS v4u*)(stg + rr * 144 + (lane & 7) * 16);
                *(v4u*)(Yq + (size_t)(tile * 256 + 32 * w + rr) * D + colu + 128 * c + 16 * (lane & 7)) = o; }
            if (c == 3) { const f32x4 so = fq == 0 ? (f32x4){scq[0][0], scq[0][1], scq[0][2], scq[0][3]} : (f32x4){scq[1][0], scq[1][1], scq[1][2], scq[1][3]};
                if (fq < 2) *(f32x4*)(Ysc + (size_t)(tile * 256 + 32 * w + 16 * fq + fr) * 16 + (colu >> 7)) = so; }
            __builtin_amdgcn_sched_barrier(0);
        }
        asm volatile("s_waitcnt vmcnt(9)" : "+v"(An[0][0]), "+v"(An[0][1]), "+v"(An[0][2]), "+v"(An[0][3]), "+v"(An[1][0]), "+v"(An[1][1]), "+v"(An[1][2]), "+v"(An[1][3]) :: "memory");
        if (un == u) break;
#pragma unroll
        for (int m = 0; m < 2; ++m)
#pragma unroll
            for (int kk = 0; kk < 4; ++kk) A[m][kk] = An[m][kk];
        u = un; ecur = enx; nvcur = nvnx; abc = abn; asc = asn; gbc = gbn; bsc = bsn;
    }
    asm volatile("s_waitcnt vmcnt(0)" ::: "memory");
#undef DP3_UNITINFO
#undef DP3_STAGE
#undef DP3_GLDS
#undef DP3_SRC
}

enum { PH_PRO = 0, PH_POOL_G1, PH_POOL_P, PH_POOL_G2, PH_POOL_G3, PH_DIL_G1, PH_DIL_ATT, PH_DIL_CMB, PH_DIL_G2, PH_CONV_G1, PH_CONV_E, PH_CONV_G2, PH_MOE1, PH_MOE2, PH_MOE3, PH_MOE4, PH_COUNT };

template <int PH>
__device__ __forceinline__ void run_phase(const Frame& Fin, const Args& args_, const int L) {
    Frame F = Fin; { int w_ = Fin.wave, l_; asm volatile("" : "+s"(w_)); asm volatile("v_mbcnt_lo_u32_b32 %0, -1, 0\n\tv_mbcnt_hi_u32_b32 %0, -1, %0" : "=v"(l_)); F.wave = w_; F.lane = l_; F.tid = w_ * 64 + l_; }
    unsigned char* ws; { GAS unsigned char* wsg = (GAS unsigned char*)Fin.ws; asm volatile("" : "+s"(wsg)); ws = (unsigned char*)wsg; } F.ws = ws; F.ctl = (unsigned*)(ws + WS_CTL);
    KP kp = (KP)__builtin_amdgcn_kernarg_segment_ptr(); asm volatile("" : "+s"(kp)); (void)args_;
    { unsigned l_ = (unsigned)(size_t)Fin.lds; asm volatile("" : "+s"(l_)); F.lds = (LAS unsigned char*)(size_t)l_; }
    LAS unsigned char* ring = F.lds; int c = (int)blockIdx.x; { int g_ = Fin.G; asm volatile("" : "+s"(c), "+s"(g_)); F.G = g_; F.bid = c; }
    const float* xres = ain(kp, IN_X);
    const float* st2 = (const float*)(ws + WS_ST2); float* pstp = (float*)(ws + WS_PST);
    const float* g2p = ain(kp, IN_LNG) + (size_t)((L > 0 ? L - 1 : 0) * 2 + 1) * D; const float* b2p = ain(kp, IN_LNB) + (size_t)((L > 0 ? L - 1 : 0) * 2 + 1) * D;
    const bf16* xb = (const bf16*)(ws + WS_XB);
    bf16* yf = (bf16*)(ws + WS_YF);
    unsigned char* big = ws + WS_BIG;
    const int ia = L / 3;
    if constexpr (PH == PH_PRO) { phase_prologue(F, kp); }
    if constexpr (PH == PH_POOL_G1) { g8::DenseSched S; S.init(xb, (const bf16*)(ws + WS_W_POOL_IN) + (size_t)ia * D * D, T, D, D, D, F.G, c);
        g8::EpiBf16 E{(bf16*)(big + BG_U), D, 0}; g8::gemm_phase<g8::EpiBf16, g8::DenseSched, false>(ring, F.tid, D, D, D, S, E); }
    if constexpr (PH == PH_POOL_P) { phase_pool(F, (const bf16*)(big + BG_U), (bf16*)(big + BG_PL)); }
    if constexpr (PH == PH_POOL_G2) { g8::DenseSched S; S.init((const bf16*)(big + BG_PL), (const bf16*)(ws + WS_W_POOL_G) + (size_t)ia * D * 512, T, D, D, 512, F.G, c); S.agrp_shift = 1; S.agrp_stride = 512 * 2;
        g8::EpiScaleBf16 E{(bf16*)(big + BG_MX), D, ain(kp, IN_PSC) + (size_t)ia * D}; g8::gemm_phase<g8::EpiScaleBf16, g8::DenseSched, false>(ring, F.tid, 512, D, 512, S, E); }
    if constexpr (PH == PH_POOL_G3) { g8::DenseSched S; S.init((const bf16*)(big + BG_MX), (const bf16*)(ws + WS_W_POOL_OUT) + (size_t)ia * D * D, T, D, D, D, F.G, c);
        g8::EpiResidLN E{xres, xb, st2, g2p, b2p, yf, pstp, L > 0 ? 2 : 0}; g8::gemm_phase<g8::EpiResidLN, g8::DenseSched, false>(ring, F.tid, D, D, D, S, E); }
    if constexpr (PH == PH_DIL_G1) { g8::DenseSched S; S.init(xb, (const bf16*)(ws + WS_W_DIL_QKV), T, QKVC, D, D, F.G, c);
        g8::EpiBf16 E{(bf16*)(big + BG_QKV), QKVC, 1}; g8::gemm_phase<g8::EpiBf16, g8::DenseSched, false>(ring, F.tid, D, D, D, S, E); }
    if constexpr (PH == PH_DIL_ATT) { phase_attn(F, (const bf16*)(big + BG_QKV), ain(kp, IN_RELB), (bf16*)(big + BG_OG), (float*)(big + BG_LSE)); }
    if constexpr (PH == PH_DIL_CMB) { phase_combine(F, (const bf16*)(big + BG_OG), (const float*)(big + BG_LSE), (bf16*)(big + BG_O)); }
    if constexpr (PH == PH_DIL_G2) { g8::DenseSched S; S.init((const bf16*)(big + BG_O), (const bf16*)(ws + WS_W_DIL_OUT), T, D, DILW, DILW, F.G, c);
        g8::EpiResidLN E{xres, xb, st2, g2p, b2p, yf, pstp, L > 0 ? 2 : 0}; g8::gemm_phase<g8::EpiResidLN, g8::DenseSched, false>(ring, F.tid, DILW, DILW, DILW, S, E); }
    if constexpr (PH == PH_CONV_G1) { g8::DenseSched S; S.init(xb, (const bf16*)(ws + WS_W_CONV_IN), T, 3 * D, D, D, F.G, c);
        g8::EpiConvIn E{(bf16*)(big + BG_UC), (bf16*)(big + BG_BG)}; g8::gemm_phase<g8::EpiConvIn, g8::DenseSched, false>(ring, F.tid, D, D, D, S, E); }
    if constexpr (PH == PH_CONV_E) { phase_conv(F, (const bf16*)(big + BG_UC), (const bf16*)(big + BG_BG), ain(kp, IN_CW), (bf16*)(big + BG_Z)); }
    if constexpr (PH == PH_CONV_G2) { g8::DenseSched S; S.init((const bf16*)(big + BG_Z), (const bf16*)(ws + WS_W_CONV_OUT), T, D, D, D, F.G, c);
        g8::EpiResidLN E{xres, xb, st2, g2p, b2p, yf, pstp, L > 0 ? 2 : 0}; g8::gemm_phase<g8::EpiResidLN, g8::DenseSched, false>(ring, F.tid, D, D, D, S, E); }
    unsigned* cnt = F.ctl + CW_CNT + L * 64 * 16;
    float* x1f = (float*)(ws + WS_X1F); bf16* x1b = (bf16*)(ws + WS_X1B);
    int* ltok = (int*)(ws + WS_LTOK); float* lgate = (float*)(ws + WS_LGATE); int* eidx = (int*)(ws + WS_EIDX); int* inv = (int*)(ws + WS_INV);
    bf16* HB = (bf16*)(ws + WS_HB); bf16* HS = (bf16*)(ws + WS_HS); bf16* Yr = (bf16*)(ws + WS_BIG);
    if constexpr (PH == PH_MOE1) {
        const float* g1 = ain(kp, IN_LNG) + (size_t)(L * 2 + 0) * D; const float* b1 = ain(kp, IN_LNB) + (size_t)(L * 2 + 0) * D;
        phase_moe1n(F, yf, pstp, g1, b1, (const bf16*)(ws + WS_RWH) + (size_t)L * NEXP * D, (const bf16*)(ws + WS_RWL) + (size_t)L * NEXP * D, ain(kp, IN_RB) + (size_t)L * NEXP,
                    x1b, (float*)(ws + WS_ST1), cnt, ltok, lgate, eidx, inv); }
    if constexpr (PH == PH_MOE2) {
        const int NT = build_tiles(F, cnt);
        { g8::ExpertSched<1, true> S; S.tpref = (const LAS int*)(F.lds + LDS_TAB); S.cnt = (const LAS int*)(F.lds + LDS_TAB + 512); S.A = (const char*)x1b; S.B = (const char*)((const bf16*)(ws + WS_W_EX_GU) + (size_t)L * 64 * 256 * D);
          S.tok = ltok; S.b_exp = (size_t)256 * D * 2; S.b_tile = 0; S.a_tile = 0; S.NU = NT; S.G = F.G; S.c = c;
          g8::EpiExpertGU E{HB}; g8::gemm_phase<g8::EpiExpertGU, g8::ExpertSched<1, true>, true>(ring, F.tid, D, D, D, S, E); }
        { const int rot = (c - (NT % F.G) + F.G) % F.G;
          g8::DenseSched S; S.init(x1b, (const bf16*)(ws + WS_W_SH_GU) + (size_t)L * 512 * D, T, 512, D, D, F.G, rot);
          int t2 = F.tid; asm volatile("" : "+v"(t2));
          g8::EpiSharedGU E{HS}; g8::gemm_phase<g8::EpiSharedGU, g8::DenseSched, false>(ring, t2, D, D, D, S, E); } }
    if constexpr (PH == PH_MOE3) {
        const float* g1 = ain(kp, IN_LNG) + (size_t)(L * 2 + 0) * D; const float* b1 = ain(kp, IN_LNB) + (size_t)(L * 2 + 0) * D;
        const int NT = build_tiles(F, cnt);
        __syncthreads();
        phase_downproj3(F, HB, (const bf16*)(ws + WS_W_EX_D) + (size_t)L * 64 * D * EDIM, HS, (const bf16*)(ws + WS_W_SH_D) + (size_t)L * D * SDIM, (unsigned char*)Yr, (float*)(ws + WS_BIG + BG_YSC), NT + 2 * (T / 256));
        (void)g1; (void)b1; }
    if constexpr (PH == PH_MOE4) { (void)build_tiles(F, cnt);
        const float* g2 = ain(kp, IN_LNG) + (size_t)(L * 2 + 1) * D; const float* b2 = ain(kp, IN_LNB) + (size_t)(L * 2 + 1) * D;
        phase_moe4q(F, x1b, (bf16*)(ws + WS_Y2F), (const unsigned char*)Yr, (const float*)(ws + WS_BIG + BG_YSC), eidx, inv, g2, b2, (float*)(ws + WS_ST2), (bf16*)(ws + WS_XB), aout(kp), L == DEPTH - 1); }
}
__device__ __forceinline__ void make_frame(Frame& F, const Args& args) {
    extern __shared__ __attribute__((aligned(16))) unsigned char lds_raw[];
    F.lds = (LAS unsigned char*)lds_raw; F.ws = args.ws; F.ctl = (unsigned*)(args.ws + WS_CTL);
    F.tid = threadIdx.x; F.lane = F.tid & 63; F.wave = __builtin_amdgcn_readfirstlane(F.tid >> 6); F.G = gridDim.x; F.bid = blockIdx.x;
}
template <int PH> __global__ void __launch_bounds__(512, 2) k_phase(Args args, int L) {
    Frame F; make_frame(F, args);
    run_phase<PH>(F, args, L);
}

#ifndef MK_NOINLINE
#define MK_NOINLINE 0
#endif
#if MK_NOINLINE
template <int PH> __device__ __noinline__ void call_phase_ni(const int L) {
    Args dummy{}; Frame F;
    KP kp = (KP)__builtin_amdgcn_kernarg_segment_ptr();
    extern __shared__ __attribute__((aligned(16))) unsigned char lds_raw[];
    F.lds = (LAS unsigned char*)lds_raw; F.ws = (unsigned char*)((GAS unsigned char* const CAS*)kp)[20]; F.ctl = (unsigned*)(F.ws + WS_CTL);
    F.tid = threadIdx.x; F.lane = F.tid & 63; F.wave = __builtin_amdgcn_readfirstlane(F.tid >> 6); F.G = gridDim.x; F.bid = blockIdx.x;
    run_phase<PH>(F, dummy, L);
}
template <int PH> __device__ __forceinline__ void call_phase(const Frame& F, const Args& args, const int L) { call_phase_ni<PH>(L); }
#else
template <int PH> __device__ __forceinline__ void call_phase(const Frame& F, const Args& args, const int L) { asm volatile("; PHASE_BEGIN %0" :: "n"(PH)); run_phase<PH>(F, args, L); asm volatile("; PHASE_END %0" :: "n"(PH)); }
#endif
__global__ void __launch_bounds__(512, 2) fwd_all(Args args) {
    Frame F; make_frame(F, args);
    volatile LAS unsigned* misc = (volatile LAS unsigned*)(F.lds + LDS_MISC);
    if (F.tid < 4) misc[F.tid] = 0u;
    __syncthreads();
    const int lo = args.ph_lo, hi = args.ph_hi;
    XcdBarrier bar; bar.bar = F.ctl + CW_BAR; bar.x = 0; bar.st = misc;
    if (hi - lo > 1) bar = xcd_barrier_post(F.ctl + CW_BAR, misc);
    int pc = 0;
#ifndef MK_DUP_MASK
#define MK_DUP_MASK 0
#endif
#if MK_DUP_MASK
#define STEP(PH, Lx) do { if (pc >= lo && pc < hi) { int nrep_ = ((MK_DUP_MASK >> (PH)) & 1) ? 2 : 1; asm volatile("" : "+s"(nrep_)); _Pragma("unroll 1") for (int r_ = 0; r_ < nrep_; ++r_) { call_phase<PH>(F, args, Lx); if (r_ + 1 < nrep_ || pc + 1 < hi) xcd_barrier(bar); } } ++pc; } while (0)
#else
#define STEP(PH, Lx) do { if (pc >= lo && pc < hi) { call_phase<PH>(F, args, Lx); if (pc + 1 < hi) xcd_barrier(bar); } ++pc; } while (0)
#endif
    STEP(PH_PRO, 0);
#pragma unroll 1
    for (int L = 0; L < DEPTH; ++L) {
        const int kind = L % 3;
        if (kind == 0) { STEP(PH_POOL_G1, L); STEP(PH_POOL_P, L); STEP(PH_POOL_G2, L); STEP(PH_POOL_G3, L); }
        else if (kind == 1) { STEP(PH_DIL_G1, L); STEP(PH_DIL_ATT, L); STEP(PH_DIL_CMB, L); STEP(PH_DIL_G2, L); }
        else { STEP(PH_CONV_G1, L); STEP(PH_CONV_E, L); STEP(PH_CONV_G2, L); }
        STEP(PH_MOE1, L); STEP(PH_MOE2, L); STEP(PH_MOE3, L); STEP(PH_MOE4, L);
    }
#undef STEP
}
constexpr int N_STEPS = 1 + 2 * 8 + 8 + 7;

template <int PH> static void launch_phase(const Args& a, int L, int grid, hipStream_t stream) {
    static bool attr = false;
    if (!attr) { (void)hipFuncSetAttribute((const void*)k_phase<PH>, hipFuncAttributeMaxDynamicSharedMemorySize, LDS_BYTES); attr = true; }
    hipLaunchKernelGGL(k_phase<PH>, dim3(grid), dim3(512), LDS_BYTES, stream, a, L);
}
extern "C" void kernel_launch(void* const* d_in, const int* in_sizes, int n_in, void* d_out, int out_size, void* d_ws, size_t ws_size, hipStream_t stream) {
    static int grid = 0;
    if (grid == 0) {
        if (n_in != 19 || out_size != T * D || ws_size < WS_END) { fprintf(stderr, "kernel_launch: unexpected shapes (n_in %d out %d ws %zu need %zu)\n", n_in, out_size, ws_size, (size_t)WS_END); grid = -1; return; }
        int dev = 0, cus = 0;
        if (hipGetDevice(&dev) != hipSuccess || hipDeviceGetAttribute(&cus, hipDeviceAttributeMultiprocessorCount, dev) != hipSuccess) { grid = -1; return; }
#if MK_ONE_LAUNCH
        if (hipFuncSetAttribute((const void*)fwd_all, hipFuncAttributeMaxDynamicSharedMemorySize, LDS_BYTES) != hipSuccess) { fprintf(stderr, "kernel_launch: hipFuncSetAttribute failed\n"); grid = -1; return; }
        int per_cu = 0;
        if (hipOccupancyMaxActiveBlocksPerMultiprocessor(&per_cu, (const void*)fwd_all, 512, LDS_BYTES) != hipSuccess || per_cu < 1) { fprintf(stderr, "kernel_launch: note: occupancy query reports %d blocks per CU\n", per_cu); (void)hipGetLastError(); }
#endif
        grid = cus;
    }
    if (grid < 0) return;
    (void)hipMemsetAsync((char*)d_ws + WS_CTL, 0, CTL_ZERO_BYTES, stream);
    Args a{};
    for (int i = 0; i < 19; ++i) a.in[i] = (const float*)d_in[i];
    a.out = (float*)d_out; a.ws = (unsigned char*)d_ws; a.ph_lo = 0; a.ph_hi = 0;
#if MK_ONE_LAUNCH
#ifdef MK_SPLIT
    for (int p = 0; p < N_STEPS; ++p) { a.ph_lo = p; a.ph_hi = p + 1; hipLaunchKernelGGL(fwd_all, dim3(grid), dim3(512), LDS_BYTES, stream, a); }
#else
    a.ph_lo = 0; a.ph_hi = N_STEPS;
    hipLaunchKernelGGL(fwd_all, dim3(grid), dim3(512), LDS_BYTES, stream, a);
#endif
#elif defined(MK_HYBRID_MASK)
    {
        static bool attr2 = false; if (!attr2) { (void)hipFuncSetAttribute((const void*)fwd_all, hipFuncAttributeMaxDynamicSharedMemorySize, LDS_BYTES); attr2 = true; }
        int pc = 0;
#define HSTEP(PH, Lx) do { if ((MK_HYBRID_MASK >> (PH)) & 1) { a.ph_lo = pc; a.ph_hi = pc + 1; hipLaunchKernelGGL(fwd_all, dim3(grid), dim3(512), LDS_BYTES, stream, a); } else { a.ph_lo = 0; a.ph_hi = 0; launch_phase<PH>(a, Lx, grid, stream); } ++pc; } while (0)
        HSTEP(PH_PRO, 0);
        for (int L = 0; L < DEPTH; ++L) {
            const int kind = L % 3;
            if (kind == 0) { HSTEP(PH_POOL_G1, L); HSTEP(PH_POOL_P, L); HSTEP(PH_POOL_G2, L); HSTEP(PH_POOL_G3, L); }
            else if (kind == 1) { HSTEP(PH_DIL_G1, L); HSTEP(PH_DIL_ATT, L); HSTEP(PH_DIL_CMB, L); HSTEP(PH_DIL_G2, L); }
            else { HSTEP(PH_CONV_G1, L); HSTEP(PH_CONV_E, L); HSTEP(PH_CONV_G2, L); }
            HSTEP(PH_MOE1, L); HSTEP(PH_MOE2, L); HSTEP(PH_MOE3, L); HSTEP(PH_MOE4, L);
        }
#undef HSTEP
    }
#else
    launch_phase<PH_PRO>(a, 0, grid, stream);
    for (int L = 0; L < DEPTH; ++L) {
        const int kind = L % 3;
        if (kind == 0) { launch_phase<PH_POOL_G1>(a, L, grid, stream); launch_phase<PH_POOL_P>(a, L, grid, stream); launch_phase<PH_POOL_G2>(a, L, grid, stream); launch_phase<PH_POOL_G3>(a, L, grid, stream); }
        else if (kind == 1) { launch_phase<PH_DIL_G1>(a, L, grid, stream); launch_phase<PH_DIL_ATT>(a, L, grid, stream); launch_phase<PH_DIL_CMB>(a, L, grid, stream); launch_phase<PH_DIL_G2>(a, L, grid, stream); }
        else { launch_phase<PH_CONV_G1>(a, L, grid, stream); launch_phase<PH_CONV_E>(a, L, grid, stream); launch_phase<PH_CONV_G2>(a, L, grid, stream); }
        launch_phase<PH_MOE1>(a, L, grid, stream); launch_phase<PH_MOE2>(a, L, grid, stream); launch_phase<PH_MOE3>(a, L, grid, stream); launch_phase<PH_MOE4>(a, L, grid, stream);
    }
#endif
}
```

```cpp
#include <hip/hip_runtime.h>
#include <cstdio>
#include <cstdint>

#ifndef MK_ONE_LAUNCH
#define MK_ONE_LAUNCH 1
#endif

#define GAS __attribute__((address_space(1)))
#define LAS __attribute__((address_space(3)))
typedef unsigned short bf16;
typedef unsigned v4u __attribute__((ext_vector_type(4)));
typedef unsigned v2u __attribute__((ext_vector_type(2)));
typedef float f32x4 __attribute__((ext_vector_type(4)));
typedef float f32x2 __attribute__((ext_vector_type(2)));
typedef short bf16x8 __attribute__((ext_vector_type(8)));
typedef short s16x4 __attribute__((ext_vector_type(4)));

constexpr int NBATCH = 8, SEQ = 2048, D = 2048, T = NBATCH * SEQ, DEPTH = 4;
constexpr int NEXP = 64, TOPK = 8, EDIM = 128, SDIM = 256;
constexpr int QKVC = 4608, DILW = 512;
constexpr float ALPHA = 1.681792830507429f;
constexpr float LN_EPS = 1e-5f;
constexpr int CAP = 16384;
constexpr int HROWS = T * TOPK + NEXP * 256;

constexpr size_t MiB = 1u << 20;
constexpr size_t WS_CTL = 0, CTL_ZERO_BYTES = 1 * MiB;
constexpr size_t WS_W_POOL_IN = 1 * MiB;
constexpr size_t WS_W_POOL_G = WS_W_POOL_IN + 16 * MiB;
constexpr size_t WS_W_POOL_OUT = WS_W_POOL_G + 4 * MiB;
constexpr size_t WS_W_DIL_QKV = WS_W_POOL_OUT + 16 * MiB;
constexpr size_t WS_W_DIL_OUT = WS_W_DIL_QKV + 18 * MiB;
constexpr size_t WS_W_CONV_IN = WS_W_DIL_OUT + 2 * MiB;
constexpr size_t WS_W_CONV_OUT = WS_W_CONV_IN + 24 * MiB;
constexpr size_t WS_W_SH_GU = WS_W_CONV_OUT + 8 * MiB;
constexpr size_t WS_W_SH_D = WS_W_SH_GU + 8 * MiB;
constexpr size_t WS_W_EX_GU = WS_W_SH_D + 4 * MiB;
constexpr size_t WS_W_EX_D = WS_W_EX_GU + 256 * MiB;
constexpr size_t WS_XF = WS_W_EX_D + 256 * MiB;
constexpr size_t WS_YF = WS_XF + 128 * MiB;
constexpr size_t WS_X1F = WS_YF + 128 * MiB;
constexpr size_t WS_XB = WS_X1F + 128 * MiB;
constexpr size_t WS_X1B = WS_XB + 64 * MiB;
constexpr size_t WS_HB = WS_X1B + 64 * MiB;
constexpr size_t WS_HS = WS_HB + 72 * MiB;
constexpr size_t WS_LTOK = WS_HS + 8 * MiB;
constexpr size_t WS_LGATE = WS_LTOK + 4 * MiB;
constexpr size_t WS_EIDX = WS_LGATE + 4 * MiB;
constexpr size_t WS_INV = WS_EIDX + 1 * MiB;
constexpr size_t WS_BIG = WS_INV + 1 * MiB;
constexpr size_t WS_PST = WS_BIG + 608 * MiB;
constexpr size_t WS_ST1 = WS_PST + 4 * MiB;
constexpr size_t WS_ST2 = WS_ST1 + 1 * MiB;
constexpr size_t WS_RWH = WS_ST2 + 1 * MiB;
constexpr size_t WS_RWL = WS_RWH + 1 * MiB;
constexpr size_t WS_PST2 = WS_RWL + 1 * MiB;
constexpr size_t WS_END = WS_PST2 + 8 * MiB;
constexpr size_t WS_Y2F = WS_X1F;
constexpr size_t BG_U = 0, BG_PL = 64 * MiB, BG_MX = 128 * MiB;
constexpr size_t BG_QKV = 0, BG_OG = 144 * MiB, BG_LSE = 192 * MiB, BG_O = 194 * MiB;
constexpr size_t BG_UC = 0, BG_BG = 64 * MiB, BG_Z = 128 * MiB;
constexpr size_t BG_YSC = 400 * MiB;
constexpr int CW_BAR = 4096;
constexpr int CW_CNT = 16384;

constexpr int RING_BYTES = 131072;
constexpr int LDS_TAB = RING_BYTES;
constexpr int LDS_STASH = RING_BYTES + 1024;
constexpr int LDS_BYTES = 163840;
constexpr int LDS_MISC = LDS_BYTES - 1024;

typedef __bf16 bf16x2_t __attribute__((ext_vector_type(2)));
typedef float f32x2_t __attribute__((ext_vector_type(2)));
__device__ __forceinline__ unsigned cvt_pk_bf16(float lo, float hi) { const bf16x2_t r = __builtin_convertvector((f32x2_t){lo, hi}, bf16x2_t); return __builtin_bit_cast(unsigned, r); }
__device__ __forceinline__ unsigned f2bf(float f) { unsigned u = __builtin_bit_cast(unsigned, f); return (u + 0x7fffu + ((u >> 16) & 1u)) >> 16; }
__device__ __forceinline__ unsigned pk2(float lo, float hi) { return f2bf(lo) | (f2bf(hi) << 16); }
__device__ __forceinline__ float bflo(unsigned w) { return __builtin_bit_cast(float, w << 16); }
__device__ __forceinline__ float bfhi(unsigned w) { return __builtin_bit_cast(float, w & 0xffff0000u); }
__device__ __forceinline__ float shfl_from(float v, int src) { return __builtin_bit_cast(float, __builtin_amdgcn_ds_bpermute(src << 2, __builtin_bit_cast(int, v))); }
__device__ __forceinline__ float shfl_x(float v, int o, int lane) { return shfl_from(v, lane ^ o); }
__device__ __forceinline__ float wave_sum(float v, int lane) {
#pragma unroll
    for (int o = 1; o < 64; o <<= 1) v += shfl_x(v, o, lane);
    return v;
}
#define LDS_WAIT() asm volatile("s_waitcnt lgkmcnt(0)" ::: "memory")
#define VM_WAIT() asm volatile("s_waitcnt vmcnt(0)" ::: "memory")

#define XB_TMO      128
#define XB_XCNT(j)  (256  + 64 * (j))
#define XB_XSUB(j)  (1280 + 64 * (j))
#define XB_XGEN(j)  (2304 + 64 * (j))
#define XB_TOP      3328
#define XB_TOPGEN   3392
#define XCD_BAR_WORDS 3456
#define XB_SPIN_CAP (1u << 18)

__device__ __forceinline__ unsigned xb_ld(unsigned* p)              { return __hip_atomic_load(p, __ATOMIC_RELAXED, __HIP_MEMORY_SCOPE_AGENT); }
__device__ __forceinline__ unsigned xb_add(unsigned* p, unsigned v) { return __hip_atomic_fetch_add(p, v, __ATOMIC_RELAXED, __HIP_MEMORY_SCOPE_AGENT); }
__device__ __forceinline__ unsigned xb_xcc_id() { return (unsigned)__builtin_amdgcn_s_getreg((3 << 11) | 20) & 0xFu; }
#define XB_SPIN(cond, bar) do { unsigned _sp = 0; while (cond) { __builtin_amdgcn_s_sleep(1); \
    if ((++_sp & 255u) == 0u) { if (xb_ld(&(bar)[XB_TMO])) break; if (_sp > XB_SPIN_CAP) { atomicAdd(&(bar)[XB_TMO], 1u); break; } } } } while (0)

struct XcdBarrier {
    unsigned* bar; unsigned x;
    volatile LAS unsigned* st;
};

__device__ __forceinline__ XcdBarrier xcd_barrier_post(unsigned* bar, volatile LAS unsigned* st) {
    XcdBarrier b; b.bar = bar; b.x = xb_xcc_id(); b.st = st;
    if (threadIdx.x == 0) (void)xb_add(&bar[XB_XCNT(b.x)], 1u);
    return b;
}
__device__ __forceinline__ void xcd_barrier_complete(unsigned* bar, unsigned x, unsigned& nloc, unsigned& nx) {
    const unsigned G = gridDim.x * gridDim.y * gridDim.z;
    unsigned sum, cnt, mine, sp = 0u;
    for (;;) {
        sum = 0u; cnt = 0u; mine = 0u;
#pragma unroll
        for (unsigned j = 0; j < 16; ++j) { const unsigned c = xb_ld(&bar[XB_XCNT(j)]); sum += c; cnt += (c > 0u) ? 1u : 0u; mine = (j == x) ? c : mine; }
        if (sum == G) break;
        __builtin_amdgcn_s_sleep(1);
        if ((++sp & 255u) == 0u) { if (xb_ld(&bar[XB_TMO])) break; if (sp > XB_SPIN_CAP) { atomicAdd(&bar[XB_TMO], 1u); break; } }
    }
    nloc = mine > 0u ? mine : 1u; nx = cnt > 0u ? cnt : 1u;
}

__device__ __forceinline__ void xcd_barrier(const XcdBarrier& b) {
    asm volatile("s_waitcnt vmcnt(0)" ::: "memory");
    __syncthreads();
    if (threadIdx.x == 0) {
        unsigned* bar; unsigned bx = b.x; { GAS unsigned* bg = (GAS unsigned*)b.bar; asm volatile("" : "+s"(bg), "+s"(bx)); bar = (unsigned*)bg; }
        __builtin_amdgcn_s_waitcnt(0);
        unsigned nloc = b.st[0], nx = b.st[1];
        if (nloc == 0u) { xcd_barrier_complete(bar, bx, nloc, nx); b.st[0] = nloc; b.st[1] = nx; }
        const unsigned old = xb_add(&bar[XB_XSUB(bx)], 1u);
        const unsigned gen = old / nloc;
        if (old + 1u == (gen + 1u) * nloc) {
            __builtin_amdgcn_fence(__ATOMIC_RELEASE, "agent");
            asm volatile("s_waitcnt vmcnt(0)" ::: "memory");
            const unsigned og = xb_add(&bar[XB_TOP], 1u);
            const unsigned tg = og / nx;
            if (og + 1u == (tg + 1u) * nx) xb_add(&bar[XB_TOPGEN], 1u);
            else XB_SPIN(xb_ld(&bar[XB_TOPGEN]) == tg, bar);
            __builtin_amdgcn_fence(__ATOMIC_ACQUIRE, "agent");
            xb_add(&bar[XB_XGEN(bx)], 1u);
            asm volatile("s_waitcnt vmcnt(0)" ::: "memory");
        } else {
            XB_SPIN(xb_ld(&bar[XB_XGEN(bx)]) == gen, bar);
            __builtin_amdgcn_fence(__ATOMIC_ACQUIRE, "agent");
            asm volatile("s_waitcnt vmcnt(0)" ::: "memory");
        }
    }
    __syncthreads();
}

namespace g8 {
constexpr int BM = 256, BK = 64, HALF = 128, HTB = HALF * BK * 2, STAGE_BYTES = 8 * HTB, NXCD = 8, WGM = 8;
__host__ __device__ __forceinline__ int lds_byte(int r, int c) { const int st = (r >> 4) * 2 + (c >> 5), rr = r & 15, cc = c & 31, ob = rr * 64 + cc * 2; return st * 1024 + (ob ^ (((ob >> 9) & 1) << 5)); }
__host__ __device__ __forceinline__ void stage_rc(int b, int& R, int& C) { const int st = b / 1024, sb = b % 1024, swz = sb ^ (((sb >> 9) & 1) << 5); R = (st >> 1) * 16 + swz / 64; C = (st & 1) * 32 + (swz % 64) / 2; }
__host__ __device__ __forceinline__ int perm32(int rho) { const int n = rho >> 4, i = rho & 15; return 8 * (i >> 2) + 4 * n + (i & 3); }

struct Unit { const char* A; const char* B; const int* rows; int pm, pn, nvalid, aux; };

template <class Epi, class Sched, bool GATHER>
__device__ __forceinline__ void gemm_phase(LAS unsigned char* lds, const int tid_in, const int K, const int lda, const int ldb, const Sched& S, const Epi& E) {
    const int tid = tid_in, wid = __builtin_amdgcn_readfirstlane(tid >> 6), lane = tid & 63, wr = wid >> 2, wc = wid & 3, fr = lane & 15, fq = lane >> 4;
    const int nt = K / BK;
    unsigned voffB[2];
#pragma unroll
    for (int i = 0; i < 2; ++i) { int R_, C_; stage_rc(tid * 16 + i * 8192, R_, C_); const int Rb = Epi::PERM ? ((R_ & ~31) + perm32(R_ & 31)) : R_; voffB[i] = (unsigned)(Rb * ldb + C_) * 2u; }
    LAS v4u* stash = (LAS v4u*)(lds + (LDS_STASH - 0) + tid * 16);
    const size_t kstep = (size_t)(BK * 2);
    const size_t hstepB = (size_t)HALF * ldb * 2;
    const unsigned ldsw = (unsigned)wid * 1024u;
    const int aoff = lds_byte(wr * 64 + fr, fq * 8), boff = lds_byte(wc * 32 + fr, fq * 8);
#define G8_SA(b, h) (((b) * 2 + (h)) * HTB)
#define G8_SB(b, h) ((4 + (b) * 2 + (h)) * HTB)
#define G8_STAGE2(bufoff, gbase, v0, v1) do { \
        __builtin_amdgcn_global_load_lds((const unsigned*)((const char*)(gbase) + (v0)), (LAS unsigned*)(lds + (bufoff) + ldsw), 16, 0, 0); \
        __builtin_amdgcn_global_load_lds((const unsigned*)((const char*)(gbase) + (v1)), (LAS unsigned*)(lds + (bufoff) + ldsw + 8192), 16, 0, 0); } while (0)
#define G8_STAGEB(bufoff, gbase) G8_STAGE2(bufoff, gbase, voffB[0], voffB[1])
#define G8_LDA(dst, b, h) do { _Pragma("unroll") for (int m = 0; m < 4; ++m) _Pragma("unroll") for (int k = 0; k < 2; ++k) dst[m][k] = *(const LAS bf16x8*)(lds + G8_SA(b, h) + aoff + m * 2048 + k * 1024); } while (0)
#define G8_LDB(dst, b, h) do { _Pragma("unroll") for (int n = 0; n < 2; ++n) _Pragma("unroll") for (int k = 0; k < 2; ++k) dst[n][k] = *(const LAS bf16x8*)(lds + G8_SB(b, h) + boff + n * 2048 + k * 1024); } while (0)
#define G8_MMA(ai, bj, At, Bt) do { __builtin_amdgcn_s_setprio(1); _Pragma("unroll") for (int m = 0; m < 4; ++m) _Pragma("unroll") for (int n = 0; n < 2; ++n) _Pragma("unroll") for (int k = 0; k < 2; ++k) \
        acc[ai][bj][m][n] = __builtin_amdgcn_mfma_f32_16x16x32_bf16(Bt[n][k], At[m][k], acc[ai][bj][m][n], 0, 0, 0); __builtin_amdgcn_s_setprio(0); } while (0)
#define G8_WAIT_V(n) asm volatile("s_waitcnt vmcnt(" #n ")" ::: "memory")
#define G8_WAIT_L(n) asm volatile("s_waitcnt lgkmcnt(" #n ")" ::: "memory")
#define G8_BAR __builtin_amdgcn_s_barrier()
#define G8_SCHED __builtin_amdgcn_sched_barrier(0)
#define G8_SETVA(dst, u) do { int _t2 = tid; if (GATHER) asm volatile("" : "+v"(_t2)); _Pragma("unroll") for (int _h = 0; _h < 2; ++_h) _Pragma("unroll") for (int _i = 0; _i < 2; ++_i) { \
        int _R, _C; stage_rc(_t2 * 16 + _i * 8192, _R, _C); \
        const unsigned _rl = (unsigned)(_h * HALF + _R); unsigned _row = _rl; \
        if (GATHER) { _row = 0u; if (_rl < (unsigned)(u).nvalid) _row = (unsigned)(u).rows[_rl] >> 3; } \
        dst[_h][_i] = (_row * (unsigned)lda + (unsigned)_C) * 2u; } } while (0)
    Unit cur, nxt; int ui = 0;
    if (!S.next(0, cur)) return;
    f32x4 acc[2][2][4][2];
#pragma unroll
    for (int a = 0; a < 2; ++a)
#pragma unroll
        for (int b = 0; b < 2; ++b)
#pragma unroll
            for (int m = 0; m < 4; ++m)
#pragma unroll
                for (int n = 0; n < 2; ++n) acc[a][b][m][n] = (f32x4){0.f, 0.f, 0.f, 0.f};
    bf16x8 At[4][2], B0[2][2], B1[2][2];
    unsigned vAc[2][2]; unsigned xl00 = 0, xl01 = 0, xl10 = 0, xl11 = 0;
    G8_SETVA(vAc, cur);
    const char* cA = cur.A; const char* cB = cur.B;
    G8_STAGEB(G8_SB(0, 0), cB); G8_STAGEB(G8_SB(0, 1), cB + hstepB); G8_STAGE2(G8_SA(0, 0), cA, vAc[0][0], vAc[0][1]); G8_STAGE2(G8_SA(0, 1), cA, vAc[1][0], vAc[1][1]);
    if (wr == 1) G8_BAR;
    G8_WAIT_V(2); G8_BAR;
    G8_STAGEB(G8_SB(1, 0), cB + kstep); G8_STAGE2(G8_SA(1, 0), cA + kstep, vAc[0][0], vAc[0][1]); G8_STAGEB(G8_SB(1, 1), cB + hstepB + kstep);
    G8_WAIT_V(6); G8_BAR;
    for (;;) {
        const bool has_next = S.next(ui + 1, nxt);
        const char* nA = has_next ? nxt.A : cA; const char* nB = has_next ? nxt.B : cB;
        if (GATHER) { unsigned vAn[2][2]; if (has_next) { G8_SETVA(vAn, nxt); } else {
#pragma unroll
            for (int h = 0; h < 2; ++h)
#pragma unroll
                for (int i = 0; i < 2; ++i) vAn[h][i] = vAc[h][i]; }
            *stash = (v4u){vAn[0][0], vAn[0][1], vAn[1][0], vAn[1][1]}; }
#pragma unroll 1
        for (int t = 0; t < nt; t += 2) {
            const bool last = (t == nt - 2);
            const char* a1 = cA + (size_t)(t + 1) * kstep;
            const char* a2 = last ? nA : cA + (size_t)(t + 2) * kstep; const char* b2 = last ? nB : cB + (size_t)(t + 2) * kstep;
            const char* a3 = a2 + kstep; const char* b3 = b2 + kstep;
            unsigned x00 = vAc[0][0], x01 = vAc[0][1], x10 = vAc[1][0], x11 = vAc[1][1];
            if (GATHER) { if (last) { const v4u sv = *stash; x00 = sv.x; x01 = sv.y; x10 = sv.z; x11 = sv.w; } xl00 = x00; xl01 = x01; xl10 = x10; xl11 = x11; }
            G8_LDB(B0, 0, 0); G8_LDB(B1, 0, 1); G8_SCHED; G8_LDA(At, 0, 0); G8_STAGE2(G8_SA(1, 1), a1, vAc[1][0], vAc[1][1]);
            G8_WAIT_V(8); G8_WAIT_L(0); G8_BAR; G8_MMA(0, 0, At, B0); G8_MMA(0, 1, At, B1); G8_BAR; G8_SCHED;
            G8_LDA(At, 0, 1); G8_STAGEB(G8_SB(0, 0), b2); G8_STAGEB(G8_SB(0, 1), b2 + hstepB); G8_STAGE2(G8_SA(0, 0), a2, x00, x01);
            G8_WAIT_V(8); G8_WAIT_L(0); G8_BAR; G8_MMA(1, 0, At, B0); G8_MMA(1, 1, At, B1); G8_BAR; G8_SCHED;
            G8_LDB(B0, 1, 0); G8_LDB(B1, 1, 1); G8_SCHED; G8_LDA(At, 1, 0); G8_STAGE2(G8_SA(0, 1), a2, x10, x11);
            G8_WAIT_V(8); G8_WAIT_L(0); G8_BAR; G8_MMA(0, 0, At, B0); G8_MMA(0, 1, At, B1); G8_BAR; G8_SCHED;
            G8_LDA(At, 1, 1); G8_STAGEB(G8_SB(1, 0), b3); G8_STAGEB(G8_SB(1, 1), b3 + hstepB); G8_STAGE2(G8_SA(1, 0), a3, x00, x01);
            G8_WAIT_V(8); G8_WAIT_L(0); G8_BAR; G8_MMA(1, 0, At, B0); G8_MMA(1, 1, At, B1); G8_BAR; G8_SCHED;
        }
        if (wr == 0) G8_BAR;
        E(acc, cur, wr, wc, fr, fq);
        if (!has_next) break;
#pragma unroll
        for (int a = 0; a < 2; ++a)
#pragma unroll
            for (int b = 0; b < 2; ++b)
#pragma unroll
                for (int m = 0; m < 4; ++m)
#pragma unroll
                    for (int n = 0; n < 2; ++n) acc[a][b][m][n] = (f32x4){0.f, 0.f, 0.f, 0.f};
        cur = nxt; cA = nA; cB = nB; ++ui;
        if (GATHER) { vAc[0][0] = xl00; vAc[0][1] = xl01; vAc[1][0] = xl10; vAc[1][1] = xl11; }
        if (wr == 1) G8_BAR;
    }
    G8_WAIT_V(0);
    G8_BAR;
#undef G8_SA
#undef G8_SB
#undef G8_STAGE2
#undef G8_STAGEB
#undef G8_LDA
#undef G8_LDB
#undef G8_MMA
#undef G8_WAIT_V
#undef G8_WAIT_L
#undef G8_BAR
#undef G8_SCHED
#undef G8_SETVA
}

struct DenseSched {
    const char* A; const char* B; size_t a_tile, b_tile, agrp_stride; int agrp_shift, nM, nN, nwg, G, c;
    __device__ __forceinline__ void init(const void* A_, const void* B_, int M, int N, int lda, int ldb, int G_, int c_) {
        A = (const char*)A_; B = (const char*)B_; a_tile = (size_t)BM * lda * 2; b_tile = (size_t)BM * ldb * 2; agrp_stride = 0; agrp_shift = 0; nM = M / BM; nN = N / BM; nwg = nM * nN; G = G_; c = c_; }
    __device__ __forceinline__ bool next(int i, Unit& u) const {
        const long L = (long)i * G + c; if (L >= nwg) return false;
        int wgid = (int)L; { const int q = nwg / NXCD, r = nwg % NXCD, xcd = wgid % NXCD, off = wgid / NXCD; wgid = (xcd < r ? xcd * (q + 1) : r * (q + 1) + (xcd - r) * q) + off; }
        const int nig = WGM * nN, gid = wgid / nig, fm = gid * WGM, gsz = (nM - fm) < WGM ? (nM - fm) : WGM;
        u.pm = fm + ((wgid % nig) % gsz); u.pn = (wgid % nig) / gsz;
        u.A = A + (size_t)u.pm * a_tile + (size_t)(u.pn >> agrp_shift) * agrp_stride; u.B = B + (size_t)u.pn * b_tile; u.rows = nullptr; u.nvalid = BM; u.aux = 0; return true;
    }
};
template <int NPN, bool GATHERED>
struct ExpertSched {
    const LAS int* tpref; const LAS int* cnt; const char* A; const char* B; const int* tok; size_t b_exp, b_tile, a_tile; int NU, G, c;
    __device__ __forceinline__ bool next(int i, Unit& u) const {
        int L = i * G + c; if (L >= NU) return false;
        if ((i + 1) * G <= NU && (G % NXCD) == 0) L = i * G + (c % NXCD) * (G / NXCD) + c / NXCD;
        const int tile = L / NPN, pn = L % NPN;
        int e = 0; while (__builtin_amdgcn_readfirstlane(tpref[e + 1]) <= tile) ++e;
        const int rb = tile - __builtin_amdgcn_readfirstlane(tpref[e]);
        u.pm = e; u.pn = pn; u.aux = tile * BM; u.nvalid = __builtin_amdgcn_readfirstlane(cnt[e]) - rb * BM; if (u.nvalid > BM) u.nvalid = BM;
        u.rows = tok + (size_t)e * CAP + rb * BM;
        u.A = GATHERED ? A : A + (size_t)tile * a_tile; u.B = B + (size_t)e * b_exp + (size_t)pn * b_tile; return true;
    }
};

struct EpiBf16 {
    static constexpr bool PERM = true;
    bf16* O; int ldc; int qscale;
    __device__ __forceinline__ void operator()(const f32x4 (&acc)[2][2][4][2], const Unit& u, int wr, int wc, int fr, int fq) const {
        asm volatile("" : "+v"(fr), "+v"(fq));
        const int row0 = u.pm * BM + wr * 64 + fr, col0 = u.pn * BM + wc * 32 + 8 * fq;
        const float sc = (qscale && (u.pn % 6) < 2) ? 0.125f : 1.0f;
#pragma unroll
        for (int ai = 0; ai < 2; ++ai)
#pragma unroll
            for (int m = 0; m < 4; ++m) { bf16* rowp = O + (size_t)(row0 + ai * HALF + m * 16) * ldc + col0;
#pragma unroll
                for (int bj = 0; bj < 2; ++bj) { const f32x4 v0 = acc[ai][bj][m][0] * sc, v1 = acc[ai][bj][m][1] * sc;
                    v4u w; w.x = cvt_pk_bf16(v0[0], v0[1]); w.y = cvt_pk_bf16(v0[2], v0[3]); w.z = cvt_pk_bf16(v1[0], v1[1]); w.w = cvt_pk_bf16(v1[2], v1[3]);
                    *(v4u*)(rowp + bj * HALF) = w; } }
    }
};
struct EpiScaleBf16 {
    static constexpr bool PERM = true;
    bf16* O; int ldc; const float* scale;
    __device__ __forceinline__ void operator()(const f32x4 (&acc)[2][2][4][2], const Unit& u, int wr, int wc, int fr, int fq) const {
        asm volatile("" : "+v"(fr), "+v"(fq));
        const int row0 = u.pm * BM + wr * 64 + fr, col0 = u.pn * BM + wc * 32 + 8 * fq;
        f32x4 sv[2][2];
#pragma unroll
        for (int bj = 0; bj < 2; ++bj)
#pragma unroll
            for (int n = 0; n < 2; ++n) sv[bj][n] = *(const f32x4*)(scale + col0 + bj * HALF + 4 * n);
#pragma unroll
        for (int ai = 0; ai < 2; ++ai)
#pragma unroll
            for (int m = 0; m < 4; ++m) { bf16* rowp = O + (size_t)(row0 + ai * HALF + m * 16) * ldc + col0;
#pragma unroll
                for (int bj = 0; bj < 2; ++bj) { const f32x4 v0 = acc[ai][bj][m][0] * sv[bj][0], v1 = acc[ai][bj][m][1] * sv[bj][1];
                    v4u w; w.x = cvt_pk_bf16(v0[0], v0[1]); w.y = cvt_pk_bf16(v0[2], v0[3]); w.z = cvt_pk_bf16(v1[0], v1[1]); w.w = cvt_pk_bf16(v1[2], v1[3]);
                    *(v4u*)(rowp + bj * HALF) = w; } }
    }
};
struct EpiResid {
    static constexpr bool PERM = false;
    const float* X; float* Y;
    __device__ __forceinline__ void operator()(const f32x4 (&acc)[2][2][4][2], const Unit& u, int wr, int wc, int fr, int fq) const {
        asm volatile("" : "+v"(fr), "+v"(fq));
        const int row0 = u.pm * BM + wr * 64 + fr, col0 = u.pn * BM + wc * 32 + 4 * fq;
#pragma unroll
        for (int ai = 0; ai < 2; ++ai)
#pragma unroll
            for (int m = 0; m < 4; ++m) { const size_t off = (size_t)(row0 + ai * HALF + m * 16) * D + col0;
#pragma unroll
                for (int bj = 0; bj < 2; ++bj)
#pragma unroll
                    for (int n = 0; n < 2; ++n) { const f32x4 xv = *(const f32x4*)(X + off + bj * HALF + n * 16); *(f32x4*)(Y + off + bj * HALF + n * 16) = xv * ALPHA + acc[ai][bj][m][n]; } }
    }
};
struct EpiResidLN {
    static constexpr bool PERM = true;
    const float* X32; const bf16* Xb; const float* st; const float* g; const float* b; bf16* Y; float* pst; int mode;
    __device__ __forceinline__ void operator()(const f32x4 (&acc)[2][2][4][2], const Unit& u, int wr, int wc, int fr, int fq) const {
        asm volatile("" : "+v"(fr), "+v"(fq));
        const int row0 = u.pm * BM + wr * 64 + fr, col0 = u.pn * BM + wc * 32 + 8 * fq, lane = fq * 16 + fr;
#pragma unroll
        for (int ai = 0; ai < 2; ++ai)
#pragma unroll
            for (int m = 0; m < 4; ++m) { const int row = row0 + ai * HALF + m * 16; const size_t off = (size_t)row * D + col0;
                float mean = 0.f, rstd = 1.f; if (mode == 1) { const f32x2 sv = *(const f32x2*)(st + 2 * row); mean = sv.x; rstd = sv.y; }
                float sm = 0.f, sq = 0.f;
#pragma unroll
                for (int bj = 0; bj < 2; ++bj) { f32x4 x0, x1;
                    if (mode == 2) { const v4u xv = *(const v4u*)(Xb + off + bj * HALF); x0 = (f32x4){bflo(xv.x), bfhi(xv.x), bflo(xv.y), bfhi(xv.y)}; x1 = (f32x4){bflo(xv.z), bfhi(xv.z), bflo(xv.w), bfhi(xv.w)}; }
                    else if (mode) { const v4u xv = *(const v4u*)(Xb + off + bj * HALF);
                        const f32x4 g0 = *(const f32x4*)(g + col0 + bj * HALF), g1 = *(const f32x4*)(g + col0 + bj * HALF + 4), b0 = *(const f32x4*)(b + col0 + bj * HALF), b1 = *(const f32x4*)(b + col0 + bj * HALF + 4);
                        x0 = ((f32x4){bflo(xv.x), bfhi(xv.x), bflo(xv.y), bfhi(xv.y)} - mean) * rstd * g0 + b0; x1 = ((f32x4){bflo(xv.z), bfhi(xv.z), bflo(xv.w), bfhi(xv.w)} - mean) * rstd * g1 + b1; }
                    else { x0 = *(const f32x4*)(X32 + off + bj * HALF); x1 = *(const f32x4*)(X32 + off + bj * HALF + 4); }
                    const f32x4 y0 = x0 * ALPHA + acc[ai][bj][m][0], y1 = x1 * ALPHA + acc[ai][bj][m][1];
                    v4u w; w.x = cvt_pk_bf16(y0[0], y0[1]); w.y = cvt_pk_bf16(y0[2], y0[3]); w.z = cvt_pk_bf16(y1[0], y1[1]); w.w = cvt_pk_bf16(y1[2], y1[3]);
                    *(v4u*)(Y + off + bj * HALF) = w;
                    sm += ((y0[0] + y0[1]) + (y0[2] + y0[3])) + ((y1[0] + y1[1]) + (y1[2] + y1[3]));
                    sq += ((y0[0] * y0[0] + y0[1] * y0[1]) + (y0[2] * y0[2] + y0[3] * y0[3])) + ((y1[0] * y1[0] + y1[1] * y1[1]) + (y1[2] * y1[2] + y1[3] * y1[3])); }
                sm += shfl_x(sm, 16, lane); sm += shfl_x(sm, 32, lane); sq += shfl_x(sq, 16, lane); sq += shfl_x(sq, 32, lane);
                if (fq == 0) *(f32x2*)(pst + ((size_t)row * 32 + u.pn * 4 + wc) * 2) = (f32x2){sm, sq}; }
    }
};
struct EpiConvIn {
    static constexpr bool PERM = true;
    bf16* UC; bf16* BGp;
    __device__ __forceinline__ void operator()(const f32x4 (&acc)[2][2][4][2], const Unit& u, int wr, int wc, int fr, int fq) const {
        asm volatile("" : "+v"(fr), "+v"(fq));
        const int row0 = u.pm * BM + wr * 64 + fr, cw = wc * 32 + 8 * fq;
        if (u.pn < 16) {
#pragma unroll
            for (int ai = 0; ai < 2; ++ai)
#pragma unroll
                for (int m = 0; m < 4; ++m) { bf16* rowp = UC + (size_t)(row0 + ai * HALF + m * 16) * D + u.pn * HALF + cw;
                    const f32x4 v0 = acc[ai][0][m][0] * acc[ai][1][m][0], v1 = acc[ai][0][m][1] * acc[ai][1][m][1];
                    v4u w; w.x = cvt_pk_bf16(v0[0], v0[1]); w.y = cvt_pk_bf16(v0[2], v0[3]); w.z = cvt_pk_bf16(v1[0], v1[1]); w.w = cvt_pk_bf16(v1[2], v1[3]);
                    *(v4u*)rowp = w; }
        } else {
#pragma unroll
            for (int ai = 0; ai < 2; ++ai)
#pragma unroll
                for (int m = 0; m < 4; ++m) { bf16* rowp = BGp + (size_t)(row0 + ai * HALF + m * 16) * D + (u.pn - 16) * BM + cw;
#pragma unroll
                    for (int bj = 0; bj < 2; ++bj) { const f32x4 v0 = acc[ai][bj][m][0], v1 = acc[ai][bj][m][1];
                        v4u w; w.x = cvt_pk_bf16(v0[0], v0[1]); w.y = cvt_pk_bf16(v0[2], v0[3]); w.z = cvt_pk_bf16(v1[0], v1[1]); w.w = cvt_pk_bf16(v1[2], v1[3]);
                        *(v4u*)(rowp + bj * HALF) = w; } }
        }
    }
};
__device__ __forceinline__ f32x4 silu_mul(f32x4 g, f32x4 uu) {
    f32x4 r;
#pragma unroll
    for (int j = 0; j < 4; ++j) r[j] = g[j] * __builtin_amdgcn_rcpf(1.0f + __expf(-g[j])) * uu[j];
    return r;
}
struct EpiExpertGU {
    static constexpr bool PERM = true;
    bf16* H;
    __device__ __forceinline__ void operator()(const f32x4 (&acc)[2][2][4][2], const Unit& u, int wr, int wc, int fr, int fq) const {
        asm volatile("" : "+v"(fr), "+v"(fq));
        const float* gates = (const float*)((const char*)u.rows + (WS_LGATE - WS_LTOK));
        const int cw = wc * 32 + 8 * fq;
#pragma unroll
        for (int ai = 0; ai < 2; ++ai)
#pragma unroll
            for (int m = 0; m < 4; ++m) { const int r = ai * HALF + wr * 64 + m * 16 + fr;
                if (r < u.nvalid) { const float gt = gates[r]; const unsigned pid = (unsigned)u.rows[r];
                    const f32x4 v0 = silu_mul(acc[ai][0][m][0], acc[ai][1][m][0]) * gt, v1 = silu_mul(acc[ai][0][m][1], acc[ai][1][m][1]) * gt;
                    v4u w; w.x = cvt_pk_bf16(v0[0], v0[1]); w.y = cvt_pk_bf16(v0[2], v0[3]); w.z = cvt_pk_bf16(v1[0], v1[1]); w.w = cvt_pk_bf16(v1[2], v1[3]);
                    (void)pid; *(v4u*)(H + (size_t)(u.aux + r) * EDIM + cw) = w; } }
    }
};
struct EpiSharedGU {
    static constexpr bool PERM = true;
    bf16* HS;
    __device__ __forceinline__ void operator()(const f32x4 (&acc)[2][2][4][2], const Unit& u, int wr, int wc, int fr, int fq) const {
        asm volatile("" : "+v"(fr), "+v"(fq));
        const int row0 = u.pm * BM + wr * 64 + fr, cw = u.pn * HALF + wc * 32 + 8 * fq;
#pragma unroll
        for (int ai = 0; ai < 2; ++ai)
#pragma unroll
            for (int m = 0; m < 4; ++m) {
                const f32x4 v0 = silu_mul(acc[ai][0][m][0], acc[ai][1][m][0]), v1 = silu_mul(acc[ai][0][m][1], acc[ai][1][m][1]);
                v4u w; w.x = cvt_pk_bf16(v0[0], v0[1]); w.y = cvt_pk_bf16(v0[2], v0[3]); w.z = cvt_pk_bf16(v1[0], v1[1]); w.w = cvt_pk_bf16(v1[2], v1[3]);
                *(v4u*)(HS + (size_t)(row0 + ai * HALF + m * 16) * SDIM + cw) = w; }
    }
};
struct EpiDownY {
    static constexpr bool PERM = true;
    bf16* Y;
    __device__ __forceinline__ void operator()(const f32x4 (&acc)[2][2][4][2], const Unit& u, int wr, int wc, int fr, int fq) const {
        asm volatile("" : "+v"(fr), "+v"(fq));
        const int col0 = u.pn * BM + wc * 32 + 8 * fq;
#pragma unroll
        for (int ai = 0; ai < 2; ++ai)
#pragma unroll
            for (int m = 0; m < 4; ++m) { const int r = ai * HALF + wr * 64 + m * 16 + fr; bf16* rowp = Y + (size_t)(u.aux + r) * D + col0;
#pragma unroll
                for (int bj = 0; bj < 2; ++bj) { const f32x4 v0 = acc[ai][bj][m][0], v1 = acc[ai][bj][m][1];
                    v4u w; w.x = cvt_pk_bf16(v0[0], v0[1]); w.y = cvt_pk_bf16(v0[2], v0[3]); w.z = cvt_pk_bf16(v1[0], v1[1]); w.w = cvt_pk_bf16(v1[2], v1[3]);
                    *(v4u*)(rowp + bj * HALF) = w; } }
    }
};
}

struct Args { const float* in[19]; float* out; unsigned char* ws; int ph_lo, ph_hi; };
struct Frame {
    LAS unsigned char* lds; unsigned* ctl; unsigned char* ws;
    int tid, lane, wave, G, bid;
};
enum { IN_X = 0, IN_RELB, IN_PWIN, IN_PWG, IN_PSC, IN_PWOUT, IN_DQKV, IN_DOUT, IN_CWIN, IN_CW, IN_CWOUT, IN_LNG, IN_LNB, IN_RW, IN_RB, IN_EGU, IN_ED, IN_SGU, IN_SD };

#define CAS __attribute__((address_space(4)))
typedef const CAS unsigned char* KP;
__device__ __forceinline__ const float* ain(KP kp, int i) { return (const float*)((const GAS float* const CAS*)kp)[i]; }
__device__ __forceinline__ float* aout(KP kp) { return (float*)((GAS float* const CAS*)kp)[19]; }
__device__ __forceinline__ void tr_item(const float* W, int K, int N, bf16* WT, int dstK, int mode, LAS float* scr, int item, int lane) {
    const int nblk = N / 32, kb = item / nblk, nb = item % nblk, k0 = 64 * kb, n0 = 32 * nb;
    int r0 = n0;
    if (mode == 1) { const int part = n0 / 2048, j = n0 % 2048; r0 = (part == 0) ? 4096 + j : 256 * (j / 128) + (part == 2 ? 128 : 0) + (j % 128); }
    if (mode == 2) { const int part = n0 / 256, j = n0 % 256; r0 = 256 * (j / 128) + 128 * part + (j % 128); }
#pragma unroll 8
    for (int i = 0; i < 32; ++i) { const int kk = 2 * i + (lane >> 5); scr[kk * 33 + (lane & 31)] = W[(size_t)(k0 + kk) * N + n0 + (lane & 31)]; }
    LDS_WAIT(); asm volatile("" ::: "memory");
    const int c = lane & 7;
#pragma unroll
    for (int j = 0; j < 4; ++j) { const int n = (lane >> 3) + 8 * j; const LAS float* s = scr + (8 * c) * 33 + n;
        v4u o; o.x = pk2(s[0 * 33], s[1 * 33]); o.y = pk2(s[2 * 33], s[3 * 33]); o.z = pk2(s[4 * 33], s[5 * 33]); o.w = pk2(s[6 * 33], s[7 * 33]);
        *(v4u*)(WT + (size_t)(r0 + n) * dstK + k0 + 8 * c) = o; }
    LDS_WAIT(); asm volatile("" ::: "memory");
}
__device__ __forceinline__ void phase_prologue(const Frame& F, KP kp) {
    LAS float* scr = (LAS float*)(F.lds + F.wave * 16384);
    const int gw = F.bid * 8 + F.wave, NGW = F.G * 8;
    constexpr int I0 = 2 * 2048, I1 = 8 * 128, I2 = 2 * 2048, I3 = 4608, I4 = 512, I5 = 6144, I6 = 2048, I7 = 4 * 512, I8 = 4 * 256, I9 = 256 * 256, I10 = 256 * 128;
    constexpr int NITEMS = I0 + I1 + I2 + I3 + I4 + I5 + I6 + I7 + I8 + I9 + I10;
    unsigned char* ws = F.ws;
    for (int it = gw; it < NITEMS; it += NGW) {
        int r = it;
        if (r < I0) { const int b = r / 2048; tr_item(ain(kp, IN_PWIN) + (size_t)b * D * D, D, D, (bf16*)(ws + WS_W_POOL_IN) + (size_t)b * D * D, D, 0, scr, r % 2048, F.lane); continue; } r -= I0;
        if (r < I1) { const int b = r / 128; tr_item(ain(kp, IN_PWG) + (size_t)b * 512 * 512, 512, 512, (bf16*)(ws + WS_W_POOL_G) + (size_t)b * 512 * 512, 512, 0, scr, r % 128, F.lane); continue; } r -= I1;
        if (r < I2) { const int b = r / 2048; tr_item(ain(kp, IN_PWOUT) + (size_t)b * D * D, D, D, (bf16*)(ws + WS_W_POOL_OUT) + (size_t)b * D * D, D, 0, scr, r % 2048, F.lane); continue; } r -= I2;
        if (r < I3) { tr_item(ain(kp, IN_DQKV), D, QKVC, (bf16*)(ws + WS_W_DIL_QKV), D, 0, scr, r, F.lane); continue; } r -= I3;
        if (r < I4) { tr_item(ain(kp, IN_DOUT), DILW, D, (bf16*)(ws + WS_W_DIL_OUT), DILW, 0, scr, r, F.lane); continue; } r -= I4;
        if (r < I5) { tr_item(ain(kp, IN_CWIN), D, 3 * D, (bf16*)(ws + WS_W_CONV_IN), D, 1, scr, r, F.lane); continue; } r -= I5;
        if (r < I6) { tr_item(ain(kp, IN_CWOUT), D, D, (bf16*)(ws + WS_W_CONV_OUT), D, 0, scr, r, F.lane); continue; } r -= I6;
        if (r < I7) { const int b = r / 512; tr_item(ain(kp, IN_SGU) + (size_t)b * D * 512, D, 512, (bf16*)(ws + WS_W_SH_GU) + (size_t)b * 512 * D, D, 2, scr, r % 512, F.lane); continue; } r -= I7;
        if (r < I8) { const int b = r / 256; tr_item(ain(kp, IN_SD) + (size_t)b * SDIM * D, SDIM, D, (bf16*)(ws + WS_W_SH_D) + (size_t)b * D * SDIM, SDIM, 0, scr, r % 256, F.lane); continue; } r -= I8;
        if (r < I9) { const int b = r / 256; tr_item(ain(kp, IN_EGU) + (size_t)b * D * 256, D, 256, (bf16*)(ws + WS_W_EX_GU) + (size_t)b * 256 * D, D, 0, scr, r % 256, F.lane); continue; } r -= I9;
        { const int b = r / 128; tr_item(ain(kp, IN_ED) + (size_t)b * EDIM * D, EDIM, D, (bf16*)(ws + WS_W_EX_D) + (size_t)b * D * EDIM, EDIM, 0, scr, r % 128, F.lane); }
    }
    const size_t gt = (size_t)F.bid * 512 + F.tid, GT = (size_t)F.G * 512;
    { const float* rw = ain(kp, IN_RW); bf16* wh = (bf16*)(ws + WS_RWH); bf16* wl = (bf16*)(ws + WS_RWL);
      for (size_t i = gt; i < (size_t)DEPTH * NEXP * D / 8; i += GT) { const size_t k8 = i % (D / 8), e = (i / (D / 8)) % NEXP, l = i / ((size_t)NEXP * D / 8);
          float v[8]; unsigned hi[8], lo[8];
#pragma unroll
          for (int j = 0; j < 8; ++j) { v[j] = rw[(l * D + k8 * 8 + j) * NEXP + e]; hi[j] = f2bf(v[j]); lo[j] = f2bf(v[j] - __builtin_bit_cast(float, hi[j] << 16)); }
          v4u a, b2; a.x = hi[0] | (hi[1] << 16); a.y = hi[2] | (hi[3] << 16); a.z = hi[4] | (hi[5] << 16); a.w = hi[6] | (hi[7] << 16);
          b2.x = lo[0] | (lo[1] << 16); b2.y = lo[2] | (lo[3] << 16); b2.z = lo[4] | (lo[5] << 16); b2.w = lo[6] | (lo[7] << 16);
          *(v4u*)(wh + (l * NEXP + e) * D + k8 * 8) = a; *(v4u*)(wl + (l * NEXP + e) * D + k8 * 8) = b2; } }
    const float* x = ain(kp, IN_X); bf16* xb = (bf16*)(ws + WS_XB);
    for (size_t i = gt; i < (size_t)T * D / 8; i += GT) { const f32x4 p = *(const f32x4*)(x + i * 8), q = *(const f32x4*)(x + i * 8 + 4);
        v4u w; w.x = pk2(p[0], p[1]); w.y = pk2(p[2], p[3]); w.z = pk2(q[0], q[1]); w.w = pk2(q[2], q[3]); *(v4u*)(xb + i * 8) = w; }
}

__device__ __forceinline__ void unpack8(const v4u w, float (&f)[8]) { f[0] = bflo(w.x); f[1] = bfhi(w.x); f[2] = bflo(w.y); f[3] = bfhi(w.y); f[4] = bflo(w.z); f[5] = bfhi(w.z); f[6] = bflo(w.w); f[7] = bfhi(w.w); }
__device__ __forceinline__ void phase_pool(const Frame& F, const bf16* U, bf16* PL) {
    for (int it = F.bid * 512 + F.tid; it < (T / 32) * 256; it += F.G * 512) {
        const int cv = it & 255, ch = it >> 8, col = cv * 8, w = 2 << (col >> 9);
        const int row0 = ch * 32, pos0 = row0 & (SEQ - 1);
        float s[8], uu[8];
#pragma unroll
        for (int j = 0; j < 8; ++j) s[j] = 0.f;
        for (int j = 1; j < w; ++j) if (pos0 - j >= 0) { unpack8(*(const v4u*)(U + (size_t)(row0 - j) * D + col), uu);
#pragma unroll
            for (int q = 0; q < 8; ++q) s[q] += uu[q]; }
        for (int r = 0; r < 32; ++r) {
            const int t = row0 + r, pos = pos0 + r;
            unpack8(*(const v4u*)(U + (size_t)t * D + col), uu);
            const float inv = 1.0f / (float)((pos + 1) < w ? (pos + 1) : w);
            float o[8];
#pragma unroll
            for (int q = 0; q < 8; ++q) { s[q] += uu[q]; o[q] = s[q] * inv - uu[q]; }
            v4u ww; ww.x = pk2(o[0], o[1]); ww.y = pk2(o[2], o[3]); ww.z = pk2(o[4], o[5]); ww.w = pk2(o[6], o[7]);
            *(v4u*)(PL + (size_t)t * D + col) = ww;
            if (pos - w + 1 >= 0) { unpack8(*(const v4u*)(U + (size_t)(t - w + 1) * D + col), uu);
#pragma unroll
                for (int q = 0; q < 8; ++q) s[q] -= uu[q]; }
        }
    }
}

__device__ __forceinline__ void phase_conv(const Frame& F, const bf16* UC, const bf16* BGp, const float* cw, bf16* Z) {
    for (int it = F.bid * 512 + F.tid; it < T * 256; it += F.G * 512) {
        const int cv = it & 255, t = it >> 8, col = cv * 8, pos = t & (SEQ - 1);
        float u0[8], u1[8], u2[8], bb[8], o[8];
        unpack8(*(const v4u*)(UC + (size_t)t * D + col), u2);
        if (pos >= 1) unpack8(*(const v4u*)(UC + (size_t)(t - 1) * D + col), u1); else {
#pragma unroll
            for (int q = 0; q < 8; ++q) u1[q] = 0.f; }
        if (pos >= 2) unpack8(*(const v4u*)(UC + (size_t)(t - 2) * D + col), u0); else {
#pragma unroll
            for (int q = 0; q < 8; ++q) u0[q] = 0.f; }
        unpack8(*(const v4u*)(BGp + (size_t)t * D + col), bb);
#pragma unroll
        for (int q = 0; q < 8; ++q) o[q] = bb[q] * (cw[col + q] * u0[q] + cw[D + col + q] * u1[q] + cw[2 * D + col + q] * u2[q]);
        v4u ww; ww.x = pk2(o[0], o[1]); ww.y = pk2(o[2], o[3]); ww.z = pk2(o[4], o[5]); ww.w = pk2(o[6], o[7]);
        *(v4u*)(Z + (size_t)t * D + col) = ww;
    }
}

__device__ __forceinline__ int t5_bucket(int dist) {
    if (dist < 16) return dist;
    int large = 16 + (int)(logf((float)dist / 16.0f) / logf(128.0f) * 16.0f);
    return large < 31 ? large : 31;
}
constexpr int AT_KS = 0, AT_KSTR = 144, AT_VT = 256 * 144, AT_VSTR = 520, AT_BIAS = AT_VT + 64 * 520;
__device__ __forceinline__ void phase_attn(const Frame& F, const bf16* QKV, const float* relb, bf16* OG, float* LSE) {
    LAS unsigned char* lds = F.lds;
    const int tid = F.tid, lane = F.lane, w = tid >> 6, fr = lane & 15, fq = lane >> 4;
    for (int unit = F.bid; unit < NBATCH * 3 * 8 * 16; unit += F.G) {
        const int cmb = unit & 15, h = (unit >> 4) & 7, g = (unit >> 7) % 3, b = unit / 384;
        const int dsh = 2 * g, dil = 1 << dsh, r = cmb & (dil - 1), nb = cmb >> dsh;
        const bf16* base = QKV + (size_t)b * SEQ * QKVC + g * 1536 + h * 64;
        __syncthreads();
        {
            const int key = tid >> 1, half = tid & 1, jk = (nb - 1) * 128 + key;
            v4u kv[4], vv[4];
            if (jk >= 0) { const bf16* rp = base + (size_t)(jk * dil + r) * QKVC + half * 32;
#pragma unroll
                for (int i = 0; i < 4; ++i) { kv[i] = *(const v4u*)(rp + 512 + 8 * i); vv[i] = *(const v4u*)(rp + 1024 + 8 * i); } }
            else {
#pragma unroll
                for (int i = 0; i < 4; ++i) { kv[i] = (v4u){0u, 0u, 0u, 0u}; vv[i] = (v4u){0u, 0u, 0u, 0u}; } }
#pragma unroll
            for (int i = 0; i < 4; ++i) *(LAS v4u*)(lds + AT_KS + key * AT_KSTR + half * 64 + 16 * i) = kv[i];
#pragma unroll
            for (int i = 0; i < 4; ++i) {
                const unsigned ww[4] = {vv[i].x, vv[i].y, vv[i].z, vv[i].w};
#pragma unroll
                for (int q = 0; q < 4; ++q) { const int d = half * 32 + 8 * i + 2 * q;
                    *(LAS unsigned short*)(lds + AT_VT + d * AT_VSTR + key * 2) = (unsigned short)(ww[q] & 0xffffu);
                    *(LAS unsigned short*)(lds + AT_VT + (d + 1) * AT_VSTR + key * 2) = (unsigned short)(ww[q] >> 16); } }
            if (tid <= 128) ((LAS float*)(lds + AT_BIAS))[tid] = relb[t5_bucket(tid * dil) * 24 + g * 8 + h];
        }
        __syncthreads();
        int qi = 16 * w + fr; asm volatile("" : "+v"(qi));
        const int jq = nb * 128 + qi, tq = jq * dil + r;
        const bf16* qp = base + (size_t)tq * QKVC + 8 * fq;
        const bf16x8 q0 = *(const bf16x8*)qp, q1 = *(const bf16x8*)(qp + 32);
        f32x4 s[9]; float mx = -INFINITY;
#pragma unroll
        for (int kt = 0; kt < 9; ++kt) {
            const int kb = 16 * (w + kt);
            const bf16x8 k0 = *(const LAS bf16x8*)(lds + AT_KS + (kb + fr) * AT_KSTR + fq * 16), k1 = *(const LAS bf16x8*)(lds + AT_KS + (kb + fr) * AT_KSTR + 64 + fq * 16);
            f32x4 a = (f32x4){0.f, 0.f, 0.f, 0.f};
            a = __builtin_amdgcn_mfma_f32_16x16x32_bf16(k0, q0, a, 0, 0, 0);
            a = __builtin_amdgcn_mfma_f32_16x16x32_bf16(k1, q1, a, 0, 0, 0);
#pragma unroll
            for (int i = 0; i < 4; ++i) { const int kl = kb + 4 * fq + i, rel = qi + 128 - kl;
                const bool ok = (rel >= 0) && (rel <= 128) && (nb > 0 || kl >= 128);
                const int rc = rel < 0 ? 0 : (rel > 128 ? 128 : rel);
                const float v = ok ? a[i] + ((LAS float*)(lds + AT_BIAS))[rc] : -INFINITY;
                a[i] = v; mx = fmaxf(mx, v); }
            s[kt] = a;
        }
        mx = fmaxf(mx, shfl_x(mx, 16, lane)); mx = fmaxf(mx, shfl_x(mx, 32, lane));
        float l = 0.f;
#pragma unroll
        for (int kt = 0; kt < 9; ++kt)
#pragma unroll
            for (int i = 0; i < 4; ++i) { const float p = __expf(s[kt][i] - mx); s[kt][i] = p; l += p; }
        l += shfl_x(l, 16, lane); l += shfl_x(l, 32, lane);
        f32x4 o[4];
#pragma unroll
        for (int nt = 0; nt < 4; ++nt) o[nt] = (f32x4){0.f, 0.f, 0.f, 0.f};
#pragma unroll
        for (int st = 0; st < 5; ++st) {
            const int kt0 = 2 * st, kt1 = 2 * st + 1;
            v4u pw; pw.x = pk2(s[kt0][0], s[kt0][1]); pw.y = pk2(s[kt0][2], s[kt0][3]);
            if (kt1 < 9) { pw.z = pk2(s[kt1 < 9 ? kt1 : 0][0], s[kt1 < 9 ? kt1 : 0][1]); pw.w = pk2(s[kt1 < 9 ? kt1 : 0][2], s[kt1 < 9 ? kt1 : 0][3]); } else { pw.z = 0u; pw.w = 0u; }
            const bf16x8 pf = __builtin_bit_cast(bf16x8, pw);
            const int kb0 = 16 * (w + kt0) + 4 * fq, kb1 = 16 * (w + kt1) + 4 * fq;
#pragma unroll
            for (int nt = 0; nt < 4; ++nt) { const int d = 16 * nt + fr;
                v2u va = *(const LAS v2u*)(lds + AT_VT + d * AT_VSTR + kb0 * 2), vb = (v2u){0u, 0u};
                if (kt1 < 9) vb = *(const LAS v2u*)(lds + AT_VT + d * AT_VSTR + kb1 * 2);
                v4u vw; vw.x = va.x; vw.y = va.y; vw.z = vb.x; vw.w = vb.y;
                o[nt] = __builtin_amdgcn_mfma_f32_16x16x32_bf16(__builtin_bit_cast(bf16x8, vw), pf, o[nt], 0, 0, 0); }
        }
        const float il = 1.0f / l;
        bf16* op = OG + ((size_t)g * T + (size_t)b * SEQ + tq) * DILW + h * 64 + 4 * fq;
#pragma unroll
        for (int nt = 0; nt < 4; ++nt) { v2u ww; ww.x = pk2(o[nt][0] * il, o[nt][1] * il); ww.y = pk2(o[nt][2] * il, o[nt][3] * il); *(v2u*)(op + 16 * nt) = ww; }
        if (fq == 0) LSE[((size_t)g * T + (size_t)b * SEQ + tq) * 8 + h] = mx + logf(l);
    }
}
__device__ __forceinline__ void phase_combine(const Frame& F, const bf16* OG, const float* LSE, bf16* O) {
    for (int it = F.bid * 512 + F.tid; it < T * 64; it += F.G * 512) {
        const int c8 = it & 7, h = (it >> 3) & 7, t = it >> 6;
        const float l0 = LSE[((size_t)0 * T + t) * 8 + h], l1 = LSE[((size_t)1 * T + t) * 8 + h], l2 = LSE[((size_t)2 * T + t) * 8 + h];
        const float m = fmaxf(l0, fmaxf(l1, l2)); float w0 = __expf(l0 - m), w1 = __expf(l1 - m), w2 = __expf(l2 - m); const float inv = 1.0f / (w0 + w1 + w2); w0 *= inv; w1 *= inv; w2 *= inv;
        float a[8], bq[8], c[8], o[8]; const size_t off = (size_t)t * DILW + h * 64 + c8 * 8;
        unpack8(*(const v4u*)(OG + off), a); unpack8(*(const v4u*)(OG + (size_t)T * DILW + off), bq); unpack8(*(const v4u*)(OG + (size_t)2 * T * DILW + off), c);
#pragma unroll
        for (int q = 0; q < 8; ++q) o[q] = w0 * a[q] + w1 * bq[q] + w2 * c[q];
        v4u ww; ww.x = pk2(o[0], o[1]); ww.y = pk2(o[2], o[3]); ww.z = pk2(o[4], o[5]); ww.w = pk2(o[6], o[7]);
        *(v4u*)(O + off) = ww;
    }
}

constexpr int M1_LOG = 131072, M1_STAT = M1_LOG + 4096, M1_HIST = M1_STAT + 128, M1_BASE = M1_HIST + 256;
__device__ __forceinline__ void phase_moe1(const Frame& F, const float* Y, const float* gain, const float* bias, const float* RW, const float* RB,
                                           float* X1F, bf16* X1B, unsigned* cnt, int* ltok, float* lgate, int* eidx, int* inv) {
    LAS float* xs = (LAS float*)F.lds; LAS float* logit = (LAS float*)(F.lds + M1_LOG); LAS float* stat = (LAS float*)(F.lds + M1_STAT);
    LAS int* hist = (LAS int*)(F.lds + M1_HIST); LAS int* basep = (LAS int*)(F.lds + M1_BASE);
    const int tid = F.tid, lane = F.lane, w = F.wave;
    for (int rg = F.bid; rg < T / 16; rg += F.G) {
        const int row0 = rg * 16;
        __syncthreads();
#pragma unroll
        for (int j = 0; j < 16; ++j) { const int idx = tid + 512 * j; *(LAS f32x4*)(xs + idx * 4) = *(const f32x4*)(Y + (size_t)row0 * D + (size_t)idx * 4); }
        if (tid < 64) hist[tid] = 0;
        __syncthreads();
#pragma unroll
        for (int rr = 0; rr < 2; ++rr) { const int r = 2 * w + rr; float sm = 0.f;
#pragma unroll
            for (int j = 0; j < 32; ++j) sm += xs[r * D + lane + 64 * j];
            const float mean = wave_sum(sm, lane) * (1.0f / D); float sq = 0.f;
#pragma unroll
            for (int j = 0; j < 32; ++j) { const float d = xs[r * D + lane + 64 * j] - mean; sq += d * d; }
            const float rstd = 1.0f / sqrtf(wave_sum(sq, lane) * (1.0f / D) + LN_EPS);
            if (lane == 0) { stat[2 * r] = mean; stat[2 * r + 1] = rstd; } }
        __syncthreads();
#pragma unroll
        for (int j = 0; j < 16; ++j) { const int idx = tid + 512 * j, r = idx >> 9, c4 = (idx & 511) * 4;
            const f32x4 v = *(LAS f32x4*)(xs + idx * 4), gv = *(const f32x4*)(gain + c4), bv = *(const f32x4*)(bias + c4);
            const float mean = stat[2 * r], rstd = stat[2 * r + 1];
            const f32x4 o = (v - mean) * rstd * gv + bv;
            *(LAS f32x4*)(xs + idx * 4) = o;
            *(f32x4*)(X1F + (size_t)(row0 + r) * D + c4) = o;
            v2u wb; wb.x = pk2(o[0], o[1]); wb.y = pk2(o[2], o[3]); *(v2u*)(X1B + (size_t)(row0 + r) * D + c4) = wb; }
        __syncthreads();
        { const int r = tid >> 5, ep = tid & 31; float a0 = 0.f, a1 = 0.f; const float* wp = RW + 2 * ep; const LAS float* xr = xs + r * D;
            for (int k0 = 0; k0 < D; k0 += 16) {
                f32x2 wv[16];
#pragma unroll
                for (int j = 0; j < 16; ++j) wv[j] = *(const f32x2*)(wp + (size_t)(k0 + j) * NEXP);
                asm volatile("" : "+v"(wv[0]), "+v"(wv[1]), "+v"(wv[2]), "+v"(wv[3]), "+v"(wv[4]), "+v"(wv[5]), "+v"(wv[6]), "+v"(wv[7]));
                asm volatile("" : "+v"(wv[8]), "+v"(wv[9]), "+v"(wv[10]), "+v"(wv[11]), "+v"(wv[12]), "+v"(wv[13]), "+v"(wv[14]), "+v"(wv[15]));
#pragma unroll
                for (int j = 0; j < 16; ++j) { const float xv = xr[k0 + j]; a0 += xv * wv[j].x; a1 += xv * wv[j].y; } }
            logit[r * NEXP + 2 * ep] = a0; logit[r * NEXP + 2 * ep + 1] = a1; }
        __syncthreads();
        int sel_pos[2]; float sel_gate[2]; int sel_rank[2]; bool sel_on[2];
#pragma unroll
        for (int rr = 0; rr < 2; ++rr) { const int r = 2 * w + rr;
            const float sc = 1.0f / (1.0f + __expf(-logit[r * NEXP + lane])); const float ch = sc + RB[lane];
            int rk = 0;
#pragma unroll
            for (int j = 0; j < 8; ++j) { const float cj = shfl_from(ch, (lane & ~7) + j); rk += (cj > ch || (cj == ch && j < (lane & 7))) ? 1 : 0; }
            float gs = rk < 2 ? ch : 0.f; gs += shfl_x(gs, 1, lane); gs += shfl_x(gs, 2, lane); gs += shfl_x(gs, 4, lane);
            int grk = 0; const int g = lane >> 3;
#pragma unroll
            for (int hh = 0; hh < 8; ++hh) { const float gh = shfl_from(gs, 8 * hh); grk += (gh > gs || (gh == gs && hh < g)) ? 1 : 0; }
            const float msk = grk < 4 ? ch : -INFINITY;
            int erk = 0;
            for (int j = 0; j < 64; ++j) { const float mj = __builtin_bit_cast(float, __builtin_amdgcn_readlane(__builtin_bit_cast(int, msk), j)); erk += (mj > msk || (mj == msk && j < lane)) ? 1 : 0; }
            const bool on = erk < 8;
            const float ssum = wave_sum(on ? sc : 0.f, lane);
            sel_on[rr] = on; sel_rank[rr] = erk; sel_gate[rr] = sc / ssum * 2.5f; sel_pos[rr] = 0;
            if (on) sel_pos[rr] = __hip_atomic_fetch_add(&hist[lane], 1, __ATOMIC_RELAXED, __HIP_MEMORY_SCOPE_WORKGROUP); }
        __syncthreads();
        if (tid < 64) { const int hc = hist[tid]; int bs = 0; if (hc > 0) bs = (int)atomicAdd(&cnt[tid * 16], (unsigned)hc); basep[tid] = bs; }
        __syncthreads();
#pragma unroll
        for (int rr = 0; rr < 2; ++rr) if (sel_on[rr]) { const int t = row0 + 2 * w + rr, pos = basep[lane] + sel_pos[rr];
            ltok[(size_t)lane * CAP + pos] = t; lgate[(size_t)lane * CAP + pos] = sel_gate[rr];
            eidx[t * 8 + sel_rank[rr]] = lane; inv[t * 8 + sel_rank[rr]] = pos; }
    }
}
__device__ __forceinline__ int build_tiles(const Frame& F, const unsigned* cnt) {
    LAS int* tpref = (LAS int*)(F.lds + LDS_TAB); LAS int* cl = (LAS int*)(F.lds + LDS_TAB + 512);
    __syncthreads();
    if (F.tid < 64) cl[F.tid] = (int)__hip_atomic_load(&cnt[F.tid * 16], __ATOMIC_RELAXED, __HIP_MEMORY_SCOPE_AGENT);
    __syncthreads();
    if (F.tid == 0) { int acc = 0; for (int e = 0; e < 64; ++e) { tpref[e] = acc; acc += (cl[e] + 255) >> 8; } tpref[64] = acc; tpref[65] = acc + T / 256; tpref[66] = acc + 2 * (T / 256); cl[64] = T; cl[65] = T; }
    __syncthreads();
    return __builtin_amdgcn_readfirstlane(tpref[64]);
}
__device__ __forceinline__ void phase_moe4(const Frame& F, const float* Y2, const bf16* Yr, const int* eidx, const int* inv, const float* gain, const float* bias, float* XO, bf16* XBo) {
    const LAS int* tpref = (const LAS int*)(F.lds + LDS_TAB);
    const int gw = F.bid * 8 + F.wave, NGW = F.G * 8, lane = F.lane;
    for (int t = gw; t < T; t += NGW) {
        f32x4 v[8];
#pragma unroll
        for (int j = 0; j < 8; ++j) v[j] = *(const f32x4*)(Y2 + (size_t)t * D + 4 * lane + 256 * j);
        for (int k = 0; k < 8; ++k) { const int e = eidx[t * 8 + k], pos = inv[t * 8 + k]; const bf16* yr = Yr + (size_t)(tpref[e] * 256 + pos) * D + 4 * lane;
#pragma unroll
            for (int j = 0; j < 8; ++j) { const v2u w = *(const v2u*)(yr + 256 * j); v[j][0] += bflo(w.x); v[j][1] += bfhi(w.x); v[j][2] += bflo(w.y); v[j][3] += bfhi(w.y); } }
        float sm = 0.f;
#pragma unroll
        for (int j = 0; j < 8; ++j) sm += (v[j][0] + v[j][1]) + (v[j][2] + v[j][3]);
        const float mean = wave_sum(sm, lane) * (1.0f / D); float sq = 0.f;
#pragma unroll
        for (int j = 0; j < 8; ++j) { v[j] = v[j] - mean; sq += (v[j][0] * v[j][0] + v[j][1] * v[j][1]) + (v[j][2] * v[j][2] + v[j][3] * v[j][3]); }
        const float rstd = 1.0f / sqrtf(wave_sum(sq, lane) * (1.0f / D) + LN_EPS);
#pragma unroll
        for (int j = 0; j < 8; ++j) { const int c = 4 * lane + 256 * j; const f32x4 o = v[j] * rstd * *(const f32x4*)(gain + c) + *(const f32x4*)(bias + c);
            *(f32x4*)(XO + (size_t)t * D + c) = o;
            v2u wb; wb.x = pk2(o[0], o[1]); wb.y = pk2(o[2], o[3]); *(v2u*)(XBo + (size_t)t * D + c) = wb; }
    }
}


constexpr int M1_P = 0, M1N_HIST = 131072, M1N_BASE = 131072 + 256, M1N_GB = 131072 + 1024;
__device__ __forceinline__ void phase_moe1n(const Frame& F, const bf16* Y, const float* pst, const float* gain, const float* bias, const bf16* WH, const bf16* WL, const float* RB,
                                            bf16* X1B, float* ST1, unsigned* cnt, int* ltok, float* lgate, int* eidx, int* inv) {
    LAS float* P = (LAS float*)(F.lds + M1_P); LAS int* hist = (LAS int*)(F.lds + M1N_HIST); LAS int* basep = (LAS int*)(F.lds + M1N_BASE);
    const int tid = F.tid, lane = F.lane, w = F.wave, r = lane & 15, q = lane >> 4;
    for (int item = F.bid; item < T / 64; item += F.G) {
        const int row0 = item * 64;
        __syncthreads();
        if (tid < 64) hist[tid] = 0;
        { LAS f32x4* gb = (LAS f32x4*)(F.lds + M1N_GB); gb[tid] = *(const f32x4*)(gain + 4 * tid); gb[512 + tid] = *(const f32x4*)(bias + 4 * tid); }
        __syncthreads();
        float mean[4], rstd[4];
#pragma unroll
        for (int rt = 0; rt < 4; ++rt) { const int row = row0 + 16 * rt + r;
          const f32x4* pp = (const f32x4*)(pst + ((size_t)row * 32 + q * 8) * 2); const f32x4 a = pp[0], b = pp[1], c = pp[2], d = pp[3];
          float sm = (a[0] + a[2]) + (b[0] + b[2]) + (c[0] + c[2]) + (d[0] + d[2]), sq = (a[1] + a[3]) + (b[1] + b[3]) + (c[1] + c[3]) + (d[1] + d[3]);
          sm += shfl_x(sm, 16, lane); sm += shfl_x(sm, 32, lane); sq += shfl_x(sq, 16, lane); sq += shfl_x(sq, 32, lane);
          mean[rt] = sm * (1.0f / D); const float var = fmaxf(sq * (1.0f / D) - mean[rt] * mean[rt], 0.f); rstd[rt] = 1.0f / sqrtf(var + LN_EPS);
          if (w == 0 && q == 0) *(f32x2*)(ST1 + 2 * row) = (f32x2){mean[rt], rstd[rt]}; }
        const int kb = 256 * w + 8 * q;
        const LAS float* gl = (const LAS float*)(F.lds + M1N_GB) + kb;
        f32x4 acc[4][4];
#pragma unroll
        for (int rt = 0; rt < 4; ++rt)
#pragma unroll
            for (int nt = 0; nt < 4; ++nt) acc[rt][nt] = (f32x4){0.f, 0.f, 0.f, 0.f};
        v4u yb[3][4]; bf16x8 wh[4], wl[4];
        unsigned vo[4];
#pragma unroll
        for (int i = 0; i < 4; ++i) { vo[i] = (unsigned)(r * D + kb) * 2u + (unsigned)i * (16u * D * 2u); asm volatile("" : "+v"(vo[i])); }
        const char* ybase = (const char*)(Y + (size_t)row0 * D); char* xbase = (char*)(X1B + (size_t)row0 * D);
#define M1_LOADY(st) do { _Pragma("unroll") for (int rt = 0; rt < 4; ++rt) yb[(st) % 3][rt] = *(const v4u*)(ybase + vo[rt] + 64 * (st)); } while (0)
#define M1_LOADW(st) do { _Pragma("unroll") for (int nt = 0; nt < 4; ++nt) { wh[nt] = *(const bf16x8*)((const char*)WH + vo[nt] + 64 * (st)); wl[nt] = *(const bf16x8*)((const char*)WL + vo[nt] + 64 * (st)); } } while (0)
        M1_LOADY(0); M1_LOADW(0); M1_LOADY(1);
        __builtin_amdgcn_sched_barrier(0);
#pragma unroll
        for (int st = 0; st < 8; ++st) {
            const f32x4 g0 = *(const LAS f32x4*)(gl + 32 * st), g1 = *(const LAS f32x4*)(gl + 32 * st + 4), b0 = *(const LAS f32x4*)(gl + 2048 + 32 * st), b1 = *(const LAS f32x4*)(gl + 2048 + 32 * st + 4);
#pragma unroll
            for (int rt = 0; rt < 4; ++rt) { const v4u yv = yb[st % 3][rt];
                const f32x4 y0_ = (f32x4){bflo(yv.x), bfhi(yv.x), bflo(yv.y), bfhi(yv.y)}, y1_ = (f32x4){bflo(yv.z), bfhi(yv.z), bflo(yv.w), bfhi(yv.w)};
                const f32x4 x0 = (y0_ - mean[rt]) * rstd[rt] * g0 + b0, x1 = (y1_ - mean[rt]) * rstd[rt] * g1 + b1;
                v4u h; h.x = cvt_pk_bf16(x0[0], x0[1]); h.y = cvt_pk_bf16(x0[2], x0[3]); h.z = cvt_pk_bf16(x1[0], x1[1]); h.w = cvt_pk_bf16(x1[2], x1[3]);
                *(v4u*)(xbase + vo[rt] + 64 * st) = h;
                v4u l; l.x = cvt_pk_bf16(x0[0] - bflo(h.x), x0[1] - bfhi(h.x)); l.y = cvt_pk_bf16(x0[2] - bflo(h.y), x0[3] - bfhi(h.y));
                l.z = cvt_pk_bf16(x1[0] - bflo(h.z), x1[1] - bfhi(h.z)); l.w = cvt_pk_bf16(x1[2] - bflo(h.w), x1[3] - bfhi(h.w));
                const bf16x8 xh = __builtin_bit_cast(bf16x8, h), xl = __builtin_bit_cast(bf16x8, l);
#pragma unroll
                for (int nt = 0; nt < 4; ++nt) { acc[rt][nt] = __builtin_amdgcn_mfma_f32_16x16x32_bf16(xh, wh[nt], acc[rt][nt], 0, 0, 0);
                    acc[rt][nt] = __builtin_amdgcn_mfma_f32_16x16x32_bf16(xl, wh[nt], acc[rt][nt], 0, 0, 0); acc[rt][nt] = __builtin_amdgcn_mfma_f32_16x16x32_bf16(xh, wl[nt], acc[rt][nt], 0, 0, 0); } }
            __builtin_amdgcn_sched_barrier(0);
            if (st + 1 < 8) M1_LOADW(st + 1);
            if (st + 2 < 8) M1_LOADY(st + 2);
            __builtin_amdgcn_sched_barrier(0);
        }
#undef M1_LOADY
#undef M1_LOADW
#pragma unroll
        for (int rt = 0; rt < 4; ++rt)
#pragma unroll
            for (int nt = 0; nt < 4; ++nt)
#pragma unroll
                for (int i = 0; i < 4; ++i) P[(w * 64 + 16 * rt + 4 * q + i) * 64 + 16 * nt + r] = acc[rt][nt][i];
        __syncthreads();
        int sel_pos[8]; float sel_gate[8]; int sel_rank[8]; bool sel_on[8];
        const float rb = RB[lane];
#pragma unroll
        for (int rr = 0; rr < 8; ++rr) { const int rl = 8 * w + rr;
            float lg = ((P[rl * 64 + lane] + P[(64 + rl) * 64 + lane]) + (P[(128 + rl) * 64 + lane] + P[(192 + rl) * 64 + lane])) + ((P[(256 + rl) * 64 + lane] + P[(320 + rl) * 64 + lane]) + (P[(384 + rl) * 64 + lane] + P[(448 + rl) * 64 + lane]));
            lg = (lg == lg) ? lg : -1.0e30f;
            const float sc = 1.0f / (1.0f + __expf(-lg)); const float ch = sc + rb;
            int rk = 0;
#pragma unroll
            for (int j = 0; j < 8; ++j) { const float cj = shfl_from(ch, (lane & ~7) + j); rk += (cj > ch || (cj == ch && j < (lane & 7))) ? 1 : 0; }
            float gs = rk < 2 ? ch : 0.f; gs += shfl_x(gs, 1, lane); gs += shfl_x(gs, 2, lane); gs += shfl_x(gs, 4, lane);
            int grk = 0; const int g = lane >> 3;
#pragma unroll
            for (int hh = 0; hh < 8; ++hh) { const float gh = shfl_from(gs, 8 * hh); grk += (gh > gs || (gh == gs && hh < g)) ? 1 : 0; }
            const float msk = grk < 4 ? ch : -INFINITY;
            int erk = 0;
            for (int j = 0; j < 64; ++j) { const float mj = __builtin_bit_cast(float, __builtin_amdgcn_readlane(__builtin_bit_cast(int, msk), j)); erk += (mj > msk || (mj == msk && j < lane)) ? 1 : 0; }
            const bool on = erk < 8;
            const float ssum = wave_sum(on ? sc : 0.f, lane);
            sel_on[rr] = on; sel_rank[rr] = erk; sel_gate[rr] = sc / ssum * 2.5f; sel_pos[rr] = 0;
            if (on) sel_pos[rr] = __hip_atomic_fetch_add(&hist[lane], 1, __ATOMIC_RELAXED, __HIP_MEMORY_SCOPE_WORKGROUP); }
        __syncthreads();
        if (tid < 64) { int tt = tid; asm volatile("" : "+v"(tt));
            const int hc = hist[tt]; int bs = 0; if (hc > 0) bs = (int)atomicAdd(&cnt[tt * 16], (unsigned)hc); basep[tt] = bs; }
        __syncthreads();
#pragma unroll
        for (int rr = 0; rr < 8; ++rr) if (sel_on[rr]) { const int t = row0 + 8 * w + rr, pos = basep[lane] + sel_pos[rr];
            ltok[(size_t)lane * CAP + pos] = t * 8 + sel_rank[rr]; lgate[(size_t)lane * CAP + pos] = sel_gate[rr];
            eidx[t * 8 + sel_rank[rr]] = lane; inv[t * 8 + sel_rank[rr]] = pos; }
    }
}

constexpr int M3_PL = 131072, M3_CNT = 147456, M3_OFF = 147456 + 272;
__device__ __forceinline__ void phase_moe3n(const Frame& F, const bf16* H, const bf16* HSp, const int* eidx, const bf16* WD, const bf16* WSD,
                                            const float* Y1, const float* ST1, const float* g1, const float* b1, float* Y2, float* PST2) {
    LAS int* out = (LAS int*)F.lds; LAS unsigned short* plist = (LAS unsigned short*)(F.lds + M3_PL); LAS int* cnt = (LAS int*)(F.lds + M3_CNT); LAS int* off = (LAS int*)(F.lds + M3_OFF);
    const int tid = F.tid, lane = F.lane, w = F.wave, r = lane & 15, q = lane >> 4;
    for (int u = F.bid; u < 1024; u += F.G) {
        int nc = (u & 7) | ((u >> 7) << 3), tb = (u >> 3) & 15;
        if (F.G == 256) { const int i = u >> 8, x = u & 7, j = (u >> 3) & 31; tb = 2 * x + (i >> 1); nc = 32 * (i & 1) + j; }
        __syncthreads();
#pragma unroll
        for (int j = 0; j < 16; ++j) ((LAS v4u*)out)[tid + 512 * j] = (v4u){0u, 0u, 0u, 0u};
        if (tid < 66) cnt[tid] = 0;
        __syncthreads();
        int ee[16], pp[16];
        { const v4u* ep = (const v4u*)(eidx + ((size_t)tb * 1024 + 2 * tid) * 8); const v4u e0 = ep[0], e1 = ep[1], e2 = ep[2], e3 = ep[3];
          ee[0] = e0.x; ee[1] = e0.y; ee[2] = e0.z; ee[3] = e0.w; ee[4] = e1.x; ee[5] = e1.y; ee[6] = e1.z; ee[7] = e1.w;
          ee[8] = e2.x; ee[9] = e2.y; ee[10] = e2.z; ee[11] = e2.w; ee[12] = e3.x; ee[13] = e3.y; ee[14] = e3.z; ee[15] = e3.w; }
#pragma unroll
        for (int j = 0; j < 16; ++j) pp[j] = __hip_atomic_fetch_add(&cnt[ee[j]], 1, __ATOMIC_RELAXED, __HIP_MEMORY_SCOPE_WORKGROUP);
        __syncthreads();
        if (w == 0) { int c = cnt[lane], x = c;
#pragma unroll
            for (int o = 1; o < 64; o <<= 1) { const int y = __builtin_amdgcn_ds_bpermute(((lane - o) & 63) << 2, x); if (lane >= o) x += y; }
            off[lane] = x - c; if (lane == 63) off[64] = x; }
        __syncthreads();
#pragma unroll
        for (int j = 0; j < 16; ++j) plist[off[ee[j]] + pp[j]] = (unsigned short)(tid * 16 + j);
        __syncthreads();
        const char* Hb = (const char*)H + (size_t)tb * 8192 * 256 + q * 16;
        const char* HSb = (const char*)HSp + (size_t)tb * 1024 * 512 + q * 16;
        const char* Bb = (const char*)WD + ((size_t)nc * 32 + r) * 256 + q * 16;
        const char* BSb = (const char*)WSD + ((size_t)nc * 32 + r) * 512 + q * 16;
#define M3_NR(sg) ((sg) < 8 ? __builtin_amdgcn_readfirstlane(cnt[w + 8 * (sg)]) : 128)
#define M3_RB(sg) ((sg) < 8 ? __builtin_amdgcn_readfirstlane(off[w + 8 * (sg)]) : 0)
#define M3_GLD(dst, ptr, OFF) asm volatile("global_load_dwordx4 %0, %1, off offset:" #OFF : "=&v"(dst) : "v"(ptr) : "memory")
#define M3_LOADB(dst, sg) do { const char* _b0 = (sg) < 8 ? Bb + (size_t)(w + 8 * (sg)) * 524288 : BSb + ((sg) - 8) * 256; const char* _b1 = _b0 + ((sg) < 8 ? 4096 : 8192); \
            M3_GLD(dst[0][0], _b0, 0); M3_GLD(dst[0][1], _b0, 64); M3_GLD(dst[0][2], _b0, 128); M3_GLD(dst[0][3], _b0, 192); \
            M3_GLD(dst[1][0], _b1, 0); M3_GLD(dst[1][1], _b1, 64); M3_GLD(dst[1][2], _b1, 128); M3_GLD(dst[1][3], _b1, 192); } while (0)
#define M3_LOADA(dst, sg, bb, nr, rbs) do { int _i = 16 * (bb) + r; _i = _i < (nr) ? _i : (nr) - 1; const unsigned _rid = plist[(rbs) + _i]; \
            const char* _a = (sg) < 8 ? Hb + (size_t)_rid * 256 : ((sg) < 10 ? HSb + (size_t)(128 * w + _i) * 512 + ((sg) - 8) * 256 : Hb); \
            M3_GLD(dst[0], _a, 0); M3_GLD(dst[1], _a, 64); M3_GLD(dst[2], _a, 128); M3_GLD(dst[3], _a, 192); } while (0)
#define M3_ADV(sg, bb, nr, rbs) do { if ((sg) < 10) { ++(bb); if ((bb) * 16 >= (nr)) { (bb) = 0; do { ++(sg); } while ((sg) < 8 && M3_NR(sg) == 0); if ((sg) < 10) { (nr) = M3_NR(sg); (rbs) = M3_RB(sg); } } } } while (0)
#define M3_WAITA(AS) asm volatile("s_waitcnt vmcnt(12)" : "+v"(AS[0]), "+v"(AS[1]), "+v"(AS[2]), "+v"(AS[3]) :: "memory")
#define M3_WAITB(N) asm volatile("s_waitcnt vmcnt(" #N ")" : "+v"(Bn[0][0]), "+v"(Bn[0][1]), "+v"(Bn[0][2]), "+v"(Bn[0][3]), "+v"(Bn[1][0]), "+v"(Bn[1][1]), "+v"(Bn[1][2]), "+v"(Bn[1][3]) :: "memory")
#define M3_STEP(AS) if (cseg < 10) { \
              \
            int tk[4]; bool ok[4]; unsigned pl[4]; const int rt_ = cseg < 8; \
            _Pragma("unroll") for (int i = 0; i < 4; ++i) { const int idx = 16 * cbt + 4 * q + i; ok[i] = idx < cnr; const int ic = ok[i] ? idx : cnr - 1; pl[i] = plist[crbs + ic]; tk[i] = 128 * w + ic; } \
            _Pragma("unroll") for (int i = 0; i < 4; ++i) tk[i] = rt_ ? (int)(pl[i] >> 3) : tk[i]; \
            M3_WAITA(AS); \
            f32x4 acc[2]; \
            _Pragma("unroll") for (int nt = 0; nt < 2; ++nt) { acc[nt] = (f32x4){0.f, 0.f, 0.f, 0.f}; \
                _Pragma("unroll") for (int kk = 0; kk < 4; ++kk) acc[nt] = __builtin_amdgcn_mfma_f32_16x16x32_bf16(__builtin_bit_cast(bf16x8, AS[kk]), __builtin_bit_cast(bf16x8, Bc[nt][kk]), acc[nt], 0, 0, 0); } \
              \
            _Pragma("unroll") for (int i = 0; i < 4; ++i) { const long long lo_ = ok[i] ? (long long)__float2int_rn(acc[0][i] * 4194304.0f) : 0ll, hi_ = ok[i] ? (long long)__float2int_rn(acc[1][i] * 4194304.0f) : 0ll; \
                (void)__hip_atomic_fetch_add((LAS unsigned long long*)out + tk[i] * 16 + r, (unsigned long long)((hi_ << 32) + lo_), __ATOMIC_RELAXED, __HIP_MEMORY_SCOPE_WORKGROUP); } \
            M3_LOADA(AS, pseg, pbt, pnr, prbs); M3_ADV(pseg, pbt, pnr, prbs); \
            { const int old_ = cseg, nbat_ = (cnr + 15) >> 4; M3_ADV(cseg, cbt, cnr, crbs); \
              if (cseg != old_ && cseg < 10) { \
                  if (nbat_ == 1) M3_WAITB(4); else if (nbat_ == 2) M3_WAITB(8); else if (nbat_ == 3) M3_WAITB(12); else M3_WAITB(16); \
                  _Pragma("unroll") for (int nt = 0; nt < 2; ++nt) _Pragma("unroll") for (int kk = 0; kk < 4; ++kk) Bc[nt][kk] = Bn[nt][kk]; \
                  int nb_ = cseg; do { ++nb_; } while (nb_ < 8 && M3_NR(nb_) == 0); if (nb_ >= 10) nb_ = 9; M3_LOADB(Bn, nb_); } } }
        int cseg = -1, cbt = 0, cnr = 0, crbs = 0;
        do { ++cseg; } while (cseg < 8 && M3_NR(cseg) == 0);
        cnr = M3_NR(cseg); crbs = M3_RB(cseg);
        int pseg = cseg, pbt = 0, pnr = cnr, prbs = crbs;
        v4u Bc[2][4], Bn[2][4], A0[4], A1[4], A2[4], A3[4];
        M3_LOADB(Bc, cseg);
        M3_LOADA(A0, pseg, pbt, pnr, prbs); M3_ADV(pseg, pbt, pnr, prbs);
        M3_LOADA(A1, pseg, pbt, pnr, prbs); M3_ADV(pseg, pbt, pnr, prbs);
        M3_LOADA(A2, pseg, pbt, pnr, prbs); M3_ADV(pseg, pbt, pnr, prbs);
        M3_LOADA(A3, pseg, pbt, pnr, prbs); M3_ADV(pseg, pbt, pnr, prbs);
        { int nb_ = cseg; do { ++nb_; } while (nb_ < 8 && M3_NR(nb_) == 0); if (nb_ >= 10) nb_ = 9; M3_LOADB(Bn, nb_); }
        asm volatile("s_waitcnt vmcnt(0)" : "+v"(Bc[0][0]), "+v"(Bc[0][1]), "+v"(Bc[0][2]), "+v"(Bc[0][3]), "+v"(Bc[1][0]), "+v"(Bc[1][1]), "+v"(Bc[1][2]), "+v"(Bc[1][3]) :: "memory");
#pragma unroll 1
        while (cseg < 10) { M3_STEP(A0) M3_STEP(A1) M3_STEP(A2) M3_STEP(A3) }
        asm volatile("s_waitcnt vmcnt(0)" : "+v"(A0[0]), "+v"(A0[1]), "+v"(A0[2]), "+v"(A0[3]), "+v"(A1[0]), "+v"(A1[1]), "+v"(A1[2]), "+v"(A1[3]), "+v"(A2[0]), "+v"(A2[1]), "+v"(A2[2]), "+v"(A2[3]),
                     "+v"(A3[0]), "+v"(A3[1]), "+v"(A3[2]), "+v"(A3[3]), "+v"(Bn[0][0]), "+v"(Bn[0][1]), "+v"(Bn[0][2]), "+v"(Bn[0][3]), "+v"(Bn[1][0]), "+v"(Bn[1][1]), "+v"(Bn[1][2]), "+v"(Bn[1][3]) :: "memory");
#undef M3_NR
#undef M3_RB
#undef M3_GLD
#undef M3_LOADB
#undef M3_LOADA
#undef M3_ADV
#undef M3_WAITA
#undef M3_WAITB
#undef M3_STEP
        __syncthreads();
        { const int c4 = lane & 7, rs = lane >> 3, col = nc * 32 + 4 * c4;
          const f32x4 gv = *(const f32x4*)(g1 + col), bv = *(const f32x4*)(b1 + col);
#pragma unroll 4
          for (int it = 0; it < 16; ++it) { const int rl = 128 * w + 8 * it + rs; const size_t row = (size_t)tb * 1024 + rl;
              const f32x4 yv = *(const f32x4*)(Y1 + row * D + col); const f32x2 sv = *(const f32x2*)(ST1 + 2 * row);
              f32x4 tv; { const int nt = c4 >> 2, r0 = (4 * c4) & 15;
#pragma unroll
                  for (int j = 0; j < 4; ++j) { const v2u cell = *(const LAS v2u*)(out + rl * 32 + 2 * (r0 + j)); const int lo = (int)cell.x, hi = (int)cell.y + (lo < 0 ? 1 : 0); tv[j] = (float)(nt ? hi : lo) * (1.0f / 4194304.0f); } }
              const f32x4 y = ((yv - sv.x) * sv.y * gv + bv) * ALPHA + tv;
              *(f32x4*)(Y2 + row * D + col) = y;
              float sm = (y[0] + y[1]) + (y[2] + y[3]), sq = (y[0] * y[0] + y[1] * y[1]) + (y[2] * y[2] + y[3] * y[3]);
#pragma unroll
              for (int o = 1; o < 8; o <<= 1) { sm += shfl_x(sm, o, lane); sq += shfl_x(sq, o, lane); }
              if (c4 == 0) *(f32x2*)(PST2 + (row * 64 + nc) * 2) = (f32x2){sm, sq}; } }
    }
}

__device__ __forceinline__ void phase_moe4n(const Frame& F, const float* Y2, const float* pst, const float* gain, const float* bias, float* ST2, bf16* XBo, float* OUT, int last) {
    const int gw = F.bid * 8 + F.wave, NGW = F.G * 8, lane = F.lane;
    for (int t = gw; t < T; t += NGW) {
        f32x4 v[8];
#pragma unroll
        for (int j = 0; j < 8; ++j) v[j] = *(const f32x4*)(Y2 + (size_t)t * D + 4 * lane + 256 * j);
        const f32x2 pv = *(const f32x2*)(pst + ((size_t)t * 64 + lane) * 2);
        const float mean = wave_sum(pv.x, lane) * (1.0f / D); const float var = fmaxf(wave_sum(pv.y, lane) * (1.0f / D) - mean * mean, 0.f); const float rstd = 1.0f / sqrtf(var + LN_EPS);
        if (lane == 0) *(f32x2*)(ST2 + 2 * (size_t)t) = (f32x2){mean, rstd};
#pragma unroll
        for (int j = 0; j < 8; ++j) { const int c = 4 * lane + 256 * j; const f32x4 o = (v[j] - mean) * rstd * *(const f32x4*)(gain + c) + *(const f32x4*)(bias + c);
            if (last) *(f32x4*)(OUT + (size_t)t * D + c) = o;
            else { v2u wb; wb.x = pk2(o[0], o[1]); wb.y = pk2(o[2], o[3]); *(v2u*)(XBo + (size_t)t * D + c) = wb; } }
    }
}


__device__ __forceinline__ void phase_moe4q(const Frame& F, const bf16* X1, bf16* Y2, const unsigned char* Yq, const float* Ysc, const int* eidx, const int* inv, const float* gain, const float* bias, float* ST2, bf16* XBo, float* OUT, int last) {
    const LAS int* tpref = (const LAS int*)(F.lds + LDS_TAB);
    const int gw = F.bid * 8 + F.wave, NGW = F.G * 8, lane = F.lane;
    for (int t = gw; t < T; t += NGW) {
        int rowi = 0; if (lane < 8) { const int e = eidx[t * 8 + lane], ps = inv[t * 8 + lane]; rowi = tpref[e] * 256 + ps; } else if (lane < 10) rowi = tpref[56 + lane] * 256 + t;
        v4u pv[2][2], yv[10][2]; float sc[10][2];
#pragma unroll
        for (int j = 0; j < 2; ++j) { pv[j][0] = *(const v4u*)(X1 + (size_t)t * D + 16 * lane + 1024 * j); pv[j][1] = *(const v4u*)(X1 + (size_t)t * D + 16 * lane + 1024 * j + 8); }
#pragma unroll
        for (int k = 0; k < 10; ++k) { const size_t row = (size_t)__builtin_amdgcn_readlane(rowi, k);
#pragma unroll
            for (int j = 0; j < 2; ++j) { yv[k][j] = __builtin_nontemporal_load((const v4u*)(Yq + row * D + 16 * lane + 1024 * j)); sc[k][j] = Ysc[row * 16 + 8 * j + (lane >> 3)]; } }
#pragma unroll
        for (int k = 0; k < 10; ++k) asm volatile("" : "+v"(yv[k][0]), "+v"(yv[k][1]), "+v"(sc[k][0]), "+v"(sc[k][1]));
        float v[2][16];
#pragma unroll
        for (int j = 0; j < 2; ++j) { float f0[8], f1[8]; unpack8(pv[j][0], f0); unpack8(pv[j][1], f1);
            const float ss = (((sc[0][j] + sc[1][j]) + (sc[2][j] + sc[3][j])) + ((sc[4][j] + sc[5][j]) + (sc[6][j] + sc[7][j]))) + (sc[8][j] + sc[9][j]);
#pragma unroll
            for (int i = 0; i < 8; ++i) { v[j][i] = ALPHA * f0[i] - 128.f * ss; v[j][8 + i] = ALPHA * f1[i] - 128.f * ss; } }
#pragma unroll
        for (int k = 0; k < 10; ++k)
#pragma unroll
            for (int j = 0; j < 2; ++j) { const float s_ = sc[k][j]; const unsigned q[4] = {yv[k][j].x, yv[k][j].y, yv[k][j].z, yv[k][j].w};
#pragma unroll
                for (int d = 0; d < 4; ++d) { v[j][4 * d + 0] += s_ * (float)(q[d] & 0xffu); v[j][4 * d + 1] += s_ * (float)((q[d] >> 8) & 0xffu); v[j][4 * d + 2] += s_ * (float)((q[d] >> 16) & 0xffu); v[j][4 * d + 3] += s_ * (float)(q[d] >> 24); } }
        float sm = 0.f;
#pragma unroll
        for (int j = 0; j < 2; ++j)
#pragma unroll
            for (int i = 0; i < 16; i += 4) sm += (v[j][i] + v[j][i + 1]) + (v[j][i + 2] + v[j][i + 3]);
        const float mean = wave_sum(sm, lane) * (1.0f / D); float sq = 0.f;
#pragma unroll
        for (int j = 0; j < 2; ++j)
#pragma unroll
            for (int i = 0; i < 16; ++i) { const float d = v[j][i] - mean; sq += d * d; }
        const float rstd = 1.0f / sqrtf(wave_sum(sq, lane) * (1.0f / D) + LN_EPS);
        (void)ST2; (void)Y2;
#pragma unroll
        for (int j = 0; j < 2; ++j)
#pragma unroll
            for (int h = 0; h < 2; ++h) { const int c = 16 * lane + 1024 * j + 8 * h; const float* vv = &v[j][8 * h];
                const f32x4 g0 = *(const f32x4*)(gain + c), g1 = *(const f32x4*)(gain + c + 4), b0 = *(const f32x4*)(bias + c), b1 = *(const f32x4*)(bias + c + 4);
                const f32x4 o0 = ((f32x4){vv[0], vv[1], vv[2], vv[3]} - mean) * rstd * g0 + b0, o1 = ((f32x4){vv[4], vv[5], vv[6], vv[7]} - mean) * rstd * g1 + b1;
                if (last) { *(f32x4*)(OUT + (size_t)t * D + c) = o0; *(f32x4*)(OUT + (size_t)t * D + c + 4) = o1; }
                else { v4u wb; wb.x = pk2(o0[0], o0[1]); wb.y = pk2(o0[2], o0[3]); wb.z = pk2(o1[0], o1[1]); wb.w = pk2(o1[2], o1[3]); *(v4u*)(XBo + (size_t)t * D + c) = wb; } }
    }
}

__device__ __forceinline__ void phase_downproj3(const Frame& F, const bf16* H, const bf16* WD, const bf16* HSp, const bf16* WSD, unsigned char* Yq, float* Ysc, int NT) {
    const LAS int* tpref = (const LAS int*)(F.lds + LDS_TAB); const LAS int* cl = (const LAS int*)(F.lds + LDS_TAB + 512);
    LAS unsigned char* lds = F.lds;
    const int tid = F.tid, lane = F.lane, w = F.wave, fr = lane & 15, fq = lane >> 4;
    unsigned rbB[2], cbB[2];
#pragma unroll
    for (int i = 0; i < 2; ++i) { int R_, C_; g8::stage_rc(tid * 16 + i * 8192, R_, C_); rbB[i] = (unsigned)((R_ & ~31) + g8::perm32(R_ & 31)); cbB[i] = (unsigned)C_ * 2u; }
    const unsigned ldsw = (unsigned)w * 1024u, lbase = (unsigned)(size_t)lds;
    int boffg[4];
#pragma unroll
    for (int g = 0; g < 4; ++g) boffg[g] = g8::lds_byte(32 * g + fr, fq * 8);
    LAS unsigned char* stg = lds + 65536 + w * (32 * 144);
    const int NU = NT * 4;
    const int upos = (F.G % 8) == 0 ? (F.bid & 7) * (F.G >> 3) + (F.bid >> 3) : F.bid;
    int ub = 0;
    int u = (F.G <= NU) ? upos : F.bid; if (u >= NU) return;
#define DP3_UNITINFO(uu, E0, EXP, NV) do { const int tl_ = (uu) >> 2; int e_ = (E0); while (__builtin_amdgcn_readfirstlane(tpref[e_ + 1]) <= tl_) ++e_; EXP = e_; \
        NV = __builtin_amdgcn_readfirstlane(cl[e_]) - (tl_ - __builtin_amdgcn_readfirstlane(tpref[e_])) * 256; } while (0)
#define DP3_GLDS(gsrc, ldsdst) do { unsigned keep_; asm volatile("s_mov_b32 %0, m0\n\ts_mov_b32 m0, %2\n\ts_nop 0\n\tglobal_load_lds_dwordx4 %1, off\n\ts_mov_b32 m0, %0" : "=&s"(keep_) : "v"(gsrc), "s"(ldsdst) : "memory"); } while (0)
#define DP3_STAGE(slot, gb, bs) do { const unsigned v0_ = rbB[0] * (unsigned)(bs) + cbB[0], v1_ = rbB[1] * (unsigned)(bs) + cbB[1]; _Pragma("unroll") for (int kt = 0; kt < 2; ++kt) { \
        DP3_GLDS((const void*)((gb) + kt * 128 + v0_), lbase + (unsigned)((slot) * 32768 + kt * 16384) + ldsw); \
        DP3_GLDS((const void*)((gb) + kt * 128 + v1_), lbase + (unsigned)((slot) * 32768 + kt * 16384) + ldsw + 8192u); } } while (0)
#define DP3_SRC(uu, ee, AB, AS, BB, BS) do { const int tl_ = (uu) >> 2, cu_ = ((uu) & 3) * 512; \
        if ((ee) < 64) { AB = (const char*)(H + (size_t)tl_ * 256 * EDIM); AS = EDIM * 2; BB = (const char*)(WD + (size_t)(ee) * D * EDIM + (size_t)cu_ * EDIM); BS = EDIM * 2; } \
        else { const int t0_ = (tl_ - __builtin_amdgcn_readfirstlane(tpref[ee])) * 256; AB = (const char*)(HSp + (size_t)t0_ * SDIM + ((ee) - 64) * EDIM); AS = SDIM * 2; \
               BB = (const char*)(WSD + (size_t)cu_ * SDIM + ((ee) - 64) * EDIM); BS = SDIM * 2; } } while (0)
    int ecur, nvcur; DP3_UNITINFO(u, 0, ecur, nvcur);
    const char* abc; const char* gbc; int asc, bsc; DP3_SRC(u, ecur, abc, asc, gbc, bsc);
    bf16x8 A[2][4], An[2][4];
    { const char* ap_ = abc + (size_t)(32 * w + fr) * asc + 16 * fq;
#pragma unroll
      for (int m = 0; m < 2; ++m)
#pragma unroll
          for (int kk = 0; kk < 4; ++kk) A[m][kk] = *(const bf16x8*)(ap_ + (size_t)m * 16 * asc + 64 * kk); }
    DP3_STAGE(0, gbc, bsc);
    asm volatile("s_waitcnt vmcnt(0)" ::: "memory");
#pragma unroll 1
    for (;;) {
        int un = u; { const int nb = ub + F.G; if (nb + F.G <= NU) un = nb + upos; else if (nb + F.bid < NU) un = nb + F.bid; if (un != u) ub = nb; }
        int enx, nvnx; DP3_UNITINFO(un, (un > u ? ecur : 0), enx, nvnx);
        const char* abn; const char* gbn; int asn, bsn; DP3_SRC(un, enx, abn, asn, gbn, bsn);
        const int tile = u >> 2, colu = (u & 3) * 512;
        float scq[2][4];
#pragma unroll
        for (int c = 0; c < 4; ++c) {
            if (c == 0) asm volatile("s_waitcnt vmcnt(5)" ::: "memory"); else asm volatile("s_waitcnt vmcnt(4)" ::: "memory");
            __builtin_amdgcn_s_barrier();
            if (c == 3) { const char* ap_ = abn + (size_t)(32 * w + fr) * asn + 16 * fq;
#pragma unroll
                for (int m = 0; m < 2; ++m) { const char* am_ = ap_ + (size_t)m * 16 * asn;
                    asm volatile("global_load_dwordx4 %0, %1, off" : "=&v"(An[m][0]) : "v"(am_) : "memory"); asm volatile("global_load_dwordx4 %0, %1, off offset:64" : "=&v"(An[m][1]) : "v"(am_) : "memory");
                    asm volatile("global_load_dwordx4 %0, %1, off offset:128" : "=&v"(An[m][2]) : "v"(am_) : "memory"); asm volatile("global_load_dwordx4 %0, %1, off offset:192" : "=&v"(An[m][3]) : "v"(am_) : "memory"); } }
            { const char* gnext = (c < 3) ? gbc + (size_t)(c + 1) * 128 * bsc : gbn; const int bnext = (c < 3) ? bsc : bsn; DP3_STAGE((c + 1) & 1, gnext, bnext); }
            __builtin_amdgcn_sched_barrier(0);
            f32x4 acc[2][4][2];
#pragma unroll
            for (int g = 0; g < 4; ++g) { bf16x8 Bf[2][4];
#pragma unroll
                for (int n = 0; n < 2; ++n)
#pragma unroll
                    for (int kk = 0; kk < 4; ++kk) Bf[n][kk] = *(const LAS bf16x8*)(lds + (c & 1) * 32768 + (kk >> 1) * 16384 + boffg[g] + n * 2048 + (kk & 1) * 1024);
#pragma unroll
                for (int m = 0; m < 2; ++m)
#pragma unroll
                    for (int n = 0; n < 2; ++n) { acc[m][g][n] = (f32x4){0.f, 0.f, 0.f, 0.f};
#pragma unroll
                        for (int kk = 0; kk < 4; ++kk) acc[m][g][n] = __builtin_amdgcn_mfma_f32_16x16x32_bf16(Bf[n][kk], A[m][kk], acc[m][g][n], 0, 0, 0); } }
#pragma unroll
            for (int m = 0; m < 2; ++m) {
                float am0 = 0.f, am1 = 0.f;
#pragma unroll
                for (int g = 0; g < 4; ++g)
#pragma unroll
                    for (int n = 0; n < 2; ++n) { am0 = fmaxf(fmaxf(am0, fabsf(acc[m][g][n][0])), fabsf(acc[m][g][n][1])); am1 = fmaxf(fmaxf(am1, fabsf(acc[m][g][n][2])), fabsf(acc[m][g][n][3])); }
                float am = fmaxf(am0, am1);
                am = fmaxf(am, shfl_x(am, 16, lane)); am = fmaxf(am, shfl_x(am, 32, lane));
                am = fminf(am, 3.0e38f);
                const float isc = am > 0.f ? 127.0f * __builtin_amdgcn_rcpf(am) : 0.f;
                scq[m][c] = am * (1.0f / 127.0f);
                const f32x2_t isc2 = (f32x2_t){isc, isc}, mg2 = (f32x2_t){8388736.0f, 8388736.0f};
#pragma unroll
                for (int g = 0; g < 4; ++g) { unsigned qd[2];
#pragma unroll
                    for (int n = 0; n < 2; ++n) {
                        const f32x2_t tl = __builtin_elementwise_fma((f32x2_t){acc[m][g][n][0], acc[m][g][n][1]}, isc2, mg2), th = __builtin_elementwise_fma((f32x2_t){acc[m][g][n][2], acc[m][g][n][3]}, isc2, mg2);
                        const float f0_ = tl.x, f1_ = tl.y, f2_ = th.x, f3_ = th.y;
                        qd[n] = __builtin_amdgcn_perm(__builtin_bit_cast(unsigned, f1_), __builtin_bit_cast(unsigned, f0_), 0x0c0c0400u) | __builtin_amdgcn_perm(__builtin_bit_cast(unsigned, f3_), __builtin_bit_cast(unsigned, f2_), 0x04000c0cu); }
                    *(LAS v2u*)(stg + (16 * m + fr) * 144 + 32 * g + 8 * fq) = (v2u){qd[0], qd[1]}; } }
#pragma unroll
            for (int it = 0; it < 4; ++it) { const int rr = 8 * it + (lane >> 3);
                const v4u o = *(const LAS v4u*)(stg + rr * 144 + (lane & 7) * 16);
                __builtin_nontemporal_store(o, (v4u*)(Yq + (size_t)(tile * 256 + 32 * w + rr) * D + colu + 128 * c + 16 * (lane & 7))); }
            if (c == 3) { const f32x4 so = fq == 0 ? (f32x4){scq[0][0], scq[0][1], scq[0][2], scq[0][3]} : (f32x4){scq[1][0], scq[1][1], scq[1][2], scq[1][3]};
                if (fq < 2) *(f32x4*)(Ysc + (size_t)(tile * 256 + 32 * w + 16 * fq + fr) * 16 + (colu >> 7)) = so; }
            __builtin_amdgcn_sched_barrier(0);
        }
        asm volatile("s_waitcnt vmcnt(9)" : "+v"(An[0][0]), "+v"(An[0][1]), "+v"(An[0][2]), "+v"(An[0][3]), "+v"(An[1][0]), "+v"(An[1][1]), "+v"(An[1][2]), "+v"(An[1][3]) :: "memory");
        if (un == u) break;
#pragma unroll
        for (int m = 0; m < 2; ++m)
#pragma unroll
            for (int kk = 0; kk < 4; ++kk) A[m][kk] = An[m][kk];
        u = un; ecur = enx; nvcur = nvnx; abc = abn; asc = asn; gbc = gbn; bsc = bsn;
    }
    asm volatile("s_waitcnt vmcnt(0)" ::: "memory");
#undef DP3_UNITINFO
#undef DP3_STAGE
#undef DP3_GLDS
#undef DP3_SRC
}

enum { PH_PRO = 0, PH_POOL_G1, PH_POOL_P, PH_POOL_G2, PH_POOL_G3, PH_DIL_G1, PH_DIL_ATT, PH_DIL_CMB, PH_DIL_G2, PH_CONV_G1, PH_CONV_E, PH_CONV_G2, PH_MOE1, PH_MOE2, PH_MOE3, PH_MOE4, PH_COUNT };

template <int PH>
__device__ __forceinline__ void run_phase(const Frame& Fin, const Args& args_, const int L) {
    Frame F = Fin; { int w_ = Fin.wave, l_; asm volatile("" : "+s"(w_)); asm volatile("v_mbcnt_lo_u32_b32 %0, -1, 0\n\tv_mbcnt_hi_u32_b32 %0, -1, %0" : "=v"(l_)); F.wave = w_; F.lane = l_; F.tid = w_ * 64 + l_; }
    unsigned char* ws; { GAS unsigned char* wsg = (GAS unsigned char*)Fin.ws; asm volatile("" : "+s"(wsg)); ws = (unsigned char*)wsg; } F.ws = ws; F.ctl = (unsigned*)(ws + WS_CTL);
    KP kp = (KP)__builtin_amdgcn_kernarg_segment_ptr(); asm volatile("" : "+s"(kp)); (void)args_;
    { unsigned l_ = (unsigned)(size_t)Fin.lds; asm volatile("" : "+s"(l_)); F.lds = (LAS unsigned char*)(size_t)l_; }
    LAS unsigned char* ring = F.lds; int c = (int)blockIdx.x; { int g_ = Fin.G; asm volatile("" : "+s"(c), "+s"(g_)); F.G = g_; F.bid = c; }
    const float* xres = ain(kp, IN_X);
    const float* st2 = (const float*)(ws + WS_ST2); float* pstp = (float*)(ws + WS_PST);
    const float* g2p = ain(kp, IN_LNG) + (size_t)((L > 0 ? L - 1 : 0) * 2 + 1) * D; const float* b2p = ain(kp, IN_LNB) + (size_t)((L > 0 ? L - 1 : 0) * 2 + 1) * D;
    const bf16* xb = (const bf16*)(ws + WS_XB);
    bf16* yf = (bf16*)(ws + WS_YF);
    unsigned char* big = ws + WS_BIG;
    const int ia = L / 3;
    if constexpr (PH == PH_PRO) { phase_prologue(F, kp); }
    if constexpr (PH == PH_POOL_G1) { g8::DenseSched S; S.init(xb, (const bf16*)(ws + WS_W_POOL_IN) + (size_t)ia * D * D, T, D, D, D, F.G, c);
        g8::EpiBf16 E{(bf16*)(big + BG_U), D, 0}; g8::gemm_phase<g8::EpiBf16, g8::DenseSched, false>(ring, F.tid, D, D, D, S, E); }
    if constexpr (PH == PH_POOL_P) { phase_pool(F, (const bf16*)(big + BG_U), (bf16*)(big + BG_PL)); }
    if constexpr (PH == PH_POOL_G2) { g8::DenseSched S; S.init((const bf16*)(big + BG_PL), (const bf16*)(ws + WS_W_POOL_G) + (size_t)ia * D * 512, T, D, D, 512, F.G, c); S.agrp_shift = 1; S.agrp_stride = 512 * 2;
        g8::EpiScaleBf16 E{(bf16*)(big + BG_MX), D, ain(kp, IN_PSC) + (size_t)ia * D}; g8::gemm_phase<g8::EpiScaleBf16, g8::DenseSched, false>(ring, F.tid, 512, D, 512, S, E); }
    if constexpr (PH == PH_POOL_G3) { g8::DenseSched S; S.init((const bf16*)(big + BG_MX), (const bf16*)(ws + WS_W_POOL_OUT) + (size_t)ia * D * D, T, D, D, D, F.G, c);
        g8::EpiResidLN E{xres, xb, st2, g2p, b2p, yf, pstp, L > 0 ? 2 : 0}; g8::gemm_phase<g8::EpiResidLN, g8::DenseSched, false>(ring, F.tid, D, D, D, S, E); }
    if constexpr (PH == PH_DIL_G1) { g8::DenseSched S; S.init(xb, (const bf16*)(ws + WS_W_DIL_QKV), T, QKVC, D, D, F.G, c);
        g8::EpiBf16 E{(bf16*)(big + BG_QKV), QKVC, 1}; g8::gemm_phase<g8::EpiBf16, g8::DenseSched, false>(ring, F.tid, D, D, D, S, E); }
    if constexpr (PH == PH_DIL_ATT) { phase_attn(F, (const bf16*)(big + BG_QKV), ain(kp, IN_RELB), (bf16*)(big + BG_OG), (float*)(big + BG_LSE)); }
    if constexpr (PH == PH_DIL_CMB) { phase_combine(F, (const bf16*)(big + BG_OG), (const float*)(big + BG_LSE), (bf16*)(big + BG_O)); }
    if constexpr (PH == PH_DIL_G2) { g8::DenseSched S; S.init((const bf16*)(big + BG_O), (const bf16*)(ws + WS_W_DIL_OUT), T, D, DILW, DILW, F.G, c);
        g8::EpiResidLN E{xres, xb, st2, g2p, b2p, yf, pstp, L > 0 ? 2 : 0}; g8::gemm_phase<g8::EpiResidLN, g8::DenseSched, false>(ring, F.tid, DILW, DILW, DILW, S, E); }
    if constexpr (PH == PH_CONV_G1) { g8::DenseSched S; S.init(xb, (const bf16*)(ws + WS_W_CONV_IN), T, 3 * D, D, D, F.G, c);
        g8::EpiConvIn E{(bf16*)(big + BG_UC), (bf16*)(big + BG_BG)}; g8::gemm_phase<g8::EpiConvIn, g8::DenseSched, false>(ring, F.tid, D, D, D, S, E); }
    if constexpr (PH == PH_CONV_E) { phase_conv(F, (const bf16*)(big + BG_UC), (const bf16*)(big + BG_BG), ain(kp, IN_CW), (bf16*)(big + BG_Z)); }
    if constexpr (PH == PH_CONV_G2) { g8::DenseSched S; S.init((const bf16*)(big + BG_Z), (const bf16*)(ws + WS_W_CONV_OUT), T, D, D, D, F.G, c);
        g8::EpiResidLN E{xres, xb, st2, g2p, b2p, yf, pstp, L > 0 ? 2 : 0}; g8::gemm_phase<g8::EpiResidLN, g8::DenseSched, false>(ring, F.tid, D, D, D, S, E); }
    unsigned* cnt = F.ctl + CW_CNT + L * 64 * 16;
    float* x1f = (float*)(ws + WS_X1F); bf16* x1b = (bf16*)(ws + WS_X1B);
    int* ltok = (int*)(ws + WS_LTOK); float* lgate = (float*)(ws + WS_LGATE); int* eidx = (int*)(ws + WS_EIDX); int* inv = (int*)(ws + WS_INV);
    bf16* HB = (bf16*)(ws + WS_HB); bf16* HS = (bf16*)(ws + WS_HS); bf16* Yr = (bf16*)(ws + WS_BIG);
    if constexpr (PH == PH_MOE1) {
        const float* g1 = ain(kp, IN_LNG) + (size_t)(L * 2 + 0) * D; const float* b1 = ain(kp, IN_LNB) + (size_t)(L * 2 + 0) * D;
        phase_moe1n(F, yf, pstp, g1, b1, (const bf16*)(ws + WS_RWH) + (size_t)L * NEXP * D, (const bf16*)(ws + WS_RWL) + (size_t)L * NEXP * D, ain(kp, IN_RB) + (size_t)L * NEXP,
                    x1b, (float*)(ws + WS_ST1), cnt, ltok, lgate, eidx, inv); }
    if constexpr (PH == PH_MOE2) {
        const int NT = build_tiles(F, cnt);
        { g8::ExpertSched<1, true> S; S.tpref = (const LAS int*)(F.lds + LDS_TAB); S.cnt = (const LAS int*)(F.lds + LDS_TAB + 512); S.A = (const char*)x1b; S.B = (const char*)((const bf16*)(ws + WS_W_EX_GU) + (size_t)L * 64 * 256 * D);
          S.tok = ltok; S.b_exp = (size_t)256 * D * 2; S.b_tile = 0; S.a_tile = 0; S.NU = NT; S.G = F.G; S.c = c;
          g8::EpiExpertGU E{HB}; g8::gemm_phase<g8::EpiExpertGU, g8::ExpertSched<1, true>, true>(ring, F.tid, D, D, D, S, E); }
        { const int rot = (c - (NT % F.G) + F.G) % F.G;
          g8::DenseSched S; S.init(x1b, (const bf16*)(ws + WS_W_SH_GU) + (size_t)L * 512 * D, T, 512, D, D, F.G, rot);
          int t2 = F.tid; asm volatile("" : "+v"(t2));
          g8::EpiSharedGU E{HS}; g8::gemm_phase<g8::EpiSharedGU, g8::DenseSched, false>(ring, t2, D, D, D, S, E); } }
    if constexpr (PH == PH_MOE3) {
        const float* g1 = ain(kp, IN_LNG) + (size_t)(L * 2 + 0) * D; const float* b1 = ain(kp, IN_LNB) + (size_t)(L * 2 + 0) * D;
        const int NT = build_tiles(F, cnt);
        __syncthreads();
        phase_downproj3(F, HB, (const bf16*)(ws + WS_W_EX_D) + (size_t)L * 64 * D * EDIM, HS, (const bf16*)(ws + WS_W_SH_D) + (size_t)L * D * SDIM, (unsigned char*)Yr, (float*)(ws + WS_BIG + BG_YSC), NT + 2 * (T / 256));
        (void)g1; (void)b1; }
    if constexpr (PH == PH_MOE4) { (void)build_tiles(F, cnt);
        const float* g2 = ain(kp, IN_LNG) + (size_t)(L * 2 + 1) * D; const float* b2 = ain(kp, IN_LNB) + (size_t)(L * 2 + 1) * D;
        phase_moe4q(F, x1b, (bf16*)(ws + WS_Y2F), (const unsigned char*)Yr, (const float*)(ws + WS_BIG + BG_YSC), eidx, inv, g2, b2, (float*)(ws + WS_ST2), (bf16*)(ws + WS_XB), aout(kp), L == DEPTH - 1); }
}
__device__ __forceinline__ void make_frame(Frame& F, const Args& args) {
    extern __shared__ __attribute__((aligned(16))) unsigned char lds_raw[];
    F.lds = (LAS unsigned char*)lds_raw; F.ws = args.ws; F.ctl = (unsigned*)(args.ws + WS_CTL);
    F.tid = threadIdx.x; F.lane = F.tid & 63; F.wave = __builtin_amdgcn_readfirstlane(F.tid >> 6); F.G = gridDim.x; F.bid = blockIdx.x;
}
template <int PH> __global__ void __launch_bounds__(512, 2) k_phase(Args args, int L) {
    Frame F; make_frame(F, args);
    run_phase<PH>(F, args, L);
}

#ifndef MK_NOINLINE
#define MK_NOINLINE 0
#endif
#if MK_NOINLINE
template <int PH> __device__ __noinline__ void call_phase_ni(const int L) {
    Args dummy{}; Frame F;
    KP kp = (KP)__builtin_amdgcn_kernarg_segment_ptr();
    extern __shared__ __attribute__((aligned(16))) unsigned char lds_raw[];
    F.lds = (LAS unsigned char*)lds_raw; F.ws = (unsigned char*)((GAS unsigned char* const CAS*)kp)[20]; F.ctl = (unsigned*)(F.ws + WS_CTL);
    F.tid = threadIdx.x; F.lane = F.tid & 63; F.wave = __builtin_amdgcn_readfirstlane(F.tid >> 6); F.G = gridDim.x; F.bid = blockIdx.x;
    run_phase<PH>(F, dummy, L);
}
template <int PH> __device__ __forceinline__ void call_phase(const Frame& F, const Args& args, const int L) { call_phase_ni<PH>(L); }
#else
template <int PH> __device__ __forceinline__ void call_phase(const Frame& F, const Args& args, const int L) { asm volatile("; PHASE_BEGIN %0" :: "n"(PH)); run_phase<PH>(F, args, L); asm volatile("; PHASE_END %0" :: "n"(PH)); }
#endif
__global__ void __launch_bounds__(512, 2) fwd_all(Args args) {
    Frame F; make_frame(F, args);
    volatile LAS unsigned* misc = (volatile LAS unsigned*)(F.lds + LDS_MISC);
    if (F.tid < 4) misc[F.tid] = 0u;
    __syncthreads();
    const int lo = args.ph_lo, hi = args.ph_hi;
    XcdBarrier bar; bar.bar = F.ctl + CW_BAR; bar.x = 0; bar.st = misc;
    if (hi - lo > 1) bar = xcd_barrier_post(F.ctl + CW_BAR, misc);
    int pc = 0;
#ifndef MK_DUP_MASK
#define MK_DUP_MASK 0
#endif
#if MK_DUP_MASK
#define STEP(PH, Lx) do { if (pc >= lo && pc < hi) { int nrep_ = ((MK_DUP_MASK >> (PH)) & 1) ? 2 : 1; asm volatile("" : "+s"(nrep_)); _Pragma("unroll 1") for (int r_ = 0; r_ < nrep_; ++r_) { call_phase<PH>(F, args, Lx); if (r_ + 1 < nrep_ || pc + 1 < hi) xcd_barrier(bar); } } ++pc; } while (0)
#else
#define STEP(PH, Lx) do { if (pc >= lo && pc < hi) { call_phase<PH>(F, args, Lx); if (pc + 1 < hi) xcd_barrier(bar); } ++pc; } while (0)
#endif
    STEP(PH_PRO, 0);
#pragma unroll 1
    for (int L = 0; L < DEPTH; ++L) {
        const int kind = L % 3;
        if (kind == 0) { STEP(PH_POOL_G1, L); STEP(PH_POOL_P, L); STEP(PH_POOL_G2, L); STEP(PH_POOL_G3, L); }
        else if (kind == 1) { STEP(PH_DIL_G1, L); STEP(PH_DIL_ATT, L); STEP(PH_DIL_CMB, L); STEP(PH_DIL_G2, L); }
        else { STEP(PH_CONV_G1, L); STEP(PH_CONV_E, L); STEP(PH_CONV_G2, L); }
        STEP(PH_MOE1, L); STEP(PH_MOE2, L); STEP(PH_MOE3, L); STEP(PH_MOE4, L);
    }
#undef STEP
}
constexpr int N_STEPS = 1 + 2 * 8 + 8 + 7;

template <int PH> static void launch_phase(const Args& a, int L, int grid, hipStream_t stream) {
    static bool attr = false;
    if (!attr) { (void)hipFuncSetAttribute((const void*)k_phase<PH>, hipFuncAttributeMaxDynamicSharedMemorySize, LDS_BYTES); attr = true; }
    hipLaunchKernelGGL(k_phase<PH>, dim3(grid), dim3(512), LDS_BYTES, stream, a, L);
}
extern "C" void kernel_launch(void* const* d_in, const int* in_sizes, int n_in, void* d_out, int out_size, void* d_ws, size_t ws_size, hipStream_t stream) {
    static int grid = 0;
    if (grid == 0) {
        if (n_in != 19 || out_size != T * D || ws_size < WS_END) { fprintf(stderr, "kernel_launch: unexpected shapes (n_in %d out %d ws %zu need %zu)\n", n_in, out_size, ws_size, (size_t)WS_END); grid = -1; return; }
        int dev = 0, cus = 0;
        if (hipGetDevice(&dev) != hipSuccess || hipDeviceGetAttribute(&cus, hipDeviceAttributeMultiprocessorCount, dev) != hipSuccess) { grid = -1; return; }
#if MK_ONE_LAUNCH
        if (hipFuncSetAttribute((const void*)fwd_all, hipFuncAttributeMaxDynamicSharedMemorySize, LDS_BYTES) != hipSuccess) { fprintf(stderr, "kernel_launch: hipFuncSetAttribute failed\n"); grid = -1; return; }
        int per_cu = 0;
        if (hipOccupancyMaxActiveBlocksPerMultiprocessor(&per_cu, (const void*)fwd_all, 512, LDS_BYTES) != hipSuccess || per_cu < 1) { fprintf(stderr, "kernel_launch: note: occupancy query reports %d blocks per CU\n", per_cu); (void)hipGetLastError(); }
#endif
        grid = cus;
    }
    if (grid < 0) return;
    (void)hipMemsetAsync((char*)d_ws + WS_CTL, 0, CTL_ZERO_BYTES, stream);
    Args a{};
    for (int i = 0; i < 19; ++i) a.in[i] = (const float*)d_in[i];
    a.out = (float*)d_out; a.ws = (unsigned char*)d_ws; a.ph_lo = 0; a.ph_hi = 0;
#if MK_ONE_LAUNCH
#ifdef MK_SPLIT
    for (int p = 0; p < N_STEPS; ++p) { a.ph_lo = p; a.ph_hi = p + 1; hipLaunchKernelGGL(fwd_all, dim3(grid), dim3(512), LDS_BYTES, stream, a); }
#else
    a.ph_lo = 0; a.ph_hi = N_STEPS;
    hipLaunchKernelGGL(fwd_all, dim3(grid), dim3(512), LDS_BYTES, stream, a);
#endif
#elif defined(MK_HYBRID_MASK)
    {
        static bool attr2 = false; if (!attr2) { (void)hipFuncSetAttribute((const void*)fwd_all, hipFuncAttributeMaxDynamicSharedMemorySize, LDS_BYTES); attr2 = true; }
        int pc = 0;
#define HSTEP(PH, Lx) do { if ((MK_HYBRID_MASK >> (PH)) & 1) { a.ph_lo = pc; a.ph_hi = pc + 1; hipLaunchKernelGGL(fwd_all, dim3(grid), dim3(512), LDS_BYTES, stream, a); } else { a.ph_lo = 0; a.ph_hi = 0; launch_phase<PH>(a, Lx, grid, stream); } ++pc; } while (0)
        HSTEP(PH_PRO, 0);
        for (int L = 0; L < DEPTH; ++L) {
            const int kind = L % 3;
            if (kind == 0) { HSTEP(PH_POOL_G1, L); HSTEP(PH_POOL_P, L); HSTEP(PH_POOL_G2, L); HSTEP(PH_POOL_G3, L); }
            else if (kind == 1) { HSTEP(PH_DIL_G1, L); HSTEP(PH_DIL_ATT, L); HSTEP(PH_DIL_CMB, L); HSTEP(PH_DIL_G2, L); }
            else { HSTEP(PH_CONV_G1, L); HSTEP(PH_CONV_E, L); HSTEP(PH_CONV_G2, L); }
            HSTEP(PH_MOE1, L); HSTEP(PH_MOE2, L); HSTEP(PH_MOE3, L); HSTEP(PH_MOE4, L);
        }
#undef HSTEP
    }
#else
    launch_phase<PH_PRO>(a, 0, grid, stream);
    for (int L = 0; L < DEPTH; ++L) {
        const int kind = L % 3;
        if (kind == 0) { launch_phase<PH_POOL_G1>(a, L, grid, stream); launch_phase<PH_POOL_P>(a, L, grid, stream); launch_phase<PH_POOL_G2>(a, L, grid, stream); launch_phase<PH_POOL_G3>(a, L, grid, stream); }
        else if (kind == 1) { launch_phase<PH_DIL_G1>(a, L, grid, stream); launch_phase<PH_DIL_ATT>(a, L, grid, stream); launch_phase<PH_DIL_CMB>(a, L, grid, stream); launch_phase<PH_DIL_G2>(a, L, grid, stream); }
        else { launch_phase<PH_CONV_G1>(a, L, grid, stream); launch_phase<PH_CONV_E>(a, L, grid, stream); launch_phase<PH_CONV_G2>(a, L, grid, stream); }
        launch_phase<PH_MOE1>(a, L, grid, stream); launch_phase<PH_MOE2>(a, L, grid, stream); launch_phase<PH_MOE3>(a, L, grid, stream); launch_phase<PH_MOE4>(a, L, grid, stream);
    }
#endif
}
```

```cpp
#include <hip/hip_runtime.h>
#include <cstdio>
#include <cstdint>

#ifndef MK_ONE_LAUNCH
#define MK_ONE_LAUNCH 1
#endif

#define GAS __attribute__((address_space(1)))
#define LAS __attribute__((address_space(3)))
typedef unsigned short bf16;
typedef unsigned v4u __attribute__((ext_vector_type(4)));
typedef unsigned v2u __attribute__((ext_vector_type(2)));
typedef float f32x4 __attribute__((ext_vector_type(4)));
typedef float f32x2 __attribute__((ext_vector_type(2)));
typedef short bf16x8 __attribute__((ext_vector_type(8)));
typedef short s16x4 __attribute__((ext_vector_type(4)));

constexpr int NBATCH = 8, SEQ = 2048, D = 2048, T = NBATCH * SEQ, DEPTH = 4;
constexpr int NEXP = 64, TOPK = 8, EDIM = 128, SDIM = 256;
constexpr int QKVC = 4608, DILW = 512;
constexpr float ALPHA = 1.681792830507429f;
constexpr float LN_EPS = 1e-5f;
constexpr int CAP = 16384;
constexpr int HROWS = T * TOPK + NEXP * 256;

constexpr size_t MiB = 1u << 20;
constexpr size_t WS_CTL = 0, CTL_ZERO_BYTES = 1 * MiB;
constexpr size_t WS_W_POOL_IN = 1 * MiB;
constexpr size_t WS_W_POOL_G = WS_W_POOL_IN + 16 * MiB;
constexpr size_t WS_W_POOL_OUT = WS_W_POOL_G + 4 * MiB;
constexpr size_t WS_W_DIL_QKV = WS_W_POOL_OUT + 16 * MiB;
constexpr size_t WS_W_DIL_OUT = WS_W_DIL_QKV + 18 * MiB;
constexpr size_t WS_W_CONV_IN = WS_W_DIL_OUT + 2 * MiB;
constexpr size_t WS_W_CONV_OUT = WS_W_CONV_IN + 24 * MiB;
constexpr size_t WS_W_SH_GU = WS_W_CONV_OUT + 8 * MiB;
constexpr size_t WS_W_SH_D = WS_W_SH_GU + 8 * MiB;
constexpr size_t WS_W_EX_GU = WS_W_SH_D + 4 * MiB;
constexpr size_t WS_W_EX_D = WS_W_EX_GU + 256 * MiB;
constexpr size_t WS_XF = WS_W_EX_D + 256 * MiB;
constexpr size_t WS_YF = WS_XF + 128 * MiB;
constexpr size_t WS_X1F = WS_YF + 128 * MiB;
constexpr size_t WS_XB = WS_X1F + 128 * MiB;
constexpr size_t WS_X1B = WS_XB + 64 * MiB;
constexpr size_t WS_HB = WS_X1B + 64 * MiB;
constexpr size_t WS_HS = WS_HB + 72 * MiB;
constexpr size_t WS_LTOK = WS_HS + 8 * MiB;
constexpr size_t WS_LGATE = WS_LTOK + 4 * MiB;
constexpr size_t WS_EIDX = WS_LGATE + 4 * MiB;
constexpr size_t WS_INV = WS_EIDX + 1 * MiB;
constexpr size_t WS_BIG = WS_INV + 1 * MiB;
constexpr size_t WS_PST = WS_BIG + 608 * MiB;
constexpr size_t WS_ST1 = WS_PST + 4 * MiB;
constexpr size_t WS_ST2 = WS_ST1 + 1 * MiB;
constexpr size_t WS_RWH = WS_ST2 + 1 * MiB;
constexpr size_t WS_RWL = WS_RWH + 1 * MiB;
constexpr size_t WS_PST2 = WS_RWL + 1 * MiB;
constexpr size_t WS_END = WS_PST2 + 8 * MiB;
constexpr size_t WS_Y2F = WS_X1F;
constexpr size_t BG_U = 0, BG_PL = 64 * MiB, BG_MX = 128 * MiB;
constexpr size_t BG_QKV = 0, BG_OG = 144 * MiB, BG_LSE = 192 * MiB, BG_O = 194 * MiB;
constexpr size_t BG_UC = 0, BG_BG = 64 * MiB, BG_Z = 128 * MiB;
constexpr size_t BG_YSC = 400 * MiB;
constexpr int CW_BAR = 4096;
constexpr int CW_CNT = 16384;

constexpr int RING_BYTES = 131072;
constexpr int LDS_TAB = RING_BYTES;
constexpr int LDS_STASH = RING_BYTES + 1024;
constexpr int LDS_BYTES = 163840;
constexpr int LDS_MISC = LDS_BYTES - 1024;

typedef __bf16 bf16x2_t __attribute__((ext_vector_type(2)));
typedef float f32x2_t __attribute__((ext_vector_type(2)));
__device__ __forceinline__ unsigned cvt_pk_bf16(float lo, float hi) { const bf16x2_t r = __builtin_convertvector((f32x2_t){lo, hi}, bf16x2_t); return __builtin_bit_cast(unsigned, r); }
__device__ __forceinline__ unsigned f2bf(float f) { unsigned u = __builtin_bit_cast(unsigned, f); return (u + 0x7fffu + ((u >> 16) & 1u)) >> 16; }
__device__ __forceinline__ unsigned pk2(float lo, float hi) { return f2bf(lo) | (f2bf(hi) << 16); }
__device__ __forceinline__ float bflo(unsigned w) { return __builtin_bit_cast(float, w << 16); }
__device__ __forceinline__ float bfhi(unsigned w) { return __builtin_bit_cast(float, w & 0xffff0000u); }
__device__ __forceinline__ float shfl_from(float v, int src) { return __builtin_bit_cast(float, __builtin_amdgcn_ds_bpermute(src << 2, __builtin_bit_cast(int, v))); }
__device__ __forceinline__ float shfl_x(float v, int o, int lane) { return shfl_from(v, lane ^ o); }
__device__ __forceinline__ float wave_sum(float v, int lane) {
#pragma unroll
    for (int o = 1; o < 64; o <<= 1) v += shfl_x(v, o, lane);
    return v;
}
#define LDS_WAIT() asm volatile("s_waitcnt lgkmcnt(0)" ::: "memory")
#define VM_WAIT() asm volatile("s_waitcnt vmcnt(0)" ::: "memory")

#define XB_TMO      128
#define XB_XCNT(j)  (256  + 64 * (j))
#define XB_XSUB(j)  (1280 + 64 * (j))
#define XB_XGEN(j)  (2304 + 64 * (j))
#define XB_TOP      3328
#define XB_TOPGEN   3392
#define XCD_BAR_WORDS 3456
#define XB_SPIN_CAP (1u << 18)

__device__ __forceinline__ unsigned xb_ld(unsigned* p)              { return __hip_atomic_load(p, __ATOMIC_RELAXED, __HIP_MEMORY_SCOPE_AGENT); }
__device__ __forceinline__ unsigned xb_add(unsigned* p, unsigned v) { return __hip_atomic_fetch_add(p, v, __ATOMIC_RELAXED, __HIP_MEMORY_SCOPE_AGENT); }
__device__ __forceinline__ unsigned xb_xcc_id() { return (unsigned)__builtin_amdgcn_s_getreg((3 << 11) | 20) & 0xFu; }
#define XB_SPIN(cond, bar) do { unsigned _sp = 0; while (cond) { __builtin_amdgcn_s_sleep(1); \
    if ((++_sp & 255u) == 0u) { if (xb_ld(&(bar)[XB_TMO])) break; if (_sp > XB_SPIN_CAP) { atomicAdd(&(bar)[XB_TMO], 1u); break; } } } } while (0)

struct XcdBarrier {
    unsigned* bar; unsigned x;
    volatile LAS unsigned* st;
};

__device__ __forceinline__ XcdBarrier xcd_barrier_post(unsigned* bar, volatile LAS unsigned* st) {
    XcdBarrier b; b.bar = bar; b.x = xb_xcc_id(); b.st = st;
    if (threadIdx.x == 0) (void)xb_add(&bar[XB_XCNT(b.x)], 1u);
    return b;
}
__device__ __forceinline__ void xcd_barrier_complete(unsigned* bar, unsigned x, unsigned& nloc, unsigned& nx) {
    const unsigned G = gridDim.x * gridDim.y * gridDim.z;
    unsigned sum, cnt, mine, sp = 0u;
    for (;;) {
        sum = 0u; cnt = 0u; mine = 0u;
#pragma unroll
        for (unsigned j = 0; j < 16; ++j) { const unsigned c = xb_ld(&bar[XB_XCNT(j)]); sum += c; cnt += (c > 0u) ? 1u : 0u; mine = (j == x) ? c : mine; }
        if (sum == G) break;
        __builtin_amdgcn_s_sleep(1);
        if ((++sp & 255u) == 0u) { if (xb_ld(&bar[XB_TMO])) break; if (sp > XB_SPIN_CAP) { atomicAdd(&bar[XB_TMO], 1u); break; } }
    }
    nloc = mine > 0u ? mine : 1u; nx = cnt > 0u ? cnt : 1u;
}

__device__ __forceinline__ void xcd_barrier(const XcdBarrier& b) {
    asm volatile("s_waitcnt vmcnt(0)" ::: "memory");
    __syncthreads();
    if (threadIdx.x == 0) {
        unsigned* bar; unsigned bx = b.x; { GAS unsigned* bg = (GAS unsigned*)b.bar; asm volatile("" : "+s"(bg), "+s"(bx)); bar = (unsigned*)bg; }
        __builtin_amdgcn_s_waitcnt(0);
        unsigned nloc = b.st[0], nx = b.st[1];
        if (nloc == 0u) { xcd_barrier_complete(bar, bx, nloc, nx); b.st[0] = nloc; b.st[1] = nx; }
        const unsigned old = xb_add(&bar[XB_XSUB(bx)], 1u);
        const unsigned gen = old / nloc;
        if (old + 1u == (gen + 1u) * nloc) {
            __builtin_amdgcn_fence(__ATOMIC_RELEASE, "agent");
            asm volatile("s_waitcnt vmcnt(0)" ::: "memory");
            const unsigned og = xb_add(&bar[XB_TOP], 1u);
            const unsigned tg = og / nx;
            if (og + 1u == (tg + 1u) * nx) xb_add(&bar[XB_TOPGEN], 1u);
            else XB_SPIN(xb_ld(&bar[XB_TOPGEN]) == tg, bar);
            __builtin_amdgcn_fence(__ATOMIC_ACQUIRE, "agent");
            xb_add(&bar[XB_XGEN(bx)], 1u);
            asm volatile("s_waitcnt vmcnt(0)" ::: "memory");
        } else {
            XB_SPIN(xb_ld(&bar[XB_XGEN(bx)]) == gen, bar);
            __builtin_amdgcn_fence(__ATOMIC_ACQUIRE, "agent");
            asm volatile("s_waitcnt vmcnt(0)" ::: "memory");
        }
    }
    __syncthreads();
}

namespace g8 {
constexpr int BM = 256, BK = 64, HALF = 128, HTB = HALF * BK * 2, STAGE_BYTES = 8 * HTB, NXCD = 8, WGM = 8;
__host__ __device__ __forceinline__ int lds_byte(int r, int c) { const int st = (r >> 4) * 2 + (c >> 5), rr = r & 15, cc = c & 31, ob = rr * 64 + cc * 2; return st * 1024 + (ob ^ (((ob >> 9) & 1) << 5)); }
__host__ __device__ __forceinline__ void stage_rc(int b, int& R, int& C) { const int st = b / 1024, sb = b % 1024, swz = sb ^ (((sb >> 9) & 1) << 5); R = (st >> 1) * 16 + swz / 64; C = (st & 1) * 32 + (swz % 64) / 2; }
__host__ __device__ __forceinline__ int perm32(int rho) { const int n = rho >> 4, i = rho & 15; return 8 * (i >> 2) + 4 * n + (i & 3); }

struct Unit { const char* A; const char* B; const int* rows; int pm, pn, nvalid, aux; };

template <class Epi, class Sched, bool GATHER>
__device__ __forceinline__ void gemm_phase(LAS unsigned char* lds, const int tid_in, const int K, const int lda, const int ldb, const Sched& S, const Epi& E) {
    const int tid = tid_in, wid = __builtin_amdgcn_readfirstlane(tid >> 6), lane = tid & 63, wr = wid >> 2, wc = wid & 3, fr = lane & 15, fq = lane >> 4;
    const int nt = K / BK;
    unsigned voffB[2];
#pragma unroll
    for (int i = 0; i < 2; ++i) { int R_, C_; stage_rc(tid * 16 + i * 8192, R_, C_); const int Rb = Epi::PERM ? ((R_ & ~31) + perm32(R_ & 31)) : R_; voffB[i] = (unsigned)(Rb * ldb + C_) * 2u; }
    LAS v4u* stash = (LAS v4u*)(lds + (LDS_STASH - 0) + tid * 16);
    const size_t kstep = (size_t)(BK * 2);
    const size_t hstepB = (size_t)HALF * ldb * 2;
    const unsigned ldsw = (unsigned)wid * 1024u;
    const int aoff = lds_byte(wr * 64 + fr, fq * 8), boff = lds_byte(wc * 32 + fr, fq * 8);
#define G8_SA(b, h) (((b) * 2 + (h)) * HTB)
#define G8_SB(b, h) ((4 + (b) * 2 + (h)) * HTB)
#define G8_STAGE2(bufoff, gbase, v0, v1) do { \
        __builtin_amdgcn_global_load_lds((const unsigned*)((const char*)(gbase) + (v0)), (LAS unsigned*)(lds + (bufoff) + ldsw), 16, 0, 0); \
        __builtin_amdgcn_global_load_lds((const unsigned*)((const char*)(gbase) + (v1)), (LAS unsigned*)(lds + (bufoff) + ldsw + 8192), 16, 0, 0); } while (0)
#define G8_STAGEB(bufoff, gbase) G8_STAGE2(bufoff, gbase, voffB[0], voffB[1])
#define G8_LDA(dst, b, h) do { _Pragma("unroll") for (int m = 0; m < 4; ++m) _Pragma("unroll") for (int k = 0; k < 2; ++k) dst[m][k] = *(const LAS bf16x8*)(lds + G8_SA(b, h) + aoff + m * 2048 + k * 1024); } while (0)
#define G8_LDB(dst, b, h) do { _Pragma("unroll") for (int n = 0; n < 2; ++n) _Pragma("unroll") for (int k = 0; k < 2; ++k) dst[n][k] = *(const LAS bf16x8*)(lds + G8_SB(b, h) + boff + n * 2048 + k * 1024); } while (0)
#define G8_MMA(ai, bj, At, Bt) do { __builtin_amdgcn_s_setprio(1); _Pragma("unroll") for (int m = 0; m < 4; ++m) _Pragma("unroll") for (int n = 0; n < 2; ++n) _Pragma("unroll") for (int k = 0; k < 2; ++k) \
        acc[ai][bj][m][n] = __builtin_amdgcn_mfma_f32_16x16x32_bf16(Bt[n][k], At[m][k], acc[ai][bj][m][n], 0, 0, 0); __builtin_amdgcn_s_setprio(0); } while (0)
#define G8_WAIT_V(n) asm volatile("s_waitcnt vmcnt(" #n ")" ::: "memory")
#define G8_WAIT_L(n) asm volatile("s_waitcnt lgkmcnt(" #n ")" ::: "memory")
#define G8_BAR __builtin_amdgcn_s_barrier()
#define G8_SCHED __builtin_amdgcn_sched_barrier(0)
#define G8_SETVA(dst, u) do { int _t2 = tid; if (GATHER) asm volatile("" : "+v"(_t2)); _Pragma("unroll") for (int _h = 0; _h < 2; ++_h) _Pragma("unroll") for (int _i = 0; _i < 2; ++_i) { \
        int _R, _C; stage_rc(_t2 * 16 + _i * 8192, _R, _C); \
        const unsigned _rl = (unsigned)(_h * HALF + _R); unsigned _row = _rl; \
        if (GATHER) { _row = 0u; if (_rl < (unsigned)(u).nvalid) _row = (unsigned)(u).rows[_rl] >> 3; } \
        dst[_h][_i] = (_row * (unsigned)lda + (unsigned)_C) * 2u; } } while (0)
    Unit cur, nxt; int ui = 0;
    if (!S.next(0, cur)) return;
    f32x4 acc[2][2][4][2];
#pragma unroll
    for (int a = 0; a < 2; ++a)
#pragma unroll
        for (int b = 0; b < 2; ++b)
#pragma unroll
            for (int m = 0; m < 4; ++m)
#pragma unroll
                for (int n = 0; n < 2; ++n) acc[a][b][m][n] = (f32x4){0.f, 0.f, 0.f, 0.f};
    bf16x8 At[4][2], B0[2][2], B1[2][2];
    unsigned vAc[2][2]; unsigned xl00 = 0, xl01 = 0, xl10 = 0, xl11 = 0;
    G8_SETVA(vAc, cur);
    const char* cA = cur.A; const char* cB = cur.B;
    G8_STAGEB(G8_SB(0, 0), cB); G8_STAGEB(G8_SB(0, 1), cB + hstepB); G8_STAGE2(G8_SA(0, 0), cA, vAc[0][0], vAc[0][1]); G8_STAGE2(G8_SA(0, 1), cA, vAc[1][0], vAc[1][1]);
    if (wr == 1) G8_BAR;
    G8_WAIT_V(2); G8_BAR;
    G8_STAGEB(G8_SB(1, 0), cB + kstep); G8_STAGE2(G8_SA(1, 0), cA + kstep, vAc[0][0], vAc[0][1]); G8_STAGEB(G8_SB(1, 1), cB + hstepB + kstep);
    G8_WAIT_V(6); G8_BAR;
    for (;;) {
        const bool has_next = S.next(ui + 1, nxt);
        const char* nA = has_next ? nxt.A : cA; const char* nB = has_next ? nxt.B : cB;
        if (GATHER) { unsigned vAn[2][2]; if (has_next) { G8_SETVA(vAn, nxt); } else {
#pragma unroll
            for (int h = 0; h < 2; ++h)
#pragma unroll
                for (int i = 0; i < 2; ++i) vAn[h][i] = vAc[h][i]; }
            *stash = (v4u){vAn[0][0], vAn[0][1], vAn[1][0], vAn[1][1]}; }
#pragma unroll 1
        for (int t = 0; t < nt; t += 2) {
            const bool last = (t == nt - 2);
            const char* a1 = cA + (size_t)(t + 1) * kstep;
            const char* a2 = last ? nA : cA + (size_t)(t + 2) * kstep; const char* b2 = last ? nB : cB + (size_t)(t + 2) * kstep;
            const char* a3 = a2 + kstep; const char* b3 = b2 + kstep;
            unsigned x00 = vAc[0][0], x01 = vAc[0][1], x10 = vAc[1][0], x11 = vAc[1][1];
            if (GATHER) { if (last) { const v4u sv = *stash; x00 = sv.x; x01 = sv.y; x10 = sv.z; x11 = sv.w; } xl00 = x00; xl01 = x01; xl10 = x10; xl11 = x11; }
            G8_LDB(B0, 0, 0); G8_LDB(B1, 0, 1); G8_SCHED; G8_LDA(At, 0, 0); G8_STAGE2(G8_SA(1, 1), a1, vAc[1][0], vAc[1][1]);
            G8_WAIT_V(8); G8_WAIT_L(0); G8_BAR; G8_MMA(0, 0, At, B0); G8_MMA(0, 1, At, B1); G8_BAR; G8_SCHED;
            G8_LDA(At, 0, 1); G8_STAGEB(G8_SB(0, 0), b2); G8_STAGEB(G8_SB(0, 1), b2 + hstepB); G8_STAGE2(G8_SA(0, 0), a2, x00, x01);
            G8_WAIT_V(8); G8_WAIT_L(0); G8_BAR; G8_MMA(1, 0, At, B0); G8_MMA(1, 1, At, B1); G8_BAR; G8_SCHED;
            G8_LDB(B0, 1, 0); G8_LDB(B1, 1, 1); G8_SCHED; G8_LDA(At, 1, 0); G8_STAGE2(G8_SA(0, 1), a2, x10, x11);
            G8_WAIT_V(8); G8_WAIT_L(0); G8_BAR; G8_MMA(0, 0, At, B0); G8_MMA(0, 1, At, B1); G8_BAR; G8_SCHED;
            G8_LDA(At, 1, 1); G8_STAGEB(G8_SB(1, 0), b3); G8_STAGEB(G8_SB(1, 1), b3 + hstepB); G8_STAGE2(G8_SA(1, 0), a3, x00, x01);
            G8_WAIT_V(8); G8_WAIT_L(0); G8_BAR; G8_MMA(1, 0, At, B0); G8_MMA(1, 1, At, B1); G8_BAR; G8_SCHED;
        }
        if (wr == 0) G8_BAR;
        E(acc, cur, wr, wc, fr, fq);
        if (!has_next) break;
#pragma unroll
        for (int a = 0; a < 2; ++a)
#pragma unroll
            for (int b = 0; b < 2; ++b)
#pragma unroll
                for (int m = 0; m < 4; ++m)
#pragma unroll
                    for (int n = 0; n < 2; ++n) acc[a][b][m][n] = (f32x4){0.f, 0.f, 0.f, 0.f};
        cur = nxt; cA = nA; cB = nB; ++ui;
        if (GATHER) { vAc[0][0] = xl00; vAc[0][1] = xl01; vAc[1][0] = xl10; vAc[1][1] = xl11; }
        if (wr == 1) G8_BAR;
    }
    G8_WAIT_V(0);
    G8_BAR;
#undef G8_SA
#undef G8_SB
#undef G8_STAGE2
#undef G8_STAGEB
#undef G8_LDA
#undef G8_LDB
#undef G8_MMA
#undef G8_WAIT_V
#undef G8_WAIT_L
#undef G8_BAR
#undef G8_SCHED
#undef G8_SETVA
}

struct DenseSched {
    const char* A; const char* B; size_t a_tile, b_tile, agrp_stride; int agrp_shift, nM, nN, nwg, G, c;
    __device__ __forceinline__ void init(const void* A_, const void* B_, int M, int N, int lda, int ldb, int G_, int c_) {
        A = (const char*)A_; B = (const char*)B_; a_tile = (size_t)BM * lda * 2; b_tile = (size_t)BM * ldb * 2; agrp_stride = 0; agrp_shift = 0; nM = M / BM; nN = N / BM; nwg = nM * nN; G = G_; c = c_; }
    __device__ __forceinline__ bool next(int i, Unit& u) const {
        const long L = (long)i * G + c; if (L >= nwg) return false;
        int wgid = (int)L; { const int q = nwg / NXCD, r = nwg % NXCD, xcd = wgid % NXCD, off = wgid / NXCD; wgid = (xcd < r ? xcd * (q + 1) : r * (q + 1) + (xcd - r) * q) + off; }
        const int nig = WGM * nN, gid = wgid / nig, fm = gid * WGM, gsz = (nM - fm) < WGM ? (nM - fm) : WGM;
        u.pm = fm + ((wgid % nig) % gsz); u.pn = (wgid % nig) / gsz;
        u.A = A + (size_t)u.pm * a_tile + (size_t)(u.pn >> agrp_shift) * agrp_stride; u.B = B + (size_t)u.pn * b_tile; u.rows = nullptr; u.nvalid = BM; u.aux = 0; return true;
    }
};
template <int NPN, bool GATHERED>
struct ExpertSched {
    const LAS int* tpref; const LAS int* cnt; const char* A; const char* B; const int* tok; size_t b_exp, b_tile, a_tile; int NU, G, c;
    __device__ __forceinline__ bool next(int i, Unit& u) const {
        int L = i * G + c; if (L >= NU) return false;
        if ((i + 1) * G <= NU && (G % NXCD) == 0) L = i * G + (c % NXCD) * (G / NXCD) + c / NXCD;
        const int tile = L / NPN, pn = L % NPN;
        int e = 0; while (__builtin_amdgcn_readfirstlane(tpref[e + 1]) <= tile) ++e;
        const int rb = tile - __builtin_amdgcn_readfirstlane(tpref[e]);
        u.pm = e; u.pn = pn; u.aux = tile * BM; u.nvalid = __builtin_amdgcn_readfirstlane(cnt[e]) - rb * BM; if (u.nvalid > BM) u.nvalid = BM;
        u.rows = tok + (size_t)e * CAP + rb * BM;
        u.A = GATHERED ? A : A + (size_t)tile * a_tile; u.B = B + (size_t)e * b_exp + (size_t)pn * b_tile; return true;
    }
};

struct EpiBf16 {
    static constexpr bool PERM = true;
    bf16* O; int ldc; int qscale;
    __device__ __forceinline__ void operator()(const f32x4 (&acc)[2][2][4][2], const Unit& u, int wr, int wc, int fr, int fq) const {
        asm volatile("" : "+v"(fr), "+v"(fq));
        const int row0 = u.pm * BM + wr * 64 + fr, col0 = u.pn * BM + wc * 32 + 8 * fq;
        const float sc = (qscale && (u.pn % 6) < 2) ? 0.125f : 1.0f;
#pragma unroll
        for (int ai = 0; ai < 2; ++ai)
#pragma unroll
            for (int m = 0; m < 4; ++m) { bf16* rowp = O + (size_t)(row0 + ai * HALF + m * 16) * ldc + col0;
#pragma unroll
                for (int bj = 0; bj < 2; ++bj) { const f32x4 v0 = acc[ai][bj][m][0] * sc, v1 = acc[ai][bj][m][1] * sc;
                    v4u w; w.x = cvt_pk_bf16(v0[0], v0[1]); w.y = cvt_pk_bf16(v0[2], v0[3]); w.z = cvt_pk_bf16(v1[0], v1[1]); w.w = cvt_pk_bf16(v1[2], v1[3]);
                    *(v4u*)(rowp + bj * HALF) = w; } }
    }
};
struct EpiScaleBf16 {
    static constexpr bool PERM = true;
    bf16* O; int ldc; const float* scale;
    __device__ __forceinline__ void operator()(const f32x4 (&acc)[2][2][4][2], const Unit& u, int wr, int wc, int fr, int fq) const {
        asm volatile("" : "+v"(fr), "+v"(fq));
        const int row0 = u.pm * BM + wr * 64 + fr, col0 = u.pn * BM + wc * 32 + 8 * fq;
        f32x4 sv[2][2];
#pragma unroll
        for (int bj = 0; bj < 2; ++bj)
#pragma unroll
            for (int n = 0; n < 2; ++n) sv[bj][n] = *(const f32x4*)(scale + col0 + bj * HALF + 4 * n);
#pragma unroll
        for (int ai = 0; ai < 2; ++ai)
#pragma unroll
            for (int m = 0; m < 4; ++m) { bf16* rowp = O + (size_t)(row0 + ai * HALF + m * 16) * ldc + col0;
#pragma unroll
                for (int bj = 0; bj < 2; ++bj) { const f32x4 v0 = acc[ai][bj][m][0] * sv[bj][0], v1 = acc[ai][bj][m][1] * sv[bj][1];
                    v4u w; w.x = cvt_pk_bf16(v0[0], v0[1]); w.y = cvt_pk_bf16(v0[2], v0[3]); w.z = cvt_pk_bf16(v1[0], v1[1]); w.w = cvt_pk_bf16(v1[2], v1[3]);
                    *(v4u*)(rowp + bj * HALF) = w; } }
    }
};
struct EpiResid {
    static constexpr bool PERM = false;
    const float* X; float* Y;
    __device__ __forceinline__ void operator()(const f32x4 (&acc)[2][2][4][2], const Unit& u, int wr, int wc, int fr, int fq) const {
        asm volatile("" : "+v"(fr), "+v"(fq));
        const int row0 = u.pm * BM + wr * 64 + fr, col0 = u.pn * BM + wc * 32 + 4 * fq;
#pragma unroll
        for (int ai = 0; ai < 2; ++ai)
#pragma unroll
            for (int m = 0; m < 4; ++m) { const size_t off = (size_t)(row0 + ai * HALF + m * 16) * D + col0;
#pragma unroll
                for (int bj = 0; bj < 2; ++bj)
#pragma unroll
                    for (int n = 0; n < 2; ++n) { const f32x4 xv = *(const f32x4*)(X + off + bj * HALF + n * 16); *(f32x4*)(Y + off + bj * HALF + n * 16) = xv * ALPHA + acc[ai][bj][m][n]; } }
    }
};
struct EpiResidLN {
    static constexpr bool PERM = true;
    const float* X32; const bf16* Xb; const float* st; const float* g; const float* b; bf16* Y; float* pst; int mode;
    __device__ __forceinline__ void operator()(const f32x4 (&acc)[2][2][4][2], const Unit& u, int wr, int wc, int fr, int fq) const {
        asm volatile("" : "+v"(fr), "+v"(fq));
        const int row0 = u.pm * BM + wr * 64 + fr, col0 = u.pn * BM + wc * 32 + 8 * fq, lane = fq * 16 + fr;
#pragma unroll
        for (int ai = 0; ai < 2; ++ai)
#pragma unroll
            for (int m = 0; m < 4; ++m) { const int row = row0 + ai * HALF + m * 16; const size_t off = (size_t)row * D + col0;
                float mean = 0.f, rstd = 1.f; if (mode == 1) { const f32x2 sv = *(const f32x2*)(st + 2 * row); mean = sv.x; rstd = sv.y; }
                float sm = 0.f, sq = 0.f;
#pragma unroll
                for (int bj = 0; bj < 2; ++bj) { f32x4 x0, x1;
                    if (mode == 2) { const v4u xv = *(const v4u*)(Xb + off + bj * HALF); x0 = (f32x4){bflo(xv.x), bfhi(xv.x), bflo(xv.y), bfhi(xv.y)}; x1 = (f32x4){bflo(xv.z), bfhi(xv.z), bflo(xv.w), bfhi(xv.w)}; }
                    else if (mode) { const v4u xv = *(const v4u*)(Xb + off + bj * HALF);
                        const f32x4 g0 = *(const f32x4*)(g + col0 + bj * HALF), g1 = *(const f32x4*)(g + col0 + bj * HALF + 4), b0 = *(const f32x4*)(b + col0 + bj * HALF), b1 = *(const f32x4*)(b + col0 + bj * HALF + 4);
                        x0 = ((f32x4){bflo(xv.x), bfhi(xv.x), bflo(xv.y), bfhi(xv.y)} - mean) * rstd * g0 + b0; x1 = ((f32x4){bflo(xv.z), bfhi(xv.z), bflo(xv.w), bfhi(xv.w)} - mean) * rstd * g1 + b1; }
                    else { x0 = *(const f32x4*)(X32 + off + bj * HALF); x1 = *(const f32x4*)(X32 + off + bj * HALF + 4); }
                    const f32x4 y0 = x0 * ALPHA + acc[ai][bj][m][0], y1 = x1 * ALPHA + acc[ai][bj][m][1];
                    v4u w; w.x = cvt_pk_bf16(y0[0], y0[1]); w.y = cvt_pk_bf16(y0[2], y0[3]); w.z = cvt_pk_bf16(y1[0], y1[1]); w.w = cvt_pk_bf16(y1[2], y1[3]);
                    *(v4u*)(Y + off + bj * HALF) = w;
                    sm += ((y0[0] + y0[1]) + (y0[2] + y0[3])) + ((y1[0] + y1[1]) + (y1[2] + y1[3]));
                    sq += ((y0[0] * y0[0] + y0[1] * y0[1]) + (y0[2] * y0[2] + y0[3] * y0[3])) + ((y1[0] * y1[0] + y1[1] * y1[1]) + (y1[2] * y1[2] + y1[3] * y1[3])); }
                sm += shfl_x(sm, 16, lane); sm += shfl_x(sm, 32, lane); sq += shfl_x(sq, 16, lane); sq += shfl_x(sq, 32, lane);
                if (fq == 0) *(f32x2*)(pst + ((size_t)row * 32 + u.pn * 4 + wc) * 2) = (f32x2){sm, sq}; }
    }
};
struct EpiConvIn {
    static constexpr bool PERM = true;
    bf16* UC; bf16* BGp;
    __device__ __forceinline__ void operator()(const f32x4 (&acc)[2][2][4][2], const Unit& u, int wr, int wc, int fr, int fq) const {
        asm volatile("" : "+v"(fr), "+v"(fq));
        const int row0 = u.pm * BM + wr * 64 + fr, cw = wc * 32 + 8 * fq;
        if (u.pn < 16) {
#pragma unroll
            for (int ai = 0; ai < 2; ++ai)
#pragma unroll
                for (int m = 0; m < 4; ++m) { bf16* rowp = UC + (size_t)(row0 + ai * HALF + m * 16) * D + u.pn * HALF + cw;
                    const f32x4 v0 = acc[ai][0][m][0] * acc[ai][1][m][0], v1 = acc[ai][0][m][1] * acc[ai][1][m][1];
                    v4u w; w.x = cvt_pk_bf16(v0[0], v0[1]); w.y = cvt_pk_bf16(v0[2], v0[3]); w.z = cvt_pk_bf16(v1[0], v1[1]); w.w = cvt_pk_bf16(v1[2], v1[3]);
                    *(v4u*)rowp = w; }
        } else {
#pragma unroll
            for (int ai = 0; ai < 2; ++ai)
#pragma unroll
                for (int m = 0; m < 4; ++m) { bf16* rowp = BGp + (size_t)(row0 + ai * HALF + m * 16) * D + (u.pn - 16) * BM + cw;
#pragma unroll
                    for (int bj = 0; bj < 2; ++bj) { const f32x4 v0 = acc[ai][bj][m][0], v1 = acc[ai][bj][m][1];
                        v4u w; w.x = cvt_pk_bf16(v0[0], v0[1]); w.y = cvt_pk_bf16(v0[2], v0[3]); w.z = cvt_pk_bf16(v1[0], v1[1]); w.w = cvt_pk_bf16(v1[2], v1[3]);
                        *(v4u*)(rowp + bj * HALF) = w; } }
        }
    }
};
__device__ __forceinline__ f32x4 silu_mul(f32x4 g, f32x4 uu) {
    f32x4 r;
#pragma unroll
    for (int j = 0; j < 4; ++j) r[j] = g[j] * __builtin_amdgcn_rcpf(1.0f + __expf(-g[j])) * uu[j];
    return r;
}
struct EpiExpertGU {
    static constexpr bool PERM = true;
    bf16* H;
    __device__ __forceinline__ void operator()(const f32x4 (&acc)[2][2][4][2], const Unit& u, int wr, int wc, int fr, int fq) const {
        asm volatile("" : "+v"(fr), "+v"(fq));
        const float* gates = (const float*)((const char*)u.rows + (WS_LGATE - WS_LTOK));
        const int cw = wc * 32 + 8 * fq;
#pragma unroll
        for (int ai = 0; ai < 2; ++ai)
#pragma unroll
            for (int m = 0; m < 4; ++m) { const int r = ai * HALF + wr * 64 + m * 16 + fr;
                if (r < u.nvalid) { const float gt = gates[r]; const unsigned pid = (unsigned)u.rows[r];
                    const f32x4 v0 = silu_mul(acc[ai][0][m][0], acc[ai][1][m][0]) * gt, v1 = silu_mul(acc[ai][0][m][1], acc[ai][1][m][1]) * gt;
                    v4u w; w.x = cvt_pk_bf16(v0[0], v0[1]); w.y = cvt_pk_bf16(v0[2], v0[3]); w.z = cvt_pk_bf16(v1[0], v1[1]); w.w = cvt_pk_bf16(v1[2], v1[3]);
                    (void)pid; *(v4u*)(H + (size_t)(u.aux + r) * EDIM + cw) = w; } }
    }
};
struct EpiSharedGU {
    static constexpr bool PERM = true;
    bf16* HS;
    __device__ __forceinline__ void operator()(const f32x4 (&acc)[2][2][4][2], const Unit& u, int wr, int wc, int fr, int fq) const {
        asm volatile("" : "+v"(fr), "+v"(fq));
        const int row0 = u.pm * BM + wr * 64 + fr, cw = u.pn * HALF + wc * 32 + 8 * fq;
#pragma unroll
        for (int ai = 0; ai < 2; ++ai)
#pragma unroll
            for (int m = 0; m < 4; ++m) {
                const f32x4 v0 = silu_mul(acc[ai][0][m][0], acc[ai][1][m][0]), v1 = silu_mul(acc[ai][0][m][1], acc[ai][1][m][1]);
                v4u w; w.x = cvt_pk_bf16(v0[0], v0[1]); w.y = cvt_pk_bf16(v0[2], v0[3]); w.z = cvt_pk_bf16(v1[0], v1[1]); w.w = cvt_pk_bf16(v1[2], v1[3]);
                *(v4u*)(HS + (size_t)(row0 + ai * HALF + m * 16) * SDIM + cw) = w; }
    }
};
struct EpiDownY {
    static constexpr bool PERM = true;
    bf16* Y;
    __device__ __forceinline__ void operator()(const f32x4 (&acc)[2][2][4][2], const Unit& u, int wr, int wc, int fr, int fq) const {
        asm volatile("" : "+v"(fr), "+v"(fq));
        const int col0 = u.pn * BM + wc * 32 + 8 * fq;
#pragma unroll
        for (int ai = 0; ai < 2; ++ai)
#pragma unroll
            for (int m = 0; m < 4; ++m) { const int r = ai * HALF + wr * 64 + m * 16 + fr; bf16* rowp = Y + (size_t)(u.aux + r) * D + col0;
#pragma unroll
                for (int bj = 0; bj < 2; ++bj) { const f32x4 v0 = acc[ai][bj][m][0], v1 = acc[ai][bj][m][1];
                    v4u w; w.x = cvt_pk_bf16(v0[0], v0[1]); w.y = cvt_pk_bf16(v0[2], v0[3]); w.z = cvt_pk_bf16(v1[0], v1[1]); w.w = cvt_pk_bf16(v1[2], v1[3]);
                    *(v4u*)(rowp + bj * HALF) = w; } }
    }
};
}

struct Args { const float* in[19]; float* out; unsigned char* ws; int ph_lo, ph_hi; };
struct Frame {
    LAS unsigned char* lds; unsigned* ctl; unsigned char* ws;
    int tid, lane, wave, G, bid;
};
enum { IN_X = 0, IN_RELB, IN_PWIN, IN_PWG, IN_PSC, IN_PWOUT, IN_DQKV, IN_DOUT, IN_CWIN, IN_CW, IN_CWOUT, IN_LNG, IN_LNB, IN_RW, IN_RB, IN_EGU, IN_ED, IN_SGU, IN_SD };

#define CAS __attribute__((address_space(4)))
typedef const CAS unsigned char* KP;
__device__ __forceinline__ const float* ain(KP kp, int i) { return (const float*)((const GAS float* const CAS*)kp)[i]; }
__device__ __forceinline__ float* aout(KP kp) { return (float*)((GAS float* const CAS*)kp)[19]; }
__device__ __forceinline__ void tr_item(const float* W, int K, int N, bf16* WT, int dstK, int mode, LAS float* scr, int item, int lane) {
    const int nblk = N / 32, kb = item / nblk, nb = item % nblk, k0 = 64 * kb, n0 = 32 * nb;
    int r0 = n0;
    if (mode == 1) { const int part = n0 / 2048, j = n0 % 2048; r0 = (part == 0) ? 4096 + j : 256 * (j / 128) + (part == 2 ? 128 : 0) + (j % 128); }
    if (mode == 2) { const int part = n0 / 256, j = n0 % 256; r0 = 256 * (j / 128) + 128 * part + (j % 128); }
#pragma unroll 8
    for (int i = 0; i < 32; ++i) { const int kk = 2 * i + (lane >> 5); scr[kk * 33 + (lane & 31)] = __builtin_nontemporal_load(W + (size_t)(k0 + kk) * N + n0 + (lane & 31)); }
    LDS_WAIT(); asm volatile("" ::: "memory");
    const int c = lane & 7;
#pragma unroll
    for (int j = 0; j < 4; ++j) { const int n = (lane >> 3) + 8 * j; const LAS float* s = scr + (8 * c) * 33 + n;
        v4u o; o.x = pk2(s[0 * 33], s[1 * 33]); o.y = pk2(s[2 * 33], s[3 * 33]); o.z = pk2(s[4 * 33], s[5 * 33]); o.w = pk2(s[6 * 33], s[7 * 33]);
        __builtin_nontemporal_store(o, (v4u*)(WT + (size_t)(r0 + n) * dstK + k0 + 8 * c)); }
    LDS_WAIT(); asm volatile("" ::: "memory");
}
__device__ __forceinline__ void phase_prologue(const Frame& F, KP kp) {
    LAS float* scr = (LAS float*)(F.lds + F.wave * 16384);
    const int gw = F.bid * 8 + F.wave, NGW = F.G * 8;
    constexpr int I0 = 2 * 2048, I1 = 8 * 128, I2 = 2 * 2048, I3 = 4608, I4 = 512, I5 = 6144, I6 = 2048, I7 = 4 * 512, I8 = 4 * 256, I9 = 256 * 256, I10 = 256 * 128;
    constexpr int NITEMS = I0 + I1 + I2 + I3 + I4 + I5 + I6 + I7 + I8 + I9 + I10;
    unsigned char* ws = F.ws;
    for (int it = gw; it < NITEMS; it += NGW) {
        int r = it;
        if (r < I0) { const int b = r / 2048; tr_item(ain(kp, IN_PWIN) + (size_t)b * D * D, D, D, (bf16*)(ws + WS_W_POOL_IN) + (size_t)b * D * D, D, 0, scr, r % 2048, F.lane); continue; } r -= I0;
        if (r < I1) { const int b = r / 128; tr_item(ain(kp, IN_PWG) + (size_t)b * 512 * 512, 512, 512, (bf16*)(ws + WS_W_POOL_G) + (size_t)b * 512 * 512, 512, 0, scr, r % 128, F.lane); continue; } r -= I1;
        if (r < I2) { const int b = r / 2048; tr_item(ain(kp, IN_PWOUT) + (size_t)b * D * D, D, D, (bf16*)(ws + WS_W_POOL_OUT) + (size_t)b * D * D, D, 0, scr, r % 2048, F.lane); continue; } r -= I2;
        if (r < I3) { tr_item(ain(kp, IN_DQKV), D, QKVC, (bf16*)(ws + WS_W_DIL_QKV), D, 0, scr, r, F.lane); continue; } r -= I3;
        if (r < I4) { tr_item(ain(kp, IN_DOUT), DILW, D, (bf16*)(ws + WS_W_DIL_OUT), DILW, 0, scr, r, F.lane); continue; } r -= I4;
        if (r < I5) { tr_item(ain(kp, IN_CWIN), D, 3 * D, (bf16*)(ws + WS_W_CONV_IN), D, 1, scr, r, F.lane); continue; } r -= I5;
        if (r < I6) { tr_item(ain(kp, IN_CWOUT), D, D, (bf16*)(ws + WS_W_CONV_OUT), D, 0, scr, r, F.lane); continue; } r -= I6;
        if (r < I7) { const int b = r / 512; tr_item(ain(kp, IN_SGU) + (size_t)b * D * 512, D, 512, (bf16*)(ws + WS_W_SH_GU) + (size_t)b * 512 * D, D, 2, scr, r % 512, F.lane); continue; } r -= I7;
        if (r < I8) { const int b = r / 256; tr_item(ain(kp, IN_SD) + (size_t)b * SDIM * D, SDIM, D, (bf16*)(ws + WS_W_SH_D) + (size_t)b * D * SDIM, SDIM, 0, scr, r % 256, F.lane); continue; } r -= I8;
        if (r < I9) { const int b = r / 256; tr_item(ain(kp, IN_EGU) + (size_t)b * D * 256, D, 256, (bf16*)(ws + WS_W_EX_GU) + (size_t)b * 256 * D, D, 0, scr, r % 256, F.lane); continue; } r -= I9;
        { const int b = r / 128; tr_item(ain(kp, IN_ED) + (size_t)b * EDIM * D, EDIM, D, (bf16*)(ws + WS_W_EX_D) + (size_t)b * D * EDIM, EDIM, 0, scr, r % 128, F.lane); }
    }
    const size_t gt = (size_t)F.bid * 512 + F.tid, GT = (size_t)F.G * 512;
    { const float* rw = ain(kp, IN_RW); bf16* wh = (bf16*)(ws + WS_RWH); bf16* wl = (bf16*)(ws + WS_RWL);
      for (size_t i = gt; i < (size_t)DEPTH * NEXP * D / 8; i += GT) { const size_t k8 = i % (D / 8), e = (i / (D / 8)) % NEXP, l = i / ((size_t)NEXP * D / 8);
          float v[8]; unsigned hi[8], lo[8];
#pragma unroll
          for (int j = 0; j < 8; ++j) { v[j] = rw[(l * D + k8 * 8 + j) * NEXP + e]; hi[j] = f2bf(v[j]); lo[j] = f2bf(v[j] - __builtin_bit_cast(float, hi[j] << 16)); }
          v4u a, b2; a.x = hi[0] | (hi[1] << 16); a.y = hi[2] | (hi[3] << 16); a.z = hi[4] | (hi[5] << 16); a.w = hi[6] | (hi[7] << 16);
          b2.x = lo[0] | (lo[1] << 16); b2.y = lo[2] | (lo[3] << 16); b2.z = lo[4] | (lo[5] << 16); b2.w = lo[6] | (lo[7] << 16);
          *(v4u*)(wh + (l * NEXP + e) * D + k8 * 8) = a; *(v4u*)(wl + (l * NEXP + e) * D + k8 * 8) = b2; } }
    const float* x = ain(kp, IN_X); bf16* xb = (bf16*)(ws + WS_XB);
    for (size_t i = gt; i < (size_t)T * D / 8; i += GT) { const f32x4 p = __builtin_nontemporal_load((const f32x4*)(x + i * 8)), q = __builtin_nontemporal_load((const f32x4*)(x + i * 8 + 4));
        v4u w; w.x = pk2(p[0], p[1]); w.y = pk2(p[2], p[3]); w.z = pk2(q[0], q[1]); w.w = pk2(q[2], q[3]); *(v4u*)(xb + i * 8) = w; }
}

__device__ __forceinline__ void unpack8(const v4u w, float (&f)[8]) { f[0] = bflo(w.x); f[1] = bfhi(w.x); f[2] = bflo(w.y); f[3] = bfhi(w.y); f[4] = bflo(w.z); f[5] = bfhi(w.z); f[6] = bflo(w.w); f[7] = bfhi(w.w); }
__device__ __forceinline__ void phase_pool(const Frame& F, const bf16* U, bf16* PL) {
    for (int it = F.bid * 512 + F.tid; it < (T / 32) * 256; it += F.G * 512) {
        const int cv = it & 255, ch = it >> 8, col = cv * 8, w = 2 << (col >> 9);
        const int row0 = ch * 32, pos0 = row0 & (SEQ - 1);
        float s[8], uu[8];
#pragma unroll
        for (int j = 0; j < 8; ++j) s[j] = 0.f;
        for (int j = 1; j < w; ++j) if (pos0 - j >= 0) { unpack8(*(const v4u*)(U + (size_t)(row0 - j) * D + col), uu);
#pragma unroll
            for (int q = 0; q < 8; ++q) s[q] += uu[q]; }
        for (int r = 0; r < 32; ++r) {
            const int t = row0 + r, pos = pos0 + r;
            unpack8(*(const v4u*)(U + (size_t)t * D + col), uu);
            const float inv = 1.0f / (float)((pos + 1) < w ? (pos + 1) : w);
            float o[8];
#pragma unroll
            for (int q = 0; q < 8; ++q) { s[q] += uu[q]; o[q] = s[q] * inv - uu[q]; }
            v4u ww; ww.x = pk2(o[0], o[1]); ww.y = pk2(o[2], o[3]); ww.z = pk2(o[4], o[5]); ww.w = pk2(o[6], o[7]);
            *(v4u*)(PL + (size_t)t * D + col) = ww;
            if (pos - w + 1 >= 0) { unpack8(*(const v4u*)(U + (size_t)(t - w + 1) * D + col), uu);
#pragma unroll
                for (int q = 0; q < 8; ++q) s[q] -= uu[q]; }
        }
    }
}

__device__ __forceinline__ void phase_conv(const Frame& F, const bf16* UC, const bf16* BGp, const float* cw, bf16* Z) {
    for (int it = F.bid * 512 + F.tid; it < T * 256; it += F.G * 512) {
        const int cv = it & 255, t = it >> 8, col = cv * 8, pos = t & (SEQ - 1);
        float u0[8], u1[8], u2[8], bb[8], o[8];
        unpack8(*(const v4u*)(UC + (size_t)t * D + col), u2);
        if (pos >= 1) unpack8(*(const v4u*)(UC + (size_t)(t - 1) * D + col), u1); else {
#pragma unroll
            for (int q = 0; q < 8; ++q) u1[q] = 0.f; }
        if (pos >= 2) unpack8(*(const v4u*)(UC + (size_t)(t - 2) * D + col), u0); else {
#pragma unroll
            for (int q = 0; q < 8; ++q) u0[q] = 0.f; }
        unpack8(*(const v4u*)(BGp + (size_t)t * D + col), bb);
#pragma unroll
        for (int q = 0; q < 8; ++q) o[q] = bb[q] * (cw[col + q] * u0[q] + cw[D + col + q] * u1[q] + cw[2 * D + col + q] * u2[q]);
        v4u ww; ww.x = pk2(o[0], o[1]); ww.y = pk2(o[2], o[3]); ww.z = pk2(o[4], o[5]); ww.w = pk2(o[6], o[7]);
        *(v4u*)(Z + (size_t)t * D + col) = ww;
    }
}

__device__ __forceinline__ int t5_bucket(int dist) {
    if (dist < 16) return dist;
    int large = 16 + (int)(logf((float)dist / 16.0f) / logf(128.0f) * 16.0f);
    return large < 31 ? large : 31;
}
constexpr int AT_KS = 0, AT_KSTR = 144, AT_VT = 256 * 144, AT_VSTR = 520, AT_BIAS = AT_VT + 64 * 520;
__device__ __forceinline__ void phase_attn(const Frame& F, const bf16* QKV, const float* relb, bf16* OG, float* LSE) {
    LAS unsigned char* lds = F.lds;
    const int tid = F.tid, lane = F.lane, w = tid >> 6, fr = lane & 15, fq = lane >> 4;
    for (int unit = F.bid; unit < NBATCH * 3 * 8 * 16; unit += F.G) {
        const int cmb = unit & 15, h = (unit >> 4) & 7, g = (unit >> 7) % 3, b = unit / 384;
        const int dsh = 2 * g, dil = 1 << dsh, r = cmb & (dil - 1), nb = cmb >> dsh;
        const bf16* base = QKV + (size_t)b * SEQ * QKVC + g * 1536 + h * 64;
        __syncthreads();
        {
            const int key = tid >> 1, half = tid & 1, jk = (nb - 1) * 128 + key;
            v4u kv[4], vv[4];
            if (jk >= 0) { const bf16* rp = base + (size_t)(jk * dil + r) * QKVC + half * 32;
#pragma unroll
                for (int i = 0; i < 4; ++i) { kv[i] = *(const v4u*)(rp + 512 + 8 * i); vv[i] = *(const v4u*)(rp + 1024 + 8 * i); } }
            else {
#pragma unroll
                for (int i = 0; i < 4; ++i) { kv[i] = (v4u){0u, 0u, 0u, 0u}; vv[i] = (v4u){0u, 0u, 0u, 0u}; } }
#pragma unroll
            for (int i = 0; i < 4; ++i) *(LAS v4u*)(lds + AT_KS + key * AT_KSTR + half * 64 + 16 * i) = kv[i];
#pragma unroll
            for (int i = 0; i < 4; ++i) {
                const unsigned ww[4] = {vv[i].x, vv[i].y, vv[i].z, vv[i].w};
#pragma unroll
                for (int q = 0; q < 4; ++q) { const int d = half * 32 + 8 * i + 2 * q;
                    *(LAS unsigned short*)(lds + AT_VT + d * AT_VSTR + key * 2) = (unsigned short)(ww[q] & 0xffffu);
                    *(LAS unsigned short*)(lds + AT_VT + (d + 1) * AT_VSTR + key * 2) = (unsigned short)(ww[q] >> 16); } }
            if (tid <= 128) ((LAS float*)(lds + AT_BIAS))[tid] = relb[t5_bucket(tid * dil) * 24 + g * 8 + h];
        }
        __syncthreads();
        int qi = 16 * w + fr; asm volatile("" : "+v"(qi));
        const int jq = nb * 128 + qi, tq = jq * dil + r;
        const bf16* qp = base + (size_t)tq * QKVC + 8 * fq;
        const bf16x8 q0 = *(const bf16x8*)qp, q1 = *(const bf16x8*)(qp + 32);
        f32x4 s[9]; float mx = -INFINITY;
#pragma unroll
        for (int kt = 0; kt < 9; ++kt) {
            const int kb = 16 * (w + kt);
            const bf16x8 k0 = *(const LAS bf16x8*)(lds + AT_KS + (kb + fr) * AT_KSTR + fq * 16), k1 = *(const LAS bf16x8*)(lds + AT_KS + (kb + fr) * AT_KSTR + 64 + fq * 16);
            f32x4 a = (f32x4){0.f, 0.f, 0.f, 0.f};
            a = __builtin_amdgcn_mfma_f32_16x16x32_bf16(k0, q0, a, 0, 0, 0);
            a = __builtin_amdgcn_mfma_f32_16x16x32_bf16(k1, q1, a, 0, 0, 0);
#pragma unroll
            for (int i = 0; i < 4; ++i) { const int kl = kb + 4 * fq + i, rel = qi + 128 - kl;
                const bool ok = (rel >= 0) && (rel <= 128) && (nb > 0 || kl >= 128);
                const int rc = rel < 0 ? 0 : (rel > 128 ? 128 : rel);
                const float v = ok ? a[i] + ((LAS float*)(lds + AT_BIAS))[rc] : -INFINITY;
                a[i] = v; mx = fmaxf(mx, v); }
            s[kt] = a;
        }
        mx = fmaxf(mx, shfl_x(mx, 16, lane)); mx = fmaxf(mx, shfl_x(mx, 32, lane));
        float l = 0.f;
#pragma unroll
        for (int kt = 0; kt < 9; ++kt)
#pragma unroll
            for (int i = 0; i < 4; ++i) { const float p = __expf(s[kt][i] - mx); s[kt][i] = p; l += p; }
        l += shfl_x(l, 16, lane); l += shfl_x(l, 32, lane);
        f32x4 o[4];
#pragma unroll
        for (int nt = 0; nt < 4; ++nt) o[nt] = (f32x4){0.f, 0.f, 0.f, 0.f};
#pragma unroll
        for (int st = 0; st < 5; ++st) {
            const int kt0 = 2 * st, kt1 = 2 * st + 1;
            v4u pw; pw.x = pk2(s[kt0][0], s[kt0][1]); pw.y = pk2(s[kt0][2], s[kt0][3]);
            if (kt1 < 9) { pw.z = pk2(s[kt1 < 9 ? kt1 : 0][0], s[kt1 < 9 ? kt1 : 0][1]); pw.w = pk2(s[kt1 < 9 ? kt1 : 0][2], s[kt1 < 9 ? kt1 : 0][3]); } else { pw.z = 0u; pw.w = 0u; }
            const bf16x8 pf = __builtin_bit_cast(bf16x8, pw);
            const int kb0 = 16 * (w + kt0) + 4 * fq, kb1 = 16 * (w + kt1) + 4 * fq;
#pragma unroll
            for (int nt = 0; nt < 4; ++nt) { const int d = 16 * nt + fr;
                v2u va = *(const LAS v2u*)(lds + AT_VT + d * AT_VSTR + kb0 * 2), vb = (v2u){0u, 0u};
                if (kt1 < 9) vb = *(const LAS v2u*)(lds + AT_VT + d * AT_VSTR + kb1 * 2);
                v4u vw; vw.x = va.x; vw.y = va.y; vw.z = vb.x; vw.w = vb.y;
                o[nt] = __builtin_amdgcn_mfma_f32_16x16x32_bf16(__builtin_bit_cast(bf16x8, vw), pf, o[nt], 0, 0, 0); }
        }
        const float il = 1.0f / l;
        bf16* op = OG + ((size_t)g * T + (size_t)b * SEQ + tq) * DILW + h * 64 + 4 * fq;
#pragma unroll
        for (int nt = 0; nt < 4; ++nt) { v2u ww; ww.x = pk2(o[nt][0] * il, o[nt][1] * il); ww.y = pk2(o[nt][2] * il, o[nt][3] * il); *(v2u*)(op + 16 * nt) = ww; }
        if (fq == 0) LSE[((size_t)g * T + (size_t)b * SEQ + tq) * 8 + h] = mx + logf(l);
    }
}
__device__ __forceinline__ void phase_combine(const Frame& F, const bf16* OG, const float* LSE, bf16* O) {
    for (int it = F.bid * 512 + F.tid; it < T * 64; it += F.G * 512) {
        const int c8 = it & 7, h = (it >> 3) & 7, t = it >> 6;
        const float l0 = LSE[((size_t)0 * T + t) * 8 + h], l1 = LSE[((size_t)1 * T + t) * 8 + h], l2 = LSE[((size_t)2 * T + t) * 8 + h];
        const float m = fmaxf(l0, fmaxf(l1, l2)); float w0 = __expf(l0 - m), w1 = __expf(l1 - m), w2 = __expf(l2 - m); const float inv = 1.0f / (w0 + w1 + w2); w0 *= inv; w1 *= inv; w2 *= inv;
        float a[8], bq[8], c[8], o[8]; const size_t off = (size_t)t * DILW + h * 64 + c8 * 8;
        unpack8(*(const v4u*)(OG + off), a); unpack8(*(const v4u*)(OG + (size_t)T * DILW + off), bq); unpack8(*(const v4u*)(OG + (size_t)2 * T * DILW + off), c);
#pragma unroll
        for (int q = 0; q < 8; ++q) o[q] = w0 * a[q] + w1 * bq[q] + w2 * c[q];
        v4u ww; ww.x = pk2(o[0], o[1]); ww.y = pk2(o[2], o[3]); ww.z = pk2(o[4], o[5]); ww.w = pk2(o[6], o[7]);
        *(v4u*)(O + off) = ww;
    }
}

constexpr int M1_LOG = 131072, M1_STAT = M1_LOG + 4096, M1_HIST = M1_STAT + 128, M1_BASE = M1_HIST + 256;
__device__ __forceinline__ void phase_moe1(const Frame& F, const float* Y, const float* gain, const float* bias, const float* RW, const float* RB,
                                           float* X1F, bf16* X1B, unsigned* cnt, int* ltok, float* lgate, int* eidx, int* inv) {
    LAS float* xs = (LAS float*)F.lds; LAS float* logit = (LAS float*)(F.lds + M1_LOG); LAS float* stat = (LAS float*)(F.lds + M1_STAT);
    LAS int* hist = (LAS int*)(F.lds + M1_HIST); LAS int* basep = (LAS int*)(F.lds + M1_BASE);
    const int tid = F.tid, lane = F.lane, w = F.wave;
    for (int rg = F.bid; rg < T / 16; rg += F.G) {
        const int row0 = rg * 16;
        __syncthreads();
#pragma unroll
        for (int j = 0; j < 16; ++j) { const int idx = tid + 512 * j; *(LAS f32x4*)(xs + idx * 4) = *(const f32x4*)(Y + (size_t)row0 * D + (size_t)idx * 4); }
        if (tid < 64) hist[tid] = 0;
        __syncthreads();
#pragma unroll
        for (int rr = 0; rr < 2; ++rr) { const int r = 2 * w + rr; float sm = 0.f;
#pragma unroll
            for (int j = 0; j < 32; ++j) sm += xs[r * D + lane + 64 * j];
            const float mean = wave_sum(sm, lane) * (1.0f / D); float sq = 0.f;
#pragma unroll
            for (int j = 0; j < 32; ++j) { const float d = xs[r * D + lane + 64 * j] - mean; sq += d * d; }
            const float rstd = 1.0f / sqrtf(wave_sum(sq, lane) * (1.0f / D) + LN_EPS);
            if (lane == 0) { stat[2 * r] = mean; stat[2 * r + 1] = rstd; } }
        __syncthreads();
#pragma unroll
        for (int j = 0; j < 16; ++j) { const int idx = tid + 512 * j, r = idx >> 9, c4 = (idx & 511) * 4;
            const f32x4 v = *(LAS f32x4*)(xs + idx * 4), gv = *(const f32x4*)(gain + c4), bv = *(const f32x4*)(bias + c4);
            const float mean = stat[2 * r], rstd = stat[2 * r + 1];
            const f32x4 o = (v - mean) * rstd * gv + bv;
            *(LAS f32x4*)(xs + idx * 4) = o;
            *(f32x4*)(X1F + (size_t)(row0 + r) * D + c4) = o;
            v2u wb; wb.x = pk2(o[0], o[1]); wb.y = pk2(o[2], o[3]); *(v2u*)(X1B + (size_t)(row0 + r) * D + c4) = wb; }
        __syncthreads();
        { const int r = tid >> 5, ep = tid & 31; float a0 = 0.f, a1 = 0.f; const float* wp = RW + 2 * ep; const LAS float* xr = xs + r * D;
            for (int k0 = 0; k0 < D; k0 += 16) {
                f32x2 wv[16];
#pragma unroll
                for (int j = 0; j < 16; ++j) wv[j] = *(const f32x2*)(wp + (size_t)(k0 + j) * NEXP);
                asm volatile("" : "+v"(wv[0]), "+v"(wv[1]), "+v"(wv[2]), "+v"(wv[3]), "+v"(wv[4]), "+v"(wv[5]), "+v"(wv[6]), "+v"(wv[7]));
                asm volatile("" : "+v"(wv[8]), "+v"(wv[9]), "+v"(wv[10]), "+v"(wv[11]), "+v"(wv[12]), "+v"(wv[13]), "+v"(wv[14]), "+v"(wv[15]));
#pragma unroll
                for (int j = 0; j < 16; ++j) { const float xv = xr[k0 + j]; a0 += xv * wv[j].x; a1 += xv * wv[j].y; } }
            logit[r * NEXP + 2 * ep] = a0; logit[r * NEXP + 2 * ep + 1] = a1; }
        __syncthreads();
        int sel_pos[2]; float sel_gate[2]; int sel_rank[2]; bool sel_on[2];
#pragma unroll
        for (int rr = 0; rr < 2; ++rr) { const int r = 2 * w + rr;
            const float sc = 1.0f / (1.0f + __expf(-logit[r * NEXP + lane])); const float ch = sc + RB[lane];
            int rk = 0;
#pragma unroll
            for (int j = 0; j < 8; ++j) { const float cj = shfl_from(ch, (lane & ~7) + j); rk += (cj > ch || (cj == ch && j < (lane & 7))) ? 1 : 0; }
            float gs = rk < 2 ? ch : 0.f; gs += shfl_x(gs, 1, lane); gs += shfl_x(gs, 2, lane); gs += shfl_x(gs, 4, lane);
            int grk = 0; const int g = lane >> 3;
#pragma unroll
            for (int hh = 0; hh < 8; ++hh) { const float gh = shfl_from(gs, 8 * hh); grk += (gh > gs || (gh == gs && hh < g)) ? 1 : 0; }
            const float msk = grk < 4 ? ch : -INFINITY;
            int erk = 0;
            for (int j = 0; j < 64; ++j) { const float mj = __builtin_bit_cast(float, __builtin_amdgcn_readlane(__builtin_bit_cast(int, msk), j)); erk += (mj > msk || (mj == msk && j < lane)) ? 1 : 0; }
            const bool on = erk < 8;
            const float ssum = wave_sum(on ? sc : 0.f, lane);
            sel_on[rr] = on; sel_rank[rr] = erk; sel_gate[rr] = sc / ssum * 2.5f; sel_pos[rr] = 0;
            if (on) sel_pos[rr] = __hip_atomic_fetch_add(&hist[lane], 1, __ATOMIC_RELAXED, __HIP_MEMORY_SCOPE_WORKGROUP); }
        __syncthreads();
        if (tid < 64) { const int hc = hist[tid]; int bs = 0; if (hc > 0) bs = (int)atomicAdd(&cnt[tid * 16], (unsigned)hc); basep[tid] = bs; }
        __syncthreads();
#pragma unroll
        for (int rr = 0; rr < 2; ++rr) if (sel_on[rr]) { const int t = row0 + 2 * w + rr, pos = basep[lane] + sel_pos[rr];
            ltok[(size_t)lane * CAP + pos] = t; lgate[(size_t)lane * CAP + pos] = sel_gate[rr];
            eidx[t * 8 + sel_rank[rr]] = lane; inv[t * 8 + sel_rank[rr]] = pos; }
    }
}
__device__ __forceinline__ int build_tiles(const Frame& F, const unsigned* cnt) {
    LAS int* tpref = (LAS int*)(F.lds + LDS_TAB); LAS int* cl = (LAS int*)(F.lds + LDS_TAB + 512);
    __syncthreads();
    if (F.tid < 64) cl[F.tid] = (int)__hip_atomic_load(&cnt[F.tid * 16], __ATOMIC_RELAXED, __HIP_MEMORY_SCOPE_AGENT);
    __syncthreads();
    if (F.tid == 0) { int acc = 0; for (int e = 0; e < 64; ++e) { tpref[e] = acc; acc += (cl[e] + 255) >> 8; } tpref[64] = acc; tpref[65] = acc + T / 256; tpref[66] = acc + 2 * (T / 256); cl[64] = T; cl[65] = T; }
    __syncthreads();
    return __builtin_amdgcn_readfirstlane(tpref[64]);
}
__device__ __forceinline__ void phase_moe4(const Frame& F, const float* Y2, const bf16* Yr, const int* eidx, const int* inv, const float* gain, const float* bias, float* XO, bf16* XBo) {
    const LAS int* tpref = (const LAS int*)(F.lds + LDS_TAB);
    const int gw = F.bid * 8 + F.wave, NGW = F.G * 8, lane = F.lane;
    for (int t = gw; t < T; t += NGW) {
        f32x4 v[8];
#pragma unroll
        for (int j = 0; j < 8; ++j) v[j] = *(const f32x4*)(Y2 + (size_t)t * D + 4 * lane + 256 * j);
        for (int k = 0; k < 8; ++k) { const int e = eidx[t * 8 + k], pos = inv[t * 8 + k]; const bf16* yr = Yr + (size_t)(tpref[e] * 256 + pos) * D + 4 * lane;
#pragma unroll
            for (int j = 0; j < 8; ++j) { const v2u w = *(const v2u*)(yr + 256 * j); v[j][0] += bflo(w.x); v[j][1] += bfhi(w.x); v[j][2] += bflo(w.y); v[j][3] += bfhi(w.y); } }
        float sm = 0.f;
#pragma unroll
        for (int j = 0; j < 8; ++j) sm += (v[j][0] + v[j][1]) + (v[j][2] + v[j][3]);
        const float mean = wave_sum(sm, lane) * (1.0f / D); float sq = 0.f;
#pragma unroll
        for (int j = 0; j < 8; ++j) { v[j] = v[j] - mean; sq += (v[j][0] * v[j][0] + v[j][1] * v[j][1]) + (v[j][2] * v[j][2] + v[j][3] * v[j][3]); }
        const float rstd = 1.0f / sqrtf(wave_sum(sq, lane) * (1.0f / D) + LN_EPS);
#pragma unroll
        for (int j = 0; j < 8; ++j) { const int c = 4 * lane + 256 * j; const f32x4 o = v[j] * rstd * *(const f32x4*)(gain + c) + *(const f32x4*)(bias + c);
            *(f32x4*)(XO + (size_t)t * D + c) = o;
            v2u wb; wb.x = pk2(o[0], o[1]); wb.y = pk2(o[2], o[3]); *(v2u*)(XBo + (size_t)t * D + c) = wb; }
    }
}


constexpr int M1_P = 0, M1N_HIST = 131072, M1N_BASE = 131072 + 256, M1N_GB = 131072 + 1024;
__device__ __forceinline__ void phase_moe1n(const Frame& F, const bf16* Y, const float* pst, const float* gain, const float* bias, const bf16* WH, const bf16* WL, const float* RB,
                                            bf16* X1B, float* ST1, unsigned* cnt, int* ltok, float* lgate, int* eidx, int* inv) {
    LAS float* P = (LAS float*)(F.lds + M1_P); LAS int* hist = (LAS int*)(F.lds + M1N_HIST); LAS int* basep = (LAS int*)(F.lds + M1N_BASE);
    const int tid = F.tid, lane = F.lane, w = F.wave, r = lane & 15, q = lane >> 4;
    for (int item = F.bid; item < T / 64; item += F.G) {
        const int row0 = item * 64;
        __syncthreads();
        if (tid < 64) hist[tid] = 0;
        { LAS f32x4* gb = (LAS f32x4*)(F.lds + M1N_GB); gb[tid] = *(const f32x4*)(gain + 4 * tid); gb[512 + tid] = *(const f32x4*)(bias + 4 * tid); }
        __syncthreads();
        float mean[4], rstd[4];
#pragma unroll
        for (int rt = 0; rt < 4; ++rt) { const int row = row0 + 16 * rt + r;
          const f32x4* pp = (const f32x4*)(pst + ((size_t)row * 32 + q * 8) * 2); const f32x4 a = pp[0], b = pp[1], c = pp[2], d = pp[3];
          float sm = (a[0] + a[2]) + (b[0] + b[2]) + (c[0] + c[2]) + (d[0] + d[2]), sq = (a[1] + a[3]) + (b[1] + b[3]) + (c[1] + c[3]) + (d[1] + d[3]);
          sm += shfl_x(sm, 16, lane); sm += shfl_x(sm, 32, lane); sq += shfl_x(sq, 16, lane); sq += shfl_x(sq, 32, lane);
          mean[rt] = sm * (1.0f / D); const float var = fmaxf(sq * (1.0f / D) - mean[rt] * mean[rt], 0.f); rstd[rt] = 1.0f / sqrtf(var + LN_EPS);
          if (w == 0 && q == 0) *(f32x2*)(ST1 + 2 * row) = (f32x2){mean[rt], rstd[rt]}; }
        const int kb = 256 * w + 8 * q;
        const LAS float* gl = (const LAS float*)(F.lds + M1N_GB) + kb;
        f32x4 acc[4][4];
#pragma unroll
        for (int rt = 0; rt < 4; ++rt)
#pragma unroll
            for (int nt = 0; nt < 4; ++nt) acc[rt][nt] = (f32x4){0.f, 0.f, 0.f, 0.f};
        v4u yb[3][4]; bf16x8 wh[4], wl[4];
        unsigned vo[4];
#pragma unroll
        for (int i = 0; i < 4; ++i) { vo[i] = (unsigned)(r * D + kb) * 2u + (unsigned)i * (16u * D * 2u); asm volatile("" : "+v"(vo[i])); }
        const char* ybase = (const char*)(Y + (size_t)row0 * D); char* xbase = (char*)(X1B + (size_t)row0 * D);
#define M1_LOADY(st) do { _Pragma("unroll") for (int rt = 0; rt < 4; ++rt) yb[(st) % 3][rt] = __builtin_nontemporal_load((const v4u*)(ybase + vo[rt] + 64 * (st))); } while (0)
#define M1_LOADW(st) do { _Pragma("unroll") for (int nt = 0; nt < 4; ++nt) { wh[nt] = *(const bf16x8*)((const char*)WH + vo[nt] + 64 * (st)); wl[nt] = *(const bf16x8*)((const char*)WL + vo[nt] + 64 * (st)); } } while (0)
        M1_LOADY(0); M1_LOADW(0); M1_LOADY(1);
        __builtin_amdgcn_sched_barrier(0);
#pragma unroll
        for (int st = 0; st < 8; ++st) {
            const f32x4 g0 = *(const LAS f32x4*)(gl + 32 * st), g1 = *(const LAS f32x4*)(gl + 32 * st + 4), b0 = *(const LAS f32x4*)(gl + 2048 + 32 * st), b1 = *(const LAS f32x4*)(gl + 2048 + 32 * st + 4);
#pragma unroll
            for (int rt = 0; rt < 4; ++rt) { const v4u yv = yb[st % 3][rt];
                const f32x4 y0_ = (f32x4){bflo(yv.x), bfhi(yv.x), bflo(yv.y), bfhi(yv.y)}, y1_ = (f32x4){bflo(yv.z), bfhi(yv.z), bflo(yv.w), bfhi(yv.w)};
                const f32x4 x0 = (y0_ - mean[rt]) * rstd[rt] * g0 + b0, x1 = (y1_ - mean[rt]) * rstd[rt] * g1 + b1;
                v4u h; h.x = cvt_pk_bf16(x0[0], x0[1]); h.y = cvt_pk_bf16(x0[2], x0[3]); h.z = cvt_pk_bf16(x1[0], x1[1]); h.w = cvt_pk_bf16(x1[2], x1[3]);
                *(v4u*)(xbase + vo[rt] + 64 * st) = h;
                v4u l; l.x = cvt_pk_bf16(x0[0] - bflo(h.x), x0[1] - bfhi(h.x)); l.y = cvt_pk_bf16(x0[2] - bflo(h.y), x0[3] - bfhi(h.y));
                l.z = cvt_pk_bf16(x1[0] - bflo(h.z), x1[1] - bfhi(h.z)); l.w = cvt_pk_bf16(x1[2] - bflo(h.w), x1[3] - bfhi(h.w));
                const bf16x8 xh = __builtin_bit_cast(bf16x8, h), xl = __builtin_bit_cast(bf16x8, l);
#pragma unroll
                for (int nt = 0; nt < 4; ++nt) { acc[rt][nt] = __builtin_amdgcn_mfma_f32_16x16x32_bf16(xh, wh[nt], acc[rt][nt], 0, 0, 0);
                    acc[rt][nt] = __builtin_amdgcn_mfma_f32_16x16x32_bf16(xl, wh[nt], acc[rt][nt], 0, 0, 0); acc[rt][nt] = __builtin_amdgcn_mfma_f32_16x16x32_bf16(xh, wl[nt], acc[rt][nt], 0, 0, 0); } }
            __builtin_amdgcn_sched_barrier(0);
            if (st + 1 < 8) M1_LOADW(st + 1);
            if (st + 2 < 8) M1_LOADY(st + 2);
            __builtin_amdgcn_sched_barrier(0);
        }
#undef M1_LOADY
#undef M1_LOADW
#pragma unroll
        for (int rt = 0; rt < 4; ++rt)
#pragma unroll
            for (int nt = 0; nt < 4; ++nt)
#pragma unroll
                for (int i = 0; i < 4; ++i) P[(w * 64 + 16 * rt + 4 * q + i) * 64 + 16 * nt + r] = acc[rt][nt][i];
        __syncthreads();
        int sel_pos[8]; float sel_gate[8]; int sel_rank[8]; bool sel_on[8];
        const float rb = RB[lane];
#pragma unroll
        for (int rr = 0; rr < 8; ++rr) { const int rl = 8 * w + rr;
            float lg = ((P[rl * 64 + lane] + P[(64 + rl) * 64 + lane]) + (P[(128 + rl) * 64 + lane] + P[(192 + rl) * 64 + lane])) + ((P[(256 + rl) * 64 + lane] + P[(320 + rl) * 64 + lane]) + (P[(384 + rl) * 64 + lane] + P[(448 + rl) * 64 + lane]));
            lg = (lg == lg) ? lg : -1.0e30f;
            const float sc = 1.0f / (1.0f + __expf(-lg)); const float ch = sc + rb;
            int rk = 0;
#pragma unroll
            for (int j = 0; j < 8; ++j) { const float cj = shfl_from(ch, (lane & ~7) + j); rk += (cj > ch || (cj == ch && j < (lane & 7))) ? 1 : 0; }
            float gs = rk < 2 ? ch : 0.f; gs += shfl_x(gs, 1, lane); gs += shfl_x(gs, 2, lane); gs += shfl_x(gs, 4, lane);
            int grk = 0; const int g = lane >> 3;
#pragma unroll
            for (int hh = 0; hh < 8; ++hh) { const float gh = shfl_from(gs, 8 * hh); grk += (gh > gs || (gh == gs && hh < g)) ? 1 : 0; }
            const float msk = grk < 4 ? ch : -INFINITY;
            int erk = 0;
            for (int j = 0; j < 64; ++j) { const float mj = __builtin_bit_cast(float, __builtin_amdgcn_readlane(__builtin_bit_cast(int, msk), j)); erk += (mj > msk || (mj == msk && j < lane)) ? 1 : 0; }
            const bool on = erk < 8;
            const float ssum = wave_sum(on ? sc : 0.f, lane);
            sel_on[rr] = on; sel_rank[rr] = erk; sel_gate[rr] = sc / ssum * 2.5f; sel_pos[rr] = 0;
            if (on) sel_pos[rr] = __hip_atomic_fetch_add(&hist[lane], 1, __ATOMIC_RELAXED, __HIP_MEMORY_SCOPE_WORKGROUP); }
        __syncthreads();
        if (tid < 64) { int tt = tid; asm volatile("" : "+v"(tt));
            const int hc = hist[tt]; int bs = 0; if (hc > 0) bs = (int)atomicAdd(&cnt[tt * 16], (unsigned)hc); basep[tt] = bs; }
        __syncthreads();
#pragma unroll
        for (int rr = 0; rr < 8; ++rr) if (sel_on[rr]) { const int t = row0 + 8 * w + rr, pos = basep[lane] + sel_pos[rr];
            ltok[(size_t)lane * CAP + pos] = t * 8 + sel_rank[rr]; lgate[(size_t)lane * CAP + pos] = sel_gate[rr];
            eidx[t * 8 + sel_rank[rr]] = lane; inv[t * 8 + sel_rank[rr]] = pos; }
    }
}

constexpr int M3_PL = 131072, M3_CNT = 147456, M3_OFF = 147456 + 272;
__device__ __forceinline__ void phase_moe3n(const Frame& F, const bf16* H, const bf16* HSp, const int* eidx, const bf16* WD, const bf16* WSD,
                                            const float* Y1, const float* ST1, const float* g1, const float* b1, float* Y2, float* PST2) {
    LAS int* out = (LAS int*)F.lds; LAS unsigned short* plist = (LAS unsigned short*)(F.lds + M3_PL); LAS int* cnt = (LAS int*)(F.lds + M3_CNT); LAS int* off = (LAS int*)(F.lds + M3_OFF);
    const int tid = F.tid, lane = F.lane, w = F.wave, r = lane & 15, q = lane >> 4;
    for (int u = F.bid; u < 1024; u += F.G) {
        int nc = (u & 7) | ((u >> 7) << 3), tb = (u >> 3) & 15;
        if (F.G == 256) { const int i = u >> 8, x = u & 7, j = (u >> 3) & 31; tb = 2 * x + (i >> 1); nc = 32 * (i & 1) + j; }
        __syncthreads();
#pragma unroll
        for (int j = 0; j < 16; ++j) ((LAS v4u*)out)[tid + 512 * j] = (v4u){0u, 0u, 0u, 0u};
        if (tid < 66) cnt[tid] = 0;
        __syncthreads();
        int ee[16], pp[16];
        { const v4u* ep = (const v4u*)(eidx + ((size_t)tb * 1024 + 2 * tid) * 8); const v4u e0 = ep[0], e1 = ep[1], e2 = ep[2], e3 = ep[3];
          ee[0] = e0.x; ee[1] = e0.y; ee[2] = e0.z; ee[3] = e0.w; ee[4] = e1.x; ee[5] = e1.y; ee[6] = e1.z; ee[7] = e1.w;
          ee[8] = e2.x; ee[9] = e2.y; ee[10] = e2.z; ee[11] = e2.w; ee[12] = e3.x; ee[13] = e3.y; ee[14] = e3.z; ee[15] = e3.w; }
#pragma unroll
        for (int j = 0; j < 16; ++j) pp[j] = __hip_atomic_fetch_add(&cnt[ee[j]], 1, __ATOMIC_RELAXED, __HIP_MEMORY_SCOPE_WORKGROUP);
        __syncthreads();
        if (w == 0) { int c = cnt[lane], x = c;
#pragma unroll
            for (int o = 1; o < 64; o <<= 1) { const int y = __builtin_amdgcn_ds_bpermute(((lane - o) & 63) << 2, x); if (lane >= o) x += y; }
            off[lane] = x - c; if (lane == 63) off[64] = x; }
        __syncthreads();
#pragma unroll
        for (int j = 0; j < 16; ++j) plist[off[ee[j]] + pp[j]] = (unsigned short)(tid * 16 + j);
        __syncthreads();
        const char* Hb = (const char*)H + (size_t)tb * 8192 * 256 + q * 16;
        const char* HSb = (const char*)HSp + (size_t)tb * 1024 * 512 + q * 16;
        const char* Bb = (const char*)WD + ((size_t)nc * 32 + r) * 256 + q * 16;
        const char* BSb = (const char*)WSD + ((size_t)nc * 32 + r) * 512 + q * 16;
#define M3_NR(sg) ((sg) < 8 ? __builtin_amdgcn_readfirstlane(cnt[w + 8 * (sg)]) : 128)
#define M3_RB(sg) ((sg) < 8 ? __builtin_amdgcn_readfirstlane(off[w + 8 * (sg)]) : 0)
#define M3_GLD(dst, ptr, OFF) asm volatile("global_load_dwordx4 %0, %1, off offset:" #OFF : "=&v"(dst) : "v"(ptr) : "memory")
#define M3_LOADB(dst, sg) do { const char* _b0 = (sg) < 8 ? Bb + (size_t)(w + 8 * (sg)) * 524288 : BSb + ((sg) - 8) * 256; const char* _b1 = _b0 + ((sg) < 8 ? 4096 : 8192); \
            M3_GLD(dst[0][0], _b0, 0); M3_GLD(dst[0][1], _b0, 64); M3_GLD(dst[0][2], _b0, 128); M3_GLD(dst[0][3], _b0, 192); \
            M3_GLD(dst[1][0], _b1, 0); M3_GLD(dst[1][1], _b1, 64); M3_GLD(dst[1][2], _b1, 128); M3_GLD(dst[1][3], _b1, 192); } while (0)
#define M3_LOADA(dst, sg, bb, nr, rbs) do { int _i = 16 * (bb) + r; _i = _i < (nr) ? _i : (nr) - 1; const unsigned _rid = plist[(rbs) + _i]; \
            const char* _a = (sg) < 8 ? Hb + (size_t)_rid * 256 : ((sg) < 10 ? HSb + (size_t)(128 * w + _i) * 512 + ((sg) - 8) * 256 : Hb); \
            M3_GLD(dst[0], _a, 0); M3_GLD(dst[1], _a, 64); M3_GLD(dst[2], _a, 128); M3_GLD(dst[3], _a, 192); } while (0)
#define M3_ADV(sg, bb, nr, rbs) do { if ((sg) < 10) { ++(bb); if ((bb) * 16 >= (nr)) { (bb) = 0; do { ++(sg); } while ((sg) < 8 && M3_NR(sg) == 0); if ((sg) < 10) { (nr) = M3_NR(sg); (rbs) = M3_RB(sg); } } } } while (0)
#define M3_WAITA(AS) asm volatile("s_waitcnt vmcnt(12)" : "+v"(AS[0]), "+v"(AS[1]), "+v"(AS[2]), "+v"(AS[3]) :: "memory")
#define M3_WAITB(N) asm volatile("s_waitcnt vmcnt(" #N ")" : "+v"(Bn[0][0]), "+v"(Bn[0][1]), "+v"(Bn[0][2]), "+v"(Bn[0][3]), "+v"(Bn[1][0]), "+v"(Bn[1][1]), "+v"(Bn[1][2]), "+v"(Bn[1][3]) :: "memory")
#define M3_STEP(AS) if (cseg < 10) { \
              \
            int tk[4]; bool ok[4]; unsigned pl[4]; const int rt_ = cseg < 8; \
            _Pragma("unroll") for (int i = 0; i < 4; ++i) { const int idx = 16 * cbt + 4 * q + i; ok[i] = idx < cnr; const int ic = ok[i] ? idx : cnr - 1; pl[i] = plist[crbs + ic]; tk[i] = 128 * w + ic; } \
            _Pragma("unroll") for (int i = 0; i < 4; ++i) tk[i] = rt_ ? (int)(pl[i] >> 3) : tk[i]; \
            M3_WAITA(AS); \
            f32x4 acc[2]; \
            _Pragma("unroll") for (int nt = 0; nt < 2; ++nt) { acc[nt] = (f32x4){0.f, 0.f, 0.f, 0.f}; \
                _Pragma("unroll") for (int kk = 0; kk < 4; ++kk) acc[nt] = __builtin_amdgcn_mfma_f32_16x16x32_bf16(__builtin_bit_cast(bf16x8, AS[kk]), __builtin_bit_cast(bf16x8, Bc[nt][kk]), acc[nt], 0, 0, 0); } \
              \
            _Pragma("unroll") for (int i = 0; i < 4; ++i) { const long long lo_ = ok[i] ? (long long)__float2int_rn(acc[0][i] * 4194304.0f) : 0ll, hi_ = ok[i] ? (long long)__float2int_rn(acc[1][i] * 4194304.0f) : 0ll; \
                (void)__hip_atomic_fetch_add((LAS unsigned long long*)out + tk[i] * 16 + r, (unsigned long long)((hi_ << 32) + lo_), __ATOMIC_RELAXED, __HIP_MEMORY_SCOPE_WORKGROUP); } \
            M3_LOADA(AS, pseg, pbt, pnr, prbs); M3_ADV(pseg, pbt, pnr, prbs); \
            { const int old_ = cseg, nbat_ = (cnr + 15) >> 4; M3_ADV(cseg, cbt, cnr, crbs); \
              if (cseg != old_ && cseg < 10) { \
                  if (nbat_ == 1) M3_WAITB(4); else if (nbat_ == 2) M3_WAITB(8); else if (nbat_ == 3) M3_WAITB(12); else M3_WAITB(16); \
                  _Pragma("unroll") for (int nt = 0; nt < 2; ++nt) _Pragma("unroll") for (int kk = 0; kk < 4; ++kk) Bc[nt][kk] = Bn[nt][kk]; \
                  int nb_ = cseg; do { ++nb_; } while (nb_ < 8 && M3_NR(nb_) == 0); if (nb_ >= 10) nb_ = 9; M3_LOADB(Bn, nb_); } } }
        int cseg = -1, cbt = 0, cnr = 0, crbs = 0;
        do { ++cseg; } while (cseg < 8 && M3_NR(cseg) == 0);
        cnr = M3_NR(cseg); crbs = M3_RB(cseg);
        int pseg = cseg, pbt = 0, pnr = cnr, prbs = crbs;
        v4u Bc[2][4], Bn[2][4], A0[4], A1[4], A2[4], A3[4];
        M3_LOADB(Bc, cseg);
        M3_LOADA(A0, pseg, pbt, pnr, prbs); M3_ADV(pseg, pbt, pnr, prbs);
        M3_LOADA(A1, pseg, pbt, pnr, prbs); M3_ADV(pseg, pbt, pnr, prbs);
        M3_LOADA(A2, pseg, pbt, pnr, prbs); M3_ADV(pseg, pbt, pnr, prbs);
        M3_LOADA(A3, pseg, pbt, pnr, prbs); M3_ADV(pseg, pbt, pnr, prbs);
        { int nb_ = cseg; do { ++nb_; } while (nb_ < 8 && M3_NR(nb_) == 0); if (nb_ >= 10) nb_ = 9; M3_LOADB(Bn, nb_); }
        asm volatile("s_waitcnt vmcnt(0)" : "+v"(Bc[0][0]), "+v"(Bc[0][1]), "+v"(Bc[0][2]), "+v"(Bc[0][3]), "+v"(Bc[1][0]), "+v"(Bc[1][1]), "+v"(Bc[1][2]), "+v"(Bc[1][3]) :: "memory");
#pragma unroll 1
        while (cseg < 10) { M3_STEP(A0) M3_STEP(A1) M3_STEP(A2) M3_STEP(A3) }
        asm volatile("s_waitcnt vmcnt(0)" : "+v"(A0[0]), "+v"(A0[1]), "+v"(A0[2]), "+v"(A0[3]), "+v"(A1[0]), "+v"(A1[1]), "+v"(A1[2]), "+v"(A1[3]), "+v"(A2[0]), "+v"(A2[1]), "+v"(A2[2]), "+v"(A2[3]),
                     "+v"(A3[0]), "+v"(A3[1]), "+v"(A3[2]), "+v"(A3[3]), "+v"(Bn[0][0]), "+v"(Bn[0][1]), "+v"(Bn[0][2]), "+v"(Bn[0][3]), "+v"(Bn[1][0]), "+v"(Bn[1][1]), "+v"(Bn[1][2]), "+v"(Bn[1][3]) :: "memory");
#undef M3_NR
#undef M3_RB
#undef M3_GLD
#undef M3_LOADB
#undef M3_LOADA
#undef M3_ADV
#undef M3_WAITA
#undef M3_WAITB
#undef M3_STEP
        __syncthreads();
        { const int c4 = lane & 7, rs = lane >> 3, col = nc * 32 + 4 * c4;
          const f32x4 gv = *(const f32x4*)(g1 + col), bv = *(const f32x4*)(b1 + col);
#pragma unroll 4
          for (int it = 0; it < 16; ++it) { const int rl = 128 * w + 8 * it + rs; const size_t row = (size_t)tb * 1024 + rl;
              const f32x4 yv = *(const f32x4*)(Y1 + row * D + col); const f32x2 sv = *(const f32x2*)(ST1 + 2 * row);
              f32x4 tv; { const int nt = c4 >> 2, r0 = (4 * c4) & 15;
#pragma unroll
                  for (int j = 0; j < 4; ++j) { const v2u cell = *(const LAS v2u*)(out + rl * 32 + 2 * (r0 + j)); const int lo = (int)cell.x, hi = (int)cell.y + (lo < 0 ? 1 : 0); tv[j] = (float)(nt ? hi : lo) * (1.0f / 4194304.0f); } }
              const f32x4 y = ((yv - sv.x) * sv.y * gv + bv) * ALPHA + tv;
              *(f32x4*)(Y2 + row * D + col) = y;
              float sm = (y[0] + y[1]) + (y[2] + y[3]), sq = (y[0] * y[0] + y[1] * y[1]) + (y[2] * y[2] + y[3] * y[3]);
#pragma unroll
              for (int o = 1; o < 8; o <<= 1) { sm += shfl_x(sm, o, lane); sq += shfl_x(sq, o, lane); }
              if (c4 == 0) *(f32x2*)(PST2 + (row * 64 + nc) * 2) = (f32x2){sm, sq}; } }
    }
}

__device__ __forceinline__ void phase_moe4n(const Frame& F, const float* Y2, const float* pst, const float* gain, const float* bias, float* ST2, bf16* XBo, float* OUT, int last) {
    const int gw = F.bid * 8 + F.wave, NGW = F.G * 8, lane = F.lane;
    for (int t = gw; t < T; t += NGW) {
        f32x4 v[8];
#pragma unroll
        for (int j = 0; j < 8; ++j) v[j] = *(const f32x4*)(Y2 + (size_t)t * D + 4 * lane + 256 * j);
        const f32x2 pv = *(const f32x2*)(pst + ((size_t)t * 64 + lane) * 2);
        const float mean = wave_sum(pv.x, lane) * (1.0f / D); const float var = fmaxf(wave_sum(pv.y, lane) * (1.0f / D) - mean * mean, 0.f); const float rstd = 1.0f / sqrtf(var + LN_EPS);
        if (lane == 0) *(f32x2*)(ST2 + 2 * (size_t)t) = (f32x2){mean, rstd};
#pragma unroll
        for (int j = 0; j < 8; ++j) { const int c = 4 * lane + 256 * j; const f32x4 o = (v[j] - mean) * rstd * *(const f32x4*)(gain + c) + *(const f32x4*)(bias + c);
            if (last) *(f32x4*)(OUT + (size_t)t * D + c) = o;
            else { v2u wb; wb.x = pk2(o[0], o[1]); wb.y = pk2(o[2], o[3]); *(v2u*)(XBo + (size_t)t * D + c) = wb; } }
    }
}


__device__ __forceinline__ void phase_moe4q(const Frame& F, const bf16* X1, bf16* Y2, const unsigned char* Yq, const float* Ysc, const int* eidx, const int* inv, const float* gain, const float* bias, float* ST2, bf16* XBo, float* OUT, int last) {
    const LAS int* tpref = (const LAS int*)(F.lds + LDS_TAB);
    const int gw = F.bid * 8 + F.wave, NGW = F.G * 8, lane = F.lane;
    for (int t = gw; t < T; t += NGW) {
        int rowi = 0; if (lane < 8) { const int e = eidx[t * 8 + lane], ps = inv[t * 8 + lane]; rowi = tpref[e] * 256 + ps; } else if (lane < 10) rowi = tpref[56 + lane] * 256 + t;
        v4u pv[2][2], yv[10][2]; float sc[10][2];
#pragma unroll
        for (int j = 0; j < 2; ++j) { pv[j][0] = __builtin_nontemporal_load((const v4u*)(X1 + (size_t)t * D + 16 * lane + 1024 * j)); pv[j][1] = __builtin_nontemporal_load((const v4u*)(X1 + (size_t)t * D + 16 * lane + 1024 * j + 8)); }
#pragma unroll
        for (int k = 0; k < 10; ++k) { const size_t row = (size_t)__builtin_amdgcn_readlane(rowi, k);
#pragma unroll
            for (int j = 0; j < 2; ++j) { yv[k][j] = __builtin_nontemporal_load((const v4u*)(Yq + row * D + 16 * lane + 1024 * j)); sc[k][j] = __builtin_nontemporal_load(Ysc + row * 16 + 8 * j + (lane >> 3)); } }
#pragma unroll
        for (int k = 0; k < 10; ++k) asm volatile("" : "+v"(yv[k][0]), "+v"(yv[k][1]), "+v"(sc[k][0]), "+v"(sc[k][1]));
        float v[2][16];
#pragma unroll
        for (int j = 0; j < 2; ++j) { float f0[8], f1[8]; unpack8(pv[j][0], f0); unpack8(pv[j][1], f1);
            const float ss = (((sc[0][j] + sc[1][j]) + (sc[2][j] + sc[3][j])) + ((sc[4][j] + sc[5][j]) + (sc[6][j] + sc[7][j]))) + (sc[8][j] + sc[9][j]);
#pragma unroll
            for (int i = 0; i < 8; ++i) { v[j][i] = ALPHA * f0[i] - 128.f * ss; v[j][8 + i] = ALPHA * f1[i] - 128.f * ss; } }
#pragma unroll
        for (int k = 0; k < 10; ++k)
#pragma unroll
            for (int j = 0; j < 2; ++j) { const float s_ = sc[k][j]; const unsigned q[4] = {yv[k][j].x, yv[k][j].y, yv[k][j].z, yv[k][j].w};
#pragma unroll
                for (int d = 0; d < 4; ++d) { v[j][4 * d + 0] += s_ * (float)(q[d] & 0xffu); v[j][4 * d + 1] += s_ * (float)((q[d] >> 8) & 0xffu); v[j][4 * d + 2] += s_ * (float)((q[d] >> 16) & 0xffu); v[j][4 * d + 3] += s_ * (float)(q[d] >> 24); } }
        float sm = 0.f;
#pragma unroll
        for (int j = 0; j < 2; ++j)
#pragma unroll
            for (int i = 0; i < 16; i += 4) sm += (v[j][i] + v[j][i + 1]) + (v[j][i + 2] + v[j][i + 3]);
        const float mean = wave_sum(sm, lane) * (1.0f / D); float sq = 0.f;
#pragma unroll
        for (int j = 0; j < 2; ++j)
#pragma unroll
            for (int i = 0; i < 16; ++i) { const float d = v[j][i] - mean; sq += d * d; }
        const float rstd = 1.0f / sqrtf(wave_sum(sq, lane) * (1.0f / D) + LN_EPS);
        (void)ST2; (void)Y2;
#pragma unroll
        for (int j = 0; j < 2; ++j)
#pragma unroll
            for (int h = 0; h < 2; ++h) { const int c = 16 * lane + 1024 * j + 8 * h; const float* vv = &v[j][8 * h];
                const f32x4 g0 = *(const f32x4*)(gain + c), g1 = *(const f32x4*)(gain + c + 4), b0 = *(const f32x4*)(bias + c), b1 = *(const f32x4*)(bias + c + 4);
                const f32x4 o0 = ((f32x4){vv[0], vv[1], vv[2], vv[3]} - mean) * rstd * g0 + b0, o1 = ((f32x4){vv[4], vv[5], vv[6], vv[7]} - mean) * rstd * g1 + b1;
                if (last) { *(f32x4*)(OUT + (size_t)t * D + c) = o0; *(f32x4*)(OUT + (size_t)t * D + c + 4) = o1; }
                else { v4u wb; wb.x = pk2(o0[0], o0[1]); wb.y = pk2(o0[2], o0[3]); wb.z = pk2(o1[0], o1[1]); wb.w = pk2(o1[2], o1[3]); *(v4u*)(XBo + (size_t)t * D + c) = wb; } }
    }
}

__device__ __forceinline__ void phase_downproj3(const Frame& F, const bf16* H, const bf16* WD, const bf16* HSp, const bf16* WSD, unsigned char* Yq, float* Ysc, int NT) {
    const LAS int* tpref = (const LAS int*)(F.lds + LDS_TAB); const LAS int* cl = (const LAS int*)(F.lds + LDS_TAB + 512);
    LAS unsigned char* lds = F.lds;
    const int tid = F.tid, lane = F.lane, w = F.wave, fr = lane & 15, fq = lane >> 4;
    unsigned rbB[2], cbB[2];
#pragma unroll
    for (int i = 0; i < 2; ++i) { int R_, C_; g8::stage_rc(tid * 16 + i * 8192, R_, C_); rbB[i] = (unsigned)((R_ & ~31) + g8::perm32(R_ & 31)); cbB[i] = (unsigned)C_ * 2u; }
    const unsigned ldsw = (unsigned)w * 1024u, lbase = (unsigned)(size_t)lds;
    int boffg[4];
#pragma unroll
    for (int g = 0; g < 4; ++g) boffg[g] = g8::lds_byte(32 * g + fr, fq * 8);
    LAS unsigned char* stg = lds + 65536 + w * (32 * 144);
    const int NU = NT * 4;
    const int upos = (F.G % 8) == 0 ? (F.bid & 7) * (F.G >> 3) + (F.bid >> 3) : F.bid;
    int ub = 0;
    int u = (F.G <= NU) ? upos : F.bid; if (u >= NU) return;
#define DP3_UNITINFO(uu, E0, EXP, NV) do { const int tl_ = (uu) >> 2; int e_ = (E0); while (__builtin_amdgcn_readfirstlane(tpref[e_ + 1]) <= tl_) ++e_; EXP = e_; \
        NV = __builtin_amdgcn_readfirstlane(cl[e_]) - (tl_ - __builtin_amdgcn_readfirstlane(tpref[e_])) * 256; } while (0)
#define DP3_GLDS(gsrc, ldsdst) do { unsigned keep_; asm volatile("s_mov_b32 %0, m0\n\ts_mov_b32 m0, %2\n\ts_nop 0\n\tglobal_load_lds_dwordx4 %1, off\n\ts_mov_b32 m0, %0" : "=&s"(keep_) : "v"(gsrc), "s"(ldsdst) : "memory"); } while (0)
#define DP3_STAGE(slot, gb, bs) do { const unsigned v0_ = rbB[0] * (unsigned)(bs) + cbB[0], v1_ = rbB[1] * (unsigned)(bs) + cbB[1]; _Pragma("unroll") for (int kt = 0; kt < 2; ++kt) { \
        DP3_GLDS((const void*)((gb) + kt * 128 + v0_), lbase + (unsigned)((slot) * 32768 + kt * 16384) + ldsw); \
        DP3_GLDS((const void*)((gb) + kt * 128 + v1_), lbase + (unsigned)((slot) * 32768 + kt * 16384) + ldsw + 8192u); } } while (0)
#define DP3_SRC(uu, ee, AB, AS, BB, BS) do { const int tl_ = (uu) >> 2, cu_ = ((uu) & 3) * 512; \
        if ((ee) < 64) { AB = (const char*)(H + (size_t)tl_ * 256 * EDIM); AS = EDIM * 2; BB = (const char*)(WD + (size_t)(ee) * D * EDIM + (size_t)cu_ * EDIM); BS = EDIM * 2; } \
        else { const int t0_ = (tl_ - __builtin_amdgcn_readfirstlane(tpref[ee])) * 256; AB = (const char*)(HSp + (size_t)t0_ * SDIM + ((ee) - 64) * EDIM); AS = SDIM * 2; \
               BB = (const char*)(WSD + (size_t)cu_ * SDIM + ((ee) - 64) * EDIM); BS = SDIM * 2; } } while (0)
    int ecur, nvcur; DP3_UNITINFO(u, 0, ecur, nvcur);
    const char* abc; const char* gbc; int asc, bsc; DP3_SRC(u, ecur, abc, asc, gbc, bsc);
    bf16x8 A[2][4], An[2][4];
    { const char* ap_ = abc + (size_t)(32 * w + fr) * asc + 16 * fq;
#pragma unroll
      for (int m = 0; m < 2; ++m)
#pragma unroll
          for (int kk = 0; kk < 4; ++kk) A[m][kk] = *(const bf16x8*)(ap_ + (size_t)m * 16 * asc + 64 * kk); }
    DP3_STAGE(0, gbc, bsc);
    asm volatile("s_waitcnt vmcnt(0)" ::: "memory");
#pragma unroll 1
    for (;;) {
        int un = u; { const int nb = ub + F.G; if (nb + F.G <= NU) un = nb + upos; else if (nb + F.bid < NU) un = nb + F.bid; if (un != u) ub = nb; }
        int enx, nvnx; DP3_UNITINFO(un, (un > u ? ecur : 0), enx, nvnx);
        const char* abn; const char* gbn; int asn, bsn; DP3_SRC(un, enx, abn, asn, gbn, bsn);
        const int tile = u >> 2, colu = (u & 3) * 512;
        float scq[2][4];
#pragma unroll
        for (int c = 0; c < 4; ++c) {
            if (c == 0) asm volatile("s_waitcnt vmcnt(5)" ::: "memory"); else asm volatile("s_waitcnt vmcnt(4)" ::: "memory");
            __builtin_amdgcn_s_barrier();
            if (c == 3) { const char* ap_ = abn + (size_t)(32 * w + fr) * asn + 16 * fq;
#pragma unroll
                for (int m = 0; m < 2; ++m) { const char* am_ = ap_ + (size_t)m * 16 * asn;
                    asm volatile("global_load_dwordx4 %0, %1, off" : "=&v"(An[m][0]) : "v"(am_) : "memory"); asm volatile("global_load_dwordx4 %0, %1, off offset:64" : "=&v"(An[m][1]) : "v"(am_) : "memory");
                    asm volatile("global_load_dwordx4 %0, %1, off offset:128" : "=&v"(An[m][2]) : "v"(am_) : "memory"); asm volatile("global_load_dwordx4 %0, %1, off offset:192" : "=&v"(An[m][3]) : "v"(am_) : "memory"); } }
            { const char* gnext = (c < 3) ? gbc + (size_t)(c + 1) * 128 * bsc : gbn; const int bnext = (c < 3) ? bsc : bsn; DP3_STAGE((c + 1) & 1, gnext, bnext); }
            __builtin_amdgcn_sched_barrier(0);
            f32x4 acc[2][4][2];
#pragma unroll
            for (int g = 0; g < 4; ++g) { bf16x8 Bf[2][4];
#pragma unroll
                for (int n = 0; n < 2; ++n)
#pragma unroll
                    for (int kk = 0; kk < 4; ++kk) Bf[n][kk] = *(const LAS bf16x8*)(lds + (c & 1) * 32768 + (kk >> 1) * 16384 + boffg[g] + n * 2048 + (kk & 1) * 1024);
#pragma unroll
                for (int m = 0; m < 2; ++m)
#pragma unroll
                    for (int n = 0; n < 2; ++n) { acc[m][g][n] = (f32x4){0.f, 0.f, 0.f, 0.f};
#pragma unroll
                        for (int kk = 0; kk < 4; ++kk) acc[m][g][n] = __builtin_amdgcn_mfma_f32_16x16x32_bf16(Bf[n][kk], A[m][kk], acc[m][g][n], 0, 0, 0); } }
#pragma unroll
            for (int m = 0; m < 2; ++m) {
                float am0 = 0.f, am1 = 0.f;
#pragma unroll
                for (int g = 0; g < 4; ++g)
#pragma unroll
                    for (int n = 0; n < 2; ++n) { am0 = fmaxf(fmaxf(am0, fabsf(acc[m][g][n][0])), fabsf(acc[m][g][n][1])); am1 = fmaxf(fmaxf(am1, fabsf(acc[m][g][n][2])), fabsf(acc[m][g][n][3])); }
                float am = fmaxf(am0, am1);
                am = fmaxf(am, shfl_x(am, 16, lane)); am = fmaxf(am, shfl_x(am, 32, lane));
                am = fminf(am, 3.0e38f);
                const float isc = am > 0.f ? 127.0f * __builtin_amdgcn_rcpf(am) : 0.f;
                scq[m][c] = am * (1.0f / 127.0f);
                const f32x2_t isc2 = (f32x2_t){isc, isc}, mg2 = (f32x2_t){8388736.0f, 8388736.0f};
#pragma unroll
                for (int g = 0; g < 4; ++g) { unsigned qd[2];
#pragma unroll
                    for (int n = 0; n < 2; ++n) {
                        const f32x2_t tl = __builtin_elementwise_fma((f32x2_t){acc[m][g][n][0], acc[m][g][n][1]}, isc2, mg2), th = __builtin_elementwise_fma((f32x2_t){acc[m][g][n][2], acc[m][g][n][3]}, isc2, mg2);
                        const float f0_ = tl.x, f1_ = tl.y, f2_ = th.x, f3_ = th.y;
                        qd[n] = __builtin_amdgcn_perm(__builtin_bit_cast(unsigned, f1_), __builtin_bit_cast(unsigned, f0_), 0x0c0c0400u) | __builtin_amdgcn_perm(__builtin_bit_cast(unsigned, f3_), __builtin_bit_cast(unsigned, f2_), 0x04000c0cu); }
                    *(LAS v2u*)(stg + (16 * m + fr) * 144 + 32 * g + 8 * fq) = (v2u){qd[0], qd[1]}; } }
#pragma unroll
            for (int it = 0; it < 4; ++it) { const int rr = 8 * it + (lane >> 3);
                const v4u o = *(const LAS v4u*)(stg + rr * 144 + (lane & 7) * 16);
                __builtin_nontemporal_store(o, (v4u*)(Yq + (size_t)(tile * 256 + 32 * w + rr) * D + colu + 128 * c + 16 * (lane & 7))); }
            if (c == 3) { const f32x4 so = fq == 0 ? (f32x4){scq[0][0], scq[0][1], scq[0][2], scq[0][3]} : (f32x4){scq[1][0], scq[1][1], scq[1][2], scq[1][3]};
                if (fq < 2) __builtin_nontemporal_store(so, (f32x4*)(Ysc + (size_t)(tile * 256 + 32 * w + 16 * fq + fr) * 16 + (colu >> 7))); }
            __builtin_amdgcn_sched_barrier(0);
        }
        asm volatile("s_waitcnt vmcnt(9)" : "+v"(An[0][0]), "+v"(An[0][1]), "+v"(An[0][2]), "+v"(An[0][3]), "+v"(An[1][0]), "+v"(An[1][1]), "+v"(An[1][2]), "+v"(An[1][3]) :: "memory");
        if (un == u) break;
#pragma unroll
        for (int m = 0; m < 2; ++m)
#pragma unroll
            for (int kk = 0; kk < 4; ++kk) A[m][kk] = An[m][kk];
        u = un; ecur = enx; nvcur = nvnx; abc = abn; asc = asn; gbc = gbn; bsc = bsn;
    }
    asm volatile("s_waitcnt vmcnt(0)" ::: "memory");
#undef DP3_UNITINFO
#undef DP3_STAGE
#undef DP3_GLDS
#undef DP3_SRC
}

enum { PH_PRO = 0, PH_POOL_G1, PH_POOL_P, PH_POOL_G2, PH_POOL_G3, PH_DIL_G1, PH_DIL_ATT, PH_DIL_CMB, PH_DIL_G2, PH_CONV_G1, PH_CONV_E, PH_CONV_G2, PH_MOE1, PH_MOE2, PH_MOE3, PH_MOE4, PH_COUNT };

template <int PH>
__device__ __forceinline__ void run_phase(const Frame& Fin, const Args& args_, const int L) {
    Frame F = Fin; { int w_ = Fin.wave, l_; asm volatile("" : "+s"(w_)); asm volatile("v_mbcnt_lo_u32_b32 %0, -1, 0\n\tv_mbcnt_hi_u32_b32 %0, -1, %0" : "=v"(l_)); F.wave = w_; F.lane = l_; F.tid = w_ * 64 + l_; }
    unsigned char* ws; { GAS unsigned char* wsg = (GAS unsigned char*)Fin.ws; asm volatile("" : "+s"(wsg)); ws = (unsigned char*)wsg; } F.ws = ws; F.ctl = (unsigned*)(ws + WS_CTL);
    KP kp = (KP)__builtin_amdgcn_kernarg_segment_ptr(); asm volatile("" : "+s"(kp)); (void)args_;
    { unsigned l_ = (unsigned)(size_t)Fin.lds; asm volatile("" : "+s"(l_)); F.lds = (LAS unsigned char*)(size_t)l_; }
    LAS unsigned char* ring = F.lds; int c = (int)blockIdx.x; { int g_ = Fin.G; asm volatile("" : "+s"(c), "+s"(g_)); F.G = g_; F.bid = c; }
    const float* xres = ain(kp, IN_X);
    const float* st2 = (const float*)(ws + WS_ST2); float* pstp = (float*)(ws + WS_PST);
    const float* g2p = ain(kp, IN_LNG) + (size_t)((L > 0 ? L - 1 : 0) * 2 + 1) * D; const float* b2p = ain(kp, IN_LNB) + (size_t)((L > 0 ? L - 1 : 0) * 2 + 1) * D;
    const bf16* xb = (const bf16*)(ws + WS_XB);
    bf16* yf = (bf16*)(ws + WS_YF);
    unsigned char* big = ws + WS_BIG;
    const int ia = L / 3;
    if constexpr (PH == PH_PRO) { phase_prologue(F, kp); }
    if constexpr (PH == PH_POOL_G1) { g8::DenseSched S; S.init(xb, (const bf16*)(ws + WS_W_POOL_IN) + (size_t)ia * D * D, T, D, D, D, F.G, c);
        g8::EpiBf16 E{(bf16*)(big + BG_U), D, 0}; g8::gemm_phase<g8::EpiBf16, g8::DenseSched, false>(ring, F.tid, D, D, D, S, E); }
    if constexpr (PH == PH_POOL_P) { phase_pool(F, (const bf16*)(big + BG_U), (bf16*)(big + BG_PL)); }
    if constexpr (PH == PH_POOL_G2) { g8::DenseSched S; S.init((const bf16*)(big + BG_PL), (const bf16*)(ws + WS_W_POOL_G) + (size_t)ia * D * 512, T, D, D, 512, F.G, c); S.agrp_shift = 1; S.agrp_stride = 512 * 2;
        g8::EpiScaleBf16 E{(bf16*)(big + BG_MX), D, ain(kp, IN_PSC) + (size_t)ia * D}; g8::gemm_phase<g8::EpiScaleBf16, g8::DenseSched, false>(ring, F.tid, 512, D, 512, S, E); }
    if constexpr (PH == PH_POOL_G3) { g8::DenseSched S; S.init((const bf16*)(big + BG_MX), (const bf16*)(ws + WS_W_POOL_OUT) + (size_t)ia * D * D, T, D, D, D, F.G, c);
        g8::EpiResidLN E{xres, xb, st2, g2p, b2p, yf, pstp, 2}; g8::gemm_phase<g8::EpiResidLN, g8::DenseSched, false>(ring, F.tid, D, D, D, S, E); }
    if constexpr (PH == PH_DIL_G1) { g8::DenseSched S; S.init(xb, (const bf16*)(ws + WS_W_DIL_QKV), T, QKVC, D, D, F.G, c);
        g8::EpiBf16 E{(bf16*)(big + BG_QKV), QKVC, 1}; g8::gemm_phase<g8::EpiBf16, g8::DenseSched, false>(ring, F.tid, D, D, D, S, E); }
    if constexpr (PH == PH_DIL_ATT) { phase_attn(F, (const bf16*)(big + BG_QKV), ain(kp, IN_RELB), (bf16*)(big + BG_OG), (float*)(big + BG_LSE)); }
    if constexpr (PH == PH_DIL_CMB) { phase_combine(F, (const bf16*)(big + BG_OG), (const float*)(big + BG_LSE), (bf16*)(big + BG_O)); }
    if constexpr (PH == PH_DIL_G2) { g8::DenseSched S; S.init((const bf16*)(big + BG_O), (const bf16*)(ws + WS_W_DIL_OUT), T, D, DILW, DILW, F.G, c);
        g8::EpiResidLN E{xres, xb, st2, g2p, b2p, yf, pstp, 2}; g8::gemm_phase<g8::EpiResidLN, g8::DenseSched, false>(ring, F.tid, DILW, DILW, DILW, S, E); }
    if constexpr (PH == PH_CONV_G1) { g8::DenseSched S; S.init(xb, (const bf16*)(ws + WS_W_CONV_IN), T, 3 * D, D, D, F.G, c);
        g8::EpiConvIn E{(bf16*)(big + BG_UC), (bf16*)(big + BG_BG)}; g8::gemm_phase<g8::EpiConvIn, g8::DenseSched, false>(ring, F.tid, D, D, D, S, E); }
    if constexpr (PH == PH_CONV_E) { phase_conv(F, (const bf16*)(big + BG_UC), (const bf16*)(big + BG_BG), ain(kp, IN_CW), (bf16*)(big + BG_Z)); }
    if constexpr (PH == PH_CONV_G2) { g8::DenseSched S; S.init((const bf16*)(big + BG_Z), (const bf16*)(ws + WS_W_CONV_OUT), T, D, D, D, F.G, c);
        g8::EpiResidLN E{xres, xb, st2, g2p, b2p, yf, pstp, 2}; g8::gemm_phase<g8::EpiResidLN, g8::DenseSched, false>(ring, F.tid, D, D, D, S, E); }
    unsigned* cnt = F.ctl + CW_CNT + L * 64 * 16;
    float* x1f = (float*)(ws + WS_X1F); bf16* x1b = (bf16*)(ws + WS_X1B);
    int* ltok = (int*)(ws + WS_LTOK); float* lgate = (float*)(ws + WS_LGATE); int* eidx = (int*)(ws + WS_EIDX); int* inv = (int*)(ws + WS_INV);
    bf16* HB = (bf16*)(ws + WS_HB); bf16* HS = (bf16*)(ws + WS_HS); bf16* Yr = (bf16*)(ws + WS_BIG);
    if constexpr (PH == PH_MOE1) {
        const float* g1 = ain(kp, IN_LNG) + (size_t)(L * 2 + 0) * D; const float* b1 = ain(kp, IN_LNB) + (size_t)(L * 2 + 0) * D;
        phase_moe1n(F, yf, pstp, g1, b1, (const bf16*)(ws + WS_RWH) + (size_t)L * NEXP * D, (const bf16*)(ws + WS_RWL) + (size_t)L * NEXP * D, ain(kp, IN_RB) + (size_t)L * NEXP,
                    x1b, (float*)(ws + WS_ST1), cnt, ltok, lgate, eidx, inv); }
    if constexpr (PH == PH_MOE2) {
        const int NT = build_tiles(F, cnt);
        { g8::ExpertSched<1, true> S; S.tpref = (const LAS int*)(F.lds + LDS_TAB); S.cnt = (const LAS int*)(F.lds + LDS_TAB + 512); S.A = (const char*)x1b; S.B = (const char*)((const bf16*)(ws + WS_W_EX_GU) + (size_t)L * 64 * 256 * D);
          S.tok = ltok; S.b_exp = (size_t)256 * D * 2; S.b_tile = 0; S.a_tile = 0; S.NU = NT; S.G = F.G; S.c = c;
          g8::EpiExpertGU E{HB}; g8::gemm_phase<g8::EpiExpertGU, g8::ExpertSched<1, true>, true>(ring, F.tid, D, D, D, S, E); }
        { const int rot = (c - (NT % F.G) + F.G) % F.G;
          g8::DenseSched S; S.init(x1b, (const bf16*)(ws + WS_W_SH_GU) + (size_t)L * 512 * D, T, 512, D, D, F.G, rot);
          int t2 = F.tid; asm volatile("" : "+v"(t2));
          g8::EpiSharedGU E{HS}; g8::gemm_phase<g8::EpiSharedGU, g8::DenseSched, false>(ring, t2, D, D, D, S, E); } }
    if constexpr (PH == PH_MOE3) {
        const float* g1 = ain(kp, IN_LNG) + (size_t)(L * 2 + 0) * D; const float* b1 = ain(kp, IN_LNB) + (size_t)(L * 2 + 0) * D;
        const int NT = build_tiles(F, cnt);
        __syncthreads();
        phase_downproj3(F, HB, (const bf16*)(ws + WS_W_EX_D) + (size_t)L * 64 * D * EDIM, HS, (const bf16*)(ws + WS_W_SH_D) + (size_t)L * D * SDIM, (unsigned char*)Yr, (float*)(ws + WS_BIG + BG_YSC), NT + 2 * (T / 256));
        (void)g1; (void)b1; }
    if constexpr (PH == PH_MOE4) { (void)build_tiles(F, cnt);
        const float* g2 = ain(kp, IN_LNG) + (size_t)(L * 2 + 1) * D; const float* b2 = ain(kp, IN_LNB) + (size_t)(L * 2 + 1) * D;
        phase_moe4q(F, x1b, (bf16*)(ws + WS_Y2F), (const unsigned char*)Yr, (const float*)(ws + WS_BIG + BG_YSC), eidx, inv, g2, b2, (float*)(ws + WS_ST2), (bf16*)(ws + WS_XB), aout(kp), L == DEPTH - 1); }
}
__device__ __forceinline__ void make_frame(Frame& F, const Args& args) {
    extern __shared__ __attribute__((aligned(16))) unsigned char lds_raw[];
    F.lds = (LAS unsigned char*)lds_raw; F.ws = args.ws; F.ctl = (unsigned*)(args.ws + WS_CTL);
    F.tid = threadIdx.x; F.lane = F.tid & 63; F.wave = __builtin_amdgcn_readfirstlane(F.tid >> 6); F.G = gridDim.x; F.bid = blockIdx.x;
}
template <int PH> __global__ void __launch_bounds__(512, 2) k_phase(Args args, int L) {
    Frame F; make_frame(F, args);
    run_phase<PH>(F, args, L);
}

#ifndef MK_NOINLINE
#define MK_NOINLINE 0
#endif
#if MK_NOINLINE
template <int PH> __device__ __noinline__ void call_phase_ni(const int L) {
    Args dummy{}; Frame F;
    KP kp = (KP)__builtin_amdgcn_kernarg_segment_ptr();
    extern __shared__ __attribute__((aligned(16))) unsigned char lds_raw[];
    F.lds = (LAS unsigned char*)lds_raw; F.ws = (unsigned char*)((GAS unsigned char* const CAS*)kp)[20]; F.ctl = (unsigned*)(F.ws + WS_CTL);
    F.tid = threadIdx.x; F.lane = F.tid & 63; F.wave = __builtin_amdgcn_readfirstlane(F.tid >> 6); F.G = gridDim.x; F.bid = blockIdx.x;
    run_phase<PH>(F, dummy, L);
}
template <int PH> __device__ __forceinline__ void call_phase(const Frame& F, const Args& args, const int L) { call_phase_ni<PH>(L); }
#else
template <int PH> __device__ __forceinline__ void call_phase(const Frame& F, const Args& args, const int L) { asm volatile("; PHASE_BEGIN %0" :: "n"(PH)); run_phase<PH>(F, args, L); asm volatile("; PHASE_END %0" :: "n"(PH)); }
#endif
__global__ void __launch_bounds__(512, 2) fwd_all(Args args) {
    Frame F; make_frame(F, args);
    volatile LAS unsigned* misc = (volatile LAS unsigned*)(F.lds + LDS_MISC);
    if (F.tid < 4) misc[F.tid] = 0u;
    __syncthreads();
    const int lo = args.ph_lo, hi = args.ph_hi;
    XcdBarrier bar; bar.bar = F.ctl + CW_BAR; bar.x = 0; bar.st = misc;
    if (hi - lo > 1) bar = xcd_barrier_post(F.ctl + CW_BAR, misc);
    int pc = 0;
#ifndef MK_DUP_MASK
#define MK_DUP_MASK 0
#endif
#if MK_DUP_MASK
#define STEP(PH, Lx) do { if (pc >= lo && pc < hi) { int nrep_ = ((MK_DUP_MASK >> (PH)) & 1) ? 2 : 1; asm volatile("" : "+s"(nrep_)); _Pragma("unroll 1") for (int r_ = 0; r_ < nrep_; ++r_) { call_phase<PH>(F, args, Lx); if (r_ + 1 < nrep_ || pc + 1 < hi) xcd_barrier(bar); } } ++pc; } while (0)
#else
#define STEP(PH, Lx) do { if (pc >= lo && pc < hi) { call_phase<PH>(F, args, Lx); if (pc + 1 < hi) xcd_barrier(bar); } ++pc; } while (0)
#endif
    STEP(PH_PRO, 0);
#pragma unroll 1
    for (int L = 0; L < DEPTH; ++L) {
        const int kind = L % 3;
        if (kind == 0) { STEP(PH_POOL_G1, L); STEP(PH_POOL_P, L); STEP(PH_POOL_G2, L); STEP(PH_POOL_G3, L); }
        else if (kind == 1) { STEP(PH_DIL_G1, L); STEP(PH_DIL_ATT, L); STEP(PH_DIL_CMB, L); STEP(PH_DIL_G2, L); }
        else { STEP(PH_CONV_G1, L); STEP(PH_CONV_E, L); STEP(PH_CONV_G2, L); }
        STEP(PH_MOE1, L); STEP(PH_MOE2, L); STEP(PH_MOE3, L); STEP(PH_MOE4, L);
    }
#undef STEP
}
constexpr int N_STEPS = 1 + 2 * 8 + 8 + 7;

template <int PH> static void launch_phase(const Args& a, int L, int grid, hipStream_t stream) {
    static bool attr = false;
    if (!attr) { (void)hipFuncSetAttribute((const void*)k_phase<PH>, hipFuncAttributeMaxDynamicSharedMemorySize, LDS_BYTES); attr = true; }
    hipLaunchKernelGGL(k_phase<PH>, dim3(grid), dim3(512), LDS_BYTES, stream, a, L);
}
extern "C" void kernel_launch(void* const* d_in, const int* in_sizes, int n_in, void* d_out, int out_size, void* d_ws, size_t ws_size, hipStream_t stream) {
    static int grid = 0;
    if (grid == 0) {
        if (n_in != 19 || out_size != T * D || ws_size < WS_END) { fprintf(stderr, "kernel_launch: unexpected shapes (n_in %d out %d ws %zu need %zu)\n", n_in, out_size, ws_size, (size_t)WS_END); grid = -1; return; }
        int dev = 0, cus = 0;
        if (hipGetDevice(&dev) != hipSuccess || hipDeviceGetAttribute(&cus, hipDeviceAttributeMultiprocessorCount, dev) != hipSuccess) { grid = -1; return; }
#if MK_ONE_LAUNCH
        if (hipFuncSetAttribute((const void*)fwd_all, hipFuncAttributeMaxDynamicSharedMemorySize, LDS_BYTES) != hipSuccess) { fprintf(stderr, "kernel_launch: hipFuncSetAttribute failed\n"); grid = -1; return; }
        int per_cu = 0;
        if (hipOccupancyMaxActiveBlocksPerMultiprocessor(&per_cu, (const void*)fwd_all, 512, LDS_BYTES) != hipSuccess || per_cu < 1) { fprintf(stderr, "kernel_launch: note: occupancy query reports %d blocks per CU\n", per_cu); (void)hipGetLastError(); }
#endif
        grid = cus;
    }
    if (grid < 0) return;
    (void)hipMemsetAsync((char*)d_ws + WS_CTL, 0, CTL_ZERO_BYTES, stream);
    Args a{};
    for (int i = 0; i < 19; ++i) a.in[i] = (const float*)d_in[i];
    a.out = (float*)d_out; a.ws = (unsigned char*)d_ws; a.ph_lo = 0; a.ph_hi = 0;
#if MK_ONE_LAUNCH
#ifdef MK_SPLIT
    for (int p = 0; p < N_STEPS; ++p) { a.ph_lo = p; a.ph_hi = p + 1; hipLaunchKernelGGL(fwd_all, dim3(grid), dim3(512), LDS_BYTES, stream, a); }
#else
    a.ph_lo = 0; a.ph_hi = N_STEPS;
    hipLaunchKernelGGL(fwd_all, dim3(grid), dim3(512), LDS_BYTES, stream, a);
#endif
#elif defined(MK_HYBRID_MASK)
    {
        static bool attr2 = false; if (!attr2) { (void)hipFuncSetAttribute((const void*)fwd_all, hipFuncAttributeMaxDynamicSharedMemorySize, LDS_BYTES); attr2 = true; }
        int pc = 0;
#define HSTEP(PH, Lx) do { if ((MK_HYBRID_MASK >> (PH)) & 1) { a.ph_lo = pc; a.ph_hi = pc + 1; hipLaunchKernelGGL(fwd_all, dim3(grid), dim3(512), LDS_BYTES, stream, a); } else { a.ph_lo = 0; a.ph_hi = 0; launch_phase<PH>(a, Lx, grid, stream); } ++pc; } while (0)
        HSTEP(PH_PRO, 0);
        for (int L = 0; L < DEPTH; ++L) {
            const int kind = L % 3;
            if (kind == 0) { HSTEP(PH_POOL_G1, L); HSTEP(PH_POOL_P, L); HSTEP(PH_POOL_G2, L); HSTEP(PH_POOL_G3, L); }
            else if (kind == 1) { HSTEP(PH_DIL_G1, L); HSTEP(PH_DIL_ATT, L); HSTEP(PH_DIL_CMB, L); HSTEP(PH_DIL_G2, L); }
            else { HSTEP(PH_CONV_G1, L); HSTEP(PH_CONV_E, L); HSTEP(PH_CONV_G2, L); }
            HSTEP(PH_MOE1, L); HSTEP(PH_MOE2, L); HSTEP(PH_MOE3, L); HSTEP(PH_MOE4, L);
        }
#undef HSTEP
    }
#else
    launch_phase<PH_PRO>(a, 0, grid, stream);
    for (int L = 0; L < DEPTH; ++L) {
        const int kind = L % 3;
        if (kind == 0) { launch_phase<PH_POOL_G1>(a, L, grid, stream); launch_phase<PH_POOL_P>(a, L, grid, stream); launch_phase<PH_POOL_G2>(a, L, grid, stream); launch_phase<PH_POOL_G3>(a, L, grid, stream); }
        else if (kind == 1) { launch_phase<PH_DIL_G1>(a, L, grid, stream); launch_phase<PH_DIL_ATT>(a, L, grid, stream); launch_phase<PH_DIL_CMB>(a, L, grid, stream); launch_phase<PH_DIL_G2>(a, L, grid, stream); }
        else { launch_phase<PH_CONV_G1>(a, L, grid, stream); launch_phase<PH_CONV_E>(a, L, grid, stream); launch_phase<PH_CONV_G2>(a, L, grid, stream); }
        launch_phase<PH_MOE1>(a, L, grid, stream); launch_phase<PH_MOE2>(a, L, grid, stream); launch_phase<PH_MOE3>(a, L, grid, stream); launch_phase<PH_MOE4>(a, L, grid, stream);
    }
#endif
}
```

```cpp
#include <hip/hip_runtime.h>
#include <cstdio>
#include <cstdint>

#ifndef MK_ONE_LAUNCH
#define MK_ONE_LAUNCH 1
#endif

#define GAS __attribute__((address_space(1)))
#define LAS __attribute__((address_space(3)))
typedef unsigned short bf16;
typedef unsigned v4u __attribute__((ext_vector_type(4)));
typedef unsigned v2u __attribute__((ext_vector_type(2)));
typedef float f32x4 __attribute__((ext_vector_type(4)));
typedef float f32x2 __attribute__((ext_vector_type(2)));
typedef short bf16x8 __attribute__((ext_vector_type(8)));
typedef short s16x4 __attribute__((ext_vector_type(4)));

constexpr int NBATCH = 8, SEQ = 2048, D = 2048, T = NBATCH * SEQ, DEPTH = 4;
constexpr int NEXP = 64, TOPK = 8, EDIM = 128, SDIM = 256;
constexpr int QKVC = 4608, DILW = 512;
constexpr float ALPHA = 1.681792830507429f;
constexpr float LN_EPS = 1e-5f;
constexpr int CAP = 16384;
constexpr int HROWS = T * TOPK + NEXP * 256;

constexpr size_t MiB = 1u << 20;
constexpr size_t WS_CTL = 0, CTL_ZERO_BYTES = 1 * MiB;
constexpr size_t WS_W_POOL_IN = 1 * MiB;
constexpr size_t WS_W_POOL_G = WS_W_POOL_IN + 16 * MiB;
constexpr size_t WS_W_POOL_OUT = WS_W_POOL_G + 4 * MiB;
constexpr size_t WS_W_DIL_QKV = WS_W_POOL_OUT + 16 * MiB;
constexpr size_t WS_W_DIL_OUT = WS_W_DIL_QKV + 18 * MiB;
constexpr size_t WS_W_CONV_IN = WS_W_DIL_OUT + 2 * MiB;
constexpr size_t WS_W_CONV_OUT = WS_W_CONV_IN + 24 * MiB;
constexpr size_t WS_W_SH_GU = WS_W_CONV_OUT + 8 * MiB;
constexpr size_t WS_W_SH_D = WS_W_SH_GU + 8 * MiB;
constexpr size_t WS_W_EX_GU = WS_W_SH_D + 4 * MiB;
constexpr size_t WS_W_EX_D = WS_W_EX_GU + 256 * MiB;
constexpr size_t WS_XF = WS_W_EX_D + 256 * MiB;
constexpr size_t WS_YF = WS_XF + 128 * MiB;
constexpr size_t WS_X1F = WS_YF + 128 * MiB;
constexpr size_t WS_XB = WS_X1F + 128 * MiB;
constexpr size_t WS_X1B = WS_XB + 64 * MiB;
constexpr size_t WS_HB = WS_X1B + 64 * MiB;
constexpr size_t WS_HS = WS_HB + 72 * MiB;
constexpr size_t WS_LTOK = WS_HS + 8 * MiB;
constexpr size_t WS_LGATE = WS_LTOK + 4 * MiB;
constexpr size_t WS_EIDX = WS_LGATE + 4 * MiB;
constexpr size_t WS_INV = WS_EIDX + 1 * MiB;
constexpr size_t WS_BIG = WS_INV + 1 * MiB;
constexpr size_t WS_PST = WS_BIG + 608 * MiB;
constexpr size_t WS_ST1 = WS_PST + 4 * MiB;
constexpr size_t WS_ST2 = WS_ST1 + 1 * MiB;
constexpr size_t WS_RWH = WS_ST2 + 1 * MiB;
constexpr size_t WS_RWL = WS_RWH + 1 * MiB;
constexpr size_t WS_PST2 = WS_RWL + 1 * MiB;
constexpr size_t WS_END = WS_PST2 + 8 * MiB;
constexpr size_t WS_Y2F = WS_X1F;
constexpr size_t BG_U = 0, BG_PL = 64 * MiB, BG_MX = 128 * MiB;
constexpr size_t BG_QKV = 0, BG_OG = 144 * MiB, BG_LSE = 192 * MiB, BG_O = 194 * MiB;
constexpr size_t BG_UC = 0, BG_BG = 64 * MiB, BG_Z = 128 * MiB;
constexpr size_t BG_YSC = 400 * MiB;
constexpr int CW_BAR = 4096;
constexpr int CW_CNT = 16384;

constexpr int RING_BYTES = 131072;
constexpr int LDS_TAB = RING_BYTES;
constexpr int LDS_STASH = RING_BYTES + 1024;
constexpr int LDS_BYTES = 163840;
constexpr int LDS_MISC = LDS_BYTES - 1024;

typedef __bf16 bf16x2_t __attribute__((ext_vector_type(2)));
typedef float f32x2_t __attribute__((ext_vector_type(2)));
__device__ __forceinline__ unsigned cvt_pk_bf16(float lo, float hi) { const bf16x2_t r = __builtin_convertvector((f32x2_t){lo, hi}, bf16x2_t); return __builtin_bit_cast(unsigned, r); }
__device__ __forceinline__ unsigned f2bf(float f) { unsigned u = __builtin_bit_cast(unsigned, f); return (u + 0x7fffu + ((u >> 16) & 1u)) >> 16; }
__device__ __forceinline__ unsigned pk2(float lo, float hi) { return f2bf(lo) | (f2bf(hi) << 16); }
__device__ __forceinline__ float bflo(unsigned w) { return __builtin_bit_cast(float, w << 16); }
__device__ __forceinline__ float bfhi(unsigned w) { return __builtin_bit_cast(float, w & 0xffff0000u); }
__device__ __forceinline__ float shfl_from(float v, int src) { return __builtin_bit_cast(float, __builtin_amdgcn_ds_bpermute(src << 2, __builtin_bit_cast(int, v))); }
__device__ __forceinline__ float shfl_x(float v, int o, int lane) { return shfl_from(v, lane ^ o); }
__device__ __forceinline__ float wave_sum(float v, int lane) {
#pragma unroll
    for (int o = 1; o < 64; o <<= 1) v += shfl_x(v, o, lane);
    return v;
}
#define LDS_WAIT() asm volatile("s_waitcnt lgkmcnt(0)" ::: "memory")
#define VM_WAIT() asm volatile("s_waitcnt vmcnt(0)" ::: "memory")

#define XB_TMO      128
#define XB_XCNT(j)  (256  + 64 * (j))
#define XB_XSUB(j)  (1280 + 64 * (j))
#define XB_XGEN(j)  (2304 + 64 * (j))
#define XB_TOP      3328
#define XB_TOPGEN   3392
#define XCD_BAR_WORDS 3456
#define XB_SPIN_CAP (1u << 18)

__device__ __forceinline__ unsigned xb_ld(unsigned* p)              { return __hip_atomic_load(p, __ATOMIC_RELAXED, __HIP_MEMORY_SCOPE_AGENT); }
__device__ __forceinline__ unsigned xb_add(unsigned* p, unsigned v) { return __hip_atomic_fetch_add(p, v, __ATOMIC_RELAXED, __HIP_MEMORY_SCOPE_AGENT); }
__device__ __forceinline__ unsigned xb_xcc_id() { return (unsigned)__builtin_amdgcn_s_getreg((3 << 11) | 20) & 0xFu; }
#define XB_SPIN(cond, bar) do { unsigned _sp = 0; while (cond) { __builtin_amdgcn_s_sleep(1); \
    if ((++_sp & 255u) == 0u) { if (xb_ld(&(bar)[XB_TMO])) break; if (_sp > XB_SPIN_CAP) { atomicAdd(&(bar)[XB_TMO], 1u); break; } } } } while (0)

struct XcdBarrier {
    unsigned* bar; unsigned x;
    volatile LAS unsigned* st;
};

__device__ __forceinline__ XcdBarrier xcd_barrier_post(unsigned* bar, volatile LAS unsigned* st) {
    XcdBarrier b; b.bar = bar; b.x = xb_xcc_id(); b.st = st;
    if (threadIdx.x == 0) (void)xb_add(&bar[XB_XCNT(b.x)], 1u);
    return b;
}
__device__ __forceinline__ void xcd_barrier_complete(unsigned* bar, unsigned x, unsigned& nloc, unsigned& nx) {
    const unsigned G = gridDim.x * gridDim.y * gridDim.z;
    unsigned sum, cnt, mine, sp = 0u;
    for (;;) {
        sum = 0u; cnt = 0u; mine = 0u;
#pragma unroll
        for (unsigned j = 0; j < 16; ++j) { const unsigned c = xb_ld(&bar[XB_XCNT(j)]); sum += c; cnt += (c > 0u) ? 1u : 0u; mine = (j == x) ? c : mine; }
        if (sum == G) break;
        __builtin_amdgcn_s_sleep(1);
        if ((++sp & 255u) == 0u) { if (xb_ld(&bar[XB_TMO])) break; if (sp > XB_SPIN_CAP) { atomicAdd(&bar[XB_TMO], 1u); break; } }
    }
    nloc = mine > 0u ? mine : 1u; nx = cnt > 0u ? cnt : 1u;
}

__device__ __forceinline__ void xcd_barrier(const XcdBarrier& b) {
    asm volatile("s_waitcnt vmcnt(0)" ::: "memory");
    __syncthreads();
    if (threadIdx.x == 0) {
        unsigned* bar; unsigned bx = b.x; { GAS unsigned* bg = (GAS unsigned*)b.bar; asm volatile("" : "+s"(bg), "+s"(bx)); bar = (unsigned*)bg; }
        __builtin_amdgcn_s_waitcnt(0);
        unsigned nloc = b.st[0], nx = b.st[1];
        if (nloc == 0u) { xcd_barrier_complete(bar, bx, nloc, nx); b.st[0] = nloc; b.st[1] = nx; }
        const unsigned old = xb_add(&bar[XB_XSUB(bx)], 1u);
        const unsigned gen = old / nloc;
        if (old + 1u == (gen + 1u) * nloc) {
            __builtin_amdgcn_fence(__ATOMIC_RELEASE, "agent");
            asm volatile("s_waitcnt vmcnt(0)" ::: "memory");
            const unsigned og = xb_add(&bar[XB_TOP], 1u);
            const unsigned tg = og / nx;
            if (og + 1u == (tg + 1u) * nx) xb_add(&bar[XB_TOPGEN], 1u);
            else XB_SPIN(xb_ld(&bar[XB_TOPGEN]) == tg, bar);
            __builtin_amdgcn_fence(__ATOMIC_ACQUIRE, "agent");
            xb_add(&bar[XB_XGEN(bx)], 1u);
            asm volatile("s_waitcnt vmcnt(0)" ::: "memory");
        } else {
            XB_SPIN(xb_ld(&bar[XB_XGEN(bx)]) == gen, bar);
            __builtin_amdgcn_fence(__ATOMIC_ACQUIRE, "agent");
            asm volatile("s_waitcnt vmcnt(0)" ::: "memory");
        }
    }
    __syncthreads();
}

namespace g8 {
constexpr int BM = 256, BK = 64, HALF = 128, HTB = HALF * BK * 2, STAGE_BYTES = 8 * HTB, NXCD = 8, WGM = 8;
__host__ __device__ __forceinline__ int lds_byte(int r, int c) { const int st = (r >> 4) * 2 + (c >> 5), rr = r & 15, cc = c & 31, ob = rr * 64 + cc * 2; return st * 1024 + (ob ^ (((ob >> 9) & 1) << 5)); }
__host__ __device__ __forceinline__ void stage_rc(int b, int& R, int& C) { const int st = b / 1024, sb = b % 1024, swz = sb ^ (((sb >> 9) & 1) << 5); R = (st >> 1) * 16 + swz / 64; C = (st & 1) * 32 + (swz % 64) / 2; }
__host__ __device__ __forceinline__ int perm32(int rho) { const int n = rho >> 4, i = rho & 15; return 8 * (i >> 2) + 4 * n + (i & 3); }

struct Unit { const char* A; const char* B; const int* rows; int pm, pn, nvalid, aux; };

template <class Epi, class Sched, bool GATHER>
__device__ __forceinline__ void gemm_phase(LAS unsigned char* lds, const int tid_in, const int K, const int lda, const int ldb, const Sched& S, const Epi& E) {
    const int tid = tid_in, wid = __builtin_amdgcn_readfirstlane(tid >> 6), lane = tid & 63, wr = wid >> 2, wc = wid & 3, fr = lane & 15, fq = lane >> 4;
    const int nt = K / BK;
    unsigned voffB[2];
#pragma unroll
    for (int i = 0; i < 2; ++i) { int R_, C_; stage_rc(tid * 16 + i * 8192, R_, C_); const int Rb = Epi::PERM ? ((R_ & ~31) + perm32(R_ & 31)) : R_; voffB[i] = (unsigned)(Rb * ldb + C_) * 2u; }
    LAS v4u* stash = (LAS v4u*)(lds + (LDS_STASH - 0) + tid * 16);
    const size_t kstep = (size_t)(BK * 2);
    const size_t hstepB = (size_t)HALF * ldb * 2;
    const unsigned ldsw = (unsigned)wid * 1024u;
    const int aoff = lds_byte(wr * 64 + fr, fq * 8), boff = lds_byte(wc * 32 + fr, fq * 8);
#define G8_SA(b, h) (((b) * 2 + (h)) * HTB)
#define G8_SB(b, h) ((4 + (b) * 2 + (h)) * HTB)
#define G8_STAGE2(bufoff, gbase, v0, v1) do { \
        __builtin_amdgcn_global_load_lds((const unsigned*)((const char*)(gbase) + (v0)), (LAS unsigned*)(lds + (bufoff) + ldsw), 16, 0, 0); \
        __builtin_amdgcn_global_load_lds((const unsigned*)((const char*)(gbase) + (v1)), (LAS unsigned*)(lds + (bufoff) + ldsw + 8192), 16, 0, 0); } while (0)
#define G8_STAGEB(bufoff, gbase) G8_STAGE2(bufoff, gbase, voffB[0], voffB[1])
#define G8_LDA(dst, b, h) do { _Pragma("unroll") for (int m = 0; m < 4; ++m) _Pragma("unroll") for (int k = 0; k < 2; ++k) dst[m][k] = *(const LAS bf16x8*)(lds + G8_SA(b, h) + aoff + m * 2048 + k * 1024); } while (0)
#define G8_LDB(dst, b, h) do { _Pragma("unroll") for (int n = 0; n < 2; ++n) _Pragma("unroll") for (int k = 0; k < 2; ++k) dst[n][k] = *(const LAS bf16x8*)(lds + G8_SB(b, h) + boff + n * 2048 + k * 1024); } while (0)
#define G8_MMA(ai, bj, At, Bt) do { __builtin_amdgcn_s_setprio(1); _Pragma("unroll") for (int m = 0; m < 4; ++m) _Pragma("unroll") for (int n = 0; n < 2; ++n) _Pragma("unroll") for (int k = 0; k < 2; ++k) \
        acc[ai][bj][m][n] = __builtin_amdgcn_mfma_f32_16x16x32_bf16(Bt[n][k], At[m][k], acc[ai][bj][m][n], 0, 0, 0); __builtin_amdgcn_s_setprio(0); } while (0)
#define G8_WAIT_V(n) asm volatile("s_waitcnt vmcnt(" #n ")" ::: "memory")
#define G8_WAIT_L(n) asm volatile("s_waitcnt lgkmcnt(" #n ")" ::: "memory")
#define G8_BAR __builtin_amdgcn_s_barrier()
#define G8_SCHED __builtin_amdgcn_sched_barrier(0)
#define G8_SETVA(dst, u) do { int _t2 = tid; if (GATHER) asm volatile("" : "+v"(_t2)); _Pragma("unroll") for (int _h = 0; _h < 2; ++_h) _Pragma("unroll") for (int _i = 0; _i < 2; ++_i) { \
        int _R, _C; stage_rc(_t2 * 16 + _i * 8192, _R, _C); \
        const unsigned _rl = (unsigned)(_h * HALF + _R); unsigned _row = _rl; \
        if (GATHER) { _row = 0u; if (_rl < (unsigned)(u).nvalid) _row = (unsigned)(u).rows[_rl] >> 3; } \
        dst[_h][_i] = (_row * (unsigned)lda + (unsigned)_C) * 2u; } } while (0)
    Unit cur, nxt; int ui = 0;
    if (!S.next(0, cur)) return;
    f32x4 acc[2][2][4][2];
#pragma unroll
    for (int a = 0; a < 2; ++a)
#pragma unroll
        for (int b = 0; b < 2; ++b)
#pragma unroll
            for (int m = 0; m < 4; ++m)
#pragma unroll
                for (int n = 0; n < 2; ++n) acc[a][b][m][n] = (f32x4){0.f, 0.f, 0.f, 0.f};
    bf16x8 At[4][2], B0[2][2], B1[2][2];
    unsigned vAc[2][2]; unsigned xl00 = 0, xl01 = 0, xl10 = 0, xl11 = 0;
    G8_SETVA(vAc, cur);
    const char* cA = cur.A; const char* cB = cur.B;
    G8_STAGEB(G8_SB(0, 0), cB); G8_STAGEB(G8_SB(0, 1), cB + hstepB); G8_STAGE2(G8_SA(0, 0), cA, vAc[0][0], vAc[0][1]); G8_STAGE2(G8_SA(0, 1), cA, vAc[1][0], vAc[1][1]);
    if (wr == 1) G8_BAR;
    G8_WAIT_V(2); G8_BAR;
    G8_STAGEB(G8_SB(1, 0), cB + kstep); G8_STAGE2(G8_SA(1, 0), cA + kstep, vAc[0][0], vAc[0][1]); G8_STAGEB(G8_SB(1, 1), cB + hstepB + kstep);
    G8_WAIT_V(6); G8_BAR;
    for (;;) {
        const bool has_next = S.next(ui + 1, nxt);
        const char* nA = has_next ? nxt.A : cA; const char* nB = has_next ? nxt.B : cB;
        if (GATHER) { unsigned vAn[2][2]; if (has_next) { G8_SETVA(vAn, nxt); } else {
#pragma unroll
            for (int h = 0; h < 2; ++h)
#pragma unroll
                for (int i = 0; i < 2; ++i) vAn[h][i] = vAc[h][i]; }
            *stash = (v4u){vAn[0][0], vAn[0][1], vAn[1][0], vAn[1][1]}; }
#pragma unroll 1
        for (int t = 0; t < nt; t += 2) {
            const bool last = (t == nt - 2);
            const char* a1 = cA + (size_t)(t + 1) * kstep;
            const char* a2 = last ? nA : cA + (size_t)(t + 2) * kstep; const char* b2 = last ? nB : cB + (size_t)(t + 2) * kstep;
            const char* a3 = a2 + kstep; const char* b3 = b2 + kstep;
            unsigned x00 = vAc[0][0], x01 = vAc[0][1], x10 = vAc[1][0], x11 = vAc[1][1];
            if (GATHER) { if (last) { const v4u sv = *stash; x00 = sv.x; x01 = sv.y; x10 = sv.z; x11 = sv.w; } xl00 = x00; xl01 = x01; xl10 = x10; xl11 = x11; }
            G8_LDB(B0, 0, 0); G8_LDB(B1, 0, 1); G8_SCHED; G8_LDA(At, 0, 0); G8_STAGE2(G8_SA(1, 1), a1, vAc[1][0], vAc[1][1]);
            G8_WAIT_V(8); G8_WAIT_L(0); G8_BAR; G8_MMA(0, 0, At, B0); G8_MMA(0, 1, At, B1); G8_BAR; G8_SCHED;
            G8_LDA(At, 0, 1); G8_STAGEB(G8_SB(0, 0), b2); G8_STAGEB(G8_SB(0, 1), b2 + hstepB); G8_STAGE2(G8_SA(0, 0), a2, x00, x01);
            G8_WAIT_V(8); G8_WAIT_L(0); G8_BAR; G8_MMA(1, 0, At, B0); G8_MMA(1, 1, At, B1); G8_BAR; G8_SCHED;
            G8_LDB(B0, 1, 0); G8_LDB(B1, 1, 1); G8_SCHED; G8_LDA(At, 1, 0); G8_STAGE2(G8_SA(0, 1), a2, x10, x11);
            G8_WAIT_V(8); G8_WAIT_L(0); G8_BAR; G8_MMA(0, 0, At, B0); G8_MMA(0, 1, At, B1); G8_BAR; G8_SCHED;
            G8_LDA(At, 1, 1); G8_STAGEB(G8_SB(1, 0), b3); G8_STAGEB(G8_SB(1, 1), b3 + hstepB); G8_STAGE2(G8_SA(1, 0), a3, x00, x01);
            G8_WAIT_V(8); G8_WAIT_L(0); G8_BAR; G8_MMA(1, 0, At, B0); G8_MMA(1, 1, At, B1); G8_BAR; G8_SCHED;
        }
        if (wr == 0) G8_BAR;
        E(acc, cur, wr, wc, fr, fq);
        if (!has_next) break;
#pragma unroll
        for (int a = 0; a < 2; ++a)
#pragma unroll
            for (int b = 0; b < 2; ++b)
#pragma unroll
                for (int m = 0; m < 4; ++m)
#pragma unroll
                    for (int n = 0; n < 2; ++n) acc[a][b][m][n] = (f32x4){0.f, 0.f, 0.f, 0.f};
        cur = nxt; cA = nA; cB = nB; ++ui;
        if (GATHER) { vAc[0][0] = xl00; vAc[0][1] = xl01; vAc[1][0] = xl10; vAc[1][1] = xl11; }
        if (wr == 1) G8_BAR;
    }
    G8_WAIT_V(0);
    G8_BAR;
#undef G8_SA
#undef G8_SB
#undef G8_STAGE2
#undef G8_STAGEB
#undef G8_LDA
#undef G8_LDB
#undef G8_MMA
#undef G8_WAIT_V
#undef G8_WAIT_L
#undef G8_BAR
#undef G8_SCHED
#undef G8_SETVA
}

struct DenseSched {
    const char* A; const char* B; size_t a_tile, b_tile, agrp_stride; int agrp_shift, nM, nN, nwg, G, c;
    __device__ __forceinline__ void init(const void* A_, const void* B_, int M, int N, int lda, int ldb, int G_, int c_) {
        A = (const char*)A_; B = (const char*)B_; a_tile = (size_t)BM * lda * 2; b_tile = (size_t)BM * ldb * 2; agrp_stride = 0; agrp_shift = 0; nM = M / BM; nN = N / BM; nwg = nM * nN; G = G_; c = c_; }
    __device__ __forceinline__ bool next(int i, Unit& u) const {
        const long L = (long)i * G + c; if (L >= nwg) return false;
        int wgid = (int)L; { const int q = nwg / NXCD, r = nwg % NXCD, xcd = wgid % NXCD, off = wgid / NXCD; wgid = (xcd < r ? xcd * (q + 1) : r * (q + 1) + (xcd - r) * q) + off; }
        const int nig = WGM * nN, gid = wgid / nig, fm = gid * WGM, gsz = (nM - fm) < WGM ? (nM - fm) : WGM;
        u.pm = fm + ((wgid % nig) % gsz); u.pn = (wgid % nig) / gsz;
        u.A = A + (size_t)u.pm * a_tile + (size_t)(u.pn >> agrp_shift) * agrp_stride; u.B = B + (size_t)u.pn * b_tile; u.rows = nullptr; u.nvalid = BM; u.aux = 0; return true;
    }
};
template <int NPN, bool GATHERED>
struct ExpertSched {
    const LAS int* tpref; const LAS int* cnt; const char* A; const char* B; const int* tok; size_t b_exp, b_tile, a_tile; int NU, G, c;
    __device__ __forceinline__ bool next(int i, Unit& u) const {
        int L = i * G + c; if (L >= NU) return false;
        if ((i + 1) * G <= NU && (G % NXCD) == 0) L = i * G + (c % NXCD) * (G / NXCD) + c / NXCD;
        const int tile = L / NPN, pn = L % NPN;
        int e = 0; while (__builtin_amdgcn_readfirstlane(tpref[e + 1]) <= tile) ++e;
        const int rb = tile - __builtin_amdgcn_readfirstlane(tpref[e]);
        u.pm = e; u.pn = pn; u.aux = tile * BM; u.nvalid = __builtin_amdgcn_readfirstlane(cnt[e]) - rb * BM; if (u.nvalid > BM) u.nvalid = BM;
        u.rows = tok + (size_t)e * CAP + rb * BM;
        u.A = GATHERED ? A : A + (size_t)tile * a_tile; u.B = B + (size_t)e * b_exp + (size_t)pn * b_tile; return true;
    }
};

struct EpiBf16 {
    static constexpr bool PERM = true;
    bf16* O; int ldc; int qscale;
    __device__ __forceinline__ void operator()(const f32x4 (&acc)[2][2][4][2], const Unit& u, int wr, int wc, int fr, int fq) const {
        asm volatile("" : "+v"(fr), "+v"(fq));
        const int row0 = u.pm * BM + wr * 64 + fr, col0 = u.pn * BM + wc * 32 + 8 * fq;
        const float sc = (qscale && (u.pn % 6) < 2) ? 0.125f : 1.0f;
#pragma unroll
        for (int ai = 0; ai < 2; ++ai)
#pragma unroll
            for (int m = 0; m < 4; ++m) { bf16* rowp = O + (size_t)(row0 + ai * HALF + m * 16) * ldc + col0;
#pragma unroll
                for (int bj = 0; bj < 2; ++bj) { const f32x4 v0 = acc[ai][bj][m][0] * sc, v1 = acc[ai][bj][m][1] * sc;
                    v4u w; w.x = cvt_pk_bf16(v0[0], v0[1]); w.y = cvt_pk_bf16(v0[2], v0[3]); w.z = cvt_pk_bf16(v1[0], v1[1]); w.w = cvt_pk_bf16(v1[2], v1[3]);
                    *(v4u*)(rowp + bj * HALF) = w; } }
    }
};
struct EpiScaleBf16 {
    static constexpr bool PERM = true;
    bf16* O; int ldc; const float* scale;
    __device__ __forceinline__ void operator()(const f32x4 (&acc)[2][2][4][2], const Unit& u, int wr, int wc, int fr, int fq) const {
        asm volatile("" : "+v"(fr), "+v"(fq));
        const int row0 = u.pm * BM + wr * 64 + fr, col0 = u.pn * BM + wc * 32 + 8 * fq;
        f32x4 sv[2][2];
#pragma unroll
        for (int bj = 0; bj < 2; ++bj)
#pragma unroll
            for (int n = 0; n < 2; ++n) sv[bj][n] = *(const f32x4*)(scale + col0 + bj * HALF + 4 * n);
#pragma unroll
        for (int ai = 0; ai < 2; ++ai)
#pragma unroll
            for (int m = 0; m < 4; ++m) { bf16* rowp = O + (size_t)(row0 + ai * HALF + m * 16) * ldc + col0;
#pragma unroll
                for (int bj = 0; bj < 2; ++bj) { const f32x4 v0 = acc[ai][bj][m][0] * sv[bj][0], v1 = acc[ai][bj][m][1] * sv[bj][1];
                    v4u w; w.x = cvt_pk_bf16(v0[0], v0[1]); w.y = cvt_pk_bf16(v0[2], v0[3]); w.z = cvt_pk_bf16(v1[0], v1[1]); w.w = cvt_pk_bf16(v1[2], v1[3]);
                    *(v4u*)(rowp + bj * HALF) = w; } }
    }
};
struct EpiResid {
    static constexpr bool PERM = false;
    const float* X; float* Y;
    __device__ __forceinline__ void operator()(const f32x4 (&acc)[2][2][4][2], const Unit& u, int wr, int wc, int fr, int fq) const {
        asm volatile("" : "+v"(fr), "+v"(fq));
        const int row0 = u.pm * BM + wr * 64 + fr, col0 = u.pn * BM + wc * 32 + 4 * fq;
#pragma unroll
        for (int ai = 0; ai < 2; ++ai)
#pragma unroll
            for (int m = 0; m < 4; ++m) { const size_t off = (size_t)(row0 + ai * HALF + m * 16) * D + col0;
#pragma unroll
                for (int bj = 0; bj < 2; ++bj)
#pragma unroll
                    for (int n = 0; n < 2; ++n) { const f32x4 xv = *(const f32x4*)(X + off + bj * HALF + n * 16); *(f32x4*)(Y + off + bj * HALF + n * 16) = xv * ALPHA + acc[ai][bj][m][n]; } }
    }
};
struct EpiResidLN {
    static constexpr bool PERM = true;
    const float* X32; const bf16* Xb; const float* st; const float* g; const float* b; bf16* Y; float* pst; int mode;
    __device__ __forceinline__ void operator()(const f32x4 (&acc)[2][2][4][2], const Unit& u, int wr, int wc, int fr, int fq) const {
        asm volatile("" : "+v"(fr), "+v"(fq));
        const int row0 = u.pm * BM + wr * 64 + fr, col0 = u.pn * BM + wc * 32 + 8 * fq, lane = fq * 16 + fr;
#pragma unroll
        for (int ai = 0; ai < 2; ++ai)
#pragma unroll
            for (int m = 0; m < 4; ++m) { const int row = row0 + ai * HALF + m * 16; const size_t off = (size_t)row * D + col0;
                float mean = 0.f, rstd = 1.f; if (mode == 1) { const f32x2 sv = *(const f32x2*)(st + 2 * row); mean = sv.x; rstd = sv.y; }
                float sm = 0.f, sq = 0.f;
#pragma unroll
                for (int bj = 0; bj < 2; ++bj) { f32x4 x0, x1;
                    if (mode == 2) { const v4u xv = *(const v4u*)(Xb + off + bj * HALF); x0 = (f32x4){bflo(xv.x), bfhi(xv.x), bflo(xv.y), bfhi(xv.y)}; x1 = (f32x4){bflo(xv.z), bfhi(xv.z), bflo(xv.w), bfhi(xv.w)}; }
                    else if (mode) { const v4u xv = *(const v4u*)(Xb + off + bj * HALF);
                        const f32x4 g0 = *(const f32x4*)(g + col0 + bj * HALF), g1 = *(const f32x4*)(g + col0 + bj * HALF + 4), b0 = *(const f32x4*)(b + col0 + bj * HALF), b1 = *(const f32x4*)(b + col0 + bj * HALF + 4);
                        x0 = ((f32x4){bflo(xv.x), bfhi(xv.x), bflo(xv.y), bfhi(xv.y)} - mean) * rstd * g0 + b0; x1 = ((f32x4){bflo(xv.z), bfhi(xv.z), bflo(xv.w), bfhi(xv.w)} - mean) * rstd * g1 + b1; }
                    else { x0 = *(const f32x4*)(X32 + off + bj * HALF); x1 = *(const f32x4*)(X32 + off + bj * HALF + 4); }
                    const f32x4 y0 = x0 * ALPHA + acc[ai][bj][m][0], y1 = x1 * ALPHA + acc[ai][bj][m][1];
                    v4u w; w.x = cvt_pk_bf16(y0[0], y0[1]); w.y = cvt_pk_bf16(y0[2], y0[3]); w.z = cvt_pk_bf16(y1[0], y1[1]); w.w = cvt_pk_bf16(y1[2], y1[3]);
                    *(v4u*)(Y + off + bj * HALF) = w;
                    sm += ((y0[0] + y0[1]) + (y0[2] + y0[3])) + ((y1[0] + y1[1]) + (y1[2] + y1[3]));
                    sq += ((y0[0] * y0[0] + y0[1] * y0[1]) + (y0[2] * y0[2] + y0[3] * y0[3])) + ((y1[0] * y1[0] + y1[1] * y1[1]) + (y1[2] * y1[2] + y1[3] * y1[3])); }
                sm += shfl_x(sm, 16, lane); sm += shfl_x(sm, 32, lane); sq += shfl_x(sq, 16, lane); sq += shfl_x(sq, 32, lane);
                if (fq == 0) *(f32x2*)(pst + ((size_t)row * 32 + u.pn * 4 + wc) * 2) = (f32x2){sm, sq}; }
    }
};
struct EpiConvIn {
    static constexpr bool PERM = true;
    bf16* UC; bf16* BGp;
    __device__ __forceinline__ void operator()(const f32x4 (&acc)[2][2][4][2], const Unit& u, int wr, int wc, int fr, int fq) const {
        asm volatile("" : "+v"(fr), "+v"(fq));
        const int row0 = u.pm * BM + wr * 64 + fr, cw = wc * 32 + 8 * fq;
        if (u.pn < 16) {
#pragma unroll
            for (int ai = 0; ai < 2; ++ai)
#pragma unroll
                for (int m = 0; m < 4; ++m) { bf16* rowp = UC + (size_t)(row0 + ai * HALF + m * 16) * D + u.pn * HALF + cw;
                    const f32x4 v0 = acc[ai][0][m][0] * acc[ai][1][m][0], v1 = acc[ai][0][m][1] * acc[ai][1][m][1];
                    v4u w; w.x = cvt_pk_bf16(v0[0], v0[1]); w.y = cvt_pk_bf16(v0[2], v0[3]); w.z = cvt_pk_bf16(v1[0], v1[1]); w.w = cvt_pk_bf16(v1[2], v1[3]);
                    *(v4u*)rowp = w; }
        } else {
#pragma unroll
            for (int ai = 0; ai < 2; ++ai)
#pragma unroll
                for (int m = 0; m < 4; ++m) { bf16* rowp = BGp + (size_t)(row0 + ai * HALF + m * 16) * D + (u.pn - 16) * BM + cw;
#pragma unroll
                    for (int bj = 0; bj < 2; ++bj) { const f32x4 v0 = acc[ai][bj][m][0], v1 = acc[ai][bj][m][1];
                        v4u w; w.x = cvt_pk_bf16(v0[0], v0[1]); w.y = cvt_pk_bf16(v0[2], v0[3]); w.z = cvt_pk_bf16(v1[0], v1[1]); w.w = cvt_pk_bf16(v1[2], v1[3]);
                        *(v4u*)(rowp + bj * HALF) = w; } }
        }
    }
};
__device__ __forceinline__ f32x4 silu_mul(f32x4 g, f32x4 uu) {
    f32x4 r;
#pragma unroll
    for (int j = 0; j < 4; ++j) r[j] = g[j] * __builtin_amdgcn_rcpf(1.0f + __expf(-g[j])) * uu[j];
    return r;
}
struct EpiExpertGU {
    static constexpr bool PERM = true;
    bf16* H;
    __device__ __forceinline__ void operator()(const f32x4 (&acc)[2][2][4][2], const Unit& u, int wr, int wc, int fr, int fq) const {
        asm volatile("" : "+v"(fr), "+v"(fq));
        const float* gates = (const float*)((const char*)u.rows + (WS_LGATE - WS_LTOK));
        const int cw = wc * 32 + 8 * fq;
#pragma unroll
        for (int ai = 0; ai < 2; ++ai)
#pragma unroll
            for (int m = 0; m < 4; ++m) { const int r = ai * HALF + wr * 64 + m * 16 + fr;
                if (r < u.nvalid) { const float gt = gates[r]; const unsigned pid = (unsigned)u.rows[r];
                    const f32x4 v0 = silu_mul(acc[ai][0][m][0], acc[ai][1][m][0]) * gt, v1 = silu_mul(acc[ai][0][m][1], acc[ai][1][m][1]) * gt;
                    v4u w; w.x = cvt_pk_bf16(v0[0], v0[1]); w.y = cvt_pk_bf16(v0[2], v0[3]); w.z = cvt_pk_bf16(v1[0], v1[1]); w.w = cvt_pk_bf16(v1[2], v1[3]);
                    (void)pid; *(v4u*)(H + (size_t)(u.aux + r) * EDIM + cw) = w; } }
    }
};
struct EpiSharedGU {
    static constexpr bool PERM = true;
    bf16* HS;
    __device__ __forceinline__ void operator()(const f32x4 (&acc)[2][2][4][2], const Unit& u, int wr, int wc, int fr, int fq) const {
        asm volatile("" : "+v"(fr), "+v"(fq));
        const int row0 = u.pm * BM + wr * 64 + fr, cw = u.pn * HALF + wc * 32 + 8 * fq;
#pragma unroll
        for (int ai = 0; ai < 2; ++ai)
#pragma unroll
            for (int m = 0; m < 4; ++m) {
                const f32x4 v0 = silu_mul(acc[ai][0][m][0], acc[ai][1][m][0]), v1 = silu_mul(acc[ai][0][m][1], acc[ai][1][m][1]);
                v4u w; w.x = cvt_pk_bf16(v0[0], v0[1]); w.y = cvt_pk_bf16(v0[2], v0[3]); w.z = cvt_pk_bf16(v1[0], v1[1]); w.w = cvt_pk_bf16(v1[2], v1[3]);
                *(v4u*)(HS + (size_t)(row0 + ai * HALF + m * 16) * SDIM + cw) = w; }
    }
};
struct EpiDownY {
    static constexpr bool PERM = true;
    bf16* Y;
    __device__ __forceinline__ void operator()(const f32x4 (&acc)[2][2][4][2], const Unit& u, int wr, int wc, int fr, int fq) const {
        asm volatile("" : "+v"(fr), "+v"(fq));
        const int col0 = u.pn * BM + wc * 32 + 8 * fq;
#pragma unroll
        for (int ai = 0; ai < 2; ++ai)
#pragma unroll
            for (int m = 0; m < 4; ++m) { const int r = ai * HALF + wr * 64 + m * 16 + fr; bf16* rowp = Y + (size_t)(u.aux + r) * D + col0;
#pragma unroll
                for (int bj = 0; bj < 2; ++bj) { const f32x4 v0 = acc[ai][bj][m][0], v1 = acc[ai][bj][m][1];
                    v4u w; w.x = cvt_pk_bf16(v0[0], v0[1]); w.y = cvt_pk_bf16(v0[2], v0[3]); w.z = cvt_pk_bf16(v1[0], v1[1]); w.w = cvt_pk_bf16(v1[2], v1[3]);
                    *(v4u*)(rowp + bj * HALF) = w; } }
    }
};
}

struct Args { const float* in[19]; float* out; unsigned char* ws; int ph_lo, ph_hi; };
struct Frame {
    LAS unsigned char* lds; unsigned* ctl; unsigned char* ws;
    int tid, lane, wave, G, bid;
};
enum { IN_X = 0, IN_RELB, IN_PWIN, IN_PWG, IN_PSC, IN_PWOUT, IN_DQKV, IN_DOUT, IN_CWIN, IN_CW, IN_CWOUT, IN_LNG, IN_LNB, IN_RW, IN_RB, IN_EGU, IN_ED, IN_SGU, IN_SD };

#define CAS __attribute__((address_space(4)))
typedef const CAS unsigned char* KP;
__device__ __forceinline__ const float* ain(KP kp, int i) { return (const float*)((const GAS float* const CAS*)kp)[i]; }
__device__ __forceinline__ float* aout(KP kp) { return (float*)((GAS float* const CAS*)kp)[19]; }
__device__ __forceinline__ void tr_item(const float* W, int K, int N, bf16* WT, int dstK, int mode, LAS float* scr, int item, int lane) {
    const int nblk = N / 32, kb = item / nblk, nb = item % nblk, k0 = 64 * kb, n0 = 32 * nb;
    int r0 = n0;
    if (mode == 1) { const int part = n0 / 2048, j = n0 % 2048; r0 = (part == 0) ? 4096 + j : 256 * (j / 128) + (part == 2 ? 128 : 0) + (j % 128); }
    if (mode == 2) { const int part = n0 / 256, j = n0 % 256; r0 = 256 * (j / 128) + 128 * part + (j % 128); }
#pragma unroll 8
    for (int i = 0; i < 32; ++i) { const int kk = 2 * i + (lane >> 5); scr[kk * 33 + (lane & 31)] = __builtin_nontemporal_load(W + (size_t)(k0 + kk) * N + n0 + (lane & 31)); }
    LDS_WAIT(); asm volatile("" ::: "memory");
    const int c = lane & 7;
#pragma unroll
    for (int j = 0; j < 4; ++j) { const int n = (lane >> 3) + 8 * j; const LAS float* s = scr + (8 * c) * 33 + n;
        v4u o; o.x = pk2(s[0 * 33], s[1 * 33]); o.y = pk2(s[2 * 33], s[3 * 33]); o.z = pk2(s[4 * 33], s[5 * 33]); o.w = pk2(s[6 * 33], s[7 * 33]);
        __builtin_nontemporal_store(o, (v4u*)(WT + (size_t)(r0 + n) * dstK + k0 + 8 * c)); }
    LDS_WAIT(); asm volatile("" ::: "memory");
}
__device__ __forceinline__ void phase_prologue(const Frame& F, KP kp) {
    LAS float* scr = (LAS float*)(F.lds + F.wave * 16384);
    const int gw = F.bid * 8 + F.wave, NGW = F.G * 8;
    constexpr int I0 = 2 * 2048, I1 = 8 * 128, I2 = 2 * 2048, I3 = 4608, I4 = 512, I5 = 6144, I6 = 2048, I7 = 4 * 512, I8 = 4 * 256, I9 = 256 * 256, I10 = 256 * 128;
    constexpr int NITEMS = I0 + I1 + I2 + I3 + I4 + I5 + I6 + I7 + I8 + I9 + I10;
    unsigned char* ws = F.ws;
    for (int it = gw; it < NITEMS; it += NGW) {
        int r = it;
        if (r < I0) { const int b = r / 2048; tr_item(ain(kp, IN_PWIN) + (size_t)b * D * D, D, D, (bf16*)(ws + WS_W_POOL_IN) + (size_t)b * D * D, D, 0, scr, r % 2048, F.lane); continue; } r -= I0;
        if (r < I1) { const int b = r / 128; tr_item(ain(kp, IN_PWG) + (size_t)b * 512 * 512, 512, 512, (bf16*)(ws + WS_W_POOL_G) + (size_t)b * 512 * 512, 512, 0, scr, r % 128, F.lane); continue; } r -= I1;
        if (r < I2) { const int b = r / 2048; tr_item(ain(kp, IN_PWOUT) + (size_t)b * D * D, D, D, (bf16*)(ws + WS_W_POOL_OUT) + (size_t)b * D * D, D, 0, scr, r % 2048, F.lane); continue; } r -= I2;
        if (r < I3) { tr_item(ain(kp, IN_DQKV), D, QKVC, (bf16*)(ws + WS_W_DIL_QKV), D, 0, scr, r, F.lane); continue; } r -= I3;
        if (r < I4) { tr_item(ain(kp, IN_DOUT), DILW, D, (bf16*)(ws + WS_W_DIL_OUT), DILW, 0, scr, r, F.lane); continue; } r -= I4;
        if (r < I5) { tr_item(ain(kp, IN_CWIN), D, 3 * D, (bf16*)(ws + WS_W_CONV_IN), D, 1, scr, r, F.lane); continue; } r -= I5;
        if (r < I6) { tr_item(ain(kp, IN_CWOUT), D, D, (bf16*)(ws + WS_W_CONV_OUT), D, 0, scr, r, F.lane); continue; } r -= I6;
        if (r < I7) { const int b = r / 512; tr_item(ain(kp, IN_SGU) + (size_t)b * D * 512, D, 512, (bf16*)(ws + WS_W_SH_GU) + (size_t)b * 512 * D, D, 2, scr, r % 512, F.lane); continue; } r -= I7;
        if (r < I8) { const int b = r / 256; tr_item(ain(kp, IN_SD) + (size_t)b * SDIM * D, SDIM, D, (bf16*)(ws + WS_W_SH_D) + (size_t)b * D * SDIM, SDIM, 0, scr, r % 256, F.lane); continue; } r -= I8;
        if (r < I9) { const int b = r / 256; tr_item(ain(kp, IN_EGU) + (size_t)b * D * 256, D, 256, (bf16*)(ws + WS_W_EX_GU) + (size_t)b * 256 * D, D, 0, scr, r % 256, F.lane); continue; } r -= I9;
        { const int b = r / 128; tr_item(ain(kp, IN_ED) + (size_t)b * EDIM * D, EDIM, D, (bf16*)(ws + WS_W_EX_D) + (size_t)b * D * EDIM, EDIM, 0, scr, r % 128, F.lane); }
    }
    const size_t gt = (size_t)F.bid * 512 + F.tid, GT = (size_t)F.G * 512;
    { const float* rw = ain(kp, IN_RW); bf16* wh = (bf16*)(ws + WS_RWH); bf16* wl = (bf16*)(ws + WS_RWL);
      for (size_t i = gt; i < (size_t)DEPTH * NEXP * D / 8; i += GT) { const size_t k8 = i % (D / 8), e = (i / (D / 8)) % NEXP, l = i / ((size_t)NEXP * D / 8);
          float v[8]; unsigned hi[8], lo[8];
#pragma unroll
          for (int j = 0; j < 8; ++j) { v[j] = rw[(l * D + k8 * 8 + j) * NEXP + e]; hi[j] = f2bf(v[j]); lo[j] = f2bf(v[j] - __builtin_bit_cast(float, hi[j] << 16)); }
          v4u a, b2; a.x = hi[0] | (hi[1] << 16); a.y = hi[2] | (hi[3] << 16); a.z = hi[4] | (hi[5] << 16); a.w = hi[6] | (hi[7] << 16);
          b2.x = lo[0] | (lo[1] << 16); b2.y = lo[2] | (lo[3] << 16); b2.z = lo[4] | (lo[5] << 16); b2.w = lo[6] | (lo[7] << 16);
          *(v4u*)(wh + (l * NEXP + e) * D + k8 * 8) = a; *(v4u*)(wl + (l * NEXP + e) * D + k8 * 8) = b2; } }
    const float* x = ain(kp, IN_X); bf16* xb = (bf16*)(ws + WS_XB);
    for (size_t i = gt; i < (size_t)T * D / 8; i += GT) { const f32x4 p = __builtin_nontemporal_load((const f32x4*)(x + i * 8)), q = __builtin_nontemporal_load((const f32x4*)(x + i * 8 + 4));
        v4u w; w.x = pk2(p[0], p[1]); w.y = pk2(p[2], p[3]); w.z = pk2(q[0], q[1]); w.w = pk2(q[2], q[3]); *(v4u*)(xb + i * 8) = w; }
}

__device__ __forceinline__ void unpack8(const v4u w, float (&f)[8]) { f[0] = bflo(w.x); f[1] = bfhi(w.x); f[2] = bflo(w.y); f[3] = bfhi(w.y); f[4] = bflo(w.z); f[5] = bfhi(w.z); f[6] = bflo(w.w); f[7] = bfhi(w.w); }
__device__ __forceinline__ void phase_pool(const Frame& F, const bf16* U, bf16* PL) {
    for (int it = F.bid * 512 + F.tid; it < (T / 32) * 256; it += F.G * 512) {
        const int cv = it & 255, ch = it >> 8, col = cv * 8, w = 2 << (col >> 9);
        const int row0 = ch * 32, pos0 = row0 & (SEQ - 1);
        float s[8], uu[8];
#pragma unroll
        for (int j = 0; j < 8; ++j) s[j] = 0.f;
        for (int j = 1; j < w; ++j) if (pos0 - j >= 0) { unpack8(*(const v4u*)(U + (size_t)(row0 - j) * D + col), uu);
#pragma unroll
            for (int q = 0; q < 8; ++q) s[q] += uu[q]; }
        for (int r = 0; r < 32; ++r) {
            const int t = row0 + r, pos = pos0 + r;
            unpack8(*(const v4u*)(U + (size_t)t * D + col), uu);
            const float inv = 1.0f / (float)((pos + 1) < w ? (pos + 1) : w);
            float o[8];
#pragma unroll
            for (int q = 0; q < 8; ++q) { s[q] += uu[q]; o[q] = s[q] * inv - uu[q]; }
            v4u ww; ww.x = pk2(o[0], o[1]); ww.y = pk2(o[2], o[3]); ww.z = pk2(o[4], o[5]); ww.w = pk2(o[6], o[7]);
            *(v4u*)(PL + (size_t)t * D + col) = ww;
            if (pos - w + 1 >= 0) { unpack8(*(const v4u*)(U + (size_t)(t - w + 1) * D + col), uu);
#pragma unroll
                for (int q = 0; q < 8; ++q) s[q] -= uu[q]; }
        }
    }
}

__device__ __forceinline__ void phase_conv(const Frame& F, const bf16* UC, const bf16* BGp, const float* cw, bf16* Z) {
    for (int it = F.bid * 512 + F.tid; it < T * 256; it += F.G * 512) {
        const int cv = it & 255, t = it >> 8, col = cv * 8, pos = t & (SEQ - 1);
        float u0[8], u1[8], u2[8], bb[8], o[8];
        unpack8(*(const v4u*)(UC + (size_t)t * D + col), u2);
        if (pos >= 1) unpack8(*(const v4u*)(UC + (size_t)(t - 1) * D + col), u1); else {
#pragma unroll
            for (int q = 0; q < 8; ++q) u1[q] = 0.f; }
        if (pos >= 2) unpack8(*(const v4u*)(UC + (size_t)(t - 2) * D + col), u0); else {
#pragma unroll
            for (int q = 0; q < 8; ++q) u0[q] = 0.f; }
        unpack8(*(const v4u*)(BGp + (size_t)t * D + col), bb);
#pragma unroll
        for (int q = 0; q < 8; ++q) o[q] = bb[q] * (cw[col + q] * u0[q] + cw[D + col + q] * u1[q] + cw[2 * D + col + q] * u2[q]);
        v4u ww; ww.x = pk2(o[0], o[1]); ww.y = pk2(o[2], o[3]); ww.z = pk2(o[4], o[5]); ww.w = pk2(o[6], o[7]);
        *(v4u*)(Z + (size_t)t * D + col) = ww;
    }
}

__device__ __forceinline__ int t5_bucket(int dist) {
    if (dist < 16) return dist;
    int large = 16 + (int)(logf((float)dist / 16.0f) / logf(128.0f) * 16.0f);
    return large < 31 ? large : 31;
}
constexpr int AT_KS = 0, AT_KSTR = 144, AT_VT = 256 * 144, AT_VSTR = 520, AT_BIAS = AT_VT + 64 * 520;
__device__ __forceinline__ void phase_attn(const Frame& F, const bf16* QKV, const float* relb, bf16* OG, float* LSE) {
    LAS unsigned char* lds = F.lds;
    const int tid = F.tid, lane = F.lane, w = tid >> 6, fr = lane & 15, fq = lane >> 4;
    for (int unit = F.bid; unit < NBATCH * 3 * 8 * 16; unit += F.G) {
        const int cmb = unit & 15, h = (unit >> 4) & 7, g = (unit >> 7) % 3, b = unit / 384;
        const int dsh = 2 * g, dil = 1 << dsh, r = cmb & (dil - 1), nb = cmb >> dsh;
        const bf16* base = QKV + (size_t)b * SEQ * QKVC + g * 1536 + h * 64;
        __syncthreads();
        {
            const int key = tid >> 1, half = tid & 1, jk = (nb - 1) * 128 + key;
            v4u kv[4], vv[4];
            if (jk >= 0) { const bf16* rp = base + (size_t)(jk * dil + r) * QKVC + half * 32;
#pragma unroll
                for (int i = 0; i < 4; ++i) { kv[i] = *(const v4u*)(rp + 512 + 8 * i); vv[i] = *(const v4u*)(rp + 1024 + 8 * i); } }
            else {
#pragma unroll
                for (int i = 0; i < 4; ++i) { kv[i] = (v4u){0u, 0u, 0u, 0u}; vv[i] = (v4u){0u, 0u, 0u, 0u}; } }
#pragma unroll
            for (int i = 0; i < 4; ++i) *(LAS v4u*)(lds + AT_KS + key * AT_KSTR + half * 64 + 16 * i) = kv[i];
#pragma unroll
            for (int i = 0; i < 4; ++i) {
                const unsigned ww[4] = {vv[i].x, vv[i].y, vv[i].z, vv[i].w};
#pragma unroll
                for (int q = 0; q < 4; ++q) { const int d = half * 32 + 8 * i + 2 * q;
                    *(LAS unsigned short*)(lds + AT_VT + d * AT_VSTR + key * 2) = (unsigned short)(ww[q] & 0xffffu);
                    *(LAS unsigned short*)(lds + AT_VT + (d + 1) * AT_VSTR + key * 2) = (unsigned short)(ww[q] >> 16); } }
            if (tid <= 128) ((LAS float*)(lds + AT_BIAS))[tid] = relb[t5_bucket(tid * dil) * 24 + g * 8 + h];
        }
        __syncthreads();
        int qi = 16 * w + fr; asm volatile("" : "+v"(qi));
        const int jq = nb * 128 + qi, tq = jq * dil + r;
        const bf16* qp = base + (size_t)tq * QKVC + 8 * fq;
        const bf16x8 q0 = *(const bf16x8*)qp, q1 = *(const bf16x8*)(qp + 32);
        f32x4 s[9]; float mx = -INFINITY;
#pragma unroll
        for (int kt = 0; kt < 9; ++kt) {
            const int kb = 16 * (w + kt);
            const bf16x8 k0 = *(const LAS bf16x8*)(lds + AT_KS + (kb + fr) * AT_KSTR + fq * 16), k1 = *(const LAS bf16x8*)(lds + AT_KS + (kb + fr) * AT_KSTR + 64 + fq * 16);
            f32x4 a = (f32x4){0.f, 0.f, 0.f, 0.f};
            a = __builtin_amdgcn_mfma_f32_16x16x32_bf16(k0, q0, a, 0, 0, 0);
            a = __builtin_amdgcn_mfma_f32_16x16x32_bf16(k1, q1, a, 0, 0, 0);
#pragma unroll
            for (int i = 0; i < 4; ++i) { const int kl = kb + 4 * fq + i, rel = qi + 128 - kl;
                const bool ok = (rel >= 0) && (rel <= 128) && (nb > 0 || kl >= 128);
                const int rc = rel < 0 ? 0 : (rel > 128 ? 128 : rel);
                const float v = ok ? a[i] + ((LAS float*)(lds + AT_BIAS))[rc] : -INFINITY;
                a[i] = v; mx = fmaxf(mx, v); }
            s[kt] = a;
        }
        mx = fmaxf(mx, shfl_x(mx, 16, lane)); mx = fmaxf(mx, shfl_x(mx, 32, lane));
        float l = 0.f;
#pragma unroll
        for (int kt = 0; kt < 9; ++kt)
#pragma unroll
            for (int i = 0; i < 4; ++i) { const float p = __expf(s[kt][i] - mx); s[kt][i] = p; l += p; }
        l += shfl_x(l, 16, lane); l += shfl_x(l, 32, lane);
        f32x4 o[4];
#pragma unroll
        for (int nt = 0; nt < 4; ++nt) o[nt] = (f32x4){0.f, 0.f, 0.f, 0.f};
#pragma unroll
        for (int st = 0; st < 5; ++st) {
            const int kt0 = 2 * st, kt1 = 2 * st + 1;
            v4u pw; pw.x = pk2(s[kt0][0], s[kt0][1]); pw.y = pk2(s[kt0][2], s[kt0][3]);
            if (kt1 < 9) { pw.z = pk2(s[kt1 < 9 ? kt1 : 0][0], s[kt1 < 9 ? kt1 : 0][1]); pw.w = pk2(s[kt1 < 9 ? kt1 : 0][2], s[kt1 < 9 ? kt1 : 0][3]); } else { pw.z = 0u; pw.w = 0u; }
            const bf16x8 pf = __builtin_bit_cast(bf16x8, pw);
            const int kb0 = 16 * (w + kt0) + 4 * fq, kb1 = 16 * (w + kt1) + 4 * fq;
#pragma unroll
            for (int nt = 0; nt < 4; ++nt) { const int d = 16 * nt + fr;
                v2u va = *(const LAS v2u*)(lds + AT_VT + d * AT_VSTR + kb0 * 2), vb = (v2u){0u, 0u};
                if (kt1 < 9) vb = *(const LAS v2u*)(lds + AT_VT + d * AT_VSTR + kb1 * 2);
                v4u vw; vw.x = va.x; vw.y = va.y; vw.z = vb.x; vw.w = vb.y;
                o[nt] = __builtin_amdgcn_mfma_f32_16x16x32_bf16(__builtin_bit_cast(bf16x8, vw), pf, o[nt], 0, 0, 0); }
        }
        const float il = 1.0f / l;
        bf16* op = OG + ((size_t)g * T + (size_t)b * SEQ + tq) * DILW + h * 64 + 4 * fq;
#pragma unroll
        for (int nt = 0; nt < 4; ++nt) { v2u ww; ww.x = pk2(o[nt][0] * il, o[nt][1] * il); ww.y = pk2(o[nt][2] * il, o[nt][3] * il); *(v2u*)(op + 16 * nt) = ww; }
        if (fq == 0) LSE[((size_t)g * T + (size_t)b * SEQ + tq) * 8 + h] = mx + logf(l);
    }
}
__device__ __forceinline__ void phase_combine(const Frame& F, const bf16* OG, const float* LSE, bf16* O) {
    for (int it = F.bid * 512 + F.tid; it < T * 64; it += F.G * 512) {
        const int c8 = it & 7, h = (it >> 3) & 7, t = it >> 6;
        const float l0 = LSE[((size_t)0 * T + t) * 8 + h], l1 = LSE[((size_t)1 * T + t) * 8 + h], l2 = LSE[((size_t)2 * T + t) * 8 + h];
        const float m = fmaxf(l0, fmaxf(l1, l2)); float w0 = __expf(l0 - m), w1 = __expf(l1 - m), w2 = __expf(l2 - m); const float inv = 1.0f / (w0 + w1 + w2); w0 *= inv; w1 *= inv; w2 *= inv;
        float a[8], bq[8], c[8], o[8]; const size_t off = (size_t)t * DILW + h * 64 + c8 * 8;
        unpack8(*(const v4u*)(OG + off), a); unpack8(*(const v4u*)(OG + (size_t)T * DILW + off), bq); unpack8(*(const v4u*)(OG + (size_t)2 * T * DILW + off), c);
#pragma unroll
        for (int q = 0; q < 8; ++q) o[q] = w0 * a[q] + w1 * bq[q] + w2 * c[q];
        v4u ww; ww.x = pk2(o[0], o[1]); ww.y = pk2(o[2], o[3]); ww.z = pk2(o[4], o[5]); ww.w = pk2(o[6], o[7]);
        *(v4u*)(O + off) = ww;
    }
}

constexpr int M1_LOG = 131072, M1_STAT = M1_LOG + 4096, M1_HIST = M1_STAT + 128, M1_BASE = M1_HIST + 256;
__device__ __forceinline__ void phase_moe1(const Frame& F, const float* Y, const float* gain, const float* bias, const float* RW, const float* RB,
                                           float* X1F, bf16* X1B, unsigned* cnt, int* ltok, float* lgate, int* eidx, int* inv) {
    LAS float* xs = (LAS float*)F.lds; LAS float* logit = (LAS float*)(F.lds + M1_LOG); LAS float* stat = (LAS float*)(F.lds + M1_STAT);
    LAS int* hist = (LAS int*)(F.lds + M1_HIST); LAS int* basep = (LAS int*)(F.lds + M1_BASE);
    const int tid = F.tid, lane = F.lane, w = F.wave;
    for (int rg = F.bid; rg < T / 16; rg += F.G) {
        const int row0 = rg * 16;
        __syncthreads();
#pragma unroll
        for (int j = 0; j < 16; ++j) { const int idx = tid + 512 * j; *(LAS f32x4*)(xs + idx * 4) = *(const f32x4*)(Y + (size_t)row0 * D + (size_t)idx * 4); }
        if (tid < 64) hist[tid] = 0;
        __syncthreads();
#pragma unroll
        for (int rr = 0; rr < 2; ++rr) { const int r = 2 * w + rr; float sm = 0.f;
#pragma unroll
            for (int j = 0; j < 32; ++j) sm += xs[r * D + lane + 64 * j];
            const float mean = wave_sum(sm, lane) * (1.0f / D); float sq = 0.f;
#pragma unroll
            for (int j = 0; j < 32; ++j) { const float d = xs[r * D + lane + 64 * j] - mean; sq += d * d; }
            const float rstd = 1.0f / sqrtf(wave_sum(sq, lane) * (1.0f / D) + LN_EPS);
            if (lane == 0) { stat[2 * r] = mean; stat[2 * r + 1] = rstd; } }
        __syncthreads();
#pragma unroll
        for (int j = 0; j < 16; ++j) { const int idx = tid + 512 * j, r = idx >> 9, c4 = (idx & 511) * 4;
            const f32x4 v = *(LAS f32x4*)(xs + idx * 4), gv = *(const f32x4*)(gain + c4), bv = *(const f32x4*)(bias + c4);
            const float mean = stat[2 * r], rstd = stat[2 * r + 1];
            const f32x4 o = (v - mean) * rstd * gv + bv;
            *(LAS f32x4*)(xs + idx * 4) = o;
            *(f32x4*)(X1F + (size_t)(row0 + r) * D + c4) = o;
            v2u wb; wb.x = pk2(o[0], o[1]); wb.y = pk2(o[2], o[3]); *(v2u*)(X1B + (size_t)(row0 + r) * D + c4) = wb; }
        __syncthreads();
        { const int r = tid >> 5, ep = tid & 31; float a0 = 0.f, a1 = 0.f; const float* wp = RW + 2 * ep; const LAS float* xr = xs + r * D;
            for (int k0 = 0; k0 < D; k0 += 16) {
                f32x2 wv[16];
#pragma unroll
                for (int j = 0; j < 16; ++j) wv[j] = *(const f32x2*)(wp + (size_t)(k0 + j) * NEXP);
                asm volatile("" : "+v"(wv[0]), "+v"(wv[1]), "+v"(wv[2]), "+v"(wv[3]), "+v"(wv[4]), "+v"(wv[5]), "+v"(wv[6]), "+v"(wv[7]));
                asm volatile("" : "+v"(wv[8]), "+v"(wv[9]), "+v"(wv[10]), "+v"(wv[11]), "+v"(wv[12]), "+v"(wv[13]), "+v"(wv[14]), "+v"(wv[15]));
#pragma unroll
                for (int j = 0; j < 16; ++j) { const float xv = xr[k0 + j]; a0 += xv * wv[j].x; a1 += xv * wv[j].y; } }
            logit[r * NEXP + 2 * ep] = a0; logit[r * NEXP + 2 * ep + 1] = a1; }
        __syncthreads();
        int sel_pos[2]; float sel_gate[2]; int sel_rank[2]; bool sel_on[2];
#pragma unroll
        for (int rr = 0; rr < 2; ++rr) { const int r = 2 * w + rr;
            const float sc = 1.0f / (1.0f + __expf(-logit[r * NEXP + lane])); const float ch = sc + RB[lane];
            int rk = 0;
#pragma unroll
            for (int j = 0; j < 8; ++j) { const float cj = shfl_from(ch, (lane & ~7) + j); rk += (cj > ch || (cj == ch && j < (lane & 7))) ? 1 : 0; }
            float gs = rk < 2 ? ch : 0.f; gs += shfl_x(gs, 1, lane); gs += shfl_x(gs, 2, lane); gs += shfl_x(gs, 4, lane);
            int grk = 0; const int g = lane >> 3;
#pragma unroll
            for (int hh = 0; hh < 8; ++hh) { const float gh = shfl_from(gs, 8 * hh); grk += (gh > gs || (gh == gs && hh < g)) ? 1 : 0; }
            const float msk = grk < 4 ? ch : -INFINITY;
            int erk = 0;
            for (int j = 0; j < 64; ++j) { const float mj = __builtin_bit_cast(float, __builtin_amdgcn_readlane(__builtin_bit_cast(int, msk), j)); erk += (mj > msk || (mj == msk && j < lane)) ? 1 : 0; }
            const bool on = erk < 8;
            const float ssum = wave_sum(on ? sc : 0.f, lane);
            sel_on[rr] = on; sel_rank[rr] = erk; sel_gate[rr] = sc / ssum * 2.5f; sel_pos[rr] = 0;
            if (on) sel_pos[rr] = __hip_atomic_fetch_add(&hist[lane], 1, __ATOMIC_RELAXED, __HIP_MEMORY_SCOPE_WORKGROUP); }
        __syncthreads();
        if (tid < 64) { const int hc = hist[tid]; int bs = 0; if (hc > 0) bs = (int)atomicAdd(&cnt[tid * 16], (unsigned)hc); basep[tid] = bs; }
        __syncthreads();
#pragma unroll
        for (int rr = 0; rr < 2; ++rr) if (sel_on[rr]) { const int t = row0 + 2 * w + rr, pos = basep[lane] + sel_pos[rr];
            ltok[(size_t)lane * CAP + pos] = t; lgate[(size_t)lane * CAP + pos] = sel_gate[rr];
            eidx[t * 8 + sel_rank[rr]] = lane; inv[t * 8 + sel_rank[rr]] = pos; }
    }
}
__device__ __forceinline__ int build_tiles(const Frame& F, const unsigned* cnt) {
    LAS int* tpref = (LAS int*)(F.lds + LDS_TAB); LAS int* cl = (LAS int*)(F.lds + LDS_TAB + 512);
    __syncthreads();
    if (F.tid < 64) cl[F.tid] = (int)__hip_atomic_load(&cnt[F.tid * 16], __ATOMIC_RELAXED, __HIP_MEMORY_SCOPE_AGENT);
    __syncthreads();
    if (F.tid == 0) { int acc = 0; for (int e = 0; e < 64; ++e) { tpref[e] = acc; acc += (cl[e] + 255) >> 8; } tpref[64] = acc; tpref[65] = acc + T / 256; tpref[66] = acc + 2 * (T / 256); cl[64] = T; cl[65] = T; }
    __syncthreads();
    return __builtin_amdgcn_readfirstlane(tpref[64]);
}
__device__ __forceinline__ void phase_moe4(const Frame& F, const float* Y2, const bf16* Yr, const int* eidx, const int* inv, const float* gain, const float* bias, float* XO, bf16* XBo) {
    const LAS int* tpref = (const LAS int*)(F.lds + LDS_TAB);
    const int gw = F.bid * 8 + F.wave, NGW = F.G * 8, lane = F.lane;
    for (int t = gw; t < T; t += NGW) {
        f32x4 v[8];
#pragma unroll
        for (int j = 0; j < 8; ++j) v[j] = *(const f32x4*)(Y2 + (size_t)t * D + 4 * lane + 256 * j);
        for (int k = 0; k < 8; ++k) { const int e = eidx[t * 8 + k], pos = inv[t * 8 + k]; const bf16* yr = Yr + (size_t)(tpref[e] * 256 + pos) * D + 4 * lane;
#pragma unroll
            for (int j = 0; j < 8; ++j) { const v2u w = *(const v2u*)(yr + 256 * j); v[j][0] += bflo(w.x); v[j][1] += bfhi(w.x); v[j][2] += bflo(w.y); v[j][3] += bfhi(w.y); } }
        float sm = 0.f;
#pragma unroll
        for (int j = 0; j < 8; ++j) sm += (v[j][0] + v[j][1]) + (v[j][2] + v[j][3]);
        const float mean = wave_sum(sm, lane) * (1.0f / D); float sq = 0.f;
#pragma unroll
        for (int j = 0; j < 8; ++j) { v[j] = v[j] - mean; sq += (v[j][0] * v[j][0] + v[j][1] * v[j][1]) + (v[j][2] * v[j][2] + v[j][3] * v[j][3]); }
        const float rstd = 1.0f / sqrtf(wave_sum(sq, lane) * (1.0f / D) + LN_EPS);
#pragma unroll
        for (int j = 0; j < 8; ++j) { const int c = 4 * lane + 256 * j; const f32x4 o = v[j] * rstd * *(const f32x4*)(gain + c) + *(const f32x4*)(bias + c);
            *(f32x4*)(XO + (size_t)t * D + c) = o;
            v2u wb; wb.x = pk2(o[0], o[1]); wb.y = pk2(o[2], o[3]); *(v2u*)(XBo + (size_t)t * D + c) = wb; }
    }
}


template <int CTRL> __device__ __forceinline__ float dppf(float x) { return __builtin_bit_cast(float, __builtin_amdgcn_update_dpp(0, __builtin_bit_cast(int, x), CTRL, 0xF, 0xF, false)); }
__device__ __forceinline__ float gmax8(float x) { x = fmaxf(x, dppf<0xB1>(x)); x = fmaxf(x, dppf<0x4E>(x)); x = fmaxf(x, dppf<0x141>(x)); return x; }
__device__ __forceinline__ float gsum8(float x) { x += dppf<0xB1>(x); x += dppf<0x4E>(x); x += dppf<0x141>(x); return x; }
__device__ __forceinline__ float rl_f(float x, int l) { return __builtin_bit_cast(float, __builtin_amdgcn_readlane(__builtin_bit_cast(int, x), l)); }
constexpr int M1_P = 0, M1N_HIST = 131072, M1N_BASE = 131072 + 256, M1N_GB = 131072 + 1024;
__device__ __forceinline__ void phase_moe1n(const Frame& F, const bf16* Y, const float* pst, const float* gain, const float* bias, const bf16* WH, const bf16* WL, const float* RB,
                                            bf16* X1B, float* ST1, unsigned* cnt, int* ltok, float* lgate, int* eidx, int* inv) {
    LAS float* P = (LAS float*)(F.lds + M1_P); LAS int* hist = (LAS int*)(F.lds + M1N_HIST); LAS int* basep = (LAS int*)(F.lds + M1N_BASE);
    const int tid = F.tid, lane = F.lane, w = F.wave, r = lane & 15, q = lane >> 4;
    for (int item = F.bid; item < T / 64; item += F.G) {
        const int row0 = item * 64;
        __syncthreads();
        if (tid < 64) hist[tid] = 0;
        { LAS f32x4* gb = (LAS f32x4*)(F.lds + M1N_GB); gb[tid] = *(const f32x4*)(gain + 4 * tid); gb[512 + tid] = *(const f32x4*)(bias + 4 * tid); }
        __syncthreads();
        float mean[4], rstd[4];
#pragma unroll
        for (int rt = 0; rt < 4; ++rt) { const int row = row0 + 16 * rt + r;
          const f32x4* pp = (const f32x4*)(pst + ((size_t)row * 32 + q * 8) * 2); const f32x4 a = pp[0], b = pp[1], c = pp[2], d = pp[3];
          float sm = (a[0] + a[2]) + (b[0] + b[2]) + (c[0] + c[2]) + (d[0] + d[2]), sq = (a[1] + a[3]) + (b[1] + b[3]) + (c[1] + c[3]) + (d[1] + d[3]);
          sm += shfl_x(sm, 16, lane); sm += shfl_x(sm, 32, lane); sq += shfl_x(sq, 16, lane); sq += shfl_x(sq, 32, lane);
          mean[rt] = sm * (1.0f / D); const float var = fmaxf(sq * (1.0f / D) - mean[rt] * mean[rt], 0.f); rstd[rt] = 1.0f / sqrtf(var + LN_EPS);
          if (w == 0 && q == 0) *(f32x2*)(ST1 + 2 * row) = (f32x2){mean[rt], rstd[rt]}; }
        const int kb = 256 * w + 8 * q;
        const LAS float* gl = (const LAS float*)(F.lds + M1N_GB) + kb;
        f32x4 acc[4][4];
#pragma unroll
        for (int rt = 0; rt < 4; ++rt)
#pragma unroll
            for (int nt = 0; nt < 4; ++nt) acc[rt][nt] = (f32x4){0.f, 0.f, 0.f, 0.f};
        v4u yb[3][4]; bf16x8 wh[4], wl[4];
        unsigned vo[4];
#pragma unroll
        for (int i = 0; i < 4; ++i) { vo[i] = (unsigned)(r * D + kb) * 2u + (unsigned)i * (16u * D * 2u); asm volatile("" : "+v"(vo[i])); }
        const char* ybase = (const char*)(Y + (size_t)row0 * D); char* xbase = (char*)(X1B + (size_t)row0 * D);
#define M1_LOADY(st) do { _Pragma("unroll") for (int rt = 0; rt < 4; ++rt) yb[(st) % 3][rt] = __builtin_nontemporal_load((const v4u*)(ybase + vo[rt] + 64 * (st))); } while (0)
#define M1_LOADW(st) do { _Pragma("unroll") for (int nt = 0; nt < 4; ++nt) { wh[nt] = *(const bf16x8*)((const char*)WH + vo[nt] + 64 * (st)); wl[nt] = *(const bf16x8*)((const char*)WL + vo[nt] + 64 * (st)); } } while (0)
        M1_LOADY(0); M1_LOADW(0); M1_LOADY(1);
        __builtin_amdgcn_sched_barrier(0);
#pragma unroll
        for (int st = 0; st < 8; ++st) {
            const f32x4 g0 = *(const LAS f32x4*)(gl + 32 * st), g1 = *(const LAS f32x4*)(gl + 32 * st + 4), b0 = *(const LAS f32x4*)(gl + 2048 + 32 * st), b1 = *(const LAS f32x4*)(gl + 2048 + 32 * st + 4);
#pragma unroll
            for (int rt = 0; rt < 4; ++rt) { const v4u yv = yb[st % 3][rt];
                const f32x4 y0_ = (f32x4){bflo(yv.x), bfhi(yv.x), bflo(yv.y), bfhi(yv.y)}, y1_ = (f32x4){bflo(yv.z), bfhi(yv.z), bflo(yv.w), bfhi(yv.w)};
                const f32x4 x0 = (y0_ - mean[rt]) * rstd[rt] * g0 + b0, x1 = (y1_ - mean[rt]) * rstd[rt] * g1 + b1;
                v4u h; h.x = cvt_pk_bf16(x0[0], x0[1]); h.y = cvt_pk_bf16(x0[2], x0[3]); h.z = cvt_pk_bf16(x1[0], x1[1]); h.w = cvt_pk_bf16(x1[2], x1[3]);
                *(v4u*)(xbase + vo[rt] + 64 * st) = h;
                v4u l; l.x = cvt_pk_bf16(x0[0] - bflo(h.x), x0[1] - bfhi(h.x)); l.y = cvt_pk_bf16(x0[2] - bflo(h.y), x0[3] - bfhi(h.y));
                l.z = cvt_pk_bf16(x1[0] - bflo(h.z), x1[1] - bfhi(h.z)); l.w = cvt_pk_bf16(x1[2] - bflo(h.w), x1[3] - bfhi(h.w));
                const bf16x8 xh = __builtin_bit_cast(bf16x8, h), xl = __builtin_bit_cast(bf16x8, l);
#pragma unroll
                for (int nt = 0; nt < 4; ++nt) { acc[rt][nt] = __builtin_amdgcn_mfma_f32_16x16x32_bf16(xh, wh[nt], acc[rt][nt], 0, 0, 0);
                    acc[rt][nt] = __builtin_amdgcn_mfma_f32_16x16x32_bf16(xl, wh[nt], acc[rt][nt], 0, 0, 0); acc[rt][nt] = __builtin_amdgcn_mfma_f32_16x16x32_bf16(xh, wl[nt], acc[rt][nt], 0, 0, 0); } }
            __builtin_amdgcn_sched_barrier(0);
            if (st + 1 < 8) M1_LOADW(st + 1);
            if (st + 2 < 8) M1_LOADY(st + 2);
            __builtin_amdgcn_sched_barrier(0);
        }
#undef M1_LOADY
#undef M1_LOADW
#pragma unroll
        for (int rt = 0; rt < 4; ++rt)
#pragma unroll
            for (int nt = 0; nt < 4; ++nt)
#pragma unroll
                for (int i = 0; i < 4; ++i) P[(w * 64 + 16 * rt + 4 * q + i) * 64 + 16 * nt + r] = acc[rt][nt][i];
        __syncthreads();
        const float rb = RB[lane];
        LAS int* Pi = (LAS int*)P;
#pragma unroll 1
        for (int rr = 0; rr < 8; ++rr) { const int rl = 8 * w + rr;
            float lg = ((P[rl * 64 + lane] + P[(64 + rl) * 64 + lane]) + (P[(128 + rl) * 64 + lane] + P[(192 + rl) * 64 + lane])) + ((P[(256 + rl) * 64 + lane] + P[(320 + rl) * 64 + lane]) + (P[(384 + rl) * 64 + lane] + P[(448 + rl) * 64 + lane]));
            lg = (lg == lg) ? lg : -1.0e30f;
            const float sc = 1.0f / (1.0f + __expf(-lg)); const float ch = sc + rb;
            const float m1 = gmax8(ch), neq = gsum8(ch == m1 ? 1.f : 0.f), m2c = gmax8(ch < m1 ? ch : -INFINITY);
            const float gs = m1 + (neq >= 2.f ? m1 : m2c);
            int grk = 0; const int g = lane >> 3;
#pragma unroll
            for (int hh = 0; hh < 8; ++hh) { const float gh = rl_f(gs, 8 * hh); grk += (gh > gs || (gh == gs && hh < g)) ? 1 : 0; }
            const float msk = grk < 4 ? ch : -INFINITY;
            float cur = msk, ssum = 0.f; int erk = 64;
#pragma unroll 1
            for (int k = 0; k < 8; ++k) {
                float rm = gmax8(cur); rm = fmaxf(rm, dppf<0x140>(rm));
                const float wm = fmaxf(fmaxf(rl_f(rm, 0), rl_f(rm, 16)), fmaxf(rl_f(rm, 32), rl_f(rm, 48)));
                const unsigned long long bal = __builtin_amdgcn_ballot_w64(cur == wm);
                const int lsel = __builtin_amdgcn_readfirstlane((int)__builtin_ctzll(bal));
                ssum += rl_f(sc, lsel);
                const bool me = lane == lsel; erk = me ? k : erk; cur = me ? -INFINITY : cur; }
            const bool on = erk < 8;
            int pk_ = -1; if (on) pk_ = __hip_atomic_fetch_add(&hist[lane], 1, __ATOMIC_RELAXED, __HIP_MEMORY_SCOPE_WORKGROUP) | (erk << 16);
            P[rl * 64 + lane] = sc / ssum * 2.5f; Pi[(64 + rl) * 64 + lane] = pk_; }
        __syncthreads();
        if (tid < 64) { int tt = tid; asm volatile("" : "+v"(tt));
            const int hc = hist[tt]; int bs = 0; if (hc > 0) bs = (int)atomicAdd(&cnt[tt * 16], (unsigned)hc); basep[tt] = bs; }
        __syncthreads();
        { const int bl = basep[lane];
#pragma unroll 1
          for (int rr = 0; rr < 8; ++rr) { const int rl = 8 * w + rr; const int pk_ = Pi[(64 + rl) * 64 + lane]; const float gt_ = P[rl * 64 + lane];
            if (pk_ >= 0) { const int t = row0 + rl, pos = bl + (pk_ & 0xffff), rk_ = pk_ >> 16;
                ltok[(size_t)lane * CAP + pos] = t * 8 + rk_; lgate[(size_t)lane * CAP + pos] = gt_;
                eidx[t * 8 + rk_] = lane; inv[t * 8 + rk_] = pos; } } }
    }
}

constexpr int M3_PL = 131072, M3_CNT = 147456, M3_OFF = 147456 + 272;
__device__ __forceinline__ void phase_moe3n(const Frame& F, const bf16* H, const bf16* HSp, const int* eidx, const bf16* WD, const bf16* WSD,
                                            const float* Y1, const float* ST1, const float* g1, const float* b1, float* Y2, float* PST2) {
    LAS int* out = (LAS int*)F.lds; LAS unsigned short* plist = (LAS unsigned short*)(F.lds + M3_PL); LAS int* cnt = (LAS int*)(F.lds + M3_CNT); LAS int* off = (LAS int*)(F.lds + M3_OFF);
    const int tid = F.tid, lane = F.lane, w = F.wave, r = lane & 15, q = lane >> 4;
    for (int u = F.bid; u < 1024; u += F.G) {
        int nc = (u & 7) | ((u >> 7) << 3), tb = (u >> 3) & 15;
        if (F.G == 256) { const int i = u >> 8, x = u & 7, j = (u >> 3) & 31; tb = 2 * x + (i >> 1); nc = 32 * (i & 1) + j; }
        __syncthreads();
#pragma unroll
        for (int j = 0; j < 16; ++j) ((LAS v4u*)out)[tid + 512 * j] = (v4u){0u, 0u, 0u, 0u};
        if (tid < 66) cnt[tid] = 0;
        __syncthreads();
        int ee[16], pp[16];
        { const v4u* ep = (const v4u*)(eidx + ((size_t)tb * 1024 + 2 * tid) * 8); const v4u e0 = ep[0], e1 = ep[1], e2 = ep[2], e3 = ep[3];
          ee[0] = e0.x; ee[1] = e0.y; ee[2] = e0.z; ee[3] = e0.w; ee[4] = e1.x; ee[5] = e1.y; ee[6] = e1.z; ee[7] = e1.w;
          ee[8] = e2.x; ee[9] = e2.y; ee[10] = e2.z; ee[11] = e2.w; ee[12] = e3.x; ee[13] = e3.y; ee[14] = e3.z; ee[15] = e3.w; }
#pragma unroll
        for (int j = 0; j < 16; ++j) pp[j] = __hip_atomic_fetch_add(&cnt[ee[j]], 1, __ATOMIC_RELAXED, __HIP_MEMORY_SCOPE_WORKGROUP);
        __syncthreads();
        if (w == 0) { int c = cnt[lane], x = c;
#pragma unroll
            for (int o = 1; o < 64; o <<= 1) { const int y = __builtin_amdgcn_ds_bpermute(((lane - o) & 63) << 2, x); if (lane >= o) x += y; }
            off[lane] = x - c; if (lane == 63) off[64] = x; }
        __syncthreads();
#pragma unroll
        for (int j = 0; j < 16; ++j) plist[off[ee[j]] + pp[j]] = (unsigned short)(tid * 16 + j);
        __syncthreads();
        const char* Hb = (const char*)H + (size_t)tb * 8192 * 256 + q * 16;
        const char* HSb = (const char*)HSp + (size_t)tb * 1024 * 512 + q * 16;
        const char* Bb = (const char*)WD + ((size_t)nc * 32 + r) * 256 + q * 16;
        const char* BSb = (const char*)WSD + ((size_t)nc * 32 + r) * 512 + q * 16;
#define M3_NR(sg) ((sg) < 8 ? __builtin_amdgcn_readfirstlane(cnt[w + 8 * (sg)]) : 128)
#define M3_RB(sg) ((sg) < 8 ? __builtin_amdgcn_readfirstlane(off[w + 8 * (sg)]) : 0)
#define M3_GLD(dst, ptr, OFF) asm volatile("global_load_dwordx4 %0, %1, off offset:" #OFF : "=&v"(dst) : "v"(ptr) : "memory")
#define M3_LOADB(dst, sg) do { const char* _b0 = (sg) < 8 ? Bb + (size_t)(w + 8 * (sg)) * 524288 : BSb + ((sg) - 8) * 256; const char* _b1 = _b0 + ((sg) < 8 ? 4096 : 8192); \
            M3_GLD(dst[0][0], _b0, 0); M3_GLD(dst[0][1], _b0, 64); M3_GLD(dst[0][2], _b0, 128); M3_GLD(dst[0][3], _b0, 192); \
            M3_GLD(dst[1][0], _b1, 0); M3_GLD(dst[1][1], _b1, 64); M3_GLD(dst[1][2], _b1, 128); M3_GLD(dst[1][3], _b1, 192); } while (0)
#define M3_LOADA(dst, sg, bb, nr, rbs) do { int _i = 16 * (bb) + r; _i = _i < (nr) ? _i : (nr) - 1; const unsigned _rid = plist[(rbs) + _i]; \
            const char* _a = (sg) < 8 ? Hb + (size_t)_rid * 256 : ((sg) < 10 ? HSb + (size_t)(128 * w + _i) * 512 + ((sg) - 8) * 256 : Hb); \
            M3_GLD(dst[0], _a, 0); M3_GLD(dst[1], _a, 64); M3_GLD(dst[2], _a, 128); M3_GLD(dst[3], _a, 192); } while (0)
#define M3_ADV(sg, bb, nr, rbs) do { if ((sg) < 10) { ++(bb); if ((bb) * 16 >= (nr)) { (bb) = 0; do { ++(sg); } while ((sg) < 8 && M3_NR(sg) == 0); if ((sg) < 10) { (nr) = M3_NR(sg); (rbs) = M3_RB(sg); } } } } while (0)
#define M3_WAITA(AS) asm volatile("s_waitcnt vmcnt(12)" : "+v"(AS[0]), "+v"(AS[1]), "+v"(AS[2]), "+v"(AS[3]) :: "memory")
#define M3_WAITB(N) asm volatile("s_waitcnt vmcnt(" #N ")" : "+v"(Bn[0][0]), "+v"(Bn[0][1]), "+v"(Bn[0][2]), "+v"(Bn[0][3]), "+v"(Bn[1][0]), "+v"(Bn[1][1]), "+v"(Bn[1][2]), "+v"(Bn[1][3]) :: "memory")
#define M3_STEP(AS) if (cseg < 10) { \
              \
            int tk[4]; bool ok[4]; unsigned pl[4]; const int rt_ = cseg < 8; \
            _Pragma("unroll") for (int i = 0; i < 4; ++i) { const int idx = 16 * cbt + 4 * q + i; ok[i] = idx < cnr; const int ic = ok[i] ? idx : cnr - 1; pl[i] = plist[crbs + ic]; tk[i] = 128 * w + ic; } \
            _Pragma("unroll") for (int i = 0; i < 4; ++i) tk[i] = rt_ ? (int)(pl[i] >> 3) : tk[i]; \
            M3_WAITA(AS); \
            f32x4 acc[2]; \
            _Pragma("unroll") for (int nt = 0; nt < 2; ++nt) { acc[nt] = (f32x4){0.f, 0.f, 0.f, 0.f}; \
                _Pragma("unroll") for (int kk = 0; kk < 4; ++kk) acc[nt] = __builtin_amdgcn_mfma_f32_16x16x32_bf16(__builtin_bit_cast(bf16x8, AS[kk]), __builtin_bit_cast(bf16x8, Bc[nt][kk]), acc[nt], 0, 0, 0); } \
              \
            _Pragma("unroll") for (int i = 0; i < 4; ++i) { const long long lo_ = ok[i] ? (long long)__float2int_rn(acc[0][i] * 4194304.0f) : 0ll, hi_ = ok[i] ? (long long)__float2int_rn(acc[1][i] * 4194304.0f) : 0ll; \
                (void)__hip_atomic_fetch_add((LAS unsigned long long*)out + tk[i] * 16 + r, (unsigned long long)((hi_ << 32) + lo_), __ATOMIC_RELAXED, __HIP_MEMORY_SCOPE_WORKGROUP); } \
            M3_LOADA(AS, pseg, pbt, pnr, prbs); M3_ADV(pseg, pbt, pnr, prbs); \
            { const int old_ = cseg, nbat_ = (cnr + 15) >> 4; M3_ADV(cseg, cbt, cnr, crbs); \
              if (cseg != old_ && cseg < 10) { \
                  if (nbat_ == 1) M3_WAITB(4); else if (nbat_ == 2) M3_WAITB(8); else if (nbat_ == 3) M3_WAITB(12); else M3_WAITB(16); \
                  _Pragma("unroll") for (int nt = 0; nt < 2; ++nt) _Pragma("unroll") for (int kk = 0; kk < 4; ++kk) Bc[nt][kk] = Bn[nt][kk]; \
                  int nb_ = cseg; do { ++nb_; } while (nb_ < 8 && M3_NR(nb_) == 0); if (nb_ >= 10) nb_ = 9; M3_LOADB(Bn, nb_); } } }
        int cseg = -1, cbt = 0, cnr = 0, crbs = 0;
        do { ++cseg; } while (cseg < 8 && M3_NR(cseg) == 0);
        cnr = M3_NR(cseg); crbs = M3_RB(cseg);
        int pseg = cseg, pbt = 0, pnr = cnr, prbs = crbs;
        v4u Bc[2][4], Bn[2][4], A0[4], A1[4], A2[4], A3[4];
        M3_LOADB(Bc, cseg);
        M3_LOADA(A0, pseg, pbt, pnr, prbs); M3_ADV(pseg, pbt, pnr, prbs);
        M3_LOADA(A1, pseg, pbt, pnr, prbs); M3_ADV(pseg, pbt, pnr, prbs);
        M3_LOADA(A2, pseg, pbt, pnr, prbs); M3_ADV(pseg, pbt, pnr, prbs);
        M3_LOADA(A3, pseg, pbt, pnr, prbs); M3_ADV(pseg, pbt, pnr, prbs);
        { int nb_ = cseg; do { ++nb_; } while (nb_ < 8 && M3_NR(nb_) == 0); if (nb_ >= 10) nb_ = 9; M3_LOADB(Bn, nb_); }
        asm volatile("s_waitcnt vmcnt(0)" : "+v"(Bc[0][0]), "+v"(Bc[0][1]), "+v"(Bc[0][2]), "+v"(Bc[0][3]), "+v"(Bc[1][0]), "+v"(Bc[1][1]), "+v"(Bc[1][2]), "+v"(Bc[1][3]) :: "memory");
#pragma unroll 1
        while (cseg < 10) { M3_STEP(A0) M3_STEP(A1) M3_STEP(A2) M3_STEP(A3) }
        asm volatile("s_waitcnt vmcnt(0)" : "+v"(A0[0]), "+v"(A0[1]), "+v"(A0[2]), "+v"(A0[3]), "+v"(A1[0]), "+v"(A1[1]), "+v"(A1[2]), "+v"(A1[3]), "+v"(A2[0]), "+v"(A2[1]), "+v"(A2[2]), "+v"(A2[3]),
                     "+v"(A3[0]), "+v"(A3[1]), "+v"(A3[2]), "+v"(A3[3]), "+v"(Bn[0][0]), "+v"(Bn[0][1]), "+v"(Bn[0][2]), "+v"(Bn[0][3]), "+v"(Bn[1][0]), "+v"(Bn[1][1]), "+v"(Bn[1][2]), "+v"(Bn[1][3]) :: "memory");
#undef M3_NR
#undef M3_RB
#undef M3_GLD
#undef M3_LOADB
#undef M3_LOADA
#undef M3_ADV
#undef M3_WAITA
#undef M3_WAITB
#undef M3_STEP
        __syncthreads();
        { const int c4 = lane & 7, rs = lane >> 3, col = nc * 32 + 4 * c4;
          const f32x4 gv = *(const f32x4*)(g1 + col), bv = *(const f32x4*)(b1 + col);
#pragma unroll 4
          for (int it = 0; it < 16; ++it) { const int rl = 128 * w + 8 * it + rs; const size_t row = (size_t)tb * 1024 + rl;
              const f32x4 yv = *(const f32x4*)(Y1 + row * D + col); const f32x2 sv = *(const f32x2*)(ST1 + 2 * row);
              f32x4 tv; { const int nt = c4 >> 2, r0 = (4 * c4) & 15;
#pragma unroll
                  for (int j = 0; j < 4; ++j) { const v2u cell = *(const LAS v2u*)(out + rl * 32 + 2 * (r0 + j)); const int lo = (int)cell.x, hi = (int)cell.y + (lo < 0 ? 1 : 0); tv[j] = (float)(nt ? hi : lo) * (1.0f / 4194304.0f); } }
              const f32x4 y = ((yv - sv.x) * sv.y * gv + bv) * ALPHA + tv;
              *(f32x4*)(Y2 + row * D + col) = y;
              float sm = (y[0] + y[1]) + (y[2] + y[3]), sq = (y[0] * y[0] + y[1] * y[1]) + (y[2] * y[2] + y[3] * y[3]);
#pragma unroll
              for (int o = 1; o < 8; o <<= 1) { sm += shfl_x(sm, o, lane); sq += shfl_x(sq, o, lane); }
              if (c4 == 0) *(f32x2*)(PST2 + (row * 64 + nc) * 2) = (f32x2){sm, sq}; } }
    }
}

__device__ __forceinline__ void phase_moe4n(const Frame& F, const float* Y2, const float* pst, const float* gain, const float* bias, float* ST2, bf16* XBo, float* OUT, int last) {
    const int gw = F.bid * 8 + F.wave, NGW = F.G * 8, lane = F.lane;
    for (int t = gw; t < T; t += NGW) {
        f32x4 v[8];
#pragma unroll
        for (int j = 0; j < 8; ++j) v[j] = *(const f32x4*)(Y2 + (size_t)t * D + 4 * lane + 256 * j);
        const f32x2 pv = *(const f32x2*)(pst + ((size_t)t * 64 + lane) * 2);
        const float mean = wave_sum(pv.x, lane) * (1.0f / D); const float var = fmaxf(wave_sum(pv.y, lane) * (1.0f / D) - mean * mean, 0.f); const float rstd = 1.0f / sqrtf(var + LN_EPS);
        if (lane == 0) *(f32x2*)(ST2 + 2 * (size_t)t) = (f32x2){mean, rstd};
#pragma unroll
        for (int j = 0; j < 8; ++j) { const int c = 4 * lane + 256 * j; const f32x4 o = (v[j] - mean) * rstd * *(const f32x4*)(gain + c) + *(const f32x4*)(bias + c);
            if (last) *(f32x4*)(OUT + (size_t)t * D + c) = o;
            else { v2u wb; wb.x = pk2(o[0], o[1]); wb.y = pk2(o[2], o[3]); *(v2u*)(XBo + (size_t)t * D + c) = wb; } }
    }
}


__device__ __forceinline__ void phase_moe4q(const Frame& F, const bf16* X1, bf16* Y2, const unsigned char* Yq, const float* Ysc, const int* eidx, const int* inv, const float* gain, const float* bias, float* ST2, bf16* XBo, float* OUT, int last) {
    const LAS int* tpref = (const LAS int*)(F.lds + LDS_TAB);
    const int gw = F.bid * 8 + F.wave, NGW = F.G * 8, lane = F.lane;
    for (int t = gw; t < T; t += NGW) {
        int rowi = 0; if (lane < 8) { const int e = eidx[t * 8 + lane], ps = inv[t * 8 + lane]; rowi = tpref[e] * 256 + ps; } else if (lane < 10) rowi = tpref[56 + lane] * 256 + t;
        v4u pv[2][2], yv[10][2]; float sc[10][2];
#pragma unroll
        for (int j = 0; j < 2; ++j) { pv[j][0] = __builtin_nontemporal_load((const v4u*)(X1 + (size_t)t * D + 16 * lane + 1024 * j)); pv[j][1] = __builtin_nontemporal_load((const v4u*)(X1 + (size_t)t * D + 16 * lane + 1024 * j + 8)); }
#pragma unroll
        for (int k = 0; k < 10; ++k) { const size_t row = (size_t)__builtin_amdgcn_readlane(rowi, k);
#pragma unroll
            for (int j = 0; j < 2; ++j) { yv[k][j] = __builtin_nontemporal_load((const v4u*)(Yq + row * D + 16 * lane + 1024 * j)); sc[k][j] = __builtin_nontemporal_load(Ysc + row * 16 + 8 * j + (lane >> 3)); } }
#pragma unroll
        for (int k = 0; k < 10; ++k) asm volatile("" : "+v"(yv[k][0]), "+v"(yv[k][1]), "+v"(sc[k][0]), "+v"(sc[k][1]));
        float v[2][16];
#pragma unroll
        for (int j = 0; j < 2; ++j) { float f0[8], f1[8]; unpack8(pv[j][0], f0); unpack8(pv[j][1], f1);
            const float ss = (((sc[0][j] + sc[1][j]) + (sc[2][j] + sc[3][j])) + ((sc[4][j] + sc[5][j]) + (sc[6][j] + sc[7][j]))) + (sc[8][j] + sc[9][j]);
#pragma unroll
            for (int i = 0; i < 8; ++i) { v[j][i] = ALPHA * f0[i] - 128.f * ss; v[j][8 + i] = ALPHA * f1[i] - 128.f * ss; } }
#pragma unroll
        for (int k = 0; k < 10; ++k)
#pragma unroll
            for (int j = 0; j < 2; ++j) { const float s_ = sc[k][j]; const unsigned q[4] = {yv[k][j].x, yv[k][j].y, yv[k][j].z, yv[k][j].w};
#pragma unroll
                for (int d = 0; d < 4; ++d) { v[j][4 * d + 0] += s_ * (float)(q[d] & 0xffu); v[j][4 * d + 1] += s_ * (float)((q[d] >> 8) & 0xffu); v[j][4 * d + 2] += s_ * (float)((q[d] >> 16) & 0xffu); v[j][4 * d + 3] += s_ * (float)(q[d] >> 24); } }
        float sm = 0.f;
#pragma unroll
        for (int j = 0; j < 2; ++j)
#pragma unroll
            for (int i = 0; i < 16; i += 4) sm += (v[j][i] + v[j][i + 1]) + (v[j][i + 2] + v[j][i + 3]);
        const float mean = wave_sum(sm, lane) * (1.0f / D); float sq = 0.f;
#pragma unroll
        for (int j = 0; j < 2; ++j)
#pragma unroll
            for (int i = 0; i < 16; ++i) { const float d = v[j][i] - mean; sq += d * d; }
        const float rstd = 1.0f / sqrtf(wave_sum(sq, lane) * (1.0f / D) + LN_EPS);
        (void)ST2; (void)Y2;
#pragma unroll
        for (int j = 0; j < 2; ++j)
#pragma unroll
            for (int h = 0; h < 2; ++h) { const int c = 16 * lane + 1024 * j + 8 * h; const float* vv = &v[j][8 * h];
                const f32x4 g0 = *(const f32x4*)(gain + c), g1 = *(const f32x4*)(gain + c + 4), b0 = *(const f32x4*)(bias + c), b1 = *(const f32x4*)(bias + c + 4);
                const f32x4 o0 = ((f32x4){vv[0], vv[1], vv[2], vv[3]} - mean) * rstd * g0 + b0, o1 = ((f32x4){vv[4], vv[5], vv[6], vv[7]} - mean) * rstd * g1 + b1;
                if (last) { *(f32x4*)(OUT + (size_t)t * D + c) = o0; *(f32x4*)(OUT + (size_t)t * D + c + 4) = o1; }
                else { v4u wb; wb.x = pk2(o0[0], o0[1]); wb.y = pk2(o0[2], o0[3]); wb.z = pk2(o1[0], o1[1]); wb.w = pk2(o1[2], o1[3]); *(v4u*)(XBo + (size_t)t * D + c) = wb; } }
    }
}

__device__ __forceinline__ void phase_downproj3(const Frame& F, const bf16* H, const bf16* WD, const bf16* HSp, const bf16* WSD, unsigned char* Yq, float* Ysc, int NT) {
    const LAS int* tpref = (const LAS int*)(F.lds + LDS_TAB); const LAS int* cl = (const LAS int*)(F.lds + LDS_TAB + 512);
    LAS unsigned char* lds = F.lds;
    const int tid = F.tid, lane = F.lane, w = F.wave, fr = lane & 15, fq = lane >> 4;
    unsigned rbB[2], cbB[2];
#pragma unroll
    for (int i = 0; i < 2; ++i) { int R_, C_; g8::stage_rc(tid * 16 + i * 8192, R_, C_); rbB[i] = (unsigned)((R_ & ~31) + g8::perm32(R_ & 31)); cbB[i] = (unsigned)C_ * 2u; }
    const unsigned ldsw = (unsigned)w * 1024u, lbase = (unsigned)(size_t)lds;
    int boffg[4];
#pragma unroll
    for (int g = 0; g < 4; ++g) boffg[g] = g8::lds_byte(32 * g + fr, fq * 8);
    LAS unsigned char* stg = lds + 65536 + w * (32 * 144);
    const int NU = NT * 4;
    const int upos = (F.G % 8) == 0 ? (F.bid & 7) * (F.G >> 3) + (F.bid >> 3) : F.bid;
    int ub = 0;
    int u = (F.G <= NU) ? upos : F.bid; if (u >= NU) return;
#define DP3_UNITINFO(uu, E0, EXP, NV) do { const int tl_ = (uu) >> 2; int e_ = (E0); while (__builtin_amdgcn_readfirstlane(tpref[e_ + 1]) <= tl_) ++e_; EXP = e_; \
        NV = __builtin_amdgcn_readfirstlane(cl[e_]) - (tl_ - __builtin_amdgcn_readfirstlane(tpref[e_])) * 256; } while (0)
#define DP3_GLDS(gsrc, ldsdst) do { unsigned keep_; asm volatile("s_mov_b32 %0, m0\n\ts_mov_b32 m0, %2\n\ts_nop 0\n\tglobal_load_lds_dwordx4 %1, off\n\ts_mov_b32 m0, %0" : "=&s"(keep_) : "v"(gsrc), "s"(ldsdst) : "memory"); } while (0)
#define DP3_STAGE(slot, gb, bs) do { const unsigned v0_ = rbB[0] * (unsigned)(bs) + cbB[0], v1_ = rbB[1] * (unsigned)(bs) + cbB[1]; _Pragma("unroll") for (int kt = 0; kt < 2; ++kt) { \
        DP3_GLDS((const void*)((gb) + kt * 128 + v0_), lbase + (unsigned)((slot) * 32768 + kt * 16384) + ldsw); \
        DP3_GLDS((const void*)((gb) + kt * 128 + v1_), lbase + (unsigned)((slot) * 32768 + kt * 16384) + ldsw + 8192u); } } while (0)
#define DP3_SRC(uu, ee, AB, AS, BB, BS) do { const int tl_ = (uu) >> 2, cu_ = ((uu) & 3) * 512; \
        if ((ee) < 64) { AB = (const char*)(H + (size_t)tl_ * 256 * EDIM); AS = EDIM * 2; BB = (const char*)(WD + (size_t)(ee) * D * EDIM + (size_t)cu_ * EDIM); BS = EDIM * 2; } \
        else { const int t0_ = (tl_ - __builtin_amdgcn_readfirstlane(tpref[ee])) * 256; AB = (const char*)(HSp + (size_t)t0_ * SDIM + ((ee) - 64) * EDIM); AS = SDIM * 2; \
               BB = (const char*)(WSD + (size_t)cu_ * SDIM + ((ee) - 64) * EDIM); BS = SDIM * 2; } } while (0)
    int ecur, nvcur; DP3_UNITINFO(u, 0, ecur, nvcur);
    const char* abc; const char* gbc; int asc, bsc; DP3_SRC(u, ecur, abc, asc, gbc, bsc);
    bf16x8 A[2][4], An[2][4];
    { const char* ap_ = abc + (size_t)(32 * w + fr) * asc + 16 * fq;
#pragma unroll
      for (int m = 0; m < 2; ++m)
#pragma unroll
          for (int kk = 0; kk < 4; ++kk) A[m][kk] = *(const bf16x8*)(ap_ + (size_t)m * 16 * asc + 64 * kk); }
    DP3_STAGE(0, gbc, bsc);
    asm volatile("s_waitcnt vmcnt(0)" ::: "memory");
#pragma unroll 1
    for (;;) {
        int un = u; { const int nb = ub + F.G; if (nb + F.G <= NU) un = nb + upos; else if (nb + F.bid < NU) un = nb + F.bid; if (un != u) ub = nb; }
        int enx, nvnx; DP3_UNITINFO(un, (un > u ? ecur : 0), enx, nvnx);
        const char* abn; const char* gbn; int asn, bsn; DP3_SRC(un, enx, abn, asn, gbn, bsn);
        const int tile = u >> 2, colu = (u & 3) * 512;
        float scq[2][4];
#pragma unroll
        for (int c = 0; c < 4; ++c) {
            if (c == 0) asm volatile("s_waitcnt vmcnt(5)" ::: "memory"); else asm volatile("s_waitcnt vmcnt(4)" ::: "memory");
            __builtin_amdgcn_s_barrier();
            if (c == 3) { const char* ap_ = abn + (size_t)(32 * w + fr) * asn + 16 * fq;
#pragma unroll
                for (int m = 0; m < 2; ++m) { const char* am_ = ap_ + (size_t)m * 16 * asn;
                    asm volatile("global_load_dwordx4 %0, %1, off" : "=&v"(An[m][0]) : "v"(am_) : "memory"); asm volatile("global_load_dwordx4 %0, %1, off offset:64" : "=&v"(An[m][1]) : "v"(am_) : "memory");
                    asm volatile("global_load_dwordx4 %0, %1, off offset:128" : "=&v"(An[m][2]) : "v"(am_) : "memory"); asm volatile("global_load_dwordx4 %0, %1, off offset:192" : "=&v"(An[m][3]) : "v"(am_) : "memory"); } }
            { const char* gnext = (c < 3) ? gbc + (size_t)(c + 1) * 128 * bsc : gbn; const int bnext = (c < 3) ? bsc : bsn; DP3_STAGE((c + 1) & 1, gnext, bnext); }
            __builtin_amdgcn_sched_barrier(0);
            f32x4 acc[2][4][2];
#pragma unroll
            for (int g = 0; g < 4; ++g) { bf16x8 Bf[2][4];
#pragma unroll
                for (int n = 0; n < 2; ++n)
#pragma unroll
                    for (int kk = 0; kk < 4; ++kk) Bf[n][kk] = *(const LAS bf16x8*)(lds + (c & 1) * 32768 + (kk >> 1) * 16384 + boffg[g] + n * 2048 + (kk & 1) * 1024);
#pragma unroll
                for (int m = 0; m < 2; ++m)
#pragma unroll
                    for (int n = 0; n < 2; ++n) { acc[m][g][n] = (f32x4){0.f, 0.f, 0.f, 0.f};
#pragma unroll
                        for (int kk = 0; kk < 4; ++kk) acc[m][g][n] = __builtin_amdgcn_mfma_f32_16x16x32_bf16(Bf[n][kk], A[m][kk], acc[m][g][n], 0, 0, 0); } }
#pragma unroll
            for (int m = 0; m < 2; ++m) {
                float am0 = 0.f, am1 = 0.f;
#pragma unroll
                for (int g = 0; g < 4; ++g)
#pragma unroll
                    for (int n = 0; n < 2; ++n) { am0 = fmaxf(fmaxf(am0, fabsf(acc[m][g][n][0])), fabsf(acc[m][g][n][1])); am1 = fmaxf(fmaxf(am1, fabsf(acc[m][g][n][2])), fabsf(acc[m][g][n][3])); }
                float am = fmaxf(am0, am1);
                am = fmaxf(am, shfl_x(am, 16, lane)); am = fmaxf(am, shfl_x(am, 32, lane));
                am = fminf(am, 3.0e38f);
                const float isc = am > 0.f ? 127.0f * __builtin_amdgcn_rcpf(am) : 0.f;
                scq[m][c] = am * (1.0f / 127.0f);
                const f32x2_t isc2 = (f32x2_t){isc, isc}, mg2 = (f32x2_t){8388736.0f, 8388736.0f};
#pragma unroll
                for (int g = 0; g < 4; ++g) { unsigned qd[2];
#pragma unroll
                    for (int n = 0; n < 2; ++n) {
                        const f32x2_t tl = __builtin_elementwise_fma((f32x2_t){acc[m][g][n][0], acc[m][g][n][1]}, isc2, mg2), th = __builtin_elementwise_fma((f32x2_t){acc[m][g][n][2], acc[m][g][n][3]}, isc2, mg2);
                        const float f0_ = tl.x, f1_ = tl.y, f2_ = th.x, f3_ = th.y;
                        qd[n] = __builtin_amdgcn_perm(__builtin_bit_cast(unsigned, f1_), __builtin_bit_cast(unsigned, f0_), 0x0c0c0400u) | __builtin_amdgcn_perm(__builtin_bit_cast(unsigned, f3_), __builtin_bit_cast(unsigned, f2_), 0x04000c0cu); }
                    *(LAS v2u*)(stg + (16 * m + fr) * 144 + 32 * g + 8 * fq) = (v2u){qd[0], qd[1]}; } }
#pragma unroll
            for (int it = 0; it < 4; ++it) { const int rr = 8 * it + (lane >> 3);
                const v4u o = *(const LAS v4u*)(stg + rr * 144 + (lane & 7) * 16);
                __builtin_nontemporal_store(o, (v4u*)(Yq + (size_t)(tile * 256 + 32 * w + rr) * D + colu + 128 * c + 16 * (lane & 7))); }
            if (c == 3) { const f32x4 so = fq == 0 ? (f32x4){scq[0][0], scq[0][1], scq[0][2], scq[0][3]} : (f32x4){scq[1][0], scq[1][1], scq[1][2], scq[1][3]};
                if (fq < 2) __builtin_nontemporal_store(so, (f32x4*)(Ysc + (size_t)(tile * 256 + 32 * w + 16 * fq + fr) * 16 + (colu >> 7))); }
            __builtin_amdgcn_sched_barrier(0);
        }
        asm volatile("s_waitcnt vmcnt(9)" : "+v"(An[0][0]), "+v"(An[0][1]), "+v"(An[0][2]), "+v"(An[0][3]), "+v"(An[1][0]), "+v"(An[1][1]), "+v"(An[1][2]), "+v"(An[1][3]) :: "memory");
        if (un == u) break;
#pragma unroll
        for (int m = 0; m < 2; ++m)
#pragma unroll
            for (int kk = 0; kk < 4; ++kk) A[m][kk] = An[m][kk];
        u = un; ecur = enx; nvcur = nvnx; abc = abn; asc = asn; gbc = gbn; bsc = bsn;
    }
    asm volatile("s_waitcnt vmcnt(0)" ::: "memory");
#undef DP3_UNITINFO
#undef DP3_STAGE
#undef DP3_GLDS
#undef DP3_SRC
}

enum { PH_PRO = 0, PH_POOL_G1, PH_POOL_P, PH_POOL_G2, PH_POOL_G3, PH_DIL_G1, PH_DIL_ATT, PH_DIL_CMB, PH_DIL_G2, PH_CONV_G1, PH_CONV_E, PH_CONV_G2, PH_MOE1, PH_MOE2, PH_MOE3, PH_MOE4, PH_COUNT };

template <int PH>
__device__ __forceinline__ void run_phase(const Frame& Fin, const Args& args_, const int L) {
    Frame F = Fin; { int w_ = Fin.wave, l_; asm volatile("" : "+s"(w_)); asm volatile("v_mbcnt_lo_u32_b32 %0, -1, 0\n\tv_mbcnt_hi_u32_b32 %0, -1, %0" : "=v"(l_)); F.wave = w_; F.lane = l_; F.tid = w_ * 64 + l_; }
    unsigned char* ws; { GAS unsigned char* wsg = (GAS unsigned char*)Fin.ws; asm volatile("" : "+s"(wsg)); ws = (unsigned char*)wsg; } F.ws = ws; F.ctl = (unsigned*)(ws + WS_CTL);
    KP kp = (KP)__builtin_amdgcn_kernarg_segment_ptr(); asm volatile("" : "+s"(kp)); (void)args_;
    { unsigned l_ = (unsigned)(size_t)Fin.lds; asm volatile("" : "+s"(l_)); F.lds = (LAS unsigned char*)(size_t)l_; }
    LAS unsigned char* ring = F.lds; int c = (int)blockIdx.x; { int g_ = Fin.G; asm volatile("" : "+s"(c), "+s"(g_)); F.G = g_; F.bid = c; }
    const float* xres = ain(kp, IN_X);
    const float* st2 = (const float*)(ws + WS_ST2); float* pstp = (float*)(ws + WS_PST);
    const float* g2p = ain(kp, IN_LNG) + (size_t)((L > 0 ? L - 1 : 0) * 2 + 1) * D; const float* b2p = ain(kp, IN_LNB) + (size_t)((L > 0 ? L - 1 : 0) * 2 + 1) * D;
    const bf16* xb = (const bf16*)(ws + WS_XB);
    bf16* yf = (bf16*)(ws + WS_YF);
    unsigned char* big = ws + WS_BIG;
    const int ia = L / 3;
    if constexpr (PH == PH_PRO) { phase_prologue(F, kp); }
    if constexpr (PH == PH_POOL_G1) { g8::DenseSched S; S.init(xb, (const bf16*)(ws + WS_W_POOL_IN) + (size_t)ia * D * D, T, D, D, D, F.G, c);
        g8::EpiBf16 E{(bf16*)(big + BG_U), D, 0}; g8::gemm_phase<g8::EpiBf16, g8::DenseSched, false>(ring, F.tid, D, D, D, S, E); }
    if constexpr (PH == PH_POOL_P) { phase_pool(F, (const bf16*)(big + BG_U), (bf16*)(big + BG_PL)); }
    if constexpr (PH == PH_POOL_G2) { g8::DenseSched S; S.init((const bf16*)(big + BG_PL), (const bf16*)(ws + WS_W_POOL_G) + (size_t)ia * D * 512, T, D, D, 512, F.G, c); S.agrp_shift = 1; S.agrp_stride = 512 * 2;
        g8::EpiScaleBf16 E{(bf16*)(big + BG_MX), D, ain(kp, IN_PSC) + (size_t)ia * D}; g8::gemm_phase<g8::EpiScaleBf16, g8::DenseSched, false>(ring, F.tid, 512, D, 512, S, E); }
    if constexpr (PH == PH_POOL_G3) { g8::DenseSched S; S.init((const bf16*)(big + BG_MX), (const bf16*)(ws + WS_W_POOL_OUT) + (size_t)ia * D * D, T, D, D, D, F.G, c);
        g8::EpiResidLN E{xres, xb, st2, g2p, b2p, yf, pstp, 2}; g8::gemm_phase<g8::EpiResidLN, g8::DenseSched, false>(ring, F.tid, D, D, D, S, E); }
    if constexpr (PH == PH_DIL_G1) { g8::DenseSched S; S.init(xb, (const bf16*)(ws + WS_W_DIL_QKV), T, QKVC, D, D, F.G, c);
        g8::EpiBf16 E{(bf16*)(big + BG_QKV), QKVC, 1}; g8::gemm_phase<g8::EpiBf16, g8::DenseSched, false>(ring, F.tid, D, D, D, S, E); }
    if constexpr (PH == PH_DIL_ATT) { phase_attn(F, (const bf16*)(big + BG_QKV), ain(kp, IN_RELB), (bf16*)(big + BG_OG), (float*)(big + BG_LSE)); }
    if constexpr (PH == PH_DIL_CMB) { phase_combine(F, (const bf16*)(big + BG_OG), (const float*)(big + BG_LSE), (bf16*)(big + BG_O)); }
    if constexpr (PH == PH_DIL_G2) { g8::DenseSched S; S.init((const bf16*)(big + BG_O), (const bf16*)(ws + WS_W_DIL_OUT), T, D, DILW, DILW, F.G, c);
        g8::EpiResidLN E{xres, xb, st2, g2p, b2p, yf, pstp, 2}; g8::gemm_phase<g8::EpiResidLN, g8::DenseSched, false>(ring, F.tid, DILW, DILW, DILW, S, E); }
    if constexpr (PH == PH_CONV_G1) { g8::DenseSched S; S.init(xb, (const bf16*)(ws + WS_W_CONV_IN), T, 3 * D, D, D, F.G, c);
        g8::EpiConvIn E{(bf16*)(big + BG_UC), (bf16*)(big + BG_BG)}; g8::gemm_phase<g8::EpiConvIn, g8::DenseSched, false>(ring, F.tid, D, D, D, S, E); }
    if constexpr (PH == PH_CONV_E) { phase_conv(F, (const bf16*)(big + BG_UC), (const bf16*)(big + BG_BG), ain(kp, IN_CW), (bf16*)(big + BG_Z)); }
    if constexpr (PH == PH_CONV_G2) { g8::DenseSched S; S.init((const bf16*)(big + BG_Z), (const bf16*)(ws + WS_W_CONV_OUT), T, D, D, D, F.G, c);
        g8::EpiResidLN E{xres, xb, st2, g2p, b2p, yf, pstp, 2}; g8::gemm_phase<g8::EpiResidLN, g8::DenseSched, false>(ring, F.tid, D, D, D, S, E); }
    unsigned* cnt = F.ctl + CW_CNT + L * 64 * 16;
    float* x1f = (float*)(ws + WS_X1F); bf16* x1b = (bf16*)(ws + WS_X1B);
    int* ltok = (int*)(ws + WS_LTOK); float* lgate = (float*)(ws + WS_LGATE); int* eidx = (int*)(ws + WS_EIDX); int* inv = (int*)(ws + WS_INV);
    bf16* HB = (bf16*)(ws + WS_HB); bf16* HS = (bf16*)(ws + WS_HS); bf16* Yr = (bf16*)(ws + WS_BIG);
    if constexpr (PH == PH_MOE1) {
        const float* g1 = ain(kp, IN_LNG) + (size_t)(L * 2 + 0) * D; const float* b1 = ain(kp, IN_LNB) + (size_t)(L * 2 + 0) * D;
        phase_moe1n(F, yf, pstp, g1, b1, (const bf16*)(ws + WS_RWH) + (size_t)L * NEXP * D, (const bf16*)(ws + WS_RWL) + (size_t)L * NEXP * D, ain(kp, IN_RB) + (size_t)L * NEXP,
                    x1b, (float*)(ws + WS_ST1), cnt, ltok, lgate, eidx, inv); }
    if constexpr (PH == PH_MOE2) {
        const int NT = build_tiles(F, cnt);
        { g8::ExpertSched<1, true> S; S.tpref = (const LAS int*)(F.lds + LDS_TAB); S.cnt = (const LAS int*)(F.lds + LDS_TAB + 512); S.A = (const char*)x1b; S.B = (const char*)((const bf16*)(ws + WS_W_EX_GU) + (size_t)L * 64 * 256 * D);
          S.tok = ltok; S.b_exp = (size_t)256 * D * 2; S.b_tile = 0; S.a_tile = 0; S.NU = NT; S.G = F.G; S.c = c;
          g8::EpiExpertGU E{HB}; g8::gemm_phase<g8::EpiExpertGU, g8::ExpertSched<1, true>, true>(ring, F.tid, D, D, D, S, E); }
        { const int rot = (c - (NT % F.G) + F.G) % F.G;
          g8::DenseSched S; S.init(x1b, (const bf16*)(ws + WS_W_SH_GU) + (size_t)L * 512 * D, T, 512, D, D, F.G, rot);
          int t2 = F.tid; asm volatile("" : "+v"(t2));
          g8::EpiSharedGU E{HS}; g8::gemm_phase<g8::EpiSharedGU, g8::DenseSched, false>(ring, t2, D, D, D, S, E); } }
    if constexpr (PH == PH_MOE3) {
        const float* g1 = ain(kp, IN_LNG) + (size_t)(L * 2 + 0) * D; const float* b1 = ain(kp, IN_LNB) + (size_t)(L * 2 + 0) * D;
        const int NT = build_tiles(F, cnt);
        __syncthreads();
        phase_downproj3(F, HB, (const bf16*)(ws + WS_W_EX_D) + (size_t)L * 64 * D * EDIM, HS, (const bf16*)(ws + WS_W_SH_D) + (size_t)L * D * SDIM, (unsigned char*)Yr, (float*)(ws + WS_BIG + BG_YSC), NT + 2 * (T / 256));
        (void)g1; (void)b1; }
    if constexpr (PH == PH_MOE4) { (void)build_tiles(F, cnt);
        const float* g2 = ain(kp, IN_LNG) + (size_t)(L * 2 + 1) * D; const float* b2 = ain(kp, IN_LNB) + (size_t)(L * 2 + 1) * D;
        phase_moe4q(F, x1b, (bf16*)(ws + WS_Y2F), (const unsigned char*)Yr, (const float*)(ws + WS_BIG + BG_YSC), eidx, inv, g2, b2, (float*)(ws + WS_ST2), (bf16*)(ws + WS_XB), aout(kp), L == DEPTH - 1); }
}
__device__ __forceinline__ void make_frame(Frame& F, const Args& args) {
    extern __shared__ __attribute__((aligned(16))) unsigned char lds_raw[];
    F.lds = (LAS unsigned char*)lds_raw; F.ws = args.ws; F.ctl = (unsigned*)(args.ws + WS_CTL);
    F.tid = threadIdx.x; F.lane = F.tid & 63; F.wave = __builtin_amdgcn_readfirstlane(F.tid >> 6); F.G = gridDim.x; F.bid = blockIdx.x;
}
template <int PH> __global__ void __launch_bounds__(512, 2) k_phase(Args args, int L) {
    Frame F; make_frame(F, args);
    run_phase<PH>(F, args, L);
}

#ifndef MK_NOINLINE
#define MK_NOINLINE 0
#endif
#if MK_NOINLINE
template <int PH> __device__ __noinline__ void call_phase_ni(const int L) {
    Args dummy{}; Frame F;
    KP kp = (KP)__builtin_amdgcn_kernarg_segment_ptr();
    extern __shared__ __attribute__((aligned(16))) unsigned char lds_raw[];
    F.lds = (LAS unsigned char*)lds_raw; F.ws = (unsigned char*)((GAS unsigned char* const CAS*)kp)[20]; F.ctl = (unsigned*)(F.ws + WS_CTL);
    F.tid = threadIdx.x; F.lane = F.tid & 63; F.wave = __builtin_amdgcn_readfirstlane(F.tid >> 6); F.G = gridDim.x; F.bid = blockIdx.x;
    run_phase<PH>(F, dummy, L);
}
template <int PH> __device__ __forceinline__ void call_phase(const Frame& F, const Args& args, const int L) { call_phase_ni<PH>(L); }
#else
template <int PH> __device__ __forceinline__ void call_phase(const Frame& F, const Args& args, const int L) { asm volatile("; PHASE_BEGIN %0" :: "n"(PH)); run_phase<PH>(F, args, L); asm volatile("; PHASE_END %0" :: "n"(PH)); }
#endif
__global__ void __launch_bounds__(512, 2) fwd_all(Args args) {
    Frame F; make_frame(F, args);
    volatile LAS unsigned* misc = (volatile LAS unsigned*)(F.lds + LDS_MISC);
    if (F.tid < 4) misc[F.tid] = 0u;
    __syncthreads();
    const int lo = args.ph_lo, hi = args.ph_hi;
    XcdBarrier bar; bar.bar = F.ctl + CW_BAR; bar.x = 0; bar.st = misc;
    if (hi - lo > 1) bar = xcd_barrier_post(F.ctl + CW_BAR, misc);
    int pc = 0;
#ifndef MK_DUP_MASK
#define MK_DUP_MASK 0
#endif
#if MK_DUP_MASK
#define STEP(PH, Lx) do { if (pc >= lo && pc < hi) { int nrep_ = ((MK_DUP_MASK >> (PH)) & 1) ? 2 : 1; asm volatile("" : "+s"(nrep_)); _Pragma("unroll 1") for (int r_ = 0; r_ < nrep_; ++r_) { call_phase<PH>(F, args, Lx); if (r_ + 1 < nrep_ || pc + 1 < hi) xcd_barrier(bar); } } ++pc; } while (0)
#else
#define STEP(PH, Lx) do { if (pc >= lo && pc < hi) { call_phase<PH>(F, args, Lx); if (pc + 1 < hi) xcd_barrier(bar); } ++pc; } while (0)
#endif
    STEP(PH_PRO, 0);
#pragma unroll 1
    for (int L = 0; L < DEPTH; ++L) {
        const int kind = L % 3;
        if (kind == 0) { STEP(PH_POOL_G1, L); STEP(PH_POOL_P, L); STEP(PH_POOL_G2, L); STEP(PH_POOL_G3, L); }
        else if (kind == 1) { STEP(PH_DIL_G1, L); STEP(PH_DIL_ATT, L); STEP(PH_DIL_CMB, L); STEP(PH_DIL_G2, L); }
        else { STEP(PH_CONV_G1, L); STEP(PH_CONV_E, L); STEP(PH_CONV_G2, L); }
        STEP(PH_MOE1, L); STEP(PH_MOE2, L); STEP(PH_MOE3, L); STEP(PH_MOE4, L);
    }
#undef STEP
}
constexpr int N_STEPS = 1 + 2 * 8 + 8 + 7;

template <int PH> static void launch_phase(const Args& a, int L, int grid, hipStream_t stream) {
    static bool attr = false;
    if (!attr) { (void)hipFuncSetAttribute((const void*)k_phase<PH>, hipFuncAttributeMaxDynamicSharedMemorySize, LDS_BYTES); attr = true; }
    hipLaunchKernelGGL(k_phase<PH>, dim3(grid), dim3(512), LDS_BYTES, stream, a, L);
}
extern "C" void kernel_launch(void* const* d_in, const int* in_sizes, int n_in, void* d_out, int out_size, void* d_ws, size_t ws_size, hipStream_t stream) {
    static int grid = 0;
    if (grid == 0) {
        if (n_in != 19 || out_size != T * D || ws_size < WS_END) { fprintf(stderr, "kernel_launch: unexpected shapes (n_in %d out %d ws %zu need %zu)\n", n_in, out_size, ws_size, (size_t)WS_END); grid = -1; return; }
        int dev = 0, cus = 0;
        if (hipGetDevice(&dev) != hipSuccess || hipDeviceGetAttribute(&cus, hipDeviceAttributeMultiprocessorCount, dev) != hipSuccess) { grid = -1; return; }
#if MK_ONE_LAUNCH
        if (hipFuncSetAttribute((const void*)fwd_all, hipFuncAttributeMaxDynamicSharedMemorySize, LDS_BYTES) != hipSuccess) { fprintf(stderr, "kernel_launch: hipFuncSetAttribute failed\n"); grid = -1; return; }
        int per_cu = 0;
        if (hipOccupancyMaxActiveBlocksPerMultiprocessor(&per_cu, (const void*)fwd_all, 512, LDS_BYTES) != hipSuccess || per_cu < 1) { fprintf(stderr, "kernel_launch: note: occupancy query reports %d blocks per CU\n", per_cu); (void)hipGetLastError(); }
#endif
        grid = cus;
    }
    if (grid < 0) return;
    (void)hipMemsetAsync((char*)d_ws + WS_CTL, 0, CTL_ZERO_BYTES, stream);
    Args a{};
    for (int i = 0; i < 19; ++i) a.in[i] = (const float*)d_in[i];
    a.out = (float*)d_out; a.ws = (unsigned char*)d_ws; a.ph_lo = 0; a.ph_hi = 0;
#if MK_ONE_LAUNCH
#ifdef MK_SPLIT
    for (int p = 0; p < N_STEPS; ++p) { a.ph_lo = p; a.ph_hi = p + 1; hipLaunchKernelGGL(fwd_all, dim3(grid), dim3(512), LDS_BYTES, stream, a); }
#else
    a.ph_lo = 0; a.ph_hi = N_STEPS;
    hipLaunchKernelGGL(fwd_all, dim3(grid), dim3(512), LDS_BYTES, stream, a);
#endif
#elif defined(MK_HYBRID_MASK)
    {
        static bool attr2 = false; if (!attr2) { (void)hipFuncSetAttribute((const void*)fwd_all, hipFuncAttributeMaxDynamicSharedMemorySize, LDS_BYTES); attr2 = true; }
        int pc = 0;
#define HSTEP(PH, Lx) do { if ((MK_HYBRID_MASK >> (PH)) & 1) { a.ph_lo = pc; a.ph_hi = pc + 1; hipLaunchKernelGGL(fwd_all, dim3(grid), dim3(512), LDS_BYTES, stream, a); } else { a.ph_lo = 0; a.ph_hi = 0; launch_phase<PH>(a, Lx, grid, stream); } ++pc; } while (0)
        HSTEP(PH_PRO, 0);
        for (int L = 0; L < DEPTH; ++L) {
            const int kind = L % 3;
            if (kind == 0) { HSTEP(PH_POOL_G1, L); HSTEP(PH_POOL_P, L); HSTEP(PH_POOL_G2, L); HSTEP(PH_POOL_G3, L); }
            else if (kind == 1) { HSTEP(PH_DIL_G1, L); HSTEP(PH_DIL_ATT, L); HSTEP(PH_DIL_CMB, L); HSTEP(PH_DIL_G2, L); }
            else { HSTEP(PH_CONV_G1, L); HSTEP(PH_CONV_E, L); HSTEP(PH_CONV_G2, L); }
            HSTEP(PH_MOE1, L); HSTEP(PH_MOE2, L); HSTEP(PH_MOE3, L); HSTEP(PH_MOE4, L);
        }
#undef HSTEP
    }
#else
    launch_phase<PH_PRO>(a, 0, grid, stream);
    for (int L = 0; L < DEPTH; ++L) {
        const int kind = L % 3;
        if (kind == 0) { launch_phase<PH_POOL_G1>(a, L, grid, stream); launch_phase<PH_POOL_P>(a, L, grid, stream); launch_phase<PH_POOL_G2>(a, L, grid, stream); launch_phase<PH_POOL_G3>(a, L, grid, stream); }
        else if (kind == 1) { launch_phase<PH_DIL_G1>(a, L, grid, stream); launch_phase<PH_DIL_ATT>(a, L, grid, stream); launch_phase<PH_DIL_CMB>(a, L, grid, stream); launch_phase<PH_DIL_G2>(a, L, grid, stream); }
        else { launch_phase<PH_CONV_G1>(a, L, grid, stream); launch_phase<PH_CONV_E>(a, L, grid, stream); launch_phase<PH_CONV_G2>(a, L, grid, stream); }
        launch_phase<PH_MOE1>(a, L, grid, stream); launch_phase<PH_MOE2>(a, L, grid, stream); launch_phase<PH_MOE3>(a, L, grid, stream); launch_phase<PH_MOE4>(a, L, grid, stream);
    }
#endif
}
```

```cpp
#include <hip/hip_runtime.h>
#include <cstdio>
#include <cstdint>

#ifndef MK_ONE_LAUNCH
#define MK_ONE_LAUNCH 1
#endif

#define GAS __attribute__((address_space(1)))
#define LAS __attribute__((address_space(3)))
typedef unsigned short bf16;
typedef unsigned v4u __attribute__((ext_vector_type(4)));
typedef unsigned v2u __attribute__((ext_vector_type(2)));
typedef float f32x4 __attribute__((ext_vector_type(4)));
typedef float f32x2 __attribute__((ext_vector_type(2)));
typedef short bf16x8 __attribute__((ext_vector_type(8)));
typedef short s16x4 __attribute__((ext_vector_type(4)));

constexpr int NBATCH = 8, SEQ = 2048, D = 2048, T = NBATCH * SEQ, DEPTH = 4;
constexpr int NEXP = 64, TOPK = 8, EDIM = 128, SDIM = 256;
constexpr int QKVC = 4608, DILW = 512;
constexpr float ALPHA = 1.681792830507429f;
constexpr float LN_EPS = 1e-5f;
constexpr int CAP = 16384;
constexpr int HROWS = T * TOPK + NEXP * 256;

constexpr size_t MiB = 1u << 20;
constexpr size_t WS_CTL = 0, CTL_ZERO_BYTES = 1 * MiB;
constexpr size_t WS_W_POOL_IN = 1 * MiB;
constexpr size_t WS_W_POOL_G = WS_W_POOL_IN + 16 * MiB;
constexpr size_t WS_W_POOL_OUT = WS_W_POOL_G + 4 * MiB;
constexpr size_t WS_W_DIL_QKV = WS_W_POOL_OUT + 16 * MiB;
constexpr size_t WS_W_DIL_OUT = WS_W_DIL_QKV + 18 * MiB;
constexpr size_t WS_W_CONV_IN = WS_W_DIL_OUT + 2 * MiB;
constexpr size_t WS_W_CONV_OUT = WS_W_CONV_IN + 24 * MiB;
constexpr size_t WS_W_SH_GU = WS_W_CONV_OUT + 8 * MiB;
constexpr size_t WS_W_SH_D = WS_W_SH_GU + 8 * MiB;
constexpr size_t WS_W_EX_GU = WS_W_SH_D + 4 * MiB;
constexpr size_t WS_W_EX_D = WS_W_EX_GU + 256 * MiB;
constexpr size_t WS_XF = WS_W_EX_D + 256 * MiB;
constexpr size_t WS_YF = WS_XF + 128 * MiB;
constexpr size_t WS_X1F = WS_YF + 128 * MiB;
constexpr size_t WS_XB = WS_X1F + 128 * MiB;
constexpr size_t WS_X1B = WS_XB + 64 * MiB;
constexpr size_t WS_HB = WS_X1B + 64 * MiB;
constexpr size_t WS_HS = WS_HB + 72 * MiB;
constexpr size_t WS_LTOK = WS_HS + 8 * MiB;
constexpr size_t WS_LGATE = WS_LTOK + 4 * MiB;
constexpr size_t WS_EIDX = WS_LGATE + 4 * MiB;
constexpr size_t WS_INV = WS_EIDX + 1 * MiB;
constexpr size_t WS_BIG = WS_INV + 1 * MiB;
constexpr size_t WS_PST = WS_BIG + 608 * MiB;
constexpr size_t WS_ST1 = WS_PST + 4 * MiB;
constexpr size_t WS_ST2 = WS_ST1 + 1 * MiB;
constexpr size_t WS_RWH = WS_ST2 + 1 * MiB;
constexpr size_t WS_RWL = WS_RWH + 1 * MiB;
constexpr size_t WS_PST2 = WS_RWL + 1 * MiB;
constexpr size_t WS_END = WS_PST2 + 8 * MiB;
constexpr size_t WS_Y2F = WS_X1F;
constexpr size_t BG_U = 0, BG_PL = 64 * MiB, BG_MX = 128 * MiB;
constexpr size_t BG_QKV = 0, BG_OG = 144 * MiB, BG_LSE = 192 * MiB, BG_O = 194 * MiB;
constexpr size_t BG_UC = 0, BG_BG = 64 * MiB, BG_Z = 128 * MiB;
constexpr size_t BG_YSC = 400 * MiB;
constexpr int CW_BAR = 4096;
constexpr int CW_CNT = 16384;

constexpr int RING_BYTES = 131072;
constexpr int LDS_TAB = RING_BYTES;
constexpr int LDS_STASH = RING_BYTES + 1024;
constexpr int LDS_BYTES = 163840;
constexpr int LDS_MISC = LDS_BYTES - 1024;

typedef __bf16 bf16x2_t __attribute__((ext_vector_type(2)));
typedef float f32x2_t __attribute__((ext_vector_type(2)));
__device__ __forceinline__ unsigned cvt_pk_bf16(float lo, float hi) { const bf16x2_t r = __builtin_convertvector((f32x2_t){lo, hi}, bf16x2_t); return __builtin_bit_cast(unsigned, r); }
__device__ __forceinline__ unsigned f2bf(float f) { unsigned u = __builtin_bit_cast(unsigned, f); return (u + 0x7fffu + ((u >> 16) & 1u)) >> 16; }
__device__ __forceinline__ unsigned pk2(float lo, float hi) { return f2bf(lo) | (f2bf(hi) << 16); }
__device__ __forceinline__ float bflo(unsigned w) { return __builtin_bit_cast(float, w << 16); }
__device__ __forceinline__ float bfhi(unsigned w) { return __builtin_bit_cast(float, w & 0xffff0000u); }
__device__ __forceinline__ float shfl_from(float v, int src) { return __builtin_bit_cast(float, __builtin_amdgcn_ds_bpermute(src << 2, __builtin_bit_cast(int, v))); }
__device__ __forceinline__ float shfl_x(float v, int o, int lane) { return shfl_from(v, lane ^ o); }
__device__ __forceinline__ float wave_sum(float v, int lane) {
#pragma unroll
    for (int o = 1; o < 64; o <<= 1) v += shfl_x(v, o, lane);
    return v;
}
#define LDS_WAIT() asm volatile("s_waitcnt lgkmcnt(0)" ::: "memory")
#define VM_WAIT() asm volatile("s_waitcnt vmcnt(0)" ::: "memory")

#define XB_TMO      128
#define XB_XCNT(j)  (256  + 64 * (j))
#define XB_XSUB(j)  (1280 + 64 * (j))
#define XB_XGEN(j)  (2304 + 64 * (j))
#define XB_TOP      3328
#define XB_TOPGEN   3392
#define XCD_BAR_WORDS 3456
#define XB_SPIN_CAP (1u << 18)

__device__ __forceinline__ unsigned xb_ld(unsigned* p)              { return __hip_atomic_load(p, __ATOMIC_RELAXED, __HIP_MEMORY_SCOPE_AGENT); }
__device__ __forceinline__ unsigned xb_add(unsigned* p, unsigned v) { return __hip_atomic_fetch_add(p, v, __ATOMIC_RELAXED, __HIP_MEMORY_SCOPE_AGENT); }
__device__ __forceinline__ unsigned xb_xcc_id() { return (unsigned)__builtin_amdgcn_s_getreg((3 << 11) | 20) & 0xFu; }
#define XB_SPIN(cond, bar) do { unsigned _sp = 0; while (cond) { __builtin_amdgcn_s_sleep(1); \
    if ((++_sp & 255u) == 0u) { if (xb_ld(&(bar)[XB_TMO])) break; if (_sp > XB_SPIN_CAP) { atomicAdd(&(bar)[XB_TMO], 1u); break; } } } } while (0)

struct XcdBarrier {
    unsigned* bar; unsigned x;
    volatile LAS unsigned* st;
};

__device__ __forceinline__ XcdBarrier xcd_barrier_post(unsigned* bar, volatile LAS unsigned* st) {
    XcdBarrier b; b.bar = bar; b.x = xb_xcc_id(); b.st = st;
    if (threadIdx.x == 0) (void)xb_add(&bar[XB_XCNT(b.x)], 1u);
    return b;
}
__device__ __forceinline__ void xcd_barrier_complete(unsigned* bar, unsigned x, unsigned& nloc, unsigned& nx) {
    const unsigned G = gridDim.x * gridDim.y * gridDim.z;
    unsigned sum, cnt, mine, sp = 0u;
    for (;;) {
        sum = 0u; cnt = 0u; mine = 0u;
#pragma unroll
        for (unsigned j = 0; j < 16; ++j) { const unsigned c = xb_ld(&bar[XB_XCNT(j)]); sum += c; cnt += (c > 0u) ? 1u : 0u; mine = (j == x) ? c : mine; }
        if (sum == G) break;
        __builtin_amdgcn_s_sleep(1);
        if ((++sp & 255u) == 0u) { if (xb_ld(&bar[XB_TMO])) break; if (sp > XB_SPIN_CAP) { atomicAdd(&bar[XB_TMO], 1u); break; } }
    }
    nloc = mine > 0u ? mine : 1u; nx = cnt > 0u ? cnt : 1u;
}

__device__ __forceinline__ void xcd_barrier(const XcdBarrier& b) {
    asm volatile("s_waitcnt vmcnt(0)" ::: "memory");
    __syncthreads();
    if (threadIdx.x == 0) {
        unsigned* bar; unsigned bx = b.x; { GAS unsigned* bg = (GAS unsigned*)b.bar; asm volatile("" : "+s"(bg), "+s"(bx)); bar = (unsigned*)bg; }
        __builtin_amdgcn_s_waitcnt(0);
        unsigned nloc = b.st[0], nx = b.st[1];
        if (nloc == 0u) { xcd_barrier_complete(bar, bx, nloc, nx); b.st[0] = nloc; b.st[1] = nx; }
        const unsigned old = xb_add(&bar[XB_XSUB(bx)], 1u);
        const unsigned gen = old / nloc;
        if (old + 1u == (gen + 1u) * nloc) {
            __builtin_amdgcn_fence(__ATOMIC_RELEASE, "agent");
            asm volatile("s_waitcnt vmcnt(0)" ::: "memory");
            const unsigned og = xb_add(&bar[XB_TOP], 1u);
            const unsigned tg = og / nx;
            if (og + 1u == (tg + 1u) * nx) xb_add(&bar[XB_TOPGEN], 1u);
            else XB_SPIN(xb_ld(&bar[XB_TOPGEN]) == tg, bar);
            __builtin_amdgcn_fence(__ATOMIC_ACQUIRE, "agent");
            xb_add(&bar[XB_XGEN(bx)], 1u);
            asm volatile("s_waitcnt vmcnt(0)" ::: "memory");
        } else {
            XB_SPIN(xb_ld(&bar[XB_XGEN(bx)]) == gen, bar);
            __builtin_amdgcn_fence(__ATOMIC_ACQUIRE, "agent");
            asm volatile("s_waitcnt vmcnt(0)" ::: "memory");
        }
    }
    __syncthreads();
}

namespace g8 {
constexpr int BM = 256, BK = 64, HALF = 128, HTB = HALF * BK * 2, STAGE_BYTES = 8 * HTB, NXCD = 8, WGM = 8;
__host__ __device__ __forceinline__ int lds_byte(int r, int c) { const int st = (r >> 4) * 2 + (c >> 5), rr = r & 15, cc = c & 31, ob = rr * 64 + cc * 2; return st * 1024 + (ob ^ (((ob >> 9) & 1) << 5)); }
__host__ __device__ __forceinline__ void stage_rc(int b, int& R, int& C) { const int st = b / 1024, sb = b % 1024, swz = sb ^ (((sb >> 9) & 1) << 5); R = (st >> 1) * 16 + swz / 64; C = (st & 1) * 32 + (swz % 64) / 2; }
__host__ __device__ __forceinline__ int perm32(int rho) { const int n = rho >> 4, i = rho & 15; return 8 * (i >> 2) + 4 * n + (i & 3); }

struct Unit { const char* A; const char* B; const int* rows; int pm, pn, nvalid, aux; };

template <class Epi, class Sched, bool GATHER>
__device__ __forceinline__ void gemm_phase(LAS unsigned char* lds, const int tid_in, const int K, const int lda, const int ldb, const Sched& S, const Epi& E) {
    const int tid = tid_in, wid = __builtin_amdgcn_readfirstlane(tid >> 6), lane = tid & 63, wr = wid >> 2, wc = wid & 3, fr = lane & 15, fq = lane >> 4;
    const int nt = K / BK;
    unsigned voffB[2];
#pragma unroll
    for (int i = 0; i < 2; ++i) { int R_, C_; stage_rc(tid * 16 + i * 8192, R_, C_); const int Rb = Epi::PERM ? ((R_ & ~31) + perm32(R_ & 31)) : R_; voffB[i] = (unsigned)(Rb * ldb + C_) * 2u; }
    LAS v4u* stash = (LAS v4u*)(lds + (LDS_STASH - 0) + tid * 16);
    const size_t kstep = (size_t)(BK * 2);
    const size_t hstepB = (size_t)HALF * ldb * 2;
    const unsigned ldsw = (unsigned)wid * 1024u;
    const int aoff = lds_byte(wr * 64 + fr, fq * 8), boff = lds_byte(wc * 32 + fr, fq * 8);
#define G8_SA(b, h) (((b) * 2 + (h)) * HTB)
#define G8_SB(b, h) ((4 + (b) * 2 + (h)) * HTB)
#define G8_STAGE2(bufoff, gbase, v0, v1) do { \
        __builtin_amdgcn_global_load_lds((const unsigned*)((const char*)(gbase) + (v0)), (LAS unsigned*)(lds + (bufoff) + ldsw), 16, 0, 0); \
        __builtin_amdgcn_global_load_lds((const unsigned*)((const char*)(gbase) + (v1)), (LAS unsigned*)(lds + (bufoff) + ldsw + 8192), 16, 0, 0); } while (0)
#define G8_STAGEB(bufoff, gbase) G8_STAGE2(bufoff, gbase, voffB[0], voffB[1])
#define G8_LDA(dst, b, h) do { _Pragma("unroll") for (int m = 0; m < 4; ++m) _Pragma("unroll") for (int k = 0; k < 2; ++k) dst[m][k] = *(const LAS bf16x8*)(lds + G8_SA(b, h) + aoff + m * 2048 + k * 1024); } while (0)
#define G8_LDB(dst, b, h) do { _Pragma("unroll") for (int n = 0; n < 2; ++n) _Pragma("unroll") for (int k = 0; k < 2; ++k) dst[n][k] = *(const LAS bf16x8*)(lds + G8_SB(b, h) + boff + n * 2048 + k * 1024); } while (0)
#define G8_MMA(ai, bj, At, Bt) do { __builtin_amdgcn_s_setprio(1); _Pragma("unroll") for (int m = 0; m < 4; ++m) _Pragma("unroll") for (int n = 0; n < 2; ++n) _Pragma("unroll") for (int k = 0; k < 2; ++k) \
        acc[ai][bj][m][n] = __builtin_amdgcn_mfma_f32_16x16x32_bf16(Bt[n][k], At[m][k], acc[ai][bj][m][n], 0, 0, 0); __builtin_amdgcn_s_setprio(0); } while (0)
#define G8_WAIT_V(n) asm volatile("s_waitcnt vmcnt(" #n ")" ::: "memory")
#define G8_WAIT_L(n) asm volatile("s_waitcnt lgkmcnt(" #n ")" ::: "memory")
#define G8_BAR __builtin_amdgcn_s_barrier()
#define G8_SCHED __builtin_amdgcn_sched_barrier(0)
#define G8_SETVA(dst, u) do { int _t2 = tid; if (GATHER) asm volatile("" : "+v"(_t2)); _Pragma("unroll") for (int _h = 0; _h < 2; ++_h) _Pragma("unroll") for (int _i = 0; _i < 2; ++_i) { \
        int _R, _C; stage_rc(_t2 * 16 + _i * 8192, _R, _C); \
        const unsigned _rl = (unsigned)(_h * HALF + _R); unsigned _row = _rl; \
        if (GATHER) { _row = 0u; if (_rl < (unsigned)(u).nvalid) _row = (unsigned)(u).rows[_rl] >> 3; } \
        dst[_h][_i] = (_row * (unsigned)lda + (unsigned)_C) * 2u; } } while (0)
    Unit cur, nxt; int ui = 0;
    if (!S.next(0, cur)) return;
    f32x4 acc[2][2][4][2];
#pragma unroll
    for (int a = 0; a < 2; ++a)
#pragma unroll
        for (int b = 0; b < 2; ++b)
#pragma unroll
            for (int m = 0; m < 4; ++m)
#pragma unroll
                for (int n = 0; n < 2; ++n) acc[a][b][m][n] = (f32x4){0.f, 0.f, 0.f, 0.f};
    bf16x8 At[4][2], B0[2][2], B1[2][2];
    unsigned vAc[2][2]; unsigned xl00 = 0, xl01 = 0, xl10 = 0, xl11 = 0;
    G8_SETVA(vAc, cur);
    const char* cA = cur.A; const char* cB = cur.B;
    G8_STAGEB(G8_SB(0, 0), cB); G8_STAGEB(G8_SB(0, 1), cB + hstepB); G8_STAGE2(G8_SA(0, 0), cA, vAc[0][0], vAc[0][1]); G8_STAGE2(G8_SA(0, 1), cA, vAc[1][0], vAc[1][1]);
    if (wr == 1) G8_BAR;
    G8_WAIT_V(2); G8_BAR;
    G8_STAGEB(G8_SB(1, 0), cB + kstep); G8_STAGE2(G8_SA(1, 0), cA + kstep, vAc[0][0], vAc[0][1]); G8_STAGEB(G8_SB(1, 1), cB + hstepB + kstep);
    G8_WAIT_V(6); G8_BAR;
    for (;;) {
        const bool has_next = S.next(ui + 1, nxt);
        const char* nA = has_next ? nxt.A : cA; const char* nB = has_next ? nxt.B : cB;
        if (GATHER) { unsigned vAn[2][2]; if (has_next) { G8_SETVA(vAn, nxt); } else {
#pragma unroll
            for (int h = 0; h < 2; ++h)
#pragma unroll
                for (int i = 0; i < 2; ++i) vAn[h][i] = vAc[h][i]; }
            *stash = (v4u){vAn[0][0], vAn[0][1], vAn[1][0], vAn[1][1]}; }
#pragma unroll 1
        for (int t = 0; t < nt; t += 2) {
            const bool last = (t == nt - 2);
            const char* a1 = cA + (size_t)(t + 1) * kstep;
            const char* a2 = last ? nA : cA + (size_t)(t + 2) * kstep; const char* b2 = last ? nB : cB + (size_t)(t + 2) * kstep;
            const char* a3 = a2 + kstep; const char* b3 = b2 + kstep;
            unsigned x00 = vAc[0][0], x01 = vAc[0][1], x10 = vAc[1][0], x11 = vAc[1][1];
            if (GATHER) { if (last) { const v4u sv = *stash; x00 = sv.x; x01 = sv.y; x10 = sv.z; x11 = sv.w; } xl00 = x00; xl01 = x01; xl10 = x10; xl11 = x11; }
            G8_LDB(B0, 0, 0); G8_LDB(B1, 0, 1); G8_SCHED; G8_LDA(At, 0, 0); G8_STAGE2(G8_SA(1, 1), a1, vAc[1][0], vAc[1][1]);
            G8_WAIT_V(8); G8_WAIT_L(0); G8_BAR; G8_MMA(0, 0, At, B0); G8_MMA(0, 1, At, B1); G8_BAR; G8_SCHED;
            G8_LDA(At, 0, 1); G8_STAGEB(G8_SB(0, 0), b2); G8_STAGEB(G8_SB(0, 1), b2 + hstepB); G8_STAGE2(G8_SA(0, 0), a2, x00, x01);
            G8_WAIT_V(8); G8_WAIT_L(0); G8_BAR; G8_MMA(1, 0, At, B0); G8_MMA(1, 1, At, B1); G8_BAR; G8_SCHED;
            G8_LDB(B0, 1, 0); G8_LDB(B1, 1, 1); G8_SCHED; G8_LDA(At, 1, 0); G8_STAGE2(G8_SA(0, 1), a2, x10, x11);
            G8_WAIT_V(8); G8_WAIT_L(0); G8_BAR; G8_MMA(0, 0, At, B0); G8_MMA(0, 1, At, B1); G8_BAR; G8_SCHED;
            G8_LDA(At, 1, 1); G8_STAGEB(G8_SB(1, 0), b3); G8_STAGEB(G8_SB(1, 1), b3 + hstepB); G8_STAGE2(G8_SA(1, 0), a3, x00, x01);
            G8_WAIT_V(8); G8_WAIT_L(0); G8_BAR; G8_MMA(1, 0, At, B0); G8_MMA(1, 1, At, B1); G8_BAR; G8_SCHED;
        }
        if (wr == 0) G8_BAR;
        E(acc, cur, wr, wc, fr, fq);
        if (!has_next) break;
#pragma unroll
        for (int a = 0; a < 2; ++a)
#pragma unroll
            for (int b = 0; b < 2; ++b)
#pragma unroll
                for (int m = 0; m < 4; ++m)
#pragma unroll
                    for (int n = 0; n < 2; ++n) acc[a][b][m][n] = (f32x4){0.f, 0.f, 0.f, 0.f};
        cur = nxt; cA = nA; cB = nB; ++ui;
        if (GATHER) { vAc[0][0] = xl00; vAc[0][1] = xl01; vAc[1][0] = xl10; vAc[1][1] = xl11; }
        if (wr == 1) G8_BAR;
    }
    G8_WAIT_V(0);
    G8_BAR;
#undef G8_SA
#undef G8_SB
#undef G8_STAGE2
#undef G8_STAGEB
#undef G8_LDA
#undef G8_LDB
#undef G8_MMA
#undef G8_WAIT_V
#undef G8_WAIT_L
#undef G8_BAR
#undef G8_SCHED
#undef G8_SETVA
}

struct DenseSched {
    const char* A; const char* B; size_t a_tile, b_tile, agrp_stride; int agrp_shift, nM, nN, nwg, G, c;
    __device__ __forceinline__ void init(const void* A_, const void* B_, int M, int N, int lda, int ldb, int G_, int c_) {
        A = (const char*)A_; B = (const char*)B_; a_tile = (size_t)BM * lda * 2; b_tile = (size_t)BM * ldb * 2; agrp_stride = 0; agrp_shift = 0; nM = M / BM; nN = N / BM; nwg = nM * nN; G = G_; c = c_; }
    __device__ __forceinline__ bool next(int i, Unit& u) const {
        const long L = (long)i * G + c; if (L >= nwg) return false;
        int wgid = (int)L; { const int q = nwg / NXCD, r = nwg % NXCD, xcd = wgid % NXCD, off = wgid / NXCD; wgid = (xcd < r ? xcd * (q + 1) : r * (q + 1) + (xcd - r) * q) + off; }
        const int nig = WGM * nN, gid = wgid / nig, fm = gid * WGM, gsz = (nM - fm) < WGM ? (nM - fm) : WGM;
        u.pm = fm + ((wgid % nig) % gsz); u.pn = (wgid % nig) / gsz;
        u.A = A + (size_t)u.pm * a_tile + (size_t)(u.pn >> agrp_shift) * agrp_stride; u.B = B + (size_t)u.pn * b_tile; u.rows = nullptr; u.nvalid = BM; u.aux = 0; return true;
    }
};
template <int NPN, bool GATHERED>
struct ExpertSched {
    const LAS int* tpref; const LAS int* cnt; const char* A; const char* B; const int* tok; size_t b_exp, b_tile, a_tile; int NU, G, c;
    __device__ __forceinline__ bool next(int i, Unit& u) const {
        int L = i * G + c; if (L >= NU) return false;
        if ((i + 1) * G <= NU && (G % NXCD) == 0) L = i * G + (c % NXCD) * (G / NXCD) + c / NXCD;
        const int tile = L / NPN, pn = L % NPN;
        int e = 0; while (__builtin_amdgcn_readfirstlane(tpref[e + 1]) <= tile) ++e;
        const int rb = tile - __builtin_amdgcn_readfirstlane(tpref[e]);
        u.pm = e; u.pn = pn; u.aux = tile * BM; u.nvalid = __builtin_amdgcn_readfirstlane(cnt[e]) - rb * BM; if (u.nvalid > BM) u.nvalid = BM;
        u.rows = tok + (size_t)e * CAP + rb * BM;
        u.A = GATHERED ? A : A + (size_t)tile * a_tile; u.B = B + (size_t)e * b_exp + (size_t)pn * b_tile; return true;
    }
};

struct EpiBf16 {
    static constexpr bool PERM = true;
    bf16* O; int ldc; int qscale;
    __device__ __forceinline__ void operator()(const f32x4 (&acc)[2][2][4][2], const Unit& u, int wr, int wc, int fr, int fq) const {
        asm volatile("" : "+v"(fr), "+v"(fq));
        const int row0 = u.pm * BM + wr * 64 + fr, col0 = u.pn * BM + wc * 32 + 8 * fq;
        const float sc = (qscale && (u.pn % 6) < 2) ? 0.125f : 1.0f;
#pragma unroll
        for (int ai = 0; ai < 2; ++ai)
#pragma unroll
            for (int m = 0; m < 4; ++m) { bf16* rowp = O + (size_t)(row0 + ai * HALF + m * 16) * ldc + col0;
#pragma unroll
                for (int bj = 0; bj < 2; ++bj) { const f32x4 v0 = acc[ai][bj][m][0] * sc, v1 = acc[ai][bj][m][1] * sc;
                    v4u w; w.x = cvt_pk_bf16(v0[0], v0[1]); w.y = cvt_pk_bf16(v0[2], v0[3]); w.z = cvt_pk_bf16(v1[0], v1[1]); w.w = cvt_pk_bf16(v1[2], v1[3]);
                    *(v4u*)(rowp + bj * HALF) = w; } }
    }
};
struct EpiScaleBf16 {
    static constexpr bool PERM = true;
    bf16* O; int ldc; const float* scale;
    __device__ __forceinline__ void operator()(const f32x4 (&acc)[2][2][4][2], const Unit& u, int wr, int wc, int fr, int fq) const {
        asm volatile("" : "+v"(fr), "+v"(fq));
        const int row0 = u.pm * BM + wr * 64 + fr, col0 = u.pn * BM + wc * 32 + 8 * fq;
        f32x4 sv[2][2];
#pragma unroll
        for (int bj = 0; bj < 2; ++bj)
#pragma unroll
            for (int n = 0; n < 2; ++n) sv[bj][n] = *(const f32x4*)(scale + col0 + bj * HALF + 4 * n);
#pragma unroll
        for (int ai = 0; ai < 2; ++ai)
#pragma unroll
            for (int m = 0; m < 4; ++m) { bf16* rowp = O + (size_t)(row0 + ai * HALF + m * 16) * ldc + col0;
#pragma unroll
                for (int bj = 0; bj < 2; ++bj) { const f32x4 v0 = acc[ai][bj][m][0] * sv[bj][0], v1 = acc[ai][bj][m][1] * sv[bj][1];
                    v4u w; w.x = cvt_pk_bf16(v0[0], v0[1]); w.y = cvt_pk_bf16(v0[2], v0[3]); w.z = cvt_pk_bf16(v1[0], v1[1]); w.w = cvt_pk_bf16(v1[2], v1[3]);
                    *(v4u*)(rowp + bj * HALF) = w; } }
    }
};
struct EpiResid {
    static constexpr bool PERM = false;
    const float* X; float* Y;
    __device__ __forceinline__ void operator()(const f32x4 (&acc)[2][2][4][2], const Unit& u, int wr, int wc, int fr, int fq) const {
        asm volatile("" : "+v"(fr), "+v"(fq));
        const int row0 = u.pm * BM + wr * 64 + fr, col0 = u.pn * BM + wc * 32 + 4 * fq;
#pragma unroll
        for (int ai = 0; ai < 2; ++ai)
#pragma unroll
            for (int m = 0; m < 4; ++m) { const size_t off = (size_t)(row0 + ai * HALF + m * 16) * D + col0;
#pragma unroll
                for (int bj = 0; bj < 2; ++bj)
#pragma unroll
                    for (int n = 0; n < 2; ++n) { const f32x4 xv = *(const f32x4*)(X + off + bj * HALF + n * 16); *(f32x4*)(Y + off + bj * HALF + n * 16) = xv * ALPHA + acc[ai][bj][m][n]; } }
    }
};
struct EpiResidLN {
    static constexpr bool PERM = true;
    const float* X32; const bf16* Xb; const float* st; const float* g; const float* b; bf16* Y; float* pst; int mode;
    __device__ __forceinline__ void operator()(const f32x4 (&acc)[2][2][4][2], const Unit& u, int wr, int wc, int fr, int fq) const {
        asm volatile("" : "+v"(fr), "+v"(fq));
        const int row0 = u.pm * BM + wr * 64 + fr, col0 = u.pn * BM + wc * 32 + 8 * fq, lane = fq * 16 + fr;
#pragma unroll
        for (int ai = 0; ai < 2; ++ai)
#pragma unroll
            for (int m = 0; m < 4; ++m) { const int row = row0 + ai * HALF + m * 16; const size_t off = (size_t)row * D + col0;
                float mean = 0.f, rstd = 1.f; if (mode == 1) { const f32x2 sv = *(const f32x2*)(st + 2 * row); mean = sv.x; rstd = sv.y; }
                float sm = 0.f, sq = 0.f;
#pragma unroll
                for (int bj = 0; bj < 2; ++bj) { f32x4 x0, x1;
                    if (mode == 2) { const v4u xv = *(const v4u*)(Xb + off + bj * HALF); x0 = (f32x4){bflo(xv.x), bfhi(xv.x), bflo(xv.y), bfhi(xv.y)}; x1 = (f32x4){bflo(xv.z), bfhi(xv.z), bflo(xv.w), bfhi(xv.w)}; }
                    else if (mode) { const v4u xv = *(const v4u*)(Xb + off + bj * HALF);
                        const f32x4 g0 = *(const f32x4*)(g + col0 + bj * HALF), g1 = *(const f32x4*)(g + col0 + bj * HALF + 4), b0 = *(const f32x4*)(b + col0 + bj * HALF), b1 = *(const f32x4*)(b + col0 + bj * HALF + 4);
                        x0 = ((f32x4){bflo(xv.x), bfhi(xv.x), bflo(xv.y), bfhi(xv.y)} - mean) * rstd * g0 + b0; x1 = ((f32x4){bflo(xv.z), bfhi(xv.z), bflo(xv.w), bfhi(xv.w)} - mean) * rstd * g1 + b1; }
                    else { x0 = *(const f32x4*)(X32 + off + bj * HALF); x1 = *(const f32x4*)(X32 + off + bj * HALF + 4); }
                    const f32x4 y0 = x0 * ALPHA + acc[ai][bj][m][0], y1 = x1 * ALPHA + acc[ai][bj][m][1];
                    v4u w; w.x = cvt_pk_bf16(y0[0], y0[1]); w.y = cvt_pk_bf16(y0[2], y0[3]); w.z = cvt_pk_bf16(y1[0], y1[1]); w.w = cvt_pk_bf16(y1[2], y1[3]);
                    *(v4u*)(Y + off + bj * HALF) = w;
                    sm += ((y0[0] + y0[1]) + (y0[2] + y0[3])) + ((y1[0] + y1[1]) + (y1[2] + y1[3]));
                    sq += ((y0[0] * y0[0] + y0[1] * y0[1]) + (y0[2] * y0[2] + y0[3] * y0[3])) + ((y1[0] * y1[0] + y1[1] * y1[1]) + (y1[2] * y1[2] + y1[3] * y1[3])); }
                sm += shfl_x(sm, 16, lane); sm += shfl_x(sm, 32, lane); sq += shfl_x(sq, 16, lane); sq += shfl_x(sq, 32, lane);
                if (fq == 0) *(f32x2*)(pst + ((size_t)row * 32 + u.pn * 4 + wc) * 2) = (f32x2){sm, sq}; }
    }
};
struct EpiConvIn {
    static constexpr bool PERM = true;
    bf16* UC; bf16* BGp;
    __device__ __forceinline__ void operator()(const f32x4 (&acc)[2][2][4][2], const Unit& u, int wr, int wc, int fr, int fq) const {
        asm volatile("" : "+v"(fr), "+v"(fq));
        const int row0 = u.pm * BM + wr * 64 + fr, cw = wc * 32 + 8 * fq;
        if (u.pn < 16) {
#pragma unroll
            for (int ai = 0; ai < 2; ++ai)
#pragma unroll
                for (int m = 0; m < 4; ++m) { bf16* rowp = UC + (size_t)(row0 + ai * HALF + m * 16) * D + u.pn * HALF + cw;
                    const f32x4 v0 = acc[ai][0][m][0] * acc[ai][1][m][0], v1 = acc[ai][0][m][1] * acc[ai][1][m][1];
                    v4u w; w.x = cvt_pk_bf16(v0[0], v0[1]); w.y = cvt_pk_bf16(v0[2], v0[3]); w.z = cvt_pk_bf16(v1[0], v1[1]); w.w = cvt_pk_bf16(v1[2], v1[3]);
                    *(v4u*)rowp = w; }
        } else {
#pragma unroll
            for (int ai = 0; ai < 2; ++ai)
#pragma unroll
                for (int m = 0; m < 4; ++m) { bf16* rowp = BGp + (size_t)(row0 + ai * HALF + m * 16) * D + (u.pn - 16) * BM + cw;
#pragma unroll
                    for (int bj = 0; bj < 2; ++bj) { const f32x4 v0 = acc[ai][bj][m][0], v1 = acc[ai][bj][m][1];
                        v4u w; w.x = cvt_pk_bf16(v0[0], v0[1]); w.y = cvt_pk_bf16(v0[2], v0[3]); w.z = cvt_pk_bf16(v1[0], v1[1]); w.w = cvt_pk_bf16(v1[2], v1[3]);
                        *(v4u*)(rowp + bj * HALF) = w; } }
        }
    }
};
__device__ __forceinline__ f32x4 silu_mul(f32x4 g, f32x4 uu) {
    f32x4 r;
#pragma unroll
    for (int j = 0; j < 4; ++j) r[j] = g[j] * __builtin_amdgcn_rcpf(1.0f + __expf(-g[j])) * uu[j];
    return r;
}
struct EpiExpertGU {
    static constexpr bool PERM = true;
    bf16* H;
    __device__ __forceinline__ void operator()(const f32x4 (&acc)[2][2][4][2], const Unit& u, int wr, int wc, int fr, int fq) const {
        asm volatile("" : "+v"(fr), "+v"(fq));
        const float* gates = (const float*)((const char*)u.rows + (WS_LGATE - WS_LTOK));
        const int cw = wc * 32 + 8 * fq;
#pragma unroll
        for (int ai = 0; ai < 2; ++ai)
#pragma unroll
            for (int m = 0; m < 4; ++m) { const int r = ai * HALF + wr * 64 + m * 16 + fr;
                if (r < u.nvalid) { const float gt = gates[r]; const unsigned pid = (unsigned)u.rows[r];
                    const f32x4 v0 = silu_mul(acc[ai][0][m][0], acc[ai][1][m][0]) * gt, v1 = silu_mul(acc[ai][0][m][1], acc[ai][1][m][1]) * gt;
                    v4u w; w.x = cvt_pk_bf16(v0[0], v0[1]); w.y = cvt_pk_bf16(v0[2], v0[3]); w.z = cvt_pk_bf16(v1[0], v1[1]); w.w = cvt_pk_bf16(v1[2], v1[3]);
                    (void)pid; *(v4u*)(H + (size_t)(u.aux + r) * EDIM + cw) = w; } }
    }
};
struct EpiSharedGU {
    static constexpr bool PERM = true;
    bf16* HS;
    __device__ __forceinline__ void operator()(const f32x4 (&acc)[2][2][4][2], const Unit& u, int wr, int wc, int fr, int fq) const {
        asm volatile("" : "+v"(fr), "+v"(fq));
        const int row0 = u.pm * BM + wr * 64 + fr, cw = u.pn * HALF + wc * 32 + 8 * fq;
#pragma unroll
        for (int ai = 0; ai < 2; ++ai)
#pragma unroll
            for (int m = 0; m < 4; ++m) {
                const f32x4 v0 = silu_mul(acc[ai][0][m][0], acc[ai][1][m][0]), v1 = silu_mul(acc[ai][0][m][1], acc[ai][1][m][1]);
                v4u w; w.x = cvt_pk_bf16(v0[0], v0[1]); w.y = cvt_pk_bf16(v0[2], v0[3]); w.z = cvt_pk_bf16(v1[0], v1[1]); w.w = cvt_pk_bf16(v1[2], v1[3]);
                *(v4u*)(HS + (size_t)(row0 + ai * HALF + m * 16) * SDIM + cw) = w; }
    }
};
struct EpiDownY {
    static constexpr bool PERM = true;
    bf16* Y;
    __device__ __forceinline__ void operator()(const f32x4 (&acc)[2][2][4][2], const Unit& u, int wr, int wc, int fr, int fq) const {
        asm volatile("" : "+v"(fr), "+v"(fq));
        const int col0 = u.pn * BM + wc * 32 + 8 * fq;
#pragma unroll
        for (int ai = 0; ai < 2; ++ai)
#pragma unroll
            for (int m = 0; m < 4; ++m) { const int r = ai * HALF + wr * 64 + m * 16 + fr; bf16* rowp = Y + (size_t)(u.aux + r) * D + col0;
#pragma unroll
                for (int bj = 0; bj < 2; ++bj) { const f32x4 v0 = acc[ai][bj][m][0], v1 = acc[ai][bj][m][1];
                    v4u w; w.x = cvt_pk_bf16(v0[0], v0[1]); w.y = cvt_pk_bf16(v0[2], v0[3]); w.z = cvt_pk_bf16(v1[0], v1[1]); w.w = cvt_pk_bf16(v1[2], v1[3]);
                    *(v4u*)(rowp + bj * HALF) = w; } }
    }
};
}

struct Args { const float* in[19]; float* out; unsigned char* ws; int ph_lo, ph_hi; };
struct Frame {
    LAS unsigned char* lds; unsigned* ctl; unsigned char* ws;
    int tid, lane, wave, G, bid;
};
enum { IN_X = 0, IN_RELB, IN_PWIN, IN_PWG, IN_PSC, IN_PWOUT, IN_DQKV, IN_DOUT, IN_CWIN, IN_CW, IN_CWOUT, IN_LNG, IN_LNB, IN_RW, IN_RB, IN_EGU, IN_ED, IN_SGU, IN_SD };

#define CAS __attribute__((address_space(4)))
typedef const CAS unsigned char* KP;
__device__ __forceinline__ const float* ain(KP kp, int i) { return (const float*)((const GAS float* const CAS*)kp)[i]; }
__device__ __forceinline__ float* aout(KP kp) { return (float*)((GAS float* const CAS*)kp)[19]; }
__device__ __forceinline__ void tr_item(const float* W, int K, int N, bf16* WT, int dstK, int mode, LAS float* scr, int item, int lane) {
    const int nblk = N / 32, kb = item / nblk, nb = item % nblk, k0 = 64 * kb, n0 = 32 * nb;
    int r0 = n0;
    if (mode == 1) { const int part = n0 / 2048, j = n0 % 2048; r0 = (part == 0) ? 4096 + j : 256 * (j / 128) + (part == 2 ? 128 : 0) + (j % 128); }
    if (mode == 2) { const int part = n0 / 256, j = n0 % 256; r0 = 256 * (j / 128) + 128 * part + (j % 128); }
#pragma unroll 8
    for (int i = 0; i < 32; ++i) { const int kk = 2 * i + (lane >> 5); scr[kk * 33 + (lane & 31)] = __builtin_nontemporal_load(W + (size_t)(k0 + kk) * N + n0 + (lane & 31)); }
    LDS_WAIT(); asm volatile("" ::: "memory");
    const int c = lane & 7;
#pragma unroll
    for (int j = 0; j < 4; ++j) { const int n = (lane >> 3) + 8 * j; const LAS float* s = scr + (8 * c) * 33 + n;
        v4u o; o.x = pk2(s[0 * 33], s[1 * 33]); o.y = pk2(s[2 * 33], s[3 * 33]); o.z = pk2(s[4 * 33], s[5 * 33]); o.w = pk2(s[6 * 33], s[7 * 33]);
        __builtin_nontemporal_store(o, (v4u*)(WT + (size_t)(r0 + n) * dstK + k0 + 8 * c)); }
    LDS_WAIT(); asm volatile("" ::: "memory");
}
__device__ __forceinline__ void phase_prologue(const Frame& F, KP kp) {
    LAS float* scr = (LAS float*)(F.lds + F.wave * 16384);
    const int gw = F.bid * 8 + F.wave, NGW = F.G * 8;
    constexpr int I0 = 2 * 2048, I1 = 8 * 128, I2 = 2 * 2048, I3 = 4608, I4 = 512, I5 = 6144, I6 = 2048, I7 = 4 * 512, I8 = 4 * 256, I9 = 256 * 256, I10 = 256 * 128;
    constexpr int NITEMS = I0 + I1 + I2 + I3 + I4 + I5 + I6 + I7 + I8 + I9 + I10;
    unsigned char* ws = F.ws;
    for (int it = gw; it < NITEMS; it += NGW) {
        int r = it;
        if (r < I0) { const int b = r / 2048; tr_item(ain(kp, IN_PWIN) + (size_t)b * D * D, D, D, (bf16*)(ws + WS_W_POOL_IN) + (size_t)b * D * D, D, 0, scr, r % 2048, F.lane); continue; } r -= I0;
        if (r < I1) { const int b = r / 128; tr_item(ain(kp, IN_PWG) + (size_t)b * 512 * 512, 512, 512, (bf16*)(ws + WS_W_POOL_G) + (size_t)b * 512 * 512, 512, 0, scr, r % 128, F.lane); continue; } r -= I1;
        if (r < I2) { const int b = r / 2048; tr_item(ain(kp, IN_PWOUT) + (size_t)b * D * D, D, D, (bf16*)(ws + WS_W_POOL_OUT) + (size_t)b * D * D, D, 0, scr, r % 2048, F.lane); continue; } r -= I2;
        if (r < I3) { tr_item(ain(kp, IN_DQKV), D, QKVC, (bf16*)(ws + WS_W_DIL_QKV), D, 0, scr, r, F.lane); continue; } r -= I3;
        if (r < I4) { tr_item(ain(kp, IN_DOUT), DILW, D, (bf16*)(ws + WS_W_DIL_OUT), DILW, 0, scr, r, F.lane); continue; } r -= I4;
        if (r < I5) { tr_item(ain(kp, IN_CWIN), D, 3 * D, (bf16*)(ws + WS_W_CONV_IN), D, 1, scr, r, F.lane); continue; } r -= I5;
        if (r < I6) { tr_item(ain(kp, IN_CWOUT), D, D, (bf16*)(ws + WS_W_CONV_OUT), D, 0, scr, r, F.lane); continue; } r -= I6;
        if (r < I7) { const int b = r / 512; tr_item(ain(kp, IN_SGU) + (size_t)b * D * 512, D, 512, (bf16*)(ws + WS_W_SH_GU) + (size_t)b * 512 * D, D, 2, scr, r % 512, F.lane); continue; } r -= I7;
        if (r < I8) { const int b = r / 256; tr_item(ain(kp, IN_SD) + (size_t)b * SDIM * D, SDIM, D, (bf16*)(ws + WS_W_SH_D) + (size_t)b * D * SDIM, SDIM, 0, scr, r % 256, F.lane); continue; } r -= I8;
        if (r < I9) { const int b = r / 256; tr_item(ain(kp, IN_EGU) + (size_t)b * D * 256, D, 256, (bf16*)(ws + WS_W_EX_GU) + (size_t)b * 256 * D, D, 0, scr, r % 256, F.lane); continue; } r -= I9;
        { const int b = r / 128; tr_item(ain(kp, IN_ED) + (size_t)b * EDIM * D, EDIM, D, (bf16*)(ws + WS_W_EX_D) + (size_t)b * D * EDIM, EDIM, 0, scr, r % 128, F.lane); }
    }
    const size_t gt = (size_t)F.bid * 512 + F.tid, GT = (size_t)F.G * 512;
    { const float* rw = ain(kp, IN_RW); bf16* wh = (bf16*)(ws + WS_RWH); bf16* wl = (bf16*)(ws + WS_RWL);
      for (size_t i = gt; i < (size_t)DEPTH * NEXP * D / 8; i += GT) { const size_t k8 = i % (D / 8), e = (i / (D / 8)) % NEXP, l = i / ((size_t)NEXP * D / 8);
          float v[8]; unsigned hi[8], lo[8];
#pragma unroll
          for (int j = 0; j < 8; ++j) { v[j] = rw[(l * D + k8 * 8 + j) * NEXP + e]; hi[j] = f2bf(v[j]); lo[j] = f2bf(v[j] - __builtin_bit_cast(float, hi[j] << 16)); }
          v4u a, b2; a.x = hi[0] | (hi[1] << 16); a.y = hi[2] | (hi[3] << 16); a.z = hi[4] | (hi[5] << 16); a.w = hi[6] | (hi[7] << 16);
          b2.x = lo[0] | (lo[1] << 16); b2.y = lo[2] | (lo[3] << 16); b2.z = lo[4] | (lo[5] << 16); b2.w = lo[6] | (lo[7] << 16);
          *(v4u*)(wh + (l * NEXP + e) * D + k8 * 8) = a; *(v4u*)(wl + (l * NEXP + e) * D + k8 * 8) = b2; } }
    const float* x = ain(kp, IN_X); bf16* xb = (bf16*)(ws + WS_XB);
    for (size_t i = gt; i < (size_t)T * D / 8; i += GT) { const f32x4 p = __builtin_nontemporal_load((const f32x4*)(x + i * 8)), q = __builtin_nontemporal_load((const f32x4*)(x + i * 8 + 4));
        v4u w; w.x = pk2(p[0], p[1]); w.y = pk2(p[2], p[3]); w.z = pk2(q[0], q[1]); w.w = pk2(q[2], q[3]); *(v4u*)(xb + i * 8) = w; }
}

__device__ __forceinline__ void unpack8(const v4u w, float (&f)[8]) { f[0] = bflo(w.x); f[1] = bfhi(w.x); f[2] = bflo(w.y); f[3] = bfhi(w.y); f[4] = bflo(w.z); f[5] = bfhi(w.z); f[6] = bflo(w.w); f[7] = bfhi(w.w); }
__device__ __forceinline__ void phase_pool(const Frame& F, const bf16* U, bf16* PL) {
    for (int it = F.bid * 512 + F.tid; it < (T / 32) * 256; it += F.G * 512) {
        const int cv = it & 255, ch = it >> 8, col = cv * 8, w = 2 << (col >> 9);
        const int row0 = ch * 32, pos0 = row0 & (SEQ - 1);
        float s[8], uu[8];
#pragma unroll
        for (int j = 0; j < 8; ++j) s[j] = 0.f;
        for (int j = 1; j < w; ++j) if (pos0 - j >= 0) { unpack8(*(const v4u*)(U + (size_t)(row0 - j) * D + col), uu);
#pragma unroll
            for (int q = 0; q < 8; ++q) s[q] += uu[q]; }
        for (int r = 0; r < 32; ++r) {
            const int t = row0 + r, pos = pos0 + r;
            unpack8(*(const v4u*)(U + (size_t)t * D + col), uu);
            const float inv = 1.0f / (float)((pos + 1) < w ? (pos + 1) : w);
            float o[8];
#pragma unroll
            for (int q = 0; q < 8; ++q) { s[q] += uu[q]; o[q] = s[q] * inv - uu[q]; }
            v4u ww; ww.x = pk2(o[0], o[1]); ww.y = pk2(o[2], o[3]); ww.z = pk2(o[4], o[5]); ww.w = pk2(o[6], o[7]);
            *(v4u*)(PL + (size_t)t * D + col) = ww;
            if (pos - w + 1 >= 0) { unpack8(*(const v4u*)(U + (size_t)(t - w + 1) * D + col), uu);
#pragma unroll
                for (int q = 0; q < 8; ++q) s[q] -= uu[q]; }
        }
    }
}

__device__ __forceinline__ void phase_conv(const Frame& F, const bf16* UC, const bf16* BGp, const float* cw, bf16* Z) {
    for (int it = F.bid * 512 + F.tid; it < T * 256; it += F.G * 512) {
        const int cv = it & 255, t = it >> 8, col = cv * 8, pos = t & (SEQ - 1);
        float u0[8], u1[8], u2[8], bb[8], o[8];
        unpack8(*(const v4u*)(UC + (size_t)t * D + col), u2);
        if (pos >= 1) unpack8(*(const v4u*)(UC + (size_t)(t - 1) * D + col), u1); else {
#pragma unroll
            for (int q = 0; q < 8; ++q) u1[q] = 0.f; }
        if (pos >= 2) unpack8(*(const v4u*)(UC + (size_t)(t - 2) * D + col), u0); else {
#pragma unroll
            for (int q = 0; q < 8; ++q) u0[q] = 0.f; }
        unpack8(*(const v4u*)(BGp + (size_t)t * D + col), bb);
#pragma unroll
        for (int q = 0; q < 8; ++q) o[q] = bb[q] * (cw[col + q] * u0[q] + cw[D + col + q] * u1[q] + cw[2 * D + col + q] * u2[q]);
        v4u ww; ww.x = pk2(o[0], o[1]); ww.y = pk2(o[2], o[3]); ww.z = pk2(o[4], o[5]); ww.w = pk2(o[6], o[7]);
        *(v4u*)(Z + (size_t)t * D + col) = ww;
    }
}

__device__ __forceinline__ int t5_bucket(int dist) {
    if (dist < 16) return dist;
    int large = 16 + (int)(logf((float)dist / 16.0f) / logf(128.0f) * 16.0f);
    return large < 31 ? large : 31;
}
constexpr int AT_KS = 0, AT_KSTR = 144, AT_VT = 256 * 144, AT_VSTR = 520, AT_BIAS = AT_VT + 64 * 520;
__device__ __forceinline__ void phase_attn(const Frame& F, const bf16* QKV, const float* relb, bf16* OG, float* LSE) {
    LAS unsigned char* lds = F.lds;
    const int tid = F.tid, lane = F.lane, w = tid >> 6, fr = lane & 15, fq = lane >> 4;
    for (int unit = F.bid; unit < NBATCH * 3 * 8 * 16; unit += F.G) {
        const int cmb = unit & 15, h = (unit >> 4) & 7, g = (unit >> 7) % 3, b = unit / 384;
        const int dsh = 2 * g, dil = 1 << dsh, r = cmb & (dil - 1), nb = cmb >> dsh;
        const bf16* base = QKV + (size_t)b * SEQ * QKVC + g * 1536 + h * 64;
        __syncthreads();
        {
            const int key = tid >> 1, half = tid & 1, jk = (nb - 1) * 128 + key;
            v4u kv[4], vv[4];
            if (jk >= 0) { const bf16* rp = base + (size_t)(jk * dil + r) * QKVC + half * 32;
#pragma unroll
                for (int i = 0; i < 4; ++i) { kv[i] = *(const v4u*)(rp + 512 + 8 * i); vv[i] = *(const v4u*)(rp + 1024 + 8 * i); } }
            else {
#pragma unroll
                for (int i = 0; i < 4; ++i) { kv[i] = (v4u){0u, 0u, 0u, 0u}; vv[i] = (v4u){0u, 0u, 0u, 0u}; } }
#pragma unroll
            for (int i = 0; i < 4; ++i) *(LAS v4u*)(lds + AT_KS + key * AT_KSTR + half * 64 + 16 * i) = kv[i];
#pragma unroll
            for (int i = 0; i < 4; ++i) {
                const unsigned ww[4] = {vv[i].x, vv[i].y, vv[i].z, vv[i].w};
#pragma unroll
                for (int q = 0; q < 4; ++q) { const int d = half * 32 + 8 * i + 2 * q;
                    *(LAS unsigned short*)(lds + AT_VT + d * AT_VSTR + key * 2) = (unsigned short)(ww[q] & 0xffffu);
                    *(LAS unsigned short*)(lds + AT_VT + (d + 1) * AT_VSTR + key * 2) = (unsigned short)(ww[q] >> 16); } }
            if (tid <= 128) ((LAS float*)(lds + AT_BIAS))[tid] = relb[t5_bucket(tid * dil) * 24 + g * 8 + h];
        }
        __syncthreads();
        int qi = 16 * w + fr; asm volatile("" : "+v"(qi));
        const int jq = nb * 128 + qi, tq = jq * dil + r;
        const bf16* qp = base + (size_t)tq * QKVC + 8 * fq;
        const bf16x8 q0 = *(const bf16x8*)qp, q1 = *(const bf16x8*)(qp + 32);
        f32x4 s[9]; float mx = -INFINITY;
#pragma unroll
        for (int kt = 0; kt < 9; ++kt) {
            const int kb = 16 * (w + kt);
            const bf16x8 k0 = *(const LAS bf16x8*)(lds + AT_KS + (kb + fr) * AT_KSTR + fq * 16), k1 = *(const LAS bf16x8*)(lds + AT_KS + (kb + fr) * AT_KSTR + 64 + fq * 16);
            f32x4 a = (f32x4){0.f, 0.f, 0.f, 0.f};
            a = __builtin_amdgcn_mfma_f32_16x16x32_bf16(k0, q0, a, 0, 0, 0);
            a = __builtin_amdgcn_mfma_f32_16x16x32_bf16(k1, q1, a, 0, 0, 0);
#pragma unroll
            for (int i = 0; i < 4; ++i) { const int kl = kb + 4 * fq + i, rel = qi + 128 - kl;
                const bool ok = (rel >= 0) && (rel <= 128) && (nb > 0 || kl >= 128);
                const int rc = rel < 0 ? 0 : (rel > 128 ? 128 : rel);
                const float v = ok ? a[i] + ((LAS float*)(lds + AT_BIAS))[rc] : -INFINITY;
                a[i] = v; mx = fmaxf(mx, v); }
            s[kt] = a;
        }
        mx = fmaxf(mx, shfl_x(mx, 16, lane)); mx = fmaxf(mx, shfl_x(mx, 32, lane));
        float l = 0.f;
#pragma unroll
        for (int kt = 0; kt < 9; ++kt)
#pragma unroll
            for (int i = 0; i < 4; ++i) { const float p = __expf(s[kt][i] - mx); s[kt][i] = p; l += p; }
        l += shfl_x(l, 16, lane); l += shfl_x(l, 32, lane);
        f32x4 o[4];
#pragma unroll
        for (int nt = 0; nt < 4; ++nt) o[nt] = (f32x4){0.f, 0.f, 0.f, 0.f};
#pragma unroll
        for (int st = 0; st < 5; ++st) {
            const int kt0 = 2 * st, kt1 = 2 * st + 1;
            v4u pw; pw.x = pk2(s[kt0][0], s[kt0][1]); pw.y = pk2(s[kt0][2], s[kt0][3]);
            if (kt1 < 9) { pw.z = pk2(s[kt1 < 9 ? kt1 : 0][0], s[kt1 < 9 ? kt1 : 0][1]); pw.w = pk2(s[kt1 < 9 ? kt1 : 0][2], s[kt1 < 9 ? kt1 : 0][3]); } else { pw.z = 0u; pw.w = 0u; }
            const bf16x8 pf = __builtin_bit_cast(bf16x8, pw);
            const int kb0 = 16 * (w + kt0) + 4 * fq, kb1 = 16 * (w + kt1) + 4 * fq;
#pragma unroll
            for (int nt = 0; nt < 4; ++nt) { const int d = 16 * nt + fr;
                v2u va = *(const LAS v2u*)(lds + AT_VT + d * AT_VSTR + kb0 * 2), vb = (v2u){0u, 0u};
                if (kt1 < 9) vb = *(const LAS v2u*)(lds + AT_VT + d * AT_VSTR + kb1 * 2);
                v4u vw; vw.x = va.x; vw.y = va.y; vw.z = vb.x; vw.w = vb.y;
                o[nt] = __builtin_amdgcn_mfma_f32_16x16x32_bf16(__builtin_bit_cast(bf16x8, vw), pf, o[nt], 0, 0, 0); }
        }
        const float il = 1.0f / l;
        bf16* op = OG + ((size_t)g * T + (size_t)b * SEQ + tq) * DILW + h * 64 + 4 * fq;
#pragma unroll
        for (int nt = 0; nt < 4; ++nt) { v2u ww; ww.x = pk2(o[nt][0] * il, o[nt][1] * il); ww.y = pk2(o[nt][2] * il, o[nt][3] * il); *(v2u*)(op + 16 * nt) = ww; }
        if (fq == 0) LSE[((size_t)g * T + (size_t)b * SEQ + tq) * 8 + h] = mx + logf(l);
    }
}
__device__ __forceinline__ void phase_combine(const Frame& F, const bf16* OG, const float* LSE, bf16* O) {
    for (int it = F.bid * 512 + F.tid; it < T * 64; it += F.G * 512) {
        const int c8 = it & 7, h = (it >> 3) & 7, t = it >> 6;
        const float l0 = LSE[((size_t)0 * T + t) * 8 + h], l1 = LSE[((size_t)1 * T + t) * 8 + h], l2 = LSE[((size_t)2 * T + t) * 8 + h];
        const float m = fmaxf(l0, fmaxf(l1, l2)); float w0 = __expf(l0 - m), w1 = __expf(l1 - m), w2 = __expf(l2 - m); const float inv = 1.0f / (w0 + w1 + w2); w0 *= inv; w1 *= inv; w2 *= inv;
        float a[8], bq[8], c[8], o[8]; const size_t off = (size_t)t * DILW + h * 64 + c8 * 8;
        unpack8(*(const v4u*)(OG + off), a); unpack8(*(const v4u*)(OG + (size_t)T * DILW + off), bq); unpack8(*(const v4u*)(OG + (size_t)2 * T * DILW + off), c);
#pragma unroll
        for (int q = 0; q < 8; ++q) o[q] = w0 * a[q] + w1 * bq[q] + w2 * c[q];
        v4u ww; ww.x = pk2(o[0], o[1]); ww.y = pk2(o[2], o[3]); ww.z = pk2(o[4], o[5]); ww.w = pk2(o[6], o[7]);
        *(v4u*)(O + off) = ww;
    }
}

constexpr int M1_LOG = 131072, M1_STAT = M1_LOG + 4096, M1_HIST = M1_STAT + 128, M1_BASE = M1_HIST + 256;
__device__ __forceinline__ void phase_moe1(const Frame& F, const float* Y, const float* gain, const float* bias, const float* RW, const float* RB,
                                           float* X1F, bf16* X1B, unsigned* cnt, int* ltok, float* lgate, int* eidx, int* inv) {
    LAS float* xs = (LAS float*)F.lds; LAS float* logit = (LAS float*)(F.lds + M1_LOG); LAS float* stat = (LAS float*)(F.lds + M1_STAT);
    LAS int* hist = (LAS int*)(F.lds + M1_HIST); LAS int* basep = (LAS int*)(F.lds + M1_BASE);
    const int tid = F.tid, lane = F.lane, w = F.wave;
    for (int rg = F.bid; rg < T / 16; rg += F.G) {
        const int row0 = rg * 16;
        __syncthreads();
#pragma unroll
        for (int j = 0; j < 16; ++j) { const int idx = tid + 512 * j; *(LAS f32x4*)(xs + idx * 4) = *(const f32x4*)(Y + (size_t)row0 * D + (size_t)idx * 4); }
        if (tid < 64) hist[tid] = 0;
        __syncthreads();
#pragma unroll
        for (int rr = 0; rr < 2; ++rr) { const int r = 2 * w + rr; float sm = 0.f;
#pragma unroll
            for (int j = 0; j < 32; ++j) sm += xs[r * D + lane + 64 * j];
            const float mean = wave_sum(sm, lane) * (1.0f / D); float sq = 0.f;
#pragma unroll
            for (int j = 0; j < 32; ++j) { const float d = xs[r * D + lane + 64 * j] - mean; sq += d * d; }
            const float rstd = 1.0f / sqrtf(wave_sum(sq, lane) * (1.0f / D) + LN_EPS);
            if (lane == 0) { stat[2 * r] = mean; stat[2 * r + 1] = rstd; } }
        __syncthreads();
#pragma unroll
        for (int j = 0; j < 16; ++j) { const int idx = tid + 512 * j, r = idx >> 9, c4 = (idx & 511) * 4;
            const f32x4 v = *(LAS f32x4*)(xs + idx * 4), gv = *(const f32x4*)(gain + c4), bv = *(const f32x4*)(bias + c4);
            const float mean = stat[2 * r], rstd = stat[2 * r + 1];
            const f32x4 o = (v - mean) * rstd * gv + bv;
            *(LAS f32x4*)(xs + idx * 4) = o;
            *(f32x4*)(X1F + (size_t)(row0 + r) * D + c4) = o;
            v2u wb; wb.x = pk2(o[0], o[1]); wb.y = pk2(o[2], o[3]); *(v2u*)(X1B + (size_t)(row0 + r) * D + c4) = wb; }
        __syncthreads();
        { const int r = tid >> 5, ep = tid & 31; float a0 = 0.f, a1 = 0.f; const float* wp = RW + 2 * ep; const LAS float* xr = xs + r * D;
            for (int k0 = 0; k0 < D; k0 += 16) {
                f32x2 wv[16];
#pragma unroll
                for (int j = 0; j < 16; ++j) wv[j] = *(const f32x2*)(wp + (size_t)(k0 + j) * NEXP);
                asm volatile("" : "+v"(wv[0]), "+v"(wv[1]), "+v"(wv[2]), "+v"(wv[3]), "+v"(wv[4]), "+v"(wv[5]), "+v"(wv[6]), "+v"(wv[7]));
                asm volatile("" : "+v"(wv[8]), "+v"(wv[9]), "+v"(wv[10]), "+v"(wv[11]), "+v"(wv[12]), "+v"(wv[13]), "+v"(wv[14]), "+v"(wv[15]));
#pragma unroll
                for (int j = 0; j < 16; ++j) { const float xv = xr[k0 + j]; a0 += xv * wv[j].x; a1 += xv * wv[j].y; } }
            logit[r * NEXP + 2 * ep] = a0; logit[r * NEXP + 2 * ep + 1] = a1; }
        __syncthreads();
        int sel_pos[2]; float sel_gate[2]; int sel_rank[2]; bool sel_on[2];
#pragma unroll
        for (int rr = 0; rr < 2; ++rr) { const int r = 2 * w + rr;
            const float sc = 1.0f / (1.0f + __expf(-logit[r * NEXP + lane])); const float ch = sc + RB[lane];
            int rk = 0;
#pragma unroll
            for (int j = 0; j < 8; ++j) { const float cj = shfl_from(ch, (lane & ~7) + j); rk += (cj > ch || (cj == ch && j < (lane & 7))) ? 1 : 0; }
            float gs = rk < 2 ? ch : 0.f; gs += shfl_x(gs, 1, lane); gs += shfl_x(gs, 2, lane); gs += shfl_x(gs, 4, lane);
            int grk = 0; const int g = lane >> 3;
#pragma unroll
            for (int hh = 0; hh < 8; ++hh) { const float gh = shfl_from(gs, 8 * hh); grk += (gh > gs || (gh == gs && hh < g)) ? 1 : 0; }
            const float msk = grk < 4 ? ch : -INFINITY;
            int erk = 0;
            for (int j = 0; j < 64; ++j) { const float mj = __builtin_bit_cast(float, __builtin_amdgcn_readlane(__builtin_bit_cast(int, msk), j)); erk += (mj > msk || (mj == msk && j < lane)) ? 1 : 0; }
            const bool on = erk < 8;
            const float ssum = wave_sum(on ? sc : 0.f, lane);
            sel_on[rr] = on; sel_rank[rr] = erk; sel_gate[rr] = sc / ssum * 2.5f; sel_pos[rr] = 0;
            if (on) sel_pos[rr] = __hip_atomic_fetch_add(&hist[lane], 1, __ATOMIC_RELAXED, __HIP_MEMORY_SCOPE_WORKGROUP); }
        __syncthreads();
        if (tid < 64) { const int hc = hist[tid]; int bs = 0; if (hc > 0) bs = (int)atomicAdd(&cnt[tid * 16], (unsigned)hc); basep[tid] = bs; }
        __syncthreads();
#pragma unroll
        for (int rr = 0; rr < 2; ++rr) if (sel_on[rr]) { const int t = row0 + 2 * w + rr, pos = basep[lane] + sel_pos[rr];
            ltok[(size_t)lane * CAP + pos] = t; lgate[(size_t)lane * CAP + pos] = sel_gate[rr];
            eidx[t * 8 + sel_rank[rr]] = lane; inv[t * 8 + sel_rank[rr]] = pos; }
    }
}
__device__ __forceinline__ int build_tiles(const Frame& F, const unsigned* cnt) {
    LAS int* tpref = (LAS int*)(F.lds + LDS_TAB); LAS int* cl = (LAS int*)(F.lds + LDS_TAB + 512);
    __syncthreads();
    if (F.tid < 64) cl[F.tid] = (int)__hip_atomic_load(&cnt[F.tid * 16], __ATOMIC_RELAXED, __HIP_MEMORY_SCOPE_AGENT);
    __syncthreads();
    if (F.tid == 0) { int acc = 0; for (int e = 0; e < 64; ++e) { tpref[e] = acc; acc += (cl[e] + 255) >> 8; } tpref[64] = acc; tpref[65] = acc + T / 256; tpref[66] = acc + 2 * (T / 256); cl[64] = T; cl[65] = T; }
    __syncthreads();
    return __builtin_amdgcn_readfirstlane(tpref[64]);
}
__device__ __forceinline__ void phase_moe4(const Frame& F, const float* Y2, const bf16* Yr, const int* eidx, const int* inv, const float* gain, const float* bias, float* XO, bf16* XBo) {
    const LAS int* tpref = (const LAS int*)(F.lds + LDS_TAB);
    const int gw = F.bid * 8 + F.wave, NGW = F.G * 8, lane = F.lane;
    for (int t = gw; t < T; t += NGW) {
        f32x4 v[8];
#pragma unroll
        for (int j = 0; j < 8; ++j) v[j] = *(const f32x4*)(Y2 + (size_t)t * D + 4 * lane + 256 * j);
        for (int k = 0; k < 8; ++k) { const int e = eidx[t * 8 + k], pos = inv[t * 8 + k]; const bf16* yr = Yr + (size_t)(tpref[e] * 256 + pos) * D + 4 * lane;
#pragma unroll
            for (int j = 0; j < 8; ++j) { const v2u w = *(const v2u*)(yr + 256 * j); v[j][0] += bflo(w.x); v[j][1] += bfhi(w.x); v[j][2] += bflo(w.y); v[j][3] += bfhi(w.y); } }
        float sm = 0.f;
#pragma unroll
        for (int j = 0; j < 8; ++j) sm += (v[j][0] + v[j][1]) + (v[j][2] + v[j][3]);
        const float mean = wave_sum(sm, lane) * (1.0f / D); float sq = 0.f;
#pragma unroll
        for (int j = 0; j < 8; ++j) { v[j] = v[j] - mean; sq += (v[j][0] * v[j][0] + v[j][1] * v[j][1]) + (v[j][2] * v[j][2] + v[j][3] * v[j][3]); }
        const float rstd = 1.0f / sqrtf(wave_sum(sq, lane) * (1.0f / D) + LN_EPS);
#pragma unroll
        for (int j = 0; j < 8; ++j) { const int c = 4 * lane + 256 * j; const f32x4 o = v[j] * rstd * *(const f32x4*)(gain + c) + *(const f32x4*)(bias + c);
            *(f32x4*)(XO + (size_t)t * D + c) = o;
            v2u wb; wb.x = pk2(o[0], o[1]); wb.y = pk2(o[2], o[3]); *(v2u*)(XBo + (size_t)t * D + c) = wb; }
    }
}


template <int CTRL> __device__ __forceinline__ float dppf(float x) { return __builtin_bit_cast(float, __builtin_amdgcn_update_dpp(0, __builtin_bit_cast(int, x), CTRL, 0xF, 0xF, false)); }
__device__ __forceinline__ float gmax8(float x) { x = fmaxf(x, dppf<0xB1>(x)); x = fmaxf(x, dppf<0x4E>(x)); x = fmaxf(x, dppf<0x141>(x)); return x; }
__device__ __forceinline__ float gsum8(float x) { x += dppf<0xB1>(x); x += dppf<0x4E>(x); x += dppf<0x141>(x); return x; }
__device__ __forceinline__ float rl_f(float x, int l) { return __builtin_bit_cast(float, __builtin_amdgcn_readlane(__builtin_bit_cast(int, x), l)); }
constexpr int M1_P = 0, M1N_HIST = 131072, M1N_BASE = 131072 + 256, M1N_GB = 131072 + 1024;
__device__ __forceinline__ void phase_moe1n(const Frame& F, const bf16* Y, const float* pst, const float* gain, const float* bias, const bf16* WH, const bf16* WL, const float* RB,
                                            bf16* X1B, float* ST1, unsigned* cnt, int* ltok, float* lgate, int* eidx, int* inv) {
    LAS float* P = (LAS float*)(F.lds + M1_P); LAS int* hist = (LAS int*)(F.lds + M1N_HIST); LAS int* basep = (LAS int*)(F.lds + M1N_BASE);
    const int tid = F.tid, lane = F.lane, w = F.wave, r = lane & 15, q = lane >> 4;
    for (int item = F.bid; item < T / 64; item += F.G) {
        const int row0 = item * 64;
        __syncthreads();
        if (tid < 64) hist[tid] = 0;
        { LAS f32x4* gb = (LAS f32x4*)(F.lds + M1N_GB); gb[tid] = *(const f32x4*)(gain + 4 * tid); gb[512 + tid] = *(const f32x4*)(bias + 4 * tid); }
        __syncthreads();
        float mean[4], rstd[4];
#pragma unroll
        for (int rt = 0; rt < 4; ++rt) { const int row = row0 + 16 * rt + r;
          const f32x4* pp = (const f32x4*)(pst + ((size_t)row * 32 + q * 8) * 2); const f32x4 a = pp[0], b = pp[1], c = pp[2], d = pp[3];
          float sm = (a[0] + a[2]) + (b[0] + b[2]) + (c[0] + c[2]) + (d[0] + d[2]), sq = (a[1] + a[3]) + (b[1] + b[3]) + (c[1] + c[3]) + (d[1] + d[3]);
          sm += shfl_x(sm, 16, lane); sm += shfl_x(sm, 32, lane); sq += shfl_x(sq, 16, lane); sq += shfl_x(sq, 32, lane);
          mean[rt] = sm * (1.0f / D); const float var = fmaxf(sq * (1.0f / D) - mean[rt] * mean[rt], 0.f); rstd[rt] = 1.0f / sqrtf(var + LN_EPS);
          if (w == 0 && q == 0) *(f32x2*)(ST1 + 2 * row) = (f32x2){mean[rt], rstd[rt]}; }
        const int kb = 256 * w + 8 * q;
        const LAS float* gl = (const LAS float*)(F.lds + M1N_GB) + kb;
        f32x4 acc[4][4];
#pragma unroll
        for (int rt = 0; rt < 4; ++rt)
#pragma unroll
            for (int nt = 0; nt < 4; ++nt) acc[rt][nt] = (f32x4){0.f, 0.f, 0.f, 0.f};
        v4u yb[3][4]; bf16x8 wh[4], wl[4];
        unsigned vo[4];
#pragma unroll
        for (int i = 0; i < 4; ++i) { vo[i] = (unsigned)(r * D + kb) * 2u + (unsigned)i * (16u * D * 2u); asm volatile("" : "+v"(vo[i])); }
        const char* ybase = (const char*)(Y + (size_t)row0 * D); char* xbase = (char*)(X1B + (size_t)row0 * D);
#define M1_LOADY(st) do { _Pragma("unroll") for (int rt = 0; rt < 4; ++rt) yb[(st) % 3][rt] = __builtin_nontemporal_load((const v4u*)(ybase + vo[rt] + 64 * (st))); } while (0)
#define M1_LOADW(st) do { _Pragma("unroll") for (int nt = 0; nt < 4; ++nt) { wh[nt] = *(const bf16x8*)((const char*)WH + vo[nt] + 64 * (st)); wl[nt] = *(const bf16x8*)((const char*)WL + vo[nt] + 64 * (st)); } } while (0)
        M1_LOADY(0); M1_LOADW(0); M1_LOADY(1);
        __builtin_amdgcn_sched_barrier(0);
#pragma unroll
        for (int st = 0; st < 8; ++st) {
            const f32x4 g0 = *(const LAS f32x4*)(gl + 32 * st), g1 = *(const LAS f32x4*)(gl + 32 * st + 4), b0 = *(const LAS f32x4*)(gl + 2048 + 32 * st), b1 = *(const LAS f32x4*)(gl + 2048 + 32 * st + 4);
#pragma unroll
            for (int rt = 0; rt < 4; ++rt) { const v4u yv = yb[st % 3][rt];
                const f32x4 y0_ = (f32x4){bflo(yv.x), bfhi(yv.x), bflo(yv.y), bfhi(yv.y)}, y1_ = (f32x4){bflo(yv.z), bfhi(yv.z), bflo(yv.w), bfhi(yv.w)};
                const f32x4 x0 = (y0_ - mean[rt]) * rstd[rt] * g0 + b0, x1 = (y1_ - mean[rt]) * rstd[rt] * g1 + b1;
                v4u h; h.x = cvt_pk_bf16(x0[0], x0[1]); h.y = cvt_pk_bf16(x0[2], x0[3]); h.z = cvt_pk_bf16(x1[0], x1[1]); h.w = cvt_pk_bf16(x1[2], x1[3]);
                *(v4u*)(xbase + vo[rt] + 64 * st) = h;
                v4u l; l.x = cvt_pk_bf16(x0[0] - bflo(h.x), x0[1] - bfhi(h.x)); l.y = cvt_pk_bf16(x0[2] - bflo(h.y), x0[3] - bfhi(h.y));
                l.z = cvt_pk_bf16(x1[0] - bflo(h.z), x1[1] - bfhi(h.z)); l.w = cvt_pk_bf16(x1[2] - bflo(h.w), x1[3] - bfhi(h.w));
                const bf16x8 xh = __builtin_bit_cast(bf16x8, h), xl = __builtin_bit_cast(bf16x8, l);
#pragma unroll
                for (int nt = 0; nt < 4; ++nt) { acc[rt][nt] = __builtin_amdgcn_mfma_f32_16x16x32_bf16(xh, wh[nt], acc[rt][nt], 0, 0, 0);
                    acc[rt][nt] = __builtin_amdgcn_mfma_f32_16x16x32_bf16(xl, wh[nt], acc[rt][nt], 0, 0, 0); acc[rt][nt] = __builtin_amdgcn_mfma_f32_16x16x32_bf16(xh, wl[nt], acc[rt][nt], 0, 0, 0); } }
            __builtin_amdgcn_sched_barrier(0);
            if (st + 1 < 8) M1_LOADW(st + 1);
            if (st + 2 < 8) M1_LOADY(st + 2);
            __builtin_amdgcn_sched_barrier(0);
        }
#undef M1_LOADY
#undef M1_LOADW
#pragma unroll
        for (int rt = 0; rt < 4; ++rt)
#pragma unroll
            for (int nt = 0; nt < 4; ++nt)
#pragma unroll
                for (int i = 0; i < 4; ++i) P[(w * 64 + 16 * rt + 4 * q + i) * 64 + 16 * nt + r] = acc[rt][nt][i];
        __syncthreads();
        const float rb = RB[lane];
        LAS int* Pi = (LAS int*)P;
#pragma unroll 1
        for (int rr = 0; rr < 8; ++rr) { const int rl = 8 * w + rr;
            float lg = ((P[rl * 64 + lane] + P[(64 + rl) * 64 + lane]) + (P[(128 + rl) * 64 + lane] + P[(192 + rl) * 64 + lane])) + ((P[(256 + rl) * 64 + lane] + P[(320 + rl) * 64 + lane]) + (P[(384 + rl) * 64 + lane] + P[(448 + rl) * 64 + lane]));
            lg = (lg == lg) ? lg : -1.0e30f;
            const float sc = 1.0f / (1.0f + __expf(-lg)); const float ch = sc + rb;
            const float m1 = gmax8(ch), neq = gsum8(ch == m1 ? 1.f : 0.f), m2c = gmax8(ch < m1 ? ch : -INFINITY);
            const float gs = m1 + (neq >= 2.f ? m1 : m2c);
            int grk = 0; const int g = lane >> 3;
#pragma unroll
            for (int hh = 0; hh < 8; ++hh) { const float gh = rl_f(gs, 8 * hh); grk += (gh > gs || (gh == gs && hh < g)) ? 1 : 0; }
            const float msk = grk < 4 ? ch : -INFINITY;
            float cur = msk, ssum = 0.f; int erk = 64;
#pragma unroll 1
            for (int k = 0; k < 8; ++k) {
                float rm = gmax8(cur); rm = fmaxf(rm, dppf<0x140>(rm));
                const float wm = fmaxf(fmaxf(rl_f(rm, 0), rl_f(rm, 16)), fmaxf(rl_f(rm, 32), rl_f(rm, 48)));
                const unsigned long long bal = __builtin_amdgcn_ballot_w64(cur == wm);
                const int lsel = __builtin_amdgcn_readfirstlane((int)__builtin_ctzll(bal));
                ssum += rl_f(sc, lsel);
                const bool me = lane == lsel; erk = me ? k : erk; cur = me ? -INFINITY : cur; }
            const bool on = erk < 8;
            int pk_ = -1; if (on) pk_ = __hip_atomic_fetch_add(&hist[lane], 1, __ATOMIC_RELAXED, __HIP_MEMORY_SCOPE_WORKGROUP) | (erk << 16);
            P[rl * 64 + lane] = sc / ssum * 2.5f; Pi[(64 + rl) * 64 + lane] = pk_; }
        __syncthreads();
        if (tid < 64) { int tt = tid; asm volatile("" : "+v"(tt));
            const int hc = hist[tt]; int bs = 0; if (hc > 0) bs = (int)atomicAdd(&cnt[tt * 16], (unsigned)hc); basep[tt] = bs; }
        __syncthreads();
        { const int bl = basep[lane];
#pragma unroll 1
          for (int rr = 0; rr < 8; ++rr) { const int rl = 8 * w + rr; const int pk_ = Pi[(64 + rl) * 64 + lane]; const float gt_ = P[rl * 64 + lane];
            if (pk_ >= 0) { const int t = row0 + rl, pos = bl + (pk_ & 0xffff), rk_ = pk_ >> 16;
                ltok[(size_t)lane * CAP + pos] = t * 8 + rk_; lgate[(size_t)lane * CAP + pos] = gt_;
                eidx[t * 8 + rk_] = lane; inv[t * 8 + rk_] = pos; } } }
    }
}

constexpr int M3_PL = 131072, M3_CNT = 147456, M3_OFF = 147456 + 272;
__device__ __forceinline__ void phase_moe3n(const Frame& F, const bf16* H, const bf16* HSp, const int* eidx, const bf16* WD, const bf16* WSD,
                                            const float* Y1, const float* ST1, const float* g1, const float* b1, float* Y2, float* PST2) {
    LAS int* out = (LAS int*)F.lds; LAS unsigned short* plist = (LAS unsigned short*)(F.lds + M3_PL); LAS int* cnt = (LAS int*)(F.lds + M3_CNT); LAS int* off = (LAS int*)(F.lds + M3_OFF);
    const int tid = F.tid, lane = F.lane, w = F.wave, r = lane & 15, q = lane >> 4;
    for (int u = F.bid; u < 1024; u += F.G) {
        int nc = (u & 7) | ((u >> 7) << 3), tb = (u >> 3) & 15;
        if (F.G == 256) { const int i = u >> 8, x = u & 7, j = (u >> 3) & 31; tb = 2 * x + (i >> 1); nc = 32 * (i & 1) + j; }
        __syncthreads();
#pragma unroll
        for (int j = 0; j < 16; ++j) ((LAS v4u*)out)[tid + 512 * j] = (v4u){0u, 0u, 0u, 0u};
        if (tid < 66) cnt[tid] = 0;
        __syncthreads();
        int ee[16], pp[16];
        { const v4u* ep = (const v4u*)(eidx + ((size_t)tb * 1024 + 2 * tid) * 8); const v4u e0 = ep[0], e1 = ep[1], e2 = ep[2], e3 = ep[3];
          ee[0] = e0.x; ee[1] = e0.y; ee[2] = e0.z; ee[3] = e0.w; ee[4] = e1.x; ee[5] = e1.y; ee[6] = e1.z; ee[7] = e1.w;
          ee[8] = e2.x; ee[9] = e2.y; ee[10] = e2.z; ee[11] = e2.w; ee[12] = e3.x; ee[13] = e3.y; ee[14] = e3.z; ee[15] = e3.w; }
#pragma unroll
        for (int j = 0; j < 16; ++j) pp[j] = __hip_atomic_fetch_add(&cnt[ee[j]], 1, __ATOMIC_RELAXED, __HIP_MEMORY_SCOPE_WORKGROUP);
        __syncthreads();
        if (w == 0) { int c = cnt[lane], x = c;
#pragma unroll
            for (int o = 1; o < 64; o <<= 1) { const int y = __builtin_amdgcn_ds_bpermute(((lane - o) & 63) << 2, x); if (lane >= o) x += y; }
            off[lane] = x - c; if (lane == 63) off[64] = x; }
        __syncthreads();
#pragma unroll
        for (int j = 0; j < 16; ++j) plist[off[ee[j]] + pp[j]] = (unsigned short)(tid * 16 + j);
        __syncthreads();
        const char* Hb = (const char*)H + (size_t)tb * 8192 * 256 + q * 16;
        const char* HSb = (const char*)HSp + (size_t)tb * 1024 * 512 + q * 16;
        const char* Bb = (const char*)WD + ((size_t)nc * 32 + r) * 256 + q * 16;
        const char* BSb = (const char*)WSD + ((size_t)nc * 32 + r) * 512 + q * 16;
#define M3_NR(sg) ((sg) < 8 ? __builtin_amdgcn_readfirstlane(cnt[w + 8 * (sg)]) : 128)
#define M3_RB(sg) ((sg) < 8 ? __builtin_amdgcn_readfirstlane(off[w + 8 * (sg)]) : 0)
#define M3_GLD(dst, ptr, OFF) asm volatile("global_load_dwordx4 %0, %1, off offset:" #OFF : "=&v"(dst) : "v"(ptr) : "memory")
#define M3_LOADB(dst, sg) do { const char* _b0 = (sg) < 8 ? Bb + (size_t)(w + 8 * (sg)) * 524288 : BSb + ((sg) - 8) * 256; const char* _b1 = _b0 + ((sg) < 8 ? 4096 : 8192); \
            M3_GLD(dst[0][0], _b0, 0); M3_GLD(dst[0][1], _b0, 64); M3_GLD(dst[0][2], _b0, 128); M3_GLD(dst[0][3], _b0, 192); \
            M3_GLD(dst[1][0], _b1, 0); M3_GLD(dst[1][1], _b1, 64); M3_GLD(dst[1][2], _b1, 128); M3_GLD(dst[1][3], _b1, 192); } while (0)
#define M3_LOADA(dst, sg, bb, nr, rbs) do { int _i = 16 * (bb) + r; _i = _i < (nr) ? _i : (nr) - 1; const unsigned _rid = plist[(rbs) + _i]; \
            const char* _a = (sg) < 8 ? Hb + (size_t)_rid * 256 : ((sg) < 10 ? HSb + (size_t)(128 * w + _i) * 512 + ((sg) - 8) * 256 : Hb); \
            M3_GLD(dst[0], _a, 0); M3_GLD(dst[1], _a, 64); M3_GLD(dst[2], _a, 128); M3_GLD(dst[3], _a, 192); } while (0)
#define M3_ADV(sg, bb, nr, rbs) do { if ((sg) < 10) { ++(bb); if ((bb) * 16 >= (nr)) { (bb) = 0; do { ++(sg); } while ((sg) < 8 && M3_NR(sg) == 0); if ((sg) < 10) { (nr) = M3_NR(sg); (rbs) = M3_RB(sg); } } } } while (0)
#define M3_WAITA(AS) asm volatile("s_waitcnt vmcnt(12)" : "+v"(AS[0]), "+v"(AS[1]), "+v"(AS[2]), "+v"(AS[3]) :: "memory")
#define M3_WAITB(N) asm volatile("s_waitcnt vmcnt(" #N ")" : "+v"(Bn[0][0]), "+v"(Bn[0][1]), "+v"(Bn[0][2]), "+v"(Bn[0][3]), "+v"(Bn[1][0]), "+v"(Bn[1][1]), "+v"(Bn[1][2]), "+v"(Bn[1][3]) :: "memory")
#define M3_STEP(AS) if (cseg < 10) { \
              \
            int tk[4]; bool ok[4]; unsigned pl[4]; const int rt_ = cseg < 8; \
            _Pragma("unroll") for (int i = 0; i < 4; ++i) { const int idx = 16 * cbt + 4 * q + i; ok[i] = idx < cnr; const int ic = ok[i] ? idx : cnr - 1; pl[i] = plist[crbs + ic]; tk[i] = 128 * w + ic; } \
            _Pragma("unroll") for (int i = 0; i < 4; ++i) tk[i] = rt_ ? (int)(pl[i] >> 3) : tk[i]; \
            M3_WAITA(AS); \
            f32x4 acc[2]; \
            _Pragma("unroll") for (int nt = 0; nt < 2; ++nt) { acc[nt] = (f32x4){0.f, 0.f, 0.f, 0.f}; \
                _Pragma("unroll") for (int kk = 0; kk < 4; ++kk) acc[nt] = __builtin_amdgcn_mfma_f32_16x16x32_bf16(__builtin_bit_cast(bf16x8, AS[kk]), __builtin_bit_cast(bf16x8, Bc[nt][kk]), acc[nt], 0, 0, 0); } \
              \
            _Pragma("unroll") for (int i = 0; i < 4; ++i) { const long long lo_ = ok[i] ? (long long)__float2int_rn(acc[0][i] * 4194304.0f) : 0ll, hi_ = ok[i] ? (long long)__float2int_rn(acc[1][i] * 4194304.0f) : 0ll; \
                (void)__hip_atomic_fetch_add((LAS unsigned long long*)out + tk[i] * 16 + r, (unsigned long long)((hi_ << 32) + lo_), __ATOMIC_RELAXED, __HIP_MEMORY_SCOPE_WORKGROUP); } \
            M3_LOADA(AS, pseg, pbt, pnr, prbs); M3_ADV(pseg, pbt, pnr, prbs); \
            { const int old_ = cseg, nbat_ = (cnr + 15) >> 4; M3_ADV(cseg, cbt, cnr, crbs); \
              if (cseg != old_ && cseg < 10) { \
                  if (nbat_ == 1) M3_WAITB(4); else if (nbat_ == 2) M3_WAITB(8); else if (nbat_ == 3) M3_WAITB(12); else M3_WAITB(16); \
                  _Pragma("unroll") for (int nt = 0; nt < 2; ++nt) _Pragma("unroll") for (int kk = 0; kk < 4; ++kk) Bc[nt][kk] = Bn[nt][kk]; \
                  int nb_ = cseg; do { ++nb_; } while (nb_ < 8 && M3_NR(nb_) == 0); if (nb_ >= 10) nb_ = 9; M3_LOADB(Bn, nb_); } } }
        int cseg = -1, cbt = 0, cnr = 0, crbs = 0;
        do { ++cseg; } while (cseg < 8 && M3_NR(cseg) == 0);
        cnr = M3_NR(cseg); crbs = M3_RB(cseg);
        int pseg = cseg, pbt = 0, pnr = cnr, prbs = crbs;
        v4u Bc[2][4], Bn[2][4], A0[4], A1[4], A2[4], A3[4];
        M3_LOADB(Bc, cseg);
        M3_LOADA(A0, pseg, pbt, pnr, prbs); M3_ADV(pseg, pbt, pnr, prbs);
        M3_LOADA(A1, pseg, pbt, pnr, prbs); M3_ADV(pseg, pbt, pnr, prbs);
        M3_LOADA(A2, pseg, pbt, pnr, prbs); M3_ADV(pseg, pbt, pnr, prbs);
        M3_LOADA(A3, pseg, pbt, pnr, prbs); M3_ADV(pseg, pbt, pnr, prbs);
        { int nb_ = cseg; do { ++nb_; } while (nb_ < 8 && M3_NR(nb_) == 0); if (nb_ >= 10) nb_ = 9; M3_LOADB(Bn, nb_); }
        asm volatile("s_waitcnt vmcnt(0)" : "+v"(Bc[0][0]), "+v"(Bc[0][1]), "+v"(Bc[0][2]), "+v"(Bc[0][3]), "+v"(Bc[1][0]), "+v"(Bc[1][1]), "+v"(Bc[1][2]), "+v"(Bc[1][3]) :: "memory");
#pragma unroll 1
        while (cseg < 10) { M3_STEP(A0) M3_STEP(A1) M3_STEP(A2) M3_STEP(A3) }
        asm volatile("s_waitcnt vmcnt(0)" : "+v"(A0[0]), "+v"(A0[1]), "+v"(A0[2]), "+v"(A0[3]), "+v"(A1[0]), "+v"(A1[1]), "+v"(A1[2]), "+v"(A1[3]), "+v"(A2[0]), "+v"(A2[1]), "+v"(A2[2]), "+v"(A2[3]),
                     "+v"(A3[0]), "+v"(A3[1]), "+v"(A3[2]), "+v"(A3[3]), "+v"(Bn[0][0]), "+v"(Bn[0][1]), "+v"(Bn[0][2]), "+v"(Bn[0][3]), "+v"(Bn[1][0]), "+v"(Bn[1][1]), "+v"(Bn[1][2]), "+v"(Bn[1][3]) :: "memory");
#undef M3_NR
#undef M3_RB
#undef M3_GLD
#undef M3_LOADB
#undef M3_LOADA
#undef M3_ADV
#undef M3_WAITA
#undef M3_WAITB
#undef M3_STEP
        __syncthreads();
        { const int c4 = lane & 7, rs = lane >> 3, col = nc * 32 + 4 * c4;
          const f32x4 gv = *(const f32x4*)(g1 + col), bv = *(const f32x4*)(b1 + col);
#pragma unroll 4
          for (int it = 0; it < 16; ++it) { const int rl = 128 * w + 8 * it + rs; const size_t row = (size_t)tb * 1024 + rl;
              const f32x4 yv = *(const f32x4*)(Y1 + row * D + col); const f32x2 sv = *(const f32x2*)(ST1 + 2 * row);
              f32x4 tv; { const int nt = c4 >> 2, r0 = (4 * c4) & 15;
#pragma unroll
                  for (int j = 0; j < 4; ++j) { const v2u cell = *(const LAS v2u*)(out + rl * 32 + 2 * (r0 + j)); const int lo = (int)cell.x, hi = (int)cell.y + (lo < 0 ? 1 : 0); tv[j] = (float)(nt ? hi : lo) * (1.0f / 4194304.0f); } }
              const f32x4 y = ((yv - sv.x) * sv.y * gv + bv) * ALPHA + tv;
              *(f32x4*)(Y2 + row * D + col) = y;
              float sm = (y[0] + y[1]) + (y[2] + y[3]), sq = (y[0] * y[0] + y[1] * y[1]) + (y[2] * y[2] + y[3] * y[3]);
#pragma unroll
              for (int o = 1; o < 8; o <<= 1) { sm += shfl_x(sm, o, lane); sq += shfl_x(sq, o, lane); }
              if (c4 == 0) *(f32x2*)(PST2 + (row * 64 + nc) * 2) = (f32x2){sm, sq}; } }
    }
}

__device__ __forceinline__ void phase_moe4n(const Frame& F, const float* Y2, const float* pst, const float* gain, const float* bias, float* ST2, bf16* XBo, float* OUT, int last) {
    const int gw = F.bid * 8 + F.wave, NGW = F.G * 8, lane = F.lane;
    for (int t = gw; t < T; t += NGW) {
        f32x4 v[8];
#pragma unroll
        for (int j = 0; j < 8; ++j) v[j] = *(const f32x4*)(Y2 + (size_t)t * D + 4 * lane + 256 * j);
        const f32x2 pv = *(const f32x2*)(pst + ((size_t)t * 64 + lane) * 2);
        const float mean = wave_sum(pv.x, lane) * (1.0f / D); const float var = fmaxf(wave_sum(pv.y, lane) * (1.0f / D) - mean * mean, 0.f); const float rstd = 1.0f / sqrtf(var + LN_EPS);
        if (lane == 0) *(f32x2*)(ST2 + 2 * (size_t)t) = (f32x2){mean, rstd};
#pragma unroll
        for (int j = 0; j < 8; ++j) { const int c = 4 * lane + 256 * j; const f32x4 o = (v[j] - mean) * rstd * *(const f32x4*)(gain + c) + *(const f32x4*)(bias + c);
            if (last) *(f32x4*)(OUT + (size_t)t * D + c) = o;
            else { v2u wb; wb.x = pk2(o[0], o[1]); wb.y = pk2(o[2], o[3]); *(v2u*)(XBo + (size_t)t * D + c) = wb; } }
    }
}


__device__ __forceinline__ void phase_moe4q(const Frame& F, const bf16* X1, bf16* Y2, const unsigned char* Yq, const float* Ysc, const int* eidx, const int* inv, const float* gain, const float* bias, float* ST2, bf16* XBo, float* OUT, int last) {
    const LAS int* tpref = (const LAS int*)(F.lds + LDS_TAB);
    const int gw = F.bid * 8 + F.wave, NGW = F.G * 8, lane = F.lane;
    int en = 0, pn = 0; if (lane < 8 && gw < T) { en = eidx[gw * 8 + lane]; pn = inv[gw * 8 + lane]; }
    for (int t = gw; t < T; t += NGW) {
        int rowi = 0; if (lane < 8) rowi = tpref[en] * 256 + pn; else if (lane < 10) rowi = tpref[56 + lane] * 256 + t;
        if (lane < 8 && t + NGW < T) { en = eidx[(t + NGW) * 8 + lane]; pn = inv[(t + NGW) * 8 + lane]; }
        v4u pv[2][2], yv[10][2]; float sc[10][2];
#pragma unroll
        for (int j = 0; j < 2; ++j) { pv[j][0] = __builtin_nontemporal_load((const v4u*)(X1 + (size_t)t * D + 16 * lane + 1024 * j)); pv[j][1] = __builtin_nontemporal_load((const v4u*)(X1 + (size_t)t * D + 16 * lane + 1024 * j + 8)); }
#pragma unroll
        for (int k = 0; k < 10; ++k) { const size_t row = (size_t)__builtin_amdgcn_readlane(rowi, k);
#pragma unroll
            for (int j = 0; j < 2; ++j) { yv[k][j] = __builtin_nontemporal_load((const v4u*)(Yq + row * D + 16 * lane + 1024 * j)); sc[k][j] = __builtin_nontemporal_load(Ysc + row * 16 + 8 * j + (lane >> 3)); } }
#pragma unroll
        for (int k = 0; k < 10; ++k) asm volatile("" : "+v"(yv[k][0]), "+v"(yv[k][1]), "+v"(sc[k][0]), "+v"(sc[k][1]));
        float v[2][16];
#pragma unroll
        for (int j = 0; j < 2; ++j) { float f0[8], f1[8]; unpack8(pv[j][0], f0); unpack8(pv[j][1], f1);
            const float ss = (((sc[0][j] + sc[1][j]) + (sc[2][j] + sc[3][j])) + ((sc[4][j] + sc[5][j]) + (sc[6][j] + sc[7][j]))) + (sc[8][j] + sc[9][j]);
#pragma unroll
            for (int i = 0; i < 8; ++i) { v[j][i] = ALPHA * f0[i] - 128.f * ss; v[j][8 + i] = ALPHA * f1[i] - 128.f * ss; } }
#pragma unroll
        for (int k = 0; k < 10; ++k)
#pragma unroll
            for (int j = 0; j < 2; ++j) { const float s_ = sc[k][j]; const unsigned q[4] = {yv[k][j].x, yv[k][j].y, yv[k][j].z, yv[k][j].w};
#pragma unroll
                for (int d = 0; d < 4; ++d) { v[j][4 * d + 0] += s_ * (float)(q[d] & 0xffu); v[j][4 * d + 1] += s_ * (float)((q[d] >> 8) & 0xffu); v[j][4 * d + 2] += s_ * (float)((q[d] >> 16) & 0xffu); v[j][4 * d + 3] += s_ * (float)(q[d] >> 24); } }
        float sm = 0.f;
#pragma unroll
        for (int j = 0; j < 2; ++j)
#pragma unroll
            for (int i = 0; i < 16; i += 4) sm += (v[j][i] + v[j][i + 1]) + (v[j][i + 2] + v[j][i + 3]);
        const float mean = wave_sum(sm, lane) * (1.0f / D); float sq = 0.f;
#pragma unroll
        for (int j = 0; j < 2; ++j)
#pragma unroll
            for (int i = 0; i < 16; ++i) { const float d = v[j][i] - mean; sq += d * d; }
        const float rstd = 1.0f / sqrtf(wave_sum(sq, lane) * (1.0f / D) + LN_EPS);
        (void)ST2; (void)Y2;
#pragma unroll
        for (int j = 0; j < 2; ++j)
#pragma unroll
            for (int h = 0; h < 2; ++h) { const int c = 16 * lane + 1024 * j + 8 * h; const float* vv = &v[j][8 * h];
                const f32x4 g0 = *(const f32x4*)(gain + c), g1 = *(const f32x4*)(gain + c + 4), b0 = *(const f32x4*)(bias + c), b1 = *(const f32x4*)(bias + c + 4);
                const f32x4 o0 = ((f32x4){vv[0], vv[1], vv[2], vv[3]} - mean) * rstd * g0 + b0, o1 = ((f32x4){vv[4], vv[5], vv[6], vv[7]} - mean) * rstd * g1 + b1;
                if (last) { *(f32x4*)(OUT + (size_t)t * D + c) = o0; *(f32x4*)(OUT + (size_t)t * D + c + 4) = o1; }
                else { v4u wb; wb.x = pk2(o0[0], o0[1]); wb.y = pk2(o0[2], o0[3]); wb.z = pk2(o1[0], o1[1]); wb.w = pk2(o1[2], o1[3]); *(v4u*)(XBo + (size_t)t * D + c) = wb; } }
    }
}

__device__ __forceinline__ void phase_downproj3(const Frame& F, const bf16* H, const bf16* WD, const bf16* HSp, const bf16* WSD, unsigned char* Yq, float* Ysc, int NT) {
    const LAS int* tpref = (const LAS int*)(F.lds + LDS_TAB); const LAS int* cl = (const LAS int*)(F.lds + LDS_TAB + 512);
    LAS unsigned char* lds = F.lds;
    const int tid = F.tid, lane = F.lane, w = F.wave, fr = lane & 15, fq = lane >> 4;
    unsigned rbB[2], cbB[2];
#pragma unroll
    for (int i = 0; i < 2; ++i) { int R_, C_; g8::stage_rc(tid * 16 + i * 8192, R_, C_); rbB[i] = (unsigned)((R_ & ~31) + g8::perm32(R_ & 31)); cbB[i] = (unsigned)C_ * 2u; }
    const unsigned ldsw = (unsigned)w * 1024u, lbase = (unsigned)(size_t)lds;
    int boffg[4];
#pragma unroll
    for (int g = 0; g < 4; ++g) boffg[g] = g8::lds_byte(32 * g + fr, fq * 8);
    LAS unsigned char* stg = lds + 65536 + w * (32 * 144);
    const int NU = NT * 4;
    const int upos = (F.G % 8) == 0 ? (F.bid & 7) * (F.G >> 3) + (F.bid >> 3) : F.bid;
    int ub = 0;
    int u = (F.G <= NU) ? upos : F.bid; if (u >= NU) return;
#define DP3_UNITINFO(uu, E0, EXP, NV) do { const int tl_ = (uu) >> 2; int e_ = (E0); while (__builtin_amdgcn_readfirstlane(tpref[e_ + 1]) <= tl_) ++e_; EXP = e_; \
        NV = __builtin_amdgcn_readfirstlane(cl[e_]) - (tl_ - __builtin_amdgcn_readfirstlane(tpref[e_])) * 256; } while (0)
#define DP3_GLDS(gsrc, ldsdst) do { unsigned keep_; asm volatile("s_mov_b32 %0, m0\n\ts_mov_b32 m0, %2\n\ts_nop 0\n\tglobal_load_lds_dwordx4 %1, off\n\ts_mov_b32 m0, %0" : "=&s"(keep_) : "v"(gsrc), "s"(ldsdst) : "memory"); } while (0)
#define DP3_STAGE(slot, gb, bs) do { const unsigned v0_ = rbB[0] * (unsigned)(bs) + cbB[0], v1_ = rbB[1] * (unsigned)(bs) + cbB[1]; _Pragma("unroll") for (int kt = 0; kt < 2; ++kt) { \
        DP3_GLDS((const void*)((gb) + kt * 128 + v0_), lbase + (unsigned)((slot) * 32768 + kt * 16384) + ldsw); \
        DP3_GLDS((const void*)((gb) + kt * 128 + v1_), lbase + (unsigned)((slot) * 32768 + kt * 16384) + ldsw + 8192u); } } while (0)
#define DP3_SRC(uu, ee, AB, AS, BB, BS) do { const int tl_ = (uu) >> 2, cu_ = ((uu) & 3) * 512; \
        if ((ee) < 64) { AB = (const char*)(H + (size_t)tl_ * 256 * EDIM); AS = EDIM * 2; BB = (const char*)(WD + (size_t)(ee) * D * EDIM + (size_t)cu_ * EDIM); BS = EDIM * 2; } \
        else { const int t0_ = (tl_ - __builtin_amdgcn_readfirstlane(tpref[ee])) * 256; AB = (const char*)(HSp + (size_t)t0_ * SDIM + ((ee) - 64) * EDIM); AS = SDIM * 2; \
               BB = (const char*)(WSD + (size_t)cu_ * SDIM + ((ee) - 64) * EDIM); BS = SDIM * 2; } } while (0)
    int ecur, nvcur; DP3_UNITINFO(u, 0, ecur, nvcur);
    const char* abc; const char* gbc; int asc, bsc; DP3_SRC(u, ecur, abc, asc, gbc, bsc);
    bf16x8 A[2][4], An[2][4];
    { const char* ap_ = abc + (size_t)(32 * w + fr) * asc + 16 * fq;
#pragma unroll
      for (int m = 0; m < 2; ++m)
#pragma unroll
          for (int kk = 0; kk < 4; ++kk) A[m][kk] = *(const bf16x8*)(ap_ + (size_t)m * 16 * asc + 64 * kk); }
    DP3_STAGE(0, gbc, bsc);
    asm volatile("s_waitcnt vmcnt(0)" ::: "memory");
#pragma unroll 1
    for (;;) {
        int un = u; { const int nb = ub + F.G; if (nb + F.G <= NU) un = nb + upos; else if (nb + F.bid < NU) un = nb + F.bid; if (un != u) ub = nb; }
        int enx, nvnx; DP3_UNITINFO(un, (un > u ? ecur : 0), enx, nvnx);
        const char* abn; const char* gbn; int asn, bsn; DP3_SRC(un, enx, abn, asn, gbn, bsn);
        const int tile = u >> 2, colu = (u & 3) * 512;
        float scq[2][4];
#pragma unroll
        for (int c = 0; c < 4; ++c) {
            if (c == 0) asm volatile("s_waitcnt vmcnt(5)" ::: "memory"); else asm volatile("s_waitcnt vmcnt(4)" ::: "memory");
            __builtin_amdgcn_s_barrier();
            if (c == 3) { const char* ap_ = abn + (size_t)(32 * w + fr) * asn + 16 * fq;
#pragma unroll
                for (int m = 0; m < 2; ++m) { const char* am_ = ap_ + (size_t)m * 16 * asn;
                    asm volatile("global_load_dwordx4 %0, %1, off" : "=&v"(An[m][0]) : "v"(am_) : "memory"); asm volatile("global_load_dwordx4 %0, %1, off offset:64" : "=&v"(An[m][1]) : "v"(am_) : "memory");
                    asm volatile("global_load_dwordx4 %0, %1, off offset:128" : "=&v"(An[m][2]) : "v"(am_) : "memory"); asm volatile("global_load_dwordx4 %0, %1, off offset:192" : "=&v"(An[m][3]) : "v"(am_) : "memory"); } }
            { const char* gnext = (c < 3) ? gbc + (size_t)(c + 1) * 128 * bsc : gbn; const int bnext = (c < 3) ? bsc : bsn; DP3_STAGE((c + 1) & 1, gnext, bnext); }
            __builtin_amdgcn_sched_barrier(0);
            f32x4 acc[2][4][2];
#pragma unroll
            for (int g = 0; g < 4; ++g) { bf16x8 Bf[2][4];
#pragma unroll
                for (int n = 0; n < 2; ++n)
#pragma unroll
                    for (int kk = 0; kk < 4; ++kk) Bf[n][kk] = *(const LAS bf16x8*)(lds + (c & 1) * 32768 + (kk >> 1) * 16384 + boffg[g] + n * 2048 + (kk & 1) * 1024);
#pragma unroll
                for (int m = 0; m < 2; ++m)
#pragma unroll
                    for (int n = 0; n < 2; ++n) { acc[m][g][n] = (f32x4){0.f, 0.f, 0.f, 0.f};
#pragma unroll
                        for (int kk = 0; kk < 4; ++kk) acc[m][g][n] = __builtin_amdgcn_mfma_f32_16x16x32_bf16(Bf[n][kk], A[m][kk], acc[m][g][n], 0, 0, 0); } }
#pragma unroll
            for (int m = 0; m < 2; ++m) {
                float am0 = 0.f, am1 = 0.f;
#pragma unroll
                for (int g = 0; g < 4; ++g)
#pragma unroll
                    for (int n = 0; n < 2; ++n) { am0 = fmaxf(fmaxf(am0, fabsf(acc[m][g][n][0])), fabsf(acc[m][g][n][1])); am1 = fmaxf(fmaxf(am1, fabsf(acc[m][g][n][2])), fabsf(acc[m][g][n][3])); }
                float am = fmaxf(am0, am1);
                am = fmaxf(am, shfl_x(am, 16, lane)); am = fmaxf(am, shfl_x(am, 32, lane));
                am = fminf(am, 3.0e38f);
                const float isc = am > 0.f ? 127.0f * __builtin_amdgcn_rcpf(am) : 0.f;
                scq[m][c] = am * (1.0f / 127.0f);
                const f32x2_t isc2 = (f32x2_t){isc, isc}, mg2 = (f32x2_t){8388736.0f, 8388736.0f};
#pragma unroll
                for (int g = 0; g < 4; ++g) { unsigned qd[2];
#pragma unroll
                    for (int n = 0; n < 2; ++n) {
                        const f32x2_t tl = __builtin_elementwise_fma((f32x2_t){acc[m][g][n][0], acc[m][g][n][1]}, isc2, mg2), th = __builtin_elementwise_fma((f32x2_t){acc[m][g][n][2], acc[m][g][n][3]}, isc2, mg2);
                        const float f0_ = tl.x, f1_ = tl.y, f2_ = th.x, f3_ = th.y;
                        qd[n] = __builtin_amdgcn_perm(__builtin_bit_cast(unsigned, f1_), __builtin_bit_cast(unsigned, f0_), 0x0c0c0400u) | __builtin_amdgcn_perm(__builtin_bit_cast(unsigned, f3_), __builtin_bit_cast(unsigned, f2_), 0x04000c0cu); }
                    *(LAS v2u*)(stg + (16 * m + fr) * 144 + 32 * g + 8 * fq) = (v2u){qd[0], qd[1]}; } }
#pragma unroll
            for (int it = 0; it < 4; ++it) { const int rr = 8 * it + (lane >> 3);
                const v4u o = *(const LAS v4u*)(stg + rr * 144 + (lane & 7) * 16);
                __builtin_nontemporal_store(o, (v4u*)(Yq + (size_t)(tile * 256 + 32 * w + rr) * D + colu + 128 * c + 16 * (lane & 7))); }
            if (c == 3) { const f32x4 so = fq == 0 ? (f32x4){scq[0][0], scq[0][1], scq[0][2], scq[0][3]} : (f32x4){scq[1][0], scq[1][1], scq[1][2], scq[1][3]};
                if (fq < 2) __builtin_nontemporal_store(so, (f32x4*)(Ysc + (size_t)(tile * 256 + 32 * w + 16 * fq + fr) * 16 + (colu >> 7))); }
            __builtin_amdgcn_sched_barrier(0);
        }
        asm volatile("s_waitcnt vmcnt(9)" : "+v"(An[0][0]), "+v"(An[0][1]), "+v"(An[0][2]), "+v"(An[0][3]), "+v"(An[1][0]), "+v"(An[1][1]), "+v"(An[1][2]), "+v"(An[1][3]) :: "memory");
        if (un == u) break;
#pragma unroll
        for (int m = 0; m < 2; ++m)
#pragma unroll
            for (int kk = 0; kk < 4; ++kk) A[m][kk] = An[m][kk];
        u = un; ecur = enx; nvcur = nvnx; abc = abn; asc = asn; gbc = gbn; bsc = bsn;
    }
    asm volatile("s_waitcnt vmcnt(0)" ::: "memory");
#undef DP3_UNITINFO
#undef DP3_STAGE
#undef DP3_GLDS
#undef DP3_SRC
}

enum { PH_PRO = 0, PH_POOL_G1, PH_POOL_P, PH_POOL_G2, PH_POOL_G3, PH_DIL_G1, PH_DIL_ATT, PH_DIL_CMB, PH_DIL_G2, PH_CONV_G1, PH_CONV_E, PH_CONV_G2, PH_MOE1, PH_MOE2, PH_MOE3, PH_MOE4, PH_COUNT };

template <int PH>
__device__ __forceinline__ void run_phase(const Frame& Fin, const Args& args_, const int L) {
    Frame F = Fin; { int w_ = Fin.wave, l_; asm volatile("" : "+s"(w_)); asm volatile("v_mbcnt_lo_u32_b32 %0, -1, 0\n\tv_mbcnt_hi_u32_b32 %0, -1, %0" : "=v"(l_)); F.wave = w_; F.lane = l_; F.tid = w_ * 64 + l_; }
    unsigned char* ws; { GAS unsigned char* wsg = (GAS unsigned char*)Fin.ws; asm volatile("" : "+s"(wsg)); ws = (unsigned char*)wsg; } F.ws = ws; F.ctl = (unsigned*)(ws + WS_CTL);
    KP kp = (KP)__builtin_amdgcn_kernarg_segment_ptr(); asm volatile("" : "+s"(kp)); (void)args_;
    { unsigned l_ = (unsigned)(size_t)Fin.lds; asm volatile("" : "+s"(l_)); F.lds = (LAS unsigned char*)(size_t)l_; }
    LAS unsigned char* ring = F.lds; int c = (int)blockIdx.x; { int g_ = Fin.G; asm volatile("" : "+s"(c), "+s"(g_)); F.G = g_; F.bid = c; }
    const float* xres = ain(kp, IN_X);
    const float* st2 = (const float*)(ws + WS_ST2); float* pstp = (float*)(ws + WS_PST);
    const float* g2p = ain(kp, IN_LNG) + (size_t)((L > 0 ? L - 1 : 0) * 2 + 1) * D; const float* b2p = ain(kp, IN_LNB) + (size_t)((L > 0 ? L - 1 : 0) * 2 + 1) * D;
    const bf16* xb = (const bf16*)(ws + WS_XB);
    bf16* yf = (bf16*)(ws + WS_YF);
    unsigned char* big = ws + WS_BIG;
    const int ia = L / 3;
    if constexpr (PH == PH_PRO) { phase_prologue(F, kp); }
    if constexpr (PH == PH_POOL_G1) { g8::DenseSched S; S.init(xb, (const bf16*)(ws + WS_W_POOL_IN) + (size_t)ia * D * D, T, D, D, D, F.G, c);
        g8::EpiBf16 E{(bf16*)(big + BG_U), D, 0}; g8::gemm_phase<g8::EpiBf16, g8::DenseSched, false>(ring, F.tid, D, D, D, S, E); }
    if constexpr (PH == PH_POOL_P) { phase_pool(F, (const bf16*)(big + BG_U), (bf16*)(big + BG_PL)); }
    if constexpr (PH == PH_POOL_G2) { g8::DenseSched S; S.init((const bf16*)(big + BG_PL), (const bf16*)(ws + WS_W_POOL_G) + (size_t)ia * D * 512, T, D, D, 512, F.G, c); S.agrp_shift = 1; S.agrp_stride = 512 * 2;
        g8::EpiScaleBf16 E{(bf16*)(big + BG_MX), D, ain(kp, IN_PSC) + (size_t)ia * D}; g8::gemm_phase<g8::EpiScaleBf16, g8::DenseSched, false>(ring, F.tid, 512, D, 512, S, E); }
    if constexpr (PH == PH_POOL_G3) { g8::DenseSched S; S.init((const bf16*)(big + BG_MX), (const bf16*)(ws + WS_W_POOL_OUT) + (size_t)ia * D * D, T, D, D, D, F.G, c);
        g8::EpiResidLN E{xres, xb, st2, g2p, b2p, yf, pstp, 2}; g8::gemm_phase<g8::EpiResidLN, g8::DenseSched, false>(ring, F.tid, D, D, D, S, E); }
    if constexpr (PH == PH_DIL_G1) { g8::DenseSched S; S.init(xb, (const bf16*)(ws + WS_W_DIL_QKV), T, QKVC, D, D, F.G, c);
        g8::EpiBf16 E{(bf16*)(big + BG_QKV), QKVC, 1}; g8::gemm_phase<g8::EpiBf16, g8::DenseSched, false>(ring, F.tid, D, D, D, S, E); }
    if constexpr (PH == PH_DIL_ATT) { phase_attn(F, (const bf16*)(big + BG_QKV), ain(kp, IN_RELB), (bf16*)(big + BG_OG), (float*)(big + BG_LSE)); }
    if constexpr (PH == PH_DIL_CMB) { phase_combine(F, (const bf16*)(big + BG_OG), (const float*)(big + BG_LSE), (bf16*)(big + BG_O)); }
    if constexpr (PH == PH_DIL_G2) { g8::DenseSched S; S.init((const bf16*)(big + BG_O), (const bf16*)(ws + WS_W_DIL_OUT), T, D, DILW, DILW, F.G, c);
        g8::EpiResidLN E{xres, xb, st2, g2p, b2p, yf, pstp, 2}; g8::gemm_phase<g8::EpiResidLN, g8::DenseSched, false>(ring, F.tid, DILW, DILW, DILW, S, E); }
    if constexpr (PH == PH_CONV_G1) { g8::DenseSched S; S.init(xb, (const bf16*)(ws + WS_W_CONV_IN), T, 3 * D, D, D, F.G, c);
        g8::EpiConvIn E{(bf16*)(big + BG_UC), (bf16*)(big + BG_BG)}; g8::gemm_phase<g8::EpiConvIn, g8::DenseSched, false>(ring, F.tid, D, D, D, S, E); }
    if constexpr (PH == PH_CONV_E) { phase_conv(F, (const bf16*)(big + BG_UC), (const bf16*)(big + BG_BG), ain(kp, IN_CW), (bf16*)(big + BG_Z)); }
    if constexpr (PH == PH_CONV_G2) { g8::DenseSched S; S.init((const bf16*)(big + BG_Z), (const bf16*)(ws + WS_W_CONV_OUT), T, D, D, D, F.G, c);
        g8::EpiResidLN E{xres, xb, st2, g2p, b2p, yf, pstp, 2}; g8::gemm_phase<g8::EpiResidLN, g8::DenseSched, false>(ring, F.tid, D, D, D, S, E); }
    unsigned* cnt = F.ctl + CW_CNT + L * 64 * 16;
    float* x1f = (float*)(ws + WS_X1F); bf16* x1b = (bf16*)(ws + WS_X1B);
    int* ltok = (int*)(ws + WS_LTOK); float* lgate = (float*)(ws + WS_LGATE); int* eidx = (int*)(ws + WS_EIDX); int* inv = (int*)(ws + WS_INV);
    bf16* HB = (bf16*)(ws + WS_HB); bf16* HS = (bf16*)(ws + WS_HS); bf16* Yr = (bf16*)(ws + WS_BIG);
    if constexpr (PH == PH_MOE1) {
        const float* g1 = ain(kp, IN_LNG) + (size_t)(L * 2 + 0) * D; const float* b1 = ain(kp, IN_LNB) + (size_t)(L * 2 + 0) * D;
        phase_moe1n(F, yf, pstp, g1, b1, (const bf16*)(ws + WS_RWH) + (size_t)L * NEXP * D, (const bf16*)(ws + WS_RWL) + (size_t)L * NEXP * D, ain(kp, IN_RB) + (size_t)L * NEXP,
                    x1b, (float*)(ws + WS_ST1), cnt, ltok, lgate, eidx, inv); }
    if constexpr (PH == PH_MOE2) {
        const int NT = build_tiles(F, cnt);
        { g8::ExpertSched<1, true> S; S.tpref = (const LAS int*)(F.lds + LDS_TAB); S.cnt = (const LAS int*)(F.lds + LDS_TAB + 512); S.A = (const char*)x1b; S.B = (const char*)((const bf16*)(ws + WS_W_EX_GU) + (size_t)L * 64 * 256 * D);
          S.tok = ltok; S.b_exp = (size_t)256 * D * 2; S.b_tile = 0; S.a_tile = 0; S.NU = NT; S.G = F.G; S.c = c;
          g8::EpiExpertGU E{HB}; g8::gemm_phase<g8::EpiExpertGU, g8::ExpertSched<1, true>, true>(ring, F.tid, D, D, D, S, E); }
        { const int rot = (c - (NT % F.G) + F.G) % F.G;
          g8::DenseSched S; S.init(x1b, (const bf16*)(ws + WS_W_SH_GU) + (size_t)L * 512 * D, T, 512, D, D, F.G, rot);
          int t2 = F.tid; asm volatile("" : "+v"(t2));
          g8::EpiSharedGU E{HS}; g8::gemm_phase<g8::EpiSharedGU, g8::DenseSched, false>(ring, t2, D, D, D, S, E); } }
    if constexpr (PH == PH_MOE3) {
        const float* g1 = ain(kp, IN_LNG) + (size_t)(L * 2 + 0) * D; const float* b1 = ain(kp, IN_LNB) + (size_t)(L * 2 + 0) * D;
        const int NT = build_tiles(F, cnt);
        __syncthreads();
        phase_downproj3(F, HB, (const bf16*)(ws + WS_W_EX_D) + (size_t)L * 64 * D * EDIM, HS, (const bf16*)(ws + WS_W_SH_D) + (size_t)L * D * SDIM, (unsigned char*)Yr, (float*)(ws + WS_BIG + BG_YSC), NT + 2 * (T / 256));
        (void)g1; (void)b1; }
    if constexpr (PH == PH_MOE4) { (void)build_tiles(F, cnt);
        const float* g2 = ain(kp, IN_LNG) + (size_t)(L * 2 + 1) * D; const float* b2 = ain(kp, IN_LNB) + (size_t)(L * 2 + 1) * D;
        phase_moe4q(F, x1b, (bf16*)(ws + WS_Y2F), (const unsigned char*)Yr, (const float*)(ws + WS_BIG + BG_YSC), eidx, inv, g2, b2, (float*)(ws + WS_ST2), (bf16*)(ws + WS_XB), aout(kp), L == DEPTH - 1); }
}
__device__ __forceinline__ void make_frame(Frame& F, const Args& args) {
    extern __shared__ __attribute__((aligned(16))) unsigned char lds_raw[];
    F.lds = (LAS unsigned char*)lds_raw; F.ws = args.ws; F.ctl = (unsigned*)(args.ws + WS_CTL);
    F.tid = threadIdx.x; F.lane = F.tid & 63; F.wave = __builtin_amdgcn_readfirstlane(F.tid >> 6); F.G = gridDim.x; F.bid = blockIdx.x;
}
template <int PH> __global__ void __launch_bounds__(512, 2) k_phase(Args args, int L) {
    Frame F; make_frame(F, args);
    run_phase<PH>(F, args, L);
}

#ifndef MK_NOINLINE
#define MK_NOINLINE 0
#endif
#if MK_NOINLINE
template <int PH> __device__ __noinline__ void call_phase_ni(const int L) {
    Args dummy{}; Frame F;
    KP kp = (KP)__builtin_amdgcn_kernarg_segment_ptr();
    extern __shared__ __attribute__((aligned(16))) unsigned char lds_raw[];
    F.lds = (LAS unsigned char*)lds_raw; F.ws = (unsigned char*)((GAS unsigned char* const CAS*)kp)[20]; F.ctl = (unsigned*)(F.ws + WS_CTL);
    F.tid = threadIdx.x; F.lane = F.tid & 63; F.wave = __builtin_amdgcn_readfirstlane(F.tid >> 6); F.G = gridDim.x; F.bid = blockIdx.x;
    run_phase<PH>(F, dummy, L);
}
template <int PH> __device__ __forceinline__ void call_phase(const Frame& F, const Args& args, const int L) { call_phase_ni<PH>(L); }
#else
template <int PH> __device__ __forceinline__ void call_phase(const Frame& F, const Args& args, const int L) { asm volatile("; PHASE_BEGIN %0" :: "n"(PH)); run_phase<PH>(F, args, L); asm volatile("; PHASE_END %0" :: "n"(PH)); }
#endif
__global__ void __launch_bounds__(512, 2) fwd_all(Args args) {
    Frame F; make_frame(F, args);
    volatile LAS unsigned* misc = (volatile LAS unsigned*)(F.lds + LDS_MISC);
    if (F.tid < 4) misc[F.tid] = 0u;
    __syncthreads();
    const int lo = args.ph_lo, hi = args.ph_hi;
    XcdBarrier bar; bar.bar = F.ctl + CW_BAR; bar.x = 0; bar.st = misc;
    if (hi - lo > 1) bar = xcd_barrier_post(F.ctl + CW_BAR, misc);
    int pc = 0;
#ifndef MK_DUP_MASK
#define MK_DUP_MASK 0
#endif
#if MK_DUP_MASK
#define STEP(PH, Lx) do { if (pc >= lo && pc < hi) { int nrep_ = ((MK_DUP_MASK >> (PH)) & 1) ? 2 : 1; asm volatile("" : "+s"(nrep_)); _Pragma("unroll 1") for (int r_ = 0; r_ < nrep_; ++r_) { call_phase<PH>(F, args, Lx); if (r_ + 1 < nrep_ || pc + 1 < hi) xcd_barrier(bar); } } ++pc; } while (0)
#else
#define STEP(PH, Lx) do { if (pc >= lo && pc < hi) { call_phase<PH>(F, args, Lx); if (pc + 1 < hi) xcd_barrier(bar); } ++pc; } while (0)
#endif
    STEP(PH_PRO, 0);
#pragma unroll 1
    for (int L = 0; L < DEPTH; ++L) {
        const int kind = L % 3;
        if (kind == 0) { STEP(PH_POOL_G1, L); STEP(PH_POOL_P, L); STEP(PH_POOL_G2, L); STEP(PH_POOL_G3, L); }
        else if (kind == 1) { STEP(PH_DIL_G1, L); STEP(PH_DIL_ATT, L); STEP(PH_DIL_CMB, L); STEP(PH_DIL_G2, L); }
        else { STEP(PH_CONV_G1, L); STEP(PH_CONV_E, L); STEP(PH_CONV_G2, L); }
        STEP(PH_MOE1, L); STEP(PH_MOE2, L); STEP(PH_MOE3, L); STEP(PH_MOE4, L);
    }
#undef STEP
}
constexpr int N_STEPS = 1 + 2 * 8 + 8 + 7;

template <int PH> static void launch_phase(const Args& a, int L, int grid, hipStream_t stream) {
    static bool attr = false;
    if (!attr) { (void)hipFuncSetAttribute((const void*)k_phase<PH>, hipFuncAttributeMaxDynamicSharedMemorySize, LDS_BYTES); attr = true; }
    hipLaunchKernelGGL(k_phase<PH>, dim3(grid), dim3(512), LDS_BYTES, stream, a, L);
}
extern "C" void kernel_launch(void* const* d_in, const int* in_sizes, int n_in, void* d_out, int out_size, void* d_ws, size_t ws_size, hipStream_t stream) {
    static int grid = 0;
    if (grid == 0) {
        if (n_in != 19 || out_size != T * D || ws_size < WS_END) { fprintf(stderr, "kernel_launch: unexpected shapes (n_in %d out %d ws %zu need %zu)\n", n_in, out_size, ws_size, (size_t)WS_END); grid = -1; return; }
        int dev = 0, cus = 0;
        if (hipGetDevice(&dev) != hipSuccess || hipDeviceGetAttribute(&cus, hipDeviceAttributeMultiprocessorCount, dev) != hipSuccess) { grid = -1; return; }
#if MK_ONE_LAUNCH
        if (hipFuncSetAttribute((const void*)fwd_all, hipFuncAttributeMaxDynamicSharedMemorySize, LDS_BYTES) != hipSuccess) { fprintf(stderr, "kernel_launch: hipFuncSetAttribute failed\n"); grid = -1; return; }
        int per_cu = 0;
        if (hipOccupancyMaxActiveBlocksPerMultiprocessor(&per_cu, (const void*)fwd_all, 512, LDS_BYTES) != hipSuccess || per_cu < 1) { fprintf(stderr, "kernel_launch: note: occupancy query reports %d blocks per CU\n", per_cu); (void)hipGetLastError(); }
#endif
        grid = cus;
    }
    if (grid < 0) return;
    (void)hipMemsetAsync((char*)d_ws + WS_CTL, 0, CTL_ZERO_BYTES, stream);
    Args a{};
    for (int i = 0; i < 19; ++i) a.in[i] = (const float*)d_in[i];
    a.out = (float*)d_out; a.ws = (unsigned char*)d_ws; a.ph_lo = 0; a.ph_hi = 0;
#if MK_ONE_LAUNCH
#ifdef MK_SPLIT
    for (int p = 0; p < N_STEPS; ++p) { a.ph_lo = p; a.ph_hi = p + 1; hipLaunchKernelGGL(fwd_all, dim3(grid), dim3(512), LDS_BYTES, stream, a); }
#else
    a.ph_lo = 0; a.ph_hi = N_STEPS;
    hipLaunchKernelGGL(fwd_all, dim3(grid), dim3(512), LDS_BYTES, stream, a);
#endif
#elif defined(MK_HYBRID_MASK)
    {
        static bool attr2 = false; if (!attr2) { (void)hipFuncSetAttribute((const void*)fwd_all, hipFuncAttributeMaxDynamicSharedMemorySize, LDS_BYTES); attr2 = true; }
        int pc = 0;
#define HSTEP(PH, Lx) do { if ((MK_HYBRID_MASK >> (PH)) & 1) { a.ph_lo = pc; a.ph_hi = pc + 1; hipLaunchKernelGGL(fwd_all, dim3(grid), dim3(512), LDS_BYTES, stream, a); } else { a.ph_lo = 0; a.ph_hi = 0; launch_phase<PH>(a, Lx, grid, stream); } ++pc; } while (0)
        HSTEP(PH_PRO, 0);
        for (int L = 0; L < DEPTH; ++L) {
            const int kind = L % 3;
            if (kind == 0) { HSTEP(PH_POOL_G1, L); HSTEP(PH_POOL_P, L); HSTEP(PH_POOL_G2, L); HSTEP(PH_POOL_G3, L); }
            else if (kind == 1) { HSTEP(PH_DIL_G1, L); HSTEP(PH_DIL_ATT, L); HSTEP(PH_DIL_CMB, L); HSTEP(PH_DIL_G2, L); }
            else { HSTEP(PH_CONV_G1, L); HSTEP(PH_CONV_E, L); HSTEP(PH_CONV_G2, L); }
            HSTEP(PH_MOE1, L); HSTEP(PH_MOE2, L); HSTEP(PH_MOE3, L); HSTEP(PH_MOE4, L);
        }
#undef HSTEP
    }
#else
    launch_phase<PH_PRO>(a, 0, grid, stream);
    for (int L = 0; L < DEPTH; ++L) {
        const int kind = L % 3;
        if (kind == 0) { launch_phase<PH_POOL_G1>(a, L, grid, stream); launch_phase<PH_POOL_P>(a, L, grid, stream); launch_phase<PH_POOL_G2>(a, L, grid, stream); launch_phase<PH_POOL_G3>(a, L, grid, stream); }
        else if (kind == 1) { launch_phase<PH_DIL_G1>(a, L, grid, stream); launch_phase<PH_DIL_ATT>(a, L, grid, stream); launch_phase<PH_DIL_CMB>(a, L, grid, stream); launch_phase<PH_DIL_G2>(a, L, grid, stream); }
        else { launch_phase<PH_CONV_G1>(a, L, grid, stream); launch_phase<PH_CONV_E>(a, L, grid, stream); launch_phase<PH_CONV_G2>(a, L, grid, stream); }
        launch_phase<PH_MOE1>(a, L, grid, stream); launch_phase<PH_MOE2>(a, L, grid, stream); launch_phase<PH_MOE3>(a, L, grid, stream); launch_phase<PH_MOE4>(a, L, grid, stream);
    }
#endif
}
```

```cpp
#include <hip/hip_runtime.h>
#include <cstdio>
#include <cstdint>

#ifndef MK_ONE_LAUNCH
#define MK_ONE_LAUNCH 1
#endif

#define GAS __attribute__((address_space(1)))
#define LAS __attribute__((address_space(3)))
typedef unsigned short bf16;
typedef unsigned v4u __attribute__((ext_vector_type(4)));
typedef unsigned v2u __attribute__((ext_vector_type(2)));
typedef float f32x4 __attribute__((ext_vector_type(4)));
typedef float f32x2 __attribute__((ext_vector_type(2)));
typedef short bf16x8 __attribute__((ext_vector_type(8)));
typedef short s16x4 __attribute__((ext_vector_type(4)));

constexpr int NBATCH = 8, SEQ = 2048, D = 2048, T = NBATCH * SEQ, DEPTH = 4;
constexpr int NEXP = 64, TOPK = 8, EDIM = 128, SDIM = 256;
constexpr int QKVC = 4608, DILW = 512;
constexpr float ALPHA = 1.681792830507429f;
constexpr float LN_EPS = 1e-5f;
constexpr int CAP = 16384;
constexpr int HROWS = T * TOPK + NEXP * 256;

constexpr size_t MiB = 1u << 20;
constexpr size_t WS_CTL = 0, CTL_ZERO_BYTES = 1 * MiB;
constexpr size_t WS_W_POOL_IN = 1 * MiB;
constexpr size_t WS_W_POOL_G = WS_W_POOL_IN + 16 * MiB;
constexpr size_t WS_W_POOL_OUT = WS_W_POOL_G + 4 * MiB;
constexpr size_t WS_W_DIL_QKV = WS_W_POOL_OUT + 16 * MiB;
constexpr size_t WS_W_DIL_OUT = WS_W_DIL_QKV + 18 * MiB;
constexpr size_t WS_W_CONV_IN = WS_W_DIL_OUT + 2 * MiB;
constexpr size_t WS_W_CONV_OUT = WS_W_CONV_IN + 24 * MiB;
constexpr size_t WS_W_SH_GU = WS_W_CONV_OUT + 8 * MiB;
constexpr size_t WS_W_SH_D = WS_W_SH_GU + 8 * MiB;
constexpr size_t WS_W_EX_GU = WS_W_SH_D + 4 * MiB;
constexpr size_t WS_W_EX_D = WS_W_EX_GU + 256 * MiB;
constexpr size_t WS_XF = WS_W_EX_D + 256 * MiB;
constexpr size_t WS_YF = WS_XF + 128 * MiB;
constexpr size_t WS_X1F = WS_YF + 128 * MiB;
constexpr size_t WS_XB = WS_X1F + 128 * MiB;
constexpr size_t WS_X1B = WS_XB + 64 * MiB;
constexpr size_t WS_HB = WS_X1B + 64 * MiB;
constexpr size_t WS_HS = WS_HB + 72 * MiB;
constexpr size_t WS_LTOK = WS_HS + 8 * MiB;
constexpr size_t WS_LGATE = WS_LTOK + 4 * MiB;
constexpr size_t WS_EIDX = WS_LGATE + 4 * MiB;
constexpr size_t WS_INV = WS_EIDX + 1 * MiB;
constexpr size_t WS_BIG = WS_INV + 1 * MiB;
constexpr size_t WS_PST = WS_BIG + 608 * MiB;
constexpr size_t WS_ST1 = WS_PST + 4 * MiB;
constexpr size_t WS_ST2 = WS_ST1 + 1 * MiB;
constexpr size_t WS_RWH = WS_ST2 + 1 * MiB;
constexpr size_t WS_RWL = WS_RWH + 1 * MiB;
constexpr size_t WS_PST2 = WS_RWL + 1 * MiB;
constexpr size_t WS_END = WS_PST2 + 8 * MiB;
constexpr size_t WS_Y2F = WS_X1F;
constexpr size_t BG_U = 0, BG_PL = 64 * MiB, BG_MX = 128 * MiB;
constexpr size_t BG_QKV = 0, BG_OG = 144 * MiB, BG_LSE = 192 * MiB, BG_O = 194 * MiB;
constexpr size_t BG_UC = 0, BG_BG = 64 * MiB, BG_Z = 128 * MiB;
constexpr size_t BG_YSC = 400 * MiB;
constexpr int CW_BAR = 4096;
constexpr int CW_CNT = 16384;

constexpr int RING_BYTES = 131072;
constexpr int LDS_TAB = RING_BYTES;
constexpr int LDS_STASH = RING_BYTES + 1024;
constexpr int LDS_BYTES = 163840;
constexpr int LDS_MISC = LDS_BYTES - 1024;

typedef __bf16 bf16x2_t __attribute__((ext_vector_type(2)));
typedef float f32x2_t __attribute__((ext_vector_type(2)));
__device__ __forceinline__ unsigned cvt_pk_bf16(float lo, float hi) { const bf16x2_t r = __builtin_convertvector((f32x2_t){lo, hi}, bf16x2_t); return __builtin_bit_cast(unsigned, r); }
__device__ __forceinline__ unsigned f2bf(float f) { unsigned u = __builtin_bit_cast(unsigned, f); return (u + 0x7fffu + ((u >> 16) & 1u)) >> 16; }
__device__ __forceinline__ unsigned pk2(float lo, float hi) { return f2bf(lo) | (f2bf(hi) << 16); }
__device__ __forceinline__ float bflo(unsigned w) { return __builtin_bit_cast(float, w << 16); }
__device__ __forceinline__ float bfhi(unsigned w) { return __builtin_bit_cast(float, w & 0xffff0000u); }
__device__ __forceinline__ float shfl_from(float v, int src) { return __builtin_bit_cast(float, __builtin_amdgcn_ds_bpermute(src << 2, __builtin_bit_cast(int, v))); }
__device__ __forceinline__ float shfl_x(float v, int o, int lane) { return shfl_from(v, lane ^ o); }
__device__ __forceinline__ float wave_sum(float v, int lane) {
#pragma unroll
    for (int o = 1; o < 64; o <<= 1) v += shfl_x(v, o, lane);
    return v;
}
#define LDS_WAIT() asm volatile("s_waitcnt lgkmcnt(0)" ::: "memory")
#define VM_WAIT() asm volatile("s_waitcnt vmcnt(0)" ::: "memory")

#define XB_TMO      128
#define XB_XCNT(j)  (256  + 64 * (j))
#define XB_XSUB(j)  (1280 + 64 * (j))
#define XB_XGEN(j)  (2304 + 64 * (j))
#define XB_TOP      3328
#define XB_TOPGEN   3392
#define XCD_BAR_WORDS 3456
#define XB_SPIN_CAP (1u << 18)

__device__ __forceinline__ unsigned xb_ld(unsigned* p)              { return __hip_atomic_load(p, __ATOMIC_RELAXED, __HIP_MEMORY_SCOPE_AGENT); }
__device__ __forceinline__ unsigned xb_add(unsigned* p, unsigned v) { return __hip_atomic_fetch_add(p, v, __ATOMIC_RELAXED, __HIP_MEMORY_SCOPE_AGENT); }
__device__ __forceinline__ unsigned xb_xcc_id() { return (unsigned)__builtin_amdgcn_s_getreg((3 << 11) | 20) & 0xFu; }
#define XB_SPIN(cond, bar) do { unsigned _sp = 0; while (cond) { __builtin_amdgcn_s_sleep(1); \
    if ((++_sp & 255u) == 0u) { if (xb_ld(&(bar)[XB_TMO])) break; if (_sp > XB_SPIN_CAP) { atomicAdd(&(bar)[XB_TMO], 1u); break; } } } } while (0)

struct XcdBarrier {
    unsigned* bar; unsigned x;
    volatile LAS unsigned* st;
};

__device__ __forceinline__ XcdBarrier xcd_barrier_post(unsigned* bar, volatile LAS unsigned* st) {
    XcdBarrier b; b.bar = bar; b.x = xb_xcc_id(); b.st = st;
    if (threadIdx.x == 0) (void)xb_add(&bar[XB_XCNT(b.x)], 1u);
    return b;
}
__device__ __forceinline__ void xcd_barrier_complete(unsigned* bar, unsigned x, unsigned& nloc, unsigned& nx) {
    const unsigned G = gridDim.x * gridDim.y * gridDim.z;
    unsigned sum, cnt, mine, sp = 0u;
    for (;;) {
        sum = 0u; cnt = 0u; mine = 0u;
#pragma unroll
        for (unsigned j = 0; j < 16; ++j) { const unsigned c = xb_ld(&bar[XB_XCNT(j)]); sum += c; cnt += (c > 0u) ? 1u : 0u; mine = (j == x) ? c : mine; }
        if (sum == G) break;
        __builtin_amdgcn_s_sleep(1);
        if ((++sp & 255u) == 0u) { if (xb_ld(&bar[XB_TMO])) break; if (sp > XB_SPIN_CAP) { atomicAdd(&bar[XB_TMO], 1u); break; } }
    }
    nloc = mine > 0u ? mine : 1u; nx = cnt > 0u ? cnt : 1u;
}

__device__ __forceinline__ void xcd_barrier(const XcdBarrier& b) {
    asm volatile("s_waitcnt vmcnt(0)" ::: "memory");
    __syncthreads();
    if (threadIdx.x == 0) {
        unsigned* bar; unsigned bx = b.x; { GAS unsigned* bg = (GAS unsigned*)b.bar; asm volatile("" : "+s"(bg), "+s"(bx)); bar = (unsigned*)bg; }
        __builtin_amdgcn_s_waitcnt(0);
        unsigned nloc = b.st[0], nx = b.st[1];
        if (nloc == 0u) { xcd_barrier_complete(bar, bx, nloc, nx); b.st[0] = nloc; b.st[1] = nx; }
        const unsigned old = xb_add(&bar[XB_XSUB(bx)], 1u);
        const unsigned gen = old / nloc;
        if (old + 1u == (gen + 1u) * nloc) {
            __builtin_amdgcn_fence(__ATOMIC_RELEASE, "agent");
            asm volatile("s_waitcnt vmcnt(0)" ::: "memory");
            const unsigned og = xb_add(&bar[XB_TOP], 1u);
            const unsigned tg = og / nx;
            if (og + 1u == (tg + 1u) * nx) xb_add(&bar[XB_TOPGEN], 1u);
            else XB_SPIN(xb_ld(&bar[XB_TOPGEN]) == tg, bar);
            __builtin_amdgcn_fence(__ATOMIC_ACQUIRE, "agent");
            xb_add(&bar[XB_XGEN(bx)], 1u);
            asm volatile("s_waitcnt vmcnt(0)" ::: "memory");
        } else {
            XB_SPIN(xb_ld(&bar[XB_XGEN(bx)]) == gen, bar);
            __builtin_amdgcn_fence(__ATOMIC_ACQUIRE, "agent");
            asm volatile("s_waitcnt vmcnt(0)" ::: "memory");
        }
    }
    __syncthreads();
}

namespace g8 {
constexpr int BM = 256, BK = 64, HALF = 128, HTB = HALF * BK * 2, STAGE_BYTES = 8 * HTB, NXCD = 8, WGM = 8;
__host__ __device__ __forceinline__ int lds_byte(int r, int c) { const int st = (r >> 4) * 2 + (c >> 5), rr = r & 15, cc = c & 31, ob = rr * 64 + cc * 2; return st * 1024 + (ob ^ (((ob >> 9) & 1) << 5)); }
__host__ __device__ __forceinline__ void stage_rc(int b, int& R, int& C) { const int st = b / 1024, sb = b % 1024, swz = sb ^ (((sb >> 9) & 1) << 5); R = (st >> 1) * 16 + swz / 64; C = (st & 1) * 32 + (swz % 64) / 2; }
__host__ __device__ __forceinline__ int perm32(int rho) { const int n = rho >> 4, i = rho & 15; return 8 * (i >> 2) + 4 * n + (i & 3); }

struct Unit { const char* A; const char* B; const int* rows; int pm, pn, nvalid, aux; };

template <class Epi, class Sched, bool GATHER>
__device__ __forceinline__ void gemm_phase(LAS unsigned char* lds, const int tid_in, const int K, const int lda, const int ldb, const Sched& S, const Epi& E) {
    const int tid = tid_in, wid = __builtin_amdgcn_readfirstlane(tid >> 6), lane = tid & 63, wr = wid >> 2, wc = wid & 3, fr = lane & 15, fq = lane >> 4;
    const int nt = K / BK;
    unsigned voffB[2];
#pragma unroll
    for (int i = 0; i < 2; ++i) { int R_, C_; stage_rc(tid * 16 + i * 8192, R_, C_); const int Rb = Epi::PERM ? ((R_ & ~31) + perm32(R_ & 31)) : R_; voffB[i] = (unsigned)(Rb * ldb + C_) * 2u; }
    LAS v4u* stash = (LAS v4u*)(lds + (LDS_STASH - 0) + tid * 16);
    const size_t kstep = (size_t)(BK * 2);
    const size_t hstepB = (size_t)HALF * ldb * 2;
    const unsigned ldsw = (unsigned)wid * 1024u;
    const int aoff = lds_byte(wr * 64 + fr, fq * 8), boff = lds_byte(wc * 32 + fr, fq * 8);
#define G8_SA(b, h) (((b) * 2 + (h)) * HTB)
#define G8_SB(b, h) ((4 + (b) * 2 + (h)) * HTB)
#define G8_STAGE2(bufoff, gbase, v0, v1) do { \
        __builtin_amdgcn_global_load_lds((const unsigned*)((const char*)(gbase) + (v0)), (LAS unsigned*)(lds + (bufoff) + ldsw), 16, 0, 0); \
        __builtin_amdgcn_global_load_lds((const unsigned*)((const char*)(gbase) + (v1)), (LAS unsigned*)(lds + (bufoff) + ldsw + 8192), 16, 0, 0); } while (0)
#define G8_STAGEB(bufoff, gbase) G8_STAGE2(bufoff, gbase, voffB[0], voffB[1])
#define G8_LDA(dst, b, h) do { _Pragma("unroll") for (int m = 0; m < 4; ++m) _Pragma("unroll") for (int k = 0; k < 2; ++k) dst[m][k] = *(const LAS bf16x8*)(lds + G8_SA(b, h) + aoff + m * 2048 + k * 1024); } while (0)
#define G8_LDB(dst, b, h) do { _Pragma("unroll") for (int n = 0; n < 2; ++n) _Pragma("unroll") for (int k = 0; k < 2; ++k) dst[n][k] = *(const LAS bf16x8*)(lds + G8_SB(b, h) + boff + n * 2048 + k * 1024); } while (0)
#define G8_MMA(ai, bj, At, Bt) do { __builtin_amdgcn_s_setprio(1); _Pragma("unroll") for (int m = 0; m < 4; ++m) _Pragma("unroll") for (int n = 0; n < 2; ++n) _Pragma("unroll") for (int k = 0; k < 2; ++k) \
        acc[ai][bj][m][n] = __builtin_amdgcn_mfma_f32_16x16x32_bf16(Bt[n][k], At[m][k], acc[ai][bj][m][n], 0, 0, 0); __builtin_amdgcn_s_setprio(0); } while (0)
#define G8_WAIT_V(n) asm volatile("s_waitcnt vmcnt(" #n ")" ::: "memory")
#define G8_WAIT_L(n) asm volatile("s_waitcnt lgkmcnt(" #n ")" ::: "memory")
#define G8_BAR __builtin_amdgcn_s_barrier()
#define G8_SCHED __builtin_amdgcn_sched_barrier(0)
#define G8_SETVA(dst, u) do { int _t2 = tid; if (GATHER) asm volatile("" : "+v"(_t2)); _Pragma("unroll") for (int _h = 0; _h < 2; ++_h) _Pragma("unroll") for (int _i = 0; _i < 2; ++_i) { \
        int _R, _C; stage_rc(_t2 * 16 + _i * 8192, _R, _C); \
        const unsigned _rl = (unsigned)(_h * HALF + _R); unsigned _row = _rl; \
        if (GATHER) { _row = 0u; if (_rl < (unsigned)(u).nvalid) _row = (unsigned)(u).rows[_rl] >> 3; } \
        dst[_h][_i] = (_row * (unsigned)lda + (unsigned)_C) * 2u; } } while (0)
    Unit cur, nxt; int ui = 0;
    if (!S.next(0, cur)) return;
    f32x4 acc[2][2][4][2];
#pragma unroll
    for (int a = 0; a < 2; ++a)
#pragma unroll
        for (int b = 0; b < 2; ++b)
#pragma unroll
            for (int m = 0; m < 4; ++m)
#pragma unroll
                for (int n = 0; n < 2; ++n) acc[a][b][m][n] = (f32x4){0.f, 0.f, 0.f, 0.f};
    bf16x8 At[4][2], B0[2][2], B1[2][2];
    unsigned vAc[2][2]; unsigned xl00 = 0, xl01 = 0, xl10 = 0, xl11 = 0;
    G8_SETVA(vAc, cur);
    const char* cA = cur.A; const char* cB = cur.B;
    G8_STAGEB(G8_SB(0, 0), cB); G8_STAGEB(G8_SB(0, 1), cB + hstepB); G8_STAGE2(G8_SA(0, 0), cA, vAc[0][0], vAc[0][1]); G8_STAGE2(G8_SA(0, 1), cA, vAc[1][0], vAc[1][1]);
    if (wr == 1) G8_BAR;
    G8_WAIT_V(2); G8_BAR;
    G8_STAGEB(G8_SB(1, 0), cB + kstep); G8_STAGE2(G8_SA(1, 0), cA + kstep, vAc[0][0], vAc[0][1]); G8_STAGEB(G8_SB(1, 1), cB + hstepB + kstep);
    G8_WAIT_V(6); G8_BAR;
    for (;;) {
        const bool has_next = S.next(ui + 1, nxt);
        const char* nA = has_next ? nxt.A : cA; const char* nB = has_next ? nxt.B : cB;
        if (GATHER) { unsigned vAn[2][2]; if (has_next) { G8_SETVA(vAn, nxt); } else {
#pragma unroll
            for (int h = 0; h < 2; ++h)
#pragma unroll
                for (int i = 0; i < 2; ++i) vAn[h][i] = vAc[h][i]; }
            *stash = (v4u){vAn[0][0], vAn[0][1], vAn[1][0], vAn[1][1]}; }
#pragma unroll 1
        for (int t = 0; t < nt; t += 2) {
            const bool last = (t == nt - 2);
            const char* a1 = cA + (size_t)(t + 1) * kstep;
            const char* a2 = last ? nA : cA + (size_t)(t + 2) * kstep; const char* b2 = last ? nB : cB + (size_t)(t + 2) * kstep;
            const char* a3 = a2 + kstep; const char* b3 = b2 + kstep;
            unsigned x00 = vAc[0][0], x01 = vAc[0][1], x10 = vAc[1][0], x11 = vAc[1][1];
            if (GATHER) { if (last) { const v4u sv = *stash; x00 = sv.x; x01 = sv.y; x10 = sv.z; x11 = sv.w; } xl00 = x00; xl01 = x01; xl10 = x10; xl11 = x11; }
            G8_LDB(B0, 0, 0); G8_LDB(B1, 0, 1); G8_SCHED; G8_LDA(At, 0, 0); G8_STAGE2(G8_SA(1, 1), a1, vAc[1][0], vAc[1][1]);
            G8_WAIT_V(8); G8_WAIT_L(0); G8_BAR; G8_MMA(0, 0, At, B0); G8_MMA(0, 1, At, B1); G8_BAR; G8_SCHED;
            G8_LDA(At, 0, 1); G8_STAGEB(G8_SB(0, 0), b2); G8_STAGEB(G8_SB(0, 1), b2 + hstepB); G8_STAGE2(G8_SA(0, 0), a2, x00, x01);
            G8_WAIT_V(8); G8_WAIT_L(0); G8_BAR; G8_MMA(1, 0, At, B0); G8_MMA(1, 1, At, B1); G8_BAR; G8_SCHED;
            G8_LDB(B0, 1, 0); G8_LDB(B1, 1, 1); G8_SCHED; G8_LDA(At, 1, 0); G8_STAGE2(G8_SA(0, 1), a2, x10, x11);
            G8_WAIT_V(8); G8_WAIT_L(0); G8_BAR; G8_MMA(0, 0, At, B0); G8_MMA(0, 1, At, B1); G8_BAR; G8_SCHED;
            G8_LDA(At, 1, 1); G8_STAGEB(G8_SB(1, 0), b3); G8_STAGEB(G8_SB(1, 1), b3 + hstepB); G8_STAGE2(G8_SA(1, 0), a3, x00, x01);
            G8_WAIT_V(8); G8_WAIT_L(0); G8_BAR; G8_MMA(1, 0, At, B0); G8_MMA(1, 1, At, B1); G8_BAR; G8_SCHED;
        }
        if (wr == 0) G8_BAR;
        E(acc, cur, wr, wc, fr, fq);
        if (!has_next) break;
#pragma unroll
        for (int a = 0; a < 2; ++a)
#pragma unroll
            for (int b = 0; b < 2; ++b)
#pragma unroll
                for (int m = 0; m < 4; ++m)
#pragma unroll
                    for (int n = 0; n < 2; ++n) acc[a][b][m][n] = (f32x4){0.f, 0.f, 0.f, 0.f};
        cur = nxt; cA = nA; cB = nB; ++ui;
        if (GATHER) { vAc[0][0] = xl00; vAc[0][1] = xl01; vAc[1][0] = xl10; vAc[1][1] = xl11; }
        if (wr == 1) G8_BAR;
    }
    G8_WAIT_V(0);
    G8_BAR;
#undef G8_SA
#undef G8_SB
#undef G8_STAGE2
#undef G8_STAGEB
#undef G8_LDA
#undef G8_LDB
#undef G8_MMA
#undef G8_WAIT_V
#undef G8_WAIT_L
#undef G8_BAR
#undef G8_SCHED
#undef G8_SETVA
}

struct DenseSched {
    const char* A; const char* B; size_t a_tile, b_tile, agrp_stride; int agrp_shift, nM, nN, nwg, G, c;
    __device__ __forceinline__ void init(const void* A_, const void* B_, int M, int N, int lda, int ldb, int G_, int c_) {
        A = (const char*)A_; B = (const char*)B_; a_tile = (size_t)BM * lda * 2; b_tile = (size_t)BM * ldb * 2; agrp_stride = 0; agrp_shift = 0; nM = M / BM; nN = N / BM; nwg = nM * nN; G = G_; c = c_; }
    __device__ __forceinline__ bool next(int i, Unit& u) const {
        const long L = (long)i * G + c; if (L >= nwg) return false;
        int wgid = (int)L; { const int q = nwg / NXCD, r = nwg % NXCD, xcd = wgid % NXCD, off = wgid / NXCD; wgid = (xcd < r ? xcd * (q + 1) : r * (q + 1) + (xcd - r) * q) + off; }
        const int nig = WGM * nN, gid = wgid / nig, fm = gid * WGM, gsz = (nM - fm) < WGM ? (nM - fm) : WGM;
        u.pm = fm + ((wgid % nig) % gsz); u.pn = (wgid % nig) / gsz;
        u.A = A + (size_t)u.pm * a_tile + (size_t)(u.pn >> agrp_shift) * agrp_stride; u.B = B + (size_t)u.pn * b_tile; u.rows = nullptr; u.nvalid = BM; u.aux = 0; return true;
    }
};
template <int NPN, bool GATHERED>
struct ExpertSched {
    const LAS int* tpref; const LAS int* cnt; const char* A; const char* B; const int* tok; size_t b_exp, b_tile, a_tile; int NU, G, c;
    __device__ __forceinline__ bool next(int i, Unit& u) const {
        int L = i * G + c; if (L >= NU) return false;
        if ((i + 1) * G <= NU && (G % NXCD) == 0) L = i * G + (c % NXCD) * (G / NXCD) + c / NXCD;
        const int tile = L / NPN, pn = L % NPN;
        int e = 0; while (__builtin_amdgcn_readfirstlane(tpref[e + 1]) <= tile) ++e;
        const int rb = tile - __builtin_amdgcn_readfirstlane(tpref[e]);
        u.pm = e; u.pn = pn; u.aux = tile * BM; u.nvalid = __builtin_amdgcn_readfirstlane(cnt[e]) - rb * BM; if (u.nvalid > BM) u.nvalid = BM;
        u.rows = tok + (size_t)e * CAP + rb * BM;
        u.A = GATHERED ? A : A + (size_t)tile * a_tile; u.B = B + (size_t)e * b_exp + (size_t)pn * b_tile; return true;
    }
};

struct EpiBf16 {
    static constexpr bool PERM = true;
    bf16* O; int ldc; int qscale;
    __device__ __forceinline__ void operator()(const f32x4 (&acc)[2][2][4][2], const Unit& u, int wr, int wc, int fr, int fq) const {
        asm volatile("" : "+v"(fr), "+v"(fq));
        const int row0 = u.pm * BM + wr * 64 + fr, col0 = u.pn * BM + wc * 32 + 8 * fq;
        const float sc = (qscale && (u.pn % 6) < 2) ? 0.125f : 1.0f;
#pragma unroll
        for (int ai = 0; ai < 2; ++ai)
#pragma unroll
            for (int m = 0; m < 4; ++m) { bf16* rowp = O + (size_t)(row0 + ai * HALF + m * 16) * ldc + col0;
#pragma unroll
                for (int bj = 0; bj < 2; ++bj) { const f32x4 v0 = acc[ai][bj][m][0] * sc, v1 = acc[ai][bj][m][1] * sc;
                    v4u w; w.x = cvt_pk_bf16(v0[0], v0[1]); w.y = cvt_pk_bf16(v0[2], v0[3]); w.z = cvt_pk_bf16(v1[0], v1[1]); w.w = cvt_pk_bf16(v1[2], v1[3]);
                    *(v4u*)(rowp + bj * HALF) = w; } }
    }
};
struct EpiScaleBf16 {
    static constexpr bool PERM = true;
    bf16* O; int ldc; const float* scale;
    __device__ __forceinline__ void operator()(const f32x4 (&acc)[2][2][4][2], const Unit& u, int wr, int wc, int fr, int fq) const {
        asm volatile("" : "+v"(fr), "+v"(fq));
        const int row0 = u.pm * BM + wr * 64 + fr, col0 = u.pn * BM + wc * 32 + 8 * fq;
        f32x4 sv[2][2];
#pragma unroll
        for (int bj = 0; bj < 2; ++bj)
#pragma unroll
            for (int n = 0; n < 2; ++n) sv[bj][n] = *(const f32x4*)(scale + col0 + bj * HALF + 4 * n);
#pragma unroll
        for (int ai = 0; ai < 2; ++ai)
#pragma unroll
            for (int m = 0; m < 4; ++m) { bf16* rowp = O + (size_t)(row0 + ai * HALF + m * 16) * ldc + col0;
#pragma unroll
                for (int bj = 0; bj < 2; ++bj) { const f32x4 v0 = acc[ai][bj][m][0] * sv[bj][0], v1 = acc[ai][bj][m][1] * sv[bj][1];
                    v4u w; w.x = cvt_pk_bf16(v0[0], v0[1]); w.y = cvt_pk_bf16(v0[2], v0[3]); w.z = cvt_pk_bf16(v1[0], v1[1]); w.w = cvt_pk_bf16(v1[2], v1[3]);
                    *(v4u*)(rowp + bj * HALF) = w; } }
    }
};
struct EpiResid {
    static constexpr bool PERM = false;
    const float* X; float* Y;
    __device__ __forceinline__ void operator()(const f32x4 (&acc)[2][2][4][2], const Unit& u, int wr, int wc, int fr, int fq) const {
        asm volatile("" : "+v"(fr), "+v"(fq));
        const int row0 = u.pm * BM + wr * 64 + fr, col0 = u.pn * BM + wc * 32 + 4 * fq;
#pragma unroll
        for (int ai = 0; ai < 2; ++ai)
#pragma unroll
            for (int m = 0; m < 4; ++m) { const size_t off = (size_t)(row0 + ai * HALF + m * 16) * D + col0;
#pragma unroll
                for (int bj = 0; bj < 2; ++bj)
#pragma unroll
                    for (int n = 0; n < 2; ++n) { const f32x4 xv = *(const f32x4*)(X + off + bj * HALF + n * 16); *(f32x4*)(Y + off + bj * HALF + n * 16) = xv * ALPHA + acc[ai][bj][m][n]; } }
    }
};
struct EpiResidLN {
    static constexpr bool PERM = true;
    const float* X32; const bf16* Xb; const float* st; const float* g; const float* b; bf16* Y; float* pst; int mode;
    __device__ __forceinline__ void operator()(const f32x4 (&acc)[2][2][4][2], const Unit& u, int wr, int wc, int fr, int fq) const {
        asm volatile("" : "+v"(fr), "+v"(fq));
        const int row0 = u.pm * BM + wr * 64 + fr, col0 = u.pn * BM + wc * 32 + 8 * fq, lane = fq * 16 + fr;
#pragma unroll
        for (int ai = 0; ai < 2; ++ai)
#pragma unroll
            for (int m = 0; m < 4; ++m) { const int row = row0 + ai * HALF + m * 16; const size_t off = (size_t)row * D + col0;
                float mean = 0.f, rstd = 1.f; if (mode == 1) { const f32x2 sv = *(const f32x2*)(st + 2 * row); mean = sv.x; rstd = sv.y; }
                float sm = 0.f, sq = 0.f;
#pragma unroll
                for (int bj = 0; bj < 2; ++bj) { f32x4 x0, x1;
                    if (mode == 2) { const v4u xv = *(const v4u*)(Xb + off + bj * HALF); x0 = (f32x4){bflo(xv.x), bfhi(xv.x), bflo(xv.y), bfhi(xv.y)}; x1 = (f32x4){bflo(xv.z), bfhi(xv.z), bflo(xv.w), bfhi(xv.w)}; }
                    else if (mode) { const v4u xv = *(const v4u*)(Xb + off + bj * HALF);
                        const f32x4 g0 = *(const f32x4*)(g + col0 + bj * HALF), g1 = *(const f32x4*)(g + col0 + bj * HALF + 4), b0 = *(const f32x4*)(b + col0 + bj * HALF), b1 = *(const f32x4*)(b + col0 + bj * HALF + 4);
                        x0 = ((f32x4){bflo(xv.x), bfhi(xv.x), bflo(xv.y), bfhi(xv.y)} - mean) * rstd * g0 + b0; x1 = ((f32x4){bflo(xv.z), bfhi(xv.z), bflo(xv.w), bfhi(xv.w)} - mean) * rstd * g1 + b1; }
                    else { x0 = *(const f32x4*)(X32 + off + bj * HALF); x1 = *(const f32x4*)(X32 + off + bj * HALF + 4); }
                    const f32x4 y0 = x0 * ALPHA + acc[ai][bj][m][0], y1 = x1 * ALPHA + acc[ai][bj][m][1];
                    v4u w; w.x = cvt_pk_bf16(y0[0], y0[1]); w.y = cvt_pk_bf16(y0[2], y0[3]); w.z = cvt_pk_bf16(y1[0], y1[1]); w.w = cvt_pk_bf16(y1[2], y1[3]);
                    *(v4u*)(Y + off + bj * HALF) = w;
                    sm += ((y0[0] + y0[1]) + (y0[2] + y0[3])) + ((y1[0] + y1[1]) + (y1[2] + y1[3]));
                    sq += ((y0[0] * y0[0] + y0[1] * y0[1]) + (y0[2] * y0[2] + y0[3] * y0[3])) + ((y1[0] * y1[0] + y1[1] * y1[1]) + (y1[2] * y1[2] + y1[3] * y1[3])); }
                sm += shfl_x(sm, 16, lane); sm += shfl_x(sm, 32, lane); sq += shfl_x(sq, 16, lane); sq += shfl_x(sq, 32, lane);
                if (fq == 0) *(f32x2*)(pst + ((size_t)row * 32 + u.pn * 4 + wc) * 2) = (f32x2){sm, sq}; }
    }
};
struct EpiConvIn {
    static constexpr bool PERM = true;
    bf16* UC; bf16* BGp;
    __device__ __forceinline__ void operator()(const f32x4 (&acc)[2][2][4][2], const Unit& u, int wr, int wc, int fr, int fq) const {
        asm volatile("" : "+v"(fr), "+v"(fq));
        const int row0 = u.pm * BM + wr * 64 + fr, cw = wc * 32 + 8 * fq;
        if (u.pn < 16) {
#pragma unroll
            for (int ai = 0; ai < 2; ++ai)
#pragma unroll
                for (int m = 0; m < 4; ++m) { bf16* rowp = UC + (size_t)(row0 + ai * HALF + m * 16) * D + u.pn * HALF + cw;
                    const f32x4 v0 = acc[ai][0][m][0] * acc[ai][1][m][0], v1 = acc[ai][0][m][1] * acc[ai][1][m][1];
                    v4u w; w.x = cvt_pk_bf16(v0[0], v0[1]); w.y = cvt_pk_bf16(v0[2], v0[3]); w.z = cvt_pk_bf16(v1[0], v1[1]); w.w = cvt_pk_bf16(v1[2], v1[3]);
                    *(v4u*)rowp = w; }
        } else {
#pragma unroll
            for (int ai = 0; ai < 2; ++ai)
#pragma unroll
                for (int m = 0; m < 4; ++m) { bf16* rowp = BGp + (size_t)(row0 + ai * HALF + m * 16) * D + (u.pn - 16) * BM + cw;
#pragma unroll
                    for (int bj = 0; bj < 2; ++bj) { const f32x4 v0 = acc[ai][bj][m][0], v1 = acc[ai][bj][m][1];
                        v4u w; w.x = cvt_pk_bf16(v0[0], v0[1]); w.y = cvt_pk_bf16(v0[2], v0[3]); w.z = cvt_pk_bf16(v1[0], v1[1]); w.w = cvt_pk_bf16(v1[2], v1[3]);
                        *(v4u*)(rowp + bj * HALF) = w; } }
        }
    }
};
__device__ __forceinline__ f32x4 silu_mul(f32x4 g, f32x4 uu) {
    f32x4 r;
#pragma unroll
    for (int j = 0; j < 4; ++j) r[j] = g[j] * __builtin_amdgcn_rcpf(1.0f + __expf(-g[j])) * uu[j];
    return r;
}
struct EpiExpertGU {
    static constexpr bool PERM = true;
    bf16* H;
    __device__ __forceinline__ void operator()(const f32x4 (&acc)[2][2][4][2], const Unit& u, int wr, int wc, int fr, int fq) const {
        asm volatile("" : "+v"(fr), "+v"(fq));
        const float* gates = (const float*)((const char*)u.rows + (WS_LGATE - WS_LTOK));
        const int cw = wc * 32 + 8 * fq;
#pragma unroll
        for (int ai = 0; ai < 2; ++ai)
#pragma unroll
            for (int m = 0; m < 4; ++m) { const int r = ai * HALF + wr * 64 + m * 16 + fr;
                if (r < u.nvalid) { const float gt = gates[r]; const unsigned pid = (unsigned)u.rows[r];
                    const f32x4 v0 = silu_mul(acc[ai][0][m][0], acc[ai][1][m][0]) * gt, v1 = silu_mul(acc[ai][0][m][1], acc[ai][1][m][1]) * gt;
                    v4u w; w.x = cvt_pk_bf16(v0[0], v0[1]); w.y = cvt_pk_bf16(v0[2], v0[3]); w.z = cvt_pk_bf16(v1[0], v1[1]); w.w = cvt_pk_bf16(v1[2], v1[3]);
                    (void)pid; *(v4u*)(H + (size_t)(u.aux + r) * EDIM + cw) = w; } }
    }
};
struct EpiSharedGU {
    static constexpr bool PERM = true;
    bf16* HS;
    __device__ __forceinline__ void operator()(const f32x4 (&acc)[2][2][4][2], const Unit& u, int wr, int wc, int fr, int fq) const {
        asm volatile("" : "+v"(fr), "+v"(fq));
        const int row0 = u.pm * BM + wr * 64 + fr, cw = u.pn * HALF + wc * 32 + 8 * fq;
#pragma unroll
        for (int ai = 0; ai < 2; ++ai)
#pragma unroll
            for (int m = 0; m < 4; ++m) {
                const f32x4 v0 = silu_mul(acc[ai][0][m][0], acc[ai][1][m][0]), v1 = silu_mul(acc[ai][0][m][1], acc[ai][1][m][1]);
                v4u w; w.x = cvt_pk_bf16(v0[0], v0[1]); w.y = cvt_pk_bf16(v0[2], v0[3]); w.z = cvt_pk_bf16(v1[0], v1[1]); w.w = cvt_pk_bf16(v1[2], v1[3]);
                *(v4u*)(HS + (size_t)(row0 + ai * HALF + m * 16) * SDIM + cw) = w; }
    }
};
struct EpiDownY {
    static constexpr bool PERM = true;
    bf16* Y;
    __device__ __forceinline__ void operator()(const f32x4 (&acc)[2][2][4][2], const Unit& u, int wr, int wc, int fr, int fq) const {
        asm volatile("" : "+v"(fr), "+v"(fq));
        const int col0 = u.pn * BM + wc * 32 + 8 * fq;
#pragma unroll
        for (int ai = 0; ai < 2; ++ai)
#pragma unroll
            for (int m = 0; m < 4; ++m) { const int r = ai * HALF + wr * 64 + m * 16 + fr; bf16* rowp = Y + (size_t)(u.aux + r) * D + col0;
#pragma unroll
                for (int bj = 0; bj < 2; ++bj) { const f32x4 v0 = acc[ai][bj][m][0], v1 = acc[ai][bj][m][1];
                    v4u w; w.x = cvt_pk_bf16(v0[0], v0[1]); w.y = cvt_pk_bf16(v0[2], v0[3]); w.z = cvt_pk_bf16(v1[0], v1[1]); w.w = cvt_pk_bf16(v1[2], v1[3]);
                    *(v4u*)(rowp + bj * HALF) = w; } }
    }
};
}

struct Args { const float* in[19]; float* out; unsigned char* ws; int ph_lo, ph_hi; };
struct Frame {
    LAS unsigned char* lds; unsigned* ctl; unsigned char* ws;
    int tid, lane, wave, G, bid;
};
enum { IN_X = 0, IN_RELB, IN_PWIN, IN_PWG, IN_PSC, IN_PWOUT, IN_DQKV, IN_DOUT, IN_CWIN, IN_CW, IN_CWOUT, IN_LNG, IN_LNB, IN_RW, IN_RB, IN_EGU, IN_ED, IN_SGU, IN_SD };

#define CAS __attribute__((address_space(4)))
typedef const CAS unsigned char* KP;
__device__ __forceinline__ const float* ain(KP kp, int i) { return (const float*)((const GAS float* const CAS*)kp)[i]; }
__device__ __forceinline__ float* aout(KP kp) { return (float*)((GAS float* const CAS*)kp)[19]; }
__device__ __forceinline__ void tr_item(const float* W, int K, int N, bf16* WT, int dstK, int mode, LAS float* scr, int item, int lane) {
    const int nblk = N / 32, kb = item / nblk, nb = item % nblk, k0 = 64 * kb, n0 = 32 * nb;
    int r0 = n0;
    if (mode == 1) { const int part = n0 / 2048, j = n0 % 2048; r0 = (part == 0) ? 4096 + j : 256 * (j / 128) + (part == 2 ? 128 : 0) + (j % 128); }
    if (mode == 2) { const int part = n0 / 256, j = n0 % 256; r0 = 256 * (j / 128) + 128 * part + (j % 128); }
#pragma unroll 8
    for (int i = 0; i < 32; ++i) { const int kk = 2 * i + (lane >> 5); scr[kk * 33 + (lane & 31)] = __builtin_nontemporal_load(W + (size_t)(k0 + kk) * N + n0 + (lane & 31)); }
    LDS_WAIT(); asm volatile("" ::: "memory");
    const int c = lane & 7;
#pragma unroll
    for (int j = 0; j < 4; ++j) { const int n = (lane >> 3) + 8 * j; const LAS float* s = scr + (8 * c) * 33 + n;
        v4u o; o.x = pk2(s[0 * 33], s[1 * 33]); o.y = pk2(s[2 * 33], s[3 * 33]); o.z = pk2(s[4 * 33], s[5 * 33]); o.w = pk2(s[6 * 33], s[7 * 33]);
        __builtin_nontemporal_store(o, (v4u*)(WT + (size_t)(r0 + n) * dstK + k0 + 8 * c)); }
    LDS_WAIT(); asm volatile("" ::: "memory");
}
__device__ __forceinline__ void phase_prologue(const Frame& F, KP kp) {
    LAS float* scr = (LAS float*)(F.lds + F.wave * 16384);
    const int gw = F.bid * 8 + F.wave, NGW = F.G * 8;
    constexpr int I0 = 2 * 2048, I1 = 8 * 128, I2 = 2 * 2048, I3 = 4608, I4 = 512, I5 = 6144, I6 = 2048, I7 = 4 * 512, I8 = 4 * 256, I9 = 256 * 256, I10 = 256 * 128;
    constexpr int NITEMS = I0 + I1 + I2 + I3 + I4 + I5 + I6 + I7 + I8 + I9 + I10;
    unsigned char* ws = F.ws;
    for (int it = gw; it < NITEMS; it += NGW) {
        int r = it;
        if (r < I0) { const int b = r / 2048; tr_item(ain(kp, IN_PWIN) + (size_t)b * D * D, D, D, (bf16*)(ws + WS_W_POOL_IN) + (size_t)b * D * D, D, 0, scr, r % 2048, F.lane); continue; } r -= I0;
        if (r < I1) { const int b = r / 128; tr_item(ain(kp, IN_PWG) + (size_t)b * 512 * 512, 512, 512, (bf16*)(ws + WS_W_POOL_G) + (size_t)b * 512 * 512, 512, 0, scr, r % 128, F.lane); continue; } r -= I1;
        if (r < I2) { const int b = r / 2048; tr_item(ain(kp, IN_PWOUT) + (size_t)b * D * D, D, D, (bf16*)(ws + WS_W_POOL_OUT) + (size_t)b * D * D, D, 0, scr, r % 2048, F.lane); continue; } r -= I2;
        if (r < I3) { tr_item(ain(kp, IN_DQKV), D, QKVC, (bf16*)(ws + WS_W_DIL_QKV), D, 0, scr, r, F.lane); continue; } r -= I3;
        if (r < I4) { tr_item(ain(kp, IN_DOUT), DILW, D, (bf16*)(ws + WS_W_DIL_OUT), DILW, 0, scr, r, F.lane); continue; } r -= I4;
        if (r < I5) { tr_item(ain(kp, IN_CWIN), D, 3 * D, (bf16*)(ws + WS_W_CONV_IN), D, 1, scr, r, F.lane); continue; } r -= I5;
        if (r < I6) { tr_item(ain(kp, IN_CWOUT), D, D, (bf16*)(ws + WS_W_CONV_OUT), D, 0, scr, r, F.lane); continue; } r -= I6;
        if (r < I7) { const int b = r / 512; tr_item(ain(kp, IN_SGU) + (size_t)b * D * 512, D, 512, (bf16*)(ws + WS_W_SH_GU) + (size_t)b * 512 * D, D, 2, scr, r % 512, F.lane); continue; } r -= I7;
        if (r < I8) { const int b = r / 256; tr_item(ain(kp, IN_SD) + (size_t)b * SDIM * D, SDIM, D, (bf16*)(ws + WS_W_SH_D) + (size_t)b * D * SDIM, SDIM, 0, scr, r % 256, F.lane); continue; } r -= I8;
        if (r < I9) { const int b = r / 256; tr_item(ain(kp, IN_EGU) + (size_t)b * D * 256, D, 256, (bf16*)(ws + WS_W_EX_GU) + (size_t)b * 256 * D, D, 0, scr, r % 256, F.lane); continue; } r -= I9;
        { const int b = r / 128; tr_item(ain(kp, IN_ED) + (size_t)b * EDIM * D, EDIM, D, (bf16*)(ws + WS_W_EX_D) + (size_t)b * D * EDIM, EDIM, 0, scr, r % 128, F.lane); }
    }
    const size_t gt = (size_t)F.bid * 512 + F.tid, GT = (size_t)F.G * 512;
    { const float* rw = ain(kp, IN_RW); bf16* wh = (bf16*)(ws + WS_RWH); bf16* wl = (bf16*)(ws + WS_RWL);
      for (size_t i = gt; i < (size_t)DEPTH * NEXP * D / 8; i += GT) { const size_t k8 = i % (D / 8), e = (i / (D / 8)) % NEXP, l = i / ((size_t)NEXP * D / 8);
          float v[8]; unsigned hi[8], lo[8];
#pragma unroll
          for (int j = 0; j < 8; ++j) { v[j] = rw[(l * D + k8 * 8 + j) * NEXP + e]; hi[j] = f2bf(v[j]); lo[j] = f2bf(v[j] - __builtin_bit_cast(float, hi[j] << 16)); }
          v4u a, b2; a.x = hi[0] | (hi[1] << 16); a.y = hi[2] | (hi[3] << 16); a.z = hi[4] | (hi[5] << 16); a.w = hi[6] | (hi[7] << 16);
          b2.x = lo[0] | (lo[1] << 16); b2.y = lo[2] | (lo[3] << 16); b2.z = lo[4] | (lo[5] << 16); b2.w = lo[6] | (lo[7] << 16);
          *(v4u*)(wh + (l * NEXP + e) * D + k8 * 8) = a; *(v4u*)(wl + (l * NEXP + e) * D + k8 * 8) = b2; } }
    const float* x = ain(kp, IN_X); bf16* xb = (bf16*)(ws + WS_XB);
    for (size_t i = gt; i < (size_t)T * D / 8; i += GT) { const f32x4 p = __builtin_nontemporal_load((const f32x4*)(x + i * 8)), q = __builtin_nontemporal_load((const f32x4*)(x + i * 8 + 4));
        v4u w; w.x = pk2(p[0], p[1]); w.y = pk2(p[2], p[3]); w.z = pk2(q[0], q[1]); w.w = pk2(q[2], q[3]); *(v4u*)(xb + i * 8) = w; }
}

__device__ __forceinline__ void unpack8(const v4u w, float (&f)[8]) { f[0] = bflo(w.x); f[1] = bfhi(w.x); f[2] = bflo(w.y); f[3] = bfhi(w.y); f[4] = bflo(w.z); f[5] = bfhi(w.z); f[6] = bflo(w.w); f[7] = bfhi(w.w); }
__device__ __forceinline__ void phase_pool(const Frame& F, const bf16* U, bf16* PL) {
    for (int it = F.bid * 512 + F.tid; it < (T / 32) * 256; it += F.G * 512) {
        const int cv = it & 255, ch = it >> 8, col = cv * 8, w = 2 << (col >> 9);
        const int row0 = ch * 32, pos0 = row0 & (SEQ - 1);
        float s[8], uu[8];
#pragma unroll
        for (int j = 0; j < 8; ++j) s[j] = 0.f;
        for (int j = 1; j < w; ++j) if (pos0 - j >= 0) { unpack8(*(const v4u*)(U + (size_t)(row0 - j) * D + col), uu);
#pragma unroll
            for (int q = 0; q < 8; ++q) s[q] += uu[q]; }
        for (int r = 0; r < 32; ++r) {
            const int t = row0 + r, pos = pos0 + r;
            unpack8(*(const v4u*)(U + (size_t)t * D + col), uu);
            const float inv = 1.0f / (float)((pos + 1) < w ? (pos + 1) : w);
            float o[8];
#pragma unroll
            for (int q = 0; q < 8; ++q) { s[q] += uu[q]; o[q] = s[q] * inv - uu[q]; }
            v4u ww; ww.x = pk2(o[0], o[1]); ww.y = pk2(o[2], o[3]); ww.z = pk2(o[4], o[5]); ww.w = pk2(o[6], o[7]);
            *(v4u*)(PL + (size_t)t * D + col) = ww;
            if (pos - w + 1 >= 0) { unpack8(*(const v4u*)(U + (size_t)(t - w + 1) * D + col), uu);
#pragma unroll
                for (int q = 0; q < 8; ++q) s[q] -= uu[q]; }
        }
    }
}

__device__ __forceinline__ void phase_conv(const Frame& F, const bf16* UC, const bf16* BGp, const float* cw, bf16* Z) {
    for (int it = F.bid * 512 + F.tid; it < T * 256; it += F.G * 512) {
        const int cv = it & 255, t = it >> 8, col = cv * 8, pos = t & (SEQ - 1);
        float u0[8], u1[8], u2[8], bb[8], o[8];
        unpack8(*(const v4u*)(UC + (size_t)t * D + col), u2);
        if (pos >= 1) unpack8(*(const v4u*)(UC + (size_t)(t - 1) * D + col), u1); else {
#pragma unroll
            for (int q = 0; q < 8; ++q) u1[q] = 0.f; }
        if (pos >= 2) unpack8(*(const v4u*)(UC + (size_t)(t - 2) * D + col), u0); else {
#pragma unroll
            for (int q = 0; q < 8; ++q) u0[q] = 0.f; }
        unpack8(*(const v4u*)(BGp + (size_t)t * D + col), bb);
#pragma unroll
        for (int q = 0; q < 8; ++q) o[q] = bb[q] * (cw[col + q] * u0[q] + cw[D + col + q] * u1[q] + cw[2 * D + col + q] * u2[q]);
        v4u ww; ww.x = pk2(o[0], o[1]); ww.y = pk2(o[2], o[3]); ww.z = pk2(o[4], o[5]); ww.w = pk2(o[6], o[7]);
        *(v4u*)(Z + (size_t)t * D + col) = ww;
    }
}

__device__ __forceinline__ int t5_bucket(int dist) {
    if (dist < 16) return dist;
    int large = 16 + (int)(logf((float)dist / 16.0f) / logf(128.0f) * 16.0f);
    return large < 31 ? large : 31;
}
constexpr int AT_KS = 0, AT_KSTR = 144, AT_VT = 256 * 144, AT_VSTR = 520, AT_BIAS = AT_VT + 64 * 520;
__device__ __forceinline__ void phase_attn(const Frame& F, const bf16* QKV, const float* relb, bf16* OG, float* LSE) {
    LAS unsigned char* lds = F.lds;
    const int tid = F.tid, lane = F.lane, w = tid >> 6, fr = lane & 15, fq = lane >> 4;
    for (int unit = F.bid; unit < NBATCH * 3 * 8 * 16; unit += F.G) {
        const int cmb = unit & 15, h = (unit >> 4) & 7, g = (unit >> 7) % 3, b = unit / 384;
        const int dsh = 2 * g, dil = 1 << dsh, r = cmb & (dil - 1), nb = cmb >> dsh;
        const bf16* base = QKV + (size_t)b * SEQ * QKVC + g * 1536 + h * 64;
        __syncthreads();
        {
            const int key = tid >> 1, half = tid & 1, jk = (nb - 1) * 128 + key;
            v4u kv[4], vv[4];
            if (jk >= 0) { const bf16* rp = base + (size_t)(jk * dil + r) * QKVC + half * 32;
#pragma unroll
                for (int i = 0; i < 4; ++i) { kv[i] = *(const v4u*)(rp + 512 + 8 * i); vv[i] = *(const v4u*)(rp + 1024 + 8 * i); } }
            else {
#pragma unroll
                for (int i = 0; i < 4; ++i) { kv[i] = (v4u){0u, 0u, 0u, 0u}; vv[i] = (v4u){0u, 0u, 0u, 0u}; } }
#pragma unroll
            for (int i = 0; i < 4; ++i) *(LAS v4u*)(lds + AT_KS + key * AT_KSTR + half * 64 + 16 * i) = kv[i];
#pragma unroll
            for (int i = 0; i < 4; ++i) {
                const unsigned ww[4] = {vv[i].x, vv[i].y, vv[i].z, vv[i].w};
#pragma unroll
                for (int q = 0; q < 4; ++q) { const int d = half * 32 + 8 * i + 2 * q;
                    *(LAS unsigned short*)(lds + AT_VT + d * AT_VSTR + key * 2) = (unsigned short)(ww[q] & 0xffffu);
                    *(LAS unsigned short*)(lds + AT_VT + (d + 1) * AT_VSTR + key * 2) = (unsigned short)(ww[q] >> 16); } }
            if (tid <= 128) ((LAS float*)(lds + AT_BIAS))[tid] = relb[t5_bucket(tid * dil) * 24 + g * 8 + h];
        }
        __syncthreads();
        int qi = 16 * w + fr; asm volatile("" : "+v"(qi));
        const int jq = nb * 128 + qi, tq = jq * dil + r;
        const bf16* qp = base + (size_t)tq * QKVC + 8 * fq;
        const bf16x8 q0 = *(const bf16x8*)qp, q1 = *(const bf16x8*)(qp + 32);
        f32x4 s[9]; float mx = -INFINITY;
#pragma unroll
        for (int kt = 0; kt < 9; ++kt) {
            const int kb = 16 * (w + kt);
            const bf16x8 k0 = *(const LAS bf16x8*)(lds + AT_KS + (kb + fr) * AT_KSTR + fq * 16), k1 = *(const LAS bf16x8*)(lds + AT_KS + (kb + fr) * AT_KSTR + 64 + fq * 16);
            f32x4 a = (f32x4){0.f, 0.f, 0.f, 0.f};
            a = __builtin_amdgcn_mfma_f32_16x16x32_bf16(k0, q0, a, 0, 0, 0);
            a = __builtin_amdgcn_mfma_f32_16x16x32_bf16(k1, q1, a, 0, 0, 0);
#pragma unroll
            for (int i = 0; i < 4; ++i) { const int kl = kb + 4 * fq + i, rel = qi + 128 - kl;
                const bool ok = (rel >= 0) && (rel <= 128) && (nb > 0 || kl >= 128);
                const int rc = rel < 0 ? 0 : (rel > 128 ? 128 : rel);
                const float v = ok ? a[i] + ((LAS float*)(lds + AT_BIAS))[rc] : -INFINITY;
                a[i] = v; mx = fmaxf(mx, v); }
            s[kt] = a;
        }
        mx = fmaxf(mx, shfl_x(mx, 16, lane)); mx = fmaxf(mx, shfl_x(mx, 32, lane));
        float l = 0.f;
#pragma unroll
        for (int kt = 0; kt < 9; ++kt)
#pragma unroll
            for (int i = 0; i < 4; ++i) { const float p = __expf(s[kt][i] - mx); s[kt][i] = p; l += p; }
        l += shfl_x(l, 16, lane); l += shfl_x(l, 32, lane);
        f32x4 o[4];
#pragma unroll
        for (int nt = 0; nt < 4; ++nt) o[nt] = (f32x4){0.f, 0.f, 0.f, 0.f};
#pragma unroll
        for (int st = 0; st < 5; ++st) {
            const int kt0 = 2 * st, kt1 = 2 * st + 1;
            v4u pw; pw.x = pk2(s[kt0][0], s[kt0][1]); pw.y = pk2(s[kt0][2], s[kt0][3]);
            if (kt1 < 9) { pw.z = pk2(s[kt1 < 9 ? kt1 : 0][0], s[kt1 < 9 ? kt1 : 0][1]); pw.w = pk2(s[kt1 < 9 ? kt1 : 0][2], s[kt1 < 9 ? kt1 : 0][3]); } else { pw.z = 0u; pw.w = 0u; }
            const bf16x8 pf = __builtin_bit_cast(bf16x8, pw);
            const int kb0 = 16 * (w + kt0) + 4 * fq, kb1 = 16 * (w + kt1) + 4 * fq;
#pragma unroll
            for (int nt = 0; nt < 4; ++nt) { const int d = 16 * nt + fr;
                v2u va = *(const LAS v2u*)(lds + AT_VT + d * AT_VSTR + kb0 * 2), vb = (v2u){0u, 0u};
                if (kt1 < 9) vb = *(const LAS v2u*)(lds + AT_VT + d * AT_VSTR + kb1 * 2);
                v4u vw; vw.x = va.x; vw.y = va.y; vw.z = vb.x; vw.w = vb.y;
                o[nt] = __builtin_amdgcn_mfma_f32_16x16x32_bf16(__builtin_bit_cast(bf16x8, vw), pf, o[nt], 0, 0, 0); }
        }
        const float il = 1.0f / l;
        bf16* op = OG + ((size_t)g * T + (size_t)b * SEQ + tq) * DILW + h * 64 + 4 * fq;
#pragma unroll
        for (int nt = 0; nt < 4; ++nt) { v2u ww; ww.x = pk2(o[nt][0] * il, o[nt][1] * il); ww.y = pk2(o[nt][2] * il, o[nt][3] * il); *(v2u*)(op + 16 * nt) = ww; }
        if (fq == 0) LSE[((size_t)g * T + (size_t)b * SEQ + tq) * 8 + h] = mx + logf(l);
    }
}
__device__ __forceinline__ void phase_combine(const Frame& F, const bf16* OG, const float* LSE, bf16* O) {
    for (int it = F.bid * 512 + F.tid; it < T * 64; it += F.G * 512) {
        const int c8 = it & 7, h = (it >> 3) & 7, t = it >> 6;
        const float l0 = LSE[((size_t)0 * T + t) * 8 + h], l1 = LSE[((size_t)1 * T + t) * 8 + h], l2 = LSE[((size_t)2 * T + t) * 8 + h];
        const float m = fmaxf(l0, fmaxf(l1, l2)); float w0 = __expf(l0 - m), w1 = __expf(l1 - m), w2 = __expf(l2 - m); const float inv = 1.0f / (w0 + w1 + w2); w0 *= inv; w1 *= inv; w2 *= inv;
        float a[8], bq[8], c[8], o[8]; const size_t off = (size_t)t * DILW + h * 64 + c8 * 8;
        unpack8(*(const v4u*)(OG + off), a); unpack8(*(const v4u*)(OG + (size_t)T * DILW + off), bq); unpack8(*(const v4u*)(OG + (size_t)2 * T * DILW + off), c);
#pragma unroll
        for (int q = 0; q < 8; ++q) o[q] = w0 * a[q] + w1 * bq[q] + w2 * c[q];
        v4u ww; ww.x = pk2(o[0], o[1]); ww.y = pk2(o[2], o[3]); ww.z = pk2(o[4], o[5]); ww.w = pk2(o[6], o[7]);
        *(v4u*)(O + off) = ww;
    }
}

constexpr int M1_LOG = 131072, M1_STAT = M1_LOG + 4096, M1_HIST = M1_STAT + 128, M1_BASE = M1_HIST + 256;
__device__ __forceinline__ void phase_moe1(const Frame& F, const float* Y, const float* gain, const float* bias, const float* RW, const float* RB,
                                           float* X1F, bf16* X1B, unsigned* cnt, int* ltok, float* lgate, int* eidx, int* inv) {
    LAS float* xs = (LAS float*)F.lds; LAS float* logit = (LAS float*)(F.lds + M1_LOG); LAS float* stat = (LAS float*)(F.lds + M1_STAT);
    LAS int* hist = (LAS int*)(F.lds + M1_HIST); LAS int* basep = (LAS int*)(F.lds + M1_BASE);
    const int tid = F.tid, lane = F.lane, w = F.wave;
    for (int rg = F.bid; rg < T / 16; rg += F.G) {
        const int row0 = rg * 16;
        __syncthreads();
#pragma unroll
        for (int j = 0; j < 16; ++j) { const int idx = tid + 512 * j; *(LAS f32x4*)(xs + idx * 4) = *(const f32x4*)(Y + (size_t)row0 * D + (size_t)idx * 4); }
        if (tid < 64) hist[tid] = 0;
        __syncthreads();
#pragma unroll
        for (int rr = 0; rr < 2; ++rr) { const int r = 2 * w + rr; float sm = 0.f;
#pragma unroll
            for (int j = 0; j < 32; ++j) sm += xs[r * D + lane + 64 * j];
            const float mean = wave_sum(sm, lane) * (1.0f / D); float sq = 0.f;
#pragma unroll
            for (int j = 0; j < 32; ++j) { const float d = xs[r * D + lane + 64 * j] - mean; sq += d * d; }
            const float rstd = 1.0f / sqrtf(wave_sum(sq, lane) * (1.0f / D) + LN_EPS);
            if (lane == 0) { stat[2 * r] = mean; stat[2 * r + 1] = rstd; } }
        __syncthreads();
#pragma unroll
        for (int j = 0; j < 16; ++j) { const int idx = tid + 512 * j, r = idx >> 9, c4 = (idx & 511) * 4;
            const f32x4 v = *(LAS f32x4*)(xs + idx * 4), gv = *(const f32x4*)(gain + c4), bv = *(const f32x4*)(bias + c4);
            const float mean = stat[2 * r], rstd = stat[2 * r + 1];
            const f32x4 o = (v - mean) * rstd * gv + bv;
            *(LAS f32x4*)(xs + idx * 4) = o;
            *(f32x4*)(X1F + (size_t)(row0 + r) * D + c4) = o;
            v2u wb; wb.x = pk2(o[0], o[1]); wb.y = pk2(o[2], o[3]); *(v2u*)(X1B + (size_t)(row0 + r) * D + c4) = wb; }
        __syncthreads();
        { const int r = tid >> 5, ep = tid & 31; float a0 = 0.f, a1 = 0.f; const float* wp = RW + 2 * ep; const LAS float* xr = xs + r * D;
            for (int k0 = 0; k0 < D; k0 += 16) {
                f32x2 wv[16];
#pragma unroll
                for (int j = 0; j < 16; ++j) wv[j] = *(const f32x2*)(wp + (size_t)(k0 + j) * NEXP);
                asm volatile("" : "+v"(wv[0]), "+v"(wv[1]), "+v"(wv[2]), "+v"(wv[3]), "+v"(wv[4]), "+v"(wv[5]), "+v"(wv[6]), "+v"(wv[7]));
                asm volatile("" : "+v"(wv[8]), "+v"(wv[9]), "+v"(wv[10]), "+v"(wv[11]), "+v"(wv[12]), "+v"(wv[13]), "+v"(wv[14]), "+v"(wv[15]));
#pragma unroll
                for (int j = 0; j < 16; ++j) { const float xv = xr[k0 + j]; a0 += xv * wv[j].x; a1 += xv * wv[j].y; } }
            logit[r * NEXP + 2 * ep] = a0; logit[r * NEXP + 2 * ep + 1] = a1; }
        __syncthreads();
        int sel_pos[2]; float sel_gate[2]; int sel_rank[2]; bool sel_on[2];
#pragma unroll
        for (int rr = 0; rr < 2; ++rr) { const int r = 2 * w + rr;
            const float sc = 1.0f / (1.0f + __expf(-logit[r * NEXP + lane])); const float ch = sc + RB[lane];
            int rk = 0;
#pragma unroll
            for (int j = 0; j < 8; ++j) { const float cj = shfl_from(ch, (lane & ~7) + j); rk += (cj > ch || (cj == ch && j < (lane & 7))) ? 1 : 0; }
            float gs = rk < 2 ? ch : 0.f; gs += shfl_x(gs, 1, lane); gs += shfl_x(gs, 2, lane); gs += shfl_x(gs, 4, lane);
            int grk = 0; const int g = lane >> 3;
#pragma unroll
            for (int hh = 0; hh < 8; ++hh) { const float gh = shfl_from(gs, 8 * hh); grk += (gh > gs || (gh == gs && hh < g)) ? 1 : 0; }
            const float msk = grk < 4 ? ch : -INFINITY;
            int erk = 0;
            for (int j = 0; j < 64; ++j) { const float mj = __builtin_bit_cast(float, __builtin_amdgcn_readlane(__builtin_bit_cast(int, msk), j)); erk += (mj > msk || (mj == msk && j < lane)) ? 1 : 0; }
            const bool on = erk < 8;
            const float ssum = wave_sum(on ? sc : 0.f, lane);
            sel_on[rr] = on; sel_rank[rr] = erk; sel_gate[rr] = sc / ssum * 2.5f; sel_pos[rr] = 0;
            if (on) sel_pos[rr] = __hip_atomic_fetch_add(&hist[lane], 1, __ATOMIC_RELAXED, __HIP_MEMORY_SCOPE_WORKGROUP); }
        __syncthreads();
        if (tid < 64) { const int hc = hist[tid]; int bs = 0; if (hc > 0) bs = (int)atomicAdd(&cnt[tid * 16], (unsigned)hc); basep[tid] = bs; }
        __syncthreads();
#pragma unroll
        for (int rr = 0; rr < 2; ++rr) if (sel_on[rr]) { const int t = row0 + 2 * w + rr, pos = basep[lane] + sel_pos[rr];
            ltok[(size_t)lane * CAP + pos] = t; lgate[(size_t)lane * CAP + pos] = sel_gate[rr];
            eidx[t * 8 + sel_rank[rr]] = lane; inv[t * 8 + sel_rank[rr]] = pos; }
    }
}
__device__ __forceinline__ int build_tiles(const Frame& F, const unsigned* cnt) {
    LAS int* tpref = (LAS int*)(F.lds + LDS_TAB); LAS int* cl = (LAS int*)(F.lds + LDS_TAB + 512);
    __syncthreads();
    if (F.tid < 64) cl[F.tid] = (int)__hip_atomic_load(&cnt[F.tid * 16], __ATOMIC_RELAXED, __HIP_MEMORY_SCOPE_AGENT);
    __syncthreads();
    if (F.tid == 0) { int acc = 0; for (int e = 0; e < 64; ++e) { tpref[e] = acc; acc += (cl[e] + 255) >> 8; } tpref[64] = acc; tpref[65] = acc + T / 256; tpref[66] = acc + 2 * (T / 256); cl[64] = T; cl[65] = T; }
    __syncthreads();
    return __builtin_amdgcn_readfirstlane(tpref[64]);
}
__device__ __forceinline__ void phase_moe4(const Frame& F, const float* Y2, const bf16* Yr, const int* eidx, const int* inv, const float* gain, const float* bias, float* XO, bf16* XBo) {
    const LAS int* tpref = (const LAS int*)(F.lds + LDS_TAB);
    const int gw = F.bid * 8 + F.wave, NGW = F.G * 8, lane = F.lane;
    for (int t = gw; t < T; t += NGW) {
        f32x4 v[8];
#pragma unroll
        for (int j = 0; j < 8; ++j) v[j] = *(const f32x4*)(Y2 + (size_t)t * D + 4 * lane + 256 * j);
        for (int k = 0; k < 8; ++k) { const int e = eidx[t * 8 + k], pos = inv[t * 8 + k]; const bf16* yr = Yr + (size_t)(tpref[e] * 256 + pos) * D + 4 * lane;
#pragma unroll
            for (int j = 0; j < 8; ++j) { const v2u w = *(const v2u*)(yr + 256 * j); v[j][0] += bflo(w.x); v[j][1] += bfhi(w.x); v[j][2] += bflo(w.y); v[j][3] += bfhi(w.y); } }
        float sm = 0.f;
#pragma unroll
        for (int j = 0; j < 8; ++j) sm += (v[j][0] + v[j][1]) + (v[j][2] + v[j][3]);
        const float mean = wave_sum(sm, lane) * (1.0f / D); float sq = 0.f;
#pragma unroll
        for (int j = 0; j < 8; ++j) { v[j] = v[j] - mean; sq += (v[j][0] * v[j][0] + v[j][1] * v[j][1]) + (v[j][2] * v[j][2] + v[j][3] * v[j][3]); }
        const float rstd = 1.0f / sqrtf(wave_sum(sq, lane) * (1.0f / D) + LN_EPS);
#pragma unroll
        for (int j = 0; j < 8; ++j) { const int c = 4 * lane + 256 * j; const f32x4 o = v[j] * rstd * *(const f32x4*)(gain + c) + *(const f32x4*)(bias + c);
            *(f32x4*)(XO + (size_t)t * D + c) = o;
            v2u wb; wb.x = pk2(o[0], o[1]); wb.y = pk2(o[2], o[3]); *(v2u*)(XBo + (size_t)t * D + c) = wb; }
    }
}


template <int CTRL> __device__ __forceinline__ float dppf(float x) { return __builtin_bit_cast(float, __builtin_amdgcn_update_dpp(0, __builtin_bit_cast(int, x), CTRL, 0xF, 0xF, false)); }
__device__ __forceinline__ float gmax8(float x) { x = fmaxf(x, dppf<0xB1>(x)); x = fmaxf(x, dppf<0x4E>(x)); x = fmaxf(x, dppf<0x141>(x)); return x; }
__device__ __forceinline__ float gsum8(float x) { x += dppf<0xB1>(x); x += dppf<0x4E>(x); x += dppf<0x141>(x); return x; }
__device__ __forceinline__ float rl_f(float x, int l) { return __builtin_bit_cast(float, __builtin_amdgcn_readlane(__builtin_bit_cast(int, x), l)); }
constexpr int M1_P = 0, M1N_HIST = 131072, M1N_BASE = 131072 + 256, M1N_GB = 131072 + 1024;
__device__ __forceinline__ void phase_moe1n(const Frame& F, const bf16* Y, const float* pst, const float* gain, const float* bias, const bf16* WH, const bf16* WL, const float* RB,
                                            bf16* X1B, float* ST1, unsigned* cnt, int* ltok, float* lgate, int* eidx, int* inv) {
    LAS float* P = (LAS float*)(F.lds + M1_P); LAS int* hist = (LAS int*)(F.lds + M1N_HIST); LAS int* basep = (LAS int*)(F.lds + M1N_BASE);
    const int tid = F.tid, lane = F.lane, w = F.wave, r = lane & 15, q = lane >> 4;
    for (int item = F.bid; item < T / 64; item += F.G) {
        const int row0 = item * 64;
        __syncthreads();
        if (tid < 64) hist[tid] = 0;
        { LAS f32x4* gb = (LAS f32x4*)(F.lds + M1N_GB); gb[tid] = *(const f32x4*)(gain + 4 * tid); gb[512 + tid] = *(const f32x4*)(bias + 4 * tid); }
        __syncthreads();
        float mean[4], rstd[4];
#pragma unroll
        for (int rt = 0; rt < 4; ++rt) { const int row = row0 + 16 * rt + r;
          const f32x4* pp = (const f32x4*)(pst + ((size_t)row * 32 + q * 8) * 2); const f32x4 a = pp[0], b = pp[1], c = pp[2], d = pp[3];
          float sm = (a[0] + a[2]) + (b[0] + b[2]) + (c[0] + c[2]) + (d[0] + d[2]), sq = (a[1] + a[3]) + (b[1] + b[3]) + (c[1] + c[3]) + (d[1] + d[3]);
          sm += shfl_x(sm, 16, lane); sm += shfl_x(sm, 32, lane); sq += shfl_x(sq, 16, lane); sq += shfl_x(sq, 32, lane);
          mean[rt] = sm * (1.0f / D); const float var = fmaxf(sq * (1.0f / D) - mean[rt] * mean[rt], 0.f); rstd[rt] = 1.0f / sqrtf(var + LN_EPS);
          if (w == 0 && q == 0) *(f32x2*)(ST1 + 2 * row) = (f32x2){mean[rt], rstd[rt]}; }
        const int kb = 256 * w + 8 * q;
        const LAS float* gl = (const LAS float*)(F.lds + M1N_GB) + kb;
        f32x4 acc[4][4];
#pragma unroll
        for (int rt = 0; rt < 4; ++rt)
#pragma unroll
            for (int nt = 0; nt < 4; ++nt) acc[rt][nt] = (f32x4){0.f, 0.f, 0.f, 0.f};
        v4u yb[3][4]; bf16x8 wh[4], wl[4];
        unsigned vo[4];
#pragma unroll
        for (int i = 0; i < 4; ++i) { vo[i] = (unsigned)(r * D + kb) * 2u + (unsigned)i * (16u * D * 2u); asm volatile("" : "+v"(vo[i])); }
        const char* ybase = (const char*)(Y + (size_t)row0 * D); char* xbase = (char*)(X1B + (size_t)row0 * D);
#define M1_LOADY(st) do { _Pragma("unroll") for (int rt = 0; rt < 4; ++rt) yb[(st) % 3][rt] = *(const v4u*)(ybase + vo[rt] + 64 * (st)); } while (0)
#define M1_LOADW(st) do { _Pragma("unroll") for (int nt = 0; nt < 4; ++nt) { wh[nt] = *(const bf16x8*)((const char*)WH + vo[nt] + 64 * (st)); wl[nt] = *(const bf16x8*)((const char*)WL + vo[nt] + 64 * (st)); } } while (0)
        M1_LOADY(0); M1_LOADW(0); M1_LOADY(1);
        __builtin_amdgcn_sched_barrier(0);
#pragma unroll
        for (int st = 0; st < 8; ++st) {
            const f32x4 g0 = *(const LAS f32x4*)(gl + 32 * st), g1 = *(const LAS f32x4*)(gl + 32 * st + 4), b0 = *(const LAS f32x4*)(gl + 2048 + 32 * st), b1 = *(const LAS f32x4*)(gl + 2048 + 32 * st + 4);
#pragma unroll
            for (int rt = 0; rt < 4; ++rt) { const v4u yv = yb[st % 3][rt];
                const f32x4 y0_ = (f32x4){bflo(yv.x), bfhi(yv.x), bflo(yv.y), bfhi(yv.y)}, y1_ = (f32x4){bflo(yv.z), bfhi(yv.z), bflo(yv.w), bfhi(yv.w)};
                const f32x4 x0 = (y0_ - mean[rt]) * rstd[rt] * g0 + b0, x1 = (y1_ - mean[rt]) * rstd[rt] * g1 + b1;
                v4u h; h.x = cvt_pk_bf16(x0[0], x0[1]); h.y = cvt_pk_bf16(x0[2], x0[3]); h.z = cvt_pk_bf16(x1[0], x1[1]); h.w = cvt_pk_bf16(x1[2], x1[3]);
                *(v4u*)(xbase + vo[rt] + 64 * st) = h;
                v4u l; l.x = cvt_pk_bf16(x0[0] - bflo(h.x), x0[1] - bfhi(h.x)); l.y = cvt_pk_bf16(x0[2] - bflo(h.y), x0[3] - bfhi(h.y));
                l.z = cvt_pk_bf16(x1[0] - bflo(h.z), x1[1] - bfhi(h.z)); l.w = cvt_pk_bf16(x1[2] - bflo(h.w), x1[3] - bfhi(h.w));
                const bf16x8 xh = __builtin_bit_cast(bf16x8, h), xl = __builtin_bit_cast(bf16x8, l);
#pragma unroll
                for (int nt = 0; nt < 4; ++nt) { acc[rt][nt] = __builtin_amdgcn_mfma_f32_16x16x32_bf16(xh, wh[nt], acc[rt][nt], 0, 0, 0);
                    acc[rt][nt] = __builtin_amdgcn_mfma_f32_16x16x32_bf16(xl, wh[nt], acc[rt][nt], 0, 0, 0); acc[rt][nt] = __builtin_amdgcn_mfma_f32_16x16x32_bf16(xh, wl[nt], acc[rt][nt], 0, 0, 0); } }
            __builtin_amdgcn_sched_barrier(0);
            if (st + 1 < 8) M1_LOADW(st + 1);
            if (st + 2 < 8) M1_LOADY(st + 2);
            __builtin_amdgcn_sched_barrier(0);
        }
#undef M1_LOADY
#undef M1_LOADW
#pragma unroll
        for (int rt = 0; rt < 4; ++rt)
#pragma unroll
            for (int nt = 0; nt < 4; ++nt)
#pragma unroll
                for (int i = 0; i < 4; ++i) P[(w * 64 + 16 * rt + 4 * q + i) * 64 + 16 * nt + r] = acc[rt][nt][i];
        __syncthreads();
        const float rb = RB[lane];
        LAS int* Pi = (LAS int*)P;
#pragma unroll 1
        for (int rr = 0; rr < 8; ++rr) { const int rl = 8 * w + rr;
            float lg = ((P[rl * 64 + lane] + P[(64 + rl) * 64 + lane]) + (P[(128 + rl) * 64 + lane] + P[(192 + rl) * 64 + lane])) + ((P[(256 + rl) * 64 + lane] + P[(320 + rl) * 64 + lane]) + (P[(384 + rl) * 64 + lane] + P[(448 + rl) * 64 + lane]));
            lg = (lg == lg) ? lg : -1.0e30f;
            const float sc = 1.0f / (1.0f + __expf(-lg)); const float ch = sc + rb;
            const float m1 = gmax8(ch), neq = gsum8(ch == m1 ? 1.f : 0.f), m2c = gmax8(ch < m1 ? ch : -INFINITY);
            const float gs = m1 + (neq >= 2.f ? m1 : m2c);
            int grk = 0; const int g = lane >> 3;
#pragma unroll
            for (int hh = 0; hh < 8; ++hh) { const float gh = rl_f(gs, 8 * hh); grk += (gh > gs || (gh == gs && hh < g)) ? 1 : 0; }
            const float msk = grk < 4 ? ch : -INFINITY;
            float cur = msk, ssum = 0.f; int erk = 64;
#pragma unroll 1
            for (int k = 0; k < 8; ++k) {
                float rm = gmax8(cur); rm = fmaxf(rm, dppf<0x140>(rm));
                const float wm = fmaxf(fmaxf(rl_f(rm, 0), rl_f(rm, 16)), fmaxf(rl_f(rm, 32), rl_f(rm, 48)));
                const unsigned long long bal = __builtin_amdgcn_ballot_w64(cur == wm);
                const int lsel = __builtin_amdgcn_readfirstlane((int)__builtin_ctzll(bal));
                ssum += rl_f(sc, lsel);
                const bool me = lane == lsel; erk = me ? k : erk; cur = me ? -INFINITY : cur; }
            const bool on = erk < 8;
            int pk_ = -1; if (on) pk_ = __hip_atomic_fetch_add(&hist[lane], 1, __ATOMIC_RELAXED, __HIP_MEMORY_SCOPE_WORKGROUP) | (erk << 16);
            P[rl * 64 + lane] = sc / ssum * 2.5f; Pi[(64 + rl) * 64 + lane] = pk_; }
        __syncthreads();
        if (tid < 64) { int tt = tid; asm volatile("" : "+v"(tt));
            const int hc = hist[tt]; int bs = 0; if (hc > 0) bs = (int)atomicAdd(&cnt[tt * 16], (unsigned)hc); basep[tt] = bs; }
        __syncthreads();
        { const int bl = basep[lane];
#pragma unroll 1
          for (int rr = 0; rr < 8; ++rr) { const int rl = 8 * w + rr; const int pk_ = Pi[(64 + rl) * 64 + lane]; const float gt_ = P[rl * 64 + lane];
            if (pk_ >= 0) { const int t = row0 + rl, pos = bl + (pk_ & 0xffff), rk_ = pk_ >> 16;
                ltok[(size_t)lane * CAP + pos] = t * 8 + rk_; lgate[(size_t)lane * CAP + pos] = gt_;
                eidx[t * 8 + rk_] = lane; inv[t * 8 + rk_] = pos; } } }
    }
}

constexpr int M3_PL = 131072, M3_CNT = 147456, M3_OFF = 147456 + 272;
__device__ __forceinline__ void phase_moe3n(const Frame& F, const bf16* H, const bf16* HSp, const int* eidx, const bf16* WD, const bf16* WSD,
                                            const float* Y1, const float* ST1, const float* g1, const float* b1, float* Y2, float* PST2) {
    LAS int* out = (LAS int*)F.lds; LAS unsigned short* plist = (LAS unsigned short*)(F.lds + M3_PL); LAS int* cnt = (LAS int*)(F.lds + M3_CNT); LAS int* off = (LAS int*)(F.lds + M3_OFF);
    const int tid = F.tid, lane = F.lane, w = F.wave, r = lane & 15, q = lane >> 4;
    for (int u = F.bid; u < 1024; u += F.G) {
        int nc = (u & 7) | ((u >> 7) << 3), tb = (u >> 3) & 15;
        if (F.G == 256) { const int i = u >> 8, x = u & 7, j = (u >> 3) & 31; tb = 2 * x + (i >> 1); nc = 32 * (i & 1) + j; }
        __syncthreads();
#pragma unroll
        for (int j = 0; j < 16; ++j) ((LAS v4u*)out)[tid + 512 * j] = (v4u){0u, 0u, 0u, 0u};
        if (tid < 66) cnt[tid] = 0;
        __syncthreads();
        int ee[16], pp[16];
        { const v4u* ep = (const v4u*)(eidx + ((size_t)tb * 1024 + 2 * tid) * 8); const v4u e0 = ep[0], e1 = ep[1], e2 = ep[2], e3 = ep[3];
          ee[0] = e0.x; ee[1] = e0.y; ee[2] = e0.z; ee[3] = e0.w; ee[4] = e1.x; ee[5] = e1.y; ee[6] = e1.z; ee[7] = e1.w;
          ee[8] = e2.x; ee[9] = e2.y; ee[10] = e2.z; ee[11] = e2.w; ee[12] = e3.x; ee[13] = e3.y; ee[14] = e3.z; ee[15] = e3.w; }
#pragma unroll
        for (int j = 0; j < 16; ++j) pp[j] = __hip_atomic_fetch_add(&cnt[ee[j]], 1, __ATOMIC_RELAXED, __HIP_MEMORY_SCOPE_WORKGROUP);
        __syncthreads();
        if (w == 0) { int c = cnt[lane], x = c;
#pragma unroll
            for (int o = 1; o < 64; o <<= 1) { const int y = __builtin_amdgcn_ds_bpermute(((lane - o) & 63) << 2, x); if (lane >= o) x += y; }
            off[lane] = x - c; if (lane == 63) off[64] = x; }
        __syncthreads();
#pragma unroll
        for (int j = 0; j < 16; ++j) plist[off[ee[j]] + pp[j]] = (unsigned short)(tid * 16 + j);
        __syncthreads();
        const char* Hb = (const char*)H + (size_t)tb * 8192 * 256 + q * 16;
        const char* HSb = (const char*)HSp + (size_t)tb * 1024 * 512 + q * 16;
        const char* Bb = (const char*)WD + ((size_t)nc * 32 + r) * 256 + q * 16;
        const char* BSb = (const char*)WSD + ((size_t)nc * 32 + r) * 512 + q * 16;
#define M3_NR(sg) ((sg) < 8 ? __builtin_amdgcn_readfirstlane(cnt[w + 8 * (sg)]) : 128)
#define M3_RB(sg) ((sg) < 8 ? __builtin_amdgcn_readfirstlane(off[w + 8 * (sg)]) : 0)
#define M3_GLD(dst, ptr, OFF) asm volatile("global_load_dwordx4 %0, %1, off offset:" #OFF : "=&v"(dst) : "v"(ptr) : "memory")
#define M3_LOADB(dst, sg) do { const char* _b0 = (sg) < 8 ? Bb + (size_t)(w + 8 * (sg)) * 524288 : BSb + ((sg) - 8) * 256; const char* _b1 = _b0 + ((sg) < 8 ? 4096 : 8192); \
            M3_GLD(dst[0][0], _b0, 0); M3_GLD(dst[0][1], _b0, 64); M3_GLD(dst[0][2], _b0, 128); M3_GLD(dst[0][3], _b0, 192); \
            M3_GLD(dst[1][0], _b1, 0); M3_GLD(dst[1][1], _b1, 64); M3_GLD(dst[1][2], _b1, 128); M3_GLD(dst[1][3], _b1, 192); } while (0)
#define M3_LOADA(dst, sg, bb, nr, rbs) do { int _i = 16 * (bb) + r; _i = _i < (nr) ? _i : (nr) - 1; const unsigned _rid = plist[(rbs) + _i]; \
            const char* _a = (sg) < 8 ? Hb + (size_t)_rid * 256 : ((sg) < 10 ? HSb + (size_t)(128 * w + _i) * 512 + ((sg) - 8) * 256 : Hb); \
            M3_GLD(dst[0], _a, 0); M3_GLD(dst[1], _a, 64); M3_GLD(dst[2], _a, 128); M3_GLD(dst[3], _a, 192); } while (0)
#define M3_ADV(sg, bb, nr, rbs) do { if ((sg) < 10) { ++(bb); if ((bb) * 16 >= (nr)) { (bb) = 0; do { ++(sg); } while ((sg) < 8 && M3_NR(sg) == 0); if ((sg) < 10) { (nr) = M3_NR(sg); (rbs) = M3_RB(sg); } } } } while (0)
#define M3_WAITA(AS) asm volatile("s_waitcnt vmcnt(12)" : "+v"(AS[0]), "+v"(AS[1]), "+v"(AS[2]), "+v"(AS[3]) :: "memory")
#define M3_WAITB(N) asm volatile("s_waitcnt vmcnt(" #N ")" : "+v"(Bn[0][0]), "+v"(Bn[0][1]), "+v"(Bn[0][2]), "+v"(Bn[0][3]), "+v"(Bn[1][0]), "+v"(Bn[1][1]), "+v"(Bn[1][2]), "+v"(Bn[1][3]) :: "memory")
#define M3_STEP(AS) if (cseg < 10) { \
              \
            int tk[4]; bool ok[4]; unsigned pl[4]; const int rt_ = cseg < 8; \
            _Pragma("unroll") for (int i = 0; i < 4; ++i) { const int idx = 16 * cbt + 4 * q + i; ok[i] = idx < cnr; const int ic = ok[i] ? idx : cnr - 1; pl[i] = plist[crbs + ic]; tk[i] = 128 * w + ic; } \
            _Pragma("unroll") for (int i = 0; i < 4; ++i) tk[i] = rt_ ? (int)(pl[i] >> 3) : tk[i]; \
            M3_WAITA(AS); \
            f32x4 acc[2]; \
            _Pragma("unroll") for (int nt = 0; nt < 2; ++nt) { acc[nt] = (f32x4){0.f, 0.f, 0.f, 0.f}; \
                _Pragma("unroll") for (int kk = 0; kk < 4; ++kk) acc[nt] = __builtin_amdgcn_mfma_f32_16x16x32_bf16(__builtin_bit_cast(bf16x8, AS[kk]), __builtin_bit_cast(bf16x8, Bc[nt][kk]), acc[nt], 0, 0, 0); } \
              \
            _Pragma("unroll") for (int i = 0; i < 4; ++i) { const long long lo_ = ok[i] ? (long long)__float2int_rn(acc[0][i] * 4194304.0f) : 0ll, hi_ = ok[i] ? (long long)__float2int_rn(acc[1][i] * 4194304.0f) : 0ll; \
                (void)__hip_atomic_fetch_add((LAS unsigned long long*)out + tk[i] * 16 + r, (unsigned long long)((hi_ << 32) + lo_), __ATOMIC_RELAXED, __HIP_MEMORY_SCOPE_WORKGROUP); } \
            M3_LOADA(AS, pseg, pbt, pnr, prbs); M3_ADV(pseg, pbt, pnr, prbs); \
            { const int old_ = cseg, nbat_ = (cnr + 15) >> 4; M3_ADV(cseg, cbt, cnr, crbs); \
              if (cseg != old_ && cseg < 10) { \
                  if (nbat_ == 1) M3_WAITB(4); else if (nbat_ == 2) M3_WAITB(8); else if (nbat_ == 3) M3_WAITB(12); else M3_WAITB(16); \
                  _Pragma("unroll") for (int nt = 0; nt < 2; ++nt) _Pragma("unroll") for (int kk = 0; kk < 4; ++kk) Bc[nt][kk] = Bn[nt][kk]; \
                  int nb_ = cseg; do { ++nb_; } while (nb_ < 8 && M3_NR(nb_) == 0); if (nb_ >= 10) nb_ = 9; M3_LOADB(Bn, nb_); } } }
        int cseg = -1, cbt = 0, cnr = 0, crbs = 0;
        do { ++cseg; } while (cseg < 8 && M3_NR(cseg) == 0);
        cnr = M3_NR(cseg); crbs = M3_RB(cseg);
        int pseg = cseg, pbt = 0, pnr = cnr, prbs = crbs;
        v4u Bc[2][4], Bn[2][4], A0[4], A1[4], A2[4], A3[4];
        M3_LOADB(Bc, cseg);
        M3_LOADA(A0, pseg, pbt, pnr, prbs); M3_ADV(pseg, pbt, pnr, prbs);
        M3_LOADA(A1, pseg, pbt, pnr, prbs); M3_ADV(pseg, pbt, pnr, prbs);
        M3_LOADA(A2, pseg, pbt, pnr, prbs); M3_ADV(pseg, pbt, pnr, prbs);
        M3_LOADA(A3, pseg, pbt, pnr, prbs); M3_ADV(pseg, pbt, pnr, prbs);
        { int nb_ = cseg; do { ++nb_; } while (nb_ < 8 && M3_NR(nb_) == 0); if (nb_ >= 10) nb_ = 9; M3_LOADB(Bn, nb_); }
        asm volatile("s_waitcnt vmcnt(0)" : "+v"(Bc[0][0]), "+v"(Bc[0][1]), "+v"(Bc[0][2]), "+v"(Bc[0][3]), "+v"(Bc[1][0]), "+v"(Bc[1][1]), "+v"(Bc[1][2]), "+v"(Bc[1][3]) :: "memory");
#pragma unroll 1
        while (cseg < 10) { M3_STEP(A0) M3_STEP(A1) M3_STEP(A2) M3_STEP(A3) }
        asm volatile("s_waitcnt vmcnt(0)" : "+v"(A0[0]), "+v"(A0[1]), "+v"(A0[2]), "+v"(A0[3]), "+v"(A1[0]), "+v"(A1[1]), "+v"(A1[2]), "+v"(A1[3]), "+v"(A2[0]), "+v"(A2[1]), "+v"(A2[2]), "+v"(A2[3]),
                     "+v"(A3[0]), "+v"(A3[1]), "+v"(A3[2]), "+v"(A3[3]), "+v"(Bn[0][0]), "+v"(Bn[0][1]), "+v"(Bn[0][2]), "+v"(Bn[0][3]), "+v"(Bn[1][0]), "+v"(Bn[1][1]), "+v"(Bn[1][2]), "+v"(Bn[1][3]) :: "memory");
#undef M3_NR
#undef M3_RB
#undef M3_GLD
#undef M3_LOADB
#undef M3_LOADA
#undef M3_ADV
#undef M3_WAITA
#undef M3_WAITB
#undef M3_STEP
        __syncthreads();
        { const int c4 = lane & 7, rs = lane >> 3, col = nc * 32 + 4 * c4;
          const f32x4 gv = *(const f32x4*)(g1 + col), bv = *(const f32x4*)(b1 + col);
#pragma unroll 4
          for (int it = 0; it < 16; ++it) { const int rl = 128 * w + 8 * it + rs; const size_t row = (size_t)tb * 1024 + rl;
              const f32x4 yv = *(const f32x4*)(Y1 + row * D + col); const f32x2 sv = *(const f32x2*)(ST1 + 2 * row);
              f32x4 tv; { const int nt = c4 >> 2, r0 = (4 * c4) & 15;
#pragma unroll
                  for (int j = 0; j < 4; ++j) { const v2u cell = *(const LAS v2u*)(out + rl * 32 + 2 * (r0 + j)); const int lo = (int)cell.x, hi = (int)cell.y + (lo < 0 ? 1 : 0); tv[j] = (float)(nt ? hi : lo) * (1.0f / 4194304.0f); } }
              const f32x4 y = ((yv - sv.x) * sv.y * gv + bv) * ALPHA + tv;
              *(f32x4*)(Y2 + row * D + col) = y;
              float sm = (y[0] + y[1]) + (y[2] + y[3]), sq = (y[0] * y[0] + y[1] * y[1]) + (y[2] * y[2] + y[3] * y[3]);
#pragma unroll
              for (int o = 1; o < 8; o <<= 1) { sm += shfl_x(sm, o, lane); sq += shfl_x(sq, o, lane); }
              if (c4 == 0) *(f32x2*)(PST2 + (row * 64 + nc) * 2) = (f32x2){sm, sq}; } }
    }
}

__device__ __forceinline__ void phase_moe4n(const Frame& F, const float* Y2, const float* pst, const float* gain, const float* bias, float* ST2, bf16* XBo, float* OUT, int last) {
    const int gw = F.bid * 8 + F.wave, NGW = F.G * 8, lane = F.lane;
    for (int t = gw; t < T; t += NGW) {
        f32x4 v[8];
#pragma unroll
        for (int j = 0; j < 8; ++j) v[j] = *(const f32x4*)(Y2 + (size_t)t * D + 4 * lane + 256 * j);
        const f32x2 pv = *(const f32x2*)(pst + ((size_t)t * 64 + lane) * 2);
        const float mean = wave_sum(pv.x, lane) * (1.0f / D); const float var = fmaxf(wave_sum(pv.y, lane) * (1.0f / D) - mean * mean, 0.f); const float rstd = 1.0f / sqrtf(var + LN_EPS);
        if (lane == 0) *(f32x2*)(ST2 + 2 * (size_t)t) = (f32x2){mean, rstd};
#pragma unroll
        for (int j = 0; j < 8; ++j) { const int c = 4 * lane + 256 * j; const f32x4 o = (v[j] - mean) * rstd * *(const f32x4*)(gain + c) + *(const f32x4*)(bias + c);
            if (last) *(f32x4*)(OUT + (size_t)t * D + c) = o;
            else { v2u wb; wb.x = pk2(o[0], o[1]); wb.y = pk2(o[2], o[3]); *(v2u*)(XBo + (size_t)t * D + c) = wb; } }
    }
}


__device__ __forceinline__ void phase_moe4q(const Frame& F, const bf16* X1, bf16* Y2, const unsigned char* Yq, const float* Ysc, const int* eidx, const int* inv, const float* gain, const float* bias, float* ST2, bf16* XBo, float* OUT, int last) {
    const LAS int* tpref = (const LAS int*)(F.lds + LDS_TAB);
    const int gw = F.bid * 8 + F.wave, NGW = F.G * 8, lane = F.lane;
    int en = 0, pn = 0; if (lane < 8 && gw < T) { en = eidx[gw * 8 + lane]; pn = inv[gw * 8 + lane]; }
    for (int t = gw; t < T; t += NGW) {
        int rowi = 0; if (lane < 8) rowi = tpref[en] * 256 + pn; else if (lane < 10) rowi = tpref[56 + lane] * 256 + t;
        if (lane < 8 && t + NGW < T) { en = eidx[(t + NGW) * 8 + lane]; pn = inv[(t + NGW) * 8 + lane]; }
        v4u pv[2][2], yv[10][2]; float sc[10][2];
#pragma unroll
        for (int j = 0; j < 2; ++j) { pv[j][0] = __builtin_nontemporal_load((const v4u*)(X1 + (size_t)t * D + 16 * lane + 1024 * j)); pv[j][1] = __builtin_nontemporal_load((const v4u*)(X1 + (size_t)t * D + 16 * lane + 1024 * j + 8)); }
#pragma unroll
        for (int k = 0; k < 10; ++k) { const size_t row = (size_t)__builtin_amdgcn_readlane(rowi, k);
#pragma unroll
            for (int j = 0; j < 2; ++j) { yv[k][j] = __builtin_nontemporal_load((const v4u*)(Yq + row * D + 16 * lane + 1024 * j)); sc[k][j] = __builtin_nontemporal_load(Ysc + row * 16 + 8 * j + (lane >> 3)); } }
#pragma unroll
        for (int k = 0; k < 10; ++k) asm volatile("" : "+v"(yv[k][0]), "+v"(yv[k][1]), "+v"(sc[k][0]), "+v"(sc[k][1]));
        float v[2][16];
#pragma unroll
        for (int j = 0; j < 2; ++j) { float f0[8], f1[8]; unpack8(pv[j][0], f0); unpack8(pv[j][1], f1);
            const float ss = (((sc[0][j] + sc[1][j]) + (sc[2][j] + sc[3][j])) + ((sc[4][j] + sc[5][j]) + (sc[6][j] + sc[7][j]))) + (sc[8][j] + sc[9][j]);
#pragma unroll
            for (int i = 0; i < 8; ++i) { v[j][i] = ALPHA * f0[i] - 128.f * ss; v[j][8 + i] = ALPHA * f1[i] - 128.f * ss; } }
#pragma unroll
        for (int k = 0; k < 10; ++k)
#pragma unroll
            for (int j = 0; j < 2; ++j) { const float s_ = sc[k][j]; const unsigned q[4] = {yv[k][j].x, yv[k][j].y, yv[k][j].z, yv[k][j].w};
#pragma unroll
                for (int d = 0; d < 4; ++d) { v[j][4 * d + 0] += s_ * (float)(q[d] & 0xffu); v[j][4 * d + 1] += s_ * (float)((q[d] >> 8) & 0xffu); v[j][4 * d + 2] += s_ * (float)((q[d] >> 16) & 0xffu); v[j][4 * d + 3] += s_ * (float)(q[d] >> 24); } }
        float sm = 0.f;
#pragma unroll
        for (int j = 0; j < 2; ++j)
#pragma unroll
            for (int i = 0; i < 16; i += 4) sm += (v[j][i] + v[j][i + 1]) + (v[j][i + 2] + v[j][i + 3]);
        const float mean = wave_sum(sm, lane) * (1.0f / D); float sq = 0.f;
#pragma unroll
        for (int j = 0; j < 2; ++j)
#pragma unroll
            for (int i = 0; i < 16; ++i) { const float d = v[j][i] - mean; sq += d * d; }
        const float rstd = 1.0f / sqrtf(wave_sum(sq, lane) * (1.0f / D) + LN_EPS);
        (void)ST2; (void)Y2;
#pragma unroll
        for (int j = 0; j < 2; ++j)
#pragma unroll
            for (int h = 0; h < 2; ++h) { const int c = 16 * lane + 1024 * j + 8 * h; const float* vv = &v[j][8 * h];
                const f32x4 g0 = *(const f32x4*)(gain + c), g1 = *(const f32x4*)(gain + c + 4), b0 = *(const f32x4*)(bias + c), b1 = *(const f32x4*)(bias + c + 4);
                const f32x4 o0 = ((f32x4){vv[0], vv[1], vv[2], vv[3]} - mean) * rstd * g0 + b0, o1 = ((f32x4){vv[4], vv[5], vv[6], vv[7]} - mean) * rstd * g1 + b1;
                if (last) { *(f32x4*)(OUT + (size_t)t * D + c) = o0; *(f32x4*)(OUT + (size_t)t * D + c + 4) = o1; }
                else { v4u wb; wb.x = pk2(o0[0], o0[1]); wb.y = pk2(o0[2], o0[3]); wb.z = pk2(o1[0], o1[1]); wb.w = pk2(o1[2], o1[3]); *(v4u*)(XBo + (size_t)t * D + c) = wb; } }
    }
}

__device__ __forceinline__ void phase_downproj3(const Frame& F, const bf16* H, const bf16* WD, const bf16* HSp, const bf16* WSD, unsigned char* Yq, float* Ysc, int NT) {
    const LAS int* tpref = (const LAS int*)(F.lds + LDS_TAB); const LAS int* cl = (const LAS int*)(F.lds + LDS_TAB + 512);
    LAS unsigned char* lds = F.lds;
    const int tid = F.tid, lane = F.lane, w = F.wave, fr = lane & 15, fq = lane >> 4;
    unsigned rbB[2], cbB[2];
#pragma unroll
    for (int i = 0; i < 2; ++i) { int R_, C_; g8::stage_rc(tid * 16 + i * 8192, R_, C_); rbB[i] = (unsigned)((R_ & ~31) + g8::perm32(R_ & 31)); cbB[i] = (unsigned)C_ * 2u; }
    const unsigned ldsw = (unsigned)w * 1024u, lbase = (unsigned)(size_t)lds;
    int boffg[4];
#pragma unroll
    for (int g = 0; g < 4; ++g) boffg[g] = g8::lds_byte(32 * g + fr, fq * 8);
    LAS unsigned char* stg = lds + 65536 + w * (32 * 144);
    const int NU = NT * 4;
    const int upos = (F.G % 8) == 0 ? (F.bid & 7) * (F.G >> 3) + (F.bid >> 3) : F.bid;
    int ub = 0;
    int u = (F.G <= NU) ? upos : F.bid; if (u >= NU) return;
#define DP3_UNITINFO(uu, E0, EXP, NV) do { const int tl_ = (uu) >> 2; int e_ = (E0); while (__builtin_amdgcn_readfirstlane(tpref[e_ + 1]) <= tl_) ++e_; EXP = e_; \
        NV = __builtin_amdgcn_readfirstlane(cl[e_]) - (tl_ - __builtin_amdgcn_readfirstlane(tpref[e_])) * 256; } while (0)
#define DP3_GLDS(gsrc, ldsdst) do { unsigned keep_; asm volatile("s_mov_b32 %0, m0\n\ts_mov_b32 m0, %2\n\ts_nop 0\n\tglobal_load_lds_dwordx4 %1, off\n\ts_mov_b32 m0, %0" : "=&s"(keep_) : "v"(gsrc), "s"(ldsdst) : "memory"); } while (0)
#define DP3_STAGE(slot, gb, bs) do { const unsigned v0_ = rbB[0] * (unsigned)(bs) + cbB[0], v1_ = rbB[1] * (unsigned)(bs) + cbB[1]; _Pragma("unroll") for (int kt = 0; kt < 2; ++kt) { \
        DP3_GLDS((const void*)((gb) + kt * 128 + v0_), lbase + (unsigned)((slot) * 32768 + kt * 16384) + ldsw); \
        DP3_GLDS((const void*)((gb) + kt * 128 + v1_), lbase + (unsigned)((slot) * 32768 + kt * 16384) + ldsw + 8192u); } } while (0)
#define DP3_SRC(uu, ee, AB, AS, BB, BS) do { const int tl_ = (uu) >> 2, cu_ = ((uu) & 3) * 512; \
        if ((ee) < 64) { AB = (const char*)(H + (size_t)tl_ * 256 * EDIM); AS = EDIM * 2; BB = (const char*)(WD + (size_t)(ee) * D * EDIM + (size_t)cu_ * EDIM); BS = EDIM * 2; } \
        else { const int t0_ = (tl_ - __builtin_amdgcn_readfirstlane(tpref[ee])) * 256; AB = (const char*)(HSp + (size_t)t0_ * SDIM + ((ee) - 64) * EDIM); AS = SDIM * 2; \
               BB = (const char*)(WSD + (size_t)cu_ * SDIM + ((ee) - 64) * EDIM); BS = SDIM * 2; } } while (0)
    int ecur, nvcur; DP3_UNITINFO(u, 0, ecur, nvcur);
    const char* abc; const char* gbc; int asc, bsc; DP3_SRC(u, ecur, abc, asc, gbc, bsc);
    bf16x8 A[2][4], An[2][4];
    { const char* ap_ = abc + (size_t)(32 * w + fr) * asc + 16 * fq;
#pragma unroll
      for (int m = 0; m < 2; ++m)
#pragma unroll
          for (int kk = 0; kk < 4; ++kk) A[m][kk] = *(const bf16x8*)(ap_ + (size_t)m * 16 * asc + 64 * kk); }
    DP3_STAGE(0, gbc, bsc);
    asm volatile("s_waitcnt vmcnt(0)" ::: "memory");
#pragma unroll 1
    for (;;) {
        int un = u; { const int nb = ub + F.G; if (nb + F.G <= NU) un = nb + upos; else if (nb + F.bid < NU) un = nb + F.bid; if (un != u) ub = nb; }
        int enx, nvnx; DP3_UNITINFO(un, (un > u ? ecur : 0), enx, nvnx);
        const char* abn; const char* gbn; int asn, bsn; DP3_SRC(un, enx, abn, asn, gbn, bsn);
        const int tile = u >> 2, colu = (u & 3) * 512;
        float scq[2][4];
#pragma unroll
        for (int c = 0; c < 4; ++c) {
            if (c == 0) asm volatile("s_waitcnt vmcnt(5)" ::: "memory"); else asm volatile("s_waitcnt vmcnt(4)" ::: "memory");
            __builtin_amdgcn_s_barrier();
            if (c == 3) { const char* ap_ = abn + (size_t)(32 * w + fr) * asn + 16 * fq;
#pragma unroll
                for (int m = 0; m < 2; ++m) { const char* am_ = ap_ + (size_t)m * 16 * asn;
                    asm volatile("global_load_dwordx4 %0, %1, off" : "=&v"(An[m][0]) : "v"(am_) : "memory"); asm volatile("global_load_dwordx4 %0, %1, off offset:64" : "=&v"(An[m][1]) : "v"(am_) : "memory");
                    asm volatile("global_load_dwordx4 %0, %1, off offset:128" : "=&v"(An[m][2]) : "v"(am_) : "memory"); asm volatile("global_load_dwordx4 %0, %1, off offset:192" : "=&v"(An[m][3]) : "v"(am_) : "memory"); } }
            { const char* gnext = (c < 3) ? gbc + (size_t)(c + 1) * 128 * bsc : gbn; const int bnext = (c < 3) ? bsc : bsn; DP3_STAGE((c + 1) & 1, gnext, bnext); }
            __builtin_amdgcn_sched_barrier(0);
            f32x4 acc[2][4][2];
#pragma unroll
            for (int g = 0; g < 4; ++g) { bf16x8 Bf[2][4];
#pragma unroll
                for (int n = 0; n < 2; ++n)
#pragma unroll
                    for (int kk = 0; kk < 4; ++kk) Bf[n][kk] = *(const LAS bf16x8*)(lds + (c & 1) * 32768 + (kk >> 1) * 16384 + boffg[g] + n * 2048 + (kk & 1) * 1024);
#pragma unroll
                for (int m = 0; m < 2; ++m)
#pragma unroll
                    for (int n = 0; n < 2; ++n) { acc[m][g][n] = (f32x4){0.f, 0.f, 0.f, 0.f};
#pragma unroll
                        for (int kk = 0; kk < 4; ++kk) acc[m][g][n] = __builtin_amdgcn_mfma_f32_16x16x32_bf16(Bf[n][kk], A[m][kk], acc[m][g][n], 0, 0, 0); } }
#pragma unroll
            for (int m = 0; m < 2; ++m) {
                float am0 = 0.f, am1 = 0.f;
#pragma unroll
                for (int g = 0; g < 4; ++g)
#pragma unroll
                    for (int n = 0; n < 2; ++n) { am0 = fmaxf(fmaxf(am0, fabsf(acc[m][g][n][0])), fabsf(acc[m][g][n][1])); am1 = fmaxf(fmaxf(am1, fabsf(acc[m][g][n][2])), fabsf(acc[m][g][n][3])); }
                float am = fmaxf(am0, am1);
                am = fmaxf(am, shfl_x(am, 16, lane)); am = fmaxf(am, shfl_x(am, 32, lane));
                am = fminf(am, 3.0e38f);
                const float isc = am > 0.f ? 127.0f * __builtin_amdgcn_rcpf(am) : 0.f;
                scq[m][c] = am * (1.0f / 127.0f);
                const f32x2_t isc2 = (f32x2_t){isc, isc}, mg2 = (f32x2_t){8388736.0f, 8388736.0f};
#pragma unroll
                for (int g = 0; g < 4; ++g) { unsigned qd[2];
#pragma unroll
                    for (int n = 0; n < 2; ++n) {
                        const f32x2_t tl = __builtin_elementwise_fma((f32x2_t){acc[m][g][n][0], acc[m][g][n][1]}, isc2, mg2), th = __builtin_elementwise_fma((f32x2_t){acc[m][g][n][2], acc[m][g][n][3]}, isc2, mg2);
                        const float f0_ = tl.x, f1_ = tl.y, f2_ = th.x, f3_ = th.y;
                        qd[n] = __builtin_amdgcn_perm(__builtin_bit_cast(unsigned, f1_), __builtin_bit_cast(unsigned, f0_), 0x0c0c0400u) | __builtin_amdgcn_perm(__builtin_bit_cast(unsigned, f3_), __builtin_bit_cast(unsigned, f2_), 0x04000c0cu); }
                    *(LAS v2u*)(stg + (16 * m + fr) * 144 + 32 * g + 8 * fq) = (v2u){qd[0], qd[1]}; } }
#pragma unroll
            for (int it = 0; it < 4; ++it) { const int rr = 8 * it + (lane >> 3);
                const v4u o = *(const LAS v4u*)(stg + rr * 144 + (lane & 7) * 16);
                __builtin_nontemporal_store(o, (v4u*)(Yq + (size_t)(tile * 256 + 32 * w + rr) * D + colu + 128 * c + 16 * (lane & 7))); }
            if (c == 3) { const f32x4 so = fq == 0 ? (f32x4){scq[0][0], scq[0][1], scq[0][2], scq[0][3]} : (f32x4){scq[1][0], scq[1][1], scq[1][2], scq[1][3]};
                if (fq < 2) __builtin_nontemporal_store(so, (f32x4*)(Ysc + (size_t)(tile * 256 + 32 * w + 16 * fq + fr) * 16 + (colu >> 7))); }
            __builtin_amdgcn_sched_barrier(0);
        }
        asm volatile("s_waitcnt vmcnt(9)" : "+v"(An[0][0]), "+v"(An[0][1]), "+v"(An[0][2]), "+v"(An[0][3]), "+v"(An[1][0]), "+v"(An[1][1]), "+v"(An[1][2]), "+v"(An[1][3]) :: "memory");
        if (un == u) break;
#pragma unroll
        for (int m = 0; m < 2; ++m)
#pragma unroll
            for (int kk = 0; kk < 4; ++kk) A[m][kk] = An[m][kk];
        u = un; ecur = enx; nvcur = nvnx; abc = abn; asc = asn; gbc = gbn; bsc = bsn;
    }
    asm volatile("s_waitcnt vmcnt(0)" ::: "memory");
#undef DP3_UNITINFO
#undef DP3_STAGE
#undef DP3_GLDS
#undef DP3_SRC
}

enum { PH_PRO = 0, PH_POOL_G1, PH_POOL_P, PH_POOL_G2, PH_POOL_G3, PH_DIL_G1, PH_DIL_ATT, PH_DIL_CMB, PH_DIL_G2, PH_CONV_G1, PH_CONV_E, PH_CONV_G2, PH_MOE1, PH_MOE2, PH_MOE3, PH_MOE4, PH_COUNT };

template <int PH>
__device__ __forceinline__ void run_phase(const Frame& Fin, const Args& args_, const int L) {
    Frame F = Fin; { int w_ = Fin.wave, l_; asm volatile("" : "+s"(w_)); asm volatile("v_mbcnt_lo_u32_b32 %0, -1, 0\n\tv_mbcnt_hi_u32_b32 %0, -1, %0" : "=v"(l_)); F.wave = w_; F.lane = l_; F.tid = w_ * 64 + l_; }
    unsigned char* ws; { GAS unsigned char* wsg = (GAS unsigned char*)Fin.ws; asm volatile("" : "+s"(wsg)); ws = (unsigned char*)wsg; } F.ws = ws; F.ctl = (unsigned*)(ws + WS_CTL);
    KP kp = (KP)__builtin_amdgcn_kernarg_segment_ptr(); asm volatile("" : "+s"(kp)); (void)args_;
    { unsigned l_ = (unsigned)(size_t)Fin.lds; asm volatile("" : "+s"(l_)); F.lds = (LAS unsigned char*)(size_t)l_; }
    LAS unsigned char* ring = F.lds; int c = (int)blockIdx.x; { int g_ = Fin.G; asm volatile("" : "+s"(c), "+s"(g_)); F.G = g_; F.bid = c; }
    const float* xres = ain(kp, IN_X);
    const float* st2 = (const float*)(ws + WS_ST2); float* pstp = (float*)(ws + WS_PST);
    const float* g2p = ain(kp, IN_LNG) + (size_t)((L > 0 ? L - 1 : 0) * 2 + 1) * D; const float* b2p = ain(kp, IN_LNB) + (size_t)((L > 0 ? L - 1 : 0) * 2 + 1) * D;
    const bf16* xb = (const bf16*)(ws + WS_XB);
    bf16* yf = (bf16*)(ws + WS_YF);
    unsigned char* big = ws + WS_BIG;
    const int ia = L / 3;
    if constexpr (PH == PH_PRO) { phase_prologue(F, kp); }
    if constexpr (PH == PH_POOL_G1) { g8::DenseSched S; S.init(xb, (const bf16*)(ws + WS_W_POOL_IN) + (size_t)ia * D * D, T, D, D, D, F.G, c);
        g8::EpiBf16 E{(bf16*)(big + BG_U), D, 0}; g8::gemm_phase<g8::EpiBf16, g8::DenseSched, false>(ring, F.tid, D, D, D, S, E); }
    if constexpr (PH == PH_POOL_P) { phase_pool(F, (const bf16*)(big + BG_U), (bf16*)(big + BG_PL)); }
    if constexpr (PH == PH_POOL_G2) { g8::DenseSched S; S.init((const bf16*)(big + BG_PL), (const bf16*)(ws + WS_W_POOL_G) + (size_t)ia * D * 512, T, D, D, 512, F.G, c); S.agrp_shift = 1; S.agrp_stride = 512 * 2;
        g8::EpiScaleBf16 E{(bf16*)(big + BG_MX), D, ain(kp, IN_PSC) + (size_t)ia * D}; g8::gemm_phase<g8::EpiScaleBf16, g8::DenseSched, false>(ring, F.tid, 512, D, 512, S, E); }
    if constexpr (PH == PH_POOL_G3) { g8::DenseSched S; S.init((const bf16*)(big + BG_MX), (const bf16*)(ws + WS_W_POOL_OUT) + (size_t)ia * D * D, T, D, D, D, F.G, c);
        g8::EpiResidLN E{xres, xb, st2, g2p, b2p, yf, pstp, 2}; g8::gemm_phase<g8::EpiResidLN, g8::DenseSched, false>(ring, F.tid, D, D, D, S, E); }
    if constexpr (PH == PH_DIL_G1) { g8::DenseSched S; S.init(xb, (const bf16*)(ws + WS_W_DIL_QKV), T, QKVC, D, D, F.G, c);
        g8::EpiBf16 E{(bf16*)(big + BG_QKV), QKVC, 1}; g8::gemm_phase<g8::EpiBf16, g8::DenseSched, false>(ring, F.tid, D, D, D, S, E); }
    if constexpr (PH == PH_DIL_ATT) { phase_attn(F, (const bf16*)(big + BG_QKV), ain(kp, IN_RELB), (bf16*)(big + BG_OG), (float*)(big + BG_LSE)); }
    if constexpr (PH == PH_DIL_CMB) { phase_combine(F, (const bf16*)(big + BG_OG), (const float*)(big + BG_LSE), (bf16*)(big + BG_O)); }
    if constexpr (PH == PH_DIL_G2) { g8::DenseSched S; S.init((const bf16*)(big + BG_O), (const bf16*)(ws + WS_W_DIL_OUT), T, D, DILW, DILW, F.G, c);
        g8::EpiResidLN E{xres, xb, st2, g2p, b2p, yf, pstp, 2}; g8::gemm_phase<g8::EpiResidLN, g8::DenseSched, false>(ring, F.tid, DILW, DILW, DILW, S, E); }
    if constexpr (PH == PH_CONV_G1) { g8::DenseSched S; S.init(xb, (const bf16*)(ws + WS_W_CONV_IN), T, 3 * D, D, D, F.G, c);
        g8::EpiConvIn E{(bf16*)(big + BG_UC), (bf16*)(big + BG_BG)}; g8::gemm_phase<g8::EpiConvIn, g8::DenseSched, false>(ring, F.tid, D, D, D, S, E); }
    if constexpr (PH == PH_CONV_E) { phase_conv(F, (const bf16*)(big + BG_UC), (const bf16*)(big + BG_BG), ain(kp, IN_CW), (bf16*)(big + BG_Z)); }
    if constexpr (PH == PH_CONV_G2) { g8::DenseSched S; S.init((const bf16*)(big + BG_Z), (const bf16*)(ws + WS_W_CONV_OUT), T, D, D, D, F.G, c);
        g8::EpiResidLN E{xres, xb, st2, g2p, b2p, yf, pstp, 2}; g8::gemm_phase<g8::EpiResidLN, g8::DenseSched, false>(ring, F.tid, D, D, D, S, E); }
    unsigned* cnt = F.ctl + CW_CNT + L * 64 * 16;
    float* x1f = (float*)(ws + WS_X1F); bf16* x1b = (bf16*)(ws + WS_X1B);
    int* ltok = (int*)(ws + WS_LTOK); float* lgate = (float*)(ws + WS_LGATE); int* eidx = (int*)(ws + WS_EIDX); int* inv = (int*)(ws + WS_INV);
    bf16* HB = (bf16*)(ws + WS_HB); bf16* HS = (bf16*)(ws + WS_HS); bf16* Yr = (bf16*)(ws + WS_BIG);
    if constexpr (PH == PH_MOE1) {
        const float* g1 = ain(kp, IN_LNG) + (size_t)(L * 2 + 0) * D; const float* b1 = ain(kp, IN_LNB) + (size_t)(L * 2 + 0) * D;
        phase_moe1n(F, yf, pstp, g1, b1, (const bf16*)(ws + WS_RWH) + (size_t)L * NEXP * D, (const bf16*)(ws + WS_RWL) + (size_t)L * NEXP * D, ain(kp, IN_RB) + (size_t)L * NEXP,
                    x1b, (float*)(ws + WS_ST1), cnt, ltok, lgate, eidx, inv); }
    if constexpr (PH == PH_MOE2) {
        const int NT = build_tiles(F, cnt);
        { g8::ExpertSched<1, true> S; S.tpref = (const LAS int*)(F.lds + LDS_TAB); S.cnt = (const LAS int*)(F.lds + LDS_TAB + 512); S.A = (const char*)x1b; S.B = (const char*)((const bf16*)(ws + WS_W_EX_GU) + (size_t)L * 64 * 256 * D);
          S.tok = ltok; S.b_exp = (size_t)256 * D * 2; S.b_tile = 0; S.a_tile = 0; S.NU = NT; S.G = F.G; S.c = c;
          g8::EpiExpertGU E{HB}; g8::gemm_phase<g8::EpiExpertGU, g8::ExpertSched<1, true>, true>(ring, F.tid, D, D, D, S, E); }
        { const int rot = (c - (NT % F.G) + F.G) % F.G;
          g8::DenseSched S; S.init(x1b, (const bf16*)(ws + WS_W_SH_GU) + (size_t)L * 512 * D, T, 512, D, D, F.G, rot);
          int t2 = F.tid; asm volatile("" : "+v"(t2));
          g8::EpiSharedGU E{HS}; g8::gemm_phase<g8::EpiSharedGU, g8::DenseSched, false>(ring, t2, D, D, D, S, E); } }
    if constexpr (PH == PH_MOE3) {
        const float* g1 = ain(kp, IN_LNG) + (size_t)(L * 2 + 0) * D; const float* b1 = ain(kp, IN_LNB) + (size_t)(L * 2 + 0) * D;
        const int NT = build_tiles(F, cnt);
        __syncthreads();
        phase_downproj3(F, HB, (const bf16*)(ws + WS_W_EX_D) + (size_t)L * 64 * D * EDIM, HS, (const bf16*)(ws + WS_W_SH_D) + (size_t)L * D * SDIM, (unsigned char*)Yr, (float*)(ws + WS_BIG + BG_YSC), NT + 2 * (T / 256));
        (void)g1; (void)b1; }
    if constexpr (PH == PH_MOE4) { (void)build_tiles(F, cnt);
        const float* g2 = ain(kp, IN_LNG) + (size_t)(L * 2 + 1) * D; const float* b2 = ain(kp, IN_LNB) + (size_t)(L * 2 + 1) * D;
        phase_moe4q(F, x1b, (bf16*)(ws + WS_Y2F), (const unsigned char*)Yr, (const float*)(ws + WS_BIG + BG_YSC), eidx, inv, g2, b2, (float*)(ws + WS_ST2), (bf16*)(ws + WS_XB), aout(kp), L == DEPTH - 1); }
}
__device__ __forceinline__ void make_frame(Frame& F, const Args& args) {
    extern __shared__ __attribute__((aligned(16))) unsigned char lds_raw[];
    F.lds = (LAS unsigned char*)lds_raw; F.ws = args.ws; F.ctl = (unsigned*)(args.ws + WS_CTL);
    F.tid = threadIdx.x; F.lane = F.tid & 63; F.wave = __builtin_amdgcn_readfirstlane(F.tid >> 6); F.G = gridDim.x; F.bid = blockIdx.x;
}
template <int PH> __global__ void __launch_bounds__(512, 2) k_phase(Args args, int L) {
    Frame F; make_frame(F, args);
    run_phase<PH>(F, args, L);
}

#ifndef MK_NOINLINE
#define MK_NOINLINE 0
#endif
#if MK_NOINLINE
template <int PH> __device__ __noinline__ void call_phase_ni(const int L) {
    Args dummy{}; Frame F;
    KP kp = (KP)__builtin_amdgcn_kernarg_segment_ptr();
    extern __shared__ __attribute__((aligned(16))) unsigned char lds_raw[];
    F.lds = (LAS unsigned char*)lds_raw; F.ws = (unsigned char*)((GAS unsigned char* const CAS*)kp)[20]; F.ctl = (unsigned*)(F.ws + WS_CTL);
    F.tid = threadIdx.x; F.lane = F.tid & 63; F.wave = __builtin_amdgcn_readfirstlane(F.tid >> 6); F.G = gridDim.x; F.bid = blockIdx.x;
    run_phase<PH>(F, dummy, L);
}
template <int PH> __device__ __forceinline__ void call_phase(const Frame& F, const Args& args, const int L) { call_phase_ni<PH>(L); }
#else
template <int PH> __device__ __forceinline__ void call_phase(const Frame& F, const Args& args, const int L) { asm volatile("; PHASE_BEGIN %0" :: "n"(PH)); run_phase<PH>(F, args, L); asm volatile("; PHASE_END %0" :: "n"(PH)); }
#endif
__global__ void __launch_bounds__(512, 2) fwd_all(Args args) {
    Frame F; make_frame(F, args);
    volatile LAS unsigned* misc = (volatile LAS unsigned*)(F.lds + LDS_MISC);
    if (F.tid < 4) misc[F.tid] = 0u;
    __syncthreads();
    const int lo = args.ph_lo, hi = args.ph_hi;
    XcdBarrier bar; bar.bar = F.ctl + CW_BAR; bar.x = 0; bar.st = misc;
    if (hi - lo > 1) bar = xcd_barrier_post(F.ctl + CW_BAR, misc);
    int pc = 0;
#ifndef MK_DUP_MASK
#define MK_DUP_MASK 0
#endif
#if MK_DUP_MASK
#define STEP(PH, Lx) do { if (pc >= lo && pc < hi) { int nrep_ = ((MK_DUP_MASK >> (PH)) & 1) ? 2 : 1; asm volatile("" : "+s"(nrep_)); _Pragma("unroll 1") for (int r_ = 0; r_ < nrep_; ++r_) { call_phase<PH>(F, args, Lx); if (r_ + 1 < nrep_ || pc + 1 < hi) xcd_barrier(bar); } } ++pc; } while (0)
#else
#define STEP(PH, Lx) do { if (pc >= lo && pc < hi) { call_phase<PH>(F, args, Lx); if (pc + 1 < hi) xcd_barrier(bar); } ++pc; } while (0)
#endif
    STEP(PH_PRO, 0);
#pragma unroll 1
    for (int L = 0; L < DEPTH; ++L) {
        const int kind = L % 3;
        if (kind == 0) { STEP(PH_POOL_G1, L); STEP(PH_POOL_P, L); STEP(PH_POOL_G2, L); STEP(PH_POOL_G3, L); }
        else if (kind == 1) { STEP(PH_DIL_G1, L); STEP(PH_DIL_ATT, L); STEP(PH_DIL_CMB, L); STEP(PH_DIL_G2, L); }
        else { STEP(PH_CONV_G1, L); STEP(PH_CONV_E, L); STEP(PH_CONV_G2, L); }
        STEP(PH_MOE1, L); STEP(PH_MOE2, L); STEP(PH_MOE3, L); STEP(PH_MOE4, L);
    }
#undef STEP
}
constexpr int N_STEPS = 1 + 2 * 8 + 8 + 7;

template <int PH> static void launch_phase(const Args& a, int L, int grid, hipStream_t stream) {
    static bool attr = false;
    if (!attr) { (void)hipFuncSetAttribute((const void*)k_phase<PH>, hipFuncAttributeMaxDynamicSharedMemorySize, LDS_BYTES); attr = true; }
    hipLaunchKernelGGL(k_phase<PH>, dim3(grid), dim3(512), LDS_BYTES, stream, a, L);
}
extern "C" void kernel_launch(void* const* d_in, const int* in_sizes, int n_in, void* d_out, int out_size, void* d_ws, size_t ws_size, hipStream_t stream) {
    static int grid = 0;
    if (grid == 0) {
        if (n_in != 19 || out_size != T * D || ws_size < WS_END) { fprintf(stderr, "kernel_launch: unexpected shapes (n_in %d out %d ws %zu need %zu)\n", n_in, out_size, ws_size, (size_t)WS_END); grid = -1; return; }
        int dev = 0, cus = 0;
        if (hipGetDevice(&dev) != hipSuccess || hipDeviceGetAttribute(&cus, hipDeviceAttributeMultiprocessorCount, dev) != hipSuccess) { grid = -1; return; }
#if MK_ONE_LAUNCH
        if (hipFuncSetAttribute((const void*)fwd_all, hipFuncAttributeMaxDynamicSharedMemorySize, LDS_BYTES) != hipSuccess) { fprintf(stderr, "kernel_launch: hipFuncSetAttribute failed\n"); grid = -1; return; }
        int per_cu = 0;
        if (hipOccupancyMaxActiveBlocksPerMultiprocessor(&per_cu, (const void*)fwd_all, 512, LDS_BYTES) != hipSuccess || per_cu < 1) { fprintf(stderr, "kernel_launch: note: occupancy query reports %d blocks per CU\n", per_cu); (void)hipGetLastError(); }
#endif
        grid = cus;
    }
    if (grid < 0) return;
    (void)hipMemsetAsync((char*)d_ws + WS_CTL, 0, CTL_ZERO_BYTES, stream);
    Args a{};
    for (int i = 0; i < 19; ++i) a.in[i] = (const float*)d_in[i];
    a.out = (float*)d_out; a.ws = (unsigned char*)d_ws; a.ph_lo = 0; a.ph_hi = 0;
#if MK_ONE_LAUNCH
#ifdef MK_SPLIT
    for (int p = 0; p < N_STEPS; ++p) { a.ph_lo = p; a.ph_hi = p + 1; hipLaunchKernelGGL(fwd_all, dim3(grid), dim3(512), LDS_BYTES, stream, a); }
#else
    a.ph_lo = 0; a.ph_hi = N_STEPS;
    hipLaunchKernelGGL(fwd_all, dim3(grid), dim3(512), LDS_BYTES, stream, a);
#endif
#elif defined(MK_HYBRID_MASK)
    {
        static bool attr2 = false; if (!attr2) { (void)hipFuncSetAttribute((const void*)fwd_all, hipFuncAttributeMaxDynamicSharedMemorySize, LDS_BYTES); attr2 = true; }
        int pc = 0;
#define HSTEP(PH, Lx) do { if ((MK_HYBRID_MASK >> (PH)) & 1) { a.ph_lo = pc; a.ph_hi = pc + 1; hipLaunchKernelGGL(fwd_all, dim3(grid), dim3(512), LDS_BYTES, stream, a); } else { a.ph_lo = 0; a.ph_hi = 0; launch_phase<PH>(a, Lx, grid, stream); } ++pc; } while (0)
        HSTEP(PH_PRO, 0);
        for (int L = 0; L < DEPTH; ++L) {
            const int kind = L % 3;
            if (kind == 0) { HSTEP(PH_POOL_G1, L); HSTEP(PH_POOL_P, L); HSTEP(PH_POOL_G2, L); HSTEP(PH_POOL_G3, L); }
            else if (kind == 1) { HSTEP(PH_DIL_G1, L); HSTEP(PH_DIL_ATT, L); HSTEP(PH_DIL_CMB, L); HSTEP(PH_DIL_G2, L); }
            else { HSTEP(PH_CONV_G1, L); HSTEP(PH_CONV_E, L); HSTEP(PH_CONV_G2, L); }
            HSTEP(PH_MOE1, L); HSTEP(PH_MOE2, L); HSTEP(PH_MOE3, L); HSTEP(PH_MOE4, L);
        }
#undef HSTEP
    }
#else
    launch_phase<PH_PRO>(a, 0, grid, stream);
    for (int L = 0; L < DEPTH; ++L) {
        const int kind = L % 3;
        if (kind == 0) { launch_phase<PH_POOL_G1>(a, L, grid, stream); launch_phase<PH_POOL_P>(a, L, grid, stream); launch_phase<PH_POOL_G2>(a, L, grid, stream); launch_phase<PH_POOL_G3>(a, L, grid, stream); }
        else if (kind == 1) { launch_phase<PH_DIL_G1>(a, L, grid, stream); launch_phase<PH_DIL_ATT>(a, L, grid, stream); launch_phase<PH_DIL_CMB>(a, L, grid, stream); launch_phase<PH_DIL_G2>(a, L, grid, stream); }
        else { launch_phase<PH_CONV_G1>(a, L, grid, stream); launch_phase<PH_CONV_E>(a, L, grid, stream); launch_phase<PH_CONV_G2>(a, L, grid, stream); }
        launch_phase<PH_MOE1>(a, L, grid, stream); launch_phase<PH_MOE2>(a, L, grid, stream); launch_phase<PH_MOE3>(a, L, grid, stream); launch_phase<PH_MOE4>(a, L, grid, stream);
    }
#endif
}
```

```cpp
#include <hip/hip_runtime.h>
#include <cstdio>
#include <cstdint>

#ifndef MK_ONE_LAUNCH
#define MK_ONE_LAUNCH 1
#endif

#define GAS __attribute__((address_space(1)))
#define LAS __attribute__((address_space(3)))
typedef unsigned short bf16;
typedef unsigned v4u __attribute__((ext_vector_type(4)));
typedef unsigned v2u __attribute__((ext_vector_type(2)));
typedef float f32x4 __attribute__((ext_vector_type(4)));
typedef float f32x2 __attribute__((ext_vector_type(2)));
typedef short bf16x8 __attribute__((ext_vector_type(8)));
typedef short s16x4 __attribute__((ext_vector_type(4)));

constexpr int NBATCH = 8, SEQ = 2048, D = 2048, T = NBATCH * SEQ, DEPTH = 4;
constexpr int NEXP = 64, TOPK = 8, EDIM = 128, SDIM = 256;
constexpr int QKVC = 4608, DILW = 512;
constexpr float ALPHA = 1.681792830507429f;
constexpr float LN_EPS = 1e-5f;
constexpr int CAP = 16384;
constexpr int HROWS = T * TOPK + NEXP * 256;

constexpr size_t MiB = 1u << 20;
constexpr size_t WS_CTL = 0, CTL_ZERO_BYTES = 1 * MiB;
constexpr size_t WS_W_POOL_IN = 1 * MiB;
constexpr size_t WS_W_POOL_G = WS_W_POOL_IN + 16 * MiB;
constexpr size_t WS_W_POOL_OUT = WS_W_POOL_G + 4 * MiB;
constexpr size_t WS_W_DIL_QKV = WS_W_POOL_OUT + 16 * MiB;
constexpr size_t WS_W_DIL_OUT = WS_W_DIL_QKV + 18 * MiB;
constexpr size_t WS_W_CONV_IN = WS_W_DIL_OUT + 2 * MiB;
constexpr size_t WS_W_CONV_OUT = WS_W_CONV_IN + 24 * MiB;
constexpr size_t WS_W_SH_GU = WS_W_CONV_OUT + 8 * MiB;
constexpr size_t WS_W_SH_D = WS_W_SH_GU + 8 * MiB;
constexpr size_t WS_W_EX_GU = WS_W_SH_D + 4 * MiB;
constexpr size_t WS_W_EX_D = WS_W_EX_GU + 256 * MiB;
constexpr size_t WS_XF = WS_W_EX_D + 256 * MiB;
constexpr size_t WS_YF = WS_XF + 128 * MiB;
constexpr size_t WS_X1F = WS_YF + 128 * MiB;
constexpr size_t WS_XB = WS_X1F + 128 * MiB;
constexpr size_t WS_X1B = WS_XB + 64 * MiB;
constexpr size_t WS_HB = WS_X1B + 64 * MiB;
constexpr size_t WS_HS = WS_HB + 72 * MiB;
constexpr size_t WS_LTOK = WS_HS + 8 * MiB;
constexpr size_t WS_LGATE = WS_LTOK + 4 * MiB;
constexpr size_t WS_EIDX = WS_LGATE + 4 * MiB;
constexpr size_t WS_INV = WS_EIDX + 1 * MiB;
constexpr size_t WS_BIG = WS_INV + 1 * MiB;
constexpr size_t WS_PST = WS_BIG + 608 * MiB;
constexpr size_t WS_ST1 = WS_PST + 4 * MiB;
constexpr size_t WS_ST2 = WS_ST1 + 1 * MiB;
constexpr size_t WS_RWH = WS_ST2 + 1 * MiB;
constexpr size_t WS_RWL = WS_RWH + 1 * MiB;
constexpr size_t WS_PST2 = WS_RWL + 1 * MiB;
constexpr size_t WS_END = WS_PST2 + 8 * MiB;
constexpr size_t WS_Y2F = WS_X1F;
constexpr size_t BG_U = 0, BG_PL = 64 * MiB, BG_MX = 128 * MiB;
constexpr size_t BG_QKV = 0, BG_OG = 144 * MiB, BG_LSE = 192 * MiB, BG_O = 194 * MiB;
constexpr size_t BG_UC = 0, BG_BG = 64 * MiB, BG_Z = 128 * MiB;
constexpr size_t BG_YSC = 400 * MiB;
constexpr int CW_BAR = 4096;
constexpr int CW_CNT = 16384;

constexpr int RING_BYTES = 131072;
constexpr int LDS_TAB = RING_BYTES;
constexpr int LDS_STASH = RING_BYTES + 1024;
constexpr int LDS_BYTES = 163840;
constexpr int LDS_MISC = LDS_BYTES - 1024;

typedef __bf16 bf16x2_t __attribute__((ext_vector_type(2)));
typedef float f32x2_t __attribute__((ext_vector_type(2)));
__device__ __forceinline__ unsigned cvt_pk_bf16(float lo, float hi) { const bf16x2_t r = __builtin_convertvector((f32x2_t){lo, hi}, bf16x2_t); return __builtin_bit_cast(unsigned, r); }
__device__ __forceinline__ unsigned f2bf(float f) { unsigned u = __builtin_bit_cast(unsigned, f); return (u + 0x7fffu + ((u >> 16) & 1u)) >> 16; }
__device__ __forceinline__ unsigned pk2(float lo, float hi) { return f2bf(lo) | (f2bf(hi) << 16); }
__device__ __forceinline__ float bflo(unsigned w) { return __builtin_bit_cast(float, w << 16); }
__device__ __forceinline__ float bfhi(unsigned w) { return __builtin_bit_cast(float, w & 0xffff0000u); }
__device__ __forceinline__ float shfl_from(float v, int src) { return __builtin_bit_cast(float, __builtin_amdgcn_ds_bpermute(src << 2, __builtin_bit_cast(int, v))); }
__device__ __forceinline__ float shfl_x(float v, int o, int lane) { return shfl_from(v, lane ^ o); }
__device__ __forceinline__ float wave_sum(float v, int lane) {
#pragma unroll
    for (int o = 1; o < 64; o <<= 1) v += shfl_x(v, o, lane);
    return v;
}
#define LDS_WAIT() asm volatile("s_waitcnt lgkmcnt(0)" ::: "memory")
#define VM_WAIT() asm volatile("s_waitcnt vmcnt(0)" ::: "memory")

#define XB_TMO      128
#define XB_XCNT(j)  (256  + 64 * (j))
#define XB_XSUB(j)  (1280 + 64 * (j))
#define XB_XGEN(j)  (2304 + 64 * (j))
#define XB_TOP      3328
#define XB_TOPGEN   3392
#define XCD_BAR_WORDS 3456
#define XB_SPIN_CAP (1u << 18)

__device__ __forceinline__ unsigned xb_ld(unsigned* p)              { return __hip_atomic_load(p, __ATOMIC_RELAXED, __HIP_MEMORY_SCOPE_AGENT); }
__device__ __forceinline__ unsigned xb_add(unsigned* p, unsigned v) { return __hip_atomic_fetch_add(p, v, __ATOMIC_RELAXED, __HIP_MEMORY_SCOPE_AGENT); }
__device__ __forceinline__ unsigned xb_xcc_id() { return (unsigned)__builtin_amdgcn_s_getreg((3 << 11) | 20) & 0xFu; }
#define XB_SPIN(cond, bar) do { unsigned _sp = 0; while (cond) { __builtin_amdgcn_s_sleep(1); \
    if ((++_sp & 255u) == 0u) { if (xb_ld(&(bar)[XB_TMO])) break; if (_sp > XB_SPIN_CAP) { atomicAdd(&(bar)[XB_TMO], 1u); break; } } } } while (0)

struct XcdBarrier {
    unsigned* bar; unsigned x;
    volatile LAS unsigned* st;
};

__device__ __forceinline__ XcdBarrier xcd_barrier_post(unsigned* bar, volatile LAS unsigned* st) {
    XcdBarrier b; b.bar = bar; b.x = xb_xcc_id(); b.st = st;
    if (threadIdx.x == 0) (void)xb_add(&bar[XB_XCNT(b.x)], 1u);
    return b;
}
__device__ __forceinline__ void xcd_barrier_complete(unsigned* bar, unsigned x, unsigned& nloc, unsigned& nx) {
    const unsigned G = gridDim.x * gridDim.y * gridDim.z;
    unsigned sum, cnt, mine, sp = 0u;
    for (;;) {
        sum = 0u; cnt = 0u; mine = 0u;
#pragma unroll
        for (unsigned j = 0; j < 16; ++j) { const unsigned c = xb_ld(&bar[XB_XCNT(j)]); sum += c; cnt += (c > 0u) ? 1u : 0u; mine = (j == x) ? c : mine; }
        if (sum == G) break;
        __builtin_amdgcn_s_sleep(1);
        if ((++sp & 255u) == 0u) { if (xb_ld(&bar[XB_TMO])) break; if (sp > XB_SPIN_CAP) { atomicAdd(&bar[XB_TMO], 1u); break; } }
    }
    nloc = mine > 0u ? mine : 1u; nx = cnt > 0u ? cnt : 1u;
}

__device__ __forceinline__ void xcd_barrier(const XcdBarrier& b) {
    asm volatile("s_waitcnt vmcnt(0)" ::: "memory");
    __syncthreads();
    if (threadIdx.x == 0) {
        unsigned* bar; unsigned bx = b.x; { GAS unsigned* bg = (GAS unsigned*)b.bar; asm volatile("" : "+s"(bg), "+s"(bx)); bar = (unsigned*)bg; }
        __builtin_amdgcn_s_waitcnt(0);
        unsigned nloc = b.st[0], nx = b.st[1];
        if (nloc == 0u) { xcd_barrier_complete(bar, bx, nloc, nx); b.st[0] = nloc; b.st[1] = nx; }
        const unsigned old = xb_add(&bar[XB_XSUB(bx)], 1u);
        const unsigned gen = old / nloc;
        if (old + 1u == (gen + 1u) * nloc) {
            __builtin_amdgcn_fence(__ATOMIC_RELEASE, "agent");
            asm volatile("s_waitcnt vmcnt(0)" ::: "memory");
            const unsigned og = xb_add(&bar[XB_TOP], 1u);
            const unsigned tg = og / nx;
            if (og + 1u == (tg + 1u) * nx) xb_add(&bar[XB_TOPGEN], 1u);
            else XB_SPIN(xb_ld(&bar[XB_TOPGEN]) == tg, bar);
            __builtin_amdgcn_fence(__ATOMIC_ACQUIRE, "agent");
            xb_add(&bar[XB_XGEN(bx)], 1u);
            asm volatile("s_waitcnt vmcnt(0)" ::: "memory");
        } else {
            XB_SPIN(xb_ld(&bar[XB_XGEN(bx)]) == gen, bar);
            __builtin_amdgcn_fence(__ATOMIC_ACQUIRE, "agent");
            asm volatile("s_waitcnt vmcnt(0)" ::: "memory");
        }
    }
    __syncthreads();
}

namespace g8 {
constexpr int BM = 256, BK = 64, HALF = 128, HTB = HALF * BK * 2, STAGE_BYTES = 8 * HTB, NXCD = 8, WGM = 8;
__host__ __device__ __forceinline__ int lds_byte(int r, int c) { const int st = (r >> 4) * 2 + (c >> 5), rr = r & 15, cc = c & 31, ob = rr * 64 + cc * 2; return st * 1024 + (ob ^ (((ob >> 9) & 1) << 5)); }
__host__ __device__ __forceinline__ void stage_rc(int b, int& R, int& C) { const int st = b / 1024, sb = b % 1024, swz = sb ^ (((sb >> 9) & 1) << 5); R = (st >> 1) * 16 + swz / 64; C = (st & 1) * 32 + (swz % 64) / 2; }
__host__ __device__ __forceinline__ int perm32(int rho) { const int n = rho >> 4, i = rho & 15; return 8 * (i >> 2) + 4 * n + (i & 3); }

struct Unit { const char* A; const char* B; const int* rows; int pm, pn, nvalid, aux; };

template <class Epi, class Sched, bool GATHER>
__device__ __forceinline__ void gemm_phase(LAS unsigned char* lds, const int tid_in, const int K, const int lda, const int ldb, const Sched& S, const Epi& E) {
    const int tid = tid_in, wid = __builtin_amdgcn_readfirstlane(tid >> 6), lane = tid & 63, wr = wid >> 2, wc = wid & 3, fr = lane & 15, fq = lane >> 4;
    const int nt = K / BK;
    unsigned voffB[2];
#pragma unroll
    for (int i = 0; i < 2; ++i) { int R_, C_; stage_rc(tid * 16 + i * 8192, R_, C_); const int Rb = Epi::PERM ? ((R_ & ~31) + perm32(R_ & 31)) : R_; voffB[i] = (unsigned)(Rb * ldb + C_) * 2u; }
    LAS v4u* stash = (LAS v4u*)(lds + (LDS_STASH - 0) + tid * 16);
    const size_t kstep = (size_t)(BK * 2);
    const size_t hstepB = (size_t)HALF * ldb * 2;
    const unsigned ldsw = (unsigned)wid * 1024u;
    const int aoff = lds_byte(wr * 64 + fr, fq * 8), boff = lds_byte(wc * 32 + fr, fq * 8);
#define G8_SA(b, h) (((b) * 2 + (h)) * HTB)
#define G8_SB(b, h) ((4 + (b) * 2 + (h)) * HTB)
#define G8_STAGE2(bufoff, gbase, v0, v1) do { \
        __builtin_amdgcn_global_load_lds((const unsigned*)((const char*)(gbase) + (v0)), (LAS unsigned*)(lds + (bufoff) + ldsw), 16, 0, 0); \
        __builtin_amdgcn_global_load_lds((const unsigned*)((const char*)(gbase) + (v1)), (LAS unsigned*)(lds + (bufoff) + ldsw + 8192), 16, 0, 0); } while (0)
#define G8_STAGEB(bufoff, gbase) G8_STAGE2(bufoff, gbase, voffB[0], voffB[1])
#define G8_LDA(dst, b, h) do { _Pragma("unroll") for (int m = 0; m < 4; ++m) _Pragma("unroll") for (int k = 0; k < 2; ++k) dst[m][k] = *(const LAS bf16x8*)(lds + G8_SA(b, h) + aoff + m * 2048 + k * 1024); } while (0)
#define G8_LDB(dst, b, h) do { _Pragma("unroll") for (int n = 0; n < 2; ++n) _Pragma("unroll") for (int k = 0; k < 2; ++k) dst[n][k] = *(const LAS bf16x8*)(lds + G8_SB(b, h) + boff + n * 2048 + k * 1024); } while (0)
#define G8_MMA(ai, bj, At, Bt) do { __builtin_amdgcn_s_setprio(1); _Pragma("unroll") for (int m = 0; m < 4; ++m) _Pragma("unroll") for (int n = 0; n < 2; ++n) _Pragma("unroll") for (int k = 0; k < 2; ++k) \
        acc[ai][bj][m][n] = __builtin_amdgcn_mfma_f32_16x16x32_bf16(Bt[n][k], At[m][k], acc[ai][bj][m][n], 0, 0, 0); __builtin_amdgcn_s_setprio(0); } while (0)
#define G8_WAIT_V(n) asm volatile("s_waitcnt vmcnt(" #n ")" ::: "memory")
#define G8_WAIT_L(n) asm volatile("s_waitcnt lgkmcnt(" #n ")" ::: "memory")
#define G8_BAR __builtin_amdgcn_s_barrier()
#define G8_SCHED __builtin_amdgcn_sched_barrier(0)
#define G8_SETVA(dst, u) do { int _t2 = tid; if (GATHER) asm volatile("" : "+v"(_t2)); _Pragma("unroll") for (int _h = 0; _h < 2; ++_h) _Pragma("unroll") for (int _i = 0; _i < 2; ++_i) { \
        int _R, _C; stage_rc(_t2 * 16 + _i * 8192, _R, _C); \
        const unsigned _rl = (unsigned)(_h * HALF + _R); unsigned _row = _rl; \
        if (GATHER) { _row = 0u; if (_rl < (unsigned)(u).nvalid) _row = (unsigned)(u).rows[_rl] >> 3; } \
        dst[_h][_i] = (_row * (unsigned)lda + (unsigned)_C) * 2u; } } while (0)
    Unit cur, nxt; int ui = 0;
    if (!S.next(0, cur)) return;
    f32x4 acc[2][2][4][2];
#pragma unroll
    for (int a = 0; a < 2; ++a)
#pragma unroll
        for (int b = 0; b < 2; ++b)
#pragma unroll
            for (int m = 0; m < 4; ++m)
#pragma unroll
                for (int n = 0; n < 2; ++n) acc[a][b][m][n] = (f32x4){0.f, 0.f, 0.f, 0.f};
    bf16x8 At[4][2], B0[2][2], B1[2][2];
    unsigned vAc[2][2]; unsigned xl00 = 0, xl01 = 0, xl10 = 0, xl11 = 0;
    G8_SETVA(vAc, cur);
    const char* cA = cur.A; const char* cB = cur.B;
    G8_STAGEB(G8_SB(0, 0), cB); G8_STAGEB(G8_SB(0, 1), cB + hstepB); G8_STAGE2(G8_SA(0, 0), cA, vAc[0][0], vAc[0][1]); G8_STAGE2(G8_SA(0, 1), cA, vAc[1][0], vAc[1][1]);
    if (wr == 1) G8_BAR;
    G8_WAIT_V(2); G8_BAR;
    G8_STAGEB(G8_SB(1, 0), cB + kstep); G8_STAGE2(G8_SA(1, 0), cA + kstep, vAc[0][0], vAc[0][1]); G8_STAGEB(G8_SB(1, 1), cB + hstepB + kstep);
    G8_WAIT_V(6); G8_BAR;
    for (;;) {
        const bool has_next = S.next(ui + 1, nxt);
        const char* nA = has_next ? nxt.A : cA; const char* nB = has_next ? nxt.B : cB;
        if (GATHER) { unsigned vAn[2][2]; if (has_next) { G8_SETVA(vAn, nxt); } else {
#pragma unroll
            for (int h = 0; h < 2; ++h)
#pragma unroll
                for (int i = 0; i < 2; ++i) vAn[h][i] = vAc[h][i]; }
            *stash = (v4u){vAn[0][0], vAn[0][1], vAn[1][0], vAn[1][1]}; }
#pragma unroll 1
        for (int t = 0; t < nt; t += 2) {
            const bool last = (t == nt - 2);
            const char* a1 = cA + (size_t)(t + 1) * kstep;
            const char* a2 = last ? nA : cA + (size_t)(t + 2) * kstep; const char* b2 = last ? nB : cB + (size_t)(t + 2) * kstep;
            const char* a3 = a2 + kstep; const char* b3 = b2 + kstep;
            unsigned x00 = vAc[0][0], x01 = vAc[0][1], x10 = vAc[1][0], x11 = vAc[1][1];
            if (GATHER) { if (last) { const v4u sv = *stash; x00 = sv.x; x01 = sv.y; x10 = sv.z; x11 = sv.w; } xl00 = x00; xl01 = x01; xl10 = x10; xl11 = x11; }
            G8_LDB(B0, 0, 0); G8_LDB(B1, 0, 1); G8_SCHED; G8_LDA(At, 0, 0); G8_STAGE2(G8_SA(1, 1), a1, vAc[1][0], vAc[1][1]);
            G8_WAIT_V(8); G8_WAIT_L(0); G8_BAR; G8_MMA(0, 0, At, B0); G8_MMA(0, 1, At, B1); G8_BAR; G8_SCHED;
            G8_LDA(At, 0, 1); G8_STAGEB(G8_SB(0, 0), b2); G8_STAGEB(G8_SB(0, 1), b2 + hstepB); G8_STAGE2(G8_SA(0, 0), a2, x00, x01);
            G8_WAIT_V(8); G8_WAIT_L(0); G8_BAR; G8_MMA(1, 0, At, B0); G8_MMA(1, 1, At, B1); G8_BAR; G8_SCHED;
            G8_LDB(B0, 1, 0); G8_LDB(B1, 1, 1); G8_SCHED; G8_LDA(At, 1, 0); G8_STAGE2(G8_SA(0, 1), a2, x10, x11);
            G8_WAIT_V(8); G8_WAIT_L(0); G8_BAR; G8_MMA(0, 0, At, B0); G8_MMA(0, 1, At, B1); G8_BAR; G8_SCHED;
            G8_LDA(At, 1, 1); G8_STAGEB(G8_SB(1, 0), b3); G8_STAGEB(G8_SB(1, 1), b3 + hstepB); G8_STAGE2(G8_SA(1, 0), a3, x00, x01);
            G8_WAIT_V(8); G8_WAIT_L(0); G8_BAR; G8_MMA(1, 0, At, B0); G8_MMA(1, 1, At, B1); G8_BAR; G8_SCHED;
        }
        if (wr == 0) G8_BAR;
        E(acc, cur, wr, wc, fr, fq);
        if (!has_next) break;
#pragma unroll
        for (int a = 0; a < 2; ++a)
#pragma unroll
            for (int b = 0; b < 2; ++b)
#pragma unroll
                for (int m = 0; m < 4; ++m)
#pragma unroll
                    for (int n = 0; n < 2; ++n) acc[a][b][m][n] = (f32x4){0.f, 0.f, 0.f, 0.f};
        cur = nxt; cA = nA; cB = nB; ++ui;
        if (GATHER) { vAc[0][0] = xl00; vAc[0][1] = xl01; vAc[1][0] = xl10; vAc[1][1] = xl11; }
        if (wr == 1) G8_BAR;
    }
    G8_WAIT_V(0);
    G8_BAR;
#undef G8_SA
#undef G8_SB
#undef G8_STAGE2
#undef G8_STAGEB
#undef G8_LDA
#undef G8_LDB
#undef G8_MMA
#undef G8_WAIT_V
#undef G8_WAIT_L
#undef G8_BAR
#undef G8_SCHED
#undef G8_SETVA
}

struct DenseSched {
    const char* A; const char* B; size_t a_tile, b_tile, agrp_stride; int agrp_shift, nM, nN, nwg, G, c;
    __device__ __forceinline__ void init(const void* A_, const void* B_, int M, int N, int lda, int ldb, int G_, int c_) {
        A = (const char*)A_; B = (const char*)B_; a_tile = (size_t)BM * lda * 2; b_tile = (size_t)BM * ldb * 2; agrp_stride = 0; agrp_shift = 0; nM = M / BM; nN = N / BM; nwg = nM * nN; G = G_; c = c_; }
    __device__ __forceinline__ bool next(int i, Unit& u) const {
        const long L = (long)i * G + c; if (L >= nwg) return false;
        int wgid = (int)L; { const int q = nwg / NXCD, r = nwg % NXCD, xcd = wgid % NXCD, off = wgid / NXCD; wgid = (xcd < r ? xcd * (q + 1) : r * (q + 1) + (xcd - r) * q) + off; }
        const int nig = WGM * nN, gid = wgid / nig, fm = gid * WGM, gsz = (nM - fm) < WGM ? (nM - fm) : WGM;
        u.pm = fm + ((wgid % nig) % gsz); u.pn = (wgid % nig) / gsz;
        u.A = A + (size_t)u.pm * a_tile + (size_t)(u.pn >> agrp_shift) * agrp_stride; u.B = B + (size_t)u.pn * b_tile; u.rows = nullptr; u.nvalid = BM; u.aux = 0; return true;
    }
};
template <int NPN, bool GATHERED>
struct ExpertSched {
    const LAS int* tpref; const LAS int* cnt; const char* A; const char* B; const int* tok; size_t b_exp, b_tile, a_tile; int NU, G, c;
    __device__ __forceinline__ bool next(int i, Unit& u) const {
        int L = i * G + c; if (L >= NU) return false;
        if ((i + 1) * G <= NU && (G % NXCD) == 0) L = i * G + (c % NXCD) * (G / NXCD) + c / NXCD;
        const int tile = L / NPN, pn = L % NPN;
        int e = 0; while (__builtin_amdgcn_readfirstlane(tpref[e + 1]) <= tile) ++e;
        const int rb = tile - __builtin_amdgcn_readfirstlane(tpref[e]);
        u.pm = e; u.pn = pn; u.aux = tile * BM; u.nvalid = __builtin_amdgcn_readfirstlane(cnt[e]) - rb * BM; if (u.nvalid > BM) u.nvalid = BM;
        u.rows = tok + (size_t)e * CAP + rb * BM;
        u.A = GATHERED ? A : A + (size_t)tile * a_tile; u.B = B + (size_t)e * b_exp + (size_t)pn * b_tile; return true;
    }
};

struct EpiBf16 {
    static constexpr bool PERM = true;
    bf16* O; int ldc; int qscale;
    __device__ __forceinline__ void operator()(const f32x4 (&acc)[2][2][4][2], const Unit& u, int wr, int wc, int fr, int fq) const {
        asm volatile("" : "+v"(fr), "+v"(fq));
        const int row0 = u.pm * BM + wr * 64 + fr, col0 = u.pn * BM + wc * 32 + 8 * fq;
        const float sc = (qscale && (u.pn % 6) < 2) ? 0.125f : 1.0f;
#pragma unroll
        for (int ai = 0; ai < 2; ++ai)
#pragma unroll
            for (int m = 0; m < 4; ++m) { bf16* rowp = O + (size_t)(row0 + ai * HALF + m * 16) * ldc + col0;
#pragma unroll
                for (int bj = 0; bj < 2; ++bj) { const f32x4 v0 = acc[ai][bj][m][0] * sc, v1 = acc[ai][bj][m][1] * sc;
                    v4u w; w.x = cvt_pk_bf16(v0[0], v0[1]); w.y = cvt_pk_bf16(v0[2], v0[3]); w.z = cvt_pk_bf16(v1[0], v1[1]); w.w = cvt_pk_bf16(v1[2], v1[3]);
                    *(v4u*)(rowp + bj * HALF) = w; } }
    }
};
struct EpiScaleBf16 {
    static constexpr bool PERM = true;
    bf16* O; int ldc; const float* scale;
    __device__ __forceinline__ void operator()(const f32x4 (&acc)[2][2][4][2], const Unit& u, int wr, int wc, int fr, int fq) const {
        asm volatile("" : "+v"(fr), "+v"(fq));
        const int row0 = u.pm * BM + wr * 64 + fr, col0 = u.pn * BM + wc * 32 + 8 * fq;
        f32x4 sv[2][2];
#pragma unroll
        for (int bj = 0; bj < 2; ++bj)
#pragma unroll
            for (int n = 0; n < 2; ++n) sv[bj][n] = *(const f32x4*)(scale + col0 + bj * HALF + 4 * n);
#pragma unroll
        for (int ai = 0; ai < 2; ++ai)
#pragma unroll
            for (int m = 0; m < 4; ++m) { bf16* rowp = O + (size_t)(row0 + ai * HALF + m * 16) * ldc + col0;
#pragma unroll
                for (int bj = 0; bj < 2; ++bj) { const f32x4 v0 = acc[ai][bj][m][0] * sv[bj][0], v1 = acc[ai][bj][m][1] * sv[bj][1];
                    v4u w; w.x = cvt_pk_bf16(v0[0], v0[1]); w.y = cvt_pk_bf16(v0[2], v0[3]); w.z = cvt_pk_bf16(v1[0], v1[1]); w.w = cvt_pk_bf16(v1[2], v1[3]);
                    *(v4u*)(rowp + bj * HALF) = w; } }
    }
};
struct EpiResid {
    static constexpr bool PERM = false;
    const float* X; float* Y;
    __device__ __forceinline__ void operator()(const f32x4 (&acc)[2][2][4][2], const Unit& u, int wr, int wc, int fr, int fq) const {
        asm volatile("" : "+v"(fr), "+v"(fq));
        const int row0 = u.pm * BM + wr * 64 + fr, col0 = u.pn * BM + wc * 32 + 4 * fq;
#pragma unroll
        for (int ai = 0; ai < 2; ++ai)
#pragma unroll
            for (int m = 0; m < 4; ++m) { const size_t off = (size_t)(row0 + ai * HALF + m * 16) * D + col0;
#pragma unroll
                for (int bj = 0; bj < 2; ++bj)
#pragma unroll
                    for (int n = 0; n < 2; ++n) { const f32x4 xv = *(const f32x4*)(X + off + bj * HALF + n * 16); *(f32x4*)(Y + off + bj * HALF + n * 16) = xv * ALPHA + acc[ai][bj][m][n]; } }
    }
};
struct EpiResidLN {
    static constexpr bool PERM = true;
    const float* X32; const bf16* Xb; const float* st; const float* g; const float* b; bf16* Y; float* pst; int mode;
    __device__ __forceinline__ void operator()(const f32x4 (&acc)[2][2][4][2], const Unit& u, int wr, int wc, int fr, int fq) const {
        asm volatile("" : "+v"(fr), "+v"(fq));
        const int row0 = u.pm * BM + wr * 64 + fr, col0 = u.pn * BM + wc * 32 + 8 * fq, lane = fq * 16 + fr;
#pragma unroll
        for (int ai = 0; ai < 2; ++ai)
#pragma unroll
            for (int m = 0; m < 4; ++m) { const int row = row0 + ai * HALF + m * 16; const size_t off = (size_t)row * D + col0;
                float mean = 0.f, rstd = 1.f; if (mode == 1) { const f32x2 sv = *(const f32x2*)(st + 2 * row); mean = sv.x; rstd = sv.y; }
                float sm = 0.f, sq = 0.f;
#pragma unroll
                for (int bj = 0; bj < 2; ++bj) { f32x4 x0, x1;
                    if (mode == 2) { const v4u xv = *(const v4u*)(Xb + off + bj * HALF); x0 = (f32x4){bflo(xv.x), bfhi(xv.x), bflo(xv.y), bfhi(xv.y)}; x1 = (f32x4){bflo(xv.z), bfhi(xv.z), bflo(xv.w), bfhi(xv.w)}; }
                    else if (mode) { const v4u xv = *(const v4u*)(Xb + off + bj * HALF);
                        const f32x4 g0 = *(const f32x4*)(g + col0 + bj * HALF), g1 = *(const f32x4*)(g + col0 + bj * HALF + 4), b0 = *(const f32x4*)(b + col0 + bj * HALF), b1 = *(const f32x4*)(b + col0 + bj * HALF + 4);
                        x0 = ((f32x4){bflo(xv.x), bfhi(xv.x), bflo(xv.y), bfhi(xv.y)} - mean) * rstd * g0 + b0; x1 = ((f32x4){bflo(xv.z), bfhi(xv.z), bflo(xv.w), bfhi(xv.w)} - mean) * rstd * g1 + b1; }
                    else { x0 = *(const f32x4*)(X32 + off + bj * HALF); x1 = *(const f32x4*)(X32 + off + bj * HALF + 4); }
                    const f32x4 y0 = x0 * ALPHA + acc[ai][bj][m][0], y1 = x1 * ALPHA + acc[ai][bj][m][1];
                    v4u w; w.x = cvt_pk_bf16(y0[0], y0[1]); w.y = cvt_pk_bf16(y0[2], y0[3]); w.z = cvt_pk_bf16(y1[0], y1[1]); w.w = cvt_pk_bf16(y1[2], y1[3]);
                    *(v4u*)(Y + off + bj * HALF) = w;
                    sm += ((y0[0] + y0[1]) + (y0[2] + y0[3])) + ((y1[0] + y1[1]) + (y1[2] + y1[3]));
                    sq += ((y0[0] * y0[0] + y0[1] * y0[1]) + (y0[2] * y0[2] + y0[3] * y0[3])) + ((y1[0] * y1[0] + y1[1] * y1[1]) + (y1[2] * y1[2] + y1[3] * y1[3])); }
                sm += shfl_x(sm, 16, lane); sm += shfl_x(sm, 32, lane); sq += shfl_x(sq, 16, lane); sq += shfl_x(sq, 32, lane);
                if (fq == 0) *(f32x2*)(pst + ((size_t)row * 32 + u.pn * 4 + wc) * 2) = (f32x2){sm, sq}; }
    }
};
struct EpiConvIn {
    static constexpr bool PERM = true;
    bf16* UC; bf16* BGp;
    __device__ __forceinline__ void operator()(const f32x4 (&acc)[2][2][4][2], const Unit& u, int wr, int wc, int fr, int fq) const {
        asm volatile("" : "+v"(fr), "+v"(fq));
        const int row0 = u.pm * BM + wr * 64 + fr, cw = wc * 32 + 8 * fq;
        if (u.pn < 16) {
#pragma unroll
            for (int ai = 0; ai < 2; ++ai)
#pragma unroll
                for (int m = 0; m < 4; ++m) { bf16* rowp = UC + (size_t)(row0 + ai * HALF + m * 16) * D + u.pn * HALF + cw;
                    const f32x4 v0 = acc[ai][0][m][0] * acc[ai][1][m][0], v1 = acc[ai][0][m][1] * acc[ai][1][m][1];
                    v4u w; w.x = cvt_pk_bf16(v0[0], v0[1]); w.y = cvt_pk_bf16(v0[2], v0[3]); w.z = cvt_pk_bf16(v1[0], v1[1]); w.w = cvt_pk_bf16(v1[2], v1[3]);
                    *(v4u*)rowp = w; }
        } else {
#pragma unroll
            for (int ai = 0; ai < 2; ++ai)
#pragma unroll
                for (int m = 0; m < 4; ++m) { bf16* rowp = BGp + (size_t)(row0 + ai * HALF + m * 16) * D + (u.pn - 16) * BM + cw;
#pragma unroll
                    for (int bj = 0; bj < 2; ++bj) { const f32x4 v0 = acc[ai][bj][m][0], v1 = acc[ai][bj][m][1];
                        v4u w; w.x = cvt_pk_bf16(v0[0], v0[1]); w.y = cvt_pk_bf16(v0[2], v0[3]); w.z = cvt_pk_bf16(v1[0], v1[1]); w.w = cvt_pk_bf16(v1[2], v1[3]);
                        *(v4u*)(rowp + bj * HALF) = w; } }
        }
    }
};
__device__ __forceinline__ f32x4 silu_mul(f32x4 g, f32x4 uu) {
    f32x4 r;
#pragma unroll
    for (int j = 0; j < 4; ++j) r[j] = g[j] * __builtin_amdgcn_rcpf(1.0f + __expf(-g[j])) * uu[j];
    return r;
}
struct EpiExpertGU {
    static constexpr bool PERM = true;
    bf16* H;
    __device__ __forceinline__ void operator()(const f32x4 (&acc)[2][2][4][2], const Unit& u, int wr, int wc, int fr, int fq) const {
        asm volatile("" : "+v"(fr), "+v"(fq));
        const float* gates = (const float*)((const char*)u.rows + (WS_LGATE - WS_LTOK));
        const int cw = wc * 32 + 8 * fq;
#pragma unroll
        for (int ai = 0; ai < 2; ++ai)
#pragma unroll
            for (int m = 0; m < 4; ++m) { const int r = ai * HALF + wr * 64 + m * 16 + fr;
                if (r < u.nvalid) { const float gt = gates[r]; const unsigned pid = (unsigned)u.rows[r];
                    const f32x4 v0 = silu_mul(acc[ai][0][m][0], acc[ai][1][m][0]) * gt, v1 = silu_mul(acc[ai][0][m][1], acc[ai][1][m][1]) * gt;
                    v4u w; w.x = cvt_pk_bf16(v0[0], v0[1]); w.y = cvt_pk_bf16(v0[2], v0[3]); w.z = cvt_pk_bf16(v1[0], v1[1]); w.w = cvt_pk_bf16(v1[2], v1[3]);
                    (void)pid; *(v4u*)(H + (size_t)(u.aux + r) * EDIM + cw) = w; } }
    }
};
struct EpiSharedGU {
    static constexpr bool PERM = true;
    bf16* HS;
    __device__ __forceinline__ void operator()(const f32x4 (&acc)[2][2][4][2], const Unit& u, int wr, int wc, int fr, int fq) const {
        asm volatile("" : "+v"(fr), "+v"(fq));
        const int row0 = u.pm * BM + wr * 64 + fr, cw = u.pn * HALF + wc * 32 + 8 * fq;
#pragma unroll
        for (int ai = 0; ai < 2; ++ai)
#pragma unroll
            for (int m = 0; m < 4; ++m) {
                const f32x4 v0 = silu_mul(acc[ai][0][m][0], acc[ai][1][m][0]), v1 = silu_mul(acc[ai][0][m][1], acc[ai][1][m][1]);
                v4u w; w.x = cvt_pk_bf16(v0[0], v0[1]); w.y = cvt_pk_bf16(v0[2], v0[3]); w.z = cvt_pk_bf16(v1[0], v1[1]); w.w = cvt_pk_bf16(v1[2], v1[3]);
                *(v4u*)(HS + (size_t)(row0 + ai * HALF + m * 16) * SDIM + cw) = w; }
    }
};
struct EpiDownY {
    static constexpr bool PERM = true;
    bf16* Y;
    __device__ __forceinline__ void operator()(const f32x4 (&acc)[2][2][4][2], const Unit& u, int wr, int wc, int fr, int fq) const {
        asm volatile("" : "+v"(fr), "+v"(fq));
        const int col0 = u.pn * BM + wc * 32 + 8 * fq;
#pragma unroll
        for (int ai = 0; ai < 2; ++ai)
#pragma unroll
            for (int m = 0; m < 4; ++m) { const int r = ai * HALF + wr * 64 + m * 16 + fr; bf16* rowp = Y + (size_t)(u.aux + r) * D + col0;
#pragma unroll
                for (int bj = 0; bj < 2; ++bj) { const f32x4 v0 = acc[ai][bj][m][0], v1 = acc[ai][bj][m][1];
                    v4u w; w.x = cvt_pk_bf16(v0[0], v0[1]); w.y = cvt_pk_bf16(v0[2], v0[3]); w.z = cvt_pk_bf16(v1[0], v1[1]); w.w = cvt_pk_bf16(v1[2], v1[3]);
                    *(v4u*)(rowp + bj * HALF) = w; } }
    }
};
}

struct Args { const float* in[19]; float* out; unsigned char* ws; int ph_lo, ph_hi; };
struct Frame {
    LAS unsigned char* lds; unsigned* ctl; unsigned char* ws;
    int tid, lane, wave, G, bid;
};
enum { IN_X = 0, IN_RELB, IN_PWIN, IN_PWG, IN_PSC, IN_PWOUT, IN_DQKV, IN_DOUT, IN_CWIN, IN_CW, IN_CWOUT, IN_LNG, IN_LNB, IN_RW, IN_RB, IN_EGU, IN_ED, IN_SGU, IN_SD };

#define CAS __attribute__((address_space(4)))
typedef const CAS unsigned char* KP;
__device__ __forceinline__ const float* ain(KP kp, int i) { return (const float*)((const GAS float* const CAS*)kp)[i]; }
__device__ __forceinline__ float* aout(KP kp) { return (float*)((GAS float* const CAS*)kp)[19]; }
__device__ __forceinline__ void tr_item(const float* W, int K, int N, bf16* WT, int dstK, int mode, LAS float* scr, int item, int lane) {
    const int nblk = N / 32, kb = item / nblk, nb = item % nblk, k0 = 64 * kb, n0 = 32 * nb;
    int r0 = n0;
    if (mode == 1) { const int part = n0 / 2048, j = n0 % 2048; r0 = (part == 0) ? 4096 + j : 256 * (j / 128) + (part == 2 ? 128 : 0) + (j % 128); }
    if (mode == 2) { const int part = n0 / 256, j = n0 % 256; r0 = 256 * (j / 128) + 128 * part + (j % 128); }
#pragma unroll 8
    for (int i = 0; i < 32; ++i) { const int kk = 2 * i + (lane >> 5); scr[kk * 33 + (lane & 31)] = __builtin_nontemporal_load(W + (size_t)(k0 + kk) * N + n0 + (lane & 31)); }
    LDS_WAIT(); asm volatile("" ::: "memory");
    const int c = lane & 7;
#pragma unroll
    for (int j = 0; j < 4; ++j) { const int n = (lane >> 3) + 8 * j; const LAS float* s = scr + (8 * c) * 33 + n;
        v4u o; o.x = pk2(s[0 * 33], s[1 * 33]); o.y = pk2(s[2 * 33], s[3 * 33]); o.z = pk2(s[4 * 33], s[5 * 33]); o.w = pk2(s[6 * 33], s[7 * 33]);
        __builtin_nontemporal_store(o, (v4u*)(WT + (size_t)(r0 + n) * dstK + k0 + 8 * c)); }
    LDS_WAIT(); asm volatile("" ::: "memory");
}
__device__ __forceinline__ void phase_prologue(const Frame& F, KP kp) {
    LAS float* scr = (LAS float*)(F.lds + F.wave * 16384);
    const int gw = F.bid * 8 + F.wave, NGW = F.G * 8;
    constexpr int I0 = 2 * 2048, I1 = 8 * 128, I2 = 2 * 2048, I3 = 4608, I4 = 512, I5 = 6144, I6 = 2048, I7 = 4 * 512, I8 = 4 * 256, I9 = 256 * 256, I10 = 256 * 128;
    constexpr int NITEMS = I0 + I1 + I2 + I3 + I4 + I5 + I6 + I7 + I8 + I9 + I10;
    unsigned char* ws = F.ws;
    for (int it = gw; it < NITEMS; it += NGW) {
        int r = it;
        if (r < I0) { const int b = r / 2048; tr_item(ain(kp, IN_PWIN) + (size_t)b * D * D, D, D, (bf16*)(ws + WS_W_POOL_IN) + (size_t)b * D * D, D, 0, scr, r % 2048, F.lane); continue; } r -= I0;
        if (r < I1) { const int b = r / 128; tr_item(ain(kp, IN_PWG) + (size_t)b * 512 * 512, 512, 512, (bf16*)(ws + WS_W_POOL_G) + (size_t)b * 512 * 512, 512, 0, scr, r % 128, F.lane); continue; } r -= I1;
        if (r < I2) { const int b = r / 2048; tr_item(ain(kp, IN_PWOUT) + (size_t)b * D * D, D, D, (bf16*)(ws + WS_W_POOL_OUT) + (size_t)b * D * D, D, 0, scr, r % 2048, F.lane); continue; } r -= I2;
        if (r < I3) { tr_item(ain(kp, IN_DQKV), D, QKVC, (bf16*)(ws + WS_W_DIL_QKV), D, 0, scr, r, F.lane); continue; } r -= I3;
        if (r < I4) { tr_item(ain(kp, IN_DOUT), DILW, D, (bf16*)(ws + WS_W_DIL_OUT), DILW, 0, scr, r, F.lane); continue; } r -= I4;
        if (r < I5) { tr_item(ain(kp, IN_CWIN), D, 3 * D, (bf16*)(ws + WS_W_CONV_IN), D, 1, scr, r, F.lane); continue; } r -= I5;
        if (r < I6) { tr_item(ain(kp, IN_CWOUT), D, D, (bf16*)(ws + WS_W_CONV_OUT), D, 0, scr, r, F.lane); continue; } r -= I6;
        if (r < I7) { const int b = r / 512; tr_item(ain(kp, IN_SGU) + (size_t)b * D * 512, D, 512, (bf16*)(ws + WS_W_SH_GU) + (size_t)b * 512 * D, D, 2, scr, r % 512, F.lane); continue; } r -= I7;
        if (r < I8) { const int b = r / 256; tr_item(ain(kp, IN_SD) + (size_t)b * SDIM * D, SDIM, D, (bf16*)(ws + WS_W_SH_D) + (size_t)b * D * SDIM, SDIM, 0, scr, r % 256, F.lane); continue; } r -= I8;
        if (r < I9) { const int b = r / 256; tr_item(ain(kp, IN_EGU) + (size_t)b * D * 256, D, 256, (bf16*)(ws + WS_W_EX_GU) + (size_t)b * 256 * D, D, 0, scr, r % 256, F.lane); continue; } r -= I9;
        { const int b = r / 128; tr_item(ain(kp, IN_ED) + (size_t)b * EDIM * D, EDIM, D, (bf16*)(ws + WS_W_EX_D) + (size_t)b * D * EDIM, EDIM, 0, scr, r % 128, F.lane); }
    }
    const size_t gt = (size_t)F.bid * 512 + F.tid, GT = (size_t)F.G * 512;
    { const float* rw = ain(kp, IN_RW); bf16* wh = (bf16*)(ws + WS_RWH); bf16* wl = (bf16*)(ws + WS_RWL);
      for (size_t i = gt; i < (size_t)DEPTH * NEXP * D / 8; i += GT) { const size_t k8 = i % (D / 8), e = (i / (D / 8)) % NEXP, l = i / ((size_t)NEXP * D / 8);
          float v[8]; unsigned hi[8], lo[8];
#pragma unroll
          for (int j = 0; j < 8; ++j) { v[j] = rw[(l * D + k8 * 8 + j) * NEXP + e]; hi[j] = f2bf(v[j]); lo[j] = f2bf(v[j] - __builtin_bit_cast(float, hi[j] << 16)); }
          v4u a, b2; a.x = hi[0] | (hi[1] << 16); a.y = hi[2] | (hi[3] << 16); a.z = hi[4] | (hi[5] << 16); a.w = hi[6] | (hi[7] << 16);
          b2.x = lo[0] | (lo[1] << 16); b2.y = lo[2] | (lo[3] << 16); b2.z = lo[4] | (lo[5] << 16); b2.w = lo[6] | (lo[7] << 16);
          *(v4u*)(wh + (l * NEXP + e) * D + k8 * 8) = a; *(v4u*)(wl + (l * NEXP + e) * D + k8 * 8) = b2; } }
    const float* x = ain(kp, IN_X); bf16* xb = (bf16*)(ws + WS_XB);
    for (size_t i = gt; i < (size_t)T * D / 8; i += GT) { const f32x4 p = __builtin_nontemporal_load((const f32x4*)(x + i * 8)), q = __builtin_nontemporal_load((const f32x4*)(x + i * 8 + 4));
        v4u w; w.x = pk2(p[0], p[1]); w.y = pk2(p[2], p[3]); w.z = pk2(q[0], q[1]); w.w = pk2(q[2], q[3]); *(v4u*)(xb + i * 8) = w; }
}

__device__ __forceinline__ void unpack8(const v4u w, float (&f)[8]) { f[0] = bflo(w.x); f[1] = bfhi(w.x); f[2] = bflo(w.y); f[3] = bfhi(w.y); f[4] = bflo(w.z); f[5] = bfhi(w.z); f[6] = bflo(w.w); f[7] = bfhi(w.w); }
__device__ __forceinline__ void phase_pool(const Frame& F, const bf16* U, bf16* PL) {
    for (int it = F.bid * 512 + F.tid; it < (T / 32) * 256; it += F.G * 512) {
        const int cv = it & 255, ch = it >> 8, col = cv * 8, w = 2 << (col >> 9);
        const int row0 = ch * 32, pos0 = row0 & (SEQ - 1);
        float s[8], uu[8];
#pragma unroll
        for (int j = 0; j < 8; ++j) s[j] = 0.f;
        for (int j = 1; j < w; ++j) if (pos0 - j >= 0) { unpack8(*(const v4u*)(U + (size_t)(row0 - j) * D + col), uu);
#pragma unroll
            for (int q = 0; q < 8; ++q) s[q] += uu[q]; }
        for (int r = 0; r < 32; ++r) {
            const int t = row0 + r, pos = pos0 + r;
            unpack8(*(const v4u*)(U + (size_t)t * D + col), uu);
            const float inv = 1.0f / (float)((pos + 1) < w ? (pos + 1) : w);
            float o[8];
#pragma unroll
            for (int q = 0; q < 8; ++q) { s[q] += uu[q]; o[q] = s[q] * inv - uu[q]; }
            v4u ww; ww.x = pk2(o[0], o[1]); ww.y = pk2(o[2], o[3]); ww.z = pk2(o[4], o[5]); ww.w = pk2(o[6], o[7]);
            *(v4u*)(PL + (size_t)t * D + col) = ww;
            if (pos - w + 1 >= 0) { unpack8(*(const v4u*)(U + (size_t)(t - w + 1) * D + col), uu);
#pragma unroll
                for (int q = 0; q < 8; ++q) s[q] -= uu[q]; }
        }
    }
}

__device__ __forceinline__ void phase_conv(const Frame& F, const bf16* UC, const bf16* BGp, const float* cw, bf16* Z) {
    for (int it = F.bid * 512 + F.tid; it < T * 256; it += F.G * 512) {
        const int cv = it & 255, t = it >> 8, col = cv * 8, pos = t & (SEQ - 1);
        float u0[8], u1[8], u2[8], bb[8], o[8];
        unpack8(*(const v4u*)(UC + (size_t)t * D + col), u2);
        if (pos >= 1) unpack8(*(const v4u*)(UC + (size_t)(t - 1) * D + col), u1); else {
#pragma unroll
            for (int q = 0; q < 8; ++q) u1[q] = 0.f; }
        if (pos >= 2) unpack8(*(const v4u*)(UC + (size_t)(t - 2) * D + col), u0); else {
#pragma unroll
            for (int q = 0; q < 8; ++q) u0[q] = 0.f; }
        unpack8(*(const v4u*)(BGp + (size_t)t * D + col), bb);
#pragma unroll
        for (int q = 0; q < 8; ++q) o[q] = bb[q] * (cw[col + q] * u0[q] + cw[D + col + q] * u1[q] + cw[2 * D + col + q] * u2[q]);
        v4u ww; ww.x = pk2(o[0], o[1]); ww.y = pk2(o[2], o[3]); ww.z = pk2(o[4], o[5]); ww.w = pk2(o[6], o[7]);
        *(v4u*)(Z + (size_t)t * D + col) = ww;
    }
}

__device__ __forceinline__ int t5_bucket(int dist) {
    if (dist < 16) return dist;
    int large = 16 + (int)(logf((float)dist / 16.0f) / logf(128.0f) * 16.0f);
    return large < 31 ? large : 31;
}
constexpr int AT_KS = 0, AT_KSTR = 144, AT_VT = 256 * 144, AT_VSTR = 520, AT_BIAS = AT_VT + 64 * 520;
__device__ __forceinline__ void phase_attn(const Frame& F, const bf16* QKV, const float* relb, bf16* OG, float* LSE) {
    LAS unsigned char* lds = F.lds;
    const int tid = F.tid, lane = F.lane, w = tid >> 6, fr = lane & 15, fq = lane >> 4;
    for (int unit = F.bid; unit < NBATCH * 3 * 8 * 16; unit += F.G) {
        const int cmb = unit & 15, h = (unit >> 4) & 7, g = (unit >> 7) % 3, b = unit / 384;
        const int dsh = 2 * g, dil = 1 << dsh, r = cmb & (dil - 1), nb = cmb >> dsh;
        const bf16* base = QKV + (size_t)b * SEQ * QKVC + g * 1536 + h * 64;
        __syncthreads();
        {
            const int key = tid >> 1, half = tid & 1, jk = (nb - 1) * 128 + key;
            v4u kv[4], vv[4];
            if (jk >= 0) { const bf16* rp = base + (size_t)(jk * dil + r) * QKVC + half * 32;
#pragma unroll
                for (int i = 0; i < 4; ++i) { kv[i] = *(const v4u*)(rp + 512 + 8 * i); vv[i] = *(const v4u*)(rp + 1024 + 8 * i); } }
            else {
#pragma unroll
                for (int i = 0; i < 4; ++i) { kv[i] = (v4u){0u, 0u, 0u, 0u}; vv[i] = (v4u){0u, 0u, 0u, 0u}; } }
#pragma unroll
            for (int i = 0; i < 4; ++i) *(LAS v4u*)(lds + AT_KS + key * AT_KSTR + half * 64 + 16 * i) = kv[i];
#pragma unroll
            for (int i = 0; i < 4; ++i) {
                const unsigned ww[4] = {vv[i].x, vv[i].y, vv[i].z, vv[i].w};
#pragma unroll
                for (int q = 0; q < 4; ++q) { const int d = half * 32 + 8 * i + 2 * q;
                    *(LAS unsigned short*)(lds + AT_VT + d * AT_VSTR + key * 2) = (unsigned short)(ww[q] & 0xffffu);
                    *(LAS unsigned short*)(lds + AT_VT + (d + 1) * AT_VSTR + key * 2) = (unsigned short)(ww[q] >> 16); } }
            if (tid <= 128) ((LAS float*)(lds + AT_BIAS))[tid] = relb[t5_bucket(tid * dil) * 24 + g * 8 + h];
        }
        __syncthreads();
        int qi = 16 * w + fr; asm volatile("" : "+v"(qi));
        const int jq = nb * 128 + qi, tq = jq * dil + r;
        const bf16* qp = base + (size_t)tq * QKVC + 8 * fq;
        const bf16x8 q0 = *(const bf16x8*)qp, q1 = *(const bf16x8*)(qp + 32);
        f32x4 s[9]; float mx = -INFINITY;
#pragma unroll
        for (int kt = 0; kt < 9; ++kt) {
            const int kb = 16 * (w + kt);
            const bf16x8 k0 = *(const LAS bf16x8*)(lds + AT_KS + (kb + fr) * AT_KSTR + fq * 16), k1 = *(const LAS bf16x8*)(lds + AT_KS + (kb + fr) * AT_KSTR + 64 + fq * 16);
            f32x4 a = (f32x4){0.f, 0.f, 0.f, 0.f};
            a = __builtin_amdgcn_mfma_f32_16x16x32_bf16(k0, q0, a, 0, 0, 0);
            a = __builtin_amdgcn_mfma_f32_16x16x32_bf16(k1, q1, a, 0, 0, 0);
#pragma unroll
            for (int i = 0; i < 4; ++i) { const int kl = kb + 4 * fq + i, rel = qi + 128 - kl;
                const bool ok = (rel >= 0) && (rel <= 128) && (nb > 0 || kl >= 128);
                const int rc = rel < 0 ? 0 : (rel > 128 ? 128 : rel);
                const float v = ok ? a[i] + ((LAS float*)(lds + AT_BIAS))[rc] : -INFINITY;
                a[i] = v; mx = fmaxf(mx, v); }
            s[kt] = a;
        }
        mx = fmaxf(mx, shfl_x(mx, 16, lane)); mx = fmaxf(mx, shfl_x(mx, 32, lane));
        float l = 0.f;
#pragma unroll
        for (int kt = 0; kt < 9; ++kt)
#pragma unroll
            for (int i = 0; i < 4; ++i) { const float p = __expf(s[kt][i] - mx); s[kt][i] = p; l += p; }
        l += shfl_x(l, 16, lane); l += shfl_x(l, 32, lane);
        f32x4 o[4];
#pragma unroll
        for (int nt = 0; nt < 4; ++nt) o[nt] = (f32x4){0.f, 0.f, 0.f, 0.f};
#pragma unroll
        for (int st = 0; st < 5; ++st) {
            const int kt0 = 2 * st, kt1 = 2 * st + 1;
            v4u pw; pw.x = pk2(s[kt0][0], s[kt0][1]); pw.y = pk2(s[kt0][2], s[kt0][3]);
            if (kt1 < 9) { pw.z = pk2(s[kt1 < 9 ? kt1 : 0][0], s[kt1 < 9 ? kt1 : 0][1]); pw.w = pk2(s[kt1 < 9 ? kt1 : 0][2], s[kt1 < 9 ? kt1 : 0][3]); } else { pw.z = 0u; pw.w = 0u; }
            const bf16x8 pf = __builtin_bit_cast(bf16x8, pw);
            const int kb0 = 16 * (w + kt0) + 4 * fq, kb1 = 16 * (w + kt1) + 4 * fq;
#pragma unroll
            for (int nt = 0; nt < 4; ++nt) { const int d = 16 * nt + fr;
                v2u va = *(const LAS v2u*)(lds + AT_VT + d * AT_VSTR + kb0 * 2), vb = (v2u){0u, 0u};
                if (kt1 < 9) vb = *(const LAS v2u*)(lds + AT_VT + d * AT_VSTR + kb1 * 2);
                v4u vw; vw.x = va.x; vw.y = va.y; vw.z = vb.x; vw.w = vb.y;
                o[nt] = __builtin_amdgcn_mfma_f32_16x16x32_bf16(__builtin_bit_cast(bf16x8, vw), pf, o[nt], 0, 0, 0); }
        }
        const float il = 1.0f / l;
        bf16* op = OG + ((size_t)g * T + (size_t)b * SEQ + tq) * DILW + h * 64 + 4 * fq;
#pragma unroll
        for (int nt = 0; nt < 4; ++nt) { v2u ww; ww.x = pk2(o[nt][0] * il, o[nt][1] * il); ww.y = pk2(o[nt][2] * il, o[nt][3] * il); *(v2u*)(op + 16 * nt) = ww; }
        if (fq == 0) LSE[((size_t)g * T + (size_t)b * SEQ + tq) * 8 + h] = mx + logf(l);
    }
}
__device__ __forceinline__ void phase_combine(const Frame& F, const bf16* OG, const float* LSE, bf16* O) {
    for (int it = F.bid * 512 + F.tid; it < T * 64; it += F.G * 512) {
        const int c8 = it & 7, h = (it >> 3) & 7, t = it >> 6;
        const float l0 = LSE[((size_t)0 * T + t) * 8 + h], l1 = LSE[((size_t)1 * T + t) * 8 + h], l2 = LSE[((size_t)2 * T + t) * 8 + h];
        const float m = fmaxf(l0, fmaxf(l1, l2)); float w0 = __expf(l0 - m), w1 = __expf(l1 - m), w2 = __expf(l2 - m); const float inv = 1.0f / (w0 + w1 + w2); w0 *= inv; w1 *= inv; w2 *= inv;
        float a[8], bq[8], c[8], o[8]; const size_t off = (size_t)t * DILW + h * 64 + c8 * 8;
        unpack8(*(const v4u*)(OG + off), a); unpack8(*(const v4u*)(OG + (size_t)T * DILW + off), bq); unpack8(*(const v4u*)(OG + (size_t)2 * T * DILW + off), c);
#pragma unroll
        for (int q = 0; q < 8; ++q) o[q] = w0 * a[q] + w1 * bq[q] + w2 * c[q];
        v4u ww; ww.x = pk2(o[0], o[1]); ww.y = pk2(o[2], o[3]); ww.z = pk2(o[4], o[5]); ww.w = pk2(o[6], o[7]);
        *(v4u*)(O + off) = ww;
    }
}

constexpr int M1_LOG = 131072, M1_STAT = M1_LOG + 4096, M1_HIST = M1_STAT + 128, M1_BASE = M1_HIST + 256;
__device__ __forceinline__ void phase_moe1(const Frame& F, const float* Y, const float* gain, const float* bias, const float* RW, const float* RB,
                                           float* X1F, bf16* X1B, unsigned* cnt, int* ltok, float* lgate, int* eidx, int* inv) {
    LAS float* xs = (LAS float*)F.lds; LAS float* logit = (LAS float*)(F.lds + M1_LOG); LAS float* stat = (LAS float*)(F.lds + M1_STAT);
    LAS int* hist = (LAS int*)(F.lds + M1_HIST); LAS int* basep = (LAS int*)(F.lds + M1_BASE);
    const int tid = F.tid, lane = F.lane, w = F.wave;
    for (int rg = F.bid; rg < T / 16; rg += F.G) {
        const int row0 = rg * 16;
        __syncthreads();
#pragma unroll
        for (int j = 0; j < 16; ++j) { const int idx = tid + 512 * j; *(LAS f32x4*)(xs + idx * 4) = *(const f32x4*)(Y + (size_t)row0 * D + (size_t)idx * 4); }
        if (tid < 64) hist[tid] = 0;
        __syncthreads();
#pragma unroll
        for (int rr = 0; rr < 2; ++rr) { const int r = 2 * w + rr; float sm = 0.f;
#pragma unroll
            for (int j = 0; j < 32; ++j) sm += xs[r * D + lane + 64 * j];
            const float mean = wave_sum(sm, lane) * (1.0f / D); float sq = 0.f;
#pragma unroll
            for (int j = 0; j < 32; ++j) { const float d = xs[r * D + lane + 64 * j] - mean; sq += d * d; }
            const float rstd = 1.0f / sqrtf(wave_sum(sq, lane) * (1.0f / D) + LN_EPS);
            if (lane == 0) { stat[2 * r] = mean; stat[2 * r + 1] = rstd; } }
        __syncthreads();
#pragma unroll
        for (int j = 0; j < 16; ++j) { const int idx = tid + 512 * j, r = idx >> 9, c4 = (idx & 511) * 4;
            const f32x4 v = *(LAS f32x4*)(xs + idx * 4), gv = *(const f32x4*)(gain + c4), bv = *(const f32x4*)(bias + c4);
            const float mean = stat[2 * r], rstd = stat[2 * r + 1];
            const f32x4 o = (v - mean) * rstd * gv + bv;
            *(LAS f32x4*)(xs + idx * 4) = o;
            *(f32x4*)(X1F + (size_t)(row0 + r) * D + c4) = o;
            v2u wb; wb.x = pk2(o[0], o[1]); wb.y = pk2(o[2], o[3]); *(v2u*)(X1B + (size_t)(row0 + r) * D + c4) = wb; }
        __syncthreads();
        { const int r = tid >> 5, ep = tid & 31; float a0 = 0.f, a1 = 0.f; const float* wp = RW + 2 * ep; const LAS float* xr = xs + r * D;
            for (int k0 = 0; k0 < D; k0 += 16) {
                f32x2 wv[16];
#pragma unroll
                for (int j = 0; j < 16; ++j) wv[j] = *(const f32x2*)(wp + (size_t)(k0 + j) * NEXP);
                asm volatile("" : "+v"(wv[0]), "+v"(wv[1]), "+v"(wv[2]), "+v"(wv[3]), "+v"(wv[4]), "+v"(wv[5]), "+v"(wv[6]), "+v"(wv[7]));
                asm volatile("" : "+v"(wv[8]), "+v"(wv[9]), "+v"(wv[10]), "+v"(wv[11]), "+v"(wv[12]), "+v"(wv[13]), "+v"(wv[14]), "+v"(wv[15]));
#pragma unroll
                for (int j = 0; j < 16; ++j) { const float xv = xr[k0 + j]; a0 += xv * wv[j].x; a1 += xv * wv[j].y; } }
            logit[r * NEXP + 2 * ep] = a0; logit[r * NEXP + 2 * ep + 1] = a1; }
        __syncthreads();
        int sel_pos[2]; float sel_gate[2]; int sel_rank[2]; bool sel_on[2];
#pragma unroll
        for (int rr = 0; rr < 2; ++rr) { const int r = 2 * w + rr;
            const float sc = 1.0f / (1.0f + __expf(-logit[r * NEXP + lane])); const float ch = sc + RB[lane];
            int rk = 0;
#pragma unroll
            for (int j = 0; j < 8; ++j) { const float cj = shfl_from(ch, (lane & ~7) + j); rk += (cj > ch || (cj == ch && j < (lane & 7))) ? 1 : 0; }
            float gs = rk < 2 ? ch : 0.f; gs += shfl_x(gs, 1, lane); gs += shfl_x(gs, 2, lane); gs += shfl_x(gs, 4, lane);
            int grk = 0; const int g = lane >> 3;
#pragma unroll
            for (int hh = 0; hh < 8; ++hh) { const float gh = shfl_from(gs, 8 * hh); grk += (gh > gs || (gh == gs && hh < g)) ? 1 : 0; }
            const float msk = grk < 4 ? ch : -INFINITY;
            int erk = 0;
            for (int j = 0; j < 64; ++j) { const float mj = __builtin_bit_cast(float, __builtin_amdgcn_readlane(__builtin_bit_cast(int, msk), j)); erk += (mj > msk || (mj == msk && j < lane)) ? 1 : 0; }
            const bool on = erk < 8;
            const float ssum = wave_sum(on ? sc : 0.f, lane);
            sel_on[rr] = on; sel_rank[rr] = erk; sel_gate[rr] = sc / ssum * 2.5f; sel_pos[rr] = 0;
            if (on) sel_pos[rr] = __hip_atomic_fetch_add(&hist[lane], 1, __ATOMIC_RELAXED, __HIP_MEMORY_SCOPE_WORKGROUP); }
        __syncthreads();
        if (tid < 64) { const int hc = hist[tid]; int bs = 0; if (hc > 0) bs = (int)atomicAdd(&cnt[tid * 16], (unsigned)hc); basep[tid] = bs; }
        __syncthreads();
#pragma unroll
        for (int rr = 0; rr < 2; ++rr) if (sel_on[rr]) { const int t = row0 + 2 * w + rr, pos = basep[lane] + sel_pos[rr];
            ltok[(size_t)lane * CAP + pos] = t; lgate[(size_t)lane * CAP + pos] = sel_gate[rr];
            eidx[t * 8 + sel_rank[rr]] = lane; inv[t * 8 + sel_rank[rr]] = pos; }
    }
}
__device__ __forceinline__ int build_tiles(const Frame& F, const unsigned* cnt) {
    LAS int* tpref = (LAS int*)(F.lds + LDS_TAB); LAS int* cl = (LAS int*)(F.lds + LDS_TAB + 512);
    __syncthreads();
    if (F.tid < 64) cl[F.tid] = (int)__hip_atomic_load(&cnt[F.tid * 16], __ATOMIC_RELAXED, __HIP_MEMORY_SCOPE_AGENT);
    __syncthreads();
    if (F.tid == 0) { int acc = 0; for (int e = 0; e < 64; ++e) { tpref[e] = acc; acc += (cl[e] + 255) >> 8; } tpref[64] = acc; tpref[65] = acc + T / 256; tpref[66] = acc + 2 * (T / 256); cl[64] = T; cl[65] = T; }
    __syncthreads();
    return __builtin_amdgcn_readfirstlane(tpref[64]);
}
__device__ __forceinline__ void phase_moe4(const Frame& F, const float* Y2, const bf16* Yr, const int* eidx, const int* inv, const float* gain, const float* bias, float* XO, bf16* XBo) {
    const LAS int* tpref = (const LAS int*)(F.lds + LDS_TAB);
    const int gw = F.bid * 8 + F.wave, NGW = F.G * 8, lane = F.lane;
    for (int t = gw; t < T; t += NGW) {
        f32x4 v[8];
#pragma unroll
        for (int j = 0; j < 8; ++j) v[j] = *(const f32x4*)(Y2 + (size_t)t * D + 4 * lane + 256 * j);
        for (int k = 0; k < 8; ++k) { const int e = eidx[t * 8 + k], pos = inv[t * 8 + k]; const bf16* yr = Yr + (size_t)(tpref[e] * 256 + pos) * D + 4 * lane;
#pragma unroll
            for (int j = 0; j < 8; ++j) { const v2u w = *(const v2u*)(yr + 256 * j); v[j][0] += bflo(w.x); v[j][1] += bfhi(w.x); v[j][2] += bflo(w.y); v[j][3] += bfhi(w.y); } }
        float sm = 0.f;
#pragma unroll
        for (int j = 0; j < 8; ++j) sm += (v[j][0] + v[j][1]) + (v[j][2] + v[j][3]);
        const float mean = wave_sum(sm, lane) * (1.0f / D); float sq = 0.f;
#pragma unroll
        for (int j = 0; j < 8; ++j) { v[j] = v[j] - mean; sq += (v[j][0] * v[j][0] + v[j][1] * v[j][1]) + (v[j][2] * v[j][2] + v[j][3] * v[j][3]); }
        const float rstd = 1.0f / sqrtf(wave_sum(sq, lane) * (1.0f / D) + LN_EPS);
#pragma unroll
        for (int j = 0; j < 8; ++j) { const int c = 4 * lane + 256 * j; const f32x4 o = v[j] * rstd * *(const f32x4*)(gain + c) + *(const f32x4*)(bias + c);
            *(f32x4*)(XO + (size_t)t * D + c) = o;
            v2u wb; wb.x = pk2(o[0], o[1]); wb.y = pk2(o[2], o[3]); *(v2u*)(XBo + (size_t)t * D + c) = wb; }
    }
}


template <int CTRL> __device__ __forceinline__ float dppf(float x) { return __builtin_bit_cast(float, __builtin_amdgcn_update_dpp(0, __builtin_bit_cast(int, x), CTRL, 0xF, 0xF, false)); }
__device__ __forceinline__ float gmax8(float x) { x = fmaxf(x, dppf<0xB1>(x)); x = fmaxf(x, dppf<0x4E>(x)); x = fmaxf(x, dppf<0x141>(x)); return x; }
__device__ __forceinline__ float gsum8(float x) { x += dppf<0xB1>(x); x += dppf<0x4E>(x); x += dppf<0x141>(x); return x; }
__device__ __forceinline__ float rl_f(float x, int l) { return __builtin_bit_cast(float, __builtin_amdgcn_readlane(__builtin_bit_cast(int, x), l)); }
constexpr int M1_P = 0, M1N_HIST = 131072, M1N_BASE = 131072 + 256, M1N_GB = 131072 + 1024;
__device__ __forceinline__ void phase_moe1n(const Frame& F, const bf16* Y, const float* pst, const float* gain, const float* bias, const bf16* WH, const bf16* WL, const float* RB,
                                            bf16* X1B, float* ST1, unsigned* cnt, int* ltok, float* lgate, int* eidx, int* inv) {
    LAS float* P = (LAS float*)(F.lds + M1_P); LAS int* hist = (LAS int*)(F.lds + M1N_HIST); LAS int* basep = (LAS int*)(F.lds + M1N_BASE);
    const int tid = F.tid, lane = F.lane, w = F.wave, r = lane & 15, q = lane >> 4;
    for (int item = F.bid; item < T / 64; item += F.G) {
        const int row0 = item * 64;
        __syncthreads();
        { int t0 = tid; asm volatile("" : "+v"(t0));
          if (t0 < 64) hist[t0] = 0;
          LAS f32x4* gb = (LAS f32x4*)(F.lds + M1N_GB); gb[t0] = *(const f32x4*)(gain + 4 * t0); gb[512 + t0] = *(const f32x4*)(bias + 4 * t0); }
        __syncthreads();
        float mean[4], rstd[4];
#pragma unroll
        for (int rt = 0; rt < 4; ++rt) { const int row = row0 + 16 * rt + r;
          const f32x4* pp = (const f32x4*)(pst + ((size_t)row * 32 + q * 8) * 2); const f32x4 a = pp[0], b = pp[1], c = pp[2], d = pp[3];
          float sm = (a[0] + a[2]) + (b[0] + b[2]) + (c[0] + c[2]) + (d[0] + d[2]), sq = (a[1] + a[3]) + (b[1] + b[3]) + (c[1] + c[3]) + (d[1] + d[3]);
          sm += shfl_x(sm, 16, lane); sm += shfl_x(sm, 32, lane); sq += shfl_x(sq, 16, lane); sq += shfl_x(sq, 32, lane);
          mean[rt] = sm * (1.0f / D); const float var = fmaxf(sq * (1.0f / D) - mean[rt] * mean[rt], 0.f); rstd[rt] = 1.0f / sqrtf(var + LN_EPS);
          if (w == 0 && q == 0) *(f32x2*)(ST1 + 2 * row) = (f32x2){mean[rt], rstd[rt]}; }
        const int kb = 256 * w + 8 * q;
        const LAS float* gl = (const LAS float*)(F.lds + M1N_GB) + kb;
        f32x4 acc[4][4];
#pragma unroll
        for (int rt = 0; rt < 4; ++rt)
#pragma unroll
            for (int nt = 0; nt < 4; ++nt) acc[rt][nt] = (f32x4){0.f, 0.f, 0.f, 0.f};
        v4u yb[2][2][4], hb[4]; bf16x8 wh[4], wl[4];
        unsigned vo[4];
#pragma unroll
        for (int i = 0; i < 4; ++i) { vo[i] = (unsigned)(r * D + kb) * 2u + (unsigned)i * (16u * D * 2u); asm volatile("" : "+v"(vo[i])); }
        const char* ybase = (const char*)(Y + (size_t)row0 * D); char* xbase = (char*)(X1B + (size_t)row0 * D);
#define M1_LOADY(ms) do { _Pragma("unroll") for (int hf = 0; hf < 2; ++hf) _Pragma("unroll") for (int rt = 0; rt < 4; ++rt) yb[(ms) & 1][hf][rt] = *(const v4u*)(ybase + vo[rt] + 128 * (ms) + 64 * hf); } while (0)
#define M1_LOADW(st) do { _Pragma("unroll") for (int nt = 0; nt < 4; ++nt) { wh[nt] = *(const bf16x8*)((const char*)WH + vo[nt] + 64 * (st)); wl[nt] = *(const bf16x8*)((const char*)WL + vo[nt] + 64 * (st)); } } while (0)
        M1_LOADY(0); M1_LOADW(0); M1_LOADY(1);
        __builtin_amdgcn_sched_barrier(0);
#pragma unroll
        for (int st = 0; st < 8; ++st) {
            const f32x4 g0 = *(const LAS f32x4*)(gl + 32 * st), g1 = *(const LAS f32x4*)(gl + 32 * st + 4), b0 = *(const LAS f32x4*)(gl + 2048 + 32 * st), b1 = *(const LAS f32x4*)(gl + 2048 + 32 * st + 4);
#pragma unroll
            for (int rt = 0; rt < 4; ++rt) { const v4u yv = yb[(st >> 1) & 1][st & 1][rt];
                const f32x4 y0_ = (f32x4){bflo(yv.x), bfhi(yv.x), bflo(yv.y), bfhi(yv.y)}, y1_ = (f32x4){bflo(yv.z), bfhi(yv.z), bflo(yv.w), bfhi(yv.w)};
                const f32x4 x0 = (y0_ - mean[rt]) * rstd[rt] * g0 + b0, x1 = (y1_ - mean[rt]) * rstd[rt] * g1 + b1;
                v4u h; h.x = cvt_pk_bf16(x0[0], x0[1]); h.y = cvt_pk_bf16(x0[2], x0[3]); h.z = cvt_pk_bf16(x1[0], x1[1]); h.w = cvt_pk_bf16(x1[2], x1[3]);
                if ((st & 1) == 0) hb[rt] = h; else { *(v4u*)(xbase + vo[rt] + 64 * (st - 1)) = hb[rt]; *(v4u*)(xbase + vo[rt] + 64 * st) = h; }
                v4u l; l.x = cvt_pk_bf16(x0[0] - bflo(h.x), x0[1] - bfhi(h.x)); l.y = cvt_pk_bf16(x0[2] - bflo(h.y), x0[3] - bfhi(h.y));
                l.z = cvt_pk_bf16(x1[0] - bflo(h.z), x1[1] - bfhi(h.z)); l.w = cvt_pk_bf16(x1[2] - bflo(h.w), x1[3] - bfhi(h.w));
                const bf16x8 xh = __builtin_bit_cast(bf16x8, h), xl = __builtin_bit_cast(bf16x8, l);
#pragma unroll
                for (int nt = 0; nt < 4; ++nt) { acc[rt][nt] = __builtin_amdgcn_mfma_f32_16x16x32_bf16(xh, wh[nt], acc[rt][nt], 0, 0, 0);
                    acc[rt][nt] = __builtin_amdgcn_mfma_f32_16x16x32_bf16(xl, wh[nt], acc[rt][nt], 0, 0, 0); acc[rt][nt] = __builtin_amdgcn_mfma_f32_16x16x32_bf16(xh, wl[nt], acc[rt][nt], 0, 0, 0); } }
            __builtin_amdgcn_sched_barrier(0);
            if (st + 1 < 8) M1_LOADW(st + 1);
            if ((st & 1) == 1 && (st >> 1) + 2 < 4) M1_LOADY((st >> 1) + 2);
            __builtin_amdgcn_sched_barrier(0);
        }
#undef M1_LOADY
#undef M1_LOADW
#pragma unroll
        for (int rt = 0; rt < 4; ++rt)
#pragma unroll
            for (int nt = 0; nt < 4; ++nt)
#pragma unroll
                for (int i = 0; i < 4; ++i) P[(w * 64 + 16 * rt + 4 * q + i) * 64 + 16 * nt + r] = acc[rt][nt][i];
        __syncthreads();
        const float rb = RB[lane];
        LAS int* Pi = (LAS int*)P;
#pragma unroll 1
        for (int rr = 0; rr < 8; ++rr) { const int rl = 8 * w + rr;
            float lg = ((P[rl * 64 + lane] + P[(64 + rl) * 64 + lane]) + (P[(128 + rl) * 64 + lane] + P[(192 + rl) * 64 + lane])) + ((P[(256 + rl) * 64 + lane] + P[(320 + rl) * 64 + lane]) + (P[(384 + rl) * 64 + lane] + P[(448 + rl) * 64 + lane]));
            lg = (lg == lg) ? lg : -1.0e30f;
            const float sc = 1.0f / (1.0f + __expf(-lg)); const float ch = sc + rb;
            const float m1 = gmax8(ch), neq = gsum8(ch == m1 ? 1.f : 0.f), m2c = gmax8(ch < m1 ? ch : -INFINITY);
            const float gs = m1 + (neq >= 2.f ? m1 : m2c);
            int grk = 0; const int g = lane >> 3;
#pragma unroll
            for (int hh = 0; hh < 8; ++hh) { const float gh = rl_f(gs, 8 * hh); grk += (gh > gs || (gh == gs && hh < g)) ? 1 : 0; }
            const float msk = grk < 4 ? ch : -INFINITY;
            float cur = msk, ssum = 0.f; int erk = 64;
#pragma unroll 1
            for (int k = 0; k < 8; ++k) {
                float rm = gmax8(cur); rm = fmaxf(rm, dppf<0x140>(rm));
                const float wm = fmaxf(fmaxf(rl_f(rm, 0), rl_f(rm, 16)), fmaxf(rl_f(rm, 32), rl_f(rm, 48)));
                const unsigned long long bal = __builtin_amdgcn_ballot_w64(cur == wm);
                const int lsel = __builtin_amdgcn_readfirstlane((int)__builtin_ctzll(bal));
                ssum += rl_f(sc, lsel);
                const bool me = lane == lsel; erk = me ? k : erk; cur = me ? -INFINITY : cur; }
            const bool on = erk < 8;
            int pk_ = -1; if (on) pk_ = __hip_atomic_fetch_add(&hist[lane], 1, __ATOMIC_RELAXED, __HIP_MEMORY_SCOPE_WORKGROUP) | (erk << 16);
            P[rl * 64 + lane] = sc / ssum * 2.5f; Pi[(64 + rl) * 64 + lane] = pk_; }
        __syncthreads();
        if (tid < 64) { int tt = tid; asm volatile("" : "+v"(tt));
            const int hc = hist[tt]; int bs = 0; if (hc > 0) bs = (int)atomicAdd(&cnt[tt * 16], (unsigned)hc); basep[tt] = bs; }
        __syncthreads();
        { const int bl = basep[lane];
#pragma unroll 1
          for (int rr = 0; rr < 8; ++rr) { const int rl = 8 * w + rr; const int pk_ = Pi[(64 + rl) * 64 + lane]; const float gt_ = P[rl * 64 + lane];
            if (pk_ >= 0) { const int t = row0 + rl, pos = bl + (pk_ & 0xffff), rk_ = pk_ >> 16;
                ltok[(size_t)lane * CAP + pos] = t * 8 + rk_; lgate[(size_t)lane * CAP + pos] = gt_;
                eidx[t * 8 + rk_] = lane; inv[t * 8 + rk_] = pos; } } }
    }
}

constexpr int M3_PL = 131072, M3_CNT = 147456, M3_OFF = 147456 + 272;
__device__ __forceinline__ void phase_moe3n(const Frame& F, const bf16* H, const bf16* HSp, const int* eidx, const bf16* WD, const bf16* WSD,
                                            const float* Y1, const float* ST1, const float* g1, const float* b1, float* Y2, float* PST2) {
    LAS int* out = (LAS int*)F.lds; LAS unsigned short* plist = (LAS unsigned short*)(F.lds + M3_PL); LAS int* cnt = (LAS int*)(F.lds + M3_CNT); LAS int* off = (LAS int*)(F.lds + M3_OFF);
    const int tid = F.tid, lane = F.lane, w = F.wave, r = lane & 15, q = lane >> 4;
    for (int u = F.bid; u < 1024; u += F.G) {
        int nc = (u & 7) | ((u >> 7) << 3), tb = (u >> 3) & 15;
        if (F.G == 256) { const int i = u >> 8, x = u & 7, j = (u >> 3) & 31; tb = 2 * x + (i >> 1); nc = 32 * (i & 1) + j; }
        __syncthreads();
#pragma unroll
        for (int j = 0; j < 16; ++j) ((LAS v4u*)out)[tid + 512 * j] = (v4u){0u, 0u, 0u, 0u};
        if (tid < 66) cnt[tid] = 0;
        __syncthreads();
        int ee[16], pp[16];
        { const v4u* ep = (const v4u*)(eidx + ((size_t)tb * 1024 + 2 * tid) * 8); const v4u e0 = ep[0], e1 = ep[1], e2 = ep[2], e3 = ep[3];
          ee[0] = e0.x; ee[1] = e0.y; ee[2] = e0.z; ee[3] = e0.w; ee[4] = e1.x; ee[5] = e1.y; ee[6] = e1.z; ee[7] = e1.w;
          ee[8] = e2.x; ee[9] = e2.y; ee[10] = e2.z; ee[11] = e2.w; ee[12] = e3.x; ee[13] = e3.y; ee[14] = e3.z; ee[15] = e3.w; }
#pragma unroll
        for (int j = 0; j < 16; ++j) pp[j] = __hip_atomic_fetch_add(&cnt[ee[j]], 1, __ATOMIC_RELAXED, __HIP_MEMORY_SCOPE_WORKGROUP);
        __syncthreads();
        if (w == 0) { int c = cnt[lane], x = c;
#pragma unroll
            for (int o = 1; o < 64; o <<= 1) { const int y = __builtin_amdgcn_ds_bpermute(((lane - o) & 63) << 2, x); if (lane >= o) x += y; }
            off[lane] = x - c; if (lane == 63) off[64] = x; }
        __syncthreads();
#pragma unroll
        for (int j = 0; j < 16; ++j) plist[off[ee[j]] + pp[j]] = (unsigned short)(tid * 16 + j);
        __syncthreads();
        const char* Hb = (const char*)H + (size_t)tb * 8192 * 256 + q * 16;
        const char* HSb = (const char*)HSp + (size_t)tb * 1024 * 512 + q * 16;
        const char* Bb = (const char*)WD + ((size_t)nc * 32 + r) * 256 + q * 16;
        const char* BSb = (const char*)WSD + ((size_t)nc * 32 + r) * 512 + q * 16;
#define M3_NR(sg) ((sg) < 8 ? __builtin_amdgcn_readfirstlane(cnt[w + 8 * (sg)]) : 128)
#define M3_RB(sg) ((sg) < 8 ? __builtin_amdgcn_readfirstlane(off[w + 8 * (sg)]) : 0)
#define M3_GLD(dst, ptr, OFF) asm volatile("global_load_dwordx4 %0, %1, off offset:" #OFF : "=&v"(dst) : "v"(ptr) : "memory")
#define M3_LOADB(dst, sg) do { const char* _b0 = (sg) < 8 ? Bb + (size_t)(w + 8 * (sg)) * 524288 : BSb + ((sg) - 8) * 256; const char* _b1 = _b0 + ((sg) < 8 ? 4096 : 8192); \
            M3_GLD(dst[0][0], _b0, 0); M3_GLD(dst[0][1], _b0, 64); M3_GLD(dst[0][2], _b0, 128); M3_GLD(dst[0][3], _b0, 192); \
            M3_GLD(dst[1][0], _b1, 0); M3_GLD(dst[1][1], _b1, 64); M3_GLD(dst[1][2], _b1, 128); M3_GLD(dst[1][3], _b1, 192); } while (0)
#define M3_LOADA(dst, sg, bb, nr, rbs) do { int _i = 16 * (bb) + r; _i = _i < (nr) ? _i : (nr) - 1; const unsigned _rid = plist[(rbs) + _i]; \
            const char* _a = (sg) < 8 ? Hb + (size_t)_rid * 256 : ((sg) < 10 ? HSb + (size_t)(128 * w + _i) * 512 + ((sg) - 8) * 256 : Hb); \
            M3_GLD(dst[0], _a, 0); M3_GLD(dst[1], _a, 64); M3_GLD(dst[2], _a, 128); M3_GLD(dst[3], _a, 192); } while (0)
#define M3_ADV(sg, bb, nr, rbs) do { if ((sg) < 10) { ++(bb); if ((bb) * 16 >= (nr)) { (bb) = 0; do { ++(sg); } while ((sg) < 8 && M3_NR(sg) == 0); if ((sg) < 10) { (nr) = M3_NR(sg); (rbs) = M3_RB(sg); } } } } while (0)
#define M3_WAITA(AS) asm volatile("s_waitcnt vmcnt(12)" : "+v"(AS[0]), "+v"(AS[1]), "+v"(AS[2]), "+v"(AS[3]) :: "memory")
#define M3_WAITB(N) asm volatile("s_waitcnt vmcnt(" #N ")" : "+v"(Bn[0][0]), "+v"(Bn[0][1]), "+v"(Bn[0][2]), "+v"(Bn[0][3]), "+v"(Bn[1][0]), "+v"(Bn[1][1]), "+v"(Bn[1][2]), "+v"(Bn[1][3]) :: "memory")
#define M3_STEP(AS) if (cseg < 10) { \
              \
            int tk[4]; bool ok[4]; unsigned pl[4]; const int rt_ = cseg < 8; \
            _Pragma("unroll") for (int i = 0; i < 4; ++i) { const int idx = 16 * cbt + 4 * q + i; ok[i] = idx < cnr; const int ic = ok[i] ? idx : cnr - 1; pl[i] = plist[crbs + ic]; tk[i] = 128 * w + ic; } \
            _Pragma("unroll") for (int i = 0; i < 4; ++i) tk[i] = rt_ ? (int)(pl[i] >> 3) : tk[i]; \
            M3_WAITA(AS); \
            f32x4 acc[2]; \
            _Pragma("unroll") for (int nt = 0; nt < 2; ++nt) { acc[nt] = (f32x4){0.f, 0.f, 0.f, 0.f}; \
                _Pragma("unroll") for (int kk = 0; kk < 4; ++kk) acc[nt] = __builtin_amdgcn_mfma_f32_16x16x32_bf16(__builtin_bit_cast(bf16x8, AS[kk]), __builtin_bit_cast(bf16x8, Bc[nt][kk]), acc[nt], 0, 0, 0); } \
              \
            _Pragma("unroll") for (int i = 0; i < 4; ++i) { const long long lo_ = ok[i] ? (long long)__float2int_rn(acc[0][i] * 4194304.0f) : 0ll, hi_ = ok[i] ? (long long)__float2int_rn(acc[1][i] * 4194304.0f) : 0ll; \
                (void)__hip_atomic_fetch_add((LAS unsigned long long*)out + tk[i] * 16 + r, (unsigned long long)((hi_ << 32) + lo_), __ATOMIC_RELAXED, __HIP_MEMORY_SCOPE_WORKGROUP); } \
            M3_LOADA(AS, pseg, pbt, pnr, prbs); M3_ADV(pseg, pbt, pnr, prbs); \
            { const int old_ = cseg, nbat_ = (cnr + 15) >> 4; M3_ADV(cseg, cbt, cnr, crbs); \
              if (cseg != old_ && cseg < 10) { \
                  if (nbat_ == 1) M3_WAITB(4); else if (nbat_ == 2) M3_WAITB(8); else if (nbat_ == 3) M3_WAITB(12); else M3_WAITB(16); \
                  _Pragma("unroll") for (int nt = 0; nt < 2; ++nt) _Pragma("unroll") for (int kk = 0; kk < 4; ++kk) Bc[nt][kk] = Bn[nt][kk]; \
                  int nb_ = cseg; do { ++nb_; } while (nb_ < 8 && M3_NR(nb_) == 0); if (nb_ >= 10) nb_ = 9; M3_LOADB(Bn, nb_); } } }
        int cseg = -1, cbt = 0, cnr = 0, crbs = 0;
        do { ++cseg; } while (cseg < 8 && M3_NR(cseg) == 0);
        cnr = M3_NR(cseg); crbs = M3_RB(cseg);
        int pseg = cseg, pbt = 0, pnr = cnr, prbs = crbs;
        v4u Bc[2][4], Bn[2][4], A0[4], A1[4], A2[4], A3[4];
        M3_LOADB(Bc, cseg);
        M3_LOADA(A0, pseg, pbt, pnr, prbs); M3_ADV(pseg, pbt, pnr, prbs);
        M3_LOADA(A1, pseg, pbt, pnr, prbs); M3_ADV(pseg, pbt, pnr, prbs);
        M3_LOADA(A2, pseg, pbt, pnr, prbs); M3_ADV(pseg, pbt, pnr, prbs);
        M3_LOADA(A3, pseg, pbt, pnr, prbs); M3_ADV(pseg, pbt, pnr, prbs);
        { int nb_ = cseg; do { ++nb_; } while (nb_ < 8 && M3_NR(nb_) == 0); if (nb_ >= 10) nb_ = 9; M3_LOADB(Bn, nb_); }
        asm volatile("s_waitcnt vmcnt(0)" : "+v"(Bc[0][0]), "+v"(Bc[0][1]), "+v"(Bc[0][2]), "+v"(Bc[0][3]), "+v"(Bc[1][0]), "+v"(Bc[1][1]), "+v"(Bc[1][2]), "+v"(Bc[1][3]) :: "memory");
#pragma unroll 1
        while (cseg < 10) { M3_STEP(A0) M3_STEP(A1) M3_STEP(A2) M3_STEP(A3) }
        asm volatile("s_waitcnt vmcnt(0)" : "+v"(A0[0]), "+v"(A0[1]), "+v"(A0[2]), "+v"(A0[3]), "+v"(A1[0]), "+v"(A1[1]), "+v"(A1[2]), "+v"(A1[3]), "+v"(A2[0]), "+v"(A2[1]), "+v"(A2[2]), "+v"(A2[3]),
                     "+v"(A3[0]), "+v"(A3[1]), "+v"(A3[2]), "+v"(A3[3]), "+v"(Bn[0][0]), "+v"(Bn[0][1]), "+v"(Bn[0][2]), "+v"(Bn[0][3]), "+v"(Bn[1][0]), "+v"(Bn[1][1]), "+v"(Bn[1][2]), "+v"(Bn[1][3]) :: "memory");
#undef M3_NR
#undef M3_RB
#undef M3_GLD
#undef M3_LOADB
#undef M3_LOADA
#undef M3_ADV
#undef M3_WAITA
#undef M3_WAITB
#undef M3_STEP
        __syncthreads();
        { const int c4 = lane & 7, rs = lane >> 3, col = nc * 32 + 4 * c4;
          const f32x4 gv = *(const f32x4*)(g1 + col), bv = *(const f32x4*)(b1 + col);
#pragma unroll 4
          for (int it = 0; it < 16; ++it) { const int rl = 128 * w + 8 * it + rs; const size_t row = (size_t)tb * 1024 + rl;
              const f32x4 yv = *(const f32x4*)(Y1 + row * D + col); const f32x2 sv = *(const f32x2*)(ST1 + 2 * row);
              f32x4 tv; { const int nt = c4 >> 2, r0 = (4 * c4) & 15;
#pragma unroll
                  for (int j = 0; j < 4; ++j) { const v2u cell = *(const LAS v2u*)(out + rl * 32 + 2 * (r0 + j)); const int lo = (int)cell.x, hi = (int)cell.y + (lo < 0 ? 1 : 0); tv[j] = (float)(nt ? hi : lo) * (1.0f / 4194304.0f); } }
              const f32x4 y = ((yv - sv.x) * sv.y * gv + bv) * ALPHA + tv;
              *(f32x4*)(Y2 + row * D + col) = y;
              float sm = (y[0] + y[1]) + (y[2] + y[3]), sq = (y[0] * y[0] + y[1] * y[1]) + (y[2] * y[2] + y[3] * y[3]);
#pragma unroll
              for (int o = 1; o < 8; o <<= 1) { sm += shfl_x(sm, o, lane); sq += shfl_x(sq, o, lane); }
              if (c4 == 0) *(f32x2*)(PST2 + (row * 64 + nc) * 2) = (f32x2){sm, sq}; } }
    }
}

__device__ __forceinline__ void phase_moe4n(const Frame& F, const float* Y2, const float* pst, const float* gain, const float* bias, float* ST2, bf16* XBo, float* OUT, int last) {
    const int gw = F.bid * 8 + F.wave, NGW = F.G * 8, lane = F.lane;
    for (int t = gw; t < T; t += NGW) {
        f32x4 v[8];
#pragma unroll
        for (int j = 0; j < 8; ++j) v[j] = *(const f32x4*)(Y2 + (size_t)t * D + 4 * lane + 256 * j);
        const f32x2 pv = *(const f32x2*)(pst + ((size_t)t * 64 + lane) * 2);
        const float mean = wave_sum(pv.x, lane) * (1.0f / D); const float var = fmaxf(wave_sum(pv.y, lane) * (1.0f / D) - mean * mean, 0.f); const float rstd = 1.0f / sqrtf(var + LN_EPS);
        if (lane == 0) *(f32x2*)(ST2 + 2 * (size_t)t) = (f32x2){mean, rstd};
#pragma unroll
        for (int j = 0; j < 8; ++j) { const int c = 4 * lane + 256 * j; const f32x4 o = (v[j] - mean) * rstd * *(const f32x4*)(gain + c) + *(const f32x4*)(bias + c);
            if (last) *(f32x4*)(OUT + (size_t)t * D + c) = o;
            else { v2u wb; wb.x = pk2(o[0], o[1]); wb.y = pk2(o[2], o[3]); *(v2u*)(XBo + (size_t)t * D + c) = wb; } }
    }
}


__device__ __forceinline__ void phase_moe4q(const Frame& F, const bf16* X1, bf16* Y2, const unsigned char* Yq, const float* Ysc, const int* eidx, const int* inv, const float* gain, const float* bias, float* ST2, bf16* XBo, float* OUT, int last) {
    const LAS int* tpref = (const LAS int*)(F.lds + LDS_TAB);
    const int gw = F.bid * 8 + F.wave, NGW = F.G * 8, lane = F.lane;
    int en = 0, pn = 0; if (lane < 8 && gw < T) { en = eidx[gw * 8 + lane]; pn = inv[gw * 8 + lane]; }
    for (int t = gw; t < T; t += NGW) {
        int rowi = 0; if (lane < 8) rowi = tpref[en] * 256 + pn; else if (lane < 10) rowi = tpref[56 + lane] * 256 + t;
        if (lane < 8 && t + NGW < T) { en = eidx[(t + NGW) * 8 + lane]; pn = inv[(t + NGW) * 8 + lane]; }
        v4u pv[2][2], yv[10][2]; float sc[10][2];
#pragma unroll
        for (int j = 0; j < 2; ++j) { pv[j][0] = __builtin_nontemporal_load((const v4u*)(X1 + (size_t)t * D + 16 * lane + 1024 * j)); pv[j][1] = __builtin_nontemporal_load((const v4u*)(X1 + (size_t)t * D + 16 * lane + 1024 * j + 8)); }
#pragma unroll
        for (int k = 0; k < 10; ++k) { const size_t row = (size_t)__builtin_amdgcn_readlane(rowi, k);
#pragma unroll
            for (int j = 0; j < 2; ++j) { yv[k][j] = __builtin_nontemporal_load((const v4u*)(Yq + row * D + 16 * lane + 1024 * j)); sc[k][j] = __builtin_nontemporal_load(Ysc + row * 16 + 8 * j + (lane >> 3)); } }
#pragma unroll
        for (int k = 0; k < 10; ++k) asm volatile("" : "+v"(yv[k][0]), "+v"(yv[k][1]), "+v"(sc[k][0]), "+v"(sc[k][1]));
        float v[2][16];
#pragma unroll
        for (int j = 0; j < 2; ++j) { float f0[8], f1[8]; unpack8(pv[j][0], f0); unpack8(pv[j][1], f1);
            const float ss = (((sc[0][j] + sc[1][j]) + (sc[2][j] + sc[3][j])) + ((sc[4][j] + sc[5][j]) + (sc[6][j] + sc[7][j]))) + (sc[8][j] + sc[9][j]);
#pragma unroll
            for (int i = 0; i < 8; ++i) { v[j][i] = ALPHA * f0[i] - 128.f * ss; v[j][8 + i] = ALPHA * f1[i] - 128.f * ss; } }
#pragma unroll
        for (int k = 0; k < 10; ++k)
#pragma unroll
            for (int j = 0; j < 2; ++j) { const float s_ = sc[k][j]; const unsigned q[4] = {yv[k][j].x, yv[k][j].y, yv[k][j].z, yv[k][j].w};
#pragma unroll
                for (int d = 0; d < 4; ++d) { v[j][4 * d + 0] += s_ * (float)(q[d] & 0xffu); v[j][4 * d + 1] += s_ * (float)((q[d] >> 8) & 0xffu); v[j][4 * d + 2] += s_ * (float)((q[d] >> 16) & 0xffu); v[j][4 * d + 3] += s_ * (float)(q[d] >> 24); } }
        float sm = 0.f;
#pragma unroll
        for (int j = 0; j < 2; ++j)
#pragma unroll
            for (int i = 0; i < 16; i += 4) sm += (v[j][i] + v[j][i + 1]) + (v[j][i + 2] + v[j][i + 3]);
        const float mean = wave_sum(sm, lane) * (1.0f / D); float sq = 0.f;
#pragma unroll
        for (int j = 0; j < 2; ++j)
#pragma unroll
            for (int i = 0; i < 16; ++i) { const float d = v[j][i] - mean; sq += d * d; }
        const float rstd = 1.0f / sqrtf(wave_sum(sq, lane) * (1.0f / D) + LN_EPS);
        (void)ST2; (void)Y2;
#pragma unroll
        for (int j = 0; j < 2; ++j)
#pragma unroll
            for (int h = 0; h < 2; ++h) { const int c = 16 * lane + 1024 * j + 8 * h; const float* vv = &v[j][8 * h];
                const f32x4 g0 = *(const f32x4*)(gain + c), g1 = *(const f32x4*)(gain + c + 4), b0 = *(const f32x4*)(bias + c), b1 = *(const f32x4*)(bias + c + 4);
                const f32x4 o0 = ((f32x4){vv[0], vv[1], vv[2], vv[3]} - mean) * rstd * g0 + b0, o1 = ((f32x4){vv[4], vv[5], vv[6], vv[7]} - mean) * rstd * g1 + b1;
                if (last) { *(f32x4*)(OUT + (size_t)t * D + c) = o0; *(f32x4*)(OUT + (size_t)t * D + c + 4) = o1; }
                else { v4u wb; wb.x = pk2(o0[0], o0[1]); wb.y = pk2(o0[2], o0[3]); wb.z = pk2(o1[0], o1[1]); wb.w = pk2(o1[2], o1[3]); *(v4u*)(XBo + (size_t)t * D + c) = wb; } }
    }
}

__device__ __forceinline__ void phase_downproj3(const Frame& F, const bf16* H, const bf16* WD, const bf16* HSp, const bf16* WSD, unsigned char* Yq, float* Ysc, int NT) {
    const LAS int* tpref = (const LAS int*)(F.lds + LDS_TAB); const LAS int* cl = (const LAS int*)(F.lds + LDS_TAB + 512);
    LAS unsigned char* lds = F.lds;
    const int tid = F.tid, lane = F.lane, w = F.wave, fr = lane & 15, fq = lane >> 4;
    unsigned rbB[2], cbB[2];
#pragma unroll
    for (int i = 0; i < 2; ++i) { int R_, C_; g8::stage_rc(tid * 16 + i * 8192, R_, C_); rbB[i] = (unsigned)((R_ & ~31) + g8::perm32(R_ & 31)); cbB[i] = (unsigned)C_ * 2u; }
    const unsigned ldsw = (unsigned)w * 1024u, lbase = (unsigned)(size_t)lds;
    int boffg[4];
#pragma unroll
    for (int g = 0; g < 4; ++g) boffg[g] = g8::lds_byte(32 * g + fr, fq * 8);
    LAS unsigned char* stg = lds + 65536 + w * (32 * 144);
    const int NU = NT * 4;
    const int upos = (F.G % 8) == 0 ? (F.bid & 7) * (F.G >> 3) + (F.bid >> 3) : F.bid;
    int ub = 0;
    int u = (F.G <= NU) ? upos : F.bid; if (u >= NU) return;
#define DP3_UNITINFO(uu, E0, EXP, NV) do { const int tl_ = (uu) >> 2; int e_ = (E0); while (__builtin_amdgcn_readfirstlane(tpref[e_ + 1]) <= tl_) ++e_; EXP = e_; \
        NV = __builtin_amdgcn_readfirstlane(cl[e_]) - (tl_ - __builtin_amdgcn_readfirstlane(tpref[e_])) * 256; } while (0)
#define DP3_GLDS(gsrc, ldsdst) do { unsigned keep_; asm volatile("s_mov_b32 %0, m0\n\ts_mov_b32 m0, %2\n\ts_nop 0\n\tglobal_load_lds_dwordx4 %1, off\n\ts_mov_b32 m0, %0" : "=&s"(keep_) : "v"(gsrc), "s"(ldsdst) : "memory"); } while (0)
#define DP3_STAGE(slot, gb, bs) do { const unsigned v0_ = rbB[0] * (unsigned)(bs) + cbB[0], v1_ = rbB[1] * (unsigned)(bs) + cbB[1]; _Pragma("unroll") for (int kt = 0; kt < 2; ++kt) { \
        DP3_GLDS((const void*)((gb) + kt * 128 + v0_), lbase + (unsigned)((slot) * 32768 + kt * 16384) + ldsw); \
        DP3_GLDS((const void*)((gb) + kt * 128 + v1_), lbase + (unsigned)((slot) * 32768 + kt * 16384) + ldsw + 8192u); } } while (0)
#define DP3_SRC(uu, ee, AB, AS, BB, BS) do { const int tl_ = (uu) >> 2, cu_ = ((uu) & 3) * 512; \
        if ((ee) < 64) { AB = (const char*)(H + (size_t)tl_ * 256 * EDIM); AS = EDIM * 2; BB = (const char*)(WD + (size_t)(ee) * D * EDIM + (size_t)cu_ * EDIM); BS = EDIM * 2; } \
        else { const int t0_ = (tl_ - __builtin_amdgcn_readfirstlane(tpref[ee])) * 256; AB = (const char*)(HSp + (size_t)t0_ * SDIM + ((ee) - 64) * EDIM); AS = SDIM * 2; \
               BB = (const char*)(WSD + (size_t)cu_ * SDIM + ((ee) - 64) * EDIM); BS = SDIM * 2; } } while (0)
    int ecur, nvcur; DP3_UNITINFO(u, 0, ecur, nvcur);
    const char* abc; const char* gbc; int asc, bsc; DP3_SRC(u, ecur, abc, asc, gbc, bsc);
    bf16x8 A[2][4], An[2][4];
    { const char* ap_ = abc + (size_t)(32 * w + fr) * asc + 16 * fq;
#pragma unroll
      for (int m = 0; m < 2; ++m)
#pragma unroll
          for (int kk = 0; kk < 4; ++kk) A[m][kk] = *(const bf16x8*)(ap_ + (size_t)m * 16 * asc + 64 * kk); }
    DP3_STAGE(0, gbc, bsc);
    asm volatile("s_waitcnt vmcnt(0)" ::: "memory");
#pragma unroll 1
    for (;;) {
        int un = u; { const int nb = ub + F.G; if (nb + F.G <= NU) un = nb + upos; else if (nb + F.bid < NU) un = nb + F.bid; if (un != u) ub = nb; }
        int enx, nvnx; DP3_UNITINFO(un, (un > u ? ecur : 0), enx, nvnx);
        const char* abn; const char* gbn; int asn, bsn; DP3_SRC(un, enx, abn, asn, gbn, bsn);
        const int tile = u >> 2, colu = (u & 3) * 512;
        float scq[2][4];
#pragma unroll
        for (int c = 0; c < 4; ++c) {
            if (c == 0) asm volatile("s_waitcnt vmcnt(5)" ::: "memory"); else asm volatile("s_waitcnt vmcnt(4)" ::: "memory");
            __builtin_amdgcn_s_barrier();
            if (c == 3) { const char* ap_ = abn + (size_t)(32 * w + fr) * asn + 16 * fq;
#pragma unroll
                for (int m = 0; m < 2; ++m) { const char* am_ = ap_ + (size_t)m * 16 * asn;
                    asm volatile("global_load_dwordx4 %0, %1, off" : "=&v"(An[m][0]) : "v"(am_) : "memory"); asm volatile("global_load_dwordx4 %0, %1, off offset:64" : "=&v"(An[m][1]) : "v"(am_) : "memory");
                    asm volatile("global_load_dwordx4 %0, %1, off offset:128" : "=&v"(An[m][2]) : "v"(am_) : "memory"); asm volatile("global_load_dwordx4 %0, %1, off offset:192" : "=&v"(An[m][3]) : "v"(am_) : "memory"); } }
            { const char* gnext = (c < 3) ? gbc + (size_t)(c + 1) * 128 * bsc : gbn; const int bnext = (c < 3) ? bsc : bsn; DP3_STAGE((c + 1) & 1, gnext, bnext); }
            __builtin_amdgcn_sched_barrier(0);
            f32x4 acc[2][4][2];
#pragma unroll
            for (int g = 0; g < 4; ++g) { bf16x8 Bf[2][4];
#pragma unroll
                for (int n = 0; n < 2; ++n)
#pragma unroll
                    for (int kk = 0; kk < 4; ++kk) Bf[n][kk] = *(const LAS bf16x8*)(lds + (c & 1) * 32768 + (kk >> 1) * 16384 + boffg[g] + n * 2048 + (kk & 1) * 1024);
#pragma unroll
                for (int m = 0; m < 2; ++m)
#pragma unroll
                    for (int n = 0; n < 2; ++n) { acc[m][g][n] = (f32x4){0.f, 0.f, 0.f, 0.f};
#pragma unroll
                        for (int kk = 0; kk < 4; ++kk) acc[m][g][n] = __builtin_amdgcn_mfma_f32_16x16x32_bf16(Bf[n][kk], A[m][kk], acc[m][g][n], 0, 0, 0); } }
#pragma unroll
            for (int m = 0; m < 2; ++m) {
                float am0 = 0.f, am1 = 0.f;
#pragma unroll
                for (int g = 0; g < 4; ++g)
#pragma unroll
                    for (int n = 0; n < 2; ++n) { am0 = fmaxf(fmaxf(am0, fabsf(acc[m][g][n][0])), fabsf(acc[m][g][n][1])); am1 = fmaxf(fmaxf(am1, fabsf(acc[m][g][n][2])), fabsf(acc[m][g][n][3])); }
                float am = fmaxf(am0, am1);
                am = fmaxf(am, shfl_x(am, 16, lane)); am = fmaxf(am, shfl_x(am, 32, lane));
                am = fminf(am, 3.0e38f);
                const float isc = am > 0.f ? 127.0f * __builtin_amdgcn_rcpf(am) : 0.f;
                scq[m][c] = am * (1.0f / 127.0f);
                const f32x2_t isc2 = (f32x2_t){isc, isc}, mg2 = (f32x2_t){8388736.0f, 8388736.0f};
#pragma unroll
                for (int g = 0; g < 4; ++g) { unsigned qd[2];
#pragma unroll
                    for (int n = 0; n < 2; ++n) {
                        const f32x2_t tl = __builtin_elementwise_fma((f32x2_t){acc[m][g][n][0], acc[m][g][n][1]}, isc2, mg2), th = __builtin_elementwise_fma((f32x2_t){acc[m][g][n][2], acc[m][g][n][3]}, isc2, mg2);
                        const float f0_ = tl.x, f1_ = tl.y, f2_ = th.x, f3_ = th.y;
                        qd[n] = __builtin_amdgcn_perm(__builtin_bit_cast(unsigned, f1_), __builtin_bit_cast(unsigned, f0_), 0x0c0c0400u) | __builtin_amdgcn_perm(__builtin_bit_cast(unsigned, f3_), __builtin_bit_cast(unsigned, f2_), 0x04000c0cu); }
                    *(LAS v2u*)(stg + (16 * m + fr) * 144 + 32 * g + 8 * fq) = (v2u){qd[0], qd[1]}; } }
#pragma unroll
            for (int it = 0; it < 4; ++it) { const int rr = 8 * it + (lane >> 3);
                const v4u o = *(const LAS v4u*)(stg + rr * 144 + (lane & 7) * 16);
                __builtin_nontemporal_store(o, (v4u*)(Yq + (size_t)(tile * 256 + 32 * w + rr) * D + colu + 128 * c + 16 * (lane & 7))); }
            if (c == 3) { const f32x4 so = fq == 0 ? (f32x4){scq[0][0], scq[0][1], scq[0][2], scq[0][3]} : (f32x4){scq[1][0], scq[1][1], scq[1][2], scq[1][3]};
                if (fq < 2) __builtin_nontemporal_store(so, (f32x4*)(Ysc + (size_t)(tile * 256 + 32 * w + 16 * fq + fr) * 16 + (colu >> 7))); }
            __builtin_amdgcn_sched_barrier(0);
        }
        asm volatile("s_waitcnt vmcnt(9)" : "+v"(An[0][0]), "+v"(An[0][1]), "+v"(An[0][2]), "+v"(An[0][3]), "+v"(An[1][0]), "+v"(An[1][1]), "+v"(An[1][2]), "+v"(An[1][3]) :: "memory");
        if (un == u) break;
#pragma unroll
        for (int m = 0; m < 2; ++m)
#pragma unroll
            for (int kk = 0; kk < 4; ++kk) A[m][kk] = An[m][kk];
        u = un; ecur = enx; nvcur = nvnx; abc = abn; asc = asn; gbc = gbn; bsc = bsn;
    }
    asm volatile("s_waitcnt vmcnt(0)" ::: "memory");
#undef DP3_UNITINFO
#undef DP3_STAGE
#undef DP3_GLDS
#undef DP3_SRC
}

enum { PH_PRO = 0, PH_POOL_G1, PH_POOL_P, PH_POOL_G2, PH_POOL_G3, PH_DIL_G1, PH_DIL_ATT, PH_DIL_CMB, PH_DIL_G2, PH_CONV_G1, PH_CONV_E, PH_CONV_G2, PH_MOE1, PH_MOE2, PH_MOE3, PH_MOE4, PH_COUNT };

template <int PH>
__device__ __forceinline__ void run_phase(const Frame& Fin, const Args& args_, const int L) {
    Frame F = Fin; { int w_ = Fin.wave, l_; asm volatile("" : "+s"(w_)); asm volatile("v_mbcnt_lo_u32_b32 %0, -1, 0\n\tv_mbcnt_hi_u32_b32 %0, -1, %0" : "=v"(l_)); F.wave = w_; F.lane = l_; F.tid = w_ * 64 + l_; }
    unsigned char* ws; { GAS unsigned char* wsg = (GAS unsigned char*)Fin.ws; asm volatile("" : "+s"(wsg)); ws = (unsigned char*)wsg; } F.ws = ws; F.ctl = (unsigned*)(ws + WS_CTL);
    KP kp = (KP)__builtin_amdgcn_kernarg_segment_ptr(); asm volatile("" : "+s"(kp)); (void)args_;
    { unsigned l_ = (unsigned)(size_t)Fin.lds; asm volatile("" : "+s"(l_)); F.lds = (LAS unsigned char*)(size_t)l_; }
    LAS unsigned char* ring = F.lds; int c = (int)blockIdx.x; { int g_ = Fin.G; asm volatile("" : "+s"(c), "+s"(g_)); F.G = g_; F.bid = c; }
    const float* xres = ain(kp, IN_X);
    const float* st2 = (const float*)(ws + WS_ST2); float* pstp = (float*)(ws + WS_PST);
    const float* g2p = ain(kp, IN_LNG) + (size_t)((L > 0 ? L - 1 : 0) * 2 + 1) * D; const float* b2p = ain(kp, IN_LNB) + (size_t)((L > 0 ? L - 1 : 0) * 2 + 1) * D;
    const bf16* xb = (const bf16*)(ws + WS_XB);
    bf16* yf = (bf16*)(ws + WS_YF);
    unsigned char* big = ws + WS_BIG;
    const int ia = L / 3;
    if constexpr (PH == PH_PRO) { phase_prologue(F, kp); }
    if constexpr (PH == PH_POOL_G1) { g8::DenseSched S; S.init(xb, (const bf16*)(ws + WS_W_POOL_IN) + (size_t)ia * D * D, T, D, D, D, F.G, c);
        g8::EpiBf16 E{(bf16*)(big + BG_U), D, 0}; g8::gemm_phase<g8::EpiBf16, g8::DenseSched, false>(ring, F.tid, D, D, D, S, E); }
    if constexpr (PH == PH_POOL_P) { phase_pool(F, (const bf16*)(big + BG_U), (bf16*)(big + BG_PL)); }
    if constexpr (PH == PH_POOL_G2) { g8::DenseSched S; S.init((const bf16*)(big + BG_PL), (const bf16*)(ws + WS_W_POOL_G) + (size_t)ia * D * 512, T, D, D, 512, F.G, c); S.agrp_shift = 1; S.agrp_stride = 512 * 2;
        g8::EpiScaleBf16 E{(bf16*)(big + BG_MX), D, ain(kp, IN_PSC) + (size_t)ia * D}; g8::gemm_phase<g8::EpiScaleBf16, g8::DenseSched, false>(ring, F.tid, 512, D, 512, S, E); }
    if constexpr (PH == PH_POOL_G3) { g8::DenseSched S; S.init((const bf16*)(big + BG_MX), (const bf16*)(ws + WS_W_POOL_OUT) + (size_t)ia * D * D, T, D, D, D, F.G, c);
        g8::EpiResidLN E{xres, xb, st2, g2p, b2p, yf, pstp, 2}; g8::gemm_phase<g8::EpiResidLN, g8::DenseSched, false>(ring, F.tid, D, D, D, S, E); }
    if constexpr (PH == PH_DIL_G1) { g8::DenseSched S; S.init(xb, (const bf16*)(ws + WS_W_DIL_QKV), T, QKVC, D, D, F.G, c);
        g8::EpiBf16 E{(bf16*)(big + BG_QKV), QKVC, 1}; g8::gemm_phase<g8::EpiBf16, g8::DenseSched, false>(ring, F.tid, D, D, D, S, E); }
    if constexpr (PH == PH_DIL_ATT) { phase_attn(F, (const bf16*)(big + BG_QKV), ain(kp, IN_RELB), (bf16*)(big + BG_OG), (float*)(big + BG_LSE)); }
    if constexpr (PH == PH_DIL_CMB) { phase_combine(F, (const bf16*)(big + BG_OG), (const float*)(big + BG_LSE), (bf16*)(big + BG_O)); }
    if constexpr (PH == PH_DIL_G2) { g8::DenseSched S; S.init((const bf16*)(big + BG_O), (const bf16*)(ws + WS_W_DIL_OUT), T, D, DILW, DILW, F.G, c);
        g8::EpiResidLN E{xres, xb, st2, g2p, b2p, yf, pstp, 2}; g8::gemm_phase<g8::EpiResidLN, g8::DenseSched, false>(ring, F.tid, DILW, DILW, DILW, S, E); }
    if constexpr (PH == PH_CONV_G1) { g8::DenseSched S; S.init(xb, (const bf16*)(ws + WS_W_CONV_IN), T, 3 * D, D, D, F.G, c);
        g8::EpiConvIn E{(bf16*)(big + BG_UC), (bf16*)(big + BG_BG)}; g8::gemm_phase<g8::EpiConvIn, g8::DenseSched, false>(ring, F.tid, D, D, D, S, E); }
    if constexpr (PH == PH_CONV_E) { phase_conv(F, (const bf16*)(big + BG_UC), (const bf16*)(big + BG_BG), ain(kp, IN_CW), (bf16*)(big + BG_Z)); }
    if constexpr (PH == PH_CONV_G2) { g8::DenseSched S; S.init((const bf16*)(big + BG_Z), (const bf16*)(ws + WS_W_CONV_OUT), T, D, D, D, F.G, c);
        g8::EpiResidLN E{xres, xb, st2, g2p, b2p, yf, pstp, 2}; g8::gemm_phase<g8::EpiResidLN, g8::DenseSched, false>(ring, F.tid, D, D, D, S, E); }
    unsigned* cnt = F.ctl + CW_CNT + L * 64 * 16;
    float* x1f = (float*)(ws + WS_X1F); bf16* x1b = (bf16*)(ws + WS_X1B);
    int* ltok = (int*)(ws + WS_LTOK); float* lgate = (float*)(ws + WS_LGATE); int* eidx = (int*)(ws + WS_EIDX); int* inv = (int*)(ws + WS_INV);
    bf16* HB = (bf16*)(ws + WS_HB); bf16* HS = (bf16*)(ws + WS_HS); bf16* Yr = (bf16*)(ws + WS_BIG);
    if constexpr (PH == PH_MOE1) {
        const float* g1 = ain(kp, IN_LNG) + (size_t)(L * 2 + 0) * D; const float* b1 = ain(kp, IN_LNB) + (size_t)(L * 2 + 0) * D;
        phase_moe1n(F, yf, pstp, g1, b1, (const bf16*)(ws + WS_RWH) + (size_t)L * NEXP * D, (const bf16*)(ws + WS_RWL) + (size_t)L * NEXP * D, ain(kp, IN_RB) + (size_t)L * NEXP,
                    x1b, (float*)(ws + WS_ST1), cnt, ltok, lgate, eidx, inv); }
    if constexpr (PH == PH_MOE2) {
        const int NT = build_tiles(F, cnt);
        { g8::ExpertSched<1, true> S; S.tpref = (const LAS int*)(F.lds + LDS_TAB); S.cnt = (const LAS int*)(F.lds + LDS_TAB + 512); S.A = (const char*)x1b; S.B = (const char*)((const bf16*)(ws + WS_W_EX_GU) + (size_t)L * 64 * 256 * D);
          S.tok = ltok; S.b_exp = (size_t)256 * D * 2; S.b_tile = 0; S.a_tile = 0; S.NU = NT; S.G = F.G; S.c = c;
          g8::EpiExpertGU E{HB}; g8::gemm_phase<g8::EpiExpertGU, g8::ExpertSched<1, true>, true>(ring, F.tid, D, D, D, S, E); }
        { const int rot = (c - (NT % F.G) + F.G) % F.G;
          g8::DenseSched S; S.init(x1b, (const bf16*)(ws + WS_W_SH_GU) + (size_t)L * 512 * D, T, 512, D, D, F.G, rot);
          int t2 = F.tid; asm volatile("" : "+v"(t2));
          g8::EpiSharedGU E{HS}; g8::gemm_phase<g8::EpiSharedGU, g8::DenseSched, false>(ring, t2, D, D, D, S, E); } }
    if constexpr (PH == PH_MOE3) {
        const float* g1 = ain(kp, IN_LNG) + (size_t)(L * 2 + 0) * D; const float* b1 = ain(kp, IN_LNB) + (size_t)(L * 2 + 0) * D;
        const int NT = build_tiles(F, cnt);
        __syncthreads();
        phase_downproj3(F, HB, (const bf16*)(ws + WS_W_EX_D) + (size_t)L * 64 * D * EDIM, HS, (const bf16*)(ws + WS_W_SH_D) + (size_t)L * D * SDIM, (unsigned char*)Yr, (float*)(ws + WS_BIG + BG_YSC), NT + 2 * (T / 256));
        (void)g1; (void)b1; }
    if constexpr (PH == PH_MOE4) { (void)build_tiles(F, cnt);
        const float* g2 = ain(kp, IN_LNG) + (size_t)(L * 2 + 1) * D; const float* b2 = ain(kp, IN_LNB) + (size_t)(L * 2 + 1) * D;
        phase_moe4q(F, x1b, (bf16*)(ws + WS_Y2F), (const unsigned char*)Yr, (const float*)(ws + WS_BIG + BG_YSC), eidx, inv, g2, b2, (float*)(ws + WS_ST2), (bf16*)(ws + WS_XB), aout(kp), L == DEPTH - 1); }
}
__device__ __forceinline__ void make_frame(Frame& F, const Args& args) {
    extern __shared__ __attribute__((aligned(16))) unsigned char lds_raw[];
    F.lds = (LAS unsigned char*)lds_raw; F.ws = args.ws; F.ctl = (unsigned*)(args.ws + WS_CTL);
    F.tid = threadIdx.x; F.lane = F.tid & 63; F.wave = __builtin_amdgcn_readfirstlane(F.tid >> 6); F.G = gridDim.x; F.bid = blockIdx.x;
}
template <int PH> __global__ void __launch_bounds__(512, 2) k_phase(Args args, int L) {
    Frame F; make_frame(F, args);
    run_phase<PH>(F, args, L);
}

#ifndef MK_NOINLINE
#define MK_NOINLINE 0
#endif
#if MK_NOINLINE
template <int PH> __device__ __noinline__ void call_phase_ni(const int L) {
    Args dummy{}; Frame F;
    KP kp = (KP)__builtin_amdgcn_kernarg_segment_ptr();
    extern __shared__ __attribute__((aligned(16))) unsigned char lds_raw[];
    F.lds = (LAS unsigned char*)lds_raw; F.ws = (unsigned char*)((GAS unsigned char* const CAS*)kp)[20]; F.ctl = (unsigned*)(F.ws + WS_CTL);
    F.tid = threadIdx.x; F.lane = F.tid & 63; F.wave = __builtin_amdgcn_readfirstlane(F.tid >> 6); F.G = gridDim.x; F.bid = blockIdx.x;
    run_phase<PH>(F, dummy, L);
}
template <int PH> __device__ __forceinline__ void call_phase(const Frame& F, const Args& args, const int L) { call_phase_ni<PH>(L); }
#else
template <int PH> __device__ __forceinline__ void call_phase(const Frame& F, const Args& args, const int L) { asm volatile("; PHASE_BEGIN %0" :: "n"(PH)); run_phase<PH>(F, args, L); asm volatile("; PHASE_END %0" :: "n"(PH)); }
#endif
__global__ void __launch_bounds__(512, 2) fwd_all(Args args) {
    Frame F; make_frame(F, args);
    volatile LAS unsigned* misc = (volatile LAS unsigned*)(F.lds + LDS_MISC);
    if (F.tid < 4) misc[F.tid] = 0u;
    __syncthreads();
    const int lo = args.ph_lo, hi = args.ph_hi;
    XcdBarrier bar; bar.bar = F.ctl + CW_BAR; bar.x = 0; bar.st = misc;
    if (hi - lo > 1) bar = xcd_barrier_post(F.ctl + CW_BAR, misc);
    int pc = 0;
#ifndef MK_DUP_MASK
#define MK_DUP_MASK 0
#endif
#if MK_DUP_MASK
#define STEP(PH, Lx) do { if (pc >= lo && pc < hi) { int nrep_ = ((MK_DUP_MASK >> (PH)) & 1) ? 2 : 1; asm volatile("" : "+s"(nrep_)); _Pragma("unroll 1") for (int r_ = 0; r_ < nrep_; ++r_) { call_phase<PH>(F, args, Lx); if (r_ + 1 < nrep_ || pc + 1 < hi) xcd_barrier(bar); } } ++pc; } while (0)
#else
#define STEP(PH, Lx) do { if (pc >= lo && pc < hi) { call_phase<PH>(F, args, Lx); if (pc + 1 < hi) xcd_barrier(bar); } ++pc; } while (0)
#endif
    STEP(PH_PRO, 0);
#pragma unroll 1
    for (int L = 0; L < DEPTH; ++L) {
        const int kind = L % 3;
        if (kind == 0) { STEP(PH_POOL_G1, L); STEP(PH_POOL_P, L); STEP(PH_POOL_G2, L); STEP(PH_POOL_G3, L); }
        else if (kind == 1) { STEP(PH_DIL_G1, L); STEP(PH_DIL_ATT, L); STEP(PH_DIL_CMB, L); STEP(PH_DIL_G2, L); }
        else { STEP(PH_CONV_G1, L); STEP(PH_CONV_E, L); STEP(PH_CONV_G2, L); }
        STEP(PH_MOE1, L); STEP(PH_MOE2, L); STEP(PH_MOE3, L); STEP(PH_MOE4, L);
    }
#undef STEP
}
constexpr int N_STEPS = 1 + 2 * 8 + 8 + 7;

template <int PH> static void launch_phase(const Args& a, int L, int grid, hipStream_t stream) {
    static bool attr = false;
    if (!attr) { (void)hipFuncSetAttribute((const void*)k_phase<PH>, hipFuncAttributeMaxDynamicSharedMemorySize, LDS_BYTES); attr = true; }
    hipLaunchKernelGGL(k_phase<PH>, dim3(grid), dim3(512), LDS_BYTES, stream, a, L);
}
extern "C" void kernel_launch(void* const* d_in, const int* in_sizes, int n_in, void* d_out, int out_size, void* d_ws, size_t ws_size, hipStream_t stream) {
    static int grid = 0;
    if (grid == 0) {
        if (n_in != 19 || out_size != T * D || ws_size < WS_END) { fprintf(stderr, "kernel_launch: unexpected shapes (n_in %d out %d ws %zu need %zu)\n", n_in, out_size, ws_size, (size_t)WS_END); grid = -1; return; }
        int dev = 0, cus = 0;
        if (hipGetDevice(&dev) != hipSuccess || hipDeviceGetAttribute(&cus, hipDeviceAttributeMultiprocessorCount, dev) != hipSuccess) { grid = -1; return; }
#if MK_ONE_LAUNCH
        if (hipFuncSetAttribute((const void*)fwd_all, hipFuncAttributeMaxDynamicSharedMemorySize, LDS_BYTES) != hipSuccess) { fprintf(stderr, "kernel_launch: hipFuncSetAttribute failed\n"); grid = -1; return; }
        int per_cu = 0;
        if (hipOccupancyMaxActiveBlocksPerMultiprocessor(&per_cu, (const void*)fwd_all, 512, LDS_BYTES) != hipSuccess || per_cu < 1) { fprintf(stderr, "kernel_launch: note: occupancy query reports %d blocks per CU\n", per_cu); (void)hipGetLastError(); }
#endif
        grid = cus;
    }
    if (grid < 0) return;
    (void)hipMemsetAsync((char*)d_ws + WS_CTL, 0, CTL_ZERO_BYTES, stream);
    Args a{};
    for (int i = 0; i < 19; ++i) a.in[i] = (const float*)d_in[i];
    a.out = (float*)d_out; a.ws = (unsigned char*)d_ws; a.ph_lo = 0; a.ph_hi = 0;
#if MK_ONE_LAUNCH
#ifdef MK_SPLIT
    for (int p = 0; p < N_STEPS; ++p) { a.ph_lo = p; a.ph_hi = p + 1; hipLaunchKernelGGL(fwd_all, dim3(grid), dim3(512), LDS_BYTES, stream, a); }
#else
    a.ph_lo = 0; a.ph_hi = N_STEPS;
    hipLaunchKernelGGL(fwd_all, dim3(grid), dim3(512), LDS_BYTES, stream, a);
#endif
#elif defined(MK_HYBRID_MASK)
    {
        static bool attr2 = false; if (!attr2) { (void)hipFuncSetAttribute((const void*)fwd_all, hipFuncAttributeMaxDynamicSharedMemorySize, LDS_BYTES); attr2 = true; }
        int pc = 0;
#define HSTEP(PH, Lx) do { if ((MK_HYBRID_MASK >> (PH)) & 1) { a.ph_lo = pc; a.ph_hi = pc + 1; hipLaunchKernelGGL(fwd_all, dim3(grid), dim3(512), LDS_BYTES, stream, a); } else { a.ph_lo = 0; a.ph_hi = 0; launch_phase<PH>(a, Lx, grid, stream); } ++pc; } while (0)
        HSTEP(PH_PRO, 0);
        for (int L = 0; L < DEPTH; ++L) {
            const int kind = L % 3;
            if (kind == 0) { HSTEP(PH_POOL_G1, L); HSTEP(PH_POOL_P, L); HSTEP(PH_POOL_G2, L); HSTEP(PH_POOL_G3, L); }
            else if (kind == 1) { HSTEP(PH_DIL_G1, L); HSTEP(PH_DIL_ATT, L); HSTEP(PH_DIL_CMB, L); HSTEP(PH_DIL_G2, L); }
            else { HSTEP(PH_CONV_G1, L); HSTEP(PH_CONV_E, L); HSTEP(PH_CONV_G2, L); }
            HSTEP(PH_MOE1, L); HSTEP(PH_MOE2, L); HSTEP(PH_MOE3, L); HSTEP(PH_MOE4, L);
        }
#undef HSTEP
    }
#else
    launch_phase<PH_PRO>(a, 0, grid, stream);
    for (int L = 0; L < DEPTH; ++L) {
        const int kind = L % 3;
        if (kind == 0) { launch_phase<PH_POOL_G1>(a, L, grid, stream); launch_phase<PH_POOL_P>(a, L, grid, stream); launch_phase<PH_POOL_G2>(a, L, grid, stream); launch_phase<PH_POOL_G3>(a, L, grid, stream); }
        else if (kind == 1) { launch_phase<PH_DIL_G1>(a, L, grid, stream); launch_phase<PH_DIL_ATT>(a, L, grid, stream); launch_phase<PH_DIL_CMB>(a, L, grid, stream); launch_phase<PH_DIL_G2>(a, L, grid, stream); }
        else { launch_phase<PH_CONV_G1>(a, L, grid, stream); launch_phase<PH_CONV_E>(a, L, grid, stream); launch_phase<PH_CONV_G2>(a, L, grid, stream); }
        launch_phase<PH_MOE1>(a, L, grid, stream); launch_phase<PH_MOE2>(a, L, grid, stream); launch_phase<PH_MOE3>(a, L, grid, stream); launch_phase<PH_MOE4>(a, L, grid, stream);
    }
#endif
}
```

```cpp
#include <hip/hip_runtime.h>
#include <cstdio>
#include <cstdint>

#ifndef MK_ONE_LAUNCH
#define MK_ONE_LAUNCH 1
#endif

#define GAS __attribute__((address_space(1)))
#define LAS __attribute__((address_space(3)))
typedef unsigned short bf16;
typedef unsigned v4u __attribute__((ext_vector_type(4)));
typedef unsigned v2u __attribute__((ext_vector_type(2)));
typedef float f32x4 __attribute__((ext_vector_type(4)));
typedef float f32x2 __attribute__((ext_vector_type(2)));
typedef short bf16x8 __attribute__((ext_vector_type(8)));
typedef short s16x4 __attribute__((ext_vector_type(4)));

constexpr int NBATCH = 8, SEQ = 2048, D = 2048, T = NBATCH * SEQ, DEPTH = 4;
constexpr int NEXP = 64, TOPK = 8, EDIM = 128, SDIM = 256;
constexpr int QKVC = 4608, DILW = 512;
constexpr float ALPHA = 1.681792830507429f;
constexpr float LN_EPS = 1e-5f;
constexpr int CAP = 16384;
constexpr int HROWS = T * TOPK + NEXP * 256;

constexpr size_t MiB = 1u << 20;
constexpr size_t WS_CTL = 0, CTL_ZERO_BYTES = 1 * MiB;
constexpr size_t WS_W_POOL_IN = 1 * MiB;
constexpr size_t WS_W_POOL_G = WS_W_POOL_IN + 16 * MiB;
constexpr size_t WS_W_POOL_OUT = WS_W_POOL_G + 4 * MiB;
constexpr size_t WS_W_DIL_QKV = WS_W_POOL_OUT + 16 * MiB;
constexpr size_t WS_W_DIL_OUT = WS_W_DIL_QKV + 18 * MiB;
constexpr size_t WS_W_CONV_IN = WS_W_DIL_OUT + 2 * MiB;
constexpr size_t WS_W_CONV_OUT = WS_W_CONV_IN + 24 * MiB;
constexpr size_t WS_W_SH_GU = WS_W_CONV_OUT + 8 * MiB;
constexpr size_t WS_W_SH_D = WS_W_SH_GU + 8 * MiB;
constexpr size_t WS_W_EX_GU = WS_W_SH_D + 4 * MiB;
constexpr size_t WS_W_EX_D = WS_W_EX_GU + 256 * MiB;
constexpr size_t WS_XF = WS_W_EX_D + 256 * MiB;
constexpr size_t WS_YF = WS_XF + 128 * MiB;
constexpr size_t WS_X1F = WS_YF + 128 * MiB;
constexpr size_t WS_XB = WS_X1F + 128 * MiB;
constexpr size_t WS_X1B = WS_XB + 64 * MiB;
constexpr size_t WS_HB = WS_X1B + 64 * MiB;
constexpr size_t WS_HS = WS_HB + 72 * MiB;
constexpr size_t WS_LTOK = WS_HS + 8 * MiB;
constexpr size_t WS_LGATE = WS_LTOK + 4 * MiB;
constexpr size_t WS_EIDX = WS_LGATE + 4 * MiB;
constexpr size_t WS_INV = WS_EIDX + 1 * MiB;
constexpr size_t WS_BIG = WS_INV + 1 * MiB;
constexpr size_t WS_PST = WS_BIG + 608 * MiB;
constexpr size_t WS_ST1 = WS_PST + 4 * MiB;
constexpr size_t WS_ST2 = WS_ST1 + 1 * MiB;
constexpr size_t WS_RWH = WS_ST2 + 1 * MiB;
constexpr size_t WS_RWL = WS_RWH + 1 * MiB;
constexpr size_t WS_PST2 = WS_RWL + 1 * MiB;
constexpr size_t WS_END = WS_PST2 + 8 * MiB;
constexpr size_t WS_Y2F = WS_X1F;
constexpr size_t BG_U = 0, BG_PL = 64 * MiB, BG_MX = 128 * MiB;
constexpr size_t BG_QKV = 0, BG_OG = 144 * MiB, BG_LSE = 192 * MiB, BG_O = 194 * MiB;
constexpr size_t BG_UC = 0, BG_BG = 64 * MiB, BG_Z = 128 * MiB;
constexpr size_t BG_YSC = 400 * MiB;
constexpr int CW_BAR = 4096;
constexpr int CW_CNT = 16384;

constexpr int RING_BYTES = 131072;
constexpr int LDS_TAB = RING_BYTES;
constexpr int LDS_STASH = RING_BYTES + 1024;
constexpr int LDS_BYTES = 163840;
constexpr int LDS_MISC = LDS_BYTES - 1024;

typedef __bf16 bf16x2_t __attribute__((ext_vector_type(2)));
typedef float f32x2_t __attribute__((ext_vector_type(2)));
__device__ __forceinline__ unsigned cvt_pk_bf16(float lo, float hi) { const bf16x2_t r = __builtin_convertvector((f32x2_t){lo, hi}, bf16x2_t); return __builtin_bit_cast(unsigned, r); }
__device__ __forceinline__ unsigned f2bf(float f) { unsigned u = __builtin_bit_cast(unsigned, f); return (u + 0x7fffu + ((u >> 16) & 1u)) >> 16; }
__device__ __forceinline__ unsigned pk2(float lo, float hi) { return f2bf(lo) | (f2bf(hi) << 16); }
__device__ __forceinline__ float bflo(unsigned w) { return __builtin_bit_cast(float, w << 16); }
__device__ __forceinline__ float bfhi(unsigned w) { return __builtin_bit_cast(float, w & 0xffff0000u); }
__device__ __forceinline__ float shfl_from(float v, int src) { return __builtin_bit_cast(float, __builtin_amdgcn_ds_bpermute(src << 2, __builtin_bit_cast(int, v))); }
__device__ __forceinline__ float shfl_x(float v, int o, int lane) { return shfl_from(v, lane ^ o); }
__device__ __forceinline__ float wave_sum(float v, int lane) {
#pragma unroll
    for (int o = 1; o < 64; o <<= 1) v += shfl_x(v, o, lane);
    return v;
}
#define LDS_WAIT() asm volatile("s_waitcnt lgkmcnt(0)" ::: "memory")
#define VM_WAIT() asm volatile("s_waitcnt vmcnt(0)" ::: "memory")

#define XB_TMO      128
#define XB_XCNT(j)  (256  + 64 * (j))
#define XB_XSUB(j)  (1280 + 64 * (j))
#define XB_XGEN(j)  (2304 + 64 * (j))
#define XB_TOP      3328
#define XB_TOPGEN   3392
#define XCD_BAR_WORDS 3456
#define XB_SPIN_CAP (1u << 18)

__device__ __forceinline__ unsigned xb_ld(unsigned* p)              { return __hip_atomic_load(p, __ATOMIC_RELAXED, __HIP_MEMORY_SCOPE_AGENT); }
__device__ __forceinline__ unsigned xb_add(unsigned* p, unsigned v) { return __hip_atomic_fetch_add(p, v, __ATOMIC_RELAXED, __HIP_MEMORY_SCOPE_AGENT); }
__device__ __forceinline__ unsigned xb_xcc_id() { return (unsigned)__builtin_amdgcn_s_getreg((3 << 11) | 20) & 0xFu; }
#define XB_SPIN(cond, bar) do { unsigned _sp = 0; while (cond) { __builtin_amdgcn_s_sleep(1); \
    if ((++_sp & 255u) == 0u) { if (xb_ld(&(bar)[XB_TMO])) break; if (_sp > XB_SPIN_CAP) { atomicAdd(&(bar)[XB_TMO], 1u); break; } } } } while (0)

struct XcdBarrier {
    unsigned* bar; unsigned x;
    volatile LAS unsigned* st;
};

__device__ __forceinline__ XcdBarrier xcd_barrier_post(unsigned* bar, volatile LAS unsigned* st) {
    XcdBarrier b; b.bar = bar; b.x = xb_xcc_id(); b.st = st;
    if (threadIdx.x == 0) (void)xb_add(&bar[XB_XCNT(b.x)], 1u);
    return b;
}
__device__ __forceinline__ void xcd_barrier_complete(unsigned* bar, unsigned x, unsigned& nloc, unsigned& nx) {
    const unsigned G = gridDim.x * gridDim.y * gridDim.z;
    unsigned sum, cnt, mine, sp = 0u;
    for (;;) {
        sum = 0u; cnt = 0u; mine = 0u;
#pragma unroll
        for (unsigned j = 0; j < 16; ++j) { const unsigned c = xb_ld(&bar[XB_XCNT(j)]); sum += c; cnt += (c > 0u) ? 1u : 0u; mine = (j == x) ? c : mine; }
        if (sum == G) break;
        __builtin_amdgcn_s_sleep(1);
        if ((++sp & 255u) == 0u) { if (xb_ld(&bar[XB_TMO])) break; if (sp > XB_SPIN_CAP) { atomicAdd(&bar[XB_TMO], 1u); break; } }
    }
    nloc = mine > 0u ? mine : 1u; nx = cnt > 0u ? cnt : 1u;
}

__device__ __forceinline__ void xcd_barrier(const XcdBarrier& b) {
    asm volatile("s_waitcnt vmcnt(0)" ::: "memory");
    __syncthreads();
    if (threadIdx.x == 0) {
        unsigned* bar; unsigned bx = b.x; { GAS unsigned* bg = (GAS unsigned*)b.bar; asm volatile("" : "+s"(bg), "+s"(bx)); bar = (unsigned*)bg; }
        __builtin_amdgcn_s_waitcnt(0);
        unsigned nloc = b.st[0], nx = b.st[1];
        if (nloc == 0u) { xcd_barrier_complete(bar, bx, nloc, nx); b.st[0] = nloc; b.st[1] = nx; }
        const unsigned old = xb_add(&bar[XB_XSUB(bx)], 1u);
        const unsigned gen = old / nloc;
        if (old + 1u == (gen + 1u) * nloc) {
            __builtin_amdgcn_fence(__ATOMIC_RELEASE, "agent");
            asm volatile("s_waitcnt vmcnt(0)" ::: "memory");
            const unsigned og = xb_add(&bar[XB_TOP], 1u);
            const unsigned tg = og / nx;
            if (og + 1u == (tg + 1u) * nx) xb_add(&bar[XB_TOPGEN], 1u);
            else XB_SPIN(xb_ld(&bar[XB_TOPGEN]) == tg, bar);
            __builtin_amdgcn_fence(__ATOMIC_ACQUIRE, "agent");
            xb_add(&bar[XB_XGEN(bx)], 1u);
            asm volatile("s_waitcnt vmcnt(0)" ::: "memory");
        } else {
            XB_SPIN(xb_ld(&bar[XB_XGEN(bx)]) == gen, bar);
            __builtin_amdgcn_fence(__ATOMIC_ACQUIRE, "agent");
            asm volatile("s_waitcnt vmcnt(0)" ::: "memory");
        }
    }
    __syncthreads();
}

namespace g8 {
constexpr int BM = 256, BK = 64, HALF = 128, HTB = HALF * BK * 2, STAGE_BYTES = 8 * HTB, NXCD = 8, WGM = 8;
__host__ __device__ __forceinline__ int lds_byte(int r, int c) { const int st = (r >> 4) * 2 + (c >> 5), rr = r & 15, cc = c & 31, ob = rr * 64 + cc * 2; return st * 1024 + (ob ^ (((ob >> 9) & 1) << 5)); }
__host__ __device__ __forceinline__ void stage_rc(int b, int& R, int& C) { const int st = b / 1024, sb = b % 1024, swz = sb ^ (((sb >> 9) & 1) << 5); R = (st >> 1) * 16 + swz / 64; C = (st & 1) * 32 + (swz % 64) / 2; }
__host__ __device__ __forceinline__ int perm32(int rho) { const int n = rho >> 4, i = rho & 15; return 8 * (i >> 2) + 4 * n + (i & 3); }

struct Unit { const char* A; const char* B; const int* rows; int pm, pn, nvalid, aux; };

template <class Epi, class Sched, bool GATHER>
__device__ __forceinline__ void gemm_phase(LAS unsigned char* lds, const int tid_in, const int K, const int lda, const int ldb, const Sched& S, const Epi& E) {
    const int tid = tid_in, wid = __builtin_amdgcn_readfirstlane(tid >> 6), lane = tid & 63, wr = wid >> 2, wc = wid & 3, fr = lane & 15, fq = lane >> 4;
    const int nt = K / BK;
    unsigned voffB[2];
#pragma unroll
    for (int i = 0; i < 2; ++i) { int R_, C_; stage_rc(tid * 16 + i * 8192, R_, C_); const int Rb = Epi::PERM ? ((R_ & ~31) + perm32(R_ & 31)) : R_; voffB[i] = (unsigned)(Rb * ldb + C_) * 2u; }
    LAS v4u* stash = (LAS v4u*)(lds + (LDS_STASH - 0) + tid * 16);
    const size_t kstep = (size_t)(BK * 2);
    const size_t hstepB = (size_t)HALF * ldb * 2;
    const unsigned ldsw = (unsigned)wid * 1024u;
    const int aoff = lds_byte(wr * 64 + fr, fq * 8), boff = lds_byte(wc * 32 + fr, fq * 8);
#define G8_SA(b, h) (((b) * 2 + (h)) * HTB)
#define G8_SB(b, h) ((4 + (b) * 2 + (h)) * HTB)
#define G8_STAGE2(bufoff, gbase, v0, v1) do { \
        __builtin_amdgcn_global_load_lds((const unsigned*)((const char*)(gbase) + (v0)), (LAS unsigned*)(lds + (bufoff) + ldsw), 16, 0, 0); \
        __builtin_amdgcn_global_load_lds((const unsigned*)((const char*)(gbase) + (v1)), (LAS unsigned*)(lds + (bufoff) + ldsw + 8192), 16, 0, 0); } while (0)
#define G8_STAGEB(bufoff, gbase) G8_STAGE2(bufoff, gbase, voffB[0], voffB[1])
#define G8_LDA(dst, b, h) do { _Pragma("unroll") for (int m = 0; m < 4; ++m) _Pragma("unroll") for (int k = 0; k < 2; ++k) dst[m][k] = *(const LAS bf16x8*)(lds + G8_SA(b, h) + aoff + m * 2048 + k * 1024); } while (0)
#define G8_LDB(dst, b, h) do { _Pragma("unroll") for (int n = 0; n < 2; ++n) _Pragma("unroll") for (int k = 0; k < 2; ++k) dst[n][k] = *(const LAS bf16x8*)(lds + G8_SB(b, h) + boff + n * 2048 + k * 1024); } while (0)
#define G8_MMA(ai, bj, At, Bt) do { __builtin_amdgcn_s_setprio(1); _Pragma("unroll") for (int m = 0; m < 4; ++m) _Pragma("unroll") for (int n = 0; n < 2; ++n) _Pragma("unroll") for (int k = 0; k < 2; ++k) \
        acc[ai][bj][m][n] = __builtin_amdgcn_mfma_f32_16x16x32_bf16(Bt[n][k], At[m][k], acc[ai][bj][m][n], 0, 0, 0); __builtin_amdgcn_s_setprio(0); } while (0)
#define G8_WAIT_V(n) asm volatile("s_waitcnt vmcnt(" #n ")" ::: "memory")
#define G8_WAIT_L(n) asm volatile("s_waitcnt lgkmcnt(" #n ")" ::: "memory")
#define G8_BAR __builtin_amdgcn_s_barrier()
#define G8_SCHED __builtin_amdgcn_sched_barrier(0)
#define G8_SETVA(dst, u) do { int _t2 = tid; if (GATHER) asm volatile("" : "+v"(_t2)); _Pragma("unroll") for (int _h = 0; _h < 2; ++_h) _Pragma("unroll") for (int _i = 0; _i < 2; ++_i) { \
        int _R, _C; stage_rc(_t2 * 16 + _i * 8192, _R, _C); \
        const unsigned _rl = (unsigned)(_h * HALF + _R); unsigned _row = _rl; \
        if (GATHER) { _row = 0u; if (_rl < (unsigned)(u).nvalid) _row = (unsigned)(u).rows[_rl] >> 3; } \
        dst[_h][_i] = (_row * (unsigned)lda + (unsigned)_C) * 2u; } } while (0)
    Unit cur, nxt; int ui = 0;
    if (!S.next(0, cur)) return;
    f32x4 acc[2][2][4][2];
#pragma unroll
    for (int a = 0; a < 2; ++a)
#pragma unroll
        for (int b = 0; b < 2; ++b)
#pragma unroll
            for (int m = 0; m < 4; ++m)
#pragma unroll
                for (int n = 0; n < 2; ++n) acc[a][b][m][n] = (f32x4){0.f, 0.f, 0.f, 0.f};
    bf16x8 At[4][2], B0[2][2], B1[2][2];
    unsigned vAc[2][2]; unsigned xl00 = 0, xl01 = 0, xl10 = 0, xl11 = 0;
    G8_SETVA(vAc, cur);
    const char* cA = cur.A; const char* cB = cur.B;
    G8_STAGEB(G8_SB(0, 0), cB); G8_STAGEB(G8_SB(0, 1), cB + hstepB); G8_STAGE2(G8_SA(0, 0), cA, vAc[0][0], vAc[0][1]); G8_STAGE2(G8_SA(0, 1), cA, vAc[1][0], vAc[1][1]);
    if (wr == 1) G8_BAR;
    G8_WAIT_V(2); G8_BAR;
    G8_STAGEB(G8_SB(1, 0), cB + kstep); G8_STAGE2(G8_SA(1, 0), cA + kstep, vAc[0][0], vAc[0][1]); G8_STAGEB(G8_SB(1, 1), cB + hstepB + kstep);
    G8_WAIT_V(6); G8_BAR;
    for (;;) {
        const bool has_next = S.next(ui + 1, nxt);
        const char* nA = has_next ? nxt.A : cA; const char* nB = has_next ? nxt.B : cB;
        if (GATHER) { unsigned vAn[2][2]; if (has_next) { G8_SETVA(vAn, nxt); } else {
#pragma unroll
            for (int h = 0; h < 2; ++h)
#pragma unroll
                for (int i = 0; i < 2; ++i) vAn[h][i] = vAc[h][i]; }
            *stash = (v4u){vAn[0][0], vAn[0][1], vAn[1][0], vAn[1][1]}; }
#pragma unroll 1
        for (int t = 0; t < nt; t += 2) {
            const bool last = (t == nt - 2);
            const char* a1 = cA + (size_t)(t + 1) * kstep;
            const char* a2 = last ? nA : cA + (size_t)(t + 2) * kstep; const char* b2 = last ? nB : cB + (size_t)(t + 2) * kstep;
            const char* a3 = a2 + kstep; const char* b3 = b2 + kstep;
            unsigned x00 = vAc[0][0], x01 = vAc[0][1], x10 = vAc[1][0], x11 = vAc[1][1];
            if (GATHER) { if (last) { const v4u sv = *stash; x00 = sv.x; x01 = sv.y; x10 = sv.z; x11 = sv.w; } xl00 = x00; xl01 = x01; xl10 = x10; xl11 = x11; }
            G8_LDB(B0, 0, 0); G8_LDB(B1, 0, 1); G8_SCHED; G8_LDA(At, 0, 0); G8_STAGE2(G8_SA(1, 1), a1, vAc[1][0], vAc[1][1]);
            G8_WAIT_V(8); G8_WAIT_L(0); G8_BAR; G8_MMA(0, 0, At, B0); G8_MMA(0, 1, At, B1); G8_BAR; G8_SCHED;
            G8_LDA(At, 0, 1); G8_STAGEB(G8_SB(0, 0), b2); G8_STAGEB(G8_SB(0, 1), b2 + hstepB); G8_STAGE2(G8_SA(0, 0), a2, x00, x01);
            G8_WAIT_V(8); G8_WAIT_L(0); G8_BAR; G8_MMA(1, 0, At, B0); G8_MMA(1, 1, At, B1); G8_BAR; G8_SCHED;
            G8_LDB(B0, 1, 0); G8_LDB(B1, 1, 1); G8_SCHED; G8_LDA(At, 1, 0); G8_STAGE2(G8_SA(0, 1), a2, x10, x11);
            G8_WAIT_V(8); G8_WAIT_L(0); G8_BAR; G8_MMA(0, 0, At, B0); G8_MMA(0, 1, At, B1); G8_BAR; G8_SCHED;
            G8_LDA(At, 1, 1); G8_STAGEB(G8_SB(1, 0), b3); G8_STAGEB(G8_SB(1, 1), b3 + hstepB); G8_STAGE2(G8_SA(1, 0), a3, x00, x01);
            G8_WAIT_V(8); G8_WAIT_L(0); G8_BAR; G8_MMA(1, 0, At, B0); G8_MMA(1, 1, At, B1); G8_BAR; G8_SCHED;
        }
        if (wr == 0) G8_BAR;
        E(acc, cur, wr, wc, fr, fq);
        if (!has_next) break;
#pragma unroll
        for (int a = 0; a < 2; ++a)
#pragma unroll
            for (int b = 0; b < 2; ++b)
#pragma unroll
                for (int m = 0; m < 4; ++m)
#pragma unroll
                    for (int n = 0; n < 2; ++n) acc[a][b][m][n] = (f32x4){0.f, 0.f, 0.f, 0.f};
        cur = nxt; cA = nA; cB = nB; ++ui;
        if (GATHER) { vAc[0][0] = xl00; vAc[0][1] = xl01; vAc[1][0] = xl10; vAc[1][1] = xl11; }
        if (wr == 1) G8_BAR;
    }
    G8_WAIT_V(0);
    G8_BAR;
#undef G8_SA
#undef G8_SB
#undef G8_STAGE2
#undef G8_STAGEB
#undef G8_LDA
#undef G8_LDB
#undef G8_MMA
#undef G8_WAIT_V
#undef G8_WAIT_L
#undef G8_BAR
#undef G8_SCHED
#undef G8_SETVA
}

struct DenseSched {
    const char* A; const char* B; size_t a_tile, b_tile, agrp_stride; int agrp_shift, nM, nN, nwg, G, c;
    __device__ __forceinline__ void init(const void* A_, const void* B_, int M, int N, int lda, int ldb, int G_, int c_) {
        A = (const char*)A_; B = (const char*)B_; a_tile = (size_t)BM * lda * 2; b_tile = (size_t)BM * ldb * 2; agrp_stride = 0; agrp_shift = 0; nM = M / BM; nN = N / BM; nwg = nM * nN; G = G_; c = c_; }
    __device__ __forceinline__ bool next(int i, Unit& u) const {
        const long L = (long)i * G + c; if (L >= nwg) return false;
        int wgid = (int)L; { const int q = nwg / NXCD, r = nwg % NXCD, xcd = wgid % NXCD, off = wgid / NXCD; wgid = (xcd < r ? xcd * (q + 1) : r * (q + 1) + (xcd - r) * q) + off; }
        const int nig = WGM * nN, gid = wgid / nig, fm = gid * WGM, gsz = (nM - fm) < WGM ? (nM - fm) : WGM;
        u.pm = fm + ((wgid % nig) % gsz); u.pn = (wgid % nig) / gsz;
        u.A = A + (size_t)u.pm * a_tile + (size_t)(u.pn >> agrp_shift) * agrp_stride; u.B = B + (size_t)u.pn * b_tile; u.rows = nullptr; u.nvalid = BM; u.aux = 0; return true;
    }
};
template <int NPN, bool GATHERED>
struct ExpertSched {
    const LAS int* tpref; const LAS int* cnt; const char* A; const char* B; const int* tok; size_t b_exp, b_tile, a_tile; int NU, G, c;
    __device__ __forceinline__ bool next(int i, Unit& u) const {
        int L = i * G + c; if (L >= NU) return false;
        if ((i + 1) * G <= NU && (G % NXCD) == 0) L = i * G + (c % NXCD) * (G / NXCD) + c / NXCD;
        const int tile = L / NPN, pn = L % NPN;
        int e = 0; while (__builtin_amdgcn_readfirstlane(tpref[e + 1]) <= tile) ++e;
        const int rb = tile - __builtin_amdgcn_readfirstlane(tpref[e]);
        u.pm = e; u.pn = pn; u.aux = tile * BM; u.nvalid = __builtin_amdgcn_readfirstlane(cnt[e]) - rb * BM; if (u.nvalid > BM) u.nvalid = BM;
        u.rows = tok + (size_t)e * CAP + rb * BM;
        u.A = GATHERED ? A : A + (size_t)tile * a_tile; u.B = B + (size_t)e * b_exp + (size_t)pn * b_tile; return true;
    }
};

struct EpiBf16 {
    static constexpr bool PERM = true;
    bf16* O; int ldc; int qscale;
    __device__ __forceinline__ void operator()(const f32x4 (&acc)[2][2][4][2], const Unit& u, int wr, int wc, int fr, int fq) const {
        asm volatile("" : "+v"(fr), "+v"(fq));
        const int row0 = u.pm * BM + wr * 64 + fr, col0 = u.pn * BM + wc * 32 + 8 * fq;
        const float sc = (qscale && (u.pn % 6) < 2) ? 0.125f : 1.0f;
#pragma unroll
        for (int ai = 0; ai < 2; ++ai)
#pragma unroll
            for (int m = 0; m < 4; ++m) { bf16* rowp = O + (size_t)(row0 + ai * HALF + m * 16) * ldc + col0;
#pragma unroll
                for (int bj = 0; bj < 2; ++bj) { const f32x4 v0 = acc[ai][bj][m][0] * sc, v1 = acc[ai][bj][m][1] * sc;
                    v4u w; w.x = cvt_pk_bf16(v0[0], v0[1]); w.y = cvt_pk_bf16(v0[2], v0[3]); w.z = cvt_pk_bf16(v1[0], v1[1]); w.w = cvt_pk_bf16(v1[2], v1[3]);
                    *(v4u*)(rowp + bj * HALF) = w; } }
    }
};
struct EpiScaleBf16 {
    static constexpr bool PERM = true;
    bf16* O; int ldc; const float* scale;
    __device__ __forceinline__ void operator()(const f32x4 (&acc)[2][2][4][2], const Unit& u, int wr, int wc, int fr, int fq) const {
        asm volatile("" : "+v"(fr), "+v"(fq));
        const int row0 = u.pm * BM + wr * 64 + fr, col0 = u.pn * BM + wc * 32 + 8 * fq;
        f32x4 sv[2][2];
#pragma unroll
        for (int bj = 0; bj < 2; ++bj)
#pragma unroll
            for (int n = 0; n < 2; ++n) sv[bj][n] = *(const f32x4*)(scale + col0 + bj * HALF + 4 * n);
#pragma unroll
        for (int ai = 0; ai < 2; ++ai)
#pragma unroll
            for (int m = 0; m < 4; ++m) { bf16* rowp = O + (size_t)(row0 + ai * HALF + m * 16) * ldc + col0;
#pragma unroll
                for (int bj = 0; bj < 2; ++bj) { const f32x4 v0 = acc[ai][bj][m][0] * sv[bj][0], v1 = acc[ai][bj][m][1] * sv[bj][1];
                    v4u w; w.x = cvt_pk_bf16(v0[0], v0[1]); w.y = cvt_pk_bf16(v0[2], v0[3]); w.z = cvt_pk_bf16(v1[0], v1[1]); w.w = cvt_pk_bf16(v1[2], v1[3]);
                    *(v4u*)(rowp + bj * HALF) = w; } }
    }
};
struct EpiResid {
    static constexpr bool PERM = false;
    const float* X; float* Y;
    __device__ __forceinline__ void operator()(const f32x4 (&acc)[2][2][4][2], const Unit& u, int wr, int wc, int fr, int fq) const {
        asm volatile("" : "+v"(fr), "+v"(fq));
        const int row0 = u.pm * BM + wr * 64 + fr, col0 = u.pn * BM + wc * 32 + 4 * fq;
#pragma unroll
        for (int ai = 0; ai < 2; ++ai)
#pragma unroll
            for (int m = 0; m < 4; ++m) { const size_t off = (size_t)(row0 + ai * HALF + m * 16) * D + col0;
#pragma unroll
                for (int bj = 0; bj < 2; ++bj)
#pragma unroll
                    for (int n = 0; n < 2; ++n) { const f32x4 xv = *(const f32x4*)(X + off + bj * HALF + n * 16); *(f32x4*)(Y + off + bj * HALF + n * 16) = xv * ALPHA + acc[ai][bj][m][n]; } }
    }
};
struct EpiResidLN {
    static constexpr bool PERM = true;
    const float* X32; const bf16* Xb; const float* st; const float* g; const float* b; bf16* Y; float* pst; int mode;
    __device__ __forceinline__ void operator()(const f32x4 (&acc)[2][2][4][2], const Unit& u, int wr, int wc, int fr, int fq) const {
        asm volatile("" : "+v"(fr), "+v"(fq));
        const int row0 = u.pm * BM + wr * 64 + fr, col0 = u.pn * BM + wc * 32 + 8 * fq, lane = fq * 16 + fr;
#pragma unroll
        for (int ai = 0; ai < 2; ++ai)
#pragma unroll
            for (int m = 0; m < 4; ++m) { const int row = row0 + ai * HALF + m * 16; const size_t off = (size_t)row * D + col0;
                float mean = 0.f, rstd = 1.f; if (mode == 1) { const f32x2 sv = *(const f32x2*)(st + 2 * row); mean = sv.x; rstd = sv.y; }
                float sm = 0.f, sq = 0.f;
#pragma unroll
                for (int bj = 0; bj < 2; ++bj) { f32x4 x0, x1;
                    if (mode == 2) { const v4u xv = *(const v4u*)(Xb + off + bj * HALF); x0 = (f32x4){bflo(xv.x), bfhi(xv.x), bflo(xv.y), bfhi(xv.y)}; x1 = (f32x4){bflo(xv.z), bfhi(xv.z), bflo(xv.w), bfhi(xv.w)}; }
                    else if (mode) { const v4u xv = *(const v4u*)(Xb + off + bj * HALF);
                        const f32x4 g0 = *(const f32x4*)(g + col0 + bj * HALF), g1 = *(const f32x4*)(g + col0 + bj * HALF + 4), b0 = *(const f32x4*)(b + col0 + bj * HALF), b1 = *(const f32x4*)(b + col0 + bj * HALF + 4);
                        x0 = ((f32x4){bflo(xv.x), bfhi(xv.x), bflo(xv.y), bfhi(xv.y)} - mean) * rstd * g0 + b0; x1 = ((f32x4){bflo(xv.z), bfhi(xv.z), bflo(xv.w), bfhi(xv.w)} - mean) * rstd * g1 + b1; }
                    else { x0 = *(const f32x4*)(X32 + off + bj * HALF); x1 = *(const f32x4*)(X32 + off + bj * HALF + 4); }
                    const f32x4 y0 = x0 * ALPHA + acc[ai][bj][m][0], y1 = x1 * ALPHA + acc[ai][bj][m][1];
                    v4u w; w.x = cvt_pk_bf16(y0[0], y0[1]); w.y = cvt_pk_bf16(y0[2], y0[3]); w.z = cvt_pk_bf16(y1[0], y1[1]); w.w = cvt_pk_bf16(y1[2], y1[3]);
                    *(v4u*)(Y + off + bj * HALF) = w;
                    sm += ((y0[0] + y0[1]) + (y0[2] + y0[3])) + ((y1[0] + y1[1]) + (y1[2] + y1[3]));
                    sq += ((y0[0] * y0[0] + y0[1] * y0[1]) + (y0[2] * y0[2] + y0[3] * y0[3])) + ((y1[0] * y1[0] + y1[1] * y1[1]) + (y1[2] * y1[2] + y1[3] * y1[3])); }
                sm += shfl_x(sm, 16, lane); sm += shfl_x(sm, 32, lane); sq += shfl_x(sq, 16, lane); sq += shfl_x(sq, 32, lane);
                if (fq == 0) *(f32x2*)(pst + ((size_t)row * 32 + u.pn * 4 + wc) * 2) = (f32x2){sm, sq}; }
    }
};
struct EpiConvIn {
    static constexpr bool PERM = true;
    bf16* UC; bf16* BGp;
    __device__ __forceinline__ void operator()(const f32x4 (&acc)[2][2][4][2], const Unit& u, int wr, int wc, int fr, int fq) const {
        asm volatile("" : "+v"(fr), "+v"(fq));
        const int row0 = u.pm * BM + wr * 64 + fr, cw = wc * 32 + 8 * fq;
        if (u.pn < 16) {
#pragma unroll
            for (int ai = 0; ai < 2; ++ai)
#pragma unroll
                for (int m = 0; m < 4; ++m) { bf16* rowp = UC + (size_t)(row0 + ai * HALF + m * 16) * D + u.pn * HALF + cw;
                    const f32x4 v0 = acc[ai][0][m][0] * acc[ai][1][m][0], v1 = acc[ai][0][m][1] * acc[ai][1][m][1];
                    v4u w; w.x = cvt_pk_bf16(v0[0], v0[1]); w.y = cvt_pk_bf16(v0[2], v0[3]); w.z = cvt_pk_bf16(v1[0], v1[1]); w.w = cvt_pk_bf16(v1[2], v1[3]);
                    *(v4u*)rowp = w; }
        } else {
#pragma unroll
            for (int ai = 0; ai < 2; ++ai)
#pragma unroll
                for (int m = 0; m < 4; ++m) { bf16* rowp = BGp + (size_t)(row0 + ai * HALF + m * 16) * D + (u.pn - 16) * BM + cw;
#pragma unroll
                    for (int bj = 0; bj < 2; ++bj) { const f32x4 v0 = acc[ai][bj][m][0], v1 = acc[ai][bj][m][1];
                        v4u w; w.x = cvt_pk_bf16(v0[0], v0[1]); w.y = cvt_pk_bf16(v0[2], v0[3]); w.z = cvt_pk_bf16(v1[0], v1[1]); w.w = cvt_pk_bf16(v1[2], v1[3]);
                        *(v4u*)(rowp + bj * HALF) = w; } }
        }
    }
};
__device__ __forceinline__ f32x4 silu_mul(f32x4 g, f32x4 uu) {
    f32x4 r;
#pragma unroll
    for (int j = 0; j < 4; ++j) r[j] = g[j] * __builtin_amdgcn_rcpf(1.0f + __expf(-g[j])) * uu[j];
    return r;
}
struct EpiExpertGU {
    static constexpr bool PERM = true;
    bf16* H;
    __device__ __forceinline__ void operator()(const f32x4 (&acc)[2][2][4][2], const Unit& u, int wr, int wc, int fr, int fq) const {
        asm volatile("" : "+v"(fr), "+v"(fq));
        const float* gates = (const float*)((const char*)u.rows + (WS_LGATE - WS_LTOK));
        const int cw = wc * 32 + 8 * fq;
#pragma unroll
        for (int ai = 0; ai < 2; ++ai)
#pragma unroll
            for (int m = 0; m < 4; ++m) { const int r = ai * HALF + wr * 64 + m * 16 + fr;
                if (r < u.nvalid) { const float gt = gates[r]; const unsigned pid = (unsigned)u.rows[r];
                    const f32x4 v0 = silu_mul(acc[ai][0][m][0], acc[ai][1][m][0]) * gt, v1 = silu_mul(acc[ai][0][m][1], acc[ai][1][m][1]) * gt;
                    v4u w; w.x = cvt_pk_bf16(v0[0], v0[1]); w.y = cvt_pk_bf16(v0[2], v0[3]); w.z = cvt_pk_bf16(v1[0], v1[1]); w.w = cvt_pk_bf16(v1[2], v1[3]);
                    (void)pid; *(v4u*)(H + (size_t)(u.aux + r) * EDIM + cw) = w; } }
    }
};
struct EpiSharedGU {
    static constexpr bool PERM = true;
    bf16* HS;
    __device__ __forceinline__ void operator()(const f32x4 (&acc)[2][2][4][2], const Unit& u, int wr, int wc, int fr, int fq) const {
        asm volatile("" : "+v"(fr), "+v"(fq));
        const int row0 = u.pm * BM + wr * 64 + fr, cw = u.pn * HALF + wc * 32 + 8 * fq;
#pragma unroll
        for (int ai = 0; ai < 2; ++ai)
#pragma unroll
            for (int m = 0; m < 4; ++m) {
                const f32x4 v0 = silu_mul(acc[ai][0][m][0], acc[ai][1][m][0]), v1 = silu_mul(acc[ai][0][m][1], acc[ai][1][m][1]);
                v4u w; w.x = cvt_pk_bf16(v0[0], v0[1]); w.y = cvt_pk_bf16(v0[2], v0[3]); w.z = cvt_pk_bf16(v1[0], v1[1]); w.w = cvt_pk_bf16(v1[2], v1[3]);
                *(v4u*)(HS + (size_t)(row0 + ai * HALF + m * 16) * SDIM + cw) = w; }
    }
};
struct EpiDownY {
    static constexpr bool PERM = true;
    bf16* Y;
    __device__ __forceinline__ void operator()(const f32x4 (&acc)[2][2][4][2], const Unit& u, int wr, int wc, int fr, int fq) const {
        asm volatile("" : "+v"(fr), "+v"(fq));
        const int col0 = u.pn * BM + wc * 32 + 8 * fq;
#pragma unroll
        for (int ai = 0; ai < 2; ++ai)
#pragma unroll
            for (int m = 0; m < 4; ++m) { const int r = ai * HALF + wr * 64 + m * 16 + fr; bf16* rowp = Y + (size_t)(u.aux + r) * D + col0;
#pragma unroll
                for (int bj = 0; bj < 2; ++bj) { const f32x4 v0 = acc[ai][bj][m][0], v1 = acc[ai][bj][m][1];
                    v4u w; w.x = cvt_pk_bf16(v0[0], v0[1]); w.y = cvt_pk_bf16(v0[2], v0[3]); w.z = cvt_pk_bf16(v1[0], v1[1]); w.w = cvt_pk_bf16(v1[2], v1[3]);
                    *(v4u*)(rowp + bj * HALF) = w; } }
    }
};
}

struct Args { const float* in[19]; float* out; unsigned char* ws; int ph_lo, ph_hi; };
struct Frame {
    LAS unsigned char* lds; unsigned* ctl; unsigned char* ws;
    int tid, lane, wave, G, bid;
};
enum { IN_X = 0, IN_RELB, IN_PWIN, IN_PWG, IN_PSC, IN_PWOUT, IN_DQKV, IN_DOUT, IN_CWIN, IN_CW, IN_CWOUT, IN_LNG, IN_LNB, IN_RW, IN_RB, IN_EGU, IN_ED, IN_SGU, IN_SD };

#define CAS __attribute__((address_space(4)))
typedef const CAS unsigned char* KP;
__device__ __forceinline__ const float* ain(KP kp, int i) { return (const float*)((const GAS float* const CAS*)kp)[i]; }
__device__ __forceinline__ float* aout(KP kp) { return (float*)((GAS float* const CAS*)kp)[19]; }
__device__ __forceinline__ void tr_item(const float* W, int K, int N, bf16* WT, int dstK, int mode, LAS float* scr, int item, int lane) {
    const int nblk = N / 32, kb = item / nblk, nb = item % nblk, k0 = 64 * kb, n0 = 32 * nb;
    int r0 = n0;
    if (mode == 1) { const int part = n0 / 2048, j = n0 % 2048; r0 = (part == 0) ? 4096 + j : 256 * (j / 128) + (part == 2 ? 128 : 0) + (j % 128); }
    if (mode == 2) { const int part = n0 / 256, j = n0 % 256; r0 = 256 * (j / 128) + 128 * part + (j % 128); }
#pragma unroll 8
    for (int i = 0; i < 32; ++i) { const int kk = 2 * i + (lane >> 5); scr[kk * 33 + (lane & 31)] = __builtin_nontemporal_load(W + (size_t)(k0 + kk) * N + n0 + (lane & 31)); }
    LDS_WAIT(); asm volatile("" ::: "memory");
    const int c = lane & 7;
#pragma unroll
    for (int j = 0; j < 4; ++j) { const int n = (lane >> 3) + 8 * j; const LAS float* s = scr + (8 * c) * 33 + n;
        v4u o; o.x = pk2(s[0 * 33], s[1 * 33]); o.y = pk2(s[2 * 33], s[3 * 33]); o.z = pk2(s[4 * 33], s[5 * 33]); o.w = pk2(s[6 * 33], s[7 * 33]);
        __builtin_nontemporal_store(o, (v4u*)(WT + (size_t)(r0 + n) * dstK + k0 + 8 * c)); }
    LDS_WAIT(); asm volatile("" ::: "memory");
}
__device__ __forceinline__ void phase_prologue(const Frame& F, KP kp) {
    LAS float* scr = (LAS float*)(F.lds + F.wave * 16384);
    const int gw = F.bid * 8 + F.wave, NGW = F.G * 8;
    constexpr int I0 = 2 * 2048, I1 = 8 * 128, I2 = 2 * 2048, I3 = 4608, I4 = 512, I5 = 6144, I6 = 2048, I7 = 4 * 512, I8 = 4 * 256, I9 = 256 * 256, I10 = 256 * 128;
    constexpr int NITEMS = I0 + I1 + I2 + I3 + I4 + I5 + I6 + I7 + I8 + I9 + I10;
    unsigned char* ws = F.ws;
    for (int it = gw; it < NITEMS; it += NGW) {
        int r = it;
        if (r < I0) { const int b = r / 2048; tr_item(ain(kp, IN_PWIN) + (size_t)b * D * D, D, D, (bf16*)(ws + WS_W_POOL_IN) + (size_t)b * D * D, D, 0, scr, r % 2048, F.lane); continue; } r -= I0;
        if (r < I1) { const int b = r / 128; tr_item(ain(kp, IN_PWG) + (size_t)b * 512 * 512, 512, 512, (bf16*)(ws + WS_W_POOL_G) + (size_t)b * 512 * 512, 512, 0, scr, r % 128, F.lane); continue; } r -= I1;
        if (r < I2) { const int b = r / 2048; tr_item(ain(kp, IN_PWOUT) + (size_t)b * D * D, D, D, (bf16*)(ws + WS_W_POOL_OUT) + (size_t)b * D * D, D, 0, scr, r % 2048, F.lane); continue; } r -= I2;
        if (r < I3) { tr_item(ain(kp, IN_DQKV), D, QKVC, (bf16*)(ws + WS_W_DIL_QKV), D, 0, scr, r, F.lane); continue; } r -= I3;
        if (r < I4) { tr_item(ain(kp, IN_DOUT), DILW, D, (bf16*)(ws + WS_W_DIL_OUT), DILW, 0, scr, r, F.lane); continue; } r -= I4;
        if (r < I5) { tr_item(ain(kp, IN_CWIN), D, 3 * D, (bf16*)(ws + WS_W_CONV_IN), D, 1, scr, r, F.lane); continue; } r -= I5;
        if (r < I6) { tr_item(ain(kp, IN_CWOUT), D, D, (bf16*)(ws + WS_W_CONV_OUT), D, 0, scr, r, F.lane); continue; } r -= I6;
        if (r < I7) { const int b = r / 512; tr_item(ain(kp, IN_SGU) + (size_t)b * D * 512, D, 512, (bf16*)(ws + WS_W_SH_GU) + (size_t)b * 512 * D, D, 2, scr, r % 512, F.lane); continue; } r -= I7;
        if (r < I8) { const int b = r / 256; tr_item(ain(kp, IN_SD) + (size_t)b * SDIM * D, SDIM, D, (bf16*)(ws + WS_W_SH_D) + (size_t)b * D * SDIM, SDIM, 0, scr, r % 256, F.lane); continue; } r -= I8;
        if (r < I9) { const int b = r / 256; tr_item(ain(kp, IN_EGU) + (size_t)b * D * 256, D, 256, (bf16*)(ws + WS_W_EX_GU) + (size_t)b * 256 * D, D, 0, scr, r % 256, F.lane); continue; } r -= I9;
        { const int b = r / 128; tr_item(ain(kp, IN_ED) + (size_t)b * EDIM * D, EDIM, D, (bf16*)(ws + WS_W_EX_D) + (size_t)b * D * EDIM, EDIM, 0, scr, r % 128, F.lane); }
    }
    const size_t gt = (size_t)F.bid * 512 + F.tid, GT = (size_t)F.G * 512;
    { const float* rw = ain(kp, IN_RW); bf16* wh = (bf16*)(ws + WS_RWH); bf16* wl = (bf16*)(ws + WS_RWL);
      for (size_t i = gt; i < (size_t)DEPTH * NEXP * D / 8; i += GT) { const size_t k8 = i % (D / 8), e = (i / (D / 8)) % NEXP, l = i / ((size_t)NEXP * D / 8);
          float v[8]; unsigned hi[8], lo[8];
#pragma unroll
          for (int j = 0; j < 8; ++j) { v[j] = rw[(l * D + k8 * 8 + j) * NEXP + e]; hi[j] = f2bf(v[j]); lo[j] = f2bf(v[j] - __builtin_bit_cast(float, hi[j] << 16)); }
          v4u a, b2; a.x = hi[0] | (hi[1] << 16); a.y = hi[2] | (hi[3] << 16); a.z = hi[4] | (hi[5] << 16); a.w = hi[6] | (hi[7] << 16);
          b2.x = lo[0] | (lo[1] << 16); b2.y = lo[2] | (lo[3] << 16); b2.z = lo[4] | (lo[5] << 16); b2.w = lo[6] | (lo[7] << 16);
          *(v4u*)(wh + (l * NEXP + e) * D + k8 * 8) = a; *(v4u*)(wl + (l * NEXP + e) * D + k8 * 8) = b2; } }
    const float* x = ain(kp, IN_X); bf16* xb = (bf16*)(ws + WS_XB);
    for (size_t i = gt; i < (size_t)T * D / 8; i += GT) { const f32x4 p = __builtin_nontemporal_load((const f32x4*)(x + i * 8)), q = __builtin_nontemporal_load((const f32x4*)(x + i * 8 + 4));
        v4u w; w.x = pk2(p[0], p[1]); w.y = pk2(p[2], p[3]); w.z = pk2(q[0], q[1]); w.w = pk2(q[2], q[3]); *(v4u*)(xb + i * 8) = w; }
}

__device__ __forceinline__ void unpack8(const v4u w, float (&f)[8]) { f[0] = bflo(w.x); f[1] = bfhi(w.x); f[2] = bflo(w.y); f[3] = bfhi(w.y); f[4] = bflo(w.z); f[5] = bfhi(w.z); f[6] = bflo(w.w); f[7] = bfhi(w.w); }
__device__ __forceinline__ void phase_pool(const Frame& F, const bf16* U, bf16* PL) {
    for (int it = F.bid * 512 + F.tid; it < (T / 32) * 256; it += F.G * 512) {
        const int cv = it & 255, ch = it >> 8, col = cv * 8;
        const int w = __builtin_amdgcn_readfirstlane(2 << (col >> 9));
        const int row0 = __builtin_amdgcn_readfirstlane(ch * 32), pos0 = row0 & (SEQ - 1);
        float s[8], uu[8];
#pragma unroll
        for (int j = 0; j < 8; ++j) s[j] = 0.f;
        { v4u pre[15];
#pragma unroll
          for (int j = 0; j < 15; ++j) { pre[j] = (v4u){0u, 0u, 0u, 0u}; if (j + 1 < w && pos0 - (j + 1) >= 0) pre[j] = *(const v4u*)(U + (size_t)(row0 - (j + 1)) * D + col); }
#pragma unroll
          for (int j = 0; j < 15; ++j) asm volatile("" : "+v"(pre[j]));
#pragma unroll
          for (int j = 0; j < 15; ++j) { unpack8(pre[j], uu);
#pragma unroll
              for (int q = 0; q < 8; ++q) s[q] += uu[q]; } }
#pragma unroll 1
        for (int cb = 0; cb < 4; ++cb) {
            v4u un[8], uo[8];
#pragma unroll
            for (int j = 0; j < 8; ++j) { const int r = 8 * cb + j, t = row0 + r, pos = pos0 + r;
                un[j] = *(const v4u*)(U + (size_t)t * D + col);
                uo[j] = (v4u){0u, 0u, 0u, 0u}; if (pos - w + 1 >= 0) uo[j] = *(const v4u*)(U + (size_t)(t - w + 1) * D + col); }
#pragma unroll
            for (int j = 0; j < 8; ++j) asm volatile("" : "+v"(un[j]), "+v"(uo[j]));
#pragma unroll
            for (int j = 0; j < 8; ++j) { const int r = 8 * cb + j, t = row0 + r, pos = pos0 + r;
                unpack8(un[j], uu);
                const float inv = 1.0f / (float)((pos + 1) < w ? (pos + 1) : w);
                float o[8];
#pragma unroll
                for (int q = 0; q < 8; ++q) { s[q] += uu[q]; o[q] = s[q] * inv - uu[q]; }
                v4u ww; ww.x = pk2(o[0], o[1]); ww.y = pk2(o[2], o[3]); ww.z = pk2(o[4], o[5]); ww.w = pk2(o[6], o[7]);
                *(v4u*)(PL + (size_t)t * D + col) = ww;
                unpack8(uo[j], uu);
#pragma unroll
                for (int q = 0; q < 8; ++q) s[q] -= uu[q]; }
        }
    }
}

__device__ __forceinline__ void phase_conv(const Frame& F, const bf16* UC, const bf16* BGp, const float* cw, bf16* Z) {
    for (int it = F.bid * 512 + F.tid; it < (T / 4) * 256; it += F.G * 512) {
        const int cv = it & 255, col = cv * 8, t0 = __builtin_amdgcn_readfirstlane((it >> 8) * 4), pos0 = t0 & (SEQ - 1);
        v4u ur[6], br[4];
#pragma unroll
        for (int j = 0; j < 6; ++j) { ur[j] = (v4u){0u, 0u, 0u, 0u}; if (j >= 2 || pos0 > 0) ur[j] = *(const v4u*)(UC + (size_t)(t0 - 2 + j) * D + col); }
#pragma unroll
        for (int j = 0; j < 4; ++j) br[j] = *(const v4u*)(BGp + (size_t)(t0 + j) * D + col);
        const f32x4 c0a = *(const f32x4*)(cw + col), c0b = *(const f32x4*)(cw + col + 4), c1a = *(const f32x4*)(cw + D + col), c1b = *(const f32x4*)(cw + D + col + 4), c2a = *(const f32x4*)(cw + 2 * D + col), c2b = *(const f32x4*)(cw + 2 * D + col + 4);
        asm volatile("" : "+v"(ur[0]), "+v"(ur[1]), "+v"(ur[2]), "+v"(ur[3]), "+v"(ur[4]), "+v"(ur[5]), "+v"(br[0]), "+v"(br[1]), "+v"(br[2]), "+v"(br[3]));
        const float c0[8] = {c0a[0], c0a[1], c0a[2], c0a[3], c0b[0], c0b[1], c0b[2], c0b[3]}, c1[8] = {c1a[0], c1a[1], c1a[2], c1a[3], c1b[0], c1b[1], c1b[2], c1b[3]}, c2[8] = {c2a[0], c2a[1], c2a[2], c2a[3], c2b[0], c2b[1], c2b[2], c2b[3]};
#pragma unroll
        for (int j = 0; j < 4; ++j) { float u0[8], u1[8], u2[8], bb[8], o[8];
            unpack8(ur[j], u0); unpack8(ur[j + 1], u1); unpack8(ur[j + 2], u2); unpack8(br[j], bb);
#pragma unroll
            for (int q = 0; q < 8; ++q) o[q] = bb[q] * (c0[q] * u0[q] + c1[q] * u1[q] + c2[q] * u2[q]);
            v4u ww; ww.x = pk2(o[0], o[1]); ww.y = pk2(o[2], o[3]); ww.z = pk2(o[4], o[5]); ww.w = pk2(o[6], o[7]);
            *(v4u*)(Z + (size_t)(t0 + j) * D + col) = ww; }
    }
}

__device__ __forceinline__ int t5_bucket(int dist) {
    if (dist < 16) return dist;
    int large = 16 + (int)(logf((float)dist / 16.0f) / logf(128.0f) * 16.0f);
    return large < 31 ? large : 31;
}
constexpr int AT_KS = 0, AT_KSTR = 144, AT_VT = 256 * 144, AT_VSTR = 520, AT_BIAS = AT_VT + 64 * 520;
__device__ __forceinline__ void phase_attn(const Frame& F, const bf16* QKV, const float* relb, bf16* OG, float* LSE) {
    LAS unsigned char* lds = F.lds;
    const int tid = F.tid, lane = F.lane, w = tid >> 6, fr = lane & 15, fq = lane >> 4;
    for (int unit = F.bid; unit < NBATCH * 3 * 8 * 16; unit += F.G) {
        const int cmb = unit & 15, h = (unit >> 4) & 7, g = (unit >> 7) % 3, b = unit / 384;
        const int dsh = 2 * g, dil = 1 << dsh, r = cmb & (dil - 1), nb = cmb >> dsh;
        const bf16* base = QKV + (size_t)b * SEQ * QKVC + g * 1536 + h * 64;
        __syncthreads();
        {
            const int key = tid >> 1, half = tid & 1, jk = (nb - 1) * 128 + key;
            v4u kv[4], vv[4];
            if (jk >= 0) { const bf16* rp = base + (size_t)(jk * dil + r) * QKVC + half * 32;
#pragma unroll
                for (int i = 0; i < 4; ++i) { kv[i] = *(const v4u*)(rp + 512 + 8 * i); vv[i] = *(const v4u*)(rp + 1024 + 8 * i); } }
            else {
#pragma unroll
                for (int i = 0; i < 4; ++i) { kv[i] = (v4u){0u, 0u, 0u, 0u}; vv[i] = (v4u){0u, 0u, 0u, 0u}; } }
#pragma unroll
            for (int i = 0; i < 4; ++i) *(LAS v4u*)(lds + AT_KS + key * AT_KSTR + half * 64 + 16 * i) = kv[i];
#pragma unroll
            for (int i = 0; i < 4; ++i) {
                const unsigned ww[4] = {vv[i].x, vv[i].y, vv[i].z, vv[i].w};
#pragma unroll
                for (int q = 0; q < 4; ++q) { const int d = half * 32 + 8 * i + 2 * q;
                    *(LAS unsigned short*)(lds + AT_VT + d * AT_VSTR + key * 2) = (unsigned short)(ww[q] & 0xffffu);
                    *(LAS unsigned short*)(lds + AT_VT + (d + 1) * AT_VSTR + key * 2) = (unsigned short)(ww[q] >> 16); } }
            if (tid <= 128) ((LAS float*)(lds + AT_BIAS))[tid] = relb[t5_bucket(tid * dil) * 24 + g * 8 + h];
        }
        __syncthreads();
        int qi = 16 * w + fr; asm volatile("" : "+v"(qi));
        const int jq = nb * 128 + qi, tq = jq * dil + r;
        const bf16* qp = base + (size_t)tq * QKVC + 8 * fq;
        const bf16x8 q0 = *(const bf16x8*)qp, q1 = *(const bf16x8*)(qp + 32);
        f32x4 s[9]; float mx = -INFINITY;
#pragma unroll
        for (int kt = 0; kt < 9; ++kt) {
            const int kb = 16 * (w + kt);
            const bf16x8 k0 = *(const LAS bf16x8*)(lds + AT_KS + (kb + fr) * AT_KSTR + fq * 16), k1 = *(const LAS bf16x8*)(lds + AT_KS + (kb + fr) * AT_KSTR + 64 + fq * 16);
            f32x4 a = (f32x4){0.f, 0.f, 0.f, 0.f};
            a = __builtin_amdgcn_mfma_f32_16x16x32_bf16(k0, q0, a, 0, 0, 0);
            a = __builtin_amdgcn_mfma_f32_16x16x32_bf16(k1, q1, a, 0, 0, 0);
#pragma unroll
            for (int i = 0; i < 4; ++i) { const int kl = kb + 4 * fq + i, rel = qi + 128 - kl;
                const bool ok = (rel >= 0) && (rel <= 128) && (nb > 0 || kl >= 128);
                const int rc = rel < 0 ? 0 : (rel > 128 ? 128 : rel);
                const float v = ok ? a[i] + ((LAS float*)(lds + AT_BIAS))[rc] : -INFINITY;
                a[i] = v; mx = fmaxf(mx, v); }
            s[kt] = a;
        }
        mx = fmaxf(mx, shfl_x(mx, 16, lane)); mx = fmaxf(mx, shfl_x(mx, 32, lane));
        float l = 0.f;
#pragma unroll
        for (int kt = 0; kt < 9; ++kt)
#pragma unroll
            for (int i = 0; i < 4; ++i) { const float p = __expf(s[kt][i] - mx); s[kt][i] = p; l += p; }
        l += shfl_x(l, 16, lane); l += shfl_x(l, 32, lane);
        f32x4 o[4];
#pragma unroll
        for (int nt = 0; nt < 4; ++nt) o[nt] = (f32x4){0.f, 0.f, 0.f, 0.f};
#pragma unroll
        for (int st = 0; st < 5; ++st) {
            const int kt0 = 2 * st, kt1 = 2 * st + 1;
            v4u pw; pw.x = pk2(s[kt0][0], s[kt0][1]); pw.y = pk2(s[kt0][2], s[kt0][3]);
            if (kt1 < 9) { pw.z = pk2(s[kt1 < 9 ? kt1 : 0][0], s[kt1 < 9 ? kt1 : 0][1]); pw.w = pk2(s[kt1 < 9 ? kt1 : 0][2], s[kt1 < 9 ? kt1 : 0][3]); } else { pw.z = 0u; pw.w = 0u; }
            const bf16x8 pf = __builtin_bit_cast(bf16x8, pw);
            const int kb0 = 16 * (w + kt0) + 4 * fq, kb1 = 16 * (w + kt1) + 4 * fq;
#pragma unroll
            for (int nt = 0; nt < 4; ++nt) { const int d = 16 * nt + fr;
                v2u va = *(const LAS v2u*)(lds + AT_VT + d * AT_VSTR + kb0 * 2), vb = (v2u){0u, 0u};
                if (kt1 < 9) vb = *(const LAS v2u*)(lds + AT_VT + d * AT_VSTR + kb1 * 2);
                v4u vw; vw.x = va.x; vw.y = va.y; vw.z = vb.x; vw.w = vb.y;
                o[nt] = __builtin_amdgcn_mfma_f32_16x16x32_bf16(__builtin_bit_cast(bf16x8, vw), pf, o[nt], 0, 0, 0); }
        }
        const float il = 1.0f / l;
        bf16* op = OG + ((size_t)g * T + (size_t)b * SEQ + tq) * DILW + h * 64 + 4 * fq;
#pragma unroll
        for (int nt = 0; nt < 4; ++nt) { v2u ww; ww.x = pk2(o[nt][0] * il, o[nt][1] * il); ww.y = pk2(o[nt][2] * il, o[nt][3] * il); *(v2u*)(op + 16 * nt) = ww; }
        if (fq == 0) LSE[((size_t)g * T + (size_t)b * SEQ + tq) * 8 + h] = mx + logf(l);
    }
}
__device__ __forceinline__ void phase_combine(const Frame& F, const bf16* OG, const float* LSE, bf16* O) {
    for (int it0 = F.bid * 512 + F.tid; it0 < T * 64; it0 += 4 * F.G * 512) {
        float ls[4][3]; v4u og[4][3];
#pragma unroll
        for (int u = 0; u < 4; ++u) { int it = it0 + u * F.G * 512; it = it < T * 64 ? it : it0;
            const int c8 = it & 7, h = (it >> 3) & 7, t = it >> 6; const size_t off = (size_t)t * DILW + h * 64 + c8 * 8;
#pragma unroll
            for (int g = 0; g < 3; ++g) { ls[u][g] = LSE[((size_t)g * T + t) * 8 + h]; og[u][g] = *(const v4u*)(OG + (size_t)g * T * DILW + off); } }
#pragma unroll
        for (int u = 0; u < 4; ++u) asm volatile("" : "+v"(ls[u][0]), "+v"(ls[u][1]), "+v"(ls[u][2]), "+v"(og[u][0]), "+v"(og[u][1]), "+v"(og[u][2]));
#pragma unroll
        for (int u = 0; u < 4; ++u) { const int it = it0 + u * F.G * 512, c8 = it & 7, h = (it >> 3) & 7, t = it >> 6; const size_t off = (size_t)t * DILW + h * 64 + c8 * 8;
            if (it >= T * 64) continue;
            const float l0 = ls[u][0], l1 = ls[u][1], l2 = ls[u][2];
            const float m = fmaxf(l0, fmaxf(l1, l2)); float w0 = __expf(l0 - m), w1 = __expf(l1 - m), w2 = __expf(l2 - m); const float inv = 1.0f / (w0 + w1 + w2); w0 *= inv; w1 *= inv; w2 *= inv;
            float a[8], bq[8], c[8], o[8];
            unpack8(og[u][0], a); unpack8(og[u][1], bq); unpack8(og[u][2], c);
#pragma unroll
            for (int q = 0; q < 8; ++q) o[q] = w0 * a[q] + w1 * bq[q] + w2 * c[q];
            v4u ww; ww.x = pk2(o[0], o[1]); ww.y = pk2(o[2], o[3]); ww.z = pk2(o[4], o[5]); ww.w = pk2(o[6], o[7]);
            *(v4u*)(O + off) = ww; }
    }
}

constexpr int M1_LOG = 131072, M1_STAT = M1_LOG + 4096, M1_HIST = M1_STAT + 128, M1_BASE = M1_HIST + 256;
__device__ __forceinline__ void phase_moe1(const Frame& F, const float* Y, const float* gain, const float* bias, const float* RW, const float* RB,
                                           float* X1F, bf16* X1B, unsigned* cnt, int* ltok, float* lgate, int* eidx, int* inv) {
    LAS float* xs = (LAS float*)F.lds; LAS float* logit = (LAS float*)(F.lds + M1_LOG); LAS float* stat = (LAS float*)(F.lds + M1_STAT);
    LAS int* hist = (LAS int*)(F.lds + M1_HIST); LAS int* basep = (LAS int*)(F.lds + M1_BASE);
    const int tid = F.tid, lane = F.lane, w = F.wave;
    for (int rg = F.bid; rg < T / 16; rg += F.G) {
        const int row0 = rg * 16;
        __syncthreads();
#pragma unroll
        for (int j = 0; j < 16; ++j) { const int idx = tid + 512 * j; *(LAS f32x4*)(xs + idx * 4) = *(const f32x4*)(Y + (size_t)row0 * D + (size_t)idx * 4); }
        if (tid < 64) hist[tid] = 0;
        __syncthreads();
#pragma unroll
        for (int rr = 0; rr < 2; ++rr) { const int r = 2 * w + rr; float sm = 0.f;
#pragma unroll
            for (int j = 0; j < 32; ++j) sm += xs[r * D + lane + 64 * j];
            const float mean = wave_sum(sm, lane) * (1.0f / D); float sq = 0.f;
#pragma unroll
            for (int j = 0; j < 32; ++j) { const float d = xs[r * D + lane + 64 * j] - mean; sq += d * d; }
            const float rstd = 1.0f / sqrtf(wave_sum(sq, lane) * (1.0f / D) + LN_EPS);
            if (lane == 0) { stat[2 * r] = mean; stat[2 * r + 1] = rstd; } }
        __syncthreads();
#pragma unroll
        for (int j = 0; j < 16; ++j) { const int idx = tid + 512 * j, r = idx >> 9, c4 = (idx & 511) * 4;
            const f32x4 v = *(LAS f32x4*)(xs + idx * 4), gv = *(const f32x4*)(gain + c4), bv = *(const f32x4*)(bias + c4);
            const float mean = stat[2 * r], rstd = stat[2 * r + 1];
            const f32x4 o = (v - mean) * rstd * gv + bv;
            *(LAS f32x4*)(xs + idx * 4) = o;
            *(f32x4*)(X1F + (size_t)(row0 + r) * D + c4) = o;
            v2u wb; wb.x = pk2(o[0], o[1]); wb.y = pk2(o[2], o[3]); *(v2u*)(X1B + (size_t)(row0 + r) * D + c4) = wb; }
        __syncthreads();
        { const int r = tid >> 5, ep = tid & 31; float a0 = 0.f, a1 = 0.f; const float* wp = RW + 2 * ep; const LAS float* xr = xs + r * D;
            for (int k0 = 0; k0 < D; k0 += 16) {
                f32x2 wv[16];
#pragma unroll
                for (int j = 0; j < 16; ++j) wv[j] = *(const f32x2*)(wp + (size_t)(k0 + j) * NEXP);
                asm volatile("" : "+v"(wv[0]), "+v"(wv[1]), "+v"(wv[2]), "+v"(wv[3]), "+v"(wv[4]), "+v"(wv[5]), "+v"(wv[6]), "+v"(wv[7]));
                asm volatile("" : "+v"(wv[8]), "+v"(wv[9]), "+v"(wv[10]), "+v"(wv[11]), "+v"(wv[12]), "+v"(wv[13]), "+v"(wv[14]), "+v"(wv[15]));
#pragma unroll
                for (int j = 0; j < 16; ++j) { const float xv = xr[k0 + j]; a0 += xv * wv[j].x; a1 += xv * wv[j].y; } }
            logit[r * NEXP + 2 * ep] = a0; logit[r * NEXP + 2 * ep + 1] = a1; }
        __syncthreads();
        int sel_pos[2]; float sel_gate[2]; int sel_rank[2]; bool sel_on[2];
#pragma unroll
        for (int rr = 0; rr < 2; ++rr) { const int r = 2 * w + rr;
            const float sc = 1.0f / (1.0f + __expf(-logit[r * NEXP + lane])); const float ch = sc + RB[lane];
            int rk = 0;
#pragma unroll
            for (int j = 0; j < 8; ++j) { const float cj = shfl_from(ch, (lane & ~7) + j); rk += (cj > ch || (cj == ch && j < (lane & 7))) ? 1 : 0; }
            float gs = rk < 2 ? ch : 0.f; gs += shfl_x(gs, 1, lane); gs += shfl_x(gs, 2, lane); gs += shfl_x(gs, 4, lane);
            int grk = 0; const int g = lane >> 3;
#pragma unroll
            for (int hh = 0; hh < 8; ++hh) { const float gh = shfl_from(gs, 8 * hh); grk += (gh > gs || (gh == gs && hh < g)) ? 1 : 0; }
            const float msk = grk < 4 ? ch : -INFINITY;
            int erk = 0;
            for (int j = 0; j < 64; ++j) { const float mj = __builtin_bit_cast(float, __builtin_amdgcn_readlane(__builtin_bit_cast(int, msk), j)); erk += (mj > msk || (mj == msk && j < lane)) ? 1 : 0; }
            const bool on = erk < 8;
            const float ssum = wave_sum(on ? sc : 0.f, lane);
            sel_on[rr] = on; sel_rank[rr] = erk; sel_gate[rr] = sc / ssum * 2.5f; sel_pos[rr] = 0;
            if (on) sel_pos[rr] = __hip_atomic_fetch_add(&hist[lane], 1, __ATOMIC_RELAXED, __HIP_MEMORY_SCOPE_WORKGROUP); }
        __syncthreads();
        if (tid < 64) { const int hc = hist[tid]; int bs = 0; if (hc > 0) bs = (int)atomicAdd(&cnt[tid * 16], (unsigned)hc); basep[tid] = bs; }
        __syncthreads();
#pragma unroll
        for (int rr = 0; rr < 2; ++rr) if (sel_on[rr]) { const int t = row0 + 2 * w + rr, pos = basep[lane] + sel_pos[rr];
            ltok[(size_t)lane * CAP + pos] = t; lgate[(size_t)lane * CAP + pos] = sel_gate[rr];
            eidx[t * 8 + sel_rank[rr]] = lane; inv[t * 8 + sel_rank[rr]] = pos; }
    }
}
__device__ __forceinline__ int build_tiles(const Frame& F, const unsigned* cnt) {
    LAS int* tpref = (LAS int*)(F.lds + LDS_TAB); LAS int* cl = (LAS int*)(F.lds + LDS_TAB + 512);
    __syncthreads();
    if (F.tid < 64) cl[F.tid] = (int)__hip_atomic_load(&cnt[F.tid * 16], __ATOMIC_RELAXED, __HIP_MEMORY_SCOPE_AGENT);
    __syncthreads();
    if (F.tid == 0) { int acc = 0; for (int e = 0; e < 64; ++e) { tpref[e] = acc; acc += (cl[e] + 255) >> 8; } tpref[64] = acc; tpref[65] = acc + T / 256; tpref[66] = acc + 2 * (T / 256); cl[64] = T; cl[65] = T; }
    __syncthreads();
    return __builtin_amdgcn_readfirstlane(tpref[64]);
}
__device__ __forceinline__ void phase_moe4(const Frame& F, const float* Y2, const bf16* Yr, const int* eidx, const int* inv, const float* gain, const float* bias, float* XO, bf16* XBo) {
    const LAS int* tpref = (const LAS int*)(F.lds + LDS_TAB);
    const int gw = F.bid * 8 + F.wave, NGW = F.G * 8, lane = F.lane;
    for (int t = gw; t < T; t += NGW) {
        f32x4 v[8];
#pragma unroll
        for (int j = 0; j < 8; ++j) v[j] = *(const f32x4*)(Y2 + (size_t)t * D + 4 * lane + 256 * j);
        for (int k = 0; k < 8; ++k) { const int e = eidx[t * 8 + k], pos = inv[t * 8 + k]; const bf16* yr = Yr + (size_t)(tpref[e] * 256 + pos) * D + 4 * lane;
#pragma unroll
            for (int j = 0; j < 8; ++j) { const v2u w = *(const v2u*)(yr + 256 * j); v[j][0] += bflo(w.x); v[j][1] += bfhi(w.x); v[j][2] += bflo(w.y); v[j][3] += bfhi(w.y); } }
        float sm = 0.f;
#pragma unroll
        for (int j = 0; j < 8; ++j) sm += (v[j][0] + v[j][1]) + (v[j][2] + v[j][3]);
        const float mean = wave_sum(sm, lane) * (1.0f / D); float sq = 0.f;
#pragma unroll
        for (int j = 0; j < 8; ++j) { v[j] = v[j] - mean; sq += (v[j][0] * v[j][0] + v[j][1] * v[j][1]) + (v[j][2] * v[j][2] + v[j][3] * v[j][3]); }
        const float rstd = 1.0f / sqrtf(wave_sum(sq, lane) * (1.0f / D) + LN_EPS);
#pragma unroll
        for (int j = 0; j < 8; ++j) { const int c = 4 * lane + 256 * j; const f32x4 o = v[j] * rstd * *(const f32x4*)(gain + c) + *(const f32x4*)(bias + c);
            *(f32x4*)(XO + (size_t)t * D + c) = o;
            v2u wb; wb.x = pk2(o[0], o[1]); wb.y = pk2(o[2], o[3]); *(v2u*)(XBo + (size_t)t * D + c) = wb; }
    }
}


template <int CTRL> __device__ __forceinline__ float dppf(float x) { return __builtin_bit_cast(float, __builtin_amdgcn_update_dpp(0, __builtin_bit_cast(int, x), CTRL, 0xF, 0xF, false)); }
__device__ __forceinline__ float gmax8(float x) { x = fmaxf(x, dppf<0xB1>(x)); x = fmaxf(x, dppf<0x4E>(x)); x = fmaxf(x, dppf<0x141>(x)); return x; }
__device__ __forceinline__ float gsum8(float x) { x += dppf<0xB1>(x); x += dppf<0x4E>(x); x += dppf<0x141>(x); return x; }
__device__ __forceinline__ float rl_f(float x, int l) { return __builtin_bit_cast(float, __builtin_amdgcn_readlane(__builtin_bit_cast(int, x), l)); }
constexpr int M1_P = 0, M1N_HIST = 131072, M1N_BASE = 131072 + 256, M1N_GB = 131072 + 1024;
__device__ __forceinline__ void phase_moe1n(const Frame& F, const bf16* Y, const float* pst, const float* gain, const float* bias, const bf16* WH, const bf16* WL, const float* RB,
                                            bf16* X1B, float* ST1, unsigned* cnt, int* ltok, float* lgate, int* eidx, int* inv) {
    LAS float* P = (LAS float*)(F.lds + M1_P); LAS int* hist = (LAS int*)(F.lds + M1N_HIST); LAS int* basep = (LAS int*)(F.lds + M1N_BASE);
    const int tid = F.tid, lane = F.lane, w = F.wave, r = lane & 15, q = lane >> 4;
    for (int item = F.bid; item < T / 64; item += F.G) {
        const int row0 = item * 64;
        __syncthreads();
        { int t0 = tid; asm volatile("" : "+v"(t0));
          if (t0 < 64) hist[t0] = 0;
          LAS f32x4* gb = (LAS f32x4*)(F.lds + M1N_GB); gb[t0] = *(const f32x4*)(gain + 4 * t0); gb[512 + t0] = *(const f32x4*)(bias + 4 * t0); }
        __syncthreads();
        float mean[4], rstd[4];
#pragma unroll
        for (int rt = 0; rt < 4; ++rt) { const int row = row0 + 16 * rt + r;
          const f32x4* pp = (const f32x4*)(pst + ((size_t)row * 32 + q * 8) * 2); const f32x4 a = pp[0], b = pp[1], c = pp[2], d = pp[3];
          float sm = (a[0] + a[2]) + (b[0] + b[2]) + (c[0] + c[2]) + (d[0] + d[2]), sq = (a[1] + a[3]) + (b[1] + b[3]) + (c[1] + c[3]) + (d[1] + d[3]);
          sm += shfl_x(sm, 16, lane); sm += shfl_x(sm, 32, lane); sq += shfl_x(sq, 16, lane); sq += shfl_x(sq, 32, lane);
          mean[rt] = sm * (1.0f / D); const float var = fmaxf(sq * (1.0f / D) - mean[rt] * mean[rt], 0.f); rstd[rt] = 1.0f / sqrtf(var + LN_EPS);
          if (w == 0 && q == 0) *(f32x2*)(ST1 + 2 * row) = (f32x2){mean[rt], rstd[rt]}; }
        const int kb = 256 * w + 8 * q;
        const LAS float* gl = (const LAS float*)(F.lds + M1N_GB) + kb;
        f32x4 acc[4][4];
#pragma unroll
        for (int rt = 0; rt < 4; ++rt)
#pragma unroll
            for (int nt = 0; nt < 4; ++nt) acc[rt][nt] = (f32x4){0.f, 0.f, 0.f, 0.f};
        v4u yb[2][2][4], hb[4]; bf16x8 wh[4], wl[4];
        unsigned vo[4];
#pragma unroll
        for (int i = 0; i < 4; ++i) { vo[i] = (unsigned)(r * D + kb) * 2u + (unsigned)i * (16u * D * 2u); asm volatile("" : "+v"(vo[i])); }
        const char* ybase = (const char*)(Y + (size_t)row0 * D); char* xbase = (char*)(X1B + (size_t)row0 * D);
#define M1_LOADY(ms) do { _Pragma("unroll") for (int hf = 0; hf < 2; ++hf) _Pragma("unroll") for (int rt = 0; rt < 4; ++rt) yb[(ms) & 1][hf][rt] = *(const v4u*)(ybase + vo[rt] + 128 * (ms) + 64 * hf); } while (0)
#define M1_LOADW(st) do { _Pragma("unroll") for (int nt = 0; nt < 4; ++nt) { wh[nt] = *(const bf16x8*)((const char*)WH + vo[nt] + 64 * (st)); wl[nt] = *(const bf16x8*)((const char*)WL + vo[nt] + 64 * (st)); } } while (0)
        M1_LOADY(0); M1_LOADW(0); M1_LOADY(1);
        __builtin_amdgcn_sched_barrier(0);
#pragma unroll
        for (int st = 0; st < 8; ++st) {
            const f32x4 g0 = *(const LAS f32x4*)(gl + 32 * st), g1 = *(const LAS f32x4*)(gl + 32 * st + 4), b0 = *(const LAS f32x4*)(gl + 2048 + 32 * st), b1 = *(const LAS f32x4*)(gl + 2048 + 32 * st + 4);
#pragma unroll
            for (int rt = 0; rt < 4; ++rt) { const v4u yv = yb[(st >> 1) & 1][st & 1][rt];
                const f32x4 y0_ = (f32x4){bflo(yv.x), bfhi(yv.x), bflo(yv.y), bfhi(yv.y)}, y1_ = (f32x4){bflo(yv.z), bfhi(yv.z), bflo(yv.w), bfhi(yv.w)};
                const f32x4 x0 = (y0_ - mean[rt]) * rstd[rt] * g0 + b0, x1 = (y1_ - mean[rt]) * rstd[rt] * g1 + b1;
                v4u h; h.x = cvt_pk_bf16(x0[0], x0[1]); h.y = cvt_pk_bf16(x0[2], x0[3]); h.z = cvt_pk_bf16(x1[0], x1[1]); h.w = cvt_pk_bf16(x1[2], x1[3]);
                if ((st & 1) == 0) hb[rt] = h; else { *(v4u*)(xbase + vo[rt] + 64 * (st - 1)) = hb[rt]; *(v4u*)(xbase + vo[rt] + 64 * st) = h; }
                v4u l; l.x = cvt_pk_bf16(x0[0] - bflo(h.x), x0[1] - bfhi(h.x)); l.y = cvt_pk_bf16(x0[2] - bflo(h.y), x0[3] - bfhi(h.y));
                l.z = cvt_pk_bf16(x1[0] - bflo(h.z), x1[1] - bfhi(h.z)); l.w = cvt_pk_bf16(x1[2] - bflo(h.w), x1[3] - bfhi(h.w));
                const bf16x8 xh = __builtin_bit_cast(bf16x8, h), xl = __builtin_bit_cast(bf16x8, l);
#pragma unroll
                for (int nt = 0; nt < 4; ++nt) { acc[rt][nt] = __builtin_amdgcn_mfma_f32_16x16x32_bf16(xh, wh[nt], acc[rt][nt], 0, 0, 0);
                    acc[rt][nt] = __builtin_amdgcn_mfma_f32_16x16x32_bf16(xl, wh[nt], acc[rt][nt], 0, 0, 0); acc[rt][nt] = __builtin_amdgcn_mfma_f32_16x16x32_bf16(xh, wl[nt], acc[rt][nt], 0, 0, 0); } }
            __builtin_amdgcn_sched_barrier(0);
            if (st + 1 < 8) M1_LOADW(st + 1);
            if ((st & 1) == 1 && (st >> 1) + 2 < 4) M1_LOADY((st >> 1) + 2);
            __builtin_amdgcn_sched_barrier(0);
        }
#undef M1_LOADY
#undef M1_LOADW
#pragma unroll
        for (int rt = 0; rt < 4; ++rt)
#pragma unroll
            for (int nt = 0; nt < 4; ++nt)
#pragma unroll
                for (int i = 0; i < 4; ++i) P[(w * 64 + 16 * rt + 4 * q + i) * 64 + 16 * nt + r] = acc[rt][nt][i];
        __syncthreads();
        const float rb = RB[lane];
        LAS int* Pi = (LAS int*)P;
#pragma unroll 1
        for (int rr = 0; rr < 8; ++rr) { const int rl = 8 * w + rr;
            float lg = ((P[rl * 64 + lane] + P[(64 + rl) * 64 + lane]) + (P[(128 + rl) * 64 + lane] + P[(192 + rl) * 64 + lane])) + ((P[(256 + rl) * 64 + lane] + P[(320 + rl) * 64 + lane]) + (P[(384 + rl) * 64 + lane] + P[(448 + rl) * 64 + lane]));
            lg = (lg == lg) ? lg : -1.0e30f;
            const float sc = 1.0f / (1.0f + __expf(-lg)); const float ch = sc + rb;
            const float m1 = gmax8(ch), neq = gsum8(ch == m1 ? 1.f : 0.f), m2c = gmax8(ch < m1 ? ch : -INFINITY);
            const float gs = m1 + (neq >= 2.f ? m1 : m2c);
            int grk = 0; const int g = lane >> 3;
#pragma unroll
            for (int hh = 0; hh < 8; ++hh) { const float gh = rl_f(gs, 8 * hh); grk += (gh > gs || (gh == gs && hh < g)) ? 1 : 0; }
            const float msk = grk < 4 ? ch : -INFINITY;
            float cur = msk, ssum = 0.f; int erk = 64;
#pragma unroll 1
            for (int k = 0; k < 8; ++k) {
                float rm = gmax8(cur); rm = fmaxf(rm, dppf<0x140>(rm));
                const float wm = fmaxf(fmaxf(rl_f(rm, 0), rl_f(rm, 16)), fmaxf(rl_f(rm, 32), rl_f(rm, 48)));
                const unsigned long long bal = __builtin_amdgcn_ballot_w64(cur == wm);
                const int lsel = __builtin_amdgcn_readfirstlane((int)__builtin_ctzll(bal));
                ssum += rl_f(sc, lsel);
                const bool me = lane == lsel; erk = me ? k : erk; cur = me ? -INFINITY : cur; }
            const bool on = erk < 8;
            int pk_ = -1; if (on) pk_ = __hip_atomic_fetch_add(&hist[lane], 1, __ATOMIC_RELAXED, __HIP_MEMORY_SCOPE_WORKGROUP) | (erk << 16);
            P[rl * 64 + lane] = sc / ssum * 2.5f; Pi[(64 + rl) * 64 + lane] = pk_; }
        __syncthreads();
        if (tid < 64) { int tt = tid; asm volatile("" : "+v"(tt));
            const int hc = hist[tt]; int bs = 0; if (hc > 0) bs = (int)atomicAdd(&cnt[tt * 16], (unsigned)hc); basep[tt] = bs; }
        __syncthreads();
        { const int bl = basep[lane];
#pragma unroll 1
          for (int rr = 0; rr < 8; ++rr) { const int rl = 8 * w + rr; const int pk_ = Pi[(64 + rl) * 64 + lane]; const float gt_ = P[rl * 64 + lane];
            if (pk_ >= 0) { const int t = row0 + rl, pos = bl + (pk_ & 0xffff), rk_ = pk_ >> 16;
                ltok[(size_t)lane * CAP + pos] = t * 8 + rk_; lgate[(size_t)lane * CAP + pos] = gt_;
                eidx[t * 8 + rk_] = lane; inv[t * 8 + rk_] = pos; } } }
    }
}

constexpr int M3_PL = 131072, M3_CNT = 147456, M3_OFF = 147456 + 272;
__device__ __forceinline__ void phase_moe3n(const Frame& F, const bf16* H, const bf16* HSp, const int* eidx, const bf16* WD, const bf16* WSD,
                                            const float* Y1, const float* ST1, const float* g1, const float* b1, float* Y2, float* PST2) {
    LAS int* out = (LAS int*)F.lds; LAS unsigned short* plist = (LAS unsigned short*)(F.lds + M3_PL); LAS int* cnt = (LAS int*)(F.lds + M3_CNT); LAS int* off = (LAS int*)(F.lds + M3_OFF);
    const int tid = F.tid, lane = F.lane, w = F.wave, r = lane & 15, q = lane >> 4;
    for (int u = F.bid; u < 1024; u += F.G) {
        int nc = (u & 7) | ((u >> 7) << 3), tb = (u >> 3) & 15;
        if (F.G == 256) { const int i = u >> 8, x = u & 7, j = (u >> 3) & 31; tb = 2 * x + (i >> 1); nc = 32 * (i & 1) + j; }
        __syncthreads();
#pragma unroll
        for (int j = 0; j < 16; ++j) ((LAS v4u*)out)[tid + 512 * j] = (v4u){0u, 0u, 0u, 0u};
        if (tid < 66) cnt[tid] = 0;
        __syncthreads();
        int ee[16], pp[16];
        { const v4u* ep = (const v4u*)(eidx + ((size_t)tb * 1024 + 2 * tid) * 8); const v4u e0 = ep[0], e1 = ep[1], e2 = ep[2], e3 = ep[3];
          ee[0] = e0.x; ee[1] = e0.y; ee[2] = e0.z; ee[3] = e0.w; ee[4] = e1.x; ee[5] = e1.y; ee[6] = e1.z; ee[7] = e1.w;
          ee[8] = e2.x; ee[9] = e2.y; ee[10] = e2.z; ee[11] = e2.w; ee[12] = e3.x; ee[13] = e3.y; ee[14] = e3.z; ee[15] = e3.w; }
#pragma unroll
        for (int j = 0; j < 16; ++j) pp[j] = __hip_atomic_fetch_add(&cnt[ee[j]], 1, __ATOMIC_RELAXED, __HIP_MEMORY_SCOPE_WORKGROUP);
        __syncthreads();
        if (w == 0) { int c = cnt[lane], x = c;
#pragma unroll
            for (int o = 1; o < 64; o <<= 1) { const int y = __builtin_amdgcn_ds_bpermute(((lane - o) & 63) << 2, x); if (lane >= o) x += y; }
            off[lane] = x - c; if (lane == 63) off[64] = x; }
        __syncthreads();
#pragma unroll
        for (int j = 0; j < 16; ++j) plist[off[ee[j]] + pp[j]] = (unsigned short)(tid * 16 + j);
        __syncthreads();
        const char* Hb = (const char*)H + (size_t)tb * 8192 * 256 + q * 16;
        const char* HSb = (const char*)HSp + (size_t)tb * 1024 * 512 + q * 16;
        const char* Bb = (const char*)WD + ((size_t)nc * 32 + r) * 256 + q * 16;
        const char* BSb = (const char*)WSD + ((size_t)nc * 32 + r) * 512 + q * 16;
#define M3_NR(sg) ((sg) < 8 ? __builtin_amdgcn_readfirstlane(cnt[w + 8 * (sg)]) : 128)
#define M3_RB(sg) ((sg) < 8 ? __builtin_amdgcn_readfirstlane(off[w + 8 * (sg)]) : 0)
#define M3_GLD(dst, ptr, OFF) asm volatile("global_load_dwordx4 %0, %1, off offset:" #OFF : "=&v"(dst) : "v"(ptr) : "memory")
#define M3_LOADB(dst, sg) do { const char* _b0 = (sg) < 8 ? Bb + (size_t)(w + 8 * (sg)) * 524288 : BSb + ((sg) - 8) * 256; const char* _b1 = _b0 + ((sg) < 8 ? 4096 : 8192); \
            M3_GLD(dst[0][0], _b0, 0); M3_GLD(dst[0][1], _b0, 64); M3_GLD(dst[0][2], _b0, 128); M3_GLD(dst[0][3], _b0, 192); \
            M3_GLD(dst[1][0], _b1, 0); M3_GLD(dst[1][1], _b1, 64); M3_GLD(dst[1][2], _b1, 128); M3_GLD(dst[1][3], _b1, 192); } while (0)
#define M3_LOADA(dst, sg, bb, nr, rbs) do { int _i = 16 * (bb) + r; _i = _i < (nr) ? _i : (nr) - 1; const unsigned _rid = plist[(rbs) + _i]; \
            const char* _a = (sg) < 8 ? Hb + (size_t)_rid * 256 : ((sg) < 10 ? HSb + (size_t)(128 * w + _i) * 512 + ((sg) - 8) * 256 : Hb); \
            M3_GLD(dst[0], _a, 0); M3_GLD(dst[1], _a, 64); M3_GLD(dst[2], _a, 128); M3_GLD(dst[3], _a, 192); } while (0)
#define M3_ADV(sg, bb, nr, rbs) do { if ((sg) < 10) { ++(bb); if ((bb) * 16 >= (nr)) { (bb) = 0; do { ++(sg); } while ((sg) < 8 && M3_NR(sg) == 0); if ((sg) < 10) { (nr) = M3_NR(sg); (rbs) = M3_RB(sg); } } } } while (0)
#define M3_WAITA(AS) asm volatile("s_waitcnt vmcnt(12)" : "+v"(AS[0]), "+v"(AS[1]), "+v"(AS[2]), "+v"(AS[3]) :: "memory")
#define M3_WAITB(N) asm volatile("s_waitcnt vmcnt(" #N ")" : "+v"(Bn[0][0]), "+v"(Bn[0][1]), "+v"(Bn[0][2]), "+v"(Bn[0][3]), "+v"(Bn[1][0]), "+v"(Bn[1][1]), "+v"(Bn[1][2]), "+v"(Bn[1][3]) :: "memory")
#define M3_STEP(AS) if (cseg < 10) { \
              \
            int tk[4]; bool ok[4]; unsigned pl[4]; const int rt_ = cseg < 8; \
            _Pragma("unroll") for (int i = 0; i < 4; ++i) { const int idx = 16 * cbt + 4 * q + i; ok[i] = idx < cnr; const int ic = ok[i] ? idx : cnr - 1; pl[i] = plist[crbs + ic]; tk[i] = 128 * w + ic; } \
            _Pragma("unroll") for (int i = 0; i < 4; ++i) tk[i] = rt_ ? (int)(pl[i] >> 3) : tk[i]; \
            M3_WAITA(AS); \
            f32x4 acc[2]; \
            _Pragma("unroll") for (int nt = 0; nt < 2; ++nt) { acc[nt] = (f32x4){0.f, 0.f, 0.f, 0.f}; \
                _Pragma("unroll") for (int kk = 0; kk < 4; ++kk) acc[nt] = __builtin_amdgcn_mfma_f32_16x16x32_bf16(__builtin_bit_cast(bf16x8, AS[kk]), __builtin_bit_cast(bf16x8, Bc[nt][kk]), acc[nt], 0, 0, 0); } \
              \
            _Pragma("unroll") for (int i = 0; i < 4; ++i) { const long long lo_ = ok[i] ? (long long)__float2int_rn(acc[0][i] * 4194304.0f) : 0ll, hi_ = ok[i] ? (long long)__float2int_rn(acc[1][i] * 4194304.0f) : 0ll; \
                (void)__hip_atomic_fetch_add((LAS unsigned long long*)out + tk[i] * 16 + r, (unsigned long long)((hi_ << 32) + lo_), __ATOMIC_RELAXED, __HIP_MEMORY_SCOPE_WORKGROUP); } \
            M3_LOADA(AS, pseg, pbt, pnr, prbs); M3_ADV(pseg, pbt, pnr, prbs); \
            { const int old_ = cseg, nbat_ = (cnr + 15) >> 4; M3_ADV(cseg, cbt, cnr, crbs); \
              if (cseg != old_ && cseg < 10) { \
                  if (nbat_ == 1) M3_WAITB(4); else if (nbat_ == 2) M3_WAITB(8); else if (nbat_ == 3) M3_WAITB(12); else M3_WAITB(16); \
                  _Pragma("unroll") for (int nt = 0; nt < 2; ++nt) _Pragma("unroll") for (int kk = 0; kk < 4; ++kk) Bc[nt][kk] = Bn[nt][kk]; \
                  int nb_ = cseg; do { ++nb_; } while (nb_ < 8 && M3_NR(nb_) == 0); if (nb_ >= 10) nb_ = 9; M3_LOADB(Bn, nb_); } } }
        int cseg = -1, cbt = 0, cnr = 0, crbs = 0;
        do { ++cseg; } while (cseg < 8 && M3_NR(cseg) == 0);
        cnr = M3_NR(cseg); crbs = M3_RB(cseg);
        int pseg = cseg, pbt = 0, pnr = cnr, prbs = crbs;
        v4u Bc[2][4], Bn[2][4], A0[4], A1[4], A2[4], A3[4];
        M3_LOADB(Bc, cseg);
        M3_LOADA(A0, pseg, pbt, pnr, prbs); M3_ADV(pseg, pbt, pnr, prbs);
        M3_LOADA(A1, pseg, pbt, pnr, prbs); M3_ADV(pseg, pbt, pnr, prbs);
        M3_LOADA(A2, pseg, pbt, pnr, prbs); M3_ADV(pseg, pbt, pnr, prbs);
        M3_LOADA(A3, pseg, pbt, pnr, prbs); M3_ADV(pseg, pbt, pnr, prbs);
        { int nb_ = cseg; do { ++nb_; } while (nb_ < 8 && M3_NR(nb_) == 0); if (nb_ >= 10) nb_ = 9; M3_LOADB(Bn, nb_); }
        asm volatile("s_waitcnt vmcnt(0)" : "+v"(Bc[0][0]), "+v"(Bc[0][1]), "+v"(Bc[0][2]), "+v"(Bc[0][3]), "+v"(Bc[1][0]), "+v"(Bc[1][1]), "+v"(Bc[1][2]), "+v"(Bc[1][3]) :: "memory");
#pragma unroll 1
        while (cseg < 10) { M3_STEP(A0) M3_STEP(A1) M3_STEP(A2) M3_STEP(A3) }
        asm volatile("s_waitcnt vmcnt(0)" : "+v"(A0[0]), "+v"(A0[1]), "+v"(A0[2]), "+v"(A0[3]), "+v"(A1[0]), "+v"(A1[1]), "+v"(A1[2]), "+v"(A1[3]), "+v"(A2[0]), "+v"(A2[1]), "+v"(A2[2]), "+v"(A2[3]),
                     "+v"(A3[0]), "+v"(A3[1]), "+v"(A3[2]), "+v"(A3[3]), "+v"(Bn[0][0]), "+v"(Bn[0][1]), "+v"(Bn[0][2]), "+v"(Bn[0][3]), "+v"(Bn[1][0]), "+v"(Bn[1][1]), "+v"(Bn[1][2]), "+v"(Bn[1][3]) :: "memory");
#undef M3_NR
#undef M3_RB
#undef M3_GLD
#undef M3_LOADB
#undef M3_LOADA
#undef M3_ADV
#undef M3_WAITA
#undef M3_WAITB
#undef M3_STEP
        __syncthreads();
        { const int c4 = lane & 7, rs = lane >> 3, col = nc * 32 + 4 * c4;
          const f32x4 gv = *(const f32x4*)(g1 + col), bv = *(const f32x4*)(b1 + col);
#pragma unroll 4
          for (int it = 0; it < 16; ++it) { const int rl = 128 * w + 8 * it + rs; const size_t row = (size_t)tb * 1024 + rl;
              const f32x4 yv = *(const f32x4*)(Y1 + row * D + col); const f32x2 sv = *(const f32x2*)(ST1 + 2 * row);
              f32x4 tv; { const int nt = c4 >> 2, r0 = (4 * c4) & 15;
#pragma unroll
                  for (int j = 0; j < 4; ++j) { const v2u cell = *(const LAS v2u*)(out + rl * 32 + 2 * (r0 + j)); const int lo = (int)cell.x, hi = (int)cell.y + (lo < 0 ? 1 : 0); tv[j] = (float)(nt ? hi : lo) * (1.0f / 4194304.0f); } }
              const f32x4 y = ((yv - sv.x) * sv.y * gv + bv) * ALPHA + tv;
              *(f32x4*)(Y2 + row * D + col) = y;
              float sm = (y[0] + y[1]) + (y[2] + y[3]), sq = (y[0] * y[0] + y[1] * y[1]) + (y[2] * y[2] + y[3] * y[3]);
#pragma unroll
              for (int o = 1; o < 8; o <<= 1) { sm += shfl_x(sm, o, lane); sq += shfl_x(sq, o, lane); }
              if (c4 == 0) *(f32x2*)(PST2 + (row * 64 + nc) * 2) = (f32x2){sm, sq}; } }
    }
}

__device__ __forceinline__ void phase_moe4n(const Frame& F, const float* Y2, const float* pst, const float* gain, const float* bias, float* ST2, bf16* XBo, float* OUT, int last) {
    const int gw = F.bid * 8 + F.wave, NGW = F.G * 8, lane = F.lane;
    for (int t = gw; t < T; t += NGW) {
        f32x4 v[8];
#pragma unroll
        for (int j = 0; j < 8; ++j) v[j] = *(const f32x4*)(Y2 + (size_t)t * D + 4 * lane + 256 * j);
        const f32x2 pv = *(const f32x2*)(pst + ((size_t)t * 64 + lane) * 2);
        const float mean = wave_sum(pv.x, lane) * (1.0f / D); const float var = fmaxf(wave_sum(pv.y, lane) * (1.0f / D) - mean * mean, 0.f); const float rstd = 1.0f / sqrtf(var + LN_EPS);
        if (lane == 0) *(f32x2*)(ST2 + 2 * (size_t)t) = (f32x2){mean, rstd};
#pragma unroll
        for (int j = 0; j < 8; ++j) { const int c = 4 * lane + 256 * j; const f32x4 o = (v[j] - mean) * rstd * *(const f32x4*)(gain + c) + *(const f32x4*)(bias + c);
            if (last) *(f32x4*)(OUT + (size_t)t * D + c) = o;
            else { v2u wb; wb.x = pk2(o[0], o[1]); wb.y = pk2(o[2], o[3]); *(v2u*)(XBo + (size_t)t * D + c) = wb; } }
    }
}


__device__ __forceinline__ void phase_moe4q(const Frame& F, const bf16* X1, bf16* Y2, const unsigned char* Yq, const float* Ysc, const int* eidx, const int* inv, const float* gain, const float* bias, float* ST2, bf16* XBo, float* OUT, int last) {
    const LAS int* tpref = (const LAS int*)(F.lds + LDS_TAB);
    const int gw = F.bid * 8 + F.wave, NGW = F.G * 8, lane = F.lane;
    int en = 0, pn = 0; if (lane < 8 && gw < T) { en = eidx[gw * 8 + lane]; pn = inv[gw * 8 + lane]; }
    for (int t = gw; t < T; t += NGW) {
        int rowi = 0; if (lane < 8) rowi = tpref[en] * 256 + pn; else if (lane < 10) rowi = tpref[56 + lane] * 256 + t;
        if (lane < 8 && t + NGW < T) { en = eidx[(t + NGW) * 8 + lane]; pn = inv[(t + NGW) * 8 + lane]; }
        v4u pv[2][2], yv[10][2]; float sc[10][2];
#pragma unroll
        for (int j = 0; j < 2; ++j) { pv[j][0] = __builtin_nontemporal_load((const v4u*)(X1 + (size_t)t * D + 16 * lane + 1024 * j)); pv[j][1] = __builtin_nontemporal_load((const v4u*)(X1 + (size_t)t * D + 16 * lane + 1024 * j + 8)); }
#pragma unroll
        for (int k = 0; k < 10; ++k) { const size_t row = (size_t)__builtin_amdgcn_readlane(rowi, k);
#pragma unroll
            for (int j = 0; j < 2; ++j) { yv[k][j] = __builtin_nontemporal_load((const v4u*)(Yq + row * D + 16 * lane + 1024 * j)); sc[k][j] = __builtin_nontemporal_load(Ysc + row * 16 + 8 * j + (lane >> 3)); } }
#pragma unroll
        for (int k = 0; k < 10; ++k) asm volatile("" : "+v"(yv[k][0]), "+v"(yv[k][1]), "+v"(sc[k][0]), "+v"(sc[k][1]));
        float v[2][16];
#pragma unroll
        for (int j = 0; j < 2; ++j) { float f0[8], f1[8]; unpack8(pv[j][0], f0); unpack8(pv[j][1], f1);
            const float ss = (((sc[0][j] + sc[1][j]) + (sc[2][j] + sc[3][j])) + ((sc[4][j] + sc[5][j]) + (sc[6][j] + sc[7][j]))) + (sc[8][j] + sc[9][j]);
#pragma unroll
            for (int i = 0; i < 8; ++i) { v[j][i] = ALPHA * f0[i] - 128.f * ss; v[j][8 + i] = ALPHA * f1[i] - 128.f * ss; } }
#pragma unroll
        for (int k = 0; k < 10; ++k)
#pragma unroll
            for (int j = 0; j < 2; ++j) { const float s_ = sc[k][j]; const unsigned q[4] = {yv[k][j].x, yv[k][j].y, yv[k][j].z, yv[k][j].w};
#pragma unroll
                for (int d = 0; d < 4; ++d) { v[j][4 * d + 0] += s_ * (float)(q[d] & 0xffu); v[j][4 * d + 1] += s_ * (float)((q[d] >> 8) & 0xffu); v[j][4 * d + 2] += s_ * (float)((q[d] >> 16) & 0xffu); v[j][4 * d + 3] += s_ * (float)(q[d] >> 24); } }
        float sm = 0.f;
#pragma unroll
        for (int j = 0; j < 2; ++j)
#pragma unroll
            for (int i = 0; i < 16; i += 4) sm += (v[j][i] + v[j][i + 1]) + (v[j][i + 2] + v[j][i + 3]);
        const float mean = wave_sum(sm, lane) * (1.0f / D); float sq = 0.f;
#pragma unroll
        for (int j = 0; j < 2; ++j)
#pragma unroll
            for (int i = 0; i < 16; ++i) { const float d = v[j][i] - mean; sq += d * d; }
        const float rstd = 1.0f / sqrtf(wave_sum(sq, lane) * (1.0f / D) + LN_EPS);
        (void)ST2; (void)Y2;
#pragma unroll
        for (int j = 0; j < 2; ++j)
#pragma unroll
            for (int h = 0; h < 2; ++h) { const int c = 16 * lane + 1024 * j + 8 * h; const float* vv = &v[j][8 * h];
                const f32x4 g0 = *(const f32x4*)(gain + c), g1 = *(const f32x4*)(gain + c + 4), b0 = *(const f32x4*)(bias + c), b1 = *(const f32x4*)(bias + c + 4);
                const f32x4 o0 = ((f32x4){vv[0], vv[1], vv[2], vv[3]} - mean) * rstd * g0 + b0, o1 = ((f32x4){vv[4], vv[5], vv[6], vv[7]} - mean) * rstd * g1 + b1;
                if (last) { *(f32x4*)(OUT + (size_t)t * D + c) = o0; *(f32x4*)(OUT + (size_t)t * D + c + 4) = o1; }
                else { v4u wb; wb.x = pk2(o0[0], o0[1]); wb.y = pk2(o0[2], o0[3]); wb.z = pk2(o1[0], o1[1]); wb.w = pk2(o1[2], o1[3]); *(v4u*)(XBo + (size_t)t * D + c) = wb; } }
    }
}

__device__ __forceinline__ void phase_downproj3(const Frame& F, const bf16* H, const bf16* WD, const bf16* HSp, const bf16* WSD, unsigned char* Yq, float* Ysc, int NT) {
    const LAS int* tpref = (const LAS int*)(F.lds + LDS_TAB); const LAS int* cl = (const LAS int*)(F.lds + LDS_TAB + 512);
    LAS unsigned char* lds = F.lds;
    const int tid = F.tid, lane = F.lane, w = F.wave, fr = lane & 15, fq = lane >> 4;
    unsigned rbB[2], cbB[2];
#pragma unroll
    for (int i = 0; i < 2; ++i) { int R_, C_; g8::stage_rc(tid * 16 + i * 8192, R_, C_); rbB[i] = (unsigned)((R_ & ~31) + g8::perm32(R_ & 31)); cbB[i] = (unsigned)C_ * 2u; }
    const unsigned ldsw = (unsigned)w * 1024u, lbase = (unsigned)(size_t)lds;
    int boffg[4];
#pragma unroll
    for (int g = 0; g < 4; ++g) boffg[g] = g8::lds_byte(32 * g + fr, fq * 8);
    LAS unsigned char* stg = lds + 65536 + w * (32 * 144);
    const int NU = NT * 4;
    const int upos = (F.G % 8) == 0 ? (F.bid & 7) * (F.G >> 3) + (F.bid >> 3) : F.bid;
    int ub = 0;
    int u = (F.G <= NU) ? upos : F.bid; if (u >= NU) return;
#define DP3_UNITINFO(uu, E0, EXP, NV) do { const int tl_ = (uu) >> 2; int e_ = (E0); while (__builtin_amdgcn_readfirstlane(tpref[e_ + 1]) <= tl_) ++e_; EXP = e_; \
        NV = __builtin_amdgcn_readfirstlane(cl[e_]) - (tl_ - __builtin_amdgcn_readfirstlane(tpref[e_])) * 256; } while (0)
#define DP3_GLDS(gsrc, ldsdst) do { unsigned keep_; asm volatile("s_mov_b32 %0, m0\n\ts_mov_b32 m0, %2\n\ts_nop 0\n\tglobal_load_lds_dwordx4 %1, off\n\ts_mov_b32 m0, %0" : "=&s"(keep_) : "v"(gsrc), "s"(ldsdst) : "memory"); } while (0)
#define DP3_STAGE(slot, gb, bs) do { const unsigned v0_ = rbB[0] * (unsigned)(bs) + cbB[0], v1_ = rbB[1] * (unsigned)(bs) + cbB[1]; _Pragma("unroll") for (int kt = 0; kt < 2; ++kt) { \
        DP3_GLDS((const void*)((gb) + kt * 128 + v0_), lbase + (unsigned)((slot) * 32768 + kt * 16384) + ldsw); \
        DP3_GLDS((const void*)((gb) + kt * 128 + v1_), lbase + (unsigned)((slot) * 32768 + kt * 16384) + ldsw + 8192u); } } while (0)
#define DP3_SRC(uu, ee, AB, AS, BB, BS) do { const int tl_ = (uu) >> 2, cu_ = ((uu) & 3) * 512; \
        if ((ee) < 64) { AB = (const char*)(H + (size_t)tl_ * 256 * EDIM); AS = EDIM * 2; BB = (const char*)(WD + (size_t)(ee) * D * EDIM + (size_t)cu_ * EDIM); BS = EDIM * 2; } \
        else { const int t0_ = (tl_ - __builtin_amdgcn_readfirstlane(tpref[ee])) * 256; AB = (const char*)(HSp + (size_t)t0_ * SDIM + ((ee) - 64) * EDIM); AS = SDIM * 2; \
               BB = (const char*)(WSD + (size_t)cu_ * SDIM + ((ee) - 64) * EDIM); BS = SDIM * 2; } } while (0)
    int ecur, nvcur; DP3_UNITINFO(u, 0, ecur, nvcur);
    const char* abc; const char* gbc; int asc, bsc; DP3_SRC(u, ecur, abc, asc, gbc, bsc);
    bf16x8 A[2][4], An[2][4];
    { const char* ap_ = abc + (size_t)(32 * w + fr) * asc + 16 * fq;
#pragma unroll
      for (int m = 0; m < 2; ++m)
#pragma unroll
          for (int kk = 0; kk < 4; ++kk) A[m][kk] = *(const bf16x8*)(ap_ + (size_t)m * 16 * asc + 64 * kk); }
    DP3_STAGE(0, gbc, bsc);
    asm volatile("s_waitcnt vmcnt(0)" ::: "memory");
#pragma unroll 1
    for (;;) {
        int un = u; { const int nb = ub + F.G; if (nb + F.G <= NU) un = nb + upos; else if (nb + F.bid < NU) un = nb + F.bid; if (un != u) ub = nb; }
        int enx, nvnx; DP3_UNITINFO(un, (un > u ? ecur : 0), enx, nvnx);
        const char* abn; const char* gbn; int asn, bsn; DP3_SRC(un, enx, abn, asn, gbn, bsn);
        const int tile = u >> 2, colu = (u & 3) * 512;
        float scq[2][4];
#pragma unroll
        for (int c = 0; c < 4; ++c) {
            if (c == 0) asm volatile("s_waitcnt vmcnt(5)" ::: "memory"); else asm volatile("s_waitcnt vmcnt(4)" ::: "memory");
            __builtin_amdgcn_s_barrier();
            if (c == 3) { const char* ap_ = abn + (size_t)(32 * w + fr) * asn + 16 * fq;
#pragma unroll
                for (int m = 0; m < 2; ++m) { const char* am_ = ap_ + (size_t)m * 16 * asn;
                    asm volatile("global_load_dwordx4 %0, %1, off" : "=&v"(An[m][0]) : "v"(am_) : "memory"); asm volatile("global_load_dwordx4 %0, %1, off offset:64" : "=&v"(An[m][1]) : "v"(am_) : "memory");
                    asm volatile("global_load_dwordx4 %0, %1, off offset:128" : "=&v"(An[m][2]) : "v"(am_) : "memory"); asm volatile("global_load_dwordx4 %0, %1, off offset:192" : "=&v"(An[m][3]) : "v"(am_) : "memory"); } }
            { const char* gnext = (c < 3) ? gbc + (size_t)(c + 1) * 128 * bsc : gbn; const int bnext = (c < 3) ? bsc : bsn; DP3_STAGE((c + 1) & 1, gnext, bnext); }
            __builtin_amdgcn_sched_barrier(0);
            f32x4 acc[2][4][2];
#pragma unroll
            for (int g = 0; g < 4; ++g) { bf16x8 Bf[2][4];
#pragma unroll
                for (int n = 0; n < 2; ++n)
#pragma unroll
                    for (int kk = 0; kk < 4; ++kk) Bf[n][kk] = *(const LAS bf16x8*)(lds + (c & 1) * 32768 + (kk >> 1) * 16384 + boffg[g] + n * 2048 + (kk & 1) * 1024);
#pragma unroll
                for (int m = 0; m < 2; ++m)
#pragma unroll
                    for (int n = 0; n < 2; ++n) { acc[m][g][n] = (f32x4){0.f, 0.f, 0.f, 0.f};
#pragma unroll
                        for (int kk = 0; kk < 4; ++kk) acc[m][g][n] = __builtin_amdgcn_mfma_f32_16x16x32_bf16(Bf[n][kk], A[m][kk], acc[m][g][n], 0, 0, 0); } }
#pragma unroll
            for (int m = 0; m < 2; ++m) {
                float am0 = 0.f, am1 = 0.f;
#pragma unroll
                for (int g = 0; g < 4; ++g)
#pragma unroll
                    for (int n = 0; n < 2; ++n) { am0 = fmaxf(fmaxf(am0, fabsf(acc[m][g][n][0])), fabsf(acc[m][g][n][1])); am1 = fmaxf(fmaxf(am1, fabsf(acc[m][g][n][2])), fabsf(acc[m][g][n][3])); }
                float am = fmaxf(am0, am1);
                am = fmaxf(am, shfl_x(am, 16, lane)); am = fmaxf(am, shfl_x(am, 32, lane));
                am = fminf(am, 3.0e38f);
                const float isc = am > 0.f ? 127.0f * __builtin_amdgcn_rcpf(am) : 0.f;
                scq[m][c] = am * (1.0f / 127.0f);
                const f32x2_t isc2 = (f32x2_t){isc, isc}, mg2 = (f32x2_t){8388736.0f, 8388736.0f};
#pragma unroll
                for (int g = 0; g < 4; ++g) { unsigned qd[2];
#pragma unroll
                    for (int n = 0; n < 2; ++n) {
                        const f32x2_t tl = __builtin_elementwise_fma((f32x2_t){acc[m][g][n][0], acc[m][g][n][1]}, isc2, mg2), th = __builtin_elementwise_fma((f32x2_t){acc[m][g][n][2], acc[m][g][n][3]}, isc2, mg2);
                        const float f0_ = tl.x, f1_ = tl.y, f2_ = th.x, f3_ = th.y;
                        qd[n] = __builtin_amdgcn_perm(__builtin_bit_cast(unsigned, f1_), __builtin_bit_cast(unsigned, f0_), 0x0c0c0400u) | __builtin_amdgcn_perm(__builtin_bit_cast(unsigned, f3_), __builtin_bit_cast(unsigned, f2_), 0x04000c0cu); }
                    *(LAS v2u*)(stg + (16 * m + fr) * 144 + 32 * g + 8 * fq) = (v2u){qd[0], qd[1]}; } }
#pragma unroll
            for (int it = 0; it < 4; ++it) { const int rr = 8 * it + (lane >> 3);
                const v4u o = *(const LAS v4u*)(stg + rr * 144 + (lane & 7) * 16);
                __builtin_nontemporal_store(o, (v4u*)(Yq + (size_t)(tile * 256 + 32 * w + rr) * D + colu + 128 * c + 16 * (lane & 7))); }
            if (c == 3) { const f32x4 so = fq == 0 ? (f32x4){scq[0][0], scq[0][1], scq[0][2], scq[0][3]} : (f32x4){scq[1][0], scq[1][1], scq[1][2], scq[1][3]};
                if (fq < 2) __builtin_nontemporal_store(so, (f32x4*)(Ysc + (size_t)(tile * 256 + 32 * w + 16 * fq + fr) * 16 + (colu >> 7))); }
            __builtin_amdgcn_sched_barrier(0);
        }
        asm volatile("s_waitcnt vmcnt(9)" : "+v"(An[0][0]), "+v"(An[0][1]), "+v"(An[0][2]), "+v"(An[0][3]), "+v"(An[1][0]), "+v"(An[1][1]), "+v"(An[1][2]), "+v"(An[1][3]) :: "memory");
        if (un == u) break;
#pragma unroll
        for (int m = 0; m < 2; ++m)
#pragma unroll
            for (int kk = 0; kk < 4; ++kk) A[m][kk] = An[m][kk];
        u = un; ecur = enx; nvcur = nvnx; abc = abn; asc = asn; gbc = gbn; bsc = bsn;
    }
    asm volatile("s_waitcnt vmcnt(0)" ::: "memory");
#undef DP3_UNITINFO
#undef DP3_STAGE
#undef DP3_GLDS
#undef DP3_SRC
}

enum { PH_PRO = 0, PH_POOL_G1, PH_POOL_P, PH_POOL_G2, PH_POOL_G3, PH_DIL_G1, PH_DIL_ATT, PH_DIL_CMB, PH_DIL_G2, PH_CONV_G1, PH_CONV_E, PH_CONV_G2, PH_MOE1, PH_MOE2, PH_MOE3, PH_MOE4, PH_COUNT };

template <int PH>
__device__ __forceinline__ void run_phase(const Frame& Fin, const Args& args_, const int L) {
    Frame F = Fin; { int w_ = Fin.wave, l_; asm volatile("" : "+s"(w_)); asm volatile("v_mbcnt_lo_u32_b32 %0, -1, 0\n\tv_mbcnt_hi_u32_b32 %0, -1, %0" : "=v"(l_)); F.wave = w_; F.lane = l_; F.tid = w_ * 64 + l_; }
    unsigned char* ws; { GAS unsigned char* wsg = (GAS unsigned char*)Fin.ws; asm volatile("" : "+s"(wsg)); ws = (unsigned char*)wsg; } F.ws = ws; F.ctl = (unsigned*)(ws + WS_CTL);
    KP kp = (KP)__builtin_amdgcn_kernarg_segment_ptr(); asm volatile("" : "+s"(kp)); (void)args_;
    { unsigned l_ = (unsigned)(size_t)Fin.lds; asm volatile("" : "+s"(l_)); F.lds = (LAS unsigned char*)(size_t)l_; }
    LAS unsigned char* ring = F.lds; int c = (int)blockIdx.x; { int g_ = Fin.G; asm volatile("" : "+s"(c), "+s"(g_)); F.G = g_; F.bid = c; }
    const float* xres = ain(kp, IN_X);
    const float* st2 = (const float*)(ws + WS_ST2); float* pstp = (float*)(ws + WS_PST);
    const float* g2p = ain(kp, IN_LNG) + (size_t)((L > 0 ? L - 1 : 0) * 2 + 1) * D; const float* b2p = ain(kp, IN_LNB) + (size_t)((L > 0 ? L - 1 : 0) * 2 + 1) * D;
    const bf16* xb = (const bf16*)(ws + WS_XB);
    bf16* yf = (bf16*)(ws + WS_YF);
    unsigned char* big = ws + WS_BIG;
    const int ia = L / 3;
    if constexpr (PH == PH_PRO) { phase_prologue(F, kp); }
    if constexpr (PH == PH_POOL_G1) { g8::DenseSched S; S.init(xb, (const bf16*)(ws + WS_W_POOL_IN) + (size_t)ia * D * D, T, D, D, D, F.G, c);
        g8::EpiBf16 E{(bf16*)(big + BG_U), D, 0}; g8::gemm_phase<g8::EpiBf16, g8::DenseSched, false>(ring, F.tid, D, D, D, S, E); }
    if constexpr (PH == PH_POOL_P) { phase_pool(F, (const bf16*)(big + BG_U), (bf16*)(big + BG_PL)); }
    if constexpr (PH == PH_POOL_G2) { g8::DenseSched S; S.init((const bf16*)(big + BG_PL), (const bf16*)(ws + WS_W_POOL_G) + (size_t)ia * D * 512, T, D, D, 512, F.G, c); S.agrp_shift = 1; S.agrp_stride = 512 * 2;
        g8::EpiScaleBf16 E{(bf16*)(big + BG_MX), D, ain(kp, IN_PSC) + (size_t)ia * D}; g8::gemm_phase<g8::EpiScaleBf16, g8::DenseSched, false>(ring, F.tid, 512, D, 512, S, E); }
    if constexpr (PH == PH_POOL_G3) { g8::DenseSched S; S.init((const bf16*)(big + BG_MX), (const bf16*)(ws + WS_W_POOL_OUT) + (size_t)ia * D * D, T, D, D, D, F.G, c);
        g8::EpiResidLN E{xres, xb, st2, g2p, b2p, yf, pstp, 2}; g8::gemm_phase<g8::EpiResidLN, g8::DenseSched, false>(ring, F.tid, D, D, D, S, E); }
    if constexpr (PH == PH_DIL_G1) { g8::DenseSched S; S.init(xb, (const bf16*)(ws + WS_W_DIL_QKV), T, QKVC, D, D, F.G, c);
        g8::EpiBf16 E{(bf16*)(big + BG_QKV), QKVC, 1}; g8::gemm_phase<g8::EpiBf16, g8::DenseSched, false>(ring, F.tid, D, D, D, S, E); }
    if constexpr (PH == PH_DIL_ATT) { phase_attn(F, (const bf16*)(big + BG_QKV), ain(kp, IN_RELB), (bf16*)(big + BG_OG), (float*)(big + BG_LSE)); }
    if constexpr (PH == PH_DIL_CMB) { phase_combine(F, (const bf16*)(big + BG_OG), (const float*)(big + BG_LSE), (bf16*)(big + BG_O)); }
    if constexpr (PH == PH_DIL_G2) { g8::DenseSched S; S.init((const bf16*)(big + BG_O), (const bf16*)(ws + WS_W_DIL_OUT), T, D, DILW, DILW, F.G, c);
        g8::EpiResidLN E{xres, xb, st2, g2p, b2p, yf, pstp, 2}; g8::gemm_phase<g8::EpiResidLN, g8::DenseSched, false>(ring, F.tid, DILW, DILW, DILW, S, E); }
    if constexpr (PH == PH_CONV_G1) { g8::DenseSched S; S.init(xb, (const bf16*)(ws + WS_W_CONV_IN), T, 3 * D, D, D, F.G, c);
        g8::EpiConvIn E{(bf16*)(big + BG_UC), (bf16*)(big + BG_BG)}; g8::gemm_phase<g8::EpiConvIn, g8::DenseSched, false>(ring, F.tid, D, D, D, S, E); }
    if constexpr (PH == PH_CONV_E) { phase_conv(F, (const bf16*)(big + BG_UC), (const bf16*)(big + BG_BG), ain(kp, IN_CW), (bf16*)(big + BG_Z)); }
    if constexpr (PH == PH_CONV_G2) { g8::DenseSched S; S.init((const bf16*)(big + BG_Z), (const bf16*)(ws + WS_W_CONV_OUT), T, D, D, D, F.G, c);
        g8::EpiResidLN E{xres, xb, st2, g2p, b2p, yf, pstp, 2}; g8::gemm_phase<g8::EpiResidLN, g8::DenseSched, false>(ring, F.tid, D, D, D, S, E); }
    unsigned* cnt = F.ctl + CW_CNT + L * 64 * 16;
    float* x1f = (float*)(ws + WS_X1F); bf16* x1b = (bf16*)(ws + WS_X1B);
    int* ltok = (int*)(ws + WS_LTOK); float* lgate = (float*)(ws + WS_LGATE); int* eidx = (int*)(ws + WS_EIDX); int* inv = (int*)(ws + WS_INV);
    bf16* HB = (bf16*)(ws + WS_HB); bf16* HS = (bf16*)(ws + WS_HS); bf16* Yr = (bf16*)(ws + WS_BIG);
    if constexpr (PH == PH_MOE1) {
        const float* g1 = ain(kp, IN_LNG) + (size_t)(L * 2 + 0) * D; const float* b1 = ain(kp, IN_LNB) + (size_t)(L * 2 + 0) * D;
        phase_moe1n(F, yf, pstp, g1, b1, (const bf16*)(ws + WS_RWH) + (size_t)L * NEXP * D, (const bf16*)(ws + WS_RWL) + (size_t)L * NEXP * D, ain(kp, IN_RB) + (size_t)L * NEXP,
                    x1b, (float*)(ws + WS_ST1), cnt, ltok, lgate, eidx, inv); }
    if constexpr (PH == PH_MOE2) {
        const int NT = build_tiles(F, cnt);
        { g8::ExpertSched<1, true> S; S.tpref = (const LAS int*)(F.lds + LDS_TAB); S.cnt = (const LAS int*)(F.lds + LDS_TAB + 512); S.A = (const char*)x1b; S.B = (const char*)((const bf16*)(ws + WS_W_EX_GU) + (size_t)L * 64 * 256 * D);
          S.tok = ltok; S.b_exp = (size_t)256 * D * 2; S.b_tile = 0; S.a_tile = 0; S.NU = NT; S.G = F.G; S.c = c;
          g8::EpiExpertGU E{HB}; g8::gemm_phase<g8::EpiExpertGU, g8::ExpertSched<1, true>, true>(ring, F.tid, D, D, D, S, E); }
        { const int rot = (c - (NT % F.G) + F.G) % F.G;
          g8::DenseSched S; S.init(x1b, (const bf16*)(ws + WS_W_SH_GU) + (size_t)L * 512 * D, T, 512, D, D, F.G, rot);
          int t2 = F.tid; asm volatile("" : "+v"(t2));
          g8::EpiSharedGU E{HS}; g8::gemm_phase<g8::EpiSharedGU, g8::DenseSched, false>(ring, t2, D, D, D, S, E); } }
    if constexpr (PH == PH_MOE3) {
        const float* g1 = ain(kp, IN_LNG) + (size_t)(L * 2 + 0) * D; const float* b1 = ain(kp, IN_LNB) + (size_t)(L * 2 + 0) * D;
        const int NT = build_tiles(F, cnt);
        __syncthreads();
        phase_downproj3(F, HB, (const bf16*)(ws + WS_W_EX_D) + (size_t)L * 64 * D * EDIM, HS, (const bf16*)(ws + WS_W_SH_D) + (size_t)L * D * SDIM, (unsigned char*)Yr, (float*)(ws + WS_BIG + BG_YSC), NT + 2 * (T / 256));
        (void)g1; (void)b1; }
    if constexpr (PH == PH_MOE4) { (void)build_tiles(F, cnt);
        const float* g2 = ain(kp, IN_LNG) + (size_t)(L * 2 + 1) * D; const float* b2 = ain(kp, IN_LNB) + (size_t)(L * 2 + 1) * D;
        phase_moe4q(F, x1b, (bf16*)(ws + WS_Y2F), (const unsigned char*)Yr, (const float*)(ws + WS_BIG + BG_YSC), eidx, inv, g2, b2, (float*)(ws + WS_ST2), (bf16*)(ws + WS_XB), aout(kp), L == DEPTH - 1); }
}
__device__ __forceinline__ void make_frame(Frame& F, const Args& args) {
    extern __shared__ __attribute__((aligned(16))) unsigned char lds_raw[];
    F.lds = (LAS unsigned char*)lds_raw; F.ws = args.ws; F.ctl = (unsigned*)(args.ws + WS_CTL);
    F.tid = threadIdx.x; F.lane = F.tid & 63; F.wave = __builtin_amdgcn_readfirstlane(F.tid >> 6); F.G = gridDim.x; F.bid = blockIdx.x;
}
template <int PH> __global__ void __launch_bounds__(512, 2) k_phase(Args args, int L) {
    Frame F; make_frame(F, args);
    run_phase<PH>(F, args, L);
}

#ifndef MK_NOINLINE
#define MK_NOINLINE 0
#endif
#if MK_NOINLINE
template <int PH> __device__ __noinline__ void call_phase_ni(const int L) {
    Args dummy{}; Frame F;
    KP kp = (KP)__builtin_amdgcn_kernarg_segment_ptr();
    extern __shared__ __attribute__((aligned(16))) unsigned char lds_raw[];
    F.lds = (LAS unsigned char*)lds_raw; F.ws = (unsigned char*)((GAS unsigned char* const CAS*)kp)[20]; F.ctl = (unsigned*)(F.ws + WS_CTL);
    F.tid = threadIdx.x; F.lane = F.tid & 63; F.wave = __builtin_amdgcn_readfirstlane(F.tid >> 6); F.G = gridDim.x; F.bid = blockIdx.x;
    run_phase<PH>(F, dummy, L);
}
template <int PH> __device__ __forceinline__ void call_phase(const Frame& F, const Args& args, const int L) { call_phase_ni<PH>(L); }
#else
template <int PH> __device__ __forceinline__ void call_phase(const Frame& F, const Args& args, const int L) { asm volatile("; PHASE_BEGIN %0" :: "n"(PH)); run_phase<PH>(F, args, L); asm volatile("; PHASE_END %0" :: "n"(PH)); }
#endif
__global__ void __launch_bounds__(512, 2) fwd_all(Args args) {
    Frame F; make_frame(F, args);
    volatile LAS unsigned* misc = (volatile LAS unsigned*)(F.lds + LDS_MISC);
    if (F.tid < 4) misc[F.tid] = 0u;
    __syncthreads();
    const int lo = args.ph_lo, hi = args.ph_hi;
    XcdBarrier bar; bar.bar = F.ctl + CW_BAR; bar.x = 0; bar.st = misc;
    if (hi - lo > 1) bar = xcd_barrier_post(F.ctl + CW_BAR, misc);
    int pc = 0;
#ifndef MK_DUP_MASK
#define MK_DUP_MASK 0
#endif
#if MK_DUP_MASK
#define STEP(PH, Lx) do { if (pc >= lo && pc < hi) { int nrep_ = ((MK_DUP_MASK >> (PH)) & 1) ? 2 : 1; asm volatile("" : "+s"(nrep_)); _Pragma("unroll 1") for (int r_ = 0; r_ < nrep_; ++r_) { call_phase<PH>(F, args, Lx); if (r_ + 1 < nrep_ || pc + 1 < hi) xcd_barrier(bar); } } ++pc; } while (0)
#else
#define STEP(PH, Lx) do { if (pc >= lo && pc < hi) { call_phase<PH>(F, args, Lx); if (pc + 1 < hi) xcd_barrier(bar); } ++pc; } while (0)
#endif
    STEP(PH_PRO, 0);
#pragma unroll 1
    for (int L = 0; L < DEPTH; ++L) {
        const int kind = L % 3;
        if (kind == 0) { STEP(PH_POOL_G1, L); STEP(PH_POOL_P, L); STEP(PH_POOL_G2, L); STEP(PH_POOL_G3, L); }
        else if (kind == 1) { STEP(PH_DIL_G1, L); STEP(PH_DIL_ATT, L); STEP(PH_DIL_CMB, L); STEP(PH_DIL_G2, L); }
        else { STEP(PH_CONV_G1, L); STEP(PH_CONV_E, L); STEP(PH_CONV_G2, L); }
        STEP(PH_MOE1, L); STEP(PH_MOE2, L); STEP(PH_MOE3, L); STEP(PH_MOE4, L);
    }
#undef STEP
}
constexpr int N_STEPS = 1 + 2 * 8 + 8 + 7;

template <int PH> static void launch_phase(const Args& a, int L, int grid, hipStream_t stream) {
    static bool attr = false;
    if (!attr) { (void)hipFuncSetAttribute((const void*)k_phase<PH>, hipFuncAttributeMaxDynamicSharedMemorySize, LDS_BYTES); attr = true; }
    hipLaunchKernelGGL(k_phase<PH>, dim3(grid), dim3(512), LDS_BYTES, stream, a, L);
}
extern "C" void kernel_launch(void* const* d_in, const int* in_sizes, int n_in, void* d_out, int out_size, void* d_ws, size_t ws_size, hipStream_t stream) {
    static int grid = 0;
    if (grid == 0) {
        if (n_in != 19 || out_size != T * D || ws_size < WS_END) { fprintf(stderr, "kernel_launch: unexpected shapes (n_in %d out %d ws %zu need %zu)\n", n_in, out_size, ws_size, (size_t)WS_END); grid = -1; return; }
        int dev = 0, cus = 0;
        if (hipGetDevice(&dev) != hipSuccess || hipDeviceGetAttribute(&cus, hipDeviceAttributeMultiprocessorCount, dev) != hipSuccess) { grid = -1; return; }
#if MK_ONE_LAUNCH
        if (hipFuncSetAttribute((const void*)fwd_all, hipFuncAttributeMaxDynamicSharedMemorySize, LDS_BYTES) != hipSuccess) { fprintf(stderr, "kernel_launch: hipFuncSetAttribute failed\n"); grid = -1; return; }
        int per_cu = 0;
        if (hipOccupancyMaxActiveBlocksPerMultiprocessor(&per_cu, (const void*)fwd_all, 512, LDS_BYTES) != hipSuccess || per_cu < 1) { fprintf(stderr, "kernel_launch: note: occupancy query reports %d blocks per CU\n", per_cu); (void)hipGetLastError(); }
#endif
        grid = cus;
    }
    if (grid < 0) return;
    (void)hipMemsetAsync((char*)d_ws + WS_CTL, 0, CTL_ZERO_BYTES, stream);
    Args a{};
    for (int i = 0; i < 19; ++i) a.in[i] = (const float*)d_in[i];
    a.out = (float*)d_out; a.ws = (unsigned char*)d_ws; a.ph_lo = 0; a.ph_hi = 0;
#if MK_ONE_LAUNCH
#ifdef MK_SPLIT
    for (int p = 0; p < N_STEPS; ++p) { a.ph_lo = p; a.ph_hi = p + 1; hipLaunchKernelGGL(fwd_all, dim3(grid), dim3(512), LDS_BYTES, stream, a); }
#else
    a.ph_lo = 0; a.ph_hi = N_STEPS;
    hipLaunchKernelGGL(fwd_all, dim3(grid), dim3(512), LDS_BYTES, stream, a);
#endif
#elif defined(MK_HYBRID_MASK)
    {
        static bool attr2 = false; if (!attr2) { (void)hipFuncSetAttribute((const void*)fwd_all, hipFuncAttributeMaxDynamicSharedMemorySize, LDS_BYTES); attr2 = true; }
        int pc = 0;
#define HSTEP(PH, Lx) do { if ((MK_HYBRID_MASK >> (PH)) & 1) { a.ph_lo = pc; a.ph_hi = pc + 1; hipLaunchKernelGGL(fwd_all, dim3(grid), dim3(512), LDS_BYTES, stream, a); } else { a.ph_lo = 0; a.ph_hi = 0; launch_phase<PH>(a, Lx, grid, stream); } ++pc; } while (0)
        HSTEP(PH_PRO, 0);
        for (int L = 0; L < DEPTH; ++L) {
            const int kind = L % 3;
            if (kind == 0) { HSTEP(PH_POOL_G1, L); HSTEP(PH_POOL_P, L); HSTEP(PH_POOL_G2, L); HSTEP(PH_POOL_G3, L); }
            else if (kind == 1) { HSTEP(PH_DIL_G1, L); HSTEP(PH_DIL_ATT, L); HSTEP(PH_DIL_CMB, L); HSTEP(PH_DIL_G2, L); }
            else { HSTEP(PH_CONV_G1, L); HSTEP(PH_CONV_E, L); HSTEP(PH_CONV_G2, L); }
            HSTEP(PH_MOE1, L); HSTEP(PH_MOE2, L); HSTEP(PH_MOE3, L); HSTEP(PH_MOE4, L);
        }
#undef HSTEP
    }
#else
    launch_phase<PH_PRO>(a, 0, grid, stream);
    for (int L = 0; L < DEPTH; ++L) {
        const int kind = L % 3;
        if (kind == 0) { launch_phase<PH_POOL_G1>(a, L, grid, stream); launch_phase<PH_POOL_P>(a, L, grid, stream); launch_phase<PH_POOL_G2>(a, L, grid, stream); launch_phase<PH_POOL_G3>(a, L, grid, stream); }
        else if (kind == 1) { launch_phase<PH_DIL_G1>(a, L, grid, stream); launch_phase<PH_DIL_ATT>(a, L, grid, stream); launch_phase<PH_DIL_CMB>(a, L, grid, stream); launch_phase<PH_DIL_G2>(a, L, grid, stream); }
        else { launch_phase<PH_CONV_G1>(a, L, grid, stream); launch_phase<PH_CONV_E>(a, L, grid, stream); launch_phase<PH_CONV_G2>(a, L, grid, stream); }
        launch_phase<PH_MOE1>(a, L, grid, stream); launch_phase<PH_MOE2>(a, L, grid, stream); launch_phase<PH_MOE3>(a, L, grid, stream); launch_phase<PH_MOE4>(a, L, grid, stream);
    }
#endif
}
```

```cpp
#include <hip/hip_runtime.h>
#include <cstdio>
#include <cstdint>

#ifndef MK_ONE_LAUNCH
#define MK_ONE_LAUNCH 1
#endif

#define GAS __attribute__((address_space(1)))
#define LAS __attribute__((address_space(3)))
typedef unsigned short bf16;
typedef unsigned v4u __attribute__((ext_vector_type(4)));
typedef unsigned v2u __attribute__((ext_vector_type(2)));
typedef float f32x4 __attribute__((ext_vector_type(4)));
typedef float f32x2 __attribute__((ext_vector_type(2)));
typedef short bf16x8 __attribute__((ext_vector_type(8)));
typedef short s16x4 __attribute__((ext_vector_type(4)));

constexpr int NBATCH = 8, SEQ = 2048, D = 2048, T = NBATCH * SEQ, DEPTH = 4;
constexpr int NEXP = 64, TOPK = 8, EDIM = 128, SDIM = 256;
constexpr int QKVC = 4608, DILW = 512;
constexpr float ALPHA = 1.681792830507429f;
constexpr float LN_EPS = 1e-5f;
constexpr int CAP = 16384;
constexpr int HROWS = T * TOPK + NEXP * 256;

constexpr size_t MiB = 1u << 20;
constexpr size_t WS_CTL = 0, CTL_ZERO_BYTES = 1 * MiB;
constexpr size_t WS_W_POOL_IN = 1 * MiB;
constexpr size_t WS_W_POOL_G = WS_W_POOL_IN + 16 * MiB;
constexpr size_t WS_W_POOL_OUT = WS_W_POOL_G + 4 * MiB;
constexpr size_t WS_W_DIL_QKV = WS_W_POOL_OUT + 16 * MiB;
constexpr size_t WS_W_DIL_OUT = WS_W_DIL_QKV + 18 * MiB;
constexpr size_t WS_W_CONV_IN = WS_W_DIL_OUT + 2 * MiB;
constexpr size_t WS_W_CONV_OUT = WS_W_CONV_IN + 24 * MiB;
constexpr size_t WS_W_SH_GU = WS_W_CONV_OUT + 8 * MiB;
constexpr size_t WS_W_SH_D = WS_W_SH_GU + 8 * MiB;
constexpr size_t WS_W_EX_GU = WS_W_SH_D + 4 * MiB;
constexpr size_t WS_W_EX_D = WS_W_EX_GU + 256 * MiB;
constexpr size_t WS_XF = WS_W_EX_D + 256 * MiB;
constexpr size_t WS_YF = WS_XF + 128 * MiB;
constexpr size_t WS_X1F = WS_YF + 128 * MiB;
constexpr size_t WS_XB = WS_X1F + 128 * MiB;
constexpr size_t WS_X1B = WS_XB + 64 * MiB;
constexpr size_t WS_HB = WS_X1B + 64 * MiB;
constexpr size_t WS_HS = WS_HB + 72 * MiB;
constexpr size_t WS_LTOK = WS_HS + 8 * MiB;
constexpr size_t WS_LGATE = WS_LTOK + 4 * MiB;
constexpr size_t WS_EIDX = WS_LGATE + 4 * MiB;
constexpr size_t WS_INV = WS_EIDX + 1 * MiB;
constexpr size_t WS_BIG = WS_INV + 1 * MiB;
constexpr size_t WS_PST = WS_BIG + 608 * MiB;
constexpr size_t WS_ST1 = WS_PST + 4 * MiB;
constexpr size_t WS_ST2 = WS_ST1 + 1 * MiB;
constexpr size_t WS_RWH = WS_ST2 + 1 * MiB;
constexpr size_t WS_RWL = WS_RWH + 1 * MiB;
constexpr size_t WS_PST2 = WS_RWL + 1 * MiB;
constexpr size_t WS_END = WS_PST2 + 8 * MiB;
constexpr size_t WS_Y2F = WS_X1F;
constexpr size_t BG_U = 0, BG_PL = 64 * MiB, BG_MX = 128 * MiB;
constexpr size_t BG_QKV = 0, BG_OG = 144 * MiB, BG_LSE = 192 * MiB, BG_O = 194 * MiB;
constexpr size_t BG_UC = 0, BG_BG = 64 * MiB, BG_Z = 128 * MiB;
constexpr size_t BG_YSC = 400 * MiB;
constexpr int CW_BAR = 4096;
constexpr int CW_CNT = 16384;

constexpr int RING_BYTES = 131072;
constexpr int LDS_TAB = RING_BYTES;
constexpr int LDS_STASH = RING_BYTES + 1024;
constexpr int LDS_BYTES = 163840;
constexpr int LDS_MISC = LDS_BYTES - 1024;

typedef __bf16 bf16x2_t __attribute__((ext_vector_type(2)));
typedef float f32x2_t __attribute__((ext_vector_type(2)));
__device__ __forceinline__ unsigned cvt_pk_bf16(float lo, float hi) { const bf16x2_t r = __builtin_convertvector((f32x2_t){lo, hi}, bf16x2_t); return __builtin_bit_cast(unsigned, r); }
__device__ __forceinline__ unsigned f2bf(float f) { unsigned u = __builtin_bit_cast(unsigned, f); return (u + 0x7fffu + ((u >> 16) & 1u)) >> 16; }
__device__ __forceinline__ unsigned pk2(float lo, float hi) { return f2bf(lo) | (f2bf(hi) << 16); }
__device__ __forceinline__ float bflo(unsigned w) { return __builtin_bit_cast(float, w << 16); }
__device__ __forceinline__ float bfhi(unsigned w) { return __builtin_bit_cast(float, w & 0xffff0000u); }
__device__ __forceinline__ float shfl_from(float v, int src) { return __builtin_bit_cast(float, __builtin_amdgcn_ds_bpermute(src << 2, __builtin_bit_cast(int, v))); }
__device__ __forceinline__ float shfl_x(float v, int o, int lane) { return shfl_from(v, lane ^ o); }
__device__ __forceinline__ float wave_sum(float v, int lane) {
#pragma unroll
    for (int o = 1; o < 64; o <<= 1) v += shfl_x(v, o, lane);
    return v;
}
#define LDS_WAIT() asm volatile("s_waitcnt lgkmcnt(0)" ::: "memory")
#define VM_WAIT() asm volatile("s_waitcnt vmcnt(0)" ::: "memory")

#define XB_TMO      128
#define XB_XCNT(j)  (256  + 64 * (j))
#define XB_XSUB(j)  (1280 + 64 * (j))
#define XB_XGEN(j)  (2304 + 64 * (j))
#define XB_TOP      3328
#define XB_TOPGEN   3392
#define XCD_BAR_WORDS 3456
#define XB_SPIN_CAP (1u << 18)

__device__ __forceinline__ unsigned xb_ld(unsigned* p)              { return __hip_atomic_load(p, __ATOMIC_RELAXED, __HIP_MEMORY_SCOPE_AGENT); }
__device__ __forceinline__ unsigned xb_add(unsigned* p, unsigned v) { return __hip_atomic_fetch_add(p, v, __ATOMIC_RELAXED, __HIP_MEMORY_SCOPE_AGENT); }
__device__ __forceinline__ unsigned xb_xcc_id() { return (unsigned)__builtin_amdgcn_s_getreg((3 << 11) | 20) & 0xFu; }
#define XB_SPIN(cond, bar) do { unsigned _sp = 0; while (cond) { __builtin_amdgcn_s_sleep(1); \
    if ((++_sp & 255u) == 0u) { if (xb_ld(&(bar)[XB_TMO])) break; if (_sp > XB_SPIN_CAP) { atomicAdd(&(bar)[XB_TMO], 1u); break; } } } } while (0)

struct XcdBarrier {
    unsigned* bar; unsigned x;
    volatile LAS unsigned* st;
};

__device__ __forceinline__ XcdBarrier xcd_barrier_post(unsigned* bar, volatile LAS unsigned* st) {
    XcdBarrier b; b.bar = bar; b.x = xb_xcc_id(); b.st = st;
    if (threadIdx.x == 0) (void)xb_add(&bar[XB_XCNT(b.x)], 1u);
    return b;
}
__device__ __forceinline__ void xcd_barrier_complete(unsigned* bar, unsigned x, unsigned& nloc, unsigned& nx) {
    const unsigned G = gridDim.x * gridDim.y * gridDim.z;
    unsigned sum, cnt, mine, sp = 0u;
    for (;;) {
        sum = 0u; cnt = 0u; mine = 0u;
#pragma unroll
        for (unsigned j = 0; j < 16; ++j) { const unsigned c = xb_ld(&bar[XB_XCNT(j)]); sum += c; cnt += (c > 0u) ? 1u : 0u; mine = (j == x) ? c : mine; }
        if (sum == G) break;
        __builtin_amdgcn_s_sleep(1);
        if ((++sp & 255u) == 0u) { if (xb_ld(&bar[XB_TMO])) break; if (sp > XB_SPIN_CAP) { atomicAdd(&bar[XB_TMO], 1u); break; } }
    }
    nloc = mine > 0u ? mine : 1u; nx = cnt > 0u ? cnt : 1u;
}

__device__ __forceinline__ void xcd_barrier(const XcdBarrier& b) {
    asm volatile("s_waitcnt vmcnt(0)" ::: "memory");
    __syncthreads();
    if (threadIdx.x == 0) {
        unsigned* bar; unsigned bx = b.x; { GAS unsigned* bg = (GAS unsigned*)b.bar; asm volatile("" : "+s"(bg), "+s"(bx)); bar = (unsigned*)bg; }
        __builtin_amdgcn_s_waitcnt(0);
        unsigned nloc = b.st[0], nx = b.st[1];
        if (nloc == 0u) { xcd_barrier_complete(bar, bx, nloc, nx); b.st[0] = nloc; b.st[1] = nx; }
        const unsigned old = xb_add(&bar[XB_XSUB(bx)], 1u);
        const unsigned gen = old / nloc;
        if (old + 1u == (gen + 1u) * nloc) {
            __builtin_amdgcn_fence(__ATOMIC_RELEASE, "agent");
            asm volatile("s_waitcnt vmcnt(0)" ::: "memory");
            const unsigned og = xb_add(&bar[XB_TOP], 1u);
            const unsigned tg = og / nx;
            if (og + 1u == (tg + 1u) * nx) xb_add(&bar[XB_TOPGEN], 1u);
            else XB_SPIN(xb_ld(&bar[XB_TOPGEN]) == tg, bar);
            __builtin_amdgcn_fence(__ATOMIC_ACQUIRE, "agent");
            xb_add(&bar[XB_XGEN(bx)], 1u);
            asm volatile("s_waitcnt vmcnt(0)" ::: "memory");
        } else {
            XB_SPIN(xb_ld(&bar[XB_XGEN(bx)]) == gen, bar);
            __builtin_amdgcn_fence(__ATOMIC_ACQUIRE, "agent");
            asm volatile("s_waitcnt vmcnt(0)" ::: "memory");
        }
    }
    __syncthreads();
}

namespace g8 {
constexpr int BM = 256, BK = 64, HALF = 128, HTB = HALF * BK * 2, STAGE_BYTES = 8 * HTB, NXCD = 8, WGM = 8;
__host__ __device__ __forceinline__ int lds_byte(int r, int c) { const int st = (r >> 4) * 2 + (c >> 5), rr = r & 15, cc = c & 31, ob = rr * 64 + cc * 2; return st * 1024 + (ob ^ (((ob >> 9) & 1) << 5)); }
__host__ __device__ __forceinline__ void stage_rc(int b, int& R, int& C) { const int st = b / 1024, sb = b % 1024, swz = sb ^ (((sb >> 9) & 1) << 5); R = (st >> 1) * 16 + swz / 64; C = (st & 1) * 32 + (swz % 64) / 2; }
__host__ __device__ __forceinline__ int perm32(int rho) { const int n = rho >> 4, i = rho & 15; return 8 * (i >> 2) + 4 * n + (i & 3); }

struct Unit { const char* A; const char* B; const int* rows; int pm, pn, nvalid, aux; };

template <class Epi, class Sched, bool GATHER>
__device__ __forceinline__ void gemm_phase(LAS unsigned char* lds, const int tid_in, const int K, const int lda, const int ldb, const Sched& S, const Epi& E) {
    const int tid = tid_in, wid = __builtin_amdgcn_readfirstlane(tid >> 6), lane = tid & 63, wr = wid >> 2, wc = wid & 3, fr = lane & 15, fq = lane >> 4;
    const int nt = K / BK;
    unsigned voffB[2];
#pragma unroll
    for (int i = 0; i < 2; ++i) { int R_, C_; stage_rc(tid * 16 + i * 8192, R_, C_); const int Rb = Epi::PERM ? ((R_ & ~31) + perm32(R_ & 31)) : R_; voffB[i] = (unsigned)(Rb * ldb + C_) * 2u; }
    LAS v4u* stash = (LAS v4u*)(lds + (LDS_STASH - 0) + tid * 16);
    const size_t kstep = (size_t)(BK * 2);
    const size_t hstepB = (size_t)HALF * ldb * 2;
    const unsigned ldsw = (unsigned)wid * 1024u;
    const int aoff = lds_byte(wr * 64 + fr, fq * 8), boff = lds_byte(wc * 32 + fr, fq * 8);
#define G8_SA(b, h) (((b) * 2 + (h)) * HTB)
#define G8_SB(b, h) ((4 + (b) * 2 + (h)) * HTB)
#define G8_STAGE2(bufoff, gbase, v0, v1) do { \
        __builtin_amdgcn_global_load_lds((const unsigned*)((const char*)(gbase) + (v0)), (LAS unsigned*)(lds + (bufoff) + ldsw), 16, 0, 0); \
        __builtin_amdgcn_global_load_lds((const unsigned*)((const char*)(gbase) + (v1)), (LAS unsigned*)(lds + (bufoff) + ldsw + 8192), 16, 0, 0); } while (0)
#define G8_STAGEB(bufoff, gbase) G8_STAGE2(bufoff, gbase, voffB[0], voffB[1])
#define G8_LDA(dst, b, h) do { _Pragma("unroll") for (int m = 0; m < 4; ++m) _Pragma("unroll") for (int k = 0; k < 2; ++k) dst[m][k] = *(const LAS bf16x8*)(lds + G8_SA(b, h) + aoff + m * 2048 + k * 1024); } while (0)
#define G8_LDB(dst, b, h) do { _Pragma("unroll") for (int n = 0; n < 2; ++n) _Pragma("unroll") for (int k = 0; k < 2; ++k) dst[n][k] = *(const LAS bf16x8*)(lds + G8_SB(b, h) + boff + n * 2048 + k * 1024); } while (0)
#define G8_MMA(ai, bj, At, Bt) do { __builtin_amdgcn_s_setprio(1); _Pragma("unroll") for (int m = 0; m < 4; ++m) _Pragma("unroll") for (int n = 0; n < 2; ++n) _Pragma("unroll") for (int k = 0; k < 2; ++k) \
        acc[ai][bj][m][n] = __builtin_amdgcn_mfma_f32_16x16x32_bf16(Bt[n][k], At[m][k], acc[ai][bj][m][n], 0, 0, 0); __builtin_amdgcn_s_setprio(0); } while (0)
#define G8_WAIT_V(n) asm volatile("s_waitcnt vmcnt(" #n ")" ::: "memory")
#define G8_WAIT_L(n) asm volatile("s_waitcnt lgkmcnt(" #n ")" ::: "memory")
#define G8_BAR __builtin_amdgcn_s_barrier()
#define G8_SCHED __builtin_amdgcn_sched_barrier(0)
#define G8_SETVA(dst, u) do { int _t2 = tid; if (GATHER) asm volatile("" : "+v"(_t2)); _Pragma("unroll") for (int _h = 0; _h < 2; ++_h) _Pragma("unroll") for (int _i = 0; _i < 2; ++_i) { \
        int _R, _C; stage_rc(_t2 * 16 + _i * 8192, _R, _C); \
        const unsigned _rl = (unsigned)(_h * HALF + _R); unsigned _row = _rl; \
        if (GATHER) { _row = 0u; if (_rl < (unsigned)(u).nvalid) _row = (unsigned)(u).rows[_rl] >> 3; } \
        dst[_h][_i] = (_row * (unsigned)lda + (unsigned)_C) * 2u; } } while (0)
    Unit cur, nxt; int ui = 0;
    if (!S.next(0, cur)) return;
    f32x4 acc[2][2][4][2];
#pragma unroll
    for (int a = 0; a < 2; ++a)
#pragma unroll
        for (int b = 0; b < 2; ++b)
#pragma unroll
            for (int m = 0; m < 4; ++m)
#pragma unroll
                for (int n = 0; n < 2; ++n) acc[a][b][m][n] = (f32x4){0.f, 0.f, 0.f, 0.f};
    bf16x8 At[4][2], B0[2][2], B1[2][2];
    unsigned vAc[2][2]; unsigned xl00 = 0, xl01 = 0, xl10 = 0, xl11 = 0;
    G8_SETVA(vAc, cur);
    const char* cA = cur.A; const char* cB = cur.B;
    G8_STAGEB(G8_SB(0, 0), cB); G8_STAGEB(G8_SB(0, 1), cB + hstepB); G8_STAGE2(G8_SA(0, 0), cA, vAc[0][0], vAc[0][1]); G8_STAGE2(G8_SA(0, 1), cA, vAc[1][0], vAc[1][1]);
    if (wr == 1) G8_BAR;
    G8_WAIT_V(2); G8_BAR;
    G8_STAGEB(G8_SB(1, 0), cB + kstep); G8_STAGE2(G8_SA(1, 0), cA + kstep, vAc[0][0], vAc[0][1]); G8_STAGEB(G8_SB(1, 1), cB + hstepB + kstep);
    G8_WAIT_V(6); G8_BAR;
    for (;;) {
        const bool has_next = S.next(ui + 1, nxt);
        const char* nA = has_next ? nxt.A : cA; const char* nB = has_next ? nxt.B : cB;
        if (GATHER) { unsigned vAn[2][2]; if (has_next) { G8_SETVA(vAn, nxt); } else {
#pragma unroll
            for (int h = 0; h < 2; ++h)
#pragma unroll
                for (int i = 0; i < 2; ++i) vAn[h][i] = vAc[h][i]; }
            *stash = (v4u){vAn[0][0], vAn[0][1], vAn[1][0], vAn[1][1]}; }
#pragma unroll 1
        for (int t = 0; t < nt; t += 2) {
            const bool last = (t == nt - 2);
            const char* a1 = cA + (size_t)(t + 1) * kstep;
            const char* a2 = last ? nA : cA + (size_t)(t + 2) * kstep; const char* b2 = last ? nB : cB + (size_t)(t + 2) * kstep;
            const char* a3 = a2 + kstep; const char* b3 = b2 + kstep;
            unsigned x00 = vAc[0][0], x01 = vAc[0][1], x10 = vAc[1][0], x11 = vAc[1][1];
            if (GATHER) { if (last) { const v4u sv = *stash; x00 = sv.x; x01 = sv.y; x10 = sv.z; x11 = sv.w; } xl00 = x00; xl01 = x01; xl10 = x10; xl11 = x11; }
            G8_LDB(B0, 0, 0); G8_LDB(B1, 0, 1); G8_SCHED; G8_LDA(At, 0, 0); G8_STAGE2(G8_SA(1, 1), a1, vAc[1][0], vAc[1][1]);
            G8_WAIT_V(8); G8_WAIT_L(0); G8_BAR; G8_MMA(0, 0, At, B0); G8_MMA(0, 1, At, B1); G8_BAR; G8_SCHED;
            G8_LDA(At, 0, 1); G8_STAGEB(G8_SB(0, 0), b2); G8_STAGEB(G8_SB(0, 1), b2 + hstepB); G8_STAGE2(G8_SA(0, 0), a2, x00, x01);
            G8_WAIT_V(8); G8_WAIT_L(0); G8_BAR; G8_MMA(1, 0, At, B0); G8_MMA(1, 1, At, B1); G8_BAR; G8_SCHED;
            G8_LDB(B0, 1, 0); G8_LDB(B1, 1, 1); G8_SCHED; G8_LDA(At, 1, 0); G8_STAGE2(G8_SA(0, 1), a2, x10, x11);
            G8_WAIT_V(8); G8_WAIT_L(0); G8_BAR; G8_MMA(0, 0, At, B0); G8_MMA(0, 1, At, B1); G8_BAR; G8_SCHED;
            G8_LDA(At, 1, 1); G8_STAGEB(G8_SB(1, 0), b3); G8_STAGEB(G8_SB(1, 1), b3 + hstepB); G8_STAGE2(G8_SA(1, 0), a3, x00, x01);
            G8_WAIT_V(8); G8_WAIT_L(0); G8_BAR; G8_MMA(1, 0, At, B0); G8_MMA(1, 1, At, B1); G8_BAR; G8_SCHED;
        }
        if (wr == 0) G8_BAR;
        E(acc, cur, wr, wc, fr, fq);
        if (!has_next) break;
#pragma unroll
        for (int a = 0; a < 2; ++a)
#pragma unroll
            for (int b = 0; b < 2; ++b)
#pragma unroll
                for (int m = 0; m < 4; ++m)
#pragma unroll
                    for (int n = 0; n < 2; ++n) acc[a][b][m][n] = (f32x4){0.f, 0.f, 0.f, 0.f};
        cur = nxt; cA = nA; cB = nB; ++ui;
        if (GATHER) { vAc[0][0] = xl00; vAc[0][1] = xl01; vAc[1][0] = xl10; vAc[1][1] = xl11; }
        if (wr == 1) G8_BAR;
    }
    G8_WAIT_V(0);
    G8_BAR;
#undef G8_SA
#undef G8_SB
#undef G8_STAGE2
#undef G8_STAGEB
#undef G8_LDA
#undef G8_LDB
#undef G8_MMA
#undef G8_WAIT_V
#undef G8_WAIT_L
#undef G8_BAR
#undef G8_SCHED
#undef G8_SETVA
}

struct DenseSched {
    const char* A; const char* B; size_t a_tile, b_tile, agrp_stride; int agrp_shift, nM, nN, nwg, G, c;
    __device__ __forceinline__ void init(const void* A_, const void* B_, int M, int N, int lda, int ldb, int G_, int c_) {
        A = (const char*)A_; B = (const char*)B_; a_tile = (size_t)BM * lda * 2; b_tile = (size_t)BM * ldb * 2; agrp_stride = 0; agrp_shift = 0; nM = M / BM; nN = N / BM; nwg = nM * nN; G = G_; c = c_; }
    __device__ __forceinline__ bool next(int i, Unit& u) const {
        const long L = (long)i * G + c; if (L >= nwg) return false;
        int wgid = (int)L; { const int q = nwg / NXCD, r = nwg % NXCD, xcd = wgid % NXCD, off = wgid / NXCD; wgid = (xcd < r ? xcd * (q + 1) : r * (q + 1) + (xcd - r) * q) + off; }
        const int nig = WGM * nN, gid = wgid / nig, fm = gid * WGM, gsz = (nM - fm) < WGM ? (nM - fm) : WGM;
        u.pm = fm + ((wgid % nig) % gsz); u.pn = (wgid % nig) / gsz;
        u.A = A + (size_t)u.pm * a_tile + (size_t)(u.pn >> agrp_shift) * agrp_stride; u.B = B + (size_t)u.pn * b_tile; u.rows = nullptr; u.nvalid = BM; u.aux = 0; return true;
    }
};
template <int NPN, bool GATHERED>
struct ExpertSched {
    const LAS int* tpref; const LAS int* cnt; const char* A; const char* B; const int* tok; size_t b_exp, b_tile, a_tile; int NU, G, c;
    __device__ __forceinline__ bool next(int i, Unit& u) const {
        int L = i * G + c; if (L >= NU) return false;
        if ((i + 1) * G <= NU && (G % NXCD) == 0) L = i * G + (c % NXCD) * (G / NXCD) + c / NXCD;
        const int tile = L / NPN, pn = L % NPN;
        int e = 0; while (__builtin_amdgcn_readfirstlane(tpref[e + 1]) <= tile) ++e;
        const int rb = tile - __builtin_amdgcn_readfirstlane(tpref[e]);
        u.pm = e; u.pn = pn; u.aux = tile * BM; u.nvalid = __builtin_amdgcn_readfirstlane(cnt[e]) - rb * BM; if (u.nvalid > BM) u.nvalid = BM;
        u.rows = tok + (size_t)e * CAP + rb * BM;
        u.A = GATHERED ? A : A + (size_t)tile * a_tile; u.B = B + (size_t)e * b_exp + (size_t)pn * b_tile; return true;
    }
};

struct EpiBf16 {
    static constexpr bool PERM = true;
    bf16* O; int ldc; int qscale;
    __device__ __forceinline__ void operator()(const f32x4 (&acc)[2][2][4][2], const Unit& u, int wr, int wc, int fr, int fq) const {
        asm volatile("" : "+v"(fr), "+v"(fq));
        const int row0 = u.pm * BM + wr * 64 + fr, col0 = u.pn * BM + wc * 32 + 8 * fq;
        const float sc = (qscale && (u.pn % 6) < 2) ? 0.125f : 1.0f;
#pragma unroll
        for (int ai = 0; ai < 2; ++ai)
#pragma unroll
            for (int m = 0; m < 4; ++m) { bf16* rowp = O + (size_t)(row0 + ai * HALF + m * 16) * ldc + col0;
#pragma unroll
                for (int bj = 0; bj < 2; ++bj) { const f32x4 v0 = acc[ai][bj][m][0] * sc, v1 = acc[ai][bj][m][1] * sc;
                    v4u w; w.x = cvt_pk_bf16(v0[0], v0[1]); w.y = cvt_pk_bf16(v0[2], v0[3]); w.z = cvt_pk_bf16(v1[0], v1[1]); w.w = cvt_pk_bf16(v1[2], v1[3]);
                    *(v4u*)(rowp + bj * HALF) = w; } }
    }
};
struct EpiScaleBf16 {
    static constexpr bool PERM = true;
    bf16* O; int ldc; const float* scale;
    __device__ __forceinline__ void operator()(const f32x4 (&acc)[2][2][4][2], const Unit& u, int wr, int wc, int fr, int fq) const {
        asm volatile("" : "+v"(fr), "+v"(fq));
        const int row0 = u.pm * BM + wr * 64 + fr, col0 = u.pn * BM + wc * 32 + 8 * fq;
        f32x4 sv[2][2];
#pragma unroll
        for (int bj = 0; bj < 2; ++bj)
#pragma unroll
            for (int n = 0; n < 2; ++n) sv[bj][n] = *(const f32x4*)(scale + col0 + bj * HALF + 4 * n);
#pragma unroll
        for (int ai = 0; ai < 2; ++ai)
#pragma unroll
            for (int m = 0; m < 4; ++m) { bf16* rowp = O + (size_t)(row0 + ai * HALF + m * 16) * ldc + col0;
#pragma unroll
                for (int bj = 0; bj < 2; ++bj) { const f32x4 v0 = acc[ai][bj][m][0] * sv[bj][0], v1 = acc[ai][bj][m][1] * sv[bj][1];
                    v4u w; w.x = cvt_pk_bf16(v0[0], v0[1]); w.y = cvt_pk_bf16(v0[2], v0[3]); w.z = cvt_pk_bf16(v1[0], v1[1]); w.w = cvt_pk_bf16(v1[2], v1[3]);
                    *(v4u*)(rowp + bj * HALF) = w; } }
    }
};
struct EpiResid {
    static constexpr bool PERM = false;
    const float* X; float* Y;
    __device__ __forceinline__ void operator()(const f32x4 (&acc)[2][2][4][2], const Unit& u, int wr, int wc, int fr, int fq) const {
        asm volatile("" : "+v"(fr), "+v"(fq));
        const int row0 = u.pm * BM + wr * 64 + fr, col0 = u.pn * BM + wc * 32 + 4 * fq;
#pragma unroll
        for (int ai = 0; ai < 2; ++ai)
#pragma unroll
            for (int m = 0; m < 4; ++m) { const size_t off = (size_t)(row0 + ai * HALF + m * 16) * D + col0;
#pragma unroll
                for (int bj = 0; bj < 2; ++bj)
#pragma unroll
                    for (int n = 0; n < 2; ++n) { const f32x4 xv = *(const f32x4*)(X + off + bj * HALF + n * 16); *(f32x4*)(Y + off + bj * HALF + n * 16) = xv * ALPHA + acc[ai][bj][m][n]; } }
    }
};
struct EpiResidLN {
    static constexpr bool PERM = true;
    const float* X32; const bf16* Xb; const float* st; const float* g; const float* b; bf16* Y; float* pst; int mode;
    __device__ __forceinline__ void operator()(const f32x4 (&acc)[2][2][4][2], const Unit& u, int wr, int wc, int fr, int fq) const {
        asm volatile("" : "+v"(fr), "+v"(fq));
        const int row0 = u.pm * BM + wr * 64 + fr, col0 = u.pn * BM + wc * 32 + 8 * fq, lane = fq * 16 + fr;
#pragma unroll
        for (int ai = 0; ai < 2; ++ai) {
            v4u xr[4][2];
#pragma unroll
            for (int m = 0; m < 4; ++m)
#pragma unroll
                for (int bj = 0; bj < 2; ++bj) xr[m][bj] = *(const v4u*)(Xb + (size_t)(row0 + ai * HALF + m * 16) * D + col0 + bj * HALF);
            asm volatile("" : "+v"(xr[0][0]), "+v"(xr[0][1]), "+v"(xr[1][0]), "+v"(xr[1][1]), "+v"(xr[2][0]), "+v"(xr[2][1]), "+v"(xr[3][0]), "+v"(xr[3][1]));
#pragma unroll
            for (int m = 0; m < 4; ++m) { const int row = row0 + ai * HALF + m * 16; const size_t off = (size_t)row * D + col0;
                float sm = 0.f, sq = 0.f;
#pragma unroll
                for (int bj = 0; bj < 2; ++bj) { const v4u xv = xr[m][bj];
                    const f32x4 x0 = (f32x4){bflo(xv.x), bfhi(xv.x), bflo(xv.y), bfhi(xv.y)}, x1 = (f32x4){bflo(xv.z), bfhi(xv.z), bflo(xv.w), bfhi(xv.w)};
                    const f32x4 y0 = x0 * ALPHA + acc[ai][bj][m][0], y1 = x1 * ALPHA + acc[ai][bj][m][1];
                    v4u w; w.x = cvt_pk_bf16(y0[0], y0[1]); w.y = cvt_pk_bf16(y0[2], y0[3]); w.z = cvt_pk_bf16(y1[0], y1[1]); w.w = cvt_pk_bf16(y1[2], y1[3]);
                    *(v4u*)(Y + off + bj * HALF) = w;
                    sm += ((y0[0] + y0[1]) + (y0[2] + y0[3])) + ((y1[0] + y1[1]) + (y1[2] + y1[3]));
                    sq += ((y0[0] * y0[0] + y0[1] * y0[1]) + (y0[2] * y0[2] + y0[3] * y0[3])) + ((y1[0] * y1[0] + y1[1] * y1[1]) + (y1[2] * y1[2] + y1[3] * y1[3])); }
                sm += shfl_x(sm, 16, lane); sm += shfl_x(sm, 32, lane); sq += shfl_x(sq, 16, lane); sq += shfl_x(sq, 32, lane);
                if (fq == 0) *(f32x2*)(pst + ((size_t)row * 32 + u.pn * 4 + wc) * 2) = (f32x2){sm, sq}; } }
    }
};
struct EpiConvIn {
    static constexpr bool PERM = true;
    bf16* UC; bf16* BGp;
    __device__ __forceinline__ void operator()(const f32x4 (&acc)[2][2][4][2], const Unit& u, int wr, int wc, int fr, int fq) const {
        asm volatile("" : "+v"(fr), "+v"(fq));
        const int row0 = u.pm * BM + wr * 64 + fr, cw = wc * 32 + 8 * fq;
        if (u.pn < 16) {
#pragma unroll
            for (int ai = 0; ai < 2; ++ai)
#pragma unroll
                for (int m = 0; m < 4; ++m) { bf16* rowp = UC + (size_t)(row0 + ai * HALF + m * 16) * D + u.pn * HALF + cw;
                    const f32x4 v0 = acc[ai][0][m][0] * acc[ai][1][m][0], v1 = acc[ai][0][m][1] * acc[ai][1][m][1];
                    v4u w; w.x = cvt_pk_bf16(v0[0], v0[1]); w.y = cvt_pk_bf16(v0[2], v0[3]); w.z = cvt_pk_bf16(v1[0], v1[1]); w.w = cvt_pk_bf16(v1[2], v1[3]);
                    *(v4u*)rowp = w; }
        } else {
#pragma unroll
            for (int ai = 0; ai < 2; ++ai)
#pragma unroll
                for (int m = 0; m < 4; ++m) { bf16* rowp = BGp + (size_t)(row0 + ai * HALF + m * 16) * D + (u.pn - 16) * BM + cw;
#pragma unroll
                    for (int bj = 0; bj < 2; ++bj) { const f32x4 v0 = acc[ai][bj][m][0], v1 = acc[ai][bj][m][1];
                        v4u w; w.x = cvt_pk_bf16(v0[0], v0[1]); w.y = cvt_pk_bf16(v0[2], v0[3]); w.z = cvt_pk_bf16(v1[0], v1[1]); w.w = cvt_pk_bf16(v1[2], v1[3]);
                        *(v4u*)(rowp + bj * HALF) = w; } }
        }
    }
};
__device__ __forceinline__ f32x4 silu_mul(f32x4 g, f32x4 uu) {
    f32x4 r;
#pragma unroll
    for (int j = 0; j < 4; ++j) r[j] = g[j] * __builtin_amdgcn_rcpf(1.0f + __expf(-g[j])) * uu[j];
    return r;
}
struct EpiExpertGU {
    static constexpr bool PERM = true;
    bf16* H;
    __device__ __forceinline__ void operator()(const f32x4 (&acc)[2][2][4][2], const Unit& u, int wr, int wc, int fr, int fq) const {
        asm volatile("" : "+v"(fr), "+v"(fq));
        const float* gates = (const float*)((const char*)u.rows + (WS_LGATE - WS_LTOK));
        const int cw = wc * 32 + 8 * fq;
        float gtv[2][4];
#pragma unroll
        for (int ai = 0; ai < 2; ++ai)
#pragma unroll
            for (int m = 0; m < 4; ++m) { const int r = ai * HALF + wr * 64 + m * 16 + fr; gtv[ai][m] = gates[r < u.nvalid ? r : 0]; }
        asm volatile("" : "+v"(gtv[0][0]), "+v"(gtv[0][1]), "+v"(gtv[0][2]), "+v"(gtv[0][3]), "+v"(gtv[1][0]), "+v"(gtv[1][1]), "+v"(gtv[1][2]), "+v"(gtv[1][3]));
#pragma unroll
        for (int ai = 0; ai < 2; ++ai)
#pragma unroll
            for (int m = 0; m < 4; ++m) { const int r = ai * HALF + wr * 64 + m * 16 + fr;
                if (r < u.nvalid) { const float gt = gtv[ai][m]; const unsigned pid = 0u;
                    const f32x4 v0 = silu_mul(acc[ai][0][m][0], acc[ai][1][m][0]) * gt, v1 = silu_mul(acc[ai][0][m][1], acc[ai][1][m][1]) * gt;
                    v4u w; w.x = cvt_pk_bf16(v0[0], v0[1]); w.y = cvt_pk_bf16(v0[2], v0[3]); w.z = cvt_pk_bf16(v1[0], v1[1]); w.w = cvt_pk_bf16(v1[2], v1[3]);
                    (void)pid; *(v4u*)(H + (size_t)(u.aux + r) * EDIM + cw) = w; } }
    }
};
struct EpiSharedGU {
    static constexpr bool PERM = true;
    bf16* HS;
    __device__ __forceinline__ void operator()(const f32x4 (&acc)[2][2][4][2], const Unit& u, int wr, int wc, int fr, int fq) const {
        asm volatile("" : "+v"(fr), "+v"(fq));
        const int row0 = u.pm * BM + wr * 64 + fr, cw = u.pn * HALF + wc * 32 + 8 * fq;
#pragma unroll
        for (int ai = 0; ai < 2; ++ai)
#pragma unroll
            for (int m = 0; m < 4; ++m) {
                const f32x4 v0 = silu_mul(acc[ai][0][m][0], acc[ai][1][m][0]), v1 = silu_mul(acc[ai][0][m][1], acc[ai][1][m][1]);
                v4u w; w.x = cvt_pk_bf16(v0[0], v0[1]); w.y = cvt_pk_bf16(v0[2], v0[3]); w.z = cvt_pk_bf16(v1[0], v1[1]); w.w = cvt_pk_bf16(v1[2], v1[3]);
                *(v4u*)(HS + (size_t)(row0 + ai * HALF + m * 16) * SDIM + cw) = w; }
    }
};
struct EpiDownY {
    static constexpr bool PERM = true;
    bf16* Y;
    __device__ __forceinline__ void operator()(const f32x4 (&acc)[2][2][4][2], const Unit& u, int wr, int wc, int fr, int fq) const {
        asm volatile("" : "+v"(fr), "+v"(fq));
        const int col0 = u.pn * BM + wc * 32 + 8 * fq;
#pragma unroll
        for (int ai = 0; ai < 2; ++ai)
#pragma unroll
            for (int m = 0; m < 4; ++m) { const int r = ai * HALF + wr * 64 + m * 16 + fr; bf16* rowp = Y + (size_t)(u.aux + r) * D + col0;
#pragma unroll
                for (int bj = 0; bj < 2; ++bj) { const f32x4 v0 = acc[ai][bj][m][0], v1 = acc[ai][bj][m][1];
                    v4u w; w.x = cvt_pk_bf16(v0[0], v0[1]); w.y = cvt_pk_bf16(v0[2], v0[3]); w.z = cvt_pk_bf16(v1[0], v1[1]); w.w = cvt_pk_bf16(v1[2], v1[3]);
                    *(v4u*)(rowp + bj * HALF) = w; } }
    }
};
}

struct Args { const float* in[19]; float* out; unsigned char* ws; int ph_lo, ph_hi; };
struct Frame {
    LAS unsigned char* lds; unsigned* ctl; unsigned char* ws;
    int tid, lane, wave, G, bid;
};
enum { IN_X = 0, IN_RELB, IN_PWIN, IN_PWG, IN_PSC, IN_PWOUT, IN_DQKV, IN_DOUT, IN_CWIN, IN_CW, IN_CWOUT, IN_LNG, IN_LNB, IN_RW, IN_RB, IN_EGU, IN_ED, IN_SGU, IN_SD };

#define CAS __attribute__((address_space(4)))
typedef const CAS unsigned char* KP;
__device__ __forceinline__ const float* ain(KP kp, int i) { return (const float*)((const GAS float* const CAS*)kp)[i]; }
__device__ __forceinline__ float* aout(KP kp) { return (float*)((GAS float* const CAS*)kp)[19]; }
__device__ __forceinline__ void tr_item(const float* W, int K, int N, bf16* WT, int dstK, int mode, LAS float* scr, int item, int lane) {
    const int nblk = N / 32, kb = item / nblk, nb = item % nblk, k0 = 64 * kb, n0 = 32 * nb;
    int r0 = n0;
    if (mode == 1) { const int part = n0 / 2048, j = n0 % 2048; r0 = (part == 0) ? 4096 + j : 256 * (j / 128) + (part == 2 ? 128 : 0) + (j % 128); }
    if (mode == 2) { const int part = n0 / 256, j = n0 % 256; r0 = 256 * (j / 128) + 128 * part + (j % 128); }
#pragma unroll 8
    for (int i = 0; i < 32; ++i) { const int kk = 2 * i + (lane >> 5); scr[kk * 33 + (lane & 31)] = __builtin_nontemporal_load(W + (size_t)(k0 + kk) * N + n0 + (lane & 31)); }
    LDS_WAIT(); asm volatile("" ::: "memory");
    const int c = lane & 7;
#pragma unroll
    for (int j = 0; j < 4; ++j) { const int n = (lane >> 3) + 8 * j; const LAS float* s = scr + (8 * c) * 33 + n;
        v4u o; o.x = pk2(s[0 * 33], s[1 * 33]); o.y = pk2(s[2 * 33], s[3 * 33]); o.z = pk2(s[4 * 33], s[5 * 33]); o.w = pk2(s[6 * 33], s[7 * 33]);
        __builtin_nontemporal_store(o, (v4u*)(WT + (size_t)(r0 + n) * dstK + k0 + 8 * c)); }
    LDS_WAIT(); asm volatile("" ::: "memory");
}
__device__ __forceinline__ void phase_prologue(const Frame& F, KP kp) {
    LAS float* scr = (LAS float*)(F.lds + F.wave * 16384);
    const int gw = F.bid * 8 + F.wave, NGW = F.G * 8;
    constexpr int I0 = 2 * 2048, I1 = 8 * 128, I2 = 2 * 2048, I3 = 4608, I4 = 512, I5 = 6144, I6 = 2048, I7 = 4 * 512, I8 = 4 * 256, I9 = 256 * 256, I10 = 256 * 128;
    constexpr int NITEMS = I0 + I1 + I2 + I3 + I4 + I5 + I6 + I7 + I8 + I9 + I10;
    unsigned char* ws = F.ws;
    for (int it = gw; it < NITEMS; it += NGW) {
        int r = it;
        if (r < I0) { const int b = r / 2048; tr_item(ain(kp, IN_PWIN) + (size_t)b * D * D, D, D, (bf16*)(ws + WS_W_POOL_IN) + (size_t)b * D * D, D, 0, scr, r % 2048, F.lane); continue; } r -= I0;
        if (r < I1) { const int b = r / 128; tr_item(ain(kp, IN_PWG) + (size_t)b * 512 * 512, 512, 512, (bf16*)(ws + WS_W_POOL_G) + (size_t)b * 512 * 512, 512, 0, scr, r % 128, F.lane); continue; } r -= I1;
        if (r < I2) { const int b = r / 2048; tr_item(ain(kp, IN_PWOUT) + (size_t)b * D * D, D, D, (bf16*)(ws + WS_W_POOL_OUT) + (size_t)b * D * D, D, 0, scr, r % 2048, F.lane); continue; } r -= I2;
        if (r < I3) { tr_item(ain(kp, IN_DQKV), D, QKVC, (bf16*)(ws + WS_W_DIL_QKV), D, 0, scr, r, F.lane); continue; } r -= I3;
        if (r < I4) { tr_item(ain(kp, IN_DOUT), DILW, D, (bf16*)(ws + WS_W_DIL_OUT), DILW, 0, scr, r, F.lane); continue; } r -= I4;
        if (r < I5) { tr_item(ain(kp, IN_CWIN), D, 3 * D, (bf16*)(ws + WS_W_CONV_IN), D, 1, scr, r, F.lane); continue; } r -= I5;
        if (r < I6) { tr_item(ain(kp, IN_CWOUT), D, D, (bf16*)(ws + WS_W_CONV_OUT), D, 0, scr, r, F.lane); continue; } r -= I6;
        if (r < I7) { const int b = r / 512; tr_item(ain(kp, IN_SGU) + (size_t)b * D * 512, D, 512, (bf16*)(ws + WS_W_SH_GU) + (size_t)b * 512 * D, D, 2, scr, r % 512, F.lane); continue; } r -= I7;
        if (r < I8) { const int b = r / 256; tr_item(ain(kp, IN_SD) + (size_t)b * SDIM * D, SDIM, D, (bf16*)(ws + WS_W_SH_D) + (size_t)b * D * SDIM, SDIM, 0, scr, r % 256, F.lane); continue; } r -= I8;
        if (r < I9) { const int b = r / 256; tr_item(ain(kp, IN_EGU) + (size_t)b * D * 256, D, 256, (bf16*)(ws + WS_W_EX_GU) + (size_t)b * 256 * D, D, 0, scr, r % 256, F.lane); continue; } r -= I9;
        { const int b = r / 128; tr_item(ain(kp, IN_ED) + (size_t)b * EDIM * D, EDIM, D, (bf16*)(ws + WS_W_EX_D) + (size_t)b * D * EDIM, EDIM, 0, scr, r % 128, F.lane); }
    }
    const size_t gt = (size_t)F.bid * 512 + F.tid, GT = (size_t)F.G * 512;
    { const float* rw = ain(kp, IN_RW); bf16* wh = (bf16*)(ws + WS_RWH); bf16* wl = (bf16*)(ws + WS_RWL);
      for (size_t i = gt; i < (size_t)DEPTH * NEXP * D / 8; i += GT) { const size_t k8 = i % (D / 8), e = (i / (D / 8)) % NEXP, l = i / ((size_t)NEXP * D / 8);
          float v[8]; unsigned hi[8], lo[8];
#pragma unroll
          for (int j = 0; j < 8; ++j) { v[j] = rw[(l * D + k8 * 8 + j) * NEXP + e]; hi[j] = f2bf(v[j]); lo[j] = f2bf(v[j] - __builtin_bit_cast(float, hi[j] << 16)); }
          v4u a, b2; a.x = hi[0] | (hi[1] << 16); a.y = hi[2] | (hi[3] << 16); a.z = hi[4] | (hi[5] << 16); a.w = hi[6] | (hi[7] << 16);
          b2.x = lo[0] | (lo[1] << 16); b2.y = lo[2] | (lo[3] << 16); b2.z = lo[4] | (lo[5] << 16); b2.w = lo[6] | (lo[7] << 16);
          *(v4u*)(wh + (l * NEXP + e) * D + k8 * 8) = a; *(v4u*)(wl + (l * NEXP + e) * D + k8 * 8) = b2; } }
    const float* x = ain(kp, IN_X); bf16* xb = (bf16*)(ws + WS_XB);
    for (size_t i = gt; i < (size_t)T * D / 8; i += GT) { const f32x4 p = __builtin_nontemporal_load((const f32x4*)(x + i * 8)), q = __builtin_nontemporal_load((const f32x4*)(x + i * 8 + 4));
        v4u w; w.x = pk2(p[0], p[1]); w.y = pk2(p[2], p[3]); w.z = pk2(q[0], q[1]); w.w = pk2(q[2], q[3]); *(v4u*)(xb + i * 8) = w; }
}

__device__ __forceinline__ void unpack8(const v4u w, float (&f)[8]) { f[0] = bflo(w.x); f[1] = bfhi(w.x); f[2] = bflo(w.y); f[3] = bfhi(w.y); f[4] = bflo(w.z); f[5] = bfhi(w.z); f[6] = bflo(w.w); f[7] = bfhi(w.w); }
__device__ __forceinline__ void phase_pool(const Frame& F, const bf16* U, bf16* PL) {
    for (int it = F.bid * 512 + F.tid; it < (T / 32) * 256; it += F.G * 512) {
        const int cv = it & 255, ch = it >> 8, col = cv * 8;
        const int w = __builtin_amdgcn_readfirstlane(2 << (col >> 9));
        const int row0 = __builtin_amdgcn_readfirstlane(ch * 32), pos0 = row0 & (SEQ - 1);
        float s[8], uu[8];
#pragma unroll
        for (int j = 0; j < 8; ++j) s[j] = 0.f;
        { v4u pre[15];
#pragma unroll
          for (int j = 0; j < 15; ++j) { pre[j] = (v4u){0u, 0u, 0u, 0u}; if (j + 1 < w && pos0 - (j + 1) >= 0) pre[j] = *(const v4u*)(U + (size_t)(row0 - (j + 1)) * D + col); }
#pragma unroll
          for (int j = 0; j < 15; ++j) asm volatile("" : "+v"(pre[j]));
#pragma unroll
          for (int j = 0; j < 15; ++j) { unpack8(pre[j], uu);
#pragma unroll
              for (int q = 0; q < 8; ++q) s[q] += uu[q]; } }
#pragma unroll 1
        for (int cb = 0; cb < 4; ++cb) {
            v4u un[8], uo[8];
#pragma unroll
            for (int j = 0; j < 8; ++j) { const int r = 8 * cb + j, t = row0 + r, pos = pos0 + r;
                un[j] = *(const v4u*)(U + (size_t)t * D + col);
                uo[j] = (v4u){0u, 0u, 0u, 0u}; if (pos - w + 1 >= 0) uo[j] = *(const v4u*)(U + (size_t)(t - w + 1) * D + col); }
#pragma unroll
            for (int j = 0; j < 8; ++j) asm volatile("" : "+v"(un[j]), "+v"(uo[j]));
#pragma unroll
            for (int j = 0; j < 8; ++j) { const int r = 8 * cb + j, t = row0 + r, pos = pos0 + r;
                unpack8(un[j], uu);
                const float inv = 1.0f / (float)((pos + 1) < w ? (pos + 1) : w);
                float o[8];
#pragma unroll
                for (int q = 0; q < 8; ++q) { s[q] += uu[q]; o[q] = s[q] * inv - uu[q]; }
                v4u ww; ww.x = pk2(o[0], o[1]); ww.y = pk2(o[2], o[3]); ww.z = pk2(o[4], o[5]); ww.w = pk2(o[6], o[7]);
                *(v4u*)(PL + (size_t)t * D + col) = ww;
                unpack8(uo[j], uu);
#pragma unroll
                for (int q = 0; q < 8; ++q) s[q] -= uu[q]; }
        }
    }
}

__device__ __forceinline__ void phase_conv(const Frame& F, const bf16* UC, const bf16* BGp, const float* cw, bf16* Z) {
    for (int it = F.bid * 512 + F.tid; it < (T / 4) * 256; it += F.G * 512) {
        const int cv = it & 255, col = cv * 8, t0 = __builtin_amdgcn_readfirstlane((it >> 8) * 4), pos0 = t0 & (SEQ - 1);
        v4u ur[6], br[4];
#pragma unroll
        for (int j = 0; j < 6; ++j) { ur[j] = (v4u){0u, 0u, 0u, 0u}; if (j >= 2 || pos0 > 0) ur[j] = *(const v4u*)(UC + (size_t)(t0 - 2 + j) * D + col); }
#pragma unroll
        for (int j = 0; j < 4; ++j) br[j] = *(const v4u*)(BGp + (size_t)(t0 + j) * D + col);
        const f32x4 c0a = *(const f32x4*)(cw + col), c0b = *(const f32x4*)(cw + col + 4), c1a = *(const f32x4*)(cw + D + col), c1b = *(const f32x4*)(cw + D + col + 4), c2a = *(const f32x4*)(cw + 2 * D + col), c2b = *(const f32x4*)(cw + 2 * D + col + 4);
        asm volatile("" : "+v"(ur[0]), "+v"(ur[1]), "+v"(ur[2]), "+v"(ur[3]), "+v"(ur[4]), "+v"(ur[5]), "+v"(br[0]), "+v"(br[1]), "+v"(br[2]), "+v"(br[3]));
        const float c0[8] = {c0a[0], c0a[1], c0a[2], c0a[3], c0b[0], c0b[1], c0b[2], c0b[3]}, c1[8] = {c1a[0], c1a[1], c1a[2], c1a[3], c1b[0], c1b[1], c1b[2], c1b[3]}, c2[8] = {c2a[0], c2a[1], c2a[2], c2a[3], c2b[0], c2b[1], c2b[2], c2b[3]};
#pragma unroll
        for (int j = 0; j < 4; ++j) { float u0[8], u1[8], u2[8], bb[8], o[8];
            unpack8(ur[j], u0); unpack8(ur[j + 1], u1); unpack8(ur[j + 2], u2); unpack8(br[j], bb);
#pragma unroll
            for (int q = 0; q < 8; ++q) o[q] = bb[q] * (c0[q] * u0[q] + c1[q] * u1[q] + c2[q] * u2[q]);
            v4u ww; ww.x = pk2(o[0], o[1]); ww.y = pk2(o[2], o[3]); ww.z = pk2(o[4], o[5]); ww.w = pk2(o[6], o[7]);
            *(v4u*)(Z + (size_t)(t0 + j) * D + col) = ww; }
    }
}

__device__ __forceinline__ int t5_bucket(int dist) {
    if (dist < 16) return dist;
    int large = 16 + (int)(logf((float)dist / 16.0f) / logf(128.0f) * 16.0f);
    return large < 31 ? large : 31;
}
constexpr int AT_KS = 0, AT_KSTR = 144, AT_VT = 256 * 144, AT_VSTR = 520, AT_BIAS = AT_VT + 64 * 520;
__device__ __forceinline__ void phase_attn(const Frame& F, const bf16* QKV, const float* relb, bf16* OG, float* LSE) {
    LAS unsigned char* lds = F.lds;
    const int tid = F.tid, lane = F.lane, w = tid >> 6, fr = lane & 15, fq = lane >> 4;
    for (int unit = F.bid; unit < NBATCH * 3 * 8 * 16; unit += F.G) {
        const int cmb = unit & 15, h = (unit >> 4) & 7, g = (unit >> 7) % 3, b = unit / 384;
        const int dsh = 2 * g, dil = 1 << dsh, r = cmb & (dil - 1), nb = cmb >> dsh;
        const bf16* base = QKV + (size_t)b * SEQ * QKVC + g * 1536 + h * 64;
        __syncthreads();
        {
            const int key = tid >> 1, half = tid & 1, jk = (nb - 1) * 128 + key;
            v4u kv[4], vv[4];
            if (jk >= 0) { const bf16* rp = base + (size_t)(jk * dil + r) * QKVC + half * 32;
#pragma unroll
                for (int i = 0; i < 4; ++i) { kv[i] = *(const v4u*)(rp + 512 + 8 * i); vv[i] = *(const v4u*)(rp + 1024 + 8 * i); } }
            else {
#pragma unroll
                for (int i = 0; i < 4; ++i) { kv[i] = (v4u){0u, 0u, 0u, 0u}; vv[i] = (v4u){0u, 0u, 0u, 0u}; } }
#pragma unroll
            for (int i = 0; i < 4; ++i) *(LAS v4u*)(lds + AT_KS + key * AT_KSTR + half * 64 + 16 * i) = kv[i];
#pragma unroll
            for (int i = 0; i < 4; ++i) {
                const unsigned ww[4] = {vv[i].x, vv[i].y, vv[i].z, vv[i].w};
#pragma unroll
                for (int q = 0; q < 4; ++q) { const int d = half * 32 + 8 * i + 2 * q;
                    *(LAS unsigned short*)(lds + AT_VT + d * AT_VSTR + key * 2) = (unsigned short)(ww[q] & 0xffffu);
                    *(LAS unsigned short*)(lds + AT_VT + (d + 1) * AT_VSTR + key * 2) = (unsigned short)(ww[q] >> 16); } }
            if (tid <= 128) ((LAS float*)(lds + AT_BIAS))[tid] = relb[t5_bucket(tid * dil) * 24 + g * 8 + h];
        }
        __syncthreads();
        int qi = 16 * w + fr; asm volatile("" : "+v"(qi));
        const int jq = nb * 128 + qi, tq = jq * dil + r;
        const bf16* qp = base + (size_t)tq * QKVC + 8 * fq;
        const bf16x8 q0 = *(const bf16x8*)qp, q1 = *(const bf16x8*)(qp + 32);
        f32x4 s[9]; float mx = -INFINITY;
#pragma unroll
        for (int kt = 0; kt < 9; ++kt) {
            const int kb = 16 * (w + kt);
            const bf16x8 k0 = *(const LAS bf16x8*)(lds + AT_KS + (kb + fr) * AT_KSTR + fq * 16), k1 = *(const LAS bf16x8*)(lds + AT_KS + (kb + fr) * AT_KSTR + 64 + fq * 16);
            f32x4 a = (f32x4){0.f, 0.f, 0.f, 0.f};
            a = __builtin_amdgcn_mfma_f32_16x16x32_bf16(k0, q0, a, 0, 0, 0);
            a = __builtin_amdgcn_mfma_f32_16x16x32_bf16(k1, q1, a, 0, 0, 0);
#pragma unroll
            for (int i = 0; i < 4; ++i) { const int kl = kb + 4 * fq + i, rel = qi + 128 - kl;
                const bool ok = (rel >= 0) && (rel <= 128) && (nb > 0 || kl >= 128);
                const int rc = rel < 0 ? 0 : (rel > 128 ? 128 : rel);
                const float v = ok ? a[i] + ((LAS float*)(lds + AT_BIAS))[rc] : -INFINITY;
                a[i] = v; mx = fmaxf(mx, v); }
            s[kt] = a;
        }
        mx = fmaxf(mx, shfl_x(mx, 16, lane)); mx = fmaxf(mx, shfl_x(mx, 32, lane));
        float l = 0.f;
#pragma unroll
        for (int kt = 0; kt < 9; ++kt)
#pragma unroll
            for (int i = 0; i < 4; ++i) { const float p = __expf(s[kt][i] - mx); s[kt][i] = p; l += p; }
        l += shfl_x(l, 16, lane); l += shfl_x(l, 32, lane);
        f32x4 o[4];
#pragma unroll
        for (int nt = 0; nt < 4; ++nt) o[nt] = (f32x4){0.f, 0.f, 0.f, 0.f};
#pragma unroll
        for (int st = 0; st < 5; ++st) {
            const int kt0 = 2 * st, kt1 = 2 * st + 1;
            v4u pw; pw.x = pk2(s[kt0][0], s[kt0][1]); pw.y = pk2(s[kt0][2], s[kt0][3]);
            if (kt1 < 9) { pw.z = pk2(s[kt1 < 9 ? kt1 : 0][0], s[kt1 < 9 ? kt1 : 0][1]); pw.w = pk2(s[kt1 < 9 ? kt1 : 0][2], s[kt1 < 9 ? kt1 : 0][3]); } else { pw.z = 0u; pw.w = 0u; }
            const bf16x8 pf = __builtin_bit_cast(bf16x8, pw);
            const int kb0 = 16 * (w + kt0) + 4 * fq, kb1 = 16 * (w + kt1) + 4 * fq;
#pragma unroll
            for (int nt = 0; nt < 4; ++nt) { const int d = 16 * nt + fr;
                v2u va = *(const LAS v2u*)(lds + AT_VT + d * AT_VSTR + kb0 * 2), vb = (v2u){0u, 0u};
                if (kt1 < 9) vb = *(const LAS v2u*)(lds + AT_VT + d * AT_VSTR + kb1 * 2);
                v4u vw; vw.x = va.x; vw.y = va.y; vw.z = vb.x; vw.w = vb.y;
                o[nt] = __builtin_amdgcn_mfma_f32_16x16x32_bf16(__builtin_bit_cast(bf16x8, vw), pf, o[nt], 0, 0, 0); }
        }
        const float il = 1.0f / l;
        bf16* op = OG + ((size_t)g * T + (size_t)b * SEQ + tq) * DILW + h * 64 + 4 * fq;
#pragma unroll
        for (int nt = 0; nt < 4; ++nt) { v2u ww; ww.x = pk2(o[nt][0] * il, o[nt][1] * il); ww.y = pk2(o[nt][2] * il, o[nt][3] * il); *(v2u*)(op + 16 * nt) = ww; }
        if (fq == 0) LSE[((size_t)g * T + (size_t)b * SEQ + tq) * 8 + h] = mx + logf(l);
    }
}
__device__ __forceinline__ void phase_combine(const Frame& F, const bf16* OG, const float* LSE, bf16* O) {
    for (int it0 = F.bid * 512 + F.tid; it0 < T * 64; it0 += 4 * F.G * 512) {
        float ls[4][3]; v4u og[4][3];
#pragma unroll
        for (int u = 0; u < 4; ++u) { int it = it0 + u * F.G * 512; it = it < T * 64 ? it : it0;
            const int c8 = it & 7, h = (it >> 3) & 7, t = it >> 6; const size_t off = (size_t)t * DILW + h * 64 + c8 * 8;
#pragma unroll
            for (int g = 0; g < 3; ++g) { ls[u][g] = LSE[((size_t)g * T + t) * 8 + h]; og[u][g] = *(const v4u*)(OG + (size_t)g * T * DILW + off); } }
#pragma unroll
        for (int u = 0; u < 4; ++u) asm volatile("" : "+v"(ls[u][0]), "+v"(ls[u][1]), "+v"(ls[u][2]), "+v"(og[u][0]), "+v"(og[u][1]), "+v"(og[u][2]));
#pragma unroll
        for (int u = 0; u < 4; ++u) { const int it = it0 + u * F.G * 512, c8 = it & 7, h = (it >> 3) & 7, t = it >> 6; const size_t off = (size_t)t * DILW + h * 64 + c8 * 8;
            if (it >= T * 64) continue;
            const float l0 = ls[u][0], l1 = ls[u][1], l2 = ls[u][2];
            const float m = fmaxf(l0, fmaxf(l1, l2)); float w0 = __expf(l0 - m), w1 = __expf(l1 - m), w2 = __expf(l2 - m); const float inv = 1.0f / (w0 + w1 + w2); w0 *= inv; w1 *= inv; w2 *= inv;
            float a[8], bq[8], c[8], o[8];
            unpack8(og[u][0], a); unpack8(og[u][1], bq); unpack8(og[u][2], c);
#pragma unroll
            for (int q = 0; q < 8; ++q) o[q] = w0 * a[q] + w1 * bq[q] + w2 * c[q];
            v4u ww; ww.x = pk2(o[0], o[1]); ww.y = pk2(o[2], o[3]); ww.z = pk2(o[4], o[5]); ww.w = pk2(o[6], o[7]);
            *(v4u*)(O + off) = ww; }
    }
}

constexpr int M1_LOG = 131072, M1_STAT = M1_LOG + 4096, M1_HIST = M1_STAT + 128, M1_BASE = M1_HIST + 256;
__device__ __forceinline__ void phase_moe1(const Frame& F, const float* Y, const float* gain, const float* bias, const float* RW, const float* RB,
                                           float* X1F, bf16* X1B, unsigned* cnt, int* ltok, float* lgate, int* eidx, int* inv) {
    LAS float* xs = (LAS float*)F.lds; LAS float* logit = (LAS float*)(F.lds + M1_LOG); LAS float* stat = (LAS float*)(F.lds + M1_STAT);
    LAS int* hist = (LAS int*)(F.lds + M1_HIST); LAS int* basep = (LAS int*)(F.lds + M1_BASE);
    const int tid = F.tid, lane = F.lane, w = F.wave;
    for (int rg = F.bid; rg < T / 16; rg += F.G) {
        const int row0 = rg * 16;
        __syncthreads();
#pragma unroll
        for (int j = 0; j < 16; ++j) { const int idx = tid + 512 * j; *(LAS f32x4*)(xs + idx * 4) = *(const f32x4*)(Y + (size_t)row0 * D + (size_t)idx * 4); }
        if (tid < 64) hist[tid] = 0;
        __syncthreads();
#pragma unroll
        for (int rr = 0; rr < 2; ++rr) { const int r = 2 * w + rr; float sm = 0.f;
#pragma unroll
            for (int j = 0; j < 32; ++j) sm += xs[r * D + lane + 64 * j];
            const float mean = wave_sum(sm, lane) * (1.0f / D); float sq = 0.f;
#pragma unroll
            for (int j = 0; j < 32; ++j) { const float d = xs[r * D + lane + 64 * j] - mean; sq += d * d; }
            const float rstd = 1.0f / sqrtf(wave_sum(sq, lane) * (1.0f / D) + LN_EPS);
            if (lane == 0) { stat[2 * r] = mean; stat[2 * r + 1] = rstd; } }
        __syncthreads();
#pragma unroll
        for (int j = 0; j < 16; ++j) { const int idx = tid + 512 * j, r = idx >> 9, c4 = (idx & 511) * 4;
            const f32x4 v = *(LAS f32x4*)(xs + idx * 4), gv = *(const f32x4*)(gain + c4), bv = *(const f32x4*)(bias + c4);
            const float mean = stat[2 * r], rstd = stat[2 * r + 1];
            const f32x4 o = (v - mean) * rstd * gv + bv;
            *(LAS f32x4*)(xs + idx * 4) = o;
            *(f32x4*)(X1F + (size_t)(row0 + r) * D + c4) = o;
            v2u wb; wb.x = pk2(o[0], o[1]); wb.y = pk2(o[2], o[3]); *(v2u*)(X1B + (size_t)(row0 + r) * D + c4) = wb; }
        __syncthreads();
        { const int r = tid >> 5, ep = tid & 31; float a0 = 0.f, a1 = 0.f; const float* wp = RW + 2 * ep; const LAS float* xr = xs + r * D;
            for (int k0 = 0; k0 < D; k0 += 16) {
                f32x2 wv[16];
#pragma unroll
                for (int j = 0; j < 16; ++j) wv[j] = *(const f32x2*)(wp + (size_t)(k0 + j) * NEXP);
                asm volatile("" : "+v"(wv[0]), "+v"(wv[1]), "+v"(wv[2]), "+v"(wv[3]), "+v"(wv[4]), "+v"(wv[5]), "+v"(wv[6]), "+v"(wv[7]));
                asm volatile("" : "+v"(wv[8]), "+v"(wv[9]), "+v"(wv[10]), "+v"(wv[11]), "+v"(wv[12]), "+v"(wv[13]), "+v"(wv[14]), "+v"(wv[15]));
#pragma unroll
                for (int j = 0; j < 16; ++j) { const float xv = xr[k0 + j]; a0 += xv * wv[j].x; a1 += xv * wv[j].y; } }
            logit[r * NEXP + 2 * ep] = a0; logit[r * NEXP + 2 * ep + 1] = a1; }
        __syncthreads();
        int sel_pos[2]; float sel_gate[2]; int sel_rank[2]; bool sel_on[2];
#pragma unroll
        for (int rr = 0; rr < 2; ++rr) { const int r = 2 * w + rr;
            const float sc = 1.0f / (1.0f + __expf(-logit[r * NEXP + lane])); const float ch = sc + RB[lane];
            int rk = 0;
#pragma unroll
            for (int j = 0; j < 8; ++j) { const float cj = shfl_from(ch, (lane & ~7) + j); rk += (cj > ch || (cj == ch && j < (lane & 7))) ? 1 : 0; }
            float gs = rk < 2 ? ch : 0.f; gs += shfl_x(gs, 1, lane); gs += shfl_x(gs, 2, lane); gs += shfl_x(gs, 4, lane);
            int grk = 0; const int g = lane >> 3;
#pragma unroll
            for (int hh = 0; hh < 8; ++hh) { const float gh = shfl_from(gs, 8 * hh); grk += (gh > gs || (gh == gs && hh < g)) ? 1 : 0; }
            const float msk = grk < 4 ? ch : -INFINITY;
            int erk = 0;
            for (int j = 0; j < 64; ++j) { const float mj = __builtin_bit_cast(float, __builtin_amdgcn_readlane(__builtin_bit_cast(int, msk), j)); erk += (mj > msk || (mj == msk && j < lane)) ? 1 : 0; }
            const bool on = erk < 8;
            const float ssum = wave_sum(on ? sc : 0.f, lane);
            sel_on[rr] = on; sel_rank[rr] = erk; sel_gate[rr] = sc / ssum * 2.5f; sel_pos[rr] = 0;
            if (on) sel_pos[rr] = __hip_atomic_fetch_add(&hist[lane], 1, __ATOMIC_RELAXED, __HIP_MEMORY_SCOPE_WORKGROUP); }
        __syncthreads();
        if (tid < 64) { const int hc = hist[tid]; int bs = 0; if (hc > 0) bs = (int)atomicAdd(&cnt[tid * 16], (unsigned)hc); basep[tid] = bs; }
        __syncthreads();
#pragma unroll
        for (int rr = 0; rr < 2; ++rr) if (sel_on[rr]) { const int t = row0 + 2 * w + rr, pos = basep[lane] + sel_pos[rr];
            ltok[(size_t)lane * CAP + pos] = t; lgate[(size_t)lane * CAP + pos] = sel_gate[rr];
            eidx[t * 8 + sel_rank[rr]] = lane; inv[t * 8 + sel_rank[rr]] = pos; }
    }
}
__device__ __forceinline__ int build_tiles(const Frame& F, const unsigned* cnt) {
    LAS int* tpref = (LAS int*)(F.lds + LDS_TAB); LAS int* cl = (LAS int*)(F.lds + LDS_TAB + 512);
    __syncthreads();
    if (F.tid < 64) cl[F.tid] = (int)__hip_atomic_load(&cnt[F.tid * 16], __ATOMIC_RELAXED, __HIP_MEMORY_SCOPE_AGENT);
    __syncthreads();
    if (F.tid == 0) { int acc = 0; for (int e = 0; e < 64; ++e) { tpref[e] = acc; acc += (cl[e] + 255) >> 8; } tpref[64] = acc; tpref[65] = acc + T / 256; tpref[66] = acc + 2 * (T / 256); cl[64] = T; cl[65] = T; }
    __syncthreads();
    return __builtin_amdgcn_readfirstlane(tpref[64]);
}
__device__ __forceinline__ void phase_moe4(const Frame& F, const float* Y2, const bf16* Yr, const int* eidx, const int* inv, const float* gain, const float* bias, float* XO, bf16* XBo) {
    const LAS int* tpref = (const LAS int*)(F.lds + LDS_TAB);
    const int gw = F.bid * 8 + F.wave, NGW = F.G * 8, lane = F.lane;
    for (int t = gw; t < T; t += NGW) {
        f32x4 v[8];
#pragma unroll
        for (int j = 0; j < 8; ++j) v[j] = *(const f32x4*)(Y2 + (size_t)t * D + 4 * lane + 256 * j);
        for (int k = 0; k < 8; ++k) { const int e = eidx[t * 8 + k], pos = inv[t * 8 + k]; const bf16* yr = Yr + (size_t)(tpref[e] * 256 + pos) * D + 4 * lane;
#pragma unroll
            for (int j = 0; j < 8; ++j) { const v2u w = *(const v2u*)(yr + 256 * j); v[j][0] += bflo(w.x); v[j][1] += bfhi(w.x); v[j][2] += bflo(w.y); v[j][3] += bfhi(w.y); } }
        float sm = 0.f;
#pragma unroll
        for (int j = 0; j < 8; ++j) sm += (v[j][0] + v[j][1]) + (v[j][2] + v[j][3]);
        const float mean = wave_sum(sm, lane) * (1.0f / D); float sq = 0.f;
#pragma unroll
        for (int j = 0; j < 8; ++j) { v[j] = v[j] - mean; sq += (v[j][0] * v[j][0] + v[j][1] * v[j][1]) + (v[j][2] * v[j][2] + v[j][3] * v[j][3]); }
        const float rstd = 1.0f / sqrtf(wave_sum(sq, lane) * (1.0f / D) + LN_EPS);
#pragma unroll
        for (int j = 0; j < 8; ++j) { const int c = 4 * lane + 256 * j; const f32x4 o = v[j] * rstd * *(const f32x4*)(gain + c) + *(const f32x4*)(bias + c);
            *(f32x4*)(XO + (size_t)t * D + c) = o;
            v2u wb; wb.x = pk2(o[0], o[1]); wb.y = pk2(o[2], o[3]); *(v2u*)(XBo + (size_t)t * D + c) = wb; }
    }
}


template <int CTRL> __device__ __forceinline__ float dppf(float x) { return __builtin_bit_cast(float, __builtin_amdgcn_update_dpp(0, __builtin_bit_cast(int, x), CTRL, 0xF, 0xF, false)); }
__device__ __forceinline__ float gmax8(float x) { x = fmaxf(x, dppf<0xB1>(x)); x = fmaxf(x, dppf<0x4E>(x)); x = fmaxf(x, dppf<0x141>(x)); return x; }
__device__ __forceinline__ float gsum8(float x) { x += dppf<0xB1>(x); x += dppf<0x4E>(x); x += dppf<0x141>(x); return x; }
__device__ __forceinline__ float rl_f(float x, int l) { return __builtin_bit_cast(float, __builtin_amdgcn_readlane(__builtin_bit_cast(int, x), l)); }
constexpr int M1_P = 0, M1N_HIST = 131072, M1N_BASE = 131072 + 256, M1N_GB = 131072 + 1024;
__device__ __forceinline__ void phase_moe1n(const Frame& F, const bf16* Y, const float* pst, const float* gain, const float* bias, const bf16* WH, const bf16* WL, const float* RB,
                                            bf16* X1B, float* ST1, unsigned* cnt, int* ltok, float* lgate, int* eidx, int* inv) {
    LAS float* P = (LAS float*)(F.lds + M1_P); LAS int* hist = (LAS int*)(F.lds + M1N_HIST); LAS int* basep = (LAS int*)(F.lds + M1N_BASE);
    const int tid = F.tid, lane = F.lane, w = F.wave, r = lane & 15, q = lane >> 4;
    for (int item = F.bid; item < T / 64; item += F.G) {
        const int row0 = item * 64;
        __syncthreads();
        { int t0 = tid; asm volatile("" : "+v"(t0));
          if (t0 < 64) hist[t0] = 0;
          LAS f32x4* gb = (LAS f32x4*)(F.lds + M1N_GB); gb[t0] = *(const f32x4*)(gain + 4 * t0); gb[512 + t0] = *(const f32x4*)(bias + 4 * t0); }
        __syncthreads();
        float mean[4], rstd[4];
#pragma unroll
        for (int rt = 0; rt < 4; ++rt) { const int row = row0 + 16 * rt + r;
          const f32x4* pp = (const f32x4*)(pst + ((size_t)row * 32 + q * 8) * 2); const f32x4 a = pp[0], b = pp[1], c = pp[2], d = pp[3];
          float sm = (a[0] + a[2]) + (b[0] + b[2]) + (c[0] + c[2]) + (d[0] + d[2]), sq = (a[1] + a[3]) + (b[1] + b[3]) + (c[1] + c[3]) + (d[1] + d[3]);
          sm += shfl_x(sm, 16, lane); sm += shfl_x(sm, 32, lane); sq += shfl_x(sq, 16, lane); sq += shfl_x(sq, 32, lane);
          mean[rt] = sm * (1.0f / D); const float var = fmaxf(sq * (1.0f / D) - mean[rt] * mean[rt], 0.f); rstd[rt] = 1.0f / sqrtf(var + LN_EPS);
          if (w == 0 && q == 0) *(f32x2*)(ST1 + 2 * row) = (f32x2){mean[rt], rstd[rt]}; }
        const int kb = 256 * w + 8 * q;
        const LAS float* gl = (const LAS float*)(F.lds + M1N_GB) + kb;
        f32x4 acc[4][4];
#pragma unroll
        for (int rt = 0; rt < 4; ++rt)
#pragma unroll
            for (int nt = 0; nt < 4; ++nt) acc[rt][nt] = (f32x4){0.f, 0.f, 0.f, 0.f};
        v4u yb[2][2][4], hb[4]; bf16x8 wh[4], wl[4];
        unsigned vo[4];
#pragma unroll
        for (int i = 0; i < 4; ++i) { vo[i] = (unsigned)(r * D + kb) * 2u + (unsigned)i * (16u * D * 2u); asm volatile("" : "+v"(vo[i])); }
        const char* ybase = (const char*)(Y + (size_t)row0 * D); char* xbase = (char*)(X1B + (size_t)row0 * D);
#define M1_LOADY(ms) do { _Pragma("unroll") for (int hf = 0; hf < 2; ++hf) _Pragma("unroll") for (int rt = 0; rt < 4; ++rt) yb[(ms) & 1][hf][rt] = *(const v4u*)(ybase + vo[rt] + 128 * (ms) + 64 * hf); } while (0)
#define M1_LOADW(st) do { _Pragma("unroll") for (int nt = 0; nt < 4; ++nt) { wh[nt] = *(const bf16x8*)((const char*)WH + vo[nt] + 64 * (st)); wl[nt] = *(const bf16x8*)((const char*)WL + vo[nt] + 64 * (st)); } } while (0)
        M1_LOADY(0); M1_LOADW(0); M1_LOADY(1);
        __builtin_amdgcn_sched_barrier(0);
#pragma unroll
        for (int st = 0; st < 8; ++st) {
            const f32x4 g0 = *(const LAS f32x4*)(gl + 32 * st), g1 = *(const LAS f32x4*)(gl + 32 * st + 4), b0 = *(const LAS f32x4*)(gl + 2048 + 32 * st), b1 = *(const LAS f32x4*)(gl + 2048 + 32 * st + 4);
#pragma unroll
            for (int rt = 0; rt < 4; ++rt) { const v4u yv = yb[(st >> 1) & 1][st & 1][rt];
                const f32x4 y0_ = (f32x4){bflo(yv.x), bfhi(yv.x), bflo(yv.y), bfhi(yv.y)}, y1_ = (f32x4){bflo(yv.z), bfhi(yv.z), bflo(yv.w), bfhi(yv.w)};
                const f32x4 x0 = (y0_ - mean[rt]) * rstd[rt] * g0 + b0, x1 = (y1_ - mean[rt]) * rstd[rt] * g1 + b1;
                v4u h; h.x = cvt_pk_bf16(x0[0], x0[1]); h.y = cvt_pk_bf16(x0[2], x0[3]); h.z = cvt_pk_bf16(x1[0], x1[1]); h.w = cvt_pk_bf16(x1[2], x1[3]);
                if ((st & 1) == 0) hb[rt] = h; else { *(v4u*)(xbase + vo[rt] + 64 * (st - 1)) = hb[rt]; *(v4u*)(xbase + vo[rt] + 64 * st) = h; }
                v4u l; l.x = cvt_pk_bf16(x0[0] - bflo(h.x), x0[1] - bfhi(h.x)); l.y = cvt_pk_bf16(x0[2] - bflo(h.y), x0[3] - bfhi(h.y));
                l.z = cvt_pk_bf16(x1[0] - bflo(h.z), x1[1] - bfhi(h.z)); l.w = cvt_pk_bf16(x1[2] - bflo(h.w), x1[3] - bfhi(h.w));
                const bf16x8 xh = __builtin_bit_cast(bf16x8, h), xl = __builtin_bit_cast(bf16x8, l);
#pragma unroll
                for (int nt = 0; nt < 4; ++nt) { acc[rt][nt] = __builtin_amdgcn_mfma_f32_16x16x32_bf16(xh, wh[nt], acc[rt][nt], 0, 0, 0);
                    acc[rt][nt] = __builtin_amdgcn_mfma_f32_16x16x32_bf16(xl, wh[nt], acc[rt][nt], 0, 0, 0); acc[rt][nt] = __builtin_amdgcn_mfma_f32_16x16x32_bf16(xh, wl[nt], acc[rt][nt], 0, 0, 0); } }
            __builtin_amdgcn_sched_barrier(0);
            if (st + 1 < 8) M1_LOADW(st + 1);
            if ((st & 1) == 1 && (st >> 1) + 2 < 4) M1_LOADY((st >> 1) + 2);
            __builtin_amdgcn_sched_barrier(0);
        }
#undef M1_LOADY
#undef M1_LOADW
#pragma unroll
        for (int rt = 0; rt < 4; ++rt)
#pragma unroll
            for (int nt = 0; nt < 4; ++nt)
#pragma unroll
                for (int i = 0; i < 4; ++i) P[(w * 64 + 16 * rt + 4 * q + i) * 64 + 16 * nt + r] = acc[rt][nt][i];
        __syncthreads();
        const float rb = RB[lane];
        LAS int* Pi = (LAS int*)P;
#pragma unroll 1
        for (int rr = 0; rr < 8; ++rr) { const int rl = 8 * w + rr;
            float lg = ((P[rl * 64 + lane] + P[(64 + rl) * 64 + lane]) + (P[(128 + rl) * 64 + lane] + P[(192 + rl) * 64 + lane])) + ((P[(256 + rl) * 64 + lane] + P[(320 + rl) * 64 + lane]) + (P[(384 + rl) * 64 + lane] + P[(448 + rl) * 64 + lane]));
            lg = (lg == lg) ? lg : -1.0e30f;
            const float sc = 1.0f / (1.0f + __expf(-lg)); const float ch = sc + rb;
            const float m1 = gmax8(ch), neq = gsum8(ch == m1 ? 1.f : 0.f), m2c = gmax8(ch < m1 ? ch : -INFINITY);
            const float gs = m1 + (neq >= 2.f ? m1 : m2c);
            int grk = 0; const int g = lane >> 3;
#pragma unroll
            for (int hh = 0; hh < 8; ++hh) { const float gh = rl_f(gs, 8 * hh); grk += (gh > gs || (gh == gs && hh < g)) ? 1 : 0; }
            const float msk = grk < 4 ? ch : -INFINITY;
            float cur = msk, ssum = 0.f; int erk = 64;
#pragma unroll 1
            for (int k = 0; k < 8; ++k) {
                float rm = gmax8(cur); rm = fmaxf(rm, dppf<0x140>(rm));
                const float wm = fmaxf(fmaxf(rl_f(rm, 0), rl_f(rm, 16)), fmaxf(rl_f(rm, 32), rl_f(rm, 48)));
                const unsigned long long bal = __builtin_amdgcn_ballot_w64(cur == wm);
                const int lsel = __builtin_amdgcn_readfirstlane((int)__builtin_ctzll(bal));
                ssum += rl_f(sc, lsel);
                const bool me = lane == lsel; erk = me ? k : erk; cur = me ? -INFINITY : cur; }
            const bool on = erk < 8;
            int pk_ = -1; if (on) pk_ = __hip_atomic_fetch_add(&hist[lane], 1, __ATOMIC_RELAXED, __HIP_MEMORY_SCOPE_WORKGROUP) | (erk << 16);
            P[rl * 64 + lane] = sc / ssum * 2.5f; Pi[(64 + rl) * 64 + lane] = pk_; }
        __syncthreads();
        if (tid < 64) { int tt = tid; asm volatile("" : "+v"(tt));
            const int hc = hist[tt]; int bs = 0; if (hc > 0) bs = (int)atomicAdd(&cnt[tt * 16], (unsigned)hc); basep[tt] = bs; }
        __syncthreads();
        { const int bl = basep[lane];
#pragma unroll 1
          for (int rr = 0; rr < 8; ++rr) { const int rl = 8 * w + rr; const int pk_ = Pi[(64 + rl) * 64 + lane]; const float gt_ = P[rl * 64 + lane];
            if (pk_ >= 0) { const int t = row0 + rl, pos = bl + (pk_ & 0xffff), rk_ = pk_ >> 16;
                ltok[(size_t)lane * CAP + pos] = t * 8 + rk_; lgate[(size_t)lane * CAP + pos] = gt_;
                eidx[t * 8 + rk_] = lane; inv[t * 8 + rk_] = pos; } } }
    }
}

constexpr int M3_PL = 131072, M3_CNT = 147456, M3_OFF = 147456 + 272;
__device__ __forceinline__ void phase_moe3n(const Frame& F, const bf16* H, const bf16* HSp, const int* eidx, const bf16* WD, const bf16* WSD,
                                            const float* Y1, const float* ST1, const float* g1, const float* b1, float* Y2, float* PST2) {
    LAS int* out = (LAS int*)F.lds; LAS unsigned short* plist = (LAS unsigned short*)(F.lds + M3_PL); LAS int* cnt = (LAS int*)(F.lds + M3_CNT); LAS int* off = (LAS int*)(F.lds + M3_OFF);
    const int tid = F.tid, lane = F.lane, w = F.wave, r = lane & 15, q = lane >> 4;
    for (int u = F.bid; u < 1024; u += F.G) {
        int nc = (u & 7) | ((u >> 7) << 3), tb = (u >> 3) & 15;
        if (F.G == 256) { const int i = u >> 8, x = u & 7, j = (u >> 3) & 31; tb = 2 * x + (i >> 1); nc = 32 * (i & 1) + j; }
        __syncthreads();
#pragma unroll
        for (int j = 0; j < 16; ++j) ((LAS v4u*)out)[tid + 512 * j] = (v4u){0u, 0u, 0u, 0u};
        if (tid < 66) cnt[tid] = 0;
        __syncthreads();
        int ee[16], pp[16];
        { const v4u* ep = (const v4u*)(eidx + ((size_t)tb * 1024 + 2 * tid) * 8); const v4u e0 = ep[0], e1 = ep[1], e2 = ep[2], e3 = ep[3];
          ee[0] = e0.x; ee[1] = e0.y; ee[2] = e0.z; ee[3] = e0.w; ee[4] = e1.x; ee[5] = e1.y; ee[6] = e1.z; ee[7] = e1.w;
          ee[8] = e2.x; ee[9] = e2.y; ee[10] = e2.z; ee[11] = e2.w; ee[12] = e3.x; ee[13] = e3.y; ee[14] = e3.z; ee[15] = e3.w; }
#pragma unroll
        for (int j = 0; j < 16; ++j) pp[j] = __hip_atomic_fetch_add(&cnt[ee[j]], 1, __ATOMIC_RELAXED, __HIP_MEMORY_SCOPE_WORKGROUP);
        __syncthreads();
        if (w == 0) { int c = cnt[lane], x = c;
#pragma unroll
            for (int o = 1; o < 64; o <<= 1) { const int y = __builtin_amdgcn_ds_bpermute(((lane - o) & 63) << 2, x); if (lane >= o) x += y; }
            off[lane] = x - c; if (lane == 63) off[64] = x; }
        __syncthreads();
#pragma unroll
        for (int j = 0; j < 16; ++j) plist[off[ee[j]] + pp[j]] = (unsigned short)(tid * 16 + j);
        __syncthreads();
        const char* Hb = (const char*)H + (size_t)tb * 8192 * 256 + q * 16;
        const char* HSb = (const char*)HSp + (size_t)tb * 1024 * 512 + q * 16;
        const char* Bb = (const char*)WD + ((size_t)nc * 32 + r) * 256 + q * 16;
        const char* BSb = (const char*)WSD + ((size_t)nc * 32 + r) * 512 + q * 16;
#define M3_NR(sg) ((sg) < 8 ? __builtin_amdgcn_readfirstlane(cnt[w + 8 * (sg)]) : 128)
#define M3_RB(sg) ((sg) < 8 ? __builtin_amdgcn_readfirstlane(off[w + 8 * (sg)]) : 0)
#define M3_GLD(dst, ptr, OFF) asm volatile("global_load_dwordx4 %0, %1, off offset:" #OFF : "=&v"(dst) : "v"(ptr) : "memory")
#define M3_LOADB(dst, sg) do { const char* _b0 = (sg) < 8 ? Bb + (size_t)(w + 8 * (sg)) * 524288 : BSb + ((sg) - 8) * 256; const char* _b1 = _b0 + ((sg) < 8 ? 4096 : 8192); \
            M3_GLD(dst[0][0], _b0, 0); M3_GLD(dst[0][1], _b0, 64); M3_GLD(dst[0][2], _b0, 128); M3_GLD(dst[0][3], _b0, 192); \
            M3_GLD(dst[1][0], _b1, 0); M3_GLD(dst[1][1], _b1, 64); M3_GLD(dst[1][2], _b1, 128); M3_GLD(dst[1][3], _b1, 192); } while (0)
#define M3_LOADA(dst, sg, bb, nr, rbs) do { int _i = 16 * (bb) + r; _i = _i < (nr) ? _i : (nr) - 1; const unsigned _rid = plist[(rbs) + _i]; \
            const char* _a = (sg) < 8 ? Hb + (size_t)_rid * 256 : ((sg) < 10 ? HSb + (size_t)(128 * w + _i) * 512 + ((sg) - 8) * 256 : Hb); \
            M3_GLD(dst[0], _a, 0); M3_GLD(dst[1], _a, 64); M3_GLD(dst[2], _a, 128); M3_GLD(dst[3], _a, 192); } while (0)
#define M3_ADV(sg, bb, nr, rbs) do { if ((sg) < 10) { ++(bb); if ((bb) * 16 >= (nr)) { (bb) = 0; do { ++(sg); } while ((sg) < 8 && M3_NR(sg) == 0); if ((sg) < 10) { (nr) = M3_NR(sg); (rbs) = M3_RB(sg); } } } } while (0)
#define M3_WAITA(AS) asm volatile("s_waitcnt vmcnt(12)" : "+v"(AS[0]), "+v"(AS[1]), "+v"(AS[2]), "+v"(AS[3]) :: "memory")
#define M3_WAITB(N) asm volatile("s_waitcnt vmcnt(" #N ")" : "+v"(Bn[0][0]), "+v"(Bn[0][1]), "+v"(Bn[0][2]), "+v"(Bn[0][3]), "+v"(Bn[1][0]), "+v"(Bn[1][1]), "+v"(Bn[1][2]), "+v"(Bn[1][3]) :: "memory")
#define M3_STEP(AS) if (cseg < 10) { \
              \
            int tk[4]; bool ok[4]; unsigned pl[4]; const int rt_ = cseg < 8; \
            _Pragma("unroll") for (int i = 0; i < 4; ++i) { const int idx = 16 * cbt + 4 * q + i; ok[i] = idx < cnr; const int ic = ok[i] ? idx : cnr - 1; pl[i] = plist[crbs + ic]; tk[i] = 128 * w + ic; } \
            _Pragma("unroll") for (int i = 0; i < 4; ++i) tk[i] = rt_ ? (int)(pl[i] >> 3) : tk[i]; \
            M3_WAITA(AS); \
            f32x4 acc[2]; \
            _Pragma("unroll") for (int nt = 0; nt < 2; ++nt) { acc[nt] = (f32x4){0.f, 0.f, 0.f, 0.f}; \
                _Pragma("unroll") for (int kk = 0; kk < 4; ++kk) acc[nt] = __builtin_amdgcn_mfma_f32_16x16x32_bf16(__builtin_bit_cast(bf16x8, AS[kk]), __builtin_bit_cast(bf16x8, Bc[nt][kk]), acc[nt], 0, 0, 0); } \
              \
            _Pragma("unroll") for (int i = 0; i < 4; ++i) { const long long lo_ = ok[i] ? (long long)__float2int_rn(acc[0][i] * 4194304.0f) : 0ll, hi_ = ok[i] ? (long long)__float2int_rn(acc[1][i] * 4194304.0f) : 0ll; \
                (void)__hip_atomic_fetch_add((LAS unsigned long long*)out + tk[i] * 16 + r, (unsigned long long)((hi_ << 32) + lo_), __ATOMIC_RELAXED, __HIP_MEMORY_SCOPE_WORKGROUP); } \
            M3_LOADA(AS, pseg, pbt, pnr, prbs); M3_ADV(pseg, pbt, pnr, prbs); \
            { const int old_ = cseg, nbat_ = (cnr + 15) >> 4; M3_ADV(cseg, cbt, cnr, crbs); \
              if (cseg != old_ && cseg < 10) { \
                  if (nbat_ == 1) M3_WAITB(4); else if (nbat_ == 2) M3_WAITB(8); else if (nbat_ == 3) M3_WAITB(12); else M3_WAITB(16); \
                  _Pragma("unroll") for (int nt = 0; nt < 2; ++nt) _Pragma("unroll") for (int kk = 0; kk < 4; ++kk) Bc[nt][kk] = Bn[nt][kk]; \
                  int nb_ = cseg; do { ++nb_; } while (nb_ < 8 && M3_NR(nb_) == 0); if (nb_ >= 10) nb_ = 9; M3_LOADB(Bn, nb_); } } }
        int cseg = -1, cbt = 0, cnr = 0, crbs = 0;
        do { ++cseg; } while (cseg < 8 && M3_NR(cseg) == 0);
        cnr = M3_NR(cseg); crbs = M3_RB(cseg);
        int pseg = cseg, pbt = 0, pnr = cnr, prbs = crbs;
        v4u Bc[2][4], Bn[2][4], A0[4], A1[4], A2[4], A3[4];
        M3_LOADB(Bc, cseg);
        M3_LOADA(A0, pseg, pbt, pnr, prbs); M3_ADV(pseg, pbt, pnr, prbs);
        M3_LOADA(A1, pseg, pbt, pnr, prbs); M3_ADV(pseg, pbt, pnr, prbs);
        M3_LOADA(A2, pseg, pbt, pnr, prbs); M3_ADV(pseg, pbt, pnr, prbs);
        M3_LOADA(A3, pseg, pbt, pnr, prbs); M3_ADV(pseg, pbt, pnr, prbs);
        { int nb_ = cseg; do { ++nb_; } while (nb_ < 8 && M3_NR(nb_) == 0); if (nb_ >= 10) nb_ = 9; M3_LOADB(Bn, nb_); }
        asm volatile("s_waitcnt vmcnt(0)" : "+v"(Bc[0][0]), "+v"(Bc[0][1]), "+v"(Bc[0][2]), "+v"(Bc[0][3]), "+v"(Bc[1][0]), "+v"(Bc[1][1]), "+v"(Bc[1][2]), "+v"(Bc[1][3]) :: "memory");
#pragma unroll 1
        while (cseg < 10) { M3_STEP(A0) M3_STEP(A1) M3_STEP(A2) M3_STEP(A3) }
        asm volatile("s_waitcnt vmcnt(0)" : "+v"(A0[0]), "+v"(A0[1]), "+v"(A0[2]), "+v"(A0[3]), "+v"(A1[0]), "+v"(A1[1]), "+v"(A1[2]), "+v"(A1[3]), "+v"(A2[0]), "+v"(A2[1]), "+v"(A2[2]), "+v"(A2[3]),
                     "+v"(A3[0]), "+v"(A3[1]), "+v"(A3[2]), "+v"(A3[3]), "+v"(Bn[0][0]), "+v"(Bn[0][1]), "+v"(Bn[0][2]), "+v"(Bn[0][3]), "+v"(Bn[1][0]), "+v"(Bn[1][1]), "+v"(Bn[1][2]), "+v"(Bn[1][3]) :: "memory");
#undef M3_NR
#undef M3_RB
#undef M3_GLD
#undef M3_LOADB
#undef M3_LOADA
#undef M3_ADV
#undef M3_WAITA
#undef M3_WAITB
#undef M3_STEP
        __syncthreads();
        { const int c4 = lane & 7, rs = lane >> 3, col = nc * 32 + 4 * c4;
          const f32x4 gv = *(const f32x4*)(g1 + col), bv = *(const f32x4*)(b1 + col);
#pragma unroll 4
          for (int it = 0; it < 16; ++it) { const int rl = 128 * w + 8 * it + rs; const size_t row = (size_t)tb * 1024 + rl;
              const f32x4 yv = *(const f32x4*)(Y1 + row * D + col); const f32x2 sv = *(const f32x2*)(ST1 + 2 * row);
              f32x4 tv; { const int nt = c4 >> 2, r0 = (4 * c4) & 15;
#pragma unroll
                  for (int j = 0; j < 4; ++j) { const v2u cell = *(const LAS v2u*)(out + rl * 32 + 2 * (r0 + j)); const int lo = (int)cell.x, hi = (int)cell.y + (lo < 0 ? 1 : 0); tv[j] = (float)(nt ? hi : lo) * (1.0f / 4194304.0f); } }
              const f32x4 y = ((yv - sv.x) * sv.y * gv + bv) * ALPHA + tv;
              *(f32x4*)(Y2 + row * D + col) = y;
              float sm = (y[0] + y[1]) + (y[2] + y[3]), sq = (y[0] * y[0] + y[1] * y[1]) + (y[2] * y[2] + y[3] * y[3]);
#pragma unroll
              for (int o = 1; o < 8; o <<= 1) { sm += shfl_x(sm, o, lane); sq += shfl_x(sq, o, lane); }
              if (c4 == 0) *(f32x2*)(PST2 + (row * 64 + nc) * 2) = (f32x2){sm, sq}; } }
    }
}

__device__ __forceinline__ void phase_moe4n(const Frame& F, const float* Y2, const float* pst, const float* gain, const float* bias, float* ST2, bf16* XBo, float* OUT, int last) {
    const int gw = F.bid * 8 + F.wave, NGW = F.G * 8, lane = F.lane;
    for (int t = gw; t < T; t += NGW) {
        f32x4 v[8];
#pragma unroll
        for (int j = 0; j < 8; ++j) v[j] = *(const f32x4*)(Y2 + (size_t)t * D + 4 * lane + 256 * j);
        const f32x2 pv = *(const f32x2*)(pst + ((size_t)t * 64 + lane) * 2);
        const float mean = wave_sum(pv.x, lane) * (1.0f / D); const float var = fmaxf(wave_sum(pv.y, lane) * (1.0f / D) - mean * mean, 0.f); const float rstd = 1.0f / sqrtf(var + LN_EPS);
        if (lane == 0) *(f32x2*)(ST2 + 2 * (size_t)t) = (f32x2){mean, rstd};
#pragma unroll
        for (int j = 0; j < 8; ++j) { const int c = 4 * lane + 256 * j; const f32x4 o = (v[j] - mean) * rstd * *(const f32x4*)(gain + c) + *(const f32x4*)(bias + c);
            if (last) *(f32x4*)(OUT + (size_t)t * D + c) = o;
            else { v2u wb; wb.x = pk2(o[0], o[1]); wb.y = pk2(o[2], o[3]); *(v2u*)(XBo + (size_t)t * D + c) = wb; } }
    }
}


__device__ __forceinline__ void phase_moe4q(const Frame& F, const bf16* X1, bf16* Y2, const unsigned char* Yq, const float* Ysc, const int* eidx, const int* inv, const float* gain, const float* bias, float* ST2, bf16* XBo, float* OUT, int last) {
    const LAS int* tpref = (const LAS int*)(F.lds + LDS_TAB);
    const int gw = F.bid * 8 + F.wave, NGW = F.G * 8, lane = F.lane;
    int en = 0, pn = 0; if (lane < 8 && gw < T) { en = eidx[gw * 8 + lane]; pn = inv[gw * 8 + lane]; }
    for (int t = gw; t < T; t += NGW) {
        int rowi = 0; if (lane < 8) rowi = tpref[en] * 256 + pn; else if (lane < 10) rowi = tpref[56 + lane] * 256 + t;
        if (lane < 8 && t + NGW < T) { en = eidx[(t + NGW) * 8 + lane]; pn = inv[(t + NGW) * 8 + lane]; }
        v4u pv[2][2], yv[10][2]; float sc[10][2];
#pragma unroll
        for (int j = 0; j < 2; ++j) { pv[j][0] = __builtin_nontemporal_load((const v4u*)(X1 + (size_t)t * D + 16 * lane + 1024 * j)); pv[j][1] = __builtin_nontemporal_load((const v4u*)(X1 + (size_t)t * D + 16 * lane + 1024 * j + 8)); }
#pragma unroll
        for (int k = 0; k < 10; ++k) { const size_t row = (size_t)__builtin_amdgcn_readlane(rowi, k);
#pragma unroll
            for (int j = 0; j < 2; ++j) { yv[k][j] = __builtin_nontemporal_load((const v4u*)(Yq + row * D + 16 * lane + 1024 * j)); sc[k][j] = __builtin_nontemporal_load(Ysc + row * 16 + 8 * j + (lane >> 3)); } }
#pragma unroll
        for (int k = 0; k < 10; ++k) asm volatile("" : "+v"(yv[k][0]), "+v"(yv[k][1]), "+v"(sc[k][0]), "+v"(sc[k][1]));
        float v[2][16];
#pragma unroll
        for (int j = 0; j < 2; ++j) { float f0[8], f1[8]; unpack8(pv[j][0], f0); unpack8(pv[j][1], f1);
            const float ss = (((sc[0][j] + sc[1][j]) + (sc[2][j] + sc[3][j])) + ((sc[4][j] + sc[5][j]) + (sc[6][j] + sc[7][j]))) + (sc[8][j] + sc[9][j]);
#pragma unroll
            for (int i = 0; i < 8; ++i) { v[j][i] = ALPHA * f0[i] - 128.f * ss; v[j][8 + i] = ALPHA * f1[i] - 128.f * ss; } }
#pragma unroll
        for (int k = 0; k < 10; ++k)
#pragma unroll
            for (int j = 0; j < 2; ++j) { const float s_ = sc[k][j]; const unsigned q[4] = {yv[k][j].x, yv[k][j].y, yv[k][j].z, yv[k][j].w};
#pragma unroll
                for (int d = 0; d < 4; ++d) { v[j][4 * d + 0] += s_ * (float)(q[d] & 0xffu); v[j][4 * d + 1] += s_ * (float)((q[d] >> 8) & 0xffu); v[j][4 * d + 2] += s_ * (float)((q[d] >> 16) & 0xffu); v[j][4 * d + 3] += s_ * (float)(q[d] >> 24); } }
        float sm = 0.f;
#pragma unroll
        for (int j = 0; j < 2; ++j)
#pragma unroll
            for (int i = 0; i < 16; i += 4) sm += (v[j][i] + v[j][i + 1]) + (v[j][i + 2] + v[j][i + 3]);
        const float mean = wave_sum(sm, lane) * (1.0f / D); float sq = 0.f;
#pragma unroll
        for (int j = 0; j < 2; ++j)
#pragma unroll
            for (int i = 0; i < 16; ++i) { const float d = v[j][i] - mean; sq += d * d; }
        const float rstd = 1.0f / sqrtf(wave_sum(sq, lane) * (1.0f / D) + LN_EPS);
        (void)ST2; (void)Y2;
#pragma unroll
        for (int j = 0; j < 2; ++j)
#pragma unroll
            for (int h = 0; h < 2; ++h) { const int c = 16 * lane + 1024 * j + 8 * h; const float* vv = &v[j][8 * h];
                const f32x4 g0 = *(const f32x4*)(gain + c), g1 = *(const f32x4*)(gain + c + 4), b0 = *(const f32x4*)(bias + c), b1 = *(const f32x4*)(bias + c + 4);
                const f32x4 o0 = ((f32x4){vv[0], vv[1], vv[2], vv[3]} - mean) * rstd * g0 + b0, o1 = ((f32x4){vv[4], vv[5], vv[6], vv[7]} - mean) * rstd * g1 + b1;
                if (last) { *(f32x4*)(OUT + (size_t)t * D + c) = o0; *(f32x4*)(OUT + (size_t)t * D + c + 4) = o1; }
                else { v4u wb; wb.x = pk2(o0[0], o0[1]); wb.y = pk2(o0[2], o0[3]); wb.z = pk2(o1[0], o1[1]); wb.w = pk2(o1[2], o1[3]); *(v4u*)(XBo + (size_t)t * D + c) = wb; } }
    }
}

__device__ __forceinline__ void phase_downproj3(const Frame& F, const bf16* H, const bf16* WD, const bf16* HSp, const bf16* WSD, unsigned char* Yq, float* Ysc, int NT) {
    const LAS int* tpref = (const LAS int*)(F.lds + LDS_TAB); const LAS int* cl = (const LAS int*)(F.lds + LDS_TAB + 512);
    LAS unsigned char* lds = F.lds;
    const int tid = F.tid, lane = F.lane, w = F.wave, fr = lane & 15, fq = lane >> 4;
    unsigned rbB[2], cbB[2];
#pragma unroll
    for (int i = 0; i < 2; ++i) { int R_, C_; g8::stage_rc(tid * 16 + i * 8192, R_, C_); rbB[i] = (unsigned)((R_ & ~31) + g8::perm32(R_ & 31)); cbB[i] = (unsigned)C_ * 2u; }
    const unsigned ldsw = (unsigned)w * 1024u, lbase = (unsigned)(size_t)lds;
    int boffg[4];
#pragma unroll
    for (int g = 0; g < 4; ++g) boffg[g] = g8::lds_byte(32 * g + fr, fq * 8);
    LAS unsigned char* stg = lds + 65536 + w * (32 * 144);
    const int NU = NT * 4;
    const int upos = (F.G % 8) == 0 ? (F.bid & 7) * (F.G >> 3) + (F.bid >> 3) : F.bid;
    int ub = 0;
    int u = (F.G <= NU) ? upos : F.bid; if (u >= NU) return;
#define DP3_UNITINFO(uu, E0, EXP, NV) do { const int tl_ = (uu) >> 2; int e_ = (E0); while (__builtin_amdgcn_readfirstlane(tpref[e_ + 1]) <= tl_) ++e_; EXP = e_; \
        NV = __builtin_amdgcn_readfirstlane(cl[e_]) - (tl_ - __builtin_amdgcn_readfirstlane(tpref[e_])) * 256; } while (0)
#define DP3_GLDS(gsrc, ldsdst) do { unsigned keep_; asm volatile("s_mov_b32 %0, m0\n\ts_mov_b32 m0, %2\n\ts_nop 0\n\tglobal_load_lds_dwordx4 %1, off\n\ts_mov_b32 m0, %0" : "=&s"(keep_) : "v"(gsrc), "s"(ldsdst) : "memory"); } while (0)
#define DP3_STAGE(slot, gb, bs) do { const unsigned v0_ = rbB[0] * (unsigned)(bs) + cbB[0], v1_ = rbB[1] * (unsigned)(bs) + cbB[1]; _Pragma("unroll") for (int kt = 0; kt < 2; ++kt) { \
        DP3_GLDS((const void*)((gb) + kt * 128 + v0_), lbase + (unsigned)((slot) * 32768 + kt * 16384) + ldsw); \
        DP3_GLDS((const void*)((gb) + kt * 128 + v1_), lbase + (unsigned)((slot) * 32768 + kt * 16384) + ldsw + 8192u); } } while (0)
#define DP3_SRC(uu, ee, AB, AS, BB, BS) do { const int tl_ = (uu) >> 2, cu_ = ((uu) & 3) * 512; \
        if ((ee) < 64) { AB = (const char*)(H + (size_t)tl_ * 256 * EDIM); AS = EDIM * 2; BB = (const char*)(WD + (size_t)(ee) * D * EDIM + (size_t)cu_ * EDIM); BS = EDIM * 2; } \
        else { const int t0_ = (tl_ - __builtin_amdgcn_readfirstlane(tpref[ee])) * 256; AB = (const char*)(HSp + (size_t)t0_ * SDIM + ((ee) - 64) * EDIM); AS = SDIM * 2; \
               BB = (const char*)(WSD + (size_t)cu_ * SDIM + ((ee) - 64) * EDIM); BS = SDIM * 2; } } while (0)
    int ecur, nvcur; DP3_UNITINFO(u, 0, ecur, nvcur);
    const char* abc; const char* gbc; int asc, bsc; DP3_SRC(u, ecur, abc, asc, gbc, bsc);
    bf16x8 A[2][4], An[2][4];
    { const char* ap_ = abc + (size_t)(32 * w + fr) * asc + 16 * fq;
#pragma unroll
      for (int m = 0; m < 2; ++m)
#pragma unroll
          for (int kk = 0; kk < 4; ++kk) A[m][kk] = *(const bf16x8*)(ap_ + (size_t)m * 16 * asc + 64 * kk); }
    DP3_STAGE(0, gbc, bsc);
    asm volatile("s_waitcnt vmcnt(0)" ::: "memory");
#pragma unroll 1
    for (;;) {
        int un = u; { const int nb = ub + F.G; if (nb + F.G <= NU) un = nb + upos; else if (nb + F.bid < NU) un = nb + F.bid; if (un != u) ub = nb; }
        int enx, nvnx; DP3_UNITINFO(un, (un > u ? ecur : 0), enx, nvnx);
        const char* abn; const char* gbn; int asn, bsn; DP3_SRC(un, enx, abn, asn, gbn, bsn);
        const int tile = u >> 2, colu = (u & 3) * 512;
        float scq[2][4];
#pragma unroll
        for (int c = 0; c < 4; ++c) {
            if (c == 0) asm volatile("s_waitcnt vmcnt(5)" ::: "memory"); else asm volatile("s_waitcnt vmcnt(4)" ::: "memory");
            __builtin_amdgcn_s_barrier();
            if (c == 3) { const char* ap_ = abn + (size_t)(32 * w + fr) * asn + 16 * fq;
#pragma unroll
                for (int m = 0; m < 2; ++m) { const char* am_ = ap_ + (size_t)m * 16 * asn;
                    asm volatile("global_load_dwordx4 %0, %1, off" : "=&v"(An[m][0]) : "v"(am_) : "memory"); asm volatile("global_load_dwordx4 %0, %1, off offset:64" : "=&v"(An[m][1]) : "v"(am_) : "memory");
                    asm volatile("global_load_dwordx4 %0, %1, off offset:128" : "=&v"(An[m][2]) : "v"(am_) : "memory"); asm volatile("global_load_dwordx4 %0, %1, off offset:192" : "=&v"(An[m][3]) : "v"(am_) : "memory"); } }
            { const char* gnext = (c < 3) ? gbc + (size_t)(c + 1) * 128 * bsc : gbn; const int bnext = (c < 3) ? bsc : bsn; DP3_STAGE((c + 1) & 1, gnext, bnext); }
            __builtin_amdgcn_sched_barrier(0);
            f32x4 acc[2][4][2];
#pragma unroll
            for (int g = 0; g < 4; ++g) { bf16x8 Bf[2][4];
#pragma unroll
                for (int n = 0; n < 2; ++n)
#pragma unroll
                    for (int kk = 0; kk < 4; ++kk) Bf[n][kk] = *(const LAS bf16x8*)(lds + (c & 1) * 32768 + (kk >> 1) * 16384 + boffg[g] + n * 2048 + (kk & 1) * 1024);
#pragma unroll
                for (int m = 0; m < 2; ++m)
#pragma unroll
                    for (int n = 0; n < 2; ++n) { acc[m][g][n] = (f32x4){0.f, 0.f, 0.f, 0.f};
#pragma unroll
                        for (int kk = 0; kk < 4; ++kk) acc[m][g][n] = __builtin_amdgcn_mfma_f32_16x16x32_bf16(Bf[n][kk], A[m][kk], acc[m][g][n], 0, 0, 0); } }
#pragma unroll
            for (int m = 0; m < 2; ++m) {
                float am0 = 0.f, am1 = 0.f;
#pragma unroll
                for (int g = 0; g < 4; ++g)
#pragma unroll
                    for (int n = 0; n < 2; ++n) { am0 = fmaxf(fmaxf(am0, fabsf(acc[m][g][n][0])), fabsf(acc[m][g][n][1])); am1 = fmaxf(fmaxf(am1, fabsf(acc[m][g][n][2])), fabsf(acc[m][g][n][3])); }
                float am = fmaxf(am0, am1);
                am = fmaxf(am, shfl_x(am, 16, lane)); am = fmaxf(am, shfl_x(am, 32, lane));
                am = fminf(am, 3.0e38f);
                const float isc = am > 0.f ? 127.0f * __builtin_amdgcn_rcpf(am) : 0.f;
                scq[m][c] = am * (1.0f / 127.0f);
                const f32x2_t isc2 = (f32x2_t){isc, isc}, mg2 = (f32x2_t){8388736.0f, 8388736.0f};
#pragma unroll
                for (int g = 0; g < 4; ++g) { unsigned qd[2];
#pragma unroll
                    for (int n = 0; n < 2; ++n) {
                        const f32x2_t tl = __builtin_elementwise_fma((f32x2_t){acc[m][g][n][0], acc[m][g][n][1]}, isc2, mg2), th = __builtin_elementwise_fma((f32x2_t){acc[m][g][n][2], acc[m][g][n][3]}, isc2, mg2);
                        const float f0_ = tl.x, f1_ = tl.y, f2_ = th.x, f3_ = th.y;
                        qd[n] = __builtin_amdgcn_perm(__builtin_bit_cast(unsigned, f1_), __builtin_bit_cast(unsigned, f0_), 0x0c0c0400u) | __builtin_amdgcn_perm(__builtin_bit_cast(unsigned, f3_), __builtin_bit_cast(unsigned, f2_), 0x04000c0cu); }
                    *(LAS v2u*)(stg + (16 * m + fr) * 144 + 32 * g + 8 * fq) = (v2u){qd[0], qd[1]}; } }
#pragma unroll
            for (int it = 0; it < 4; ++it) { const int rr = 8 * it + (lane >> 3);
                const v4u o = *(const LAS v4u*)(stg + rr * 144 + (lane & 7) * 16);
                __builtin_nontemporal_store(o, (v4u*)(Yq + (size_t)(tile * 256 + 32 * w + rr) * D + colu + 128 * c + 16 * (lane & 7))); }
            if (c == 3) { const f32x4 so = fq == 0 ? (f32x4){scq[0][0], scq[0][1], scq[0][2], scq[0][3]} : (f32x4){scq[1][0], scq[1][1], scq[1][2], scq[1][3]};
                if (fq < 2) __builtin_nontemporal_store(so, (f32x4*)(Ysc + (size_t)(tile * 256 + 32 * w + 16 * fq + fr) * 16 + (colu >> 7))); }
            __builtin_amdgcn_sched_barrier(0);
        }
        asm volatile("s_waitcnt vmcnt(9)" : "+v"(An[0][0]), "+v"(An[0][1]), "+v"(An[0][2]), "+v"(An[0][3]), "+v"(An[1][0]), "+v"(An[1][1]), "+v"(An[1][2]), "+v"(An[1][3]) :: "memory");
        if (un == u) break;
#pragma unroll
        for (int m = 0; m < 2; ++m)
#pragma unroll
            for (int kk = 0; kk < 4; ++kk) A[m][kk] = An[m][kk];
        u = un; ecur = enx; nvcur = nvnx; abc = abn; asc = asn; gbc = gbn; bsc = bsn;
    }
    asm volatile("s_waitcnt vmcnt(0)" ::: "memory");
#undef DP3_UNITINFO
#undef DP3_STAGE
#undef DP3_GLDS
#undef DP3_SRC
}

enum { PH_PRO = 0, PH_POOL_G1, PH_POOL_P, PH_POOL_G2, PH_POOL_G3, PH_DIL_G1, PH_DIL_ATT, PH_DIL_CMB, PH_DIL_G2, PH_CONV_G1, PH_CONV_E, PH_CONV_G2, PH_MOE1, PH_MOE2, PH_MOE3, PH_MOE4, PH_COUNT };

template <int PH>
__device__ __forceinline__ void run_phase(const Frame& Fin, const Args& args_, const int L) {
    Frame F = Fin; { int w_ = Fin.wave, l_; asm volatile("" : "+s"(w_)); asm volatile("v_mbcnt_lo_u32_b32 %0, -1, 0\n\tv_mbcnt_hi_u32_b32 %0, -1, %0" : "=v"(l_)); F.wave = w_; F.lane = l_; F.tid = w_ * 64 + l_; }
    unsigned char* ws; { GAS unsigned char* wsg = (GAS unsigned char*)Fin.ws; asm volatile("" : "+s"(wsg)); ws = (unsigned char*)wsg; } F.ws = ws; F.ctl = (unsigned*)(ws + WS_CTL);
    KP kp = (KP)__builtin_amdgcn_kernarg_segment_ptr(); asm volatile("" : "+s"(kp)); (void)args_;
    { unsigned l_ = (unsigned)(size_t)Fin.lds; asm volatile("" : "+s"(l_)); F.lds = (LAS unsigned char*)(size_t)l_; }
    LAS unsigned char* ring = F.lds; int c = (int)blockIdx.x; { int g_ = Fin.G; asm volatile("" : "+s"(c), "+s"(g_)); F.G = g_; F.bid = c; }
    const float* xres = ain(kp, IN_X);
    const float* st2 = (const float*)(ws + WS_ST2); float* pstp = (float*)(ws + WS_PST);
    const float* g2p = ain(kp, IN_LNG) + (size_t)((L > 0 ? L - 1 : 0) * 2 + 1) * D; const float* b2p = ain(kp, IN_LNB) + (size_t)((L > 0 ? L - 1 : 0) * 2 + 1) * D;
    const bf16* xb = (const bf16*)(ws + WS_XB);
    bf16* yf = (bf16*)(ws + WS_YF);
    unsigned char* big = ws + WS_BIG;
    const int ia = L / 3;
    if constexpr (PH == PH_PRO) { phase_prologue(F, kp); }
    if constexpr (PH == PH_POOL_G1) { g8::DenseSched S; S.init(xb, (const bf16*)(ws + WS_W_POOL_IN) + (size_t)ia * D * D, T, D, D, D, F.G, c);
        g8::EpiBf16 E{(bf16*)(big + BG_U), D, 0}; g8::gemm_phase<g8::EpiBf16, g8::DenseSched, false>(ring, F.tid, D, D, D, S, E); }
    if constexpr (PH == PH_POOL_P) { phase_pool(F, (const bf16*)(big + BG_U), (bf16*)(big + BG_PL)); }
    if constexpr (PH == PH_POOL_G2) { g8::DenseSched S; S.init((const bf16*)(big + BG_PL), (const bf16*)(ws + WS_W_POOL_G) + (size_t)ia * D * 512, T, D, D, 512, F.G, c); S.agrp_shift = 1; S.agrp_stride = 512 * 2;
        g8::EpiScaleBf16 E{(bf16*)(big + BG_MX), D, ain(kp, IN_PSC) + (size_t)ia * D}; g8::gemm_phase<g8::EpiScaleBf16, g8::DenseSched, false>(ring, F.tid, 512, D, 512, S, E); }
    if constexpr (PH == PH_POOL_G3) { g8::DenseSched S; S.init((const bf16*)(big + BG_MX), (const bf16*)(ws + WS_W_POOL_OUT) + (size_t)ia * D * D, T, D, D, D, F.G, c);
        g8::EpiResidLN E{xres, xb, st2, g2p, b2p, yf, pstp, 2}; g8::gemm_phase<g8::EpiResidLN, g8::DenseSched, false>(ring, F.tid, D, D, D, S, E); }
    if constexpr (PH == PH_DIL_G1) { g8::DenseSched S; S.init(xb, (const bf16*)(ws + WS_W_DIL_QKV), T, QKVC, D, D, F.G, c);
        g8::EpiBf16 E{(bf16*)(big + BG_QKV), QKVC, 1}; g8::gemm_phase<g8::EpiBf16, g8::DenseSched, false>(ring, F.tid, D, D, D, S, E); }
    if constexpr (PH == PH_DIL_ATT) { phase_attn(F, (const bf16*)(big + BG_QKV), ain(kp, IN_RELB), (bf16*)(big + BG_OG), (float*)(big + BG_LSE)); }
    if constexpr (PH == PH_DIL_CMB) { phase_combine(F, (const bf16*)(big + BG_OG), (const float*)(big + BG_LSE), (bf16*)(big + BG_O)); }
    if constexpr (PH == PH_DIL_G2) { g8::DenseSched S; S.init((const bf16*)(big + BG_O), (const bf16*)(ws + WS_W_DIL_OUT), T, D, DILW, DILW, F.G, c);
        g8::EpiResidLN E{xres, xb, st2, g2p, b2p, yf, pstp, 2}; g8::gemm_phase<g8::EpiResidLN, g8::DenseSched, false>(ring, F.tid, DILW, DILW, DILW, S, E); }
    if constexpr (PH == PH_CONV_G1) { g8::DenseSched S; S.init(xb, (const bf16*)(ws + WS_W_CONV_IN), T, 3 * D, D, D, F.G, c);
        g8::EpiConvIn E{(bf16*)(big + BG_UC), (bf16*)(big + BG_BG)}; g8::gemm_phase<g8::EpiConvIn, g8::DenseSched, false>(ring, F.tid, D, D, D, S, E); }
    if constexpr (PH == PH_CONV_E) { phase_conv(F, (const bf16*)(big + BG_UC), (const bf16*)(big + BG_BG), ain(kp, IN_CW), (bf16*)(big + BG_Z)); }
    if constexpr (PH == PH_CONV_G2) { g8::DenseSched S; S.init((const bf16*)(big + BG_Z), (const bf16*)(ws + WS_W_CONV_OUT), T, D, D, D, F.G, c);
        g8::EpiResidLN E{xres, xb, st2, g2p, b2p, yf, pstp, 2}; g8::gemm_phase<g8::EpiResidLN, g8::DenseSched, false>(ring, F.tid, D, D, D, S, E); }
    unsigned* cnt = F.ctl + CW_CNT + L * 64 * 16;
    float* x1f = (float*)(ws + WS_X1F); bf16* x1b = (bf16*)(ws + WS_X1B);
    int* ltok = (int*)(ws + WS_LTOK); float* lgate = (float*)(ws + WS_LGATE); int* eidx = (int*)(ws + WS_EIDX); int* inv = (int*)(ws + WS_INV);
    bf16* HB = (bf16*)(ws + WS_HB); bf16* HS = (bf16*)(ws + WS_HS); bf16* Yr = (bf16*)(ws + WS_BIG);
    if constexpr (PH == PH_MOE1) {
        const float* g1 = ain(kp, IN_LNG) + (size_t)(L * 2 + 0) * D; const float* b1 = ain(kp, IN_LNB) + (size_t)(L * 2 + 0) * D;
        phase_moe1n(F, yf, pstp, g1, b1, (const bf16*)(ws + WS_RWH) + (size_t)L * NEXP * D, (const bf16*)(ws + WS_RWL) + (size_t)L * NEXP * D, ain(kp, IN_RB) + (size_t)L * NEXP,
                    x1b, (float*)(ws + WS_ST1), cnt, ltok, lgate, eidx, inv); }
    if constexpr (PH == PH_MOE2) {
        const int NT = build_tiles(F, cnt);
        { g8::ExpertSched<1, true> S; S.tpref = (const LAS int*)(F.lds + LDS_TAB); S.cnt = (const LAS int*)(F.lds + LDS_TAB + 512); S.A = (const char*)x1b; S.B = (const char*)((const bf16*)(ws + WS_W_EX_GU) + (size_t)L * 64 * 256 * D);
          S.tok = ltok; S.b_exp = (size_t)256 * D * 2; S.b_tile = 0; S.a_tile = 0; S.NU = NT; S.G = F.G; S.c = c;
          g8::EpiExpertGU E{HB}; g8::gemm_phase<g8::EpiExpertGU, g8::ExpertSched<1, true>, true>(ring, F.tid, D, D, D, S, E); }
        { const int rot = (c - (NT % F.G) + F.G) % F.G;
          g8::DenseSched S; S.init(x1b, (const bf16*)(ws + WS_W_SH_GU) + (size_t)L * 512 * D, T, 512, D, D, F.G, rot);
          int t2 = F.tid; asm volatile("" : "+v"(t2));
          g8::EpiSharedGU E{HS}; g8::gemm_phase<g8::EpiSharedGU, g8::DenseSched, false>(ring, t2, D, D, D, S, E); } }
    if constexpr (PH == PH_MOE3) {
        const float* g1 = ain(kp, IN_LNG) + (size_t)(L * 2 + 0) * D; const float* b1 = ain(kp, IN_LNB) + (size_t)(L * 2 + 0) * D;
        const int NT = build_tiles(F, cnt);
        __syncthreads();
        phase_downproj3(F, HB, (const bf16*)(ws + WS_W_EX_D) + (size_t)L * 64 * D * EDIM, HS, (const bf16*)(ws + WS_W_SH_D) + (size_t)L * D * SDIM, (unsigned char*)Yr, (float*)(ws + WS_BIG + BG_YSC), NT + 2 * (T / 256));
        (void)g1; (void)b1; }
    if constexpr (PH == PH_MOE4) { (void)build_tiles(F, cnt);
        const float* g2 = ain(kp, IN_LNG) + (size_t)(L * 2 + 1) * D; const float* b2 = ain(kp, IN_LNB) + (size_t)(L * 2 + 1) * D;
        phase_moe4q(F, x1b, (bf16*)(ws + WS_Y2F), (const unsigned char*)Yr, (const float*)(ws + WS_BIG + BG_YSC), eidx, inv, g2, b2, (float*)(ws + WS_ST2), (bf16*)(ws + WS_XB), aout(kp), L == DEPTH - 1); }
}
__device__ __forceinline__ void make_frame(Frame& F, const Args& args) {
    extern __shared__ __attribute__((aligned(16))) unsigned char lds_raw[];
    F.lds = (LAS unsigned char*)lds_raw; F.ws = args.ws; F.ctl = (unsigned*)(args.ws + WS_CTL);
    F.tid = threadIdx.x; F.lane = F.tid & 63; F.wave = __builtin_amdgcn_readfirstlane(F.tid >> 6); F.G = gridDim.x; F.bid = blockIdx.x;
}
template <int PH> __global__ void __launch_bounds__(512, 2) k_phase(Args args, int L) {
    Frame F; make_frame(F, args);
    run_phase<PH>(F, args, L);
}

#ifndef MK_NOINLINE
#define MK_NOINLINE 0
#endif
#if MK_NOINLINE
template <int PH> __device__ __noinline__ void call_phase_ni(const int L) {
    Args dummy{}; Frame F;
    KP kp = (KP)__builtin_amdgcn_kernarg_segment_ptr();
    extern __shared__ __attribute__((aligned(16))) unsigned char lds_raw[];
    F.lds = (LAS unsigned char*)lds_raw; F.ws = (unsigned char*)((GAS unsigned char* const CAS*)kp)[20]; F.ctl = (unsigned*)(F.ws + WS_CTL);
    F.tid = threadIdx.x; F.lane = F.tid & 63; F.wave = __builtin_amdgcn_readfirstlane(F.tid >> 6); F.G = gridDim.x; F.bid = blockIdx.x;
    run_phase<PH>(F, dummy, L);
}
template <int PH> __device__ __forceinline__ void call_phase(const Frame& F, const Args& args, const int L) { call_phase_ni<PH>(L); }
#else
template <int PH> __device__ __forceinline__ void call_phase(const Frame& F, const Args& args, const int L) { asm volatile("; PHASE_BEGIN %0" :: "n"(PH)); run_phase<PH>(F, args, L); asm volatile("; PHASE_END %0" :: "n"(PH)); }
#endif
__global__ void __launch_bounds__(512, 2) fwd_all(Args args) {
    Frame F; make_frame(F, args);
    volatile LAS unsigned* misc = (volatile LAS unsigned*)(F.lds + LDS_MISC);
    if (F.tid < 4) misc[F.tid] = 0u;
    __syncthreads();
    const int lo = args.ph_lo, hi = args.ph_hi;
    XcdBarrier bar; bar.bar = F.ctl + CW_BAR; bar.x = 0; bar.st = misc;
    if (hi - lo > 1) bar = xcd_barrier_post(F.ctl + CW_BAR, misc);
    int pc = 0;
#ifndef MK_DUP_MASK
#define MK_DUP_MASK 0
#endif
#if MK_DUP_MASK
#define STEP(PH, Lx) do { if (pc >= lo && pc < hi) { int nrep_ = ((MK_DUP_MASK >> (PH)) & 1) ? 2 : 1; asm volatile("" : "+s"(nrep_)); _Pragma("unroll 1") for (int r_ = 0; r_ < nrep_; ++r_) { call_phase<PH>(F, args, Lx); if (r_ + 1 < nrep_ || pc + 1 < hi) xcd_barrier(bar); } } ++pc; } while (0)
#else
#define STEP(PH, Lx) do { if (pc >= lo && pc < hi) { call_phase<PH>(F, args, Lx); if (pc + 1 < hi) xcd_barrier(bar); } ++pc; } while (0)
#endif
    STEP(PH_PRO, 0);
#pragma unroll 1
    for (int L = 0; L < DEPTH; ++L) {
        const int kind = L % 3;
        if (kind == 0) { STEP(PH_POOL_G1, L); STEP(PH_POOL_P, L); STEP(PH_POOL_G2, L); STEP(PH_POOL_G3, L); }
        else if (kind == 1) { STEP(PH_DIL_G1, L); STEP(PH_DIL_ATT, L); STEP(PH_DIL_CMB, L); STEP(PH_DIL_G2, L); }
        else { STEP(PH_CONV_G1, L); STEP(PH_CONV_E, L); STEP(PH_CONV_G2, L); }
        STEP(PH_MOE1, L); STEP(PH_MOE2, L); STEP(PH_MOE3, L); STEP(PH_MOE4, L);
    }
#undef STEP
}
constexpr int N_STEPS = 1 + 2 * 8 + 8 + 7;

template <int PH> static void launch_phase(const Args& a, int L, int grid, hipStream_t stream) {
    static bool attr = false;
    if (!attr) { (void)hipFuncSetAttribute((const void*)k_phase<PH>, hipFuncAttributeMaxDynamicSharedMemorySize, LDS_BYTES); attr = true; }
    hipLaunchKernelGGL(k_phase<PH>, dim3(grid), dim3(512), LDS_BYTES, stream, a, L);
}
extern "C" void kernel_launch(void* const* d_in, const int* in_sizes, int n_in, void* d_out, int out_size, void* d_ws, size_t ws_size, hipStream_t stream) {
    static int grid = 0;
    if (grid == 0) {
        if (n_in != 19 || out_size != T * D || ws_size < WS_END) { fprintf(stderr, "kernel_launch: unexpected shapes (n_in %d out %d ws %zu need %zu)\n", n_in, out_size, ws_size, (size_t)WS_END); grid = -1; return; }
        int dev = 0, cus = 0;
        if (hipGetDevice(&dev) != hipSuccess || hipDeviceGetAttribute(&cus, hipDeviceAttributeMultiprocessorCount, dev) != hipSuccess) { grid = -1; return; }
#if MK_ONE_LAUNCH
        if (hipFuncSetAttribute((const void*)fwd_all, hipFuncAttributeMaxDynamicSharedMemorySize, LDS_BYTES) != hipSuccess) { fprintf(stderr, "kernel_launch: hipFuncSetAttribute failed\n"); grid = -1; return; }
        int per_cu = 0;
        if (hipOccupancyMaxActiveBlocksPerMultiprocessor(&per_cu, (const void*)fwd_all, 512, LDS_BYTES) != hipSuccess || per_cu < 1) { fprintf(stderr, "kernel_launch: note: occupancy query reports %d blocks per CU\n", per_cu); (void)hipGetLastError(); }
#endif
        grid = cus;
    }
    if (grid < 0) return;
    (void)hipMemsetAsync((char*)d_ws + WS_CTL, 0, CTL_ZERO_BYTES, stream);
    Args a{};
    for (int i = 0; i < 19; ++i) a.in[i] = (const float*)d_in[i];
    a.out = (float*)d_out; a.ws = (unsigned char*)d_ws; a.ph_lo = 0; a.ph_hi = 0;
#if MK_ONE_LAUNCH
#ifdef MK_SPLIT
    for (int p = 0; p < N_STEPS; ++p) { a.ph_lo = p; a.ph_hi = p + 1; hipLaunchKernelGGL(fwd_all, dim3(grid), dim3(512), LDS_BYTES, stream, a); }
#else
    a.ph_lo = 0; a.ph_hi = N_STEPS;
    hipLaunchKernelGGL(fwd_all, dim3(grid), dim3(512), LDS_BYTES, stream, a);
#endif
#elif defined(MK_HYBRID_MASK)
    {
        static bool attr2 = false; if (!attr2) { (void)hipFuncSetAttribute((const void*)fwd_all, hipFuncAttributeMaxDynamicSharedMemorySize, LDS_BYTES); attr2 = true; }
        int pc = 0;
#define HSTEP(PH, Lx) do { if ((MK_HYBRID_MASK >> (PH)) & 1) { a.ph_lo = pc; a.ph_hi = pc + 1; hipLaunchKernelGGL(fwd_all, dim3(grid), dim3(512), LDS_BYTES, stream, a); } else { a.ph_lo = 0; a.ph_hi = 0; launch_phase<PH>(a, Lx, grid, stream); } ++pc; } while (0)
        HSTEP(PH_PRO, 0);
        for (int L = 0; L < DEPTH; ++L) {
            const int kind = L % 3;
            if (kind == 0) { HSTEP(PH_POOL_G1, L); HSTEP(PH_POOL_P, L); HSTEP(PH_POOL_G2, L); HSTEP(PH_POOL_G3, L); }
            else if (kind == 1) { HSTEP(PH_DIL_G1, L); HSTEP(PH_DIL_ATT, L); HSTEP(PH_DIL_CMB, L); HSTEP(PH_DIL_G2, L); }
            else { HSTEP(PH_CONV_G1, L); HSTEP(PH_CONV_E, L); HSTEP(PH_CONV_G2, L); }
            HSTEP(PH_MOE1, L); HSTEP(PH_MOE2, L); HSTEP(PH_MOE3, L); HSTEP(PH_MOE4, L);
        }
#undef HSTEP
    }
#else
    launch_phase<PH_PRO>(a, 0, grid, stream);
    for (int L = 0; L < DEPTH; ++L) {
        const int kind = L % 3;
        if (kind == 0) { launch_phase<PH_POOL_G1>(a, L, grid, stream); launch_phase<PH_POOL_P>(a, L, grid, stream); launch_phase<PH_POOL_G2>(a, L, grid, stream); launch_phase<PH_POOL_G3>(a, L, grid, stream); }
        else if (kind == 1) { launch_phase<PH_DIL_G1>(a, L, grid, stream); launch_phase<PH_DIL_ATT>(a, L, grid, stream); launch_phase<PH_DIL_CMB>(a, L, grid, stream); launch_phase<PH_DIL_G2>(a, L, grid, stream); }
        else { launch_phase<PH_CONV_G1>(a, L, grid, stream); launch_phase<PH_CONV_E>(a, L, grid, stream); launch_phase<PH_CONV_G2>(a, L, grid, stream); }
        launch_phase<PH_MOE1>(a, L, grid, stream); launch_phase<PH_MOE2>(a, L, grid, stream); launch_phase<PH_MOE3>(a, L, grid, stream); launch_phase<PH_MOE4>(a, L, grid, stream);
    }
#endif
}
```

```cpp
#include <hip/hip_runtime.h>
#include <cstdio>
#include <cstdint>

#ifndef MK_ONE_LAUNCH
#define MK_ONE_LAUNCH 1
#endif

#define GAS __attribute__((address_space(1)))
#define LAS __attribute__((address_space(3)))
typedef unsigned short bf16;
typedef unsigned v4u __attribute__((ext_vector_type(4)));
typedef unsigned v2u __attribute__((ext_vector_type(2)));
typedef float f32x4 __attribute__((ext_vector_type(4)));
typedef float f32x2 __attribute__((ext_vector_type(2)));
typedef short bf16x8 __attribute__((ext_vector_type(8)));
typedef short s16x4 __attribute__((ext_vector_type(4)));

constexpr int NBATCH = 8, SEQ = 2048, D = 2048, T = NBATCH * SEQ, DEPTH = 4;
constexpr int NEXP = 64, TOPK = 8, EDIM = 128, SDIM = 256;
constexpr int QKVC = 4608, DILW = 512;
constexpr float ALPHA = 1.681792830507429f;
constexpr float LN_EPS = 1e-5f;
constexpr int CAP = 16384;
constexpr int HROWS = T * TOPK + NEXP * 256;

constexpr size_t MiB = 1u << 20;
constexpr size_t WS_CTL = 0, CTL_ZERO_BYTES = 1 * MiB;
constexpr size_t WS_W_POOL_IN = 1 * MiB;
constexpr size_t WS_W_POOL_G = WS_W_POOL_IN + 16 * MiB;
constexpr size_t WS_W_POOL_OUT = WS_W_POOL_G + 4 * MiB;
constexpr size_t WS_W_DIL_QKV = WS_W_POOL_OUT + 16 * MiB;
constexpr size_t WS_W_DIL_OUT = WS_W_DIL_QKV + 18 * MiB;
constexpr size_t WS_W_CONV_IN = WS_W_DIL_OUT + 2 * MiB;
constexpr size_t WS_W_CONV_OUT = WS_W_CONV_IN + 24 * MiB;
constexpr size_t WS_W_SH_GU = WS_W_CONV_OUT + 8 * MiB;
constexpr size_t WS_W_SH_D = WS_W_SH_GU + 8 * MiB;
constexpr size_t WS_W_EX_GU = WS_W_SH_D + 4 * MiB;
constexpr size_t WS_W_EX_D = WS_W_EX_GU + 256 * MiB;
constexpr size_t WS_XF = WS_W_EX_D + 256 * MiB;
constexpr size_t WS_YF = WS_XF + 128 * MiB;
constexpr size_t WS_X1F = WS_YF + 128 * MiB;
constexpr size_t WS_XB = WS_X1F + 128 * MiB;
constexpr size_t WS_X1B = WS_XB + 64 * MiB;
constexpr size_t WS_HB = WS_X1B + 64 * MiB;
constexpr size_t WS_HS = WS_HB + 72 * MiB;
constexpr size_t WS_LTOK = WS_HS + 8 * MiB;
constexpr size_t WS_LGATE = WS_LTOK + 4 * MiB;
constexpr size_t WS_EIDX = WS_LGATE + 4 * MiB;
constexpr size_t WS_INV = WS_EIDX + 1 * MiB;
constexpr size_t WS_BIG = WS_INV + 1 * MiB;
constexpr size_t WS_PST = WS_BIG + 608 * MiB;
constexpr size_t WS_ST1 = WS_PST + 4 * MiB;
constexpr size_t WS_ST2 = WS_ST1 + 1 * MiB;
constexpr size_t WS_RWH = WS_ST2 + 1 * MiB;
constexpr size_t WS_RWL = WS_RWH + 1 * MiB;
constexpr size_t WS_PST2 = WS_RWL + 1 * MiB;
constexpr size_t WS_END = WS_PST2 + 8 * MiB;
constexpr size_t WS_Y2F = WS_X1F;
constexpr size_t BG_U = 0, BG_PL = 64 * MiB, BG_MX = 128 * MiB;
constexpr size_t BG_QKV = 0, BG_OG = 144 * MiB, BG_LSE = 192 * MiB, BG_O = 194 * MiB;
constexpr size_t BG_UC = 0, BG_BG = 64 * MiB, BG_Z = 128 * MiB;
constexpr size_t BG_YSC = 400 * MiB;
constexpr int CW_BAR = 4096;
constexpr int CW_CNT = 16384;

constexpr int RING_BYTES = 131072;
constexpr int LDS_TAB = RING_BYTES;
constexpr int LDS_STASH = RING_BYTES + 1024;
constexpr int LDS_BYTES = 163840;
constexpr int LDS_MISC = LDS_BYTES - 1024;

typedef __bf16 bf16x2_t __attribute__((ext_vector_type(2)));
typedef float f32x2_t __attribute__((ext_vector_type(2)));
__device__ __forceinline__ unsigned cvt_pk_bf16(float lo, float hi) { const bf16x2_t r = __builtin_convertvector((f32x2_t){lo, hi}, bf16x2_t); return __builtin_bit_cast(unsigned, r); }
__device__ __forceinline__ unsigned f2bf(float f) { unsigned u = __builtin_bit_cast(unsigned, f); return (u + 0x7fffu + ((u >> 16) & 1u)) >> 16; }
__device__ __forceinline__ unsigned pk2(float lo, float hi) { return f2bf(lo) | (f2bf(hi) << 16); }
__device__ __forceinline__ float bflo(unsigned w) { return __builtin_bit_cast(float, w << 16); }
__device__ __forceinline__ float bfhi(unsigned w) { return __builtin_bit_cast(float, w & 0xffff0000u); }
__device__ __forceinline__ float shfl_from(float v, int src) { return __builtin_bit_cast(float, __builtin_amdgcn_ds_bpermute(src << 2, __builtin_bit_cast(int, v))); }
__device__ __forceinline__ float shfl_x(float v, int o, int lane) { return shfl_from(v, lane ^ o); }
__device__ __forceinline__ float wave_sum(float v, int lane) {
#pragma unroll
    for (int o = 1; o < 64; o <<= 1) v += shfl_x(v, o, lane);
    return v;
}
#define LDS_WAIT() asm volatile("s_waitcnt lgkmcnt(0)" ::: "memory")
#define VM_WAIT() asm volatile("s_waitcnt vmcnt(0)" ::: "memory")

#define XB_TMO      128
#define XB_XCNT(j)  (256  + 64 * (j))
#define XB_XSUB(j)  (1280 + 64 * (j))
#define XB_XGEN(j)  (2304 + 64 * (j))
#define XB_TOP      3328
#define XB_TOPGEN   3392
#define XCD_BAR_WORDS 3456
#define XB_SPIN_CAP (1u << 18)

__device__ __forceinline__ unsigned xb_ld(unsigned* p)              { return __hip_atomic_load(p, __ATOMIC_RELAXED, __HIP_MEMORY_SCOPE_AGENT); }
__device__ __forceinline__ unsigned xb_add(unsigned* p, unsigned v) { return __hip_atomic_fetch_add(p, v, __ATOMIC_RELAXED, __HIP_MEMORY_SCOPE_AGENT); }
__device__ __forceinline__ unsigned xb_xcc_id() { return (unsigned)__builtin_amdgcn_s_getreg((3 << 11) | 20) & 0xFu; }
#define XB_SPIN(cond, bar) do { unsigned _sp = 0; while (cond) { __builtin_amdgcn_s_sleep(1); \
    if ((++_sp & 255u) == 0u) { if (xb_ld(&(bar)[XB_TMO])) break; if (_sp > XB_SPIN_CAP) { atomicAdd(&(bar)[XB_TMO], 1u); break; } } } } while (0)

struct XcdBarrier {
    unsigned* bar; unsigned x;
    volatile LAS unsigned* st;
};

__device__ __forceinline__ XcdBarrier xcd_barrier_post(unsigned* bar, volatile LAS unsigned* st) {
    XcdBarrier b; b.bar = bar; b.x = xb_xcc_id(); b.st = st;
    if (threadIdx.x == 0) (void)xb_add(&bar[XB_XCNT(b.x)], 1u);
    return b;
}
__device__ __forceinline__ void xcd_barrier_complete(unsigned* bar, unsigned x, unsigned& nloc, unsigned& nx) {
    const unsigned G = gridDim.x * gridDim.y * gridDim.z;
    unsigned sum, cnt, mine, sp = 0u;
    for (;;) {
        sum = 0u; cnt = 0u; mine = 0u;
#pragma unroll
        for (unsigned j = 0; j < 16; ++j) { const unsigned c = xb_ld(&bar[XB_XCNT(j)]); sum += c; cnt += (c > 0u) ? 1u : 0u; mine = (j == x) ? c : mine; }
        if (sum == G) break;
        __builtin_amdgcn_s_sleep(1);
        if ((++sp & 255u) == 0u) { if (xb_ld(&bar[XB_TMO])) break; if (sp > XB_SPIN_CAP) { atomicAdd(&bar[XB_TMO], 1u); break; } }
    }
    nloc = mine > 0u ? mine : 1u; nx = cnt > 0u ? cnt : 1u;
}

__device__ __forceinline__ void xcd_barrier(const XcdBarrier& b) {
    asm volatile("s_waitcnt vmcnt(0)" ::: "memory");
    __syncthreads();
    if (threadIdx.x == 0) {
        unsigned* bar; unsigned bx = b.x; { GAS unsigned* bg = (GAS unsigned*)b.bar; asm volatile("" : "+s"(bg), "+s"(bx)); bar = (unsigned*)bg; }
        __builtin_amdgcn_s_waitcnt(0);
        unsigned nloc = b.st[0], nx = b.st[1];
        if (nloc == 0u) { xcd_barrier_complete(bar, bx, nloc, nx); b.st[0] = nloc; b.st[1] = nx; }
        const unsigned old = xb_add(&bar[XB_XSUB(bx)], 1u);
        const unsigned gen = old / nloc;
        if (old + 1u == (gen + 1u) * nloc) {
            __builtin_amdgcn_fence(__ATOMIC_RELEASE, "agent");
            asm volatile("s_waitcnt vmcnt(0)" ::: "memory");
            const unsigned og = xb_add(&bar[XB_TOP], 1u);
            const unsigned tg = og / nx;
            if (og + 1u == (tg + 1u) * nx) xb_add(&bar[XB_TOPGEN], 1u);
            else XB_SPIN(xb_ld(&bar[XB_TOPGEN]) == tg, bar);
            __builtin_amdgcn_fence(__ATOMIC_ACQUIRE, "agent");
            xb_add(&bar[XB_XGEN(bx)], 1u);
            asm volatile("s_waitcnt vmcnt(0)" ::: "memory");
        } else {
            XB_SPIN(xb_ld(&bar[XB_XGEN(bx)]) == gen, bar);
            __builtin_amdgcn_fence(__ATOMIC_ACQUIRE, "agent");
            asm volatile("s_waitcnt vmcnt(0)" ::: "memory");
        }
    }
    __syncthreads();
}

namespace g8 {
constexpr int BM = 256, BK = 64, HALF = 128, HTB = HALF * BK * 2, STAGE_BYTES = 8 * HTB, NXCD = 8, WGM = 8;
__host__ __device__ __forceinline__ int lds_byte(int r, int c) { const int st = (r >> 4) * 2 + (c >> 5), rr = r & 15, cc = c & 31, ob = rr * 64 + cc * 2; return st * 1024 + (ob ^ (((ob >> 9) & 1) << 5)); }
__host__ __device__ __forceinline__ void stage_rc(int b, int& R, int& C) { const int st = b / 1024, sb = b % 1024, swz = sb ^ (((sb >> 9) & 1) << 5); R = (st >> 1) * 16 + swz / 64; C = (st & 1) * 32 + (swz % 64) / 2; }
__host__ __device__ __forceinline__ int perm32(int rho) { const int n = rho >> 4, i = rho & 15; return 8 * (i >> 2) + 4 * n + (i & 3); }

struct Unit { const char* A; const char* B; const int* rows; int pm, pn, nvalid, aux; };

template <class Epi, class Sched, bool GATHER>
__device__ __forceinline__ void gemm_phase(LAS unsigned char* lds, const int tid_in, const int K, const int lda, const int ldb, const Sched& S, const Epi& E) {
    const int tid = tid_in, wid = __builtin_amdgcn_readfirstlane(tid >> 6), lane = tid & 63, wr = wid >> 2, wc = wid & 3, fr = lane & 15, fq = lane >> 4;
    const int nt = K / BK;
    unsigned voffB[2];
#pragma unroll
    for (int i = 0; i < 2; ++i) { int R_, C_; stage_rc(tid * 16 + i * 8192, R_, C_); const int Rb = Epi::PERM ? ((R_ & ~31) + perm32(R_ & 31)) : R_; voffB[i] = (unsigned)(Rb * ldb + C_) * 2u; }
    LAS v4u* stash = (LAS v4u*)(lds + (LDS_STASH - 0) + tid * 16);
    const size_t kstep = (size_t)(BK * 2);
    const size_t hstepB = (size_t)HALF * ldb * 2;
    const unsigned ldsw = (unsigned)wid * 1024u;
    const int aoff = lds_byte(wr * 64 + fr, fq * 8), boff = lds_byte(wc * 32 + fr, fq * 8);
#define G8_SA(b, h) (((b) * 2 + (h)) * HTB)
#define G8_SB(b, h) ((4 + (b) * 2 + (h)) * HTB)
#define G8_STAGE2(bufoff, gbase, v0, v1) do { \
        __builtin_amdgcn_global_load_lds((const unsigned*)((const char*)(gbase) + (v0)), (LAS unsigned*)(lds + (bufoff) + ldsw), 16, 0, 0); \
        __builtin_amdgcn_global_load_lds((const unsigned*)((const char*)(gbase) + (v1)), (LAS unsigned*)(lds + (bufoff) + ldsw + 8192), 16, 0, 0); } while (0)
#define G8_STAGEB(bufoff, gbase) G8_STAGE2(bufoff, gbase, voffB[0], voffB[1])
#define G8_LDA(dst, b, h) do { _Pragma("unroll") for (int m = 0; m < 4; ++m) _Pragma("unroll") for (int k = 0; k < 2; ++k) dst[m][k] = *(const LAS bf16x8*)(lds + G8_SA(b, h) + aoff + m * 2048 + k * 1024); } while (0)
#define G8_LDB(dst, b, h) do { _Pragma("unroll") for (int n = 0; n < 2; ++n) _Pragma("unroll") for (int k = 0; k < 2; ++k) dst[n][k] = *(const LAS bf16x8*)(lds + G8_SB(b, h) + boff + n * 2048 + k * 1024); } while (0)
#define G8_MMA(ai, bj, At, Bt) do { __builtin_amdgcn_s_setprio(1); _Pragma("unroll") for (int m = 0; m < 4; ++m) _Pragma("unroll") for (int n = 0; n < 2; ++n) _Pragma("unroll") for (int k = 0; k < 2; ++k) \
        acc[ai][bj][m][n] = __builtin_amdgcn_mfma_f32_16x16x32_bf16(Bt[n][k], At[m][k], acc[ai][bj][m][n], 0, 0, 0); __builtin_amdgcn_s_setprio(0); } while (0)
#define G8_WAIT_V(n) asm volatile("s_waitcnt vmcnt(" #n ")" ::: "memory")
#define G8_WAIT_L(n) asm volatile("s_waitcnt lgkmcnt(" #n ")" ::: "memory")
#define G8_BAR __builtin_amdgcn_s_barrier()
#define G8_SCHED __builtin_amdgcn_sched_barrier(0)
#define G8_SETVA(dst, u) do { int _t2 = tid; if (GATHER) asm volatile("" : "+v"(_t2)); _Pragma("unroll") for (int _h = 0; _h < 2; ++_h) _Pragma("unroll") for (int _i = 0; _i < 2; ++_i) { \
        int _R, _C; stage_rc(_t2 * 16 + _i * 8192, _R, _C); \
        const unsigned _rl = (unsigned)(_h * HALF + _R); unsigned _row = _rl; \
        if (GATHER) { const bool _ok = _rl < (unsigned)(u).nvalid; _row = (unsigned)(u).rows[_ok ? _rl : 0u] >> 3; if (!_ok) _row = 0u; }     \
        dst[_h][_i] = (_row * (unsigned)lda + (unsigned)_C) * 2u; } } while (0)
    Unit cur, nxt; int ui = 0;
    if (!S.next(0, cur)) return;
    f32x4 acc[2][2][4][2];
#pragma unroll
    for (int a = 0; a < 2; ++a)
#pragma unroll
        for (int b = 0; b < 2; ++b)
#pragma unroll
            for (int m = 0; m < 4; ++m)
#pragma unroll
                for (int n = 0; n < 2; ++n) acc[a][b][m][n] = (f32x4){0.f, 0.f, 0.f, 0.f};
    bf16x8 At[4][2], B0[2][2], B1[2][2];
    unsigned vAc[2][2]; unsigned xl00 = 0, xl01 = 0, xl10 = 0, xl11 = 0;
    G8_SETVA(vAc, cur);
    const char* cA = cur.A; const char* cB = cur.B;
    G8_STAGEB(G8_SB(0, 0), cB); G8_STAGEB(G8_SB(0, 1), cB + hstepB); G8_STAGE2(G8_SA(0, 0), cA, vAc[0][0], vAc[0][1]); G8_STAGE2(G8_SA(0, 1), cA, vAc[1][0], vAc[1][1]);
    if (wr == 1) G8_BAR;
    G8_WAIT_V(2); G8_BAR;
    G8_STAGEB(G8_SB(1, 0), cB + kstep); G8_STAGE2(G8_SA(1, 0), cA + kstep, vAc[0][0], vAc[0][1]); G8_STAGEB(G8_SB(1, 1), cB + hstepB + kstep);
    G8_WAIT_V(6); G8_BAR;
    for (;;) {
        const bool has_next = S.next(ui + 1, nxt);
        const char* nA = has_next ? nxt.A : cA; const char* nB = has_next ? nxt.B : cB;
        if (GATHER) { unsigned vAn[2][2]; if (has_next) { G8_SETVA(vAn, nxt); } else {
#pragma unroll
            for (int h = 0; h < 2; ++h)
#pragma unroll
                for (int i = 0; i < 2; ++i) vAn[h][i] = vAc[h][i]; }
            *stash = (v4u){vAn[0][0], vAn[0][1], vAn[1][0], vAn[1][1]}; }
#pragma unroll 1
        for (int t = 0; t < nt; t += 2) {
            const bool last = (t == nt - 2);
            const char* a1 = cA + (size_t)(t + 1) * kstep;
            const char* a2 = last ? nA : cA + (size_t)(t + 2) * kstep; const char* b2 = last ? nB : cB + (size_t)(t + 2) * kstep;
            const char* a3 = a2 + kstep; const char* b3 = b2 + kstep;
            unsigned x00 = vAc[0][0], x01 = vAc[0][1], x10 = vAc[1][0], x11 = vAc[1][1];
            if (GATHER) { if (last) { const v4u sv = *stash; x00 = sv.x; x01 = sv.y; x10 = sv.z; x11 = sv.w; } xl00 = x00; xl01 = x01; xl10 = x10; xl11 = x11; }
            G8_LDB(B0, 0, 0); G8_LDB(B1, 0, 1); G8_SCHED; G8_LDA(At, 0, 0); G8_STAGE2(G8_SA(1, 1), a1, vAc[1][0], vAc[1][1]);
            G8_WAIT_V(8); G8_WAIT_L(0); G8_BAR; G8_MMA(0, 0, At, B0); G8_MMA(0, 1, At, B1); G8_BAR; G8_SCHED;
            G8_LDA(At, 0, 1); G8_STAGEB(G8_SB(0, 0), b2); G8_STAGEB(G8_SB(0, 1), b2 + hstepB); G8_STAGE2(G8_SA(0, 0), a2, x00, x01);
            G8_WAIT_V(8); G8_WAIT_L(0); G8_BAR; G8_MMA(1, 0, At, B0); G8_MMA(1, 1, At, B1); G8_BAR; G8_SCHED;
            G8_LDB(B0, 1, 0); G8_LDB(B1, 1, 1); G8_SCHED; G8_LDA(At, 1, 0); G8_STAGE2(G8_SA(0, 1), a2, x10, x11);
            G8_WAIT_V(8); G8_WAIT_L(0); G8_BAR; G8_MMA(0, 0, At, B0); G8_MMA(0, 1, At, B1); G8_BAR; G8_SCHED;
            G8_LDA(At, 1, 1); G8_STAGEB(G8_SB(1, 0), b3); G8_STAGEB(G8_SB(1, 1), b3 + hstepB); G8_STAGE2(G8_SA(1, 0), a3, x00, x01);
            G8_WAIT_V(8); G8_WAIT_L(0); G8_BAR; G8_MMA(1, 0, At, B0); G8_MMA(1, 1, At, B1); G8_BAR; G8_SCHED;
        }
        if (wr == 0) G8_BAR;
        E(acc, cur, wr, wc, fr, fq);
        if (!has_next) break;
#pragma unroll
        for (int a = 0; a < 2; ++a)
#pragma unroll
            for (int b = 0; b < 2; ++b)
#pragma unroll
                for (int m = 0; m < 4; ++m)
#pragma unroll
                    for (int n = 0; n < 2; ++n) acc[a][b][m][n] = (f32x4){0.f, 0.f, 0.f, 0.f};
        cur = nxt; cA = nA; cB = nB; ++ui;
        if (GATHER) { vAc[0][0] = xl00; vAc[0][1] = xl01; vAc[1][0] = xl10; vAc[1][1] = xl11; }
        if (wr == 1) G8_BAR;
    }
    G8_WAIT_V(0);
    G8_BAR;
#undef G8_SA
#undef G8_SB
#undef G8_STAGE2
#undef G8_STAGEB
#undef G8_LDA
#undef G8_LDB
#undef G8_MMA
#undef G8_WAIT_V
#undef G8_WAIT_L
#undef G8_BAR
#undef G8_SCHED
#undef G8_SETVA
}

struct DenseSched {
    const char* A; const char* B; size_t a_tile, b_tile, agrp_stride; int agrp_shift, nM, nN, nwg, G, c;
    __device__ __forceinline__ void init(const void* A_, const void* B_, int M, int N, int lda, int ldb, int G_, int c_) {
        A = (const char*)A_; B = (const char*)B_; a_tile = (size_t)BM * lda * 2; b_tile = (size_t)BM * ldb * 2; agrp_stride = 0; agrp_shift = 0; nM = M / BM; nN = N / BM; nwg = nM * nN; G = G_; c = c_; }
    __device__ __forceinline__ bool next(int i, Unit& u) const {
        const long L = (long)i * G + c; if (L >= nwg) return false;
        int wgid = (int)L; { const int q = nwg / NXCD, r = nwg % NXCD, xcd = wgid % NXCD, off = wgid / NXCD; wgid = (xcd < r ? xcd * (q + 1) : r * (q + 1) + (xcd - r) * q) + off; }
        const int nig = WGM * nN, gid = wgid / nig, fm = gid * WGM, gsz = (nM - fm) < WGM ? (nM - fm) : WGM;
        u.pm = fm + ((wgid % nig) % gsz); u.pn = (wgid % nig) / gsz;
        u.A = A + (size_t)u.pm * a_tile + (size_t)(u.pn >> agrp_shift) * agrp_stride; u.B = B + (size_t)u.pn * b_tile; u.rows = nullptr; u.nvalid = BM; u.aux = 0; return true;
    }
};
template <int NPN, bool GATHERED>
struct ExpertSched {
    const LAS int* tpref; const LAS int* cnt; const char* A; const char* B; const int* tok; size_t b_exp, b_tile, a_tile; int NU, G, c;
    __device__ __forceinline__ bool next(int i, Unit& u) const {
        int L = i * G + c; if (L >= NU) return false;
        if ((i + 1) * G <= NU && (G % NXCD) == 0) L = i * G + (c % NXCD) * (G / NXCD) + c / NXCD;
        const int tile = L / NPN, pn = L % NPN;
        int e = 0; while (__builtin_amdgcn_readfirstlane(tpref[e + 1]) <= tile) ++e;
        const int rb = tile - __builtin_amdgcn_readfirstlane(tpref[e]);
        u.pm = e; u.pn = pn; u.aux = tile * BM; u.nvalid = __builtin_amdgcn_readfirstlane(cnt[e]) - rb * BM; if (u.nvalid > BM) u.nvalid = BM;
        u.rows = tok + (size_t)e * CAP + rb * BM;
        u.A = GATHERED ? A : A + (size_t)tile * a_tile; u.B = B + (size_t)e * b_exp + (size_t)pn * b_tile; return true;
    }
};

struct EpiBf16 {
    static constexpr bool PERM = true;
    bf16* O; int ldc; int qscale;
    __device__ __forceinline__ void operator()(const f32x4 (&acc)[2][2][4][2], const Unit& u, int wr, int wc, int fr, int fq) const {
        asm volatile("" : "+v"(fr), "+v"(fq));
        const int row0 = u.pm * BM + wr * 64 + fr, col0 = u.pn * BM + wc * 32 + 8 * fq;
        const float sc = (qscale && (u.pn % 6) < 2) ? 0.125f : 1.0f;
#pragma unroll
        for (int ai = 0; ai < 2; ++ai)
#pragma unroll
            for (int m = 0; m < 4; ++m) { bf16* rowp = O + (size_t)(row0 + ai * HALF + m * 16) * ldc + col0;
#pragma unroll
                for (int bj = 0; bj < 2; ++bj) { const f32x4 v0 = acc[ai][bj][m][0] * sc, v1 = acc[ai][bj][m][1] * sc;
                    v4u w; w.x = cvt_pk_bf16(v0[0], v0[1]); w.y = cvt_pk_bf16(v0[2], v0[3]); w.z = cvt_pk_bf16(v1[0], v1[1]); w.w = cvt_pk_bf16(v1[2], v1[3]);
                    *(v4u*)(rowp + bj * HALF) = w; } }
    }
};
struct EpiScaleBf16 {
    static constexpr bool PERM = true;
    bf16* O; int ldc; const float* scale;
    __device__ __forceinline__ void operator()(const f32x4 (&acc)[2][2][4][2], const Unit& u, int wr, int wc, int fr, int fq) const {
        asm volatile("" : "+v"(fr), "+v"(fq));
        const int row0 = u.pm * BM + wr * 64 + fr, col0 = u.pn * BM + wc * 32 + 8 * fq;
        f32x4 sv[2][2];
#pragma unroll
        for (int bj = 0; bj < 2; ++bj)
#pragma unroll
            for (int n = 0; n < 2; ++n) sv[bj][n] = *(const f32x4*)(scale + col0 + bj * HALF + 4 * n);
#pragma unroll
        for (int ai = 0; ai < 2; ++ai)
#pragma unroll
            for (int m = 0; m < 4; ++m) { bf16* rowp = O + (size_t)(row0 + ai * HALF + m * 16) * ldc + col0;
#pragma unroll
                for (int bj = 0; bj < 2; ++bj) { const f32x4 v0 = acc[ai][bj][m][0] * sv[bj][0], v1 = acc[ai][bj][m][1] * sv[bj][1];
                    v4u w; w.x = cvt_pk_bf16(v0[0], v0[1]); w.y = cvt_pk_bf16(v0[2], v0[3]); w.z = cvt_pk_bf16(v1[0], v1[1]); w.w = cvt_pk_bf16(v1[2], v1[3]);
                    *(v4u*)(rowp + bj * HALF) = w; } }
    }
};
struct EpiResid {
    static constexpr bool PERM = false;
    const float* X; float* Y;
    __device__ __forceinline__ void operator()(const f32x4 (&acc)[2][2][4][2], const Unit& u, int wr, int wc, int fr, int fq) const {
        asm volatile("" : "+v"(fr), "+v"(fq));
        const int row0 = u.pm * BM + wr * 64 + fr, col0 = u.pn * BM + wc * 32 + 4 * fq;
#pragma unroll
        for (int ai = 0; ai < 2; ++ai)
#pragma unroll
            for (int m = 0; m < 4; ++m) { const size_t off = (size_t)(row0 + ai * HALF + m * 16) * D + col0;
#pragma unroll
                for (int bj = 0; bj < 2; ++bj)
#pragma unroll
                    for (int n = 0; n < 2; ++n) { const f32x4 xv = *(const f32x4*)(X + off + bj * HALF + n * 16); *(f32x4*)(Y + off + bj * HALF + n * 16) = xv * ALPHA + acc[ai][bj][m][n]; } }
    }
};
struct EpiResidLN {
    static constexpr bool PERM = true;
    const float* X32; const bf16* Xb; const float* st; const float* g; const float* b; bf16* Y; float* pst; int mode;
    __device__ __forceinline__ void operator()(const f32x4 (&acc)[2][2][4][2], const Unit& u, int wr, int wc, int fr, int fq) const {
        asm volatile("" : "+v"(fr), "+v"(fq));
        const int row0 = u.pm * BM + wr * 64 + fr, col0 = u.pn * BM + wc * 32 + 8 * fq, lane = fq * 16 + fr;
#pragma unroll
        for (int ai = 0; ai < 2; ++ai) {
            v4u xr[4][2];
#pragma unroll
            for (int m = 0; m < 4; ++m)
#pragma unroll
                for (int bj = 0; bj < 2; ++bj) xr[m][bj] = *(const v4u*)(Xb + (size_t)(row0 + ai * HALF + m * 16) * D + col0 + bj * HALF);
            asm volatile("" : "+v"(xr[0][0]), "+v"(xr[0][1]), "+v"(xr[1][0]), "+v"(xr[1][1]), "+v"(xr[2][0]), "+v"(xr[2][1]), "+v"(xr[3][0]), "+v"(xr[3][1]));
#pragma unroll
            for (int m = 0; m < 4; ++m) { const int row = row0 + ai * HALF + m * 16; const size_t off = (size_t)row * D + col0;
                float sm = 0.f, sq = 0.f;
#pragma unroll
                for (int bj = 0; bj < 2; ++bj) { const v4u xv = xr[m][bj];
                    const f32x4 x0 = (f32x4){bflo(xv.x), bfhi(xv.x), bflo(xv.y), bfhi(xv.y)}, x1 = (f32x4){bflo(xv.z), bfhi(xv.z), bflo(xv.w), bfhi(xv.w)};
                    const f32x4 y0 = x0 * ALPHA + acc[ai][bj][m][0], y1 = x1 * ALPHA + acc[ai][bj][m][1];
                    v4u w; w.x = cvt_pk_bf16(y0[0], y0[1]); w.y = cvt_pk_bf16(y0[2], y0[3]); w.z = cvt_pk_bf16(y1[0], y1[1]); w.w = cvt_pk_bf16(y1[2], y1[3]);
                    *(v4u*)(Y + off + bj * HALF) = w;
                    sm += ((y0[0] + y0[1]) + (y0[2] + y0[3])) + ((y1[0] + y1[1]) + (y1[2] + y1[3]));
                    sq += ((y0[0] * y0[0] + y0[1] * y0[1]) + (y0[2] * y0[2] + y0[3] * y0[3])) + ((y1[0] * y1[0] + y1[1] * y1[1]) + (y1[2] * y1[2] + y1[3] * y1[3])); }
                sm += shfl_x(sm, 16, lane); sm += shfl_x(sm, 32, lane); sq += shfl_x(sq, 16, lane); sq += shfl_x(sq, 32, lane);
                if (fq == 0) *(f32x2*)(pst + ((size_t)row * 32 + u.pn * 4 + wc) * 2) = (f32x2){sm, sq}; } }
    }
};
struct EpiConvIn {
    static constexpr bool PERM = true;
    bf16* UC; bf16* BGp;
    __device__ __forceinline__ void operator()(const f32x4 (&acc)[2][2][4][2], const Unit& u, int wr, int wc, int fr, int fq) const {
        asm volatile("" : "+v"(fr), "+v"(fq));
        const int row0 = u.pm * BM + wr * 64 + fr, cw = wc * 32 + 8 * fq;
        if (u.pn < 16) {
#pragma unroll
            for (int ai = 0; ai < 2; ++ai)
#pragma unroll
                for (int m = 0; m < 4; ++m) { bf16* rowp = UC + (size_t)(row0 + ai * HALF + m * 16) * D + u.pn * HALF + cw;
                    const f32x4 v0 = acc[ai][0][m][0] * acc[ai][1][m][0], v1 = acc[ai][0][m][1] * acc[ai][1][m][1];
                    v4u w; w.x = cvt_pk_bf16(v0[0], v0[1]); w.y = cvt_pk_bf16(v0[2], v0[3]); w.z = cvt_pk_bf16(v1[0], v1[1]); w.w = cvt_pk_bf16(v1[2], v1[3]);
                    *(v4u*)rowp = w; }
        } else {
#pragma unroll
            for (int ai = 0; ai < 2; ++ai)
#pragma unroll
                for (int m = 0; m < 4; ++m) { bf16* rowp = BGp + (size_t)(row0 + ai * HALF + m * 16) * D + (u.pn - 16) * BM + cw;
#pragma unroll
                    for (int bj = 0; bj < 2; ++bj) { const f32x4 v0 = acc[ai][bj][m][0], v1 = acc[ai][bj][m][1];
                        v4u w; w.x = cvt_pk_bf16(v0[0], v0[1]); w.y = cvt_pk_bf16(v0[2], v0[3]); w.z = cvt_pk_bf16(v1[0], v1[1]); w.w = cvt_pk_bf16(v1[2], v1[3]);
                        *(v4u*)(rowp + bj * HALF) = w; } }
        }
    }
};
__device__ __forceinline__ f32x4 silu_mul(f32x4 g, f32x4 uu) {
    f32x4 r;
#pragma unroll
    for (int j = 0; j < 4; ++j) r[j] = g[j] * __builtin_amdgcn_rcpf(1.0f + __expf(-g[j])) * uu[j];
    return r;
}
struct EpiExpertGU {
    static constexpr bool PERM = true;
    bf16* H;
    __device__ __forceinline__ void operator()(const f32x4 (&acc)[2][2][4][2], const Unit& u, int wr, int wc, int fr, int fq) const {
        asm volatile("" : "+v"(fr), "+v"(fq));
        const float* gates = (const float*)((const char*)u.rows + (WS_LGATE - WS_LTOK));
        const int cw = wc * 32 + 8 * fq;
        float gtv[2][4];
#pragma unroll
        for (int ai = 0; ai < 2; ++ai)
#pragma unroll
            for (int m = 0; m < 4; ++m) { const int r = ai * HALF + wr * 64 + m * 16 + fr; gtv[ai][m] = gates[r < u.nvalid ? r : 0]; }
        asm volatile("" : "+v"(gtv[0][0]), "+v"(gtv[0][1]), "+v"(gtv[0][2]), "+v"(gtv[0][3]), "+v"(gtv[1][0]), "+v"(gtv[1][1]), "+v"(gtv[1][2]), "+v"(gtv[1][3]));
#pragma unroll
        for (int ai = 0; ai < 2; ++ai)
#pragma unroll
            for (int m = 0; m < 4; ++m) { const int r = ai * HALF + wr * 64 + m * 16 + fr;
                if (r < u.nvalid) { const float gt = gtv[ai][m]; const unsigned pid = 0u;
                    const f32x4 v0 = silu_mul(acc[ai][0][m][0], acc[ai][1][m][0]) * gt, v1 = silu_mul(acc[ai][0][m][1], acc[ai][1][m][1]) * gt;
                    v4u w; w.x = cvt_pk_bf16(v0[0], v0[1]); w.y = cvt_pk_bf16(v0[2], v0[3]); w.z = cvt_pk_bf16(v1[0], v1[1]); w.w = cvt_pk_bf16(v1[2], v1[3]);
                    (void)pid; *(v4u*)(H + (size_t)(u.aux + r) * EDIM + cw) = w; } }
    }
};
struct EpiSharedGU {
    static constexpr bool PERM = true;
    bf16* HS;
    __device__ __forceinline__ void operator()(const f32x4 (&acc)[2][2][4][2], const Unit& u, int wr, int wc, int fr, int fq) const {
        asm volatile("" : "+v"(fr), "+v"(fq));
        const int row0 = u.pm * BM + wr * 64 + fr, cw = u.pn * HALF + wc * 32 + 8 * fq;
#pragma unroll
        for (int ai = 0; ai < 2; ++ai)
#pragma unroll
            for (int m = 0; m < 4; ++m) {
                const f32x4 v0 = silu_mul(acc[ai][0][m][0], acc[ai][1][m][0]), v1 = silu_mul(acc[ai][0][m][1], acc[ai][1][m][1]);
                v4u w; w.x = cvt_pk_bf16(v0[0], v0[1]); w.y = cvt_pk_bf16(v0[2], v0[3]); w.z = cvt_pk_bf16(v1[0], v1[1]); w.w = cvt_pk_bf16(v1[2], v1[3]);
                *(v4u*)(HS + (size_t)(row0 + ai * HALF + m * 16) * SDIM + cw) = w; }
    }
};
struct EpiDownY {
    static constexpr bool PERM = true;
    bf16* Y;
    __device__ __forceinline__ void operator()(const f32x4 (&acc)[2][2][4][2], const Unit& u, int wr, int wc, int fr, int fq) const {
        asm volatile("" : "+v"(fr), "+v"(fq));
        const int col0 = u.pn * BM + wc * 32 + 8 * fq;
#pragma unroll
        for (int ai = 0; ai < 2; ++ai)
#pragma unroll
            for (int m = 0; m < 4; ++m) { const int r = ai * HALF + wr * 64 + m * 16 + fr; bf16* rowp = Y + (size_t)(u.aux + r) * D + col0;
#pragma unroll
                for (int bj = 0; bj < 2; ++bj) { const f32x4 v0 = acc[ai][bj][m][0], v1 = acc[ai][bj][m][1];
                    v4u w; w.x = cvt_pk_bf16(v0[0], v0[1]); w.y = cvt_pk_bf16(v0[2], v0[3]); w.z = cvt_pk_bf16(v1[0], v1[1]); w.w = cvt_pk_bf16(v1[2], v1[3]);
                    *(v4u*)(rowp + bj * HALF) = w; } }
    }
};
}

struct Args { const float* in[19]; float* out; unsigned char* ws; int ph_lo, ph_hi; };
struct Frame {
    LAS unsigned char* lds; unsigned* ctl; unsigned char* ws;
    int tid, lane, wave, G, bid;
};
enum { IN_X = 0, IN_RELB, IN_PWIN, IN_PWG, IN_PSC, IN_PWOUT, IN_DQKV, IN_DOUT, IN_CWIN, IN_CW, IN_CWOUT, IN_LNG, IN_LNB, IN_RW, IN_RB, IN_EGU, IN_ED, IN_SGU, IN_SD };

#define CAS __attribute__((address_space(4)))
typedef const CAS unsigned char* KP;
__device__ __forceinline__ const float* ain(KP kp, int i) { return (const float*)((const GAS float* const CAS*)kp)[i]; }
__device__ __forceinline__ float* aout(KP kp) { return (float*)((GAS float* const CAS*)kp)[19]; }
__device__ __forceinline__ void tr_item(const float* W, int K, int N, bf16* WT, int dstK, int mode, LAS float* scr, int item, int lane) {
    const int nblk = N / 32, kb = item / nblk, nb = item % nblk, k0 = 64 * kb, n0 = 32 * nb;
    int r0 = n0;
    if (mode == 1) { const int part = n0 / 2048, j = n0 % 2048; r0 = (part == 0) ? 4096 + j : 256 * (j / 128) + (part == 2 ? 128 : 0) + (j % 128); }
    if (mode == 2) { const int part = n0 / 256, j = n0 % 256; r0 = 256 * (j / 128) + 128 * part + (j % 128); }
#pragma unroll 8
    for (int i = 0; i < 32; ++i) { const int kk = 2 * i + (lane >> 5); scr[kk * 33 + (lane & 31)] = __builtin_nontemporal_load(W + (size_t)(k0 + kk) * N + n0 + (lane & 31)); }
    LDS_WAIT(); asm volatile("" ::: "memory");
    const int c = lane & 7;
#pragma unroll
    for (int j = 0; j < 4; ++j) { const int n = (lane >> 3) + 8 * j; const LAS float* s = scr + (8 * c) * 33 + n;
        v4u o; o.x = pk2(s[0 * 33], s[1 * 33]); o.y = pk2(s[2 * 33], s[3 * 33]); o.z = pk2(s[4 * 33], s[5 * 33]); o.w = pk2(s[6 * 33], s[7 * 33]);
        __builtin_nontemporal_store(o, (v4u*)(WT + (size_t)(r0 + n) * dstK + k0 + 8 * c)); }
    LDS_WAIT(); asm volatile("" ::: "memory");
}
__device__ __forceinline__ void phase_prologue(const Frame& F, KP kp) {
    LAS float* scr = (LAS float*)(F.lds + F.wave * 16384);
    const int gw = F.bid * 8 + F.wave, NGW = F.G * 8;
    constexpr int I0 = 2 * 2048, I1 = 8 * 128, I2 = 2 * 2048, I3 = 4608, I4 = 512, I5 = 6144, I6 = 2048, I7 = 4 * 512, I8 = 4 * 256, I9 = 256 * 256, I10 = 256 * 128;
    constexpr int NITEMS = I0 + I1 + I2 + I3 + I4 + I5 + I6 + I7 + I8 + I9 + I10;
    unsigned char* ws = F.ws;
    for (int it = gw; it < NITEMS; it += NGW) {
        int r = it;
        if (r < I0) { const int b = r / 2048; tr_item(ain(kp, IN_PWIN) + (size_t)b * D * D, D, D, (bf16*)(ws + WS_W_POOL_IN) + (size_t)b * D * D, D, 0, scr, r % 2048, F.lane); continue; } r -= I0;
        if (r < I1) { const int b = r / 128; tr_item(ain(kp, IN_PWG) + (size_t)b * 512 * 512, 512, 512, (bf16*)(ws + WS_W_POOL_G) + (size_t)b * 512 * 512, 512, 0, scr, r % 128, F.lane); continue; } r -= I1;
        if (r < I2) { const int b = r / 2048; tr_item(ain(kp, IN_PWOUT) + (size_t)b * D * D, D, D, (bf16*)(ws + WS_W_POOL_OUT) + (size_t)b * D * D, D, 0, scr, r % 2048, F.lane); continue; } r -= I2;
        if (r < I3) { tr_item(ain(kp, IN_DQKV), D, QKVC, (bf16*)(ws + WS_W_DIL_QKV), D, 0, scr, r, F.lane); continue; } r -= I3;
        if (r < I4) { tr_item(ain(kp, IN_DOUT), DILW, D, (bf16*)(ws + WS_W_DIL_OUT), DILW, 0, scr, r, F.lane); continue; } r -= I4;
        if (r < I5) { tr_item(ain(kp, IN_CWIN), D, 3 * D, (bf16*)(ws + WS_W_CONV_IN), D, 1, scr, r, F.lane); continue; } r -= I5;
        if (r < I6) { tr_item(ain(kp, IN_CWOUT), D, D, (bf16*)(ws + WS_W_CONV_OUT), D, 0, scr, r, F.lane); continue; } r -= I6;
        if (r < I7) { const int b = r / 512; tr_item(ain(kp, IN_SGU) + (size_t)b * D * 512, D, 512, (bf16*)(ws + WS_W_SH_GU) + (size_t)b * 512 * D, D, 2, scr, r % 512, F.lane); continue; } r -= I7;
        if (r < I8) { const int b = r / 256; tr_item(ain(kp, IN_SD) + (size_t)b * SDIM * D, SDIM, D, (bf16*)(ws + WS_W_SH_D) + (size_t)b * D * SDIM, SDIM, 0, scr, r % 256, F.lane); continue; } r -= I8;
        if (r < I9) { const int b = r / 256; tr_item(ain(kp, IN_EGU) + (size_t)b * D * 256, D, 256, (bf16*)(ws + WS_W_EX_GU) + (size_t)b * 256 * D, D, 0, scr, r % 256, F.lane); continue; } r -= I9;
        { const int b = r / 128; tr_item(ain(kp, IN_ED) + (size_t)b * EDIM * D, EDIM, D, (bf16*)(ws + WS_W_EX_D) + (size_t)b * D * EDIM, EDIM, 0, scr, r % 128, F.lane); }
    }
    const size_t gt = (size_t)F.bid * 512 + F.tid, GT = (size_t)F.G * 512;
    { const float* rw = ain(kp, IN_RW); bf16* wh = (bf16*)(ws + WS_RWH); bf16* wl = (bf16*)(ws + WS_RWL);
      for (size_t i = gt; i < (size_t)DEPTH * NEXP * D / 8; i += GT) { const size_t k8 = i % (D / 8), e = (i / (D / 8)) % NEXP, l = i / ((size_t)NEXP * D / 8);
          float v[8]; unsigned hi[8], lo[8];
#pragma unroll
          for (int j = 0; j < 8; ++j) { v[j] = rw[(l * D + k8 * 8 + j) * NEXP + e]; hi[j] = f2bf(v[j]); lo[j] = f2bf(v[j] - __builtin_bit_cast(float, hi[j] << 16)); }
          v4u a, b2; a.x = hi[0] | (hi[1] << 16); a.y = hi[2] | (hi[3] << 16); a.z = hi[4] | (hi[5] << 16); a.w = hi[6] | (hi[7] << 16);
          b2.x = lo[0] | (lo[1] << 16); b2.y = lo[2] | (lo[3] << 16); b2.z = lo[4] | (lo[5] << 16); b2.w = lo[6] | (lo[7] << 16);
          *(v4u*)(wh + (l * NEXP + e) * D + k8 * 8) = a; *(v4u*)(wl + (l * NEXP + e) * D + k8 * 8) = b2; } }
    const float* x = ain(kp, IN_X); bf16* xb = (bf16*)(ws + WS_XB);
    for (size_t i = gt; i < (size_t)T * D / 8; i += GT) { const f32x4 p = __builtin_nontemporal_load((const f32x4*)(x + i * 8)), q = __builtin_nontemporal_load((const f32x4*)(x + i * 8 + 4));
        v4u w; w.x = pk2(p[0], p[1]); w.y = pk2(p[2], p[3]); w.z = pk2(q[0], q[1]); w.w = pk2(q[2], q[3]); *(v4u*)(xb + i * 8) = w; }
}

__device__ __forceinline__ void unpack8(const v4u w, float (&f)[8]) { f[0] = bflo(w.x); f[1] = bfhi(w.x); f[2] = bflo(w.y); f[3] = bfhi(w.y); f[4] = bflo(w.z); f[5] = bfhi(w.z); f[6] = bflo(w.w); f[7] = bfhi(w.w); }
__device__ __forceinline__ void phase_pool(const Frame& F, const bf16* U, bf16* PL) {
    for (int it = F.bid * 512 + F.tid; it < (T / 32) * 256; it += F.G * 512) {
        const int cv = it & 255, ch = it >> 8, col = cv * 8;
        const int w = __builtin_amdgcn_readfirstlane(2 << (col >> 9));
        const int row0 = __builtin_amdgcn_readfirstlane(ch * 32), pos0 = row0 & (SEQ - 1);
        float s[8], uu[8];
#pragma unroll
        for (int j = 0; j < 8; ++j) s[j] = 0.f;
        { v4u pre[15];
#pragma unroll
          for (int j = 0; j < 15; ++j) { pre[j] = (v4u){0u, 0u, 0u, 0u}; if (j + 1 < w && pos0 - (j + 1) >= 0) pre[j] = *(const v4u*)(U + (size_t)(row0 - (j + 1)) * D + col); }
#pragma unroll
          for (int j = 0; j < 15; ++j) asm volatile("" : "+v"(pre[j]));
#pragma unroll
          for (int j = 0; j < 15; ++j) { unpack8(pre[j], uu);
#pragma unroll
              for (int q = 0; q < 8; ++q) s[q] += uu[q]; } }
#pragma unroll 1
        for (int cb = 0; cb < 4; ++cb) {
            v4u un[8], uo[8];
#pragma unroll
            for (int j = 0; j < 8; ++j) { const int r = 8 * cb + j, t = row0 + r, pos = pos0 + r;
                un[j] = *(const v4u*)(U + (size_t)t * D + col);
                uo[j] = (v4u){0u, 0u, 0u, 0u}; if (pos - w + 1 >= 0) uo[j] = *(const v4u*)(U + (size_t)(t - w + 1) * D + col); }
#pragma unroll
            for (int j = 0; j < 8; ++j) asm volatile("" : "+v"(un[j]), "+v"(uo[j]));
#pragma unroll
            for (int j = 0; j < 8; ++j) { const int r = 8 * cb + j, t = row0 + r, pos = pos0 + r;
                unpack8(un[j], uu);
                const float inv = 1.0f / (float)((pos + 1) < w ? (pos + 1) : w);
                float o[8];
#pragma unroll
                for (int q = 0; q < 8; ++q) { s[q] += uu[q]; o[q] = s[q] * inv - uu[q]; }
                v4u ww; ww.x = pk2(o[0], o[1]); ww.y = pk2(o[2], o[3]); ww.z = pk2(o[4], o[5]); ww.w = pk2(o[6], o[7]);
                *(v4u*)(PL + (size_t)t * D + col) = ww;
                unpack8(uo[j], uu);
#pragma unroll
                for (int q = 0; q < 8; ++q) s[q] -= uu[q]; }
        }
    }
}

__device__ __forceinline__ void phase_conv(const Frame& F, const bf16* UC, const bf16* BGp, const float* cw, bf16* Z) {
    for (int it = F.bid * 512 + F.tid; it < (T / 4) * 256; it += F.G * 512) {
        const int cv = it & 255, col = cv * 8, t0 = __builtin_amdgcn_readfirstlane((it >> 8) * 4), pos0 = t0 & (SEQ - 1);
        v4u ur[6], br[4];
#pragma unroll
        for (int j = 0; j < 6; ++j) { ur[j] = (v4u){0u, 0u, 0u, 0u}; if (j >= 2 || pos0 > 0) ur[j] = *(const v4u*)(UC + (size_t)(t0 - 2 + j) * D + col); }
#pragma unroll
        for (int j = 0; j < 4; ++j) br[j] = *(const v4u*)(BGp + (size_t)(t0 + j) * D + col);
        const f32x4 c0a = *(const f32x4*)(cw + col), c0b = *(const f32x4*)(cw + col + 4), c1a = *(const f32x4*)(cw + D + col), c1b = *(const f32x4*)(cw + D + col + 4), c2a = *(const f32x4*)(cw + 2 * D + col), c2b = *(const f32x4*)(cw + 2 * D + col + 4);
        asm volatile("" : "+v"(ur[0]), "+v"(ur[1]), "+v"(ur[2]), "+v"(ur[3]), "+v"(ur[4]), "+v"(ur[5]), "+v"(br[0]), "+v"(br[1]), "+v"(br[2]), "+v"(br[3]));
        const float c0[8] = {c0a[0], c0a[1], c0a[2], c0a[3], c0b[0], c0b[1], c0b[2], c0b[3]}, c1[8] = {c1a[0], c1a[1], c1a[2], c1a[3], c1b[0], c1b[1], c1b[2], c1b[3]}, c2[8] = {c2a[0], c2a[1], c2a[2], c2a[3], c2b[0], c2b[1], c2b[2], c2b[3]};
#pragma unroll
        for (int j = 0; j < 4; ++j) { float u0[8], u1[8], u2[8], bb[8], o[8];
            unpack8(ur[j], u0); unpack8(ur[j + 1], u1); unpack8(ur[j + 2], u2); unpack8(br[j], bb);
#pragma unroll
            for (int q = 0; q < 8; ++q) o[q] = bb[q] * (c0[q] * u0[q] + c1[q] * u1[q] + c2[q] * u2[q]);
            v4u ww; ww.x = pk2(o[0], o[1]); ww.y = pk2(o[2], o[3]); ww.z = pk2(o[4], o[5]); ww.w = pk2(o[6], o[7]);
            *(v4u*)(Z + (size_t)(t0 + j) * D + col) = ww; }
    }
}

__device__ __forceinline__ int t5_bucket(int dist) {
    if (dist < 16) return dist;
    int large = 16 + (int)(logf((float)dist / 16.0f) / logf(128.0f) * 16.0f);
    return large < 31 ? large : 31;
}
constexpr int AT_KS = 0, AT_KSTR = 144, AT_VT = 256 * 144, AT_VSTR = 520, AT_BIAS = AT_VT + 64 * 520;
__device__ __forceinline__ void phase_attn(const Frame& F, const bf16* QKV, const float* relb, bf16* OG, float* LSE) {
    LAS unsigned char* lds = F.lds;
    const int tid = F.tid, lane = F.lane, w = tid >> 6, fr = lane & 15, fq = lane >> 4;
    for (int unit = F.bid; unit < NBATCH * 3 * 8 * 16; unit += F.G) {
        const int cmb = unit & 15, h = (unit >> 4) & 7, g = (unit >> 7) % 3, b = unit / 384;
        const int dsh = 2 * g, dil = 1 << dsh, r = cmb & (dil - 1), nb = cmb >> dsh;
        const bf16* base = QKV + (size_t)b * SEQ * QKVC + g * 1536 + h * 64;
        __syncthreads();
        {
            const int key = tid >> 1, half = tid & 1, jk = (nb - 1) * 128 + key;
            v4u kv[4], vv[4];
            if (jk >= 0) { const bf16* rp = base + (size_t)(jk * dil + r) * QKVC + half * 32;
#pragma unroll
                for (int i = 0; i < 4; ++i) { kv[i] = *(const v4u*)(rp + 512 + 8 * i); vv[i] = *(const v4u*)(rp + 1024 + 8 * i); } }
            else {
#pragma unroll
                for (int i = 0; i < 4; ++i) { kv[i] = (v4u){0u, 0u, 0u, 0u}; vv[i] = (v4u){0u, 0u, 0u, 0u}; } }
#pragma unroll
            for (int i = 0; i < 4; ++i) *(LAS v4u*)(lds + AT_KS + key * AT_KSTR + half * 64 + 16 * i) = kv[i];
#pragma unroll
            for (int i = 0; i < 4; ++i) {
                const unsigned ww[4] = {vv[i].x, vv[i].y, vv[i].z, vv[i].w};
#pragma unroll
                for (int q = 0; q < 4; ++q) { const int d = half * 32 + 8 * i + 2 * q;
                    *(LAS unsigned short*)(lds + AT_VT + d * AT_VSTR + key * 2) = (unsigned short)(ww[q] & 0xffffu);
                    *(LAS unsigned short*)(lds + AT_VT + (d + 1) * AT_VSTR + key * 2) = (unsigned short)(ww[q] >> 16); } }
            if (tid <= 128) ((LAS float*)(lds + AT_BIAS))[tid] = relb[t5_bucket(tid * dil) * 24 + g * 8 + h];
        }
        __syncthreads();
        int qi = 16 * w + fr; asm volatile("" : "+v"(qi));
        const int jq = nb * 128 + qi, tq = jq * dil + r;
        const bf16* qp = base + (size_t)tq * QKVC + 8 * fq;
        const bf16x8 q0 = *(const bf16x8*)qp, q1 = *(const bf16x8*)(qp + 32);
        f32x4 s[9]; float mx = -INFINITY;
#pragma unroll
        for (int kt = 0; kt < 9; ++kt) {
            const int kb = 16 * (w + kt);
            const bf16x8 k0 = *(const LAS bf16x8*)(lds + AT_KS + (kb + fr) * AT_KSTR + fq * 16), k1 = *(const LAS bf16x8*)(lds + AT_KS + (kb + fr) * AT_KSTR + 64 + fq * 16);
            f32x4 a = (f32x4){0.f, 0.f, 0.f, 0.f};
            a = __builtin_amdgcn_mfma_f32_16x16x32_bf16(k0, q0, a, 0, 0, 0);
            a = __builtin_amdgcn_mfma_f32_16x16x32_bf16(k1, q1, a, 0, 0, 0);
#pragma unroll
            for (int i = 0; i < 4; ++i) { const int kl = kb + 4 * fq + i, rel = qi + 128 - kl;
                const bool ok = (rel >= 0) && (rel <= 128) && (nb > 0 || kl >= 128);
                const int rc = rel < 0 ? 0 : (rel > 128 ? 128 : rel);
                float bv_ = ((LAS float*)(lds + AT_BIAS))[rc]; asm volatile("" : "+v"(bv_));
                const float v = ok ? a[i] + bv_ : -INFINITY;
                a[i] = v; mx = fmaxf(mx, v); }
            s[kt] = a;
        }
        mx = fmaxf(mx, shfl_x(mx, 16, lane)); mx = fmaxf(mx, shfl_x(mx, 32, lane));
        float l = 0.f;
#pragma unroll
        for (int kt = 0; kt < 9; ++kt)
#pragma unroll
            for (int i = 0; i < 4; ++i) { const float p = __expf(s[kt][i] - mx); s[kt][i] = p; l += p; }
        l += shfl_x(l, 16, lane); l += shfl_x(l, 32, lane);
        f32x4 o[4];
#pragma unroll
        for (int nt = 0; nt < 4; ++nt) o[nt] = (f32x4){0.f, 0.f, 0.f, 0.f};
#pragma unroll
        for (int st = 0; st < 5; ++st) {
            const int kt0 = 2 * st, kt1 = 2 * st + 1;
            v4u pw; pw.x = pk2(s[kt0][0], s[kt0][1]); pw.y = pk2(s[kt0][2], s[kt0][3]);
            if (kt1 < 9) { pw.z = pk2(s[kt1 < 9 ? kt1 : 0][0], s[kt1 < 9 ? kt1 : 0][1]); pw.w = pk2(s[kt1 < 9 ? kt1 : 0][2], s[kt1 < 9 ? kt1 : 0][3]); } else { pw.z = 0u; pw.w = 0u; }
            const bf16x8 pf = __builtin_bit_cast(bf16x8, pw);
            const int kb0 = 16 * (w + kt0) + 4 * fq, kb1 = 16 * (w + kt1) + 4 * fq;
#pragma unroll
            for (int nt = 0; nt < 4; ++nt) { const int d = 16 * nt + fr;
                v2u va = *(const LAS v2u*)(lds + AT_VT + d * AT_VSTR + kb0 * 2), vb = (v2u){0u, 0u};
                if (kt1 < 9) vb = *(const LAS v2u*)(lds + AT_VT + d * AT_VSTR + kb1 * 2);
                v4u vw; vw.x = va.x; vw.y = va.y; vw.z = vb.x; vw.w = vb.y;
                o[nt] = __builtin_amdgcn_mfma_f32_16x16x32_bf16(__builtin_bit_cast(bf16x8, vw), pf, o[nt], 0, 0, 0); }
        }
        const float il = 1.0f / l;
        bf16* op = OG + ((size_t)g * T + (size_t)b * SEQ + tq) * DILW + h * 64 + 4 * fq;
#pragma unroll
        for (int nt = 0; nt < 4; ++nt) { v2u ww; ww.x = pk2(o[nt][0] * il, o[nt][1] * il); ww.y = pk2(o[nt][2] * il, o[nt][3] * il); *(v2u*)(op + 16 * nt) = ww; }
        if (fq == 0) LSE[((size_t)g * T + (size_t)b * SEQ + tq) * 8 + h] = mx + logf(l);
    }
}
__device__ __forceinline__ void phase_combine(const Frame& F, const bf16* OG, const float* LSE, bf16* O) {
    for (int it0 = F.bid * 512 + F.tid; it0 < T * 64; it0 += 4 * F.G * 512) {
        float ls[4][3]; v4u og[4][3];
#pragma unroll
        for (int u = 0; u < 4; ++u) { int it = it0 + u * F.G * 512; it = it < T * 64 ? it : it0;
            const int c8 = it & 7, h = (it >> 3) & 7, t = it >> 6; const size_t off = (size_t)t * DILW + h * 64 + c8 * 8;
#pragma unroll
            for (int g = 0; g < 3; ++g) { ls[u][g] = LSE[((size_t)g * T + t) * 8 + h]; og[u][g] = *(const v4u*)(OG + (size_t)g * T * DILW + off); } }
#pragma unroll
        for (int u = 0; u < 4; ++u) asm volatile("" : "+v"(ls[u][0]), "+v"(ls[u][1]), "+v"(ls[u][2]), "+v"(og[u][0]), "+v"(og[u][1]), "+v"(og[u][2]));
#pragma unroll
        for (int u = 0; u < 4; ++u) { const int it = it0 + u * F.G * 512, c8 = it & 7, h = (it >> 3) & 7, t = it >> 6; const size_t off = (size_t)t * DILW + h * 64 + c8 * 8;
            if (it >= T * 64) continue;
            const float l0 = ls[u][0], l1 = ls[u][1], l2 = ls[u][2];
            const float m = fmaxf(l0, fmaxf(l1, l2)); float w0 = __expf(l0 - m), w1 = __expf(l1 - m), w2 = __expf(l2 - m); const float inv = 1.0f / (w0 + w1 + w2); w0 *= inv; w1 *= inv; w2 *= inv;
            float a[8], bq[8], c[8], o[8];
            unpack8(og[u][0], a); unpack8(og[u][1], bq); unpack8(og[u][2], c);
#pragma unroll
            for (int q = 0; q < 8; ++q) o[q] = w0 * a[q] + w1 * bq[q] + w2 * c[q];
            v4u ww; ww.x = pk2(o[0], o[1]); ww.y = pk2(o[2], o[3]); ww.z = pk2(o[4], o[5]); ww.w = pk2(o[6], o[7]);
            *(v4u*)(O + off) = ww; }
    }
}

constexpr int M1_LOG = 131072, M1_STAT = M1_LOG + 4096, M1_HIST = M1_STAT + 128, M1_BASE = M1_HIST + 256;
__device__ __forceinline__ void phase_moe1(const Frame& F, const float* Y, const float* gain, const float* bias, const float* RW, const float* RB,
                                           float* X1F, bf16* X1B, unsigned* cnt, int* ltok, float* lgate, int* eidx, int* inv) {
    LAS float* xs = (LAS float*)F.lds; LAS float* logit = (LAS float*)(F.lds + M1_LOG); LAS float* stat = (LAS float*)(F.lds + M1_STAT);
    LAS int* hist = (LAS int*)(F.lds + M1_HIST); LAS int* basep = (LAS int*)(F.lds + M1_BASE);
    const int tid = F.tid, lane = F.lane, w = F.wave;
    for (int rg = F.bid; rg < T / 16; rg += F.G) {
        const int row0 = rg * 16;
        __syncthreads();
#pragma unroll
        for (int j = 0; j < 16; ++j) { const int idx = tid + 512 * j; *(LAS f32x4*)(xs + idx * 4) = *(const f32x4*)(Y + (size_t)row0 * D + (size_t)idx * 4); }
        if (tid < 64) hist[tid] = 0;
        __syncthreads();
#pragma unroll
        for (int rr = 0; rr < 2; ++rr) { const int r = 2 * w + rr; float sm = 0.f;
#pragma unroll
            for (int j = 0; j < 32; ++j) sm += xs[r * D + lane + 64 * j];
            const float mean = wave_sum(sm, lane) * (1.0f / D); float sq = 0.f;
#pragma unroll
            for (int j = 0; j < 32; ++j) { const float d = xs[r * D + lane + 64 * j] - mean; sq += d * d; }
            const float rstd = 1.0f / sqrtf(wave_sum(sq, lane) * (1.0f / D) + LN_EPS);
            if (lane == 0) { stat[2 * r] = mean; stat[2 * r + 1] = rstd; } }
        __syncthreads();
#pragma unroll
        for (int j = 0; j < 16; ++j) { const int idx = tid + 512 * j, r = idx >> 9, c4 = (idx & 511) * 4;
            const f32x4 v = *(LAS f32x4*)(xs + idx * 4), gv = *(const f32x4*)(gain + c4), bv = *(const f32x4*)(bias + c4);
            const float mean = stat[2 * r], rstd = stat[2 * r + 1];
            const f32x4 o = (v - mean) * rstd * gv + bv;
            *(LAS f32x4*)(xs + idx * 4) = o;
            *(f32x4*)(X1F + (size_t)(row0 + r) * D + c4) = o;
            v2u wb; wb.x = pk2(o[0], o[1]); wb.y = pk2(o[2], o[3]); *(v2u*)(X1B + (size_t)(row0 + r) * D + c4) = wb; }
        __syncthreads();
        { const int r = tid >> 5, ep = tid & 31; float a0 = 0.f, a1 = 0.f; const float* wp = RW + 2 * ep; const LAS float* xr = xs + r * D;
            for (int k0 = 0; k0 < D; k0 += 16) {
                f32x2 wv[16];
#pragma unroll
                for (int j = 0; j < 16; ++j) wv[j] = *(const f32x2*)(wp + (size_t)(k0 + j) * NEXP);
                asm volatile("" : "+v"(wv[0]), "+v"(wv[1]), "+v"(wv[2]), "+v"(wv[3]), "+v"(wv[4]), "+v"(wv[5]), "+v"(wv[6]), "+v"(wv[7]));
                asm volatile("" : "+v"(wv[8]), "+v"(wv[9]), "+v"(wv[10]), "+v"(wv[11]), "+v"(wv[12]), "+v"(wv[13]), "+v"(wv[14]), "+v"(wv[15]));
#pragma unroll
                for (int j = 0; j < 16; ++j) { const float xv = xr[k0 + j]; a0 += xv * wv[j].x; a1 += xv * wv[j].y; } }
            logit[r * NEXP + 2 * ep] = a0; logit[r * NEXP + 2 * ep + 1] = a1; }
        __syncthreads();
        int sel_pos[2]; float sel_gate[2]; int sel_rank[2]; bool sel_on[2];
#pragma unroll
        for (int rr = 0; rr < 2; ++rr) { const int r = 2 * w + rr;
            const float sc = 1.0f / (1.0f + __expf(-logit[r * NEXP + lane])); const float ch = sc + RB[lane];
            int rk = 0;
#pragma unroll
            for (int j = 0; j < 8; ++j) { const float cj = shfl_from(ch, (lane & ~7) + j); rk += (cj > ch || (cj == ch && j < (lane & 7))) ? 1 : 0; }
            float gs = rk < 2 ? ch : 0.f; gs += shfl_x(gs, 1, lane); gs += shfl_x(gs, 2, lane); gs += shfl_x(gs, 4, lane);
            int grk = 0; const int g = lane >> 3;
#pragma unroll
            for (int hh = 0; hh < 8; ++hh) { const float gh = shfl_from(gs, 8 * hh); grk += (gh > gs || (gh == gs && hh < g)) ? 1 : 0; }
            const float msk = grk < 4 ? ch : -INFINITY;
            int erk = 0;
            for (int j = 0; j < 64; ++j) { const float mj = __builtin_bit_cast(float, __builtin_amdgcn_readlane(__builtin_bit_cast(int, msk), j)); erk += (mj > msk || (mj == msk && j < lane)) ? 1 : 0; }
            const bool on = erk < 8;
            const float ssum = wave_sum(on ? sc : 0.f, lane);
            sel_on[rr] = on; sel_rank[rr] = erk; sel_gate[rr] = sc / ssum * 2.5f; sel_pos[rr] = 0;
            if (on) sel_pos[rr] = __hip_atomic_fetch_add(&hist[lane], 1, __ATOMIC_RELAXED, __HIP_MEMORY_SCOPE_WORKGROUP); }
        __syncthreads();
        if (tid < 64) { const int hc = hist[tid]; int bs = 0; if (hc > 0) bs = (int)atomicAdd(&cnt[tid * 16], (unsigned)hc); basep[tid] = bs; }
        __syncthreads();
#pragma unroll
        for (int rr = 0; rr < 2; ++rr) if (sel_on[rr]) { const int t = row0 + 2 * w + rr, pos = basep[lane] + sel_pos[rr];
            ltok[(size_t)lane * CAP + pos] = t; lgate[(size_t)lane * CAP + pos] = sel_gate[rr];
            eidx[t * 8 + sel_rank[rr]] = lane; inv[t * 8 + sel_rank[rr]] = pos; }
    }
}
__device__ __forceinline__ int build_tiles(const Frame& F, const unsigned* cnt) {
    LAS int* tpref = (LAS int*)(F.lds + LDS_TAB); LAS int* cl = (LAS int*)(F.lds + LDS_TAB + 512);
    __syncthreads();
    if (F.tid < 64) {
        const int lane = F.lane; const int c = (int)__hip_atomic_load(&cnt[lane * 16], __ATOMIC_RELAXED, __HIP_MEMORY_SCOPE_AGENT);
        const int tl = (c + 255) >> 8; int inc = tl;
#pragma unroll
        for (int o = 1; o < 64; o <<= 1) { const int v = __builtin_amdgcn_ds_bpermute((lane >= o ? lane - o : lane) << 2, inc); inc += lane >= o ? v : 0; }
        cl[lane] = c; tpref[lane] = inc - tl;
        if (lane == 63) { tpref[64] = inc; tpref[65] = inc + T / 256; tpref[66] = inc + 2 * (T / 256); cl[64] = T; cl[65] = T; } }
    __syncthreads();
    return __builtin_amdgcn_readfirstlane(tpref[64]);
}
__device__ __forceinline__ void phase_moe4(const Frame& F, const float* Y2, const bf16* Yr, const int* eidx, const int* inv, const float* gain, const float* bias, float* XO, bf16* XBo) {
    const LAS int* tpref = (const LAS int*)(F.lds + LDS_TAB);
    const int gw = F.bid * 8 + F.wave, NGW = F.G * 8, lane = F.lane;
    for (int t = gw; t < T; t += NGW) {
        f32x4 v[8];
#pragma unroll
        for (int j = 0; j < 8; ++j) v[j] = *(const f32x4*)(Y2 + (size_t)t * D + 4 * lane + 256 * j);
        for (int k = 0; k < 8; ++k) { const int e = eidx[t * 8 + k], pos = inv[t * 8 + k]; const bf16* yr = Yr + (size_t)(tpref[e] * 256 + pos) * D + 4 * lane;
#pragma unroll
            for (int j = 0; j < 8; ++j) { const v2u w = *(const v2u*)(yr + 256 * j); v[j][0] += bflo(w.x); v[j][1] += bfhi(w.x); v[j][2] += bflo(w.y); v[j][3] += bfhi(w.y); } }
        float sm = 0.f;
#pragma unroll
        for (int j = 0; j < 8; ++j) sm += (v[j][0] + v[j][1]) + (v[j][2] + v[j][3]);
        const float mean = wave_sum(sm, lane) * (1.0f / D); float sq = 0.f;
#pragma unroll
        for (int j = 0; j < 8; ++j) { v[j] = v[j] - mean; sq += (v[j][0] * v[j][0] + v[j][1] * v[j][1]) + (v[j][2] * v[j][2] + v[j][3] * v[j][3]); }
        const float rstd = 1.0f / sqrtf(wave_sum(sq, lane) * (1.0f / D) + LN_EPS);
#pragma unroll
        for (int j = 0; j < 8; ++j) { const int c = 4 * lane + 256 * j; const f32x4 o = v[j] * rstd * *(const f32x4*)(gain + c) + *(const f32x4*)(bias + c);
            *(f32x4*)(XO + (size_t)t * D + c) = o;
            v2u wb; wb.x = pk2(o[0], o[1]); wb.y = pk2(o[2], o[3]); *(v2u*)(XBo + (size_t)t * D + c) = wb; }
    }
}


template <int CTRL> __device__ __forceinline__ float dppf(float x) { return __builtin_bit_cast(float, __builtin_amdgcn_update_dpp(0, __builtin_bit_cast(int, x), CTRL, 0xF, 0xF, false)); }
__device__ __forceinline__ float gmax8(float x) { x = fmaxf(x, dppf<0xB1>(x)); x = fmaxf(x, dppf<0x4E>(x)); x = fmaxf(x, dppf<0x141>(x)); return x; }
__device__ __forceinline__ float gsum8(float x) { x += dppf<0xB1>(x); x += dppf<0x4E>(x); x += dppf<0x141>(x); return x; }
__device__ __forceinline__ float rl_f(float x, int l) { return __builtin_bit_cast(float, __builtin_amdgcn_readlane(__builtin_bit_cast(int, x), l)); }
constexpr int M1_P = 0, M1N_HIST = 131072, M1N_BASE = 131072 + 256, M1N_GB = 131072 + 1024;
__device__ __forceinline__ void phase_moe1n(const Frame& F, const bf16* Y, const float* pst, const float* gain, const float* bias, const bf16* WH, const bf16* WL, const float* RB,
                                            bf16* X1B, float* ST1, unsigned* cnt, int* ltok, float* lgate, int* eidx, int* inv) {
    LAS float* P = (LAS float*)(F.lds + M1_P); LAS int* hist = (LAS int*)(F.lds + M1N_HIST); LAS int* basep = (LAS int*)(F.lds + M1N_BASE);
    const int tid = F.tid, lane = F.lane, w = F.wave, r = lane & 15, q = lane >> 4;
    for (int item = F.bid; item < T / 64; item += F.G) {
        const int row0 = item * 64;
        __syncthreads();
        { int t0 = tid; asm volatile("" : "+v"(t0));
          if (t0 < 64) hist[t0] = 0;
          LAS f32x4* gb = (LAS f32x4*)(F.lds + M1N_GB); gb[t0] = *(const f32x4*)(gain + 4 * t0); gb[512 + t0] = *(const f32x4*)(bias + 4 * t0); }
        __syncthreads();
        float mean[4], rstd[4];
#pragma unroll
        for (int rt = 0; rt < 4; ++rt) { const int row = row0 + 16 * rt + r;
          const f32x4* pp = (const f32x4*)(pst + ((size_t)row * 32 + q * 8) * 2); const f32x4 a = pp[0], b = pp[1], c = pp[2], d = pp[3];
          float sm = (a[0] + a[2]) + (b[0] + b[2]) + (c[0] + c[2]) + (d[0] + d[2]), sq = (a[1] + a[3]) + (b[1] + b[3]) + (c[1] + c[3]) + (d[1] + d[3]);
          sm += shfl_x(sm, 16, lane); sm += shfl_x(sm, 32, lane); sq += shfl_x(sq, 16, lane); sq += shfl_x(sq, 32, lane);
          mean[rt] = sm * (1.0f / D); const float var = fmaxf(sq * (1.0f / D) - mean[rt] * mean[rt], 0.f); rstd[rt] = 1.0f / sqrtf(var + LN_EPS);
          if (w == 0 && q == 0) *(f32x2*)(ST1 + 2 * row) = (f32x2){mean[rt], rstd[rt]}; }
        const int kb = 256 * w + 8 * q;
        const LAS float* gl = (const LAS float*)(F.lds + M1N_GB) + kb;
        f32x4 acc[4][4];
#pragma unroll
        for (int rt = 0; rt < 4; ++rt)
#pragma unroll
            for (int nt = 0; nt < 4; ++nt) acc[rt][nt] = (f32x4){0.f, 0.f, 0.f, 0.f};
        v4u yb[2][2][4], hb[4]; bf16x8 wh[4], wl[4];
        unsigned vo[4];
#pragma unroll
        for (int i = 0; i < 4; ++i) { vo[i] = (unsigned)(r * D + kb) * 2u + (unsigned)i * (16u * D * 2u); asm volatile("" : "+v"(vo[i])); }
        const char* ybase = (const char*)(Y + (size_t)row0 * D); char* xbase = (char*)(X1B + (size_t)row0 * D);
#define M1_LOADY(ms) do { _Pragma("unroll") for (int hf = 0; hf < 2; ++hf) _Pragma("unroll") for (int rt = 0; rt < 4; ++rt) yb[(ms) & 1][hf][rt] = *(const v4u*)(ybase + vo[rt] + 128 * (ms) + 64 * hf); } while (0)
#define M1_LOADW(st) do { _Pragma("unroll") for (int nt = 0; nt < 4; ++nt) { wh[nt] = *(const bf16x8*)((const char*)WH + vo[nt] + 64 * (st)); wl[nt] = *(const bf16x8*)((const char*)WL + vo[nt] + 64 * (st)); } } while (0)
        M1_LOADY(0); M1_LOADW(0); M1_LOADY(1);
        __builtin_amdgcn_sched_barrier(0);
#pragma unroll
        for (int st = 0; st < 8; ++st) {
            const f32x4 g0 = *(const LAS f32x4*)(gl + 32 * st), g1 = *(const LAS f32x4*)(gl + 32 * st + 4), b0 = *(const LAS f32x4*)(gl + 2048 + 32 * st), b1 = *(const LAS f32x4*)(gl + 2048 + 32 * st + 4);
#pragma unroll
            for (int rt = 0; rt < 4; ++rt) { const v4u yv = yb[(st >> 1) & 1][st & 1][rt];
                const f32x4 y0_ = (f32x4){bflo(yv.x), bfhi(yv.x), bflo(yv.y), bfhi(yv.y)}, y1_ = (f32x4){bflo(yv.z), bfhi(yv.z), bflo(yv.w), bfhi(yv.w)};
                const f32x4 x0 = (y0_ - mean[rt]) * rstd[rt] * g0 + b0, x1 = (y1_ - mean[rt]) * rstd[rt] * g1 + b1;
                v4u h; h.x = cvt_pk_bf16(x0[0], x0[1]); h.y = cvt_pk_bf16(x0[2], x0[3]); h.z = cvt_pk_bf16(x1[0], x1[1]); h.w = cvt_pk_bf16(x1[2], x1[3]);
                if ((st & 1) == 0) hb[rt] = h; else { *(v4u*)(xbase + vo[rt] + 64 * (st - 1)) = hb[rt]; *(v4u*)(xbase + vo[rt] + 64 * st) = h; }
                v4u l; l.x = cvt_pk_bf16(x0[0] - bflo(h.x), x0[1] - bfhi(h.x)); l.y = cvt_pk_bf16(x0[2] - bflo(h.y), x0[3] - bfhi(h.y));
                l.z = cvt_pk_bf16(x1[0] - bflo(h.z), x1[1] - bfhi(h.z)); l.w = cvt_pk_bf16(x1[2] - bflo(h.w), x1[3] - bfhi(h.w));
                const bf16x8 xh = __builtin_bit_cast(bf16x8, h), xl = __builtin_bit_cast(bf16x8, l);
#pragma unroll
                for (int nt = 0; nt < 4; ++nt) { acc[rt][nt] = __builtin_amdgcn_mfma_f32_16x16x32_bf16(xh, wh[nt], acc[rt][nt], 0, 0, 0);
                    acc[rt][nt] = __builtin_amdgcn_mfma_f32_16x16x32_bf16(xl, wh[nt], acc[rt][nt], 0, 0, 0); acc[rt][nt] = __builtin_amdgcn_mfma_f32_16x16x32_bf16(xh, wl[nt], acc[rt][nt], 0, 0, 0); } }
            __builtin_amdgcn_sched_barrier(0);
            if (st + 1 < 8) M1_LOADW(st + 1);
            if ((st & 1) == 1 && (st >> 1) + 2 < 4) M1_LOADY((st >> 1) + 2);
            __builtin_amdgcn_sched_barrier(0);
        }
#undef M1_LOADY
#undef M1_LOADW
#pragma unroll
        for (int rt = 0; rt < 4; ++rt)
#pragma unroll
            for (int nt = 0; nt < 4; ++nt)
#pragma unroll
                for (int i = 0; i < 4; ++i) P[(w * 64 + 16 * rt + 4 * q + i) * 64 + 16 * nt + r] = acc[rt][nt][i];
        __syncthreads();
        const float rb = RB[lane];
        LAS int* Pi = (LAS int*)P;
#pragma unroll 1
        for (int rr = 0; rr < 8; ++rr) { const int rl = 8 * w + rr;
            float lg = ((P[rl * 64 + lane] + P[(64 + rl) * 64 + lane]) + (P[(128 + rl) * 64 + lane] + P[(192 + rl) * 64 + lane])) + ((P[(256 + rl) * 64 + lane] + P[(320 + rl) * 64 + lane]) + (P[(384 + rl) * 64 + lane] + P[(448 + rl) * 64 + lane]));
            lg = (lg == lg) ? lg : -1.0e30f;
            const float sc = 1.0f / (1.0f + __expf(-lg)); const float ch = sc + rb;
            const float m1 = gmax8(ch), neq = gsum8(ch == m1 ? 1.f : 0.f), m2c = gmax8(ch < m1 ? ch : -INFINITY);
            const float gs = m1 + (neq >= 2.f ? m1 : m2c);
            int grk = 0; const int g = lane >> 3;
#pragma unroll
            for (int hh = 0; hh < 8; ++hh) { const float gh = rl_f(gs, 8 * hh); grk += (gh > gs || (gh == gs && hh < g)) ? 1 : 0; }
            const float msk = grk < 4 ? ch : -INFINITY;
            float cur = msk, ssum = 0.f; int erk = 64;
#pragma unroll 1
            for (int k = 0; k < 8; ++k) {
                float rm = gmax8(cur); rm = fmaxf(rm, dppf<0x140>(rm));
                const float wm = fmaxf(fmaxf(rl_f(rm, 0), rl_f(rm, 16)), fmaxf(rl_f(rm, 32), rl_f(rm, 48)));
                const unsigned long long bal = __builtin_amdgcn_ballot_w64(cur == wm);
                const int lsel = __builtin_amdgcn_readfirstlane((int)__builtin_ctzll(bal));
                ssum += rl_f(sc, lsel);
                const bool me = lane == lsel; erk = me ? k : erk; cur = me ? -INFINITY : cur; }
            const bool on = erk < 8;
            int pk_ = -1; if (on) pk_ = __hip_atomic_fetch_add(&hist[lane], 1, __ATOMIC_RELAXED, __HIP_MEMORY_SCOPE_WORKGROUP) | (erk << 16);
            P[rl * 64 + lane] = sc / ssum * 2.5f; Pi[(64 + rl) * 64 + lane] = pk_; }
        __syncthreads();
        if (tid < 64) { int tt = tid; asm volatile("" : "+v"(tt));
            const int hc = hist[tt]; int bs = 0; if (hc > 0) bs = (int)atomicAdd(&cnt[tt * 16], (unsigned)hc); basep[tt] = bs; }
        __syncthreads();
        { const int bl = basep[lane];
#pragma unroll 1
          for (int rr = 0; rr < 8; ++rr) { const int rl = 8 * w + rr; const int pk_ = Pi[(64 + rl) * 64 + lane]; const float gt_ = P[rl * 64 + lane];
            if (pk_ >= 0) { const int t = row0 + rl, pos = bl + (pk_ & 0xffff), rk_ = pk_ >> 16;
                ltok[(size_t)lane * CAP + pos] = t * 8 + rk_; lgate[(size_t)lane * CAP + pos] = gt_;
                eidx[t * 8 + rk_] = lane; inv[t * 8 + rk_] = pos; } } }
    }
}

constexpr int M3_PL = 131072, M3_CNT = 147456, M3_OFF = 147456 + 272;
__device__ __forceinline__ void phase_moe3n(const Frame& F, const bf16* H, const bf16* HSp, const int* eidx, const bf16* WD, const bf16* WSD,
                                            const float* Y1, const float* ST1, const float* g1, const float* b1, float* Y2, float* PST2) {
    LAS int* out = (LAS int*)F.lds; LAS unsigned short* plist = (LAS unsigned short*)(F.lds + M3_PL); LAS int* cnt = (LAS int*)(F.lds + M3_CNT); LAS int* off = (LAS int*)(F.lds + M3_OFF);
    const int tid = F.tid, lane = F.lane, w = F.wave, r = lane & 15, q = lane >> 4;
    for (int u = F.bid; u < 1024; u += F.G) {
        int nc = (u & 7) | ((u >> 7) << 3), tb = (u >> 3) & 15;
        if (F.G == 256) { const int i = u >> 8, x = u & 7, j = (u >> 3) & 31; tb = 2 * x + (i >> 1); nc = 32 * (i & 1) + j; }
        __syncthreads();
#pragma unroll
        for (int j = 0; j < 16; ++j) ((LAS v4u*)out)[tid + 512 * j] = (v4u){0u, 0u, 0u, 0u};
        if (tid < 66) cnt[tid] = 0;
        __syncthreads();
        int ee[16], pp[16];
        { const v4u* ep = (const v4u*)(eidx + ((size_t)tb * 1024 + 2 * tid) * 8); const v4u e0 = ep[0], e1 = ep[1], e2 = ep[2], e3 = ep[3];
          ee[0] = e0.x; ee[1] = e0.y; ee[2] = e0.z; ee[3] = e0.w; ee[4] = e1.x; ee[5] = e1.y; ee[6] = e1.z; ee[7] = e1.w;
          ee[8] = e2.x; ee[9] = e2.y; ee[10] = e2.z; ee[11] = e2.w; ee[12] = e3.x; ee[13] = e3.y; ee[14] = e3.z; ee[15] = e3.w; }
#pragma unroll
        for (int j = 0; j < 16; ++j) pp[j] = __hip_atomic_fetch_add(&cnt[ee[j]], 1, __ATOMIC_RELAXED, __HIP_MEMORY_SCOPE_WORKGROUP);
        __syncthreads();
        if (w == 0) { int c = cnt[lane], x = c;
#pragma unroll
            for (int o = 1; o < 64; o <<= 1) { const int y = __builtin_amdgcn_ds_bpermute(((lane - o) & 63) << 2, x); if (lane >= o) x += y; }
            off[lane] = x - c; if (lane == 63) off[64] = x; }
        __syncthreads();
#pragma unroll
        for (int j = 0; j < 16; ++j) plist[off[ee[j]] + pp[j]] = (unsigned short)(tid * 16 + j);
        __syncthreads();
        const char* Hb = (const char*)H + (size_t)tb * 8192 * 256 + q * 16;
        const char* HSb = (const char*)HSp + (size_t)tb * 1024 * 512 + q * 16;
        const char* Bb = (const char*)WD + ((size_t)nc * 32 + r) * 256 + q * 16;
        const char* BSb = (const char*)WSD + ((size_t)nc * 32 + r) * 512 + q * 16;
#define M3_NR(sg) ((sg) < 8 ? __builtin_amdgcn_readfirstlane(cnt[w + 8 * (sg)]) : 128)
#define M3_RB(sg) ((sg) < 8 ? __builtin_amdgcn_readfirstlane(off[w + 8 * (sg)]) : 0)
#define M3_GLD(dst, ptr, OFF) asm volatile("global_load_dwordx4 %0, %1, off offset:" #OFF : "=&v"(dst) : "v"(ptr) : "memory")
#define M3_LOADB(dst, sg) do { const char* _b0 = (sg) < 8 ? Bb + (size_t)(w + 8 * (sg)) * 524288 : BSb + ((sg) - 8) * 256; const char* _b1 = _b0 + ((sg) < 8 ? 4096 : 8192); \
            M3_GLD(dst[0][0], _b0, 0); M3_GLD(dst[0][1], _b0, 64); M3_GLD(dst[0][2], _b0, 128); M3_GLD(dst[0][3], _b0, 192); \
            M3_GLD(dst[1][0], _b1, 0); M3_GLD(dst[1][1], _b1, 64); M3_GLD(dst[1][2], _b1, 128); M3_GLD(dst[1][3], _b1, 192); } while (0)
#define M3_LOADA(dst, sg, bb, nr, rbs) do { int _i = 16 * (bb) + r; _i = _i < (nr) ? _i : (nr) - 1; const unsigned _rid = plist[(rbs) + _i]; \
            const char* _a = (sg) < 8 ? Hb + (size_t)_rid * 256 : ((sg) < 10 ? HSb + (size_t)(128 * w + _i) * 512 + ((sg) - 8) * 256 : Hb); \
            M3_GLD(dst[0], _a, 0); M3_GLD(dst[1], _a, 64); M3_GLD(dst[2], _a, 128); M3_GLD(dst[3], _a, 192); } while (0)
#define M3_ADV(sg, bb, nr, rbs) do { if ((sg) < 10) { ++(bb); if ((bb) * 16 >= (nr)) { (bb) = 0; do { ++(sg); } while ((sg) < 8 && M3_NR(sg) == 0); if ((sg) < 10) { (nr) = M3_NR(sg); (rbs) = M3_RB(sg); } } } } while (0)
#define M3_WAITA(AS) asm volatile("s_waitcnt vmcnt(12)" : "+v"(AS[0]), "+v"(AS[1]), "+v"(AS[2]), "+v"(AS[3]) :: "memory")
#define M3_WAITB(N) asm volatile("s_waitcnt vmcnt(" #N ")" : "+v"(Bn[0][0]), "+v"(Bn[0][1]), "+v"(Bn[0][2]), "+v"(Bn[0][3]), "+v"(Bn[1][0]), "+v"(Bn[1][1]), "+v"(Bn[1][2]), "+v"(Bn[1][3]) :: "memory")
#define M3_STEP(AS) if (cseg < 10) { \
              \
            int tk[4]; bool ok[4]; unsigned pl[4]; const int rt_ = cseg < 8; \
            _Pragma("unroll") for (int i = 0; i < 4; ++i) { const int idx = 16 * cbt + 4 * q + i; ok[i] = idx < cnr; const int ic = ok[i] ? idx : cnr - 1; pl[i] = plist[crbs + ic]; tk[i] = 128 * w + ic; } \
            _Pragma("unroll") for (int i = 0; i < 4; ++i) tk[i] = rt_ ? (int)(pl[i] >> 3) : tk[i]; \
            M3_WAITA(AS); \
            f32x4 acc[2]; \
            _Pragma("unroll") for (int nt = 0; nt < 2; ++nt) { acc[nt] = (f32x4){0.f, 0.f, 0.f, 0.f}; \
                _Pragma("unroll") for (int kk = 0; kk < 4; ++kk) acc[nt] = __builtin_amdgcn_mfma_f32_16x16x32_bf16(__builtin_bit_cast(bf16x8, AS[kk]), __builtin_bit_cast(bf16x8, Bc[nt][kk]), acc[nt], 0, 0, 0); } \
              \
            _Pragma("unroll") for (int i = 0; i < 4; ++i) { const long long lo_ = ok[i] ? (long long)__float2int_rn(acc[0][i] * 4194304.0f) : 0ll, hi_ = ok[i] ? (long long)__float2int_rn(acc[1][i] * 4194304.0f) : 0ll; \
                (void)__hip_atomic_fetch_add((LAS unsigned long long*)out + tk[i] * 16 + r, (unsigned long long)((hi_ << 32) + lo_), __ATOMIC_RELAXED, __HIP_MEMORY_SCOPE_WORKGROUP); } \
            M3_LOADA(AS, pseg, pbt, pnr, prbs); M3_ADV(pseg, pbt, pnr, prbs); \
            { const int old_ = cseg, nbat_ = (cnr + 15) >> 4; M3_ADV(cseg, cbt, cnr, crbs); \
              if (cseg != old_ && cseg < 10) { \
                  if (nbat_ == 1) M3_WAITB(4); else if (nbat_ == 2) M3_WAITB(8); else if (nbat_ == 3) M3_WAITB(12); else M3_WAITB(16); \
                  _Pragma("unroll") for (int nt = 0; nt < 2; ++nt) _Pragma("unroll") for (int kk = 0; kk < 4; ++kk) Bc[nt][kk] = Bn[nt][kk]; \
                  int nb_ = cseg; do { ++nb_; } while (nb_ < 8 && M3_NR(nb_) == 0); if (nb_ >= 10) nb_ = 9; M3_LOADB(Bn, nb_); } } }
        int cseg = -1, cbt = 0, cnr = 0, crbs = 0;
        do { ++cseg; } while (cseg < 8 && M3_NR(cseg) == 0);
        cnr = M3_NR(cseg); crbs = M3_RB(cseg);
        int pseg = cseg, pbt = 0, pnr = cnr, prbs = crbs;
        v4u Bc[2][4], Bn[2][4], A0[4], A1[4], A2[4], A3[4];
        M3_LOADB(Bc, cseg);
        M3_LOADA(A0, pseg, pbt, pnr, prbs); M3_ADV(pseg, pbt, pnr, prbs);
        M3_LOADA(A1, pseg, pbt, pnr, prbs); M3_ADV(pseg, pbt, pnr, prbs);
        M3_LOADA(A2, pseg, pbt, pnr, prbs); M3_ADV(pseg, pbt, pnr, prbs);
        M3_LOADA(A3, pseg, pbt, pnr, prbs); M3_ADV(pseg, pbt, pnr, prbs);
        { int nb_ = cseg; do { ++nb_; } while (nb_ < 8 && M3_NR(nb_) == 0); if (nb_ >= 10) nb_ = 9; M3_LOADB(Bn, nb_); }
        asm volatile("s_waitcnt vmcnt(0)" : "+v"(Bc[0][0]), "+v"(Bc[0][1]), "+v"(Bc[0][2]), "+v"(Bc[0][3]), "+v"(Bc[1][0]), "+v"(Bc[1][1]), "+v"(Bc[1][2]), "+v"(Bc[1][3]) :: "memory");
#pragma unroll 1
        while (cseg < 10) { M3_STEP(A0) M3_STEP(A1) M3_STEP(A2) M3_STEP(A3) }
        asm volatile("s_waitcnt vmcnt(0)" : "+v"(A0[0]), "+v"(A0[1]), "+v"(A0[2]), "+v"(A0[3]), "+v"(A1[0]), "+v"(A1[1]), "+v"(A1[2]), "+v"(A1[3]), "+v"(A2[0]), "+v"(A2[1]), "+v"(A2[2]), "+v"(A2[3]),
                     "+v"(A3[0]), "+v"(A3[1]), "+v"(A3[2]), "+v"(A3[3]), "+v"(Bn[0][0]), "+v"(Bn[0][1]), "+v"(Bn[0][2]), "+v"(Bn[0][3]), "+v"(Bn[1][0]), "+v"(Bn[1][1]), "+v"(Bn[1][2]), "+v"(Bn[1][3]) :: "memory");
#undef M3_NR
#undef M3_RB
#undef M3_GLD
#undef M3_LOADB
#undef M3_LOADA
#undef M3_ADV
#undef M3_WAITA
#undef M3_WAITB
#undef M3_STEP
        __syncthreads();
        { const int c4 = lane & 7, rs = lane >> 3, col = nc * 32 + 4 * c4;
          const f32x4 gv = *(const f32x4*)(g1 + col), bv = *(const f32x4*)(b1 + col);
#pragma unroll 4
          for (int it = 0; it < 16; ++it) { const int rl = 128 * w + 8 * it + rs; const size_t row = (size_t)tb * 1024 + rl;
              const f32x4 yv = *(const f32x4*)(Y1 + row * D + col); const f32x2 sv = *(const f32x2*)(ST1 + 2 * row);
              f32x4 tv; { const int nt = c4 >> 2, r0 = (4 * c4) & 15;
#pragma unroll
                  for (int j = 0; j < 4; ++j) { const v2u cell = *(const LAS v2u*)(out + rl * 32 + 2 * (r0 + j)); const int lo = (int)cell.x, hi = (int)cell.y + (lo < 0 ? 1 : 0); tv[j] = (float)(nt ? hi : lo) * (1.0f / 4194304.0f); } }
              const f32x4 y = ((yv - sv.x) * sv.y * gv + bv) * ALPHA + tv;
              *(f32x4*)(Y2 + row * D + col) = y;
              float sm = (y[0] + y[1]) + (y[2] + y[3]), sq = (y[0] * y[0] + y[1] * y[1]) + (y[2] * y[2] + y[3] * y[3]);
#pragma unroll
              for (int o = 1; o < 8; o <<= 1) { sm += shfl_x(sm, o, lane); sq += shfl_x(sq, o, lane); }
              if (c4 == 0) *(f32x2*)(PST2 + (row * 64 + nc) * 2) = (f32x2){sm, sq}; } }
    }
}

__device__ __forceinline__ void phase_moe4n(const Frame& F, const float* Y2, const float* pst, const float* gain, const float* bias, float* ST2, bf16* XBo, float* OUT, int last) {
    const int gw = F.bid * 8 + F.wave, NGW = F.G * 8, lane = F.lane;
    for (int t = gw; t < T; t += NGW) {
        f32x4 v[8];
#pragma unroll
        for (int j = 0; j < 8; ++j) v[j] = *(const f32x4*)(Y2 + (size_t)t * D + 4 * lane + 256 * j);
        const f32x2 pv = *(const f32x2*)(pst + ((size_t)t * 64 + lane) * 2);
        const float mean = wave_sum(pv.x, lane) * (1.0f / D); const float var = fmaxf(wave_sum(pv.y, lane) * (1.0f / D) - mean * mean, 0.f); const float rstd = 1.0f / sqrtf(var + LN_EPS);
        if (lane == 0) *(f32x2*)(ST2 + 2 * (size_t)t) = (f32x2){mean, rstd};
#pragma unroll
        for (int j = 0; j < 8; ++j) { const int c = 4 * lane + 256 * j; const f32x4 o = (v[j] - mean) * rstd * *(const f32x4*)(gain + c) + *(const f32x4*)(bias + c);
            if (last) *(f32x4*)(OUT + (size_t)t * D + c) = o;
            else { v2u wb; wb.x = pk2(o[0], o[1]); wb.y = pk2(o[2], o[3]); *(v2u*)(XBo + (size_t)t * D + c) = wb; } }
    }
}


__device__ __forceinline__ void phase_moe4q(const Frame& F, const bf16* X1, bf16* Y2, const unsigned char* Yq, const float* Ysc, const int* eidx, const int* inv, const float* gain, const float* bias, float* ST2, bf16* XBo, float* OUT, int last) {
    const LAS int* tpref = (const LAS int*)(F.lds + LDS_TAB);
    const int gw = F.bid * 8 + F.wave, NGW = F.G * 8, lane = F.lane;
    int en = 0, pn = 0; if (lane < 8 && gw < T) { en = eidx[gw * 8 + lane]; pn = inv[gw * 8 + lane]; }
    for (int t = gw; t < T; t += NGW) {
        int rowi = 0; if (lane < 8) rowi = tpref[en] * 256 + pn; else if (lane < 10) rowi = tpref[56 + lane] * 256 + t;
        if (lane < 8 && t + NGW < T) { en = eidx[(t + NGW) * 8 + lane]; pn = inv[(t + NGW) * 8 + lane]; }
        v4u pv[2][2], yv[10][2]; float sc[10][2];
#pragma unroll
        for (int j = 0; j < 2; ++j) { pv[j][0] = __builtin_nontemporal_load((const v4u*)(X1 + (size_t)t * D + 16 * lane + 1024 * j)); pv[j][1] = __builtin_nontemporal_load((const v4u*)(X1 + (size_t)t * D + 16 * lane + 1024 * j + 8)); }
#pragma unroll
        for (int k = 0; k < 10; ++k) { const size_t row = (size_t)__builtin_amdgcn_readlane(rowi, k);
#pragma unroll
            for (int j = 0; j < 2; ++j) { yv[k][j] = __builtin_nontemporal_load((const v4u*)(Yq + row * D + 16 * lane + 1024 * j)); sc[k][j] = __builtin_nontemporal_load(Ysc + row * 16 + 8 * j + (lane >> 3)); } }
#pragma unroll
        for (int k = 0; k < 10; ++k) asm volatile("" : "+v"(yv[k][0]), "+v"(yv[k][1]), "+v"(sc[k][0]), "+v"(sc[k][1]));
        float v[2][16];
#pragma unroll
        for (int j = 0; j < 2; ++j) { float f0[8], f1[8]; unpack8(pv[j][0], f0); unpack8(pv[j][1], f1);
            const float ss = (((sc[0][j] + sc[1][j]) + (sc[2][j] + sc[3][j])) + ((sc[4][j] + sc[5][j]) + (sc[6][j] + sc[7][j]))) + (sc[8][j] + sc[9][j]);
#pragma unroll
            for (int i = 0; i < 8; ++i) { v[j][i] = ALPHA * f0[i] - 128.f * ss; v[j][8 + i] = ALPHA * f1[i] - 128.f * ss; } }
#pragma unroll
        for (int k = 0; k < 10; ++k)
#pragma unroll
            for (int j = 0; j < 2; ++j) { const float s_ = sc[k][j]; const unsigned q[4] = {yv[k][j].x, yv[k][j].y, yv[k][j].z, yv[k][j].w};
#pragma unroll
                for (int d = 0; d < 4; ++d) { v[j][4 * d + 0] += s_ * (float)(q[d] & 0xffu); v[j][4 * d + 1] += s_ * (float)((q[d] >> 8) & 0xffu); v[j][4 * d + 2] += s_ * (float)((q[d] >> 16) & 0xffu); v[j][4 * d + 3] += s_ * (float)(q[d] >> 24); } }
        float sm = 0.f;
#pragma unroll
        for (int j = 0; j < 2; ++j)
#pragma unroll
            for (int i = 0; i < 16; i += 4) sm += (v[j][i] + v[j][i + 1]) + (v[j][i + 2] + v[j][i + 3]);
        const float mean = wave_sum(sm, lane) * (1.0f / D); float sq = 0.f;
#pragma unroll
        for (int j = 0; j < 2; ++j)
#pragma unroll
            for (int i = 0; i < 16; ++i) { const float d = v[j][i] - mean; sq += d * d; }
        const float rstd = 1.0f / sqrtf(wave_sum(sq, lane) * (1.0f / D) + LN_EPS);
        (void)ST2; (void)Y2;
#pragma unroll
        for (int j = 0; j < 2; ++j)
#pragma unroll
            for (int h = 0; h < 2; ++h) { const int c = 16 * lane + 1024 * j + 8 * h; const float* vv = &v[j][8 * h];
                const f32x4 g0 = *(const f32x4*)(gain + c), g1 = *(const f32x4*)(gain + c + 4), b0 = *(const f32x4*)(bias + c), b1 = *(const f32x4*)(bias + c + 4);
                const f32x4 o0 = ((f32x4){vv[0], vv[1], vv[2], vv[3]} - mean) * rstd * g0 + b0, o1 = ((f32x4){vv[4], vv[5], vv[6], vv[7]} - mean) * rstd * g1 + b1;
                if (last) { *(f32x4*)(OUT + (size_t)t * D + c) = o0; *(f32x4*)(OUT + (size_t)t * D + c + 4) = o1; }
                else { v4u wb; wb.x = pk2(o0[0], o0[1]); wb.y = pk2(o0[2], o0[3]); wb.z = pk2(o1[0], o1[1]); wb.w = pk2(o1[2], o1[3]); *(v4u*)(XBo + (size_t)t * D + c) = wb; } }
    }
}

__device__ __forceinline__ void phase_downproj3(const Frame& F, const bf16* H, const bf16* WD, const bf16* HSp, const bf16* WSD, unsigned char* Yq, float* Ysc, int NT) {
    const LAS int* tpref = (const LAS int*)(F.lds + LDS_TAB); const LAS int* cl = (const LAS int*)(F.lds + LDS_TAB + 512);
    LAS unsigned char* lds = F.lds;
    const int tid = F.tid, lane = F.lane, w = F.wave, fr = lane & 15, fq = lane >> 4;
    unsigned rbB[2], cbB[2];
#pragma unroll
    for (int i = 0; i < 2; ++i) { int R_, C_; g8::stage_rc(tid * 16 + i * 8192, R_, C_); rbB[i] = (unsigned)((R_ & ~31) + g8::perm32(R_ & 31)); cbB[i] = (unsigned)C_ * 2u; }
    const unsigned ldsw = (unsigned)w * 1024u, lbase = (unsigned)(size_t)lds;
    int boffg[4];
#pragma unroll
    for (int g = 0; g < 4; ++g) boffg[g] = g8::lds_byte(32 * g + fr, fq * 8);
    LAS unsigned char* stg = lds + 65536 + w * (32 * 144);
    const int NU = NT * 4;
    const int upos = (F.G % 8) == 0 ? (F.bid & 7) * (F.G >> 3) + (F.bid >> 3) : F.bid;
    int ub = 0;
    int u = (F.G <= NU) ? upos : F.bid; if (u >= NU) return;
#define DP3_UNITINFO(uu, E0, EXP, NV) do { const int tl_ = (uu) >> 2; int e_ = (E0); while (__builtin_amdgcn_readfirstlane(tpref[e_ + 1]) <= tl_) ++e_; EXP = e_; \
        NV = __builtin_amdgcn_readfirstlane(cl[e_]) - (tl_ - __builtin_amdgcn_readfirstlane(tpref[e_])) * 256; } while (0)
#define DP3_GLDS(gsrc, ldsdst) do { unsigned keep_; asm volatile("s_mov_b32 %0, m0\n\ts_mov_b32 m0, %2\n\ts_nop 0\n\tglobal_load_lds_dwordx4 %1, off\n\ts_mov_b32 m0, %0" : "=&s"(keep_) : "v"(gsrc), "s"(ldsdst) : "memory"); } while (0)
#define DP3_STAGE(slot, gb, bs) do { const unsigned v0_ = rbB[0] * (unsigned)(bs) + cbB[0], v1_ = rbB[1] * (unsigned)(bs) + cbB[1]; _Pragma("unroll") for (int kt = 0; kt < 2; ++kt) { \
        DP3_GLDS((const void*)((gb) + kt * 128 + v0_), lbase + (unsigned)((slot) * 32768 + kt * 16384) + ldsw); \
        DP3_GLDS((const void*)((gb) + kt * 128 + v1_), lbase + (unsigned)((slot) * 32768 + kt * 16384) + ldsw + 8192u); } } while (0)
#define DP3_SRC(uu, ee, AB, AS, BB, BS) do { const int tl_ = (uu) >> 2, cu_ = ((uu) & 3) * 512; \
        if ((ee) < 64) { AB = (const char*)(H + (size_t)tl_ * 256 * EDIM); AS = EDIM * 2; BB = (const char*)(WD + (size_t)(ee) * D * EDIM + (size_t)cu_ * EDIM); BS = EDIM * 2; } \
        else { const int t0_ = (tl_ - __builtin_amdgcn_readfirstlane(tpref[ee])) * 256; AB = (const char*)(HSp + (size_t)t0_ * SDIM + ((ee) - 64) * EDIM); AS = SDIM * 2; \
               BB = (const char*)(WSD + (size_t)cu_ * SDIM + ((ee) - 64) * EDIM); BS = SDIM * 2; } } while (0)
    int ecur, nvcur; DP3_UNITINFO(u, 0, ecur, nvcur);
    const char* abc; const char* gbc; int asc, bsc; DP3_SRC(u, ecur, abc, asc, gbc, bsc);
    bf16x8 A[2][4], An[2][4];
    { const char* ap_ = abc + (size_t)(32 * w + fr) * asc + 16 * fq;
#pragma unroll
      for (int m = 0; m < 2; ++m)
#pragma unroll
          for (int kk = 0; kk < 4; ++kk) A[m][kk] = *(const bf16x8*)(ap_ + (size_t)m * 16 * asc + 64 * kk); }
    DP3_STAGE(0, gbc, bsc);
    asm volatile("s_waitcnt vmcnt(0)" ::: "memory");
#pragma unroll 1
    for (;;) {
        int un = u; { const int nb = ub + F.G; if (nb + F.G <= NU) un = nb + upos; else if (nb + F.bid < NU) un = nb + F.bid; if (un != u) ub = nb; }
        int enx, nvnx; DP3_UNITINFO(un, (un > u ? ecur : 0), enx, nvnx);
        const char* abn; const char* gbn; int asn, bsn; DP3_SRC(un, enx, abn, asn, gbn, bsn);
        const int tile = u >> 2, colu = (u & 3) * 512;
        float scq[2][4];
#pragma unroll
        for (int c = 0; c < 4; ++c) {
            if (c == 0) asm volatile("s_waitcnt vmcnt(5)" ::: "memory"); else asm volatile("s_waitcnt vmcnt(4)" ::: "memory");
            __builtin_amdgcn_s_barrier();
            if (c == 3) { const char* ap_ = abn + (size_t)(32 * w + fr) * asn + 16 * fq;
#pragma unroll
                for (int m = 0; m < 2; ++m) { const char* am_ = ap_ + (size_t)m * 16 * asn;
                    asm volatile("global_load_dwordx4 %0, %1, off" : "=&v"(An[m][0]) : "v"(am_) : "memory"); asm volatile("global_load_dwordx4 %0, %1, off offset:64" : "=&v"(An[m][1]) : "v"(am_) : "memory");
                    asm volatile("global_load_dwordx4 %0, %1, off offset:128" : "=&v"(An[m][2]) : "v"(am_) : "memory"); asm volatile("global_load_dwordx4 %0, %1, off offset:192" : "=&v"(An[m][3]) : "v"(am_) : "memory"); } }
            { const char* gnext = (c < 3) ? gbc + (size_t)(c + 1) * 128 * bsc : gbn; const int bnext = (c < 3) ? bsc : bsn; DP3_STAGE((c + 1) & 1, gnext, bnext); }
            __builtin_amdgcn_sched_barrier(0);
            f32x4 acc[2][4][2];
#pragma unroll
            for (int g = 0; g < 4; ++g) { bf16x8 Bf[2][4];
#pragma unroll
                for (int n = 0; n < 2; ++n)
#pragma unroll
                    for (int kk = 0; kk < 4; ++kk) Bf[n][kk] = *(const LAS bf16x8*)(lds + (c & 1) * 32768 + (kk >> 1) * 16384 + boffg[g] + n * 2048 + (kk & 1) * 1024);
#pragma unroll
                for (int m = 0; m < 2; ++m)
#pragma unroll
                    for (int n = 0; n < 2; ++n) { acc[m][g][n] = (f32x4){0.f, 0.f, 0.f, 0.f};
#pragma unroll
                        for (int kk = 0; kk < 4; ++kk) acc[m][g][n] = __builtin_amdgcn_mfma_f32_16x16x32_bf16(Bf[n][kk], A[m][kk], acc[m][g][n], 0, 0, 0); } }
#pragma unroll
            for (int m = 0; m < 2; ++m) {
                float am0 = 0.f, am1 = 0.f;
#pragma unroll
                for (int g = 0; g < 4; ++g)
#pragma unroll
                    for (int n = 0; n < 2; ++n) { am0 = fmaxf(fmaxf(am0, fabsf(acc[m][g][n][0])), fabsf(acc[m][g][n][1])); am1 = fmaxf(fmaxf(am1, fabsf(acc[m][g][n][2])), fabsf(acc[m][g][n][3])); }
                float am = fmaxf(am0, am1);
                am = fmaxf(am, shfl_x(am, 16, lane)); am = fmaxf(am, shfl_x(am, 32, lane));
                am = fminf(am, 3.0e38f);
                const float isc = am > 0.f ? 127.0f * __builtin_amdgcn_rcpf(am) : 0.f;
                scq[m][c] = am * (1.0f / 127.0f);
                const f32x2_t isc2 = (f32x2_t){isc, isc}, mg2 = (f32x2_t){8388736.0f, 8388736.0f};
#pragma unroll
                for (int g = 0; g < 4; ++g) { unsigned qd[2];
#pragma unroll
                    for (int n = 0; n < 2; ++n) {
                        const f32x2_t tl = __builtin_elementwise_fma((f32x2_t){acc[m][g][n][0], acc[m][g][n][1]}, isc2, mg2), th = __builtin_elementwise_fma((f32x2_t){acc[m][g][n][2], acc[m][g][n][3]}, isc2, mg2);
                        const float f0_ = tl.x, f1_ = tl.y, f2_ = th.x, f3_ = th.y;
                        qd[n] = __builtin_amdgcn_perm(__builtin_bit_cast(unsigned, f1_), __builtin_bit_cast(unsigned, f0_), 0x0c0c0400u) | __builtin_amdgcn_perm(__builtin_bit_cast(unsigned, f3_), __builtin_bit_cast(unsigned, f2_), 0x04000c0cu); }
                    *(LAS v2u*)(stg + (16 * m + fr) * 144 + 32 * g + 8 * fq) = (v2u){qd[0], qd[1]}; } }
#pragma unroll
            for (int it = 0; it < 4; ++it) { const int rr = 8 * it + (lane >> 3);
                const v4u o = *(const LAS v4u*)(stg + rr * 144 + (lane & 7) * 16);
                __builtin_nontemporal_store(o, (v4u*)(Yq + (size_t)(tile * 256 + 32 * w + rr) * D + colu + 128 * c + 16 * (lane & 7))); }
            if (c == 3) { const f32x4 so = fq == 0 ? (f32x4){scq[0][0], scq[0][1], scq[0][2], scq[0][3]} : (f32x4){scq[1][0], scq[1][1], scq[1][2], scq[1][3]};
                if (fq < 2) __builtin_nontemporal_store(so, (f32x4*)(Ysc + (size_t)(tile * 256 + 32 * w + 16 * fq + fr) * 16 + (colu >> 7))); }
            __builtin_amdgcn_sched_barrier(0);
        }
        asm volatile("s_waitcnt vmcnt(9)" : "+v"(An[0][0]), "+v"(An[0][1]), "+v"(An[0][2]), "+v"(An[0][3]), "+v"(An[1][0]), "+v"(An[1][1]), "+v"(An[1][2]), "+v"(An[1][3]) :: "memory");
        if (un == u) break;
#pragma unroll
        for (int m = 0; m < 2; ++m)
#pragma unroll
            for (int kk = 0; kk < 4; ++kk) A[m][kk] = An[m][kk];
        u = un; ecur = enx; nvcur = nvnx; abc = abn; asc = asn; gbc = gbn; bsc = bsn;
    }
    asm volatile("s_waitcnt vmcnt(0)" ::: "memory");
#undef DP3_UNITINFO
#undef DP3_STAGE
#undef DP3_GLDS
#undef DP3_SRC
}

enum { PH_PRO = 0, PH_POOL_G1, PH_POOL_P, PH_POOL_G2, PH_POOL_G3, PH_DIL_G1, PH_DIL_ATT, PH_DIL_CMB, PH_DIL_G2, PH_CONV_G1, PH_CONV_E, PH_CONV_G2, PH_MOE1, PH_MOE2, PH_MOE3, PH_MOE4, PH_COUNT };

template <int PH>
__device__ __forceinline__ void run_phase(const Frame& Fin, const Args& args_, const int L) {
    Frame F = Fin; { int w_ = Fin.wave, l_; asm volatile("" : "+s"(w_)); asm volatile("v_mbcnt_lo_u32_b32 %0, -1, 0\n\tv_mbcnt_hi_u32_b32 %0, -1, %0" : "=v"(l_)); F.wave = w_; F.lane = l_; F.tid = w_ * 64 + l_; }
    unsigned char* ws; { GAS unsigned char* wsg = (GAS unsigned char*)Fin.ws; asm volatile("" : "+s"(wsg)); ws = (unsigned char*)wsg; } F.ws = ws; F.ctl = (unsigned*)(ws + WS_CTL);
    KP kp = (KP)__builtin_amdgcn_kernarg_segment_ptr(); asm volatile("" : "+s"(kp)); (void)args_;
    { unsigned l_ = (unsigned)(size_t)Fin.lds; asm volatile("" : "+s"(l_)); F.lds = (LAS unsigned char*)(size_t)l_; }
    LAS unsigned char* ring = F.lds; int c = (int)blockIdx.x; { int g_ = Fin.G; asm volatile("" : "+s"(c), "+s"(g_)); F.G = g_; F.bid = c; }
    const float* xres = ain(kp, IN_X);
    const float* st2 = (const float*)(ws + WS_ST2); float* pstp = (float*)(ws + WS_PST);
    const float* g2p = ain(kp, IN_LNG) + (size_t)((L > 0 ? L - 1 : 0) * 2 + 1) * D; const float* b2p = ain(kp, IN_LNB) + (size_t)((L > 0 ? L - 1 : 0) * 2 + 1) * D;
    const bf16* xb = (const bf16*)(ws + WS_XB);
    bf16* yf = (bf16*)(ws + WS_YF);
    unsigned char* big = ws + WS_BIG;
    const int ia = L / 3;
    if constexpr (PH == PH_PRO) { phase_prologue(F, kp); }
    if constexpr (PH == PH_POOL_G1) { g8::DenseSched S; S.init(xb, (const bf16*)(ws + WS_W_POOL_IN) + (size_t)ia * D * D, T, D, D, D, F.G, c);
        g8::EpiBf16 E{(bf16*)(big + BG_U), D, 0}; g8::gemm_phase<g8::EpiBf16, g8::DenseSched, false>(ring, F.tid, D, D, D, S, E); }
    if constexpr (PH == PH_POOL_P) { phase_pool(F, (const bf16*)(big + BG_U), (bf16*)(big + BG_PL)); }
    if constexpr (PH == PH_POOL_G2) { g8::DenseSched S; S.init((const bf16*)(big + BG_PL), (const bf16*)(ws + WS_W_POOL_G) + (size_t)ia * D * 512, T, D, D, 512, F.G, c); S.agrp_shift = 1; S.agrp_stride = 512 * 2;
        g8::EpiScaleBf16 E{(bf16*)(big + BG_MX), D, ain(kp, IN_PSC) + (size_t)ia * D}; g8::gemm_phase<g8::EpiScaleBf16, g8::DenseSched, false>(ring, F.tid, 512, D, 512, S, E); }
    if constexpr (PH == PH_POOL_G3) { g8::DenseSched S; S.init((const bf16*)(big + BG_MX), (const bf16*)(ws + WS_W_POOL_OUT) + (size_t)ia * D * D, T, D, D, D, F.G, c);
        g8::EpiResidLN E{xres, xb, st2, g2p, b2p, yf, pstp, 2}; g8::gemm_phase<g8::EpiResidLN, g8::DenseSched, false>(ring, F.tid, D, D, D, S, E); }
    if constexpr (PH == PH_DIL_G1) { g8::DenseSched S; S.init(xb, (const bf16*)(ws + WS_W_DIL_QKV), T, QKVC, D, D, F.G, c);
        g8::EpiBf16 E{(bf16*)(big + BG_QKV), QKVC, 1}; g8::gemm_phase<g8::EpiBf16, g8::DenseSched, false>(ring, F.tid, D, D, D, S, E); }
    if constexpr (PH == PH_DIL_ATT) { phase_attn(F, (const bf16*)(big + BG_QKV), ain(kp, IN_RELB), (bf16*)(big + BG_OG), (float*)(big + BG_LSE)); }
    if constexpr (PH == PH_DIL_CMB) { phase_combine(F, (const bf16*)(big + BG_OG), (const float*)(big + BG_LSE), (bf16*)(big + BG_O)); }
    if constexpr (PH == PH_DIL_G2) { g8::DenseSched S; S.init((const bf16*)(big + BG_O), (const bf16*)(ws + WS_W_DIL_OUT), T, D, DILW, DILW, F.G, c);
        g8::EpiResidLN E{xres, xb, st2, g2p, b2p, yf, pstp, 2}; g8::gemm_phase<g8::EpiResidLN, g8::DenseSched, false>(ring, F.tid, DILW, DILW, DILW, S, E); }
    if constexpr (PH == PH_CONV_G1) { g8::DenseSched S; S.init(xb, (const bf16*)(ws + WS_W_CONV_IN), T, 3 * D, D, D, F.G, c);
        g8::EpiConvIn E{(bf16*)(big + BG_UC), (bf16*)(big + BG_BG)}; g8::gemm_phase<g8::EpiConvIn, g8::DenseSched, false>(ring, F.tid, D, D, D, S, E); }
    if constexpr (PH == PH_CONV_E) { phase_conv(F, (const bf16*)(big + BG_UC), (const bf16*)(big + BG_BG), ain(kp, IN_CW), (bf16*)(big + BG_Z)); }
    if constexpr (PH == PH_CONV_G2) { g8::DenseSched S; S.init((const bf16*)(big + BG_Z), (const bf16*)(ws + WS_W_CONV_OUT), T, D, D, D, F.G, c);
        g8::EpiResidLN E{xres, xb, st2, g2p, b2p, yf, pstp, 2}; g8::gemm_phase<g8::EpiResidLN, g8::DenseSched, false>(ring, F.tid, D, D, D, S, E); }
    unsigned* cnt = F.ctl + CW_CNT + L * 64 * 16;
    float* x1f = (float*)(ws + WS_X1F); bf16* x1b = (bf16*)(ws + WS_X1B);
    int* ltok = (int*)(ws + WS_LTOK); float* lgate = (float*)(ws + WS_LGATE); int* eidx = (int*)(ws + WS_EIDX); int* inv = (int*)(ws + WS_INV);
    bf16* HB = (bf16*)(ws + WS_HB); bf16* HS = (bf16*)(ws + WS_HS); bf16* Yr = (bf16*)(ws + WS_BIG);
    if constexpr (PH == PH_MOE1) {
        const float* g1 = ain(kp, IN_LNG) + (size_t)(L * 2 + 0) * D; const float* b1 = ain(kp, IN_LNB) + (size_t)(L * 2 + 0) * D;
        phase_moe1n(F, yf, pstp, g1, b1, (const bf16*)(ws + WS_RWH) + (size_t)L * NEXP * D, (const bf16*)(ws + WS_RWL) + (size_t)L * NEXP * D, ain(kp, IN_RB) + (size_t)L * NEXP,
                    x1b, (float*)(ws + WS_ST1), cnt, ltok, lgate, eidx, inv); }
    if constexpr (PH == PH_MOE2) {
        const int NT = build_tiles(F, cnt);
        { g8::ExpertSched<1, true> S; S.tpref = (const LAS int*)(F.lds + LDS_TAB); S.cnt = (const LAS int*)(F.lds + LDS_TAB + 512); S.A = (const char*)x1b; S.B = (const char*)((const bf16*)(ws + WS_W_EX_GU) + (size_t)L * 64 * 256 * D);
          S.tok = ltok; S.b_exp = (size_t)256 * D * 2; S.b_tile = 0; S.a_tile = 0; S.NU = NT; S.G = F.G; S.c = c;
          g8::EpiExpertGU E{HB}; g8::gemm_phase<g8::EpiExpertGU, g8::ExpertSched<1, true>, true>(ring, F.tid, D, D, D, S, E); }
        { const int rot = (c - (NT % F.G) + F.G) % F.G;
          g8::DenseSched S; S.init(x1b, (const bf16*)(ws + WS_W_SH_GU) + (size_t)L * 512 * D, T, 512, D, D, F.G, rot);
          int t2 = F.tid; asm volatile("" : "+v"(t2));
          g8::EpiSharedGU E{HS}; g8::gemm_phase<g8::EpiSharedGU, g8::DenseSched, false>(ring, t2, D, D, D, S, E); } }
    if constexpr (PH == PH_MOE3) {
        const float* g1 = ain(kp, IN_LNG) + (size_t)(L * 2 + 0) * D; const float* b1 = ain(kp, IN_LNB) + (size_t)(L * 2 + 0) * D;
        const int NT = build_tiles(F, cnt);
        __syncthreads();
        phase_downproj3(F, HB, (const bf16*)(ws + WS_W_EX_D) + (size_t)L * 64 * D * EDIM, HS, (const bf16*)(ws + WS_W_SH_D) + (size_t)L * D * SDIM, (unsigned char*)Yr, (float*)(ws + WS_BIG + BG_YSC), NT + 2 * (T / 256));
        (void)g1; (void)b1; }
    if constexpr (PH == PH_MOE4) { (void)build_tiles(F, cnt);
        const float* g2 = ain(kp, IN_LNG) + (size_t)(L * 2 + 1) * D; const float* b2 = ain(kp, IN_LNB) + (size_t)(L * 2 + 1) * D;
        phase_moe4q(F, x1b, (bf16*)(ws + WS_Y2F), (const unsigned char*)Yr, (const float*)(ws + WS_BIG + BG_YSC), eidx, inv, g2, b2, (float*)(ws + WS_ST2), (bf16*)(ws + WS_XB), aout(kp), L == DEPTH - 1); }
}
__device__ __forceinline__ void make_frame(Frame& F, const Args& args) {
    extern __shared__ __attribute__((aligned(16))) unsigned char lds_raw[];
    F.lds = (LAS unsigned char*)lds_raw; F.ws = args.ws; F.ctl = (unsigned*)(args.ws + WS_CTL);
    F.tid = threadIdx.x; F.lane = F.tid & 63; F.wave = __builtin_amdgcn_readfirstlane(F.tid >> 6); F.G = gridDim.x; F.bid = blockIdx.x;
}
template <int PH> __global__ void __launch_bounds__(512, 2) k_phase(Args args, int L) {
    Frame F; make_frame(F, args);
    run_phase<PH>(F, args, L);
}

#ifndef MK_NOINLINE
#define MK_NOINLINE 0
#endif
#if MK_NOINLINE
template <int PH> __device__ __noinline__ void call_phase_ni(const int L) {
    Args dummy{}; Frame F;
    KP kp = (KP)__builtin_amdgcn_kernarg_segment_ptr();
    extern __shared__ __attribute__((aligned(16))) unsigned char lds_raw[];
    F.lds = (LAS unsigned char*)lds_raw; F.ws = (unsigned char*)((GAS unsigned char* const CAS*)kp)[20]; F.ctl = (unsigned*)(F.ws + WS_CTL);
    F.tid = threadIdx.x; F.lane = F.tid & 63; F.wave = __builtin_amdgcn_readfirstlane(F.tid >> 6); F.G = gridDim.x; F.bid = blockIdx.x;
    run_phase<PH>(F, dummy, L);
}
template <int PH> __device__ __forceinline__ void call_phase(const Frame& F, const Args& args, const int L) { call_phase_ni<PH>(L); }
#else
template <int PH> __device__ __forceinline__ void call_phase(const Frame& F, const Args& args, const int L) { asm volatile("; PHASE_BEGIN %0" :: "n"(PH)); run_phase<PH>(F, args, L); asm volatile("; PHASE_END %0" :: "n"(PH)); }
#endif
__global__ void __launch_bounds__(512, 2) fwd_all(Args args) {
    Frame F; make_frame(F, args);
    volatile LAS unsigned* misc = (volatile LAS unsigned*)(F.lds + LDS_MISC);
    if (F.tid < 4) misc[F.tid] = 0u;
    __syncthreads();
    const int lo = args.ph_lo, hi = args.ph_hi;
    XcdBarrier bar; bar.bar = F.ctl + CW_BAR; bar.x = 0; bar.st = misc;
    if (hi - lo > 1) bar = xcd_barrier_post(F.ctl + CW_BAR, misc);
    int pc = 0;
#ifndef MK_DUP_MASK
#define MK_DUP_MASK 0
#endif
#if MK_DUP_MASK
#define STEP(PH, Lx) do { if (pc >= lo && pc < hi) { int nrep_ = ((MK_DUP_MASK >> (PH)) & 1) ? 2 : 1; asm volatile("" : "+s"(nrep_)); _Pragma("unroll 1") for (int r_ = 0; r_ < nrep_; ++r_) { call_phase<PH>(F, args, Lx); if (r_ + 1 < nrep_ || pc + 1 < hi) xcd_barrier(bar); } } ++pc; } while (0)
#else
#define STEP(PH, Lx) do { if (pc >= lo && pc < hi) { call_phase<PH>(F, args, Lx); if (pc + 1 < hi) xcd_barrier(bar); } ++pc; } while (0)
#endif
    STEP(PH_PRO, 0);
#pragma unroll 1
    for (int L = 0; L < DEPTH; ++L) {
        const int kind = L % 3;
        if (kind == 0) { STEP(PH_POOL_G1, L); STEP(PH_POOL_P, L); STEP(PH_POOL_G2, L); STEP(PH_POOL_G3, L); }
        else if (kind == 1) { STEP(PH_DIL_G1, L); STEP(PH_DIL_ATT, L); STEP(PH_DIL_CMB, L); STEP(PH_DIL_G2, L); }
        else { STEP(PH_CONV_G1, L); STEP(PH_CONV_E, L); STEP(PH_CONV_G2, L); }
        STEP(PH_MOE1, L); STEP(PH_MOE2, L); STEP(PH_MOE3, L); STEP(PH_MOE4, L);
    }
#undef STEP
}
constexpr int N_STEPS = 1 + 2 * 8 + 8 + 7;

template <int PH> static void launch_phase(const Args& a, int L, int grid, hipStream_t stream) {
    static bool attr = false;
    if (!attr) { (void)hipFuncSetAttribute((const void*)k_phase<PH>, hipFuncAttributeMaxDynamicSharedMemorySize, LDS_BYTES); attr = true; }
    hipLaunchKernelGGL(k_phase<PH>, dim3(grid), dim3(512), LDS_BYTES, stream, a, L);
}
extern "C" void kernel_launch(void* const* d_in, const int* in_sizes, int n_in, void* d_out, int out_size, void* d_ws, size_t ws_size, hipStream_t stream) {
    static int grid = 0;
    if (grid == 0) {
        if (n_in != 19 || out_size != T * D || ws_size < WS_END) { fprintf(stderr, "kernel_launch: unexpected shapes (n_in %d out %d ws %zu need %zu)\n", n_in, out_size, ws_size, (size_t)WS_END); grid = -1; return; }
        int dev = 0, cus = 0;
        if (hipGetDevice(&dev) != hipSuccess || hipDeviceGetAttribute(&cus, hipDeviceAttributeMultiprocessorCount, dev) != hipSuccess) { grid = -1; return; }
#if MK_ONE_LAUNCH
        if (hipFuncSetAttribute((const void*)fwd_all, hipFuncAttributeMaxDynamicSharedMemorySize, LDS_BYTES) != hipSuccess) { fprintf(stderr, "kernel_launch: hipFuncSetAttribute failed\n"); grid = -1; return; }
        int per_cu = 0;
        if (hipOccupancyMaxActiveBlocksPerMultiprocessor(&per_cu, (const void*)fwd_all, 512, LDS_BYTES) != hipSuccess || per_cu < 1) { fprintf(stderr, "kernel_launch: note: occupancy query reports %d blocks per CU\n", per_cu); (void)hipGetLastError(); }
#endif
        grid = cus;
    }
    if (grid < 0) return;
    (void)hipMemsetAsync((char*)d_ws + WS_CTL, 0, CTL_ZERO_BYTES, stream);
    Args a{};
    for (int i = 0; i < 19; ++i) a.in[i] = (const float*)d_in[i];
    a.out = (float*)d_out; a.ws = (unsigned char*)d_ws; a.ph_lo = 0; a.ph_hi = 0;
#if MK_ONE_LAUNCH
#ifdef MK_SPLIT
    for (int p = 0; p < N_STEPS; ++p) { a.ph_lo = p; a.ph_hi = p + 1; hipLaunchKernelGGL(fwd_all, dim3(grid), dim3(512), LDS_BYTES, stream, a); }
#else
    a.ph_lo = 0; a.ph_hi = N_STEPS;
    hipLaunchKernelGGL(fwd_all, dim3(grid), dim3(512), LDS_BYTES, stream, a);
#endif
#elif defined(MK_HYBRID_MASK)
    {
        static bool attr2 = false; if (!attr2) { (void)hipFuncSetAttribute((const void*)fwd_all, hipFuncAttributeMaxDynamicSharedMemorySize, LDS_BYTES); attr2 = true; }
        int pc = 0;
#define HSTEP(PH, Lx) do { if ((MK_HYBRID_MASK >> (PH)) & 1) { a.ph_lo = pc; a.ph_hi = pc + 1; hipLaunchKernelGGL(fwd_all, dim3(grid), dim3(512), LDS_BYTES, stream, a); } else { a.ph_lo = 0; a.ph_hi = 0; launch_phase<PH>(a, Lx, grid, stream); } ++pc; } while (0)
        HSTEP(PH_PRO, 0);
        for (int L = 0; L < DEPTH; ++L) {
            const int kind = L % 3;
            if (kind == 0) { HSTEP(PH_POOL_G1, L); HSTEP(PH_POOL_P, L); HSTEP(PH_POOL_G2, L); HSTEP(PH_POOL_G3, L); }
            else if (kind == 1) { HSTEP(PH_DIL_G1, L); HSTEP(PH_DIL_ATT, L); HSTEP(PH_DIL_CMB, L); HSTEP(PH_DIL_G2, L); }
            else { HSTEP(PH_CONV_G1, L); HSTEP(PH_CONV_E, L); HSTEP(PH_CONV_G2, L); }
            HSTEP(PH_MOE1, L); HSTEP(PH_MOE2, L); HSTEP(PH_MOE3, L); HSTEP(PH_MOE4, L);
        }
#undef HSTEP
    }
#else
    launch_phase<PH_PRO>(a, 0, grid, stream);
    for (int L = 0; L < DEPTH; ++L) {
        const int kind = L % 3;
        if (kind == 0) { launch_phase<PH_POOL_G1>(a, L, grid, stream); launch_phase<PH_POOL_P>(a, L, grid, stream); launch_phase<PH_POOL_G2>(a, L, grid, stream); launch_phase<PH_POOL_G3>(a, L, grid, stream); }
        else if (kind == 1) { launch_phase<PH_DIL_G1>(a, L, grid, stream); launch_phase<PH_DIL_ATT>(a, L, grid, stream); launch_phase<PH_DIL_CMB>(a, L, grid, stream); launch_phase<PH_DIL_G2>(a, L, grid, stream); }
        else { launch_phase<PH_CONV_G1>(a, L, grid, stream); launch_phase<PH_CONV_E>(a, L, grid, stream); launch_phase<PH_CONV_G2>(a, L, grid, stream); }
        launch_phase<PH_MOE1>(a, L, grid, stream); launch_phase<PH_MOE2>(a, L, grid, stream); launch_phase<PH_MOE3>(a, L, grid, stream); launch_phase<PH_MOE4>(a, L, grid, stream);
    }
#endif
}
```

```cpp
#include <hip/hip_runtime.h>
#include <cstdio>
#include <cstdint>

#ifndef MK_ONE_LAUNCH
#define MK_ONE_LAUNCH 1
#endif

#define GAS __attribute__((address_space(1)))
#define LAS __attribute__((address_space(3)))
typedef unsigned short bf16;
typedef unsigned v4u __attribute__((ext_vector_type(4)));
typedef unsigned v2u __attribute__((ext_vector_type(2)));
typedef float f32x4 __attribute__((ext_vector_type(4)));
typedef float f32x2 __attribute__((ext_vector_type(2)));
typedef short bf16x8 __attribute__((ext_vector_type(8)));
typedef short s16x4 __attribute__((ext_vector_type(4)));

constexpr int NBATCH = 8, SEQ = 2048, D = 2048, T = NBATCH * SEQ, DEPTH = 4;
constexpr int NEXP = 64, TOPK = 8, EDIM = 128, SDIM = 256;
constexpr int QKVC = 4608, DILW = 512;
constexpr float ALPHA = 1.681792830507429f;
constexpr float LN_EPS = 1e-5f;
constexpr int CAP = 16384;
constexpr int HROWS = T * TOPK + NEXP * 256;

constexpr size_t MiB = 1u << 20;
constexpr size_t WS_CTL = 0, CTL_ZERO_BYTES = 1 * MiB;
constexpr size_t WS_W_POOL_IN = 1 * MiB;
constexpr size_t WS_W_POOL_G = WS_W_POOL_IN + 16 * MiB;
constexpr size_t WS_W_POOL_OUT = WS_W_POOL_G + 4 * MiB;
constexpr size_t WS_W_DIL_QKV = WS_W_POOL_OUT + 16 * MiB;
constexpr size_t WS_W_DIL_OUT = WS_W_DIL_QKV + 18 * MiB;
constexpr size_t WS_W_CONV_IN = WS_W_DIL_OUT + 2 * MiB;
constexpr size_t WS_W_CONV_OUT = WS_W_CONV_IN + 24 * MiB;
constexpr size_t WS_W_SH_GU = WS_W_CONV_OUT + 8 * MiB;
constexpr size_t WS_W_SH_D = WS_W_SH_GU + 8 * MiB;
constexpr size_t WS_W_EX_GU = WS_W_SH_D + 4 * MiB;
constexpr size_t WS_W_EX_D = WS_W_EX_GU + 256 * MiB;
constexpr size_t WS_XF = WS_W_EX_D + 256 * MiB;
constexpr size_t WS_YF = WS_XF + 128 * MiB;
constexpr size_t WS_X1F = WS_YF + 128 * MiB;
constexpr size_t WS_XB = WS_X1F + 128 * MiB;
constexpr size_t WS_X1B = WS_XB + 64 * MiB;
constexpr size_t WS_HB = WS_X1B + 64 * MiB;
constexpr size_t WS_HS = WS_HB + 72 * MiB;
constexpr size_t WS_LTOK = WS_HS + 8 * MiB;
constexpr size_t WS_LGATE = WS_LTOK + 4 * MiB;
constexpr size_t WS_EIDX = WS_LGATE + 4 * MiB;
constexpr size_t WS_INV = WS_EIDX + 1 * MiB;
constexpr size_t WS_BIG = WS_INV + 1 * MiB;
constexpr size_t WS_PST = WS_BIG + 608 * MiB;
constexpr size_t WS_ST1 = WS_PST + 4 * MiB;
constexpr size_t WS_ST2 = WS_ST1 + 1 * MiB;
constexpr size_t WS_RWH = WS_ST2 + 1 * MiB;
constexpr size_t WS_RWL = WS_RWH + 1 * MiB;
constexpr size_t WS_PST2 = WS_RWL + 1 * MiB;
constexpr size_t WS_END = WS_PST2 + 8 * MiB;
constexpr size_t WS_Y2F = WS_X1F;
constexpr size_t BG_U = 0, BG_PL = 64 * MiB, BG_MX = 128 * MiB;
constexpr size_t BG_QKV = 0, BG_OG = 144 * MiB, BG_LSE = 192 * MiB, BG_O = 194 * MiB;
constexpr size_t BG_UC = 0, BG_BG = 64 * MiB, BG_Z = 128 * MiB;
constexpr size_t BG_YSC = 400 * MiB;
constexpr int CW_BAR = 4096;
constexpr int CW_CNT = 16384;

constexpr int RING_BYTES = 131072;
constexpr int LDS_TAB = RING_BYTES;
constexpr int LDS_STASH = RING_BYTES + 1024;
constexpr int LDS_BYTES = 163840;
constexpr int LDS_MISC = LDS_BYTES - 1024;

typedef __bf16 bf16x2_t __attribute__((ext_vector_type(2)));
typedef float f32x2_t __attribute__((ext_vector_type(2)));
__device__ __forceinline__ unsigned cvt_pk_bf16(float lo, float hi) { const bf16x2_t r = __builtin_convertvector((f32x2_t){lo, hi}, bf16x2_t); return __builtin_bit_cast(unsigned, r); }
__device__ __forceinline__ unsigned f2bf(float f) { unsigned u = __builtin_bit_cast(unsigned, f); return (u + 0x7fffu + ((u >> 16) & 1u)) >> 16; }
__device__ __forceinline__ unsigned pk2(float lo, float hi) { return f2bf(lo) | (f2bf(hi) << 16); }
__device__ __forceinline__ float bflo(unsigned w) { return __builtin_bit_cast(float, w << 16); }
__device__ __forceinline__ float bfhi(unsigned w) { return __builtin_bit_cast(float, w & 0xffff0000u); }
__device__ __forceinline__ float shfl_from(float v, int src) { return __builtin_bit_cast(float, __builtin_amdgcn_ds_bpermute(src << 2, __builtin_bit_cast(int, v))); }
__device__ __forceinline__ float shfl_x(float v, int o, int lane) { return shfl_from(v, lane ^ o); }
__device__ __forceinline__ float wave_sum(float v, int lane) {
    (void)lane;
    v += __builtin_bit_cast(float, __builtin_amdgcn_update_dpp(0, __builtin_bit_cast(int, v), 0xB1, 0xF, 0xF, false));
    v += __builtin_bit_cast(float, __builtin_amdgcn_update_dpp(0, __builtin_bit_cast(int, v), 0x4E, 0xF, 0xF, false));
    v += __builtin_bit_cast(float, __builtin_amdgcn_update_dpp(0, __builtin_bit_cast(int, v), 0x141, 0xF, 0xF, false));
    v += __builtin_bit_cast(float, __builtin_amdgcn_update_dpp(0, __builtin_bit_cast(int, v), 0x140, 0xF, 0xF, false));
    const float r0 = __builtin_bit_cast(float, __builtin_amdgcn_readlane(__builtin_bit_cast(int, v), 0)), r1 = __builtin_bit_cast(float, __builtin_amdgcn_readlane(__builtin_bit_cast(int, v), 16));
    const float r2 = __builtin_bit_cast(float, __builtin_amdgcn_readlane(__builtin_bit_cast(int, v), 32)), r3 = __builtin_bit_cast(float, __builtin_amdgcn_readlane(__builtin_bit_cast(int, v), 48));
    return (r0 + r1) + (r2 + r3);
}
#define LDS_WAIT() asm volatile("s_waitcnt lgkmcnt(0)" ::: "memory")
#define VM_WAIT() asm volatile("s_waitcnt vmcnt(0)" ::: "memory")

#define XB_TMO      128
#define XB_XCNT(j)  (256  + 64 * (j))
#define XB_XSUB(j)  (1280 + 64 * (j))
#define XB_XGEN(j)  (2304 + 64 * (j))
#define XB_TOP      3328
#define XB_TOPGEN   3392
#define XCD_BAR_WORDS 3456
#define XB_SPIN_CAP (1u << 18)

__device__ __forceinline__ unsigned xb_ld(unsigned* p)              { return __hip_atomic_load(p, __ATOMIC_RELAXED, __HIP_MEMORY_SCOPE_AGENT); }
__device__ __forceinline__ unsigned xb_add(unsigned* p, unsigned v) { return __hip_atomic_fetch_add(p, v, __ATOMIC_RELAXED, __HIP_MEMORY_SCOPE_AGENT); }
__device__ __forceinline__ unsigned xb_xcc_id() { return (unsigned)__builtin_amdgcn_s_getreg((3 << 11) | 20) & 0xFu; }
#define XB_SPIN(cond, bar) do { unsigned _sp = 0; while (cond) { __builtin_amdgcn_s_sleep(1); \
    if ((++_sp & 255u) == 0u) { if (xb_ld(&(bar)[XB_TMO])) break; if (_sp > XB_SPIN_CAP) { atomicAdd(&(bar)[XB_TMO], 1u); break; } } } } while (0)

struct XcdBarrier {
    unsigned* bar; unsigned x;
    volatile LAS unsigned* st;
};

__device__ __forceinline__ XcdBarrier xcd_barrier_post(unsigned* bar, volatile LAS unsigned* st) {
    XcdBarrier b; b.bar = bar; b.x = xb_xcc_id(); b.st = st;
    if (threadIdx.x == 0) (void)xb_add(&bar[XB_XCNT(b.x)], 1u);
    return b;
}
__device__ __forceinline__ void xcd_barrier_complete(unsigned* bar, unsigned x, unsigned& nloc, unsigned& nx) {
    const unsigned G = gridDim.x * gridDim.y * gridDim.z;
    unsigned sum, cnt, mine, sp = 0u;
    for (;;) {
        sum = 0u; cnt = 0u; mine = 0u;
#pragma unroll
        for (unsigned j = 0; j < 16; ++j) { const unsigned c = xb_ld(&bar[XB_XCNT(j)]); sum += c; cnt += (c > 0u) ? 1u : 0u; mine = (j == x) ? c : mine; }
        if (sum == G) break;
        __builtin_amdgcn_s_sleep(1);
        if ((++sp & 255u) == 0u) { if (xb_ld(&bar[XB_TMO])) break; if (sp > XB_SPIN_CAP) { atomicAdd(&bar[XB_TMO], 1u); break; } }
    }
    nloc = mine > 0u ? mine : 1u; nx = cnt > 0u ? cnt : 1u;
}

__device__ __forceinline__ void xcd_barrier(const XcdBarrier& b) {
    asm volatile("s_waitcnt vmcnt(0)" ::: "memory");
    __syncthreads();
    if (threadIdx.x == 0) {
        unsigned* bar; unsigned bx = b.x; { GAS unsigned* bg = (GAS unsigned*)b.bar; asm volatile("" : "+s"(bg), "+s"(bx)); bar = (unsigned*)bg; }
        __builtin_amdgcn_s_waitcnt(0);
        unsigned nloc = b.st[0], nx = b.st[1];
        if (nloc == 0u) { xcd_barrier_complete(bar, bx, nloc, nx); b.st[0] = nloc; b.st[1] = nx; }
        const unsigned old = xb_add(&bar[XB_XSUB(bx)], 1u);
        const unsigned gen = old / nloc;
        if (old + 1u == (gen + 1u) * nloc) {
            __builtin_amdgcn_fence(__ATOMIC_RELEASE, "agent");
            asm volatile("s_waitcnt vmcnt(0)" ::: "memory");
            const unsigned og = xb_add(&bar[XB_TOP], 1u);
            const unsigned tg = og / nx;
            if (og + 1u == (tg + 1u) * nx) xb_add(&bar[XB_TOPGEN], 1u);
            else XB_SPIN(xb_ld(&bar[XB_TOPGEN]) == tg, bar);
            __builtin_amdgcn_fence(__ATOMIC_ACQUIRE, "agent");
            xb_add(&bar[XB_XGEN(bx)], 1u);
            asm volatile("s_waitcnt vmcnt(0)" ::: "memory");
        } else {
            XB_SPIN(xb_ld(&bar[XB_XGEN(bx)]) == gen, bar);
            __builtin_amdgcn_fence(__ATOMIC_ACQUIRE, "agent");
            asm volatile("s_waitcnt vmcnt(0)" ::: "memory");
        }
    }
    __syncthreads();
}

namespace g8 {
constexpr int BM = 256, BK = 64, HALF = 128, HTB = HALF * BK * 2, STAGE_BYTES = 8 * HTB, NXCD = 8, WGM = 8;
__host__ __device__ __forceinline__ int lds_byte(int r, int c) { const int st = (r >> 4) * 2 + (c >> 5), rr = r & 15, cc = c & 31, ob = rr * 64 + cc * 2; return st * 1024 + (ob ^ (((ob >> 9) & 1) << 5)); }
__host__ __device__ __forceinline__ void stage_rc(int b, int& R, int& C) { const int st = b / 1024, sb = b % 1024, swz = sb ^ (((sb >> 9) & 1) << 5); R = (st >> 1) * 16 + swz / 64; C = (st & 1) * 32 + (swz % 64) / 2; }
__host__ __device__ __forceinline__ int perm32(int rho) { const int n = rho >> 4, i = rho & 15; return 8 * (i >> 2) + 4 * n + (i & 3); }

struct Unit { const char* A; const char* B; const int* rows; int pm, pn, nvalid, aux; };

template <class Epi, class Sched, bool GATHER>
__device__ __forceinline__ void gemm_phase(LAS unsigned char* lds, const int tid_in, const int K, const int lda, const int ldb, const Sched& S, const Epi& E) {
    const int tid = tid_in, wid = __builtin_amdgcn_readfirstlane(tid >> 6), lane = tid & 63, wr = wid >> 2, wc = wid & 3, fr = lane & 15, fq = lane >> 4;
    const int nt = K / BK;
    unsigned voffB[2];
#pragma unroll
    for (int i = 0; i < 2; ++i) { int R_, C_; stage_rc(tid * 16 + i * 8192, R_, C_); const int Rb = Epi::PERM ? ((R_ & ~31) + perm32(R_ & 31)) : R_; voffB[i] = (unsigned)(Rb * ldb + C_) * 2u; }
    LAS v4u* stash = (LAS v4u*)(lds + (LDS_STASH - 0) + tid * 16);
    const size_t kstep = (size_t)(BK * 2);
    const size_t hstepB = (size_t)HALF * ldb * 2;
    const unsigned ldsw = (unsigned)wid * 1024u;
    const int aoff = lds_byte(wr * 64 + fr, fq * 8), boff = lds_byte(wc * 32 + fr, fq * 8);
#define G8_SA(b, h) (((b) * 2 + (h)) * HTB)
#define G8_SB(b, h) ((4 + (b) * 2 + (h)) * HTB)
#define G8_STAGE2(bufoff, gbase, v0, v1) do { \
        __builtin_amdgcn_global_load_lds((const unsigned*)((const char*)(gbase) + (v0)), (LAS unsigned*)(lds + (bufoff) + ldsw), 16, 0, 0); \
        __builtin_amdgcn_global_load_lds((const unsigned*)((const char*)(gbase) + (v1)), (LAS unsigned*)(lds + (bufoff) + ldsw + 8192), 16, 0, 0); } while (0)
#define G8_STAGEB(bufoff, gbase) G8_STAGE2(bufoff, gbase, voffB[0], voffB[1])
#define G8_LDA(dst, b, h) do { _Pragma("unroll") for (int m = 0; m < 4; ++m) _Pragma("unroll") for (int k = 0; k < 2; ++k) dst[m][k] = *(const LAS bf16x8*)(lds + G8_SA(b, h) + aoff + m * 2048 + k * 1024); } while (0)
#define G8_LDB(dst, b, h) do { _Pragma("unroll") for (int n = 0; n < 2; ++n) _Pragma("unroll") for (int k = 0; k < 2; ++k) dst[n][k] = *(const LAS bf16x8*)(lds + G8_SB(b, h) + boff + n * 2048 + k * 1024); } while (0)
#define G8_MMA(ai, bj, At, Bt) do { __builtin_amdgcn_s_setprio(1); _Pragma("unroll") for (int m = 0; m < 4; ++m) _Pragma("unroll") for (int n = 0; n < 2; ++n) _Pragma("unroll") for (int k = 0; k < 2; ++k) \
        acc[ai][bj][m][n] = __builtin_amdgcn_mfma_f32_16x16x32_bf16(Bt[n][k], At[m][k], acc[ai][bj][m][n], 0, 0, 0); __builtin_amdgcn_s_setprio(0); } while (0)
#define G8_WAIT_V(n) asm volatile("s_waitcnt vmcnt(" #n ")" ::: "memory")
#define G8_WAIT_L(n) asm volatile("s_waitcnt lgkmcnt(" #n ")" ::: "memory")
#define G8_BAR __builtin_amdgcn_s_barrier()
#define G8_SCHED __builtin_amdgcn_sched_barrier(0)
#define G8_SETVA(dst, u) do { int _t2 = tid; if (GATHER) asm volatile("" : "+v"(_t2)); _Pragma("unroll") for (int _h = 0; _h < 2; ++_h) _Pragma("unroll") for (int _i = 0; _i < 2; ++_i) { \
        int _R, _C; stage_rc(_t2 * 16 + _i * 8192, _R, _C); \
        const unsigned _rl = (unsigned)(_h * HALF + _R); unsigned _row = _rl; \
        if (GATHER) { const bool _ok = _rl < (unsigned)(u).nvalid; _row = (unsigned)(u).rows[_ok ? _rl : 0u] >> 3; if (!_ok) _row = 0u; }     \
        dst[_h][_i] = (_row * (unsigned)lda + (unsigned)_C) * 2u; } } while (0)
    Unit cur, nxt; int ui = 0;
    if (!S.next(0, cur)) return;
    f32x4 acc[2][2][4][2];
#pragma unroll
    for (int a = 0; a < 2; ++a)
#pragma unroll
        for (int b = 0; b < 2; ++b)
#pragma unroll
            for (int m = 0; m < 4; ++m)
#pragma unroll
                for (int n = 0; n < 2; ++n) acc[a][b][m][n] = (f32x4){0.f, 0.f, 0.f, 0.f};
    bf16x8 At[4][2], B0[2][2], B1[2][2];
    unsigned vAc[2][2]; unsigned xl00 = 0, xl01 = 0, xl10 = 0, xl11 = 0;
    G8_SETVA(vAc, cur);
    const char* cA = cur.A; const char* cB = cur.B;
    G8_STAGEB(G8_SB(0, 0), cB); G8_STAGEB(G8_SB(0, 1), cB + hstepB); G8_STAGE2(G8_SA(0, 0), cA, vAc[0][0], vAc[0][1]); G8_STAGE2(G8_SA(0, 1), cA, vAc[1][0], vAc[1][1]);
    if (wr == 1) G8_BAR;
    G8_WAIT_V(2); G8_BAR;
    G8_STAGEB(G8_SB(1, 0), cB + kstep); G8_STAGE2(G8_SA(1, 0), cA + kstep, vAc[0][0], vAc[0][1]); G8_STAGEB(G8_SB(1, 1), cB + hstepB + kstep);
    G8_WAIT_V(6); G8_BAR;
    for (;;) {
        const bool has_next = S.next(ui + 1, nxt);
        const char* nA = has_next ? nxt.A : cA; const char* nB = has_next ? nxt.B : cB;
        if (GATHER) { unsigned vAn[2][2]; if (has_next) { G8_SETVA(vAn, nxt); } else {
#pragma unroll
            for (int h = 0; h < 2; ++h)
#pragma unroll
                for (int i = 0; i < 2; ++i) vAn[h][i] = vAc[h][i]; }
            *stash = (v4u){vAn[0][0], vAn[0][1], vAn[1][0], vAn[1][1]}; }
#pragma unroll 1
        for (int t = 0; t < nt; t += 2) {
            const bool last = (t == nt - 2);
            const char* a1 = cA + (size_t)(t + 1) * kstep;
            const char* a2 = last ? nA : cA + (size_t)(t + 2) * kstep; const char* b2 = last ? nB : cB + (size_t)(t + 2) * kstep;
            const char* a3 = a2 + kstep; const char* b3 = b2 + kstep;
            unsigned x00 = vAc[0][0], x01 = vAc[0][1], x10 = vAc[1][0], x11 = vAc[1][1];
            if (GATHER) { if (last) { const v4u sv = *stash; x00 = sv.x; x01 = sv.y; x10 = sv.z; x11 = sv.w; } xl00 = x00; xl01 = x01; xl10 = x10; xl11 = x11; }
            G8_LDB(B0, 0, 0); G8_LDB(B1, 0, 1); G8_SCHED; G8_LDA(At, 0, 0); G8_STAGE2(G8_SA(1, 1), a1, vAc[1][0], vAc[1][1]);
            G8_WAIT_V(8); G8_WAIT_L(0); G8_BAR; G8_MMA(0, 0, At, B0); G8_MMA(0, 1, At, B1); G8_BAR; G8_SCHED;
            G8_LDA(At, 0, 1); G8_STAGEB(G8_SB(0, 0), b2); G8_STAGEB(G8_SB(0, 1), b2 + hstepB); G8_STAGE2(G8_SA(0, 0), a2, x00, x01);
            G8_WAIT_V(8); G8_WAIT_L(0); G8_BAR; G8_MMA(1, 0, At, B0); G8_MMA(1, 1, At, B1); G8_BAR; G8_SCHED;
            G8_LDB(B0, 1, 0); G8_LDB(B1, 1, 1); G8_SCHED; G8_LDA(At, 1, 0); G8_STAGE2(G8_SA(0, 1), a2, x10, x11);
            G8_WAIT_V(8); G8_WAIT_L(0); G8_BAR; G8_MMA(0, 0, At, B0); G8_MMA(0, 1, At, B1); G8_BAR; G8_SCHED;
            G8_LDA(At, 1, 1); G8_STAGEB(G8_SB(1, 0), b3); G8_STAGEB(G8_SB(1, 1), b3 + hstepB); G8_STAGE2(G8_SA(1, 0), a3, x00, x01);
            G8_WAIT_V(8); G8_WAIT_L(0); G8_BAR; G8_MMA(1, 0, At, B0); G8_MMA(1, 1, At, B1); G8_BAR; G8_SCHED;
        }
        if (wr == 0) G8_BAR;
        E(acc, cur, wr, wc, fr, fq);
        if (!has_next) break;
#pragma unroll
        for (int a = 0; a < 2; ++a)
#pragma unroll
            for (int b = 0; b < 2; ++b)
#pragma unroll
                for (int m = 0; m < 4; ++m)
#pragma unroll
                    for (int n = 0; n < 2; ++n) acc[a][b][m][n] = (f32x4){0.f, 0.f, 0.f, 0.f};
        cur = nxt; cA = nA; cB = nB; ++ui;
        if (GATHER) { vAc[0][0] = xl00; vAc[0][1] = xl01; vAc[1][0] = xl10; vAc[1][1] = xl11; }
        if (wr == 1) G8_BAR;
    }
    G8_WAIT_V(0);
    G8_BAR;
#undef G8_SA
#undef G8_SB
#undef G8_STAGE2
#undef G8_STAGEB
#undef G8_LDA
#undef G8_LDB
#undef G8_MMA
#undef G8_WAIT_V
#undef G8_WAIT_L
#undef G8_BAR
#undef G8_SCHED
#undef G8_SETVA
}

struct DenseSched {
    const char* A; const char* B; size_t a_tile, b_tile, agrp_stride; int agrp_shift, nM, nN, nwg, G, c;
    __device__ __forceinline__ void init(const void* A_, const void* B_, int M, int N, int lda, int ldb, int G_, int c_) {
        A = (const char*)A_; B = (const char*)B_; a_tile = (size_t)BM * lda * 2; b_tile = (size_t)BM * ldb * 2; agrp_stride = 0; agrp_shift = 0; nM = M / BM; nN = N / BM; nwg = nM * nN; G = G_; c = c_; }
    __device__ __forceinline__ bool next(int i, Unit& u) const {
        const long L = (long)i * G + c; if (L >= nwg) return false;
        int wgid = (int)L; { const int q = nwg / NXCD, r = nwg % NXCD, xcd = wgid % NXCD, off = wgid / NXCD; wgid = (xcd < r ? xcd * (q + 1) : r * (q + 1) + (xcd - r) * q) + off; }
        const int nig = WGM * nN, gid = wgid / nig, fm = gid * WGM, gsz = (nM - fm) < WGM ? (nM - fm) : WGM;
        u.pm = fm + ((wgid % nig) % gsz); u.pn = (wgid % nig) / gsz;
        u.A = A + (size_t)u.pm * a_tile + (size_t)(u.pn >> agrp_shift) * agrp_stride; u.B = B + (size_t)u.pn * b_tile; u.rows = nullptr; u.nvalid = BM; u.aux = 0; return true;
    }
};
template <int NPN, bool GATHERED>
struct ExpertSched {
    const LAS int* tpref; const LAS int* cnt; const char* A; const char* B; const int* tok; size_t b_exp, b_tile, a_tile; int NU, G, c;
    __device__ __forceinline__ bool next(int i, Unit& u) const {
        int L = i * G + c; if (L >= NU) return false;
        if ((i + 1) * G <= NU && (G % NXCD) == 0) L = i * G + (c % NXCD) * (G / NXCD) + c / NXCD;
        const int tile = L / NPN, pn = L % NPN;
        int e = 0; while (__builtin_amdgcn_readfirstlane(tpref[e + 1]) <= tile) ++e;
        const int rb = tile - __builtin_amdgcn_readfirstlane(tpref[e]);
        u.pm = e; u.pn = pn; u.aux = tile * BM; u.nvalid = __builtin_amdgcn_readfirstlane(cnt[e]) - rb * BM; if (u.nvalid > BM) u.nvalid = BM;
        u.rows = tok + (size_t)e * CAP + rb * BM;
        u.A = GATHERED ? A : A + (size_t)tile * a_tile; u.B = B + (size_t)e * b_exp + (size_t)pn * b_tile; return true;
    }
};

struct EpiBf16 {
    static constexpr bool PERM = true;
    bf16* O; int ldc; int qscale;
    __device__ __forceinline__ void operator()(const f32x4 (&acc)[2][2][4][2], const Unit& u, int wr, int wc, int fr, int fq) const {
        asm volatile("" : "+v"(fr), "+v"(fq));
        const int row0 = u.pm * BM + wr * 64 + fr, col0 = u.pn * BM + wc * 32 + 8 * fq;
        const float sc = (qscale && (u.pn % 6) < 2) ? 0.125f : 1.0f;
#pragma unroll
        for (int ai = 0; ai < 2; ++ai)
#pragma unroll
            for (int m = 0; m < 4; ++m) { bf16* rowp = O + (size_t)(row0 + ai * HALF + m * 16) * ldc + col0;
#pragma unroll
                for (int bj = 0; bj < 2; ++bj) { const f32x4 v0 = acc[ai][bj][m][0] * sc, v1 = acc[ai][bj][m][1] * sc;
                    v4u w; w.x = cvt_pk_bf16(v0[0], v0[1]); w.y = cvt_pk_bf16(v0[2], v0[3]); w.z = cvt_pk_bf16(v1[0], v1[1]); w.w = cvt_pk_bf16(v1[2], v1[3]);
                    *(v4u*)(rowp + bj * HALF) = w; } }
    }
};
struct EpiScaleBf16 {
    static constexpr bool PERM = true;
    bf16* O; int ldc; const float* scale;
    __device__ __forceinline__ void operator()(const f32x4 (&acc)[2][2][4][2], const Unit& u, int wr, int wc, int fr, int fq) const {
        asm volatile("" : "+v"(fr), "+v"(fq));
        const int row0 = u.pm * BM + wr * 64 + fr, col0 = u.pn * BM + wc * 32 + 8 * fq;
        f32x4 sv[2][2];
#pragma unroll
        for (int bj = 0; bj < 2; ++bj)
#pragma unroll
            for (int n = 0; n < 2; ++n) sv[bj][n] = *(const f32x4*)(scale + col0 + bj * HALF + 4 * n);
#pragma unroll
        for (int ai = 0; ai < 2; ++ai)
#pragma unroll
            for (int m = 0; m < 4; ++m) { bf16* rowp = O + (size_t)(row0 + ai * HALF + m * 16) * ldc + col0;
#pragma unroll
                for (int bj = 0; bj < 2; ++bj) { const f32x4 v0 = acc[ai][bj][m][0] * sv[bj][0], v1 = acc[ai][bj][m][1] * sv[bj][1];
                    v4u w; w.x = cvt_pk_bf16(v0[0], v0[1]); w.y = cvt_pk_bf16(v0[2], v0[3]); w.z = cvt_pk_bf16(v1[0], v1[1]); w.w = cvt_pk_bf16(v1[2], v1[3]);
                    *(v4u*)(rowp + bj * HALF) = w; } }
    }
};
struct EpiResid {
    static constexpr bool PERM = false;
    const float* X; float* Y;
    __device__ __forceinline__ void operator()(const f32x4 (&acc)[2][2][4][2], const Unit& u, int wr, int wc, int fr, int fq) const {
        asm volatile("" : "+v"(fr), "+v"(fq));
        const int row0 = u.pm * BM + wr * 64 + fr, col0 = u.pn * BM + wc * 32 + 4 * fq;
#pragma unroll
        for (int ai = 0; ai < 2; ++ai)
#pragma unroll
            for (int m = 0; m < 4; ++m) { const size_t off = (size_t)(row0 + ai * HALF + m * 16) * D + col0;
#pragma unroll
                for (int bj = 0; bj < 2; ++bj)
#pragma unroll
                    for (int n = 0; n < 2; ++n) { const f32x4 xv = *(const f32x4*)(X + off + bj * HALF + n * 16); *(f32x4*)(Y + off + bj * HALF + n * 16) = xv * ALPHA + acc[ai][bj][m][n]; } }
    }
};
struct EpiResidLN {
    static constexpr bool PERM = true;
    const float* X32; const bf16* Xb; const float* st; const float* g; const float* b; bf16* Y; float* pst; int mode;
    __device__ __forceinline__ void operator()(const f32x4 (&acc)[2][2][4][2], const Unit& u, int wr, int wc, int fr, int fq) const {
        asm volatile("" : "+v"(fr), "+v"(fq));
        const int row0 = u.pm * BM + wr * 64 + fr, col0 = u.pn * BM + wc * 32 + 8 * fq, lane = fq * 16 + fr;
#pragma unroll
        for (int ai = 0; ai < 2; ++ai) {
            v4u xr[4][2];
#pragma unroll
            for (int m = 0; m < 4; ++m)
#pragma unroll
                for (int bj = 0; bj < 2; ++bj) xr[m][bj] = *(const v4u*)(Xb + (size_t)(row0 + ai * HALF + m * 16) * D + col0 + bj * HALF);
            asm volatile("" : "+v"(xr[0][0]), "+v"(xr[0][1]), "+v"(xr[1][0]), "+v"(xr[1][1]), "+v"(xr[2][0]), "+v"(xr[2][1]), "+v"(xr[3][0]), "+v"(xr[3][1]));
#pragma unroll
            for (int m = 0; m < 4; ++m) { const int row = row0 + ai * HALF + m * 16; const size_t off = (size_t)row * D + col0;
                float sm = 0.f, sq = 0.f;
#pragma unroll
                for (int bj = 0; bj < 2; ++bj) { const v4u xv = xr[m][bj];
                    const f32x4 x0 = (f32x4){bflo(xv.x), bfhi(xv.x), bflo(xv.y), bfhi(xv.y)}, x1 = (f32x4){bflo(xv.z), bfhi(xv.z), bflo(xv.w), bfhi(xv.w)};
                    const f32x4 y0 = x0 * ALPHA + acc[ai][bj][m][0], y1 = x1 * ALPHA + acc[ai][bj][m][1];
                    v4u w; w.x = cvt_pk_bf16(y0[0], y0[1]); w.y = cvt_pk_bf16(y0[2], y0[3]); w.z = cvt_pk_bf16(y1[0], y1[1]); w.w = cvt_pk_bf16(y1[2], y1[3]);
                    *(v4u*)(Y + off + bj * HALF) = w;
                    sm += ((y0[0] + y0[1]) + (y0[2] + y0[3])) + ((y1[0] + y1[1]) + (y1[2] + y1[3]));
                    sq += ((y0[0] * y0[0] + y0[1] * y0[1]) + (y0[2] * y0[2] + y0[3] * y0[3])) + ((y1[0] * y1[0] + y1[1] * y1[1]) + (y1[2] * y1[2] + y1[3] * y1[3])); }
                sm += shfl_x(sm, 16, lane); sm += shfl_x(sm, 32, lane); sq += shfl_x(sq, 16, lane); sq += shfl_x(sq, 32, lane);
                if (fq == 0) *(f32x2*)(pst + ((size_t)row * 32 + u.pn * 4 + wc) * 2) = (f32x2){sm, sq}; } }
    }
};
struct EpiConvIn {
    static constexpr bool PERM = true;
    bf16* UC; bf16* BGp;
    __device__ __forceinline__ void operator()(const f32x4 (&acc)[2][2][4][2], const Unit& u, int wr, int wc, int fr, int fq) const {
        asm volatile("" : "+v"(fr), "+v"(fq));
        const int row0 = u.pm * BM + wr * 64 + fr, cw = wc * 32 + 8 * fq;
        if (u.pn < 16) {
#pragma unroll
            for (int ai = 0; ai < 2; ++ai)
#pragma unroll
                for (int m = 0; m < 4; ++m) { bf16* rowp = UC + (size_t)(row0 + ai * HALF + m * 16) * D + u.pn * HALF + cw;
                    const f32x4 v0 = acc[ai][0][m][0] * acc[ai][1][m][0], v1 = acc[ai][0][m][1] * acc[ai][1][m][1];
                    v4u w; w.x = cvt_pk_bf16(v0[0], v0[1]); w.y = cvt_pk_bf16(v0[2], v0[3]); w.z = cvt_pk_bf16(v1[0], v1[1]); w.w = cvt_pk_bf16(v1[2], v1[3]);
                    *(v4u*)rowp = w; }
        } else {
#pragma unroll
            for (int ai = 0; ai < 2; ++ai)
#pragma unroll
                for (int m = 0; m < 4; ++m) { bf16* rowp = BGp + (size_t)(row0 + ai * HALF + m * 16) * D + (u.pn - 16) * BM + cw;
#pragma unroll
                    for (int bj = 0; bj < 2; ++bj) { const f32x4 v0 = acc[ai][bj][m][0], v1 = acc[ai][bj][m][1];
                        v4u w; w.x = cvt_pk_bf16(v0[0], v0[1]); w.y = cvt_pk_bf16(v0[2], v0[3]); w.z = cvt_pk_bf16(v1[0], v1[1]); w.w = cvt_pk_bf16(v1[2], v1[3]);
                        *(v4u*)(rowp + bj * HALF) = w; } }
        }
    }
};
__device__ __forceinline__ f32x4 silu_mul(f32x4 g, f32x4 uu) {
    f32x4 r;
#pragma unroll
    for (int j = 0; j < 4; ++j) r[j] = g[j] * __builtin_amdgcn_rcpf(1.0f + __expf(-g[j])) * uu[j];
    return r;
}
struct EpiExpertGU {
    static constexpr bool PERM = true;
    bf16* H;
    __device__ __forceinline__ void operator()(const f32x4 (&acc)[2][2][4][2], const Unit& u, int wr, int wc, int fr, int fq) const {
        asm volatile("" : "+v"(fr), "+v"(fq));
        const float* gates = (const float*)((const char*)u.rows + (WS_LGATE - WS_LTOK));
        const int cw = wc * 32 + 8 * fq;
        float gtv[2][4];
#pragma unroll
        for (int ai = 0; ai < 2; ++ai)
#pragma unroll
            for (int m = 0; m < 4; ++m) { const int r = ai * HALF + wr * 64 + m * 16 + fr; gtv[ai][m] = gates[r < u.nvalid ? r : 0]; }
        asm volatile("" : "+v"(gtv[0][0]), "+v"(gtv[0][1]), "+v"(gtv[0][2]), "+v"(gtv[0][3]), "+v"(gtv[1][0]), "+v"(gtv[1][1]), "+v"(gtv[1][2]), "+v"(gtv[1][3]));
#pragma unroll
        for (int ai = 0; ai < 2; ++ai)
#pragma unroll
            for (int m = 0; m < 4; ++m) { const int r = ai * HALF + wr * 64 + m * 16 + fr;
                if (r < u.nvalid) { const float gt = gtv[ai][m]; const unsigned pid = 0u;
                    const f32x4 v0 = silu_mul(acc[ai][0][m][0], acc[ai][1][m][0]) * gt, v1 = silu_mul(acc[ai][0][m][1], acc[ai][1][m][1]) * gt;
                    v4u w; w.x = cvt_pk_bf16(v0[0], v0[1]); w.y = cvt_pk_bf16(v0[2], v0[3]); w.z = cvt_pk_bf16(v1[0], v1[1]); w.w = cvt_pk_bf16(v1[2], v1[3]);
                    (void)pid; *(v4u*)(H + (size_t)(u.aux + r) * EDIM + cw) = w; } }
    }
};
struct EpiSharedGU {
    static constexpr bool PERM = true;
    bf16* HS;
    __device__ __forceinline__ void operator()(const f32x4 (&acc)[2][2][4][2], const Unit& u, int wr, int wc, int fr, int fq) const {
        asm volatile("" : "+v"(fr), "+v"(fq));
        const int row0 = u.pm * BM + wr * 64 + fr, cw = u.pn * HALF + wc * 32 + 8 * fq;
#pragma unroll
        for (int ai = 0; ai < 2; ++ai)
#pragma unroll
            for (int m = 0; m < 4; ++m) {
                const f32x4 v0 = silu_mul(acc[ai][0][m][0], acc[ai][1][m][0]), v1 = silu_mul(acc[ai][0][m][1], acc[ai][1][m][1]);
                v4u w; w.x = cvt_pk_bf16(v0[0], v0[1]); w.y = cvt_pk_bf16(v0[2], v0[3]); w.z = cvt_pk_bf16(v1[0], v1[1]); w.w = cvt_pk_bf16(v1[2], v1[3]);
                *(v4u*)(HS + (size_t)(row0 + ai * HALF + m * 16) * SDIM + cw) = w; }
    }
};
struct EpiDownY {
    static constexpr bool PERM = true;
    bf16* Y;
    __device__ __forceinline__ void operator()(const f32x4 (&acc)[2][2][4][2], const Unit& u, int wr, int wc, int fr, int fq) const {
        asm volatile("" : "+v"(fr), "+v"(fq));
        const int col0 = u.pn * BM + wc * 32 + 8 * fq;
#pragma unroll
        for (int ai = 0; ai < 2; ++ai)
#pragma unroll
            for (int m = 0; m < 4; ++m) { const int r = ai * HALF + wr * 64 + m * 16 + fr; bf16* rowp = Y + (size_t)(u.aux + r) * D + col0;
#pragma unroll
                for (int bj = 0; bj < 2; ++bj) { const f32x4 v0 = acc[ai][bj][m][0], v1 = acc[ai][bj][m][1];
                    v4u w; w.x = cvt_pk_bf16(v0[0], v0[1]); w.y = cvt_pk_bf16(v0[2], v0[3]); w.z = cvt_pk_bf16(v1[0], v1[1]); w.w = cvt_pk_bf16(v1[2], v1[3]);
                    *(v4u*)(rowp + bj * HALF) = w; } }
    }
};
}

struct Args { const float* in[19]; float* out; unsigned char* ws; int ph_lo, ph_hi; };
struct Frame {
    LAS unsigned char* lds; unsigned* ctl; unsigned char* ws;
    int tid, lane, wave, G, bid;
};
enum { IN_X = 0, IN_RELB, IN_PWIN, IN_PWG, IN_PSC, IN_PWOUT, IN_DQKV, IN_DOUT, IN_CWIN, IN_CW, IN_CWOUT, IN_LNG, IN_LNB, IN_RW, IN_RB, IN_EGU, IN_ED, IN_SGU, IN_SD };

#define CAS __attribute__((address_space(4)))
typedef const CAS unsigned char* KP;
__device__ __forceinline__ const float* ain(KP kp, int i) { return (const float*)((const GAS float* const CAS*)kp)[i]; }
__device__ __forceinline__ float* aout(KP kp) { return (float*)((GAS float* const CAS*)kp)[19]; }
__device__ __forceinline__ void tr_item(const float* W, int K, int N, bf16* WT, int dstK, int mode, LAS float* scr, int item, int lane) {
    const int nblk = N / 32, kb = item / nblk, nb = item % nblk, k0 = 64 * kb, n0 = 32 * nb;
    int r0 = n0;
    if (mode == 1) { const int part = n0 / 2048, j = n0 % 2048; r0 = (part == 0) ? 4096 + j : 256 * (j / 128) + (part == 2 ? 128 : 0) + (j % 128); }
    if (mode == 2) { const int part = n0 / 256, j = n0 % 256; r0 = 256 * (j / 128) + 128 * part + (j % 128); }
#pragma unroll 8
    for (int i = 0; i < 32; ++i) { const int kk = 2 * i + (lane >> 5); scr[kk * 33 + (lane & 31)] = __builtin_nontemporal_load(W + (size_t)(k0 + kk) * N + n0 + (lane & 31)); }
    LDS_WAIT(); asm volatile("" ::: "memory");
    const int c = lane & 7;
#pragma unroll
    for (int j = 0; j < 4; ++j) { const int n = (lane >> 3) + 8 * j; const LAS float* s = scr + (8 * c) * 33 + n;
        v4u o; o.x = pk2(s[0 * 33], s[1 * 33]); o.y = pk2(s[2 * 33], s[3 * 33]); o.z = pk2(s[4 * 33], s[5 * 33]); o.w = pk2(s[6 * 33], s[7 * 33]);
        __builtin_nontemporal_store(o, (v4u*)(WT + (size_t)(r0 + n) * dstK + k0 + 8 * c)); }
    LDS_WAIT(); asm volatile("" ::: "memory");
}
__device__ __forceinline__ void phase_prologue(const Frame& F, KP kp) {
    LAS float* scr = (LAS float*)(F.lds + F.wave * 16384);
    const int gw = F.bid * 8 + F.wave, NGW = F.G * 8;
    constexpr int I0 = 2 * 2048, I1 = 8 * 128, I2 = 2 * 2048, I3 = 4608, I4 = 512, I5 = 6144, I6 = 2048, I7 = 4 * 512, I8 = 4 * 256, I9 = 256 * 256, I10 = 256 * 128;
    constexpr int NITEMS = I0 + I1 + I2 + I3 + I4 + I5 + I6 + I7 + I8 + I9 + I10;
    unsigned char* ws = F.ws;
    for (int it = gw; it < NITEMS; it += NGW) {
        int r = it;
        if (r < I0) { const int b = r / 2048; tr_item(ain(kp, IN_PWIN) + (size_t)b * D * D, D, D, (bf16*)(ws + WS_W_POOL_IN) + (size_t)b * D * D, D, 0, scr, r % 2048, F.lane); continue; } r -= I0;
        if (r < I1) { const int b = r / 128; tr_item(ain(kp, IN_PWG) + (size_t)b * 512 * 512, 512, 512, (bf16*)(ws + WS_W_POOL_G) + (size_t)b * 512 * 512, 512, 0, scr, r % 128, F.lane); continue; } r -= I1;
        if (r < I2) { const int b = r / 2048; tr_item(ain(kp, IN_PWOUT) + (size_t)b * D * D, D, D, (bf16*)(ws + WS_W_POOL_OUT) + (size_t)b * D * D, D, 0, scr, r % 2048, F.lane); continue; } r -= I2;
        if (r < I3) { tr_item(ain(kp, IN_DQKV), D, QKVC, (bf16*)(ws + WS_W_DIL_QKV), D, 0, scr, r, F.lane); continue; } r -= I3;
        if (r < I4) { tr_item(ain(kp, IN_DOUT), DILW, D, (bf16*)(ws + WS_W_DIL_OUT), DILW, 0, scr, r, F.lane); continue; } r -= I4;
        if (r < I5) { tr_item(ain(kp, IN_CWIN), D, 3 * D, (bf16*)(ws + WS_W_CONV_IN), D, 1, scr, r, F.lane); continue; } r -= I5;
        if (r < I6) { tr_item(ain(kp, IN_CWOUT), D, D, (bf16*)(ws + WS_W_CONV_OUT), D, 0, scr, r, F.lane); continue; } r -= I6;
        if (r < I7) { const int b = r / 512; tr_item(ain(kp, IN_SGU) + (size_t)b * D * 512, D, 512, (bf16*)(ws + WS_W_SH_GU) + (size_t)b * 512 * D, D, 2, scr, r % 512, F.lane); continue; } r -= I7;
        if (r < I8) { const int b = r / 256; tr_item(ain(kp, IN_SD) + (size_t)b * SDIM * D, SDIM, D, (bf16*)(ws + WS_W_SH_D) + (size_t)b * D * SDIM, SDIM, 0, scr, r % 256, F.lane); continue; } r -= I8;
        if (r < I9) { const int b = r / 256; tr_item(ain(kp, IN_EGU) + (size_t)b * D * 256, D, 256, (bf16*)(ws + WS_W_EX_GU) + (size_t)b * 256 * D, D, 0, scr, r % 256, F.lane); continue; } r -= I9;
        { const int b = r / 128; tr_item(ain(kp, IN_ED) + (size_t)b * EDIM * D, EDIM, D, (bf16*)(ws + WS_W_EX_D) + (size_t)b * D * EDIM, EDIM, 0, scr, r % 128, F.lane); }
    }
    const size_t gt = (size_t)F.bid * 512 + F.tid, GT = (size_t)F.G * 512;
    { const float* rw = ain(kp, IN_RW); bf16* wh = (bf16*)(ws + WS_RWH); bf16* wl = (bf16*)(ws + WS_RWL);
      for (size_t i = gt; i < (size_t)DEPTH * NEXP * D / 8; i += GT) { const size_t k8 = i % (D / 8), e = (i / (D / 8)) % NEXP, l = i / ((size_t)NEXP * D / 8);
          float v[8]; unsigned hi[8], lo[8];
#pragma unroll
          for (int j = 0; j < 8; ++j) { v[j] = rw[(l * D + k8 * 8 + j) * NEXP + e]; hi[j] = f2bf(v[j]); lo[j] = f2bf(v[j] - __builtin_bit_cast(float, hi[j] << 16)); }
          v4u a, b2; a.x = hi[0] | (hi[1] << 16); a.y = hi[2] | (hi[3] << 16); a.z = hi[4] | (hi[5] << 16); a.w = hi[6] | (hi[7] << 16);
          b2.x = lo[0] | (lo[1] << 16); b2.y = lo[2] | (lo[3] << 16); b2.z = lo[4] | (lo[5] << 16); b2.w = lo[6] | (lo[7] << 16);
          *(v4u*)(wh + (l * NEXP + e) * D + k8 * 8) = a; *(v4u*)(wl + (l * NEXP + e) * D + k8 * 8) = b2; } }
    const float* x = ain(kp, IN_X); bf16* xb = (bf16*)(ws + WS_XB);
    for (size_t i = gt; i < (size_t)T * D / 8; i += GT) { const f32x4 p = __builtin_nontemporal_load((const f32x4*)(x + i * 8)), q = __builtin_nontemporal_load((const f32x4*)(x + i * 8 + 4));
        v4u w; w.x = pk2(p[0], p[1]); w.y = pk2(p[2], p[3]); w.z = pk2(q[0], q[1]); w.w = pk2(q[2], q[3]); *(v4u*)(xb + i * 8) = w; }
}

__device__ __forceinline__ void unpack8(const v4u w, float (&f)[8]) { f[0] = bflo(w.x); f[1] = bfhi(w.x); f[2] = bflo(w.y); f[3] = bfhi(w.y); f[4] = bflo(w.z); f[5] = bfhi(w.z); f[6] = bflo(w.w); f[7] = bfhi(w.w); }
__device__ __forceinline__ void phase_pool(const Frame& F, const bf16* U, bf16* PL) {
    for (int it = F.bid * 512 + F.tid; it < (T / 32) * 256; it += F.G * 512) {
        const int cv = it & 255, ch = it >> 8, col = cv * 8;
        const int w = __builtin_amdgcn_readfirstlane(2 << (col >> 9));
        const int row0 = __builtin_amdgcn_readfirstlane(ch * 32), pos0 = row0 & (SEQ - 1);
        float s[8], uu[8];
#pragma unroll
        for (int j = 0; j < 8; ++j) s[j] = 0.f;
        { v4u pre[15];
#pragma unroll
          for (int j = 0; j < 15; ++j) { pre[j] = (v4u){0u, 0u, 0u, 0u}; if (j + 1 < w && pos0 - (j + 1) >= 0) pre[j] = *(const v4u*)(U + (size_t)(row0 - (j + 1)) * D + col); }
#pragma unroll
          for (int j = 0; j < 15; ++j) asm volatile("" : "+v"(pre[j]));
#pragma unroll
          for (int j = 0; j < 15; ++j) { unpack8(pre[j], uu);
#pragma unroll
              for (int q = 0; q < 8; ++q) s[q] += uu[q]; } }
#pragma unroll 1
        for (int cb = 0; cb < 4; ++cb) {
            v4u un[8], uo[8];
#pragma unroll
            for (int j = 0; j < 8; ++j) { const int r = 8 * cb + j, t = row0 + r, pos = pos0 + r;
                un[j] = *(const v4u*)(U + (size_t)t * D + col);
                uo[j] = (v4u){0u, 0u, 0u, 0u}; if (pos - w + 1 >= 0) uo[j] = *(const v4u*)(U + (size_t)(t - w + 1) * D + col); }
#pragma unroll
            for (int j = 0; j < 8; ++j) asm volatile("" : "+v"(un[j]), "+v"(uo[j]));
#pragma unroll
            for (int j = 0; j < 8; ++j) { const int r = 8 * cb + j, t = row0 + r, pos = pos0 + r;
                unpack8(un[j], uu);
                const float inv = 1.0f / (float)((pos + 1) < w ? (pos + 1) : w);
                float o[8];
#pragma unroll
                for (int q = 0; q < 8; ++q) { s[q] += uu[q]; o[q] = s[q] * inv - uu[q]; }
                v4u ww; ww.x = pk2(o[0], o[1]); ww.y = pk2(o[2], o[3]); ww.z = pk2(o[4], o[5]); ww.w = pk2(o[6], o[7]);
                *(v4u*)(PL + (size_t)t * D + col) = ww;
                unpack8(uo[j], uu);
#pragma unroll
                for (int q = 0; q < 8; ++q) s[q] -= uu[q]; }
        }
    }
}

__device__ __forceinline__ void phase_conv(const Frame& F, const bf16* UC, const bf16* BGp, const float* cw, bf16* Z) {
    for (int it = F.bid * 512 + F.tid; it < (T / 4) * 256; it += F.G * 512) {
        const int cv = it & 255, col = cv * 8, t0 = __builtin_amdgcn_readfirstlane((it >> 8) * 4), pos0 = t0 & (SEQ - 1);
        v4u ur[6], br[4];
#pragma unroll
        for (int j = 0; j < 6; ++j) { ur[j] = (v4u){0u, 0u, 0u, 0u}; if (j >= 2 || pos0 > 0) ur[j] = *(const v4u*)(UC + (size_t)(t0 - 2 + j) * D + col); }
#pragma unroll
        for (int j = 0; j < 4; ++j) br[j] = *(const v4u*)(BGp + (size_t)(t0 + j) * D + col);
        const f32x4 c0a = *(const f32x4*)(cw + col), c0b = *(const f32x4*)(cw + col + 4), c1a = *(const f32x4*)(cw + D + col), c1b = *(const f32x4*)(cw + D + col + 4), c2a = *(const f32x4*)(cw + 2 * D + col), c2b = *(const f32x4*)(cw + 2 * D + col + 4);
        asm volatile("" : "+v"(ur[0]), "+v"(ur[1]), "+v"(ur[2]), "+v"(ur[3]), "+v"(ur[4]), "+v"(ur[5]), "+v"(br[0]), "+v"(br[1]), "+v"(br[2]), "+v"(br[3]));
        const float c0[8] = {c0a[0], c0a[1], c0a[2], c0a[3], c0b[0], c0b[1], c0b[2], c0b[3]}, c1[8] = {c1a[0], c1a[1], c1a[2], c1a[3], c1b[0], c1b[1], c1b[2], c1b[3]}, c2[8] = {c2a[0], c2a[1], c2a[2], c2a[3], c2b[0], c2b[1], c2b[2], c2b[3]};
#pragma unroll
        for (int j = 0; j < 4; ++j) { float u0[8], u1[8], u2[8], bb[8], o[8];
            unpack8(ur[j], u0); unpack8(ur[j + 1], u1); unpack8(ur[j + 2], u2); unpack8(br[j], bb);
#pragma unroll
            for (int q = 0; q < 8; ++q) o[q] = bb[q] * (c0[q] * u0[q] + c1[q] * u1[q] + c2[q] * u2[q]);
            v4u ww; ww.x = pk2(o[0], o[1]); ww.y = pk2(o[2], o[3]); ww.z = pk2(o[4], o[5]); ww.w = pk2(o[6], o[7]);
            *(v4u*)(Z + (size_t)(t0 + j) * D + col) = ww; }
    }
}

__device__ __forceinline__ int t5_bucket(int dist) {
    if (dist < 16) return dist;
    int large = 16 + (int)(logf((float)dist / 16.0f) / logf(128.0f) * 16.0f);
    return large < 31 ? large : 31;
}
constexpr int AT_KS = 0, AT_KSTR = 144, AT_VT = 256 * 144, AT_VSTR = 520, AT_BIAS = AT_VT + 64 * 520;
__device__ __forceinline__ void phase_attn(const Frame& F, const bf16* QKV, const float* relb, bf16* OG, float* LSE) {
    LAS unsigned char* lds = F.lds;
    const int tid = F.tid, lane = F.lane, w = tid >> 6, fr = lane & 15, fq = lane >> 4;
    for (int unit = F.bid; unit < NBATCH * 3 * 8 * 16; unit += F.G) {
        const int cmb = unit & 15, h = (unit >> 4) & 7, g = (unit >> 7) % 3, b = unit / 384;
        const int dsh = 2 * g, dil = 1 << dsh, r = cmb & (dil - 1), nb = cmb >> dsh;
        const bf16* base = QKV + (size_t)b * SEQ * QKVC + g * 1536 + h * 64;
        __syncthreads();
        {
            const int key = tid >> 1, half = tid & 1, jk = (nb - 1) * 128 + key;
            v4u kv[4], vv[4];
            if (jk >= 0) { const bf16* rp = base + (size_t)(jk * dil + r) * QKVC + half * 32;
#pragma unroll
                for (int i = 0; i < 4; ++i) { kv[i] = *(const v4u*)(rp + 512 + 8 * i); vv[i] = *(const v4u*)(rp + 1024 + 8 * i); } }
            else {
#pragma unroll
                for (int i = 0; i < 4; ++i) { kv[i] = (v4u){0u, 0u, 0u, 0u}; vv[i] = (v4u){0u, 0u, 0u, 0u}; } }
#pragma unroll
            for (int i = 0; i < 4; ++i) *(LAS v4u*)(lds + AT_KS + key * AT_KSTR + half * 64 + 16 * i) = kv[i];
#pragma unroll
            for (int i = 0; i < 4; ++i) {
                const unsigned ww[4] = {vv[i].x, vv[i].y, vv[i].z, vv[i].w};
#pragma unroll
                for (int q = 0; q < 4; ++q) { const int d = half * 32 + 8 * i + 2 * q;
                    *(LAS unsigned short*)(lds + AT_VT + d * AT_VSTR + key * 2) = (unsigned short)(ww[q] & 0xffffu);
                    *(LAS unsigned short*)(lds + AT_VT + (d + 1) * AT_VSTR + key * 2) = (unsigned short)(ww[q] >> 16); } }
            if (tid <= 128) ((LAS float*)(lds + AT_BIAS))[tid] = relb[t5_bucket(tid * dil) * 24 + g * 8 + h];
        }
        __syncthreads();
        int qi = 16 * w + fr; asm volatile("" : "+v"(qi));
        const int jq = nb * 128 + qi, tq = jq * dil + r;
        const bf16* qp = base + (size_t)tq * QKVC + 8 * fq;
        const bf16x8 q0 = *(const bf16x8*)qp, q1 = *(const bf16x8*)(qp + 32);
        f32x4 s[9]; float mx = -INFINITY;
#pragma unroll
        for (int kt = 0; kt < 9; ++kt) {
            const int kb = 16 * (w + kt);
            const bf16x8 k0 = *(const LAS bf16x8*)(lds + AT_KS + (kb + fr) * AT_KSTR + fq * 16), k1 = *(const LAS bf16x8*)(lds + AT_KS + (kb + fr) * AT_KSTR + 64 + fq * 16);
            f32x4 a = (f32x4){0.f, 0.f, 0.f, 0.f};
            a = __builtin_amdgcn_mfma_f32_16x16x32_bf16(k0, q0, a, 0, 0, 0);
            a = __builtin_amdgcn_mfma_f32_16x16x32_bf16(k1, q1, a, 0, 0, 0);
#pragma unroll
            for (int i = 0; i < 4; ++i) { const int kl = kb + 4 * fq + i, rel = qi + 128 - kl;
                const bool ok = (rel >= 0) && (rel <= 128) && (nb > 0 || kl >= 128);
                const int rc = rel < 0 ? 0 : (rel > 128 ? 128 : rel);
                float bv_ = ((LAS float*)(lds + AT_BIAS))[rc]; asm volatile("" : "+v"(bv_));
                const float v = ok ? a[i] + bv_ : -INFINITY;
                a[i] = v; mx = fmaxf(mx, v); }
            s[kt] = a;
        }
        mx = fmaxf(mx, shfl_x(mx, 16, lane)); mx = fmaxf(mx, shfl_x(mx, 32, lane));
        float l = 0.f;
#pragma unroll
        for (int kt = 0; kt < 9; ++kt)
#pragma unroll
            for (int i = 0; i < 4; ++i) { const float p = __expf(s[kt][i] - mx); s[kt][i] = p; l += p; }
        l += shfl_x(l, 16, lane); l += shfl_x(l, 32, lane);
        f32x4 o[4];
#pragma unroll
        for (int nt = 0; nt < 4; ++nt) o[nt] = (f32x4){0.f, 0.f, 0.f, 0.f};
#pragma unroll
        for (int st = 0; st < 5; ++st) {
            const int kt0 = 2 * st, kt1 = 2 * st + 1;
            v4u pw; pw.x = pk2(s[kt0][0], s[kt0][1]); pw.y = pk2(s[kt0][2], s[kt0][3]);
            if (kt1 < 9) { pw.z = pk2(s[kt1 < 9 ? kt1 : 0][0], s[kt1 < 9 ? kt1 : 0][1]); pw.w = pk2(s[kt1 < 9 ? kt1 : 0][2], s[kt1 < 9 ? kt1 : 0][3]); } else { pw.z = 0u; pw.w = 0u; }
            const bf16x8 pf = __builtin_bit_cast(bf16x8, pw);
            const int kb0 = 16 * (w + kt0) + 4 * fq, kb1 = 16 * (w + kt1) + 4 * fq;
#pragma unroll
            for (int nt = 0; nt < 4; ++nt) { const int d = 16 * nt + fr;
                v2u va = *(const LAS v2u*)(lds + AT_VT + d * AT_VSTR + kb0 * 2), vb = (v2u){0u, 0u};
                if (kt1 < 9) vb = *(const LAS v2u*)(lds + AT_VT + d * AT_VSTR + kb1 * 2);
                v4u vw; vw.x = va.x; vw.y = va.y; vw.z = vb.x; vw.w = vb.y;
                o[nt] = __builtin_amdgcn_mfma_f32_16x16x32_bf16(__builtin_bit_cast(bf16x8, vw), pf, o[nt], 0, 0, 0); }
        }
        const float il = 1.0f / l;
        bf16* op = OG + ((size_t)g * T + (size_t)b * SEQ + tq) * DILW + h * 64 + 4 * fq;
#pragma unroll
        for (int nt = 0; nt < 4; ++nt) { v2u ww; ww.x = pk2(o[nt][0] * il, o[nt][1] * il); ww.y = pk2(o[nt][2] * il, o[nt][3] * il); *(v2u*)(op + 16 * nt) = ww; }
        if (fq == 0) LSE[((size_t)g * T + (size_t)b * SEQ + tq) * 8 + h] = mx + logf(l);
    }
}
__device__ __forceinline__ void phase_combine(const Frame& F, const bf16* OG, const float* LSE, bf16* O) {
    for (int it0 = F.bid * 512 + F.tid; it0 < T * 64; it0 += 4 * F.G * 512) {
        float ls[4][3]; v4u og[4][3];
#pragma unroll
        for (int u = 0; u < 4; ++u) { int it = it0 + u * F.G * 512; it = it < T * 64 ? it : it0;
            const int c8 = it & 7, h = (it >> 3) & 7, t = it >> 6; const size_t off = (size_t)t * DILW + h * 64 + c8 * 8;
#pragma unroll
            for (int g = 0; g < 3; ++g) { ls[u][g] = LSE[((size_t)g * T + t) * 8 + h]; og[u][g] = *(const v4u*)(OG + (size_t)g * T * DILW + off); } }
#pragma unroll
        for (int u = 0; u < 4; ++u) asm volatile("" : "+v"(ls[u][0]), "+v"(ls[u][1]), "+v"(ls[u][2]), "+v"(og[u][0]), "+v"(og[u][1]), "+v"(og[u][2]));
#pragma unroll
        for (int u = 0; u < 4; ++u) { const int it = it0 + u * F.G * 512, c8 = it & 7, h = (it >> 3) & 7, t = it >> 6; const size_t off = (size_t)t * DILW + h * 64 + c8 * 8;
            if (it >= T * 64) continue;
            const float l0 = ls[u][0], l1 = ls[u][1], l2 = ls[u][2];
            const float m = fmaxf(l0, fmaxf(l1, l2)); float w0 = __expf(l0 - m), w1 = __expf(l1 - m), w2 = __expf(l2 - m); const float inv = 1.0f / (w0 + w1 + w2); w0 *= inv; w1 *= inv; w2 *= inv;
            float a[8], bq[8], c[8], o[8];
            unpack8(og[u][0], a); unpack8(og[u][1], bq); unpack8(og[u][2], c);
#pragma unroll
            for (int q = 0; q < 8; ++q) o[q] = w0 * a[q] + w1 * bq[q] + w2 * c[q];
            v4u ww; ww.x = pk2(o[0], o[1]); ww.y = pk2(o[2], o[3]); ww.z = pk2(o[4], o[5]); ww.w = pk2(o[6], o[7]);
            *(v4u*)(O + off) = ww; }
    }
}

constexpr int M1_LOG = 131072, M1_STAT = M1_LOG + 4096, M1_HIST = M1_STAT + 128, M1_BASE = M1_HIST + 256;
__device__ __forceinline__ void phase_moe1(const Frame& F, const float* Y, const float* gain, const float* bias, const float* RW, const float* RB,
                                           float* X1F, bf16* X1B, unsigned* cnt, int* ltok, float* lgate, int* eidx, int* inv) {
    LAS float* xs = (LAS float*)F.lds; LAS float* logit = (LAS float*)(F.lds + M1_LOG); LAS float* stat = (LAS float*)(F.lds + M1_STAT);
    LAS int* hist = (LAS int*)(F.lds + M1_HIST); LAS int* basep = (LAS int*)(F.lds + M1_BASE);
    const int tid = F.tid, lane = F.lane, w = F.wave;
    for (int rg = F.bid; rg < T / 16; rg += F.G) {
        const int row0 = rg * 16;
        __syncthreads();
#pragma unroll
        for (int j = 0; j < 16; ++j) { const int idx = tid + 512 * j; *(LAS f32x4*)(xs + idx * 4) = *(const f32x4*)(Y + (size_t)row0 * D + (size_t)idx * 4); }
        if (tid < 64) hist[tid] = 0;
        __syncthreads();
#pragma unroll
        for (int rr = 0; rr < 2; ++rr) { const int r = 2 * w + rr; float sm = 0.f;
#pragma unroll
            for (int j = 0; j < 32; ++j) sm += xs[r * D + lane + 64 * j];
            const float mean = wave_sum(sm, lane) * (1.0f / D); float sq = 0.f;
#pragma unroll
            for (int j = 0; j < 32; ++j) { const float d = xs[r * D + lane + 64 * j] - mean; sq += d * d; }
            const float rstd = 1.0f / sqrtf(wave_sum(sq, lane) * (1.0f / D) + LN_EPS);
            if (lane == 0) { stat[2 * r] = mean; stat[2 * r + 1] = rstd; } }
        __syncthreads();
#pragma unroll
        for (int j = 0; j < 16; ++j) { const int idx = tid + 512 * j, r = idx >> 9, c4 = (idx & 511) * 4;
            const f32x4 v = *(LAS f32x4*)(xs + idx * 4), gv = *(const f32x4*)(gain + c4), bv = *(const f32x4*)(bias + c4);
            const float mean = stat[2 * r], rstd = stat[2 * r + 1];
            const f32x4 o = (v - mean) * rstd * gv + bv;
            *(LAS f32x4*)(xs + idx * 4) = o;
            *(f32x4*)(X1F + (size_t)(row0 + r) * D + c4) = o;
            v2u wb; wb.x = pk2(o[0], o[1]); wb.y = pk2(o[2], o[3]); *(v2u*)(X1B + (size_t)(row0 + r) * D + c4) = wb; }
        __syncthreads();
        { const int r = tid >> 5, ep = tid & 31; float a0 = 0.f, a1 = 0.f; const float* wp = RW + 2 * ep; const LAS float* xr = xs + r * D;
            for (int k0 = 0; k0 < D; k0 += 16) {
                f32x2 wv[16];
#pragma unroll
                for (int j = 0; j < 16; ++j) wv[j] = *(const f32x2*)(wp + (size_t)(k0 + j) * NEXP);
                asm volatile("" : "+v"(wv[0]), "+v"(wv[1]), "+v"(wv[2]), "+v"(wv[3]), "+v"(wv[4]), "+v"(wv[5]), "+v"(wv[6]), "+v"(wv[7]));
                asm volatile("" : "+v"(wv[8]), "+v"(wv[9]), "+v"(wv[10]), "+v"(wv[11]), "+v"(wv[12]), "+v"(wv[13]), "+v"(wv[14]), "+v"(wv[15]));
#pragma unroll
                for (int j = 0; j < 16; ++j) { const float xv = xr[k0 + j]; a0 += xv * wv[j].x; a1 += xv * wv[j].y; } }
            logit[r * NEXP + 2 * ep] = a0; logit[r * NEXP + 2 * ep + 1] = a1; }
        __syncthreads();
        int sel_pos[2]; float sel_gate[2]; int sel_rank[2]; bool sel_on[2];
#pragma unroll
        for (int rr = 0; rr < 2; ++rr) { const int r = 2 * w + rr;
            const float sc = 1.0f / (1.0f + __expf(-logit[r * NEXP + lane])); const float ch = sc + RB[lane];
            int rk = 0;
#pragma unroll
            for (int j = 0; j < 8; ++j) { const float cj = shfl_from(ch, (lane & ~7) + j); rk += (cj > ch || (cj == ch && j < (lane & 7))) ? 1 : 0; }
            float gs = rk < 2 ? ch : 0.f; gs += shfl_x(gs, 1, lane); gs += shfl_x(gs, 2, lane); gs += shfl_x(gs, 4, lane);
            int grk = 0; const int g = lane >> 3;
#pragma unroll
            for (int hh = 0; hh < 8; ++hh) { const float gh = shfl_from(gs, 8 * hh); grk += (gh > gs || (gh == gs && hh < g)) ? 1 : 0; }
            const float msk = grk < 4 ? ch : -INFINITY;
            int erk = 0;
            for (int j = 0; j < 64; ++j) { const float mj = __builtin_bit_cast(float, __builtin_amdgcn_readlane(__builtin_bit_cast(int, msk), j)); erk += (mj > msk || (mj == msk && j < lane)) ? 1 : 0; }
            const bool on = erk < 8;
            const float ssum = wave_sum(on ? sc : 0.f, lane);
            sel_on[rr] = on; sel_rank[rr] = erk; sel_gate[rr] = sc / ssum * 2.5f; sel_pos[rr] = 0;
            if (on) sel_pos[rr] = __hip_atomic_fetch_add(&hist[lane], 1, __ATOMIC_RELAXED, __HIP_MEMORY_SCOPE_WORKGROUP); }
        __syncthreads();
        if (tid < 64) { const int hc = hist[tid]; int bs = 0; if (hc > 0) bs = (int)atomicAdd(&cnt[tid * 16], (unsigned)hc); basep[tid] = bs; }
        __syncthreads();
#pragma unroll
        for (int rr = 0; rr < 2; ++rr) if (sel_on[rr]) { const int t = row0 + 2 * w + rr, pos = basep[lane] + sel_pos[rr];
            ltok[(size_t)lane * CAP + pos] = t; lgate[(size_t)lane * CAP + pos] = sel_gate[rr];
            eidx[t * 8 + sel_rank[rr]] = lane; inv[t * 8 + sel_rank[rr]] = pos; }
    }
}
__device__ __forceinline__ int build_tiles(const Frame& F, const unsigned* cnt) {
    LAS int* tpref = (LAS int*)(F.lds + LDS_TAB); LAS int* cl = (LAS int*)(F.lds + LDS_TAB + 512);
    __syncthreads();
    if (F.tid < 64) {
        const int lane = F.lane; const int c = (int)__hip_atomic_load(&cnt[lane * 16], __ATOMIC_RELAXED, __HIP_MEMORY_SCOPE_AGENT);
        const int tl = (c + 255) >> 8; int inc = tl;
#pragma unroll
        for (int o = 1; o < 64; o <<= 1) { const int v = __builtin_amdgcn_ds_bpermute((lane >= o ? lane - o : lane) << 2, inc); inc += lane >= o ? v : 0; }
        cl[lane] = c; tpref[lane] = inc - tl;
        if (lane == 63) { tpref[64] = inc; tpref[65] = inc + T / 256; tpref[66] = inc + 2 * (T / 256); cl[64] = T; cl[65] = T; } }
    __syncthreads();
    return __builtin_amdgcn_readfirstlane(tpref[64]);
}
__device__ __forceinline__ void phase_moe4(const Frame& F, const float* Y2, const bf16* Yr, const int* eidx, const int* inv, const float* gain, const float* bias, float* XO, bf16* XBo) {
    const LAS int* tpref = (const LAS int*)(F.lds + LDS_TAB);
    const int gw = F.bid * 8 + F.wave, NGW = F.G * 8, lane = F.lane;
    for (int t = gw; t < T; t += NGW) {
        f32x4 v[8];
#pragma unroll
        for (int j = 0; j < 8; ++j) v[j] = *(const f32x4*)(Y2 + (size_t)t * D + 4 * lane + 256 * j);
        for (int k = 0; k < 8; ++k) { const int e = eidx[t * 8 + k], pos = inv[t * 8 + k]; const bf16* yr = Yr + (size_t)(tpref[e] * 256 + pos) * D + 4 * lane;
#pragma unroll
            for (int j = 0; j < 8; ++j) { const v2u w = *(const v2u*)(yr + 256 * j); v[j][0] += bflo(w.x); v[j][1] += bfhi(w.x); v[j][2] += bflo(w.y); v[j][3] += bfhi(w.y); } }
        float sm = 0.f;
#pragma unroll
        for (int j = 0; j < 8; ++j) sm += (v[j][0] + v[j][1]) + (v[j][2] + v[j][3]);
        const float mean = wave_sum(sm, lane) * (1.0f / D); float sq = 0.f;
#pragma unroll
        for (int j = 0; j < 8; ++j) { v[j] = v[j] - mean; sq += (v[j][0] * v[j][0] + v[j][1] * v[j][1]) + (v[j][2] * v[j][2] + v[j][3] * v[j][3]); }
        const float rstd = 1.0f / sqrtf(wave_sum(sq, lane) * (1.0f / D) + LN_EPS);
#pragma unroll
        for (int j = 0; j < 8; ++j) { const int c = 4 * lane + 256 * j; const f32x4 o = v[j] * rstd * *(const f32x4*)(gain + c) + *(const f32x4*)(bias + c);
            *(f32x4*)(XO + (size_t)t * D + c) = o;
            v2u wb; wb.x = pk2(o[0], o[1]); wb.y = pk2(o[2], o[3]); *(v2u*)(XBo + (size_t)t * D + c) = wb; }
    }
}


template <int CTRL> __device__ __forceinline__ float dppf(float x) { return __builtin_bit_cast(float, __builtin_amdgcn_update_dpp(0, __builtin_bit_cast(int, x), CTRL, 0xF, 0xF, false)); }
__device__ __forceinline__ float gmax8(float x) { x = fmaxf(x, dppf<0xB1>(x)); x = fmaxf(x, dppf<0x4E>(x)); x = fmaxf(x, dppf<0x141>(x)); return x; }
__device__ __forceinline__ float gsum8(float x) { x += dppf<0xB1>(x); x += dppf<0x4E>(x); x += dppf<0x141>(x); return x; }
__device__ __forceinline__ float rl_f(float x, int l) { return __builtin_bit_cast(float, __builtin_amdgcn_readlane(__builtin_bit_cast(int, x), l)); }
constexpr int M1_P = 0, M1N_HIST = 131072, M1N_BASE = 131072 + 256, M1N_GB = 131072 + 1024;
__device__ __forceinline__ void phase_moe1n(const Frame& F, const bf16* Y, const float* pst, const float* gain, const float* bias, const bf16* WH, const bf16* WL, const float* RB,
                                            bf16* X1B, float* ST1, unsigned* cnt, int* ltok, float* lgate, int* eidx, int* inv) {
    LAS float* P = (LAS float*)(F.lds + M1_P); LAS int* hist = (LAS int*)(F.lds + M1N_HIST); LAS int* basep = (LAS int*)(F.lds + M1N_BASE);
    const int tid = F.tid, lane = F.lane, w = F.wave, r = lane & 15, q = lane >> 4;
    for (int item = F.bid; item < T / 64; item += F.G) {
        const int row0 = item * 64;
        __syncthreads();
        { int t0 = tid; asm volatile("" : "+v"(t0));
          if (t0 < 64) hist[t0] = 0;
          LAS f32x4* gb = (LAS f32x4*)(F.lds + M1N_GB); gb[t0] = *(const f32x4*)(gain + 4 * t0); gb[512 + t0] = *(const f32x4*)(bias + 4 * t0); }
        __syncthreads();
        float mean[4], rstd[4];
#pragma unroll
        for (int rt = 0; rt < 4; ++rt) { const int row = row0 + 16 * rt + r;
          const f32x4* pp = (const f32x4*)(pst + ((size_t)row * 32 + q * 8) * 2); const f32x4 a = pp[0], b = pp[1], c = pp[2], d = pp[3];
          float sm = (a[0] + a[2]) + (b[0] + b[2]) + (c[0] + c[2]) + (d[0] + d[2]), sq = (a[1] + a[3]) + (b[1] + b[3]) + (c[1] + c[3]) + (d[1] + d[3]);
          sm += shfl_x(sm, 16, lane); sm += shfl_x(sm, 32, lane); sq += shfl_x(sq, 16, lane); sq += shfl_x(sq, 32, lane);
          mean[rt] = sm * (1.0f / D); const float var = fmaxf(sq * (1.0f / D) - mean[rt] * mean[rt], 0.f); rstd[rt] = 1.0f / sqrtf(var + LN_EPS);
          if (w == 0 && q == 0) *(f32x2*)(ST1 + 2 * row) = (f32x2){mean[rt], rstd[rt]}; }
        const int kb = 256 * w + 8 * q;
        const LAS float* gl = (const LAS float*)(F.lds + M1N_GB) + kb;
        f32x4 acc[4][4];
#pragma unroll
        for (int rt = 0; rt < 4; ++rt)
#pragma unroll
            for (int nt = 0; nt < 4; ++nt) acc[rt][nt] = (f32x4){0.f, 0.f, 0.f, 0.f};
        v4u yb[2][2][4], hb[4]; bf16x8 wh[4], wl[4];
        unsigned vo[4];
#pragma unroll
        for (int i = 0; i < 4; ++i) { vo[i] = (unsigned)(r * D + kb) * 2u + (unsigned)i * (16u * D * 2u); asm volatile("" : "+v"(vo[i])); }
        const char* ybase = (const char*)(Y + (size_t)row0 * D); char* xbase = (char*)(X1B + (size_t)row0 * D);
#define M1_LOADY(ms) do { _Pragma("unroll") for (int hf = 0; hf < 2; ++hf) _Pragma("unroll") for (int rt = 0; rt < 4; ++rt) yb[(ms) & 1][hf][rt] = *(const v4u*)(ybase + vo[rt] + 128 * (ms) + 64 * hf); } while (0)
#define M1_LOADW(st) do { _Pragma("unroll") for (int nt = 0; nt < 4; ++nt) { wh[nt] = *(const bf16x8*)((const char*)WH + vo[nt] + 64 * (st)); wl[nt] = *(const bf16x8*)((const char*)WL + vo[nt] + 64 * (st)); } } while (0)
        M1_LOADY(0); M1_LOADW(0); M1_LOADY(1);
        __builtin_amdgcn_sched_barrier(0);
#pragma unroll
        for (int st = 0; st < 8; ++st) {
            const f32x4 g0 = *(const LAS f32x4*)(gl + 32 * st), g1 = *(const LAS f32x4*)(gl + 32 * st + 4), b0 = *(const LAS f32x4*)(gl + 2048 + 32 * st), b1 = *(const LAS f32x4*)(gl + 2048 + 32 * st + 4);
#pragma unroll
            for (int rt = 0; rt < 4; ++rt) { const v4u yv = yb[(st >> 1) & 1][st & 1][rt];
                const f32x4 y0_ = (f32x4){bflo(yv.x), bfhi(yv.x), bflo(yv.y), bfhi(yv.y)}, y1_ = (f32x4){bflo(yv.z), bfhi(yv.z), bflo(yv.w), bfhi(yv.w)};
                const f32x4 x0 = (y0_ - mean[rt]) * rstd[rt] * g0 + b0, x1 = (y1_ - mean[rt]) * rstd[rt] * g1 + b1;
                v4u h; h.x = cvt_pk_bf16(x0[0], x0[1]); h.y = cvt_pk_bf16(x0[2], x0[3]); h.z = cvt_pk_bf16(x1[0], x1[1]); h.w = cvt_pk_bf16(x1[2], x1[3]);
                if ((st & 1) == 0) hb[rt] = h; else { *(v4u*)(xbase + vo[rt] + 64 * (st - 1)) = hb[rt]; *(v4u*)(xbase + vo[rt] + 64 * st) = h; }
                v4u l; l.x = cvt_pk_bf16(x0[0] - bflo(h.x), x0[1] - bfhi(h.x)); l.y = cvt_pk_bf16(x0[2] - bflo(h.y), x0[3] - bfhi(h.y));
                l.z = cvt_pk_bf16(x1[0] - bflo(h.z), x1[1] - bfhi(h.z)); l.w = cvt_pk_bf16(x1[2] - bflo(h.w), x1[3] - bfhi(h.w));
                const bf16x8 xh = __builtin_bit_cast(bf16x8, h), xl = __builtin_bit_cast(bf16x8, l);
#pragma unroll
                for (int nt = 0; nt < 4; ++nt) { acc[rt][nt] = __builtin_amdgcn_mfma_f32_16x16x32_bf16(xh, wh[nt], acc[rt][nt], 0, 0, 0);
                    acc[rt][nt] = __builtin_amdgcn_mfma_f32_16x16x32_bf16(xl, wh[nt], acc[rt][nt], 0, 0, 0); acc[rt][nt] = __builtin_amdgcn_mfma_f32_16x16x32_bf16(xh, wl[nt], acc[rt][nt], 0, 0, 0); } }
            __builtin_amdgcn_sched_barrier(0);
            if (st + 1 < 8) M1_LOADW(st + 1);
            if ((st & 1) == 1 && (st >> 1) + 2 < 4) M1_LOADY((st >> 1) + 2);
            __builtin_amdgcn_sched_barrier(0);
        }
#undef M1_LOADY
#undef M1_LOADW
#pragma unroll
        for (int rt = 0; rt < 4; ++rt)
#pragma unroll
            for (int nt = 0; nt < 4; ++nt)
#pragma unroll
                for (int i = 0; i < 4; ++i) P[(w * 64 + 16 * rt + 4 * q + i) * 64 + 16 * nt + r] = acc[rt][nt][i];
        __syncthreads();
        const float rb = RB[lane];
        LAS int* Pi = (LAS int*)P;
#pragma unroll 1
        for (int rr = 0; rr < 8; ++rr) { const int rl = 8 * w + rr;
            float lg = ((P[rl * 64 + lane] + P[(64 + rl) * 64 + lane]) + (P[(128 + rl) * 64 + lane] + P[(192 + rl) * 64 + lane])) + ((P[(256 + rl) * 64 + lane] + P[(320 + rl) * 64 + lane]) + (P[(384 + rl) * 64 + lane] + P[(448 + rl) * 64 + lane]));
            lg = (lg == lg) ? lg : -1.0e30f;
            const float sc = 1.0f / (1.0f + __expf(-lg)); const float ch = sc + rb;
            const float m1 = gmax8(ch), neq = gsum8(ch == m1 ? 1.f : 0.f), m2c = gmax8(ch < m1 ? ch : -INFINITY);
            const float gs = m1 + (neq >= 2.f ? m1 : m2c);
            int grk = 0; const int g = lane >> 3;
#pragma unroll
            for (int hh = 0; hh < 8; ++hh) { const float gh = rl_f(gs, 8 * hh); grk += (gh > gs || (gh == gs && hh < g)) ? 1 : 0; }
            const float msk = grk < 4 ? ch : -INFINITY;
            float cur = msk, ssum = 0.f; int erk = 64;
#pragma unroll 1
            for (int k = 0; k < 8; ++k) {
                float rm = gmax8(cur); rm = fmaxf(rm, dppf<0x140>(rm));
                const float wm = fmaxf(fmaxf(rl_f(rm, 0), rl_f(rm, 16)), fmaxf(rl_f(rm, 32), rl_f(rm, 48)));
                const unsigned long long bal = __builtin_amdgcn_ballot_w64(cur == wm);
                const int lsel = __builtin_amdgcn_readfirstlane((int)__builtin_ctzll(bal));
                ssum += rl_f(sc, lsel);
                const bool me = lane == lsel; erk = me ? k : erk; cur = me ? -INFINITY : cur; }
            const bool on = erk < 8;
            int pk_ = -1; if (on) pk_ = __hip_atomic_fetch_add(&hist[lane], 1, __ATOMIC_RELAXED, __HIP_MEMORY_SCOPE_WORKGROUP) | (erk << 16);
            P[rl * 64 + lane] = sc / ssum * 2.5f; Pi[(64 + rl) * 64 + lane] = pk_; }
        __syncthreads();
        if (tid < 64) { int tt = tid; asm volatile("" : "+v"(tt));
            const int hc = hist[tt]; int bs = 0; if (hc > 0) bs = (int)atomicAdd(&cnt[tt * 16], (unsigned)hc); basep[tt] = bs; }
        __syncthreads();
        { const int bl = basep[lane];
#pragma unroll 1
          for (int rr = 0; rr < 8; ++rr) { const int rl = 8 * w + rr; const int pk_ = Pi[(64 + rl) * 64 + lane]; const float gt_ = P[rl * 64 + lane];
            if (pk_ >= 0) { const int t = row0 + rl, pos = bl + (pk_ & 0xffff), rk_ = pk_ >> 16;
                ltok[(size_t)lane * CAP + pos] = t * 8 + rk_; lgate[(size_t)lane * CAP + pos] = gt_;
                eidx[t * 8 + rk_] = lane; inv[t * 8 + rk_] = pos; } } }
    }
}

constexpr int M3_PL = 131072, M3_CNT = 147456, M3_OFF = 147456 + 272;
__device__ __forceinline__ void phase_moe3n(const Frame& F, const bf16* H, const bf16* HSp, const int* eidx, const bf16* WD, const bf16* WSD,
                                            const float* Y1, const float* ST1, const float* g1, const float* b1, float* Y2, float* PST2) {
    LAS int* out = (LAS int*)F.lds; LAS unsigned short* plist = (LAS unsigned short*)(F.lds + M3_PL); LAS int* cnt = (LAS int*)(F.lds + M3_CNT); LAS int* off = (LAS int*)(F.lds + M3_OFF);
    const int tid = F.tid, lane = F.lane, w = F.wave, r = lane & 15, q = lane >> 4;
    for (int u = F.bid; u < 1024; u += F.G) {
        int nc = (u & 7) | ((u >> 7) << 3), tb = (u >> 3) & 15;
        if (F.G == 256) { const int i = u >> 8, x = u & 7, j = (u >> 3) & 31; tb = 2 * x + (i >> 1); nc = 32 * (i & 1) + j; }
        __syncthreads();
#pragma unroll
        for (int j = 0; j < 16; ++j) ((LAS v4u*)out)[tid + 512 * j] = (v4u){0u, 0u, 0u, 0u};
        if (tid < 66) cnt[tid] = 0;
        __syncthreads();
        int ee[16], pp[16];
        { const v4u* ep = (const v4u*)(eidx + ((size_t)tb * 1024 + 2 * tid) * 8); const v4u e0 = ep[0], e1 = ep[1], e2 = ep[2], e3 = ep[3];
          ee[0] = e0.x; ee[1] = e0.y; ee[2] = e0.z; ee[3] = e0.w; ee[4] = e1.x; ee[5] = e1.y; ee[6] = e1.z; ee[7] = e1.w;
          ee[8] = e2.x; ee[9] = e2.y; ee[10] = e2.z; ee[11] = e2.w; ee[12] = e3.x; ee[13] = e3.y; ee[14] = e3.z; ee[15] = e3.w; }
#pragma unroll
        for (int j = 0; j < 16; ++j) pp[j] = __hip_atomic_fetch_add(&cnt[ee[j]], 1, __ATOMIC_RELAXED, __HIP_MEMORY_SCOPE_WORKGROUP);
        __syncthreads();
        if (w == 0) { int c = cnt[lane], x = c;
#pragma unroll
            for (int o = 1; o < 64; o <<= 1) { const int y = __builtin_amdgcn_ds_bpermute(((lane - o) & 63) << 2, x); if (lane >= o) x += y; }
            off[lane] = x - c; if (lane == 63) off[64] = x; }
        __syncthreads();
#pragma unroll
        for (int j = 0; j < 16; ++j) plist[off[ee[j]] + pp[j]] = (unsigned short)(tid * 16 + j);
        __syncthreads();
        const char* Hb = (const char*)H + (size_t)tb * 8192 * 256 + q * 16;
        const char* HSb = (const char*)HSp + (size_t)tb * 1024 * 512 + q * 16;
        const char* Bb = (const char*)WD + ((size_t)nc * 32 + r) * 256 + q * 16;
        const char* BSb = (const char*)WSD + ((size_t)nc * 32 + r) * 512 + q * 16;
#define M3_NR(sg) ((sg) < 8 ? __builtin_amdgcn_readfirstlane(cnt[w + 8 * (sg)]) : 128)
#define M3_RB(sg) ((sg) < 8 ? __builtin_amdgcn_readfirstlane(off[w + 8 * (sg)]) : 0)
#define M3_GLD(dst, ptr, OFF) asm volatile("global_load_dwordx4 %0, %1, off offset:" #OFF : "=&v"(dst) : "v"(ptr) : "memory")
#define M3_LOADB(dst, sg) do { const char* _b0 = (sg) < 8 ? Bb + (size_t)(w + 8 * (sg)) * 524288 : BSb + ((sg) - 8) * 256; const char* _b1 = _b0 + ((sg) < 8 ? 4096 : 8192); \
            M3_GLD(dst[0][0], _b0, 0); M3_GLD(dst[0][1], _b0, 64); M3_GLD(dst[0][2], _b0, 128); M3_GLD(dst[0][3], _b0, 192); \
            M3_GLD(dst[1][0], _b1, 0); M3_GLD(dst[1][1], _b1, 64); M3_GLD(dst[1][2], _b1, 128); M3_GLD(dst[1][3], _b1, 192); } while (0)
#define M3_LOADA(dst, sg, bb, nr, rbs) do { int _i = 16 * (bb) + r; _i = _i < (nr) ? _i : (nr) - 1; const unsigned _rid = plist[(rbs) + _i]; \
            const char* _a = (sg) < 8 ? Hb + (size_t)_rid * 256 : ((sg) < 10 ? HSb + (size_t)(128 * w + _i) * 512 + ((sg) - 8) * 256 : Hb); \
            M3_GLD(dst[0], _a, 0); M3_GLD(dst[1], _a, 64); M3_GLD(dst[2], _a, 128); M3_GLD(dst[3], _a, 192); } while (0)
#define M3_ADV(sg, bb, nr, rbs) do { if ((sg) < 10) { ++(bb); if ((bb) * 16 >= (nr)) { (bb) = 0; do { ++(sg); } while ((sg) < 8 && M3_NR(sg) == 0); if ((sg) < 10) { (nr) = M3_NR(sg); (rbs) = M3_RB(sg); } } } } while (0)
#define M3_WAITA(AS) asm volatile("s_waitcnt vmcnt(12)" : "+v"(AS[0]), "+v"(AS[1]), "+v"(AS[2]), "+v"(AS[3]) :: "memory")
#define M3_WAITB(N) asm volatile("s_waitcnt vmcnt(" #N ")" : "+v"(Bn[0][0]), "+v"(Bn[0][1]), "+v"(Bn[0][2]), "+v"(Bn[0][3]), "+v"(Bn[1][0]), "+v"(Bn[1][1]), "+v"(Bn[1][2]), "+v"(Bn[1][3]) :: "memory")
#define M3_STEP(AS) if (cseg < 10) { \
              \
            int tk[4]; bool ok[4]; unsigned pl[4]; const int rt_ = cseg < 8; \
            _Pragma("unroll") for (int i = 0; i < 4; ++i) { const int idx = 16 * cbt + 4 * q + i; ok[i] = idx < cnr; const int ic = ok[i] ? idx : cnr - 1; pl[i] = plist[crbs + ic]; tk[i] = 128 * w + ic; } \
            _Pragma("unroll") for (int i = 0; i < 4; ++i) tk[i] = rt_ ? (int)(pl[i] >> 3) : tk[i]; \
            M3_WAITA(AS); \
            f32x4 acc[2]; \
            _Pragma("unroll") for (int nt = 0; nt < 2; ++nt) { acc[nt] = (f32x4){0.f, 0.f, 0.f, 0.f}; \
                _Pragma("unroll") for (int kk = 0; kk < 4; ++kk) acc[nt] = __builtin_amdgcn_mfma_f32_16x16x32_bf16(__builtin_bit_cast(bf16x8, AS[kk]), __builtin_bit_cast(bf16x8, Bc[nt][kk]), acc[nt], 0, 0, 0); } \
              \
            _Pragma("unroll") for (int i = 0; i < 4; ++i) { const long long lo_ = ok[i] ? (long long)__float2int_rn(acc[0][i] * 4194304.0f) : 0ll, hi_ = ok[i] ? (long long)__float2int_rn(acc[1][i] * 4194304.0f) : 0ll; \
                (void)__hip_atomic_fetch_add((LAS unsigned long long*)out + tk[i] * 16 + r, (unsigned long long)((hi_ << 32) + lo_), __ATOMIC_RELAXED, __HIP_MEMORY_SCOPE_WORKGROUP); } \
            M3_LOADA(AS, pseg, pbt, pnr, prbs); M3_ADV(pseg, pbt, pnr, prbs); \
            { const int old_ = cseg, nbat_ = (cnr + 15) >> 4; M3_ADV(cseg, cbt, cnr, crbs); \
              if (cseg != old_ && cseg < 10) { \
                  if (nbat_ == 1) M3_WAITB(4); else if (nbat_ == 2) M3_WAITB(8); else if (nbat_ == 3) M3_WAITB(12); else M3_WAITB(16); \
                  _Pragma("unroll") for (int nt = 0; nt < 2; ++nt) _Pragma("unroll") for (int kk = 0; kk < 4; ++kk) Bc[nt][kk] = Bn[nt][kk]; \
                  int nb_ = cseg; do { ++nb_; } while (nb_ < 8 && M3_NR(nb_) == 0); if (nb_ >= 10) nb_ = 9; M3_LOADB(Bn, nb_); } } }
        int cseg = -1, cbt = 0, cnr = 0, crbs = 0;
        do { ++cseg; } while (cseg < 8 && M3_NR(cseg) == 0);
        cnr = M3_NR(cseg); crbs = M3_RB(cseg);
        int pseg = cseg, pbt = 0, pnr = cnr, prbs = crbs;
        v4u Bc[2][4], Bn[2][4], A0[4], A1[4], A2[4], A3[4];
        M3_LOADB(Bc, cseg);
        M3_LOADA(A0, pseg, pbt, pnr, prbs); M3_ADV(pseg, pbt, pnr, prbs);
        M3_LOADA(A1, pseg, pbt, pnr, prbs); M3_ADV(pseg, pbt, pnr, prbs);
        M3_LOADA(A2, pseg, pbt, pnr, prbs); M3_ADV(pseg, pbt, pnr, prbs);
        M3_LOADA(A3, pseg, pbt, pnr, prbs); M3_ADV(pseg, pbt, pnr, prbs);
        { int nb_ = cseg; do { ++nb_; } while (nb_ < 8 && M3_NR(nb_) == 0); if (nb_ >= 10) nb_ = 9; M3_LOADB(Bn, nb_); }
        asm volatile("s_waitcnt vmcnt(0)" : "+v"(Bc[0][0]), "+v"(Bc[0][1]), "+v"(Bc[0][2]), "+v"(Bc[0][3]), "+v"(Bc[1][0]), "+v"(Bc[1][1]), "+v"(Bc[1][2]), "+v"(Bc[1][3]) :: "memory");
#pragma unroll 1
        while (cseg < 10) { M3_STEP(A0) M3_STEP(A1) M3_STEP(A2) M3_STEP(A3) }
        asm volatile("s_waitcnt vmcnt(0)" : "+v"(A0[0]), "+v"(A0[1]), "+v"(A0[2]), "+v"(A0[3]), "+v"(A1[0]), "+v"(A1[1]), "+v"(A1[2]), "+v"(A1[3]), "+v"(A2[0]), "+v"(A2[1]), "+v"(A2[2]), "+v"(A2[3]),
                     "+v"(A3[0]), "+v"(A3[1]), "+v"(A3[2]), "+v"(A3[3]), "+v"(Bn[0][0]), "+v"(Bn[0][1]), "+v"(Bn[0][2]), "+v"(Bn[0][3]), "+v"(Bn[1][0]), "+v"(Bn[1][1]), "+v"(Bn[1][2]), "+v"(Bn[1][3]) :: "memory");
#undef M3_NR
#undef M3_RB
#undef M3_GLD
#undef M3_LOADB
#undef M3_LOADA
#undef M3_ADV
#undef M3_WAITA
#undef M3_WAITB
#undef M3_STEP
        __syncthreads();
        { const int c4 = lane & 7, rs = lane >> 3, col = nc * 32 + 4 * c4;
          const f32x4 gv = *(const f32x4*)(g1 + col), bv = *(const f32x4*)(b1 + col);
#pragma unroll 4
          for (int it = 0; it < 16; ++it) { const int rl = 128 * w + 8 * it + rs; const size_t row = (size_t)tb * 1024 + rl;
              const f32x4 yv = *(const f32x4*)(Y1 + row * D + col); const f32x2 sv = *(const f32x2*)(ST1 + 2 * row);
              f32x4 tv; { const int nt = c4 >> 2, r0 = (4 * c4) & 15;
#pragma unroll
                  for (int j = 0; j < 4; ++j) { const v2u cell = *(const LAS v2u*)(out + rl * 32 + 2 * (r0 + j)); const int lo = (int)cell.x, hi = (int)cell.y + (lo < 0 ? 1 : 0); tv[j] = (float)(nt ? hi : lo) * (1.0f / 4194304.0f); } }
              const f32x4 y = ((yv - sv.x) * sv.y * gv + bv) * ALPHA + tv;
              *(f32x4*)(Y2 + row * D + col) = y;
              float sm = (y[0] + y[1]) + (y[2] + y[3]), sq = (y[0] * y[0] + y[1] * y[1]) + (y[2] * y[2] + y[3] * y[3]);
#pragma unroll
              for (int o = 1; o < 8; o <<= 1) { sm += shfl_x(sm, o, lane); sq += shfl_x(sq, o, lane); }
              if (c4 == 0) *(f32x2*)(PST2 + (row * 64 + nc) * 2) = (f32x2){sm, sq}; } }
    }
}

__device__ __forceinline__ void phase_moe4n(const Frame& F, const float* Y2, const float* pst, const float* gain, const float* bias, float* ST2, bf16* XBo, float* OUT, int last) {
    const int gw = F.bid * 8 + F.wave, NGW = F.G * 8, lane = F.lane;
    for (int t = gw; t < T; t += NGW) {
        f32x4 v[8];
#pragma unroll
        for (int j = 0; j < 8; ++j) v[j] = *(const f32x4*)(Y2 + (size_t)t * D + 4 * lane + 256 * j);
        const f32x2 pv = *(const f32x2*)(pst + ((size_t)t * 64 + lane) * 2);
        const float mean = wave_sum(pv.x, lane) * (1.0f / D); const float var = fmaxf(wave_sum(pv.y, lane) * (1.0f / D) - mean * mean, 0.f); const float rstd = 1.0f / sqrtf(var + LN_EPS);
        if (lane == 0) *(f32x2*)(ST2 + 2 * (size_t)t) = (f32x2){mean, rstd};
#pragma unroll
        for (int j = 0; j < 8; ++j) { const int c = 4 * lane + 256 * j; const f32x4 o = (v[j] - mean) * rstd * *(const f32x4*)(gain + c) + *(const f32x4*)(bias + c);
            if (last) *(f32x4*)(OUT + (size_t)t * D + c) = o;
            else { v2u wb; wb.x = pk2(o[0], o[1]); wb.y = pk2(o[2], o[3]); *(v2u*)(XBo + (size_t)t * D + c) = wb; } }
    }
}


__device__ __forceinline__ void phase_moe4q(const Frame& F, const bf16* X1, bf16* Y2, const unsigned char* Yq, const float* Ysc, const int* eidx, const int* inv, const float* gain, const float* bias, float* ST2, bf16* XBo, float* OUT, int last) {
    const LAS int* tpref = (const LAS int*)(F.lds + LDS_TAB);
    const int gw = F.bid * 8 + F.wave, NGW = F.G * 8, lane = F.lane;
    { LAS f32x4* gb = (LAS f32x4*)(F.lds + 0); int t0 = F.tid; asm volatile("" : "+v"(t0)); gb[t0] = *(const f32x4*)(gain + 4 * t0); gb[512 + t0] = *(const f32x4*)(bias + 4 * t0); }
    __syncthreads();
    const LAS float* gl = (const LAS float*)(F.lds + 0);
    int en = 0, pn = 0; if (lane < 8 && gw < T) { en = eidx[gw * 8 + lane]; pn = inv[gw * 8 + lane]; }
    for (int t = gw; t < T; t += NGW) {
        int rowi = 0; if (lane < 8) rowi = tpref[en] * 256 + pn; else if (lane < 10) rowi = tpref[56 + lane] * 256 + t;
        if (lane < 8 && t + NGW < T) { en = eidx[(t + NGW) * 8 + lane]; pn = inv[(t + NGW) * 8 + lane]; }
        v4u pv[2][2], yv[10][2]; float sc[10][2];
#pragma unroll
        for (int j = 0; j < 2; ++j) { pv[j][0] = __builtin_nontemporal_load((const v4u*)(X1 + (size_t)t * D + 16 * lane + 1024 * j)); pv[j][1] = __builtin_nontemporal_load((const v4u*)(X1 + (size_t)t * D + 16 * lane + 1024 * j + 8)); }
#pragma unroll
        for (int k = 0; k < 10; ++k) { const size_t row = (size_t)__builtin_amdgcn_readlane(rowi, k);
#pragma unroll
            for (int j = 0; j < 2; ++j) { yv[k][j] = __builtin_nontemporal_load((const v4u*)(Yq + row * D + 16 * lane + 1024 * j)); sc[k][j] = __builtin_nontemporal_load(Ysc + row * 16 + 8 * j + (lane >> 3)); } }
#pragma unroll
        for (int k = 0; k < 10; ++k) asm volatile("" : "+v"(yv[k][0]), "+v"(yv[k][1]), "+v"(sc[k][0]), "+v"(sc[k][1]));
        float v[2][16];
#pragma unroll
        for (int j = 0; j < 2; ++j) { float f0[8], f1[8]; unpack8(pv[j][0], f0); unpack8(pv[j][1], f1);
            const float ss = (((sc[0][j] + sc[1][j]) + (sc[2][j] + sc[3][j])) + ((sc[4][j] + sc[5][j]) + (sc[6][j] + sc[7][j]))) + (sc[8][j] + sc[9][j]);
#pragma unroll
            for (int i = 0; i < 8; ++i) { v[j][i] = ALPHA * f0[i] - 128.f * ss; v[j][8 + i] = ALPHA * f1[i] - 128.f * ss; } }
#pragma unroll
        for (int k = 0; k < 10; ++k)
#pragma unroll
            for (int j = 0; j < 2; ++j) { const float s_ = sc[k][j]; const unsigned q[4] = {yv[k][j].x, yv[k][j].y, yv[k][j].z, yv[k][j].w};
#pragma unroll
                for (int d = 0; d < 4; ++d) { v[j][4 * d + 0] += s_ * (float)(q[d] & 0xffu); v[j][4 * d + 1] += s_ * (float)((q[d] >> 8) & 0xffu); v[j][4 * d + 2] += s_ * (float)((q[d] >> 16) & 0xffu); v[j][4 * d + 3] += s_ * (float)(q[d] >> 24); } }
        float sm = 0.f;
#pragma unroll
        for (int j = 0; j < 2; ++j)
#pragma unroll
            for (int i = 0; i < 16; i += 4) sm += (v[j][i] + v[j][i + 1]) + (v[j][i + 2] + v[j][i + 3]);
        const float mean = wave_sum(sm, lane) * (1.0f / D); float sq = 0.f;
#pragma unroll
        for (int j = 0; j < 2; ++j)
#pragma unroll
            for (int i = 0; i < 16; ++i) { const float d = v[j][i] - mean; sq += d * d; }
        const float rstd = 1.0f / sqrtf(wave_sum(sq, lane) * (1.0f / D) + LN_EPS);
        (void)ST2; (void)Y2;
#pragma unroll
        for (int j = 0; j < 2; ++j)
#pragma unroll
            for (int h = 0; h < 2; ++h) { const int c = 16 * lane + 1024 * j + 8 * h; const float* vv = &v[j][8 * h];
                const f32x4 g0 = *(const LAS f32x4*)(gl + c), g1 = *(const LAS f32x4*)(gl + c + 4), b0 = *(const LAS f32x4*)(gl + 2048 + c), b1 = *(const LAS f32x4*)(gl + 2048 + c + 4);
                const f32x4 o0 = ((f32x4){vv[0], vv[1], vv[2], vv[3]} - mean) * rstd * g0 + b0, o1 = ((f32x4){vv[4], vv[5], vv[6], vv[7]} - mean) * rstd * g1 + b1;
                if (last) { *(f32x4*)(OUT + (size_t)t * D + c) = o0; *(f32x4*)(OUT + (size_t)t * D + c + 4) = o1; }
                else { v4u wb; wb.x = pk2(o0[0], o0[1]); wb.y = pk2(o0[2], o0[3]); wb.z = pk2(o1[0], o1[1]); wb.w = pk2(o1[2], o1[3]); *(v4u*)(XBo + (size_t)t * D + c) = wb; } }
    }
}

__device__ __forceinline__ void phase_downproj3(const Frame& F, const bf16* H, const bf16* WD, const bf16* HSp, const bf16* WSD, unsigned char* Yq, float* Ysc, int NT) {
    const LAS int* tpref = (const LAS int*)(F.lds + LDS_TAB); const LAS int* cl = (const LAS int*)(F.lds + LDS_TAB + 512);
    LAS unsigned char* lds = F.lds;
    const int tid = F.tid, lane = F.lane, w = F.wave, fr = lane & 15, fq = lane >> 4;
    unsigned rbB[2], cbB[2];
#pragma unroll
    for (int i = 0; i < 2; ++i) { int R_, C_; g8::stage_rc(tid * 16 + i * 8192, R_, C_); rbB[i] = (unsigned)((R_ & ~31) + g8::perm32(R_ & 31)); cbB[i] = (unsigned)C_ * 2u; }
    const unsigned ldsw = (unsigned)w * 1024u, lbase = (unsigned)(size_t)lds;
    int boffg[4];
#pragma unroll
    for (int g = 0; g < 4; ++g) boffg[g] = g8::lds_byte(32 * g + fr, fq * 8);
    LAS unsigned char* stg = lds + 65536 + w * (32 * 144);
    const int NU = NT * 4;
    const int upos = (F.G % 8) == 0 ? (F.bid & 7) * (F.G >> 3) + (F.bid >> 3) : F.bid;
    int ub = 0;
    int u = (F.G <= NU) ? upos : F.bid; if (u >= NU) return;
#define DP3_UNITINFO(uu, E0, EXP, NV) do { const int tl_ = (uu) >> 2; int e_ = (E0); while (__builtin_amdgcn_readfirstlane(tpref[e_ + 1]) <= tl_) ++e_; EXP = e_; \
        NV = __builtin_amdgcn_readfirstlane(cl[e_]) - (tl_ - __builtin_amdgcn_readfirstlane(tpref[e_])) * 256; } while (0)
#define DP3_GLDS(gsrc, ldsdst) do { unsigned keep_; asm volatile("s_mov_b32 %0, m0\n\ts_mov_b32 m0, %2\n\ts_nop 0\n\tglobal_load_lds_dwordx4 %1, off\n\ts_mov_b32 m0, %0" : "=&s"(keep_) : "v"(gsrc), "s"(ldsdst) : "memory"); } while (0)
#define DP3_STAGE(slot, gb, bs) do { const unsigned v0_ = rbB[0] * (unsigned)(bs) + cbB[0], v1_ = rbB[1] * (unsigned)(bs) + cbB[1]; _Pragma("unroll") for (int kt = 0; kt < 2; ++kt) { \
        DP3_GLDS((const void*)((gb) + kt * 128 + v0_), lbase + (unsigned)((slot) * 32768 + kt * 16384) + ldsw); \
        DP3_GLDS((const void*)((gb) + kt * 128 + v1_), lbase + (unsigned)((slot) * 32768 + kt * 16384) + ldsw + 8192u); } } while (0)
#define DP3_SRC(uu, ee, AB, AS, BB, BS) do { const int tl_ = (uu) >> 2, cu_ = ((uu) & 3) * 512; \
        if ((ee) < 64) { AB = (const char*)(H + (size_t)tl_ * 256 * EDIM); AS = EDIM * 2; BB = (const char*)(WD + (size_t)(ee) * D * EDIM + (size_t)cu_ * EDIM); BS = EDIM * 2; } \
        else { const int t0_ = (tl_ - __builtin_amdgcn_readfirstlane(tpref[ee])) * 256; AB = (const char*)(HSp + (size_t)t0_ * SDIM + ((ee) - 64) * EDIM); AS = SDIM * 2; \
               BB = (const char*)(WSD + (size_t)cu_ * SDIM + ((ee) - 64) * EDIM); BS = SDIM * 2; } } while (0)
    int ecur, nvcur; DP3_UNITINFO(u, 0, ecur, nvcur);
    const char* abc; const char* gbc; int asc, bsc; DP3_SRC(u, ecur, abc, asc, gbc, bsc);
    bf16x8 A[2][4], An[2][4];
    { const char* ap_ = abc + (size_t)(32 * w + fr) * asc + 16 * fq;
#pragma unroll
      for (int m = 0; m < 2; ++m)
#pragma unroll
          for (int kk = 0; kk < 4; ++kk) A[m][kk] = *(const bf16x8*)(ap_ + (size_t)m * 16 * asc + 64 * kk); }
    DP3_STAGE(0, gbc, bsc);
    asm volatile("s_waitcnt vmcnt(0)" ::: "memory");
#pragma unroll 1
    for (;;) {
        int un = u; { const int nb = ub + F.G; if (nb + F.G <= NU) un = nb + upos; else if (nb + F.bid < NU) un = nb + F.bid; if (un != u) ub = nb; }
        int enx, nvnx; DP3_UNITINFO(un, (un > u ? ecur : 0), enx, nvnx);
        const char* abn; const char* gbn; int asn, bsn; DP3_SRC(un, enx, abn, asn, gbn, bsn);
        const int tile = u >> 2, colu = (u & 3) * 512;
        float scq[2][4];
#pragma unroll
        for (int c = 0; c < 4; ++c) {
            if (c == 0) asm volatile("s_waitcnt vmcnt(5)" ::: "memory"); else asm volatile("s_waitcnt vmcnt(4)" ::: "memory");
            __builtin_amdgcn_s_barrier();
            if (c == 3) { const char* ap_ = abn + (size_t)(32 * w + fr) * asn + 16 * fq;
#pragma unroll
                for (int m = 0; m < 2; ++m) { const char* am_ = ap_ + (size_t)m * 16 * asn;
                    asm volatile("global_load_dwordx4 %0, %1, off" : "=&v"(An[m][0]) : "v"(am_) : "memory"); asm volatile("global_load_dwordx4 %0, %1, off offset:64" : "=&v"(An[m][1]) : "v"(am_) : "memory");
                    asm volatile("global_load_dwordx4 %0, %1, off offset:128" : "=&v"(An[m][2]) : "v"(am_) : "memory"); asm volatile("global_load_dwordx4 %0, %1, off offset:192" : "=&v"(An[m][3]) : "v"(am_) : "memory"); } }
            { const char* gnext = (c < 3) ? gbc + (size_t)(c + 1) * 128 * bsc : gbn; const int bnext = (c < 3) ? bsc : bsn; DP3_STAGE((c + 1) & 1, gnext, bnext); }
            __builtin_amdgcn_sched_barrier(0);
            f32x4 acc[2][4][2];
#pragma unroll
            for (int g = 0; g < 4; ++g) { bf16x8 Bf[2][4];
#pragma unroll
                for (int n = 0; n < 2; ++n)
#pragma unroll
                    for (int kk = 0; kk < 4; ++kk) Bf[n][kk] = *(const LAS bf16x8*)(lds + (c & 1) * 32768 + (kk >> 1) * 16384 + boffg[g] + n * 2048 + (kk & 1) * 1024);
#pragma unroll
                for (int m = 0; m < 2; ++m)
#pragma unroll
                    for (int n = 0; n < 2; ++n) { acc[m][g][n] = (f32x4){0.f, 0.f, 0.f, 0.f};
#pragma unroll
                        for (int kk = 0; kk < 4; ++kk) acc[m][g][n] = __builtin_amdgcn_mfma_f32_16x16x32_bf16(Bf[n][kk], A[m][kk], acc[m][g][n], 0, 0, 0); } }
#pragma unroll
            for (int m = 0; m < 2; ++m) {
                float am0 = 0.f, am1 = 0.f;
#pragma unroll
                for (int g = 0; g < 4; ++g)
#pragma unroll
                    for (int n = 0; n < 2; ++n) { am0 = fmaxf(fmaxf(am0, fabsf(acc[m][g][n][0])), fabsf(acc[m][g][n][1])); am1 = fmaxf(fmaxf(am1, fabsf(acc[m][g][n][2])), fabsf(acc[m][g][n][3])); }
                float am = fmaxf(am0, am1);
                am = fmaxf(am, shfl_x(am, 16, lane)); am = fmaxf(am, shfl_x(am, 32, lane));
                am = fminf(am, 3.0e38f);
                const float isc = am > 0.f ? 127.0f * __builtin_amdgcn_rcpf(am) : 0.f;
                scq[m][c] = am * (1.0f / 127.0f);
                const f32x2_t isc2 = (f32x2_t){isc, isc}, mg2 = (f32x2_t){8388736.0f, 8388736.0f};
#pragma unroll
                for (int g = 0; g < 4; ++g) { unsigned qd[2];
#pragma unroll
                    for (int n = 0; n < 2; ++n) {
                        const f32x2_t tl = __builtin_elementwise_fma((f32x2_t){acc[m][g][n][0], acc[m][g][n][1]}, isc2, mg2), th = __builtin_elementwise_fma((f32x2_t){acc[m][g][n][2], acc[m][g][n][3]}, isc2, mg2);
                        const float f0_ = tl.x, f1_ = tl.y, f2_ = th.x, f3_ = th.y;
                        qd[n] = __builtin_amdgcn_perm(__builtin_bit_cast(unsigned, f1_), __builtin_bit_cast(unsigned, f0_), 0x0c0c0400u) | __builtin_amdgcn_perm(__builtin_bit_cast(unsigned, f3_), __builtin_bit_cast(unsigned, f2_), 0x04000c0cu); }
                    *(LAS v2u*)(stg + (16 * m + fr) * 144 + 32 * g + 8 * fq) = (v2u){qd[0], qd[1]}; } }
#pragma unroll
            for (int it = 0; it < 4; ++it) { const int rr = 8 * it + (lane >> 3);
                const v4u o = *(const LAS v4u*)(stg + rr * 144 + (lane & 7) * 16);
                __builtin_nontemporal_store(o, (v4u*)(Yq + (size_t)(tile * 256 + 32 * w + rr) * D + colu + 128 * c + 16 * (lane & 7))); }
            if (c == 3) { const f32x4 so = fq == 0 ? (f32x4){scq[0][0], scq[0][1], scq[0][2], scq[0][3]} : (f32x4){scq[1][0], scq[1][1], scq[1][2], scq[1][3]};
                if (fq < 2) __builtin_nontemporal_store(so, (f32x4*)(Ysc + (size_t)(tile * 256 + 32 * w + 16 * fq + fr) * 16 + (colu >> 7))); }
            __builtin_amdgcn_sched_barrier(0);
        }
        asm volatile("s_waitcnt vmcnt(9)" : "+v"(An[0][0]), "+v"(An[0][1]), "+v"(An[0][2]), "+v"(An[0][3]), "+v"(An[1][0]), "+v"(An[1][1]), "+v"(An[1][2]), "+v"(An[1][3]) :: "memory");
        if (un == u) break;
#pragma unroll
        for (int m = 0; m < 2; ++m)
#pragma unroll
            for (int kk = 0; kk < 4; ++kk) A[m][kk] = An[m][kk];
        u = un; ecur = enx; nvcur = nvnx; abc = abn; asc = asn; gbc = gbn; bsc = bsn;
    }
    asm volatile("s_waitcnt vmcnt(0)" ::: "memory");
#undef DP3_UNITINFO
#undef DP3_STAGE
#undef DP3_GLDS
#undef DP3_SRC
}

enum { PH_PRO = 0, PH_POOL_G1, PH_POOL_P, PH_POOL_G2, PH_POOL_G3, PH_DIL_G1, PH_DIL_ATT, PH_DIL_CMB, PH_DIL_G2, PH_CONV_G1, PH_CONV_E, PH_CONV_G2, PH_MOE1, PH_MOE2, PH_MOE3, PH_MOE4, PH_COUNT };

template <int PH>
__device__ __forceinline__ void run_phase(const Frame& Fin, const Args& args_, const int L) {
    Frame F = Fin; { int w_ = Fin.wave, l_; asm volatile("" : "+s"(w_)); asm volatile("v_mbcnt_lo_u32_b32 %0, -1, 0\n\tv_mbcnt_hi_u32_b32 %0, -1, %0" : "=v"(l_)); F.wave = w_; F.lane = l_; F.tid = w_ * 64 + l_; }
    unsigned char* ws; { GAS unsigned char* wsg = (GAS unsigned char*)Fin.ws; asm volatile("" : "+s"(wsg)); ws = (unsigned char*)wsg; } F.ws = ws; F.ctl = (unsigned*)(ws + WS_CTL);
    KP kp = (KP)__builtin_amdgcn_kernarg_segment_ptr(); asm volatile("" : "+s"(kp)); (void)args_;
    { unsigned l_ = (unsigned)(size_t)Fin.lds; asm volatile("" : "+s"(l_)); F.lds = (LAS unsigned char*)(size_t)l_; }
    LAS unsigned char* ring = F.lds; int c = (int)blockIdx.x; { int g_ = Fin.G; asm volatile("" : "+s"(c), "+s"(g_)); F.G = g_; F.bid = c; }
    const float* xres = ain(kp, IN_X);
    const float* st2 = (const float*)(ws + WS_ST2); float* pstp = (float*)(ws + WS_PST);
    const float* g2p = ain(kp, IN_LNG) + (size_t)((L > 0 ? L - 1 : 0) * 2 + 1) * D; const float* b2p = ain(kp, IN_LNB) + (size_t)((L > 0 ? L - 1 : 0) * 2 + 1) * D;
    const bf16* xb = (const bf16*)(ws + WS_XB);
    bf16* yf = (bf16*)(ws + WS_YF);
    unsigned char* big = ws + WS_BIG;
    const int ia = L / 3;
    if constexpr (PH == PH_PRO) { phase_prologue(F, kp); }
    if constexpr (PH == PH_POOL_G1) { g8::DenseSched S; S.init(xb, (const bf16*)(ws + WS_W_POOL_IN) + (size_t)ia * D * D, T, D, D, D, F.G, c);
        g8::EpiBf16 E{(bf16*)(big + BG_U), D, 0}; g8::gemm_phase<g8::EpiBf16, g8::DenseSched, false>(ring, F.tid, D, D, D, S, E); }
    if constexpr (PH == PH_POOL_P) { phase_pool(F, (const bf16*)(big + BG_U), (bf16*)(big + BG_PL)); }
    if constexpr (PH == PH_POOL_G2) { g8::DenseSched S; S.init((const bf16*)(big + BG_PL), (const bf16*)(ws + WS_W_POOL_G) + (size_t)ia * D * 512, T, D, D, 512, F.G, c); S.agrp_shift = 1; S.agrp_stride = 512 * 2;
        g8::EpiScaleBf16 E{(bf16*)(big + BG_MX), D, ain(kp, IN_PSC) + (size_t)ia * D}; g8::gemm_phase<g8::EpiScaleBf16, g8::DenseSched, false>(ring, F.tid, 512, D, 512, S, E); }
    if constexpr (PH == PH_POOL_G3) { g8::DenseSched S; S.init((const bf16*)(big + BG_MX), (const bf16*)(ws + WS_W_POOL_OUT) + (size_t)ia * D * D, T, D, D, D, F.G, c);
        g8::EpiResidLN E{xres, xb, st2, g2p, b2p, yf, pstp, 2}; g8::gemm_phase<g8::EpiResidLN, g8::DenseSched, false>(ring, F.tid, D, D, D, S, E); }
    if constexpr (PH == PH_DIL_G1) { g8::DenseSched S; S.init(xb, (const bf16*)(ws + WS_W_DIL_QKV), T, QKVC, D, D, F.G, c);
        g8::EpiBf16 E{(bf16*)(big + BG_QKV), QKVC, 1}; g8::gemm_phase<g8::EpiBf16, g8::DenseSched, false>(ring, F.tid, D, D, D, S, E); }
    if constexpr (PH == PH_DIL_ATT) { phase_attn(F, (const bf16*)(big + BG_QKV), ain(kp, IN_RELB), (bf16*)(big + BG_OG), (float*)(big + BG_LSE)); }
    if constexpr (PH == PH_DIL_CMB) { phase_combine(F, (const bf16*)(big + BG_OG), (const float*)(big + BG_LSE), (bf16*)(big + BG_O)); }
    if constexpr (PH == PH_DIL_G2) { g8::DenseSched S; S.init((const bf16*)(big + BG_O), (const bf16*)(ws + WS_W_DIL_OUT), T, D, DILW, DILW, F.G, c);
        g8::EpiResidLN E{xres, xb, st2, g2p, b2p, yf, pstp, 2}; g8::gemm_phase<g8::EpiResidLN, g8::DenseSched, false>(ring, F.tid, DILW, DILW, DILW, S, E); }
    if constexpr (PH == PH_CONV_G1) { g8::DenseSched S; S.init(xb, (const bf16*)(ws + WS_W_CONV_IN), T, 3 * D, D, D, F.G, c);
        g8::EpiConvIn E{(bf16*)(big + BG_UC), (bf16*)(big + BG_BG)}; g8::gemm_phase<g8::EpiConvIn, g8::DenseSched, false>(ring, F.tid, D, D, D, S, E); }
    if constexpr (PH == PH_CONV_E) { phase_conv(F, (const bf16*)(big + BG_UC), (const bf16*)(big + BG_BG), ain(kp, IN_CW), (bf16*)(big + BG_Z)); }
    if constexpr (PH == PH_CONV_G2) { g8::DenseSched S; S.init((const bf16*)(big + BG_Z), (const bf16*)(ws + WS_W_CONV_OUT), T, D, D, D, F.G, c);
        g8::EpiResidLN E{xres, xb, st2, g2p, b2p, yf, pstp, 2}; g8::gemm_phase<g8::EpiResidLN, g8::DenseSched, false>(ring, F.tid, D, D, D, S, E); }
    unsigned* cnt = F.ctl + CW_CNT + L * 64 * 16;
    float* x1f = (float*)(ws + WS_X1F); bf16* x1b = (bf16*)(ws + WS_X1B);
    int* ltok = (int*)(ws + WS_LTOK); float* lgate = (float*)(ws + WS_LGATE); int* eidx = (int*)(ws + WS_EIDX); int* inv = (int*)(ws + WS_INV);
    bf16* HB = (bf16*)(ws + WS_HB); bf16* HS = (bf16*)(ws + WS_HS); bf16* Yr = (bf16*)(ws + WS_BIG);
    if constexpr (PH == PH_MOE1) {
        const float* g1 = ain(kp, IN_LNG) + (size_t)(L * 2 + 0) * D; const float* b1 = ain(kp, IN_LNB) + (size_t)(L * 2 + 0) * D;
        phase_moe1n(F, yf, pstp, g1, b1, (const bf16*)(ws + WS_RWH) + (size_t)L * NEXP * D, (const bf16*)(ws + WS_RWL) + (size_t)L * NEXP * D, ain(kp, IN_RB) + (size_t)L * NEXP,
                    x1b, (float*)(ws + WS_ST1), cnt, ltok, lgate, eidx, inv); }
    if constexpr (PH == PH_MOE2) {
        const int NT = build_tiles(F, cnt);
        { g8::ExpertSched<1, true> S; S.tpref = (const LAS int*)(F.lds + LDS_TAB); S.cnt = (const LAS int*)(F.lds + LDS_TAB + 512); S.A = (const char*)x1b; S.B = (const char*)((const bf16*)(ws + WS_W_EX_GU) + (size_t)L * 64 * 256 * D);
          S.tok = ltok; S.b_exp = (size_t)256 * D * 2; S.b_tile = 0; S.a_tile = 0; S.NU = NT; S.G = F.G; S.c = c;
          g8::EpiExpertGU E{HB}; g8::gemm_phase<g8::EpiExpertGU, g8::ExpertSched<1, true>, true>(ring, F.tid, D, D, D, S, E); }
        { const int rot = (c - (NT % F.G) + F.G) % F.G;
          g8::DenseSched S; S.init(x1b, (const bf16*)(ws + WS_W_SH_GU) + (size_t)L * 512 * D, T, 512, D, D, F.G, rot);
          int t2 = F.tid; asm volatile("" : "+v"(t2));
          g8::EpiSharedGU E{HS}; g8::gemm_phase<g8::EpiSharedGU, g8::DenseSched, false>(ring, t2, D, D, D, S, E); } }
    if constexpr (PH == PH_MOE3) {
        const float* g1 = ain(kp, IN_LNG) + (size_t)(L * 2 + 0) * D; const float* b1 = ain(kp, IN_LNB) + (size_t)(L * 2 + 0) * D;
        const int NT = build_tiles(F, cnt);
        __syncthreads();
        phase_downproj3(F, HB, (const bf16*)(ws + WS_W_EX_D) + (size_t)L * 64 * D * EDIM, HS, (const bf16*)(ws + WS_W_SH_D) + (size_t)L * D * SDIM, (unsigned char*)Yr, (float*)(ws + WS_BIG + BG_YSC), NT + 2 * (T / 256));
        (void)g1; (void)b1; }
    if constexpr (PH == PH_MOE4) { (void)build_tiles(F, cnt);
        const float* g2 = ain(kp, IN_LNG) + (size_t)(L * 2 + 1) * D; const float* b2 = ain(kp, IN_LNB) + (size_t)(L * 2 + 1) * D;
        phase_moe4q(F, x1b, (bf16*)(ws + WS_Y2F), (const unsigned char*)Yr, (const float*)(ws + WS_BIG + BG_YSC), eidx, inv, g2, b2, (float*)(ws + WS_ST2), (bf16*)(ws + WS_XB), aout(kp), L == DEPTH - 1); }
}
__device__ __forceinline__ void make_frame(Frame& F, const Args& args) {
    extern __shared__ __attribute__((aligned(16))) unsigned char lds_raw[];
    F.lds = (LAS unsigned char*)lds_raw; F.ws = args.ws; F.ctl = (unsigned*)(args.ws + WS_CTL);
    F.tid = threadIdx.x; F.lane = F.tid & 63; F.wave = __builtin_amdgcn_readfirstlane(F.tid >> 6); F.G = gridDim.x; F.bid = blockIdx.x;
}
template <int PH> __global__ void __launch_bounds__(512, 2) k_phase(Args args, int L) {
    Frame F; make_frame(F, args);
    run_phase<PH>(F, args, L);
}

#ifndef MK_NOINLINE
#define MK_NOINLINE 0
#endif
#if MK_NOINLINE
template <int PH> __device__ __noinline__ void call_phase_ni(const int L) {
    Args dummy{}; Frame F;
    KP kp = (KP)__builtin_amdgcn_kernarg_segment_ptr();
    extern __shared__ __attribute__((aligned(16))) unsigned char lds_raw[];
    F.lds = (LAS unsigned char*)lds_raw; F.ws = (unsigned char*)((GAS unsigned char* const CAS*)kp)[20]; F.ctl = (unsigned*)(F.ws + WS_CTL);
    F.tid = threadIdx.x; F.lane = F.tid & 63; F.wave = __builtin_amdgcn_readfirstlane(F.tid >> 6); F.G = gridDim.x; F.bid = blockIdx.x;
    run_phase<PH>(F, dummy, L);
}
template <int PH> __device__ __forceinline__ void call_phase(const Frame& F, const Args& args, const int L) { call_phase_ni<PH>(L); }
#else
template <int PH> __device__ __forceinline__ void call_phase(const Frame& F, const Args& args, const int L) { asm volatile("; PHASE_BEGIN %0" :: "n"(PH)); run_phase<PH>(F, args, L); asm volatile("; PHASE_END %0" :: "n"(PH)); }
#endif
__global__ void __launch_bounds__(512, 2) fwd_all(Args args) {
    Frame F; make_frame(F, args);
    volatile LAS unsigned* misc = (volatile LAS unsigned*)(F.lds + LDS_MISC);
    if (F.tid < 4) misc[F.tid] = 0u;
    __syncthreads();
    const int lo = args.ph_lo, hi = args.ph_hi;
    XcdBarrier bar; bar.bar = F.ctl + CW_BAR; bar.x = 0; bar.st = misc;
    if (hi - lo > 1) bar = xcd_barrier_post(F.ctl + CW_BAR, misc);
    int pc = 0;
#ifndef MK_DUP_MASK
#define MK_DUP_MASK 0
#endif
#if MK_DUP_MASK
#define STEP(PH, Lx) do { if (pc >= lo && pc < hi) { int nrep_ = ((MK_DUP_MASK >> (PH)) & 1) ? 2 : 1; asm volatile("" : "+s"(nrep_)); _Pragma("unroll 1") for (int r_ = 0; r_ < nrep_; ++r_) { call_phase<PH>(F, args, Lx); if (r_ + 1 < nrep_ || pc + 1 < hi) xcd_barrier(bar); } } ++pc; } while (0)
#else
#define STEP(PH, Lx) do { if (pc >= lo && pc < hi) { call_phase<PH>(F, args, Lx); if (pc + 1 < hi) xcd_barrier(bar); } ++pc; } while (0)
#endif
    STEP(PH_PRO, 0);
#pragma unroll 1
    for (int L = 0; L < DEPTH; ++L) {
        const int kind = L % 3;
        if (kind == 0) { STEP(PH_POOL_G1, L); STEP(PH_POOL_P, L); STEP(PH_POOL_G2, L); STEP(PH_POOL_G3, L); }
        else if (kind == 1) { STEP(PH_DIL_G1, L); STEP(PH_DIL_ATT, L); STEP(PH_DIL_CMB, L); STEP(PH_DIL_G2, L); }
        else { STEP(PH_CONV_G1, L); STEP(PH_CONV_E, L); STEP(PH_CONV_G2, L); }
        STEP(PH_MOE1, L); STEP(PH_MOE2, L); STEP(PH_MOE3, L); STEP(PH_MOE4, L);
    }
#undef STEP
}
constexpr int N_STEPS = 1 + 2 * 8 + 8 + 7;

template <int PH> static void launch_phase(const Args& a, int L, int grid, hipStream_t stream) {
    static bool attr = false;
    if (!attr) { (void)hipFuncSetAttribute((const void*)k_phase<PH>, hipFuncAttributeMaxDynamicSharedMemorySize, LDS_BYTES); attr = true; }
    hipLaunchKernelGGL(k_phase<PH>, dim3(grid), dim3(512), LDS_BYTES, stream, a, L);
}
extern "C" void kernel_launch(void* const* d_in, const int* in_sizes, int n_in, void* d_out, int out_size, void* d_ws, size_t ws_size, hipStream_t stream) {
    static int grid = 0;
    if (grid == 0) {
        if (n_in != 19 || out_size != T * D || ws_size < WS_END) { fprintf(stderr, "kernel_launch: unexpected shapes (n_in %d out %d ws %zu need %zu)\n", n_in, out_size, ws_size, (size_t)WS_END); grid = -1; return; }
        int dev = 0, cus = 0;
        if (hipGetDevice(&dev) != hipSuccess || hipDeviceGetAttribute(&cus, hipDeviceAttributeMultiprocessorCount, dev) != hipSuccess) { grid = -1; return; }
#if MK_ONE_LAUNCH
        if (hipFuncSetAttribute((const void*)fwd_all, hipFuncAttributeMaxDynamicSharedMemorySize, LDS_BYTES) != hipSuccess) { fprintf(stderr, "kernel_launch: hipFuncSetAttribute failed\n"); grid = -1; return; }
        int per_cu = 0;
        if (hipOccupancyMaxActiveBlocksPerMultiprocessor(&per_cu, (const void*)fwd_all, 512, LDS_BYTES) != hipSuccess || per_cu < 1) { fprintf(stderr, "kernel_launch: note: occupancy query reports %d blocks per CU\n", per_cu); (void)hipGetLastError(); }
#endif
        grid = cus;
    }
    if (grid < 0) return;
    (void)hipMemsetAsync((char*)d_ws + WS_CTL, 0, CTL_ZERO_BYTES, stream);
    Args a{};
    for (int i = 0; i < 19; ++i) a.in[i] = (const float*)d_in[i];
    a.out = (float*)d_out; a.ws = (unsigned char*)d_ws; a.ph_lo = 0; a.ph_hi = 0;
#if MK_ONE_LAUNCH
#ifdef MK_SPLIT
    for (int p = 0; p < N_STEPS; ++p) { a.ph_lo = p; a.ph_hi = p + 1; hipLaunchKernelGGL(fwd_all, dim3(grid), dim3(512), LDS_BYTES, stream, a); }
#else
    a.ph_lo = 0; a.ph_hi = N_STEPS;
    hipLaunchKernelGGL(fwd_all, dim3(grid), dim3(512), LDS_BYTES, stream, a);
#endif
#elif defined(MK_HYBRID_MASK)
    {
        static bool attr2 = false; if (!attr2) { (void)hipFuncSetAttribute((const void*)fwd_all, hipFuncAttributeMaxDynamicSharedMemorySize, LDS_BYTES); attr2 = true; }
        int pc = 0;
#define HSTEP(PH, Lx) do { if ((MK_HYBRID_MASK >> (PH)) & 1) { a.ph_lo = pc; a.ph_hi = pc + 1; hipLaunchKernelGGL(fwd_all, dim3(grid), dim3(512), LDS_BYTES, stream, a); } else { a.ph_lo = 0; a.ph_hi = 0; launch_phase<PH>(a, Lx, grid, stream); } ++pc; } while (0)
        HSTEP(PH_PRO, 0);
        for (int L = 0; L < DEPTH; ++L) {
            const int kind = L % 3;
            if (kind == 0) { HSTEP(PH_POOL_G1, L); HSTEP(PH_POOL_P, L); HSTEP(PH_POOL_G2, L); HSTEP(PH_POOL_G3, L); }
            else if (kind == 1) { HSTEP(PH_DIL_G1, L); HSTEP(PH_DIL_ATT, L); HSTEP(PH_DIL_CMB, L); HSTEP(PH_DIL_G2, L); }
            else { HSTEP(PH_CONV_G1, L); HSTEP(PH_CONV_E, L); HSTEP(PH_CONV_G2, L); }
            HSTEP(PH_MOE1, L); HSTEP(PH_MOE2, L); HSTEP(PH_MOE3, L); HSTEP(PH_MOE4, L);
        }
#undef HSTEP
    }
#else
    launch_phase<PH_PRO>(a, 0, grid, stream);
    for (int L = 0; L < DEPTH; ++L) {
        const int kind = L % 3;
        if (kind == 0) { launch_phase<PH_POOL_G1>(a, L, grid, stream); launch_phase<PH_POOL_P>(a, L, grid, stream); launch_phase<PH_POOL_G2>(a, L, grid, stream); launch_phase<PH_POOL_G3>(a, L, grid, stream); }
        else if (kind == 1) { launch_phase<PH_DIL_G1>(a, L, grid, stream); launch_phase<PH_DIL_ATT>(a, L, grid, stream); launch_phase<PH_DIL_CMB>(a, L, grid, stream); launch_phase<PH_DIL_G2>(a, L, grid, stream); }
        else { launch_phase<PH_CONV_G1>(a, L, grid, stream); launch_phase<PH_CONV_E>(a, L, grid, stream); launch_phase<PH_CONV_G2>(a, L, grid, stream); }
        launch_phase<PH_MOE1>(a, L, grid, stream); launch_phase<PH_MOE2>(a, L, grid, stream); launch_phase<PH_MOE3>(a, L, grid, stream); launch_phase<PH_MOE4>(a, L, grid, stream);
    }
#endif
}
```

```cpp
#include <hip/hip_runtime.h>
#include <cstdio>
#include <cstdint>

#ifndef MK_ONE_LAUNCH
#define MK_ONE_LAUNCH 1
#endif

#define GAS __attribute__((address_space(1)))
#define LAS __attribute__((address_space(3)))
typedef unsigned short bf16;
typedef unsigned v4u __attribute__((ext_vector_type(4)));
typedef unsigned v2u __attribute__((ext_vector_type(2)));
typedef float f32x4 __attribute__((ext_vector_type(4)));
typedef float f32x2 __attribute__((ext_vector_type(2)));
typedef short bf16x8 __attribute__((ext_vector_type(8)));
typedef short s16x4 __attribute__((ext_vector_type(4)));

constexpr int NBATCH = 8, SEQ = 2048, D = 2048, T = NBATCH * SEQ, DEPTH = 4;
constexpr int NEXP = 64, TOPK = 8, EDIM = 128, SDIM = 256;
constexpr int QKVC = 4608, DILW = 512;
constexpr float ALPHA = 1.681792830507429f;
constexpr float LN_EPS = 1e-5f;
constexpr int CAP = 16384;
constexpr int HROWS = T * TOPK + NEXP * 256;

constexpr size_t MiB = 1u << 20;
constexpr size_t WS_CTL = 0, CTL_ZERO_BYTES = 1 * MiB;
constexpr size_t WS_W_POOL_IN = 1 * MiB;
constexpr size_t WS_W_POOL_G = WS_W_POOL_IN + 16 * MiB;
constexpr size_t WS_W_POOL_OUT = WS_W_POOL_G + 4 * MiB;
constexpr size_t WS_W_DIL_QKV = WS_W_POOL_OUT + 16 * MiB;
constexpr size_t WS_W_DIL_OUT = WS_W_DIL_QKV + 18 * MiB;
constexpr size_t WS_W_CONV_IN = WS_W_DIL_OUT + 2 * MiB;
constexpr size_t WS_W_CONV_OUT = WS_W_CONV_IN + 24 * MiB;
constexpr size_t WS_W_SH_GU = WS_W_CONV_OUT + 8 * MiB;
constexpr size_t WS_W_SH_D = WS_W_SH_GU + 8 * MiB;
constexpr size_t WS_W_EX_GU = WS_W_SH_D + 4 * MiB;
constexpr size_t WS_W_EX_D = WS_W_EX_GU + 256 * MiB;
constexpr size_t WS_XF = WS_W_EX_D + 256 * MiB;
constexpr size_t WS_YF = WS_XF + 128 * MiB;
constexpr size_t WS_X1F = WS_YF + 128 * MiB;
constexpr size_t WS_XB = WS_X1F + 128 * MiB;
constexpr size_t WS_X1B = WS_XB + 64 * MiB;
constexpr size_t WS_HB = WS_X1B + 64 * MiB;
constexpr size_t WS_HS = WS_HB + 72 * MiB;
constexpr size_t WS_LTOK = WS_HS + 8 * MiB;
constexpr size_t WS_LGATE = WS_LTOK + 4 * MiB;
constexpr size_t WS_EIDX = WS_LGATE + 4 * MiB;
constexpr size_t WS_INV = WS_EIDX + 1 * MiB;
constexpr size_t WS_BIG = WS_INV + 1 * MiB;
constexpr size_t WS_PST = WS_BIG + 608 * MiB;
constexpr size_t WS_ST1 = WS_PST + 4 * MiB;
constexpr size_t WS_ST2 = WS_ST1 + 1 * MiB;
constexpr size_t WS_RWH = WS_ST2 + 1 * MiB;
constexpr size_t WS_RWL = WS_RWH + 1 * MiB;
constexpr size_t WS_PST2 = WS_RWL + 1 * MiB;
constexpr size_t WS_END = WS_PST2 + 8 * MiB;
constexpr size_t WS_Y2F = WS_X1F;
constexpr size_t BG_U = 0, BG_PL = 64 * MiB, BG_MX = 128 * MiB;
constexpr size_t BG_QKV = 0, BG_OG = 144 * MiB, BG_LSE = 192 * MiB, BG_O = 194 * MiB;
constexpr size_t BG_UC = 0, BG_BG = 64 * MiB, BG_Z = 128 * MiB;
constexpr size_t BG_YSC = 400 * MiB;
constexpr int CW_BAR = 4096;
constexpr int CW_CNT = 16384;

constexpr int RING_BYTES = 131072;
constexpr int LDS_TAB = RING_BYTES;
constexpr int LDS_STASH = RING_BYTES + 1024;
constexpr int LDS_BYTES = 163840;
constexpr int LDS_MISC = LDS_BYTES - 1024;

typedef __bf16 bf16x2_t __attribute__((ext_vector_type(2)));
typedef float f32x2_t __attribute__((ext_vector_type(2)));
__device__ __forceinline__ unsigned cvt_pk_bf16(float lo, float hi) { const bf16x2_t r = __builtin_convertvector((f32x2_t){lo, hi}, bf16x2_t); return __builtin_bit_cast(unsigned, r); }
__device__ __forceinline__ unsigned f2bf(float f) { unsigned u = __builtin_bit_cast(unsigned, f); return (u + 0x7fffu + ((u >> 16) & 1u)) >> 16; }
__device__ __forceinline__ unsigned pk2(float lo, float hi) { return f2bf(lo) | (f2bf(hi) << 16); }
__device__ __forceinline__ float bflo(unsigned w) { return __builtin_bit_cast(float, w << 16); }
__device__ __forceinline__ float bfhi(unsigned w) { return __builtin_bit_cast(float, w & 0xffff0000u); }
__device__ __forceinline__ float shfl_from(float v, int src) { return __builtin_bit_cast(float, __builtin_amdgcn_ds_bpermute(src << 2, __builtin_bit_cast(int, v))); }
__device__ __forceinline__ float shfl_x(float v, int o, int lane) { return shfl_from(v, lane ^ o); }
__device__ __forceinline__ float wave_sum(float v, int lane) {
    (void)lane;
    v += __builtin_bit_cast(float, __builtin_amdgcn_update_dpp(0, __builtin_bit_cast(int, v), 0xB1, 0xF, 0xF, false));
    v += __builtin_bit_cast(float, __builtin_amdgcn_update_dpp(0, __builtin_bit_cast(int, v), 0x4E, 0xF, 0xF, false));
    v += __builtin_bit_cast(float, __builtin_amdgcn_update_dpp(0, __builtin_bit_cast(int, v), 0x141, 0xF, 0xF, false));
    v += __builtin_bit_cast(float, __builtin_amdgcn_update_dpp(0, __builtin_bit_cast(int, v), 0x140, 0xF, 0xF, false));
    const float r0 = __builtin_bit_cast(float, __builtin_amdgcn_readlane(__builtin_bit_cast(int, v), 0)), r1 = __builtin_bit_cast(float, __builtin_amdgcn_readlane(__builtin_bit_cast(int, v), 16));
    const float r2 = __builtin_bit_cast(float, __builtin_amdgcn_readlane(__builtin_bit_cast(int, v), 32)), r3 = __builtin_bit_cast(float, __builtin_amdgcn_readlane(__builtin_bit_cast(int, v), 48));
    return (r0 + r1) + (r2 + r3);
}
#define LDS_WAIT() asm volatile("s_waitcnt lgkmcnt(0)" ::: "memory")
#define VM_WAIT() asm volatile("s_waitcnt vmcnt(0)" ::: "memory")

#define XB_TMO      128
#define XB_XCNT(j)  (256  + 64 * (j))
#define XB_XSUB(j)  (1280 + 64 * (j))
#define XB_XGEN(j)  (2304 + 64 * (j))
#define XB_TOP      3328
#define XB_TOPGEN   3392
#define XCD_BAR_WORDS 3456
#define XB_SPIN_CAP (1u << 18)

__device__ __forceinline__ unsigned xb_ld(unsigned* p)              { return __hip_atomic_load(p, __ATOMIC_RELAXED, __HIP_MEMORY_SCOPE_AGENT); }
__device__ __forceinline__ unsigned xb_add(unsigned* p, unsigned v) { return __hip_atomic_fetch_add(p, v, __ATOMIC_RELAXED, __HIP_MEMORY_SCOPE_AGENT); }
__device__ __forceinline__ unsigned xb_xcc_id() { return (unsigned)__builtin_amdgcn_s_getreg((3 << 11) | 20) & 0xFu; }
#define XB_SPIN(cond, bar) do { unsigned _sp = 0; while (cond) { __builtin_amdgcn_s_sleep(1); \
    if ((++_sp & 255u) == 0u) { if (xb_ld(&(bar)[XB_TMO])) break; if (_sp > XB_SPIN_CAP) { atomicAdd(&(bar)[XB_TMO], 1u); break; } } } } while (0)

struct XcdBarrier {
    unsigned* bar; unsigned x;
    volatile LAS unsigned* st;
};

__device__ __forceinline__ XcdBarrier xcd_barrier_post(unsigned* bar, volatile LAS unsigned* st) {
    XcdBarrier b; b.bar = bar; b.x = xb_xcc_id(); b.st = st;
    if (threadIdx.x == 0) (void)xb_add(&bar[XB_XCNT(b.x)], 1u);
    return b;
}
__device__ __forceinline__ void xcd_barrier_complete(unsigned* bar, unsigned x, unsigned& nloc, unsigned& nx) {
    const unsigned G = gridDim.x * gridDim.y * gridDim.z;
    unsigned sum, cnt, mine, sp = 0u;
    for (;;) {
        sum = 0u; cnt = 0u; mine = 0u;
#pragma unroll
        for (unsigned j = 0; j < 16; ++j) { const unsigned c = xb_ld(&bar[XB_XCNT(j)]); sum += c; cnt += (c > 0u) ? 1u : 0u; mine = (j == x) ? c : mine; }
        if (sum == G) break;
        __builtin_amdgcn_s_sleep(1);
        if ((++sp & 255u) == 0u) { if (xb_ld(&bar[XB_TMO])) break; if (sp > XB_SPIN_CAP) { atomicAdd(&bar[XB_TMO], 1u); break; } }
    }
    nloc = mine > 0u ? mine : 1u; nx = cnt > 0u ? cnt : 1u;
}

__device__ __forceinline__ void xcd_barrier(const XcdBarrier& b) {
    asm volatile("s_waitcnt vmcnt(0)" ::: "memory");
    __syncthreads();
    if (threadIdx.x == 0) {
        unsigned* bar; unsigned bx = b.x; { GAS unsigned* bg = (GAS unsigned*)b.bar; asm volatile("" : "+s"(bg), "+s"(bx)); bar = (unsigned*)bg; }
        __builtin_amdgcn_s_waitcnt(0);
        unsigned nloc = b.st[0], nx = b.st[1];
        if (nloc == 0u) { xcd_barrier_complete(bar, bx, nloc, nx); b.st[0] = nloc; b.st[1] = nx; }
        const unsigned old = xb_add(&bar[XB_XSUB(bx)], 1u);
        const unsigned gen = old / nloc;
        if (old + 1u == (gen + 1u) * nloc) {
            __builtin_amdgcn_fence(__ATOMIC_RELEASE, "agent");
            asm volatile("s_waitcnt vmcnt(0)" ::: "memory");
            const unsigned og = xb_add(&bar[XB_TOP], 1u);
            const unsigned tg = og / nx;
            if (og + 1u == (tg + 1u) * nx) xb_add(&bar[XB_TOPGEN], 1u);
            else XB_SPIN(xb_ld(&bar[XB_TOPGEN]) == tg, bar);
            __builtin_amdgcn_fence(__ATOMIC_ACQUIRE, "agent");
            xb_add(&bar[XB_XGEN(bx)], 1u);
            asm volatile("s_waitcnt vmcnt(0)" ::: "memory");
        } else {
            XB_SPIN(xb_ld(&bar[XB_XGEN(bx)]) == gen, bar);
            __builtin_amdgcn_fence(__ATOMIC_ACQUIRE, "agent");
            asm volatile("s_waitcnt vmcnt(0)" ::: "memory");
        }
    }
    __syncthreads();
}

namespace g8 {
constexpr int BM = 256, BK = 64, HALF = 128, HTB = HALF * BK * 2, STAGE_BYTES = 8 * HTB, NXCD = 8, WGM = 8;
__host__ __device__ __forceinline__ int lds_byte(int r, int c) { const int st = (r >> 4) * 2 + (c >> 5), rr = r & 15, cc = c & 31, ob = rr * 64 + cc * 2; return st * 1024 + (ob ^ (((ob >> 9) & 1) << 5)); }
__host__ __device__ __forceinline__ void stage_rc(int b, int& R, int& C) { const int st = b / 1024, sb = b % 1024, swz = sb ^ (((sb >> 9) & 1) << 5); R = (st >> 1) * 16 + swz / 64; C = (st & 1) * 32 + (swz % 64) / 2; }
__host__ __device__ __forceinline__ int perm32(int rho) { const int n = rho >> 4, i = rho & 15; return 8 * (i >> 2) + 4 * n + (i & 3); }

struct Unit { const char* A; const char* B; const int* rows; int pm, pn, nvalid, aux; };

template <class Epi, class Sched, bool GATHER>
__device__ __forceinline__ void gemm_phase(LAS unsigned char* lds, const int tid_in, const int K, const int lda, const int ldb, const Sched& S, const Epi& E) {
    const int tid = tid_in, wid = __builtin_amdgcn_readfirstlane(tid >> 6), lane = tid & 63, wr = wid >> 2, wc = wid & 3, fr = lane & 15, fq = lane >> 4;
    const int nt = K / BK;
    unsigned voffB[2];
#pragma unroll
    for (int i = 0; i < 2; ++i) { int R_, C_; stage_rc(tid * 16 + i * 8192, R_, C_); const int Rb = Epi::PERM ? ((R_ & ~31) + perm32(R_ & 31)) : R_; voffB[i] = (unsigned)(Rb * ldb + C_) * 2u; }
    LAS v4u* stash = (LAS v4u*)(lds + (LDS_STASH - 0) + tid * 16);
    const size_t kstep = (size_t)(BK * 2);
    const size_t hstepB = (size_t)HALF * ldb * 2;
    const unsigned ldsw = (unsigned)wid * 1024u;
    const int aoff = lds_byte(wr * 64 + fr, fq * 8), boff = lds_byte(wc * 32 + fr, fq * 8);
#define G8_SA(b, h) (((b) * 2 + (h)) * HTB)
#define G8_SB(b, h) ((4 + (b) * 2 + (h)) * HTB)
#define G8_STAGE2(bufoff, gbase, v0, v1) do { \
        __builtin_amdgcn_global_load_lds((const unsigned*)((const char*)(gbase) + (v0)), (LAS unsigned*)(lds + (bufoff) + ldsw), 16, 0, 0); \
        __builtin_amdgcn_global_load_lds((const unsigned*)((const char*)(gbase) + (v1)), (LAS unsigned*)(lds + (bufoff) + ldsw + 8192), 16, 0, 0); } while (0)
#define G8_STAGEB(bufoff, gbase) G8_STAGE2(bufoff, gbase, voffB[0], voffB[1])
#define G8_LDA(dst, b, h) do { _Pragma("unroll") for (int m = 0; m < 4; ++m) _Pragma("unroll") for (int k = 0; k < 2; ++k) dst[m][k] = *(const LAS bf16x8*)(lds + G8_SA(b, h) + aoff + m * 2048 + k * 1024); } while (0)
#define G8_LDB(dst, b, h) do { _Pragma("unroll") for (int n = 0; n < 2; ++n) _Pragma("unroll") for (int k = 0; k < 2; ++k) dst[n][k] = *(const LAS bf16x8*)(lds + G8_SB(b, h) + boff + n * 2048 + k * 1024); } while (0)
#define G8_MMA(ai, bj, At, Bt) do { __builtin_amdgcn_s_setprio(1); _Pragma("unroll") for (int m = 0; m < 4; ++m) _Pragma("unroll") for (int n = 0; n < 2; ++n) _Pragma("unroll") for (int k = 0; k < 2; ++k) \
        acc[ai][bj][m][n] = __builtin_amdgcn_mfma_f32_16x16x32_bf16(Bt[n][k], At[m][k], acc[ai][bj][m][n], 0, 0, 0); __builtin_amdgcn_s_setprio(0); } while (0)
#define G8_WAIT_V(n) asm volatile("s_waitcnt vmcnt(" #n ")" ::: "memory")
#define G8_WAIT_L(n) asm volatile("s_waitcnt lgkmcnt(" #n ")" ::: "memory")
#define G8_BAR __builtin_amdgcn_s_barrier()
#define G8_SCHED __builtin_amdgcn_sched_barrier(0)
#define G8_SETVA(dst, u) do { int _t2 = tid; if (GATHER) asm volatile("" : "+v"(_t2)); _Pragma("unroll") for (int _h = 0; _h < 2; ++_h) _Pragma("unroll") for (int _i = 0; _i < 2; ++_i) { \
        int _R, _C; stage_rc(_t2 * 16 + _i * 8192, _R, _C); \
        const unsigned _rl = (unsigned)(_h * HALF + _R); unsigned _row = _rl; \
        if (GATHER) { const bool _ok = _rl < (unsigned)(u).nvalid; _row = (unsigned)(u).rows[_ok ? _rl : 0u] >> 3; if (!_ok) _row = 0u; }     \
        dst[_h][_i] = (_row * (unsigned)lda + (unsigned)_C) * 2u; } } while (0)
    Unit cur, nxt; int ui = 0;
    if (!S.next(0, cur)) return;
    f32x4 acc[2][2][4][2];
#pragma unroll
    for (int a = 0; a < 2; ++a)
#pragma unroll
        for (int b = 0; b < 2; ++b)
#pragma unroll
            for (int m = 0; m < 4; ++m)
#pragma unroll
                for (int n = 0; n < 2; ++n) acc[a][b][m][n] = (f32x4){0.f, 0.f, 0.f, 0.f};
    bf16x8 At[4][2], B0[2][2], B1[2][2];
    unsigned vAc[2][2]; unsigned xl00 = 0, xl01 = 0, xl10 = 0, xl11 = 0;
    G8_SETVA(vAc, cur);
    const char* cA = cur.A; const char* cB = cur.B;
    G8_STAGEB(G8_SB(0, 0), cB); G8_STAGEB(G8_SB(0, 1), cB + hstepB); G8_STAGE2(G8_SA(0, 0), cA, vAc[0][0], vAc[0][1]); G8_STAGE2(G8_SA(0, 1), cA, vAc[1][0], vAc[1][1]);
    if (wr == 1) G8_BAR;
    G8_WAIT_V(2); G8_BAR;
    G8_STAGEB(G8_SB(1, 0), cB + kstep); G8_STAGE2(G8_SA(1, 0), cA + kstep, vAc[0][0], vAc[0][1]); G8_STAGEB(G8_SB(1, 1), cB + hstepB + kstep);
    G8_WAIT_V(6); G8_BAR;
    for (;;) {
        const bool has_next = S.next(ui + 1, nxt);
        const char* nA = has_next ? nxt.A : cA; const char* nB = has_next ? nxt.B : cB;
        if (GATHER) { unsigned vAn[2][2]; if (has_next) { G8_SETVA(vAn, nxt); } else {
#pragma unroll
            for (int h = 0; h < 2; ++h)
#pragma unroll
                for (int i = 0; i < 2; ++i) vAn[h][i] = vAc[h][i]; }
            *stash = (v4u){vAn[0][0], vAn[0][1], vAn[1][0], vAn[1][1]}; }
#pragma unroll 1
        for (int t = 0; t < nt; t += 2) {
            const bool last = (t == nt - 2);
            const char* a1 = cA + (size_t)(t + 1) * kstep;
            const char* a2 = last ? nA : cA + (size_t)(t + 2) * kstep; const char* b2 = last ? nB : cB + (size_t)(t + 2) * kstep;
            const char* a3 = a2 + kstep; const char* b3 = b2 + kstep;
            unsigned x00 = vAc[0][0], x01 = vAc[0][1], x10 = vAc[1][0], x11 = vAc[1][1];
            if (GATHER) { if (last) { const v4u sv = *stash; x00 = sv.x; x01 = sv.y; x10 = sv.z; x11 = sv.w; } xl00 = x00; xl01 = x01; xl10 = x10; xl11 = x11; }
            G8_LDB(B0, 0, 0); G8_LDB(B1, 0, 1); G8_SCHED; G8_LDA(At, 0, 0); G8_STAGE2(G8_SA(1, 1), a1, vAc[1][0], vAc[1][1]);
            G8_WAIT_V(8); G8_WAIT_L(0); G8_BAR; G8_MMA(0, 0, At, B0); G8_MMA(0, 1, At, B1); G8_BAR; G8_SCHED;
            G8_LDA(At, 0, 1); G8_STAGEB(G8_SB(0, 0), b2); G8_STAGEB(G8_SB(0, 1), b2 + hstepB); G8_STAGE2(G8_SA(0, 0), a2, x00, x01);
            G8_WAIT_V(8); G8_WAIT_L(0); G8_BAR; G8_MMA(1, 0, At, B0); G8_MMA(1, 1, At, B1); G8_BAR; G8_SCHED;
            G8_LDB(B0, 1, 0); G8_LDB(B1, 1, 1); G8_SCHED; G8_LDA(At, 1, 0); G8_STAGE2(G8_SA(0, 1), a2, x10, x11);
            G8_WAIT_V(8); G8_WAIT_L(0); G8_BAR; G8_MMA(0, 0, At, B0); G8_MMA(0, 1, At, B1); G8_BAR; G8_SCHED;
            G8_LDA(At, 1, 1); G8_STAGEB(G8_SB(1, 0), b3); G8_STAGEB(G8_SB(1, 1), b3 + hstepB); G8_STAGE2(G8_SA(1, 0), a3, x00, x01);
            G8_WAIT_V(8); G8_WAIT_L(0); G8_BAR; G8_MMA(1, 0, At, B0); G8_MMA(1, 1, At, B1); G8_BAR; G8_SCHED;
        }
        if (wr == 0) G8_BAR;
        E(acc, cur, wr, wc, fr, fq);
        if (!has_next) break;
#pragma unroll
        for (int a = 0; a < 2; ++a)
#pragma unroll
            for (int b = 0; b < 2; ++b)
#pragma unroll
                for (int m = 0; m < 4; ++m)
#pragma unroll
                    for (int n = 0; n < 2; ++n) acc[a][b][m][n] = (f32x4){0.f, 0.f, 0.f, 0.f};
        cur = nxt; cA = nA; cB = nB; ++ui;
        if (GATHER) { vAc[0][0] = xl00; vAc[0][1] = xl01; vAc[1][0] = xl10; vAc[1][1] = xl11; }
        if (wr == 1) G8_BAR;
    }
    G8_WAIT_V(0);
    G8_BAR;
#undef G8_SA
#undef G8_SB
#undef G8_STAGE2
#undef G8_STAGEB
#undef G8_LDA
#undef G8_LDB
#undef G8_MMA
#undef G8_WAIT_V
#undef G8_WAIT_L
#undef G8_BAR
#undef G8_SCHED
#undef G8_SETVA
}

struct DenseSched {
    const char* A; const char* B; size_t a_tile, b_tile, agrp_stride; int agrp_shift, nM, nN, nwg, G, c;
    __device__ __forceinline__ void init(const void* A_, const void* B_, int M, int N, int lda, int ldb, int G_, int c_) {
        A = (const char*)A_; B = (const char*)B_; a_tile = (size_t)BM * lda * 2; b_tile = (size_t)BM * ldb * 2; agrp_stride = 0; agrp_shift = 0; nM = M / BM; nN = N / BM; nwg = nM * nN; G = G_; c = c_; }
    __device__ __forceinline__ bool next(int i, Unit& u) const {
        const long L = (long)i * G + c; if (L >= nwg) return false;
        int wgid = (int)L; { const int q = nwg / NXCD, r = nwg % NXCD, xcd = wgid % NXCD, off = wgid / NXCD; wgid = (xcd < r ? xcd * (q + 1) : r * (q + 1) + (xcd - r) * q) + off; }
        const int nig = WGM * nN, gid = wgid / nig, fm = gid * WGM, gsz = (nM - fm) < WGM ? (nM - fm) : WGM;
        u.pm = fm + ((wgid % nig) % gsz); u.pn = (wgid % nig) / gsz;
        u.A = A + (size_t)u.pm * a_tile + (size_t)(u.pn >> agrp_shift) * agrp_stride; u.B = B + (size_t)u.pn * b_tile; u.rows = nullptr; u.nvalid = BM; u.aux = 0; return true;
    }
};
template <int NPN, bool GATHERED>
struct ExpertSched {
    const LAS int* tpref; const LAS int* cnt; const char* A; const char* B; const int* tok; size_t b_exp, b_tile, a_tile; int NU, G, c;
    __device__ __forceinline__ bool next(int i, Unit& u) const {
        int L = i * G + c; if (L >= NU) return false;
        if ((i + 1) * G <= NU && (G % NXCD) == 0) L = i * G + (c % NXCD) * (G / NXCD) + c / NXCD;
        const int tile = L / NPN, pn = L % NPN;
        int e = 0; { int hi = 64;
#pragma unroll
          for (int it_ = 0; it_ < 6; ++it_) { const int mid = (e + hi) >> 1; if (__builtin_amdgcn_readfirstlane(tpref[mid]) <= tile) e = mid; else hi = mid; } }
        const int rb = tile - __builtin_amdgcn_readfirstlane(tpref[e]);
        u.pm = e; u.pn = pn; u.aux = tile * BM; u.nvalid = __builtin_amdgcn_readfirstlane(cnt[e]) - rb * BM; if (u.nvalid > BM) u.nvalid = BM;
        u.rows = tok + (size_t)e * CAP + rb * BM;
        u.A = GATHERED ? A : A + (size_t)tile * a_tile; u.B = B + (size_t)e * b_exp + (size_t)pn * b_tile; return true;
    }
};

struct EpiBf16 {
    static constexpr bool PERM = true;
    bf16* O; int ldc; int qscale;
    __device__ __forceinline__ void operator()(const f32x4 (&acc)[2][2][4][2], const Unit& u, int wr, int wc, int fr, int fq) const {
        asm volatile("" : "+v"(fr), "+v"(fq));
        const int row0 = u.pm * BM + wr * 64 + fr, col0 = u.pn * BM + wc * 32 + 8 * fq;
        const float sc = (qscale && (u.pn % 6) < 2) ? 0.125f : 1.0f;
#pragma unroll
        for (int ai = 0; ai < 2; ++ai)
#pragma unroll
            for (int m = 0; m < 4; ++m) { bf16* rowp = O + (size_t)(row0 + ai * HALF + m * 16) * ldc + col0;
#pragma unroll
                for (int bj = 0; bj < 2; ++bj) { const f32x4 v0 = acc[ai][bj][m][0] * sc, v1 = acc[ai][bj][m][1] * sc;
                    v4u w; w.x = cvt_pk_bf16(v0[0], v0[1]); w.y = cvt_pk_bf16(v0[2], v0[3]); w.z = cvt_pk_bf16(v1[0], v1[1]); w.w = cvt_pk_bf16(v1[2], v1[3]);
                    *(v4u*)(rowp + bj * HALF) = w; } }
    }
};
struct EpiScaleBf16 {
    static constexpr bool PERM = true;
    bf16* O; int ldc; const float* scale;
    __device__ __forceinline__ void operator()(const f32x4 (&acc)[2][2][4][2], const Unit& u, int wr, int wc, int fr, int fq) const {
        asm volatile("" : "+v"(fr), "+v"(fq));
        const int row0 = u.pm * BM + wr * 64 + fr, col0 = u.pn * BM + wc * 32 + 8 * fq;
        f32x4 sv[2][2];
#pragma unroll
        for (int bj = 0; bj < 2; ++bj)
#pragma unroll
            for (int n = 0; n < 2; ++n) sv[bj][n] = *(const f32x4*)(scale + col0 + bj * HALF + 4 * n);
#pragma unroll
        for (int ai = 0; ai < 2; ++ai)
#pragma unroll
            for (int m = 0; m < 4; ++m) { bf16* rowp = O + (size_t)(row0 + ai * HALF + m * 16) * ldc + col0;
#pragma unroll
                for (int bj = 0; bj < 2; ++bj) { const f32x4 v0 = acc[ai][bj][m][0] * sv[bj][0], v1 = acc[ai][bj][m][1] * sv[bj][1];
                    v4u w; w.x = cvt_pk_bf16(v0[0], v0[1]); w.y = cvt_pk_bf16(v0[2], v0[3]); w.z = cvt_pk_bf16(v1[0], v1[1]); w.w = cvt_pk_bf16(v1[2], v1[3]);
                    *(v4u*)(rowp + bj * HALF) = w; } }
    }
};
struct EpiResid {
    static constexpr bool PERM = false;
    const float* X; float* Y;
    __device__ __forceinline__ void operator()(const f32x4 (&acc)[2][2][4][2], const Unit& u, int wr, int wc, int fr, int fq) const {
        asm volatile("" : "+v"(fr), "+v"(fq));
        const int row0 = u.pm * BM + wr * 64 + fr, col0 = u.pn * BM + wc * 32 + 4 * fq;
#pragma unroll
        for (int ai = 0; ai < 2; ++ai)
#pragma unroll
            for (int m = 0; m < 4; ++m) { const size_t off = (size_t)(row0 + ai * HALF + m * 16) * D + col0;
#pragma unroll
                for (int bj = 0; bj < 2; ++bj)
#pragma unroll
                    for (int n = 0; n < 2; ++n) { const f32x4 xv = *(const f32x4*)(X + off + bj * HALF + n * 16); *(f32x4*)(Y + off + bj * HALF + n * 16) = xv * ALPHA + acc[ai][bj][m][n]; } }
    }
};
struct EpiResidLN {
    static constexpr bool PERM = true;
    const float* X32; const bf16* Xb; const float* st; const float* g; const float* b; bf16* Y; float* pst; int mode;
    __device__ __forceinline__ void operator()(const f32x4 (&acc)[2][2][4][2], const Unit& u, int wr, int wc, int fr, int fq) const {
        asm volatile("" : "+v"(fr), "+v"(fq));
        const int row0 = u.pm * BM + wr * 64 + fr, col0 = u.pn * BM + wc * 32 + 8 * fq, lane = fq * 16 + fr;
#pragma unroll
        for (int ai = 0; ai < 2; ++ai) {
            v4u xr[4][2];
#pragma unroll
            for (int m = 0; m < 4; ++m)
#pragma unroll
                for (int bj = 0; bj < 2; ++bj) xr[m][bj] = *(const v4u*)(Xb + (size_t)(row0 + ai * HALF + m * 16) * D + col0 + bj * HALF);
            asm volatile("" : "+v"(xr[0][0]), "+v"(xr[0][1]), "+v"(xr[1][0]), "+v"(xr[1][1]), "+v"(xr[2][0]), "+v"(xr[2][1]), "+v"(xr[3][0]), "+v"(xr[3][1]));
#pragma unroll
            for (int m = 0; m < 4; ++m) { const int row = row0 + ai * HALF + m * 16; const size_t off = (size_t)row * D + col0;
                float sm = 0.f, sq = 0.f;
#pragma unroll
                for (int bj = 0; bj < 2; ++bj) { const v4u xv = xr[m][bj];
                    const f32x4 x0 = (f32x4){bflo(xv.x), bfhi(xv.x), bflo(xv.y), bfhi(xv.y)}, x1 = (f32x4){bflo(xv.z), bfhi(xv.z), bflo(xv.w), bfhi(xv.w)};
                    const f32x4 y0 = x0 * ALPHA + acc[ai][bj][m][0], y1 = x1 * ALPHA + acc[ai][bj][m][1];
                    v4u w; w.x = cvt_pk_bf16(y0[0], y0[1]); w.y = cvt_pk_bf16(y0[2], y0[3]); w.z = cvt_pk_bf16(y1[0], y1[1]); w.w = cvt_pk_bf16(y1[2], y1[3]);
                    *(v4u*)(Y + off + bj * HALF) = w;
                    sm += ((y0[0] + y0[1]) + (y0[2] + y0[3])) + ((y1[0] + y1[1]) + (y1[2] + y1[3]));
                    sq += ((y0[0] * y0[0] + y0[1] * y0[1]) + (y0[2] * y0[2] + y0[3] * y0[3])) + ((y1[0] * y1[0] + y1[1] * y1[1]) + (y1[2] * y1[2] + y1[3] * y1[3])); }
                sm += shfl_x(sm, 16, lane); sm += shfl_x(sm, 32, lane); sq += shfl_x(sq, 16, lane); sq += shfl_x(sq, 32, lane);
                if (fq == 0) *(f32x2*)(pst + ((size_t)row * 32 + u.pn * 4 + wc) * 2) = (f32x2){sm, sq}; } }
    }
};
struct EpiConvIn {
    static constexpr bool PERM = true;
    bf16* UC; bf16* BGp;
    __device__ __forceinline__ void operator()(const f32x4 (&acc)[2][2][4][2], const Unit& u, int wr, int wc, int fr, int fq) const {
        asm volatile("" : "+v"(fr), "+v"(fq));
        const int row0 = u.pm * BM + wr * 64 + fr, cw = wc * 32 + 8 * fq;
        if (u.pn < 16) {
#pragma unroll
            for (int ai = 0; ai < 2; ++ai)
#pragma unroll
                for (int m = 0; m < 4; ++m) { bf16* rowp = UC + (size_t)(row0 + ai * HALF + m * 16) * D + u.pn * HALF + cw;
                    const f32x4 v0 = acc[ai][0][m][0] * acc[ai][1][m][0], v1 = acc[ai][0][m][1] * acc[ai][1][m][1];
                    v4u w; w.x = cvt_pk_bf16(v0[0], v0[1]); w.y = cvt_pk_bf16(v0[2], v0[3]); w.z = cvt_pk_bf16(v1[0], v1[1]); w.w = cvt_pk_bf16(v1[2], v1[3]);
                    *(v4u*)rowp = w; }
        } else {
#pragma unroll
            for (int ai = 0; ai < 2; ++ai)
#pragma unroll
                for (int m = 0; m < 4; ++m) { bf16* rowp = BGp + (size_t)(row0 + ai * HALF + m * 16) * D + (u.pn - 16) * BM + cw;
#pragma unroll
                    for (int bj = 0; bj < 2; ++bj) { const f32x4 v0 = acc[ai][bj][m][0], v1 = acc[ai][bj][m][1];
                        v4u w; w.x = cvt_pk_bf16(v0[0], v0[1]); w.y = cvt_pk_bf16(v0[2], v0[3]); w.z = cvt_pk_bf16(v1[0], v1[1]); w.w = cvt_pk_bf16(v1[2], v1[3]);
                        *(v4u*)(rowp + bj * HALF) = w; } }
        }
    }
};
__device__ __forceinline__ f32x4 silu_mul(f32x4 g, f32x4 uu) {
    f32x4 r;
#pragma unroll
    for (int j = 0; j < 4; ++j) r[j] = g[j] * __builtin_amdgcn_rcpf(1.0f + __expf(-g[j])) * uu[j];
    return r;
}
struct EpiExpertGU {
    static constexpr bool PERM = true;
    bf16* H;
    __device__ __forceinline__ void operator()(const f32x4 (&acc)[2][2][4][2], const Unit& u, int wr, int wc, int fr, int fq) const {
        asm volatile("" : "+v"(fr), "+v"(fq));
        const float* gates = (const float*)((const char*)u.rows + (WS_LGATE - WS_LTOK));
        const int cw = wc * 32 + 8 * fq;
        float gtv[2][4];
#pragma unroll
        for (int ai = 0; ai < 2; ++ai)
#pragma unroll
            for (int m = 0; m < 4; ++m) { const int r = ai * HALF + wr * 64 + m * 16 + fr; gtv[ai][m] = gates[r < u.nvalid ? r : 0]; }
        asm volatile("" : "+v"(gtv[0][0]), "+v"(gtv[0][1]), "+v"(gtv[0][2]), "+v"(gtv[0][3]), "+v"(gtv[1][0]), "+v"(gtv[1][1]), "+v"(gtv[1][2]), "+v"(gtv[1][3]));
#pragma unroll
        for (int ai = 0; ai < 2; ++ai)
#pragma unroll
            for (int m = 0; m < 4; ++m) { const int r = ai * HALF + wr * 64 + m * 16 + fr;
                if (r < u.nvalid) { const float gt = gtv[ai][m]; const unsigned pid = 0u;
                    const f32x4 v0 = silu_mul(acc[ai][0][m][0], acc[ai][1][m][0]) * gt, v1 = silu_mul(acc[ai][0][m][1], acc[ai][1][m][1]) * gt;
                    v4u w; w.x = cvt_pk_bf16(v0[0], v0[1]); w.y = cvt_pk_bf16(v0[2], v0[3]); w.z = cvt_pk_bf16(v1[0], v1[1]); w.w = cvt_pk_bf16(v1[2], v1[3]);
                    (void)pid; *(v4u*)(H + (size_t)(u.aux + r) * EDIM + cw) = w; } }
    }
};
struct EpiSharedGU {
    static constexpr bool PERM = true;
    bf16* HS;
    __device__ __forceinline__ void operator()(const f32x4 (&acc)[2][2][4][2], const Unit& u, int wr, int wc, int fr, int fq) const {
        asm volatile("" : "+v"(fr), "+v"(fq));
        const int row0 = u.pm * BM + wr * 64 + fr, cw = u.pn * HALF + wc * 32 + 8 * fq;
#pragma unroll
        for (int ai = 0; ai < 2; ++ai)
#pragma unroll
            for (int m = 0; m < 4; ++m) {
                const f32x4 v0 = silu_mul(acc[ai][0][m][0], acc[ai][1][m][0]), v1 = silu_mul(acc[ai][0][m][1], acc[ai][1][m][1]);
                v4u w; w.x = cvt_pk_bf16(v0[0], v0[1]); w.y = cvt_pk_bf16(v0[2], v0[3]); w.z = cvt_pk_bf16(v1[0], v1[1]); w.w = cvt_pk_bf16(v1[2], v1[3]);
                *(v4u*)(HS + (size_t)(row0 + ai * HALF + m * 16) * SDIM + cw) = w; }
    }
};
struct EpiDownY {
    static constexpr bool PERM = true;
    bf16* Y;
    __device__ __forceinline__ void operator()(const f32x4 (&acc)[2][2][4][2], const Unit& u, int wr, int wc, int fr, int fq) const {
        asm volatile("" : "+v"(fr), "+v"(fq));
        const int col0 = u.pn * BM + wc * 32 + 8 * fq;
#pragma unroll
        for (int ai = 0; ai < 2; ++ai)
#pragma unroll
            for (int m = 0; m < 4; ++m) { const int r = ai * HALF + wr * 64 + m * 16 + fr; bf16* rowp = Y + (size_t)(u.aux + r) * D + col0;
#pragma unroll
                for (int bj = 0; bj < 2; ++bj) { const f32x4 v0 = acc[ai][bj][m][0], v1 = acc[ai][bj][m][1];
                    v4u w; w.x = cvt_pk_bf16(v0[0], v0[1]); w.y = cvt_pk_bf16(v0[2], v0[3]); w.z = cvt_pk_bf16(v1[0], v1[1]); w.w = cvt_pk_bf16(v1[2], v1[3]);
                    *(v4u*)(rowp + bj * HALF) = w; } }
    }
};
}

struct Args { const float* in[19]; float* out; unsigned char* ws; int ph_lo, ph_hi; };
struct Frame {
    LAS unsigned char* lds; unsigned* ctl; unsigned char* ws;
    int tid, lane, wave, G, bid;
};
enum { IN_X = 0, IN_RELB, IN_PWIN, IN_PWG, IN_PSC, IN_PWOUT, IN_DQKV, IN_DOUT, IN_CWIN, IN_CW, IN_CWOUT, IN_LNG, IN_LNB, IN_RW, IN_RB, IN_EGU, IN_ED, IN_SGU, IN_SD };

#define CAS __attribute__((address_space(4)))
typedef const CAS unsigned char* KP;
__device__ __forceinline__ const float* ain(KP kp, int i) { return (const float*)((const GAS float* const CAS*)kp)[i]; }
__device__ __forceinline__ float* aout(KP kp) { return (float*)((GAS float* const CAS*)kp)[19]; }
__device__ __forceinline__ void tr_item(const float* W, int K, int N, bf16* WT, int dstK, int mode, LAS float* scr, int item, int lane) {
    const int nblk = N / 32, kb = item / nblk, nb = item % nblk, k0 = 64 * kb, n0 = 32 * nb;
    int r0 = n0;
    if (mode == 1) { const int part = n0 / 2048, j = n0 % 2048; r0 = (part == 0) ? 4096 + j : 256 * (j / 128) + (part == 2 ? 128 : 0) + (j % 128); }
    if (mode == 2) { const int part = n0 / 256, j = n0 % 256; r0 = 256 * (j / 128) + 128 * part + (j % 128); }
    float wv[32];
#pragma unroll
    for (int i = 0; i < 32; ++i) { const int kk = 2 * i + (lane >> 5); wv[i] = __builtin_nontemporal_load(W + (size_t)(k0 + kk) * N + n0 + (lane & 31)); }
#pragma unroll
    for (int i = 0; i < 32; ++i) { const int kk = 2 * i + (lane >> 5); scr[kk * 33 + (lane & 31)] = wv[i]; }
    LDS_WAIT(); asm volatile("" ::: "memory");
    const int c = lane & 7;
#pragma unroll
    for (int j = 0; j < 4; ++j) { const int n = (lane >> 3) + 8 * j; const LAS float* s = scr + (8 * c) * 33 + n;
        v4u o; o.x = pk2(s[0 * 33], s[1 * 33]); o.y = pk2(s[2 * 33], s[3 * 33]); o.z = pk2(s[4 * 33], s[5 * 33]); o.w = pk2(s[6 * 33], s[7 * 33]);
        __builtin_nontemporal_store(o, (v4u*)(WT + (size_t)(r0 + n) * dstK + k0 + 8 * c)); }
    LDS_WAIT(); asm volatile("" ::: "memory");
}
__device__ __forceinline__ void phase_prologue(const Frame& F, KP kp) {
    LAS float* scr = (LAS float*)(F.lds + F.wave * 16384);
    const int gw = F.bid * 8 + F.wave, NGW = F.G * 8;
    constexpr int I0 = 2 * 2048, I1 = 8 * 128, I2 = 2 * 2048, I3 = 4608, I4 = 512, I5 = 6144, I6 = 2048, I7 = 4 * 512, I8 = 4 * 256, I9 = 256 * 256, I10 = 256 * 128;
    constexpr int NITEMS = I0 + I1 + I2 + I3 + I4 + I5 + I6 + I7 + I8 + I9 + I10;
    unsigned char* ws = F.ws;
    for (int it = gw; it < NITEMS; it += NGW) {
        int r = it;
        if (r < I0) { const int b = r / 2048; tr_item(ain(kp, IN_PWIN) + (size_t)b * D * D, D, D, (bf16*)(ws + WS_W_POOL_IN) + (size_t)b * D * D, D, 0, scr, r % 2048, F.lane); continue; } r -= I0;
        if (r < I1) { const int b = r / 128; tr_item(ain(kp, IN_PWG) + (size_t)b * 512 * 512, 512, 512, (bf16*)(ws + WS_W_POOL_G) + (size_t)b * 512 * 512, 512, 0, scr, r % 128, F.lane); continue; } r -= I1;
        if (r < I2) { const int b = r / 2048; tr_item(ain(kp, IN_PWOUT) + (size_t)b * D * D, D, D, (bf16*)(ws + WS_W_POOL_OUT) + (size_t)b * D * D, D, 0, scr, r % 2048, F.lane); continue; } r -= I2;
        if (r < I3) { tr_item(ain(kp, IN_DQKV), D, QKVC, (bf16*)(ws + WS_W_DIL_QKV), D, 0, scr, r, F.lane); continue; } r -= I3;
        if (r < I4) { tr_item(ain(kp, IN_DOUT), DILW, D, (bf16*)(ws + WS_W_DIL_OUT), DILW, 0, scr, r, F.lane); continue; } r -= I4;
        if (r < I5) { tr_item(ain(kp, IN_CWIN), D, 3 * D, (bf16*)(ws + WS_W_CONV_IN), D, 1, scr, r, F.lane); continue; } r -= I5;
        if (r < I6) { tr_item(ain(kp, IN_CWOUT), D, D, (bf16*)(ws + WS_W_CONV_OUT), D, 0, scr, r, F.lane); continue; } r -= I6;
        if (r < I7) { const int b = r / 512; tr_item(ain(kp, IN_SGU) + (size_t)b * D * 512, D, 512, (bf16*)(ws + WS_W_SH_GU) + (size_t)b * 512 * D, D, 2, scr, r % 512, F.lane); continue; } r -= I7;
        if (r < I8) { const int b = r / 256; tr_item(ain(kp, IN_SD) + (size_t)b * SDIM * D, SDIM, D, (bf16*)(ws + WS_W_SH_D) + (size_t)b * D * SDIM, SDIM, 0, scr, r % 256, F.lane); continue; } r -= I8;
        if (r < I9) { const int b = r / 256; tr_item(ain(kp, IN_EGU) + (size_t)b * D * 256, D, 256, (bf16*)(ws + WS_W_EX_GU) + (size_t)b * 256 * D, D, 0, scr, r % 256, F.lane); continue; } r -= I9;
        { const int b = r / 128; tr_item(ain(kp, IN_ED) + (size_t)b * EDIM * D, EDIM, D, (bf16*)(ws + WS_W_EX_D) + (size_t)b * D * EDIM, EDIM, 0, scr, r % 128, F.lane); }
    }
    const size_t gt = (size_t)F.bid * 512 + F.tid, GT = (size_t)F.G * 512;
    { const float* rw = ain(kp, IN_RW); bf16* wh = (bf16*)(ws + WS_RWH); bf16* wl = (bf16*)(ws + WS_RWL);
      for (size_t i = gt; i < (size_t)DEPTH * NEXP * D / 8; i += GT) { const size_t k8 = i % (D / 8), e = (i / (D / 8)) % NEXP, l = i / ((size_t)NEXP * D / 8);
          float v[8]; unsigned hi[8], lo[8];
#pragma unroll
          for (int j = 0; j < 8; ++j) { v[j] = rw[(l * D + k8 * 8 + j) * NEXP + e]; hi[j] = f2bf(v[j]); lo[j] = f2bf(v[j] - __builtin_bit_cast(float, hi[j] << 16)); }
          v4u a, b2; a.x = hi[0] | (hi[1] << 16); a.y = hi[2] | (hi[3] << 16); a.z = hi[4] | (hi[5] << 16); a.w = hi[6] | (hi[7] << 16);
          b2.x = lo[0] | (lo[1] << 16); b2.y = lo[2] | (lo[3] << 16); b2.z = lo[4] | (lo[5] << 16); b2.w = lo[6] | (lo[7] << 16);
          *(v4u*)(wh + (l * NEXP + e) * D + k8 * 8) = a; *(v4u*)(wl + (l * NEXP + e) * D + k8 * 8) = b2; } }
    const float* x = ain(kp, IN_X); bf16* xb = (bf16*)(ws + WS_XB);
    for (size_t i = gt; i < (size_t)T * D / 8; i += GT) { const f32x4 p = __builtin_nontemporal_load((const f32x4*)(x + i * 8)), q = __builtin_nontemporal_load((const f32x4*)(x + i * 8 + 4));
        v4u w; w.x = pk2(p[0], p[1]); w.y = pk2(p[2], p[3]); w.z = pk2(q[0], q[1]); w.w = pk2(q[2], q[3]); *(v4u*)(xb + i * 8) = w; }
}

__device__ __forceinline__ void unpack8(const v4u w, float (&f)[8]) { f[0] = bflo(w.x); f[1] = bfhi(w.x); f[2] = bflo(w.y); f[3] = bfhi(w.y); f[4] = bflo(w.z); f[5] = bfhi(w.z); f[6] = bflo(w.w); f[7] = bfhi(w.w); }
__device__ __forceinline__ void phase_pool(const Frame& F, const bf16* U, bf16* PL) {
    for (int it = F.bid * 512 + F.tid; it < (T / 32) * 256; it += F.G * 512) {
        const int cv = it & 255, ch = it >> 8, col = cv * 8;
        const int w = __builtin_amdgcn_readfirstlane(2 << (col >> 9));
        const int row0 = __builtin_amdgcn_readfirstlane(ch * 32), pos0 = row0 & (SEQ - 1);
        float s[8], uu[8];
#pragma unroll
        for (int j = 0; j < 8; ++j) s[j] = 0.f;
        { v4u pre[15];
#pragma unroll
          for (int j = 0; j < 15; ++j) { pre[j] = (v4u){0u, 0u, 0u, 0u}; if (j + 1 < w && pos0 - (j + 1) >= 0) pre[j] = *(const v4u*)(U + (size_t)(row0 - (j + 1)) * D + col); }
#pragma unroll
          for (int j = 0; j < 15; ++j) asm volatile("" : "+v"(pre[j]));
#pragma unroll
          for (int j = 0; j < 15; ++j) { unpack8(pre[j], uu);
#pragma unroll
              for (int q = 0; q < 8; ++q) s[q] += uu[q]; } }
#pragma unroll 1
        for (int cb = 0; cb < 4; ++cb) {
            v4u un[8], uo[8];
#pragma unroll
            for (int j = 0; j < 8; ++j) { const int r = 8 * cb + j, t = row0 + r, pos = pos0 + r;
                un[j] = *(const v4u*)(U + (size_t)t * D + col);
                uo[j] = (v4u){0u, 0u, 0u, 0u}; if (pos - w + 1 >= 0) uo[j] = *(const v4u*)(U + (size_t)(t - w + 1) * D + col); }
#pragma unroll
            for (int j = 0; j < 8; ++j) asm volatile("" : "+v"(un[j]), "+v"(uo[j]));
#pragma unroll
            for (int j = 0; j < 8; ++j) { const int r = 8 * cb + j, t = row0 + r, pos = pos0 + r;
                unpack8(un[j], uu);
                const float inv = 1.0f / (float)((pos + 1) < w ? (pos + 1) : w);
                float o[8];
#pragma unroll
                for (int q = 0; q < 8; ++q) { s[q] += uu[q]; o[q] = s[q] * inv - uu[q]; }
                v4u ww; ww.x = pk2(o[0], o[1]); ww.y = pk2(o[2], o[3]); ww.z = pk2(o[4], o[5]); ww.w = pk2(o[6], o[7]);
                *(v4u*)(PL + (size_t)t * D + col) = ww;
                unpack8(uo[j], uu);
#pragma unroll
                for (int q = 0; q < 8; ++q) s[q] -= uu[q]; }
        }
    }
}

__device__ __forceinline__ void phase_conv(const Frame& F, const bf16* UC, const bf16* BGp, const float* cw, bf16* Z) {
    for (int it = F.bid * 512 + F.tid; it < (T / 4) * 256; it += F.G * 512) {
        const int cv = it & 255, col = cv * 8, t0 = __builtin_amdgcn_readfirstlane((it >> 8) * 4), pos0 = t0 & (SEQ - 1);
        v4u ur[6], br[4];
#pragma unroll
        for (int j = 0; j < 6; ++j) { ur[j] = (v4u){0u, 0u, 0u, 0u}; if (j >= 2 || pos0 > 0) ur[j] = *(const v4u*)(UC + (size_t)(t0 - 2 + j) * D + col); }
#pragma unroll
        for (int j = 0; j < 4; ++j) br[j] = *(const v4u*)(BGp + (size_t)(t0 + j) * D + col);
        const f32x4 c0a = *(const f32x4*)(cw + col), c0b = *(const f32x4*)(cw + col + 4), c1a = *(const f32x4*)(cw + D + col), c1b = *(const f32x4*)(cw + D + col + 4), c2a = *(const f32x4*)(cw + 2 * D + col), c2b = *(const f32x4*)(cw + 2 * D + col + 4);
        asm volatile("" : "+v"(ur[0]), "+v"(ur[1]), "+v"(ur[2]), "+v"(ur[3]), "+v"(ur[4]), "+v"(ur[5]), "+v"(br[0]), "+v"(br[1]), "+v"(br[2]), "+v"(br[3]));
        const float c0[8] = {c0a[0], c0a[1], c0a[2], c0a[3], c0b[0], c0b[1], c0b[2], c0b[3]}, c1[8] = {c1a[0], c1a[1], c1a[2], c1a[3], c1b[0], c1b[1], c1b[2], c1b[3]}, c2[8] = {c2a[0], c2a[1], c2a[2], c2a[3], c2b[0], c2b[1], c2b[2], c2b[3]};
#pragma unroll
        for (int j = 0; j < 4; ++j) { float u0[8], u1[8], u2[8], bb[8], o[8];
            unpack8(ur[j], u0); unpack8(ur[j + 1], u1); unpack8(ur[j + 2], u2); unpack8(br[j], bb);
#pragma unroll
            for (int q = 0; q < 8; ++q) o[q] = bb[q] * (c0[q] * u0[q] + c1[q] * u1[q] + c2[q] * u2[q]);
            v4u ww; ww.x = pk2(o[0], o[1]); ww.y = pk2(o[2], o[3]); ww.z = pk2(o[4], o[5]); ww.w = pk2(o[6], o[7]);
            *(v4u*)(Z + (size_t)(t0 + j) * D + col) = ww; }
    }
}

__device__ __forceinline__ int t5_bucket(int dist) {
    if (dist < 16) return dist;
    int large = 16 + (int)(logf((float)dist / 16.0f) / logf(128.0f) * 16.0f);
    return large < 31 ? large : 31;
}
constexpr int AT_KS = 0, AT_KSTR = 144, AT_VT = 256 * 144, AT_VSTR = 520, AT_BIAS = AT_VT + 64 * 520;
__device__ __forceinline__ void phase_attn(const Frame& F, const bf16* QKV, const float* relb, bf16* OG, float* LSE) {
    LAS unsigned char* lds = F.lds;
    const int tid = F.tid, lane = F.lane, w = tid >> 6, fr = lane & 15, fq = lane >> 4;
    for (int unit = F.bid; unit < NBATCH * 3 * 8 * 16; unit += F.G) {
        const int cmb = unit & 15, h = (unit >> 4) & 7, g = (unit >> 7) % 3, b = unit / 384;
        const int dsh = 2 * g, dil = 1 << dsh, r = cmb & (dil - 1), nb = cmb >> dsh;
        const bf16* base = QKV + (size_t)b * SEQ * QKVC + g * 1536 + h * 64;
        __syncthreads();
        {
            const int key = tid >> 1, half = tid & 1, jk = (nb - 1) * 128 + key;
            v4u kv[4], vv[4];
            if (jk >= 0) { const bf16* rp = base + (size_t)(jk * dil + r) * QKVC + half * 32;
#pragma unroll
                for (int i = 0; i < 4; ++i) { kv[i] = *(const v4u*)(rp + 512 + 8 * i); vv[i] = *(const v4u*)(rp + 1024 + 8 * i); } }
            else {
#pragma unroll
                for (int i = 0; i < 4; ++i) { kv[i] = (v4u){0u, 0u, 0u, 0u}; vv[i] = (v4u){0u, 0u, 0u, 0u}; } }
#pragma unroll
            for (int i = 0; i < 4; ++i) *(LAS v4u*)(lds + AT_KS + key * AT_KSTR + half * 64 + 16 * i) = kv[i];
#pragma unroll
            for (int i = 0; i < 4; ++i) {
                const unsigned ww[4] = {vv[i].x, vv[i].y, vv[i].z, vv[i].w};
#pragma unroll
                for (int q = 0; q < 4; ++q) { const int d = half * 32 + 8 * i + 2 * q;
                    *(LAS unsigned short*)(lds + AT_VT + d * AT_VSTR + key * 2) = (unsigned short)(ww[q] & 0xffffu);
                    *(LAS unsigned short*)(lds + AT_VT + (d + 1) * AT_VSTR + key * 2) = (unsigned short)(ww[q] >> 16); } }
            if (tid <= 128) ((LAS float*)(lds + AT_BIAS))[tid] = relb[t5_bucket(tid * dil) * 24 + g * 8 + h];
        }
        __syncthreads();
        int qi = 16 * w + fr; asm volatile("" : "+v"(qi));
        const int jq = nb * 128 + qi, tq = jq * dil + r;
        const bf16* qp = base + (size_t)tq * QKVC + 8 * fq;
        const bf16x8 q0 = *(const bf16x8*)qp, q1 = *(const bf16x8*)(qp + 32);
        f32x4 s[9]; float mx = -INFINITY;
#pragma unroll
        for (int kt = 0; kt < 9; ++kt) {
            const int kb = 16 * (w + kt);
            const bf16x8 k0 = *(const LAS bf16x8*)(lds + AT_KS + (kb + fr) * AT_KSTR + fq * 16), k1 = *(const LAS bf16x8*)(lds + AT_KS + (kb + fr) * AT_KSTR + 64 + fq * 16);
            f32x4 a = (f32x4){0.f, 0.f, 0.f, 0.f};
            a = __builtin_amdgcn_mfma_f32_16x16x32_bf16(k0, q0, a, 0, 0, 0);
            a = __builtin_amdgcn_mfma_f32_16x16x32_bf16(k1, q1, a, 0, 0, 0);
#pragma unroll
            for (int i = 0; i < 4; ++i) { const int kl = kb + 4 * fq + i, rel = qi + 128 - kl;
                const bool ok = (rel >= 0) && (rel <= 128) && (nb > 0 || kl >= 128);
                const int rc = rel < 0 ? 0 : (rel > 128 ? 128 : rel);
                float bv_ = ((LAS float*)(lds + AT_BIAS))[rc]; asm volatile("" : "+v"(bv_));
                const float v = ok ? a[i] + bv_ : -INFINITY;
                a[i] = v; mx = fmaxf(mx, v); }
            s[kt] = a;
        }
        mx = fmaxf(mx, shfl_x(mx, 16, lane)); mx = fmaxf(mx, shfl_x(mx, 32, lane));
        float l = 0.f;
#pragma unroll
        for (int kt = 0; kt < 9; ++kt)
#pragma unroll
            for (int i = 0; i < 4; ++i) { const float p = __expf(s[kt][i] - mx); s[kt][i] = p; l += p; }
        l += shfl_x(l, 16, lane); l += shfl_x(l, 32, lane);
        f32x4 o[4];
#pragma unroll
        for (int nt = 0; nt < 4; ++nt) o[nt] = (f32x4){0.f, 0.f, 0.f, 0.f};
#pragma unroll
        for (int st = 0; st < 5; ++st) {
            const int kt0 = 2 * st, kt1 = 2 * st + 1;
            v4u pw; pw.x = pk2(s[kt0][0], s[kt0][1]); pw.y = pk2(s[kt0][2], s[kt0][3]);
            if (kt1 < 9) { pw.z = pk2(s[kt1 < 9 ? kt1 : 0][0], s[kt1 < 9 ? kt1 : 0][1]); pw.w = pk2(s[kt1 < 9 ? kt1 : 0][2], s[kt1 < 9 ? kt1 : 0][3]); } else { pw.z = 0u; pw.w = 0u; }
            const bf16x8 pf = __builtin_bit_cast(bf16x8, pw);
            const int kb0 = 16 * (w + kt0) + 4 * fq, kb1 = 16 * (w + kt1) + 4 * fq;
#pragma unroll
            for (int nt = 0; nt < 4; ++nt) { const int d = 16 * nt + fr;
                v2u va = *(const LAS v2u*)(lds + AT_VT + d * AT_VSTR + kb0 * 2), vb = (v2u){0u, 0u};
                if (kt1 < 9) vb = *(const LAS v2u*)(lds + AT_VT + d * AT_VSTR + kb1 * 2);
                v4u vw; vw.x = va.x; vw.y = va.y; vw.z = vb.x; vw.w = vb.y;
                o[nt] = __builtin_amdgcn_mfma_f32_16x16x32_bf16(__builtin_bit_cast(bf16x8, vw), pf, o[nt], 0, 0, 0); }
        }
        const float il = 1.0f / l;
        bf16* op = OG + ((size_t)g * T + (size_t)b * SEQ + tq) * DILW + h * 64 + 4 * fq;
#pragma unroll
        for (int nt = 0; nt < 4; ++nt) { v2u ww; ww.x = pk2(o[nt][0] * il, o[nt][1] * il); ww.y = pk2(o[nt][2] * il, o[nt][3] * il); *(v2u*)(op + 16 * nt) = ww; }
        if (fq == 0) LSE[((size_t)g * T + (size_t)b * SEQ + tq) * 8 + h] = mx + logf(l);
    }
}
__device__ __forceinline__ void phase_combine(const Frame& F, const bf16* OG, const float* LSE, bf16* O) {
    for (int it0 = F.bid * 512 + F.tid; it0 < T * 64; it0 += 4 * F.G * 512) {
        float ls[4][3]; v4u og[4][3];
#pragma unroll
        for (int u = 0; u < 4; ++u) { int it = it0 + u * F.G * 512; it = it < T * 64 ? it : it0;
            const int c8 = it & 7, h = (it >> 3) & 7, t = it >> 6; const size_t off = (size_t)t * DILW + h * 64 + c8 * 8;
#pragma unroll
            for (int g = 0; g < 3; ++g) { ls[u][g] = LSE[((size_t)g * T + t) * 8 + h]; og[u][g] = *(const v4u*)(OG + (size_t)g * T * DILW + off); } }
#pragma unroll
        for (int u = 0; u < 4; ++u) asm volatile("" : "+v"(ls[u][0]), "+v"(ls[u][1]), "+v"(ls[u][2]), "+v"(og[u][0]), "+v"(og[u][1]), "+v"(og[u][2]));
#pragma unroll
        for (int u = 0; u < 4; ++u) { const int it = it0 + u * F.G * 512, c8 = it & 7, h = (it >> 3) & 7, t = it >> 6; const size_t off = (size_t)t * DILW + h * 64 + c8 * 8;
            if (it >= T * 64) continue;
            const float l0 = ls[u][0], l1 = ls[u][1], l2 = ls[u][2];
            const float m = fmaxf(l0, fmaxf(l1, l2)); float w0 = __expf(l0 - m), w1 = __expf(l1 - m), w2 = __expf(l2 - m); const float inv = 1.0f / (w0 + w1 + w2); w0 *= inv; w1 *= inv; w2 *= inv;
            float a[8], bq[8], c[8], o[8];
            unpack8(og[u][0], a); unpack8(og[u][1], bq); unpack8(og[u][2], c);
#pragma unroll
            for (int q = 0; q < 8; ++q) o[q] = w0 * a[q] + w1 * bq[q] + w2 * c[q];
            v4u ww; ww.x = pk2(o[0], o[1]); ww.y = pk2(o[2], o[3]); ww.z = pk2(o[4], o[5]); ww.w = pk2(o[6], o[7]);
            *(v4u*)(O + off) = ww; }
    }
}

constexpr int M1_LOG = 131072, M1_STAT = M1_LOG + 4096, M1_HIST = M1_STAT + 128, M1_BASE = M1_HIST + 256;
__device__ __forceinline__ void phase_moe1(const Frame& F, const float* Y, const float* gain, const float* bias, const float* RW, const float* RB,
                                           float* X1F, bf16* X1B, unsigned* cnt, int* ltok, float* lgate, int* eidx, int* inv) {
    LAS float* xs = (LAS float*)F.lds; LAS float* logit = (LAS float*)(F.lds + M1_LOG); LAS float* stat = (LAS float*)(F.lds + M1_STAT);
    LAS int* hist = (LAS int*)(F.lds + M1_HIST); LAS int* basep = (LAS int*)(F.lds + M1_BASE);
    const int tid = F.tid, lane = F.lane, w = F.wave;
    for (int rg = F.bid; rg < T / 16; rg += F.G) {
        const int row0 = rg * 16;
        __syncthreads();
#pragma unroll
        for (int j = 0; j < 16; ++j) { const int idx = tid + 512 * j; *(LAS f32x4*)(xs + idx * 4) = *(const f32x4*)(Y + (size_t)row0 * D + (size_t)idx * 4); }
        if (tid < 64) hist[tid] = 0;
        __syncthreads();
#pragma unroll
        for (int rr = 0; rr < 2; ++rr) { const int r = 2 * w + rr; float sm = 0.f;
#pragma unroll
            for (int j = 0; j < 32; ++j) sm += xs[r * D + lane + 64 * j];
            const float mean = wave_sum(sm, lane) * (1.0f / D); float sq = 0.f;
#pragma unroll
            for (int j = 0; j < 32; ++j) { const float d = xs[r * D + lane + 64 * j] - mean; sq += d * d; }
            const float rstd = 1.0f / sqrtf(wave_sum(sq, lane) * (1.0f / D) + LN_EPS);
            if (lane == 0) { stat[2 * r] = mean; stat[2 * r + 1] = rstd; } }
        __syncthreads();
#pragma unroll
        for (int j = 0; j < 16; ++j) { const int idx = tid + 512 * j, r = idx >> 9, c4 = (idx & 511) * 4;
            const f32x4 v = *(LAS f32x4*)(xs + idx * 4), gv = *(const f32x4*)(gain + c4), bv = *(const f32x4*)(bias + c4);
            const float mean = stat[2 * r], rstd = stat[2 * r + 1];
            const f32x4 o = (v - mean) * rstd * gv + bv;
            *(LAS f32x4*)(xs + idx * 4) = o;
            *(f32x4*)(X1F + (size_t)(row0 + r) * D + c4) = o;
            v2u wb; wb.x = pk2(o[0], o[1]); wb.y = pk2(o[2], o[3]); *(v2u*)(X1B + (size_t)(row0 + r) * D + c4) = wb; }
        __syncthreads();
        { const int r = tid >> 5, ep = tid & 31; float a0 = 0.f, a1 = 0.f; const float* wp = RW + 2 * ep; const LAS float* xr = xs + r * D;
            for (int k0 = 0; k0 < D; k0 += 16) {
                f32x2 wv[16];
#pragma unroll
                for (int j = 0; j < 16; ++j) wv[j] = *(const f32x2*)(wp + (size_t)(k0 + j) * NEXP);
                asm volatile("" : "+v"(wv[0]), "+v"(wv[1]), "+v"(wv[2]), "+v"(wv[3]), "+v"(wv[4]), "+v"(wv[5]), "+v"(wv[6]), "+v"(wv[7]));
                asm volatile("" : "+v"(wv[8]), "+v"(wv[9]), "+v"(wv[10]), "+v"(wv[11]), "+v"(wv[12]), "+v"(wv[13]), "+v"(wv[14]), "+v"(wv[15]));
#pragma unroll
                for (int j = 0; j < 16; ++j) { const float xv = xr[k0 + j]; a0 += xv * wv[j].x; a1 += xv * wv[j].y; } }
            logit[r * NEXP + 2 * ep] = a0; logit[r * NEXP + 2 * ep + 1] = a1; }
        __syncthreads();
        int sel_pos[2]; float sel_gate[2]; int sel_rank[2]; bool sel_on[2];
#pragma unroll
        for (int rr = 0; rr < 2; ++rr) { const int r = 2 * w + rr;
            const float sc = 1.0f / (1.0f + __expf(-logit[r * NEXP + lane])); const float ch = sc + RB[lane];
            int rk = 0;
#pragma unroll
            for (int j = 0; j < 8; ++j) { const float cj = shfl_from(ch, (lane & ~7) + j); rk += (cj > ch || (cj == ch && j < (lane & 7))) ? 1 : 0; }
            float gs = rk < 2 ? ch : 0.f; gs += shfl_x(gs, 1, lane); gs += shfl_x(gs, 2, lane); gs += shfl_x(gs, 4, lane);
            int grk = 0; const int g = lane >> 3;
#pragma unroll
            for (int hh = 0; hh < 8; ++hh) { const float gh = shfl_from(gs, 8 * hh); grk += (gh > gs || (gh == gs && hh < g)) ? 1 : 0; }
            const float msk = grk < 4 ? ch : -INFINITY;
            int erk = 0;
            for (int j = 0; j < 64; ++j) { const float mj = __builtin_bit_cast(float, __builtin_amdgcn_readlane(__builtin_bit_cast(int, msk), j)); erk += (mj > msk || (mj == msk && j < lane)) ? 1 : 0; }
            const bool on = erk < 8;
            const float ssum = wave_sum(on ? sc : 0.f, lane);
            sel_on[rr] = on; sel_rank[rr] = erk; sel_gate[rr] = sc / ssum * 2.5f; sel_pos[rr] = 0;
            if (on) sel_pos[rr] = __hip_atomic_fetch_add(&hist[lane], 1, __ATOMIC_RELAXED, __HIP_MEMORY_SCOPE_WORKGROUP); }
        __syncthreads();
        if (tid < 64) { const int hc = hist[tid]; int bs = 0; if (hc > 0) bs = (int)atomicAdd(&cnt[tid * 16], (unsigned)hc); basep[tid] = bs; }
        __syncthreads();
#pragma unroll
        for (int rr = 0; rr < 2; ++rr) if (sel_on[rr]) { const int t = row0 + 2 * w + rr, pos = basep[lane] + sel_pos[rr];
            ltok[(size_t)lane * CAP + pos] = t; lgate[(size_t)lane * CAP + pos] = sel_gate[rr];
            eidx[t * 8 + sel_rank[rr]] = lane; inv[t * 8 + sel_rank[rr]] = pos; }
    }
}
__device__ __forceinline__ int build_tiles(const Frame& F, const unsigned* cnt) {
    LAS int* tpref = (LAS int*)(F.lds + LDS_TAB); LAS int* cl = (LAS int*)(F.lds + LDS_TAB + 512);
    __syncthreads();
    if (F.tid < 64) {
        const int lane = F.lane; const int c = (int)__hip_atomic_load(&cnt[lane * 16], __ATOMIC_RELAXED, __HIP_MEMORY_SCOPE_AGENT);
        const int tl = (c + 255) >> 8; int inc = tl;
#pragma unroll
        for (int o = 1; o < 64; o <<= 1) { const int v = __builtin_amdgcn_ds_bpermute((lane >= o ? lane - o : lane) << 2, inc); inc += lane >= o ? v : 0; }
        cl[lane] = c; tpref[lane] = inc - tl;
        if (lane == 63) { tpref[64] = inc; tpref[65] = inc + T / 256; tpref[66] = inc + 2 * (T / 256); cl[64] = T; cl[65] = T; } }
    __syncthreads();
    return __builtin_amdgcn_readfirstlane(tpref[64]);
}
__device__ __forceinline__ void phase_moe4(const Frame& F, const float* Y2, const bf16* Yr, const int* eidx, const int* inv, const float* gain, const float* bias, float* XO, bf16* XBo) {
    const LAS int* tpref = (const LAS int*)(F.lds + LDS_TAB);
    const int gw = F.bid * 8 + F.wave, NGW = F.G * 8, lane = F.lane;
    for (int t = gw; t < T; t += NGW) {
        f32x4 v[8];
#pragma unroll
        for (int j = 0; j < 8; ++j) v[j] = *(const f32x4*)(Y2 + (size_t)t * D + 4 * lane + 256 * j);
        for (int k = 0; k < 8; ++k) { const int e = eidx[t * 8 + k], pos = inv[t * 8 + k]; const bf16* yr = Yr + (size_t)(tpref[e] * 256 + pos) * D + 4 * lane;
#pragma unroll
            for (int j = 0; j < 8; ++j) { const v2u w = *(const v2u*)(yr + 256 * j); v[j][0] += bflo(w.x); v[j][1] += bfhi(w.x); v[j][2] += bflo(w.y); v[j][3] += bfhi(w.y); } }
        float sm = 0.f;
#pragma unroll
        for (int j = 0; j < 8; ++j) sm += (v[j][0] + v[j][1]) + (v[j][2] + v[j][3]);
        const float mean = wave_sum(sm, lane) * (1.0f / D); float sq = 0.f;
#pragma unroll
        for (int j = 0; j < 8; ++j) { v[j] = v[j] - mean; sq += (v[j][0] * v[j][0] + v[j][1] * v[j][1]) + (v[j][2] * v[j][2] + v[j][3] * v[j][3]); }
        const float rstd = 1.0f / sqrtf(wave_sum(sq, lane) * (1.0f / D) + LN_EPS);
#pragma unroll
        for (int j = 0; j < 8; ++j) { const int c = 4 * lane + 256 * j; const f32x4 o = v[j] * rstd * *(const f32x4*)(gain + c) + *(const f32x4*)(bias + c);
            *(f32x4*)(XO + (size_t)t * D + c) = o;
            v2u wb; wb.x = pk2(o[0], o[1]); wb.y = pk2(o[2], o[3]); *(v2u*)(XBo + (size_t)t * D + c) = wb; }
    }
}


template <int CTRL> __device__ __forceinline__ float dppf(float x) { return __builtin_bit_cast(float, __builtin_amdgcn_update_dpp(0, __builtin_bit_cast(int, x), CTRL, 0xF, 0xF, false)); }
__device__ __forceinline__ float gmax8(float x) { x = fmaxf(x, dppf<0xB1>(x)); x = fmaxf(x, dppf<0x4E>(x)); x = fmaxf(x, dppf<0x141>(x)); return x; }
__device__ __forceinline__ float gsum8(float x) { x += dppf<0xB1>(x); x += dppf<0x4E>(x); x += dppf<0x141>(x); return x; }
__device__ __forceinline__ float rl_f(float x, int l) { return __builtin_bit_cast(float, __builtin_amdgcn_readlane(__builtin_bit_cast(int, x), l)); }
constexpr int M1_P = 0, M1N_HIST = 131072, M1N_BASE = 131072 + 256, M1N_GB = 131072 + 1024;
__device__ __forceinline__ void phase_moe1n(const Frame& F, const bf16* Y, const float* pst, const float* gain, const float* bias, const bf16* WH, const bf16* WL, const float* RB,
                                            bf16* X1B, float* ST1, unsigned* cnt, int* ltok, float* lgate, int* eidx, int* inv) {
    LAS float* P = (LAS float*)(F.lds + M1_P); LAS int* hist = (LAS int*)(F.lds + M1N_HIST); LAS int* basep = (LAS int*)(F.lds + M1N_BASE);
    const int tid = F.tid, lane = F.lane, w = F.wave, r = lane & 15, q = lane >> 4;
    for (int item = F.bid; item < T / 64; item += F.G) {
        const int row0 = item * 64;
        __syncthreads();
        { int t0 = tid; asm volatile("" : "+v"(t0));
          if (t0 < 64) hist[t0] = 0;
          LAS f32x4* gb = (LAS f32x4*)(F.lds + M1N_GB); gb[t0] = *(const f32x4*)(gain + 4 * t0); gb[512 + t0] = *(const f32x4*)(bias + 4 * t0); }
        __syncthreads();
        float mean[4], rstd[4];
#pragma unroll
        for (int rt = 0; rt < 4; ++rt) { const int row = row0 + 16 * rt + r;
          const f32x4* pp = (const f32x4*)(pst + ((size_t)row * 32 + q * 8) * 2); const f32x4 a = pp[0], b = pp[1], c = pp[2], d = pp[3];
          float sm = (a[0] + a[2]) + (b[0] + b[2]) + (c[0] + c[2]) + (d[0] + d[2]), sq = (a[1] + a[3]) + (b[1] + b[3]) + (c[1] + c[3]) + (d[1] + d[3]);
          sm += shfl_x(sm, 16, lane); sm += shfl_x(sm, 32, lane); sq += shfl_x(sq, 16, lane); sq += shfl_x(sq, 32, lane);
          mean[rt] = sm * (1.0f / D); const float var = fmaxf(sq * (1.0f / D) - mean[rt] * mean[rt], 0.f); rstd[rt] = 1.0f / sqrtf(var + LN_EPS);
          if (w == 0 && q == 0) *(f32x2*)(ST1 + 2 * row) = (f32x2){mean[rt], rstd[rt]}; }
        const int kb = 256 * w + 8 * q;
        const LAS float* gl = (const LAS float*)(F.lds + M1N_GB) + kb;
        f32x4 acc[4][4];
#pragma unroll
        for (int rt = 0; rt < 4; ++rt)
#pragma unroll
            for (int nt = 0; nt < 4; ++nt) acc[rt][nt] = (f32x4){0.f, 0.f, 0.f, 0.f};
        v4u yb[2][2][4], hb[4]; bf16x8 wh[4], wl[4];
        unsigned vo[4];
#pragma unroll
        for (int i = 0; i < 4; ++i) { vo[i] = (unsigned)(r * D + kb) * 2u + (unsigned)i * (16u * D * 2u); asm volatile("" : "+v"(vo[i])); }
        const char* ybase = (const char*)(Y + (size_t)row0 * D); char* xbase = (char*)(X1B + (size_t)row0 * D);
#define M1_LOADY(ms) do { _Pragma("unroll") for (int hf = 0; hf < 2; ++hf) _Pragma("unroll") for (int rt = 0; rt < 4; ++rt) yb[(ms) & 1][hf][rt] = *(const v4u*)(ybase + vo[rt] + 128 * (ms) + 64 * hf); } while (0)
#define M1_LOADW(st) do { _Pragma("unroll") for (int nt = 0; nt < 4; ++nt) { wh[nt] = *(const bf16x8*)((const char*)WH + vo[nt] + 64 * (st)); wl[nt] = *(const bf16x8*)((const char*)WL + vo[nt] + 64 * (st)); } } while (0)
        M1_LOADY(0); M1_LOADW(0); M1_LOADY(1);
        __builtin_amdgcn_sched_barrier(0);
#pragma unroll
        for (int st = 0; st < 8; ++st) {
            const f32x4 g0 = *(const LAS f32x4*)(gl + 32 * st), g1 = *(const LAS f32x4*)(gl + 32 * st + 4), b0 = *(const LAS f32x4*)(gl + 2048 + 32 * st), b1 = *(const LAS f32x4*)(gl + 2048 + 32 * st + 4);
#pragma unroll
            for (int rt = 0; rt < 4; ++rt) { const v4u yv = yb[(st >> 1) & 1][st & 1][rt];
                const f32x4 y0_ = (f32x4){bflo(yv.x), bfhi(yv.x), bflo(yv.y), bfhi(yv.y)}, y1_ = (f32x4){bflo(yv.z), bfhi(yv.z), bflo(yv.w), bfhi(yv.w)};
                const f32x4 x0 = (y0_ - mean[rt]) * rstd[rt] * g0 + b0, x1 = (y1_ - mean[rt]) * rstd[rt] * g1 + b1;
                v4u h; h.x = cvt_pk_bf16(x0[0], x0[1]); h.y = cvt_pk_bf16(x0[2], x0[3]); h.z = cvt_pk_bf16(x1[0], x1[1]); h.w = cvt_pk_bf16(x1[2], x1[3]);
                if ((st & 1) == 0) hb[rt] = h; else { *(v4u*)(xbase + vo[rt] + 64 * (st - 1)) = hb[rt]; *(v4u*)(xbase + vo[rt] + 64 * st) = h; }
                v4u l; l.x = cvt_pk_bf16(x0[0] - bflo(h.x), x0[1] - bfhi(h.x)); l.y = cvt_pk_bf16(x0[2] - bflo(h.y), x0[3] - bfhi(h.y));
                l.z = cvt_pk_bf16(x1[0] - bflo(h.z), x1[1] - bfhi(h.z)); l.w = cvt_pk_bf16(x1[2] - bflo(h.w), x1[3] - bfhi(h.w));
                const bf16x8 xh = __builtin_bit_cast(bf16x8, h), xl = __builtin_bit_cast(bf16x8, l);
#pragma unroll
                for (int nt = 0; nt < 4; ++nt) { acc[rt][nt] = __builtin_amdgcn_mfma_f32_16x16x32_bf16(xh, wh[nt], acc[rt][nt], 0, 0, 0);
                    acc[rt][nt] = __builtin_amdgcn_mfma_f32_16x16x32_bf16(xl, wh[nt], acc[rt][nt], 0, 0, 0); acc[rt][nt] = __builtin_amdgcn_mfma_f32_16x16x32_bf16(xh, wl[nt], acc[rt][nt], 0, 0, 0); } }
            __builtin_amdgcn_sched_barrier(0);
            if (st + 1 < 8) M1_LOADW(st + 1);
            if ((st & 1) == 1 && (st >> 1) + 2 < 4) M1_LOADY((st >> 1) + 2);
            __builtin_amdgcn_sched_barrier(0);
        }
#undef M1_LOADY
#undef M1_LOADW
#pragma unroll
        for (int rt = 0; rt < 4; ++rt)
#pragma unroll
            for (int nt = 0; nt < 4; ++nt)
#pragma unroll
                for (int i = 0; i < 4; ++i) P[(w * 64 + 16 * rt + 4 * q + i) * 64 + 16 * nt + r] = acc[rt][nt][i];
        __syncthreads();
        const float rb = RB[lane];
        LAS int* Pi = (LAS int*)P;
#pragma unroll 1
        for (int rr = 0; rr < 8; ++rr) { const int rl = 8 * w + rr;
            float lg = ((P[rl * 64 + lane] + P[(64 + rl) * 64 + lane]) + (P[(128 + rl) * 64 + lane] + P[(192 + rl) * 64 + lane])) + ((P[(256 + rl) * 64 + lane] + P[(320 + rl) * 64 + lane]) + (P[(384 + rl) * 64 + lane] + P[(448 + rl) * 64 + lane]));
            lg = (lg == lg) ? lg : -1.0e30f;
            const float sc = 1.0f / (1.0f + __expf(-lg)); const float ch = sc + rb;
            const float m1 = gmax8(ch), neq = gsum8(ch == m1 ? 1.f : 0.f), m2c = gmax8(ch < m1 ? ch : -INFINITY);
            const float gs = m1 + (neq >= 2.f ? m1 : m2c);
            int grk = 0; const int g = lane >> 3;
#pragma unroll
            for (int hh = 0; hh < 8; ++hh) { const float gh = rl_f(gs, 8 * hh); grk += (gh > gs || (gh == gs && hh < g)) ? 1 : 0; }
            const float msk = grk < 4 ? ch : -INFINITY;
            float cur = msk, ssum = 0.f; int erk = 64;
#pragma unroll 1
            for (int k = 0; k < 8; ++k) {
                float rm = gmax8(cur); rm = fmaxf(rm, dppf<0x140>(rm));
                const float wm = fmaxf(fmaxf(rl_f(rm, 0), rl_f(rm, 16)), fmaxf(rl_f(rm, 32), rl_f(rm, 48)));
                const unsigned long long bal = __builtin_amdgcn_ballot_w64(cur == wm);
                const int lsel = __builtin_amdgcn_readfirstlane((int)__builtin_ctzll(bal));
                ssum += rl_f(sc, lsel);
                const bool me = lane == lsel; erk = me ? k : erk; cur = me ? -INFINITY : cur; }
            const bool on = erk < 8;
            int pk_ = -1; if (on) pk_ = __hip_atomic_fetch_add(&hist[lane], 1, __ATOMIC_RELAXED, __HIP_MEMORY_SCOPE_WORKGROUP) | (erk << 16);
            P[rl * 64 + lane] = sc / ssum * 2.5f; Pi[(64 + rl) * 64 + lane] = pk_; }
        __syncthreads();
        if (tid < 64) { int tt = tid; asm volatile("" : "+v"(tt));
            const int hc = hist[tt]; int bs = 0; if (hc > 0) bs = (int)atomicAdd(&cnt[tt * 16], (unsigned)hc); basep[tt] = bs; }
        __syncthreads();
        { const int bl = basep[lane];
#pragma unroll 1
          for (int rr = 0; rr < 8; ++rr) { const int rl = 8 * w + rr; const int pk_ = Pi[(64 + rl) * 64 + lane]; const float gt_ = P[rl * 64 + lane];
            if (pk_ >= 0) { const int t = row0 + rl, pos = bl + (pk_ & 0xffff), rk_ = pk_ >> 16;
                ltok[(size_t)lane * CAP + pos] = t * 8 + rk_; lgate[(size_t)lane * CAP + pos] = gt_;
                eidx[t * 8 + rk_] = lane; inv[t * 8 + rk_] = pos; } } }
    }
}

constexpr int M3_PL = 131072, M3_CNT = 147456, M3_OFF = 147456 + 272;
__device__ __forceinline__ void phase_moe3n(const Frame& F, const bf16* H, const bf16* HSp, const int* eidx, const bf16* WD, const bf16* WSD,
                                            const float* Y1, const float* ST1, const float* g1, const float* b1, float* Y2, float* PST2) {
    LAS int* out = (LAS int*)F.lds; LAS unsigned short* plist = (LAS unsigned short*)(F.lds + M3_PL); LAS int* cnt = (LAS int*)(F.lds + M3_CNT); LAS int* off = (LAS int*)(F.lds + M3_OFF);
    const int tid = F.tid, lane = F.lane, w = F.wave, r = lane & 15, q = lane >> 4;
    for (int u = F.bid; u < 1024; u += F.G) {
        int nc = (u & 7) | ((u >> 7) << 3), tb = (u >> 3) & 15;
        if (F.G == 256) { const int i = u >> 8, x = u & 7, j = (u >> 3) & 31; tb = 2 * x + (i >> 1); nc = 32 * (i & 1) + j; }
        __syncthreads();
#pragma unroll
        for (int j = 0; j < 16; ++j) ((LAS v4u*)out)[tid + 512 * j] = (v4u){0u, 0u, 0u, 0u};
        if (tid < 66) cnt[tid] = 0;
        __syncthreads();
        int ee[16], pp[16];
        { const v4u* ep = (const v4u*)(eidx + ((size_t)tb * 1024 + 2 * tid) * 8); const v4u e0 = ep[0], e1 = ep[1], e2 = ep[2], e3 = ep[3];
          ee[0] = e0.x; ee[1] = e0.y; ee[2] = e0.z; ee[3] = e0.w; ee[4] = e1.x; ee[5] = e1.y; ee[6] = e1.z; ee[7] = e1.w;
          ee[8] = e2.x; ee[9] = e2.y; ee[10] = e2.z; ee[11] = e2.w; ee[12] = e3.x; ee[13] = e3.y; ee[14] = e3.z; ee[15] = e3.w; }
#pragma unroll
        for (int j = 0; j < 16; ++j) pp[j] = __hip_atomic_fetch_add(&cnt[ee[j]], 1, __ATOMIC_RELAXED, __HIP_MEMORY_SCOPE_WORKGROUP);
        __syncthreads();
        if (w == 0) { int c = cnt[lane], x = c;
#pragma unroll
            for (int o = 1; o < 64; o <<= 1) { const int y = __builtin_amdgcn_ds_bpermute(((lane - o) & 63) << 2, x); if (lane >= o) x += y; }
            off[lane] = x - c; if (lane == 63) off[64] = x; }
        __syncthreads();
#pragma unroll
        for (int j = 0; j < 16; ++j) plist[off[ee[j]] + pp[j]] = (unsigned short)(tid * 16 + j);
        __syncthreads();
        const char* Hb = (const char*)H + (size_t)tb * 8192 * 256 + q * 16;
        const char* HSb = (const char*)HSp + (size_t)tb * 1024 * 512 + q * 16;
        const char* Bb = (const char*)WD + ((size_t)nc * 32 + r) * 256 + q * 16;
        const char* BSb = (const char*)WSD + ((size_t)nc * 32 + r) * 512 + q * 16;
#define M3_NR(sg) ((sg) < 8 ? __builtin_amdgcn_readfirstlane(cnt[w + 8 * (sg)]) : 128)
#define M3_RB(sg) ((sg) < 8 ? __builtin_amdgcn_readfirstlane(off[w + 8 * (sg)]) : 0)
#define M3_GLD(dst, ptr, OFF) asm volatile("global_load_dwordx4 %0, %1, off offset:" #OFF : "=&v"(dst) : "v"(ptr) : "memory")
#define M3_LOADB(dst, sg) do { const char* _b0 = (sg) < 8 ? Bb + (size_t)(w + 8 * (sg)) * 524288 : BSb + ((sg) - 8) * 256; const char* _b1 = _b0 + ((sg) < 8 ? 4096 : 8192); \
            M3_GLD(dst[0][0], _b0, 0); M3_GLD(dst[0][1], _b0, 64); M3_GLD(dst[0][2], _b0, 128); M3_GLD(dst[0][3], _b0, 192); \
            M3_GLD(dst[1][0], _b1, 0); M3_GLD(dst[1][1], _b1, 64); M3_GLD(dst[1][2], _b1, 128); M3_GLD(dst[1][3], _b1, 192); } while (0)
#define M3_LOADA(dst, sg, bb, nr, rbs) do { int _i = 16 * (bb) + r; _i = _i < (nr) ? _i : (nr) - 1; const unsigned _rid = plist[(rbs) + _i]; \
            const char* _a = (sg) < 8 ? Hb + (size_t)_rid * 256 : ((sg) < 10 ? HSb + (size_t)(128 * w + _i) * 512 + ((sg) - 8) * 256 : Hb); \
            M3_GLD(dst[0], _a, 0); M3_GLD(dst[1], _a, 64); M3_GLD(dst[2], _a, 128); M3_GLD(dst[3], _a, 192); } while (0)
#define M3_ADV(sg, bb, nr, rbs) do { if ((sg) < 10) { ++(bb); if ((bb) * 16 >= (nr)) { (bb) = 0; do { ++(sg); } while ((sg) < 8 && M3_NR(sg) == 0); if ((sg) < 10) { (nr) = M3_NR(sg); (rbs) = M3_RB(sg); } } } } while (0)
#define M3_WAITA(AS) asm volatile("s_waitcnt vmcnt(12)" : "+v"(AS[0]), "+v"(AS[1]), "+v"(AS[2]), "+v"(AS[3]) :: "memory")
#define M3_WAITB(N) asm volatile("s_waitcnt vmcnt(" #N ")" : "+v"(Bn[0][0]), "+v"(Bn[0][1]), "+v"(Bn[0][2]), "+v"(Bn[0][3]), "+v"(Bn[1][0]), "+v"(Bn[1][1]), "+v"(Bn[1][2]), "+v"(Bn[1][3]) :: "memory")
#define M3_STEP(AS) if (cseg < 10) { \
              \
            int tk[4]; bool ok[4]; unsigned pl[4]; const int rt_ = cseg < 8; \
            _Pragma("unroll") for (int i = 0; i < 4; ++i) { const int idx = 16 * cbt + 4 * q + i; ok[i] = idx < cnr; const int ic = ok[i] ? idx : cnr - 1; pl[i] = plist[crbs + ic]; tk[i] = 128 * w + ic; } \
            _Pragma("unroll") for (int i = 0; i < 4; ++i) tk[i] = rt_ ? (int)(pl[i] >> 3) : tk[i]; \
            M3_WAITA(AS); \
            f32x4 acc[2]; \
            _Pragma("unroll") for (int nt = 0; nt < 2; ++nt) { acc[nt] = (f32x4){0.f, 0.f, 0.f, 0.f}; \
                _Pragma("unroll") for (int kk = 0; kk < 4; ++kk) acc[nt] = __builtin_amdgcn_mfma_f32_16x16x32_bf16(__builtin_bit_cast(bf16x8, AS[kk]), __builtin_bit_cast(bf16x8, Bc[nt][kk]), acc[nt], 0, 0, 0); } \
              \
            _Pragma("unroll") for (int i = 0; i < 4; ++i) { const long long lo_ = ok[i] ? (long long)__float2int_rn(acc[0][i] * 4194304.0f) : 0ll, hi_ = ok[i] ? (long long)__float2int_rn(acc[1][i] * 4194304.0f) : 0ll; \
                (void)__hip_atomic_fetch_add((LAS unsigned long long*)out + tk[i] * 16 + r, (unsigned long long)((hi_ << 32) + lo_), __ATOMIC_RELAXED, __HIP_MEMORY_SCOPE_WORKGROUP); } \
            M3_LOADA(AS, pseg, pbt, pnr, prbs); M3_ADV(pseg, pbt, pnr, prbs); \
            { const int old_ = cseg, nbat_ = (cnr + 15) >> 4; M3_ADV(cseg, cbt, cnr, crbs); \
              if (cseg != old_ && cseg < 10) { \
                  if (nbat_ == 1) M3_WAITB(4); else if (nbat_ == 2) M3_WAITB(8); else if (nbat_ == 3) M3_WAITB(12); else M3_WAITB(16); \
                  _Pragma("unroll") for (int nt = 0; nt < 2; ++nt) _Pragma("unroll") for (int kk = 0; kk < 4; ++kk) Bc[nt][kk] = Bn[nt][kk]; \
                  int nb_ = cseg; do { ++nb_; } while (nb_ < 8 && M3_NR(nb_) == 0); if (nb_ >= 10) nb_ = 9; M3_LOADB(Bn, nb_); } } }
        int cseg = -1, cbt = 0, cnr = 0, crbs = 0;
        do { ++cseg; } while (cseg < 8 && M3_NR(cseg) == 0);
        cnr = M3_NR(cseg); crbs = M3_RB(cseg);
        int pseg = cseg, pbt = 0, pnr = cnr, prbs = crbs;
        v4u Bc[2][4], Bn[2][4], A0[4], A1[4], A2[4], A3[4];
        M3_LOADB(Bc, cseg);
        M3_LOADA(A0, pseg, pbt, pnr, prbs); M3_ADV(pseg, pbt, pnr, prbs);
        M3_LOADA(A1, pseg, pbt, pnr, prbs); M3_ADV(pseg, pbt, pnr, prbs);
        M3_LOADA(A2, pseg, pbt, pnr, prbs); M3_ADV(pseg, pbt, pnr, prbs);
        M3_LOADA(A3, pseg, pbt, pnr, prbs); M3_ADV(pseg, pbt, pnr, prbs);
        { int nb_ = cseg; do { ++nb_; } while (nb_ < 8 && M3_NR(nb_) == 0); if (nb_ >= 10) nb_ = 9; M3_LOADB(Bn, nb_); }
        asm volatile("s_waitcnt vmcnt(0)" : "+v"(Bc[0][0]), "+v"(Bc[0][1]), "+v"(Bc[0][2]), "+v"(Bc[0][3]), "+v"(Bc[1][0]), "+v"(Bc[1][1]), "+v"(Bc[1][2]), "+v"(Bc[1][3]) :: "memory");
#pragma unroll 1
        while (cseg < 10) { M3_STEP(A0) M3_STEP(A1) M3_STEP(A2) M3_STEP(A3) }
        asm volatile("s_waitcnt vmcnt(0)" : "+v"(A0[0]), "+v"(A0[1]), "+v"(A0[2]), "+v"(A0[3]), "+v"(A1[0]), "+v"(A1[1]), "+v"(A1[2]), "+v"(A1[3]), "+v"(A2[0]), "+v"(A2[1]), "+v"(A2[2]), "+v"(A2[3]),
                     "+v"(A3[0]), "+v"(A3[1]), "+v"(A3[2]), "+v"(A3[3]), "+v"(Bn[0][0]), "+v"(Bn[0][1]), "+v"(Bn[0][2]), "+v"(Bn[0][3]), "+v"(Bn[1][0]), "+v"(Bn[1][1]), "+v"(Bn[1][2]), "+v"(Bn[1][3]) :: "memory");
#undef M3_NR
#undef M3_RB
#undef M3_GLD
#undef M3_LOADB
#undef M3_LOADA
#undef M3_ADV
#undef M3_WAITA
#undef M3_WAITB
#undef M3_STEP
        __syncthreads();
        { const int c4 = lane & 7, rs = lane >> 3, col = nc * 32 + 4 * c4;
          const f32x4 gv = *(const f32x4*)(g1 + col), bv = *(const f32x4*)(b1 + col);
#pragma unroll 4
          for (int it = 0; it < 16; ++it) { const int rl = 128 * w + 8 * it + rs; const size_t row = (size_t)tb * 1024 + rl;
              const f32x4 yv = *(const f32x4*)(Y1 + row * D + col); const f32x2 sv = *(const f32x2*)(ST1 + 2 * row);
              f32x4 tv; { const int nt = c4 >> 2, r0 = (4 * c4) & 15;
#pragma unroll
                  for (int j = 0; j < 4; ++j) { const v2u cell = *(const LAS v2u*)(out + rl * 32 + 2 * (r0 + j)); const int lo = (int)cell.x, hi = (int)cell.y + (lo < 0 ? 1 : 0); tv[j] = (float)(nt ? hi : lo) * (1.0f / 4194304.0f); } }
              const f32x4 y = ((yv - sv.x) * sv.y * gv + bv) * ALPHA + tv;
              *(f32x4*)(Y2 + row * D + col) = y;
              float sm = (y[0] + y[1]) + (y[2] + y[3]), sq = (y[0] * y[0] + y[1] * y[1]) + (y[2] * y[2] + y[3] * y[3]);
#pragma unroll
              for (int o = 1; o < 8; o <<= 1) { sm += shfl_x(sm, o, lane); sq += shfl_x(sq, o, lane); }
              if (c4 == 0) *(f32x2*)(PST2 + (row * 64 + nc) * 2) = (f32x2){sm, sq}; } }
    }
}

__device__ __forceinline__ void phase_moe4n(const Frame& F, const float* Y2, const float* pst, const float* gain, const float* bias, float* ST2, bf16* XBo, float* OUT, int last) {
    const int gw = F.bid * 8 + F.wave, NGW = F.G * 8, lane = F.lane;
    for (int t = gw; t < T; t += NGW) {
        f32x4 v[8];
#pragma unroll
        for (int j = 0; j < 8; ++j) v[j] = *(const f32x4*)(Y2 + (size_t)t * D + 4 * lane + 256 * j);
        const f32x2 pv = *(const f32x2*)(pst + ((size_t)t * 64 + lane) * 2);
        const float mean = wave_sum(pv.x, lane) * (1.0f / D); const float var = fmaxf(wave_sum(pv.y, lane) * (1.0f / D) - mean * mean, 0.f); const float rstd = 1.0f / sqrtf(var + LN_EPS);
        if (lane == 0) *(f32x2*)(ST2 + 2 * (size_t)t) = (f32x2){mean, rstd};
#pragma unroll
        for (int j = 0; j < 8; ++j) { const int c = 4 * lane + 256 * j; const f32x4 o = (v[j] - mean) * rstd * *(const f32x4*)(gain + c) + *(const f32x4*)(bias + c);
            if (last) *(f32x4*)(OUT + (size_t)t * D + c) = o;
            else { v2u wb; wb.x = pk2(o[0], o[1]); wb.y = pk2(o[2], o[3]); *(v2u*)(XBo + (size_t)t * D + c) = wb; } }
    }
}


__device__ __forceinline__ void phase_moe4q(const Frame& F, const bf16* X1, bf16* Y2, const unsigned char* Yq, const float* Ysc, const int* eidx, const int* inv, const float* gain, const float* bias, float* ST2, bf16* XBo, float* OUT, int last) {
    const LAS int* tpref = (const LAS int*)(F.lds + LDS_TAB);
    const int gw = F.bid * 8 + F.wave, NGW = F.G * 8, lane = F.lane;
    { LAS f32x4* gb = (LAS f32x4*)(F.lds + 0); int t0 = F.tid; asm volatile("" : "+v"(t0)); gb[t0] = *(const f32x4*)(gain + 4 * t0); gb[512 + t0] = *(const f32x4*)(bias + 4 * t0); }
    __syncthreads();
    const LAS float* gl = (const LAS float*)(F.lds + 0);
    int en = 0, pn = 0; if (lane < 8 && gw < T) { en = eidx[gw * 8 + lane]; pn = inv[gw * 8 + lane]; }
    for (int t = gw; t < T; t += NGW) {
        int rowi = 0; if (lane < 8) rowi = tpref[en] * 256 + pn; else if (lane < 10) rowi = tpref[56 + lane] * 256 + t;
        if (lane < 8 && t + NGW < T) { en = eidx[(t + NGW) * 8 + lane]; pn = inv[(t + NGW) * 8 + lane]; }
        v4u pv[2][2], yv[10][2]; float sc[10][2];
#pragma unroll
        for (int j = 0; j < 2; ++j) { pv[j][0] = __builtin_nontemporal_load((const v4u*)(X1 + (size_t)t * D + 16 * lane + 1024 * j)); pv[j][1] = __builtin_nontemporal_load((const v4u*)(X1 + (size_t)t * D + 16 * lane + 1024 * j + 8)); }
#pragma unroll
        for (int k = 0; k < 10; ++k) { const size_t row = (size_t)__builtin_amdgcn_readlane(rowi, k);
#pragma unroll
            for (int j = 0; j < 2; ++j) { yv[k][j] = __builtin_nontemporal_load((const v4u*)(Yq + row * D + 16 * lane + 1024 * j)); sc[k][j] = __builtin_nontemporal_load(Ysc + row * 16 + 8 * j + (lane >> 3)); } }
#pragma unroll
        for (int k = 0; k < 10; ++k) asm volatile("" : "+v"(yv[k][0]), "+v"(yv[k][1]), "+v"(sc[k][0]), "+v"(sc[k][1]));
        float v[2][16];
#pragma unroll
        for (int j = 0; j < 2; ++j) { float f0[8], f1[8]; unpack8(pv[j][0], f0); unpack8(pv[j][1], f1);
            const float ss = (((sc[0][j] + sc[1][j]) + (sc[2][j] + sc[3][j])) + ((sc[4][j] + sc[5][j]) + (sc[6][j] + sc[7][j]))) + (sc[8][j] + sc[9][j]);
#pragma unroll
            for (int i = 0; i < 8; ++i) { v[j][i] = ALPHA * f0[i] - 128.f * ss; v[j][8 + i] = ALPHA * f1[i] - 128.f * ss; } }
#pragma unroll
        for (int k = 0; k < 10; ++k)
#pragma unroll
            for (int j = 0; j < 2; ++j) { const float s_ = sc[k][j]; const unsigned q[4] = {yv[k][j].x, yv[k][j].y, yv[k][j].z, yv[k][j].w};
#pragma unroll
                for (int d = 0; d < 4; ++d) { v[j][4 * d + 0] += s_ * (float)(q[d] & 0xffu); v[j][4 * d + 1] += s_ * (float)((q[d] >> 8) & 0xffu); v[j][4 * d + 2] += s_ * (float)((q[d] >> 16) & 0xffu); v[j][4 * d + 3] += s_ * (float)(q[d] >> 24); } }
        float sm = 0.f;
#pragma unroll
        for (int j = 0; j < 2; ++j)
#pragma unroll
            for (int i = 0; i < 16; i += 4) sm += (v[j][i] + v[j][i + 1]) + (v[j][i + 2] + v[j][i + 3]);
        const float mean = wave_sum(sm, lane) * (1.0f / D); float sq = 0.f;
#pragma unroll
        for (int j = 0; j < 2; ++j)
#pragma unroll
            for (int i = 0; i < 16; ++i) { const float d = v[j][i] - mean; sq += d * d; }
        const float rstd = 1.0f / sqrtf(wave_sum(sq, lane) * (1.0f / D) + LN_EPS);
        (void)ST2; (void)Y2;
#pragma unroll
        for (int j = 0; j < 2; ++j)
#pragma unroll
            for (int h = 0; h < 2; ++h) { const int c = 16 * lane + 1024 * j + 8 * h; const float* vv = &v[j][8 * h];
                const f32x4 g0 = *(const LAS f32x4*)(gl + c), g1 = *(const LAS f32x4*)(gl + c + 4), b0 = *(const LAS f32x4*)(gl + 2048 + c), b1 = *(const LAS f32x4*)(gl + 2048 + c + 4);
                const f32x4 o0 = ((f32x4){vv[0], vv[1], vv[2], vv[3]} - mean) * rstd * g0 + b0, o1 = ((f32x4){vv[4], vv[5], vv[6], vv[7]} - mean) * rstd * g1 + b1;
                if (last) { *(f32x4*)(OUT + (size_t)t * D + c) = o0; *(f32x4*)(OUT + (size_t)t * D + c + 4) = o1; }
                else { v4u wb; wb.x = pk2(o0[0], o0[1]); wb.y = pk2(o0[2], o0[3]); wb.z = pk2(o1[0], o1[1]); wb.w = pk2(o1[2], o1[3]); *(v4u*)(XBo + (size_t)t * D + c) = wb; } }
    }
}

__device__ __forceinline__ void phase_downproj3(const Frame& F, const bf16* H, const bf16* WD, const bf16* HSp, const bf16* WSD, unsigned char* Yq, float* Ysc, int NT) {
    const LAS int* tpref = (const LAS int*)(F.lds + LDS_TAB); const LAS int* cl = (const LAS int*)(F.lds + LDS_TAB + 512);
    LAS unsigned char* lds = F.lds;
    const int tid = F.tid, lane = F.lane, w = F.wave, fr = lane & 15, fq = lane >> 4;
    unsigned rbB[2], cbB[2];
#pragma unroll
    for (int i = 0; i < 2; ++i) { int R_, C_; g8::stage_rc(tid * 16 + i * 8192, R_, C_); rbB[i] = (unsigned)((R_ & ~31) + g8::perm32(R_ & 31)); cbB[i] = (unsigned)C_ * 2u; }
    const unsigned ldsw = (unsigned)w * 1024u, lbase = (unsigned)(size_t)lds;
    int boffg[4];
#pragma unroll
    for (int g = 0; g < 4; ++g) boffg[g] = g8::lds_byte(32 * g + fr, fq * 8);
    LAS unsigned char* stg = lds + 65536 + w * (32 * 144);
    const int NU = NT * 4;
    const int upos = (F.G % 8) == 0 ? (F.bid & 7) * (F.G >> 3) + (F.bid >> 3) : F.bid;
    int ub = 0;
    int u = (F.G <= NU) ? upos : F.bid; if (u >= NU) return;
#define DP3_UNITINFO(uu, E0, EXP, NV) do { const int tl_ = (uu) >> 2; int e_ = (E0); while (__builtin_amdgcn_readfirstlane(tpref[e_ + 1]) <= tl_) ++e_; EXP = e_; \
        NV = __builtin_amdgcn_readfirstlane(cl[e_]) - (tl_ - __builtin_amdgcn_readfirstlane(tpref[e_])) * 256; } while (0)
#define DP3_GLDS(gsrc, ldsdst) do { unsigned keep_; asm volatile("s_mov_b32 %0, m0\n\ts_mov_b32 m0, %2\n\ts_nop 0\n\tglobal_load_lds_dwordx4 %1, off\n\ts_mov_b32 m0, %0" : "=&s"(keep_) : "v"(gsrc), "s"(ldsdst) : "memory"); } while (0)
#define DP3_STAGE(slot, gb, bs) do { const unsigned v0_ = rbB[0] * (unsigned)(bs) + cbB[0], v1_ = rbB[1] * (unsigned)(bs) + cbB[1]; _Pragma("unroll") for (int kt = 0; kt < 2; ++kt) { \
        DP3_GLDS((const void*)((gb) + kt * 128 + v0_), lbase + (unsigned)((slot) * 32768 + kt * 16384) + ldsw); \
        DP3_GLDS((const void*)((gb) + kt * 128 + v1_), lbase + (unsigned)((slot) * 32768 + kt * 16384) + ldsw + 8192u); } } while (0)
#define DP3_SRC(uu, ee, AB, AS, BB, BS) do { const int tl_ = (uu) >> 2, cu_ = ((uu) & 3) * 512; \
        if ((ee) < 64) { AB = (const char*)(H + (size_t)tl_ * 256 * EDIM); AS = EDIM * 2; BB = (const char*)(WD + (size_t)(ee) * D * EDIM + (size_t)cu_ * EDIM); BS = EDIM * 2; } \
        else { const int t0_ = (tl_ - __builtin_amdgcn_readfirstlane(tpref[ee])) * 256; AB = (const char*)(HSp + (size_t)t0_ * SDIM + ((ee) - 64) * EDIM); AS = SDIM * 2; \
               BB = (const char*)(WSD + (size_t)cu_ * SDIM + ((ee) - 64) * EDIM); BS = SDIM * 2; } } while (0)
    int ecur, nvcur; DP3_UNITINFO(u, 0, ecur, nvcur);
    const char* abc; const char* gbc; int asc, bsc; DP3_SRC(u, ecur, abc, asc, gbc, bsc);
    bf16x8 A[2][4], An[2][4];
    { const char* ap_ = abc + (size_t)(32 * w + fr) * asc + 16 * fq;
#pragma unroll
      for (int m = 0; m < 2; ++m)
#pragma unroll
          for (int kk = 0; kk < 4; ++kk) A[m][kk] = *(const bf16x8*)(ap_ + (size_t)m * 16 * asc + 64 * kk); }
    DP3_STAGE(0, gbc, bsc);
    asm volatile("s_waitcnt vmcnt(0)" ::: "memory");
#pragma unroll 1
    for (;;) {
        int un = u; { const int nb = ub + F.G; if (nb + F.G <= NU) un = nb + upos; else if (nb + F.bid < NU) un = nb + F.bid; if (un != u) ub = nb; }
        int enx, nvnx; DP3_UNITINFO(un, (un > u ? ecur : 0), enx, nvnx);
        const char* abn; const char* gbn; int asn, bsn; DP3_SRC(un, enx, abn, asn, gbn, bsn);
        const int tile = u >> 2, colu = (u & 3) * 512;
        float scq[2][4];
#pragma unroll
        for (int c = 0; c < 4; ++c) {
            if (c == 0) asm volatile("s_waitcnt vmcnt(5)" ::: "memory"); else asm volatile("s_waitcnt vmcnt(4)" ::: "memory");
            __builtin_amdgcn_s_barrier();
            if (c == 3) { const char* ap_ = abn + (size_t)(32 * w + fr) * asn + 16 * fq;
#pragma unroll
                for (int m = 0; m < 2; ++m) { const char* am_ = ap_ + (size_t)m * 16 * asn;
                    asm volatile("global_load_dwordx4 %0, %1, off" : "=&v"(An[m][0]) : "v"(am_) : "memory"); asm volatile("global_load_dwordx4 %0, %1, off offset:64" : "=&v"(An[m][1]) : "v"(am_) : "memory");
                    asm volatile("global_load_dwordx4 %0, %1, off offset:128" : "=&v"(An[m][2]) : "v"(am_) : "memory"); asm volatile("global_load_dwordx4 %0, %1, off offset:192" : "=&v"(An[m][3]) : "v"(am_) : "memory"); } }
            { const char* gnext = (c < 3) ? gbc + (size_t)(c + 1) * 128 * bsc : gbn; const int bnext = (c < 3) ? bsc : bsn; DP3_STAGE((c + 1) & 1, gnext, bnext); }
            __builtin_amdgcn_sched_barrier(0);
            f32x4 acc[2][4][2];
#pragma unroll
            for (int g = 0; g < 4; ++g) { bf16x8 Bf[2][4];
#pragma unroll
                for (int n = 0; n < 2; ++n)
#pragma unroll
                    for (int kk = 0; kk < 4; ++kk) Bf[n][kk] = *(const LAS bf16x8*)(lds + (c & 1) * 32768 + (kk >> 1) * 16384 + boffg[g] + n * 2048 + (kk & 1) * 1024);
#pragma unroll
                for (int m = 0; m < 2; ++m)
#pragma unroll
                    for (int n = 0; n < 2; ++n) { acc[m][g][n] = (f32x4){0.f, 0.f, 0.f, 0.f};
#pragma unroll
                        for (int kk = 0; kk < 4; ++kk) acc[m][g][n] = __builtin_amdgcn_mfma_f32_16x16x32_bf16(Bf[n][kk], A[m][kk], acc[m][g][n], 0, 0, 0); } }
#pragma unroll
            for (int m = 0; m < 2; ++m) {
                float am0 = 0.f, am1 = 0.f;
#pragma unroll
                for (int g = 0; g < 4; ++g)
#pragma unroll
                    for (int n = 0; n < 2; ++n) { am0 = fmaxf(fmaxf(am0, fabsf(acc[m][g][n][0])), fabsf(acc[m][g][n][1])); am1 = fmaxf(fmaxf(am1, fabsf(acc[m][g][n][2])), fabsf(acc[m][g][n][3])); }
                float am = fmaxf(am0, am1);
                am = fmaxf(am, shfl_x(am, 16, lane)); am = fmaxf(am, shfl_x(am, 32, lane));
                am = fminf(am, 3.0e38f);
                const float isc = am > 0.f ? 127.0f * __builtin_amdgcn_rcpf(am) : 0.f;
                scq[m][c] = am * (1.0f / 127.0f);
                const f32x2_t isc2 = (f32x2_t){isc, isc}, mg2 = (f32x2_t){8388736.0f, 8388736.0f};
#pragma unroll
                for (int g = 0; g < 4; ++g) { unsigned qd[2];
#pragma unroll
                    for (int n = 0; n < 2; ++n) {
                        const f32x2_t tl = __builtin_elementwise_fma((f32x2_t){acc[m][g][n][0], acc[m][g][n][1]}, isc2, mg2), th = __builtin_elementwise_fma((f32x2_t){acc[m][g][n][2], acc[m][g][n][3]}, isc2, mg2);
                        const float f0_ = tl.x, f1_ = tl.y, f2_ = th.x, f3_ = th.y;
                        qd[n] = __builtin_amdgcn_perm(__builtin_bit_cast(unsigned, f1_), __builtin_bit_cast(unsigned, f0_), 0x0c0c0400u) | __builtin_amdgcn_perm(__builtin_bit_cast(unsigned, f3_), __builtin_bit_cast(unsigned, f2_), 0x04000c0cu); }
                    *(LAS v2u*)(stg + (16 * m + fr) * 144 + 32 * g + 8 * fq) = (v2u){qd[0], qd[1]}; } }
#pragma unroll
            for (int it = 0; it < 4; ++it) { const int rr = 8 * it + (lane >> 3);
                const v4u o = *(const LAS v4u*)(stg + rr * 144 + (lane & 7) * 16);
                __builtin_nontemporal_store(o, (v4u*)(Yq + (size_t)(tile * 256 + 32 * w + rr) * D + colu + 128 * c + 16 * (lane & 7))); }
            if (c == 3) { const f32x4 so = fq == 0 ? (f32x4){scq[0][0], scq[0][1], scq[0][2], scq[0][3]} : (f32x4){scq[1][0], scq[1][1], scq[1][2], scq[1][3]};
                if (fq < 2) __builtin_nontemporal_store(so, (f32x4*)(Ysc + (size_t)(tile * 256 + 32 * w + 16 * fq + fr) * 16 + (colu >> 7))); }
            __builtin_amdgcn_sched_barrier(0);
        }
        asm volatile("s_waitcnt vmcnt(9)" : "+v"(An[0][0]), "+v"(An[0][1]), "+v"(An[0][2]), "+v"(An[0][3]), "+v"(An[1][0]), "+v"(An[1][1]), "+v"(An[1][2]), "+v"(An[1][3]) :: "memory");
        if (un == u) break;
#pragma unroll
        for (int m = 0; m < 2; ++m)
#pragma unroll
            for (int kk = 0; kk < 4; ++kk) A[m][kk] = An[m][kk];
        u = un; ecur = enx; nvcur = nvnx; abc = abn; asc = asn; gbc = gbn; bsc = bsn;
    }
    asm volatile("s_waitcnt vmcnt(0)" ::: "memory");
#undef DP3_UNITINFO
#undef DP3_STAGE
#undef DP3_GLDS
#undef DP3_SRC
}

enum { PH_PRO = 0, PH_POOL_G1, PH_POOL_P, PH_POOL_G2, PH_POOL_G3, PH_DIL_G1, PH_DIL_ATT, PH_DIL_CMB, PH_DIL_G2, PH_CONV_G1, PH_CONV_E, PH_CONV_G2, PH_MOE1, PH_MOE2, PH_MOE3, PH_MOE4, PH_COUNT };

template <int PH>
__device__ __forceinline__ void run_phase(const Frame& Fin, const Args& args_, const int L) {
    Frame F = Fin; { int w_ = Fin.wave, l_; asm volatile("" : "+s"(w_)); asm volatile("v_mbcnt_lo_u32_b32 %0, -1, 0\n\tv_mbcnt_hi_u32_b32 %0, -1, %0" : "=v"(l_)); F.wave = w_; F.lane = l_; F.tid = w_ * 64 + l_; }
    unsigned char* ws; { GAS unsigned char* wsg = (GAS unsigned char*)Fin.ws; asm volatile("" : "+s"(wsg)); ws = (unsigned char*)wsg; } F.ws = ws; F.ctl = (unsigned*)(ws + WS_CTL);
    KP kp = (KP)__builtin_amdgcn_kernarg_segment_ptr(); asm volatile("" : "+s"(kp)); (void)args_;
    { unsigned l_ = (unsigned)(size_t)Fin.lds; asm volatile("" : "+s"(l_)); F.lds = (LAS unsigned char*)(size_t)l_; }
    LAS unsigned char* ring = F.lds; int c = (int)blockIdx.x; { int g_ = Fin.G; asm volatile("" : "+s"(c), "+s"(g_)); F.G = g_; F.bid = c; }
    const float* xres = ain(kp, IN_X);
    const float* st2 = (const float*)(ws + WS_ST2); float* pstp = (float*)(ws + WS_PST);
    const float* g2p = ain(kp, IN_LNG) + (size_t)((L > 0 ? L - 1 : 0) * 2 + 1) * D; const float* b2p = ain(kp, IN_LNB) + (size_t)((L > 0 ? L - 1 : 0) * 2 + 1) * D;
    const bf16* xb = (const bf16*)(ws + WS_XB);
    bf16* yf = (bf16*)(ws + WS_YF);
    unsigned char* big = ws + WS_BIG;
    const int ia = L / 3;
    if constexpr (PH == PH_PRO) { phase_prologue(F, kp); }
    if constexpr (PH == PH_POOL_G1) { g8::DenseSched S; S.init(xb, (const bf16*)(ws + WS_W_POOL_IN) + (size_t)ia * D * D, T, D, D, D, F.G, c);
        g8::EpiBf16 E{(bf16*)(big + BG_U), D, 0}; g8::gemm_phase<g8::EpiBf16, g8::DenseSched, false>(ring, F.tid, D, D, D, S, E); }
    if constexpr (PH == PH_POOL_P) { phase_pool(F, (const bf16*)(big + BG_U), (bf16*)(big + BG_PL)); }
    if constexpr (PH == PH_POOL_G2) { g8::DenseSched S; S.init((const bf16*)(big + BG_PL), (const bf16*)(ws + WS_W_POOL_G) + (size_t)ia * D * 512, T, D, D, 512, F.G, c); S.agrp_shift = 1; S.agrp_stride = 512 * 2;
        g8::EpiScaleBf16 E{(bf16*)(big + BG_MX), D, ain(kp, IN_PSC) + (size_t)ia * D}; g8::gemm_phase<g8::EpiScaleBf16, g8::DenseSched, false>(ring, F.tid, 512, D, 512, S, E); }
    if constexpr (PH == PH_POOL_G3) { g8::DenseSched S; S.init((const bf16*)(big + BG_MX), (const bf16*)(ws + WS_W_POOL_OUT) + (size_t)ia * D * D, T, D, D, D, F.G, c);
        g8::EpiResidLN E{xres, xb, st2, g2p, b2p, yf, pstp, 2}; g8::gemm_phase<g8::EpiResidLN, g8::DenseSched, false>(ring, F.tid, D, D, D, S, E); }
    if constexpr (PH == PH_DIL_G1) { g8::DenseSched S; S.init(xb, (const bf16*)(ws + WS_W_DIL_QKV), T, QKVC, D, D, F.G, c);
        g8::EpiBf16 E{(bf16*)(big + BG_QKV), QKVC, 1}; g8::gemm_phase<g8::EpiBf16, g8::DenseSched, false>(ring, F.tid, D, D, D, S, E); }
    if constexpr (PH == PH_DIL_ATT) { phase_attn(F, (const bf16*)(big + BG_QKV), ain(kp, IN_RELB), (bf16*)(big + BG_OG), (float*)(big + BG_LSE)); }
    if constexpr (PH == PH_DIL_CMB) { phase_combine(F, (const bf16*)(big + BG_OG), (const float*)(big + BG_LSE), (bf16*)(big + BG_O)); }
    if constexpr (PH == PH_DIL_G2) { g8::DenseSched S; S.init((const bf16*)(big + BG_O), (const bf16*)(ws + WS_W_DIL_OUT), T, D, DILW, DILW, F.G, c);
        g8::EpiResidLN E{xres, xb, st2, g2p, b2p, yf, pstp, 2}; g8::gemm_phase<g8::EpiResidLN, g8::DenseSched, false>(ring, F.tid, DILW, DILW, DILW, S, E); }
    if constexpr (PH == PH_CONV_G1) { g8::DenseSched S; S.init(xb, (const bf16*)(ws + WS_W_CONV_IN), T, 3 * D, D, D, F.G, c);
        g8::EpiConvIn E{(bf16*)(big + BG_UC), (bf16*)(big + BG_BG)}; g8::gemm_phase<g8::EpiConvIn, g8::DenseSched, false>(ring, F.tid, D, D, D, S, E); }
    if constexpr (PH == PH_CONV_E) { phase_conv(F, (const bf16*)(big + BG_UC), (const bf16*)(big + BG_BG), ain(kp, IN_CW), (bf16*)(big + BG_Z)); }
    if constexpr (PH == PH_CONV_G2) { g8::DenseSched S; S.init((const bf16*)(big + BG_Z), (const bf16*)(ws + WS_W_CONV_OUT), T, D, D, D, F.G, c);
        g8::EpiResidLN E{xres, xb, st2, g2p, b2p, yf, pstp, 2}; g8::gemm_phase<g8::EpiResidLN, g8::DenseSched, false>(ring, F.tid, D, D, D, S, E); }
    unsigned* cnt = F.ctl + CW_CNT + L * 64 * 16;
    float* x1f = (float*)(ws + WS_X1F); bf16* x1b = (bf16*)(ws + WS_X1B);
    int* ltok = (int*)(ws + WS_LTOK); float* lgate = (float*)(ws + WS_LGATE); int* eidx = (int*)(ws + WS_EIDX); int* inv = (int*)(ws + WS_INV);
    bf16* HB = (bf16*)(ws + WS_HB); bf16* HS = (bf16*)(ws + WS_HS); bf16* Yr = (bf16*)(ws + WS_BIG);
    if constexpr (PH == PH_MOE1) {
        const float* g1 = ain(kp, IN_LNG) + (size_t)(L * 2 + 0) * D; const float* b1 = ain(kp, IN_LNB) + (size_t)(L * 2 + 0) * D;
        phase_moe1n(F, yf, pstp, g1, b1, (const bf16*)(ws + WS_RWH) + (size_t)L * NEXP * D, (const bf16*)(ws + WS_RWL) + (size_t)L * NEXP * D, ain(kp, IN_RB) + (size_t)L * NEXP,
                    x1b, (float*)(ws + WS_ST1), cnt, ltok, lgate, eidx, inv); }
    if constexpr (PH == PH_MOE2) {
        const int NT = build_tiles(F, cnt);
        { g8::ExpertSched<1, true> S; S.tpref = (const LAS int*)(F.lds + LDS_TAB); S.cnt = (const LAS int*)(F.lds + LDS_TAB + 512); S.A = (const char*)x1b; S.B = (const char*)((const bf16*)(ws + WS_W_EX_GU) + (size_t)L * 64 * 256 * D);
          S.tok = ltok; S.b_exp = (size_t)256 * D * 2; S.b_tile = 0; S.a_tile = 0; S.NU = NT; S.G = F.G; S.c = c;
          g8::EpiExpertGU E{HB}; g8::gemm_phase<g8::EpiExpertGU, g8::ExpertSched<1, true>, true>(ring, F.tid, D, D, D, S, E); }
        { const int rot = (c - (NT % F.G) + F.G) % F.G;
          g8::DenseSched S; S.init(x1b, (const bf16*)(ws + WS_W_SH_GU) + (size_t)L * 512 * D, T, 512, D, D, F.G, rot);
          int t2 = F.tid; asm volatile("" : "+v"(t2));
          g8::EpiSharedGU E{HS}; g8::gemm_phase<g8::EpiSharedGU, g8::DenseSched, false>(ring, t2, D, D, D, S, E); } }
    if constexpr (PH == PH_MOE3) {
        const float* g1 = ain(kp, IN_LNG) + (size_t)(L * 2 + 0) * D; const float* b1 = ain(kp, IN_LNB) + (size_t)(L * 2 + 0) * D;
        const int NT = build_tiles(F, cnt);
        __syncthreads();
        phase_downproj3(F, HB, (const bf16*)(ws + WS_W_EX_D) + (size_t)L * 64 * D * EDIM, HS, (const bf16*)(ws + WS_W_SH_D) + (size_t)L * D * SDIM, (unsigned char*)Yr, (float*)(ws + WS_BIG + BG_YSC), NT + 2 * (T / 256));
        (void)g1; (void)b1; }
    if constexpr (PH == PH_MOE4) { (void)build_tiles(F, cnt);
        const float* g2 = ain(kp, IN_LNG) + (size_t)(L * 2 + 1) * D; const float* b2 = ain(kp, IN_LNB) + (size_t)(L * 2 + 1) * D;
        phase_moe4q(F, x1b, (bf16*)(ws + WS_Y2F), (const unsigned char*)Yr, (const float*)(ws + WS_BIG + BG_YSC), eidx, inv, g2, b2, (float*)(ws + WS_ST2), (bf16*)(ws + WS_XB), aout(kp), L == DEPTH - 1); }
}
__device__ __forceinline__ void make_frame(Frame& F, const Args& args) {
    extern __shared__ __attribute__((aligned(16))) unsigned char lds_raw[];
    F.lds = (LAS unsigned char*)lds_raw; F.ws = args.ws; F.ctl = (unsigned*)(args.ws + WS_CTL);
    F.tid = threadIdx.x; F.lane = F.tid & 63; F.wave = __builtin_amdgcn_readfirstlane(F.tid >> 6); F.G = gridDim.x; F.bid = blockIdx.x;
}
template <int PH> __global__ void __launch_bounds__(512, 2) k_phase(Args args, int L) {
    Frame F; make_frame(F, args);
    run_phase<PH>(F, args, L);
}

#ifndef MK_NOINLINE
#define MK_NOINLINE 0
#endif
#if MK_NOINLINE
template <int PH> __device__ __noinline__ void call_phase_ni(const int L) {
    Args dummy{}; Frame F;
    KP kp = (KP)__builtin_amdgcn_kernarg_segment_ptr();
    extern __shared__ __attribute__((aligned(16))) unsigned char lds_raw[];
    F.lds = (LAS unsigned char*)lds_raw; F.ws = (unsigned char*)((GAS unsigned char* const CAS*)kp)[20]; F.ctl = (unsigned*)(F.ws + WS_CTL);
    F.tid = threadIdx.x; F.lane = F.tid & 63; F.wave = __builtin_amdgcn_readfirstlane(F.tid >> 6); F.G = gridDim.x; F.bid = blockIdx.x;
    run_phase<PH>(F, dummy, L);
}
template <int PH> __device__ __forceinline__ void call_phase(const Frame& F, const Args& args, const int L) { call_phase_ni<PH>(L); }
#else
template <int PH> __device__ __forceinline__ void call_phase(const Frame& F, const Args& args, const int L) { asm volatile("; PHASE_BEGIN %0" :: "n"(PH)); run_phase<PH>(F, args, L); asm volatile("; PHASE_END %0" :: "n"(PH)); }
#endif
__global__ void __launch_bounds__(512, 2) fwd_all(Args args) {
    Frame F; make_frame(F, args);
    volatile LAS unsigned* misc = (volatile LAS unsigned*)(F.lds + LDS_MISC);
    if (F.tid < 4) misc[F.tid] = 0u;
    __syncthreads();
    const int lo = args.ph_lo, hi = args.ph_hi;
    XcdBarrier bar; bar.bar = F.ctl + CW_BAR; bar.x = 0; bar.st = misc;
    if (hi - lo > 1) bar = xcd_barrier_post(F.ctl + CW_BAR, misc);
    int pc = 0;
#ifndef MK_DUP_MASK
#define MK_DUP_MASK 0
#endif
#if MK_DUP_MASK
#define STEP(PH, Lx) do { if (pc >= lo && pc < hi) { int nrep_ = ((MK_DUP_MASK >> (PH)) & 1) ? 2 : 1; asm volatile("" : "+s"(nrep_)); _Pragma("unroll 1") for (int r_ = 0; r_ < nrep_; ++r_) { call_phase<PH>(F, args, Lx); if (r_ + 1 < nrep_ || pc + 1 < hi) xcd_barrier(bar); } } ++pc; } while (0)
#else
#define STEP(PH, Lx) do { if (pc >= lo && pc < hi) { call_phase<PH>(F, args, Lx); if (pc + 1 < hi) xcd_barrier(bar); } ++pc; } while (0)
#endif
    STEP(PH_PRO, 0);
#pragma unroll 1
    for (int L = 0; L < DEPTH; ++L) {
        const int kind = L % 3;
        if (kind == 0) { STEP(PH_POOL_G1, L); STEP(PH_POOL_P, L); STEP(PH_POOL_G2, L); STEP(PH_POOL_G3, L); }
        else if (kind == 1) { STEP(PH_DIL_G1, L); STEP(PH_DIL_ATT, L); STEP(PH_DIL_CMB, L); STEP(PH_DIL_G2, L); }
        else { STEP(PH_CONV_G1, L); STEP(PH_CONV_E, L); STEP(PH_CONV_G2, L); }
        STEP(PH_MOE1, L); STEP(PH_MOE2, L); STEP(PH_MOE3, L); STEP(PH_MOE4, L);
    }
#undef STEP
}
constexpr int N_STEPS = 1 + 2 * 8 + 8 + 7;

template <int PH> static void launch_phase(const Args& a, int L, int grid, hipStream_t stream) {
    static bool attr = false;
    if (!attr) { (void)hipFuncSetAttribute((const void*)k_phase<PH>, hipFuncAttributeMaxDynamicSharedMemorySize, LDS_BYTES); attr = true; }
    hipLaunchKernelGGL(k_phase<PH>, dim3(grid), dim3(512), LDS_BYTES, stream, a, L);
}
extern "C" void kernel_launch(void* const* d_in, const int* in_sizes, int n_in, void* d_out, int out_size, void* d_ws, size_t ws_size, hipStream_t stream) {
    static int grid = 0;
    if (grid == 0) {
        if (n_in != 19 || out_size != T * D || ws_size < WS_END) { fprintf(stderr, "kernel_launch: unexpected shapes (n_in %d out %d ws %zu need %zu)\n", n_in, out_size, ws_size, (size_t)WS_END); grid = -1; return; }
        int dev = 0, cus = 0;
        if (hipGetDevice(&dev) != hipSuccess || hipDeviceGetAttribute(&cus, hipDeviceAttributeMultiprocessorCount, dev) != hipSuccess) { grid = -1; return; }
#if MK_ONE_LAUNCH
        if (hipFuncSetAttribute((const void*)fwd_all, hipFuncAttributeMaxDynamicSharedMemorySize, LDS_BYTES) != hipSuccess) { fprintf(stderr, "kernel_launch: hipFuncSetAttribute failed\n"); grid = -1; return; }
        int per_cu = 0;
        if (hipOccupancyMaxActiveBlocksPerMultiprocessor(&per_cu, (const void*)fwd_all, 512, LDS_BYTES) != hipSuccess || per_cu < 1) { fprintf(stderr, "kernel_launch: note: occupancy query reports %d blocks per CU\n", per_cu); (void)hipGetLastError(); }
#endif
        grid = cus;
    }
    if (grid < 0) return;
    (void)hipMemsetAsync((char*)d_ws + WS_CTL, 0, CTL_ZERO_BYTES, stream);
    Args a{};
    for (int i = 0; i < 19; ++i) a.in[i] = (const float*)d_in[i];
    a.out = (float*)d_out; a.ws = (unsigned char*)d_ws; a.ph_lo = 0; a.ph_hi = 0;
#if MK_ONE_LAUNCH
#ifdef MK_SPLIT
    for (int p = 0; p < N_STEPS; ++p) { a.ph_lo = p; a.ph_hi = p + 1; hipLaunchKernelGGL(fwd_all, dim3(grid), dim3(512), LDS_BYTES, stream, a); }
#else
    a.ph_lo = 0; a.ph_hi = N_STEPS;
    hipLaunchKernelGGL(fwd_all, dim3(grid), dim3(512), LDS_BYTES, stream, a);
#endif
#elif defined(MK_HYBRID_MASK)
    {
        static bool attr2 = false; if (!attr2) { (void)hipFuncSetAttribute((const void*)fwd_all, hipFuncAttributeMaxDynamicSharedMemorySize, LDS_BYTES); attr2 = true; }
        int pc = 0;
#define HSTEP(PH, Lx) do { if ((MK_HYBRID_MASK >> (PH)) & 1) { a.ph_lo = pc; a.ph_hi = pc + 1; hipLaunchKernelGGL(fwd_all, dim3(grid), dim3(512), LDS_BYTES, stream, a); } else { a.ph_lo = 0; a.ph_hi = 0; launch_phase<PH>(a, Lx, grid, stream); } ++pc; } while (0)
        HSTEP(PH_PRO, 0);
        for (int L = 0; L < DEPTH; ++L) {
            const int kind = L % 3;
            if (kind == 0) { HSTEP(PH_POOL_G1, L); HSTEP(PH_POOL_P, L); HSTEP(PH_POOL_G2, L); HSTEP(PH_POOL_G3, L); }
            else if (kind == 1) { HSTEP(PH_DIL_G1, L); HSTEP(PH_DIL_ATT, L); HSTEP(PH_DIL_CMB, L); HSTEP(PH_DIL_G2, L); }
            else { HSTEP(PH_CONV_G1, L); HSTEP(PH_CONV_E, L); HSTEP(PH_CONV_G2, L); }
            HSTEP(PH_MOE1, L); HSTEP(PH_MOE2, L); HSTEP(PH_MOE3, L); HSTEP(PH_MOE4, L);
        }
#undef HSTEP
    }
#else
    launch_phase<PH_PRO>(a, 0, grid, stream);
    for (int L = 0; L < DEPTH; ++L) {
        const int kind = L % 3;
        if (kind == 0) { launch_phase<PH_POOL_G1>(a, L, grid, stream); launch_phase<PH_POOL_P>(a, L, grid, stream); launch_phase<PH_POOL_G2>(a, L, grid, stream); launch_phase<PH_POOL_G3>(a, L, grid, stream); }
        else if (kind == 1) { launch_phase<PH_DIL_G1>(a, L, grid, stream); launch_phase<PH_DIL_ATT>(a, L, grid, stream); launch_phase<PH_DIL_CMB>(a, L, grid, stream); launch_phase<PH_DIL_G2>(a, L, grid, stream); }
        else { launch_phase<PH_CONV_G1>(a, L, grid, stream); launch_phase<PH_CONV_E>(a, L, grid, stream); launch_phase<PH_CONV_G2>(a, L, grid, stream); }
        launch_phase<PH_MOE1>(a, L, grid, stream); launch_phase<PH_MOE2>(a, L, grid, stream); launch_phase<PH_MOE3>(a, L, grid, stream); launch_phase<PH_MOE4>(a, L, grid, stream);
    }
#endif
}
```

```cpp
#include <hip/hip_runtime.h>
#include <cstdio>
#include <cstdint>

#ifndef MK_ONE_LAUNCH
#define MK_ONE_LAUNCH 1
#endif

#define GAS __attribute__((address_space(1)))
#define LAS __attribute__((address_space(3)))
typedef unsigned short bf16;
typedef unsigned v4u __attribute__((ext_vector_type(4)));
typedef unsigned v2u __attribute__((ext_vector_type(2)));
typedef float f32x4 __attribute__((ext_vector_type(4)));
typedef float f32x2 __attribute__((ext_vector_type(2)));
typedef short bf16x8 __attribute__((ext_vector_type(8)));
typedef short s16x4 __attribute__((ext_vector_type(4)));

constexpr int NBATCH = 8, SEQ = 2048, D = 2048, T = NBATCH * SEQ, DEPTH = 4;
constexpr int NEXP = 64, TOPK = 8, EDIM = 128, SDIM = 256;
constexpr int QKVC = 4608, DILW = 512;
constexpr float ALPHA = 1.681792830507429f;
constexpr float LN_EPS = 1e-5f;
constexpr int CAP = 16384;
constexpr int HROWS = T * TOPK + NEXP * 256;

constexpr size_t MiB = 1u << 20;
constexpr size_t WS_CTL = 0, CTL_ZERO_BYTES = 1 * MiB;
constexpr size_t WS_W_POOL_IN = 1 * MiB;
constexpr size_t WS_W_POOL_G = WS_W_POOL_IN + 16 * MiB;
constexpr size_t WS_W_POOL_OUT = WS_W_POOL_G + 4 * MiB;
constexpr size_t WS_W_DIL_QKV = WS_W_POOL_OUT + 16 * MiB;
constexpr size_t WS_W_DIL_OUT = WS_W_DIL_QKV + 18 * MiB;
constexpr size_t WS_W_CONV_IN = WS_W_DIL_OUT + 2 * MiB;
constexpr size_t WS_W_CONV_OUT = WS_W_CONV_IN + 24 * MiB;
constexpr size_t WS_W_SH_GU = WS_W_CONV_OUT + 8 * MiB;
constexpr size_t WS_W_SH_D = WS_W_SH_GU + 8 * MiB;
constexpr size_t WS_W_EX_GU = WS_W_SH_D + 4 * MiB;
constexpr size_t WS_W_EX_D = WS_W_EX_GU + 256 * MiB;
constexpr size_t WS_XF = WS_W_EX_D + 256 * MiB;
constexpr size_t WS_YF = WS_XF + 128 * MiB;
constexpr size_t WS_X1F = WS_YF + 128 * MiB;
constexpr size_t WS_XB = WS_X1F + 128 * MiB;
constexpr size_t WS_X1B = WS_XB + 64 * MiB;
constexpr size_t WS_HB = WS_X1B + 64 * MiB;
constexpr size_t WS_HS = WS_HB + 72 * MiB;
constexpr size_t WS_LTOK = WS_HS + 8 * MiB;
constexpr size_t WS_LGATE = WS_LTOK + 4 * MiB;
constexpr size_t WS_EIDX = WS_LGATE + 4 * MiB;
constexpr size_t WS_INV = WS_EIDX + 1 * MiB;
constexpr size_t WS_BIG = WS_INV + 1 * MiB;
constexpr size_t WS_PST = WS_BIG + 608 * MiB;
constexpr size_t WS_ST1 = WS_PST + 4 * MiB;
constexpr size_t WS_ST2 = WS_ST1 + 1 * MiB;
constexpr size_t WS_RWH = WS_ST2 + 1 * MiB;
constexpr size_t WS_RWL = WS_RWH + 1 * MiB;
constexpr size_t WS_PST2 = WS_RWL + 1 * MiB;
constexpr size_t WS_END = WS_PST2 + 8 * MiB;
constexpr size_t WS_Y2F = WS_X1F;
constexpr size_t BG_U = 0, BG_PL = 64 * MiB, BG_MX = 128 * MiB;
constexpr size_t BG_QKV = 0, BG_OG = 144 * MiB, BG_LSE = 192 * MiB, BG_O = 194 * MiB;
constexpr size_t BG_UC = 0, BG_BG = 64 * MiB, BG_Z = 128 * MiB;
constexpr size_t BG_YSC = 400 * MiB;
constexpr int CW_BAR = 4096;
constexpr int CW_CNT = 16384;

constexpr int RING_BYTES = 131072;
constexpr int LDS_TAB = RING_BYTES;
constexpr int LDS_STASH = RING_BYTES + 1024;
constexpr int LDS_BYTES = 163840;
constexpr int LDS_MISC = LDS_BYTES - 1024;

typedef __bf16 bf16x2_t __attribute__((ext_vector_type(2)));
typedef float f32x2_t __attribute__((ext_vector_type(2)));
__device__ __forceinline__ unsigned cvt_pk_bf16(float lo, float hi) { const bf16x2_t r = __builtin_convertvector((f32x2_t){lo, hi}, bf16x2_t); return __builtin_bit_cast(unsigned, r); }
__device__ __forceinline__ unsigned f2bf(float f) { unsigned u = __builtin_bit_cast(unsigned, f); return (u + 0x7fffu + ((u >> 16) & 1u)) >> 16; }
__device__ __forceinline__ unsigned pk2(float lo, float hi) { return f2bf(lo) | (f2bf(hi) << 16); }
__device__ __forceinline__ float bflo(unsigned w) { return __builtin_bit_cast(float, w << 16); }
__device__ __forceinline__ float bfhi(unsigned w) { return __builtin_bit_cast(float, w & 0xffff0000u); }
__device__ __forceinline__ float shfl_from(float v, int src) { return __builtin_bit_cast(float, __builtin_amdgcn_ds_bpermute(src << 2, __builtin_bit_cast(int, v))); }
__device__ __forceinline__ float shfl_x(float v, int o, int lane) { return shfl_from(v, lane ^ o); }
__device__ __forceinline__ float wave_sum(float v, int lane) {
    (void)lane;
    v += __builtin_bit_cast(float, __builtin_amdgcn_update_dpp(0, __builtin_bit_cast(int, v), 0xB1, 0xF, 0xF, false));
    v += __builtin_bit_cast(float, __builtin_amdgcn_update_dpp(0, __builtin_bit_cast(int, v), 0x4E, 0xF, 0xF, false));
    v += __builtin_bit_cast(float, __builtin_amdgcn_update_dpp(0, __builtin_bit_cast(int, v), 0x141, 0xF, 0xF, false));
    v += __builtin_bit_cast(float, __builtin_amdgcn_update_dpp(0, __builtin_bit_cast(int, v), 0x140, 0xF, 0xF, false));
    const float r0 = __builtin_bit_cast(float, __builtin_amdgcn_readlane(__builtin_bit_cast(int, v), 0)), r1 = __builtin_bit_cast(float, __builtin_amdgcn_readlane(__builtin_bit_cast(int, v), 16));
    const float r2 = __builtin_bit_cast(float, __builtin_amdgcn_readlane(__builtin_bit_cast(int, v), 32)), r3 = __builtin_bit_cast(float, __builtin_amdgcn_readlane(__builtin_bit_cast(int, v), 48));
    return (r0 + r1) + (r2 + r3);
}
__device__ __forceinline__ float sum_fq(float x) {
    { const auto r = __builtin_amdgcn_permlane16_swap(__builtin_bit_cast(unsigned, x), __builtin_bit_cast(unsigned, x), false, false); const unsigned a_ = r[0], b_ = r[1]; x = __builtin_bit_cast(float, a_) + __builtin_bit_cast(float, b_); }
    { const auto r = __builtin_amdgcn_permlane32_swap(__builtin_bit_cast(unsigned, x), __builtin_bit_cast(unsigned, x), false, false); const unsigned a_ = r[0], b_ = r[1]; x = __builtin_bit_cast(float, a_) + __builtin_bit_cast(float, b_); }
    return x;
}
__device__ __forceinline__ float max_fq(float x) {
    { const auto r = __builtin_amdgcn_permlane16_swap(__builtin_bit_cast(unsigned, x), __builtin_bit_cast(unsigned, x), false, false); const unsigned a_ = r[0], b_ = r[1]; x = fmaxf(__builtin_bit_cast(float, a_), __builtin_bit_cast(float, b_)); }
    { const auto r = __builtin_amdgcn_permlane32_swap(__builtin_bit_cast(unsigned, x), __builtin_bit_cast(unsigned, x), false, false); const unsigned a_ = r[0], b_ = r[1]; x = fmaxf(__builtin_bit_cast(float, a_), __builtin_bit_cast(float, b_)); }
    return x;
}
#define LDS_WAIT() asm volatile("s_waitcnt lgkmcnt(0)" ::: "memory")
#define VM_WAIT() asm volatile("s_waitcnt vmcnt(0)" ::: "memory")

#define XB_TMO      128
#define XB_XCNT(j)  (256  + 64 * (j))
#define XB_XSUB(j)  (1280 + 64 * (j))
#define XB_XGEN(j)  (2304 + 64 * (j))
#define XB_TOP      3328
#define XB_TOPGEN   3392
#define XCD_BAR_WORDS 3456
#define XB_SPIN_CAP (1u << 18)

__device__ __forceinline__ unsigned xb_ld(unsigned* p)              { return __hip_atomic_load(p, __ATOMIC_RELAXED, __HIP_MEMORY_SCOPE_AGENT); }
__device__ __forceinline__ unsigned xb_add(unsigned* p, unsigned v) { return __hip_atomic_fetch_add(p, v, __ATOMIC_RELAXED, __HIP_MEMORY_SCOPE_AGENT); }
__device__ __forceinline__ unsigned xb_xcc_id() { return (unsigned)__builtin_amdgcn_s_getreg((3 << 11) | 20) & 0xFu; }
#define XB_SPIN(cond, bar) do { unsigned _sp = 0; while (cond) { __builtin_amdgcn_s_sleep(1); \
    if ((++_sp & 255u) == 0u) { if (xb_ld(&(bar)[XB_TMO])) break; if (_sp > XB_SPIN_CAP) { atomicAdd(&(bar)[XB_TMO], 1u); break; } } } } while (0)

struct XcdBarrier {
    unsigned* bar; unsigned x;
    volatile LAS unsigned* st;
};

__device__ __forceinline__ XcdBarrier xcd_barrier_post(unsigned* bar, volatile LAS unsigned* st) {
    XcdBarrier b; b.bar = bar; b.x = xb_xcc_id(); b.st = st;
    if (threadIdx.x == 0) (void)xb_add(&bar[XB_XCNT(b.x)], 1u);
    return b;
}
__device__ __forceinline__ void xcd_barrier_complete(unsigned* bar, unsigned x, unsigned& nloc, unsigned& nx) {
    const unsigned G = gridDim.x * gridDim.y * gridDim.z;
    unsigned sum, cnt, mine, sp = 0u;
    for (;;) {
        sum = 0u; cnt = 0u; mine = 0u;
#pragma unroll
        for (unsigned j = 0; j < 16; ++j) { const unsigned c = xb_ld(&bar[XB_XCNT(j)]); sum += c; cnt += (c > 0u) ? 1u : 0u; mine = (j == x) ? c : mine; }
        if (sum == G) break;
        __builtin_amdgcn_s_sleep(1);
        if ((++sp & 255u) == 0u) { if (xb_ld(&bar[XB_TMO])) break; if (sp > XB_SPIN_CAP) { atomicAdd(&bar[XB_TMO], 1u); break; } }
    }
    nloc = mine > 0u ? mine : 1u; nx = cnt > 0u ? cnt : 1u;
}

__device__ __forceinline__ void xcd_barrier(const XcdBarrier& b) {
    asm volatile("s_waitcnt vmcnt(0)" ::: "memory");
    __syncthreads();
    if (threadIdx.x == 0) {
        unsigned* bar; unsigned bx = b.x; { GAS unsigned* bg = (GAS unsigned*)b.bar; asm volatile("" : "+s"(bg), "+s"(bx)); bar = (unsigned*)bg; }
        __builtin_amdgcn_s_waitcnt(0);
        unsigned nloc = b.st[0], nx = b.st[1];
        if (nloc == 0u) { xcd_barrier_complete(bar, bx, nloc, nx); b.st[0] = nloc; b.st[1] = nx; }
        const unsigned old = xb_add(&bar[XB_XSUB(bx)], 1u);
        const unsigned gen = old / nloc;
        if (old + 1u == (gen + 1u) * nloc) {
            __builtin_amdgcn_fence(__ATOMIC_RELEASE, "agent");
            asm volatile("s_waitcnt vmcnt(0)" ::: "memory");
            const unsigned og = xb_add(&bar[XB_TOP], 1u);
            const unsigned tg = og / nx;
            if (og + 1u == (tg + 1u) * nx) xb_add(&bar[XB_TOPGEN], 1u);
            else XB_SPIN(xb_ld(&bar[XB_TOPGEN]) == tg, bar);
            __builtin_amdgcn_fence(__ATOMIC_ACQUIRE, "agent");
            xb_add(&bar[XB_XGEN(bx)], 1u);
            asm volatile("s_waitcnt vmcnt(0)" ::: "memory");
        } else {
            XB_SPIN(xb_ld(&bar[XB_XGEN(bx)]) == gen, bar);
            __builtin_amdgcn_fence(__ATOMIC_ACQUIRE, "agent");
            asm volatile("s_waitcnt vmcnt(0)" ::: "memory");
        }
    }
    __syncthreads();
}

namespace g8 {
constexpr int BM = 256, BK = 64, HALF = 128, HTB = HALF * BK * 2, STAGE_BYTES = 8 * HTB, NXCD = 8, WGM = 8;
__host__ __device__ __forceinline__ int lds_byte(int r, int c) { const int st = (r >> 4) * 2 + (c >> 5), rr = r & 15, cc = c & 31, ob = rr * 64 + cc * 2; return st * 1024 + (ob ^ (((ob >> 9) & 1) << 5)); }
__host__ __device__ __forceinline__ void stage_rc(int b, int& R, int& C) { const int st = b / 1024, sb = b % 1024, swz = sb ^ (((sb >> 9) & 1) << 5); R = (st >> 1) * 16 + swz / 64; C = (st & 1) * 32 + (swz % 64) / 2; }
__host__ __device__ __forceinline__ int perm32(int rho) { const int n = rho >> 4, i = rho & 15; return 8 * (i >> 2) + 4 * n + (i & 3); }

struct Unit { const char* A; const char* B; const int* rows; int pm, pn, nvalid, aux; };

template <class Epi, class Sched, bool GATHER>
__device__ __forceinline__ void gemm_phase(LAS unsigned char* lds, const int tid_in, const int K, const int lda, const int ldb, const Sched& S, const Epi& E) {
    const int tid = tid_in, wid = __builtin_amdgcn_readfirstlane(tid >> 6), lane = tid & 63, wr = wid >> 2, wc = wid & 3, fr = lane & 15, fq = lane >> 4;
    const int nt = K / BK;
    unsigned voffB[2];
#pragma unroll
    for (int i = 0; i < 2; ++i) { int R_, C_; stage_rc(tid * 16 + i * 8192, R_, C_); const int Rb = Epi::PERM ? ((R_ & ~31) + perm32(R_ & 31)) : R_; voffB[i] = (unsigned)(Rb * ldb + C_) * 2u; }
    LAS v4u* stash = (LAS v4u*)(lds + (LDS_STASH - 0) + tid * 16);
    const size_t kstep = (size_t)(BK * 2);
    const size_t hstepB = (size_t)HALF * ldb * 2;
    const unsigned ldsw = (unsigned)wid * 1024u;
    const int aoff = lds_byte(wr * 64 + fr, fq * 8), boff = lds_byte(wc * 32 + fr, fq * 8);
#define G8_SA(b, h) (((b) * 2 + (h)) * HTB)
#define G8_SB(b, h) ((4 + (b) * 2 + (h)) * HTB)
#define G8_STAGE2(bufoff, gbase, v0, v1) do { \
        __builtin_amdgcn_global_load_lds((const unsigned*)((const char*)(gbase) + (v0)), (LAS unsigned*)(lds + (bufoff) + ldsw), 16, 0, 0); \
        __builtin_amdgcn_global_load_lds((const unsigned*)((const char*)(gbase) + (v1)), (LAS unsigned*)(lds + (bufoff) + ldsw + 8192), 16, 0, 0); } while (0)
#define G8_STAGEB(bufoff, gbase) G8_STAGE2(bufoff, gbase, voffB[0], voffB[1])
#define G8_LDA(dst, b, h) do { _Pragma("unroll") for (int m = 0; m < 4; ++m) _Pragma("unroll") for (int k = 0; k < 2; ++k) dst[m][k] = *(const LAS bf16x8*)(lds + G8_SA(b, h) + aoff + m * 2048 + k * 1024); } while (0)
#define G8_LDB(dst, b, h) do { _Pragma("unroll") for (int n = 0; n < 2; ++n) _Pragma("unroll") for (int k = 0; k < 2; ++k) dst[n][k] = *(const LAS bf16x8*)(lds + G8_SB(b, h) + boff + n * 2048 + k * 1024); } while (0)
#define G8_MMA(ai, bj, At, Bt) do { __builtin_amdgcn_s_setprio(1); _Pragma("unroll") for (int m = 0; m < 4; ++m) _Pragma("unroll") for (int n = 0; n < 2; ++n) _Pragma("unroll") for (int k = 0; k < 2; ++k) \
        acc[ai][bj][m][n] = __builtin_amdgcn_mfma_f32_16x16x32_bf16(Bt[n][k], At[m][k], acc[ai][bj][m][n], 0, 0, 0); __builtin_amdgcn_s_setprio(0); } while (0)
#define G8_WAIT_V(n) asm volatile("s_waitcnt vmcnt(" #n ")" ::: "memory")
#define G8_WAIT_L(n) asm volatile("s_waitcnt lgkmcnt(" #n ")" ::: "memory")
#define G8_BAR __builtin_amdgcn_s_barrier()
#define G8_SCHED __builtin_amdgcn_sched_barrier(0)
#define G8_SETVA(dst, u) do { int _t2 = tid; if (GATHER) asm volatile("" : "+v"(_t2)); _Pragma("unroll") for (int _h = 0; _h < 2; ++_h) _Pragma("unroll") for (int _i = 0; _i < 2; ++_i) { \
        int _R, _C; stage_rc(_t2 * 16 + _i * 8192, _R, _C); \
        const unsigned _rl = (unsigned)(_h * HALF + _R); unsigned _row = _rl; \
        if (GATHER) { const bool _ok = _rl < (unsigned)(u).nvalid; _row = (unsigned)(u).rows[_ok ? _rl : 0u] >> 3; if (!_ok) _row = 0u; }     \
        dst[_h][_i] = (_row * (unsigned)lda + (unsigned)_C) * 2u; } } while (0)
    Unit cur, nxt; int ui = 0;
    if (!S.next(0, cur)) return;
    f32x4 acc[2][2][4][2];
#pragma unroll
    for (int a = 0; a < 2; ++a)
#pragma unroll
        for (int b = 0; b < 2; ++b)
#pragma unroll
            for (int m = 0; m < 4; ++m)
#pragma unroll
                for (int n = 0; n < 2; ++n) acc[a][b][m][n] = (f32x4){0.f, 0.f, 0.f, 0.f};
    bf16x8 At[4][2], B0[2][2], B1[2][2];
    unsigned vAc[2][2]; unsigned xl00 = 0, xl01 = 0, xl10 = 0, xl11 = 0;
    G8_SETVA(vAc, cur);
    const char* cA = cur.A; const char* cB = cur.B;
    G8_STAGEB(G8_SB(0, 0), cB); G8_STAGEB(G8_SB(0, 1), cB + hstepB); G8_STAGE2(G8_SA(0, 0), cA, vAc[0][0], vAc[0][1]); G8_STAGE2(G8_SA(0, 1), cA, vAc[1][0], vAc[1][1]);
    if (wr == 1) G8_BAR;
    G8_WAIT_V(2); G8_BAR;
    G8_STAGEB(G8_SB(1, 0), cB + kstep); G8_STAGE2(G8_SA(1, 0), cA + kstep, vAc[0][0], vAc[0][1]); G8_STAGEB(G8_SB(1, 1), cB + hstepB + kstep);
    G8_WAIT_V(6); G8_BAR;
    for (;;) {
        const bool has_next = S.next(ui + 1, nxt);
        const char* nA = has_next ? nxt.A : cA; const char* nB = has_next ? nxt.B : cB;
        if (GATHER) { unsigned vAn[2][2]; if (has_next) { G8_SETVA(vAn, nxt); } else {
#pragma unroll
            for (int h = 0; h < 2; ++h)
#pragma unroll
                for (int i = 0; i < 2; ++i) vAn[h][i] = vAc[h][i]; }
            *stash = (v4u){vAn[0][0], vAn[0][1], vAn[1][0], vAn[1][1]}; }
#pragma unroll 1
        for (int t = 0; t < nt; t += 2) {
            const bool last = (t == nt - 2);
            const char* a1 = cA + (size_t)(t + 1) * kstep;
            const char* a2 = last ? nA : cA + (size_t)(t + 2) * kstep; const char* b2 = last ? nB : cB + (size_t)(t + 2) * kstep;
            const char* a3 = a2 + kstep; const char* b3 = b2 + kstep;
            unsigned x00 = vAc[0][0], x01 = vAc[0][1], x10 = vAc[1][0], x11 = vAc[1][1];
            if (GATHER) { if (last) { const v4u sv = *stash; x00 = sv.x; x01 = sv.y; x10 = sv.z; x11 = sv.w; } xl00 = x00; xl01 = x01; xl10 = x10; xl11 = x11; }
            G8_LDB(B0, 0, 0); G8_LDB(B1, 0, 1); G8_SCHED; G8_LDA(At, 0, 0); G8_STAGE2(G8_SA(1, 1), a1, vAc[1][0], vAc[1][1]);
            G8_WAIT_V(8); G8_WAIT_L(0); G8_BAR; G8_MMA(0, 0, At, B0); G8_MMA(0, 1, At, B1); G8_BAR; G8_SCHED;
            G8_LDA(At, 0, 1); G8_STAGEB(G8_SB(0, 0), b2); G8_STAGEB(G8_SB(0, 1), b2 + hstepB); G8_STAGE2(G8_SA(0, 0), a2, x00, x01);
            G8_WAIT_V(8); G8_WAIT_L(0); G8_BAR; G8_MMA(1, 0, At, B0); G8_MMA(1, 1, At, B1); G8_BAR; G8_SCHED;
            G8_LDB(B0, 1, 0); G8_LDB(B1, 1, 1); G8_SCHED; G8_LDA(At, 1, 0); G8_STAGE2(G8_SA(0, 1), a2, x10, x11);
            G8_WAIT_V(8); G8_WAIT_L(0); G8_BAR; G8_MMA(0, 0, At, B0); G8_MMA(0, 1, At, B1); G8_BAR; G8_SCHED;
            G8_LDA(At, 1, 1); G8_STAGEB(G8_SB(1, 0), b3); G8_STAGEB(G8_SB(1, 1), b3 + hstepB); G8_STAGE2(G8_SA(1, 0), a3, x00, x01);
            G8_WAIT_V(8); G8_WAIT_L(0); G8_BAR; G8_MMA(1, 0, At, B0); G8_MMA(1, 1, At, B1); G8_BAR; G8_SCHED;
        }
        if (wr == 0) G8_BAR;
        E(acc, cur, wr, wc, fr, fq);
        if (!has_next) break;
#pragma unroll
        for (int a = 0; a < 2; ++a)
#pragma unroll
            for (int b = 0; b < 2; ++b)
#pragma unroll
                for (int m = 0; m < 4; ++m)
#pragma unroll
                    for (int n = 0; n < 2; ++n) acc[a][b][m][n] = (f32x4){0.f, 0.f, 0.f, 0.f};
        cur = nxt; cA = nA; cB = nB; ++ui;
        if (GATHER) { vAc[0][0] = xl00; vAc[0][1] = xl01; vAc[1][0] = xl10; vAc[1][1] = xl11; }
        if (wr == 1) G8_BAR;
    }
    G8_WAIT_V(0);
    G8_BAR;
#undef G8_SA
#undef G8_SB
#undef G8_STAGE2
#undef G8_STAGEB
#undef G8_LDA
#undef G8_LDB
#undef G8_MMA
#undef G8_WAIT_V
#undef G8_WAIT_L
#undef G8_BAR
#undef G8_SCHED
#undef G8_SETVA
}

struct DenseSched {
    const char* A; const char* B; size_t a_tile, b_tile, agrp_stride; int agrp_shift, nM, nN, nwg, G, c;
    __device__ __forceinline__ void init(const void* A_, const void* B_, int M, int N, int lda, int ldb, int G_, int c_) {
        A = (const char*)A_; B = (const char*)B_; a_tile = (size_t)BM * lda * 2; b_tile = (size_t)BM * ldb * 2; agrp_stride = 0; agrp_shift = 0; nM = M / BM; nN = N / BM; nwg = nM * nN; G = G_; c = c_; }
    __device__ __forceinline__ bool next(int i, Unit& u) const {
        const long L = (long)i * G + c; if (L >= nwg) return false;
        int wgid = (int)L; { const int q = nwg / NXCD, r = nwg % NXCD, xcd = wgid % NXCD, off = wgid / NXCD; wgid = (xcd < r ? xcd * (q + 1) : r * (q + 1) + (xcd - r) * q) + off; }
        const int nig = WGM * nN, gid = wgid / nig, fm = gid * WGM, gsz = (nM - fm) < WGM ? (nM - fm) : WGM;
        u.pm = fm + ((wgid % nig) % gsz); u.pn = (wgid % nig) / gsz;
        u.A = A + (size_t)u.pm * a_tile + (size_t)(u.pn >> agrp_shift) * agrp_stride; u.B = B + (size_t)u.pn * b_tile; u.rows = nullptr; u.nvalid = BM; u.aux = 0; return true;
    }
};
template <int NPN, bool GATHERED>
struct ExpertSched {
    const LAS int* tpref; const LAS int* cnt; const char* A; const char* B; const int* tok; size_t b_exp, b_tile, a_tile; int NU, G, c;
    __device__ __forceinline__ bool next(int i, Unit& u) const {
        int L = i * G + c; if (L >= NU) return false;
        if ((i + 1) * G <= NU && (G % NXCD) == 0) L = i * G + (c % NXCD) * (G / NXCD) + c / NXCD;
        const int tile = L / NPN, pn = L % NPN;
        int e = 0; { int hi = 64;
#pragma unroll
          for (int it_ = 0; it_ < 6; ++it_) { const int mid = (e + hi) >> 1; if (__builtin_amdgcn_readfirstlane(tpref[mid]) <= tile) e = mid; else hi = mid; } }
        const int rb = tile - __builtin_amdgcn_readfirstlane(tpref[e]);
        u.pm = e; u.pn = pn; u.aux = tile * BM; u.nvalid = __builtin_amdgcn_readfirstlane(cnt[e]) - rb * BM; if (u.nvalid > BM) u.nvalid = BM;
        u.rows = tok + (size_t)e * CAP + rb * BM;
        u.A = GATHERED ? A : A + (size_t)tile * a_tile; u.B = B + (size_t)e * b_exp + (size_t)pn * b_tile; return true;
    }
};

struct EpiBf16 {
    static constexpr bool PERM = true;
    bf16* O; int ldc; int qscale;
    __device__ __forceinline__ void operator()(const f32x4 (&acc)[2][2][4][2], const Unit& u, int wr, int wc, int fr, int fq) const {
        asm volatile("" : "+v"(fr), "+v"(fq));
        const int row0 = u.pm * BM + wr * 64 + fr, col0 = u.pn * BM + wc * 32 + 8 * fq;
        const float sc = (qscale && (u.pn % 6) < 2) ? 0.125f : 1.0f;
#pragma unroll
        for (int ai = 0; ai < 2; ++ai)
#pragma unroll
            for (int m = 0; m < 4; ++m) { bf16* rowp = O + (size_t)(row0 + ai * HALF + m * 16) * ldc + col0;
#pragma unroll
                for (int bj = 0; bj < 2; ++bj) { const f32x4 v0 = acc[ai][bj][m][0] * sc, v1 = acc[ai][bj][m][1] * sc;
                    v4u w; w.x = cvt_pk_bf16(v0[0], v0[1]); w.y = cvt_pk_bf16(v0[2], v0[3]); w.z = cvt_pk_bf16(v1[0], v1[1]); w.w = cvt_pk_bf16(v1[2], v1[3]);
                    *(v4u*)(rowp + bj * HALF) = w; } }
    }
};
struct EpiScaleBf16 {
    static constexpr bool PERM = true;
    bf16* O; int ldc; const float* scale;
    __device__ __forceinline__ void operator()(const f32x4 (&acc)[2][2][4][2], const Unit& u, int wr, int wc, int fr, int fq) const {
        asm volatile("" : "+v"(fr), "+v"(fq));
        const int row0 = u.pm * BM + wr * 64 + fr, col0 = u.pn * BM + wc * 32 + 8 * fq;
        f32x4 sv[2][2];
#pragma unroll
        for (int bj = 0; bj < 2; ++bj)
#pragma unroll
            for (int n = 0; n < 2; ++n) sv[bj][n] = *(const f32x4*)(scale + col0 + bj * HALF + 4 * n);
#pragma unroll
        for (int ai = 0; ai < 2; ++ai)
#pragma unroll
            for (int m = 0; m < 4; ++m) { bf16* rowp = O + (size_t)(row0 + ai * HALF + m * 16) * ldc + col0;
#pragma unroll
                for (int bj = 0; bj < 2; ++bj) { const f32x4 v0 = acc[ai][bj][m][0] * sv[bj][0], v1 = acc[ai][bj][m][1] * sv[bj][1];
                    v4u w; w.x = cvt_pk_bf16(v0[0], v0[1]); w.y = cvt_pk_bf16(v0[2], v0[3]); w.z = cvt_pk_bf16(v1[0], v1[1]); w.w = cvt_pk_bf16(v1[2], v1[3]);
                    *(v4u*)(rowp + bj * HALF) = w; } }
    }
};
struct EpiResid {
    static constexpr bool PERM = false;
    const float* X; float* Y;
    __device__ __forceinline__ void operator()(const f32x4 (&acc)[2][2][4][2], const Unit& u, int wr, int wc, int fr, int fq) const {
        asm volatile("" : "+v"(fr), "+v"(fq));
        const int row0 = u.pm * BM + wr * 64 + fr, col0 = u.pn * BM + wc * 32 + 4 * fq;
#pragma unroll
        for (int ai = 0; ai < 2; ++ai)
#pragma unroll
            for (int m = 0; m < 4; ++m) { const size_t off = (size_t)(row0 + ai * HALF + m * 16) * D + col0;
#pragma unroll
                for (int bj = 0; bj < 2; ++bj)
#pragma unroll
                    for (int n = 0; n < 2; ++n) { const f32x4 xv = *(const f32x4*)(X + off + bj * HALF + n * 16); *(f32x4*)(Y + off + bj * HALF + n * 16) = xv * ALPHA + acc[ai][bj][m][n]; } }
    }
};
struct EpiResidLN {
    static constexpr bool PERM = true;
    const float* X32; const bf16* Xb; const float* st; const float* g; const float* b; bf16* Y; float* pst; int mode;
    __device__ __forceinline__ void operator()(const f32x4 (&acc)[2][2][4][2], const Unit& u, int wr, int wc, int fr, int fq) const {
        asm volatile("" : "+v"(fr), "+v"(fq));
        const int row0 = u.pm * BM + wr * 64 + fr, col0 = u.pn * BM + wc * 32 + 8 * fq, lane = fq * 16 + fr;
#pragma unroll
        for (int ai = 0; ai < 2; ++ai) {
            v4u xr[4][2];
#pragma unroll
            for (int m = 0; m < 4; ++m)
#pragma unroll
                for (int bj = 0; bj < 2; ++bj) xr[m][bj] = *(const v4u*)(Xb + (size_t)(row0 + ai * HALF + m * 16) * D + col0 + bj * HALF);
            asm volatile("" : "+v"(xr[0][0]), "+v"(xr[0][1]), "+v"(xr[1][0]), "+v"(xr[1][1]), "+v"(xr[2][0]), "+v"(xr[2][1]), "+v"(xr[3][0]), "+v"(xr[3][1]));
#pragma unroll
            for (int m = 0; m < 4; ++m) { const int row = row0 + ai * HALF + m * 16; const size_t off = (size_t)row * D + col0;
                float sm = 0.f, sq = 0.f;
#pragma unroll
                for (int bj = 0; bj < 2; ++bj) { const v4u xv = xr[m][bj];
                    const f32x4 x0 = (f32x4){bflo(xv.x), bfhi(xv.x), bflo(xv.y), bfhi(xv.y)}, x1 = (f32x4){bflo(xv.z), bfhi(xv.z), bflo(xv.w), bfhi(xv.w)};
                    const f32x4 y0 = x0 * ALPHA + acc[ai][bj][m][0], y1 = x1 * ALPHA + acc[ai][bj][m][1];
                    v4u w; w.x = cvt_pk_bf16(y0[0], y0[1]); w.y = cvt_pk_bf16(y0[2], y0[3]); w.z = cvt_pk_bf16(y1[0], y1[1]); w.w = cvt_pk_bf16(y1[2], y1[3]);
                    *(v4u*)(Y + off + bj * HALF) = w;
                    sm += ((y0[0] + y0[1]) + (y0[2] + y0[3])) + ((y1[0] + y1[1]) + (y1[2] + y1[3]));
                    sq += ((y0[0] * y0[0] + y0[1] * y0[1]) + (y0[2] * y0[2] + y0[3] * y0[3])) + ((y1[0] * y1[0] + y1[1] * y1[1]) + (y1[2] * y1[2] + y1[3] * y1[3])); }
                sm = sum_fq(sm); sq = sum_fq(sq);
                if (fq == 0) *(f32x2*)(pst + ((size_t)row * 32 + u.pn * 4 + wc) * 2) = (f32x2){sm, sq}; } }
    }
};
struct EpiConvIn {
    static constexpr bool PERM = true;
    bf16* UC; bf16* BGp;
    __device__ __forceinline__ void operator()(const f32x4 (&acc)[2][2][4][2], const Unit& u, int wr, int wc, int fr, int fq) const {
        asm volatile("" : "+v"(fr), "+v"(fq));
        const int row0 = u.pm * BM + wr * 64 + fr, cw = wc * 32 + 8 * fq;
        if (u.pn < 16) {
#pragma unroll
            for (int ai = 0; ai < 2; ++ai)
#pragma unroll
                for (int m = 0; m < 4; ++m) { bf16* rowp = UC + (size_t)(row0 + ai * HALF + m * 16) * D + u.pn * HALF + cw;
                    const f32x4 v0 = acc[ai][0][m][0] * acc[ai][1][m][0], v1 = acc[ai][0][m][1] * acc[ai][1][m][1];
                    v4u w; w.x = cvt_pk_bf16(v0[0], v0[1]); w.y = cvt_pk_bf16(v0[2], v0[3]); w.z = cvt_pk_bf16(v1[0], v1[1]); w.w = cvt_pk_bf16(v1[2], v1[3]);
                    *(v4u*)rowp = w; }
        } else {
#pragma unroll
            for (int ai = 0; ai < 2; ++ai)
#pragma unroll
                for (int m = 0; m < 4; ++m) { bf16* rowp = BGp + (size_t)(row0 + ai * HALF + m * 16) * D + (u.pn - 16) * BM + cw;
#pragma unroll
                    for (int bj = 0; bj < 2; ++bj) { const f32x4 v0 = acc[ai][bj][m][0], v1 = acc[ai][bj][m][1];
                        v4u w; w.x = cvt_pk_bf16(v0[0], v0[1]); w.y = cvt_pk_bf16(v0[2], v0[3]); w.z = cvt_pk_bf16(v1[0], v1[1]); w.w = cvt_pk_bf16(v1[2], v1[3]);
                        *(v4u*)(rowp + bj * HALF) = w; } }
        }
    }
};
__device__ __forceinline__ f32x4 silu_mul(f32x4 g, f32x4 uu) {
    f32x4 r;
#pragma unroll
    for (int j = 0; j < 4; ++j) r[j] = g[j] * __builtin_amdgcn_rcpf(1.0f + __expf(-g[j])) * uu[j];
    return r;
}
struct EpiExpertGU {
    static constexpr bool PERM = true;
    bf16* H;
    __device__ __forceinline__ void operator()(const f32x4 (&acc)[2][2][4][2], const Unit& u, int wr, int wc, int fr, int fq) const {
        asm volatile("" : "+v"(fr), "+v"(fq));
        const float* gates = (const float*)((const char*)u.rows + (WS_LGATE - WS_LTOK));
        const int cw = wc * 32 + 8 * fq;
        float gtv[2][4];
#pragma unroll
        for (int ai = 0; ai < 2; ++ai)
#pragma unroll
            for (int m = 0; m < 4; ++m) { const int r = ai * HALF + wr * 64 + m * 16 + fr; gtv[ai][m] = gates[r < u.nvalid ? r : 0]; }
        asm volatile("" : "+v"(gtv[0][0]), "+v"(gtv[0][1]), "+v"(gtv[0][2]), "+v"(gtv[0][3]), "+v"(gtv[1][0]), "+v"(gtv[1][1]), "+v"(gtv[1][2]), "+v"(gtv[1][3]));
#pragma unroll
        for (int ai = 0; ai < 2; ++ai)
#pragma unroll
            for (int m = 0; m < 4; ++m) { const int r = ai * HALF + wr * 64 + m * 16 + fr;
                if (r < u.nvalid) { const float gt = gtv[ai][m]; const unsigned pid = 0u;
                    const f32x4 v0 = silu_mul(acc[ai][0][m][0], acc[ai][1][m][0]) * gt, v1 = silu_mul(acc[ai][0][m][1], acc[ai][1][m][1]) * gt;
                    v4u w; w.x = cvt_pk_bf16(v0[0], v0[1]); w.y = cvt_pk_bf16(v0[2], v0[3]); w.z = cvt_pk_bf16(v1[0], v1[1]); w.w = cvt_pk_bf16(v1[2], v1[3]);
                    (void)pid; *(v4u*)(H + (size_t)(u.aux + r) * EDIM + cw) = w; } }
    }
};
struct EpiSharedGU {
    static constexpr bool PERM = true;
    bf16* HS;
    __device__ __forceinline__ void operator()(const f32x4 (&acc)[2][2][4][2], const Unit& u, int wr, int wc, int fr, int fq) const {
        asm volatile("" : "+v"(fr), "+v"(fq));
        const int row0 = u.pm * BM + wr * 64 + fr, cw = u.pn * HALF + wc * 32 + 8 * fq;
#pragma unroll
        for (int ai = 0; ai < 2; ++ai)
#pragma unroll
            for (int m = 0; m < 4; ++m) {
                const f32x4 v0 = silu_mul(acc[ai][0][m][0], acc[ai][1][m][0]), v1 = silu_mul(acc[ai][0][m][1], acc[ai][1][m][1]);
                v4u w; w.x = cvt_pk_bf16(v0[0], v0[1]); w.y = cvt_pk_bf16(v0[2], v0[3]); w.z = cvt_pk_bf16(v1[0], v1[1]); w.w = cvt_pk_bf16(v1[2], v1[3]);
                *(v4u*)(HS + (size_t)(row0 + ai * HALF + m * 16) * SDIM + cw) = w; }
    }
};
struct EpiDownY {
    static constexpr bool PERM = true;
    bf16* Y;
    __device__ __forceinline__ void operator()(const f32x4 (&acc)[2][2][4][2], const Unit& u, int wr, int wc, int fr, int fq) const {
        asm volatile("" : "+v"(fr), "+v"(fq));
        const int col0 = u.pn * BM + wc * 32 + 8 * fq;
#pragma unroll
        for (int ai = 0; ai < 2; ++ai)
#pragma unroll
            for (int m = 0; m < 4; ++m) { const int r = ai * HALF + wr * 64 + m * 16 + fr; bf16* rowp = Y + (size_t)(u.aux + r) * D + col0;
#pragma unroll
                for (int bj = 0; bj < 2; ++bj) { const f32x4 v0 = acc[ai][bj][m][0], v1 = acc[ai][bj][m][1];
                    v4u w; w.x = cvt_pk_bf16(v0[0], v0[1]); w.y = cvt_pk_bf16(v0[2], v0[3]); w.z = cvt_pk_bf16(v1[0], v1[1]); w.w = cvt_pk_bf16(v1[2], v1[3]);
                    *(v4u*)(rowp + bj * HALF) = w; } }
    }
};
}

struct Args { const float* in[19]; float* out; unsigned char* ws; int ph_lo, ph_hi; };
struct Frame {
    LAS unsigned char* lds; unsigned* ctl; unsigned char* ws;
    int tid, lane, wave, G, bid;
};
enum { IN_X = 0, IN_RELB, IN_PWIN, IN_PWG, IN_PSC, IN_PWOUT, IN_DQKV, IN_DOUT, IN_CWIN, IN_CW, IN_CWOUT, IN_LNG, IN_LNB, IN_RW, IN_RB, IN_EGU, IN_ED, IN_SGU, IN_SD };

#define CAS __attribute__((address_space(4)))
typedef const CAS unsigned char* KP;
__device__ __forceinline__ const float* ain(KP kp, int i) { return (const float*)((const GAS float* const CAS*)kp)[i]; }
__device__ __forceinline__ float* aout(KP kp) { return (float*)((GAS float* const CAS*)kp)[19]; }
__device__ __forceinline__ void tr_item(const float* W, int K, int N, bf16* WT, int dstK, int mode, LAS float* scr, int item, int lane) {
    const int nblk = N / 32, kb = item / nblk, nb = item % nblk, k0 = 64 * kb, n0 = 32 * nb;
    int r0 = n0;
    if (mode == 1) { const int part = n0 / 2048, j = n0 % 2048; r0 = (part == 0) ? 4096 + j : 256 * (j / 128) + (part == 2 ? 128 : 0) + (j % 128); }
    if (mode == 2) { const int part = n0 / 256, j = n0 % 256; r0 = 256 * (j / 128) + 128 * part + (j % 128); }
    float wv[32];
#pragma unroll
    for (int i = 0; i < 32; ++i) { const int kk = 2 * i + (lane >> 5); wv[i] = __builtin_nontemporal_load(W + (size_t)(k0 + kk) * N + n0 + (lane & 31)); }
#pragma unroll
    for (int i = 0; i < 32; ++i) { const int kk = 2 * i + (lane >> 5); scr[kk * 33 + (lane & 31)] = wv[i]; }
    LDS_WAIT(); asm volatile("" ::: "memory");
    const int c = lane & 7;
#pragma unroll
    for (int j = 0; j < 4; ++j) { const int n = (lane >> 3) + 8 * j; const LAS float* s = scr + (8 * c) * 33 + n;
        v4u o; o.x = pk2(s[0 * 33], s[1 * 33]); o.y = pk2(s[2 * 33], s[3 * 33]); o.z = pk2(s[4 * 33], s[5 * 33]); o.w = pk2(s[6 * 33], s[7 * 33]);
        __builtin_nontemporal_store(o, (v4u*)(WT + (size_t)(r0 + n) * dstK + k0 + 8 * c)); }
    LDS_WAIT(); asm volatile("" ::: "memory");
}
__device__ __forceinline__ void phase_prologue(const Frame& F, KP kp) {
    LAS float* scr = (LAS float*)(F.lds + F.wave * 16384);
    const int gw = F.bid * 8 + F.wave, NGW = F.G * 8;
    constexpr int I0 = 2 * 2048, I1 = 8 * 128, I2 = 2 * 2048, I3 = 4608, I4 = 512, I5 = 6144, I6 = 2048, I7 = 4 * 512, I8 = 4 * 256, I9 = 256 * 256, I10 = 256 * 128;
    constexpr int NITEMS = I0 + I1 + I2 + I3 + I4 + I5 + I6 + I7 + I8 + I9 + I10;
    unsigned char* ws = F.ws;
    for (int it = gw; it < NITEMS; it += NGW) {
        int r = it;
        if (r < I0) { const int b = r / 2048; tr_item(ain(kp, IN_PWIN) + (size_t)b * D * D, D, D, (bf16*)(ws + WS_W_POOL_IN) + (size_t)b * D * D, D, 0, scr, r % 2048, F.lane); continue; } r -= I0;
        if (r < I1) { const int b = r / 128; tr_item(ain(kp, IN_PWG) + (size_t)b * 512 * 512, 512, 512, (bf16*)(ws + WS_W_POOL_G) + (size_t)b * 512 * 512, 512, 0, scr, r % 128, F.lane); continue; } r -= I1;
        if (r < I2) { const int b = r / 2048; tr_item(ain(kp, IN_PWOUT) + (size_t)b * D * D, D, D, (bf16*)(ws + WS_W_POOL_OUT) + (size_t)b * D * D, D, 0, scr, r % 2048, F.lane); continue; } r -= I2;
        if (r < I3) { tr_item(ain(kp, IN_DQKV), D, QKVC, (bf16*)(ws + WS_W_DIL_QKV), D, 0, scr, r, F.lane); continue; } r -= I3;
        if (r < I4) { tr_item(ain(kp, IN_DOUT), DILW, D, (bf16*)(ws + WS_W_DIL_OUT), DILW, 0, scr, r, F.lane); continue; } r -= I4;
        if (r < I5) { tr_item(ain(kp, IN_CWIN), D, 3 * D, (bf16*)(ws + WS_W_CONV_IN), D, 1, scr, r, F.lane); continue; } r -= I5;
        if (r < I6) { tr_item(ain(kp, IN_CWOUT), D, D, (bf16*)(ws + WS_W_CONV_OUT), D, 0, scr, r, F.lane); continue; } r -= I6;
        if (r < I7) { const int b = r / 512; tr_item(ain(kp, IN_SGU) + (size_t)b * D * 512, D, 512, (bf16*)(ws + WS_W_SH_GU) + (size_t)b * 512 * D, D, 2, scr, r % 512, F.lane); continue; } r -= I7;
        if (r < I8) { const int b = r / 256; tr_item(ain(kp, IN_SD) + (size_t)b * SDIM * D, SDIM, D, (bf16*)(ws + WS_W_SH_D) + (size_t)b * D * SDIM, SDIM, 0, scr, r % 256, F.lane); continue; } r -= I8;
        if (r < I9) { const int b = r / 256; tr_item(ain(kp, IN_EGU) + (size_t)b * D * 256, D, 256, (bf16*)(ws + WS_W_EX_GU) + (size_t)b * 256 * D, D, 0, scr, r % 256, F.lane); continue; } r -= I9;
        { const int b = r / 128; tr_item(ain(kp, IN_ED) + (size_t)b * EDIM * D, EDIM, D, (bf16*)(ws + WS_W_EX_D) + (size_t)b * D * EDIM, EDIM, 0, scr, r % 128, F.lane); }
    }
    const size_t gt = (size_t)F.bid * 512 + F.tid, GT = (size_t)F.G * 512;
    { const float* rw = ain(kp, IN_RW); bf16* wh = (bf16*)(ws + WS_RWH); bf16* wl = (bf16*)(ws + WS_RWL);
      for (size_t i = gt; i < (size_t)DEPTH * NEXP * D / 8; i += GT) { const size_t k8 = i % (D / 8), e = (i / (D / 8)) % NEXP, l = i / ((size_t)NEXP * D / 8);
          float v[8]; unsigned hi[8], lo[8];
#pragma unroll
          for (int j = 0; j < 8; ++j) { v[j] = rw[(l * D + k8 * 8 + j) * NEXP + e]; hi[j] = f2bf(v[j]); lo[j] = f2bf(v[j] - __builtin_bit_cast(float, hi[j] << 16)); }
          v4u a, b2; a.x = hi[0] | (hi[1] << 16); a.y = hi[2] | (hi[3] << 16); a.z = hi[4] | (hi[5] << 16); a.w = hi[6] | (hi[7] << 16);
          b2.x = lo[0] | (lo[1] << 16); b2.y = lo[2] | (lo[3] << 16); b2.z = lo[4] | (lo[5] << 16); b2.w = lo[6] | (lo[7] << 16);
          *(v4u*)(wh + (l * NEXP + e) * D + k8 * 8) = a; *(v4u*)(wl + (l * NEXP + e) * D + k8 * 8) = b2; } }
    const float* x = ain(kp, IN_X); bf16* xb = (bf16*)(ws + WS_XB);
    for (size_t i = gt; i < (size_t)T * D / 8; i += GT) { const f32x4 p = __builtin_nontemporal_load((const f32x4*)(x + i * 8)), q = __builtin_nontemporal_load((const f32x4*)(x + i * 8 + 4));
        v4u w; w.x = pk2(p[0], p[1]); w.y = pk2(p[2], p[3]); w.z = pk2(q[0], q[1]); w.w = pk2(q[2], q[3]); *(v4u*)(xb + i * 8) = w; }
}

__device__ __forceinline__ void unpack8(const v4u w, float (&f)[8]) { f[0] = bflo(w.x); f[1] = bfhi(w.x); f[2] = bflo(w.y); f[3] = bfhi(w.y); f[4] = bflo(w.z); f[5] = bfhi(w.z); f[6] = bflo(w.w); f[7] = bfhi(w.w); }
__device__ __forceinline__ void phase_pool(const Frame& F, const bf16* U, bf16* PL) {
    for (int it = F.bid * 512 + F.tid; it < (T / 32) * 256; it += F.G * 512) {
        const int cv = it & 255, ch = it >> 8, col = cv * 8;
        const int w = __builtin_amdgcn_readfirstlane(2 << (col >> 9));
        const int row0 = __builtin_amdgcn_readfirstlane(ch * 32), pos0 = row0 & (SEQ - 1);
        float s[8], uu[8];
#pragma unroll
        for (int j = 0; j < 8; ++j) s[j] = 0.f;
        { v4u pre[15];
#pragma unroll
          for (int j = 0; j < 15; ++j) { pre[j] = (v4u){0u, 0u, 0u, 0u}; if (j + 1 < w && pos0 - (j + 1) >= 0) pre[j] = *(const v4u*)(U + (size_t)(row0 - (j + 1)) * D + col); }
#pragma unroll
          for (int j = 0; j < 15; ++j) asm volatile("" : "+v"(pre[j]));
#pragma unroll
          for (int j = 0; j < 15; ++j) { unpack8(pre[j], uu);
#pragma unroll
              for (int q = 0; q < 8; ++q) s[q] += uu[q]; } }
#pragma unroll 1
        for (int cb = 0; cb < 4; ++cb) {
            v4u un[8], uo[8];
#pragma unroll
            for (int j = 0; j < 8; ++j) { const int r = 8 * cb + j, t = row0 + r, pos = pos0 + r;
                un[j] = *(const v4u*)(U + (size_t)t * D + col);
                uo[j] = (v4u){0u, 0u, 0u, 0u}; if (pos - w + 1 >= 0) uo[j] = *(const v4u*)(U + (size_t)(t - w + 1) * D + col); }
#pragma unroll
            for (int j = 0; j < 8; ++j) asm volatile("" : "+v"(un[j]), "+v"(uo[j]));
#pragma unroll
            for (int j = 0; j < 8; ++j) { const int r = 8 * cb + j, t = row0 + r, pos = pos0 + r;
                unpack8(un[j], uu);
                const float inv = 1.0f / (float)((pos + 1) < w ? (pos + 1) : w);
                float o[8];
#pragma unroll
                for (int q = 0; q < 8; ++q) { s[q] += uu[q]; o[q] = s[q] * inv - uu[q]; }
                v4u ww; ww.x = pk2(o[0], o[1]); ww.y = pk2(o[2], o[3]); ww.z = pk2(o[4], o[5]); ww.w = pk2(o[6], o[7]);
                *(v4u*)(PL + (size_t)t * D + col) = ww;
                unpack8(uo[j], uu);
#pragma unroll
                for (int q = 0; q < 8; ++q) s[q] -= uu[q]; }
        }
    }
}

__device__ __forceinline__ void phase_conv(const Frame& F, const bf16* UC, const bf16* BGp, const float* cw, bf16* Z) {
    for (int it = F.bid * 512 + F.tid; it < (T / 4) * 256; it += F.G * 512) {
        const int cv = it & 255, col = cv * 8, t0 = __builtin_amdgcn_readfirstlane((it >> 8) * 4), pos0 = t0 & (SEQ - 1);
        v4u ur[6], br[4];
#pragma unroll
        for (int j = 0; j < 6; ++j) { ur[j] = (v4u){0u, 0u, 0u, 0u}; if (j >= 2 || pos0 > 0) ur[j] = *(const v4u*)(UC + (size_t)(t0 - 2 + j) * D + col); }
#pragma unroll
        for (int j = 0; j < 4; ++j) br[j] = *(const v4u*)(BGp + (size_t)(t0 + j) * D + col);
        const f32x4 c0a = *(const f32x4*)(cw + col), c0b = *(const f32x4*)(cw + col + 4), c1a = *(const f32x4*)(cw + D + col), c1b = *(const f32x4*)(cw + D + col + 4), c2a = *(const f32x4*)(cw + 2 * D + col), c2b = *(const f32x4*)(cw + 2 * D + col + 4);
        asm volatile("" : "+v"(ur[0]), "+v"(ur[1]), "+v"(ur[2]), "+v"(ur[3]), "+v"(ur[4]), "+v"(ur[5]), "+v"(br[0]), "+v"(br[1]), "+v"(br[2]), "+v"(br[3]));
        const float c0[8] = {c0a[0], c0a[1], c0a[2], c0a[3], c0b[0], c0b[1], c0b[2], c0b[3]}, c1[8] = {c1a[0], c1a[1], c1a[2], c1a[3], c1b[0], c1b[1], c1b[2], c1b[3]}, c2[8] = {c2a[0], c2a[1], c2a[2], c2a[3], c2b[0], c2b[1], c2b[2], c2b[3]};
#pragma unroll
        for (int j = 0; j < 4; ++j) { float u0[8], u1[8], u2[8], bb[8], o[8];
            unpack8(ur[j], u0); unpack8(ur[j + 1], u1); unpack8(ur[j + 2], u2); unpack8(br[j], bb);
#pragma unroll
            for (int q = 0; q < 8; ++q) o[q] = bb[q] * (c0[q] * u0[q] + c1[q] * u1[q] + c2[q] * u2[q]);
            v4u ww; ww.x = pk2(o[0], o[1]); ww.y = pk2(o[2], o[3]); ww.z = pk2(o[4], o[5]); ww.w = pk2(o[6], o[7]);
            *(v4u*)(Z + (size_t)(t0 + j) * D + col) = ww; }
    }
}

__device__ __forceinline__ int t5_bucket(int dist) {
    if (dist < 16) return dist;
    int large = 16 + (int)(logf((float)dist / 16.0f) / logf(128.0f) * 16.0f);
    return large < 31 ? large : 31;
}
constexpr int AT_KS = 0, AT_KSTR = 144, AT_VT = 256 * 144, AT_VSTR = 520, AT_BIAS = AT_VT + 64 * 520;
__device__ __forceinline__ void phase_attn(const Frame& F, const bf16* QKV, const float* relb, bf16* OG, float* LSE) {
    LAS unsigned char* lds = F.lds;
    const int tid = F.tid, lane = F.lane, w = tid >> 6, fr = lane & 15, fq = lane >> 4;
    for (int unit = F.bid; unit < NBATCH * 3 * 8 * 16; unit += F.G) {
        const int cmb = unit & 15, h = (unit >> 4) & 7, g = (unit >> 7) % 3, b = unit / 384;
        const int dsh = 2 * g, dil = 1 << dsh, r = cmb & (dil - 1), nb = cmb >> dsh;
        const bf16* base = QKV + (size_t)b * SEQ * QKVC + g * 1536 + h * 64;
        __syncthreads();
        {
            const int key = tid >> 1, half = tid & 1, jk = (nb - 1) * 128 + key;
            v4u kv[4], vv[4];
            if (jk >= 0) { const bf16* rp = base + (size_t)(jk * dil + r) * QKVC + half * 32;
#pragma unroll
                for (int i = 0; i < 4; ++i) { kv[i] = *(const v4u*)(rp + 512 + 8 * i); vv[i] = *(const v4u*)(rp + 1024 + 8 * i); } }
            else {
#pragma unroll
                for (int i = 0; i < 4; ++i) { kv[i] = (v4u){0u, 0u, 0u, 0u}; vv[i] = (v4u){0u, 0u, 0u, 0u}; } }
#pragma unroll
            for (int i = 0; i < 4; ++i) *(LAS v4u*)(lds + AT_KS + key * AT_KSTR + half * 64 + 16 * i) = kv[i];
#pragma unroll
            for (int i = 0; i < 4; ++i) {
                const unsigned ww[4] = {vv[i].x, vv[i].y, vv[i].z, vv[i].w};
#pragma unroll
                for (int q = 0; q < 4; ++q) { const int d = half * 32 + 8 * i + 2 * q;
                    *(LAS unsigned short*)(lds + AT_VT + d * AT_VSTR + key * 2) = (unsigned short)(ww[q] & 0xffffu);
                    *(LAS unsigned short*)(lds + AT_VT + (d + 1) * AT_VSTR + key * 2) = (unsigned short)(ww[q] >> 16); } }
            if (tid <= 128) ((LAS float*)(lds + AT_BIAS))[tid] = relb[t5_bucket(tid * dil) * 24 + g * 8 + h];
        }
        __syncthreads();
        int qi = 16 * w + fr; asm volatile("" : "+v"(qi));
        const int jq = nb * 128 + qi, tq = jq * dil + r;
        const bf16* qp = base + (size_t)tq * QKVC + 8 * fq;
        const bf16x8 q0 = *(const bf16x8*)qp, q1 = *(const bf16x8*)(qp + 32);
        f32x4 s[9]; float mx = -INFINITY;
#pragma unroll
        for (int kt = 0; kt < 9; ++kt) {
            const int kb = 16 * (w + kt);
            const bf16x8 k0 = *(const LAS bf16x8*)(lds + AT_KS + (kb + fr) * AT_KSTR + fq * 16), k1 = *(const LAS bf16x8*)(lds + AT_KS + (kb + fr) * AT_KSTR + 64 + fq * 16);
            f32x4 a = (f32x4){0.f, 0.f, 0.f, 0.f};
            a = __builtin_amdgcn_mfma_f32_16x16x32_bf16(k0, q0, a, 0, 0, 0);
            a = __builtin_amdgcn_mfma_f32_16x16x32_bf16(k1, q1, a, 0, 0, 0);
#pragma unroll
            for (int i = 0; i < 4; ++i) { const int kl = kb + 4 * fq + i, rel = qi + 128 - kl;
                const bool ok = (rel >= 0) && (rel <= 128) && (nb > 0 || kl >= 128);
                const int rc = rel < 0 ? 0 : (rel > 128 ? 128 : rel);
                float bv_ = ((LAS float*)(lds + AT_BIAS))[rc]; asm volatile("" : "+v"(bv_));
                const float v = ok ? a[i] + bv_ : -INFINITY;
                a[i] = v; mx = fmaxf(mx, v); }
            s[kt] = a;
        }
        mx = max_fq(mx);
        float l = 0.f;
#pragma unroll
        for (int kt = 0; kt < 9; ++kt)
#pragma unroll
            for (int i = 0; i < 4; ++i) { const float p = __expf(s[kt][i] - mx); s[kt][i] = p; l += p; }
        l = sum_fq(l);
        f32x4 o[4];
#pragma unroll
        for (int nt = 0; nt < 4; ++nt) o[nt] = (f32x4){0.f, 0.f, 0.f, 0.f};
#pragma unroll
        for (int st = 0; st < 5; ++st) {
            const int kt0 = 2 * st, kt1 = 2 * st + 1;
            v4u pw; pw.x = pk2(s[kt0][0], s[kt0][1]); pw.y = pk2(s[kt0][2], s[kt0][3]);
            if (kt1 < 9) { pw.z = pk2(s[kt1 < 9 ? kt1 : 0][0], s[kt1 < 9 ? kt1 : 0][1]); pw.w = pk2(s[kt1 < 9 ? kt1 : 0][2], s[kt1 < 9 ? kt1 : 0][3]); } else { pw.z = 0u; pw.w = 0u; }
            const bf16x8 pf = __builtin_bit_cast(bf16x8, pw);
            const int kb0 = 16 * (w + kt0) + 4 * fq, kb1 = 16 * (w + kt1) + 4 * fq;
#pragma unroll
            for (int nt = 0; nt < 4; ++nt) { const int d = 16 * nt + fr;
                v2u va = *(const LAS v2u*)(lds + AT_VT + d * AT_VSTR + kb0 * 2), vb = (v2u){0u, 0u};
                if (kt1 < 9) vb = *(const LAS v2u*)(lds + AT_VT + d * AT_VSTR + kb1 * 2);
                v4u vw; vw.x = va.x; vw.y = va.y; vw.z = vb.x; vw.w = vb.y;
                o[nt] = __builtin_amdgcn_mfma_f32_16x16x32_bf16(__builtin_bit_cast(bf16x8, vw), pf, o[nt], 0, 0, 0); }
        }
        const float il = 1.0f / l;
        bf16* op = OG + ((size_t)g * T + (size_t)b * SEQ + tq) * DILW + h * 64 + 4 * fq;
#pragma unroll
        for (int nt = 0; nt < 4; ++nt) { v2u ww; ww.x = pk2(o[nt][0] * il, o[nt][1] * il); ww.y = pk2(o[nt][2] * il, o[nt][3] * il); *(v2u*)(op + 16 * nt) = ww; }
        if (fq == 0) LSE[((size_t)g * T + (size_t)b * SEQ + tq) * 8 + h] = mx + logf(l);
    }
}
__device__ __forceinline__ void phase_combine(const Frame& F, const bf16* OG, const float* LSE, bf16* O) {
    for (int it0 = F.bid * 512 + F.tid; it0 < T * 64; it0 += 4 * F.G * 512) {
        float ls[4][3]; v4u og[4][3];
#pragma unroll
        for (int u = 0; u < 4; ++u) { int it = it0 + u * F.G * 512; it = it < T * 64 ? it : it0;
            const int c8 = it & 7, h = (it >> 3) & 7, t = it >> 6; const size_t off = (size_t)t * DILW + h * 64 + c8 * 8;
#pragma unroll
            for (int g = 0; g < 3; ++g) { ls[u][g] = LSE[((size_t)g * T + t) * 8 + h]; og[u][g] = *(const v4u*)(OG + (size_t)g * T * DILW + off); } }
#pragma unroll
        for (int u = 0; u < 4; ++u) asm volatile("" : "+v"(ls[u][0]), "+v"(ls[u][1]), "+v"(ls[u][2]), "+v"(og[u][0]), "+v"(og[u][1]), "+v"(og[u][2]));
#pragma unroll
        for (int u = 0; u < 4; ++u) { const int it = it0 + u * F.G * 512, c8 = it & 7, h = (it >> 3) & 7, t = it >> 6; const size_t off = (size_t)t * DILW + h * 64 + c8 * 8;
            if (it >= T * 64) continue;
            const float l0 = ls[u][0], l1 = ls[u][1], l2 = ls[u][2];
            const float m = fmaxf(l0, fmaxf(l1, l2)); float w0 = __expf(l0 - m), w1 = __expf(l1 - m), w2 = __expf(l2 - m); const float inv = 1.0f / (w0 + w1 + w2); w0 *= inv; w1 *= inv; w2 *= inv;
            float a[8], bq[8], c[8], o[8];
            unpack8(og[u][0], a); unpack8(og[u][1], bq); unpack8(og[u][2], c);
#pragma unroll
            for (int q = 0; q < 8; ++q) o[q] = w0 * a[q] + w1 * bq[q] + w2 * c[q];
            v4u ww; ww.x = pk2(o[0], o[1]); ww.y = pk2(o[2], o[3]); ww.z = pk2(o[4], o[5]); ww.w = pk2(o[6], o[7]);
            *(v4u*)(O + off) = ww; }
    }
}

constexpr int M1_LOG = 131072, M1_STAT = M1_LOG + 4096, M1_HIST = M1_STAT + 128, M1_BASE = M1_HIST + 256;
__device__ __forceinline__ void phase_moe1(const Frame& F, const float* Y, const float* gain, const float* bias, const float* RW, const float* RB,
                                           float* X1F, bf16* X1B, unsigned* cnt, int* ltok, float* lgate, int* eidx, int* inv) {
    LAS float* xs = (LAS float*)F.lds; LAS float* logit = (LAS float*)(F.lds + M1_LOG); LAS float* stat = (LAS float*)(F.lds + M1_STAT);
    LAS int* hist = (LAS int*)(F.lds + M1_HIST); LAS int* basep = (LAS int*)(F.lds + M1_BASE);
    const int tid = F.tid, lane = F.lane, w = F.wave;
    for (int rg = F.bid; rg < T / 16; rg += F.G) {
        const int row0 = rg * 16;
        __syncthreads();
#pragma unroll
        for (int j = 0; j < 16; ++j) { const int idx = tid + 512 * j; *(LAS f32x4*)(xs + idx * 4) = *(const f32x4*)(Y + (size_t)row0 * D + (size_t)idx * 4); }
        if (tid < 64) hist[tid] = 0;
        __syncthreads();
#pragma unroll
        for (int rr = 0; rr < 2; ++rr) { const int r = 2 * w + rr; float sm = 0.f;
#pragma unroll
            for (int j = 0; j < 32; ++j) sm += xs[r * D + lane + 64 * j];
            const float mean = wave_sum(sm, lane) * (1.0f / D); float sq = 0.f;
#pragma unroll
            for (int j = 0; j < 32; ++j) { const float d = xs[r * D + lane + 64 * j] - mean; sq += d * d; }
            const float rstd = 1.0f / sqrtf(wave_sum(sq, lane) * (1.0f / D) + LN_EPS);
            if (lane == 0) { stat[2 * r] = mean; stat[2 * r + 1] = rstd; } }
        __syncthreads();
#pragma unroll
        for (int j = 0; j < 16; ++j) { const int idx = tid + 512 * j, r = idx >> 9, c4 = (idx & 511) * 4;
            const f32x4 v = *(LAS f32x4*)(xs + idx * 4), gv = *(const f32x4*)(gain + c4), bv = *(const f32x4*)(bias + c4);
            const float mean = stat[2 * r], rstd = stat[2 * r + 1];
            const f32x4 o = (v - mean) * rstd * gv + bv;
            *(LAS f32x4*)(xs + idx * 4) = o;
            *(f32x4*)(X1F + (size_t)(row0 + r) * D + c4) = o;
            v2u wb; wb.x = pk2(o[0], o[1]); wb.y = pk2(o[2], o[3]); *(v2u*)(X1B + (size_t)(row0 + r) * D + c4) = wb; }
        __syncthreads();
        { const int r = tid >> 5, ep = tid & 31; float a0 = 0.f, a1 = 0.f; const float* wp = RW + 2 * ep; const LAS float* xr = xs + r * D;
            for (int k0 = 0; k0 < D; k0 += 16) {
                f32x2 wv[16];
#pragma unroll
                for (int j = 0; j < 16; ++j) wv[j] = *(const f32x2*)(wp + (size_t)(k0 + j) * NEXP);
                asm volatile("" : "+v"(wv[0]), "+v"(wv[1]), "+v"(wv[2]), "+v"(wv[3]), "+v"(wv[4]), "+v"(wv[5]), "+v"(wv[6]), "+v"(wv[7]));
                asm volatile("" : "+v"(wv[8]), "+v"(wv[9]), "+v"(wv[10]), "+v"(wv[11]), "+v"(wv[12]), "+v"(wv[13]), "+v"(wv[14]), "+v"(wv[15]));
#pragma unroll
                for (int j = 0; j < 16; ++j) { const float xv = xr[k0 + j]; a0 += xv * wv[j].x; a1 += xv * wv[j].y; } }
            logit[r * NEXP + 2 * ep] = a0; logit[r * NEXP + 2 * ep + 1] = a1; }
        __syncthreads();
        int sel_pos[2]; float sel_gate[2]; int sel_rank[2]; bool sel_on[2];
#pragma unroll
        for (int rr = 0; rr < 2; ++rr) { const int r = 2 * w + rr;
            const float sc = 1.0f / (1.0f + __expf(-logit[r * NEXP + lane])); const float ch = sc + RB[lane];
            int rk = 0;
#pragma unroll
            for (int j = 0; j < 8; ++j) { const float cj = shfl_from(ch, (lane & ~7) + j); rk += (cj > ch || (cj == ch && j < (lane & 7))) ? 1 : 0; }
            float gs = rk < 2 ? ch : 0.f; gs += shfl_x(gs, 1, lane); gs += shfl_x(gs, 2, lane); gs += shfl_x(gs, 4, lane);
            int grk = 0; const int g = lane >> 3;
#pragma unroll
            for (int hh = 0; hh < 8; ++hh) { const float gh = shfl_from(gs, 8 * hh); grk += (gh > gs || (gh == gs && hh < g)) ? 1 : 0; }
            const float msk = grk < 4 ? ch : -INFINITY;
            int erk = 0;
            for (int j = 0; j < 64; ++j) { const float mj = __builtin_bit_cast(float, __builtin_amdgcn_readlane(__builtin_bit_cast(int, msk), j)); erk += (mj > msk || (mj == msk && j < lane)) ? 1 : 0; }
            const bool on = erk < 8;
            const float ssum = wave_sum(on ? sc : 0.f, lane);
            sel_on[rr] = on; sel_rank[rr] = erk; sel_gate[rr] = sc / ssum * 2.5f; sel_pos[rr] = 0;
            if (on) sel_pos[rr] = __hip_atomic_fetch_add(&hist[lane], 1, __ATOMIC_RELAXED, __HIP_MEMORY_SCOPE_WORKGROUP); }
        __syncthreads();
        if (tid < 64) { const int hc = hist[tid]; int bs = 0; if (hc > 0) bs = (int)atomicAdd(&cnt[tid * 16], (unsigned)hc); basep[tid] = bs; }
        __syncthreads();
#pragma unroll
        for (int rr = 0; rr < 2; ++rr) if (sel_on[rr]) { const int t = row0 + 2 * w + rr, pos = basep[lane] + sel_pos[rr];
            ltok[(size_t)lane * CAP + pos] = t; lgate[(size_t)lane * CAP + pos] = sel_gate[rr];
            eidx[t * 8 + sel_rank[rr]] = lane; inv[t * 8 + sel_rank[rr]] = pos; }
    }
}
__device__ __forceinline__ int build_tiles(const Frame& F, const unsigned* cnt) {
    LAS int* tpref = (LAS int*)(F.lds + LDS_TAB); LAS int* cl = (LAS int*)(F.lds + LDS_TAB + 512);
    __syncthreads();
    if (F.tid < 64) {
        const int lane = F.lane; const int c = (int)__hip_atomic_load(&cnt[lane * 16], __ATOMIC_RELAXED, __HIP_MEMORY_SCOPE_AGENT);
        const int tl = (c + 255) >> 8; int inc = tl;
#pragma unroll
        for (int o = 1; o < 64; o <<= 1) { const int v = __builtin_amdgcn_ds_bpermute((lane >= o ? lane - o : lane) << 2, inc); inc += lane >= o ? v : 0; }
        cl[lane] = c; tpref[lane] = inc - tl;
        if (lane == 63) { tpref[64] = inc; tpref[65] = inc + T / 256; tpref[66] = inc + 2 * (T / 256); cl[64] = T; cl[65] = T; } }
    __syncthreads();
    return __builtin_amdgcn_readfirstlane(tpref[64]);
}
__device__ __forceinline__ void phase_moe4(const Frame& F, const float* Y2, const bf16* Yr, const int* eidx, const int* inv, const float* gain, const float* bias, float* XO, bf16* XBo) {
    const LAS int* tpref = (const LAS int*)(F.lds + LDS_TAB);
    const int gw = F.bid * 8 + F.wave, NGW = F.G * 8, lane = F.lane;
    for (int t = gw; t < T; t += NGW) {
        f32x4 v[8];
#pragma unroll
        for (int j = 0; j < 8; ++j) v[j] = *(const f32x4*)(Y2 + (size_t)t * D + 4 * lane + 256 * j);
        for (int k = 0; k < 8; ++k) { const int e = eidx[t * 8 + k], pos = inv[t * 8 + k]; const bf16* yr = Yr + (size_t)(tpref[e] * 256 + pos) * D + 4 * lane;
#pragma unroll
            for (int j = 0; j < 8; ++j) { const v2u w = *(const v2u*)(yr + 256 * j); v[j][0] += bflo(w.x); v[j][1] += bfhi(w.x); v[j][2] += bflo(w.y); v[j][3] += bfhi(w.y); } }
        float sm = 0.f;
#pragma unroll
        for (int j = 0; j < 8; ++j) sm += (v[j][0] + v[j][1]) + (v[j][2] + v[j][3]);
        const float mean = wave_sum(sm, lane) * (1.0f / D); float sq = 0.f;
#pragma unroll
        for (int j = 0; j < 8; ++j) { v[j] = v[j] - mean; sq += (v[j][0] * v[j][0] + v[j][1] * v[j][1]) + (v[j][2] * v[j][2] + v[j][3] * v[j][3]); }
        const float rstd = 1.0f / sqrtf(wave_sum(sq, lane) * (1.0f / D) + LN_EPS);
#pragma unroll
        for (int j = 0; j < 8; ++j) { const int c = 4 * lane + 256 * j; const f32x4 o = v[j] * rstd * *(const f32x4*)(gain + c) + *(const f32x4*)(bias + c);
            *(f32x4*)(XO + (size_t)t * D + c) = o;
            v2u wb; wb.x = pk2(o[0], o[1]); wb.y = pk2(o[2], o[3]); *(v2u*)(XBo + (size_t)t * D + c) = wb; }
    }
}


template <int CTRL> __device__ __forceinline__ float dppf(float x) { return __builtin_bit_cast(float, __builtin_amdgcn_update_dpp(0, __builtin_bit_cast(int, x), CTRL, 0xF, 0xF, false)); }
__device__ __forceinline__ float gmax8(float x) { x = fmaxf(x, dppf<0xB1>(x)); x = fmaxf(x, dppf<0x4E>(x)); x = fmaxf(x, dppf<0x141>(x)); return x; }
__device__ __forceinline__ float gsum8(float x) { x += dppf<0xB1>(x); x += dppf<0x4E>(x); x += dppf<0x141>(x); return x; }
__device__ __forceinline__ float rl_f(float x, int l) { return __builtin_bit_cast(float, __builtin_amdgcn_readlane(__builtin_bit_cast(int, x), l)); }
constexpr int M1_P = 0, M1N_HIST = 131072, M1N_BASE = 131072 + 256, M1N_GB = 131072 + 1024;
__device__ __forceinline__ void phase_moe1n(const Frame& F, const bf16* Y, const float* pst, const float* gain, const float* bias, const bf16* WH, const bf16* WL, const float* RB,
                                            bf16* X1B, float* ST1, unsigned* cnt, int* ltok, float* lgate, int* eidx, int* inv) {
    LAS float* P = (LAS float*)(F.lds + M1_P); LAS int* hist = (LAS int*)(F.lds + M1N_HIST); LAS int* basep = (LAS int*)(F.lds + M1N_BASE);
    const int tid = F.tid, lane = F.lane, w = F.wave, r = lane & 15, q = lane >> 4;
    for (int item = F.bid; item < T / 64; item += F.G) {
        const int row0 = item * 64;
        __syncthreads();
        { int t0 = tid; asm volatile("" : "+v"(t0));
          if (t0 < 64) hist[t0] = 0;
          LAS f32x4* gb = (LAS f32x4*)(F.lds + M1N_GB); gb[t0] = *(const f32x4*)(gain + 4 * t0); gb[512 + t0] = *(const f32x4*)(bias + 4 * t0); }
        __syncthreads();
        float mean[4], rstd[4];
#pragma unroll
        for (int rt = 0; rt < 4; ++rt) { const int row = row0 + 16 * rt + r;
          const f32x4* pp = (const f32x4*)(pst + ((size_t)row * 32 + q * 8) * 2); const f32x4 a = pp[0], b = pp[1], c = pp[2], d = pp[3];
          float sm = (a[0] + a[2]) + (b[0] + b[2]) + (c[0] + c[2]) + (d[0] + d[2]), sq = (a[1] + a[3]) + (b[1] + b[3]) + (c[1] + c[3]) + (d[1] + d[3]);
          sm = sum_fq(sm); sq = sum_fq(sq);
          mean[rt] = sm * (1.0f / D); const float var = fmaxf(sq * (1.0f / D) - mean[rt] * mean[rt], 0.f); rstd[rt] = 1.0f / sqrtf(var + LN_EPS);
          if (w == 0 && q == 0) *(f32x2*)(ST1 + 2 * row) = (f32x2){mean[rt], rstd[rt]}; }
        const int kb = 256 * w + 8 * q;
        const LAS float* gl = (const LAS float*)(F.lds + M1N_GB) + kb;
        f32x4 acc[4][4];
#pragma unroll
        for (int rt = 0; rt < 4; ++rt)
#pragma unroll
            for (int nt = 0; nt < 4; ++nt) acc[rt][nt] = (f32x4){0.f, 0.f, 0.f, 0.f};
        v4u yb[2][2][4], hb[4]; bf16x8 wh[4], wl[4];
        unsigned vo[4];
#pragma unroll
        for (int i = 0; i < 4; ++i) { vo[i] = (unsigned)(r * D + kb) * 2u + (unsigned)i * (16u * D * 2u); asm volatile("" : "+v"(vo[i])); }
        const char* ybase = (const char*)(Y + (size_t)row0 * D); char* xbase = (char*)(X1B + (size_t)row0 * D);
#define M1_LOADY(ms) do { _Pragma("unroll") for (int hf = 0; hf < 2; ++hf) _Pragma("unroll") for (int rt = 0; rt < 4; ++rt) yb[(ms) & 1][hf][rt] = *(const v4u*)(ybase + vo[rt] + 128 * (ms) + 64 * hf); } while (0)
#define M1_LOADW(st) do { _Pragma("unroll") for (int nt = 0; nt < 4; ++nt) { wh[nt] = *(const bf16x8*)((const char*)WH + vo[nt] + 64 * (st)); wl[nt] = *(const bf16x8*)((const char*)WL + vo[nt] + 64 * (st)); } } while (0)
        M1_LOADY(0); M1_LOADW(0); M1_LOADY(1);
        __builtin_amdgcn_sched_barrier(0);
#pragma unroll
        for (int st = 0; st < 8; ++st) {
            const f32x4 g0 = *(const LAS f32x4*)(gl + 32 * st), g1 = *(const LAS f32x4*)(gl + 32 * st + 4), b0 = *(const LAS f32x4*)(gl + 2048 + 32 * st), b1 = *(const LAS f32x4*)(gl + 2048 + 32 * st + 4);
#pragma unroll
            for (int rt = 0; rt < 4; ++rt) { const v4u yv = yb[(st >> 1) & 1][st & 1][rt];
                const f32x4 y0_ = (f32x4){bflo(yv.x), bfhi(yv.x), bflo(yv.y), bfhi(yv.y)}, y1_ = (f32x4){bflo(yv.z), bfhi(yv.z), bflo(yv.w), bfhi(yv.w)};
                const f32x4 x0 = (y0_ - mean[rt]) * rstd[rt] * g0 + b0, x1 = (y1_ - mean[rt]) * rstd[rt] * g1 + b1;
                v4u h; h.x = cvt_pk_bf16(x0[0], x0[1]); h.y = cvt_pk_bf16(x0[2], x0[3]); h.z = cvt_pk_bf16(x1[0], x1[1]); h.w = cvt_pk_bf16(x1[2], x1[3]);
                if ((st & 1) == 0) hb[rt] = h; else { *(v4u*)(xbase + vo[rt] + 64 * (st - 1)) = hb[rt]; *(v4u*)(xbase + vo[rt] + 64 * st) = h; }
                v4u l; l.x = cvt_pk_bf16(x0[0] - bflo(h.x), x0[1] - bfhi(h.x)); l.y = cvt_pk_bf16(x0[2] - bflo(h.y), x0[3] - bfhi(h.y));
                l.z = cvt_pk_bf16(x1[0] - bflo(h.z), x1[1] - bfhi(h.z)); l.w = cvt_pk_bf16(x1[2] - bflo(h.w), x1[3] - bfhi(h.w));
                const bf16x8 xh = __builtin_bit_cast(bf16x8, h), xl = __builtin_bit_cast(bf16x8, l);
#pragma unroll
                for (int nt = 0; nt < 4; ++nt) { acc[rt][nt] = __builtin_amdgcn_mfma_f32_16x16x32_bf16(xh, wh[nt], acc[rt][nt], 0, 0, 0);
                    acc[rt][nt] = __builtin_amdgcn_mfma_f32_16x16x32_bf16(xl, wh[nt], acc[rt][nt], 0, 0, 0); acc[rt][nt] = __builtin_amdgcn_mfma_f32_16x16x32_bf16(xh, wl[nt], acc[rt][nt], 0, 0, 0); } }
            __builtin_amdgcn_sched_barrier(0);
            if (st + 1 < 8) M1_LOADW(st + 1);
            if ((st & 1) == 1 && (st >> 1) + 2 < 4) M1_LOADY((st >> 1) + 2);
            __builtin_amdgcn_sched_barrier(0);
        }
#undef M1_LOADY
#undef M1_LOADW
#pragma unroll
        for (int rt = 0; rt < 4; ++rt)
#pragma unroll
            for (int nt = 0; nt < 4; ++nt)
#pragma unroll
                for (int i = 0; i < 4; ++i) P[(w * 64 + 16 * rt + 4 * q + i) * 64 + 16 * nt + r] = acc[rt][nt][i];
        __syncthreads();
        const float rb = RB[lane];
        LAS int* Pi = (LAS int*)P;
#pragma unroll 1
        for (int rr = 0; rr < 8; ++rr) { const int rl = 8 * w + rr;
            float lg = ((P[rl * 64 + lane] + P[(64 + rl) * 64 + lane]) + (P[(128 + rl) * 64 + lane] + P[(192 + rl) * 64 + lane])) + ((P[(256 + rl) * 64 + lane] + P[(320 + rl) * 64 + lane]) + (P[(384 + rl) * 64 + lane] + P[(448 + rl) * 64 + lane]));
            lg = (lg == lg) ? lg : -1.0e30f;
            const float sc = 1.0f / (1.0f + __expf(-lg)); const float ch = sc + rb;
            const float m1 = gmax8(ch), neq = gsum8(ch == m1 ? 1.f : 0.f), m2c = gmax8(ch < m1 ? ch : -INFINITY);
            const float gs = m1 + (neq >= 2.f ? m1 : m2c);
            int grk = 0; const int g = lane >> 3;
#pragma unroll
            for (int hh = 0; hh < 8; ++hh) { const float gh = rl_f(gs, 8 * hh); grk += (gh > gs || (gh == gs && hh < g)) ? 1 : 0; }
            const float msk = grk < 4 ? ch : -INFINITY;
            float cur = msk, ssum = 0.f; int erk = 64;
#pragma unroll 1
            for (int k = 0; k < 8; ++k) {
                float rm = gmax8(cur); rm = fmaxf(rm, dppf<0x140>(rm));
                const float wm = fmaxf(fmaxf(rl_f(rm, 0), rl_f(rm, 16)), fmaxf(rl_f(rm, 32), rl_f(rm, 48)));
                const unsigned long long bal = __builtin_amdgcn_ballot_w64(cur == wm);
                const int lsel = __builtin_amdgcn_readfirstlane((int)__builtin_ctzll(bal));
                ssum += rl_f(sc, lsel);
                const bool me = lane == lsel; erk = me ? k : erk; cur = me ? -INFINITY : cur; }
            const bool on = erk < 8;
            int pk_ = -1; if (on) pk_ = __hip_atomic_fetch_add(&hist[lane], 1, __ATOMIC_RELAXED, __HIP_MEMORY_SCOPE_WORKGROUP) | (erk << 16);
            P[rl * 64 + lane] = sc / ssum * 2.5f; Pi[(64 + rl) * 64 + lane] = pk_; }
        __syncthreads();
        if (tid < 64) { int tt = tid; asm volatile("" : "+v"(tt));
            const int hc = hist[tt]; int bs = 0; if (hc > 0) bs = (int)atomicAdd(&cnt[tt * 16], (unsigned)hc); basep[tt] = bs; }
        __syncthreads();
        { const int bl = basep[lane];
#pragma unroll 1
          for (int rr = 0; rr < 8; ++rr) { const int rl = 8 * w + rr; const int pk_ = Pi[(64 + rl) * 64 + lane]; const float gt_ = P[rl * 64 + lane];
            if (pk_ >= 0) { const int t = row0 + rl, pos = bl + (pk_ & 0xffff), rk_ = pk_ >> 16;
                ltok[(size_t)lane * CAP + pos] = t * 8 + rk_; lgate[(size_t)lane * CAP + pos] = gt_;
                eidx[t * 8 + rk_] = lane; inv[t * 8 + rk_] = pos; } } }
    }
}

constexpr int M3_PL = 131072, M3_CNT = 147456, M3_OFF = 147456 + 272;
__device__ __forceinline__ void phase_moe3n(const Frame& F, const bf16* H, const bf16* HSp, const int* eidx, const bf16* WD, const bf16* WSD,
                                            const float* Y1, const float* ST1, const float* g1, const float* b1, float* Y2, float* PST2) {
    LAS int* out = (LAS int*)F.lds; LAS unsigned short* plist = (LAS unsigned short*)(F.lds + M3_PL); LAS int* cnt = (LAS int*)(F.lds + M3_CNT); LAS int* off = (LAS int*)(F.lds + M3_OFF);
    const int tid = F.tid, lane = F.lane, w = F.wave, r = lane & 15, q = lane >> 4;
    for (int u = F.bid; u < 1024; u += F.G) {
        int nc = (u & 7) | ((u >> 7) << 3), tb = (u >> 3) & 15;
        if (F.G == 256) { const int i = u >> 8, x = u & 7, j = (u >> 3) & 31; tb = 2 * x + (i >> 1); nc = 32 * (i & 1) + j; }
        __syncthreads();
#pragma unroll
        for (int j = 0; j < 16; ++j) ((LAS v4u*)out)[tid + 512 * j] = (v4u){0u, 0u, 0u, 0u};
        if (tid < 66) cnt[tid] = 0;
        __syncthreads();
        int ee[16], pp[16];
        { const v4u* ep = (const v4u*)(eidx + ((size_t)tb * 1024 + 2 * tid) * 8); const v4u e0 = ep[0], e1 = ep[1], e2 = ep[2], e3 = ep[3];
          ee[0] = e0.x; ee[1] = e0.y; ee[2] = e0.z; ee[3] = e0.w; ee[4] = e1.x; ee[5] = e1.y; ee[6] = e1.z; ee[7] = e1.w;
          ee[8] = e2.x; ee[9] = e2.y; ee[10] = e2.z; ee[11] = e2.w; ee[12] = e3.x; ee[13] = e3.y; ee[14] = e3.z; ee[15] = e3.w; }
#pragma unroll
        for (int j = 0; j < 16; ++j) pp[j] = __hip_atomic_fetch_add(&cnt[ee[j]], 1, __ATOMIC_RELAXED, __HIP_MEMORY_SCOPE_WORKGROUP);
        __syncthreads();
        if (w == 0) { int c = cnt[lane], x = c;
#pragma unroll
            for (int o = 1; o < 64; o <<= 1) { const int y = __builtin_amdgcn_ds_bpermute(((lane - o) & 63) << 2, x); if (lane >= o) x += y; }
            off[lane] = x - c; if (lane == 63) off[64] = x; }
        __syncthreads();
#pragma unroll
        for (int j = 0; j < 16; ++j) plist[off[ee[j]] + pp[j]] = (unsigned short)(tid * 16 + j);
        __syncthreads();
        const char* Hb = (const char*)H + (size_t)tb * 8192 * 256 + q * 16;
        const char* HSb = (const char*)HSp + (size_t)tb * 1024 * 512 + q * 16;
        const char* Bb = (const char*)WD + ((size_t)nc * 32 + r) * 256 + q * 16;
        const char* BSb = (const char*)WSD + ((size_t)nc * 32 + r) * 512 + q * 16;
#define M3_NR(sg) ((sg) < 8 ? __builtin_amdgcn_readfirstlane(cnt[w + 8 * (sg)]) : 128)
#define M3_RB(sg) ((sg) < 8 ? __builtin_amdgcn_readfirstlane(off[w + 8 * (sg)]) : 0)
#define M3_GLD(dst, ptr, OFF) asm volatile("global_load_dwordx4 %0, %1, off offset:" #OFF : "=&v"(dst) : "v"(ptr) : "memory")
#define M3_LOADB(dst, sg) do { const char* _b0 = (sg) < 8 ? Bb + (size_t)(w + 8 * (sg)) * 524288 : BSb + ((sg) - 8) * 256; const char* _b1 = _b0 + ((sg) < 8 ? 4096 : 8192); \
            M3_GLD(dst[0][0], _b0, 0); M3_GLD(dst[0][1], _b0, 64); M3_GLD(dst[0][2], _b0, 128); M3_GLD(dst[0][3], _b0, 192); \
            M3_GLD(dst[1][0], _b1, 0); M3_GLD(dst[1][1], _b1, 64); M3_GLD(dst[1][2], _b1, 128); M3_GLD(dst[1][3], _b1, 192); } while (0)
#define M3_LOADA(dst, sg, bb, nr, rbs) do { int _i = 16 * (bb) + r; _i = _i < (nr) ? _i : (nr) - 1; const unsigned _rid = plist[(rbs) + _i]; \
            const char* _a = (sg) < 8 ? Hb + (size_t)_rid * 256 : ((sg) < 10 ? HSb + (size_t)(128 * w + _i) * 512 + ((sg) - 8) * 256 : Hb); \
            M3_GLD(dst[0], _a, 0); M3_GLD(dst[1], _a, 64); M3_GLD(dst[2], _a, 128); M3_GLD(dst[3], _a, 192); } while (0)
#define M3_ADV(sg, bb, nr, rbs) do { if ((sg) < 10) { ++(bb); if ((bb) * 16 >= (nr)) { (bb) = 0; do { ++(sg); } while ((sg) < 8 && M3_NR(sg) == 0); if ((sg) < 10) { (nr) = M3_NR(sg); (rbs) = M3_RB(sg); } } } } while (0)
#define M3_WAITA(AS) asm volatile("s_waitcnt vmcnt(12)" : "+v"(AS[0]), "+v"(AS[1]), "+v"(AS[2]), "+v"(AS[3]) :: "memory")
#define M3_WAITB(N) asm volatile("s_waitcnt vmcnt(" #N ")" : "+v"(Bn[0][0]), "+v"(Bn[0][1]), "+v"(Bn[0][2]), "+v"(Bn[0][3]), "+v"(Bn[1][0]), "+v"(Bn[1][1]), "+v"(Bn[1][2]), "+v"(Bn[1][3]) :: "memory")
#define M3_STEP(AS) if (cseg < 10) { \
              \
            int tk[4]; bool ok[4]; unsigned pl[4]; const int rt_ = cseg < 8; \
            _Pragma("unroll") for (int i = 0; i < 4; ++i) { const int idx = 16 * cbt + 4 * q + i; ok[i] = idx < cnr; const int ic = ok[i] ? idx : cnr - 1; pl[i] = plist[crbs + ic]; tk[i] = 128 * w + ic; } \
            _Pragma("unroll") for (int i = 0; i < 4; ++i) tk[i] = rt_ ? (int)(pl[i] >> 3) : tk[i]; \
            M3_WAITA(AS); \
            f32x4 acc[2]; \
            _Pragma("unroll") for (int nt = 0; nt < 2; ++nt) { acc[nt] = (f32x4){0.f, 0.f, 0.f, 0.f}; \
                _Pragma("unroll") for (int kk = 0; kk < 4; ++kk) acc[nt] = __builtin_amdgcn_mfma_f32_16x16x32_bf16(__builtin_bit_cast(bf16x8, AS[kk]), __builtin_bit_cast(bf16x8, Bc[nt][kk]), acc[nt], 0, 0, 0); } \
              \
            _Pragma("unroll") for (int i = 0; i < 4; ++i) { const long long lo_ = ok[i] ? (long long)__float2int_rn(acc[0][i] * 4194304.0f) : 0ll, hi_ = ok[i] ? (long long)__float2int_rn(acc[1][i] * 4194304.0f) : 0ll; \
                (void)__hip_atomic_fetch_add((LAS unsigned long long*)out + tk[i] * 16 + r, (unsigned long long)((hi_ << 32) + lo_), __ATOMIC_RELAXED, __HIP_MEMORY_SCOPE_WORKGROUP); } \
            M3_LOADA(AS, pseg, pbt, pnr, prbs); M3_ADV(pseg, pbt, pnr, prbs); \
            { const int old_ = cseg, nbat_ = (cnr + 15) >> 4; M3_ADV(cseg, cbt, cnr, crbs); \
              if (cseg != old_ && cseg < 10) { \
                  if (nbat_ == 1) M3_WAITB(4); else if (nbat_ == 2) M3_WAITB(8); else if (nbat_ == 3) M3_WAITB(12); else M3_WAITB(16); \
                  _Pragma("unroll") for (int nt = 0; nt < 2; ++nt) _Pragma("unroll") for (int kk = 0; kk < 4; ++kk) Bc[nt][kk] = Bn[nt][kk]; \
                  int nb_ = cseg; do { ++nb_; } while (nb_ < 8 && M3_NR(nb_) == 0); if (nb_ >= 10) nb_ = 9; M3_LOADB(Bn, nb_); } } }
        int cseg = -1, cbt = 0, cnr = 0, crbs = 0;
        do { ++cseg; } while (cseg < 8 && M3_NR(cseg) == 0);
        cnr = M3_NR(cseg); crbs = M3_RB(cseg);
        int pseg = cseg, pbt = 0, pnr = cnr, prbs = crbs;
        v4u Bc[2][4], Bn[2][4], A0[4], A1[4], A2[4], A3[4];
        M3_LOADB(Bc, cseg);
        M3_LOADA(A0, pseg, pbt, pnr, prbs); M3_ADV(pseg, pbt, pnr, prbs);
        M3_LOADA(A1, pseg, pbt, pnr, prbs); M3_ADV(pseg, pbt, pnr, prbs);
        M3_LOADA(A2, pseg, pbt, pnr, prbs); M3_ADV(pseg, pbt, pnr, prbs);
        M3_LOADA(A3, pseg, pbt, pnr, prbs); M3_ADV(pseg, pbt, pnr, prbs);
        { int nb_ = cseg; do { ++nb_; } while (nb_ < 8 && M3_NR(nb_) == 0); if (nb_ >= 10) nb_ = 9; M3_LOADB(Bn, nb_); }
        asm volatile("s_waitcnt vmcnt(0)" : "+v"(Bc[0][0]), "+v"(Bc[0][1]), "+v"(Bc[0][2]), "+v"(Bc[0][3]), "+v"(Bc[1][0]), "+v"(Bc[1][1]), "+v"(Bc[1][2]), "+v"(Bc[1][3]) :: "memory");
#pragma unroll 1
        while (cseg < 10) { M3_STEP(A0) M3_STEP(A1) M3_STEP(A2) M3_STEP(A3) }
        asm volatile("s_waitcnt vmcnt(0)" : "+v"(A0[0]), "+v"(A0[1]), "+v"(A0[2]), "+v"(A0[3]), "+v"(A1[0]), "+v"(A1[1]), "+v"(A1[2]), "+v"(A1[3]), "+v"(A2[0]), "+v"(A2[1]), "+v"(A2[2]), "+v"(A2[3]),
                     "+v"(A3[0]), "+v"(A3[1]), "+v"(A3[2]), "+v"(A3[3]), "+v"(Bn[0][0]), "+v"(Bn[0][1]), "+v"(Bn[0][2]), "+v"(Bn[0][3]), "+v"(Bn[1][0]), "+v"(Bn[1][1]), "+v"(Bn[1][2]), "+v"(Bn[1][3]) :: "memory");
#undef M3_NR
#undef M3_RB
#undef M3_GLD
#undef M3_LOADB
#undef M3_LOADA
#undef M3_ADV
#undef M3_WAITA
#undef M3_WAITB
#undef M3_STEP
        __syncthreads();
        { const int c4 = lane & 7, rs = lane >> 3, col = nc * 32 + 4 * c4;
          const f32x4 gv = *(const f32x4*)(g1 + col), bv = *(const f32x4*)(b1 + col);
#pragma unroll 4
          for (int it = 0; it < 16; ++it) { const int rl = 128 * w + 8 * it + rs; const size_t row = (size_t)tb * 1024 + rl;
              const f32x4 yv = *(const f32x4*)(Y1 + row * D + col); const f32x2 sv = *(const f32x2*)(ST1 + 2 * row);
              f32x4 tv; { const int nt = c4 >> 2, r0 = (4 * c4) & 15;
#pragma unroll
                  for (int j = 0; j < 4; ++j) { const v2u cell = *(const LAS v2u*)(out + rl * 32 + 2 * (r0 + j)); const int lo = (int)cell.x, hi = (int)cell.y + (lo < 0 ? 1 : 0); tv[j] = (float)(nt ? hi : lo) * (1.0f / 4194304.0f); } }
              const f32x4 y = ((yv - sv.x) * sv.y * gv + bv) * ALPHA + tv;
              *(f32x4*)(Y2 + row * D + col) = y;
              float sm = (y[0] + y[1]) + (y[2] + y[3]), sq = (y[0] * y[0] + y[1] * y[1]) + (y[2] * y[2] + y[3] * y[3]);
#pragma unroll
              for (int o = 1; o < 8; o <<= 1) { sm += shfl_x(sm, o, lane); sq += shfl_x(sq, o, lane); }
              if (c4 == 0) *(f32x2*)(PST2 + (row * 64 + nc) * 2) = (f32x2){sm, sq}; } }
    }
}

__device__ __forceinline__ void phase_moe4n(const Frame& F, const float* Y2, const float* pst, const float* gain, const float* bias, float* ST2, bf16* XBo, float* OUT, int last) {
    const int gw = F.bid * 8 + F.wave, NGW = F.G * 8, lane = F.lane;
    for (int t = gw; t < T; t += NGW) {
        f32x4 v[8];
#pragma unroll
        for (int j = 0; j < 8; ++j) v[j] = *(const f32x4*)(Y2 + (size_t)t * D + 4 * lane + 256 * j);
        const f32x2 pv = *(const f32x2*)(pst + ((size_t)t * 64 + lane) * 2);
        const float mean = wave_sum(pv.x, lane) * (1.0f / D); const float var = fmaxf(wave_sum(pv.y, lane) * (1.0f / D) - mean * mean, 0.f); const float rstd = 1.0f / sqrtf(var + LN_EPS);
        if (lane == 0) *(f32x2*)(ST2 + 2 * (size_t)t) = (f32x2){mean, rstd};
#pragma unroll
        for (int j = 0; j < 8; ++j) { const int c = 4 * lane + 256 * j; const f32x4 o = (v[j] - mean) * rstd * *(const f32x4*)(gain + c) + *(const f32x4*)(bias + c);
            if (last) *(f32x4*)(OUT + (size_t)t * D + c) = o;
            else { v2u wb; wb.x = pk2(o[0], o[1]); wb.y = pk2(o[2], o[3]); *(v2u*)(XBo + (size_t)t * D + c) = wb; } }
    }
}


__device__ __forceinline__ void phase_moe4q(const Frame& F, const bf16* X1, bf16* Y2, const unsigned char* Yq, const float* Ysc, const int* eidx, const int* inv, const float* gain, const float* bias, float* ST2, bf16* XBo, float* OUT, int last) {
    const LAS int* tpref = (const LAS int*)(F.lds + LDS_TAB);
    const int gw = F.bid * 8 + F.wave, NGW = F.G * 8, lane = F.lane;
    { LAS f32x4* gb = (LAS f32x4*)(F.lds + 0); int t0 = F.tid; asm volatile("" : "+v"(t0)); gb[t0] = *(const f32x4*)(gain + 4 * t0); gb[512 + t0] = *(const f32x4*)(bias + 4 * t0); }
    __syncthreads();
    const LAS float* gl = (const LAS float*)(F.lds + 0);
    int en = 0, pn = 0; if (lane < 8 && gw < T) { en = eidx[gw * 8 + lane]; pn = inv[gw * 8 + lane]; }
    for (int t = gw; t < T; t += NGW) {
        int rowi = 0; if (lane < 8) rowi = tpref[en] * 256 + pn; else if (lane < 10) rowi = tpref[56 + lane] * 256 + t;
        if (lane < 8 && t + NGW < T) { en = eidx[(t + NGW) * 8 + lane]; pn = inv[(t + NGW) * 8 + lane]; }
        v4u pv[2][2], yv[10][2]; float sc[10][2];
#pragma unroll
        for (int j = 0; j < 2; ++j) { pv[j][0] = __builtin_nontemporal_load((const v4u*)(X1 + (size_t)t * D + 16 * lane + 1024 * j)); pv[j][1] = __builtin_nontemporal_load((const v4u*)(X1 + (size_t)t * D + 16 * lane + 1024 * j + 8)); }
#pragma unroll
        for (int k = 0; k < 10; ++k) { const size_t row = (size_t)__builtin_amdgcn_readlane(rowi, k);
#pragma unroll
            for (int j = 0; j < 2; ++j) { yv[k][j] = __builtin_nontemporal_load((const v4u*)(Yq + row * D + 16 * lane + 1024 * j)); sc[k][j] = __builtin_nontemporal_load(Ysc + row * 16 + 8 * j + (lane >> 3)); } }
#pragma unroll
        for (int k = 0; k < 10; ++k) asm volatile("" : "+v"(yv[k][0]), "+v"(yv[k][1]), "+v"(sc[k][0]), "+v"(sc[k][1]));
        float v[2][16];
#pragma unroll
        for (int j = 0; j < 2; ++j) { float f0[8], f1[8]; unpack8(pv[j][0], f0); unpack8(pv[j][1], f1);
            const float ss = (((sc[0][j] + sc[1][j]) + (sc[2][j] + sc[3][j])) + ((sc[4][j] + sc[5][j]) + (sc[6][j] + sc[7][j]))) + (sc[8][j] + sc[9][j]);
#pragma unroll
            for (int i = 0; i < 8; ++i) { v[j][i] = ALPHA * f0[i] - 128.f * ss; v[j][8 + i] = ALPHA * f1[i] - 128.f * ss; } }
#pragma unroll
        for (int k = 0; k < 10; ++k)
#pragma unroll
            for (int j = 0; j < 2; ++j) { const float s_ = sc[k][j]; const unsigned q[4] = {yv[k][j].x, yv[k][j].y, yv[k][j].z, yv[k][j].w};
#pragma unroll
                for (int d = 0; d < 4; ++d) { v[j][4 * d + 0] += s_ * (float)(q[d] & 0xffu); v[j][4 * d + 1] += s_ * (float)((q[d] >> 8) & 0xffu); v[j][4 * d + 2] += s_ * (float)((q[d] >> 16) & 0xffu); v[j][4 * d + 3] += s_ * (float)(q[d] >> 24); } }
        float sm = 0.f;
#pragma unroll
        for (int j = 0; j < 2; ++j)
#pragma unroll
            for (int i = 0; i < 16; i += 4) sm += (v[j][i] + v[j][i + 1]) + (v[j][i + 2] + v[j][i + 3]);
        const float mean = wave_sum(sm, lane) * (1.0f / D); float sq = 0.f;
#pragma unroll
        for (int j = 0; j < 2; ++j)
#pragma unroll
            for (int i = 0; i < 16; ++i) { const float d = v[j][i] - mean; sq += d * d; }
        const float rstd = 1.0f / sqrtf(wave_sum(sq, lane) * (1.0f / D) + LN_EPS);
        (void)ST2; (void)Y2;
#pragma unroll
        for (int j = 0; j < 2; ++j)
#pragma unroll
            for (int h = 0; h < 2; ++h) { const int c = 16 * lane + 1024 * j + 8 * h; const float* vv = &v[j][8 * h];
                const f32x4 g0 = *(const LAS f32x4*)(gl + c), g1 = *(const LAS f32x4*)(gl + c + 4), b0 = *(const LAS f32x4*)(gl + 2048 + c), b1 = *(const LAS f32x4*)(gl + 2048 + c + 4);
                const f32x4 o0 = ((f32x4){vv[0], vv[1], vv[2], vv[3]} - mean) * rstd * g0 + b0, o1 = ((f32x4){vv[4], vv[5], vv[6], vv[7]} - mean) * rstd * g1 + b1;
                if (last) { *(f32x4*)(OUT + (size_t)t * D + c) = o0; *(f32x4*)(OUT + (size_t)t * D + c + 4) = o1; }
                else { v4u wb; wb.x = pk2(o0[0], o0[1]); wb.y = pk2(o0[2], o0[3]); wb.z = pk2(o1[0], o1[1]); wb.w = pk2(o1[2], o1[3]); *(v4u*)(XBo + (size_t)t * D + c) = wb; } }
    }
}

__device__ __forceinline__ void phase_downproj3(const Frame& F, const bf16* H, const bf16* WD, const bf16* HSp, const bf16* WSD, unsigned char* Yq, float* Ysc, int NT) {
    const LAS int* tpref = (const LAS int*)(F.lds + LDS_TAB); const LAS int* cl = (const LAS int*)(F.lds + LDS_TAB + 512);
    LAS unsigned char* lds = F.lds;
    const int tid = F.tid, lane = F.lane, w = F.wave, fr = lane & 15, fq = lane >> 4;
    unsigned rbB[2], cbB[2];
#pragma unroll
    for (int i = 0; i < 2; ++i) { int R_, C_; g8::stage_rc(tid * 16 + i * 8192, R_, C_); rbB[i] = (unsigned)((R_ & ~31) + g8::perm32(R_ & 31)); cbB[i] = (unsigned)C_ * 2u; }
    const unsigned ldsw = (unsigned)w * 1024u, lbase = (unsigned)(size_t)lds;
    int boffg[4];
#pragma unroll
    for (int g = 0; g < 4; ++g) boffg[g] = g8::lds_byte(32 * g + fr, fq * 8);
    LAS unsigned char* stg = lds + 65536 + w * (32 * 144);
    const int NU = NT * 4;
    const int upos = (F.G % 8) == 0 ? (F.bid & 7) * (F.G >> 3) + (F.bid >> 3) : F.bid;
    int ub = 0;
    int u = (F.G <= NU) ? upos : F.bid; if (u >= NU) return;
#define DP3_UNITINFO(uu, E0, EXP, NV) do { const int tl_ = (uu) >> 2; int e_ = (E0); while (__builtin_amdgcn_readfirstlane(tpref[e_ + 1]) <= tl_) ++e_; EXP = e_; \
        NV = __builtin_amdgcn_readfirstlane(cl[e_]) - (tl_ - __builtin_amdgcn_readfirstlane(tpref[e_])) * 256; } while (0)
#define DP3_GLDS(gsrc, ldsdst) do { unsigned keep_; asm volatile("s_mov_b32 %0, m0\n\ts_mov_b32 m0, %2\n\ts_nop 0\n\tglobal_load_lds_dwordx4 %1, off\n\ts_mov_b32 m0, %0" : "=&s"(keep_) : "v"(gsrc), "s"(ldsdst) : "memory"); } while (0)
#define DP3_STAGE(slot, gb, bs) do { const unsigned v0_ = rbB[0] * (unsigned)(bs) + cbB[0], v1_ = rbB[1] * (unsigned)(bs) + cbB[1]; _Pragma("unroll") for (int kt = 0; kt < 2; ++kt) { \
        DP3_GLDS((const void*)((gb) + kt * 128 + v0_), lbase + (unsigned)((slot) * 32768 + kt * 16384) + ldsw); \
        DP3_GLDS((const void*)((gb) + kt * 128 + v1_), lbase + (unsigned)((slot) * 32768 + kt * 16384) + ldsw + 8192u); } } while (0)
#define DP3_SRC(uu, ee, AB, AS, BB, BS) do { const int tl_ = (uu) >> 2, cu_ = ((uu) & 3) * 512; \
        if ((ee) < 64) { AB = (const char*)(H + (size_t)tl_ * 256 * EDIM); AS = EDIM * 2; BB = (const char*)(WD + (size_t)(ee) * D * EDIM + (size_t)cu_ * EDIM); BS = EDIM * 2; } \
        else { const int t0_ = (tl_ - __builtin_amdgcn_readfirstlane(tpref[ee])) * 256; AB = (const char*)(HSp + (size_t)t0_ * SDIM + ((ee) - 64) * EDIM); AS = SDIM * 2; \
               BB = (const char*)(WSD + (size_t)cu_ * SDIM + ((ee) - 64) * EDIM); BS = SDIM * 2; } } while (0)
    int ecur, nvcur; DP3_UNITINFO(u, 0, ecur, nvcur);
    const char* abc; const char* gbc; int asc, bsc; DP3_SRC(u, ecur, abc, asc, gbc, bsc);
    bf16x8 A[2][4], An[2][4];
    { const char* ap_ = abc + (size_t)(32 * w + fr) * asc + 16 * fq;
#pragma unroll
      for (int m = 0; m < 2; ++m)
#pragma unroll
          for (int kk = 0; kk < 4; ++kk) A[m][kk] = *(const bf16x8*)(ap_ + (size_t)m * 16 * asc + 64 * kk); }
    DP3_STAGE(0, gbc, bsc);
    asm volatile("s_waitcnt vmcnt(0)" ::: "memory");
#pragma unroll 1
    for (;;) {
        int un = u; { const int nb = ub + F.G; if (nb + F.G <= NU) un = nb + upos; else if (nb + F.bid < NU) un = nb + F.bid; if (un != u) ub = nb; }
        int enx, nvnx; DP3_UNITINFO(un, (un > u ? ecur : 0), enx, nvnx);
        const char* abn; const char* gbn; int asn, bsn; DP3_SRC(un, enx, abn, asn, gbn, bsn);
        const int tile = u >> 2, colu = (u & 3) * 512;
        float scq[2][4];
#pragma unroll
        for (int c = 0; c < 4; ++c) {
            if (c == 0) asm volatile("s_waitcnt vmcnt(5)" ::: "memory"); else asm volatile("s_waitcnt vmcnt(4)" ::: "memory");
            __builtin_amdgcn_s_barrier();
            if (c == 3) { const char* ap_ = abn + (size_t)(32 * w + fr) * asn + 16 * fq;
#pragma unroll
                for (int m = 0; m < 2; ++m) { const char* am_ = ap_ + (size_t)m * 16 * asn;
                    asm volatile("global_load_dwordx4 %0, %1, off" : "=&v"(An[m][0]) : "v"(am_) : "memory"); asm volatile("global_load_dwordx4 %0, %1, off offset:64" : "=&v"(An[m][1]) : "v"(am_) : "memory");
                    asm volatile("global_load_dwordx4 %0, %1, off offset:128" : "=&v"(An[m][2]) : "v"(am_) : "memory"); asm volatile("global_load_dwordx4 %0, %1, off offset:192" : "=&v"(An[m][3]) : "v"(am_) : "memory"); } }
            { const char* gnext = (c < 3) ? gbc + (size_t)(c + 1) * 128 * bsc : gbn; const int bnext = (c < 3) ? bsc : bsn; DP3_STAGE((c + 1) & 1, gnext, bnext); }
            __builtin_amdgcn_sched_barrier(0);
            f32x4 acc[2][4][2];
#pragma unroll
            for (int g = 0; g < 4; ++g) { bf16x8 Bf[2][4];
#pragma unroll
                for (int n = 0; n < 2; ++n)
#pragma unroll
                    for (int kk = 0; kk < 4; ++kk) Bf[n][kk] = *(const LAS bf16x8*)(lds + (c & 1) * 32768 + (kk >> 1) * 16384 + boffg[g] + n * 2048 + (kk & 1) * 1024);
#pragma unroll
                for (int m = 0; m < 2; ++m)
#pragma unroll
                    for (int n = 0; n < 2; ++n) { acc[m][g][n] = (f32x4){0.f, 0.f, 0.f, 0.f};
#pragma unroll
                        for (int kk = 0; kk < 4; ++kk) acc[m][g][n] = __builtin_amdgcn_mfma_f32_16x16x32_bf16(Bf[n][kk], A[m][kk], acc[m][g][n], 0, 0, 0); } }
#pragma unroll
            for (int m = 0; m < 2; ++m) {
                float am0 = 0.f, am1 = 0.f;
#pragma unroll
                for (int g = 0; g < 4; ++g)
#pragma unroll
                    for (int n = 0; n < 2; ++n) { am0 = fmaxf(fmaxf(am0, fabsf(acc[m][g][n][0])), fabsf(acc[m][g][n][1])); am1 = fmaxf(fmaxf(am1, fabsf(acc[m][g][n][2])), fabsf(acc[m][g][n][3])); }
                float am = fmaxf(am0, am1);
                am = max_fq(am);
                am = fminf(am, 3.0e38f);
                const float isc = am > 0.f ? 127.0f * __builtin_amdgcn_rcpf(am) : 0.f;
                scq[m][c] = am * (1.0f / 127.0f);
                const f32x2_t isc2 = (f32x2_t){isc, isc}, mg2 = (f32x2_t){8388736.0f, 8388736.0f};
#pragma unroll
                for (int g = 0; g < 4; ++g) { unsigned qd[2];
#pragma unroll
                    for (int n = 0; n < 2; ++n) {
                        const f32x2_t tl = __builtin_elementwise_fma((f32x2_t){acc[m][g][n][0], acc[m][g][n][1]}, isc2, mg2), th = __builtin_elementwise_fma((f32x2_t){acc[m][g][n][2], acc[m][g][n][3]}, isc2, mg2);
                        const float f0_ = tl.x, f1_ = tl.y, f2_ = th.x, f3_ = th.y;
                        qd[n] = __builtin_amdgcn_perm(__builtin_bit_cast(unsigned, f1_), __builtin_bit_cast(unsigned, f0_), 0x0c0c0400u) | __builtin_amdgcn_perm(__builtin_bit_cast(unsigned, f3_), __builtin_bit_cast(unsigned, f2_), 0x04000c0cu); }
                    *(LAS v2u*)(stg + (16 * m + fr) * 144 + 32 * g + 8 * fq) = (v2u){qd[0], qd[1]}; } }
            v4u ob[4];
#pragma unroll
            for (int it = 0; it < 4; ++it) ob[it] = *(const LAS v4u*)(stg + (8 * it + (lane >> 3)) * 144 + (lane & 7) * 16);
            asm volatile("" : "+v"(ob[0]), "+v"(ob[1]), "+v"(ob[2]), "+v"(ob[3]));
#pragma unroll
            for (int it = 0; it < 4; ++it) { const int rr = 8 * it + (lane >> 3);
                __builtin_nontemporal_store(ob[it], (v4u*)(Yq + (size_t)(tile * 256 + 32 * w + rr) * D + colu + 128 * c + 16 * (lane & 7))); }
            if (c == 3) { const f32x4 so = fq == 0 ? (f32x4){scq[0][0], scq[0][1], scq[0][2], scq[0][3]} : (f32x4){scq[1][0], scq[1][1], scq[1][2], scq[1][3]};
                if (fq < 2) __builtin_nontemporal_store(so, (f32x4*)(Ysc + (size_t)(tile * 256 + 32 * w + 16 * fq + fr) * 16 + (colu >> 7))); }
            __builtin_amdgcn_sched_barrier(0);
        }
        asm volatile("s_waitcnt vmcnt(9)" : "+v"(An[0][0]), "+v"(An[0][1]), "+v"(An[0][2]), "+v"(An[0][3]), "+v"(An[1][0]), "+v"(An[1][1]), "+v"(An[1][2]), "+v"(An[1][3]) :: "memory");
        if (un == u) break;
#pragma unroll
        for (int m = 0; m < 2; ++m)
#pragma unroll
            for (int kk = 0; kk < 4; ++kk) A[m][kk] = An[m][kk];
        u = un; ecur = enx; nvcur = nvnx; abc = abn; asc = asn; gbc = gbn; bsc = bsn;
    }
    asm volatile("s_waitcnt vmcnt(0)" ::: "memory");
#undef DP3_UNITINFO
#undef DP3_STAGE
#undef DP3_GLDS
#undef DP3_SRC
}

enum { PH_PRO = 0, PH_POOL_G1, PH_POOL_P, PH_POOL_G2, PH_POOL_G3, PH_DIL_G1, PH_DIL_ATT, PH_DIL_CMB, PH_DIL_G2, PH_CONV_G1, PH_CONV_E, PH_CONV_G2, PH_MOE1, PH_MOE2, PH_MOE3, PH_MOE4, PH_COUNT };

template <int PH>
__device__ __forceinline__ void run_phase(const Frame& Fin, const Args& args_, const int L) {
    Frame F = Fin; { int w_ = Fin.wave, l_; asm volatile("" : "+s"(w_)); asm volatile("v_mbcnt_lo_u32_b32 %0, -1, 0\n\tv_mbcnt_hi_u32_b32 %0, -1, %0" : "=v"(l_)); F.wave = w_; F.lane = l_; F.tid = w_ * 64 + l_; }
    unsigned char* ws; { GAS unsigned char* wsg = (GAS unsigned char*)Fin.ws; asm volatile("" : "+s"(wsg)); ws = (unsigned char*)wsg; } F.ws = ws; F.ctl = (unsigned*)(ws + WS_CTL);
    KP kp = (KP)__builtin_amdgcn_kernarg_segment_ptr(); asm volatile("" : "+s"(kp)); (void)args_;
    { unsigned l_ = (unsigned)(size_t)Fin.lds; asm volatile("" : "+s"(l_)); F.lds = (LAS unsigned char*)(size_t)l_; }
    LAS unsigned char* ring = F.lds; int c = (int)blockIdx.x; { int g_ = Fin.G; asm volatile("" : "+s"(c), "+s"(g_)); F.G = g_; F.bid = c; }
    const float* xres = ain(kp, IN_X);
    const float* st2 = (const float*)(ws + WS_ST2); float* pstp = (float*)(ws + WS_PST);
    const float* g2p = ain(kp, IN_LNG) + (size_t)((L > 0 ? L - 1 : 0) * 2 + 1) * D; const float* b2p = ain(kp, IN_LNB) + (size_t)((L > 0 ? L - 1 : 0) * 2 + 1) * D;
    const bf16* xb = (const bf16*)(ws + WS_XB);
    bf16* yf = (bf16*)(ws + WS_YF);
    unsigned char* big = ws + WS_BIG;
    const int ia = L / 3;
    if constexpr (PH == PH_PRO) { phase_prologue(F, kp); }
    if constexpr (PH == PH_POOL_G1) { g8::DenseSched S; S.init(xb, (const bf16*)(ws + WS_W_POOL_IN) + (size_t)ia * D * D, T, D, D, D, F.G, c);
        g8::EpiBf16 E{(bf16*)(big + BG_U), D, 0}; g8::gemm_phase<g8::EpiBf16, g8::DenseSched, false>(ring, F.tid, D, D, D, S, E); }
    if constexpr (PH == PH_POOL_P) { phase_pool(F, (const bf16*)(big + BG_U), (bf16*)(big + BG_PL)); }
    if constexpr (PH == PH_POOL_G2) { g8::DenseSched S; S.init((const bf16*)(big + BG_PL), (const bf16*)(ws + WS_W_POOL_G) + (size_t)ia * D * 512, T, D, D, 512, F.G, c); S.agrp_shift = 1; S.agrp_stride = 512 * 2;
        g8::EpiScaleBf16 E{(bf16*)(big + BG_MX), D, ain(kp, IN_PSC) + (size_t)ia * D}; g8::gemm_phase<g8::EpiScaleBf16, g8::DenseSched, false>(ring, F.tid, 512, D, 512, S, E); }
    if constexpr (PH == PH_POOL_G3) { g8::DenseSched S; S.init((const bf16*)(big + BG_MX), (const bf16*)(ws + WS_W_POOL_OUT) + (size_t)ia * D * D, T, D, D, D, F.G, c);
        g8::EpiResidLN E{xres, xb, st2, g2p, b2p, yf, pstp, 2}; g8::gemm_phase<g8::EpiResidLN, g8::DenseSched, false>(ring, F.tid, D, D, D, S, E); }
    if constexpr (PH == PH_DIL_G1) { g8::DenseSched S; S.init(xb, (const bf16*)(ws + WS_W_DIL_QKV), T, QKVC, D, D, F.G, c);
        g8::EpiBf16 E{(bf16*)(big + BG_QKV), QKVC, 1}; g8::gemm_phase<g8::EpiBf16, g8::DenseSched, false>(ring, F.tid, D, D, D, S, E); }
    if constexpr (PH == PH_DIL_ATT) { phase_attn(F, (const bf16*)(big + BG_QKV), ain(kp, IN_RELB), (bf16*)(big + BG_OG), (float*)(big + BG_LSE)); }
    if constexpr (PH == PH_DIL_CMB) { phase_combine(F, (const bf16*)(big + BG_OG), (const float*)(big + BG_LSE), (bf16*)(big + BG_O)); }
    if constexpr (PH == PH_DIL_G2) { g8::DenseSched S; S.init((const bf16*)(big + BG_O), (const bf16*)(ws + WS_W_DIL_OUT), T, D, DILW, DILW, F.G, c);
        g8::EpiResidLN E{xres, xb, st2, g2p, b2p, yf, pstp, 2}; g8::gemm_phase<g8::EpiResidLN, g8::DenseSched, false>(ring, F.tid, DILW, DILW, DILW, S, E); }
    if constexpr (PH == PH_CONV_G1) { g8::DenseSched S; S.init(xb, (const bf16*)(ws + WS_W_CONV_IN), T, 3 * D, D, D, F.G, c);
        g8::EpiConvIn E{(bf16*)(big + BG_UC), (bf16*)(big + BG_BG)}; g8::gemm_phase<g8::EpiConvIn, g8::DenseSched, false>(ring, F.tid, D, D, D, S, E); }
    if constexpr (PH == PH_CONV_E) { phase_conv(F, (const bf16*)(big + BG_UC), (const bf16*)(big + BG_BG), ain(kp, IN_CW), (bf16*)(big + BG_Z)); }
    if constexpr (PH == PH_CONV_G2) { g8::DenseSched S; S.init((const bf16*)(big + BG_Z), (const bf16*)(ws + WS_W_CONV_OUT), T, D, D, D, F.G, c);
        g8::EpiResidLN E{xres, xb, st2, g2p, b2p, yf, pstp, 2}; g8::gemm_phase<g8::EpiResidLN, g8::DenseSched, false>(ring, F.tid, D, D, D, S, E); }
    unsigned* cnt = F.ctl + CW_CNT + L * 64 * 16;
    float* x1f = (float*)(ws + WS_X1F); bf16* x1b = (bf16*)(ws + WS_X1B);
    int* ltok = (int*)(ws + WS_LTOK); float* lgate = (float*)(ws + WS_LGATE); int* eidx = (int*)(ws + WS_EIDX); int* inv = (int*)(ws + WS_INV);
    bf16* HB = (bf16*)(ws + WS_HB); bf16* HS = (bf16*)(ws + WS_HS); bf16* Yr = (bf16*)(ws + WS_BIG);
    if constexpr (PH == PH_MOE1) {
        const float* g1 = ain(kp, IN_LNG) + (size_t)(L * 2 + 0) * D; const float* b1 = ain(kp, IN_LNB) + (size_t)(L * 2 + 0) * D;
        phase_moe1n(F, yf, pstp, g1, b1, (const bf16*)(ws + WS_RWH) + (size_t)L * NEXP * D, (const bf16*)(ws + WS_RWL) + (size_t)L * NEXP * D, ain(kp, IN_RB) + (size_t)L * NEXP,
                    x1b, (float*)(ws + WS_ST1), cnt, ltok, lgate, eidx, inv); }
    if constexpr (PH == PH_MOE2) {
        const int NT = build_tiles(F, cnt);
        { g8::ExpertSched<1, true> S; S.tpref = (const LAS int*)(F.lds + LDS_TAB); S.cnt = (const LAS int*)(F.lds + LDS_TAB + 512); S.A = (const char*)x1b; S.B = (const char*)((const bf16*)(ws + WS_W_EX_GU) + (size_t)L * 64 * 256 * D);
          S.tok = ltok; S.b_exp = (size_t)256 * D * 2; S.b_tile = 0; S.a_tile = 0; S.NU = NT; S.G = F.G; S.c = c;
          g8::EpiExpertGU E{HB}; g8::gemm_phase<g8::EpiExpertGU, g8::ExpertSched<1, true>, true>(ring, F.tid, D, D, D, S, E); }
        { const int rot = (c - (NT % F.G) + F.G) % F.G;
          g8::DenseSched S; S.init(x1b, (const bf16*)(ws + WS_W_SH_GU) + (size_t)L * 512 * D, T, 512, D, D, F.G, rot);
          int t2 = F.tid; asm volatile("" : "+v"(t2));
          g8::EpiSharedGU E{HS}; g8::gemm_phase<g8::EpiSharedGU, g8::DenseSched, false>(ring, t2, D, D, D, S, E); } }
    if constexpr (PH == PH_MOE3) {
        const float* g1 = ain(kp, IN_LNG) + (size_t)(L * 2 + 0) * D; const float* b1 = ain(kp, IN_LNB) + (size_t)(L * 2 + 0) * D;
        const int NT = build_tiles(F, cnt);
        __syncthreads();
        phase_downproj3(F, HB, (const bf16*)(ws + WS_W_EX_D) + (size_t)L * 64 * D * EDIM, HS, (const bf16*)(ws + WS_W_SH_D) + (size_t)L * D * SDIM, (unsigned char*)Yr, (float*)(ws + WS_BIG + BG_YSC), NT + 2 * (T / 256));
        (void)g1; (void)b1; }
    if constexpr (PH == PH_MOE4) { (void)build_tiles(F, cnt);
        const float* g2 = ain(kp, IN_LNG) + (size_t)(L * 2 + 1) * D; const float* b2 = ain(kp, IN_LNB) + (size_t)(L * 2 + 1) * D;
        phase_moe4q(F, x1b, (bf16*)(ws + WS_Y2F), (const unsigned char*)Yr, (const float*)(ws + WS_BIG + BG_YSC), eidx, inv, g2, b2, (float*)(ws + WS_ST2), (bf16*)(ws + WS_XB), aout(kp), L == DEPTH - 1); }
}
__device__ __forceinline__ void make_frame(Frame& F, const Args& args) {
    extern __shared__ __attribute__((aligned(16))) unsigned char lds_raw[];
    F.lds = (LAS unsigned char*)lds_raw; F.ws = args.ws; F.ctl = (unsigned*)(args.ws + WS_CTL);
    F.tid = threadIdx.x; F.lane = F.tid & 63; F.wave = __builtin_amdgcn_readfirstlane(F.tid >> 6); F.G = gridDim.x; F.bid = blockIdx.x;
}
template <int PH> __global__ void __launch_bounds__(512, 2) k_phase(Args args, int L) {
    Frame F; make_frame(F, args);
    run_phase<PH>(F, args, L);
}

#ifndef MK_NOINLINE
#define MK_NOINLINE 0
#endif
#if MK_NOINLINE
template <int PH> __device__ __noinline__ void call_phase_ni(const int L) {
    Args dummy{}; Frame F;
    KP kp = (KP)__builtin_amdgcn_kernarg_segment_ptr();
    extern __shared__ __attribute__((aligned(16))) unsigned char lds_raw[];
    F.lds = (LAS unsigned char*)lds_raw; F.ws = (unsigned char*)((GAS unsigned char* const CAS*)kp)[20]; F.ctl = (unsigned*)(F.ws + WS_CTL);
    F.tid = threadIdx.x; F.lane = F.tid & 63; F.wave = __builtin_amdgcn_readfirstlane(F.tid >> 6); F.G = gridDim.x; F.bid = blockIdx.x;
    run_phase<PH>(F, dummy, L);
}
template <int PH> __device__ __forceinline__ void call_phase(const Frame& F, const Args& args, const int L) { call_phase_ni<PH>(L); }
#else
template <int PH> __device__ __forceinline__ void call_phase(const Frame& F, const Args& args, const int L) { asm volatile("; PHASE_BEGIN %0" :: "n"(PH)); run_phase<PH>(F, args, L); asm volatile("; PHASE_END %0" :: "n"(PH)); }
#endif
__global__ void __launch_bounds__(512, 2) fwd_all(Args args) {
    Frame F; make_frame(F, args);
    volatile LAS unsigned* misc = (volatile LAS unsigned*)(F.lds + LDS_MISC);
    if (F.tid < 4) misc[F.tid] = 0u;
    __syncthreads();
    const int lo = args.ph_lo, hi = args.ph_hi;
    XcdBarrier bar; bar.bar = F.ctl + CW_BAR; bar.x = 0; bar.st = misc;
    if (hi - lo > 1) bar = xcd_barrier_post(F.ctl + CW_BAR, misc);
    int pc = 0;
#ifndef MK_DUP_MASK
#define MK_DUP_MASK 0
#endif
#if MK_DUP_MASK
#define STEP(PH, Lx) do { if (pc >= lo && pc < hi) { int nrep_ = ((MK_DUP_MASK >> (PH)) & 1) ? 2 : 1; asm volatile("" : "+s"(nrep_)); _Pragma("unroll 1") for (int r_ = 0; r_ < nrep_; ++r_) { call_phase<PH>(F, args, Lx); if (r_ + 1 < nrep_ || pc + 1 < hi) xcd_barrier(bar); } } ++pc; } while (0)
#else
#define STEP(PH, Lx) do { if (pc >= lo && pc < hi) { call_phase<PH>(F, args, Lx); if (pc + 1 < hi) xcd_barrier(bar); } ++pc; } while (0)
#endif
    STEP(PH_PRO, 0);
#pragma unroll 1
    for (int L = 0; L < DEPTH; ++L) {
        const int kind = L % 3;
        if (kind == 0) { STEP(PH_POOL_G1, L); STEP(PH_POOL_P, L); STEP(PH_POOL_G2, L); STEP(PH_POOL_G3, L); }
        else if (kind == 1) { STEP(PH_DIL_G1, L); STEP(PH_DIL_ATT, L); STEP(PH_DIL_CMB, L); STEP(PH_DIL_G2, L); }
        else { STEP(PH_CONV_G1, L); STEP(PH_CONV_E, L); STEP(PH_CONV_G2, L); }
        STEP(PH_MOE1, L); STEP(PH_MOE2, L); STEP(PH_MOE3, L); STEP(PH_MOE4, L);
    }
#undef STEP
}
constexpr int N_STEPS = 1 + 2 * 8 + 8 + 7;

template <int PH> static void launch_phase(const Args& a, int L, int grid, hipStream_t stream) {
    static bool attr = false;
    if (!attr) { (void)hipFuncSetAttribute((const void*)k_phase<PH>, hipFuncAttributeMaxDynamicSharedMemorySize, LDS_BYTES); attr = true; }
    hipLaunchKernelGGL(k_phase<PH>, dim3(grid), dim3(512), LDS_BYTES, stream, a, L);
}
extern "C" void kernel_launch(void* const* d_in, const int* in_sizes, int n_in, void* d_out, int out_size, void* d_ws, size_t ws_size, hipStream_t stream) {
    static int grid = 0;
    if (grid == 0) {
        if (n_in != 19 || out_size != T * D || ws_size < WS_END) { fprintf(stderr, "kernel_launch: unexpected shapes (n_in %d out %d ws %zu need %zu)\n", n_in, out_size, ws_size, (size_t)WS_END); grid = -1; return; }
        int dev = 0, cus = 0;
        if (hipGetDevice(&dev) != hipSuccess || hipDeviceGetAttribute(&cus, hipDeviceAttributeMultiprocessorCount, dev) != hipSuccess) { grid = -1; return; }
#if MK_ONE_LAUNCH
        if (hipFuncSetAttribute((const void*)fwd_all, hipFuncAttributeMaxDynamicSharedMemorySize, LDS_BYTES) != hipSuccess) { fprintf(stderr, "kernel_launch: hipFuncSetAttribute failed\n"); grid = -1; return; }
        int per_cu = 0;
        if (hipOccupancyMaxActiveBlocksPerMultiprocessor(&per_cu, (const void*)fwd_all, 512, LDS_BYTES) != hipSuccess || per_cu < 1) { fprintf(stderr, "kernel_launch: note: occupancy query reports %d blocks per CU\n", per_cu); (void)hipGetLastError(); }
#endif
        grid = cus;
    }
    if (grid < 0) return;
    (void)hipMemsetAsync((char*)d_ws + WS_CTL, 0, CTL_ZERO_BYTES, stream);
    Args a{};
    for (int i = 0; i < 19; ++i) a.in[i] = (const float*)d_in[i];
    a.out = (float*)d_out; a.ws = (unsigned char*)d_ws; a.ph_lo = 0; a.ph_hi = 0;
#if MK_ONE_LAUNCH
#ifdef MK_SPLIT
    for (int p = 0; p < N_STEPS; ++p) { a.ph_lo = p; a.ph_hi = p + 1; hipLaunchKernelGGL(fwd_all, dim3(grid), dim3(512), LDS_BYTES, stream, a); }
#else
    a.ph_lo = 0; a.ph_hi = N_STEPS;
    hipLaunchKernelGGL(fwd_all, dim3(grid), dim3(512), LDS_BYTES, stream, a);
#endif
#elif defined(MK_HYBRID_MASK)
    {
        static bool attr2 = false; if (!attr2) { (void)hipFuncSetAttribute((const void*)fwd_all, hipFuncAttributeMaxDynamicSharedMemorySize, LDS_BYTES); attr2 = true; }
        int pc = 0;
#define HSTEP(PH, Lx) do { if ((MK_HYBRID_MASK >> (PH)) & 1) { a.ph_lo = pc; a.ph_hi = pc + 1; hipLaunchKernelGGL(fwd_all, dim3(grid), dim3(512), LDS_BYTES, stream, a); } else { a.ph_lo = 0; a.ph_hi = 0; launch_phase<PH>(a, Lx, grid, stream); } ++pc; } while (0)
        HSTEP(PH_PRO, 0);
        for (int L = 0; L < DEPTH; ++L) {
            const int kind = L % 3;
            if (kind == 0) { HSTEP(PH_POOL_G1, L); HSTEP(PH_POOL_P, L); HSTEP(PH_POOL_G2, L); HSTEP(PH_POOL_G3, L); }
            else if (kind == 1) { HSTEP(PH_DIL_G1, L); HSTEP(PH_DIL_ATT, L); HSTEP(PH_DIL_CMB, L); HSTEP(PH_DIL_G2, L); }
            else { HSTEP(PH_CONV_G1, L); HSTEP(PH_CONV_E, L); HSTEP(PH_CONV_G2, L); }
            HSTEP(PH_MOE1, L); HSTEP(PH_MOE2, L); HSTEP(PH_MOE3, L); HSTEP(PH_MOE4, L);
        }
#undef HSTEP
    }
#else
    launch_phase<PH_PRO>(a, 0, grid, stream);
    for (int L = 0; L < DEPTH; ++L) {
        const int kind = L % 3;
        if (kind == 0) { launch_phase<PH_POOL_G1>(a, L, grid, stream); launch_phase<PH_POOL_P>(a, L, grid, stream); launch_phase<PH_POOL_G2>(a, L, grid, stream); launch_phase<PH_POOL_G3>(a, L, grid, stream); }
        else if (kind == 1) { launch_phase<PH_DIL_G1>(a, L, grid, stream); launch_phase<PH_DIL_ATT>(a, L, grid, stream); launch_phase<PH_DIL_CMB>(a, L, grid, stream); launch_phase<PH_DIL_G2>(a, L, grid, stream); }
        else { launch_phase<PH_CONV_G1>(a, L, grid, stream); launch_phase<PH_CONV_E>(a, L, grid, stream); launch_phase<PH_CONV_G2>(a, L, grid, stream); }
        launch_phase<PH_MOE1>(a, L, grid, stream); launch_phase<PH_MOE2>(a, L, grid, stream); launch_phase<PH_MOE3>(a, L, grid, stream); launch_phase<PH_MOE4>(a, L, grid, stream);
    }
#endif
}
```

```cpp
#include <hip/hip_runtime.h>
#include <cstdio>
#include <cstdint>

#ifndef MK_ONE_LAUNCH
#define MK_ONE_LAUNCH 1
#endif

#define GAS __attribute__((address_space(1)))
#define LAS __attribute__((address_space(3)))
typedef unsigned short bf16;
typedef unsigned v4u __attribute__((ext_vector_type(4)));
typedef unsigned v2u __attribute__((ext_vector_type(2)));
typedef float f32x4 __attribute__((ext_vector_type(4)));
typedef float f32x2 __attribute__((ext_vector_type(2)));
typedef short bf16x8 __attribute__((ext_vector_type(8)));
typedef short s16x4 __attribute__((ext_vector_type(4)));

constexpr int NBATCH = 8, SEQ = 2048, D = 2048, T = NBATCH * SEQ, DEPTH = 4;
constexpr int NEXP = 64, TOPK = 8, EDIM = 128, SDIM = 256;
constexpr int QKVC = 4608, DILW = 512;
constexpr float ALPHA = 1.681792830507429f;
constexpr float LN_EPS = 1e-5f;
constexpr int CAP = 16384;
constexpr int HROWS = T * TOPK + NEXP * 256;

constexpr size_t MiB = 1u << 20;
constexpr size_t WS_CTL = 0, CTL_ZERO_BYTES = 1 * MiB;
constexpr size_t WS_W_POOL_IN = 1 * MiB;
constexpr size_t WS_W_POOL_G = WS_W_POOL_IN + 16 * MiB;
constexpr size_t WS_W_POOL_OUT = WS_W_POOL_G + 4 * MiB;
constexpr size_t WS_W_DIL_QKV = WS_W_POOL_OUT + 16 * MiB;
constexpr size_t WS_W_DIL_OUT = WS_W_DIL_QKV + 18 * MiB;
constexpr size_t WS_W_CONV_IN = WS_W_DIL_OUT + 2 * MiB;
constexpr size_t WS_W_CONV_OUT = WS_W_CONV_IN + 24 * MiB;
constexpr size_t WS_W_SH_GU = WS_W_CONV_OUT + 8 * MiB;
constexpr size_t WS_W_SH_D = WS_W_SH_GU + 8 * MiB;
constexpr size_t WS_W_EX_GU = WS_W_SH_D + 4 * MiB;
constexpr size_t WS_W_EX_D = WS_W_EX_GU + 256 * MiB;
constexpr size_t WS_XF = WS_W_EX_D + 256 * MiB;
constexpr size_t WS_YF = WS_XF + 128 * MiB;
constexpr size_t WS_X1F = WS_YF + 128 * MiB;
constexpr size_t WS_XB = WS_X1F + 128 * MiB;
constexpr size_t WS_X1B = WS_XB + 64 * MiB;
constexpr size_t WS_HB = WS_X1B + 64 * MiB;
constexpr size_t WS_HS = WS_HB + 72 * MiB;
constexpr size_t WS_LTOK = WS_HS + 8 * MiB;
constexpr size_t WS_LGATE = WS_LTOK + 4 * MiB;
constexpr size_t WS_EIDX = WS_LGATE + 4 * MiB;
constexpr size_t WS_INV = WS_EIDX + 1 * MiB;
constexpr size_t WS_BIG = WS_INV + 1 * MiB;
constexpr size_t WS_PST = WS_BIG + 608 * MiB;
constexpr size_t WS_ST1 = WS_PST + 4 * MiB;
constexpr size_t WS_ST2 = WS_ST1 + 1 * MiB;
constexpr size_t WS_RWH = WS_ST2 + 1 * MiB;
constexpr size_t WS_RWL = WS_RWH + 1 * MiB;
constexpr size_t WS_PST2 = WS_RWL + 1 * MiB;
constexpr size_t WS_END = WS_PST2 + 8 * MiB;
constexpr size_t WS_Y2F = WS_X1F;
constexpr size_t BG_U = 0, BG_PL = 64 * MiB, BG_MX = 128 * MiB;
constexpr size_t BG_QKV = 0, BG_OG = 144 * MiB, BG_LSE = 192 * MiB, BG_O = 194 * MiB;
constexpr size_t BG_UC = 0, BG_BG = 64 * MiB, BG_Z = 128 * MiB;
constexpr size_t BG_YSC = 400 * MiB;
constexpr int CW_BAR = 4096;
constexpr int CW_CNT = 16384;

constexpr int RING_BYTES = 131072;
constexpr int LDS_TAB = RING_BYTES;
constexpr int LDS_STASH = RING_BYTES + 1024;
constexpr int LDS_BYTES = 163840;
constexpr int LDS_MISC = LDS_BYTES - 1024;

typedef __bf16 bf16x2_t __attribute__((ext_vector_type(2)));
typedef float f32x2_t __attribute__((ext_vector_type(2)));
__device__ __forceinline__ unsigned cvt_pk_bf16(float lo, float hi) { const bf16x2_t r = __builtin_convertvector((f32x2_t){lo, hi}, bf16x2_t); return __builtin_bit_cast(unsigned, r); }
__device__ __forceinline__ unsigned f2bf(float f) { unsigned u = __builtin_bit_cast(unsigned, f); return (u + 0x7fffu + ((u >> 16) & 1u)) >> 16; }
__device__ __forceinline__ unsigned pk2(float lo, float hi) { return f2bf(lo) | (f2bf(hi) << 16); }
__device__ __forceinline__ float bflo(unsigned w) { return __builtin_bit_cast(float, w << 16); }
__device__ __forceinline__ float bfhi(unsigned w) { return __builtin_bit_cast(float, w & 0xffff0000u); }
__device__ __forceinline__ float shfl_from(float v, int src) { return __builtin_bit_cast(float, __builtin_amdgcn_ds_bpermute(src << 2, __builtin_bit_cast(int, v))); }
__device__ __forceinline__ float shfl_x(float v, int o, int lane) { return shfl_from(v, lane ^ o); }
__device__ __forceinline__ float wave_sum(float v, int lane) {
    (void)lane;
    v += __builtin_bit_cast(float, __builtin_amdgcn_update_dpp(0, __builtin_bit_cast(int, v), 0xB1, 0xF, 0xF, false));
    v += __builtin_bit_cast(float, __builtin_amdgcn_update_dpp(0, __builtin_bit_cast(int, v), 0x4E, 0xF, 0xF, false));
    v += __builtin_bit_cast(float, __builtin_amdgcn_update_dpp(0, __builtin_bit_cast(int, v), 0x141, 0xF, 0xF, false));
    v += __builtin_bit_cast(float, __builtin_amdgcn_update_dpp(0, __builtin_bit_cast(int, v), 0x140, 0xF, 0xF, false));
    const float r0 = __builtin_bit_cast(float, __builtin_amdgcn_readlane(__builtin_bit_cast(int, v), 0)), r1 = __builtin_bit_cast(float, __builtin_amdgcn_readlane(__builtin_bit_cast(int, v), 16));
    const float r2 = __builtin_bit_cast(float, __builtin_amdgcn_readlane(__builtin_bit_cast(int, v), 32)), r3 = __builtin_bit_cast(float, __builtin_amdgcn_readlane(__builtin_bit_cast(int, v), 48));
    return (r0 + r1) + (r2 + r3);
}
__device__ __forceinline__ float sum_fq(float x) {
    { const auto r = __builtin_amdgcn_permlane16_swap(__builtin_bit_cast(unsigned, x), __builtin_bit_cast(unsigned, x), false, false); const unsigned a_ = r[0], b_ = r[1]; x = __builtin_bit_cast(float, a_) + __builtin_bit_cast(float, b_); }
    { const auto r = __builtin_amdgcn_permlane32_swap(__builtin_bit_cast(unsigned, x), __builtin_bit_cast(unsigned, x), false, false); const unsigned a_ = r[0], b_ = r[1]; x = __builtin_bit_cast(float, a_) + __builtin_bit_cast(float, b_); }
    return x;
}
__device__ __forceinline__ float max_fq(float x) {
    { const auto r = __builtin_amdgcn_permlane16_swap(__builtin_bit_cast(unsigned, x), __builtin_bit_cast(unsigned, x), false, false); const unsigned a_ = r[0], b_ = r[1]; x = fmaxf(__builtin_bit_cast(float, a_), __builtin_bit_cast(float, b_)); }
    { const auto r = __builtin_amdgcn_permlane32_swap(__builtin_bit_cast(unsigned, x), __builtin_bit_cast(unsigned, x), false, false); const unsigned a_ = r[0], b_ = r[1]; x = fmaxf(__builtin_bit_cast(float, a_), __builtin_bit_cast(float, b_)); }
    return x;
}
#define LDS_WAIT() asm volatile("s_waitcnt lgkmcnt(0)" ::: "memory")
#define VM_WAIT() asm volatile("s_waitcnt vmcnt(0)" ::: "memory")

#define XB_TMO      128
#define XB_XCNT(j)  (256  + 64 * (j))
#define XB_XSUB(j)  (1280 + 64 * (j))
#define XB_XGEN(j)  (2304 + 64 * (j))
#define XB_TOP      3328
#define XB_TOPGEN   3392
#define XCD_BAR_WORDS 3456
#define XB_SPIN_CAP (1u << 18)

__device__ __forceinline__ unsigned xb_ld(unsigned* p)              { return __hip_atomic_load(p, __ATOMIC_RELAXED, __HIP_MEMORY_SCOPE_AGENT); }
__device__ __forceinline__ unsigned xb_add(unsigned* p, unsigned v) { return __hip_atomic_fetch_add(p, v, __ATOMIC_RELAXED, __HIP_MEMORY_SCOPE_AGENT); }
__device__ __forceinline__ unsigned xb_xcc_id() { return (unsigned)__builtin_amdgcn_s_getreg((3 << 11) | 20) & 0xFu; }
#define XB_SPIN(cond, bar) do { unsigned _sp = 0; while (cond) { __builtin_amdgcn_s_sleep(1); \
    if ((++_sp & 255u) == 0u) { if (xb_ld(&(bar)[XB_TMO])) break; if (_sp > XB_SPIN_CAP) { atomicAdd(&(bar)[XB_TMO], 1u); break; } } } } while (0)

struct XcdBarrier {
    unsigned* bar; unsigned x;
    volatile LAS unsigned* st;
};

__device__ __forceinline__ XcdBarrier xcd_barrier_post(unsigned* bar, volatile LAS unsigned* st) {
    XcdBarrier b; b.bar = bar; b.x = xb_xcc_id(); b.st = st;
    if (threadIdx.x == 0) (void)xb_add(&bar[XB_XCNT(b.x)], 1u);
    return b;
}
__device__ __forceinline__ void xcd_barrier_complete(unsigned* bar, unsigned x, unsigned& nloc, unsigned& nx) {
    const unsigned G = gridDim.x * gridDim.y * gridDim.z;
    unsigned sum, cnt, mine, sp = 0u;
    for (;;) {
        sum = 0u; cnt = 0u; mine = 0u;
#pragma unroll
        for (unsigned j = 0; j < 16; ++j) { const unsigned c = xb_ld(&bar[XB_XCNT(j)]); sum += c; cnt += (c > 0u) ? 1u : 0u; mine = (j == x) ? c : mine; }
        if (sum == G) break;
        __builtin_amdgcn_s_sleep(1);
        if ((++sp & 255u) == 0u) { if (xb_ld(&bar[XB_TMO])) break; if (sp > XB_SPIN_CAP) { atomicAdd(&bar[XB_TMO], 1u); break; } }
    }
    nloc = mine > 0u ? mine : 1u; nx = cnt > 0u ? cnt : 1u;
}

__device__ __forceinline__ void xcd_barrier(const XcdBarrier& b) {
    asm volatile("s_waitcnt vmcnt(0)" ::: "memory");
    __syncthreads();
    if (threadIdx.x == 0) {
        unsigned* bar; unsigned bx = b.x; { GAS unsigned* bg = (GAS unsigned*)b.bar; asm volatile("" : "+s"(bg), "+s"(bx)); bar = (unsigned*)bg; }
        __builtin_amdgcn_s_waitcnt(0);
        unsigned nloc = b.st[0], nx = b.st[1];
        if (nloc == 0u) { xcd_barrier_complete(bar, bx, nloc, nx); b.st[0] = nloc; b.st[1] = nx; }
        const unsigned old = xb_add(&bar[XB_XSUB(bx)], 1u);
        const unsigned gen = old / nloc;
        if (old + 1u == (gen + 1u) * nloc) {
            __builtin_amdgcn_fence(__ATOMIC_RELEASE, "agent");
            asm volatile("s_waitcnt vmcnt(0)" ::: "memory");
            const unsigned og = xb_add(&bar[XB_TOP], 1u);
            const unsigned tg = og / nx;
            if (og + 1u == (tg + 1u) * nx) xb_add(&bar[XB_TOPGEN], 1u);
            else XB_SPIN(xb_ld(&bar[XB_TOPGEN]) == tg, bar);
            __builtin_amdgcn_fence(__ATOMIC_ACQUIRE, "agent");
            xb_add(&bar[XB_XGEN(bx)], 1u);
            asm volatile("s_waitcnt vmcnt(0)" ::: "memory");
        } else {
            XB_SPIN(xb_ld(&bar[XB_XGEN(bx)]) == gen, bar);
            __builtin_amdgcn_fence(__ATOMIC_ACQUIRE, "agent");
            asm volatile("s_waitcnt vmcnt(0)" ::: "memory");
        }
    }
    __syncthreads();
}

namespace g8 {
constexpr int BM = 256, BK = 64, HALF = 128, HTB = HALF * BK * 2, STAGE_BYTES = 8 * HTB, NXCD = 8, WGM = 8;
__host__ __device__ __forceinline__ int lds_byte(int r, int c) { const int st = (r >> 4) * 2 + (c >> 5), rr = r & 15, cc = c & 31, ob = rr * 64 + cc * 2; return st * 1024 + (ob ^ (((ob >> 9) & 1) << 5)); }
__host__ __device__ __forceinline__ void stage_rc(int b, int& R, int& C) { const int st = b / 1024, sb = b % 1024, swz = sb ^ (((sb >> 9) & 1) << 5); R = (st >> 1) * 16 + swz / 64; C = (st & 1) * 32 + (swz % 64) / 2; }
__host__ __device__ __forceinline__ int perm32(int rho) { const int n = rho >> 4, i = rho & 15; return 8 * (i >> 2) + 4 * n + (i & 3); }

struct Unit { const char* A; const char* B; const int* rows; int pm, pn, nvalid, aux; };

template <class Epi, class Sched, bool GATHER>
__device__ __forceinline__ void gemm_phase(LAS unsigned char* lds, const int tid_in, const int K, const int lda, const int ldb, const Sched& S, const Epi& E) {
    const int tid = tid_in, wid = __builtin_amdgcn_readfirstlane(tid >> 6), lane = tid & 63, wr = wid >> 2, wc = wid & 3, fr = lane & 15, fq = lane >> 4;
    const int nt = K / BK;
    unsigned voffB[2];
#pragma unroll
    for (int i = 0; i < 2; ++i) { int R_, C_; stage_rc(tid * 16 + i * 8192, R_, C_); const int Rb = Epi::PERM ? ((R_ & ~31) + perm32(R_ & 31)) : R_; voffB[i] = (unsigned)(Rb * ldb + C_) * 2u; }
    LAS v4u* stash = (LAS v4u*)(lds + (LDS_STASH - 0) + tid * 16);
    const size_t kstep = (size_t)(BK * 2);
    const size_t hstepB = (size_t)HALF * ldb * 2;
    const unsigned ldsw = (unsigned)wid * 1024u;
    const int aoff = lds_byte(wr * 64 + fr, fq * 8), boff = lds_byte(wc * 32 + fr, fq * 8);
#define G8_SA(b, h) (((b) * 2 + (h)) * HTB)
#define G8_SB(b, h) ((4 + (b) * 2 + (h)) * HTB)
#define G8_STAGE2(bufoff, gbase, v0, v1) do { \
        __builtin_amdgcn_global_load_lds((const unsigned*)((const char*)(gbase) + (v0)), (LAS unsigned*)(lds + (bufoff) + ldsw), 16, 0, 0); \
        __builtin_amdgcn_global_load_lds((const unsigned*)((const char*)(gbase) + (v1)), (LAS unsigned*)(lds + (bufoff) + ldsw + 8192), 16, 0, 0); } while (0)
#define G8_STAGEB(bufoff, gbase) G8_STAGE2(bufoff, gbase, voffB[0], voffB[1])
#define G8_LDA(dst, b, h) do { _Pragma("unroll") for (int m = 0; m < 4; ++m) _Pragma("unroll") for (int k = 0; k < 2; ++k) dst[m][k] = *(const LAS bf16x8*)(lds + G8_SA(b, h) + aoff + m * 2048 + k * 1024); } while (0)
#define G8_LDB(dst, b, h) do { _Pragma("unroll") for (int n = 0; n < 2; ++n) _Pragma("unroll") for (int k = 0; k < 2; ++k) dst[n][k] = *(const LAS bf16x8*)(lds + G8_SB(b, h) + boff + n * 2048 + k * 1024); } while (0)
#define G8_MMA(ai, bj, At, Bt) do { __builtin_amdgcn_s_setprio(1); _Pragma("unroll") for (int m = 0; m < 4; ++m) _Pragma("unroll") for (int n = 0; n < 2; ++n) _Pragma("unroll") for (int k = 0; k < 2; ++k) \
        acc[ai][bj][m][n] = __builtin_amdgcn_mfma_f32_16x16x32_bf16(Bt[n][k], At[m][k], acc[ai][bj][m][n], 0, 0, 0); __builtin_amdgcn_s_setprio(0); } while (0)
#define G8_WAIT_V(n) asm volatile("s_waitcnt vmcnt(" #n ")" ::: "memory")
#define G8_WAIT_L(n) asm volatile("s_waitcnt lgkmcnt(" #n ")" ::: "memory")
#define G8_BAR __builtin_amdgcn_s_barrier()
#define G8_SCHED __builtin_amdgcn_sched_barrier(0)
#define G8_SETVA(dst, u) do { int _t2 = tid; if (GATHER) asm volatile("" : "+v"(_t2)); _Pragma("unroll") for (int _h = 0; _h < 2; ++_h) _Pragma("unroll") for (int _i = 0; _i < 2; ++_i) { \
        int _R, _C; stage_rc(_t2 * 16 + _i * 8192, _R, _C); \
        const unsigned _rl = (unsigned)(_h * HALF + _R); unsigned _row = _rl; \
        if (GATHER) { const bool _ok = _rl < (unsigned)(u).nvalid; _row = (unsigned)(u).rows[_ok ? _rl : 0u] >> 3; if (!_ok) _row = 0u; }     \
        dst[_h][_i] = (_row * (unsigned)lda + (unsigned)_C) * 2u; } } while (0)
    Unit cur, nxt; int ui = 0;
    if (!S.next(0, cur)) return;
    f32x4 acc[2][2][4][2];
#pragma unroll
    for (int a = 0; a < 2; ++a)
#pragma unroll
        for (int b = 0; b < 2; ++b)
#pragma unroll
            for (int m = 0; m < 4; ++m)
#pragma unroll
                for (int n = 0; n < 2; ++n) acc[a][b][m][n] = (f32x4){0.f, 0.f, 0.f, 0.f};
    bf16x8 At[4][2], B0[2][2], B1[2][2];
    unsigned vAc[2][2]; unsigned xl00 = 0, xl01 = 0, xl10 = 0, xl11 = 0;
    G8_SETVA(vAc, cur);
    const char* cA = cur.A; const char* cB = cur.B;
    G8_STAGEB(G8_SB(0, 0), cB); G8_STAGEB(G8_SB(0, 1), cB + hstepB); G8_STAGE2(G8_SA(0, 0), cA, vAc[0][0], vAc[0][1]); G8_STAGE2(G8_SA(0, 1), cA, vAc[1][0], vAc[1][1]);
    if (wr == 1) G8_BAR;
    G8_WAIT_V(2); G8_BAR;
    G8_STAGEB(G8_SB(1, 0), cB + kstep); G8_STAGE2(G8_SA(1, 0), cA + kstep, vAc[0][0], vAc[0][1]); G8_STAGEB(G8_SB(1, 1), cB + hstepB + kstep);
    G8_WAIT_V(6); G8_BAR;
    for (;;) {
        const bool has_next = S.next(ui + 1, nxt);
        const char* nA = has_next ? nxt.A : cA; const char* nB = has_next ? nxt.B : cB;
        if (GATHER) { unsigned vAn[2][2]; if (has_next) { G8_SETVA(vAn, nxt); } else {
#pragma unroll
            for (int h = 0; h < 2; ++h)
#pragma unroll
                for (int i = 0; i < 2; ++i) vAn[h][i] = vAc[h][i]; }
            *stash = (v4u){vAn[0][0], vAn[0][1], vAn[1][0], vAn[1][1]}; }
#pragma unroll 1
        for (int t = 0; t < nt; t += 2) {
            const bool last = (t == nt - 2);
            const char* a1 = cA + (size_t)(t + 1) * kstep;
            const char* a2 = last ? nA : cA + (size_t)(t + 2) * kstep; const char* b2 = last ? nB : cB + (size_t)(t + 2) * kstep;
            const char* a3 = a2 + kstep; const char* b3 = b2 + kstep;
            unsigned x00 = vAc[0][0], x01 = vAc[0][1], x10 = vAc[1][0], x11 = vAc[1][1];
            if (GATHER) { if (last) { const v4u sv = *stash; x00 = sv.x; x01 = sv.y; x10 = sv.z; x11 = sv.w; } xl00 = x00; xl01 = x01; xl10 = x10; xl11 = x11; }
            G8_LDB(B0, 0, 0); G8_LDB(B1, 0, 1); G8_SCHED; G8_LDA(At, 0, 0); G8_STAGE2(G8_SA(1, 1), a1, vAc[1][0], vAc[1][1]);
            G8_WAIT_V(8); G8_WAIT_L(0); G8_BAR; G8_MMA(0, 0, At, B0); G8_MMA(0, 1, At, B1); G8_BAR; G8_SCHED;
            G8_LDA(At, 0, 1); G8_STAGEB(G8_SB(0, 0), b2); G8_STAGEB(G8_SB(0, 1), b2 + hstepB); G8_STAGE2(G8_SA(0, 0), a2, x00, x01);
            G8_WAIT_V(8); G8_WAIT_L(0); G8_BAR; G8_MMA(1, 0, At, B0); G8_MMA(1, 1, At, B1); G8_BAR; G8_SCHED;
            G8_LDB(B0, 1, 0); G8_LDB(B1, 1, 1); G8_SCHED; G8_LDA(At, 1, 0); G8_STAGE2(G8_SA(0, 1), a2, x10, x11);
            G8_WAIT_V(8); G8_WAIT_L(0); G8_BAR; G8_MMA(0, 0, At, B0); G8_MMA(0, 1, At, B1); G8_BAR; G8_SCHED;
            G8_LDA(At, 1, 1); G8_STAGEB(G8_SB(1, 0), b3); G8_STAGEB(G8_SB(1, 1), b3 + hstepB); G8_STAGE2(G8_SA(1, 0), a3, x00, x01);
            G8_WAIT_V(8); G8_WAIT_L(0); G8_BAR; G8_MMA(1, 0, At, B0); G8_MMA(1, 1, At, B1); G8_BAR; G8_SCHED;
        }
        if (wr == 0) G8_BAR;
        E(acc, cur, wr, wc, fr, fq);
        if (!has_next) break;
#pragma unroll
        for (int a = 0; a < 2; ++a)
#pragma unroll
            for (int b = 0; b < 2; ++b)
#pragma unroll
                for (int m = 0; m < 4; ++m)
#pragma unroll
                    for (int n = 0; n < 2; ++n) acc[a][b][m][n] = (f32x4){0.f, 0.f, 0.f, 0.f};
        cur = nxt; cA = nA; cB = nB; ++ui;
        if (GATHER) { vAc[0][0] = xl00; vAc[0][1] = xl01; vAc[1][0] = xl10; vAc[1][1] = xl11; }
        if (wr == 1) G8_BAR;
    }
    G8_WAIT_V(0);
    G8_BAR;
#undef G8_SA
#undef G8_SB
#undef G8_STAGE2
#undef G8_STAGEB
#undef G8_LDA
#undef G8_LDB
#undef G8_MMA
#undef G8_WAIT_V
#undef G8_WAIT_L
#undef G8_BAR
#undef G8_SCHED
#undef G8_SETVA
}

struct DenseSched {
    const char* A; const char* B; size_t a_tile, b_tile, agrp_stride; int agrp_shift, nM, nN, nwg, G, c;
    __device__ __forceinline__ void init(const void* A_, const void* B_, int M, int N, int lda, int ldb, int G_, int c_) {
        A = (const char*)A_; B = (const char*)B_; a_tile = (size_t)BM * lda * 2; b_tile = (size_t)BM * ldb * 2; agrp_stride = 0; agrp_shift = 0; nM = M / BM; nN = N / BM; nwg = nM * nN; G = G_; c = c_; }
    __device__ __forceinline__ bool next(int i, Unit& u) const {
        const long L = (long)i * G + c; if (L >= nwg) return false;
        int wgid = (int)L; { const int q = nwg / NXCD, r = nwg % NXCD, xcd = wgid % NXCD, off = wgid / NXCD; wgid = (xcd < r ? xcd * (q + 1) : r * (q + 1) + (xcd - r) * q) + off; }
        const int nig = WGM * nN, gid = wgid / nig, fm = gid * WGM, gsz = (nM - fm) < WGM ? (nM - fm) : WGM;
        u.pm = fm + ((wgid % nig) % gsz); u.pn = (wgid % nig) / gsz;
        u.A = A + (size_t)u.pm * a_tile + (size_t)(u.pn >> agrp_shift) * agrp_stride; u.B = B + (size_t)u.pn * b_tile; u.rows = nullptr; u.nvalid = BM; u.aux = 0; return true;
    }
};
template <int NPN, bool GATHERED>
struct ExpertSched {
    const LAS int* tpref; const LAS int* cnt; const char* A; const char* B; const int* tok; size_t b_exp, b_tile, a_tile; int NU, G, c; int tf = 0;
    __device__ __forceinline__ bool next(int i, Unit& u) const {
        int L = i * G + c;
        if (tf) {
            const int x = c & 7, q = c >> 3;
            if (c >= 128) { if (i > 2) return false; L = i == 0 ? x * 16 + (q - 16) : i == 1 ? 128 + x * 32 + q : 512 + (c - 128); }
            else { if (i > 1) return false; L = i == 0 ? 128 + x * 32 + q : 384 + x * 16 + q; }
            if (L >= NU) return false;
        } else {
        if (L >= NU) return false;
        if ((i + 1) * G <= NU && (G % NXCD) == 0) L = i * G + (c % NXCD) * (G / NXCD) + c / NXCD;
        }
        const int tile = L / NPN, pn = L % NPN;
        int e = 0; { int hi = 64;
#pragma unroll
          for (int it_ = 0; it_ < 6; ++it_) { const int mid = (e + hi) >> 1; if (__builtin_amdgcn_readfirstlane(tpref[mid]) <= tile) e = mid; else hi = mid; } }
        const int rb = tile - __builtin_amdgcn_readfirstlane(tpref[e]);
        u.pm = e; u.pn = pn; u.aux = tile * BM; u.nvalid = __builtin_amdgcn_readfirstlane(cnt[e]) - rb * BM; if (u.nvalid > BM) u.nvalid = BM;
        u.rows = tok + (size_t)e * CAP + rb * BM;
        u.A = GATHERED ? A : A + (size_t)tile * a_tile; u.B = B + (size_t)e * b_exp + (size_t)pn * b_tile; return true;
    }
};

struct EpiBf16 {
    static constexpr bool PERM = true;
    bf16* O; int ldc; int qscale;
    __device__ __forceinline__ void operator()(const f32x4 (&acc)[2][2][4][2], const Unit& u, int wr, int wc, int fr, int fq) const {
        asm volatile("" : "+v"(fr), "+v"(fq));
        const int row0 = u.pm * BM + wr * 64 + fr, col0 = u.pn * BM + wc * 32 + 8 * fq;
        const float sc = (qscale && (u.pn % 6) < 2) ? 0.125f : 1.0f;
#pragma unroll
        for (int ai = 0; ai < 2; ++ai)
#pragma unroll
            for (int m = 0; m < 4; ++m) { bf16* rowp = O + (size_t)(row0 + ai * HALF + m * 16) * ldc + col0;
#pragma unroll
                for (int bj = 0; bj < 2; ++bj) { const f32x4 v0 = acc[ai][bj][m][0] * sc, v1 = acc[ai][bj][m][1] * sc;
                    v4u w; w.x = cvt_pk_bf16(v0[0], v0[1]); w.y = cvt_pk_bf16(v0[2], v0[3]); w.z = cvt_pk_bf16(v1[0], v1[1]); w.w = cvt_pk_bf16(v1[2], v1[3]);
                    *(v4u*)(rowp + bj * HALF) = w; } }
    }
};
struct EpiScaleBf16 {
    static constexpr bool PERM = true;
    bf16* O; int ldc; const float* scale;
    __device__ __forceinline__ void operator()(const f32x4 (&acc)[2][2][4][2], const Unit& u, int wr, int wc, int fr, int fq) const {
        asm volatile("" : "+v"(fr), "+v"(fq));
        const int row0 = u.pm * BM + wr * 64 + fr, col0 = u.pn * BM + wc * 32 + 8 * fq;
        f32x4 sv[2][2];
#pragma unroll
        for (int bj = 0; bj < 2; ++bj)
#pragma unroll
            for (int n = 0; n < 2; ++n) sv[bj][n] = *(const f32x4*)(scale + col0 + bj * HALF + 4 * n);
#pragma unroll
        for (int ai = 0; ai < 2; ++ai)
#pragma unroll
            for (int m = 0; m < 4; ++m) { bf16* rowp = O + (size_t)(row0 + ai * HALF + m * 16) * ldc + col0;
#pragma unroll
                for (int bj = 0; bj < 2; ++bj) { const f32x4 v0 = acc[ai][bj][m][0] * sv[bj][0], v1 = acc[ai][bj][m][1] * sv[bj][1];
                    v4u w; w.x = cvt_pk_bf16(v0[0], v0[1]); w.y = cvt_pk_bf16(v0[2], v0[3]); w.z = cvt_pk_bf16(v1[0], v1[1]); w.w = cvt_pk_bf16(v1[2], v1[3]);
                    *(v4u*)(rowp + bj * HALF) = w; } }
    }
};
struct EpiResid {
    static constexpr bool PERM = false;
    const float* X; float* Y;
    __device__ __forceinline__ void operator()(const f32x4 (&acc)[2][2][4][2], const Unit& u, int wr, int wc, int fr, int fq) const {
        asm volatile("" : "+v"(fr), "+v"(fq));
        const int row0 = u.pm * BM + wr * 64 + fr, col0 = u.pn * BM + wc * 32 + 4 * fq;
#pragma unroll
        for (int ai = 0; ai < 2; ++ai)
#pragma unroll
            for (int m = 0; m < 4; ++m) { const size_t off = (size_t)(row0 + ai * HALF + m * 16) * D + col0;
#pragma unroll
                for (int bj = 0; bj < 2; ++bj)
#pragma unroll
                    for (int n = 0; n < 2; ++n) { const f32x4 xv = *(const f32x4*)(X + off + bj * HALF + n * 16); *(f32x4*)(Y + off + bj * HALF + n * 16) = xv * ALPHA + acc[ai][bj][m][n]; } }
    }
};
struct EpiResidLN {
    static constexpr bool PERM = true;
    const float* X32; const bf16* Xb; const float* st; const float* g; const float* b; bf16* Y; float* pst; int mode;
    __device__ __forceinline__ void operator()(const f32x4 (&acc)[2][2][4][2], const Unit& u, int wr, int wc, int fr, int fq) const {
        asm volatile("" : "+v"(fr), "+v"(fq));
        const int row0 = u.pm * BM + wr * 64 + fr, col0 = u.pn * BM + wc * 32 + 8 * fq, lane = fq * 16 + fr;
#pragma unroll
        for (int ai = 0; ai < 2; ++ai) {
            v4u xr[4][2];
#pragma unroll
            for (int m = 0; m < 4; ++m)
#pragma unroll
                for (int bj = 0; bj < 2; ++bj) xr[m][bj] = *(const v4u*)(Xb + (size_t)(row0 + ai * HALF + m * 16) * D + col0 + bj * HALF);
            asm volatile("" : "+v"(xr[0][0]), "+v"(xr[0][1]), "+v"(xr[1][0]), "+v"(xr[1][1]), "+v"(xr[2][0]), "+v"(xr[2][1]), "+v"(xr[3][0]), "+v"(xr[3][1]));
#pragma unroll
            for (int m = 0; m < 4; ++m) { const int row = row0 + ai * HALF + m * 16; const size_t off = (size_t)row * D + col0;
                float sm = 0.f, sq = 0.f;
#pragma unroll
                for (int bj = 0; bj < 2; ++bj) { const v4u xv = xr[m][bj];
                    const f32x4 x0 = (f32x4){bflo(xv.x), bfhi(xv.x), bflo(xv.y), bfhi(xv.y)}, x1 = (f32x4){bflo(xv.z), bfhi(xv.z), bflo(xv.w), bfhi(xv.w)};
                    const f32x4 y0 = x0 * ALPHA + acc[ai][bj][m][0], y1 = x1 * ALPHA + acc[ai][bj][m][1];
                    v4u w; w.x = cvt_pk_bf16(y0[0], y0[1]); w.y = cvt_pk_bf16(y0[2], y0[3]); w.z = cvt_pk_bf16(y1[0], y1[1]); w.w = cvt_pk_bf16(y1[2], y1[3]);
                    *(v4u*)(Y + off + bj * HALF) = w;
                    sm += ((y0[0] + y0[1]) + (y0[2] + y0[3])) + ((y1[0] + y1[1]) + (y1[2] + y1[3]));
                    sq += ((y0[0] * y0[0] + y0[1] * y0[1]) + (y0[2] * y0[2] + y0[3] * y0[3])) + ((y1[0] * y1[0] + y1[1] * y1[1]) + (y1[2] * y1[2] + y1[3] * y1[3])); }
                sm = sum_fq(sm); sq = sum_fq(sq);
                if (fq == 0) *(f32x2*)(pst + ((size_t)row * 32 + u.pn * 4 + wc) * 2) = (f32x2){sm, sq}; } }
    }
};
struct EpiConvIn {
    static constexpr bool PERM = true;
    bf16* UC; bf16* BGp;
    __device__ __forceinline__ void operator()(const f32x4 (&acc)[2][2][4][2], const Unit& u, int wr, int wc, int fr, int fq) const {
        asm volatile("" : "+v"(fr), "+v"(fq));
        const int row0 = u.pm * BM + wr * 64 + fr, cw = wc * 32 + 8 * fq;
        if (u.pn < 16) {
#pragma unroll
            for (int ai = 0; ai < 2; ++ai)
#pragma unroll
                for (int m = 0; m < 4; ++m) { bf16* rowp = UC + (size_t)(row0 + ai * HALF + m * 16) * D + u.pn * HALF + cw;
                    const f32x4 v0 = acc[ai][0][m][0] * acc[ai][1][m][0], v1 = acc[ai][0][m][1] * acc[ai][1][m][1];
                    v4u w; w.x = cvt_pk_bf16(v0[0], v0[1]); w.y = cvt_pk_bf16(v0[2], v0[3]); w.z = cvt_pk_bf16(v1[0], v1[1]); w.w = cvt_pk_bf16(v1[2], v1[3]);
                    *(v4u*)rowp = w; }
        } else {
#pragma unroll
            for (int ai = 0; ai < 2; ++ai)
#pragma unroll
                for (int m = 0; m < 4; ++m) { bf16* rowp = BGp + (size_t)(row0 + ai * HALF + m * 16) * D + (u.pn - 16) * BM + cw;
#pragma unroll
                    for (int bj = 0; bj < 2; ++bj) { const f32x4 v0 = acc[ai][bj][m][0], v1 = acc[ai][bj][m][1];
                        v4u w; w.x = cvt_pk_bf16(v0[0], v0[1]); w.y = cvt_pk_bf16(v0[2], v0[3]); w.z = cvt_pk_bf16(v1[0], v1[1]); w.w = cvt_pk_bf16(v1[2], v1[3]);
                        *(v4u*)(rowp + bj * HALF) = w; } }
        }
    }
};
__device__ __forceinline__ f32x4 silu_mul(f32x4 g, f32x4 uu) {
    f32x4 r;
#pragma unroll
    for (int j = 0; j < 4; ++j) r[j] = g[j] * __builtin_amdgcn_rcpf(1.0f + __expf(-g[j])) * uu[j];
    return r;
}
struct EpiExpertGU {
    static constexpr bool PERM = true;
    bf16* H;
    __device__ __forceinline__ void operator()(const f32x4 (&acc)[2][2][4][2], const Unit& u, int wr, int wc, int fr, int fq) const {
        asm volatile("" : "+v"(fr), "+v"(fq));
        const float* gates = (const float*)((const char*)u.rows + (WS_LGATE - WS_LTOK));
        const int cw = wc * 32 + 8 * fq;
        float gtv[2][4];
#pragma unroll
        for (int ai = 0; ai < 2; ++ai)
#pragma unroll
            for (int m = 0; m < 4; ++m) { const int r = ai * HALF + wr * 64 + m * 16 + fr; gtv[ai][m] = gates[r < u.nvalid ? r : 0]; }
        asm volatile("" : "+v"(gtv[0][0]), "+v"(gtv[0][1]), "+v"(gtv[0][2]), "+v"(gtv[0][3]), "+v"(gtv[1][0]), "+v"(gtv[1][1]), "+v"(gtv[1][2]), "+v"(gtv[1][3]));
#pragma unroll
        for (int ai = 0; ai < 2; ++ai)
#pragma unroll
            for (int m = 0; m < 4; ++m) { const int r = ai * HALF + wr * 64 + m * 16 + fr;
                if (r < u.nvalid) { const float gt = gtv[ai][m]; const unsigned pid = 0u;
                    const f32x4 v0 = silu_mul(acc[ai][0][m][0], acc[ai][1][m][0]) * gt, v1 = silu_mul(acc[ai][0][m][1], acc[ai][1][m][1]) * gt;
                    v4u w; w.x = cvt_pk_bf16(v0[0], v0[1]); w.y = cvt_pk_bf16(v0[2], v0[3]); w.z = cvt_pk_bf16(v1[0], v1[1]); w.w = cvt_pk_bf16(v1[2], v1[3]);
                    (void)pid; *(v4u*)(H + (size_t)(u.aux + r) * EDIM + cw) = w; } }
    }
};
struct EpiSharedGU {
    static constexpr bool PERM = true;
    bf16* HS;
    __device__ __forceinline__ void operator()(const f32x4 (&acc)[2][2][4][2], const Unit& u, int wr, int wc, int fr, int fq) const {
        asm volatile("" : "+v"(fr), "+v"(fq));
        const int row0 = u.pm * BM + wr * 64 + fr, cw = u.pn * HALF + wc * 32 + 8 * fq;
#pragma unroll
        for (int ai = 0; ai < 2; ++ai)
#pragma unroll
            for (int m = 0; m < 4; ++m) {
                const f32x4 v0 = silu_mul(acc[ai][0][m][0], acc[ai][1][m][0]), v1 = silu_mul(acc[ai][0][m][1], acc[ai][1][m][1]);
                v4u w; w.x = cvt_pk_bf16(v0[0], v0[1]); w.y = cvt_pk_bf16(v0[2], v0[3]); w.z = cvt_pk_bf16(v1[0], v1[1]); w.w = cvt_pk_bf16(v1[2], v1[3]);
                *(v4u*)(HS + (size_t)(row0 + ai * HALF + m * 16) * SDIM + cw) = w; }
    }
};
struct EpiDownY {
    static constexpr bool PERM = true;
    bf16* Y;
    __device__ __forceinline__ void operator()(const f32x4 (&acc)[2][2][4][2], const Unit& u, int wr, int wc, int fr, int fq) const {
        asm volatile("" : "+v"(fr), "+v"(fq));
        const int col0 = u.pn * BM + wc * 32 + 8 * fq;
#pragma unroll
        for (int ai = 0; ai < 2; ++ai)
#pragma unroll
            for (int m = 0; m < 4; ++m) { const int r = ai * HALF + wr * 64 + m * 16 + fr; bf16* rowp = Y + (size_t)(u.aux + r) * D + col0;
#pragma unroll
                for (int bj = 0; bj < 2; ++bj) { const f32x4 v0 = acc[ai][bj][m][0], v1 = acc[ai][bj][m][1];
                    v4u w; w.x = cvt_pk_bf16(v0[0], v0[1]); w.y = cvt_pk_bf16(v0[2], v0[3]); w.z = cvt_pk_bf16(v1[0], v1[1]); w.w = cvt_pk_bf16(v1[2], v1[3]);
                    *(v4u*)(rowp + bj * HALF) = w; } }
    }
};
}

struct Args { const float* in[19]; float* out; unsigned char* ws; int ph_lo, ph_hi; };
struct Frame {
    LAS unsigned char* lds; unsigned* ctl; unsigned char* ws;
    int tid, lane, wave, G, bid;
};
enum { IN_X = 0, IN_RELB, IN_PWIN, IN_PWG, IN_PSC, IN_PWOUT, IN_DQKV, IN_DOUT, IN_CWIN, IN_CW, IN_CWOUT, IN_LNG, IN_LNB, IN_RW, IN_RB, IN_EGU, IN_ED, IN_SGU, IN_SD };

#define CAS __attribute__((address_space(4)))
typedef const CAS unsigned char* KP;
__device__ __forceinline__ const float* ain(KP kp, int i) { return (const float*)((const GAS float* const CAS*)kp)[i]; }
__device__ __forceinline__ float* aout(KP kp) { return (float*)((GAS float* const CAS*)kp)[19]; }
__device__ __forceinline__ void tr_item(const float* W, int K, int N, bf16* WT, int dstK, int mode, LAS float* scr, int item, int lane) {
    const int nblk = N / 32, kb = item / nblk, nb = item % nblk, k0 = 64 * kb, n0 = 32 * nb;
    int r0 = n0;
    if (mode == 1) { const int part = n0 / 2048, j = n0 % 2048; r0 = (part == 0) ? 4096 + j : 256 * (j / 128) + (part == 2 ? 128 : 0) + (j % 128); }
    if (mode == 2) { const int part = n0 / 256, j = n0 % 256; r0 = 256 * (j / 128) + 128 * part + (j % 128); }
    float wv[32];
#pragma unroll
    for (int i = 0; i < 32; ++i) { const int kk = 2 * i + (lane >> 5); wv[i] = __builtin_nontemporal_load(W + (size_t)(k0 + kk) * N + n0 + (lane & 31)); }
#pragma unroll
    for (int i = 0; i < 32; ++i) { const int kk = 2 * i + (lane >> 5); scr[kk * 33 + (lane & 31)] = wv[i]; }
    LDS_WAIT(); asm volatile("" ::: "memory");
    const int c = lane & 7;
#pragma unroll
    for (int j = 0; j < 4; ++j) { const int n = (lane >> 3) + 8 * j; const LAS float* s = scr + (8 * c) * 33 + n;
        v4u o; o.x = pk2(s[0 * 33], s[1 * 33]); o.y = pk2(s[2 * 33], s[3 * 33]); o.z = pk2(s[4 * 33], s[5 * 33]); o.w = pk2(s[6 * 33], s[7 * 33]);
        __builtin_nontemporal_store(o, (v4u*)(WT + (size_t)(r0 + n) * dstK + k0 + 8 * c)); }
    LDS_WAIT(); asm volatile("" ::: "memory");
}
__device__ __forceinline__ void phase_prologue(const Frame& F, KP kp) {
    LAS float* scr = (LAS float*)(F.lds + F.wave * 16384);
    const int gw = F.bid * 8 + F.wave, NGW = F.G * 8;
    constexpr int I0 = 2 * 2048, I1 = 8 * 128, I2 = 2 * 2048, I3 = 4608, I4 = 512, I5 = 6144, I6 = 2048, I7 = 4 * 512, I8 = 4 * 256, I9 = 256 * 256, I10 = 256 * 128;
    constexpr int NITEMS = I0 + I1 + I2 + I3 + I4 + I5 + I6 + I7 + I8 + I9 + I10;
    unsigned char* ws = F.ws;
    for (int it = gw; it < NITEMS; it += NGW) {
        int r = it;
        if (r < I0) { const int b = r / 2048; tr_item(ain(kp, IN_PWIN) + (size_t)b * D * D, D, D, (bf16*)(ws + WS_W_POOL_IN) + (size_t)b * D * D, D, 0, scr, r % 2048, F.lane); continue; } r -= I0;
        if (r < I1) { const int b = r / 128; tr_item(ain(kp, IN_PWG) + (size_t)b * 512 * 512, 512, 512, (bf16*)(ws + WS_W_POOL_G) + (size_t)b * 512 * 512, 512, 0, scr, r % 128, F.lane); continue; } r -= I1;
        if (r < I2) { const int b = r / 2048; tr_item(ain(kp, IN_PWOUT) + (size_t)b * D * D, D, D, (bf16*)(ws + WS_W_POOL_OUT) + (size_t)b * D * D, D, 0, scr, r % 2048, F.lane); continue; } r -= I2;
        if (r < I3) { tr_item(ain(kp, IN_DQKV), D, QKVC, (bf16*)(ws + WS_W_DIL_QKV), D, 0, scr, r, F.lane); continue; } r -= I3;
        if (r < I4) { tr_item(ain(kp, IN_DOUT), DILW, D, (bf16*)(ws + WS_W_DIL_OUT), DILW, 0, scr, r, F.lane); continue; } r -= I4;
        if (r < I5) { tr_item(ain(kp, IN_CWIN), D, 3 * D, (bf16*)(ws + WS_W_CONV_IN), D, 1, scr, r, F.lane); continue; } r -= I5;
        if (r < I6) { tr_item(ain(kp, IN_CWOUT), D, D, (bf16*)(ws + WS_W_CONV_OUT), D, 0, scr, r, F.lane); continue; } r -= I6;
        if (r < I7) { const int b = r / 512; tr_item(ain(kp, IN_SGU) + (size_t)b * D * 512, D, 512, (bf16*)(ws + WS_W_SH_GU) + (size_t)b * 512 * D, D, 2, scr, r % 512, F.lane); continue; } r -= I7;
        if (r < I8) { const int b = r / 256; tr_item(ain(kp, IN_SD) + (size_t)b * SDIM * D, SDIM, D, (bf16*)(ws + WS_W_SH_D) + (size_t)b * D * SDIM, SDIM, 0, scr, r % 256, F.lane); continue; } r -= I8;
        if (r < I9) { const int b = r / 256; tr_item(ain(kp, IN_EGU) + (size_t)b * D * 256, D, 256, (bf16*)(ws + WS_W_EX_GU) + (size_t)b * 256 * D, D, 0, scr, r % 256, F.lane); continue; } r -= I9;
        { const int b = r / 128; tr_item(ain(kp, IN_ED) + (size_t)b * EDIM * D, EDIM, D, (bf16*)(ws + WS_W_EX_D) + (size_t)b * D * EDIM, EDIM, 0, scr, r % 128, F.lane); }
    }
    const size_t gt = (size_t)F.bid * 512 + F.tid, GT = (size_t)F.G * 512;
    { const float* rw = ain(kp, IN_RW); bf16* wh = (bf16*)(ws + WS_RWH); bf16* wl = (bf16*)(ws + WS_RWL);
      for (size_t i = gt; i < (size_t)DEPTH * NEXP * D / 8; i += GT) { const size_t k8 = i % (D / 8), e = (i / (D / 8)) % NEXP, l = i / ((size_t)NEXP * D / 8);
          float v[8]; unsigned hi[8], lo[8];
#pragma unroll
          for (int j = 0; j < 8; ++j) { v[j] = rw[(l * D + k8 * 8 + j) * NEXP + e]; hi[j] = f2bf(v[j]); lo[j] = f2bf(v[j] - __builtin_bit_cast(float, hi[j] << 16)); }
          v4u a, b2; a.x = hi[0] | (hi[1] << 16); a.y = hi[2] | (hi[3] << 16); a.z = hi[4] | (hi[5] << 16); a.w = hi[6] | (hi[7] << 16);
          b2.x = lo[0] | (lo[1] << 16); b2.y = lo[2] | (lo[3] << 16); b2.z = lo[4] | (lo[5] << 16); b2.w = lo[6] | (lo[7] << 16);
          *(v4u*)(wh + (l * NEXP + e) * D + k8 * 8) = a; *(v4u*)(wl + (l * NEXP + e) * D + k8 * 8) = b2; } }
    const float* x = ain(kp, IN_X); bf16* xb = (bf16*)(ws + WS_XB);
    for (size_t i = gt; i < (size_t)T * D / 8; i += GT) { const f32x4 p = __builtin_nontemporal_load((const f32x4*)(x + i * 8)), q = __builtin_nontemporal_load((const f32x4*)(x + i * 8 + 4));
        v4u w; w.x = pk2(p[0], p[1]); w.y = pk2(p[2], p[3]); w.z = pk2(q[0], q[1]); w.w = pk2(q[2], q[3]); *(v4u*)(xb + i * 8) = w; }
}

__device__ __forceinline__ void unpack8(const v4u w, float (&f)[8]) { f[0] = bflo(w.x); f[1] = bfhi(w.x); f[2] = bflo(w.y); f[3] = bfhi(w.y); f[4] = bflo(w.z); f[5] = bfhi(w.z); f[6] = bflo(w.w); f[7] = bfhi(w.w); }
__device__ __forceinline__ void phase_pool(const Frame& F, const bf16* U, bf16* PL) {
    for (int it = F.bid * 512 + F.tid; it < (T / 32) * 256; it += F.G * 512) {
        const int cv = it & 255, ch = it >> 8, col = cv * 8;
        const int w = __builtin_amdgcn_readfirstlane(2 << (col >> 9));
        const int row0 = __builtin_amdgcn_readfirstlane(ch * 32), pos0 = row0 & (SEQ - 1);
        float s[8], uu[8];
#pragma unroll
        for (int j = 0; j < 8; ++j) s[j] = 0.f;
        { v4u pre[15];
#pragma unroll
          for (int j = 0; j < 15; ++j) { pre[j] = (v4u){0u, 0u, 0u, 0u}; if (j + 1 < w && pos0 - (j + 1) >= 0) pre[j] = *(const v4u*)(U + (size_t)(row0 - (j + 1)) * D + col); }
#pragma unroll
          for (int j = 0; j < 15; ++j) asm volatile("" : "+v"(pre[j]));
#pragma unroll
          for (int j = 0; j < 15; ++j) { unpack8(pre[j], uu);
#pragma unroll
              for (int q = 0; q < 8; ++q) s[q] += uu[q]; } }
#pragma unroll 1
        for (int cb = 0; cb < 4; ++cb) {
            v4u un[8], uo[8];
#pragma unroll
            for (int j = 0; j < 8; ++j) { const int r = 8 * cb + j, t = row0 + r, pos = pos0 + r;
                un[j] = *(const v4u*)(U + (size_t)t * D + col);
                uo[j] = (v4u){0u, 0u, 0u, 0u}; if (pos - w + 1 >= 0) uo[j] = *(const v4u*)(U + (size_t)(t - w + 1) * D + col); }
#pragma unroll
            for (int j = 0; j < 8; ++j) asm volatile("" : "+v"(un[j]), "+v"(uo[j]));
#pragma unroll
            for (int j = 0; j < 8; ++j) { const int r = 8 * cb + j, t = row0 + r, pos = pos0 + r;
                unpack8(un[j], uu);
                const float inv = 1.0f / (float)((pos + 1) < w ? (pos + 1) : w);
                float o[8];
#pragma unroll
                for (int q = 0; q < 8; ++q) { s[q] += uu[q]; o[q] = s[q] * inv - uu[q]; }
                v4u ww; ww.x = pk2(o[0], o[1]); ww.y = pk2(o[2], o[3]); ww.z = pk2(o[4], o[5]); ww.w = pk2(o[6], o[7]);
                *(v4u*)(PL + (size_t)t * D + col) = ww;
                unpack8(uo[j], uu);
#pragma unroll
                for (int q = 0; q < 8; ++q) s[q] -= uu[q]; }
        }
    }
}

__device__ __forceinline__ void phase_conv(const Frame& F, const bf16* UC, const bf16* BGp, const float* cw, bf16* Z) {
    for (int it = F.bid * 512 + F.tid; it < (T / 4) * 256; it += F.G * 512) {
        const int cv = it & 255, col = cv * 8, t0 = __builtin_amdgcn_readfirstlane((it >> 8) * 4), pos0 = t0 & (SEQ - 1);
        v4u ur[6], br[4];
#pragma unroll
        for (int j = 0; j < 6; ++j) { ur[j] = (v4u){0u, 0u, 0u, 0u}; if (j >= 2 || pos0 > 0) ur[j] = *(const v4u*)(UC + (size_t)(t0 - 2 + j) * D + col); }
#pragma unroll
        for (int j = 0; j < 4; ++j) br[j] = *(const v4u*)(BGp + (size_t)(t0 + j) * D + col);
        const f32x4 c0a = *(const f32x4*)(cw + col), c0b = *(const f32x4*)(cw + col + 4), c1a = *(const f32x4*)(cw + D + col), c1b = *(const f32x4*)(cw + D + col + 4), c2a = *(const f32x4*)(cw + 2 * D + col), c2b = *(const f32x4*)(cw + 2 * D + col + 4);
        asm volatile("" : "+v"(ur[0]), "+v"(ur[1]), "+v"(ur[2]), "+v"(ur[3]), "+v"(ur[4]), "+v"(ur[5]), "+v"(br[0]), "+v"(br[1]), "+v"(br[2]), "+v"(br[3]));
        const float c0[8] = {c0a[0], c0a[1], c0a[2], c0a[3], c0b[0], c0b[1], c0b[2], c0b[3]}, c1[8] = {c1a[0], c1a[1], c1a[2], c1a[3], c1b[0], c1b[1], c1b[2], c1b[3]}, c2[8] = {c2a[0], c2a[1], c2a[2], c2a[3], c2b[0], c2b[1], c2b[2], c2b[3]};
#pragma unroll
        for (int j = 0; j < 4; ++j) { float u0[8], u1[8], u2[8], bb[8], o[8];
            unpack8(ur[j], u0); unpack8(ur[j + 1], u1); unpack8(ur[j + 2], u2); unpack8(br[j], bb);
#pragma unroll
            for (int q = 0; q < 8; ++q) o[q] = bb[q] * (c0[q] * u0[q] + c1[q] * u1[q] + c2[q] * u2[q]);
            v4u ww; ww.x = pk2(o[0], o[1]); ww.y = pk2(o[2], o[3]); ww.z = pk2(o[4], o[5]); ww.w = pk2(o[6], o[7]);
            *(v4u*)(Z + (size_t)(t0 + j) * D + col) = ww; }
    }
}

__device__ __forceinline__ int t5_bucket(int dist) {
    if (dist < 16) return dist;
    int large = 16 + (int)(logf((float)dist / 16.0f) / logf(128.0f) * 16.0f);
    return large < 31 ? large : 31;
}
constexpr int AT_KS = 0, AT_KSTR = 144, AT_VT = 256 * 144, AT_VSTR = 520, AT_BIAS = AT_VT + 64 * 520;
__device__ __forceinline__ void phase_attn(const Frame& F, const bf16* QKV, const float* relb, bf16* OG, float* LSE) {
    LAS unsigned char* lds = F.lds;
    const int tid = F.tid, lane = F.lane, w = tid >> 6, fr = lane & 15, fq = lane >> 4;
    for (int unit = F.bid; unit < NBATCH * 3 * 8 * 16; unit += F.G) {
        const int cmb = unit & 15, h = (unit >> 4) & 7, g = (unit >> 7) % 3, b = unit / 384;
        const int dsh = 2 * g, dil = 1 << dsh, r = cmb & (dil - 1), nb = cmb >> dsh;
        const bf16* base = QKV + (size_t)b * SEQ * QKVC + g * 1536 + h * 64;
        __syncthreads();
        {
            const int key = tid >> 1, half = tid & 1, jk = (nb - 1) * 128 + key;
            v4u kv[4], vv[4];
            if (jk >= 0) { const bf16* rp = base + (size_t)(jk * dil + r) * QKVC + half * 32;
#pragma unroll
                for (int i = 0; i < 4; ++i) { kv[i] = *(const v4u*)(rp + 512 + 8 * i); vv[i] = *(const v4u*)(rp + 1024 + 8 * i); } }
            else {
#pragma unroll
                for (int i = 0; i < 4; ++i) { kv[i] = (v4u){0u, 0u, 0u, 0u}; vv[i] = (v4u){0u, 0u, 0u, 0u}; } }
#pragma unroll
            for (int i = 0; i < 4; ++i) *(LAS v4u*)(lds + AT_KS + key * AT_KSTR + half * 64 + 16 * i) = kv[i];
#pragma unroll
            for (int i = 0; i < 4; ++i) {
                const unsigned ww[4] = {vv[i].x, vv[i].y, vv[i].z, vv[i].w};
#pragma unroll
                for (int q = 0; q < 4; ++q) { const int d = half * 32 + 8 * i + 2 * q;
                    *(LAS unsigned short*)(lds + AT_VT + d * AT_VSTR + key * 2) = (unsigned short)(ww[q] & 0xffffu);
                    *(LAS unsigned short*)(lds + AT_VT + (d + 1) * AT_VSTR + key * 2) = (unsigned short)(ww[q] >> 16); } }
            if (tid <= 128) ((LAS float*)(lds + AT_BIAS))[tid] = relb[t5_bucket(tid * dil) * 24 + g * 8 + h];
        }
        __syncthreads();
        int qi = 16 * w + fr; asm volatile("" : "+v"(qi));
        const int jq = nb * 128 + qi, tq = jq * dil + r;
        const bf16* qp = base + (size_t)tq * QKVC + 8 * fq;
        const bf16x8 q0 = *(const bf16x8*)qp, q1 = *(const bf16x8*)(qp + 32);
        f32x4 s[9]; float mx = -INFINITY;
#pragma unroll
        for (int kt = 0; kt < 9; ++kt) {
            const int kb = 16 * (w + kt);
            const bf16x8 k0 = *(const LAS bf16x8*)(lds + AT_KS + (kb + fr) * AT_KSTR + fq * 16), k1 = *(const LAS bf16x8*)(lds + AT_KS + (kb + fr) * AT_KSTR + 64 + fq * 16);
            f32x4 a = (f32x4){0.f, 0.f, 0.f, 0.f};
            a = __builtin_amdgcn_mfma_f32_16x16x32_bf16(k0, q0, a, 0, 0, 0);
            a = __builtin_amdgcn_mfma_f32_16x16x32_bf16(k1, q1, a, 0, 0, 0);
#pragma unroll
            for (int i = 0; i < 4; ++i) { const int kl = kb + 4 * fq + i, rel = qi + 128 - kl;
                const bool ok = (rel >= 0) && (rel <= 128) && (nb > 0 || kl >= 128);
                const int rc = rel < 0 ? 0 : (rel > 128 ? 128 : rel);
                float bv_ = ((LAS float*)(lds + AT_BIAS))[rc]; asm volatile("" : "+v"(bv_));
                const float v = ok ? a[i] + bv_ : -INFINITY;
                a[i] = v; mx = fmaxf(mx, v); }
            s[kt] = a;
        }
        mx = max_fq(mx);
        float l = 0.f;
#pragma unroll
        for (int kt = 0; kt < 9; ++kt)
#pragma unroll
            for (int i = 0; i < 4; ++i) { const float p = __expf(s[kt][i] - mx); s[kt][i] = p; l += p; }
        l = sum_fq(l);
        f32x4 o[4];
#pragma unroll
        for (int nt = 0; nt < 4; ++nt) o[nt] = (f32x4){0.f, 0.f, 0.f, 0.f};
#pragma unroll
        for (int st = 0; st < 5; ++st) {
            const int kt0 = 2 * st, kt1 = 2 * st + 1;
            v4u pw; pw.x = pk2(s[kt0][0], s[kt0][1]); pw.y = pk2(s[kt0][2], s[kt0][3]);
            if (kt1 < 9) { pw.z = pk2(s[kt1 < 9 ? kt1 : 0][0], s[kt1 < 9 ? kt1 : 0][1]); pw.w = pk2(s[kt1 < 9 ? kt1 : 0][2], s[kt1 < 9 ? kt1 : 0][3]); } else { pw.z = 0u; pw.w = 0u; }
            const bf16x8 pf = __builtin_bit_cast(bf16x8, pw);
            const int kb0 = 16 * (w + kt0) + 4 * fq, kb1 = 16 * (w + kt1) + 4 * fq;
#pragma unroll
            for (int nt = 0; nt < 4; ++nt) { const int d = 16 * nt + fr;
                v2u va = *(const LAS v2u*)(lds + AT_VT + d * AT_VSTR + kb0 * 2), vb = (v2u){0u, 0u};
                if (kt1 < 9) vb = *(const LAS v2u*)(lds + AT_VT + d * AT_VSTR + kb1 * 2);
                v4u vw; vw.x = va.x; vw.y = va.y; vw.z = vb.x; vw.w = vb.y;
                o[nt] = __builtin_amdgcn_mfma_f32_16x16x32_bf16(__builtin_bit_cast(bf16x8, vw), pf, o[nt], 0, 0, 0); }
        }
        const float il = 1.0f / l;
        bf16* op = OG + ((size_t)g * T + (size_t)b * SEQ + tq) * DILW + h * 64 + 4 * fq;
#pragma unroll
        for (int nt = 0; nt < 4; ++nt) { v2u ww; ww.x = pk2(o[nt][0] * il, o[nt][1] * il); ww.y = pk2(o[nt][2] * il, o[nt][3] * il); *(v2u*)(op + 16 * nt) = ww; }
        if (fq == 0) LSE[((size_t)g * T + (size_t)b * SEQ + tq) * 8 + h] = mx + logf(l);
    }
}
__device__ __forceinline__ void phase_combine(const Frame& F, const bf16* OG, const float* LSE, bf16* O) {
    for (int it0 = F.bid * 512 + F.tid; it0 < T * 64; it0 += 4 * F.G * 512) {
        float ls[4][3]; v4u og[4][3];
#pragma unroll
        for (int u = 0; u < 4; ++u) { int it = it0 + u * F.G * 512; it = it < T * 64 ? it : it0;
            const int c8 = it & 7, h = (it >> 3) & 7, t = it >> 6; const size_t off = (size_t)t * DILW + h * 64 + c8 * 8;
#pragma unroll
            for (int g = 0; g < 3; ++g) { ls[u][g] = LSE[((size_t)g * T + t) * 8 + h]; og[u][g] = *(const v4u*)(OG + (size_t)g * T * DILW + off); } }
#pragma unroll
        for (int u = 0; u < 4; ++u) asm volatile("" : "+v"(ls[u][0]), "+v"(ls[u][1]), "+v"(ls[u][2]), "+v"(og[u][0]), "+v"(og[u][1]), "+v"(og[u][2]));
#pragma unroll
        for (int u = 0; u < 4; ++u) { const int it = it0 + u * F.G * 512, c8 = it & 7, h = (it >> 3) & 7, t = it >> 6; const size_t off = (size_t)t * DILW + h * 64 + c8 * 8;
            if (it >= T * 64) continue;
            const float l0 = ls[u][0], l1 = ls[u][1], l2 = ls[u][2];
            const float m = fmaxf(l0, fmaxf(l1, l2)); float w0 = __expf(l0 - m), w1 = __expf(l1 - m), w2 = __expf(l2 - m); const float inv = 1.0f / (w0 + w1 + w2); w0 *= inv; w1 *= inv; w2 *= inv;
            float a[8], bq[8], c[8], o[8];
            unpack8(og[u][0], a); unpack8(og[u][1], bq); unpack8(og[u][2], c);
#pragma unroll
            for (int q = 0; q < 8; ++q) o[q] = w0 * a[q] + w1 * bq[q] + w2 * c[q];
            v4u ww; ww.x = pk2(o[0], o[1]); ww.y = pk2(o[2], o[3]); ww.z = pk2(o[4], o[5]); ww.w = pk2(o[6], o[7]);
            *(v4u*)(O + off) = ww; }
    }
}

constexpr int M1_LOG = 131072, M1_STAT = M1_LOG + 4096, M1_HIST = M1_STAT + 128, M1_BASE = M1_HIST + 256;
__device__ __forceinline__ void phase_moe1(const Frame& F, const float* Y, const float* gain, const float* bias, const float* RW, const float* RB,
                                           float* X1F, bf16* X1B, unsigned* cnt, int* ltok, float* lgate, int* eidx, int* inv) {
    LAS float* xs = (LAS float*)F.lds; LAS float* logit = (LAS float*)(F.lds + M1_LOG); LAS float* stat = (LAS float*)(F.lds + M1_STAT);
    LAS int* hist = (LAS int*)(F.lds + M1_HIST); LAS int* basep = (LAS int*)(F.lds + M1_BASE);
    const int tid = F.tid, lane = F.lane, w = F.wave;
    for (int rg = F.bid; rg < T / 16; rg += F.G) {
        const int row0 = rg * 16;
        __syncthreads();
#pragma unroll
        for (int j = 0; j < 16; ++j) { const int idx = tid + 512 * j; *(LAS f32x4*)(xs + idx * 4) = *(const f32x4*)(Y + (size_t)row0 * D + (size_t)idx * 4); }
        if (tid < 64) hist[tid] = 0;
        __syncthreads();
#pragma unroll
        for (int rr = 0; rr < 2; ++rr) { const int r = 2 * w + rr; float sm = 0.f;
#pragma unroll
            for (int j = 0; j < 32; ++j) sm += xs[r * D + lane + 64 * j];
            const float mean = wave_sum(sm, lane) * (1.0f / D); float sq = 0.f;
#pragma unroll
            for (int j = 0; j < 32; ++j) { const float d = xs[r * D + lane + 64 * j] - mean; sq += d * d; }
            const float rstd = 1.0f / sqrtf(wave_sum(sq, lane) * (1.0f / D) + LN_EPS);
            if (lane == 0) { stat[2 * r] = mean; stat[2 * r + 1] = rstd; } }
        __syncthreads();
#pragma unroll
        for (int j = 0; j < 16; ++j) { const int idx = tid + 512 * j, r = idx >> 9, c4 = (idx & 511) * 4;
            const f32x4 v = *(LAS f32x4*)(xs + idx * 4), gv = *(const f32x4*)(gain + c4), bv = *(const f32x4*)(bias + c4);
            const float mean = stat[2 * r], rstd = stat[2 * r + 1];
            const f32x4 o = (v - mean) * rstd * gv + bv;
            *(LAS f32x4*)(xs + idx * 4) = o;
            *(f32x4*)(X1F + (size_t)(row0 + r) * D + c4) = o;
            v2u wb; wb.x = pk2(o[0], o[1]); wb.y = pk2(o[2], o[3]); *(v2u*)(X1B + (size_t)(row0 + r) * D + c4) = wb; }
        __syncthreads();
        { const int r = tid >> 5, ep = tid & 31; float a0 = 0.f, a1 = 0.f; const float* wp = RW + 2 * ep; const LAS float* xr = xs + r * D;
            for (int k0 = 0; k0 < D; k0 += 16) {
                f32x2 wv[16];
#pragma unroll
                for (int j = 0; j < 16; ++j) wv[j] = *(const f32x2*)(wp + (size_t)(k0 + j) * NEXP);
                asm volatile("" : "+v"(wv[0]), "+v"(wv[1]), "+v"(wv[2]), "+v"(wv[3]), "+v"(wv[4]), "+v"(wv[5]), "+v"(wv[6]), "+v"(wv[7]));
                asm volatile("" : "+v"(wv[8]), "+v"(wv[9]), "+v"(wv[10]), "+v"(wv[11]), "+v"(wv[12]), "+v"(wv[13]), "+v"(wv[14]), "+v"(wv[15]));
#pragma unroll
                for (int j = 0; j < 16; ++j) { const float xv = xr[k0 + j]; a0 += xv * wv[j].x; a1 += xv * wv[j].y; } }
            logit[r * NEXP + 2 * ep] = a0; logit[r * NEXP + 2 * ep + 1] = a1; }
        __syncthreads();
        int sel_pos[2]; float sel_gate[2]; int sel_rank[2]; bool sel_on[2];
#pragma unroll
        for (int rr = 0; rr < 2; ++rr) { const int r = 2 * w + rr;
            const float sc = 1.0f / (1.0f + __expf(-logit[r * NEXP + lane])); const float ch = sc + RB[lane];
            int rk = 0;
#pragma unroll
            for (int j = 0; j < 8; ++j) { const float cj = shfl_from(ch, (lane & ~7) + j); rk += (cj > ch || (cj == ch && j < (lane & 7))) ? 1 : 0; }
            float gs = rk < 2 ? ch : 0.f; gs += shfl_x(gs, 1, lane); gs += shfl_x(gs, 2, lane); gs += shfl_x(gs, 4, lane);
            int grk = 0; const int g = lane >> 3;
#pragma unroll
            for (int hh = 0; hh < 8; ++hh) { const float gh = shfl_from(gs, 8 * hh); grk += (gh > gs || (gh == gs && hh < g)) ? 1 : 0; }
            const float msk = grk < 4 ? ch : -INFINITY;
            int erk = 0;
            for (int j = 0; j < 64; ++j) { const float mj = __builtin_bit_cast(float, __builtin_amdgcn_readlane(__builtin_bit_cast(int, msk), j)); erk += (mj > msk || (mj == msk && j < lane)) ? 1 : 0; }
            const bool on = erk < 8;
            const float ssum = wave_sum(on ? sc : 0.f, lane);
            sel_on[rr] = on; sel_rank[rr] = erk; sel_gate[rr] = sc / ssum * 2.5f; sel_pos[rr] = 0;
            if (on) sel_pos[rr] = __hip_atomic_fetch_add(&hist[lane], 1, __ATOMIC_RELAXED, __HIP_MEMORY_SCOPE_WORKGROUP); }
        __syncthreads();
        if (tid < 64) { const int hc = hist[tid]; int bs = 0; if (hc > 0) bs = (int)atomicAdd(&cnt[tid * 16], (unsigned)hc); basep[tid] = bs; }
        __syncthreads();
#pragma unroll
        for (int rr = 0; rr < 2; ++rr) if (sel_on[rr]) { const int t = row0 + 2 * w + rr, pos = basep[lane] + sel_pos[rr];
            ltok[(size_t)lane * CAP + pos] = t; lgate[(size_t)lane * CAP + pos] = sel_gate[rr];
            eidx[t * 8 + sel_rank[rr]] = lane; inv[t * 8 + sel_rank[rr]] = pos; }
    }
}
__device__ __forceinline__ int build_tiles(const Frame& F, const unsigned* cnt) {
    LAS int* tpref = (LAS int*)(F.lds + LDS_TAB); LAS int* cl = (LAS int*)(F.lds + LDS_TAB + 512);
    __syncthreads();
    if (F.tid < 64) {
        const int lane = F.lane; const int c = (int)__hip_atomic_load(&cnt[lane * 16], __ATOMIC_RELAXED, __HIP_MEMORY_SCOPE_AGENT);
        const int tl = (c + 255) >> 8; int inc = tl;
#pragma unroll
        for (int o = 1; o < 64; o <<= 1) { const int v = __builtin_amdgcn_ds_bpermute((lane >= o ? lane - o : lane) << 2, inc); inc += lane >= o ? v : 0; }
        cl[lane] = c; tpref[lane] = inc - tl;
        if (lane == 63) { tpref[64] = inc; tpref[65] = inc + T / 256; tpref[66] = inc + 2 * (T / 256); cl[64] = T; cl[65] = T; } }
    __syncthreads();
    return __builtin_amdgcn_readfirstlane(tpref[64]);
}
__device__ __forceinline__ void phase_moe4(const Frame& F, const float* Y2, const bf16* Yr, const int* eidx, const int* inv, const float* gain, const float* bias, float* XO, bf16* XBo) {
    const LAS int* tpref = (const LAS int*)(F.lds + LDS_TAB);
    const int gw = F.bid * 8 + F.wave, NGW = F.G * 8, lane = F.lane;
    for (int t = gw; t < T; t += NGW) {
        f32x4 v[8];
#pragma unroll
        for (int j = 0; j < 8; ++j) v[j] = *(const f32x4*)(Y2 + (size_t)t * D + 4 * lane + 256 * j);
        for (int k = 0; k < 8; ++k) { const int e = eidx[t * 8 + k], pos = inv[t * 8 + k]; const bf16* yr = Yr + (size_t)(tpref[e] * 256 + pos) * D + 4 * lane;
#pragma unroll
            for (int j = 0; j < 8; ++j) { const v2u w = *(const v2u*)(yr + 256 * j); v[j][0] += bflo(w.x); v[j][1] += bfhi(w.x); v[j][2] += bflo(w.y); v[j][3] += bfhi(w.y); } }
        float sm = 0.f;
#pragma unroll
        for (int j = 0; j < 8; ++j) sm += (v[j][0] + v[j][1]) + (v[j][2] + v[j][3]);
        const float mean = wave_sum(sm, lane) * (1.0f / D); float sq = 0.f;
#pragma unroll
        for (int j = 0; j < 8; ++j) { v[j] = v[j] - mean; sq += (v[j][0] * v[j][0] + v[j][1] * v[j][1]) + (v[j][2] * v[j][2] + v[j][3] * v[j][3]); }
        const float rstd = 1.0f / sqrtf(wave_sum(sq, lane) * (1.0f / D) + LN_EPS);
#pragma unroll
        for (int j = 0; j < 8; ++j) { const int c = 4 * lane + 256 * j; const f32x4 o = v[j] * rstd * *(const f32x4*)(gain + c) + *(const f32x4*)(bias + c);
            *(f32x4*)(XO + (size_t)t * D + c) = o;
            v2u wb; wb.x = pk2(o[0], o[1]); wb.y = pk2(o[2], o[3]); *(v2u*)(XBo + (size_t)t * D + c) = wb; }
    }
}


template <int CTRL> __device__ __forceinline__ float dppf(float x) { return __builtin_bit_cast(float, __builtin_amdgcn_update_dpp(0, __builtin_bit_cast(int, x), CTRL, 0xF, 0xF, false)); }
__device__ __forceinline__ float gmax8(float x) { x = fmaxf(x, dppf<0xB1>(x)); x = fmaxf(x, dppf<0x4E>(x)); x = fmaxf(x, dppf<0x141>(x)); return x; }
__device__ __forceinline__ float gsum8(float x) { x += dppf<0xB1>(x); x += dppf<0x4E>(x); x += dppf<0x141>(x); return x; }
__device__ __forceinline__ float rl_f(float x, int l) { return __builtin_bit_cast(float, __builtin_amdgcn_readlane(__builtin_bit_cast(int, x), l)); }
constexpr int M1_P = 0, M1N_HIST = 131072, M1N_BASE = 131072 + 256, M1N_GB = 131072 + 1024;
__device__ __forceinline__ void phase_moe1n(const Frame& F, const bf16* Y, const float* pst, const float* gain, const float* bias, const bf16* WH, const bf16* WL, const float* RB,
                                            bf16* X1B, float* ST1, unsigned* cnt, int* ltok, float* lgate, int* eidx, int* inv) {
    LAS float* P = (LAS float*)(F.lds + M1_P); LAS int* hist = (LAS int*)(F.lds + M1N_HIST); LAS int* basep = (LAS int*)(F.lds + M1N_BASE);
    const int tid = F.tid, lane = F.lane, w = F.wave, r = lane & 15, q = lane >> 4;
    for (int item = F.bid; item < T / 64; item += F.G) {
        const int row0 = item * 64;
        __syncthreads();
        { int t0 = tid; asm volatile("" : "+v"(t0));
          if (t0 < 64) hist[t0] = 0;
          LAS f32x4* gb = (LAS f32x4*)(F.lds + M1N_GB); gb[t0] = *(const f32x4*)(gain + 4 * t0); gb[512 + t0] = *(const f32x4*)(bias + 4 * t0); }
        __syncthreads();
        float mean[4], rstd[4];
#pragma unroll
        for (int rt = 0; rt < 4; ++rt) { const int row = row0 + 16 * rt + r;
          const f32x4* pp = (const f32x4*)(pst + ((size_t)row * 32 + q * 8) * 2); const f32x4 a = pp[0], b = pp[1], c = pp[2], d = pp[3];
          float sm = (a[0] + a[2]) + (b[0] + b[2]) + (c[0] + c[2]) + (d[0] + d[2]), sq = (a[1] + a[3]) + (b[1] + b[3]) + (c[1] + c[3]) + (d[1] + d[3]);
          sm = sum_fq(sm); sq = sum_fq(sq);
          mean[rt] = sm * (1.0f / D); const float var = fmaxf(sq * (1.0f / D) - mean[rt] * mean[rt], 0.f); rstd[rt] = 1.0f / sqrtf(var + LN_EPS);
          if (w == 0 && q == 0) *(f32x2*)(ST1 + 2 * row) = (f32x2){mean[rt], rstd[rt]}; }
        const int kb = 256 * w + 8 * q;
        const LAS float* gl = (const LAS float*)(F.lds + M1N_GB) + kb;
        f32x4 acc[4][4];
#pragma unroll
        for (int rt = 0; rt < 4; ++rt)
#pragma unroll
            for (int nt = 0; nt < 4; ++nt) acc[rt][nt] = (f32x4){0.f, 0.f, 0.f, 0.f};
        v4u yb[2][2][4], hb[4]; bf16x8 wh[4], wl[4];
        unsigned vo[4];
#pragma unroll
        for (int i = 0; i < 4; ++i) { vo[i] = (unsigned)(r * D + kb) * 2u + (unsigned)i * (16u * D * 2u); asm volatile("" : "+v"(vo[i])); }
        const char* ybase = (const char*)(Y + (size_t)row0 * D); char* xbase = (char*)(X1B + (size_t)row0 * D);
#define M1_LOADY(ms) do { _Pragma("unroll") for (int hf = 0; hf < 2; ++hf) _Pragma("unroll") for (int rt = 0; rt < 4; ++rt) yb[(ms) & 1][hf][rt] = *(const v4u*)(ybase + vo[rt] + 128 * (ms) + 64 * hf); } while (0)
#define M1_LOADW(st) do { _Pragma("unroll") for (int nt = 0; nt < 4; ++nt) { wh[nt] = *(const bf16x8*)((const char*)WH + vo[nt] + 64 * (st)); wl[nt] = *(const bf16x8*)((const char*)WL + vo[nt] + 64 * (st)); } } while (0)
        M1_LOADY(0); M1_LOADW(0); M1_LOADY(1);
        __builtin_amdgcn_sched_barrier(0);
#pragma unroll
        for (int st = 0; st < 8; ++st) {
            const f32x4 g0 = *(const LAS f32x4*)(gl + 32 * st), g1 = *(const LAS f32x4*)(gl + 32 * st + 4), b0 = *(const LAS f32x4*)(gl + 2048 + 32 * st), b1 = *(const LAS f32x4*)(gl + 2048 + 32 * st + 4);
#pragma unroll
            for (int rt = 0; rt < 4; ++rt) { const v4u yv = yb[(st >> 1) & 1][st & 1][rt];
                const f32x4 y0_ = (f32x4){bflo(yv.x), bfhi(yv.x), bflo(yv.y), bfhi(yv.y)}, y1_ = (f32x4){bflo(yv.z), bfhi(yv.z), bflo(yv.w), bfhi(yv.w)};
                const f32x4 x0 = (y0_ - mean[rt]) * rstd[rt] * g0 + b0, x1 = (y1_ - mean[rt]) * rstd[rt] * g1 + b1;
                v4u h; h.x = cvt_pk_bf16(x0[0], x0[1]); h.y = cvt_pk_bf16(x0[2], x0[3]); h.z = cvt_pk_bf16(x1[0], x1[1]); h.w = cvt_pk_bf16(x1[2], x1[3]);
                if ((st & 1) == 0) hb[rt] = h; else { *(v4u*)(xbase + vo[rt] + 64 * (st - 1)) = hb[rt]; *(v4u*)(xbase + vo[rt] + 64 * st) = h; }
                v4u l; l.x = cvt_pk_bf16(x0[0] - bflo(h.x), x0[1] - bfhi(h.x)); l.y = cvt_pk_bf16(x0[2] - bflo(h.y), x0[3] - bfhi(h.y));
                l.z = cvt_pk_bf16(x1[0] - bflo(h.z), x1[1] - bfhi(h.z)); l.w = cvt_pk_bf16(x1[2] - bflo(h.w), x1[3] - bfhi(h.w));
                const bf16x8 xh = __builtin_bit_cast(bf16x8, h), xl = __builtin_bit_cast(bf16x8, l);
#pragma unroll
                for (int nt = 0; nt < 4; ++nt) { acc[rt][nt] = __builtin_amdgcn_mfma_f32_16x16x32_bf16(xh, wh[nt], acc[rt][nt], 0, 0, 0);
                    acc[rt][nt] = __builtin_amdgcn_mfma_f32_16x16x32_bf16(xl, wh[nt], acc[rt][nt], 0, 0, 0); acc[rt][nt] = __builtin_amdgcn_mfma_f32_16x16x32_bf16(xh, wl[nt], acc[rt][nt], 0, 0, 0); } }
            __builtin_amdgcn_sched_barrier(0);
            if (st + 1 < 8) M1_LOADW(st + 1);
            if ((st & 1) == 1 && (st >> 1) + 2 < 4) M1_LOADY((st >> 1) + 2);
            __builtin_amdgcn_sched_barrier(0);
        }
#undef M1_LOADY
#undef M1_LOADW
#pragma unroll
        for (int rt = 0; rt < 4; ++rt)
#pragma unroll
            for (int nt = 0; nt < 4; ++nt)
#pragma unroll
                for (int i = 0; i < 4; ++i) P[(w * 64 + 16 * rt + 4 * q + i) * 64 + 16 * nt + r] = acc[rt][nt][i];
        __syncthreads();
        const float rb = RB[lane];
        LAS int* Pi = (LAS int*)P;
#pragma unroll 1
        for (int rr = 0; rr < 8; ++rr) { const int rl = 8 * w + rr;
            float lg = ((P[rl * 64 + lane] + P[(64 + rl) * 64 + lane]) + (P[(128 + rl) * 64 + lane] + P[(192 + rl) * 64 + lane])) + ((P[(256 + rl) * 64 + lane] + P[(320 + rl) * 64 + lane]) + (P[(384 + rl) * 64 + lane] + P[(448 + rl) * 64 + lane]));
            lg = (lg == lg) ? lg : -1.0e30f;
            const float sc = 1.0f / (1.0f + __expf(-lg)); const float ch = sc + rb;
            const float m1 = gmax8(ch), neq = gsum8(ch == m1 ? 1.f : 0.f), m2c = gmax8(ch < m1 ? ch : -INFINITY);
            const float gs = m1 + (neq >= 2.f ? m1 : m2c);
            int grk = 0; const int g = lane >> 3;
#pragma unroll
            for (int hh = 0; hh < 8; ++hh) { const float gh = rl_f(gs, 8 * hh); grk += (gh > gs || (gh == gs && hh < g)) ? 1 : 0; }
            const float msk = grk < 4 ? ch : -INFINITY;
            float cur = msk, ssum = 0.f; int erk = 64;
#pragma unroll 1
            for (int k = 0; k < 8; ++k) {
                float rm = gmax8(cur); rm = fmaxf(rm, dppf<0x140>(rm));
                const float wm = fmaxf(fmaxf(rl_f(rm, 0), rl_f(rm, 16)), fmaxf(rl_f(rm, 32), rl_f(rm, 48)));
                const unsigned long long bal = __builtin_amdgcn_ballot_w64(cur == wm);
                const int lsel = __builtin_amdgcn_readfirstlane((int)__builtin_ctzll(bal));
                ssum += rl_f(sc, lsel);
                const bool me = lane == lsel; erk = me ? k : erk; cur = me ? -INFINITY : cur; }
            const bool on = erk < 8;
            int pk_ = -1; if (on) pk_ = __hip_atomic_fetch_add(&hist[lane], 1, __ATOMIC_RELAXED, __HIP_MEMORY_SCOPE_WORKGROUP) | (erk << 16);
            P[rl * 64 + lane] = sc / ssum * 2.5f; Pi[(64 + rl) * 64 + lane] = pk_; }
        __syncthreads();
        if (tid < 64) { int tt = tid; asm volatile("" : "+v"(tt));
            const int hc = hist[tt]; int bs = 0; if (hc > 0) bs = (int)atomicAdd(&cnt[tt * 16], (unsigned)hc); basep[tt] = bs; }
        __syncthreads();
        { const int bl = basep[lane];
#pragma unroll 1
          for (int rr = 0; rr < 8; ++rr) { const int rl = 8 * w + rr; const int pk_ = Pi[(64 + rl) * 64 + lane]; const float gt_ = P[rl * 64 + lane];
            if (pk_ >= 0) { const int t = row0 + rl, pos = bl + (pk_ & 0xffff), rk_ = pk_ >> 16;
                ltok[(size_t)lane * CAP + pos] = t * 8 + rk_; lgate[(size_t)lane * CAP + pos] = gt_;
                eidx[t * 8 + rk_] = lane; inv[t * 8 + rk_] = pos; } } }
    }
}

constexpr int M3_PL = 131072, M3_CNT = 147456, M3_OFF = 147456 + 272;
__device__ __forceinline__ void phase_moe3n(const Frame& F, const bf16* H, const bf16* HSp, const int* eidx, const bf16* WD, const bf16* WSD,
                                            const float* Y1, const float* ST1, const float* g1, const float* b1, float* Y2, float* PST2) {
    LAS int* out = (LAS int*)F.lds; LAS unsigned short* plist = (LAS unsigned short*)(F.lds + M3_PL); LAS int* cnt = (LAS int*)(F.lds + M3_CNT); LAS int* off = (LAS int*)(F.lds + M3_OFF);
    const int tid = F.tid, lane = F.lane, w = F.wave, r = lane & 15, q = lane >> 4;
    for (int u = F.bid; u < 1024; u += F.G) {
        int nc = (u & 7) | ((u >> 7) << 3), tb = (u >> 3) & 15;
        if (F.G == 256) { const int i = u >> 8, x = u & 7, j = (u >> 3) & 31; tb = 2 * x + (i >> 1); nc = 32 * (i & 1) + j; }
        __syncthreads();
#pragma unroll
        for (int j = 0; j < 16; ++j) ((LAS v4u*)out)[tid + 512 * j] = (v4u){0u, 0u, 0u, 0u};
        if (tid < 66) cnt[tid] = 0;
        __syncthreads();
        int ee[16], pp[16];
        { const v4u* ep = (const v4u*)(eidx + ((size_t)tb * 1024 + 2 * tid) * 8); const v4u e0 = ep[0], e1 = ep[1], e2 = ep[2], e3 = ep[3];
          ee[0] = e0.x; ee[1] = e0.y; ee[2] = e0.z; ee[3] = e0.w; ee[4] = e1.x; ee[5] = e1.y; ee[6] = e1.z; ee[7] = e1.w;
          ee[8] = e2.x; ee[9] = e2.y; ee[10] = e2.z; ee[11] = e2.w; ee[12] = e3.x; ee[13] = e3.y; ee[14] = e3.z; ee[15] = e3.w; }
#pragma unroll
        for (int j = 0; j < 16; ++j) pp[j] = __hip_atomic_fetch_add(&cnt[ee[j]], 1, __ATOMIC_RELAXED, __HIP_MEMORY_SCOPE_WORKGROUP);
        __syncthreads();
        if (w == 0) { int c = cnt[lane], x = c;
#pragma unroll
            for (int o = 1; o < 64; o <<= 1) { const int y = __builtin_amdgcn_ds_bpermute(((lane - o) & 63) << 2, x); if (lane >= o) x += y; }
            off[lane] = x - c; if (lane == 63) off[64] = x; }
        __syncthreads();
#pragma unroll
        for (int j = 0; j < 16; ++j) plist[off[ee[j]] + pp[j]] = (unsigned short)(tid * 16 + j);
        __syncthreads();
        const char* Hb = (const char*)H + (size_t)tb * 8192 * 256 + q * 16;
        const char* HSb = (const char*)HSp + (size_t)tb * 1024 * 512 + q * 16;
        const char* Bb = (const char*)WD + ((size_t)nc * 32 + r) * 256 + q * 16;
        const char* BSb = (const char*)WSD + ((size_t)nc * 32 + r) * 512 + q * 16;
#define M3_NR(sg) ((sg) < 8 ? __builtin_amdgcn_readfirstlane(cnt[w + 8 * (sg)]) : 128)
#define M3_RB(sg) ((sg) < 8 ? __builtin_amdgcn_readfirstlane(off[w + 8 * (sg)]) : 0)
#define M3_GLD(dst, ptr, OFF) asm volatile("global_load_dwordx4 %0, %1, off offset:" #OFF : "=&v"(dst) : "v"(ptr) : "memory")
#define M3_LOADB(dst, sg) do { const char* _b0 = (sg) < 8 ? Bb + (size_t)(w + 8 * (sg)) * 524288 : BSb + ((sg) - 8) * 256; const char* _b1 = _b0 + ((sg) < 8 ? 4096 : 8192); \
            M3_GLD(dst[0][0], _b0, 0); M3_GLD(dst[0][1], _b0, 64); M3_GLD(dst[0][2], _b0, 128); M3_GLD(dst[0][3], _b0, 192); \
            M3_GLD(dst[1][0], _b1, 0); M3_GLD(dst[1][1], _b1, 64); M3_GLD(dst[1][2], _b1, 128); M3_GLD(dst[1][3], _b1, 192); } while (0)
#define M3_LOADA(dst, sg, bb, nr, rbs) do { int _i = 16 * (bb) + r; _i = _i < (nr) ? _i : (nr) - 1; const unsigned _rid = plist[(rbs) + _i]; \
            const char* _a = (sg) < 8 ? Hb + (size_t)_rid * 256 : ((sg) < 10 ? HSb + (size_t)(128 * w + _i) * 512 + ((sg) - 8) * 256 : Hb); \
            M3_GLD(dst[0], _a, 0); M3_GLD(dst[1], _a, 64); M3_GLD(dst[2], _a, 128); M3_GLD(dst[3], _a, 192); } while (0)
#define M3_ADV(sg, bb, nr, rbs) do { if ((sg) < 10) { ++(bb); if ((bb) * 16 >= (nr)) { (bb) = 0; do { ++(sg); } while ((sg) < 8 && M3_NR(sg) == 0); if ((sg) < 10) { (nr) = M3_NR(sg); (rbs) = M3_RB(sg); } } } } while (0)
#define M3_WAITA(AS) asm volatile("s_waitcnt vmcnt(12)" : "+v"(AS[0]), "+v"(AS[1]), "+v"(AS[2]), "+v"(AS[3]) :: "memory")
#define M3_WAITB(N) asm volatile("s_waitcnt vmcnt(" #N ")" : "+v"(Bn[0][0]), "+v"(Bn[0][1]), "+v"(Bn[0][2]), "+v"(Bn[0][3]), "+v"(Bn[1][0]), "+v"(Bn[1][1]), "+v"(Bn[1][2]), "+v"(Bn[1][3]) :: "memory")
#define M3_STEP(AS) if (cseg < 10) { \
              \
            int tk[4]; bool ok[4]; unsigned pl[4]; const int rt_ = cseg < 8; \
            _Pragma("unroll") for (int i = 0; i < 4; ++i) { const int idx = 16 * cbt + 4 * q + i; ok[i] = idx < cnr; const int ic = ok[i] ? idx : cnr - 1; pl[i] = plist[crbs + ic]; tk[i] = 128 * w + ic; } \
            _Pragma("unroll") for (int i = 0; i < 4; ++i) tk[i] = rt_ ? (int)(pl[i] >> 3) : tk[i]; \
            M3_WAITA(AS); \
            f32x4 acc[2]; \
            _Pragma("unroll") for (int nt = 0; nt < 2; ++nt) { acc[nt] = (f32x4){0.f, 0.f, 0.f, 0.f}; \
                _Pragma("unroll") for (int kk = 0; kk < 4; ++kk) acc[nt] = __builtin_amdgcn_mfma_f32_16x16x32_bf16(__builtin_bit_cast(bf16x8, AS[kk]), __builtin_bit_cast(bf16x8, Bc[nt][kk]), acc[nt], 0, 0, 0); } \
              \
            _Pragma("unroll") for (int i = 0; i < 4; ++i) { const long long lo_ = ok[i] ? (long long)__float2int_rn(acc[0][i] * 4194304.0f) : 0ll, hi_ = ok[i] ? (long long)__float2int_rn(acc[1][i] * 4194304.0f) : 0ll; \
                (void)__hip_atomic_fetch_add((LAS unsigned long long*)out + tk[i] * 16 + r, (unsigned long long)((hi_ << 32) + lo_), __ATOMIC_RELAXED, __HIP_MEMORY_SCOPE_WORKGROUP); } \
            M3_LOADA(AS, pseg, pbt, pnr, prbs); M3_ADV(pseg, pbt, pnr, prbs); \
            { const int old_ = cseg, nbat_ = (cnr + 15) >> 4; M3_ADV(cseg, cbt, cnr, crbs); \
              if (cseg != old_ && cseg < 10) { \
                  if (nbat_ == 1) M3_WAITB(4); else if (nbat_ == 2) M3_WAITB(8); else if (nbat_ == 3) M3_WAITB(12); else M3_WAITB(16); \
                  _Pragma("unroll") for (int nt = 0; nt < 2; ++nt) _Pragma("unroll") for (int kk = 0; kk < 4; ++kk) Bc[nt][kk] = Bn[nt][kk]; \
                  int nb_ = cseg; do { ++nb_; } while (nb_ < 8 && M3_NR(nb_) == 0); if (nb_ >= 10) nb_ = 9; M3_LOADB(Bn, nb_); } } }
        int cseg = -1, cbt = 0, cnr = 0, crbs = 0;
        do { ++cseg; } while (cseg < 8 && M3_NR(cseg) == 0);
        cnr = M3_NR(cseg); crbs = M3_RB(cseg);
        int pseg = cseg, pbt = 0, pnr = cnr, prbs = crbs;
        v4u Bc[2][4], Bn[2][4], A0[4], A1[4], A2[4], A3[4];
        M3_LOADB(Bc, cseg);
        M3_LOADA(A0, pseg, pbt, pnr, prbs); M3_ADV(pseg, pbt, pnr, prbs);
        M3_LOADA(A1, pseg, pbt, pnr, prbs); M3_ADV(pseg, pbt, pnr, prbs);
        M3_LOADA(A2, pseg, pbt, pnr, prbs); M3_ADV(pseg, pbt, pnr, prbs);
        M3_LOADA(A3, pseg, pbt, pnr, prbs); M3_ADV(pseg, pbt, pnr, prbs);
        { int nb_ = cseg; do { ++nb_; } while (nb_ < 8 && M3_NR(nb_) == 0); if (nb_ >= 10) nb_ = 9; M3_LOADB(Bn, nb_); }
        asm volatile("s_waitcnt vmcnt(0)" : "+v"(Bc[0][0]), "+v"(Bc[0][1]), "+v"(Bc[0][2]), "+v"(Bc[0][3]), "+v"(Bc[1][0]), "+v"(Bc[1][1]), "+v"(Bc[1][2]), "+v"(Bc[1][3]) :: "memory");
#pragma unroll 1
        while (cseg < 10) { M3_STEP(A0) M3_STEP(A1) M3_STEP(A2) M3_STEP(A3) }
        asm volatile("s_waitcnt vmcnt(0)" : "+v"(A0[0]), "+v"(A0[1]), "+v"(A0[2]), "+v"(A0[3]), "+v"(A1[0]), "+v"(A1[1]), "+v"(A1[2]), "+v"(A1[3]), "+v"(A2[0]), "+v"(A2[1]), "+v"(A2[2]), "+v"(A2[3]),
                     "+v"(A3[0]), "+v"(A3[1]), "+v"(A3[2]), "+v"(A3[3]), "+v"(Bn[0][0]), "+v"(Bn[0][1]), "+v"(Bn[0][2]), "+v"(Bn[0][3]), "+v"(Bn[1][0]), "+v"(Bn[1][1]), "+v"(Bn[1][2]), "+v"(Bn[1][3]) :: "memory");
#undef M3_NR
#undef M3_RB
#undef M3_GLD
#undef M3_LOADB
#undef M3_LOADA
#undef M3_ADV
#undef M3_WAITA
#undef M3_WAITB
#undef M3_STEP
        __syncthreads();
        { const int c4 = lane & 7, rs = lane >> 3, col = nc * 32 + 4 * c4;
          const f32x4 gv = *(const f32x4*)(g1 + col), bv = *(const f32x4*)(b1 + col);
#pragma unroll 4
          for (int it = 0; it < 16; ++it) { const int rl = 128 * w + 8 * it + rs; const size_t row = (size_t)tb * 1024 + rl;
              const f32x4 yv = *(const f32x4*)(Y1 + row * D + col); const f32x2 sv = *(const f32x2*)(ST1 + 2 * row);
              f32x4 tv; { const int nt = c4 >> 2, r0 = (4 * c4) & 15;
#pragma unroll
                  for (int j = 0; j < 4; ++j) { const v2u cell = *(const LAS v2u*)(out + rl * 32 + 2 * (r0 + j)); const int lo = (int)cell.x, hi = (int)cell.y + (lo < 0 ? 1 : 0); tv[j] = (float)(nt ? hi : lo) * (1.0f / 4194304.0f); } }
              const f32x4 y = ((yv - sv.x) * sv.y * gv + bv) * ALPHA + tv;
              *(f32x4*)(Y2 + row * D + col) = y;
              float sm = (y[0] + y[1]) + (y[2] + y[3]), sq = (y[0] * y[0] + y[1] * y[1]) + (y[2] * y[2] + y[3] * y[3]);
#pragma unroll
              for (int o = 1; o < 8; o <<= 1) { sm += shfl_x(sm, o, lane); sq += shfl_x(sq, o, lane); }
              if (c4 == 0) *(f32x2*)(PST2 + (row * 64 + nc) * 2) = (f32x2){sm, sq}; } }
    }
}

__device__ __forceinline__ void phase_moe4n(const Frame& F, const float* Y2, const float* pst, const float* gain, const float* bias, float* ST2, bf16* XBo, float* OUT, int last) {
    const int gw = F.bid * 8 + F.wave, NGW = F.G * 8, lane = F.lane;
    for (int t = gw; t < T; t += NGW) {
        f32x4 v[8];
#pragma unroll
        for (int j = 0; j < 8; ++j) v[j] = *(const f32x4*)(Y2 + (size_t)t * D + 4 * lane + 256 * j);
        const f32x2 pv = *(const f32x2*)(pst + ((size_t)t * 64 + lane) * 2);
        const float mean = wave_sum(pv.x, lane) * (1.0f / D); const float var = fmaxf(wave_sum(pv.y, lane) * (1.0f / D) - mean * mean, 0.f); const float rstd = 1.0f / sqrtf(var + LN_EPS);
        if (lane == 0) *(f32x2*)(ST2 + 2 * (size_t)t) = (f32x2){mean, rstd};
#pragma unroll
        for (int j = 0; j < 8; ++j) { const int c = 4 * lane + 256 * j; const f32x4 o = (v[j] - mean) * rstd * *(const f32x4*)(gain + c) + *(const f32x4*)(bias + c);
            if (last) *(f32x4*)(OUT + (size_t)t * D + c) = o;
            else { v2u wb; wb.x = pk2(o[0], o[1]); wb.y = pk2(o[2], o[3]); *(v2u*)(XBo + (size_t)t * D + c) = wb; } }
    }
}


__device__ __forceinline__ void phase_moe4q(const Frame& F, const bf16* X1, bf16* Y2, const unsigned char* Yq, const float* Ysc, const int* eidx, const int* inv, const float* gain, const float* bias, float* ST2, bf16* XBo, float* OUT, int last) {
    const LAS int* tpref = (const LAS int*)(F.lds + LDS_TAB);
    const int gw = F.bid * 8 + F.wave, NGW = F.G * 8, lane = F.lane;
    { LAS f32x4* gb = (LAS f32x4*)(F.lds + 0); int t0 = F.tid; asm volatile("" : "+v"(t0)); gb[t0] = *(const f32x4*)(gain + 4 * t0); gb[512 + t0] = *(const f32x4*)(bias + 4 * t0); }
    __syncthreads();
    const LAS float* gl = (const LAS float*)(F.lds + 0);
    int en = 0, pn = 0; if (lane < 8 && gw < T) { en = eidx[gw * 8 + lane]; pn = inv[gw * 8 + lane]; }
    for (int t = gw; t < T; t += NGW) {
        int rowi = 0; if (lane < 8) rowi = tpref[en] * 256 + pn; else if (lane < 10) rowi = tpref[56 + lane] * 256 + t;
        if (lane < 8 && t + NGW < T) { en = eidx[(t + NGW) * 8 + lane]; pn = inv[(t + NGW) * 8 + lane]; }
        v4u pv[2][2], yv[10][2]; float sc[10][2];
#pragma unroll
        for (int j = 0; j < 2; ++j) { pv[j][0] = __builtin_nontemporal_load((const v4u*)(X1 + (size_t)t * D + 16 * lane + 1024 * j)); pv[j][1] = __builtin_nontemporal_load((const v4u*)(X1 + (size_t)t * D + 16 * lane + 1024 * j + 8)); }
#pragma unroll
        for (int k = 0; k < 10; ++k) { const size_t row = (size_t)__builtin_amdgcn_readlane(rowi, k);
#pragma unroll
            for (int j = 0; j < 2; ++j) { yv[k][j] = __builtin_nontemporal_load((const v4u*)(Yq + row * D + 16 * lane + 1024 * j)); sc[k][j] = __builtin_nontemporal_load(Ysc + row * 16 + 8 * j + (lane >> 3)); } }
#pragma unroll
        for (int k = 0; k < 10; ++k) asm volatile("" : "+v"(yv[k][0]), "+v"(yv[k][1]), "+v"(sc[k][0]), "+v"(sc[k][1]));
        float v[2][16];
#pragma unroll
        for (int j = 0; j < 2; ++j) { float f0[8], f1[8]; unpack8(pv[j][0], f0); unpack8(pv[j][1], f1);
            const float ss = (((sc[0][j] + sc[1][j]) + (sc[2][j] + sc[3][j])) + ((sc[4][j] + sc[5][j]) + (sc[6][j] + sc[7][j]))) + (sc[8][j] + sc[9][j]);
#pragma unroll
            for (int i = 0; i < 8; ++i) { v[j][i] = ALPHA * f0[i] - 128.f * ss; v[j][8 + i] = ALPHA * f1[i] - 128.f * ss; } }
#pragma unroll
        for (int k = 0; k < 10; ++k)
#pragma unroll
            for (int j = 0; j < 2; ++j) { const float s_ = sc[k][j]; const unsigned q[4] = {yv[k][j].x, yv[k][j].y, yv[k][j].z, yv[k][j].w};
#pragma unroll
                for (int d = 0; d < 4; ++d) { v[j][4 * d + 0] += s_ * (float)(q[d] & 0xffu); v[j][4 * d + 1] += s_ * (float)((q[d] >> 8) & 0xffu); v[j][4 * d + 2] += s_ * (float)((q[d] >> 16) & 0xffu); v[j][4 * d + 3] += s_ * (float)(q[d] >> 24); } }
        float sm = 0.f;
#pragma unroll
        for (int j = 0; j < 2; ++j)
#pragma unroll
            for (int i = 0; i < 16; i += 4) sm += (v[j][i] + v[j][i + 1]) + (v[j][i + 2] + v[j][i + 3]);
        const float mean = wave_sum(sm, lane) * (1.0f / D); float sq = 0.f;
#pragma unroll
        for (int j = 0; j < 2; ++j)
#pragma unroll
            for (int i = 0; i < 16; ++i) { const float d = v[j][i] - mean; sq += d * d; }
        const float rstd = 1.0f / sqrtf(wave_sum(sq, lane) * (1.0f / D) + LN_EPS);
        (void)ST2; (void)Y2;
#pragma unroll
        for (int j = 0; j < 2; ++j)
#pragma unroll
            for (int h = 0; h < 2; ++h) { const int c = 16 * lane + 1024 * j + 8 * h; const float* vv = &v[j][8 * h];
                const f32x4 g0 = *(const LAS f32x4*)(gl + c), g1 = *(const LAS f32x4*)(gl + c + 4), b0 = *(const LAS f32x4*)(gl + 2048 + c), b1 = *(const LAS f32x4*)(gl + 2048 + c + 4);
                const f32x4 o0 = ((f32x4){vv[0], vv[1], vv[2], vv[3]} - mean) * rstd * g0 + b0, o1 = ((f32x4){vv[4], vv[5], vv[6], vv[7]} - mean) * rstd * g1 + b1;
                if (last) { *(f32x4*)(OUT + (size_t)t * D + c) = o0; *(f32x4*)(OUT + (size_t)t * D + c + 4) = o1; }
                else { v4u wb; wb.x = pk2(o0[0], o0[1]); wb.y = pk2(o0[2], o0[3]); wb.z = pk2(o1[0], o1[1]); wb.w = pk2(o1[2], o1[3]); *(v4u*)(XBo + (size_t)t * D + c) = wb; } }
    }
}

__device__ __forceinline__ void phase_downproj3(const Frame& F, const bf16* H, const bf16* WD, const bf16* HSp, const bf16* WSD, unsigned char* Yq, float* Ysc, int NU, int GQ, int posf, int posp, int thr, int add) {
    const LAS int* tpref = (const LAS int*)(F.lds + LDS_TAB); const LAS int* cl = (const LAS int*)(F.lds + LDS_TAB + 512);
    LAS unsigned char* lds = F.lds;
    const int tid = F.tid, lane = F.lane, w = F.wave, fr = lane & 15, fq = lane >> 4;
    unsigned rbB[2], cbB[2];
#pragma unroll
    for (int i = 0; i < 2; ++i) { int R_, C_; g8::stage_rc(tid * 16 + i * 8192, R_, C_); rbB[i] = (unsigned)((R_ & ~31) + g8::perm32(R_ & 31)); cbB[i] = (unsigned)C_ * 2u; }
    const unsigned ldsw = (unsigned)w * 1024u, lbase = (unsigned)(size_t)lds;
    int boffg[4];
#pragma unroll
    for (int g = 0; g < 4; ++g) boffg[g] = g8::lds_byte(32 * g + fr, fq * 8);
    LAS unsigned char* stg = lds + 65536 + w * (32 * 144);
#define DP3_U(v) ((v) < thr ? (v) : (v) + add)
    int vb = 0;
    int vcur = (GQ <= NU) ? posf : posp; if (vcur >= NU) return;
    int u = DP3_U(vcur);
#define DP3_UNITINFO(uu, E0, EXP, NV) do { const int tl_ = (uu) >> 2; int e_ = (E0); while (__builtin_amdgcn_readfirstlane(tpref[e_ + 1]) <= tl_) ++e_; EXP = e_; \
        NV = __builtin_amdgcn_readfirstlane(cl[e_]) - (tl_ - __builtin_amdgcn_readfirstlane(tpref[e_])) * 256; } while (0)
#define DP3_GLDS(gsrc, ldsdst) do { unsigned keep_; asm volatile("s_mov_b32 %0, m0\n\ts_mov_b32 m0, %2\n\ts_nop 0\n\tglobal_load_lds_dwordx4 %1, off\n\ts_mov_b32 m0, %0" : "=&s"(keep_) : "v"(gsrc), "s"(ldsdst) : "memory"); } while (0)
#define DP3_STAGE(slot, gb, bs) do { const unsigned v0_ = rbB[0] * (unsigned)(bs) + cbB[0], v1_ = rbB[1] * (unsigned)(bs) + cbB[1]; _Pragma("unroll") for (int kt = 0; kt < 2; ++kt) { \
        DP3_GLDS((const void*)((gb) + kt * 128 + v0_), lbase + (unsigned)((slot) * 32768 + kt * 16384) + ldsw); \
        DP3_GLDS((const void*)((gb) + kt * 128 + v1_), lbase + (unsigned)((slot) * 32768 + kt * 16384) + ldsw + 8192u); } } while (0)
#define DP3_SRC(uu, ee, AB, AS, BB, BS) do { const int tl_ = (uu) >> 2, cu_ = ((uu) & 3) * 512; \
        if ((ee) < 64) { AB = (const char*)(H + (size_t)tl_ * 256 * EDIM); AS = EDIM * 2; BB = (const char*)(WD + (size_t)(ee) * D * EDIM + (size_t)cu_ * EDIM); BS = EDIM * 2; } \
        else { const int t0_ = (tl_ - __builtin_amdgcn_readfirstlane(tpref[ee])) * 256; AB = (const char*)(HSp + (size_t)t0_ * SDIM + ((ee) - 64) * EDIM); AS = SDIM * 2; \
               BB = (const char*)(WSD + (size_t)cu_ * SDIM + ((ee) - 64) * EDIM); BS = SDIM * 2; } } while (0)
    int ecur, nvcur; DP3_UNITINFO(u, 0, ecur, nvcur);
    const char* abc; const char* gbc; int asc, bsc; DP3_SRC(u, ecur, abc, asc, gbc, bsc);
    bf16x8 A[2][4], An[2][4];
    { const char* ap_ = abc + (size_t)(32 * w + fr) * asc + 16 * fq;
#pragma unroll
      for (int m = 0; m < 2; ++m)
#pragma unroll
          for (int kk = 0; kk < 4; ++kk) A[m][kk] = *(const bf16x8*)(ap_ + (size_t)m * 16 * asc + 64 * kk); }
    DP3_STAGE(0, gbc, bsc);
    asm volatile("s_waitcnt vmcnt(0)" ::: "memory");
#pragma unroll 1
    for (;;) {
        int vn = vcur; { const int nb = vb + GQ; if (nb + GQ <= NU) vn = nb + posf; else if (nb + posp < NU) vn = nb + posp; if (vn != vcur) vb = nb; }
        const int un = DP3_U(vn);
        int enx, nvnx; DP3_UNITINFO(un, (un > u ? ecur : 0), enx, nvnx);
        const char* abn; const char* gbn; int asn, bsn; DP3_SRC(un, enx, abn, asn, gbn, bsn);
        const int tile = u >> 2, colu = (u & 3) * 512;
        float scq[2][4];
#pragma unroll
        for (int c = 0; c < 4; ++c) {
            if (c == 0) asm volatile("s_waitcnt vmcnt(5)" ::: "memory"); else asm volatile("s_waitcnt vmcnt(4)" ::: "memory");
            __builtin_amdgcn_s_barrier();
            if (c == 3) { const char* ap_ = abn + (size_t)(32 * w + fr) * asn + 16 * fq;
#pragma unroll
                for (int m = 0; m < 2; ++m) { const char* am_ = ap_ + (size_t)m * 16 * asn;
                    asm volatile("global_load_dwordx4 %0, %1, off" : "=&v"(An[m][0]) : "v"(am_) : "memory"); asm volatile("global_load_dwordx4 %0, %1, off offset:64" : "=&v"(An[m][1]) : "v"(am_) : "memory");
                    asm volatile("global_load_dwordx4 %0, %1, off offset:128" : "=&v"(An[m][2]) : "v"(am_) : "memory"); asm volatile("global_load_dwordx4 %0, %1, off offset:192" : "=&v"(An[m][3]) : "v"(am_) : "memory"); } }
            { const char* gnext = (c < 3) ? gbc + (size_t)(c + 1) * 128 * bsc : gbn; const int bnext = (c < 3) ? bsc : bsn; DP3_STAGE((c + 1) & 1, gnext, bnext); }
            __builtin_amdgcn_sched_barrier(0);
            f32x4 acc[2][4][2];
#pragma unroll
            for (int g = 0; g < 4; ++g) { bf16x8 Bf[2][4];
#pragma unroll
                for (int n = 0; n < 2; ++n)
#pragma unroll
                    for (int kk = 0; kk < 4; ++kk) Bf[n][kk] = *(const LAS bf16x8*)(lds + (c & 1) * 32768 + (kk >> 1) * 16384 + boffg[g] + n * 2048 + (kk & 1) * 1024);
#pragma unroll
                for (int m = 0; m < 2; ++m)
#pragma unroll
                    for (int n = 0; n < 2; ++n) { acc[m][g][n] = (f32x4){0.f, 0.f, 0.f, 0.f};
#pragma unroll
                        for (int kk = 0; kk < 4; ++kk) acc[m][g][n] = __builtin_amdgcn_mfma_f32_16x16x32_bf16(Bf[n][kk], A[m][kk], acc[m][g][n], 0, 0, 0); } }
#pragma unroll
            for (int m = 0; m < 2; ++m) {
                float am0 = 0.f, am1 = 0.f;
#pragma unroll
                for (int g = 0; g < 4; ++g)
#pragma unroll
                    for (int n = 0; n < 2; ++n) { am0 = fmaxf(fmaxf(am0, fabsf(acc[m][g][n][0])), fabsf(acc[m][g][n][1])); am1 = fmaxf(fmaxf(am1, fabsf(acc[m][g][n][2])), fabsf(acc[m][g][n][3])); }
                float am = fmaxf(am0, am1);
                am = max_fq(am);
                am = fminf(am, 3.0e38f);
                const float isc = am > 0.f ? 127.0f * __builtin_amdgcn_rcpf(am) : 0.f;
                scq[m][c] = am * (1.0f / 127.0f);
                const f32x2_t isc2 = (f32x2_t){isc, isc}, mg2 = (f32x2_t){8388736.0f, 8388736.0f};
#pragma unroll
                for (int g = 0; g < 4; ++g) { unsigned qd[2];
#pragma unroll
                    for (int n = 0; n < 2; ++n) {
                        const f32x2_t tl = __builtin_elementwise_fma((f32x2_t){acc[m][g][n][0], acc[m][g][n][1]}, isc2, mg2), th = __builtin_elementwise_fma((f32x2_t){acc[m][g][n][2], acc[m][g][n][3]}, isc2, mg2);
                        const float f0_ = tl.x, f1_ = tl.y, f2_ = th.x, f3_ = th.y;
                        qd[n] = __builtin_amdgcn_perm(__builtin_bit_cast(unsigned, f1_), __builtin_bit_cast(unsigned, f0_), 0x0c0c0400u) | __builtin_amdgcn_perm(__builtin_bit_cast(unsigned, f3_), __builtin_bit_cast(unsigned, f2_), 0x04000c0cu); }
                    *(LAS v2u*)(stg + (16 * m + fr) * 144 + 32 * g + 8 * fq) = (v2u){qd[0], qd[1]}; } }
            v4u ob[4];
#pragma unroll
            for (int it = 0; it < 4; ++it) ob[it] = *(const LAS v4u*)(stg + (8 * it + (lane >> 3)) * 144 + (lane & 7) * 16);
            asm volatile("" : "+v"(ob[0]), "+v"(ob[1]), "+v"(ob[2]), "+v"(ob[3]));
#pragma unroll
            for (int it = 0; it < 4; ++it) { const int rr = 8 * it + (lane >> 3);
                __builtin_nontemporal_store(ob[it], (v4u*)(Yq + (size_t)(tile * 256 + 32 * w + rr) * D + colu + 128 * c + 16 * (lane & 7))); }
            if (c == 3) { const f32x4 so = fq == 0 ? (f32x4){scq[0][0], scq[0][1], scq[0][2], scq[0][3]} : (f32x4){scq[1][0], scq[1][1], scq[1][2], scq[1][3]};
                if (fq < 2) __builtin_nontemporal_store(so, (f32x4*)(Ysc + (size_t)(tile * 256 + 32 * w + 16 * fq + fr) * 16 + (colu >> 7))); }
            __builtin_amdgcn_sched_barrier(0);
        }
        asm volatile("s_waitcnt vmcnt(9)" : "+v"(An[0][0]), "+v"(An[0][1]), "+v"(An[0][2]), "+v"(An[0][3]), "+v"(An[1][0]), "+v"(An[1][1]), "+v"(An[1][2]), "+v"(An[1][3]) :: "memory");
        if (un == u) break;
#pragma unroll
        for (int m = 0; m < 2; ++m)
#pragma unroll
            for (int kk = 0; kk < 4; ++kk) A[m][kk] = An[m][kk];
        u = un; vcur = vn; ecur = enx; nvcur = nvnx; abc = abn; asc = asn; gbc = gbn; bsc = bsn;
    }
    asm volatile("s_waitcnt vmcnt(0)" ::: "memory");
#undef DP3_UNITINFO
#undef DP3_STAGE
#undef DP3_GLDS
#undef DP3_SRC
#undef DP3_U
}

enum { PH_PRO = 0, PH_POOL_G1, PH_POOL_P, PH_POOL_G2, PH_POOL_G3, PH_DIL_G1, PH_DIL_ATT, PH_DIL_CMB, PH_DIL_G2, PH_CONV_G1, PH_CONV_E, PH_CONV_G2, PH_MOE1, PH_MOE2, PH_MOE3, PH_MOE4, PH_COUNT };

template <int PH>
__device__ __forceinline__ void run_phase(const Frame& Fin, const Args& args_, const int L) {
    Frame F = Fin; { int w_ = Fin.wave, l_; asm volatile("" : "+s"(w_)); asm volatile("v_mbcnt_lo_u32_b32 %0, -1, 0\n\tv_mbcnt_hi_u32_b32 %0, -1, %0" : "=v"(l_)); F.wave = w_; F.lane = l_; F.tid = w_ * 64 + l_; }
    unsigned char* ws; { GAS unsigned char* wsg = (GAS unsigned char*)Fin.ws; asm volatile("" : "+s"(wsg)); ws = (unsigned char*)wsg; } F.ws = ws; F.ctl = (unsigned*)(ws + WS_CTL);
    KP kp = (KP)__builtin_amdgcn_kernarg_segment_ptr(); asm volatile("" : "+s"(kp)); (void)args_;
    { unsigned l_ = (unsigned)(size_t)Fin.lds; asm volatile("" : "+s"(l_)); F.lds = (LAS unsigned char*)(size_t)l_; }
    LAS unsigned char* ring = F.lds; int c = (int)blockIdx.x; { int g_ = Fin.G; asm volatile("" : "+s"(c), "+s"(g_)); F.G = g_; F.bid = c; }
    const float* xres = ain(kp, IN_X);
    const float* st2 = (const float*)(ws + WS_ST2); float* pstp = (float*)(ws + WS_PST);
    const float* g2p = ain(kp, IN_LNG) + (size_t)((L > 0 ? L - 1 : 0) * 2 + 1) * D; const float* b2p = ain(kp, IN_LNB) + (size_t)((L > 0 ? L - 1 : 0) * 2 + 1) * D;
    const bf16* xb = (const bf16*)(ws + WS_XB);
    bf16* yf = (bf16*)(ws + WS_YF);
    unsigned char* big = ws + WS_BIG;
    const int ia = L / 3;
    if constexpr (PH == PH_PRO) { phase_prologue(F, kp); }
    if constexpr (PH == PH_POOL_G1) { g8::DenseSched S; S.init(xb, (const bf16*)(ws + WS_W_POOL_IN) + (size_t)ia * D * D, T, D, D, D, F.G, c);
        g8::EpiBf16 E{(bf16*)(big + BG_U), D, 0}; g8::gemm_phase<g8::EpiBf16, g8::DenseSched, false>(ring, F.tid, D, D, D, S, E); }
    if constexpr (PH == PH_POOL_P) { phase_pool(F, (const bf16*)(big + BG_U), (bf16*)(big + BG_PL)); }
    if constexpr (PH == PH_POOL_G2) { g8::DenseSched S; S.init((const bf16*)(big + BG_PL), (const bf16*)(ws + WS_W_POOL_G) + (size_t)ia * D * 512, T, D, D, 512, F.G, c); S.agrp_shift = 1; S.agrp_stride = 512 * 2;
        g8::EpiScaleBf16 E{(bf16*)(big + BG_MX), D, ain(kp, IN_PSC) + (size_t)ia * D}; g8::gemm_phase<g8::EpiScaleBf16, g8::DenseSched, false>(ring, F.tid, 512, D, 512, S, E); }
    if constexpr (PH == PH_POOL_G3) { g8::DenseSched S; S.init((const bf16*)(big + BG_MX), (const bf16*)(ws + WS_W_POOL_OUT) + (size_t)ia * D * D, T, D, D, D, F.G, c);
        g8::EpiResidLN E{xres, xb, st2, g2p, b2p, yf, pstp, 2}; g8::gemm_phase<g8::EpiResidLN, g8::DenseSched, false>(ring, F.tid, D, D, D, S, E); }
    if constexpr (PH == PH_DIL_G1) { g8::DenseSched S; S.init(xb, (const bf16*)(ws + WS_W_DIL_QKV), T, QKVC, D, D, F.G, c);
        g8::EpiBf16 E{(bf16*)(big + BG_QKV), QKVC, 1}; g8::gemm_phase<g8::EpiBf16, g8::DenseSched, false>(ring, F.tid, D, D, D, S, E); }
    if constexpr (PH == PH_DIL_ATT) { phase_attn(F, (const bf16*)(big + BG_QKV), ain(kp, IN_RELB), (bf16*)(big + BG_OG), (float*)(big + BG_LSE)); }
    if constexpr (PH == PH_DIL_CMB) { phase_combine(F, (const bf16*)(big + BG_OG), (const float*)(big + BG_LSE), (bf16*)(big + BG_O)); }
    if constexpr (PH == PH_DIL_G2) { g8::DenseSched S; S.init((const bf16*)(big + BG_O), (const bf16*)(ws + WS_W_DIL_OUT), T, D, DILW, DILW, F.G, c);
        g8::EpiResidLN E{xres, xb, st2, g2p, b2p, yf, pstp, 2}; g8::gemm_phase<g8::EpiResidLN, g8::DenseSched, false>(ring, F.tid, DILW, DILW, DILW, S, E); }
    if constexpr (PH == PH_CONV_G1) { g8::DenseSched S; S.init(xb, (const bf16*)(ws + WS_W_CONV_IN), T, 3 * D, D, D, F.G, c);
        g8::EpiConvIn E{(bf16*)(big + BG_UC), (bf16*)(big + BG_BG)}; g8::gemm_phase<g8::EpiConvIn, g8::DenseSched, false>(ring, F.tid, D, D, D, S, E); }
    if constexpr (PH == PH_CONV_E) { phase_conv(F, (const bf16*)(big + BG_UC), (const bf16*)(big + BG_BG), ain(kp, IN_CW), (bf16*)(big + BG_Z)); }
    if constexpr (PH == PH_CONV_G2) { g8::DenseSched S; S.init((const bf16*)(big + BG_Z), (const bf16*)(ws + WS_W_CONV_OUT), T, D, D, D, F.G, c);
        g8::EpiResidLN E{xres, xb, st2, g2p, b2p, yf, pstp, 2}; g8::gemm_phase<g8::EpiResidLN, g8::DenseSched, false>(ring, F.tid, D, D, D, S, E); }
    unsigned* cnt = F.ctl + CW_CNT + L * 64 * 16;
    float* x1f = (float*)(ws + WS_X1F); bf16* x1b = (bf16*)(ws + WS_X1B);
    int* ltok = (int*)(ws + WS_LTOK); float* lgate = (float*)(ws + WS_LGATE); int* eidx = (int*)(ws + WS_EIDX); int* inv = (int*)(ws + WS_INV);
    bf16* HB = (bf16*)(ws + WS_HB); bf16* HS = (bf16*)(ws + WS_HS); bf16* Yr = (bf16*)(ws + WS_BIG);
    if constexpr (PH == PH_MOE1) {
        const float* g1 = ain(kp, IN_LNG) + (size_t)(L * 2 + 0) * D; const float* b1 = ain(kp, IN_LNB) + (size_t)(L * 2 + 0) * D;
        phase_moe1n(F, yf, pstp, g1, b1, (const bf16*)(ws + WS_RWH) + (size_t)L * NEXP * D, (const bf16*)(ws + WS_RWL) + (size_t)L * NEXP * D, ain(kp, IN_RB) + (size_t)L * NEXP,
                    x1b, (float*)(ws + WS_ST1), cnt, ltok, lgate, eidx, inv); }
    unsigned* shctr = F.ctl + 24576 + L * 16;
    constexpr int TFU = 2;
    if constexpr (PH == PH_MOE2) {
        const int NT = build_tiles(F, cnt);
        const bool tf = F.G == 256;
        const int R = NT - 2 * F.G, NI = tf ? 128 - R : 0;
        if (tf) {
            { g8::DenseSched S; S.init(x1b, (const bf16*)(ws + WS_W_SH_GU) + (size_t)L * 512 * D, T, 512, D, D, F.G, c);
              g8::EpiSharedGU E{HS}; g8::gemm_phase<g8::EpiSharedGU, g8::DenseSched, false>(ring, F.tid, D, D, D, S, E); }
            asm volatile("s_waitcnt vmcnt(0)" ::: "memory"); __syncthreads();
            if (threadIdx.x == 0 && c < 128) { __builtin_amdgcn_fence(__ATOMIC_RELEASE, "agent"); asm volatile("s_waitcnt vmcnt(0)" ::: "memory");
                unsigned* ctr; { GAS unsigned* cg = (GAS unsigned*)shctr; asm volatile("" : "+s"(cg)); ctr = (unsigned*)cg; }
                __hip_atomic_fetch_add(ctr, 1u, __ATOMIC_RELAXED, __HIP_MEMORY_SCOPE_AGENT); }
            { g8::ExpertSched<1, true> S; S.tpref = (const LAS int*)(F.lds + LDS_TAB); S.cnt = (const LAS int*)(F.lds + LDS_TAB + 512); S.A = (const char*)x1b; S.B = (const char*)((const bf16*)(ws + WS_W_EX_GU) + (size_t)L * 64 * 256 * D);
              S.tok = ltok; S.b_exp = (size_t)256 * D * 2; S.b_tile = 0; S.a_tile = 0; S.NU = NT; S.G = F.G; S.c = c; S.tf = 1;
              int t2 = F.tid; asm volatile("" : "+v"(t2));
              g8::EpiExpertGU E{HB}; g8::gemm_phase<g8::EpiExpertGU, g8::ExpertSched<1, true>, true>(ring, t2, D, D, D, S, E); }
            if (c >= 128 + R) {
                __syncthreads();
                if (threadIdx.x == 0) { unsigned* ctr; { GAS unsigned* cg = (GAS unsigned*)shctr; asm volatile("" : "+s"(cg)); ctr = (unsigned*)cg; }
                    unsigned sp = 0; while (__hip_atomic_load(ctr, __ATOMIC_RELAXED, __HIP_MEMORY_SCOPE_AGENT) < 128u && ++sp < (1u << 22)) __builtin_amdgcn_s_sleep(2);
                    __builtin_amdgcn_fence(__ATOMIC_ACQUIRE, "agent"); asm volatile("s_waitcnt vmcnt(0)" ::: "memory"); }
                __syncthreads();
                Frame F3 = F; { int t3 = F.tid; asm volatile("" : "+v"(t3)); F3.tid = t3; F3.lane = t3 & 63; }
                const int j = c - 128 - R;
                phase_downproj3(F3, HB, (const bf16*)(ws + WS_W_EX_D) + (size_t)L * 64 * D * EDIM, HS, (const bf16*)(ws + WS_W_SH_D) + (size_t)L * D * SDIM, (unsigned char*)Yr, (float*)(ws + WS_BIG + BG_YSC),
                                TFU * NI, NI, j, j, 0, 4 * NT); }
        } else {
            { g8::ExpertSched<1, true> S; S.tpref = (const LAS int*)(F.lds + LDS_TAB); S.cnt = (const LAS int*)(F.lds + LDS_TAB + 512); S.A = (const char*)x1b; S.B = (const char*)((const bf16*)(ws + WS_W_EX_GU) + (size_t)L * 64 * 256 * D);
              S.tok = ltok; S.b_exp = (size_t)256 * D * 2; S.b_tile = 0; S.a_tile = 0; S.NU = NT; S.G = F.G; S.c = c;
              g8::EpiExpertGU E{HB}; g8::gemm_phase<g8::EpiExpertGU, g8::ExpertSched<1, true>, true>(ring, F.tid, D, D, D, S, E); }
            { const int rot = (c - (NT % F.G) + F.G) % F.G;
              g8::DenseSched S; S.init(x1b, (const bf16*)(ws + WS_W_SH_GU) + (size_t)L * 512 * D, T, 512, D, D, F.G, rot);
              int t2 = F.tid; asm volatile("" : "+v"(t2));
              g8::EpiSharedGU E{HS}; g8::gemm_phase<g8::EpiSharedGU, g8::DenseSched, false>(ring, t2, D, D, D, S, E); } } }
    if constexpr (PH == PH_MOE3) {
        const int NT = build_tiles(F, cnt);
        const int NI = F.G == 256 ? 128 - (NT - 2 * F.G) : 0;
        __syncthreads();
        const int upos = (F.G % 8) == 0 ? (F.bid & 7) * (F.G >> 3) + (F.bid >> 3) : F.bid;
        phase_downproj3(F, HB, (const bf16*)(ws + WS_W_EX_D) + (size_t)L * 64 * D * EDIM, HS, (const bf16*)(ws + WS_W_SH_D) + (size_t)L * D * SDIM, (unsigned char*)Yr, (float*)(ws + WS_BIG + BG_YSC),
                        4 * NT + 8 * (T / 256) - TFU * NI, F.G, upos, F.bid, 4 * NT, TFU * NI); }
    if constexpr (PH == PH_MOE4) { (void)build_tiles(F, cnt);
        const float* g2 = ain(kp, IN_LNG) + (size_t)(L * 2 + 1) * D; const float* b2 = ain(kp, IN_LNB) + (size_t)(L * 2 + 1) * D;
        phase_moe4q(F, x1b, (bf16*)(ws + WS_Y2F), (const unsigned char*)Yr, (const float*)(ws + WS_BIG + BG_YSC), eidx, inv, g2, b2, (float*)(ws + WS_ST2), (bf16*)(ws + WS_XB), aout(kp), L == DEPTH - 1); }
}
__device__ __forceinline__ void make_frame(Frame& F, const Args& args) {
    extern __shared__ __attribute__((aligned(16))) unsigned char lds_raw[];
    F.lds = (LAS unsigned char*)lds_raw; F.ws = args.ws; F.ctl = (unsigned*)(args.ws + WS_CTL);
    F.tid = threadIdx.x; F.lane = F.tid & 63; F.wave = __builtin_amdgcn_readfirstlane(F.tid >> 6); F.G = gridDim.x; F.bid = blockIdx.x;
}
template <int PH> __global__ void __launch_bounds__(512, 2) k_phase(Args args, int L) {
    Frame F; make_frame(F, args);
    run_phase<PH>(F, args, L);
}

#ifndef MK_NOINLINE
#define MK_NOINLINE 0
#endif
#if MK_NOINLINE
template <int PH> __device__ __noinline__ void call_phase_ni(const int L) {
    Args dummy{}; Frame F;
    KP kp = (KP)__builtin_amdgcn_kernarg_segment_ptr();
    extern __shared__ __attribute__((aligned(16))) unsigned char lds_raw[];
    F.lds = (LAS unsigned char*)lds_raw; F.ws = (unsigned char*)((GAS unsigned char* const CAS*)kp)[20]; F.ctl = (unsigned*)(F.ws + WS_CTL);
    F.tid = threadIdx.x; F.lane = F.tid & 63; F.wave = __builtin_amdgcn_readfirstlane(F.tid >> 6); F.G = gridDim.x; F.bid = blockIdx.x;
    run_phase<PH>(F, dummy, L);
}
template <int PH> __device__ __forceinline__ void call_phase(const Frame& F, const Args& args, const int L) { call_phase_ni<PH>(L); }
#else
template <int PH> __device__ __forceinline__ void call_phase(const Frame& F, const Args& args, const int L) { asm volatile("; PHASE_BEGIN %0" :: "n"(PH)); run_phase<PH>(F, args, L); asm volatile("; PHASE_END %0" :: "n"(PH)); }
#endif
__global__ void __launch_bounds__(512, 2) fwd_all(Args args) {
    Frame F; make_frame(F, args);
    volatile LAS unsigned* misc = (volatile LAS unsigned*)(F.lds + LDS_MISC);
    if (F.tid < 4) misc[F.tid] = 0u;
    __syncthreads();
    const int lo = args.ph_lo, hi = args.ph_hi;
    XcdBarrier bar; bar.bar = F.ctl + CW_BAR; bar.x = 0; bar.st = misc;
    if (hi - lo > 1) bar = xcd_barrier_post(F.ctl + CW_BAR, misc);
    int pc = 0;
#ifndef MK_DUP_MASK
#define MK_DUP_MASK 0
#endif
#if MK_DUP_MASK
#define STEP(PH, Lx) do { if (pc >= lo && pc < hi) { int nrep_ = ((MK_DUP_MASK >> (PH)) & 1) ? 2 : 1; asm volatile("" : "+s"(nrep_)); _Pragma("unroll 1") for (int r_ = 0; r_ < nrep_; ++r_) { call_phase<PH>(F, args, Lx); if (r_ + 1 < nrep_ || pc + 1 < hi) xcd_barrier(bar); } } ++pc; } while (0)
#else
#define STEP(PH, Lx) do { if (pc >= lo && pc < hi) { call_phase<PH>(F, args, Lx); if (pc + 1 < hi) xcd_barrier(bar); } ++pc; } while (0)
#endif
    STEP(PH_PRO, 0);
#pragma unroll 1
    for (int L = 0; L < DEPTH; ++L) {
        const int kind = L % 3;
        if (kind == 0) { STEP(PH_POOL_G1, L); STEP(PH_POOL_P, L); STEP(PH_POOL_G2, L); STEP(PH_POOL_G3, L); }
        else if (kind == 1) { STEP(PH_DIL_G1, L); STEP(PH_DIL_ATT, L); STEP(PH_DIL_CMB, L); STEP(PH_DIL_G2, L); }
        else { STEP(PH_CONV_G1, L); STEP(PH_CONV_E, L); STEP(PH_CONV_G2, L); }
        STEP(PH_MOE1, L); STEP(PH_MOE2, L); STEP(PH_MOE3, L); STEP(PH_MOE4, L);
    }
#undef STEP
}
constexpr int N_STEPS = 1 + 2 * 8 + 8 + 7;

template <int PH> static void launch_phase(const Args& a, int L, int grid, hipStream_t stream) {
    static bool attr = false;
    if (!attr) { (void)hipFuncSetAttribute((const void*)k_phase<PH>, hipFuncAttributeMaxDynamicSharedMemorySize, LDS_BYTES); attr = true; }
    hipLaunchKernelGGL(k_phase<PH>, dim3(grid), dim3(512), LDS_BYTES, stream, a, L);
}
extern "C" void kernel_launch(void* const* d_in, const int* in_sizes, int n_in, void* d_out, int out_size, void* d_ws, size_t ws_size, hipStream_t stream) {
    static int grid = 0;
    if (grid == 0) {
        if (n_in != 19 || out_size != T * D || ws_size < WS_END) { fprintf(stderr, "kernel_launch: unexpected shapes (n_in %d out %d ws %zu need %zu)\n", n_in, out_size, ws_size, (size_t)WS_END); grid = -1; return; }
        int dev = 0, cus = 0;
        if (hipGetDevice(&dev) != hipSuccess || hipDeviceGetAttribute(&cus, hipDeviceAttributeMultiprocessorCount, dev) != hipSuccess) { grid = -1; return; }
#if MK_ONE_LAUNCH
        if (hipFuncSetAttribute((const void*)fwd_all, hipFuncAttributeMaxDynamicSharedMemorySize, LDS_BYTES) != hipSuccess) { fprintf(stderr, "kernel_launch: hipFuncSetAttribute failed\n"); grid = -1; return; }
        int per_cu = 0;
        if (hipOccupancyMaxActiveBlocksPerMultiprocessor(&per_cu, (const void*)fwd_all, 512, LDS_BYTES) != hipSuccess || per_cu < 1) { fprintf(stderr, "kernel_launch: note: occupancy query reports %d blocks per CU\n", per_cu); (void)hipGetLastError(); }
#endif
        grid = cus;
    }
    if (grid < 0) return;
    (void)hipMemsetAsync((char*)d_ws + WS_CTL, 0, CTL_ZERO_BYTES, stream);
    Args a{};
    for (int i = 0; i < 19; ++i) a.in[i] = (const float*)d_in[i];
    a.out = (float*)d_out; a.ws = (unsigned char*)d_ws; a.ph_lo = 0; a.ph_hi = 0;
#if MK_ONE_LAUNCH
#ifdef MK_SPLIT
    for (int p = 0; p < N_STEPS; ++p) { a.ph_lo = p; a.ph_hi = p + 1; hipLaunchKernelGGL(fwd_all, dim3(grid), dim3(512), LDS_BYTES, stream, a); }
#else
    a.ph_lo = 0; a.ph_hi = N_STEPS;
    hipLaunchKernelGGL(fwd_all, dim3(grid), dim3(512), LDS_BYTES, stream, a);
#endif
#elif defined(MK_HYBRID_MASK)
    {
        static bool attr2 = false; if (!attr2) { (void)hipFuncSetAttribute((const void*)fwd_all, hipFuncAttributeMaxDynamicSharedMemorySize, LDS_BYTES); attr2 = true; }
        int pc = 0;
#define HSTEP(PH, Lx) do { if ((MK_HYBRID_MASK >> (PH)) & 1) { a.ph_lo = pc; a.ph_hi = pc + 1; hipLaunchKernelGGL(fwd_all, dim3(grid), dim3(512), LDS_BYTES, stream, a); } else { a.ph_lo = 0; a.ph_hi = 0; launch_phase<PH>(a, Lx, grid, stream); } ++pc; } while (0)
        HSTEP(PH_PRO, 0);
        for (int L = 0; L < DEPTH; ++L) {
            const int kind = L % 3;
            if (kind == 0) { HSTEP(PH_POOL_G1, L); HSTEP(PH_POOL_P, L); HSTEP(PH_POOL_G2, L); HSTEP(PH_POOL_G3, L); }
            else if (kind == 1) { HSTEP(PH_DIL_G1, L); HSTEP(PH_DIL_ATT, L); HSTEP(PH_DIL_CMB, L); HSTEP(PH_DIL_G2, L); }
            else { HSTEP(PH_CONV_G1, L); HSTEP(PH_CONV_E, L); HSTEP(PH_CONV_G2, L); }
            HSTEP(PH_MOE1, L); HSTEP(PH_MOE2, L); HSTEP(PH_MOE3, L); HSTEP(PH_MOE4, L);
        }
#undef HSTEP
    }
#else
    launch_phase<PH_PRO>(a, 0, grid, stream);
    for (int L = 0; L < DEPTH; ++L) {
        const int kind = L % 3;
        if (kind == 0) { launch_phase<PH_POOL_G1>(a, L, grid, stream); launch_phase<PH_POOL_P>(a, L, grid, stream); launch_phase<PH_POOL_G2>(a, L, grid, stream); launch_phase<PH_POOL_G3>(a, L, grid, stream); }
        else if (kind == 1) { launch_phase<PH_DIL_G1>(a, L, grid, stream); launch_phase<PH_DIL_ATT>(a, L, grid, stream); launch_phase<PH_DIL_CMB>(a, L, grid, stream); launch_phase<PH_DIL_G2>(a, L, grid, stream); }
        else { launch_phase<PH_CONV_G1>(a, L, grid, stream); launch_phase<PH_CONV_E>(a, L, grid, stream); launch_phase<PH_CONV_G2>(a, L, grid, stream); }
        launch_phase<PH_MOE1>(a, L, grid, stream); launch_phase<PH_MOE2>(a, L, grid, stream); launch_phase<PH_MOE3>(a, L, grid, stream); launch_phase<PH_MOE4>(a, L, grid, stream);
    }
#endif
}
```

```cpp
#include <hip/hip_runtime.h>
#include <cstdio>
#include <cstdint>

#ifndef MK_ONE_LAUNCH
#define MK_ONE_LAUNCH 1
#endif

#define GAS __attribute__((address_space(1)))
#define LAS __attribute__((address_space(3)))
typedef unsigned short bf16;
typedef unsigned v4u __attribute__((ext_vector_type(4)));
typedef unsigned v2u __attribute__((ext_vector_type(2)));
typedef float f32x4 __attribute__((ext_vector_type(4)));
typedef float f32x2 __attribute__((ext_vector_type(2)));
typedef short bf16x8 __attribute__((ext_vector_type(8)));
typedef short s16x4 __attribute__((ext_vector_type(4)));

constexpr int NBATCH = 8, SEQ = 2048, D = 2048, T = NBATCH * SEQ, DEPTH = 4;
constexpr int NEXP = 64, TOPK = 8, EDIM = 128, SDIM = 256;
constexpr int QKVC = 4608, DILW = 512;
constexpr float ALPHA = 1.681792830507429f;
constexpr float LN_EPS = 1e-5f;
constexpr int CAP = 16384;
constexpr int HROWS = T * TOPK + NEXP * 256;

constexpr size_t MiB = 1u << 20;
constexpr size_t WS_CTL = 0, CTL_ZERO_BYTES = 1 * MiB;
constexpr size_t WS_W_POOL_IN = 1 * MiB;
constexpr size_t WS_W_POOL_G = WS_W_POOL_IN + 16 * MiB;
constexpr size_t WS_W_POOL_OUT = WS_W_POOL_G + 4 * MiB;
constexpr size_t WS_W_DIL_QKV = WS_W_POOL_OUT + 16 * MiB;
constexpr size_t WS_W_DIL_OUT = WS_W_DIL_QKV + 18 * MiB;
constexpr size_t WS_W_CONV_IN = WS_W_DIL_OUT + 2 * MiB;
constexpr size_t WS_W_CONV_OUT = WS_W_CONV_IN + 24 * MiB;
constexpr size_t WS_W_SH_GU = WS_W_CONV_OUT + 8 * MiB;
constexpr size_t WS_W_SH_D = WS_W_SH_GU + 8 * MiB;
constexpr size_t WS_W_EX_GU = WS_W_SH_D + 4 * MiB;
constexpr size_t WS_W_EX_D = WS_W_EX_GU + 256 * MiB;
constexpr size_t WS_XF = WS_W_EX_D + 256 * MiB;
constexpr size_t WS_YF = WS_XF + 128 * MiB;
constexpr size_t WS_X1F = WS_YF + 128 * MiB;
constexpr size_t WS_XB = WS_X1F + 128 * MiB;
constexpr size_t WS_X1B = WS_XB + 64 * MiB;
constexpr size_t WS_HB = WS_X1B + 64 * MiB;
constexpr size_t WS_HS = WS_HB + 72 * MiB;
constexpr size_t WS_LTOK = WS_HS + 8 * MiB;
constexpr size_t WS_LGATE = WS_LTOK + 4 * MiB;
constexpr size_t WS_EIDX = WS_LGATE + 4 * MiB;
constexpr size_t WS_INV = WS_EIDX + 1 * MiB;
constexpr size_t WS_BIG = WS_INV + 1 * MiB;
constexpr size_t WS_PST = WS_BIG + 608 * MiB;
constexpr size_t WS_ST1 = WS_PST + 4 * MiB;
constexpr size_t WS_ST2 = WS_ST1 + 1 * MiB;
constexpr size_t WS_RWH = WS_ST2 + 1 * MiB;
constexpr size_t WS_RWL = WS_RWH + 1 * MiB;
constexpr size_t WS_PST2 = WS_RWL + 1 * MiB;
constexpr size_t WS_END = WS_PST2 + 8 * MiB;
constexpr size_t WS_Y2F = WS_X1F;
constexpr size_t BG_U = 0, BG_PL = 64 * MiB, BG_MX = 128 * MiB;
constexpr size_t BG_QKV = 0, BG_OG = 144 * MiB, BG_LSE = 192 * MiB, BG_O = 194 * MiB;
constexpr size_t BG_UC = 0, BG_BG = 64 * MiB, BG_Z = 128 * MiB;
constexpr size_t BG_YSC = 400 * MiB;
constexpr int CW_BAR = 4096;
constexpr int CW_CNT = 16384;

constexpr int RING_BYTES = 131072;
constexpr int LDS_TAB = RING_BYTES;
constexpr int LDS_STASH = RING_BYTES + 1024;
constexpr int LDS_BYTES = 163840;
constexpr int LDS_MISC = LDS_BYTES - 1024;

typedef __bf16 bf16x2_t __attribute__((ext_vector_type(2)));
typedef float f32x2_t __attribute__((ext_vector_type(2)));
__device__ __forceinline__ unsigned cvt_pk_bf16(float lo, float hi) { const bf16x2_t r = __builtin_convertvector((f32x2_t){lo, hi}, bf16x2_t); return __builtin_bit_cast(unsigned, r); }
__device__ __forceinline__ unsigned f2bf(float f) { unsigned u = __builtin_bit_cast(unsigned, f); return (u + 0x7fffu + ((u >> 16) & 1u)) >> 16; }
__device__ __forceinline__ unsigned pk2(float lo, float hi) { return f2bf(lo) | (f2bf(hi) << 16); }
__device__ __forceinline__ float bflo(unsigned w) { return __builtin_bit_cast(float, w << 16); }
__device__ __forceinline__ float bfhi(unsigned w) { return __builtin_bit_cast(float, w & 0xffff0000u); }
__device__ __forceinline__ float shfl_from(float v, int src) { return __builtin_bit_cast(float, __builtin_amdgcn_ds_bpermute(src << 2, __builtin_bit_cast(int, v))); }
__device__ __forceinline__ float shfl_x(float v, int o, int lane) { return shfl_from(v, lane ^ o); }
__device__ __forceinline__ float wave_sum(float v, int lane) {
    (void)lane;
    v += __builtin_bit_cast(float, __builtin_amdgcn_update_dpp(0, __builtin_bit_cast(int, v), 0xB1, 0xF, 0xF, false));
    v += __builtin_bit_cast(float, __builtin_amdgcn_update_dpp(0, __builtin_bit_cast(int, v), 0x4E, 0xF, 0xF, false));
    v += __builtin_bit_cast(float, __builtin_amdgcn_update_dpp(0, __builtin_bit_cast(int, v), 0x141, 0xF, 0xF, false));
    v += __builtin_bit_cast(float, __builtin_amdgcn_update_dpp(0, __builtin_bit_cast(int, v), 0x140, 0xF, 0xF, false));
    const float r0 = __builtin_bit_cast(float, __builtin_amdgcn_readlane(__builtin_bit_cast(int, v), 0)), r1 = __builtin_bit_cast(float, __builtin_amdgcn_readlane(__builtin_bit_cast(int, v), 16));
    const float r2 = __builtin_bit_cast(float, __builtin_amdgcn_readlane(__builtin_bit_cast(int, v), 32)), r3 = __builtin_bit_cast(float, __builtin_amdgcn_readlane(__builtin_bit_cast(int, v), 48));
    return (r0 + r1) + (r2 + r3);
}
__device__ __forceinline__ float sum_fq(float x) {
    { const auto r = __builtin_amdgcn_permlane16_swap(__builtin_bit_cast(unsigned, x), __builtin_bit_cast(unsigned, x), false, false); const unsigned a_ = r[0], b_ = r[1]; x = __builtin_bit_cast(float, a_) + __builtin_bit_cast(float, b_); }
    { const auto r = __builtin_amdgcn_permlane32_swap(__builtin_bit_cast(unsigned, x), __builtin_bit_cast(unsigned, x), false, false); const unsigned a_ = r[0], b_ = r[1]; x = __builtin_bit_cast(float, a_) + __builtin_bit_cast(float, b_); }
    return x;
}
__device__ __forceinline__ float max_fq(float x) {
    { const auto r = __builtin_amdgcn_permlane16_swap(__builtin_bit_cast(unsigned, x), __builtin_bit_cast(unsigned, x), false, false); const unsigned a_ = r[0], b_ = r[1]; x = fmaxf(__builtin_bit_cast(float, a_), __builtin_bit_cast(float, b_)); }
    { const auto r = __builtin_amdgcn_permlane32_swap(__builtin_bit_cast(unsigned, x), __builtin_bit_cast(unsigned, x), false, false); const unsigned a_ = r[0], b_ = r[1]; x = fmaxf(__builtin_bit_cast(float, a_), __builtin_bit_cast(float, b_)); }
    return x;
}
#define LDS_WAIT() asm volatile("s_waitcnt lgkmcnt(0)" ::: "memory")
#define VM_WAIT() asm volatile("s_waitcnt vmcnt(0)" ::: "memory")

#define XB_TMO      128
#define XB_XCNT(j)  (256  + 64 * (j))
#define XB_XSUB(j)  (1280 + 64 * (j))
#define XB_XGEN(j)  (2304 + 64 * (j))
#define XB_TOP      3328
#define XB_TOPGEN   3392
#define XCD_BAR_WORDS 3456
#define XB_SPIN_CAP (1u << 18)

__device__ __forceinline__ unsigned xb_ld(unsigned* p)              { return __hip_atomic_load(p, __ATOMIC_RELAXED, __HIP_MEMORY_SCOPE_AGENT); }
__device__ __forceinline__ unsigned xb_add(unsigned* p, unsigned v) { return __hip_atomic_fetch_add(p, v, __ATOMIC_RELAXED, __HIP_MEMORY_SCOPE_AGENT); }
__device__ __forceinline__ unsigned xb_xcc_id() { return (unsigned)__builtin_amdgcn_s_getreg((3 << 11) | 20) & 0xFu; }
#define XB_SPIN(cond, bar) do { unsigned _sp = 0; while (cond) { __builtin_amdgcn_s_sleep(1); \
    if ((++_sp & 255u) == 0u) { if (xb_ld(&(bar)[XB_TMO])) break; if (_sp > XB_SPIN_CAP) { atomicAdd(&(bar)[XB_TMO], 1u); break; } } } } while (0)

struct XcdBarrier {
    unsigned* bar; unsigned x;
    volatile LAS unsigned* st;
};

__device__ __forceinline__ XcdBarrier xcd_barrier_post(unsigned* bar, volatile LAS unsigned* st) {
    XcdBarrier b; b.bar = bar; b.x = xb_xcc_id(); b.st = st;
    if (threadIdx.x == 0) (void)xb_add(&bar[XB_XCNT(b.x)], 1u);
    return b;
}
__device__ __forceinline__ void xcd_barrier_complete(unsigned* bar, unsigned x, unsigned& nloc, unsigned& nx) {
    const unsigned G = gridDim.x * gridDim.y * gridDim.z;
    unsigned sum, cnt, mine, sp = 0u;
    for (;;) {
        sum = 0u; cnt = 0u; mine = 0u;
#pragma unroll
        for (unsigned j = 0; j < 16; ++j) { const unsigned c = xb_ld(&bar[XB_XCNT(j)]); sum += c; cnt += (c > 0u) ? 1u : 0u; mine = (j == x) ? c : mine; }
        if (sum == G) break;
        __builtin_amdgcn_s_sleep(1);
        if ((++sp & 255u) == 0u) { if (xb_ld(&bar[XB_TMO])) break; if (sp > XB_SPIN_CAP) { atomicAdd(&bar[XB_TMO], 1u); break; } }
    }
    nloc = mine > 0u ? mine : 1u; nx = cnt > 0u ? cnt : 1u;
}

__device__ __forceinline__ void xcd_barrier(const XcdBarrier& b) {
    asm volatile("s_waitcnt vmcnt(0)" ::: "memory");
    __syncthreads();
    if (threadIdx.x == 0) {
        unsigned* bar; unsigned bx = b.x; { GAS unsigned* bg = (GAS unsigned*)b.bar; asm volatile("" : "+s"(bg), "+s"(bx)); bar = (unsigned*)bg; }
        __builtin_amdgcn_s_waitcnt(0);
        unsigned nloc = b.st[0], nx = b.st[1];
        if (nloc == 0u) { xcd_barrier_complete(bar, bx, nloc, nx); b.st[0] = nloc; b.st[1] = nx; }
        const unsigned old = xb_add(&bar[XB_XSUB(bx)], 1u);
        const unsigned gen = old / nloc;
        if (old + 1u == (gen + 1u) * nloc) {
            __builtin_amdgcn_fence(__ATOMIC_RELEASE, "agent");
            asm volatile("s_waitcnt vmcnt(0)" ::: "memory");
            const unsigned og = xb_add(&bar[XB_TOP], 1u);
            const unsigned tg = og / nx;
            if (og + 1u == (tg + 1u) * nx) xb_add(&bar[XB_TOPGEN], 1u);
            else XB_SPIN(xb_ld(&bar[XB_TOPGEN]) == tg, bar);
            __builtin_amdgcn_fence(__ATOMIC_ACQUIRE, "agent");
            xb_add(&bar[XB_XGEN(bx)], 1u);
            asm volatile("s_waitcnt vmcnt(0)" ::: "memory");
        } else {
            XB_SPIN(xb_ld(&bar[XB_XGEN(bx)]) == gen, bar);
            __builtin_amdgcn_fence(__ATOMIC_ACQUIRE, "agent");
            asm volatile("s_waitcnt vmcnt(0)" ::: "memory");
        }
    }
    __syncthreads();
}

namespace g8 {
constexpr int BM = 256, BK = 64, HALF = 128, HTB = HALF * BK * 2, STAGE_BYTES = 8 * HTB, NXCD = 8, WGM = 8;
__host__ __device__ __forceinline__ int lds_byte(int r, int c) { const int st = (r >> 4) * 2 + (c >> 5), rr = r & 15, cc = c & 31, ob = rr * 64 + cc * 2; return st * 1024 + (ob ^ (((ob >> 9) & 1) << 5)); }
__host__ __device__ __forceinline__ void stage_rc(int b, int& R, int& C) { const int st = b / 1024, sb = b % 1024, swz = sb ^ (((sb >> 9) & 1) << 5); R = (st >> 1) * 16 + swz / 64; C = (st & 1) * 32 + (swz % 64) / 2; }
__host__ __device__ __forceinline__ int perm32(int rho) { const int n = rho >> 4, i = rho & 15; return 8 * (i >> 2) + 4 * n + (i & 3); }

struct Unit { const char* A; const char* B; const int* rows; int pm, pn, nvalid, aux; };

template <class Epi, class Sched, bool GATHER>
__device__ __forceinline__ void gemm_phase(LAS unsigned char* lds, const int tid_in, const int K, const int lda, const int ldb, const Sched& S, const Epi& E) {
    const int tid = tid_in, wid = __builtin_amdgcn_readfirstlane(tid >> 6), lane = tid & 63, wr = wid >> 2, wc = wid & 3, fr = lane & 15, fq = lane >> 4;
    const int nt = K / BK;
    unsigned voffB[2];
#pragma unroll
    for (int i = 0; i < 2; ++i) { int R_, C_; stage_rc(tid * 16 + i * 8192, R_, C_); const int Rb = Epi::PERM ? ((R_ & ~31) + perm32(R_ & 31)) : R_; voffB[i] = (unsigned)(Rb * ldb + C_) * 2u; }
    LAS v4u* stash = (LAS v4u*)(lds + (LDS_STASH - 0) + tid * 16);
    const size_t kstep = (size_t)(BK * 2);
    const size_t hstepB = (size_t)HALF * ldb * 2;
    const unsigned ldsw = (unsigned)wid * 1024u;
    const int aoff = lds_byte(wr * 64 + fr, fq * 8), boff = lds_byte(wc * 32 + fr, fq * 8);
#define G8_SA(b, h) (((b) * 2 + (h)) * HTB)
#define G8_SB(b, h) ((4 + (b) * 2 + (h)) * HTB)
#define G8_STAGE2(bufoff, gbase, v0, v1) do { \
        __builtin_amdgcn_global_load_lds((const unsigned*)((const char*)(gbase) + (v0)), (LAS unsigned*)(lds + (bufoff) + ldsw), 16, 0, 0); \
        __builtin_amdgcn_global_load_lds((const unsigned*)((const char*)(gbase) + (v1)), (LAS unsigned*)(lds + (bufoff) + ldsw + 8192), 16, 0, 0); } while (0)
#define G8_STAGEB(bufoff, gbase) G8_STAGE2(bufoff, gbase, voffB[0], voffB[1])
#define G8_LDA(dst, b, h) do { _Pragma("unroll") for (int m = 0; m < 4; ++m) _Pragma("unroll") for (int k = 0; k < 2; ++k) dst[m][k] = *(const LAS bf16x8*)(lds + G8_SA(b, h) + aoff + m * 2048 + k * 1024); } while (0)
#define G8_LDB(dst, b, h) do { _Pragma("unroll") for (int n = 0; n < 2; ++n) _Pragma("unroll") for (int k = 0; k < 2; ++k) dst[n][k] = *(const LAS bf16x8*)(lds + G8_SB(b, h) + boff + n * 2048 + k * 1024); } while (0)
#define G8_MMA(ai, bj, At, Bt) do { __builtin_amdgcn_s_setprio(1); _Pragma("unroll") for (int m = 0; m < 4; ++m) _Pragma("unroll") for (int n = 0; n < 2; ++n) _Pragma("unroll") for (int k = 0; k < 2; ++k) \
        acc[ai][bj][m][n] = __builtin_amdgcn_mfma_f32_16x16x32_bf16(Bt[n][k], At[m][k], acc[ai][bj][m][n], 0, 0, 0); __builtin_amdgcn_s_setprio(0); } while (0)
#define G8_WAIT_V(n) asm volatile("s_waitcnt vmcnt(" #n ")" ::: "memory")
#define G8_WAIT_L(n) asm volatile("s_waitcnt lgkmcnt(" #n ")" ::: "memory")
#define G8_BAR __builtin_amdgcn_s_barrier()
#define G8_SCHED __builtin_amdgcn_sched_barrier(0)
#define G8_SETVA(dst, u) do { int _t2 = tid; if (GATHER) asm volatile("" : "+v"(_t2)); _Pragma("unroll") for (int _h = 0; _h < 2; ++_h) _Pragma("unroll") for (int _i = 0; _i < 2; ++_i) { \
        int _R, _C; stage_rc(_t2 * 16 + _i * 8192, _R, _C); \
        const unsigned _rl = (unsigned)(_h * HALF + _R); unsigned _row = _rl; \
        if (GATHER) { const bool _ok = _rl < (unsigned)(u).nvalid; _row = (unsigned)(u).rows[_ok ? _rl : 0u] >> 3; if (!_ok) _row = 0u; }     \
        dst[_h][_i] = (_row * (unsigned)lda + (unsigned)_C) * 2u; } } while (0)
    Unit cur, nxt; int ui = 0;
    if (!S.next(0, cur)) return;
    f32x4 acc[2][2][4][2];
#pragma unroll
    for (int a = 0; a < 2; ++a)
#pragma unroll
        for (int b = 0; b < 2; ++b)
#pragma unroll
            for (int m = 0; m < 4; ++m)
#pragma unroll
                for (int n = 0; n < 2; ++n) acc[a][b][m][n] = (f32x4){0.f, 0.f, 0.f, 0.f};
    bf16x8 At[4][2], B0[2][2], B1[2][2];
    unsigned vAc[2][2]; unsigned xl00 = 0, xl01 = 0, xl10 = 0, xl11 = 0;
    G8_SETVA(vAc, cur);
    const char* cA = cur.A; const char* cB = cur.B;
    G8_STAGEB(G8_SB(0, 0), cB); G8_STAGEB(G8_SB(0, 1), cB + hstepB); G8_STAGE2(G8_SA(0, 0), cA, vAc[0][0], vAc[0][1]); G8_STAGE2(G8_SA(0, 1), cA, vAc[1][0], vAc[1][1]);
    if (wr == 1) G8_BAR;
    G8_WAIT_V(2); G8_BAR;
    G8_STAGEB(G8_SB(1, 0), cB + kstep); G8_STAGE2(G8_SA(1, 0), cA + kstep, vAc[0][0], vAc[0][1]); G8_STAGEB(G8_SB(1, 1), cB + hstepB + kstep);
    G8_WAIT_V(6); G8_BAR;
    for (;;) {
        const bool has_next = S.next(ui + 1, nxt);
        const char* nA = has_next ? nxt.A : cA; const char* nB = has_next ? nxt.B : cB;
        if (GATHER) { unsigned vAn[2][2]; if (has_next) { G8_SETVA(vAn, nxt); } else {
#pragma unroll
            for (int h = 0; h < 2; ++h)
#pragma unroll
                for (int i = 0; i < 2; ++i) vAn[h][i] = vAc[h][i]; }
            *stash = (v4u){vAn[0][0], vAn[0][1], vAn[1][0], vAn[1][1]}; }
#pragma unroll 1
        for (int t = 0; t < nt; t += 2) {
            const bool last = (t == nt - 2);
            const char* a1 = cA + (size_t)(t + 1) * kstep;
            const char* a2 = last ? nA : cA + (size_t)(t + 2) * kstep; const char* b2 = last ? nB : cB + (size_t)(t + 2) * kstep;
            const char* a3 = a2 + kstep; const char* b3 = b2 + kstep;
            unsigned x00 = vAc[0][0], x01 = vAc[0][1], x10 = vAc[1][0], x11 = vAc[1][1];
            if (GATHER) { if (last) { const v4u sv = *stash; x00 = sv.x; x01 = sv.y; x10 = sv.z; x11 = sv.w; } xl00 = x00; xl01 = x01; xl10 = x10; xl11 = x11; }
            G8_LDB(B0, 0, 0); G8_LDB(B1, 0, 1); G8_SCHED; G8_LDA(At, 0, 0); G8_STAGE2(G8_SA(1, 1), a1, vAc[1][0], vAc[1][1]);
            G8_WAIT_V(8); G8_WAIT_L(0); G8_BAR; G8_MMA(0, 0, At, B0); G8_MMA(0, 1, At, B1); G8_BAR; G8_SCHED;
            G8_LDA(At, 0, 1); G8_STAGEB(G8_SB(0, 0), b2); G8_STAGEB(G8_SB(0, 1), b2 + hstepB); G8_STAGE2(G8_SA(0, 0), a2, x00, x01);
            G8_WAIT_V(8); G8_WAIT_L(0); G8_BAR; G8_MMA(1, 0, At, B0); G8_MMA(1, 1, At, B1); G8_BAR; G8_SCHED;
            G8_LDB(B0, 1, 0); G8_LDB(B1, 1, 1); G8_SCHED; G8_LDA(At, 1, 0); G8_STAGE2(G8_SA(0, 1), a2, x10, x11);
            G8_WAIT_V(8); G8_WAIT_L(0); G8_BAR; G8_MMA(0, 0, At, B0); G8_MMA(0, 1, At, B1); G8_BAR; G8_SCHED;
            G8_LDA(At, 1, 1); G8_STAGEB(G8_SB(1, 0), b3); G8_STAGEB(G8_SB(1, 1), b3 + hstepB); G8_STAGE2(G8_SA(1, 0), a3, x00, x01);
            G8_WAIT_V(8); G8_WAIT_L(0); G8_BAR; G8_MMA(1, 0, At, B0); G8_MMA(1, 1, At, B1); G8_BAR; G8_SCHED;
        }
        if (wr == 0) G8_BAR;
        E(acc, cur, wr, wc, fr, fq);
        if (!has_next) break;
#pragma unroll
        for (int a = 0; a < 2; ++a)
#pragma unroll
            for (int b = 0; b < 2; ++b)
#pragma unroll
                for (int m = 0; m < 4; ++m)
#pragma unroll
                    for (int n = 0; n < 2; ++n) acc[a][b][m][n] = (f32x4){0.f, 0.f, 0.f, 0.f};
        cur = nxt; cA = nA; cB = nB; ++ui;
        if (GATHER) { vAc[0][0] = xl00; vAc[0][1] = xl01; vAc[1][0] = xl10; vAc[1][1] = xl11; }
        if (wr == 1) G8_BAR;
    }
    G8_WAIT_V(0);
    G8_BAR;
#undef G8_SA
#undef G8_SB
#undef G8_STAGE2
#undef G8_STAGEB
#undef G8_LDA
#undef G8_LDB
#undef G8_MMA
#undef G8_WAIT_V
#undef G8_WAIT_L
#undef G8_BAR
#undef G8_SCHED
#undef G8_SETVA
}

struct DenseSched {
    const char* A; const char* B; size_t a_tile, b_tile, agrp_stride; int agrp_shift, nM, nN, nwg, G, c;
    __device__ __forceinline__ void init(const void* A_, const void* B_, int M, int N, int lda, int ldb, int G_, int c_) {
        A = (const char*)A_; B = (const char*)B_; a_tile = (size_t)BM * lda * 2; b_tile = (size_t)BM * ldb * 2; agrp_stride = 0; agrp_shift = 0; nM = M / BM; nN = N / BM; nwg = nM * nN; G = G_; c = c_; }
    __device__ __forceinline__ bool next(int i, Unit& u) const {
        const long L = (long)i * G + c; if (L >= nwg) return false;
        int wgid = (int)L; { const int q = nwg / NXCD, r = nwg % NXCD, xcd = wgid % NXCD, off = wgid / NXCD; wgid = (xcd < r ? xcd * (q + 1) : r * (q + 1) + (xcd - r) * q) + off; }
        const int nig = WGM * nN, gid = wgid / nig, fm = gid * WGM, gsz = (nM - fm) < WGM ? (nM - fm) : WGM;
        u.pm = fm + ((wgid % nig) % gsz); u.pn = (wgid % nig) / gsz;
        u.A = A + (size_t)u.pm * a_tile + (size_t)(u.pn >> agrp_shift) * agrp_stride; u.B = B + (size_t)u.pn * b_tile; u.rows = nullptr; u.nvalid = BM; u.aux = 0; return true;
    }
};
template <int NPN, bool GATHERED>
struct ExpertSched {
    const LAS int* tpref; const LAS int* cnt; const char* A; const char* B; const int* tok; size_t b_exp, b_tile, a_tile; int NU, G, c;
    __device__ __forceinline__ bool next(int i, Unit& u) const {
        int L = i * G + c; if (L >= NU) return false;
        if ((i + 1) * G <= NU && (G % NXCD) == 0) L = i * G + (c % NXCD) * (G / NXCD) + c / NXCD;
        const int tile = L / NPN, pn = L % NPN;
        int e = 0; { int hi = 64;
#pragma unroll
          for (int it_ = 0; it_ < 6; ++it_) { const int mid = (e + hi) >> 1; if (__builtin_amdgcn_readfirstlane(tpref[mid]) <= tile) e = mid; else hi = mid; } }
        const int rb = tile - __builtin_amdgcn_readfirstlane(tpref[e]);
        u.pm = e; u.pn = pn; u.aux = tile * BM; u.nvalid = __builtin_amdgcn_readfirstlane(cnt[e]) - rb * BM; if (u.nvalid > BM) u.nvalid = BM;
        u.rows = tok + (size_t)e * CAP + rb * BM;
        u.A = GATHERED ? A : A + (size_t)tile * a_tile; u.B = B + (size_t)e * b_exp + (size_t)pn * b_tile; return true;
    }
};

struct EpiBf16 {
    static constexpr bool PERM = true;
    bf16* O; int ldc; int qscale;
    __device__ __forceinline__ void operator()(const f32x4 (&acc)[2][2][4][2], const Unit& u, int wr, int wc, int fr, int fq) const {
        asm volatile("" : "+v"(fr), "+v"(fq));
        const int row0 = u.pm * BM + wr * 64 + fr, col0 = u.pn * BM + wc * 32 + 8 * fq;
        const float sc = (qscale && (u.pn % 6) < 2) ? 0.125f : 1.0f;
#pragma unroll
        for (int ai = 0; ai < 2; ++ai)
#pragma unroll
            for (int m = 0; m < 4; ++m) { bf16* rowp = O + (size_t)(row0 + ai * HALF + m * 16) * ldc + col0;
#pragma unroll
                for (int bj = 0; bj < 2; ++bj) { const f32x4 v0 = acc[ai][bj][m][0] * sc, v1 = acc[ai][bj][m][1] * sc;
                    v4u w; w.x = cvt_pk_bf16(v0[0], v0[1]); w.y = cvt_pk_bf16(v0[2], v0[3]); w.z = cvt_pk_bf16(v1[0], v1[1]); w.w = cvt_pk_bf16(v1[2], v1[3]);
                    *(v4u*)(rowp + bj * HALF) = w; } }
    }
};
struct EpiScaleBf16 {
    static constexpr bool PERM = true;
    bf16* O; int ldc; const float* scale;
    __device__ __forceinline__ void operator()(const f32x4 (&acc)[2][2][4][2], const Unit& u, int wr, int wc, int fr, int fq) const {
        asm volatile("" : "+v"(fr), "+v"(fq));
        const int row0 = u.pm * BM + wr * 64 + fr, col0 = u.pn * BM + wc * 32 + 8 * fq;
        f32x4 sv[2][2];
#pragma unroll
        for (int bj = 0; bj < 2; ++bj)
#pragma unroll
            for (int n = 0; n < 2; ++n) sv[bj][n] = *(const f32x4*)(scale + col0 + bj * HALF + 4 * n);
#pragma unroll
        for (int ai = 0; ai < 2; ++ai)
#pragma unroll
            for (int m = 0; m < 4; ++m) { bf16* rowp = O + (size_t)(row0 + ai * HALF + m * 16) * ldc + col0;
#pragma unroll
                for (int bj = 0; bj < 2; ++bj) { const f32x4 v0 = acc[ai][bj][m][0] * sv[bj][0], v1 = acc[ai][bj][m][1] * sv[bj][1];
                    v4u w; w.x = cvt_pk_bf16(v0[0], v0[1]); w.y = cvt_pk_bf16(v0[2], v0[3]); w.z = cvt_pk_bf16(v1[0], v1[1]); w.w = cvt_pk_bf16(v1[2], v1[3]);
                    *(v4u*)(rowp + bj * HALF) = w; } }
    }
};
struct EpiResid {
    static constexpr bool PERM = false;
    const float* X; float* Y;
    __device__ __forceinline__ void operator()(const f32x4 (&acc)[2][2][4][2], const Unit& u, int wr, int wc, int fr, int fq) const {
        asm volatile("" : "+v"(fr), "+v"(fq));
        const int row0 = u.pm * BM + wr * 64 + fr, col0 = u.pn * BM + wc * 32 + 4 * fq;
#pragma unroll
        for (int ai = 0; ai < 2; ++ai)
#pragma unroll
            for (int m = 0; m < 4; ++m) { const size_t off = (size_t)(row0 + ai * HALF + m * 16) * D + col0;
#pragma unroll
                for (int bj = 0; bj < 2; ++bj)
#pragma unroll
                    for (int n = 0; n < 2; ++n) { const f32x4 xv = *(const f32x4*)(X + off + bj * HALF + n * 16); *(f32x4*)(Y + off + bj * HALF + n * 16) = xv * ALPHA + acc[ai][bj][m][n]; } }
    }
};
struct EpiResidLN {
    static constexpr bool PERM = true;
    const float* X32; const bf16* Xb; const float* st; const float* g; const float* b; bf16* Y; float* pst; int mode;
    __device__ __forceinline__ void operator()(const f32x4 (&acc)[2][2][4][2], const Unit& u, int wr, int wc, int fr, int fq) const {
        asm volatile("" : "+v"(fr), "+v"(fq));
        const int row0 = u.pm * BM + wr * 64 + fr, col0 = u.pn * BM + wc * 32 + 8 * fq, lane = fq * 16 + fr;
#pragma unroll
        for (int ai = 0; ai < 2; ++ai) {
            v4u xr[4][2];
#pragma unroll
            for (int m = 0; m < 4; ++m)
#pragma unroll
                for (int bj = 0; bj < 2; ++bj) xr[m][bj] = *(const v4u*)(Xb + (size_t)(row0 + ai * HALF + m * 16) * D + col0 + bj * HALF);
            asm volatile("" : "+v"(xr[0][0]), "+v"(xr[0][1]), "+v"(xr[1][0]), "+v"(xr[1][1]), "+v"(xr[2][0]), "+v"(xr[2][1]), "+v"(xr[3][0]), "+v"(xr[3][1]));
#pragma unroll
            for (int m = 0; m < 4; ++m) { const int row = row0 + ai * HALF + m * 16; const size_t off = (size_t)row * D + col0;
                float sm = 0.f, sq = 0.f;
#pragma unroll
                for (int bj = 0; bj < 2; ++bj) { const v4u xv = xr[m][bj];
                    const f32x4 x0 = (f32x4){bflo(xv.x), bfhi(xv.x), bflo(xv.y), bfhi(xv.y)}, x1 = (f32x4){bflo(xv.z), bfhi(xv.z), bflo(xv.w), bfhi(xv.w)};
                    const f32x4 y0 = x0 * ALPHA + acc[ai][bj][m][0], y1 = x1 * ALPHA + acc[ai][bj][m][1];
                    v4u w; w.x = cvt_pk_bf16(y0[0], y0[1]); w.y = cvt_pk_bf16(y0[2], y0[3]); w.z = cvt_pk_bf16(y1[0], y1[1]); w.w = cvt_pk_bf16(y1[2], y1[3]);
                    *(v4u*)(Y + off + bj * HALF) = w;
                    sm += ((y0[0] + y0[1]) + (y0[2] + y0[3])) + ((y1[0] + y1[1]) + (y1[2] + y1[3]));
                    sq += ((y0[0] * y0[0] + y0[1] * y0[1]) + (y0[2] * y0[2] + y0[3] * y0[3])) + ((y1[0] * y1[0] + y1[1] * y1[1]) + (y1[2] * y1[2] + y1[3] * y1[3])); }
                sm = sum_fq(sm); sq = sum_fq(sq);
                if (fq == 0) *(f32x2*)(pst + ((size_t)row * 32 + u.pn * 4 + wc) * 2) = (f32x2){sm, sq}; } }
    }
};
struct EpiConvIn {
    static constexpr bool PERM = true;
    bf16* UC; bf16* BGp;
    __device__ __forceinline__ void operator()(const f32x4 (&acc)[2][2][4][2], const Unit& u, int wr, int wc, int fr, int fq) const {
        asm volatile("" : "+v"(fr), "+v"(fq));
        const int row0 = u.pm * BM + wr * 64 + fr, cw = wc * 32 + 8 * fq;
        if (u.pn < 16) {
#pragma unroll
            for (int ai = 0; ai < 2; ++ai)
#pragma unroll
                for (int m = 0; m < 4; ++m) { bf16* rowp = UC + (size_t)(row0 + ai * HALF + m * 16) * D + u.pn * HALF + cw;
                    const f32x4 v0 = acc[ai][0][m][0] * acc[ai][1][m][0], v1 = acc[ai][0][m][1] * acc[ai][1][m][1];
                    v4u w; w.x = cvt_pk_bf16(v0[0], v0[1]); w.y = cvt_pk_bf16(v0[2], v0[3]); w.z = cvt_pk_bf16(v1[0], v1[1]); w.w = cvt_pk_bf16(v1[2], v1[3]);
                    *(v4u*)rowp = w; }
        } else {
#pragma unroll
            for (int ai = 0; ai < 2; ++ai)
#pragma unroll
                for (int m = 0; m < 4; ++m) { bf16* rowp = BGp + (size_t)(row0 + ai * HALF + m * 16) * D + (u.pn - 16) * BM + cw;
#pragma unroll
                    for (int bj = 0; bj < 2; ++bj) { const f32x4 v0 = acc[ai][bj][m][0], v1 = acc[ai][bj][m][1];
                        v4u w; w.x = cvt_pk_bf16(v0[0], v0[1]); w.y = cvt_pk_bf16(v0[2], v0[3]); w.z = cvt_pk_bf16(v1[0], v1[1]); w.w = cvt_pk_bf16(v1[2], v1[3]);
                        *(v4u*)(rowp + bj * HALF) = w; } }
        }
    }
};
__device__ __forceinline__ f32x4 silu_mul(f32x4 g, f32x4 uu) {
    f32x4 r;
#pragma unroll
    for (int j = 0; j < 4; ++j) r[j] = g[j] * __builtin_amdgcn_rcpf(1.0f + __expf(-g[j])) * uu[j];
    return r;
}
struct EpiExpertGU {
    static constexpr bool PERM = true;
    bf16* H;
    __device__ __forceinline__ void operator()(const f32x4 (&acc)[2][2][4][2], const Unit& u, int wr, int wc, int fr, int fq) const {
        asm volatile("" : "+v"(fr), "+v"(fq));
        const float* gates = (const float*)((const char*)u.rows + (WS_LGATE - WS_LTOK));
        const int cw = wc * 32 + 8 * fq;
        float gtv[2][4];
#pragma unroll
        for (int ai = 0; ai < 2; ++ai)
#pragma unroll
            for (int m = 0; m < 4; ++m) { const int r = ai * HALF + wr * 64 + m * 16 + fr; gtv[ai][m] = gates[r < u.nvalid ? r : 0]; }
        asm volatile("" : "+v"(gtv[0][0]), "+v"(gtv[0][1]), "+v"(gtv[0][2]), "+v"(gtv[0][3]), "+v"(gtv[1][0]), "+v"(gtv[1][1]), "+v"(gtv[1][2]), "+v"(gtv[1][3]));
#pragma unroll
        for (int ai = 0; ai < 2; ++ai)
#pragma unroll
            for (int m = 0; m < 4; ++m) { const int r = ai * HALF + wr * 64 + m * 16 + fr;
                if (r < u.nvalid) { const float gt = gtv[ai][m]; const unsigned pid = 0u;
                    const f32x4 v0 = silu_mul(acc[ai][0][m][0], acc[ai][1][m][0]) * gt, v1 = silu_mul(acc[ai][0][m][1], acc[ai][1][m][1]) * gt;
                    v4u w; w.x = cvt_pk_bf16(v0[0], v0[1]); w.y = cvt_pk_bf16(v0[2], v0[3]); w.z = cvt_pk_bf16(v1[0], v1[1]); w.w = cvt_pk_bf16(v1[2], v1[3]);
                    (void)pid; *(v4u*)(H + (size_t)(u.aux + r) * EDIM + cw) = w; } }
    }
};
struct EpiSharedGU {
    static constexpr bool PERM = true;
    bf16* HS;
    __device__ __forceinline__ void operator()(const f32x4 (&acc)[2][2][4][2], const Unit& u, int wr, int wc, int fr, int fq) const {
        asm volatile("" : "+v"(fr), "+v"(fq));
        const int row0 = u.pm * BM + wr * 64 + fr, cw = u.pn * HALF + wc * 32 + 8 * fq;
#pragma unroll
        for (int ai = 0; ai < 2; ++ai)
#pragma unroll
            for (int m = 0; m < 4; ++m) {
                const f32x4 v0 = silu_mul(acc[ai][0][m][0], acc[ai][1][m][0]), v1 = silu_mul(acc[ai][0][m][1], acc[ai][1][m][1]);
                v4u w; w.x = cvt_pk_bf16(v0[0], v0[1]); w.y = cvt_pk_bf16(v0[2], v0[3]); w.z = cvt_pk_bf16(v1[0], v1[1]); w.w = cvt_pk_bf16(v1[2], v1[3]);
                *(v4u*)(HS + (size_t)(row0 + ai * HALF + m * 16) * SDIM + cw) = w; }
    }
};
struct EpiDownY {
    static constexpr bool PERM = true;
    bf16* Y;
    __device__ __forceinline__ void operator()(const f32x4 (&acc)[2][2][4][2], const Unit& u, int wr, int wc, int fr, int fq) const {
        asm volatile("" : "+v"(fr), "+v"(fq));
        const int col0 = u.pn * BM + wc * 32 + 8 * fq;
#pragma unroll
        for (int ai = 0; ai < 2; ++ai)
#pragma unroll
            for (int m = 0; m < 4; ++m) { const int r = ai * HALF + wr * 64 + m * 16 + fr; bf16* rowp = Y + (size_t)(u.aux + r) * D + col0;
#pragma unroll
                for (int bj = 0; bj < 2; ++bj) { const f32x4 v0 = acc[ai][bj][m][0], v1 = acc[ai][bj][m][1];
                    v4u w; w.x = cvt_pk_bf16(v0[0], v0[1]); w.y = cvt_pk_bf16(v0[2], v0[3]); w.z = cvt_pk_bf16(v1[0], v1[1]); w.w = cvt_pk_bf16(v1[2], v1[3]);
                    *(v4u*)(rowp + bj * HALF) = w; } }
    }
};
}

struct Args { const float* in[19]; float* out; unsigned char* ws; int ph_lo, ph_hi; };
struct Frame {
    LAS unsigned char* lds; unsigned* ctl; unsigned char* ws;
    int tid, lane, wave, G, bid;
};
enum { IN_X = 0, IN_RELB, IN_PWIN, IN_PWG, IN_PSC, IN_PWOUT, IN_DQKV, IN_DOUT, IN_CWIN, IN_CW, IN_CWOUT, IN_LNG, IN_LNB, IN_RW, IN_RB, IN_EGU, IN_ED, IN_SGU, IN_SD };

#define CAS __attribute__((address_space(4)))
typedef const CAS unsigned char* KP;
__device__ __forceinline__ const float* ain(KP kp, int i) { return (const float*)((const GAS float* const CAS*)kp)[i]; }
__device__ __forceinline__ float* aout(KP kp) { return (float*)((GAS float* const CAS*)kp)[19]; }
__device__ __forceinline__ void tr_item(const float* W, int K, int N, bf16* WT, int dstK, int mode, LAS float* scr, int item, int lane) {
    const int nblk = N / 32, kb = item / nblk, nb = item % nblk, k0 = 64 * kb, n0 = 32 * nb;
    int r0 = n0;
    if (mode == 1) { const int part = n0 / 2048, j = n0 % 2048; r0 = (part == 0) ? 4096 + j : 256 * (j / 128) + (part == 2 ? 128 : 0) + (j % 128); }
    if (mode == 2) { const int part = n0 / 256, j = n0 % 256; r0 = 256 * (j / 128) + 128 * part + (j % 128); }
    float wv[32];
#pragma unroll
    for (int i = 0; i < 32; ++i) { const int kk = 2 * i + (lane >> 5); wv[i] = __builtin_nontemporal_load(W + (size_t)(k0 + kk) * N + n0 + (lane & 31)); }
#pragma unroll
    for (int i = 0; i < 32; ++i) { const int kk = 2 * i + (lane >> 5); scr[kk * 33 + (lane & 31)] = wv[i]; }
    LDS_WAIT(); asm volatile("" ::: "memory");
    const int c = lane & 7;
#pragma unroll
    for (int j = 0; j < 4; ++j) { const int n = (lane >> 3) + 8 * j; const LAS float* s = scr + (8 * c) * 33 + n;
        v4u o; o.x = pk2(s[0 * 33], s[1 * 33]); o.y = pk2(s[2 * 33], s[3 * 33]); o.z = pk2(s[4 * 33], s[5 * 33]); o.w = pk2(s[6 * 33], s[7 * 33]);
        __builtin_nontemporal_store(o, (v4u*)(WT + (size_t)(r0 + n) * dstK + k0 + 8 * c)); }
    LDS_WAIT(); asm volatile("" ::: "memory");
}
__device__ __forceinline__ void phase_prologue(const Frame& F, KP kp) {
    LAS float* scr = (LAS float*)(F.lds + F.wave * 16384);
    const int gw = F.bid * 8 + F.wave, NGW = F.G * 8;
    constexpr int I0 = 2 * 2048, I1 = 8 * 128, I2 = 2 * 2048, I3 = 4608, I4 = 512, I5 = 6144, I6 = 2048, I7 = 4 * 512, I8 = 4 * 256, I9 = 256 * 256, I10 = 256 * 128;
    constexpr int NITEMS = I0 + I1 + I2 + I3 + I4 + I5 + I6 + I7 + I8 + I9 + I10;
    unsigned char* ws = F.ws;
    for (int it = gw; it < NITEMS; it += NGW) {
        int r = it;
        if (r < I0) { const int b = r / 2048; tr_item(ain(kp, IN_PWIN) + (size_t)b * D * D, D, D, (bf16*)(ws + WS_W_POOL_IN) + (size_t)b * D * D, D, 0, scr, r % 2048, F.lane); continue; } r -= I0;
        if (r < I1) { const int b = r / 128; tr_item(ain(kp, IN_PWG) + (size_t)b * 512 * 512, 512, 512, (bf16*)(ws + WS_W_POOL_G) + (size_t)b * 512 * 512, 512, 0, scr, r % 128, F.lane); continue; } r -= I1;
        if (r < I2) { const int b = r / 2048; tr_item(ain(kp, IN_PWOUT) + (size_t)b * D * D, D, D, (bf16*)(ws + WS_W_POOL_OUT) + (size_t)b * D * D, D, 0, scr, r % 2048, F.lane); continue; } r -= I2;
        if (r < I3) { tr_item(ain(kp, IN_DQKV), D, QKVC, (bf16*)(ws + WS_W_DIL_QKV), D, 0, scr, r, F.lane); continue; } r -= I3;
        if (r < I4) { tr_item(ain(kp, IN_DOUT), DILW, D, (bf16*)(ws + WS_W_DIL_OUT), DILW, 0, scr, r, F.lane); continue; } r -= I4;
        if (r < I5) { tr_item(ain(kp, IN_CWIN), D, 3 * D, (bf16*)(ws + WS_W_CONV_IN), D, 1, scr, r, F.lane); continue; } r -= I5;
        if (r < I6) { tr_item(ain(kp, IN_CWOUT), D, D, (bf16*)(ws + WS_W_CONV_OUT), D, 0, scr, r, F.lane); continue; } r -= I6;
        if (r < I7) { const int b = r / 512; tr_item(ain(kp, IN_SGU) + (size_t)b * D * 512, D, 512, (bf16*)(ws + WS_W_SH_GU) + (size_t)b * 512 * D, D, 2, scr, r % 512, F.lane); continue; } r -= I7;
        if (r < I8) { const int b = r / 256; tr_item(ain(kp, IN_SD) + (size_t)b * SDIM * D, SDIM, D, (bf16*)(ws + WS_W_SH_D) + (size_t)b * D * SDIM, SDIM, 0, scr, r % 256, F.lane); continue; } r -= I8;
        if (r < I9) { const int b = r / 256; tr_item(ain(kp, IN_EGU) + (size_t)b * D * 256, D, 256, (bf16*)(ws + WS_W_EX_GU) + (size_t)b * 256 * D, D, 0, scr, r % 256, F.lane); continue; } r -= I9;
        { const int b = r / 128; tr_item(ain(kp, IN_ED) + (size_t)b * EDIM * D, EDIM, D, (bf16*)(ws + WS_W_EX_D) + (size_t)b * D * EDIM, EDIM, 0, scr, r % 128, F.lane); }
    }
    const size_t gt = (size_t)F.bid * 512 + F.tid, GT = (size_t)F.G * 512;
    { const float* rw = ain(kp, IN_RW); bf16* wh = (bf16*)(ws + WS_RWH); bf16* wl = (bf16*)(ws + WS_RWL);
      for (size_t i = gt; i < (size_t)DEPTH * NEXP * D / 8; i += GT) { const size_t k8 = i % (D / 8), e = (i / (D / 8)) % NEXP, l = i / ((size_t)NEXP * D / 8);
          float v[8]; unsigned hi[8], lo[8];
#pragma unroll
          for (int j = 0; j < 8; ++j) { v[j] = rw[(l * D + k8 * 8 + j) * NEXP + e]; hi[j] = f2bf(v[j]); lo[j] = f2bf(v[j] - __builtin_bit_cast(float, hi[j] << 16)); }
          v4u a, b2; a.x = hi[0] | (hi[1] << 16); a.y = hi[2] | (hi[3] << 16); a.z = hi[4] | (hi[5] << 16); a.w = hi[6] | (hi[7] << 16);
          b2.x = lo[0] | (lo[1] << 16); b2.y = lo[2] | (lo[3] << 16); b2.z = lo[4] | (lo[5] << 16); b2.w = lo[6] | (lo[7] << 16);
          *(v4u*)(wh + (l * NEXP + e) * D + k8 * 8) = a; *(v4u*)(wl + (l * NEXP + e) * D + k8 * 8) = b2; } }
    const float* x = ain(kp, IN_X); bf16* xb = (bf16*)(ws + WS_XB);
    for (size_t i = gt; i < (size_t)T * D / 8; i += GT) { const f32x4 p = __builtin_nontemporal_load((const f32x4*)(x + i * 8)), q = __builtin_nontemporal_load((const f32x4*)(x + i * 8 + 4));
        v4u w; w.x = pk2(p[0], p[1]); w.y = pk2(p[2], p[3]); w.z = pk2(q[0], q[1]); w.w = pk2(q[2], q[3]); *(v4u*)(xb + i * 8) = w; }
}

__device__ __forceinline__ void unpack8(const v4u w, float (&f)[8]) { f[0] = bflo(w.x); f[1] = bfhi(w.x); f[2] = bflo(w.y); f[3] = bfhi(w.y); f[4] = bflo(w.z); f[5] = bfhi(w.z); f[6] = bflo(w.w); f[7] = bfhi(w.w); }
__device__ __forceinline__ void phase_pool(const Frame& F, const bf16* U, bf16* PL) {
    for (int it = F.bid * 512 + F.tid; it < (T / 32) * 256; it += F.G * 512) {
        const int cv = it & 255, ch = it >> 8, col = cv * 8;
        const int w = __builtin_amdgcn_readfirstlane(2 << (col >> 9));
        const int row0 = __builtin_amdgcn_readfirstlane(ch * 32), pos0 = row0 & (SEQ - 1);
        float s[8], uu[8];
#pragma unroll
        for (int j = 0; j < 8; ++j) s[j] = 0.f;
        { v4u pre[15];
#pragma unroll
          for (int j = 0; j < 15; ++j) { pre[j] = (v4u){0u, 0u, 0u, 0u}; if (j + 1 < w && pos0 - (j + 1) >= 0) pre[j] = *(const v4u*)(U + (size_t)(row0 - (j + 1)) * D + col); }
#pragma unroll
          for (int j = 0; j < 15; ++j) asm volatile("" : "+v"(pre[j]));
#pragma unroll
          for (int j = 0; j < 15; ++j) { unpack8(pre[j], uu);
#pragma unroll
              for (int q = 0; q < 8; ++q) s[q] += uu[q]; } }
#pragma unroll 1
        for (int cb = 0; cb < 4; ++cb) {
            v4u un[8], uo[8];
#pragma unroll
            for (int j = 0; j < 8; ++j) { const int r = 8 * cb + j, t = row0 + r, pos = pos0 + r;
                un[j] = *(const v4u*)(U + (size_t)t * D + col);
                uo[j] = (v4u){0u, 0u, 0u, 0u}; if (pos - w + 1 >= 0) uo[j] = *(const v4u*)(U + (size_t)(t - w + 1) * D + col); }
#pragma unroll
            for (int j = 0; j < 8; ++j) asm volatile("" : "+v"(un[j]), "+v"(uo[j]));
#pragma unroll
            for (int j = 0; j < 8; ++j) { const int r = 8 * cb + j, t = row0 + r, pos = pos0 + r;
                unpack8(un[j], uu);
                const float inv = 1.0f / (float)((pos + 1) < w ? (pos + 1) : w);
                float o[8];
#pragma unroll
                for (int q = 0; q < 8; ++q) { s[q] += uu[q]; o[q] = s[q] * inv - uu[q]; }
                v4u ww; ww.x = pk2(o[0], o[1]); ww.y = pk2(o[2], o[3]); ww.z = pk2(o[4], o[5]); ww.w = pk2(o[6], o[7]);
                *(v4u*)(PL + (size_t)t * D + col) = ww;
                unpack8(uo[j], uu);
#pragma unroll
                for (int q = 0; q < 8; ++q) s[q] -= uu[q]; }
        }
    }
}

__device__ __forceinline__ void phase_conv(const Frame& F, const bf16* UC, const bf16* BGp, const float* cw, bf16* Z) {
    for (int it = F.bid * 512 + F.tid; it < (T / 4) * 256; it += F.G * 512) {
        const int cv = it & 255, col = cv * 8, t0 = __builtin_amdgcn_readfirstlane((it >> 8) * 4), pos0 = t0 & (SEQ - 1);
        v4u ur[6], br[4];
#pragma unroll
        for (int j = 0; j < 6; ++j) { ur[j] = (v4u){0u, 0u, 0u, 0u}; if (j >= 2 || pos0 > 0) ur[j] = *(const v4u*)(UC + (size_t)(t0 - 2 + j) * D + col); }
#pragma unroll
        for (int j = 0; j < 4; ++j) br[j] = *(const v4u*)(BGp + (size_t)(t0 + j) * D + col);
        const f32x4 c0a = *(const f32x4*)(cw + col), c0b = *(const f32x4*)(cw + col + 4), c1a = *(const f32x4*)(cw + D + col), c1b = *(const f32x4*)(cw + D + col + 4), c2a = *(const f32x4*)(cw + 2 * D + col), c2b = *(const f32x4*)(cw + 2 * D + col + 4);
        asm volatile("" : "+v"(ur[0]), "+v"(ur[1]), "+v"(ur[2]), "+v"(ur[3]), "+v"(ur[4]), "+v"(ur[5]), "+v"(br[0]), "+v"(br[1]), "+v"(br[2]), "+v"(br[3]));
        const float c0[8] = {c0a[0], c0a[1], c0a[2], c0a[3], c0b[0], c0b[1], c0b[2], c0b[3]}, c1[8] = {c1a[0], c1a[1], c1a[2], c1a[3], c1b[0], c1b[1], c1b[2], c1b[3]}, c2[8] = {c2a[0], c2a[1], c2a[2], c2a[3], c2b[0], c2b[1], c2b[2], c2b[3]};
#pragma unroll
        for (int j = 0; j < 4; ++j) { float u0[8], u1[8], u2[8], bb[8], o[8];
            unpack8(ur[j], u0); unpack8(ur[j + 1], u1); unpack8(ur[j + 2], u2); unpack8(br[j], bb);
#pragma unroll
            for (int q = 0; q < 8; ++q) o[q] = bb[q] * (c0[q] * u0[q] + c1[q] * u1[q] + c2[q] * u2[q]);
            v4u ww; ww.x = pk2(o[0], o[1]); ww.y = pk2(o[2], o[3]); ww.z = pk2(o[4], o[5]); ww.w = pk2(o[6], o[7]);
            *(v4u*)(Z + (size_t)(t0 + j) * D + col) = ww; }
    }
}

__device__ __forceinline__ int t5_bucket(int dist) {
    if (dist < 16) return dist;
    int large = 16 + (int)(logf((float)dist / 16.0f) / logf(128.0f) * 16.0f);
    return large < 31 ? large : 31;
}
constexpr int AT_KS = 0, AT_KSTR = 144, AT_VT = 256 * 144, AT_VSTR = 520, AT_BIAS = AT_VT + 64 * 520;
__device__ __forceinline__ void phase_attn(const Frame& F, const bf16* QKV, const float* relb, bf16* OG, float* LSE) {
    LAS unsigned char* lds = F.lds;
    const int tid = F.tid, lane = F.lane, w = tid >> 6, fr = lane & 15, fq = lane >> 4;
    for (int unit = F.bid; unit < NBATCH * 3 * 8 * 16; unit += F.G) {
        const int cmb = unit & 15, h = (unit >> 4) & 7, g = (unit >> 7) % 3, b = unit / 384;
        const int dsh = 2 * g, dil = 1 << dsh, r = cmb & (dil - 1), nb = cmb >> dsh;
        const bf16* base = QKV + (size_t)b * SEQ * QKVC + g * 1536 + h * 64;
        __syncthreads();
        {
            const int key = tid >> 1, half = tid & 1, jk = (nb - 1) * 128 + key;
            v4u kv[4], vv[4];
            if (jk >= 0) { const bf16* rp = base + (size_t)(jk * dil + r) * QKVC + half * 32;
#pragma unroll
                for (int i = 0; i < 4; ++i) { kv[i] = *(const v4u*)(rp + 512 + 8 * i); vv[i] = *(const v4u*)(rp + 1024 + 8 * i); } }
            else {
#pragma unroll
                for (int i = 0; i < 4; ++i) { kv[i] = (v4u){0u, 0u, 0u, 0u}; vv[i] = (v4u){0u, 0u, 0u, 0u}; } }
#pragma unroll
            for (int i = 0; i < 4; ++i) *(LAS v4u*)(lds + AT_KS + key * AT_KSTR + half * 64 + 16 * i) = kv[i];
#pragma unroll
            for (int i = 0; i < 4; ++i) {
                const unsigned ww[4] = {vv[i].x, vv[i].y, vv[i].z, vv[i].w};
#pragma unroll
                for (int q = 0; q < 4; ++q) { const int d = half * 32 + 8 * i + 2 * q;
                    *(LAS unsigned short*)(lds + AT_VT + d * AT_VSTR + key * 2) = (unsigned short)(ww[q] & 0xffffu);
                    *(LAS unsigned short*)(lds + AT_VT + (d + 1) * AT_VSTR + key * 2) = (unsigned short)(ww[q] >> 16); } }
            if (tid <= 128) ((LAS float*)(lds + AT_BIAS))[tid] = relb[t5_bucket(tid * dil) * 24 + g * 8 + h];
        }
        __syncthreads();
        int qi = 16 * w + fr; asm volatile("" : "+v"(qi));
        const int jq = nb * 128 + qi, tq = jq * dil + r;
        const bf16* qp = base + (size_t)tq * QKVC + 8 * fq;
        const bf16x8 q0 = *(const bf16x8*)qp, q1 = *(const bf16x8*)(qp + 32);
        f32x4 s[9]; float mx = -INFINITY;
#pragma unroll
        for (int kt = 0; kt < 9; ++kt) {
            const int kb = 16 * (w + kt);
            const bf16x8 k0 = *(const LAS bf16x8*)(lds + AT_KS + (kb + fr) * AT_KSTR + fq * 16), k1 = *(const LAS bf16x8*)(lds + AT_KS + (kb + fr) * AT_KSTR + 64 + fq * 16);
            f32x4 a = (f32x4){0.f, 0.f, 0.f, 0.f};
            a = __builtin_amdgcn_mfma_f32_16x16x32_bf16(k0, q0, a, 0, 0, 0);
            a = __builtin_amdgcn_mfma_f32_16x16x32_bf16(k1, q1, a, 0, 0, 0);
#pragma unroll
            for (int i = 0; i < 4; ++i) { const int kl = kb + 4 * fq + i, rel = qi + 128 - kl;
                const bool ok = (rel >= 0) && (rel <= 128) && (nb > 0 || kl >= 128);
                const int rc = rel < 0 ? 0 : (rel > 128 ? 128 : rel);
                float bv_ = ((LAS float*)(lds + AT_BIAS))[rc]; asm volatile("" : "+v"(bv_));
                const float v = ok ? a[i] + bv_ : -INFINITY;
                a[i] = v; mx = fmaxf(mx, v); }
            s[kt] = a;
        }
        mx = max_fq(mx);
        float l = 0.f;
#pragma unroll
        for (int kt = 0; kt < 9; ++kt)
#pragma unroll
            for (int i = 0; i < 4; ++i) { const float p = __expf(s[kt][i] - mx); s[kt][i] = p; l += p; }
        l = sum_fq(l);
        f32x4 o[4];
#pragma unroll
        for (int nt = 0; nt < 4; ++nt) o[nt] = (f32x4){0.f, 0.f, 0.f, 0.f};
#pragma unroll
        for (int st = 0; st < 5; ++st) {
            const int kt0 = 2 * st, kt1 = 2 * st + 1;
            v4u pw; pw.x = pk2(s[kt0][0], s[kt0][1]); pw.y = pk2(s[kt0][2], s[kt0][3]);
            if (kt1 < 9) { pw.z = pk2(s[kt1 < 9 ? kt1 : 0][0], s[kt1 < 9 ? kt1 : 0][1]); pw.w = pk2(s[kt1 < 9 ? kt1 : 0][2], s[kt1 < 9 ? kt1 : 0][3]); } else { pw.z = 0u; pw.w = 0u; }
            const bf16x8 pf = __builtin_bit_cast(bf16x8, pw);
            const int kb0 = 16 * (w + kt0) + 4 * fq, kb1 = 16 * (w + kt1) + 4 * fq;
#pragma unroll
            for (int nt = 0; nt < 4; ++nt) { const int d = 16 * nt + fr;
                v2u va = *(const LAS v2u*)(lds + AT_VT + d * AT_VSTR + kb0 * 2), vb = (v2u){0u, 0u};
                if (kt1 < 9) vb = *(const LAS v2u*)(lds + AT_VT + d * AT_VSTR + kb1 * 2);
                v4u vw; vw.x = va.x; vw.y = va.y; vw.z = vb.x; vw.w = vb.y;
                o[nt] = __builtin_amdgcn_mfma_f32_16x16x32_bf16(__builtin_bit_cast(bf16x8, vw), pf, o[nt], 0, 0, 0); }
        }
        const float il = 1.0f / l;
        bf16* op = OG + ((size_t)g * T + (size_t)b * SEQ + tq) * DILW + h * 64 + 4 * fq;
#pragma unroll
        for (int nt = 0; nt < 4; ++nt) { v2u ww; ww.x = pk2(o[nt][0] * il, o[nt][1] * il); ww.y = pk2(o[nt][2] * il, o[nt][3] * il); *(v2u*)(op + 16 * nt) = ww; }
        if (fq == 0) LSE[((size_t)g * T + (size_t)b * SEQ + tq) * 8 + h] = mx + logf(l);
    }
}
__device__ __forceinline__ void phase_combine(const Frame& F, const bf16* OG, const float* LSE, bf16* O) {
    for (int it0 = F.bid * 512 + F.tid; it0 < T * 64; it0 += 4 * F.G * 512) {
        float ls[4][3]; v4u og[4][3];
#pragma unroll
        for (int u = 0; u < 4; ++u) { int it = it0 + u * F.G * 512; it = it < T * 64 ? it : it0;
            const int c8 = it & 7, h = (it >> 3) & 7, t = it >> 6; const size_t off = (size_t)t * DILW + h * 64 + c8 * 8;
#pragma unroll
            for (int g = 0; g < 3; ++g) { ls[u][g] = LSE[((size_t)g * T + t) * 8 + h]; og[u][g] = *(const v4u*)(OG + (size_t)g * T * DILW + off); } }
#pragma unroll
        for (int u = 0; u < 4; ++u) asm volatile("" : "+v"(ls[u][0]), "+v"(ls[u][1]), "+v"(ls[u][2]), "+v"(og[u][0]), "+v"(og[u][1]), "+v"(og[u][2]));
#pragma unroll
        for (int u = 0; u < 4; ++u) { const int it = it0 + u * F.G * 512, c8 = it & 7, h = (it >> 3) & 7, t = it >> 6; const size_t off = (size_t)t * DILW + h * 64 + c8 * 8;
            if (it >= T * 64) continue;
            const float l0 = ls[u][0], l1 = ls[u][1], l2 = ls[u][2];
            const float m = fmaxf(l0, fmaxf(l1, l2)); float w0 = __expf(l0 - m), w1 = __expf(l1 - m), w2 = __expf(l2 - m); const float inv = 1.0f / (w0 + w1 + w2); w0 *= inv; w1 *= inv; w2 *= inv;
            float a[8], bq[8], c[8], o[8];
            unpack8(og[u][0], a); unpack8(og[u][1], bq); unpack8(og[u][2], c);
#pragma unroll
            for (int q = 0; q < 8; ++q) o[q] = w0 * a[q] + w1 * bq[q] + w2 * c[q];
            v4u ww; ww.x = pk2(o[0], o[1]); ww.y = pk2(o[2], o[3]); ww.z = pk2(o[4], o[5]); ww.w = pk2(o[6], o[7]);
            *(v4u*)(O + off) = ww; }
    }
}

constexpr int M1_LOG = 131072, M1_STAT = M1_LOG + 4096, M1_HIST = M1_STAT + 128, M1_BASE = M1_HIST + 256;
__device__ __forceinline__ void phase_moe1(const Frame& F, const float* Y, const float* gain, const float* bias, const float* RW, const float* RB,
                                           float* X1F, bf16* X1B, unsigned* cnt, int* ltok, float* lgate, int* eidx, int* inv) {
    LAS float* xs = (LAS float*)F.lds; LAS float* logit = (LAS float*)(F.lds + M1_LOG); LAS float* stat = (LAS float*)(F.lds + M1_STAT);
    LAS int* hist = (LAS int*)(F.lds + M1_HIST); LAS int* basep = (LAS int*)(F.lds + M1_BASE);
    const int tid = F.tid, lane = F.lane, w = F.wave;
    for (int rg = F.bid; rg < T / 16; rg += F.G) {
        const int row0 = rg * 16;
        __syncthreads();
#pragma unroll
        for (int j = 0; j < 16; ++j) { const int idx = tid + 512 * j; *(LAS f32x4*)(xs + idx * 4) = *(const f32x4*)(Y + (size_t)row0 * D + (size_t)idx * 4); }
        if (tid < 64) hist[tid] = 0;
        __syncthreads();
#pragma unroll
        for (int rr = 0; rr < 2; ++rr) { const int r = 2 * w + rr; float sm = 0.f;
#pragma unroll
            for (int j = 0; j < 32; ++j) sm += xs[r * D + lane + 64 * j];
            const float mean = wave_sum(sm, lane) * (1.0f / D); float sq = 0.f;
#pragma unroll
            for (int j = 0; j < 32; ++j) { const float d = xs[r * D + lane + 64 * j] - mean; sq += d * d; }
            const float rstd = 1.0f / sqrtf(wave_sum(sq, lane) * (1.0f / D) + LN_EPS);
            if (lane == 0) { stat[2 * r] = mean; stat[2 * r + 1] = rstd; } }
        __syncthreads();
#pragma unroll
        for (int j = 0; j < 16; ++j) { const int idx = tid + 512 * j, r = idx >> 9, c4 = (idx & 511) * 4;
            const f32x4 v = *(LAS f32x4*)(xs + idx * 4), gv = *(const f32x4*)(gain + c4), bv = *(const f32x4*)(bias + c4);
            const float mean = stat[2 * r], rstd = stat[2 * r + 1];
            const f32x4 o = (v - mean) * rstd * gv + bv;
            *(LAS f32x4*)(xs + idx * 4) = o;
            *(f32x4*)(X1F + (size_t)(row0 + r) * D + c4) = o;
            v2u wb; wb.x = pk2(o[0], o[1]); wb.y = pk2(o[2], o[3]); *(v2u*)(X1B + (size_t)(row0 + r) * D + c4) = wb; }
        __syncthreads();
        { const int r = tid >> 5, ep = tid & 31; float a0 = 0.f, a1 = 0.f; const float* wp = RW + 2 * ep; const LAS float* xr = xs + r * D;
            for (int k0 = 0; k0 < D; k0 += 16) {
                f32x2 wv[16];
#pragma unroll
                for (int j = 0; j < 16; ++j) wv[j] = *(const f32x2*)(wp + (size_t)(k0 + j) * NEXP);
                asm volatile("" : "+v"(wv[0]), "+v"(wv[1]), "+v"(wv[2]), "+v"(wv[3]), "+v"(wv[4]), "+v"(wv[5]), "+v"(wv[6]), "+v"(wv[7]));
                asm volatile("" : "+v"(wv[8]), "+v"(wv[9]), "+v"(wv[10]), "+v"(wv[11]), "+v"(wv[12]), "+v"(wv[13]), "+v"(wv[14]), "+v"(wv[15]));
#pragma unroll
                for (int j = 0; j < 16; ++j) { const float xv = xr[k0 + j]; a0 += xv * wv[j].x; a1 += xv * wv[j].y; } }
            logit[r * NEXP + 2 * ep] = a0; logit[r * NEXP + 2 * ep + 1] = a1; }
        __syncthreads();
        int sel_pos[2]; float sel_gate[2]; int sel_rank[2]; bool sel_on[2];
#pragma unroll
        for (int rr = 0; rr < 2; ++rr) { const int r = 2 * w + rr;
            const float sc = 1.0f / (1.0f + __expf(-logit[r * NEXP + lane])); const float ch = sc + RB[lane];
            int rk = 0;
#pragma unroll
            for (int j = 0; j < 8; ++j) { const float cj = shfl_from(ch, (lane & ~7) + j); rk += (cj > ch || (cj == ch && j < (lane & 7))) ? 1 : 0; }
            float gs = rk < 2 ? ch : 0.f; gs += shfl_x(gs, 1, lane); gs += shfl_x(gs, 2, lane); gs += shfl_x(gs, 4, lane);
            int grk = 0; const int g = lane >> 3;
#pragma unroll
            for (int hh = 0; hh < 8; ++hh) { const float gh = shfl_from(gs, 8 * hh); grk += (gh > gs || (gh == gs && hh < g)) ? 1 : 0; }
            const float msk = grk < 4 ? ch : -INFINITY;
            int erk = 0;
            for (int j = 0; j < 64; ++j) { const float mj = __builtin_bit_cast(float, __builtin_amdgcn_readlane(__builtin_bit_cast(int, msk), j)); erk += (mj > msk || (mj == msk && j < lane)) ? 1 : 0; }
            const bool on = erk < 8;
            const float ssum = wave_sum(on ? sc : 0.f, lane);
            sel_on[rr] = on; sel_rank[rr] = erk; sel_gate[rr] = sc / ssum * 2.5f; sel_pos[rr] = 0;
            if (on) sel_pos[rr] = __hip_atomic_fetch_add(&hist[lane], 1, __ATOMIC_RELAXED, __HIP_MEMORY_SCOPE_WORKGROUP); }
        __syncthreads();
        if (tid < 64) { const int hc = hist[tid]; int bs = 0; if (hc > 0) bs = (int)atomicAdd(&cnt[tid * 16], (unsigned)hc); basep[tid] = bs; }
        __syncthreads();
#pragma unroll
        for (int rr = 0; rr < 2; ++rr) if (sel_on[rr]) { const int t = row0 + 2 * w + rr, pos = basep[lane] + sel_pos[rr];
            ltok[(size_t)lane * CAP + pos] = t; lgate[(size_t)lane * CAP + pos] = sel_gate[rr];
            eidx[t * 8 + sel_rank[rr]] = lane; inv[t * 8 + sel_rank[rr]] = pos; }
    }
}
__device__ __forceinline__ int build_tiles(const Frame& F, const unsigned* cnt) {
    LAS int* tpref = (LAS int*)(F.lds + LDS_TAB); LAS int* cl = (LAS int*)(F.lds + LDS_TAB + 512);
    __syncthreads();
    if (F.tid < 64) {
        const int lane = F.lane; const int c = (int)__hip_atomic_load(&cnt[lane * 16], __ATOMIC_RELAXED, __HIP_MEMORY_SCOPE_AGENT);
        const int tl = (c + 255) >> 8; int inc = tl;
#pragma unroll
        for (int o = 1; o < 64; o <<= 1) { const int v = __builtin_amdgcn_ds_bpermute((lane >= o ? lane - o : lane) << 2, inc); inc += lane >= o ? v : 0; }
        cl[lane] = c; tpref[lane] = inc - tl;
        if (lane == 63) { tpref[64] = inc; tpref[65] = inc + T / 256; tpref[66] = inc + 2 * (T / 256); cl[64] = T; cl[65] = T; } }
    __syncthreads();
    return __builtin_amdgcn_readfirstlane(tpref[64]);
}
__device__ __forceinline__ void phase_moe4(const Frame& F, const float* Y2, const bf16* Yr, const int* eidx, const int* inv, const float* gain, const float* bias, float* XO, bf16* XBo) {
    const LAS int* tpref = (const LAS int*)(F.lds + LDS_TAB);
    const int gw = F.bid * 8 + F.wave, NGW = F.G * 8, lane = F.lane;
    for (int t = gw; t < T; t += NGW) {
        f32x4 v[8];
#pragma unroll
        for (int j = 0; j < 8; ++j) v[j] = *(const f32x4*)(Y2 + (size_t)t * D + 4 * lane + 256 * j);
        for (int k = 0; k < 8; ++k) { const int e = eidx[t * 8 + k], pos = inv[t * 8 + k]; const bf16* yr = Yr + (size_t)(tpref[e] * 256 + pos) * D + 4 * lane;
#pragma unroll
            for (int j = 0; j < 8; ++j) { const v2u w = *(const v2u*)(yr + 256 * j); v[j][0] += bflo(w.x); v[j][1] += bfhi(w.x); v[j][2] += bflo(w.y); v[j][3] += bfhi(w.y); } }
        float sm = 0.f;
#pragma unroll
        for (int j = 0; j < 8; ++j) sm += (v[j][0] + v[j][1]) + (v[j][2] + v[j][3]);
        const float mean = wave_sum(sm, lane) * (1.0f / D); float sq = 0.f;
#pragma unroll
        for (int j = 0; j < 8; ++j) { v[j] = v[j] - mean; sq += (v[j][0] * v[j][0] + v[j][1] * v[j][1]) + (v[j][2] * v[j][2] + v[j][3] * v[j][3]); }
        const float rstd = 1.0f / sqrtf(wave_sum(sq, lane) * (1.0f / D) + LN_EPS);
#pragma unroll
        for (int j = 0; j < 8; ++j) { const int c = 4 * lane + 256 * j; const f32x4 o = v[j] * rstd * *(const f32x4*)(gain + c) + *(const f32x4*)(bias + c);
            *(f32x4*)(XO + (size_t)t * D + c) = o;
            v2u wb; wb.x = pk2(o[0], o[1]); wb.y = pk2(o[2], o[3]); *(v2u*)(XBo + (size_t)t * D + c) = wb; }
    }
}


template <int CTRL> __device__ __forceinline__ float dppf(float x) { return __builtin_bit_cast(float, __builtin_amdgcn_update_dpp(0, __builtin_bit_cast(int, x), CTRL, 0xF, 0xF, false)); }
__device__ __forceinline__ float gmax8(float x) { x = fmaxf(x, dppf<0xB1>(x)); x = fmaxf(x, dppf<0x4E>(x)); x = fmaxf(x, dppf<0x141>(x)); return x; }
__device__ __forceinline__ float gsum8(float x) { x += dppf<0xB1>(x); x += dppf<0x4E>(x); x += dppf<0x141>(x); return x; }
__device__ __forceinline__ float rl_f(float x, int l) { return __builtin_bit_cast(float, __builtin_amdgcn_readlane(__builtin_bit_cast(int, x), l)); }
constexpr int M1_P = 0, M1N_HIST = 131072, M1N_BASE = 131072 + 256, M1N_GB = 131072 + 1024;
__device__ __forceinline__ void phase_moe1n(const Frame& F, const bf16* Y, const float* pst, const float* gain, const float* bias, const bf16* WH, const bf16* WL, const float* RB,
                                            bf16* X1B, float* ST1, unsigned* cnt, int* ltok, float* lgate, int* eidx, int* inv) {
    LAS float* P = (LAS float*)(F.lds + M1_P); LAS int* hist = (LAS int*)(F.lds + M1N_HIST); LAS int* basep = (LAS int*)(F.lds + M1N_BASE);
    const int tid = F.tid, lane = F.lane, w = F.wave, r = lane & 15, q = lane >> 4;
    for (int item = F.bid; item < T / 64; item += F.G) {
        const int row0 = item * 64;
        __syncthreads();
        { int t0 = tid; asm volatile("" : "+v"(t0));
          if (t0 < 64) hist[t0] = 0;
          LAS f32x4* gb = (LAS f32x4*)(F.lds + M1N_GB); gb[t0] = *(const f32x4*)(gain + 4 * t0); gb[512 + t0] = *(const f32x4*)(bias + 4 * t0); }
        __syncthreads();
        float mean[4], rstd[4];
#pragma unroll
        for (int rt = 0; rt < 4; ++rt) { const int row = row0 + 16 * rt + r;
          const f32x4* pp = (const f32x4*)(pst + ((size_t)row * 32 + q * 8) * 2); const f32x4 a = pp[0], b = pp[1], c = pp[2], d = pp[3];
          float sm = (a[0] + a[2]) + (b[0] + b[2]) + (c[0] + c[2]) + (d[0] + d[2]), sq = (a[1] + a[3]) + (b[1] + b[3]) + (c[1] + c[3]) + (d[1] + d[3]);
          sm = sum_fq(sm); sq = sum_fq(sq);
          mean[rt] = sm * (1.0f / D); const float var = fmaxf(sq * (1.0f / D) - mean[rt] * mean[rt], 0.f); rstd[rt] = 1.0f / sqrtf(var + LN_EPS);
          if (w == 0 && q == 0) *(f32x2*)(ST1 + 2 * row) = (f32x2){mean[rt], rstd[rt]}; }
        const int kb = 256 * w + 8 * q;
        const LAS float* gl = (const LAS float*)(F.lds + M1N_GB) + kb;
        f32x4 acc[4][4];
#pragma unroll
        for (int rt = 0; rt < 4; ++rt)
#pragma unroll
            for (int nt = 0; nt < 4; ++nt) acc[rt][nt] = (f32x4){0.f, 0.f, 0.f, 0.f};
        v4u yb[2][2][4], hb[4]; bf16x8 wh[4], wl[4];
        unsigned vo[4];
#pragma unroll
        for (int i = 0; i < 4; ++i) { vo[i] = (unsigned)(r * D + kb) * 2u + (unsigned)i * (16u * D * 2u); asm volatile("" : "+v"(vo[i])); }
        const char* ybase = (const char*)(Y + (size_t)row0 * D); char* xbase = (char*)(X1B + (size_t)row0 * D);
#define M1_LOADY(ms) do { _Pragma("unroll") for (int hf = 0; hf < 2; ++hf) _Pragma("unroll") for (int rt = 0; rt < 4; ++rt) yb[(ms) & 1][hf][rt] = *(const v4u*)(ybase + vo[rt] + 128 * (ms) + 64 * hf); } while (0)
#define M1_LOADW(st) do { _Pragma("unroll") for (int nt = 0; nt < 4; ++nt) { wh[nt] = *(const bf16x8*)((const char*)WH + vo[nt] + 64 * (st)); wl[nt] = *(const bf16x8*)((const char*)WL + vo[nt] + 64 * (st)); } } while (0)
        M1_LOADY(0); M1_LOADW(0); M1_LOADY(1);
        __builtin_amdgcn_sched_barrier(0);
#pragma unroll
        for (int st = 0; st < 8; ++st) {
            const f32x4 g0 = *(const LAS f32x4*)(gl + 32 * st), g1 = *(const LAS f32x4*)(gl + 32 * st + 4), b0 = *(const LAS f32x4*)(gl + 2048 + 32 * st), b1 = *(const LAS f32x4*)(gl + 2048 + 32 * st + 4);
#pragma unroll
            for (int rt = 0; rt < 4; ++rt) { const v4u yv = yb[(st >> 1) & 1][st & 1][rt];
                const f32x4 y0_ = (f32x4){bflo(yv.x), bfhi(yv.x), bflo(yv.y), bfhi(yv.y)}, y1_ = (f32x4){bflo(yv.z), bfhi(yv.z), bflo(yv.w), bfhi(yv.w)};
                const f32x4 x0 = (y0_ - mean[rt]) * rstd[rt] * g0 + b0, x1 = (y1_ - mean[rt]) * rstd[rt] * g1 + b1;
                v4u h; h.x = cvt_pk_bf16(x0[0], x0[1]); h.y = cvt_pk_bf16(x0[2], x0[3]); h.z = cvt_pk_bf16(x1[0], x1[1]); h.w = cvt_pk_bf16(x1[2], x1[3]);
                if ((st & 1) == 0) hb[rt] = h; else { *(v4u*)(xbase + vo[rt] + 64 * (st - 1)) = hb[rt]; *(v4u*)(xbase + vo[rt] + 64 * st) = h; }
                v4u l; l.x = cvt_pk_bf16(x0[0] - bflo(h.x), x0[1] - bfhi(h.x)); l.y = cvt_pk_bf16(x0[2] - bflo(h.y), x0[3] - bfhi(h.y));
                l.z = cvt_pk_bf16(x1[0] - bflo(h.z), x1[1] - bfhi(h.z)); l.w = cvt_pk_bf16(x1[2] - bflo(h.w), x1[3] - bfhi(h.w));
                const bf16x8 xh = __builtin_bit_cast(bf16x8, h), xl = __builtin_bit_cast(bf16x8, l);
#pragma unroll
                for (int nt = 0; nt < 4; ++nt) { acc[rt][nt] = __builtin_amdgcn_mfma_f32_16x16x32_bf16(xh, wh[nt], acc[rt][nt], 0, 0, 0);
                    acc[rt][nt] = __builtin_amdgcn_mfma_f32_16x16x32_bf16(xl, wh[nt], acc[rt][nt], 0, 0, 0); acc[rt][nt] = __builtin_amdgcn_mfma_f32_16x16x32_bf16(xh, wl[nt], acc[rt][nt], 0, 0, 0); } }
            __builtin_amdgcn_sched_barrier(0);
            if (st + 1 < 8) M1_LOADW(st + 1);
            if ((st & 1) == 1 && (st >> 1) + 2 < 4) M1_LOADY((st >> 1) + 2);
            __builtin_amdgcn_sched_barrier(0);
        }
#undef M1_LOADY
#undef M1_LOADW
#pragma unroll
        for (int rt = 0; rt < 4; ++rt)
#pragma unroll
            for (int nt = 0; nt < 4; ++nt)
#pragma unroll
                for (int i = 0; i < 4; ++i) P[(w * 64 + 16 * rt + 4 * q + i) * 64 + 16 * nt + r] = acc[rt][nt][i];
        __syncthreads();
        const float rb = RB[lane];
        LAS int* Pi = (LAS int*)P;
#pragma unroll 1
        for (int rr = 0; rr < 8; ++rr) { const int rl = 8 * w + rr;
            float lg = ((P[rl * 64 + lane] + P[(64 + rl) * 64 + lane]) + (P[(128 + rl) * 64 + lane] + P[(192 + rl) * 64 + lane])) + ((P[(256 + rl) * 64 + lane] + P[(320 + rl) * 64 + lane]) + (P[(384 + rl) * 64 + lane] + P[(448 + rl) * 64 + lane]));
            lg = (lg == lg) ? lg : -1.0e30f;
            const float sc = 1.0f / (1.0f + __expf(-lg)); const float ch = sc + rb;
            const float m1 = gmax8(ch), neq = gsum8(ch == m1 ? 1.f : 0.f), m2c = gmax8(ch < m1 ? ch : -INFINITY);
            const float gs = m1 + (neq >= 2.f ? m1 : m2c);
            int grk = 0; const int g = lane >> 3;
#pragma unroll
            for (int hh = 0; hh < 8; ++hh) { const float gh = rl_f(gs, 8 * hh); grk += (gh > gs || (gh == gs && hh < g)) ? 1 : 0; }
            const float msk = grk < 4 ? ch : -INFINITY;
            float cur = msk, ssum = 0.f; int erk = 64;
#pragma unroll 1
            for (int k = 0; k < 8; ++k) {
                float rm = gmax8(cur); rm = fmaxf(rm, dppf<0x140>(rm));
                const float wm = fmaxf(fmaxf(rl_f(rm, 0), rl_f(rm, 16)), fmaxf(rl_f(rm, 32), rl_f(rm, 48)));
                const unsigned long long bal = __builtin_amdgcn_ballot_w64(cur == wm);
                const int lsel = __builtin_amdgcn_readfirstlane((int)__builtin_ctzll(bal));
                ssum += rl_f(sc, lsel);
                const bool me = lane == lsel; erk = me ? k : erk; cur = me ? -INFINITY : cur; }
            const bool on = erk < 8;
            int pk_ = -1; if (on) pk_ = __hip_atomic_fetch_add(&hist[lane], 1, __ATOMIC_RELAXED, __HIP_MEMORY_SCOPE_WORKGROUP) | (erk << 16);
            P[rl * 64 + lane] = sc / ssum * 2.5f; Pi[(64 + rl) * 64 + lane] = pk_; }
        __syncthreads();
        if (tid < 64) { int tt = tid; asm volatile("" : "+v"(tt));
            const int hc = hist[tt]; int bs = 0; if (hc > 0) bs = (int)atomicAdd(&cnt[tt * 16], (unsigned)hc); basep[tt] = bs; }
        __syncthreads();
        { const int bl = basep[lane];
#pragma unroll 1
          for (int rr = 0; rr < 8; ++rr) { const int rl = 8 * w + rr; const int pk_ = Pi[(64 + rl) * 64 + lane]; const float gt_ = P[rl * 64 + lane];
            if (pk_ >= 0) { const int t = row0 + rl, pos = bl + (pk_ & 0xffff), rk_ = pk_ >> 16;
                ltok[(size_t)lane * CAP + pos] = t * 8 + rk_; lgate[(size_t)lane * CAP + pos] = gt_;
                eidx[t * 8 + rk_] = lane; inv[t * 8 + rk_] = pos; } } }
    }
}

constexpr int M3_PL = 131072, M3_CNT = 147456, M3_OFF = 147456 + 272;
__device__ __forceinline__ void phase_moe3n(const Frame& F, const bf16* H, const bf16* HSp, const int* eidx, const bf16* WD, const bf16* WSD,
                                            const float* Y1, const float* ST1, const float* g1, const float* b1, float* Y2, float* PST2) {
    LAS int* out = (LAS int*)F.lds; LAS unsigned short* plist = (LAS unsigned short*)(F.lds + M3_PL); LAS int* cnt = (LAS int*)(F.lds + M3_CNT); LAS int* off = (LAS int*)(F.lds + M3_OFF);
    const int tid = F.tid, lane = F.lane, w = F.wave, r = lane & 15, q = lane >> 4;
    for (int u = F.bid; u < 1024; u += F.G) {
        int nc = (u & 7) | ((u >> 7) << 3), tb = (u >> 3) & 15;
        if (F.G == 256) { const int i = u >> 8, x = u & 7, j = (u >> 3) & 31; tb = 2 * x + (i >> 1); nc = 32 * (i & 1) + j; }
        __syncthreads();
#pragma unroll
        for (int j = 0; j < 16; ++j) ((LAS v4u*)out)[tid + 512 * j] = (v4u){0u, 0u, 0u, 0u};
        if (tid < 66) cnt[tid] = 0;
        __syncthreads();
        int ee[16], pp[16];
        { const v4u* ep = (const v4u*)(eidx + ((size_t)tb * 1024 + 2 * tid) * 8); const v4u e0 = ep[0], e1 = ep[1], e2 = ep[2], e3 = ep[3];
          ee[0] = e0.x; ee[1] = e0.y; ee[2] = e0.z; ee[3] = e0.w; ee[4] = e1.x; ee[5] = e1.y; ee[6] = e1.z; ee[7] = e1.w;
          ee[8] = e2.x; ee[9] = e2.y; ee[10] = e2.z; ee[11] = e2.w; ee[12] = e3.x; ee[13] = e3.y; ee[14] = e3.z; ee[15] = e3.w; }
#pragma unroll
        for (int j = 0; j < 16; ++j) pp[j] = __hip_atomic_fetch_add(&cnt[ee[j]], 1, __ATOMIC_RELAXED, __HIP_MEMORY_SCOPE_WORKGROUP);
        __syncthreads();
        if (w == 0) { int c = cnt[lane], x = c;
#pragma unroll
            for (int o = 1; o < 64; o <<= 1) { const int y = __builtin_amdgcn_ds_bpermute(((lane - o) & 63) << 2, x); if (lane >= o) x += y; }
            off[lane] = x - c; if (lane == 63) off[64] = x; }
        __syncthreads();
#pragma unroll
        for (int j = 0; j < 16; ++j) plist[off[ee[j]] + pp[j]] = (unsigned short)(tid * 16 + j);
        __syncthreads();
        const char* Hb = (const char*)H + (size_t)tb * 8192 * 256 + q * 16;
        const char* HSb = (const char*)HSp + (size_t)tb * 1024 * 512 + q * 16;
        const char* Bb = (const char*)WD + ((size_t)nc * 32 + r) * 256 + q * 16;
        const char* BSb = (const char*)WSD + ((size_t)nc * 32 + r) * 512 + q * 16;
#define M3_NR(sg) ((sg) < 8 ? __builtin_amdgcn_readfirstlane(cnt[w + 8 * (sg)]) : 128)
#define M3_RB(sg) ((sg) < 8 ? __builtin_amdgcn_readfirstlane(off[w + 8 * (sg)]) : 0)
#define M3_GLD(dst, ptr, OFF) asm volatile("global_load_dwordx4 %0, %1, off offset:" #OFF : "=&v"(dst) : "v"(ptr) : "memory")
#define M3_LOADB(dst, sg) do { const char* _b0 = (sg) < 8 ? Bb + (size_t)(w + 8 * (sg)) * 524288 : BSb + ((sg) - 8) * 256; const char* _b1 = _b0 + ((sg) < 8 ? 4096 : 8192); \
            M3_GLD(dst[0][0], _b0, 0); M3_GLD(dst[0][1], _b0, 64); M3_GLD(dst[0][2], _b0, 128); M3_GLD(dst[0][3], _b0, 192); \
            M3_GLD(dst[1][0], _b1, 0); M3_GLD(dst[1][1], _b1, 64); M3_GLD(dst[1][2], _b1, 128); M3_GLD(dst[1][3], _b1, 192); } while (0)
#define M3_LOADA(dst, sg, bb, nr, rbs) do { int _i = 16 * (bb) + r; _i = _i < (nr) ? _i : (nr) - 1; const unsigned _rid = plist[(rbs) + _i]; \
            const char* _a = (sg) < 8 ? Hb + (size_t)_rid * 256 : ((sg) < 10 ? HSb + (size_t)(128 * w + _i) * 512 + ((sg) - 8) * 256 : Hb); \
            M3_GLD(dst[0], _a, 0); M3_GLD(dst[1], _a, 64); M3_GLD(dst[2], _a, 128); M3_GLD(dst[3], _a, 192); } while (0)
#define M3_ADV(sg, bb, nr, rbs) do { if ((sg) < 10) { ++(bb); if ((bb) * 16 >= (nr)) { (bb) = 0; do { ++(sg); } while ((sg) < 8 && M3_NR(sg) == 0); if ((sg) < 10) { (nr) = M3_NR(sg); (rbs) = M3_RB(sg); } } } } while (0)
#define M3_WAITA(AS) asm volatile("s_waitcnt vmcnt(12)" : "+v"(AS[0]), "+v"(AS[1]), "+v"(AS[2]), "+v"(AS[3]) :: "memory")
#define M3_WAITB(N) asm volatile("s_waitcnt vmcnt(" #N ")" : "+v"(Bn[0][0]), "+v"(Bn[0][1]), "+v"(Bn[0][2]), "+v"(Bn[0][3]), "+v"(Bn[1][0]), "+v"(Bn[1][1]), "+v"(Bn[1][2]), "+v"(Bn[1][3]) :: "memory")
#define M3_STEP(AS) if (cseg < 10) { \
              \
            int tk[4]; bool ok[4]; unsigned pl[4]; const int rt_ = cseg < 8; \
            _Pragma("unroll") for (int i = 0; i < 4; ++i) { const int idx = 16 * cbt + 4 * q + i; ok[i] = idx < cnr; const int ic = ok[i] ? idx : cnr - 1; pl[i] = plist[crbs + ic]; tk[i] = 128 * w + ic; } \
            _Pragma("unroll") for (int i = 0; i < 4; ++i) tk[i] = rt_ ? (int)(pl[i] >> 3) : tk[i]; \
            M3_WAITA(AS); \
            f32x4 acc[2]; \
            _Pragma("unroll") for (int nt = 0; nt < 2; ++nt) { acc[nt] = (f32x4){0.f, 0.f, 0.f, 0.f}; \
                _Pragma("unroll") for (int kk = 0; kk < 4; ++kk) acc[nt] = __builtin_amdgcn_mfma_f32_16x16x32_bf16(__builtin_bit_cast(bf16x8, AS[kk]), __builtin_bit_cast(bf16x8, Bc[nt][kk]), acc[nt], 0, 0, 0); } \
              \
            _Pragma("unroll") for (int i = 0; i < 4; ++i) { const long long lo_ = ok[i] ? (long long)__float2int_rn(acc[0][i] * 4194304.0f) : 0ll, hi_ = ok[i] ? (long long)__float2int_rn(acc[1][i] * 4194304.0f) : 0ll; \
                (void)__hip_atomic_fetch_add((LAS unsigned long long*)out + tk[i] * 16 + r, (unsigned long long)((hi_ << 32) + lo_), __ATOMIC_RELAXED, __HIP_MEMORY_SCOPE_WORKGROUP); } \
            M3_LOADA(AS, pseg, pbt, pnr, prbs); M3_ADV(pseg, pbt, pnr, prbs); \
            { const int old_ = cseg, nbat_ = (cnr + 15) >> 4; M3_ADV(cseg, cbt, cnr, crbs); \
              if (cseg != old_ && cseg < 10) { \
                  if (nbat_ == 1) M3_WAITB(4); else if (nbat_ == 2) M3_WAITB(8); else if (nbat_ == 3) M3_WAITB(12); else M3_WAITB(16); \
                  _Pragma("unroll") for (int nt = 0; nt < 2; ++nt) _Pragma("unroll") for (int kk = 0; kk < 4; ++kk) Bc[nt][kk] = Bn[nt][kk]; \
                  int nb_ = cseg; do { ++nb_; } while (nb_ < 8 && M3_NR(nb_) == 0); if (nb_ >= 10) nb_ = 9; M3_LOADB(Bn, nb_); } } }
        int cseg = -1, cbt = 0, cnr = 0, crbs = 0;
        do { ++cseg; } while (cseg < 8 && M3_NR(cseg) == 0);
        cnr = M3_NR(cseg); crbs = M3_RB(cseg);
        int pseg = cseg, pbt = 0, pnr = cnr, prbs = crbs;
        v4u Bc[2][4], Bn[2][4], A0[4], A1[4], A2[4], A3[4];
        M3_LOADB(Bc, cseg);
        M3_LOADA(A0, pseg, pbt, pnr, prbs); M3_ADV(pseg, pbt, pnr, prbs);
        M3_LOADA(A1, pseg, pbt, pnr, prbs); M3_ADV(pseg, pbt, pnr, prbs);
        M3_LOADA(A2, pseg, pbt, pnr, prbs); M3_ADV(pseg, pbt, pnr, prbs);
        M3_LOADA(A3, pseg, pbt, pnr, prbs); M3_ADV(pseg, pbt, pnr, prbs);
        { int nb_ = cseg; do { ++nb_; } while (nb_ < 8 && M3_NR(nb_) == 0); if (nb_ >= 10) nb_ = 9; M3_LOADB(Bn, nb_); }
        asm volatile("s_waitcnt vmcnt(0)" : "+v"(Bc[0][0]), "+v"(Bc[0][1]), "+v"(Bc[0][2]), "+v"(Bc[0][3]), "+v"(Bc[1][0]), "+v"(Bc[1][1]), "+v"(Bc[1][2]), "+v"(Bc[1][3]) :: "memory");
#pragma unroll 1
        while (cseg < 10) { M3_STEP(A0) M3_STEP(A1) M3_STEP(A2) M3_STEP(A3) }
        asm volatile("s_waitcnt vmcnt(0)" : "+v"(A0[0]), "+v"(A0[1]), "+v"(A0[2]), "+v"(A0[3]), "+v"(A1[0]), "+v"(A1[1]), "+v"(A1[2]), "+v"(A1[3]), "+v"(A2[0]), "+v"(A2[1]), "+v"(A2[2]), "+v"(A2[3]),
                     "+v"(A3[0]), "+v"(A3[1]), "+v"(A3[2]), "+v"(A3[3]), "+v"(Bn[0][0]), "+v"(Bn[0][1]), "+v"(Bn[0][2]), "+v"(Bn[0][3]), "+v"(Bn[1][0]), "+v"(Bn[1][1]), "+v"(Bn[1][2]), "+v"(Bn[1][3]) :: "memory");
#undef M3_NR
#undef M3_RB
#undef M3_GLD
#undef M3_LOADB
#undef M3_LOADA
#undef M3_ADV
#undef M3_WAITA
#undef M3_WAITB
#undef M3_STEP
        __syncthreads();
        { const int c4 = lane & 7, rs = lane >> 3, col = nc * 32 + 4 * c4;
          const f32x4 gv = *(const f32x4*)(g1 + col), bv = *(const f32x4*)(b1 + col);
#pragma unroll 4
          for (int it = 0; it < 16; ++it) { const int rl = 128 * w + 8 * it + rs; const size_t row = (size_t)tb * 1024 + rl;
              const f32x4 yv = *(const f32x4*)(Y1 + row * D + col); const f32x2 sv = *(const f32x2*)(ST1 + 2 * row);
              f32x4 tv; { const int nt = c4 >> 2, r0 = (4 * c4) & 15;
#pragma unroll
                  for (int j = 0; j < 4; ++j) { const v2u cell = *(const LAS v2u*)(out + rl * 32 + 2 * (r0 + j)); const int lo = (int)cell.x, hi = (int)cell.y + (lo < 0 ? 1 : 0); tv[j] = (float)(nt ? hi : lo) * (1.0f / 4194304.0f); } }
              const f32x4 y = ((yv - sv.x) * sv.y * gv + bv) * ALPHA + tv;
              *(f32x4*)(Y2 + row * D + col) = y;
              float sm = (y[0] + y[1]) + (y[2] + y[3]), sq = (y[0] * y[0] + y[1] * y[1]) + (y[2] * y[2] + y[3] * y[3]);
#pragma unroll
              for (int o = 1; o < 8; o <<= 1) { sm += shfl_x(sm, o, lane); sq += shfl_x(sq, o, lane); }
              if (c4 == 0) *(f32x2*)(PST2 + (row * 64 + nc) * 2) = (f32x2){sm, sq}; } }
    }
}

__device__ __forceinline__ void phase_moe4n(const Frame& F, const float* Y2, const float* pst, const float* gain, const float* bias, float* ST2, bf16* XBo, float* OUT, int last) {
    const int gw = F.bid * 8 + F.wave, NGW = F.G * 8, lane = F.lane;
    for (int t = gw; t < T; t += NGW) {
        f32x4 v[8];
#pragma unroll
        for (int j = 0; j < 8; ++j) v[j] = *(const f32x4*)(Y2 + (size_t)t * D + 4 * lane + 256 * j);
        const f32x2 pv = *(const f32x2*)(pst + ((size_t)t * 64 + lane) * 2);
        const float mean = wave_sum(pv.x, lane) * (1.0f / D); const float var = fmaxf(wave_sum(pv.y, lane) * (1.0f / D) - mean * mean, 0.f); const float rstd = 1.0f / sqrtf(var + LN_EPS);
        if (lane == 0) *(f32x2*)(ST2 + 2 * (size_t)t) = (f32x2){mean, rstd};
#pragma unroll
        for (int j = 0; j < 8; ++j) { const int c = 4 * lane + 256 * j; const f32x4 o = (v[j] - mean) * rstd * *(const f32x4*)(gain + c) + *(const f32x4*)(bias + c);
            if (last) *(f32x4*)(OUT + (size_t)t * D + c) = o;
            else { v2u wb; wb.x = pk2(o[0], o[1]); wb.y = pk2(o[2], o[3]); *(v2u*)(XBo + (size_t)t * D + c) = wb; } }
    }
}


__device__ __forceinline__ void phase_moe4q(const Frame& F, const bf16* X1, bf16* Y2, const unsigned char* Yq, const float* Ysc, const int* eidx, const int* inv, const float* gain, const float* bias, float* ST2, bf16* XBo, float* OUT, int last) {
    const LAS int* tpref = (const LAS int*)(F.lds + LDS_TAB);
    const int gw = F.bid * 8 + F.wave, NGW = F.G * 8, lane = F.lane;
    { LAS f32x4* gb = (LAS f32x4*)(F.lds + 0); int t0 = F.tid; asm volatile("" : "+v"(t0)); gb[t0] = *(const f32x4*)(gain + 4 * t0); gb[512 + t0] = *(const f32x4*)(bias + 4 * t0); }
    __syncthreads();
    const LAS float* gl = (const LAS float*)(F.lds + 0);
    int en = 0, pn = 0; if (lane < 8 && gw < T) { en = eidx[gw * 8 + lane]; pn = inv[gw * 8 + lane]; }
    for (int t = gw; t < T; t += NGW) {
        int rowi = 0; if (lane < 8) rowi = tpref[en] * 256 + pn; else if (lane < 10) rowi = tpref[56 + lane] * 256 + t;
        if (lane < 8 && t + NGW < T) { en = eidx[(t + NGW) * 8 + lane]; pn = inv[(t + NGW) * 8 + lane]; }
        v4u pv[2][2], yv[10][2]; float sc[10][2];
#pragma unroll
        for (int j = 0; j < 2; ++j) { pv[j][0] = __builtin_nontemporal_load((const v4u*)(X1 + (size_t)t * D + 16 * lane + 1024 * j)); pv[j][1] = __builtin_nontemporal_load((const v4u*)(X1 + (size_t)t * D + 16 * lane + 1024 * j + 8)); }
#pragma unroll
        for (int k = 0; k < 10; ++k) { const size_t row = (size_t)__builtin_amdgcn_readlane(rowi, k);
#pragma unroll
            for (int j = 0; j < 2; ++j) { yv[k][j] = __builtin_nontemporal_load((const v4u*)(Yq + row * D + 16 * lane + 1024 * j)); sc[k][j] = __builtin_nontemporal_load(Ysc + row * 16 + 8 * j + (lane >> 3)); } }
#pragma unroll
        for (int k = 0; k < 10; ++k) asm volatile("" : "+v"(yv[k][0]), "+v"(yv[k][1]), "+v"(sc[k][0]), "+v"(sc[k][1]));
        float v[2][16];
#pragma unroll
        for (int j = 0; j < 2; ++j) { float f0[8], f1[8]; unpack8(pv[j][0], f0); unpack8(pv[j][1], f1);
            const float ss = (((sc[0][j] + sc[1][j]) + (sc[2][j] + sc[3][j])) + ((sc[4][j] + sc[5][j]) + (sc[6][j] + sc[7][j]))) + (sc[8][j] + sc[9][j]);
#pragma unroll
            for (int i = 0; i < 8; ++i) { v[j][i] = ALPHA * f0[i] - 128.f * ss; v[j][8 + i] = ALPHA * f1[i] - 128.f * ss; } }
#pragma unroll
        for (int k = 0; k < 10; ++k)
#pragma unroll
            for (int j = 0; j < 2; ++j) { const float s_ = sc[k][j]; const unsigned q[4] = {yv[k][j].x, yv[k][j].y, yv[k][j].z, yv[k][j].w};
#pragma unroll
                for (int d = 0; d < 4; ++d) { v[j][4 * d + 0] += s_ * (float)(q[d] & 0xffu); v[j][4 * d + 1] += s_ * (float)((q[d] >> 8) & 0xffu); v[j][4 * d + 2] += s_ * (float)((q[d] >> 16) & 0xffu); v[j][4 * d + 3] += s_ * (float)(q[d] >> 24); } }
        float sm = 0.f;
#pragma unroll
        for (int j = 0; j < 2; ++j)
#pragma unroll
            for (int i = 0; i < 16; i += 4) sm += (v[j][i] + v[j][i + 1]) + (v[j][i + 2] + v[j][i + 3]);
        const float mean = wave_sum(sm, lane) * (1.0f / D); float sq = 0.f;
#pragma unroll
        for (int j = 0; j < 2; ++j)
#pragma unroll
            for (int i = 0; i < 16; ++i) { const float d = v[j][i] - mean; sq += d * d; }
        const float rstd = 1.0f / sqrtf(wave_sum(sq, lane) * (1.0f / D) + LN_EPS);
        (void)ST2; (void)Y2;
#pragma unroll
        for (int j = 0; j < 2; ++j)
#pragma unroll
            for (int h = 0; h < 2; ++h) { const int c = 16 * lane + 1024 * j + 8 * h; const float* vv = &v[j][8 * h];
                const f32x4 g0 = *(const LAS f32x4*)(gl + c), g1 = *(const LAS f32x4*)(gl + c + 4), b0 = *(const LAS f32x4*)(gl + 2048 + c), b1 = *(const LAS f32x4*)(gl + 2048 + c + 4);
                const f32x4 o0 = ((f32x4){vv[0], vv[1], vv[2], vv[3]} - mean) * rstd * g0 + b0, o1 = ((f32x4){vv[4], vv[5], vv[6], vv[7]} - mean) * rstd * g1 + b1;
                if (last) { *(f32x4*)(OUT + (size_t)t * D + c) = o0; *(f32x4*)(OUT + (size_t)t * D + c + 4) = o1; }
                else { v4u wb; wb.x = pk2(o0[0], o0[1]); wb.y = pk2(o0[2], o0[3]); wb.z = pk2(o1[0], o1[1]); wb.w = pk2(o1[2], o1[3]); *(v4u*)(XBo + (size_t)t * D + c) = wb; } }
    }
}

__device__ __forceinline__ void phase_downproj3(const Frame& F, const bf16* H, const bf16* WD, const bf16* HSp, const bf16* WSD, unsigned char* Yq, float* Ysc, int NT) {
    const LAS int* tpref = (const LAS int*)(F.lds + LDS_TAB); const LAS int* cl = (const LAS int*)(F.lds + LDS_TAB + 512);
    LAS unsigned char* lds = F.lds;
    const int tid = F.tid, lane = F.lane, w = F.wave, fr = lane & 15, fq = lane >> 4;
    unsigned rbB[2], cbB[2];
#pragma unroll
    for (int i = 0; i < 2; ++i) { int R_, C_; g8::stage_rc(tid * 16 + i * 8192, R_, C_); rbB[i] = (unsigned)((R_ & ~31) + g8::perm32(R_ & 31)); cbB[i] = (unsigned)C_ * 2u; }
    const unsigned ldsw = (unsigned)w * 1024u, lbase = (unsigned)(size_t)lds;
    int boffg[4];
#pragma unroll
    for (int g = 0; g < 4; ++g) boffg[g] = g8::lds_byte(32 * g + fr, fq * 8);
    LAS unsigned char* stg = lds + 65536 + w * (32 * 144);
    const int NU = NT * 4;
    const int upos = (F.G % 8) == 0 ? (F.bid & 7) * (F.G >> 3) + (F.bid >> 3) : F.bid;
    int ub = 0;
    int u = (F.G <= NU) ? upos : F.bid; if (u >= NU) return;
#define DP3_UNITINFO(uu, E0, EXP, NV) do { const int tl_ = (uu) >> 2; int e_ = (E0); while (__builtin_amdgcn_readfirstlane(tpref[e_ + 1]) <= tl_) ++e_; EXP = e_; \
        NV = __builtin_amdgcn_readfirstlane(cl[e_]) - (tl_ - __builtin_amdgcn_readfirstlane(tpref[e_])) * 256; } while (0)
#define DP3_GLDS(gsrc, ldsdst) do { unsigned keep_; asm volatile("s_mov_b32 %0, m0\n\ts_mov_b32 m0, %2\n\ts_nop 0\n\tglobal_load_lds_dwordx4 %1, off\n\ts_mov_b32 m0, %0" : "=&s"(keep_) : "v"(gsrc), "s"(ldsdst) : "memory"); } while (0)
#define DP3_STAGE(slot, gb, bs) do { const unsigned v0_ = rbB[0] * (unsigned)(bs) + cbB[0], v1_ = rbB[1] * (unsigned)(bs) + cbB[1]; _Pragma("unroll") for (int kt = 0; kt < 2; ++kt) { \
        DP3_GLDS((const void*)((gb) + kt * 128 + v0_), lbase + (unsigned)((slot) * 32768 + kt * 16384) + ldsw); \
        DP3_GLDS((const void*)((gb) + kt * 128 + v1_), lbase + (unsigned)((slot) * 32768 + kt * 16384) + ldsw + 8192u); } } while (0)
#define DP3_SRC(uu, ee, AB, AS, BB, BS) do { const int tl_ = (uu) >> 2, cu_ = ((uu) & 3) * 512; \
        if ((ee) < 64) { AB = (const char*)(H + (size_t)tl_ * 256 * EDIM); AS = EDIM * 2; BB = (const char*)(WD + (size_t)(ee) * D * EDIM + (size_t)cu_ * EDIM); BS = EDIM * 2; } \
        else { const int t0_ = (tl_ - __builtin_amdgcn_readfirstlane(tpref[ee])) * 256; AB = (const char*)(HSp + (size_t)t0_ * SDIM + ((ee) - 64) * EDIM); AS = SDIM * 2; \
               BB = (const char*)(WSD + (size_t)cu_ * SDIM + ((ee) - 64) * EDIM); BS = SDIM * 2; } } while (0)
    int ecur, nvcur; DP3_UNITINFO(u, 0, ecur, nvcur);
    const char* abc; const char* gbc; int asc, bsc; DP3_SRC(u, ecur, abc, asc, gbc, bsc);
    bf16x8 A[2][4], An[2][4];
    { const char* ap_ = abc + (size_t)(32 * w + fr) * asc + 16 * fq;
#pragma unroll
      for (int m = 0; m < 2; ++m)
#pragma unroll
          for (int kk = 0; kk < 4; ++kk) A[m][kk] = *(const bf16x8*)(ap_ + (size_t)m * 16 * asc + 64 * kk); }
    DP3_STAGE(0, gbc, bsc);
    asm volatile("s_waitcnt vmcnt(0)" ::: "memory");
#pragma unroll 1
    for (;;) {
        int un = u; { const int nb = ub + F.G; if (nb + F.G <= NU) un = nb + upos; else if (nb + F.bid < NU) un = nb + F.bid; if (un != u) ub = nb; }
        int enx, nvnx; DP3_UNITINFO(un, (un > u ? ecur : 0), enx, nvnx);
        const char* abn; const char* gbn; int asn, bsn; DP3_SRC(un, enx, abn, asn, gbn, bsn);
        const int tile = u >> 2, colu = (u & 3) * 512;
        float scq[2][4];
#pragma unroll
        for (int c = 0; c < 4; ++c) {
            if (c == 0) asm volatile("s_waitcnt vmcnt(5)" ::: "memory"); else asm volatile("s_waitcnt vmcnt(4)" ::: "memory");
            __builtin_amdgcn_s_barrier();
            if (c == 3) { const char* ap_ = abn + (size_t)(32 * w + fr) * asn + 16 * fq;
#pragma unroll
                for (int m = 0; m < 2; ++m) { const char* am_ = ap_ + (size_t)m * 16 * asn;
                    asm volatile("global_load_dwordx4 %0, %1, off" : "=&v"(An[m][0]) : "v"(am_) : "memory"); asm volatile("global_load_dwordx4 %0, %1, off offset:64" : "=&v"(An[m][1]) : "v"(am_) : "memory");
                    asm volatile("global_load_dwordx4 %0, %1, off offset:128" : "=&v"(An[m][2]) : "v"(am_) : "memory"); asm volatile("global_load_dwordx4 %0, %1, off offset:192" : "=&v"(An[m][3]) : "v"(am_) : "memory"); } }
            { const char* gnext = (c < 3) ? gbc + (size_t)(c + 1) * 128 * bsc : gbn; const int bnext = (c < 3) ? bsc : bsn; DP3_STAGE((c + 1) & 1, gnext, bnext); }
            __builtin_amdgcn_sched_barrier(0);
            f32x4 acc[2][4][2];
            __builtin_amdgcn_s_setprio(1);
#pragma unroll
            for (int g = 0; g < 4; ++g) { bf16x8 Bf[2][4];
#pragma unroll
                for (int n = 0; n < 2; ++n)
#pragma unroll
                    for (int kk = 0; kk < 4; ++kk) Bf[n][kk] = *(const LAS bf16x8*)(lds + (c & 1) * 32768 + (kk >> 1) * 16384 + boffg[g] + n * 2048 + (kk & 1) * 1024);
#pragma unroll
                for (int m = 0; m < 2; ++m)
#pragma unroll
                    for (int n = 0; n < 2; ++n) { acc[m][g][n] = (f32x4){0.f, 0.f, 0.f, 0.f};
#pragma unroll
                        for (int kk = 0; kk < 4; ++kk) acc[m][g][n] = __builtin_amdgcn_mfma_f32_16x16x32_bf16(Bf[n][kk], A[m][kk], acc[m][g][n], 0, 0, 0); } }
            __builtin_amdgcn_s_setprio(0);
#pragma unroll
            for (int m = 0; m < 2; ++m) {
                float am0 = 0.f, am1 = 0.f;
#pragma unroll
                for (int g = 0; g < 4; ++g)
#pragma unroll
                    for (int n = 0; n < 2; ++n) { am0 = fmaxf(fmaxf(am0, fabsf(acc[m][g][n][0])), fabsf(acc[m][g][n][1])); am1 = fmaxf(fmaxf(am1, fabsf(acc[m][g][n][2])), fabsf(acc[m][g][n][3])); }
                float am = fmaxf(am0, am1);
                am = max_fq(am);
                am = fminf(am, 3.0e38f);
                const float isc = am > 0.f ? 127.0f * __builtin_amdgcn_rcpf(am) : 0.f;
                scq[m][c] = am * (1.0f / 127.0f);
                const f32x2_t isc2 = (f32x2_t){isc, isc}, mg2 = (f32x2_t){8388736.0f, 8388736.0f};
#pragma unroll
                for (int g = 0; g < 4; ++g) { unsigned qd[2];
#pragma unroll
                    for (int n = 0; n < 2; ++n) {
                        const f32x2_t tl = __builtin_elementwise_fma((f32x2_t){acc[m][g][n][0], acc[m][g][n][1]}, isc2, mg2), th = __builtin_elementwise_fma((f32x2_t){acc[m][g][n][2], acc[m][g][n][3]}, isc2, mg2);
                        const float f0_ = tl.x, f1_ = tl.y, f2_ = th.x, f3_ = th.y;
                        qd[n] = __builtin_amdgcn_perm(__builtin_bit_cast(unsigned, f1_), __builtin_bit_cast(unsigned, f0_), 0x0c0c0400u) | __builtin_amdgcn_perm(__builtin_bit_cast(unsigned, f3_), __builtin_bit_cast(unsigned, f2_), 0x04000c0cu); }
                    *(LAS v2u*)(stg + (16 * m + fr) * 144 + 32 * g + 8 * fq) = (v2u){qd[0], qd[1]}; } }
            v4u ob[4];
#pragma unroll
            for (int it = 0; it < 4; ++it) ob[it] = *(const LAS v4u*)(stg + (8 * it + (lane >> 3)) * 144 + (lane & 7) * 16);
            asm volatile("" : "+v"(ob[0]), "+v"(ob[1]), "+v"(ob[2]), "+v"(ob[3]));
#pragma unroll
            for (int it = 0; it < 4; ++it) { const int rr = 8 * it + (lane >> 3);
                __builtin_nontemporal_store(ob[it], (v4u*)(Yq + (size_t)(tile * 256 + 32 * w + rr) * D + colu + 128 * c + 16 * (lane & 7))); }
            if (c == 3) { const f32x4 so = fq == 0 ? (f32x4){scq[0][0], scq[0][1], scq[0][2], scq[0][3]} : (f32x4){scq[1][0], scq[1][1], scq[1][2], scq[1][3]};
                if (fq < 2) __builtin_nontemporal_store(so, (f32x4*)(Ysc + (size_t)(tile * 256 + 32 * w + 16 * fq + fr) * 16 + (colu >> 7))); }
            __builtin_amdgcn_sched_barrier(0);
        }
        asm volatile("s_waitcnt vmcnt(9)" : "+v"(An[0][0]), "+v"(An[0][1]), "+v"(An[0][2]), "+v"(An[0][3]), "+v"(An[1][0]), "+v"(An[1][1]), "+v"(An[1][2]), "+v"(An[1][3]) :: "memory");
        if (un == u) break;
#pragma unroll
        for (int m = 0; m < 2; ++m)
#pragma unroll
            for (int kk = 0; kk < 4; ++kk) A[m][kk] = An[m][kk];
        u = un; ecur = enx; nvcur = nvnx; abc = abn; asc = asn; gbc = gbn; bsc = bsn;
    }
    asm volatile("s_waitcnt vmcnt(0)" ::: "memory");
#undef DP3_UNITINFO
#undef DP3_STAGE
#undef DP3_GLDS
#undef DP3_SRC
}

enum { PH_PRO = 0, PH_POOL_G1, PH_POOL_P, PH_POOL_G2, PH_POOL_G3, PH_DIL_G1, PH_DIL_ATT, PH_DIL_CMB, PH_DIL_G2, PH_CONV_G1, PH_CONV_E, PH_CONV_G2, PH_MOE1, PH_MOE2, PH_MOE3, PH_MOE4, PH_COUNT };

template <int PH>
__device__ __forceinline__ void run_phase(const Frame& Fin, const Args& args_, const int L) {
    Frame F = Fin; { int w_ = Fin.wave, l_; asm volatile("" : "+s"(w_)); asm volatile("v_mbcnt_lo_u32_b32 %0, -1, 0\n\tv_mbcnt_hi_u32_b32 %0, -1, %0" : "=v"(l_)); F.wave = w_; F.lane = l_; F.tid = w_ * 64 + l_; }
    unsigned char* ws; { GAS unsigned char* wsg = (GAS unsigned char*)Fin.ws; asm volatile("" : "+s"(wsg)); ws = (unsigned char*)wsg; } F.ws = ws; F.ctl = (unsigned*)(ws + WS_CTL);
    KP kp = (KP)__builtin_amdgcn_kernarg_segment_ptr(); asm volatile("" : "+s"(kp)); (void)args_;
    { unsigned l_ = (unsigned)(size_t)Fin.lds; asm volatile("" : "+s"(l_)); F.lds = (LAS unsigned char*)(size_t)l_; }
    LAS unsigned char* ring = F.lds; int c = (int)blockIdx.x; { int g_ = Fin.G; asm volatile("" : "+s"(c), "+s"(g_)); F.G = g_; F.bid = c; }
    const float* xres = ain(kp, IN_X);
    const float* st2 = (const float*)(ws + WS_ST2); float* pstp = (float*)(ws + WS_PST);
    const float* g2p = ain(kp, IN_LNG) + (size_t)((L > 0 ? L - 1 : 0) * 2 + 1) * D; const float* b2p = ain(kp, IN_LNB) + (size_t)((L > 0 ? L - 1 : 0) * 2 + 1) * D;
    const bf16* xb = (const bf16*)(ws + WS_XB);
    bf16* yf = (bf16*)(ws + WS_YF);
    unsigned char* big = ws + WS_BIG;
    const int ia = L / 3;
    if constexpr (PH == PH_PRO) { phase_prologue(F, kp); }
    if constexpr (PH == PH_POOL_G1) { g8::DenseSched S; S.init(xb, (const bf16*)(ws + WS_W_POOL_IN) + (size_t)ia * D * D, T, D, D, D, F.G, c);
        g8::EpiBf16 E{(bf16*)(big + BG_U), D, 0}; g8::gemm_phase<g8::EpiBf16, g8::DenseSched, false>(ring, F.tid, D, D, D, S, E); }
    if constexpr (PH == PH_POOL_P) { phase_pool(F, (const bf16*)(big + BG_U), (bf16*)(big + BG_PL)); }
    if constexpr (PH == PH_POOL_G2) { g8::DenseSched S; S.init((const bf16*)(big + BG_PL), (const bf16*)(ws + WS_W_POOL_G) + (size_t)ia * D * 512, T, D, D, 512, F.G, c); S.agrp_shift = 1; S.agrp_stride = 512 * 2;
        g8::EpiScaleBf16 E{(bf16*)(big + BG_MX), D, ain(kp, IN_PSC) + (size_t)ia * D}; g8::gemm_phase<g8::EpiScaleBf16, g8::DenseSched, false>(ring, F.tid, 512, D, 512, S, E); }
    if constexpr (PH == PH_POOL_G3) { g8::DenseSched S; S.init((const bf16*)(big + BG_MX), (const bf16*)(ws + WS_W_POOL_OUT) + (size_t)ia * D * D, T, D, D, D, F.G, c);
        g8::EpiResidLN E{xres, xb, st2, g2p, b2p, yf, pstp, 2}; g8::gemm_phase<g8::EpiResidLN, g8::DenseSched, false>(ring, F.tid, D, D, D, S, E); }
    if constexpr (PH == PH_DIL_G1) { g8::DenseSched S; S.init(xb, (const bf16*)(ws + WS_W_DIL_QKV), T, QKVC, D, D, F.G, c);
        g8::EpiBf16 E{(bf16*)(big + BG_QKV), QKVC, 1}; g8::gemm_phase<g8::EpiBf16, g8::DenseSched, false>(ring, F.tid, D, D, D, S, E); }
    if constexpr (PH == PH_DIL_ATT) { phase_attn(F, (const bf16*)(big + BG_QKV), ain(kp, IN_RELB), (bf16*)(big + BG_OG), (float*)(big + BG_LSE)); }
    if constexpr (PH == PH_DIL_CMB) { phase_combine(F, (const bf16*)(big + BG_OG), (const float*)(big + BG_LSE), (bf16*)(big + BG_O)); }
    if constexpr (PH == PH_DIL_G2) { g8::DenseSched S; S.init((const bf16*)(big + BG_O), (const bf16*)(ws + WS_W_DIL_OUT), T, D, DILW, DILW, F.G, c);
        g8::EpiResidLN E{xres, xb, st2, g2p, b2p, yf, pstp, 2}; g8::gemm_phase<g8::EpiResidLN, g8::DenseSched, false>(ring, F.tid, DILW, DILW, DILW, S, E); }
    if constexpr (PH == PH_CONV_G1) { g8::DenseSched S; S.init(xb, (const bf16*)(ws + WS_W_CONV_IN), T, 3 * D, D, D, F.G, c);
        g8::EpiConvIn E{(bf16*)(big + BG_UC), (bf16*)(big + BG_BG)}; g8::gemm_phase<g8::EpiConvIn, g8::DenseSched, false>(ring, F.tid, D, D, D, S, E); }
    if constexpr (PH == PH_CONV_E) { phase_conv(F, (const bf16*)(big + BG_UC), (const bf16*)(big + BG_BG), ain(kp, IN_CW), (bf16*)(big + BG_Z)); }
    if constexpr (PH == PH_CONV_G2) { g8::DenseSched S; S.init((const bf16*)(big + BG_Z), (const bf16*)(ws + WS_W_CONV_OUT), T, D, D, D, F.G, c);
        g8::EpiResidLN E{xres, xb, st2, g2p, b2p, yf, pstp, 2}; g8::gemm_phase<g8::EpiResidLN, g8::DenseSched, false>(ring, F.tid, D, D, D, S, E); }
    unsigned* cnt = F.ctl + CW_CNT + L * 64 * 16;
    float* x1f = (float*)(ws + WS_X1F); bf16* x1b = (bf16*)(ws + WS_X1B);
    int* ltok = (int*)(ws + WS_LTOK); float* lgate = (float*)(ws + WS_LGATE); int* eidx = (int*)(ws + WS_EIDX); int* inv = (int*)(ws + WS_INV);
    bf16* HB = (bf16*)(ws + WS_HB); bf16* HS = (bf16*)(ws + WS_HS); bf16* Yr = (bf16*)(ws + WS_BIG);
    if constexpr (PH == PH_MOE1) {
        const float* g1 = ain(kp, IN_LNG) + (size_t)(L * 2 + 0) * D; const float* b1 = ain(kp, IN_LNB) + (size_t)(L * 2 + 0) * D;
        phase_moe1n(F, yf, pstp, g1, b1, (const bf16*)(ws + WS_RWH) + (size_t)L * NEXP * D, (const bf16*)(ws + WS_RWL) + (size_t)L * NEXP * D, ain(kp, IN_RB) + (size_t)L * NEXP,
                    x1b, (float*)(ws + WS_ST1), cnt, ltok, lgate, eidx, inv); }
    if constexpr (PH == PH_MOE2) {
        const int NT = build_tiles(F, cnt);
        { g8::ExpertSched<1, true> S; S.tpref = (const LAS int*)(F.lds + LDS_TAB); S.cnt = (const LAS int*)(F.lds + LDS_TAB + 512); S.A = (const char*)x1b; S.B = (const char*)((const bf16*)(ws + WS_W_EX_GU) + (size_t)L * 64 * 256 * D);
          S.tok = ltok; S.b_exp = (size_t)256 * D * 2; S.b_tile = 0; S.a_tile = 0; S.NU = NT; S.G = F.G; S.c = c;
          g8::EpiExpertGU E{HB}; g8::gemm_phase<g8::EpiExpertGU, g8::ExpertSched<1, true>, true>(ring, F.tid, D, D, D, S, E); }
        { const int rot = (c - (NT % F.G) + F.G) % F.G;
          g8::DenseSched S; S.init(x1b, (const bf16*)(ws + WS_W_SH_GU) + (size_t)L * 512 * D, T, 512, D, D, F.G, rot);
          int t2 = F.tid; asm volatile("" : "+v"(t2));
          g8::EpiSharedGU E{HS}; g8::gemm_phase<g8::EpiSharedGU, g8::DenseSched, false>(ring, t2, D, D, D, S, E); } }
    if constexpr (PH == PH_MOE3) {
        const float* g1 = ain(kp, IN_LNG) + (size_t)(L * 2 + 0) * D; const float* b1 = ain(kp, IN_LNB) + (size_t)(L * 2 + 0) * D;
        const int NT = build_tiles(F, cnt);
        __syncthreads();
        phase_downproj3(F, HB, (const bf16*)(ws + WS_W_EX_D) + (size_t)L * 64 * D * EDIM, HS, (const bf16*)(ws + WS_W_SH_D) + (size_t)L * D * SDIM, (unsigned char*)Yr, (float*)(ws + WS_BIG + BG_YSC), NT + 2 * (T / 256));
        (void)g1; (void)b1; }
    if constexpr (PH == PH_MOE4) { (void)build_tiles(F, cnt);
        const float* g2 = ain(kp, IN_LNG) + (size_t)(L * 2 + 1) * D; const float* b2 = ain(kp, IN_LNB) + (size_t)(L * 2 + 1) * D;
        phase_moe4q(F, x1b, (bf16*)(ws + WS_Y2F), (const unsigned char*)Yr, (const float*)(ws + WS_BIG + BG_YSC), eidx, inv, g2, b2, (float*)(ws + WS_ST2), (bf16*)(ws + WS_XB), aout(kp), L == DEPTH - 1); }
}
__device__ __forceinline__ void make_frame(Frame& F, const Args& args) {
    extern __shared__ __attribute__((aligned(16))) unsigned char lds_raw[];
    F.lds = (LAS unsigned char*)lds_raw; F.ws = args.ws; F.ctl = (unsigned*)(args.ws + WS_CTL);
    F.tid = threadIdx.x; F.lane = F.tid & 63; F.wave = __builtin_amdgcn_readfirstlane(F.tid >> 6); F.G = gridDim.x; F.bid = blockIdx.x;
}
template <int PH> __global__ void __launch_bounds__(512, 2) k_phase(Args args, int L) {
    Frame F; make_frame(F, args);
    run_phase<PH>(F, args, L);
}

#ifndef MK_NOINLINE
#define MK_NOINLINE 0
#endif
#if MK_NOINLINE
template <int PH> __device__ __noinline__ void call_phase_ni(const int L) {
    Args dummy{}; Frame F;
    KP kp = (KP)__builtin_amdgcn_kernarg_segment_ptr();
    extern __shared__ __attribute__((aligned(16))) unsigned char lds_raw[];
    F.lds = (LAS unsigned char*)lds_raw; F.ws = (unsigned char*)((GAS unsigned char* const CAS*)kp)[20]; F.ctl = (unsigned*)(F.ws + WS_CTL);
    F.tid = threadIdx.x; F.lane = F.tid & 63; F.wave = __builtin_amdgcn_readfirstlane(F.tid >> 6); F.G = gridDim.x; F.bid = blockIdx.x;
    run_phase<PH>(F, dummy, L);
}
template <int PH> __device__ __forceinline__ void call_phase(const Frame& F, const Args& args, const int L) { call_phase_ni<PH>(L); }
#else
template <int PH> __device__ __forceinline__ void call_phase(const Frame& F, const Args& args, const int L) { asm volatile("; PHASE_BEGIN %0" :: "n"(PH)); run_phase<PH>(F, args, L); asm volatile("; PHASE_END %0" :: "n"(PH)); }
#endif
__global__ void __launch_bounds__(512, 2) fwd_all(Args args) {
    Frame F; make_frame(F, args);
    volatile LAS unsigned* misc = (volatile LAS unsigned*)(F.lds + LDS_MISC);
    if (F.tid < 4) misc[F.tid] = 0u;
    __syncthreads();
    const int lo = args.ph_lo, hi = args.ph_hi;
    XcdBarrier bar; bar.bar = F.ctl + CW_BAR; bar.x = 0; bar.st = misc;
    if (hi - lo > 1) bar = xcd_barrier_post(F.ctl + CW_BAR, misc);
    int pc = 0;
#ifndef MK_DUP_MASK
#define MK_DUP_MASK 0
#endif
#if MK_DUP_MASK
#define STEP(PH, Lx) do { if (pc >= lo && pc < hi) { int nrep_ = ((MK_DUP_MASK >> (PH)) & 1) ? 2 : 1; asm volatile("" : "+s"(nrep_)); _Pragma("unroll 1") for (int r_ = 0; r_ < nrep_; ++r_) { call_phase<PH>(F, args, Lx); if (r_ + 1 < nrep_ || pc + 1 < hi) xcd_barrier(bar); } } ++pc; } while (0)
#else
#define STEP(PH, Lx) do { if (pc >= lo && pc < hi) { call_phase<PH>(F, args, Lx); if (pc + 1 < hi) xcd_barrier(bar); } ++pc; } while (0)
#endif
    STEP(PH_PRO, 0);
#pragma unroll 1
    for (int L = 0; L < DEPTH; ++L) {
        const int kind = L % 3;
        if (kind == 0) { STEP(PH_POOL_G1, L); STEP(PH_POOL_P, L); STEP(PH_POOL_G2, L); STEP(PH_POOL_G3, L); }
        else if (kind == 1) { STEP(PH_DIL_G1, L); STEP(PH_DIL_ATT, L); STEP(PH_DIL_CMB, L); STEP(PH_DIL_G2, L); }
        else { STEP(PH_CONV_G1, L); STEP(PH_CONV_E, L); STEP(PH_CONV_G2, L); }
        STEP(PH_MOE1, L); STEP(PH_MOE2, L); STEP(PH_MOE3, L); STEP(PH_MOE4, L);
    }
#undef STEP
}
constexpr int N_STEPS = 1 + 2 * 8 + 8 + 7;

template <int PH> static void launch_phase(const Args& a, int L, int grid, hipStream_t stream) {
    static bool attr = false;
    if (!attr) { (void)hipFuncSetAttribute((const void*)k_phase<PH>, hipFuncAttributeMaxDynamicSharedMemorySize, LDS_BYTES); attr = true; }
    hipLaunchKernelGGL(k_phase<PH>, dim3(grid), dim3(512), LDS_BYTES, stream, a, L);
}
extern "C" void kernel_launch(void* const* d_in, const int* in_sizes, int n_in, void* d_out, int out_size, void* d_ws, size_t ws_size, hipStream_t stream) {
    static int grid = 0;
    if (grid == 0) {
        if (n_in != 19 || out_size != T * D || ws_size < WS_END) { fprintf(stderr, "kernel_launch: unexpected shapes (n_in %d out %d ws %zu need %zu)\n", n_in, out_size, ws_size, (size_t)WS_END); grid = -1; return; }
        int dev = 0, cus = 0;
        if (hipGetDevice(&dev) != hipSuccess || hipDeviceGetAttribute(&cus, hipDeviceAttributeMultiprocessorCount, dev) != hipSuccess) { grid = -1; return; }
#if MK_ONE_LAUNCH
        if (hipFuncSetAttribute((const void*)fwd_all, hipFuncAttributeMaxDynamicSharedMemorySize, LDS_BYTES) != hipSuccess) { fprintf(stderr, "kernel_launch: hipFuncSetAttribute failed\n"); grid = -1; return; }
        int per_cu = 0;
        if (hipOccupancyMaxActiveBlocksPerMultiprocessor(&per_cu, (const void*)fwd_all, 512, LDS_BYTES) != hipSuccess || per_cu < 1) { fprintf(stderr, "kernel_launch: note: occupancy query reports %d blocks per CU\n", per_cu); (void)hipGetLastError(); }
#endif
        grid = cus;
    }
    if (grid < 0) return;
    (void)hipMemsetAsync((char*)d_ws + WS_CTL, 0, CTL_ZERO_BYTES, stream);
    Args a{};
    for (int i = 0; i < 19; ++i) a.in[i] = (const float*)d_in[i];
    a.out = (float*)d_out; a.ws = (unsigned char*)d_ws; a.ph_lo = 0; a.ph_hi = 0;
#if MK_ONE_LAUNCH
#ifdef MK_SPLIT
    for (int p = 0; p < N_STEPS; ++p) { a.ph_lo = p; a.ph_hi = p + 1; hipLaunchKernelGGL(fwd_all, dim3(grid), dim3(512), LDS_BYTES, stream, a); }
#else
    a.ph_lo = 0; a.ph_hi = N_STEPS;
    hipLaunchKernelGGL(fwd_all, dim3(grid), dim3(512), LDS_BYTES, stream, a);
#endif
#elif defined(MK_HYBRID_MASK)
    {
        static bool attr2 = false; if (!attr2) { (void)hipFuncSetAttribute((const void*)fwd_all, hipFuncAttributeMaxDynamicSharedMemorySize, LDS_BYTES); attr2 = true; }
        int pc = 0;
#define HSTEP(PH, Lx) do { if ((MK_HYBRID_MASK >> (PH)) & 1) { a.ph_lo = pc; a.ph_hi = pc + 1; hipLaunchKernelGGL(fwd_all, dim3(grid), dim3(512), LDS_BYTES, stream, a); } else { a.ph_lo = 0; a.ph_hi = 0; launch_phase<PH>(a, Lx, grid, stream); } ++pc; } while (0)
        HSTEP(PH_PRO, 0);
        for (int L = 0; L < DEPTH; ++L) {
            const int kind = L % 3;
            if (kind == 0) { HSTEP(PH_POOL_G1, L); HSTEP(PH_POOL_P, L); HSTEP(PH_POOL_G2, L); HSTEP(PH_POOL_G3, L); }
            else if (kind == 1) { HSTEP(PH_DIL_G1, L); HSTEP(PH_DIL_ATT, L); HSTEP(PH_DIL_CMB, L); HSTEP(PH_DIL_G2, L); }
            else { HSTEP(PH_CONV_G1, L); HSTEP(PH_CONV_E, L); HSTEP(PH_CONV_G2, L); }
            HSTEP(PH_MOE1, L); HSTEP(PH_MOE2, L); HSTEP(PH_MOE3, L); HSTEP(PH_MOE4, L);
        }
#undef HSTEP
    }
#else
    launch_phase<PH_PRO>(a, 0, grid, stream);
    for (int L = 0; L < DEPTH; ++L) {
        const int kind = L % 3;
        if (kind == 0) { launch_phase<PH_POOL_G1>(a, L, grid, stream); launch_phase<PH_POOL_P>(a, L, grid, stream); launch_phase<PH_POOL_G2>(a, L, grid, stream); launch_phase<PH_POOL_G3>(a, L, grid, stream); }
        else if (kind == 1) { launch_phase<PH_DIL_G1>(a, L, grid, stream); launch_phase<PH_DIL_ATT>(a, L, grid, stream); launch_phase<PH_DIL_CMB>(a, L, grid, stream); launch_phase<PH_DIL_G2>(a, L, grid, stream); }
        else { launch_phase<PH_CONV_G1>(a, L, grid, stream); launch_phase<PH_CONV_E>(a, L, grid, stream); launch_phase<PH_CONV_G2>(a, L, grid, stream); }
        launch_phase<PH_MOE1>(a, L, grid, stream); launch_phase<PH_MOE2>(a, L, grid, stream); launch_phase<PH_MOE3>(a, L, grid, stream); launch_phase<PH_MOE4>(a, L, grid, stream);
    }
#endif
}
```

```cpp
#include <hip/hip_runtime.h>
#include <cstdio>
#include <cstdint>

#ifndef MK_ONE_LAUNCH
#define MK_ONE_LAUNCH 1
#endif

#define GAS __attribute__((address_space(1)))
#define LAS __attribute__((address_space(3)))
typedef unsigned short bf16;
typedef unsigned v4u __attribute__((ext_vector_type(4)));
typedef unsigned v2u __attribute__((ext_vector_type(2)));
typedef float f32x4 __attribute__((ext_vector_type(4)));
typedef float f32x2 __attribute__((ext_vector_type(2)));
typedef short bf16x8 __attribute__((ext_vector_type(8)));
typedef short s16x4 __attribute__((ext_vector_type(4)));

constexpr int NBATCH = 8, SEQ = 2048, D = 2048, T = NBATCH * SEQ, DEPTH = 4;
constexpr int NEXP = 64, TOPK = 8, EDIM = 128, SDIM = 256;
constexpr int QKVC = 4608, DILW = 512;
constexpr float ALPHA = 1.681792830507429f;
constexpr float LN_EPS = 1e-5f;
constexpr int CAP = 16384;
constexpr int HROWS = T * TOPK + NEXP * 256;

constexpr size_t MiB = 1u << 20;
constexpr size_t WS_CTL = 0, CTL_ZERO_BYTES = 1 * MiB;
constexpr size_t WS_W_POOL_IN = 1 * MiB;
constexpr size_t WS_W_POOL_G = WS_W_POOL_IN + 16 * MiB;
constexpr size_t WS_W_POOL_OUT = WS_W_POOL_G + 4 * MiB;
constexpr size_t WS_W_DIL_QKV = WS_W_POOL_OUT + 16 * MiB;
constexpr size_t WS_W_DIL_OUT = WS_W_DIL_QKV + 18 * MiB;
constexpr size_t WS_W_CONV_IN = WS_W_DIL_OUT + 2 * MiB;
constexpr size_t WS_W_CONV_OUT = WS_W_CONV_IN + 24 * MiB;
constexpr size_t WS_W_SH_GU = WS_W_CONV_OUT + 8 * MiB;
constexpr size_t WS_W_SH_D = WS_W_SH_GU + 8 * MiB;
constexpr size_t WS_W_EX_GU = WS_W_SH_D + 4 * MiB;
constexpr size_t WS_W_EX_D = WS_W_EX_GU + 256 * MiB;
constexpr size_t WS_XF = WS_W_EX_D + 256 * MiB;
constexpr size_t WS_YF = WS_XF + 128 * MiB;
constexpr size_t WS_X1F = WS_YF + 128 * MiB;
constexpr size_t WS_XB = WS_X1F + 128 * MiB;
constexpr size_t WS_X1B = WS_XB + 64 * MiB;
constexpr size_t WS_HB = WS_X1B + 64 * MiB;
constexpr size_t WS_HS = WS_HB + 72 * MiB;
constexpr size_t WS_LTOK = WS_HS + 8 * MiB;
constexpr size_t WS_LGATE = WS_LTOK + 4 * MiB;
constexpr size_t WS_EIDX = WS_LGATE + 4 * MiB;
constexpr size_t WS_INV = WS_EIDX + 1 * MiB;
constexpr size_t WS_BIG = WS_INV + 1 * MiB;
constexpr size_t WS_PST = WS_BIG + 608 * MiB;
constexpr size_t WS_ST1 = WS_PST + 4 * MiB;
constexpr size_t WS_ST2 = WS_ST1 + 1 * MiB;
constexpr size_t WS_RWH = WS_ST2 + 1 * MiB;
constexpr size_t WS_RWL = WS_RWH + 1 * MiB;
constexpr size_t WS_PST2 = WS_RWL + 1 * MiB;
constexpr size_t WS_END = WS_PST2 + 8 * MiB;
constexpr size_t WS_Y2F = WS_X1F;
constexpr size_t BG_U = 0, BG_PL = 64 * MiB, BG_MX = 128 * MiB;
constexpr size_t BG_QKV = 0, BG_OG = 144 * MiB, BG_LSE = 192 * MiB, BG_O = 194 * MiB;
constexpr size_t BG_UC = 0, BG_BG = 64 * MiB, BG_Z = 128 * MiB;
constexpr size_t BG_YSC = 400 * MiB;
constexpr int CW_BAR = 4096;
constexpr int CW_CNT = 16384;

constexpr int RING_BYTES = 131072;
constexpr int LDS_TAB = RING_BYTES;
constexpr int LDS_STASH = RING_BYTES + 1024;
constexpr int LDS_BYTES = 163840;
constexpr int LDS_MISC = LDS_BYTES - 1024;

typedef __bf16 bf16x2_t __attribute__((ext_vector_type(2)));
typedef float f32x2_t __attribute__((ext_vector_type(2)));
__device__ __forceinline__ unsigned cvt_pk_bf16(float lo, float hi) { const bf16x2_t r = __builtin_convertvector((f32x2_t){lo, hi}, bf16x2_t); return __builtin_bit_cast(unsigned, r); }
__device__ __forceinline__ unsigned f2bf(float f) { unsigned u = __builtin_bit_cast(unsigned, f); return (u + 0x7fffu + ((u >> 16) & 1u)) >> 16; }
__device__ __forceinline__ unsigned pk2(float lo, float hi) { return f2bf(lo) | (f2bf(hi) << 16); }
__device__ __forceinline__ float bflo(unsigned w) { return __builtin_bit_cast(float, w << 16); }
__device__ __forceinline__ float bfhi(unsigned w) { return __builtin_bit_cast(float, w & 0xffff0000u); }
__device__ __forceinline__ float shfl_from(float v, int src) { return __builtin_bit_cast(float, __builtin_amdgcn_ds_bpermute(src << 2, __builtin_bit_cast(int, v))); }
__device__ __forceinline__ float shfl_x(float v, int o, int lane) { return shfl_from(v, lane ^ o); }
__device__ __forceinline__ float wave_sum(float v, int lane) {
    (void)lane;
    v += __builtin_bit_cast(float, __builtin_amdgcn_update_dpp(0, __builtin_bit_cast(int, v), 0xB1, 0xF, 0xF, false));
    v += __builtin_bit_cast(float, __builtin_amdgcn_update_dpp(0, __builtin_bit_cast(int, v), 0x4E, 0xF, 0xF, false));
    v += __builtin_bit_cast(float, __builtin_amdgcn_update_dpp(0, __builtin_bit_cast(int, v), 0x141, 0xF, 0xF, false));
    v += __builtin_bit_cast(float, __builtin_amdgcn_update_dpp(0, __builtin_bit_cast(int, v), 0x140, 0xF, 0xF, false));
    const float r0 = __builtin_bit_cast(float, __builtin_amdgcn_readlane(__builtin_bit_cast(int, v), 0)), r1 = __builtin_bit_cast(float, __builtin_amdgcn_readlane(__builtin_bit_cast(int, v), 16));
    const float r2 = __builtin_bit_cast(float, __builtin_amdgcn_readlane(__builtin_bit_cast(int, v), 32)), r3 = __builtin_bit_cast(float, __builtin_amdgcn_readlane(__builtin_bit_cast(int, v), 48));
    return (r0 + r1) + (r2 + r3);
}
__device__ __forceinline__ float sum_fq(float x) {
    { const auto r = __builtin_amdgcn_permlane16_swap(__builtin_bit_cast(unsigned, x), __builtin_bit_cast(unsigned, x), false, false); const unsigned a_ = r[0], b_ = r[1]; x = __builtin_bit_cast(float, a_) + __builtin_bit_cast(float, b_); }
    { const auto r = __builtin_amdgcn_permlane32_swap(__builtin_bit_cast(unsigned, x), __builtin_bit_cast(unsigned, x), false, false); const unsigned a_ = r[0], b_ = r[1]; x = __builtin_bit_cast(float, a_) + __builtin_bit_cast(float, b_); }
    return x;
}
__device__ __forceinline__ float max_fq(float x) {
    { const auto r = __builtin_amdgcn_permlane16_swap(__builtin_bit_cast(unsigned, x), __builtin_bit_cast(unsigned, x), false, false); const unsigned a_ = r[0], b_ = r[1]; x = fmaxf(__builtin_bit_cast(float, a_), __builtin_bit_cast(float, b_)); }
    { const auto r = __builtin_amdgcn_permlane32_swap(__builtin_bit_cast(unsigned, x), __builtin_bit_cast(unsigned, x), false, false); const unsigned a_ = r[0], b_ = r[1]; x = fmaxf(__builtin_bit_cast(float, a_), __builtin_bit_cast(float, b_)); }
    return x;
}
#define LDS_WAIT() asm volatile("s_waitcnt lgkmcnt(0)" ::: "memory")
#define VM_WAIT() asm volatile("s_waitcnt vmcnt(0)" ::: "memory")

#define XB_TMO      128
#define XB_XCNT(j)  (256  + 64 * (j))
#define XB_XSUB(j)  (1280 + 64 * (j))
#define XB_XGEN(j)  (2304 + 64 * (j))
#define XB_TOP      3328
#define XB_TOPGEN   3392
#define XCD_BAR_WORDS 3456
#define XB_SPIN_CAP (1u << 18)

__device__ __forceinline__ unsigned xb_ld(unsigned* p)              { return __hip_atomic_load(p, __ATOMIC_RELAXED, __HIP_MEMORY_SCOPE_AGENT); }
__device__ __forceinline__ unsigned xb_add(unsigned* p, unsigned v) { return __hip_atomic_fetch_add(p, v, __ATOMIC_RELAXED, __HIP_MEMORY_SCOPE_AGENT); }
__device__ __forceinline__ unsigned xb_xcc_id() { return (unsigned)__builtin_amdgcn_s_getreg((3 << 11) | 20) & 0xFu; }
#define XB_SPIN(cond, bar) do { unsigned _sp = 0; while (cond) { __builtin_amdgcn_s_sleep(1); \
    if ((++_sp & 255u) == 0u) { if (xb_ld(&(bar)[XB_TMO])) break; if (_sp > XB_SPIN_CAP) { atomicAdd(&(bar)[XB_TMO], 1u); break; } } } } while (0)

struct XcdBarrier {
    unsigned* bar; unsigned x;
    volatile LAS unsigned* st;
};

__device__ __forceinline__ XcdBarrier xcd_barrier_post(unsigned* bar, volatile LAS unsigned* st) {
    XcdBarrier b; b.bar = bar; b.x = xb_xcc_id(); b.st = st;
    if (threadIdx.x == 0) (void)xb_add(&bar[XB_XCNT(b.x)], 1u);
    return b;
}
__device__ __forceinline__ void xcd_barrier_complete(unsigned* bar, unsigned x, unsigned& nloc, unsigned& nx) {
    const unsigned G = gridDim.x * gridDim.y * gridDim.z;
    unsigned sum, cnt, mine, sp = 0u;
    for (;;) {
        sum = 0u; cnt = 0u; mine = 0u;
#pragma unroll
        for (unsigned j = 0; j < 16; ++j) { const unsigned c = xb_ld(&bar[XB_XCNT(j)]); sum += c; cnt += (c > 0u) ? 1u : 0u; mine = (j == x) ? c : mine; }
        if (sum == G) break;
        __builtin_amdgcn_s_sleep(1);
        if ((++sp & 255u) == 0u) { if (xb_ld(&bar[XB_TMO])) break; if (sp > XB_SPIN_CAP) { atomicAdd(&bar[XB_TMO], 1u); break; } }
    }
    nloc = mine > 0u ? mine : 1u; nx = cnt > 0u ? cnt : 1u;
}

__device__ __forceinline__ void xcd_barrier(const XcdBarrier& b) {
    asm volatile("s_waitcnt vmcnt(0)" ::: "memory");
    __syncthreads();
    if (threadIdx.x == 0) {
        unsigned* bar; unsigned bx = b.x; { GAS unsigned* bg = (GAS unsigned*)b.bar; asm volatile("" : "+s"(bg), "+s"(bx)); bar = (unsigned*)bg; }
        __builtin_amdgcn_s_waitcnt(0);
        unsigned nloc = b.st[0], nx = b.st[1];
        if (nloc == 0u) { xcd_barrier_complete(bar, bx, nloc, nx); b.st[0] = nloc; b.st[1] = nx; }
        const unsigned old = xb_add(&bar[XB_XSUB(bx)], 1u);
        const unsigned gen = old / nloc;
        if (old + 1u == (gen + 1u) * nloc) {
            __builtin_amdgcn_fence(__ATOMIC_RELEASE, "agent");
            asm volatile("s_waitcnt vmcnt(0)" ::: "memory");
            const unsigned og = xb_add(&bar[XB_TOP], 1u);
            const unsigned tg = og / nx;
            if (og + 1u == (tg + 1u) * nx) xb_add(&bar[XB_TOPGEN], 1u);
            else XB_SPIN(xb_ld(&bar[XB_TOPGEN]) == tg, bar);
            __builtin_amdgcn_fence(__ATOMIC_ACQUIRE, "agent");
            xb_add(&bar[XB_XGEN(bx)], 1u);
            asm volatile("s_waitcnt vmcnt(0)" ::: "memory");
        } else {
            XB_SPIN(xb_ld(&bar[XB_XGEN(bx)]) == gen, bar);
            __builtin_amdgcn_fence(__ATOMIC_ACQUIRE, "agent");
            asm volatile("s_waitcnt vmcnt(0)" ::: "memory");
        }
    }
    __syncthreads();
}

namespace g8 {
constexpr int BM = 256, BK = 64, HALF = 128, HTB = HALF * BK * 2, STAGE_BYTES = 8 * HTB, NXCD = 8, WGM = 8;
__host__ __device__ __forceinline__ int lds_byte(int r, int c) { const int st = (r >> 4) * 2 + (c >> 5), rr = r & 15, cc = c & 31, ob = rr * 64 + cc * 2; return st * 1024 + (ob ^ (((ob >> 9) & 1) << 5)); }
__host__ __device__ __forceinline__ void stage_rc(int b, int& R, int& C) { const int st = b / 1024, sb = b % 1024, swz = sb ^ (((sb >> 9) & 1) << 5); R = (st >> 1) * 16 + swz / 64; C = (st & 1) * 32 + (swz % 64) / 2; }
__host__ __device__ __forceinline__ int perm32(int rho) { const int n = rho >> 4, i = rho & 15; return 8 * (i >> 2) + 4 * n + (i & 3); }

struct Unit { const char* A; const char* B; const int* rows; int pm, pn, nvalid, aux; };

template <class Epi, class Sched, bool GATHER>
__device__ __forceinline__ void gemm_phase(LAS unsigned char* lds, const int tid_in, const int K, const int lda, const int ldb, const Sched& S, const Epi& E) {
    const int tid = tid_in, wid = __builtin_amdgcn_readfirstlane(tid >> 6), lane = tid & 63, wr = wid >> 2, wc = wid & 3, fr = lane & 15, fq = lane >> 4;
    const int nt = K / BK;
    unsigned voffB[2];
#pragma unroll
    for (int i = 0; i < 2; ++i) { int R_, C_; stage_rc(tid * 16 + i * 8192, R_, C_); const int Rb = Epi::PERM ? ((R_ & ~31) + perm32(R_ & 31)) : R_; voffB[i] = (unsigned)(Rb * ldb + C_) * 2u; }
    LAS v4u* stash = (LAS v4u*)(lds + (LDS_STASH - 0) + tid * 16);
    const size_t kstep = (size_t)(BK * 2);
    const size_t hstepB = (size_t)HALF * ldb * 2;
    const unsigned ldsw = (unsigned)wid * 1024u;
    const int aoff = lds_byte(wr * 64 + fr, fq * 8), boff = lds_byte(wc * 32 + fr, fq * 8);
#define G8_SA(b, h) (((b) * 2 + (h)) * HTB)
#define G8_SB(b, h) ((4 + (b) * 2 + (h)) * HTB)
#define G8_STAGE2(bufoff, gbase, v0, v1) do { \
        __builtin_amdgcn_global_load_lds((const unsigned*)((const char*)(gbase) + (v0)), (LAS unsigned*)(lds + (bufoff) + ldsw), 16, 0, 0); \
        __builtin_amdgcn_global_load_lds((const unsigned*)((const char*)(gbase) + (v1)), (LAS unsigned*)(lds + (bufoff) + ldsw + 8192), 16, 0, 0); } while (0)
#define G8_STAGEB(bufoff, gbase) G8_STAGE2(bufoff, gbase, voffB[0], voffB[1])
#define G8_LDA(dst, b, h) do { _Pragma("unroll") for (int m = 0; m < 4; ++m) _Pragma("unroll") for (int k = 0; k < 2; ++k) dst[m][k] = *(const LAS bf16x8*)(lds + G8_SA(b, h) + aoff + m * 2048 + k * 1024); } while (0)
#define G8_LDB(dst, b, h) do { _Pragma("unroll") for (int n = 0; n < 2; ++n) _Pragma("unroll") for (int k = 0; k < 2; ++k) dst[n][k] = *(const LAS bf16x8*)(lds + G8_SB(b, h) + boff + n * 2048 + k * 1024); } while (0)
#define G8_MMA(ai, bj, At, Bt) do { __builtin_amdgcn_s_setprio(1); _Pragma("unroll") for (int m = 0; m < 4; ++m) _Pragma("unroll") for (int n = 0; n < 2; ++n) _Pragma("unroll") for (int k = 0; k < 2; ++k) \
        acc[ai][bj][m][n] = __builtin_amdgcn_mfma_f32_16x16x32_bf16(Bt[n][k], At[m][k], acc[ai][bj][m][n], 0, 0, 0); __builtin_amdgcn_s_setprio(0); } while (0)
#define G8_WAIT_V(n) asm volatile("s_waitcnt vmcnt(" #n ")" ::: "memory")
#define G8_WAIT_L(n) asm volatile("s_waitcnt lgkmcnt(" #n ")" ::: "memory")
#define G8_BAR __builtin_amdgcn_s_barrier()
#define G8_SCHED __builtin_amdgcn_sched_barrier(0)
#define G8_SETVA(dst, u) do { int _t2 = tid; if (GATHER) asm volatile("" : "+v"(_t2)); _Pragma("unroll") for (int _h = 0; _h < 2; ++_h) _Pragma("unroll") for (int _i = 0; _i < 2; ++_i) { \
        int _R, _C; stage_rc(_t2 * 16 + _i * 8192, _R, _C); \
        const unsigned _rl = (unsigned)(_h * HALF + _R); unsigned _row = _rl; \
        if (GATHER) { const bool _ok = _rl < (unsigned)(u).nvalid; _row = (unsigned)(u).rows[_ok ? _rl : 0u] >> 3; if (!_ok) _row = 0u; }     \
        dst[_h][_i] = (_row * (unsigned)lda + (unsigned)_C) * 2u; } } while (0)
    Unit cur, nxt; int ui = 0;
    if (!S.next(0, cur)) return;
    f32x4 acc[2][2][4][2];
#pragma unroll
    for (int a = 0; a < 2; ++a)
#pragma unroll
        for (int b = 0; b < 2; ++b)
#pragma unroll
            for (int m = 0; m < 4; ++m)
#pragma unroll
                for (int n = 0; n < 2; ++n) acc[a][b][m][n] = (f32x4){0.f, 0.f, 0.f, 0.f};
    bf16x8 At[4][2], B0[2][2], B1[2][2];
    unsigned vAc[2][2]; unsigned xl00 = 0, xl01 = 0, xl10 = 0, xl11 = 0;
    G8_SETVA(vAc, cur);
    const char* cA = cur.A; const char* cB = cur.B;
    G8_STAGEB(G8_SB(0, 0), cB); G8_STAGEB(G8_SB(0, 1), cB + hstepB); G8_STAGE2(G8_SA(0, 0), cA, vAc[0][0], vAc[0][1]); G8_STAGE2(G8_SA(0, 1), cA, vAc[1][0], vAc[1][1]);
    if (wr == 1) G8_BAR;
    G8_WAIT_V(2); G8_BAR;
    G8_STAGEB(G8_SB(1, 0), cB + kstep); G8_STAGE2(G8_SA(1, 0), cA + kstep, vAc[0][0], vAc[0][1]); G8_STAGEB(G8_SB(1, 1), cB + hstepB + kstep);
    G8_WAIT_V(6); G8_BAR;
    for (;;) {
        const bool has_next = S.next(ui + 1, nxt);
        const char* nA = has_next ? nxt.A : cA; const char* nB = has_next ? nxt.B : cB;
        if (GATHER) { unsigned vAn[2][2]; if (has_next) { G8_SETVA(vAn, nxt); } else {
#pragma unroll
            for (int h = 0; h < 2; ++h)
#pragma unroll
                for (int i = 0; i < 2; ++i) vAn[h][i] = vAc[h][i]; }
            *stash = (v4u){vAn[0][0], vAn[0][1], vAn[1][0], vAn[1][1]}; }
#pragma unroll 1
        for (int t = 0; t < nt; t += 2) {
            const bool last = (t == nt - 2);
            const char* a1 = cA + (size_t)(t + 1) * kstep;
            const char* a2 = last ? nA : cA + (size_t)(t + 2) * kstep; const char* b2 = last ? nB : cB + (size_t)(t + 2) * kstep;
            const char* a3 = a2 + kstep; const char* b3 = b2 + kstep;
            unsigned x00 = vAc[0][0], x01 = vAc[0][1], x10 = vAc[1][0], x11 = vAc[1][1];
            if (GATHER) { if (last) { const v4u sv = *stash; x00 = sv.x; x01 = sv.y; x10 = sv.z; x11 = sv.w; } xl00 = x00; xl01 = x01; xl10 = x10; xl11 = x11; }
            G8_LDB(B0, 0, 0); G8_LDB(B1, 0, 1); G8_SCHED; G8_LDA(At, 0, 0); G8_STAGE2(G8_SA(1, 1), a1, vAc[1][0], vAc[1][1]);
            G8_WAIT_V(8); G8_WAIT_L(0); G8_BAR; G8_MMA(0, 0, At, B0); G8_MMA(0, 1, At, B1); G8_BAR; G8_SCHED;
            G8_LDA(At, 0, 1); G8_STAGEB(G8_SB(0, 0), b2); G8_STAGEB(G8_SB(0, 1), b2 + hstepB); G8_STAGE2(G8_SA(0, 0), a2, x00, x01);
            G8_WAIT_V(8); G8_WAIT_L(0); G8_BAR; G8_MMA(1, 0, At, B0); G8_MMA(1, 1, At, B1); G8_BAR; G8_SCHED;
            G8_LDB(B0, 1, 0); G8_LDB(B1, 1, 1); G8_SCHED; G8_LDA(At, 1, 0); G8_STAGE2(G8_SA(0, 1), a2, x10, x11);
            G8_WAIT_V(8); G8_WAIT_L(0); G8_BAR; G8_MMA(0, 0, At, B0); G8_MMA(0, 1, At, B1); G8_BAR; G8_SCHED;
            G8_LDA(At, 1, 1); G8_STAGEB(G8_SB(1, 0), b3); G8_STAGEB(G8_SB(1, 1), b3 + hstepB); G8_STAGE2(G8_SA(1, 0), a3, x00, x01);
            G8_WAIT_V(8); G8_WAIT_L(0); G8_BAR; G8_MMA(1, 0, At, B0); G8_MMA(1, 1, At, B1); G8_BAR; G8_SCHED;
        }
        if (wr == 0) G8_BAR;
        E(acc, cur, wr, wc, fr, fq);
        if (!has_next) break;
#pragma unroll
        for (int a = 0; a < 2; ++a)
#pragma unroll
            for (int b = 0; b < 2; ++b)
#pragma unroll
                for (int m = 0; m < 4; ++m)
#pragma unroll
                    for (int n = 0; n < 2; ++n) acc[a][b][m][n] = (f32x4){0.f, 0.f, 0.f, 0.f};
        cur = nxt; cA = nA; cB = nB; ++ui;
        if (GATHER) { vAc[0][0] = xl00; vAc[0][1] = xl01; vAc[1][0] = xl10; vAc[1][1] = xl11; }
        if (wr == 1) G8_BAR;
    }
    G8_WAIT_V(0);
    G8_BAR;
#undef G8_SA
#undef G8_SB
#undef G8_STAGE2
#undef G8_STAGEB
#undef G8_LDA
#undef G8_LDB
#undef G8_MMA
#undef G8_WAIT_V
#undef G8_WAIT_L
#undef G8_BAR
#undef G8_SCHED
#undef G8_SETVA
}

struct DenseSched {
    const char* A; const char* B; size_t a_tile, b_tile, agrp_stride; int agrp_shift, nM, nN, nwg, G, c;
    __device__ __forceinline__ void init(const void* A_, const void* B_, int M, int N, int lda, int ldb, int G_, int c_) {
        A = (const char*)A_; B = (const char*)B_; a_tile = (size_t)BM * lda * 2; b_tile = (size_t)BM * ldb * 2; agrp_stride = 0; agrp_shift = 0; nM = M / BM; nN = N / BM; nwg = nM * nN; G = G_; c = c_; }
    __device__ __forceinline__ bool next(int i, Unit& u) const {
        const long L = (long)i * G + c; if (L >= nwg) return false;
        int wgid = (int)L; { const int q = nwg / NXCD, r = nwg % NXCD, xcd = wgid % NXCD, off = wgid / NXCD; wgid = (xcd < r ? xcd * (q + 1) : r * (q + 1) + (xcd - r) * q) + off; }
        const int nig = WGM * nN, gid = wgid / nig, fm = gid * WGM, gsz = (nM - fm) < WGM ? (nM - fm) : WGM;
        u.pm = fm + ((wgid % nig) % gsz); u.pn = (wgid % nig) / gsz;
        u.A = A + (size_t)u.pm * a_tile + (size_t)(u.pn >> agrp_shift) * agrp_stride; u.B = B + (size_t)u.pn * b_tile; u.rows = nullptr; u.nvalid = BM; u.aux = 0; return true;
    }
};
template <int NPN, bool GATHERED>
struct ExpertSched {
    const LAS int* tpref; const LAS int* cnt; const char* A; const char* B; const int* tok; size_t b_exp, b_tile, a_tile; int NU, G, c;
    __device__ __forceinline__ bool next(int i, Unit& u) const {
        int L = i * G + c; if (L >= NU) return false;
        if ((i + 1) * G <= NU && (G % NXCD) == 0) L = i * G + (c % NXCD) * (G / NXCD) + c / NXCD;
        const int tile = L / NPN, pn = L % NPN;
        int e = 0; { int hi = 64;
#pragma unroll
          for (int it_ = 0; it_ < 6; ++it_) { const int mid = (e + hi) >> 1; if (__builtin_amdgcn_readfirstlane(tpref[mid]) <= tile) e = mid; else hi = mid; } }
        const int rb = tile - __builtin_amdgcn_readfirstlane(tpref[e]);
        u.pm = e; u.pn = pn; u.aux = tile * BM; u.nvalid = __builtin_amdgcn_readfirstlane(cnt[e]) - rb * BM; if (u.nvalid > BM) u.nvalid = BM;
        u.rows = tok + (size_t)e * CAP + rb * BM;
        u.A = GATHERED ? A : A + (size_t)tile * a_tile; u.B = B + (size_t)e * b_exp + (size_t)pn * b_tile; return true;
    }
};

struct EpiBf16 {
    static constexpr bool PERM = true;
    bf16* O; int ldc; int qscale;
    __device__ __forceinline__ void operator()(const f32x4 (&acc)[2][2][4][2], const Unit& u, int wr, int wc, int fr, int fq) const {
        asm volatile("" : "+v"(fr), "+v"(fq));
        const int row0 = u.pm * BM + wr * 64 + fr, col0 = u.pn * BM + wc * 32 + 8 * fq;
        const float sc = (qscale && (u.pn % 6) < 2) ? 0.125f : 1.0f;
#pragma unroll
        for (int ai = 0; ai < 2; ++ai)
#pragma unroll
            for (int m = 0; m < 4; ++m) { bf16* rowp = O + (size_t)(row0 + ai * HALF + m * 16) * ldc + col0;
#pragma unroll
                for (int bj = 0; bj < 2; ++bj) { const f32x4 v0 = acc[ai][bj][m][0] * sc, v1 = acc[ai][bj][m][1] * sc;
                    v4u w; w.x = cvt_pk_bf16(v0[0], v0[1]); w.y = cvt_pk_bf16(v0[2], v0[3]); w.z = cvt_pk_bf16(v1[0], v1[1]); w.w = cvt_pk_bf16(v1[2], v1[3]);
                    *(v4u*)(rowp + bj * HALF) = w; } }
    }
};
struct EpiScaleBf16 {
    static constexpr bool PERM = true;
    bf16* O; int ldc; const float* scale;
    __device__ __forceinline__ void operator()(const f32x4 (&acc)[2][2][4][2], const Unit& u, int wr, int wc, int fr, int fq) const {
        asm volatile("" : "+v"(fr), "+v"(fq));
        const int row0 = u.pm * BM + wr * 64 + fr, col0 = u.pn * BM + wc * 32 + 8 * fq;
        f32x4 sv[2][2];
#pragma unroll
        for (int bj = 0; bj < 2; ++bj)
#pragma unroll
            for (int n = 0; n < 2; ++n) sv[bj][n] = *(const f32x4*)(scale + col0 + bj * HALF + 4 * n);
#pragma unroll
        for (int ai = 0; ai < 2; ++ai)
#pragma unroll
            for (int m = 0; m < 4; ++m) { bf16* rowp = O + (size_t)(row0 + ai * HALF + m * 16) * ldc + col0;
#pragma unroll
                for (int bj = 0; bj < 2; ++bj) { const f32x4 v0 = acc[ai][bj][m][0] * sv[bj][0], v1 = acc[ai][bj][m][1] * sv[bj][1];
                    v4u w; w.x = cvt_pk_bf16(v0[0], v0[1]); w.y = cvt_pk_bf16(v0[2], v0[3]); w.z = cvt_pk_bf16(v1[0], v1[1]); w.w = cvt_pk_bf16(v1[2], v1[3]);
                    *(v4u*)(rowp + bj * HALF) = w; } }
    }
};
struct EpiResid {
    static constexpr bool PERM = false;
    const float* X; float* Y;
    __device__ __forceinline__ void operator()(const f32x4 (&acc)[2][2][4][2], const Unit& u, int wr, int wc, int fr, int fq) const {
        asm volatile("" : "+v"(fr), "+v"(fq));
        const int row0 = u.pm * BM + wr * 64 + fr, col0 = u.pn * BM + wc * 32 + 4 * fq;
#pragma unroll
        for (int ai = 0; ai < 2; ++ai)
#pragma unroll
            for (int m = 0; m < 4; ++m) { const size_t off = (size_t)(row0 + ai * HALF + m * 16) * D + col0;
#pragma unroll
                for (int bj = 0; bj < 2; ++bj)
#pragma unroll
                    for (int n = 0; n < 2; ++n) { const f32x4 xv = *(const f32x4*)(X + off + bj * HALF + n * 16); *(f32x4*)(Y + off + bj * HALF + n * 16) = xv * ALPHA + acc[ai][bj][m][n]; } }
    }
};
struct EpiResidLN {
    static constexpr bool PERM = true;
    const float* X32; const bf16* Xb; const float* st; const float* g; const float* b; bf16* Y; float* pst; int mode;
    __device__ __forceinline__ void operator()(const f32x4 (&acc)[2][2][4][2], const Unit& u, int wr, int wc, int fr, int fq) const {
        asm volatile("" : "+v"(fr), "+v"(fq));
        const int row0 = u.pm * BM + wr * 64 + fr, col0 = u.pn * BM + wc * 32 + 8 * fq, lane = fq * 16 + fr;
#pragma unroll
        for (int ai = 0; ai < 2; ++ai) {
            v4u xr[4][2];
#pragma unroll
            for (int m = 0; m < 4; ++m)
#pragma unroll
                for (int bj = 0; bj < 2; ++bj) xr[m][bj] = *(const v4u*)(Xb + (size_t)(row0 + ai * HALF + m * 16) * D + col0 + bj * HALF);
            asm volatile("" : "+v"(xr[0][0]), "+v"(xr[0][1]), "+v"(xr[1][0]), "+v"(xr[1][1]), "+v"(xr[2][0]), "+v"(xr[2][1]), "+v"(xr[3][0]), "+v"(xr[3][1]));
#pragma unroll
            for (int m = 0; m < 4; ++m) { const int row = row0 + ai * HALF + m * 16; const size_t off = (size_t)row * D + col0;
                float sm = 0.f, sq = 0.f;
#pragma unroll
                for (int bj = 0; bj < 2; ++bj) { const v4u xv = xr[m][bj];
                    const f32x4 x0 = (f32x4){bflo(xv.x), bfhi(xv.x), bflo(xv.y), bfhi(xv.y)}, x1 = (f32x4){bflo(xv.z), bfhi(xv.z), bflo(xv.w), bfhi(xv.w)};
                    const f32x4 y0 = x0 * ALPHA + acc[ai][bj][m][0], y1 = x1 * ALPHA + acc[ai][bj][m][1];
                    v4u w; w.x = cvt_pk_bf16(y0[0], y0[1]); w.y = cvt_pk_bf16(y0[2], y0[3]); w.z = cvt_pk_bf16(y1[0], y1[1]); w.w = cvt_pk_bf16(y1[2], y1[3]);
                    *(v4u*)(Y + off + bj * HALF) = w;
                    sm += ((y0[0] + y0[1]) + (y0[2] + y0[3])) + ((y1[0] + y1[1]) + (y1[2] + y1[3]));
                    sq += ((y0[0] * y0[0] + y0[1] * y0[1]) + (y0[2] * y0[2] + y0[3] * y0[3])) + ((y1[0] * y1[0] + y1[1] * y1[1]) + (y1[2] * y1[2] + y1[3] * y1[3])); }
                sm = sum_fq(sm); sq = sum_fq(sq);
                if (fq == 0) *(f32x2*)(pst + ((size_t)row * 32 + u.pn * 4 + wc) * 2) = (f32x2){sm, sq}; } }
    }
};
struct EpiConvIn {
    static constexpr bool PERM = true;
    bf16* UC; bf16* BGp;
    __device__ __forceinline__ void operator()(const f32x4 (&acc)[2][2][4][2], const Unit& u, int wr, int wc, int fr, int fq) const {
        asm volatile("" : "+v"(fr), "+v"(fq));
        const int row0 = u.pm * BM + wr * 64 + fr, cw = wc * 32 + 8 * fq;
        if (u.pn < 16) {
#pragma unroll
            for (int ai = 0; ai < 2; ++ai)
#pragma unroll
                for (int m = 0; m < 4; ++m) { bf16* rowp = UC + (size_t)(row0 + ai * HALF + m * 16) * D + u.pn * HALF + cw;
                    const f32x4 v0 = acc[ai][0][m][0] * acc[ai][1][m][0], v1 = acc[ai][0][m][1] * acc[ai][1][m][1];
                    v4u w; w.x = cvt_pk_bf16(v0[0], v0[1]); w.y = cvt_pk_bf16(v0[2], v0[3]); w.z = cvt_pk_bf16(v1[0], v1[1]); w.w = cvt_pk_bf16(v1[2], v1[3]);
                    *(v4u*)rowp = w; }
        } else {
#pragma unroll
            for (int ai = 0; ai < 2; ++ai)
#pragma unroll
                for (int m = 0; m < 4; ++m) { bf16* rowp = BGp + (size_t)(row0 + ai * HALF + m * 16) * D + (u.pn - 16) * BM + cw;
#pragma unroll
                    for (int bj = 0; bj < 2; ++bj) { const f32x4 v0 = acc[ai][bj][m][0], v1 = acc[ai][bj][m][1];
                        v4u w; w.x = cvt_pk_bf16(v0[0], v0[1]); w.y = cvt_pk_bf16(v0[2], v0[3]); w.z = cvt_pk_bf16(v1[0], v1[1]); w.w = cvt_pk_bf16(v1[2], v1[3]);
                        *(v4u*)(rowp + bj * HALF) = w; } }
        }
    }
};
__device__ __forceinline__ f32x4 silu_mul(f32x4 g, f32x4 uu) {
    f32x4 r;
#pragma unroll
    for (int j = 0; j < 4; ++j) r[j] = g[j] * __builtin_amdgcn_rcpf(1.0f + __expf(-g[j])) * uu[j];
    return r;
}
struct EpiExpertGU {
    static constexpr bool PERM = true;
    bf16* H;
    __device__ __forceinline__ void operator()(const f32x4 (&acc)[2][2][4][2], const Unit& u, int wr, int wc, int fr, int fq) const {
        asm volatile("" : "+v"(fr), "+v"(fq));
        const float* gates = (const float*)((const char*)u.rows + (WS_LGATE - WS_LTOK));
        const int cw = wc * 32 + 8 * fq;
        float gtv[2][4];
#pragma unroll
        for (int ai = 0; ai < 2; ++ai)
#pragma unroll
            for (int m = 0; m < 4; ++m) { const int r = ai * HALF + wr * 64 + m * 16 + fr; gtv[ai][m] = gates[r < u.nvalid ? r : 0]; }
        asm volatile("" : "+v"(gtv[0][0]), "+v"(gtv[0][1]), "+v"(gtv[0][2]), "+v"(gtv[0][3]), "+v"(gtv[1][0]), "+v"(gtv[1][1]), "+v"(gtv[1][2]), "+v"(gtv[1][3]));
#pragma unroll
        for (int ai = 0; ai < 2; ++ai)
#pragma unroll
            for (int m = 0; m < 4; ++m) { const int r = ai * HALF + wr * 64 + m * 16 + fr;
                if (r < u.nvalid) { const float gt = gtv[ai][m]; const unsigned pid = 0u;
                    const f32x4 v0 = silu_mul(acc[ai][0][m][0], acc[ai][1][m][0]) * gt, v1 = silu_mul(acc[ai][0][m][1], acc[ai][1][m][1]) * gt;
                    v4u w; w.x = cvt_pk_bf16(v0[0], v0[1]); w.y = cvt_pk_bf16(v0[2], v0[3]); w.z = cvt_pk_bf16(v1[0], v1[1]); w.w = cvt_pk_bf16(v1[2], v1[3]);
                    (void)pid; *(v4u*)(H + (size_t)(u.aux + r) * EDIM + cw) = w; } }
    }
};
struct EpiSharedGU {
    static constexpr bool PERM = true;
    bf16* HS;
    __device__ __forceinline__ void operator()(const f32x4 (&acc)[2][2][4][2], const Unit& u, int wr, int wc, int fr, int fq) const {
        asm volatile("" : "+v"(fr), "+v"(fq));
        const int row0 = u.pm * BM + wr * 64 + fr, cw = u.pn * HALF + wc * 32 + 8 * fq;
#pragma unroll
        for (int ai = 0; ai < 2; ++ai)
#pragma unroll
            for (int m = 0; m < 4; ++m) {
                const f32x4 v0 = silu_mul(acc[ai][0][m][0], acc[ai][1][m][0]), v1 = silu_mul(acc[ai][0][m][1], acc[ai][1][m][1]);
                v4u w; w.x = cvt_pk_bf16(v0[0], v0[1]); w.y = cvt_pk_bf16(v0[2], v0[3]); w.z = cvt_pk_bf16(v1[0], v1[1]); w.w = cvt_pk_bf16(v1[2], v1[3]);
                *(v4u*)(HS + (size_t)(row0 + ai * HALF + m * 16) * SDIM + cw) = w; }
    }
};
struct EpiDownY {
    static constexpr bool PERM = true;
    bf16* Y;
    __device__ __forceinline__ void operator()(const f32x4 (&acc)[2][2][4][2], const Unit& u, int wr, int wc, int fr, int fq) const {
        asm volatile("" : "+v"(fr), "+v"(fq));
        const int col0 = u.pn * BM + wc * 32 + 8 * fq;
#pragma unroll
        for (int ai = 0; ai < 2; ++ai)
#pragma unroll
            for (int m = 0; m < 4; ++m) { const int r = ai * HALF + wr * 64 + m * 16 + fr; bf16* rowp = Y + (size_t)(u.aux + r) * D + col0;
#pragma unroll
                for (int bj = 0; bj < 2; ++bj) { const f32x4 v0 = acc[ai][bj][m][0], v1 = acc[ai][bj][m][1];
                    v4u w; w.x = cvt_pk_bf16(v0[0], v0[1]); w.y = cvt_pk_bf16(v0[2], v0[3]); w.z = cvt_pk_bf16(v1[0], v1[1]); w.w = cvt_pk_bf16(v1[2], v1[3]);
                    *(v4u*)(rowp + bj * HALF) = w; } }
    }
};
}

struct Args { const float* in[19]; float* out; unsigned char* ws; int ph_lo, ph_hi; };
struct Frame {
    LAS unsigned char* lds; unsigned* ctl; unsigned char* ws;
    int tid, lane, wave, G, bid;
};
enum { IN_X = 0, IN_RELB, IN_PWIN, IN_PWG, IN_PSC, IN_PWOUT, IN_DQKV, IN_DOUT, IN_CWIN, IN_CW, IN_CWOUT, IN_LNG, IN_LNB, IN_RW, IN_RB, IN_EGU, IN_ED, IN_SGU, IN_SD };

#define CAS __attribute__((address_space(4)))
typedef const CAS unsigned char* KP;
__device__ __forceinline__ const float* ain(KP kp, int i) { return (const float*)((const GAS float* const CAS*)kp)[i]; }
__device__ __forceinline__ float* aout(KP kp) { return (float*)((GAS float* const CAS*)kp)[19]; }
__device__ __forceinline__ void tr_item(const float* W, int K, int N, bf16* WT, int dstK, int mode, LAS float* scr, int item, int lane) {
    const int nblk = N / 32, kb = item / nblk, nb = item % nblk, k0 = 64 * kb, n0 = 32 * nb;
    int r0 = n0;
    if (mode == 1) { const int part = n0 / 2048, j = n0 % 2048; r0 = (part == 0) ? 4096 + j : 256 * (j / 128) + (part == 2 ? 128 : 0) + (j % 128); }
    if (mode == 2) { const int part = n0 / 256, j = n0 % 256; r0 = 256 * (j / 128) + 128 * part + (j % 128); }
    float wv[32];
#pragma unroll
    for (int i = 0; i < 32; ++i) { const int kk = 2 * i + (lane >> 5); wv[i] = __builtin_nontemporal_load(W + (size_t)(k0 + kk) * N + n0 + (lane & 31)); }
#pragma unroll
    for (int i = 0; i < 32; ++i) { const int kk = 2 * i + (lane >> 5); scr[kk * 33 + (lane & 31)] = wv[i]; }
    LDS_WAIT(); asm volatile("" ::: "memory");
    const int c = lane & 7;
#pragma unroll
    for (int j = 0; j < 4; ++j) { const int n = (lane >> 3) + 8 * j; const LAS float* s = scr + (8 * c) * 33 + n;
        v4u o; o.x = pk2(s[0 * 33], s[1 * 33]); o.y = pk2(s[2 * 33], s[3 * 33]); o.z = pk2(s[4 * 33], s[5 * 33]); o.w = pk2(s[6 * 33], s[7 * 33]);
        __builtin_nontemporal_store(o, (v4u*)(WT + (size_t)(r0 + n) * dstK + k0 + 8 * c)); }
    LDS_WAIT(); asm volatile("" ::: "memory");
}
__device__ __forceinline__ void phase_prologue(const Frame& F, KP kp) {
    LAS float* scr = (LAS float*)(F.lds + F.wave * 16384);
    const int gw = F.bid * 8 + F.wave, NGW = F.G * 8;
    constexpr int I0 = 2 * 2048, I1 = 8 * 128, I2 = 2 * 2048, I3 = 4608, I4 = 512, I5 = 6144, I6 = 2048, I7 = 4 * 512, I8 = 4 * 256, I9 = 256 * 256, I10 = 256 * 128;
    constexpr int NITEMS = I0 + I1 + I2 + I3 + I4 + I5 + I6 + I7 + I8 + I9 + I10;
    unsigned char* ws = F.ws;
    for (int it = gw; it < NITEMS; it += NGW) {
        int r = it;
        if (r < I0) { const int b = r / 2048; tr_item(ain(kp, IN_PWIN) + (size_t)b * D * D, D, D, (bf16*)(ws + WS_W_POOL_IN) + (size_t)b * D * D, D, 0, scr, r % 2048, F.lane); continue; } r -= I0;
        if (r < I1) { const int b = r / 128; tr_item(ain(kp, IN_PWG) + (size_t)b * 512 * 512, 512, 512, (bf16*)(ws + WS_W_POOL_G) + (size_t)b * 512 * 512, 512, 0, scr, r % 128, F.lane); continue; } r -= I1;
        if (r < I2) { const int b = r / 2048; tr_item(ain(kp, IN_PWOUT) + (size_t)b * D * D, D, D, (bf16*)(ws + WS_W_POOL_OUT) + (size_t)b * D * D, D, 0, scr, r % 2048, F.lane); continue; } r -= I2;
        if (r < I3) { tr_item(ain(kp, IN_DQKV), D, QKVC, (bf16*)(ws + WS_W_DIL_QKV), D, 0, scr, r, F.lane); continue; } r -= I3;
        if (r < I4) { tr_item(ain(kp, IN_DOUT), DILW, D, (bf16*)(ws + WS_W_DIL_OUT), DILW, 0, scr, r, F.lane); continue; } r -= I4;
        if (r < I5) { tr_item(ain(kp, IN_CWIN), D, 3 * D, (bf16*)(ws + WS_W_CONV_IN), D, 1, scr, r, F.lane); continue; } r -= I5;
        if (r < I6) { tr_item(ain(kp, IN_CWOUT), D, D, (bf16*)(ws + WS_W_CONV_OUT), D, 0, scr, r, F.lane); continue; } r -= I6;
        if (r < I7) { const int b = r / 512; tr_item(ain(kp, IN_SGU) + (size_t)b * D * 512, D, 512, (bf16*)(ws + WS_W_SH_GU) + (size_t)b * 512 * D, D, 2, scr, r % 512, F.lane); continue; } r -= I7;
        if (r < I8) { const int b = r / 256; tr_item(ain(kp, IN_SD) + (size_t)b * SDIM * D, SDIM, D, (bf16*)(ws + WS_W_SH_D) + (size_t)b * D * SDIM, SDIM, 0, scr, r % 256, F.lane); continue; } r -= I8;
        if (r < I9) { const int b = r / 256; tr_item(ain(kp, IN_EGU) + (size_t)b * D * 256, D, 256, (bf16*)(ws + WS_W_EX_GU) + (size_t)b * 256 * D, D, 0, scr, r % 256, F.lane); continue; } r -= I9;
        { const int b = r / 128; tr_item(ain(kp, IN_ED) + (size_t)b * EDIM * D, EDIM, D, (bf16*)(ws + WS_W_EX_D) + (size_t)b * D * EDIM, EDIM, 0, scr, r % 128, F.lane); }
    }
    const size_t gt = (size_t)F.bid * 512 + F.tid, GT = (size_t)F.G * 512;
    { const float* rw = ain(kp, IN_RW); bf16* wh = (bf16*)(ws + WS_RWH); bf16* wl = (bf16*)(ws + WS_RWL);
      for (size_t i = gt; i < (size_t)DEPTH * NEXP * D / 8; i += GT) { const size_t k8 = i % (D / 8), e = (i / (D / 8)) % NEXP, l = i / ((size_t)NEXP * D / 8);
          float v[8]; unsigned hi[8], lo[8];
#pragma unroll
          for (int j = 0; j < 8; ++j) { v[j] = rw[(l * D + k8 * 8 + j) * NEXP + e]; hi[j] = f2bf(v[j]); lo[j] = f2bf(v[j] - __builtin_bit_cast(float, hi[j] << 16)); }
          v4u a, b2; a.x = hi[0] | (hi[1] << 16); a.y = hi[2] | (hi[3] << 16); a.z = hi[4] | (hi[5] << 16); a.w = hi[6] | (hi[7] << 16);
          b2.x = lo[0] | (lo[1] << 16); b2.y = lo[2] | (lo[3] << 16); b2.z = lo[4] | (lo[5] << 16); b2.w = lo[6] | (lo[7] << 16);
          *(v4u*)(wh + (l * NEXP + e) * D + k8 * 8) = a; *(v4u*)(wl + (l * NEXP + e) * D + k8 * 8) = b2; } }
    const float* x = ain(kp, IN_X); bf16* xb = (bf16*)(ws + WS_XB);
    for (size_t i = gt; i < (size_t)T * D / 8; i += GT) { const f32x4 p = __builtin_nontemporal_load((const f32x4*)(x + i * 8)), q = __builtin_nontemporal_load((const f32x4*)(x + i * 8 + 4));
        v4u w; w.x = pk2(p[0], p[1]); w.y = pk2(p[2], p[3]); w.z = pk2(q[0], q[1]); w.w = pk2(q[2], q[3]); *(v4u*)(xb + i * 8) = w; }
}

__device__ __forceinline__ void unpack8(const v4u w, float (&f)[8]) { f[0] = bflo(w.x); f[1] = bfhi(w.x); f[2] = bflo(w.y); f[3] = bfhi(w.y); f[4] = bflo(w.z); f[5] = bfhi(w.z); f[6] = bflo(w.w); f[7] = bfhi(w.w); }
__device__ __forceinline__ void phase_pool(const Frame& F, const bf16* U, bf16* PL) {
    for (int it = F.bid * 512 + F.tid; it < (T / 32) * 256; it += F.G * 512) {
        const int cv = it & 255, ch = it >> 8, col = cv * 8;
        const int w = __builtin_amdgcn_readfirstlane(2 << (col >> 9));
        const int row0 = __builtin_amdgcn_readfirstlane(ch * 32), pos0 = row0 & (SEQ - 1);
        float s[8], uu[8];
#pragma unroll
        for (int j = 0; j < 8; ++j) s[j] = 0.f;
        { v4u pre[15];
#pragma unroll
          for (int j = 0; j < 15; ++j) { pre[j] = (v4u){0u, 0u, 0u, 0u}; if (j + 1 < w && pos0 - (j + 1) >= 0) pre[j] = *(const v4u*)(U + (size_t)(row0 - (j + 1)) * D + col); }
#pragma unroll
          for (int j = 0; j < 15; ++j) asm volatile("" : "+v"(pre[j]));
#pragma unroll
          for (int j = 0; j < 15; ++j) { unpack8(pre[j], uu);
#pragma unroll
              for (int q = 0; q < 8; ++q) s[q] += uu[q]; } }
#pragma unroll 1
        for (int cb = 0; cb < 4; ++cb) {
            v4u un[8], uo[8];
#pragma unroll
            for (int j = 0; j < 8; ++j) { const int r = 8 * cb + j, t = row0 + r, pos = pos0 + r;
                un[j] = *(const v4u*)(U + (size_t)t * D + col);
                uo[j] = (v4u){0u, 0u, 0u, 0u}; if (pos - w + 1 >= 0) uo[j] = *(const v4u*)(U + (size_t)(t - w + 1) * D + col); }
#pragma unroll
            for (int j = 0; j < 8; ++j) asm volatile("" : "+v"(un[j]), "+v"(uo[j]));
#pragma unroll
            for (int j = 0; j < 8; ++j) { const int r = 8 * cb + j, t = row0 + r, pos = pos0 + r;
                unpack8(un[j], uu);
                const float inv = 1.0f / (float)((pos + 1) < w ? (pos + 1) : w);
                float o[8];
#pragma unroll
                for (int q = 0; q < 8; ++q) { s[q] += uu[q]; o[q] = s[q] * inv - uu[q]; }
                v4u ww; ww.x = pk2(o[0], o[1]); ww.y = pk2(o[2], o[3]); ww.z = pk2(o[4], o[5]); ww.w = pk2(o[6], o[7]);
                *(v4u*)(PL + (size_t)t * D + col) = ww;
                unpack8(uo[j], uu);
#pragma unroll
                for (int q = 0; q < 8; ++q) s[q] -= uu[q]; }
        }
    }
}

__device__ __forceinline__ void phase_conv(const Frame& F, const bf16* UC, const bf16* BGp, const float* cw, bf16* Z) {
    for (int it = F.bid * 512 + F.tid; it < (T / 4) * 256; it += F.G * 512) {
        const int cv = it & 255, col = cv * 8, t0 = __builtin_amdgcn_readfirstlane((it >> 8) * 4), pos0 = t0 & (SEQ - 1);
        v4u ur[6], br[4];
#pragma unroll
        for (int j = 0; j < 6; ++j) { ur[j] = (v4u){0u, 0u, 0u, 0u}; if (j >= 2 || pos0 > 0) ur[j] = *(const v4u*)(UC + (size_t)(t0 - 2 + j) * D + col); }
#pragma unroll
        for (int j = 0; j < 4; ++j) br[j] = *(const v4u*)(BGp + (size_t)(t0 + j) * D + col);
        const f32x4 c0a = *(const f32x4*)(cw + col), c0b = *(const f32x4*)(cw + col + 4), c1a = *(const f32x4*)(cw + D + col), c1b = *(const f32x4*)(cw + D + col + 4), c2a = *(const f32x4*)(cw + 2 * D + col), c2b = *(const f32x4*)(cw + 2 * D + col + 4);
        asm volatile("" : "+v"(ur[0]), "+v"(ur[1]), "+v"(ur[2]), "+v"(ur[3]), "+v"(ur[4]), "+v"(ur[5]), "+v"(br[0]), "+v"(br[1]), "+v"(br[2]), "+v"(br[3]));
        const float c0[8] = {c0a[0], c0a[1], c0a[2], c0a[3], c0b[0], c0b[1], c0b[2], c0b[3]}, c1[8] = {c1a[0], c1a[1], c1a[2], c1a[3], c1b[0], c1b[1], c1b[2], c1b[3]}, c2[8] = {c2a[0], c2a[1], c2a[2], c2a[3], c2b[0], c2b[1], c2b[2], c2b[3]};
#pragma unroll
        for (int j = 0; j < 4; ++j) { float u0[8], u1[8], u2[8], bb[8], o[8];
            unpack8(ur[j], u0); unpack8(ur[j + 1], u1); unpack8(ur[j + 2], u2); unpack8(br[j], bb);
#pragma unroll
            for (int q = 0; q < 8; ++q) o[q] = bb[q] * (c0[q] * u0[q] + c1[q] * u1[q] + c2[q] * u2[q]);
            v4u ww; ww.x = pk2(o[0], o[1]); ww.y = pk2(o[2], o[3]); ww.z = pk2(o[4], o[5]); ww.w = pk2(o[6], o[7]);
            *(v4u*)(Z + (size_t)(t0 + j) * D + col) = ww; }
    }
}

__device__ __forceinline__ int t5_bucket(int dist) {
    if (dist < 16) return dist;
    int large = 16 + (int)(logf((float)dist / 16.0f) / logf(128.0f) * 16.0f);
    return large < 31 ? large : 31;
}
constexpr int AT_KS = 0, AT_KSTR = 144, AT_VT = 256 * 144, AT_VSTR = 520, AT_BIAS = AT_VT + 64 * 520;
__device__ __forceinline__ void phase_attn(const Frame& F, const bf16* QKV, const float* relb, bf16* OG, float* LSE) {
    LAS unsigned char* lds = F.lds;
    const int tid = F.tid, lane = F.lane, w = tid >> 6, fr = lane & 15, fq = lane >> 4;
    for (int unit = F.bid; unit < NBATCH * 3 * 8 * 16; unit += F.G) {
        const int cmb = unit & 15, h = (unit >> 4) & 7, g = (unit >> 7) % 3, b = unit / 384;
        const int dsh = 2 * g, dil = 1 << dsh, r = cmb & (dil - 1), nb = cmb >> dsh;
        const bf16* base = QKV + (size_t)b * SEQ * QKVC + g * 1536 + h * 64;
        __syncthreads();
        {
            const int key = tid >> 1, half = tid & 1, jk = (nb - 1) * 128 + key;
            v4u kv[4], vv[4];
            if (jk >= 0) { const bf16* rp = base + (size_t)(jk * dil + r) * QKVC + half * 32;
#pragma unroll
                for (int i = 0; i < 4; ++i) { kv[i] = *(const v4u*)(rp + 512 + 8 * i); vv[i] = *(const v4u*)(rp + 1024 + 8 * i); } }
            else {
#pragma unroll
                for (int i = 0; i < 4; ++i) { kv[i] = (v4u){0u, 0u, 0u, 0u}; vv[i] = (v4u){0u, 0u, 0u, 0u}; } }
#pragma unroll
            for (int i = 0; i < 4; ++i) *(LAS v4u*)(lds + AT_KS + key * AT_KSTR + half * 64 + 16 * i) = kv[i];
#pragma unroll
            for (int i = 0; i < 4; ++i) {
                const unsigned ww[4] = {vv[i].x, vv[i].y, vv[i].z, vv[i].w};
#pragma unroll
                for (int q = 0; q < 4; ++q) { const int d = half * 32 + 8 * i + 2 * q;
                    *(LAS unsigned short*)(lds + AT_VT + d * AT_VSTR + key * 2) = (unsigned short)(ww[q] & 0xffffu);
                    *(LAS unsigned short*)(lds + AT_VT + (d + 1) * AT_VSTR + key * 2) = (unsigned short)(ww[q] >> 16); } }
            if (tid <= 128) ((LAS float*)(lds + AT_BIAS))[tid] = relb[t5_bucket(tid * dil) * 24 + g * 8 + h];
        }
        __syncthreads();
        int qi = 16 * w + fr; asm volatile("" : "+v"(qi));
        const int jq = nb * 128 + qi, tq = jq * dil + r;
        const bf16* qp = base + (size_t)tq * QKVC + 8 * fq;
        const bf16x8 q0 = *(const bf16x8*)qp, q1 = *(const bf16x8*)(qp + 32);
        f32x4 s[9]; float mx = -INFINITY;
#pragma unroll
        for (int kt = 0; kt < 9; ++kt) {
            const int kb = 16 * (w + kt);
            const bf16x8 k0 = *(const LAS bf16x8*)(lds + AT_KS + (kb + fr) * AT_KSTR + fq * 16), k1 = *(const LAS bf16x8*)(lds + AT_KS + (kb + fr) * AT_KSTR + 64 + fq * 16);
            f32x4 a = (f32x4){0.f, 0.f, 0.f, 0.f};
            a = __builtin_amdgcn_mfma_f32_16x16x32_bf16(k0, q0, a, 0, 0, 0);
            a = __builtin_amdgcn_mfma_f32_16x16x32_bf16(k1, q1, a, 0, 0, 0);
#pragma unroll
            for (int i = 0; i < 4; ++i) { const int kl = kb + 4 * fq + i, rel = qi + 128 - kl;
                const bool ok = (rel >= 0) && (rel <= 128) && (nb > 0 || kl >= 128);
                const int rc = rel < 0 ? 0 : (rel > 128 ? 128 : rel);
                float bv_ = ((LAS float*)(lds + AT_BIAS))[rc]; asm volatile("" : "+v"(bv_));
                const float v = ok ? a[i] + bv_ : -INFINITY;
                a[i] = v; mx = fmaxf(mx, v); }
            s[kt] = a;
        }
        mx = max_fq(mx);
        float l = 0.f;
#pragma unroll
        for (int kt = 0; kt < 9; ++kt)
#pragma unroll
            for (int i = 0; i < 4; ++i) { const float p = __expf(s[kt][i] - mx); s[kt][i] = p; l += p; }
        l = sum_fq(l);
        f32x4 o[4];
#pragma unroll
        for (int nt = 0; nt < 4; ++nt) o[nt] = (f32x4){0.f, 0.f, 0.f, 0.f};
#pragma unroll
        for (int st = 0; st < 5; ++st) {
            const int kt0 = 2 * st, kt1 = 2 * st + 1;
            v4u pw; pw.x = pk2(s[kt0][0], s[kt0][1]); pw.y = pk2(s[kt0][2], s[kt0][3]);
            if (kt1 < 9) { pw.z = pk2(s[kt1 < 9 ? kt1 : 0][0], s[kt1 < 9 ? kt1 : 0][1]); pw.w = pk2(s[kt1 < 9 ? kt1 : 0][2], s[kt1 < 9 ? kt1 : 0][3]); } else { pw.z = 0u; pw.w = 0u; }
            const bf16x8 pf = __builtin_bit_cast(bf16x8, pw);
            const int kb0 = 16 * (w + kt0) + 4 * fq, kb1 = 16 * (w + kt1) + 4 * fq;
#pragma unroll
            for (int nt = 0; nt < 4; ++nt) { const int d = 16 * nt + fr;
                v2u va = *(const LAS v2u*)(lds + AT_VT + d * AT_VSTR + kb0 * 2), vb = (v2u){0u, 0u};
                if (kt1 < 9) vb = *(const LAS v2u*)(lds + AT_VT + d * AT_VSTR + kb1 * 2);
                v4u vw; vw.x = va.x; vw.y = va.y; vw.z = vb.x; vw.w = vb.y;
                o[nt] = __builtin_amdgcn_mfma_f32_16x16x32_bf16(__builtin_bit_cast(bf16x8, vw), pf, o[nt], 0, 0, 0); }
        }
        const float il = 1.0f / l;
        bf16* op = OG + ((size_t)g * T + (size_t)b * SEQ + tq) * DILW + h * 64 + 4 * fq;
#pragma unroll
        for (int nt = 0; nt < 4; ++nt) { v2u ww; ww.x = pk2(o[nt][0] * il, o[nt][1] * il); ww.y = pk2(o[nt][2] * il, o[nt][3] * il); *(v2u*)(op + 16 * nt) = ww; }
        if (fq == 0) LSE[((size_t)g * T + (size_t)b * SEQ + tq) * 8 + h] = mx + logf(l);
    }
}
__device__ __forceinline__ void phase_combine(const Frame& F, const bf16* OG, const float* LSE, bf16* O) {
    for (int it0 = F.bid * 512 + F.tid; it0 < T * 64; it0 += 4 * F.G * 512) {
        float ls[4][3]; v4u og[4][3];
#pragma unroll
        for (int u = 0; u < 4; ++u) { int it = it0 + u * F.G * 512; it = it < T * 64 ? it : it0;
            const int c8 = it & 7, h = (it >> 3) & 7, t = it >> 6; const size_t off = (size_t)t * DILW + h * 64 + c8 * 8;
#pragma unroll
            for (int g = 0; g < 3; ++g) { ls[u][g] = LSE[((size_t)g * T + t) * 8 + h]; og[u][g] = *(const v4u*)(OG + (size_t)g * T * DILW + off); } }
#pragma unroll
        for (int u = 0; u < 4; ++u) asm volatile("" : "+v"(ls[u][0]), "+v"(ls[u][1]), "+v"(ls[u][2]), "+v"(og[u][0]), "+v"(og[u][1]), "+v"(og[u][2]));
#pragma unroll
        for (int u = 0; u < 4; ++u) { const int it = it0 + u * F.G * 512, c8 = it & 7, h = (it >> 3) & 7, t = it >> 6; const size_t off = (size_t)t * DILW + h * 64 + c8 * 8;
            if (it >= T * 64) continue;
            const float l0 = ls[u][0], l1 = ls[u][1], l2 = ls[u][2];
            const float m = fmaxf(l0, fmaxf(l1, l2)); float w0 = __expf(l0 - m), w1 = __expf(l1 - m), w2 = __expf(l2 - m); const float inv = 1.0f / (w0 + w1 + w2); w0 *= inv; w1 *= inv; w2 *= inv;
            float a[8], bq[8], c[8], o[8];
            unpack8(og[u][0], a); unpack8(og[u][1], bq); unpack8(og[u][2], c);
#pragma unroll
            for (int q = 0; q < 8; ++q) o[q] = w0 * a[q] + w1 * bq[q] + w2 * c[q];
            v4u ww; ww.x = pk2(o[0], o[1]); ww.y = pk2(o[2], o[3]); ww.z = pk2(o[4], o[5]); ww.w = pk2(o[6], o[7]);
            *(v4u*)(O + off) = ww; }
    }
}

constexpr int M1_LOG = 131072, M1_STAT = M1_LOG + 4096, M1_HIST = M1_STAT + 128, M1_BASE = M1_HIST + 256;
__device__ __forceinline__ void phase_moe1(const Frame& F, const float* Y, const float* gain, const float* bias, const float* RW, const float* RB,
                                           float* X1F, bf16* X1B, unsigned* cnt, int* ltok, float* lgate, int* eidx, int* inv) {
    LAS float* xs = (LAS float*)F.lds; LAS float* logit = (LAS float*)(F.lds + M1_LOG); LAS float* stat = (LAS float*)(F.lds + M1_STAT);
    LAS int* hist = (LAS int*)(F.lds + M1_HIST); LAS int* basep = (LAS int*)(F.lds + M1_BASE);
    const int tid = F.tid, lane = F.lane, w = F.wave;
    for (int rg = F.bid; rg < T / 16; rg += F.G) {
        const int row0 = rg * 16;
        __syncthreads();
#pragma unroll
        for (int j = 0; j < 16; ++j) { const int idx = tid + 512 * j; *(LAS f32x4*)(xs + idx * 4) = *(const f32x4*)(Y + (size_t)row0 * D + (size_t)idx * 4); }
        if (tid < 64) hist[tid] = 0;
        __syncthreads();
#pragma unroll
        for (int rr = 0; rr < 2; ++rr) { const int r = 2 * w + rr; float sm = 0.f;
#pragma unroll
            for (int j = 0; j < 32; ++j) sm += xs[r * D + lane + 64 * j];
            const float mean = wave_sum(sm, lane) * (1.0f / D); float sq = 0.f;
#pragma unroll
            for (int j = 0; j < 32; ++j) { const float d = xs[r * D + lane + 64 * j] - mean; sq += d * d; }
            const float rstd = 1.0f / sqrtf(wave_sum(sq, lane) * (1.0f / D) + LN_EPS);
            if (lane == 0) { stat[2 * r] = mean; stat[2 * r + 1] = rstd; } }
        __syncthreads();
#pragma unroll
        for (int j = 0; j < 16; ++j) { const int idx = tid + 512 * j, r = idx >> 9, c4 = (idx & 511) * 4;
            const f32x4 v = *(LAS f32x4*)(xs + idx * 4), gv = *(const f32x4*)(gain + c4), bv = *(const f32x4*)(bias + c4);
            const float mean = stat[2 * r], rstd = stat[2 * r + 1];
            const f32x4 o = (v - mean) * rstd * gv + bv;
            *(LAS f32x4*)(xs + idx * 4) = o;
            *(f32x4*)(X1F + (size_t)(row0 + r) * D + c4) = o;
            v2u wb; wb.x = pk2(o[0], o[1]); wb.y = pk2(o[2], o[3]); *(v2u*)(X1B + (size_t)(row0 + r) * D + c4) = wb; }
        __syncthreads();
        { const int r = tid >> 5, ep = tid & 31; float a0 = 0.f, a1 = 0.f; const float* wp = RW + 2 * ep; const LAS float* xr = xs + r * D;
            for (int k0 = 0; k0 < D; k0 += 16) {
                f32x2 wv[16];
#pragma unroll
                for (int j = 0; j < 16; ++j) wv[j] = *(const f32x2*)(wp + (size_t)(k0 + j) * NEXP);
                asm volatile("" : "+v"(wv[0]), "+v"(wv[1]), "+v"(wv[2]), "+v"(wv[3]), "+v"(wv[4]), "+v"(wv[5]), "+v"(wv[6]), "+v"(wv[7]));
                asm volatile("" : "+v"(wv[8]), "+v"(wv[9]), "+v"(wv[10]), "+v"(wv[11]), "+v"(wv[12]), "+v"(wv[13]), "+v"(wv[14]), "+v"(wv[15]));
#pragma unroll
                for (int j = 0; j < 16; ++j) { const float xv = xr[k0 + j]; a0 += xv * wv[j].x; a1 += xv * wv[j].y; } }
            logit[r * NEXP + 2 * ep] = a0; logit[r * NEXP + 2 * ep + 1] = a1; }
        __syncthreads();
        int sel_pos[2]; float sel_gate[2]; int sel_rank[2]; bool sel_on[2];
#pragma unroll
        for (int rr = 0; rr < 2; ++rr) { const int r = 2 * w + rr;
            const float sc = 1.0f / (1.0f + __expf(-logit[r * NEXP + lane])); const float ch = sc + RB[lane];
            int rk = 0;
#pragma unroll
            for (int j = 0; j < 8; ++j) { const float cj = shfl_from(ch, (lane & ~7) + j); rk += (cj > ch || (cj == ch && j < (lane & 7))) ? 1 : 0; }
            float gs = rk < 2 ? ch : 0.f; gs += shfl_x(gs, 1, lane); gs += shfl_x(gs, 2, lane); gs += shfl_x(gs, 4, lane);
            int grk = 0; const int g = lane >> 3;
#pragma unroll
            for (int hh = 0; hh < 8; ++hh) { const float gh = shfl_from(gs, 8 * hh); grk += (gh > gs || (gh == gs && hh < g)) ? 1 : 0; }
            const float msk = grk < 4 ? ch : -INFINITY;
            int erk = 0;
            for (int j = 0; j < 64; ++j) { const float mj = __builtin_bit_cast(float, __builtin_amdgcn_readlane(__builtin_bit_cast(int, msk), j)); erk += (mj > msk || (mj == msk && j < lane)) ? 1 : 0; }
            const bool on = erk < 8;
            const float ssum = wave_sum(on ? sc : 0.f, lane);
            sel_on[rr] = on; sel_rank[rr] = erk; sel_gate[rr] = sc / ssum * 2.5f; sel_pos[rr] = 0;
            if (on) sel_pos[rr] = __hip_atomic_fetch_add(&hist[lane], 1, __ATOMIC_RELAXED, __HIP_MEMORY_SCOPE_WORKGROUP); }
        __syncthreads();
        if (tid < 64) { const int hc = hist[tid]; int bs = 0; if (hc > 0) bs = (int)atomicAdd(&cnt[tid * 16], (unsigned)hc); basep[tid] = bs; }
        __syncthreads();
#pragma unroll
        for (int rr = 0; rr < 2; ++rr) if (sel_on[rr]) { const int t = row0 + 2 * w + rr, pos = basep[lane] + sel_pos[rr];
            ltok[(size_t)lane * CAP + pos] = t; lgate[(size_t)lane * CAP + pos] = sel_gate[rr];
            eidx[t * 8 + sel_rank[rr]] = lane; inv[t * 8 + sel_rank[rr]] = pos; }
    }
}
__device__ __forceinline__ int build_tiles(const Frame& F, const unsigned* cnt) {
    LAS int* tpref = (LAS int*)(F.lds + LDS_TAB); LAS int* cl = (LAS int*)(F.lds + LDS_TAB + 512);
    __syncthreads();
    if (F.tid < 64) {
        const int lane = F.lane; const int c = (int)__hip_atomic_load(&cnt[lane * 16], __ATOMIC_RELAXED, __HIP_MEMORY_SCOPE_AGENT);
        const int tl = (c + 255) >> 8; int inc = tl;
#pragma unroll
        for (int o = 1; o < 64; o <<= 1) { const int v = __builtin_amdgcn_ds_bpermute((lane >= o ? lane - o : lane) << 2, inc); inc += lane >= o ? v : 0; }
        cl[lane] = c; tpref[lane] = inc - tl;
        if (lane == 63) { tpref[64] = inc; tpref[65] = inc + T / 256; tpref[66] = inc + 2 * (T / 256); cl[64] = T; cl[65] = T; } }
    __syncthreads();
    return __builtin_amdgcn_readfirstlane(tpref[64]);
}
__device__ __forceinline__ void phase_moe4(const Frame& F, const float* Y2, const bf16* Yr, const int* eidx, const int* inv, const float* gain, const float* bias, float* XO, bf16* XBo) {
    const LAS int* tpref = (const LAS int*)(F.lds + LDS_TAB);
    const int gw = F.bid * 8 + F.wave, NGW = F.G * 8, lane = F.lane;
    for (int t = gw; t < T; t += NGW) {
        f32x4 v[8];
#pragma unroll
        for (int j = 0; j < 8; ++j) v[j] = *(const f32x4*)(Y2 + (size_t)t * D + 4 * lane + 256 * j);
        for (int k = 0; k < 8; ++k) { const int e = eidx[t * 8 + k], pos = inv[t * 8 + k]; const bf16* yr = Yr + (size_t)(tpref[e] * 256 + pos) * D + 4 * lane;
#pragma unroll
            for (int j = 0; j < 8; ++j) { const v2u w = *(const v2u*)(yr + 256 * j); v[j][0] += bflo(w.x); v[j][1] += bfhi(w.x); v[j][2] += bflo(w.y); v[j][3] += bfhi(w.y); } }
        float sm = 0.f;
#pragma unroll
        for (int j = 0; j < 8; ++j) sm += (v[j][0] + v[j][1]) + (v[j][2] + v[j][3]);
        const float mean = wave_sum(sm, lane) * (1.0f / D); float sq = 0.f;
#pragma unroll
        for (int j = 0; j < 8; ++j) { v[j] = v[j] - mean; sq += (v[j][0] * v[j][0] + v[j][1] * v[j][1]) + (v[j][2] * v[j][2] + v[j][3] * v[j][3]); }
        const float rstd = 1.0f / sqrtf(wave_sum(sq, lane) * (1.0f / D) + LN_EPS);
#pragma unroll
        for (int j = 0; j < 8; ++j) { const int c = 4 * lane + 256 * j; const f32x4 o = v[j] * rstd * *(const f32x4*)(gain + c) + *(const f32x4*)(bias + c);
            *(f32x4*)(XO + (size_t)t * D + c) = o;
            v2u wb; wb.x = pk2(o[0], o[1]); wb.y = pk2(o[2], o[3]); *(v2u*)(XBo + (size_t)t * D + c) = wb; }
    }
}


template <int CTRL> __device__ __forceinline__ float dppf(float x) { return __builtin_bit_cast(float, __builtin_amdgcn_update_dpp(0, __builtin_bit_cast(int, x), CTRL, 0xF, 0xF, false)); }
__device__ __forceinline__ float gmax8(float x) { x = fmaxf(x, dppf<0xB1>(x)); x = fmaxf(x, dppf<0x4E>(x)); x = fmaxf(x, dppf<0x141>(x)); return x; }
__device__ __forceinline__ float gsum8(float x) { x += dppf<0xB1>(x); x += dppf<0x4E>(x); x += dppf<0x141>(x); return x; }
__device__ __forceinline__ float rl_f(float x, int l) { return __builtin_bit_cast(float, __builtin_amdgcn_readlane(__builtin_bit_cast(int, x), l)); }
constexpr int M1_P = 0, M1N_HIST = 131072, M1N_BASE = 131072 + 256, M1N_GB = 131072 + 1024;
__device__ __forceinline__ void phase_moe1n(const Frame& F, const bf16* Y, const float* pst, const float* gain, const float* bias, const bf16* WH, const bf16* WL, const float* RB,
                                            bf16* X1B, float* ST1, unsigned* cnt, int* ltok, float* lgate, int* eidx, int* inv) {
    LAS float* P = (LAS float*)(F.lds + M1_P); LAS int* hist = (LAS int*)(F.lds + M1N_HIST); LAS int* basep = (LAS int*)(F.lds + M1N_BASE);
    const int tid = F.tid, lane = F.lane, w = F.wave, r = lane & 15, q = lane >> 4;
    for (int item = F.bid; item < T / 64; item += F.G) {
        const int row0 = item * 64;
        __syncthreads();
        { int t0 = tid; asm volatile("" : "+v"(t0));
          if (t0 < 64) hist[t0] = 0;
          LAS f32x4* gb = (LAS f32x4*)(F.lds + M1N_GB); gb[t0] = *(const f32x4*)(gain + 4 * t0); gb[512 + t0] = *(const f32x4*)(bias + 4 * t0); }
        __syncthreads();
        float mean[4], rstd[4];
#pragma unroll
        for (int rt = 0; rt < 4; ++rt) { const int row = row0 + 16 * rt + r;
          const f32x4* pp = (const f32x4*)(pst + ((size_t)row * 32 + q * 8) * 2); const f32x4 a = pp[0], b = pp[1], c = pp[2], d = pp[3];
          float sm = (a[0] + a[2]) + (b[0] + b[2]) + (c[0] + c[2]) + (d[0] + d[2]), sq = (a[1] + a[3]) + (b[1] + b[3]) + (c[1] + c[3]) + (d[1] + d[3]);
          sm = sum_fq(sm); sq = sum_fq(sq);
          mean[rt] = sm * (1.0f / D); const float var = fmaxf(sq * (1.0f / D) - mean[rt] * mean[rt], 0.f); rstd[rt] = 1.0f / sqrtf(var + LN_EPS);
          if (w == 0 && q == 0) *(f32x2*)(ST1 + 2 * row) = (f32x2){mean[rt], rstd[rt]}; }
        const int kb = 256 * w + 8 * q;
        const LAS float* gl = (const LAS float*)(F.lds + M1N_GB) + kb;
        f32x4 acc[4][4];
#pragma unroll
        for (int rt = 0; rt < 4; ++rt)
#pragma unroll
            for (int nt = 0; nt < 4; ++nt) acc[rt][nt] = (f32x4){0.f, 0.f, 0.f, 0.f};
        v4u yb[2][2][4], hb[4]; bf16x8 wh[4], wl[4];
        unsigned vo[4];
#pragma unroll
        for (int i = 0; i < 4; ++i) { vo[i] = (unsigned)(r * D + kb) * 2u + (unsigned)i * (16u * D * 2u); asm volatile("" : "+v"(vo[i])); }
        const char* ybase = (const char*)(Y + (size_t)row0 * D); char* xbase = (char*)(X1B + (size_t)row0 * D);
#define M1_LOADY(ms) do { _Pragma("unroll") for (int hf = 0; hf < 2; ++hf) _Pragma("unroll") for (int rt = 0; rt < 4; ++rt) yb[(ms) & 1][hf][rt] = *(const v4u*)(ybase + vo[rt] + 128 * (ms) + 64 * hf); } while (0)
#define M1_LOADW(st) do { _Pragma("unroll") for (int nt = 0; nt < 4; ++nt) { wh[nt] = *(const bf16x8*)((const char*)WH + vo[nt] + 64 * (st)); wl[nt] = *(const bf16x8*)((const char*)WL + vo[nt] + 64 * (st)); } } while (0)
        M1_LOADY(0); M1_LOADW(0); M1_LOADY(1);
        __builtin_amdgcn_sched_barrier(0);
#pragma unroll
        for (int st = 0; st < 8; ++st) {
            const f32x4 g0 = *(const LAS f32x4*)(gl + 32 * st), g1 = *(const LAS f32x4*)(gl + 32 * st + 4), b0 = *(const LAS f32x4*)(gl + 2048 + 32 * st), b1 = *(const LAS f32x4*)(gl + 2048 + 32 * st + 4);
#pragma unroll
            for (int rt = 0; rt < 4; ++rt) { const v4u yv = yb[(st >> 1) & 1][st & 1][rt];
                const f32x4 y0_ = (f32x4){bflo(yv.x), bfhi(yv.x), bflo(yv.y), bfhi(yv.y)}, y1_ = (f32x4){bflo(yv.z), bfhi(yv.z), bflo(yv.w), bfhi(yv.w)};
                const f32x4 x0 = (y0_ - mean[rt]) * rstd[rt] * g0 + b0, x1 = (y1_ - mean[rt]) * rstd[rt] * g1 + b1;
                v4u h; h.x = cvt_pk_bf16(x0[0], x0[1]); h.y = cvt_pk_bf16(x0[2], x0[3]); h.z = cvt_pk_bf16(x1[0], x1[1]); h.w = cvt_pk_bf16(x1[2], x1[3]);
                if ((st & 1) == 0) hb[rt] = h; else { *(v4u*)(xbase + vo[rt] + 64 * (st - 1)) = hb[rt]; *(v4u*)(xbase + vo[rt] + 64 * st) = h; }
                v4u l; l.x = cvt_pk_bf16(x0[0] - bflo(h.x), x0[1] - bfhi(h.x)); l.y = cvt_pk_bf16(x0[2] - bflo(h.y), x0[3] - bfhi(h.y));
                l.z = cvt_pk_bf16(x1[0] - bflo(h.z), x1[1] - bfhi(h.z)); l.w = cvt_pk_bf16(x1[2] - bflo(h.w), x1[3] - bfhi(h.w));
                const bf16x8 xh = __builtin_bit_cast(bf16x8, h), xl = __builtin_bit_cast(bf16x8, l);
#pragma unroll
                for (int nt = 0; nt < 4; ++nt) { acc[rt][nt] = __builtin_amdgcn_mfma_f32_16x16x32_bf16(xh, wh[nt], acc[rt][nt], 0, 0, 0);
                    acc[rt][nt] = __builtin_amdgcn_mfma_f32_16x16x32_bf16(xl, wh[nt], acc[rt][nt], 0, 0, 0); acc[rt][nt] = __builtin_amdgcn_mfma_f32_16x16x32_bf16(xh, wl[nt], acc[rt][nt], 0, 0, 0); } }
            __builtin_amdgcn_sched_barrier(0);
            if (st + 1 < 8) M1_LOADW(st + 1);
            if ((st & 1) == 1 && (st >> 1) + 2 < 4) M1_LOADY((st >> 1) + 2);
            __builtin_amdgcn_sched_barrier(0);
        }
#undef M1_LOADY
#undef M1_LOADW
#pragma unroll
        for (int rt = 0; rt < 4; ++rt)
#pragma unroll
            for (int nt = 0; nt < 4; ++nt)
#pragma unroll
                for (int i = 0; i < 4; ++i) P[(w * 64 + 16 * rt + 4 * q + i) * 64 + 16 * nt + r] = acc[rt][nt][i];
        __syncthreads();
        const float rb = RB[lane];
        LAS int* Pi = (LAS int*)P;
#pragma unroll 1
        for (int rr = 0; rr < 8; ++rr) { const int rl = 8 * w + rr;
            float lg = ((P[rl * 64 + lane] + P[(64 + rl) * 64 + lane]) + (P[(128 + rl) * 64 + lane] + P[(192 + rl) * 64 + lane])) + ((P[(256 + rl) * 64 + lane] + P[(320 + rl) * 64 + lane]) + (P[(384 + rl) * 64 + lane] + P[(448 + rl) * 64 + lane]));
            lg = (lg == lg) ? lg : -1.0e30f;
            const float sc = 1.0f / (1.0f + __expf(-lg)); const float ch = sc + rb;
            const float m1 = gmax8(ch), neq = gsum8(ch == m1 ? 1.f : 0.f), m2c = gmax8(ch < m1 ? ch : -INFINITY);
            const float gs = m1 + (neq >= 2.f ? m1 : m2c);
            int grk = 0; const int g = lane >> 3;
#pragma unroll
            for (int hh = 0; hh < 8; ++hh) { const float gh = rl_f(gs, 8 * hh); grk += (gh > gs || (gh == gs && hh < g)) ? 1 : 0; }
            const float msk = grk < 4 ? ch : -INFINITY;
            float cur = msk, ssum = 0.f; int erk = 64;
#pragma unroll 1
            for (int k = 0; k < 8; ++k) {
                float rm = gmax8(cur); rm = fmaxf(rm, dppf<0x140>(rm));
                const float wm = fmaxf(fmaxf(rl_f(rm, 0), rl_f(rm, 16)), fmaxf(rl_f(rm, 32), rl_f(rm, 48)));
                const unsigned long long bal = __builtin_amdgcn_ballot_w64(cur == wm);
                const int lsel = __builtin_amdgcn_readfirstlane((int)__builtin_ctzll(bal));
                ssum += rl_f(sc, lsel);
                const bool me = lane == lsel; erk = me ? k : erk; cur = me ? -INFINITY : cur; }
            const bool on = erk < 8;
            int pk_ = -1; if (on) pk_ = __hip_atomic_fetch_add(&hist[lane], 1, __ATOMIC_RELAXED, __HIP_MEMORY_SCOPE_WORKGROUP) | (erk << 16);
            P[rl * 64 + lane] = sc / ssum * 2.5f; Pi[(64 + rl) * 64 + lane] = pk_; }
        __syncthreads();
        if (tid < 64) { int tt = tid; asm volatile("" : "+v"(tt));
            const int hc = hist[tt]; int bs = 0; if (hc > 0) bs = (int)atomicAdd(&cnt[tt * 16], (unsigned)hc); basep[tt] = bs; }
        __syncthreads();
        { const int bl = basep[lane];
#pragma unroll 1
          for (int rr = 0; rr < 8; ++rr) { const int rl = 8 * w + rr; const int pk_ = Pi[(64 + rl) * 64 + lane]; const float gt_ = P[rl * 64 + lane];
            if (pk_ >= 0) { const int t = row0 + rl, pos = bl + (pk_ & 0xffff), rk_ = pk_ >> 16;
                ltok[(size_t)lane * CAP + pos] = t * 8 + rk_; lgate[(size_t)lane * CAP + pos] = gt_;
                eidx[t * 8 + rk_] = lane; inv[t * 8 + rk_] = pos; } } }
    }
}

constexpr int M3_PL = 131072, M3_CNT = 147456, M3_OFF = 147456 + 272;
__device__ __forceinline__ void phase_moe3n(const Frame& F, const bf16* H, const bf16* HSp, const int* eidx, const bf16* WD, const bf16* WSD,
                                            const float* Y1, const float* ST1, const float* g1, const float* b1, float* Y2, float* PST2) {
    LAS int* out = (LAS int*)F.lds; LAS unsigned short* plist = (LAS unsigned short*)(F.lds + M3_PL); LAS int* cnt = (LAS int*)(F.lds + M3_CNT); LAS int* off = (LAS int*)(F.lds + M3_OFF);
    const int tid = F.tid, lane = F.lane, w = F.wave, r = lane & 15, q = lane >> 4;
    for (int u = F.bid; u < 1024; u += F.G) {
        int nc = (u & 7) | ((u >> 7) << 3), tb = (u >> 3) & 15;
        if (F.G == 256) { const int i = u >> 8, x = u & 7, j = (u >> 3) & 31; tb = 2 * x + (i >> 1); nc = 32 * (i & 1) + j; }
        __syncthreads();
#pragma unroll
        for (int j = 0; j < 16; ++j) ((LAS v4u*)out)[tid + 512 * j] = (v4u){0u, 0u, 0u, 0u};
        if (tid < 66) cnt[tid] = 0;
        __syncthreads();
        int ee[16], pp[16];
        { const v4u* ep = (const v4u*)(eidx + ((size_t)tb * 1024 + 2 * tid) * 8); const v4u e0 = ep[0], e1 = ep[1], e2 = ep[2], e3 = ep[3];
          ee[0] = e0.x; ee[1] = e0.y; ee[2] = e0.z; ee[3] = e0.w; ee[4] = e1.x; ee[5] = e1.y; ee[6] = e1.z; ee[7] = e1.w;
          ee[8] = e2.x; ee[9] = e2.y; ee[10] = e2.z; ee[11] = e2.w; ee[12] = e3.x; ee[13] = e3.y; ee[14] = e3.z; ee[15] = e3.w; }
#pragma unroll
        for (int j = 0; j < 16; ++j) pp[j] = __hip_atomic_fetch_add(&cnt[ee[j]], 1, __ATOMIC_RELAXED, __HIP_MEMORY_SCOPE_WORKGROUP);
        __syncthreads();
        if (w == 0) { int c = cnt[lane], x = c;
#pragma unroll
            for (int o = 1; o < 64; o <<= 1) { const int y = __builtin_amdgcn_ds_bpermute(((lane - o) & 63) << 2, x); if (lane >= o) x += y; }
            off[lane] = x - c; if (lane == 63) off[64] = x; }
        __syncthreads();
#pragma unroll
        for (int j = 0; j < 16; ++j) plist[off[ee[j]] + pp[j]] = (unsigned short)(tid * 16 + j);
        __syncthreads();
        const char* Hb = (const char*)H + (size_t)tb * 8192 * 256 + q * 16;
        const char* HSb = (const char*)HSp + (size_t)tb * 1024 * 512 + q * 16;
        const char* Bb = (const char*)WD + ((size_t)nc * 32 + r) * 256 + q * 16;
        const char* BSb = (const char*)WSD + ((size_t)nc * 32 + r) * 512 + q * 16;
#define M3_NR(sg) ((sg) < 8 ? __builtin_amdgcn_readfirstlane(cnt[w + 8 * (sg)]) : 128)
#define M3_RB(sg) ((sg) < 8 ? __builtin_amdgcn_readfirstlane(off[w + 8 * (sg)]) : 0)
#define M3_GLD(dst, ptr, OFF) asm volatile("global_load_dwordx4 %0, %1, off offset:" #OFF : "=&v"(dst) : "v"(ptr) : "memory")
#define M3_LOADB(dst, sg) do { const char* _b0 = (sg) < 8 ? Bb + (size_t)(w + 8 * (sg)) * 524288 : BSb + ((sg) - 8) * 256; const char* _b1 = _b0 + ((sg) < 8 ? 4096 : 8192); \
            M3_GLD(dst[0][0], _b0, 0); M3_GLD(dst[0][1], _b0, 64); M3_GLD(dst[0][2], _b0, 128); M3_GLD(dst[0][3], _b0, 192); \
            M3_GLD(dst[1][0], _b1, 0); M3_GLD(dst[1][1], _b1, 64); M3_GLD(dst[1][2], _b1, 128); M3_GLD(dst[1][3], _b1, 192); } while (0)
#define M3_LOADA(dst, sg, bb, nr, rbs) do { int _i = 16 * (bb) + r; _i = _i < (nr) ? _i : (nr) - 1; const unsigned _rid = plist[(rbs) + _i]; \
            const char* _a = (sg) < 8 ? Hb + (size_t)_rid * 256 : ((sg) < 10 ? HSb + (size_t)(128 * w + _i) * 512 + ((sg) - 8) * 256 : Hb); \
            M3_GLD(dst[0], _a, 0); M3_GLD(dst[1], _a, 64); M3_GLD(dst[2], _a, 128); M3_GLD(dst[3], _a, 192); } while (0)
#define M3_ADV(sg, bb, nr, rbs) do { if ((sg) < 10) { ++(bb); if ((bb) * 16 >= (nr)) { (bb) = 0; do { ++(sg); } while ((sg) < 8 && M3_NR(sg) == 0); if ((sg) < 10) { (nr) = M3_NR(sg); (rbs) = M3_RB(sg); } } } } while (0)
#define M3_WAITA(AS) asm volatile("s_waitcnt vmcnt(12)" : "+v"(AS[0]), "+v"(AS[1]), "+v"(AS[2]), "+v"(AS[3]) :: "memory")
#define M3_WAITB(N) asm volatile("s_waitcnt vmcnt(" #N ")" : "+v"(Bn[0][0]), "+v"(Bn[0][1]), "+v"(Bn[0][2]), "+v"(Bn[0][3]), "+v"(Bn[1][0]), "+v"(Bn[1][1]), "+v"(Bn[1][2]), "+v"(Bn[1][3]) :: "memory")
#define M3_STEP(AS) if (cseg < 10) { \
              \
            int tk[4]; bool ok[4]; unsigned pl[4]; const int rt_ = cseg < 8; \
            _Pragma("unroll") for (int i = 0; i < 4; ++i) { const int idx = 16 * cbt + 4 * q + i; ok[i] = idx < cnr; const int ic = ok[i] ? idx : cnr - 1; pl[i] = plist[crbs + ic]; tk[i] = 128 * w + ic; } \
            _Pragma("unroll") for (int i = 0; i < 4; ++i) tk[i] = rt_ ? (int)(pl[i] >> 3) : tk[i]; \
            M3_WAITA(AS); \
            f32x4 acc[2]; \
            _Pragma("unroll") for (int nt = 0; nt < 2; ++nt) { acc[nt] = (f32x4){0.f, 0.f, 0.f, 0.f}; \
                _Pragma("unroll") for (int kk = 0; kk < 4; ++kk) acc[nt] = __builtin_amdgcn_mfma_f32_16x16x32_bf16(__builtin_bit_cast(bf16x8, AS[kk]), __builtin_bit_cast(bf16x8, Bc[nt][kk]), acc[nt], 0, 0, 0); } \
              \
            _Pragma("unroll") for (int i = 0; i < 4; ++i) { const long long lo_ = ok[i] ? (long long)__float2int_rn(acc[0][i] * 4194304.0f) : 0ll, hi_ = ok[i] ? (long long)__float2int_rn(acc[1][i] * 4194304.0f) : 0ll; \
                (void)__hip_atomic_fetch_add((LAS unsigned long long*)out + tk[i] * 16 + r, (unsigned long long)((hi_ << 32) + lo_), __ATOMIC_RELAXED, __HIP_MEMORY_SCOPE_WORKGROUP); } \
            M3_LOADA(AS, pseg, pbt, pnr, prbs); M3_ADV(pseg, pbt, pnr, prbs); \
            { const int old_ = cseg, nbat_ = (cnr + 15) >> 4; M3_ADV(cseg, cbt, cnr, crbs); \
              if (cseg != old_ && cseg < 10) { \
                  if (nbat_ == 1) M3_WAITB(4); else if (nbat_ == 2) M3_WAITB(8); else if (nbat_ == 3) M3_WAITB(12); else M3_WAITB(16); \
                  _Pragma("unroll") for (int nt = 0; nt < 2; ++nt) _Pragma("unroll") for (int kk = 0; kk < 4; ++kk) Bc[nt][kk] = Bn[nt][kk]; \
                  int nb_ = cseg; do { ++nb_; } while (nb_ < 8 && M3_NR(nb_) == 0); if (nb_ >= 10) nb_ = 9; M3_LOADB(Bn, nb_); } } }
        int cseg = -1, cbt = 0, cnr = 0, crbs = 0;
        do { ++cseg; } while (cseg < 8 && M3_NR(cseg) == 0);
        cnr = M3_NR(cseg); crbs = M3_RB(cseg);
        int pseg = cseg, pbt = 0, pnr = cnr, prbs = crbs;
        v4u Bc[2][4], Bn[2][4], A0[4], A1[4], A2[4], A3[4];
        M3_LOADB(Bc, cseg);
        M3_LOADA(A0, pseg, pbt, pnr, prbs); M3_ADV(pseg, pbt, pnr, prbs);
        M3_LOADA(A1, pseg, pbt, pnr, prbs); M3_ADV(pseg, pbt, pnr, prbs);
        M3_LOADA(A2, pseg, pbt, pnr, prbs); M3_ADV(pseg, pbt, pnr, prbs);
        M3_LOADA(A3, pseg, pbt, pnr, prbs); M3_ADV(pseg, pbt, pnr, prbs);
        { int nb_ = cseg; do { ++nb_; } while (nb_ < 8 && M3_NR(nb_) == 0); if (nb_ >= 10) nb_ = 9; M3_LOADB(Bn, nb_); }
        asm volatile("s_waitcnt vmcnt(0)" : "+v"(Bc[0][0]), "+v"(Bc[0][1]), "+v"(Bc[0][2]), "+v"(Bc[0][3]), "+v"(Bc[1][0]), "+v"(Bc[1][1]), "+v"(Bc[1][2]), "+v"(Bc[1][3]) :: "memory");
#pragma unroll 1
        while (cseg < 10) { M3_STEP(A0) M3_STEP(A1) M3_STEP(A2) M3_STEP(A3) }
        asm volatile("s_waitcnt vmcnt(0)" : "+v"(A0[0]), "+v"(A0[1]), "+v"(A0[2]), "+v"(A0[3]), "+v"(A1[0]), "+v"(A1[1]), "+v"(A1[2]), "+v"(A1[3]), "+v"(A2[0]), "+v"(A2[1]), "+v"(A2[2]), "+v"(A2[3]),
                     "+v"(A3[0]), "+v"(A3[1]), "+v"(A3[2]), "+v"(A3[3]), "+v"(Bn[0][0]), "+v"(Bn[0][1]), "+v"(Bn[0][2]), "+v"(Bn[0][3]), "+v"(Bn[1][0]), "+v"(Bn[1][1]), "+v"(Bn[1][2]), "+v"(Bn[1][3]) :: "memory");
#undef M3_NR
#undef M3_RB
#undef M3_GLD
#undef M3_LOADB
#undef M3_LOADA
#undef M3_ADV
#undef M3_WAITA
#undef M3_WAITB
#undef M3_STEP
        __syncthreads();
        { const int c4 = lane & 7, rs = lane >> 3, col = nc * 32 + 4 * c4;
          const f32x4 gv = *(const f32x4*)(g1 + col), bv = *(const f32x4*)(b1 + col);
#pragma unroll 4
          for (int it = 0; it < 16; ++it) { const int rl = 128 * w + 8 * it + rs; const size_t row = (size_t)tb * 1024 + rl;
              const f32x4 yv = *(const f32x4*)(Y1 + row * D + col); const f32x2 sv = *(const f32x2*)(ST1 + 2 * row);
              f32x4 tv; { const int nt = c4 >> 2, r0 = (4 * c4) & 15;
#pragma unroll
                  for (int j = 0; j < 4; ++j) { const v2u cell = *(const LAS v2u*)(out + rl * 32 + 2 * (r0 + j)); const int lo = (int)cell.x, hi = (int)cell.y + (lo < 0 ? 1 : 0); tv[j] = (float)(nt ? hi : lo) * (1.0f / 4194304.0f); } }
              const f32x4 y = ((yv - sv.x) * sv.y * gv + bv) * ALPHA + tv;
              *(f32x4*)(Y2 + row * D + col) = y;
              float sm = (y[0] + y[1]) + (y[2] + y[3]), sq = (y[0] * y[0] + y[1] * y[1]) + (y[2] * y[2] + y[3] * y[3]);
#pragma unroll
              for (int o = 1; o < 8; o <<= 1) { sm += shfl_x(sm, o, lane); sq += shfl_x(sq, o, lane); }
              if (c4 == 0) *(f32x2*)(PST2 + (row * 64 + nc) * 2) = (f32x2){sm, sq}; } }
    }
}

__device__ __forceinline__ void phase_moe4n(const Frame& F, const float* Y2, const float* pst, const float* gain, const float* bias, float* ST2, bf16* XBo, float* OUT, int last) {
    const int gw = F.bid * 8 + F.wave, NGW = F.G * 8, lane = F.lane;
    for (int t = gw; t < T; t += NGW) {
        f32x4 v[8];
#pragma unroll
        for (int j = 0; j < 8; ++j) v[j] = *(const f32x4*)(Y2 + (size_t)t * D + 4 * lane + 256 * j);
        const f32x2 pv = *(const f32x2*)(pst + ((size_t)t * 64 + lane) * 2);
        const float mean = wave_sum(pv.x, lane) * (1.0f / D); const float var = fmaxf(wave_sum(pv.y, lane) * (1.0f / D) - mean * mean, 0.f); const float rstd = 1.0f / sqrtf(var + LN_EPS);
        if (lane == 0) *(f32x2*)(ST2 + 2 * (size_t)t) = (f32x2){mean, rstd};
#pragma unroll
        for (int j = 0; j < 8; ++j) { const int c = 4 * lane + 256 * j; const f32x4 o = (v[j] - mean) * rstd * *(const f32x4*)(gain + c) + *(const f32x4*)(bias + c);
            if (last) *(f32x4*)(OUT + (size_t)t * D + c) = o;
            else { v2u wb; wb.x = pk2(o[0], o[1]); wb.y = pk2(o[2], o[3]); *(v2u*)(XBo + (size_t)t * D + c) = wb; } }
    }
}


__device__ __forceinline__ void phase_moe4q(const Frame& F, const bf16* X1, bf16* Y2, const unsigned char* Yq, const float* Ysc, const int* eidx, const int* inv, const float* gain, const float* bias, float* ST2, bf16* XBo, float* OUT, int last) {
    const LAS int* tpref = (const LAS int*)(F.lds + LDS_TAB);
    const int gw = F.bid * 8 + F.wave, NGW = F.G * 8, lane = F.lane;
    { LAS f32x4* gb = (LAS f32x4*)(F.lds + 0); int t0 = F.tid; asm volatile("" : "+v"(t0)); gb[t0] = *(const f32x4*)(gain + 4 * t0); gb[512 + t0] = *(const f32x4*)(bias + 4 * t0); }
    __syncthreads();
    const LAS float* gl = (const LAS float*)(F.lds + 0);
    int en = 0, pn = 0; if (lane < 8 && gw < T) { en = eidx[gw * 8 + lane]; pn = inv[gw * 8 + lane]; }
    for (int t = gw; t < T; t += NGW) {
        int rowi = 0; if (lane < 8) rowi = tpref[en] * 256 + pn; else if (lane < 10) rowi = tpref[56 + lane] * 256 + t;
        if (lane < 8 && t + NGW < T) { en = eidx[(t + NGW) * 8 + lane]; pn = inv[(t + NGW) * 8 + lane]; }
        v4u pv[2][2], yv[10][2]; float sc[10][2];
#pragma unroll
        for (int j = 0; j < 2; ++j) { pv[j][0] = __builtin_nontemporal_load((const v4u*)(X1 + (size_t)t * D + 16 * lane + 1024 * j)); pv[j][1] = __builtin_nontemporal_load((const v4u*)(X1 + (size_t)t * D + 16 * lane + 1024 * j + 8)); }
#pragma unroll
        for (int k = 0; k < 10; ++k) { const size_t row = (size_t)__builtin_amdgcn_readlane(rowi, k);
#pragma unroll
            for (int j = 0; j < 2; ++j) yv[k][j] = __builtin_nontemporal_load((const v4u*)(Yq + row * D + 16 * lane + 1024 * j));
            sc[k][0] = __builtin_nontemporal_load(Ysc + row * 16 + (lane & 15)); }
#pragma unroll
        for (int k = 0; k < 10; ++k) asm volatile("" : "+v"(yv[k][0]), "+v"(yv[k][1]), "+v"(sc[k][0]));
#pragma unroll
        for (int k = 0; k < 10; ++k) { const float all = sc[k][0];
            sc[k][1] = __builtin_bit_cast(float, __builtin_amdgcn_ds_bpermute((8 + (lane >> 3)) << 2, __builtin_bit_cast(int, all)));
            sc[k][0] = __builtin_bit_cast(float, __builtin_amdgcn_ds_bpermute((lane >> 3) << 2, __builtin_bit_cast(int, all))); }
        float v[2][16];
#pragma unroll
        for (int j = 0; j < 2; ++j) { float f0[8], f1[8]; unpack8(pv[j][0], f0); unpack8(pv[j][1], f1);
            const float ss = (((sc[0][j] + sc[1][j]) + (sc[2][j] + sc[3][j])) + ((sc[4][j] + sc[5][j]) + (sc[6][j] + sc[7][j]))) + (sc[8][j] + sc[9][j]);
#pragma unroll
            for (int i = 0; i < 8; ++i) { v[j][i] = ALPHA * f0[i] - 128.f * ss; v[j][8 + i] = ALPHA * f1[i] - 128.f * ss; } }
#pragma unroll
        for (int k = 0; k < 10; ++k)
#pragma unroll
            for (int j = 0; j < 2; ++j) { const float s_ = sc[k][j]; const unsigned q[4] = {yv[k][j].x, yv[k][j].y, yv[k][j].z, yv[k][j].w};
#pragma unroll
                for (int d = 0; d < 4; ++d) { v[j][4 * d + 0] += s_ * (float)(q[d] & 0xffu); v[j][4 * d + 1] += s_ * (float)((q[d] >> 8) & 0xffu); v[j][4 * d + 2] += s_ * (float)((q[d] >> 16) & 0xffu); v[j][4 * d + 3] += s_ * (float)(q[d] >> 24); } }
        float sm = 0.f;
#pragma unroll
        for (int j = 0; j < 2; ++j)
#pragma unroll
            for (int i = 0; i < 16; i += 4) sm += (v[j][i] + v[j][i + 1]) + (v[j][i + 2] + v[j][i + 3]);
        const float mean = wave_sum(sm, lane) * (1.0f / D); float sq = 0.f;
#pragma unroll
        for (int j = 0; j < 2; ++j)
#pragma unroll
            for (int i = 0; i < 16; ++i) { const float d = v[j][i] - mean; sq += d * d; }
        const float rstd = 1.0f / sqrtf(wave_sum(sq, lane) * (1.0f / D) + LN_EPS);
        (void)ST2; (void)Y2;
#pragma unroll
        for (int j = 0; j < 2; ++j)
#pragma unroll
            for (int h = 0; h < 2; ++h) { const int c = 16 * lane + 1024 * j + 8 * h; const float* vv = &v[j][8 * h];
                const f32x4 g0 = *(const LAS f32x4*)(gl + c), g1 = *(const LAS f32x4*)(gl + c + 4), b0 = *(const LAS f32x4*)(gl + 2048 + c), b1 = *(const LAS f32x4*)(gl + 2048 + c + 4);
                const f32x4 o0 = ((f32x4){vv[0], vv[1], vv[2], vv[3]} - mean) * rstd * g0 + b0, o1 = ((f32x4){vv[4], vv[5], vv[6], vv[7]} - mean) * rstd * g1 + b1;
                if (last) { *(f32x4*)(OUT + (size_t)t * D + c) = o0; *(f32x4*)(OUT + (size_t)t * D + c + 4) = o1; }
                else { v4u wb; wb.x = pk2(o0[0], o0[1]); wb.y = pk2(o0[2], o0[3]); wb.z = pk2(o1[0], o1[1]); wb.w = pk2(o1[2], o1[3]); *(v4u*)(XBo + (size_t)t * D + c) = wb; } }
    }
}

__device__ __forceinline__ void phase_downproj3(const Frame& F, const bf16* H, const bf16* WD, const bf16* HSp, const bf16* WSD, unsigned char* Yq, float* Ysc, int NT) {
    const LAS int* tpref = (const LAS int*)(F.lds + LDS_TAB); const LAS int* cl = (const LAS int*)(F.lds + LDS_TAB + 512);
    LAS unsigned char* lds = F.lds;
    const int tid = F.tid, lane = F.lane, w = F.wave, fr = lane & 15, fq = lane >> 4;
    unsigned rbB[2], cbB[2];
#pragma unroll
    for (int i = 0; i < 2; ++i) { int R_, C_; g8::stage_rc(tid * 16 + i * 8192, R_, C_); rbB[i] = (unsigned)((R_ & ~31) + g8::perm32(R_ & 31)); cbB[i] = (unsigned)C_ * 2u; }
    const unsigned ldsw = (unsigned)w * 1024u, lbase = (unsigned)(size_t)lds;
    int boffg[4];
#pragma unroll
    for (int g = 0; g < 4; ++g) boffg[g] = g8::lds_byte(32 * g + fr, fq * 8);
    LAS unsigned char* stg = lds + 65536 + w * (32 * 144);
    const int NU = NT * 4;
    const int upos = (F.G % 8) == 0 ? (F.bid & 7) * (F.G >> 3) + (F.bid >> 3) : F.bid;
    int ub = 0;
    int u = (F.G <= NU) ? upos : F.bid; if (u >= NU) return;
#define DP3_UNITINFO(uu, E0, EXP, NV) do { const int tl_ = (uu) >> 2; int e_ = (E0); while (__builtin_amdgcn_readfirstlane(tpref[e_ + 1]) <= tl_) ++e_; EXP = e_; \
        NV = __builtin_amdgcn_readfirstlane(cl[e_]) - (tl_ - __builtin_amdgcn_readfirstlane(tpref[e_])) * 256; } while (0)
#define DP3_GLDS(gsrc, ldsdst) do { unsigned keep_; asm volatile("s_mov_b32 %0, m0\n\ts_mov_b32 m0, %2\n\ts_nop 0\n\tglobal_load_lds_dwordx4 %1, off\n\ts_mov_b32 m0, %0" : "=&s"(keep_) : "v"(gsrc), "s"(ldsdst) : "memory"); } while (0)
#define DP3_STAGE(slot, gb, bs) do { const unsigned v0_ = rbB[0] * (unsigned)(bs) + cbB[0], v1_ = rbB[1] * (unsigned)(bs) + cbB[1]; _Pragma("unroll") for (int kt = 0; kt < 2; ++kt) { \
        DP3_GLDS((const void*)((gb) + kt * 128 + v0_), lbase + (unsigned)((slot) * 32768 + kt * 16384) + ldsw); \
        DP3_GLDS((const void*)((gb) + kt * 128 + v1_), lbase + (unsigned)((slot) * 32768 + kt * 16384) + ldsw + 8192u); } } while (0)
#define DP3_SRC(uu, ee, AB, AS, BB, BS) do { const int tl_ = (uu) >> 2, cu_ = ((uu) & 3) * 512; \
        if ((ee) < 64) { AB = (const char*)(H + (size_t)tl_ * 256 * EDIM); AS = EDIM * 2; BB = (const char*)(WD + (size_t)(ee) * D * EDIM + (size_t)cu_ * EDIM); BS = EDIM * 2; } \
        else { const int t0_ = (tl_ - __builtin_amdgcn_readfirstlane(tpref[ee])) * 256; AB = (const char*)(HSp + (size_t)t0_ * SDIM + ((ee) - 64) * EDIM); AS = SDIM * 2; \
               BB = (const char*)(WSD + (size_t)cu_ * SDIM + ((ee) - 64) * EDIM); BS = SDIM * 2; } } while (0)
    int ecur, nvcur; DP3_UNITINFO(u, 0, ecur, nvcur);
    const char* abc; const char* gbc; int asc, bsc; DP3_SRC(u, ecur, abc, asc, gbc, bsc);
    bf16x8 A[2][4], An[2][4];
    { const char* ap_ = abc + (size_t)(32 * w + fr) * asc + 16 * fq;
#pragma unroll
      for (int m = 0; m < 2; ++m)
#pragma unroll
          for (int kk = 0; kk < 4; ++kk) A[m][kk] = *(const bf16x8*)(ap_ + (size_t)m * 16 * asc + 64 * kk); }
    DP3_STAGE(0, gbc, bsc);
    asm volatile("s_waitcnt vmcnt(0)" ::: "memory");
#pragma unroll 1
    for (;;) {
        int un = u; { const int nb = ub + F.G; if (nb + F.G <= NU) un = nb + upos; else if (nb + F.bid < NU) un = nb + F.bid; if (un != u) ub = nb; }
        int enx, nvnx; DP3_UNITINFO(un, (un > u ? ecur : 0), enx, nvnx);
        const char* abn; const char* gbn; int asn, bsn; DP3_SRC(un, enx, abn, asn, gbn, bsn);
        const int tile = u >> 2, colu = (u & 3) * 512;
        float scq[2][4];
#pragma unroll
        for (int c = 0; c < 4; ++c) {
            if (c == 0) asm volatile("s_waitcnt vmcnt(5)" ::: "memory"); else asm volatile("s_waitcnt vmcnt(4)" ::: "memory");
            __builtin_amdgcn_s_barrier();
            if (c == 3) { const char* ap_ = abn + (size_t)(32 * w + fr) * asn + 16 * fq;
#pragma unroll
                for (int m = 0; m < 2; ++m) { const char* am_ = ap_ + (size_t)m * 16 * asn;
                    asm volatile("global_load_dwordx4 %0, %1, off" : "=&v"(An[m][0]) : "v"(am_) : "memory"); asm volatile("global_load_dwordx4 %0, %1, off offset:64" : "=&v"(An[m][1]) : "v"(am_) : "memory");
                    asm volatile("global_load_dwordx4 %0, %1, off offset:128" : "=&v"(An[m][2]) : "v"(am_) : "memory"); asm volatile("global_load_dwordx4 %0, %1, off offset:192" : "=&v"(An[m][3]) : "v"(am_) : "memory"); } }
            { const char* gnext = (c < 3) ? gbc + (size_t)(c + 1) * 128 * bsc : gbn; const int bnext = (c < 3) ? bsc : bsn; DP3_STAGE((c + 1) & 1, gnext, bnext); }
            __builtin_amdgcn_sched_barrier(0);
            f32x4 acc[2][4][2];
            __builtin_amdgcn_s_setprio(1);
#pragma unroll
            for (int g = 0; g < 4; ++g) { bf16x8 Bf[2][4];
#pragma unroll
                for (int n = 0; n < 2; ++n)
#pragma unroll
                    for (int kk = 0; kk < 4; ++kk) Bf[n][kk] = *(const LAS bf16x8*)(lds + (c & 1) * 32768 + (kk >> 1) * 16384 + boffg[g] + n * 2048 + (kk & 1) * 1024);
#pragma unroll
                for (int m = 0; m < 2; ++m)
#pragma unroll
                    for (int n = 0; n < 2; ++n) { acc[m][g][n] = (f32x4){0.f, 0.f, 0.f, 0.f};
#pragma unroll
                        for (int kk = 0; kk < 4; ++kk) acc[m][g][n] = __builtin_amdgcn_mfma_f32_16x16x32_bf16(Bf[n][kk], A[m][kk], acc[m][g][n], 0, 0, 0); } }
            __builtin_amdgcn_s_setprio(0);
#pragma unroll
            for (int m = 0; m < 2; ++m) {
                float am0 = 0.f, am1 = 0.f;
#pragma unroll
                for (int g = 0; g < 4; ++g)
#pragma unroll
                    for (int n = 0; n < 2; ++n) { am0 = fmaxf(fmaxf(am0, fabsf(acc[m][g][n][0])), fabsf(acc[m][g][n][1])); am1 = fmaxf(fmaxf(am1, fabsf(acc[m][g][n][2])), fabsf(acc[m][g][n][3])); }
                float am = fmaxf(am0, am1);
                am = max_fq(am);
                am = fminf(am, 3.0e38f);
                const float isc = am > 0.f ? 127.0f * __builtin_amdgcn_rcpf(am) : 0.f;
                scq[m][c] = am * (1.0f / 127.0f);
                const f32x2_t isc2 = (f32x2_t){isc, isc}, mg2 = (f32x2_t){8388736.0f, 8388736.0f};
#pragma unroll
                for (int g = 0; g < 4; ++g) { unsigned qd[2];
#pragma unroll
                    for (int n = 0; n < 2; ++n) {
                        const f32x2_t tl = __builtin_elementwise_fma((f32x2_t){acc[m][g][n][0], acc[m][g][n][1]}, isc2, mg2), th = __builtin_elementwise_fma((f32x2_t){acc[m][g][n][2], acc[m][g][n][3]}, isc2, mg2);
                        const float f0_ = tl.x, f1_ = tl.y, f2_ = th.x, f3_ = th.y;
                        qd[n] = __builtin_amdgcn_perm(__builtin_bit_cast(unsigned, f1_), __builtin_bit_cast(unsigned, f0_), 0x0c0c0400u) | __builtin_amdgcn_perm(__builtin_bit_cast(unsigned, f3_), __builtin_bit_cast(unsigned, f2_), 0x04000c0cu); }
                    *(LAS v2u*)(stg + (16 * m + fr) * 144 + 32 * g + 8 * fq) = (v2u){qd[0], qd[1]}; } }
            v4u ob[4];
#pragma unroll
            for (int it = 0; it < 4; ++it) ob[it] = *(const LAS v4u*)(stg + (8 * it + (lane >> 3)) * 144 + (lane & 7) * 16);
            asm volatile("" : "+v"(ob[0]), "+v"(ob[1]), "+v"(ob[2]), "+v"(ob[3]));
#pragma unroll
            for (int it = 0; it < 4; ++it) { const int rr = 8 * it + (lane >> 3);
                __builtin_nontemporal_store(ob[it], (v4u*)(Yq + (size_t)(tile * 256 + 32 * w + rr) * D + colu + 128 * c + 16 * (lane & 7))); }
            if (c == 3) { const f32x4 so = fq == 0 ? (f32x4){scq[0][0], scq[0][1], scq[0][2], scq[0][3]} : (f32x4){scq[1][0], scq[1][1], scq[1][2], scq[1][3]};
                if (fq < 2) __builtin_nontemporal_store(so, (f32x4*)(Ysc + (size_t)(tile * 256 + 32 * w + 16 * fq + fr) * 16 + (colu >> 7))); }
            __builtin_amdgcn_sched_barrier(0);
        }
        asm volatile("s_waitcnt vmcnt(9)" : "+v"(An[0][0]), "+v"(An[0][1]), "+v"(An[0][2]), "+v"(An[0][3]), "+v"(An[1][0]), "+v"(An[1][1]), "+v"(An[1][2]), "+v"(An[1][3]) :: "memory");
        if (un == u) break;
#pragma unroll
        for (int m = 0; m < 2; ++m)
#pragma unroll
            for (int kk = 0; kk < 4; ++kk) A[m][kk] = An[m][kk];
        u = un; ecur = enx; nvcur = nvnx; abc = abn; asc = asn; gbc = gbn; bsc = bsn;
    }
    asm volatile("s_waitcnt vmcnt(0)" ::: "memory");
#undef DP3_UNITINFO
#undef DP3_STAGE
#undef DP3_GLDS
#undef DP3_SRC
}

enum { PH_PRO = 0, PH_POOL_G1, PH_POOL_P, PH_POOL_G2, PH_POOL_G3, PH_DIL_G1, PH_DIL_ATT, PH_DIL_CMB, PH_DIL_G2, PH_CONV_G1, PH_CONV_E, PH_CONV_G2, PH_MOE1, PH_MOE2, PH_MOE3, PH_MOE4, PH_COUNT };

template <int PH>
__device__ __forceinline__ void run_phase(const Frame& Fin, const Args& args_, const int L) {
    Frame F = Fin; { int w_ = Fin.wave, l_; asm volatile("" : "+s"(w_)); asm volatile("v_mbcnt_lo_u32_b32 %0, -1, 0\n\tv_mbcnt_hi_u32_b32 %0, -1, %0" : "=v"(l_)); F.wave = w_; F.lane = l_; F.tid = w_ * 64 + l_; }
    unsigned char* ws; { GAS unsigned char* wsg = (GAS unsigned char*)Fin.ws; asm volatile("" : "+s"(wsg)); ws = (unsigned char*)wsg; } F.ws = ws; F.ctl = (unsigned*)(ws + WS_CTL);
    KP kp = (KP)__builtin_amdgcn_kernarg_segment_ptr(); asm volatile("" : "+s"(kp)); (void)args_;
    { unsigned l_ = (unsigned)(size_t)Fin.lds; asm volatile("" : "+s"(l_)); F.lds = (LAS unsigned char*)(size_t)l_; }
    LAS unsigned char* ring = F.lds; int c = (int)blockIdx.x; { int g_ = Fin.G; asm volatile("" : "+s"(c), "+s"(g_)); F.G = g_; F.bid = c; }
    const float* xres = ain(kp, IN_X);
    const float* st2 = (const float*)(ws + WS_ST2); float* pstp = (float*)(ws + WS_PST);
    const float* g2p = ain(kp, IN_LNG) + (size_t)((L > 0 ? L - 1 : 0) * 2 + 1) * D; const float* b2p = ain(kp, IN_LNB) + (size_t)((L > 0 ? L - 1 : 0) * 2 + 1) * D;
    const bf16* xb = (const bf16*)(ws + WS_XB);
    bf16* yf = (bf16*)(ws + WS_YF);
    unsigned char* big = ws + WS_BIG;
    const int ia = L / 3;
    if constexpr (PH == PH_PRO) { phase_prologue(F, kp); }
    if constexpr (PH == PH_POOL_G1) { g8::DenseSched S; S.init(xb, (const bf16*)(ws + WS_W_POOL_IN) + (size_t)ia * D * D, T, D, D, D, F.G, c);
        g8::EpiBf16 E{(bf16*)(big + BG_U), D, 0}; g8::gemm_phase<g8::EpiBf16, g8::DenseSched, false>(ring, F.tid, D, D, D, S, E); }
    if constexpr (PH == PH_POOL_P) { phase_pool(F, (const bf16*)(big + BG_U), (bf16*)(big + BG_PL)); }
    if constexpr (PH == PH_POOL_G2) { g8::DenseSched S; S.init((const bf16*)(big + BG_PL), (const bf16*)(ws + WS_W_POOL_G) + (size_t)ia * D * 512, T, D, D, 512, F.G, c); S.agrp_shift = 1; S.agrp_stride = 512 * 2;
        g8::EpiScaleBf16 E{(bf16*)(big + BG_MX), D, ain(kp, IN_PSC) + (size_t)ia * D}; g8::gemm_phase<g8::EpiScaleBf16, g8::DenseSched, false>(ring, F.tid, 512, D, 512, S, E); }
    if constexpr (PH == PH_POOL_G3) { g8::DenseSched S; S.init((const bf16*)(big + BG_MX), (const bf16*)(ws + WS_W_POOL_OUT) + (size_t)ia * D * D, T, D, D, D, F.G, c);
        g8::EpiResidLN E{xres, xb, st2, g2p, b2p, yf, pstp, 2}; g8::gemm_phase<g8::EpiResidLN, g8::DenseSched, false>(ring, F.tid, D, D, D, S, E); }
    if constexpr (PH == PH_DIL_G1) { g8::DenseSched S; S.init(xb, (const bf16*)(ws + WS_W_DIL_QKV), T, QKVC, D, D, F.G, c);
        g8::EpiBf16 E{(bf16*)(big + BG_QKV), QKVC, 1}; g8::gemm_phase<g8::EpiBf16, g8::DenseSched, false>(ring, F.tid, D, D, D, S, E); }
    if constexpr (PH == PH_DIL_ATT) { phase_attn(F, (const bf16*)(big + BG_QKV), ain(kp, IN_RELB), (bf16*)(big + BG_OG), (float*)(big + BG_LSE)); }
    if constexpr (PH == PH_DIL_CMB) { phase_combine(F, (const bf16*)(big + BG_OG), (const float*)(big + BG_LSE), (bf16*)(big + BG_O)); }
    if constexpr (PH == PH_DIL_G2) { g8::DenseSched S; S.init((const bf16*)(big + BG_O), (const bf16*)(ws + WS_W_DIL_OUT), T, D, DILW, DILW, F.G, c);
        g8::EpiResidLN E{xres, xb, st2, g2p, b2p, yf, pstp, 2}; g8::gemm_phase<g8::EpiResidLN, g8::DenseSched, false>(ring, F.tid, DILW, DILW, DILW, S, E); }
    if constexpr (PH == PH_CONV_G1) { g8::DenseSched S; S.init(xb, (const bf16*)(ws + WS_W_CONV_IN), T, 3 * D, D, D, F.G, c);
        g8::EpiConvIn E{(bf16*)(big + BG_UC), (bf16*)(big + BG_BG)}; g8::gemm_phase<g8::EpiConvIn, g8::DenseSched, false>(ring, F.tid, D, D, D, S, E); }
    if constexpr (PH == PH_CONV_E) { phase_conv(F, (const bf16*)(big + BG_UC), (const bf16*)(big + BG_BG), ain(kp, IN_CW), (bf16*)(big + BG_Z)); }
    if constexpr (PH == PH_CONV_G2) { g8::DenseSched S; S.init((const bf16*)(big + BG_Z), (const bf16*)(ws + WS_W_CONV_OUT), T, D, D, D, F.G, c);
        g8::EpiResidLN E{xres, xb, st2, g2p, b2p, yf, pstp, 2}; g8::gemm_phase<g8::EpiResidLN, g8::DenseSched, false>(ring, F.tid, D, D, D, S, E); }
    unsigned* cnt = F.ctl + CW_CNT + L * 64 * 16;
    float* x1f = (float*)(ws + WS_X1F); bf16* x1b = (bf16*)(ws + WS_X1B);
    int* ltok = (int*)(ws + WS_LTOK); float* lgate = (float*)(ws + WS_LGATE); int* eidx = (int*)(ws + WS_EIDX); int* inv = (int*)(ws + WS_INV);
    bf16* HB = (bf16*)(ws + WS_HB); bf16* HS = (bf16*)(ws + WS_HS); bf16* Yr = (bf16*)(ws + WS_BIG);
    if constexpr (PH == PH_MOE1) {
        const float* g1 = ain(kp, IN_LNG) + (size_t)(L * 2 + 0) * D; const float* b1 = ain(kp, IN_LNB) + (size_t)(L * 2 + 0) * D;
        phase_moe1n(F, yf, pstp, g1, b1, (const bf16*)(ws + WS_RWH) + (size_t)L * NEXP * D, (const bf16*)(ws + WS_RWL) + (size_t)L * NEXP * D, ain(kp, IN_RB) + (size_t)L * NEXP,
                    x1b, (float*)(ws + WS_ST1), cnt, ltok, lgate, eidx, inv); }
    if constexpr (PH == PH_MOE2) {
        const int NT = build_tiles(F, cnt);
        { g8::ExpertSched<1, true> S; S.tpref = (const LAS int*)(F.lds + LDS_TAB); S.cnt = (const LAS int*)(F.lds + LDS_TAB + 512); S.A = (const char*)x1b; S.B = (const char*)((const bf16*)(ws + WS_W_EX_GU) + (size_t)L * 64 * 256 * D);
          S.tok = ltok; S.b_exp = (size_t)256 * D * 2; S.b_tile = 0; S.a_tile = 0; S.NU = NT; S.G = F.G; S.c = c;
          g8::EpiExpertGU E{HB}; g8::gemm_phase<g8::EpiExpertGU, g8::ExpertSched<1, true>, true>(ring, F.tid, D, D, D, S, E); }
        { const int rot = (c - (NT % F.G) + F.G) % F.G;
          g8::DenseSched S; S.init(x1b, (const bf16*)(ws + WS_W_SH_GU) + (size_t)L * 512 * D, T, 512, D, D, F.G, rot);
          int t2 = F.tid; asm volatile("" : "+v"(t2));
          g8::EpiSharedGU E{HS}; g8::gemm_phase<g8::EpiSharedGU, g8::DenseSched, false>(ring, t2, D, D, D, S, E); } }
    if constexpr (PH == PH_MOE3) {
        const float* g1 = ain(kp, IN_LNG) + (size_t)(L * 2 + 0) * D; const float* b1 = ain(kp, IN_LNB) + (size_t)(L * 2 + 0) * D;
        const int NT = build_tiles(F, cnt);
        __syncthreads();
        phase_downproj3(F, HB, (const bf16*)(ws + WS_W_EX_D) + (size_t)L * 64 * D * EDIM, HS, (const bf16*)(ws + WS_W_SH_D) + (size_t)L * D * SDIM, (unsigned char*)Yr, (float*)(ws + WS_BIG + BG_YSC), NT + 2 * (T / 256));
        (void)g1; (void)b1; }
    if constexpr (PH == PH_MOE4) { (void)build_tiles(F, cnt);
        const float* g2 = ain(kp, IN_LNG) + (size_t)(L * 2 + 1) * D; const float* b2 = ain(kp, IN_LNB) + (size_t)(L * 2 + 1) * D;
        phase_moe4q(F, x1b, (bf16*)(ws + WS_Y2F), (const unsigned char*)Yr, (const float*)(ws + WS_BIG + BG_YSC), eidx, inv, g2, b2, (float*)(ws + WS_ST2), (bf16*)(ws + WS_XB), aout(kp), L == DEPTH - 1); }
}
__device__ __forceinline__ void make_frame(Frame& F, const Args& args) {
    extern __shared__ __attribute__((aligned(16))) unsigned char lds_raw[];
    F.lds = (LAS unsigned char*)lds_raw; F.ws = args.ws; F.ctl = (unsigned*)(args.ws + WS_CTL);
    F.tid = threadIdx.x; F.lane = F.tid & 63; F.wave = __builtin_amdgcn_readfirstlane(F.tid >> 6); F.G = gridDim.x; F.bid = blockIdx.x;
}
template <int PH> __global__ void __launch_bounds__(512, 2) k_phase(Args args, int L) {
    Frame F; make_frame(F, args);
    run_phase<PH>(F, args, L);
}

#ifndef MK_NOINLINE
#define MK_NOINLINE 0
#endif
#if MK_NOINLINE
template <int PH> __device__ __noinline__ void call_phase_ni(const int L) {
    Args dummy{}; Frame F;
    KP kp = (KP)__builtin_amdgcn_kernarg_segment_ptr();
    extern __shared__ __attribute__((aligned(16))) unsigned char lds_raw[];
    F.lds = (LAS unsigned char*)lds_raw; F.ws = (unsigned char*)((GAS unsigned char* const CAS*)kp)[20]; F.ctl = (unsigned*)(F.ws + WS_CTL);
    F.tid = threadIdx.x; F.lane = F.tid & 63; F.wave = __builtin_amdgcn_readfirstlane(F.tid >> 6); F.G = gridDim.x; F.bid = blockIdx.x;
    run_phase<PH>(F, dummy, L);
}
template <int PH> __device__ __forceinline__ void call_phase(const Frame& F, const Args& args, const int L) { call_phase_ni<PH>(L); }
#else
template <int PH> __device__ __forceinline__ void call_phase(const Frame& F, const Args& args, const int L) { asm volatile("; PHASE_BEGIN %0" :: "n"(PH)); run_phase<PH>(F, args, L); asm volatile("; PHASE_END %0" :: "n"(PH)); }
#endif
__global__ void __launch_bounds__(512, 2) fwd_all(Args args) {
    Frame F; make_frame(F, args);
    volatile LAS unsigned* misc = (volatile LAS unsigned*)(F.lds + LDS_MISC);
    if (F.tid < 4) misc[F.tid] = 0u;
    __syncthreads();
    const int lo = args.ph_lo, hi = args.ph_hi;
    XcdBarrier bar; bar.bar = F.ctl + CW_BAR; bar.x = 0; bar.st = misc;
    if (hi - lo > 1) bar = xcd_barrier_post(F.ctl + CW_BAR, misc);
    int pc = 0;
#ifndef MK_DUP_MASK
#define MK_DUP_MASK 0
#endif
#if MK_DUP_MASK
#define STEP(PH, Lx) do { if (pc >= lo && pc < hi) { int nrep_ = ((MK_DUP_MASK >> (PH)) & 1) ? 2 : 1; asm volatile("" : "+s"(nrep_)); _Pragma("unroll 1") for (int r_ = 0; r_ < nrep_; ++r_) { call_phase<PH>(F, args, Lx); if (r_ + 1 < nrep_ || pc + 1 < hi) xcd_barrier(bar); } } ++pc; } while (0)
#else
#define STEP(PH, Lx) do { if (pc >= lo && pc < hi) { call_phase<PH>(F, args, Lx); if (pc + 1 < hi) xcd_barrier(bar); } ++pc; } while (0)
#endif
    STEP(PH_PRO, 0);
#pragma unroll 1
    for (int L = 0; L < DEPTH; ++L) {
        const int kind = L % 3;
        if (kind == 0) { STEP(PH_POOL_G1, L); STEP(PH_POOL_P, L); STEP(PH_POOL_G2, L); STEP(PH_POOL_G3, L); }
        else if (kind == 1) { STEP(PH_DIL_G1, L); STEP(PH_DIL_ATT, L); STEP(PH_DIL_CMB, L); STEP(PH_DIL_G2, L); }
        else { STEP(PH_CONV_G1, L); STEP(PH_CONV_E, L); STEP(PH_CONV_G2, L); }
        STEP(PH_MOE1, L); STEP(PH_MOE2, L); STEP(PH_MOE3, L); STEP(PH_MOE4, L);
    }
#undef STEP
}
constexpr int N_STEPS = 1 + 2 * 8 + 8 + 7;

template <int PH> static void launch_phase(const Args& a, int L, int grid, hipStream_t stream) {
    static bool attr = false;
    if (!attr) { (void)hipFuncSetAttribute((const void*)k_phase<PH>, hipFuncAttributeMaxDynamicSharedMemorySize, LDS_BYTES); attr = true; }
    hipLaunchKernelGGL(k_phase<PH>, dim3(grid), dim3(512), LDS_BYTES, stream, a, L);
}
extern "C" void kernel_launch(void* const* d_in, const int* in_sizes, int n_in, void* d_out, int out_size, void* d_ws, size_t ws_size, hipStream_t stream) {
    static int grid = 0;
    if (grid == 0) {
        if (n_in != 19 || out_size != T * D || ws_size < WS_END) { fprintf(stderr, "kernel_launch: unexpected shapes (n_in %d out %d ws %zu need %zu)\n", n_in, out_size, ws_size, (size_t)WS_END); grid = -1; return; }
        int dev = 0, cus = 0;
        if (hipGetDevice(&dev) != hipSuccess || hipDeviceGetAttribute(&cus, hipDeviceAttributeMultiprocessorCount, dev) != hipSuccess) { grid = -1; return; }
#if MK_ONE_LAUNCH
        if (hipFuncSetAttribute((const void*)fwd_all, hipFuncAttributeMaxDynamicSharedMemorySize, LDS_BYTES) != hipSuccess) { fprintf(stderr, "kernel_launch: hipFuncSetAttribute failed\n"); grid = -1; return; }
        int per_cu = 0;
        if (hipOccupancyMaxActiveBlocksPerMultiprocessor(&per_cu, (const void*)fwd_all, 512, LDS_BYTES) != hipSuccess || per_cu < 1) { fprintf(stderr, "kernel_launch: note: occupancy query reports %d blocks per CU\n", per_cu); (void)hipGetLastError(); }
#endif
        grid = cus;
    }
    if (grid < 0) return;
    (void)hipMemsetAsync((char*)d_ws + WS_CTL, 0, CTL_ZERO_BYTES, stream);
    Args a{};
    for (int i = 0; i < 19; ++i) a.in[i] = (const float*)d_in[i];
    a.out = (float*)d_out; a.ws = (unsigned char*)d_ws; a.ph_lo = 0; a.ph_hi = 0;
#if MK_ONE_LAUNCH
#ifdef MK_SPLIT
    for (int p = 0; p < N_STEPS; ++p) { a.ph_lo = p; a.ph_hi = p + 1; hipLaunchKernelGGL(fwd_all, dim3(grid), dim3(512), LDS_BYTES, stream, a); }
#else
    a.ph_lo = 0; a.ph_hi = N_STEPS;
    hipLaunchKernelGGL(fwd_all, dim3(grid), dim3(512), LDS_BYTES, stream, a);
#endif
#elif defined(MK_HYBRID_MASK)
    {
        static bool attr2 = false; if (!attr2) { (void)hipFuncSetAttribute((const void*)fwd_all, hipFuncAttributeMaxDynamicSharedMemorySize, LDS_BYTES); attr2 = true; }
        int pc = 0;
#define HSTEP(PH, Lx) do { if ((MK_HYBRID_MASK >> (PH)) & 1) { a.ph_lo = pc; a.ph_hi = pc + 1; hipLaunchKernelGGL(fwd_all, dim3(grid), dim3(512), LDS_BYTES, stream, a); } else { a.ph_lo = 0; a.ph_hi = 0; launch_phase<PH>(a, Lx, grid, stream); } ++pc; } while (0)
        HSTEP(PH_PRO, 0);
        for (int L = 0; L < DEPTH; ++L) {
            const int kind = L % 3;
            if (kind == 0) { HSTEP(PH_POOL_G1, L); HSTEP(PH_POOL_P, L); HSTEP(PH_POOL_G2, L); HSTEP(PH_POOL_G3, L); }
            else if (kind == 1) { HSTEP(PH_DIL_G1, L); HSTEP(PH_DIL_ATT, L); HSTEP(PH_DIL_CMB, L); HSTEP(PH_DIL_G2, L); }
            else { HSTEP(PH_CONV_G1, L); HSTEP(PH_CONV_E, L); HSTEP(PH_CONV_G2, L); }
            HSTEP(PH_MOE1, L); HSTEP(PH_MOE2, L); HSTEP(PH_MOE3, L); HSTEP(PH_MOE4, L);
        }
#undef HSTEP
    }
#else
    launch_phase<PH_PRO>(a, 0, grid, stream);
    for (int L = 0; L < DEPTH; ++L) {
        const int kind = L % 3;
        if (kind == 0) { launch_phase<PH_POOL_G1>(a, L, grid, stream); launch_phase<PH_POOL_P>(a, L, grid, stream); launch_phase<PH_POOL_G2>(a, L, grid, stream); launch_phase<PH_POOL_G3>(a, L, grid, stream); }
        else if (kind == 1) { launch_phase<PH_DIL_G1>(a, L, grid, stream); launch_phase<PH_DIL_ATT>(a, L, grid, stream); launch_phase<PH_DIL_CMB>(a, L, grid, stream); launch_phase<PH_DIL_G2>(a, L, grid, stream); }
        else { launch_phase<PH_CONV_G1>(a, L, grid, stream); launch_phase<PH_CONV_E>(a, L, grid, stream); launch_phase<PH_CONV_G2>(a, L, grid, stream); }
        launch_phase<PH_MOE1>(a, L, grid, stream); launch_phase<PH_MOE2>(a, L, grid, stream); launch_phase<PH_MOE3>(a, L, grid, stream); launch_phase<PH_MOE4>(a, L, grid, stream);
    }
#endif
}
```

```cpp
#include <hip/hip_runtime.h>
#include <cstdio>
#include <cstdint>

#ifndef MK_ONE_LAUNCH
#define MK_ONE_LAUNCH 1
#endif

#define GAS __attribute__((address_space(1)))
#define LAS __attribute__((address_space(3)))
typedef unsigned short bf16;
typedef unsigned v4u __attribute__((ext_vector_type(4)));
typedef unsigned v2u __attribute__((ext_vector_type(2)));
typedef float f32x4 __attribute__((ext_vector_type(4)));
typedef float f32x2 __attribute__((ext_vector_type(2)));
typedef short bf16x8 __attribute__((ext_vector_type(8)));
typedef short s16x4 __attribute__((ext_vector_type(4)));

constexpr int NBATCH = 8, SEQ = 2048, D = 2048, T = NBATCH * SEQ, DEPTH = 4;
constexpr int NEXP = 64, TOPK = 8, EDIM = 128, SDIM = 256;
constexpr int QKVC = 4608, DILW = 512;
constexpr float ALPHA = 1.681792830507429f;
constexpr float LN_EPS = 1e-5f;
constexpr int CAP = 16384;
constexpr int HROWS = T * TOPK + NEXP * 256;

constexpr size_t MiB = 1u << 20;
constexpr size_t WS_CTL = 0, CTL_ZERO_BYTES = 1 * MiB;
constexpr size_t WS_W_POOL_IN = 1 * MiB;
constexpr size_t WS_W_POOL_G = WS_W_POOL_IN + 16 * MiB;
constexpr size_t WS_W_POOL_OUT = WS_W_POOL_G + 4 * MiB;
constexpr size_t WS_W_DIL_QKV = WS_W_POOL_OUT + 16 * MiB;
constexpr size_t WS_W_DIL_OUT = WS_W_DIL_QKV + 18 * MiB;
constexpr size_t WS_W_CONV_IN = WS_W_DIL_OUT + 2 * MiB;
constexpr size_t WS_W_CONV_OUT = WS_W_CONV_IN + 24 * MiB;
constexpr size_t WS_W_SH_GU = WS_W_CONV_OUT + 8 * MiB;
constexpr size_t WS_W_SH_D = WS_W_SH_GU + 8 * MiB;
constexpr size_t WS_W_EX_GU = WS_W_SH_D + 4 * MiB;
constexpr size_t WS_W_EX_D = WS_W_EX_GU + 256 * MiB;
constexpr size_t WS_XF = WS_W_EX_D + 256 * MiB;
constexpr size_t WS_YF = WS_XF + 128 * MiB;
constexpr size_t WS_X1F = WS_YF + 128 * MiB;
constexpr size_t WS_XB = WS_X1F + 128 * MiB;
constexpr size_t WS_X1B = WS_XB + 64 * MiB;
constexpr size_t WS_HB = WS_X1B + 64 * MiB;
constexpr size_t WS_HS = WS_HB + 72 * MiB;
constexpr size_t WS_LTOK = WS_HS + 8 * MiB;
constexpr size_t WS_LGATE = WS_LTOK + 4 * MiB;
constexpr size_t WS_EIDX = WS_LGATE + 4 * MiB;
constexpr size_t WS_INV = WS_EIDX + 1 * MiB;
constexpr size_t WS_BIG = WS_INV + 1 * MiB;
constexpr size_t WS_PST = WS_BIG + 608 * MiB;
constexpr size_t WS_ST1 = WS_PST + 4 * MiB;
constexpr size_t WS_ST2 = WS_ST1 + 1 * MiB;
constexpr size_t WS_RWH = WS_ST2 + 1 * MiB;
constexpr size_t WS_RWL = WS_RWH + 1 * MiB;
constexpr size_t WS_PST2 = WS_RWL + 1 * MiB;
constexpr size_t WS_END = WS_PST2 + 8 * MiB;
constexpr size_t WS_Y2F = WS_X1F;
constexpr size_t BG_U = 0, BG_PL = 64 * MiB, BG_MX = 128 * MiB;
constexpr size_t BG_QKV = 0, BG_OG = 144 * MiB, BG_LSE = 192 * MiB, BG_O = 194 * MiB;
constexpr size_t BG_UC = 0, BG_BG = 64 * MiB, BG_Z = 128 * MiB;
constexpr size_t BG_YSC = 400 * MiB;
constexpr int CW_BAR = 4096;
constexpr int CW_CNT = 16384;

constexpr int RING_BYTES = 131072;
constexpr int LDS_TAB = RING_BYTES;
constexpr int LDS_STASH = RING_BYTES + 1024;
constexpr int LDS_BYTES = 163840;
constexpr int LDS_MISC = LDS_BYTES - 1024;

typedef __bf16 bf16x2_t __attribute__((ext_vector_type(2)));
typedef float f32x2_t __attribute__((ext_vector_type(2)));
__device__ __forceinline__ unsigned cvt_pk_bf16(float lo, float hi) { const bf16x2_t r = __builtin_convertvector((f32x2_t){lo, hi}, bf16x2_t); return __builtin_bit_cast(unsigned, r); }
__device__ __forceinline__ unsigned f2bf(float f) { unsigned u = __builtin_bit_cast(unsigned, f); return (u + 0x7fffu + ((u >> 16) & 1u)) >> 16; }
__device__ __forceinline__ unsigned pk2(float lo, float hi) { return f2bf(lo) | (f2bf(hi) << 16); }
__device__ __forceinline__ float bflo(unsigned w) { return __builtin_bit_cast(float, w << 16); }
__device__ __forceinline__ float bfhi(unsigned w) { return __builtin_bit_cast(float, w & 0xffff0000u); }
__device__ __forceinline__ float shfl_from(float v, int src) { return __builtin_bit_cast(float, __builtin_amdgcn_ds_bpermute(src << 2, __builtin_bit_cast(int, v))); }
__device__ __forceinline__ float shfl_x(float v, int o, int lane) { return shfl_from(v, lane ^ o); }
__device__ __forceinline__ float wave_sum(float v, int lane) {
    (void)lane;
    v += __builtin_bit_cast(float, __builtin_amdgcn_update_dpp(0, __builtin_bit_cast(int, v), 0xB1, 0xF, 0xF, false));
    v += __builtin_bit_cast(float, __builtin_amdgcn_update_dpp(0, __builtin_bit_cast(int, v), 0x4E, 0xF, 0xF, false));
    v += __builtin_bit_cast(float, __builtin_amdgcn_update_dpp(0, __builtin_bit_cast(int, v), 0x141, 0xF, 0xF, false));
    v += __builtin_bit_cast(float, __builtin_amdgcn_update_dpp(0, __builtin_bit_cast(int, v), 0x140, 0xF, 0xF, false));
    const float r0 = __builtin_bit_cast(float, __builtin_amdgcn_readlane(__builtin_bit_cast(int, v), 0)), r1 = __builtin_bit_cast(float, __builtin_amdgcn_readlane(__builtin_bit_cast(int, v), 16));
    const float r2 = __builtin_bit_cast(float, __builtin_amdgcn_readlane(__builtin_bit_cast(int, v), 32)), r3 = __builtin_bit_cast(float, __builtin_amdgcn_readlane(__builtin_bit_cast(int, v), 48));
    return (r0 + r1) + (r2 + r3);
}
__device__ __forceinline__ float sum_fq(float x) {
    { const auto r = __builtin_amdgcn_permlane16_swap(__builtin_bit_cast(unsigned, x), __builtin_bit_cast(unsigned, x), false, false); const unsigned a_ = r[0], b_ = r[1]; x = __builtin_bit_cast(float, a_) + __builtin_bit_cast(float, b_); }
    { const auto r = __builtin_amdgcn_permlane32_swap(__builtin_bit_cast(unsigned, x), __builtin_bit_cast(unsigned, x), false, false); const unsigned a_ = r[0], b_ = r[1]; x = __builtin_bit_cast(float, a_) + __builtin_bit_cast(float, b_); }
    return x;
}
__device__ __forceinline__ float max_fq(float x) {
    { const auto r = __builtin_amdgcn_permlane16_swap(__builtin_bit_cast(unsigned, x), __builtin_bit_cast(unsigned, x), false, false); const unsigned a_ = r[0], b_ = r[1]; x = fmaxf(__builtin_bit_cast(float, a_), __builtin_bit_cast(float, b_)); }
    { const auto r = __builtin_amdgcn_permlane32_swap(__builtin_bit_cast(unsigned, x), __builtin_bit_cast(unsigned, x), false, false); const unsigned a_ = r[0], b_ = r[1]; x = fmaxf(__builtin_bit_cast(float, a_), __builtin_bit_cast(float, b_)); }
    return x;
}
#define LDS_WAIT() asm volatile("s_waitcnt lgkmcnt(0)" ::: "memory")
#define VM_WAIT() asm volatile("s_waitcnt vmcnt(0)" ::: "memory")

#define XB_TMO      128
#define XB_XCNT(j)  (256  + 64 * (j))
#define XB_XSUB(j)  (1280 + 64 * (j))
#define XB_XGEN(j)  (2304 + 64 * (j))
#define XB_TOP      3328
#define XB_TOPGEN   3392
#define XCD_BAR_WORDS 3456
#define XB_SPIN_CAP (1u << 18)

__device__ __forceinline__ unsigned xb_ld(unsigned* p)              { return __hip_atomic_load(p, __ATOMIC_RELAXED, __HIP_MEMORY_SCOPE_AGENT); }
__device__ __forceinline__ unsigned xb_add(unsigned* p, unsigned v) { return __hip_atomic_fetch_add(p, v, __ATOMIC_RELAXED, __HIP_MEMORY_SCOPE_AGENT); }
__device__ __forceinline__ unsigned xb_xcc_id() { return (unsigned)__builtin_amdgcn_s_getreg((3 << 11) | 20) & 0xFu; }
#define XB_SPIN(cond, bar) do { unsigned _sp = 0; while (cond) { __builtin_amdgcn_s_sleep(1); \
    if ((++_sp & 255u) == 0u) { if (xb_ld(&(bar)[XB_TMO])) break; if (_sp > XB_SPIN_CAP) { atomicAdd(&(bar)[XB_TMO], 1u); break; } } } } while (0)

struct XcdBarrier {
    unsigned* bar; unsigned x;
    volatile LAS unsigned* st;
};

__device__ __forceinline__ XcdBarrier xcd_barrier_post(unsigned* bar, volatile LAS unsigned* st) {
    XcdBarrier b; b.bar = bar; b.x = xb_xcc_id(); b.st = st;
    if (threadIdx.x == 0) (void)xb_add(&bar[XB_XCNT(b.x)], 1u);
    return b;
}
__device__ __forceinline__ void xcd_barrier_complete(unsigned* bar, unsigned x, unsigned& nloc, unsigned& nx) {
    const unsigned G = gridDim.x * gridDim.y * gridDim.z;
    unsigned sum, cnt, mine, sp = 0u;
    for (;;) {
        sum = 0u; cnt = 0u; mine = 0u;
#pragma unroll
        for (unsigned j = 0; j < 16; ++j) { const unsigned c = xb_ld(&bar[XB_XCNT(j)]); sum += c; cnt += (c > 0u) ? 1u : 0u; mine = (j == x) ? c : mine; }
        if (sum == G) break;
        __builtin_amdgcn_s_sleep(1);
        if ((++sp & 255u) == 0u) { if (xb_ld(&bar[XB_TMO])) break; if (sp > XB_SPIN_CAP) { atomicAdd(&bar[XB_TMO], 1u); break; } }
    }
    nloc = mine > 0u ? mine : 1u; nx = cnt > 0u ? cnt : 1u;
}

__device__ __forceinline__ void xcd_barrier(const XcdBarrier& b) {
    asm volatile("s_waitcnt vmcnt(0)" ::: "memory");
    __syncthreads();
    if (threadIdx.x == 0) {
        unsigned* bar; unsigned bx = b.x; { GAS unsigned* bg = (GAS unsigned*)b.bar; asm volatile("" : "+s"(bg), "+s"(bx)); bar = (unsigned*)bg; }
        __builtin_amdgcn_s_waitcnt(0);
        unsigned nloc = b.st[0], nx = b.st[1];
        if (nloc == 0u) { xcd_barrier_complete(bar, bx, nloc, nx); b.st[0] = nloc; b.st[1] = nx; }
        const unsigned old = xb_add(&bar[XB_XSUB(bx)], 1u);
        const unsigned gen = old / nloc;
        if (old + 1u == (gen + 1u) * nloc) {
            __builtin_amdgcn_fence(__ATOMIC_RELEASE, "agent");
            asm volatile("s_waitcnt vmcnt(0)" ::: "memory");
            const unsigned og = xb_add(&bar[XB_TOP], 1u);
            const unsigned tg = og / nx;
            if (og + 1u == (tg + 1u) * nx) xb_add(&bar[XB_TOPGEN], 1u);
            else XB_SPIN(xb_ld(&bar[XB_TOPGEN]) == tg, bar);
            __builtin_amdgcn_fence(__ATOMIC_ACQUIRE, "agent");
            xb_add(&bar[XB_XGEN(bx)], 1u);
            asm volatile("s_waitcnt vmcnt(0)" ::: "memory");
        } else {
            XB_SPIN(xb_ld(&bar[XB_XGEN(bx)]) == gen, bar);
            __builtin_amdgcn_fence(__ATOMIC_ACQUIRE, "agent");
            asm volatile("s_waitcnt vmcnt(0)" ::: "memory");
        }
    }
    __syncthreads();
}

namespace g8 {
constexpr int BM = 256, BK = 64, HALF = 128, HTB = HALF * BK * 2, STAGE_BYTES = 8 * HTB, NXCD = 8, WGM = 8;
__host__ __device__ __forceinline__ int lds_byte(int r, int c) { const int st = (r >> 4) * 2 + (c >> 5), rr = r & 15, cc = c & 31, ob = rr * 64 + cc * 2; return st * 1024 + (ob ^ (((ob >> 9) & 1) << 5)); }
__host__ __device__ __forceinline__ void stage_rc(int b, int& R, int& C) { const int st = b / 1024, sb = b % 1024, swz = sb ^ (((sb >> 9) & 1) << 5); R = (st >> 1) * 16 + swz / 64; C = (st & 1) * 32 + (swz % 64) / 2; }
__host__ __device__ __forceinline__ int perm32(int rho) { const int n = rho >> 4, i = rho & 15; return 8 * (i >> 2) + 4 * n + (i & 3); }

struct Unit { const char* A; const char* B; const int* rows; int pm, pn, nvalid, aux; };

template <class Epi, class Sched, bool GATHER>
__device__ __forceinline__ void gemm_phase(LAS unsigned char* lds, const int tid_in, const int K, const int lda, const int ldb, const Sched& S, const Epi& E) {
    const int tid = tid_in, wid = __builtin_amdgcn_readfirstlane(tid >> 6), lane = tid & 63, wr = wid >> 2, wc = wid & 3, fr = lane & 15, fq = lane >> 4;
    const int nt = K / BK;
    unsigned voffB[2];
#pragma unroll
    for (int i = 0; i < 2; ++i) { int R_, C_; stage_rc(tid * 16 + i * 8192, R_, C_); const int Rb = Epi::PERM ? ((R_ & ~31) + perm32(R_ & 31)) : R_; voffB[i] = (unsigned)(Rb * ldb + C_) * 2u; }
    LAS v4u* stash = (LAS v4u*)(lds + (LDS_STASH - 0) + tid * 16);
    const size_t kstep = (size_t)(BK * 2);
    const size_t hstepB = (size_t)HALF * ldb * 2;
    const unsigned ldsw = (unsigned)wid * 1024u;
    const int aoff = lds_byte(wr * 64 + fr, fq * 8), boff = lds_byte(wc * 32 + fr, fq * 8);
#define G8_SA(b, h) (((b) * 2 + (h)) * HTB)
#define G8_SB(b, h) ((4 + (b) * 2 + (h)) * HTB)
#define G8_STAGE2(bufoff, gbase, v0, v1) do { \
        __builtin_amdgcn_global_load_lds((const unsigned*)((const char*)(gbase) + (v0)), (LAS unsigned*)(lds + (bufoff) + ldsw), 16, 0, 0); \
        __builtin_amdgcn_global_load_lds((const unsigned*)((const char*)(gbase) + (v1)), (LAS unsigned*)(lds + (bufoff) + ldsw + 8192), 16, 0, 0); } while (0)
#define G8_STAGEB(bufoff, gbase) G8_STAGE2(bufoff, gbase, voffB[0], voffB[1])
#define G8_LDA(dst, b, h) do { _Pragma("unroll") for (int m = 0; m < 4; ++m) _Pragma("unroll") for (int k = 0; k < 2; ++k) dst[m][k] = *(const LAS bf16x8*)(lds + G8_SA(b, h) + aoff + m * 2048 + k * 1024); } while (0)
#define G8_LDB(dst, b, h) do { _Pragma("unroll") for (int n = 0; n < 2; ++n) _Pragma("unroll") for (int k = 0; k < 2; ++k) dst[n][k] = *(const LAS bf16x8*)(lds + G8_SB(b, h) + boff + n * 2048 + k * 1024); } while (0)
#define G8_MMA(ai, bj, At, Bt) do { __builtin_amdgcn_s_setprio(1); _Pragma("unroll") for (int m = 0; m < 4; ++m) _Pragma("unroll") for (int n = 0; n < 2; ++n) _Pragma("unroll") for (int k = 0; k < 2; ++k) \
        acc[ai][bj][m][n] = __builtin_amdgcn_mfma_f32_16x16x32_bf16(Bt[n][k], At[m][k], acc[ai][bj][m][n], 0, 0, 0); __builtin_amdgcn_s_setprio(0); } while (0)
#define G8_WAIT_V(n) asm volatile("s_waitcnt vmcnt(" #n ")" ::: "memory")
#define G8_WAIT_L(n) asm volatile("s_waitcnt lgkmcnt(" #n ")" ::: "memory")
#define G8_BAR __builtin_amdgcn_s_barrier()
#define G8_SCHED __builtin_amdgcn_sched_barrier(0)
#define G8_SETVA(dst, u) do { int _t2 = tid; if (GATHER) asm volatile("" : "+v"(_t2)); _Pragma("unroll") for (int _h = 0; _h < 2; ++_h) _Pragma("unroll") for (int _i = 0; _i < 2; ++_i) { \
        int _R, _C; stage_rc(_t2 * 16 + _i * 8192, _R, _C); \
        const unsigned _rl = (unsigned)(_h * HALF + _R); unsigned _row = _rl; \
        if (GATHER) { const bool _ok = _rl < (unsigned)(u).nvalid; _row = (unsigned)(u).rows[_ok ? _rl : 0u] >> 3; if (!_ok) _row = 0u; }     \
        dst[_h][_i] = (_row * (unsigned)lda + (unsigned)_C) * 2u; } } while (0)
    Unit cur, nxt; int ui = 0;
    if (!S.next(0, cur)) return;
    f32x4 acc[2][2][4][2];
#pragma unroll
    for (int a = 0; a < 2; ++a)
#pragma unroll
        for (int b = 0; b < 2; ++b)
#pragma unroll
            for (int m = 0; m < 4; ++m)
#pragma unroll
                for (int n = 0; n < 2; ++n) acc[a][b][m][n] = (f32x4){0.f, 0.f, 0.f, 0.f};
    bf16x8 At[4][2], B0[2][2], B1[2][2];
    unsigned vAc[2][2]; unsigned xl00 = 0, xl01 = 0, xl10 = 0, xl11 = 0;
    G8_SETVA(vAc, cur);
    const char* cA = cur.A; const char* cB = cur.B;
    G8_STAGEB(G8_SB(0, 0), cB); G8_STAGEB(G8_SB(0, 1), cB + hstepB); G8_STAGE2(G8_SA(0, 0), cA, vAc[0][0], vAc[0][1]); G8_STAGE2(G8_SA(0, 1), cA, vAc[1][0], vAc[1][1]);
    if (wr == 1) G8_BAR;
    G8_WAIT_V(2); G8_BAR;
    G8_STAGEB(G8_SB(1, 0), cB + kstep); G8_STAGE2(G8_SA(1, 0), cA + kstep, vAc[0][0], vAc[0][1]); G8_STAGEB(G8_SB(1, 1), cB + hstepB + kstep);
    G8_WAIT_V(6); G8_BAR;
    for (;;) {
        const bool has_next = S.next(ui + 1, nxt);
        const char* nA = has_next ? nxt.A : cA; const char* nB = has_next ? nxt.B : cB;
        if (GATHER) { unsigned vAn[2][2]; if (has_next) { G8_SETVA(vAn, nxt); } else {
#pragma unroll
            for (int h = 0; h < 2; ++h)
#pragma unroll
                for (int i = 0; i < 2; ++i) vAn[h][i] = vAc[h][i]; }
            *stash = (v4u){vAn[0][0], vAn[0][1], vAn[1][0], vAn[1][1]}; }
#pragma unroll 1
        for (int t = 0; t < nt; t += 2) {
            const bool last = (t == nt - 2);
            const char* a1 = cA + (size_t)(t + 1) * kstep;
            const char* a2 = last ? nA : cA + (size_t)(t + 2) * kstep; const char* b2 = last ? nB : cB + (size_t)(t + 2) * kstep;
            const char* a3 = a2 + kstep; const char* b3 = b2 + kstep;
            unsigned x00 = vAc[0][0], x01 = vAc[0][1], x10 = vAc[1][0], x11 = vAc[1][1];
            if (GATHER) { if (last) { const v4u sv = *stash; x00 = sv.x; x01 = sv.y; x10 = sv.z; x11 = sv.w; } xl00 = x00; xl01 = x01; xl10 = x10; xl11 = x11; }
            G8_LDB(B0, 0, 0); G8_LDB(B1, 0, 1); G8_SCHED; G8_LDA(At, 0, 0); G8_STAGE2(G8_SA(1, 1), a1, vAc[1][0], vAc[1][1]);
            G8_WAIT_V(8); G8_WAIT_L(0); G8_BAR; G8_MMA(0, 0, At, B0); G8_MMA(0, 1, At, B1); G8_BAR; G8_SCHED;
            G8_LDA(At, 0, 1); G8_STAGEB(G8_SB(0, 0), b2); G8_STAGEB(G8_SB(0, 1), b2 + hstepB); G8_STAGE2(G8_SA(0, 0), a2, x00, x01);
            G8_WAIT_V(8); G8_WAIT_L(0); G8_BAR; G8_MMA(1, 0, At, B0); G8_MMA(1, 1, At, B1); G8_BAR; G8_SCHED;
            G8_LDB(B0, 1, 0); G8_LDB(B1, 1, 1); G8_SCHED; G8_LDA(At, 1, 0); G8_STAGE2(G8_SA(0, 1), a2, x10, x11);
            G8_WAIT_V(8); G8_WAIT_L(0); G8_BAR; G8_MMA(0, 0, At, B0); G8_MMA(0, 1, At, B1); G8_BAR; G8_SCHED;
            G8_LDA(At, 1, 1); G8_STAGEB(G8_SB(1, 0), b3); G8_STAGEB(G8_SB(1, 1), b3 + hstepB); G8_STAGE2(G8_SA(1, 0), a3, x00, x01);
            G8_WAIT_V(8); G8_WAIT_L(0); G8_BAR; G8_MMA(1, 0, At, B0); G8_MMA(1, 1, At, B1); G8_BAR; G8_SCHED;
        }
        if (wr == 0) G8_BAR;
        E(acc, cur, wr, wc, fr, fq);
        if (!has_next) break;
#pragma unroll
        for (int a = 0; a < 2; ++a)
#pragma unroll
            for (int b = 0; b < 2; ++b)
#pragma unroll
                for (int m = 0; m < 4; ++m)
#pragma unroll
                    for (int n = 0; n < 2; ++n) acc[a][b][m][n] = (f32x4){0.f, 0.f, 0.f, 0.f};
        cur = nxt; cA = nA; cB = nB; ++ui;
        if (GATHER) { vAc[0][0] = xl00; vAc[0][1] = xl01; vAc[1][0] = xl10; vAc[1][1] = xl11; }
        if (wr == 1) G8_BAR;
    }
    G8_WAIT_V(0);
    G8_BAR;
#undef G8_SA
#undef G8_SB
#undef G8_STAGE2
#undef G8_STAGEB
#undef G8_LDA
#undef G8_LDB
#undef G8_MMA
#undef G8_WAIT_V
#undef G8_WAIT_L
#undef G8_BAR
#undef G8_SCHED
#undef G8_SETVA
}

struct DenseSched {
    const char* A; const char* B; size_t a_tile, b_tile, agrp_stride; int agrp_shift, nM, nN, nwg, G, c;
    __device__ __forceinline__ void init(const void* A_, const void* B_, int M, int N, int lda, int ldb, int G_, int c_) {
        A = (const char*)A_; B = (const char*)B_; a_tile = (size_t)BM * lda * 2; b_tile = (size_t)BM * ldb * 2; agrp_stride = 0; agrp_shift = 0; nM = M / BM; nN = N / BM; nwg = nM * nN; G = G_; c = c_; }
    __device__ __forceinline__ bool next(int i, Unit& u) const {
        const long L = (long)i * G + c; if (L >= nwg) return false;
        int wgid = (int)L; { const int q = nwg / NXCD, r = nwg % NXCD, xcd = wgid % NXCD, off = wgid / NXCD; wgid = (xcd < r ? xcd * (q + 1) : r * (q + 1) + (xcd - r) * q) + off; }
        const int nig = WGM * nN, gid = wgid / nig, fm = gid * WGM, gsz = (nM - fm) < WGM ? (nM - fm) : WGM;
        u.pm = fm + ((wgid % nig) % gsz); u.pn = (wgid % nig) / gsz;
        u.A = A + (size_t)u.pm * a_tile + (size_t)(u.pn >> agrp_shift) * agrp_stride; u.B = B + (size_t)u.pn * b_tile; u.rows = nullptr; u.nvalid = BM; u.aux = 0; return true;
    }
};
template <int NPN, bool GATHERED>
struct ExpertSched {
    const LAS int* tpref; const LAS int* cnt; const char* A; const char* B; const int* tok; size_t b_exp, b_tile, a_tile; int NU, G, c;
    __device__ __forceinline__ bool next(int i, Unit& u) const {
        int L = i * G + c; if (L >= NU) return false;
        if ((i + 1) * G <= NU && (G % NXCD) == 0) L = i * G + (c % NXCD) * (G / NXCD) + c / NXCD;
        const int tile = L / NPN, pn = L % NPN;
        int e = 0; { int hi = 64;
#pragma unroll
          for (int it_ = 0; it_ < 6; ++it_) { const int mid = (e + hi) >> 1; if (__builtin_amdgcn_readfirstlane(tpref[mid]) <= tile) e = mid; else hi = mid; } }
        const int rb = tile - __builtin_amdgcn_readfirstlane(tpref[e]);
        u.pm = e; u.pn = pn; u.aux = tile * BM; u.nvalid = __builtin_amdgcn_readfirstlane(cnt[e]) - rb * BM; if (u.nvalid > BM) u.nvalid = BM;
        u.rows = tok + (size_t)e * CAP + rb * BM;
        u.A = GATHERED ? A : A + (size_t)tile * a_tile; u.B = B + (size_t)e * b_exp + (size_t)pn * b_tile; return true;
    }
};

struct EpiBf16 {
    static constexpr bool PERM = true;
    bf16* O; int ldc; int qscale;
    __device__ __forceinline__ void operator()(const f32x4 (&acc)[2][2][4][2], const Unit& u, int wr, int wc, int fr, int fq) const {
        asm volatile("" : "+v"(fr), "+v"(fq));
        const int row0 = u.pm * BM + wr * 64 + fr, col0 = u.pn * BM + wc * 32 + 8 * fq;
        const float sc = (qscale && (u.pn % 6) < 2) ? 0.125f : 1.0f;
#pragma unroll
        for (int ai = 0; ai < 2; ++ai)
#pragma unroll
            for (int m = 0; m < 4; ++m) { bf16* rowp = O + (size_t)(row0 + ai * HALF + m * 16) * ldc + col0;
#pragma unroll
                for (int bj = 0; bj < 2; ++bj) { const f32x4 v0 = acc[ai][bj][m][0] * sc, v1 = acc[ai][bj][m][1] * sc;
                    v4u w; w.x = cvt_pk_bf16(v0[0], v0[1]); w.y = cvt_pk_bf16(v0[2], v0[3]); w.z = cvt_pk_bf16(v1[0], v1[1]); w.w = cvt_pk_bf16(v1[2], v1[3]);
                    *(v4u*)(rowp + bj * HALF) = w; } }
    }
};
struct EpiScaleBf16 {
    static constexpr bool PERM = true;
    bf16* O; int ldc; const float* scale;
    __device__ __forceinline__ void operator()(const f32x4 (&acc)[2][2][4][2], const Unit& u, int wr, int wc, int fr, int fq) const {
        asm volatile("" : "+v"(fr), "+v"(fq));
        const int row0 = u.pm * BM + wr * 64 + fr, col0 = u.pn * BM + wc * 32 + 8 * fq;
        f32x4 sv[2][2];
#pragma unroll
        for (int bj = 0; bj < 2; ++bj)
#pragma unroll
            for (int n = 0; n < 2; ++n) sv[bj][n] = *(const f32x4*)(scale + col0 + bj * HALF + 4 * n);
#pragma unroll
        for (int ai = 0; ai < 2; ++ai)
#pragma unroll
            for (int m = 0; m < 4; ++m) { bf16* rowp = O + (size_t)(row0 + ai * HALF + m * 16) * ldc + col0;
#pragma unroll
                for (int bj = 0; bj < 2; ++bj) { const f32x4 v0 = acc[ai][bj][m][0] * sv[bj][0], v1 = acc[ai][bj][m][1] * sv[bj][1];
                    v4u w; w.x = cvt_pk_bf16(v0[0], v0[1]); w.y = cvt_pk_bf16(v0[2], v0[3]); w.z = cvt_pk_bf16(v1[0], v1[1]); w.w = cvt_pk_bf16(v1[2], v1[3]);
                    *(v4u*)(rowp + bj * HALF) = w; } }
    }
};
struct EpiResid {
    static constexpr bool PERM = false;
    const float* X; float* Y;
    __device__ __forceinline__ void operator()(const f32x4 (&acc)[2][2][4][2], const Unit& u, int wr, int wc, int fr, int fq) const {
        asm volatile("" : "+v"(fr), "+v"(fq));
        const int row0 = u.pm * BM + wr * 64 + fr, col0 = u.pn * BM + wc * 32 + 4 * fq;
#pragma unroll
        for (int ai = 0; ai < 2; ++ai)
#pragma unroll
            for (int m = 0; m < 4; ++m) { const size_t off = (size_t)(row0 + ai * HALF + m * 16) * D + col0;
#pragma unroll
                for (int bj = 0; bj < 2; ++bj)
#pragma unroll
                    for (int n = 0; n < 2; ++n) { const f32x4 xv = *(const f32x4*)(X + off + bj * HALF + n * 16); *(f32x4*)(Y + off + bj * HALF + n * 16) = xv * ALPHA + acc[ai][bj][m][n]; } }
    }
};
struct EpiResidLN {
    static constexpr bool PERM = true;
    const float* X32; const bf16* Xb; const float* st; const float* g; const float* b; bf16* Y; float* pst; int mode;
    __device__ __forceinline__ void operator()(const f32x4 (&acc)[2][2][4][2], const Unit& u, int wr, int wc, int fr, int fq) const {
        asm volatile("" : "+v"(fr), "+v"(fq));
        const int row0 = u.pm * BM + wr * 64 + fr, col0 = u.pn * BM + wc * 32 + 8 * fq, lane = fq * 16 + fr;
#pragma unroll
        for (int ai = 0; ai < 2; ++ai) {
            v4u xr[4][2];
#pragma unroll
            for (int m = 0; m < 4; ++m)
#pragma unroll
                for (int bj = 0; bj < 2; ++bj) xr[m][bj] = *(const v4u*)(Xb + (size_t)(row0 + ai * HALF + m * 16) * D + col0 + bj * HALF);
            asm volatile("" : "+v"(xr[0][0]), "+v"(xr[0][1]), "+v"(xr[1][0]), "+v"(xr[1][1]), "+v"(xr[2][0]), "+v"(xr[2][1]), "+v"(xr[3][0]), "+v"(xr[3][1]));
#pragma unroll
            for (int m = 0; m < 4; ++m) { const int row = row0 + ai * HALF + m * 16; const size_t off = (size_t)row * D + col0;
                float sm = 0.f, sq = 0.f;
#pragma unroll
                for (int bj = 0; bj < 2; ++bj) { const v4u xv = xr[m][bj];
                    const f32x4 x0 = (f32x4){bflo(xv.x), bfhi(xv.x), bflo(xv.y), bfhi(xv.y)}, x1 = (f32x4){bflo(xv.z), bfhi(xv.z), bflo(xv.w), bfhi(xv.w)};
                    const f32x4 y0 = x0 * ALPHA + acc[ai][bj][m][0], y1 = x1 * ALPHA + acc[ai][bj][m][1];
                    v4u w; w.x = cvt_pk_bf16(y0[0], y0[1]); w.y = cvt_pk_bf16(y0[2], y0[3]); w.z = cvt_pk_bf16(y1[0], y1[1]); w.w = cvt_pk_bf16(y1[2], y1[3]);
                    *(v4u*)(Y + off + bj * HALF) = w;
                    sm += ((y0[0] + y0[1]) + (y0[2] + y0[3])) + ((y1[0] + y1[1]) + (y1[2] + y1[3]));
                    sq += ((y0[0] * y0[0] + y0[1] * y0[1]) + (y0[2] * y0[2] + y0[3] * y0[3])) + ((y1[0] * y1[0] + y1[1] * y1[1]) + (y1[2] * y1[2] + y1[3] * y1[3])); }
                sm = sum_fq(sm); sq = sum_fq(sq);
                if (fq == 0) *(f32x2*)(pst + ((size_t)row * 32 + u.pn * 4 + wc) * 2) = (f32x2){sm, sq}; } }
    }
};
struct EpiConvIn {
    static constexpr bool PERM = true;
    bf16* UC; bf16* BGp;
    __device__ __forceinline__ void operator()(const f32x4 (&acc)[2][2][4][2], const Unit& u, int wr, int wc, int fr, int fq) const {
        asm volatile("" : "+v"(fr), "+v"(fq));
        const int row0 = u.pm * BM + wr * 64 + fr, cw = wc * 32 + 8 * fq;
        if (u.pn < 16) {
#pragma unroll
            for (int ai = 0; ai < 2; ++ai)
#pragma unroll
                for (int m = 0; m < 4; ++m) { bf16* rowp = UC + (size_t)(row0 + ai * HALF + m * 16) * D + u.pn * HALF + cw;
                    const f32x4 v0 = acc[ai][0][m][0] * acc[ai][1][m][0], v1 = acc[ai][0][m][1] * acc[ai][1][m][1];
                    v4u w; w.x = cvt_pk_bf16(v0[0], v0[1]); w.y = cvt_pk_bf16(v0[2], v0[3]); w.z = cvt_pk_bf16(v1[0], v1[1]); w.w = cvt_pk_bf16(v1[2], v1[3]);
                    *(v4u*)rowp = w; }
        } else {
#pragma unroll
            for (int ai = 0; ai < 2; ++ai)
#pragma unroll
                for (int m = 0; m < 4; ++m) { bf16* rowp = BGp + (size_t)(row0 + ai * HALF + m * 16) * D + (u.pn - 16) * BM + cw;
#pragma unroll
                    for (int bj = 0; bj < 2; ++bj) { const f32x4 v0 = acc[ai][bj][m][0], v1 = acc[ai][bj][m][1];
                        v4u w; w.x = cvt_pk_bf16(v0[0], v0[1]); w.y = cvt_pk_bf16(v0[2], v0[3]); w.z = cvt_pk_bf16(v1[0], v1[1]); w.w = cvt_pk_bf16(v1[2], v1[3]);
                        *(v4u*)(rowp + bj * HALF) = w; } }
        }
    }
};
__device__ __forceinline__ f32x4 silu_mul(f32x4 g, f32x4 uu) {
    f32x4 r;
#pragma unroll
    for (int j = 0; j < 4; ++j) r[j] = g[j] * __builtin_amdgcn_rcpf(1.0f + __expf(-g[j])) * uu[j];
    return r;
}
struct EpiExpertGU {
    static constexpr bool PERM = true;
    bf16* H;
    __device__ __forceinline__ void operator()(const f32x4 (&acc)[2][2][4][2], const Unit& u, int wr, int wc, int fr, int fq) const {
        asm volatile("" : "+v"(fr), "+v"(fq));
        const float* gates = (const float*)((const char*)u.rows + (WS_LGATE - WS_LTOK));
        const int cw = wc * 32 + 8 * fq;
        float gtv[2][4];
#pragma unroll
        for (int ai = 0; ai < 2; ++ai)
#pragma unroll
            for (int m = 0; m < 4; ++m) { const int r = ai * HALF + wr * 64 + m * 16 + fr; gtv[ai][m] = gates[r < u.nvalid ? r : 0]; }
        asm volatile("" : "+v"(gtv[0][0]), "+v"(gtv[0][1]), "+v"(gtv[0][2]), "+v"(gtv[0][3]), "+v"(gtv[1][0]), "+v"(gtv[1][1]), "+v"(gtv[1][2]), "+v"(gtv[1][3]));
#pragma unroll
        for (int ai = 0; ai < 2; ++ai)
#pragma unroll
            for (int m = 0; m < 4; ++m) { const int r = ai * HALF + wr * 64 + m * 16 + fr;
                if (r < u.nvalid) { const float gt = gtv[ai][m]; const unsigned pid = 0u;
                    const f32x4 v0 = silu_mul(acc[ai][0][m][0], acc[ai][1][m][0]) * gt, v1 = silu_mul(acc[ai][0][m][1], acc[ai][1][m][1]) * gt;
                    v4u w; w.x = cvt_pk_bf16(v0[0], v0[1]); w.y = cvt_pk_bf16(v0[2], v0[3]); w.z = cvt_pk_bf16(v1[0], v1[1]); w.w = cvt_pk_bf16(v1[2], v1[3]);
                    (void)pid; *(v4u*)(H + (size_t)(u.aux + r) * EDIM + cw) = w; } }
    }
};
struct EpiSharedGU {
    static constexpr bool PERM = true;
    bf16* HS;
    __device__ __forceinline__ void operator()(const f32x4 (&acc)[2][2][4][2], const Unit& u, int wr, int wc, int fr, int fq) const {
        asm volatile("" : "+v"(fr), "+v"(fq));
        const int row0 = u.pm * BM + wr * 64 + fr, cw = u.pn * HALF + wc * 32 + 8 * fq;
#pragma unroll
        for (int ai = 0; ai < 2; ++ai)
#pragma unroll
            for (int m = 0; m < 4; ++m) {
                const f32x4 v0 = silu_mul(acc[ai][0][m][0], acc[ai][1][m][0]), v1 = silu_mul(acc[ai][0][m][1], acc[ai][1][m][1]);
                v4u w; w.x = cvt_pk_bf16(v0[0], v0[1]); w.y = cvt_pk_bf16(v0[2], v0[3]); w.z = cvt_pk_bf16(v1[0], v1[1]); w.w = cvt_pk_bf16(v1[2], v1[3]);
                *(v4u*)(HS + (size_t)(row0 + ai * HALF + m * 16) * SDIM + cw) = w; }
    }
};
struct EpiDownY {
    static constexpr bool PERM = true;
    bf16* Y;
    __device__ __forceinline__ void operator()(const f32x4 (&acc)[2][2][4][2], const Unit& u, int wr, int wc, int fr, int fq) const {
        asm volatile("" : "+v"(fr), "+v"(fq));
        const int col0 = u.pn * BM + wc * 32 + 8 * fq;
#pragma unroll
        for (int ai = 0; ai < 2; ++ai)
#pragma unroll
            for (int m = 0; m < 4; ++m) { const int r = ai * HALF + wr * 64 + m * 16 + fr; bf16* rowp = Y + (size_t)(u.aux + r) * D + col0;
#pragma unroll
                for (int bj = 0; bj < 2; ++bj) { const f32x4 v0 = acc[ai][bj][m][0], v1 = acc[ai][bj][m][1];
                    v4u w; w.x = cvt_pk_bf16(v0[0], v0[1]); w.y = cvt_pk_bf16(v0[2], v0[3]); w.z = cvt_pk_bf16(v1[0], v1[1]); w.w = cvt_pk_bf16(v1[2], v1[3]);
                    *(v4u*)(rowp + bj * HALF) = w; } }
    }
};
}

struct Args { const float* in[19]; float* out; unsigned char* ws; int ph_lo, ph_hi; };
struct Frame {
    LAS unsigned char* lds; unsigned* ctl; unsigned char* ws;
    int tid, lane, wave, G, bid;
};
enum { IN_X = 0, IN_RELB, IN_PWIN, IN_PWG, IN_PSC, IN_PWOUT, IN_DQKV, IN_DOUT, IN_CWIN, IN_CW, IN_CWOUT, IN_LNG, IN_LNB, IN_RW, IN_RB, IN_EGU, IN_ED, IN_SGU, IN_SD };

#define CAS __attribute__((address_space(4)))
typedef const CAS unsigned char* KP;
__device__ __forceinline__ const float* ain(KP kp, int i) { return (const float*)((const GAS float* const CAS*)kp)[i]; }
__device__ __forceinline__ float* aout(KP kp) { return (float*)((GAS float* const CAS*)kp)[19]; }
__device__ __forceinline__ void tr_item(const float* W, int K, int N, bf16* WT, int dstK, int mode, LAS float* scr, int item, int lane) {
    const int nblk = N / 32, kb = item / nblk, nb = item % nblk, k0 = 64 * kb, n0 = 32 * nb;
    int r0 = n0;
    if (mode == 1) { const int part = n0 / 2048, j = n0 % 2048; r0 = (part == 0) ? 4096 + j : 256 * (j / 128) + (part == 2 ? 128 : 0) + (j % 128); }
    if (mode == 2) { const int part = n0 / 256, j = n0 % 256; r0 = 256 * (j / 128) + 128 * part + (j % 128); }
    float wv[32];
#pragma unroll
    for (int i = 0; i < 32; ++i) { const int kk = 2 * i + (lane >> 5); wv[i] = __builtin_nontemporal_load(W + (size_t)(k0 + kk) * N + n0 + (lane & 31)); }
#pragma unroll
    for (int i = 0; i < 32; ++i) { const int kk = 2 * i + (lane >> 5); scr[kk * 33 + (lane & 31)] = wv[i]; }
    LDS_WAIT(); asm volatile("" ::: "memory");
    const int c = lane & 7;
#pragma unroll
    for (int j = 0; j < 4; ++j) { const int n = (lane >> 3) + 8 * j; const LAS float* s = scr + (8 * c) * 33 + n;
        v4u o; o.x = pk2(s[0 * 33], s[1 * 33]); o.y = pk2(s[2 * 33], s[3 * 33]); o.z = pk2(s[4 * 33], s[5 * 33]); o.w = pk2(s[6 * 33], s[7 * 33]);
        __builtin_nontemporal_store(o, (v4u*)(WT + (size_t)(r0 + n) * dstK + k0 + 8 * c)); }
    LDS_WAIT(); asm volatile("" ::: "memory");
}
__device__ __forceinline__ void phase_prologue(const Frame& F, KP kp) {
    LAS float* scr = (LAS float*)(F.lds + F.wave * 16384);
    const int gw = F.bid * 8 + F.wave, NGW = F.G * 8;
    constexpr int I0 = 2 * 2048, I1 = 8 * 128, I2 = 2 * 2048, I3 = 4608, I4 = 512, I5 = 6144, I6 = 2048, I7 = 4 * 512, I8 = 4 * 256, I9 = 256 * 256, I10 = 256 * 128;
    constexpr int NITEMS = I0 + I1 + I2 + I3 + I4 + I5 + I6 + I7 + I8 + I9 + I10;
    unsigned char* ws = F.ws;
    for (int it = gw; it < NITEMS; it += NGW) {
        int r = it;
        if (r < I0) { const int b = r / 2048; tr_item(ain(kp, IN_PWIN) + (size_t)b * D * D, D, D, (bf16*)(ws + WS_W_POOL_IN) + (size_t)b * D * D, D, 0, scr, r % 2048, F.lane); continue; } r -= I0;
        if (r < I1) { const int b = r / 128; tr_item(ain(kp, IN_PWG) + (size_t)b * 512 * 512, 512, 512, (bf16*)(ws + WS_W_POOL_G) + (size_t)b * 512 * 512, 512, 0, scr, r % 128, F.lane); continue; } r -= I1;
        if (r < I2) { const int b = r / 2048; tr_item(ain(kp, IN_PWOUT) + (size_t)b * D * D, D, D, (bf16*)(ws + WS_W_POOL_OUT) + (size_t)b * D * D, D, 0, scr, r % 2048, F.lane); continue; } r -= I2;
        if (r < I3) { tr_item(ain(kp, IN_DQKV), D, QKVC, (bf16*)(ws + WS_W_DIL_QKV), D, 0, scr, r, F.lane); continue; } r -= I3;
        if (r < I4) { tr_item(ain(kp, IN_DOUT), DILW, D, (bf16*)(ws + WS_W_DIL_OUT), DILW, 0, scr, r, F.lane); continue; } r -= I4;
        if (r < I5) { tr_item(ain(kp, IN_CWIN), D, 3 * D, (bf16*)(ws + WS_W_CONV_IN), D, 1, scr, r, F.lane); continue; } r -= I5;
        if (r < I6) { tr_item(ain(kp, IN_CWOUT), D, D, (bf16*)(ws + WS_W_CONV_OUT), D, 0, scr, r, F.lane); continue; } r -= I6;
        if (r < I7) { const int b = r / 512; tr_item(ain(kp, IN_SGU) + (size_t)b * D * 512, D, 512, (bf16*)(ws + WS_W_SH_GU) + (size_t)b * 512 * D, D, 2, scr, r % 512, F.lane); continue; } r -= I7;
        if (r < I8) { const int b = r / 256; tr_item(ain(kp, IN_SD) + (size_t)b * SDIM * D, SDIM, D, (bf16*)(ws + WS_W_SH_D) + (size_t)b * D * SDIM, SDIM, 0, scr, r % 256, F.lane); continue; } r -= I8;
        if (r < I9) { const int b = r / 256; tr_item(ain(kp, IN_EGU) + (size_t)b * D * 256, D, 256, (bf16*)(ws + WS_W_EX_GU) + (size_t)b * 256 * D, D, 0, scr, r % 256, F.lane); continue; } r -= I9;
        { const int b = r / 128; tr_item(ain(kp, IN_ED) + (size_t)b * EDIM * D, EDIM, D, (bf16*)(ws + WS_W_EX_D) + (size_t)b * D * EDIM, EDIM, 0, scr, r % 128, F.lane); }
    }
    const size_t gt = (size_t)F.bid * 512 + F.tid, GT = (size_t)F.G * 512;
    { const float* rw = ain(kp, IN_RW); bf16* wh = (bf16*)(ws + WS_RWH); bf16* wl = (bf16*)(ws + WS_RWL);
      for (size_t i = gt; i < (size_t)DEPTH * NEXP * D / 8; i += GT) { const size_t k8 = i % (D / 8), e = (i / (D / 8)) % NEXP, l = i / ((size_t)NEXP * D / 8);
          float v[8]; unsigned hi[8], lo[8];
#pragma unroll
          for (int j = 0; j < 8; ++j) { v[j] = rw[(l * D + k8 * 8 + j) * NEXP + e]; hi[j] = f2bf(v[j]); lo[j] = f2bf(v[j] - __builtin_bit_cast(float, hi[j] << 16)); }
          v4u a, b2; a.x = hi[0] | (hi[1] << 16); a.y = hi[2] | (hi[3] << 16); a.z = hi[4] | (hi[5] << 16); a.w = hi[6] | (hi[7] << 16);
          b2.x = lo[0] | (lo[1] << 16); b2.y = lo[2] | (lo[3] << 16); b2.z = lo[4] | (lo[5] << 16); b2.w = lo[6] | (lo[7] << 16);
          *(v4u*)(wh + (l * NEXP + e) * D + k8 * 8) = a; *(v4u*)(wl + (l * NEXP + e) * D + k8 * 8) = b2; } }
    const float* x = ain(kp, IN_X); bf16* xb = (bf16*)(ws + WS_XB);
    for (size_t i0 = gt; i0 < (size_t)T * D / 8; i0 += 4 * GT) {
        f32x4 pp[4], qq[4];
#pragma unroll
        for (int u = 0; u < 4; ++u) { size_t i = i0 + u * GT; i = i < (size_t)T * D / 8 ? i : i0; pp[u] = __builtin_nontemporal_load((const f32x4*)(x + i * 8)); qq[u] = __builtin_nontemporal_load((const f32x4*)(x + i * 8 + 4)); }
        asm volatile("" : "+v"(pp[0]), "+v"(pp[1]), "+v"(pp[2]), "+v"(pp[3]), "+v"(qq[0]), "+v"(qq[1]), "+v"(qq[2]), "+v"(qq[3]));
#pragma unroll
        for (int u = 0; u < 4; ++u) { const size_t i = i0 + u * GT; if (i >= (size_t)T * D / 8) continue; const f32x4 p = pp[u], q = qq[u];
            v4u w; w.x = pk2(p[0], p[1]); w.y = pk2(p[2], p[3]); w.z = pk2(q[0], q[1]); w.w = pk2(q[2], q[3]); *(v4u*)(xb + i * 8) = w; } }
}

__device__ __forceinline__ void unpack8(const v4u w, float (&f)[8]) { f[0] = bflo(w.x); f[1] = bfhi(w.x); f[2] = bflo(w.y); f[3] = bfhi(w.y); f[4] = bflo(w.z); f[5] = bfhi(w.z); f[6] = bflo(w.w); f[7] = bfhi(w.w); }
__device__ __forceinline__ void phase_pool(const Frame& F, const bf16* U, bf16* PL) {
    for (int it = F.bid * 512 + F.tid; it < (T / 32) * 256; it += F.G * 512) {
        const int cv = it & 255, ch = it >> 8, col = cv * 8;
        const int w = __builtin_amdgcn_readfirstlane(2 << (col >> 9));
        const int row0 = __builtin_amdgcn_readfirstlane(ch * 32), pos0 = row0 & (SEQ - 1);
        float s[8], uu[8];
#pragma unroll
        for (int j = 0; j < 8; ++j) s[j] = 0.f;
        { v4u pre[15];
#pragma unroll
          for (int j = 0; j < 15; ++j) { pre[j] = (v4u){0u, 0u, 0u, 0u}; if (j + 1 < w && pos0 - (j + 1) >= 0) pre[j] = *(const v4u*)(U + (size_t)(row0 - (j + 1)) * D + col); }
#pragma unroll
          for (int j = 0; j < 15; ++j) asm volatile("" : "+v"(pre[j]));
#pragma unroll
          for (int j = 0; j < 15; ++j) { unpack8(pre[j], uu);
#pragma unroll
              for (int q = 0; q < 8; ++q) s[q] += uu[q]; } }
#pragma unroll 1
        for (int cb = 0; cb < 4; ++cb) {
            v4u un[8], uo[8];
#pragma unroll
            for (int j = 0; j < 8; ++j) { const int r = 8 * cb + j, t = row0 + r, pos = pos0 + r;
                un[j] = *(const v4u*)(U + (size_t)t * D + col);
                uo[j] = (v4u){0u, 0u, 0u, 0u}; if (pos - w + 1 >= 0) uo[j] = *(const v4u*)(U + (size_t)(t - w + 1) * D + col); }
#pragma unroll
            for (int j = 0; j < 8; ++j) asm volatile("" : "+v"(un[j]), "+v"(uo[j]));
#pragma unroll
            for (int j = 0; j < 8; ++j) { const int r = 8 * cb + j, t = row0 + r, pos = pos0 + r;
                unpack8(un[j], uu);
                const float inv = 1.0f / (float)((pos + 1) < w ? (pos + 1) : w);
                float o[8];
#pragma unroll
                for (int q = 0; q < 8; ++q) { s[q] += uu[q]; o[q] = s[q] * inv - uu[q]; }
                v4u ww; ww.x = pk2(o[0], o[1]); ww.y = pk2(o[2], o[3]); ww.z = pk2(o[4], o[5]); ww.w = pk2(o[6], o[7]);
                *(v4u*)(PL + (size_t)t * D + col) = ww;
                unpack8(uo[j], uu);
#pragma unroll
                for (int q = 0; q < 8; ++q) s[q] -= uu[q]; }
        }
    }
}

__device__ __forceinline__ void phase_conv(const Frame& F, const bf16* UC, const bf16* BGp, const float* cw, bf16* Z) {
    for (int it = F.bid * 512 + F.tid; it < (T / 4) * 256; it += F.G * 512) {
        const int cv = it & 255, col = cv * 8, t0 = __builtin_amdgcn_readfirstlane((it >> 8) * 4), pos0 = t0 & (SEQ - 1);
        v4u ur[6], br[4];
#pragma unroll
        for (int j = 0; j < 6; ++j) { ur[j] = (v4u){0u, 0u, 0u, 0u}; if (j >= 2 || pos0 > 0) ur[j] = *(const v4u*)(UC + (size_t)(t0 - 2 + j) * D + col); }
#pragma unroll
        for (int j = 0; j < 4; ++j) br[j] = *(const v4u*)(BGp + (size_t)(t0 + j) * D + col);
        const f32x4 c0a = *(const f32x4*)(cw + col), c0b = *(const f32x4*)(cw + col + 4), c1a = *(const f32x4*)(cw + D + col), c1b = *(const f32x4*)(cw + D + col + 4), c2a = *(const f32x4*)(cw + 2 * D + col), c2b = *(const f32x4*)(cw + 2 * D + col + 4);
        asm volatile("" : "+v"(ur[0]), "+v"(ur[1]), "+v"(ur[2]), "+v"(ur[3]), "+v"(ur[4]), "+v"(ur[5]), "+v"(br[0]), "+v"(br[1]), "+v"(br[2]), "+v"(br[3]));
        const float c0[8] = {c0a[0], c0a[1], c0a[2], c0a[3], c0b[0], c0b[1], c0b[2], c0b[3]}, c1[8] = {c1a[0], c1a[1], c1a[2], c1a[3], c1b[0], c1b[1], c1b[2], c1b[3]}, c2[8] = {c2a[0], c2a[1], c2a[2], c2a[3], c2b[0], c2b[1], c2b[2], c2b[3]};
#pragma unroll
        for (int j = 0; j < 4; ++j) { float u0[8], u1[8], u2[8], bb[8], o[8];
            unpack8(ur[j], u0); unpack8(ur[j + 1], u1); unpack8(ur[j + 2], u2); unpack8(br[j], bb);
#pragma unroll
            for (int q = 0; q < 8; ++q) o[q] = bb[q] * (c0[q] * u0[q] + c1[q] * u1[q] + c2[q] * u2[q]);
            v4u ww; ww.x = pk2(o[0], o[1]); ww.y = pk2(o[2], o[3]); ww.z = pk2(o[4], o[5]); ww.w = pk2(o[6], o[7]);
            *(v4u*)(Z + (size_t)(t0 + j) * D + col) = ww; }
    }
}

__device__ __forceinline__ int t5_bucket(int dist) {
    if (dist < 16) return dist;
    int large = 16 + (int)(logf((float)dist / 16.0f) / logf(128.0f) * 16.0f);
    return large < 31 ? large : 31;
}
constexpr int AT_KS = 0, AT_KSTR = 144, AT_VT = 256 * 144, AT_VSTR = 520, AT_BIAS = AT_VT + 64 * 520;
__device__ __forceinline__ void phase_attn(const Frame& F, const bf16* QKV, const float* relb, bf16* OG, float* LSE) {
    LAS unsigned char* lds = F.lds;
    const int tid = F.tid, lane = F.lane, w = tid >> 6, fr = lane & 15, fq = lane >> 4;
    for (int unit = F.bid; unit < NBATCH * 3 * 8 * 16; unit += F.G) {
        const int cmb = unit & 15, h = (unit >> 4) & 7, g = (unit >> 7) % 3, b = unit / 384;
        const int dsh = 2 * g, dil = 1 << dsh, r = cmb & (dil - 1), nb = cmb >> dsh;
        const bf16* base = QKV + (size_t)b * SEQ * QKVC + g * 1536 + h * 64;
        __syncthreads();
        {
            const int key = tid >> 1, half = tid & 1, jk = (nb - 1) * 128 + key;
            v4u kv[4], vv[4];
            if (jk >= 0) { const bf16* rp = base + (size_t)(jk * dil + r) * QKVC + half * 32;
#pragma unroll
                for (int i = 0; i < 4; ++i) { kv[i] = *(const v4u*)(rp + 512 + 8 * i); vv[i] = *(const v4u*)(rp + 1024 + 8 * i); } }
            else {
#pragma unroll
                for (int i = 0; i < 4; ++i) { kv[i] = (v4u){0u, 0u, 0u, 0u}; vv[i] = (v4u){0u, 0u, 0u, 0u}; } }
#pragma unroll
            for (int i = 0; i < 4; ++i) *(LAS v4u*)(lds + AT_KS + key * AT_KSTR + half * 64 + 16 * i) = kv[i];
#pragma unroll
            for (int i = 0; i < 4; ++i) {
                const unsigned ww[4] = {vv[i].x, vv[i].y, vv[i].z, vv[i].w};
#pragma unroll
                for (int q = 0; q < 4; ++q) { const int d = half * 32 + 8 * i + 2 * q;
                    *(LAS unsigned short*)(lds + AT_VT + d * AT_VSTR + key * 2) = (unsigned short)(ww[q] & 0xffffu);
                    *(LAS unsigned short*)(lds + AT_VT + (d + 1) * AT_VSTR + key * 2) = (unsigned short)(ww[q] >> 16); } }
            if (tid <= 128) ((LAS float*)(lds + AT_BIAS))[tid] = relb[t5_bucket(tid * dil) * 24 + g * 8 + h];
        }
        __syncthreads();
        int qi = 16 * w + fr; asm volatile("" : "+v"(qi));
        const int jq = nb * 128 + qi, tq = jq * dil + r;
        const bf16* qp = base + (size_t)tq * QKVC + 8 * fq;
        const bf16x8 q0 = *(const bf16x8*)qp, q1 = *(const bf16x8*)(qp + 32);
        f32x4 s[9]; float mx = -INFINITY;
        int dq = fr - 4 * fq; asm volatile("" : "+v"(dq));
        const LAS float* bl = (const LAS float*)(lds + AT_BIAS) + dq;
#pragma unroll
        for (int kt = 0; kt < 9; ++kt) {
            const int kb = 16 * (w + kt);
            const bf16x8 k0 = *(const LAS bf16x8*)(lds + AT_KS + (kb + fr) * AT_KSTR + fq * 16), k1 = *(const LAS bf16x8*)(lds + AT_KS + (kb + fr) * AT_KSTR + 64 + fq * 16);
            f32x4 a = (f32x4){0.f, 0.f, 0.f, 0.f};
            a = __builtin_amdgcn_mfma_f32_16x16x32_bf16(k0, q0, a, 0, 0, 0);
            a = __builtin_amdgcn_mfma_f32_16x16x32_bf16(k1, q1, a, 0, 0, 0);
            const bool tv = (nb > 0) || (w + kt >= 8);
#pragma unroll
            for (int i = 0; i < 4; ++i) { const int d = dq - i, rel = 128 - 16 * kt + d;
                bool ok = tv; int rc = rel;
                if (kt == 0) { ok = ok && d <= 0; rc = rel > 128 ? 128 : rel; }
                if (kt == 8) { ok = ok && d >= 0; rc = rel < 0 ? 0 : rel; }
                float bv_ = (kt == 0 || kt == 8) ? ((const LAS float*)(lds + AT_BIAS))[rc] : bl[128 - 16 * kt - i]; asm volatile("" : "+v"(bv_));
                const float v = ok ? a[i] + bv_ : -INFINITY;
                a[i] = v; mx = fmaxf(mx, v); }
            s[kt] = a;
        }
        mx = max_fq(mx);
        float l = 0.f;
#pragma unroll
        for (int kt = 0; kt < 9; ++kt)
#pragma unroll
            for (int i = 0; i < 4; ++i) { const float p = __expf(s[kt][i] - mx); s[kt][i] = p; l += p; }
        l = sum_fq(l);
        f32x4 o[4];
#pragma unroll
        for (int nt = 0; nt < 4; ++nt) o[nt] = (f32x4){0.f, 0.f, 0.f, 0.f};
#pragma unroll
        for (int st = 0; st < 5; ++st) {
            const int kt0 = 2 * st, kt1 = 2 * st + 1;
            v4u pw; pw.x = pk2(s[kt0][0], s[kt0][1]); pw.y = pk2(s[kt0][2], s[kt0][3]);
            if (kt1 < 9) { pw.z = pk2(s[kt1 < 9 ? kt1 : 0][0], s[kt1 < 9 ? kt1 : 0][1]); pw.w = pk2(s[kt1 < 9 ? kt1 : 0][2], s[kt1 < 9 ? kt1 : 0][3]); } else { pw.z = 0u; pw.w = 0u; }
            const bf16x8 pf = __builtin_bit_cast(bf16x8, pw);
            const int kb0 = 16 * (w + kt0) + 4 * fq, kb1 = 16 * (w + kt1) + 4 * fq;
#pragma unroll
            for (int nt = 0; nt < 4; ++nt) { const int d = 16 * nt + fr;
                v2u va = *(const LAS v2u*)(lds + AT_VT + d * AT_VSTR + kb0 * 2), vb = (v2u){0u, 0u};
                if (kt1 < 9) vb = *(const LAS v2u*)(lds + AT_VT + d * AT_VSTR + kb1 * 2);
                v4u vw; vw.x = va.x; vw.y = va.y; vw.z = vb.x; vw.w = vb.y;
                o[nt] = __builtin_amdgcn_mfma_f32_16x16x32_bf16(__builtin_bit_cast(bf16x8, vw), pf, o[nt], 0, 0, 0); }
        }
        const float il = 1.0f / l;
        bf16* op = OG + ((size_t)g * T + (size_t)b * SEQ + tq) * DILW + h * 64 + 4 * fq;
#pragma unroll
        for (int nt = 0; nt < 4; ++nt) { v2u ww; ww.x = pk2(o[nt][0] * il, o[nt][1] * il); ww.y = pk2(o[nt][2] * il, o[nt][3] * il); *(v2u*)(op + 16 * nt) = ww; }
        if (fq == 0) LSE[((size_t)g * T + (size_t)b * SEQ + tq) * 8 + h] = mx + logf(l);
    }
}
__device__ __forceinline__ void phase_combine(const Frame& F, const bf16* OG, const float* LSE, bf16* O) {
    for (int it0 = F.bid * 512 + F.tid; it0 < T * 64; it0 += 4 * F.G * 512) {
        float ls[4][3]; v4u og[4][3];
#pragma unroll
        for (int u = 0; u < 4; ++u) { int it = it0 + u * F.G * 512; it = it < T * 64 ? it : it0;
            const int c8 = it & 7, h = (it >> 3) & 7, t = it >> 6; const size_t off = (size_t)t * DILW + h * 64 + c8 * 8;
#pragma unroll
            for (int g = 0; g < 3; ++g) { ls[u][g] = LSE[((size_t)g * T + t) * 8 + h]; og[u][g] = *(const v4u*)(OG + (size_t)g * T * DILW + off); } }
#pragma unroll
        for (int u = 0; u < 4; ++u) asm volatile("" : "+v"(ls[u][0]), "+v"(ls[u][1]), "+v"(ls[u][2]), "+v"(og[u][0]), "+v"(og[u][1]), "+v"(og[u][2]));
#pragma unroll
        for (int u = 0; u < 4; ++u) { const int it = it0 + u * F.G * 512, c8 = it & 7, h = (it >> 3) & 7, t = it >> 6; const size_t off = (size_t)t * DILW + h * 64 + c8 * 8;
            if (it >= T * 64) continue;
            const float l0 = ls[u][0], l1 = ls[u][1], l2 = ls[u][2];
            const float m = fmaxf(l0, fmaxf(l1, l2)); float w0 = __expf(l0 - m), w1 = __expf(l1 - m), w2 = __expf(l2 - m); const float inv = 1.0f / (w0 + w1 + w2); w0 *= inv; w1 *= inv; w2 *= inv;
            float a[8], bq[8], c[8], o[8];
            unpack8(og[u][0], a); unpack8(og[u][1], bq); unpack8(og[u][2], c);
#pragma unroll
            for (int q = 0; q < 8; ++q) o[q] = w0 * a[q] + w1 * bq[q] + w2 * c[q];
            v4u ww; ww.x = pk2(o[0], o[1]); ww.y = pk2(o[2], o[3]); ww.z = pk2(o[4], o[5]); ww.w = pk2(o[6], o[7]);
            *(v4u*)(O + off) = ww; }
    }
}

constexpr int M1_LOG = 131072, M1_STAT = M1_LOG + 4096, M1_HIST = M1_STAT + 128, M1_BASE = M1_HIST + 256;
__device__ __forceinline__ void phase_moe1(const Frame& F, const float* Y, const float* gain, const float* bias, const float* RW, const float* RB,
                                           float* X1F, bf16* X1B, unsigned* cnt, int* ltok, float* lgate, int* eidx, int* inv) {
    LAS float* xs = (LAS float*)F.lds; LAS float* logit = (LAS float*)(F.lds + M1_LOG); LAS float* stat = (LAS float*)(F.lds + M1_STAT);
    LAS int* hist = (LAS int*)(F.lds + M1_HIST); LAS int* basep = (LAS int*)(F.lds + M1_BASE);
    const int tid = F.tid, lane = F.lane, w = F.wave;
    for (int rg = F.bid; rg < T / 16; rg += F.G) {
        const int row0 = rg * 16;
        __syncthreads();
#pragma unroll
        for (int j = 0; j < 16; ++j) { const int idx = tid + 512 * j; *(LAS f32x4*)(xs + idx * 4) = *(const f32x4*)(Y + (size_t)row0 * D + (size_t)idx * 4); }
        if (tid < 64) hist[tid] = 0;
        __syncthreads();
#pragma unroll
        for (int rr = 0; rr < 2; ++rr) { const int r = 2 * w + rr; float sm = 0.f;
#pragma unroll
            for (int j = 0; j < 32; ++j) sm += xs[r * D + lane + 64 * j];
            const float mean = wave_sum(sm, lane) * (1.0f / D); float sq = 0.f;
#pragma unroll
            for (int j = 0; j < 32; ++j) { const float d = xs[r * D + lane + 64 * j] - mean; sq += d * d; }
            const float rstd = 1.0f / sqrtf(wave_sum(sq, lane) * (1.0f / D) + LN_EPS);
            if (lane == 0) { stat[2 * r] = mean; stat[2 * r + 1] = rstd; } }
        __syncthreads();
#pragma unroll
        for (int j = 0; j < 16; ++j) { const int idx = tid + 512 * j, r = idx >> 9, c4 = (idx & 511) * 4;
            const f32x4 v = *(LAS f32x4*)(xs + idx * 4), gv = *(const f32x4*)(gain + c4), bv = *(const f32x4*)(bias + c4);
            const float mean = stat[2 * r], rstd = stat[2 * r + 1];
            const f32x4 o = (v - mean) * rstd * gv + bv;
            *(LAS f32x4*)(xs + idx * 4) = o;
            *(f32x4*)(X1F + (size_t)(row0 + r) * D + c4) = o;
            v2u wb; wb.x = pk2(o[0], o[1]); wb.y = pk2(o[2], o[3]); *(v2u*)(X1B + (size_t)(row0 + r) * D + c4) = wb; }
        __syncthreads();
        { const int r = tid >> 5, ep = tid & 31; float a0 = 0.f, a1 = 0.f; const float* wp = RW + 2 * ep; const LAS float* xr = xs + r * D;
            for (int k0 = 0; k0 < D; k0 += 16) {
                f32x2 wv[16];
#pragma unroll
                for (int j = 0; j < 16; ++j) wv[j] = *(const f32x2*)(wp + (size_t)(k0 + j) * NEXP);
                asm volatile("" : "+v"(wv[0]), "+v"(wv[1]), "+v"(wv[2]), "+v"(wv[3]), "+v"(wv[4]), "+v"(wv[5]), "+v"(wv[6]), "+v"(wv[7]));
                asm volatile("" : "+v"(wv[8]), "+v"(wv[9]), "+v"(wv[10]), "+v"(wv[11]), "+v"(wv[12]), "+v"(wv[13]), "+v"(wv[14]), "+v"(wv[15]));
#pragma unroll
                for (int j = 0; j < 16; ++j) { const float xv = xr[k0 + j]; a0 += xv * wv[j].x; a1 += xv * wv[j].y; } }
            logit[r * NEXP + 2 * ep] = a0; logit[r * NEXP + 2 * ep + 1] = a1; }
        __syncthreads();
        int sel_pos[2]; float sel_gate[2]; int sel_rank[2]; bool sel_on[2];
#pragma unroll
        for (int rr = 0; rr < 2; ++rr) { const int r = 2 * w + rr;
            const float sc = 1.0f / (1.0f + __expf(-logit[r * NEXP + lane])); const float ch = sc + RB[lane];
            int rk = 0;
#pragma unroll
            for (int j = 0; j < 8; ++j) { const float cj = shfl_from(ch, (lane & ~7) + j); rk += (cj > ch || (cj == ch && j < (lane & 7))) ? 1 : 0; }
            float gs = rk < 2 ? ch : 0.f; gs += shfl_x(gs, 1, lane); gs += shfl_x(gs, 2, lane); gs += shfl_x(gs, 4, lane);
            int grk = 0; const int g = lane >> 3;
#pragma unroll
            for (int hh = 0; hh < 8; ++hh) { const float gh = shfl_from(gs, 8 * hh); grk += (gh > gs || (gh == gs && hh < g)) ? 1 : 0; }
            const float msk = grk < 4 ? ch : -INFINITY;
            int erk = 0;
            for (int j = 0; j < 64; ++j) { const float mj = __builtin_bit_cast(float, __builtin_amdgcn_readlane(__builtin_bit_cast(int, msk), j)); erk += (mj > msk || (mj == msk && j < lane)) ? 1 : 0; }
            const bool on = erk < 8;
            const float ssum = wave_sum(on ? sc : 0.f, lane);
            sel_on[rr] = on; sel_rank[rr] = erk; sel_gate[rr] = sc / ssum * 2.5f; sel_pos[rr] = 0;
            if (on) sel_pos[rr] = __hip_atomic_fetch_add(&hist[lane], 1, __ATOMIC_RELAXED, __HIP_MEMORY_SCOPE_WORKGROUP); }
        __syncthreads();
        if (tid < 64) { const int hc = hist[tid]; int bs = 0; if (hc > 0) bs = (int)atomicAdd(&cnt[tid * 16], (unsigned)hc); basep[tid] = bs; }
        __syncthreads();
#pragma unroll
        for (int rr = 0; rr < 2; ++rr) if (sel_on[rr]) { const int t = row0 + 2 * w + rr, pos = basep[lane] + sel_pos[rr];
            ltok[(size_t)lane * CAP + pos] = t; lgate[(size_t)lane * CAP + pos] = sel_gate[rr];
            eidx[t * 8 + sel_rank[rr]] = lane; inv[t * 8 + sel_rank[rr]] = pos; }
    }
}
__device__ __forceinline__ int build_tiles(const Frame& F, const unsigned* cnt) {
    LAS int* tpref = (LAS int*)(F.lds + LDS_TAB); LAS int* cl = (LAS int*)(F.lds + LDS_TAB + 512);
    __syncthreads();
    if (F.tid < 64) {
        const int lane = F.lane; const int c = (int)__hip_atomic_load(&cnt[lane * 16], __ATOMIC_RELAXED, __HIP_MEMORY_SCOPE_AGENT);
        const int tl = (c + 255) >> 8; int inc = tl;
#pragma unroll
        for (int o = 1; o < 64; o <<= 1) { const int v = __builtin_amdgcn_ds_bpermute((lane >= o ? lane - o : lane) << 2, inc); inc += lane >= o ? v : 0; }
        cl[lane] = c; tpref[lane] = inc - tl;
        if (lane == 63) { tpref[64] = inc; tpref[65] = inc + T / 256; tpref[66] = inc + 2 * (T / 256); cl[64] = T; cl[65] = T; } }
    __syncthreads();
    return __builtin_amdgcn_readfirstlane(tpref[64]);
}
__device__ __forceinline__ void phase_moe4(const Frame& F, const float* Y2, const bf16* Yr, const int* eidx, const int* inv, const float* gain, const float* bias, float* XO, bf16* XBo) {
    const LAS int* tpref = (const LAS int*)(F.lds + LDS_TAB);
    const int gw = F.bid * 8 + F.wave, NGW = F.G * 8, lane = F.lane;
    for (int t = gw; t < T; t += NGW) {
        f32x4 v[8];
#pragma unroll
        for (int j = 0; j < 8; ++j) v[j] = *(const f32x4*)(Y2 + (size_t)t * D + 4 * lane + 256 * j);
        for (int k = 0; k < 8; ++k) { const int e = eidx[t * 8 + k], pos = inv[t * 8 + k]; const bf16* yr = Yr + (size_t)(tpref[e] * 256 + pos) * D + 4 * lane;
#pragma unroll
            for (int j = 0; j < 8; ++j) { const v2u w = *(const v2u*)(yr + 256 * j); v[j][0] += bflo(w.x); v[j][1] += bfhi(w.x); v[j][2] += bflo(w.y); v[j][3] += bfhi(w.y); } }
        float sm = 0.f;
#pragma unroll
        for (int j = 0; j < 8; ++j) sm += (v[j][0] + v[j][1]) + (v[j][2] + v[j][3]);
        const float mean = wave_sum(sm, lane) * (1.0f / D); float sq = 0.f;
#pragma unroll
        for (int j = 0; j < 8; ++j) { v[j] = v[j] - mean; sq += (v[j][0] * v[j][0] + v[j][1] * v[j][1]) + (v[j][2] * v[j][2] + v[j][3] * v[j][3]); }
        const float rstd = 1.0f / sqrtf(wave_sum(sq, lane) * (1.0f / D) + LN_EPS);
#pragma unroll
        for (int j = 0; j < 8; ++j) { const int c = 4 * lane + 256 * j; const f32x4 o = v[j] * rstd * *(const f32x4*)(gain + c) + *(const f32x4*)(bias + c);
            *(f32x4*)(XO + (size_t)t * D + c) = o;
            v2u wb; wb.x = pk2(o[0], o[1]); wb.y = pk2(o[2], o[3]); *(v2u*)(XBo + (size_t)t * D + c) = wb; }
    }
}


template <int CTRL> __device__ __forceinline__ float dppf(float x) { return __builtin_bit_cast(float, __builtin_amdgcn_update_dpp(0, __builtin_bit_cast(int, x), CTRL, 0xF, 0xF, false)); }
__device__ __forceinline__ float gmax8(float x) { x = fmaxf(x, dppf<0xB1>(x)); x = fmaxf(x, dppf<0x4E>(x)); x = fmaxf(x, dppf<0x141>(x)); return x; }
__device__ __forceinline__ float gsum8(float x) { x += dppf<0xB1>(x); x += dppf<0x4E>(x); x += dppf<0x141>(x); return x; }
__device__ __forceinline__ float rl_f(float x, int l) { return __builtin_bit_cast(float, __builtin_amdgcn_readlane(__builtin_bit_cast(int, x), l)); }
constexpr int M1_P = 0, M1N_HIST = 131072, M1N_BASE = 131072 + 256, M1N_GB = 131072 + 1024;
__device__ __forceinline__ void phase_moe1n(const Frame& F, const bf16* Y, const float* pst, const float* gain, const float* bias, const bf16* WH, const bf16* WL, const float* RB,
                                            bf16* X1B, float* ST1, unsigned* cnt, int* ltok, float* lgate, int* eidx, int* inv) {
    LAS float* P = (LAS float*)(F.lds + M1_P); LAS int* hist = (LAS int*)(F.lds + M1N_HIST); LAS int* basep = (LAS int*)(F.lds + M1N_BASE);
    const int tid = F.tid, lane = F.lane, w = F.wave, r = lane & 15, q = lane >> 4;
    for (int item = F.bid; item < T / 64; item += F.G) {
        const int row0 = item * 64;
        __syncthreads();
        { int t0 = tid; asm volatile("" : "+v"(t0));
          if (t0 < 64) hist[t0] = 0;
          LAS f32x4* gb = (LAS f32x4*)(F.lds + M1N_GB); gb[t0] = *(const f32x4*)(gain + 4 * t0); gb[512 + t0] = *(const f32x4*)(bias + 4 * t0); }
        __syncthreads();
        float mean[4], rstd[4];
#pragma unroll
        for (int rt = 0; rt < 4; ++rt) { const int row = row0 + 16 * rt + r;
          const f32x4* pp = (const f32x4*)(pst + ((size_t)row * 32 + q * 8) * 2); const f32x4 a = pp[0], b = pp[1], c = pp[2], d = pp[3];
          float sm = (a[0] + a[2]) + (b[0] + b[2]) + (c[0] + c[2]) + (d[0] + d[2]), sq = (a[1] + a[3]) + (b[1] + b[3]) + (c[1] + c[3]) + (d[1] + d[3]);
          sm = sum_fq(sm); sq = sum_fq(sq);
          mean[rt] = sm * (1.0f / D); const float var = fmaxf(sq * (1.0f / D) - mean[rt] * mean[rt], 0.f); rstd[rt] = 1.0f / sqrtf(var + LN_EPS);
          if (w == 0 && q == 0) *(f32x2*)(ST1 + 2 * row) = (f32x2){mean[rt], rstd[rt]}; }
        const int kb = 256 * w + 8 * q;
        const LAS float* gl = (const LAS float*)(F.lds + M1N_GB) + kb;
        f32x4 acc[4][4];
#pragma unroll
        for (int rt = 0; rt < 4; ++rt)
#pragma unroll
            for (int nt = 0; nt < 4; ++nt) acc[rt][nt] = (f32x4){0.f, 0.f, 0.f, 0.f};
        v4u yb[2][2][4], hb[4]; bf16x8 wh[4], wl[4];
        unsigned vo[4];
#pragma unroll
        for (int i = 0; i < 4; ++i) { vo[i] = (unsigned)(r * D + kb) * 2u + (unsigned)i * (16u * D * 2u); asm volatile("" : "+v"(vo[i])); }
        const char* ybase = (const char*)(Y + (size_t)row0 * D); char* xbase = (char*)(X1B + (size_t)row0 * D);
#define M1_LOADY(ms) do { _Pragma("unroll") for (int hf = 0; hf < 2; ++hf) _Pragma("unroll") for (int rt = 0; rt < 4; ++rt) yb[(ms) & 1][hf][rt] = *(const v4u*)(ybase + vo[rt] + 128 * (ms) + 64 * hf); } while (0)
#define M1_LOADW(st) do { _Pragma("unroll") for (int nt = 0; nt < 4; ++nt) { wh[nt] = *(const bf16x8*)((const char*)WH + vo[nt] + 64 * (st)); wl[nt] = *(const bf16x8*)((const char*)WL + vo[nt] + 64 * (st)); } } while (0)
        M1_LOADY(0); M1_LOADW(0); M1_LOADY(1);
        __builtin_amdgcn_sched_barrier(0);
#pragma unroll
        for (int st = 0; st < 8; ++st) {
            const f32x4 g0 = *(const LAS f32x4*)(gl + 32 * st), g1 = *(const LAS f32x4*)(gl + 32 * st + 4), b0 = *(const LAS f32x4*)(gl + 2048 + 32 * st), b1 = *(const LAS f32x4*)(gl + 2048 + 32 * st + 4);
#pragma unroll
            for (int rt = 0; rt < 4; ++rt) { const v4u yv = yb[(st >> 1) & 1][st & 1][rt];
                const f32x4 y0_ = (f32x4){bflo(yv.x), bfhi(yv.x), bflo(yv.y), bfhi(yv.y)}, y1_ = (f32x4){bflo(yv.z), bfhi(yv.z), bflo(yv.w), bfhi(yv.w)};
                const f32x4 x0 = (y0_ - mean[rt]) * rstd[rt] * g0 + b0, x1 = (y1_ - mean[rt]) * rstd[rt] * g1 + b1;
                v4u h; h.x = cvt_pk_bf16(x0[0], x0[1]); h.y = cvt_pk_bf16(x0[2], x0[3]); h.z = cvt_pk_bf16(x1[0], x1[1]); h.w = cvt_pk_bf16(x1[2], x1[3]);
                if ((st & 1) == 0) hb[rt] = h; else { *(v4u*)(xbase + vo[rt] + 64 * (st - 1)) = hb[rt]; *(v4u*)(xbase + vo[rt] + 64 * st) = h; }
                v4u l; l.x = cvt_pk_bf16(x0[0] - bflo(h.x), x0[1] - bfhi(h.x)); l.y = cvt_pk_bf16(x0[2] - bflo(h.y), x0[3] - bfhi(h.y));
                l.z = cvt_pk_bf16(x1[0] - bflo(h.z), x1[1] - bfhi(h.z)); l.w = cvt_pk_bf16(x1[2] - bflo(h.w), x1[3] - bfhi(h.w));
                const bf16x8 xh = __builtin_bit_cast(bf16x8, h), xl = __builtin_bit_cast(bf16x8, l);
#pragma unroll
                for (int nt = 0; nt < 4; ++nt) { acc[rt][nt] = __builtin_amdgcn_mfma_f32_16x16x32_bf16(xh, wh[nt], acc[rt][nt], 0, 0, 0);
                    acc[rt][nt] = __builtin_amdgcn_mfma_f32_16x16x32_bf16(xl, wh[nt], acc[rt][nt], 0, 0, 0); acc[rt][nt] = __builtin_amdgcn_mfma_f32_16x16x32_bf16(xh, wl[nt], acc[rt][nt], 0, 0, 0); } }
            __builtin_amdgcn_sched_barrier(0);
            if (st + 1 < 8) M1_LOADW(st + 1);
            if ((st & 1) == 1 && (st >> 1) + 2 < 4) M1_LOADY((st >> 1) + 2);
            __builtin_amdgcn_sched_barrier(0);
        }
#undef M1_LOADY
#undef M1_LOADW
#pragma unroll
        for (int rt = 0; rt < 4; ++rt)
#pragma unroll
            for (int nt = 0; nt < 4; ++nt)
#pragma unroll
                for (int i = 0; i < 4; ++i) P[(w * 64 + 16 * rt + 4 * q + i) * 64 + 16 * nt + r] = acc[rt][nt][i];
        __syncthreads();
        const float rb = RB[lane];
        LAS int* Pi = (LAS int*)P;
#pragma unroll 1
        for (int rr = 0; rr < 8; ++rr) { const int rl = 8 * w + rr;
            float lg = ((P[rl * 64 + lane] + P[(64 + rl) * 64 + lane]) + (P[(128 + rl) * 64 + lane] + P[(192 + rl) * 64 + lane])) + ((P[(256 + rl) * 64 + lane] + P[(320 + rl) * 64 + lane]) + (P[(384 + rl) * 64 + lane] + P[(448 + rl) * 64 + lane]));
            lg = (lg == lg) ? lg : -1.0e30f;
            const float sc = 1.0f / (1.0f + __expf(-lg)); const float ch = sc + rb;
            const float m1 = gmax8(ch), neq = gsum8(ch == m1 ? 1.f : 0.f), m2c = gmax8(ch < m1 ? ch : -INFINITY);
            const float gs = m1 + (neq >= 2.f ? m1 : m2c);
            int grk = 0; const int g = lane >> 3;
#pragma unroll
            for (int hh = 0; hh < 8; ++hh) { const float gh = rl_f(gs, 8 * hh); grk += (gh > gs || (gh == gs && hh < g)) ? 1 : 0; }
            const float msk = grk < 4 ? ch : -INFINITY;
            float cur = msk, ssum = 0.f; int erk = 64;
#pragma unroll 1
            for (int k = 0; k < 8; ++k) {
                float rm = gmax8(cur); rm = fmaxf(rm, dppf<0x140>(rm));
                const float wm = fmaxf(fmaxf(rl_f(rm, 0), rl_f(rm, 16)), fmaxf(rl_f(rm, 32), rl_f(rm, 48)));
                const unsigned long long bal = __builtin_amdgcn_ballot_w64(cur == wm);
                const int lsel = __builtin_amdgcn_readfirstlane((int)__builtin_ctzll(bal));
                ssum += rl_f(sc, lsel);
                const bool me = lane == lsel; erk = me ? k : erk; cur = me ? -INFINITY : cur; }
            const bool on = erk < 8;
            int pk_ = -1; if (on) pk_ = __hip_atomic_fetch_add(&hist[lane], 1, __ATOMIC_RELAXED, __HIP_MEMORY_SCOPE_WORKGROUP) | (erk << 16);
            P[rl * 64 + lane] = sc / ssum * 2.5f; Pi[(64 + rl) * 64 + lane] = pk_; }
        __syncthreads();
        if (tid < 64) { int tt = tid; asm volatile("" : "+v"(tt));
            const int hc = hist[tt]; int bs = 0; if (hc > 0) bs = (int)atomicAdd(&cnt[tt * 16], (unsigned)hc); basep[tt] = bs; }
        __syncthreads();
        { const int bl = basep[lane];
#pragma unroll 1
          for (int rr = 0; rr < 8; ++rr) { const int rl = 8 * w + rr; const int pk_ = Pi[(64 + rl) * 64 + lane]; const float gt_ = P[rl * 64 + lane];
            if (pk_ >= 0) { const int t = row0 + rl, pos = bl + (pk_ & 0xffff), rk_ = pk_ >> 16;
                ltok[(size_t)lane * CAP + pos] = t * 8 + rk_; lgate[(size_t)lane * CAP + pos] = gt_;
                eidx[t * 8 + rk_] = lane; inv[t * 8 + rk_] = pos; } } }
    }
}

constexpr int M3_PL = 131072, M3_CNT = 147456, M3_OFF = 147456 + 272;
__device__ __forceinline__ void phase_moe3n(const Frame& F, const bf16* H, const bf16* HSp, const int* eidx, const bf16* WD, const bf16* WSD,
                                            const float* Y1, const float* ST1, const float* g1, const float* b1, float* Y2, float* PST2) {
    LAS int* out = (LAS int*)F.lds; LAS unsigned short* plist = (LAS unsigned short*)(F.lds + M3_PL); LAS int* cnt = (LAS int*)(F.lds + M3_CNT); LAS int* off = (LAS int*)(F.lds + M3_OFF);
    const int tid = F.tid, lane = F.lane, w = F.wave, r = lane & 15, q = lane >> 4;
    for (int u = F.bid; u < 1024; u += F.G) {
        int nc = (u & 7) | ((u >> 7) << 3), tb = (u >> 3) & 15;
        if (F.G == 256) { const int i = u >> 8, x = u & 7, j = (u >> 3) & 31; tb = 2 * x + (i >> 1); nc = 32 * (i & 1) + j; }
        __syncthreads();
#pragma unroll
        for (int j = 0; j < 16; ++j) ((LAS v4u*)out)[tid + 512 * j] = (v4u){0u, 0u, 0u, 0u};
        if (tid < 66) cnt[tid] = 0;
        __syncthreads();
        int ee[16], pp[16];
        { const v4u* ep = (const v4u*)(eidx + ((size_t)tb * 1024 + 2 * tid) * 8); const v4u e0 = ep[0], e1 = ep[1], e2 = ep[2], e3 = ep[3];
          ee[0] = e0.x; ee[1] = e0.y; ee[2] = e0.z; ee[3] = e0.w; ee[4] = e1.x; ee[5] = e1.y; ee[6] = e1.z; ee[7] = e1.w;
          ee[8] = e2.x; ee[9] = e2.y; ee[10] = e2.z; ee[11] = e2.w; ee[12] = e3.x; ee[13] = e3.y; ee[14] = e3.z; ee[15] = e3.w; }
#pragma unroll
        for (int j = 0; j < 16; ++j) pp[j] = __hip_atomic_fetch_add(&cnt[ee[j]], 1, __ATOMIC_RELAXED, __HIP_MEMORY_SCOPE_WORKGROUP);
        __syncthreads();
        if (w == 0) { int c = cnt[lane], x = c;
#pragma unroll
            for (int o = 1; o < 64; o <<= 1) { const int y = __builtin_amdgcn_ds_bpermute(((lane - o) & 63) << 2, x); if (lane >= o) x += y; }
            off[lane] = x - c; if (lane == 63) off[64] = x; }
        __syncthreads();
#pragma unroll
        for (int j = 0; j < 16; ++j) plist[off[ee[j]] + pp[j]] = (unsigned short)(tid * 16 + j);
        __syncthreads();
        const char* Hb = (const char*)H + (size_t)tb * 8192 * 256 + q * 16;
        const char* HSb = (const char*)HSp + (size_t)tb * 1024 * 512 + q * 16;
        const char* Bb = (const char*)WD + ((size_t)nc * 32 + r) * 256 + q * 16;
        const char* BSb = (const char*)WSD + ((size_t)nc * 32 + r) * 512 + q * 16;
#define M3_NR(sg) ((sg) < 8 ? __builtin_amdgcn_readfirstlane(cnt[w + 8 * (sg)]) : 128)
#define M3_RB(sg) ((sg) < 8 ? __builtin_amdgcn_readfirstlane(off[w + 8 * (sg)]) : 0)
#define M3_GLD(dst, ptr, OFF) asm volatile("global_load_dwordx4 %0, %1, off offset:" #OFF : "=&v"(dst) : "v"(ptr) : "memory")
#define M3_LOADB(dst, sg) do { const char* _b0 = (sg) < 8 ? Bb + (size_t)(w + 8 * (sg)) * 524288 : BSb + ((sg) - 8) * 256; const char* _b1 = _b0 + ((sg) < 8 ? 4096 : 8192); \
            M3_GLD(dst[0][0], _b0, 0); M3_GLD(dst[0][1], _b0, 64); M3_GLD(dst[0][2], _b0, 128); M3_GLD(dst[0][3], _b0, 192); \
            M3_GLD(dst[1][0], _b1, 0); M3_GLD(dst[1][1], _b1, 64); M3_GLD(dst[1][2], _b1, 128); M3_GLD(dst[1][3], _b1, 192); } while (0)
#define M3_LOADA(dst, sg, bb, nr, rbs) do { int _i = 16 * (bb) + r; _i = _i < (nr) ? _i : (nr) - 1; const unsigned _rid = plist[(rbs) + _i]; \
            const char* _a = (sg) < 8 ? Hb + (size_t)_rid * 256 : ((sg) < 10 ? HSb + (size_t)(128 * w + _i) * 512 + ((sg) - 8) * 256 : Hb); \
            M3_GLD(dst[0], _a, 0); M3_GLD(dst[1], _a, 64); M3_GLD(dst[2], _a, 128); M3_GLD(dst[3], _a, 192); } while (0)
#define M3_ADV(sg, bb, nr, rbs) do { if ((sg) < 10) { ++(bb); if ((bb) * 16 >= (nr)) { (bb) = 0; do { ++(sg); } while ((sg) < 8 && M3_NR(sg) == 0); if ((sg) < 10) { (nr) = M3_NR(sg); (rbs) = M3_RB(sg); } } } } while (0)
#define M3_WAITA(AS) asm volatile("s_waitcnt vmcnt(12)" : "+v"(AS[0]), "+v"(AS[1]), "+v"(AS[2]), "+v"(AS[3]) :: "memory")
#define M3_WAITB(N) asm volatile("s_waitcnt vmcnt(" #N ")" : "+v"(Bn[0][0]), "+v"(Bn[0][1]), "+v"(Bn[0][2]), "+v"(Bn[0][3]), "+v"(Bn[1][0]), "+v"(Bn[1][1]), "+v"(Bn[1][2]), "+v"(Bn[1][3]) :: "memory")
#define M3_STEP(AS) if (cseg < 10) { \
              \
            int tk[4]; bool ok[4]; unsigned pl[4]; const int rt_ = cseg < 8; \
            _Pragma("unroll") for (int i = 0; i < 4; ++i) { const int idx = 16 * cbt + 4 * q + i; ok[i] = idx < cnr; const int ic = ok[i] ? idx : cnr - 1; pl[i] = plist[crbs + ic]; tk[i] = 128 * w + ic; } \
            _Pragma("unroll") for (int i = 0; i < 4; ++i) tk[i] = rt_ ? (int)(pl[i] >> 3) : tk[i]; \
            M3_WAITA(AS); \
            f32x4 acc[2]; \
            _Pragma("unroll") for (int nt = 0; nt < 2; ++nt) { acc[nt] = (f32x4){0.f, 0.f, 0.f, 0.f}; \
                _Pragma("unroll") for (int kk = 0; kk < 4; ++kk) acc[nt] = __builtin_amdgcn_mfma_f32_16x16x32_bf16(__builtin_bit_cast(bf16x8, AS[kk]), __builtin_bit_cast(bf16x8, Bc[nt][kk]), acc[nt], 0, 0, 0); } \
              \
            _Pragma("unroll") for (int i = 0; i < 4; ++i) { const long long lo_ = ok[i] ? (long long)__float2int_rn(acc[0][i] * 4194304.0f) : 0ll, hi_ = ok[i] ? (long long)__float2int_rn(acc[1][i] * 4194304.0f) : 0ll; \
                (void)__hip_atomic_fetch_add((LAS unsigned long long*)out + tk[i] * 16 + r, (unsigned long long)((hi_ << 32) + lo_), __ATOMIC_RELAXED, __HIP_MEMORY_SCOPE_WORKGROUP); } \
            M3_LOADA(AS, pseg, pbt, pnr, prbs); M3_ADV(pseg, pbt, pnr, prbs); \
            { const int old_ = cseg, nbat_ = (cnr + 15) >> 4; M3_ADV(cseg, cbt, cnr, crbs); \
              if (cseg != old_ && cseg < 10) { \
                  if (nbat_ == 1) M3_WAITB(4); else if (nbat_ == 2) M3_WAITB(8); else if (nbat_ == 3) M3_WAITB(12); else M3_WAITB(16); \
                  _Pragma("unroll") for (int nt = 0; nt < 2; ++nt) _Pragma("unroll") for (int kk = 0; kk < 4; ++kk) Bc[nt][kk] = Bn[nt][kk]; \
                  int nb_ = cseg; do { ++nb_; } while (nb_ < 8 && M3_NR(nb_) == 0); if (nb_ >= 10) nb_ = 9; M3_LOADB(Bn, nb_); } } }
        int cseg = -1, cbt = 0, cnr = 0, crbs = 0;
        do { ++cseg; } while (cseg < 8 && M3_NR(cseg) == 0);
        cnr = M3_NR(cseg); crbs = M3_RB(cseg);
        int pseg = cseg, pbt = 0, pnr = cnr, prbs = crbs;
        v4u Bc[2][4], Bn[2][4], A0[4], A1[4], A2[4], A3[4];
        M3_LOADB(Bc, cseg);
        M3_LOADA(A0, pseg, pbt, pnr, prbs); M3_ADV(pseg, pbt, pnr, prbs);
        M3_LOADA(A1, pseg, pbt, pnr, prbs); M3_ADV(pseg, pbt, pnr, prbs);
        M3_LOADA(A2, pseg, pbt, pnr, prbs); M3_ADV(pseg, pbt, pnr, prbs);
        M3_LOADA(A3, pseg, pbt, pnr, prbs); M3_ADV(pseg, pbt, pnr, prbs);
        { int nb_ = cseg; do { ++nb_; } while (nb_ < 8 && M3_NR(nb_) == 0); if (nb_ >= 10) nb_ = 9; M3_LOADB(Bn, nb_); }
        asm volatile("s_waitcnt vmcnt(0)" : "+v"(Bc[0][0]), "+v"(Bc[0][1]), "+v"(Bc[0][2]), "+v"(Bc[0][3]), "+v"(Bc[1][0]), "+v"(Bc[1][1]), "+v"(Bc[1][2]), "+v"(Bc[1][3]) :: "memory");
#pragma unroll 1
        while (cseg < 10) { M3_STEP(A0) M3_STEP(A1) M3_STEP(A2) M3_STEP(A3) }
        asm volatile("s_waitcnt vmcnt(0)" : "+v"(A0[0]), "+v"(A0[1]), "+v"(A0[2]), "+v"(A0[3]), "+v"(A1[0]), "+v"(A1[1]), "+v"(A1[2]), "+v"(A1[3]), "+v"(A2[0]), "+v"(A2[1]), "+v"(A2[2]), "+v"(A2[3]),
                     "+v"(A3[0]), "+v"(A3[1]), "+v"(A3[2]), "+v"(A3[3]), "+v"(Bn[0][0]), "+v"(Bn[0][1]), "+v"(Bn[0][2]), "+v"(Bn[0][3]), "+v"(Bn[1][0]), "+v"(Bn[1][1]), "+v"(Bn[1][2]), "+v"(Bn[1][3]) :: "memory");
#undef M3_NR
#undef M3_RB
#undef M3_GLD
#undef M3_LOADB
#undef M3_LOADA
#undef M3_ADV
#undef M3_WAITA
#undef M3_WAITB
#undef M3_STEP
        __syncthreads();
        { const int c4 = lane & 7, rs = lane >> 3, col = nc * 32 + 4 * c4;
          const f32x4 gv = *(const f32x4*)(g1 + col), bv = *(const f32x4*)(b1 + col);
#pragma unroll 4
          for (int it = 0; it < 16; ++it) { const int rl = 128 * w + 8 * it + rs; const size_t row = (size_t)tb * 1024 + rl;
              const f32x4 yv = *(const f32x4*)(Y1 + row * D + col); const f32x2 sv = *(const f32x2*)(ST1 + 2 * row);
              f32x4 tv; { const int nt = c4 >> 2, r0 = (4 * c4) & 15;
#pragma unroll
                  for (int j = 0; j < 4; ++j) { const v2u cell = *(const LAS v2u*)(out + rl * 32 + 2 * (r0 + j)); const int lo = (int)cell.x, hi = (int)cell.y + (lo < 0 ? 1 : 0); tv[j] = (float)(nt ? hi : lo) * (1.0f / 4194304.0f); } }
              const f32x4 y = ((yv - sv.x) * sv.y * gv + bv) * ALPHA + tv;
              *(f32x4*)(Y2 + row * D + col) = y;
              float sm = (y[0] + y[1]) + (y[2] + y[3]), sq = (y[0] * y[0] + y[1] * y[1]) + (y[2] * y[2] + y[3] * y[3]);
#pragma unroll
              for (int o = 1; o < 8; o <<= 1) { sm += shfl_x(sm, o, lane); sq += shfl_x(sq, o, lane); }
              if (c4 == 0) *(f32x2*)(PST2 + (row * 64 + nc) * 2) = (f32x2){sm, sq}; } }
    }
}

__device__ __forceinline__ void phase_moe4n(const Frame& F, const float* Y2, const float* pst, const float* gain, const float* bias, float* ST2, bf16* XBo, float* OUT, int last) {
    const int gw = F.bid * 8 + F.wave, NGW = F.G * 8, lane = F.lane;
    for (int t = gw; t < T; t += NGW) {
        f32x4 v[8];
#pragma unroll
        for (int j = 0; j < 8; ++j) v[j] = *(const f32x4*)(Y2 + (size_t)t * D + 4 * lane + 256 * j);
        const f32x2 pv = *(const f32x2*)(pst + ((size_t)t * 64 + lane) * 2);
        const float mean = wave_sum(pv.x, lane) * (1.0f / D); const float var = fmaxf(wave_sum(pv.y, lane) * (1.0f / D) - mean * mean, 0.f); const float rstd = 1.0f / sqrtf(var + LN_EPS);
        if (lane == 0) *(f32x2*)(ST2 + 2 * (size_t)t) = (f32x2){mean, rstd};
#pragma unroll
        for (int j = 0; j < 8; ++j) { const int c = 4 * lane + 256 * j; const f32x4 o = (v[j] - mean) * rstd * *(const f32x4*)(gain + c) + *(const f32x4*)(bias + c);
            if (last) *(f32x4*)(OUT + (size_t)t * D + c) = o;
            else { v2u wb; wb.x = pk2(o[0], o[1]); wb.y = pk2(o[2], o[3]); *(v2u*)(XBo + (size_t)t * D + c) = wb; } }
    }
}


__device__ __forceinline__ void phase_moe4q(const Frame& F, const bf16* X1, bf16* Y2, const unsigned char* Yq, const float* Ysc, const int* eidx, const int* inv, const float* gain, const float* bias, float* ST2, bf16* XBo, float* OUT, int last) {
    const LAS int* tpref = (const LAS int*)(F.lds + LDS_TAB);
    const int gw = F.bid * 8 + F.wave, NGW = F.G * 8, lane = F.lane;
    { LAS f32x4* gb = (LAS f32x4*)(F.lds + 0); int t0 = F.tid; asm volatile("" : "+v"(t0)); gb[t0] = *(const f32x4*)(gain + 4 * t0); gb[512 + t0] = *(const f32x4*)(bias + 4 * t0); }
    __syncthreads();
    const LAS float* gl = (const LAS float*)(F.lds + 0);
    int en = 0, pn = 0; if (lane < 8 && gw < T) { en = eidx[gw * 8 + lane]; pn = inv[gw * 8 + lane]; }
    for (int t = gw; t < T; t += NGW) {
        int rowi = 0; if (lane < 8) rowi = tpref[en] * 256 + pn; else if (lane < 10) rowi = tpref[56 + lane] * 256 + t;
        if (lane < 8 && t + NGW < T) { en = eidx[(t + NGW) * 8 + lane]; pn = inv[(t + NGW) * 8 + lane]; }
        v4u pv[2][2], yv[10][2]; float sc[10][2];
#pragma unroll
        for (int j = 0; j < 2; ++j) { pv[j][0] = __builtin_nontemporal_load((const v4u*)(X1 + (size_t)t * D + 16 * lane + 1024 * j)); pv[j][1] = __builtin_nontemporal_load((const v4u*)(X1 + (size_t)t * D + 16 * lane + 1024 * j + 8)); }
#pragma unroll
        for (int k = 0; k < 10; ++k) { const size_t row = (size_t)__builtin_amdgcn_readlane(rowi, k);
#pragma unroll
            for (int j = 0; j < 2; ++j) yv[k][j] = __builtin_nontemporal_load((const v4u*)(Yq + row * D + 16 * lane + 1024 * j));
            sc[k][0] = __builtin_nontemporal_load(Ysc + row * 16 + (lane & 15)); }
#pragma unroll
        for (int k = 0; k < 10; ++k) asm volatile("" : "+v"(yv[k][0]), "+v"(yv[k][1]), "+v"(sc[k][0]));
#pragma unroll
        for (int k = 0; k < 10; ++k) { const float all = sc[k][0];
            sc[k][1] = __builtin_bit_cast(float, __builtin_amdgcn_ds_bpermute((8 + (lane >> 3)) << 2, __builtin_bit_cast(int, all)));
            sc[k][0] = __builtin_bit_cast(float, __builtin_amdgcn_ds_bpermute((lane >> 3) << 2, __builtin_bit_cast(int, all))); }
        float v[2][16];
#pragma unroll
        for (int j = 0; j < 2; ++j) { float f0[8], f1[8]; unpack8(pv[j][0], f0); unpack8(pv[j][1], f1);
            const float ss = (((sc[0][j] + sc[1][j]) + (sc[2][j] + sc[3][j])) + ((sc[4][j] + sc[5][j]) + (sc[6][j] + sc[7][j]))) + (sc[8][j] + sc[9][j]);
#pragma unroll
            for (int i = 0; i < 8; ++i) { v[j][i] = ALPHA * f0[i] - 128.f * ss; v[j][8 + i] = ALPHA * f1[i] - 128.f * ss; } }
#pragma unroll
        for (int k = 0; k < 10; ++k)
#pragma unroll
            for (int j = 0; j < 2; ++j) { const float s_ = sc[k][j]; const unsigned q[4] = {yv[k][j].x, yv[k][j].y, yv[k][j].z, yv[k][j].w};
#pragma unroll
                for (int d = 0; d < 4; ++d) { v[j][4 * d + 0] += s_ * (float)(q[d] & 0xffu); v[j][4 * d + 1] += s_ * (float)((q[d] >> 8) & 0xffu); v[j][4 * d + 2] += s_ * (float)((q[d] >> 16) & 0xffu); v[j][4 * d + 3] += s_ * (float)(q[d] >> 24); } }
        float sm = 0.f;
#pragma unroll
        for (int j = 0; j < 2; ++j)
#pragma unroll
            for (int i = 0; i < 16; i += 4) sm += (v[j][i] + v[j][i + 1]) + (v[j][i + 2] + v[j][i + 3]);
        const float mean = wave_sum(sm, lane) * (1.0f / D); float sq = 0.f;
#pragma unroll
        for (int j = 0; j < 2; ++j)
#pragma unroll
            for (int i = 0; i < 16; ++i) { const float d = v[j][i] - mean; sq += d * d; }
        const float rstd = 1.0f / sqrtf(wave_sum(sq, lane) * (1.0f / D) + LN_EPS);
        (void)ST2; (void)Y2;
#pragma unroll
        for (int j = 0; j < 2; ++j)
#pragma unroll
            for (int h = 0; h < 2; ++h) { const int c = 16 * lane + 1024 * j + 8 * h; const float* vv = &v[j][8 * h];
                const f32x4 g0 = *(const LAS f32x4*)(gl + c), g1 = *(const LAS f32x4*)(gl + c + 4), b0 = *(const LAS f32x4*)(gl + 2048 + c), b1 = *(const LAS f32x4*)(gl + 2048 + c + 4);
                const f32x4 o0 = ((f32x4){vv[0], vv[1], vv[2], vv[3]} - mean) * rstd * g0 + b0, o1 = ((f32x4){vv[4], vv[5], vv[6], vv[7]} - mean) * rstd * g1 + b1;
                if (last) { *(f32x4*)(OUT + (size_t)t * D + c) = o0; *(f32x4*)(OUT + (size_t)t * D + c + 4) = o1; }
                else { v4u wb; wb.x = pk2(o0[0], o0[1]); wb.y = pk2(o0[2], o0[3]); wb.z = pk2(o1[0], o1[1]); wb.w = pk2(o1[2], o1[3]); *(v4u*)(XBo + (size_t)t * D + c) = wb; } }
    }
}

__device__ __forceinline__ void phase_downproj3(const Frame& F, const bf16* H, const bf16* WD, const bf16* HSp, const bf16* WSD, unsigned char* Yq, float* Ysc, int NT) {
    const LAS int* tpref = (const LAS int*)(F.lds + LDS_TAB); const LAS int* cl = (const LAS int*)(F.lds + LDS_TAB + 512);
    LAS unsigned char* lds = F.lds;
    const int tid = F.tid, lane = F.lane, w = F.wave, fr = lane & 15, fq = lane >> 4;
    unsigned rbB[2], cbB[2];
#pragma unroll
    for (int i = 0; i < 2; ++i) { int R_, C_; g8::stage_rc(tid * 16 + i * 8192, R_, C_); rbB[i] = (unsigned)((R_ & ~31) + g8::perm32(R_ & 31)); cbB[i] = (unsigned)C_ * 2u; }
    const unsigned ldsw = (unsigned)w * 1024u, lbase = (unsigned)(size_t)lds;
    int boffg[4];
#pragma unroll
    for (int g = 0; g < 4; ++g) boffg[g] = g8::lds_byte(32 * g + fr, fq * 8);
    LAS unsigned char* stg = lds + 65536 + w * (32 * 144);
    const int NU = NT * 4;
    const int upos = (F.G % 8) == 0 ? (F.bid & 7) * (F.G >> 3) + (F.bid >> 3) : F.bid;
    int ub = 0;
    int u = (F.G <= NU) ? upos : F.bid; if (u >= NU) return;
#define DP3_UNITINFO(uu, E0, EXP, NV) do { const int tl_ = (uu) >> 2; int e_ = (E0); while (__builtin_amdgcn_readfirstlane(tpref[e_ + 1]) <= tl_) ++e_; EXP = e_; \
        NV = __builtin_amdgcn_readfirstlane(cl[e_]) - (tl_ - __builtin_amdgcn_readfirstlane(tpref[e_])) * 256; } while (0)
#define DP3_GLDS(gsrc, ldsdst) do { unsigned keep_; asm volatile("s_mov_b32 %0, m0\n\ts_mov_b32 m0, %2\n\ts_nop 0\n\tglobal_load_lds_dwordx4 %1, off\n\ts_mov_b32 m0, %0" : "=&s"(keep_) : "v"(gsrc), "s"(ldsdst) : "memory"); } while (0)
#define DP3_STAGE(slot, gb, bs) do { const unsigned v0_ = rbB[0] * (unsigned)(bs) + cbB[0], v1_ = rbB[1] * (unsigned)(bs) + cbB[1]; _Pragma("unroll") for (int kt = 0; kt < 2; ++kt) { \
        DP3_GLDS((const void*)((gb) + kt * 128 + v0_), lbase + (unsigned)((slot) * 32768 + kt * 16384) + ldsw); \
        DP3_GLDS((const void*)((gb) + kt * 128 + v1_), lbase + (unsigned)((slot) * 32768 + kt * 16384) + ldsw + 8192u); } } while (0)
#define DP3_SRC(uu, ee, AB, AS, BB, BS) do { const int tl_ = (uu) >> 2, cu_ = ((uu) & 3) * 512; \
        if ((ee) < 64) { AB = (const char*)(H + (size_t)tl_ * 256 * EDIM); AS = EDIM * 2; BB = (const char*)(WD + (size_t)(ee) * D * EDIM + (size_t)cu_ * EDIM); BS = EDIM * 2; } \
        else { const int t0_ = (tl_ - __builtin_amdgcn_readfirstlane(tpref[ee])) * 256; AB = (const char*)(HSp + (size_t)t0_ * SDIM + ((ee) - 64) * EDIM); AS = SDIM * 2; \
               BB = (const char*)(WSD + (size_t)cu_ * SDIM + ((ee) - 64) * EDIM); BS = SDIM * 2; } } while (0)
    int ecur, nvcur; DP3_UNITINFO(u, 0, ecur, nvcur);
    const char* abc; const char* gbc; int asc, bsc; DP3_SRC(u, ecur, abc, asc, gbc, bsc);
    bf16x8 A[2][4], An[2][4];
    { const char* ap_ = abc + (size_t)(32 * w + fr) * asc + 16 * fq;
#pragma unroll
      for (int m = 0; m < 2; ++m)
#pragma unroll
          for (int kk = 0; kk < 4; ++kk) A[m][kk] = *(const bf16x8*)(ap_ + (size_t)m * 16 * asc + 64 * kk); }
    DP3_STAGE(0, gbc, bsc);
    asm volatile("s_waitcnt vmcnt(0)" ::: "memory");
#pragma unroll 1
    for (;;) {
        int un = u; { const int nb = ub + F.G; if (nb + F.G <= NU) un = nb + upos; else if (nb + F.bid < NU) un = nb + F.bid; if (un != u) ub = nb; }
        int enx, nvnx; DP3_UNITINFO(un, (un > u ? ecur : 0), enx, nvnx);
        const char* abn; const char* gbn; int asn, bsn; DP3_SRC(un, enx, abn, asn, gbn, bsn);
        const int tile = u >> 2, colu = (u & 3) * 512;
        float scq[2][4];
#pragma unroll
        for (int c = 0; c < 4; ++c) {
            if (c == 0) asm volatile("s_waitcnt vmcnt(5)" ::: "memory"); else asm volatile("s_waitcnt vmcnt(4)" ::: "memory");
            __builtin_amdgcn_s_barrier();
            if (c == 3) { const char* ap_ = abn + (size_t)(32 * w + fr) * asn + 16 * fq;
#pragma unroll
                for (int m = 0; m < 2; ++m) { const char* am_ = ap_ + (size_t)m * 16 * asn;
                    asm volatile("global_load_dwordx4 %0, %1, off" : "=&v"(An[m][0]) : "v"(am_) : "memory"); asm volatile("global_load_dwordx4 %0, %1, off offset:64" : "=&v"(An[m][1]) : "v"(am_) : "memory");
                    asm volatile("global_load_dwordx4 %0, %1, off offset:128" : "=&v"(An[m][2]) : "v"(am_) : "memory"); asm volatile("global_load_dwordx4 %0, %1, off offset:192" : "=&v"(An[m][3]) : "v"(am_) : "memory"); } }
            { const char* gnext = (c < 3) ? gbc + (size_t)(c + 1) * 128 * bsc : gbn; const int bnext = (c < 3) ? bsc : bsn; DP3_STAGE((c + 1) & 1, gnext, bnext); }
            __builtin_amdgcn_sched_barrier(0);
            f32x4 acc[2][4][2];
            __builtin_amdgcn_s_setprio(1);
#pragma unroll
            for (int g = 0; g < 4; ++g) { bf16x8 Bf[2][4];
#pragma unroll
                for (int n = 0; n < 2; ++n)
#pragma unroll
                    for (int kk = 0; kk < 4; ++kk) Bf[n][kk] = *(const LAS bf16x8*)(lds + (c & 1) * 32768 + (kk >> 1) * 16384 + boffg[g] + n * 2048 + (kk & 1) * 1024);
#pragma unroll
                for (int m = 0; m < 2; ++m)
#pragma unroll
                    for (int n = 0; n < 2; ++n) { acc[m][g][n] = (f32x4){0.f, 0.f, 0.f, 0.f};
#pragma unroll
                        for (int kk = 0; kk < 4; ++kk) acc[m][g][n] = __builtin_amdgcn_mfma_f32_16x16x32_bf16(Bf[n][kk], A[m][kk], acc[m][g][n], 0, 0, 0); } }
            __builtin_amdgcn_s_setprio(0);
#pragma unroll
            for (int m = 0; m < 2; ++m) {
                float am0 = 0.f, am1 = 0.f;
#pragma unroll
                for (int g = 0; g < 4; ++g)
#pragma unroll
                    for (int n = 0; n < 2; ++n) { am0 = fmaxf(fmaxf(am0, fabsf(acc[m][g][n][0])), fabsf(acc[m][g][n][1])); am1 = fmaxf(fmaxf(am1, fabsf(acc[m][g][n][2])), fabsf(acc[m][g][n][3])); }
                float am = fmaxf(am0, am1);
                am = max_fq(am);
                am = fminf(am, 3.0e38f);
                const float isc = am > 0.f ? 127.0f * __builtin_amdgcn_rcpf(am) : 0.f;
                scq[m][c] = am * (1.0f / 127.0f);
                const f32x2_t isc2 = (f32x2_t){isc, isc}, mg2 = (f32x2_t){8388736.0f, 8388736.0f};
#pragma unroll
                for (int g = 0; g < 4; ++g) { unsigned qd[2];
#pragma unroll
                    for (int n = 0; n < 2; ++n) {
                        const f32x2_t tl = __builtin_elementwise_fma((f32x2_t){acc[m][g][n][0], acc[m][g][n][1]}, isc2, mg2), th = __builtin_elementwise_fma((f32x2_t){acc[m][g][n][2], acc[m][g][n][3]}, isc2, mg2);
                        const float f0_ = tl.x, f1_ = tl.y, f2_ = th.x, f3_ = th.y;
                        qd[n] = __builtin_amdgcn_perm(__builtin_bit_cast(unsigned, f1_), __builtin_bit_cast(unsigned, f0_), 0x0c0c0400u) | __builtin_amdgcn_perm(__builtin_bit_cast(unsigned, f3_), __builtin_bit_cast(unsigned, f2_), 0x04000c0cu); }
                    *(LAS v2u*)(stg + (16 * m + fr) * 144 + 32 * g + 8 * fq) = (v2u){qd[0], qd[1]}; } }
            v4u ob[4];
#pragma unroll
            for (int it = 0; it < 4; ++it) ob[it] = *(const LAS v4u*)(stg + (8 * it + (lane >> 3)) * 144 + (lane & 7) * 16);
            asm volatile("" : "+v"(ob[0]), "+v"(ob[1]), "+v"(ob[2]), "+v"(ob[3]));
#pragma unroll
            for (int it = 0; it < 4; ++it) { const int rr = 8 * it + (lane >> 3);
                __builtin_nontemporal_store(ob[it], (v4u*)(Yq + (size_t)(tile * 256 + 32 * w + rr) * D + colu + 128 * c + 16 * (lane & 7))); }
            if (c == 3) { const f32x4 so = fq == 0 ? (f32x4){scq[0][0], scq[0][1], scq[0][2], scq[0][3]} : (f32x4){scq[1][0], scq[1][1], scq[1][2], scq[1][3]};
                if (fq < 2) __builtin_nontemporal_store(so, (f32x4*)(Ysc + (size_t)(tile * 256 + 32 * w + 16 * fq + fr) * 16 + (colu >> 7))); }
            __builtin_amdgcn_sched_barrier(0);
        }
        asm volatile("s_waitcnt vmcnt(9)" : "+v"(An[0][0]), "+v"(An[0][1]), "+v"(An[0][2]), "+v"(An[0][3]), "+v"(An[1][0]), "+v"(An[1][1]), "+v"(An[1][2]), "+v"(An[1][3]) :: "memory");
        if (un == u) break;
#pragma unroll
        for (int m = 0; m < 2; ++m)
#pragma unroll
            for (int kk = 0; kk < 4; ++kk) A[m][kk] = An[m][kk];
        u = un; ecur = enx; nvcur = nvnx; abc = abn; asc = asn; gbc = gbn; bsc = bsn;
    }
    asm volatile("s_waitcnt vmcnt(0)" ::: "memory");
#undef DP3_UNITINFO
#undef DP3_STAGE
#undef DP3_GLDS
#undef DP3_SRC
}

enum { PH_PRO = 0, PH_POOL_G1, PH_POOL_P, PH_POOL_G2, PH_POOL_G3, PH_DIL_G1, PH_DIL_ATT, PH_DIL_CMB, PH_DIL_G2, PH_CONV_G1, PH_CONV_E, PH_CONV_G2, PH_MOE1, PH_MOE2, PH_MOE3, PH_MOE4, PH_COUNT };

template <int PH>
__device__ __forceinline__ void run_phase(const Frame& Fin, const Args& args_, const int L) {
    Frame F = Fin; { int w_ = Fin.wave, l_; asm volatile("" : "+s"(w_)); asm volatile("v_mbcnt_lo_u32_b32 %0, -1, 0\n\tv_mbcnt_hi_u32_b32 %0, -1, %0" : "=v"(l_)); F.wave = w_; F.lane = l_; F.tid = w_ * 64 + l_; }
    unsigned char* ws; { GAS unsigned char* wsg = (GAS unsigned char*)Fin.ws; asm volatile("" : "+s"(wsg)); ws = (unsigned char*)wsg; } F.ws = ws; F.ctl = (unsigned*)(ws + WS_CTL);
    KP kp = (KP)__builtin_amdgcn_kernarg_segment_ptr(); asm volatile("" : "+s"(kp)); (void)args_;
    { unsigned l_ = (unsigned)(size_t)Fin.lds; asm volatile("" : "+s"(l_)); F.lds = (LAS unsigned char*)(size_t)l_; }
    LAS unsigned char* ring = F.lds; int c = (int)blockIdx.x; { int g_ = Fin.G; asm volatile("" : "+s"(c), "+s"(g_)); F.G = g_; F.bid = c; }
    const float* xres = ain(kp, IN_X);
    const float* st2 = (const float*)(ws + WS_ST2); float* pstp = (float*)(ws + WS_PST);
    const float* g2p = ain(kp, IN_LNG) + (size_t)((L > 0 ? L - 1 : 0) * 2 + 1) * D; const float* b2p = ain(kp, IN_LNB) + (size_t)((L > 0 ? L - 1 : 0) * 2 + 1) * D;
    const bf16* xb = (const bf16*)(ws + WS_XB);
    bf16* yf = (bf16*)(ws + WS_YF);
    unsigned char* big = ws + WS_BIG;
    const int ia = L / 3;
    if constexpr (PH == PH_PRO) { phase_prologue(F, kp); }
    if constexpr (PH == PH_POOL_G1) { g8::DenseSched S; S.init(xb, (const bf16*)(ws + WS_W_POOL_IN) + (size_t)ia * D * D, T, D, D, D, F.G, c);
        g8::EpiBf16 E{(bf16*)(big + BG_U), D, 0}; g8::gemm_phase<g8::EpiBf16, g8::DenseSched, false>(ring, F.tid, D, D, D, S, E); }
    if constexpr (PH == PH_POOL_P) { phase_pool(F, (const bf16*)(big + BG_U), (bf16*)(big + BG_PL)); }
    if constexpr (PH == PH_POOL_G2) { g8::DenseSched S; S.init((const bf16*)(big + BG_PL), (const bf16*)(ws + WS_W_POOL_G) + (size_t)ia * D * 512, T, D, D, 512, F.G, c); S.agrp_shift = 1; S.agrp_stride = 512 * 2;
        g8::EpiScaleBf16 E{(bf16*)(big + BG_MX), D, ain(kp, IN_PSC) + (size_t)ia * D}; g8::gemm_phase<g8::EpiScaleBf16, g8::DenseSched, false>(ring, F.tid, 512, D, 512, S, E); }
    if constexpr (PH == PH_POOL_G3) { g8::DenseSched S; S.init((const bf16*)(big + BG_MX), (const bf16*)(ws + WS_W_POOL_OUT) + (size_t)ia * D * D, T, D, D, D, F.G, c);
        g8::EpiResidLN E{xres, xb, st2, g2p, b2p, yf, pstp, 2}; g8::gemm_phase<g8::EpiResidLN, g8::DenseSched, false>(ring, F.tid, D, D, D, S, E); }
    if constexpr (PH == PH_DIL_G1) { g8::DenseSched S; S.init(xb, (const bf16*)(ws + WS_W_DIL_QKV), T, QKVC, D, D, F.G, c);
        g8::EpiBf16 E{(bf16*)(big + BG_QKV), QKVC, 1}; g8::gemm_phase<g8::EpiBf16, g8::DenseSched, false>(ring, F.tid, D, D, D, S, E); }
    if constexpr (PH == PH_DIL_ATT) { phase_attn(F, (const bf16*)(big + BG_QKV), ain(kp, IN_RELB), (bf16*)(big + BG_OG), (float*)(big + BG_LSE)); }
    if constexpr (PH == PH_DIL_CMB) { phase_combine(F, (const bf16*)(big + BG_OG), (const float*)(big + BG_LSE), (bf16*)(big + BG_O)); }
    if constexpr (PH == PH_DIL_G2) { g8::DenseSched S; S.init((const bf16*)(big + BG_O), (const bf16*)(ws + WS_W_DIL_OUT), T, D, DILW, DILW, F.G, c);
        g8::EpiResidLN E{xres, xb, st2, g2p, b2p, yf, pstp, 2}; g8::gemm_phase<g8::EpiResidLN, g8::DenseSched, false>(ring, F.tid, DILW, DILW, DILW, S, E); }
    if constexpr (PH == PH_CONV_G1) { g8::DenseSched S; S.init(xb, (const bf16*)(ws + WS_W_CONV_IN), T, 3 * D, D, D, F.G, c);
        g8::EpiConvIn E{(bf16*)(big + BG_UC), (bf16*)(big + BG_BG)}; g8::gemm_phase<g8::EpiConvIn, g8::DenseSched, false>(ring, F.tid, D, D, D, S, E); }
    if constexpr (PH == PH_CONV_E) { phase_conv(F, (const bf16*)(big + BG_UC), (const bf16*)(big + BG_BG), ain(kp, IN_CW), (bf16*)(big + BG_Z)); }
    if constexpr (PH == PH_CONV_G2) { g8::DenseSched S; S.init((const bf16*)(big + BG_Z), (const bf16*)(ws + WS_W_CONV_OUT), T, D, D, D, F.G, c);
        g8::EpiResidLN E{xres, xb, st2, g2p, b2p, yf, pstp, 2}; g8::gemm_phase<g8::EpiResidLN, g8::DenseSched, false>(ring, F.tid, D, D, D, S, E); }
    unsigned* cnt = F.ctl + CW_CNT + L * 64 * 16;
    float* x1f = (float*)(ws + WS_X1F); bf16* x1b = (bf16*)(ws + WS_X1B);
    int* ltok = (int*)(ws + WS_LTOK); float* lgate = (float*)(ws + WS_LGATE); int* eidx = (int*)(ws + WS_EIDX); int* inv = (int*)(ws + WS_INV);
    bf16* HB = (bf16*)(ws + WS_HB); bf16* HS = (bf16*)(ws + WS_HS); bf16* Yr = (bf16*)(ws + WS_BIG);
    if constexpr (PH == PH_MOE1) {
        const float* g1 = ain(kp, IN_LNG) + (size_t)(L * 2 + 0) * D; const float* b1 = ain(kp, IN_LNB) + (size_t)(L * 2 + 0) * D;
        phase_moe1n(F, yf, pstp, g1, b1, (const bf16*)(ws + WS_RWH) + (size_t)L * NEXP * D, (const bf16*)(ws + WS_RWL) + (size_t)L * NEXP * D, ain(kp, IN_RB) + (size_t)L * NEXP,
                    x1b, (float*)(ws + WS_ST1), cnt, ltok, lgate, eidx, inv); }
    if constexpr (PH == PH_MOE2) {
        const int NT = build_tiles(F, cnt);
        { g8::ExpertSched<1, true> S; S.tpref = (const LAS int*)(F.lds + LDS_TAB); S.cnt = (const LAS int*)(F.lds + LDS_TAB + 512); S.A = (const char*)x1b; S.B = (const char*)((const bf16*)(ws + WS_W_EX_GU) + (size_t)L * 64 * 256 * D);
          S.tok = ltok; S.b_exp = (size_t)256 * D * 2; S.b_tile = 0; S.a_tile = 0; S.NU = NT; S.G = F.G; S.c = c;
          g8::EpiExpertGU E{HB}; g8::gemm_phase<g8::EpiExpertGU, g8::ExpertSched<1, true>, true>(ring, F.tid, D, D, D, S, E); }
        { const int rot = (c - (NT % F.G) + F.G) % F.G;
          g8::DenseSched S; S.init(x1b, (const bf16*)(ws + WS_W_SH_GU) + (size_t)L * 512 * D, T, 512, D, D, F.G, rot);
          int t2 = F.tid; asm volatile("" : "+v"(t2));
          g8::EpiSharedGU E{HS}; g8::gemm_phase<g8::EpiSharedGU, g8::DenseSched, false>(ring, t2, D, D, D, S, E); } }
    if constexpr (PH == PH_MOE3) {
        const float* g1 = ain(kp, IN_LNG) + (size_t)(L * 2 + 0) * D; const float* b1 = ain(kp, IN_LNB) + (size_t)(L * 2 + 0) * D;
        const int NT = build_tiles(F, cnt);
        __syncthreads();
        phase_downproj3(F, HB, (const bf16*)(ws + WS_W_EX_D) + (size_t)L * 64 * D * EDIM, HS, (const bf16*)(ws + WS_W_SH_D) + (size_t)L * D * SDIM, (unsigned char*)Yr, (float*)(ws + WS_BIG + BG_YSC), NT + 2 * (T / 256));
        (void)g1; (void)b1; }
    if constexpr (PH == PH_MOE4) { (void)build_tiles(F, cnt);
        const float* g2 = ain(kp, IN_LNG) + (size_t)(L * 2 + 1) * D; const float* b2 = ain(kp, IN_LNB) + (size_t)(L * 2 + 1) * D;
        phase_moe4q(F, x1b, (bf16*)(ws + WS_Y2F), (const unsigned char*)Yr, (const float*)(ws + WS_BIG + BG_YSC), eidx, inv, g2, b2, (float*)(ws + WS_ST2), (bf16*)(ws + WS_XB), aout(kp), L == DEPTH - 1); }
}
__device__ __forceinline__ void make_frame(Frame& F, const Args& args) {
    extern __shared__ __attribute__((aligned(16))) unsigned char lds_raw[];
    F.lds = (LAS unsigned char*)lds_raw; F.ws = args.ws; F.ctl = (unsigned*)(args.ws + WS_CTL);
    F.tid = threadIdx.x; F.lane = F.tid & 63; F.wave = __builtin_amdgcn_readfirstlane(F.tid >> 6); F.G = gridDim.x; F.bid = blockIdx.x;
}
template <int PH> __global__ void __launch_bounds__(512, 2) k_phase(Args args, int L) {
    Frame F; make_frame(F, args);
    run_phase<PH>(F, args, L);
}

#ifndef MK_NOINLINE
#define MK_NOINLINE 0
#endif
#if MK_NOINLINE
template <int PH> __device__ __noinline__ void call_phase_ni(const int L) {
    Args dummy{}; Frame F;
    KP kp = (KP)__builtin_amdgcn_kernarg_segment_ptr();
    extern __shared__ __attribute__((aligned(16))) unsigned char lds_raw[];
    F.lds = (LAS unsigned char*)lds_raw; F.ws = (unsigned char*)((GAS unsigned char* const CAS*)kp)[20]; F.ctl = (unsigned*)(F.ws + WS_CTL);
    F.tid = threadIdx.x; F.lane = F.tid & 63; F.wave = __builtin_amdgcn_readfirstlane(F.tid >> 6); F.G = gridDim.x; F.bid = blockIdx.x;
    run_phase<PH>(F, dummy, L);
}
template <int PH> __device__ __forceinline__ void call_phase(const Frame& F, const Args& args, const int L) { call_phase_ni<PH>(L); }
#else
template <int PH> __device__ __forceinline__ void call_phase(const Frame& F, const Args& args, const int L) { asm volatile("; PHASE_BEGIN %0" :: "n"(PH)); run_phase<PH>(F, args, L); asm volatile("; PHASE_END %0" :: "n"(PH)); }
#endif
__global__ void __launch_bounds__(512, 2) fwd_all(Args args) {
    Frame F; make_frame(F, args);
    volatile LAS unsigned* misc = (volatile LAS unsigned*)(F.lds + LDS_MISC);
    if (F.tid < 4) misc[F.tid] = 0u;
    __syncthreads();
    const int lo = args.ph_lo, hi = args.ph_hi;
    XcdBarrier bar; bar.bar = F.ctl + CW_BAR; bar.x = 0; bar.st = misc;
    if (hi - lo > 1) bar = xcd_barrier_post(F.ctl + CW_BAR, misc);
    int pc = 0;
#ifndef MK_DUP_MASK
#define MK_DUP_MASK 0
#endif
#if MK_DUP_MASK
#define STEP(PH, Lx) do { if (pc >= lo && pc < hi) { int nrep_ = ((MK_DUP_MASK >> (PH)) & 1) ? 2 : 1; asm volatile("" : "+s"(nrep_)); _Pragma("unroll 1") for (int r_ = 0; r_ < nrep_; ++r_) { call_phase<PH>(F, args, Lx); if (r_ + 1 < nrep_ || pc + 1 < hi) xcd_barrier(bar); } } ++pc; } while (0)
#else
#define STEP(PH, Lx) do { if (pc >= lo && pc < hi) { call_phase<PH>(F, args, Lx); if (pc + 1 < hi) xcd_barrier(bar); } ++pc; } while (0)
#endif
    STEP(PH_PRO, 0);
#pragma unroll 1
    for (int L = 0; L < DEPTH; ++L) {
        const int kind = L % 3;
        if (kind == 0) { STEP(PH_POOL_G1, L); STEP(PH_POOL_P, L); STEP(PH_POOL_G2, L); STEP(PH_POOL_G3, L); }
        else if (kind == 1) { STEP(PH_DIL_G1, L); STEP(PH_DIL_ATT, L); STEP(PH_DIL_CMB, L); STEP(PH_DIL_G2, L); }
        else { STEP(PH_CONV_G1, L); STEP(PH_CONV_E, L); STEP(PH_CONV_G2, L); }
        STEP(PH_MOE1, L); STEP(PH_MOE2, L); STEP(PH_MOE3, L); STEP(PH_MOE4, L);
    }
#undef STEP
}
constexpr int N_STEPS = 1 + 2 * 8 + 8 + 7;

template <int PH> static void launch_phase(const Args& a, int L, int grid, hipStream_t stream) {
    static bool attr = false;
    if (!attr) { (void)hipFuncSetAttribute((const void*)k_phase<PH>, hipFuncAttributeMaxDynamicSharedMemorySize, LDS_BYTES); attr = true; }
    hipLaunchKernelGGL(k_phase<PH>, dim3(grid), dim3(512), LDS_BYTES, stream, a, L);
}
extern "C" void kernel_launch(void* const* d_in, const int* in_sizes, int n_in, void* d_out, int out_size, void* d_ws, size_t ws_size, hipStream_t stream) {
    static int grid = 0;
    if (grid == 0) {
        if (n_in != 19 || out_size != T * D || ws_size < WS_END) { fprintf(stderr, "kernel_launch: unexpected shapes (n_in %d out %d ws %zu need %zu)\n", n_in, out_size, ws_size, (size_t)WS_END); grid = -1; return; }
        int dev = 0, cus = 0;
        if (hipGetDevice(&dev) != hipSuccess || hipDeviceGetAttribute(&cus, hipDeviceAttributeMultiprocessorCount, dev) != hipSuccess) { grid = -1; return; }
#if MK_ONE_LAUNCH
        if (hipFuncSetAttribute((const void*)fwd_all, hipFuncAttributeMaxDynamicSharedMemorySize, LDS_BYTES) != hipSuccess) { fprintf(stderr, "kernel_launch: hipFuncSetAttribute failed\n"); grid = -1; return; }
        int per_cu = 0;
        if (hipOccupancyMaxActiveBlocksPerMultiprocessor(&per_cu, (const void*)fwd_all, 512, LDS_BYTES) != hipSuccess || per_cu < 1) { fprintf(stderr, "kernel_launch: note: occupancy query reports %d blocks per CU\n", per_cu); (void)hipGetLastError(); }
#endif
        grid = cus;
    }
    if (grid < 0) return;
    (void)hipMemsetAsync((char*)d_ws + WS_CTL, 0, CTL_ZERO_BYTES, stream);
    Args a{};
    for (int i = 0; i < 19; ++i) a.in[i] = (const float*)d_in[i];
    a.out = (float*)d_out; a.ws = (unsigned char*)d_ws; a.ph_lo = 0; a.ph_hi = 0;
#if MK_ONE_LAUNCH
#ifdef MK_SPLIT
    for (int p = 0; p < N_STEPS; ++p) { a.ph_lo = p; a.ph_hi = p + 1; hipLaunchKernelGGL(fwd_all, dim3(grid), dim3(512), LDS_BYTES, stream, a); }
#else
    a.ph_lo = 0; a.ph_hi = N_STEPS;
    hipLaunchKernelGGL(fwd_all, dim3(grid), dim3(512), LDS_BYTES, stream, a);
#endif
#elif defined(MK_HYBRID_MASK)
    {
        static bool attr2 = false; if (!attr2) { (void)hipFuncSetAttribute((const void*)fwd_all, hipFuncAttributeMaxDynamicSharedMemorySize, LDS_BYTES); attr2 = true; }
        int pc = 0;
#define HSTEP(PH, Lx) do { if ((MK_HYBRID_MASK >> (PH)) & 1) { a.ph_lo = pc; a.ph_hi = pc + 1; hipLaunchKernelGGL(fwd_all, dim3(grid), dim3(512), LDS_BYTES, stream, a); } else { a.ph_lo = 0; a.ph_hi = 0; launch_phase<PH>(a, Lx, grid, stream); } ++pc; } while (0)
        HSTEP(PH_PRO, 0);
        for (int L = 0; L < DEPTH; ++L) {
            const int kind = L % 3;
            if (kind == 0) { HSTEP(PH_POOL_G1, L); HSTEP(PH_POOL_P, L); HSTEP(PH_POOL_G2, L); HSTEP(PH_POOL_G3, L); }
            else if (kind == 1) { HSTEP(PH_DIL_G1, L); HSTEP(PH_DIL_ATT, L); HSTEP(PH_DIL_CMB, L); HSTEP(PH_DIL_G2, L); }
            else { HSTEP(PH_CONV_G1, L); HSTEP(PH_CONV_E, L); HSTEP(PH_CONV_G2, L); }
            HSTEP(PH_MOE1, L); HSTEP(PH_MOE2, L); HSTEP(PH_MOE3, L); HSTEP(PH_MOE4, L);
        }
#undef HSTEP
    }
#else
    launch_phase<PH_PRO>(a, 0, grid, stream);
    for (int L = 0; L < DEPTH; ++L) {
        const int kind = L % 3;
        if (kind == 0) { launch_phase<PH_POOL_G1>(a, L, grid, stream); launch_phase<PH_POOL_P>(a, L, grid, stream); launch_phase<PH_POOL_G2>(a, L, grid, stream); launch_phase<PH_POOL_G3>(a, L, grid, stream); }
        else if (kind == 1) { launch_phase<PH_DIL_G1>(a, L, grid, stream); launch_phase<PH_DIL_ATT>(a, L, grid, stream); launch_phase<PH_DIL_CMB>(a, L, grid, stream); launch_phase<PH_DIL_G2>(a, L, grid, stream); }
        else { launch_phase<PH_CONV_G1>(a, L, grid, stream); launch_phase<PH_CONV_E>(a, L, grid, stream); launch_phase<PH_CONV_G2>(a, L, grid, stream); }
        launch_phase<PH_MOE1>(a, L, grid, stream); launch_phase<PH_MOE2>(a, L, grid, stream); launch_phase<PH_MOE3>(a, L, grid, stream); launch_phase<PH_MOE4>(a, L, grid, stream);
    }
#endif
}
```
